# Optimizing an MI355X kernel written in HIP

```python
import math
import jax
import jax.numpy as jnp
from jax import lax
import numpy as np

D_MODEL = 1024
BATCH = 4
SEQ = 4096
DEPTH = 2
DEC_BATCH = 128
DEC_SEQ = 1
PAST_LEN = 8192
PAGE_SIZE = 128

GDN_HEADS = 4
GDN_DK = 128
GDN_DV = 128
GDN_CHUNK = 64
CONV_W = 4
LRU_WIDTH = 512
LRU_BLOCKS = 8
LRU_BW = LRU_WIDTH // LRU_BLOCKS
LRU_C = 8.0
SWA_HEADS = 16
SWA_KV_HEADS = 4
SWA_HEAD_DIM = 64
SWA_GROUP = SWA_HEADS // SWA_KV_HEADS
WINDOW = 128
REL_BUCKETS = 32
REL_MAX_DIST = 128
PEER_HEADS = 8
PEER_N_KEYS = 128
PEER_N_EXPERTS = PEER_N_KEYS ** 2
PEER_D_QUERY = 256
PEER_D_SUB = PEER_D_QUERY // 2
PEER_TOPK = 16
PEER_BLOCK = 128
DN_ALPHA = (2 * DEPTH) ** 0.25
DN_BETA = (8 * DEPTH) ** -0.25
LN_EPS = 1e-5
N_AB = (DEPTH + 1) // 2
N_C = DEPTH // 2
GDN_QK_W = GDN_HEADS * GDN_DK
GDN_V_W = GDN_HEADS * GDN_DV
GDN_CONV_CH = 2 * GDN_QK_W + GDN_V_W
AB_IN_COLS = GDN_CONV_CH + GDN_V_W + 2 * GDN_HEADS + 2 * LRU_WIDTH
AB_MIX_W = GDN_V_W + LRU_WIDTH
SWA_Q_W = SWA_HEADS * SWA_HEAD_DIM
SWA_KV_W = SWA_KV_HEADS * SWA_HEAD_DIM
C_IN_COLS = SWA_Q_W + 2 * SWA_KV_W

kernel_name = 'hybrid_gdn_rglru_swa_peer_step'

F32 = jnp.float32


def layer_norm(x, g, b):
    xf = x.astype(F32)
    mu = xf.mean(-1, keepdims=True)
    var = jnp.square(xf - mu).mean(-1, keepdims=True)
    return ((xf - mu) * lax.rsqrt(var + LN_EPS) * g + b).astype(x.dtype)


def causal_conv(x, w, buf, bias=None):
    xp = jnp.concatenate([buf.astype(x.dtype), x], axis=1)
    t_len = x.shape[1]
    y = sum(xp[:, i:i + t_len] * w[i] for i in range(CONV_W))
    if bias is not None:
        y = y + bias
    return y, xp[:, -(CONV_W - 1):]


def l2_normalize(x):
    return x * lax.rsqrt(jnp.sum(x * x, axis=-1, keepdims=True) + 1e-6)


def gated_delta_rule(q, k, v, g, beta, s0):
    bsz, t_len, n_h, _ = q.shape
    n_chunks = -(-t_len // GDN_CHUNK)
    pad = n_chunks * GDN_CHUNK - t_len

    def chunks(t):
        t = jnp.pad(t, [(0, 0), (0, pad)] + [(0, 0)] * (t.ndim - 2))
        t = t.reshape((bsz, n_chunks, GDN_CHUNK) + t.shape[2:])
        return jnp.moveaxis(t, 3, 1)

    q, k, v, g, beta = (chunks(t) for t in (q, k, v, g, beta))
    idx = jnp.arange(GDN_CHUNK)
    incl = idx[:, None] >= idx[None, :]
    strict = idx[:, None] > idx[None, :]
    gc = jnp.cumsum(g, axis=-1)
    decay = jnp.exp(jnp.where(incl, gc[..., :, None] - gc[..., None, :], -jnp.inf))
    kb = k * beta[..., None]
    lower = jnp.where(strict, jnp.einsum('bhncd,bhnsd->bhncs', kb, k) * decay, 0.0)
    rhs = jnp.concatenate([v * beta[..., None], kb * jnp.exp(gc)[..., None]], axis=-1)
    sol = lax.linalg.triangular_solve(lower, rhs, left_side=True, lower=True, unit_diagonal=True)
    u, w = sol[..., :GDN_DV], sol[..., GDN_DV:]
    qk = jnp.einsum('bhncd,bhnsd->bhncs', q, k) * decay

    def step(s, inp):
        q_c, k_c, u_c, w_c, gc_c, qk_c = inp
        v_new = u_c - jnp.einsum('bhcd,bhde->bhce', w_c, s)
        o = (jnp.einsum('bhcd,bhde->bhce', q_c * jnp.exp(gc_c)[..., None], s)
             + jnp.einsum('bhcs,bhse->bhce', qk_c, v_new))
        g_last = gc_c[..., -1:]
        s = (s * jnp.exp(g_last)[..., None]
             + jnp.einsum('bhcd,bhce->bhde', k_c * jnp.exp(g_last - gc_c)[..., None], v_new))
        return s, o

    xs = tuple(jnp.moveaxis(t, 2, 0) for t in (q, k, u, w, gc, qk))
    s_last, o = lax.scan(step, s0, xs)
    o = jnp.moveaxis(o, 0, 2).reshape(bsz, n_h, n_chunks * GDN_CHUNK, GDN_DV)[:, :, :t_len]
    return jnp.moveaxis(o, 1, 2), s_last


def _lru_combine(e1, e2):
    return e1[0] * e2[0], e2[0] * e1[1] + e2[1]


def rg_lru(x, h0, w_r, b_r, w_i, b_i, lam):
    bsz, t_len, _ = x.shape
    xf = x.astype(F32)
    xb = xf.reshape(bsz, t_len, LRU_BLOCKS, LRU_BW)
    r = jax.nn.sigmoid(jnp.einsum('btnc,ncd->btnd', xb, w_r).reshape(bsz, t_len, LRU_WIDTH) + b_r)
    i = jax.nn.sigmoid(jnp.einsum('btnc,ncd->btnd', xb, w_i).reshape(bsz, t_len, LRU_WIDTH) + b_i)
    log_a = -LRU_C * r * jax.nn.softplus(-lam.astype(F32))
    a = jnp.exp(log_a)
    b = jnp.sqrt(-jnp.expm1(2.0 * log_a)) * (i * xf)
    b = b.at[:, 0].add(a[:, 0] * h0.astype(F32))
    _, h = lax.associative_scan(_lru_combine, (a, b), axis=1)
    return h, h[:, -1]


def ab_mixer(x, s0, gdn_buf, h0, lru_buf, w_in, gdn_conv_w, gdn_a_log, gdn_dt_bias, gdn_norm_w,
             lru_conv_w, lru_conv_b, lru_w_r, lru_b_r, lru_w_i, lru_b_i, lru_lam, w_out):
    bsz, t_len, _ = x.shape
    proj = x @ w_in
    splits = np.cumsum([GDN_CONV_CH, GDN_V_W, GDN_HEADS, GDN_HEADS, LRU_WIDTH]).tolist()
    qkv, z, a_raw, b_raw, xr, gate = jnp.split(proj, splits, axis=-1)
    qkv, gdn_buf_new = causal_conv(qkv, gdn_conv_w, gdn_buf)
    qkv = jax.nn.silu(qkv).astype(F32)
    q, k, v = jnp.split(qkv, [GDN_QK_W, 2 * GDN_QK_W], axis=-1)
    q = l2_normalize(q.reshape(bsz, t_len, GDN_HEADS, GDN_DK)) * (GDN_DK ** -0.5)
    k = l2_normalize(k.reshape(bsz, t_len, GDN_HEADS, GDN_DK))
    v = v.reshape(bsz, t_len, GDN_HEADS, GDN_DV)
    beta = jax.nn.sigmoid(b_raw.astype(F32))
    g = -jnp.exp(gdn_a_log.astype(F32)) * jax.nn.softplus(a_raw.astype(F32) + gdn_dt_bias)
    o, s_new = gated_delta_rule(q, k, v, g, beta, s0.astype(F32))
    o = o * lax.rsqrt(jnp.mean(o * o, axis=-1, keepdims=True) + 1e-6) * gdn_norm_w
    o = o * jax.nn.silu(z.astype(F32).reshape(bsz, t_len, GDN_HEADS, GDN_DV))
    o_a = o.reshape(bsz, t_len, GDN_V_W).astype(x.dtype)
    xr, lru_buf_new = causal_conv(xr, lru_conv_w, lru_buf, lru_conv_b)
    h, h_last = rg_lru(xr, h0, lru_w_r, lru_b_r, lru_w_i, lru_b_i, lru_lam)
    o_b = (jax.nn.gelu(gate.astype(F32)) * h).astype(x.dtype)
    y = jnp.concatenate([o_a, o_b], axis=-1) @ w_out
    return y, s_new, gdn_buf_new, h_last, lru_buf_new


def t5_bucket(rel):
    n = jnp.maximum(rel, 0)
    exact = REL_BUCKETS // 2
    nf = jnp.maximum(n, 1).astype(F32)
    large = exact + (jnp.log(nf / exact) / math.log(REL_MAX_DIST / exact)
                     * (REL_BUCKETS - exact)).astype(jnp.int32)
    return jnp.where(n < exact, n, jnp.minimum(large, REL_BUCKETS - 1))


def swa_project(x, w_in, b_in):
    bsz, t_len, _ = x.shape
    proj = x @ w_in + b_in
    q, k, v = jnp.split(proj, [SWA_Q_W, SWA_Q_W + SWA_KV_W], axis=-1)
    return (q.reshape(bsz, t_len, SWA_KV_HEADS, SWA_GROUP, SWA_HEAD_DIM),
            k.reshape(bsz, t_len, SWA_KV_HEADS, SWA_HEAD_DIM),
            v.reshape(bsz, t_len, SWA_KV_HEADS, SWA_HEAD_DIM))


def banded_attention(q, k, v, qpos, kpos, rel_bias, sinks):
    n_blk, n_q = qpos.shape
    n_k = kpos.shape[1]
    rel = qpos[:, :, None] - kpos[:, None, :]
    mask = (rel >= 0) & (rel < WINDOW) & (kpos[:, None, :] >= 0)
    bias = rel_bias.astype(F32)[t5_bucket(rel)]
    bias = bias.reshape(n_blk, n_q, n_k, SWA_KV_HEADS, SWA_GROUP).transpose(0, 3, 4, 1, 2)
    logits = (jnp.einsum('bnqhgd,bnkhd->bnhgqk', q.astype(F32), k.astype(F32)) * (SWA_HEAD_DIM ** -0.5)
              + bias[None])
    logits = jnp.where(mask[None, :, None, None], logits, -jnp.inf)
    sink = sinks.astype(F32).reshape(SWA_KV_HEADS, SWA_GROUP)[None, None, :, :, None, None]
    m = jnp.maximum(logits.max(-1, keepdims=True), sink)
    p = jnp.exp(logits - m)
    probs = p / (p.sum(-1, keepdims=True) + jnp.exp(sink - m))
    return jnp.einsum('bnhgqk,bnkhd->bnqhgd', probs, v.astype(F32))


def swa_prompt(x, w_in, b_in, sinks, w_out, b_out, rel_bias):
    bsz, t_len, _ = x.shape
    q, k, v = swa_project(x, w_in, b_in)
    n_blk = t_len // WINDOW

    def key_blocks(t):
        tp = jnp.concatenate([jnp.zeros_like(t[:, :WINDOW]), t], axis=1)
        prev = tp[:, :t_len].reshape((bsz, n_blk, WINDOW) + t.shape[2:])
        cur = tp[:, WINDOW:].reshape((bsz, n_blk, WINDOW) + t.shape[2:])
        return jnp.concatenate([prev, cur], axis=2)

    base = jnp.arange(n_blk)[:, None] * WINDOW
    qpos = base + jnp.arange(WINDOW)[None, :]
    kpos = base - WINDOW + jnp.arange(2 * WINDOW)[None, :]
    qb = q.reshape(bsz, n_blk, WINDOW, SWA_KV_HEADS, SWA_GROUP, SWA_HEAD_DIM)
    o = banded_attention(qb, key_blocks(k), key_blocks(v), qpos, kpos, rel_bias, sinks)
    y = o.reshape(bsz, t_len, SWA_Q_W).astype(x.dtype) @ w_out + b_out
    return y, k[:, -WINDOW:], v[:, -WINDOW:]


def swa_sample(x, k_buf, v_buf, w_in, b_in, sinks, w_out, b_out, rel_bias):
    bsz, t_len, _ = x.shape
    q, k, v = swa_project(x, w_in, b_in)
    wb = k_buf.shape[1]
    kc = jnp.concatenate([k_buf.astype(k.dtype), k], axis=1)
    vc = jnp.concatenate([v_buf.astype(v.dtype), v], axis=1)
    qpos = (PAST_LEN + jnp.arange(t_len))[None, :]
    kpos = (PAST_LEN - wb + jnp.arange(wb + t_len))[None, :]
    o = banded_attention(q[:, None], kc[:, None], vc[:, None], qpos, kpos, rel_bias, sinks)[:, 0]
    y = o.reshape(bsz, t_len, SWA_Q_W).astype(x.dtype) @ w_out + b_out
    return y, kc[:, -wb:], vc[:, -wb:]


def peer(x, w_q, sub_keys, u_tab, v_tab):
    shp = x.shape
    t = x.reshape(-1, D_MODEL)
    n_tok = t.shape[0]
    n_blocks = -(-n_tok // PEER_BLOCK)
    t = jnp.pad(t, ((0, n_blocks * PEER_BLOCK - n_tok), (0, 0)))

    def block(tb):
        q = (tb @ w_q).reshape(PEER_BLOCK, PEER_HEADS, 2, PEER_D_SUB)
        s = jnp.einsum('thcd,hcnd->thcn', q, sub_keys).astype(F32)
        s_top, i_top = lax.top_k(s, PEER_TOPK)
        cand = (s_top[:, :, 0, :, None] + s_top[:, :, 1, None, :]).reshape(PEER_BLOCK, PEER_HEADS, -1)
        cand_idx = (i_top[:, :, 0, :, None] * PEER_N_KEYS + i_top[:, :, 1, None, :]).reshape(
            PEER_BLOCK, PEER_HEADS, -1)
        best, pos = lax.top_k(cand, PEER_TOPK)
        expert = jnp.take_along_axis(cand_idx, pos, axis=-1)
        gate = jax.nn.softmax(best, axis=-1)
        act = jax.nn.gelu(jnp.einsum('td,thkd->thk', tb, u_tab[expert]).astype(F32))
        return jnp.einsum('thk,thkd->td', (gate * act).astype(tb.dtype), v_tab[expert])

    y = lax.map(block, t.reshape(n_blocks, PEER_BLOCK, D_MODEL))
    return y.reshape(-1, D_MODEL)[:n_tok].reshape(shp)


def setup_inputs(seed: int = 0) -> dict:
    key = jax.random.key(seed)
    keys = iter(jax.random.split(key, 48))

    def nrm(shape, scale):
        return scale * jax.random.normal(next(keys), shape, jnp.float32)

    win_buf = min(WINDOW, PAST_LEN)
    a_init = jax.random.uniform(next(keys), (N_AB, LRU_WIDTH), jnp.float32, 0.9, 0.999)
    sig_l = a_init ** (1.0 / LRU_C)
    lru_lam = jnp.log(sig_l) - jnp.log1p(-sig_l)
    gdn_a_log = jnp.log(jax.random.uniform(next(keys), (N_AB, GDN_HEADS), jnp.float32, 1.0, 16.0))
    dt = jnp.exp(jax.random.uniform(next(keys), (N_AB, GDN_HEADS), jnp.float32,
                                    math.log(1e-3), math.log(1e-1)))
    gdn_dt_bias = dt + jnp.log(-jnp.expm1(-dt))
    return {
        'x_prompt': nrm((BATCH, SEQ, D_MODEL), 1.0),
        'x_sample': nrm((DEC_BATCH, DEC_SEQ, D_MODEL), 1.0),
        'state_gdn': nrm((N_AB, DEC_BATCH, GDN_HEADS, GDN_DK, GDN_DV), 0.05),
        'state_gdn_conv': nrm((N_AB, DEC_BATCH, CONV_W - 1, GDN_CONV_CH), 1.0),
        'state_lru': nrm((N_AB, DEC_BATCH, LRU_WIDTH), 0.5),
        'state_lru_conv': nrm((N_AB, DEC_BATCH, CONV_W - 1, LRU_WIDTH), 1.0),
        'cache_swa_k': nrm((N_C, DEC_BATCH, win_buf, SWA_KV_HEADS, SWA_HEAD_DIM), 1.0),
        'cache_swa_v': nrm((N_C, DEC_BATCH, win_buf, SWA_KV_HEADS, SWA_HEAD_DIM), 1.0),
        'w_in_ab': nrm((N_AB, D_MODEL, AB_IN_COLS), D_MODEL ** -0.5),
        'gdn_conv_w': nrm((N_AB, CONV_W, GDN_CONV_CH), CONV_W ** -0.5),
        'gdn_a_log': gdn_a_log,
        'gdn_dt_bias': gdn_dt_bias,
        'gdn_norm_w': 1.0 + nrm((N_AB, GDN_DV), 0.01),
        'lru_conv_w': nrm((N_AB, CONV_W, LRU_WIDTH), CONV_W ** -0.5),
        'lru_conv_b': nrm((N_AB, LRU_WIDTH), 0.01),
        'lru_w_r': nrm((N_AB, LRU_BLOCKS, LRU_BW, LRU_BW), LRU_BW ** -0.5),
        'lru_b_r': nrm((N_AB, LRU_WIDTH), 0.01),
        'lru_w_i': nrm((N_AB, LRU_BLOCKS, LRU_BW, LRU_BW), LRU_BW ** -0.5),
        'lru_b_i': nrm((N_AB, LRU_WIDTH), 0.01),
        'lru_lam': lru_lam,
        'w_out_ab': nrm((N_AB, AB_MIX_W, D_MODEL), DN_BETA * AB_MIX_W ** -0.5),
        'w_in_c': nrm((N_C, D_MODEL, C_IN_COLS), D_MODEL ** -0.5),
        'b_in_c': nrm((N_C, C_IN_COLS), 0.01),
        'swa_sinks': nrm((N_C, SWA_HEADS), 0.5),
        'w_out_c': nrm((N_C, SWA_Q_W, D_MODEL), DN_BETA * SWA_Q_W ** -0.5),
        'b_out_c': nrm((N_C, D_MODEL), 0.01),
        'rel_bias': nrm((REL_BUCKETS, SWA_HEADS), 0.3),
        'ln_mix_g': 1.0 + nrm((DEPTH, D_MODEL), 0.01),
        'ln_mix_b': nrm((DEPTH, D_MODEL), 0.01),
        'ln_ffn_g': 1.0 + nrm((DEPTH, D_MODEL), 0.01),
        'ln_ffn_b': nrm((DEPTH, D_MODEL), 0.01),
        'peer_w_q': nrm((DEPTH, D_MODEL, PEER_HEADS * PEER_D_QUERY), D_MODEL ** -0.5),
        'peer_keys': nrm((DEPTH, PEER_HEADS, 2, PEER_N_KEYS, PEER_D_SUB), PEER_D_SUB ** -0.5),
        'peer_u': nrm((DEPTH, PEER_N_EXPERTS, D_MODEL), D_MODEL ** -0.5),
        'peer_v': nrm((DEPTH, PEER_N_EXPERTS, D_MODEL), DN_BETA * PEER_HEADS ** -0.5),
    }


def reference(x_prompt, x_sample, state_gdn, state_gdn_conv, state_lru, state_lru_conv,
              cache_swa_k, cache_swa_v, w_in_ab, gdn_conv_w, gdn_a_log, gdn_dt_bias, gdn_norm_w,
              lru_conv_w, lru_conv_b, lru_w_r, lru_b_r, lru_w_i, lru_b_i, lru_lam, w_out_ab,
              w_in_c, b_in_c, swa_sinks, w_out_c, b_out_c, rel_bias,
              ln_mix_g, ln_mix_b, ln_ffn_g, ln_ffn_b, peer_w_q, peer_keys, peer_u, peer_v):
    xp, xs = x_prompt, x_sample
    bsz = xp.shape[0]
    p_gdn, p_gdn_conv, p_lru, p_lru_conv, p_k, p_v = [], [], [], [], [], []
    s_gdn, s_gdn_conv, s_lru, s_lru_conv, s_k, s_v = [], [], [], [], [], []
    for layer in range(DEPTH):
        j = layer // 2
        if layer % 2 == 0:
            ab_w = (w_in_ab[j], gdn_conv_w[j], gdn_a_log[j], gdn_dt_bias[j], gdn_norm_w[j],
                    lru_conv_w[j], lru_conv_b[j], lru_w_r[j], lru_b_r[j], lru_w_i[j], lru_b_i[j],
                    lru_lam[j], w_out_ab[j])
            mp, st, cb, hl, lb = ab_mixer(
                xp, jnp.zeros((bsz, GDN_HEADS, GDN_DK, GDN_DV), F32),
                jnp.zeros((bsz, CONV_W - 1, GDN_CONV_CH), xp.dtype),
                jnp.zeros((bsz, LRU_WIDTH), F32),
                jnp.zeros((bsz, CONV_W - 1, LRU_WIDTH), xp.dtype), *ab_w)
            p_gdn.append(st); p_gdn_conv.append(cb); p_lru.append(hl); p_lru_conv.append(lb)
            ms, st, cb, hl, lb = ab_mixer(xs, state_gdn[j], state_gdn_conv[j], state_lru[j],
                                          state_lru_conv[j], *ab_w)
            s_gdn.append(st); s_gdn_conv.append(cb); s_lru.append(hl); s_lru_conv.append(lb)
        else:
            c_w = (w_in_c[j], b_in_c[j], swa_sinks[j], w_out_c[j], b_out_c[j], rel_bias)
            mp, kk, vv = swa_prompt(xp, *c_w)
            p_k.append(kk); p_v.append(vv)
            ms, kk, vv = swa_sample(xs, cache_swa_k[j], cache_swa_v[j], *c_w)
            s_k.append(kk); s_v.append(vv)
        xp = layer_norm(DN_ALPHA * xp + mp, ln_mix_g[layer], ln_mix_b[layer])
        xs = layer_norm(DN_ALPHA * xs + ms, ln_mix_g[layer], ln_mix_b[layer])
        peer_w = (peer_w_q[layer], peer_keys[layer], peer_u[layer], peer_v[layer])
        xp = layer_norm(DN_ALPHA * xp + peer(xp, *peer_w), ln_ffn_g[layer], ln_ffn_b[layer])
        xs = layer_norm(DN_ALPHA * xs + peer(xs, *peer_w), ln_ffn_g[layer], ln_ffn_b[layer])
    return (xp, xs,
            jnp.stack(p_gdn), jnp.stack(p_gdn_conv), jnp.stack(p_lru), jnp.stack(p_lru_conv),
            jnp.stack(p_k), jnp.stack(p_v),
            jnp.stack(s_gdn), jnp.stack(s_gdn_conv), jnp.stack(s_lru), jnp.stack(s_lru_conv),
            jnp.stack(s_k), jnp.stack(s_v))
```

```cpp
#include <hip/hip_runtime.h>
#include <cstdio>
#include <cstdint>

namespace {
constexpr int D = 1024, NB = 4, SEQ = 4096, NP = NB * SEQ, NS = 128, NT = NP + NS, MP = 16640;
constexpr int ABN = 3080;
constexpr int C_QKV = 0, C_Z = 1536, C_A = 2048, C_B = 2052, C_XR = 2056, C_GATE = 2568;
constexpr int CN = 1536;
constexpr float ALPHA = 1.4142135623730951f;
constexpr float LN_EPS = 1e-5f;

__device__ __forceinline__ float sigmoidf_(float x) { return 1.0f / (1.0f + expf(-x)); }
__device__ __forceinline__ float softplusf_(float x) { return fmaxf(x, 0.f) + log1pf(expf(-fabsf(x))); }
__device__ __forceinline__ float siluf_(float x) { return x / (1.0f + expf(-x)); }
__device__ __forceinline__ float geluf_(float x) { return 0.5f * x * (1.0f + tanhf(0.7978845608028654f * (x + 0.044715f * x * x * x))); }
__device__ __forceinline__ float wave_sum(float v) {
#pragma unroll
    for (int o = 32; o > 0; o >>= 1) v += __shfl_xor(v, o);
    return v;
}
__device__ __forceinline__ float wave_max(float v) {
#pragma unroll
    for (int o = 32; o > 0; o >>= 1) v = fmaxf(v, __shfl_xor(v, o));
    return v;
}

__global__ void __launch_bounds__(256) gemm_f32(const float* __restrict__ A, const float* __restrict__ W, const float* __restrict__ bias,
                                                float* __restrict__ C, int M, int N, int K, int ldc) {
    __shared__ float As[16][68];
    __shared__ float Ws[16][68];
    const int tid = threadIdx.x, bm = blockIdx.y * 64, bn = blockIdx.x * 64, tx = tid % 16, ty = tid / 16;
    float acc[4][4];
#pragma unroll
    for (int i = 0; i < 4; ++i)
#pragma unroll
        for (int j = 0; j < 4; ++j) acc[i][j] = 0.f;
    for (int k0 = 0; k0 < K; k0 += 16) {
        {
            const int r = tid / 4, c = (tid % 4) * 4;
            float4 v = make_float4(0.f, 0.f, 0.f, 0.f);
            if (bm + r < M) v = *(const float4*)(A + (size_t)(bm + r) * K + k0 + c);
            As[c + 0][r] = v.x; As[c + 1][r] = v.y; As[c + 2][r] = v.z; As[c + 3][r] = v.w;
        }
        {
            const int r = tid / 16, c = (tid % 16) * 4;
            float4 v = make_float4(0.f, 0.f, 0.f, 0.f);
            if (bn + c < N) v = *(const float4*)(W + (size_t)(k0 + r) * N + bn + c);
            *(float4*)&Ws[r][c] = v;
        }
        __syncthreads();
#pragma unroll
        for (int k = 0; k < 16; ++k) {
            const float4 a = *(const float4*)&As[k][ty * 4];
            const float4 b = *(const float4*)&Ws[k][tx * 4];
            const float av[4] = {a.x, a.y, a.z, a.w}, bv[4] = {b.x, b.y, b.z, b.w};
#pragma unroll
            for (int i = 0; i < 4; ++i)
#pragma unroll
                for (int j = 0; j < 4; ++j) acc[i][j] += av[i] * bv[j];
        }
        __syncthreads();
    }
#pragma unroll
    for (int i = 0; i < 4; ++i) {
        const int row = bm + ty * 4 + i;
        if (row >= M) continue;
#pragma unroll
        for (int j = 0; j < 4; ++j) {
            const int col = bn + tx * 4 + j;
            if (col < N) C[(size_t)row * ldc + col] = acc[i][j] + (bias ? bias[col] : 0.f);
        }
    }
}

struct AbPrepArgs {
    const float* PROJ; const float* st_gdn_conv; const float* st_lru_conv;
    const float* gdn_conv_w; const float* a_log; const float* dt_bias;
    const float* lru_conv_w; const float* lru_conv_b; const float* w_r; const float* b_r; const float* w_i; const float* b_i; const float* lam;
    float* QKV; float* G; float* BETA; float* LA; float* LB;
    float* p_gdn_conv; float* p_lru_conv; float* s_gdn_conv; float* s_lru_conv;
};
__global__ void __launch_bounds__(256) ab_prep(AbPrepArgs a) {
    const int t = blockIdx.x, tid = threadIdx.x, lane = tid & 63, wid = tid >> 6;
    const bool samp = t >= NP; const int sb = t - NP, pos = t % SEQ, b = t / SEQ;
    __shared__ float sq[1536];
    __shared__ float sx[512];
    __shared__ float scl[8];
    const float* prow = a.PROJ + (size_t)t * ABN;
    for (int c = tid; c < 1536; c += 256) {
        float acc = 0.f;
#pragma unroll
        for (int i = 0; i < 4; ++i) {
            float xv;
            if (i == 3) xv = prow[C_QKV + c];
            else if (samp) xv = a.st_gdn_conv[((size_t)sb * 3 + i) * 1536 + c];
            else xv = (pos - 3 + i >= 0) ? a.PROJ[(size_t)(t - 3 + i) * ABN + C_QKV + c] : 0.f;
            acc += a.gdn_conv_w[i * 1536 + c] * xv;
        }
        sq[c] = siluf_(acc);
    }
    for (int c = tid; c < 512; c += 256) {
        float acc = a.lru_conv_b[c];
#pragma unroll
        for (int i = 0; i < 4; ++i) {
            float xv;
            if (i == 3) xv = prow[C_XR + c];
            else if (samp) xv = a.st_lru_conv[((size_t)sb * 3 + i) * 512 + c];
            else xv = (pos - 3 + i >= 0) ? a.PROJ[(size_t)(t - 3 + i) * ABN + C_XR + c] : 0.f;
            acc += a.lru_conv_w[i * 512 + c] * xv;
        }
        sx[c] = acc;
    }
    __syncthreads();
#pragma unroll
    for (int gi = 0; gi < 2; ++gi) {
        const int grp = wid * 2 + gi;
        const float v0 = sq[grp * 128 + lane], v1 = sq[grp * 128 + 64 + lane];
        const float s = wave_sum(v0 * v0 + v1 * v1);
        if (lane == 0) scl[grp] = rsqrtf(s + 1e-6f) * (grp < 4 ? 0.08838834764831845f : 1.0f);
    }
    __syncthreads();
    for (int c = tid; c < 1536; c += 256) a.QKV[(size_t)t * 1536 + c] = (c < 1024) ? sq[c] * scl[c >> 7] : sq[c];
    if (tid < 4) {
        const float a_raw = prow[C_A + tid], b_raw = prow[C_B + tid];
        a.G[(size_t)t * 4 + tid] = -expf(a.a_log[tid]) * softplusf_(a_raw + a.dt_bias[tid]);
        a.BETA[(size_t)t * 4 + tid] = sigmoidf_(b_raw);
    }
    if (!samp) {
        if (pos >= SEQ - 3) {
            const int row = pos - (SEQ - 3);
            for (int c = tid; c < 1536; c += 256) a.p_gdn_conv[((size_t)b * 3 + row) * 1536 + c] = prow[C_QKV + c];
            for (int c = tid; c < 512; c += 256) a.p_lru_conv[((size_t)b * 3 + row) * 512 + c] = prow[C_XR + c];
        }
    } else {
        for (int c = tid; c < 1536; c += 256) {
            a.s_gdn_conv[((size_t)sb * 3 + 0) * 1536 + c] = a.st_gdn_conv[((size_t)sb * 3 + 1) * 1536 + c];
            a.s_gdn_conv[((size_t)sb * 3 + 1) * 1536 + c] = a.st_gdn_conv[((size_t)sb * 3 + 2) * 1536 + c];
            a.s_gdn_conv[((size_t)sb * 3 + 2) * 1536 + c] = prow[C_QKV + c];
        }
        for (int c = tid; c < 512; c += 256) {
            a.s_lru_conv[((size_t)sb * 3 + 0) * 512 + c] = a.st_lru_conv[((size_t)sb * 3 + 1) * 512 + c];
            a.s_lru_conv[((size_t)sb * 3 + 1) * 512 + c] = a.st_lru_conv[((size_t)sb * 3 + 2) * 512 + c];
            a.s_lru_conv[((size_t)sb * 3 + 2) * 512 + c] = prow[C_XR + c];
        }
    }
    for (int c = tid; c < 512; c += 256) {
        const int n = c >> 6, d = c & 63;
        float r = a.b_r[c], ii = a.b_i[c];
        for (int cc = 0; cc < 64; ++cc) {
            const float xv = sx[n * 64 + cc];
            r += xv * a.w_r[((size_t)n * 64 + cc) * 64 + d];
            ii += xv * a.w_i[((size_t)n * 64 + cc) * 64 + d];
        }
        r = sigmoidf_(r); ii = sigmoidf_(ii);
        const float log_a = -8.0f * r * softplusf_(-a.lam[c]);
        a.LA[(size_t)t * 512 + c] = expf(log_a);
        a.LB[(size_t)t * 512 + c] = sqrtf(-expm1f(2.0f * log_a)) * (ii * sx[c]);
    }
}

__global__ void __launch_bounds__(256) gdn_scan(const float* __restrict__ QKV, const float* __restrict__ G, const float* __restrict__ BETA,
                                                const float* __restrict__ S0, float* __restrict__ O, float* __restrict__ Sout, int tok_base, int T) {
    const int sl = blockIdx.x, h = blockIdx.y, sq = blockIdx.z, tid = threadIdx.x, dvl = tid & 31, kg = tid >> 5;
    const int dv = sl * 32 + dvl;
    __shared__ float red1[8][32];
    __shared__ float red2[8][32];
    float S[16];
#pragma unroll
    for (int i = 0; i < 16; ++i) S[i] = S0 ? S0[(((size_t)sq * 4 + h) * 128 + kg * 16 + i) * 128 + dv] : 0.f;
    float kk[16], qq[16], vv, g, be;
    {
        const size_t tok = (size_t)tok_base + (size_t)sq * T;
        const float* row = QKV + tok * 1536;
#pragma unroll
        for (int i = 0; i < 16; ++i) { kk[i] = row[512 + h * 128 + kg * 16 + i]; qq[i] = row[h * 128 + kg * 16 + i]; }
        vv = row[1024 + h * 128 + dv]; g = G[tok * 4 + h]; be = BETA[tok * 4 + h];
    }
    for (int t = 0; t < T; ++t) {
        const size_t tok = (size_t)tok_base + (size_t)sq * T + t;
        float nk[16], nq[16], nv = 0.f, ng = 0.f, nb = 0.f;
        if (t + 1 < T) {
            const float* row = QKV + (tok + 1) * 1536;
#pragma unroll
            for (int i = 0; i < 16; ++i) { nk[i] = row[512 + h * 128 + kg * 16 + i]; nq[i] = row[h * 128 + kg * 16 + i]; }
            nv = row[1024 + h * 128 + dv]; ng = G[(tok + 1) * 4 + h]; nb = BETA[(tok + 1) * 4 + h];
        } else {
#pragma unroll
            for (int i = 0; i < 16; ++i) { nk[i] = 0.f; nq[i] = 0.f; }
        }
        const float al = expf(g);
        float p = 0.f;
#pragma unroll
        for (int i = 0; i < 16; ++i) { S[i] *= al; p += S[i] * kk[i]; }
        red1[kg][dvl] = p;
        __syncthreads();
        float ks = 0.f;
#pragma unroll
        for (int j = 0; j < 8; ++j) ks += red1[j][dvl];
        const float vn = be * (vv - ks);
        float o = 0.f;
#pragma unroll
        for (int i = 0; i < 16; ++i) { S[i] += kk[i] * vn; o += S[i] * qq[i]; }
        red2[kg][dvl] = o;
        __syncthreads();
        if (kg == 0) {
            float os = 0.f;
#pragma unroll
            for (int j = 0; j < 8; ++j) os += red2[j][dvl];
            O[tok * 512 + h * 128 + dv] = os;
        }
#pragma unroll
        for (int i = 0; i < 16; ++i) { kk[i] = nk[i]; qq[i] = nq[i]; }
        vv = nv; g = ng; be = nb;
    }
#pragma unroll
    for (int i = 0; i < 16; ++i) Sout[(((size_t)sq * 4 + h) * 128 + kg * 16 + i) * 128 + dv] = S[i];
}

__global__ void __launch_bounds__(256) lru_scan(const float* __restrict__ LA, float* __restrict__ LB, const float* __restrict__ h0,
                                                float* __restrict__ hlast, int tok_base, int T, int nseq) {
    const int idx = blockIdx.x * 256 + threadIdx.x;
    if (idx >= nseq * 512) return;
    const int sq = idx / 512, c = idx % 512;
    float h = h0 ? h0[(size_t)sq * 512 + c] : 0.f;
    const size_t base = ((size_t)tok_base + (size_t)sq * T) * 512 + c;
#pragma unroll 8
    for (int t = 0; t < T; ++t) {
        const size_t o = base + (size_t)t * 512;
        h = LA[o] * h + LB[o];
        LB[o] = h;
    }
    hlast[(size_t)sq * 512 + c] = h;
}

__global__ void __launch_bounds__(256) ab_mix(const float* __restrict__ PROJ, const float* __restrict__ O, const float* __restrict__ H,
                                              const float* __restrict__ norm_w, float* __restrict__ MIX) {
    const int t = blockIdx.x, tid = threadIdx.x, lane = tid & 63, wid = tid >> 6;
    const float* prow = PROJ + (size_t)t * ABN;
    {
        const int h = wid;
        const float o0 = O[(size_t)t * 512 + h * 128 + lane], o1 = O[(size_t)t * 512 + h * 128 + 64 + lane];
        const float ms = wave_sum(o0 * o0 + o1 * o1) * (1.0f / 128.0f);
        const float sc = rsqrtf(ms + 1e-6f);
        MIX[(size_t)t * 1024 + h * 128 + lane] = o0 * sc * norm_w[lane] * siluf_(prow[C_Z + h * 128 + lane]);
        MIX[(size_t)t * 1024 + h * 128 + 64 + lane] = o1 * sc * norm_w[64 + lane] * siluf_(prow[C_Z + h * 128 + 64 + lane]);
    }
    for (int c = tid; c < 512; c += 256) MIX[(size_t)t * 1024 + 512 + c] = geluf_(prow[C_GATE + c]) * H[(size_t)t * 512 + c];
}

__device__ __forceinline__ void block_ln_store(float v[4], const float* __restrict__ g, const float* __restrict__ bta, float* __restrict__ out, int tid, float* sred) {
    const int lane = tid & 63, wid = tid >> 6;
    float s = wave_sum(v[0] + v[1] + v[2] + v[3]);
    if (lane == 0) sred[wid] = s;
    __syncthreads();
    const float mean = (sred[0] + sred[1] + sred[2] + sred[3]) * (1.0f / 1024.0f);
    __syncthreads();
    float d[4], q = 0.f;
#pragma unroll
    for (int i = 0; i < 4; ++i) { d[i] = v[i] - mean; q += d[i] * d[i]; }
    q = wave_sum(q);
    if (lane == 0) sred[wid] = q;
    __syncthreads();
    const float var = (sred[0] + sred[1] + sred[2] + sred[3]) * (1.0f / 1024.0f);
    const float rs = rsqrtf(var + LN_EPS);
#pragma unroll
    for (int i = 0; i < 4; ++i) out[tid * 4 + i] = d[i] * rs * g[tid * 4 + i] + bta[tid * 4 + i];
}

__global__ void __launch_bounds__(256) ln_res(const float* __restrict__ xa, const float* __restrict__ xb, const float* __restrict__ Y,
                                              const float* __restrict__ g, const float* __restrict__ bta, float* __restrict__ out) {
    const int t = blockIdx.x, tid = threadIdx.x;
    __shared__ float sred[4];
    const float* xr = (t < NP) ? xa + (size_t)t * D : xb + (size_t)(t - NP) * D;
    float v[4];
#pragma unroll
    for (int i = 0; i < 4; ++i) v[i] = ALPHA * xr[tid * 4 + i] + Y[(size_t)t * D + tid * 4 + i];
    block_ln_store(v, g, bta, out + (size_t)t * D, tid, sred);
}

__global__ void __launch_bounds__(256) peer_topk(const float* __restrict__ Q, const float* __restrict__ keys, int* __restrict__ EXP, float* __restrict__ GATE) {
    const int tg = blockIdx.x, h = blockIdx.y, tid = threadIdx.x, c = tid >> 7, n = tid & 127;
    __shared__ float sq[32][256];
    __shared__ float ss[32][257];
    __shared__ float tvs[32][2][16];
    __shared__ int tis[32][2][16];
    for (int i = tid; i < 32 * 256; i += 256) {
        const int tk = i >> 8, col = i & 255;
        sq[tk][col] = Q[(size_t)(tg * 32 + tk) * 2048 + h * 256 + col];
    }
    __syncthreads();
    float acc[32];
#pragma unroll
    for (int i = 0; i < 32; ++i) acc[i] = 0.f;
    const float* krow = keys + (((size_t)h * 2 + c) * 128 + n) * 128;
    for (int d4 = 0; d4 < 32; ++d4) {
        const float4 kv = *(const float4*)(krow + d4 * 4);
#pragma unroll
        for (int tk = 0; tk < 32; ++tk) {
            const float4 qv = *(const float4*)&sq[tk][c * 128 + d4 * 4];
            acc[tk] += qv.x * kv.x + qv.y * kv.y + qv.z * kv.z + qv.w * kv.w;
        }
    }
#pragma unroll
    for (int tk = 0; tk < 32; ++tk) ss[tk][tid] = acc[tk];
    __syncthreads();
    if (tid < 64) {
        const int tk = tid >> 1, cc = tid & 1;
        float tv[16]; int ti[16];
#pragma unroll
        for (int j = 0; j < 16; ++j) { tv[j] = -INFINITY; ti[j] = 0; }
        for (int nn = 0; nn < 128; ++nn) {
            float x = ss[tk][cc * 128 + nn]; int xi = nn;
#pragma unroll
            for (int j = 0; j < 16; ++j) {
                const bool gt = x > tv[j];
                const float tf = tv[j]; const int tj = ti[j];
                tv[j] = gt ? x : tf; ti[j] = gt ? xi : tj;
                x = gt ? tf : x; xi = gt ? tj : xi;
            }
        }
#pragma unroll
        for (int j = 0; j < 16; ++j) { tvs[tk][cc][j] = tv[j]; tis[tk][cc][j] = ti[j]; }
    }
    __syncthreads();
    if (tid < 32) {
        const int tk = tid;
        float bv[16]; int bi[16];
#pragma unroll
        for (int j = 0; j < 16; ++j) { bv[j] = -INFINITY; bi[j] = 0; }
        for (int i = 0; i < 16; ++i)
            for (int jj = 0; jj < 16; ++jj) {
                float x = tvs[tk][0][i] + tvs[tk][1][jj]; int xi = tis[tk][0][i] * 128 + tis[tk][1][jj];
#pragma unroll
                for (int j = 0; j < 16; ++j) {
                    const bool gt = x > bv[j];
                    const float tf = bv[j]; const int tj = bi[j];
                    bv[j] = gt ? x : tf; bi[j] = gt ? xi : tj;
                    x = gt ? tf : x; xi = gt ? tj : xi;
                }
            }
        float e[16], sum = 0.f;
#pragma unroll
        for (int j = 0; j < 16; ++j) { e[j] = expf(bv[j] - bv[0]); sum += e[j]; }
        const float inv = 1.0f / sum;
        const size_t o = (size_t)(tg * 32 + tk) * 128 + h * 16;
#pragma unroll
        for (int j = 0; j < 16; ++j) { EXP[o + j] = bi[j]; GATE[o + j] = e[j] * inv; }
    }
}

__global__ void __launch_bounds__(256) peer_expert(const float* __restrict__ X, const int* __restrict__ EXP, const float* __restrict__ GATE,
                                                   const float* __restrict__ U, const float* __restrict__ V,
                                                   const float* __restrict__ g, const float* __restrict__ bta, float* __restrict__ out) {
    const int t = blockIdx.x, tid = threadIdx.x, lane = tid & 63, wid = tid >> 6;
    __shared__ float accs[4][1024];
    __shared__ float sred[4];
    const float4* xr = (const float4*)(X + (size_t)t * D);
    float4 xv[4];
#pragma unroll
    for (int j = 0; j < 4; ++j) xv[j] = xr[lane + 64 * j];
    float4 acc[4];
#pragma unroll
    for (int j = 0; j < 4; ++j) acc[j] = make_float4(0.f, 0.f, 0.f, 0.f);
    for (int e = 0; e < 32; ++e) {
        const int id = EXP[(size_t)t * 128 + wid * 32 + e];
        const float gt = GATE[(size_t)t * 128 + wid * 32 + e];
        const float4* ur = (const float4*)(U + (size_t)id * D);
        const float4* vr = (const float4*)(V + (size_t)id * D);
        float4 uv[4], vv[4];
#pragma unroll
        for (int j = 0; j < 4; ++j) { uv[j] = ur[lane + 64 * j]; vv[j] = vr[lane + 64 * j]; }
        float dot = 0.f;
#pragma unroll
        for (int j = 0; j < 4; ++j) dot += uv[j].x * xv[j].x + uv[j].y * xv[j].y + uv[j].z * xv[j].z + uv[j].w * xv[j].w;
        dot = wave_sum(dot);
        const float cf = gt * geluf_(dot);
#pragma unroll
        for (int j = 0; j < 4; ++j) { acc[j].x += cf * vv[j].x; acc[j].y += cf * vv[j].y; acc[j].z += cf * vv[j].z; acc[j].w += cf * vv[j].w; }
    }
#pragma unroll
    for (int j = 0; j < 4; ++j) *(float4*)&accs[wid][(lane + 64 * j) * 4] = acc[j];
    __syncthreads();
    float v[4];
#pragma unroll
    for (int i = 0; i < 4; ++i) {
        const int c = tid * 4 + i;
        v[i] = ALPHA * X[(size_t)t * D + c] + (accs[0][c] + accs[1][c] + accs[2][c] + accs[3][c]);
    }
    block_ln_store(v, g, bta, out + (size_t)t * D, tid, sred);
}

__device__ __forceinline__ int t5_bucket(int n) {
    if (n < 16) return n;
    const int large = 16 + (int)(logf((float)n / 16.0f) / 2.0794415416798357f * 16.0f);
    return large < 31 ? large : 31;
}
__global__ void __launch_bounds__(256) swa_attn(const float* __restrict__ PC, const float* __restrict__ cache_k, const float* __restrict__ cache_v,
                                                const float* __restrict__ rel_bias, const float* __restrict__ sinks, float* __restrict__ ATT) {
    const int tid = threadIdx.x, lane = tid & 63, wid = tid >> 6;
    const int gw = blockIdx.x * 4 + wid;
    const int t = gw >> 4, h = gw & 15, kvh = h >> 2;
    if (t >= NT) return;
    const bool samp = t >= NP; const int sb = t - NP, pos = t % SEQ;
    const float* qrow = PC + (size_t)t * CN + h * 64;
    float lg[2]; bool valid[2];
#pragma unroll
    for (int rr = 0; rr < 2; ++rr) {
        const int r = lane + 64 * rr;
        const float* krow;
        if (!samp) { valid[rr] = (pos - r) >= 0; krow = PC + (size_t)(valid[rr] ? t - r : t) * CN + 1024 + kvh * 64; }
        else { valid[rr] = true; krow = (r == 0) ? PC + (size_t)t * CN + 1024 + kvh * 64 : cache_k + (((size_t)sb * 128 + (128 - r)) * 4 + kvh) * 64; }
        float dot = 0.f;
#pragma unroll
        for (int d4 = 0; d4 < 16; ++d4) {
            const float4 kv = *(const float4*)(krow + d4 * 4);
            const float4 qv = *(const float4*)(qrow + d4 * 4);
            dot += qv.x * kv.x + qv.y * kv.y + qv.z * kv.z + qv.w * kv.w;
        }
        lg[rr] = valid[rr] ? dot * 0.125f + rel_bias[t5_bucket(r) * 16 + h] : -INFINITY;
    }
    const float sink = sinks[h];
    const float m = fmaxf(wave_max(fmaxf(lg[0], lg[1])), sink);
    float p[2];
#pragma unroll
    for (int rr = 0; rr < 2; ++rr) p[rr] = valid[rr] ? expf(lg[rr] - m) : 0.f;
    const float den = wave_sum(p[0] + p[1]) + expf(sink - m);
    const float inv = 1.0f / den;
    float o = 0.f;
#pragma unroll
    for (int rr = 0; rr < 2; ++rr)
        for (int l2 = 0; l2 < 64; ++l2) {
            const int r = l2 + 64 * rr;
            const float pj = __shfl(p[rr], l2);
            if (pj != 0.f) {
                const float* vrow;
                if (!samp) vrow = PC + (size_t)(t - r) * CN + 1280 + kvh * 64;
                else vrow = (r == 0) ? PC + (size_t)t * CN + 1280 + kvh * 64 : cache_v + (((size_t)sb * 128 + (128 - r)) * 4 + kvh) * 64;
                o += pj * vrow[lane];
            }
        }
    ATT[(size_t)t * D + h * 64 + lane] = o * inv;
}

__global__ void __launch_bounds__(256) swa_kv_out(const float* __restrict__ PC, const float* __restrict__ cache_k, const float* __restrict__ cache_v,
                                                  float* __restrict__ pk, float* __restrict__ pv, float* __restrict__ sk, float* __restrict__ sv) {
    const int row = blockIdx.x, c = threadIdx.x;
    if (row < NB * 128) {
        const int b = row >> 7, i = row & 127;
        const float* src = PC + (size_t)(b * SEQ + SEQ - 128 + i) * CN;
        pk[(size_t)row * 256 + c] = src[1024 + c];
        pv[(size_t)row * 256 + c] = src[1280 + c];
    } else {
        const int r2 = row - NB * 128, sb = r2 >> 7, i = r2 & 127;
        if (i < 127) {
            sk[(size_t)r2 * 256 + c] = cache_k[((size_t)sb * 128 + i + 1) * 256 + c];
            sv[(size_t)r2 * 256 + c] = cache_v[((size_t)sb * 128 + i + 1) * 256 + c];
        } else {
            const float* src = PC + (size_t)(NP + sb) * CN;
            sk[(size_t)r2 * 256 + c] = src[1024 + c];
            sv[(size_t)r2 * 256 + c] = src[1280 + c];
        }
    }
}

inline void gemm(const float* A, const float* W, const float* bias, float* C, int M, int N, int K, int ldc, hipStream_t s) {
    dim3 grid((N + 63) / 64, (M + 63) / 64);
    gemm_f32<<<grid, 256, 0, s>>>(A, W, bias, C, M, N, K, ldc);
}
}

extern "C" void kernel_launch(void* const* d_in, const int* in_sizes, int n_in,
                              void* d_out, int out_size, void* d_ws, size_t ws_size,
                              hipStream_t stream) {
    const float* x_prompt = (const float*)d_in[0];
    const float* x_sample = (const float*)d_in[1];
    const float* state_gdn = (const float*)d_in[2];
    const float* state_gdn_conv = (const float*)d_in[3];
    const float* state_lru = (const float*)d_in[4];
    const float* state_lru_conv = (const float*)d_in[5];
    const float* cache_k = (const float*)d_in[6];
    const float* cache_v = (const float*)d_in[7];
    const float* w_in_ab = (const float*)d_in[8];
    const float* gdn_conv_w = (const float*)d_in[9];
    const float* gdn_a_log = (const float*)d_in[10];
    const float* gdn_dt_bias = (const float*)d_in[11];
    const float* gdn_norm_w = (const float*)d_in[12];
    const float* lru_conv_w = (const float*)d_in[13];
    const float* lru_conv_b = (const float*)d_in[14];
    const float* lru_w_r = (const float*)d_in[15];
    const float* lru_b_r = (const float*)d_in[16];
    const float* lru_w_i = (const float*)d_in[17];
    const float* lru_b_i = (const float*)d_in[18];
    const float* lru_lam = (const float*)d_in[19];
    const float* w_out_ab = (const float*)d_in[20];
    const float* w_in_c = (const float*)d_in[21];
    const float* b_in_c = (const float*)d_in[22];
    const float* swa_sinks = (const float*)d_in[23];
    const float* w_out_c = (const float*)d_in[24];
    const float* b_out_c = (const float*)d_in[25];
    const float* rel_bias = (const float*)d_in[26];
    const float* ln_mix_g = (const float*)d_in[27];
    const float* ln_mix_b = (const float*)d_in[28];
    const float* ln_ffn_g = (const float*)d_in[29];
    const float* ln_ffn_b = (const float*)d_in[30];
    const float* peer_w_q = (const float*)d_in[31];
    const float* peer_keys = (const float*)d_in[32];
    const float* peer_u = (const float*)d_in[33];
    const float* peer_v = (const float*)d_in[34];

    float* out = (float*)d_out;
    float* o_y = out;
    float* o_p_gdn = out + (size_t)NT * D;
    float* o_p_gdn_conv = o_p_gdn + 262144;
    float* o_p_lru = o_p_gdn_conv + 18432;
    float* o_p_lru_conv = o_p_lru + 2048;
    float* o_p_k = o_p_lru_conv + 6144;
    float* o_p_v = o_p_k + 131072;
    float* o_s_gdn = o_p_v + 131072;
    float* o_s_gdn_conv = o_s_gdn + 8388608;
    float* o_s_lru = o_s_gdn_conv + 589824;
    float* o_s_lru_conv = o_s_lru + 65536;
    float* o_s_k = o_s_lru_conv + 196608;
    float* o_s_v = o_s_k + 4194304;

    float* ws = (float*)d_ws;
    float* R_P = ws;
    float* R_Q = R_P + (size_t)MP * ABN;
    float* R_A = R_Q + (size_t)MP * 1536;
    float* R_B = R_A + (size_t)MP * 512;
    float* R_O = R_B + (size_t)MP * 512;
    float* R_X1 = R_O + (size_t)MP * 512;
    float* R_G = R_X1 + (size_t)MP * D;
    float* R_BETA = R_G + (size_t)MP * 4;
    float* R_GATE = R_BETA + (size_t)MP * 4;
    int* R_EXP = (int*)(R_GATE + (size_t)MP * 128);

    float* PROJ = R_P;
    gemm(x_prompt, w_in_ab, nullptr, PROJ, NP, ABN, D, ABN, stream);
    gemm(x_sample, w_in_ab, nullptr, PROJ + (size_t)NP * ABN, NS, ABN, D, ABN, stream);
    AbPrepArgs pa{};
    pa.PROJ = PROJ; pa.st_gdn_conv = state_gdn_conv; pa.st_lru_conv = state_lru_conv;
    pa.gdn_conv_w = gdn_conv_w; pa.a_log = gdn_a_log; pa.dt_bias = gdn_dt_bias;
    pa.lru_conv_w = lru_conv_w; pa.lru_conv_b = lru_conv_b; pa.w_r = lru_w_r; pa.b_r = lru_b_r; pa.w_i = lru_w_i; pa.b_i = lru_b_i; pa.lam = lru_lam;
    pa.QKV = R_Q; pa.G = R_G; pa.BETA = R_BETA; pa.LA = R_A; pa.LB = R_B;
    pa.p_gdn_conv = o_p_gdn_conv; pa.p_lru_conv = o_p_lru_conv; pa.s_gdn_conv = o_s_gdn_conv; pa.s_lru_conv = o_s_lru_conv;
    ab_prep<<<NT, 256, 0, stream>>>(pa);
    gdn_scan<<<dim3(4, 4, NB), 256, 0, stream>>>(R_Q, R_G, R_BETA, nullptr, R_O, o_p_gdn, 0, SEQ);
    gdn_scan<<<dim3(4, 4, NS), 256, 0, stream>>>(R_Q, R_G, R_BETA, state_gdn, R_O, o_s_gdn, NP, 1);
    lru_scan<<<(NB * 512 + 255) / 256, 256, 0, stream>>>(R_A, R_B, nullptr, o_p_lru, 0, SEQ, NB);
    lru_scan<<<(NS * 512 + 255) / 256, 256, 0, stream>>>(R_A, R_B, state_lru, o_s_lru, NP, 1, NS);
    float* MIX = R_Q;
    ab_mix<<<NT, 256, 0, stream>>>(PROJ, R_O, R_B, gdn_norm_w, MIX);
    float* Y = R_P;
    gemm(MIX, w_out_ab, nullptr, Y, NT, D, D, D, stream);
    ln_res<<<NT, 256, 0, stream>>>(x_prompt, x_sample, Y, ln_mix_g, ln_mix_b, R_X1);
    float* Qb = R_P;
    gemm(R_X1, peer_w_q, nullptr, Qb, NT, 2048, D, 2048, stream);
    peer_topk<<<dim3(NT / 32, 8), 256, 0, stream>>>(Qb, peer_keys, R_EXP, R_GATE);
    float* X2 = R_Q;
    peer_expert<<<NT, 256, 0, stream>>>(R_X1, R_EXP, R_GATE, peer_u, peer_v, ln_ffn_g, ln_ffn_b, X2);

    float* PC = R_P;
    float* ATT = R_P + (size_t)MP * CN;
    gemm(X2, w_in_c, b_in_c, PC, NT, CN, D, CN, stream);
    swa_attn<<<(NT * 16 + 3) / 4, 256, 0, stream>>>(PC, cache_k, cache_v, rel_bias, swa_sinks, ATT);
    swa_kv_out<<<NB * 128 + NS * 128, 256, 0, stream>>>(PC, cache_k, cache_v, o_p_k, o_p_v, o_s_k, o_s_v);
    float* Y1 = R_A;
    gemm(ATT, w_out_c, b_out_c, Y1, NT, D, D, D, stream);
    float* X3 = R_X1;
    ln_res<<<NT, 256, 0, stream>>>(X2, X2 + (size_t)NP * D, Y1, ln_mix_g + D, ln_mix_b + D, X3);
    gemm(X3, peer_w_q + (size_t)D * 2048, nullptr, Qb, NT, 2048, D, 2048, stream);
    peer_topk<<<dim3(NT / 32, 8), 256, 0, stream>>>(Qb, peer_keys + (size_t)8 * 2 * 128 * 128, R_EXP, R_GATE);
    peer_expert<<<NT, 256, 0, stream>>>(X3, R_EXP, R_GATE, peer_u + (size_t)16384 * D, peer_v + (size_t)16384 * D, ln_ffn_g + D, ln_ffn_b + D, o_y);
}
```

```cpp
#include <hip/hip_runtime.h>
#include <hip/hip_cooperative_groups.h>
#include <cstdio>
#include <cstdint>
namespace cg = cooperative_groups;

namespace {
constexpr int D = 1024, NB = 4, SEQ = 4096, NP = NB * SEQ, NS = 128, NT = NP + NS, MP = 16640;
constexpr int ABN = 3080;
constexpr int C_QKV = 0, C_Z = 1536, C_A = 2048, C_B = 2052, C_XR = 2056, C_GATE = 2568;
constexpr int CN = 1536;
constexpr float ALPHA = 1.4142135623730951f;
constexpr float LN_EPS = 1e-5f;

__device__ __forceinline__ float sigmoidf_(float x) { return 1.0f / (1.0f + expf(-x)); }
__device__ __forceinline__ float softplusf_(float x) { return fmaxf(x, 0.f) + log1pf(expf(-fabsf(x))); }
__device__ __forceinline__ float siluf_(float x) { return x / (1.0f + expf(-x)); }
__device__ __forceinline__ float geluf_(float x) { return 0.5f * x * (1.0f + tanhf(0.7978845608028654f * (x + 0.044715f * x * x * x))); }
__device__ __forceinline__ float wave_sum(float v) {
#pragma unroll
    for (int o = 32; o > 0; o >>= 1) v += __shfl_xor(v, o);
    return v;
}
__device__ __forceinline__ float wave_max(float v) {
#pragma unroll
    for (int o = 32; o > 0; o >>= 1) v = fmaxf(v, __shfl_xor(v, o));
    return v;
}

__device__ __forceinline__ void gemm_f32(const float* __restrict__ A, const float* __restrict__ W, const float* __restrict__ bias,
                                                float* __restrict__ C, int M, int N, int K, int ldc, int bx, int by, float* smem) {
    float (*As)[68] = (float (*)[68])smem;
    float (*Ws)[68] = (float (*)[68])(smem + 16 * 68);
    const int tid = threadIdx.x, bm = by * 64, bn = bx * 64, tx = tid % 16, ty = tid / 16;
    float acc[4][4];
#pragma unroll
    for (int i = 0; i < 4; ++i)
#pragma unroll
        for (int j = 0; j < 4; ++j) acc[i][j] = 0.f;
    for (int k0 = 0; k0 < K; k0 += 16) {
        {
            const int r = tid / 4, c = (tid % 4) * 4;
            float4 v = make_float4(0.f, 0.f, 0.f, 0.f);
            if (bm + r < M) v = *(const float4*)(A + (size_t)(bm + r) * K + k0 + c);
            As[c + 0][r] = v.x; As[c + 1][r] = v.y; As[c + 2][r] = v.z; As[c + 3][r] = v.w;
        }
        {
            const int r = tid / 16, c = (tid % 16) * 4;
            float4 v = make_float4(0.f, 0.f, 0.f, 0.f);
            if (bn + c < N) v = *(const float4*)(W + (size_t)(k0 + r) * N + bn + c);
            *(float4*)&Ws[r][c] = v;
        }
        __syncthreads();
#pragma unroll
        for (int k = 0; k < 16; ++k) {
            const float4 a = *(const float4*)&As[k][ty * 4];
            const float4 b = *(const float4*)&Ws[k][tx * 4];
            const float av[4] = {a.x, a.y, a.z, a.w}, bv[4] = {b.x, b.y, b.z, b.w};
#pragma unroll
            for (int i = 0; i < 4; ++i)
#pragma unroll
                for (int j = 0; j < 4; ++j) acc[i][j] += av[i] * bv[j];
        }
        __syncthreads();
    }
#pragma unroll
    for (int i = 0; i < 4; ++i) {
        const int row = bm + ty * 4 + i;
        if (row >= M) continue;
#pragma unroll
        for (int j = 0; j < 4; ++j) {
            const int col = bn + tx * 4 + j;
            if (col < N) C[(size_t)row * ldc + col] = acc[i][j] + (bias ? bias[col] : 0.f);
        }
    }
}

struct AbPrepArgs {
    const float* PROJ; const float* st_gdn_conv; const float* st_lru_conv;
    const float* gdn_conv_w; const float* a_log; const float* dt_bias;
    const float* lru_conv_w; const float* lru_conv_b; const float* w_r; const float* b_r; const float* w_i; const float* b_i; const float* lam;
    float* QKV; float* G; float* BETA; float* LA; float* LB;
    float* p_gdn_conv; float* p_lru_conv; float* s_gdn_conv; float* s_lru_conv;
};
__device__ __forceinline__ void ab_prep(const AbPrepArgs& a, int t, float* smem) {
    const int tid = threadIdx.x, lane = tid & 63, wid = tid >> 6;
    const bool samp = t >= NP; const int sb = t - NP, pos = t % SEQ, b = t / SEQ;
    float* sq = smem;
    float* sx = smem + 1536;
    float* scl = smem + 2048;
    const float* prow = a.PROJ + (size_t)t * ABN;
    for (int c = tid; c < 1536; c += 256) {
        float acc = 0.f;
#pragma unroll
        for (int i = 0; i < 4; ++i) {
            float xv;
            if (i == 3) xv = prow[C_QKV + c];
            else if (samp) xv = a.st_gdn_conv[((size_t)sb * 3 + i) * 1536 + c];
            else xv = (pos - 3 + i >= 0) ? a.PROJ[(size_t)(t - 3 + i) * ABN + C_QKV + c] : 0.f;
            acc += a.gdn_conv_w[i * 1536 + c] * xv;
        }
        sq[c] = siluf_(acc);
    }
    for (int c = tid; c < 512; c += 256) {
        float acc = a.lru_conv_b[c];
#pragma unroll
        for (int i = 0; i < 4; ++i) {
            float xv;
            if (i == 3) xv = prow[C_XR + c];
            else if (samp) xv = a.st_lru_conv[((size_t)sb * 3 + i) * 512 + c];
            else xv = (pos - 3 + i >= 0) ? a.PROJ[(size_t)(t - 3 + i) * ABN + C_XR + c] : 0.f;
            acc += a.lru_conv_w[i * 512 + c] * xv;
        }
        sx[c] = acc;
    }
    __syncthreads();
#pragma unroll
    for (int gi = 0; gi < 2; ++gi) {
        const int grp = wid * 2 + gi;
        const float v0 = sq[grp * 128 + lane], v1 = sq[grp * 128 + 64 + lane];
        const float s = wave_sum(v0 * v0 + v1 * v1);
        if (lane == 0) scl[grp] = rsqrtf(s + 1e-6f) * (grp < 4 ? 0.08838834764831845f : 1.0f);
    }
    __syncthreads();
    for (int c = tid; c < 1536; c += 256) a.QKV[(size_t)t * 1536 + c] = (c < 1024) ? sq[c] * scl[c >> 7] : sq[c];
    if (tid < 4) {
        const float a_raw = prow[C_A + tid], b_raw = prow[C_B + tid];
        a.G[(size_t)t * 4 + tid] = -expf(a.a_log[tid]) * softplusf_(a_raw + a.dt_bias[tid]);
        a.BETA[(size_t)t * 4 + tid] = sigmoidf_(b_raw);
    }
    if (!samp) {
        if (pos >= SEQ - 3) {
            const int row = pos - (SEQ - 3);
            for (int c = tid; c < 1536; c += 256) a.p_gdn_conv[((size_t)b * 3 + row) * 1536 + c] = prow[C_QKV + c];
            for (int c = tid; c < 512; c += 256) a.p_lru_conv[((size_t)b * 3 + row) * 512 + c] = prow[C_XR + c];
        }
    } else {
        for (int c = tid; c < 1536; c += 256) {
            a.s_gdn_conv[((size_t)sb * 3 + 0) * 1536 + c] = a.st_gdn_conv[((size_t)sb * 3 + 1) * 1536 + c];
            a.s_gdn_conv[((size_t)sb * 3 + 1) * 1536 + c] = a.st_gdn_conv[((size_t)sb * 3 + 2) * 1536 + c];
            a.s_gdn_conv[((size_t)sb * 3 + 2) * 1536 + c] = prow[C_QKV + c];
        }
        for (int c = tid; c < 512; c += 256) {
            a.s_lru_conv[((size_t)sb * 3 + 0) * 512 + c] = a.st_lru_conv[((size_t)sb * 3 + 1) * 512 + c];
            a.s_lru_conv[((size_t)sb * 3 + 1) * 512 + c] = a.st_lru_conv[((size_t)sb * 3 + 2) * 512 + c];
            a.s_lru_conv[((size_t)sb * 3 + 2) * 512 + c] = prow[C_XR + c];
        }
    }
    for (int c = tid; c < 512; c += 256) {
        const int n = c >> 6, d = c & 63;
        float r = a.b_r[c], ii = a.b_i[c];
        for (int cc = 0; cc < 64; ++cc) {
            const float xv = sx[n * 64 + cc];
            r += xv * a.w_r[((size_t)n * 64 + cc) * 64 + d];
            ii += xv * a.w_i[((size_t)n * 64 + cc) * 64 + d];
        }
        r = sigmoidf_(r); ii = sigmoidf_(ii);
        const float log_a = -8.0f * r * softplusf_(-a.lam[c]);
        a.LA[(size_t)t * 512 + c] = expf(log_a);
        a.LB[(size_t)t * 512 + c] = sqrtf(-expm1f(2.0f * log_a)) * (ii * sx[c]);
    }
}

__device__ __forceinline__ void gdn_scan(const float* __restrict__ QKV, const float* __restrict__ G, const float* __restrict__ BETA,
                                                const float* __restrict__ S0, float* __restrict__ O, float* __restrict__ Sout, int tok_base, int T,
                                                int sl, int h, int sq, float* smem) {
    const int tid = threadIdx.x, dvl = tid & 31, kg = tid >> 5;
    const int dv = sl * 32 + dvl;
    float (*red1)[32] = (float (*)[32])smem;
    float (*red2)[32] = (float (*)[32])(smem + 256);
    float S[16];
#pragma unroll
    for (int i = 0; i < 16; ++i) S[i] = S0 ? S0[(((size_t)sq * 4 + h) * 128 + kg * 16 + i) * 128 + dv] : 0.f;
    float kk[16], qq[16], vv, g, be;
    {
        const size_t tok = (size_t)tok_base + (size_t)sq * T;
        const float* row = QKV + tok * 1536;
#pragma unroll
        for (int i = 0; i < 16; ++i) { kk[i] = row[512 + h * 128 + kg * 16 + i]; qq[i] = row[h * 128 + kg * 16 + i]; }
        vv = row[1024 + h * 128 + dv]; g = G[tok * 4 + h]; be = BETA[tok * 4 + h];
    }
    for (int t = 0; t < T; ++t) {
        const size_t tok = (size_t)tok_base + (size_t)sq * T + t;
        float nk[16], nq[16], nv = 0.f, ng = 0.f, nb = 0.f;
        if (t + 1 < T) {
            const float* row = QKV + (tok + 1) * 1536;
#pragma unroll
            for (int i = 0; i < 16; ++i) { nk[i] = row[512 + h * 128 + kg * 16 + i]; nq[i] = row[h * 128 + kg * 16 + i]; }
            nv = row[1024 + h * 128 + dv]; ng = G[(tok + 1) * 4 + h]; nb = BETA[(tok + 1) * 4 + h];
        } else {
#pragma unroll
            for (int i = 0; i < 16; ++i) { nk[i] = 0.f; nq[i] = 0.f; }
        }
        const float al = expf(g);
        float p = 0.f;
#pragma unroll
        for (int i = 0; i < 16; ++i) { S[i] *= al; p += S[i] * kk[i]; }
        red1[kg][dvl] = p;
        __syncthreads();
        float ks = 0.f;
#pragma unroll
        for (int j = 0; j < 8; ++j) ks += red1[j][dvl];
        const float vn = be * (vv - ks);
        float o = 0.f;
#pragma unroll
        for (int i = 0; i < 16; ++i) { S[i] += kk[i] * vn; o += S[i] * qq[i]; }
        red2[kg][dvl] = o;
        __syncthreads();
        if (kg == 0) {
            float os = 0.f;
#pragma unroll
            for (int j = 0; j < 8; ++j) os += red2[j][dvl];
            O[tok * 512 + h * 128 + dv] = os;
        }
#pragma unroll
        for (int i = 0; i < 16; ++i) { kk[i] = nk[i]; qq[i] = nq[i]; }
        vv = nv; g = ng; be = nb;
    }
#pragma unroll
    for (int i = 0; i < 16; ++i) Sout[(((size_t)sq * 4 + h) * 128 + kg * 16 + i) * 128 + dv] = S[i];
}

__device__ __forceinline__ void lru_scan(const float* __restrict__ LA, float* __restrict__ LB, const float* __restrict__ h0,
                                                float* __restrict__ hlast, int tok_base, int T, int nseq, int bx) {
    const int idx = bx * 256 + threadIdx.x;
    if (idx >= nseq * 512) return;
    const int sq = idx / 512, c = idx % 512;
    float h = h0 ? h0[(size_t)sq * 512 + c] : 0.f;
    const size_t base = ((size_t)tok_base + (size_t)sq * T) * 512 + c;
#pragma unroll 8
    for (int t = 0; t < T; ++t) {
        const size_t o = base + (size_t)t * 512;
        h = LA[o] * h + LB[o];
        LB[o] = h;
    }
    hlast[(size_t)sq * 512 + c] = h;
}

__device__ __forceinline__ void ab_mix(const float* __restrict__ PROJ, const float* __restrict__ O, const float* __restrict__ H,
                                              const float* __restrict__ norm_w, float* __restrict__ MIX, int t) {
    const int tid = threadIdx.x, lane = tid & 63, wid = tid >> 6;
    const float* prow = PROJ + (size_t)t * ABN;
    {
        const int h = wid;
        const float o0 = O[(size_t)t * 512 + h * 128 + lane], o1 = O[(size_t)t * 512 + h * 128 + 64 + lane];
        const float ms = wave_sum(o0 * o0 + o1 * o1) * (1.0f / 128.0f);
        const float sc = rsqrtf(ms + 1e-6f);
        MIX[(size_t)t * 1024 + h * 128 + lane] = o0 * sc * norm_w[lane] * siluf_(prow[C_Z + h * 128 + lane]);
        MIX[(size_t)t * 1024 + h * 128 + 64 + lane] = o1 * sc * norm_w[64 + lane] * siluf_(prow[C_Z + h * 128 + 64 + lane]);
    }
    for (int c = tid; c < 512; c += 256) MIX[(size_t)t * 1024 + 512 + c] = geluf_(prow[C_GATE + c]) * H[(size_t)t * 512 + c];
}

__device__ __forceinline__ void block_ln_store(float v[4], const float* __restrict__ g, const float* __restrict__ bta, float* __restrict__ out, int tid, float* sred) {
    const int lane = tid & 63, wid = tid >> 6;
    float s = wave_sum(v[0] + v[1] + v[2] + v[3]);
    if (lane == 0) sred[wid] = s;
    __syncthreads();
    const float mean = (sred[0] + sred[1] + sred[2] + sred[3]) * (1.0f / 1024.0f);
    __syncthreads();
    float d[4], q = 0.f;
#pragma unroll
    for (int i = 0; i < 4; ++i) { d[i] = v[i] - mean; q += d[i] * d[i]; }
    q = wave_sum(q);
    if (lane == 0) sred[wid] = q;
    __syncthreads();
    const float var = (sred[0] + sred[1] + sred[2] + sred[3]) * (1.0f / 1024.0f);
    const float rs = rsqrtf(var + LN_EPS);
#pragma unroll
    for (int i = 0; i < 4; ++i) out[tid * 4 + i] = d[i] * rs * g[tid * 4 + i] + bta[tid * 4 + i];
}

__device__ __forceinline__ void ln_res(const float* __restrict__ xa, const float* __restrict__ xb, const float* __restrict__ Y,
                                              const float* __restrict__ g, const float* __restrict__ bta, float* __restrict__ out, int t, float* smem) {
    const int tid = threadIdx.x;
    float* sred = smem;
    const float* xr = (t < NP) ? xa + (size_t)t * D : xb + (size_t)(t - NP) * D;
    float v[4];
#pragma unroll
    for (int i = 0; i < 4; ++i) v[i] = ALPHA * xr[tid * 4 + i] + Y[(size_t)t * D + tid * 4 + i];
    block_ln_store(v, g, bta, out + (size_t)t * D, tid, sred);
}

__device__ __forceinline__ void peer_topk(const float* __restrict__ Q, const float* __restrict__ keys, int* __restrict__ EXP, float* __restrict__ GATE,
                                          int tg, int h, float* smem) {
    const int tid = threadIdx.x, c = tid >> 7, n = tid & 127;
    float (*sq)[256] = (float (*)[256])smem;
    float (*ss)[257] = (float (*)[257])(smem + 32 * 256);
    float (*tvs)[2][16] = (float (*)[2][16])(smem + 32 * 256 + 32 * 257 + 32);
    int (*tis)[2][16] = (int (*)[2][16])(smem + 32 * 256 + 32 * 257 + 32 + 1024);
    for (int i = tid; i < 32 * 256; i += 256) {
        const int tk = i >> 8, col = i & 255;
        sq[tk][col] = Q[(size_t)(tg * 32 + tk) * 2048 + h * 256 + col];
    }
    __syncthreads();
    float acc[32];
#pragma unroll
    for (int i = 0; i < 32; ++i) acc[i] = 0.f;
    const float* krow = keys + (((size_t)h * 2 + c) * 128 + n) * 128;
    for (int d4 = 0; d4 < 32; ++d4) {
        const float4 kv = *(const float4*)(krow + d4 * 4);
#pragma unroll
        for (int tk = 0; tk < 32; ++tk) {
            const float4 qv = *(const float4*)&sq[tk][c * 128 + d4 * 4];
            acc[tk] += qv.x * kv.x + qv.y * kv.y + qv.z * kv.z + qv.w * kv.w;
        }
    }
#pragma unroll
    for (int tk = 0; tk < 32; ++tk) ss[tk][tid] = acc[tk];
    __syncthreads();
    if (tid < 64) {
        const int tk = tid >> 1, cc = tid & 1;
        float tv[16]; int ti[16];
#pragma unroll
        for (int j = 0; j < 16; ++j) { tv[j] = -INFINITY; ti[j] = 0; }
        for (int nn = 0; nn < 128; ++nn) {
            float x = ss[tk][cc * 128 + nn]; int xi = nn;
#pragma unroll
            for (int j = 0; j < 16; ++j) {
                const bool gt = x > tv[j];
                const float tf = tv[j]; const int tj = ti[j];
                tv[j] = gt ? x : tf; ti[j] = gt ? xi : tj;
                x = gt ? tf : x; xi = gt ? tj : xi;
            }
        }
#pragma unroll
        for (int j = 0; j < 16; ++j) { tvs[tk][cc][j] = tv[j]; tis[tk][cc][j] = ti[j]; }
    }
    __syncthreads();
    if (tid < 32) {
        const int tk = tid;
        float bv[16]; int bi[16];
#pragma unroll
        for (int j = 0; j < 16; ++j) { bv[j] = -INFINITY; bi[j] = 0; }
        for (int i = 0; i < 16; ++i)
            for (int jj = 0; jj < 16; ++jj) {
                float x = tvs[tk][0][i] + tvs[tk][1][jj]; int xi = tis[tk][0][i] * 128 + tis[tk][1][jj];
#pragma unroll
                for (int j = 0; j < 16; ++j) {
                    const bool gt = x > bv[j];
                    const float tf = bv[j]; const int tj = bi[j];
                    bv[j] = gt ? x : tf; bi[j] = gt ? xi : tj;
                    x = gt ? tf : x; xi = gt ? tj : xi;
                }
            }
        float e[16], sum = 0.f;
#pragma unroll
        for (int j = 0; j < 16; ++j) { e[j] = expf(bv[j] - bv[0]); sum += e[j]; }
        const float inv = 1.0f / sum;
        const size_t o = (size_t)(tg * 32 + tk) * 128 + h * 16;
#pragma unroll
        for (int j = 0; j < 16; ++j) { EXP[o + j] = bi[j]; GATE[o + j] = e[j] * inv; }
    }
}

__device__ __forceinline__ void peer_expert(const float* __restrict__ X, const int* __restrict__ EXP, const float* __restrict__ GATE,
                                                   const float* __restrict__ U, const float* __restrict__ V,
                                                   const float* __restrict__ g, const float* __restrict__ bta, float* __restrict__ out, int t, float* smem) {
    const int tid = threadIdx.x, lane = tid & 63, wid = tid >> 6;
    float (*accs)[1024] = (float (*)[1024])smem;
    float* sred = smem + 4096;
    const float4* xr = (const float4*)(X + (size_t)t * D);
    float4 xv[4];
#pragma unroll
    for (int j = 0; j < 4; ++j) xv[j] = xr[lane + 64 * j];
    float4 acc[4];
#pragma unroll
    for (int j = 0; j < 4; ++j) acc[j] = make_float4(0.f, 0.f, 0.f, 0.f);
    for (int e = 0; e < 32; ++e) {
        const int id = EXP[(size_t)t * 128 + wid * 32 + e];
        const float gt = GATE[(size_t)t * 128 + wid * 32 + e];
        const float4* ur = (const float4*)(U + (size_t)id * D);
        const float4* vr = (const float4*)(V + (size_t)id * D);
        float4 uv[4], vv[4];
#pragma unroll
        for (int j = 0; j < 4; ++j) { uv[j] = ur[lane + 64 * j]; vv[j] = vr[lane + 64 * j]; }
        float dot = 0.f;
#pragma unroll
        for (int j = 0; j < 4; ++j) dot += uv[j].x * xv[j].x + uv[j].y * xv[j].y + uv[j].z * xv[j].z + uv[j].w * xv[j].w;
        dot = wave_sum(dot);
        const float cf = gt * geluf_(dot);
#pragma unroll
        for (int j = 0; j < 4; ++j) { acc[j].x += cf * vv[j].x; acc[j].y += cf * vv[j].y; acc[j].z += cf * vv[j].z; acc[j].w += cf * vv[j].w; }
    }
#pragma unroll
    for (int j = 0; j < 4; ++j) *(float4*)&accs[wid][(lane + 64 * j) * 4] = acc[j];
    __syncthreads();
    float v[4];
#pragma unroll
    for (int i = 0; i < 4; ++i) {
        const int c = tid * 4 + i;
        v[i] = ALPHA * X[(size_t)t * D + c] + (accs[0][c] + accs[1][c] + accs[2][c] + accs[3][c]);
    }
    block_ln_store(v, g, bta, out + (size_t)t * D, tid, sred);
}

__device__ __forceinline__ int t5_bucket(int n) {
    if (n < 16) return n;
    const int large = 16 + (int)(logf((float)n / 16.0f) / 2.0794415416798357f * 16.0f);
    return large < 31 ? large : 31;
}
__device__ __forceinline__ void swa_attn(const float* __restrict__ PC, const float* __restrict__ cache_k, const float* __restrict__ cache_v,
                                                const float* __restrict__ rel_bias, const float* __restrict__ sinks, float* __restrict__ ATT, int bx) {
    const int tid = threadIdx.x, lane = tid & 63, wid = tid >> 6;
    const int gw = bx * 4 + wid;
    const int t = gw >> 4, h = gw & 15, kvh = h >> 2;
    if (t >= NT) return;
    const bool samp = t >= NP; const int sb = t - NP, pos = t % SEQ;
    const float* qrow = PC + (size_t)t * CN + h * 64;
    float lg[2]; bool valid[2];
#pragma unroll
    for (int rr = 0; rr < 2; ++rr) {
        const int r = lane + 64 * rr;
        const float* krow;
        if (!samp) { valid[rr] = (pos - r) >= 0; krow = PC + (size_t)(valid[rr] ? t - r : t) * CN + 1024 + kvh * 64; }
        else { valid[rr] = true; krow = (r == 0) ? PC + (size_t)t * CN + 1024 + kvh * 64 : cache_k + (((size_t)sb * 128 + (128 - r)) * 4 + kvh) * 64; }
        float dot = 0.f;
#pragma unroll
        for (int d4 = 0; d4 < 16; ++d4) {
            const float4 kv = *(const float4*)(krow + d4 * 4);
            const float4 qv = *(const float4*)(qrow + d4 * 4);
            dot += qv.x * kv.x + qv.y * kv.y + qv.z * kv.z + qv.w * kv.w;
        }
        lg[rr] = valid[rr] ? dot * 0.125f + rel_bias[t5_bucket(r) * 16 + h] : -INFINITY;
    }
    const float sink = sinks[h];
    const float m = fmaxf(wave_max(fmaxf(lg[0], lg[1])), sink);
    float p[2];
#pragma unroll
    for (int rr = 0; rr < 2; ++rr) p[rr] = valid[rr] ? expf(lg[rr] - m) : 0.f;
    const float den = wave_sum(p[0] + p[1]) + expf(sink - m);
    const float inv = 1.0f / den;
    float o = 0.f;
#pragma unroll
    for (int rr = 0; rr < 2; ++rr)
        for (int l2 = 0; l2 < 64; ++l2) {
            const int r = l2 + 64 * rr;
            const float pj = __shfl(p[rr], l2);
            if (pj != 0.f) {
                const float* vrow;
                if (!samp) vrow = PC + (size_t)(t - r) * CN + 1280 + kvh * 64;
                else vrow = (r == 0) ? PC + (size_t)t * CN + 1280 + kvh * 64 : cache_v + (((size_t)sb * 128 + (128 - r)) * 4 + kvh) * 64;
                o += pj * vrow[lane];
            }
        }
    ATT[(size_t)t * D + h * 64 + lane] = o * inv;
}

__device__ __forceinline__ void swa_kv_out(const float* __restrict__ PC, const float* __restrict__ cache_k, const float* __restrict__ cache_v,
                                                  float* __restrict__ pk, float* __restrict__ pv, float* __restrict__ sk, float* __restrict__ sv, int row) {
    const int c = threadIdx.x;
    if (row < NB * 128) {
        const int b = row >> 7, i = row & 127;
        const float* src = PC + (size_t)(b * SEQ + SEQ - 128 + i) * CN;
        pk[(size_t)row * 256 + c] = src[1024 + c];
        pv[(size_t)row * 256 + c] = src[1280 + c];
    } else {
        const int r2 = row - NB * 128, sb = r2 >> 7, i = r2 & 127;
        if (i < 127) {
            sk[(size_t)r2 * 256 + c] = cache_k[((size_t)sb * 128 + i + 1) * 256 + c];
            sv[(size_t)r2 * 256 + c] = cache_v[((size_t)sb * 128 + i + 1) * 256 + c];
        } else {
            const float* src = PC + (size_t)(NP + sb) * CN;
            sk[(size_t)r2 * 256 + c] = src[1024 + c];
            sv[(size_t)r2 * 256 + c] = src[1280 + c];
        }
    }
}

struct MegaArgs {
    const float* in[35];
    float* out;
    float* ws;
};

__global__ void __launch_bounds__(256) fwd_megakernel(MegaArgs ma) {
    cg::grid_group grid = cg::this_grid();
    __shared__ __attribute__((aligned(16))) float smem[18464];
    const int nb = gridDim.x, b0 = blockIdx.x;
    const float* x_prompt = ma.in[0];
    const float* x_sample = ma.in[1];
    const float* state_gdn = ma.in[2];
    const float* state_gdn_conv = ma.in[3];
    const float* state_lru = ma.in[4];
    const float* state_lru_conv = ma.in[5];
    const float* cache_k = ma.in[6];
    const float* cache_v = ma.in[7];
    const float* w_in_ab = ma.in[8];
    const float* gdn_conv_w = ma.in[9];
    const float* gdn_a_log = ma.in[10];
    const float* gdn_dt_bias = ma.in[11];
    const float* gdn_norm_w = ma.in[12];
    const float* lru_conv_w = ma.in[13];
    const float* lru_conv_b = ma.in[14];
    const float* lru_w_r = ma.in[15];
    const float* lru_b_r = ma.in[16];
    const float* lru_w_i = ma.in[17];
    const float* lru_b_i = ma.in[18];
    const float* lru_lam = ma.in[19];
    const float* w_out_ab = ma.in[20];
    const float* w_in_c = ma.in[21];
    const float* b_in_c = ma.in[22];
    const float* swa_sinks = ma.in[23];
    const float* w_out_c = ma.in[24];
    const float* b_out_c = ma.in[25];
    const float* rel_bias = ma.in[26];
    const float* ln_mix_g = ma.in[27];
    const float* ln_mix_b = ma.in[28];
    const float* ln_ffn_g = ma.in[29];
    const float* ln_ffn_b = ma.in[30];
    const float* peer_w_q = ma.in[31];
    const float* peer_keys = ma.in[32];
    const float* peer_u = ma.in[33];
    const float* peer_v = ma.in[34];

    float* out = ma.out;
    float* o_y = out;
    float* o_p_gdn = out + (size_t)NT * D;
    float* o_p_gdn_conv = o_p_gdn + 262144;
    float* o_p_lru = o_p_gdn_conv + 18432;
    float* o_p_lru_conv = o_p_lru + 2048;
    float* o_p_k = o_p_lru_conv + 6144;
    float* o_p_v = o_p_k + 131072;
    float* o_s_gdn = o_p_v + 131072;
    float* o_s_gdn_conv = o_s_gdn + 8388608;
    float* o_s_lru = o_s_gdn_conv + 589824;
    float* o_s_lru_conv = o_s_lru + 65536;
    float* o_s_k = o_s_lru_conv + 196608;
    float* o_s_v = o_s_k + 4194304;

    float* ws = ma.ws;
    float* R_P = ws;
    float* R_Q = R_P + (size_t)MP * ABN;
    float* R_A = R_Q + (size_t)MP * 1536;
    float* R_B = R_A + (size_t)MP * 512;
    float* R_O = R_B + (size_t)MP * 512;
    float* R_X1 = R_O + (size_t)MP * 512;
    float* R_G = R_X1 + (size_t)MP * D;
    float* R_BETA = R_G + (size_t)MP * 4;
    float* R_GATE = R_BETA + (size_t)MP * 4;
    int* R_EXP = (int*)(R_GATE + (size_t)MP * 128);

#define PHASE_LOOP(n) for (int vb = b0; vb < (n); vb += nb)
#define PHASE_END __syncthreads()
    constexpr int MT = NT / 64;
    float* PROJ = R_P;
    { constexpr int NTL = (ABN + 63) / 64;
      PHASE_LOOP(MT * NTL) { const int mt = vb / NTL, nt = vb % NTL;
        const float* A = mt < NP / 64 ? x_prompt + (size_t)mt * 64 * D : x_sample + (size_t)(mt - NP / 64) * 64 * D;
        gemm_f32(A, w_in_ab, nullptr, PROJ + (size_t)mt * 64 * ABN, 64, ABN, D, ABN, nt, 0, smem); PHASE_END; } }
    grid.sync();
    { AbPrepArgs pa;
      pa.PROJ = PROJ; pa.st_gdn_conv = state_gdn_conv; pa.st_lru_conv = state_lru_conv;
      pa.gdn_conv_w = gdn_conv_w; pa.a_log = gdn_a_log; pa.dt_bias = gdn_dt_bias;
      pa.lru_conv_w = lru_conv_w; pa.lru_conv_b = lru_conv_b; pa.w_r = lru_w_r; pa.b_r = lru_b_r; pa.w_i = lru_w_i; pa.b_i = lru_b_i; pa.lam = lru_lam;
      pa.QKV = R_Q; pa.G = R_G; pa.BETA = R_BETA; pa.LA = R_A; pa.LB = R_B;
      pa.p_gdn_conv = o_p_gdn_conv; pa.p_lru_conv = o_p_lru_conv; pa.s_gdn_conv = o_s_gdn_conv; pa.s_lru_conv = o_s_lru_conv;
      PHASE_LOOP(NT) { ab_prep(pa, vb, smem); PHASE_END; } }
    grid.sync();
    PHASE_LOOP(64 + 2048 + 8 + 256) {
        if (vb < 64) gdn_scan(R_Q, R_G, R_BETA, nullptr, R_O, o_p_gdn, 0, SEQ, vb & 3, (vb >> 2) & 3, vb >> 4, smem);
        else if (vb < 64 + 2048) { const int v = vb - 64; gdn_scan(R_Q, R_G, R_BETA, state_gdn, R_O, o_s_gdn, NP, 1, v & 3, (v >> 2) & 3, v >> 4, smem); }
        else if (vb < 64 + 2048 + 8) lru_scan(R_A, R_B, nullptr, o_p_lru, 0, SEQ, NB, vb - (64 + 2048));
        else lru_scan(R_A, R_B, state_lru, o_s_lru, NP, 1, NS, vb - (64 + 2048 + 8));
        PHASE_END;
    }
    grid.sync();
    float* MIX = R_Q;
    PHASE_LOOP(NT) { ab_mix(PROJ, R_O, R_B, gdn_norm_w, MIX, vb); }
    grid.sync();
    float* Y = R_P;
    PHASE_LOOP(MT * 16) { gemm_f32(MIX, w_out_ab, nullptr, Y, NT, D, D, D, vb & 15, vb >> 4, smem); PHASE_END; }
    grid.sync();
    PHASE_LOOP(NT) { ln_res(x_prompt, x_sample, Y, ln_mix_g, ln_mix_b, R_X1, vb, smem); PHASE_END; }
    grid.sync();
    float* Qb = R_P;
    PHASE_LOOP(MT * 32) { gemm_f32(R_X1, peer_w_q, nullptr, Qb, NT, 2048, D, 2048, vb & 31, vb >> 5, smem); PHASE_END; }
    grid.sync();
    PHASE_LOOP((NT / 32) * 8) { peer_topk(Qb, peer_keys, R_EXP, R_GATE, vb >> 3, vb & 7, smem); PHASE_END; }
    grid.sync();
    float* X2 = R_Q;
    PHASE_LOOP(NT) { peer_expert(R_X1, R_EXP, R_GATE, peer_u, peer_v, ln_ffn_g, ln_ffn_b, X2, vb, smem); PHASE_END; }
    grid.sync();

    float* PC = R_P;
    float* ATT = R_P + (size_t)MP * CN;
    PHASE_LOOP(MT * 24) { gemm_f32(X2, w_in_c, b_in_c, PC, NT, CN, D, CN, vb % 24, vb / 24, smem); PHASE_END; }
    grid.sync();
    PHASE_LOOP(NT * 4 + NB * 128 + NS * 128) {
        if (vb < NT * 4) swa_attn(PC, cache_k, cache_v, rel_bias, swa_sinks, ATT, vb);
        else swa_kv_out(PC, cache_k, cache_v, o_p_k, o_p_v, o_s_k, o_s_v, vb - NT * 4);
    }
    grid.sync();
    float* Y1 = R_A;
    PHASE_LOOP(MT * 16) { gemm_f32(ATT, w_out_c, b_out_c, Y1, NT, D, D, D, vb & 15, vb >> 4, smem); PHASE_END; }
    grid.sync();
    float* X3 = R_X1;
    PHASE_LOOP(NT) { ln_res(X2, X2 + (size_t)NP * D, Y1, ln_mix_g + D, ln_mix_b + D, X3, vb, smem); PHASE_END; }
    grid.sync();
    PHASE_LOOP(MT * 32) { gemm_f32(X3, peer_w_q + (size_t)D * 2048, nullptr, Qb, NT, 2048, D, 2048, vb & 31, vb >> 5, smem); PHASE_END; }
    grid.sync();
    PHASE_LOOP((NT / 32) * 8) { peer_topk(Qb, peer_keys + (size_t)8 * 2 * 128 * 128, R_EXP, R_GATE, vb >> 3, vb & 7, smem); PHASE_END; }
    grid.sync();
    PHASE_LOOP(NT) { peer_expert(X3, R_EXP, R_GATE, peer_u + (size_t)16384 * D, peer_v + (size_t)16384 * D, ln_ffn_g + D, ln_ffn_b + D, o_y, vb, smem); PHASE_END; }
}
}

extern "C" void kernel_launch(void* const* d_in, const int* in_sizes, int n_in,
                              void* d_out, int out_size, void* d_ws, size_t ws_size,
                              hipStream_t stream) {
    static int grid_blocks = 0;
    if (!grid_blocks) {
        int dev = 0, cus = 0, per_cu = 0;
        (void)hipGetDevice(&dev);
        (void)hipDeviceGetAttribute(&cus, hipDeviceAttributeMultiprocessorCount, dev);
        (void)hipOccupancyMaxActiveBlocksPerMultiprocessor(&per_cu, fwd_megakernel, 256, 0);
        if (per_cu > 2) per_cu = 2;
        if (per_cu < 1) per_cu = 1;
        grid_blocks = cus * per_cu;
    }
    MegaArgs ma{};
    for (int i = 0; i < 35; ++i) ma.in[i] = (const float*)d_in[i];
    ma.out = (float*)d_out;
    ma.ws = (float*)d_ws;
    void* args[] = {&ma};
    hipError_t e = hipLaunchCooperativeKernel((void*)fwd_megakernel, dim3(grid_blocks), dim3(256), args, 0, stream);
    if (e != hipSuccess) fprintf(stderr, "cooperative launch failed: %s (grid %d)\n", hipGetErrorString(e), grid_blocks);
}
```

```cpp
#include <hip/hip_runtime.h>
#include <hip/hip_cooperative_groups.h>
#include <cstdio>
#include <cstdint>
namespace cg = cooperative_groups;

namespace pg8 {
#define PG8_LAS __attribute__((address_space(3)))
typedef unsigned short bf16_t;
typedef short bf16x8 __attribute__((ext_vector_type(8)));
typedef float f32x4 __attribute__((ext_vector_type(4)));
typedef unsigned u32x4 __attribute__((ext_vector_type(4)));
constexpr int BM = 256, BK = 64, HALF = 128, HTB = HALF * BK * 2  , STAGE_BYTES = 8 * HTB, NXCD = 8, WGM = 8;

__host__ __device__ __forceinline__ int lds_byte(int r, int c) { const int st = (r >> 4) * 2 + (c >> 5), rr = r & 15, cc = c & 31, ob = rr * 64 + cc * 2; return st * 1024 + (ob ^ (((ob >> 9) & 1) << 5)); }
__host__ __device__ __forceinline__ void stage_rc(int b, int& R, int& C) { const int st = b / 1024, sb = b % 1024, swz = sb ^ (((sb >> 9) & 1) << 5); R = (st >> 1) * 16 + swz / 64; C = (st & 1) * 32 + (swz % 64) / 2; }
__host__ __device__ __forceinline__ int perm32(int rho) { const int n = rho >> 4, i = rho & 15; return 8 * (i >> 2) + 4 * n + (i & 3); }

struct Unit { int pm, pn; };
struct Gemm { const bf16_t* A; const bf16_t* Bt; int M, N, K; };

struct StaticOrder {
    int nM, nN, nwg, G, c;
    __host__ __device__ void init(int M, int N, int G_, int c_) { nM = M / BM; nN = N / BM; nwg = nM * nN; G = G_; c = c_; }
    __host__ __device__ bool next(int i, Unit& u) const {
        const long L = (long)i * G + c; if (L >= nwg) return false;
        int wgid = (int)L; { const int q = nwg / NXCD, r = nwg % NXCD, xcd = wgid % NXCD, off = wgid / NXCD; wgid = (xcd < r ? xcd * (q + 1) : r * (q + 1) + (xcd - r) * q) + off; }
        const int nig = WGM * nN, gid = wgid / nig, fm = gid * WGM, gsz = (nM - fm) < WGM ? (nM - fm) : WGM;
        u.pm = fm + ((wgid % nig) % gsz); u.pn = (wgid % nig) / gsz; return true;
    }
    __device__ __forceinline__ void a_ready(const Unit&) const {}
    __device__ __forceinline__ void done(const Unit&) const {}
};

__device__ __forceinline__ unsigned cvt_pk_bf16(float lo, float hi) { unsigned r; asm volatile("v_cvt_pk_bf16_f32 %0, %1, %2" : "=v"(r) : "v"(lo), "v"(hi)); return r; }
template <class Epi, class Sched, bool ALIGN_EPI = false, bool SP2 = false>
__device__ __forceinline__ void gemm_phase(PG8_LAS unsigned char* lds, const Gemm g, const Sched& S, const Epi& E) {
    const int tid = threadIdx.x, wid = __builtin_amdgcn_readfirstlane(tid >> 6), lane = tid & 63, wr = wid >> 2, wc = wid & 3, fr = lane & 15, fq = lane >> 4;
    const int K = g.K, nt = K / BK;
    unsigned voffA[2], voffB[2];
#pragma unroll
    for (int i = 0; i < 2; ++i) { int R, C; stage_rc(tid * 16 + i * 8192, R, C); const int Rb = Epi::PERM ? ((R & ~31) + perm32(R & 31)) : R;
        voffA[i] = (unsigned)(R * K + C) * 2u; voffB[i] = (unsigned)(Rb * K + C) * 2u; }
    const size_t kstep = (size_t)(BK * 2);
    const size_t hstep = (size_t)HALF * K * 2;
    const size_t tstep = 2 * hstep;
    const unsigned ldsw = (unsigned)wid * 1024u;
    const int aoff = lds_byte(wr * 64 + fr, fq * 8), boff = lds_byte(wc * 32 + fr, fq * 8);
#define PG8_SA(b, h) (((b) * 2 + (h)) * HTB)
#define PG8_SB(b, h) ((4 + (b) * 2 + (h)) * HTB)
#define PG8_STAGE(bufoff, gbase, voff) do { _Pragma("unroll") for (int _i = 0; _i < 2; ++_i) \
        __builtin_amdgcn_global_load_lds((const unsigned*)((const char*)(gbase) + (voff)[_i]), (PG8_LAS unsigned*)(lds + (bufoff) + ldsw + _i * 8192), 16, 0, 0); } while (0)
#define PG8_LDA(dst, b, h) do { _Pragma("unroll") for (int m = 0; m < 4; ++m) _Pragma("unroll") for (int k = 0; k < 2; ++k) dst[m][k] = *(const PG8_LAS bf16x8*)(lds + PG8_SA(b, h) + aoff + m * 2048 + k * 1024); } while (0)
#define PG8_LDB(dst, b, h) do { _Pragma("unroll") for (int n = 0; n < 2; ++n) _Pragma("unroll") for (int k = 0; k < 2; ++k) dst[n][k] = *(const PG8_LAS bf16x8*)(lds + PG8_SB(b, h) + boff + n * 2048 + k * 1024); } while (0)
#define PG8_MMA(ai, bj, At, Bt) do { __builtin_amdgcn_s_setprio(1); _Pragma("unroll") for (int m = 0; m < 4; ++m) _Pragma("unroll") for (int n = 0; n < 2; ++n) _Pragma("unroll") for (int k = 0; k < 2; ++k) \
        acc[ai][bj][m][n] = __builtin_amdgcn_mfma_f32_16x16x32_bf16(Bt[n][k], At[m][k], acc[ai][bj][m][n], 0, 0, 0); __builtin_amdgcn_s_setprio(0); } while (0)
#define PG8_WAIT_V(n) asm volatile("s_waitcnt vmcnt(" #n ")" ::: "memory")
#define PG8_WAIT_L(n) asm volatile("s_waitcnt lgkmcnt(" #n ")" ::: "memory")
#define PG8_BAR __builtin_amdgcn_s_barrier()
#define PG8_SCHED __builtin_amdgcn_sched_barrier(0)
    Unit cur, nxt; int ui = 0;
    if (!S.next(0, cur)) return;
    f32x4 acc[2][2][4][2];
#pragma unroll
    for (int a = 0; a < 2; ++a)
#pragma unroll
        for (int b = 0; b < 2; ++b)
#pragma unroll
            for (int m = 0; m < 4; ++m)
#pragma unroll
                for (int n = 0; n < 2; ++n) acc[a][b][m][n] = (f32x4){0.f, 0.f, 0.f, 0.f};
    bf16x8 At[4][2], B0[2][2], B1[2][2];
    const char* cA = (const char*)g.A + (size_t)cur.pm * tstep; const char* cB = (const char*)g.Bt + (size_t)cur.pn * tstep;
    S.a_ready(cur);
    if constexpr (SP2) {
        PG8_STAGE(PG8_SB(0, 0), cB, voffB); PG8_STAGE(PG8_SB(0, 1), cB + hstep, voffB); PG8_STAGE(PG8_SA(0, 0), cA, voffA); PG8_STAGE(PG8_SA(0, 1), cA + hstep, voffA);
        if (wr == 1) PG8_BAR;
        PG8_WAIT_V(2); PG8_BAR;
        PG8_STAGE(PG8_SB(1, 0), cB + kstep, voffB); PG8_STAGE(PG8_SA(1, 0), cA + kstep, voffA); PG8_STAGE(PG8_SB(1, 1), cB + hstep + kstep, voffB);
        PG8_WAIT_V(6); PG8_BAR;
    } else {
        PG8_STAGE(PG8_SB(0, 0), cB, voffB); PG8_STAGE(PG8_SA(0, 0), cA, voffA); PG8_STAGE(PG8_SB(0, 1), cB + hstep, voffB); PG8_STAGE(PG8_SA(0, 1), cA + hstep, voffA);
        if (wr == 1) PG8_BAR;
        PG8_WAIT_V(4); PG8_BAR;
        PG8_STAGE(PG8_SB(1, 0), cB + kstep, voffB); PG8_STAGE(PG8_SA(1, 0), cA + kstep, voffA); PG8_STAGE(PG8_SB(1, 1), cB + hstep + kstep, voffB);
        PG8_WAIT_V(6); PG8_BAR;
    }
    for (;;) {
        const bool has_next = S.next(ui + 1, nxt);
        const char* nA = has_next ? (const char*)g.A + (size_t)nxt.pm * tstep : cA; const char* nB = has_next ? (const char*)g.Bt + (size_t)nxt.pn * tstep : cB;
        for (int t = 0; t < nt; t += 2) {
            const bool last = (t == nt - 2);
            const char* a1 = cA + (size_t)(t + 1) * kstep;
            const char* a2 = last ? nA : cA + (size_t)(t + 2) * kstep; const char* b2 = last ? nB : cB + (size_t)(t + 2) * kstep;
            const char* a3 = a2 + kstep; const char* b3 = b2 + kstep;
            if (last && has_next) S.a_ready(nxt);
            if constexpr (SP2) {
            PG8_LDB(B0, 0, 0); PG8_LDB(B1, 0, 1); PG8_SCHED; PG8_LDA(At, 0, 0); PG8_STAGE(PG8_SA(1, 1), a1 + hstep, voffA);
            PG8_WAIT_V(8); PG8_WAIT_L(0); PG8_BAR; PG8_MMA(0, 0, At, B0); PG8_MMA(0, 1, At, B1); PG8_BAR; PG8_SCHED;
            PG8_LDA(At, 0, 1); PG8_STAGE(PG8_SB(0, 0), b2, voffB); PG8_STAGE(PG8_SB(0, 1), b2 + hstep, voffB); PG8_STAGE(PG8_SA(0, 0), a2, voffA);
            PG8_WAIT_V(8); PG8_WAIT_L(0); PG8_BAR; PG8_MMA(1, 0, At, B0); PG8_MMA(1, 1, At, B1); PG8_BAR; PG8_SCHED;
            PG8_LDB(B0, 1, 0); PG8_LDB(B1, 1, 1); PG8_SCHED; PG8_LDA(At, 1, 0); PG8_STAGE(PG8_SA(0, 1), a2 + hstep, voffA);
            PG8_WAIT_V(8); PG8_WAIT_L(0); PG8_BAR; PG8_MMA(0, 0, At, B0); PG8_MMA(0, 1, At, B1); PG8_BAR; PG8_SCHED;
            PG8_LDA(At, 1, 1); PG8_STAGE(PG8_SB(1, 0), b3, voffB); PG8_STAGE(PG8_SB(1, 1), b3 + hstep, voffB); PG8_STAGE(PG8_SA(1, 0), a3, voffA);
            PG8_WAIT_V(8); PG8_WAIT_L(0); PG8_BAR; PG8_MMA(1, 0, At, B0); PG8_MMA(1, 1, At, B1); PG8_BAR; PG8_SCHED;
            } else {
            PG8_LDB(B0, 0, 0); PG8_SCHED; PG8_LDA(At, 0, 0); PG8_STAGE(PG8_SA(1, 1), a1 + hstep, voffA);
            PG8_WAIT_L(8); PG8_BAR; PG8_WAIT_L(0); PG8_MMA(0, 0, At, B0); PG8_BAR; PG8_SCHED;
            PG8_LDB(B1, 0, 1); PG8_STAGE(PG8_SB(0, 0), b2, voffB);
            PG8_BAR; PG8_WAIT_L(0); PG8_MMA(0, 1, At, B1); PG8_BAR;
            PG8_LDA(At, 0, 1); PG8_STAGE(PG8_SA(0, 0), a2, voffA);
            PG8_BAR; PG8_WAIT_L(0); PG8_MMA(1, 0, At, B0); PG8_BAR; PG8_SCHED;
            PG8_STAGE(PG8_SB(0, 1), b2 + hstep, voffB);
            PG8_WAIT_V(6); PG8_BAR; PG8_MMA(1, 1, At, B1); PG8_BAR;
            PG8_LDB(B0, 1, 0); PG8_SCHED; PG8_LDA(At, 1, 0); PG8_STAGE(PG8_SA(0, 1), a2 + hstep, voffA);
            PG8_WAIT_L(8); PG8_BAR; PG8_WAIT_L(0); PG8_MMA(0, 0, At, B0); PG8_BAR; PG8_SCHED;
            PG8_LDB(B1, 1, 1); PG8_STAGE(PG8_SB(1, 0), b3, voffB);
            PG8_BAR; PG8_WAIT_L(0); PG8_MMA(0, 1, At, B1); PG8_BAR;
            PG8_LDA(At, 1, 1); PG8_STAGE(PG8_SA(1, 0), a3, voffA);
            PG8_BAR; PG8_WAIT_L(0); PG8_MMA(1, 0, At, B0); PG8_BAR; PG8_SCHED;
            PG8_STAGE(PG8_SB(1, 1), b3 + hstep, voffB);
            PG8_WAIT_V(6); PG8_BAR; PG8_MMA(1, 1, At, B1); PG8_BAR;
            }
        }
        if constexpr (ALIGN_EPI) { if (wr == 0) PG8_BAR; }
        if constexpr (!Epi::AFTER_DRAIN) { E(acc, cur, wr, wc, fr, fq); S.done(cur); }
        if (!has_next) break;
#pragma unroll
        for (int a = 0; a < 2; ++a)
#pragma unroll
            for (int b = 0; b < 2; ++b)
#pragma unroll
                for (int m = 0; m < 4; ++m)
#pragma unroll
                    for (int n = 0; n < 2; ++n) acc[a][b][m][n] = (f32x4){0.f, 0.f, 0.f, 0.f};
        cur = nxt; cA = nA; cB = nB; ++ui;
        if constexpr (ALIGN_EPI) { if (wr == 1) PG8_BAR; }
    }
    PG8_WAIT_V(0);
    if constexpr (!ALIGN_EPI) { if (wr == 0) PG8_BAR; }
    PG8_BAR;
    if constexpr (Epi::AFTER_DRAIN) { E.fused(acc, cur, wr, wc, fr, fq, lds, wid, lane); S.done(cur); }
#undef PG8_SA
#undef PG8_SB
#undef PG8_STAGE
#undef PG8_LDA
#undef PG8_LDB
#undef PG8_MMA
#undef PG8_WAIT_V
#undef PG8_WAIT_L
#undef PG8_BAR
#undef PG8_SCHED
}
}
namespace pg8 {
struct EpiStoreBf16 {
    static constexpr bool PERM = true, AFTER_DRAIN = false;
    bf16_t* O; int ldc; const float* bias; int m_real, n_real;
    __device__ __forceinline__ void operator()(const f32x4 (&acc)[2][2][4][2], const Unit& u, int wr, int wc, int fr, int fq) const {
        const int row0 = u.pm * BM + wr * 64 + fr, col0 = u.pn * BM + wc * 32 + 8 * fq;
#pragma unroll
        for (int bj = 0; bj < 2; ++bj) {
            const int col = col0 + bj * HALF;
            if (col >= n_real) continue;
            f32x4 b0 = (f32x4){0.f, 0.f, 0.f, 0.f}, b1 = b0;
            if (bias) { b0 = *(const f32x4*)(bias + col); b1 = *(const f32x4*)(bias + col + 4); }
#pragma unroll
            for (int ai = 0; ai < 2; ++ai)
#pragma unroll
                for (int m = 0; m < 4; ++m) {
                    const int row = row0 + ai * HALF + m * 16;
                    if (row >= m_real) continue;
                    const f32x4 v0 = acc[ai][bj][m][0] + b0, v1 = acc[ai][bj][m][1] + b1;
                    u32x4 w; w.x = cvt_pk_bf16(v0[0], v0[1]); w.y = cvt_pk_bf16(v0[2], v0[3]); w.z = cvt_pk_bf16(v1[0], v1[1]); w.w = cvt_pk_bf16(v1[2], v1[3]);
                    *(u32x4*)(O + (size_t)row * ldc + col) = w;
                }
        }
    }
};
struct EpiStoreF32 {
    static constexpr bool PERM = false, AFTER_DRAIN = false;
    float* O; int ldc; const float* bias; int m_real, n_real;
    __device__ __forceinline__ void operator()(const f32x4 (&acc)[2][2][4][2], const Unit& u, int wr, int wc, int fr, int fq) const {
        const int row0 = u.pm * BM + wr * 64 + fr, col0 = u.pn * BM + wc * 32 + 4 * fq;
#pragma unroll
        for (int bj = 0; bj < 2; ++bj)
#pragma unroll
            for (int n = 0; n < 2; ++n) {
                const int col = col0 + bj * HALF + n * 16;
                if (col >= n_real) continue;
                const f32x4 bv = bias ? *(const f32x4*)(bias + col) : (f32x4){0.f, 0.f, 0.f, 0.f};
#pragma unroll
                for (int ai = 0; ai < 2; ++ai)
#pragma unroll
                    for (int m = 0; m < 4; ++m) {
                        const int row = row0 + ai * HALF + m * 16;
                        if (row >= m_real) continue;
                        *(f32x4*)(O + (size_t)row * ldc + col) = acc[ai][bj][m][n] + bv;
                    }
            }
    }
};
}
namespace {
#define GAS __attribute__((address_space(1)))
#define LAS __attribute__((address_space(3)))
typedef unsigned short bf16;
typedef float f32x4 __attribute__((ext_vector_type(4)));
typedef unsigned v4u __attribute__((ext_vector_type(4)));
typedef unsigned v2u __attribute__((ext_vector_type(2)));

constexpr int D = 1024, NB = 4, SEQ = 4096, NP = NB * SEQ, NS = 128, NT = NP + NS, MP = 16640;
constexpr int ABN = 3080, ABNP = 3328;
constexpr int C_QKV = 0, C_Z = 1536, C_A = 2048, C_B = 2052, C_XR = 2056, C_GATE = 2568;
constexpr int CN = 1536;
constexpr float ALPHA = 1.4142135623730951f;
constexpr float LN_EPS = 1e-5f;
constexpr int NTH = 512, NWAVES = 8;
constexpr int RING_BYTES = 131072, MISC_OFF = RING_BYTES + 320, LDS_BYTES = 147456;

__device__ __forceinline__ float bf2f(bf16 v) { return __uint_as_float((unsigned)v << 16); }
__device__ __forceinline__ unsigned f2bf(float f) { unsigned u = __float_as_uint(f); return (u + 0x7fffu + ((u >> 16) & 1u)) >> 16; }
__device__ __forceinline__ unsigned pk2(float lo, float hi) { return f2bf(lo) | (f2bf(hi) << 16); }
__device__ __forceinline__ float sigmoidf_(float x) { return 1.0f / (1.0f + expf(-x)); }
__device__ __forceinline__ float softplusf_(float x) { return fmaxf(x, 0.f) + log1pf(expf(-fabsf(x))); }
__device__ __forceinline__ float siluf_(float x) { return x / (1.0f + expf(-x)); }
__device__ __forceinline__ float geluf_(float x) { return 0.5f * x * (1.0f + tanhf(0.7978845608028654f * (x + 0.044715f * x * x * x))); }
__device__ __forceinline__ float wave_sum(float v) {
#pragma unroll
    for (int o = 32; o > 0; o >>= 1) v += __shfl_xor(v, o);
    return v;
}
__device__ __forceinline__ float wave_max(float v) {
#pragma unroll
    for (int o = 32; o > 0; o >>= 1) v = fmaxf(v, __shfl_xor(v, o));
    return v;
}

__device__ __forceinline__ void p0_transpose_item(const float* __restrict__ W, int K, int N, bf16* __restrict__ WT, float* scr, int item, int lane) {
    const int nblk = (N + 31) / 32, kb = item / nblk, nb = item % nblk, k0 = 64 * kb, n0 = 32 * nb;
#pragma unroll 8
    for (int i = 0; i < 32; ++i) { const int kk = 2 * i + (lane >> 5), n = n0 + (lane & 31); scr[kk * 33 + (lane & 31)] = n < N ? W[(size_t)(k0 + kk) * N + n] : 0.f; }
    asm volatile("s_waitcnt lgkmcnt(0)" ::: "memory");
    const int c = lane & 7;
#pragma unroll
    for (int j = 0; j < 4; ++j) { const int n = (lane >> 3) + 8 * j; const float* s = scr + (8 * c) * 33 + n;
        v4u o; o.x = pk2(s[0 * 33], s[1 * 33]); o.y = pk2(s[2 * 33], s[3 * 33]); o.z = pk2(s[4 * 33], s[5 * 33]); o.w = pk2(s[6 * 33], s[7 * 33]);
        *(v4u*)(WT + (size_t)(n0 + n) * K + k0 + 8 * c) = o; }
    asm volatile("s_waitcnt lgkmcnt(0)" ::: "memory");
}
__device__ __forceinline__ void row_to_bf16(const float* __restrict__ xrow, bf16* __restrict__ orow, int lane) {
#pragma unroll
    for (int j = 0; j < 4; ++j) {
        f32x4 v = (f32x4){0.f, 0.f, 0.f, 0.f};
        if (xrow) v = ((const f32x4*)xrow)[lane + 64 * j];
        v2u o; o.x = pk2(v.x, v.y); o.y = pk2(v.z, v.w);
        ((v2u*)orow)[lane + 64 * j] = o;
    }
}

struct AbPrepArgs {
    const bf16* PROJ; const float* st_gdn_conv; const float* st_lru_conv;
    const float* gdn_conv_w; const float* a_log; const float* dt_bias;
    const float* lru_conv_w; const float* lru_conv_b; const float* w_r; const float* b_r; const float* w_i; const float* b_i; const float* lam;
    float* QKV; float* G; float* BETA; float* LA; float* LB;
    float* p_gdn_conv; float* p_lru_conv; float* s_gdn_conv; float* s_lru_conv;
};
__device__ __forceinline__ void ab_prep(const AbPrepArgs& a, int t, float* smem) {
    const int tid = threadIdx.x, lane = tid & 63, wid = tid >> 6;
    const bool samp = t >= NP; const int sb = t - NP, pos = t % SEQ, b = t / SEQ;
    float* sq = smem;
    float* sx = smem + 1536;
    float* scl = smem + 2048;
    const bf16* prow = a.PROJ + (size_t)t * ABN;
    for (int c = tid; c < 1536; c += NTH) {
        float acc = 0.f;
#pragma unroll
        for (int i = 0; i < 4; ++i) {
            float xv;
            if (i == 3) xv = bf2f(prow[C_QKV + c]);
            else if (samp) xv = a.st_gdn_conv[((size_t)sb * 3 + i) * 1536 + c];
            else xv = (pos - 3 + i >= 0) ? bf2f(a.PROJ[(size_t)(t - 3 + i) * ABN + C_QKV + c]) : 0.f;
            acc += a.gdn_conv_w[i * 1536 + c] * xv;
        }
        sq[c] = siluf_(acc);
    }
    {
        const int c = tid;
        float acc = a.lru_conv_b[c];
#pragma unroll
        for (int i = 0; i < 4; ++i) {
            float xv;
            if (i == 3) xv = bf2f(prow[C_XR + c]);
            else if (samp) xv = a.st_lru_conv[((size_t)sb * 3 + i) * 512 + c];
            else xv = (pos - 3 + i >= 0) ? bf2f(a.PROJ[(size_t)(t - 3 + i) * ABN + C_XR + c]) : 0.f;
            acc += a.lru_conv_w[i * 512 + c] * xv;
        }
        sx[c] = acc;
    }
    __syncthreads();
    {
        const int grp = wid;
        const float v0 = sq[grp * 128 + lane], v1 = sq[grp * 128 + 64 + lane];
        const float s = wave_sum(v0 * v0 + v1 * v1);
        if (lane == 0) scl[grp] = rsqrtf(s + 1e-6f) * (grp < 4 ? 0.08838834764831845f : 1.0f);
    }
    __syncthreads();
    for (int c = tid; c < 1536; c += NTH) a.QKV[(size_t)t * 1536 + c] = (c < 1024) ? sq[c] * scl[c >> 7] : sq[c];
    if (tid < 4) {
        const float a_raw = bf2f(prow[C_A + tid]), b_raw = bf2f(prow[C_B + tid]);
        a.G[(size_t)t * 4 + tid] = -expf(a.a_log[tid]) * softplusf_(a_raw + a.dt_bias[tid]);
        a.BETA[(size_t)t * 4 + tid] = sigmoidf_(b_raw);
    }
    if (!samp) {
        if (pos >= SEQ - 3) {
            const int row = pos - (SEQ - 3);
            for (int c = tid; c < 1536; c += NTH) a.p_gdn_conv[((size_t)b * 3 + row) * 1536 + c] = bf2f(prow[C_QKV + c]);
            a.p_lru_conv[((size_t)b * 3 + row) * 512 + tid] = bf2f(prow[C_XR + tid]);
        }
    } else {
        for (int c = tid; c < 1536; c += NTH) {
            a.s_gdn_conv[((size_t)sb * 3 + 0) * 1536 + c] = a.st_gdn_conv[((size_t)sb * 3 + 1) * 1536 + c];
            a.s_gdn_conv[((size_t)sb * 3 + 1) * 1536 + c] = a.st_gdn_conv[((size_t)sb * 3 + 2) * 1536 + c];
            a.s_gdn_conv[((size_t)sb * 3 + 2) * 1536 + c] = bf2f(prow[C_QKV + c]);
        }
        {
            const int c = tid;
            a.s_lru_conv[((size_t)sb * 3 + 0) * 512 + c] = a.st_lru_conv[((size_t)sb * 3 + 1) * 512 + c];
            a.s_lru_conv[((size_t)sb * 3 + 1) * 512 + c] = a.st_lru_conv[((size_t)sb * 3 + 2) * 512 + c];
            a.s_lru_conv[((size_t)sb * 3 + 2) * 512 + c] = bf2f(prow[C_XR + c]);
        }
    }
    {
        const int c = tid, n = c >> 6, d = c & 63;
        float r = a.b_r[c], ii = a.b_i[c];
#pragma unroll 4
        for (int cc = 0; cc < 64; ++cc) {
            const float xv = sx[n * 64 + cc];
            r += xv * a.w_r[((size_t)n * 64 + cc) * 64 + d];
            ii += xv * a.w_i[((size_t)n * 64 + cc) * 64 + d];
        }
        r = sigmoidf_(r); ii = sigmoidf_(ii);
        const float log_a = -8.0f * r * softplusf_(-a.lam[c]);
        a.LA[(size_t)t * 512 + c] = expf(log_a);
        a.LB[(size_t)t * 512 + c] = sqrtf(-expm1f(2.0f * log_a)) * (ii * sx[c]);
    }
}

__device__ __forceinline__ void gdn_scan(const float* __restrict__ QKV, const float* __restrict__ G, const float* __restrict__ BETA,
                                         const float* __restrict__ S0, float* __restrict__ O, float* __restrict__ Sout, int tok_base, int T,
                                         int sl, int h, int sq, float* smem) {
    const int tid = threadIdx.x, dvl = tid & 31, kg = tid >> 5;
    const int dv = sl * 32 + dvl;
    float (*red1)[32] = (float (*)[32])smem;
    float (*red2)[32] = (float (*)[32])(smem + 512);
    float S[8];
#pragma unroll
    for (int i = 0; i < 8; ++i) S[i] = S0 ? S0[(((size_t)sq * 4 + h) * 128 + kg * 8 + i) * 128 + dv] : 0.f;
    float kk[8], qq[8], vv, g, be;
    {
        const size_t tok = (size_t)tok_base + (size_t)sq * T;
        const float* row = QKV + tok * 1536;
#pragma unroll
        for (int i = 0; i < 8; ++i) { kk[i] = row[512 + h * 128 + kg * 8 + i]; qq[i] = row[h * 128 + kg * 8 + i]; }
        vv = row[1024 + h * 128 + dv]; g = G[tok * 4 + h]; be = BETA[tok * 4 + h];
    }
    for (int t = 0; t < T; ++t) {
        const size_t tok = (size_t)tok_base + (size_t)sq * T + t;
        float nk[8], nq[8], nv = 0.f, ng = 0.f, nb = 0.f;
        if (t + 1 < T) {
            const float* row = QKV + (tok + 1) * 1536;
#pragma unroll
            for (int i = 0; i < 8; ++i) { nk[i] = row[512 + h * 128 + kg * 8 + i]; nq[i] = row[h * 128 + kg * 8 + i]; }
            nv = row[1024 + h * 128 + dv]; ng = G[(tok + 1) * 4 + h]; nb = BETA[(tok + 1) * 4 + h];
        } else {
#pragma unroll
            for (int i = 0; i < 8; ++i) { nk[i] = 0.f; nq[i] = 0.f; }
        }
        const float al = expf(g);
        float p = 0.f;
#pragma unroll
        for (int i = 0; i < 8; ++i) { S[i] *= al; p += S[i] * kk[i]; }
        red1[kg][dvl] = p;
        __syncthreads();
        float ks = 0.f;
#pragma unroll
        for (int j = 0; j < 16; ++j) ks += red1[j][dvl];
        const float vn = be * (vv - ks);
        float o = 0.f;
#pragma unroll
        for (int i = 0; i < 8; ++i) { S[i] += kk[i] * vn; o += S[i] * qq[i]; }
        red2[kg][dvl] = o;
        __syncthreads();
        if (kg == 0) {
            float os = 0.f;
#pragma unroll
            for (int j = 0; j < 16; ++j) os += red2[j][dvl];
            O[tok * 512 + h * 128 + dv] = os;
        }
#pragma unroll
        for (int i = 0; i < 8; ++i) { kk[i] = nk[i]; qq[i] = nq[i]; }
        vv = nv; g = ng; be = nb;
    }
#pragma unroll
    for (int i = 0; i < 8; ++i) Sout[(((size_t)sq * 4 + h) * 128 + kg * 8 + i) * 128 + dv] = S[i];
}

__device__ __forceinline__ void lru_scan(const float* __restrict__ LA, float* __restrict__ LB, const float* __restrict__ h0,
                                         float* __restrict__ hlast, int tok_base, int T, int nseq, int bx) {
    const int idx = bx * NTH + threadIdx.x;
    if (idx >= nseq * 512) return;
    const int sq = idx / 512, c = idx % 512;
    float h = h0 ? h0[(size_t)sq * 512 + c] : 0.f;
    const size_t base = ((size_t)tok_base + (size_t)sq * T) * 512 + c;
#pragma unroll 8
    for (int t = 0; t < T; ++t) {
        const size_t o = base + (size_t)t * 512;
        h = LA[o] * h + LB[o];
        LB[o] = h;
    }
    hlast[(size_t)sq * 512 + c] = h;
}

__device__ __forceinline__ void ab_mix(const bf16* __restrict__ PROJ, const float* __restrict__ O, const float* __restrict__ H,
                                       const float* __restrict__ norm_w, bf16* __restrict__ MIX, int vb) {
    const int tid = threadIdx.x & 255, lane = tid & 63, wid = tid >> 6, t = vb * 2 + (threadIdx.x >> 8);
    const bf16* prow = PROJ + (size_t)t * ABN;
    {
        const int h = wid;
        const float o0 = O[(size_t)t * 512 + h * 128 + lane], o1 = O[(size_t)t * 512 + h * 128 + 64 + lane];
        const float ms = wave_sum(o0 * o0 + o1 * o1) * (1.0f / 128.0f);
        const float sc = rsqrtf(ms + 1e-6f);
        MIX[(size_t)t * 1024 + h * 128 + lane] = (bf16)f2bf(o0 * sc * norm_w[lane] * siluf_(bf2f(prow[C_Z + h * 128 + lane])));
        MIX[(size_t)t * 1024 + h * 128 + 64 + lane] = (bf16)f2bf(o1 * sc * norm_w[64 + lane] * siluf_(bf2f(prow[C_Z + h * 128 + 64 + lane])));
    }
    for (int c = tid; c < 512; c += 256) MIX[(size_t)t * 1024 + 512 + c] = (bf16)f2bf(geluf_(bf2f(prow[C_GATE + c])) * H[(size_t)t * 512 + c]);
}

__device__ __forceinline__ void ln_res_w(const float* __restrict__ xrow, const float* __restrict__ yrow, const float* __restrict__ g, const float* __restrict__ bta,
                                         float* __restrict__ orow, bf16* __restrict__ obrow, int lane) {
    f32x4 v[4]; float s = 0.f;
#pragma unroll
    for (int j = 0; j < 4; ++j) { const f32x4 x4 = ((const f32x4*)xrow)[lane + 64 * j], y4 = ((const f32x4*)yrow)[lane + 64 * j]; v[j] = x4 * ALPHA + y4; s += (v[j].x + v[j].y) + (v[j].z + v[j].w); }
    const float mean = wave_sum(s) * (1.0f / 1024.0f); float q = 0.f;
#pragma unroll
    for (int j = 0; j < 4; ++j) { v[j] = v[j] - mean; q += (v[j].x * v[j].x + v[j].y * v[j].y) + (v[j].z * v[j].z + v[j].w * v[j].w); }
    const float rs = rsqrtf(wave_sum(q) * (1.0f / 1024.0f) + LN_EPS);
#pragma unroll
    for (int j = 0; j < 4; ++j) {
        const f32x4 g4 = ((const f32x4*)g)[lane + 64 * j], b4 = ((const f32x4*)bta)[lane + 64 * j];
        const f32x4 o = v[j] * rs * g4 + b4;
        ((f32x4*)orow)[lane + 64 * j] = o;
        v2u ob; ob.x = pk2(o.x, o.y); ob.y = pk2(o.z, o.w);
        ((v2u*)obrow)[lane + 64 * j] = ob;
    }
}

__device__ __forceinline__ void peer_topk(const float* __restrict__ Q, const float* __restrict__ keys, int* __restrict__ EXP, float* __restrict__ GATE,
                                          int tg, int h, float* smem) {
    const int tid = threadIdx.x, cn = tid & 255, c = cn >> 7, n = cn & 127, th = tid >> 8;
    float (*sq)[256] = (float (*)[256])smem;
    float (*ss)[257] = (float (*)[257])(smem + 32 * 256);
    float (*tvs)[2][16] = (float (*)[2][16])(smem + 32 * 256 + 32 * 257 + 32);
    int (*tis)[2][16] = (int (*)[2][16])(smem + 32 * 256 + 32 * 257 + 32 + 1024);
    for (int i = tid; i < 32 * 256; i += NTH) {
        const int tk = i >> 8, col = i & 255;
        sq[tk][col] = Q[(size_t)(tg * 32 + tk) * 2048 + h * 256 + col];
    }
    __syncthreads();
    float acc[16];
#pragma unroll
    for (int i = 0; i < 16; ++i) acc[i] = 0.f;
    const float* krow = keys + (((size_t)h * 2 + c) * 128 + n) * 128;
    for (int d4 = 0; d4 < 32; ++d4) {
        const float4 kv = *(const float4*)(krow + d4 * 4);
#pragma unroll
        for (int tk = 0; tk < 16; ++tk) {
            const float4 qv = *(const float4*)&sq[th * 16 + tk][c * 128 + d4 * 4];
            acc[tk] += qv.x * kv.x + qv.y * kv.y + qv.z * kv.z + qv.w * kv.w;
        }
    }
#pragma unroll
    for (int tk = 0; tk < 16; ++tk) ss[th * 16 + tk][cn] = acc[tk];
    __syncthreads();
    if (tid < 64) {
        const int tk = tid >> 1, cc = tid & 1;
        float tv[16]; int ti[16];
#pragma unroll
        for (int j = 0; j < 16; ++j) { tv[j] = -INFINITY; ti[j] = 0; }
        for (int nn = 0; nn < 128; ++nn) {
            float x = ss[tk][cc * 128 + nn]; int xi = nn;
#pragma unroll
            for (int j = 0; j < 16; ++j) {
                const bool gt = x > tv[j];
                const float tf = tv[j]; const int tj = ti[j];
                tv[j] = gt ? x : tf; ti[j] = gt ? xi : tj;
                x = gt ? tf : x; xi = gt ? tj : xi;
            }
        }
#pragma unroll
        for (int j = 0; j < 16; ++j) { tvs[tk][cc][j] = tv[j]; tis[tk][cc][j] = ti[j]; }
    }
    __syncthreads();
    if (tid < 32) {
        const int tk = tid;
        float bv[16]; int bi[16];
#pragma unroll
        for (int j = 0; j < 16; ++j) { bv[j] = -INFINITY; bi[j] = 0; }
        for (int i = 0; i < 16; ++i)
            for (int jj = 0; jj < 16; ++jj) {
                float x = tvs[tk][0][i] + tvs[tk][1][jj]; int xi = tis[tk][0][i] * 128 + tis[tk][1][jj];
#pragma unroll
                for (int j = 0; j < 16; ++j) {
                    const bool gt = x > bv[j];
                    const float tf = bv[j]; const int tj = bi[j];
                    bv[j] = gt ? x : tf; bi[j] = gt ? xi : tj;
                    x = gt ? tf : x; xi = gt ? tj : xi;
                }
            }
        float e[16], sum = 0.f;
#pragma unroll
        for (int j = 0; j < 16; ++j) { e[j] = expf(bv[j] - bv[0]); sum += e[j]; }
        const float inv = 1.0f / sum;
        const size_t o = (size_t)(tg * 32 + tk) * 128 + h * 16;
#pragma unroll
        for (int j = 0; j < 16; ++j) { EXP[o + j] = bi[j]; GATE[o + j] = e[j] * inv; }
    }
}

__device__ __forceinline__ void peer_expert(const float* __restrict__ X, const int* __restrict__ EXP, const float* __restrict__ GATE,
                                            const float* __restrict__ U, const float* __restrict__ V,
                                            const float* __restrict__ g, const float* __restrict__ bta, float* __restrict__ out, bf16* __restrict__ outb, int t, float* smem) {
    const int tid = threadIdx.x, lane = tid & 63, wid = tid >> 6;
    float (*accs)[1024] = (float (*)[1024])smem;
    float* sred = smem + 8192;
    const float4* xr = (const float4*)(X + (size_t)t * D);
    float4 xv[4];
#pragma unroll
    for (int j = 0; j < 4; ++j) xv[j] = xr[lane + 64 * j];
    float4 acc[4];
#pragma unroll
    for (int j = 0; j < 4; ++j) acc[j] = make_float4(0.f, 0.f, 0.f, 0.f);
    for (int e = 0; e < 16; ++e) {
        const int id = EXP[(size_t)t * 128 + wid * 16 + e];
        const float gt = GATE[(size_t)t * 128 + wid * 16 + e];
        const float4* ur = (const float4*)(U + (size_t)id * D);
        const float4* vr = (const float4*)(V + (size_t)id * D);
        float4 uv[4], vv[4];
#pragma unroll
        for (int j = 0; j < 4; ++j) { uv[j] = ur[lane + 64 * j]; vv[j] = vr[lane + 64 * j]; }
        float dot = 0.f;
#pragma unroll
        for (int j = 0; j < 4; ++j) dot += uv[j].x * xv[j].x + uv[j].y * xv[j].y + uv[j].z * xv[j].z + uv[j].w * xv[j].w;
        dot = wave_sum(dot);
        const float cf = gt * geluf_(dot);
#pragma unroll
        for (int j = 0; j < 4; ++j) { acc[j].x += cf * vv[j].x; acc[j].y += cf * vv[j].y; acc[j].z += cf * vv[j].z; acc[j].w += cf * vv[j].w; }
    }
#pragma unroll
    for (int j = 0; j < 4; ++j) *(float4*)&accs[wid][(lane + 64 * j) * 4] = acc[j];
    __syncthreads();
    float v[2];
#pragma unroll
    for (int i = 0; i < 2; ++i) {
        const int c = tid * 2 + i;
        float s = 0.f;
#pragma unroll
        for (int w = 0; w < 8; ++w) s += accs[w][c];
        v[i] = ALPHA * X[(size_t)t * D + c] + s;
    }
    float s = wave_sum(v[0] + v[1]);
    if (lane == 0) sred[wid] = s;
    __syncthreads();
    float mean = 0.f;
#pragma unroll
    for (int w = 0; w < 8; ++w) mean += sred[w];
    mean *= (1.0f / 1024.0f);
    __syncthreads();
    const float d0 = v[0] - mean, d1 = v[1] - mean;
    float q = wave_sum(d0 * d0 + d1 * d1);
    if (lane == 0) sred[wid] = q;
    __syncthreads();
    float var = 0.f;
#pragma unroll
    for (int w = 0; w < 8; ++w) var += sred[w];
    const float rs = rsqrtf(var * (1.0f / 1024.0f) + LN_EPS);
    const float o0 = d0 * rs * g[tid * 2] + bta[tid * 2], o1 = d1 * rs * g[tid * 2 + 1] + bta[tid * 2 + 1];
    *(float2*)(out + (size_t)t * D + tid * 2) = make_float2(o0, o1);
    if (outb) *(unsigned*)(outb + (size_t)t * D + tid * 2) = pk2(o0, o1);
}

__device__ __forceinline__ int t5_bucket(int n) {
    if (n < 16) return n;
    const int large = 16 + (int)(logf((float)n / 16.0f) / 2.0794415416798357f * 16.0f);
    return large < 31 ? large : 31;
}
__device__ __forceinline__ void swa_attn(const float* __restrict__ PC, const float* __restrict__ cache_k, const float* __restrict__ cache_v,
                                         const float* __restrict__ rel_bias, const float* __restrict__ sinks, bf16* __restrict__ ATT, int bx) {
    const int tid = threadIdx.x, lane = tid & 63, wid = tid >> 6;
    const int gw = bx * 8 + wid;
    const int t = gw >> 4, h = gw & 15, kvh = h >> 2;
    if (t >= NT) return;
    const bool samp = t >= NP; const int sb = t - NP, pos = t % SEQ;
    const float* qrow = PC + (size_t)t * CN + h * 64;
    float lg[2]; bool valid[2];
#pragma unroll
    for (int rr = 0; rr < 2; ++rr) {
        const int r = lane + 64 * rr;
        const float* krow;
        if (!samp) { valid[rr] = (pos - r) >= 0; krow = PC + (size_t)(valid[rr] ? t - r : t) * CN + 1024 + kvh * 64; }
        else { valid[rr] = true; krow = (r == 0) ? PC + (size_t)t * CN + 1024 + kvh * 64 : cache_k + (((size_t)sb * 128 + (128 - r)) * 4 + kvh) * 64; }
        float dot = 0.f;
#pragma unroll
        for (int d4 = 0; d4 < 16; ++d4) {
            const float4 kv = *(const float4*)(krow + d4 * 4);
            const float4 qv = *(const float4*)(qrow + d4 * 4);
            dot += qv.x * kv.x + qv.y * kv.y + qv.z * kv.z + qv.w * kv.w;
        }
        lg[rr] = valid[rr] ? dot * 0.125f + rel_bias[t5_bucket(r) * 16 + h] : -INFINITY;
    }
    const float sink = sinks[h];
    const float m = fmaxf(wave_max(fmaxf(lg[0], lg[1])), sink);
    float p[2];
#pragma unroll
    for (int rr = 0; rr < 2; ++rr) p[rr] = valid[rr] ? expf(lg[rr] - m) : 0.f;
    const float den = wave_sum(p[0] + p[1]) + expf(sink - m);
    const float inv = 1.0f / den;
    float o = 0.f;
#pragma unroll
    for (int rr = 0; rr < 2; ++rr)
        for (int l2 = 0; l2 < 64; ++l2) {
            const int r = l2 + 64 * rr;
            const float pj = __shfl(p[rr], l2);
            if (pj != 0.f) {
                const float* vrow;
                if (!samp) vrow = PC + (size_t)(t - r) * CN + 1280 + kvh * 64;
                else vrow = (r == 0) ? PC + (size_t)t * CN + 1280 + kvh * 64 : cache_v + (((size_t)sb * 128 + (128 - r)) * 4 + kvh) * 64;
                o += pj * vrow[lane];
            }
        }
    ATT[(size_t)t * D + h * 64 + lane] = (bf16)f2bf(o * inv);
}

__device__ __forceinline__ void swa_kv_out(const float* __restrict__ PC, const float* __restrict__ cache_k, const float* __restrict__ cache_v,
                                           float* __restrict__ pk, float* __restrict__ pv, float* __restrict__ sk, float* __restrict__ sv, int vb) {
    const int c = threadIdx.x & 255, row = vb * 2 + (threadIdx.x >> 8);
    if (row < NB * 128) {
        const int b = row >> 7, i = row & 127;
        const float* src = PC + (size_t)(b * SEQ + SEQ - 128 + i) * CN;
        pk[(size_t)row * 256 + c] = src[1024 + c];
        pv[(size_t)row * 256 + c] = src[1280 + c];
    } else {
        const int r2 = row - NB * 128, sb = r2 >> 7, i = r2 & 127;
        if (i < 127) {
            sk[(size_t)r2 * 256 + c] = cache_k[((size_t)sb * 128 + i + 1) * 256 + c];
            sv[(size_t)r2 * 256 + c] = cache_v[((size_t)sb * 128 + i + 1) * 256 + c];
        } else {
            const float* src = PC + (size_t)(NP + sb) * CN;
            sk[(size_t)r2 * 256 + c] = src[1024 + c];
            sv[(size_t)r2 * 256 + c] = src[1280 + c];
        }
    }
}
#define XB_TMO      128
#define XB_XCNT(j)  (256  + 64 * (j))
#define XB_XSUB(j)  (1280 + 64 * (j))
#define XB_XGEN(j)  (2304 + 64 * (j))
#define XB_TOP      3328
#define XB_TOPGEN   3392
#define XCD_BAR_WORDS 3456
#define XB_SPIN_CAP (1u << 18)

__device__ __forceinline__ unsigned xb_ld(unsigned* p)              { return __hip_atomic_load(p, __ATOMIC_RELAXED, __HIP_MEMORY_SCOPE_AGENT); }
__device__ __forceinline__ unsigned xb_add(unsigned* p, unsigned v) { return __hip_atomic_fetch_add(p, v, __ATOMIC_RELAXED, __HIP_MEMORY_SCOPE_AGENT); }
__device__ __forceinline__ unsigned xb_xcc_id() { return (unsigned)__builtin_amdgcn_s_getreg((3 << 11) | 20) & 0xFu; }
#define XB_SPIN(cond, bar) do { unsigned _sp = 0; while (cond) { __builtin_amdgcn_s_sleep(1); \
    if ((++_sp & 255u) == 0u) { if (xb_ld(&(bar)[XB_TMO])) break; if (_sp > XB_SPIN_CAP) { atomicAdd(&(bar)[XB_TMO], 1u); break; } } } } while (0)

struct XcdBarrier {
    unsigned* bar; unsigned x;
    volatile LAS unsigned* st;
};

__device__ __forceinline__ XcdBarrier xcd_barrier_post(unsigned* bar, volatile LAS unsigned* st) {
    XcdBarrier b; b.bar = bar; b.x = xb_xcc_id(); b.st = st;
    if (threadIdx.x == 0) (void)xb_add(&bar[XB_XCNT(b.x)], 1u);
    return b;
}
__device__ __forceinline__ void xcd_barrier_complete(unsigned* bar, unsigned x, unsigned& nloc, unsigned& nx) {
    const unsigned G = gridDim.x * gridDim.y * gridDim.z;
    unsigned sum, cnt, mine, sp = 0u;
    for (;;) {
        sum = 0u; cnt = 0u; mine = 0u;
#pragma unroll
        for (unsigned j = 0; j < 16; ++j) { const unsigned c = xb_ld(&bar[XB_XCNT(j)]); sum += c; cnt += (c > 0u) ? 1u : 0u; mine = (j == x) ? c : mine; }
        if (sum == G) break;
        __builtin_amdgcn_s_sleep(1);
        if ((++sp & 255u) == 0u) { if (xb_ld(&bar[XB_TMO])) break; if (sp > XB_SPIN_CAP) { atomicAdd(&bar[XB_TMO], 1u); break; } }
    }
    nloc = mine > 0u ? mine : 1u; nx = cnt > 0u ? cnt : 1u;
}

__device__ __forceinline__ void xcd_barrier(const XcdBarrier& b) {
    asm volatile("s_waitcnt vmcnt(0)" ::: "memory");
    __syncthreads();
    if (threadIdx.x == 0) {
        unsigned* bar = b.bar;
        __builtin_amdgcn_s_waitcnt(0);
        unsigned nloc = b.st[0], nx = b.st[1];
        if (nloc == 0u) { xcd_barrier_complete(bar, b.x, nloc, nx); b.st[0] = nloc; b.st[1] = nx; }
        const unsigned old = xb_add(&bar[XB_XSUB(b.x)], 1u);
        const unsigned gen = old / nloc;
        if (old + 1u == (gen + 1u) * nloc) {
            __builtin_amdgcn_fence(__ATOMIC_RELEASE, "agent");
            asm volatile("s_waitcnt vmcnt(0)" ::: "memory");
            const unsigned og = xb_add(&bar[XB_TOP], 1u);
            const unsigned tg = og / nx;
            if (og + 1u == (tg + 1u) * nx) xb_add(&bar[XB_TOPGEN], 1u);
            else XB_SPIN(xb_ld(&bar[XB_TOPGEN]) == tg, bar);
            __builtin_amdgcn_fence(__ATOMIC_ACQUIRE, "agent");
            xb_add(&bar[XB_XGEN(b.x)], 1u);
            asm volatile("s_waitcnt vmcnt(0)" ::: "memory");
        } else {
            XB_SPIN(xb_ld(&bar[XB_XGEN(b.x)]) == gen, bar);
            __builtin_amdgcn_fence(__ATOMIC_ACQUIRE, "agent");
            asm volatile("s_waitcnt vmcnt(0)" ::: "memory");
        }
    }
    __syncthreads();
}

constexpr size_t MiB = 1u << 20;
constexpr size_t WS_CTL = 0, CTL_ZERO_BYTES = 64 * 1024;
constexpr size_t WS_WAB = 1 * MiB;
constexpr size_t WS_WOUT = WS_WAB + (size_t)ABNP * D * 2;
constexpr size_t WS_WQ0 = WS_WOUT + (size_t)D * D * 2;
constexpr size_t WS_WQ1 = WS_WQ0 + (size_t)2048 * D * 2;
constexpr size_t WS_WINC = WS_WQ1 + (size_t)2048 * D * 2;
constexpr size_t WS_WOUTC = WS_WINC + (size_t)CN * D * 2;
constexpr size_t WS_ABUF = WS_WOUTC + (size_t)D * D * 2;
constexpr size_t WS_P = WS_ABUF + (size_t)MP * D * 2;
constexpr size_t WS_Q = WS_P + (size_t)MP * 2048 * 4;
constexpr size_t WS_A = WS_Q + (size_t)MP * 1536 * 4;
constexpr size_t WS_B = WS_A + (size_t)MP * 512 * 4;
constexpr size_t WS_O = WS_B + (size_t)MP * 512 * 4;
constexpr size_t WS_X1 = WS_O + (size_t)MP * 512 * 4;
constexpr size_t WS_G = WS_X1 + (size_t)MP * D * 4;
constexpr size_t WS_BETA = WS_G + (size_t)MP * 4 * 4;
constexpr size_t WS_GATE = WS_BETA + (size_t)MP * 4 * 4;
constexpr size_t WS_EXP = WS_GATE + (size_t)MP * 128 * 4;
constexpr size_t WS_END = WS_EXP + (size_t)MP * 128 * 4;
static_assert(WS_END <= 512 * MiB, "d_ws map");

struct MegaArgs {
    const float* in[35];
    float* out;
    unsigned char* ws;
};

__global__ void __launch_bounds__(NTH, 2) fwd_megakernel(MegaArgs ma) {
    cg::grid_group grid = cg::this_grid();
    extern __shared__ __attribute__((aligned(16))) unsigned char lds[];
    float* smem = (float*)lds;
    const int nb = gridDim.x, b0 = blockIdx.x, tid = threadIdx.x, lane = tid & 63, wave = __builtin_amdgcn_readfirstlane(tid >> 6);
    const float* x_prompt = ma.in[0];
    const float* x_sample = ma.in[1];
    const float* state_gdn = ma.in[2];
    const float* state_gdn_conv = ma.in[3];
    const float* state_lru = ma.in[4];
    const float* state_lru_conv = ma.in[5];
    const float* cache_k = ma.in[6];
    const float* cache_v = ma.in[7];
    const float* w_in_ab = ma.in[8];
    const float* gdn_conv_w = ma.in[9];
    const float* gdn_a_log = ma.in[10];
    const float* gdn_dt_bias = ma.in[11];
    const float* gdn_norm_w = ma.in[12];
    const float* lru_conv_w = ma.in[13];
    const float* lru_conv_b = ma.in[14];
    const float* lru_w_r = ma.in[15];
    const float* lru_b_r = ma.in[16];
    const float* lru_w_i = ma.in[17];
    const float* lru_b_i = ma.in[18];
    const float* lru_lam = ma.in[19];
    const float* w_out_ab = ma.in[20];
    const float* w_in_c = ma.in[21];
    const float* b_in_c = ma.in[22];
    const float* swa_sinks = ma.in[23];
    const float* w_out_c = ma.in[24];
    const float* b_out_c = ma.in[25];
    const float* rel_bias = ma.in[26];
    const float* ln_mix_g = ma.in[27];
    const float* ln_mix_b = ma.in[28];
    const float* ln_ffn_g = ma.in[29];
    const float* ln_ffn_b = ma.in[30];
    const float* peer_w_q = ma.in[31];
    const float* peer_keys = ma.in[32];
    const float* peer_u = ma.in[33];
    const float* peer_v = ma.in[34];

    float* out = ma.out;
    float* o_y = out;
    float* o_p_gdn = out + (size_t)NT * D;
    float* o_p_gdn_conv = o_p_gdn + 262144;
    float* o_p_lru = o_p_gdn_conv + 18432;
    float* o_p_lru_conv = o_p_lru + 2048;
    float* o_p_k = o_p_lru_conv + 6144;
    float* o_p_v = o_p_k + 131072;
    float* o_s_gdn = o_p_v + 131072;
    float* o_s_gdn_conv = o_s_gdn + 8388608;
    float* o_s_lru = o_s_gdn_conv + 589824;
    float* o_s_lru_conv = o_s_lru + 65536;
    float* o_s_k = o_s_lru_conv + 196608;
    float* o_s_v = o_s_k + 4194304;

    unsigned char* ws = ma.ws;
    bf16* WAB_T = (bf16*)(ws + WS_WAB); bf16* WOUT_T = (bf16*)(ws + WS_WOUT); bf16* WQ0_T = (bf16*)(ws + WS_WQ0); bf16* WQ1_T = (bf16*)(ws + WS_WQ1);
    bf16* WINC_T = (bf16*)(ws + WS_WINC); bf16* WOUTC_T = (bf16*)(ws + WS_WOUTC);
    bf16* ABUF = (bf16*)(ws + WS_ABUF);
    bf16* PROJ = (bf16*)(ws + WS_P); float* Y = (float*)(ws + WS_P); float* Qb = (float*)(ws + WS_P); float* PC = (float*)(ws + WS_P);
    float* R_Q = (float*)(ws + WS_Q); float* X2 = (float*)(ws + WS_Q);
    float* R_A = (float*)(ws + WS_A); float* R_B = (float*)(ws + WS_B); float* R_O = (float*)(ws + WS_O); float* Y1 = (float*)(ws + WS_A);
    float* R_X1 = (float*)(ws + WS_X1); float* X3 = R_X1;
    float* R_G = (float*)(ws + WS_G); float* R_BETA = (float*)(ws + WS_BETA); float* R_GATE = (float*)(ws + WS_GATE); int* R_EXP = (int*)(ws + WS_EXP);

    for (int u = tid; u < (LDS_BYTES - RING_BYTES) / 4; u += NTH) ((unsigned*)(lds + RING_BYTES))[u] = 0u;
    __syncthreads();
    XcdBarrier bar = xcd_barrier_post((unsigned*)(ws + WS_CTL), (volatile LAS unsigned*)((LAS unsigned char*)lds + MISC_OFF) + 8);
#define GRID_BAR() xcd_barrier(bar)
#define PHASE_LOOP(n) for (int vb = b0; vb < (n); vb += nb)
#define PHASE_END __syncthreads()
#define GEMM_PHASE(EPI, Aptr, Btptr, Nn, ...) do { pg8::Gemm g_{(const pg8::bf16_t*)(Aptr), (const pg8::bf16_t*)(Btptr), MP, (Nn), D}; pg8::StaticOrder S_; S_.init(MP, (Nn), nb, b0); \
        pg8::EPI E_{__VA_ARGS__}; pg8::gemm_phase<pg8::EPI, pg8::StaticOrder, true, true>((PG8_LAS unsigned char*)lds, g_, S_, E_); } while (0)

    {
        float* scr = smem + wave * 4096;
        const int gw = b0 * NWAVES + wave, NGW = nb * NWAVES;
        constexpr int I_AB = 16 * 97, I_OUT = 16 * 32, I_Q = 16 * 64, I_INC = 16 * 48;
        constexpr int NITEMS = I_AB + I_OUT + 2 * I_Q + I_INC + I_OUT;
        for (int it = gw; it < NITEMS; it += NGW) {
            int r = it;
            if (r < I_AB) { p0_transpose_item(w_in_ab, D, ABN, WAB_T, scr, r, lane); continue; } r -= I_AB;
            if (r < I_OUT) { p0_transpose_item(w_out_ab, D, D, WOUT_T, scr, r, lane); continue; } r -= I_OUT;
            if (r < I_Q) { p0_transpose_item(peer_w_q, D, 2048, WQ0_T, scr, r, lane); continue; } r -= I_Q;
            if (r < I_Q) { p0_transpose_item(peer_w_q + (size_t)D * 2048, D, 2048, WQ1_T, scr, r, lane); continue; } r -= I_Q;
            if (r < I_INC) { p0_transpose_item(w_in_c, D, CN, WINC_T, scr, r, lane); continue; } r -= I_INC;
            p0_transpose_item(w_out_c, D, D, WOUTC_T, scr, r, lane);
        }
        for (int m = gw; m < MP + (ABNP - 97 * 32); m += NGW) {
            if (m < MP) row_to_bf16(m < NP ? x_prompt + (size_t)m * D : (m < NT ? x_sample + (size_t)(m - NP) * D : nullptr), ABUF + (size_t)m * D, lane);
            else row_to_bf16(nullptr, WAB_T + (size_t)(97 * 32 + (m - MP)) * D, lane);
        }
    }
    grid.sync();
    GEMM_PHASE(EpiStoreBf16, ABUF, WAB_T, ABNP, PROJ, ABN, nullptr, NT, ABN);
    GRID_BAR();
    { AbPrepArgs pa;
      pa.PROJ = PROJ; pa.st_gdn_conv = state_gdn_conv; pa.st_lru_conv = state_lru_conv;
      pa.gdn_conv_w = gdn_conv_w; pa.a_log = gdn_a_log; pa.dt_bias = gdn_dt_bias;
      pa.lru_conv_w = lru_conv_w; pa.lru_conv_b = lru_conv_b; pa.w_r = lru_w_r; pa.b_r = lru_b_r; pa.w_i = lru_w_i; pa.b_i = lru_b_i; pa.lam = lru_lam;
      pa.QKV = R_Q; pa.G = R_G; pa.BETA = R_BETA; pa.LA = R_A; pa.LB = R_B;
      pa.p_gdn_conv = o_p_gdn_conv; pa.p_lru_conv = o_p_lru_conv; pa.s_gdn_conv = o_s_gdn_conv; pa.s_lru_conv = o_s_lru_conv;
      PHASE_LOOP(NT) { ab_prep(pa, vb, smem); PHASE_END; } }
    GRID_BAR();
    if (b0 < 64) gdn_scan(R_Q, R_G, R_BETA, nullptr, R_O, o_p_gdn, 0, SEQ, b0 & 3, (b0 >> 2) & 3, b0 >> 4, smem);
    else for (int v = b0 - 64; v < 2048 + 4 + 128; v += nb - 64) {
        if (v < 2048) gdn_scan(R_Q, R_G, R_BETA, state_gdn, R_O, o_s_gdn, NP, 1, v & 3, (v >> 2) & 3, v >> 4, smem);
        else if (v < 2048 + 4) lru_scan(R_A, R_B, nullptr, o_p_lru, 0, SEQ, NB, v - 2048);
        else lru_scan(R_A, R_B, state_lru, o_s_lru, NP, 1, NS, v - (2048 + 4));
        PHASE_END;
    }
    GRID_BAR();
    PHASE_LOOP(NT / 2) { ab_mix(PROJ, R_O, R_B, gdn_norm_w, ABUF, vb); }
    GRID_BAR();
    GEMM_PHASE(EpiStoreF32, ABUF, WOUT_T, D, Y, D, nullptr, NT, D);
    GRID_BAR();
    PHASE_LOOP(NT / 8) { const int t = vb * 8 + wave;
        ln_res_w(t < NP ? x_prompt + (size_t)t * D : x_sample + (size_t)(t - NP) * D, Y + (size_t)t * D, ln_mix_g, ln_mix_b, R_X1 + (size_t)t * D, ABUF + (size_t)t * D, lane); }
    GRID_BAR();
    GEMM_PHASE(EpiStoreF32, ABUF, WQ0_T, 2048, Qb, 2048, nullptr, NT, 2048);
    GRID_BAR();
    PHASE_LOOP((NT / 32) * 8) { peer_topk(Qb, peer_keys, R_EXP, R_GATE, vb >> 3, vb & 7, smem); PHASE_END; }
    GRID_BAR();
    PHASE_LOOP(NT) { peer_expert(R_X1, R_EXP, R_GATE, peer_u, peer_v, ln_ffn_g, ln_ffn_b, X2, ABUF, vb, smem); PHASE_END; }
    GRID_BAR();

    GEMM_PHASE(EpiStoreF32, ABUF, WINC_T, CN, PC, CN, b_in_c, NT, CN);
    GRID_BAR();
    PHASE_LOOP(NT * 2 + (NB * 128 + NS * 128) / 2) {
        if (vb < NT * 2) swa_attn(PC, cache_k, cache_v, rel_bias, swa_sinks, ABUF, vb);
        else swa_kv_out(PC, cache_k, cache_v, o_p_k, o_p_v, o_s_k, o_s_v, vb - NT * 2);
    }
    GRID_BAR();
    GEMM_PHASE(EpiStoreF32, ABUF, WOUTC_T, D, Y1, D, b_out_c, NT, D);
    GRID_BAR();
    PHASE_LOOP(NT / 8) { const int t = vb * 8 + wave;
        ln_res_w(X2 + (size_t)t * D, Y1 + (size_t)t * D, ln_mix_g + D, ln_mix_b + D, X3 + (size_t)t * D, ABUF + (size_t)t * D, lane); }
    GRID_BAR();
    GEMM_PHASE(EpiStoreF32, ABUF, WQ1_T, 2048, Qb, 2048, nullptr, NT, 2048);
    GRID_BAR();
    PHASE_LOOP((NT / 32) * 8) { peer_topk(Qb, peer_keys + (size_t)8 * 2 * 128 * 128, R_EXP, R_GATE, vb >> 3, vb & 7, smem); PHASE_END; }
    GRID_BAR();
    PHASE_LOOP(NT) { peer_expert(X3, R_EXP, R_GATE, peer_u + (size_t)16384 * D, peer_v + (size_t)16384 * D, ln_ffn_g + D, ln_ffn_b + D, o_y, nullptr, vb, smem); PHASE_END; }
}
}

extern "C" void kernel_launch(void* const* d_in, const int* in_sizes, int n_in,
                              void* d_out, int out_size, void* d_ws, size_t ws_size,
                              hipStream_t stream) {
    static int grid_blocks = 0;
    if (!grid_blocks) {
        int dev = 0, cus = 0, per_cu = 0;
        (void)hipGetDevice(&dev);
        (void)hipDeviceGetAttribute(&cus, hipDeviceAttributeMultiprocessorCount, dev);
        if (hipFuncSetAttribute((const void*)fwd_megakernel, hipFuncAttributeMaxDynamicSharedMemorySize, LDS_BYTES) != hipSuccess) { fprintf(stderr, "hipFuncSetAttribute failed\n"); grid_blocks = -1; return; }
        (void)hipOccupancyMaxActiveBlocksPerMultiprocessor(&per_cu, (const void*)fwd_megakernel, NTH, LDS_BYTES);
        if (per_cu < 1) { fprintf(stderr, "occupancy query says %d blocks per CU\n", per_cu); grid_blocks = -1; return; }
        grid_blocks = cus;
    }
    if (grid_blocks < 0) return;
    (void)hipMemsetAsync((char*)d_ws + WS_CTL, 0, CTL_ZERO_BYTES, stream);
    MegaArgs ma{};
    for (int i = 0; i < 35; ++i) ma.in[i] = (const float*)d_in[i];
    ma.out = (float*)d_out;
    ma.ws = (unsigned char*)d_ws;
    void* args[] = {&ma};
    hipError_t e = hipLaunchCooperativeKernel((void*)fwd_megakernel, dim3(grid_blocks), dim3(NTH), args, LDS_BYTES, stream);
    if (e != hipSuccess) fprintf(stderr, "cooperative launch failed: %s (grid %d)\n", hipGetErrorString(e), grid_blocks);
}
```

```cpp
#include <hip/hip_runtime.h>
#include <hip/hip_cooperative_groups.h>
#include <cstdio>
#include <cstdint>
namespace cg = cooperative_groups;

namespace pg8 {
#define PG8_LAS __attribute__((address_space(3)))
typedef unsigned short bf16_t;
typedef short bf16x8 __attribute__((ext_vector_type(8)));
typedef float f32x4 __attribute__((ext_vector_type(4)));
typedef unsigned u32x4 __attribute__((ext_vector_type(4)));
constexpr int BM = 256, BK = 64, HALF = 128, HTB = HALF * BK * 2  , STAGE_BYTES = 8 * HTB, NXCD = 8, WGM = 8;

__host__ __device__ __forceinline__ int lds_byte(int r, int c) { const int st = (r >> 4) * 2 + (c >> 5), rr = r & 15, cc = c & 31, ob = rr * 64 + cc * 2; return st * 1024 + (ob ^ (((ob >> 9) & 1) << 5)); }
__host__ __device__ __forceinline__ void stage_rc(int b, int& R, int& C) { const int st = b / 1024, sb = b % 1024, swz = sb ^ (((sb >> 9) & 1) << 5); R = (st >> 1) * 16 + swz / 64; C = (st & 1) * 32 + (swz % 64) / 2; }
__host__ __device__ __forceinline__ int perm32(int rho) { const int n = rho >> 4, i = rho & 15; return 8 * (i >> 2) + 4 * n + (i & 3); }

struct Unit { int pm, pn; };
struct Gemm { const bf16_t* A; const bf16_t* Bt; int M, N, K; };

struct StaticOrder {
    int nM, nN, nwg, G, c;
    __host__ __device__ void init(int M, int N, int G_, int c_) { nM = M / BM; nN = N / BM; nwg = nM * nN; G = G_; c = c_; }
    __host__ __device__ bool next(int i, Unit& u) const {
        const long L = (long)i * G + c; if (L >= nwg) return false;
        int wgid = (int)L; { const int q = nwg / NXCD, r = nwg % NXCD, xcd = wgid % NXCD, off = wgid / NXCD; wgid = (xcd < r ? xcd * (q + 1) : r * (q + 1) + (xcd - r) * q) + off; }
        const int nig = WGM * nN, gid = wgid / nig, fm = gid * WGM, gsz = (nM - fm) < WGM ? (nM - fm) : WGM;
        u.pm = fm + ((wgid % nig) % gsz); u.pn = (wgid % nig) / gsz; return true;
    }
    __device__ __forceinline__ void a_ready(const Unit&) const {}
    __device__ __forceinline__ void done(const Unit&) const {}
};

__device__ __forceinline__ unsigned cvt_pk_bf16(float lo, float hi) { unsigned r; asm volatile("v_cvt_pk_bf16_f32 %0, %1, %2" : "=v"(r) : "v"(lo), "v"(hi)); return r; }
template <class Epi, class Sched, bool ALIGN_EPI = false, bool SP2 = false>
__device__ __forceinline__ void gemm_phase(PG8_LAS unsigned char* lds, const Gemm g, const Sched& S, const Epi& E) {
    const int tid = threadIdx.x, wid = __builtin_amdgcn_readfirstlane(tid >> 6), lane = tid & 63, wr = wid >> 2, wc = wid & 3, fr = lane & 15, fq = lane >> 4;
    const int K = g.K, nt = K / BK;
    unsigned voffA[2], voffB[2];
#pragma unroll
    for (int i = 0; i < 2; ++i) { int R, C; stage_rc(tid * 16 + i * 8192, R, C); const int Rb = Epi::PERM ? ((R & ~31) + perm32(R & 31)) : R;
        voffA[i] = (unsigned)(R * K + C) * 2u; voffB[i] = (unsigned)(Rb * K + C) * 2u; }
    const size_t kstep = (size_t)(BK * 2);
    const size_t hstep = (size_t)HALF * K * 2;
    const size_t tstep = 2 * hstep;
    const unsigned ldsw = (unsigned)wid * 1024u;
    const int aoff = lds_byte(wr * 64 + fr, fq * 8), boff = lds_byte(wc * 32 + fr, fq * 8);
#define PG8_SA(b, h) (((b) * 2 + (h)) * HTB)
#define PG8_SB(b, h) ((4 + (b) * 2 + (h)) * HTB)
#define PG8_STAGE(bufoff, gbase, voff) do { _Pragma("unroll") for (int _i = 0; _i < 2; ++_i) \
        __builtin_amdgcn_global_load_lds((const unsigned*)((const char*)(gbase) + (voff)[_i]), (PG8_LAS unsigned*)(lds + (bufoff) + ldsw + _i * 8192), 16, 0, 0); } while (0)
#define PG8_LDA(dst, b, h) do { _Pragma("unroll") for (int m = 0; m < 4; ++m) _Pragma("unroll") for (int k = 0; k < 2; ++k) dst[m][k] = *(const PG8_LAS bf16x8*)(lds + PG8_SA(b, h) + aoff + m * 2048 + k * 1024); } while (0)
#define PG8_LDB(dst, b, h) do { _Pragma("unroll") for (int n = 0; n < 2; ++n) _Pragma("unroll") for (int k = 0; k < 2; ++k) dst[n][k] = *(const PG8_LAS bf16x8*)(lds + PG8_SB(b, h) + boff + n * 2048 + k * 1024); } while (0)
#define PG8_MMA(ai, bj, At, Bt) do { __builtin_amdgcn_s_setprio(1); _Pragma("unroll") for (int m = 0; m < 4; ++m) _Pragma("unroll") for (int n = 0; n < 2; ++n) _Pragma("unroll") for (int k = 0; k < 2; ++k) \
        acc[ai][bj][m][n] = __builtin_amdgcn_mfma_f32_16x16x32_bf16(Bt[n][k], At[m][k], acc[ai][bj][m][n], 0, 0, 0); __builtin_amdgcn_s_setprio(0); } while (0)
#define PG8_WAIT_V(n) asm volatile("s_waitcnt vmcnt(" #n ")" ::: "memory")
#define PG8_WAIT_L(n) asm volatile("s_waitcnt lgkmcnt(" #n ")" ::: "memory")
#define PG8_BAR __builtin_amdgcn_s_barrier()
#define PG8_SCHED __builtin_amdgcn_sched_barrier(0)
    Unit cur, nxt; int ui = 0;
    if (!S.next(0, cur)) return;
    f32x4 acc[2][2][4][2];
#pragma unroll
    for (int a = 0; a < 2; ++a)
#pragma unroll
        for (int b = 0; b < 2; ++b)
#pragma unroll
            for (int m = 0; m < 4; ++m)
#pragma unroll
                for (int n = 0; n < 2; ++n) acc[a][b][m][n] = (f32x4){0.f, 0.f, 0.f, 0.f};
    bf16x8 At[4][2], B0[2][2], B1[2][2];
    const char* cA = (const char*)g.A + (size_t)cur.pm * tstep; const char* cB = (const char*)g.Bt + (size_t)cur.pn * tstep;
    S.a_ready(cur);
    if constexpr (SP2) {
        PG8_STAGE(PG8_SB(0, 0), cB, voffB); PG8_STAGE(PG8_SB(0, 1), cB + hstep, voffB); PG8_STAGE(PG8_SA(0, 0), cA, voffA); PG8_STAGE(PG8_SA(0, 1), cA + hstep, voffA);
        if (wr == 1) PG8_BAR;
        PG8_WAIT_V(2); PG8_BAR;
        PG8_STAGE(PG8_SB(1, 0), cB + kstep, voffB); PG8_STAGE(PG8_SA(1, 0), cA + kstep, voffA); PG8_STAGE(PG8_SB(1, 1), cB + hstep + kstep, voffB);
        PG8_WAIT_V(6); PG8_BAR;
    } else {
        PG8_STAGE(PG8_SB(0, 0), cB, voffB); PG8_STAGE(PG8_SA(0, 0), cA, voffA); PG8_STAGE(PG8_SB(0, 1), cB + hstep, voffB); PG8_STAGE(PG8_SA(0, 1), cA + hstep, voffA);
        if (wr == 1) PG8_BAR;
        PG8_WAIT_V(4); PG8_BAR;
        PG8_STAGE(PG8_SB(1, 0), cB + kstep, voffB); PG8_STAGE(PG8_SA(1, 0), cA + kstep, voffA); PG8_STAGE(PG8_SB(1, 1), cB + hstep + kstep, voffB);
        PG8_WAIT_V(6); PG8_BAR;
    }
    for (;;) {
        const bool has_next = S.next(ui + 1, nxt);
        const char* nA = has_next ? (const char*)g.A + (size_t)nxt.pm * tstep : cA; const char* nB = has_next ? (const char*)g.Bt + (size_t)nxt.pn * tstep : cB;
        for (int t = 0; t < nt; t += 2) {
            const bool last = (t == nt - 2);
            const char* a1 = cA + (size_t)(t + 1) * kstep;
            const char* a2 = last ? nA : cA + (size_t)(t + 2) * kstep; const char* b2 = last ? nB : cB + (size_t)(t + 2) * kstep;
            const char* a3 = a2 + kstep; const char* b3 = b2 + kstep;
            if (last && has_next) S.a_ready(nxt);
            if constexpr (SP2) {
            PG8_LDB(B0, 0, 0); PG8_LDB(B1, 0, 1); PG8_SCHED; PG8_LDA(At, 0, 0); PG8_STAGE(PG8_SA(1, 1), a1 + hstep, voffA);
            PG8_WAIT_V(8); PG8_WAIT_L(0); PG8_BAR; PG8_MMA(0, 0, At, B0); PG8_MMA(0, 1, At, B1); PG8_BAR; PG8_SCHED;
            PG8_LDA(At, 0, 1); PG8_STAGE(PG8_SB(0, 0), b2, voffB); PG8_STAGE(PG8_SB(0, 1), b2 + hstep, voffB); PG8_STAGE(PG8_SA(0, 0), a2, voffA);
            PG8_WAIT_V(8); PG8_WAIT_L(0); PG8_BAR; PG8_MMA(1, 0, At, B0); PG8_MMA(1, 1, At, B1); PG8_BAR; PG8_SCHED;
            PG8_LDB(B0, 1, 0); PG8_LDB(B1, 1, 1); PG8_SCHED; PG8_LDA(At, 1, 0); PG8_STAGE(PG8_SA(0, 1), a2 + hstep, voffA);
            PG8_WAIT_V(8); PG8_WAIT_L(0); PG8_BAR; PG8_MMA(0, 0, At, B0); PG8_MMA(0, 1, At, B1); PG8_BAR; PG8_SCHED;
            PG8_LDA(At, 1, 1); PG8_STAGE(PG8_SB(1, 0), b3, voffB); PG8_STAGE(PG8_SB(1, 1), b3 + hstep, voffB); PG8_STAGE(PG8_SA(1, 0), a3, voffA);
            PG8_WAIT_V(8); PG8_WAIT_L(0); PG8_BAR; PG8_MMA(1, 0, At, B0); PG8_MMA(1, 1, At, B1); PG8_BAR; PG8_SCHED;
            } else {
            PG8_LDB(B0, 0, 0); PG8_SCHED; PG8_LDA(At, 0, 0); PG8_STAGE(PG8_SA(1, 1), a1 + hstep, voffA);
            PG8_WAIT_L(8); PG8_BAR; PG8_WAIT_L(0); PG8_MMA(0, 0, At, B0); PG8_BAR; PG8_SCHED;
            PG8_LDB(B1, 0, 1); PG8_STAGE(PG8_SB(0, 0), b2, voffB);
            PG8_BAR; PG8_WAIT_L(0); PG8_MMA(0, 1, At, B1); PG8_BAR;
            PG8_LDA(At, 0, 1); PG8_STAGE(PG8_SA(0, 0), a2, voffA);
            PG8_BAR; PG8_WAIT_L(0); PG8_MMA(1, 0, At, B0); PG8_BAR; PG8_SCHED;
            PG8_STAGE(PG8_SB(0, 1), b2 + hstep, voffB);
            PG8_WAIT_V(6); PG8_BAR; PG8_MMA(1, 1, At, B1); PG8_BAR;
            PG8_LDB(B0, 1, 0); PG8_SCHED; PG8_LDA(At, 1, 0); PG8_STAGE(PG8_SA(0, 1), a2 + hstep, voffA);
            PG8_WAIT_L(8); PG8_BAR; PG8_WAIT_L(0); PG8_MMA(0, 0, At, B0); PG8_BAR; PG8_SCHED;
            PG8_LDB(B1, 1, 1); PG8_STAGE(PG8_SB(1, 0), b3, voffB);
            PG8_BAR; PG8_WAIT_L(0); PG8_MMA(0, 1, At, B1); PG8_BAR;
            PG8_LDA(At, 1, 1); PG8_STAGE(PG8_SA(1, 0), a3, voffA);
            PG8_BAR; PG8_WAIT_L(0); PG8_MMA(1, 0, At, B0); PG8_BAR; PG8_SCHED;
            PG8_STAGE(PG8_SB(1, 1), b3 + hstep, voffB);
            PG8_WAIT_V(6); PG8_BAR; PG8_MMA(1, 1, At, B1); PG8_BAR;
            }
        }
        if constexpr (ALIGN_EPI) { if (wr == 0) PG8_BAR; }
        if constexpr (!Epi::AFTER_DRAIN) { E(acc, cur, wr, wc, fr, fq); S.done(cur); }
        if (!has_next) break;
#pragma unroll
        for (int a = 0; a < 2; ++a)
#pragma unroll
            for (int b = 0; b < 2; ++b)
#pragma unroll
                for (int m = 0; m < 4; ++m)
#pragma unroll
                    for (int n = 0; n < 2; ++n) acc[a][b][m][n] = (f32x4){0.f, 0.f, 0.f, 0.f};
        cur = nxt; cA = nA; cB = nB; ++ui;
        if constexpr (ALIGN_EPI) { if (wr == 1) PG8_BAR; }
    }
    PG8_WAIT_V(0);
    if constexpr (!ALIGN_EPI) { if (wr == 0) PG8_BAR; }
    PG8_BAR;
    if constexpr (Epi::AFTER_DRAIN) { E.fused(acc, cur, wr, wc, fr, fq, lds, wid, lane); S.done(cur); }
#undef PG8_SA
#undef PG8_SB
#undef PG8_STAGE
#undef PG8_LDA
#undef PG8_LDB
#undef PG8_MMA
#undef PG8_WAIT_V
#undef PG8_WAIT_L
#undef PG8_BAR
#undef PG8_SCHED
}
}
namespace pg8 {
struct EpiStoreBf16 {
    static constexpr bool PERM = true, AFTER_DRAIN = false;
    bf16_t* O; int ldc; const float* bias; int m_real, n_real;
    __device__ __forceinline__ void operator()(const f32x4 (&acc)[2][2][4][2], const Unit& u, int wr, int wc, int fr, int fq) const {
        const int row0 = u.pm * BM + wr * 64 + fr, col0 = u.pn * BM + wc * 32 + 8 * fq;
#pragma unroll
        for (int bj = 0; bj < 2; ++bj) {
            const int col = col0 + bj * HALF;
            if (col >= n_real) continue;
            f32x4 b0 = (f32x4){0.f, 0.f, 0.f, 0.f}, b1 = b0;
            if (bias) { b0 = *(const f32x4*)(bias + col); b1 = *(const f32x4*)(bias + col + 4); }
#pragma unroll
            for (int ai = 0; ai < 2; ++ai)
#pragma unroll
                for (int m = 0; m < 4; ++m) {
                    const int row = row0 + ai * HALF + m * 16;
                    if (row >= m_real) continue;
                    const f32x4 v0 = acc[ai][bj][m][0] + b0, v1 = acc[ai][bj][m][1] + b1;
                    u32x4 w; w.x = cvt_pk_bf16(v0[0], v0[1]); w.y = cvt_pk_bf16(v0[2], v0[3]); w.z = cvt_pk_bf16(v1[0], v1[1]); w.w = cvt_pk_bf16(v1[2], v1[3]);
                    *(u32x4*)(O + (size_t)row * ldc + col) = w;
                }
        }
    }
};
struct EpiStoreF32 {
    static constexpr bool PERM = false, AFTER_DRAIN = false;
    float* O; int ldc; const float* bias; int m_real, n_real;
    __device__ __forceinline__ void operator()(const f32x4 (&acc)[2][2][4][2], const Unit& u, int wr, int wc, int fr, int fq) const {
        const int row0 = u.pm * BM + wr * 64 + fr, col0 = u.pn * BM + wc * 32 + 4 * fq;
#pragma unroll
        for (int bj = 0; bj < 2; ++bj)
#pragma unroll
            for (int n = 0; n < 2; ++n) {
                const int col = col0 + bj * HALF + n * 16;
                if (col >= n_real) continue;
                const f32x4 bv = bias ? *(const f32x4*)(bias + col) : (f32x4){0.f, 0.f, 0.f, 0.f};
#pragma unroll
                for (int ai = 0; ai < 2; ++ai)
#pragma unroll
                    for (int m = 0; m < 4; ++m) {
                        const int row = row0 + ai * HALF + m * 16;
                        if (row >= m_real) continue;
                        *(f32x4*)(O + (size_t)row * ldc + col) = acc[ai][bj][m][n] + bv;
                    }
            }
    }
};
}
namespace {
#define GAS __attribute__((address_space(1)))
#define LAS __attribute__((address_space(3)))
typedef unsigned short bf16;
typedef float f32x4 __attribute__((ext_vector_type(4)));
typedef unsigned v4u __attribute__((ext_vector_type(4)));
typedef unsigned v2u __attribute__((ext_vector_type(2)));

constexpr int D = 1024, NB = 4, SEQ = 4096, NP = NB * SEQ, NS = 128, NT = NP + NS, MP = 16640;
constexpr int ABN = 3080, ABNP = 3328;
constexpr int C_QKV = 0, C_Z = 1536, C_A = 2048, C_B = 2052, C_XR = 2056, C_GATE = 2568;
constexpr int CN = 1536;
constexpr float ALPHA = 1.4142135623730951f;
constexpr float LN_EPS = 1e-5f;
constexpr int NTH = 512, NWAVES = 8;
constexpr int RING_BYTES = 131072, MISC_OFF = RING_BYTES + 320, LDS_BYTES = 147456;

__device__ __forceinline__ float bf2f(bf16 v) { return __uint_as_float((unsigned)v << 16); }
__device__ __forceinline__ unsigned f2bf(float f) { unsigned u = __float_as_uint(f); return (u + 0x7fffu + ((u >> 16) & 1u)) >> 16; }
__device__ __forceinline__ unsigned pk2(float lo, float hi) { return f2bf(lo) | (f2bf(hi) << 16); }
__device__ __forceinline__ float sigmoidf_(float x) { return 1.0f / (1.0f + expf(-x)); }
__device__ __forceinline__ float softplusf_(float x) { return fmaxf(x, 0.f) + log1pf(expf(-fabsf(x))); }
__device__ __forceinline__ float siluf_(float x) { return x / (1.0f + expf(-x)); }
__device__ __forceinline__ float geluf_(float x) { return 0.5f * x * (1.0f + tanhf(0.7978845608028654f * (x + 0.044715f * x * x * x))); }
__device__ __forceinline__ float wave_sum(float v) {
#pragma unroll
    for (int o = 32; o > 0; o >>= 1) v += __shfl_xor(v, o);
    return v;
}
__device__ __forceinline__ float wave_max(float v) {
#pragma unroll
    for (int o = 32; o > 0; o >>= 1) v = fmaxf(v, __shfl_xor(v, o));
    return v;
}

__device__ __forceinline__ void p0_transpose_item(const float* __restrict__ W, int K, int N, bf16* __restrict__ WT, float* scr, int item, int lane) {
    const int nblk = (N + 31) / 32, kb = item / nblk, nb = item % nblk, k0 = 64 * kb, n0 = 32 * nb;
#pragma unroll 8
    for (int i = 0; i < 32; ++i) { const int kk = 2 * i + (lane >> 5), n = n0 + (lane & 31); scr[kk * 33 + (lane & 31)] = n < N ? W[(size_t)(k0 + kk) * N + n] : 0.f; }
    asm volatile("s_waitcnt lgkmcnt(0)" ::: "memory");
    const int c = lane & 7;
#pragma unroll
    for (int j = 0; j < 4; ++j) { const int n = (lane >> 3) + 8 * j; const float* s = scr + (8 * c) * 33 + n;
        v4u o; o.x = pk2(s[0 * 33], s[1 * 33]); o.y = pk2(s[2 * 33], s[3 * 33]); o.z = pk2(s[4 * 33], s[5 * 33]); o.w = pk2(s[6 * 33], s[7 * 33]);
        *(v4u*)(WT + (size_t)(n0 + n) * K + k0 + 8 * c) = o; }
    asm volatile("s_waitcnt lgkmcnt(0)" ::: "memory");
}
__device__ __forceinline__ void row_to_bf16(const float* __restrict__ xrow, bf16* __restrict__ orow, int lane) {
#pragma unroll
    for (int j = 0; j < 4; ++j) {
        f32x4 v = (f32x4){0.f, 0.f, 0.f, 0.f};
        if (xrow) v = ((const f32x4*)xrow)[lane + 64 * j];
        v2u o; o.x = pk2(v.x, v.y); o.y = pk2(v.z, v.w);
        ((v2u*)orow)[lane + 64 * j] = o;
    }
}

struct AbPrepArgs {
    const bf16* PROJ; const float* st_gdn_conv; const float* st_lru_conv;
    const float* gdn_conv_w; const float* a_log; const float* dt_bias;
    const float* lru_conv_w; const float* lru_conv_b; const float* w_r; const float* b_r; const float* w_i; const float* b_i; const float* lam;
    float* QKV; float* G; float* BETA; float* LA; float* LB;
    float* p_gdn_conv; float* p_lru_conv; float* s_gdn_conv; float* s_lru_conv;
};
__device__ __forceinline__ void ab_prep(const AbPrepArgs& a, int t, float* smem) {
    const int tid = threadIdx.x, lane = tid & 63, wid = tid >> 6;
    const bool samp = t >= NP; const int sb = t - NP, pos = t % SEQ, b = t / SEQ;
    float* sq = smem;
    float* sx = smem + 1536;
    float* scl = smem + 2048;
    const bf16* prow = a.PROJ + (size_t)t * ABN;
    for (int c = tid; c < 1536; c += NTH) {
        float acc = 0.f;
#pragma unroll
        for (int i = 0; i < 4; ++i) {
            float xv;
            if (i == 3) xv = bf2f(prow[C_QKV + c]);
            else if (samp) xv = a.st_gdn_conv[((size_t)sb * 3 + i) * 1536 + c];
            else xv = (pos - 3 + i >= 0) ? bf2f(a.PROJ[(size_t)(t - 3 + i) * ABN + C_QKV + c]) : 0.f;
            acc += a.gdn_conv_w[i * 1536 + c] * xv;
        }
        sq[c] = siluf_(acc);
    }
    {
        const int c = tid;
        float acc = a.lru_conv_b[c];
#pragma unroll
        for (int i = 0; i < 4; ++i) {
            float xv;
            if (i == 3) xv = bf2f(prow[C_XR + c]);
            else if (samp) xv = a.st_lru_conv[((size_t)sb * 3 + i) * 512 + c];
            else xv = (pos - 3 + i >= 0) ? bf2f(a.PROJ[(size_t)(t - 3 + i) * ABN + C_XR + c]) : 0.f;
            acc += a.lru_conv_w[i * 512 + c] * xv;
        }
        sx[c] = acc;
    }
    __syncthreads();
    {
        const int grp = wid;
        const float v0 = sq[grp * 128 + lane], v1 = sq[grp * 128 + 64 + lane];
        const float s = wave_sum(v0 * v0 + v1 * v1);
        if (lane == 0) scl[grp] = rsqrtf(s + 1e-6f) * (grp < 4 ? 0.08838834764831845f : 1.0f);
    }
    __syncthreads();
    for (int c = tid; c < 1536; c += NTH) a.QKV[(size_t)t * 1536 + c] = (c < 1024) ? sq[c] * scl[c >> 7] : sq[c];
    if (tid < 4) {
        const float a_raw = bf2f(prow[C_A + tid]), b_raw = bf2f(prow[C_B + tid]);
        a.G[(size_t)t * 4 + tid] = -expf(a.a_log[tid]) * softplusf_(a_raw + a.dt_bias[tid]);
        a.BETA[(size_t)t * 4 + tid] = sigmoidf_(b_raw);
    }
    if (!samp) {
        if (pos >= SEQ - 3) {
            const int row = pos - (SEQ - 3);
            for (int c = tid; c < 1536; c += NTH) a.p_gdn_conv[((size_t)b * 3 + row) * 1536 + c] = bf2f(prow[C_QKV + c]);
            a.p_lru_conv[((size_t)b * 3 + row) * 512 + tid] = bf2f(prow[C_XR + tid]);
        }
    } else {
        for (int c = tid; c < 1536; c += NTH) {
            a.s_gdn_conv[((size_t)sb * 3 + 0) * 1536 + c] = a.st_gdn_conv[((size_t)sb * 3 + 1) * 1536 + c];
            a.s_gdn_conv[((size_t)sb * 3 + 1) * 1536 + c] = a.st_gdn_conv[((size_t)sb * 3 + 2) * 1536 + c];
            a.s_gdn_conv[((size_t)sb * 3 + 2) * 1536 + c] = bf2f(prow[C_QKV + c]);
        }
        {
            const int c = tid;
            a.s_lru_conv[((size_t)sb * 3 + 0) * 512 + c] = a.st_lru_conv[((size_t)sb * 3 + 1) * 512 + c];
            a.s_lru_conv[((size_t)sb * 3 + 1) * 512 + c] = a.st_lru_conv[((size_t)sb * 3 + 2) * 512 + c];
            a.s_lru_conv[((size_t)sb * 3 + 2) * 512 + c] = bf2f(prow[C_XR + c]);
        }
    }
    {
        const int c = tid, n = c >> 6, d = c & 63;
        float r = a.b_r[c], ii = a.b_i[c];
#pragma unroll 4
        for (int cc = 0; cc < 64; ++cc) {
            const float xv = sx[n * 64 + cc];
            r += xv * a.w_r[((size_t)n * 64 + cc) * 64 + d];
            ii += xv * a.w_i[((size_t)n * 64 + cc) * 64 + d];
        }
        r = sigmoidf_(r); ii = sigmoidf_(ii);
        const float log_a = -8.0f * r * softplusf_(-a.lam[c]);
        a.LA[(size_t)t * 512 + c] = expf(log_a);
        a.LB[(size_t)t * 512 + c] = sqrtf(-expm1f(2.0f * log_a)) * (ii * sx[c]);
    }
}

__device__ __forceinline__ void gdn_scan(const float* __restrict__ QKV, const float* __restrict__ G, const float* __restrict__ BETA,
                                         const float* __restrict__ S0, float* __restrict__ O, float* __restrict__ Sout, int tok_base, int T,
                                         int sl, int h, int sq, float* smem) {
    const int tid = threadIdx.x, dvl = tid & 31, kg = tid >> 5;
    const int dv = sl * 32 + dvl;
    float (*red1)[32] = (float (*)[32])smem;
    float (*red2)[32] = (float (*)[32])(smem + 512);
    float S[8];
#pragma unroll
    for (int i = 0; i < 8; ++i) S[i] = S0 ? S0[(((size_t)sq * 4 + h) * 128 + kg * 8 + i) * 128 + dv] : 0.f;
    float kk[8], qq[8], vv, g, be;
    {
        const size_t tok = (size_t)tok_base + (size_t)sq * T;
        const float* row = QKV + tok * 1536;
#pragma unroll
        for (int i = 0; i < 8; ++i) { kk[i] = row[512 + h * 128 + kg * 8 + i]; qq[i] = row[h * 128 + kg * 8 + i]; }
        vv = row[1024 + h * 128 + dv]; g = G[tok * 4 + h]; be = BETA[tok * 4 + h];
    }
    for (int t = 0; t < T; ++t) {
        const size_t tok = (size_t)tok_base + (size_t)sq * T + t;
        float nk[8], nq[8], nv = 0.f, ng = 0.f, nb = 0.f;
        if (t + 1 < T) {
            const float* row = QKV + (tok + 1) * 1536;
#pragma unroll
            for (int i = 0; i < 8; ++i) { nk[i] = row[512 + h * 128 + kg * 8 + i]; nq[i] = row[h * 128 + kg * 8 + i]; }
            nv = row[1024 + h * 128 + dv]; ng = G[(tok + 1) * 4 + h]; nb = BETA[(tok + 1) * 4 + h];
        } else {
#pragma unroll
            for (int i = 0; i < 8; ++i) { nk[i] = 0.f; nq[i] = 0.f; }
        }
        const float al = expf(g);
        float p = 0.f;
#pragma unroll
        for (int i = 0; i < 8; ++i) { S[i] *= al; p += S[i] * kk[i]; }
        red1[kg][dvl] = p;
        __syncthreads();
        float ks = 0.f;
#pragma unroll
        for (int j = 0; j < 16; ++j) ks += red1[j][dvl];
        const float vn = be * (vv - ks);
        float o = 0.f;
#pragma unroll
        for (int i = 0; i < 8; ++i) { S[i] += kk[i] * vn; o += S[i] * qq[i]; }
        red2[kg][dvl] = o;
        __syncthreads();
        if (kg == 0) {
            float os = 0.f;
#pragma unroll
            for (int j = 0; j < 16; ++j) os += red2[j][dvl];
            O[tok * 512 + h * 128 + dv] = os;
        }
#pragma unroll
        for (int i = 0; i < 8; ++i) { kk[i] = nk[i]; qq[i] = nq[i]; }
        vv = nv; g = ng; be = nb;
    }
#pragma unroll
    for (int i = 0; i < 8; ++i) Sout[(((size_t)sq * 4 + h) * 128 + kg * 8 + i) * 128 + dv] = S[i];
}

__device__ __forceinline__ void lru_scan(const float* __restrict__ LA, float* __restrict__ LB, const float* __restrict__ h0,
                                         float* __restrict__ hlast, int tok_base, int T, int nseq, int bx) {
    const int idx = bx * NTH + threadIdx.x;
    if (idx >= nseq * 512) return;
    const int sq = idx / 512, c = idx % 512;
    float h = h0 ? h0[(size_t)sq * 512 + c] : 0.f;
    const size_t base = ((size_t)tok_base + (size_t)sq * T) * 512 + c;
#pragma unroll 8
    for (int t = 0; t < T; ++t) {
        const size_t o = base + (size_t)t * 512;
        h = LA[o] * h + LB[o];
        LB[o] = h;
    }
    hlast[(size_t)sq * 512 + c] = h;
}

__device__ __forceinline__ void ab_mix(const bf16* __restrict__ PROJ, const float* __restrict__ O, const float* __restrict__ H, const float* __restrict__ P, const float* __restrict__ CIN,
                                       const float* __restrict__ norm_w, bf16* __restrict__ MIX, int vb) {
    const int tid = threadIdx.x & 255, lane = tid & 63, wid = tid >> 6, t = vb * 2 + (threadIdx.x >> 8);
    const bf16* prow = PROJ + (size_t)t * ABN;
    {
        const int h = wid;
        const float o0 = O[(size_t)t * 512 + h * 128 + lane], o1 = O[(size_t)t * 512 + h * 128 + 64 + lane];
        const float ms = wave_sum(o0 * o0 + o1 * o1) * (1.0f / 128.0f);
        const float sc = rsqrtf(ms + 1e-6f);
        MIX[(size_t)t * 1024 + h * 128 + lane] = (bf16)f2bf(o0 * sc * norm_w[lane] * siluf_(bf2f(prow[C_Z + h * 128 + lane])));
        MIX[(size_t)t * 1024 + h * 128 + 64 + lane] = (bf16)f2bf(o1 * sc * norm_w[64 + lane] * siluf_(bf2f(prow[C_Z + h * 128 + 64 + lane])));
    }
    for (int c = tid; c < 512; c += 256) {
        float hv = H[(size_t)t * 512 + c];
        if (t < NP) hv += P[(size_t)t * 512 + c] * CIN[(size_t)(t >> 6) * 512 + c];
        MIX[(size_t)t * 1024 + 512 + c] = (bf16)f2bf(geluf_(bf2f(prow[C_GATE + c])) * hv);
    }
}

__device__ __forceinline__ void ln_res_w(const float* __restrict__ xrow, const float* __restrict__ yrow, const float* __restrict__ g, const float* __restrict__ bta,
                                         float* __restrict__ orow, bf16* __restrict__ obrow, int lane) {
    f32x4 v[4]; float s = 0.f;
#pragma unroll
    for (int j = 0; j < 4; ++j) { const f32x4 x4 = ((const f32x4*)xrow)[lane + 64 * j], y4 = ((const f32x4*)yrow)[lane + 64 * j]; v[j] = x4 * ALPHA + y4; s += (v[j].x + v[j].y) + (v[j].z + v[j].w); }
    const float mean = wave_sum(s) * (1.0f / 1024.0f); float q = 0.f;
#pragma unroll
    for (int j = 0; j < 4; ++j) { v[j] = v[j] - mean; q += (v[j].x * v[j].x + v[j].y * v[j].y) + (v[j].z * v[j].z + v[j].w * v[j].w); }
    const float rs = rsqrtf(wave_sum(q) * (1.0f / 1024.0f) + LN_EPS);
#pragma unroll
    for (int j = 0; j < 4; ++j) {
        const f32x4 g4 = ((const f32x4*)g)[lane + 64 * j], b4 = ((const f32x4*)bta)[lane + 64 * j];
        const f32x4 o = v[j] * rs * g4 + b4;
        ((f32x4*)orow)[lane + 64 * j] = o;
        v2u ob; ob.x = pk2(o.x, o.y); ob.y = pk2(o.z, o.w);
        ((v2u*)obrow)[lane + 64 * j] = ob;
    }
}

__device__ __forceinline__ void peer_topk(const bf16* __restrict__ Q, const float* __restrict__ keys, int* __restrict__ EXP, float* __restrict__ GATE,
                                          int tg, int h, float* smem) {
    const int tid = threadIdx.x, cn = tid & 255, c = cn >> 7, n = cn & 127, th = tid >> 8;
    float (*sq)[256] = (float (*)[256])smem;
    float (*ss)[257] = (float (*)[257])(smem + 32 * 256);
    float (*tvs)[2][16] = (float (*)[2][16])(smem + 32 * 256 + 32 * 257 + 32);
    int (*tis)[2][16] = (int (*)[2][16])(smem + 32 * 256 + 32 * 257 + 32 + 1024);
    for (int i = tid; i < 32 * 256; i += NTH) {
        const int tk = i >> 8, col = i & 255;
        sq[tk][col] = bf2f(Q[(size_t)(tg * 32 + tk) * 2048 + h * 256 + col]);
    }
    __syncthreads();
    float acc[16];
#pragma unroll
    for (int i = 0; i < 16; ++i) acc[i] = 0.f;
    const float* krow = keys + (((size_t)h * 2 + c) * 128 + n) * 128;
    for (int d4 = 0; d4 < 32; ++d4) {
        const float4 kv = *(const float4*)(krow + d4 * 4);
#pragma unroll
        for (int tk = 0; tk < 16; ++tk) {
            const float4 qv = *(const float4*)&sq[th * 16 + tk][c * 128 + d4 * 4];
            acc[tk] += qv.x * kv.x + qv.y * kv.y + qv.z * kv.z + qv.w * kv.w;
        }
    }
#pragma unroll
    for (int tk = 0; tk < 16; ++tk) ss[th * 16 + tk][cn] = acc[tk];
    __syncthreads();
    if (tid < 64) {
        const int tk = tid >> 1, cc = tid & 1;
        float tv[16]; int ti[16];
#pragma unroll
        for (int j = 0; j < 16; ++j) { tv[j] = -INFINITY; ti[j] = 0; }
        for (int nn = 0; nn < 128; ++nn) {
            float x = ss[tk][cc * 128 + nn]; int xi = nn;
#pragma unroll
            for (int j = 0; j < 16; ++j) {
                const bool gt = x > tv[j];
                const float tf = tv[j]; const int tj = ti[j];
                tv[j] = gt ? x : tf; ti[j] = gt ? xi : tj;
                x = gt ? tf : x; xi = gt ? tj : xi;
            }
        }
#pragma unroll
        for (int j = 0; j < 16; ++j) { tvs[tk][cc][j] = tv[j]; tis[tk][cc][j] = ti[j]; }
    }
    __syncthreads();
    if (tid < 32) {
        const int tk = tid;
        float bv[16]; int bi[16];
#pragma unroll
        for (int j = 0; j < 16; ++j) { bv[j] = -INFINITY; bi[j] = 0; }
        for (int i = 0; i < 16; ++i)
            for (int jj = 0; jj < 16; ++jj) {
                float x = tvs[tk][0][i] + tvs[tk][1][jj]; int xi = tis[tk][0][i] * 128 + tis[tk][1][jj];
#pragma unroll
                for (int j = 0; j < 16; ++j) {
                    const bool gt = x > bv[j];
                    const float tf = bv[j]; const int tj = bi[j];
                    bv[j] = gt ? x : tf; bi[j] = gt ? xi : tj;
                    x = gt ? tf : x; xi = gt ? tj : xi;
                }
            }
        float e[16], sum = 0.f;
#pragma unroll
        for (int j = 0; j < 16; ++j) { e[j] = expf(bv[j] - bv[0]); sum += e[j]; }
        const float inv = 1.0f / sum;
        const size_t o = (size_t)(tg * 32 + tk) * 128 + h * 16;
#pragma unroll
        for (int j = 0; j < 16; ++j) { EXP[o + j] = bi[j]; GATE[o + j] = e[j] * inv; }
    }
}

__device__ __forceinline__ void peer_expert(const float* __restrict__ X, const int* __restrict__ EXP, const float* __restrict__ GATE,
                                            const float* __restrict__ U, const float* __restrict__ V,
                                            const float* __restrict__ g, const float* __restrict__ bta, float* __restrict__ out, bf16* __restrict__ outb, int t, float* smem) {
    const int tid = threadIdx.x, lane = tid & 63, wid = tid >> 6;
    float (*accs)[1024] = (float (*)[1024])smem;
    float* sred = smem + 8192;
    const float4* xr = (const float4*)(X + (size_t)t * D);
    float4 xv[4];
#pragma unroll
    for (int j = 0; j < 4; ++j) xv[j] = xr[lane + 64 * j];
    float4 acc[4];
#pragma unroll
    for (int j = 0; j < 4; ++j) acc[j] = make_float4(0.f, 0.f, 0.f, 0.f);
    for (int e = 0; e < 16; ++e) {
        const int id = EXP[(size_t)t * 128 + wid * 16 + e];
        const float gt = GATE[(size_t)t * 128 + wid * 16 + e];
        const float4* ur = (const float4*)(U + (size_t)id * D);
        const float4* vr = (const float4*)(V + (size_t)id * D);
        float4 uv[4], vv[4];
#pragma unroll
        for (int j = 0; j < 4; ++j) { uv[j] = ur[lane + 64 * j]; vv[j] = vr[lane + 64 * j]; }
        float dot = 0.f;
#pragma unroll
        for (int j = 0; j < 4; ++j) dot += uv[j].x * xv[j].x + uv[j].y * xv[j].y + uv[j].z * xv[j].z + uv[j].w * xv[j].w;
        dot = wave_sum(dot);
        const float cf = gt * geluf_(dot);
#pragma unroll
        for (int j = 0; j < 4; ++j) { acc[j].x += cf * vv[j].x; acc[j].y += cf * vv[j].y; acc[j].z += cf * vv[j].z; acc[j].w += cf * vv[j].w; }
    }
#pragma unroll
    for (int j = 0; j < 4; ++j) *(float4*)&accs[wid][(lane + 64 * j) * 4] = acc[j];
    __syncthreads();
    float v[2];
#pragma unroll
    for (int i = 0; i < 2; ++i) {
        const int c = tid * 2 + i;
        float s = 0.f;
#pragma unroll
        for (int w = 0; w < 8; ++w) s += accs[w][c];
        v[i] = ALPHA * X[(size_t)t * D + c] + s;
    }
    float s = wave_sum(v[0] + v[1]);
    if (lane == 0) sred[wid] = s;
    __syncthreads();
    float mean = 0.f;
#pragma unroll
    for (int w = 0; w < 8; ++w) mean += sred[w];
    mean *= (1.0f / 1024.0f);
    __syncthreads();
    const float d0 = v[0] - mean, d1 = v[1] - mean;
    float q = wave_sum(d0 * d0 + d1 * d1);
    if (lane == 0) sred[wid] = q;
    __syncthreads();
    float var = 0.f;
#pragma unroll
    for (int w = 0; w < 8; ++w) var += sred[w];
    const float rs = rsqrtf(var * (1.0f / 1024.0f) + LN_EPS);
    const float o0 = d0 * rs * g[tid * 2] + bta[tid * 2], o1 = d1 * rs * g[tid * 2 + 1] + bta[tid * 2 + 1];
    *(float2*)(out + (size_t)t * D + tid * 2) = make_float2(o0, o1);
    if (outb) *(unsigned*)(outb + (size_t)t * D + tid * 2) = pk2(o0, o1);
}


typedef __bf16 bf16x2_t __attribute__((ext_vector_type(2)));
__device__ __forceinline__ float dot2bf(unsigned w, unsigned x, float acc) { return __builtin_amdgcn_fdot2_f32_bf16(__builtin_bit_cast(bf16x2_t, w), __builtin_bit_cast(bf16x2_t, x), acc, false); }
__device__ __forceinline__ float bflo(unsigned w) { return __uint_as_float(w << 16); }
__device__ __forceinline__ float bfhi(unsigned w) { return __uint_as_float(w & 0xffff0000u); }
#define PE_LOAD(UB, VB, grp) do { _Pragma("unroll") for (int i_ = 0; i_ < 2; ++i_) { const int e_ = (grp) * 2 + i_; \
        const int id_ = __builtin_amdgcn_readlane(e_ < 64 ? id0 : id1, e_ & 63); \
        const unsigned so_ = (unsigned)id_ * 2048u; \
        UB[i_][0] = __builtin_amdgcn_raw_buffer_load_b128(ursrc, voff, so_, 0); UB[i_][1] = __builtin_amdgcn_raw_buffer_load_b128(ursrc, voff + 1024, so_, 0); \
        VB[i_][0] = __builtin_amdgcn_raw_buffer_load_b128(vrsrc, voff, so_, 0); VB[i_][1] = __builtin_amdgcn_raw_buffer_load_b128(vrsrc, voff + 1024, so_, 0); } } while (0)
#define PE_COMP(UB, VB, grp) do { float d_[2]; \
        _Pragma("unroll") for (int i_ = 0; i_ < 2; ++i_) { float a_ = 0.f, b_ = 0.f; \
            a_ = dot2bf(UB[i_][0].x, xb[0].x, a_); b_ = dot2bf(UB[i_][0].y, xb[0].y, b_); a_ = dot2bf(UB[i_][0].z, xb[0].z, a_); b_ = dot2bf(UB[i_][0].w, xb[0].w, b_); \
            a_ = dot2bf(UB[i_][1].x, xb[1].x, a_); b_ = dot2bf(UB[i_][1].y, xb[1].y, b_); a_ = dot2bf(UB[i_][1].z, xb[1].z, a_); b_ = dot2bf(UB[i_][1].w, xb[1].w, b_); d_[i_] = a_ + b_; } \
          \
        float r_ = hi32 ? d_[1] : d_[0], t0_ = hi32 ? d_[0] : d_[1]; r_ += __shfl_xor(t0_, 32); \
        r_ += __shfl_xor(r_, 16); r_ += __shfl_xor(r_, 8); r_ += __shfl_xor(r_, 4); r_ += __shfl_xor(r_, 2); r_ += __shfl_xor(r_, 1); \
        const float cfl_ = geluf_(r_); \
        _Pragma("unroll") for (int i_ = 0; i_ < 2; ++i_) { const int e_ = (grp) * 2 + i_; \
            const float cf_ = __uint_as_float(__builtin_amdgcn_readlane(__float_as_uint(cfl_), 32 * i_)) * __uint_as_float(__builtin_amdgcn_readlane(__float_as_uint(e_ < 64 ? g0 : g1), e_ & 63)); \
            _Pragma("unroll") for (int j_ = 0; j_ < 2; ++j_) { \
                acc[j_ * 8 + 0] += cf_ * bflo(VB[i_][j_].x); acc[j_ * 8 + 1] += cf_ * bfhi(VB[i_][j_].x); acc[j_ * 8 + 2] += cf_ * bflo(VB[i_][j_].y); acc[j_ * 8 + 3] += cf_ * bfhi(VB[i_][j_].y); \
                acc[j_ * 8 + 4] += cf_ * bflo(VB[i_][j_].z); acc[j_ * 8 + 5] += cf_ * bfhi(VB[i_][j_].z); acc[j_ * 8 + 6] += cf_ * bflo(VB[i_][j_].w); acc[j_ * 8 + 7] += cf_ * bfhi(VB[i_][j_].w); } } } while (0)
__device__ __forceinline__ void peer_expert_w(const float* __restrict__ xrow, const bf16* __restrict__ xbrow, const int* __restrict__ exr, const float* __restrict__ gar,
                                              const bf16* __restrict__ U, const bf16* __restrict__ V,
                                              const float* __restrict__ g, const float* __restrict__ bta, float* __restrict__ orow, bf16* __restrict__ obrow, int lane) {
    const bool hi32 = (lane & 32) != 0;
    const __amdgpu_buffer_rsrc_t ursrc = __builtin_amdgcn_make_buffer_rsrc((void*)U, 0, 16384 * 2048, 0x00020000);
    const __amdgpu_buffer_rsrc_t vrsrc = __builtin_amdgcn_make_buffer_rsrc((void*)V, 0, 16384 * 2048, 0x00020000);
    const int voff = lane * 16;
    v4u xb[2]; xb[0] = *(const v4u*)(xbrow + lane * 8); xb[1] = *(const v4u*)(xbrow + 512 + lane * 8);
    const int id0 = exr[lane], id1 = exr[64 + lane]; const float g0 = gar[lane], g1 = gar[64 + lane];
    float acc[16];
#pragma unroll
    for (int i = 0; i < 16; ++i) acc[i] = 0.f;
    v4u ua[2][2], va[2][2], ub[2][2], vb[2][2];
    PE_LOAD(ua, va, 0);
#pragma unroll 1
    for (int grp = 0; grp < 64; grp += 2) {
        PE_LOAD(ub, vb, grp + 1);
        PE_COMP(ua, va, grp);
        if (grp + 2 < 64) PE_LOAD(ua, va, grp + 2);
        PE_COMP(ub, vb, grp + 1);
    }
    float v[16]; float s = 0.f;
#pragma unroll
    for (int j = 0; j < 2; ++j) {
        const f32x4 x0 = *(const f32x4*)(xrow + j * 512 + lane * 8), x1 = *(const f32x4*)(xrow + j * 512 + lane * 8 + 4);
        v[j * 8 + 0] = ALPHA * x0.x + acc[j * 8 + 0]; v[j * 8 + 1] = ALPHA * x0.y + acc[j * 8 + 1]; v[j * 8 + 2] = ALPHA * x0.z + acc[j * 8 + 2]; v[j * 8 + 3] = ALPHA * x0.w + acc[j * 8 + 3];
        v[j * 8 + 4] = ALPHA * x1.x + acc[j * 8 + 4]; v[j * 8 + 5] = ALPHA * x1.y + acc[j * 8 + 5]; v[j * 8 + 6] = ALPHA * x1.z + acc[j * 8 + 6]; v[j * 8 + 7] = ALPHA * x1.w + acc[j * 8 + 7];
    }
#pragma unroll
    for (int i = 0; i < 16; ++i) s += v[i];
    const float mean = wave_sum(s) * (1.0f / 1024.0f); float q = 0.f;
#pragma unroll
    for (int i = 0; i < 16; ++i) { v[i] -= mean; q += v[i] * v[i]; }
    const float rs = rsqrtf(wave_sum(q) * (1.0f / 1024.0f) + LN_EPS);
#pragma unroll
    for (int j = 0; j < 2; ++j) {
        const int c0 = j * 512 + lane * 8;
        const f32x4 ga = *(const f32x4*)(g + c0), gb = *(const f32x4*)(g + c0 + 4), ba = *(const f32x4*)(bta + c0), bb = *(const f32x4*)(bta + c0 + 4);
        f32x4 oa, ob;
        oa.x = v[j * 8 + 0] * rs * ga.x + ba.x; oa.y = v[j * 8 + 1] * rs * ga.y + ba.y; oa.z = v[j * 8 + 2] * rs * ga.z + ba.z; oa.w = v[j * 8 + 3] * rs * ga.w + ba.w;
        ob.x = v[j * 8 + 4] * rs * gb.x + bb.x; ob.y = v[j * 8 + 5] * rs * gb.y + bb.y; ob.z = v[j * 8 + 6] * rs * gb.z + bb.z; ob.w = v[j * 8 + 7] * rs * gb.w + bb.w;
        *(f32x4*)(orow + c0) = oa; *(f32x4*)(orow + c0 + 4) = ob;
        if (obrow) { v4u w; w.x = pk2(oa.x, oa.y); w.y = pk2(oa.z, oa.w); w.z = pk2(ob.x, ob.y); w.w = pk2(ob.z, ob.w); *(v4u*)(obrow + c0) = w; }
    }
}

__device__ __forceinline__ int t5_bucket(int n) {
    if (n < 16) return n;
    const int large = 16 + (int)(logf((float)n / 16.0f) / 2.0794415416798357f * 16.0f);
    return large < 31 ? large : 31;
}
__device__ __forceinline__ void swa_attn(const float* __restrict__ PC, const float* __restrict__ cache_k, const float* __restrict__ cache_v,
                                         const float* __restrict__ rel_bias, const float* __restrict__ sinks, bf16* __restrict__ ATT, int bx) {
    const int tid = threadIdx.x, lane = tid & 63, wid = tid >> 6;
    const int gw = bx * 8 + wid;
    const int t = gw >> 4, h = gw & 15, kvh = h >> 2;
    if (t >= NT) return;
    const bool samp = t >= NP; const int sb = t - NP, pos = t % SEQ;
    const float* qrow = PC + (size_t)t * CN + h * 64;
    float lg[2]; bool valid[2];
#pragma unroll
    for (int rr = 0; rr < 2; ++rr) {
        const int r = lane + 64 * rr;
        const float* krow;
        if (!samp) { valid[rr] = (pos - r) >= 0; krow = PC + (size_t)(valid[rr] ? t - r : t) * CN + 1024 + kvh * 64; }
        else { valid[rr] = true; krow = (r == 0) ? PC + (size_t)t * CN + 1024 + kvh * 64 : cache_k + (((size_t)sb * 128 + (128 - r)) * 4 + kvh) * 64; }
        float dot = 0.f;
#pragma unroll
        for (int d4 = 0; d4 < 16; ++d4) {
            const float4 kv = *(const float4*)(krow + d4 * 4);
            const float4 qv = *(const float4*)(qrow + d4 * 4);
            dot += qv.x * kv.x + qv.y * kv.y + qv.z * kv.z + qv.w * kv.w;
        }
        lg[rr] = valid[rr] ? dot * 0.125f + rel_bias[t5_bucket(r) * 16 + h] : -INFINITY;
    }
    const float sink = sinks[h];
    const float m = fmaxf(wave_max(fmaxf(lg[0], lg[1])), sink);
    float p[2];
#pragma unroll
    for (int rr = 0; rr < 2; ++rr) p[rr] = valid[rr] ? expf(lg[rr] - m) : 0.f;
    const float den = wave_sum(p[0] + p[1]) + expf(sink - m);
    const float inv = 1.0f / den;
    float o = 0.f;
#pragma unroll
    for (int rr = 0; rr < 2; ++rr)
        for (int l2 = 0; l2 < 64; ++l2) {
            const int r = l2 + 64 * rr;
            const float pj = __shfl(p[rr], l2);
            if (pj != 0.f) {
                const float* vrow;
                if (!samp) vrow = PC + (size_t)(t - r) * CN + 1280 + kvh * 64;
                else vrow = (r == 0) ? PC + (size_t)t * CN + 1280 + kvh * 64 : cache_v + (((size_t)sb * 128 + (128 - r)) * 4 + kvh) * 64;
                o += pj * vrow[lane];
            }
        }
    ATT[(size_t)t * D + h * 64 + lane] = (bf16)f2bf(o * inv);
}

__device__ __forceinline__ void swa_kv_out(const float* __restrict__ PC, const float* __restrict__ cache_k, const float* __restrict__ cache_v,
                                           float* __restrict__ pk, float* __restrict__ pv, float* __restrict__ sk, float* __restrict__ sv, int vb) {
    const int c = threadIdx.x & 255, row = vb * 2 + (threadIdx.x >> 8);
    if (row < NB * 128) {
        const int b = row >> 7, i = row & 127;
        const float* src = PC + (size_t)(b * SEQ + SEQ - 128 + i) * CN;
        pk[(size_t)row * 256 + c] = src[1024 + c];
        pv[(size_t)row * 256 + c] = src[1280 + c];
    } else {
        const int r2 = row - NB * 128, sb = r2 >> 7, i = r2 & 127;
        if (i < 127) {
            sk[(size_t)r2 * 256 + c] = cache_k[((size_t)sb * 128 + i + 1) * 256 + c];
            sv[(size_t)r2 * 256 + c] = cache_v[((size_t)sb * 128 + i + 1) * 256 + c];
        } else {
            const float* src = PC + (size_t)(NP + sb) * CN;
            sk[(size_t)r2 * 256 + c] = src[1024 + c];
            sv[(size_t)r2 * 256 + c] = src[1280 + c];
        }
    }
}
#define XB_TMO      128
#define XB_XCNT(j)  (256  + 64 * (j))
#define XB_XSUB(j)  (1280 + 64 * (j))
#define XB_XGEN(j)  (2304 + 64 * (j))
#define XB_TOP      3328
#define XB_TOPGEN   3392
#define XCD_BAR_WORDS 3456
#define XB_SPIN_CAP (1u << 18)

__device__ __forceinline__ unsigned xb_ld(unsigned* p)              { return __hip_atomic_load(p, __ATOMIC_RELAXED, __HIP_MEMORY_SCOPE_AGENT); }
__device__ __forceinline__ unsigned xb_add(unsigned* p, unsigned v) { return __hip_atomic_fetch_add(p, v, __ATOMIC_RELAXED, __HIP_MEMORY_SCOPE_AGENT); }
__device__ __forceinline__ unsigned xb_xcc_id() { return (unsigned)__builtin_amdgcn_s_getreg((3 << 11) | 20) & 0xFu; }
#define XB_SPIN(cond, bar) do { unsigned _sp = 0; while (cond) { __builtin_amdgcn_s_sleep(1); \
    if ((++_sp & 255u) == 0u) { if (xb_ld(&(bar)[XB_TMO])) break; if (_sp > XB_SPIN_CAP) { atomicAdd(&(bar)[XB_TMO], 1u); break; } } } } while (0)

struct XcdBarrier {
    unsigned* bar; unsigned x;
    volatile LAS unsigned* st;
};

__device__ __forceinline__ XcdBarrier xcd_barrier_post(unsigned* bar, volatile LAS unsigned* st) {
    XcdBarrier b; b.bar = bar; b.x = xb_xcc_id(); b.st = st;
    if (threadIdx.x == 0) (void)xb_add(&bar[XB_XCNT(b.x)], 1u);
    return b;
}
__device__ __forceinline__ void xcd_barrier_complete(unsigned* bar, unsigned x, unsigned& nloc, unsigned& nx) {
    const unsigned G = gridDim.x * gridDim.y * gridDim.z;
    unsigned sum, cnt, mine, sp = 0u;
    for (;;) {
        sum = 0u; cnt = 0u; mine = 0u;
#pragma unroll
        for (unsigned j = 0; j < 16; ++j) { const unsigned c = xb_ld(&bar[XB_XCNT(j)]); sum += c; cnt += (c > 0u) ? 1u : 0u; mine = (j == x) ? c : mine; }
        if (sum == G) break;
        __builtin_amdgcn_s_sleep(1);
        if ((++sp & 255u) == 0u) { if (xb_ld(&bar[XB_TMO])) break; if (sp > XB_SPIN_CAP) { atomicAdd(&bar[XB_TMO], 1u); break; } }
    }
    nloc = mine > 0u ? mine : 1u; nx = cnt > 0u ? cnt : 1u;
}

__device__ __forceinline__ void xcd_barrier(const XcdBarrier& b) {
    asm volatile("s_waitcnt vmcnt(0)" ::: "memory");
    __syncthreads();
    if (threadIdx.x == 0) {
        unsigned* bar = b.bar;
        __builtin_amdgcn_s_waitcnt(0);
        unsigned nloc = b.st[0], nx = b.st[1];
        if (nloc == 0u) { xcd_barrier_complete(bar, b.x, nloc, nx); b.st[0] = nloc; b.st[1] = nx; }
        const unsigned old = xb_add(&bar[XB_XSUB(b.x)], 1u);
        const unsigned gen = old / nloc;
        if (old + 1u == (gen + 1u) * nloc) {
            __builtin_amdgcn_fence(__ATOMIC_RELEASE, "agent");
            asm volatile("s_waitcnt vmcnt(0)" ::: "memory");
            const unsigned og = xb_add(&bar[XB_TOP], 1u);
            const unsigned tg = og / nx;
            if (og + 1u == (tg + 1u) * nx) xb_add(&bar[XB_TOPGEN], 1u);
            else XB_SPIN(xb_ld(&bar[XB_TOPGEN]) == tg, bar);
            __builtin_amdgcn_fence(__ATOMIC_ACQUIRE, "agent");
            xb_add(&bar[XB_XGEN(b.x)], 1u);
            asm volatile("s_waitcnt vmcnt(0)" ::: "memory");
        } else {
            XB_SPIN(xb_ld(&bar[XB_XGEN(b.x)]) == gen, bar);
            __builtin_amdgcn_fence(__ATOMIC_ACQUIRE, "agent");
            asm volatile("s_waitcnt vmcnt(0)" ::: "memory");
        }
    }
    __syncthreads();
}

typedef short bf16x8_t __attribute__((ext_vector_type(8)));
__device__ __forceinline__ f32x4 mfma16(bf16x8_t a, bf16x8_t b, f32x4 c) { return __builtin_amdgcn_mfma_f32_16x16x32_bf16(a, b, c, 0, 0, 0); }

struct GdnChunkBufs {
    bf16* W;
    bf16* QG;
    bf16* KDT;
    bf16* UT;
    bf16* QK;
    float* EGL;
};

constexpr int GP_QB = 0, GP_KB = 17408, GP_VB = 34816, GP_LS = 52224, GP_QKS = 69632, GP_WS = 78848, GP_SC = 96256;

__device__ __forceinline__ void gdn_prep_unit(const bf16* __restrict__ PROJ, const float* __restrict__ conv_w, const float* __restrict__ a_log, const float* __restrict__ dt_bias,
                                              const GdnChunkBufs& cb, float* __restrict__ p_gdn_conv, int un, unsigned char* lds) {
    int tid = threadIdx.x; asm volatile("" : "+v"(tid));
    const int lane = tid & 63, wave = __builtin_amdgcn_readfirstlane(tid >> 6), fr = lane & 15, fq = lane >> 4;
    const int h = un & 3, n = (un >> 2) & 63, b = un >> 8;
    const int t0 = b * SEQ + n * 64;
    bf16* Qb = (bf16*)(lds + GP_QB); bf16* Kb = (bf16*)(lds + GP_KB); bf16* Vb = (bf16*)(lds + GP_VB); bf16* Ws = (bf16*)(lds + GP_WS);
    float* Ls = (float*)(lds + GP_LS); bf16* QKs = (bf16*)(lds + GP_QKS);
    float* gcs = (float*)(lds + GP_SC); float* bets = gcs + 64; float* egcs = gcs + 128; float* ekds = gcs + 192; float* begs = gcs + 256;
    if (wave == 0) {
        const bf16* prow = PROJ + (size_t)(t0 + lane) * ABN;
        const float a_raw = bf2f(prow[C_A + h]), b_raw = bf2f(prow[C_B + h]);
        float g = -expf(a_log[h]) * softplusf_(a_raw + dt_bias[h]);
#pragma unroll
        for (int off = 1; off < 64; off <<= 1) { const float v = __shfl_up(g, off); if (lane >= off) g += v; }
        const float glast = __shfl(g, 63);
        { const float be_ = sigmoidf_(b_raw), eg_ = expf(g); gcs[lane] = g; bets[lane] = be_; egcs[lane] = eg_; ekds[lane] = expf(glast - g); begs[lane] = be_ * eg_; }
        if (lane == 0) cb.EGL[un] = expf(glast);
    }
    {
        int cols[6]; float cw[4][6], xw[3][6];
#pragma unroll
        for (int p = 0; p < 3; ++p)
#pragma unroll
            for (int e = 0; e < 2; ++e) cols[p * 2 + e] = p * 512 + h * 128 + e * 64 + lane;
#pragma unroll
        for (int i = 0; i < 4; ++i)
#pragma unroll
            for (int c = 0; c < 6; ++c) cw[i][c] = conv_w[i * 1536 + cols[c]];
        const int i0 = wave * 8;
#pragma unroll
        for (int k = 0; k < 3; ++k) {
            const int pos = n * 64 + i0 - 3 + k;
#pragma unroll
            for (int c = 0; c < 6; ++c) xw[k][c] = pos >= 0 ? bf2f(PROJ[(size_t)(t0 + i0 - 3 + k) * ABN + cols[c]]) : 0.f;
        }
#pragma unroll
        for (int ii = 0; ii < 8; ++ii) {
            const int i = i0 + ii;
            float xt[6], s[6];
#pragma unroll
            for (int c = 0; c < 6; ++c) xt[c] = bf2f(PROJ[(size_t)(t0 + i) * ABN + cols[c]]);
#pragma unroll
            for (int c = 0; c < 6; ++c) s[c] = siluf_(cw[0][c] * xw[0][c] + cw[1][c] * xw[1][c] + cw[2][c] * xw[2][c] + cw[3][c] * xt[c]);
            const float qs = rsqrtf(wave_sum(s[0] * s[0] + s[1] * s[1]) + 1e-6f) * 0.08838834764831845f;
            const float ks = rsqrtf(wave_sum(s[2] * s[2] + s[3] * s[3]) + 1e-6f);
            Qb[i * 136 + lane] = (bf16)f2bf(s[0] * qs); Qb[i * 136 + 64 + lane] = (bf16)f2bf(s[1] * qs);
            Kb[i * 136 + lane] = (bf16)f2bf(s[2] * ks); Kb[i * 136 + 64 + lane] = (bf16)f2bf(s[3] * ks);
            Vb[i * 136 + lane] = (bf16)f2bf(s[4]);      Vb[i * 136 + 64 + lane] = (bf16)f2bf(s[5]);
            if (n == 63 && i >= 61) {
#pragma unroll
                for (int c = 0; c < 6; ++c) p_gdn_conv[((size_t)b * 3 + (i - 61)) * 1536 + cols[c]] = xt[c];
            }
#pragma unroll
            for (int c = 0; c < 6; ++c) { xw[0][c] = xw[1][c]; xw[1][c] = xw[2][c]; xw[2][c] = xt[c]; }
        }
    }
    __syncthreads();
    {
        const int mi = wave >> 1;
        bf16x8_t aK[4], aQ[4];
#pragma unroll
        for (int ks = 0; ks < 4; ++ks) { aK[ks] = *(const bf16x8_t*)(Kb + (mi * 16 + fr) * 136 + ks * 32 + 8 * fq); aQ[ks] = *(const bf16x8_t*)(Qb + (mi * 16 + fr) * 136 + ks * 32 + 8 * fq); }
#pragma unroll
        for (int nn = 0; nn < 2; ++nn) {
            const int nj = (wave & 1) * 2 + nn;
            f32x4 accK = (f32x4){0.f, 0.f, 0.f, 0.f}, accQ = accK;
#pragma unroll
            for (int ks = 0; ks < 4; ++ks) { const bf16x8_t bk = *(const bf16x8_t*)(Kb + (nj * 16 + fr) * 136 + ks * 32 + 8 * fq); accK = mfma16(aK[ks], bk, accK); accQ = mfma16(aQ[ks], bk, accQ); }
            const int j = nj * 16 + fr; const float gj = gcs[j];
#pragma unroll
            for (int r = 0; r < 4; ++r) {
                const int i = mi * 16 + 4 * fq + r;
                const float dec = i >= j ? expf(gcs[i] - gj) : 0.f;
                Ls[i * 68 + j] = i > j ? bets[i] * accK[r] * dec : 0.f;
                QKs[i * 72 + j] = (bf16)f2bf(i >= j ? accQ[r] * dec : 0.f);
            }
        }
    }
    __syncthreads();
    if (wave < 4) {
        float x[64];
        const bool isu = tid < 128; const int c = isu ? tid : tid - 128;
        const LAS unsigned char* l3 = (const LAS unsigned char*)lds;
        unsigned so = (isu ? GP_VB : GP_KB) + c * 2, ro = GP_SC + (isu ? 64 * 4 : 256 * 4), lo = GP_LS;
        asm volatile("" : "+v"(so), "+v"(ro), "+v"(lo));
#pragma unroll
        for (int i = 0; i < 64; ++i) {
            float acc = *(const LAS float*)(l3 + ro + 4 * i) * bf2f(*(const LAS bf16*)(l3 + so + i * 272));
#pragma unroll
            for (int j4 = 0; j4 < (i + 3) / 4; ++j4) {
                const f32x4 l4 = *(const LAS f32x4*)(l3 + lo + i * 272 + j4 * 16);
                acc -= l4.x * x[j4 * 4 + 0];
                if (j4 * 4 + 1 < i) acc -= l4.y * x[j4 * 4 + 1];
                if (j4 * 4 + 2 < i) acc -= l4.z * x[j4 * 4 + 2];
                if (j4 * 4 + 3 < i) acc -= l4.w * x[j4 * 4 + 3];
            }
            x[i] = acc;
        }
        if (isu) {
            bf16* dst = cb.UT + ((size_t)un * 128 + c) * 64;
#pragma unroll
            for (int i8 = 0; i8 < 8; ++i8) { v4u o; o.x = pk2(x[i8 * 8 + 0], x[i8 * 8 + 1]); o.y = pk2(x[i8 * 8 + 2], x[i8 * 8 + 3]); o.z = pk2(x[i8 * 8 + 4], x[i8 * 8 + 5]); o.w = pk2(x[i8 * 8 + 6], x[i8 * 8 + 7]); *(v4u*)(dst + i8 * 8) = o; }
        } else {
#pragma unroll
            for (int i = 0; i < 64; ++i) Ws[i * 136 + c] = (bf16)f2bf(x[i]);
        }
    } else {
        const int t2 = tid - 256;
#pragma unroll
        for (int k = 0; k < 4; ++k) {
            const int ci = t2 + 256 * k, i = ci >> 4, d0 = (ci & 15) * 8; const float e = egcs[i];
            const v4u q = *(const v4u*)(Qb + i * 136 + d0);
            v4u o; o.x = pk2(bflo(q.x) * e, bfhi(q.x) * e); o.y = pk2(bflo(q.y) * e, bfhi(q.y) * e); o.z = pk2(bflo(q.z) * e, bfhi(q.z) * e); o.w = pk2(bflo(q.w) * e, bfhi(q.w) * e);
            *(v4u*)(cb.QG + ((size_t)un * 64 + i) * 128 + d0) = o;
        }
#pragma unroll
        for (int k = 0; k < 4; ++k) {
            const int ci = t2 + 256 * k, d = ci & 127, i0 = (ci >> 7) * 8;
            float v[8];
#pragma unroll
            for (int q = 0; q < 8; ++q) v[q] = bf2f(Kb[(i0 + q) * 136 + d]) * ekds[i0 + q];
            v4u o; o.x = pk2(v[0], v[1]); o.y = pk2(v[2], v[3]); o.z = pk2(v[4], v[5]); o.w = pk2(v[6], v[7]);
            *(v4u*)(cb.KDT + ((size_t)un * 128 + d) * 64 + i0) = o;
        }
#pragma unroll
        for (int k = 0; k < 2; ++k) {
            const int ci = t2 + 256 * k, i = ci >> 3, j0 = (ci & 7) * 8;
            *(v4u*)(cb.QK + ((size_t)un * 64 + i) * 64 + j0) = *(const v4u*)(QKs + i * 72 + j0);
        }
    }
    __syncthreads();
#pragma unroll
    for (int k = 0; k < 2; ++k) {
        const int ci = tid + 512 * k, i = ci >> 4, d0 = (ci & 15) * 8;
        *(v4u*)(cb.W + ((size_t)un * 64 + i) * 128 + d0) = *(const v4u*)(Ws + i * 136 + d0);
    }
    __syncthreads();
}

constexpr int GS_ST = 0, GS_VNT = 2 * 32 * 136 * 2, GS_END = GS_VNT + 32 * 72 * 2;
__device__ __forceinline__ void gdn_seq(const GdnChunkBufs& cb, float* __restrict__ O, float* __restrict__ Sout, int b, int h, int sl, unsigned char* lds) {
    int tid = threadIdx.x; asm volatile("" : "+v"(tid));
    const int lane = tid & 63, wave = __builtin_amdgcn_readfirstlane(tid >> 6), fr = lane & 15, fq = lane >> 4;
    const int mi = wave >> 1, nj = wave & 1;
    bf16* St = (bf16*)(lds + GS_ST); bf16* VnT = (bf16*)(lds + GS_VNT);
    for (int i = tid; i < 2 * 32 * 136 / 2; i += NTH) ((unsigned*)St)[i] = 0u;
    f32x4 accS[2]; accS[0] = (f32x4){0.f, 0.f, 0.f, 0.f}; accS[1] = accS[0];
    bf16x8_t aW[4], aQG[4], aQK[2], aKD[2]; v2u ut; float egl;
#define GS_LOAD(un_) do { const size_t u_ = (size_t)(un_); \
        _Pragma("unroll") for (int ks = 0; ks < 4; ++ks) { aW[ks] = *(const bf16x8_t*)(cb.W + (u_ * 64 + mi * 16 + fr) * 128 + ks * 32 + 8 * fq); aQG[ks] = *(const bf16x8_t*)(cb.QG + (u_ * 64 + mi * 16 + fr) * 128 + ks * 32 + 8 * fq); } \
        _Pragma("unroll") for (int ks = 0; ks < 2; ++ks) { aQK[ks] = *(const bf16x8_t*)(cb.QK + (u_ * 64 + mi * 16 + fr) * 64 + ks * 32 + 8 * fq); aKD[ks] = *(const bf16x8_t*)(cb.KDT + (u_ * 128 + wave * 16 + fr) * 64 + ks * 32 + 8 * fq); } \
        ut = *(const v2u*)(cb.UT + (u_ * 128 + sl * 32 + nj * 16 + fr) * 64 + mi * 16 + 4 * fq); egl = cb.EGL[u_]; } while (0)
    int cur = 0;
    for (int n = 0; n < 64; ++n) {
        const int un = (b * 64 + n) * 4 + h;
        GS_LOAD(un);
        __syncthreads();
        f32x4 accW = (f32x4){0.f, 0.f, 0.f, 0.f}, accO = accW;
        const bf16* Sc = St + cur * 32 * 136;
#pragma unroll
        for (int ks = 0; ks < 4; ++ks) { const bf16x8_t bs = *(const bf16x8_t*)(Sc + (nj * 16 + fr) * 136 + ks * 32 + 8 * fq); accW = mfma16(aW[ks], bs, accW); accO = mfma16(aQG[ks], bs, accO); }
        const float v0 = bflo(ut.x) - accW[0], v1 = bfhi(ut.x) - accW[1], v2 = bflo(ut.y) - accW[2], v3 = bfhi(ut.y) - accW[3];
        { v2u o; o.x = pk2(v0, v1); o.y = pk2(v2, v3); *(v2u*)(VnT + (nj * 16 + fr) * 72 + mi * 16 + 4 * fq) = o; }
        __syncthreads();
#pragma unroll
        for (int ks = 0; ks < 2; ++ks) { const bf16x8_t bv = *(const bf16x8_t*)(VnT + (nj * 16 + fr) * 72 + ks * 32 + 8 * fq); accO = mfma16(aQK[ks], bv, accO); }
        {
            float* orow = O + (size_t)(b * SEQ + n * 64 + mi * 16 + 4 * fq) * 512 + h * 128 + sl * 32 + nj * 16 + fr;
            orow[0] = accO[0]; orow[512] = accO[1]; orow[1024] = accO[2]; orow[1536] = accO[3];
        }
        bf16* Sn = St + (cur ^ 1) * 32 * 136;
#pragma unroll
        for (int njj = 0; njj < 2; ++njj) {
            accS[njj] = accS[njj] * egl;
#pragma unroll
            for (int ks = 0; ks < 2; ++ks) { const bf16x8_t bv = *(const bf16x8_t*)(VnT + (njj * 16 + fr) * 72 + ks * 32 + 8 * fq); accS[njj] = mfma16(aKD[ks], bv, accS[njj]); }
            v2u o; o.x = pk2(accS[njj][0], accS[njj][1]); o.y = pk2(accS[njj][2], accS[njj][3]);
            *(v2u*)(Sn + (njj * 16 + fr) * 136 + wave * 16 + 4 * fq) = o;
        }
        cur ^= 1;
    }
#undef GS_LOAD
#pragma unroll
    for (int njj = 0; njj < 2; ++njj)
#pragma unroll
        for (int r = 0; r < 4; ++r) Sout[(((size_t)b * 4 + h) * 128 + wave * 16 + 4 * fq + r) * 128 + sl * 32 + njj * 16 + fr] = accS[njj][r];
    __syncthreads();
}

__device__ __forceinline__ void lru_prep_unit(const bf16* __restrict__ PROJ, const float* __restrict__ conv_w, const float* __restrict__ conv_b,
                                              const float* __restrict__ w_r, const float* __restrict__ b_r, const float* __restrict__ w_i, const float* __restrict__ b_i, const float* __restrict__ lam,
                                              float* __restrict__ H, float* __restrict__ P, float* __restrict__ Hend, float* __restrict__ Pend, float* __restrict__ p_lru_conv, int ub) {
    int c = threadIdx.x; asm volatile("" : "+v"(c));
    const int nblk = c >> 6, d = c & 63;
    const int n = ub & 63, b = ub >> 6, t0 = b * SEQ + n * 64;
    float wr[64], wi[64];
#pragma unroll
    for (int cc = 0; cc < 64; ++cc) { wr[cc] = w_r[((size_t)nblk * 64 + cc) * 64 + d]; wi[cc] = w_i[((size_t)nblk * 64 + cc) * 64 + d]; }
    const float cw0 = conv_w[c], cw1 = conv_w[512 + c], cw2 = conv_w[1024 + c], cw3 = conv_w[1536 + c], cb_ = conv_b[c];
    const float br = b_r[c], bi = b_i[c], spl = -8.0f * softplusf_(-lam[c]);
    float x0 = (n * 64 - 3 >= 0) ? bf2f(PROJ[(size_t)(t0 - 3) * ABN + C_XR + c]) : 0.f;
    float x1 = (n * 64 - 2 >= 0) ? bf2f(PROJ[(size_t)(t0 - 2) * ABN + C_XR + c]) : 0.f;
    float x2 = (n * 64 - 1 >= 0) ? bf2f(PROJ[(size_t)(t0 - 1) * ABN + C_XR + c]) : 0.f;
    float hloc = 0.f, ploc = 1.f;
    for (int i = 0; i < 64; ++i) {
        const float xt = bf2f(PROJ[(size_t)(t0 + i) * ABN + C_XR + c]);
        const float xr = cb_ + cw0 * x0 + cw1 * x1 + cw2 * x2 + cw3 * xt;
        float r = br, ii = bi;
#pragma unroll
        for (int cc = 0; cc < 64; ++cc) { const float xv = __uint_as_float(__builtin_amdgcn_readlane(__float_as_uint(xr), cc)); r += xv * wr[cc]; ii += xv * wi[cc]; }
        r = sigmoidf_(r); ii = sigmoidf_(ii);
        const float log_a = spl * r;
        const float a = expf(log_a), bb = sqrtf(-expm1f(2.0f * log_a)) * (ii * xr);
        hloc = a * hloc + bb; ploc *= a;
        H[(size_t)(t0 + i) * 512 + c] = hloc; P[(size_t)(t0 + i) * 512 + c] = ploc;
        if (n == 63 && i >= 61) p_lru_conv[((size_t)b * 3 + (i - 61)) * 512 + c] = xt;
        x0 = x1; x1 = x2; x2 = xt;
    }
    Hend[(size_t)ub * 512 + c] = hloc; Pend[(size_t)ub * 512 + c] = ploc;
}
__device__ __forceinline__ void lru_carry(const float* __restrict__ Hend, const float* __restrict__ Pend, float* __restrict__ CIN, float* __restrict__ hlast, int bx) {
    const int idx = bx * NTH + threadIdx.x, b = idx >> 9, c = idx & 511;
    float carry = 0.f;
#pragma unroll 8
    for (int n = 0; n < 64; ++n) {
        const size_t o = ((size_t)b * 64 + n) * 512 + c;
        CIN[o] = carry;
        carry = Hend[o] + Pend[o] * carry;
    }
    hlast[(size_t)b * 512 + c] = carry;
}

constexpr size_t MiB = 1u << 20;
constexpr size_t WS_CTL = 0, CTL_ZERO_BYTES = 64 * 1024;
constexpr size_t WS_WAB = 1 * MiB;
constexpr size_t WS_WOUT = WS_WAB + (size_t)ABNP * D * 2;
constexpr size_t WS_WQ0 = WS_WOUT + (size_t)D * D * 2;
constexpr size_t WS_WQ1 = WS_WQ0 + (size_t)2048 * D * 2;
constexpr size_t WS_WINC = WS_WQ1 + (size_t)2048 * D * 2;
constexpr size_t WS_WOUTC = WS_WINC + (size_t)CN * D * 2;
constexpr size_t WS_ABUF = WS_WOUTC + (size_t)D * D * 2;
constexpr size_t WS_P = WS_ABUF + (size_t)MP * D * 2;
constexpr size_t WS_T = WS_P + (size_t)MP * ABN * 2;
constexpr size_t WS_Q = WS_T + (size_t)2 * 16384 * D * 2;
constexpr size_t WS_A = WS_Q + (size_t)MP * 1536 * 4;
constexpr size_t WS_B = WS_A + (size_t)MP * 512 * 4;
constexpr size_t WS_O = WS_B + (size_t)MP * 512 * 4;
constexpr size_t WS_X1 = WS_O + (size_t)MP * 512 * 4;
constexpr size_t WS_G = WS_X1 + (size_t)MP * D * 4;
constexpr size_t WS_BETA = WS_G + (size_t)MP * 4 * 4;
constexpr size_t WS_GATE = WS_BETA + (size_t)MP * 4 * 4;
constexpr size_t WS_EXP = WS_GATE + (size_t)MP * 128 * 4;
constexpr size_t WS_HEND = WS_EXP + (size_t)MP * 128 * 4;
constexpr size_t WS_END = WS_HEND + (size_t)3 * 4 * 64 * 512 * 4;
constexpr size_t Q_QKVS = 0, Q_W = 1 * MiB, Q_QG = Q_W + 16 * MiB, Q_KDT = Q_QG + 16 * MiB, Q_UT = Q_KDT + 16 * MiB, Q_QK = Q_UT + 16 * MiB, Q_EGL = Q_QK + 8 * MiB, Q_END = Q_EGL + 4096;
static_assert(Q_END <= (size_t)MP * 1536 * 4, "region Q");
static_assert(WS_END <= 512 * MiB, "d_ws map");

struct MegaArgs {
    const float* in[35];
    float* out;
    unsigned char* ws;
};

__global__ void __launch_bounds__(NTH, 2) fwd_megakernel(MegaArgs ma) {
    cg::grid_group grid = cg::this_grid();
    extern __shared__ __attribute__((aligned(16))) unsigned char lds[];
    float* smem = (float*)lds;
    const int nb = gridDim.x, b0 = blockIdx.x, tid = threadIdx.x, lane = tid & 63, wave = __builtin_amdgcn_readfirstlane(tid >> 6);
    const float* x_prompt = ma.in[0];
    const float* x_sample = ma.in[1];
    const float* state_gdn = ma.in[2];
    const float* state_gdn_conv = ma.in[3];
    const float* state_lru = ma.in[4];
    const float* state_lru_conv = ma.in[5];
    const float* cache_k = ma.in[6];
    const float* cache_v = ma.in[7];
    const float* w_in_ab = ma.in[8];
    const float* gdn_conv_w = ma.in[9];
    const float* gdn_a_log = ma.in[10];
    const float* gdn_dt_bias = ma.in[11];
    const float* gdn_norm_w = ma.in[12];
    const float* lru_conv_w = ma.in[13];
    const float* lru_conv_b = ma.in[14];
    const float* lru_w_r = ma.in[15];
    const float* lru_b_r = ma.in[16];
    const float* lru_w_i = ma.in[17];
    const float* lru_b_i = ma.in[18];
    const float* lru_lam = ma.in[19];
    const float* w_out_ab = ma.in[20];
    const float* w_in_c = ma.in[21];
    const float* b_in_c = ma.in[22];
    const float* swa_sinks = ma.in[23];
    const float* w_out_c = ma.in[24];
    const float* b_out_c = ma.in[25];
    const float* rel_bias = ma.in[26];
    const float* ln_mix_g = ma.in[27];
    const float* ln_mix_b = ma.in[28];
    const float* ln_ffn_g = ma.in[29];
    const float* ln_ffn_b = ma.in[30];
    const float* peer_w_q = ma.in[31];
    const float* peer_keys = ma.in[32];
    const float* peer_u = ma.in[33];
    const float* peer_v = ma.in[34];

    float* out = ma.out;
    float* o_y = out;
    float* o_p_gdn = out + (size_t)NT * D;
    float* o_p_gdn_conv = o_p_gdn + 262144;
    float* o_p_lru = o_p_gdn_conv + 18432;
    float* o_p_lru_conv = o_p_lru + 2048;
    float* o_p_k = o_p_lru_conv + 6144;
    float* o_p_v = o_p_k + 131072;
    float* o_s_gdn = o_p_v + 131072;
    float* o_s_gdn_conv = o_s_gdn + 8388608;
    float* o_s_lru = o_s_gdn_conv + 589824;
    float* o_s_lru_conv = o_s_lru + 65536;
    float* o_s_k = o_s_lru_conv + 196608;
    float* o_s_v = o_s_k + 4194304;

    unsigned char* ws = ma.ws;
    bf16* WAB_T = (bf16*)(ws + WS_WAB); bf16* WOUT_T = (bf16*)(ws + WS_WOUT); bf16* WQ0_T = (bf16*)(ws + WS_WQ0); bf16* WQ1_T = (bf16*)(ws + WS_WQ1);
    bf16* WINC_T = (bf16*)(ws + WS_WINC); bf16* WOUTC_T = (bf16*)(ws + WS_WOUTC);
    bf16* ABUF = (bf16*)(ws + WS_ABUF);
    bf16* PROJ = (bf16*)(ws + WS_P); float* Y = (float*)(ws + WS_P); bf16* Qb = (bf16*)(ws + WS_P); float* PC = (float*)(ws + WS_P); float* Y1 = (float*)(ws + WS_P);
    bf16* UV0 = (bf16*)(ws + WS_T); bf16* UV1 = (bf16*)(ws + WS_Q);
    float* R_Q = (float*)(ws + WS_Q + Q_QKVS) - (size_t)NP * 1536; float* X2 = (float*)(ws + WS_A);
    GdnChunkBufs cbuf; cbuf.W = (bf16*)(ws + WS_Q + Q_W); cbuf.QG = (bf16*)(ws + WS_Q + Q_QG); cbuf.KDT = (bf16*)(ws + WS_Q + Q_KDT); cbuf.UT = (bf16*)(ws + WS_Q + Q_UT); cbuf.QK = (bf16*)(ws + WS_Q + Q_QK); cbuf.EGL = (float*)(ws + WS_Q + Q_EGL);
    float* HEND = (float*)(ws + WS_HEND); float* PEND = HEND + 4 * 64 * 512; float* CIN = PEND + 4 * 64 * 512;
    float* R_A = (float*)(ws + WS_A); float* R_B = (float*)(ws + WS_B); float* R_O = (float*)(ws + WS_O);
    float* R_X1 = (float*)(ws + WS_X1); float* X3 = R_X1;
    float* R_G = (float*)(ws + WS_G); float* R_BETA = (float*)(ws + WS_BETA); float* R_GATE = (float*)(ws + WS_GATE); int* R_EXP = (int*)(ws + WS_EXP);

    for (int u = tid; u < (LDS_BYTES - RING_BYTES) / 4; u += NTH) ((unsigned*)(lds + RING_BYTES))[u] = 0u;
    __syncthreads();
    XcdBarrier bar = xcd_barrier_post((unsigned*)(ws + WS_CTL), (volatile LAS unsigned*)((LAS unsigned char*)lds + MISC_OFF) + 8);
#define GRID_BAR() xcd_barrier(bar)
#define PHASE_LOOP(n) for (int vb = b0; vb < (n); vb += nb)
#define PHASE_END __syncthreads()
#define GEMM_PHASE(EPI, Aptr, Btptr, Nn, ...) do { pg8::Gemm g_{(const pg8::bf16_t*)(Aptr), (const pg8::bf16_t*)(Btptr), MP, (Nn), D}; pg8::StaticOrder S_; S_.init(MP, (Nn), nb, b0); \
        pg8::EPI E_{__VA_ARGS__}; pg8::gemm_phase<pg8::EPI, pg8::StaticOrder, true, true>((PG8_LAS unsigned char*)lds, g_, S_, E_); } while (0)

    {
        float* scr = smem + wave * 4096;
        const int gw = b0 * NWAVES + wave, NGW = nb * NWAVES;
        constexpr int I_AB = 16 * 97, I_OUT = 16 * 32, I_Q = 16 * 64, I_INC = 16 * 48;
        constexpr int NITEMS = I_AB + I_OUT + 2 * I_Q + I_INC + I_OUT;
        for (int it = gw; it < NITEMS; it += NGW) {
            int r = it;
            if (r < I_AB) { p0_transpose_item(w_in_ab, D, ABN, WAB_T, scr, r, lane); continue; } r -= I_AB;
            if (r < I_OUT) { p0_transpose_item(w_out_ab, D, D, WOUT_T, scr, r, lane); continue; } r -= I_OUT;
            if (r < I_Q) { p0_transpose_item(peer_w_q, D, 2048, WQ0_T, scr, r, lane); continue; } r -= I_Q;
            if (r < I_Q) { p0_transpose_item(peer_w_q + (size_t)D * 2048, D, 2048, WQ1_T, scr, r, lane); continue; } r -= I_Q;
            if (r < I_INC) { p0_transpose_item(w_in_c, D, CN, WINC_T, scr, r, lane); continue; } r -= I_INC;
            p0_transpose_item(w_out_c, D, D, WOUTC_T, scr, r, lane);
        }
        for (int m = gw; m < 2 * 16384; m += NGW)
            row_to_bf16((m < 16384 ? peer_u : peer_v) + (size_t)(m & 16383) * D, UV0 + (size_t)m * D, lane);
        for (int m = gw; m < MP + (ABNP - 97 * 32); m += NGW) {
            if (m < MP) row_to_bf16(m < NP ? x_prompt + (size_t)m * D : (m < NT ? x_sample + (size_t)(m - NP) * D : nullptr), ABUF + (size_t)m * D, lane);
            else row_to_bf16(nullptr, WAB_T + (size_t)(97 * 32 + (m - MP)) * D, lane);
        }
    }
    grid.sync();
    GEMM_PHASE(EpiStoreBf16, ABUF, WAB_T, ABNP, PROJ, ABN, nullptr, NT, ABN);
    GRID_BAR();
    { AbPrepArgs pa;
      pa.PROJ = PROJ; pa.st_gdn_conv = state_gdn_conv; pa.st_lru_conv = state_lru_conv;
      pa.gdn_conv_w = gdn_conv_w; pa.a_log = gdn_a_log; pa.dt_bias = gdn_dt_bias;
      pa.lru_conv_w = lru_conv_w; pa.lru_conv_b = lru_conv_b; pa.w_r = lru_w_r; pa.b_r = lru_b_r; pa.w_i = lru_w_i; pa.b_i = lru_b_i; pa.lam = lru_lam;
      pa.QKV = R_Q; pa.G = R_G; pa.BETA = R_BETA; pa.LA = R_A; pa.LB = R_B;
      pa.p_gdn_conv = o_p_gdn_conv; pa.p_lru_conv = o_p_lru_conv; pa.s_gdn_conv = o_s_gdn_conv; pa.s_lru_conv = o_s_lru_conv;
      PHASE_LOOP(1024 + 256 + NS) {
          if (vb < 1024) gdn_prep_unit(PROJ, gdn_conv_w, gdn_a_log, gdn_dt_bias, cbuf, o_p_gdn_conv, vb, lds);
          else if (vb < 1280) lru_prep_unit(PROJ, lru_conv_w, lru_conv_b, lru_w_r, lru_b_r, lru_w_i, lru_b_i, lru_lam, R_B, R_A, HEND, PEND, o_p_lru_conv, vb - 1024);
          else { ab_prep(pa, NP + (vb - 1280), smem); PHASE_END; } } }
    GRID_BAR();
    if (b0 < 64) gdn_seq(cbuf, R_O, o_p_gdn, b0 >> 4, (b0 >> 2) & 3, b0 & 3, lds);
    else if (b0 < 68) lru_carry(HEND, PEND, CIN, o_p_lru, b0 - 64);
    else for (int v = b0 - 68; v < 2048 + 128; v += nb - 68) {
        if (v < 2048) gdn_scan(R_Q, R_G, R_BETA, state_gdn, R_O, o_s_gdn, NP, 1, v & 3, (v >> 2) & 3, v >> 4, smem);
        else lru_scan(R_A, R_B, state_lru, o_s_lru, NP, 1, NS, v - 2048);
        PHASE_END;
    }
    GRID_BAR();
    PHASE_LOOP(NT / 2) { ab_mix(PROJ, R_O, R_B, R_A, CIN, gdn_norm_w, ABUF, vb); }
    for (int m = b0 * NWAVES + wave; m < 2 * 16384; m += nb * NWAVES)
        row_to_bf16((m < 16384 ? peer_u : peer_v) + (size_t)(16384 + (m & 16383)) * D, UV1 + (size_t)m * D, lane);
    GRID_BAR();
    GEMM_PHASE(EpiStoreF32, ABUF, WOUT_T, D, Y, D, nullptr, NT, D);
    GRID_BAR();
    PHASE_LOOP(NT / 8) { const int t = vb * 8 + wave;
        ln_res_w(t < NP ? x_prompt + (size_t)t * D : x_sample + (size_t)(t - NP) * D, Y + (size_t)t * D, ln_mix_g, ln_mix_b, R_X1 + (size_t)t * D, ABUF + (size_t)t * D, lane); }
    GRID_BAR();
    GEMM_PHASE(EpiStoreBf16, ABUF, WQ0_T, 2048, Qb, 2048, nullptr, NT, 2048);
    GRID_BAR();
    PHASE_LOOP((NT / 32) * 8) { peer_topk(Qb, peer_keys, R_EXP, R_GATE, vb >> 3, vb & 7, smem); PHASE_END; }
    GRID_BAR();
    PHASE_LOOP(NT / 8) { const int t = vb * 8 + wave;
        peer_expert_w(R_X1 + (size_t)t * D, ABUF + (size_t)t * D, R_EXP + (size_t)t * 128, R_GATE + (size_t)t * 128, UV0, UV0 + (size_t)16384 * D, ln_ffn_g, ln_ffn_b, X2 + (size_t)t * D, ABUF + (size_t)t * D, lane); }
    GRID_BAR();

    GEMM_PHASE(EpiStoreF32, ABUF, WINC_T, CN, PC, CN, b_in_c, NT, CN);
    GRID_BAR();
    PHASE_LOOP(NT * 2 + (NB * 128 + NS * 128) / 2) {
        if (vb < NT * 2) swa_attn(PC, cache_k, cache_v, rel_bias, swa_sinks, ABUF, vb);
        else swa_kv_out(PC, cache_k, cache_v, o_p_k, o_p_v, o_s_k, o_s_v, vb - NT * 2);
    }
    GRID_BAR();
    GEMM_PHASE(EpiStoreF32, ABUF, WOUTC_T, D, Y1, D, b_out_c, NT, D);
    GRID_BAR();
    PHASE_LOOP(NT / 8) { const int t = vb * 8 + wave;
        ln_res_w(X2 + (size_t)t * D, Y1 + (size_t)t * D, ln_mix_g + D, ln_mix_b + D, X3 + (size_t)t * D, ABUF + (size_t)t * D, lane); }
    GRID_BAR();
    GEMM_PHASE(EpiStoreBf16, ABUF, WQ1_T, 2048, Qb, 2048, nullptr, NT, 2048);
    GRID_BAR();
    PHASE_LOOP((NT / 32) * 8) { peer_topk(Qb, peer_keys + (size_t)8 * 2 * 128 * 128, R_EXP, R_GATE, vb >> 3, vb & 7, smem); PHASE_END; }
    GRID_BAR();
    PHASE_LOOP(NT / 8) { const int t = vb * 8 + wave;
        peer_expert_w(X3 + (size_t)t * D, ABUF + (size_t)t * D, R_EXP + (size_t)t * 128, R_GATE + (size_t)t * 128, UV1, UV1 + (size_t)16384 * D, ln_ffn_g + D, ln_ffn_b + D, o_y + (size_t)t * D, nullptr, lane); }
}
}

extern "C" void kernel_launch(void* const* d_in, const int* in_sizes, int n_in,
                              void* d_out, int out_size, void* d_ws, size_t ws_size,
                              hipStream_t stream) {
    static int grid_blocks = 0;
    if (!grid_blocks) {
        int dev = 0, cus = 0, per_cu = 0;
        (void)hipGetDevice(&dev);
        (void)hipDeviceGetAttribute(&cus, hipDeviceAttributeMultiprocessorCount, dev);
        if (hipFuncSetAttribute((const void*)fwd_megakernel, hipFuncAttributeMaxDynamicSharedMemorySize, LDS_BYTES) != hipSuccess) { fprintf(stderr, "hipFuncSetAttribute failed\n"); grid_blocks = -1; return; }
        (void)hipOccupancyMaxActiveBlocksPerMultiprocessor(&per_cu, (const void*)fwd_megakernel, NTH, LDS_BYTES);
        if (per_cu < 1) { fprintf(stderr, "occupancy query says %d blocks per CU\n", per_cu); grid_blocks = -1; return; }
        grid_blocks = cus;
    }
    if (grid_blocks < 0) return;
    (void)hipMemsetAsync((char*)d_ws + WS_CTL, 0, CTL_ZERO_BYTES, stream);
    MegaArgs ma{};
    for (int i = 0; i < 35; ++i) ma.in[i] = (const float*)d_in[i];
    ma.out = (float*)d_out;
    ma.ws = (unsigned char*)d_ws;
    void* args[] = {&ma};
    hipError_t e = hipLaunchCooperativeKernel((void*)fwd_megakernel, dim3(grid_blocks), dim3(NTH), args, LDS_BYTES, stream);
    if (e != hipSuccess) fprintf(stderr, "cooperative launch failed: %s (grid %d)\n", hipGetErrorString(e), grid_blocks);
}
```

```cpp
#include <hip/hip_runtime.h>
#include <hip/hip_cooperative_groups.h>
#include <cstdio>
#include <cstdint>
namespace cg = cooperative_groups;

namespace pg8 {
#define PG8_LAS __attribute__((address_space(3)))
typedef unsigned short bf16_t;
typedef short bf16x8 __attribute__((ext_vector_type(8)));
typedef float f32x4 __attribute__((ext_vector_type(4)));
typedef unsigned u32x4 __attribute__((ext_vector_type(4)));
constexpr int BM = 256, BK = 64, HALF = 128, HTB = HALF * BK * 2  , STAGE_BYTES = 8 * HTB, NXCD = 8, WGM = 8;

__host__ __device__ __forceinline__ int lds_byte(int r, int c) { const int st = (r >> 4) * 2 + (c >> 5), rr = r & 15, cc = c & 31, ob = rr * 64 + cc * 2; return st * 1024 + (ob ^ (((ob >> 9) & 1) << 5)); }
__host__ __device__ __forceinline__ void stage_rc(int b, int& R, int& C) { const int st = b / 1024, sb = b % 1024, swz = sb ^ (((sb >> 9) & 1) << 5); R = (st >> 1) * 16 + swz / 64; C = (st & 1) * 32 + (swz % 64) / 2; }
__host__ __device__ __forceinline__ int perm32(int rho) { const int n = rho >> 4, i = rho & 15; return 8 * (i >> 2) + 4 * n + (i & 3); }

struct Unit { int pm, pn; };
struct Gemm { const bf16_t* A; const bf16_t* Bt; int M, N, K; };

struct StaticOrder {
    int nM, nN, nwg, G, c;
    __host__ __device__ void init(int M, int N, int G_, int c_) { nM = M / BM; nN = N / BM; nwg = nM * nN; G = G_; c = c_; }
    __host__ __device__ bool next(int i, Unit& u) const {
        const long L = (long)i * G + c; if (L >= nwg) return false;
        int wgid = (int)L; { const int q = nwg / NXCD, r = nwg % NXCD, xcd = wgid % NXCD, off = wgid / NXCD; wgid = (xcd < r ? xcd * (q + 1) : r * (q + 1) + (xcd - r) * q) + off; }
        const int nig = WGM * nN, gid = wgid / nig, fm = gid * WGM, gsz = (nM - fm) < WGM ? (nM - fm) : WGM;
        u.pm = fm + ((wgid % nig) % gsz); u.pn = (wgid % nig) / gsz; return true;
    }
    __device__ __forceinline__ void a_ready(const Unit&) const {}
    __device__ __forceinline__ void done(const Unit&) const {}
};

__device__ __forceinline__ unsigned cvt_pk_bf16(float lo, float hi) { unsigned r; asm volatile("v_cvt_pk_bf16_f32 %0, %1, %2" : "=v"(r) : "v"(lo), "v"(hi)); return r; }
template <class Epi, class Sched, bool ALIGN_EPI = false, bool SP2 = false>
__device__ __forceinline__ void gemm_phase(PG8_LAS unsigned char* lds, const Gemm g, const Sched& S, const Epi& E) {
    const int tid = threadIdx.x, wid = __builtin_amdgcn_readfirstlane(tid >> 6), lane = tid & 63, wr = wid >> 2, wc = wid & 3, fr = lane & 15, fq = lane >> 4;
    const int K = g.K, nt = K / BK;
    unsigned voffA[2], voffB[2];
#pragma unroll
    for (int i = 0; i < 2; ++i) { int R, C; stage_rc(tid * 16 + i * 8192, R, C); const int Rb = Epi::PERM ? ((R & ~31) + perm32(R & 31)) : R;
        voffA[i] = (unsigned)(R * K + C) * 2u; voffB[i] = (unsigned)(Rb * K + C) * 2u; }
    const size_t kstep = (size_t)(BK * 2);
    const size_t hstep = (size_t)HALF * K * 2;
    const size_t tstep = 2 * hstep;
    const unsigned ldsw = (unsigned)wid * 1024u;
    const int aoff = lds_byte(wr * 64 + fr, fq * 8), boff = lds_byte(wc * 32 + fr, fq * 8);
#define PG8_SA(b, h) (((b) * 2 + (h)) * HTB)
#define PG8_SB(b, h) ((4 + (b) * 2 + (h)) * HTB)
#define PG8_STAGE(bufoff, gbase, voff) do { _Pragma("unroll") for (int _i = 0; _i < 2; ++_i) \
        __builtin_amdgcn_global_load_lds((const unsigned*)((const char*)(gbase) + (voff)[_i]), (PG8_LAS unsigned*)(lds + (bufoff) + ldsw + _i * 8192), 16, 0, 0); } while (0)
#define PG8_LDA(dst, b, h) do { _Pragma("unroll") for (int m = 0; m < 4; ++m) _Pragma("unroll") for (int k = 0; k < 2; ++k) dst[m][k] = *(const PG8_LAS bf16x8*)(lds + PG8_SA(b, h) + aoff + m * 2048 + k * 1024); } while (0)
#define PG8_LDB(dst, b, h) do { _Pragma("unroll") for (int n = 0; n < 2; ++n) _Pragma("unroll") for (int k = 0; k < 2; ++k) dst[n][k] = *(const PG8_LAS bf16x8*)(lds + PG8_SB(b, h) + boff + n * 2048 + k * 1024); } while (0)
#define PG8_MMA(ai, bj, At, Bt) do { __builtin_amdgcn_s_setprio(1); _Pragma("unroll") for (int m = 0; m < 4; ++m) _Pragma("unroll") for (int n = 0; n < 2; ++n) _Pragma("unroll") for (int k = 0; k < 2; ++k) \
        acc[ai][bj][m][n] = __builtin_amdgcn_mfma_f32_16x16x32_bf16(Bt[n][k], At[m][k], acc[ai][bj][m][n], 0, 0, 0); __builtin_amdgcn_s_setprio(0); } while (0)
#define PG8_WAIT_V(n) asm volatile("s_waitcnt vmcnt(" #n ")" ::: "memory")
#define PG8_WAIT_L(n) asm volatile("s_waitcnt lgkmcnt(" #n ")" ::: "memory")
#define PG8_BAR __builtin_amdgcn_s_barrier()
#define PG8_SCHED __builtin_amdgcn_sched_barrier(0)
    Unit cur, nxt; int ui = 0;
    if (!S.next(0, cur)) return;
    f32x4 acc[2][2][4][2];
#pragma unroll
    for (int a = 0; a < 2; ++a)
#pragma unroll
        for (int b = 0; b < 2; ++b)
#pragma unroll
            for (int m = 0; m < 4; ++m)
#pragma unroll
                for (int n = 0; n < 2; ++n) acc[a][b][m][n] = (f32x4){0.f, 0.f, 0.f, 0.f};
    bf16x8 At[4][2], B0[2][2], B1[2][2];
    const char* cA = (const char*)g.A + (size_t)cur.pm * tstep; const char* cB = (const char*)g.Bt + (size_t)cur.pn * tstep;
    S.a_ready(cur);
    if constexpr (SP2) {
        PG8_STAGE(PG8_SB(0, 0), cB, voffB); PG8_STAGE(PG8_SB(0, 1), cB + hstep, voffB); PG8_STAGE(PG8_SA(0, 0), cA, voffA); PG8_STAGE(PG8_SA(0, 1), cA + hstep, voffA);
        if (wr == 1) PG8_BAR;
        PG8_WAIT_V(2); PG8_BAR;
        PG8_STAGE(PG8_SB(1, 0), cB + kstep, voffB); PG8_STAGE(PG8_SA(1, 0), cA + kstep, voffA); PG8_STAGE(PG8_SB(1, 1), cB + hstep + kstep, voffB);
        PG8_WAIT_V(6); PG8_BAR;
    } else {
        PG8_STAGE(PG8_SB(0, 0), cB, voffB); PG8_STAGE(PG8_SA(0, 0), cA, voffA); PG8_STAGE(PG8_SB(0, 1), cB + hstep, voffB); PG8_STAGE(PG8_SA(0, 1), cA + hstep, voffA);
        if (wr == 1) PG8_BAR;
        PG8_WAIT_V(4); PG8_BAR;
        PG8_STAGE(PG8_SB(1, 0), cB + kstep, voffB); PG8_STAGE(PG8_SA(1, 0), cA + kstep, voffA); PG8_STAGE(PG8_SB(1, 1), cB + hstep + kstep, voffB);
        PG8_WAIT_V(6); PG8_BAR;
    }
    for (;;) {
        const bool has_next = S.next(ui + 1, nxt);
        const char* nA = has_next ? (const char*)g.A + (size_t)nxt.pm * tstep : cA; const char* nB = has_next ? (const char*)g.Bt + (size_t)nxt.pn * tstep : cB;
        for (int t = 0; t < nt; t += 2) {
            const bool last = (t == nt - 2);
            const char* a1 = cA + (size_t)(t + 1) * kstep;
            const char* a2 = last ? nA : cA + (size_t)(t + 2) * kstep; const char* b2 = last ? nB : cB + (size_t)(t + 2) * kstep;
            const char* a3 = a2 + kstep; const char* b3 = b2 + kstep;
            if (last && has_next) S.a_ready(nxt);
            if constexpr (SP2) {
            PG8_LDB(B0, 0, 0); PG8_LDB(B1, 0, 1); PG8_SCHED; PG8_LDA(At, 0, 0); PG8_STAGE(PG8_SA(1, 1), a1 + hstep, voffA);
            PG8_WAIT_V(8); PG8_WAIT_L(0); PG8_BAR; PG8_MMA(0, 0, At, B0); PG8_MMA(0, 1, At, B1); PG8_BAR; PG8_SCHED;
            PG8_LDA(At, 0, 1); PG8_STAGE(PG8_SB(0, 0), b2, voffB); PG8_STAGE(PG8_SB(0, 1), b2 + hstep, voffB); PG8_STAGE(PG8_SA(0, 0), a2, voffA);
            PG8_WAIT_V(8); PG8_WAIT_L(0); PG8_BAR; PG8_MMA(1, 0, At, B0); PG8_MMA(1, 1, At, B1); PG8_BAR; PG8_SCHED;
            PG8_LDB(B0, 1, 0); PG8_LDB(B1, 1, 1); PG8_SCHED; PG8_LDA(At, 1, 0); PG8_STAGE(PG8_SA(0, 1), a2 + hstep, voffA);
            PG8_WAIT_V(8); PG8_WAIT_L(0); PG8_BAR; PG8_MMA(0, 0, At, B0); PG8_MMA(0, 1, At, B1); PG8_BAR; PG8_SCHED;
            PG8_LDA(At, 1, 1); PG8_STAGE(PG8_SB(1, 0), b3, voffB); PG8_STAGE(PG8_SB(1, 1), b3 + hstep, voffB); PG8_STAGE(PG8_SA(1, 0), a3, voffA);
            PG8_WAIT_V(8); PG8_WAIT_L(0); PG8_BAR; PG8_MMA(1, 0, At, B0); PG8_MMA(1, 1, At, B1); PG8_BAR; PG8_SCHED;
            } else {
            PG8_LDB(B0, 0, 0); PG8_SCHED; PG8_LDA(At, 0, 0); PG8_STAGE(PG8_SA(1, 1), a1 + hstep, voffA);
            PG8_WAIT_L(8); PG8_BAR; PG8_WAIT_L(0); PG8_MMA(0, 0, At, B0); PG8_BAR; PG8_SCHED;
            PG8_LDB(B1, 0, 1); PG8_STAGE(PG8_SB(0, 0), b2, voffB);
            PG8_BAR; PG8_WAIT_L(0); PG8_MMA(0, 1, At, B1); PG8_BAR;
            PG8_LDA(At, 0, 1); PG8_STAGE(PG8_SA(0, 0), a2, voffA);
            PG8_BAR; PG8_WAIT_L(0); PG8_MMA(1, 0, At, B0); PG8_BAR; PG8_SCHED;
            PG8_STAGE(PG8_SB(0, 1), b2 + hstep, voffB);
            PG8_WAIT_V(6); PG8_BAR; PG8_MMA(1, 1, At, B1); PG8_BAR;
            PG8_LDB(B0, 1, 0); PG8_SCHED; PG8_LDA(At, 1, 0); PG8_STAGE(PG8_SA(0, 1), a2 + hstep, voffA);
            PG8_WAIT_L(8); PG8_BAR; PG8_WAIT_L(0); PG8_MMA(0, 0, At, B0); PG8_BAR; PG8_SCHED;
            PG8_LDB(B1, 1, 1); PG8_STAGE(PG8_SB(1, 0), b3, voffB);
            PG8_BAR; PG8_WAIT_L(0); PG8_MMA(0, 1, At, B1); PG8_BAR;
            PG8_LDA(At, 1, 1); PG8_STAGE(PG8_SA(1, 0), a3, voffA);
            PG8_BAR; PG8_WAIT_L(0); PG8_MMA(1, 0, At, B0); PG8_BAR; PG8_SCHED;
            PG8_STAGE(PG8_SB(1, 1), b3 + hstep, voffB);
            PG8_WAIT_V(6); PG8_BAR; PG8_MMA(1, 1, At, B1); PG8_BAR;
            }
        }
        if constexpr (ALIGN_EPI) { if (wr == 0) PG8_BAR; }
        if constexpr (!Epi::AFTER_DRAIN) { E(acc, cur, wr, wc, fr, fq); S.done(cur); }
        if (!has_next) break;
#pragma unroll
        for (int a = 0; a < 2; ++a)
#pragma unroll
            for (int b = 0; b < 2; ++b)
#pragma unroll
                for (int m = 0; m < 4; ++m)
#pragma unroll
                    for (int n = 0; n < 2; ++n) acc[a][b][m][n] = (f32x4){0.f, 0.f, 0.f, 0.f};
        cur = nxt; cA = nA; cB = nB; ++ui;
        if constexpr (ALIGN_EPI) { if (wr == 1) PG8_BAR; }
    }
    PG8_WAIT_V(0);
    if constexpr (!ALIGN_EPI) { if (wr == 0) PG8_BAR; }
    PG8_BAR;
    if constexpr (Epi::AFTER_DRAIN) { E.fused(acc, cur, wr, wc, fr, fq, lds, wid, lane); S.done(cur); }
#undef PG8_SA
#undef PG8_SB
#undef PG8_STAGE
#undef PG8_LDA
#undef PG8_LDB
#undef PG8_MMA
#undef PG8_WAIT_V
#undef PG8_WAIT_L
#undef PG8_BAR
#undef PG8_SCHED
}
}
namespace pg8 {
struct EpiStoreBf16 {
    static constexpr bool PERM = true, AFTER_DRAIN = false;
    bf16_t* O; int ldc; const float* bias; int m_real, n_real;
    __device__ __forceinline__ void operator()(const f32x4 (&acc)[2][2][4][2], const Unit& u, int wr, int wc, int fr, int fq) const {
        const int row0 = u.pm * BM + wr * 64 + fr, col0 = u.pn * BM + wc * 32 + 8 * fq;
#pragma unroll
        for (int bj = 0; bj < 2; ++bj) {
            const int col = col0 + bj * HALF;
            if (col >= n_real) continue;
            f32x4 b0 = (f32x4){0.f, 0.f, 0.f, 0.f}, b1 = b0;
            if (bias) { b0 = *(const f32x4*)(bias + col); b1 = *(const f32x4*)(bias + col + 4); }
#pragma unroll
            for (int ai = 0; ai < 2; ++ai)
#pragma unroll
                for (int m = 0; m < 4; ++m) {
                    const int row = row0 + ai * HALF + m * 16;
                    if (row >= m_real) continue;
                    const f32x4 v0 = acc[ai][bj][m][0] + b0, v1 = acc[ai][bj][m][1] + b1;
                    u32x4 w; w.x = cvt_pk_bf16(v0[0], v0[1]); w.y = cvt_pk_bf16(v0[2], v0[3]); w.z = cvt_pk_bf16(v1[0], v1[1]); w.w = cvt_pk_bf16(v1[2], v1[3]);
                    *(u32x4*)(O + (size_t)row * ldc + col) = w;
                }
        }
    }
};
struct EpiStoreF32 {
    static constexpr bool PERM = false, AFTER_DRAIN = false;
    float* O; int ldc; const float* bias; int m_real, n_real;
    __device__ __forceinline__ void operator()(const f32x4 (&acc)[2][2][4][2], const Unit& u, int wr, int wc, int fr, int fq) const {
        const int row0 = u.pm * BM + wr * 64 + fr, col0 = u.pn * BM + wc * 32 + 4 * fq;
#pragma unroll
        for (int bj = 0; bj < 2; ++bj)
#pragma unroll
            for (int n = 0; n < 2; ++n) {
                const int col = col0 + bj * HALF + n * 16;
                if (col >= n_real) continue;
                const f32x4 bv = bias ? *(const f32x4*)(bias + col) : (f32x4){0.f, 0.f, 0.f, 0.f};
#pragma unroll
                for (int ai = 0; ai < 2; ++ai)
#pragma unroll
                    for (int m = 0; m < 4; ++m) {
                        const int row = row0 + ai * HALF + m * 16;
                        if (row >= m_real) continue;
                        *(f32x4*)(O + (size_t)row * ldc + col) = acc[ai][bj][m][n] + bv;
                    }
            }
    }
};
}
namespace {
#define GAS __attribute__((address_space(1)))
#define LAS __attribute__((address_space(3)))
typedef unsigned short bf16;
typedef float f32x4 __attribute__((ext_vector_type(4)));
typedef unsigned v4u __attribute__((ext_vector_type(4)));
typedef unsigned v2u __attribute__((ext_vector_type(2)));

constexpr int D = 1024, NB = 4, SEQ = 4096, NP = NB * SEQ, NS = 128, NT = NP + NS, MP = 16640;
constexpr int ABN = 3080, ABNP = 3328;
constexpr int C_QKV = 0, C_Z = 1536, C_A = 2048, C_B = 2052, C_XR = 2056, C_GATE = 2568;
constexpr int CN = 1536;
constexpr float ALPHA = 1.4142135623730951f;
constexpr float LN_EPS = 1e-5f;
constexpr int NTH = 512, NWAVES = 8;
constexpr int RING_BYTES = 131072, MISC_OFF = RING_BYTES + 320, LDS_BYTES = 147456;

__device__ __forceinline__ float bf2f(bf16 v) { return __uint_as_float((unsigned)v << 16); }
__device__ __forceinline__ unsigned f2bf(float f) { unsigned u = __float_as_uint(f); return (u + 0x7fffu + ((u >> 16) & 1u)) >> 16; }
__device__ __forceinline__ unsigned pk2(float lo, float hi) { return f2bf(lo) | (f2bf(hi) << 16); }
__device__ __forceinline__ float sigmoidf_(float x) { return 1.0f / (1.0f + expf(-x)); }
__device__ __forceinline__ float softplusf_(float x) { return fmaxf(x, 0.f) + log1pf(expf(-fabsf(x))); }
__device__ __forceinline__ float siluf_(float x) { return x / (1.0f + expf(-x)); }
__device__ __forceinline__ float geluf_(float x) { return 0.5f * x * (1.0f + tanhf(0.7978845608028654f * (x + 0.044715f * x * x * x))); }
__device__ __forceinline__ float wave_sum(float v) {
#pragma unroll
    for (int o = 32; o > 0; o >>= 1) v += __shfl_xor(v, o);
    return v;
}
__device__ __forceinline__ float wave_max(float v) {
#pragma unroll
    for (int o = 32; o > 0; o >>= 1) v = fmaxf(v, __shfl_xor(v, o));
    return v;
}

__device__ __forceinline__ void p0_transpose_item(const float* __restrict__ W, int K, int N, bf16* __restrict__ WT, float* scr, int item, int lane) {
    const int nblk = (N + 31) / 32, kb = item / nblk, nb = item % nblk, k0 = 64 * kb, n0 = 32 * nb;
#pragma unroll 8
    for (int i = 0; i < 32; ++i) { const int kk = 2 * i + (lane >> 5), n = n0 + (lane & 31); scr[kk * 33 + (lane & 31)] = n < N ? W[(size_t)(k0 + kk) * N + n] : 0.f; }
    asm volatile("s_waitcnt lgkmcnt(0)" ::: "memory");
    const int c = lane & 7;
#pragma unroll
    for (int j = 0; j < 4; ++j) { const int n = (lane >> 3) + 8 * j; const float* s = scr + (8 * c) * 33 + n;
        v4u o; o.x = pk2(s[0 * 33], s[1 * 33]); o.y = pk2(s[2 * 33], s[3 * 33]); o.z = pk2(s[4 * 33], s[5 * 33]); o.w = pk2(s[6 * 33], s[7 * 33]);
        *(v4u*)(WT + (size_t)(n0 + n) * K + k0 + 8 * c) = o; }
    asm volatile("s_waitcnt lgkmcnt(0)" ::: "memory");
}
__device__ __forceinline__ void row_to_bf16(const float* __restrict__ xrow, bf16* __restrict__ orow, int lane) {
#pragma unroll
    for (int j = 0; j < 4; ++j) {
        f32x4 v = (f32x4){0.f, 0.f, 0.f, 0.f};
        if (xrow) v = ((const f32x4*)xrow)[lane + 64 * j];
        v2u o; o.x = pk2(v.x, v.y); o.y = pk2(v.z, v.w);
        ((v2u*)orow)[lane + 64 * j] = o;
    }
}

struct AbPrepArgs {
    const bf16* PROJ; const float* st_gdn_conv; const float* st_lru_conv;
    const float* gdn_conv_w; const float* a_log; const float* dt_bias;
    const float* lru_conv_w; const float* lru_conv_b; const float* w_r; const float* b_r; const float* w_i; const float* b_i; const float* lam;
    float* QKV; float* G; float* BETA; float* LA; float* LB;
    float* p_gdn_conv; float* p_lru_conv; float* s_gdn_conv; float* s_lru_conv;
};
__device__ __forceinline__ void ab_prep(const AbPrepArgs& a, int t, float* smem) {
    const int tid = threadIdx.x, lane = tid & 63, wid = tid >> 6;
    const bool samp = t >= NP; const int sb = t - NP, pos = t % SEQ, b = t / SEQ;
    float* sq = smem;
    float* sx = smem + 1536;
    float* scl = smem + 2048;
    const bf16* prow = a.PROJ + (size_t)t * ABN;
    for (int c = tid; c < 1536; c += NTH) {
        float acc = 0.f;
#pragma unroll
        for (int i = 0; i < 4; ++i) {
            float xv;
            if (i == 3) xv = bf2f(prow[C_QKV + c]);
            else if (samp) xv = a.st_gdn_conv[((size_t)sb * 3 + i) * 1536 + c];
            else xv = (pos - 3 + i >= 0) ? bf2f(a.PROJ[(size_t)(t - 3 + i) * ABN + C_QKV + c]) : 0.f;
            acc += a.gdn_conv_w[i * 1536 + c] * xv;
        }
        sq[c] = siluf_(acc);
    }
    {
        const int c = tid;
        float acc = a.lru_conv_b[c];
#pragma unroll
        for (int i = 0; i < 4; ++i) {
            float xv;
            if (i == 3) xv = bf2f(prow[C_XR + c]);
            else if (samp) xv = a.st_lru_conv[((size_t)sb * 3 + i) * 512 + c];
            else xv = (pos - 3 + i >= 0) ? bf2f(a.PROJ[(size_t)(t - 3 + i) * ABN + C_XR + c]) : 0.f;
            acc += a.lru_conv_w[i * 512 + c] * xv;
        }
        sx[c] = acc;
    }
    __syncthreads();
    {
        const int grp = wid;
        const float v0 = sq[grp * 128 + lane], v1 = sq[grp * 128 + 64 + lane];
        const float s = wave_sum(v0 * v0 + v1 * v1);
        if (lane == 0) scl[grp] = rsqrtf(s + 1e-6f) * (grp < 4 ? 0.08838834764831845f : 1.0f);
    }
    __syncthreads();
    for (int c = tid; c < 1536; c += NTH) a.QKV[(size_t)t * 1536 + c] = (c < 1024) ? sq[c] * scl[c >> 7] : sq[c];
    if (tid < 4) {
        const float a_raw = bf2f(prow[C_A + tid]), b_raw = bf2f(prow[C_B + tid]);
        a.G[(size_t)t * 4 + tid] = -expf(a.a_log[tid]) * softplusf_(a_raw + a.dt_bias[tid]);
        a.BETA[(size_t)t * 4 + tid] = sigmoidf_(b_raw);
    }
    if (!samp) {
        if (pos >= SEQ - 3) {
            const int row = pos - (SEQ - 3);
            for (int c = tid; c < 1536; c += NTH) a.p_gdn_conv[((size_t)b * 3 + row) * 1536 + c] = bf2f(prow[C_QKV + c]);
            a.p_lru_conv[((size_t)b * 3 + row) * 512 + tid] = bf2f(prow[C_XR + tid]);
        }
    } else {
        for (int c = tid; c < 1536; c += NTH) {
            a.s_gdn_conv[((size_t)sb * 3 + 0) * 1536 + c] = a.st_gdn_conv[((size_t)sb * 3 + 1) * 1536 + c];
            a.s_gdn_conv[((size_t)sb * 3 + 1) * 1536 + c] = a.st_gdn_conv[((size_t)sb * 3 + 2) * 1536 + c];
            a.s_gdn_conv[((size_t)sb * 3 + 2) * 1536 + c] = bf2f(prow[C_QKV + c]);
        }
        {
            const int c = tid;
            a.s_lru_conv[((size_t)sb * 3 + 0) * 512 + c] = a.st_lru_conv[((size_t)sb * 3 + 1) * 512 + c];
            a.s_lru_conv[((size_t)sb * 3 + 1) * 512 + c] = a.st_lru_conv[((size_t)sb * 3 + 2) * 512 + c];
            a.s_lru_conv[((size_t)sb * 3 + 2) * 512 + c] = bf2f(prow[C_XR + c]);
        }
    }
    {
        const int c = tid, n = c >> 6, d = c & 63;
        float r = a.b_r[c], ii = a.b_i[c];
#pragma unroll 4
        for (int cc = 0; cc < 64; ++cc) {
            const float xv = sx[n * 64 + cc];
            r += xv * a.w_r[((size_t)n * 64 + cc) * 64 + d];
            ii += xv * a.w_i[((size_t)n * 64 + cc) * 64 + d];
        }
        r = sigmoidf_(r); ii = sigmoidf_(ii);
        const float log_a = -8.0f * r * softplusf_(-a.lam[c]);
        a.LA[(size_t)t * 512 + c] = expf(log_a);
        a.LB[(size_t)t * 512 + c] = sqrtf(-expm1f(2.0f * log_a)) * (ii * sx[c]);
    }
}

__device__ __forceinline__ void gdn_scan(const float* __restrict__ QKV, const float* __restrict__ G, const float* __restrict__ BETA,
                                         const float* __restrict__ S0, float* __restrict__ O, float* __restrict__ Sout, int tok_base, int T,
                                         int sl, int h, int sq, float* smem) {
    const int tid = threadIdx.x, dvl = tid & 31, kg = tid >> 5;
    const int dv = sl * 32 + dvl;
    float (*red1)[32] = (float (*)[32])smem;
    float (*red2)[32] = (float (*)[32])(smem + 512);
    float S[8];
#pragma unroll
    for (int i = 0; i < 8; ++i) S[i] = S0 ? S0[(((size_t)sq * 4 + h) * 128 + kg * 8 + i) * 128 + dv] : 0.f;
    float kk[8], qq[8], vv, g, be;
    {
        const size_t tok = (size_t)tok_base + (size_t)sq * T;
        const float* row = QKV + tok * 1536;
#pragma unroll
        for (int i = 0; i < 8; ++i) { kk[i] = row[512 + h * 128 + kg * 8 + i]; qq[i] = row[h * 128 + kg * 8 + i]; }
        vv = row[1024 + h * 128 + dv]; g = G[tok * 4 + h]; be = BETA[tok * 4 + h];
    }
    for (int t = 0; t < T; ++t) {
        const size_t tok = (size_t)tok_base + (size_t)sq * T + t;
        float nk[8], nq[8], nv = 0.f, ng = 0.f, nb = 0.f;
        if (t + 1 < T) {
            const float* row = QKV + (tok + 1) * 1536;
#pragma unroll
            for (int i = 0; i < 8; ++i) { nk[i] = row[512 + h * 128 + kg * 8 + i]; nq[i] = row[h * 128 + kg * 8 + i]; }
            nv = row[1024 + h * 128 + dv]; ng = G[(tok + 1) * 4 + h]; nb = BETA[(tok + 1) * 4 + h];
        } else {
#pragma unroll
            for (int i = 0; i < 8; ++i) { nk[i] = 0.f; nq[i] = 0.f; }
        }
        const float al = expf(g);
        float p = 0.f;
#pragma unroll
        for (int i = 0; i < 8; ++i) { S[i] *= al; p += S[i] * kk[i]; }
        red1[kg][dvl] = p;
        __syncthreads();
        float ks = 0.f;
#pragma unroll
        for (int j = 0; j < 16; ++j) ks += red1[j][dvl];
        const float vn = be * (vv - ks);
        float o = 0.f;
#pragma unroll
        for (int i = 0; i < 8; ++i) { S[i] += kk[i] * vn; o += S[i] * qq[i]; }
        red2[kg][dvl] = o;
        __syncthreads();
        if (kg == 0) {
            float os = 0.f;
#pragma unroll
            for (int j = 0; j < 16; ++j) os += red2[j][dvl];
            O[tok * 512 + h * 128 + dv] = os;
        }
#pragma unroll
        for (int i = 0; i < 8; ++i) { kk[i] = nk[i]; qq[i] = nq[i]; }
        vv = nv; g = ng; be = nb;
    }
#pragma unroll
    for (int i = 0; i < 8; ++i) Sout[(((size_t)sq * 4 + h) * 128 + kg * 8 + i) * 128 + dv] = S[i];
}

__device__ __forceinline__ void lru_scan(const float* __restrict__ LA, float* __restrict__ LB, const float* __restrict__ h0,
                                         float* __restrict__ hlast, int tok_base, int T, int nseq, int bx) {
    const int idx = bx * NTH + threadIdx.x;
    if (idx >= nseq * 512) return;
    const int sq = idx / 512, c = idx % 512;
    float h = h0 ? h0[(size_t)sq * 512 + c] : 0.f;
    const size_t base = ((size_t)tok_base + (size_t)sq * T) * 512 + c;
#pragma unroll 8
    for (int t = 0; t < T; ++t) {
        const size_t o = base + (size_t)t * 512;
        h = LA[o] * h + LB[o];
        LB[o] = h;
    }
    hlast[(size_t)sq * 512 + c] = h;
}

__device__ __forceinline__ void ab_mix(const bf16* __restrict__ PROJ, const float* __restrict__ O, const float* __restrict__ H, const float* __restrict__ P, const float* __restrict__ CIN,
                                       const float* __restrict__ norm_w, bf16* __restrict__ MIX, int vb) {
    const int tid = threadIdx.x & 255, lane = tid & 63, wid = tid >> 6, t = vb * 2 + (threadIdx.x >> 8);
    const bf16* prow = PROJ + (size_t)t * ABN;
    {
        const int h = wid;
        const float o0 = O[(size_t)t * 512 + h * 128 + lane], o1 = O[(size_t)t * 512 + h * 128 + 64 + lane];
        const float ms = wave_sum(o0 * o0 + o1 * o1) * (1.0f / 128.0f);
        const float sc = rsqrtf(ms + 1e-6f);
        MIX[(size_t)t * 1024 + h * 128 + lane] = (bf16)f2bf(o0 * sc * norm_w[lane] * siluf_(bf2f(prow[C_Z + h * 128 + lane])));
        MIX[(size_t)t * 1024 + h * 128 + 64 + lane] = (bf16)f2bf(o1 * sc * norm_w[64 + lane] * siluf_(bf2f(prow[C_Z + h * 128 + 64 + lane])));
    }
    for (int c = tid; c < 512; c += 256) {
        float hv = H[(size_t)t * 512 + c];
        if (t < NP) hv += P[(size_t)t * 512 + c] * CIN[(size_t)(t >> 6) * 512 + c];
        MIX[(size_t)t * 1024 + 512 + c] = (bf16)f2bf(geluf_(bf2f(prow[C_GATE + c])) * hv);
    }
}

__device__ __forceinline__ void ln_res_w(const float* __restrict__ xrow, const float* __restrict__ yrow, const float* __restrict__ g, const float* __restrict__ bta,
                                         float* __restrict__ orow, bf16* __restrict__ obrow, int lane) {
    f32x4 v[4]; float s = 0.f;
#pragma unroll
    for (int j = 0; j < 4; ++j) { const f32x4 x4 = ((const f32x4*)xrow)[lane + 64 * j], y4 = ((const f32x4*)yrow)[lane + 64 * j]; v[j] = x4 * ALPHA + y4; s += (v[j].x + v[j].y) + (v[j].z + v[j].w); }
    const float mean = wave_sum(s) * (1.0f / 1024.0f); float q = 0.f;
#pragma unroll
    for (int j = 0; j < 4; ++j) { v[j] = v[j] - mean; q += (v[j].x * v[j].x + v[j].y * v[j].y) + (v[j].z * v[j].z + v[j].w * v[j].w); }
    const float rs = rsqrtf(wave_sum(q) * (1.0f / 1024.0f) + LN_EPS);
#pragma unroll
    for (int j = 0; j < 4; ++j) {
        const f32x4 g4 = ((const f32x4*)g)[lane + 64 * j], b4 = ((const f32x4*)bta)[lane + 64 * j];
        const f32x4 o = v[j] * rs * g4 + b4;
        ((f32x4*)orow)[lane + 64 * j] = o;
        v2u ob; ob.x = pk2(o.x, o.y); ob.y = pk2(o.z, o.w);
        ((v2u*)obrow)[lane + 64 * j] = ob;
    }
}

__device__ __forceinline__ void peer_topk(const bf16* __restrict__ Q, const float* __restrict__ keys, int* __restrict__ EXP, float* __restrict__ GATE,
                                          int tg, int h, float* smem) {
    const int tid = threadIdx.x, cn = tid & 255, c = cn >> 7, n = cn & 127, th = tid >> 8;
    float (*sq)[256] = (float (*)[256])smem;
    float (*ss)[257] = (float (*)[257])(smem + 32 * 256);
    float (*tvs)[2][16] = (float (*)[2][16])(smem + 32 * 256 + 32 * 257 + 32);
    int (*tis)[2][16] = (int (*)[2][16])(smem + 32 * 256 + 32 * 257 + 32 + 1024);
    for (int i = tid; i < 32 * 256; i += NTH) {
        const int tk = i >> 8, col = i & 255;
        sq[tk][col] = bf2f(Q[(size_t)(tg * 32 + tk) * 2048 + h * 256 + col]);
    }
    __syncthreads();
    float acc[16];
#pragma unroll
    for (int i = 0; i < 16; ++i) acc[i] = 0.f;
    const float* krow = keys + (((size_t)h * 2 + c) * 128 + n) * 128;
    for (int d4 = 0; d4 < 32; ++d4) {
        const float4 kv = *(const float4*)(krow + d4 * 4);
#pragma unroll
        for (int tk = 0; tk < 16; ++tk) {
            const float4 qv = *(const float4*)&sq[th * 16 + tk][c * 128 + d4 * 4];
            acc[tk] += qv.x * kv.x + qv.y * kv.y + qv.z * kv.z + qv.w * kv.w;
        }
    }
#pragma unroll
    for (int tk = 0; tk < 16; ++tk) ss[th * 16 + tk][cn] = acc[tk];
    __syncthreads();
    if (tid < 64) {
        const int tk = tid >> 1, cc = tid & 1;
        float tv[16]; int ti[16];
#pragma unroll
        for (int j = 0; j < 16; ++j) { tv[j] = -INFINITY; ti[j] = 0; }
        for (int nn = 0; nn < 128; ++nn) {
            float x = ss[tk][cc * 128 + nn]; int xi = nn;
#pragma unroll
            for (int j = 0; j < 16; ++j) {
                const bool gt = x > tv[j];
                const float tf = tv[j]; const int tj = ti[j];
                tv[j] = gt ? x : tf; ti[j] = gt ? xi : tj;
                x = gt ? tf : x; xi = gt ? tj : xi;
            }
        }
#pragma unroll
        for (int j = 0; j < 16; ++j) { tvs[tk][cc][j] = tv[j]; tis[tk][cc][j] = ti[j]; }
    }
    __syncthreads();
    if (tid < 32) {
        const int tk = tid;
        float bv[16]; int bi[16];
#pragma unroll
        for (int j = 0; j < 16; ++j) { bv[j] = -INFINITY; bi[j] = 0; }
        for (int i = 0; i < 16; ++i)
            for (int jj = 0; jj < 16; ++jj) {
                float x = tvs[tk][0][i] + tvs[tk][1][jj]; int xi = tis[tk][0][i] * 128 + tis[tk][1][jj];
#pragma unroll
                for (int j = 0; j < 16; ++j) {
                    const bool gt = x > bv[j];
                    const float tf = bv[j]; const int tj = bi[j];
                    bv[j] = gt ? x : tf; bi[j] = gt ? xi : tj;
                    x = gt ? tf : x; xi = gt ? tj : xi;
                }
            }
        float e[16], sum = 0.f;
#pragma unroll
        for (int j = 0; j < 16; ++j) { e[j] = expf(bv[j] - bv[0]); sum += e[j]; }
        const float inv = 1.0f / sum;
        const size_t o = (size_t)(tg * 32 + tk) * 128 + h * 16;
#pragma unroll
        for (int j = 0; j < 16; ++j) { EXP[o + j] = bi[j]; GATE[o + j] = e[j] * inv; }
    }
}

__device__ __forceinline__ void peer_expert(const float* __restrict__ X, const int* __restrict__ EXP, const float* __restrict__ GATE,
                                            const float* __restrict__ U, const float* __restrict__ V,
                                            const float* __restrict__ g, const float* __restrict__ bta, float* __restrict__ out, bf16* __restrict__ outb, int t, float* smem) {
    const int tid = threadIdx.x, lane = tid & 63, wid = tid >> 6;
    float (*accs)[1024] = (float (*)[1024])smem;
    float* sred = smem + 8192;
    const float4* xr = (const float4*)(X + (size_t)t * D);
    float4 xv[4];
#pragma unroll
    for (int j = 0; j < 4; ++j) xv[j] = xr[lane + 64 * j];
    float4 acc[4];
#pragma unroll
    for (int j = 0; j < 4; ++j) acc[j] = make_float4(0.f, 0.f, 0.f, 0.f);
    for (int e = 0; e < 16; ++e) {
        const int id = EXP[(size_t)t * 128 + wid * 16 + e];
        const float gt = GATE[(size_t)t * 128 + wid * 16 + e];
        const float4* ur = (const float4*)(U + (size_t)id * D);
        const float4* vr = (const float4*)(V + (size_t)id * D);
        float4 uv[4], vv[4];
#pragma unroll
        for (int j = 0; j < 4; ++j) { uv[j] = ur[lane + 64 * j]; vv[j] = vr[lane + 64 * j]; }
        float dot = 0.f;
#pragma unroll
        for (int j = 0; j < 4; ++j) dot += uv[j].x * xv[j].x + uv[j].y * xv[j].y + uv[j].z * xv[j].z + uv[j].w * xv[j].w;
        dot = wave_sum(dot);
        const float cf = gt * geluf_(dot);
#pragma unroll
        for (int j = 0; j < 4; ++j) { acc[j].x += cf * vv[j].x; acc[j].y += cf * vv[j].y; acc[j].z += cf * vv[j].z; acc[j].w += cf * vv[j].w; }
    }
#pragma unroll
    for (int j = 0; j < 4; ++j) *(float4*)&accs[wid][(lane + 64 * j) * 4] = acc[j];
    __syncthreads();
    float v[2];
#pragma unroll
    for (int i = 0; i < 2; ++i) {
        const int c = tid * 2 + i;
        float s = 0.f;
#pragma unroll
        for (int w = 0; w < 8; ++w) s += accs[w][c];
        v[i] = ALPHA * X[(size_t)t * D + c] + s;
    }
    float s = wave_sum(v[0] + v[1]);
    if (lane == 0) sred[wid] = s;
    __syncthreads();
    float mean = 0.f;
#pragma unroll
    for (int w = 0; w < 8; ++w) mean += sred[w];
    mean *= (1.0f / 1024.0f);
    __syncthreads();
    const float d0 = v[0] - mean, d1 = v[1] - mean;
    float q = wave_sum(d0 * d0 + d1 * d1);
    if (lane == 0) sred[wid] = q;
    __syncthreads();
    float var = 0.f;
#pragma unroll
    for (int w = 0; w < 8; ++w) var += sred[w];
    const float rs = rsqrtf(var * (1.0f / 1024.0f) + LN_EPS);
    const float o0 = d0 * rs * g[tid * 2] + bta[tid * 2], o1 = d1 * rs * g[tid * 2 + 1] + bta[tid * 2 + 1];
    *(float2*)(out + (size_t)t * D + tid * 2) = make_float2(o0, o1);
    if (outb) *(unsigned*)(outb + (size_t)t * D + tid * 2) = pk2(o0, o1);
}


typedef __bf16 bf16x2_t __attribute__((ext_vector_type(2)));
__device__ __forceinline__ float dot2bf(unsigned w, unsigned x, float acc) { return __builtin_amdgcn_fdot2_f32_bf16(__builtin_bit_cast(bf16x2_t, w), __builtin_bit_cast(bf16x2_t, x), acc, false); }
__device__ __forceinline__ float bflo(unsigned w) { return __uint_as_float(w << 16); }
__device__ __forceinline__ float bfhi(unsigned w) { return __uint_as_float(w & 0xffff0000u); }
#define PE_LOAD(UB, VB, grp) do { _Pragma("unroll") for (int i_ = 0; i_ < 2; ++i_) { const int e_ = (grp) * 2 + i_; \
        const int id_ = __builtin_amdgcn_readlane(e_ < 64 ? id0 : id1, e_ & 63); \
        const unsigned so_ = (unsigned)id_ * 2048u; \
        UB[i_][0] = __builtin_amdgcn_raw_buffer_load_b128(ursrc, voff, so_, 0); UB[i_][1] = __builtin_amdgcn_raw_buffer_load_b128(ursrc, voff + 1024, so_, 0); \
        VB[i_][0] = __builtin_amdgcn_raw_buffer_load_b128(vrsrc, voff, so_, 0); VB[i_][1] = __builtin_amdgcn_raw_buffer_load_b128(vrsrc, voff + 1024, so_, 0); } } while (0)
#define PE_COMP(UB, VB, grp) do { float d_[2]; \
        _Pragma("unroll") for (int i_ = 0; i_ < 2; ++i_) { float a_ = 0.f, b_ = 0.f; \
            a_ = dot2bf(UB[i_][0].x, xb[0].x, a_); b_ = dot2bf(UB[i_][0].y, xb[0].y, b_); a_ = dot2bf(UB[i_][0].z, xb[0].z, a_); b_ = dot2bf(UB[i_][0].w, xb[0].w, b_); \
            a_ = dot2bf(UB[i_][1].x, xb[1].x, a_); b_ = dot2bf(UB[i_][1].y, xb[1].y, b_); a_ = dot2bf(UB[i_][1].z, xb[1].z, a_); b_ = dot2bf(UB[i_][1].w, xb[1].w, b_); d_[i_] = a_ + b_; } \
          \
        float r_ = hi32 ? d_[1] : d_[0], t0_ = hi32 ? d_[0] : d_[1]; r_ += __shfl_xor(t0_, 32); \
        r_ += __shfl_xor(r_, 16); r_ += __shfl_xor(r_, 8); r_ += __shfl_xor(r_, 4); r_ += __shfl_xor(r_, 2); r_ += __shfl_xor(r_, 1); \
        const float cfl_ = geluf_(r_); \
        _Pragma("unroll") for (int i_ = 0; i_ < 2; ++i_) { const int e_ = (grp) * 2 + i_; \
            const float cf_ = __uint_as_float(__builtin_amdgcn_readlane(__float_as_uint(cfl_), 32 * i_)) * __uint_as_float(__builtin_amdgcn_readlane(__float_as_uint(e_ < 64 ? g0 : g1), e_ & 63)); \
            _Pragma("unroll") for (int j_ = 0; j_ < 2; ++j_) { \
                acc[j_ * 8 + 0] += cf_ * bflo(VB[i_][j_].x); acc[j_ * 8 + 1] += cf_ * bfhi(VB[i_][j_].x); acc[j_ * 8 + 2] += cf_ * bflo(VB[i_][j_].y); acc[j_ * 8 + 3] += cf_ * bfhi(VB[i_][j_].y); \
                acc[j_ * 8 + 4] += cf_ * bflo(VB[i_][j_].z); acc[j_ * 8 + 5] += cf_ * bfhi(VB[i_][j_].z); acc[j_ * 8 + 6] += cf_ * bflo(VB[i_][j_].w); acc[j_ * 8 + 7] += cf_ * bfhi(VB[i_][j_].w); } } } while (0)
__device__ __forceinline__ void peer_expert_w(const float* __restrict__ xrow, const bf16* __restrict__ xbrow, const int* __restrict__ exr, const float* __restrict__ gar,
                                              const bf16* __restrict__ U, const bf16* __restrict__ V,
                                              const float* __restrict__ g, const float* __restrict__ bta, float* __restrict__ orow, bf16* __restrict__ obrow, int lane) {
    const bool hi32 = (lane & 32) != 0;
    const __amdgpu_buffer_rsrc_t ursrc = __builtin_amdgcn_make_buffer_rsrc((void*)U, 0, 16384 * 2048, 0x00020000);
    const __amdgpu_buffer_rsrc_t vrsrc = __builtin_amdgcn_make_buffer_rsrc((void*)V, 0, 16384 * 2048, 0x00020000);
    const int voff = lane * 16;
    v4u xb[2]; xb[0] = *(const v4u*)(xbrow + lane * 8); xb[1] = *(const v4u*)(xbrow + 512 + lane * 8);
    const int id0 = exr[lane], id1 = exr[64 + lane]; const float g0 = gar[lane], g1 = gar[64 + lane];
    float acc[16];
#pragma unroll
    for (int i = 0; i < 16; ++i) acc[i] = 0.f;
    v4u ua[2][2], va[2][2], ub[2][2], vb[2][2];
    PE_LOAD(ua, va, 0);
#pragma unroll 1
    for (int grp = 0; grp < 64; grp += 2) {
        PE_LOAD(ub, vb, grp + 1);
        PE_COMP(ua, va, grp);
        if (grp + 2 < 64) PE_LOAD(ua, va, grp + 2);
        PE_COMP(ub, vb, grp + 1);
    }
    float v[16]; float s = 0.f;
#pragma unroll
    for (int j = 0; j < 2; ++j) {
        const f32x4 x0 = *(const f32x4*)(xrow + j * 512 + lane * 8), x1 = *(const f32x4*)(xrow + j * 512 + lane * 8 + 4);
        v[j * 8 + 0] = ALPHA * x0.x + acc[j * 8 + 0]; v[j * 8 + 1] = ALPHA * x0.y + acc[j * 8 + 1]; v[j * 8 + 2] = ALPHA * x0.z + acc[j * 8 + 2]; v[j * 8 + 3] = ALPHA * x0.w + acc[j * 8 + 3];
        v[j * 8 + 4] = ALPHA * x1.x + acc[j * 8 + 4]; v[j * 8 + 5] = ALPHA * x1.y + acc[j * 8 + 5]; v[j * 8 + 6] = ALPHA * x1.z + acc[j * 8 + 6]; v[j * 8 + 7] = ALPHA * x1.w + acc[j * 8 + 7];
    }
#pragma unroll
    for (int i = 0; i < 16; ++i) s += v[i];
    const float mean = wave_sum(s) * (1.0f / 1024.0f); float q = 0.f;
#pragma unroll
    for (int i = 0; i < 16; ++i) { v[i] -= mean; q += v[i] * v[i]; }
    const float rs = rsqrtf(wave_sum(q) * (1.0f / 1024.0f) + LN_EPS);
#pragma unroll
    for (int j = 0; j < 2; ++j) {
        const int c0 = j * 512 + lane * 8;
        const f32x4 ga = *(const f32x4*)(g + c0), gb = *(const f32x4*)(g + c0 + 4), ba = *(const f32x4*)(bta + c0), bb = *(const f32x4*)(bta + c0 + 4);
        f32x4 oa, ob;
        oa.x = v[j * 8 + 0] * rs * ga.x + ba.x; oa.y = v[j * 8 + 1] * rs * ga.y + ba.y; oa.z = v[j * 8 + 2] * rs * ga.z + ba.z; oa.w = v[j * 8 + 3] * rs * ga.w + ba.w;
        ob.x = v[j * 8 + 4] * rs * gb.x + bb.x; ob.y = v[j * 8 + 5] * rs * gb.y + bb.y; ob.z = v[j * 8 + 6] * rs * gb.z + bb.z; ob.w = v[j * 8 + 7] * rs * gb.w + bb.w;
        *(f32x4*)(orow + c0) = oa; *(f32x4*)(orow + c0 + 4) = ob;
        if (obrow) { v4u w; w.x = pk2(oa.x, oa.y); w.y = pk2(oa.z, oa.w); w.z = pk2(ob.x, ob.y); w.w = pk2(ob.z, ob.w); *(v4u*)(obrow + c0) = w; }
    }
}

__device__ __forceinline__ int t5_bucket(int n) {
    if (n < 16) return n;
    const int large = 16 + (int)(logf((float)n / 16.0f) / 2.0794415416798357f * 16.0f);
    return large < 31 ? large : 31;
}
__device__ __forceinline__ void swa_attn(const float* __restrict__ PC, const float* __restrict__ cache_k, const float* __restrict__ cache_v,
                                         const float* __restrict__ rel_bias, const float* __restrict__ sinks, bf16* __restrict__ ATT, int bx) {
    const int tid = threadIdx.x, lane = tid & 63, wid = tid >> 6;
    const int gw = bx * 8 + wid;
    const int t = gw >> 4, h = gw & 15, kvh = h >> 2;
    if (t >= NT) return;
    const bool samp = t >= NP; const int sb = t - NP, pos = t % SEQ;
    const float* qrow = PC + (size_t)t * CN + h * 64;
    float lg[2]; bool valid[2];
#pragma unroll
    for (int rr = 0; rr < 2; ++rr) {
        const int r = lane + 64 * rr;
        const float* krow;
        if (!samp) { valid[rr] = (pos - r) >= 0; krow = PC + (size_t)(valid[rr] ? t - r : t) * CN + 1024 + kvh * 64; }
        else { valid[rr] = true; krow = (r == 0) ? PC + (size_t)t * CN + 1024 + kvh * 64 : cache_k + (((size_t)sb * 128 + (128 - r)) * 4 + kvh) * 64; }
        float dot = 0.f;
#pragma unroll
        for (int d4 = 0; d4 < 16; ++d4) {
            const float4 kv = *(const float4*)(krow + d4 * 4);
            const float4 qv = *(const float4*)(qrow + d4 * 4);
            dot += qv.x * kv.x + qv.y * kv.y + qv.z * kv.z + qv.w * kv.w;
        }
        lg[rr] = valid[rr] ? dot * 0.125f + rel_bias[t5_bucket(r) * 16 + h] : -INFINITY;
    }
    const float sink = sinks[h];
    const float m = fmaxf(wave_max(fmaxf(lg[0], lg[1])), sink);
    float p[2];
#pragma unroll
    for (int rr = 0; rr < 2; ++rr) p[rr] = valid[rr] ? expf(lg[rr] - m) : 0.f;
    const float den = wave_sum(p[0] + p[1]) + expf(sink - m);
    const float inv = 1.0f / den;
    float o = 0.f;
#pragma unroll
    for (int rr = 0; rr < 2; ++rr)
        for (int l2 = 0; l2 < 64; ++l2) {
            const int r = l2 + 64 * rr;
            const float pj = __shfl(p[rr], l2);
            if (pj != 0.f) {
                const float* vrow;
                if (!samp) vrow = PC + (size_t)(t - r) * CN + 1280 + kvh * 64;
                else vrow = (r == 0) ? PC + (size_t)t * CN + 1280 + kvh * 64 : cache_v + (((size_t)sb * 128 + (128 - r)) * 4 + kvh) * 64;
                o += pj * vrow[lane];
            }
        }
    ATT[(size_t)t * D + h * 64 + lane] = (bf16)f2bf(o * inv);
}

__device__ __forceinline__ void swa_kv_out(const float* __restrict__ PC, const float* __restrict__ cache_k, const float* __restrict__ cache_v,
                                           float* __restrict__ pk, float* __restrict__ pv, float* __restrict__ sk, float* __restrict__ sv, int vb) {
    const int c = threadIdx.x & 255, row = vb * 2 + (threadIdx.x >> 8);
    if (row < NB * 128) {
        const int b = row >> 7, i = row & 127;
        const float* src = PC + (size_t)(b * SEQ + SEQ - 128 + i) * CN;
        pk[(size_t)row * 256 + c] = src[1024 + c];
        pv[(size_t)row * 256 + c] = src[1280 + c];
    } else {
        const int r2 = row - NB * 128, sb = r2 >> 7, i = r2 & 127;
        if (i < 127) {
            sk[(size_t)r2 * 256 + c] = cache_k[((size_t)sb * 128 + i + 1) * 256 + c];
            sv[(size_t)r2 * 256 + c] = cache_v[((size_t)sb * 128 + i + 1) * 256 + c];
        } else {
            const float* src = PC + (size_t)(NP + sb) * CN;
            sk[(size_t)r2 * 256 + c] = src[1024 + c];
            sv[(size_t)r2 * 256 + c] = src[1280 + c];
        }
    }
}
#define XB_TMO      128
#define XB_XCNT(j)  (256  + 64 * (j))
#define XB_XSUB(j)  (1280 + 64 * (j))
#define XB_XGEN(j)  (2304 + 64 * (j))
#define XB_TOP      3328
#define XB_TOPGEN   3392
#define XCD_BAR_WORDS 3456
#define XB_SPIN_CAP (1u << 18)

__device__ __forceinline__ unsigned xb_ld(unsigned* p)              { return __hip_atomic_load(p, __ATOMIC_RELAXED, __HIP_MEMORY_SCOPE_AGENT); }
__device__ __forceinline__ unsigned xb_add(unsigned* p, unsigned v) { return __hip_atomic_fetch_add(p, v, __ATOMIC_RELAXED, __HIP_MEMORY_SCOPE_AGENT); }
__device__ __forceinline__ unsigned xb_xcc_id() { return (unsigned)__builtin_amdgcn_s_getreg((3 << 11) | 20) & 0xFu; }
#define XB_SPIN(cond, bar) do { unsigned _sp = 0; while (cond) { __builtin_amdgcn_s_sleep(1); \
    if ((++_sp & 255u) == 0u) { if (xb_ld(&(bar)[XB_TMO])) break; if (_sp > XB_SPIN_CAP) { atomicAdd(&(bar)[XB_TMO], 1u); break; } } } } while (0)

struct XcdBarrier {
    unsigned* bar; unsigned x;
    volatile LAS unsigned* st;
};

__device__ __forceinline__ XcdBarrier xcd_barrier_post(unsigned* bar, volatile LAS unsigned* st) {
    XcdBarrier b; b.bar = bar; b.x = xb_xcc_id(); b.st = st;
    if (threadIdx.x == 0) (void)xb_add(&bar[XB_XCNT(b.x)], 1u);
    return b;
}
__device__ __forceinline__ void xcd_barrier_complete(unsigned* bar, unsigned x, unsigned& nloc, unsigned& nx) {
    const unsigned G = gridDim.x * gridDim.y * gridDim.z;
    unsigned sum, cnt, mine, sp = 0u;
    for (;;) {
        sum = 0u; cnt = 0u; mine = 0u;
#pragma unroll
        for (unsigned j = 0; j < 16; ++j) { const unsigned c = xb_ld(&bar[XB_XCNT(j)]); sum += c; cnt += (c > 0u) ? 1u : 0u; mine = (j == x) ? c : mine; }
        if (sum == G) break;
        __builtin_amdgcn_s_sleep(1);
        if ((++sp & 255u) == 0u) { if (xb_ld(&bar[XB_TMO])) break; if (sp > XB_SPIN_CAP) { atomicAdd(&bar[XB_TMO], 1u); break; } }
    }
    nloc = mine > 0u ? mine : 1u; nx = cnt > 0u ? cnt : 1u;
}

__device__ __forceinline__ void xcd_barrier(const XcdBarrier& b) {
    asm volatile("s_waitcnt vmcnt(0)" ::: "memory");
    __syncthreads();
    if (threadIdx.x == 0) {
        unsigned* bar = b.bar;
        __builtin_amdgcn_s_waitcnt(0);
        unsigned nloc = b.st[0], nx = b.st[1];
        if (nloc == 0u) { xcd_barrier_complete(bar, b.x, nloc, nx); b.st[0] = nloc; b.st[1] = nx; }
        const unsigned old = xb_add(&bar[XB_XSUB(b.x)], 1u);
        const unsigned gen = old / nloc;
        if (old + 1u == (gen + 1u) * nloc) {
            __builtin_amdgcn_fence(__ATOMIC_RELEASE, "agent");
            asm volatile("s_waitcnt vmcnt(0)" ::: "memory");
            const unsigned og = xb_add(&bar[XB_TOP], 1u);
            const unsigned tg = og / nx;
            if (og + 1u == (tg + 1u) * nx) xb_add(&bar[XB_TOPGEN], 1u);
            else XB_SPIN(xb_ld(&bar[XB_TOPGEN]) == tg, bar);
            __builtin_amdgcn_fence(__ATOMIC_ACQUIRE, "agent");
            xb_add(&bar[XB_XGEN(b.x)], 1u);
            asm volatile("s_waitcnt vmcnt(0)" ::: "memory");
        } else {
            XB_SPIN(xb_ld(&bar[XB_XGEN(b.x)]) == gen, bar);
            __builtin_amdgcn_fence(__ATOMIC_ACQUIRE, "agent");
            asm volatile("s_waitcnt vmcnt(0)" ::: "memory");
        }
    }
    __syncthreads();
}

typedef short bf16x8_t __attribute__((ext_vector_type(8)));
__device__ __forceinline__ f32x4 mfma16(bf16x8_t a, bf16x8_t b, f32x4 c) { return __builtin_amdgcn_mfma_f32_16x16x32_bf16(a, b, c, 0, 0, 0); }

struct GdnChunkBufs {
    bf16* W;
    bf16* QG;
    bf16* KDT;
    bf16* UT;
    bf16* QK;
    float* EGL;
};

constexpr int GP_QB = 0, GP_KB = 17408, GP_VB = 34816, GP_LS = 52224, GP_QKS = 69632, GP_WS = 78848, GP_SC = 96256;

__device__ __forceinline__ void gdn_prep_unit(const bf16* __restrict__ PROJ, const float* __restrict__ conv_w, const float* __restrict__ a_log, const float* __restrict__ dt_bias,
                                              const GdnChunkBufs& cb, float* __restrict__ p_gdn_conv, int un, unsigned char* lds) {
    int tid = threadIdx.x; asm volatile("" : "+v"(tid));
    const int lane = tid & 63, wave = __builtin_amdgcn_readfirstlane(tid >> 6), fr = lane & 15, fq = lane >> 4;
    const int h = un & 3, n = (un >> 2) & 63, b = un >> 8;
    const int t0 = b * SEQ + n * 64;
    bf16* Qb = (bf16*)(lds + GP_QB); bf16* Kb = (bf16*)(lds + GP_KB); bf16* Vb = (bf16*)(lds + GP_VB); bf16* Ws = (bf16*)(lds + GP_WS);
    float* Ls = (float*)(lds + GP_LS); bf16* QKs = (bf16*)(lds + GP_QKS);
    float* gcs = (float*)(lds + GP_SC); float* bets = gcs + 64; float* egcs = gcs + 128; float* ekds = gcs + 192; float* begs = gcs + 256;
    if (wave == 0) {
        const bf16* prow = PROJ + (size_t)(t0 + lane) * ABN;
        const float a_raw = bf2f(prow[C_A + h]), b_raw = bf2f(prow[C_B + h]);
        float g = -expf(a_log[h]) * softplusf_(a_raw + dt_bias[h]);
#pragma unroll
        for (int off = 1; off < 64; off <<= 1) { const float v = __shfl_up(g, off); if (lane >= off) g += v; }
        const float glast = __shfl(g, 63);
        { const float be_ = sigmoidf_(b_raw), eg_ = expf(g); gcs[lane] = g; bets[lane] = be_; egcs[lane] = eg_; ekds[lane] = expf(glast - g); begs[lane] = be_ * eg_; }
        if (lane == 0) cb.EGL[un] = expf(glast);
    }
    {
        int cols[6]; float cw[4][6], xw[3][6];
#pragma unroll
        for (int p = 0; p < 3; ++p)
#pragma unroll
            for (int e = 0; e < 2; ++e) cols[p * 2 + e] = p * 512 + h * 128 + e * 64 + lane;
#pragma unroll
        for (int i = 0; i < 4; ++i)
#pragma unroll
            for (int c = 0; c < 6; ++c) cw[i][c] = conv_w[i * 1536 + cols[c]];
        const int i0 = wave * 8;
#pragma unroll
        for (int k = 0; k < 3; ++k) {
            const int pos = n * 64 + i0 - 3 + k;
#pragma unroll
            for (int c = 0; c < 6; ++c) xw[k][c] = pos >= 0 ? bf2f(PROJ[(size_t)(t0 + i0 - 3 + k) * ABN + cols[c]]) : 0.f;
        }
#pragma unroll
        for (int ii = 0; ii < 8; ++ii) {
            const int i = i0 + ii;
            float xt[6], s[6];
#pragma unroll
            for (int c = 0; c < 6; ++c) xt[c] = bf2f(PROJ[(size_t)(t0 + i) * ABN + cols[c]]);
#pragma unroll
            for (int c = 0; c < 6; ++c) s[c] = siluf_(cw[0][c] * xw[0][c] + cw[1][c] * xw[1][c] + cw[2][c] * xw[2][c] + cw[3][c] * xt[c]);
            const float qs = rsqrtf(wave_sum(s[0] * s[0] + s[1] * s[1]) + 1e-6f) * 0.08838834764831845f;
            const float ks = rsqrtf(wave_sum(s[2] * s[2] + s[3] * s[3]) + 1e-6f);
            Qb[i * 136 + lane] = (bf16)f2bf(s[0] * qs); Qb[i * 136 + 64 + lane] = (bf16)f2bf(s[1] * qs);
            Kb[i * 136 + lane] = (bf16)f2bf(s[2] * ks); Kb[i * 136 + 64 + lane] = (bf16)f2bf(s[3] * ks);
            Vb[i * 136 + lane] = (bf16)f2bf(s[4]);      Vb[i * 136 + 64 + lane] = (bf16)f2bf(s[5]);
            if (n == 63 && i >= 61) {
#pragma unroll
                for (int c = 0; c < 6; ++c) p_gdn_conv[((size_t)b * 3 + (i - 61)) * 1536 + cols[c]] = xt[c];
            }
#pragma unroll
            for (int c = 0; c < 6; ++c) { xw[0][c] = xw[1][c]; xw[1][c] = xw[2][c]; xw[2][c] = xt[c]; }
        }
    }
    __syncthreads();
    {
        const int mi = wave >> 1;
        bf16x8_t aK[4], aQ[4];
#pragma unroll
        for (int ks = 0; ks < 4; ++ks) { aK[ks] = *(const bf16x8_t*)(Kb + (mi * 16 + fr) * 136 + ks * 32 + 8 * fq); aQ[ks] = *(const bf16x8_t*)(Qb + (mi * 16 + fr) * 136 + ks * 32 + 8 * fq); }
#pragma unroll
        for (int nn = 0; nn < 2; ++nn) {
            const int nj = (wave & 1) * 2 + nn;
            f32x4 accK = (f32x4){0.f, 0.f, 0.f, 0.f}, accQ = accK;
#pragma unroll
            for (int ks = 0; ks < 4; ++ks) { const bf16x8_t bk = *(const bf16x8_t*)(Kb + (nj * 16 + fr) * 136 + ks * 32 + 8 * fq); accK = mfma16(aK[ks], bk, accK); accQ = mfma16(aQ[ks], bk, accQ); }
            const int j = nj * 16 + fr; const float gj = gcs[j];
#pragma unroll
            for (int r = 0; r < 4; ++r) {
                const int i = mi * 16 + 4 * fq + r;
                const float dec = i >= j ? expf(gcs[i] - gj) : 0.f;
                Ls[i * 68 + j] = i > j ? bets[i] * accK[r] * dec : 0.f;
                QKs[i * 72 + j] = (bf16)f2bf(i >= j ? accQ[r] * dec : 0.f);
            }
        }
    }
    __syncthreads();
    if (wave < 4) {
        float x[64];
        const bool isu = tid < 128; const int c = isu ? tid : tid - 128;
        const LAS unsigned char* l3 = (const LAS unsigned char*)lds;
        unsigned so = (isu ? GP_VB : GP_KB) + c * 2, ro = GP_SC + (isu ? 64 * 4 : 256 * 4), lo = GP_LS;
        asm volatile("" : "+v"(so), "+v"(ro), "+v"(lo));
#pragma unroll
        for (int i = 0; i < 64; ++i) {
            float acc = *(const LAS float*)(l3 + ro + 4 * i) * bf2f(*(const LAS bf16*)(l3 + so + i * 272));
#pragma unroll
            for (int j4 = 0; j4 < (i + 3) / 4; ++j4) {
                const f32x4 l4 = *(const LAS f32x4*)(l3 + lo + i * 272 + j4 * 16);
                acc -= l4.x * x[j4 * 4 + 0];
                if (j4 * 4 + 1 < i) acc -= l4.y * x[j4 * 4 + 1];
                if (j4 * 4 + 2 < i) acc -= l4.z * x[j4 * 4 + 2];
                if (j4 * 4 + 3 < i) acc -= l4.w * x[j4 * 4 + 3];
            }
            x[i] = acc;
        }
        if (isu) {
            bf16* dst = cb.UT + ((size_t)un * 128 + c) * 64;
#pragma unroll
            for (int i8 = 0; i8 < 8; ++i8) { v4u o; o.x = pk2(x[i8 * 8 + 0], x[i8 * 8 + 1]); o.y = pk2(x[i8 * 8 + 2], x[i8 * 8 + 3]); o.z = pk2(x[i8 * 8 + 4], x[i8 * 8 + 5]); o.w = pk2(x[i8 * 8 + 6], x[i8 * 8 + 7]); *(v4u*)(dst + i8 * 8) = o; }
        } else {
#pragma unroll
            for (int i = 0; i < 64; ++i) Ws[i * 136 + c] = (bf16)f2bf(x[i]);
        }
    } else {
        const int t2 = tid - 256;
#pragma unroll
        for (int k = 0; k < 4; ++k) {
            const int ci = t2 + 256 * k, i = ci >> 4, d0 = (ci & 15) * 8; const float e = egcs[i];
            const v4u q = *(const v4u*)(Qb + i * 136 + d0);
            v4u o; o.x = pk2(bflo(q.x) * e, bfhi(q.x) * e); o.y = pk2(bflo(q.y) * e, bfhi(q.y) * e); o.z = pk2(bflo(q.z) * e, bfhi(q.z) * e); o.w = pk2(bflo(q.w) * e, bfhi(q.w) * e);
            *(v4u*)(cb.QG + ((size_t)un * 64 + i) * 128 + d0) = o;
        }
#pragma unroll
        for (int k = 0; k < 4; ++k) {
            const int ci = t2 + 256 * k, d = ci & 127, i0 = (ci >> 7) * 8;
            float v[8];
#pragma unroll
            for (int q = 0; q < 8; ++q) v[q] = bf2f(Kb[(i0 + q) * 136 + d]) * ekds[i0 + q];
            v4u o; o.x = pk2(v[0], v[1]); o.y = pk2(v[2], v[3]); o.z = pk2(v[4], v[5]); o.w = pk2(v[6], v[7]);
            *(v4u*)(cb.KDT + ((size_t)un * 128 + d) * 64 + i0) = o;
        }
#pragma unroll
        for (int k = 0; k < 2; ++k) {
            const int ci = t2 + 256 * k, i = ci >> 3, j0 = (ci & 7) * 8;
            *(v4u*)(cb.QK + ((size_t)un * 64 + i) * 64 + j0) = *(const v4u*)(QKs + i * 72 + j0);
        }
    }
    __syncthreads();
#pragma unroll
    for (int k = 0; k < 2; ++k) {
        const int ci = tid + 512 * k, i = ci >> 4, d0 = (ci & 15) * 8;
        *(v4u*)(cb.W + ((size_t)un * 64 + i) * 128 + d0) = *(const v4u*)(Ws + i * 136 + d0);
    }
    __syncthreads();
}

constexpr int GS_ST = 0, GS_VNT = 2 * 32 * 136 * 2, GS_END = GS_VNT + 32 * 72 * 2;
__device__ __forceinline__ void gdn_seq(const GdnChunkBufs& cb, float* __restrict__ O, float* __restrict__ Sout, int b, int h, int sl, unsigned char* lds) {
    int tid = threadIdx.x; asm volatile("" : "+v"(tid));
    const int lane = tid & 63, wave = __builtin_amdgcn_readfirstlane(tid >> 6), fr = lane & 15, fq = lane >> 4;
    const int mi = wave >> 1, nj = wave & 1;
    bf16* St = (bf16*)(lds + GS_ST); bf16* VnT = (bf16*)(lds + GS_VNT);
    for (int i = tid; i < 2 * 32 * 136 / 2; i += NTH) ((unsigned*)St)[i] = 0u;
    f32x4 accS[2]; accS[0] = (f32x4){0.f, 0.f, 0.f, 0.f}; accS[1] = accS[0];
    bf16x8_t aW[4], aQG[4], aQK[2], aKD[2]; v2u ut; float egl;
#define GS_LOAD(un_) do { const size_t u_ = (size_t)(un_); \
        _Pragma("unroll") for (int ks = 0; ks < 4; ++ks) { aW[ks] = *(const bf16x8_t*)(cb.W + (u_ * 64 + mi * 16 + fr) * 128 + ks * 32 + 8 * fq); aQG[ks] = *(const bf16x8_t*)(cb.QG + (u_ * 64 + mi * 16 + fr) * 128 + ks * 32 + 8 * fq); } \
        _Pragma("unroll") for (int ks = 0; ks < 2; ++ks) { aQK[ks] = *(const bf16x8_t*)(cb.QK + (u_ * 64 + mi * 16 + fr) * 64 + ks * 32 + 8 * fq); aKD[ks] = *(const bf16x8_t*)(cb.KDT + (u_ * 128 + wave * 16 + fr) * 64 + ks * 32 + 8 * fq); } \
        ut = *(const v2u*)(cb.UT + (u_ * 128 + sl * 32 + nj * 16 + fr) * 64 + mi * 16 + 4 * fq); egl = cb.EGL[u_]; } while (0)
    int cur = 0;
    for (int n = 0; n < 64; ++n) {
        const int un = (b * 64 + n) * 4 + h;
        GS_LOAD(un);
        __syncthreads();
        f32x4 accW = (f32x4){0.f, 0.f, 0.f, 0.f}, accO = accW;
        const bf16* Sc = St + cur * 32 * 136;
#pragma unroll
        for (int ks = 0; ks < 4; ++ks) { const bf16x8_t bs = *(const bf16x8_t*)(Sc + (nj * 16 + fr) * 136 + ks * 32 + 8 * fq); accW = mfma16(aW[ks], bs, accW); accO = mfma16(aQG[ks], bs, accO); }
        const float v0 = bflo(ut.x) - accW[0], v1 = bfhi(ut.x) - accW[1], v2 = bflo(ut.y) - accW[2], v3 = bfhi(ut.y) - accW[3];
        { v2u o; o.x = pk2(v0, v1); o.y = pk2(v2, v3); *(v2u*)(VnT + (nj * 16 + fr) * 72 + mi * 16 + 4 * fq) = o; }
        __syncthreads();
#pragma unroll
        for (int ks = 0; ks < 2; ++ks) { const bf16x8_t bv = *(const bf16x8_t*)(VnT + (nj * 16 + fr) * 72 + ks * 32 + 8 * fq); accO = mfma16(aQK[ks], bv, accO); }
        {
            float* orow = O + (size_t)(b * SEQ + n * 64 + mi * 16 + 4 * fq) * 512 + h * 128 + sl * 32 + nj * 16 + fr;
            orow[0] = accO[0]; orow[512] = accO[1]; orow[1024] = accO[2]; orow[1536] = accO[3];
        }
        bf16* Sn = St + (cur ^ 1) * 32 * 136;
#pragma unroll
        for (int njj = 0; njj < 2; ++njj) {
            accS[njj] = accS[njj] * egl;
#pragma unroll
            for (int ks = 0; ks < 2; ++ks) { const bf16x8_t bv = *(const bf16x8_t*)(VnT + (njj * 16 + fr) * 72 + ks * 32 + 8 * fq); accS[njj] = mfma16(aKD[ks], bv, accS[njj]); }
            v2u o; o.x = pk2(accS[njj][0], accS[njj][1]); o.y = pk2(accS[njj][2], accS[njj][3]);
            *(v2u*)(Sn + (njj * 16 + fr) * 136 + wave * 16 + 4 * fq) = o;
        }
        cur ^= 1;
    }
#undef GS_LOAD
#pragma unroll
    for (int njj = 0; njj < 2; ++njj)
#pragma unroll
        for (int r = 0; r < 4; ++r) Sout[(((size_t)b * 4 + h) * 128 + wave * 16 + 4 * fq + r) * 128 + sl * 32 + njj * 16 + fr] = accS[njj][r];
    __syncthreads();
}

__device__ __forceinline__ void lru_prep_unit(const bf16* __restrict__ PROJ, const float* __restrict__ conv_w, const float* __restrict__ conv_b,
                                              const float* __restrict__ w_r, const float* __restrict__ b_r, const float* __restrict__ w_i, const float* __restrict__ b_i, const float* __restrict__ lam,
                                              float* __restrict__ H, float* __restrict__ P, float* __restrict__ Hend, float* __restrict__ Pend, float* __restrict__ p_lru_conv, int ub) {
    int c = threadIdx.x; asm volatile("" : "+v"(c));
    const int nblk = c >> 6, d = c & 63;
    const int n = ub & 63, b = ub >> 6, t0 = b * SEQ + n * 64;
    float wr[64], wi[64];
#pragma unroll
    for (int cc = 0; cc < 64; ++cc) { wr[cc] = w_r[((size_t)nblk * 64 + cc) * 64 + d]; wi[cc] = w_i[((size_t)nblk * 64 + cc) * 64 + d]; }
    const float cw0 = conv_w[c], cw1 = conv_w[512 + c], cw2 = conv_w[1024 + c], cw3 = conv_w[1536 + c], cb_ = conv_b[c];
    const float br = b_r[c], bi = b_i[c], spl = -8.0f * softplusf_(-lam[c]);
    float x0 = (n * 64 - 3 >= 0) ? bf2f(PROJ[(size_t)(t0 - 3) * ABN + C_XR + c]) : 0.f;
    float x1 = (n * 64 - 2 >= 0) ? bf2f(PROJ[(size_t)(t0 - 2) * ABN + C_XR + c]) : 0.f;
    float x2 = (n * 64 - 1 >= 0) ? bf2f(PROJ[(size_t)(t0 - 1) * ABN + C_XR + c]) : 0.f;
    float hloc = 0.f, ploc = 1.f;
    for (int i = 0; i < 64; ++i) {
        const float xt = bf2f(PROJ[(size_t)(t0 + i) * ABN + C_XR + c]);
        const float xr = cb_ + cw0 * x0 + cw1 * x1 + cw2 * x2 + cw3 * xt;
        float r = br, ii = bi;
#pragma unroll
        for (int cc = 0; cc < 64; ++cc) { const float xv = __uint_as_float(__builtin_amdgcn_readlane(__float_as_uint(xr), cc)); r += xv * wr[cc]; ii += xv * wi[cc]; }
        r = sigmoidf_(r); ii = sigmoidf_(ii);
        const float log_a = spl * r;
        const float a = expf(log_a), bb = sqrtf(-expm1f(2.0f * log_a)) * (ii * xr);
        hloc = a * hloc + bb; ploc *= a;
        H[(size_t)(t0 + i) * 512 + c] = hloc; P[(size_t)(t0 + i) * 512 + c] = ploc;
        if (n == 63 && i >= 61) p_lru_conv[((size_t)b * 3 + (i - 61)) * 512 + c] = xt;
        x0 = x1; x1 = x2; x2 = xt;
    }
    Hend[(size_t)ub * 512 + c] = hloc; Pend[(size_t)ub * 512 + c] = ploc;
}
__device__ __forceinline__ void lru_carry(const float* __restrict__ Hend, const float* __restrict__ Pend, float* __restrict__ CIN, float* __restrict__ hlast, int bx) {
    const int idx = bx * NTH + threadIdx.x, b = idx >> 9, c = idx & 511;
    float carry = 0.f;
#pragma unroll 8
    for (int n = 0; n < 64; ++n) {
        const size_t o = ((size_t)b * 64 + n) * 512 + c;
        CIN[o] = carry;
        carry = Hend[o] + Pend[o] * carry;
    }
    hlast[(size_t)b * 512 + c] = carry;
}

__device__ __forceinline__ unsigned f2key(float f) { const unsigned u = __float_as_uint(f); return u ^ ((u >> 31) ? 0xffffffffu : 0x80000000u); }
__device__ __forceinline__ float key2f(unsigned k) { return __uint_as_float(k ^ ((k >> 31) ? 0x80000000u : 0xffffffffu)); }
constexpr int TK_SS = 0, TK_TS = 2 * 64 * 129 * 4, TK_END = TK_TS + 64 * 2 * 16 * 4;
__device__ __forceinline__ void peer_topk2(const bf16* __restrict__ Q, const bf16* __restrict__ KB  , int* __restrict__ EXP, float* __restrict__ GATE,
                                           int tile, int h, unsigned char* lds) {
    int tid = threadIdx.x; asm volatile("" : "+v"(tid));
    const int lane = tid & 63, wave = __builtin_amdgcn_readfirstlane(tid >> 6), fr = lane & 15, fq = lane >> 4;
    float* Ss = (float*)(lds + TK_SS); unsigned* Ts = (unsigned*)(lds + TK_TS);
    {
        const int c = wave >> 2, mt = wave & 3;
        bf16x8_t a[4];
#pragma unroll
        for (int ks = 0; ks < 4; ++ks) a[ks] = *(const bf16x8_t*)(Q + (size_t)(tile * 64 + mt * 16 + fr) * 2048 + h * 256 + c * 128 + ks * 32 + 8 * fq);
        const bf16* kb = KB + ((size_t)(h * 2 + c) * 128) * 128;
#pragma unroll
        for (int nt = 0; nt < 8; ++nt) {
            f32x4 acc = (f32x4){0.f, 0.f, 0.f, 0.f};
#pragma unroll
            for (int ks = 0; ks < 4; ++ks) { const bf16x8_t bk = *(const bf16x8_t*)(kb + (size_t)(nt * 16 + fr) * 128 + ks * 32 + 8 * fq); acc = mfma16(a[ks], bk, acc); }
#pragma unroll
            for (int r = 0; r < 4; ++r) Ss[(c * 64 + mt * 16 + 4 * fq + r) * 129 + nt * 16 + fr] = acc[r];
        }
    }
    __syncthreads();
    if (tid < 128) {
        const float* row = Ss + tid * 129;
        unsigned top[16];
#pragma unroll
        for (int j = 0; j < 16; ++j) top[j] = 0u;
        for (int n = 0; n < 128; ++n) {
            unsigned x = (f2key(row[n]) & ~127u) | (unsigned)(127 - n);
#pragma unroll
            for (int j = 0; j < 16; ++j) { const unsigned t = top[j] > x ? top[j] : x; x = top[j] > x ? x : top[j]; top[j] = t; }
        }
        const int c = tid >> 6, tk = tid & 63;
#pragma unroll
        for (int j = 0; j < 16; ++j) Ts[(tk * 2 + c) * 16 + j] = top[j];
    }
    __syncthreads();
    if (tid < 64) {
        const int tk = tid;
        float s0[16], s1[16];
#pragma unroll
        for (int j = 0; j < 16; ++j) { s0[j] = key2f(Ts[(tk * 2 + 0) * 16 + j] & ~127u); s1[j] = key2f(Ts[(tk * 2 + 1) * 16 + j] & ~127u); }
        unsigned top[16];
#pragma unroll
        for (int j = 0; j < 16; ++j) top[j] = 0u;
#pragma unroll
        for (int i = 0; i < 16; ++i)
#pragma unroll
            for (int jj = 0; jj < 16; ++jj)
                if ((i + 1) * (jj + 1) <= 16) {
                    unsigned x = (f2key(s0[i] + s1[jj]) & ~255u) | (unsigned)(255 - (i * 16 + jj));
#pragma unroll
                    for (int j = 0; j < 16; ++j) { const unsigned t = top[j] > x ? top[j] : x; x = top[j] > x ? x : top[j]; top[j] = t; }
                }
        float e[16], sum = 0.f; const float m = key2f(top[0] & ~255u);
#pragma unroll
        for (int j = 0; j < 16; ++j) { e[j] = expf(key2f(top[j] & ~255u) - m); sum += e[j]; }
        const float inv = 1.0f / sum;
        const size_t o = (size_t)(tile * 64 + tk) * 128 + h * 16;
#pragma unroll
        for (int j = 0; j < 16; ++j) {
            const int code = 255 - (int)(top[j] & 255u), i = code >> 4, jj = code & 15;
            const int n0 = 127 - (int)(Ts[(tk * 2 + 0) * 16 + i] & 127u), n1 = 127 - (int)(Ts[(tk * 2 + 1) * 16 + jj] & 127u);
            EXP[o + j] = n0 * 128 + n1; GATE[o + j] = e[j] * inv;
        }
    }
    __syncthreads();
}

constexpr size_t MiB = 1u << 20;
constexpr size_t WS_CTL = 0, CTL_ZERO_BYTES = 64 * 1024;
constexpr size_t WS_WAB = 1 * MiB;
constexpr size_t WS_WOUT = WS_WAB + (size_t)ABNP * D * 2;
constexpr size_t WS_WQ0 = WS_WOUT + (size_t)D * D * 2;
constexpr size_t WS_WQ1 = WS_WQ0 + (size_t)2048 * D * 2;
constexpr size_t WS_WINC = WS_WQ1 + (size_t)2048 * D * 2;
constexpr size_t WS_WOUTC = WS_WINC + (size_t)CN * D * 2;
constexpr size_t WS_ABUF = WS_WOUTC + (size_t)D * D * 2;
constexpr size_t WS_P = WS_ABUF + (size_t)MP * D * 2;
constexpr size_t WS_T = WS_P + (size_t)MP * ABN * 2;
constexpr size_t WS_Q = WS_T + (size_t)2 * 16384 * D * 2;
constexpr size_t WS_A = WS_Q + (size_t)MP * 1536 * 4;
constexpr size_t WS_B = WS_A + (size_t)MP * 512 * 4;
constexpr size_t WS_O = WS_B + (size_t)MP * 512 * 4;
constexpr size_t WS_X1 = WS_O + (size_t)MP * 512 * 4;
constexpr size_t WS_G = WS_X1 + (size_t)MP * D * 4;
constexpr size_t WS_BETA = WS_G + (size_t)MP * 4 * 4;
constexpr size_t WS_GATE = WS_BETA + (size_t)MP * 4 * 4;
constexpr size_t WS_EXP = WS_GATE + (size_t)MP * 128 * 4;
constexpr size_t WS_HEND = WS_EXP + (size_t)MP * 128 * 4;
constexpr size_t WS_KEYS = WS_HEND + (size_t)3 * 4 * 64 * 512 * 4;
constexpr size_t WS_END = WS_KEYS + (size_t)2 * 8 * 2 * 128 * 128 * 2;
constexpr size_t Q_QKVS = 0, Q_W = 1 * MiB, Q_QG = Q_W + 16 * MiB, Q_KDT = Q_QG + 16 * MiB, Q_UT = Q_KDT + 16 * MiB, Q_QK = Q_UT + 16 * MiB, Q_EGL = Q_QK + 8 * MiB, Q_END = Q_EGL + 4096;
static_assert(Q_END <= (size_t)MP * 1536 * 4, "region Q");
static_assert(WS_END <= 512 * MiB, "d_ws map");

struct MegaArgs {
    const float* in[35];
    float* out;
    unsigned char* ws;
};

__global__ void __launch_bounds__(NTH, 2) fwd_megakernel(MegaArgs ma) {
    cg::grid_group grid = cg::this_grid();
    extern __shared__ __attribute__((aligned(16))) unsigned char lds[];
    float* smem = (float*)lds;
    const int nb = gridDim.x, b0 = blockIdx.x, tid = threadIdx.x, lane = tid & 63, wave = __builtin_amdgcn_readfirstlane(tid >> 6);
    const float* x_prompt = ma.in[0];
    const float* x_sample = ma.in[1];
    const float* state_gdn = ma.in[2];
    const float* state_gdn_conv = ma.in[3];
    const float* state_lru = ma.in[4];
    const float* state_lru_conv = ma.in[5];
    const float* cache_k = ma.in[6];
    const float* cache_v = ma.in[7];
    const float* w_in_ab = ma.in[8];
    const float* gdn_conv_w = ma.in[9];
    const float* gdn_a_log = ma.in[10];
    const float* gdn_dt_bias = ma.in[11];
    const float* gdn_norm_w = ma.in[12];
    const float* lru_conv_w = ma.in[13];
    const float* lru_conv_b = ma.in[14];
    const float* lru_w_r = ma.in[15];
    const float* lru_b_r = ma.in[16];
    const float* lru_w_i = ma.in[17];
    const float* lru_b_i = ma.in[18];
    const float* lru_lam = ma.in[19];
    const float* w_out_ab = ma.in[20];
    const float* w_in_c = ma.in[21];
    const float* b_in_c = ma.in[22];
    const float* swa_sinks = ma.in[23];
    const float* w_out_c = ma.in[24];
    const float* b_out_c = ma.in[25];
    const float* rel_bias = ma.in[26];
    const float* ln_mix_g = ma.in[27];
    const float* ln_mix_b = ma.in[28];
    const float* ln_ffn_g = ma.in[29];
    const float* ln_ffn_b = ma.in[30];
    const float* peer_w_q = ma.in[31];
    const float* peer_keys = ma.in[32];
    const float* peer_u = ma.in[33];
    const float* peer_v = ma.in[34];

    float* out = ma.out;
    float* o_y = out;
    float* o_p_gdn = out + (size_t)NT * D;
    float* o_p_gdn_conv = o_p_gdn + 262144;
    float* o_p_lru = o_p_gdn_conv + 18432;
    float* o_p_lru_conv = o_p_lru + 2048;
    float* o_p_k = o_p_lru_conv + 6144;
    float* o_p_v = o_p_k + 131072;
    float* o_s_gdn = o_p_v + 131072;
    float* o_s_gdn_conv = o_s_gdn + 8388608;
    float* o_s_lru = o_s_gdn_conv + 589824;
    float* o_s_lru_conv = o_s_lru + 65536;
    float* o_s_k = o_s_lru_conv + 196608;
    float* o_s_v = o_s_k + 4194304;

    unsigned char* ws = ma.ws;
    bf16* WAB_T = (bf16*)(ws + WS_WAB); bf16* WOUT_T = (bf16*)(ws + WS_WOUT); bf16* WQ0_T = (bf16*)(ws + WS_WQ0); bf16* WQ1_T = (bf16*)(ws + WS_WQ1);
    bf16* WINC_T = (bf16*)(ws + WS_WINC); bf16* WOUTC_T = (bf16*)(ws + WS_WOUTC);
    bf16* ABUF = (bf16*)(ws + WS_ABUF);
    bf16* PROJ = (bf16*)(ws + WS_P); float* Y = (float*)(ws + WS_P); bf16* Qb = (bf16*)(ws + WS_P); float* PC = (float*)(ws + WS_P); float* Y1 = (float*)(ws + WS_P);
    bf16* UV0 = (bf16*)(ws + WS_T); bf16* UV1 = (bf16*)(ws + WS_Q);
    float* R_Q = (float*)(ws + WS_Q + Q_QKVS) - (size_t)NP * 1536; float* X2 = (float*)(ws + WS_A);
    GdnChunkBufs cbuf; cbuf.W = (bf16*)(ws + WS_Q + Q_W); cbuf.QG = (bf16*)(ws + WS_Q + Q_QG); cbuf.KDT = (bf16*)(ws + WS_Q + Q_KDT); cbuf.UT = (bf16*)(ws + WS_Q + Q_UT); cbuf.QK = (bf16*)(ws + WS_Q + Q_QK); cbuf.EGL = (float*)(ws + WS_Q + Q_EGL);
    bf16* KEYSB = (bf16*)(ws + WS_KEYS);
    float* HEND = (float*)(ws + WS_HEND); float* PEND = HEND + 4 * 64 * 512; float* CIN = PEND + 4 * 64 * 512;
    float* R_A = (float*)(ws + WS_A); float* R_B = (float*)(ws + WS_B); float* R_O = (float*)(ws + WS_O);
    float* R_X1 = (float*)(ws + WS_X1); float* X3 = R_X1;
    float* R_G = (float*)(ws + WS_G); float* R_BETA = (float*)(ws + WS_BETA); float* R_GATE = (float*)(ws + WS_GATE); int* R_EXP = (int*)(ws + WS_EXP);

    for (int u = tid; u < (LDS_BYTES - RING_BYTES) / 4; u += NTH) ((unsigned*)(lds + RING_BYTES))[u] = 0u;
    __syncthreads();
    XcdBarrier bar = xcd_barrier_post((unsigned*)(ws + WS_CTL), (volatile LAS unsigned*)((LAS unsigned char*)lds + MISC_OFF) + 8);
#define GRID_BAR() xcd_barrier(bar)
#define PHASE_LOOP(n) for (int vb = b0; vb < (n); vb += nb)
#define PHASE_END __syncthreads()
#define GEMM_PHASE(EPI, Aptr, Btptr, Nn, ...) do { pg8::Gemm g_{(const pg8::bf16_t*)(Aptr), (const pg8::bf16_t*)(Btptr), MP, (Nn), D}; pg8::StaticOrder S_; S_.init(MP, (Nn), nb, b0); \
        pg8::EPI E_{__VA_ARGS__}; pg8::gemm_phase<pg8::EPI, pg8::StaticOrder, true, true>((PG8_LAS unsigned char*)lds, g_, S_, E_); } while (0)

    {
        float* scr = smem + wave * 4096;
        const int gw = b0 * NWAVES + wave, NGW = nb * NWAVES;
        constexpr int I_AB = 16 * 97, I_OUT = 16 * 32, I_Q = 16 * 64, I_INC = 16 * 48;
        constexpr int NITEMS = I_AB + I_OUT + 2 * I_Q + I_INC + I_OUT;
        for (int it = gw; it < NITEMS; it += NGW) {
            int r = it;
            if (r < I_AB) { p0_transpose_item(w_in_ab, D, ABN, WAB_T, scr, r, lane); continue; } r -= I_AB;
            if (r < I_OUT) { p0_transpose_item(w_out_ab, D, D, WOUT_T, scr, r, lane); continue; } r -= I_OUT;
            if (r < I_Q) { p0_transpose_item(peer_w_q, D, 2048, WQ0_T, scr, r, lane); continue; } r -= I_Q;
            if (r < I_Q) { p0_transpose_item(peer_w_q + (size_t)D * 2048, D, 2048, WQ1_T, scr, r, lane); continue; } r -= I_Q;
            if (r < I_INC) { p0_transpose_item(w_in_c, D, CN, WINC_T, scr, r, lane); continue; } r -= I_INC;
            p0_transpose_item(w_out_c, D, D, WOUTC_T, scr, r, lane);
        }
        for (int m = gw; m < 512; m += NGW) row_to_bf16(peer_keys + (size_t)m * D, KEYSB + (size_t)m * D, lane);
        for (int m = gw; m < 2 * 16384; m += NGW)
            row_to_bf16((m < 16384 ? peer_u : peer_v) + (size_t)(m & 16383) * D, UV0 + (size_t)m * D, lane);
        for (int m = gw; m < MP + (ABNP - 97 * 32); m += NGW) {
            if (m < MP) row_to_bf16(m < NP ? x_prompt + (size_t)m * D : (m < NT ? x_sample + (size_t)(m - NP) * D : nullptr), ABUF + (size_t)m * D, lane);
            else row_to_bf16(nullptr, WAB_T + (size_t)(97 * 32 + (m - MP)) * D, lane);
        }
    }
    grid.sync();
    GEMM_PHASE(EpiStoreBf16, ABUF, WAB_T, ABNP, PROJ, ABN, nullptr, NT, ABN);
    GRID_BAR();
    { AbPrepArgs pa;
      pa.PROJ = PROJ; pa.st_gdn_conv = state_gdn_conv; pa.st_lru_conv = state_lru_conv;
      pa.gdn_conv_w = gdn_conv_w; pa.a_log = gdn_a_log; pa.dt_bias = gdn_dt_bias;
      pa.lru_conv_w = lru_conv_w; pa.lru_conv_b = lru_conv_b; pa.w_r = lru_w_r; pa.b_r = lru_b_r; pa.w_i = lru_w_i; pa.b_i = lru_b_i; pa.lam = lru_lam;
      pa.QKV = R_Q; pa.G = R_G; pa.BETA = R_BETA; pa.LA = R_A; pa.LB = R_B;
      pa.p_gdn_conv = o_p_gdn_conv; pa.p_lru_conv = o_p_lru_conv; pa.s_gdn_conv = o_s_gdn_conv; pa.s_lru_conv = o_s_lru_conv;
      PHASE_LOOP(1024 + 256 + NS) {
          if (vb < 1024) gdn_prep_unit(PROJ, gdn_conv_w, gdn_a_log, gdn_dt_bias, cbuf, o_p_gdn_conv, vb, lds);
          else if (vb < 1280) lru_prep_unit(PROJ, lru_conv_w, lru_conv_b, lru_w_r, lru_b_r, lru_w_i, lru_b_i, lru_lam, R_B, R_A, HEND, PEND, o_p_lru_conv, vb - 1024);
          else { ab_prep(pa, NP + (vb - 1280), smem); PHASE_END; } } }
    GRID_BAR();
    if (b0 < 64) gdn_seq(cbuf, R_O, o_p_gdn, b0 >> 4, (b0 >> 2) & 3, b0 & 3, lds);
    else if (b0 < 68) lru_carry(HEND, PEND, CIN, o_p_lru, b0 - 64);
    else for (int v = b0 - 68; v < 2048 + 128; v += nb - 68) {
        if (v < 2048) gdn_scan(R_Q, R_G, R_BETA, state_gdn, R_O, o_s_gdn, NP, 1, v & 3, (v >> 2) & 3, v >> 4, smem);
        else lru_scan(R_A, R_B, state_lru, o_s_lru, NP, 1, NS, v - 2048);
        PHASE_END;
    }
    GRID_BAR();
    PHASE_LOOP(NT / 2) { ab_mix(PROJ, R_O, R_B, R_A, CIN, gdn_norm_w, ABUF, vb); }
    for (int m = b0 * NWAVES + wave; m < 2 * 16384; m += nb * NWAVES)
        row_to_bf16((m < 16384 ? peer_u : peer_v) + (size_t)(16384 + (m & 16383)) * D, UV1 + (size_t)m * D, lane);
    GRID_BAR();
    GEMM_PHASE(EpiStoreF32, ABUF, WOUT_T, D, Y, D, nullptr, NT, D);
    GRID_BAR();
    PHASE_LOOP(NT / 8) { const int t = vb * 8 + wave;
        ln_res_w(t < NP ? x_prompt + (size_t)t * D : x_sample + (size_t)(t - NP) * D, Y + (size_t)t * D, ln_mix_g, ln_mix_b, R_X1 + (size_t)t * D, ABUF + (size_t)t * D, lane); }
    GRID_BAR();
    GEMM_PHASE(EpiStoreBf16, ABUF, WQ0_T, 2048, Qb, 2048, nullptr, NT, 2048);
    GRID_BAR();
    PHASE_LOOP((NT / 64) * 8) { peer_topk2(Qb, KEYSB, R_EXP, R_GATE, vb >> 3, vb & 7, lds); }
    GRID_BAR();
    PHASE_LOOP(NT / 8) { const int t = vb * 8 + wave;
        peer_expert_w(R_X1 + (size_t)t * D, ABUF + (size_t)t * D, R_EXP + (size_t)t * 128, R_GATE + (size_t)t * 128, UV0, UV0 + (size_t)16384 * D, ln_ffn_g, ln_ffn_b, X2 + (size_t)t * D, ABUF + (size_t)t * D, lane); }
    GRID_BAR();

    GEMM_PHASE(EpiStoreF32, ABUF, WINC_T, CN, PC, CN, b_in_c, NT, CN);
    GRID_BAR();
    PHASE_LOOP(NT * 2 + (NB * 128 + NS * 128) / 2) {
        if (vb < NT * 2) swa_attn(PC, cache_k, cache_v, rel_bias, swa_sinks, ABUF, vb);
        else swa_kv_out(PC, cache_k, cache_v, o_p_k, o_p_v, o_s_k, o_s_v, vb - NT * 2);
    }
    GRID_BAR();
    GEMM_PHASE(EpiStoreF32, ABUF, WOUTC_T, D, Y1, D, b_out_c, NT, D);
    GRID_BAR();
    PHASE_LOOP(NT / 8) { const int t = vb * 8 + wave;
        ln_res_w(X2 + (size_t)t * D, Y1 + (size_t)t * D, ln_mix_g + D, ln_mix_b + D, X3 + (size_t)t * D, ABUF + (size_t)t * D, lane); }
    GRID_BAR();
    GEMM_PHASE(EpiStoreBf16, ABUF, WQ1_T, 2048, Qb, 2048, nullptr, NT, 2048);
    GRID_BAR();
    PHASE_LOOP((NT / 64) * 8) { peer_topk2(Qb, KEYSB + (size_t)8 * 2 * 128 * 128, R_EXP, R_GATE, vb >> 3, vb & 7, lds); }
    GRID_BAR();
    PHASE_LOOP(NT / 8) { const int t = vb * 8 + wave;
        peer_expert_w(X3 + (size_t)t * D, ABUF + (size_t)t * D, R_EXP + (size_t)t * 128, R_GATE + (size_t)t * 128, UV1, UV1 + (size_t)16384 * D, ln_ffn_g + D, ln_ffn_b + D, o_y + (size_t)t * D, nullptr, lane); }
}
}

extern "C" void kernel_launch(void* const* d_in, const int* in_sizes, int n_in,
                              void* d_out, int out_size, void* d_ws, size_t ws_size,
                              hipStream_t stream) {
    static int grid_blocks = 0;
    if (!grid_blocks) {
        int dev = 0, cus = 0, per_cu = 0;
        (void)hipGetDevice(&dev);
        (void)hipDeviceGetAttribute(&cus, hipDeviceAttributeMultiprocessorCount, dev);
        if (hipFuncSetAttribute((const void*)fwd_megakernel, hipFuncAttributeMaxDynamicSharedMemorySize, LDS_BYTES) != hipSuccess) { fprintf(stderr, "hipFuncSetAttribute failed\n"); grid_blocks = -1; return; }
        (void)hipOccupancyMaxActiveBlocksPerMultiprocessor(&per_cu, (const void*)fwd_megakernel, NTH, LDS_BYTES);
        if (per_cu < 1) { fprintf(stderr, "occupancy query says %d blocks per CU\n", per_cu); grid_blocks = -1; return; }
        grid_blocks = cus;
    }
    if (grid_blocks < 0) return;
    (void)hipMemsetAsync((char*)d_ws + WS_CTL, 0, CTL_ZERO_BYTES, stream);
    MegaArgs ma{};
    for (int i = 0; i < 35; ++i) ma.in[i] = (const float*)d_in[i];
    ma.out = (float*)d_out;
    ma.ws = (unsigned char*)d_ws;
    void* args[] = {&ma};
    hipError_t e = hipLaunchCooperativeKernel((void*)fwd_megakernel, dim3(grid_blocks), dim3(NTH), args, LDS_BYTES, stream);
    if (e != hipSuccess) fprintf(stderr, "cooperative launch failed: %s (grid %d)\n", hipGetErrorString(e), grid_blocks);
}
```

```cpp
#include <hip/hip_runtime.h>
#include <hip/hip_cooperative_groups.h>
#include <cstdio>
#include <cstdint>
namespace cg = cooperative_groups;

namespace pg8 {
#define PG8_LAS __attribute__((address_space(3)))
typedef unsigned short bf16_t;
typedef short bf16x8 __attribute__((ext_vector_type(8)));
typedef float f32x4 __attribute__((ext_vector_type(4)));
typedef unsigned u32x4 __attribute__((ext_vector_type(4)));
constexpr int BM = 256, BK = 64, HALF = 128, HTB = HALF * BK * 2  , STAGE_BYTES = 8 * HTB, NXCD = 8, WGM = 8;

__host__ __device__ __forceinline__ int lds_byte(int r, int c) { const int st = (r >> 4) * 2 + (c >> 5), rr = r & 15, cc = c & 31, ob = rr * 64 + cc * 2; return st * 1024 + (ob ^ (((ob >> 9) & 1) << 5)); }
__host__ __device__ __forceinline__ void stage_rc(int b, int& R, int& C) { const int st = b / 1024, sb = b % 1024, swz = sb ^ (((sb >> 9) & 1) << 5); R = (st >> 1) * 16 + swz / 64; C = (st & 1) * 32 + (swz % 64) / 2; }
__host__ __device__ __forceinline__ int perm32(int rho) { const int n = rho >> 4, i = rho & 15; return 8 * (i >> 2) + 4 * n + (i & 3); }

struct Unit { int pm, pn; };
struct Gemm { const bf16_t* A; const bf16_t* Bt; int M, N, K; };

struct StaticOrder {
    int nM, nN, nwg, G, c;
    __host__ __device__ void init(int M, int N, int G_, int c_) { nM = M / BM; nN = N / BM; nwg = nM * nN; G = G_; c = c_; }
    __host__ __device__ bool next(int i, Unit& u) const {
        const long L = (long)i * G + c; if (L >= nwg) return false;
        int wgid = (int)L; { const int q = nwg / NXCD, r = nwg % NXCD, xcd = wgid % NXCD, off = wgid / NXCD; wgid = (xcd < r ? xcd * (q + 1) : r * (q + 1) + (xcd - r) * q) + off; }
        const int nig = WGM * nN, gid = wgid / nig, fm = gid * WGM, gsz = (nM - fm) < WGM ? (nM - fm) : WGM;
        u.pm = fm + ((wgid % nig) % gsz); u.pn = (wgid % nig) / gsz; return true;
    }
    __device__ __forceinline__ void a_ready(const Unit&) const {}
    __device__ __forceinline__ void done(const Unit&) const {}
};

__device__ __forceinline__ unsigned cvt_pk_bf16(float lo, float hi) { unsigned r; asm volatile("v_cvt_pk_bf16_f32 %0, %1, %2" : "=v"(r) : "v"(lo), "v"(hi)); return r; }
template <class Epi, class Sched, bool ALIGN_EPI = false, bool SP2 = false>
__device__ __forceinline__ void gemm_phase(PG8_LAS unsigned char* lds, const Gemm g, const Sched& S, const Epi& E) {
    const int tid = threadIdx.x, wid = __builtin_amdgcn_readfirstlane(tid >> 6), lane = tid & 63, wr = wid >> 2, wc = wid & 3, fr = lane & 15, fq = lane >> 4;
    const int K = g.K, nt = K / BK;
    unsigned voffA[2], voffB[2];
#pragma unroll
    for (int i = 0; i < 2; ++i) { int R, C; stage_rc(tid * 16 + i * 8192, R, C); const int Rb = Epi::PERM ? ((R & ~31) + perm32(R & 31)) : R;
        voffA[i] = (unsigned)(R * K + C) * 2u; voffB[i] = (unsigned)(Rb * K + C) * 2u; }
    const size_t kstep = (size_t)(BK * 2);
    const size_t hstep = (size_t)HALF * K * 2;
    const size_t tstep = 2 * hstep;
    const unsigned ldsw = (unsigned)wid * 1024u;
    const int aoff = lds_byte(wr * 64 + fr, fq * 8), boff = lds_byte(wc * 32 + fr, fq * 8);
#define PG8_SA(b, h) (((b) * 2 + (h)) * HTB)
#define PG8_SB(b, h) ((4 + (b) * 2 + (h)) * HTB)
#define PG8_STAGE(bufoff, gbase, voff) do { _Pragma("unroll") for (int _i = 0; _i < 2; ++_i) \
        __builtin_amdgcn_global_load_lds((const unsigned*)((const char*)(gbase) + (voff)[_i]), (PG8_LAS unsigned*)(lds + (bufoff) + ldsw + _i * 8192), 16, 0, 0); } while (0)
#define PG8_LDA(dst, b, h) do { _Pragma("unroll") for (int m = 0; m < 4; ++m) _Pragma("unroll") for (int k = 0; k < 2; ++k) dst[m][k] = *(const PG8_LAS bf16x8*)(lds + PG8_SA(b, h) + aoff + m * 2048 + k * 1024); } while (0)
#define PG8_LDB(dst, b, h) do { _Pragma("unroll") for (int n = 0; n < 2; ++n) _Pragma("unroll") for (int k = 0; k < 2; ++k) dst[n][k] = *(const PG8_LAS bf16x8*)(lds + PG8_SB(b, h) + boff + n * 2048 + k * 1024); } while (0)
#define PG8_MMA(ai, bj, At, Bt) do { __builtin_amdgcn_s_setprio(1); _Pragma("unroll") for (int m = 0; m < 4; ++m) _Pragma("unroll") for (int n = 0; n < 2; ++n) _Pragma("unroll") for (int k = 0; k < 2; ++k) \
        acc[ai][bj][m][n] = __builtin_amdgcn_mfma_f32_16x16x32_bf16(Bt[n][k], At[m][k], acc[ai][bj][m][n], 0, 0, 0); __builtin_amdgcn_s_setprio(0); } while (0)
#define PG8_WAIT_V(n) asm volatile("s_waitcnt vmcnt(" #n ")" ::: "memory")
#define PG8_WAIT_L(n) asm volatile("s_waitcnt lgkmcnt(" #n ")" ::: "memory")
#define PG8_BAR __builtin_amdgcn_s_barrier()
#define PG8_SCHED __builtin_amdgcn_sched_barrier(0)
    Unit cur, nxt; int ui = 0;
    if (!S.next(0, cur)) return;
    f32x4 acc[2][2][4][2];
#pragma unroll
    for (int a = 0; a < 2; ++a)
#pragma unroll
        for (int b = 0; b < 2; ++b)
#pragma unroll
            for (int m = 0; m < 4; ++m)
#pragma unroll
                for (int n = 0; n < 2; ++n) acc[a][b][m][n] = (f32x4){0.f, 0.f, 0.f, 0.f};
    bf16x8 At[4][2], B0[2][2], B1[2][2];
    const char* cA = (const char*)g.A + (size_t)cur.pm * tstep; const char* cB = (const char*)g.Bt + (size_t)cur.pn * tstep;
    S.a_ready(cur);
    if constexpr (SP2) {
        PG8_STAGE(PG8_SB(0, 0), cB, voffB); PG8_STAGE(PG8_SB(0, 1), cB + hstep, voffB); PG8_STAGE(PG8_SA(0, 0), cA, voffA); PG8_STAGE(PG8_SA(0, 1), cA + hstep, voffA);
        if (wr == 1) PG8_BAR;
        PG8_WAIT_V(2); PG8_BAR;
        PG8_STAGE(PG8_SB(1, 0), cB + kstep, voffB); PG8_STAGE(PG8_SA(1, 0), cA + kstep, voffA); PG8_STAGE(PG8_SB(1, 1), cB + hstep + kstep, voffB);
        PG8_WAIT_V(6); PG8_BAR;
    } else {
        PG8_STAGE(PG8_SB(0, 0), cB, voffB); PG8_STAGE(PG8_SA(0, 0), cA, voffA); PG8_STAGE(PG8_SB(0, 1), cB + hstep, voffB); PG8_STAGE(PG8_SA(0, 1), cA + hstep, voffA);
        if (wr == 1) PG8_BAR;
        PG8_WAIT_V(4); PG8_BAR;
        PG8_STAGE(PG8_SB(1, 0), cB + kstep, voffB); PG8_STAGE(PG8_SA(1, 0), cA + kstep, voffA); PG8_STAGE(PG8_SB(1, 1), cB + hstep + kstep, voffB);
        PG8_WAIT_V(6); PG8_BAR;
    }
    for (;;) {
        const bool has_next = S.next(ui + 1, nxt);
        const char* nA = has_next ? (const char*)g.A + (size_t)nxt.pm * tstep : cA; const char* nB = has_next ? (const char*)g.Bt + (size_t)nxt.pn * tstep : cB;
        for (int t = 0; t < nt; t += 2) {
            const bool last = (t == nt - 2);
            const char* a1 = cA + (size_t)(t + 1) * kstep;
            const char* a2 = last ? nA : cA + (size_t)(t + 2) * kstep; const char* b2 = last ? nB : cB + (size_t)(t + 2) * kstep;
            const char* a3 = a2 + kstep; const char* b3 = b2 + kstep;
            if (last && has_next) S.a_ready(nxt);
            if constexpr (SP2) {
            PG8_LDB(B0, 0, 0); PG8_LDB(B1, 0, 1); PG8_SCHED; PG8_LDA(At, 0, 0); PG8_STAGE(PG8_SA(1, 1), a1 + hstep, voffA);
            PG8_WAIT_V(8); PG8_WAIT_L(0); PG8_BAR; PG8_MMA(0, 0, At, B0); PG8_MMA(0, 1, At, B1); PG8_BAR; PG8_SCHED;
            PG8_LDA(At, 0, 1); PG8_STAGE(PG8_SB(0, 0), b2, voffB); PG8_STAGE(PG8_SB(0, 1), b2 + hstep, voffB); PG8_STAGE(PG8_SA(0, 0), a2, voffA);
            PG8_WAIT_V(8); PG8_WAIT_L(0); PG8_BAR; PG8_MMA(1, 0, At, B0); PG8_MMA(1, 1, At, B1); PG8_BAR; PG8_SCHED;
            PG8_LDB(B0, 1, 0); PG8_LDB(B1, 1, 1); PG8_SCHED; PG8_LDA(At, 1, 0); PG8_STAGE(PG8_SA(0, 1), a2 + hstep, voffA);
            PG8_WAIT_V(8); PG8_WAIT_L(0); PG8_BAR; PG8_MMA(0, 0, At, B0); PG8_MMA(0, 1, At, B1); PG8_BAR; PG8_SCHED;
            PG8_LDA(At, 1, 1); PG8_STAGE(PG8_SB(1, 0), b3, voffB); PG8_STAGE(PG8_SB(1, 1), b3 + hstep, voffB); PG8_STAGE(PG8_SA(1, 0), a3, voffA);
            PG8_WAIT_V(8); PG8_WAIT_L(0); PG8_BAR; PG8_MMA(1, 0, At, B0); PG8_MMA(1, 1, At, B1); PG8_BAR; PG8_SCHED;
            } else {
            PG8_LDB(B0, 0, 0); PG8_SCHED; PG8_LDA(At, 0, 0); PG8_STAGE(PG8_SA(1, 1), a1 + hstep, voffA);
            PG8_WAIT_L(8); PG8_BAR; PG8_WAIT_L(0); PG8_MMA(0, 0, At, B0); PG8_BAR; PG8_SCHED;
            PG8_LDB(B1, 0, 1); PG8_STAGE(PG8_SB(0, 0), b2, voffB);
            PG8_BAR; PG8_WAIT_L(0); PG8_MMA(0, 1, At, B1); PG8_BAR;
            PG8_LDA(At, 0, 1); PG8_STAGE(PG8_SA(0, 0), a2, voffA);
            PG8_BAR; PG8_WAIT_L(0); PG8_MMA(1, 0, At, B0); PG8_BAR; PG8_SCHED;
            PG8_STAGE(PG8_SB(0, 1), b2 + hstep, voffB);
            PG8_WAIT_V(6); PG8_BAR; PG8_MMA(1, 1, At, B1); PG8_BAR;
            PG8_LDB(B0, 1, 0); PG8_SCHED; PG8_LDA(At, 1, 0); PG8_STAGE(PG8_SA(0, 1), a2 + hstep, voffA);
            PG8_WAIT_L(8); PG8_BAR; PG8_WAIT_L(0); PG8_MMA(0, 0, At, B0); PG8_BAR; PG8_SCHED;
            PG8_LDB(B1, 1, 1); PG8_STAGE(PG8_SB(1, 0), b3, voffB);
            PG8_BAR; PG8_WAIT_L(0); PG8_MMA(0, 1, At, B1); PG8_BAR;
            PG8_LDA(At, 1, 1); PG8_STAGE(PG8_SA(1, 0), a3, voffA);
            PG8_BAR; PG8_WAIT_L(0); PG8_MMA(1, 0, At, B0); PG8_BAR; PG8_SCHED;
            PG8_STAGE(PG8_SB(1, 1), b3 + hstep, voffB);
            PG8_WAIT_V(6); PG8_BAR; PG8_MMA(1, 1, At, B1); PG8_BAR;
            }
        }
        if constexpr (ALIGN_EPI) { if (wr == 0) PG8_BAR; }
        if constexpr (!Epi::AFTER_DRAIN) { E(acc, cur, wr, wc, fr, fq); S.done(cur); }
        if (!has_next) break;
#pragma unroll
        for (int a = 0; a < 2; ++a)
#pragma unroll
            for (int b = 0; b < 2; ++b)
#pragma unroll
                for (int m = 0; m < 4; ++m)
#pragma unroll
                    for (int n = 0; n < 2; ++n) acc[a][b][m][n] = (f32x4){0.f, 0.f, 0.f, 0.f};
        cur = nxt; cA = nA; cB = nB; ++ui;
        if constexpr (ALIGN_EPI) { if (wr == 1) PG8_BAR; }
    }
    PG8_WAIT_V(0);
    if constexpr (!ALIGN_EPI) { if (wr == 0) PG8_BAR; }
    PG8_BAR;
    if constexpr (Epi::AFTER_DRAIN) { E.fused(acc, cur, wr, wc, fr, fq, lds, wid, lane); S.done(cur); }
#undef PG8_SA
#undef PG8_SB
#undef PG8_STAGE
#undef PG8_LDA
#undef PG8_LDB
#undef PG8_MMA
#undef PG8_WAIT_V
#undef PG8_WAIT_L
#undef PG8_BAR
#undef PG8_SCHED
}
}
namespace pg8 {
struct EpiStoreBf16 {
    static constexpr bool PERM = true, AFTER_DRAIN = false;
    bf16_t* O; int ldc; const float* bias; int m_real, n_real;
    __device__ __forceinline__ void operator()(const f32x4 (&acc)[2][2][4][2], const Unit& u, int wr, int wc, int fr, int fq) const {
        const int row0 = u.pm * BM + wr * 64 + fr, col0 = u.pn * BM + wc * 32 + 8 * fq;
#pragma unroll
        for (int bj = 0; bj < 2; ++bj) {
            const int col = col0 + bj * HALF;
            if (col >= n_real) continue;
            f32x4 b0 = (f32x4){0.f, 0.f, 0.f, 0.f}, b1 = b0;
            if (bias) { b0 = *(const f32x4*)(bias + col); b1 = *(const f32x4*)(bias + col + 4); }
#pragma unroll
            for (int ai = 0; ai < 2; ++ai)
#pragma unroll
                for (int m = 0; m < 4; ++m) {
                    const int row = row0 + ai * HALF + m * 16;
                    if (row >= m_real) continue;
                    const f32x4 v0 = acc[ai][bj][m][0] + b0, v1 = acc[ai][bj][m][1] + b1;
                    u32x4 w; w.x = cvt_pk_bf16(v0[0], v0[1]); w.y = cvt_pk_bf16(v0[2], v0[3]); w.z = cvt_pk_bf16(v1[0], v1[1]); w.w = cvt_pk_bf16(v1[2], v1[3]);
                    *(u32x4*)(O + (size_t)row * ldc + col) = w;
                }
        }
    }
};
struct EpiStoreF32 {
    static constexpr bool PERM = false, AFTER_DRAIN = false;
    float* O; int ldc; const float* bias; int m_real, n_real;
    __device__ __forceinline__ void operator()(const f32x4 (&acc)[2][2][4][2], const Unit& u, int wr, int wc, int fr, int fq) const {
        const int row0 = u.pm * BM + wr * 64 + fr, col0 = u.pn * BM + wc * 32 + 4 * fq;
#pragma unroll
        for (int bj = 0; bj < 2; ++bj)
#pragma unroll
            for (int n = 0; n < 2; ++n) {
                const int col = col0 + bj * HALF + n * 16;
                if (col >= n_real) continue;
                const f32x4 bv = bias ? *(const f32x4*)(bias + col) : (f32x4){0.f, 0.f, 0.f, 0.f};
#pragma unroll
                for (int ai = 0; ai < 2; ++ai)
#pragma unroll
                    for (int m = 0; m < 4; ++m) {
                        const int row = row0 + ai * HALF + m * 16;
                        if (row >= m_real) continue;
                        *(f32x4*)(O + (size_t)row * ldc + col) = acc[ai][bj][m][n] + bv;
                    }
            }
    }
};
}
namespace {
#define GAS __attribute__((address_space(1)))
#define LAS __attribute__((address_space(3)))
typedef unsigned short bf16;
typedef float f32x4 __attribute__((ext_vector_type(4)));
typedef unsigned v4u __attribute__((ext_vector_type(4)));
typedef unsigned v2u __attribute__((ext_vector_type(2)));

constexpr int D = 1024, NB = 4, SEQ = 4096, NP = NB * SEQ, NS = 128, NT = NP + NS, MP = 16640;
constexpr int ABN = 3080, ABNP = 3328;
constexpr int C_QKV = 0, C_Z = 1536, C_A = 2048, C_B = 2052, C_XR = 2056, C_GATE = 2568;
constexpr int CN = 1536;
constexpr float ALPHA = 1.4142135623730951f;
constexpr float LN_EPS = 1e-5f;
constexpr int NTH = 512, NWAVES = 8;
constexpr int RING_BYTES = 131072, MISC_OFF = RING_BYTES + 320, LDS_BYTES = 147456;

__device__ __forceinline__ float bf2f(bf16 v) { return __uint_as_float((unsigned)v << 16); }
__device__ __forceinline__ unsigned f2bf(float f) { unsigned u = __float_as_uint(f); return (u + 0x7fffu + ((u >> 16) & 1u)) >> 16; }
__device__ __forceinline__ unsigned pk2(float lo, float hi) { return f2bf(lo) | (f2bf(hi) << 16); }
__device__ __forceinline__ float sigmoidf_(float x) { return 1.0f / (1.0f + expf(-x)); }
__device__ __forceinline__ float softplusf_(float x) { return fmaxf(x, 0.f) + log1pf(expf(-fabsf(x))); }
__device__ __forceinline__ float siluf_(float x) { return x / (1.0f + expf(-x)); }
__device__ __forceinline__ float geluf_(float x) { return 0.5f * x * (1.0f + tanhf(0.7978845608028654f * (x + 0.044715f * x * x * x))); }
__device__ __forceinline__ float wave_sum(float v) {
#pragma unroll
    for (int o = 32; o > 0; o >>= 1) v += __shfl_xor(v, o);
    return v;
}
__device__ __forceinline__ float wave_max(float v) {
#pragma unroll
    for (int o = 32; o > 0; o >>= 1) v = fmaxf(v, __shfl_xor(v, o));
    return v;
}

__device__ __forceinline__ void p0_transpose_item(const float* __restrict__ W, int K, int N, bf16* __restrict__ WT, float* scr, int item, int lane) {
    const int nblk = (N + 31) / 32, kb = item / nblk, nb = item % nblk, k0 = 64 * kb, n0 = 32 * nb;
#pragma unroll 8
    for (int i = 0; i < 32; ++i) { const int kk = 2 * i + (lane >> 5), n = n0 + (lane & 31); scr[kk * 33 + (lane & 31)] = n < N ? W[(size_t)(k0 + kk) * N + n] : 0.f; }
    asm volatile("s_waitcnt lgkmcnt(0)" ::: "memory");
    const int c = lane & 7;
#pragma unroll
    for (int j = 0; j < 4; ++j) { const int n = (lane >> 3) + 8 * j; const float* s = scr + (8 * c) * 33 + n;
        v4u o; o.x = pk2(s[0 * 33], s[1 * 33]); o.y = pk2(s[2 * 33], s[3 * 33]); o.z = pk2(s[4 * 33], s[5 * 33]); o.w = pk2(s[6 * 33], s[7 * 33]);
        *(v4u*)(WT + (size_t)(n0 + n) * K + k0 + 8 * c) = o; }
    asm volatile("s_waitcnt lgkmcnt(0)" ::: "memory");
}
__device__ __forceinline__ void row_to_bf16(const float* __restrict__ xrow, bf16* __restrict__ orow, int lane) {
#pragma unroll
    for (int j = 0; j < 4; ++j) {
        f32x4 v = (f32x4){0.f, 0.f, 0.f, 0.f};
        if (xrow) v = ((const f32x4*)xrow)[lane + 64 * j];
        v2u o; o.x = pk2(v.x, v.y); o.y = pk2(v.z, v.w);
        ((v2u*)orow)[lane + 64 * j] = o;
    }
}

struct AbPrepArgs {
    const bf16* PROJ; const float* st_gdn_conv; const float* st_lru_conv;
    const float* gdn_conv_w; const float* a_log; const float* dt_bias;
    const float* lru_conv_w; const float* lru_conv_b; const float* w_r; const float* b_r; const float* w_i; const float* b_i; const float* lam;
    float* QKV; float* G; float* BETA; float* LA; float* LB;
    float* p_gdn_conv; float* p_lru_conv; float* s_gdn_conv; float* s_lru_conv;
};
__device__ __forceinline__ void ab_prep(const AbPrepArgs& a, int t, float* smem) {
    const int tid = threadIdx.x, lane = tid & 63, wid = tid >> 6;
    const bool samp = t >= NP; const int sb = t - NP, pos = t % SEQ, b = t / SEQ;
    float* sq = smem;
    float* sx = smem + 1536;
    float* scl = smem + 2048;
    const bf16* prow = a.PROJ + (size_t)t * ABN;
    for (int c = tid; c < 1536; c += NTH) {
        float acc = 0.f;
#pragma unroll
        for (int i = 0; i < 4; ++i) {
            float xv;
            if (i == 3) xv = bf2f(prow[C_QKV + c]);
            else if (samp) xv = a.st_gdn_conv[((size_t)sb * 3 + i) * 1536 + c];
            else xv = (pos - 3 + i >= 0) ? bf2f(a.PROJ[(size_t)(t - 3 + i) * ABN + C_QKV + c]) : 0.f;
            acc += a.gdn_conv_w[i * 1536 + c] * xv;
        }
        sq[c] = siluf_(acc);
    }
    {
        const int c = tid;
        float acc = a.lru_conv_b[c];
#pragma unroll
        for (int i = 0; i < 4; ++i) {
            float xv;
            if (i == 3) xv = bf2f(prow[C_XR + c]);
            else if (samp) xv = a.st_lru_conv[((size_t)sb * 3 + i) * 512 + c];
            else xv = (pos - 3 + i >= 0) ? bf2f(a.PROJ[(size_t)(t - 3 + i) * ABN + C_XR + c]) : 0.f;
            acc += a.lru_conv_w[i * 512 + c] * xv;
        }
        sx[c] = acc;
    }
    __syncthreads();
    {
        const int grp = wid;
        const float v0 = sq[grp * 128 + lane], v1 = sq[grp * 128 + 64 + lane];
        const float s = wave_sum(v0 * v0 + v1 * v1);
        if (lane == 0) scl[grp] = rsqrtf(s + 1e-6f) * (grp < 4 ? 0.08838834764831845f : 1.0f);
    }
    __syncthreads();
    for (int c = tid; c < 1536; c += NTH) a.QKV[(size_t)t * 1536 + c] = (c < 1024) ? sq[c] * scl[c >> 7] : sq[c];
    if (tid < 4) {
        const float a_raw = bf2f(prow[C_A + tid]), b_raw = bf2f(prow[C_B + tid]);
        a.G[(size_t)t * 4 + tid] = -expf(a.a_log[tid]) * softplusf_(a_raw + a.dt_bias[tid]);
        a.BETA[(size_t)t * 4 + tid] = sigmoidf_(b_raw);
    }
    if (!samp) {
        if (pos >= SEQ - 3) {
            const int row = pos - (SEQ - 3);
            for (int c = tid; c < 1536; c += NTH) a.p_gdn_conv[((size_t)b * 3 + row) * 1536 + c] = bf2f(prow[C_QKV + c]);
            a.p_lru_conv[((size_t)b * 3 + row) * 512 + tid] = bf2f(prow[C_XR + tid]);
        }
    } else {
        for (int c = tid; c < 1536; c += NTH) {
            a.s_gdn_conv[((size_t)sb * 3 + 0) * 1536 + c] = a.st_gdn_conv[((size_t)sb * 3 + 1) * 1536 + c];
            a.s_gdn_conv[((size_t)sb * 3 + 1) * 1536 + c] = a.st_gdn_conv[((size_t)sb * 3 + 2) * 1536 + c];
            a.s_gdn_conv[((size_t)sb * 3 + 2) * 1536 + c] = bf2f(prow[C_QKV + c]);
        }
        {
            const int c = tid;
            a.s_lru_conv[((size_t)sb * 3 + 0) * 512 + c] = a.st_lru_conv[((size_t)sb * 3 + 1) * 512 + c];
            a.s_lru_conv[((size_t)sb * 3 + 1) * 512 + c] = a.st_lru_conv[((size_t)sb * 3 + 2) * 512 + c];
            a.s_lru_conv[((size_t)sb * 3 + 2) * 512 + c] = bf2f(prow[C_XR + c]);
        }
    }
    {
        const int c = tid, n = c >> 6, d = c & 63;
        float r = a.b_r[c], ii = a.b_i[c];
#pragma unroll 4
        for (int cc = 0; cc < 64; ++cc) {
            const float xv = sx[n * 64 + cc];
            r += xv * a.w_r[((size_t)n * 64 + cc) * 64 + d];
            ii += xv * a.w_i[((size_t)n * 64 + cc) * 64 + d];
        }
        r = sigmoidf_(r); ii = sigmoidf_(ii);
        const float log_a = -8.0f * r * softplusf_(-a.lam[c]);
        a.LA[(size_t)t * 512 + c] = expf(log_a);
        a.LB[(size_t)t * 512 + c] = sqrtf(-expm1f(2.0f * log_a)) * (ii * sx[c]);
    }
}

__device__ __forceinline__ void gdn_scan(const float* __restrict__ QKV, const float* __restrict__ G, const float* __restrict__ BETA,
                                         const float* __restrict__ S0, float* __restrict__ O, float* __restrict__ Sout, int tok_base, int T,
                                         int sl, int h, int sq, float* smem) {
    const int tid = threadIdx.x, dvl = tid & 31, kg = tid >> 5;
    const int dv = sl * 32 + dvl;
    float (*red1)[32] = (float (*)[32])smem;
    float (*red2)[32] = (float (*)[32])(smem + 512);
    float S[8];
#pragma unroll
    for (int i = 0; i < 8; ++i) S[i] = S0 ? S0[(((size_t)sq * 4 + h) * 128 + kg * 8 + i) * 128 + dv] : 0.f;
    float kk[8], qq[8], vv, g, be;
    {
        const size_t tok = (size_t)tok_base + (size_t)sq * T;
        const float* row = QKV + tok * 1536;
#pragma unroll
        for (int i = 0; i < 8; ++i) { kk[i] = row[512 + h * 128 + kg * 8 + i]; qq[i] = row[h * 128 + kg * 8 + i]; }
        vv = row[1024 + h * 128 + dv]; g = G[tok * 4 + h]; be = BETA[tok * 4 + h];
    }
    for (int t = 0; t < T; ++t) {
        const size_t tok = (size_t)tok_base + (size_t)sq * T + t;
        float nk[8], nq[8], nv = 0.f, ng = 0.f, nb = 0.f;
        if (t + 1 < T) {
            const float* row = QKV + (tok + 1) * 1536;
#pragma unroll
            for (int i = 0; i < 8; ++i) { nk[i] = row[512 + h * 128 + kg * 8 + i]; nq[i] = row[h * 128 + kg * 8 + i]; }
            nv = row[1024 + h * 128 + dv]; ng = G[(tok + 1) * 4 + h]; nb = BETA[(tok + 1) * 4 + h];
        } else {
#pragma unroll
            for (int i = 0; i < 8; ++i) { nk[i] = 0.f; nq[i] = 0.f; }
        }
        const float al = expf(g);
        float p = 0.f;
#pragma unroll
        for (int i = 0; i < 8; ++i) { S[i] *= al; p += S[i] * kk[i]; }
        red1[kg][dvl] = p;
        __syncthreads();
        float ks = 0.f;
#pragma unroll
        for (int j = 0; j < 16; ++j) ks += red1[j][dvl];
        const float vn = be * (vv - ks);
        float o = 0.f;
#pragma unroll
        for (int i = 0; i < 8; ++i) { S[i] += kk[i] * vn; o += S[i] * qq[i]; }
        red2[kg][dvl] = o;
        __syncthreads();
        if (kg == 0) {
            float os = 0.f;
#pragma unroll
            for (int j = 0; j < 16; ++j) os += red2[j][dvl];
            O[tok * 512 + h * 128 + dv] = os;
        }
#pragma unroll
        for (int i = 0; i < 8; ++i) { kk[i] = nk[i]; qq[i] = nq[i]; }
        vv = nv; g = ng; be = nb;
    }
#pragma unroll
    for (int i = 0; i < 8; ++i) Sout[(((size_t)sq * 4 + h) * 128 + kg * 8 + i) * 128 + dv] = S[i];
}

__device__ __forceinline__ void lru_scan(const float* __restrict__ LA, float* __restrict__ LB, const float* __restrict__ h0,
                                         float* __restrict__ hlast, int tok_base, int T, int nseq, int bx) {
    const int idx = bx * NTH + threadIdx.x;
    if (idx >= nseq * 512) return;
    const int sq = idx / 512, c = idx % 512;
    float h = h0 ? h0[(size_t)sq * 512 + c] : 0.f;
    const size_t base = ((size_t)tok_base + (size_t)sq * T) * 512 + c;
#pragma unroll 8
    for (int t = 0; t < T; ++t) {
        const size_t o = base + (size_t)t * 512;
        h = LA[o] * h + LB[o];
        LB[o] = h;
    }
    hlast[(size_t)sq * 512 + c] = h;
}

__device__ __forceinline__ void ab_mix(const bf16* __restrict__ PROJ, const float* __restrict__ O, const float* __restrict__ H, const float* __restrict__ P, const float* __restrict__ CIN,
                                       const float* __restrict__ norm_w, bf16* __restrict__ MIX, int vb) {
    const int tid = threadIdx.x & 255, lane = tid & 63, wid = tid >> 6, t = vb * 2 + (threadIdx.x >> 8);
    const bf16* prow = PROJ + (size_t)t * ABN;
    {
        const int h = wid;
        const float o0 = O[(size_t)t * 512 + h * 128 + lane], o1 = O[(size_t)t * 512 + h * 128 + 64 + lane];
        const float ms = wave_sum(o0 * o0 + o1 * o1) * (1.0f / 128.0f);
        const float sc = rsqrtf(ms + 1e-6f);
        MIX[(size_t)t * 1024 + h * 128 + lane] = (bf16)f2bf(o0 * sc * norm_w[lane] * siluf_(bf2f(prow[C_Z + h * 128 + lane])));
        MIX[(size_t)t * 1024 + h * 128 + 64 + lane] = (bf16)f2bf(o1 * sc * norm_w[64 + lane] * siluf_(bf2f(prow[C_Z + h * 128 + 64 + lane])));
    }
    for (int c = tid; c < 512; c += 256) {
        float hv = H[(size_t)t * 512 + c];
        if (t < NP) hv += P[(size_t)t * 512 + c] * CIN[(size_t)(t >> 6) * 512 + c];
        MIX[(size_t)t * 1024 + 512 + c] = (bf16)f2bf(geluf_(bf2f(prow[C_GATE + c])) * hv);
    }
}

__device__ __forceinline__ void ln_res_w(const float* __restrict__ xrow, const float* __restrict__ yrow, const float* __restrict__ g, const float* __restrict__ bta,
                                         float* __restrict__ orow, bf16* __restrict__ obrow, int lane) {
    f32x4 v[4]; float s = 0.f;
#pragma unroll
    for (int j = 0; j < 4; ++j) { const f32x4 x4 = ((const f32x4*)xrow)[lane + 64 * j], y4 = ((const f32x4*)yrow)[lane + 64 * j]; v[j] = x4 * ALPHA + y4; s += (v[j].x + v[j].y) + (v[j].z + v[j].w); }
    const float mean = wave_sum(s) * (1.0f / 1024.0f); float q = 0.f;
#pragma unroll
    for (int j = 0; j < 4; ++j) { v[j] = v[j] - mean; q += (v[j].x * v[j].x + v[j].y * v[j].y) + (v[j].z * v[j].z + v[j].w * v[j].w); }
    const float rs = rsqrtf(wave_sum(q) * (1.0f / 1024.0f) + LN_EPS);
#pragma unroll
    for (int j = 0; j < 4; ++j) {
        const f32x4 g4 = ((const f32x4*)g)[lane + 64 * j], b4 = ((const f32x4*)bta)[lane + 64 * j];
        const f32x4 o = v[j] * rs * g4 + b4;
        ((f32x4*)orow)[lane + 64 * j] = o;
        v2u ob; ob.x = pk2(o.x, o.y); ob.y = pk2(o.z, o.w);
        ((v2u*)obrow)[lane + 64 * j] = ob;
    }
}

__device__ __forceinline__ void peer_topk(const bf16* __restrict__ Q, const float* __restrict__ keys, int* __restrict__ EXP, float* __restrict__ GATE,
                                          int tg, int h, float* smem) {
    const int tid = threadIdx.x, cn = tid & 255, c = cn >> 7, n = cn & 127, th = tid >> 8;
    float (*sq)[256] = (float (*)[256])smem;
    float (*ss)[257] = (float (*)[257])(smem + 32 * 256);
    float (*tvs)[2][16] = (float (*)[2][16])(smem + 32 * 256 + 32 * 257 + 32);
    int (*tis)[2][16] = (int (*)[2][16])(smem + 32 * 256 + 32 * 257 + 32 + 1024);
    for (int i = tid; i < 32 * 256; i += NTH) {
        const int tk = i >> 8, col = i & 255;
        sq[tk][col] = bf2f(Q[(size_t)(tg * 32 + tk) * 2048 + h * 256 + col]);
    }
    __syncthreads();
    float acc[16];
#pragma unroll
    for (int i = 0; i < 16; ++i) acc[i] = 0.f;
    const float* krow = keys + (((size_t)h * 2 + c) * 128 + n) * 128;
    for (int d4 = 0; d4 < 32; ++d4) {
        const float4 kv = *(const float4*)(krow + d4 * 4);
#pragma unroll
        for (int tk = 0; tk < 16; ++tk) {
            const float4 qv = *(const float4*)&sq[th * 16 + tk][c * 128 + d4 * 4];
            acc[tk] += qv.x * kv.x + qv.y * kv.y + qv.z * kv.z + qv.w * kv.w;
        }
    }
#pragma unroll
    for (int tk = 0; tk < 16; ++tk) ss[th * 16 + tk][cn] = acc[tk];
    __syncthreads();
    if (tid < 64) {
        const int tk = tid >> 1, cc = tid & 1;
        float tv[16]; int ti[16];
#pragma unroll
        for (int j = 0; j < 16; ++j) { tv[j] = -INFINITY; ti[j] = 0; }
        for (int nn = 0; nn < 128; ++nn) {
            float x = ss[tk][cc * 128 + nn]; int xi = nn;
#pragma unroll
            for (int j = 0; j < 16; ++j) {
                const bool gt = x > tv[j];
                const float tf = tv[j]; const int tj = ti[j];
                tv[j] = gt ? x : tf; ti[j] = gt ? xi : tj;
                x = gt ? tf : x; xi = gt ? tj : xi;
            }
        }
#pragma unroll
        for (int j = 0; j < 16; ++j) { tvs[tk][cc][j] = tv[j]; tis[tk][cc][j] = ti[j]; }
    }
    __syncthreads();
    if (tid < 32) {
        const int tk = tid;
        float bv[16]; int bi[16];
#pragma unroll
        for (int j = 0; j < 16; ++j) { bv[j] = -INFINITY; bi[j] = 0; }
        for (int i = 0; i < 16; ++i)
            for (int jj = 0; jj < 16; ++jj) {
                float x = tvs[tk][0][i] + tvs[tk][1][jj]; int xi = tis[tk][0][i] * 128 + tis[tk][1][jj];
#pragma unroll
                for (int j = 0; j < 16; ++j) {
                    const bool gt = x > bv[j];
                    const float tf = bv[j]; const int tj = bi[j];
                    bv[j] = gt ? x : tf; bi[j] = gt ? xi : tj;
                    x = gt ? tf : x; xi = gt ? tj : xi;
                }
            }
        float e[16], sum = 0.f;
#pragma unroll
        for (int j = 0; j < 16; ++j) { e[j] = expf(bv[j] - bv[0]); sum += e[j]; }
        const float inv = 1.0f / sum;
        const size_t o = (size_t)(tg * 32 + tk) * 128 + h * 16;
#pragma unroll
        for (int j = 0; j < 16; ++j) { EXP[o + j] = bi[j]; GATE[o + j] = e[j] * inv; }
    }
}

__device__ __forceinline__ void peer_expert(const float* __restrict__ X, const int* __restrict__ EXP, const float* __restrict__ GATE,
                                            const float* __restrict__ U, const float* __restrict__ V,
                                            const float* __restrict__ g, const float* __restrict__ bta, float* __restrict__ out, bf16* __restrict__ outb, int t, float* smem) {
    const int tid = threadIdx.x, lane = tid & 63, wid = tid >> 6;
    float (*accs)[1024] = (float (*)[1024])smem;
    float* sred = smem + 8192;
    const float4* xr = (const float4*)(X + (size_t)t * D);
    float4 xv[4];
#pragma unroll
    for (int j = 0; j < 4; ++j) xv[j] = xr[lane + 64 * j];
    float4 acc[4];
#pragma unroll
    for (int j = 0; j < 4; ++j) acc[j] = make_float4(0.f, 0.f, 0.f, 0.f);
    for (int e = 0; e < 16; ++e) {
        const int id = EXP[(size_t)t * 128 + wid * 16 + e];
        const float gt = GATE[(size_t)t * 128 + wid * 16 + e];
        const float4* ur = (const float4*)(U + (size_t)id * D);
        const float4* vr = (const float4*)(V + (size_t)id * D);
        float4 uv[4], vv[4];
#pragma unroll
        for (int j = 0; j < 4; ++j) { uv[j] = ur[lane + 64 * j]; vv[j] = vr[lane + 64 * j]; }
        float dot = 0.f;
#pragma unroll
        for (int j = 0; j < 4; ++j) dot += uv[j].x * xv[j].x + uv[j].y * xv[j].y + uv[j].z * xv[j].z + uv[j].w * xv[j].w;
        dot = wave_sum(dot);
        const float cf = gt * geluf_(dot);
#pragma unroll
        for (int j = 0; j < 4; ++j) { acc[j].x += cf * vv[j].x; acc[j].y += cf * vv[j].y; acc[j].z += cf * vv[j].z; acc[j].w += cf * vv[j].w; }
    }
#pragma unroll
    for (int j = 0; j < 4; ++j) *(float4*)&accs[wid][(lane + 64 * j) * 4] = acc[j];
    __syncthreads();
    float v[2];
#pragma unroll
    for (int i = 0; i < 2; ++i) {
        const int c = tid * 2 + i;
        float s = 0.f;
#pragma unroll
        for (int w = 0; w < 8; ++w) s += accs[w][c];
        v[i] = ALPHA * X[(size_t)t * D + c] + s;
    }
    float s = wave_sum(v[0] + v[1]);
    if (lane == 0) sred[wid] = s;
    __syncthreads();
    float mean = 0.f;
#pragma unroll
    for (int w = 0; w < 8; ++w) mean += sred[w];
    mean *= (1.0f / 1024.0f);
    __syncthreads();
    const float d0 = v[0] - mean, d1 = v[1] - mean;
    float q = wave_sum(d0 * d0 + d1 * d1);
    if (lane == 0) sred[wid] = q;
    __syncthreads();
    float var = 0.f;
#pragma unroll
    for (int w = 0; w < 8; ++w) var += sred[w];
    const float rs = rsqrtf(var * (1.0f / 1024.0f) + LN_EPS);
    const float o0 = d0 * rs * g[tid * 2] + bta[tid * 2], o1 = d1 * rs * g[tid * 2 + 1] + bta[tid * 2 + 1];
    *(float2*)(out + (size_t)t * D + tid * 2) = make_float2(o0, o1);
    if (outb) *(unsigned*)(outb + (size_t)t * D + tid * 2) = pk2(o0, o1);
}


typedef __bf16 bf16x2_t __attribute__((ext_vector_type(2)));
__device__ __forceinline__ float dot2bf(unsigned w, unsigned x, float acc) { return __builtin_amdgcn_fdot2_f32_bf16(__builtin_bit_cast(bf16x2_t, w), __builtin_bit_cast(bf16x2_t, x), acc, false); }
__device__ __forceinline__ float bflo(unsigned w) { return __uint_as_float(w << 16); }
__device__ __forceinline__ float bfhi(unsigned w) { return __uint_as_float(w & 0xffff0000u); }
#define PE_LOAD(UB, VB, grp) do { _Pragma("unroll") for (int i_ = 0; i_ < 2; ++i_) { const int e_ = (grp) * 2 + i_; \
        const int id_ = __builtin_amdgcn_readlane(e_ < 64 ? id0 : id1, e_ & 63); \
        const unsigned so_ = (unsigned)id_ * 2048u; \
        UB[i_][0] = __builtin_amdgcn_raw_buffer_load_b128(ursrc, voff, so_, 0); UB[i_][1] = __builtin_amdgcn_raw_buffer_load_b128(ursrc, voff + 1024, so_, 0); \
        VB[i_][0] = __builtin_amdgcn_raw_buffer_load_b128(vrsrc, voff, so_, 0); VB[i_][1] = __builtin_amdgcn_raw_buffer_load_b128(vrsrc, voff + 1024, so_, 0); } } while (0)
#define PE_COMP(UB, VB, grp) do { float d_[2]; \
        _Pragma("unroll") for (int i_ = 0; i_ < 2; ++i_) { float a_ = 0.f, b_ = 0.f; \
            a_ = dot2bf(UB[i_][0].x, xb[0].x, a_); b_ = dot2bf(UB[i_][0].y, xb[0].y, b_); a_ = dot2bf(UB[i_][0].z, xb[0].z, a_); b_ = dot2bf(UB[i_][0].w, xb[0].w, b_); \
            a_ = dot2bf(UB[i_][1].x, xb[1].x, a_); b_ = dot2bf(UB[i_][1].y, xb[1].y, b_); a_ = dot2bf(UB[i_][1].z, xb[1].z, a_); b_ = dot2bf(UB[i_][1].w, xb[1].w, b_); d_[i_] = a_ + b_; } \
          \
        float r_ = hi32 ? d_[1] : d_[0], t0_ = hi32 ? d_[0] : d_[1]; r_ += __shfl_xor(t0_, 32); \
        r_ += __shfl_xor(r_, 16); r_ += __shfl_xor(r_, 8); r_ += __shfl_xor(r_, 4); r_ += __shfl_xor(r_, 2); r_ += __shfl_xor(r_, 1); \
        const float cfl_ = geluf_(r_); \
        _Pragma("unroll") for (int i_ = 0; i_ < 2; ++i_) { const int e_ = (grp) * 2 + i_; \
            const float cf_ = __uint_as_float(__builtin_amdgcn_readlane(__float_as_uint(cfl_), 32 * i_)) * __uint_as_float(__builtin_amdgcn_readlane(__float_as_uint(e_ < 64 ? g0 : g1), e_ & 63)); \
            _Pragma("unroll") for (int j_ = 0; j_ < 2; ++j_) { \
                acc[j_ * 8 + 0] += cf_ * bflo(VB[i_][j_].x); acc[j_ * 8 + 1] += cf_ * bfhi(VB[i_][j_].x); acc[j_ * 8 + 2] += cf_ * bflo(VB[i_][j_].y); acc[j_ * 8 + 3] += cf_ * bfhi(VB[i_][j_].y); \
                acc[j_ * 8 + 4] += cf_ * bflo(VB[i_][j_].z); acc[j_ * 8 + 5] += cf_ * bfhi(VB[i_][j_].z); acc[j_ * 8 + 6] += cf_ * bflo(VB[i_][j_].w); acc[j_ * 8 + 7] += cf_ * bfhi(VB[i_][j_].w); } } } while (0)
__device__ __forceinline__ void peer_expert_w(const float* __restrict__ xrow, const bf16* __restrict__ xbrow, const int* __restrict__ exr, const float* __restrict__ gar,
                                              const bf16* __restrict__ U, const bf16* __restrict__ V,
                                              const float* __restrict__ g, const float* __restrict__ bta, float* __restrict__ orow, bf16* __restrict__ obrow, int lane) {
    const bool hi32 = (lane & 32) != 0;
    const __amdgpu_buffer_rsrc_t ursrc = __builtin_amdgcn_make_buffer_rsrc((void*)U, 0, 16384 * 2048, 0x00020000);
    const __amdgpu_buffer_rsrc_t vrsrc = __builtin_amdgcn_make_buffer_rsrc((void*)V, 0, 16384 * 2048, 0x00020000);
    const int voff = lane * 16;
    v4u xb[2]; xb[0] = *(const v4u*)(xbrow + lane * 8); xb[1] = *(const v4u*)(xbrow + 512 + lane * 8);
    const int id0 = exr[lane], id1 = exr[64 + lane]; const float g0 = gar[lane], g1 = gar[64 + lane];
    float acc[16];
#pragma unroll
    for (int i = 0; i < 16; ++i) acc[i] = 0.f;
    v4u ua[2][2], va[2][2], ub[2][2], vb[2][2];
    PE_LOAD(ua, va, 0);
#pragma unroll 1
    for (int grp = 0; grp < 64; grp += 2) {
        PE_LOAD(ub, vb, grp + 1);
        PE_COMP(ua, va, grp);
        if (grp + 2 < 64) PE_LOAD(ua, va, grp + 2);
        PE_COMP(ub, vb, grp + 1);
    }
    float v[16]; float s = 0.f;
#pragma unroll
    for (int j = 0; j < 2; ++j) {
        const f32x4 x0 = *(const f32x4*)(xrow + j * 512 + lane * 8), x1 = *(const f32x4*)(xrow + j * 512 + lane * 8 + 4);
        v[j * 8 + 0] = ALPHA * x0.x + acc[j * 8 + 0]; v[j * 8 + 1] = ALPHA * x0.y + acc[j * 8 + 1]; v[j * 8 + 2] = ALPHA * x0.z + acc[j * 8 + 2]; v[j * 8 + 3] = ALPHA * x0.w + acc[j * 8 + 3];
        v[j * 8 + 4] = ALPHA * x1.x + acc[j * 8 + 4]; v[j * 8 + 5] = ALPHA * x1.y + acc[j * 8 + 5]; v[j * 8 + 6] = ALPHA * x1.z + acc[j * 8 + 6]; v[j * 8 + 7] = ALPHA * x1.w + acc[j * 8 + 7];
    }
#pragma unroll
    for (int i = 0; i < 16; ++i) s += v[i];
    const float mean = wave_sum(s) * (1.0f / 1024.0f); float q = 0.f;
#pragma unroll
    for (int i = 0; i < 16; ++i) { v[i] -= mean; q += v[i] * v[i]; }
    const float rs = rsqrtf(wave_sum(q) * (1.0f / 1024.0f) + LN_EPS);
#pragma unroll
    for (int j = 0; j < 2; ++j) {
        const int c0 = j * 512 + lane * 8;
        const f32x4 ga = *(const f32x4*)(g + c0), gb = *(const f32x4*)(g + c0 + 4), ba = *(const f32x4*)(bta + c0), bb = *(const f32x4*)(bta + c0 + 4);
        f32x4 oa, ob;
        oa.x = v[j * 8 + 0] * rs * ga.x + ba.x; oa.y = v[j * 8 + 1] * rs * ga.y + ba.y; oa.z = v[j * 8 + 2] * rs * ga.z + ba.z; oa.w = v[j * 8 + 3] * rs * ga.w + ba.w;
        ob.x = v[j * 8 + 4] * rs * gb.x + bb.x; ob.y = v[j * 8 + 5] * rs * gb.y + bb.y; ob.z = v[j * 8 + 6] * rs * gb.z + bb.z; ob.w = v[j * 8 + 7] * rs * gb.w + bb.w;
        *(f32x4*)(orow + c0) = oa; *(f32x4*)(orow + c0 + 4) = ob;
        if (obrow) { v4u w; w.x = pk2(oa.x, oa.y); w.y = pk2(oa.z, oa.w); w.z = pk2(ob.x, ob.y); w.w = pk2(ob.z, ob.w); *(v4u*)(obrow + c0) = w; }
    }
}

__device__ __forceinline__ int t5_bucket(int n) {
    if (n < 16) return n;
    const int large = 16 + (int)(logf((float)n / 16.0f) / 2.0794415416798357f * 16.0f);
    return large < 31 ? large : 31;
}
__device__ __forceinline__ void swa_attn(const float* __restrict__ PC, const float* __restrict__ cache_k, const float* __restrict__ cache_v,
                                         const float* __restrict__ rel_bias, const float* __restrict__ sinks, bf16* __restrict__ ATT, int bx) {
    const int tid = threadIdx.x, lane = tid & 63, wid = tid >> 6;
    const int gw = bx * 8 + wid;
    const int t = gw >> 4, h = gw & 15, kvh = h >> 2;
    if (t >= NT) return;
    const bool samp = t >= NP; const int sb = t - NP, pos = t % SEQ;
    const float* qrow = PC + (size_t)t * CN + h * 64;
    float lg[2]; bool valid[2];
#pragma unroll
    for (int rr = 0; rr < 2; ++rr) {
        const int r = lane + 64 * rr;
        const float* krow;
        if (!samp) { valid[rr] = (pos - r) >= 0; krow = PC + (size_t)(valid[rr] ? t - r : t) * CN + 1024 + kvh * 64; }
        else { valid[rr] = true; krow = (r == 0) ? PC + (size_t)t * CN + 1024 + kvh * 64 : cache_k + (((size_t)sb * 128 + (128 - r)) * 4 + kvh) * 64; }
        float dot = 0.f;
#pragma unroll
        for (int d4 = 0; d4 < 16; ++d4) {
            const float4 kv = *(const float4*)(krow + d4 * 4);
            const float4 qv = *(const float4*)(qrow + d4 * 4);
            dot += qv.x * kv.x + qv.y * kv.y + qv.z * kv.z + qv.w * kv.w;
        }
        lg[rr] = valid[rr] ? dot * 0.125f + rel_bias[t5_bucket(r) * 16 + h] : -INFINITY;
    }
    const float sink = sinks[h];
    const float m = fmaxf(wave_max(fmaxf(lg[0], lg[1])), sink);
    float p[2];
#pragma unroll
    for (int rr = 0; rr < 2; ++rr) p[rr] = valid[rr] ? expf(lg[rr] - m) : 0.f;
    const float den = wave_sum(p[0] + p[1]) + expf(sink - m);
    const float inv = 1.0f / den;
    float o = 0.f;
#pragma unroll
    for (int rr = 0; rr < 2; ++rr)
        for (int l2 = 0; l2 < 64; ++l2) {
            const int r = l2 + 64 * rr;
            const float pj = __shfl(p[rr], l2);
            if (pj != 0.f) {
                const float* vrow;
                if (!samp) vrow = PC + (size_t)(t - r) * CN + 1280 + kvh * 64;
                else vrow = (r == 0) ? PC + (size_t)t * CN + 1280 + kvh * 64 : cache_v + (((size_t)sb * 128 + (128 - r)) * 4 + kvh) * 64;
                o += pj * vrow[lane];
            }
        }
    ATT[(size_t)t * D + h * 64 + lane] = (bf16)f2bf(o * inv);
}

__device__ __forceinline__ void swa_kv_out(const float* __restrict__ PC, const float* __restrict__ cache_k, const float* __restrict__ cache_v,
                                           float* __restrict__ pk, float* __restrict__ pv, float* __restrict__ sk, float* __restrict__ sv, int vb) {
    const int c = threadIdx.x & 255, row = vb * 2 + (threadIdx.x >> 8);
    if (row < NB * 128) {
        const int b = row >> 7, i = row & 127;
        const float* src = PC + (size_t)(b * SEQ + SEQ - 128 + i) * CN;
        pk[(size_t)row * 256 + c] = src[1024 + c];
        pv[(size_t)row * 256 + c] = src[1280 + c];
    } else {
        const int r2 = row - NB * 128, sb = r2 >> 7, i = r2 & 127;
        if (i < 127) {
            sk[(size_t)r2 * 256 + c] = cache_k[((size_t)sb * 128 + i + 1) * 256 + c];
            sv[(size_t)r2 * 256 + c] = cache_v[((size_t)sb * 128 + i + 1) * 256 + c];
        } else {
            const float* src = PC + (size_t)(NP + sb) * CN;
            sk[(size_t)r2 * 256 + c] = src[1024 + c];
            sv[(size_t)r2 * 256 + c] = src[1280 + c];
        }
    }
}
#define XB_TMO      128
#define XB_XCNT(j)  (256  + 64 * (j))
#define XB_XSUB(j)  (1280 + 64 * (j))
#define XB_XGEN(j)  (2304 + 64 * (j))
#define XB_TOP      3328
#define XB_TOPGEN   3392
#define XCD_BAR_WORDS 3456
#define XB_SPIN_CAP (1u << 18)

__device__ __forceinline__ unsigned xb_ld(unsigned* p)              { return __hip_atomic_load(p, __ATOMIC_RELAXED, __HIP_MEMORY_SCOPE_AGENT); }
__device__ __forceinline__ unsigned xb_add(unsigned* p, unsigned v) { return __hip_atomic_fetch_add(p, v, __ATOMIC_RELAXED, __HIP_MEMORY_SCOPE_AGENT); }
__device__ __forceinline__ unsigned xb_xcc_id() { return (unsigned)__builtin_amdgcn_s_getreg((3 << 11) | 20) & 0xFu; }
#define XB_SPIN(cond, bar) do { unsigned _sp = 0; while (cond) { __builtin_amdgcn_s_sleep(1); \
    if ((++_sp & 255u) == 0u) { if (xb_ld(&(bar)[XB_TMO])) break; if (_sp > XB_SPIN_CAP) { atomicAdd(&(bar)[XB_TMO], 1u); break; } } } } while (0)

struct XcdBarrier {
    unsigned* bar; unsigned x;
    volatile LAS unsigned* st;
};

__device__ __forceinline__ XcdBarrier xcd_barrier_post(unsigned* bar, volatile LAS unsigned* st) {
    XcdBarrier b; b.bar = bar; b.x = xb_xcc_id(); b.st = st;
    if (threadIdx.x == 0) (void)xb_add(&bar[XB_XCNT(b.x)], 1u);
    return b;
}
__device__ __forceinline__ void xcd_barrier_complete(unsigned* bar, unsigned x, unsigned& nloc, unsigned& nx) {
    const unsigned G = gridDim.x * gridDim.y * gridDim.z;
    unsigned sum, cnt, mine, sp = 0u;
    for (;;) {
        sum = 0u; cnt = 0u; mine = 0u;
#pragma unroll
        for (unsigned j = 0; j < 16; ++j) { const unsigned c = xb_ld(&bar[XB_XCNT(j)]); sum += c; cnt += (c > 0u) ? 1u : 0u; mine = (j == x) ? c : mine; }
        if (sum == G) break;
        __builtin_amdgcn_s_sleep(1);
        if ((++sp & 255u) == 0u) { if (xb_ld(&bar[XB_TMO])) break; if (sp > XB_SPIN_CAP) { atomicAdd(&bar[XB_TMO], 1u); break; } }
    }
    nloc = mine > 0u ? mine : 1u; nx = cnt > 0u ? cnt : 1u;
}

__device__ __forceinline__ void xcd_barrier(const XcdBarrier& b) {
    asm volatile("s_waitcnt vmcnt(0)" ::: "memory");
    __syncthreads();
    if (threadIdx.x == 0) {
        unsigned* bar = b.bar;
        __builtin_amdgcn_s_waitcnt(0);
        unsigned nloc = b.st[0], nx = b.st[1];
        if (nloc == 0u) { xcd_barrier_complete(bar, b.x, nloc, nx); b.st[0] = nloc; b.st[1] = nx; }
        const unsigned old = xb_add(&bar[XB_XSUB(b.x)], 1u);
        const unsigned gen = old / nloc;
        if (old + 1u == (gen + 1u) * nloc) {
            __builtin_amdgcn_fence(__ATOMIC_RELEASE, "agent");
            asm volatile("s_waitcnt vmcnt(0)" ::: "memory");
            const unsigned og = xb_add(&bar[XB_TOP], 1u);
            const unsigned tg = og / nx;
            if (og + 1u == (tg + 1u) * nx) xb_add(&bar[XB_TOPGEN], 1u);
            else XB_SPIN(xb_ld(&bar[XB_TOPGEN]) == tg, bar);
            __builtin_amdgcn_fence(__ATOMIC_ACQUIRE, "agent");
            xb_add(&bar[XB_XGEN(b.x)], 1u);
            asm volatile("s_waitcnt vmcnt(0)" ::: "memory");
        } else {
            XB_SPIN(xb_ld(&bar[XB_XGEN(b.x)]) == gen, bar);
            __builtin_amdgcn_fence(__ATOMIC_ACQUIRE, "agent");
            asm volatile("s_waitcnt vmcnt(0)" ::: "memory");
        }
    }
    __syncthreads();
}

typedef short bf16x8_t __attribute__((ext_vector_type(8)));
__device__ __forceinline__ f32x4 mfma16(bf16x8_t a, bf16x8_t b, f32x4 c) { return __builtin_amdgcn_mfma_f32_16x16x32_bf16(a, b, c, 0, 0, 0); }

struct GdnChunkBufs {
    bf16* W;
    bf16* QG;
    bf16* KDT;
    bf16* UT;
    bf16* QK;
    float* EGL;
};

constexpr int GP_QB = 0, GP_KB = 17408, GP_VB = 34816, GP_LS = 52224, GP_QKS = 69632, GP_WS = 78848, GP_SC = 96256;

__device__ __forceinline__ void gdn_prep_unit(const bf16* __restrict__ PROJ, const float* __restrict__ conv_w, const float* __restrict__ a_log, const float* __restrict__ dt_bias,
                                              const GdnChunkBufs& cb, float* __restrict__ p_gdn_conv, int un, unsigned char* lds) {
    int tid = threadIdx.x; asm volatile("" : "+v"(tid));
    const int lane = tid & 63, wave = __builtin_amdgcn_readfirstlane(tid >> 6), fr = lane & 15, fq = lane >> 4;
    const int h = un & 3, n = (un >> 2) & 63, b = un >> 8;
    const int t0 = b * SEQ + n * 64;
    bf16* Qb = (bf16*)(lds + GP_QB); bf16* Kb = (bf16*)(lds + GP_KB); bf16* Vb = (bf16*)(lds + GP_VB); bf16* Ws = (bf16*)(lds + GP_WS);
    float* Ls = (float*)(lds + GP_LS); bf16* QKs = (bf16*)(lds + GP_QKS);
    float* gcs = (float*)(lds + GP_SC); float* bets = gcs + 64; float* egcs = gcs + 128; float* ekds = gcs + 192; float* begs = gcs + 256;
    if (wave == 0) {
        const bf16* prow = PROJ + (size_t)(t0 + lane) * ABN;
        const float a_raw = bf2f(prow[C_A + h]), b_raw = bf2f(prow[C_B + h]);
        float g = -expf(a_log[h]) * softplusf_(a_raw + dt_bias[h]);
#pragma unroll
        for (int off = 1; off < 64; off <<= 1) { const float v = __shfl_up(g, off); if (lane >= off) g += v; }
        const float glast = __shfl(g, 63);
        { const float be_ = sigmoidf_(b_raw), eg_ = expf(g); gcs[lane] = g; bets[lane] = be_; egcs[lane] = eg_; ekds[lane] = expf(glast - g); begs[lane] = be_ * eg_; }
        if (lane == 0) cb.EGL[un] = expf(glast);
    }
    {
        int cols[6]; float cw[4][6], xw[3][6];
#pragma unroll
        for (int p = 0; p < 3; ++p)
#pragma unroll
            for (int e = 0; e < 2; ++e) cols[p * 2 + e] = p * 512 + h * 128 + e * 64 + lane;
#pragma unroll
        for (int i = 0; i < 4; ++i)
#pragma unroll
            for (int c = 0; c < 6; ++c) cw[i][c] = conv_w[i * 1536 + cols[c]];
        const int i0 = wave * 8;
#pragma unroll
        for (int k = 0; k < 3; ++k) {
            const int pos = n * 64 + i0 - 3 + k;
#pragma unroll
            for (int c = 0; c < 6; ++c) xw[k][c] = pos >= 0 ? bf2f(PROJ[(size_t)(t0 + i0 - 3 + k) * ABN + cols[c]]) : 0.f;
        }
#pragma unroll
        for (int ii = 0; ii < 8; ++ii) {
            const int i = i0 + ii;
            float xt[6], s[6];
#pragma unroll
            for (int c = 0; c < 6; ++c) xt[c] = bf2f(PROJ[(size_t)(t0 + i) * ABN + cols[c]]);
#pragma unroll
            for (int c = 0; c < 6; ++c) s[c] = siluf_(cw[0][c] * xw[0][c] + cw[1][c] * xw[1][c] + cw[2][c] * xw[2][c] + cw[3][c] * xt[c]);
            const float qs = rsqrtf(wave_sum(s[0] * s[0] + s[1] * s[1]) + 1e-6f) * 0.08838834764831845f;
            const float ks = rsqrtf(wave_sum(s[2] * s[2] + s[3] * s[3]) + 1e-6f);
            Qb[i * 136 + lane] = (bf16)f2bf(s[0] * qs); Qb[i * 136 + 64 + lane] = (bf16)f2bf(s[1] * qs);
            Kb[i * 136 + lane] = (bf16)f2bf(s[2] * ks); Kb[i * 136 + 64 + lane] = (bf16)f2bf(s[3] * ks);
            Vb[i * 136 + lane] = (bf16)f2bf(s[4]);      Vb[i * 136 + 64 + lane] = (bf16)f2bf(s[5]);
            if (n == 63 && i >= 61) {
#pragma unroll
                for (int c = 0; c < 6; ++c) p_gdn_conv[((size_t)b * 3 + (i - 61)) * 1536 + cols[c]] = xt[c];
            }
#pragma unroll
            for (int c = 0; c < 6; ++c) { xw[0][c] = xw[1][c]; xw[1][c] = xw[2][c]; xw[2][c] = xt[c]; }
        }
    }
    __syncthreads();
    {
        const int mi = wave >> 1;
        bf16x8_t aK[4], aQ[4];
#pragma unroll
        for (int ks = 0; ks < 4; ++ks) { aK[ks] = *(const bf16x8_t*)(Kb + (mi * 16 + fr) * 136 + ks * 32 + 8 * fq); aQ[ks] = *(const bf16x8_t*)(Qb + (mi * 16 + fr) * 136 + ks * 32 + 8 * fq); }
#pragma unroll
        for (int nn = 0; nn < 2; ++nn) {
            const int nj = (wave & 1) * 2 + nn;
            f32x4 accK = (f32x4){0.f, 0.f, 0.f, 0.f}, accQ = accK;
#pragma unroll
            for (int ks = 0; ks < 4; ++ks) { const bf16x8_t bk = *(const bf16x8_t*)(Kb + (nj * 16 + fr) * 136 + ks * 32 + 8 * fq); accK = mfma16(aK[ks], bk, accK); accQ = mfma16(aQ[ks], bk, accQ); }
            const int j = nj * 16 + fr; const float gj = gcs[j];
#pragma unroll
            for (int r = 0; r < 4; ++r) {
                const int i = mi * 16 + 4 * fq + r;
                const float dec = i >= j ? expf(gcs[i] - gj) : 0.f;
                Ls[i * 68 + j] = i > j ? bets[i] * accK[r] * dec : 0.f;
                QKs[i * 72 + j] = (bf16)f2bf(i >= j ? accQ[r] * dec : 0.f);
            }
        }
    }
    __syncthreads();
    if (wave < 4) {
        float x[64];
        const bool isu = tid < 128; const int c = isu ? tid : tid - 128;
        const LAS unsigned char* l3 = (const LAS unsigned char*)lds;
        unsigned so = (isu ? GP_VB : GP_KB) + c * 2, ro = GP_SC + (isu ? 64 * 4 : 256 * 4), lo = GP_LS;
        asm volatile("" : "+v"(so), "+v"(ro), "+v"(lo));
#pragma unroll
        for (int i = 0; i < 64; ++i) {
            float acc = *(const LAS float*)(l3 + ro + 4 * i) * bf2f(*(const LAS bf16*)(l3 + so + i * 272));
#pragma unroll
            for (int j4 = 0; j4 < (i + 3) / 4; ++j4) {
                const f32x4 l4 = *(const LAS f32x4*)(l3 + lo + i * 272 + j4 * 16);
                acc -= l4.x * x[j4 * 4 + 0];
                if (j4 * 4 + 1 < i) acc -= l4.y * x[j4 * 4 + 1];
                if (j4 * 4 + 2 < i) acc -= l4.z * x[j4 * 4 + 2];
                if (j4 * 4 + 3 < i) acc -= l4.w * x[j4 * 4 + 3];
            }
            x[i] = acc;
        }
        if (isu) {
            bf16* dst = cb.UT + ((size_t)un * 128 + c) * 64;
#pragma unroll
            for (int i8 = 0; i8 < 8; ++i8) { v4u o; o.x = pk2(x[i8 * 8 + 0], x[i8 * 8 + 1]); o.y = pk2(x[i8 * 8 + 2], x[i8 * 8 + 3]); o.z = pk2(x[i8 * 8 + 4], x[i8 * 8 + 5]); o.w = pk2(x[i8 * 8 + 6], x[i8 * 8 + 7]); *(v4u*)(dst + i8 * 8) = o; }
        } else {
#pragma unroll
            for (int i = 0; i < 64; ++i) Ws[i * 136 + c] = (bf16)f2bf(x[i]);
        }
    } else {
        const int t2 = tid - 256;
#pragma unroll
        for (int k = 0; k < 4; ++k) {
            const int ci = t2 + 256 * k, i = ci >> 4, d0 = (ci & 15) * 8; const float e = egcs[i];
            const v4u q = *(const v4u*)(Qb + i * 136 + d0);
            v4u o; o.x = pk2(bflo(q.x) * e, bfhi(q.x) * e); o.y = pk2(bflo(q.y) * e, bfhi(q.y) * e); o.z = pk2(bflo(q.z) * e, bfhi(q.z) * e); o.w = pk2(bflo(q.w) * e, bfhi(q.w) * e);
            *(v4u*)(cb.QG + ((size_t)un * 64 + i) * 128 + d0) = o;
        }
#pragma unroll
        for (int k = 0; k < 4; ++k) {
            const int ci = t2 + 256 * k, d = ci & 127, i0 = (ci >> 7) * 8;
            float v[8];
#pragma unroll
            for (int q = 0; q < 8; ++q) v[q] = bf2f(Kb[(i0 + q) * 136 + d]) * ekds[i0 + q];
            v4u o; o.x = pk2(v[0], v[1]); o.y = pk2(v[2], v[3]); o.z = pk2(v[4], v[5]); o.w = pk2(v[6], v[7]);
            *(v4u*)(cb.KDT + ((size_t)un * 128 + d) * 64 + i0) = o;
        }
#pragma unroll
        for (int k = 0; k < 2; ++k) {
            const int ci = t2 + 256 * k, i = ci >> 3, j0 = (ci & 7) * 8;
            *(v4u*)(cb.QK + ((size_t)un * 64 + i) * 64 + j0) = *(const v4u*)(QKs + i * 72 + j0);
        }
    }
    __syncthreads();
#pragma unroll
    for (int k = 0; k < 2; ++k) {
        const int ci = tid + 512 * k, i = ci >> 4, d0 = (ci & 15) * 8;
        *(v4u*)(cb.W + ((size_t)un * 64 + i) * 128 + d0) = *(const v4u*)(Ws + i * 136 + d0);
    }
    __syncthreads();
}

constexpr int GS_ST = 0, GS_VNT = 2 * 32 * 136 * 2, GS_END = GS_VNT + 32 * 72 * 2;
__device__ __forceinline__ void gdn_seq(const GdnChunkBufs& cb, float* __restrict__ O, float* __restrict__ Sout, int b, int h, int sl, unsigned char* lds) {
    int tid = threadIdx.x; asm volatile("" : "+v"(tid));
    const int lane = tid & 63, wave = __builtin_amdgcn_readfirstlane(tid >> 6), fr = lane & 15, fq = lane >> 4;
    const int mi = wave >> 1, nj = wave & 1;
    bf16* St = (bf16*)(lds + GS_ST); bf16* VnT = (bf16*)(lds + GS_VNT);
    for (int i = tid; i < 2 * 32 * 136 / 2; i += NTH) ((unsigned*)St)[i] = 0u;
    f32x4 accS[2]; accS[0] = (f32x4){0.f, 0.f, 0.f, 0.f}; accS[1] = accS[0];
    bf16x8_t aW[4], aQG[4], aQK[2], aKD[2]; v2u ut; float egl;
#define GS_LOAD(un_) do { const size_t u_ = (size_t)(un_); \
        _Pragma("unroll") for (int ks = 0; ks < 4; ++ks) { aW[ks] = *(const bf16x8_t*)(cb.W + (u_ * 64 + mi * 16 + fr) * 128 + ks * 32 + 8 * fq); aQG[ks] = *(const bf16x8_t*)(cb.QG + (u_ * 64 + mi * 16 + fr) * 128 + ks * 32 + 8 * fq); } \
        _Pragma("unroll") for (int ks = 0; ks < 2; ++ks) { aQK[ks] = *(const bf16x8_t*)(cb.QK + (u_ * 64 + mi * 16 + fr) * 64 + ks * 32 + 8 * fq); aKD[ks] = *(const bf16x8_t*)(cb.KDT + (u_ * 128 + wave * 16 + fr) * 64 + ks * 32 + 8 * fq); } \
        ut = *(const v2u*)(cb.UT + (u_ * 128 + sl * 32 + nj * 16 + fr) * 64 + mi * 16 + 4 * fq); egl = cb.EGL[u_]; } while (0)
    int cur = 0;
    for (int n = 0; n < 64; ++n) {
        const int un = (b * 64 + n) * 4 + h;
        GS_LOAD(un);
        __syncthreads();
        f32x4 accW = (f32x4){0.f, 0.f, 0.f, 0.f}, accO = accW;
        const bf16* Sc = St + cur * 32 * 136;
#pragma unroll
        for (int ks = 0; ks < 4; ++ks) { const bf16x8_t bs = *(const bf16x8_t*)(Sc + (nj * 16 + fr) * 136 + ks * 32 + 8 * fq); accW = mfma16(aW[ks], bs, accW); accO = mfma16(aQG[ks], bs, accO); }
        const float v0 = bflo(ut.x) - accW[0], v1 = bfhi(ut.x) - accW[1], v2 = bflo(ut.y) - accW[2], v3 = bfhi(ut.y) - accW[3];
        { v2u o; o.x = pk2(v0, v1); o.y = pk2(v2, v3); *(v2u*)(VnT + (nj * 16 + fr) * 72 + mi * 16 + 4 * fq) = o; }
        __syncthreads();
#pragma unroll
        for (int ks = 0; ks < 2; ++ks) { const bf16x8_t bv = *(const bf16x8_t*)(VnT + (nj * 16 + fr) * 72 + ks * 32 + 8 * fq); accO = mfma16(aQK[ks], bv, accO); }
        {
            float* orow = O + (size_t)(b * SEQ + n * 64 + mi * 16 + 4 * fq) * 512 + h * 128 + sl * 32 + nj * 16 + fr;
            orow[0] = accO[0]; orow[512] = accO[1]; orow[1024] = accO[2]; orow[1536] = accO[3];
        }
        bf16* Sn = St + (cur ^ 1) * 32 * 136;
#pragma unroll
        for (int njj = 0; njj < 2; ++njj) {
            accS[njj] = accS[njj] * egl;
#pragma unroll
            for (int ks = 0; ks < 2; ++ks) { const bf16x8_t bv = *(const bf16x8_t*)(VnT + (njj * 16 + fr) * 72 + ks * 32 + 8 * fq); accS[njj] = mfma16(aKD[ks], bv, accS[njj]); }
            v2u o; o.x = pk2(accS[njj][0], accS[njj][1]); o.y = pk2(accS[njj][2], accS[njj][3]);
            *(v2u*)(Sn + (njj * 16 + fr) * 136 + wave * 16 + 4 * fq) = o;
        }
        cur ^= 1;
    }
#undef GS_LOAD
#pragma unroll
    for (int njj = 0; njj < 2; ++njj)
#pragma unroll
        for (int r = 0; r < 4; ++r) Sout[(((size_t)b * 4 + h) * 128 + wave * 16 + 4 * fq + r) * 128 + sl * 32 + njj * 16 + fr] = accS[njj][r];
    __syncthreads();
}

__device__ __forceinline__ void lru_prep_unit(const bf16* __restrict__ PROJ, const float* __restrict__ conv_w, const float* __restrict__ conv_b,
                                              const float* __restrict__ w_r, const float* __restrict__ b_r, const float* __restrict__ w_i, const float* __restrict__ b_i, const float* __restrict__ lam,
                                              float* __restrict__ H, float* __restrict__ P, float* __restrict__ Hend, float* __restrict__ Pend, float* __restrict__ p_lru_conv, int ub) {
    int c = threadIdx.x; asm volatile("" : "+v"(c));
    const int nblk = c >> 6, d = c & 63;
    const int n = ub & 63, b = ub >> 6, t0 = b * SEQ + n * 64;
    float wr[64], wi[64];
#pragma unroll
    for (int cc = 0; cc < 64; ++cc) { wr[cc] = w_r[((size_t)nblk * 64 + cc) * 64 + d]; wi[cc] = w_i[((size_t)nblk * 64 + cc) * 64 + d]; }
    const float cw0 = conv_w[c], cw1 = conv_w[512 + c], cw2 = conv_w[1024 + c], cw3 = conv_w[1536 + c], cb_ = conv_b[c];
    const float br = b_r[c], bi = b_i[c], spl = -8.0f * softplusf_(-lam[c]);
    float x0 = (n * 64 - 3 >= 0) ? bf2f(PROJ[(size_t)(t0 - 3) * ABN + C_XR + c]) : 0.f;
    float x1 = (n * 64 - 2 >= 0) ? bf2f(PROJ[(size_t)(t0 - 2) * ABN + C_XR + c]) : 0.f;
    float x2 = (n * 64 - 1 >= 0) ? bf2f(PROJ[(size_t)(t0 - 1) * ABN + C_XR + c]) : 0.f;
    float hloc = 0.f, ploc = 1.f;
    for (int i = 0; i < 64; ++i) {
        const float xt = bf2f(PROJ[(size_t)(t0 + i) * ABN + C_XR + c]);
        const float xr = cb_ + cw0 * x0 + cw1 * x1 + cw2 * x2 + cw3 * xt;
        float r = br, ii = bi;
#pragma unroll
        for (int cc = 0; cc < 64; ++cc) { const float xv = __uint_as_float(__builtin_amdgcn_readlane(__float_as_uint(xr), cc)); r += xv * wr[cc]; ii += xv * wi[cc]; }
        r = sigmoidf_(r); ii = sigmoidf_(ii);
        const float log_a = spl * r;
        const float a = expf(log_a), bb = sqrtf(-expm1f(2.0f * log_a)) * (ii * xr);
        hloc = a * hloc + bb; ploc *= a;
        H[(size_t)(t0 + i) * 512 + c] = hloc; P[(size_t)(t0 + i) * 512 + c] = ploc;
        if (n == 63 && i >= 61) p_lru_conv[((size_t)b * 3 + (i - 61)) * 512 + c] = xt;
        x0 = x1; x1 = x2; x2 = xt;
    }
    Hend[(size_t)ub * 512 + c] = hloc; Pend[(size_t)ub * 512 + c] = ploc;
}
__device__ __forceinline__ void lru_carry(const float* __restrict__ Hend, const float* __restrict__ Pend, float* __restrict__ CIN, float* __restrict__ hlast, int bx) {
    const int idx = bx * NTH + threadIdx.x, b = idx >> 9, c = idx & 511;
    float carry = 0.f;
#pragma unroll 8
    for (int n = 0; n < 64; ++n) {
        const size_t o = ((size_t)b * 64 + n) * 512 + c;
        CIN[o] = carry;
        carry = Hend[o] + Pend[o] * carry;
    }
    hlast[(size_t)b * 512 + c] = carry;
}

__device__ __forceinline__ unsigned f2key(float f) { const unsigned u = __float_as_uint(f); return u ^ ((u >> 31) ? 0xffffffffu : 0x80000000u); }
__device__ __forceinline__ float key2f(unsigned k) { return __uint_as_float(k ^ ((k >> 31) ? 0x80000000u : 0xffffffffu)); }
constexpr int TK_SS = 0, TK_TS = 2 * 64 * 129 * 4, TK_END = TK_TS + 64 * 2 * 16 * 4;
__device__ __forceinline__ void peer_topk2(const bf16* __restrict__ Q, const bf16* __restrict__ KB  , int* __restrict__ EXP, float* __restrict__ GATE,
                                           int tile, int h, unsigned char* lds) {
    int tid = threadIdx.x; asm volatile("" : "+v"(tid));
    const int lane = tid & 63, wave = __builtin_amdgcn_readfirstlane(tid >> 6), fr = lane & 15, fq = lane >> 4;
    float* Ss = (float*)(lds + TK_SS); unsigned* Ts = (unsigned*)(lds + TK_TS);
    {
        const int c = wave >> 2, mt = wave & 3;
        bf16x8_t a[4];
#pragma unroll
        for (int ks = 0; ks < 4; ++ks) a[ks] = *(const bf16x8_t*)(Q + (size_t)(tile * 64 + mt * 16 + fr) * 2048 + h * 256 + c * 128 + ks * 32 + 8 * fq);
        const bf16* kb = KB + ((size_t)(h * 2 + c) * 128) * 128;
#pragma unroll
        for (int nt = 0; nt < 8; ++nt) {
            f32x4 acc = (f32x4){0.f, 0.f, 0.f, 0.f};
#pragma unroll
            for (int ks = 0; ks < 4; ++ks) { const bf16x8_t bk = *(const bf16x8_t*)(kb + (size_t)(nt * 16 + fr) * 128 + ks * 32 + 8 * fq); acc = mfma16(a[ks], bk, acc); }
#pragma unroll
            for (int r = 0; r < 4; ++r) Ss[(c * 64 + mt * 16 + 4 * fq + r) * 129 + nt * 16 + fr] = acc[r];
        }
    }
    __syncthreads();
    if (tid < 128) {
        const float* row = Ss + tid * 129;
        unsigned top[16];
#pragma unroll
        for (int j = 0; j < 16; ++j) top[j] = 0u;
        for (int n = 0; n < 128; ++n) {
            unsigned x = (f2key(row[n]) & ~127u) | (unsigned)(127 - n);
#pragma unroll
            for (int j = 0; j < 16; ++j) { const unsigned t = top[j] > x ? top[j] : x; x = top[j] > x ? x : top[j]; top[j] = t; }
        }
        const int c = tid >> 6, tk = tid & 63;
#pragma unroll
        for (int j = 0; j < 16; ++j) Ts[(tk * 2 + c) * 16 + j] = top[j];
    }
    __syncthreads();
    if (tid < 64) {
        const int tk = tid;
        float s0[16], s1[16];
#pragma unroll
        for (int j = 0; j < 16; ++j) { s0[j] = key2f(Ts[(tk * 2 + 0) * 16 + j] & ~127u); s1[j] = key2f(Ts[(tk * 2 + 1) * 16 + j] & ~127u); }
        unsigned top[16];
#pragma unroll
        for (int j = 0; j < 16; ++j) top[j] = 0u;
#pragma unroll
        for (int i = 0; i < 16; ++i)
#pragma unroll
            for (int jj = 0; jj < 16; ++jj)
                if ((i + 1) * (jj + 1) <= 16) {
                    unsigned x = (f2key(s0[i] + s1[jj]) & ~255u) | (unsigned)(255 - (i * 16 + jj));
#pragma unroll
                    for (int j = 0; j < 16; ++j) { const unsigned t = top[j] > x ? top[j] : x; x = top[j] > x ? x : top[j]; top[j] = t; }
                }
        float e[16], sum = 0.f; const float m = key2f(top[0] & ~255u);
#pragma unroll
        for (int j = 0; j < 16; ++j) { e[j] = expf(key2f(top[j] & ~255u) - m); sum += e[j]; }
        const float inv = 1.0f / sum;
        const size_t o = (size_t)(tile * 64 + tk) * 128 + h * 16;
#pragma unroll
        for (int j = 0; j < 16; ++j) {
            const int code = 255 - (int)(top[j] & 255u), i = code >> 4, jj = code & 15;
            const int n0 = 127 - (int)(Ts[(tk * 2 + 0) * 16 + i] & 127u), n1 = 127 - (int)(Ts[(tk * 2 + 1) * 16 + jj] & 127u);
            EXP[o + j] = n0 * 128 + n1; GATE[o + j] = e[j] * inv;
        }
    }
    __syncthreads();
}

constexpr int AT_KS = 0, AT_VT = 192 * 72 * 2, AT_BT = AT_VT + 64 * 200 * 2, AT_PW = AT_BT + 4 * 128 * 4, AT_END = AT_PW + 8 * 32 * 72 * 2;
__device__ __forceinline__ void attn_unit(const bf16* __restrict__ PCb, const float* __restrict__ rel_bias, const float* __restrict__ sinks, bf16* __restrict__ ATT, int un, unsigned char* lds) {
    int tid = threadIdx.x; asm volatile("" : "+v"(tid));
    const int lane = tid & 63, wave = __builtin_amdgcn_readfirstlane(tid >> 6), fr = lane & 15, fq = lane >> 4;
    const int kvh = un & 3, qblk = (un >> 2) & 63, b = un >> 8;
    const int q0 = qblk * 64, tb = b * SEQ;
    bf16* Ks = (bf16*)(lds + AT_KS); bf16* Vt = (bf16*)(lds + AT_VT); float* Bt = (float*)(lds + AT_BT); bf16* Pw = (bf16*)(lds + AT_PW) + wave * 32 * 72;
#pragma unroll
    for (int k = 0; k < 3; ++k) {
        const int ci = tid + 512 * k, row = ci >> 3, part = ci & 7, kpos = q0 - 128 + row;
        v4u kv = (v4u){0u, 0u, 0u, 0u}, vv = kv;
        if (kpos >= 0) { const bf16* src = PCb + (size_t)(tb + kpos) * CN + kvh * 64 + part * 8; kv = *(const v4u*)(src + 1024); vv = *(const v4u*)(src + 1280); }
        *(v4u*)(Ks + row * 72 + part * 8) = kv;
        bf16* vd = Vt + (part * 8) * 200 + row;
        vd[0 * 200] = (bf16)(vv.x & 0xffffu); vd[1 * 200] = (bf16)(vv.x >> 16); vd[2 * 200] = (bf16)(vv.y & 0xffffu); vd[3 * 200] = (bf16)(vv.y >> 16);
        vd[4 * 200] = (bf16)(vv.z & 0xffffu); vd[5 * 200] = (bf16)(vv.z >> 16); vd[6 * 200] = (bf16)(vv.w & 0xffffu); vd[7 * 200] = (bf16)(vv.w >> 16);
    }
    Bt[tid] = rel_bias[t5_bucket(tid & 127) * 16 + kvh * 4 + (tid >> 7)];
    __syncthreads();
    const int g = wave >> 1, qs = (wave & 1) * 32, hh = kvh * 4 + g;
    bf16x8_t aQ[2][2];
#pragma unroll
    for (int mt = 0; mt < 2; ++mt)
#pragma unroll
        for (int ks = 0; ks < 2; ++ks) aQ[mt][ks] = *(const bf16x8_t*)(PCb + (size_t)(tb + q0 + qs + mt * 16 + fr) * CN + hh * 64 + ks * 32 + 8 * fq);
    f32x4 sc[2][12];
#pragma unroll
    for (int nt = 0; nt < 12; ++nt) {
        const bf16x8_t b0 = *(const bf16x8_t*)(Ks + (nt * 16 + fr) * 72 + 8 * fq), b1 = *(const bf16x8_t*)(Ks + (nt * 16 + fr) * 72 + 32 + 8 * fq);
#pragma unroll
        for (int mt = 0; mt < 2; ++mt) { f32x4 a = (f32x4){0.f, 0.f, 0.f, 0.f}; a = mfma16(aQ[mt][0], b0, a); a = mfma16(aQ[mt][1], b1, a); sc[mt][nt] = a; }
    }
    const float sink = sinks[hh];
    const float* bt = Bt + g * 128;
#pragma unroll
    for (int mt = 0; mt < 2; ++mt)
#pragma unroll
        for (int r = 0; r < 4; ++r) {
            const int qi = qs + mt * 16 + 4 * fq + r;
            float mx = sink;
#pragma unroll
            for (int nt = 0; nt < 12; ++nt) {
                const int kk = nt * 16 + fr, rel = qi + 128 - kk;
                const bool valid = rel >= 0 && rel < 128 && (q0 - 128 + kk) >= 0;
                const float lg = valid ? sc[mt][nt][r] * 0.125f + bt[valid ? rel : 0] : -INFINITY;
                sc[mt][nt][r] = lg; mx = fmaxf(mx, lg);
            }
            mx = fmaxf(mx, __shfl_xor(mx, 1)); mx = fmaxf(mx, __shfl_xor(mx, 2)); mx = fmaxf(mx, __shfl_xor(mx, 4)); mx = fmaxf(mx, __shfl_xor(mx, 8));
            float sum = 0.f;
#pragma unroll
            for (int nt = 0; nt < 12; ++nt) { const float p = __expf(sc[mt][nt][r] - mx); sc[mt][nt][r] = p; sum += p; }
            sum += __shfl_xor(sum, 1); sum += __shfl_xor(sum, 2); sum += __shfl_xor(sum, 4); sum += __shfl_xor(sum, 8);
            const float inv = 1.0f / (sum + __expf(sink - mx));
#pragma unroll
            for (int nt = 0; nt < 12; ++nt) sc[mt][nt][r] *= inv;
        }
    f32x4 oacc[2][4];
#pragma unroll
    for (int mt = 0; mt < 2; ++mt)
#pragma unroll
        for (int dt = 0; dt < 4; ++dt) oacc[mt][dt] = (f32x4){0.f, 0.f, 0.f, 0.f};
#pragma unroll
    for (int kc = 0; kc < 3; ++kc) {
#pragma unroll
        for (int mt = 0; mt < 2; ++mt)
#pragma unroll
            for (int n4 = 0; n4 < 4; ++n4)
#pragma unroll
                for (int r = 0; r < 4; ++r) Pw[(mt * 16 + 4 * fq + r) * 72 + n4 * 16 + fr] = (bf16)f2bf(sc[mt][kc * 4 + n4][r]);
        asm volatile("s_waitcnt lgkmcnt(0)" ::: "memory");
#pragma unroll
        for (int ks = 0; ks < 2; ++ks) {
            const bf16x8_t p0 = *(const bf16x8_t*)(Pw + fr * 72 + ks * 32 + 8 * fq), p1 = *(const bf16x8_t*)(Pw + (16 + fr) * 72 + ks * 32 + 8 * fq);
#pragma unroll
            for (int dt = 0; dt < 4; ++dt) {
                const bf16x8_t bv = *(const bf16x8_t*)(Vt + (dt * 16 + fr) * 200 + kc * 64 + ks * 32 + 8 * fq);
                oacc[0][dt] = mfma16(p0, bv, oacc[0][dt]); oacc[1][dt] = mfma16(p1, bv, oacc[1][dt]);
            }
        }
        asm volatile("s_waitcnt lgkmcnt(0)" ::: "memory");
    }
#pragma unroll
    for (int mt = 0; mt < 2; ++mt)
#pragma unroll
        for (int dt = 0; dt < 4; ++dt)
#pragma unroll
            for (int r = 0; r < 4; ++r) Pw[(mt * 16 + 4 * fq + r) * 72 + dt * 16 + fr] = (bf16)f2bf(oacc[mt][dt][r]);
    asm volatile("s_waitcnt lgkmcnt(0)" ::: "memory");
#pragma unroll
    for (int k = 0; k < 4; ++k) {
        const int ci = lane + 64 * k, row = ci >> 3, part = ci & 7;
        *(v4u*)(ATT + (size_t)(tb + q0 + qs + row) * D + hh * 64 + part * 8) = *(const v4u*)(Pw + row * 72 + part * 8);
    }
    __syncthreads();
}

__device__ __forceinline__ void swa_attn_sample(const bf16* __restrict__ PCb, const float* __restrict__ cache_k, const float* __restrict__ cache_v,
                                                const float* __restrict__ rel_bias, const float* __restrict__ sinks, bf16* __restrict__ ATT, int gw, int lane) {
    const int sb = gw >> 4, h = gw & 15, kvh = h >> 2, t = NP + sb;
    const bf16* qrow = PCb + (size_t)t * CN + h * 64;
    float lg[2];
#pragma unroll
    for (int rr = 0; rr < 2; ++rr) {
        const int r = lane + 64 * rr;
        float dot = 0.f;
        if (r == 0) {
            const bf16* krow = PCb + (size_t)t * CN + 1024 + kvh * 64;
            for (int d = 0; d < 64; ++d) dot += bf2f(qrow[d]) * bf2f(krow[d]);
        } else {
            const float* krow = cache_k + (((size_t)sb * 128 + (128 - r)) * 4 + kvh) * 64;
#pragma unroll
            for (int d4 = 0; d4 < 16; ++d4) { const float4 kv = *(const float4*)(krow + d4 * 4);
                dot += bf2f(qrow[d4 * 4]) * kv.x + bf2f(qrow[d4 * 4 + 1]) * kv.y + bf2f(qrow[d4 * 4 + 2]) * kv.z + bf2f(qrow[d4 * 4 + 3]) * kv.w; }
        }
        lg[rr] = dot * 0.125f + rel_bias[t5_bucket(r) * 16 + h];
    }
    const float sink = sinks[h];
    const float m = fmaxf(wave_max(fmaxf(lg[0], lg[1])), sink);
    float p[2] = {expf(lg[0] - m), expf(lg[1] - m)};
    const float inv = 1.0f / (wave_sum(p[0] + p[1]) + expf(sink - m));
    float o = 0.f;
#pragma unroll
    for (int rr = 0; rr < 2; ++rr)
        for (int l2 = 0; l2 < 64; ++l2) {
            const int r = l2 + 64 * rr;
            const float pj = __shfl(p[rr], l2);
            const float vv = (r == 0) ? bf2f(PCb[(size_t)t * CN + 1280 + kvh * 64 + lane]) : cache_v[(((size_t)sb * 128 + (128 - r)) * 4 + kvh) * 64 + lane];
            o += pj * vv;
        }
    ATT[(size_t)t * D + h * 64 + lane] = (bf16)f2bf(o * inv);
}
__device__ __forceinline__ void swa_kv_out2(const bf16* __restrict__ PCb, const float* __restrict__ cache_k, const float* __restrict__ cache_v,
                                            float* __restrict__ pk, float* __restrict__ pv, float* __restrict__ sk, float* __restrict__ sv, int vb) {
    const int c = threadIdx.x & 255, row = vb * 2 + (threadIdx.x >> 8);
    if (row < NB * 128) {
        const int b = row >> 7, i = row & 127;
        const bf16* src = PCb + (size_t)(b * SEQ + SEQ - 128 + i) * CN;
        pk[(size_t)row * 256 + c] = bf2f(src[1024 + c]);
        pv[(size_t)row * 256 + c] = bf2f(src[1280 + c]);
    } else {
        const int r2 = row - NB * 128, sb = r2 >> 7, i = r2 & 127;
        if (i < 127) {
            sk[(size_t)r2 * 256 + c] = cache_k[((size_t)sb * 128 + i + 1) * 256 + c];
            sv[(size_t)r2 * 256 + c] = cache_v[((size_t)sb * 128 + i + 1) * 256 + c];
        } else {
            const bf16* src = PCb + (size_t)(NP + sb) * CN;
            sk[(size_t)r2 * 256 + c] = bf2f(src[1024 + c]);
            sv[(size_t)r2 * 256 + c] = bf2f(src[1280 + c]);
        }
    }
}

constexpr size_t MiB = 1u << 20;
constexpr size_t WS_CTL = 0, CTL_ZERO_BYTES = 64 * 1024;
constexpr size_t WS_WAB = 1 * MiB;
constexpr size_t WS_WOUT = WS_WAB + (size_t)ABNP * D * 2;
constexpr size_t WS_WQ0 = WS_WOUT + (size_t)D * D * 2;
constexpr size_t WS_WQ1 = WS_WQ0 + (size_t)2048 * D * 2;
constexpr size_t WS_WINC = WS_WQ1 + (size_t)2048 * D * 2;
constexpr size_t WS_WOUTC = WS_WINC + (size_t)CN * D * 2;
constexpr size_t WS_ABUF = WS_WOUTC + (size_t)D * D * 2;
constexpr size_t WS_P = WS_ABUF + (size_t)MP * D * 2;
constexpr size_t WS_T = WS_P + (size_t)MP * ABN * 2;
constexpr size_t WS_Q = WS_T + (size_t)2 * 16384 * D * 2;
constexpr size_t WS_A = WS_Q + (size_t)MP * 1536 * 4;
constexpr size_t WS_B = WS_A + (size_t)MP * 512 * 4;
constexpr size_t WS_O = WS_B + (size_t)MP * 512 * 4;
constexpr size_t WS_X1 = WS_O + (size_t)MP * 512 * 4;
constexpr size_t WS_G = WS_X1 + (size_t)MP * D * 4;
constexpr size_t WS_BETA = WS_G + (size_t)MP * 4 * 4;
constexpr size_t WS_GATE = WS_BETA + (size_t)MP * 4 * 4;
constexpr size_t WS_EXP = WS_GATE + (size_t)MP * 128 * 4;
constexpr size_t WS_HEND = WS_EXP + (size_t)MP * 128 * 4;
constexpr size_t WS_KEYS = WS_HEND + (size_t)3 * 4 * 64 * 512 * 4;
constexpr size_t WS_END = WS_KEYS + (size_t)2 * 8 * 2 * 128 * 128 * 2;
constexpr size_t Q_QKVS = 0, Q_W = 1 * MiB, Q_QG = Q_W + 16 * MiB, Q_KDT = Q_QG + 16 * MiB, Q_UT = Q_KDT + 16 * MiB, Q_QK = Q_UT + 16 * MiB, Q_EGL = Q_QK + 8 * MiB, Q_END = Q_EGL + 4096;
static_assert(Q_END <= (size_t)MP * 1536 * 4, "region Q");
static_assert(WS_END <= 512 * MiB, "d_ws map");

struct MegaArgs {
    const float* in[35];
    float* out;
    unsigned char* ws;
};

__global__ void __launch_bounds__(NTH, 2) fwd_megakernel(MegaArgs ma) {
    cg::grid_group grid = cg::this_grid();
    extern __shared__ __attribute__((aligned(16))) unsigned char lds[];
    float* smem = (float*)lds;
    const int nb = gridDim.x, b0 = blockIdx.x, tid = threadIdx.x, lane = tid & 63, wave = __builtin_amdgcn_readfirstlane(tid >> 6);
    const float* x_prompt = ma.in[0];
    const float* x_sample = ma.in[1];
    const float* state_gdn = ma.in[2];
    const float* state_gdn_conv = ma.in[3];
    const float* state_lru = ma.in[4];
    const float* state_lru_conv = ma.in[5];
    const float* cache_k = ma.in[6];
    const float* cache_v = ma.in[7];
    const float* w_in_ab = ma.in[8];
    const float* gdn_conv_w = ma.in[9];
    const float* gdn_a_log = ma.in[10];
    const float* gdn_dt_bias = ma.in[11];
    const float* gdn_norm_w = ma.in[12];
    const float* lru_conv_w = ma.in[13];
    const float* lru_conv_b = ma.in[14];
    const float* lru_w_r = ma.in[15];
    const float* lru_b_r = ma.in[16];
    const float* lru_w_i = ma.in[17];
    const float* lru_b_i = ma.in[18];
    const float* lru_lam = ma.in[19];
    const float* w_out_ab = ma.in[20];
    const float* w_in_c = ma.in[21];
    const float* b_in_c = ma.in[22];
    const float* swa_sinks = ma.in[23];
    const float* w_out_c = ma.in[24];
    const float* b_out_c = ma.in[25];
    const float* rel_bias = ma.in[26];
    const float* ln_mix_g = ma.in[27];
    const float* ln_mix_b = ma.in[28];
    const float* ln_ffn_g = ma.in[29];
    const float* ln_ffn_b = ma.in[30];
    const float* peer_w_q = ma.in[31];
    const float* peer_keys = ma.in[32];
    const float* peer_u = ma.in[33];
    const float* peer_v = ma.in[34];

    float* out = ma.out;
    float* o_y = out;
    float* o_p_gdn = out + (size_t)NT * D;
    float* o_p_gdn_conv = o_p_gdn + 262144;
    float* o_p_lru = o_p_gdn_conv + 18432;
    float* o_p_lru_conv = o_p_lru + 2048;
    float* o_p_k = o_p_lru_conv + 6144;
    float* o_p_v = o_p_k + 131072;
    float* o_s_gdn = o_p_v + 131072;
    float* o_s_gdn_conv = o_s_gdn + 8388608;
    float* o_s_lru = o_s_gdn_conv + 589824;
    float* o_s_lru_conv = o_s_lru + 65536;
    float* o_s_k = o_s_lru_conv + 196608;
    float* o_s_v = o_s_k + 4194304;

    unsigned char* ws = ma.ws;
    bf16* WAB_T = (bf16*)(ws + WS_WAB); bf16* WOUT_T = (bf16*)(ws + WS_WOUT); bf16* WQ0_T = (bf16*)(ws + WS_WQ0); bf16* WQ1_T = (bf16*)(ws + WS_WQ1);
    bf16* WINC_T = (bf16*)(ws + WS_WINC); bf16* WOUTC_T = (bf16*)(ws + WS_WOUTC);
    bf16* ABUF = (bf16*)(ws + WS_ABUF);
    bf16* PROJ = (bf16*)(ws + WS_P); float* Y = (float*)(ws + WS_P); bf16* Qb = (bf16*)(ws + WS_P); bf16* PCb = (bf16*)(ws + WS_P); float* Y1 = (float*)(ws + WS_P);
    bf16* UV0 = (bf16*)(ws + WS_T); bf16* UV1 = (bf16*)(ws + WS_Q);
    float* R_Q = (float*)(ws + WS_Q + Q_QKVS) - (size_t)NP * 1536; float* X2 = (float*)(ws + WS_A);
    GdnChunkBufs cbuf; cbuf.W = (bf16*)(ws + WS_Q + Q_W); cbuf.QG = (bf16*)(ws + WS_Q + Q_QG); cbuf.KDT = (bf16*)(ws + WS_Q + Q_KDT); cbuf.UT = (bf16*)(ws + WS_Q + Q_UT); cbuf.QK = (bf16*)(ws + WS_Q + Q_QK); cbuf.EGL = (float*)(ws + WS_Q + Q_EGL);
    bf16* KEYSB = (bf16*)(ws + WS_KEYS);
    float* HEND = (float*)(ws + WS_HEND); float* PEND = HEND + 4 * 64 * 512; float* CIN = PEND + 4 * 64 * 512;
    float* R_A = (float*)(ws + WS_A); float* R_B = (float*)(ws + WS_B); float* R_O = (float*)(ws + WS_O);
    float* R_X1 = (float*)(ws + WS_X1); float* X3 = R_X1;
    float* R_G = (float*)(ws + WS_G); float* R_BETA = (float*)(ws + WS_BETA); float* R_GATE = (float*)(ws + WS_GATE); int* R_EXP = (int*)(ws + WS_EXP);

    for (int u = tid; u < (LDS_BYTES - RING_BYTES) / 4; u += NTH) ((unsigned*)(lds + RING_BYTES))[u] = 0u;
    __syncthreads();
    XcdBarrier bar = xcd_barrier_post((unsigned*)(ws + WS_CTL), (volatile LAS unsigned*)((LAS unsigned char*)lds + MISC_OFF) + 8);
#define GRID_BAR() xcd_barrier(bar)
#define PHASE_LOOP(n) for (int vb = b0; vb < (n); vb += nb)
#define PHASE_END __syncthreads()
#define GEMM_PHASE(EPI, Aptr, Btptr, Nn, ...) do { pg8::Gemm g_{(const pg8::bf16_t*)(Aptr), (const pg8::bf16_t*)(Btptr), MP, (Nn), D}; pg8::StaticOrder S_; S_.init(MP, (Nn), nb, b0); \
        pg8::EPI E_{__VA_ARGS__}; pg8::gemm_phase<pg8::EPI, pg8::StaticOrder, true, true>((PG8_LAS unsigned char*)lds, g_, S_, E_); } while (0)

    {
        float* scr = smem + wave * 4096;
        const int gw = b0 * NWAVES + wave, NGW = nb * NWAVES;
        constexpr int I_AB = 16 * 97, I_OUT = 16 * 32, I_Q = 16 * 64, I_INC = 16 * 48;
        constexpr int NITEMS = I_AB + I_OUT + 2 * I_Q + I_INC + I_OUT;
        for (int it = gw; it < NITEMS; it += NGW) {
            int r = it;
            if (r < I_AB) { p0_transpose_item(w_in_ab, D, ABN, WAB_T, scr, r, lane); continue; } r -= I_AB;
            if (r < I_OUT) { p0_transpose_item(w_out_ab, D, D, WOUT_T, scr, r, lane); continue; } r -= I_OUT;
            if (r < I_Q) { p0_transpose_item(peer_w_q, D, 2048, WQ0_T, scr, r, lane); continue; } r -= I_Q;
            if (r < I_Q) { p0_transpose_item(peer_w_q + (size_t)D * 2048, D, 2048, WQ1_T, scr, r, lane); continue; } r -= I_Q;
            if (r < I_INC) { p0_transpose_item(w_in_c, D, CN, WINC_T, scr, r, lane); continue; } r -= I_INC;
            p0_transpose_item(w_out_c, D, D, WOUTC_T, scr, r, lane);
        }
        for (int m = gw; m < 512; m += NGW) row_to_bf16(peer_keys + (size_t)m * D, KEYSB + (size_t)m * D, lane);
        for (int m = gw; m < 2 * 16384; m += NGW)
            row_to_bf16((m < 16384 ? peer_u : peer_v) + (size_t)(m & 16383) * D, UV0 + (size_t)m * D, lane);
        for (int m = gw; m < MP + (ABNP - 97 * 32); m += NGW) {
            if (m < MP) row_to_bf16(m < NP ? x_prompt + (size_t)m * D : (m < NT ? x_sample + (size_t)(m - NP) * D : nullptr), ABUF + (size_t)m * D, lane);
            else row_to_bf16(nullptr, WAB_T + (size_t)(97 * 32 + (m - MP)) * D, lane);
        }
    }
    grid.sync();
    GEMM_PHASE(EpiStoreBf16, ABUF, WAB_T, ABNP, PROJ, ABN, nullptr, NT, ABN);
    GRID_BAR();
    { AbPrepArgs pa;
      pa.PROJ = PROJ; pa.st_gdn_conv = state_gdn_conv; pa.st_lru_conv = state_lru_conv;
      pa.gdn_conv_w = gdn_conv_w; pa.a_log = gdn_a_log; pa.dt_bias = gdn_dt_bias;
      pa.lru_conv_w = lru_conv_w; pa.lru_conv_b = lru_conv_b; pa.w_r = lru_w_r; pa.b_r = lru_b_r; pa.w_i = lru_w_i; pa.b_i = lru_b_i; pa.lam = lru_lam;
      pa.QKV = R_Q; pa.G = R_G; pa.BETA = R_BETA; pa.LA = R_A; pa.LB = R_B;
      pa.p_gdn_conv = o_p_gdn_conv; pa.p_lru_conv = o_p_lru_conv; pa.s_gdn_conv = o_s_gdn_conv; pa.s_lru_conv = o_s_lru_conv;
      PHASE_LOOP(1024 + 256 + NS) {
          if (vb < 1024) gdn_prep_unit(PROJ, gdn_conv_w, gdn_a_log, gdn_dt_bias, cbuf, o_p_gdn_conv, vb, lds);
          else if (vb < 1280) lru_prep_unit(PROJ, lru_conv_w, lru_conv_b, lru_w_r, lru_b_r, lru_w_i, lru_b_i, lru_lam, R_B, R_A, HEND, PEND, o_p_lru_conv, vb - 1024);
          else { ab_prep(pa, NP + (vb - 1280), smem); PHASE_END; } } }
    GRID_BAR();
    if (b0 < 64) gdn_seq(cbuf, R_O, o_p_gdn, b0 >> 4, (b0 >> 2) & 3, b0 & 3, lds);
    else if (b0 < 68) lru_carry(HEND, PEND, CIN, o_p_lru, b0 - 64);
    else for (int v = b0 - 68; v < 2048 + 128; v += nb - 68) {
        if (v < 2048) gdn_scan(R_Q, R_G, R_BETA, state_gdn, R_O, o_s_gdn, NP, 1, v & 3, (v >> 2) & 3, v >> 4, smem);
        else lru_scan(R_A, R_B, state_lru, o_s_lru, NP, 1, NS, v - 2048);
        PHASE_END;
    }
    GRID_BAR();
    PHASE_LOOP(NT / 2) { ab_mix(PROJ, R_O, R_B, R_A, CIN, gdn_norm_w, ABUF, vb); }
    for (int m = b0 * NWAVES + wave; m < 2 * 16384; m += nb * NWAVES)
        row_to_bf16((m < 16384 ? peer_u : peer_v) + (size_t)(16384 + (m & 16383)) * D, UV1 + (size_t)m * D, lane);
    GRID_BAR();
    GEMM_PHASE(EpiStoreF32, ABUF, WOUT_T, D, Y, D, nullptr, NT, D);
    GRID_BAR();
    PHASE_LOOP(NT / 8) { const int t = vb * 8 + wave;
        ln_res_w(t < NP ? x_prompt + (size_t)t * D : x_sample + (size_t)(t - NP) * D, Y + (size_t)t * D, ln_mix_g, ln_mix_b, R_X1 + (size_t)t * D, ABUF + (size_t)t * D, lane); }
    GRID_BAR();
    GEMM_PHASE(EpiStoreBf16, ABUF, WQ0_T, 2048, Qb, 2048, nullptr, NT, 2048);
    GRID_BAR();
    PHASE_LOOP((NT / 64) * 8) { peer_topk2(Qb, KEYSB, R_EXP, R_GATE, vb >> 3, vb & 7, lds); }
    GRID_BAR();
    PHASE_LOOP(NT / 8) { const int t = vb * 8 + wave;
        peer_expert_w(R_X1 + (size_t)t * D, ABUF + (size_t)t * D, R_EXP + (size_t)t * 128, R_GATE + (size_t)t * 128, UV0, UV0 + (size_t)16384 * D, ln_ffn_g, ln_ffn_b, X2 + (size_t)t * D, ABUF + (size_t)t * D, lane); }
    GRID_BAR();

    GEMM_PHASE(EpiStoreBf16, ABUF, WINC_T, CN, PCb, CN, b_in_c, NT, CN);
    GRID_BAR();
    PHASE_LOOP(1024 + 256 + (NB * 128 + NS * 128) / 2) {
        if (vb < 1024) attn_unit(PCb, rel_bias, swa_sinks, ABUF, vb, lds);
        else if (vb < 1280) swa_attn_sample(PCb, cache_k, cache_v, rel_bias, swa_sinks, ABUF, (vb - 1024) * 8 + wave, lane);
        else swa_kv_out2(PCb, cache_k, cache_v, o_p_k, o_p_v, o_s_k, o_s_v, vb - 1280);
    }
    GRID_BAR();
    GEMM_PHASE(EpiStoreF32, ABUF, WOUTC_T, D, Y1, D, b_out_c, NT, D);
    GRID_BAR();
    PHASE_LOOP(NT / 8) { const int t = vb * 8 + wave;
        ln_res_w(X2 + (size_t)t * D, Y1 + (size_t)t * D, ln_mix_g + D, ln_mix_b + D, X3 + (size_t)t * D, ABUF + (size_t)t * D, lane); }
    GRID_BAR();
    GEMM_PHASE(EpiStoreBf16, ABUF, WQ1_T, 2048, Qb, 2048, nullptr, NT, 2048);
    GRID_BAR();
    PHASE_LOOP((NT / 64) * 8) { peer_topk2(Qb, KEYSB + (size_t)8 * 2 * 128 * 128, R_EXP, R_GATE, vb >> 3, vb & 7, lds); }
    GRID_BAR();
    PHASE_LOOP(NT / 8) { const int t = vb * 8 + wave;
        peer_expert_w(X3 + (size_t)t * D, ABUF + (size_t)t * D, R_EXP + (size_t)t * 128, R_GATE + (size_t)t * 128, UV1, UV1 + (size_t)16384 * D, ln_ffn_g + D, ln_ffn_b + D, o_y + (size_t)t * D, nullptr, lane); }
}
}

extern "C" void kernel_launch(void* const* d_in, const int* in_sizes, int n_in,
                              void* d_out, int out_size, void* d_ws, size_t ws_size,
                              hipStream_t stream) {
    static int grid_blocks = 0;
    if (!grid_blocks) {
        int dev = 0, cus = 0, per_cu = 0;
        (void)hipGetDevice(&dev);
        (void)hipDeviceGetAttribute(&cus, hipDeviceAttributeMultiprocessorCount, dev);
        if (hipFuncSetAttribute((const void*)fwd_megakernel, hipFuncAttributeMaxDynamicSharedMemorySize, LDS_BYTES) != hipSuccess) { fprintf(stderr, "hipFuncSetAttribute failed\n"); grid_blocks = -1; return; }
        (void)hipOccupancyMaxActiveBlocksPerMultiprocessor(&per_cu, (const void*)fwd_megakernel, NTH, LDS_BYTES);
        if (per_cu < 1) { fprintf(stderr, "occupancy query says %d blocks per CU\n", per_cu); grid_blocks = -1; return; }
        grid_blocks = cus;
    }
    if (grid_blocks < 0) return;
    (void)hipMemsetAsync((char*)d_ws + WS_CTL, 0, CTL_ZERO_BYTES, stream);
    MegaArgs ma{};
    for (int i = 0; i < 35; ++i) ma.in[i] = (const float*)d_in[i];
    ma.out = (float*)d_out;
    ma.ws = (unsigned char*)d_ws;
    void* args[] = {&ma};
    hipError_t e = hipLaunchCooperativeKernel((void*)fwd_megakernel, dim3(grid_blocks), dim3(NTH), args, LDS_BYTES, stream);
    if (e != hipSuccess) fprintf(stderr, "cooperative launch failed: %s (grid %d)\n", hipGetErrorString(e), grid_blocks);
}
```

```cpp
#include <hip/hip_runtime.h>
#include <hip/hip_cooperative_groups.h>
#include <cstdio>
#include <cstdint>
namespace cg = cooperative_groups;

namespace pg8 {
#define PG8_LAS __attribute__((address_space(3)))
typedef unsigned short bf16_t;
typedef short bf16x8 __attribute__((ext_vector_type(8)));
typedef float f32x4 __attribute__((ext_vector_type(4)));
typedef unsigned u32x4 __attribute__((ext_vector_type(4)));
constexpr int BM = 256, BK = 64, HALF = 128, HTB = HALF * BK * 2  , STAGE_BYTES = 8 * HTB, NXCD = 8, WGM = 8;

__host__ __device__ __forceinline__ int lds_byte(int r, int c) { const int st = (r >> 4) * 2 + (c >> 5), rr = r & 15, cc = c & 31, ob = rr * 64 + cc * 2; return st * 1024 + (ob ^ (((ob >> 9) & 1) << 5)); }
__host__ __device__ __forceinline__ void stage_rc(int b, int& R, int& C) { const int st = b / 1024, sb = b % 1024, swz = sb ^ (((sb >> 9) & 1) << 5); R = (st >> 1) * 16 + swz / 64; C = (st & 1) * 32 + (swz % 64) / 2; }
__host__ __device__ __forceinline__ int perm32(int rho) { const int n = rho >> 4, i = rho & 15; return 8 * (i >> 2) + 4 * n + (i & 3); }

struct Unit { int pm, pn; };
struct Gemm { const bf16_t* A; const bf16_t* Bt; int M, N, K; };

struct StaticOrder {
    int nM, nN, nwg, G, c;
    __host__ __device__ void init(int M, int N, int G_, int c_) { nM = M / BM; nN = N / BM; nwg = nM * nN; G = G_; c = c_; }
    __host__ __device__ bool next(int i, Unit& u) const {
        const long L = (long)i * G + c; if (L >= nwg) return false;
        int wgid = (int)L; { const int q = nwg / NXCD, r = nwg % NXCD, xcd = wgid % NXCD, off = wgid / NXCD; wgid = (xcd < r ? xcd * (q + 1) : r * (q + 1) + (xcd - r) * q) + off; }
        const int nig = WGM * nN, gid = wgid / nig, fm = gid * WGM, gsz = (nM - fm) < WGM ? (nM - fm) : WGM;
        u.pm = fm + ((wgid % nig) % gsz); u.pn = (wgid % nig) / gsz; return true;
    }
    __device__ __forceinline__ void a_ready(const Unit&) const {}
    __device__ __forceinline__ void done(const Unit&) const {}
};

__device__ __forceinline__ unsigned cvt_pk_bf16(float lo, float hi) { unsigned r; asm volatile("v_cvt_pk_bf16_f32 %0, %1, %2" : "=v"(r) : "v"(lo), "v"(hi)); return r; }
template <class Epi, class Sched, bool ALIGN_EPI = false, bool SP2 = false>
__device__ __forceinline__ void gemm_phase(PG8_LAS unsigned char* lds, const Gemm g, const Sched& S, const Epi& E) {
    const int tid = threadIdx.x, wid = __builtin_amdgcn_readfirstlane(tid >> 6), lane = tid & 63, wr = wid >> 2, wc = wid & 3, fr = lane & 15, fq = lane >> 4;
    const int K = g.K, nt = K / BK;
    unsigned voffA[2], voffB[2];
#pragma unroll
    for (int i = 0; i < 2; ++i) { int R, C; stage_rc(tid * 16 + i * 8192, R, C); const int Rb = Epi::PERM ? ((R & ~31) + perm32(R & 31)) : R;
        voffA[i] = (unsigned)(R * K + C) * 2u; voffB[i] = (unsigned)(Rb * K + C) * 2u; }
    const size_t kstep = (size_t)(BK * 2);
    const size_t hstep = (size_t)HALF * K * 2;
    const size_t tstep = 2 * hstep;
    const unsigned ldsw = (unsigned)wid * 1024u;
    const int aoff = lds_byte(wr * 64 + fr, fq * 8), boff = lds_byte(wc * 32 + fr, fq * 8);
#define PG8_SA(b, h) (((b) * 2 + (h)) * HTB)
#define PG8_SB(b, h) ((4 + (b) * 2 + (h)) * HTB)
#define PG8_STAGE(bufoff, gbase, voff) do { _Pragma("unroll") for (int _i = 0; _i < 2; ++_i) \
        __builtin_amdgcn_global_load_lds((const unsigned*)((const char*)(gbase) + (voff)[_i]), (PG8_LAS unsigned*)(lds + (bufoff) + ldsw + _i * 8192), 16, 0, 0); } while (0)
#define PG8_LDA(dst, b, h) do { _Pragma("unroll") for (int m = 0; m < 4; ++m) _Pragma("unroll") for (int k = 0; k < 2; ++k) dst[m][k] = *(const PG8_LAS bf16x8*)(lds + PG8_SA(b, h) + aoff + m * 2048 + k * 1024); } while (0)
#define PG8_LDB(dst, b, h) do { _Pragma("unroll") for (int n = 0; n < 2; ++n) _Pragma("unroll") for (int k = 0; k < 2; ++k) dst[n][k] = *(const PG8_LAS bf16x8*)(lds + PG8_SB(b, h) + boff + n * 2048 + k * 1024); } while (0)
#define PG8_MMA(ai, bj, At, Bt) do { __builtin_amdgcn_s_setprio(1); _Pragma("unroll") for (int m = 0; m < 4; ++m) _Pragma("unroll") for (int n = 0; n < 2; ++n) _Pragma("unroll") for (int k = 0; k < 2; ++k) \
        acc[ai][bj][m][n] = __builtin_amdgcn_mfma_f32_16x16x32_bf16(Bt[n][k], At[m][k], acc[ai][bj][m][n], 0, 0, 0); __builtin_amdgcn_s_setprio(0); } while (0)
#define PG8_WAIT_V(n) asm volatile("s_waitcnt vmcnt(" #n ")" ::: "memory")
#define PG8_WAIT_L(n) asm volatile("s_waitcnt lgkmcnt(" #n ")" ::: "memory")
#define PG8_BAR __builtin_amdgcn_s_barrier()
#define PG8_SCHED __builtin_amdgcn_sched_barrier(0)
    Unit cur, nxt; int ui = 0;
    if (!S.next(0, cur)) return;
    f32x4 acc[2][2][4][2];
#pragma unroll
    for (int a = 0; a < 2; ++a)
#pragma unroll
        for (int b = 0; b < 2; ++b)
#pragma unroll
            for (int m = 0; m < 4; ++m)
#pragma unroll
                for (int n = 0; n < 2; ++n) acc[a][b][m][n] = (f32x4){0.f, 0.f, 0.f, 0.f};
    bf16x8 At[4][2], B0[2][2], B1[2][2];
    const char* cA = (const char*)g.A + (size_t)cur.pm * tstep; const char* cB = (const char*)g.Bt + (size_t)cur.pn * tstep;
    S.a_ready(cur);
    if constexpr (SP2) {
        PG8_STAGE(PG8_SB(0, 0), cB, voffB); PG8_STAGE(PG8_SB(0, 1), cB + hstep, voffB); PG8_STAGE(PG8_SA(0, 0), cA, voffA); PG8_STAGE(PG8_SA(0, 1), cA + hstep, voffA);
        if (wr == 1) PG8_BAR;
        PG8_WAIT_V(2); PG8_BAR;
        PG8_STAGE(PG8_SB(1, 0), cB + kstep, voffB); PG8_STAGE(PG8_SA(1, 0), cA + kstep, voffA); PG8_STAGE(PG8_SB(1, 1), cB + hstep + kstep, voffB);
        PG8_WAIT_V(6); PG8_BAR;
    } else {
        PG8_STAGE(PG8_SB(0, 0), cB, voffB); PG8_STAGE(PG8_SA(0, 0), cA, voffA); PG8_STAGE(PG8_SB(0, 1), cB + hstep, voffB); PG8_STAGE(PG8_SA(0, 1), cA + hstep, voffA);
        if (wr == 1) PG8_BAR;
        PG8_WAIT_V(4); PG8_BAR;
        PG8_STAGE(PG8_SB(1, 0), cB + kstep, voffB); PG8_STAGE(PG8_SA(1, 0), cA + kstep, voffA); PG8_STAGE(PG8_SB(1, 1), cB + hstep + kstep, voffB);
        PG8_WAIT_V(6); PG8_BAR;
    }
    for (;;) {
        const bool has_next = S.next(ui + 1, nxt);
        const char* nA = has_next ? (const char*)g.A + (size_t)nxt.pm * tstep : cA; const char* nB = has_next ? (const char*)g.Bt + (size_t)nxt.pn * tstep : cB;
        for (int t = 0; t < nt; t += 2) {
            const bool last = (t == nt - 2);
            const char* a1 = cA + (size_t)(t + 1) * kstep;
            const char* a2 = last ? nA : cA + (size_t)(t + 2) * kstep; const char* b2 = last ? nB : cB + (size_t)(t + 2) * kstep;
            const char* a3 = a2 + kstep; const char* b3 = b2 + kstep;
            if (last && has_next) S.a_ready(nxt);
            if constexpr (SP2) {
            PG8_LDB(B0, 0, 0); PG8_LDB(B1, 0, 1); PG8_SCHED; PG8_LDA(At, 0, 0); PG8_STAGE(PG8_SA(1, 1), a1 + hstep, voffA);
            PG8_WAIT_V(8); PG8_WAIT_L(0); PG8_BAR; PG8_MMA(0, 0, At, B0); PG8_MMA(0, 1, At, B1); PG8_BAR; PG8_SCHED;
            PG8_LDA(At, 0, 1); PG8_STAGE(PG8_SB(0, 0), b2, voffB); PG8_STAGE(PG8_SB(0, 1), b2 + hstep, voffB); PG8_STAGE(PG8_SA(0, 0), a2, voffA);
            PG8_WAIT_V(8); PG8_WAIT_L(0); PG8_BAR; PG8_MMA(1, 0, At, B0); PG8_MMA(1, 1, At, B1); PG8_BAR; PG8_SCHED;
            PG8_LDB(B0, 1, 0); PG8_LDB(B1, 1, 1); PG8_SCHED; PG8_LDA(At, 1, 0); PG8_STAGE(PG8_SA(0, 1), a2 + hstep, voffA);
            PG8_WAIT_V(8); PG8_WAIT_L(0); PG8_BAR; PG8_MMA(0, 0, At, B0); PG8_MMA(0, 1, At, B1); PG8_BAR; PG8_SCHED;
            PG8_LDA(At, 1, 1); PG8_STAGE(PG8_SB(1, 0), b3, voffB); PG8_STAGE(PG8_SB(1, 1), b3 + hstep, voffB); PG8_STAGE(PG8_SA(1, 0), a3, voffA);
            PG8_WAIT_V(8); PG8_WAIT_L(0); PG8_BAR; PG8_MMA(1, 0, At, B0); PG8_MMA(1, 1, At, B1); PG8_BAR; PG8_SCHED;
            } else {
            PG8_LDB(B0, 0, 0); PG8_SCHED; PG8_LDA(At, 0, 0); PG8_STAGE(PG8_SA(1, 1), a1 + hstep, voffA);
            PG8_WAIT_L(8); PG8_BAR; PG8_WAIT_L(0); PG8_MMA(0, 0, At, B0); PG8_BAR; PG8_SCHED;
            PG8_LDB(B1, 0, 1); PG8_STAGE(PG8_SB(0, 0), b2, voffB);
            PG8_BAR; PG8_WAIT_L(0); PG8_MMA(0, 1, At, B1); PG8_BAR;
            PG8_LDA(At, 0, 1); PG8_STAGE(PG8_SA(0, 0), a2, voffA);
            PG8_BAR; PG8_WAIT_L(0); PG8_MMA(1, 0, At, B0); PG8_BAR; PG8_SCHED;
            PG8_STAGE(PG8_SB(0, 1), b2 + hstep, voffB);
            PG8_WAIT_V(6); PG8_BAR; PG8_MMA(1, 1, At, B1); PG8_BAR;
            PG8_LDB(B0, 1, 0); PG8_SCHED; PG8_LDA(At, 1, 0); PG8_STAGE(PG8_SA(0, 1), a2 + hstep, voffA);
            PG8_WAIT_L(8); PG8_BAR; PG8_WAIT_L(0); PG8_MMA(0, 0, At, B0); PG8_BAR; PG8_SCHED;
            PG8_LDB(B1, 1, 1); PG8_STAGE(PG8_SB(1, 0), b3, voffB);
            PG8_BAR; PG8_WAIT_L(0); PG8_MMA(0, 1, At, B1); PG8_BAR;
            PG8_LDA(At, 1, 1); PG8_STAGE(PG8_SA(1, 0), a3, voffA);
            PG8_BAR; PG8_WAIT_L(0); PG8_MMA(1, 0, At, B0); PG8_BAR; PG8_SCHED;
            PG8_STAGE(PG8_SB(1, 1), b3 + hstep, voffB);
            PG8_WAIT_V(6); PG8_BAR; PG8_MMA(1, 1, At, B1); PG8_BAR;
            }
        }
        if constexpr (ALIGN_EPI) { if (wr == 0) PG8_BAR; }
        if constexpr (!Epi::AFTER_DRAIN) { E(acc, cur, wr, wc, fr, fq); S.done(cur); }
        if (!has_next) break;
#pragma unroll
        for (int a = 0; a < 2; ++a)
#pragma unroll
            for (int b = 0; b < 2; ++b)
#pragma unroll
                for (int m = 0; m < 4; ++m)
#pragma unroll
                    for (int n = 0; n < 2; ++n) acc[a][b][m][n] = (f32x4){0.f, 0.f, 0.f, 0.f};
        cur = nxt; cA = nA; cB = nB; ++ui;
        if constexpr (ALIGN_EPI) { if (wr == 1) PG8_BAR; }
    }
    PG8_WAIT_V(0);
    if constexpr (!ALIGN_EPI) { if (wr == 0) PG8_BAR; }
    PG8_BAR;
    if constexpr (Epi::AFTER_DRAIN) { E.fused(acc, cur, wr, wc, fr, fq, lds, wid, lane); S.done(cur); }
#undef PG8_SA
#undef PG8_SB
#undef PG8_STAGE
#undef PG8_LDA
#undef PG8_LDB
#undef PG8_MMA
#undef PG8_WAIT_V
#undef PG8_WAIT_L
#undef PG8_BAR
#undef PG8_SCHED
}
}
namespace pg8 {
struct EpiStoreBf16 {
    static constexpr bool PERM = true, AFTER_DRAIN = false;
    bf16_t* O; int ldc; const float* bias; int m_real, n_real;
    __device__ __forceinline__ void operator()(const f32x4 (&acc)[2][2][4][2], const Unit& u, int wr, int wc, int fr, int fq) const {
        const int row0 = u.pm * BM + wr * 64 + fr, col0 = u.pn * BM + wc * 32 + 8 * fq;
#pragma unroll
        for (int bj = 0; bj < 2; ++bj) {
            const int col = col0 + bj * HALF;
            if (col >= n_real) continue;
            f32x4 b0 = (f32x4){0.f, 0.f, 0.f, 0.f}, b1 = b0;
            if (bias) { b0 = *(const f32x4*)(bias + col); b1 = *(const f32x4*)(bias + col + 4); }
#pragma unroll
            for (int ai = 0; ai < 2; ++ai)
#pragma unroll
                for (int m = 0; m < 4; ++m) {
                    const int row = row0 + ai * HALF + m * 16;
                    if (row >= m_real) continue;
                    const f32x4 v0 = acc[ai][bj][m][0] + b0, v1 = acc[ai][bj][m][1] + b1;
                    u32x4 w; w.x = cvt_pk_bf16(v0[0], v0[1]); w.y = cvt_pk_bf16(v0[2], v0[3]); w.z = cvt_pk_bf16(v1[0], v1[1]); w.w = cvt_pk_bf16(v1[2], v1[3]);
                    *(u32x4*)(O + (size_t)row * ldc + col) = w;
                }
        }
    }
};
struct EpiStoreF32 {
    static constexpr bool PERM = false, AFTER_DRAIN = false;
    float* O; int ldc; const float* bias; int m_real, n_real;
    __device__ __forceinline__ void operator()(const f32x4 (&acc)[2][2][4][2], const Unit& u, int wr, int wc, int fr, int fq) const {
        const int row0 = u.pm * BM + wr * 64 + fr, col0 = u.pn * BM + wc * 32 + 4 * fq;
#pragma unroll
        for (int bj = 0; bj < 2; ++bj)
#pragma unroll
            for (int n = 0; n < 2; ++n) {
                const int col = col0 + bj * HALF + n * 16;
                if (col >= n_real) continue;
                const f32x4 bv = bias ? *(const f32x4*)(bias + col) : (f32x4){0.f, 0.f, 0.f, 0.f};
#pragma unroll
                for (int ai = 0; ai < 2; ++ai)
#pragma unroll
                    for (int m = 0; m < 4; ++m) {
                        const int row = row0 + ai * HALF + m * 16;
                        if (row >= m_real) continue;
                        *(f32x4*)(O + (size_t)row * ldc + col) = acc[ai][bj][m][n] + bv;
                    }
            }
    }
};
}
namespace {
#define GAS __attribute__((address_space(1)))
#define LAS __attribute__((address_space(3)))
typedef unsigned short bf16;
typedef float f32x4 __attribute__((ext_vector_type(4)));
typedef unsigned v4u __attribute__((ext_vector_type(4)));
typedef unsigned v2u __attribute__((ext_vector_type(2)));

constexpr int D = 1024, NB = 4, SEQ = 4096, NP = NB * SEQ, NS = 128, NT = NP + NS, MP = 16640;
constexpr int ABN = 3080, ABNP = 3328;
constexpr int C_QKV = 0, C_Z = 1536, C_A = 2048, C_B = 2052, C_XR = 2056, C_GATE = 2568;
constexpr int CN = 1536;
constexpr float ALPHA = 1.4142135623730951f;
constexpr float LN_EPS = 1e-5f;
constexpr int NTH = 512, NWAVES = 8;
constexpr int RING_BYTES = 131072, MISC_OFF = RING_BYTES + 320, LDS_BYTES = 147456;

__device__ __forceinline__ float bf2f(bf16 v) { return __uint_as_float((unsigned)v << 16); }
__device__ __forceinline__ unsigned f2bf(float f) { unsigned u = __float_as_uint(f); return (u + 0x7fffu + ((u >> 16) & 1u)) >> 16; }
__device__ __forceinline__ unsigned pk2(float lo, float hi) { return f2bf(lo) | (f2bf(hi) << 16); }
__device__ __forceinline__ float sigmoidf_(float x) { return 1.0f / (1.0f + expf(-x)); }
__device__ __forceinline__ float softplusf_(float x) { return fmaxf(x, 0.f) + log1pf(expf(-fabsf(x))); }
__device__ __forceinline__ float siluf_(float x) { return x / (1.0f + expf(-x)); }
__device__ __forceinline__ float geluf_(float x) { return 0.5f * x * (1.0f + tanhf(0.7978845608028654f * (x + 0.044715f * x * x * x))); }
__device__ __forceinline__ float wave_sum(float v) {
#pragma unroll
    for (int o = 32; o > 0; o >>= 1) v += __shfl_xor(v, o);
    return v;
}
__device__ __forceinline__ float wave_max(float v) {
#pragma unroll
    for (int o = 32; o > 0; o >>= 1) v = fmaxf(v, __shfl_xor(v, o));
    return v;
}

__device__ __forceinline__ void p0_transpose_item(const float* __restrict__ W, int K, int N, bf16* __restrict__ WT, float* scr, int item, int lane) {
    const int nblk = (N + 31) / 32, kb = item / nblk, nb = item % nblk, k0 = 64 * kb, n0 = 32 * nb;
#pragma unroll 8
    for (int i = 0; i < 32; ++i) { const int kk = 2 * i + (lane >> 5), n = n0 + (lane & 31); scr[kk * 33 + (lane & 31)] = n < N ? W[(size_t)(k0 + kk) * N + n] : 0.f; }
    asm volatile("s_waitcnt lgkmcnt(0)" ::: "memory");
    const int c = lane & 7;
#pragma unroll
    for (int j = 0; j < 4; ++j) { const int n = (lane >> 3) + 8 * j; const float* s = scr + (8 * c) * 33 + n;
        v4u o; o.x = pk2(s[0 * 33], s[1 * 33]); o.y = pk2(s[2 * 33], s[3 * 33]); o.z = pk2(s[4 * 33], s[5 * 33]); o.w = pk2(s[6 * 33], s[7 * 33]);
        *(v4u*)(WT + (size_t)(n0 + n) * K + k0 + 8 * c) = o; }
    asm volatile("s_waitcnt lgkmcnt(0)" ::: "memory");
}
__device__ __forceinline__ void row_to_bf16(const float* __restrict__ xrow, bf16* __restrict__ orow, int lane) {
#pragma unroll
    for (int j = 0; j < 4; ++j) {
        f32x4 v = (f32x4){0.f, 0.f, 0.f, 0.f};
        if (xrow) v = ((const f32x4*)xrow)[lane + 64 * j];
        v2u o; o.x = pk2(v.x, v.y); o.y = pk2(v.z, v.w);
        ((v2u*)orow)[lane + 64 * j] = o;
    }
}

struct AbPrepArgs {
    const bf16* PROJ; const float* st_gdn_conv; const float* st_lru_conv;
    const float* gdn_conv_w; const float* a_log; const float* dt_bias;
    const float* lru_conv_w; const float* lru_conv_b; const float* w_r; const float* b_r; const float* w_i; const float* b_i; const float* lam;
    float* QKV; float* G; float* BETA; float* LA; float* LB;
    float* p_gdn_conv; float* p_lru_conv; float* s_gdn_conv; float* s_lru_conv;
};
__device__ __forceinline__ void ab_prep(const AbPrepArgs& a, int t, float* smem) {
    const int tid = threadIdx.x, lane = tid & 63, wid = tid >> 6;
    const bool samp = t >= NP; const int sb = t - NP, pos = t % SEQ, b = t / SEQ;
    float* sq = smem;
    float* sx = smem + 1536;
    float* scl = smem + 2048;
    const bf16* prow = a.PROJ + (size_t)t * ABN;
    for (int c = tid; c < 1536; c += NTH) {
        float acc = 0.f;
#pragma unroll
        for (int i = 0; i < 4; ++i) {
            float xv;
            if (i == 3) xv = bf2f(prow[C_QKV + c]);
            else if (samp) xv = a.st_gdn_conv[((size_t)sb * 3 + i) * 1536 + c];
            else xv = (pos - 3 + i >= 0) ? bf2f(a.PROJ[(size_t)(t - 3 + i) * ABN + C_QKV + c]) : 0.f;
            acc += a.gdn_conv_w[i * 1536 + c] * xv;
        }
        sq[c] = siluf_(acc);
    }
    {
        const int c = tid;
        float acc = a.lru_conv_b[c];
#pragma unroll
        for (int i = 0; i < 4; ++i) {
            float xv;
            if (i == 3) xv = bf2f(prow[C_XR + c]);
            else if (samp) xv = a.st_lru_conv[((size_t)sb * 3 + i) * 512 + c];
            else xv = (pos - 3 + i >= 0) ? bf2f(a.PROJ[(size_t)(t - 3 + i) * ABN + C_XR + c]) : 0.f;
            acc += a.lru_conv_w[i * 512 + c] * xv;
        }
        sx[c] = acc;
    }
    __syncthreads();
    {
        const int grp = wid;
        const float v0 = sq[grp * 128 + lane], v1 = sq[grp * 128 + 64 + lane];
        const float s = wave_sum(v0 * v0 + v1 * v1);
        if (lane == 0) scl[grp] = rsqrtf(s + 1e-6f) * (grp < 4 ? 0.08838834764831845f : 1.0f);
    }
    __syncthreads();
    for (int c = tid; c < 1536; c += NTH) a.QKV[(size_t)t * 1536 + c] = (c < 1024) ? sq[c] * scl[c >> 7] : sq[c];
    if (tid < 4) {
        const float a_raw = bf2f(prow[C_A + tid]), b_raw = bf2f(prow[C_B + tid]);
        a.G[(size_t)t * 4 + tid] = -expf(a.a_log[tid]) * softplusf_(a_raw + a.dt_bias[tid]);
        a.BETA[(size_t)t * 4 + tid] = sigmoidf_(b_raw);
    }
    if (!samp) {
        if (pos >= SEQ - 3) {
            const int row = pos - (SEQ - 3);
            for (int c = tid; c < 1536; c += NTH) a.p_gdn_conv[((size_t)b * 3 + row) * 1536 + c] = bf2f(prow[C_QKV + c]);
            a.p_lru_conv[((size_t)b * 3 + row) * 512 + tid] = bf2f(prow[C_XR + tid]);
        }
    } else {
        for (int c = tid; c < 1536; c += NTH) {
            a.s_gdn_conv[((size_t)sb * 3 + 0) * 1536 + c] = a.st_gdn_conv[((size_t)sb * 3 + 1) * 1536 + c];
            a.s_gdn_conv[((size_t)sb * 3 + 1) * 1536 + c] = a.st_gdn_conv[((size_t)sb * 3 + 2) * 1536 + c];
            a.s_gdn_conv[((size_t)sb * 3 + 2) * 1536 + c] = bf2f(prow[C_QKV + c]);
        }
        {
            const int c = tid;
            a.s_lru_conv[((size_t)sb * 3 + 0) * 512 + c] = a.st_lru_conv[((size_t)sb * 3 + 1) * 512 + c];
            a.s_lru_conv[((size_t)sb * 3 + 1) * 512 + c] = a.st_lru_conv[((size_t)sb * 3 + 2) * 512 + c];
            a.s_lru_conv[((size_t)sb * 3 + 2) * 512 + c] = bf2f(prow[C_XR + c]);
        }
    }
    {
        const int c = tid, n = c >> 6, d = c & 63;
        float r = a.b_r[c], ii = a.b_i[c];
#pragma unroll 4
        for (int cc = 0; cc < 64; ++cc) {
            const float xv = sx[n * 64 + cc];
            r += xv * a.w_r[((size_t)n * 64 + cc) * 64 + d];
            ii += xv * a.w_i[((size_t)n * 64 + cc) * 64 + d];
        }
        r = sigmoidf_(r); ii = sigmoidf_(ii);
        const float log_a = -8.0f * r * softplusf_(-a.lam[c]);
        a.LA[(size_t)t * 512 + c] = expf(log_a);
        a.LB[(size_t)t * 512 + c] = sqrtf(-expm1f(2.0f * log_a)) * (ii * sx[c]);
    }
}

__device__ __forceinline__ void gdn_scan(const float* __restrict__ QKV, const float* __restrict__ G, const float* __restrict__ BETA,
                                         const float* __restrict__ S0, float* __restrict__ O, float* __restrict__ Sout, int tok_base, int T,
                                         int sl, int h, int sq, float* smem) {
    const int tid = threadIdx.x, dvl = tid & 31, kg = tid >> 5;
    const int dv = sl * 32 + dvl;
    float (*red1)[32] = (float (*)[32])smem;
    float (*red2)[32] = (float (*)[32])(smem + 512);
    float S[8];
#pragma unroll
    for (int i = 0; i < 8; ++i) S[i] = S0 ? S0[(((size_t)sq * 4 + h) * 128 + kg * 8 + i) * 128 + dv] : 0.f;
    float kk[8], qq[8], vv, g, be;
    {
        const size_t tok = (size_t)tok_base + (size_t)sq * T;
        const float* row = QKV + tok * 1536;
#pragma unroll
        for (int i = 0; i < 8; ++i) { kk[i] = row[512 + h * 128 + kg * 8 + i]; qq[i] = row[h * 128 + kg * 8 + i]; }
        vv = row[1024 + h * 128 + dv]; g = G[tok * 4 + h]; be = BETA[tok * 4 + h];
    }
    for (int t = 0; t < T; ++t) {
        const size_t tok = (size_t)tok_base + (size_t)sq * T + t;
        float nk[8], nq[8], nv = 0.f, ng = 0.f, nb = 0.f;
        if (t + 1 < T) {
            const float* row = QKV + (tok + 1) * 1536;
#pragma unroll
            for (int i = 0; i < 8; ++i) { nk[i] = row[512 + h * 128 + kg * 8 + i]; nq[i] = row[h * 128 + kg * 8 + i]; }
            nv = row[1024 + h * 128 + dv]; ng = G[(tok + 1) * 4 + h]; nb = BETA[(tok + 1) * 4 + h];
        } else {
#pragma unroll
            for (int i = 0; i < 8; ++i) { nk[i] = 0.f; nq[i] = 0.f; }
        }
        const float al = expf(g);
        float p = 0.f;
#pragma unroll
        for (int i = 0; i < 8; ++i) { S[i] *= al; p += S[i] * kk[i]; }
        red1[kg][dvl] = p;
        __syncthreads();
        float ks = 0.f;
#pragma unroll
        for (int j = 0; j < 16; ++j) ks += red1[j][dvl];
        const float vn = be * (vv - ks);
        float o = 0.f;
#pragma unroll
        for (int i = 0; i < 8; ++i) { S[i] += kk[i] * vn; o += S[i] * qq[i]; }
        red2[kg][dvl] = o;
        __syncthreads();
        if (kg == 0) {
            float os = 0.f;
#pragma unroll
            for (int j = 0; j < 16; ++j) os += red2[j][dvl];
            O[tok * 512 + h * 128 + dv] = os;
        }
#pragma unroll
        for (int i = 0; i < 8; ++i) { kk[i] = nk[i]; qq[i] = nq[i]; }
        vv = nv; g = ng; be = nb;
    }
#pragma unroll
    for (int i = 0; i < 8; ++i) Sout[(((size_t)sq * 4 + h) * 128 + kg * 8 + i) * 128 + dv] = S[i];
}

__device__ __forceinline__ void lru_scan(const float* __restrict__ LA, float* __restrict__ LB, const float* __restrict__ h0,
                                         float* __restrict__ hlast, int tok_base, int T, int nseq, int bx) {
    const int idx = bx * NTH + threadIdx.x;
    if (idx >= nseq * 512) return;
    const int sq = idx / 512, c = idx % 512;
    float h = h0 ? h0[(size_t)sq * 512 + c] : 0.f;
    const size_t base = ((size_t)tok_base + (size_t)sq * T) * 512 + c;
#pragma unroll 8
    for (int t = 0; t < T; ++t) {
        const size_t o = base + (size_t)t * 512;
        h = LA[o] * h + LB[o];
        LB[o] = h;
    }
    hlast[(size_t)sq * 512 + c] = h;
}

__device__ __forceinline__ void ab_mix(const bf16* __restrict__ PROJ, const float* __restrict__ O, const float* __restrict__ H, const float* __restrict__ P, const float* __restrict__ CIN,
                                       const float* __restrict__ norm_w, bf16* __restrict__ MIX, int vb) {
    const int tid = threadIdx.x & 255, lane = tid & 63, wid = tid >> 6, t = vb * 2 + (threadIdx.x >> 8);
    const bf16* prow = PROJ + (size_t)t * ABN;
    {
        const int h = wid;
        const float o0 = O[(size_t)t * 512 + h * 128 + lane], o1 = O[(size_t)t * 512 + h * 128 + 64 + lane];
        const float ms = wave_sum(o0 * o0 + o1 * o1) * (1.0f / 128.0f);
        const float sc = rsqrtf(ms + 1e-6f);
        MIX[(size_t)t * 1024 + h * 128 + lane] = (bf16)f2bf(o0 * sc * norm_w[lane] * siluf_(bf2f(prow[C_Z + h * 128 + lane])));
        MIX[(size_t)t * 1024 + h * 128 + 64 + lane] = (bf16)f2bf(o1 * sc * norm_w[64 + lane] * siluf_(bf2f(prow[C_Z + h * 128 + 64 + lane])));
    }
    for (int c = tid; c < 512; c += 256) {
        float hv = H[(size_t)t * 512 + c];
        if (t < NP) hv += P[(size_t)t * 512 + c] * CIN[(size_t)(t >> 6) * 512 + c];
        MIX[(size_t)t * 1024 + 512 + c] = (bf16)f2bf(geluf_(bf2f(prow[C_GATE + c])) * hv);
    }
}

__device__ __forceinline__ void ln_res_w(const float* __restrict__ xrow, const float* __restrict__ yrow, const float* __restrict__ g, const float* __restrict__ bta,
                                         float* __restrict__ orow, bf16* __restrict__ obrow, int lane) {
    f32x4 v[4]; float s = 0.f;
#pragma unroll
    for (int j = 0; j < 4; ++j) { const f32x4 x4 = ((const f32x4*)xrow)[lane + 64 * j], y4 = ((const f32x4*)yrow)[lane + 64 * j]; v[j] = x4 * ALPHA + y4; s += (v[j].x + v[j].y) + (v[j].z + v[j].w); }
    const float mean = wave_sum(s) * (1.0f / 1024.0f); float q = 0.f;
#pragma unroll
    for (int j = 0; j < 4; ++j) { v[j] = v[j] - mean; q += (v[j].x * v[j].x + v[j].y * v[j].y) + (v[j].z * v[j].z + v[j].w * v[j].w); }
    const float rs = rsqrtf(wave_sum(q) * (1.0f / 1024.0f) + LN_EPS);
#pragma unroll
    for (int j = 0; j < 4; ++j) {
        const f32x4 g4 = ((const f32x4*)g)[lane + 64 * j], b4 = ((const f32x4*)bta)[lane + 64 * j];
        const f32x4 o = v[j] * rs * g4 + b4;
        ((f32x4*)orow)[lane + 64 * j] = o;
        v2u ob; ob.x = pk2(o.x, o.y); ob.y = pk2(o.z, o.w);
        ((v2u*)obrow)[lane + 64 * j] = ob;
    }
}

__device__ __forceinline__ void peer_topk(const bf16* __restrict__ Q, const float* __restrict__ keys, int* __restrict__ EXP, float* __restrict__ GATE,
                                          int tg, int h, float* smem) {
    const int tid = threadIdx.x, cn = tid & 255, c = cn >> 7, n = cn & 127, th = tid >> 8;
    float (*sq)[256] = (float (*)[256])smem;
    float (*ss)[257] = (float (*)[257])(smem + 32 * 256);
    float (*tvs)[2][16] = (float (*)[2][16])(smem + 32 * 256 + 32 * 257 + 32);
    int (*tis)[2][16] = (int (*)[2][16])(smem + 32 * 256 + 32 * 257 + 32 + 1024);
    for (int i = tid; i < 32 * 256; i += NTH) {
        const int tk = i >> 8, col = i & 255;
        sq[tk][col] = bf2f(Q[(size_t)(tg * 32 + tk) * 2048 + h * 256 + col]);
    }
    __syncthreads();
    float acc[16];
#pragma unroll
    for (int i = 0; i < 16; ++i) acc[i] = 0.f;
    const float* krow = keys + (((size_t)h * 2 + c) * 128 + n) * 128;
    for (int d4 = 0; d4 < 32; ++d4) {
        const float4 kv = *(const float4*)(krow + d4 * 4);
#pragma unroll
        for (int tk = 0; tk < 16; ++tk) {
            const float4 qv = *(const float4*)&sq[th * 16 + tk][c * 128 + d4 * 4];
            acc[tk] += qv.x * kv.x + qv.y * kv.y + qv.z * kv.z + qv.w * kv.w;
        }
    }
#pragma unroll
    for (int tk = 0; tk < 16; ++tk) ss[th * 16 + tk][cn] = acc[tk];
    __syncthreads();
    if (tid < 64) {
        const int tk = tid >> 1, cc = tid & 1;
        float tv[16]; int ti[16];
#pragma unroll
        for (int j = 0; j < 16; ++j) { tv[j] = -INFINITY; ti[j] = 0; }
        for (int nn = 0; nn < 128; ++nn) {
            float x = ss[tk][cc * 128 + nn]; int xi = nn;
#pragma unroll
            for (int j = 0; j < 16; ++j) {
                const bool gt = x > tv[j];
                const float tf = tv[j]; const int tj = ti[j];
                tv[j] = gt ? x : tf; ti[j] = gt ? xi : tj;
                x = gt ? tf : x; xi = gt ? tj : xi;
            }
        }
#pragma unroll
        for (int j = 0; j < 16; ++j) { tvs[tk][cc][j] = tv[j]; tis[tk][cc][j] = ti[j]; }
    }
    __syncthreads();
    if (tid < 32) {
        const int tk = tid;
        float bv[16]; int bi[16];
#pragma unroll
        for (int j = 0; j < 16; ++j) { bv[j] = -INFINITY; bi[j] = 0; }
        for (int i = 0; i < 16; ++i)
            for (int jj = 0; jj < 16; ++jj) {
                float x = tvs[tk][0][i] + tvs[tk][1][jj]; int xi = tis[tk][0][i] * 128 + tis[tk][1][jj];
#pragma unroll
                for (int j = 0; j < 16; ++j) {
                    const bool gt = x > bv[j];
                    const float tf = bv[j]; const int tj = bi[j];
                    bv[j] = gt ? x : tf; bi[j] = gt ? xi : tj;
                    x = gt ? tf : x; xi = gt ? tj : xi;
                }
            }
        float e[16], sum = 0.f;
#pragma unroll
        for (int j = 0; j < 16; ++j) { e[j] = expf(bv[j] - bv[0]); sum += e[j]; }
        const float inv = 1.0f / sum;
        const size_t o = (size_t)(tg * 32 + tk) * 128 + h * 16;
#pragma unroll
        for (int j = 0; j < 16; ++j) { EXP[o + j] = bi[j]; GATE[o + j] = e[j] * inv; }
    }
}

__device__ __forceinline__ void peer_expert(const float* __restrict__ X, const int* __restrict__ EXP, const float* __restrict__ GATE,
                                            const float* __restrict__ U, const float* __restrict__ V,
                                            const float* __restrict__ g, const float* __restrict__ bta, float* __restrict__ out, bf16* __restrict__ outb, int t, float* smem) {
    const int tid = threadIdx.x, lane = tid & 63, wid = tid >> 6;
    float (*accs)[1024] = (float (*)[1024])smem;
    float* sred = smem + 8192;
    const float4* xr = (const float4*)(X + (size_t)t * D);
    float4 xv[4];
#pragma unroll
    for (int j = 0; j < 4; ++j) xv[j] = xr[lane + 64 * j];
    float4 acc[4];
#pragma unroll
    for (int j = 0; j < 4; ++j) acc[j] = make_float4(0.f, 0.f, 0.f, 0.f);
    for (int e = 0; e < 16; ++e) {
        const int id = EXP[(size_t)t * 128 + wid * 16 + e];
        const float gt = GATE[(size_t)t * 128 + wid * 16 + e];
        const float4* ur = (const float4*)(U + (size_t)id * D);
        const float4* vr = (const float4*)(V + (size_t)id * D);
        float4 uv[4], vv[4];
#pragma unroll
        for (int j = 0; j < 4; ++j) { uv[j] = ur[lane + 64 * j]; vv[j] = vr[lane + 64 * j]; }
        float dot = 0.f;
#pragma unroll
        for (int j = 0; j < 4; ++j) dot += uv[j].x * xv[j].x + uv[j].y * xv[j].y + uv[j].z * xv[j].z + uv[j].w * xv[j].w;
        dot = wave_sum(dot);
        const float cf = gt * geluf_(dot);
#pragma unroll
        for (int j = 0; j < 4; ++j) { acc[j].x += cf * vv[j].x; acc[j].y += cf * vv[j].y; acc[j].z += cf * vv[j].z; acc[j].w += cf * vv[j].w; }
    }
#pragma unroll
    for (int j = 0; j < 4; ++j) *(float4*)&accs[wid][(lane + 64 * j) * 4] = acc[j];
    __syncthreads();
    float v[2];
#pragma unroll
    for (int i = 0; i < 2; ++i) {
        const int c = tid * 2 + i;
        float s = 0.f;
#pragma unroll
        for (int w = 0; w < 8; ++w) s += accs[w][c];
        v[i] = ALPHA * X[(size_t)t * D + c] + s;
    }
    float s = wave_sum(v[0] + v[1]);
    if (lane == 0) sred[wid] = s;
    __syncthreads();
    float mean = 0.f;
#pragma unroll
    for (int w = 0; w < 8; ++w) mean += sred[w];
    mean *= (1.0f / 1024.0f);
    __syncthreads();
    const float d0 = v[0] - mean, d1 = v[1] - mean;
    float q = wave_sum(d0 * d0 + d1 * d1);
    if (lane == 0) sred[wid] = q;
    __syncthreads();
    float var = 0.f;
#pragma unroll
    for (int w = 0; w < 8; ++w) var += sred[w];
    const float rs = rsqrtf(var * (1.0f / 1024.0f) + LN_EPS);
    const float o0 = d0 * rs * g[tid * 2] + bta[tid * 2], o1 = d1 * rs * g[tid * 2 + 1] + bta[tid * 2 + 1];
    *(float2*)(out + (size_t)t * D + tid * 2) = make_float2(o0, o1);
    if (outb) *(unsigned*)(outb + (size_t)t * D + tid * 2) = pk2(o0, o1);
}


typedef __bf16 bf16x2_t __attribute__((ext_vector_type(2)));
__device__ __forceinline__ float dot2bf(unsigned w, unsigned x, float acc) { return __builtin_amdgcn_fdot2_f32_bf16(__builtin_bit_cast(bf16x2_t, w), __builtin_bit_cast(bf16x2_t, x), acc, false); }
__device__ __forceinline__ float bflo(unsigned w) { return __uint_as_float(w << 16); }
__device__ __forceinline__ float bfhi(unsigned w) { return __uint_as_float(w & 0xffff0000u); }
typedef float f32x2_t __attribute__((ext_vector_type(2)));
__device__ __forceinline__ void row_to_fp8(const float* __restrict__ xrow, unsigned char* __restrict__ orow, float* __restrict__ scale, int lane) {
    f32x4 v[4]; float am = 0.f;
#pragma unroll
    for (int j = 0; j < 4; ++j) { v[j] = *(const f32x4*)(xrow + lane * 16 + j * 4); am = fmaxf(am, fmaxf(fmaxf(fabsf(v[j].x), fabsf(v[j].y)), fmaxf(fabsf(v[j].z), fabsf(v[j].w)))); }
    am = wave_max(am);
    const float s = am > 0.f ? am * (1.0f / 448.0f) : 1.0f, inv = 1.0f / s;
    v4u o;
    unsigned w;
    w = 0u; w = __builtin_amdgcn_cvt_pk_fp8_f32(v[0].x * inv, v[0].y * inv, w, false); w = __builtin_amdgcn_cvt_pk_fp8_f32(v[0].z * inv, v[0].w * inv, w, true); o.x = w;
    w = 0u; w = __builtin_amdgcn_cvt_pk_fp8_f32(v[1].x * inv, v[1].y * inv, w, false); w = __builtin_amdgcn_cvt_pk_fp8_f32(v[1].z * inv, v[1].w * inv, w, true); o.y = w;
    w = 0u; w = __builtin_amdgcn_cvt_pk_fp8_f32(v[2].x * inv, v[2].y * inv, w, false); w = __builtin_amdgcn_cvt_pk_fp8_f32(v[2].z * inv, v[2].w * inv, w, true); o.z = w;
    w = 0u; w = __builtin_amdgcn_cvt_pk_fp8_f32(v[3].x * inv, v[3].y * inv, w, false); w = __builtin_amdgcn_cvt_pk_fp8_f32(v[3].z * inv, v[3].w * inv, w, true); o.w = w;
    *(v4u*)(orow + lane * 16) = o;
    if (lane == 0) *scale = s;
}
#define PE_LOAD(UB, VB, grp) do { _Pragma("unroll") for (int i_ = 0; i_ < 4; ++i_) { const int e_ = (grp) * 4 + i_; \
        const int id_ = __builtin_amdgcn_readlane(e_ < 64 ? id0 : id1, e_ & 63); \
        const unsigned so_ = (unsigned)id_ * 1024u; \
        UB[i_] = __builtin_amdgcn_raw_buffer_load_b128(ursrc, voff, so_, 0); VB[i_] = __builtin_amdgcn_raw_buffer_load_b128(vrsrc, voff, so_, 0); } } while (0)
#define PE_DOT4(w, k) do { const f32x2_t l_ = __builtin_amdgcn_cvt_pk_f32_fp8((w), false), h_ = __builtin_amdgcn_cvt_pk_f32_fp8((w), true); \
        a_ += l_.x * xv[(k) * 4 + 0]; b_ += l_.y * xv[(k) * 4 + 1]; a_ += h_.x * xv[(k) * 4 + 2]; b_ += h_.y * xv[(k) * 4 + 3]; } while (0)
#define PE_AXPY4(w, k) do { const f32x2_t l_ = __builtin_amdgcn_cvt_pk_f32_fp8((w), false), h_ = __builtin_amdgcn_cvt_pk_f32_fp8((w), true); \
        acc[(k) * 4 + 0] += cf_ * l_.x; acc[(k) * 4 + 1] += cf_ * l_.y; acc[(k) * 4 + 2] += cf_ * h_.x; acc[(k) * 4 + 3] += cf_ * h_.y; } while (0)
#define PE_COMP(UB, VB, grp) do { float d_[4]; \
        _Pragma("unroll") for (int i_ = 0; i_ < 4; ++i_) { float a_ = 0.f, b_ = 0.f; PE_DOT4(UB[i_].x, 0); PE_DOT4(UB[i_].y, 1); PE_DOT4(UB[i_].z, 2); PE_DOT4(UB[i_].w, 3); d_[i_] = a_ + b_; } \
          \
        float s0_ = hi32 ? d_[2] : d_[0], t0_ = hi32 ? d_[0] : d_[2]; s0_ += __shfl_xor(t0_, 32); \
        float s1_ = hi32 ? d_[3] : d_[1], t1_ = hi32 ? d_[1] : d_[3]; s1_ += __shfl_xor(t1_, 32); \
        float r_ = hi16 ? s1_ : s0_, t2_ = hi16 ? s0_ : s1_; r_ += __shfl_xor(t2_, 16); \
        r_ += __shfl_xor(r_, 8); r_ += __shfl_xor(r_, 4); r_ += __shfl_xor(r_, 2); r_ += __shfl_xor(r_, 1); \
          \
        const int esel_ = (grp) * 4 + (lane >> 4); \
        const float su_ = __shfl(esel_ < 64 ? su0 : su1, esel_ & 63), gv_ = __shfl(esel_ < 64 ? gs0 : gs1, esel_ & 63); \
        const float cfl_ = geluf_(r_ * su_) * gv_; \
        _Pragma("unroll") for (int i_ = 0; i_ < 4; ++i_) { \
            const float cf_ = __uint_as_float(__builtin_amdgcn_readlane(__float_as_uint(cfl_), 16 * i_)); \
            PE_AXPY4(VB[i_].x, 0); PE_AXPY4(VB[i_].y, 1); PE_AXPY4(VB[i_].z, 2); PE_AXPY4(VB[i_].w, 3); } } while (0)
__device__ __forceinline__ void peer_expert_w(const float* __restrict__ xrow, const int* __restrict__ exr, const float* __restrict__ gar,
                                              const unsigned char* __restrict__ U, const unsigned char* __restrict__ V, const float* __restrict__ SU, const float* __restrict__ SV,
                                              const float* __restrict__ g, const float* __restrict__ bta, float* __restrict__ orow, bf16* __restrict__ obrow, int lane) {
    const bool hi32 = (lane & 32) != 0, hi16 = (lane & 16) != 0;
    const __amdgpu_buffer_rsrc_t ursrc = __builtin_amdgcn_make_buffer_rsrc((void*)U, 0, 16384 * 1024, 0x00020000);
    const __amdgpu_buffer_rsrc_t vrsrc = __builtin_amdgcn_make_buffer_rsrc((void*)V, 0, 16384 * 1024, 0x00020000);
    const int voff = lane * 16;
    float xv[16];
#pragma unroll
    for (int j = 0; j < 4; ++j) { const f32x4 t = *(const f32x4*)(xrow + lane * 16 + j * 4); xv[j * 4 + 0] = t.x; xv[j * 4 + 1] = t.y; xv[j * 4 + 2] = t.z; xv[j * 4 + 3] = t.w; }
    const int id0 = exr[lane], id1 = exr[64 + lane];
    const float su0 = SU[id0], su1 = SU[id1];
    const float gs0 = gar[lane] * SV[id0], gs1 = gar[64 + lane] * SV[id1];
    float acc[16];
#pragma unroll
    for (int i = 0; i < 16; ++i) acc[i] = 0.f;
    v4u ua[4], va[4], ub[4], vb[4];
    PE_LOAD(ua, va, 0);
#pragma unroll 1
    for (int grp = 0; grp < 32; grp += 2) {
        PE_LOAD(ub, vb, grp + 1);
        PE_COMP(ua, va, grp);
        if (grp + 2 < 32) PE_LOAD(ua, va, grp + 2);
        PE_COMP(ub, vb, grp + 1);
    }
    float v[16]; float s = 0.f;
#pragma unroll
    for (int i = 0; i < 16; ++i) { v[i] = ALPHA * xv[i] + acc[i]; s += v[i]; }
    const float mean = wave_sum(s) * (1.0f / 1024.0f); float q = 0.f;
#pragma unroll
    for (int i = 0; i < 16; ++i) { v[i] -= mean; q += v[i] * v[i]; }
    const float rs = rsqrtf(wave_sum(q) * (1.0f / 1024.0f) + LN_EPS);
    float o[16];
#pragma unroll
    for (int j = 0; j < 4; ++j) {
        const f32x4 g4 = *(const f32x4*)(g + lane * 16 + j * 4), b4 = *(const f32x4*)(bta + lane * 16 + j * 4);
        o[j * 4 + 0] = v[j * 4 + 0] * rs * g4.x + b4.x; o[j * 4 + 1] = v[j * 4 + 1] * rs * g4.y + b4.y; o[j * 4 + 2] = v[j * 4 + 2] * rs * g4.z + b4.z; o[j * 4 + 3] = v[j * 4 + 3] * rs * g4.w + b4.w;
        *(f32x4*)(orow + lane * 16 + j * 4) = (f32x4){o[j * 4 + 0], o[j * 4 + 1], o[j * 4 + 2], o[j * 4 + 3]};
    }
    if (obrow) {
        v4u w0, w1; w0.x = pk2(o[0], o[1]); w0.y = pk2(o[2], o[3]); w0.z = pk2(o[4], o[5]); w0.w = pk2(o[6], o[7]); w1.x = pk2(o[8], o[9]); w1.y = pk2(o[10], o[11]); w1.z = pk2(o[12], o[13]); w1.w = pk2(o[14], o[15]);
        *(v4u*)(obrow + lane * 16) = w0; *(v4u*)(obrow + lane * 16 + 8) = w1;
    }
}

__device__ __forceinline__ int t5_bucket(int n) {
    if (n < 16) return n;
    const int large = 16 + (int)(logf((float)n / 16.0f) / 2.0794415416798357f * 16.0f);
    return large < 31 ? large : 31;
}
__device__ __forceinline__ void swa_attn(const float* __restrict__ PC, const float* __restrict__ cache_k, const float* __restrict__ cache_v,
                                         const float* __restrict__ rel_bias, const float* __restrict__ sinks, bf16* __restrict__ ATT, int bx) {
    const int tid = threadIdx.x, lane = tid & 63, wid = tid >> 6;
    const int gw = bx * 8 + wid;
    const int t = gw >> 4, h = gw & 15, kvh = h >> 2;
    if (t >= NT) return;
    const bool samp = t >= NP; const int sb = t - NP, pos = t % SEQ;
    const float* qrow = PC + (size_t)t * CN + h * 64;
    float lg[2]; bool valid[2];
#pragma unroll
    for (int rr = 0; rr < 2; ++rr) {
        const int r = lane + 64 * rr;
        const float* krow;
        if (!samp) { valid[rr] = (pos - r) >= 0; krow = PC + (size_t)(valid[rr] ? t - r : t) * CN + 1024 + kvh * 64; }
        else { valid[rr] = true; krow = (r == 0) ? PC + (size_t)t * CN + 1024 + kvh * 64 : cache_k + (((size_t)sb * 128 + (128 - r)) * 4 + kvh) * 64; }
        float dot = 0.f;
#pragma unroll
        for (int d4 = 0; d4 < 16; ++d4) {
            const float4 kv = *(const float4*)(krow + d4 * 4);
            const float4 qv = *(const float4*)(qrow + d4 * 4);
            dot += qv.x * kv.x + qv.y * kv.y + qv.z * kv.z + qv.w * kv.w;
        }
        lg[rr] = valid[rr] ? dot * 0.125f + rel_bias[t5_bucket(r) * 16 + h] : -INFINITY;
    }
    const float sink = sinks[h];
    const float m = fmaxf(wave_max(fmaxf(lg[0], lg[1])), sink);
    float p[2];
#pragma unroll
    for (int rr = 0; rr < 2; ++rr) p[rr] = valid[rr] ? expf(lg[rr] - m) : 0.f;
    const float den = wave_sum(p[0] + p[1]) + expf(sink - m);
    const float inv = 1.0f / den;
    float o = 0.f;
#pragma unroll
    for (int rr = 0; rr < 2; ++rr)
        for (int l2 = 0; l2 < 64; ++l2) {
            const int r = l2 + 64 * rr;
            const float pj = __shfl(p[rr], l2);
            if (pj != 0.f) {
                const float* vrow;
                if (!samp) vrow = PC + (size_t)(t - r) * CN + 1280 + kvh * 64;
                else vrow = (r == 0) ? PC + (size_t)t * CN + 1280 + kvh * 64 : cache_v + (((size_t)sb * 128 + (128 - r)) * 4 + kvh) * 64;
                o += pj * vrow[lane];
            }
        }
    ATT[(size_t)t * D + h * 64 + lane] = (bf16)f2bf(o * inv);
}

__device__ __forceinline__ void swa_kv_out(const float* __restrict__ PC, const float* __restrict__ cache_k, const float* __restrict__ cache_v,
                                           float* __restrict__ pk, float* __restrict__ pv, float* __restrict__ sk, float* __restrict__ sv, int vb) {
    const int c = threadIdx.x & 255, row = vb * 2 + (threadIdx.x >> 8);
    if (row < NB * 128) {
        const int b = row >> 7, i = row & 127;
        const float* src = PC + (size_t)(b * SEQ + SEQ - 128 + i) * CN;
        pk[(size_t)row * 256 + c] = src[1024 + c];
        pv[(size_t)row * 256 + c] = src[1280 + c];
    } else {
        const int r2 = row - NB * 128, sb = r2 >> 7, i = r2 & 127;
        if (i < 127) {
            sk[(size_t)r2 * 256 + c] = cache_k[((size_t)sb * 128 + i + 1) * 256 + c];
            sv[(size_t)r2 * 256 + c] = cache_v[((size_t)sb * 128 + i + 1) * 256 + c];
        } else {
            const float* src = PC + (size_t)(NP + sb) * CN;
            sk[(size_t)r2 * 256 + c] = src[1024 + c];
            sv[(size_t)r2 * 256 + c] = src[1280 + c];
        }
    }
}
#define XB_TMO      128
#define XB_XCNT(j)  (256  + 64 * (j))
#define XB_XSUB(j)  (1280 + 64 * (j))
#define XB_XGEN(j)  (2304 + 64 * (j))
#define XB_TOP      3328
#define XB_TOPGEN   3392
#define XCD_BAR_WORDS 3456
#define XB_SPIN_CAP (1u << 18)

__device__ __forceinline__ unsigned xb_ld(unsigned* p)              { return __hip_atomic_load(p, __ATOMIC_RELAXED, __HIP_MEMORY_SCOPE_AGENT); }
__device__ __forceinline__ unsigned xb_add(unsigned* p, unsigned v) { return __hip_atomic_fetch_add(p, v, __ATOMIC_RELAXED, __HIP_MEMORY_SCOPE_AGENT); }
__device__ __forceinline__ unsigned xb_xcc_id() { return (unsigned)__builtin_amdgcn_s_getreg((3 << 11) | 20) & 0xFu; }
#define XB_SPIN(cond, bar) do { unsigned _sp = 0; while (cond) { __builtin_amdgcn_s_sleep(1); \
    if ((++_sp & 255u) == 0u) { if (xb_ld(&(bar)[XB_TMO])) break; if (_sp > XB_SPIN_CAP) { atomicAdd(&(bar)[XB_TMO], 1u); break; } } } } while (0)

struct XcdBarrier {
    unsigned* bar; unsigned x;
    volatile LAS unsigned* st;
};

__device__ __forceinline__ XcdBarrier xcd_barrier_post(unsigned* bar, volatile LAS unsigned* st) {
    XcdBarrier b; b.bar = bar; b.x = xb_xcc_id(); b.st = st;
    if (threadIdx.x == 0) (void)xb_add(&bar[XB_XCNT(b.x)], 1u);
    return b;
}
__device__ __forceinline__ void xcd_barrier_complete(unsigned* bar, unsigned x, unsigned& nloc, unsigned& nx) {
    const unsigned G = gridDim.x * gridDim.y * gridDim.z;
    unsigned sum, cnt, mine, sp = 0u;
    for (;;) {
        sum = 0u; cnt = 0u; mine = 0u;
#pragma unroll
        for (unsigned j = 0; j < 16; ++j) { const unsigned c = xb_ld(&bar[XB_XCNT(j)]); sum += c; cnt += (c > 0u) ? 1u : 0u; mine = (j == x) ? c : mine; }
        if (sum == G) break;
        __builtin_amdgcn_s_sleep(1);
        if ((++sp & 255u) == 0u) { if (xb_ld(&bar[XB_TMO])) break; if (sp > XB_SPIN_CAP) { atomicAdd(&bar[XB_TMO], 1u); break; } }
    }
    nloc = mine > 0u ? mine : 1u; nx = cnt > 0u ? cnt : 1u;
}

__device__ __forceinline__ void xcd_barrier(const XcdBarrier& b) {
    asm volatile("s_waitcnt vmcnt(0)" ::: "memory");
    __syncthreads();
    if (threadIdx.x == 0) {
        unsigned* bar = b.bar;
        __builtin_amdgcn_s_waitcnt(0);
        unsigned nloc = b.st[0], nx = b.st[1];
        if (nloc == 0u) { xcd_barrier_complete(bar, b.x, nloc, nx); b.st[0] = nloc; b.st[1] = nx; }
        const unsigned old = xb_add(&bar[XB_XSUB(b.x)], 1u);
        const unsigned gen = old / nloc;
        if (old + 1u == (gen + 1u) * nloc) {
            __builtin_amdgcn_fence(__ATOMIC_RELEASE, "agent");
            asm volatile("s_waitcnt vmcnt(0)" ::: "memory");
            const unsigned og = xb_add(&bar[XB_TOP], 1u);
            const unsigned tg = og / nx;
            if (og + 1u == (tg + 1u) * nx) xb_add(&bar[XB_TOPGEN], 1u);
            else XB_SPIN(xb_ld(&bar[XB_TOPGEN]) == tg, bar);
            __builtin_amdgcn_fence(__ATOMIC_ACQUIRE, "agent");
            xb_add(&bar[XB_XGEN(b.x)], 1u);
            asm volatile("s_waitcnt vmcnt(0)" ::: "memory");
        } else {
            XB_SPIN(xb_ld(&bar[XB_XGEN(b.x)]) == gen, bar);
            __builtin_amdgcn_fence(__ATOMIC_ACQUIRE, "agent");
            asm volatile("s_waitcnt vmcnt(0)" ::: "memory");
        }
    }
    __syncthreads();
}

typedef short bf16x8_t __attribute__((ext_vector_type(8)));
__device__ __forceinline__ f32x4 mfma16(bf16x8_t a, bf16x8_t b, f32x4 c) { return __builtin_amdgcn_mfma_f32_16x16x32_bf16(a, b, c, 0, 0, 0); }

struct GdnChunkBufs {
    bf16* W;
    bf16* QG;
    bf16* KDT;
    bf16* UT;
    bf16* QK;
    float* EGL;
};

constexpr int GP_QB = 0, GP_KB = 17408, GP_VB = 34816, GP_LS = 52224, GP_QKS = 69632, GP_WS = 78848, GP_SC = 96256;

__device__ __forceinline__ void gdn_prep_unit(const bf16* __restrict__ PROJ, const float* __restrict__ conv_w, const float* __restrict__ a_log, const float* __restrict__ dt_bias,
                                              const GdnChunkBufs& cb, float* __restrict__ p_gdn_conv, int un, unsigned char* lds) {
    int tid = threadIdx.x; asm volatile("" : "+v"(tid));
    const int lane = tid & 63, wave = __builtin_amdgcn_readfirstlane(tid >> 6), fr = lane & 15, fq = lane >> 4;
    const int h = un & 3, n = (un >> 2) & 63, b = un >> 8;
    const int t0 = b * SEQ + n * 64;
    bf16* Qb = (bf16*)(lds + GP_QB); bf16* Kb = (bf16*)(lds + GP_KB); bf16* Vb = (bf16*)(lds + GP_VB); bf16* Ws = (bf16*)(lds + GP_WS);
    float* Ls = (float*)(lds + GP_LS); bf16* QKs = (bf16*)(lds + GP_QKS);
    float* gcs = (float*)(lds + GP_SC); float* bets = gcs + 64; float* egcs = gcs + 128; float* ekds = gcs + 192; float* begs = gcs + 256;
    if (wave == 0) {
        const bf16* prow = PROJ + (size_t)(t0 + lane) * ABN;
        const float a_raw = bf2f(prow[C_A + h]), b_raw = bf2f(prow[C_B + h]);
        float g = -expf(a_log[h]) * softplusf_(a_raw + dt_bias[h]);
#pragma unroll
        for (int off = 1; off < 64; off <<= 1) { const float v = __shfl_up(g, off); if (lane >= off) g += v; }
        const float glast = __shfl(g, 63);
        { const float be_ = sigmoidf_(b_raw), eg_ = expf(g); gcs[lane] = g; bets[lane] = be_; egcs[lane] = eg_; ekds[lane] = expf(glast - g); begs[lane] = be_ * eg_; }
        if (lane == 0) cb.EGL[un] = expf(glast);
    }
    {
        int cols[6]; float cw[4][6], xw[3][6];
#pragma unroll
        for (int p = 0; p < 3; ++p)
#pragma unroll
            for (int e = 0; e < 2; ++e) cols[p * 2 + e] = p * 512 + h * 128 + e * 64 + lane;
#pragma unroll
        for (int i = 0; i < 4; ++i)
#pragma unroll
            for (int c = 0; c < 6; ++c) cw[i][c] = conv_w[i * 1536 + cols[c]];
        const int i0 = wave * 8;
#pragma unroll
        for (int k = 0; k < 3; ++k) {
            const int pos = n * 64 + i0 - 3 + k;
#pragma unroll
            for (int c = 0; c < 6; ++c) xw[k][c] = pos >= 0 ? bf2f(PROJ[(size_t)(t0 + i0 - 3 + k) * ABN + cols[c]]) : 0.f;
        }
#pragma unroll
        for (int ii = 0; ii < 8; ++ii) {
            const int i = i0 + ii;
            float xt[6], s[6];
#pragma unroll
            for (int c = 0; c < 6; ++c) xt[c] = bf2f(PROJ[(size_t)(t0 + i) * ABN + cols[c]]);
#pragma unroll
            for (int c = 0; c < 6; ++c) s[c] = siluf_(cw[0][c] * xw[0][c] + cw[1][c] * xw[1][c] + cw[2][c] * xw[2][c] + cw[3][c] * xt[c]);
            const float qs = rsqrtf(wave_sum(s[0] * s[0] + s[1] * s[1]) + 1e-6f) * 0.08838834764831845f;
            const float ks = rsqrtf(wave_sum(s[2] * s[2] + s[3] * s[3]) + 1e-6f);
            Qb[i * 136 + lane] = (bf16)f2bf(s[0] * qs); Qb[i * 136 + 64 + lane] = (bf16)f2bf(s[1] * qs);
            Kb[i * 136 + lane] = (bf16)f2bf(s[2] * ks); Kb[i * 136 + 64 + lane] = (bf16)f2bf(s[3] * ks);
            Vb[i * 136 + lane] = (bf16)f2bf(s[4]);      Vb[i * 136 + 64 + lane] = (bf16)f2bf(s[5]);
            if (n == 63 && i >= 61) {
#pragma unroll
                for (int c = 0; c < 6; ++c) p_gdn_conv[((size_t)b * 3 + (i - 61)) * 1536 + cols[c]] = xt[c];
            }
#pragma unroll
            for (int c = 0; c < 6; ++c) { xw[0][c] = xw[1][c]; xw[1][c] = xw[2][c]; xw[2][c] = xt[c]; }
        }
    }
    __syncthreads();
    {
        const int mi = wave >> 1;
        bf16x8_t aK[4], aQ[4];
#pragma unroll
        for (int ks = 0; ks < 4; ++ks) { aK[ks] = *(const bf16x8_t*)(Kb + (mi * 16 + fr) * 136 + ks * 32 + 8 * fq); aQ[ks] = *(const bf16x8_t*)(Qb + (mi * 16 + fr) * 136 + ks * 32 + 8 * fq); }
#pragma unroll
        for (int nn = 0; nn < 2; ++nn) {
            const int nj = (wave & 1) * 2 + nn;
            f32x4 accK = (f32x4){0.f, 0.f, 0.f, 0.f}, accQ = accK;
#pragma unroll
            for (int ks = 0; ks < 4; ++ks) { const bf16x8_t bk = *(const bf16x8_t*)(Kb + (nj * 16 + fr) * 136 + ks * 32 + 8 * fq); accK = mfma16(aK[ks], bk, accK); accQ = mfma16(aQ[ks], bk, accQ); }
            const int j = nj * 16 + fr; const float gj = gcs[j];
#pragma unroll
            for (int r = 0; r < 4; ++r) {
                const int i = mi * 16 + 4 * fq + r;
                const float dec = i >= j ? expf(gcs[i] - gj) : 0.f;
                Ls[i * 68 + j] = i > j ? bets[i] * accK[r] * dec : 0.f;
                QKs[i * 72 + j] = (bf16)f2bf(i >= j ? accQ[r] * dec : 0.f);
            }
        }
    }
    __syncthreads();
    if (wave < 4) {
        float x[64];
        const bool isu = tid < 128; const int c = isu ? tid : tid - 128;
        const LAS unsigned char* l3 = (const LAS unsigned char*)lds;
        unsigned so = (isu ? GP_VB : GP_KB) + c * 2, ro = GP_SC + (isu ? 64 * 4 : 256 * 4), lo = GP_LS;
        asm volatile("" : "+v"(so), "+v"(ro), "+v"(lo));
#pragma unroll
        for (int i = 0; i < 64; ++i) {
            float acc = *(const LAS float*)(l3 + ro + 4 * i) * bf2f(*(const LAS bf16*)(l3 + so + i * 272));
#pragma unroll
            for (int j4 = 0; j4 < (i + 3) / 4; ++j4) {
                const f32x4 l4 = *(const LAS f32x4*)(l3 + lo + i * 272 + j4 * 16);
                acc -= l4.x * x[j4 * 4 + 0];
                if (j4 * 4 + 1 < i) acc -= l4.y * x[j4 * 4 + 1];
                if (j4 * 4 + 2 < i) acc -= l4.z * x[j4 * 4 + 2];
                if (j4 * 4 + 3 < i) acc -= l4.w * x[j4 * 4 + 3];
            }
            x[i] = acc;
        }
        if (isu) {
            bf16* dst = cb.UT + ((size_t)un * 128 + c) * 64;
#pragma unroll
            for (int i8 = 0; i8 < 8; ++i8) { v4u o; o.x = pk2(x[i8 * 8 + 0], x[i8 * 8 + 1]); o.y = pk2(x[i8 * 8 + 2], x[i8 * 8 + 3]); o.z = pk2(x[i8 * 8 + 4], x[i8 * 8 + 5]); o.w = pk2(x[i8 * 8 + 6], x[i8 * 8 + 7]); *(v4u*)(dst + i8 * 8) = o; }
        } else {
#pragma unroll
            for (int i = 0; i < 64; ++i) Ws[i * 136 + c] = (bf16)f2bf(x[i]);
        }
    } else {
        const int t2 = tid - 256;
#pragma unroll
        for (int k = 0; k < 4; ++k) {
            const int ci = t2 + 256 * k, i = ci >> 4, d0 = (ci & 15) * 8; const float e = egcs[i];
            const v4u q = *(const v4u*)(Qb + i * 136 + d0);
            v4u o; o.x = pk2(bflo(q.x) * e, bfhi(q.x) * e); o.y = pk2(bflo(q.y) * e, bfhi(q.y) * e); o.z = pk2(bflo(q.z) * e, bfhi(q.z) * e); o.w = pk2(bflo(q.w) * e, bfhi(q.w) * e);
            *(v4u*)(cb.QG + ((size_t)un * 64 + i) * 128 + d0) = o;
        }
#pragma unroll
        for (int k = 0; k < 4; ++k) {
            const int ci = t2 + 256 * k, d = ci & 127, i0 = (ci >> 7) * 8;
            float v[8];
#pragma unroll
            for (int q = 0; q < 8; ++q) v[q] = bf2f(Kb[(i0 + q) * 136 + d]) * ekds[i0 + q];
            v4u o; o.x = pk2(v[0], v[1]); o.y = pk2(v[2], v[3]); o.z = pk2(v[4], v[5]); o.w = pk2(v[6], v[7]);
            *(v4u*)(cb.KDT + ((size_t)un * 128 + d) * 64 + i0) = o;
        }
#pragma unroll
        for (int k = 0; k < 2; ++k) {
            const int ci = t2 + 256 * k, i = ci >> 3, j0 = (ci & 7) * 8;
            *(v4u*)(cb.QK + ((size_t)un * 64 + i) * 64 + j0) = *(const v4u*)(QKs + i * 72 + j0);
        }
    }
    __syncthreads();
#pragma unroll
    for (int k = 0; k < 2; ++k) {
        const int ci = tid + 512 * k, i = ci >> 4, d0 = (ci & 15) * 8;
        *(v4u*)(cb.W + ((size_t)un * 64 + i) * 128 + d0) = *(const v4u*)(Ws + i * 136 + d0);
    }
    __syncthreads();
}

constexpr int GS_ST = 0, GS_VNT = 2 * 32 * 136 * 2, GS_END = GS_VNT + 32 * 72 * 2;
__device__ __forceinline__ void gdn_seq(const GdnChunkBufs& cb, float* __restrict__ O, float* __restrict__ Sout, int b, int h, int sl, unsigned char* lds) {
    int tid = threadIdx.x; asm volatile("" : "+v"(tid));
    const int lane = tid & 63, wave = __builtin_amdgcn_readfirstlane(tid >> 6), fr = lane & 15, fq = lane >> 4;
    const int mi = wave >> 1, nj = wave & 1;
    bf16* St = (bf16*)(lds + GS_ST); bf16* VnT = (bf16*)(lds + GS_VNT);
    for (int i = tid; i < 2 * 32 * 136 / 2; i += NTH) ((unsigned*)St)[i] = 0u;
    f32x4 accS[2]; accS[0] = (f32x4){0.f, 0.f, 0.f, 0.f}; accS[1] = accS[0];
    bf16x8_t aW[4], aQG[4], aQK[2], aKD[2]; v2u ut; float egl;
#define GS_LOAD(un_) do { const size_t u_ = (size_t)(un_); \
        _Pragma("unroll") for (int ks = 0; ks < 4; ++ks) { aW[ks] = *(const bf16x8_t*)(cb.W + (u_ * 64 + mi * 16 + fr) * 128 + ks * 32 + 8 * fq); aQG[ks] = *(const bf16x8_t*)(cb.QG + (u_ * 64 + mi * 16 + fr) * 128 + ks * 32 + 8 * fq); } \
        _Pragma("unroll") for (int ks = 0; ks < 2; ++ks) { aQK[ks] = *(const bf16x8_t*)(cb.QK + (u_ * 64 + mi * 16 + fr) * 64 + ks * 32 + 8 * fq); aKD[ks] = *(const bf16x8_t*)(cb.KDT + (u_ * 128 + wave * 16 + fr) * 64 + ks * 32 + 8 * fq); } \
        ut = *(const v2u*)(cb.UT + (u_ * 128 + sl * 32 + nj * 16 + fr) * 64 + mi * 16 + 4 * fq); egl = cb.EGL[u_]; } while (0)
    int cur = 0;
    for (int n = 0; n < 64; ++n) {
        const int un = (b * 64 + n) * 4 + h;
        GS_LOAD(un);
        __syncthreads();
        f32x4 accW = (f32x4){0.f, 0.f, 0.f, 0.f}, accO = accW;
        const bf16* Sc = St + cur * 32 * 136;
#pragma unroll
        for (int ks = 0; ks < 4; ++ks) { const bf16x8_t bs = *(const bf16x8_t*)(Sc + (nj * 16 + fr) * 136 + ks * 32 + 8 * fq); accW = mfma16(aW[ks], bs, accW); accO = mfma16(aQG[ks], bs, accO); }
        const float v0 = bflo(ut.x) - accW[0], v1 = bfhi(ut.x) - accW[1], v2 = bflo(ut.y) - accW[2], v3 = bfhi(ut.y) - accW[3];
        { v2u o; o.x = pk2(v0, v1); o.y = pk2(v2, v3); *(v2u*)(VnT + (nj * 16 + fr) * 72 + mi * 16 + 4 * fq) = o; }
        __syncthreads();
#pragma unroll
        for (int ks = 0; ks < 2; ++ks) { const bf16x8_t bv = *(const bf16x8_t*)(VnT + (nj * 16 + fr) * 72 + ks * 32 + 8 * fq); accO = mfma16(aQK[ks], bv, accO); }
        {
            float* orow = O + (size_t)(b * SEQ + n * 64 + mi * 16 + 4 * fq) * 512 + h * 128 + sl * 32 + nj * 16 + fr;
            orow[0] = accO[0]; orow[512] = accO[1]; orow[1024] = accO[2]; orow[1536] = accO[3];
        }
        bf16* Sn = St + (cur ^ 1) * 32 * 136;
#pragma unroll
        for (int njj = 0; njj < 2; ++njj) {
            accS[njj] = accS[njj] * egl;
#pragma unroll
            for (int ks = 0; ks < 2; ++ks) { const bf16x8_t bv = *(const bf16x8_t*)(VnT + (njj * 16 + fr) * 72 + ks * 32 + 8 * fq); accS[njj] = mfma16(aKD[ks], bv, accS[njj]); }
            v2u o; o.x = pk2(accS[njj][0], accS[njj][1]); o.y = pk2(accS[njj][2], accS[njj][3]);
            *(v2u*)(Sn + (njj * 16 + fr) * 136 + wave * 16 + 4 * fq) = o;
        }
        cur ^= 1;
    }
#undef GS_LOAD
#pragma unroll
    for (int njj = 0; njj < 2; ++njj)
#pragma unroll
        for (int r = 0; r < 4; ++r) Sout[(((size_t)b * 4 + h) * 128 + wave * 16 + 4 * fq + r) * 128 + sl * 32 + njj * 16 + fr] = accS[njj][r];
    __syncthreads();
}

__device__ __forceinline__ void lru_prep_unit(const bf16* __restrict__ PROJ, const float* __restrict__ conv_w, const float* __restrict__ conv_b,
                                              const float* __restrict__ w_r, const float* __restrict__ b_r, const float* __restrict__ w_i, const float* __restrict__ b_i, const float* __restrict__ lam,
                                              float* __restrict__ H, float* __restrict__ P, float* __restrict__ Hend, float* __restrict__ Pend, float* __restrict__ p_lru_conv, int ub) {
    int c = threadIdx.x; asm volatile("" : "+v"(c));
    const int nblk = c >> 6, d = c & 63;
    const int n = ub & 63, b = ub >> 6, t0 = b * SEQ + n * 64;
    float wr[64], wi[64];
#pragma unroll
    for (int cc = 0; cc < 64; ++cc) { wr[cc] = w_r[((size_t)nblk * 64 + cc) * 64 + d]; wi[cc] = w_i[((size_t)nblk * 64 + cc) * 64 + d]; }
    const float cw0 = conv_w[c], cw1 = conv_w[512 + c], cw2 = conv_w[1024 + c], cw3 = conv_w[1536 + c], cb_ = conv_b[c];
    const float br = b_r[c], bi = b_i[c], spl = -8.0f * softplusf_(-lam[c]);
    float x0 = (n * 64 - 3 >= 0) ? bf2f(PROJ[(size_t)(t0 - 3) * ABN + C_XR + c]) : 0.f;
    float x1 = (n * 64 - 2 >= 0) ? bf2f(PROJ[(size_t)(t0 - 2) * ABN + C_XR + c]) : 0.f;
    float x2 = (n * 64 - 1 >= 0) ? bf2f(PROJ[(size_t)(t0 - 1) * ABN + C_XR + c]) : 0.f;
    float hloc = 0.f, ploc = 1.f;
    for (int i = 0; i < 64; ++i) {
        const float xt = bf2f(PROJ[(size_t)(t0 + i) * ABN + C_XR + c]);
        const float xr = cb_ + cw0 * x0 + cw1 * x1 + cw2 * x2 + cw3 * xt;
        float r = br, ii = bi;
#pragma unroll
        for (int cc = 0; cc < 64; ++cc) { const float xv = __uint_as_float(__builtin_amdgcn_readlane(__float_as_uint(xr), cc)); r += xv * wr[cc]; ii += xv * wi[cc]; }
        r = sigmoidf_(r); ii = sigmoidf_(ii);
        const float log_a = spl * r;
        const float a = expf(log_a), bb = sqrtf(-expm1f(2.0f * log_a)) * (ii * xr);
        hloc = a * hloc + bb; ploc *= a;
        H[(size_t)(t0 + i) * 512 + c] = hloc; P[(size_t)(t0 + i) * 512 + c] = ploc;
        if (n == 63 && i >= 61) p_lru_conv[((size_t)b * 3 + (i - 61)) * 512 + c] = xt;
        x0 = x1; x1 = x2; x2 = xt;
    }
    Hend[(size_t)ub * 512 + c] = hloc; Pend[(size_t)ub * 512 + c] = ploc;
}
__device__ __forceinline__ void lru_carry(const float* __restrict__ Hend, const float* __restrict__ Pend, float* __restrict__ CIN, float* __restrict__ hlast, int bx) {
    const int idx = bx * NTH + threadIdx.x, b = idx >> 9, c = idx & 511;
    float carry = 0.f;
#pragma unroll 8
    for (int n = 0; n < 64; ++n) {
        const size_t o = ((size_t)b * 64 + n) * 512 + c;
        CIN[o] = carry;
        carry = Hend[o] + Pend[o] * carry;
    }
    hlast[(size_t)b * 512 + c] = carry;
}

__device__ __forceinline__ unsigned f2key(float f) { const unsigned u = __float_as_uint(f); return u ^ ((u >> 31) ? 0xffffffffu : 0x80000000u); }
__device__ __forceinline__ float key2f(unsigned k) { return __uint_as_float(k ^ ((k >> 31) ? 0x80000000u : 0xffffffffu)); }
constexpr int TK_SS = 0, TK_TS = 2 * 64 * 129 * 4, TK_END = TK_TS + 64 * 2 * 16 * 4;
__device__ __forceinline__ void peer_topk2(const bf16* __restrict__ Q, const bf16* __restrict__ KB  , int* __restrict__ EXP, float* __restrict__ GATE,
                                           int tile, int h, unsigned char* lds) {
    int tid = threadIdx.x; asm volatile("" : "+v"(tid));
    const int lane = tid & 63, wave = __builtin_amdgcn_readfirstlane(tid >> 6), fr = lane & 15, fq = lane >> 4;
    float* Ss = (float*)(lds + TK_SS); unsigned* Ts = (unsigned*)(lds + TK_TS);
    {
        const int c = wave >> 2, mt = wave & 3;
        bf16x8_t a[4];
#pragma unroll
        for (int ks = 0; ks < 4; ++ks) a[ks] = *(const bf16x8_t*)(Q + (size_t)(tile * 64 + mt * 16 + fr) * 2048 + h * 256 + c * 128 + ks * 32 + 8 * fq);
        const bf16* kb = KB + ((size_t)(h * 2 + c) * 128) * 128;
#pragma unroll
        for (int nt = 0; nt < 8; ++nt) {
            f32x4 acc = (f32x4){0.f, 0.f, 0.f, 0.f};
#pragma unroll
            for (int ks = 0; ks < 4; ++ks) { const bf16x8_t bk = *(const bf16x8_t*)(kb + (size_t)(nt * 16 + fr) * 128 + ks * 32 + 8 * fq); acc = mfma16(a[ks], bk, acc); }
#pragma unroll
            for (int r = 0; r < 4; ++r) Ss[(c * 64 + mt * 16 + 4 * fq + r) * 129 + nt * 16 + fr] = acc[r];
        }
    }
    __syncthreads();
    if (tid < 128) {
        const float* row = Ss + tid * 129;
        unsigned top[16];
#pragma unroll
        for (int j = 0; j < 16; ++j) top[j] = 0u;
        for (int n = 0; n < 128; ++n) {
            unsigned x = (f2key(row[n]) & ~127u) | (unsigned)(127 - n);
#pragma unroll
            for (int j = 0; j < 16; ++j) { const unsigned t = top[j] > x ? top[j] : x; x = top[j] > x ? x : top[j]; top[j] = t; }
        }
        const int c = tid >> 6, tk = tid & 63;
#pragma unroll
        for (int j = 0; j < 16; ++j) Ts[(tk * 2 + c) * 16 + j] = top[j];
    }
    __syncthreads();
    if (tid < 64) {
        const int tk = tid;
        float s0[16], s1[16];
#pragma unroll
        for (int j = 0; j < 16; ++j) { s0[j] = key2f(Ts[(tk * 2 + 0) * 16 + j] & ~127u); s1[j] = key2f(Ts[(tk * 2 + 1) * 16 + j] & ~127u); }
        unsigned top[16];
#pragma unroll
        for (int j = 0; j < 16; ++j) top[j] = 0u;
#pragma unroll
        for (int i = 0; i < 16; ++i)
#pragma unroll
            for (int jj = 0; jj < 16; ++jj)
                if ((i + 1) * (jj + 1) <= 16) {
                    unsigned x = (f2key(s0[i] + s1[jj]) & ~255u) | (unsigned)(255 - (i * 16 + jj));
#pragma unroll
                    for (int j = 0; j < 16; ++j) { const unsigned t = top[j] > x ? top[j] : x; x = top[j] > x ? x : top[j]; top[j] = t; }
                }
        float e[16], sum = 0.f; const float m = key2f(top[0] & ~255u);
#pragma unroll
        for (int j = 0; j < 16; ++j) { e[j] = expf(key2f(top[j] & ~255u) - m); sum += e[j]; }
        const float inv = 1.0f / sum;
        const size_t o = (size_t)(tile * 64 + tk) * 128 + h * 16;
#pragma unroll
        for (int j = 0; j < 16; ++j) {
            const int code = 255 - (int)(top[j] & 255u), i = code >> 4, jj = code & 15;
            const int n0 = 127 - (int)(Ts[(tk * 2 + 0) * 16 + i] & 127u), n1 = 127 - (int)(Ts[(tk * 2 + 1) * 16 + jj] & 127u);
            EXP[o + j] = n0 * 128 + n1; GATE[o + j] = e[j] * inv;
        }
    }
    __syncthreads();
}

constexpr int AT_KS = 0, AT_VT = 192 * 72 * 2, AT_BT = AT_VT + 64 * 200 * 2, AT_PW = AT_BT + 4 * 128 * 4, AT_END = AT_PW + 8 * 32 * 72 * 2;
__device__ __forceinline__ void attn_unit(const bf16* __restrict__ PCb, const float* __restrict__ rel_bias, const float* __restrict__ sinks, bf16* __restrict__ ATT, int un, unsigned char* lds) {
    int tid = threadIdx.x; asm volatile("" : "+v"(tid));
    const int lane = tid & 63, wave = __builtin_amdgcn_readfirstlane(tid >> 6), fr = lane & 15, fq = lane >> 4;
    const int kvh = un & 3, qblk = (un >> 2) & 63, b = un >> 8;
    const int q0 = qblk * 64, tb = b * SEQ;
    bf16* Ks = (bf16*)(lds + AT_KS); bf16* Vt = (bf16*)(lds + AT_VT); float* Bt = (float*)(lds + AT_BT); bf16* Pw = (bf16*)(lds + AT_PW) + wave * 32 * 72;
#pragma unroll
    for (int k = 0; k < 3; ++k) {
        const int ci = tid + 512 * k, row = ci >> 3, part = ci & 7, kpos = q0 - 128 + row;
        v4u kv = (v4u){0u, 0u, 0u, 0u}, vv = kv;
        if (kpos >= 0) { const bf16* src = PCb + (size_t)(tb + kpos) * CN + kvh * 64 + part * 8; kv = *(const v4u*)(src + 1024); vv = *(const v4u*)(src + 1280); }
        *(v4u*)(Ks + row * 72 + part * 8) = kv;
        bf16* vd = Vt + (part * 8) * 200 + row;
        vd[0 * 200] = (bf16)(vv.x & 0xffffu); vd[1 * 200] = (bf16)(vv.x >> 16); vd[2 * 200] = (bf16)(vv.y & 0xffffu); vd[3 * 200] = (bf16)(vv.y >> 16);
        vd[4 * 200] = (bf16)(vv.z & 0xffffu); vd[5 * 200] = (bf16)(vv.z >> 16); vd[6 * 200] = (bf16)(vv.w & 0xffffu); vd[7 * 200] = (bf16)(vv.w >> 16);
    }
    Bt[tid] = rel_bias[t5_bucket(tid & 127) * 16 + kvh * 4 + (tid >> 7)];
    __syncthreads();
    const int g = wave >> 1, qs = (wave & 1) * 32, hh = kvh * 4 + g;
    bf16x8_t aQ[2][2];
#pragma unroll
    for (int mt = 0; mt < 2; ++mt)
#pragma unroll
        for (int ks = 0; ks < 2; ++ks) aQ[mt][ks] = *(const bf16x8_t*)(PCb + (size_t)(tb + q0 + qs + mt * 16 + fr) * CN + hh * 64 + ks * 32 + 8 * fq);
    f32x4 sc[2][12];
#pragma unroll
    for (int nt = 0; nt < 12; ++nt) {
        const bf16x8_t b0 = *(const bf16x8_t*)(Ks + (nt * 16 + fr) * 72 + 8 * fq), b1 = *(const bf16x8_t*)(Ks + (nt * 16 + fr) * 72 + 32 + 8 * fq);
#pragma unroll
        for (int mt = 0; mt < 2; ++mt) { f32x4 a = (f32x4){0.f, 0.f, 0.f, 0.f}; a = mfma16(aQ[mt][0], b0, a); a = mfma16(aQ[mt][1], b1, a); sc[mt][nt] = a; }
    }
    const float sink = sinks[hh];
    const float* bt = Bt + g * 128;
#pragma unroll
    for (int mt = 0; mt < 2; ++mt)
#pragma unroll
        for (int r = 0; r < 4; ++r) {
            const int qi = qs + mt * 16 + 4 * fq + r;
            float mx = sink;
#pragma unroll
            for (int nt = 0; nt < 12; ++nt) {
                const int kk = nt * 16 + fr, rel = qi + 128 - kk;
                const bool valid = rel >= 0 && rel < 128 && (q0 - 128 + kk) >= 0;
                const float lg = valid ? sc[mt][nt][r] * 0.125f + bt[valid ? rel : 0] : -INFINITY;
                sc[mt][nt][r] = lg; mx = fmaxf(mx, lg);
            }
            mx = fmaxf(mx, __shfl_xor(mx, 1)); mx = fmaxf(mx, __shfl_xor(mx, 2)); mx = fmaxf(mx, __shfl_xor(mx, 4)); mx = fmaxf(mx, __shfl_xor(mx, 8));
            float sum = 0.f;
#pragma unroll
            for (int nt = 0; nt < 12; ++nt) { const float p = __expf(sc[mt][nt][r] - mx); sc[mt][nt][r] = p; sum += p; }
            sum += __shfl_xor(sum, 1); sum += __shfl_xor(sum, 2); sum += __shfl_xor(sum, 4); sum += __shfl_xor(sum, 8);
            const float inv = 1.0f / (sum + __expf(sink - mx));
#pragma unroll
            for (int nt = 0; nt < 12; ++nt) sc[mt][nt][r] *= inv;
        }
    f32x4 oacc[2][4];
#pragma unroll
    for (int mt = 0; mt < 2; ++mt)
#pragma unroll
        for (int dt = 0; dt < 4; ++dt) oacc[mt][dt] = (f32x4){0.f, 0.f, 0.f, 0.f};
#pragma unroll
    for (int kc = 0; kc < 3; ++kc) {
#pragma unroll
        for (int mt = 0; mt < 2; ++mt)
#pragma unroll
            for (int n4 = 0; n4 < 4; ++n4)
#pragma unroll
                for (int r = 0; r < 4; ++r) Pw[(mt * 16 + 4 * fq + r) * 72 + n4 * 16 + fr] = (bf16)f2bf(sc[mt][kc * 4 + n4][r]);
        asm volatile("s_waitcnt lgkmcnt(0)" ::: "memory");
#pragma unroll
        for (int ks = 0; ks < 2; ++ks) {
            const bf16x8_t p0 = *(const bf16x8_t*)(Pw + fr * 72 + ks * 32 + 8 * fq), p1 = *(const bf16x8_t*)(Pw + (16 + fr) * 72 + ks * 32 + 8 * fq);
#pragma unroll
            for (int dt = 0; dt < 4; ++dt) {
                const bf16x8_t bv = *(const bf16x8_t*)(Vt + (dt * 16 + fr) * 200 + kc * 64 + ks * 32 + 8 * fq);
                oacc[0][dt] = mfma16(p0, bv, oacc[0][dt]); oacc[1][dt] = mfma16(p1, bv, oacc[1][dt]);
            }
        }
        asm volatile("s_waitcnt lgkmcnt(0)" ::: "memory");
    }
#pragma unroll
    for (int mt = 0; mt < 2; ++mt)
#pragma unroll
        for (int dt = 0; dt < 4; ++dt)
#pragma unroll
            for (int r = 0; r < 4; ++r) Pw[(mt * 16 + 4 * fq + r) * 72 + dt * 16 + fr] = (bf16)f2bf(oacc[mt][dt][r]);
    asm volatile("s_waitcnt lgkmcnt(0)" ::: "memory");
#pragma unroll
    for (int k = 0; k < 4; ++k) {
        const int ci = lane + 64 * k, row = ci >> 3, part = ci & 7;
        *(v4u*)(ATT + (size_t)(tb + q0 + qs + row) * D + hh * 64 + part * 8) = *(const v4u*)(Pw + row * 72 + part * 8);
    }
    __syncthreads();
}

__device__ __forceinline__ void swa_attn_sample(const bf16* __restrict__ PCb, const float* __restrict__ cache_k, const float* __restrict__ cache_v,
                                                const float* __restrict__ rel_bias, const float* __restrict__ sinks, bf16* __restrict__ ATT, int gw, int lane) {
    const int sb = gw >> 4, h = gw & 15, kvh = h >> 2, t = NP + sb;
    const bf16* qrow = PCb + (size_t)t * CN + h * 64;
    float lg[2];
#pragma unroll
    for (int rr = 0; rr < 2; ++rr) {
        const int r = lane + 64 * rr;
        float dot = 0.f;
        if (r == 0) {
            const bf16* krow = PCb + (size_t)t * CN + 1024 + kvh * 64;
            for (int d = 0; d < 64; ++d) dot += bf2f(qrow[d]) * bf2f(krow[d]);
        } else {
            const float* krow = cache_k + (((size_t)sb * 128 + (128 - r)) * 4 + kvh) * 64;
#pragma unroll
            for (int d4 = 0; d4 < 16; ++d4) { const float4 kv = *(const float4*)(krow + d4 * 4);
                dot += bf2f(qrow[d4 * 4]) * kv.x + bf2f(qrow[d4 * 4 + 1]) * kv.y + bf2f(qrow[d4 * 4 + 2]) * kv.z + bf2f(qrow[d4 * 4 + 3]) * kv.w; }
        }
        lg[rr] = dot * 0.125f + rel_bias[t5_bucket(r) * 16 + h];
    }
    const float sink = sinks[h];
    const float m = fmaxf(wave_max(fmaxf(lg[0], lg[1])), sink);
    float p[2] = {expf(lg[0] - m), expf(lg[1] - m)};
    const float inv = 1.0f / (wave_sum(p[0] + p[1]) + expf(sink - m));
    float o = 0.f;
#pragma unroll
    for (int rr = 0; rr < 2; ++rr)
        for (int l2 = 0; l2 < 64; ++l2) {
            const int r = l2 + 64 * rr;
            const float pj = __shfl(p[rr], l2);
            const float vv = (r == 0) ? bf2f(PCb[(size_t)t * CN + 1280 + kvh * 64 + lane]) : cache_v[(((size_t)sb * 128 + (128 - r)) * 4 + kvh) * 64 + lane];
            o += pj * vv;
        }
    ATT[(size_t)t * D + h * 64 + lane] = (bf16)f2bf(o * inv);
}
__device__ __forceinline__ void swa_kv_out2(const bf16* __restrict__ PCb, const float* __restrict__ cache_k, const float* __restrict__ cache_v,
                                            float* __restrict__ pk, float* __restrict__ pv, float* __restrict__ sk, float* __restrict__ sv, int vb) {
    const int c = threadIdx.x & 255, row = vb * 2 + (threadIdx.x >> 8);
    if (row < NB * 128) {
        const int b = row >> 7, i = row & 127;
        const bf16* src = PCb + (size_t)(b * SEQ + SEQ - 128 + i) * CN;
        pk[(size_t)row * 256 + c] = bf2f(src[1024 + c]);
        pv[(size_t)row * 256 + c] = bf2f(src[1280 + c]);
    } else {
        const int r2 = row - NB * 128, sb = r2 >> 7, i = r2 & 127;
        if (i < 127) {
            sk[(size_t)r2 * 256 + c] = cache_k[((size_t)sb * 128 + i + 1) * 256 + c];
            sv[(size_t)r2 * 256 + c] = cache_v[((size_t)sb * 128 + i + 1) * 256 + c];
        } else {
            const bf16* src = PCb + (size_t)(NP + sb) * CN;
            sk[(size_t)r2 * 256 + c] = bf2f(src[1024 + c]);
            sv[(size_t)r2 * 256 + c] = bf2f(src[1280 + c]);
        }
    }
}

constexpr size_t MiB = 1u << 20;
constexpr size_t WS_CTL = 0, CTL_ZERO_BYTES = 64 * 1024;
constexpr size_t WS_WAB = 1 * MiB;
constexpr size_t WS_WOUT = WS_WAB + (size_t)ABNP * D * 2;
constexpr size_t WS_WQ0 = WS_WOUT + (size_t)D * D * 2;
constexpr size_t WS_WQ1 = WS_WQ0 + (size_t)2048 * D * 2;
constexpr size_t WS_WINC = WS_WQ1 + (size_t)2048 * D * 2;
constexpr size_t WS_WOUTC = WS_WINC + (size_t)CN * D * 2;
constexpr size_t WS_ABUF = WS_WOUTC + (size_t)D * D * 2;
constexpr size_t WS_P = WS_ABUF + (size_t)MP * D * 2;
constexpr size_t WS_T = WS_P + (size_t)MP * ABN * 2;
constexpr size_t WS_Q = WS_T + (size_t)4 * 16384 * D + (size_t)4 * 16384 * 4;
constexpr size_t WS_A = WS_Q + (size_t)MP * 1536 * 4;
constexpr size_t WS_B = WS_A + (size_t)MP * 512 * 4;
constexpr size_t WS_O = WS_B + (size_t)MP * 512 * 4;
constexpr size_t WS_X1 = WS_O + (size_t)MP * 512 * 4;
constexpr size_t WS_G = WS_X1 + (size_t)MP * D * 4;
constexpr size_t WS_BETA = WS_G + (size_t)MP * 4 * 4;
constexpr size_t WS_GATE = WS_BETA + (size_t)MP * 4 * 4;
constexpr size_t WS_EXP = WS_GATE + (size_t)MP * 128 * 4;
constexpr size_t WS_HEND = WS_EXP + (size_t)MP * 128 * 4;
constexpr size_t WS_KEYS = WS_HEND + (size_t)3 * 4 * 64 * 512 * 4;
constexpr size_t WS_END = WS_KEYS + (size_t)2 * 8 * 2 * 128 * 128 * 2;
constexpr size_t Q_QKVS = 0, Q_W = 1 * MiB, Q_QG = Q_W + 16 * MiB, Q_KDT = Q_QG + 16 * MiB, Q_UT = Q_KDT + 16 * MiB, Q_QK = Q_UT + 16 * MiB, Q_EGL = Q_QK + 8 * MiB, Q_END = Q_EGL + 4096;
static_assert(Q_END <= (size_t)MP * 1536 * 4, "region Q");
static_assert(WS_END <= 512 * MiB, "d_ws map");

struct MegaArgs {
    const float* in[35];
    float* out;
    unsigned char* ws;
};

__global__ void __launch_bounds__(NTH, 2) fwd_megakernel(MegaArgs ma) {
    cg::grid_group grid = cg::this_grid();
    extern __shared__ __attribute__((aligned(16))) unsigned char lds[];
    float* smem = (float*)lds;
    const int nb = gridDim.x, b0 = blockIdx.x, tid = threadIdx.x, lane = tid & 63, wave = __builtin_amdgcn_readfirstlane(tid >> 6);
    const float* x_prompt = ma.in[0];
    const float* x_sample = ma.in[1];
    const float* state_gdn = ma.in[2];
    const float* state_gdn_conv = ma.in[3];
    const float* state_lru = ma.in[4];
    const float* state_lru_conv = ma.in[5];
    const float* cache_k = ma.in[6];
    const float* cache_v = ma.in[7];
    const float* w_in_ab = ma.in[8];
    const float* gdn_conv_w = ma.in[9];
    const float* gdn_a_log = ma.in[10];
    const float* gdn_dt_bias = ma.in[11];
    const float* gdn_norm_w = ma.in[12];
    const float* lru_conv_w = ma.in[13];
    const float* lru_conv_b = ma.in[14];
    const float* lru_w_r = ma.in[15];
    const float* lru_b_r = ma.in[16];
    const float* lru_w_i = ma.in[17];
    const float* lru_b_i = ma.in[18];
    const float* lru_lam = ma.in[19];
    const float* w_out_ab = ma.in[20];
    const float* w_in_c = ma.in[21];
    const float* b_in_c = ma.in[22];
    const float* swa_sinks = ma.in[23];
    const float* w_out_c = ma.in[24];
    const float* b_out_c = ma.in[25];
    const float* rel_bias = ma.in[26];
    const float* ln_mix_g = ma.in[27];
    const float* ln_mix_b = ma.in[28];
    const float* ln_ffn_g = ma.in[29];
    const float* ln_ffn_b = ma.in[30];
    const float* peer_w_q = ma.in[31];
    const float* peer_keys = ma.in[32];
    const float* peer_u = ma.in[33];
    const float* peer_v = ma.in[34];

    float* out = ma.out;
    float* o_y = out;
    float* o_p_gdn = out + (size_t)NT * D;
    float* o_p_gdn_conv = o_p_gdn + 262144;
    float* o_p_lru = o_p_gdn_conv + 18432;
    float* o_p_lru_conv = o_p_lru + 2048;
    float* o_p_k = o_p_lru_conv + 6144;
    float* o_p_v = o_p_k + 131072;
    float* o_s_gdn = o_p_v + 131072;
    float* o_s_gdn_conv = o_s_gdn + 8388608;
    float* o_s_lru = o_s_gdn_conv + 589824;
    float* o_s_lru_conv = o_s_lru + 65536;
    float* o_s_k = o_s_lru_conv + 196608;
    float* o_s_v = o_s_k + 4194304;

    unsigned char* ws = ma.ws;
    bf16* WAB_T = (bf16*)(ws + WS_WAB); bf16* WOUT_T = (bf16*)(ws + WS_WOUT); bf16* WQ0_T = (bf16*)(ws + WS_WQ0); bf16* WQ1_T = (bf16*)(ws + WS_WQ1);
    bf16* WINC_T = (bf16*)(ws + WS_WINC); bf16* WOUTC_T = (bf16*)(ws + WS_WOUTC);
    bf16* ABUF = (bf16*)(ws + WS_ABUF);
    bf16* PROJ = (bf16*)(ws + WS_P); float* Y = (float*)(ws + WS_P); bf16* Qb = (bf16*)(ws + WS_P); bf16* PCb = (bf16*)(ws + WS_P); float* Y1 = (float*)(ws + WS_P);
    unsigned char* TAB8 = ws + WS_T; float* TSC = (float*)(ws + WS_T + (size_t)4 * 16384 * D);
    float* R_Q = (float*)(ws + WS_Q + Q_QKVS) - (size_t)NP * 1536; float* X2 = (float*)(ws + WS_A);
    GdnChunkBufs cbuf; cbuf.W = (bf16*)(ws + WS_Q + Q_W); cbuf.QG = (bf16*)(ws + WS_Q + Q_QG); cbuf.KDT = (bf16*)(ws + WS_Q + Q_KDT); cbuf.UT = (bf16*)(ws + WS_Q + Q_UT); cbuf.QK = (bf16*)(ws + WS_Q + Q_QK); cbuf.EGL = (float*)(ws + WS_Q + Q_EGL);
    bf16* KEYSB = (bf16*)(ws + WS_KEYS);
    float* HEND = (float*)(ws + WS_HEND); float* PEND = HEND + 4 * 64 * 512; float* CIN = PEND + 4 * 64 * 512;
    float* R_A = (float*)(ws + WS_A); float* R_B = (float*)(ws + WS_B); float* R_O = (float*)(ws + WS_O);
    float* R_X1 = (float*)(ws + WS_X1); float* X3 = R_X1;
    float* R_G = (float*)(ws + WS_G); float* R_BETA = (float*)(ws + WS_BETA); float* R_GATE = (float*)(ws + WS_GATE); int* R_EXP = (int*)(ws + WS_EXP);

    for (int u = tid; u < (LDS_BYTES - RING_BYTES) / 4; u += NTH) ((unsigned*)(lds + RING_BYTES))[u] = 0u;
    __syncthreads();
    XcdBarrier bar = xcd_barrier_post((unsigned*)(ws + WS_CTL), (volatile LAS unsigned*)((LAS unsigned char*)lds + MISC_OFF) + 8);
#define GRID_BAR() xcd_barrier(bar)
#define PHASE_LOOP(n) for (int vb = b0; vb < (n); vb += nb)
#define PHASE_END __syncthreads()
#define GEMM_PHASE(EPI, Aptr, Btptr, Nn, ...) do { pg8::Gemm g_{(const pg8::bf16_t*)(Aptr), (const pg8::bf16_t*)(Btptr), MP, (Nn), D}; pg8::StaticOrder S_; S_.init(MP, (Nn), nb, b0); \
        pg8::EPI E_{__VA_ARGS__}; pg8::gemm_phase<pg8::EPI, pg8::StaticOrder, true, true>((PG8_LAS unsigned char*)lds, g_, S_, E_); } while (0)

    {
        float* scr = smem + wave * 4096;
        const int gw = b0 * NWAVES + wave, NGW = nb * NWAVES;
        constexpr int I_AB = 16 * 97, I_OUT = 16 * 32, I_Q = 16 * 64, I_INC = 16 * 48;
        constexpr int NITEMS = I_AB + I_OUT + 2 * I_Q + I_INC + I_OUT;
        for (int it = gw; it < NITEMS; it += NGW) {
            int r = it;
            if (r < I_AB) { p0_transpose_item(w_in_ab, D, ABN, WAB_T, scr, r, lane); continue; } r -= I_AB;
            if (r < I_OUT) { p0_transpose_item(w_out_ab, D, D, WOUT_T, scr, r, lane); continue; } r -= I_OUT;
            if (r < I_Q) { p0_transpose_item(peer_w_q, D, 2048, WQ0_T, scr, r, lane); continue; } r -= I_Q;
            if (r < I_Q) { p0_transpose_item(peer_w_q + (size_t)D * 2048, D, 2048, WQ1_T, scr, r, lane); continue; } r -= I_Q;
            if (r < I_INC) { p0_transpose_item(w_in_c, D, CN, WINC_T, scr, r, lane); continue; } r -= I_INC;
            p0_transpose_item(w_out_c, D, D, WOUTC_T, scr, r, lane);
        }
        for (int m = gw; m < 512; m += NGW) row_to_bf16(peer_keys + (size_t)m * D, KEYSB + (size_t)m * D, lane);
        for (int m = gw; m < 4 * 16384; m += NGW) {
            const int k = m >> 14, r = m & 16383;
            row_to_fp8(((k & 1) ? peer_v : peer_u) + ((size_t)(k >> 1) * 16384 + r) * D, TAB8 + (size_t)m * D, TSC + m, lane);
        }
        for (int m = gw; m < MP + (ABNP - 97 * 32); m += NGW) {
            if (m < MP) row_to_bf16(m < NP ? x_prompt + (size_t)m * D : (m < NT ? x_sample + (size_t)(m - NP) * D : nullptr), ABUF + (size_t)m * D, lane);
            else row_to_bf16(nullptr, WAB_T + (size_t)(97 * 32 + (m - MP)) * D, lane);
        }
    }
    grid.sync();
    GEMM_PHASE(EpiStoreBf16, ABUF, WAB_T, ABNP, PROJ, ABN, nullptr, NT, ABN);
    GRID_BAR();
    { AbPrepArgs pa;
      pa.PROJ = PROJ; pa.st_gdn_conv = state_gdn_conv; pa.st_lru_conv = state_lru_conv;
      pa.gdn_conv_w = gdn_conv_w; pa.a_log = gdn_a_log; pa.dt_bias = gdn_dt_bias;
      pa.lru_conv_w = lru_conv_w; pa.lru_conv_b = lru_conv_b; pa.w_r = lru_w_r; pa.b_r = lru_b_r; pa.w_i = lru_w_i; pa.b_i = lru_b_i; pa.lam = lru_lam;
      pa.QKV = R_Q; pa.G = R_G; pa.BETA = R_BETA; pa.LA = R_A; pa.LB = R_B;
      pa.p_gdn_conv = o_p_gdn_conv; pa.p_lru_conv = o_p_lru_conv; pa.s_gdn_conv = o_s_gdn_conv; pa.s_lru_conv = o_s_lru_conv;
      PHASE_LOOP(1024 + 256 + NS) {
          if (vb < 1024) gdn_prep_unit(PROJ, gdn_conv_w, gdn_a_log, gdn_dt_bias, cbuf, o_p_gdn_conv, vb, lds);
          else if (vb < 1280) lru_prep_unit(PROJ, lru_conv_w, lru_conv_b, lru_w_r, lru_b_r, lru_w_i, lru_b_i, lru_lam, R_B, R_A, HEND, PEND, o_p_lru_conv, vb - 1024);
          else { ab_prep(pa, NP + (vb - 1280), smem); PHASE_END; } } }
    GRID_BAR();
    if (b0 < 64) gdn_seq(cbuf, R_O, o_p_gdn, b0 >> 4, (b0 >> 2) & 3, b0 & 3, lds);
    else if (b0 < 68) lru_carry(HEND, PEND, CIN, o_p_lru, b0 - 64);
    else for (int v = b0 - 68; v < 2048 + 128; v += nb - 68) {
        if (v < 2048) gdn_scan(R_Q, R_G, R_BETA, state_gdn, R_O, o_s_gdn, NP, 1, v & 3, (v >> 2) & 3, v >> 4, smem);
        else lru_scan(R_A, R_B, state_lru, o_s_lru, NP, 1, NS, v - 2048);
        PHASE_END;
    }
    GRID_BAR();
    PHASE_LOOP(NT / 2) { ab_mix(PROJ, R_O, R_B, R_A, CIN, gdn_norm_w, ABUF, vb); }
    GRID_BAR();
    GEMM_PHASE(EpiStoreF32, ABUF, WOUT_T, D, Y, D, nullptr, NT, D);
    GRID_BAR();
    PHASE_LOOP(NT / 8) { const int t = vb * 8 + wave;
        ln_res_w(t < NP ? x_prompt + (size_t)t * D : x_sample + (size_t)(t - NP) * D, Y + (size_t)t * D, ln_mix_g, ln_mix_b, R_X1 + (size_t)t * D, ABUF + (size_t)t * D, lane); }
    GRID_BAR();
    GEMM_PHASE(EpiStoreBf16, ABUF, WQ0_T, 2048, Qb, 2048, nullptr, NT, 2048);
    GRID_BAR();
    PHASE_LOOP((NT / 64) * 8) { peer_topk2(Qb, KEYSB, R_EXP, R_GATE, vb >> 3, vb & 7, lds); }
    GRID_BAR();
    PHASE_LOOP(NT / 8) { const int t = vb * 8 + wave;
        peer_expert_w(R_X1 + (size_t)t * D, R_EXP + (size_t)t * 128, R_GATE + (size_t)t * 128, TAB8, TAB8 + (size_t)16384 * D, TSC, TSC + 16384, ln_ffn_g, ln_ffn_b, X2 + (size_t)t * D, ABUF + (size_t)t * D, lane); }
    GRID_BAR();

    GEMM_PHASE(EpiStoreBf16, ABUF, WINC_T, CN, PCb, CN, b_in_c, NT, CN);
    GRID_BAR();
    PHASE_LOOP(1024 + 256 + (NB * 128 + NS * 128) / 2) {
        if (vb < 1024) attn_unit(PCb, rel_bias, swa_sinks, ABUF, vb, lds);
        else if (vb < 1280) swa_attn_sample(PCb, cache_k, cache_v, rel_bias, swa_sinks, ABUF, (vb - 1024) * 8 + wave, lane);
        else swa_kv_out2(PCb, cache_k, cache_v, o_p_k, o_p_v, o_s_k, o_s_v, vb - 1280);
    }
    GRID_BAR();
    GEMM_PHASE(EpiStoreF32, ABUF, WOUTC_T, D, Y1, D, b_out_c, NT, D);
    GRID_BAR();
    PHASE_LOOP(NT / 8) { const int t = vb * 8 + wave;
        ln_res_w(X2 + (size_t)t * D, Y1 + (size_t)t * D, ln_mix_g + D, ln_mix_b + D, X3 + (size_t)t * D, ABUF + (size_t)t * D, lane); }
    GRID_BAR();
    GEMM_PHASE(EpiStoreBf16, ABUF, WQ1_T, 2048, Qb, 2048, nullptr, NT, 2048);
    GRID_BAR();
    PHASE_LOOP((NT / 64) * 8) { peer_topk2(Qb, KEYSB + (size_t)8 * 2 * 128 * 128, R_EXP, R_GATE, vb >> 3, vb & 7, lds); }
    GRID_BAR();
    PHASE_LOOP(NT / 8) { const int t = vb * 8 + wave;
        peer_expert_w(X3 + (size_t)t * D, R_EXP + (size_t)t * 128, R_GATE + (size_t)t * 128, TAB8 + (size_t)2 * 16384 * D, TAB8 + (size_t)3 * 16384 * D, TSC + 2 * 16384, TSC + 3 * 16384, ln_ffn_g + D, ln_ffn_b + D, o_y + (size_t)t * D, nullptr, lane); }
}
}

extern "C" void kernel_launch(void* const* d_in, const int* in_sizes, int n_in,
                              void* d_out, int out_size, void* d_ws, size_t ws_size,
                              hipStream_t stream) {
    static int grid_blocks = 0;
    if (!grid_blocks) {
        int dev = 0, cus = 0, per_cu = 0;
        (void)hipGetDevice(&dev);
        (void)hipDeviceGetAttribute(&cus, hipDeviceAttributeMultiprocessorCount, dev);
        if (hipFuncSetAttribute((const void*)fwd_megakernel, hipFuncAttributeMaxDynamicSharedMemorySize, LDS_BYTES) != hipSuccess) { fprintf(stderr, "hipFuncSetAttribute failed\n"); grid_blocks = -1; return; }
        (void)hipOccupancyMaxActiveBlocksPerMultiprocessor(&per_cu, (const void*)fwd_megakernel, NTH, LDS_BYTES);
        if (per_cu < 1) { fprintf(stderr, "occupancy query says %d blocks per CU\n", per_cu); grid_blocks = -1; return; }
        grid_blocks = cus;
    }
    if (grid_blocks < 0) return;
    (void)hipMemsetAsync((char*)d_ws + WS_CTL, 0, CTL_ZERO_BYTES, stream);
    MegaArgs ma{};
    for (int i = 0; i < 35; ++i) ma.in[i] = (const float*)d_in[i];
    ma.out = (float*)d_out;
    ma.ws = (unsigned char*)d_ws;
    void* args[] = {&ma};
    hipError_t e = hipLaunchCooperativeKernel((void*)fwd_megakernel, dim3(grid_blocks), dim3(NTH), args, LDS_BYTES, stream);
    if (e != hipSuccess) fprintf(stderr, "cooperative launch failed: %s (grid %d)\n", hipGetErrorString(e), grid_blocks);
}
```

```cpp
#include <hip/hip_runtime.h>
#include <hip/hip_cooperative_groups.h>
#include <cstdio>
#include <cstdint>
namespace cg = cooperative_groups;

namespace pg8 {
#define PG8_LAS __attribute__((address_space(3)))
typedef unsigned short bf16_t;
typedef short bf16x8 __attribute__((ext_vector_type(8)));
typedef float f32x4 __attribute__((ext_vector_type(4)));
typedef unsigned u32x4 __attribute__((ext_vector_type(4)));
constexpr int BM = 256, BK = 64, HALF = 128, HTB = HALF * BK * 2  , STAGE_BYTES = 8 * HTB, NXCD = 8, WGM = 8;

__host__ __device__ __forceinline__ int lds_byte(int r, int c) { const int st = (r >> 4) * 2 + (c >> 5), rr = r & 15, cc = c & 31, ob = rr * 64 + cc * 2; return st * 1024 + (ob ^ (((ob >> 9) & 1) << 5)); }
__host__ __device__ __forceinline__ void stage_rc(int b, int& R, int& C) { const int st = b / 1024, sb = b % 1024, swz = sb ^ (((sb >> 9) & 1) << 5); R = (st >> 1) * 16 + swz / 64; C = (st & 1) * 32 + (swz % 64) / 2; }
__host__ __device__ __forceinline__ int perm32(int rho) { const int n = rho >> 4, i = rho & 15; return 8 * (i >> 2) + 4 * n + (i & 3); }

struct Unit { int pm, pn; };
struct Gemm { const bf16_t* A; const bf16_t* Bt; int M, N, K; };

struct StaticOrder {
    int nM, nN, nwg, G, c;
    __host__ __device__ void init(int M, int N, int G_, int c_) { nM = M / BM; nN = N / BM; nwg = nM * nN; G = G_; c = c_; }
    __host__ __device__ bool next(int i, Unit& u) const {
        const long L = (long)i * G + c; if (L >= nwg) return false;
        int wgid = (int)L; { const int q = nwg / NXCD, r = nwg % NXCD, xcd = wgid % NXCD, off = wgid / NXCD; wgid = (xcd < r ? xcd * (q + 1) : r * (q + 1) + (xcd - r) * q) + off; }
        const int nig = WGM * nN, gid = wgid / nig, fm = gid * WGM, gsz = (nM - fm) < WGM ? (nM - fm) : WGM;
        u.pm = fm + ((wgid % nig) % gsz); u.pn = (wgid % nig) / gsz; return true;
    }
    __device__ __forceinline__ void a_ready(const Unit&) const {}
    __device__ __forceinline__ void done(const Unit&) const {}
};

__device__ __forceinline__ unsigned cvt_pk_bf16(float lo, float hi) { unsigned r; asm volatile("v_cvt_pk_bf16_f32 %0, %1, %2" : "=v"(r) : "v"(lo), "v"(hi)); return r; }
template <class Epi, class Sched, bool ALIGN_EPI = false, bool SP2 = false>
__device__ __forceinline__ void gemm_phase(PG8_LAS unsigned char* lds, const Gemm g, const Sched& S, const Epi& E) {
    int tid_ = threadIdx.x; asm volatile("" : "+v"(tid_));
    const int tid = tid_, wid = __builtin_amdgcn_readfirstlane(tid >> 6), lane = tid & 63, wr = wid >> 2, wc = wid & 3, fr = lane & 15, fq = lane >> 4;
    const int K = g.K, nt = K / BK;
    unsigned voffA[2], voffB[2];
#pragma unroll
    for (int i = 0; i < 2; ++i) { int R, C; stage_rc(tid * 16 + i * 8192, R, C); const int Rb = Epi::PERM ? ((R & ~31) + perm32(R & 31)) : R;
        voffA[i] = (unsigned)(R * K + C) * 2u; voffB[i] = (unsigned)(Rb * K + C) * 2u; }
    const size_t kstep = (size_t)(BK * 2);
    const size_t hstep = (size_t)HALF * K * 2;
    const size_t tstep = 2 * hstep;
    const unsigned ldsw = (unsigned)wid * 1024u;
    const int aoff = lds_byte(wr * 64 + fr, fq * 8), boff = lds_byte(wc * 32 + fr, fq * 8);
#define PG8_SA(b, h) (((b) * 2 + (h)) * HTB)
#define PG8_SB(b, h) ((4 + (b) * 2 + (h)) * HTB)
#define PG8_STAGE(bufoff, gbase, voff) do { _Pragma("unroll") for (int _i = 0; _i < 2; ++_i) \
        __builtin_amdgcn_global_load_lds((const unsigned*)((const char*)(gbase) + (voff)[_i]), (PG8_LAS unsigned*)(lds + (bufoff) + ldsw + _i * 8192), 16, 0, 0); } while (0)
#define PG8_LDA(dst, b, h) do { _Pragma("unroll") for (int m = 0; m < 4; ++m) _Pragma("unroll") for (int k = 0; k < 2; ++k) dst[m][k] = *(const PG8_LAS bf16x8*)(lds + PG8_SA(b, h) + aoff + m * 2048 + k * 1024); } while (0)
#define PG8_LDB(dst, b, h) do { _Pragma("unroll") for (int n = 0; n < 2; ++n) _Pragma("unroll") for (int k = 0; k < 2; ++k) dst[n][k] = *(const PG8_LAS bf16x8*)(lds + PG8_SB(b, h) + boff + n * 2048 + k * 1024); } while (0)
#define PG8_MMA(ai, bj, At, Bt) do { __builtin_amdgcn_s_setprio(1); _Pragma("unroll") for (int m = 0; m < 4; ++m) _Pragma("unroll") for (int n = 0; n < 2; ++n) _Pragma("unroll") for (int k = 0; k < 2; ++k) \
        acc[ai][bj][m][n] = __builtin_amdgcn_mfma_f32_16x16x32_bf16(Bt[n][k], At[m][k], acc[ai][bj][m][n], 0, 0, 0); __builtin_amdgcn_s_setprio(0); } while (0)
#define PG8_WAIT_V(n) asm volatile("s_waitcnt vmcnt(" #n ")" ::: "memory")
#define PG8_WAIT_L(n) asm volatile("s_waitcnt lgkmcnt(" #n ")" ::: "memory")
#define PG8_BAR __builtin_amdgcn_s_barrier()
#define PG8_SCHED __builtin_amdgcn_sched_barrier(0)
    Unit cur, nxt; int ui = 0;
    if (!S.next(0, cur)) return;
    f32x4 acc[2][2][4][2];
#pragma unroll
    for (int a = 0; a < 2; ++a)
#pragma unroll
        for (int b = 0; b < 2; ++b)
#pragma unroll
            for (int m = 0; m < 4; ++m)
#pragma unroll
                for (int n = 0; n < 2; ++n) acc[a][b][m][n] = (f32x4){0.f, 0.f, 0.f, 0.f};
    bf16x8 At[4][2], B0[2][2], B1[2][2];
    const char* cA = (const char*)g.A + (size_t)cur.pm * tstep; const char* cB = (const char*)g.Bt + (size_t)cur.pn * tstep;
    S.a_ready(cur);
    if constexpr (SP2) {
        PG8_STAGE(PG8_SB(0, 0), cB, voffB); PG8_STAGE(PG8_SB(0, 1), cB + hstep, voffB); PG8_STAGE(PG8_SA(0, 0), cA, voffA); PG8_STAGE(PG8_SA(0, 1), cA + hstep, voffA);
        if (wr == 1) PG8_BAR;
        PG8_WAIT_V(2); PG8_BAR;
        PG8_STAGE(PG8_SB(1, 0), cB + kstep, voffB); PG8_STAGE(PG8_SA(1, 0), cA + kstep, voffA); PG8_STAGE(PG8_SB(1, 1), cB + hstep + kstep, voffB);
        PG8_WAIT_V(6); PG8_BAR;
    } else {
        PG8_STAGE(PG8_SB(0, 0), cB, voffB); PG8_STAGE(PG8_SA(0, 0), cA, voffA); PG8_STAGE(PG8_SB(0, 1), cB + hstep, voffB); PG8_STAGE(PG8_SA(0, 1), cA + hstep, voffA);
        if (wr == 1) PG8_BAR;
        PG8_WAIT_V(4); PG8_BAR;
        PG8_STAGE(PG8_SB(1, 0), cB + kstep, voffB); PG8_STAGE(PG8_SA(1, 0), cA + kstep, voffA); PG8_STAGE(PG8_SB(1, 1), cB + hstep + kstep, voffB);
        PG8_WAIT_V(6); PG8_BAR;
    }
    for (;;) {
        const bool has_next = S.next(ui + 1, nxt);
        const char* nA = has_next ? (const char*)g.A + (size_t)nxt.pm * tstep : cA; const char* nB = has_next ? (const char*)g.Bt + (size_t)nxt.pn * tstep : cB;
        for (int t = 0; t < nt; t += 2) {
            const bool last = (t == nt - 2);
            const char* a1 = cA + (size_t)(t + 1) * kstep;
            const char* a2 = last ? nA : cA + (size_t)(t + 2) * kstep; const char* b2 = last ? nB : cB + (size_t)(t + 2) * kstep;
            const char* a3 = a2 + kstep; const char* b3 = b2 + kstep;
            if (last && has_next) S.a_ready(nxt);
            if constexpr (SP2) {
            PG8_LDB(B0, 0, 0); PG8_LDB(B1, 0, 1); PG8_SCHED; PG8_LDA(At, 0, 0); PG8_STAGE(PG8_SA(1, 1), a1 + hstep, voffA);
            PG8_WAIT_V(8); PG8_WAIT_L(0); PG8_BAR; PG8_MMA(0, 0, At, B0); PG8_MMA(0, 1, At, B1); PG8_BAR; PG8_SCHED;
            PG8_LDA(At, 0, 1); PG8_STAGE(PG8_SB(0, 0), b2, voffB); PG8_STAGE(PG8_SB(0, 1), b2 + hstep, voffB); PG8_STAGE(PG8_SA(0, 0), a2, voffA);
            PG8_WAIT_V(8); PG8_WAIT_L(0); PG8_BAR; PG8_MMA(1, 0, At, B0); PG8_MMA(1, 1, At, B1); PG8_BAR; PG8_SCHED;
            PG8_LDB(B0, 1, 0); PG8_LDB(B1, 1, 1); PG8_SCHED; PG8_LDA(At, 1, 0); PG8_STAGE(PG8_SA(0, 1), a2 + hstep, voffA);
            PG8_WAIT_V(8); PG8_WAIT_L(0); PG8_BAR; PG8_MMA(0, 0, At, B0); PG8_MMA(0, 1, At, B1); PG8_BAR; PG8_SCHED;
            PG8_LDA(At, 1, 1); PG8_STAGE(PG8_SB(1, 0), b3, voffB); PG8_STAGE(PG8_SB(1, 1), b3 + hstep, voffB); PG8_STAGE(PG8_SA(1, 0), a3, voffA);
            PG8_WAIT_V(8); PG8_WAIT_L(0); PG8_BAR; PG8_MMA(1, 0, At, B0); PG8_MMA(1, 1, At, B1); PG8_BAR; PG8_SCHED;
            } else {
            PG8_LDB(B0, 0, 0); PG8_SCHED; PG8_LDA(At, 0, 0); PG8_STAGE(PG8_SA(1, 1), a1 + hstep, voffA);
            PG8_WAIT_L(8); PG8_BAR; PG8_WAIT_L(0); PG8_MMA(0, 0, At, B0); PG8_BAR; PG8_SCHED;
            PG8_LDB(B1, 0, 1); PG8_STAGE(PG8_SB(0, 0), b2, voffB);
            PG8_BAR; PG8_WAIT_L(0); PG8_MMA(0, 1, At, B1); PG8_BAR;
            PG8_LDA(At, 0, 1); PG8_STAGE(PG8_SA(0, 0), a2, voffA);
            PG8_BAR; PG8_WAIT_L(0); PG8_MMA(1, 0, At, B0); PG8_BAR; PG8_SCHED;
            PG8_STAGE(PG8_SB(0, 1), b2 + hstep, voffB);
            PG8_WAIT_V(6); PG8_BAR; PG8_MMA(1, 1, At, B1); PG8_BAR;
            PG8_LDB(B0, 1, 0); PG8_SCHED; PG8_LDA(At, 1, 0); PG8_STAGE(PG8_SA(0, 1), a2 + hstep, voffA);
            PG8_WAIT_L(8); PG8_BAR; PG8_WAIT_L(0); PG8_MMA(0, 0, At, B0); PG8_BAR; PG8_SCHED;
            PG8_LDB(B1, 1, 1); PG8_STAGE(PG8_SB(1, 0), b3, voffB);
            PG8_BAR; PG8_WAIT_L(0); PG8_MMA(0, 1, At, B1); PG8_BAR;
            PG8_LDA(At, 1, 1); PG8_STAGE(PG8_SA(1, 0), a3, voffA);
            PG8_BAR; PG8_WAIT_L(0); PG8_MMA(1, 0, At, B0); PG8_BAR; PG8_SCHED;
            PG8_STAGE(PG8_SB(1, 1), b3 + hstep, voffB);
            PG8_WAIT_V(6); PG8_BAR; PG8_MMA(1, 1, At, B1); PG8_BAR;
            }
        }
        if constexpr (ALIGN_EPI) { if (wr == 0) PG8_BAR; }
        if constexpr (!Epi::AFTER_DRAIN) { E(acc, cur, wr, wc, fr, fq); S.done(cur); }
        if (!has_next) break;
#pragma unroll
        for (int a = 0; a < 2; ++a)
#pragma unroll
            for (int b = 0; b < 2; ++b)
#pragma unroll
                for (int m = 0; m < 4; ++m)
#pragma unroll
                    for (int n = 0; n < 2; ++n) acc[a][b][m][n] = (f32x4){0.f, 0.f, 0.f, 0.f};
        cur = nxt; cA = nA; cB = nB; ++ui;
        if constexpr (ALIGN_EPI) { if (wr == 1) PG8_BAR; }
    }
    PG8_WAIT_V(0);
    if constexpr (!ALIGN_EPI) { if (wr == 0) PG8_BAR; }
    PG8_BAR;
    if constexpr (Epi::AFTER_DRAIN) { E.fused(acc, cur, wr, wc, fr, fq, lds, wid, lane); S.done(cur); }
#undef PG8_SA
#undef PG8_SB
#undef PG8_STAGE
#undef PG8_LDA
#undef PG8_LDB
#undef PG8_MMA
#undef PG8_WAIT_V
#undef PG8_WAIT_L
#undef PG8_BAR
#undef PG8_SCHED
}
}
namespace pg8 {
struct EpiStoreBf16 {
    static constexpr bool PERM = true, AFTER_DRAIN = false;
    bf16_t* O; int ldc; const float* bias; int m_real, n_real;
    __device__ __forceinline__ void operator()(const f32x4 (&acc)[2][2][4][2], const Unit& u, int wr, int wc, int fr, int fq) const {
        const int row0 = u.pm * BM + wr * 64 + fr, col0 = u.pn * BM + wc * 32 + 8 * fq;
#pragma unroll
        for (int bj = 0; bj < 2; ++bj) {
            const int col = col0 + bj * HALF;
            if (col >= n_real) continue;
            f32x4 b0 = (f32x4){0.f, 0.f, 0.f, 0.f}, b1 = b0;
            if (bias) { b0 = *(const f32x4*)(bias + col); b1 = *(const f32x4*)(bias + col + 4); }
#pragma unroll
            for (int ai = 0; ai < 2; ++ai)
#pragma unroll
                for (int m = 0; m < 4; ++m) {
                    const int row = row0 + ai * HALF + m * 16;
                    if (row >= m_real) continue;
                    const f32x4 v0 = acc[ai][bj][m][0] + b0, v1 = acc[ai][bj][m][1] + b1;
                    u32x4 w; w.x = cvt_pk_bf16(v0[0], v0[1]); w.y = cvt_pk_bf16(v0[2], v0[3]); w.z = cvt_pk_bf16(v1[0], v1[1]); w.w = cvt_pk_bf16(v1[2], v1[3]);
                    *(u32x4*)(O + (size_t)row * ldc + col) = w;
                }
        }
    }
};
struct EpiStoreF32 {
    static constexpr bool PERM = false, AFTER_DRAIN = false;
    float* O; int ldc; const float* bias; int m_real, n_real;
    __device__ __forceinline__ void operator()(const f32x4 (&acc)[2][2][4][2], const Unit& u, int wr, int wc, int fr, int fq) const {
        const int row0 = u.pm * BM + wr * 64 + fr, col0 = u.pn * BM + wc * 32 + 4 * fq;
#pragma unroll
        for (int bj = 0; bj < 2; ++bj)
#pragma unroll
            for (int n = 0; n < 2; ++n) {
                const int col = col0 + bj * HALF + n * 16;
                if (col >= n_real) continue;
                const f32x4 bv = bias ? *(const f32x4*)(bias + col) : (f32x4){0.f, 0.f, 0.f, 0.f};
#pragma unroll
                for (int ai = 0; ai < 2; ++ai)
#pragma unroll
                    for (int m = 0; m < 4; ++m) {
                        const int row = row0 + ai * HALF + m * 16;
                        if (row >= m_real) continue;
                        *(f32x4*)(O + (size_t)row * ldc + col) = acc[ai][bj][m][n] + bv;
                    }
            }
    }
};
}
namespace {
#define GAS __attribute__((address_space(1)))
#define LAS __attribute__((address_space(3)))
typedef unsigned short bf16;
typedef float f32x4 __attribute__((ext_vector_type(4)));
typedef unsigned v4u __attribute__((ext_vector_type(4)));
typedef unsigned v2u __attribute__((ext_vector_type(2)));

constexpr int D = 1024, NB = 4, SEQ = 4096, NP = NB * SEQ, NS = 128, NT = NP + NS, MP = 16640;
constexpr int ABN = 3080, ABNP = 3328;
constexpr int C_QKV = 0, C_Z = 1536, C_A = 2048, C_B = 2052, C_XR = 2056, C_GATE = 2568;
constexpr int CN = 1536;
constexpr float ALPHA = 1.4142135623730951f;
constexpr float LN_EPS = 1e-5f;
constexpr int NTH = 512, NWAVES = 8;
constexpr int RING_BYTES = 131072, MISC_OFF = RING_BYTES + 320, LDS_BYTES = 147456;

__device__ __forceinline__ float bf2f(bf16 v) { return __uint_as_float((unsigned)v << 16); }
__device__ __forceinline__ unsigned f2bf(float f) { unsigned u = __float_as_uint(f); return (u + 0x7fffu + ((u >> 16) & 1u)) >> 16; }
__device__ __forceinline__ unsigned pk2(float lo, float hi) { return f2bf(lo) | (f2bf(hi) << 16); }
__device__ __forceinline__ float sigmoidf_(float x) { return 1.0f / (1.0f + expf(-x)); }
__device__ __forceinline__ float softplusf_(float x) { return fmaxf(x, 0.f) + log1pf(expf(-fabsf(x))); }
__device__ __forceinline__ float siluf_(float x) { return x / (1.0f + expf(-x)); }
__device__ __forceinline__ float geluf_(float x) { return 0.5f * x * (1.0f + tanhf(0.7978845608028654f * (x + 0.044715f * x * x * x))); }
__device__ __forceinline__ float wave_sum(float v) {
#pragma unroll
    for (int o = 32; o > 0; o >>= 1) v += __shfl_xor(v, o);
    return v;
}
__device__ __forceinline__ float wave_max(float v) {
#pragma unroll
    for (int o = 32; o > 0; o >>= 1) v = fmaxf(v, __shfl_xor(v, o));
    return v;
}

__device__ __forceinline__ void p0_transpose_item(const float* __restrict__ W, int K, int N, bf16* __restrict__ WT, float* scr, int item, int lane) {
    const int nblk = (N + 31) / 32, kb = item / nblk, nb = item % nblk, k0 = 64 * kb, n0 = 32 * nb;
#pragma unroll 8
    for (int i = 0; i < 32; ++i) { const int kk = 2 * i + (lane >> 5), n = n0 + (lane & 31); scr[kk * 33 + (lane & 31)] = n < N ? W[(size_t)(k0 + kk) * N + n] : 0.f; }
    asm volatile("s_waitcnt lgkmcnt(0)" ::: "memory");
    const int c = lane & 7;
#pragma unroll
    for (int j = 0; j < 4; ++j) { const int n = (lane >> 3) + 8 * j; const float* s = scr + (8 * c) * 33 + n;
        v4u o; o.x = pk2(s[0 * 33], s[1 * 33]); o.y = pk2(s[2 * 33], s[3 * 33]); o.z = pk2(s[4 * 33], s[5 * 33]); o.w = pk2(s[6 * 33], s[7 * 33]);
        *(v4u*)(WT + (size_t)(n0 + n) * K + k0 + 8 * c) = o; }
    asm volatile("s_waitcnt lgkmcnt(0)" ::: "memory");
}
__device__ __forceinline__ void row_to_bf16(const float* __restrict__ xrow, bf16* __restrict__ orow, int lane) {
#pragma unroll
    for (int j = 0; j < 4; ++j) {
        f32x4 v = (f32x4){0.f, 0.f, 0.f, 0.f};
        if (xrow) v = ((const f32x4*)xrow)[lane + 64 * j];
        v2u o; o.x = pk2(v.x, v.y); o.y = pk2(v.z, v.w);
        ((v2u*)orow)[lane + 64 * j] = o;
    }
}

struct AbPrepArgs {
    const bf16* PROJ; const float* st_gdn_conv; const float* st_lru_conv;
    const float* gdn_conv_w; const float* a_log; const float* dt_bias;
    const float* lru_conv_w; const float* lru_conv_b; const float* w_r; const float* b_r; const float* w_i; const float* b_i; const float* lam;
    float* QKV; float* G; float* BETA; float* LA; float* LB;
    float* p_gdn_conv; float* p_lru_conv; float* s_gdn_conv; float* s_lru_conv;
};
__device__ __forceinline__ void ab_prep(const AbPrepArgs& a, int t, float* smem) {
    int tid = threadIdx.x; asm volatile("" : "+v"(tid));
    const int lane = tid & 63, wid = tid >> 6;
    const bool samp = t >= NP; const int sb = t - NP, pos = t % SEQ, b = t / SEQ;
    float* sq = smem;
    float* sx = smem + 1536;
    float* scl = smem + 2048;
    const bf16* prow = a.PROJ + (size_t)t * ABN;
    for (int c = tid; c < 1536; c += NTH) {
        float acc = 0.f;
#pragma unroll
        for (int i = 0; i < 4; ++i) {
            float xv;
            if (i == 3) xv = bf2f(prow[C_QKV + c]);
            else if (samp) xv = a.st_gdn_conv[((size_t)sb * 3 + i) * 1536 + c];
            else xv = (pos - 3 + i >= 0) ? bf2f(a.PROJ[(size_t)(t - 3 + i) * ABN + C_QKV + c]) : 0.f;
            acc += a.gdn_conv_w[i * 1536 + c] * xv;
        }
        sq[c] = siluf_(acc);
    }
    {
        const int c = tid;
        float acc = a.lru_conv_b[c];
#pragma unroll
        for (int i = 0; i < 4; ++i) {
            float xv;
            if (i == 3) xv = bf2f(prow[C_XR + c]);
            else if (samp) xv = a.st_lru_conv[((size_t)sb * 3 + i) * 512 + c];
            else xv = (pos - 3 + i >= 0) ? bf2f(a.PROJ[(size_t)(t - 3 + i) * ABN + C_XR + c]) : 0.f;
            acc += a.lru_conv_w[i * 512 + c] * xv;
        }
        sx[c] = acc;
    }
    __syncthreads();
    {
        const int grp = wid;
        const float v0 = sq[grp * 128 + lane], v1 = sq[grp * 128 + 64 + lane];
        const float s = wave_sum(v0 * v0 + v1 * v1);
        if (lane == 0) scl[grp] = rsqrtf(s + 1e-6f) * (grp < 4 ? 0.08838834764831845f : 1.0f);
    }
    __syncthreads();
    for (int c = tid; c < 1536; c += NTH) a.QKV[(size_t)t * 1536 + c] = (c < 1024) ? sq[c] * scl[c >> 7] : sq[c];
    if (tid < 4) {
        const float a_raw = bf2f(prow[C_A + tid]), b_raw = bf2f(prow[C_B + tid]);
        a.G[(size_t)t * 4 + tid] = -expf(a.a_log[tid]) * softplusf_(a_raw + a.dt_bias[tid]);
        a.BETA[(size_t)t * 4 + tid] = sigmoidf_(b_raw);
    }
    if (!samp) {
        if (pos >= SEQ - 3) {
            const int row = pos - (SEQ - 3);
            for (int c = tid; c < 1536; c += NTH) a.p_gdn_conv[((size_t)b * 3 + row) * 1536 + c] = bf2f(prow[C_QKV + c]);
            a.p_lru_conv[((size_t)b * 3 + row) * 512 + tid] = bf2f(prow[C_XR + tid]);
        }
    } else {
        for (int c = tid; c < 1536; c += NTH) {
            a.s_gdn_conv[((size_t)sb * 3 + 0) * 1536 + c] = a.st_gdn_conv[((size_t)sb * 3 + 1) * 1536 + c];
            a.s_gdn_conv[((size_t)sb * 3 + 1) * 1536 + c] = a.st_gdn_conv[((size_t)sb * 3 + 2) * 1536 + c];
            a.s_gdn_conv[((size_t)sb * 3 + 2) * 1536 + c] = bf2f(prow[C_QKV + c]);
        }
        {
            const int c = tid;
            a.s_lru_conv[((size_t)sb * 3 + 0) * 512 + c] = a.st_lru_conv[((size_t)sb * 3 + 1) * 512 + c];
            a.s_lru_conv[((size_t)sb * 3 + 1) * 512 + c] = a.st_lru_conv[((size_t)sb * 3 + 2) * 512 + c];
            a.s_lru_conv[((size_t)sb * 3 + 2) * 512 + c] = bf2f(prow[C_XR + c]);
        }
    }
    {
        const int c = tid, n = c >> 6, d = c & 63;
        float r = a.b_r[c], ii = a.b_i[c];
#pragma unroll 4
        for (int cc = 0; cc < 64; ++cc) {
            const float xv = sx[n * 64 + cc];
            r += xv * a.w_r[((size_t)n * 64 + cc) * 64 + d];
            ii += xv * a.w_i[((size_t)n * 64 + cc) * 64 + d];
        }
        r = sigmoidf_(r); ii = sigmoidf_(ii);
        const float log_a = -8.0f * r * softplusf_(-a.lam[c]);
        a.LA[(size_t)t * 512 + c] = expf(log_a);
        a.LB[(size_t)t * 512 + c] = sqrtf(-expm1f(2.0f * log_a)) * (ii * sx[c]);
    }
}

__device__ __forceinline__ void gdn_scan(const float* __restrict__ QKV, const float* __restrict__ G, const float* __restrict__ BETA,
                                         const float* __restrict__ S0, float* __restrict__ O, float* __restrict__ Sout, int tok_base, int T,
                                         int sl, int h, int sq, float* smem) {
    int tid = threadIdx.x; asm volatile("" : "+v"(tid));
    const int dvl = tid & 31, kg = tid >> 5;
    const int dv = sl * 32 + dvl;
    float (*red1)[32] = (float (*)[32])smem;
    float (*red2)[32] = (float (*)[32])(smem + 512);
    float S[8];
#pragma unroll
    for (int i = 0; i < 8; ++i) S[i] = S0 ? S0[(((size_t)sq * 4 + h) * 128 + kg * 8 + i) * 128 + dv] : 0.f;
    float kk[8], qq[8], vv, g, be;
    {
        const size_t tok = (size_t)tok_base + (size_t)sq * T;
        const float* row = QKV + tok * 1536;
#pragma unroll
        for (int i = 0; i < 8; ++i) { kk[i] = row[512 + h * 128 + kg * 8 + i]; qq[i] = row[h * 128 + kg * 8 + i]; }
        vv = row[1024 + h * 128 + dv]; g = G[tok * 4 + h]; be = BETA[tok * 4 + h];
    }
    for (int t = 0; t < T; ++t) {
        const size_t tok = (size_t)tok_base + (size_t)sq * T + t;
        float nk[8], nq[8], nv = 0.f, ng = 0.f, nb = 0.f;
        if (t + 1 < T) {
            const float* row = QKV + (tok + 1) * 1536;
#pragma unroll
            for (int i = 0; i < 8; ++i) { nk[i] = row[512 + h * 128 + kg * 8 + i]; nq[i] = row[h * 128 + kg * 8 + i]; }
            nv = row[1024 + h * 128 + dv]; ng = G[(tok + 1) * 4 + h]; nb = BETA[(tok + 1) * 4 + h];
        } else {
#pragma unroll
            for (int i = 0; i < 8; ++i) { nk[i] = 0.f; nq[i] = 0.f; }
        }
        const float al = expf(g);
        float p = 0.f;
#pragma unroll
        for (int i = 0; i < 8; ++i) { S[i] *= al; p += S[i] * kk[i]; }
        red1[kg][dvl] = p;
        __syncthreads();
        float ks = 0.f;
#pragma unroll
        for (int j = 0; j < 16; ++j) ks += red1[j][dvl];
        const float vn = be * (vv - ks);
        float o = 0.f;
#pragma unroll
        for (int i = 0; i < 8; ++i) { S[i] += kk[i] * vn; o += S[i] * qq[i]; }
        red2[kg][dvl] = o;
        __syncthreads();
        if (kg == 0) {
            float os = 0.f;
#pragma unroll
            for (int j = 0; j < 16; ++j) os += red2[j][dvl];
            O[tok * 512 + h * 128 + dv] = os;
        }
#pragma unroll
        for (int i = 0; i < 8; ++i) { kk[i] = nk[i]; qq[i] = nq[i]; }
        vv = nv; g = ng; be = nb;
    }
#pragma unroll
    for (int i = 0; i < 8; ++i) Sout[(((size_t)sq * 4 + h) * 128 + kg * 8 + i) * 128 + dv] = S[i];
}

__device__ __forceinline__ void lru_scan(const float* __restrict__ LA, float* __restrict__ LB, const float* __restrict__ h0,
                                         float* __restrict__ hlast, int tok_base, int T, int nseq, int bx) {
    int tx_ = threadIdx.x; asm volatile("" : "+v"(tx_));
    const int idx = bx * NTH + tx_;
    if (idx >= nseq * 512) return;
    const int sq = idx / 512, c = idx % 512;
    float h = h0 ? h0[(size_t)sq * 512 + c] : 0.f;
    const size_t base = ((size_t)tok_base + (size_t)sq * T) * 512 + c;
#pragma unroll 8
    for (int t = 0; t < T; ++t) {
        const size_t o = base + (size_t)t * 512;
        h = LA[o] * h + LB[o];
        LB[o] = h;
    }
    hlast[(size_t)sq * 512 + c] = h;
}

__device__ __forceinline__ void ab_mix(const bf16* __restrict__ PROJ, const float* __restrict__ O, const float* __restrict__ H, const float* __restrict__ P, const float* __restrict__ CIN,
                                       const float* __restrict__ norm_w, bf16* __restrict__ MIX, int vb) {
    int tx_ = threadIdx.x; asm volatile("" : "+v"(tx_));
    const int tid = tx_ & 255, lane = tid & 63, wid = tid >> 6, t = vb * 2 + (tx_ >> 8);
    const bf16* prow = PROJ + (size_t)t * ABN;
    {
        const int h = wid;
        const float o0 = O[(size_t)t * 512 + h * 128 + lane], o1 = O[(size_t)t * 512 + h * 128 + 64 + lane];
        const float ms = wave_sum(o0 * o0 + o1 * o1) * (1.0f / 128.0f);
        const float sc = rsqrtf(ms + 1e-6f);
        MIX[(size_t)t * 1024 + h * 128 + lane] = (bf16)f2bf(o0 * sc * norm_w[lane] * siluf_(bf2f(prow[C_Z + h * 128 + lane])));
        MIX[(size_t)t * 1024 + h * 128 + 64 + lane] = (bf16)f2bf(o1 * sc * norm_w[64 + lane] * siluf_(bf2f(prow[C_Z + h * 128 + 64 + lane])));
    }
    for (int c = tid; c < 512; c += 256) {
        float hv = H[(size_t)t * 512 + c];
        if (t < NP) hv += P[(size_t)t * 512 + c] * CIN[(size_t)(t >> 6) * 512 + c];
        MIX[(size_t)t * 1024 + 512 + c] = (bf16)f2bf(geluf_(bf2f(prow[C_GATE + c])) * hv);
    }
}

__device__ __forceinline__ void ln_res_w(const float* __restrict__ xrow, const float* __restrict__ yrow, const float* __restrict__ g, const float* __restrict__ bta,
                                         float* __restrict__ orow, bf16* __restrict__ obrow, int lane) {
    f32x4 v[4]; float s = 0.f;
#pragma unroll
    for (int j = 0; j < 4; ++j) { const f32x4 x4 = ((const f32x4*)xrow)[lane + 64 * j], y4 = ((const f32x4*)yrow)[lane + 64 * j]; v[j] = x4 * ALPHA + y4; s += (v[j].x + v[j].y) + (v[j].z + v[j].w); }
    const float mean = wave_sum(s) * (1.0f / 1024.0f); float q = 0.f;
#pragma unroll
    for (int j = 0; j < 4; ++j) { v[j] = v[j] - mean; q += (v[j].x * v[j].x + v[j].y * v[j].y) + (v[j].z * v[j].z + v[j].w * v[j].w); }
    const float rs = rsqrtf(wave_sum(q) * (1.0f / 1024.0f) + LN_EPS);
#pragma unroll
    for (int j = 0; j < 4; ++j) {
        const f32x4 g4 = ((const f32x4*)g)[lane + 64 * j], b4 = ((const f32x4*)bta)[lane + 64 * j];
        const f32x4 o = v[j] * rs * g4 + b4;
        ((f32x4*)orow)[lane + 64 * j] = o;
        v2u ob; ob.x = pk2(o.x, o.y); ob.y = pk2(o.z, o.w);
        ((v2u*)obrow)[lane + 64 * j] = ob;
    }
}

__device__ __forceinline__ void peer_topk(const bf16* __restrict__ Q, const float* __restrict__ keys, int* __restrict__ EXP, float* __restrict__ GATE,
                                          int tg, int h, float* smem) {
    const int tid = threadIdx.x, cn = tid & 255, c = cn >> 7, n = cn & 127, th = tid >> 8;
    float (*sq)[256] = (float (*)[256])smem;
    float (*ss)[257] = (float (*)[257])(smem + 32 * 256);
    float (*tvs)[2][16] = (float (*)[2][16])(smem + 32 * 256 + 32 * 257 + 32);
    int (*tis)[2][16] = (int (*)[2][16])(smem + 32 * 256 + 32 * 257 + 32 + 1024);
    for (int i = tid; i < 32 * 256; i += NTH) {
        const int tk = i >> 8, col = i & 255;
        sq[tk][col] = bf2f(Q[(size_t)(tg * 32 + tk) * 2048 + h * 256 + col]);
    }
    __syncthreads();
    float acc[16];
#pragma unroll
    for (int i = 0; i < 16; ++i) acc[i] = 0.f;
    const float* krow = keys + (((size_t)h * 2 + c) * 128 + n) * 128;
    for (int d4 = 0; d4 < 32; ++d4) {
        const float4 kv = *(const float4*)(krow + d4 * 4);
#pragma unroll
        for (int tk = 0; tk < 16; ++tk) {
            const float4 qv = *(const float4*)&sq[th * 16 + tk][c * 128 + d4 * 4];
            acc[tk] += qv.x * kv.x + qv.y * kv.y + qv.z * kv.z + qv.w * kv.w;
        }
    }
#pragma unroll
    for (int tk = 0; tk < 16; ++tk) ss[th * 16 + tk][cn] = acc[tk];
    __syncthreads();
    if (tid < 64) {
        const int tk = tid >> 1, cc = tid & 1;
        float tv[16]; int ti[16];
#pragma unroll
        for (int j = 0; j < 16; ++j) { tv[j] = -INFINITY; ti[j] = 0; }
        for (int nn = 0; nn < 128; ++nn) {
            float x = ss[tk][cc * 128 + nn]; int xi = nn;
#pragma unroll
            for (int j = 0; j < 16; ++j) {
                const bool gt = x > tv[j];
                const float tf = tv[j]; const int tj = ti[j];
                tv[j] = gt ? x : tf; ti[j] = gt ? xi : tj;
                x = gt ? tf : x; xi = gt ? tj : xi;
            }
        }
#pragma unroll
        for (int j = 0; j < 16; ++j) { tvs[tk][cc][j] = tv[j]; tis[tk][cc][j] = ti[j]; }
    }
    __syncthreads();
    if (tid < 32) {
        const int tk = tid;
        float bv[16]; int bi[16];
#pragma unroll
        for (int j = 0; j < 16; ++j) { bv[j] = -INFINITY; bi[j] = 0; }
        for (int i = 0; i < 16; ++i)
            for (int jj = 0; jj < 16; ++jj) {
                float x = tvs[tk][0][i] + tvs[tk][1][jj]; int xi = tis[tk][0][i] * 128 + tis[tk][1][jj];
#pragma unroll
                for (int j = 0; j < 16; ++j) {
                    const bool gt = x > bv[j];
                    const float tf = bv[j]; const int tj = bi[j];
                    bv[j] = gt ? x : tf; bi[j] = gt ? xi : tj;
                    x = gt ? tf : x; xi = gt ? tj : xi;
                }
            }
        float e[16], sum = 0.f;
#pragma unroll
        for (int j = 0; j < 16; ++j) { e[j] = expf(bv[j] - bv[0]); sum += e[j]; }
        const float inv = 1.0f / sum;
        const size_t o = (size_t)(tg * 32 + tk) * 128 + h * 16;
#pragma unroll
        for (int j = 0; j < 16; ++j) { EXP[o + j] = bi[j]; GATE[o + j] = e[j] * inv; }
    }
}

__device__ __forceinline__ void peer_expert(const float* __restrict__ X, const int* __restrict__ EXP, const float* __restrict__ GATE,
                                            const float* __restrict__ U, const float* __restrict__ V,
                                            const float* __restrict__ g, const float* __restrict__ bta, float* __restrict__ out, bf16* __restrict__ outb, int t, float* smem) {
    const int tid = threadIdx.x, lane = tid & 63, wid = tid >> 6;
    float (*accs)[1024] = (float (*)[1024])smem;
    float* sred = smem + 8192;
    const float4* xr = (const float4*)(X + (size_t)t * D);
    float4 xv[4];
#pragma unroll
    for (int j = 0; j < 4; ++j) xv[j] = xr[lane + 64 * j];
    float4 acc[4];
#pragma unroll
    for (int j = 0; j < 4; ++j) acc[j] = make_float4(0.f, 0.f, 0.f, 0.f);
    for (int e = 0; e < 16; ++e) {
        const int id = EXP[(size_t)t * 128 + wid * 16 + e];
        const float gt = GATE[(size_t)t * 128 + wid * 16 + e];
        const float4* ur = (const float4*)(U + (size_t)id * D);
        const float4* vr = (const float4*)(V + (size_t)id * D);
        float4 uv[4], vv[4];
#pragma unroll
        for (int j = 0; j < 4; ++j) { uv[j] = ur[lane + 64 * j]; vv[j] = vr[lane + 64 * j]; }
        float dot = 0.f;
#pragma unroll
        for (int j = 0; j < 4; ++j) dot += uv[j].x * xv[j].x + uv[j].y * xv[j].y + uv[j].z * xv[j].z + uv[j].w * xv[j].w;
        dot = wave_sum(dot);
        const float cf = gt * geluf_(dot);
#pragma unroll
        for (int j = 0; j < 4; ++j) { acc[j].x += cf * vv[j].x; acc[j].y += cf * vv[j].y; acc[j].z += cf * vv[j].z; acc[j].w += cf * vv[j].w; }
    }
#pragma unroll
    for (int j = 0; j < 4; ++j) *(float4*)&accs[wid][(lane + 64 * j) * 4] = acc[j];
    __syncthreads();
    float v[2];
#pragma unroll
    for (int i = 0; i < 2; ++i) {
        const int c = tid * 2 + i;
        float s = 0.f;
#pragma unroll
        for (int w = 0; w < 8; ++w) s += accs[w][c];
        v[i] = ALPHA * X[(size_t)t * D + c] + s;
    }
    float s = wave_sum(v[0] + v[1]);
    if (lane == 0) sred[wid] = s;
    __syncthreads();
    float mean = 0.f;
#pragma unroll
    for (int w = 0; w < 8; ++w) mean += sred[w];
    mean *= (1.0f / 1024.0f);
    __syncthreads();
    const float d0 = v[0] - mean, d1 = v[1] - mean;
    float q = wave_sum(d0 * d0 + d1 * d1);
    if (lane == 0) sred[wid] = q;
    __syncthreads();
    float var = 0.f;
#pragma unroll
    for (int w = 0; w < 8; ++w) var += sred[w];
    const float rs = rsqrtf(var * (1.0f / 1024.0f) + LN_EPS);
    const float o0 = d0 * rs * g[tid * 2] + bta[tid * 2], o1 = d1 * rs * g[tid * 2 + 1] + bta[tid * 2 + 1];
    *(float2*)(out + (size_t)t * D + tid * 2) = make_float2(o0, o1);
    if (outb) *(unsigned*)(outb + (size_t)t * D + tid * 2) = pk2(o0, o1);
}


typedef __bf16 bf16x2_t __attribute__((ext_vector_type(2)));
__device__ __forceinline__ float dot2bf(unsigned w, unsigned x, float acc) { return __builtin_amdgcn_fdot2_f32_bf16(__builtin_bit_cast(bf16x2_t, w), __builtin_bit_cast(bf16x2_t, x), acc, false); }
__device__ __forceinline__ float bflo(unsigned w) { return __uint_as_float(w << 16); }
__device__ __forceinline__ float bfhi(unsigned w) { return __uint_as_float(w & 0xffff0000u); }
typedef float f32x2_t __attribute__((ext_vector_type(2)));
__device__ __forceinline__ void row_to_fp8(const float* __restrict__ xrow, unsigned char* __restrict__ orow, float* __restrict__ scale, int lane) {
    f32x4 v[4]; float am = 0.f;
#pragma unroll
    for (int j = 0; j < 4; ++j) { v[j] = *(const f32x4*)(xrow + lane * 16 + j * 4); am = fmaxf(am, fmaxf(fmaxf(fabsf(v[j].x), fabsf(v[j].y)), fmaxf(fabsf(v[j].z), fabsf(v[j].w)))); }
    am = wave_max(am);
    const float s = am > 0.f ? am * (1.0f / 448.0f) : 1.0f, inv = 1.0f / s;
    v4u o;
    unsigned w;
    w = 0u; w = __builtin_amdgcn_cvt_pk_fp8_f32(v[0].x * inv, v[0].y * inv, w, false); w = __builtin_amdgcn_cvt_pk_fp8_f32(v[0].z * inv, v[0].w * inv, w, true); o.x = w;
    w = 0u; w = __builtin_amdgcn_cvt_pk_fp8_f32(v[1].x * inv, v[1].y * inv, w, false); w = __builtin_amdgcn_cvt_pk_fp8_f32(v[1].z * inv, v[1].w * inv, w, true); o.y = w;
    w = 0u; w = __builtin_amdgcn_cvt_pk_fp8_f32(v[2].x * inv, v[2].y * inv, w, false); w = __builtin_amdgcn_cvt_pk_fp8_f32(v[2].z * inv, v[2].w * inv, w, true); o.z = w;
    w = 0u; w = __builtin_amdgcn_cvt_pk_fp8_f32(v[3].x * inv, v[3].y * inv, w, false); w = __builtin_amdgcn_cvt_pk_fp8_f32(v[3].z * inv, v[3].w * inv, w, true); o.w = w;
    *(v4u*)(orow + lane * 16) = o;
    if (lane == 0) *scale = s;
}
#define PE_LOAD(UB, VB, grp) do { _Pragma("unroll") for (int i_ = 0; i_ < 4; ++i_) { const int e_ = (grp) * 4 + i_; \
        const int id_ = __builtin_amdgcn_readlane(e_ < 64 ? id0 : id1, e_ & 63); \
        const unsigned so_ = (unsigned)id_ * 1024u; \
        UB[i_] = __builtin_amdgcn_raw_buffer_load_b128(ursrc, voff, so_, 0); VB[i_] = __builtin_amdgcn_raw_buffer_load_b128(vrsrc, voff, so_, 0); } } while (0)
#define PE_DOT4(w, k) do { const f32x2_t l_ = __builtin_amdgcn_cvt_pk_f32_fp8((w), false), h_ = __builtin_amdgcn_cvt_pk_f32_fp8((w), true); \
        a_ += l_.x * xv[(k) * 4 + 0]; b_ += l_.y * xv[(k) * 4 + 1]; a_ += h_.x * xv[(k) * 4 + 2]; b_ += h_.y * xv[(k) * 4 + 3]; } while (0)
#define PE_AXPY4(w, k) do { const f32x2_t l_ = __builtin_amdgcn_cvt_pk_f32_fp8((w), false), h_ = __builtin_amdgcn_cvt_pk_f32_fp8((w), true); \
        acc[(k) * 4 + 0] += cf_ * l_.x; acc[(k) * 4 + 1] += cf_ * l_.y; acc[(k) * 4 + 2] += cf_ * h_.x; acc[(k) * 4 + 3] += cf_ * h_.y; } while (0)
#define PE_COMP(UB, VB, grp) do { float d_[4]; \
        _Pragma("unroll") for (int i_ = 0; i_ < 4; ++i_) { float a_ = 0.f, b_ = 0.f; PE_DOT4(UB[i_].x, 0); PE_DOT4(UB[i_].y, 1); PE_DOT4(UB[i_].z, 2); PE_DOT4(UB[i_].w, 3); d_[i_] = a_ + b_; } \
          \
        float s0_ = hi32 ? d_[2] : d_[0], t0_ = hi32 ? d_[0] : d_[2]; s0_ += __shfl_xor(t0_, 32); \
        float s1_ = hi32 ? d_[3] : d_[1], t1_ = hi32 ? d_[1] : d_[3]; s1_ += __shfl_xor(t1_, 32); \
        float r_ = hi16 ? s1_ : s0_, t2_ = hi16 ? s0_ : s1_; r_ += __shfl_xor(t2_, 16); \
        r_ += __shfl_xor(r_, 8); r_ += __shfl_xor(r_, 4); r_ += __shfl_xor(r_, 2); r_ += __shfl_xor(r_, 1); \
          \
        const int esel_ = (grp) * 4 + (lane >> 4); \
        const float su_ = __shfl(esel_ < 64 ? su0 : su1, esel_ & 63), gv_ = __shfl(esel_ < 64 ? gs0 : gs1, esel_ & 63); \
        const float cfl_ = geluf_(r_ * su_) * gv_; \
        _Pragma("unroll") for (int i_ = 0; i_ < 4; ++i_) { \
            const float cf_ = __uint_as_float(__builtin_amdgcn_readlane(__float_as_uint(cfl_), 16 * i_)); \
            PE_AXPY4(VB[i_].x, 0); PE_AXPY4(VB[i_].y, 1); PE_AXPY4(VB[i_].z, 2); PE_AXPY4(VB[i_].w, 3); } } while (0)
__device__ __forceinline__ void peer_expert_w(const float* __restrict__ xrow, const int* __restrict__ exr, const float* __restrict__ gar,
                                              const unsigned char* __restrict__ U, const unsigned char* __restrict__ V, const float* __restrict__ SU, const float* __restrict__ SV,
                                              const float* __restrict__ g, const float* __restrict__ bta, float* __restrict__ orow, bf16* __restrict__ obrow, int lane) {
    const bool hi32 = (lane & 32) != 0, hi16 = (lane & 16) != 0;
    const __amdgpu_buffer_rsrc_t ursrc = __builtin_amdgcn_make_buffer_rsrc((void*)U, 0, 16384 * 1024, 0x00020000);
    const __amdgpu_buffer_rsrc_t vrsrc = __builtin_amdgcn_make_buffer_rsrc((void*)V, 0, 16384 * 1024, 0x00020000);
    const int voff = lane * 16;
    float xv[16];
#pragma unroll
    for (int j = 0; j < 4; ++j) { const f32x4 t = *(const f32x4*)(xrow + lane * 16 + j * 4); xv[j * 4 + 0] = t.x; xv[j * 4 + 1] = t.y; xv[j * 4 + 2] = t.z; xv[j * 4 + 3] = t.w; }
    const int id0 = exr[lane], id1 = exr[64 + lane];
    const float su0 = SU[id0], su1 = SU[id1];
    const float gs0 = gar[lane] * SV[id0], gs1 = gar[64 + lane] * SV[id1];
    float acc[16];
#pragma unroll
    for (int i = 0; i < 16; ++i) acc[i] = 0.f;
    v4u ua[4], va[4], ub[4], vb[4];
    PE_LOAD(ua, va, 0);
#pragma unroll 1
    for (int grp = 0; grp < 32; grp += 2) {
        PE_LOAD(ub, vb, grp + 1);
        PE_COMP(ua, va, grp);
        if (grp + 2 < 32) PE_LOAD(ua, va, grp + 2);
        PE_COMP(ub, vb, grp + 1);
    }
    float v[16]; float s = 0.f;
#pragma unroll
    for (int i = 0; i < 16; ++i) { v[i] = ALPHA * xv[i] + acc[i]; s += v[i]; }
    const float mean = wave_sum(s) * (1.0f / 1024.0f); float q = 0.f;
#pragma unroll
    for (int i = 0; i < 16; ++i) { v[i] -= mean; q += v[i] * v[i]; }
    const float rs = rsqrtf(wave_sum(q) * (1.0f / 1024.0f) + LN_EPS);
    float o[16];
#pragma unroll
    for (int j = 0; j < 4; ++j) {
        const f32x4 g4 = *(const f32x4*)(g + lane * 16 + j * 4), b4 = *(const f32x4*)(bta + lane * 16 + j * 4);
        o[j * 4 + 0] = v[j * 4 + 0] * rs * g4.x + b4.x; o[j * 4 + 1] = v[j * 4 + 1] * rs * g4.y + b4.y; o[j * 4 + 2] = v[j * 4 + 2] * rs * g4.z + b4.z; o[j * 4 + 3] = v[j * 4 + 3] * rs * g4.w + b4.w;
        *(f32x4*)(orow + lane * 16 + j * 4) = (f32x4){o[j * 4 + 0], o[j * 4 + 1], o[j * 4 + 2], o[j * 4 + 3]};
    }
    if (obrow) {
        v4u w0, w1; w0.x = pk2(o[0], o[1]); w0.y = pk2(o[2], o[3]); w0.z = pk2(o[4], o[5]); w0.w = pk2(o[6], o[7]); w1.x = pk2(o[8], o[9]); w1.y = pk2(o[10], o[11]); w1.z = pk2(o[12], o[13]); w1.w = pk2(o[14], o[15]);
        *(v4u*)(obrow + lane * 16) = w0; *(v4u*)(obrow + lane * 16 + 8) = w1;
    }
}

__device__ __forceinline__ int t5_bucket(int n) {
    if (n < 16) return n;
    const int large = 16 + (int)(logf((float)n / 16.0f) / 2.0794415416798357f * 16.0f);
    return large < 31 ? large : 31;
}
__device__ __forceinline__ void swa_attn(const float* __restrict__ PC, const float* __restrict__ cache_k, const float* __restrict__ cache_v,
                                         const float* __restrict__ rel_bias, const float* __restrict__ sinks, bf16* __restrict__ ATT, int bx) {
    const int tid = threadIdx.x, lane = tid & 63, wid = tid >> 6;
    const int gw = bx * 8 + wid;
    const int t = gw >> 4, h = gw & 15, kvh = h >> 2;
    if (t >= NT) return;
    const bool samp = t >= NP; const int sb = t - NP, pos = t % SEQ;
    const float* qrow = PC + (size_t)t * CN + h * 64;
    float lg[2]; bool valid[2];
#pragma unroll
    for (int rr = 0; rr < 2; ++rr) {
        const int r = lane + 64 * rr;
        const float* krow;
        if (!samp) { valid[rr] = (pos - r) >= 0; krow = PC + (size_t)(valid[rr] ? t - r : t) * CN + 1024 + kvh * 64; }
        else { valid[rr] = true; krow = (r == 0) ? PC + (size_t)t * CN + 1024 + kvh * 64 : cache_k + (((size_t)sb * 128 + (128 - r)) * 4 + kvh) * 64; }
        float dot = 0.f;
#pragma unroll
        for (int d4 = 0; d4 < 16; ++d4) {
            const float4 kv = *(const float4*)(krow + d4 * 4);
            const float4 qv = *(const float4*)(qrow + d4 * 4);
            dot += qv.x * kv.x + qv.y * kv.y + qv.z * kv.z + qv.w * kv.w;
        }
        lg[rr] = valid[rr] ? dot * 0.125f + rel_bias[t5_bucket(r) * 16 + h] : -INFINITY;
    }
    const float sink = sinks[h];
    const float m = fmaxf(wave_max(fmaxf(lg[0], lg[1])), sink);
    float p[2];
#pragma unroll
    for (int rr = 0; rr < 2; ++rr) p[rr] = valid[rr] ? expf(lg[rr] - m) : 0.f;
    const float den = wave_sum(p[0] + p[1]) + expf(sink - m);
    const float inv = 1.0f / den;
    float o = 0.f;
#pragma unroll
    for (int rr = 0; rr < 2; ++rr)
        for (int l2 = 0; l2 < 64; ++l2) {
            const int r = l2 + 64 * rr;
            const float pj = __shfl(p[rr], l2);
            if (pj != 0.f) {
                const float* vrow;
                if (!samp) vrow = PC + (size_t)(t - r) * CN + 1280 + kvh * 64;
                else vrow = (r == 0) ? PC + (size_t)t * CN + 1280 + kvh * 64 : cache_v + (((size_t)sb * 128 + (128 - r)) * 4 + kvh) * 64;
                o += pj * vrow[lane];
            }
        }
    ATT[(size_t)t * D + h * 64 + lane] = (bf16)f2bf(o * inv);
}

__device__ __forceinline__ void swa_kv_out(const float* __restrict__ PC, const float* __restrict__ cache_k, const float* __restrict__ cache_v,
                                           float* __restrict__ pk, float* __restrict__ pv, float* __restrict__ sk, float* __restrict__ sv, int vb) {
    const int c = threadIdx.x & 255, row = vb * 2 + (threadIdx.x >> 8);
    if (row < NB * 128) {
        const int b = row >> 7, i = row & 127;
        const float* src = PC + (size_t)(b * SEQ + SEQ - 128 + i) * CN;
        pk[(size_t)row * 256 + c] = src[1024 + c];
        pv[(size_t)row * 256 + c] = src[1280 + c];
    } else {
        const int r2 = row - NB * 128, sb = r2 >> 7, i = r2 & 127;
        if (i < 127) {
            sk[(size_t)r2 * 256 + c] = cache_k[((size_t)sb * 128 + i + 1) * 256 + c];
            sv[(size_t)r2 * 256 + c] = cache_v[((size_t)sb * 128 + i + 1) * 256 + c];
        } else {
            const float* src = PC + (size_t)(NP + sb) * CN;
            sk[(size_t)r2 * 256 + c] = src[1024 + c];
            sv[(size_t)r2 * 256 + c] = src[1280 + c];
        }
    }
}
#define XB_TMO      128
#define XB_XCNT(j)  (256  + 64 * (j))
#define XB_XSUB(j)  (1280 + 64 * (j))
#define XB_XGEN(j)  (2304 + 64 * (j))
#define XB_TOP      3328
#define XB_TOPGEN   3392
#define XCD_BAR_WORDS 3456
#define XB_SPIN_CAP (1u << 18)

__device__ __forceinline__ unsigned xb_ld(unsigned* p)              { return __hip_atomic_load(p, __ATOMIC_RELAXED, __HIP_MEMORY_SCOPE_AGENT); }
__device__ __forceinline__ unsigned xb_add(unsigned* p, unsigned v) { return __hip_atomic_fetch_add(p, v, __ATOMIC_RELAXED, __HIP_MEMORY_SCOPE_AGENT); }
__device__ __forceinline__ unsigned xb_xcc_id() { return (unsigned)__builtin_amdgcn_s_getreg((3 << 11) | 20) & 0xFu; }
#define XB_SPIN(cond, bar) do { unsigned _sp = 0; while (cond) { __builtin_amdgcn_s_sleep(1); \
    if ((++_sp & 255u) == 0u) { if (xb_ld(&(bar)[XB_TMO])) break; if (_sp > XB_SPIN_CAP) { atomicAdd(&(bar)[XB_TMO], 1u); break; } } } } while (0)

struct XcdBarrier {
    unsigned* bar; unsigned x;
    volatile LAS unsigned* st;
};

__device__ __forceinline__ XcdBarrier xcd_barrier_post(unsigned* bar, volatile LAS unsigned* st) {
    XcdBarrier b; b.bar = bar; b.x = xb_xcc_id(); b.st = st;
    if (threadIdx.x == 0) (void)xb_add(&bar[XB_XCNT(b.x)], 1u);
    return b;
}
__device__ __forceinline__ void xcd_barrier_complete(unsigned* bar, unsigned x, unsigned& nloc, unsigned& nx) {
    const unsigned G = gridDim.x * gridDim.y * gridDim.z;
    unsigned sum, cnt, mine, sp = 0u;
    for (;;) {
        sum = 0u; cnt = 0u; mine = 0u;
#pragma unroll
        for (unsigned j = 0; j < 16; ++j) { const unsigned c = xb_ld(&bar[XB_XCNT(j)]); sum += c; cnt += (c > 0u) ? 1u : 0u; mine = (j == x) ? c : mine; }
        if (sum == G) break;
        __builtin_amdgcn_s_sleep(1);
        if ((++sp & 255u) == 0u) { if (xb_ld(&bar[XB_TMO])) break; if (sp > XB_SPIN_CAP) { atomicAdd(&bar[XB_TMO], 1u); break; } }
    }
    nloc = mine > 0u ? mine : 1u; nx = cnt > 0u ? cnt : 1u;
}

__device__ __forceinline__ void xcd_barrier(const XcdBarrier& b) {
    asm volatile("s_waitcnt vmcnt(0)" ::: "memory");
    __syncthreads();
    if (threadIdx.x == 0) {
        unsigned* bar = b.bar;
        __builtin_amdgcn_s_waitcnt(0);
        unsigned nloc = b.st[0], nx = b.st[1];
        if (nloc == 0u) { xcd_barrier_complete(bar, b.x, nloc, nx); b.st[0] = nloc; b.st[1] = nx; }
        const unsigned old = xb_add(&bar[XB_XSUB(b.x)], 1u);
        const unsigned gen = old / nloc;
        if (old + 1u == (gen + 1u) * nloc) {
            __builtin_amdgcn_fence(__ATOMIC_RELEASE, "agent");
            asm volatile("s_waitcnt vmcnt(0)" ::: "memory");
            const unsigned og = xb_add(&bar[XB_TOP], 1u);
            const unsigned tg = og / nx;
            if (og + 1u == (tg + 1u) * nx) xb_add(&bar[XB_TOPGEN], 1u);
            else XB_SPIN(xb_ld(&bar[XB_TOPGEN]) == tg, bar);
            __builtin_amdgcn_fence(__ATOMIC_ACQUIRE, "agent");
            xb_add(&bar[XB_XGEN(b.x)], 1u);
            asm volatile("s_waitcnt vmcnt(0)" ::: "memory");
        } else {
            XB_SPIN(xb_ld(&bar[XB_XGEN(b.x)]) == gen, bar);
            __builtin_amdgcn_fence(__ATOMIC_ACQUIRE, "agent");
            asm volatile("s_waitcnt vmcnt(0)" ::: "memory");
        }
    }
    __syncthreads();
}

typedef short bf16x8_t __attribute__((ext_vector_type(8)));
__device__ __forceinline__ f32x4 mfma16(bf16x8_t a, bf16x8_t b, f32x4 c) { return __builtin_amdgcn_mfma_f32_16x16x32_bf16(a, b, c, 0, 0, 0); }

struct GdnChunkBufs {
    bf16* W;
    bf16* QG;
    bf16* KDT;
    bf16* UT;
    bf16* QK;
    float* EGL;
};

constexpr int GP_QB = 0, GP_KB = 17408, GP_VB = 34816, GP_LS = 52224, GP_QKS = 69632, GP_WS = 78848, GP_SC = 96256;

__device__ __forceinline__ void gdn_prep_unit(const bf16* __restrict__ PROJ, const float* __restrict__ conv_w, const float* __restrict__ a_log, const float* __restrict__ dt_bias,
                                              const GdnChunkBufs& cb, float* __restrict__ p_gdn_conv, int un, unsigned char* lds) {
    int tid = threadIdx.x; asm volatile("" : "+v"(tid));
    const int lane = tid & 63, wave = __builtin_amdgcn_readfirstlane(tid >> 6), fr = lane & 15, fq = lane >> 4;
    const int h = un & 3, n = (un >> 2) & 63, b = un >> 8;
    const int t0 = b * SEQ + n * 64;
    bf16* Qb = (bf16*)(lds + GP_QB); bf16* Kb = (bf16*)(lds + GP_KB); bf16* Vb = (bf16*)(lds + GP_VB); bf16* Ws = (bf16*)(lds + GP_WS);
    float* Ls = (float*)(lds + GP_LS); bf16* QKs = (bf16*)(lds + GP_QKS);
    float* gcs = (float*)(lds + GP_SC); float* bets = gcs + 64; float* egcs = gcs + 128; float* ekds = gcs + 192; float* begs = gcs + 256;
    if (wave == 0) {
        const bf16* prow = PROJ + (size_t)(t0 + lane) * ABN;
        const float a_raw = bf2f(prow[C_A + h]), b_raw = bf2f(prow[C_B + h]);
        float g = -expf(a_log[h]) * softplusf_(a_raw + dt_bias[h]);
#pragma unroll
        for (int off = 1; off < 64; off <<= 1) { const float v = __shfl_up(g, off); if (lane >= off) g += v; }
        const float glast = __shfl(g, 63);
        { const float be_ = sigmoidf_(b_raw), eg_ = expf(g); gcs[lane] = g; bets[lane] = be_; egcs[lane] = eg_; ekds[lane] = expf(glast - g); begs[lane] = be_ * eg_; }
        if (lane == 0) cb.EGL[un] = expf(glast);
    }
    {
        int cols[6]; float cw[4][6], xw[3][6];
#pragma unroll
        for (int p = 0; p < 3; ++p)
#pragma unroll
            for (int e = 0; e < 2; ++e) cols[p * 2 + e] = p * 512 + h * 128 + e * 64 + lane;
#pragma unroll
        for (int i = 0; i < 4; ++i)
#pragma unroll
            for (int c = 0; c < 6; ++c) cw[i][c] = conv_w[i * 1536 + cols[c]];
        const int i0 = wave * 8;
#pragma unroll
        for (int k = 0; k < 3; ++k) {
            const int pos = n * 64 + i0 - 3 + k;
#pragma unroll
            for (int c = 0; c < 6; ++c) xw[k][c] = pos >= 0 ? bf2f(PROJ[(size_t)(t0 + i0 - 3 + k) * ABN + cols[c]]) : 0.f;
        }
        bf16 xraw[8][6];
#pragma unroll
        for (int ii = 0; ii < 8; ++ii)
#pragma unroll
            for (int c = 0; c < 6; ++c) xraw[ii][c] = PROJ[(size_t)(t0 + i0 + ii) * ABN + cols[c]];
#pragma unroll
        for (int ii = 0; ii < 8; ++ii) {
            const int i = i0 + ii;
            float xt[6], s[6];
#pragma unroll
            for (int c = 0; c < 6; ++c) xt[c] = bf2f(xraw[ii][c]);
#pragma unroll
            for (int c = 0; c < 6; ++c) s[c] = siluf_(cw[0][c] * xw[0][c] + cw[1][c] * xw[1][c] + cw[2][c] * xw[2][c] + cw[3][c] * xt[c]);
            const float qs = rsqrtf(wave_sum(s[0] * s[0] + s[1] * s[1]) + 1e-6f) * 0.08838834764831845f;
            const float ks = rsqrtf(wave_sum(s[2] * s[2] + s[3] * s[3]) + 1e-6f);
            Qb[i * 136 + lane] = (bf16)f2bf(s[0] * qs); Qb[i * 136 + 64 + lane] = (bf16)f2bf(s[1] * qs);
            Kb[i * 136 + lane] = (bf16)f2bf(s[2] * ks); Kb[i * 136 + 64 + lane] = (bf16)f2bf(s[3] * ks);
            Vb[i * 136 + lane] = (bf16)f2bf(s[4]);      Vb[i * 136 + 64 + lane] = (bf16)f2bf(s[5]);
            if (n == 63 && i >= 61) {
#pragma unroll
                for (int c = 0; c < 6; ++c) p_gdn_conv[((size_t)b * 3 + (i - 61)) * 1536 + cols[c]] = xt[c];
            }
#pragma unroll
            for (int c = 0; c < 6; ++c) { xw[0][c] = xw[1][c]; xw[1][c] = xw[2][c]; xw[2][c] = xt[c]; }
        }
    }
    __syncthreads();
    {
        const int mi = wave >> 1;
        bf16x8_t aK[4], aQ[4];
#pragma unroll
        for (int ks = 0; ks < 4; ++ks) { aK[ks] = *(const bf16x8_t*)(Kb + (mi * 16 + fr) * 136 + ks * 32 + 8 * fq); aQ[ks] = *(const bf16x8_t*)(Qb + (mi * 16 + fr) * 136 + ks * 32 + 8 * fq); }
#pragma unroll
        for (int nn = 0; nn < 2; ++nn) {
            const int nj = (wave & 1) * 2 + nn;
            f32x4 accK = (f32x4){0.f, 0.f, 0.f, 0.f}, accQ = accK;
#pragma unroll
            for (int ks = 0; ks < 4; ++ks) { const bf16x8_t bk = *(const bf16x8_t*)(Kb + (nj * 16 + fr) * 136 + ks * 32 + 8 * fq); accK = mfma16(aK[ks], bk, accK); accQ = mfma16(aQ[ks], bk, accQ); }
            const int j = nj * 16 + fr; const float gj = gcs[j];
#pragma unroll
            for (int r = 0; r < 4; ++r) {
                const int i = mi * 16 + 4 * fq + r;
                const float dec = i >= j ? expf(gcs[i] - gj) : 0.f;
                Ls[i * 68 + j] = i > j ? bets[i] * accK[r] * dec : 0.f;
                QKs[i * 72 + j] = (bf16)f2bf(i >= j ? accQ[r] * dec : 0.f);
            }
        }
    }
    __syncthreads();
    if (wave < 4) {
        float x[64];
        const bool isu = tid < 128; const int c = isu ? tid : tid - 128;
        const LAS unsigned char* l3 = (const LAS unsigned char*)lds;
        unsigned so = (isu ? GP_VB : GP_KB) + c * 2, ro = GP_SC + (isu ? 64 * 4 : 256 * 4), lo = GP_LS;
        asm volatile("" : "+v"(so), "+v"(ro), "+v"(lo));
#pragma unroll
        for (int i = 0; i < 64; ++i) {
            float acc = *(const LAS float*)(l3 + ro + 4 * i) * bf2f(*(const LAS bf16*)(l3 + so + i * 272));
#pragma unroll
            for (int j4 = 0; j4 < (i + 3) / 4; ++j4) {
                const f32x4 l4 = *(const LAS f32x4*)(l3 + lo + i * 272 + j4 * 16);
                acc -= l4.x * x[j4 * 4 + 0];
                if (j4 * 4 + 1 < i) acc -= l4.y * x[j4 * 4 + 1];
                if (j4 * 4 + 2 < i) acc -= l4.z * x[j4 * 4 + 2];
                if (j4 * 4 + 3 < i) acc -= l4.w * x[j4 * 4 + 3];
            }
            x[i] = acc;
        }
        if (isu) {
            bf16* dst = cb.UT + ((size_t)un * 128 + c) * 64;
#pragma unroll
            for (int i8 = 0; i8 < 8; ++i8) { v4u o; o.x = pk2(x[i8 * 8 + 0], x[i8 * 8 + 1]); o.y = pk2(x[i8 * 8 + 2], x[i8 * 8 + 3]); o.z = pk2(x[i8 * 8 + 4], x[i8 * 8 + 5]); o.w = pk2(x[i8 * 8 + 6], x[i8 * 8 + 7]); *(v4u*)(dst + i8 * 8) = o; }
        } else {
#pragma unroll
            for (int i = 0; i < 64; ++i) Ws[i * 136 + c] = (bf16)f2bf(x[i]);
        }
    } else {
        const int t2 = tid - 256;
#pragma unroll
        for (int k = 0; k < 4; ++k) {
            const int ci = t2 + 256 * k, i = ci >> 4, d0 = (ci & 15) * 8; const float e = egcs[i];
            const v4u q = *(const v4u*)(Qb + i * 136 + d0);
            v4u o; o.x = pk2(bflo(q.x) * e, bfhi(q.x) * e); o.y = pk2(bflo(q.y) * e, bfhi(q.y) * e); o.z = pk2(bflo(q.z) * e, bfhi(q.z) * e); o.w = pk2(bflo(q.w) * e, bfhi(q.w) * e);
            *(v4u*)(cb.QG + ((size_t)un * 64 + i) * 128 + d0) = o;
        }
#pragma unroll
        for (int k = 0; k < 4; ++k) {
            const int ci = t2 + 256 * k, d = ci & 127, i0 = (ci >> 7) * 8;
            float v[8];
#pragma unroll
            for (int q = 0; q < 8; ++q) v[q] = bf2f(Kb[(i0 + q) * 136 + d]) * ekds[i0 + q];
            v4u o; o.x = pk2(v[0], v[1]); o.y = pk2(v[2], v[3]); o.z = pk2(v[4], v[5]); o.w = pk2(v[6], v[7]);
            *(v4u*)(cb.KDT + ((size_t)un * 128 + d) * 64 + i0) = o;
        }
#pragma unroll
        for (int k = 0; k < 2; ++k) {
            const int ci = t2 + 256 * k, i = ci >> 3, j0 = (ci & 7) * 8;
            *(v4u*)(cb.QK + ((size_t)un * 64 + i) * 64 + j0) = *(const v4u*)(QKs + i * 72 + j0);
        }
    }
    __syncthreads();
#pragma unroll
    for (int k = 0; k < 2; ++k) {
        const int ci = tid + 512 * k, i = ci >> 4, d0 = (ci & 15) * 8;
        *(v4u*)(cb.W + ((size_t)un * 64 + i) * 128 + d0) = *(const v4u*)(Ws + i * 136 + d0);
    }
    __syncthreads();
}

constexpr int GS_ST = 0, GS_VNT = 2 * 32 * 136 * 2, GS_END = GS_VNT + 32 * 72 * 2;
__device__ __forceinline__ void gdn_seq(const GdnChunkBufs& cb, float* __restrict__ O, float* __restrict__ Sout, int b, int h, int sl, unsigned char* lds) {
    int tid = threadIdx.x; asm volatile("" : "+v"(tid));
    const int lane = tid & 63, wave = __builtin_amdgcn_readfirstlane(tid >> 6), fr = lane & 15, fq = lane >> 4;
    const int mi = wave >> 1, nj = wave & 1;
    bf16* St = (bf16*)(lds + GS_ST); bf16* VnT = (bf16*)(lds + GS_VNT);
    for (int i = tid; i < 2 * 32 * 136 / 2; i += NTH) ((unsigned*)St)[i] = 0u;
    float* egls = (float*)(lds + GS_END);
    if (tid < 64) egls[tid] = cb.EGL[(size_t)((b * 64 + tid) * 4 + h)];
    f32x4 accS[2]; accS[0] = (f32x4){0.f, 0.f, 0.f, 0.f}; accS[1] = accS[0];
#define GS_DECL(X) bf16x8_t aW##X[4], aQG##X[4], aQK##X[2], aKD##X[2]; v2u ut##X;
    GS_DECL(0) GS_DECL(1) GS_DECL(2)
#define GS_GLD16(dst, ptr) asm volatile("global_load_dwordx4 %0, %1, off" : "=v"(dst) : "v"(ptr))
#define GS_GLD8(dst, ptr) asm volatile("global_load_dwordx2 %0, %1, off" : "=v"(dst) : "v"(ptr))
#define GS_LOAD(X, n_) do { const size_t u_ = (size_t)((b * 64 + ((n_) < 63 ? (n_) : 63)) * 4 + h);     \
        _Pragma("unroll") for (int ks = 0; ks < 4; ++ks) { GS_GLD16(aW##X[ks], cb.W + (u_ * 64 + mi * 16 + fr) * 128 + ks * 32 + 8 * fq); GS_GLD16(aQG##X[ks], cb.QG + (u_ * 64 + mi * 16 + fr) * 128 + ks * 32 + 8 * fq); } \
        _Pragma("unroll") for (int ks = 0; ks < 2; ++ks) { GS_GLD16(aQK##X[ks], cb.QK + (u_ * 64 + mi * 16 + fr) * 64 + ks * 32 + 8 * fq); GS_GLD16(aKD##X[ks], cb.KDT + (u_ * 128 + wave * 16 + fr) * 64 + ks * 32 + 8 * fq); } \
        GS_GLD8(ut##X, cb.UT + (u_ * 128 + sl * 32 + nj * 16 + fr) * 64 + mi * 16 + 4 * fq); } while (0)
#define GS_WAITN(X, N) asm volatile("s_waitcnt vmcnt(" #N ")" : "+v"(aW##X[0]), "+v"(aW##X[1]), "+v"(aW##X[2]), "+v"(aW##X[3]), "+v"(aQG##X[0]), "+v"(aQG##X[1]), "+v"(aQG##X[2]), "+v"(aQG##X[3]), \
        "+v"(aQK##X[0]), "+v"(aQK##X[1]), "+v"(aKD##X[0]), "+v"(aKD##X[1]), "+v"(ut##X))
#define GS_WAIT(X, n_) GS_WAITN(X, 26)
#define GS_STEP(X, n_) do { \
        const float egl##X = egls[(n_)]; \
        GS_WAIT(X, n_); \
        __syncthreads();                                        \
        f32x4 accW = (f32x4){0.f, 0.f, 0.f, 0.f}, accO = accW; \
        const bf16* Sc = St + cur * 32 * 136; \
        _Pragma("unroll") for (int ks = 0; ks < 4; ++ks) { const bf16x8_t bs = *(const bf16x8_t*)(Sc + (nj * 16 + fr) * 136 + ks * 32 + 8 * fq); accW = mfma16(aW##X[ks], bs, accW); accO = mfma16(aQG##X[ks], bs, accO); } \
          \
        const float v0 = bflo(ut##X.x) - accW[0], v1 = bfhi(ut##X.x) - accW[1], v2 = bflo(ut##X.y) - accW[2], v3 = bfhi(ut##X.y) - accW[3]; \
        { v2u o; o.x = pk2(v0, v1); o.y = pk2(v2, v3); *(v2u*)(VnT + (nj * 16 + fr) * 72 + mi * 16 + 4 * fq) = o; } \
        __syncthreads();                                        \
        _Pragma("unroll") for (int ks = 0; ks < 2; ++ks) { const bf16x8_t bv = *(const bf16x8_t*)(VnT + (nj * 16 + fr) * 72 + ks * 32 + 8 * fq); accO = mfma16(aQK##X[ks], bv, accO); } \
        { float* orow = O + (size_t)(b * SEQ + (n_) * 64 + mi * 16 + 4 * fq) * 512 + h * 128 + sl * 32 + nj * 16 + fr; \
          orow[0] = accO[0]; orow[512] = accO[1]; orow[1024] = accO[2]; orow[1536] = accO[3]; } \
          \
        bf16* Sn = St + (cur ^ 1) * 32 * 136; \
        _Pragma("unroll") for (int njj = 0; njj < 2; ++njj) { \
            accS[njj] = accS[njj] * egl##X; \
            _Pragma("unroll") for (int ks = 0; ks < 2; ++ks) { const bf16x8_t bv = *(const bf16x8_t*)(VnT + (njj * 16 + fr) * 72 + ks * 32 + 8 * fq); accS[njj] = mfma16(aKD##X[ks], bv, accS[njj]); } \
            v2u o; o.x = pk2(accS[njj][0], accS[njj][1]); o.y = pk2(accS[njj][2], accS[njj][3]); \
            *(v2u*)(Sn + (njj * 16 + fr) * 136 + wave * 16 + 4 * fq) = o; } \
        cur ^= 1; } while (0)
    int cur = 0;
    GS_LOAD(0, 0); GS_LOAD(1, 1);
#pragma unroll 1
    for (int n = 0; n < 63; n += 3) {
        GS_LOAD(2, n + 2);
        GS_STEP(0, n);
        GS_LOAD(0, n + 3);
        GS_STEP(1, n + 1);
        GS_LOAD(1, n + 4);
        GS_STEP(2, n + 2);
    }
    GS_LOAD(2, 63);
    GS_STEP(0, 63);
    GS_WAITN(1, 0); GS_WAITN(2, 0);
#undef GS_STEP
#undef GS_DECL
#undef GS_WAIT
#undef GS_WAITN
#undef GS_GLD16
#undef GS_GLD8
    asm volatile("s_waitcnt vmcnt(0)" ::: "memory");
#undef GS_LOAD
#pragma unroll
    for (int njj = 0; njj < 2; ++njj)
#pragma unroll
        for (int r = 0; r < 4; ++r) Sout[(((size_t)b * 4 + h) * 128 + wave * 16 + 4 * fq + r) * 128 + sl * 32 + njj * 16 + fr] = accS[njj][r];
    __syncthreads();
}

__device__ __forceinline__ void lru_prep_unit(const bf16* __restrict__ PROJ, const float* __restrict__ conv_w, const float* __restrict__ conv_b,
                                              const float* __restrict__ w_r, const float* __restrict__ b_r, const float* __restrict__ w_i, const float* __restrict__ b_i, const float* __restrict__ lam,
                                              float* __restrict__ H, float* __restrict__ P, float* __restrict__ Hend, float* __restrict__ Pend, float* __restrict__ p_lru_conv, int ub) {
    int c = threadIdx.x; asm volatile("" : "+v"(c));
    const int nblk = c >> 6, d = c & 63;
    const int n = ub & 63, b = ub >> 6, t0 = b * SEQ + n * 64;
    float wr[64], wi[64];
#pragma unroll
    for (int cc = 0; cc < 64; ++cc) { wr[cc] = w_r[((size_t)nblk * 64 + cc) * 64 + d]; wi[cc] = w_i[((size_t)nblk * 64 + cc) * 64 + d]; }
    const float cw0 = conv_w[c], cw1 = conv_w[512 + c], cw2 = conv_w[1024 + c], cw3 = conv_w[1536 + c], cb_ = conv_b[c];
    const float br = b_r[c], bi = b_i[c], spl = -8.0f * softplusf_(-lam[c]);
    float x0 = (n * 64 - 3 >= 0) ? bf2f(PROJ[(size_t)(t0 - 3) * ABN + C_XR + c]) : 0.f;
    float x1 = (n * 64 - 2 >= 0) ? bf2f(PROJ[(size_t)(t0 - 2) * ABN + C_XR + c]) : 0.f;
    float x2 = (n * 64 - 1 >= 0) ? bf2f(PROJ[(size_t)(t0 - 1) * ABN + C_XR + c]) : 0.f;
    float hloc = 0.f, ploc = 1.f;
    bf16 xa[16], xb[16];
#pragma unroll
    for (int k = 0; k < 16; ++k) xa[k] = PROJ[(size_t)(t0 + k) * ABN + C_XR + c];
#pragma unroll 1
    for (int ib = 0; ib < 64; ib += 16) {
      if (ib + 16 < 64) {
#pragma unroll
        for (int k = 0; k < 16; ++k) xb[k] = PROJ[(size_t)(t0 + ib + 16 + k) * ABN + C_XR + c];
      }
#pragma unroll
      for (int k = 0; k < 16; ++k) {
        const int i = ib + k;
        const float xt = bf2f(xa[k]);
        const float xr = cb_ + cw0 * x0 + cw1 * x1 + cw2 * x2 + cw3 * xt;
        float r = br, ii = bi;
#pragma unroll
        for (int cc = 0; cc < 64; ++cc) { const float xv = __uint_as_float(__builtin_amdgcn_readlane(__float_as_uint(xr), cc)); r += xv * wr[cc]; ii += xv * wi[cc]; }
        r = sigmoidf_(r); ii = sigmoidf_(ii);
        const float log_a = spl * r;
        const float a = expf(log_a), bb = sqrtf(-expm1f(2.0f * log_a)) * (ii * xr);
        hloc = a * hloc + bb; ploc *= a;
        H[(size_t)(t0 + i) * 512 + c] = hloc; P[(size_t)(t0 + i) * 512 + c] = ploc;
        if (n == 63 && i >= 61) p_lru_conv[((size_t)b * 3 + (i - 61)) * 512 + c] = xt;
        x0 = x1; x1 = x2; x2 = xt;
      }
#pragma unroll
      for (int k = 0; k < 16; ++k) xa[k] = xb[k];
    }
    Hend[(size_t)ub * 512 + c] = hloc; Pend[(size_t)ub * 512 + c] = ploc;
}
__device__ __forceinline__ void lru_carry(const float* __restrict__ Hend, const float* __restrict__ Pend, float* __restrict__ CIN, float* __restrict__ hlast, int bx) {
    int tx_ = threadIdx.x; asm volatile("" : "+v"(tx_));
    const int idx = bx * NTH + tx_, b = idx >> 9, c = idx & 511;
    float carry = 0.f;
#pragma unroll 8
    for (int n = 0; n < 64; ++n) {
        const size_t o = ((size_t)b * 64 + n) * 512 + c;
        CIN[o] = carry;
        carry = Hend[o] + Pend[o] * carry;
    }
    hlast[(size_t)b * 512 + c] = carry;
}

__device__ __forceinline__ unsigned f2key(float f) { const unsigned u = __float_as_uint(f); return u ^ ((u >> 31) ? 0xffffffffu : 0x80000000u); }
__device__ __forceinline__ float key2f(unsigned k) { return __uint_as_float(k ^ ((k >> 31) ? 0x80000000u : 0xffffffffu)); }
#define TK_CE(hi, lo) do { const unsigned a_ = (hi), b_ = (lo); (hi) = a_ > b_ ? a_ : b_; (lo) = a_ > b_ ? b_ : a_; } while (0)
template <int N> __device__ __forceinline__ void bitonic_sort_desc(unsigned (&a)[N]) {
#pragma unroll
    for (int k = 2; k <= N; k <<= 1)
#pragma unroll
        for (int j = k >> 1; j > 0; j >>= 1)
#pragma unroll
            for (int i = 0; i < N; ++i) { const int l = i ^ j; if (l > i) { if ((i & k) == 0) TK_CE(a[i], a[l]); else TK_CE(a[l], a[i]); } }
}
template <int XM> __device__ __forceinline__ void merge_top16(unsigned (&a)[16]) {
    unsigned c[16];
#pragma unroll
    for (int i = 0; i < 16; ++i) { const unsigned o = (unsigned)__shfl_xor((int)a[15 - i], XM); c[i] = a[i] > o ? a[i] : o; }
#pragma unroll
    for (int j = 8; j > 0; j >>= 1)
#pragma unroll
        for (int i = 0; i < 16; ++i) { const int l = i ^ j; if (l > i) TK_CE(c[i], c[l]); }
#pragma unroll
    for (int i = 0; i < 16; ++i) a[i] = c[i];
}
constexpr int TK_SS = 0, TK_TS = 128 * 132 * 4, TK_END = TK_TS + 64 * 2 * 16 * 4;
__device__ __forceinline__ void peer_topk3(const bf16* __restrict__ Q, const bf16* __restrict__ KB  , int* __restrict__ EXP, float* __restrict__ GATE,
                                           int tile, int h, unsigned char* lds) {
    int tid = threadIdx.x; asm volatile("" : "+v"(tid));
    const int lane = tid & 63, wave = __builtin_amdgcn_readfirstlane(tid >> 6), fr = lane & 15, fq = lane >> 4;
    float* Ss = (float*)(lds + TK_SS); unsigned* Ts = (unsigned*)(lds + TK_TS);
    {
        const int c = wave >> 2, mt = wave & 3;
        bf16x8_t a[4];
#pragma unroll
        for (int ks = 0; ks < 4; ++ks) a[ks] = *(const bf16x8_t*)(Q + (size_t)(tile * 64 + mt * 16 + fr) * 2048 + h * 256 + c * 128 + ks * 32 + 8 * fq);
        const bf16* kb = KB + ((size_t)(h * 2 + c) * 128) * 128;
#pragma unroll
        for (int nt = 0; nt < 8; ++nt) {
            f32x4 acc = (f32x4){0.f, 0.f, 0.f, 0.f};
#pragma unroll
            for (int ks = 0; ks < 4; ++ks) { const bf16x8_t bk = *(const bf16x8_t*)(kb + (size_t)(nt * 16 + fr) * 128 + ks * 32 + 8 * fq); acc = mfma16(a[ks], bk, acc); }
#pragma unroll
            for (int r = 0; r < 4; ++r) Ss[(c * 64 + mt * 16 + 4 * fq + r) * 132 + (nt >> 1) * 33 + (nt & 1) * 16 + fr] = acc[r];
        }
    }
    __syncthreads();
    {
        const int row = tid >> 2, q = tid & 3;
        const float* src = Ss + row * 132 + q * 33;
        unsigned a[32];
#pragma unroll
        for (int j = 0; j < 32; ++j) a[j] = (f2key(src[j]) & ~127u) | (unsigned)(127 - (q * 32 + j));
        bitonic_sort_desc<32>(a);
        unsigned t[16];
#pragma unroll
        for (int j = 0; j < 16; ++j) t[j] = a[j];
        merge_top16<1>(t); merge_top16<2>(t);
        if (q == 0) {
            const int c = row >> 6, tk = row & 63;
#pragma unroll
            for (int j = 0; j < 16; ++j) Ts[(tk * 2 + c) * 16 + j] = t[j];
        }
    }
    __syncthreads();
    if (tid < 256) {
        const int tk = tid >> 2, q = tid & 3;
        const unsigned* t0 = Ts + (tk * 2 + 0) * 16; const unsigned* t1 = Ts + (tk * 2 + 1) * 16;
        unsigned a[16];
#pragma unroll
        for (int s = 0; s < 13; ++s) {
            const int e = s * 4 + q;
            int i, j;
            if (e < 16) { i = 0; j = e; } else if (e < 24) { i = 1; j = e - 16; } else if (e < 29) { i = 2; j = e - 24; } else if (e < 33) { i = 3; j = e - 29; }
            else if (e < 36) { i = 4; j = e - 33; } else if (e < 42) { i = 5 + ((e - 36) >> 1); j = (e - 36) & 1; } else { i = 8 + (e - 42); j = 0; }
            const bool ok = e < 50;
            const float sum = key2f(t0[ok ? i : 0] & ~127u) + key2f(t1[ok ? j : 0] & ~127u);
            a[s] = ok ? ((f2key(sum) & ~255u) | (unsigned)(255 - (i * 16 + j))) : 0u;
        }
        a[13] = 0u; a[14] = 0u; a[15] = 0u;
        bitonic_sort_desc<16>(a);
        merge_top16<1>(a); merge_top16<2>(a);
        float ev[16], sum = 0.f; const float m = key2f(a[0] & ~255u);
#pragma unroll
        for (int j = 0; j < 16; ++j) { ev[j] = __expf(key2f(a[j] & ~255u) - m); sum += ev[j]; }
        const float inv = 1.0f / sum;
        const size_t o = (size_t)(tile * 64 + tk) * 128 + h * 16;
#pragma unroll
        for (int j = 0; j < 16; ++j)
            if ((j >> 2) == q) {
                const int code = 255 - (int)(a[j] & 255u), i = code >> 4, jj = code & 15;
                const int n0 = 127 - (int)(t0[i] & 127u), n1 = 127 - (int)(t1[jj] & 127u);
                EXP[o + j] = n0 * 128 + n1; GATE[o + j] = ev[j] * inv;
            }
    }
    __syncthreads();
}

constexpr int AT_KS = 0, AT_VT = 192 * 72 * 2, AT_BT = AT_VT + 64 * 200 * 2, AT_PW = AT_BT + 4 * 128 * 4, AT_END = AT_PW + 8 * 32 * 72 * 2;
__device__ __forceinline__ void attn_unit(const bf16* __restrict__ PCb, const float* __restrict__ rel_bias, const float* __restrict__ sinks, bf16* __restrict__ ATT, int un, unsigned char* lds) {
    int tid = threadIdx.x; asm volatile("" : "+v"(tid));
    const int lane = tid & 63, wave = __builtin_amdgcn_readfirstlane(tid >> 6), fr = lane & 15, fq = lane >> 4;
    const int kvh = un & 3, qblk = (un >> 2) & 63, b = un >> 8;
    const int q0 = qblk * 64, tb = b * SEQ;
    bf16* Ks = (bf16*)(lds + AT_KS); bf16* Vt = (bf16*)(lds + AT_VT); float* Bt = (float*)(lds + AT_BT); bf16* Pw = (bf16*)(lds + AT_PW) + wave * 32 * 72;
#pragma unroll
    for (int k = 0; k < 3; ++k) {
        const int ci = tid + 512 * k, row = ci >> 3, part = ci & 7, kpos = q0 - 128 + row;
        v4u kv = (v4u){0u, 0u, 0u, 0u}, vv = kv;
        if (kpos >= 0) { const bf16* src = PCb + (size_t)(tb + kpos) * CN + kvh * 64 + part * 8; kv = *(const v4u*)(src + 1024); vv = *(const v4u*)(src + 1280); }
        *(v4u*)(Ks + row * 72 + part * 8) = kv;
        bf16* vd = Vt + (part * 8) * 200 + row;
        vd[0 * 200] = (bf16)(vv.x & 0xffffu); vd[1 * 200] = (bf16)(vv.x >> 16); vd[2 * 200] = (bf16)(vv.y & 0xffffu); vd[3 * 200] = (bf16)(vv.y >> 16);
        vd[4 * 200] = (bf16)(vv.z & 0xffffu); vd[5 * 200] = (bf16)(vv.z >> 16); vd[6 * 200] = (bf16)(vv.w & 0xffffu); vd[7 * 200] = (bf16)(vv.w >> 16);
    }
    Bt[tid] = rel_bias[t5_bucket(tid & 127) * 16 + kvh * 4 + (tid >> 7)];
    __syncthreads();
    const int g = wave >> 1, qs = (wave & 1) * 32, hh = kvh * 4 + g;
    bf16x8_t aQ[2][2];
#pragma unroll
    for (int mt = 0; mt < 2; ++mt)
#pragma unroll
        for (int ks = 0; ks < 2; ++ks) aQ[mt][ks] = *(const bf16x8_t*)(PCb + (size_t)(tb + q0 + qs + mt * 16 + fr) * CN + hh * 64 + ks * 32 + 8 * fq);
    f32x4 sc[2][12];
#pragma unroll
    for (int nt = 0; nt < 12; ++nt) {
        const bf16x8_t b0 = *(const bf16x8_t*)(Ks + (nt * 16 + fr) * 72 + 8 * fq), b1 = *(const bf16x8_t*)(Ks + (nt * 16 + fr) * 72 + 32 + 8 * fq);
#pragma unroll
        for (int mt = 0; mt < 2; ++mt) { f32x4 a = (f32x4){0.f, 0.f, 0.f, 0.f}; a = mfma16(aQ[mt][0], b0, a); a = mfma16(aQ[mt][1], b1, a); sc[mt][nt] = a; }
    }
    const float sink = sinks[hh];
    const float* bt = Bt + g * 128;
#pragma unroll
    for (int mt = 0; mt < 2; ++mt)
#pragma unroll
        for (int r = 0; r < 4; ++r) {
            const int qi = qs + mt * 16 + 4 * fq + r;
            float mx = sink;
#pragma unroll
            for (int nt = 0; nt < 12; ++nt) {
                const int kk = nt * 16 + fr, rel = qi + 128 - kk;
                const bool valid = rel >= 0 && rel < 128 && (q0 - 128 + kk) >= 0;
                const float lg = valid ? sc[mt][nt][r] * 0.125f + bt[valid ? rel : 0] : -INFINITY;
                sc[mt][nt][r] = lg; mx = fmaxf(mx, lg);
            }
            mx = fmaxf(mx, __shfl_xor(mx, 1)); mx = fmaxf(mx, __shfl_xor(mx, 2)); mx = fmaxf(mx, __shfl_xor(mx, 4)); mx = fmaxf(mx, __shfl_xor(mx, 8));
            float sum = 0.f;
#pragma unroll
            for (int nt = 0; nt < 12; ++nt) { const float p = __expf(sc[mt][nt][r] - mx); sc[mt][nt][r] = p; sum += p; }
            sum += __shfl_xor(sum, 1); sum += __shfl_xor(sum, 2); sum += __shfl_xor(sum, 4); sum += __shfl_xor(sum, 8);
            const float inv = 1.0f / (sum + __expf(sink - mx));
#pragma unroll
            for (int nt = 0; nt < 12; ++nt) sc[mt][nt][r] *= inv;
        }
    f32x4 oacc[2][4];
#pragma unroll
    for (int mt = 0; mt < 2; ++mt)
#pragma unroll
        for (int dt = 0; dt < 4; ++dt) oacc[mt][dt] = (f32x4){0.f, 0.f, 0.f, 0.f};
#pragma unroll
    for (int kc = 0; kc < 3; ++kc) {
#pragma unroll
        for (int mt = 0; mt < 2; ++mt)
#pragma unroll
            for (int n4 = 0; n4 < 4; ++n4)
#pragma unroll
                for (int r = 0; r < 4; ++r) Pw[(mt * 16 + 4 * fq + r) * 72 + n4 * 16 + fr] = (bf16)f2bf(sc[mt][kc * 4 + n4][r]);
        asm volatile("s_waitcnt lgkmcnt(0)" ::: "memory");
#pragma unroll
        for (int ks = 0; ks < 2; ++ks) {
            const bf16x8_t p0 = *(const bf16x8_t*)(Pw + fr * 72 + ks * 32 + 8 * fq), p1 = *(const bf16x8_t*)(Pw + (16 + fr) * 72 + ks * 32 + 8 * fq);
#pragma unroll
            for (int dt = 0; dt < 4; ++dt) {
                const bf16x8_t bv = *(const bf16x8_t*)(Vt + (dt * 16 + fr) * 200 + kc * 64 + ks * 32 + 8 * fq);
                oacc[0][dt] = mfma16(p0, bv, oacc[0][dt]); oacc[1][dt] = mfma16(p1, bv, oacc[1][dt]);
            }
        }
        asm volatile("s_waitcnt lgkmcnt(0)" ::: "memory");
    }
#pragma unroll
    for (int mt = 0; mt < 2; ++mt)
#pragma unroll
        for (int dt = 0; dt < 4; ++dt)
#pragma unroll
            for (int r = 0; r < 4; ++r) Pw[(mt * 16 + 4 * fq + r) * 72 + dt * 16 + fr] = (bf16)f2bf(oacc[mt][dt][r]);
    asm volatile("s_waitcnt lgkmcnt(0)" ::: "memory");
#pragma unroll
    for (int k = 0; k < 4; ++k) {
        const int ci = lane + 64 * k, row = ci >> 3, part = ci & 7;
        *(v4u*)(ATT + (size_t)(tb + q0 + qs + row) * D + hh * 64 + part * 8) = *(const v4u*)(Pw + row * 72 + part * 8);
    }
    __syncthreads();
}

__device__ __forceinline__ void swa_attn_sample(const bf16* __restrict__ PCb, const float* __restrict__ cache_k, const float* __restrict__ cache_v,
                                                const float* __restrict__ rel_bias, const float* __restrict__ sinks, bf16* __restrict__ ATT, int gw, int lane) {
    const int sb = gw >> 4, h = gw & 15, kvh = h >> 2, t = NP + sb;
    const bf16* qrow = PCb + (size_t)t * CN + h * 64;
    float lg[2];
#pragma unroll
    for (int rr = 0; rr < 2; ++rr) {
        const int r = lane + 64 * rr;
        float dot = 0.f;
        if (r == 0) {
            const bf16* krow = PCb + (size_t)t * CN + 1024 + kvh * 64;
            for (int d = 0; d < 64; ++d) dot += bf2f(qrow[d]) * bf2f(krow[d]);
        } else {
            const float* krow = cache_k + (((size_t)sb * 128 + (128 - r)) * 4 + kvh) * 64;
#pragma unroll
            for (int d4 = 0; d4 < 16; ++d4) { const float4 kv = *(const float4*)(krow + d4 * 4);
                dot += bf2f(qrow[d4 * 4]) * kv.x + bf2f(qrow[d4 * 4 + 1]) * kv.y + bf2f(qrow[d4 * 4 + 2]) * kv.z + bf2f(qrow[d4 * 4 + 3]) * kv.w; }
        }
        lg[rr] = dot * 0.125f + rel_bias[t5_bucket(r) * 16 + h];
    }
    const float sink = sinks[h];
    const float m = fmaxf(wave_max(fmaxf(lg[0], lg[1])), sink);
    float p[2] = {expf(lg[0] - m), expf(lg[1] - m)};
    const float inv = 1.0f / (wave_sum(p[0] + p[1]) + expf(sink - m));
    float o = 0.f;
#pragma unroll
    for (int rr = 0; rr < 2; ++rr)
        for (int l2 = 0; l2 < 64; ++l2) {
            const int r = l2 + 64 * rr;
            const float pj = __shfl(p[rr], l2);
            const float vv = (r == 0) ? bf2f(PCb[(size_t)t * CN + 1280 + kvh * 64 + lane]) : cache_v[(((size_t)sb * 128 + (128 - r)) * 4 + kvh) * 64 + lane];
            o += pj * vv;
        }
    ATT[(size_t)t * D + h * 64 + lane] = (bf16)f2bf(o * inv);
}
__device__ __forceinline__ void swa_kv_out2(const bf16* __restrict__ PCb, const float* __restrict__ cache_k, const float* __restrict__ cache_v,
                                            float* __restrict__ pk, float* __restrict__ pv, float* __restrict__ sk, float* __restrict__ sv, int vb) {
    int tx_ = threadIdx.x; asm volatile("" : "+v"(tx_));
    const int c = tx_ & 255, row = vb * 2 + (tx_ >> 8);
    if (row < NB * 128) {
        const int b = row >> 7, i = row & 127;
        const bf16* src = PCb + (size_t)(b * SEQ + SEQ - 128 + i) * CN;
        pk[(size_t)row * 256 + c] = bf2f(src[1024 + c]);
        pv[(size_t)row * 256 + c] = bf2f(src[1280 + c]);
    } else {
        const int r2 = row - NB * 128, sb = r2 >> 7, i = r2 & 127;
        if (i < 127) {
            sk[(size_t)r2 * 256 + c] = cache_k[((size_t)sb * 128 + i + 1) * 256 + c];
            sv[(size_t)r2 * 256 + c] = cache_v[((size_t)sb * 128 + i + 1) * 256 + c];
        } else {
            const bf16* src = PCb + (size_t)(NP + sb) * CN;
            sk[(size_t)r2 * 256 + c] = bf2f(src[1024 + c]);
            sv[(size_t)r2 * 256 + c] = bf2f(src[1280 + c]);
        }
    }
}

constexpr size_t MiB = 1u << 20;
constexpr size_t WS_CTL = 0, CTL_ZERO_BYTES = 64 * 1024;
constexpr size_t WS_WAB = 1 * MiB;
constexpr size_t WS_WOUT = WS_WAB + (size_t)ABNP * D * 2;
constexpr size_t WS_WQ0 = WS_WOUT + (size_t)D * D * 2;
constexpr size_t WS_WQ1 = WS_WQ0 + (size_t)2048 * D * 2;
constexpr size_t WS_WINC = WS_WQ1 + (size_t)2048 * D * 2;
constexpr size_t WS_WOUTC = WS_WINC + (size_t)CN * D * 2;
constexpr size_t WS_ABUF = WS_WOUTC + (size_t)D * D * 2;
constexpr size_t WS_P = WS_ABUF + (size_t)MP * D * 2;
constexpr size_t WS_T = WS_P + (size_t)MP * ABN * 2;
constexpr size_t WS_Q = WS_T + (size_t)4 * 16384 * D + (size_t)4 * 16384 * 4;
constexpr size_t WS_A = WS_Q + (size_t)MP * 1536 * 4;
constexpr size_t WS_B = WS_A + (size_t)MP * 512 * 4;
constexpr size_t WS_O = WS_B + (size_t)MP * 512 * 4;
constexpr size_t WS_X1 = WS_O + (size_t)MP * 512 * 4;
constexpr size_t WS_G = WS_X1 + (size_t)MP * D * 4;
constexpr size_t WS_BETA = WS_G + (size_t)MP * 4 * 4;
constexpr size_t WS_GATE = WS_BETA + (size_t)MP * 4 * 4;
constexpr size_t WS_EXP = WS_GATE + (size_t)MP * 128 * 4;
constexpr size_t WS_HEND = WS_EXP + (size_t)MP * 128 * 4;
constexpr size_t WS_KEYS = WS_HEND + (size_t)3 * 4 * 64 * 512 * 4;
constexpr size_t WS_END = WS_KEYS + (size_t)2 * 8 * 2 * 128 * 128 * 2;
constexpr size_t Q_QKVS = 0, Q_W = 1 * MiB, Q_QG = Q_W + 16 * MiB, Q_KDT = Q_QG + 16 * MiB, Q_UT = Q_KDT + 16 * MiB, Q_QK = Q_UT + 16 * MiB, Q_EGL = Q_QK + 8 * MiB, Q_END = Q_EGL + 4096;
static_assert(Q_END <= (size_t)MP * 1536 * 4, "region Q");
static_assert(WS_END <= 512 * MiB, "d_ws map");

struct MegaArgs {
    const float* in[35];
    float* out;
    unsigned char* ws;
};

__global__ void __launch_bounds__(NTH, 2) fwd_megakernel(MegaArgs ma) {
    cg::grid_group grid = cg::this_grid();
    extern __shared__ __attribute__((aligned(16))) unsigned char lds[];
    float* smem = (float*)lds;
    const int nb = gridDim.x, b0 = blockIdx.x, wave = __builtin_amdgcn_readfirstlane(threadIdx.x >> 6);
    int tid = threadIdx.x, lane = tid & 63;
    const float* x_prompt = ma.in[0];
    const float* x_sample = ma.in[1];
    const float* state_gdn = ma.in[2];
    const float* state_gdn_conv = ma.in[3];
    const float* state_lru = ma.in[4];
    const float* state_lru_conv = ma.in[5];
    const float* cache_k = ma.in[6];
    const float* cache_v = ma.in[7];
    const float* w_in_ab = ma.in[8];
    const float* gdn_conv_w = ma.in[9];
    const float* gdn_a_log = ma.in[10];
    const float* gdn_dt_bias = ma.in[11];
    const float* gdn_norm_w = ma.in[12];
    const float* lru_conv_w = ma.in[13];
    const float* lru_conv_b = ma.in[14];
    const float* lru_w_r = ma.in[15];
    const float* lru_b_r = ma.in[16];
    const float* lru_w_i = ma.in[17];
    const float* lru_b_i = ma.in[18];
    const float* lru_lam = ma.in[19];
    const float* w_out_ab = ma.in[20];
    const float* w_in_c = ma.in[21];
    const float* b_in_c = ma.in[22];
    const float* swa_sinks = ma.in[23];
    const float* w_out_c = ma.in[24];
    const float* b_out_c = ma.in[25];
    const float* rel_bias = ma.in[26];
    const float* ln_mix_g = ma.in[27];
    const float* ln_mix_b = ma.in[28];
    const float* ln_ffn_g = ma.in[29];
    const float* ln_ffn_b = ma.in[30];
    const float* peer_w_q = ma.in[31];
    const float* peer_keys = ma.in[32];
    const float* peer_u = ma.in[33];
    const float* peer_v = ma.in[34];

    float* out = ma.out;
    float* o_y = out;
    float* o_p_gdn = out + (size_t)NT * D;
    float* o_p_gdn_conv = o_p_gdn + 262144;
    float* o_p_lru = o_p_gdn_conv + 18432;
    float* o_p_lru_conv = o_p_lru + 2048;
    float* o_p_k = o_p_lru_conv + 6144;
    float* o_p_v = o_p_k + 131072;
    float* o_s_gdn = o_p_v + 131072;
    float* o_s_gdn_conv = o_s_gdn + 8388608;
    float* o_s_lru = o_s_gdn_conv + 589824;
    float* o_s_lru_conv = o_s_lru + 65536;
    float* o_s_k = o_s_lru_conv + 196608;
    float* o_s_v = o_s_k + 4194304;

    unsigned char* ws = ma.ws;
    bf16* WAB_T = (bf16*)(ws + WS_WAB); bf16* WOUT_T = (bf16*)(ws + WS_WOUT); bf16* WQ0_T = (bf16*)(ws + WS_WQ0); bf16* WQ1_T = (bf16*)(ws + WS_WQ1);
    bf16* WINC_T = (bf16*)(ws + WS_WINC); bf16* WOUTC_T = (bf16*)(ws + WS_WOUTC);
    bf16* ABUF = (bf16*)(ws + WS_ABUF);
    bf16* PROJ = (bf16*)(ws + WS_P); float* Y = (float*)(ws + WS_P); bf16* Qb = (bf16*)(ws + WS_P); bf16* PCb = (bf16*)(ws + WS_P); float* Y1 = (float*)(ws + WS_P);
    unsigned char* TAB8 = ws + WS_T; float* TSC = (float*)(ws + WS_T + (size_t)4 * 16384 * D);
    float* R_Q = (float*)(ws + WS_Q + Q_QKVS) - (size_t)NP * 1536; float* X2 = (float*)(ws + WS_A);
    GdnChunkBufs cbuf; cbuf.W = (bf16*)(ws + WS_Q + Q_W); cbuf.QG = (bf16*)(ws + WS_Q + Q_QG); cbuf.KDT = (bf16*)(ws + WS_Q + Q_KDT); cbuf.UT = (bf16*)(ws + WS_Q + Q_UT); cbuf.QK = (bf16*)(ws + WS_Q + Q_QK); cbuf.EGL = (float*)(ws + WS_Q + Q_EGL);
    bf16* KEYSB = (bf16*)(ws + WS_KEYS);
    float* HEND = (float*)(ws + WS_HEND); float* PEND = HEND + 4 * 64 * 512; float* CIN = PEND + 4 * 64 * 512;
    float* R_A = (float*)(ws + WS_A); float* R_B = (float*)(ws + WS_B); float* R_O = (float*)(ws + WS_O);
    float* R_X1 = (float*)(ws + WS_X1); float* X3 = R_X1;
    float* R_G = (float*)(ws + WS_G); float* R_BETA = (float*)(ws + WS_BETA); float* R_GATE = (float*)(ws + WS_GATE); int* R_EXP = (int*)(ws + WS_EXP);

    for (int u = tid; u < (LDS_BYTES - RING_BYTES) / 4; u += NTH) ((unsigned*)(lds + RING_BYTES))[u] = 0u;
    __syncthreads();
    XcdBarrier bar = xcd_barrier_post((unsigned*)(ws + WS_CTL), (volatile LAS unsigned*)((LAS unsigned char*)lds + MISC_OFF) + 8);
#define GRID_BAR() do { xcd_barrier(bar); asm volatile("" : "+v"(tid)); lane = tid & 63; } while (0)
#define PHASE_LOOP(n) for (int vb = b0; vb < (n); vb += nb)
#define PHASE_END __syncthreads()
#define GEMM_PHASE(EPI, Aptr, Btptr, Nn, ...) do { pg8::Gemm g_{(const pg8::bf16_t*)(Aptr), (const pg8::bf16_t*)(Btptr), MP, (Nn), D}; pg8::StaticOrder S_; S_.init(MP, (Nn), nb, b0); \
        pg8::EPI E_{__VA_ARGS__}; pg8::gemm_phase<pg8::EPI, pg8::StaticOrder, true, true>((PG8_LAS unsigned char*)lds, g_, S_, E_); } while (0)

    {
        float* scr = smem + wave * 4096;
        const int gw = b0 * NWAVES + wave, NGW = nb * NWAVES;
        constexpr int I_AB = 16 * 97, I_OUT = 16 * 32, I_Q = 16 * 64, I_INC = 16 * 48;
        constexpr int NITEMS = I_AB + I_OUT + 2 * I_Q + I_INC + I_OUT;
        for (int it = gw; it < NITEMS; it += NGW) {
            int r = it;
            if (r < I_AB) { p0_transpose_item(w_in_ab, D, ABN, WAB_T, scr, r, lane); continue; } r -= I_AB;
            if (r < I_OUT) { p0_transpose_item(w_out_ab, D, D, WOUT_T, scr, r, lane); continue; } r -= I_OUT;
            if (r < I_Q) { p0_transpose_item(peer_w_q, D, 2048, WQ0_T, scr, r, lane); continue; } r -= I_Q;
            if (r < I_Q) { p0_transpose_item(peer_w_q + (size_t)D * 2048, D, 2048, WQ1_T, scr, r, lane); continue; } r -= I_Q;
            if (r < I_INC) { p0_transpose_item(w_in_c, D, CN, WINC_T, scr, r, lane); continue; } r -= I_INC;
            p0_transpose_item(w_out_c, D, D, WOUTC_T, scr, r, lane);
        }
        for (int m = gw; m < MP + (ABNP - 97 * 32); m += NGW) {
            if (m < MP) row_to_bf16(m < NP ? x_prompt + (size_t)m * D : (m < NT ? x_sample + (size_t)(m - NP) * D : nullptr), ABUF + (size_t)m * D, lane);
            else row_to_bf16(nullptr, WAB_T + (size_t)(97 * 32 + (m - MP)) * D, lane);
        }
    }
    grid.sync();
    GEMM_PHASE(EpiStoreBf16, ABUF, WAB_T, ABNP, PROJ, ABN, nullptr, NT, ABN);
    GRID_BAR();
    { AbPrepArgs pa;
      pa.PROJ = PROJ; pa.st_gdn_conv = state_gdn_conv; pa.st_lru_conv = state_lru_conv;
      pa.gdn_conv_w = gdn_conv_w; pa.a_log = gdn_a_log; pa.dt_bias = gdn_dt_bias;
      pa.lru_conv_w = lru_conv_w; pa.lru_conv_b = lru_conv_b; pa.w_r = lru_w_r; pa.b_r = lru_b_r; pa.w_i = lru_w_i; pa.b_i = lru_b_i; pa.lam = lru_lam;
      pa.QKV = R_Q; pa.G = R_G; pa.BETA = R_BETA; pa.LA = R_A; pa.LB = R_B;
      pa.p_gdn_conv = o_p_gdn_conv; pa.p_lru_conv = o_p_lru_conv; pa.s_gdn_conv = o_s_gdn_conv; pa.s_lru_conv = o_s_lru_conv;
      PHASE_LOOP(1024 + 256 + NS) {
          if (vb < 1024) gdn_prep_unit(PROJ, gdn_conv_w, gdn_a_log, gdn_dt_bias, cbuf, o_p_gdn_conv, vb, lds);
          else if (vb < 1280) lru_prep_unit(PROJ, lru_conv_w, lru_conv_b, lru_w_r, lru_b_r, lru_w_i, lru_b_i, lru_lam, R_B, R_A, HEND, PEND, o_p_lru_conv, vb - 1024);
          else { ab_prep(pa, NP + (vb - 1280), smem); PHASE_END; } } }
    GRID_BAR();
    if (b0 < 64) gdn_seq(cbuf, R_O, o_p_gdn, b0 >> 4, (b0 >> 2) & 3, b0 & 3, lds);
    else if (b0 < 68) lru_carry(HEND, PEND, CIN, o_p_lru, b0 - 64);
    else {
        for (int v = b0 - 68; v < 2048 + 128; v += nb - 68) {
            if (v < 2048) gdn_scan(R_Q, R_G, R_BETA, state_gdn, R_O, o_s_gdn, NP, 1, v & 3, (v >> 2) & 3, v >> 4, smem);
            else lru_scan(R_A, R_B, state_lru, o_s_lru, NP, 1, NS, v - 2048);
            PHASE_END;
        }
        const int gw2 = (b0 - 68) * NWAVES + wave, NGW2 = (nb - 68) * NWAVES;
        for (int m = gw2; m < 512; m += NGW2) row_to_bf16(peer_keys + (size_t)m * D, KEYSB + (size_t)m * D, lane);
        for (int m = gw2; m < 4 * 16384; m += NGW2) {
            const int k = m >> 14, r = m & 16383;
            row_to_fp8(((k & 1) ? peer_v : peer_u) + ((size_t)(k >> 1) * 16384 + r) * D, TAB8 + (size_t)m * D, TSC + m, lane);
        }
    }
    GRID_BAR();
    PHASE_LOOP(NT / 2) { ab_mix(PROJ, R_O, R_B, R_A, CIN, gdn_norm_w, ABUF, vb); }
    GRID_BAR();
    GEMM_PHASE(EpiStoreF32, ABUF, WOUT_T, D, Y, D, nullptr, NT, D);
    GRID_BAR();
    PHASE_LOOP(NT / 8) { const int t = vb * 8 + wave;
        ln_res_w(t < NP ? x_prompt + (size_t)t * D : x_sample + (size_t)(t - NP) * D, Y + (size_t)t * D, ln_mix_g, ln_mix_b, R_X1 + (size_t)t * D, ABUF + (size_t)t * D, lane); }
    GRID_BAR();
    GEMM_PHASE(EpiStoreBf16, ABUF, WQ0_T, 2048, Qb, 2048, nullptr, NT, 2048);
    GRID_BAR();
    PHASE_LOOP((NT / 64) * 8) { peer_topk3(Qb, KEYSB, R_EXP, R_GATE, vb >> 3, vb & 7, lds); }
    GRID_BAR();
    PHASE_LOOP(NT / 8) { const int t = vb * 8 + wave;
        peer_expert_w(R_X1 + (size_t)t * D, R_EXP + (size_t)t * 128, R_GATE + (size_t)t * 128, TAB8, TAB8 + (size_t)16384 * D, TSC, TSC + 16384, ln_ffn_g, ln_ffn_b, X2 + (size_t)t * D, ABUF + (size_t)t * D, lane); }
    GRID_BAR();

    GEMM_PHASE(EpiStoreBf16, ABUF, WINC_T, CN, PCb, CN, b_in_c, NT, CN);
    GRID_BAR();
    PHASE_LOOP(1024 + 256 + (NB * 128 + NS * 128) / 2) {
        if (vb < 1024) attn_unit(PCb, rel_bias, swa_sinks, ABUF, vb, lds);
        else if (vb < 1280) swa_attn_sample(PCb, cache_k, cache_v, rel_bias, swa_sinks, ABUF, (vb - 1024) * 8 + wave, lane);
        else swa_kv_out2(PCb, cache_k, cache_v, o_p_k, o_p_v, o_s_k, o_s_v, vb - 1280);
    }
    GRID_BAR();
    GEMM_PHASE(EpiStoreF32, ABUF, WOUTC_T, D, Y1, D, b_out_c, NT, D);
    GRID_BAR();
    PHASE_LOOP(NT / 8) { const int t = vb * 8 + wave;
        ln_res_w(X2 + (size_t)t * D, Y1 + (size_t)t * D, ln_mix_g + D, ln_mix_b + D, X3 + (size_t)t * D, ABUF + (size_t)t * D, lane); }
    GRID_BAR();
    GEMM_PHASE(EpiStoreBf16, ABUF, WQ1_T, 2048, Qb, 2048, nullptr, NT, 2048);
    GRID_BAR();
    PHASE_LOOP((NT / 64) * 8) { peer_topk3(Qb, KEYSB + (size_t)8 * 2 * 128 * 128, R_EXP, R_GATE, vb >> 3, vb & 7, lds); }
    GRID_BAR();
    PHASE_LOOP(NT / 8) { const int t = vb * 8 + wave;
        peer_expert_w(X3 + (size_t)t * D, R_EXP + (size_t)t * 128, R_GATE + (size_t)t * 128, TAB8 + (size_t)2 * 16384 * D, TAB8 + (size_t)3 * 16384 * D, TSC + 2 * 16384, TSC + 3 * 16384, ln_ffn_g + D, ln_ffn_b + D, o_y + (size_t)t * D, nullptr, lane); }
}
}

extern "C" void kernel_launch(void* const* d_in, const int* in_sizes, int n_in,
                              void* d_out, int out_size, void* d_ws, size_t ws_size,
                              hipStream_t stream) {
    static int grid_blocks = 0;
    if (!grid_blocks) {
        int dev = 0, cus = 0, per_cu = 0;
        (void)hipGetDevice(&dev);
        (void)hipDeviceGetAttribute(&cus, hipDeviceAttributeMultiprocessorCount, dev);
        if (hipFuncSetAttribute((const void*)fwd_megakernel, hipFuncAttributeMaxDynamicSharedMemorySize, LDS_BYTES) != hipSuccess) { fprintf(stderr, "hipFuncSetAttribute failed\n"); grid_blocks = -1; return; }
        (void)hipOccupancyMaxActiveBlocksPerMultiprocessor(&per_cu, (const void*)fwd_megakernel, NTH, LDS_BYTES);
        if (per_cu < 1) { fprintf(stderr, "occupancy query says %d blocks per CU\n", per_cu); grid_blocks = -1; return; }
        grid_blocks = cus;
    }
    if (grid_blocks < 0) return;
    (void)hipMemsetAsync((char*)d_ws + WS_CTL, 0, CTL_ZERO_BYTES, stream);
    MegaArgs ma{};
    for (int i = 0; i < 35; ++i) ma.in[i] = (const float*)d_in[i];
    ma.out = (float*)d_out;
    ma.ws = (unsigned char*)d_ws;
    void* args[] = {&ma};
    hipError_t e = hipLaunchCooperativeKernel((void*)fwd_megakernel, dim3(grid_blocks), dim3(NTH), args, LDS_BYTES, stream);
    if (e != hipSuccess) fprintf(stderr, "cooperative launch failed: %s (grid %d)\n", hipGetErrorString(e), grid_blocks);
}
```

```cpp
#include <hip/hip_runtime.h>
#include <hip/hip_cooperative_groups.h>
#include <cstdio>
#include <cstdint>
namespace cg = cooperative_groups;

namespace pg8 {
#define PG8_LAS __attribute__((address_space(3)))
typedef unsigned short bf16_t;
typedef short bf16x8 __attribute__((ext_vector_type(8)));
typedef float f32x4 __attribute__((ext_vector_type(4)));
typedef unsigned u32x4 __attribute__((ext_vector_type(4)));
constexpr int BM = 256, BK = 64, HALF = 128, HTB = HALF * BK * 2  , STAGE_BYTES = 8 * HTB, NXCD = 8, WGM = 8;

__host__ __device__ __forceinline__ int lds_byte(int r, int c) { const int st = (r >> 4) * 2 + (c >> 5), rr = r & 15, cc = c & 31, ob = rr * 64 + cc * 2; return st * 1024 + (ob ^ (((ob >> 9) & 1) << 5)); }
__host__ __device__ __forceinline__ void stage_rc(int b, int& R, int& C) { const int st = b / 1024, sb = b % 1024, swz = sb ^ (((sb >> 9) & 1) << 5); R = (st >> 1) * 16 + swz / 64; C = (st & 1) * 32 + (swz % 64) / 2; }
__host__ __device__ __forceinline__ int perm32(int rho) { const int n = rho >> 4, i = rho & 15; return 8 * (i >> 2) + 4 * n + (i & 3); }

struct Unit { int pm, pn; };
struct Gemm { const bf16_t* A; const bf16_t* Bt; int M, N, K; };

struct StaticOrder {
    int nM, nN, nwg, G, c;
    __host__ __device__ void init(int M, int N, int G_, int c_) { nM = M / BM; nN = N / BM; nwg = nM * nN; G = G_; c = c_; }
    __host__ __device__ bool next(int i, Unit& u) const {
        const long L = (long)i * G + c; if (L >= nwg) return false;
        int wgid = (int)L; { const int q = nwg / NXCD, r = nwg % NXCD, xcd = wgid % NXCD, off = wgid / NXCD; wgid = (xcd < r ? xcd * (q + 1) : r * (q + 1) + (xcd - r) * q) + off; }
        const int nig = WGM * nN, gid = wgid / nig, fm = gid * WGM, gsz = (nM - fm) < WGM ? (nM - fm) : WGM;
        u.pm = fm + ((wgid % nig) % gsz); u.pn = (wgid % nig) / gsz; return true;
    }
    __device__ __forceinline__ void a_ready(const Unit&) const {}
    __device__ __forceinline__ void done(const Unit&) const {}
};

__device__ __forceinline__ unsigned cvt_pk_bf16(float lo, float hi) { unsigned r; asm volatile("v_cvt_pk_bf16_f32 %0, %1, %2" : "=v"(r) : "v"(lo), "v"(hi)); return r; }
template <class Epi, class Sched, bool ALIGN_EPI = false, bool SP2 = false>
__device__ __forceinline__ void gemm_phase(PG8_LAS unsigned char* lds, const Gemm g, const Sched& S, const Epi& E) {
    int tid_ = threadIdx.x; asm volatile("" : "+v"(tid_));
    const int tid = tid_, wid = __builtin_amdgcn_readfirstlane(tid >> 6), lane = tid & 63, wr = wid >> 2, wc = wid & 3, fr = lane & 15, fq = lane >> 4;
    const int K = g.K, nt = K / BK;
    unsigned voffA[2], voffB[2];
#pragma unroll
    for (int i = 0; i < 2; ++i) { int R, C; stage_rc(tid * 16 + i * 8192, R, C); const int Rb = Epi::PERM ? ((R & ~31) + perm32(R & 31)) : R;
        voffA[i] = (unsigned)(R * K + C) * 2u; voffB[i] = (unsigned)(Rb * K + C) * 2u; }
    const size_t kstep = (size_t)(BK * 2);
    const size_t hstep = (size_t)HALF * K * 2;
    const size_t tstep = 2 * hstep;
    const unsigned ldsw = (unsigned)wid * 1024u;
    const int aoff = lds_byte(wr * 64 + fr, fq * 8), boff = lds_byte(wc * 32 + fr, fq * 8);
#define PG8_SA(b, h) (((b) * 2 + (h)) * HTB)
#define PG8_SB(b, h) ((4 + (b) * 2 + (h)) * HTB)
#define PG8_STAGE(bufoff, gbase, voff) do { _Pragma("unroll") for (int _i = 0; _i < 2; ++_i) \
        __builtin_amdgcn_global_load_lds((const unsigned*)((const char*)(gbase) + (voff)[_i]), (PG8_LAS unsigned*)(lds + (bufoff) + ldsw + _i * 8192), 16, 0, 0); } while (0)
#define PG8_LDA(dst, b, h) do { _Pragma("unroll") for (int m = 0; m < 4; ++m) _Pragma("unroll") for (int k = 0; k < 2; ++k) dst[m][k] = *(const PG8_LAS bf16x8*)(lds + PG8_SA(b, h) + aoff + m * 2048 + k * 1024); } while (0)
#define PG8_LDB(dst, b, h) do { _Pragma("unroll") for (int n = 0; n < 2; ++n) _Pragma("unroll") for (int k = 0; k < 2; ++k) dst[n][k] = *(const PG8_LAS bf16x8*)(lds + PG8_SB(b, h) + boff + n * 2048 + k * 1024); } while (0)
#define PG8_MMA(ai, bj, At, Bt) do { __builtin_amdgcn_s_setprio(1); _Pragma("unroll") for (int m = 0; m < 4; ++m) _Pragma("unroll") for (int n = 0; n < 2; ++n) _Pragma("unroll") for (int k = 0; k < 2; ++k) \
        acc[ai][bj][m][n] = __builtin_amdgcn_mfma_f32_16x16x32_bf16(Bt[n][k], At[m][k], acc[ai][bj][m][n], 0, 0, 0); __builtin_amdgcn_s_setprio(0); } while (0)
#define PG8_WAIT_V(n) asm volatile("s_waitcnt vmcnt(" #n ")" ::: "memory")
#define PG8_WAIT_L(n) asm volatile("s_waitcnt lgkmcnt(" #n ")" ::: "memory")
#define PG8_BAR __builtin_amdgcn_s_barrier()
#define PG8_SCHED __builtin_amdgcn_sched_barrier(0)
    Unit cur, nxt; int ui = 0;
    if (!S.next(0, cur)) return;
    f32x4 acc[2][2][4][2];
#pragma unroll
    for (int a = 0; a < 2; ++a)
#pragma unroll
        for (int b = 0; b < 2; ++b)
#pragma unroll
            for (int m = 0; m < 4; ++m)
#pragma unroll
                for (int n = 0; n < 2; ++n) acc[a][b][m][n] = (f32x4){0.f, 0.f, 0.f, 0.f};
    bf16x8 At[4][2], B0[2][2], B1[2][2];
    const char* cA = (const char*)g.A + (size_t)cur.pm * tstep; const char* cB = (const char*)g.Bt + (size_t)cur.pn * tstep;
    S.a_ready(cur);
    if constexpr (SP2) {
        PG8_STAGE(PG8_SB(0, 0), cB, voffB); PG8_STAGE(PG8_SB(0, 1), cB + hstep, voffB); PG8_STAGE(PG8_SA(0, 0), cA, voffA); PG8_STAGE(PG8_SA(0, 1), cA + hstep, voffA);
        if (wr == 1) PG8_BAR;
        PG8_WAIT_V(2); PG8_BAR;
        PG8_STAGE(PG8_SB(1, 0), cB + kstep, voffB); PG8_STAGE(PG8_SA(1, 0), cA + kstep, voffA); PG8_STAGE(PG8_SB(1, 1), cB + hstep + kstep, voffB);
        PG8_WAIT_V(6); PG8_BAR;
    } else {
        PG8_STAGE(PG8_SB(0, 0), cB, voffB); PG8_STAGE(PG8_SA(0, 0), cA, voffA); PG8_STAGE(PG8_SB(0, 1), cB + hstep, voffB); PG8_STAGE(PG8_SA(0, 1), cA + hstep, voffA);
        if (wr == 1) PG8_BAR;
        PG8_WAIT_V(4); PG8_BAR;
        PG8_STAGE(PG8_SB(1, 0), cB + kstep, voffB); PG8_STAGE(PG8_SA(1, 0), cA + kstep, voffA); PG8_STAGE(PG8_SB(1, 1), cB + hstep + kstep, voffB);
        PG8_WAIT_V(6); PG8_BAR;
    }
    for (;;) {
        const bool has_next = S.next(ui + 1, nxt);
        const char* nA = has_next ? (const char*)g.A + (size_t)nxt.pm * tstep : cA; const char* nB = has_next ? (const char*)g.Bt + (size_t)nxt.pn * tstep : cB;
        for (int t = 0; t < nt; t += 2) {
            const bool last = (t == nt - 2);
            const char* a1 = cA + (size_t)(t + 1) * kstep;
            const char* a2 = last ? nA : cA + (size_t)(t + 2) * kstep; const char* b2 = last ? nB : cB + (size_t)(t + 2) * kstep;
            const char* a3 = a2 + kstep; const char* b3 = b2 + kstep;
            if (last && has_next) S.a_ready(nxt);
            if constexpr (SP2) {
            PG8_LDB(B0, 0, 0); PG8_LDB(B1, 0, 1); PG8_SCHED; PG8_LDA(At, 0, 0); PG8_STAGE(PG8_SA(1, 1), a1 + hstep, voffA);
            PG8_WAIT_V(8); PG8_WAIT_L(0); PG8_BAR; PG8_MMA(0, 0, At, B0); PG8_MMA(0, 1, At, B1); PG8_BAR; PG8_SCHED;
            PG8_LDA(At, 0, 1); PG8_STAGE(PG8_SB(0, 0), b2, voffB); PG8_STAGE(PG8_SB(0, 1), b2 + hstep, voffB); PG8_STAGE(PG8_SA(0, 0), a2, voffA);
            PG8_WAIT_V(8); PG8_WAIT_L(0); PG8_BAR; PG8_MMA(1, 0, At, B0); PG8_MMA(1, 1, At, B1); PG8_BAR; PG8_SCHED;
            PG8_LDB(B0, 1, 0); PG8_LDB(B1, 1, 1); PG8_SCHED; PG8_LDA(At, 1, 0); PG8_STAGE(PG8_SA(0, 1), a2 + hstep, voffA);
            PG8_WAIT_V(8); PG8_WAIT_L(0); PG8_BAR; PG8_MMA(0, 0, At, B0); PG8_MMA(0, 1, At, B1); PG8_BAR; PG8_SCHED;
            PG8_LDA(At, 1, 1); PG8_STAGE(PG8_SB(1, 0), b3, voffB); PG8_STAGE(PG8_SB(1, 1), b3 + hstep, voffB); PG8_STAGE(PG8_SA(1, 0), a3, voffA);
            PG8_WAIT_V(8); PG8_WAIT_L(0); PG8_BAR; PG8_MMA(1, 0, At, B0); PG8_MMA(1, 1, At, B1); PG8_BAR; PG8_SCHED;
            } else {
            PG8_LDB(B0, 0, 0); PG8_SCHED; PG8_LDA(At, 0, 0); PG8_STAGE(PG8_SA(1, 1), a1 + hstep, voffA);
            PG8_WAIT_L(8); PG8_BAR; PG8_WAIT_L(0); PG8_MMA(0, 0, At, B0); PG8_BAR; PG8_SCHED;
            PG8_LDB(B1, 0, 1); PG8_STAGE(PG8_SB(0, 0), b2, voffB);
            PG8_BAR; PG8_WAIT_L(0); PG8_MMA(0, 1, At, B1); PG8_BAR;
            PG8_LDA(At, 0, 1); PG8_STAGE(PG8_SA(0, 0), a2, voffA);
            PG8_BAR; PG8_WAIT_L(0); PG8_MMA(1, 0, At, B0); PG8_BAR; PG8_SCHED;
            PG8_STAGE(PG8_SB(0, 1), b2 + hstep, voffB);
            PG8_WAIT_V(6); PG8_BAR; PG8_MMA(1, 1, At, B1); PG8_BAR;
            PG8_LDB(B0, 1, 0); PG8_SCHED; PG8_LDA(At, 1, 0); PG8_STAGE(PG8_SA(0, 1), a2 + hstep, voffA);
            PG8_WAIT_L(8); PG8_BAR; PG8_WAIT_L(0); PG8_MMA(0, 0, At, B0); PG8_BAR; PG8_SCHED;
            PG8_LDB(B1, 1, 1); PG8_STAGE(PG8_SB(1, 0), b3, voffB);
            PG8_BAR; PG8_WAIT_L(0); PG8_MMA(0, 1, At, B1); PG8_BAR;
            PG8_LDA(At, 1, 1); PG8_STAGE(PG8_SA(1, 0), a3, voffA);
            PG8_BAR; PG8_WAIT_L(0); PG8_MMA(1, 0, At, B0); PG8_BAR; PG8_SCHED;
            PG8_STAGE(PG8_SB(1, 1), b3 + hstep, voffB);
            PG8_WAIT_V(6); PG8_BAR; PG8_MMA(1, 1, At, B1); PG8_BAR;
            }
        }
        if constexpr (ALIGN_EPI) { if (wr == 0) PG8_BAR; }
        if constexpr (!Epi::AFTER_DRAIN) { E(acc, cur, wr, wc, fr, fq); S.done(cur); }
        if (!has_next) break;
#pragma unroll
        for (int a = 0; a < 2; ++a)
#pragma unroll
            for (int b = 0; b < 2; ++b)
#pragma unroll
                for (int m = 0; m < 4; ++m)
#pragma unroll
                    for (int n = 0; n < 2; ++n) acc[a][b][m][n] = (f32x4){0.f, 0.f, 0.f, 0.f};
        cur = nxt; cA = nA; cB = nB; ++ui;
        if constexpr (ALIGN_EPI) { if (wr == 1) PG8_BAR; }
    }
    PG8_WAIT_V(0);
    if constexpr (!ALIGN_EPI) { if (wr == 0) PG8_BAR; }
    PG8_BAR;
    if constexpr (Epi::AFTER_DRAIN) { E.fused(acc, cur, wr, wc, fr, fq, lds, wid, lane); S.done(cur); }
#undef PG8_SA
#undef PG8_SB
#undef PG8_STAGE
#undef PG8_LDA
#undef PG8_LDB
#undef PG8_MMA
#undef PG8_WAIT_V
#undef PG8_WAIT_L
#undef PG8_BAR
#undef PG8_SCHED
}
}
namespace pg8 {
struct EpiStoreBf16 {
    static constexpr bool PERM = true, AFTER_DRAIN = false;
    bf16_t* O; int ldc; const float* bias; int m_real, n_real;
    __device__ __forceinline__ void operator()(const f32x4 (&acc)[2][2][4][2], const Unit& u, int wr, int wc, int fr, int fq) const {
        const int row0 = u.pm * BM + wr * 64 + fr, col0 = u.pn * BM + wc * 32 + 8 * fq;
#pragma unroll
        for (int bj = 0; bj < 2; ++bj) {
            const int col = col0 + bj * HALF;
            if (col >= n_real) continue;
            f32x4 b0 = (f32x4){0.f, 0.f, 0.f, 0.f}, b1 = b0;
            if (bias) { b0 = *(const f32x4*)(bias + col); b1 = *(const f32x4*)(bias + col + 4); }
#pragma unroll
            for (int ai = 0; ai < 2; ++ai)
#pragma unroll
                for (int m = 0; m < 4; ++m) {
                    const int row = row0 + ai * HALF + m * 16;
                    if (row >= m_real) continue;
                    const f32x4 v0 = acc[ai][bj][m][0] + b0, v1 = acc[ai][bj][m][1] + b1;
                    u32x4 w; w.x = cvt_pk_bf16(v0[0], v0[1]); w.y = cvt_pk_bf16(v0[2], v0[3]); w.z = cvt_pk_bf16(v1[0], v1[1]); w.w = cvt_pk_bf16(v1[2], v1[3]);
                    *(u32x4*)(O + (size_t)row * ldc + col) = w;
                }
        }
    }
};
struct EpiStoreF32 {
    static constexpr bool PERM = false, AFTER_DRAIN = false;
    float* O; int ldc; const float* bias; int m_real, n_real;
    __device__ __forceinline__ void operator()(const f32x4 (&acc)[2][2][4][2], const Unit& u, int wr, int wc, int fr, int fq) const {
        const int row0 = u.pm * BM + wr * 64 + fr, col0 = u.pn * BM + wc * 32 + 4 * fq;
#pragma unroll
        for (int bj = 0; bj < 2; ++bj)
#pragma unroll
            for (int n = 0; n < 2; ++n) {
                const int col = col0 + bj * HALF + n * 16;
                if (col >= n_real) continue;
                const f32x4 bv = bias ? *(const f32x4*)(bias + col) : (f32x4){0.f, 0.f, 0.f, 0.f};
#pragma unroll
                for (int ai = 0; ai < 2; ++ai)
#pragma unroll
                    for (int m = 0; m < 4; ++m) {
                        const int row = row0 + ai * HALF + m * 16;
                        if (row >= m_real) continue;
                        *(f32x4*)(O + (size_t)row * ldc + col) = acc[ai][bj][m][n] + bv;
                    }
            }
    }
};
}
namespace {
#define GAS __attribute__((address_space(1)))
#define LAS __attribute__((address_space(3)))
typedef unsigned short bf16;
typedef float f32x4 __attribute__((ext_vector_type(4)));
typedef unsigned v4u __attribute__((ext_vector_type(4)));
typedef unsigned v2u __attribute__((ext_vector_type(2)));

constexpr int D = 1024, NB = 4, SEQ = 4096, NP = NB * SEQ, NS = 128, NT = NP + NS, MP = 16640;
constexpr int ABN = 3080, ABNP = 3328;
constexpr int C_QKV = 0, C_Z = 1536, C_A = 2048, C_B = 2052, C_XR = 2056, C_GATE = 2568;
constexpr int CN = 1536;
constexpr float ALPHA = 1.4142135623730951f;
constexpr float LN_EPS = 1e-5f;
constexpr int NTH = 512, NWAVES = 8;
constexpr int RING_BYTES = 131072, MISC_OFF = RING_BYTES + 320, LDS_BYTES = 147456;

__device__ __forceinline__ float bf2f(bf16 v) { return __uint_as_float((unsigned)v << 16); }
__device__ __forceinline__ unsigned f2bf(float f) { unsigned u = __float_as_uint(f); return (u + 0x7fffu + ((u >> 16) & 1u)) >> 16; }
__device__ __forceinline__ unsigned pk2(float lo, float hi) { return f2bf(lo) | (f2bf(hi) << 16); }
__device__ __forceinline__ float sigmoidf_(float x) { return 1.0f / (1.0f + expf(-x)); }
__device__ __forceinline__ float softplusf_(float x) { return fmaxf(x, 0.f) + log1pf(expf(-fabsf(x))); }
__device__ __forceinline__ float siluf_(float x) { return x / (1.0f + expf(-x)); }
__device__ __forceinline__ float geluf_(float x) { return 0.5f * x * (1.0f + tanhf(0.7978845608028654f * (x + 0.044715f * x * x * x))); }
__device__ __forceinline__ float wave_sum(float v) {
#pragma unroll
    for (int o = 32; o > 0; o >>= 1) v += __shfl_xor(v, o);
    return v;
}
__device__ __forceinline__ float wave_max(float v) {
#pragma unroll
    for (int o = 32; o > 0; o >>= 1) v = fmaxf(v, __shfl_xor(v, o));
    return v;
}

__device__ __forceinline__ void p0_transpose_item(const float* __restrict__ W, int K, int N, bf16* __restrict__ WT, float* scr, int item, int lane) {
    const int nblk = (N + 31) / 32, kb = item / nblk, nb = item % nblk, k0 = 64 * kb, n0 = 32 * nb;
#pragma unroll 8
    for (int i = 0; i < 32; ++i) { const int kk = 2 * i + (lane >> 5), n = n0 + (lane & 31); scr[kk * 33 + (lane & 31)] = n < N ? W[(size_t)(k0 + kk) * N + n] : 0.f; }
    asm volatile("s_waitcnt lgkmcnt(0)" ::: "memory");
    const int c = lane & 7;
#pragma unroll
    for (int j = 0; j < 4; ++j) { const int n = (lane >> 3) + 8 * j; const float* s = scr + (8 * c) * 33 + n;
        v4u o; o.x = pk2(s[0 * 33], s[1 * 33]); o.y = pk2(s[2 * 33], s[3 * 33]); o.z = pk2(s[4 * 33], s[5 * 33]); o.w = pk2(s[6 * 33], s[7 * 33]);
        *(v4u*)(WT + (size_t)(n0 + n) * K + k0 + 8 * c) = o; }
    asm volatile("s_waitcnt lgkmcnt(0)" ::: "memory");
}
__device__ __forceinline__ void row_to_bf16(const float* __restrict__ xrow, bf16* __restrict__ orow, int lane) {
#pragma unroll
    for (int j = 0; j < 4; ++j) {
        f32x4 v = (f32x4){0.f, 0.f, 0.f, 0.f};
        if (xrow) v = ((const f32x4*)xrow)[lane + 64 * j];
        v2u o; o.x = pk2(v.x, v.y); o.y = pk2(v.z, v.w);
        ((v2u*)orow)[lane + 64 * j] = o;
    }
}

struct AbPrepArgs {
    const bf16* PROJ; const float* st_gdn_conv; const float* st_lru_conv;
    const float* gdn_conv_w; const float* a_log; const float* dt_bias;
    const float* lru_conv_w; const float* lru_conv_b; const float* w_r; const float* b_r; const float* w_i; const float* b_i; const float* lam;
    float* QKV; float* G; float* BETA; float* LA; float* LB;
    float* p_gdn_conv; float* p_lru_conv; float* s_gdn_conv; float* s_lru_conv;
};
__device__ __forceinline__ void ab_prep(const AbPrepArgs& a, int t, float* smem) {
    int tid = threadIdx.x; asm volatile("" : "+v"(tid));
    const int lane = tid & 63, wid = tid >> 6;
    const bool samp = t >= NP; const int sb = t - NP, pos = t % SEQ, b = t / SEQ;
    float* sq = smem;
    float* sx = smem + 1536;
    float* scl = smem + 2048;
    const bf16* prow = a.PROJ + (size_t)t * ABN;
    for (int c = tid; c < 1536; c += NTH) {
        float acc = 0.f;
#pragma unroll
        for (int i = 0; i < 4; ++i) {
            float xv;
            if (i == 3) xv = bf2f(prow[C_QKV + c]);
            else if (samp) xv = a.st_gdn_conv[((size_t)sb * 3 + i) * 1536 + c];
            else xv = (pos - 3 + i >= 0) ? bf2f(a.PROJ[(size_t)(t - 3 + i) * ABN + C_QKV + c]) : 0.f;
            acc += a.gdn_conv_w[i * 1536 + c] * xv;
        }
        sq[c] = siluf_(acc);
    }
    {
        const int c = tid;
        float acc = a.lru_conv_b[c];
#pragma unroll
        for (int i = 0; i < 4; ++i) {
            float xv;
            if (i == 3) xv = bf2f(prow[C_XR + c]);
            else if (samp) xv = a.st_lru_conv[((size_t)sb * 3 + i) * 512 + c];
            else xv = (pos - 3 + i >= 0) ? bf2f(a.PROJ[(size_t)(t - 3 + i) * ABN + C_XR + c]) : 0.f;
            acc += a.lru_conv_w[i * 512 + c] * xv;
        }
        sx[c] = acc;
    }
    __syncthreads();
    {
        const int grp = wid;
        const float v0 = sq[grp * 128 + lane], v1 = sq[grp * 128 + 64 + lane];
        const float s = wave_sum(v0 * v0 + v1 * v1);
        if (lane == 0) scl[grp] = rsqrtf(s + 1e-6f) * (grp < 4 ? 0.08838834764831845f : 1.0f);
    }
    __syncthreads();
    for (int c = tid; c < 1536; c += NTH) a.QKV[(size_t)t * 1536 + c] = (c < 1024) ? sq[c] * scl[c >> 7] : sq[c];
    if (tid < 4) {
        const float a_raw = bf2f(prow[C_A + tid]), b_raw = bf2f(prow[C_B + tid]);
        a.G[(size_t)t * 4 + tid] = -expf(a.a_log[tid]) * softplusf_(a_raw + a.dt_bias[tid]);
        a.BETA[(size_t)t * 4 + tid] = sigmoidf_(b_raw);
    }
    if (!samp) {
        if (pos >= SEQ - 3) {
            const int row = pos - (SEQ - 3);
            for (int c = tid; c < 1536; c += NTH) a.p_gdn_conv[((size_t)b * 3 + row) * 1536 + c] = bf2f(prow[C_QKV + c]);
            a.p_lru_conv[((size_t)b * 3 + row) * 512 + tid] = bf2f(prow[C_XR + tid]);
        }
    } else {
        for (int c = tid; c < 1536; c += NTH) {
            a.s_gdn_conv[((size_t)sb * 3 + 0) * 1536 + c] = a.st_gdn_conv[((size_t)sb * 3 + 1) * 1536 + c];
            a.s_gdn_conv[((size_t)sb * 3 + 1) * 1536 + c] = a.st_gdn_conv[((size_t)sb * 3 + 2) * 1536 + c];
            a.s_gdn_conv[((size_t)sb * 3 + 2) * 1536 + c] = bf2f(prow[C_QKV + c]);
        }
        {
            const int c = tid;
            a.s_lru_conv[((size_t)sb * 3 + 0) * 512 + c] = a.st_lru_conv[((size_t)sb * 3 + 1) * 512 + c];
            a.s_lru_conv[((size_t)sb * 3 + 1) * 512 + c] = a.st_lru_conv[((size_t)sb * 3 + 2) * 512 + c];
            a.s_lru_conv[((size_t)sb * 3 + 2) * 512 + c] = bf2f(prow[C_XR + c]);
        }
    }
    {
        const int c = tid, n = c >> 6, d = c & 63;
        float r = a.b_r[c], ii = a.b_i[c];
#pragma unroll 4
        for (int cc = 0; cc < 64; ++cc) {
            const float xv = sx[n * 64 + cc];
            r += xv * a.w_r[((size_t)n * 64 + cc) * 64 + d];
            ii += xv * a.w_i[((size_t)n * 64 + cc) * 64 + d];
        }
        r = sigmoidf_(r); ii = sigmoidf_(ii);
        const float log_a = -8.0f * r * softplusf_(-a.lam[c]);
        a.LA[(size_t)t * 512 + c] = expf(log_a);
        a.LB[(size_t)t * 512 + c] = sqrtf(-expm1f(2.0f * log_a)) * (ii * sx[c]);
    }
}

__device__ __forceinline__ void gdn_scan(const float* __restrict__ QKV, const float* __restrict__ G, const float* __restrict__ BETA,
                                         const float* __restrict__ S0, float* __restrict__ O, float* __restrict__ Sout, int tok_base, int T,
                                         int sl, int h, int sq, float* smem) {
    int tid = threadIdx.x; asm volatile("" : "+v"(tid));
    const int dvl = tid & 31, kg = tid >> 5;
    const int dv = sl * 32 + dvl;
    float (*red1)[32] = (float (*)[32])smem;
    float (*red2)[32] = (float (*)[32])(smem + 512);
    float S[8];
#pragma unroll
    for (int i = 0; i < 8; ++i) S[i] = S0 ? S0[(((size_t)sq * 4 + h) * 128 + kg * 8 + i) * 128 + dv] : 0.f;
    float kk[8], qq[8], vv, g, be;
    {
        const size_t tok = (size_t)tok_base + (size_t)sq * T;
        const float* row = QKV + tok * 1536;
#pragma unroll
        for (int i = 0; i < 8; ++i) { kk[i] = row[512 + h * 128 + kg * 8 + i]; qq[i] = row[h * 128 + kg * 8 + i]; }
        vv = row[1024 + h * 128 + dv]; g = G[tok * 4 + h]; be = BETA[tok * 4 + h];
    }
    for (int t = 0; t < T; ++t) {
        const size_t tok = (size_t)tok_base + (size_t)sq * T + t;
        float nk[8], nq[8], nv = 0.f, ng = 0.f, nb = 0.f;
        if (t + 1 < T) {
            const float* row = QKV + (tok + 1) * 1536;
#pragma unroll
            for (int i = 0; i < 8; ++i) { nk[i] = row[512 + h * 128 + kg * 8 + i]; nq[i] = row[h * 128 + kg * 8 + i]; }
            nv = row[1024 + h * 128 + dv]; ng = G[(tok + 1) * 4 + h]; nb = BETA[(tok + 1) * 4 + h];
        } else {
#pragma unroll
            for (int i = 0; i < 8; ++i) { nk[i] = 0.f; nq[i] = 0.f; }
        }
        const float al = expf(g);
        float p = 0.f;
#pragma unroll
        for (int i = 0; i < 8; ++i) { S[i] *= al; p += S[i] * kk[i]; }
        red1[kg][dvl] = p;
        __syncthreads();
        float ks = 0.f;
#pragma unroll
        for (int j = 0; j < 16; ++j) ks += red1[j][dvl];
        const float vn = be * (vv - ks);
        float o = 0.f;
#pragma unroll
        for (int i = 0; i < 8; ++i) { S[i] += kk[i] * vn; o += S[i] * qq[i]; }
        red2[kg][dvl] = o;
        __syncthreads();
        if (kg == 0) {
            float os = 0.f;
#pragma unroll
            for (int j = 0; j < 16; ++j) os += red2[j][dvl];
            O[tok * 512 + h * 128 + dv] = os;
        }
#pragma unroll
        for (int i = 0; i < 8; ++i) { kk[i] = nk[i]; qq[i] = nq[i]; }
        vv = nv; g = ng; be = nb;
    }
#pragma unroll
    for (int i = 0; i < 8; ++i) Sout[(((size_t)sq * 4 + h) * 128 + kg * 8 + i) * 128 + dv] = S[i];
}

__device__ __forceinline__ void lru_scan(const float* __restrict__ LA, float* __restrict__ LB, const float* __restrict__ h0,
                                         float* __restrict__ hlast, int tok_base, int T, int nseq, int bx) {
    int tx_ = threadIdx.x; asm volatile("" : "+v"(tx_));
    const int idx = bx * NTH + tx_;
    if (idx >= nseq * 512) return;
    const int sq = idx / 512, c = idx % 512;
    float h = h0 ? h0[(size_t)sq * 512 + c] : 0.f;
    const size_t base = ((size_t)tok_base + (size_t)sq * T) * 512 + c;
#pragma unroll 8
    for (int t = 0; t < T; ++t) {
        const size_t o = base + (size_t)t * 512;
        h = LA[o] * h + LB[o];
        LB[o] = h;
    }
    hlast[(size_t)sq * 512 + c] = h;
}

__device__ __forceinline__ void ab_mix(const bf16* __restrict__ PROJ, const float* __restrict__ O, const float* __restrict__ H, const float* __restrict__ P, const float* __restrict__ CIN,
                                       const float* __restrict__ norm_w, bf16* __restrict__ MIX, int vb) {
    int tx_ = threadIdx.x; asm volatile("" : "+v"(tx_));
    const int tid = tx_ & 255, lane = tid & 63, wid = tid >> 6, t = vb * 2 + (tx_ >> 8);
    const bf16* prow = PROJ + (size_t)t * ABN;
    {
        const int h = wid;
        const float o0 = O[(size_t)t * 512 + h * 128 + lane], o1 = O[(size_t)t * 512 + h * 128 + 64 + lane];
        const float ms = wave_sum(o0 * o0 + o1 * o1) * (1.0f / 128.0f);
        const float sc = rsqrtf(ms + 1e-6f);
        MIX[(size_t)t * 1024 + h * 128 + lane] = (bf16)f2bf(o0 * sc * norm_w[lane] * siluf_(bf2f(prow[C_Z + h * 128 + lane])));
        MIX[(size_t)t * 1024 + h * 128 + 64 + lane] = (bf16)f2bf(o1 * sc * norm_w[64 + lane] * siluf_(bf2f(prow[C_Z + h * 128 + 64 + lane])));
    }
    for (int c = tid; c < 512; c += 256) {
        float hv = H[(size_t)t * 512 + c];
        if (t < NP) hv += P[(size_t)t * 512 + c] * CIN[(size_t)(t >> 6) * 512 + c];
        MIX[(size_t)t * 1024 + 512 + c] = (bf16)f2bf(geluf_(bf2f(prow[C_GATE + c])) * hv);
    }
}

__device__ __forceinline__ void ln_res_w(const float* __restrict__ xrow, const float* __restrict__ yrow, const float* __restrict__ g, const float* __restrict__ bta,
                                         float* __restrict__ orow, bf16* __restrict__ obrow, int lane) {
    f32x4 v[4]; float s = 0.f;
#pragma unroll
    for (int j = 0; j < 4; ++j) { const f32x4 x4 = ((const f32x4*)xrow)[lane + 64 * j], y4 = ((const f32x4*)yrow)[lane + 64 * j]; v[j] = x4 * ALPHA + y4; s += (v[j].x + v[j].y) + (v[j].z + v[j].w); }
    const float mean = wave_sum(s) * (1.0f / 1024.0f); float q = 0.f;
#pragma unroll
    for (int j = 0; j < 4; ++j) { v[j] = v[j] - mean; q += (v[j].x * v[j].x + v[j].y * v[j].y) + (v[j].z * v[j].z + v[j].w * v[j].w); }
    const float rs = rsqrtf(wave_sum(q) * (1.0f / 1024.0f) + LN_EPS);
#pragma unroll
    for (int j = 0; j < 4; ++j) {
        const f32x4 g4 = ((const f32x4*)g)[lane + 64 * j], b4 = ((const f32x4*)bta)[lane + 64 * j];
        const f32x4 o = v[j] * rs * g4 + b4;
        ((f32x4*)orow)[lane + 64 * j] = o;
        v2u ob; ob.x = pk2(o.x, o.y); ob.y = pk2(o.z, o.w);
        ((v2u*)obrow)[lane + 64 * j] = ob;
    }
}

__device__ __forceinline__ void peer_topk(const bf16* __restrict__ Q, const float* __restrict__ keys, int* __restrict__ EXP, float* __restrict__ GATE,
                                          int tg, int h, float* smem) {
    const int tid = threadIdx.x, cn = tid & 255, c = cn >> 7, n = cn & 127, th = tid >> 8;
    float (*sq)[256] = (float (*)[256])smem;
    float (*ss)[257] = (float (*)[257])(smem + 32 * 256);
    float (*tvs)[2][16] = (float (*)[2][16])(smem + 32 * 256 + 32 * 257 + 32);
    int (*tis)[2][16] = (int (*)[2][16])(smem + 32 * 256 + 32 * 257 + 32 + 1024);
    for (int i = tid; i < 32 * 256; i += NTH) {
        const int tk = i >> 8, col = i & 255;
        sq[tk][col] = bf2f(Q[(size_t)(tg * 32 + tk) * 2048 + h * 256 + col]);
    }
    __syncthreads();
    float acc[16];
#pragma unroll
    for (int i = 0; i < 16; ++i) acc[i] = 0.f;
    const float* krow = keys + (((size_t)h * 2 + c) * 128 + n) * 128;
    for (int d4 = 0; d4 < 32; ++d4) {
        const float4 kv = *(const float4*)(krow + d4 * 4);
#pragma unroll
        for (int tk = 0; tk < 16; ++tk) {
            const float4 qv = *(const float4*)&sq[th * 16 + tk][c * 128 + d4 * 4];
            acc[tk] += qv.x * kv.x + qv.y * kv.y + qv.z * kv.z + qv.w * kv.w;
        }
    }
#pragma unroll
    for (int tk = 0; tk < 16; ++tk) ss[th * 16 + tk][cn] = acc[tk];
    __syncthreads();
    if (tid < 64) {
        const int tk = tid >> 1, cc = tid & 1;
        float tv[16]; int ti[16];
#pragma unroll
        for (int j = 0; j < 16; ++j) { tv[j] = -INFINITY; ti[j] = 0; }
        for (int nn = 0; nn < 128; ++nn) {
            float x = ss[tk][cc * 128 + nn]; int xi = nn;
#pragma unroll
            for (int j = 0; j < 16; ++j) {
                const bool gt = x > tv[j];
                const float tf = tv[j]; const int tj = ti[j];
                tv[j] = gt ? x : tf; ti[j] = gt ? xi : tj;
                x = gt ? tf : x; xi = gt ? tj : xi;
            }
        }
#pragma unroll
        for (int j = 0; j < 16; ++j) { tvs[tk][cc][j] = tv[j]; tis[tk][cc][j] = ti[j]; }
    }
    __syncthreads();
    if (tid < 32) {
        const int tk = tid;
        float bv[16]; int bi[16];
#pragma unroll
        for (int j = 0; j < 16; ++j) { bv[j] = -INFINITY; bi[j] = 0; }
        for (int i = 0; i < 16; ++i)
            for (int jj = 0; jj < 16; ++jj) {
                float x = tvs[tk][0][i] + tvs[tk][1][jj]; int xi = tis[tk][0][i] * 128 + tis[tk][1][jj];
#pragma unroll
                for (int j = 0; j < 16; ++j) {
                    const bool gt = x > bv[j];
                    const float tf = bv[j]; const int tj = bi[j];
                    bv[j] = gt ? x : tf; bi[j] = gt ? xi : tj;
                    x = gt ? tf : x; xi = gt ? tj : xi;
                }
            }
        float e[16], sum = 0.f;
#pragma unroll
        for (int j = 0; j < 16; ++j) { e[j] = expf(bv[j] - bv[0]); sum += e[j]; }
        const float inv = 1.0f / sum;
        const size_t o = (size_t)(tg * 32 + tk) * 128 + h * 16;
#pragma unroll
        for (int j = 0; j < 16; ++j) { EXP[o + j] = bi[j]; GATE[o + j] = e[j] * inv; }
    }
}

__device__ __forceinline__ void peer_expert(const float* __restrict__ X, const int* __restrict__ EXP, const float* __restrict__ GATE,
                                            const float* __restrict__ U, const float* __restrict__ V,
                                            const float* __restrict__ g, const float* __restrict__ bta, float* __restrict__ out, bf16* __restrict__ outb, int t, float* smem) {
    const int tid = threadIdx.x, lane = tid & 63, wid = tid >> 6;
    float (*accs)[1024] = (float (*)[1024])smem;
    float* sred = smem + 8192;
    const float4* xr = (const float4*)(X + (size_t)t * D);
    float4 xv[4];
#pragma unroll
    for (int j = 0; j < 4; ++j) xv[j] = xr[lane + 64 * j];
    float4 acc[4];
#pragma unroll
    for (int j = 0; j < 4; ++j) acc[j] = make_float4(0.f, 0.f, 0.f, 0.f);
    for (int e = 0; e < 16; ++e) {
        const int id = EXP[(size_t)t * 128 + wid * 16 + e];
        const float gt = GATE[(size_t)t * 128 + wid * 16 + e];
        const float4* ur = (const float4*)(U + (size_t)id * D);
        const float4* vr = (const float4*)(V + (size_t)id * D);
        float4 uv[4], vv[4];
#pragma unroll
        for (int j = 0; j < 4; ++j) { uv[j] = ur[lane + 64 * j]; vv[j] = vr[lane + 64 * j]; }
        float dot = 0.f;
#pragma unroll
        for (int j = 0; j < 4; ++j) dot += uv[j].x * xv[j].x + uv[j].y * xv[j].y + uv[j].z * xv[j].z + uv[j].w * xv[j].w;
        dot = wave_sum(dot);
        const float cf = gt * geluf_(dot);
#pragma unroll
        for (int j = 0; j < 4; ++j) { acc[j].x += cf * vv[j].x; acc[j].y += cf * vv[j].y; acc[j].z += cf * vv[j].z; acc[j].w += cf * vv[j].w; }
    }
#pragma unroll
    for (int j = 0; j < 4; ++j) *(float4*)&accs[wid][(lane + 64 * j) * 4] = acc[j];
    __syncthreads();
    float v[2];
#pragma unroll
    for (int i = 0; i < 2; ++i) {
        const int c = tid * 2 + i;
        float s = 0.f;
#pragma unroll
        for (int w = 0; w < 8; ++w) s += accs[w][c];
        v[i] = ALPHA * X[(size_t)t * D + c] + s;
    }
    float s = wave_sum(v[0] + v[1]);
    if (lane == 0) sred[wid] = s;
    __syncthreads();
    float mean = 0.f;
#pragma unroll
    for (int w = 0; w < 8; ++w) mean += sred[w];
    mean *= (1.0f / 1024.0f);
    __syncthreads();
    const float d0 = v[0] - mean, d1 = v[1] - mean;
    float q = wave_sum(d0 * d0 + d1 * d1);
    if (lane == 0) sred[wid] = q;
    __syncthreads();
    float var = 0.f;
#pragma unroll
    for (int w = 0; w < 8; ++w) var += sred[w];
    const float rs = rsqrtf(var * (1.0f / 1024.0f) + LN_EPS);
    const float o0 = d0 * rs * g[tid * 2] + bta[tid * 2], o1 = d1 * rs * g[tid * 2 + 1] + bta[tid * 2 + 1];
    *(float2*)(out + (size_t)t * D + tid * 2) = make_float2(o0, o1);
    if (outb) *(unsigned*)(outb + (size_t)t * D + tid * 2) = pk2(o0, o1);
}


typedef __bf16 bf16x2_t __attribute__((ext_vector_type(2)));
__device__ __forceinline__ float dot2bf(unsigned w, unsigned x, float acc) { return __builtin_amdgcn_fdot2_f32_bf16(__builtin_bit_cast(bf16x2_t, w), __builtin_bit_cast(bf16x2_t, x), acc, false); }
__device__ __forceinline__ float bflo(unsigned w) { return __uint_as_float(w << 16); }
__device__ __forceinline__ float bfhi(unsigned w) { return __uint_as_float(w & 0xffff0000u); }
typedef float f32x2_t __attribute__((ext_vector_type(2)));
__device__ __forceinline__ void row_to_fp8(const float* __restrict__ xrow, unsigned char* __restrict__ orow, float* __restrict__ scale, int lane) {
    f32x4 v[4]; float am = 0.f;
#pragma unroll
    for (int j = 0; j < 4; ++j) { v[j] = *(const f32x4*)(xrow + lane * 16 + j * 4); am = fmaxf(am, fmaxf(fmaxf(fabsf(v[j].x), fabsf(v[j].y)), fmaxf(fabsf(v[j].z), fabsf(v[j].w)))); }
    am = wave_max(am);
    const float s = am > 0.f ? am * (1.0f / 448.0f) : 1.0f, inv = 1.0f / s;
    v4u o;
    unsigned w;
    w = 0u; w = __builtin_amdgcn_cvt_pk_fp8_f32(v[0].x * inv, v[0].y * inv, w, false); w = __builtin_amdgcn_cvt_pk_fp8_f32(v[0].z * inv, v[0].w * inv, w, true); o.x = w;
    w = 0u; w = __builtin_amdgcn_cvt_pk_fp8_f32(v[1].x * inv, v[1].y * inv, w, false); w = __builtin_amdgcn_cvt_pk_fp8_f32(v[1].z * inv, v[1].w * inv, w, true); o.y = w;
    w = 0u; w = __builtin_amdgcn_cvt_pk_fp8_f32(v[2].x * inv, v[2].y * inv, w, false); w = __builtin_amdgcn_cvt_pk_fp8_f32(v[2].z * inv, v[2].w * inv, w, true); o.z = w;
    w = 0u; w = __builtin_amdgcn_cvt_pk_fp8_f32(v[3].x * inv, v[3].y * inv, w, false); w = __builtin_amdgcn_cvt_pk_fp8_f32(v[3].z * inv, v[3].w * inv, w, true); o.w = w;
    *(v4u*)(orow + lane * 16) = o;
    if (lane == 0) *scale = s;
}
#define PE_LOAD(UB, VB, grp) do { _Pragma("unroll") for (int i_ = 0; i_ < 4; ++i_) { const int e_ = (grp) * 4 + i_; \
        const int id_ = __builtin_amdgcn_readlane(e_ < 64 ? id0 : id1, e_ & 63); \
        const unsigned so_ = (unsigned)id_ * 1024u; \
        UB[i_] = __builtin_amdgcn_raw_buffer_load_b128(ursrc, voff, so_, 0); VB[i_] = __builtin_amdgcn_raw_buffer_load_b128(vrsrc, voff, so_, 0); } } while (0)
#define PE_DOT4(w, k) do { const f32x2_t l_ = __builtin_amdgcn_cvt_pk_f32_fp8((w), false), h_ = __builtin_amdgcn_cvt_pk_f32_fp8((w), true); \
        a_ += l_.x * xv[(k) * 4 + 0]; b_ += l_.y * xv[(k) * 4 + 1]; a_ += h_.x * xv[(k) * 4 + 2]; b_ += h_.y * xv[(k) * 4 + 3]; } while (0)
#define PE_AXPY4(w, k) do { const f32x2_t l_ = __builtin_amdgcn_cvt_pk_f32_fp8((w), false), h_ = __builtin_amdgcn_cvt_pk_f32_fp8((w), true); \
        acc[(k) * 4 + 0] += cf_ * l_.x; acc[(k) * 4 + 1] += cf_ * l_.y; acc[(k) * 4 + 2] += cf_ * h_.x; acc[(k) * 4 + 3] += cf_ * h_.y; } while (0)
#define PE_COMP(UB, VB, grp) do { float d_[4]; \
        _Pragma("unroll") for (int i_ = 0; i_ < 4; ++i_) { float a_ = 0.f, b_ = 0.f; PE_DOT4(UB[i_].x, 0); PE_DOT4(UB[i_].y, 1); PE_DOT4(UB[i_].z, 2); PE_DOT4(UB[i_].w, 3); d_[i_] = a_ + b_; } \
          \
        float s0_ = hi32 ? d_[2] : d_[0], t0_ = hi32 ? d_[0] : d_[2]; s0_ += __shfl_xor(t0_, 32); \
        float s1_ = hi32 ? d_[3] : d_[1], t1_ = hi32 ? d_[1] : d_[3]; s1_ += __shfl_xor(t1_, 32); \
        float r_ = hi16 ? s1_ : s0_, t2_ = hi16 ? s0_ : s1_; r_ += __shfl_xor(t2_, 16); \
        r_ += __shfl_xor(r_, 8); r_ += __shfl_xor(r_, 4); r_ += __shfl_xor(r_, 2); r_ += __shfl_xor(r_, 1); \
          \
        const int esel_ = (grp) * 4 + (lane >> 4); \
        const float su_ = __shfl(esel_ < 64 ? su0 : su1, esel_ & 63), gv_ = __shfl(esel_ < 64 ? gs0 : gs1, esel_ & 63); \
        const float cfl_ = geluf_(r_ * su_) * gv_; \
        _Pragma("unroll") for (int i_ = 0; i_ < 4; ++i_) { \
            const float cf_ = __uint_as_float(__builtin_amdgcn_readlane(__float_as_uint(cfl_), 16 * i_)); \
            PE_AXPY4(VB[i_].x, 0); PE_AXPY4(VB[i_].y, 1); PE_AXPY4(VB[i_].z, 2); PE_AXPY4(VB[i_].w, 3); } } while (0)
__device__ __forceinline__ void peer_expert_w(const float* __restrict__ xrow, const int* __restrict__ exr, const float* __restrict__ gar,
                                              const unsigned char* __restrict__ U, const unsigned char* __restrict__ V, const float* __restrict__ SU, const float* __restrict__ SV,
                                              const float* __restrict__ g, const float* __restrict__ bta, float* __restrict__ orow, bf16* __restrict__ obrow, int lane) {
    const bool hi32 = (lane & 32) != 0, hi16 = (lane & 16) != 0;
    const __amdgpu_buffer_rsrc_t ursrc = __builtin_amdgcn_make_buffer_rsrc((void*)U, 0, 16384 * 1024, 0x00020000);
    const __amdgpu_buffer_rsrc_t vrsrc = __builtin_amdgcn_make_buffer_rsrc((void*)V, 0, 16384 * 1024, 0x00020000);
    const int voff = lane * 16;
    float xv[16];
#pragma unroll
    for (int j = 0; j < 4; ++j) { const f32x4 t = *(const f32x4*)(xrow + lane * 16 + j * 4); xv[j * 4 + 0] = t.x; xv[j * 4 + 1] = t.y; xv[j * 4 + 2] = t.z; xv[j * 4 + 3] = t.w; }
    const int id0 = exr[lane], id1 = exr[64 + lane];
    const float su0 = SU[id0], su1 = SU[id1];
    const float gs0 = gar[lane] * SV[id0], gs1 = gar[64 + lane] * SV[id1];
    float acc[16];
#pragma unroll
    for (int i = 0; i < 16; ++i) acc[i] = 0.f;
    v4u ua[4], va[4], ub[4], vb[4];
    PE_LOAD(ua, va, 0);
#pragma unroll 1
    for (int grp = 0; grp < 32; grp += 2) {
        PE_LOAD(ub, vb, grp + 1);
        PE_COMP(ua, va, grp);
        if (grp + 2 < 32) PE_LOAD(ua, va, grp + 2);
        PE_COMP(ub, vb, grp + 1);
    }
    float v[16]; float s = 0.f;
#pragma unroll
    for (int i = 0; i < 16; ++i) { v[i] = ALPHA * xv[i] + acc[i]; s += v[i]; }
    const float mean = wave_sum(s) * (1.0f / 1024.0f); float q = 0.f;
#pragma unroll
    for (int i = 0; i < 16; ++i) { v[i] -= mean; q += v[i] * v[i]; }
    const float rs = rsqrtf(wave_sum(q) * (1.0f / 1024.0f) + LN_EPS);
    float o[16];
#pragma unroll
    for (int j = 0; j < 4; ++j) {
        const f32x4 g4 = *(const f32x4*)(g + lane * 16 + j * 4), b4 = *(const f32x4*)(bta + lane * 16 + j * 4);
        o[j * 4 + 0] = v[j * 4 + 0] * rs * g4.x + b4.x; o[j * 4 + 1] = v[j * 4 + 1] * rs * g4.y + b4.y; o[j * 4 + 2] = v[j * 4 + 2] * rs * g4.z + b4.z; o[j * 4 + 3] = v[j * 4 + 3] * rs * g4.w + b4.w;
        *(f32x4*)(orow + lane * 16 + j * 4) = (f32x4){o[j * 4 + 0], o[j * 4 + 1], o[j * 4 + 2], o[j * 4 + 3]};
    }
    if (obrow) {
        v4u w0, w1; w0.x = pk2(o[0], o[1]); w0.y = pk2(o[2], o[3]); w0.z = pk2(o[4], o[5]); w0.w = pk2(o[6], o[7]); w1.x = pk2(o[8], o[9]); w1.y = pk2(o[10], o[11]); w1.z = pk2(o[12], o[13]); w1.w = pk2(o[14], o[15]);
        *(v4u*)(obrow + lane * 16) = w0; *(v4u*)(obrow + lane * 16 + 8) = w1;
    }
}


__device__ __forceinline__ void peer_expert_blk(const float* __restrict__ xrow, const int* __restrict__ exr, const float* __restrict__ gar,
                                                const unsigned char* __restrict__ U, const unsigned char* __restrict__ V, const float* __restrict__ SU, const float* __restrict__ SV,
                                                const float* __restrict__ g, const float* __restrict__ bta, float* __restrict__ orow, bf16* __restrict__ obrow, int lane, int wave, float* smem) {
    const bool hi32 = (lane & 32) != 0, hi16 = (lane & 16) != 0;
    const __amdgpu_buffer_rsrc_t ursrc = __builtin_amdgcn_make_buffer_rsrc((void*)U, 0, 16384 * 1024, 0x00020000);
    const __amdgpu_buffer_rsrc_t vrsrc = __builtin_amdgcn_make_buffer_rsrc((void*)V, 0, 16384 * 1024, 0x00020000);
    const int voff = lane * 16;
    float xv[16];
#pragma unroll
    for (int j = 0; j < 4; ++j) { const f32x4 t = *(const f32x4*)(xrow + lane * 16 + j * 4); xv[j * 4 + 0] = t.x; xv[j * 4 + 1] = t.y; xv[j * 4 + 2] = t.z; xv[j * 4 + 3] = t.w; }
    const int id0 = exr[lane], id1 = exr[64 + lane];
    const float su0 = SU[id0], su1 = SU[id1];
    const float gs0 = gar[lane] * SV[id0], gs1 = gar[64 + lane] * SV[id1];
    float acc[16];
#pragma unroll
    for (int i = 0; i < 16; ++i) acc[i] = 0.f;
    v4u ua[4], va[4], ub[4], vb[4];
    const int g0 = wave * 4;
    PE_LOAD(ua, va, g0); PE_LOAD(ub, vb, g0 + 1);
    PE_COMP(ua, va, g0); PE_LOAD(ua, va, g0 + 2);
    PE_COMP(ub, vb, g0 + 1); PE_LOAD(ub, vb, g0 + 3);
    PE_COMP(ua, va, g0 + 2);
    PE_COMP(ub, vb, g0 + 3);
    float* accs = smem;
    float* sred = smem + 8192;
#pragma unroll
    for (int j = 0; j < 4; ++j) *(f32x4*)(accs + wave * 1024 + lane * 16 + j * 4) = (f32x4){acc[j * 4 + 0], acc[j * 4 + 1], acc[j * 4 + 2], acc[j * 4 + 3]};
    __syncthreads();
    const int tid = wave * 64 + lane;
    float v0 = ALPHA * xrow[tid * 2], v1 = ALPHA * xrow[tid * 2 + 1];
#pragma unroll
    for (int w = 0; w < 8; ++w) { v0 += accs[w * 1024 + tid * 2]; v1 += accs[w * 1024 + tid * 2 + 1]; }
    const float s = wave_sum(v0 + v1);
    if (lane == 0) sred[wave] = s;
    __syncthreads();
    float mean = 0.f;
#pragma unroll
    for (int w = 0; w < 8; ++w) mean += sred[w];
    mean *= (1.0f / 1024.0f);
    __syncthreads();
    const float d0 = v0 - mean, d1 = v1 - mean;
    const float q = wave_sum(d0 * d0 + d1 * d1);
    if (lane == 0) sred[wave] = q;
    __syncthreads();
    float var = 0.f;
#pragma unroll
    for (int w = 0; w < 8; ++w) var += sred[w];
    const float rs = rsqrtf(var * (1.0f / 1024.0f) + LN_EPS);
    const float o0 = d0 * rs * g[tid * 2] + bta[tid * 2], o1 = d1 * rs * g[tid * 2 + 1] + bta[tid * 2 + 1];
    *(float2*)(orow + tid * 2) = make_float2(o0, o1);
    if (obrow) *(unsigned*)(obrow + tid * 2) = pk2(o0, o1);
    __syncthreads();
}

__device__ __forceinline__ int t5_bucket(int n) {
    if (n < 16) return n;
    const int large = 16 + (int)(logf((float)n / 16.0f) / 2.0794415416798357f * 16.0f);
    return large < 31 ? large : 31;
}
__device__ __forceinline__ void swa_attn(const float* __restrict__ PC, const float* __restrict__ cache_k, const float* __restrict__ cache_v,
                                         const float* __restrict__ rel_bias, const float* __restrict__ sinks, bf16* __restrict__ ATT, int bx) {
    const int tid = threadIdx.x, lane = tid & 63, wid = tid >> 6;
    const int gw = bx * 8 + wid;
    const int t = gw >> 4, h = gw & 15, kvh = h >> 2;
    if (t >= NT) return;
    const bool samp = t >= NP; const int sb = t - NP, pos = t % SEQ;
    const float* qrow = PC + (size_t)t * CN + h * 64;
    float lg[2]; bool valid[2];
#pragma unroll
    for (int rr = 0; rr < 2; ++rr) {
        const int r = lane + 64 * rr;
        const float* krow;
        if (!samp) { valid[rr] = (pos - r) >= 0; krow = PC + (size_t)(valid[rr] ? t - r : t) * CN + 1024 + kvh * 64; }
        else { valid[rr] = true; krow = (r == 0) ? PC + (size_t)t * CN + 1024 + kvh * 64 : cache_k + (((size_t)sb * 128 + (128 - r)) * 4 + kvh) * 64; }
        float dot = 0.f;
#pragma unroll
        for (int d4 = 0; d4 < 16; ++d4) {
            const float4 kv = *(const float4*)(krow + d4 * 4);
            const float4 qv = *(const float4*)(qrow + d4 * 4);
            dot += qv.x * kv.x + qv.y * kv.y + qv.z * kv.z + qv.w * kv.w;
        }
        lg[rr] = valid[rr] ? dot * 0.125f + rel_bias[t5_bucket(r) * 16 + h] : -INFINITY;
    }
    const float sink = sinks[h];
    const float m = fmaxf(wave_max(fmaxf(lg[0], lg[1])), sink);
    float p[2];
#pragma unroll
    for (int rr = 0; rr < 2; ++rr) p[rr] = valid[rr] ? expf(lg[rr] - m) : 0.f;
    const float den = wave_sum(p[0] + p[1]) + expf(sink - m);
    const float inv = 1.0f / den;
    float o = 0.f;
#pragma unroll
    for (int rr = 0; rr < 2; ++rr)
        for (int l2 = 0; l2 < 64; ++l2) {
            const int r = l2 + 64 * rr;
            const float pj = __shfl(p[rr], l2);
            if (pj != 0.f) {
                const float* vrow;
                if (!samp) vrow = PC + (size_t)(t - r) * CN + 1280 + kvh * 64;
                else vrow = (r == 0) ? PC + (size_t)t * CN + 1280 + kvh * 64 : cache_v + (((size_t)sb * 128 + (128 - r)) * 4 + kvh) * 64;
                o += pj * vrow[lane];
            }
        }
    ATT[(size_t)t * D + h * 64 + lane] = (bf16)f2bf(o * inv);
}

__device__ __forceinline__ void swa_kv_out(const float* __restrict__ PC, const float* __restrict__ cache_k, const float* __restrict__ cache_v,
                                           float* __restrict__ pk, float* __restrict__ pv, float* __restrict__ sk, float* __restrict__ sv, int vb) {
    const int c = threadIdx.x & 255, row = vb * 2 + (threadIdx.x >> 8);
    if (row < NB * 128) {
        const int b = row >> 7, i = row & 127;
        const float* src = PC + (size_t)(b * SEQ + SEQ - 128 + i) * CN;
        pk[(size_t)row * 256 + c] = src[1024 + c];
        pv[(size_t)row * 256 + c] = src[1280 + c];
    } else {
        const int r2 = row - NB * 128, sb = r2 >> 7, i = r2 & 127;
        if (i < 127) {
            sk[(size_t)r2 * 256 + c] = cache_k[((size_t)sb * 128 + i + 1) * 256 + c];
            sv[(size_t)r2 * 256 + c] = cache_v[((size_t)sb * 128 + i + 1) * 256 + c];
        } else {
            const float* src = PC + (size_t)(NP + sb) * CN;
            sk[(size_t)r2 * 256 + c] = src[1024 + c];
            sv[(size_t)r2 * 256 + c] = src[1280 + c];
        }
    }
}
#define XB_TMO      128
#define XB_XCNT(j)  (256  + 64 * (j))
#define XB_XSUB(j)  (1280 + 64 * (j))
#define XB_XGEN(j)  (2304 + 64 * (j))
#define XB_TOP      3328
#define XB_TOPGEN   3392
#define XCD_BAR_WORDS 3456
#define XB_SPIN_CAP (1u << 18)

__device__ __forceinline__ unsigned xb_ld(unsigned* p)              { return __hip_atomic_load(p, __ATOMIC_RELAXED, __HIP_MEMORY_SCOPE_AGENT); }
__device__ __forceinline__ unsigned xb_add(unsigned* p, unsigned v) { return __hip_atomic_fetch_add(p, v, __ATOMIC_RELAXED, __HIP_MEMORY_SCOPE_AGENT); }
__device__ __forceinline__ unsigned xb_xcc_id() { return (unsigned)__builtin_amdgcn_s_getreg((3 << 11) | 20) & 0xFu; }
#define XB_SPIN(cond, bar) do { unsigned _sp = 0; while (cond) { __builtin_amdgcn_s_sleep(1); \
    if ((++_sp & 255u) == 0u) { if (xb_ld(&(bar)[XB_TMO])) break; if (_sp > XB_SPIN_CAP) { atomicAdd(&(bar)[XB_TMO], 1u); break; } } } } while (0)

struct XcdBarrier {
    unsigned* bar; unsigned x;
    volatile LAS unsigned* st;
};

__device__ __forceinline__ XcdBarrier xcd_barrier_post(unsigned* bar, volatile LAS unsigned* st) {
    XcdBarrier b; b.bar = bar; b.x = xb_xcc_id(); b.st = st;
    if (threadIdx.x == 0) (void)xb_add(&bar[XB_XCNT(b.x)], 1u);
    return b;
}
__device__ __forceinline__ void xcd_barrier_complete(unsigned* bar, unsigned x, unsigned& nloc, unsigned& nx) {
    const unsigned G = gridDim.x * gridDim.y * gridDim.z;
    unsigned sum, cnt, mine, sp = 0u;
    for (;;) {
        sum = 0u; cnt = 0u; mine = 0u;
#pragma unroll
        for (unsigned j = 0; j < 16; ++j) { const unsigned c = xb_ld(&bar[XB_XCNT(j)]); sum += c; cnt += (c > 0u) ? 1u : 0u; mine = (j == x) ? c : mine; }
        if (sum == G) break;
        __builtin_amdgcn_s_sleep(1);
        if ((++sp & 255u) == 0u) { if (xb_ld(&bar[XB_TMO])) break; if (sp > XB_SPIN_CAP) { atomicAdd(&bar[XB_TMO], 1u); break; } }
    }
    nloc = mine > 0u ? mine : 1u; nx = cnt > 0u ? cnt : 1u;
}

__device__ __forceinline__ void xcd_barrier(const XcdBarrier& b) {
    asm volatile("s_waitcnt vmcnt(0)" ::: "memory");
    __syncthreads();
    if (threadIdx.x == 0) {
        unsigned* bar = b.bar;
        __builtin_amdgcn_s_waitcnt(0);
        unsigned nloc = b.st[0], nx = b.st[1];
        if (nloc == 0u) { xcd_barrier_complete(bar, b.x, nloc, nx); b.st[0] = nloc; b.st[1] = nx; }
        const unsigned old = xb_add(&bar[XB_XSUB(b.x)], 1u);
        const unsigned gen = old / nloc;
        if (old + 1u == (gen + 1u) * nloc) {
            __builtin_amdgcn_fence(__ATOMIC_RELEASE, "agent");
            asm volatile("s_waitcnt vmcnt(0)" ::: "memory");
            const unsigned og = xb_add(&bar[XB_TOP], 1u);
            const unsigned tg = og / nx;
            if (og + 1u == (tg + 1u) * nx) xb_add(&bar[XB_TOPGEN], 1u);
            else XB_SPIN(xb_ld(&bar[XB_TOPGEN]) == tg, bar);
            __builtin_amdgcn_fence(__ATOMIC_ACQUIRE, "agent");
            xb_add(&bar[XB_XGEN(b.x)], 1u);
            asm volatile("s_waitcnt vmcnt(0)" ::: "memory");
        } else {
            XB_SPIN(xb_ld(&bar[XB_XGEN(b.x)]) == gen, bar);
            __builtin_amdgcn_fence(__ATOMIC_ACQUIRE, "agent");
            asm volatile("s_waitcnt vmcnt(0)" ::: "memory");
        }
    }
    __syncthreads();
}

typedef short bf16x8_t __attribute__((ext_vector_type(8)));
__device__ __forceinline__ f32x4 mfma16(bf16x8_t a, bf16x8_t b, f32x4 c) { return __builtin_amdgcn_mfma_f32_16x16x32_bf16(a, b, c, 0, 0, 0); }

struct GdnChunkBufs {
    bf16* W;
    bf16* QG;
    bf16* KDT;
    bf16* UT;
    bf16* QK;
    float* EGL;
};

constexpr int GP_QB = 0, GP_KB = 17408, GP_VB = 34816, GP_LS = 52224, GP_QKS = 69632, GP_WS = 78848, GP_SC = 96256;

__device__ __forceinline__ void gdn_prep_unit(const bf16* __restrict__ PROJ, const float* __restrict__ conv_w, const float* __restrict__ a_log, const float* __restrict__ dt_bias,
                                              const GdnChunkBufs& cb, float* __restrict__ p_gdn_conv, int un, unsigned char* lds) {
    int tid = threadIdx.x; asm volatile("" : "+v"(tid));
    const int lane = tid & 63, wave = __builtin_amdgcn_readfirstlane(tid >> 6), fr = lane & 15, fq = lane >> 4;
    const int h = un & 3, n = (un >> 2) & 63, b = un >> 8;
    const int t0 = b * SEQ + n * 64;
    bf16* Qb = (bf16*)(lds + GP_QB); bf16* Kb = (bf16*)(lds + GP_KB); bf16* Vb = (bf16*)(lds + GP_VB); bf16* Ws = (bf16*)(lds + GP_WS);
    float* Ls = (float*)(lds + GP_LS); bf16* QKs = (bf16*)(lds + GP_QKS);
    float* gcs = (float*)(lds + GP_SC); float* bets = gcs + 64; float* egcs = gcs + 128; float* ekds = gcs + 192; float* begs = gcs + 256;
    if (wave == 0) {
        const bf16* prow = PROJ + (size_t)(t0 + lane) * ABN;
        const float a_raw = bf2f(prow[C_A + h]), b_raw = bf2f(prow[C_B + h]);
        float g = -expf(a_log[h]) * softplusf_(a_raw + dt_bias[h]);
#pragma unroll
        for (int off = 1; off < 64; off <<= 1) { const float v = __shfl_up(g, off); if (lane >= off) g += v; }
        const float glast = __shfl(g, 63);
        { const float be_ = sigmoidf_(b_raw), eg_ = expf(g); gcs[lane] = g; bets[lane] = be_; egcs[lane] = eg_; ekds[lane] = expf(glast - g); begs[lane] = be_ * eg_; }
        if (lane == 0) cb.EGL[un] = expf(glast);
    }
    {
        int cols[6]; float cw[4][6], xw[3][6];
#pragma unroll
        for (int p = 0; p < 3; ++p)
#pragma unroll
            for (int e = 0; e < 2; ++e) cols[p * 2 + e] = p * 512 + h * 128 + e * 64 + lane;
#pragma unroll
        for (int i = 0; i < 4; ++i)
#pragma unroll
            for (int c = 0; c < 6; ++c) cw[i][c] = conv_w[i * 1536 + cols[c]];
        const int i0 = wave * 8;
#pragma unroll
        for (int k = 0; k < 3; ++k) {
            const int pos = n * 64 + i0 - 3 + k;
#pragma unroll
            for (int c = 0; c < 6; ++c) xw[k][c] = pos >= 0 ? bf2f(PROJ[(size_t)(t0 + i0 - 3 + k) * ABN + cols[c]]) : 0.f;
        }
        bf16 xraw[8][6];
#pragma unroll
        for (int ii = 0; ii < 8; ++ii)
#pragma unroll
            for (int c = 0; c < 6; ++c) xraw[ii][c] = PROJ[(size_t)(t0 + i0 + ii) * ABN + cols[c]];
#pragma unroll
        for (int ii = 0; ii < 8; ++ii) {
            const int i = i0 + ii;
            float xt[6], s[6];
#pragma unroll
            for (int c = 0; c < 6; ++c) xt[c] = bf2f(xraw[ii][c]);
#pragma unroll
            for (int c = 0; c < 6; ++c) s[c] = siluf_(cw[0][c] * xw[0][c] + cw[1][c] * xw[1][c] + cw[2][c] * xw[2][c] + cw[3][c] * xt[c]);
            const float qs = rsqrtf(wave_sum(s[0] * s[0] + s[1] * s[1]) + 1e-6f) * 0.08838834764831845f;
            const float ks = rsqrtf(wave_sum(s[2] * s[2] + s[3] * s[3]) + 1e-6f);
            Qb[i * 136 + lane] = (bf16)f2bf(s[0] * qs); Qb[i * 136 + 64 + lane] = (bf16)f2bf(s[1] * qs);
            Kb[i * 136 + lane] = (bf16)f2bf(s[2] * ks); Kb[i * 136 + 64 + lane] = (bf16)f2bf(s[3] * ks);
            Vb[i * 136 + lane] = (bf16)f2bf(s[4]);      Vb[i * 136 + 64 + lane] = (bf16)f2bf(s[5]);
            if (n == 63 && i >= 61) {
#pragma unroll
                for (int c = 0; c < 6; ++c) p_gdn_conv[((size_t)b * 3 + (i - 61)) * 1536 + cols[c]] = xt[c];
            }
#pragma unroll
            for (int c = 0; c < 6; ++c) { xw[0][c] = xw[1][c]; xw[1][c] = xw[2][c]; xw[2][c] = xt[c]; }
        }
    }
    __syncthreads();
    {
        const int mi = wave >> 1;
        bf16x8_t aK[4], aQ[4];
#pragma unroll
        for (int ks = 0; ks < 4; ++ks) { aK[ks] = *(const bf16x8_t*)(Kb + (mi * 16 + fr) * 136 + ks * 32 + 8 * fq); aQ[ks] = *(const bf16x8_t*)(Qb + (mi * 16 + fr) * 136 + ks * 32 + 8 * fq); }
#pragma unroll
        for (int nn = 0; nn < 2; ++nn) {
            const int nj = (wave & 1) * 2 + nn;
            f32x4 accK = (f32x4){0.f, 0.f, 0.f, 0.f}, accQ = accK;
#pragma unroll
            for (int ks = 0; ks < 4; ++ks) { const bf16x8_t bk = *(const bf16x8_t*)(Kb + (nj * 16 + fr) * 136 + ks * 32 + 8 * fq); accK = mfma16(aK[ks], bk, accK); accQ = mfma16(aQ[ks], bk, accQ); }
            const int j = nj * 16 + fr; const float gj = gcs[j];
#pragma unroll
            for (int r = 0; r < 4; ++r) {
                const int i = mi * 16 + 4 * fq + r;
                const float dec = i >= j ? expf(gcs[i] - gj) : 0.f;
                Ls[i * 68 + j] = i > j ? bets[i] * accK[r] * dec : 0.f;
                QKs[i * 72 + j] = (bf16)f2bf(i >= j ? accQ[r] * dec : 0.f);
            }
        }
    }
    __syncthreads();
    if (wave < 4) {
        float x[64];
        const bool isu = tid < 128; const int c = isu ? tid : tid - 128;
        const LAS unsigned char* l3 = (const LAS unsigned char*)lds;
        unsigned so = (isu ? GP_VB : GP_KB) + c * 2, ro = GP_SC + (isu ? 64 * 4 : 256 * 4), lo = GP_LS;
        asm volatile("" : "+v"(so), "+v"(ro), "+v"(lo));
#pragma unroll
        for (int i = 0; i < 64; ++i) {
            float acc = *(const LAS float*)(l3 + ro + 4 * i) * bf2f(*(const LAS bf16*)(l3 + so + i * 272));
#pragma unroll
            for (int j4 = 0; j4 < (i + 3) / 4; ++j4) {
                const f32x4 l4 = *(const LAS f32x4*)(l3 + lo + i * 272 + j4 * 16);
                acc -= l4.x * x[j4 * 4 + 0];
                if (j4 * 4 + 1 < i) acc -= l4.y * x[j4 * 4 + 1];
                if (j4 * 4 + 2 < i) acc -= l4.z * x[j4 * 4 + 2];
                if (j4 * 4 + 3 < i) acc -= l4.w * x[j4 * 4 + 3];
            }
            x[i] = acc;
        }
        if (isu) {
            bf16* dst = cb.UT + ((size_t)un * 128 + c) * 64;
#pragma unroll
            for (int i8 = 0; i8 < 8; ++i8) { v4u o; o.x = pk2(x[i8 * 8 + 0], x[i8 * 8 + 1]); o.y = pk2(x[i8 * 8 + 2], x[i8 * 8 + 3]); o.z = pk2(x[i8 * 8 + 4], x[i8 * 8 + 5]); o.w = pk2(x[i8 * 8 + 6], x[i8 * 8 + 7]); *(v4u*)(dst + i8 * 8) = o; }
        } else {
#pragma unroll
            for (int i = 0; i < 64; ++i) Ws[i * 136 + c] = (bf16)f2bf(x[i]);
        }
    } else {
        const int t2 = tid - 256;
#pragma unroll
        for (int k = 0; k < 4; ++k) {
            const int ci = t2 + 256 * k, i = ci >> 4, d0 = (ci & 15) * 8; const float e = egcs[i];
            const v4u q = *(const v4u*)(Qb + i * 136 + d0);
            v4u o; o.x = pk2(bflo(q.x) * e, bfhi(q.x) * e); o.y = pk2(bflo(q.y) * e, bfhi(q.y) * e); o.z = pk2(bflo(q.z) * e, bfhi(q.z) * e); o.w = pk2(bflo(q.w) * e, bfhi(q.w) * e);
            *(v4u*)(cb.QG + ((size_t)un * 64 + i) * 128 + d0) = o;
        }
#pragma unroll
        for (int k = 0; k < 4; ++k) {
            const int ci = t2 + 256 * k, d = ci & 127, i0 = (ci >> 7) * 8;
            float v[8];
#pragma unroll
            for (int q = 0; q < 8; ++q) v[q] = bf2f(Kb[(i0 + q) * 136 + d]) * ekds[i0 + q];
            v4u o; o.x = pk2(v[0], v[1]); o.y = pk2(v[2], v[3]); o.z = pk2(v[4], v[5]); o.w = pk2(v[6], v[7]);
            *(v4u*)(cb.KDT + ((size_t)un * 128 + d) * 64 + i0) = o;
        }
#pragma unroll
        for (int k = 0; k < 2; ++k) {
            const int ci = t2 + 256 * k, i = ci >> 3, j0 = (ci & 7) * 8;
            *(v4u*)(cb.QK + ((size_t)un * 64 + i) * 64 + j0) = *(const v4u*)(QKs + i * 72 + j0);
        }
    }
    __syncthreads();
#pragma unroll
    for (int k = 0; k < 2; ++k) {
        const int ci = tid + 512 * k, i = ci >> 4, d0 = (ci & 15) * 8;
        *(v4u*)(cb.W + ((size_t)un * 64 + i) * 128 + d0) = *(const v4u*)(Ws + i * 136 + d0);
    }
    __syncthreads();
}

constexpr int GS_ST = 0, GS_VNT = 2 * 32 * 136 * 2, GS_END = GS_VNT + 32 * 72 * 2;
template <int N0, int N1>
__device__ __forceinline__ void gdn_seq(const GdnChunkBufs& cb, float* __restrict__ O, float* __restrict__ Sout, int b, int h, int sl, unsigned char* lds, f32x4 (&accS)[2], int& cur) {
    int tid = threadIdx.x; asm volatile("" : "+v"(tid));
    const int lane = tid & 63, wave = __builtin_amdgcn_readfirstlane(tid >> 6), fr = lane & 15, fq = lane >> 4;
    const int mi = wave >> 1, nj = wave & 1;
    bf16* St = (bf16*)(lds + GS_ST); bf16* VnT = (bf16*)(lds + GS_VNT);
    float* egls = (float*)(lds + GS_END);
    if (N0 == 0) {
        for (int i = tid; i < 2 * 32 * 136 / 2; i += NTH) ((unsigned*)St)[i] = 0u;
        accS[0] = (f32x4){0.f, 0.f, 0.f, 0.f}; accS[1] = accS[0]; cur = 0;
    }
    if (tid >= N0 && tid < N1) egls[tid] = cb.EGL[(size_t)((b * 64 + tid) * 4 + h)];
    __syncthreads();
#define GS_DECL(X) bf16x8_t aW##X[4], aQG##X[4], aQK##X[2], aKD##X[2]; v2u ut##X;
    GS_DECL(0) GS_DECL(1) GS_DECL(2)
#define GS_GLD16(dst, ptr) asm volatile("global_load_dwordx4 %0, %1, off" : "=v"(dst) : "v"(ptr))
#define GS_GLD8(dst, ptr) asm volatile("global_load_dwordx2 %0, %1, off" : "=v"(dst) : "v"(ptr))
#define GS_LOAD(X, n_) do { const size_t u_ = (size_t)((b * 64 + ((n_) < 63 ? (n_) : 63)) * 4 + h);     \
        _Pragma("unroll") for (int ks = 0; ks < 4; ++ks) { GS_GLD16(aW##X[ks], cb.W + (u_ * 64 + mi * 16 + fr) * 128 + ks * 32 + 8 * fq); GS_GLD16(aQG##X[ks], cb.QG + (u_ * 64 + mi * 16 + fr) * 128 + ks * 32 + 8 * fq); } \
        _Pragma("unroll") for (int ks = 0; ks < 2; ++ks) { GS_GLD16(aQK##X[ks], cb.QK + (u_ * 64 + mi * 16 + fr) * 64 + ks * 32 + 8 * fq); GS_GLD16(aKD##X[ks], cb.KDT + (u_ * 128 + wave * 16 + fr) * 64 + ks * 32 + 8 * fq); } \
        GS_GLD8(ut##X, cb.UT + (u_ * 128 + sl * 32 + nj * 16 + fr) * 64 + mi * 16 + 4 * fq); } while (0)
#define GS_WAITN(X, N) asm volatile("s_waitcnt vmcnt(" #N ")" : "+v"(aW##X[0]), "+v"(aW##X[1]), "+v"(aW##X[2]), "+v"(aW##X[3]), "+v"(aQG##X[0]), "+v"(aQG##X[1]), "+v"(aQG##X[2]), "+v"(aQG##X[3]), \
        "+v"(aQK##X[0]), "+v"(aQK##X[1]), "+v"(aKD##X[0]), "+v"(aKD##X[1]), "+v"(ut##X))
#define GS_WAIT(X, n_) GS_WAITN(X, 26)
#define GS_STEP(X, n_) do { \
        const float egl##X = egls[(n_)]; \
        GS_WAIT(X, n_); \
        __syncthreads();                                        \
        f32x4 accW = (f32x4){0.f, 0.f, 0.f, 0.f}, accO = accW; \
        const bf16* Sc = St + cur * 32 * 136; \
        _Pragma("unroll") for (int ks = 0; ks < 4; ++ks) { const bf16x8_t bs = *(const bf16x8_t*)(Sc + (nj * 16 + fr) * 136 + ks * 32 + 8 * fq); accW = mfma16(aW##X[ks], bs, accW); accO = mfma16(aQG##X[ks], bs, accO); } \
          \
        const float v0 = bflo(ut##X.x) - accW[0], v1 = bfhi(ut##X.x) - accW[1], v2 = bflo(ut##X.y) - accW[2], v3 = bfhi(ut##X.y) - accW[3]; \
        { v2u o; o.x = pk2(v0, v1); o.y = pk2(v2, v3); *(v2u*)(VnT + (nj * 16 + fr) * 72 + mi * 16 + 4 * fq) = o; } \
        __syncthreads();                                        \
        _Pragma("unroll") for (int ks = 0; ks < 2; ++ks) { const bf16x8_t bv = *(const bf16x8_t*)(VnT + (nj * 16 + fr) * 72 + ks * 32 + 8 * fq); accO = mfma16(aQK##X[ks], bv, accO); } \
        { float* orow = O + (size_t)(b * SEQ + (n_) * 64 + mi * 16 + 4 * fq) * 512 + h * 128 + sl * 32 + nj * 16 + fr; \
          orow[0] = accO[0]; orow[512] = accO[1]; orow[1024] = accO[2]; orow[1536] = accO[3]; } \
          \
        bf16* Sn = St + (cur ^ 1) * 32 * 136; \
        _Pragma("unroll") for (int njj = 0; njj < 2; ++njj) { \
            accS[njj] = accS[njj] * egl##X; \
            _Pragma("unroll") for (int ks = 0; ks < 2; ++ks) { const bf16x8_t bv = *(const bf16x8_t*)(VnT + (njj * 16 + fr) * 72 + ks * 32 + 8 * fq); accS[njj] = mfma16(aKD##X[ks], bv, accS[njj]); } \
            v2u o; o.x = pk2(accS[njj][0], accS[njj][1]); o.y = pk2(accS[njj][2], accS[njj][3]); \
            *(v2u*)(Sn + (njj * 16 + fr) * 136 + wave * 16 + 4 * fq) = o; } \
        cur ^= 1; } while (0)
    constexpr int NTRI = (N1 - N0) / 3, NREM = (N1 - N0) % 3, NM = N0 + 3 * NTRI;
    GS_LOAD(0, N0); GS_LOAD(1, N0 + 1);
#pragma unroll 1
    for (int n = N0; n < NM; n += 3) {
        GS_LOAD(2, n + 2);
        GS_STEP(0, n);
        GS_LOAD(0, n + 3);
        GS_STEP(1, n + 1);
        GS_LOAD(1, n + 4);
        GS_STEP(2, n + 2);
    }
    if (NREM >= 1) { GS_LOAD(2, NM + 2); GS_STEP(0, NM); }
    if (NREM == 2) { GS_LOAD(0, NM + 3); GS_STEP(1, NM + 1); }
    GS_WAITN(0, 0); GS_WAITN(1, 0); GS_WAITN(2, 0);
#undef GS_STEP
#undef GS_DECL
#undef GS_WAIT
#undef GS_WAITN
#undef GS_GLD16
#undef GS_GLD8
    asm volatile("s_waitcnt vmcnt(0)" ::: "memory");
#undef GS_LOAD
    if (N1 == 64) {
#pragma unroll
        for (int njj = 0; njj < 2; ++njj)
#pragma unroll
            for (int r = 0; r < 4; ++r) Sout[(((size_t)b * 4 + h) * 128 + wave * 16 + 4 * fq + r) * 128 + sl * 32 + njj * 16 + fr] = accS[njj][r];
    }
    __syncthreads();
}

__device__ __forceinline__ void lru_prep_unit(const bf16* __restrict__ PROJ, const float* __restrict__ conv_w, const float* __restrict__ conv_b,
                                              const float* __restrict__ w_r, const float* __restrict__ b_r, const float* __restrict__ w_i, const float* __restrict__ b_i, const float* __restrict__ lam,
                                              float* __restrict__ H, float* __restrict__ P, float* __restrict__ Hend, float* __restrict__ Pend, float* __restrict__ p_lru_conv, int ub) {
    int c = threadIdx.x; asm volatile("" : "+v"(c));
    const int nblk = c >> 6, d = c & 63;
    const int n = ub & 63, b = ub >> 6, t0 = b * SEQ + n * 64;
    float wr[64], wi[64];
#pragma unroll
    for (int cc = 0; cc < 64; ++cc) { wr[cc] = w_r[((size_t)nblk * 64 + cc) * 64 + d]; wi[cc] = w_i[((size_t)nblk * 64 + cc) * 64 + d]; }
    const float cw0 = conv_w[c], cw1 = conv_w[512 + c], cw2 = conv_w[1024 + c], cw3 = conv_w[1536 + c], cb_ = conv_b[c];
    const float br = b_r[c], bi = b_i[c], spl = -8.0f * softplusf_(-lam[c]);
    float x0 = (n * 64 - 3 >= 0) ? bf2f(PROJ[(size_t)(t0 - 3) * ABN + C_XR + c]) : 0.f;
    float x1 = (n * 64 - 2 >= 0) ? bf2f(PROJ[(size_t)(t0 - 2) * ABN + C_XR + c]) : 0.f;
    float x2 = (n * 64 - 1 >= 0) ? bf2f(PROJ[(size_t)(t0 - 1) * ABN + C_XR + c]) : 0.f;
    float hloc = 0.f, ploc = 1.f;
    bf16 xa[16], xb[16];
#pragma unroll
    for (int k = 0; k < 16; ++k) xa[k] = PROJ[(size_t)(t0 + k) * ABN + C_XR + c];
#pragma unroll 1
    for (int ib = 0; ib < 64; ib += 16) {
      if (ib + 16 < 64) {
#pragma unroll
        for (int k = 0; k < 16; ++k) xb[k] = PROJ[(size_t)(t0 + ib + 16 + k) * ABN + C_XR + c];
      }
#pragma unroll
      for (int k = 0; k < 16; ++k) {
        const int i = ib + k;
        const float xt = bf2f(xa[k]);
        const float xr = cb_ + cw0 * x0 + cw1 * x1 + cw2 * x2 + cw3 * xt;
        f32x2_t ga = (f32x2_t){br, bi}, gb = (f32x2_t){0.f, 0.f};
#pragma unroll
        for (int cc = 0; cc < 64; cc += 2) {
            const float xa_ = __uint_as_float(__builtin_amdgcn_readlane(__float_as_uint(xr), cc)), xb_ = __uint_as_float(__builtin_amdgcn_readlane(__float_as_uint(xr), cc + 1));
            ga += (f32x2_t){xa_, xa_} * (f32x2_t){wr[cc], wi[cc]}; gb += (f32x2_t){xb_, xb_} * (f32x2_t){wr[cc + 1], wi[cc + 1]};
        }
        ga += gb;
        const float r = __frcp_rn(1.0f + __expf(-ga.x)), ii = __frcp_rn(1.0f + __expf(-ga.y));
        const float a = __expf(spl * r), bb = __fsqrt_rn(fmaxf(1.0f - a * a, 0.f)) * (ii * xr);
        hloc = a * hloc + bb; ploc *= a;
        H[(size_t)(t0 + i) * 512 + c] = hloc; P[(size_t)(t0 + i) * 512 + c] = ploc;
        if (n == 63 && i >= 61) p_lru_conv[((size_t)b * 3 + (i - 61)) * 512 + c] = xt;
        x0 = x1; x1 = x2; x2 = xt;
      }
#pragma unroll
      for (int k = 0; k < 16; ++k) xa[k] = xb[k];
    }
    Hend[(size_t)ub * 512 + c] = hloc; Pend[(size_t)ub * 512 + c] = ploc;
}
__device__ __forceinline__ void lru_carry(const float* __restrict__ Hend, const float* __restrict__ Pend, float* __restrict__ CIN, float* __restrict__ hlast, int bx) {
    int tx_ = threadIdx.x; asm volatile("" : "+v"(tx_));
    const int idx = bx * NTH + tx_, b = idx >> 9, c = idx & 511;
    float carry = 0.f;
#pragma unroll 8
    for (int n = 0; n < 64; ++n) {
        const size_t o = ((size_t)b * 64 + n) * 512 + c;
        CIN[o] = carry;
        carry = Hend[o] + Pend[o] * carry;
    }
    hlast[(size_t)b * 512 + c] = carry;
}

__device__ __forceinline__ unsigned f2key(float f) { const unsigned u = __float_as_uint(f); return u ^ ((u >> 31) ? 0xffffffffu : 0x80000000u); }
__device__ __forceinline__ float key2f(unsigned k) { return __uint_as_float(k ^ ((k >> 31) ? 0x80000000u : 0xffffffffu)); }
#define TK_CE(hi, lo) do { const unsigned a_ = (hi), b_ = (lo); (hi) = a_ > b_ ? a_ : b_; (lo) = a_ > b_ ? b_ : a_; } while (0)
template <int N> __device__ __forceinline__ void bitonic_sort_desc(unsigned (&a)[N]) {
#pragma unroll
    for (int k = 2; k <= N; k <<= 1)
#pragma unroll
        for (int j = k >> 1; j > 0; j >>= 1)
#pragma unroll
            for (int i = 0; i < N; ++i) { const int l = i ^ j; if (l > i) { if ((i & k) == 0) TK_CE(a[i], a[l]); else TK_CE(a[l], a[i]); } }
}
template <int XM> __device__ __forceinline__ void merge_top16(unsigned (&a)[16]) {
    unsigned c[16];
#pragma unroll
    for (int i = 0; i < 16; ++i) { const unsigned o = (unsigned)__shfl_xor((int)a[15 - i], XM); c[i] = a[i] > o ? a[i] : o; }
#pragma unroll
    for (int j = 8; j > 0; j >>= 1)
#pragma unroll
        for (int i = 0; i < 16; ++i) { const int l = i ^ j; if (l > i) TK_CE(c[i], c[l]); }
#pragma unroll
    for (int i = 0; i < 16; ++i) a[i] = c[i];
}
constexpr int TK_SS = 0, TK_TS = 128 * 132 * 4, TK_END = TK_TS + 64 * 2 * 16 * 4;
__device__ __forceinline__ void peer_topk3(const bf16* __restrict__ Q, const bf16* __restrict__ KB  , int* __restrict__ EXP, float* __restrict__ GATE,
                                           int tile, int h, unsigned char* lds) {
    int tid = threadIdx.x; asm volatile("" : "+v"(tid));
    const int lane = tid & 63, wave = __builtin_amdgcn_readfirstlane(tid >> 6), fr = lane & 15, fq = lane >> 4;
    float* Ss = (float*)(lds + TK_SS); unsigned* Ts = (unsigned*)(lds + TK_TS);
    {
        const int c = wave >> 2, mt = wave & 3;
        bf16x8_t a[4];
#pragma unroll
        for (int ks = 0; ks < 4; ++ks) a[ks] = *(const bf16x8_t*)(Q + (size_t)(tile * 64 + mt * 16 + fr) * 2048 + h * 256 + c * 128 + ks * 32 + 8 * fq);
        const bf16* kb = KB + ((size_t)(h * 2 + c) * 128) * 128;
#pragma unroll
        for (int nt = 0; nt < 8; ++nt) {
            f32x4 acc = (f32x4){0.f, 0.f, 0.f, 0.f};
#pragma unroll
            for (int ks = 0; ks < 4; ++ks) { const bf16x8_t bk = *(const bf16x8_t*)(kb + (size_t)(nt * 16 + fr) * 128 + ks * 32 + 8 * fq); acc = mfma16(a[ks], bk, acc); }
#pragma unroll
            for (int r = 0; r < 4; ++r) Ss[(c * 64 + mt * 16 + 4 * fq + r) * 132 + (nt >> 1) * 33 + (nt & 1) * 16 + fr] = acc[r];
        }
    }
    __syncthreads();
    {
        const int row = tid >> 2, q = tid & 3;
        const float* src = Ss + row * 132 + q * 33;
        unsigned a[32];
#pragma unroll
        for (int j = 0; j < 32; ++j) a[j] = (f2key(src[j]) & ~127u) | (unsigned)(127 - (q * 32 + j));
        bitonic_sort_desc<32>(a);
        unsigned t[16];
#pragma unroll
        for (int j = 0; j < 16; ++j) t[j] = a[j];
        merge_top16<1>(t); merge_top16<2>(t);
        if (q == 0) {
            const int c = row >> 6, tk = row & 63;
#pragma unroll
            for (int j = 0; j < 16; ++j) Ts[(tk * 2 + c) * 16 + j] = t[j];
        }
    }
    __syncthreads();
    if (tid < 256) {
        const int tk = tid >> 2, q = tid & 3;
        const unsigned* t0 = Ts + (tk * 2 + 0) * 16; const unsigned* t1 = Ts + (tk * 2 + 1) * 16;
        unsigned a[16];
#pragma unroll
        for (int s = 0; s < 13; ++s) {
            const int e = s * 4 + q;
            int i, j;
            if (e < 16) { i = 0; j = e; } else if (e < 24) { i = 1; j = e - 16; } else if (e < 29) { i = 2; j = e - 24; } else if (e < 33) { i = 3; j = e - 29; }
            else if (e < 36) { i = 4; j = e - 33; } else if (e < 42) { i = 5 + ((e - 36) >> 1); j = (e - 36) & 1; } else { i = 8 + (e - 42); j = 0; }
            const bool ok = e < 50;
            const float sum = key2f(t0[ok ? i : 0] & ~127u) + key2f(t1[ok ? j : 0] & ~127u);
            a[s] = ok ? ((f2key(sum) & ~255u) | (unsigned)(255 - (i * 16 + j))) : 0u;
        }
        a[13] = 0u; a[14] = 0u; a[15] = 0u;
        bitonic_sort_desc<16>(a);
        merge_top16<1>(a); merge_top16<2>(a);
        float ev[16], sum = 0.f; const float m = key2f(a[0] & ~255u);
#pragma unroll
        for (int j = 0; j < 16; ++j) { ev[j] = __expf(key2f(a[j] & ~255u) - m); sum += ev[j]; }
        const float inv = 1.0f / sum;
        const size_t o = (size_t)(tile * 64 + tk) * 128 + h * 16;
#pragma unroll
        for (int j = 0; j < 16; ++j)
            if ((j >> 2) == q) {
                const int code = 255 - (int)(a[j] & 255u), i = code >> 4, jj = code & 15;
                const int n0 = 127 - (int)(t0[i] & 127u), n1 = 127 - (int)(t1[jj] & 127u);
                EXP[o + j] = n0 * 128 + n1; GATE[o + j] = ev[j] * inv;
            }
    }
    __syncthreads();
}

constexpr int AT_KS = 0, AT_VT = 192 * 72 * 2, AT_BT = AT_VT + 64 * 200 * 2, AT_PW = AT_BT + 4 * 128 * 4, AT_END = AT_PW + 8 * 32 * 72 * 2;
__device__ __forceinline__ void attn_unit(const bf16* __restrict__ PCb, const float* __restrict__ rel_bias, const float* __restrict__ sinks, bf16* __restrict__ ATT, int un, unsigned char* lds) {
    int tid = threadIdx.x; asm volatile("" : "+v"(tid));
    const int lane = tid & 63, wave = __builtin_amdgcn_readfirstlane(tid >> 6), fr = lane & 15, fq = lane >> 4;
    const int kvh = un & 3, qblk = (un >> 2) & 63, b = un >> 8;
    const int q0 = qblk * 64, tb = b * SEQ;
    bf16* Ks = (bf16*)(lds + AT_KS); bf16* Vt = (bf16*)(lds + AT_VT); float* Bt = (float*)(lds + AT_BT); bf16* Pw = (bf16*)(lds + AT_PW) + wave * 32 * 72;
#pragma unroll
    for (int k = 0; k < 3; ++k) {
        const int ci = tid + 512 * k, row = ci >> 3, part = ci & 7, kpos = q0 - 128 + row;
        v4u kv = (v4u){0u, 0u, 0u, 0u}, vv = kv;
        if (kpos >= 0) { const bf16* src = PCb + (size_t)(tb + kpos) * CN + kvh * 64 + part * 8; kv = *(const v4u*)(src + 1024); vv = *(const v4u*)(src + 1280); }
        *(v4u*)(Ks + row * 72 + part * 8) = kv;
        bf16* vd = Vt + (part * 8) * 200 + row;
        vd[0 * 200] = (bf16)(vv.x & 0xffffu); vd[1 * 200] = (bf16)(vv.x >> 16); vd[2 * 200] = (bf16)(vv.y & 0xffffu); vd[3 * 200] = (bf16)(vv.y >> 16);
        vd[4 * 200] = (bf16)(vv.z & 0xffffu); vd[5 * 200] = (bf16)(vv.z >> 16); vd[6 * 200] = (bf16)(vv.w & 0xffffu); vd[7 * 200] = (bf16)(vv.w >> 16);
    }
    Bt[tid] = rel_bias[t5_bucket(tid & 127) * 16 + kvh * 4 + (tid >> 7)];
    __syncthreads();
    const int g = wave >> 1, qs = (wave & 1) * 32, hh = kvh * 4 + g;
    bf16x8_t aQ[2][2];
#pragma unroll
    for (int mt = 0; mt < 2; ++mt)
#pragma unroll
        for (int ks = 0; ks < 2; ++ks) aQ[mt][ks] = *(const bf16x8_t*)(PCb + (size_t)(tb + q0 + qs + mt * 16 + fr) * CN + hh * 64 + ks * 32 + 8 * fq);
    f32x4 sc[2][12];
#pragma unroll
    for (int nt = 0; nt < 12; ++nt) {
        const bf16x8_t b0 = *(const bf16x8_t*)(Ks + (nt * 16 + fr) * 72 + 8 * fq), b1 = *(const bf16x8_t*)(Ks + (nt * 16 + fr) * 72 + 32 + 8 * fq);
#pragma unroll
        for (int mt = 0; mt < 2; ++mt) { f32x4 a = (f32x4){0.f, 0.f, 0.f, 0.f}; a = mfma16(aQ[mt][0], b0, a); a = mfma16(aQ[mt][1], b1, a); sc[mt][nt] = a; }
    }
    const float sink = sinks[hh];
    const float* bt = Bt + g * 128;
#pragma unroll
    for (int mt = 0; mt < 2; ++mt)
#pragma unroll
        for (int r = 0; r < 4; ++r) {
            const int qi = qs + mt * 16 + 4 * fq + r;
            float mx = sink;
#pragma unroll
            for (int nt = 0; nt < 12; ++nt) {
                const int kk = nt * 16 + fr, rel = qi + 128 - kk;
                const bool valid = rel >= 0 && rel < 128 && (q0 - 128 + kk) >= 0;
                const float lg = valid ? sc[mt][nt][r] * 0.125f + bt[valid ? rel : 0] : -INFINITY;
                sc[mt][nt][r] = lg; mx = fmaxf(mx, lg);
            }
            mx = fmaxf(mx, __shfl_xor(mx, 1)); mx = fmaxf(mx, __shfl_xor(mx, 2)); mx = fmaxf(mx, __shfl_xor(mx, 4)); mx = fmaxf(mx, __shfl_xor(mx, 8));
            float sum = 0.f;
#pragma unroll
            for (int nt = 0; nt < 12; ++nt) { const float p = __expf(sc[mt][nt][r] - mx); sc[mt][nt][r] = p; sum += p; }
            sum += __shfl_xor(sum, 1); sum += __shfl_xor(sum, 2); sum += __shfl_xor(sum, 4); sum += __shfl_xor(sum, 8);
            const float inv = 1.0f / (sum + __expf(sink - mx));
#pragma unroll
            for (int nt = 0; nt < 12; ++nt) sc[mt][nt][r] *= inv;
        }
    f32x4 oacc[2][4];
#pragma unroll
    for (int mt = 0; mt < 2; ++mt)
#pragma unroll
        for (int dt = 0; dt < 4; ++dt) oacc[mt][dt] = (f32x4){0.f, 0.f, 0.f, 0.f};
#pragma unroll
    for (int kc = 0; kc < 3; ++kc) {
#pragma unroll
        for (int mt = 0; mt < 2; ++mt)
#pragma unroll
            for (int n4 = 0; n4 < 4; ++n4)
#pragma unroll
                for (int r = 0; r < 4; ++r) Pw[(mt * 16 + 4 * fq + r) * 72 + n4 * 16 + fr] = (bf16)f2bf(sc[mt][kc * 4 + n4][r]);
        asm volatile("s_waitcnt lgkmcnt(0)" ::: "memory");
#pragma unroll
        for (int ks = 0; ks < 2; ++ks) {
            const bf16x8_t p0 = *(const bf16x8_t*)(Pw + fr * 72 + ks * 32 + 8 * fq), p1 = *(const bf16x8_t*)(Pw + (16 + fr) * 72 + ks * 32 + 8 * fq);
#pragma unroll
            for (int dt = 0; dt < 4; ++dt) {
                const bf16x8_t bv = *(const bf16x8_t*)(Vt + (dt * 16 + fr) * 200 + kc * 64 + ks * 32 + 8 * fq);
                oacc[0][dt] = mfma16(p0, bv, oacc[0][dt]); oacc[1][dt] = mfma16(p1, bv, oacc[1][dt]);
            }
        }
        asm volatile("s_waitcnt lgkmcnt(0)" ::: "memory");
    }
#pragma unroll
    for (int mt = 0; mt < 2; ++mt)
#pragma unroll
        for (int dt = 0; dt < 4; ++dt)
#pragma unroll
            for (int r = 0; r < 4; ++r) Pw[(mt * 16 + 4 * fq + r) * 72 + dt * 16 + fr] = (bf16)f2bf(oacc[mt][dt][r]);
    asm volatile("s_waitcnt lgkmcnt(0)" ::: "memory");
#pragma unroll
    for (int k = 0; k < 4; ++k) {
        const int ci = lane + 64 * k, row = ci >> 3, part = ci & 7;
        *(v4u*)(ATT + (size_t)(tb + q0 + qs + row) * D + hh * 64 + part * 8) = *(const v4u*)(Pw + row * 72 + part * 8);
    }
    __syncthreads();
}

__device__ __forceinline__ void swa_attn_sample(const bf16* __restrict__ PCb, const float* __restrict__ cache_k, const float* __restrict__ cache_v,
                                                const float* __restrict__ rel_bias, const float* __restrict__ sinks, bf16* __restrict__ ATT, int gw, int lane) {
    const int sb = gw >> 4, h = gw & 15, kvh = h >> 2, t = NP + sb;
    const bf16* qrow = PCb + (size_t)t * CN + h * 64;
    float lg[2];
#pragma unroll
    for (int rr = 0; rr < 2; ++rr) {
        const int r = lane + 64 * rr;
        float dot = 0.f;
        if (r == 0) {
            const bf16* krow = PCb + (size_t)t * CN + 1024 + kvh * 64;
            for (int d = 0; d < 64; ++d) dot += bf2f(qrow[d]) * bf2f(krow[d]);
        } else {
            const float* krow = cache_k + (((size_t)sb * 128 + (128 - r)) * 4 + kvh) * 64;
#pragma unroll
            for (int d4 = 0; d4 < 16; ++d4) { const float4 kv = *(const float4*)(krow + d4 * 4);
                dot += bf2f(qrow[d4 * 4]) * kv.x + bf2f(qrow[d4 * 4 + 1]) * kv.y + bf2f(qrow[d4 * 4 + 2]) * kv.z + bf2f(qrow[d4 * 4 + 3]) * kv.w; }
        }
        lg[rr] = dot * 0.125f + rel_bias[t5_bucket(r) * 16 + h];
    }
    const float sink = sinks[h];
    const float m = fmaxf(wave_max(fmaxf(lg[0], lg[1])), sink);
    float p[2] = {expf(lg[0] - m), expf(lg[1] - m)};
    const float inv = 1.0f / (wave_sum(p[0] + p[1]) + expf(sink - m));
    float o = 0.f;
#pragma unroll
    for (int rr = 0; rr < 2; ++rr)
        for (int l2 = 0; l2 < 64; ++l2) {
            const int r = l2 + 64 * rr;
            const float pj = __shfl(p[rr], l2);
            const float vv = (r == 0) ? bf2f(PCb[(size_t)t * CN + 1280 + kvh * 64 + lane]) : cache_v[(((size_t)sb * 128 + (128 - r)) * 4 + kvh) * 64 + lane];
            o += pj * vv;
        }
    ATT[(size_t)t * D + h * 64 + lane] = (bf16)f2bf(o * inv);
}
__device__ __forceinline__ void swa_kv_out2(const bf16* __restrict__ PCb, const float* __restrict__ cache_k, const float* __restrict__ cache_v,
                                            float* __restrict__ pk, float* __restrict__ pv, float* __restrict__ sk, float* __restrict__ sv, int vb) {
    int tx_ = threadIdx.x; asm volatile("" : "+v"(tx_));
    const int c = tx_ & 255, row = vb * 2 + (tx_ >> 8);
    if (row < NB * 128) {
        const int b = row >> 7, i = row & 127;
        const bf16* src = PCb + (size_t)(b * SEQ + SEQ - 128 + i) * CN;
        pk[(size_t)row * 256 + c] = bf2f(src[1024 + c]);
        pv[(size_t)row * 256 + c] = bf2f(src[1280 + c]);
    } else {
        const int r2 = row - NB * 128, sb = r2 >> 7, i = r2 & 127;
        if (i < 127) {
            sk[(size_t)r2 * 256 + c] = cache_k[((size_t)sb * 128 + i + 1) * 256 + c];
            sv[(size_t)r2 * 256 + c] = cache_v[((size_t)sb * 128 + i + 1) * 256 + c];
        } else {
            const bf16* src = PCb + (size_t)(NP + sb) * CN;
            sk[(size_t)r2 * 256 + c] = bf2f(src[1024 + c]);
            sv[(size_t)r2 * 256 + c] = bf2f(src[1280 + c]);
        }
    }
}

constexpr size_t MiB = 1u << 20;
constexpr size_t WS_CTL = 0, CTL_ZERO_BYTES = 64 * 1024;
constexpr size_t WS_WAB = 1 * MiB;
constexpr size_t WS_WOUT = WS_WAB + (size_t)ABNP * D * 2;
constexpr size_t WS_WQ0 = WS_WOUT + (size_t)D * D * 2;
constexpr size_t WS_WQ1 = WS_WQ0 + (size_t)2048 * D * 2;
constexpr size_t WS_WINC = WS_WQ1 + (size_t)2048 * D * 2;
constexpr size_t WS_WOUTC = WS_WINC + (size_t)CN * D * 2;
constexpr size_t WS_ABUF = WS_WOUTC + (size_t)D * D * 2;
constexpr size_t WS_P = WS_ABUF + (size_t)MP * D * 2;
constexpr size_t WS_T = WS_P + (size_t)MP * ABN * 2;
constexpr size_t WS_Q = WS_T + (size_t)4 * 16384 * D + (size_t)4 * 16384 * 4;
constexpr size_t WS_A = WS_Q + (size_t)MP * 1536 * 4;
constexpr size_t WS_B = WS_A + (size_t)MP * 512 * 4;
constexpr size_t WS_O = WS_B + (size_t)MP * 512 * 4;
constexpr size_t WS_X1 = WS_O + (size_t)MP * 512 * 4;
constexpr size_t WS_G = WS_X1 + (size_t)MP * D * 4;
constexpr size_t WS_BETA = WS_G + (size_t)MP * 4 * 4;
constexpr size_t WS_GATE = WS_BETA + (size_t)MP * 4 * 4;
constexpr size_t WS_EXP = WS_GATE + (size_t)MP * 128 * 4;
constexpr size_t WS_HEND = WS_EXP + (size_t)MP * 128 * 4;
constexpr size_t WS_KEYS = WS_HEND + (size_t)3 * 4 * 64 * 512 * 4;
constexpr size_t WS_END = WS_KEYS + (size_t)2 * 8 * 2 * 128 * 128 * 2;
constexpr size_t Q_QKVS = 0, Q_W = 1 * MiB, Q_QG = Q_W + 16 * MiB, Q_KDT = Q_QG + 16 * MiB, Q_UT = Q_KDT + 16 * MiB, Q_QK = Q_UT + 16 * MiB, Q_EGL = Q_QK + 8 * MiB, Q_END = Q_EGL + 4096;
static_assert(Q_END <= (size_t)MP * 1536 * 4, "region Q");
static_assert(WS_END <= 512 * MiB, "d_ws map");

struct MegaArgs {
    const float* in[35];
    float* out;
    unsigned char* ws;
};

__global__ void __launch_bounds__(NTH, 2) fwd_megakernel(MegaArgs ma) {
    cg::grid_group grid = cg::this_grid();
    extern __shared__ __attribute__((aligned(16))) unsigned char lds[];
    float* smem = (float*)lds;
    const int nb = gridDim.x, b0 = blockIdx.x, wave = __builtin_amdgcn_readfirstlane(threadIdx.x >> 6);
    int tid = threadIdx.x, lane = tid & 63;
    const float* x_prompt = ma.in[0];
    const float* x_sample = ma.in[1];
    const float* state_gdn = ma.in[2];
    const float* state_gdn_conv = ma.in[3];
    const float* state_lru = ma.in[4];
    const float* state_lru_conv = ma.in[5];
    const float* cache_k = ma.in[6];
    const float* cache_v = ma.in[7];
    const float* w_in_ab = ma.in[8];
    const float* gdn_conv_w = ma.in[9];
    const float* gdn_a_log = ma.in[10];
    const float* gdn_dt_bias = ma.in[11];
    const float* gdn_norm_w = ma.in[12];
    const float* lru_conv_w = ma.in[13];
    const float* lru_conv_b = ma.in[14];
    const float* lru_w_r = ma.in[15];
    const float* lru_b_r = ma.in[16];
    const float* lru_w_i = ma.in[17];
    const float* lru_b_i = ma.in[18];
    const float* lru_lam = ma.in[19];
    const float* w_out_ab = ma.in[20];
    const float* w_in_c = ma.in[21];
    const float* b_in_c = ma.in[22];
    const float* swa_sinks = ma.in[23];
    const float* w_out_c = ma.in[24];
    const float* b_out_c = ma.in[25];
    const float* rel_bias = ma.in[26];
    const float* ln_mix_g = ma.in[27];
    const float* ln_mix_b = ma.in[28];
    const float* ln_ffn_g = ma.in[29];
    const float* ln_ffn_b = ma.in[30];
    const float* peer_w_q = ma.in[31];
    const float* peer_keys = ma.in[32];
    const float* peer_u = ma.in[33];
    const float* peer_v = ma.in[34];

    float* out = ma.out;
    float* o_y = out;
    float* o_p_gdn = out + (size_t)NT * D;
    float* o_p_gdn_conv = o_p_gdn + 262144;
    float* o_p_lru = o_p_gdn_conv + 18432;
    float* o_p_lru_conv = o_p_lru + 2048;
    float* o_p_k = o_p_lru_conv + 6144;
    float* o_p_v = o_p_k + 131072;
    float* o_s_gdn = o_p_v + 131072;
    float* o_s_gdn_conv = o_s_gdn + 8388608;
    float* o_s_lru = o_s_gdn_conv + 589824;
    float* o_s_lru_conv = o_s_lru + 65536;
    float* o_s_k = o_s_lru_conv + 196608;
    float* o_s_v = o_s_k + 4194304;

    unsigned char* ws = ma.ws;
    bf16* WAB_T = (bf16*)(ws + WS_WAB); bf16* WOUT_T = (bf16*)(ws + WS_WOUT); bf16* WQ0_T = (bf16*)(ws + WS_WQ0); bf16* WQ1_T = (bf16*)(ws + WS_WQ1);
    bf16* WINC_T = (bf16*)(ws + WS_WINC); bf16* WOUTC_T = (bf16*)(ws + WS_WOUTC);
    bf16* ABUF = (bf16*)(ws + WS_ABUF);
    bf16* PROJ = (bf16*)(ws + WS_P); float* Y = (float*)(ws + WS_P); bf16* Qb = (bf16*)(ws + WS_P); bf16* PCb = (bf16*)(ws + WS_P); float* Y1 = (float*)(ws + WS_P);
    unsigned char* TAB8 = ws + WS_T; float* TSC = (float*)(ws + WS_T + (size_t)4 * 16384 * D);
    float* R_Q = (float*)(ws + WS_Q + Q_QKVS) - (size_t)NP * 1536; float* X2 = (float*)(ws + WS_A);
    GdnChunkBufs cbuf; cbuf.W = (bf16*)(ws + WS_Q + Q_W); cbuf.QG = (bf16*)(ws + WS_Q + Q_QG); cbuf.KDT = (bf16*)(ws + WS_Q + Q_KDT); cbuf.UT = (bf16*)(ws + WS_Q + Q_UT); cbuf.QK = (bf16*)(ws + WS_Q + Q_QK); cbuf.EGL = (float*)(ws + WS_Q + Q_EGL);
    bf16* KEYSB = (bf16*)(ws + WS_KEYS);
    float* HEND = (float*)(ws + WS_HEND); float* PEND = HEND + 4 * 64 * 512; float* CIN = PEND + 4 * 64 * 512;
    float* R_A = (float*)(ws + WS_A); float* R_B = (float*)(ws + WS_B); float* R_O = (float*)(ws + WS_O);
    float* R_X1 = (float*)(ws + WS_X1); float* X3 = R_X1;
    float* R_G = (float*)(ws + WS_G); float* R_BETA = (float*)(ws + WS_BETA); float* R_GATE = (float*)(ws + WS_GATE); int* R_EXP = (int*)(ws + WS_EXP);

    for (int u = tid; u < (LDS_BYTES - RING_BYTES) / 4; u += NTH) ((unsigned*)(lds + RING_BYTES))[u] = 0u;
    __syncthreads();
    XcdBarrier bar = xcd_barrier_post((unsigned*)(ws + WS_CTL), (volatile LAS unsigned*)((LAS unsigned char*)lds + MISC_OFF) + 8);
#define GRID_BAR() do { xcd_barrier(bar); asm volatile("" : "+v"(tid)); lane = tid & 63; } while (0)
#define PHASE_LOOP(n) for (int vb = b0; vb < (n); vb += nb)
#define PHASE_END __syncthreads()
#define GEMM_PHASE(EPI, Aptr, Btptr, Nn, ...) do { pg8::Gemm g_{(const pg8::bf16_t*)(Aptr), (const pg8::bf16_t*)(Btptr), MP, (Nn), D}; pg8::StaticOrder S_; S_.init(MP, (Nn), nb, b0); \
        pg8::EPI E_{__VA_ARGS__}; pg8::gemm_phase<pg8::EPI, pg8::StaticOrder, true, true>((PG8_LAS unsigned char*)lds, g_, S_, E_); } while (0)

    {
        float* scr = smem + wave * 4096;
        const int gw = b0 * NWAVES + wave, NGW = nb * NWAVES;
        constexpr int I_AB = 16 * 97, I_OUT = 16 * 32, I_Q = 16 * 64, I_INC = 16 * 48;
        constexpr int NITEMS = I_AB + I_OUT + 2 * I_Q + I_INC + I_OUT;
        for (int it = gw; it < NITEMS; it += NGW) {
            int r = it;
            if (r < I_AB) { p0_transpose_item(w_in_ab, D, ABN, WAB_T, scr, r, lane); continue; } r -= I_AB;
            if (r < I_OUT) { p0_transpose_item(w_out_ab, D, D, WOUT_T, scr, r, lane); continue; } r -= I_OUT;
            if (r < I_Q) { p0_transpose_item(peer_w_q, D, 2048, WQ0_T, scr, r, lane); continue; } r -= I_Q;
            if (r < I_Q) { p0_transpose_item(peer_w_q + (size_t)D * 2048, D, 2048, WQ1_T, scr, r, lane); continue; } r -= I_Q;
            if (r < I_INC) { p0_transpose_item(w_in_c, D, CN, WINC_T, scr, r, lane); continue; } r -= I_INC;
            p0_transpose_item(w_out_c, D, D, WOUTC_T, scr, r, lane);
        }
        for (int m = gw; m < MP + (ABNP - 97 * 32); m += NGW) {
            if (m < MP) row_to_bf16(m < NP ? x_prompt + (size_t)m * D : (m < NT ? x_sample + (size_t)(m - NP) * D : nullptr), ABUF + (size_t)m * D, lane);
            else row_to_bf16(nullptr, WAB_T + (size_t)(97 * 32 + (m - MP)) * D, lane);
        }
    }
    grid.sync();
    GEMM_PHASE(EpiStoreBf16, ABUF, WAB_T, ABNP, PROJ, ABN, nullptr, NT, ABN);
    GRID_BAR();
    { AbPrepArgs pa;
      pa.PROJ = PROJ; pa.st_gdn_conv = state_gdn_conv; pa.st_lru_conv = state_lru_conv;
      pa.gdn_conv_w = gdn_conv_w; pa.a_log = gdn_a_log; pa.dt_bias = gdn_dt_bias;
      pa.lru_conv_w = lru_conv_w; pa.lru_conv_b = lru_conv_b; pa.w_r = lru_w_r; pa.b_r = lru_b_r; pa.w_i = lru_w_i; pa.b_i = lru_b_i; pa.lam = lru_lam;
      pa.QKV = R_Q; pa.G = R_G; pa.BETA = R_BETA; pa.LA = R_A; pa.LB = R_B;
      pa.p_gdn_conv = o_p_gdn_conv; pa.p_lru_conv = o_p_lru_conv; pa.s_gdn_conv = o_s_gdn_conv; pa.s_lru_conv = o_s_lru_conv;
#define GDN_UN_A(i_) ((((i_) >> 7) * 64 + (((i_) >> 2) & 31)) * 4 + ((i_) & 3))
      if (b0 < 128) {
          lru_prep_unit(PROJ, lru_conv_w, lru_conv_b, lru_w_r, lru_b_r, lru_w_i, lru_b_i, lru_lam, R_B, R_A, HEND, PEND, o_p_lru_conv, (b0 >> 5) * 64 + (b0 & 31));
          gdn_prep_unit(PROJ, gdn_conv_w, gdn_a_log, gdn_dt_bias, cbuf, o_p_gdn_conv, GDN_UN_A(b0), lds);
      } else if (b0 < 256) {
          ab_prep(pa, NP + (b0 - 128), smem); PHASE_END;
          for (int k = 0; k < 3; ++k) gdn_prep_unit(PROJ, gdn_conv_w, gdn_a_log, gdn_dt_bias, cbuf, o_p_gdn_conv, GDN_UN_A(128 + (b0 - 128) * 3 + k), lds);
      } }
    GRID_BAR();
    f32x4 seqS[2]; int seqcur = 0;
    if (b0 < 64) gdn_seq<0, 32>(cbuf, R_O, o_p_gdn, b0 >> 4, (b0 >> 2) & 3, b0 & 3, lds, seqS, seqcur);
    else if (b0 < 192) {
        const int i = b0 - 64;
        lru_prep_unit(PROJ, lru_conv_w, lru_conv_b, lru_w_r, lru_b_r, lru_w_i, lru_b_i, lru_lam, R_B, R_A, HEND, PEND, o_p_lru_conv, (i >> 5) * 64 + 32 + (i & 31));
        for (int k = 0; k < 2; ++k) gdn_prep_unit(PROJ, gdn_conv_w, gdn_a_log, gdn_dt_bias, cbuf, o_p_gdn_conv, GDN_UN_A(i * 2 + k) + 32 * 4, lds);
    } else if (b0 < 256) {
        const int i = b0 - 192;
        for (int k = 0; k < 4; ++k) gdn_prep_unit(PROJ, gdn_conv_w, gdn_a_log, gdn_dt_bias, cbuf, o_p_gdn_conv, GDN_UN_A(256 + i * 4 + k) + 32 * 4, lds);
    }
    GRID_BAR();
    if (b0 < 64) gdn_seq<32, 64>(cbuf, R_O, o_p_gdn, b0 >> 4, (b0 >> 2) & 3, b0 & 3, lds, seqS, seqcur);
    else if (b0 < 68) lru_carry(HEND, PEND, CIN, o_p_lru, b0 - 64);
    else {
        for (int v = b0 - 68; v < 2048 + 128; v += nb - 68) {
            if (v < 2048) gdn_scan(R_Q, R_G, R_BETA, state_gdn, R_O, o_s_gdn, NP, 1, v & 3, (v >> 2) & 3, v >> 4, smem);
            else lru_scan(R_A, R_B, state_lru, o_s_lru, NP, 1, NS, v - 2048);
            PHASE_END;
        }
        const int gw2 = (b0 - 68) * NWAVES + wave, NGW2 = (nb - 68) * NWAVES;
        for (int m = gw2; m < 512; m += NGW2) row_to_bf16(peer_keys + (size_t)m * D, KEYSB + (size_t)m * D, lane);
        for (int m = gw2; m < 4 * 16384; m += NGW2) {
            const int k = m >> 14, r = m & 16383;
            row_to_fp8(((k & 1) ? peer_v : peer_u) + ((size_t)(k >> 1) * 16384 + r) * D, TAB8 + (size_t)m * D, TSC + m, lane);
        }
    }
    GRID_BAR();
    PHASE_LOOP(NT / 2) { ab_mix(PROJ, R_O, R_B, R_A, CIN, gdn_norm_w, ABUF, vb); }
    GRID_BAR();
    GEMM_PHASE(EpiStoreF32, ABUF, WOUT_T, D, Y, D, nullptr, NT, D);
    GRID_BAR();
    PHASE_LOOP(NT / 8) { const int t = vb * 8 + wave;
        ln_res_w(t < NP ? x_prompt + (size_t)t * D : x_sample + (size_t)(t - NP) * D, Y + (size_t)t * D, ln_mix_g, ln_mix_b, R_X1 + (size_t)t * D, ABUF + (size_t)t * D, lane); }
    GRID_BAR();
    GEMM_PHASE(EpiStoreBf16, ABUF, WQ0_T, 2048, Qb, 2048, nullptr, NT, 2048);
    GRID_BAR();
    PHASE_LOOP((NT / 64) * 8) { peer_topk3(Qb, KEYSB, R_EXP, R_GATE, vb >> 3, vb & 7, lds); }
    GRID_BAR();
    PHASE_LOOP(NP / 8 + NS) { const int t = vb < NP / 8 ? vb * 8 + wave : NP + (vb - NP / 8);
        if (vb < NP / 8) peer_expert_w(R_X1 + (size_t)t * D, R_EXP + (size_t)t * 128, R_GATE + (size_t)t * 128, TAB8, TAB8 + (size_t)16384 * D, TSC, TSC + 16384, ln_ffn_g, ln_ffn_b, X2 + (size_t)t * D, ABUF + (size_t)t * D, lane);
        else peer_expert_blk(R_X1 + (size_t)t * D, R_EXP + (size_t)t * 128, R_GATE + (size_t)t * 128, TAB8, TAB8 + (size_t)16384 * D, TSC, TSC + 16384, ln_ffn_g, ln_ffn_b, X2 + (size_t)t * D, ABUF + (size_t)t * D, lane, wave, smem); }
    GRID_BAR();

    GEMM_PHASE(EpiStoreBf16, ABUF, WINC_T, CN, PCb, CN, b_in_c, NT, CN);
    GRID_BAR();
    PHASE_LOOP(1024 + 256 + (NB * 128 + NS * 128) / 2) {
        if (vb < 1024) attn_unit(PCb, rel_bias, swa_sinks, ABUF, vb, lds);
        else if (vb < 1280) swa_attn_sample(PCb, cache_k, cache_v, rel_bias, swa_sinks, ABUF, (vb - 1024) * 8 + wave, lane);
        else swa_kv_out2(PCb, cache_k, cache_v, o_p_k, o_p_v, o_s_k, o_s_v, vb - 1280);
    }
    GRID_BAR();
    GEMM_PHASE(EpiStoreF32, ABUF, WOUTC_T, D, Y1, D, b_out_c, NT, D);
    GRID_BAR();
    PHASE_LOOP(NT / 8) { const int t = vb * 8 + wave;
        ln_res_w(X2 + (size_t)t * D, Y1 + (size_t)t * D, ln_mix_g + D, ln_mix_b + D, X3 + (size_t)t * D, ABUF + (size_t)t * D, lane); }
    GRID_BAR();
    GEMM_PHASE(EpiStoreBf16, ABUF, WQ1_T, 2048, Qb, 2048, nullptr, NT, 2048);
    GRID_BAR();
    PHASE_LOOP((NT / 64) * 8) { peer_topk3(Qb, KEYSB + (size_t)8 * 2 * 128 * 128, R_EXP, R_GATE, vb >> 3, vb & 7, lds); }
    GRID_BAR();
    PHASE_LOOP(NP / 8 + NS) { const int t = vb < NP / 8 ? vb * 8 + wave : NP + (vb - NP / 8);
        if (vb < NP / 8) peer_expert_w(X3 + (size_t)t * D, R_EXP + (size_t)t * 128, R_GATE + (size_t)t * 128, TAB8 + (size_t)2 * 16384 * D, TAB8 + (size_t)3 * 16384 * D, TSC + 2 * 16384, TSC + 3 * 16384, ln_ffn_g + D, ln_ffn_b + D, o_y + (size_t)t * D, nullptr, lane);
        else peer_expert_blk(X3 + (size_t)t * D, R_EXP + (size_t)t * 128, R_GATE + (size_t)t * 128, TAB8 + (size_t)2 * 16384 * D, TAB8 + (size_t)3 * 16384 * D, TSC + 2 * 16384, TSC + 3 * 16384, ln_ffn_g + D, ln_ffn_b + D, o_y + (size_t)t * D, nullptr, lane, wave, smem); }
}
}

extern "C" void kernel_launch(void* const* d_in, const int* in_sizes, int n_in,
                              void* d_out, int out_size, void* d_ws, size_t ws_size,
                              hipStream_t stream) {
    static int grid_blocks = 0;
    if (!grid_blocks) {
        int dev = 0, cus = 0, per_cu = 0;
        (void)hipGetDevice(&dev);
        (void)hipDeviceGetAttribute(&cus, hipDeviceAttributeMultiprocessorCount, dev);
        if (hipFuncSetAttribute((const void*)fwd_megakernel, hipFuncAttributeMaxDynamicSharedMemorySize, LDS_BYTES) != hipSuccess) { fprintf(stderr, "hipFuncSetAttribute failed\n"); grid_blocks = -1; return; }
        (void)hipOccupancyMaxActiveBlocksPerMultiprocessor(&per_cu, (const void*)fwd_megakernel, NTH, LDS_BYTES);
        if (per_cu < 1) { fprintf(stderr, "occupancy query says %d blocks per CU\n", per_cu); grid_blocks = -1; return; }
        grid_blocks = cus;
    }
    if (grid_blocks < 0) return;
    (void)hipMemsetAsync((char*)d_ws + WS_CTL, 0, CTL_ZERO_BYTES, stream);
    MegaArgs ma{};
    for (int i = 0; i < 35; ++i) ma.in[i] = (const float*)d_in[i];
    ma.out = (float*)d_out;
    ma.ws = (unsigned char*)d_ws;
    void* args[] = {&ma};
    hipError_t e = hipLaunchCooperativeKernel((void*)fwd_megakernel, dim3(grid_blocks), dim3(NTH), args, LDS_BYTES, stream);
    if (e != hipSuccess) fprintf(stderr, "cooperative launch failed: %s (grid %d)\n", hipGetErrorString(e), grid_blocks);
}
```

```cpp
#include <hip/hip_runtime.h>
#include <hip/hip_cooperative_groups.h>
#include <cstdio>
#include <cstdint>
namespace cg = cooperative_groups;

namespace pg8 {
#define PG8_LAS __attribute__((address_space(3)))
typedef unsigned short bf16_t;
typedef short bf16x8 __attribute__((ext_vector_type(8)));
typedef float f32x4 __attribute__((ext_vector_type(4)));
typedef unsigned u32x4 __attribute__((ext_vector_type(4)));
constexpr int BM = 256, BK = 64, HALF = 128, HTB = HALF * BK * 2  , STAGE_BYTES = 8 * HTB, NXCD = 8, WGM = 8;

__host__ __device__ __forceinline__ int lds_byte(int r, int c) { const int st = (r >> 4) * 2 + (c >> 5), rr = r & 15, cc = c & 31, ob = rr * 64 + cc * 2; return st * 1024 + (ob ^ (((ob >> 9) & 1) << 5)); }
__host__ __device__ __forceinline__ void stage_rc(int b, int& R, int& C) { const int st = b / 1024, sb = b % 1024, swz = sb ^ (((sb >> 9) & 1) << 5); R = (st >> 1) * 16 + swz / 64; C = (st & 1) * 32 + (swz % 64) / 2; }
__host__ __device__ __forceinline__ int perm32(int rho) { const int n = rho >> 4, i = rho & 15; return 8 * (i >> 2) + 4 * n + (i & 3); }

struct Unit { int pm, pn; };
struct Gemm { const bf16_t* A; const bf16_t* Bt; int M, N, K; };

struct StaticOrder {
    int nM, nN, nwg, G, c;
    __host__ __device__ void init(int M, int N, int G_, int c_) { nM = M / BM; nN = N / BM; nwg = nM * nN; G = G_; c = c_; }
    __host__ __device__ bool next(int i, Unit& u) const {
        const long L = (long)i * G + c; if (L >= nwg) return false;
        int wgid = (int)L; { const int q = nwg / NXCD, r = nwg % NXCD, xcd = wgid % NXCD, off = wgid / NXCD; wgid = (xcd < r ? xcd * (q + 1) : r * (q + 1) + (xcd - r) * q) + off; }
        const int nig = WGM * nN, gid = wgid / nig, fm = gid * WGM, gsz = (nM - fm) < WGM ? (nM - fm) : WGM;
        u.pm = fm + ((wgid % nig) % gsz); u.pn = (wgid % nig) / gsz; return true;
    }
    __device__ __forceinline__ void a_ready(const Unit&) const {}
    __device__ __forceinline__ void done(const Unit&) const {}
};

__device__ __forceinline__ unsigned cvt_pk_bf16(float lo, float hi) { unsigned r; asm volatile("v_cvt_pk_bf16_f32 %0, %1, %2" : "=v"(r) : "v"(lo), "v"(hi)); return r; }
template <class Epi, class Sched, bool ALIGN_EPI = false, bool SP2 = false>
__device__ __forceinline__ void gemm_phase(PG8_LAS unsigned char* lds, const Gemm g, const Sched& S, const Epi& E) {
    int tid_ = threadIdx.x; asm volatile("" : "+v"(tid_));
    const int tid = tid_, wid = __builtin_amdgcn_readfirstlane(tid >> 6), lane = tid & 63, wr = wid >> 2, wc = wid & 3, fr = lane & 15, fq = lane >> 4;
    const int K = g.K, nt = K / BK;
    unsigned voffA[2], voffB[2];
#pragma unroll
    for (int i = 0; i < 2; ++i) { int R, C; stage_rc(tid * 16 + i * 8192, R, C); const int Rb = Epi::PERM ? ((R & ~31) + perm32(R & 31)) : R;
        voffA[i] = (unsigned)(R * K + C) * 2u; voffB[i] = (unsigned)(Rb * K + C) * 2u; }
    const size_t kstep = (size_t)(BK * 2);
    const size_t hstep = (size_t)HALF * K * 2;
    const size_t tstep = 2 * hstep;
    const unsigned ldsw = (unsigned)wid * 1024u;
    const int aoff = lds_byte(wr * 64 + fr, fq * 8), boff = lds_byte(wc * 32 + fr, fq * 8);
#define PG8_SA(b, h) (((b) * 2 + (h)) * HTB)
#define PG8_SB(b, h) ((4 + (b) * 2 + (h)) * HTB)
#define PG8_STAGE(bufoff, gbase, voff) do { _Pragma("unroll") for (int _i = 0; _i < 2; ++_i) \
        __builtin_amdgcn_global_load_lds((const unsigned*)((const char*)(gbase) + (voff)[_i]), (PG8_LAS unsigned*)(lds + (bufoff) + ldsw + _i * 8192), 16, 0, 0); } while (0)
#define PG8_LDA(dst, b, h) do { _Pragma("unroll") for (int m = 0; m < 4; ++m) _Pragma("unroll") for (int k = 0; k < 2; ++k) dst[m][k] = *(const PG8_LAS bf16x8*)(lds + PG8_SA(b, h) + aoff + m * 2048 + k * 1024); } while (0)
#define PG8_LDB(dst, b, h) do { _Pragma("unroll") for (int n = 0; n < 2; ++n) _Pragma("unroll") for (int k = 0; k < 2; ++k) dst[n][k] = *(const PG8_LAS bf16x8*)(lds + PG8_SB(b, h) + boff + n * 2048 + k * 1024); } while (0)
#define PG8_MMA(ai, bj, At, Bt) do { __builtin_amdgcn_s_setprio(1); _Pragma("unroll") for (int m = 0; m < 4; ++m) _Pragma("unroll") for (int n = 0; n < 2; ++n) _Pragma("unroll") for (int k = 0; k < 2; ++k) \
        acc[ai][bj][m][n] = __builtin_amdgcn_mfma_f32_16x16x32_bf16(Bt[n][k], At[m][k], acc[ai][bj][m][n], 0, 0, 0); __builtin_amdgcn_s_setprio(0); } while (0)
#define PG8_WAIT_V(n) asm volatile("s_waitcnt vmcnt(" #n ")" ::: "memory")
#define PG8_WAIT_L(n) asm volatile("s_waitcnt lgkmcnt(" #n ")" ::: "memory")
#define PG8_BAR __builtin_amdgcn_s_barrier()
#define PG8_SCHED __builtin_amdgcn_sched_barrier(0)
    Unit cur, nxt; int ui = 0;
    if (!S.next(0, cur)) return;
    f32x4 acc[2][2][4][2];
#pragma unroll
    for (int a = 0; a < 2; ++a)
#pragma unroll
        for (int b = 0; b < 2; ++b)
#pragma unroll
            for (int m = 0; m < 4; ++m)
#pragma unroll
                for (int n = 0; n < 2; ++n) acc[a][b][m][n] = (f32x4){0.f, 0.f, 0.f, 0.f};
    bf16x8 At[4][2], B0[2][2], B1[2][2];
    const char* cA = (const char*)g.A + (size_t)cur.pm * tstep; const char* cB = (const char*)g.Bt + (size_t)cur.pn * tstep;
    S.a_ready(cur);
    if constexpr (SP2) {
        PG8_STAGE(PG8_SB(0, 0), cB, voffB); PG8_STAGE(PG8_SB(0, 1), cB + hstep, voffB); PG8_STAGE(PG8_SA(0, 0), cA, voffA); PG8_STAGE(PG8_SA(0, 1), cA + hstep, voffA);
        if (wr == 1) PG8_BAR;
        PG8_WAIT_V(2); PG8_BAR;
        PG8_STAGE(PG8_SB(1, 0), cB + kstep, voffB); PG8_STAGE(PG8_SA(1, 0), cA + kstep, voffA); PG8_STAGE(PG8_SB(1, 1), cB + hstep + kstep, voffB);
        PG8_WAIT_V(6); PG8_BAR;
    } else {
        PG8_STAGE(PG8_SB(0, 0), cB, voffB); PG8_STAGE(PG8_SA(0, 0), cA, voffA); PG8_STAGE(PG8_SB(0, 1), cB + hstep, voffB); PG8_STAGE(PG8_SA(0, 1), cA + hstep, voffA);
        if (wr == 1) PG8_BAR;
        PG8_WAIT_V(4); PG8_BAR;
        PG8_STAGE(PG8_SB(1, 0), cB + kstep, voffB); PG8_STAGE(PG8_SA(1, 0), cA + kstep, voffA); PG8_STAGE(PG8_SB(1, 1), cB + hstep + kstep, voffB);
        PG8_WAIT_V(6); PG8_BAR;
    }
    for (;;) {
        const bool has_next = S.next(ui + 1, nxt);
        const char* nA = has_next ? (const char*)g.A + (size_t)nxt.pm * tstep : cA; const char* nB = has_next ? (const char*)g.Bt + (size_t)nxt.pn * tstep : cB;
        for (int t = 0; t < nt; t += 2) {
            const bool last = (t == nt - 2);
            const char* a1 = cA + (size_t)(t + 1) * kstep;
            const char* a2 = last ? nA : cA + (size_t)(t + 2) * kstep; const char* b2 = last ? nB : cB + (size_t)(t + 2) * kstep;
            const char* a3 = a2 + kstep; const char* b3 = b2 + kstep;
            if (last && has_next) S.a_ready(nxt);
            if constexpr (SP2) {
            PG8_LDB(B0, 0, 0); PG8_LDB(B1, 0, 1); PG8_SCHED; PG8_LDA(At, 0, 0); PG8_STAGE(PG8_SA(1, 1), a1 + hstep, voffA);
            PG8_WAIT_V(8); PG8_WAIT_L(0); PG8_BAR; PG8_MMA(0, 0, At, B0); PG8_MMA(0, 1, At, B1); PG8_BAR; PG8_SCHED;
            PG8_LDA(At, 0, 1); PG8_STAGE(PG8_SB(0, 0), b2, voffB); PG8_STAGE(PG8_SB(0, 1), b2 + hstep, voffB); PG8_STAGE(PG8_SA(0, 0), a2, voffA);
            PG8_WAIT_V(8); PG8_WAIT_L(0); PG8_BAR; PG8_MMA(1, 0, At, B0); PG8_MMA(1, 1, At, B1); PG8_BAR; PG8_SCHED;
            PG8_LDB(B0, 1, 0); PG8_LDB(B1, 1, 1); PG8_SCHED; PG8_LDA(At, 1, 0); PG8_STAGE(PG8_SA(0, 1), a2 + hstep, voffA);
            PG8_WAIT_V(8); PG8_WAIT_L(0); PG8_BAR; PG8_MMA(0, 0, At, B0); PG8_MMA(0, 1, At, B1); PG8_BAR; PG8_SCHED;
            PG8_LDA(At, 1, 1); PG8_STAGE(PG8_SB(1, 0), b3, voffB); PG8_STAGE(PG8_SB(1, 1), b3 + hstep, voffB); PG8_STAGE(PG8_SA(1, 0), a3, voffA);
            PG8_WAIT_V(8); PG8_WAIT_L(0); PG8_BAR; PG8_MMA(1, 0, At, B0); PG8_MMA(1, 1, At, B1); PG8_BAR; PG8_SCHED;
            } else {
            PG8_LDB(B0, 0, 0); PG8_SCHED; PG8_LDA(At, 0, 0); PG8_STAGE(PG8_SA(1, 1), a1 + hstep, voffA);
            PG8_WAIT_L(8); PG8_BAR; PG8_WAIT_L(0); PG8_MMA(0, 0, At, B0); PG8_BAR; PG8_SCHED;
            PG8_LDB(B1, 0, 1); PG8_STAGE(PG8_SB(0, 0), b2, voffB);
            PG8_BAR; PG8_WAIT_L(0); PG8_MMA(0, 1, At, B1); PG8_BAR;
            PG8_LDA(At, 0, 1); PG8_STAGE(PG8_SA(0, 0), a2, voffA);
            PG8_BAR; PG8_WAIT_L(0); PG8_MMA(1, 0, At, B0); PG8_BAR; PG8_SCHED;
            PG8_STAGE(PG8_SB(0, 1), b2 + hstep, voffB);
            PG8_WAIT_V(6); PG8_BAR; PG8_MMA(1, 1, At, B1); PG8_BAR;
            PG8_LDB(B0, 1, 0); PG8_SCHED; PG8_LDA(At, 1, 0); PG8_STAGE(PG8_SA(0, 1), a2 + hstep, voffA);
            PG8_WAIT_L(8); PG8_BAR; PG8_WAIT_L(0); PG8_MMA(0, 0, At, B0); PG8_BAR; PG8_SCHED;
            PG8_LDB(B1, 1, 1); PG8_STAGE(PG8_SB(1, 0), b3, voffB);
            PG8_BAR; PG8_WAIT_L(0); PG8_MMA(0, 1, At, B1); PG8_BAR;
            PG8_LDA(At, 1, 1); PG8_STAGE(PG8_SA(1, 0), a3, voffA);
            PG8_BAR; PG8_WAIT_L(0); PG8_MMA(1, 0, At, B0); PG8_BAR; PG8_SCHED;
            PG8_STAGE(PG8_SB(1, 1), b3 + hstep, voffB);
            PG8_WAIT_V(6); PG8_BAR; PG8_MMA(1, 1, At, B1); PG8_BAR;
            }
        }
        if constexpr (ALIGN_EPI) { if (wr == 0) PG8_BAR; }
        if constexpr (!Epi::AFTER_DRAIN) { E(acc, cur, wr, wc, fr, fq); S.done(cur); }
        if (!has_next) break;
#pragma unroll
        for (int a = 0; a < 2; ++a)
#pragma unroll
            for (int b = 0; b < 2; ++b)
#pragma unroll
                for (int m = 0; m < 4; ++m)
#pragma unroll
                    for (int n = 0; n < 2; ++n) acc[a][b][m][n] = (f32x4){0.f, 0.f, 0.f, 0.f};
        cur = nxt; cA = nA; cB = nB; ++ui;
        if constexpr (ALIGN_EPI) { if (wr == 1) PG8_BAR; }
    }
    PG8_WAIT_V(0);
    if constexpr (!ALIGN_EPI) { if (wr == 0) PG8_BAR; }
    PG8_BAR;
    if constexpr (Epi::AFTER_DRAIN) { E.fused(acc, cur, wr, wc, fr, fq, lds, wid, lane); S.done(cur); }
#undef PG8_SA
#undef PG8_SB
#undef PG8_STAGE
#undef PG8_LDA
#undef PG8_LDB
#undef PG8_MMA
#undef PG8_WAIT_V
#undef PG8_WAIT_L
#undef PG8_BAR
#undef PG8_SCHED
}
}
namespace pg8 {
struct EpiStoreBf16 {
    static constexpr bool PERM = true, AFTER_DRAIN = false;
    bf16_t* O; int ldc; const float* bias; int m_real, n_real;
    __device__ __forceinline__ void operator()(const f32x4 (&acc)[2][2][4][2], const Unit& u, int wr, int wc, int fr, int fq) const {
        const int row0 = u.pm * BM + wr * 64 + fr, col0 = u.pn * BM + wc * 32 + 8 * fq;
#pragma unroll
        for (int bj = 0; bj < 2; ++bj) {
            const int col = col0 + bj * HALF;
            if (col >= n_real) continue;
            f32x4 b0 = (f32x4){0.f, 0.f, 0.f, 0.f}, b1 = b0;
            if (bias) { b0 = *(const f32x4*)(bias + col); b1 = *(const f32x4*)(bias + col + 4); }
#pragma unroll
            for (int ai = 0; ai < 2; ++ai)
#pragma unroll
                for (int m = 0; m < 4; ++m) {
                    const int row = row0 + ai * HALF + m * 16;
                    if (row >= m_real) continue;
                    const f32x4 v0 = acc[ai][bj][m][0] + b0, v1 = acc[ai][bj][m][1] + b1;
                    u32x4 w; w.x = cvt_pk_bf16(v0[0], v0[1]); w.y = cvt_pk_bf16(v0[2], v0[3]); w.z = cvt_pk_bf16(v1[0], v1[1]); w.w = cvt_pk_bf16(v1[2], v1[3]);
                    *(u32x4*)(O + (size_t)row * ldc + col) = w;
                }
        }
    }
};
struct EpiStoreF32 {
    static constexpr bool PERM = false, AFTER_DRAIN = false;
    float* O; int ldc; const float* bias; int m_real, n_real;
    __device__ __forceinline__ void operator()(const f32x4 (&acc)[2][2][4][2], const Unit& u, int wr, int wc, int fr, int fq) const {
        const int row0 = u.pm * BM + wr * 64 + fr, col0 = u.pn * BM + wc * 32 + 4 * fq;
#pragma unroll
        for (int bj = 0; bj < 2; ++bj)
#pragma unroll
            for (int n = 0; n < 2; ++n) {
                const int col = col0 + bj * HALF + n * 16;
                if (col >= n_real) continue;
                const f32x4 bv = bias ? *(const f32x4*)(bias + col) : (f32x4){0.f, 0.f, 0.f, 0.f};
#pragma unroll
                for (int ai = 0; ai < 2; ++ai)
#pragma unroll
                    for (int m = 0; m < 4; ++m) {
                        const int row = row0 + ai * HALF + m * 16;
                        if (row >= m_real) continue;
                        *(f32x4*)(O + (size_t)row * ldc + col) = acc[ai][bj][m][n] + bv;
                    }
            }
    }
};
}
namespace {
#define GAS __attribute__((address_space(1)))
#define LAS __attribute__((address_space(3)))
typedef unsigned short bf16;
typedef float f32x4 __attribute__((ext_vector_type(4)));
typedef unsigned v4u __attribute__((ext_vector_type(4)));
typedef unsigned v2u __attribute__((ext_vector_type(2)));

constexpr int D = 1024, NB = 4, SEQ = 4096, NP = NB * SEQ, NS = 128, NT = NP + NS, MP = 16640;
constexpr int ABN = 3080, ABNP = 3328;
constexpr int C_QKV = 0, C_Z = 1536, C_A = 2048, C_B = 2052, C_XR = 2056, C_GATE = 2568;
constexpr int CN = 1536;
constexpr float ALPHA = 1.4142135623730951f;
constexpr float LN_EPS = 1e-5f;
constexpr int NTH = 512, NWAVES = 8;
constexpr int RING_BYTES = 143360, MISC_OFF = RING_BYTES + 320, LDS_BYTES = 147456;

__device__ __forceinline__ float bf2f(bf16 v) { return __uint_as_float((unsigned)v << 16); }
__device__ __forceinline__ unsigned f2bf(float f) { unsigned u = __float_as_uint(f); return (u + 0x7fffu + ((u >> 16) & 1u)) >> 16; }
__device__ __forceinline__ unsigned pk2(float lo, float hi) { return f2bf(lo) | (f2bf(hi) << 16); }
__device__ __forceinline__ float sigmoidf_(float x) { return 1.0f / (1.0f + expf(-x)); }
__device__ __forceinline__ float softplusf_(float x) { return fmaxf(x, 0.f) + log1pf(expf(-fabsf(x))); }
__device__ __forceinline__ float siluf_(float x) { return x / (1.0f + expf(-x)); }
__device__ __forceinline__ float geluf_(float x) { return 0.5f * x * (1.0f + tanhf(0.7978845608028654f * (x + 0.044715f * x * x * x))); }
#define DPPF(v_, ctrl_, rmask_) __int_as_float(__builtin_amdgcn_update_dpp(0, __float_as_int(v_), (ctrl_), (rmask_), 0xf, false))
__device__ __forceinline__ float wave_sum(float v) {
    v += DPPF(v, 0xB1, 0xf); v += DPPF(v, 0x4E, 0xf); v += DPPF(v, 0x141, 0xf); v += DPPF(v, 0x140, 0xf);
    v += DPPF(v, 0x142, 0xa); v += DPPF(v, 0x143, 0xc);
    return __int_as_float(__builtin_amdgcn_readlane(__float_as_int(v), 63));
}
__device__ __forceinline__ float wave_max(float v) {
    v = fmaxf(v, DPPF(v, 0xB1, 0xf)); v = fmaxf(v, DPPF(v, 0x4E, 0xf)); v = fmaxf(v, DPPF(v, 0x141, 0xf)); v = fmaxf(v, DPPF(v, 0x140, 0xf));
    { const float t = __int_as_float(__builtin_amdgcn_update_dpp(__float_as_int(v), __float_as_int(v), 0x142, 0xa, 0xf, false)); v = fmaxf(v, t); }
    { const float t = __int_as_float(__builtin_amdgcn_update_dpp(__float_as_int(v), __float_as_int(v), 0x143, 0xc, 0xf, false)); v = fmaxf(v, t); }
    return __int_as_float(__builtin_amdgcn_readlane(__float_as_int(v), 63));
}

__device__ __forceinline__ void p0_transpose_item(const float* __restrict__ W, int K, int N, bf16* __restrict__ WT, float* scr, int item, int lane) {
    const int nblk = (N + 31) / 32, kb = item / nblk, nb = item % nblk, k0 = 64 * kb, n0 = 32 * nb;
#pragma unroll 8
    for (int i = 0; i < 32; ++i) { const int kk = 2 * i + (lane >> 5), n = n0 + (lane & 31); scr[kk * 33 + (lane & 31)] = n < N ? W[(size_t)(k0 + kk) * N + n] : 0.f; }
    asm volatile("s_waitcnt lgkmcnt(0)" ::: "memory");
    const int c = lane & 7;
#pragma unroll
    for (int j = 0; j < 4; ++j) { const int n = (lane >> 3) + 8 * j; const float* s = scr + (8 * c) * 33 + n;
        v4u o; o.x = pk2(s[0 * 33], s[1 * 33]); o.y = pk2(s[2 * 33], s[3 * 33]); o.z = pk2(s[4 * 33], s[5 * 33]); o.w = pk2(s[6 * 33], s[7 * 33]);
        *(v4u*)(WT + (size_t)(n0 + n) * K + k0 + 8 * c) = o; }
    asm volatile("s_waitcnt lgkmcnt(0)" ::: "memory");
}
__device__ __forceinline__ void row_to_bf16(const float* __restrict__ xrow, bf16* __restrict__ orow, int lane) {
#pragma unroll
    for (int j = 0; j < 4; ++j) {
        f32x4 v = (f32x4){0.f, 0.f, 0.f, 0.f};
        if (xrow) v = ((const f32x4*)xrow)[lane + 64 * j];
        v2u o; o.x = pk2(v.x, v.y); o.y = pk2(v.z, v.w);
        ((v2u*)orow)[lane + 64 * j] = o;
    }
}

struct AbPrepArgs {
    const bf16* PROJ; const float* st_gdn_conv; const float* st_lru_conv;
    const float* gdn_conv_w; const float* a_log; const float* dt_bias;
    const float* lru_conv_w; const float* lru_conv_b; const float* w_r; const float* b_r; const float* w_i; const float* b_i; const float* lam;
    float* QKV; float* G; float* BETA; float* LA; float* LB;
    float* p_gdn_conv; float* p_lru_conv; float* s_gdn_conv; float* s_lru_conv;
};
__device__ __forceinline__ void ab_prep(const AbPrepArgs& a, int t, float* smem) {
    int tid = threadIdx.x; asm volatile("" : "+v"(tid));
    const int lane = tid & 63, wid = tid >> 6;
    const bool samp = t >= NP; const int sb = t - NP, pos = t % SEQ, b = t / SEQ;
    float* sq = smem;
    float* sx = smem + 1536;
    float* scl = smem + 2048;
    const bf16* prow = a.PROJ + (size_t)t * ABN;
    for (int c = tid; c < 1536; c += NTH) {
        float acc = 0.f;
#pragma unroll
        for (int i = 0; i < 4; ++i) {
            float xv;
            if (i == 3) xv = bf2f(prow[C_QKV + c]);
            else if (samp) xv = a.st_gdn_conv[((size_t)sb * 3 + i) * 1536 + c];
            else xv = (pos - 3 + i >= 0) ? bf2f(a.PROJ[(size_t)(t - 3 + i) * ABN + C_QKV + c]) : 0.f;
            acc += a.gdn_conv_w[i * 1536 + c] * xv;
        }
        sq[c] = siluf_(acc);
    }
    {
        const int c = tid;
        float acc = a.lru_conv_b[c];
#pragma unroll
        for (int i = 0; i < 4; ++i) {
            float xv;
            if (i == 3) xv = bf2f(prow[C_XR + c]);
            else if (samp) xv = a.st_lru_conv[((size_t)sb * 3 + i) * 512 + c];
            else xv = (pos - 3 + i >= 0) ? bf2f(a.PROJ[(size_t)(t - 3 + i) * ABN + C_XR + c]) : 0.f;
            acc += a.lru_conv_w[i * 512 + c] * xv;
        }
        sx[c] = acc;
    }
    __syncthreads();
    {
        const int grp = wid;
        const float v0 = sq[grp * 128 + lane], v1 = sq[grp * 128 + 64 + lane];
        const float s = wave_sum(v0 * v0 + v1 * v1);
        if (lane == 0) scl[grp] = rsqrtf(s + 1e-6f) * (grp < 4 ? 0.08838834764831845f : 1.0f);
    }
    __syncthreads();
    for (int c = tid; c < 1536; c += NTH) a.QKV[(size_t)t * 1536 + c] = (c < 1024) ? sq[c] * scl[c >> 7] : sq[c];
    if (tid < 4) {
        const float a_raw = bf2f(prow[C_A + tid]), b_raw = bf2f(prow[C_B + tid]);
        a.G[(size_t)t * 4 + tid] = -expf(a.a_log[tid]) * softplusf_(a_raw + a.dt_bias[tid]);
        a.BETA[(size_t)t * 4 + tid] = sigmoidf_(b_raw);
    }
    if (!samp) {
        if (pos >= SEQ - 3) {
            const int row = pos - (SEQ - 3);
            for (int c = tid; c < 1536; c += NTH) a.p_gdn_conv[((size_t)b * 3 + row) * 1536 + c] = bf2f(prow[C_QKV + c]);
            a.p_lru_conv[((size_t)b * 3 + row) * 512 + tid] = bf2f(prow[C_XR + tid]);
        }
    } else {
        for (int c = tid; c < 1536; c += NTH) {
            a.s_gdn_conv[((size_t)sb * 3 + 0) * 1536 + c] = a.st_gdn_conv[((size_t)sb * 3 + 1) * 1536 + c];
            a.s_gdn_conv[((size_t)sb * 3 + 1) * 1536 + c] = a.st_gdn_conv[((size_t)sb * 3 + 2) * 1536 + c];
            a.s_gdn_conv[((size_t)sb * 3 + 2) * 1536 + c] = bf2f(prow[C_QKV + c]);
        }
        {
            const int c = tid;
            a.s_lru_conv[((size_t)sb * 3 + 0) * 512 + c] = a.st_lru_conv[((size_t)sb * 3 + 1) * 512 + c];
            a.s_lru_conv[((size_t)sb * 3 + 1) * 512 + c] = a.st_lru_conv[((size_t)sb * 3 + 2) * 512 + c];
            a.s_lru_conv[((size_t)sb * 3 + 2) * 512 + c] = bf2f(prow[C_XR + c]);
        }
    }
    {
        const int c = tid, n = c >> 6, d = c & 63;
        float r = a.b_r[c], ii = a.b_i[c];
#pragma unroll 4
        for (int cc = 0; cc < 64; ++cc) {
            const float xv = sx[n * 64 + cc];
            r += xv * a.w_r[((size_t)n * 64 + cc) * 64 + d];
            ii += xv * a.w_i[((size_t)n * 64 + cc) * 64 + d];
        }
        r = sigmoidf_(r); ii = sigmoidf_(ii);
        const float log_a = -8.0f * r * softplusf_(-a.lam[c]);
        a.LA[(size_t)t * 512 + c] = expf(log_a);
        a.LB[(size_t)t * 512 + c] = sqrtf(-expm1f(2.0f * log_a)) * (ii * sx[c]);
    }
}

__device__ __forceinline__ void gdn_scan(const float* __restrict__ QKV, const float* __restrict__ G, const float* __restrict__ BETA,
                                         const float* __restrict__ S0, float* __restrict__ O, float* __restrict__ Sout, int tok_base, int T,
                                         int sl, int h, int sq, float* smem) {
    int tid = threadIdx.x; asm volatile("" : "+v"(tid));
    const int dvl = tid & 31, kg = tid >> 5;
    const int dv = sl * 32 + dvl;
    float (*red1)[32] = (float (*)[32])smem;
    float (*red2)[32] = (float (*)[32])(smem + 512);
    float S[8];
#pragma unroll
    for (int i = 0; i < 8; ++i) S[i] = S0 ? S0[(((size_t)sq * 4 + h) * 128 + kg * 8 + i) * 128 + dv] : 0.f;
    float kk[8], qq[8], vv, g, be;
    {
        const size_t tok = (size_t)tok_base + (size_t)sq * T;
        const float* row = QKV + tok * 1536;
#pragma unroll
        for (int i = 0; i < 8; ++i) { kk[i] = row[512 + h * 128 + kg * 8 + i]; qq[i] = row[h * 128 + kg * 8 + i]; }
        vv = row[1024 + h * 128 + dv]; g = G[tok * 4 + h]; be = BETA[tok * 4 + h];
    }
    for (int t = 0; t < T; ++t) {
        const size_t tok = (size_t)tok_base + (size_t)sq * T + t;
        float nk[8], nq[8], nv = 0.f, ng = 0.f, nb = 0.f;
        if (t + 1 < T) {
            const float* row = QKV + (tok + 1) * 1536;
#pragma unroll
            for (int i = 0; i < 8; ++i) { nk[i] = row[512 + h * 128 + kg * 8 + i]; nq[i] = row[h * 128 + kg * 8 + i]; }
            nv = row[1024 + h * 128 + dv]; ng = G[(tok + 1) * 4 + h]; nb = BETA[(tok + 1) * 4 + h];
        } else {
#pragma unroll
            for (int i = 0; i < 8; ++i) { nk[i] = 0.f; nq[i] = 0.f; }
        }
        const float al = expf(g);
        float p = 0.f;
#pragma unroll
        for (int i = 0; i < 8; ++i) { S[i] *= al; p += S[i] * kk[i]; }
        red1[kg][dvl] = p;
        __syncthreads();
        float ks = 0.f;
#pragma unroll
        for (int j = 0; j < 16; ++j) ks += red1[j][dvl];
        const float vn = be * (vv - ks);
        float o = 0.f;
#pragma unroll
        for (int i = 0; i < 8; ++i) { S[i] += kk[i] * vn; o += S[i] * qq[i]; }
        red2[kg][dvl] = o;
        __syncthreads();
        if (kg == 0) {
            float os = 0.f;
#pragma unroll
            for (int j = 0; j < 16; ++j) os += red2[j][dvl];
            O[tok * 512 + h * 128 + dv] = os;
        }
#pragma unroll
        for (int i = 0; i < 8; ++i) { kk[i] = nk[i]; qq[i] = nq[i]; }
        vv = nv; g = ng; be = nb;
    }
#pragma unroll
    for (int i = 0; i < 8; ++i) Sout[(((size_t)sq * 4 + h) * 128 + kg * 8 + i) * 128 + dv] = S[i];
}

__device__ __forceinline__ void lru_scan(const float* __restrict__ LA, float* __restrict__ LB, const float* __restrict__ h0,
                                         float* __restrict__ hlast, int tok_base, int T, int nseq, int bx) {
    int tx_ = threadIdx.x; asm volatile("" : "+v"(tx_));
    const int idx = bx * NTH + tx_;
    if (idx >= nseq * 512) return;
    const int sq = idx / 512, c = idx % 512;
    float h = h0 ? h0[(size_t)sq * 512 + c] : 0.f;
    const size_t base = ((size_t)tok_base + (size_t)sq * T) * 512 + c;
#pragma unroll 8
    for (int t = 0; t < T; ++t) {
        const size_t o = base + (size_t)t * 512;
        h = LA[o] * h + LB[o];
        LB[o] = h;
    }
    hlast[(size_t)sq * 512 + c] = h;
}

__device__ __forceinline__ void ab_mix(const bf16* __restrict__ PROJ, const float* __restrict__ O, const float* __restrict__ H, const float* __restrict__ P, const float* __restrict__ CIN,
                                       const float* __restrict__ norm_w, bf16* __restrict__ MIX, int vb) {
    int tx_ = threadIdx.x; asm volatile("" : "+v"(tx_));
    const int tid = tx_ & 255, lane = tid & 63, wid = tid >> 6, t = vb * 2 + (tx_ >> 8);
    const bf16* prow = PROJ + (size_t)t * ABN;
    {
        const int h = wid;
        const float o0 = O[(size_t)t * 512 + h * 128 + lane], o1 = O[(size_t)t * 512 + h * 128 + 64 + lane];
        const float ms = wave_sum(o0 * o0 + o1 * o1) * (1.0f / 128.0f);
        const float sc = rsqrtf(ms + 1e-6f);
        MIX[(size_t)t * 1024 + h * 128 + lane] = (bf16)f2bf(o0 * sc * norm_w[lane] * siluf_(bf2f(prow[C_Z + h * 128 + lane])));
        MIX[(size_t)t * 1024 + h * 128 + 64 + lane] = (bf16)f2bf(o1 * sc * norm_w[64 + lane] * siluf_(bf2f(prow[C_Z + h * 128 + 64 + lane])));
    }
    for (int c = tid; c < 512; c += 256) {
        float hv = H[(size_t)t * 512 + c];
        if (t < NP) hv += P[(size_t)t * 512 + c] * CIN[(size_t)(t >> 6) * 512 + c];
        MIX[(size_t)t * 1024 + 512 + c] = (bf16)f2bf(geluf_(bf2f(prow[C_GATE + c])) * hv);
    }
}

__device__ __forceinline__ void ln_res_w(const float* __restrict__ xrow, const float* __restrict__ yrow, const float* __restrict__ g, const float* __restrict__ bta,
                                         float* __restrict__ orow, bf16* __restrict__ obrow, int lane) {
    f32x4 v[4]; float s = 0.f;
#pragma unroll
    for (int j = 0; j < 4; ++j) { const f32x4 x4 = ((const f32x4*)xrow)[lane + 64 * j], y4 = ((const f32x4*)yrow)[lane + 64 * j]; v[j] = x4 * ALPHA + y4; s += (v[j].x + v[j].y) + (v[j].z + v[j].w); }
    const float mean = wave_sum(s) * (1.0f / 1024.0f); float q = 0.f;
#pragma unroll
    for (int j = 0; j < 4; ++j) { v[j] = v[j] - mean; q += (v[j].x * v[j].x + v[j].y * v[j].y) + (v[j].z * v[j].z + v[j].w * v[j].w); }
    const float rs = rsqrtf(wave_sum(q) * (1.0f / 1024.0f) + LN_EPS);
#pragma unroll
    for (int j = 0; j < 4; ++j) {
        const f32x4 g4 = ((const f32x4*)g)[lane + 64 * j], b4 = ((const f32x4*)bta)[lane + 64 * j];
        const f32x4 o = v[j] * rs * g4 + b4;
        ((f32x4*)orow)[lane + 64 * j] = o;
        v2u ob; ob.x = pk2(o.x, o.y); ob.y = pk2(o.z, o.w);
        ((v2u*)obrow)[lane + 64 * j] = ob;
    }
}

__device__ __forceinline__ void peer_topk(const bf16* __restrict__ Q, const float* __restrict__ keys, int* __restrict__ EXP, float* __restrict__ GATE,
                                          int tg, int h, float* smem) {
    const int tid = threadIdx.x, cn = tid & 255, c = cn >> 7, n = cn & 127, th = tid >> 8;
    float (*sq)[256] = (float (*)[256])smem;
    float (*ss)[257] = (float (*)[257])(smem + 32 * 256);
    float (*tvs)[2][16] = (float (*)[2][16])(smem + 32 * 256 + 32 * 257 + 32);
    int (*tis)[2][16] = (int (*)[2][16])(smem + 32 * 256 + 32 * 257 + 32 + 1024);
    for (int i = tid; i < 32 * 256; i += NTH) {
        const int tk = i >> 8, col = i & 255;
        sq[tk][col] = bf2f(Q[(size_t)(tg * 32 + tk) * 2048 + h * 256 + col]);
    }
    __syncthreads();
    float acc[16];
#pragma unroll
    for (int i = 0; i < 16; ++i) acc[i] = 0.f;
    const float* krow = keys + (((size_t)h * 2 + c) * 128 + n) * 128;
    for (int d4 = 0; d4 < 32; ++d4) {
        const float4 kv = *(const float4*)(krow + d4 * 4);
#pragma unroll
        for (int tk = 0; tk < 16; ++tk) {
            const float4 qv = *(const float4*)&sq[th * 16 + tk][c * 128 + d4 * 4];
            acc[tk] += qv.x * kv.x + qv.y * kv.y + qv.z * kv.z + qv.w * kv.w;
        }
    }
#pragma unroll
    for (int tk = 0; tk < 16; ++tk) ss[th * 16 + tk][cn] = acc[tk];
    __syncthreads();
    if (tid < 64) {
        const int tk = tid >> 1, cc = tid & 1;
        float tv[16]; int ti[16];
#pragma unroll
        for (int j = 0; j < 16; ++j) { tv[j] = -INFINITY; ti[j] = 0; }
        for (int nn = 0; nn < 128; ++nn) {
            float x = ss[tk][cc * 128 + nn]; int xi = nn;
#pragma unroll
            for (int j = 0; j < 16; ++j) {
                const bool gt = x > tv[j];
                const float tf = tv[j]; const int tj = ti[j];
                tv[j] = gt ? x : tf; ti[j] = gt ? xi : tj;
                x = gt ? tf : x; xi = gt ? tj : xi;
            }
        }
#pragma unroll
        for (int j = 0; j < 16; ++j) { tvs[tk][cc][j] = tv[j]; tis[tk][cc][j] = ti[j]; }
    }
    __syncthreads();
    if (tid < 32) {
        const int tk = tid;
        float bv[16]; int bi[16];
#pragma unroll
        for (int j = 0; j < 16; ++j) { bv[j] = -INFINITY; bi[j] = 0; }
        for (int i = 0; i < 16; ++i)
            for (int jj = 0; jj < 16; ++jj) {
                float x = tvs[tk][0][i] + tvs[tk][1][jj]; int xi = tis[tk][0][i] * 128 + tis[tk][1][jj];
#pragma unroll
                for (int j = 0; j < 16; ++j) {
                    const bool gt = x > bv[j];
                    const float tf = bv[j]; const int tj = bi[j];
                    bv[j] = gt ? x : tf; bi[j] = gt ? xi : tj;
                    x = gt ? tf : x; xi = gt ? tj : xi;
                }
            }
        float e[16], sum = 0.f;
#pragma unroll
        for (int j = 0; j < 16; ++j) { e[j] = expf(bv[j] - bv[0]); sum += e[j]; }
        const float inv = 1.0f / sum;
        const size_t o = (size_t)(tg * 32 + tk) * 128 + h * 16;
#pragma unroll
        for (int j = 0; j < 16; ++j) { EXP[o + j] = bi[j]; GATE[o + j] = e[j] * inv; }
    }
}

__device__ __forceinline__ void peer_expert(const float* __restrict__ X, const int* __restrict__ EXP, const float* __restrict__ GATE,
                                            const float* __restrict__ U, const float* __restrict__ V,
                                            const float* __restrict__ g, const float* __restrict__ bta, float* __restrict__ out, bf16* __restrict__ outb, int t, float* smem) {
    const int tid = threadIdx.x, lane = tid & 63, wid = tid >> 6;
    float (*accs)[1024] = (float (*)[1024])smem;
    float* sred = smem + 8192;
    const float4* xr = (const float4*)(X + (size_t)t * D);
    float4 xv[4];
#pragma unroll
    for (int j = 0; j < 4; ++j) xv[j] = xr[lane + 64 * j];
    float4 acc[4];
#pragma unroll
    for (int j = 0; j < 4; ++j) acc[j] = make_float4(0.f, 0.f, 0.f, 0.f);
    for (int e = 0; e < 16; ++e) {
        const int id = EXP[(size_t)t * 128 + wid * 16 + e];
        const float gt = GATE[(size_t)t * 128 + wid * 16 + e];
        const float4* ur = (const float4*)(U + (size_t)id * D);
        const float4* vr = (const float4*)(V + (size_t)id * D);
        float4 uv[4], vv[4];
#pragma unroll
        for (int j = 0; j < 4; ++j) { uv[j] = ur[lane + 64 * j]; vv[j] = vr[lane + 64 * j]; }
        float dot = 0.f;
#pragma unroll
        for (int j = 0; j < 4; ++j) dot += uv[j].x * xv[j].x + uv[j].y * xv[j].y + uv[j].z * xv[j].z + uv[j].w * xv[j].w;
        dot = wave_sum(dot);
        const float cf = gt * geluf_(dot);
#pragma unroll
        for (int j = 0; j < 4; ++j) { acc[j].x += cf * vv[j].x; acc[j].y += cf * vv[j].y; acc[j].z += cf * vv[j].z; acc[j].w += cf * vv[j].w; }
    }
#pragma unroll
    for (int j = 0; j < 4; ++j) *(float4*)&accs[wid][(lane + 64 * j) * 4] = acc[j];
    __syncthreads();
    float v[2];
#pragma unroll
    for (int i = 0; i < 2; ++i) {
        const int c = tid * 2 + i;
        float s = 0.f;
#pragma unroll
        for (int w = 0; w < 8; ++w) s += accs[w][c];
        v[i] = ALPHA * X[(size_t)t * D + c] + s;
    }
    float s = wave_sum(v[0] + v[1]);
    if (lane == 0) sred[wid] = s;
    __syncthreads();
    float mean = 0.f;
#pragma unroll
    for (int w = 0; w < 8; ++w) mean += sred[w];
    mean *= (1.0f / 1024.0f);
    __syncthreads();
    const float d0 = v[0] - mean, d1 = v[1] - mean;
    float q = wave_sum(d0 * d0 + d1 * d1);
    if (lane == 0) sred[wid] = q;
    __syncthreads();
    float var = 0.f;
#pragma unroll
    for (int w = 0; w < 8; ++w) var += sred[w];
    const float rs = rsqrtf(var * (1.0f / 1024.0f) + LN_EPS);
    const float o0 = d0 * rs * g[tid * 2] + bta[tid * 2], o1 = d1 * rs * g[tid * 2 + 1] + bta[tid * 2 + 1];
    *(float2*)(out + (size_t)t * D + tid * 2) = make_float2(o0, o1);
    if (outb) *(unsigned*)(outb + (size_t)t * D + tid * 2) = pk2(o0, o1);
}


typedef __bf16 bf16x2_t __attribute__((ext_vector_type(2)));
__device__ __forceinline__ float dot2bf(unsigned w, unsigned x, float acc) { return __builtin_amdgcn_fdot2_f32_bf16(__builtin_bit_cast(bf16x2_t, w), __builtin_bit_cast(bf16x2_t, x), acc, false); }
__device__ __forceinline__ float bflo(unsigned w) { return __uint_as_float(w << 16); }
__device__ __forceinline__ float bfhi(unsigned w) { return __uint_as_float(w & 0xffff0000u); }
typedef float f32x2_t __attribute__((ext_vector_type(2)));
__device__ __forceinline__ void row_to_fp8(const float* __restrict__ xrow, unsigned char* __restrict__ orow, float* __restrict__ scale, int lane) {
    f32x4 v[4]; float am = 0.f;
#pragma unroll
    for (int j = 0; j < 4; ++j) { v[j] = *(const f32x4*)(xrow + lane * 16 + j * 4); am = fmaxf(am, fmaxf(fmaxf(fabsf(v[j].x), fabsf(v[j].y)), fmaxf(fabsf(v[j].z), fabsf(v[j].w)))); }
    am = wave_max(am);
    const float s = am > 0.f ? am * (1.0f / 448.0f) : 1.0f, inv = 1.0f / s;
    v4u o;
    unsigned w;
    w = 0u; w = __builtin_amdgcn_cvt_pk_fp8_f32(v[0].x * inv, v[0].y * inv, w, false); w = __builtin_amdgcn_cvt_pk_fp8_f32(v[0].z * inv, v[0].w * inv, w, true); o.x = w;
    w = 0u; w = __builtin_amdgcn_cvt_pk_fp8_f32(v[1].x * inv, v[1].y * inv, w, false); w = __builtin_amdgcn_cvt_pk_fp8_f32(v[1].z * inv, v[1].w * inv, w, true); o.y = w;
    w = 0u; w = __builtin_amdgcn_cvt_pk_fp8_f32(v[2].x * inv, v[2].y * inv, w, false); w = __builtin_amdgcn_cvt_pk_fp8_f32(v[2].z * inv, v[2].w * inv, w, true); o.z = w;
    w = 0u; w = __builtin_amdgcn_cvt_pk_fp8_f32(v[3].x * inv, v[3].y * inv, w, false); w = __builtin_amdgcn_cvt_pk_fp8_f32(v[3].z * inv, v[3].w * inv, w, true); o.w = w;
    *(v4u*)(orow + lane * 16) = o;
    if (lane == 0) *scale = s;
}
#define PE_LOAD(UB, VB, grp) do { _Pragma("unroll") for (int i_ = 0; i_ < 4; ++i_) { const int e_ = (grp) * 4 + i_; \
        const int id_ = __builtin_amdgcn_readlane(e_ < 64 ? id0 : id1, e_ & 63); \
        const unsigned so_ = (unsigned)id_ * 1024u; \
        UB[i_] = __builtin_amdgcn_raw_buffer_load_b128(ursrc, voff, so_, 0); VB[i_] = __builtin_amdgcn_raw_buffer_load_b128(vrsrc, voff, so_, 0); } } while (0)
#define PE_DOT4(w, k) do { const f32x2_t l_ = __builtin_amdgcn_cvt_pk_f32_fp8((w), false), h_ = __builtin_amdgcn_cvt_pk_f32_fp8((w), true); \
        a_ += l_.x * xv[(k) * 4 + 0]; b_ += l_.y * xv[(k) * 4 + 1]; a_ += h_.x * xv[(k) * 4 + 2]; b_ += h_.y * xv[(k) * 4 + 3]; } while (0)
#define PE_AXPY4(w, k) do { const f32x2_t l_ = __builtin_amdgcn_cvt_pk_f32_fp8((w), false), h_ = __builtin_amdgcn_cvt_pk_f32_fp8((w), true); \
        acc[(k) * 4 + 0] += cf_ * l_.x; acc[(k) * 4 + 1] += cf_ * l_.y; acc[(k) * 4 + 2] += cf_ * h_.x; acc[(k) * 4 + 3] += cf_ * h_.y; } while (0)
#define PE_COMP(UB, VB, grp) do { float d_[4]; \
        _Pragma("unroll") for (int i_ = 0; i_ < 4; ++i_) { float a_ = 0.f, b_ = 0.f; PE_DOT4(UB[i_].x, 0); PE_DOT4(UB[i_].y, 1); PE_DOT4(UB[i_].z, 2); PE_DOT4(UB[i_].w, 3); d_[i_] = a_ + b_; } \
          \
        float s0_ = hi32 ? d_[2] : d_[0], t0_ = hi32 ? d_[0] : d_[2]; s0_ += __shfl_xor(t0_, 32); \
        float s1_ = hi32 ? d_[3] : d_[1], t1_ = hi32 ? d_[1] : d_[3]; s1_ += __shfl_xor(t1_, 32); \
        float r_ = hi16 ? s1_ : s0_, t2_ = hi16 ? s0_ : s1_; r_ += __shfl_xor(t2_, 16); \
        r_ += __shfl_xor(r_, 8); r_ += __shfl_xor(r_, 4); r_ += __shfl_xor(r_, 2); r_ += __shfl_xor(r_, 1); \
          \
        const int esel_ = (grp) * 4 + (lane >> 4); \
        const float su_ = __shfl(esel_ < 64 ? su0 : su1, esel_ & 63), gv_ = __shfl(esel_ < 64 ? gs0 : gs1, esel_ & 63); \
        const float cfl_ = geluf_(r_ * su_) * gv_; \
        _Pragma("unroll") for (int i_ = 0; i_ < 4; ++i_) { \
            const float cf_ = __uint_as_float(__builtin_amdgcn_readlane(__float_as_uint(cfl_), 16 * i_)); \
            PE_AXPY4(VB[i_].x, 0); PE_AXPY4(VB[i_].y, 1); PE_AXPY4(VB[i_].z, 2); PE_AXPY4(VB[i_].w, 3); } } while (0)
__device__ __forceinline__ void peer_expert_w(const float* __restrict__ xrow, const int* __restrict__ exr, const float* __restrict__ gar,
                                              const unsigned char* __restrict__ U, const unsigned char* __restrict__ V, const float* __restrict__ SU, const float* __restrict__ SV,
                                              const float* __restrict__ g, const float* __restrict__ bta, float* __restrict__ orow, bf16* __restrict__ obrow, int lane) {
    const bool hi32 = (lane & 32) != 0, hi16 = (lane & 16) != 0;
    const __amdgpu_buffer_rsrc_t ursrc = __builtin_amdgcn_make_buffer_rsrc((void*)U, 0, 16384 * 1024, 0x00020000);
    const __amdgpu_buffer_rsrc_t vrsrc = __builtin_amdgcn_make_buffer_rsrc((void*)V, 0, 16384 * 1024, 0x00020000);
    const int voff = lane * 16;
    float xv[16];
#pragma unroll
    for (int j = 0; j < 4; ++j) { const f32x4 t = *(const f32x4*)(xrow + lane * 16 + j * 4); xv[j * 4 + 0] = t.x; xv[j * 4 + 1] = t.y; xv[j * 4 + 2] = t.z; xv[j * 4 + 3] = t.w; }
    const int id0 = exr[lane], id1 = exr[64 + lane];
    const float su0 = SU[id0], su1 = SU[id1];
    const float gs0 = gar[lane] * SV[id0], gs1 = gar[64 + lane] * SV[id1];
    float acc[16];
#pragma unroll
    for (int i = 0; i < 16; ++i) acc[i] = 0.f;
    v4u ua[4], va[4], ub[4], vb[4];
    PE_LOAD(ua, va, 0);
#pragma unroll 1
    for (int grp = 0; grp < 32; grp += 2) {
        PE_LOAD(ub, vb, grp + 1);
        PE_COMP(ua, va, grp);
        if (grp + 2 < 32) PE_LOAD(ua, va, grp + 2);
        PE_COMP(ub, vb, grp + 1);
    }
    float v[16]; float s = 0.f;
#pragma unroll
    for (int i = 0; i < 16; ++i) { v[i] = ALPHA * xv[i] + acc[i]; s += v[i]; }
    const float mean = wave_sum(s) * (1.0f / 1024.0f); float q = 0.f;
#pragma unroll
    for (int i = 0; i < 16; ++i) { v[i] -= mean; q += v[i] * v[i]; }
    const float rs = rsqrtf(wave_sum(q) * (1.0f / 1024.0f) + LN_EPS);
    float o[16];
#pragma unroll
    for (int j = 0; j < 4; ++j) {
        const f32x4 g4 = *(const f32x4*)(g + lane * 16 + j * 4), b4 = *(const f32x4*)(bta + lane * 16 + j * 4);
        o[j * 4 + 0] = v[j * 4 + 0] * rs * g4.x + b4.x; o[j * 4 + 1] = v[j * 4 + 1] * rs * g4.y + b4.y; o[j * 4 + 2] = v[j * 4 + 2] * rs * g4.z + b4.z; o[j * 4 + 3] = v[j * 4 + 3] * rs * g4.w + b4.w;
        *(f32x4*)(orow + lane * 16 + j * 4) = (f32x4){o[j * 4 + 0], o[j * 4 + 1], o[j * 4 + 2], o[j * 4 + 3]};
    }
    if (obrow) {
        v4u w0, w1; w0.x = pk2(o[0], o[1]); w0.y = pk2(o[2], o[3]); w0.z = pk2(o[4], o[5]); w0.w = pk2(o[6], o[7]); w1.x = pk2(o[8], o[9]); w1.y = pk2(o[10], o[11]); w1.z = pk2(o[12], o[13]); w1.w = pk2(o[14], o[15]);
        *(v4u*)(obrow + lane * 16) = w0; *(v4u*)(obrow + lane * 16 + 8) = w1;
    }
}


__device__ __forceinline__ void peer_expert_blk(const float* __restrict__ xrow, const int* __restrict__ exr, const float* __restrict__ gar,
                                                const unsigned char* __restrict__ U, const unsigned char* __restrict__ V, const float* __restrict__ SU, const float* __restrict__ SV,
                                                const float* __restrict__ g, const float* __restrict__ bta, float* __restrict__ orow, bf16* __restrict__ obrow, int lane, int wave, float* smem) {
    const bool hi32 = (lane & 32) != 0, hi16 = (lane & 16) != 0;
    const __amdgpu_buffer_rsrc_t ursrc = __builtin_amdgcn_make_buffer_rsrc((void*)U, 0, 16384 * 1024, 0x00020000);
    const __amdgpu_buffer_rsrc_t vrsrc = __builtin_amdgcn_make_buffer_rsrc((void*)V, 0, 16384 * 1024, 0x00020000);
    const int voff = lane * 16;
    float xv[16];
#pragma unroll
    for (int j = 0; j < 4; ++j) { const f32x4 t = *(const f32x4*)(xrow + lane * 16 + j * 4); xv[j * 4 + 0] = t.x; xv[j * 4 + 1] = t.y; xv[j * 4 + 2] = t.z; xv[j * 4 + 3] = t.w; }
    const int id0 = exr[lane], id1 = exr[64 + lane];
    const float su0 = SU[id0], su1 = SU[id1];
    const float gs0 = gar[lane] * SV[id0], gs1 = gar[64 + lane] * SV[id1];
    float acc[16];
#pragma unroll
    for (int i = 0; i < 16; ++i) acc[i] = 0.f;
    v4u ua[4], va[4], ub[4], vb[4];
    const int g0 = wave * 4;
    PE_LOAD(ua, va, g0); PE_LOAD(ub, vb, g0 + 1);
    PE_COMP(ua, va, g0); PE_LOAD(ua, va, g0 + 2);
    PE_COMP(ub, vb, g0 + 1); PE_LOAD(ub, vb, g0 + 3);
    PE_COMP(ua, va, g0 + 2);
    PE_COMP(ub, vb, g0 + 3);
    float* accs = smem;
    float* sred = smem + 8192;
#pragma unroll
    for (int j = 0; j < 4; ++j) *(f32x4*)(accs + wave * 1024 + lane * 16 + j * 4) = (f32x4){acc[j * 4 + 0], acc[j * 4 + 1], acc[j * 4 + 2], acc[j * 4 + 3]};
    __syncthreads();
    const int tid = wave * 64 + lane;
    float v0 = ALPHA * xrow[tid * 2], v1 = ALPHA * xrow[tid * 2 + 1];
#pragma unroll
    for (int w = 0; w < 8; ++w) { v0 += accs[w * 1024 + tid * 2]; v1 += accs[w * 1024 + tid * 2 + 1]; }
    const float s = wave_sum(v0 + v1);
    if (lane == 0) sred[wave] = s;
    __syncthreads();
    float mean = 0.f;
#pragma unroll
    for (int w = 0; w < 8; ++w) mean += sred[w];
    mean *= (1.0f / 1024.0f);
    __syncthreads();
    const float d0 = v0 - mean, d1 = v1 - mean;
    const float q = wave_sum(d0 * d0 + d1 * d1);
    if (lane == 0) sred[wave] = q;
    __syncthreads();
    float var = 0.f;
#pragma unroll
    for (int w = 0; w < 8; ++w) var += sred[w];
    const float rs = rsqrtf(var * (1.0f / 1024.0f) + LN_EPS);
    const float o0 = d0 * rs * g[tid * 2] + bta[tid * 2], o1 = d1 * rs * g[tid * 2 + 1] + bta[tid * 2 + 1];
    *(float2*)(orow + tid * 2) = make_float2(o0, o1);
    if (obrow) *(unsigned*)(obrow + tid * 2) = pk2(o0, o1);
    __syncthreads();
}

__device__ __forceinline__ int t5_bucket(int n) {
    if (n < 16) return n;
    const int large = 16 + (int)(logf((float)n / 16.0f) / 2.0794415416798357f * 16.0f);
    return large < 31 ? large : 31;
}
__device__ __forceinline__ void swa_attn(const float* __restrict__ PC, const float* __restrict__ cache_k, const float* __restrict__ cache_v,
                                         const float* __restrict__ rel_bias, const float* __restrict__ sinks, bf16* __restrict__ ATT, int bx) {
    const int tid = threadIdx.x, lane = tid & 63, wid = tid >> 6;
    const int gw = bx * 8 + wid;
    const int t = gw >> 4, h = gw & 15, kvh = h >> 2;
    if (t >= NT) return;
    const bool samp = t >= NP; const int sb = t - NP, pos = t % SEQ;
    const float* qrow = PC + (size_t)t * CN + h * 64;
    float lg[2]; bool valid[2];
#pragma unroll
    for (int rr = 0; rr < 2; ++rr) {
        const int r = lane + 64 * rr;
        const float* krow;
        if (!samp) { valid[rr] = (pos - r) >= 0; krow = PC + (size_t)(valid[rr] ? t - r : t) * CN + 1024 + kvh * 64; }
        else { valid[rr] = true; krow = (r == 0) ? PC + (size_t)t * CN + 1024 + kvh * 64 : cache_k + (((size_t)sb * 128 + (128 - r)) * 4 + kvh) * 64; }
        float dot = 0.f;
#pragma unroll
        for (int d4 = 0; d4 < 16; ++d4) {
            const float4 kv = *(const float4*)(krow + d4 * 4);
            const float4 qv = *(const float4*)(qrow + d4 * 4);
            dot += qv.x * kv.x + qv.y * kv.y + qv.z * kv.z + qv.w * kv.w;
        }
        lg[rr] = valid[rr] ? dot * 0.125f + rel_bias[t5_bucket(r) * 16 + h] : -INFINITY;
    }
    const float sink = sinks[h];
    const float m = fmaxf(wave_max(fmaxf(lg[0], lg[1])), sink);
    float p[2];
#pragma unroll
    for (int rr = 0; rr < 2; ++rr) p[rr] = valid[rr] ? expf(lg[rr] - m) : 0.f;
    const float den = wave_sum(p[0] + p[1]) + expf(sink - m);
    const float inv = 1.0f / den;
    float o = 0.f;
#pragma unroll
    for (int rr = 0; rr < 2; ++rr)
        for (int l2 = 0; l2 < 64; ++l2) {
            const int r = l2 + 64 * rr;
            const float pj = __shfl(p[rr], l2);
            if (pj != 0.f) {
                const float* vrow;
                if (!samp) vrow = PC + (size_t)(t - r) * CN + 1280 + kvh * 64;
                else vrow = (r == 0) ? PC + (size_t)t * CN + 1280 + kvh * 64 : cache_v + (((size_t)sb * 128 + (128 - r)) * 4 + kvh) * 64;
                o += pj * vrow[lane];
            }
        }
    ATT[(size_t)t * D + h * 64 + lane] = (bf16)f2bf(o * inv);
}

__device__ __forceinline__ void swa_kv_out(const float* __restrict__ PC, const float* __restrict__ cache_k, const float* __restrict__ cache_v,
                                           float* __restrict__ pk, float* __restrict__ pv, float* __restrict__ sk, float* __restrict__ sv, int vb) {
    const int c = threadIdx.x & 255, row = vb * 2 + (threadIdx.x >> 8);
    if (row < NB * 128) {
        const int b = row >> 7, i = row & 127;
        const float* src = PC + (size_t)(b * SEQ + SEQ - 128 + i) * CN;
        pk[(size_t)row * 256 + c] = src[1024 + c];
        pv[(size_t)row * 256 + c] = src[1280 + c];
    } else {
        const int r2 = row - NB * 128, sb = r2 >> 7, i = r2 & 127;
        if (i < 127) {
            sk[(size_t)r2 * 256 + c] = cache_k[((size_t)sb * 128 + i + 1) * 256 + c];
            sv[(size_t)r2 * 256 + c] = cache_v[((size_t)sb * 128 + i + 1) * 256 + c];
        } else {
            const float* src = PC + (size_t)(NP + sb) * CN;
            sk[(size_t)r2 * 256 + c] = src[1024 + c];
            sv[(size_t)r2 * 256 + c] = src[1280 + c];
        }
    }
}
#define XB_TMO      128
#define XB_XCNT(j)  (256  + 64 * (j))
#define XB_XSUB(j)  (1280 + 64 * (j))
#define XB_XGEN(j)  (2304 + 64 * (j))
#define XB_TOP      3328
#define XB_TOPGEN   3392
#define XCD_BAR_WORDS 3456
#define XB_SPIN_CAP (1u << 18)

__device__ __forceinline__ unsigned xb_ld(unsigned* p)              { return __hip_atomic_load(p, __ATOMIC_RELAXED, __HIP_MEMORY_SCOPE_AGENT); }
__device__ __forceinline__ unsigned xb_add(unsigned* p, unsigned v) { return __hip_atomic_fetch_add(p, v, __ATOMIC_RELAXED, __HIP_MEMORY_SCOPE_AGENT); }
__device__ __forceinline__ unsigned xb_xcc_id() { return (unsigned)__builtin_amdgcn_s_getreg((3 << 11) | 20) & 0xFu; }
#define XB_SPIN(cond, bar) do { unsigned _sp = 0; while (cond) { __builtin_amdgcn_s_sleep(1); \
    if ((++_sp & 255u) == 0u) { if (xb_ld(&(bar)[XB_TMO])) break; if (_sp > XB_SPIN_CAP) { atomicAdd(&(bar)[XB_TMO], 1u); break; } } } } while (0)

struct XcdBarrier {
    unsigned* bar; unsigned x;
    volatile LAS unsigned* st;
};

__device__ __forceinline__ XcdBarrier xcd_barrier_post(unsigned* bar, volatile LAS unsigned* st) {
    XcdBarrier b; b.bar = bar; b.x = xb_xcc_id(); b.st = st;
    if (threadIdx.x == 0) (void)xb_add(&bar[XB_XCNT(b.x)], 1u);
    return b;
}
__device__ __forceinline__ void xcd_barrier_complete(unsigned* bar, unsigned x, unsigned& nloc, unsigned& nx) {
    const unsigned G = gridDim.x * gridDim.y * gridDim.z;
    unsigned sum, cnt, mine, sp = 0u;
    for (;;) {
        sum = 0u; cnt = 0u; mine = 0u;
#pragma unroll
        for (unsigned j = 0; j < 16; ++j) { const unsigned c = xb_ld(&bar[XB_XCNT(j)]); sum += c; cnt += (c > 0u) ? 1u : 0u; mine = (j == x) ? c : mine; }
        if (sum == G) break;
        __builtin_amdgcn_s_sleep(1);
        if ((++sp & 255u) == 0u) { if (xb_ld(&bar[XB_TMO])) break; if (sp > XB_SPIN_CAP) { atomicAdd(&bar[XB_TMO], 1u); break; } }
    }
    nloc = mine > 0u ? mine : 1u; nx = cnt > 0u ? cnt : 1u;
}

__device__ __forceinline__ void xcd_barrier(const XcdBarrier& b) {
    asm volatile("s_waitcnt vmcnt(0)" ::: "memory");
    __syncthreads();
    if (threadIdx.x == 0) {
        unsigned* bar = b.bar;
        __builtin_amdgcn_s_waitcnt(0);
        unsigned nloc = b.st[0], nx = b.st[1];
        if (nloc == 0u) { xcd_barrier_complete(bar, b.x, nloc, nx); b.st[0] = nloc; b.st[1] = nx; }
        const unsigned old = xb_add(&bar[XB_XSUB(b.x)], 1u);
        const unsigned gen = old / nloc;
        if (old + 1u == (gen + 1u) * nloc) {
            __builtin_amdgcn_fence(__ATOMIC_RELEASE, "agent");
            asm volatile("s_waitcnt vmcnt(0)" ::: "memory");
            const unsigned og = xb_add(&bar[XB_TOP], 1u);
            const unsigned tg = og / nx;
            if (og + 1u == (tg + 1u) * nx) xb_add(&bar[XB_TOPGEN], 1u);
            else XB_SPIN(xb_ld(&bar[XB_TOPGEN]) == tg, bar);
            __builtin_amdgcn_fence(__ATOMIC_ACQUIRE, "agent");
            xb_add(&bar[XB_XGEN(b.x)], 1u);
            asm volatile("s_waitcnt vmcnt(0)" ::: "memory");
        } else {
            XB_SPIN(xb_ld(&bar[XB_XGEN(b.x)]) == gen, bar);
            __builtin_amdgcn_fence(__ATOMIC_ACQUIRE, "agent");
            asm volatile("s_waitcnt vmcnt(0)" ::: "memory");
        }
    }
    __syncthreads();
}

typedef short bf16x8_t __attribute__((ext_vector_type(8)));
__device__ __forceinline__ f32x4 mfma16(bf16x8_t a, bf16x8_t b, f32x4 c) { return __builtin_amdgcn_mfma_f32_16x16x32_bf16(a, b, c, 0, 0, 0); }

struct GdnChunkBufs {
    bf16* W;
    bf16* QG;
    bf16* KDT;
    bf16* UT;
    bf16* QK;
    float* EGL;
};

constexpr int GP_QB = 0, GP_KB = 17408, GP_VB = 34816, GP_LS = 52224, GP_QKS = 69632, GP_WS = 78848, GP_SC = 96256;

__device__ __forceinline__ void gdn_prep_unit(const bf16* __restrict__ PROJ, const float* __restrict__ conv_w, const float* __restrict__ a_log, const float* __restrict__ dt_bias,
                                              const GdnChunkBufs& cb, float* __restrict__ p_gdn_conv, int un, unsigned char* lds) {
    int tid = threadIdx.x; asm volatile("" : "+v"(tid));
    const int lane = tid & 63, wave = __builtin_amdgcn_readfirstlane(tid >> 6), fr = lane & 15, fq = lane >> 4;
    const int h = un & 3, n = (un >> 2) & 63, b = un >> 8;
    const int t0 = b * SEQ + n * 64;
    bf16* Qb = (bf16*)(lds + GP_QB); bf16* Kb = (bf16*)(lds + GP_KB); bf16* Vb = (bf16*)(lds + GP_VB); bf16* Ws = (bf16*)(lds + GP_WS);
    float* Ls = (float*)(lds + GP_LS); bf16* QKs = (bf16*)(lds + GP_QKS);
    float* gcs = (float*)(lds + GP_SC); float* bets = gcs + 64; float* egcs = gcs + 128; float* ekds = gcs + 192; float* begs = gcs + 256;
    if (wave == 0) {
        const bf16* prow = PROJ + (size_t)(t0 + lane) * ABN;
        const float a_raw = bf2f(prow[C_A + h]), b_raw = bf2f(prow[C_B + h]);
        float g = -expf(a_log[h]) * softplusf_(a_raw + dt_bias[h]);
#pragma unroll
        for (int off = 1; off < 64; off <<= 1) { const float v = __shfl_up(g, off); if (lane >= off) g += v; }
        const float glast = __shfl(g, 63);
        { const float be_ = sigmoidf_(b_raw), eg_ = expf(g); gcs[lane] = g; bets[lane] = be_; egcs[lane] = eg_; ekds[lane] = expf(glast - g); begs[lane] = be_ * eg_; }
        if (lane == 0) cb.EGL[un] = expf(glast);
    }
    {
        int cols[6]; float cw[4][6], xw[3][6];
#pragma unroll
        for (int p = 0; p < 3; ++p)
#pragma unroll
            for (int e = 0; e < 2; ++e) cols[p * 2 + e] = p * 512 + h * 128 + e * 64 + lane;
#pragma unroll
        for (int i = 0; i < 4; ++i)
#pragma unroll
            for (int c = 0; c < 6; ++c) cw[i][c] = conv_w[i * 1536 + cols[c]];
        const int i0 = wave * 8;
#pragma unroll
        for (int k = 0; k < 3; ++k) {
            const int pos = n * 64 + i0 - 3 + k;
#pragma unroll
            for (int c = 0; c < 6; ++c) xw[k][c] = pos >= 0 ? bf2f(PROJ[(size_t)(t0 + i0 - 3 + k) * ABN + cols[c]]) : 0.f;
        }
        bf16 xraw[8][6];
#pragma unroll
        for (int ii = 0; ii < 8; ++ii)
#pragma unroll
            for (int c = 0; c < 6; ++c) xraw[ii][c] = PROJ[(size_t)(t0 + i0 + ii) * ABN + cols[c]];
#pragma unroll
        for (int ii = 0; ii < 8; ++ii) {
            const int i = i0 + ii;
            float xt[6], s[6];
#pragma unroll
            for (int c = 0; c < 6; ++c) xt[c] = bf2f(xraw[ii][c]);
#pragma unroll
            for (int c = 0; c < 6; ++c) { const float y_ = cw[0][c] * xw[0][c] + cw[1][c] * xw[1][c] + cw[2][c] * xw[2][c] + cw[3][c] * xt[c]; s[c] = y_ * __frcp_rn(1.0f + __expf(-y_)); }
            const float qs = rsqrtf(wave_sum(s[0] * s[0] + s[1] * s[1]) + 1e-6f) * 0.08838834764831845f;
            const float ks = rsqrtf(wave_sum(s[2] * s[2] + s[3] * s[3]) + 1e-6f);
            Qb[i * 136 + lane] = (bf16)f2bf(s[0] * qs); Qb[i * 136 + 64 + lane] = (bf16)f2bf(s[1] * qs);
            Kb[i * 136 + lane] = (bf16)f2bf(s[2] * ks); Kb[i * 136 + 64 + lane] = (bf16)f2bf(s[3] * ks);
            Vb[i * 136 + lane] = (bf16)f2bf(s[4]);      Vb[i * 136 + 64 + lane] = (bf16)f2bf(s[5]);
            if (n == 63 && i >= 61) {
#pragma unroll
                for (int c = 0; c < 6; ++c) p_gdn_conv[((size_t)b * 3 + (i - 61)) * 1536 + cols[c]] = xt[c];
            }
#pragma unroll
            for (int c = 0; c < 6; ++c) { xw[0][c] = xw[1][c]; xw[1][c] = xw[2][c]; xw[2][c] = xt[c]; }
        }
    }
    __syncthreads();
    {
        const int mi = wave >> 1;
        bf16x8_t aK[4], aQ[4];
#pragma unroll
        for (int ks = 0; ks < 4; ++ks) { aK[ks] = *(const bf16x8_t*)(Kb + (mi * 16 + fr) * 136 + ks * 32 + 8 * fq); aQ[ks] = *(const bf16x8_t*)(Qb + (mi * 16 + fr) * 136 + ks * 32 + 8 * fq); }
#pragma unroll
        for (int nn = 0; nn < 2; ++nn) {
            const int nj = (wave & 1) * 2 + nn;
            f32x4 accK = (f32x4){0.f, 0.f, 0.f, 0.f}, accQ = accK;
#pragma unroll
            for (int ks = 0; ks < 4; ++ks) { const bf16x8_t bk = *(const bf16x8_t*)(Kb + (nj * 16 + fr) * 136 + ks * 32 + 8 * fq); accK = mfma16(aK[ks], bk, accK); accQ = mfma16(aQ[ks], bk, accQ); }
            const int j = nj * 16 + fr; const float gj = gcs[j];
#pragma unroll
            for (int r = 0; r < 4; ++r) {
                const int i = mi * 16 + 4 * fq + r;
                const float dec = i >= j ? expf(gcs[i] - gj) : 0.f;
                Ls[j * 68 + i] = i > j ? bets[i] * accK[r] * dec : 0.f;
                QKs[i * 72 + j] = (bf16)f2bf(i >= j ? accQ[r] * dec : 0.f);
            }
        }
    }
    __syncthreads();
    if (wave < 4) {
        float x[64];
        const bool isu = tid < 128; const int c = isu ? tid : tid - 128;
        const LAS unsigned char* l3 = (const LAS unsigned char*)lds;
        unsigned so = (isu ? GP_VB : GP_KB) + c * 2, ro = GP_SC + (isu ? 64 * 4 : 256 * 4), lo = GP_LS;
        asm volatile("" : "+v"(so), "+v"(ro), "+v"(lo));
#pragma unroll
        for (int i = 0; i < 64; ++i) x[i] = *(const LAS float*)(l3 + ro + 4 * i) * bf2f(*(const LAS bf16*)(l3 + so + i * 272));
#pragma unroll
        for (int j = 0; j < 63; ++j) {
#pragma unroll
            for (int i4 = (j + 1) / 4; i4 < 16; ++i4) {
                const f32x4 l4 = *(const LAS f32x4*)(l3 + lo + j * 272 + i4 * 16);
                if (i4 * 4 + 0 > j) x[i4 * 4 + 0] -= l4.x * x[j];
                if (i4 * 4 + 1 > j) x[i4 * 4 + 1] -= l4.y * x[j];
                if (i4 * 4 + 2 > j) x[i4 * 4 + 2] -= l4.z * x[j];
                if (i4 * 4 + 3 > j) x[i4 * 4 + 3] -= l4.w * x[j];
            }
        }
        if (isu) {
            bf16* dst = cb.UT + ((size_t)un * 128 + c) * 64;
#pragma unroll
            for (int i8 = 0; i8 < 8; ++i8) { v4u o; o.x = pk2(x[i8 * 8 + 0], x[i8 * 8 + 1]); o.y = pk2(x[i8 * 8 + 2], x[i8 * 8 + 3]); o.z = pk2(x[i8 * 8 + 4], x[i8 * 8 + 5]); o.w = pk2(x[i8 * 8 + 6], x[i8 * 8 + 7]); *(v4u*)(dst + i8 * 8) = o; }
        } else {
#pragma unroll
            for (int i = 0; i < 64; ++i) Ws[i * 136 + c] = (bf16)f2bf(x[i]);
        }
    } else {
        const int t2 = tid - 256;
#pragma unroll
        for (int k = 0; k < 4; ++k) {
            const int ci = t2 + 256 * k, i = ci >> 4, d0 = (ci & 15) * 8; const float e = egcs[i];
            const v4u q = *(const v4u*)(Qb + i * 136 + d0);
            v4u o; o.x = pk2(bflo(q.x) * e, bfhi(q.x) * e); o.y = pk2(bflo(q.y) * e, bfhi(q.y) * e); o.z = pk2(bflo(q.z) * e, bfhi(q.z) * e); o.w = pk2(bflo(q.w) * e, bfhi(q.w) * e);
            *(v4u*)(cb.QG + ((size_t)un * 64 + i) * 128 + d0) = o;
        }
#pragma unroll
        for (int k = 0; k < 4; ++k) {
            const int ci = t2 + 256 * k, d = ci & 127, i0 = (ci >> 7) * 8;
            float v[8];
#pragma unroll
            for (int q = 0; q < 8; ++q) v[q] = bf2f(Kb[(i0 + q) * 136 + d]) * ekds[i0 + q];
            v4u o; o.x = pk2(v[0], v[1]); o.y = pk2(v[2], v[3]); o.z = pk2(v[4], v[5]); o.w = pk2(v[6], v[7]);
            *(v4u*)(cb.KDT + ((size_t)un * 128 + d) * 64 + i0) = o;
        }
#pragma unroll
        for (int k = 0; k < 2; ++k) {
            const int ci = t2 + 256 * k, i = ci >> 3, j0 = (ci & 7) * 8;
            *(v4u*)(cb.QK + ((size_t)un * 64 + i) * 64 + j0) = *(const v4u*)(QKs + i * 72 + j0);
        }
    }
    __syncthreads();
#pragma unroll
    for (int k = 0; k < 2; ++k) {
        const int ci = tid + 512 * k, i = ci >> 4, d0 = (ci & 15) * 8;
        *(v4u*)(cb.W + ((size_t)un * 64 + i) * 128 + d0) = *(const v4u*)(Ws + i * 136 + d0);
    }
    __syncthreads();
}

constexpr int GS_ST = 0, GS_VNT = 2 * 32 * 136 * 2, GS_END = GS_VNT + 32 * 72 * 2;
template <int N0, int N1>
__device__ __forceinline__ void gdn_seq(const GdnChunkBufs& cb, float* __restrict__ O, float* __restrict__ Sout, int b, int h, int sl, unsigned char* lds, f32x4 (&accS)[2], int& cur) {
    int tid = threadIdx.x; asm volatile("" : "+v"(tid));
    const int lane = tid & 63, wave = __builtin_amdgcn_readfirstlane(tid >> 6), fr = lane & 15, fq = lane >> 4;
    const int mi = wave >> 1, nj = wave & 1;
    bf16* St = (bf16*)(lds + GS_ST); bf16* VnT = (bf16*)(lds + GS_VNT);
    float* egls = (float*)(lds + GS_END);
    if (N0 == 0) {
        for (int i = tid; i < 2 * 32 * 136 / 2; i += NTH) ((unsigned*)St)[i] = 0u;
        accS[0] = (f32x4){0.f, 0.f, 0.f, 0.f}; accS[1] = accS[0]; cur = 0;
    }
    if (tid >= N0 && tid < N1) egls[tid] = cb.EGL[(size_t)((b * 64 + tid) * 4 + h)];
    __syncthreads();
#define GS_DECL(X) bf16x8_t aW##X[4], aQG##X[4], aQK##X[2], aKD##X[2]; v2u ut##X;
    GS_DECL(0) GS_DECL(1) GS_DECL(2)
#define GS_GLD16(dst, ptr) asm volatile("global_load_dwordx4 %0, %1, off" : "=v"(dst) : "v"(ptr))
#define GS_GLD8(dst, ptr) asm volatile("global_load_dwordx2 %0, %1, off" : "=v"(dst) : "v"(ptr))
#define GS_LOAD(X, n_) do { const size_t u_ = (size_t)((b * 64 + ((n_) < 63 ? (n_) : 63)) * 4 + h);     \
        _Pragma("unroll") for (int ks = 0; ks < 4; ++ks) { GS_GLD16(aW##X[ks], cb.W + (u_ * 64 + mi * 16 + fr) * 128 + ks * 32 + 8 * fq); GS_GLD16(aQG##X[ks], cb.QG + (u_ * 64 + mi * 16 + fr) * 128 + ks * 32 + 8 * fq); } \
        _Pragma("unroll") for (int ks = 0; ks < 2; ++ks) { GS_GLD16(aQK##X[ks], cb.QK + (u_ * 64 + mi * 16 + fr) * 64 + ks * 32 + 8 * fq); GS_GLD16(aKD##X[ks], cb.KDT + (u_ * 128 + wave * 16 + fr) * 64 + ks * 32 + 8 * fq); } \
        GS_GLD8(ut##X, cb.UT + (u_ * 128 + sl * 32 + nj * 16 + fr) * 64 + mi * 16 + 4 * fq); } while (0)
#define GS_WAITN(X, N) asm volatile("s_waitcnt vmcnt(" #N ")" : "+v"(aW##X[0]), "+v"(aW##X[1]), "+v"(aW##X[2]), "+v"(aW##X[3]), "+v"(aQG##X[0]), "+v"(aQG##X[1]), "+v"(aQG##X[2]), "+v"(aQG##X[3]), \
        "+v"(aQK##X[0]), "+v"(aQK##X[1]), "+v"(aKD##X[0]), "+v"(aKD##X[1]), "+v"(ut##X))
#define GS_WAIT(X, n_) GS_WAITN(X, 26)
#define GS_STEP(X, n_) do { \
        const float egl##X = egls[(n_)]; \
        GS_WAIT(X, n_); \
        __syncthreads();                                        \
        f32x4 accW = (f32x4){0.f, 0.f, 0.f, 0.f}, accO = accW; \
        const bf16* Sc = St + cur * 32 * 136; \
        _Pragma("unroll") for (int ks = 0; ks < 4; ++ks) { const bf16x8_t bs = *(const bf16x8_t*)(Sc + (nj * 16 + fr) * 136 + ks * 32 + 8 * fq); accW = mfma16(aW##X[ks], bs, accW); accO = mfma16(aQG##X[ks], bs, accO); } \
          \
        const float v0 = bflo(ut##X.x) - accW[0], v1 = bfhi(ut##X.x) - accW[1], v2 = bflo(ut##X.y) - accW[2], v3 = bfhi(ut##X.y) - accW[3]; \
        { v2u o; o.x = pk2(v0, v1); o.y = pk2(v2, v3); *(v2u*)(VnT + (nj * 16 + fr) * 72 + mi * 16 + 4 * fq) = o; } \
        __syncthreads();                                        \
        _Pragma("unroll") for (int ks = 0; ks < 2; ++ks) { const bf16x8_t bv = *(const bf16x8_t*)(VnT + (nj * 16 + fr) * 72 + ks * 32 + 8 * fq); accO = mfma16(aQK##X[ks], bv, accO); } \
        { float* orow = O + (size_t)(b * SEQ + (n_) * 64 + mi * 16 + 4 * fq) * 512 + h * 128 + sl * 32 + nj * 16 + fr; \
          orow[0] = accO[0]; orow[512] = accO[1]; orow[1024] = accO[2]; orow[1536] = accO[3]; } \
          \
        bf16* Sn = St + (cur ^ 1) * 32 * 136; \
        _Pragma("unroll") for (int njj = 0; njj < 2; ++njj) { \
            accS[njj] = accS[njj] * egl##X; \
            _Pragma("unroll") for (int ks = 0; ks < 2; ++ks) { const bf16x8_t bv = *(const bf16x8_t*)(VnT + (njj * 16 + fr) * 72 + ks * 32 + 8 * fq); accS[njj] = mfma16(aKD##X[ks], bv, accS[njj]); } \
            v2u o; o.x = pk2(accS[njj][0], accS[njj][1]); o.y = pk2(accS[njj][2], accS[njj][3]); \
            *(v2u*)(Sn + (njj * 16 + fr) * 136 + wave * 16 + 4 * fq) = o; } \
        cur ^= 1; } while (0)
    constexpr int NTRI = (N1 - N0) / 3, NREM = (N1 - N0) % 3, NM = N0 + 3 * NTRI;
    GS_LOAD(0, N0); GS_LOAD(1, N0 + 1);
#pragma unroll 1
    for (int n = N0; n < NM; n += 3) {
        GS_LOAD(2, n + 2);
        GS_STEP(0, n);
        GS_LOAD(0, n + 3);
        GS_STEP(1, n + 1);
        GS_LOAD(1, n + 4);
        GS_STEP(2, n + 2);
    }
    if (NREM >= 1) { GS_LOAD(2, NM + 2); GS_STEP(0, NM); }
    if (NREM == 2) { GS_LOAD(0, NM + 3); GS_STEP(1, NM + 1); }
    GS_WAITN(0, 0); GS_WAITN(1, 0); GS_WAITN(2, 0);
#undef GS_STEP
#undef GS_DECL
#undef GS_WAIT
#undef GS_WAITN
#undef GS_GLD16
#undef GS_GLD8
    asm volatile("s_waitcnt vmcnt(0)" ::: "memory");
#undef GS_LOAD
    if (N1 == 64) {
#pragma unroll
        for (int njj = 0; njj < 2; ++njj)
#pragma unroll
            for (int r = 0; r < 4; ++r) Sout[(((size_t)b * 4 + h) * 128 + wave * 16 + 4 * fq + r) * 128 + sl * 32 + njj * 16 + fr] = accS[njj][r];
    }
    __syncthreads();
}

__device__ __forceinline__ void lru_prep_unit(const bf16* __restrict__ PROJ, const float* __restrict__ conv_w, const float* __restrict__ conv_b,
                                              const float* __restrict__ w_r, const float* __restrict__ b_r, const float* __restrict__ w_i, const float* __restrict__ b_i, const float* __restrict__ lam,
                                              float* __restrict__ H, float* __restrict__ P, float* __restrict__ Hend, float* __restrict__ Pend, float* __restrict__ p_lru_conv, int ub) {
    int c = threadIdx.x; asm volatile("" : "+v"(c));
    const int nblk = c >> 6, d = c & 63;
    const int n = ub & 63, b = ub >> 6, t0 = b * SEQ + n * 64;
    float wr[64], wi[64];
#pragma unroll
    for (int cc = 0; cc < 64; ++cc) { wr[cc] = w_r[((size_t)nblk * 64 + cc) * 64 + d]; wi[cc] = w_i[((size_t)nblk * 64 + cc) * 64 + d]; }
    const float cw0 = conv_w[c], cw1 = conv_w[512 + c], cw2 = conv_w[1024 + c], cw3 = conv_w[1536 + c], cb_ = conv_b[c];
    const float br = b_r[c], bi = b_i[c], spl = -8.0f * softplusf_(-lam[c]);
    float x0 = (n * 64 - 3 >= 0) ? bf2f(PROJ[(size_t)(t0 - 3) * ABN + C_XR + c]) : 0.f;
    float x1 = (n * 64 - 2 >= 0) ? bf2f(PROJ[(size_t)(t0 - 2) * ABN + C_XR + c]) : 0.f;
    float x2 = (n * 64 - 1 >= 0) ? bf2f(PROJ[(size_t)(t0 - 1) * ABN + C_XR + c]) : 0.f;
    float hloc = 0.f, ploc = 1.f;
    bf16 xa[16], xb[16];
#pragma unroll
    for (int k = 0; k < 16; ++k) xa[k] = PROJ[(size_t)(t0 + k) * ABN + C_XR + c];
#pragma unroll 1
    for (int ib = 0; ib < 64; ib += 16) {
      if (ib + 16 < 64) {
#pragma unroll
        for (int k = 0; k < 16; ++k) xb[k] = PROJ[(size_t)(t0 + ib + 16 + k) * ABN + C_XR + c];
      }
#pragma unroll
      for (int k = 0; k < 16; ++k) {
        const int i = ib + k;
        const float xt = bf2f(xa[k]);
        const float xr = cb_ + cw0 * x0 + cw1 * x1 + cw2 * x2 + cw3 * xt;
        f32x2_t ga = (f32x2_t){br, bi}, gb = (f32x2_t){0.f, 0.f};
#pragma unroll
        for (int cc = 0; cc < 64; cc += 2) {
            const float xa_ = __uint_as_float(__builtin_amdgcn_readlane(__float_as_uint(xr), cc)), xb_ = __uint_as_float(__builtin_amdgcn_readlane(__float_as_uint(xr), cc + 1));
            ga += (f32x2_t){xa_, xa_} * (f32x2_t){wr[cc], wi[cc]}; gb += (f32x2_t){xb_, xb_} * (f32x2_t){wr[cc + 1], wi[cc + 1]};
        }
        ga += gb;
        const float r = __frcp_rn(1.0f + __expf(-ga.x)), ii = __frcp_rn(1.0f + __expf(-ga.y));
        const float a = __expf(spl * r), bb = __fsqrt_rn(fmaxf(1.0f - a * a, 0.f)) * (ii * xr);
        hloc = a * hloc + bb; ploc *= a;
        H[(size_t)(t0 + i) * 512 + c] = hloc; P[(size_t)(t0 + i) * 512 + c] = ploc;
        if (n == 63 && i >= 61) p_lru_conv[((size_t)b * 3 + (i - 61)) * 512 + c] = xt;
        x0 = x1; x1 = x2; x2 = xt;
      }
#pragma unroll
      for (int k = 0; k < 16; ++k) xa[k] = xb[k];
    }
    Hend[(size_t)ub * 512 + c] = hloc; Pend[(size_t)ub * 512 + c] = ploc;
}
constexpr int LR_XR = 64 * 68 * 4;
__device__ __forceinline__ void lru_prep_unit2(const bf16* __restrict__ PROJ, const float* __restrict__ conv_w, const float* __restrict__ conv_b,
                                               const bf16* __restrict__ WRT, const bf16* __restrict__ WIT  , const float* __restrict__ b_r, const float* __restrict__ b_i, const float* __restrict__ lam,
                                               float* __restrict__ H, float* __restrict__ P, float* __restrict__ Hend, float* __restrict__ Pend, float* __restrict__ p_lru_conv, int ub, unsigned char* lds) {
    int tid = threadIdx.x; asm volatile("" : "+v"(tid));
    const int lane = tid & 63, wave = __builtin_amdgcn_readfirstlane(tid >> 6), fr = lane & 15, fq = lane >> 4;
    const int n = ub & 63, b = ub >> 6, t0 = b * SEQ + n * 64;
    float* XR = (float*)(lds + wave * LR_XR);
    {
        const int c = wave * 64 + lane;
        const float cw0 = conv_w[c], cw1 = conv_w[512 + c], cw2 = conv_w[1024 + c], cw3 = conv_w[1536 + c], cb_ = conv_b[c];
        float x0 = (n * 64 - 3 >= 0) ? bf2f(PROJ[(size_t)(t0 - 3) * ABN + C_XR + c]) : 0.f;
        float x1 = (n * 64 - 2 >= 0) ? bf2f(PROJ[(size_t)(t0 - 2) * ABN + C_XR + c]) : 0.f;
        float x2 = (n * 64 - 1 >= 0) ? bf2f(PROJ[(size_t)(t0 - 1) * ABN + C_XR + c]) : 0.f;
#pragma unroll 1
        for (int ib = 0; ib < 64; ib += 16) {
            bf16 xa[16];
#pragma unroll
            for (int k = 0; k < 16; ++k) xa[k] = PROJ[(size_t)(t0 + ib + k) * ABN + C_XR + c];
#pragma unroll
            for (int k = 0; k < 16; ++k) {
                const int i = ib + k; const float xt = bf2f(xa[k]);
                XR[i * 68 + lane] = cb_ + cw0 * x0 + cw1 * x1 + cw2 * x2 + cw3 * xt;
                if (n == 63 && i >= 61) p_lru_conv[((size_t)b * 3 + (i - 61)) * 512 + c] = xt;
                x0 = x1; x1 = x2; x2 = xt;
            }
        }
    }
    asm volatile("s_waitcnt lgkmcnt(0)" ::: "memory");
    bf16x8_t bR[4][2], bI[4][2];
#pragma unroll
    for (int nt = 0; nt < 4; ++nt)
#pragma unroll
        for (int ks = 0; ks < 2; ++ks) {
            bR[nt][ks] = *(const bf16x8_t*)(WRT + ((size_t)wave * 64 + nt * 16 + fr) * 64 + ks * 32 + 8 * fq);
            bI[nt][ks] = *(const bf16x8_t*)(WIT + ((size_t)wave * 64 + nt * 16 + fr) * 64 + ks * 32 + 8 * fq);
        }
    float brv[4], biv[4], splv[4];
#pragma unroll
    for (int nt = 0; nt < 4; ++nt) { const int c = wave * 64 + nt * 16 + fr; brv[nt] = b_r[c]; biv[nt] = b_i[c]; splv[nt] = -8.0f * softplusf_(-lam[c]); }
    float hin[4], pin[4];
#pragma unroll
    for (int nt = 0; nt < 4; ++nt) { hin[nt] = 0.f; pin[nt] = 1.f; }
#pragma unroll 1
    for (int mt = 0; mt < 4; ++mt) {
        bf16x8_t aX[2];
#pragma unroll
        for (int ks = 0; ks < 2; ++ks) {
            const f32x4 lo = *(const f32x4*)(XR + (mt * 16 + fr) * 68 + ks * 32 + 8 * fq), hi = *(const f32x4*)(XR + (mt * 16 + fr) * 68 + ks * 32 + 8 * fq + 4);
            v4u w; w.x = pk2(lo.x, lo.y); w.y = pk2(lo.z, lo.w); w.z = pk2(hi.x, hi.y); w.w = pk2(hi.z, hi.w);
            aX[ks] = __builtin_bit_cast(bf16x8_t, w);
        }
#pragma unroll
        for (int nt = 0; nt < 4; ++nt) {
            f32x4 aR = (f32x4){0.f, 0.f, 0.f, 0.f}, aI = aR;
            aR = mfma16(aX[0], bR[nt][0], aR); aR = mfma16(aX[1], bR[nt][1], aR);
            aI = mfma16(aX[0], bI[nt][0], aI); aI = mfma16(aX[1], bI[nt][1], aI);
            float av[4], bv[4];
#pragma unroll
            for (int r = 0; r < 4; ++r) {
                const float rg = __frcp_rn(1.0f + __expf(-(aR[r] + brv[nt]))), ig = __frcp_rn(1.0f + __expf(-(aI[r] + biv[nt])));
                const float a = __expf(splv[nt] * rg);
                av[r] = a; bv[r] = __fsqrt_rn(fmaxf(1.0f - a * a, 0.f)) * (ig * XR[(mt * 16 + 4 * fq + r) * 68 + nt * 16 + fr]);
            }
            float PA[4], PB[4];
            PA[0] = av[0]; PB[0] = bv[0];
#pragma unroll
            for (int r = 1; r < 4; ++r) { PA[r] = av[r] * PA[r - 1]; PB[r] = av[r] * PB[r - 1] + bv[r]; }
            float GA = PA[3], GB = PB[3];
            { const float pa = __shfl_up(GA, 16), pb = __shfl_up(GB, 16); if (fq >= 1) { GB = GA * pb + GB; GA = GA * pa; } }
            { const float pa = __shfl_up(GA, 32), pb = __shfl_up(GB, 32); if (fq >= 2) { GB = GA * pb + GB; GA = GA * pa; } }
            float EA = __shfl_up(GA, 16), EB = __shfl_up(GB, 16);
            if (fq == 0) { EA = 1.f; EB = 0.f; }
            const float h0 = EA * hin[nt] + EB, p0 = pin[nt] * EA;
#pragma unroll
            for (int r = 0; r < 4; ++r) {
                const size_t o = (size_t)(t0 + mt * 16 + 4 * fq + r) * 512 + wave * 64 + nt * 16 + fr;
                H[o] = PA[r] * h0 + PB[r]; P[o] = p0 * PA[r];
            }
            const float TA = __shfl(GA, 48 + fr), TB = __shfl(GB, 48 + fr);
            hin[nt] = TA * hin[nt] + TB; pin[nt] = pin[nt] * TA;
        }
    }
    if (fq == 0) {
#pragma unroll
        for (int nt = 0; nt < 4; ++nt) { Hend[(size_t)ub * 512 + wave * 64 + nt * 16 + fr] = hin[nt]; Pend[(size_t)ub * 512 + wave * 64 + nt * 16 + fr] = pin[nt]; }
    }
    asm volatile("s_waitcnt lgkmcnt(0)" ::: "memory");
}
__device__ __forceinline__ void lru_carry(const float* __restrict__ Hend, const float* __restrict__ Pend, float* __restrict__ CIN, float* __restrict__ hlast, int bx) {
    int tx_ = threadIdx.x; asm volatile("" : "+v"(tx_));
    const int idx = bx * NTH + tx_, b = idx >> 9, c = idx & 511;
    float carry = 0.f;
#pragma unroll 8
    for (int n = 0; n < 64; ++n) {
        const size_t o = ((size_t)b * 64 + n) * 512 + c;
        CIN[o] = carry;
        carry = Hend[o] + Pend[o] * carry;
    }
    hlast[(size_t)b * 512 + c] = carry;
}

__device__ __forceinline__ unsigned f2key(float f) { const unsigned u = __float_as_uint(f); return u ^ ((u >> 31) ? 0xffffffffu : 0x80000000u); }
__device__ __forceinline__ float key2f(unsigned k) { return __uint_as_float(k ^ ((k >> 31) ? 0x80000000u : 0xffffffffu)); }
#define TK_CE(hi, lo) do { const unsigned a_ = (hi), b_ = (lo); (hi) = a_ > b_ ? a_ : b_; (lo) = a_ > b_ ? b_ : a_; } while (0)
template <int N> __device__ __forceinline__ void bitonic_sort_desc(unsigned (&a)[N]) {
#pragma unroll
    for (int k = 2; k <= N; k <<= 1)
#pragma unroll
        for (int j = k >> 1; j > 0; j >>= 1)
#pragma unroll
            for (int i = 0; i < N; ++i) { const int l = i ^ j; if (l > i) { if ((i & k) == 0) TK_CE(a[i], a[l]); else TK_CE(a[l], a[i]); } }
}
template <int XM> __device__ __forceinline__ void merge_top16(unsigned (&a)[16]) {
    unsigned c[16];
#pragma unroll
    for (int i = 0; i < 16; ++i) { const unsigned o = (unsigned)__shfl_xor((int)a[15 - i], XM); c[i] = a[i] > o ? a[i] : o; }
#pragma unroll
    for (int j = 8; j > 0; j >>= 1)
#pragma unroll
        for (int i = 0; i < 16; ++i) { const int l = i ^ j; if (l > i) TK_CE(c[i], c[l]); }
#pragma unroll
    for (int i = 0; i < 16; ++i) a[i] = c[i];
}
constexpr int TK_KS = 0, TK_TS = 2 * 128 * 136 * 2, TK_END = TK_TS + 64 * 2 * 16 * 4;
__device__ __forceinline__ void peer_topk_stage_keys(const bf16* __restrict__ KB, int h, unsigned char* lds) {
    bf16* Ks = (bf16*)(lds + TK_KS);
    for (int ci = threadIdx.x; ci < 2 * 128 * 16; ci += NTH) { const int row = ci >> 4, part = ci & 15;
        *(v4u*)(Ks + row * 136 + part * 8) = *(const v4u*)(KB + ((size_t)h * 256 + row) * 128 + part * 8); }
    __syncthreads();
}
__device__ __forceinline__ void peer_topk4(const bf16* __restrict__ Q, int* __restrict__ EXP, float* __restrict__ GATE, int tile, int h, unsigned char* lds) {
    int tid = threadIdx.x; asm volatile("" : "+v"(tid));
    const int lane = tid & 63, wave = __builtin_amdgcn_readfirstlane(tid >> 6), fr = lane & 15, fq = lane >> 4;
    const bf16* Ks = (const bf16*)(lds + TK_KS); unsigned* Ts = (unsigned*)(lds + TK_TS);
    {
        const int c = wave >> 2, nt = wave & 3;
        bf16x8_t bq[4];
#pragma unroll
        for (int ks = 0; ks < 4; ++ks) bq[ks] = *(const bf16x8_t*)(Q + (size_t)(tile * 64 + nt * 16 + fr) * 2048 + h * 256 + c * 128 + ks * 32 + 8 * fq);
        unsigned a[32];
#pragma unroll
        for (int mt = 0; mt < 8; ++mt) {
            f32x4 acc = (f32x4){0.f, 0.f, 0.f, 0.f};
#pragma unroll
            for (int ks = 0; ks < 4; ++ks) { const bf16x8_t ak = *(const bf16x8_t*)(Ks + (c * 128 + mt * 16 + fr) * 136 + ks * 32 + 8 * fq); acc = mfma16(ak, bq[ks], acc); }
#pragma unroll
            for (int r = 0; r < 4; ++r) a[mt * 4 + r] = (f2key(acc[r]) & ~127u) | (unsigned)(127 - (mt * 16 + 4 * fq + r));
        }
        bitonic_sort_desc<32>(a);
        unsigned t[16];
#pragma unroll
        for (int j = 0; j < 16; ++j) t[j] = a[j];
        merge_top16<16>(t); merge_top16<32>(t);
        if (fq == 0) {
            const int tk = nt * 16 + fr;
#pragma unroll
            for (int j = 0; j < 16; ++j) Ts[(tk * 2 + c) * 16 + j] = t[j];
        }
    }
    __syncthreads();
    if (tid < 256) {
        const int tk = tid >> 2, q = tid & 3;
        const unsigned* t0 = Ts + (tk * 2 + 0) * 16; const unsigned* t1 = Ts + (tk * 2 + 1) * 16;
        unsigned a[16];
#pragma unroll
        for (int s = 0; s < 13; ++s) {
            const int e = s * 4 + q;
            int i, j;
            if (e < 16) { i = 0; j = e; } else if (e < 24) { i = 1; j = e - 16; } else if (e < 29) { i = 2; j = e - 24; } else if (e < 33) { i = 3; j = e - 29; }
            else if (e < 36) { i = 4; j = e - 33; } else if (e < 42) { i = 5 + ((e - 36) >> 1); j = (e - 36) & 1; } else { i = 8 + (e - 42); j = 0; }
            const bool ok = e < 50;
            const float sum = key2f(t0[ok ? i : 0] & ~127u) + key2f(t1[ok ? j : 0] & ~127u);
            a[s] = ok ? ((f2key(sum) & ~255u) | (unsigned)(255 - (i * 16 + j))) : 0u;
        }
        a[13] = 0u; a[14] = 0u; a[15] = 0u;
        bitonic_sort_desc<16>(a);
        merge_top16<1>(a); merge_top16<2>(a);
        float ev[16], sum = 0.f; const float m = key2f(a[0] & ~255u);
#pragma unroll
        for (int j = 0; j < 16; ++j) { ev[j] = __expf(key2f(a[j] & ~255u) - m); sum += ev[j]; }
        const float inv = 1.0f / sum;
        const size_t o = (size_t)(tile * 64 + tk) * 128 + h * 16;
#pragma unroll
        for (int j = 0; j < 16; ++j)
            if ((j >> 2) == q) {
                const int code = 255 - (int)(a[j] & 255u), i = code >> 4, jj = code & 15;
                const int n0 = 127 - (int)(t0[i] & 127u), n1 = 127 - (int)(t1[jj] & 127u);
                EXP[o + j] = n0 * 128 + n1; GATE[o + j] = ev[j] * inv;
            }
    }
    __syncthreads();
}

constexpr int AT_KS = 0, AT_VT = 192 * 72 * 2, AT_BT = AT_VT + 64 * 200 * 2, AT_PW = AT_BT + 4 * 128 * 4, AT_END = AT_PW + 8 * 32 * 72 * 2;
__device__ __forceinline__ void attn_unit(const bf16* __restrict__ PCb, const float* __restrict__ rel_bias, const float* __restrict__ sinks, bf16* __restrict__ ATT, int un, unsigned char* lds) {
    int tid = threadIdx.x; asm volatile("" : "+v"(tid));
    const int lane = tid & 63, wave = __builtin_amdgcn_readfirstlane(tid >> 6), fr = lane & 15, fq = lane >> 4;
    const int kvh = un & 3, qblk = (un >> 2) & 63, b = un >> 8;
    const int q0 = qblk * 64, tb = b * SEQ;
    bf16* Ks = (bf16*)(lds + AT_KS); bf16* Vt = (bf16*)(lds + AT_VT); float* Bt = (float*)(lds + AT_BT); bf16* Pw = (bf16*)(lds + AT_PW) + wave * 32 * 72;
#pragma unroll
    for (int k = 0; k < 3; ++k) {
        const int ci = tid + 512 * k, row = ci >> 3, part = ci & 7, kpos = q0 - 128 + row;
        v4u kv = (v4u){0u, 0u, 0u, 0u}, vv = kv;
        if (kpos >= 0) { const bf16* src = PCb + (size_t)(tb + kpos) * CN + kvh * 64 + part * 8; kv = *(const v4u*)(src + 1024); vv = *(const v4u*)(src + 1280); }
        *(v4u*)(Ks + row * 72 + part * 8) = kv;
        bf16* vd = Vt + (part * 8) * 200 + row;
        vd[0 * 200] = (bf16)(vv.x & 0xffffu); vd[1 * 200] = (bf16)(vv.x >> 16); vd[2 * 200] = (bf16)(vv.y & 0xffffu); vd[3 * 200] = (bf16)(vv.y >> 16);
        vd[4 * 200] = (bf16)(vv.z & 0xffffu); vd[5 * 200] = (bf16)(vv.z >> 16); vd[6 * 200] = (bf16)(vv.w & 0xffffu); vd[7 * 200] = (bf16)(vv.w >> 16);
    }
    Bt[tid] = rel_bias[t5_bucket(tid & 127) * 16 + kvh * 4 + (tid >> 7)];
    __syncthreads();
    const int g = wave >> 1, qs = (wave & 1) * 32, hh = kvh * 4 + g;
    bf16x8_t aQ[2][2];
#pragma unroll
    for (int mt = 0; mt < 2; ++mt)
#pragma unroll
        for (int ks = 0; ks < 2; ++ks) aQ[mt][ks] = *(const bf16x8_t*)(PCb + (size_t)(tb + q0 + qs + mt * 16 + fr) * CN + hh * 64 + ks * 32 + 8 * fq);
    f32x4 sc[2][12];
#pragma unroll
    for (int nt = 0; nt < 12; ++nt) {
        const bf16x8_t b0 = *(const bf16x8_t*)(Ks + (nt * 16 + fr) * 72 + 8 * fq), b1 = *(const bf16x8_t*)(Ks + (nt * 16 + fr) * 72 + 32 + 8 * fq);
#pragma unroll
        for (int mt = 0; mt < 2; ++mt) { f32x4 a = (f32x4){0.f, 0.f, 0.f, 0.f}; a = mfma16(aQ[mt][0], b0, a); a = mfma16(aQ[mt][1], b1, a); sc[mt][nt] = a; }
    }
    const float sink = sinks[hh];
    const float* bt = Bt + g * 128;
#pragma unroll
    for (int mt = 0; mt < 2; ++mt)
#pragma unroll
        for (int r = 0; r < 4; ++r) {
            const int qi = qs + mt * 16 + 4 * fq + r;
            float mx = sink;
#pragma unroll
            for (int nt = 0; nt < 12; ++nt) {
                const int kk = nt * 16 + fr, rel = qi + 128 - kk;
                const bool valid = rel >= 0 && rel < 128 && (q0 - 128 + kk) >= 0;
                const float lg = valid ? sc[mt][nt][r] * 0.125f + bt[valid ? rel : 0] : -INFINITY;
                sc[mt][nt][r] = lg; mx = fmaxf(mx, lg);
            }
            mx = fmaxf(mx, __shfl_xor(mx, 1)); mx = fmaxf(mx, __shfl_xor(mx, 2)); mx = fmaxf(mx, __shfl_xor(mx, 4)); mx = fmaxf(mx, __shfl_xor(mx, 8));
            float sum = 0.f;
#pragma unroll
            for (int nt = 0; nt < 12; ++nt) { const float p = __expf(sc[mt][nt][r] - mx); sc[mt][nt][r] = p; sum += p; }
            sum += __shfl_xor(sum, 1); sum += __shfl_xor(sum, 2); sum += __shfl_xor(sum, 4); sum += __shfl_xor(sum, 8);
            const float inv = 1.0f / (sum + __expf(sink - mx));
#pragma unroll
            for (int nt = 0; nt < 12; ++nt) sc[mt][nt][r] *= inv;
        }
    f32x4 oacc[2][4];
#pragma unroll
    for (int mt = 0; mt < 2; ++mt)
#pragma unroll
        for (int dt = 0; dt < 4; ++dt) oacc[mt][dt] = (f32x4){0.f, 0.f, 0.f, 0.f};
#pragma unroll
    for (int kc = 0; kc < 3; ++kc) {
#pragma unroll
        for (int mt = 0; mt < 2; ++mt)
#pragma unroll
            for (int n4 = 0; n4 < 4; ++n4)
#pragma unroll
                for (int r = 0; r < 4; ++r) Pw[(mt * 16 + 4 * fq + r) * 72 + n4 * 16 + fr] = (bf16)f2bf(sc[mt][kc * 4 + n4][r]);
        asm volatile("s_waitcnt lgkmcnt(0)" ::: "memory");
#pragma unroll
        for (int ks = 0; ks < 2; ++ks) {
            const bf16x8_t p0 = *(const bf16x8_t*)(Pw + fr * 72 + ks * 32 + 8 * fq), p1 = *(const bf16x8_t*)(Pw + (16 + fr) * 72 + ks * 32 + 8 * fq);
#pragma unroll
            for (int dt = 0; dt < 4; ++dt) {
                const bf16x8_t bv = *(const bf16x8_t*)(Vt + (dt * 16 + fr) * 200 + kc * 64 + ks * 32 + 8 * fq);
                oacc[0][dt] = mfma16(p0, bv, oacc[0][dt]); oacc[1][dt] = mfma16(p1, bv, oacc[1][dt]);
            }
        }
        asm volatile("s_waitcnt lgkmcnt(0)" ::: "memory");
    }
#pragma unroll
    for (int mt = 0; mt < 2; ++mt)
#pragma unroll
        for (int dt = 0; dt < 4; ++dt)
#pragma unroll
            for (int r = 0; r < 4; ++r) Pw[(mt * 16 + 4 * fq + r) * 72 + dt * 16 + fr] = (bf16)f2bf(oacc[mt][dt][r]);
    asm volatile("s_waitcnt lgkmcnt(0)" ::: "memory");
#pragma unroll
    for (int k = 0; k < 4; ++k) {
        const int ci = lane + 64 * k, row = ci >> 3, part = ci & 7;
        *(v4u*)(ATT + (size_t)(tb + q0 + qs + row) * D + hh * 64 + part * 8) = *(const v4u*)(Pw + row * 72 + part * 8);
    }
    __syncthreads();
}

__device__ __forceinline__ void swa_attn_sample(const bf16* __restrict__ PCb, const float* __restrict__ cache_k, const float* __restrict__ cache_v,
                                                const float* __restrict__ rel_bias, const float* __restrict__ sinks, bf16* __restrict__ ATT, int gw, int lane) {
    const int sb = gw >> 4, h = gw & 15, kvh = h >> 2, t = NP + sb;
    const bf16* qrow = PCb + (size_t)t * CN + h * 64;
    float lg[2];
#pragma unroll
    for (int rr = 0; rr < 2; ++rr) {
        const int r = lane + 64 * rr;
        float dot = 0.f;
        if (r == 0) {
            const bf16* krow = PCb + (size_t)t * CN + 1024 + kvh * 64;
            for (int d = 0; d < 64; ++d) dot += bf2f(qrow[d]) * bf2f(krow[d]);
        } else {
            const float* krow = cache_k + (((size_t)sb * 128 + (128 - r)) * 4 + kvh) * 64;
#pragma unroll
            for (int d4 = 0; d4 < 16; ++d4) { const float4 kv = *(const float4*)(krow + d4 * 4);
                dot += bf2f(qrow[d4 * 4]) * kv.x + bf2f(qrow[d4 * 4 + 1]) * kv.y + bf2f(qrow[d4 * 4 + 2]) * kv.z + bf2f(qrow[d4 * 4 + 3]) * kv.w; }
        }
        lg[rr] = dot * 0.125f + rel_bias[t5_bucket(r) * 16 + h];
    }
    const float sink = sinks[h];
    const float m = fmaxf(wave_max(fmaxf(lg[0], lg[1])), sink);
    float p[2] = {expf(lg[0] - m), expf(lg[1] - m)};
    const float inv = 1.0f / (wave_sum(p[0] + p[1]) + expf(sink - m));
    float o = 0.f;
#pragma unroll
    for (int rr = 0; rr < 2; ++rr)
        for (int l2 = 0; l2 < 64; ++l2) {
            const int r = l2 + 64 * rr;
            const float pj = __shfl(p[rr], l2);
            const float vv = (r == 0) ? bf2f(PCb[(size_t)t * CN + 1280 + kvh * 64 + lane]) : cache_v[(((size_t)sb * 128 + (128 - r)) * 4 + kvh) * 64 + lane];
            o += pj * vv;
        }
    ATT[(size_t)t * D + h * 64 + lane] = (bf16)f2bf(o * inv);
}
__device__ __forceinline__ void swa_kv_out2(const bf16* __restrict__ PCb, const float* __restrict__ cache_k, const float* __restrict__ cache_v,
                                            float* __restrict__ pk, float* __restrict__ pv, float* __restrict__ sk, float* __restrict__ sv, int vb) {
    int tx_ = threadIdx.x; asm volatile("" : "+v"(tx_));
    const int c = tx_ & 255, row = vb * 2 + (tx_ >> 8);
    if (row < NB * 128) {
        const int b = row >> 7, i = row & 127;
        const bf16* src = PCb + (size_t)(b * SEQ + SEQ - 128 + i) * CN;
        pk[(size_t)row * 256 + c] = bf2f(src[1024 + c]);
        pv[(size_t)row * 256 + c] = bf2f(src[1280 + c]);
    } else {
        const int r2 = row - NB * 128, sb = r2 >> 7, i = r2 & 127;
        if (i < 127) {
            sk[(size_t)r2 * 256 + c] = cache_k[((size_t)sb * 128 + i + 1) * 256 + c];
            sv[(size_t)r2 * 256 + c] = cache_v[((size_t)sb * 128 + i + 1) * 256 + c];
        } else {
            const bf16* src = PCb + (size_t)(NP + sb) * CN;
            sk[(size_t)r2 * 256 + c] = bf2f(src[1024 + c]);
            sv[(size_t)r2 * 256 + c] = bf2f(src[1280 + c]);
        }
    }
}

constexpr size_t MiB = 1u << 20;
constexpr size_t WS_CTL = 0, CTL_ZERO_BYTES = 64 * 1024;
constexpr size_t WS_WAB = 1 * MiB;
constexpr size_t WS_WOUT = WS_WAB + (size_t)ABNP * D * 2;
constexpr size_t WS_WQ0 = WS_WOUT + (size_t)D * D * 2;
constexpr size_t WS_WQ1 = WS_WQ0 + (size_t)2048 * D * 2;
constexpr size_t WS_WINC = WS_WQ1 + (size_t)2048 * D * 2;
constexpr size_t WS_WOUTC = WS_WINC + (size_t)CN * D * 2;
constexpr size_t WS_ABUF = WS_WOUTC + (size_t)D * D * 2;
constexpr size_t WS_P = WS_ABUF + (size_t)MP * D * 2;
constexpr size_t WS_T = WS_P + (size_t)MP * ABN * 2;
constexpr size_t WS_Q = WS_T + (size_t)4 * 16384 * D + (size_t)4 * 16384 * 4;
constexpr size_t WS_A = WS_Q + (size_t)MP * 1536 * 4;
constexpr size_t WS_B = WS_A + (size_t)MP * 512 * 4;
constexpr size_t WS_O = WS_B + (size_t)MP * 512 * 4;
constexpr size_t WS_X1 = WS_O + (size_t)MP * 512 * 4;
constexpr size_t WS_G = WS_X1 + (size_t)MP * D * 4;
constexpr size_t WS_BETA = WS_G + (size_t)MP * 4 * 4;
constexpr size_t WS_GATE = WS_BETA + (size_t)MP * 4 * 4;
constexpr size_t WS_EXP = WS_GATE + (size_t)MP * 128 * 4;
constexpr size_t WS_HEND = WS_EXP + (size_t)MP * 128 * 4;
constexpr size_t WS_KEYS = WS_HEND + (size_t)3 * 4 * 64 * 512 * 4;
constexpr size_t WS_WGT = WS_KEYS + (size_t)2 * 8 * 2 * 128 * 128 * 2;
constexpr size_t WS_END = WS_WGT + (size_t)2 * 8 * 64 * 64 * 2;
constexpr size_t Q_QKVS = 0, Q_W = 1 * MiB, Q_QG = Q_W + 16 * MiB, Q_KDT = Q_QG + 16 * MiB, Q_UT = Q_KDT + 16 * MiB, Q_QK = Q_UT + 16 * MiB, Q_EGL = Q_QK + 8 * MiB, Q_END = Q_EGL + 4096;
static_assert(Q_END <= (size_t)MP * 1536 * 4, "region Q");
static_assert(WS_END <= 512 * MiB, "d_ws map");

struct MegaArgs {
    const float* in[35];
    float* out;
    unsigned char* ws;
};

__global__ void __launch_bounds__(NTH, 2) fwd_megakernel(MegaArgs ma) {
    cg::grid_group grid = cg::this_grid();
    extern __shared__ __attribute__((aligned(16))) unsigned char lds[];
    float* smem = (float*)lds;
    const int nb = gridDim.x, b0 = blockIdx.x, wave = __builtin_amdgcn_readfirstlane(threadIdx.x >> 6);
    int tid = threadIdx.x, lane = tid & 63;
    const float* x_prompt = ma.in[0];
    const float* x_sample = ma.in[1];
    const float* state_gdn = ma.in[2];
    const float* state_gdn_conv = ma.in[3];
    const float* state_lru = ma.in[4];
    const float* state_lru_conv = ma.in[5];
    const float* cache_k = ma.in[6];
    const float* cache_v = ma.in[7];
    const float* w_in_ab = ma.in[8];
    const float* gdn_conv_w = ma.in[9];
    const float* gdn_a_log = ma.in[10];
    const float* gdn_dt_bias = ma.in[11];
    const float* gdn_norm_w = ma.in[12];
    const float* lru_conv_w = ma.in[13];
    const float* lru_conv_b = ma.in[14];
    const float* lru_w_r = ma.in[15];
    const float* lru_b_r = ma.in[16];
    const float* lru_w_i = ma.in[17];
    const float* lru_b_i = ma.in[18];
    const float* lru_lam = ma.in[19];
    const float* w_out_ab = ma.in[20];
    const float* w_in_c = ma.in[21];
    const float* b_in_c = ma.in[22];
    const float* swa_sinks = ma.in[23];
    const float* w_out_c = ma.in[24];
    const float* b_out_c = ma.in[25];
    const float* rel_bias = ma.in[26];
    const float* ln_mix_g = ma.in[27];
    const float* ln_mix_b = ma.in[28];
    const float* ln_ffn_g = ma.in[29];
    const float* ln_ffn_b = ma.in[30];
    const float* peer_w_q = ma.in[31];
    const float* peer_keys = ma.in[32];
    const float* peer_u = ma.in[33];
    const float* peer_v = ma.in[34];

    float* out = ma.out;
    float* o_y = out;
    float* o_p_gdn = out + (size_t)NT * D;
    float* o_p_gdn_conv = o_p_gdn + 262144;
    float* o_p_lru = o_p_gdn_conv + 18432;
    float* o_p_lru_conv = o_p_lru + 2048;
    float* o_p_k = o_p_lru_conv + 6144;
    float* o_p_v = o_p_k + 131072;
    float* o_s_gdn = o_p_v + 131072;
    float* o_s_gdn_conv = o_s_gdn + 8388608;
    float* o_s_lru = o_s_gdn_conv + 589824;
    float* o_s_lru_conv = o_s_lru + 65536;
    float* o_s_k = o_s_lru_conv + 196608;
    float* o_s_v = o_s_k + 4194304;

    unsigned char* ws = ma.ws;
    bf16* WAB_T = (bf16*)(ws + WS_WAB); bf16* WOUT_T = (bf16*)(ws + WS_WOUT); bf16* WQ0_T = (bf16*)(ws + WS_WQ0); bf16* WQ1_T = (bf16*)(ws + WS_WQ1);
    bf16* WINC_T = (bf16*)(ws + WS_WINC); bf16* WOUTC_T = (bf16*)(ws + WS_WOUTC);
    bf16* ABUF = (bf16*)(ws + WS_ABUF);
    bf16* PROJ = (bf16*)(ws + WS_P); float* Y = (float*)(ws + WS_P); bf16* Qb = (bf16*)(ws + WS_P); bf16* PCb = (bf16*)(ws + WS_P); float* Y1 = (float*)(ws + WS_P);
    unsigned char* TAB8 = ws + WS_T; float* TSC = (float*)(ws + WS_T + (size_t)4 * 16384 * D);
    float* R_Q = (float*)(ws + WS_Q + Q_QKVS) - (size_t)NP * 1536; float* X2 = (float*)(ws + WS_A);
    GdnChunkBufs cbuf; cbuf.W = (bf16*)(ws + WS_Q + Q_W); cbuf.QG = (bf16*)(ws + WS_Q + Q_QG); cbuf.KDT = (bf16*)(ws + WS_Q + Q_KDT); cbuf.UT = (bf16*)(ws + WS_Q + Q_UT); cbuf.QK = (bf16*)(ws + WS_Q + Q_QK); cbuf.EGL = (float*)(ws + WS_Q + Q_EGL);
    bf16* KEYSB = (bf16*)(ws + WS_KEYS); bf16* WRT = (bf16*)(ws + WS_WGT); bf16* WIT = WRT + 8 * 64 * 64;
    float* HEND = (float*)(ws + WS_HEND); float* PEND = HEND + 4 * 64 * 512; float* CIN = PEND + 4 * 64 * 512;
    float* R_A = (float*)(ws + WS_A); float* R_B = (float*)(ws + WS_B); float* R_O = (float*)(ws + WS_O);
    float* R_X1 = (float*)(ws + WS_X1); float* X3 = R_X1;
    float* R_G = (float*)(ws + WS_G); float* R_BETA = (float*)(ws + WS_BETA); float* R_GATE = (float*)(ws + WS_GATE); int* R_EXP = (int*)(ws + WS_EXP);

    for (int u = tid; u < (LDS_BYTES - RING_BYTES) / 4; u += NTH) ((unsigned*)(lds + RING_BYTES))[u] = 0u;
    __syncthreads();
    XcdBarrier bar = xcd_barrier_post((unsigned*)(ws + WS_CTL), (volatile LAS unsigned*)((LAS unsigned char*)lds + MISC_OFF) + 8);
#define GRID_BAR() do { xcd_barrier(bar); asm volatile("" : "+v"(tid)); lane = tid & 63; } while (0)
#define PHASE_LOOP(n) for (int vb = b0; vb < (n); vb += nb)
#define PHASE_END __syncthreads()
#define GEMM_PHASE(EPI, Aptr, Btptr, Nn, ...) do { pg8::Gemm g_{(const pg8::bf16_t*)(Aptr), (const pg8::bf16_t*)(Btptr), MP, (Nn), D}; pg8::StaticOrder S_; S_.init(MP, (Nn), nb, b0); \
        pg8::EPI E_{__VA_ARGS__}; pg8::gemm_phase<pg8::EPI, pg8::StaticOrder, true, true>((PG8_LAS unsigned char*)lds, g_, S_, E_); } while (0)

    {
        float* scr = smem + wave * 4096;
        const int gw = b0 * NWAVES + wave, NGW = nb * NWAVES;
        constexpr int I_AB = 16 * 97, I_OUT = 16 * 32, I_Q = 16 * 64, I_INC = 16 * 48;
        constexpr int NITEMS = I_AB + I_OUT + 2 * I_Q + I_INC + I_OUT;
        for (int it = gw; it < NITEMS; it += NGW) {
            int r = it;
            if (r < I_AB) { p0_transpose_item(w_in_ab, D, ABN, WAB_T, scr, r, lane); continue; } r -= I_AB;
            if (r < I_OUT) { p0_transpose_item(w_out_ab, D, D, WOUT_T, scr, r, lane); continue; } r -= I_OUT;
            if (r < I_Q) { p0_transpose_item(peer_w_q, D, 2048, WQ0_T, scr, r, lane); continue; } r -= I_Q;
            if (r < I_Q) { p0_transpose_item(peer_w_q + (size_t)D * 2048, D, 2048, WQ1_T, scr, r, lane); continue; } r -= I_Q;
            if (r < I_INC) { p0_transpose_item(w_in_c, D, CN, WINC_T, scr, r, lane); continue; } r -= I_INC;
            p0_transpose_item(w_out_c, D, D, WOUTC_T, scr, r, lane);
        }
        for (int it = b0 * NTH + tid; it < 2 * 8 * 64 * 8; it += nb * NTH) {
            const int gsel = it >> 12, nn = (it >> 9) & 7, dd = (it >> 3) & 63, c8 = (it & 7) * 8;
            const float* wsrc = (gsel ? lru_w_i : lru_w_r) + ((size_t)nn * 64 + c8) * 64 + dd;
            v4u o; o.x = pk2(wsrc[0], wsrc[64]); o.y = pk2(wsrc[128], wsrc[192]); o.z = pk2(wsrc[256], wsrc[320]); o.w = pk2(wsrc[384], wsrc[448]);
            *(v4u*)((gsel ? WIT : WRT) + ((size_t)nn * 64 + dd) * 64 + c8) = o;
        }
        for (int m = gw; m < MP + (ABNP - 97 * 32); m += NGW) {
            if (m < MP) row_to_bf16(m < NP ? x_prompt + (size_t)m * D : (m < NT ? x_sample + (size_t)(m - NP) * D : nullptr), ABUF + (size_t)m * D, lane);
            else row_to_bf16(nullptr, WAB_T + (size_t)(97 * 32 + (m - MP)) * D, lane);
        }
    }
    grid.sync();
    GEMM_PHASE(EpiStoreBf16, ABUF, WAB_T, ABNP, PROJ, ABN, nullptr, NT, ABN);
    GRID_BAR();
    { AbPrepArgs pa;
      pa.PROJ = PROJ; pa.st_gdn_conv = state_gdn_conv; pa.st_lru_conv = state_lru_conv;
      pa.gdn_conv_w = gdn_conv_w; pa.a_log = gdn_a_log; pa.dt_bias = gdn_dt_bias;
      pa.lru_conv_w = lru_conv_w; pa.lru_conv_b = lru_conv_b; pa.w_r = lru_w_r; pa.b_r = lru_b_r; pa.w_i = lru_w_i; pa.b_i = lru_b_i; pa.lam = lru_lam;
      pa.QKV = R_Q; pa.G = R_G; pa.BETA = R_BETA; pa.LA = R_A; pa.LB = R_B;
      pa.p_gdn_conv = o_p_gdn_conv; pa.p_lru_conv = o_p_lru_conv; pa.s_gdn_conv = o_s_gdn_conv; pa.s_lru_conv = o_s_lru_conv;
#define GDN_UN_A(i_) ((((i_) >> 7) * 64 + (((i_) >> 2) & 31)) * 4 + ((i_) & 3))
      if (b0 < 128) {
          lru_prep_unit2(PROJ, lru_conv_w, lru_conv_b, WRT, WIT, lru_b_r, lru_b_i, lru_lam, R_B, R_A, HEND, PEND, o_p_lru_conv, (b0 >> 5) * 64 + (b0 & 31), lds); PHASE_END;
          gdn_prep_unit(PROJ, gdn_conv_w, gdn_a_log, gdn_dt_bias, cbuf, o_p_gdn_conv, GDN_UN_A(b0), lds);
      } else if (b0 < 256) {
          ab_prep(pa, NP + (b0 - 128), smem); PHASE_END;
          for (int k = 0; k < 3; ++k) gdn_prep_unit(PROJ, gdn_conv_w, gdn_a_log, gdn_dt_bias, cbuf, o_p_gdn_conv, GDN_UN_A(128 + (b0 - 128) * 3 + k), lds);
      } }
    GRID_BAR();
    f32x4 seqS[2]; int seqcur = 0;
    if (b0 < 64) gdn_seq<0, 32>(cbuf, R_O, o_p_gdn, b0 >> 4, (b0 >> 2) & 3, b0 & 3, lds, seqS, seqcur);
    else if (b0 < 192) {
        const int i = b0 - 64;
        lru_prep_unit2(PROJ, lru_conv_w, lru_conv_b, WRT, WIT, lru_b_r, lru_b_i, lru_lam, R_B, R_A, HEND, PEND, o_p_lru_conv, (i >> 5) * 64 + 32 + (i & 31), lds); PHASE_END;
        for (int k = 0; k < 2; ++k) gdn_prep_unit(PROJ, gdn_conv_w, gdn_a_log, gdn_dt_bias, cbuf, o_p_gdn_conv, GDN_UN_A(i * 2 + k) + 32 * 4, lds);
    } else if (b0 < 256) {
        const int i = b0 - 192;
        for (int k = 0; k < 4; ++k) gdn_prep_unit(PROJ, gdn_conv_w, gdn_a_log, gdn_dt_bias, cbuf, o_p_gdn_conv, GDN_UN_A(256 + i * 4 + k) + 32 * 4, lds);
    }
    GRID_BAR();
    if (b0 < 64) gdn_seq<32, 64>(cbuf, R_O, o_p_gdn, b0 >> 4, (b0 >> 2) & 3, b0 & 3, lds, seqS, seqcur);
    else if (b0 < 68) lru_carry(HEND, PEND, CIN, o_p_lru, b0 - 64);
    else {
        for (int v = b0 - 68; v < 2048 + 128; v += nb - 68) {
            if (v < 2048) gdn_scan(R_Q, R_G, R_BETA, state_gdn, R_O, o_s_gdn, NP, 1, v & 3, (v >> 2) & 3, v >> 4, smem);
            else lru_scan(R_A, R_B, state_lru, o_s_lru, NP, 1, NS, v - 2048);
            PHASE_END;
        }
        const int gw2 = (b0 - 68) * NWAVES + wave, NGW2 = (nb - 68) * NWAVES;
        for (int m = gw2; m < 512; m += NGW2) row_to_bf16(peer_keys + (size_t)m * D, KEYSB + (size_t)m * D, lane);
        for (int m = gw2; m < 4 * 16384; m += NGW2) {
            const int k = m >> 14, r = m & 16383;
            row_to_fp8(((k & 1) ? peer_v : peer_u) + ((size_t)(k >> 1) * 16384 + r) * D, TAB8 + (size_t)m * D, TSC + m, lane);
        }
    }
    GRID_BAR();
    PHASE_LOOP(NT / 2) { ab_mix(PROJ, R_O, R_B, R_A, CIN, gdn_norm_w, ABUF, vb); }
    GRID_BAR();
    GEMM_PHASE(EpiStoreF32, ABUF, WOUT_T, D, Y, D, nullptr, NT, D);
    GRID_BAR();
    PHASE_LOOP(NT / 8) { const int t = vb * 8 + wave;
        ln_res_w(t < NP ? x_prompt + (size_t)t * D : x_sample + (size_t)(t - NP) * D, Y + (size_t)t * D, ln_mix_g, ln_mix_b, R_X1 + (size_t)t * D, ABUF + (size_t)t * D, lane); }
    GRID_BAR();
    GEMM_PHASE(EpiStoreBf16, ABUF, WQ0_T, 2048, Qb, 2048, nullptr, NT, 2048);
    GRID_BAR();
    if ((nb & 7) == 0) { peer_topk_stage_keys(KEYSB, b0 & 7, lds); PHASE_LOOP((NT / 64) * 8) { peer_topk4(Qb, R_EXP, R_GATE, vb >> 3, vb & 7, lds); } }
    else PHASE_LOOP((NT / 64) * 8) { peer_topk_stage_keys(KEYSB, vb & 7, lds); peer_topk4(Qb, R_EXP, R_GATE, vb >> 3, vb & 7, lds); }
    GRID_BAR();
    PHASE_LOOP(NP / 8 + NS) { const int t = vb < NP / 8 ? vb * 8 + wave : NP + (vb - NP / 8);
        if (vb < NP / 8) peer_expert_w(R_X1 + (size_t)t * D, R_EXP + (size_t)t * 128, R_GATE + (size_t)t * 128, TAB8, TAB8 + (size_t)16384 * D, TSC, TSC + 16384, ln_ffn_g, ln_ffn_b, X2 + (size_t)t * D, ABUF + (size_t)t * D, lane);
        else peer_expert_blk(R_X1 + (size_t)t * D, R_EXP + (size_t)t * 128, R_GATE + (size_t)t * 128, TAB8, TAB8 + (size_t)16384 * D, TSC, TSC + 16384, ln_ffn_g, ln_ffn_b, X2 + (size_t)t * D, ABUF + (size_t)t * D, lane, wave, smem); }
    GRID_BAR();

    GEMM_PHASE(EpiStoreBf16, ABUF, WINC_T, CN, PCb, CN, b_in_c, NT, CN);
    GRID_BAR();
    PHASE_LOOP(1024 + 256 + (NB * 128 + NS * 128) / 2) {
        if (vb < 1024) attn_unit(PCb, rel_bias, swa_sinks, ABUF, vb, lds);
        else if (vb < 1280) swa_attn_sample(PCb, cache_k, cache_v, rel_bias, swa_sinks, ABUF, (vb - 1024) * 8 + wave, lane);
        else swa_kv_out2(PCb, cache_k, cache_v, o_p_k, o_p_v, o_s_k, o_s_v, vb - 1280);
    }
    GRID_BAR();
    GEMM_PHASE(EpiStoreF32, ABUF, WOUTC_T, D, Y1, D, b_out_c, NT, D);
    GRID_BAR();
    PHASE_LOOP(NT / 8) { const int t = vb * 8 + wave;
        ln_res_w(X2 + (size_t)t * D, Y1 + (size_t)t * D, ln_mix_g + D, ln_mix_b + D, X3 + (size_t)t * D, ABUF + (size_t)t * D, lane); }
    GRID_BAR();
    GEMM_PHASE(EpiStoreBf16, ABUF, WQ1_T, 2048, Qb, 2048, nullptr, NT, 2048);
    GRID_BAR();
    if ((nb & 7) == 0) { peer_topk_stage_keys(KEYSB + (size_t)8 * 2 * 128 * 128, b0 & 7, lds); PHASE_LOOP((NT / 64) * 8) { peer_topk4(Qb, R_EXP, R_GATE, vb >> 3, vb & 7, lds); } }
    else PHASE_LOOP((NT / 64) * 8) { peer_topk_stage_keys(KEYSB + (size_t)8 * 2 * 128 * 128, vb & 7, lds); peer_topk4(Qb, R_EXP, R_GATE, vb >> 3, vb & 7, lds); }
    GRID_BAR();
    PHASE_LOOP(NP / 8 + NS) { const int t = vb < NP / 8 ? vb * 8 + wave : NP + (vb - NP / 8);
        if (vb < NP / 8) peer_expert_w(X3 + (size_t)t * D, R_EXP + (size_t)t * 128, R_GATE + (size_t)t * 128, TAB8 + (size_t)2 * 16384 * D, TAB8 + (size_t)3 * 16384 * D, TSC + 2 * 16384, TSC + 3 * 16384, ln_ffn_g + D, ln_ffn_b + D, o_y + (size_t)t * D, nullptr, lane);
        else peer_expert_blk(X3 + (size_t)t * D, R_EXP + (size_t)t * 128, R_GATE + (size_t)t * 128, TAB8 + (size_t)2 * 16384 * D, TAB8 + (size_t)3 * 16384 * D, TSC + 2 * 16384, TSC + 3 * 16384, ln_ffn_g + D, ln_ffn_b + D, o_y + (size_t)t * D, nullptr, lane, wave, smem); }
}
}

extern "C" void kernel_launch(void* const* d_in, const int* in_sizes, int n_in,
                              void* d_out, int out_size, void* d_ws, size_t ws_size,
                              hipStream_t stream) {
    static int grid_blocks = 0;
    if (!grid_blocks) {
        int dev = 0, cus = 0, per_cu = 0;
        (void)hipGetDevice(&dev);
        (void)hipDeviceGetAttribute(&cus, hipDeviceAttributeMultiprocessorCount, dev);
        if (hipFuncSetAttribute((const void*)fwd_megakernel, hipFuncAttributeMaxDynamicSharedMemorySize, LDS_BYTES) != hipSuccess) { fprintf(stderr, "hipFuncSetAttribute failed\n"); grid_blocks = -1; return; }
        (void)hipOccupancyMaxActiveBlocksPerMultiprocessor(&per_cu, (const void*)fwd_megakernel, NTH, LDS_BYTES);
        if (per_cu < 1) { fprintf(stderr, "occupancy query says %d blocks per CU\n", per_cu); grid_blocks = -1; return; }
        grid_blocks = cus;
    }
    if (grid_blocks < 0) return;
    (void)hipMemsetAsync((char*)d_ws + WS_CTL, 0, CTL_ZERO_BYTES, stream);
    MegaArgs ma{};
    for (int i = 0; i < 35; ++i) ma.in[i] = (const float*)d_in[i];
    ma.out = (float*)d_out;
    ma.ws = (unsigned char*)d_ws;
    void* args[] = {&ma};
    hipError_t e = hipLaunchCooperativeKernel((void*)fwd_megakernel, dim3(grid_blocks), dim3(NTH), args, LDS_BYTES, stream);
    if (e != hipSuccess) fprintf(stderr, "cooperative launch failed: %s (grid %d)\n", hipGetErrorString(e), grid_blocks);
}
```

```cpp
#include <hip/hip_runtime.h>
#include <hip/hip_cooperative_groups.h>
#include <cstdio>
#include <cstdint>
namespace cg = cooperative_groups;

namespace pg8 {
#define PG8_LAS __attribute__((address_space(3)))
typedef unsigned short bf16_t;
typedef short bf16x8 __attribute__((ext_vector_type(8)));
typedef float f32x4 __attribute__((ext_vector_type(4)));
typedef unsigned u32x4 __attribute__((ext_vector_type(4)));
constexpr int BM = 256, BK = 64, HALF = 128, HTB = HALF * BK * 2  , STAGE_BYTES = 8 * HTB, NXCD = 8, WGM = 8;

__host__ __device__ __forceinline__ int lds_byte(int r, int c) { const int st = (r >> 4) * 2 + (c >> 5), rr = r & 15, cc = c & 31, ob = rr * 64 + cc * 2; return st * 1024 + (ob ^ (((ob >> 9) & 1) << 5)); }
__host__ __device__ __forceinline__ void stage_rc(int b, int& R, int& C) { const int st = b / 1024, sb = b % 1024, swz = sb ^ (((sb >> 9) & 1) << 5); R = (st >> 1) * 16 + swz / 64; C = (st & 1) * 32 + (swz % 64) / 2; }
__host__ __device__ __forceinline__ int perm32(int rho) { const int n = rho >> 4, i = rho & 15; return 8 * (i >> 2) + 4 * n + (i & 3); }

struct Unit { int pm, pn; };
struct Gemm { const bf16_t* A; const bf16_t* Bt; int M, N, K; };

struct StaticOrder {
    int nM, nN, nwg, G, c;
    __host__ __device__ void init(int M, int N, int G_, int c_) { nM = M / BM; nN = N / BM; nwg = nM * nN; G = G_; c = c_; }
    __host__ __device__ bool next(int i, Unit& u) const {
        const long L = (long)i * G + c; if (L >= nwg) return false;
        int wgid = (int)L; { const int q = nwg / NXCD, r = nwg % NXCD, xcd = wgid % NXCD, off = wgid / NXCD; wgid = (xcd < r ? xcd * (q + 1) : r * (q + 1) + (xcd - r) * q) + off; }
        const int nig = WGM * nN, gid = wgid / nig, fm = gid * WGM, gsz = (nM - fm) < WGM ? (nM - fm) : WGM;
        u.pm = fm + ((wgid % nig) % gsz); u.pn = (wgid % nig) / gsz; return true;
    }
    __device__ __forceinline__ void a_ready(const Unit&) const {}
    __device__ __forceinline__ void done(const Unit&) const {}
};

__device__ __forceinline__ unsigned cvt_pk_bf16(float lo, float hi) { unsigned r; asm volatile("v_cvt_pk_bf16_f32 %0, %1, %2" : "=v"(r) : "v"(lo), "v"(hi)); return r; }
template <class Epi, class Sched, bool ALIGN_EPI = false, bool SP2 = false>
__device__ __forceinline__ void gemm_phase(PG8_LAS unsigned char* lds, const Gemm g, const Sched& S, const Epi& E) {
    int tid_ = threadIdx.x; asm volatile("" : "+v"(tid_));
    const int tid = tid_, wid = __builtin_amdgcn_readfirstlane(tid >> 6), lane = tid & 63, wr = wid >> 2, wc = wid & 3, fr = lane & 15, fq = lane >> 4;
    const int K = g.K, nt = K / BK;
    unsigned voffA[2], voffB[2];
#pragma unroll
    for (int i = 0; i < 2; ++i) { int R, C; stage_rc(tid * 16 + i * 8192, R, C); const int Rb = Epi::PERM ? ((R & ~31) + perm32(R & 31)) : R;
        voffA[i] = (unsigned)(R * K + C) * 2u; voffB[i] = (unsigned)(Rb * K + C) * 2u; }
    const size_t kstep = (size_t)(BK * 2);
    const size_t hstep = (size_t)HALF * K * 2;
    const size_t tstep = 2 * hstep;
    const unsigned ldsw = (unsigned)wid * 1024u;
    const int aoff = lds_byte(wr * 64 + fr, fq * 8), boff = lds_byte(wc * 32 + fr, fq * 8);
#define PG8_SA(b, h) (((b) * 2 + (h)) * HTB)
#define PG8_SB(b, h) ((4 + (b) * 2 + (h)) * HTB)
#define PG8_STAGE(bufoff, gbase, voff) do { _Pragma("unroll") for (int _i = 0; _i < 2; ++_i) \
        __builtin_amdgcn_global_load_lds((const unsigned*)((const char*)(gbase) + (voff)[_i]), (PG8_LAS unsigned*)(lds + (bufoff) + ldsw + _i * 8192), 16, 0, 0); } while (0)
#define PG8_LDA(dst, b, h) do { _Pragma("unroll") for (int m = 0; m < 4; ++m) _Pragma("unroll") for (int k = 0; k < 2; ++k) dst[m][k] = *(const PG8_LAS bf16x8*)(lds + PG8_SA(b, h) + aoff + m * 2048 + k * 1024); } while (0)
#define PG8_LDB(dst, b, h) do { _Pragma("unroll") for (int n = 0; n < 2; ++n) _Pragma("unroll") for (int k = 0; k < 2; ++k) dst[n][k] = *(const PG8_LAS bf16x8*)(lds + PG8_SB(b, h) + boff + n * 2048 + k * 1024); } while (0)
#define PG8_MMA(ai, bj, At, Bt) do { __builtin_amdgcn_s_setprio(1); _Pragma("unroll") for (int m = 0; m < 4; ++m) _Pragma("unroll") for (int n = 0; n < 2; ++n) _Pragma("unroll") for (int k = 0; k < 2; ++k) \
        acc[ai][bj][m][n] = __builtin_amdgcn_mfma_f32_16x16x32_bf16(Bt[n][k], At[m][k], acc[ai][bj][m][n], 0, 0, 0); __builtin_amdgcn_s_setprio(0); } while (0)
#define PG8_WAIT_V(n) asm volatile("s_waitcnt vmcnt(" #n ")" ::: "memory")
#define PG8_WAIT_L(n) asm volatile("s_waitcnt lgkmcnt(" #n ")" ::: "memory")
#define PG8_BAR __builtin_amdgcn_s_barrier()
#define PG8_SCHED __builtin_amdgcn_sched_barrier(0)
    Unit cur, nxt; int ui = 0;
    if (!S.next(0, cur)) return;
    f32x4 acc[2][2][4][2];
#pragma unroll
    for (int a = 0; a < 2; ++a)
#pragma unroll
        for (int b = 0; b < 2; ++b)
#pragma unroll
            for (int m = 0; m < 4; ++m)
#pragma unroll
                for (int n = 0; n < 2; ++n) acc[a][b][m][n] = (f32x4){0.f, 0.f, 0.f, 0.f};
    bf16x8 At[4][2], B0[2][2], B1[2][2];
    const char* cA = (const char*)g.A + (size_t)cur.pm * tstep; const char* cB = (const char*)g.Bt + (size_t)cur.pn * tstep;
    S.a_ready(cur);
    if constexpr (SP2) {
        PG8_STAGE(PG8_SB(0, 0), cB, voffB); PG8_STAGE(PG8_SB(0, 1), cB + hstep, voffB); PG8_STAGE(PG8_SA(0, 0), cA, voffA); PG8_STAGE(PG8_SA(0, 1), cA + hstep, voffA);
        if (wr == 1) PG8_BAR;
        PG8_WAIT_V(2); PG8_BAR;
        PG8_STAGE(PG8_SB(1, 0), cB + kstep, voffB); PG8_STAGE(PG8_SA(1, 0), cA + kstep, voffA); PG8_STAGE(PG8_SB(1, 1), cB + hstep + kstep, voffB);
        PG8_WAIT_V(6); PG8_BAR;
    } else {
        PG8_STAGE(PG8_SB(0, 0), cB, voffB); PG8_STAGE(PG8_SA(0, 0), cA, voffA); PG8_STAGE(PG8_SB(0, 1), cB + hstep, voffB); PG8_STAGE(PG8_SA(0, 1), cA + hstep, voffA);
        if (wr == 1) PG8_BAR;
        PG8_WAIT_V(4); PG8_BAR;
        PG8_STAGE(PG8_SB(1, 0), cB + kstep, voffB); PG8_STAGE(PG8_SA(1, 0), cA + kstep, voffA); PG8_STAGE(PG8_SB(1, 1), cB + hstep + kstep, voffB);
        PG8_WAIT_V(6); PG8_BAR;
    }
    for (;;) {
        const bool has_next = S.next(ui + 1, nxt);
        const char* nA = has_next ? (const char*)g.A + (size_t)nxt.pm * tstep : cA; const char* nB = has_next ? (const char*)g.Bt + (size_t)nxt.pn * tstep : cB;
        for (int t = 0; t < nt; t += 2) {
            const bool last = (t == nt - 2);
            const char* a1 = cA + (size_t)(t + 1) * kstep;
            const char* a2 = last ? nA : cA + (size_t)(t + 2) * kstep; const char* b2 = last ? nB : cB + (size_t)(t + 2) * kstep;
            const char* a3 = a2 + kstep; const char* b3 = b2 + kstep;
            if (last && has_next) S.a_ready(nxt);
            if constexpr (SP2) {
            PG8_LDB(B0, 0, 0); PG8_LDB(B1, 0, 1); PG8_SCHED; PG8_LDA(At, 0, 0); PG8_STAGE(PG8_SA(1, 1), a1 + hstep, voffA);
            PG8_WAIT_V(8); PG8_WAIT_L(0); PG8_BAR; PG8_MMA(0, 0, At, B0); PG8_MMA(0, 1, At, B1); PG8_BAR; PG8_SCHED;
            PG8_LDA(At, 0, 1); PG8_STAGE(PG8_SB(0, 0), b2, voffB); PG8_STAGE(PG8_SB(0, 1), b2 + hstep, voffB); PG8_STAGE(PG8_SA(0, 0), a2, voffA);
            PG8_WAIT_V(8); PG8_WAIT_L(0); PG8_BAR; PG8_MMA(1, 0, At, B0); PG8_MMA(1, 1, At, B1); PG8_BAR; PG8_SCHED;
            PG8_LDB(B0, 1, 0); PG8_LDB(B1, 1, 1); PG8_SCHED; PG8_LDA(At, 1, 0); PG8_STAGE(PG8_SA(0, 1), a2 + hstep, voffA);
            PG8_WAIT_V(8); PG8_WAIT_L(0); PG8_BAR; PG8_MMA(0, 0, At, B0); PG8_MMA(0, 1, At, B1); PG8_BAR; PG8_SCHED;
            PG8_LDA(At, 1, 1); PG8_STAGE(PG8_SB(1, 0), b3, voffB); PG8_STAGE(PG8_SB(1, 1), b3 + hstep, voffB); PG8_STAGE(PG8_SA(1, 0), a3, voffA);
            PG8_WAIT_V(8); PG8_WAIT_L(0); PG8_BAR; PG8_MMA(1, 0, At, B0); PG8_MMA(1, 1, At, B1); PG8_BAR; PG8_SCHED;
            } else {
            PG8_LDB(B0, 0, 0); PG8_SCHED; PG8_LDA(At, 0, 0); PG8_STAGE(PG8_SA(1, 1), a1 + hstep, voffA);
            PG8_WAIT_L(8); PG8_BAR; PG8_WAIT_L(0); PG8_MMA(0, 0, At, B0); PG8_BAR; PG8_SCHED;
            PG8_LDB(B1, 0, 1); PG8_STAGE(PG8_SB(0, 0), b2, voffB);
            PG8_BAR; PG8_WAIT_L(0); PG8_MMA(0, 1, At, B1); PG8_BAR;
            PG8_LDA(At, 0, 1); PG8_STAGE(PG8_SA(0, 0), a2, voffA);
            PG8_BAR; PG8_WAIT_L(0); PG8_MMA(1, 0, At, B0); PG8_BAR; PG8_SCHED;
            PG8_STAGE(PG8_SB(0, 1), b2 + hstep, voffB);
            PG8_WAIT_V(6); PG8_BAR; PG8_MMA(1, 1, At, B1); PG8_BAR;
            PG8_LDB(B0, 1, 0); PG8_SCHED; PG8_LDA(At, 1, 0); PG8_STAGE(PG8_SA(0, 1), a2 + hstep, voffA);
            PG8_WAIT_L(8); PG8_BAR; PG8_WAIT_L(0); PG8_MMA(0, 0, At, B0); PG8_BAR; PG8_SCHED;
            PG8_LDB(B1, 1, 1); PG8_STAGE(PG8_SB(1, 0), b3, voffB);
            PG8_BAR; PG8_WAIT_L(0); PG8_MMA(0, 1, At, B1); PG8_BAR;
            PG8_LDA(At, 1, 1); PG8_STAGE(PG8_SA(1, 0), a3, voffA);
            PG8_BAR; PG8_WAIT_L(0); PG8_MMA(1, 0, At, B0); PG8_BAR; PG8_SCHED;
            PG8_STAGE(PG8_SB(1, 1), b3 + hstep, voffB);
            PG8_WAIT_V(6); PG8_BAR; PG8_MMA(1, 1, At, B1); PG8_BAR;
            }
        }
        if constexpr (ALIGN_EPI) { if (wr == 0) PG8_BAR; }
        if constexpr (!Epi::AFTER_DRAIN) { E(acc, cur, wr, wc, fr, fq); S.done(cur); }
        if (!has_next) break;
#pragma unroll
        for (int a = 0; a < 2; ++a)
#pragma unroll
            for (int b = 0; b < 2; ++b)
#pragma unroll
                for (int m = 0; m < 4; ++m)
#pragma unroll
                    for (int n = 0; n < 2; ++n) acc[a][b][m][n] = (f32x4){0.f, 0.f, 0.f, 0.f};
        cur = nxt; cA = nA; cB = nB; ++ui;
        if constexpr (ALIGN_EPI) { if (wr == 1) PG8_BAR; }
    }
    PG8_WAIT_V(0);
    if constexpr (!ALIGN_EPI) { if (wr == 0) PG8_BAR; }
    PG8_BAR;
    if constexpr (Epi::AFTER_DRAIN) { E.fused(acc, cur, wr, wc, fr, fq, lds, wid, lane); S.done(cur); }
#undef PG8_SA
#undef PG8_SB
#undef PG8_STAGE
#undef PG8_LDA
#undef PG8_LDB
#undef PG8_MMA
#undef PG8_WAIT_V
#undef PG8_WAIT_L
#undef PG8_BAR
#undef PG8_SCHED
}
}
namespace pg8 {
struct EpiStoreBf16 {
    static constexpr bool PERM = true, AFTER_DRAIN = false;
    bf16_t* O; int ldc; const float* bias; int m_real, n_real;
    __device__ __forceinline__ void operator()(const f32x4 (&acc)[2][2][4][2], const Unit& u, int wr, int wc, int fr, int fq) const {
        const int row0 = u.pm * BM + wr * 64 + fr, col0 = u.pn * BM + wc * 32 + 8 * fq;
#pragma unroll
        for (int bj = 0; bj < 2; ++bj) {
            const int col = col0 + bj * HALF;
            if (col >= n_real) continue;
            f32x4 b0 = (f32x4){0.f, 0.f, 0.f, 0.f}, b1 = b0;
            if (bias) { b0 = *(const f32x4*)(bias + col); b1 = *(const f32x4*)(bias + col + 4); }
#pragma unroll
            for (int ai = 0; ai < 2; ++ai)
#pragma unroll
                for (int m = 0; m < 4; ++m) {
                    const int row = row0 + ai * HALF + m * 16;
                    if (row >= m_real) continue;
                    const f32x4 v0 = acc[ai][bj][m][0] + b0, v1 = acc[ai][bj][m][1] + b1;
                    u32x4 w; w.x = cvt_pk_bf16(v0[0], v0[1]); w.y = cvt_pk_bf16(v0[2], v0[3]); w.z = cvt_pk_bf16(v1[0], v1[1]); w.w = cvt_pk_bf16(v1[2], v1[3]);
                    *(u32x4*)(O + (size_t)row * ldc + col) = w;
                }
        }
    }
};
struct EpiStoreF32 {
    static constexpr bool PERM = false, AFTER_DRAIN = false;
    float* O; int ldc; const float* bias; int m_real, n_real;
    __device__ __forceinline__ void operator()(const f32x4 (&acc)[2][2][4][2], const Unit& u, int wr, int wc, int fr, int fq) const {
        const int row0 = u.pm * BM + wr * 64 + fr, col0 = u.pn * BM + wc * 32 + 4 * fq;
#pragma unroll
        for (int bj = 0; bj < 2; ++bj)
#pragma unroll
            for (int n = 0; n < 2; ++n) {
                const int col = col0 + bj * HALF + n * 16;
                if (col >= n_real) continue;
                const f32x4 bv = bias ? *(const f32x4*)(bias + col) : (f32x4){0.f, 0.f, 0.f, 0.f};
#pragma unroll
                for (int ai = 0; ai < 2; ++ai)
#pragma unroll
                    for (int m = 0; m < 4; ++m) {
                        const int row = row0 + ai * HALF + m * 16;
                        if (row >= m_real) continue;
                        *(f32x4*)(O + (size_t)row * ldc + col) = acc[ai][bj][m][n] + bv;
                    }
            }
    }
};
}
namespace {
#define GAS __attribute__((address_space(1)))
#define LAS __attribute__((address_space(3)))
typedef unsigned short bf16;
typedef float f32x4 __attribute__((ext_vector_type(4)));
typedef unsigned v4u __attribute__((ext_vector_type(4)));
typedef unsigned v2u __attribute__((ext_vector_type(2)));

constexpr int D = 1024, NB = 4, SEQ = 4096, NP = NB * SEQ, NS = 128, NT = NP + NS, MP = 16640;
constexpr int ABN = 3080, ABNP = 3328;
constexpr int C_QKV = 0, C_Z = 1536, C_A = 2048, C_B = 2052, C_XR = 2056, C_GATE = 2568;
constexpr int CN = 1536;
constexpr float ALPHA = 1.4142135623730951f;
constexpr float LN_EPS = 1e-5f;
constexpr int NTH = 512, NWAVES = 8;
constexpr int RING_BYTES = 143360, MISC_OFF = RING_BYTES + 320, LDS_BYTES = 147456;

__device__ __forceinline__ float bf2f(bf16 v) { return __uint_as_float((unsigned)v << 16); }
__device__ __forceinline__ unsigned f2bf(float f) { unsigned u = __float_as_uint(f); return (u + 0x7fffu + ((u >> 16) & 1u)) >> 16; }
__device__ __forceinline__ unsigned pk2(float lo, float hi) { return f2bf(lo) | (f2bf(hi) << 16); }
__device__ __forceinline__ float sigmoidf_(float x) { return 1.0f / (1.0f + expf(-x)); }
__device__ __forceinline__ float softplusf_(float x) { return fmaxf(x, 0.f) + log1pf(expf(-fabsf(x))); }
__device__ __forceinline__ float siluf_(float x) { return x / (1.0f + expf(-x)); }
__device__ __forceinline__ float geluf_(float x) { return 0.5f * x * (1.0f + tanhf(0.7978845608028654f * (x + 0.044715f * x * x * x))); }
#define DPPF(v_, ctrl_, rmask_) __int_as_float(__builtin_amdgcn_update_dpp(0, __float_as_int(v_), (ctrl_), (rmask_), 0xf, false))
__device__ __forceinline__ float wave_sum(float v) {
    v += DPPF(v, 0xB1, 0xf); v += DPPF(v, 0x4E, 0xf); v += DPPF(v, 0x141, 0xf); v += DPPF(v, 0x140, 0xf);
    v += DPPF(v, 0x142, 0xa); v += DPPF(v, 0x143, 0xc);
    return __int_as_float(__builtin_amdgcn_readlane(__float_as_int(v), 63));
}
__device__ __forceinline__ float wave_max(float v) {
    v = fmaxf(v, DPPF(v, 0xB1, 0xf)); v = fmaxf(v, DPPF(v, 0x4E, 0xf)); v = fmaxf(v, DPPF(v, 0x141, 0xf)); v = fmaxf(v, DPPF(v, 0x140, 0xf));
    { const float t = __int_as_float(__builtin_amdgcn_update_dpp(__float_as_int(v), __float_as_int(v), 0x142, 0xa, 0xf, false)); v = fmaxf(v, t); }
    { const float t = __int_as_float(__builtin_amdgcn_update_dpp(__float_as_int(v), __float_as_int(v), 0x143, 0xc, 0xf, false)); v = fmaxf(v, t); }
    return __int_as_float(__builtin_amdgcn_readlane(__float_as_int(v), 63));
}

__device__ __forceinline__ void p0_transpose_item(const float* __restrict__ W, int K, int N, bf16* __restrict__ WT, float* scr, int item, int lane) {
    const int nblk = (N + 31) / 32, kb = item / nblk, nb = item % nblk, k0 = 64 * kb, n0 = 32 * nb;
#pragma unroll 8
    for (int i = 0; i < 32; ++i) { const int kk = 2 * i + (lane >> 5), n = n0 + (lane & 31); scr[kk * 33 + (lane & 31)] = n < N ? W[(size_t)(k0 + kk) * N + n] : 0.f; }
    asm volatile("s_waitcnt lgkmcnt(0)" ::: "memory");
    const int c = lane & 7;
#pragma unroll
    for (int j = 0; j < 4; ++j) { const int n = (lane >> 3) + 8 * j; const float* s = scr + (8 * c) * 33 + n;
        v4u o; o.x = pk2(s[0 * 33], s[1 * 33]); o.y = pk2(s[2 * 33], s[3 * 33]); o.z = pk2(s[4 * 33], s[5 * 33]); o.w = pk2(s[6 * 33], s[7 * 33]);
        *(v4u*)(WT + (size_t)(n0 + n) * K + k0 + 8 * c) = o; }
    asm volatile("s_waitcnt lgkmcnt(0)" ::: "memory");
}
__device__ __forceinline__ void row_to_bf16(const float* __restrict__ xrow, bf16* __restrict__ orow, int lane) {
#pragma unroll
    for (int j = 0; j < 4; ++j) {
        f32x4 v = (f32x4){0.f, 0.f, 0.f, 0.f};
        if (xrow) v = ((const f32x4*)xrow)[lane + 64 * j];
        v2u o; o.x = pk2(v.x, v.y); o.y = pk2(v.z, v.w);
        ((v2u*)orow)[lane + 64 * j] = o;
    }
}

struct AbPrepArgs {
    const bf16* PROJ; const float* st_gdn_conv; const float* st_lru_conv;
    const float* gdn_conv_w; const float* a_log; const float* dt_bias;
    const float* lru_conv_w; const float* lru_conv_b; const float* w_r; const float* b_r; const float* w_i; const float* b_i; const float* lam;
    float* QKV; float* G; float* BETA; float* LA; float* LB;
    float* p_gdn_conv; float* p_lru_conv; float* s_gdn_conv; float* s_lru_conv;
};
__device__ __forceinline__ void ab_prep(const AbPrepArgs& a, int t, float* smem) {
    int tid = threadIdx.x; asm volatile("" : "+v"(tid));
    const int lane = tid & 63, wid = tid >> 6;
    const bool samp = t >= NP; const int sb = t - NP, pos = t % SEQ, b = t / SEQ;
    float* sq = smem;
    float* sx = smem + 1536;
    float* scl = smem + 2048;
    const bf16* prow = a.PROJ + (size_t)t * ABN;
    for (int c = tid; c < 1536; c += NTH) {
        float acc = 0.f;
#pragma unroll
        for (int i = 0; i < 4; ++i) {
            float xv;
            if (i == 3) xv = bf2f(prow[C_QKV + c]);
            else if (samp) xv = a.st_gdn_conv[((size_t)sb * 3 + i) * 1536 + c];
            else xv = (pos - 3 + i >= 0) ? bf2f(a.PROJ[(size_t)(t - 3 + i) * ABN + C_QKV + c]) : 0.f;
            acc += a.gdn_conv_w[i * 1536 + c] * xv;
        }
        sq[c] = siluf_(acc);
    }
    {
        const int c = tid;
        float acc = a.lru_conv_b[c];
#pragma unroll
        for (int i = 0; i < 4; ++i) {
            float xv;
            if (i == 3) xv = bf2f(prow[C_XR + c]);
            else if (samp) xv = a.st_lru_conv[((size_t)sb * 3 + i) * 512 + c];
            else xv = (pos - 3 + i >= 0) ? bf2f(a.PROJ[(size_t)(t - 3 + i) * ABN + C_XR + c]) : 0.f;
            acc += a.lru_conv_w[i * 512 + c] * xv;
        }
        sx[c] = acc;
    }
    __syncthreads();
    {
        const int grp = wid;
        const float v0 = sq[grp * 128 + lane], v1 = sq[grp * 128 + 64 + lane];
        const float s = wave_sum(v0 * v0 + v1 * v1);
        if (lane == 0) scl[grp] = rsqrtf(s + 1e-6f) * (grp < 4 ? 0.08838834764831845f : 1.0f);
    }
    __syncthreads();
    for (int c = tid; c < 1536; c += NTH) a.QKV[(size_t)t * 1536 + c] = (c < 1024) ? sq[c] * scl[c >> 7] : sq[c];
    if (tid < 4) {
        const float a_raw = bf2f(prow[C_A + tid]), b_raw = bf2f(prow[C_B + tid]);
        a.G[(size_t)t * 4 + tid] = -expf(a.a_log[tid]) * softplusf_(a_raw + a.dt_bias[tid]);
        a.BETA[(size_t)t * 4 + tid] = sigmoidf_(b_raw);
    }
    if (!samp) {
        if (pos >= SEQ - 3) {
            const int row = pos - (SEQ - 3);
            for (int c = tid; c < 1536; c += NTH) a.p_gdn_conv[((size_t)b * 3 + row) * 1536 + c] = bf2f(prow[C_QKV + c]);
            a.p_lru_conv[((size_t)b * 3 + row) * 512 + tid] = bf2f(prow[C_XR + tid]);
        }
    } else {
        for (int c = tid; c < 1536; c += NTH) {
            a.s_gdn_conv[((size_t)sb * 3 + 0) * 1536 + c] = a.st_gdn_conv[((size_t)sb * 3 + 1) * 1536 + c];
            a.s_gdn_conv[((size_t)sb * 3 + 1) * 1536 + c] = a.st_gdn_conv[((size_t)sb * 3 + 2) * 1536 + c];
            a.s_gdn_conv[((size_t)sb * 3 + 2) * 1536 + c] = bf2f(prow[C_QKV + c]);
        }
        {
            const int c = tid;
            a.s_lru_conv[((size_t)sb * 3 + 0) * 512 + c] = a.st_lru_conv[((size_t)sb * 3 + 1) * 512 + c];
            a.s_lru_conv[((size_t)sb * 3 + 1) * 512 + c] = a.st_lru_conv[((size_t)sb * 3 + 2) * 512 + c];
            a.s_lru_conv[((size_t)sb * 3 + 2) * 512 + c] = bf2f(prow[C_XR + c]);
        }
    }
    {
        const int c = tid, n = c >> 6, d = c & 63;
        float r = a.b_r[c], ii = a.b_i[c];
#pragma unroll 4
        for (int cc = 0; cc < 64; ++cc) {
            const float xv = sx[n * 64 + cc];
            r += xv * a.w_r[((size_t)n * 64 + cc) * 64 + d];
            ii += xv * a.w_i[((size_t)n * 64 + cc) * 64 + d];
        }
        r = sigmoidf_(r); ii = sigmoidf_(ii);
        const float log_a = -8.0f * r * softplusf_(-a.lam[c]);
        a.LA[(size_t)t * 512 + c] = expf(log_a);
        a.LB[(size_t)t * 512 + c] = sqrtf(-expm1f(2.0f * log_a)) * (ii * sx[c]);
    }
}

__device__ __forceinline__ void gdn_scan(const float* __restrict__ QKV, const float* __restrict__ G, const float* __restrict__ BETA,
                                         const float* __restrict__ S0, float* __restrict__ O, float* __restrict__ Sout, int tok_base, int T,
                                         int sl, int h, int sq, float* smem) {
    int tid = threadIdx.x; asm volatile("" : "+v"(tid));
    const int dvl = tid & 31, kg = tid >> 5;
    const int dv = sl * 32 + dvl;
    float (*red1)[32] = (float (*)[32])smem;
    float (*red2)[32] = (float (*)[32])(smem + 512);
    float S[8];
#pragma unroll
    for (int i = 0; i < 8; ++i) S[i] = S0 ? S0[(((size_t)sq * 4 + h) * 128 + kg * 8 + i) * 128 + dv] : 0.f;
    float kk[8], qq[8], vv, g, be;
    {
        const size_t tok = (size_t)tok_base + (size_t)sq * T;
        const float* row = QKV + tok * 1536;
#pragma unroll
        for (int i = 0; i < 8; ++i) { kk[i] = row[512 + h * 128 + kg * 8 + i]; qq[i] = row[h * 128 + kg * 8 + i]; }
        vv = row[1024 + h * 128 + dv]; g = G[tok * 4 + h]; be = BETA[tok * 4 + h];
    }
    for (int t = 0; t < T; ++t) {
        const size_t tok = (size_t)tok_base + (size_t)sq * T + t;
        float nk[8], nq[8], nv = 0.f, ng = 0.f, nb = 0.f;
        if (t + 1 < T) {
            const float* row = QKV + (tok + 1) * 1536;
#pragma unroll
            for (int i = 0; i < 8; ++i) { nk[i] = row[512 + h * 128 + kg * 8 + i]; nq[i] = row[h * 128 + kg * 8 + i]; }
            nv = row[1024 + h * 128 + dv]; ng = G[(tok + 1) * 4 + h]; nb = BETA[(tok + 1) * 4 + h];
        } else {
#pragma unroll
            for (int i = 0; i < 8; ++i) { nk[i] = 0.f; nq[i] = 0.f; }
        }
        const float al = expf(g);
        float p = 0.f;
#pragma unroll
        for (int i = 0; i < 8; ++i) { S[i] *= al; p += S[i] * kk[i]; }
        red1[kg][dvl] = p;
        __syncthreads();
        float ks = 0.f;
#pragma unroll
        for (int j = 0; j < 16; ++j) ks += red1[j][dvl];
        const float vn = be * (vv - ks);
        float o = 0.f;
#pragma unroll
        for (int i = 0; i < 8; ++i) { S[i] += kk[i] * vn; o += S[i] * qq[i]; }
        red2[kg][dvl] = o;
        __syncthreads();
        if (kg == 0) {
            float os = 0.f;
#pragma unroll
            for (int j = 0; j < 16; ++j) os += red2[j][dvl];
            O[tok * 512 + h * 128 + dv] = os;
        }
#pragma unroll
        for (int i = 0; i < 8; ++i) { kk[i] = nk[i]; qq[i] = nq[i]; }
        vv = nv; g = ng; be = nb;
    }
#pragma unroll
    for (int i = 0; i < 8; ++i) Sout[(((size_t)sq * 4 + h) * 128 + kg * 8 + i) * 128 + dv] = S[i];
}

__device__ __forceinline__ void lru_scan(const float* __restrict__ LA, float* __restrict__ LB, const float* __restrict__ h0,
                                         float* __restrict__ hlast, int tok_base, int T, int nseq, int bx) {
    int tx_ = threadIdx.x; asm volatile("" : "+v"(tx_));
    const int idx = bx * NTH + tx_;
    if (idx >= nseq * 512) return;
    const int sq = idx / 512, c = idx % 512;
    float h = h0 ? h0[(size_t)sq * 512 + c] : 0.f;
    const size_t base = ((size_t)tok_base + (size_t)sq * T) * 512 + c;
#pragma unroll 8
    for (int t = 0; t < T; ++t) {
        const size_t o = base + (size_t)t * 512;
        h = LA[o] * h + LB[o];
        LB[o] = h;
    }
    hlast[(size_t)sq * 512 + c] = h;
}

__device__ __forceinline__ void ab_mix(const bf16* __restrict__ PROJ, const float* __restrict__ O, const float* __restrict__ H, const float* __restrict__ P, const float* __restrict__ CIN,
                                       const float* __restrict__ norm_w, bf16* __restrict__ MIX, int vb) {
    int tx_ = threadIdx.x; asm volatile("" : "+v"(tx_));
    const int tid = tx_ & 255, lane = tid & 63, wid = tid >> 6, t = vb * 2 + (tx_ >> 8);
    const bf16* prow = PROJ + (size_t)t * ABN;
    {
        const int h = wid;
        const float o0 = O[(size_t)t * 512 + h * 128 + lane], o1 = O[(size_t)t * 512 + h * 128 + 64 + lane];
        const float ms = wave_sum(o0 * o0 + o1 * o1) * (1.0f / 128.0f);
        const float sc = rsqrtf(ms + 1e-6f);
        MIX[(size_t)t * 1024 + h * 128 + lane] = (bf16)f2bf(o0 * sc * norm_w[lane] * siluf_(bf2f(prow[C_Z + h * 128 + lane])));
        MIX[(size_t)t * 1024 + h * 128 + 64 + lane] = (bf16)f2bf(o1 * sc * norm_w[64 + lane] * siluf_(bf2f(prow[C_Z + h * 128 + 64 + lane])));
    }
    for (int c = tid; c < 512; c += 256) {
        float hv = H[(size_t)t * 512 + c];
        if (t < NP) hv += P[(size_t)t * 512 + c] * CIN[(size_t)(t >> 6) * 512 + c];
        MIX[(size_t)t * 1024 + 512 + c] = (bf16)f2bf(geluf_(bf2f(prow[C_GATE + c])) * hv);
    }
}

__device__ __forceinline__ void ln_res_w(const float* __restrict__ xrow, const float* __restrict__ yrow, const float* __restrict__ g, const float* __restrict__ bta,
                                         float* __restrict__ orow, bf16* __restrict__ obrow, int lane) {
    f32x4 v[4]; float s = 0.f;
#pragma unroll
    for (int j = 0; j < 4; ++j) { const f32x4 x4 = ((const f32x4*)xrow)[lane + 64 * j], y4 = ((const f32x4*)yrow)[lane + 64 * j]; v[j] = x4 * ALPHA + y4; s += (v[j].x + v[j].y) + (v[j].z + v[j].w); }
    const float mean = wave_sum(s) * (1.0f / 1024.0f); float q = 0.f;
#pragma unroll
    for (int j = 0; j < 4; ++j) { v[j] = v[j] - mean; q += (v[j].x * v[j].x + v[j].y * v[j].y) + (v[j].z * v[j].z + v[j].w * v[j].w); }
    const float rs = rsqrtf(wave_sum(q) * (1.0f / 1024.0f) + LN_EPS);
#pragma unroll
    for (int j = 0; j < 4; ++j) {
        const f32x4 g4 = ((const f32x4*)g)[lane + 64 * j], b4 = ((const f32x4*)bta)[lane + 64 * j];
        const f32x4 o = v[j] * rs * g4 + b4;
        ((f32x4*)orow)[lane + 64 * j] = o;
        v2u ob; ob.x = pk2(o.x, o.y); ob.y = pk2(o.z, o.w);
        ((v2u*)obrow)[lane + 64 * j] = ob;
    }
}

__device__ __forceinline__ void peer_topk(const bf16* __restrict__ Q, const float* __restrict__ keys, int* __restrict__ EXP, float* __restrict__ GATE,
                                          int tg, int h, float* smem) {
    const int tid = threadIdx.x, cn = tid & 255, c = cn >> 7, n = cn & 127, th = tid >> 8;
    float (*sq)[256] = (float (*)[256])smem;
    float (*ss)[257] = (float (*)[257])(smem + 32 * 256);
    float (*tvs)[2][16] = (float (*)[2][16])(smem + 32 * 256 + 32 * 257 + 32);
    int (*tis)[2][16] = (int (*)[2][16])(smem + 32 * 256 + 32 * 257 + 32 + 1024);
    for (int i = tid; i < 32 * 256; i += NTH) {
        const int tk = i >> 8, col = i & 255;
        sq[tk][col] = bf2f(Q[(size_t)(tg * 32 + tk) * 2048 + h * 256 + col]);
    }
    __syncthreads();
    float acc[16];
#pragma unroll
    for (int i = 0; i < 16; ++i) acc[i] = 0.f;
    const float* krow = keys + (((size_t)h * 2 + c) * 128 + n) * 128;
    for (int d4 = 0; d4 < 32; ++d4) {
        const float4 kv = *(const float4*)(krow + d4 * 4);
#pragma unroll
        for (int tk = 0; tk < 16; ++tk) {
            const float4 qv = *(const float4*)&sq[th * 16 + tk][c * 128 + d4 * 4];
            acc[tk] += qv.x * kv.x + qv.y * kv.y + qv.z * kv.z + qv.w * kv.w;
        }
    }
#pragma unroll
    for (int tk = 0; tk < 16; ++tk) ss[th * 16 + tk][cn] = acc[tk];
    __syncthreads();
    if (tid < 64) {
        const int tk = tid >> 1, cc = tid & 1;
        float tv[16]; int ti[16];
#pragma unroll
        for (int j = 0; j < 16; ++j) { tv[j] = -INFINITY; ti[j] = 0; }
        for (int nn = 0; nn < 128; ++nn) {
            float x = ss[tk][cc * 128 + nn]; int xi = nn;
#pragma unroll
            for (int j = 0; j < 16; ++j) {
                const bool gt = x > tv[j];
                const float tf = tv[j]; const int tj = ti[j];
                tv[j] = gt ? x : tf; ti[j] = gt ? xi : tj;
                x = gt ? tf : x; xi = gt ? tj : xi;
            }
        }
#pragma unroll
        for (int j = 0; j < 16; ++j) { tvs[tk][cc][j] = tv[j]; tis[tk][cc][j] = ti[j]; }
    }
    __syncthreads();
    if (tid < 32) {
        const int tk = tid;
        float bv[16]; int bi[16];
#pragma unroll
        for (int j = 0; j < 16; ++j) { bv[j] = -INFINITY; bi[j] = 0; }
        for (int i = 0; i < 16; ++i)
            for (int jj = 0; jj < 16; ++jj) {
                float x = tvs[tk][0][i] + tvs[tk][1][jj]; int xi = tis[tk][0][i] * 128 + tis[tk][1][jj];
#pragma unroll
                for (int j = 0; j < 16; ++j) {
                    const bool gt = x > bv[j];
                    const float tf = bv[j]; const int tj = bi[j];
                    bv[j] = gt ? x : tf; bi[j] = gt ? xi : tj;
                    x = gt ? tf : x; xi = gt ? tj : xi;
                }
            }
        float e[16], sum = 0.f;
#pragma unroll
        for (int j = 0; j < 16; ++j) { e[j] = expf(bv[j] - bv[0]); sum += e[j]; }
        const float inv = 1.0f / sum;
        const size_t o = (size_t)(tg * 32 + tk) * 128 + h * 16;
#pragma unroll
        for (int j = 0; j < 16; ++j) { EXP[o + j] = bi[j]; GATE[o + j] = e[j] * inv; }
    }
}

__device__ __forceinline__ void peer_expert(const float* __restrict__ X, const int* __restrict__ EXP, const float* __restrict__ GATE,
                                            const float* __restrict__ U, const float* __restrict__ V,
                                            const float* __restrict__ g, const float* __restrict__ bta, float* __restrict__ out, bf16* __restrict__ outb, int t, float* smem) {
    const int tid = threadIdx.x, lane = tid & 63, wid = tid >> 6;
    float (*accs)[1024] = (float (*)[1024])smem;
    float* sred = smem + 8192;
    const float4* xr = (const float4*)(X + (size_t)t * D);
    float4 xv[4];
#pragma unroll
    for (int j = 0; j < 4; ++j) xv[j] = xr[lane + 64 * j];
    float4 acc[4];
#pragma unroll
    for (int j = 0; j < 4; ++j) acc[j] = make_float4(0.f, 0.f, 0.f, 0.f);
    for (int e = 0; e < 16; ++e) {
        const int id = EXP[(size_t)t * 128 + wid * 16 + e];
        const float gt = GATE[(size_t)t * 128 + wid * 16 + e];
        const float4* ur = (const float4*)(U + (size_t)id * D);
        const float4* vr = (const float4*)(V + (size_t)id * D);
        float4 uv[4], vv[4];
#pragma unroll
        for (int j = 0; j < 4; ++j) { uv[j] = ur[lane + 64 * j]; vv[j] = vr[lane + 64 * j]; }
        float dot = 0.f;
#pragma unroll
        for (int j = 0; j < 4; ++j) dot += uv[j].x * xv[j].x + uv[j].y * xv[j].y + uv[j].z * xv[j].z + uv[j].w * xv[j].w;
        dot = wave_sum(dot);
        const float cf = gt * geluf_(dot);
#pragma unroll
        for (int j = 0; j < 4; ++j) { acc[j].x += cf * vv[j].x; acc[j].y += cf * vv[j].y; acc[j].z += cf * vv[j].z; acc[j].w += cf * vv[j].w; }
    }
#pragma unroll
    for (int j = 0; j < 4; ++j) *(float4*)&accs[wid][(lane + 64 * j) * 4] = acc[j];
    __syncthreads();
    float v[2];
#pragma unroll
    for (int i = 0; i < 2; ++i) {
        const int c = tid * 2 + i;
        float s = 0.f;
#pragma unroll
        for (int w = 0; w < 8; ++w) s += accs[w][c];
        v[i] = ALPHA * X[(size_t)t * D + c] + s;
    }
    float s = wave_sum(v[0] + v[1]);
    if (lane == 0) sred[wid] = s;
    __syncthreads();
    float mean = 0.f;
#pragma unroll
    for (int w = 0; w < 8; ++w) mean += sred[w];
    mean *= (1.0f / 1024.0f);
    __syncthreads();
    const float d0 = v[0] - mean, d1 = v[1] - mean;
    float q = wave_sum(d0 * d0 + d1 * d1);
    if (lane == 0) sred[wid] = q;
    __syncthreads();
    float var = 0.f;
#pragma unroll
    for (int w = 0; w < 8; ++w) var += sred[w];
    const float rs = rsqrtf(var * (1.0f / 1024.0f) + LN_EPS);
    const float o0 = d0 * rs * g[tid * 2] + bta[tid * 2], o1 = d1 * rs * g[tid * 2 + 1] + bta[tid * 2 + 1];
    *(float2*)(out + (size_t)t * D + tid * 2) = make_float2(o0, o1);
    if (outb) *(unsigned*)(outb + (size_t)t * D + tid * 2) = pk2(o0, o1);
}


typedef __bf16 bf16x2_t __attribute__((ext_vector_type(2)));
__device__ __forceinline__ float dot2bf(unsigned w, unsigned x, float acc) { return __builtin_amdgcn_fdot2_f32_bf16(__builtin_bit_cast(bf16x2_t, w), __builtin_bit_cast(bf16x2_t, x), acc, false); }
__device__ __forceinline__ float bflo(unsigned w) { return __uint_as_float(w << 16); }
__device__ __forceinline__ float bfhi(unsigned w) { return __uint_as_float(w & 0xffff0000u); }
typedef float f32x2_t __attribute__((ext_vector_type(2)));
__device__ __forceinline__ void row_to_fp8(const float* __restrict__ xrow, unsigned char* __restrict__ orow, float* __restrict__ scale, int lane) {
    f32x4 v[4]; float am = 0.f;
#pragma unroll
    for (int j = 0; j < 4; ++j) { v[j] = *(const f32x4*)(xrow + lane * 16 + j * 4); am = fmaxf(am, fmaxf(fmaxf(fabsf(v[j].x), fabsf(v[j].y)), fmaxf(fabsf(v[j].z), fabsf(v[j].w)))); }
    am = wave_max(am);
    const float s = am > 0.f ? am * (1.0f / 448.0f) : 1.0f, inv = 1.0f / s;
    v4u o;
    unsigned w;
    w = 0u; w = __builtin_amdgcn_cvt_pk_fp8_f32(v[0].x * inv, v[0].y * inv, w, false); w = __builtin_amdgcn_cvt_pk_fp8_f32(v[0].z * inv, v[0].w * inv, w, true); o.x = w;
    w = 0u; w = __builtin_amdgcn_cvt_pk_fp8_f32(v[1].x * inv, v[1].y * inv, w, false); w = __builtin_amdgcn_cvt_pk_fp8_f32(v[1].z * inv, v[1].w * inv, w, true); o.y = w;
    w = 0u; w = __builtin_amdgcn_cvt_pk_fp8_f32(v[2].x * inv, v[2].y * inv, w, false); w = __builtin_amdgcn_cvt_pk_fp8_f32(v[2].z * inv, v[2].w * inv, w, true); o.z = w;
    w = 0u; w = __builtin_amdgcn_cvt_pk_fp8_f32(v[3].x * inv, v[3].y * inv, w, false); w = __builtin_amdgcn_cvt_pk_fp8_f32(v[3].z * inv, v[3].w * inv, w, true); o.w = w;
    *(v4u*)(orow + lane * 16) = o;
    if (lane == 0) *scale = s;
}
#define PE_LOAD(UB, VB, grp) do { _Pragma("unroll") for (int i_ = 0; i_ < 4; ++i_) { const int e_ = (grp) * 4 + i_; \
        const int id_ = __builtin_amdgcn_readlane(e_ < 64 ? id0 : id1, e_ & 63); \
        const unsigned so_ = (unsigned)id_ * 1024u; \
        UB[i_] = __builtin_amdgcn_raw_buffer_load_b128(ursrc, voff, so_, 0); VB[i_] = __builtin_amdgcn_raw_buffer_load_b128(vrsrc, voff, so_, 0); } } while (0)
#define PE_DOT4(w, k) do { const f32x2_t l_ = __builtin_amdgcn_cvt_pk_f32_fp8((w), false), h_ = __builtin_amdgcn_cvt_pk_f32_fp8((w), true); \
        a_ += l_.x * xv[(k) * 4 + 0]; b_ += l_.y * xv[(k) * 4 + 1]; a_ += h_.x * xv[(k) * 4 + 2]; b_ += h_.y * xv[(k) * 4 + 3]; } while (0)
#define PE_AXPY4(w, k) do { const f32x2_t l_ = __builtin_amdgcn_cvt_pk_f32_fp8((w), false), h_ = __builtin_amdgcn_cvt_pk_f32_fp8((w), true); \
        acc[(k) * 4 + 0] += cf_ * l_.x; acc[(k) * 4 + 1] += cf_ * l_.y; acc[(k) * 4 + 2] += cf_ * h_.x; acc[(k) * 4 + 3] += cf_ * h_.y; } while (0)
#define PE_COMP(UB, VB, grp) do { float d_[4]; \
        _Pragma("unroll") for (int i_ = 0; i_ < 4; ++i_) { float a_ = 0.f, b_ = 0.f; PE_DOT4(UB[i_].x, 0); PE_DOT4(UB[i_].y, 1); PE_DOT4(UB[i_].z, 2); PE_DOT4(UB[i_].w, 3); d_[i_] = a_ + b_; } \
          \
        float s0_ = hi32 ? d_[2] : d_[0], t0_ = hi32 ? d_[0] : d_[2]; s0_ += __shfl_xor(t0_, 32); \
        float s1_ = hi32 ? d_[3] : d_[1], t1_ = hi32 ? d_[1] : d_[3]; s1_ += __shfl_xor(t1_, 32); \
        float r_ = hi16 ? s1_ : s0_, t2_ = hi16 ? s0_ : s1_; r_ += __shfl_xor(t2_, 16); \
        r_ += __shfl_xor(r_, 8); r_ += __shfl_xor(r_, 4); r_ += __shfl_xor(r_, 2); r_ += __shfl_xor(r_, 1); \
          \
        const int esel_ = (grp) * 4 + (lane >> 4); \
        const float su_ = __shfl(esel_ < 64 ? su0 : su1, esel_ & 63), gv_ = __shfl(esel_ < 64 ? gs0 : gs1, esel_ & 63); \
        const float cfl_ = geluf_(r_ * su_) * gv_; \
        _Pragma("unroll") for (int i_ = 0; i_ < 4; ++i_) { \
            const float cf_ = __uint_as_float(__builtin_amdgcn_readlane(__float_as_uint(cfl_), 16 * i_)); \
            PE_AXPY4(VB[i_].x, 0); PE_AXPY4(VB[i_].y, 1); PE_AXPY4(VB[i_].z, 2); PE_AXPY4(VB[i_].w, 3); } } while (0)
__device__ __forceinline__ void peer_expert_w(const float* __restrict__ xrow, const int* __restrict__ exr, const float* __restrict__ gar,
                                              const unsigned char* __restrict__ U, const unsigned char* __restrict__ V, const float* __restrict__ SU, const float* __restrict__ SV,
                                              const float* __restrict__ g, const float* __restrict__ bta, float* __restrict__ orow, bf16* __restrict__ obrow, int lane) {
    const bool hi32 = (lane & 32) != 0, hi16 = (lane & 16) != 0;
    const __amdgpu_buffer_rsrc_t ursrc = __builtin_amdgcn_make_buffer_rsrc((void*)U, 0, 16384 * 1024, 0x00020000);
    const __amdgpu_buffer_rsrc_t vrsrc = __builtin_amdgcn_make_buffer_rsrc((void*)V, 0, 16384 * 1024, 0x00020000);
    const int voff = lane * 16;
    float xv[16];
#pragma unroll
    for (int j = 0; j < 4; ++j) { const f32x4 t = *(const f32x4*)(xrow + lane * 16 + j * 4); xv[j * 4 + 0] = t.x; xv[j * 4 + 1] = t.y; xv[j * 4 + 2] = t.z; xv[j * 4 + 3] = t.w; }
    const int id0 = exr[lane], id1 = exr[64 + lane];
    const float su0 = SU[id0], su1 = SU[id1];
    const float gs0 = gar[lane] * SV[id0], gs1 = gar[64 + lane] * SV[id1];
    float acc[16];
#pragma unroll
    for (int i = 0; i < 16; ++i) acc[i] = 0.f;
    v4u ua[4], va[4], ub[4], vb[4];
    PE_LOAD(ua, va, 0);
#pragma unroll 1
    for (int grp = 0; grp < 32; grp += 2) {
        PE_LOAD(ub, vb, grp + 1);
        PE_COMP(ua, va, grp);
        if (grp + 2 < 32) PE_LOAD(ua, va, grp + 2);
        PE_COMP(ub, vb, grp + 1);
    }
    float v[16]; float s = 0.f;
#pragma unroll
    for (int i = 0; i < 16; ++i) { v[i] = ALPHA * xv[i] + acc[i]; s += v[i]; }
    const float mean = wave_sum(s) * (1.0f / 1024.0f); float q = 0.f;
#pragma unroll
    for (int i = 0; i < 16; ++i) { v[i] -= mean; q += v[i] * v[i]; }
    const float rs = rsqrtf(wave_sum(q) * (1.0f / 1024.0f) + LN_EPS);
    float o[16];
#pragma unroll
    for (int j = 0; j < 4; ++j) {
        const f32x4 g4 = *(const f32x4*)(g + lane * 16 + j * 4), b4 = *(const f32x4*)(bta + lane * 16 + j * 4);
        o[j * 4 + 0] = v[j * 4 + 0] * rs * g4.x + b4.x; o[j * 4 + 1] = v[j * 4 + 1] * rs * g4.y + b4.y; o[j * 4 + 2] = v[j * 4 + 2] * rs * g4.z + b4.z; o[j * 4 + 3] = v[j * 4 + 3] * rs * g4.w + b4.w;
        *(f32x4*)(orow + lane * 16 + j * 4) = (f32x4){o[j * 4 + 0], o[j * 4 + 1], o[j * 4 + 2], o[j * 4 + 3]};
    }
    if (obrow) {
        v4u w0, w1; w0.x = pk2(o[0], o[1]); w0.y = pk2(o[2], o[3]); w0.z = pk2(o[4], o[5]); w0.w = pk2(o[6], o[7]); w1.x = pk2(o[8], o[9]); w1.y = pk2(o[10], o[11]); w1.z = pk2(o[12], o[13]); w1.w = pk2(o[14], o[15]);
        *(v4u*)(obrow + lane * 16) = w0; *(v4u*)(obrow + lane * 16 + 8) = w1;
    }
}


__device__ __forceinline__ void peer_expert_blk(const float* __restrict__ xrow, const int* __restrict__ exr, const float* __restrict__ gar,
                                                const unsigned char* __restrict__ U, const unsigned char* __restrict__ V, const float* __restrict__ SU, const float* __restrict__ SV,
                                                const float* __restrict__ g, const float* __restrict__ bta, float* __restrict__ orow, bf16* __restrict__ obrow, int lane, int wave, float* smem) {
    const bool hi32 = (lane & 32) != 0, hi16 = (lane & 16) != 0;
    const __amdgpu_buffer_rsrc_t ursrc = __builtin_amdgcn_make_buffer_rsrc((void*)U, 0, 16384 * 1024, 0x00020000);
    const __amdgpu_buffer_rsrc_t vrsrc = __builtin_amdgcn_make_buffer_rsrc((void*)V, 0, 16384 * 1024, 0x00020000);
    const int voff = lane * 16;
    float xv[16];
#pragma unroll
    for (int j = 0; j < 4; ++j) { const f32x4 t = *(const f32x4*)(xrow + lane * 16 + j * 4); xv[j * 4 + 0] = t.x; xv[j * 4 + 1] = t.y; xv[j * 4 + 2] = t.z; xv[j * 4 + 3] = t.w; }
    const int id0 = exr[lane], id1 = exr[64 + lane];
    const float su0 = SU[id0], su1 = SU[id1];
    const float gs0 = gar[lane] * SV[id0], gs1 = gar[64 + lane] * SV[id1];
    float acc[16];
#pragma unroll
    for (int i = 0; i < 16; ++i) acc[i] = 0.f;
    v4u ua[4], va[4], ub[4], vb[4];
    const int g0 = wave * 4;
    PE_LOAD(ua, va, g0); PE_LOAD(ub, vb, g0 + 1);
    PE_COMP(ua, va, g0); PE_LOAD(ua, va, g0 + 2);
    PE_COMP(ub, vb, g0 + 1); PE_LOAD(ub, vb, g0 + 3);
    PE_COMP(ua, va, g0 + 2);
    PE_COMP(ub, vb, g0 + 3);
    float* accs = smem;
    float* sred = smem + 8192;
#pragma unroll
    for (int j = 0; j < 4; ++j) *(f32x4*)(accs + wave * 1024 + lane * 16 + j * 4) = (f32x4){acc[j * 4 + 0], acc[j * 4 + 1], acc[j * 4 + 2], acc[j * 4 + 3]};
    __syncthreads();
    const int tid = wave * 64 + lane;
    float v0 = ALPHA * xrow[tid * 2], v1 = ALPHA * xrow[tid * 2 + 1];
#pragma unroll
    for (int w = 0; w < 8; ++w) { v0 += accs[w * 1024 + tid * 2]; v1 += accs[w * 1024 + tid * 2 + 1]; }
    const float s = wave_sum(v0 + v1);
    if (lane == 0) sred[wave] = s;
    __syncthreads();
    float mean = 0.f;
#pragma unroll
    for (int w = 0; w < 8; ++w) mean += sred[w];
    mean *= (1.0f / 1024.0f);
    __syncthreads();
    const float d0 = v0 - mean, d1 = v1 - mean;
    const float q = wave_sum(d0 * d0 + d1 * d1);
    if (lane == 0) sred[wave] = q;
    __syncthreads();
    float var = 0.f;
#pragma unroll
    for (int w = 0; w < 8; ++w) var += sred[w];
    const float rs = rsqrtf(var * (1.0f / 1024.0f) + LN_EPS);
    const float o0 = d0 * rs * g[tid * 2] + bta[tid * 2], o1 = d1 * rs * g[tid * 2 + 1] + bta[tid * 2 + 1];
    *(float2*)(orow + tid * 2) = make_float2(o0, o1);
    if (obrow) *(unsigned*)(obrow + tid * 2) = pk2(o0, o1);
    __syncthreads();
}

__device__ __forceinline__ void row_to_fp8_sliced(const float* __restrict__ xrow, unsigned char* __restrict__ tab, int r, float* __restrict__ scale, int lane) {
    f32x4 v[4]; float am = 0.f;
#pragma unroll
    for (int j = 0; j < 4; ++j) { v[j] = *(const f32x4*)(xrow + lane * 16 + j * 4); am = fmaxf(am, fmaxf(fmaxf(fabsf(v[j].x), fabsf(v[j].y)), fmaxf(fabsf(v[j].z), fabsf(v[j].w)))); }
    am = wave_max(am);
    const float s = am > 0.f ? am * (1.0f / 448.0f) : 1.0f, inv = 1.0f / s;
    v4u o; unsigned w;
    w = 0u; w = __builtin_amdgcn_cvt_pk_fp8_f32(v[0].x * inv, v[0].y * inv, w, false); w = __builtin_amdgcn_cvt_pk_fp8_f32(v[0].z * inv, v[0].w * inv, w, true); o.x = w;
    w = 0u; w = __builtin_amdgcn_cvt_pk_fp8_f32(v[1].x * inv, v[1].y * inv, w, false); w = __builtin_amdgcn_cvt_pk_fp8_f32(v[1].z * inv, v[1].w * inv, w, true); o.y = w;
    w = 0u; w = __builtin_amdgcn_cvt_pk_fp8_f32(v[2].x * inv, v[2].y * inv, w, false); w = __builtin_amdgcn_cvt_pk_fp8_f32(v[2].z * inv, v[2].w * inv, w, true); o.z = w;
    w = 0u; w = __builtin_amdgcn_cvt_pk_fp8_f32(v[3].x * inv, v[3].y * inv, w, false); w = __builtin_amdgcn_cvt_pk_fp8_f32(v[3].z * inv, v[3].w * inv, w, true); o.w = w;
    *(v4u*)(tab + ((size_t)(lane >> 3) * 16384 + r) * 128 + (lane & 7) * 16) = o;
    if (lane == 0) *scale = s;
}
__device__ __forceinline__ void peer_u_pass(const float* __restrict__ xrow, const int* __restrict__ exr, const unsigned char* __restrict__ U8x, float* __restrict__ pd, int x, int lane) {
    const int e8 = lane >> 3, c = lane & 7;
    float xv[16];
#pragma unroll
    for (int j = 0; j < 4; ++j) { const f32x4 t = *(const f32x4*)(xrow + x * 128 + c * 16 + j * 4); xv[j * 4 + 0] = t.x; xv[j * 4 + 1] = t.y; xv[j * 4 + 2] = t.z; xv[j * 4 + 3] = t.w; }
    const __amdgpu_buffer_rsrc_t ursrc = __builtin_amdgcn_make_buffer_rsrc((void*)U8x, 0, 16384 * 128, 0x00020000);
    v4u wa[8], wb[8];
    float d[16];
#pragma unroll
    for (int g = 0; g < 8; ++g) wa[g] = __builtin_amdgcn_raw_buffer_load_b128(ursrc, exr[g * 8 + e8] * 128 + c * 16, 0, 0);
#pragma unroll
    for (int g = 0; g < 8; ++g) wb[g] = __builtin_amdgcn_raw_buffer_load_b128(ursrc, exr[(8 + g) * 8 + e8] * 128 + c * 16, 0, 0);
#define PU_DOT1(w_, k_) do { const f32x2_t l_ = __builtin_amdgcn_cvt_pk_f32_fp8((w_), false), h_ = __builtin_amdgcn_cvt_pk_f32_fp8((w_), true); \
        a_ = __builtin_fmaf(l_.x, xv[(k_) * 4 + 0], a_); a_ = __builtin_fmaf(l_.y, xv[(k_) * 4 + 1], a_); a_ = __builtin_fmaf(h_.x, xv[(k_) * 4 + 2], a_); a_ = __builtin_fmaf(h_.y, xv[(k_) * 4 + 3], a_); } while (0)
#pragma unroll
    for (int g = 0; g < 8; ++g) { float a_ = 0.f; PU_DOT1(wa[g].x, 0); PU_DOT1(wa[g].y, 1); PU_DOT1(wa[g].z, 2); PU_DOT1(wa[g].w, 3); d[g] = a_; }
#pragma unroll
    for (int g = 0; g < 8; ++g) { float a_ = 0.f; PU_DOT1(wb[g].x, 0); PU_DOT1(wb[g].y, 1); PU_DOT1(wb[g].z, 2); PU_DOT1(wb[g].w, 3); d[8 + g] = a_; }
#pragma unroll
    for (int g = 0; g < 16; ++g) { d[g] += DPPF(d[g], 0xB1, 0xf); d[g] += DPPF(d[g], 0x4E, 0xf); d[g] += DPPF(d[g], 0x141, 0xf); }
    if (c == 0) {
#pragma unroll
        for (int j = 0; j < 4; ++j) *(f32x4*)(pd + e8 * 16 + j * 4) = (f32x4){d[j * 4 + 0], d[j * 4 + 1], d[j * 4 + 2], d[j * 4 + 3]};
    }
}
#define PV_LOAD(VB, grp) do { _Pragma("unroll") for (int i_ = 0; i_ < 4; ++i_) { const int e_ = (grp) * 4 + i_; \
        const int id_ = __builtin_amdgcn_readlane(e_ < 64 ? id0 : id1, e_ & 63); \
        VB[i_] = __builtin_amdgcn_raw_buffer_load_b128(vrsrc, voff, (unsigned)id_ * 1024u, 0); } } while (0)
#define PV_COMP(VB, grp) do { _Pragma("unroll") for (int i_ = 0; i_ < 4; ++i_) { const int e_ = (grp) * 4 + i_; \
        const float cf_ = __uint_as_float(__builtin_amdgcn_readlane(__float_as_uint(e_ < 64 ? cf0 : cf1), e_ & 63)); \
        PE_AXPY4(VB[i_].x, 0); PE_AXPY4(VB[i_].y, 1); PE_AXPY4(VB[i_].z, 2); PE_AXPY4(VB[i_].w, 3); } } while (0)
#define PV_COEFS() \
    const int id0 = exr[lane], id1 = exr[64 + lane]; \
    float dot0 = 0.f, dot1 = 0.f; \
    { const int p0 = (lane & 7) * 16 + (lane >> 3), p1 = p0 + 8;        \
      _Pragma("unroll") for (int x_ = 0; x_ < 8; ++x_) { dot0 += pdt[(size_t)x_ * NT * 128 + p0]; dot1 += pdt[(size_t)x_ * NT * 128 + p1]; } } \
    const float cf0 = gar[lane] * SV[id0] * geluf_(SU[id0] * dot0), cf1 = gar[64 + lane] * SV[id1] * geluf_(SU[id1] * dot1);
__device__ __forceinline__ void peer_v_w(const float* __restrict__ xrow, const int* __restrict__ exr, const float* __restrict__ gar, const float* __restrict__ pdt,
                                         const unsigned char* __restrict__ V, const float* __restrict__ SU, const float* __restrict__ SV,
                                         const float* __restrict__ g, const float* __restrict__ bta, float* __restrict__ orow, bf16* __restrict__ obrow, int lane) {
    const __amdgpu_buffer_rsrc_t vrsrc = __builtin_amdgcn_make_buffer_rsrc((void*)V, 0, 16384 * 1024, 0x00020000);
    const int voff = lane * 16;
    PV_COEFS()
    float acc[16];
#pragma unroll
    for (int i = 0; i < 16; ++i) acc[i] = 0.f;
    v4u va[4], vb[4], vc[4];
    PV_LOAD(va, 0); PV_LOAD(vb, 1);
#pragma unroll 1
    for (int grp = 0; grp < 30; grp += 3) {
        PV_LOAD(vc, grp + 2);
        PV_COMP(va, grp);
        PV_LOAD(va, grp + 3);
        PV_COMP(vb, grp + 1);
        PV_LOAD(vb, grp + 4);
        PV_COMP(vc, grp + 2);
    }
    PV_COMP(va, 30); PV_COMP(vb, 31);
    float xv[16];
#pragma unroll
    for (int j = 0; j < 4; ++j) { const f32x4 t = *(const f32x4*)(xrow + lane * 16 + j * 4); xv[j * 4 + 0] = t.x; xv[j * 4 + 1] = t.y; xv[j * 4 + 2] = t.z; xv[j * 4 + 3] = t.w; }
    float v[16]; float s = 0.f;
#pragma unroll
    for (int i = 0; i < 16; ++i) { v[i] = ALPHA * xv[i] + acc[i]; s += v[i]; }
    const float mean = wave_sum(s) * (1.0f / 1024.0f); float q = 0.f;
#pragma unroll
    for (int i = 0; i < 16; ++i) { v[i] -= mean; q += v[i] * v[i]; }
    const float rs = rsqrtf(wave_sum(q) * (1.0f / 1024.0f) + LN_EPS);
    float o[16];
#pragma unroll
    for (int j = 0; j < 4; ++j) {
        const f32x4 g4 = *(const f32x4*)(g + lane * 16 + j * 4), b4 = *(const f32x4*)(bta + lane * 16 + j * 4);
        o[j * 4 + 0] = v[j * 4 + 0] * rs * g4.x + b4.x; o[j * 4 + 1] = v[j * 4 + 1] * rs * g4.y + b4.y; o[j * 4 + 2] = v[j * 4 + 2] * rs * g4.z + b4.z; o[j * 4 + 3] = v[j * 4 + 3] * rs * g4.w + b4.w;
        *(f32x4*)(orow + lane * 16 + j * 4) = (f32x4){o[j * 4 + 0], o[j * 4 + 1], o[j * 4 + 2], o[j * 4 + 3]};
    }
    if (obrow) {
        v4u w0, w1; w0.x = pk2(o[0], o[1]); w0.y = pk2(o[2], o[3]); w0.z = pk2(o[4], o[5]); w0.w = pk2(o[6], o[7]); w1.x = pk2(o[8], o[9]); w1.y = pk2(o[10], o[11]); w1.z = pk2(o[12], o[13]); w1.w = pk2(o[14], o[15]);
        *(v4u*)(obrow + lane * 16) = w0; *(v4u*)(obrow + lane * 16 + 8) = w1;
    }
}
__device__ __forceinline__ void peer_v_blk(const float* __restrict__ xrow, const int* __restrict__ exr, const float* __restrict__ gar, const float* __restrict__ pdt,
                                           const unsigned char* __restrict__ V, const float* __restrict__ SU, const float* __restrict__ SV,
                                           const float* __restrict__ g, const float* __restrict__ bta, float* __restrict__ orow, bf16* __restrict__ obrow, int lane, int wave, float* smem) {
    const __amdgpu_buffer_rsrc_t vrsrc = __builtin_amdgcn_make_buffer_rsrc((void*)V, 0, 16384 * 1024, 0x00020000);
    const int voff = lane * 16;
    PV_COEFS()
    float acc[16];
#pragma unroll
    for (int i = 0; i < 16; ++i) acc[i] = 0.f;
    v4u va[4], vb[4], vc[4], vd[4];
    PV_LOAD(va, wave * 4); PV_LOAD(vb, wave * 4 + 1); PV_LOAD(vc, wave * 4 + 2); PV_LOAD(vd, wave * 4 + 3);
    PV_COMP(va, wave * 4); PV_COMP(vb, wave * 4 + 1); PV_COMP(vc, wave * 4 + 2); PV_COMP(vd, wave * 4 + 3);
    float* accs = smem;
    float* sred = smem + 8192;
#pragma unroll
    for (int j = 0; j < 4; ++j) *(f32x4*)(accs + wave * 1024 + lane * 16 + j * 4) = (f32x4){acc[j * 4 + 0], acc[j * 4 + 1], acc[j * 4 + 2], acc[j * 4 + 3]};
    __syncthreads();
    const int tid = wave * 64 + lane;
    float v0 = ALPHA * xrow[tid * 2], v1 = ALPHA * xrow[tid * 2 + 1];
#pragma unroll
    for (int w = 0; w < 8; ++w) { v0 += accs[w * 1024 + tid * 2]; v1 += accs[w * 1024 + tid * 2 + 1]; }
    const float s = wave_sum(v0 + v1);
    if (lane == 0) sred[wave] = s;
    __syncthreads();
    float mean = 0.f;
#pragma unroll
    for (int w = 0; w < 8; ++w) mean += sred[w];
    mean *= (1.0f / 1024.0f);
    __syncthreads();
    const float d0 = v0 - mean, d1 = v1 - mean;
    const float q = wave_sum(d0 * d0 + d1 * d1);
    if (lane == 0) sred[wave] = q;
    __syncthreads();
    float var = 0.f;
#pragma unroll
    for (int w = 0; w < 8; ++w) var += sred[w];
    const float rs = rsqrtf(var * (1.0f / 1024.0f) + LN_EPS);
    const float o0 = d0 * rs * g[tid * 2] + bta[tid * 2], o1 = d1 * rs * g[tid * 2 + 1] + bta[tid * 2 + 1];
    *(float2*)(orow + tid * 2) = make_float2(o0, o1);
    if (obrow) *(unsigned*)(obrow + tid * 2) = pk2(o0, o1);
    __syncthreads();
}

__device__ __forceinline__ int t5_bucket(int n) {
    if (n < 16) return n;
    const int large = 16 + (int)(logf((float)n / 16.0f) / 2.0794415416798357f * 16.0f);
    return large < 31 ? large : 31;
}
__device__ __forceinline__ void swa_attn(const float* __restrict__ PC, const float* __restrict__ cache_k, const float* __restrict__ cache_v,
                                         const float* __restrict__ rel_bias, const float* __restrict__ sinks, bf16* __restrict__ ATT, int bx) {
    const int tid = threadIdx.x, lane = tid & 63, wid = tid >> 6;
    const int gw = bx * 8 + wid;
    const int t = gw >> 4, h = gw & 15, kvh = h >> 2;
    if (t >= NT) return;
    const bool samp = t >= NP; const int sb = t - NP, pos = t % SEQ;
    const float* qrow = PC + (size_t)t * CN + h * 64;
    float lg[2]; bool valid[2];
#pragma unroll
    for (int rr = 0; rr < 2; ++rr) {
        const int r = lane + 64 * rr;
        const float* krow;
        if (!samp) { valid[rr] = (pos - r) >= 0; krow = PC + (size_t)(valid[rr] ? t - r : t) * CN + 1024 + kvh * 64; }
        else { valid[rr] = true; krow = (r == 0) ? PC + (size_t)t * CN + 1024 + kvh * 64 : cache_k + (((size_t)sb * 128 + (128 - r)) * 4 + kvh) * 64; }
        float dot = 0.f;
#pragma unroll
        for (int d4 = 0; d4 < 16; ++d4) {
            const float4 kv = *(const float4*)(krow + d4 * 4);
            const float4 qv = *(const float4*)(qrow + d4 * 4);
            dot += qv.x * kv.x + qv.y * kv.y + qv.z * kv.z + qv.w * kv.w;
        }
        lg[rr] = valid[rr] ? dot * 0.125f + rel_bias[t5_bucket(r) * 16 + h] : -INFINITY;
    }
    const float sink = sinks[h];
    const float m = fmaxf(wave_max(fmaxf(lg[0], lg[1])), sink);
    float p[2];
#pragma unroll
    for (int rr = 0; rr < 2; ++rr) p[rr] = valid[rr] ? expf(lg[rr] - m) : 0.f;
    const float den = wave_sum(p[0] + p[1]) + expf(sink - m);
    const float inv = 1.0f / den;
    float o = 0.f;
#pragma unroll
    for (int rr = 0; rr < 2; ++rr)
        for (int l2 = 0; l2 < 64; ++l2) {
            const int r = l2 + 64 * rr;
            const float pj = __shfl(p[rr], l2);
            if (pj != 0.f) {
                const float* vrow;
                if (!samp) vrow = PC + (size_t)(t - r) * CN + 1280 + kvh * 64;
                else vrow = (r == 0) ? PC + (size_t)t * CN + 1280 + kvh * 64 : cache_v + (((size_t)sb * 128 + (128 - r)) * 4 + kvh) * 64;
                o += pj * vrow[lane];
            }
        }
    ATT[(size_t)t * D + h * 64 + lane] = (bf16)f2bf(o * inv);
}

__device__ __forceinline__ void swa_kv_out(const float* __restrict__ PC, const float* __restrict__ cache_k, const float* __restrict__ cache_v,
                                           float* __restrict__ pk, float* __restrict__ pv, float* __restrict__ sk, float* __restrict__ sv, int vb) {
    const int c = threadIdx.x & 255, row = vb * 2 + (threadIdx.x >> 8);
    if (row < NB * 128) {
        const int b = row >> 7, i = row & 127;
        const float* src = PC + (size_t)(b * SEQ + SEQ - 128 + i) * CN;
        pk[(size_t)row * 256 + c] = src[1024 + c];
        pv[(size_t)row * 256 + c] = src[1280 + c];
    } else {
        const int r2 = row - NB * 128, sb = r2 >> 7, i = r2 & 127;
        if (i < 127) {
            sk[(size_t)r2 * 256 + c] = cache_k[((size_t)sb * 128 + i + 1) * 256 + c];
            sv[(size_t)r2 * 256 + c] = cache_v[((size_t)sb * 128 + i + 1) * 256 + c];
        } else {
            const float* src = PC + (size_t)(NP + sb) * CN;
            sk[(size_t)r2 * 256 + c] = src[1024 + c];
            sv[(size_t)r2 * 256 + c] = src[1280 + c];
        }
    }
}
#define XB_TMO      128
#define XB_XCNT(j)  (256  + 64 * (j))
#define XB_XSUB(j)  (1280 + 64 * (j))
#define XB_XGEN(j)  (2304 + 64 * (j))
#define XB_TOP      3328
#define XB_TOPGEN   3392
#define XCD_BAR_WORDS 3456
#define XB_SPIN_CAP (1u << 18)

__device__ __forceinline__ unsigned xb_ld(unsigned* p)              { return __hip_atomic_load(p, __ATOMIC_RELAXED, __HIP_MEMORY_SCOPE_AGENT); }
__device__ __forceinline__ unsigned xb_add(unsigned* p, unsigned v) { return __hip_atomic_fetch_add(p, v, __ATOMIC_RELAXED, __HIP_MEMORY_SCOPE_AGENT); }
__device__ __forceinline__ unsigned xb_xcc_id() { return (unsigned)__builtin_amdgcn_s_getreg((3 << 11) | 20) & 0xFu; }
#define XB_SPIN(cond, bar) do { unsigned _sp = 0; while (cond) { __builtin_amdgcn_s_sleep(1); \
    if ((++_sp & 255u) == 0u) { if (xb_ld(&(bar)[XB_TMO])) break; if (_sp > XB_SPIN_CAP) { atomicAdd(&(bar)[XB_TMO], 1u); break; } } } } while (0)

struct XcdBarrier {
    unsigned* bar; unsigned x;
    volatile LAS unsigned* st;
};

__device__ __forceinline__ XcdBarrier xcd_barrier_post(unsigned* bar, volatile LAS unsigned* st) {
    XcdBarrier b; b.bar = bar; b.x = xb_xcc_id(); b.st = st;
    if (threadIdx.x == 0) (void)xb_add(&bar[XB_XCNT(b.x)], 1u);
    return b;
}
__device__ __forceinline__ void xcd_barrier_complete(unsigned* bar, unsigned x, unsigned& nloc, unsigned& nx) {
    const unsigned G = gridDim.x * gridDim.y * gridDim.z;
    unsigned sum, cnt, mine, sp = 0u;
    for (;;) {
        sum = 0u; cnt = 0u; mine = 0u;
#pragma unroll
        for (unsigned j = 0; j < 16; ++j) { const unsigned c = xb_ld(&bar[XB_XCNT(j)]); sum += c; cnt += (c > 0u) ? 1u : 0u; mine = (j == x) ? c : mine; }
        if (sum == G) break;
        __builtin_amdgcn_s_sleep(1);
        if ((++sp & 255u) == 0u) { if (xb_ld(&bar[XB_TMO])) break; if (sp > XB_SPIN_CAP) { atomicAdd(&bar[XB_TMO], 1u); break; } }
    }
    nloc = mine > 0u ? mine : 1u; nx = cnt > 0u ? cnt : 1u;
}

__device__ __forceinline__ void xcd_barrier(const XcdBarrier& b) {
    asm volatile("s_waitcnt vmcnt(0)" ::: "memory");
    __syncthreads();
    if (threadIdx.x == 0) {
        unsigned* bar = b.bar;
        __builtin_amdgcn_s_waitcnt(0);
        unsigned nloc = b.st[0], nx = b.st[1];
        if (nloc == 0u) { xcd_barrier_complete(bar, b.x, nloc, nx); b.st[0] = nloc; b.st[1] = nx; }
        const unsigned old = xb_add(&bar[XB_XSUB(b.x)], 1u);
        const unsigned gen = old / nloc;
        if (old + 1u == (gen + 1u) * nloc) {
            __builtin_amdgcn_fence(__ATOMIC_RELEASE, "agent");
            asm volatile("s_waitcnt vmcnt(0)" ::: "memory");
            const unsigned og = xb_add(&bar[XB_TOP], 1u);
            const unsigned tg = og / nx;
            if (og + 1u == (tg + 1u) * nx) xb_add(&bar[XB_TOPGEN], 1u);
            else XB_SPIN(xb_ld(&bar[XB_TOPGEN]) == tg, bar);
            __builtin_amdgcn_fence(__ATOMIC_ACQUIRE, "agent");
            xb_add(&bar[XB_XGEN(b.x)], 1u);
            asm volatile("s_waitcnt vmcnt(0)" ::: "memory");
        } else {
            XB_SPIN(xb_ld(&bar[XB_XGEN(b.x)]) == gen, bar);
            __builtin_amdgcn_fence(__ATOMIC_ACQUIRE, "agent");
            asm volatile("s_waitcnt vmcnt(0)" ::: "memory");
        }
    }
    __syncthreads();
}

typedef short bf16x8_t __attribute__((ext_vector_type(8)));
__device__ __forceinline__ f32x4 mfma16(bf16x8_t a, bf16x8_t b, f32x4 c) { return __builtin_amdgcn_mfma_f32_16x16x32_bf16(a, b, c, 0, 0, 0); }

struct GdnChunkBufs {
    bf16* W;
    bf16* QG;
    bf16* KDT;
    bf16* UT;
    bf16* QK;
    float* EGL;
};

constexpr int GP_QB = 0, GP_KB = 17408, GP_VB = 34816, GP_LS = 52224, GP_QKS = 69632, GP_WS = 78848, GP_SC = 96256;

__device__ __forceinline__ void gdn_prep_unit(const bf16* __restrict__ PROJ, const float* __restrict__ conv_w, const float* __restrict__ a_log, const float* __restrict__ dt_bias,
                                              const GdnChunkBufs& cb, float* __restrict__ p_gdn_conv, int un, unsigned char* lds) {
    int tid = threadIdx.x; asm volatile("" : "+v"(tid));
    const int lane = tid & 63, wave = __builtin_amdgcn_readfirstlane(tid >> 6), fr = lane & 15, fq = lane >> 4;
    const int h = un & 3, n = (un >> 2) & 63, b = un >> 8;
    const int t0 = b * SEQ + n * 64;
    bf16* Qb = (bf16*)(lds + GP_QB); bf16* Kb = (bf16*)(lds + GP_KB); bf16* Vb = (bf16*)(lds + GP_VB); bf16* Ws = (bf16*)(lds + GP_WS);
    float* Ls = (float*)(lds + GP_LS); bf16* QKs = (bf16*)(lds + GP_QKS);
    float* gcs = (float*)(lds + GP_SC); float* bets = gcs + 64; float* egcs = gcs + 128; float* ekds = gcs + 192; float* begs = gcs + 256;
    if (wave == 0) {
        const bf16* prow = PROJ + (size_t)(t0 + lane) * ABN;
        const float a_raw = bf2f(prow[C_A + h]), b_raw = bf2f(prow[C_B + h]);
        float g = -expf(a_log[h]) * softplusf_(a_raw + dt_bias[h]);
#pragma unroll
        for (int off = 1; off < 64; off <<= 1) { const float v = __shfl_up(g, off); if (lane >= off) g += v; }
        const float glast = __shfl(g, 63);
        { const float be_ = sigmoidf_(b_raw), eg_ = expf(g); gcs[lane] = g; bets[lane] = be_; egcs[lane] = eg_; ekds[lane] = expf(glast - g); begs[lane] = be_ * eg_; }
        if (lane == 0) cb.EGL[un] = expf(glast);
    }
    {
        int cols[6]; float cw[4][6], xw[3][6];
#pragma unroll
        for (int p = 0; p < 3; ++p)
#pragma unroll
            for (int e = 0; e < 2; ++e) cols[p * 2 + e] = p * 512 + h * 128 + e * 64 + lane;
#pragma unroll
        for (int i = 0; i < 4; ++i)
#pragma unroll
            for (int c = 0; c < 6; ++c) cw[i][c] = conv_w[i * 1536 + cols[c]];
        const int i0 = wave * 8;
#pragma unroll
        for (int k = 0; k < 3; ++k) {
            const int pos = n * 64 + i0 - 3 + k;
#pragma unroll
            for (int c = 0; c < 6; ++c) xw[k][c] = pos >= 0 ? bf2f(PROJ[(size_t)(t0 + i0 - 3 + k) * ABN + cols[c]]) : 0.f;
        }
        bf16 xraw[8][6];
#pragma unroll
        for (int ii = 0; ii < 8; ++ii)
#pragma unroll
            for (int c = 0; c < 6; ++c) xraw[ii][c] = PROJ[(size_t)(t0 + i0 + ii) * ABN + cols[c]];
#pragma unroll
        for (int ii = 0; ii < 8; ++ii) {
            const int i = i0 + ii;
            float xt[6], s[6];
#pragma unroll
            for (int c = 0; c < 6; ++c) xt[c] = bf2f(xraw[ii][c]);
#pragma unroll
            for (int c = 0; c < 6; ++c) { const float y_ = cw[0][c] * xw[0][c] + cw[1][c] * xw[1][c] + cw[2][c] * xw[2][c] + cw[3][c] * xt[c]; s[c] = y_ * __frcp_rn(1.0f + __expf(-y_)); }
            const float qs = rsqrtf(wave_sum(s[0] * s[0] + s[1] * s[1]) + 1e-6f) * 0.08838834764831845f;
            const float ks = rsqrtf(wave_sum(s[2] * s[2] + s[3] * s[3]) + 1e-6f);
            Qb[i * 136 + lane] = (bf16)f2bf(s[0] * qs); Qb[i * 136 + 64 + lane] = (bf16)f2bf(s[1] * qs);
            Kb[i * 136 + lane] = (bf16)f2bf(s[2] * ks); Kb[i * 136 + 64 + lane] = (bf16)f2bf(s[3] * ks);
            Vb[i * 136 + lane] = (bf16)f2bf(s[4]);      Vb[i * 136 + 64 + lane] = (bf16)f2bf(s[5]);
            if (n == 63 && i >= 61) {
#pragma unroll
                for (int c = 0; c < 6; ++c) p_gdn_conv[((size_t)b * 3 + (i - 61)) * 1536 + cols[c]] = xt[c];
            }
#pragma unroll
            for (int c = 0; c < 6; ++c) { xw[0][c] = xw[1][c]; xw[1][c] = xw[2][c]; xw[2][c] = xt[c]; }
        }
    }
    __syncthreads();
    {
        const int mi = wave >> 1;
        bf16x8_t aK[4], aQ[4];
#pragma unroll
        for (int ks = 0; ks < 4; ++ks) { aK[ks] = *(const bf16x8_t*)(Kb + (mi * 16 + fr) * 136 + ks * 32 + 8 * fq); aQ[ks] = *(const bf16x8_t*)(Qb + (mi * 16 + fr) * 136 + ks * 32 + 8 * fq); }
#pragma unroll
        for (int nn = 0; nn < 2; ++nn) {
            const int nj = (wave & 1) * 2 + nn;
            f32x4 accK = (f32x4){0.f, 0.f, 0.f, 0.f}, accQ = accK;
#pragma unroll
            for (int ks = 0; ks < 4; ++ks) { const bf16x8_t bk = *(const bf16x8_t*)(Kb + (nj * 16 + fr) * 136 + ks * 32 + 8 * fq); accK = mfma16(aK[ks], bk, accK); accQ = mfma16(aQ[ks], bk, accQ); }
            const int j = nj * 16 + fr; const float gj = gcs[j];
#pragma unroll
            for (int r = 0; r < 4; ++r) {
                const int i = mi * 16 + 4 * fq + r;
                const float dec = i >= j ? expf(gcs[i] - gj) : 0.f;
                Ls[j * 68 + i] = i > j ? bets[i] * accK[r] * dec : 0.f;
                QKs[i * 72 + j] = (bf16)f2bf(i >= j ? accQ[r] * dec : 0.f);
            }
        }
    }
    __syncthreads();
    if (wave < 4) {
        float x[64];
        const bool isu = tid < 128; const int c = isu ? tid : tid - 128;
        const LAS unsigned char* l3 = (const LAS unsigned char*)lds;
        unsigned so = (isu ? GP_VB : GP_KB) + c * 2, ro = GP_SC + (isu ? 64 * 4 : 256 * 4), lo = GP_LS;
        asm volatile("" : "+v"(so), "+v"(ro), "+v"(lo));
#pragma unroll
        for (int i = 0; i < 64; ++i) x[i] = *(const LAS float*)(l3 + ro + 4 * i) * bf2f(*(const LAS bf16*)(l3 + so + i * 272));
#pragma unroll
        for (int j = 0; j < 63; ++j) {
#pragma unroll
            for (int i4 = (j + 1) / 4; i4 < 16; ++i4) {
                const f32x4 l4 = *(const LAS f32x4*)(l3 + lo + j * 272 + i4 * 16);
                if (i4 * 4 + 0 > j) x[i4 * 4 + 0] -= l4.x * x[j];
                if (i4 * 4 + 1 > j) x[i4 * 4 + 1] -= l4.y * x[j];
                if (i4 * 4 + 2 > j) x[i4 * 4 + 2] -= l4.z * x[j];
                if (i4 * 4 + 3 > j) x[i4 * 4 + 3] -= l4.w * x[j];
            }
        }
        if (isu) {
            bf16* dst = cb.UT + ((size_t)un * 128 + c) * 64;
#pragma unroll
            for (int i8 = 0; i8 < 8; ++i8) { v4u o; o.x = pk2(x[i8 * 8 + 0], x[i8 * 8 + 1]); o.y = pk2(x[i8 * 8 + 2], x[i8 * 8 + 3]); o.z = pk2(x[i8 * 8 + 4], x[i8 * 8 + 5]); o.w = pk2(x[i8 * 8 + 6], x[i8 * 8 + 7]); *(v4u*)(dst + i8 * 8) = o; }
        } else {
#pragma unroll
            for (int i = 0; i < 64; ++i) Ws[i * 136 + c] = (bf16)f2bf(x[i]);
        }
    } else {
        const int t2 = tid - 256;
#pragma unroll
        for (int k = 0; k < 4; ++k) {
            const int ci = t2 + 256 * k, i = ci >> 4, d0 = (ci & 15) * 8; const float e = egcs[i];
            const v4u q = *(const v4u*)(Qb + i * 136 + d0);
            v4u o; o.x = pk2(bflo(q.x) * e, bfhi(q.x) * e); o.y = pk2(bflo(q.y) * e, bfhi(q.y) * e); o.z = pk2(bflo(q.z) * e, bfhi(q.z) * e); o.w = pk2(bflo(q.w) * e, bfhi(q.w) * e);
            *(v4u*)(cb.QG + ((size_t)un * 64 + i) * 128 + d0) = o;
        }
#pragma unroll
        for (int k = 0; k < 4; ++k) {
            const int ci = t2 + 256 * k, d = ci & 127, i0 = (ci >> 7) * 8;
            float v[8];
#pragma unroll
            for (int q = 0; q < 8; ++q) v[q] = bf2f(Kb[(i0 + q) * 136 + d]) * ekds[i0 + q];
            v4u o; o.x = pk2(v[0], v[1]); o.y = pk2(v[2], v[3]); o.z = pk2(v[4], v[5]); o.w = pk2(v[6], v[7]);
            *(v4u*)(cb.KDT + ((size_t)un * 128 + d) * 64 + i0) = o;
        }
#pragma unroll
        for (int k = 0; k < 2; ++k) {
            const int ci = t2 + 256 * k, i = ci >> 3, j0 = (ci & 7) * 8;
            *(v4u*)(cb.QK + ((size_t)un * 64 + i) * 64 + j0) = *(const v4u*)(QKs + i * 72 + j0);
        }
    }
    __syncthreads();
#pragma unroll
    for (int k = 0; k < 2; ++k) {
        const int ci = tid + 512 * k, i = ci >> 4, d0 = (ci & 15) * 8;
        *(v4u*)(cb.W + ((size_t)un * 64 + i) * 128 + d0) = *(const v4u*)(Ws + i * 136 + d0);
    }
    __syncthreads();
}

constexpr int GS_ST = 0, GS_VNT = 2 * 32 * 136 * 2, GS_END = GS_VNT + 32 * 72 * 2;
template <int N0, int N1>
__device__ __forceinline__ void gdn_seq(const GdnChunkBufs& cb, float* __restrict__ O, float* __restrict__ Sout, int b, int h, int sl, unsigned char* lds, f32x4 (&accS)[2], int& cur) {
    int tid = threadIdx.x; asm volatile("" : "+v"(tid));
    const int lane = tid & 63, wave = __builtin_amdgcn_readfirstlane(tid >> 6), fr = lane & 15, fq = lane >> 4;
    const int mi = wave >> 1, nj = wave & 1;
    bf16* St = (bf16*)(lds + GS_ST); bf16* VnT = (bf16*)(lds + GS_VNT);
    float* egls = (float*)(lds + GS_END);
    if (N0 == 0) {
        for (int i = tid; i < 2 * 32 * 136 / 2; i += NTH) ((unsigned*)St)[i] = 0u;
        accS[0] = (f32x4){0.f, 0.f, 0.f, 0.f}; accS[1] = accS[0]; cur = 0;
    }
    if (tid >= N0 && tid < N1) egls[tid] = cb.EGL[(size_t)((b * 64 + tid) * 4 + h)];
    __syncthreads();
#define GS_DECL(X) bf16x8_t aW##X[4], aQG##X[4], aQK##X[2], aKD##X[2]; v2u ut##X;
    GS_DECL(0) GS_DECL(1) GS_DECL(2)
#define GS_GLD16(dst, ptr) asm volatile("global_load_dwordx4 %0, %1, off" : "=v"(dst) : "v"(ptr))
#define GS_GLD8(dst, ptr) asm volatile("global_load_dwordx2 %0, %1, off" : "=v"(dst) : "v"(ptr))
#define GS_LOAD(X, n_) do { const size_t u_ = (size_t)((b * 64 + ((n_) < 63 ? (n_) : 63)) * 4 + h);     \
        _Pragma("unroll") for (int ks = 0; ks < 4; ++ks) { GS_GLD16(aW##X[ks], cb.W + (u_ * 64 + mi * 16 + fr) * 128 + ks * 32 + 8 * fq); GS_GLD16(aQG##X[ks], cb.QG + (u_ * 64 + mi * 16 + fr) * 128 + ks * 32 + 8 * fq); } \
        _Pragma("unroll") for (int ks = 0; ks < 2; ++ks) { GS_GLD16(aQK##X[ks], cb.QK + (u_ * 64 + mi * 16 + fr) * 64 + ks * 32 + 8 * fq); GS_GLD16(aKD##X[ks], cb.KDT + (u_ * 128 + wave * 16 + fr) * 64 + ks * 32 + 8 * fq); } \
        GS_GLD8(ut##X, cb.UT + (u_ * 128 + sl * 32 + nj * 16 + fr) * 64 + mi * 16 + 4 * fq); } while (0)
#define GS_WAITN(X, N) asm volatile("s_waitcnt vmcnt(" #N ")" : "+v"(aW##X[0]), "+v"(aW##X[1]), "+v"(aW##X[2]), "+v"(aW##X[3]), "+v"(aQG##X[0]), "+v"(aQG##X[1]), "+v"(aQG##X[2]), "+v"(aQG##X[3]), \
        "+v"(aQK##X[0]), "+v"(aQK##X[1]), "+v"(aKD##X[0]), "+v"(aKD##X[1]), "+v"(ut##X))
#define GS_WAIT(X, n_) GS_WAITN(X, 26)
#define GS_STEP(X, n_) do { \
        const float egl##X = egls[(n_)]; \
        GS_WAIT(X, n_); \
        __syncthreads();                                        \
        f32x4 accW = (f32x4){0.f, 0.f, 0.f, 0.f}, accO = accW; \
        const bf16* Sc = St + cur * 32 * 136; \
        _Pragma("unroll") for (int ks = 0; ks < 4; ++ks) { const bf16x8_t bs = *(const bf16x8_t*)(Sc + (nj * 16 + fr) * 136 + ks * 32 + 8 * fq); accW = mfma16(aW##X[ks], bs, accW); accO = mfma16(aQG##X[ks], bs, accO); } \
          \
        const float v0 = bflo(ut##X.x) - accW[0], v1 = bfhi(ut##X.x) - accW[1], v2 = bflo(ut##X.y) - accW[2], v3 = bfhi(ut##X.y) - accW[3]; \
        { v2u o; o.x = pk2(v0, v1); o.y = pk2(v2, v3); *(v2u*)(VnT + (nj * 16 + fr) * 72 + mi * 16 + 4 * fq) = o; } \
        __syncthreads();                                        \
        _Pragma("unroll") for (int ks = 0; ks < 2; ++ks) { const bf16x8_t bv = *(const bf16x8_t*)(VnT + (nj * 16 + fr) * 72 + ks * 32 + 8 * fq); accO = mfma16(aQK##X[ks], bv, accO); } \
        { float* orow = O + (size_t)(b * SEQ + (n_) * 64 + mi * 16 + 4 * fq) * 512 + h * 128 + sl * 32 + nj * 16 + fr; \
          orow[0] = accO[0]; orow[512] = accO[1]; orow[1024] = accO[2]; orow[1536] = accO[3]; } \
          \
        bf16* Sn = St + (cur ^ 1) * 32 * 136; \
        _Pragma("unroll") for (int njj = 0; njj < 2; ++njj) { \
            accS[njj] = accS[njj] * egl##X; \
            _Pragma("unroll") for (int ks = 0; ks < 2; ++ks) { const bf16x8_t bv = *(const bf16x8_t*)(VnT + (njj * 16 + fr) * 72 + ks * 32 + 8 * fq); accS[njj] = mfma16(aKD##X[ks], bv, accS[njj]); } \
            v2u o; o.x = pk2(accS[njj][0], accS[njj][1]); o.y = pk2(accS[njj][2], accS[njj][3]); \
            *(v2u*)(Sn + (njj * 16 + fr) * 136 + wave * 16 + 4 * fq) = o; } \
        cur ^= 1; } while (0)
    constexpr int NTRI = (N1 - N0) / 3, NREM = (N1 - N0) % 3, NM = N0 + 3 * NTRI;
    GS_LOAD(0, N0); GS_LOAD(1, N0 + 1);
#pragma unroll 1
    for (int n = N0; n < NM; n += 3) {
        GS_LOAD(2, n + 2);
        GS_STEP(0, n);
        GS_LOAD(0, n + 3);
        GS_STEP(1, n + 1);
        GS_LOAD(1, n + 4);
        GS_STEP(2, n + 2);
    }
    if (NREM >= 1) { GS_LOAD(2, NM + 2); GS_STEP(0, NM); }
    if (NREM == 2) { GS_LOAD(0, NM + 3); GS_STEP(1, NM + 1); }
    GS_WAITN(0, 0); GS_WAITN(1, 0); GS_WAITN(2, 0);
#undef GS_STEP
#undef GS_DECL
#undef GS_WAIT
#undef GS_WAITN
#undef GS_GLD16
#undef GS_GLD8
    asm volatile("s_waitcnt vmcnt(0)" ::: "memory");
#undef GS_LOAD
    if (N1 == 64) {
#pragma unroll
        for (int njj = 0; njj < 2; ++njj)
#pragma unroll
            for (int r = 0; r < 4; ++r) Sout[(((size_t)b * 4 + h) * 128 + wave * 16 + 4 * fq + r) * 128 + sl * 32 + njj * 16 + fr] = accS[njj][r];
    }
    __syncthreads();
}

__device__ __forceinline__ void lru_prep_unit(const bf16* __restrict__ PROJ, const float* __restrict__ conv_w, const float* __restrict__ conv_b,
                                              const float* __restrict__ w_r, const float* __restrict__ b_r, const float* __restrict__ w_i, const float* __restrict__ b_i, const float* __restrict__ lam,
                                              float* __restrict__ H, float* __restrict__ P, float* __restrict__ Hend, float* __restrict__ Pend, float* __restrict__ p_lru_conv, int ub) {
    int c = threadIdx.x; asm volatile("" : "+v"(c));
    const int nblk = c >> 6, d = c & 63;
    const int n = ub & 63, b = ub >> 6, t0 = b * SEQ + n * 64;
    float wr[64], wi[64];
#pragma unroll
    for (int cc = 0; cc < 64; ++cc) { wr[cc] = w_r[((size_t)nblk * 64 + cc) * 64 + d]; wi[cc] = w_i[((size_t)nblk * 64 + cc) * 64 + d]; }
    const float cw0 = conv_w[c], cw1 = conv_w[512 + c], cw2 = conv_w[1024 + c], cw3 = conv_w[1536 + c], cb_ = conv_b[c];
    const float br = b_r[c], bi = b_i[c], spl = -8.0f * softplusf_(-lam[c]);
    float x0 = (n * 64 - 3 >= 0) ? bf2f(PROJ[(size_t)(t0 - 3) * ABN + C_XR + c]) : 0.f;
    float x1 = (n * 64 - 2 >= 0) ? bf2f(PROJ[(size_t)(t0 - 2) * ABN + C_XR + c]) : 0.f;
    float x2 = (n * 64 - 1 >= 0) ? bf2f(PROJ[(size_t)(t0 - 1) * ABN + C_XR + c]) : 0.f;
    float hloc = 0.f, ploc = 1.f;
    bf16 xa[16], xb[16];
#pragma unroll
    for (int k = 0; k < 16; ++k) xa[k] = PROJ[(size_t)(t0 + k) * ABN + C_XR + c];
#pragma unroll 1
    for (int ib = 0; ib < 64; ib += 16) {
      if (ib + 16 < 64) {
#pragma unroll
        for (int k = 0; k < 16; ++k) xb[k] = PROJ[(size_t)(t0 + ib + 16 + k) * ABN + C_XR + c];
      }
#pragma unroll
      for (int k = 0; k < 16; ++k) {
        const int i = ib + k;
        const float xt = bf2f(xa[k]);
        const float xr = cb_ + cw0 * x0 + cw1 * x1 + cw2 * x2 + cw3 * xt;
        f32x2_t ga = (f32x2_t){br, bi}, gb = (f32x2_t){0.f, 0.f};
#pragma unroll
        for (int cc = 0; cc < 64; cc += 2) {
            const float xa_ = __uint_as_float(__builtin_amdgcn_readlane(__float_as_uint(xr), cc)), xb_ = __uint_as_float(__builtin_amdgcn_readlane(__float_as_uint(xr), cc + 1));
            ga += (f32x2_t){xa_, xa_} * (f32x2_t){wr[cc], wi[cc]}; gb += (f32x2_t){xb_, xb_} * (f32x2_t){wr[cc + 1], wi[cc + 1]};
        }
        ga += gb;
        const float r = __frcp_rn(1.0f + __expf(-ga.x)), ii = __frcp_rn(1.0f + __expf(-ga.y));
        const float a = __expf(spl * r), bb = __fsqrt_rn(fmaxf(1.0f - a * a, 0.f)) * (ii * xr);
        hloc = a * hloc + bb; ploc *= a;
        H[(size_t)(t0 + i) * 512 + c] = hloc; P[(size_t)(t0 + i) * 512 + c] = ploc;
        if (n == 63 && i >= 61) p_lru_conv[((size_t)b * 3 + (i - 61)) * 512 + c] = xt;
        x0 = x1; x1 = x2; x2 = xt;
      }
#pragma unroll
      for (int k = 0; k < 16; ++k) xa[k] = xb[k];
    }
    Hend[(size_t)ub * 512 + c] = hloc; Pend[(size_t)ub * 512 + c] = ploc;
}
constexpr int LR_XR = 64 * 68 * 4;
__device__ __forceinline__ void lru_prep_unit2(const bf16* __restrict__ PROJ, const float* __restrict__ conv_w, const float* __restrict__ conv_b,
                                               const bf16* __restrict__ WRT, const bf16* __restrict__ WIT  , const float* __restrict__ b_r, const float* __restrict__ b_i, const float* __restrict__ lam,
                                               float* __restrict__ H, float* __restrict__ P, float* __restrict__ Hend, float* __restrict__ Pend, float* __restrict__ p_lru_conv, int ub, unsigned char* lds) {
    int tid = threadIdx.x; asm volatile("" : "+v"(tid));
    const int lane = tid & 63, wave = __builtin_amdgcn_readfirstlane(tid >> 6), fr = lane & 15, fq = lane >> 4;
    const int n = ub & 63, b = ub >> 6, t0 = b * SEQ + n * 64;
    float* XR = (float*)(lds + wave * LR_XR);
    {
        const int c = wave * 64 + lane;
        const float cw0 = conv_w[c], cw1 = conv_w[512 + c], cw2 = conv_w[1024 + c], cw3 = conv_w[1536 + c], cb_ = conv_b[c];
        float x0 = (n * 64 - 3 >= 0) ? bf2f(PROJ[(size_t)(t0 - 3) * ABN + C_XR + c]) : 0.f;
        float x1 = (n * 64 - 2 >= 0) ? bf2f(PROJ[(size_t)(t0 - 2) * ABN + C_XR + c]) : 0.f;
        float x2 = (n * 64 - 1 >= 0) ? bf2f(PROJ[(size_t)(t0 - 1) * ABN + C_XR + c]) : 0.f;
#pragma unroll 1
        for (int ib = 0; ib < 64; ib += 16) {
            bf16 xa[16];
#pragma unroll
            for (int k = 0; k < 16; ++k) xa[k] = PROJ[(size_t)(t0 + ib + k) * ABN + C_XR + c];
#pragma unroll
            for (int k = 0; k < 16; ++k) {
                const int i = ib + k; const float xt = bf2f(xa[k]);
                XR[i * 68 + lane] = cb_ + cw0 * x0 + cw1 * x1 + cw2 * x2 + cw3 * xt;
                if (n == 63 && i >= 61) p_lru_conv[((size_t)b * 3 + (i - 61)) * 512 + c] = xt;
                x0 = x1; x1 = x2; x2 = xt;
            }
        }
    }
    asm volatile("s_waitcnt lgkmcnt(0)" ::: "memory");
    bf16x8_t bR[4][2], bI[4][2];
#pragma unroll
    for (int nt = 0; nt < 4; ++nt)
#pragma unroll
        for (int ks = 0; ks < 2; ++ks) {
            bR[nt][ks] = *(const bf16x8_t*)(WRT + ((size_t)wave * 64 + nt * 16 + fr) * 64 + ks * 32 + 8 * fq);
            bI[nt][ks] = *(const bf16x8_t*)(WIT + ((size_t)wave * 64 + nt * 16 + fr) * 64 + ks * 32 + 8 * fq);
        }
    float brv[4], biv[4], splv[4];
#pragma unroll
    for (int nt = 0; nt < 4; ++nt) { const int c = wave * 64 + nt * 16 + fr; brv[nt] = b_r[c]; biv[nt] = b_i[c]; splv[nt] = -8.0f * softplusf_(-lam[c]); }
    float hin[4], pin[4];
#pragma unroll
    for (int nt = 0; nt < 4; ++nt) { hin[nt] = 0.f; pin[nt] = 1.f; }
#pragma unroll 1
    for (int mt = 0; mt < 4; ++mt) {
        bf16x8_t aX[2];
#pragma unroll
        for (int ks = 0; ks < 2; ++ks) {
            const f32x4 lo = *(const f32x4*)(XR + (mt * 16 + fr) * 68 + ks * 32 + 8 * fq), hi = *(const f32x4*)(XR + (mt * 16 + fr) * 68 + ks * 32 + 8 * fq + 4);
            v4u w; w.x = pk2(lo.x, lo.y); w.y = pk2(lo.z, lo.w); w.z = pk2(hi.x, hi.y); w.w = pk2(hi.z, hi.w);
            aX[ks] = __builtin_bit_cast(bf16x8_t, w);
        }
#pragma unroll
        for (int nt = 0; nt < 4; ++nt) {
            f32x4 aR = (f32x4){0.f, 0.f, 0.f, 0.f}, aI = aR;
            aR = mfma16(aX[0], bR[nt][0], aR); aR = mfma16(aX[1], bR[nt][1], aR);
            aI = mfma16(aX[0], bI[nt][0], aI); aI = mfma16(aX[1], bI[nt][1], aI);
            float av[4], bv[4];
#pragma unroll
            for (int r = 0; r < 4; ++r) {
                const float rg = __frcp_rn(1.0f + __expf(-(aR[r] + brv[nt]))), ig = __frcp_rn(1.0f + __expf(-(aI[r] + biv[nt])));
                const float a = __expf(splv[nt] * rg);
                av[r] = a; bv[r] = __fsqrt_rn(fmaxf(1.0f - a * a, 0.f)) * (ig * XR[(mt * 16 + 4 * fq + r) * 68 + nt * 16 + fr]);
            }
            float PA[4], PB[4];
            PA[0] = av[0]; PB[0] = bv[0];
#pragma unroll
            for (int r = 1; r < 4; ++r) { PA[r] = av[r] * PA[r - 1]; PB[r] = av[r] * PB[r - 1] + bv[r]; }
            float GA = PA[3], GB = PB[3];
            { const float pa = __shfl_up(GA, 16), pb = __shfl_up(GB, 16); if (fq >= 1) { GB = GA * pb + GB; GA = GA * pa; } }
            { const float pa = __shfl_up(GA, 32), pb = __shfl_up(GB, 32); if (fq >= 2) { GB = GA * pb + GB; GA = GA * pa; } }
            float EA = __shfl_up(GA, 16), EB = __shfl_up(GB, 16);
            if (fq == 0) { EA = 1.f; EB = 0.f; }
            const float h0 = EA * hin[nt] + EB, p0 = pin[nt] * EA;
#pragma unroll
            for (int r = 0; r < 4; ++r) {
                const size_t o = (size_t)(t0 + mt * 16 + 4 * fq + r) * 512 + wave * 64 + nt * 16 + fr;
                H[o] = PA[r] * h0 + PB[r]; P[o] = p0 * PA[r];
            }
            const float TA = __shfl(GA, 48 + fr), TB = __shfl(GB, 48 + fr);
            hin[nt] = TA * hin[nt] + TB; pin[nt] = pin[nt] * TA;
        }
    }
    if (fq == 0) {
#pragma unroll
        for (int nt = 0; nt < 4; ++nt) { Hend[(size_t)ub * 512 + wave * 64 + nt * 16 + fr] = hin[nt]; Pend[(size_t)ub * 512 + wave * 64 + nt * 16 + fr] = pin[nt]; }
    }
    asm volatile("s_waitcnt lgkmcnt(0)" ::: "memory");
}
__device__ __forceinline__ void lru_carry(const float* __restrict__ Hend, const float* __restrict__ Pend, float* __restrict__ CIN, float* __restrict__ hlast, int bx) {
    int tx_ = threadIdx.x; asm volatile("" : "+v"(tx_));
    const int idx = bx * NTH + tx_, b = idx >> 9, c = idx & 511;
    float carry = 0.f;
#pragma unroll 8
    for (int n = 0; n < 64; ++n) {
        const size_t o = ((size_t)b * 64 + n) * 512 + c;
        CIN[o] = carry;
        carry = Hend[o] + Pend[o] * carry;
    }
    hlast[(size_t)b * 512 + c] = carry;
}

__device__ __forceinline__ unsigned f2key(float f) { const unsigned u = __float_as_uint(f); return u ^ ((u >> 31) ? 0xffffffffu : 0x80000000u); }
__device__ __forceinline__ float key2f(unsigned k) { return __uint_as_float(k ^ ((k >> 31) ? 0x80000000u : 0xffffffffu)); }
#define TK_CE(hi, lo) do { const unsigned a_ = (hi), b_ = (lo); (hi) = a_ > b_ ? a_ : b_; (lo) = a_ > b_ ? b_ : a_; } while (0)
template <int N> __device__ __forceinline__ void bitonic_sort_desc(unsigned (&a)[N]) {
#pragma unroll
    for (int k = 2; k <= N; k <<= 1)
#pragma unroll
        for (int j = k >> 1; j > 0; j >>= 1)
#pragma unroll
            for (int i = 0; i < N; ++i) { const int l = i ^ j; if (l > i) { if ((i & k) == 0) TK_CE(a[i], a[l]); else TK_CE(a[l], a[i]); } }
}
template <int XM> __device__ __forceinline__ void merge_top16(unsigned (&a)[16]) {
    unsigned c[16];
#pragma unroll
    for (int i = 0; i < 16; ++i) { const unsigned o = (unsigned)__shfl_xor((int)a[15 - i], XM); c[i] = a[i] > o ? a[i] : o; }
#pragma unroll
    for (int j = 8; j > 0; j >>= 1)
#pragma unroll
        for (int i = 0; i < 16; ++i) { const int l = i ^ j; if (l > i) TK_CE(c[i], c[l]); }
#pragma unroll
    for (int i = 0; i < 16; ++i) a[i] = c[i];
}
constexpr int TK_KS = 0, TK_TS = 2 * 128 * 136 * 2, TK_END = TK_TS + 64 * 2 * 16 * 4;
__device__ __forceinline__ void peer_topk_stage_keys(const bf16* __restrict__ KB, int h, unsigned char* lds) {
    bf16* Ks = (bf16*)(lds + TK_KS);
    for (int ci = threadIdx.x; ci < 2 * 128 * 16; ci += NTH) { const int row = ci >> 4, part = ci & 15;
        *(v4u*)(Ks + row * 136 + part * 8) = *(const v4u*)(KB + ((size_t)h * 256 + row) * 128 + part * 8); }
    __syncthreads();
}
__device__ __forceinline__ void peer_topk4(const bf16* __restrict__ Q, int* __restrict__ EXP, float* __restrict__ GATE, int tile, int h, unsigned char* lds) {
    int tid = threadIdx.x; asm volatile("" : "+v"(tid));
    const int lane = tid & 63, wave = __builtin_amdgcn_readfirstlane(tid >> 6), fr = lane & 15, fq = lane >> 4;
    const bf16* Ks = (const bf16*)(lds + TK_KS); unsigned* Ts = (unsigned*)(lds + TK_TS);
    {
        const int c = wave >> 2, nt = wave & 3;
        bf16x8_t bq[4];
#pragma unroll
        for (int ks = 0; ks < 4; ++ks) bq[ks] = *(const bf16x8_t*)(Q + (size_t)(tile * 64 + nt * 16 + fr) * 2048 + h * 256 + c * 128 + ks * 32 + 8 * fq);
        unsigned a[32];
#pragma unroll
        for (int mt = 0; mt < 8; ++mt) {
            f32x4 acc = (f32x4){0.f, 0.f, 0.f, 0.f};
#pragma unroll
            for (int ks = 0; ks < 4; ++ks) { const bf16x8_t ak = *(const bf16x8_t*)(Ks + (c * 128 + mt * 16 + fr) * 136 + ks * 32 + 8 * fq); acc = mfma16(ak, bq[ks], acc); }
#pragma unroll
            for (int r = 0; r < 4; ++r) a[mt * 4 + r] = (f2key(acc[r]) & ~127u) | (unsigned)(127 - (mt * 16 + 4 * fq + r));
        }
        bitonic_sort_desc<32>(a);
        unsigned t[16];
#pragma unroll
        for (int j = 0; j < 16; ++j) t[j] = a[j];
        merge_top16<16>(t); merge_top16<32>(t);
        if (fq == 0) {
            const int tk = nt * 16 + fr;
#pragma unroll
            for (int j = 0; j < 16; ++j) Ts[(tk * 2 + c) * 16 + j] = t[j];
        }
    }
    __syncthreads();
    if (tid < 256) {
        const int tk = tid >> 2, q = tid & 3;
        const unsigned* t0 = Ts + (tk * 2 + 0) * 16; const unsigned* t1 = Ts + (tk * 2 + 1) * 16;
        unsigned a[16];
#pragma unroll
        for (int s = 0; s < 13; ++s) {
            const int e = s * 4 + q;
            int i, j;
            if (e < 16) { i = 0; j = e; } else if (e < 24) { i = 1; j = e - 16; } else if (e < 29) { i = 2; j = e - 24; } else if (e < 33) { i = 3; j = e - 29; }
            else if (e < 36) { i = 4; j = e - 33; } else if (e < 42) { i = 5 + ((e - 36) >> 1); j = (e - 36) & 1; } else { i = 8 + (e - 42); j = 0; }
            const bool ok = e < 50;
            const float sum = key2f(t0[ok ? i : 0] & ~127u) + key2f(t1[ok ? j : 0] & ~127u);
            a[s] = ok ? ((f2key(sum) & ~255u) | (unsigned)(255 - (i * 16 + j))) : 0u;
        }
        a[13] = 0u; a[14] = 0u; a[15] = 0u;
        bitonic_sort_desc<16>(a);
        merge_top16<1>(a); merge_top16<2>(a);
        float ev[16], sum = 0.f; const float m = key2f(a[0] & ~255u);
#pragma unroll
        for (int j = 0; j < 16; ++j) { ev[j] = __expf(key2f(a[j] & ~255u) - m); sum += ev[j]; }
        const float inv = 1.0f / sum;
        const size_t o = (size_t)(tile * 64 + tk) * 128 + h * 16;
#pragma unroll
        for (int j = 0; j < 16; ++j)
            if ((j >> 2) == q) {
                const int code = 255 - (int)(a[j] & 255u), i = code >> 4, jj = code & 15;
                const int n0 = 127 - (int)(t0[i] & 127u), n1 = 127 - (int)(t1[jj] & 127u);
                EXP[o + j] = n0 * 128 + n1; GATE[o + j] = ev[j] * inv;
            }
    }
    __syncthreads();
}

constexpr int AT_KS = 0, AT_VT = 192 * 72 * 2, AT_BT = AT_VT + 64 * 200 * 2, AT_PW = AT_BT + 4 * 128 * 4, AT_END = AT_PW + 8 * 32 * 72 * 2;
__device__ __forceinline__ void attn_unit(const bf16* __restrict__ PCb, const float* __restrict__ rel_bias, const float* __restrict__ sinks, bf16* __restrict__ ATT, int un, unsigned char* lds) {
    int tid = threadIdx.x; asm volatile("" : "+v"(tid));
    const int lane = tid & 63, wave = __builtin_amdgcn_readfirstlane(tid >> 6), fr = lane & 15, fq = lane >> 4;
    const int kvh = un & 3, qblk = (un >> 2) & 63, b = un >> 8;
    const int q0 = qblk * 64, tb = b * SEQ;
    bf16* Ks = (bf16*)(lds + AT_KS); bf16* Vt = (bf16*)(lds + AT_VT); float* Bt = (float*)(lds + AT_BT); bf16* Pw = (bf16*)(lds + AT_PW) + wave * 32 * 72;
#pragma unroll
    for (int k = 0; k < 3; ++k) {
        const int ci = tid + 512 * k, row = ci >> 3, part = ci & 7, kpos = q0 - 128 + row;
        v4u kv = (v4u){0u, 0u, 0u, 0u}, vv = kv;
        if (kpos >= 0) { const bf16* src = PCb + (size_t)(tb + kpos) * CN + kvh * 64 + part * 8; kv = *(const v4u*)(src + 1024); vv = *(const v4u*)(src + 1280); }
        *(v4u*)(Ks + row * 72 + part * 8) = kv;
        bf16* vd = Vt + (part * 8) * 200 + row;
        vd[0 * 200] = (bf16)(vv.x & 0xffffu); vd[1 * 200] = (bf16)(vv.x >> 16); vd[2 * 200] = (bf16)(vv.y & 0xffffu); vd[3 * 200] = (bf16)(vv.y >> 16);
        vd[4 * 200] = (bf16)(vv.z & 0xffffu); vd[5 * 200] = (bf16)(vv.z >> 16); vd[6 * 200] = (bf16)(vv.w & 0xffffu); vd[7 * 200] = (bf16)(vv.w >> 16);
    }
    Bt[tid] = rel_bias[t5_bucket(tid & 127) * 16 + kvh * 4 + (tid >> 7)];
    __syncthreads();
    const int g = wave >> 1, qs = (wave & 1) * 32, hh = kvh * 4 + g;
    bf16x8_t aQ[2][2];
#pragma unroll
    for (int mt = 0; mt < 2; ++mt)
#pragma unroll
        for (int ks = 0; ks < 2; ++ks) aQ[mt][ks] = *(const bf16x8_t*)(PCb + (size_t)(tb + q0 + qs + mt * 16 + fr) * CN + hh * 64 + ks * 32 + 8 * fq);
    f32x4 sc[2][12];
#pragma unroll
    for (int nt = 0; nt < 12; ++nt) {
        const bf16x8_t b0 = *(const bf16x8_t*)(Ks + (nt * 16 + fr) * 72 + 8 * fq), b1 = *(const bf16x8_t*)(Ks + (nt * 16 + fr) * 72 + 32 + 8 * fq);
#pragma unroll
        for (int mt = 0; mt < 2; ++mt) { f32x4 a = (f32x4){0.f, 0.f, 0.f, 0.f}; a = mfma16(aQ[mt][0], b0, a); a = mfma16(aQ[mt][1], b1, a); sc[mt][nt] = a; }
    }
    const float sink = sinks[hh];
    const float* bt = Bt + g * 128;
#pragma unroll
    for (int mt = 0; mt < 2; ++mt)
#pragma unroll
        for (int r = 0; r < 4; ++r) {
            const int qi = qs + mt * 16 + 4 * fq + r;
            float mx = sink;
#pragma unroll
            for (int nt = 0; nt < 12; ++nt) {
                const int kk = nt * 16 + fr, rel = qi + 128 - kk;
                const bool valid = rel >= 0 && rel < 128 && (q0 - 128 + kk) >= 0;
                const float lg = valid ? sc[mt][nt][r] * 0.125f + bt[valid ? rel : 0] : -INFINITY;
                sc[mt][nt][r] = lg; mx = fmaxf(mx, lg);
            }
            mx = fmaxf(mx, __shfl_xor(mx, 1)); mx = fmaxf(mx, __shfl_xor(mx, 2)); mx = fmaxf(mx, __shfl_xor(mx, 4)); mx = fmaxf(mx, __shfl_xor(mx, 8));
            float sum = 0.f;
#pragma unroll
            for (int nt = 0; nt < 12; ++nt) { const float p = __expf(sc[mt][nt][r] - mx); sc[mt][nt][r] = p; sum += p; }
            sum += __shfl_xor(sum, 1); sum += __shfl_xor(sum, 2); sum += __shfl_xor(sum, 4); sum += __shfl_xor(sum, 8);
            const float inv = 1.0f / (sum + __expf(sink - mx));
#pragma unroll
            for (int nt = 0; nt < 12; ++nt) sc[mt][nt][r] *= inv;
        }
    f32x4 oacc[2][4];
#pragma unroll
    for (int mt = 0; mt < 2; ++mt)
#pragma unroll
        for (int dt = 0; dt < 4; ++dt) oacc[mt][dt] = (f32x4){0.f, 0.f, 0.f, 0.f};
#pragma unroll
    for (int kc = 0; kc < 3; ++kc) {
#pragma unroll
        for (int mt = 0; mt < 2; ++mt)
#pragma unroll
            for (int n4 = 0; n4 < 4; ++n4)
#pragma unroll
                for (int r = 0; r < 4; ++r) Pw[(mt * 16 + 4 * fq + r) * 72 + n4 * 16 + fr] = (bf16)f2bf(sc[mt][kc * 4 + n4][r]);
        asm volatile("s_waitcnt lgkmcnt(0)" ::: "memory");
#pragma unroll
        for (int ks = 0; ks < 2; ++ks) {
            const bf16x8_t p0 = *(const bf16x8_t*)(Pw + fr * 72 + ks * 32 + 8 * fq), p1 = *(const bf16x8_t*)(Pw + (16 + fr) * 72 + ks * 32 + 8 * fq);
#pragma unroll
            for (int dt = 0; dt < 4; ++dt) {
                const bf16x8_t bv = *(const bf16x8_t*)(Vt + (dt * 16 + fr) * 200 + kc * 64 + ks * 32 + 8 * fq);
                oacc[0][dt] = mfma16(p0, bv, oacc[0][dt]); oacc[1][dt] = mfma16(p1, bv, oacc[1][dt]);
            }
        }
        asm volatile("s_waitcnt lgkmcnt(0)" ::: "memory");
    }
#pragma unroll
    for (int mt = 0; mt < 2; ++mt)
#pragma unroll
        for (int dt = 0; dt < 4; ++dt)
#pragma unroll
            for (int r = 0; r < 4; ++r) Pw[(mt * 16 + 4 * fq + r) * 72 + dt * 16 + fr] = (bf16)f2bf(oacc[mt][dt][r]);
    asm volatile("s_waitcnt lgkmcnt(0)" ::: "memory");
#pragma unroll
    for (int k = 0; k < 4; ++k) {
        const int ci = lane + 64 * k, row = ci >> 3, part = ci & 7;
        *(v4u*)(ATT + (size_t)(tb + q0 + qs + row) * D + hh * 64 + part * 8) = *(const v4u*)(Pw + row * 72 + part * 8);
    }
    __syncthreads();
}

__device__ __forceinline__ void swa_attn_sample(const bf16* __restrict__ PCb, const float* __restrict__ cache_k, const float* __restrict__ cache_v,
                                                const float* __restrict__ rel_bias, const float* __restrict__ sinks, bf16* __restrict__ ATT, int gw, int lane) {
    const int sb = gw >> 4, h = gw & 15, kvh = h >> 2, t = NP + sb;
    const bf16* qrow = PCb + (size_t)t * CN + h * 64;
    float lg[2];
#pragma unroll
    for (int rr = 0; rr < 2; ++rr) {
        const int r = lane + 64 * rr;
        float dot = 0.f;
        if (r == 0) {
            const bf16* krow = PCb + (size_t)t * CN + 1024 + kvh * 64;
            for (int d = 0; d < 64; ++d) dot += bf2f(qrow[d]) * bf2f(krow[d]);
        } else {
            const float* krow = cache_k + (((size_t)sb * 128 + (128 - r)) * 4 + kvh) * 64;
#pragma unroll
            for (int d4 = 0; d4 < 16; ++d4) { const float4 kv = *(const float4*)(krow + d4 * 4);
                dot += bf2f(qrow[d4 * 4]) * kv.x + bf2f(qrow[d4 * 4 + 1]) * kv.y + bf2f(qrow[d4 * 4 + 2]) * kv.z + bf2f(qrow[d4 * 4 + 3]) * kv.w; }
        }
        lg[rr] = dot * 0.125f + rel_bias[t5_bucket(r) * 16 + h];
    }
    const float sink = sinks[h];
    const float m = fmaxf(wave_max(fmaxf(lg[0], lg[1])), sink);
    float p[2] = {expf(lg[0] - m), expf(lg[1] - m)};
    const float inv = 1.0f / (wave_sum(p[0] + p[1]) + expf(sink - m));
    float o = 0.f;
#pragma unroll
    for (int rr = 0; rr < 2; ++rr)
        for (int l2 = 0; l2 < 64; ++l2) {
            const int r = l2 + 64 * rr;
            const float pj = __shfl(p[rr], l2);
            const float vv = (r == 0) ? bf2f(PCb[(size_t)t * CN + 1280 + kvh * 64 + lane]) : cache_v[(((size_t)sb * 128 + (128 - r)) * 4 + kvh) * 64 + lane];
            o += pj * vv;
        }
    ATT[(size_t)t * D + h * 64 + lane] = (bf16)f2bf(o * inv);
}
__device__ __forceinline__ void swa_kv_out2(const bf16* __restrict__ PCb, const float* __restrict__ cache_k, const float* __restrict__ cache_v,
                                            float* __restrict__ pk, float* __restrict__ pv, float* __restrict__ sk, float* __restrict__ sv, int vb) {
    int tx_ = threadIdx.x; asm volatile("" : "+v"(tx_));
    const int c = tx_ & 255, row = vb * 2 + (tx_ >> 8);
    if (row < NB * 128) {
        const int b = row >> 7, i = row & 127;
        const bf16* src = PCb + (size_t)(b * SEQ + SEQ - 128 + i) * CN;
        pk[(size_t)row * 256 + c] = bf2f(src[1024 + c]);
        pv[(size_t)row * 256 + c] = bf2f(src[1280 + c]);
    } else {
        const int r2 = row - NB * 128, sb = r2 >> 7, i = r2 & 127;
        if (i < 127) {
            sk[(size_t)r2 * 256 + c] = cache_k[((size_t)sb * 128 + i + 1) * 256 + c];
            sv[(size_t)r2 * 256 + c] = cache_v[((size_t)sb * 128 + i + 1) * 256 + c];
        } else {
            const bf16* src = PCb + (size_t)(NP + sb) * CN;
            sk[(size_t)r2 * 256 + c] = bf2f(src[1024 + c]);
            sv[(size_t)r2 * 256 + c] = bf2f(src[1280 + c]);
        }
    }
}

constexpr size_t MiB = 1u << 20;
constexpr size_t WS_CTL = 0, CTL_ZERO_BYTES = 64 * 1024;
constexpr size_t WS_WAB = 1 * MiB;
constexpr size_t WS_WOUT = WS_WAB + (size_t)ABNP * D * 2;
constexpr size_t WS_WQ0 = WS_WOUT + (size_t)D * D * 2;
constexpr size_t WS_WQ1 = WS_WQ0 + (size_t)2048 * D * 2;
constexpr size_t WS_WINC = WS_WQ1 + (size_t)2048 * D * 2;
constexpr size_t WS_WOUTC = WS_WINC + (size_t)CN * D * 2;
constexpr size_t WS_ABUF = WS_WOUTC + (size_t)D * D * 2;
constexpr size_t WS_P = WS_ABUF + (size_t)MP * D * 2;
constexpr size_t WS_T = WS_P + (size_t)MP * ABN * 2;
constexpr size_t WS_Q = WS_T + (size_t)4 * 16384 * D + (size_t)4 * 16384 * 4;
constexpr size_t WS_A = WS_Q + (size_t)MP * 1536 * 4;
constexpr size_t WS_B = WS_A + (size_t)MP * 512 * 4;
constexpr size_t WS_O = WS_B + (size_t)MP * 512 * 4;
constexpr size_t WS_X1 = WS_O + (size_t)MP * 512 * 4;
constexpr size_t WS_G = WS_X1 + (size_t)MP * D * 4;
constexpr size_t WS_BETA = WS_G + (size_t)MP * 4 * 4;
constexpr size_t WS_GATE = WS_BETA + (size_t)MP * 4 * 4;
constexpr size_t WS_EXP = WS_GATE + (size_t)MP * 128 * 4;
constexpr size_t WS_HEND = WS_EXP + (size_t)MP * 128 * 4;
constexpr size_t WS_KEYS = WS_HEND + (size_t)3 * 4 * 64 * 512 * 4;
constexpr size_t WS_WGT = WS_KEYS + (size_t)2 * 8 * 2 * 128 * 128 * 2;
constexpr size_t WS_END = WS_WGT + (size_t)2 * 8 * 64 * 64 * 2;
constexpr size_t Q_QKVS = 0, Q_W = 1 * MiB, Q_QG = Q_W + 16 * MiB, Q_KDT = Q_QG + 16 * MiB, Q_UT = Q_KDT + 16 * MiB, Q_QK = Q_UT + 16 * MiB, Q_EGL = Q_QK + 8 * MiB, Q_END = Q_EGL + 4096;
static_assert(Q_END <= (size_t)MP * 1536 * 4, "region Q");
static_assert(WS_END <= 512 * MiB, "d_ws map");

struct MegaArgs {
    const float* in[35];
    float* out;
    unsigned char* ws;
};

__global__ void __launch_bounds__(NTH, 2) fwd_megakernel(MegaArgs ma) {
    cg::grid_group grid = cg::this_grid();
    extern __shared__ __attribute__((aligned(16))) unsigned char lds[];
    float* smem = (float*)lds;
    const int nb = gridDim.x, b0 = blockIdx.x, wave = __builtin_amdgcn_readfirstlane(threadIdx.x >> 6);
    int tid = threadIdx.x, lane = tid & 63;
    const float* x_prompt = ma.in[0];
    const float* x_sample = ma.in[1];
    const float* state_gdn = ma.in[2];
    const float* state_gdn_conv = ma.in[3];
    const float* state_lru = ma.in[4];
    const float* state_lru_conv = ma.in[5];
    const float* cache_k = ma.in[6];
    const float* cache_v = ma.in[7];
    const float* w_in_ab = ma.in[8];
    const float* gdn_conv_w = ma.in[9];
    const float* gdn_a_log = ma.in[10];
    const float* gdn_dt_bias = ma.in[11];
    const float* gdn_norm_w = ma.in[12];
    const float* lru_conv_w = ma.in[13];
    const float* lru_conv_b = ma.in[14];
    const float* lru_w_r = ma.in[15];
    const float* lru_b_r = ma.in[16];
    const float* lru_w_i = ma.in[17];
    const float* lru_b_i = ma.in[18];
    const float* lru_lam = ma.in[19];
    const float* w_out_ab = ma.in[20];
    const float* w_in_c = ma.in[21];
    const float* b_in_c = ma.in[22];
    const float* swa_sinks = ma.in[23];
    const float* w_out_c = ma.in[24];
    const float* b_out_c = ma.in[25];
    const float* rel_bias = ma.in[26];
    const float* ln_mix_g = ma.in[27];
    const float* ln_mix_b = ma.in[28];
    const float* ln_ffn_g = ma.in[29];
    const float* ln_ffn_b = ma.in[30];
    const float* peer_w_q = ma.in[31];
    const float* peer_keys = ma.in[32];
    const float* peer_u = ma.in[33];
    const float* peer_v = ma.in[34];

    float* out = ma.out;
    float* o_y = out;
    float* o_p_gdn = out + (size_t)NT * D;
    float* o_p_gdn_conv = o_p_gdn + 262144;
    float* o_p_lru = o_p_gdn_conv + 18432;
    float* o_p_lru_conv = o_p_lru + 2048;
    float* o_p_k = o_p_lru_conv + 6144;
    float* o_p_v = o_p_k + 131072;
    float* o_s_gdn = o_p_v + 131072;
    float* o_s_gdn_conv = o_s_gdn + 8388608;
    float* o_s_lru = o_s_gdn_conv + 589824;
    float* o_s_lru_conv = o_s_lru + 65536;
    float* o_s_k = o_s_lru_conv + 196608;
    float* o_s_v = o_s_k + 4194304;

    unsigned char* ws = ma.ws;
    bf16* WAB_T = (bf16*)(ws + WS_WAB); bf16* WOUT_T = (bf16*)(ws + WS_WOUT); bf16* WQ0_T = (bf16*)(ws + WS_WQ0); bf16* WQ1_T = (bf16*)(ws + WS_WQ1);
    bf16* WINC_T = (bf16*)(ws + WS_WINC); bf16* WOUTC_T = (bf16*)(ws + WS_WOUTC);
    bf16* ABUF = (bf16*)(ws + WS_ABUF);
    bf16* PROJ = (bf16*)(ws + WS_P); float* Y = (float*)(ws + WS_P); bf16* Qb = (bf16*)(ws + WS_P); bf16* PCb = (bf16*)(ws + WS_P); float* Y1 = (float*)(ws + WS_P);
    unsigned char* TAB8 = ws + WS_T; float* TSC = (float*)(ws + WS_T + (size_t)4 * 16384 * D);
    float* R_Q = (float*)(ws + WS_Q + Q_QKVS) - (size_t)NP * 1536; float* X2 = (float*)(ws + WS_A);
    GdnChunkBufs cbuf; cbuf.W = (bf16*)(ws + WS_Q + Q_W); cbuf.QG = (bf16*)(ws + WS_Q + Q_QG); cbuf.KDT = (bf16*)(ws + WS_Q + Q_KDT); cbuf.UT = (bf16*)(ws + WS_Q + Q_UT); cbuf.QK = (bf16*)(ws + WS_Q + Q_QK); cbuf.EGL = (float*)(ws + WS_Q + Q_EGL);
    float* PD = (float*)(ws + WS_P);
    bf16* KEYSB = (bf16*)(ws + WS_KEYS); bf16* WRT = (bf16*)(ws + WS_WGT); bf16* WIT = WRT + 8 * 64 * 64;
    float* HEND = (float*)(ws + WS_HEND); float* PEND = HEND + 4 * 64 * 512; float* CIN = PEND + 4 * 64 * 512;
    float* R_A = (float*)(ws + WS_A); float* R_B = (float*)(ws + WS_B); float* R_O = (float*)(ws + WS_O);
    float* R_X1 = (float*)(ws + WS_X1); float* X3 = R_X1;
    float* R_G = (float*)(ws + WS_G); float* R_BETA = (float*)(ws + WS_BETA); float* R_GATE = (float*)(ws + WS_GATE); int* R_EXP = (int*)(ws + WS_EXP);

    for (int u = tid; u < (LDS_BYTES - RING_BYTES) / 4; u += NTH) ((unsigned*)(lds + RING_BYTES))[u] = 0u;
    __syncthreads();
    XcdBarrier bar = xcd_barrier_post((unsigned*)(ws + WS_CTL), (volatile LAS unsigned*)((LAS unsigned char*)lds + MISC_OFF) + 8);
#define GRID_BAR() do { xcd_barrier(bar); asm volatile("" : "+v"(tid)); lane = tid & 63; } while (0)
#define PHASE_LOOP(n) for (int vb = b0; vb < (n); vb += nb)
#define PHASE_END __syncthreads()
#define GEMM_PHASE(EPI, Aptr, Btptr, Nn, ...) do { pg8::Gemm g_{(const pg8::bf16_t*)(Aptr), (const pg8::bf16_t*)(Btptr), MP, (Nn), D}; pg8::StaticOrder S_; S_.init(MP, (Nn), nb, b0); \
        pg8::EPI E_{__VA_ARGS__}; pg8::gemm_phase<pg8::EPI, pg8::StaticOrder, true, true>((PG8_LAS unsigned char*)lds, g_, S_, E_); } while (0)

    {
        float* scr = smem + wave * 4096;
        const int gw = b0 * NWAVES + wave, NGW = nb * NWAVES;
        constexpr int I_AB = 16 * 97, I_OUT = 16 * 32, I_Q = 16 * 64, I_INC = 16 * 48;
        constexpr int NITEMS = I_AB + I_OUT + 2 * I_Q + I_INC + I_OUT;
        for (int it = gw; it < NITEMS; it += NGW) {
            int r = it;
            if (r < I_AB) { p0_transpose_item(w_in_ab, D, ABN, WAB_T, scr, r, lane); continue; } r -= I_AB;
            if (r < I_OUT) { p0_transpose_item(w_out_ab, D, D, WOUT_T, scr, r, lane); continue; } r -= I_OUT;
            if (r < I_Q) { p0_transpose_item(peer_w_q, D, 2048, WQ0_T, scr, r, lane); continue; } r -= I_Q;
            if (r < I_Q) { p0_transpose_item(peer_w_q + (size_t)D * 2048, D, 2048, WQ1_T, scr, r, lane); continue; } r -= I_Q;
            if (r < I_INC) { p0_transpose_item(w_in_c, D, CN, WINC_T, scr, r, lane); continue; } r -= I_INC;
            p0_transpose_item(w_out_c, D, D, WOUTC_T, scr, r, lane);
        }
        for (int it = b0 * NTH + tid; it < 2 * 8 * 64 * 8; it += nb * NTH) {
            const int gsel = it >> 12, nn = (it >> 9) & 7, dd = (it >> 3) & 63, c8 = (it & 7) * 8;
            const float* wsrc = (gsel ? lru_w_i : lru_w_r) + ((size_t)nn * 64 + c8) * 64 + dd;
            v4u o; o.x = pk2(wsrc[0], wsrc[64]); o.y = pk2(wsrc[128], wsrc[192]); o.z = pk2(wsrc[256], wsrc[320]); o.w = pk2(wsrc[384], wsrc[448]);
            *(v4u*)((gsel ? WIT : WRT) + ((size_t)nn * 64 + dd) * 64 + c8) = o;
        }
        for (int m = gw; m < MP + (ABNP - 97 * 32); m += NGW) {
            if (m < MP) row_to_bf16(m < NP ? x_prompt + (size_t)m * D : (m < NT ? x_sample + (size_t)(m - NP) * D : nullptr), ABUF + (size_t)m * D, lane);
            else row_to_bf16(nullptr, WAB_T + (size_t)(97 * 32 + (m - MP)) * D, lane);
        }
    }
    grid.sync();
    GEMM_PHASE(EpiStoreBf16, ABUF, WAB_T, ABNP, PROJ, ABN, nullptr, NT, ABN);
    GRID_BAR();
    { AbPrepArgs pa;
      pa.PROJ = PROJ; pa.st_gdn_conv = state_gdn_conv; pa.st_lru_conv = state_lru_conv;
      pa.gdn_conv_w = gdn_conv_w; pa.a_log = gdn_a_log; pa.dt_bias = gdn_dt_bias;
      pa.lru_conv_w = lru_conv_w; pa.lru_conv_b = lru_conv_b; pa.w_r = lru_w_r; pa.b_r = lru_b_r; pa.w_i = lru_w_i; pa.b_i = lru_b_i; pa.lam = lru_lam;
      pa.QKV = R_Q; pa.G = R_G; pa.BETA = R_BETA; pa.LA = R_A; pa.LB = R_B;
      pa.p_gdn_conv = o_p_gdn_conv; pa.p_lru_conv = o_p_lru_conv; pa.s_gdn_conv = o_s_gdn_conv; pa.s_lru_conv = o_s_lru_conv;
#define GDN_UN_A(i_) ((((i_) >> 7) * 64 + (((i_) >> 2) & 31)) * 4 + ((i_) & 3))
      if (b0 < 128) {
          lru_prep_unit2(PROJ, lru_conv_w, lru_conv_b, WRT, WIT, lru_b_r, lru_b_i, lru_lam, R_B, R_A, HEND, PEND, o_p_lru_conv, (b0 >> 5) * 64 + (b0 & 31), lds); PHASE_END;
          gdn_prep_unit(PROJ, gdn_conv_w, gdn_a_log, gdn_dt_bias, cbuf, o_p_gdn_conv, GDN_UN_A(b0), lds);
      } else if (b0 < 256) {
          ab_prep(pa, NP + (b0 - 128), smem); PHASE_END;
          for (int k = 0; k < 3; ++k) gdn_prep_unit(PROJ, gdn_conv_w, gdn_a_log, gdn_dt_bias, cbuf, o_p_gdn_conv, GDN_UN_A(128 + (b0 - 128) * 3 + k), lds);
      } }
    GRID_BAR();
    f32x4 seqS[2]; int seqcur = 0;
    if (b0 < 64) gdn_seq<0, 32>(cbuf, R_O, o_p_gdn, b0 >> 4, (b0 >> 2) & 3, b0 & 3, lds, seqS, seqcur);
    else if (b0 < 192) {
        const int i = b0 - 64;
        lru_prep_unit2(PROJ, lru_conv_w, lru_conv_b, WRT, WIT, lru_b_r, lru_b_i, lru_lam, R_B, R_A, HEND, PEND, o_p_lru_conv, (i >> 5) * 64 + 32 + (i & 31), lds); PHASE_END;
        for (int k = 0; k < 2; ++k) gdn_prep_unit(PROJ, gdn_conv_w, gdn_a_log, gdn_dt_bias, cbuf, o_p_gdn_conv, GDN_UN_A(i * 2 + k) + 32 * 4, lds);
    } else if (b0 < 256) {
        const int i = b0 - 192;
        for (int k = 0; k < 4; ++k) gdn_prep_unit(PROJ, gdn_conv_w, gdn_a_log, gdn_dt_bias, cbuf, o_p_gdn_conv, GDN_UN_A(256 + i * 4 + k) + 32 * 4, lds);
    }
    GRID_BAR();
    if (b0 < 64) gdn_seq<32, 64>(cbuf, R_O, o_p_gdn, b0 >> 4, (b0 >> 2) & 3, b0 & 3, lds, seqS, seqcur);
    else if (b0 < 68) lru_carry(HEND, PEND, CIN, o_p_lru, b0 - 64);
    else {
        for (int v = b0 - 68; v < 2048 + 128; v += nb - 68) {
            if (v < 2048) gdn_scan(R_Q, R_G, R_BETA, state_gdn, R_O, o_s_gdn, NP, 1, v & 3, (v >> 2) & 3, v >> 4, smem);
            else lru_scan(R_A, R_B, state_lru, o_s_lru, NP, 1, NS, v - 2048);
            PHASE_END;
        }
        const int gw2 = (b0 - 68) * NWAVES + wave, NGW2 = (nb - 68) * NWAVES;
        for (int m = gw2; m < 512; m += NGW2) row_to_bf16(peer_keys + (size_t)m * D, KEYSB + (size_t)m * D, lane);
        for (int m = gw2; m < 4 * 16384; m += NGW2) {
            const int k = m >> 14, r = m & 16383;
            if (k & 1) row_to_fp8(peer_v + ((size_t)(k >> 1) * 16384 + r) * D, TAB8 + (size_t)m * D, TSC + m, lane);
            else row_to_fp8_sliced(peer_u + ((size_t)(k >> 1) * 16384 + r) * D, TAB8 + (size_t)k * 16384 * D, r, TSC + m, lane);
        }
    }
    GRID_BAR();
    PHASE_LOOP(NT / 2) { ab_mix(PROJ, R_O, R_B, R_A, CIN, gdn_norm_w, ABUF, vb); }
    GRID_BAR();
    GEMM_PHASE(EpiStoreF32, ABUF, WOUT_T, D, Y, D, nullptr, NT, D);
    GRID_BAR();
    PHASE_LOOP(NT / 8) { const int t = vb * 8 + wave;
        ln_res_w(t < NP ? x_prompt + (size_t)t * D : x_sample + (size_t)(t - NP) * D, Y + (size_t)t * D, ln_mix_g, ln_mix_b, R_X1 + (size_t)t * D, ABUF + (size_t)t * D, lane); }
    GRID_BAR();
    GEMM_PHASE(EpiStoreBf16, ABUF, WQ0_T, 2048, Qb, 2048, nullptr, NT, 2048);
    GRID_BAR();
    if ((nb & 7) == 0) { peer_topk_stage_keys(KEYSB, b0 & 7, lds); PHASE_LOOP((NT / 64) * 8) { peer_topk4(Qb, R_EXP, R_GATE, vb >> 3, vb & 7, lds); } }
    else PHASE_LOOP((NT / 64) * 8) { peer_topk_stage_keys(KEYSB, vb & 7, lds); peer_topk4(Qb, R_EXP, R_GATE, vb >> 3, vb & 7, lds); }
    GRID_BAR();
    asm volatile("" : "+v"(tid)); lane = tid & 63;
    for (int tg = b0 >> 3; tg < NT / 8; tg += nb >> 3) { const int t = tg * 8 + wave, x = b0 & 7;
        peer_u_pass(R_X1 + (size_t)t * D, R_EXP + (size_t)t * 128, TAB8 + (size_t)x * 16384 * 128, PD + ((size_t)x * NT + t) * 128, x, lane); }
    GRID_BAR();
    PHASE_LOOP(NP / 8 + NS) { const int t = vb < NP / 8 ? vb * 8 + wave : NP + (vb - NP / 8);
        if (vb < NP / 8) peer_v_w(R_X1 + (size_t)t * D, R_EXP + (size_t)t * 128, R_GATE + (size_t)t * 128, PD + (size_t)t * 128, TAB8 + (size_t)16384 * D, TSC, TSC + 16384, ln_ffn_g, ln_ffn_b, X2 + (size_t)t * D, ABUF + (size_t)t * D, lane);
        else peer_v_blk(R_X1 + (size_t)t * D, R_EXP + (size_t)t * 128, R_GATE + (size_t)t * 128, PD + (size_t)t * 128, TAB8 + (size_t)16384 * D, TSC, TSC + 16384, ln_ffn_g, ln_ffn_b, X2 + (size_t)t * D, ABUF + (size_t)t * D, lane, wave, smem); }
    GRID_BAR();

    GEMM_PHASE(EpiStoreBf16, ABUF, WINC_T, CN, PCb, CN, b_in_c, NT, CN);
    GRID_BAR();
    PHASE_LOOP(1024 + 256 + (NB * 128 + NS * 128) / 2) {
        if (vb < 1024) attn_unit(PCb, rel_bias, swa_sinks, ABUF, vb, lds);
        else if (vb < 1280) swa_attn_sample(PCb, cache_k, cache_v, rel_bias, swa_sinks, ABUF, (vb - 1024) * 8 + wave, lane);
        else swa_kv_out2(PCb, cache_k, cache_v, o_p_k, o_p_v, o_s_k, o_s_v, vb - 1280);
    }
    GRID_BAR();
    GEMM_PHASE(EpiStoreF32, ABUF, WOUTC_T, D, Y1, D, b_out_c, NT, D);
    GRID_BAR();
    PHASE_LOOP(NT / 8) { const int t = vb * 8 + wave;
        ln_res_w(X2 + (size_t)t * D, Y1 + (size_t)t * D, ln_mix_g + D, ln_mix_b + D, X3 + (size_t)t * D, ABUF + (size_t)t * D, lane); }
    GRID_BAR();
    GEMM_PHASE(EpiStoreBf16, ABUF, WQ1_T, 2048, Qb, 2048, nullptr, NT, 2048);
    GRID_BAR();
    if ((nb & 7) == 0) { peer_topk_stage_keys(KEYSB + (size_t)8 * 2 * 128 * 128, b0 & 7, lds); PHASE_LOOP((NT / 64) * 8) { peer_topk4(Qb, R_EXP, R_GATE, vb >> 3, vb & 7, lds); } }
    else PHASE_LOOP((NT / 64) * 8) { peer_topk_stage_keys(KEYSB + (size_t)8 * 2 * 128 * 128, vb & 7, lds); peer_topk4(Qb, R_EXP, R_GATE, vb >> 3, vb & 7, lds); }
    GRID_BAR();
    asm volatile("" : "+v"(tid)); lane = tid & 63;
    for (int tg = b0 >> 3; tg < NT / 8; tg += nb >> 3) { const int t = tg * 8 + wave, x = b0 & 7;
        peer_u_pass(X3 + (size_t)t * D, R_EXP + (size_t)t * 128, TAB8 + (size_t)2 * 16384 * D + (size_t)x * 16384 * 128, PD + ((size_t)x * NT + t) * 128, x, lane); }
    GRID_BAR();
    PHASE_LOOP(NP / 8 + NS) { const int t = vb < NP / 8 ? vb * 8 + wave : NP + (vb - NP / 8);
        if (vb < NP / 8) peer_v_w(X3 + (size_t)t * D, R_EXP + (size_t)t * 128, R_GATE + (size_t)t * 128, PD + (size_t)t * 128, TAB8 + (size_t)3 * 16384 * D, TSC + 2 * 16384, TSC + 3 * 16384, ln_ffn_g + D, ln_ffn_b + D, o_y + (size_t)t * D, nullptr, lane);
        else peer_v_blk(X3 + (size_t)t * D, R_EXP + (size_t)t * 128, R_GATE + (size_t)t * 128, PD + (size_t)t * 128, TAB8 + (size_t)3 * 16384 * D, TSC + 2 * 16384, TSC + 3 * 16384, ln_ffn_g + D, ln_ffn_b + D, o_y + (size_t)t * D, nullptr, lane, wave, smem); }
}
}

extern "C" void kernel_launch(void* const* d_in, const int* in_sizes, int n_in,
                              void* d_out, int out_size, void* d_ws, size_t ws_size,
                              hipStream_t stream) {
    static int grid_blocks = 0;
    if (!grid_blocks) {
        int dev = 0, cus = 0, per_cu = 0;
        (void)hipGetDevice(&dev);
        (void)hipDeviceGetAttribute(&cus, hipDeviceAttributeMultiprocessorCount, dev);
        if (hipFuncSetAttribute((const void*)fwd_megakernel, hipFuncAttributeMaxDynamicSharedMemorySize, LDS_BYTES) != hipSuccess) { fprintf(stderr, "hipFuncSetAttribute failed\n"); grid_blocks = -1; return; }
        (void)hipOccupancyMaxActiveBlocksPerMultiprocessor(&per_cu, (const void*)fwd_megakernel, NTH, LDS_BYTES);
        if (per_cu < 1) { fprintf(stderr, "occupancy query says %d blocks per CU\n", per_cu); grid_blocks = -1; return; }
        grid_blocks = cus;
    }
    if (grid_blocks < 0) return;
    (void)hipMemsetAsync((char*)d_ws + WS_CTL, 0, CTL_ZERO_BYTES, stream);
    MegaArgs ma{};
    for (int i = 0; i < 35; ++i) ma.in[i] = (const float*)d_in[i];
    ma.out = (float*)d_out;
    ma.ws = (unsigned char*)d_ws;
    void* args[] = {&ma};
    hipError_t e = hipLaunchCooperativeKernel((void*)fwd_megakernel, dim3(grid_blocks), dim3(NTH), args, LDS_BYTES, stream);
    if (e != hipSuccess) fprintf(stderr, "cooperative launch failed: %s (grid %d)\n", hipGetErrorString(e), grid_blocks);
}
```

```cpp
#include <hip/hip_runtime.h>
#include <hip/hip_cooperative_groups.h>
#include <cstdio>
#include <cstdint>
namespace cg = cooperative_groups;

namespace pg8 {
#define PG8_LAS __attribute__((address_space(3)))
typedef unsigned short bf16_t;
typedef short bf16x8 __attribute__((ext_vector_type(8)));
typedef float f32x4 __attribute__((ext_vector_type(4)));
typedef unsigned u32x4 __attribute__((ext_vector_type(4)));
constexpr int BM = 256, BK = 64, HALF = 128, HTB = HALF * BK * 2  , STAGE_BYTES = 8 * HTB, NXCD = 8, WGM = 8;

__host__ __device__ __forceinline__ int lds_byte(int r, int c) { const int st = (r >> 4) * 2 + (c >> 5), rr = r & 15, cc = c & 31, ob = rr * 64 + cc * 2; return st * 1024 + (ob ^ (((ob >> 9) & 1) << 5)); }
__host__ __device__ __forceinline__ void stage_rc(int b, int& R, int& C) { const int st = b / 1024, sb = b % 1024, swz = sb ^ (((sb >> 9) & 1) << 5); R = (st >> 1) * 16 + swz / 64; C = (st & 1) * 32 + (swz % 64) / 2; }
__host__ __device__ __forceinline__ int perm32(int rho) { const int n = rho >> 4, i = rho & 15; return 8 * (i >> 2) + 4 * n + (i & 3); }

struct Unit { int pm, pn; };
struct Gemm { const bf16_t* A; const bf16_t* Bt; int M, N, K; };

struct StaticOrder {
    int nM, nN, nwg, G, c;
    __host__ __device__ void init(int M, int N, int G_, int c_) { nM = M / BM; nN = N / BM; nwg = nM * nN; G = G_; c = c_; }
    __host__ __device__ bool next(int i, Unit& u) const {
        const long L = (long)i * G + c; if (L >= nwg) return false;
        int wgid = (int)L; { const int q = nwg / NXCD, r = nwg % NXCD, xcd = wgid % NXCD, off = wgid / NXCD; wgid = (xcd < r ? xcd * (q + 1) : r * (q + 1) + (xcd - r) * q) + off; }
        const int nig = WGM * nN, gid = wgid / nig, fm = gid * WGM, gsz = (nM - fm) < WGM ? (nM - fm) : WGM;
        u.pm = fm + ((wgid % nig) % gsz); u.pn = (wgid % nig) / gsz; return true;
    }
    __device__ __forceinline__ void a_ready(const Unit&) const {}
    __device__ __forceinline__ void done(const Unit&) const {}
};

__device__ __forceinline__ unsigned cvt_pk_bf16(float lo, float hi) { unsigned r; asm volatile("v_cvt_pk_bf16_f32 %0, %1, %2" : "=v"(r) : "v"(lo), "v"(hi)); return r; }
template <class Epi, class Sched, bool ALIGN_EPI = false, bool SP2 = false>
__device__ __forceinline__ void gemm_phase(PG8_LAS unsigned char* lds, const Gemm g, const Sched& S, const Epi& E) {
    int tid_ = threadIdx.x; asm volatile("" : "+v"(tid_));
    const int tid = tid_, wid = __builtin_amdgcn_readfirstlane(tid >> 6), lane = tid & 63, wr = wid >> 2, wc = wid & 3, fr = lane & 15, fq = lane >> 4;
    const int K = g.K, nt = K / BK;
    unsigned voffA[2], voffB[2];
#pragma unroll
    for (int i = 0; i < 2; ++i) { int R, C; stage_rc(tid * 16 + i * 8192, R, C); const int Rb = Epi::PERM ? ((R & ~31) + perm32(R & 31)) : R;
        voffA[i] = (unsigned)(R * K + C) * 2u; voffB[i] = (unsigned)(Rb * K + C) * 2u; }
    const size_t kstep = (size_t)(BK * 2);
    const size_t hstep = (size_t)HALF * K * 2;
    const size_t tstep = 2 * hstep;
    const unsigned ldsw = (unsigned)wid * 1024u;
    const int aoff = lds_byte(wr * 64 + fr, fq * 8), boff = lds_byte(wc * 32 + fr, fq * 8);
#define PG8_SA(b, h) (((b) * 2 + (h)) * HTB)
#define PG8_SB(b, h) ((4 + (b) * 2 + (h)) * HTB)
#define PG8_STAGE(bufoff, gbase, voff) do { _Pragma("unroll") for (int _i = 0; _i < 2; ++_i) \
        __builtin_amdgcn_global_load_lds((const unsigned*)((const char*)(gbase) + (voff)[_i]), (PG8_LAS unsigned*)(lds + (bufoff) + ldsw + _i * 8192), 16, 0, 0); } while (0)
#define PG8_LDA(dst, b, h) do { _Pragma("unroll") for (int m = 0; m < 4; ++m) _Pragma("unroll") for (int k = 0; k < 2; ++k) dst[m][k] = *(const PG8_LAS bf16x8*)(lds + PG8_SA(b, h) + aoff + m * 2048 + k * 1024); } while (0)
#define PG8_LDB(dst, b, h) do { _Pragma("unroll") for (int n = 0; n < 2; ++n) _Pragma("unroll") for (int k = 0; k < 2; ++k) dst[n][k] = *(const PG8_LAS bf16x8*)(lds + PG8_SB(b, h) + boff + n * 2048 + k * 1024); } while (0)
#define PG8_MMA(ai, bj, At, Bt) do { __builtin_amdgcn_s_setprio(1); _Pragma("unroll") for (int m = 0; m < 4; ++m) _Pragma("unroll") for (int n = 0; n < 2; ++n) _Pragma("unroll") for (int k = 0; k < 2; ++k) \
        acc[ai][bj][m][n] = __builtin_amdgcn_mfma_f32_16x16x32_bf16(Bt[n][k], At[m][k], acc[ai][bj][m][n], 0, 0, 0); __builtin_amdgcn_s_setprio(0); } while (0)
#define PG8_WAIT_V(n) asm volatile("s_waitcnt vmcnt(" #n ")" ::: "memory")
#define PG8_WAIT_L(n) asm volatile("s_waitcnt lgkmcnt(" #n ")" ::: "memory")
#define PG8_BAR __builtin_amdgcn_s_barrier()
#define PG8_SCHED __builtin_amdgcn_sched_barrier(0)
    Unit cur, nxt; int ui = 0;
    if (!S.next(0, cur)) return;
    f32x4 acc[2][2][4][2];
#pragma unroll
    for (int a = 0; a < 2; ++a)
#pragma unroll
        for (int b = 0; b < 2; ++b)
#pragma unroll
            for (int m = 0; m < 4; ++m)
#pragma unroll
                for (int n = 0; n < 2; ++n) acc[a][b][m][n] = (f32x4){0.f, 0.f, 0.f, 0.f};
    bf16x8 At[4][2], B0[2][2], B1[2][2];
    const char* cA = (const char*)g.A + (size_t)cur.pm * tstep; const char* cB = (const char*)g.Bt + (size_t)cur.pn * tstep;
    S.a_ready(cur);
    if constexpr (SP2) {
        PG8_STAGE(PG8_SB(0, 0), cB, voffB); PG8_STAGE(PG8_SB(0, 1), cB + hstep, voffB); PG8_STAGE(PG8_SA(0, 0), cA, voffA); PG8_STAGE(PG8_SA(0, 1), cA + hstep, voffA);
        if (wr == 1) PG8_BAR;
        PG8_WAIT_V(2); PG8_BAR;
        PG8_STAGE(PG8_SB(1, 0), cB + kstep, voffB); PG8_STAGE(PG8_SA(1, 0), cA + kstep, voffA); PG8_STAGE(PG8_SB(1, 1), cB + hstep + kstep, voffB);
        PG8_WAIT_V(6); PG8_BAR;
    } else {
        PG8_STAGE(PG8_SB(0, 0), cB, voffB); PG8_STAGE(PG8_SA(0, 0), cA, voffA); PG8_STAGE(PG8_SB(0, 1), cB + hstep, voffB); PG8_STAGE(PG8_SA(0, 1), cA + hstep, voffA);
        if (wr == 1) PG8_BAR;
        PG8_WAIT_V(4); PG8_BAR;
        PG8_STAGE(PG8_SB(1, 0), cB + kstep, voffB); PG8_STAGE(PG8_SA(1, 0), cA + kstep, voffA); PG8_STAGE(PG8_SB(1, 1), cB + hstep + kstep, voffB);
        PG8_WAIT_V(6); PG8_BAR;
    }
    for (;;) {
        const bool has_next = S.next(ui + 1, nxt);
        const char* nA = has_next ? (const char*)g.A + (size_t)nxt.pm * tstep : cA; const char* nB = has_next ? (const char*)g.Bt + (size_t)nxt.pn * tstep : cB;
        for (int t = 0; t < nt; t += 2) {
            const bool last = (t == nt - 2);
            const char* a1 = cA + (size_t)(t + 1) * kstep;
            const char* a2 = last ? nA : cA + (size_t)(t + 2) * kstep; const char* b2 = last ? nB : cB + (size_t)(t + 2) * kstep;
            const char* a3 = a2 + kstep; const char* b3 = b2 + kstep;
            if (last && has_next) S.a_ready(nxt);
            if constexpr (SP2) {
            PG8_LDB(B0, 0, 0); PG8_LDB(B1, 0, 1); PG8_SCHED; PG8_LDA(At, 0, 0); PG8_STAGE(PG8_SA(1, 1), a1 + hstep, voffA);
            PG8_WAIT_V(8); PG8_WAIT_L(0); PG8_BAR; PG8_MMA(0, 0, At, B0); PG8_MMA(0, 1, At, B1); PG8_BAR; PG8_SCHED;
            PG8_LDA(At, 0, 1); PG8_STAGE(PG8_SB(0, 0), b2, voffB); PG8_STAGE(PG8_SB(0, 1), b2 + hstep, voffB); PG8_STAGE(PG8_SA(0, 0), a2, voffA);
            PG8_WAIT_V(8); PG8_WAIT_L(0); PG8_BAR; PG8_MMA(1, 0, At, B0); PG8_MMA(1, 1, At, B1); PG8_BAR; PG8_SCHED;
            PG8_LDB(B0, 1, 0); PG8_LDB(B1, 1, 1); PG8_SCHED; PG8_LDA(At, 1, 0); PG8_STAGE(PG8_SA(0, 1), a2 + hstep, voffA);
            PG8_WAIT_V(8); PG8_WAIT_L(0); PG8_BAR; PG8_MMA(0, 0, At, B0); PG8_MMA(0, 1, At, B1); PG8_BAR; PG8_SCHED;
            PG8_LDA(At, 1, 1); PG8_STAGE(PG8_SB(1, 0), b3, voffB); PG8_STAGE(PG8_SB(1, 1), b3 + hstep, voffB); PG8_STAGE(PG8_SA(1, 0), a3, voffA);
            PG8_WAIT_V(8); PG8_WAIT_L(0); PG8_BAR; PG8_MMA(1, 0, At, B0); PG8_MMA(1, 1, At, B1); PG8_BAR; PG8_SCHED;
            } else {
            PG8_LDB(B0, 0, 0); PG8_SCHED; PG8_LDA(At, 0, 0); PG8_STAGE(PG8_SA(1, 1), a1 + hstep, voffA);
            PG8_WAIT_L(8); PG8_BAR; PG8_WAIT_L(0); PG8_MMA(0, 0, At, B0); PG8_BAR; PG8_SCHED;
            PG8_LDB(B1, 0, 1); PG8_STAGE(PG8_SB(0, 0), b2, voffB);
            PG8_BAR; PG8_WAIT_L(0); PG8_MMA(0, 1, At, B1); PG8_BAR;
            PG8_LDA(At, 0, 1); PG8_STAGE(PG8_SA(0, 0), a2, voffA);
            PG8_BAR; PG8_WAIT_L(0); PG8_MMA(1, 0, At, B0); PG8_BAR; PG8_SCHED;
            PG8_STAGE(PG8_SB(0, 1), b2 + hstep, voffB);
            PG8_WAIT_V(6); PG8_BAR; PG8_MMA(1, 1, At, B1); PG8_BAR;
            PG8_LDB(B0, 1, 0); PG8_SCHED; PG8_LDA(At, 1, 0); PG8_STAGE(PG8_SA(0, 1), a2 + hstep, voffA);
            PG8_WAIT_L(8); PG8_BAR; PG8_WAIT_L(0); PG8_MMA(0, 0, At, B0); PG8_BAR; PG8_SCHED;
            PG8_LDB(B1, 1, 1); PG8_STAGE(PG8_SB(1, 0), b3, voffB);
            PG8_BAR; PG8_WAIT_L(0); PG8_MMA(0, 1, At, B1); PG8_BAR;
            PG8_LDA(At, 1, 1); PG8_STAGE(PG8_SA(1, 0), a3, voffA);
            PG8_BAR; PG8_WAIT_L(0); PG8_MMA(1, 0, At, B0); PG8_BAR; PG8_SCHED;
            PG8_STAGE(PG8_SB(1, 1), b3 + hstep, voffB);
            PG8_WAIT_V(6); PG8_BAR; PG8_MMA(1, 1, At, B1); PG8_BAR;
            }
        }
        if constexpr (ALIGN_EPI) { if (wr == 0) PG8_BAR; }
        if constexpr (!Epi::AFTER_DRAIN) { E(acc, cur, wr, wc, fr, fq); S.done(cur); }
        if (!has_next) break;
#pragma unroll
        for (int a = 0; a < 2; ++a)
#pragma unroll
            for (int b = 0; b < 2; ++b)
#pragma unroll
                for (int m = 0; m < 4; ++m)
#pragma unroll
                    for (int n = 0; n < 2; ++n) acc[a][b][m][n] = (f32x4){0.f, 0.f, 0.f, 0.f};
        cur = nxt; cA = nA; cB = nB; ++ui;
        if constexpr (ALIGN_EPI) { if (wr == 1) PG8_BAR; }
    }
    PG8_WAIT_V(0);
    if constexpr (!ALIGN_EPI) { if (wr == 0) PG8_BAR; }
    PG8_BAR;
    if constexpr (Epi::AFTER_DRAIN) { E.fused(acc, cur, wr, wc, fr, fq, lds, wid, lane); S.done(cur); }
#undef PG8_SA
#undef PG8_SB
#undef PG8_STAGE
#undef PG8_LDA
#undef PG8_LDB
#undef PG8_MMA
#undef PG8_WAIT_V
#undef PG8_WAIT_L
#undef PG8_BAR
#undef PG8_SCHED
}
}
namespace pg8 {
struct EpiStoreBf16 {
    static constexpr bool PERM = true, AFTER_DRAIN = false;
    bf16_t* O; int ldc; const float* bias; int m_real, n_real;
    __device__ __forceinline__ void operator()(const f32x4 (&acc)[2][2][4][2], const Unit& u, int wr, int wc, int fr, int fq) const {
        const int row0 = u.pm * BM + wr * 64 + fr, col0 = u.pn * BM + wc * 32 + 8 * fq;
#pragma unroll
        for (int bj = 0; bj < 2; ++bj) {
            const int col = col0 + bj * HALF;
            if (col >= n_real) continue;
            f32x4 b0 = (f32x4){0.f, 0.f, 0.f, 0.f}, b1 = b0;
            if (bias) { b0 = *(const f32x4*)(bias + col); b1 = *(const f32x4*)(bias + col + 4); }
#pragma unroll
            for (int ai = 0; ai < 2; ++ai)
#pragma unroll
                for (int m = 0; m < 4; ++m) {
                    const int row = row0 + ai * HALF + m * 16;
                    if (row >= m_real) continue;
                    const f32x4 v0 = acc[ai][bj][m][0] + b0, v1 = acc[ai][bj][m][1] + b1;
                    u32x4 w; w.x = cvt_pk_bf16(v0[0], v0[1]); w.y = cvt_pk_bf16(v0[2], v0[3]); w.z = cvt_pk_bf16(v1[0], v1[1]); w.w = cvt_pk_bf16(v1[2], v1[3]);
                    *(u32x4*)(O + (size_t)row * ldc + col) = w;
                }
        }
    }
};
struct EpiStoreF32 {
    static constexpr bool PERM = false, AFTER_DRAIN = false;
    float* O; int ldc; const float* bias; int m_real, n_real;
    __device__ __forceinline__ void operator()(const f32x4 (&acc)[2][2][4][2], const Unit& u, int wr, int wc, int fr, int fq) const {
        const int row0 = u.pm * BM + wr * 64 + fr, col0 = u.pn * BM + wc * 32 + 4 * fq;
#pragma unroll
        for (int bj = 0; bj < 2; ++bj)
#pragma unroll
            for (int n = 0; n < 2; ++n) {
                const int col = col0 + bj * HALF + n * 16;
                if (col >= n_real) continue;
                const f32x4 bv = bias ? *(const f32x4*)(bias + col) : (f32x4){0.f, 0.f, 0.f, 0.f};
#pragma unroll
                for (int ai = 0; ai < 2; ++ai)
#pragma unroll
                    for (int m = 0; m < 4; ++m) {
                        const int row = row0 + ai * HALF + m * 16;
                        if (row >= m_real) continue;
                        *(f32x4*)(O + (size_t)row * ldc + col) = acc[ai][bj][m][n] + bv;
                    }
            }
    }
};
}
namespace {
#define GAS __attribute__((address_space(1)))
#define LAS __attribute__((address_space(3)))
typedef unsigned short bf16;
typedef float f32x4 __attribute__((ext_vector_type(4)));
typedef unsigned v4u __attribute__((ext_vector_type(4)));
typedef unsigned v2u __attribute__((ext_vector_type(2)));

constexpr int D = 1024, NB = 4, SEQ = 4096, NP = NB * SEQ, NS = 128, NT = NP + NS, MP = 16640;
constexpr int ABN = 3080, ABNP = 3328;
constexpr int C_QKV = 0, C_Z = 1536, C_A = 2048, C_B = 2052, C_XR = 2056, C_GATE = 2568;
constexpr int CN = 1536;
constexpr float ALPHA = 1.4142135623730951f;
constexpr float LN_EPS = 1e-5f;
constexpr int NTH = 512, NWAVES = 8;
constexpr int RING_BYTES = 143360, MISC_OFF = RING_BYTES + 320, LDS_BYTES = 147456;

__device__ __forceinline__ float bf2f(bf16 v) { return __uint_as_float((unsigned)v << 16); }
__device__ __forceinline__ unsigned f2bf(float f) { unsigned u = __float_as_uint(f); return (u + 0x7fffu + ((u >> 16) & 1u)) >> 16; }
__device__ __forceinline__ unsigned pk2(float lo, float hi) { return f2bf(lo) | (f2bf(hi) << 16); }
__device__ __forceinline__ float sigmoidf_(float x) { return 1.0f / (1.0f + expf(-x)); }
__device__ __forceinline__ float softplusf_(float x) { return fmaxf(x, 0.f) + log1pf(expf(-fabsf(x))); }
__device__ __forceinline__ float siluf_(float x) { return x / (1.0f + expf(-x)); }
__device__ __forceinline__ float geluf_(float x) { return 0.5f * x * (1.0f + tanhf(0.7978845608028654f * (x + 0.044715f * x * x * x))); }
#define DPPF(v_, ctrl_, rmask_) __int_as_float(__builtin_amdgcn_update_dpp(0, __float_as_int(v_), (ctrl_), (rmask_), 0xf, false))
__device__ __forceinline__ float wave_sum(float v) {
    v += DPPF(v, 0xB1, 0xf); v += DPPF(v, 0x4E, 0xf); v += DPPF(v, 0x141, 0xf); v += DPPF(v, 0x140, 0xf);
    v += DPPF(v, 0x142, 0xa); v += DPPF(v, 0x143, 0xc);
    return __int_as_float(__builtin_amdgcn_readlane(__float_as_int(v), 63));
}
__device__ __forceinline__ float wave_max(float v) {
    v = fmaxf(v, DPPF(v, 0xB1, 0xf)); v = fmaxf(v, DPPF(v, 0x4E, 0xf)); v = fmaxf(v, DPPF(v, 0x141, 0xf)); v = fmaxf(v, DPPF(v, 0x140, 0xf));
    { const float t = __int_as_float(__builtin_amdgcn_update_dpp(__float_as_int(v), __float_as_int(v), 0x142, 0xa, 0xf, false)); v = fmaxf(v, t); }
    { const float t = __int_as_float(__builtin_amdgcn_update_dpp(__float_as_int(v), __float_as_int(v), 0x143, 0xc, 0xf, false)); v = fmaxf(v, t); }
    return __int_as_float(__builtin_amdgcn_readlane(__float_as_int(v), 63));
}

__device__ __forceinline__ void p0_transpose_item(const float* __restrict__ W, int K, int N, bf16* __restrict__ WT, float* scr, int item, int lane) {
    const int nblk = (N + 31) / 32, kb = item / nblk, nb = item % nblk, k0 = 64 * kb, n0 = 32 * nb;
#pragma unroll 8
    for (int i = 0; i < 32; ++i) { const int kk = 2 * i + (lane >> 5), n = n0 + (lane & 31); scr[kk * 33 + (lane & 31)] = n < N ? W[(size_t)(k0 + kk) * N + n] : 0.f; }
    asm volatile("s_waitcnt lgkmcnt(0)" ::: "memory");
    const int c = lane & 7;
#pragma unroll
    for (int j = 0; j < 4; ++j) { const int n = (lane >> 3) + 8 * j; const float* s = scr + (8 * c) * 33 + n;
        v4u o; o.x = pk2(s[0 * 33], s[1 * 33]); o.y = pk2(s[2 * 33], s[3 * 33]); o.z = pk2(s[4 * 33], s[5 * 33]); o.w = pk2(s[6 * 33], s[7 * 33]);
        *(v4u*)(WT + (size_t)(n0 + n) * K + k0 + 8 * c) = o; }
    asm volatile("s_waitcnt lgkmcnt(0)" ::: "memory");
}
__device__ __forceinline__ void row_to_bf16(const float* __restrict__ xrow, bf16* __restrict__ orow, int lane) {
#pragma unroll
    for (int j = 0; j < 4; ++j) {
        f32x4 v = (f32x4){0.f, 0.f, 0.f, 0.f};
        if (xrow) v = ((const f32x4*)xrow)[lane + 64 * j];
        v2u o; o.x = pk2(v.x, v.y); o.y = pk2(v.z, v.w);
        ((v2u*)orow)[lane + 64 * j] = o;
    }
}

struct AbPrepArgs {
    const bf16* PROJ; const float* st_gdn_conv; const float* st_lru_conv;
    const float* gdn_conv_w; const float* a_log; const float* dt_bias;
    const float* lru_conv_w; const float* lru_conv_b; const float* w_r; const float* b_r; const float* w_i; const float* b_i; const float* lam;
    float* QKV; float* G; float* BETA; float* LA; float* LB;
    float* p_gdn_conv; float* p_lru_conv; float* s_gdn_conv; float* s_lru_conv;
};
__device__ __forceinline__ void ab_prep(const AbPrepArgs& a, int t, float* smem) {
    int tid = threadIdx.x; asm volatile("" : "+v"(tid));
    const int lane = tid & 63, wid = tid >> 6;
    const bool samp = t >= NP; const int sb = t - NP, pos = t % SEQ, b = t / SEQ;
    float* sq = smem;
    float* sx = smem + 1536;
    float* scl = smem + 2048;
    const bf16* prow = a.PROJ + (size_t)t * ABN;
    for (int c = tid; c < 1536; c += NTH) {
        float acc = 0.f;
#pragma unroll
        for (int i = 0; i < 4; ++i) {
            float xv;
            if (i == 3) xv = bf2f(prow[C_QKV + c]);
            else if (samp) xv = a.st_gdn_conv[((size_t)sb * 3 + i) * 1536 + c];
            else xv = (pos - 3 + i >= 0) ? bf2f(a.PROJ[(size_t)(t - 3 + i) * ABN + C_QKV + c]) : 0.f;
            acc += a.gdn_conv_w[i * 1536 + c] * xv;
        }
        sq[c] = siluf_(acc);
    }
    {
        const int c = tid;
        float acc = a.lru_conv_b[c];
#pragma unroll
        for (int i = 0; i < 4; ++i) {
            float xv;
            if (i == 3) xv = bf2f(prow[C_XR + c]);
            else if (samp) xv = a.st_lru_conv[((size_t)sb * 3 + i) * 512 + c];
            else xv = (pos - 3 + i >= 0) ? bf2f(a.PROJ[(size_t)(t - 3 + i) * ABN + C_XR + c]) : 0.f;
            acc += a.lru_conv_w[i * 512 + c] * xv;
        }
        sx[c] = acc;
    }
    __syncthreads();
    {
        const int grp = wid;
        const float v0 = sq[grp * 128 + lane], v1 = sq[grp * 128 + 64 + lane];
        const float s = wave_sum(v0 * v0 + v1 * v1);
        if (lane == 0) scl[grp] = rsqrtf(s + 1e-6f) * (grp < 4 ? 0.08838834764831845f : 1.0f);
    }
    __syncthreads();
    for (int c = tid; c < 1536; c += NTH) a.QKV[(size_t)t * 1536 + c] = (c < 1024) ? sq[c] * scl[c >> 7] : sq[c];
    if (tid < 4) {
        const float a_raw = bf2f(prow[C_A + tid]), b_raw = bf2f(prow[C_B + tid]);
        a.G[(size_t)t * 4 + tid] = -expf(a.a_log[tid]) * softplusf_(a_raw + a.dt_bias[tid]);
        a.BETA[(size_t)t * 4 + tid] = sigmoidf_(b_raw);
    }
    if (!samp) {
        if (pos >= SEQ - 3) {
            const int row = pos - (SEQ - 3);
            for (int c = tid; c < 1536; c += NTH) a.p_gdn_conv[((size_t)b * 3 + row) * 1536 + c] = bf2f(prow[C_QKV + c]);
            a.p_lru_conv[((size_t)b * 3 + row) * 512 + tid] = bf2f(prow[C_XR + tid]);
        }
    } else {
        for (int c = tid; c < 1536; c += NTH) {
            a.s_gdn_conv[((size_t)sb * 3 + 0) * 1536 + c] = a.st_gdn_conv[((size_t)sb * 3 + 1) * 1536 + c];
            a.s_gdn_conv[((size_t)sb * 3 + 1) * 1536 + c] = a.st_gdn_conv[((size_t)sb * 3 + 2) * 1536 + c];
            a.s_gdn_conv[((size_t)sb * 3 + 2) * 1536 + c] = bf2f(prow[C_QKV + c]);
        }
        {
            const int c = tid;
            a.s_lru_conv[((size_t)sb * 3 + 0) * 512 + c] = a.st_lru_conv[((size_t)sb * 3 + 1) * 512 + c];
            a.s_lru_conv[((size_t)sb * 3 + 1) * 512 + c] = a.st_lru_conv[((size_t)sb * 3 + 2) * 512 + c];
            a.s_lru_conv[((size_t)sb * 3 + 2) * 512 + c] = bf2f(prow[C_XR + c]);
        }
    }
    {
        const int c = tid, n = c >> 6, d = c & 63;
        float r = a.b_r[c], ii = a.b_i[c];
#pragma unroll 4
        for (int cc = 0; cc < 64; ++cc) {
            const float xv = sx[n * 64 + cc];
            r += xv * a.w_r[((size_t)n * 64 + cc) * 64 + d];
            ii += xv * a.w_i[((size_t)n * 64 + cc) * 64 + d];
        }
        r = sigmoidf_(r); ii = sigmoidf_(ii);
        const float log_a = -8.0f * r * softplusf_(-a.lam[c]);
        a.LA[(size_t)t * 512 + c] = expf(log_a);
        a.LB[(size_t)t * 512 + c] = sqrtf(-expm1f(2.0f * log_a)) * (ii * sx[c]);
    }
}

__device__ __forceinline__ void gdn_scan(const float* __restrict__ QKV, const float* __restrict__ G, const float* __restrict__ BETA,
                                         const float* __restrict__ S0, float* __restrict__ O, float* __restrict__ Sout, int tok_base, int T,
                                         int sl, int h, int sq, float* smem) {
    int tid = threadIdx.x; asm volatile("" : "+v"(tid));
    const int dvl = tid & 31, kg = tid >> 5;
    const int dv = sl * 32 + dvl;
    float (*red1)[32] = (float (*)[32])smem;
    float (*red2)[32] = (float (*)[32])(smem + 512);
    float S[8];
#pragma unroll
    for (int i = 0; i < 8; ++i) S[i] = S0 ? S0[(((size_t)sq * 4 + h) * 128 + kg * 8 + i) * 128 + dv] : 0.f;
    float kk[8], qq[8], vv, g, be;
    {
        const size_t tok = (size_t)tok_base + (size_t)sq * T;
        const float* row = QKV + tok * 1536;
#pragma unroll
        for (int i = 0; i < 8; ++i) { kk[i] = row[512 + h * 128 + kg * 8 + i]; qq[i] = row[h * 128 + kg * 8 + i]; }
        vv = row[1024 + h * 128 + dv]; g = G[tok * 4 + h]; be = BETA[tok * 4 + h];
    }
    for (int t = 0; t < T; ++t) {
        const size_t tok = (size_t)tok_base + (size_t)sq * T + t;
        float nk[8], nq[8], nv = 0.f, ng = 0.f, nb = 0.f;
        if (t + 1 < T) {
            const float* row = QKV + (tok + 1) * 1536;
#pragma unroll
            for (int i = 0; i < 8; ++i) { nk[i] = row[512 + h * 128 + kg * 8 + i]; nq[i] = row[h * 128 + kg * 8 + i]; }
            nv = row[1024 + h * 128 + dv]; ng = G[(tok + 1) * 4 + h]; nb = BETA[(tok + 1) * 4 + h];
        } else {
#pragma unroll
            for (int i = 0; i < 8; ++i) { nk[i] = 0.f; nq[i] = 0.f; }
        }
        const float al = expf(g);
        float p = 0.f;
#pragma unroll
        for (int i = 0; i < 8; ++i) { S[i] *= al; p += S[i] * kk[i]; }
        red1[kg][dvl] = p;
        __syncthreads();
        float ks = 0.f;
#pragma unroll
        for (int j = 0; j < 16; ++j) ks += red1[j][dvl];
        const float vn = be * (vv - ks);
        float o = 0.f;
#pragma unroll
        for (int i = 0; i < 8; ++i) { S[i] += kk[i] * vn; o += S[i] * qq[i]; }
        red2[kg][dvl] = o;
        __syncthreads();
        if (kg == 0) {
            float os = 0.f;
#pragma unroll
            for (int j = 0; j < 16; ++j) os += red2[j][dvl];
            O[tok * 512 + h * 128 + dv] = os;
        }
#pragma unroll
        for (int i = 0; i < 8; ++i) { kk[i] = nk[i]; qq[i] = nq[i]; }
        vv = nv; g = ng; be = nb;
    }
#pragma unroll
    for (int i = 0; i < 8; ++i) Sout[(((size_t)sq * 4 + h) * 128 + kg * 8 + i) * 128 + dv] = S[i];
}

__device__ __forceinline__ void lru_scan(const float* __restrict__ LA, float* __restrict__ LB, const float* __restrict__ h0,
                                         float* __restrict__ hlast, int tok_base, int T, int nseq, int bx) {
    int tx_ = threadIdx.x; asm volatile("" : "+v"(tx_));
    const int idx = bx * NTH + tx_;
    if (idx >= nseq * 512) return;
    const int sq = idx / 512, c = idx % 512;
    float h = h0 ? h0[(size_t)sq * 512 + c] : 0.f;
    const size_t base = ((size_t)tok_base + (size_t)sq * T) * 512 + c;
#pragma unroll 8
    for (int t = 0; t < T; ++t) {
        const size_t o = base + (size_t)t * 512;
        h = LA[o] * h + LB[o];
        LB[o] = h;
    }
    hlast[(size_t)sq * 512 + c] = h;
}

__device__ __forceinline__ void ab_mix(const bf16* __restrict__ PROJ, const float* __restrict__ O, const float* __restrict__ H, const float* __restrict__ P, const float* __restrict__ CIN,
                                       const float* __restrict__ norm_w, bf16* __restrict__ MIX, int vb) {
    int tx_ = threadIdx.x; asm volatile("" : "+v"(tx_));
    const int tid = tx_ & 255, lane = tid & 63, wid = tid >> 6, t = vb * 2 + (tx_ >> 8);
    const bf16* prow = PROJ + (size_t)t * ABN;
    {
        const int h = wid;
        const float o0 = O[(size_t)t * 512 + h * 128 + lane], o1 = O[(size_t)t * 512 + h * 128 + 64 + lane];
        const float ms = wave_sum(o0 * o0 + o1 * o1) * (1.0f / 128.0f);
        const float sc = rsqrtf(ms + 1e-6f);
        MIX[(size_t)t * 1024 + h * 128 + lane] = (bf16)f2bf(o0 * sc * norm_w[lane] * siluf_(bf2f(prow[C_Z + h * 128 + lane])));
        MIX[(size_t)t * 1024 + h * 128 + 64 + lane] = (bf16)f2bf(o1 * sc * norm_w[64 + lane] * siluf_(bf2f(prow[C_Z + h * 128 + 64 + lane])));
    }
    for (int c = tid; c < 512; c += 256) {
        float hv = H[(size_t)t * 512 + c];
        if (t < NP) hv += P[(size_t)t * 512 + c] * CIN[(size_t)(t >> 6) * 512 + c];
        MIX[(size_t)t * 1024 + 512 + c] = (bf16)f2bf(geluf_(bf2f(prow[C_GATE + c])) * hv);
    }
}

__device__ __forceinline__ void ln_res_w(const float* __restrict__ xrow, const float* __restrict__ yrow, const float* __restrict__ g, const float* __restrict__ bta,
                                         float* __restrict__ orow, bf16* __restrict__ obrow, int lane) {
    f32x4 v[4]; float s = 0.f;
#pragma unroll
    for (int j = 0; j < 4; ++j) { const f32x4 x4 = ((const f32x4*)xrow)[lane + 64 * j], y4 = ((const f32x4*)yrow)[lane + 64 * j]; v[j] = x4 * ALPHA + y4; s += (v[j].x + v[j].y) + (v[j].z + v[j].w); }
    const float mean = wave_sum(s) * (1.0f / 1024.0f); float q = 0.f;
#pragma unroll
    for (int j = 0; j < 4; ++j) { v[j] = v[j] - mean; q += (v[j].x * v[j].x + v[j].y * v[j].y) + (v[j].z * v[j].z + v[j].w * v[j].w); }
    const float rs = rsqrtf(wave_sum(q) * (1.0f / 1024.0f) + LN_EPS);
#pragma unroll
    for (int j = 0; j < 4; ++j) {
        const f32x4 g4 = ((const f32x4*)g)[lane + 64 * j], b4 = ((const f32x4*)bta)[lane + 64 * j];
        const f32x4 o = v[j] * rs * g4 + b4;
        ((f32x4*)orow)[lane + 64 * j] = o;
        v2u ob; ob.x = pk2(o.x, o.y); ob.y = pk2(o.z, o.w);
        ((v2u*)obrow)[lane + 64 * j] = ob;
    }
}

__device__ __forceinline__ void peer_topk(const bf16* __restrict__ Q, const float* __restrict__ keys, int* __restrict__ EXP, float* __restrict__ GATE,
                                          int tg, int h, float* smem) {
    const int tid = threadIdx.x, cn = tid & 255, c = cn >> 7, n = cn & 127, th = tid >> 8;
    float (*sq)[256] = (float (*)[256])smem;
    float (*ss)[257] = (float (*)[257])(smem + 32 * 256);
    float (*tvs)[2][16] = (float (*)[2][16])(smem + 32 * 256 + 32 * 257 + 32);
    int (*tis)[2][16] = (int (*)[2][16])(smem + 32 * 256 + 32 * 257 + 32 + 1024);
    for (int i = tid; i < 32 * 256; i += NTH) {
        const int tk = i >> 8, col = i & 255;
        sq[tk][col] = bf2f(Q[(size_t)(tg * 32 + tk) * 2048 + h * 256 + col]);
    }
    __syncthreads();
    float acc[16];
#pragma unroll
    for (int i = 0; i < 16; ++i) acc[i] = 0.f;
    const float* krow = keys + (((size_t)h * 2 + c) * 128 + n) * 128;
    for (int d4 = 0; d4 < 32; ++d4) {
        const float4 kv = *(const float4*)(krow + d4 * 4);
#pragma unroll
        for (int tk = 0; tk < 16; ++tk) {
            const float4 qv = *(const float4*)&sq[th * 16 + tk][c * 128 + d4 * 4];
            acc[tk] += qv.x * kv.x + qv.y * kv.y + qv.z * kv.z + qv.w * kv.w;
        }
    }
#pragma unroll
    for (int tk = 0; tk < 16; ++tk) ss[th * 16 + tk][cn] = acc[tk];
    __syncthreads();
    if (tid < 64) {
        const int tk = tid >> 1, cc = tid & 1;
        float tv[16]; int ti[16];
#pragma unroll
        for (int j = 0; j < 16; ++j) { tv[j] = -INFINITY; ti[j] = 0; }
        for (int nn = 0; nn < 128; ++nn) {
            float x = ss[tk][cc * 128 + nn]; int xi = nn;
#pragma unroll
            for (int j = 0; j < 16; ++j) {
                const bool gt = x > tv[j];
                const float tf = tv[j]; const int tj = ti[j];
                tv[j] = gt ? x : tf; ti[j] = gt ? xi : tj;
                x = gt ? tf : x; xi = gt ? tj : xi;
            }
        }
#pragma unroll
        for (int j = 0; j < 16; ++j) { tvs[tk][cc][j] = tv[j]; tis[tk][cc][j] = ti[j]; }
    }
    __syncthreads();
    if (tid < 32) {
        const int tk = tid;
        float bv[16]; int bi[16];
#pragma unroll
        for (int j = 0; j < 16; ++j) { bv[j] = -INFINITY; bi[j] = 0; }
        for (int i = 0; i < 16; ++i)
            for (int jj = 0; jj < 16; ++jj) {
                float x = tvs[tk][0][i] + tvs[tk][1][jj]; int xi = tis[tk][0][i] * 128 + tis[tk][1][jj];
#pragma unroll
                for (int j = 0; j < 16; ++j) {
                    const bool gt = x > bv[j];
                    const float tf = bv[j]; const int tj = bi[j];
                    bv[j] = gt ? x : tf; bi[j] = gt ? xi : tj;
                    x = gt ? tf : x; xi = gt ? tj : xi;
                }
            }
        float e[16], sum = 0.f;
#pragma unroll
        for (int j = 0; j < 16; ++j) { e[j] = expf(bv[j] - bv[0]); sum += e[j]; }
        const float inv = 1.0f / sum;
        const size_t o = (size_t)(tg * 32 + tk) * 128 + h * 16;
#pragma unroll
        for (int j = 0; j < 16; ++j) { EXP[o + j] = bi[j]; GATE[o + j] = e[j] * inv; }
    }
}

__device__ __forceinline__ void peer_expert(const float* __restrict__ X, const int* __restrict__ EXP, const float* __restrict__ GATE,
                                            const float* __restrict__ U, const float* __restrict__ V,
                                            const float* __restrict__ g, const float* __restrict__ bta, float* __restrict__ out, bf16* __restrict__ outb, int t, float* smem) {
    const int tid = threadIdx.x, lane = tid & 63, wid = tid >> 6;
    float (*accs)[1024] = (float (*)[1024])smem;
    float* sred = smem + 8192;
    const float4* xr = (const float4*)(X + (size_t)t * D);
    float4 xv[4];
#pragma unroll
    for (int j = 0; j < 4; ++j) xv[j] = xr[lane + 64 * j];
    float4 acc[4];
#pragma unroll
    for (int j = 0; j < 4; ++j) acc[j] = make_float4(0.f, 0.f, 0.f, 0.f);
    for (int e = 0; e < 16; ++e) {
        const int id = EXP[(size_t)t * 128 + wid * 16 + e];
        const float gt = GATE[(size_t)t * 128 + wid * 16 + e];
        const float4* ur = (const float4*)(U + (size_t)id * D);
        const float4* vr = (const float4*)(V + (size_t)id * D);
        float4 uv[4], vv[4];
#pragma unroll
        for (int j = 0; j < 4; ++j) { uv[j] = ur[lane + 64 * j]; vv[j] = vr[lane + 64 * j]; }
        float dot = 0.f;
#pragma unroll
        for (int j = 0; j < 4; ++j) dot += uv[j].x * xv[j].x + uv[j].y * xv[j].y + uv[j].z * xv[j].z + uv[j].w * xv[j].w;
        dot = wave_sum(dot);
        const float cf = gt * geluf_(dot);
#pragma unroll
        for (int j = 0; j < 4; ++j) { acc[j].x += cf * vv[j].x; acc[j].y += cf * vv[j].y; acc[j].z += cf * vv[j].z; acc[j].w += cf * vv[j].w; }
    }
#pragma unroll
    for (int j = 0; j < 4; ++j) *(float4*)&accs[wid][(lane + 64 * j) * 4] = acc[j];
    __syncthreads();
    float v[2];
#pragma unroll
    for (int i = 0; i < 2; ++i) {
        const int c = tid * 2 + i;
        float s = 0.f;
#pragma unroll
        for (int w = 0; w < 8; ++w) s += accs[w][c];
        v[i] = ALPHA * X[(size_t)t * D + c] + s;
    }
    float s = wave_sum(v[0] + v[1]);
    if (lane == 0) sred[wid] = s;
    __syncthreads();
    float mean = 0.f;
#pragma unroll
    for (int w = 0; w < 8; ++w) mean += sred[w];
    mean *= (1.0f / 1024.0f);
    __syncthreads();
    const float d0 = v[0] - mean, d1 = v[1] - mean;
    float q = wave_sum(d0 * d0 + d1 * d1);
    if (lane == 0) sred[wid] = q;
    __syncthreads();
    float var = 0.f;
#pragma unroll
    for (int w = 0; w < 8; ++w) var += sred[w];
    const float rs = rsqrtf(var * (1.0f / 1024.0f) + LN_EPS);
    const float o0 = d0 * rs * g[tid * 2] + bta[tid * 2], o1 = d1 * rs * g[tid * 2 + 1] + bta[tid * 2 + 1];
    *(float2*)(out + (size_t)t * D + tid * 2) = make_float2(o0, o1);
    if (outb) *(unsigned*)(outb + (size_t)t * D + tid * 2) = pk2(o0, o1);
}


typedef __bf16 bf16x2_t __attribute__((ext_vector_type(2)));
__device__ __forceinline__ float dot2bf(unsigned w, unsigned x, float acc) { return __builtin_amdgcn_fdot2_f32_bf16(__builtin_bit_cast(bf16x2_t, w), __builtin_bit_cast(bf16x2_t, x), acc, false); }
__device__ __forceinline__ float bflo(unsigned w) { return __uint_as_float(w << 16); }
__device__ __forceinline__ float bfhi(unsigned w) { return __uint_as_float(w & 0xffff0000u); }
typedef float f32x2_t __attribute__((ext_vector_type(2)));
__device__ __forceinline__ void row_to_fp8(const float* __restrict__ xrow, unsigned char* __restrict__ orow, float* __restrict__ scale, int lane) {
    f32x4 v[4]; float am = 0.f;
#pragma unroll
    for (int j = 0; j < 4; ++j) { v[j] = *(const f32x4*)(xrow + lane * 16 + j * 4); am = fmaxf(am, fmaxf(fmaxf(fabsf(v[j].x), fabsf(v[j].y)), fmaxf(fabsf(v[j].z), fabsf(v[j].w)))); }
    am = wave_max(am);
    const float s = am > 0.f ? am * (1.0f / 448.0f) : 1.0f, inv = 1.0f / s;
    v4u o;
    unsigned w;
    w = 0u; w = __builtin_amdgcn_cvt_pk_fp8_f32(v[0].x * inv, v[0].y * inv, w, false); w = __builtin_amdgcn_cvt_pk_fp8_f32(v[0].z * inv, v[0].w * inv, w, true); o.x = w;
    w = 0u; w = __builtin_amdgcn_cvt_pk_fp8_f32(v[1].x * inv, v[1].y * inv, w, false); w = __builtin_amdgcn_cvt_pk_fp8_f32(v[1].z * inv, v[1].w * inv, w, true); o.y = w;
    w = 0u; w = __builtin_amdgcn_cvt_pk_fp8_f32(v[2].x * inv, v[2].y * inv, w, false); w = __builtin_amdgcn_cvt_pk_fp8_f32(v[2].z * inv, v[2].w * inv, w, true); o.z = w;
    w = 0u; w = __builtin_amdgcn_cvt_pk_fp8_f32(v[3].x * inv, v[3].y * inv, w, false); w = __builtin_amdgcn_cvt_pk_fp8_f32(v[3].z * inv, v[3].w * inv, w, true); o.w = w;
    *(v4u*)(orow + lane * 16) = o;
    if (lane == 0) *scale = s;
}
#define PE_LOAD(UB, VB, grp) do { _Pragma("unroll") for (int i_ = 0; i_ < 4; ++i_) { const int e_ = (grp) * 4 + i_; \
        const int id_ = __builtin_amdgcn_readlane(e_ < 64 ? id0 : id1, e_ & 63); \
        const unsigned so_ = (unsigned)id_ * 1024u; \
        UB[i_] = __builtin_amdgcn_raw_buffer_load_b128(ursrc, voff, so_, 0); VB[i_] = __builtin_amdgcn_raw_buffer_load_b128(vrsrc, voff, so_, 0); } } while (0)
#define PE_DOT4(w, k) do { const f32x2_t l_ = __builtin_amdgcn_cvt_pk_f32_fp8((w), false), h_ = __builtin_amdgcn_cvt_pk_f32_fp8((w), true); \
        a_ += l_.x * xv[(k) * 4 + 0]; b_ += l_.y * xv[(k) * 4 + 1]; a_ += h_.x * xv[(k) * 4 + 2]; b_ += h_.y * xv[(k) * 4 + 3]; } while (0)
#define PE_AXPY4(w, k) do { const f32x2_t l_ = __builtin_amdgcn_cvt_pk_f32_fp8((w), false), h_ = __builtin_amdgcn_cvt_pk_f32_fp8((w), true); \
        acc[(k) * 4 + 0] += cf_ * l_.x; acc[(k) * 4 + 1] += cf_ * l_.y; acc[(k) * 4 + 2] += cf_ * h_.x; acc[(k) * 4 + 3] += cf_ * h_.y; } while (0)
#define PE_COMP(UB, VB, grp) do { float d_[4]; \
        _Pragma("unroll") for (int i_ = 0; i_ < 4; ++i_) { float a_ = 0.f, b_ = 0.f; PE_DOT4(UB[i_].x, 0); PE_DOT4(UB[i_].y, 1); PE_DOT4(UB[i_].z, 2); PE_DOT4(UB[i_].w, 3); d_[i_] = a_ + b_; } \
          \
        float s0_ = hi32 ? d_[2] : d_[0], t0_ = hi32 ? d_[0] : d_[2]; s0_ += __shfl_xor(t0_, 32); \
        float s1_ = hi32 ? d_[3] : d_[1], t1_ = hi32 ? d_[1] : d_[3]; s1_ += __shfl_xor(t1_, 32); \
        float r_ = hi16 ? s1_ : s0_, t2_ = hi16 ? s0_ : s1_; r_ += __shfl_xor(t2_, 16); \
        r_ += __shfl_xor(r_, 8); r_ += __shfl_xor(r_, 4); r_ += __shfl_xor(r_, 2); r_ += __shfl_xor(r_, 1); \
          \
        const int esel_ = (grp) * 4 + (lane >> 4); \
        const float su_ = __shfl(esel_ < 64 ? su0 : su1, esel_ & 63), gv_ = __shfl(esel_ < 64 ? gs0 : gs1, esel_ & 63); \
        const float cfl_ = geluf_(r_ * su_) * gv_; \
        _Pragma("unroll") for (int i_ = 0; i_ < 4; ++i_) { \
            const float cf_ = __uint_as_float(__builtin_amdgcn_readlane(__float_as_uint(cfl_), 16 * i_)); \
            PE_AXPY4(VB[i_].x, 0); PE_AXPY4(VB[i_].y, 1); PE_AXPY4(VB[i_].z, 2); PE_AXPY4(VB[i_].w, 3); } } while (0)
__device__ __forceinline__ void peer_expert_w(const float* __restrict__ xrow, const int* __restrict__ exr, const float* __restrict__ gar,
                                              const unsigned char* __restrict__ U, const unsigned char* __restrict__ V, const float* __restrict__ SU, const float* __restrict__ SV,
                                              const float* __restrict__ g, const float* __restrict__ bta, float* __restrict__ orow, bf16* __restrict__ obrow, int lane) {
    const bool hi32 = (lane & 32) != 0, hi16 = (lane & 16) != 0;
    const __amdgpu_buffer_rsrc_t ursrc = __builtin_amdgcn_make_buffer_rsrc((void*)U, 0, 16384 * 1024, 0x00020000);
    const __amdgpu_buffer_rsrc_t vrsrc = __builtin_amdgcn_make_buffer_rsrc((void*)V, 0, 16384 * 1024, 0x00020000);
    const int voff = lane * 16;
    float xv[16];
#pragma unroll
    for (int j = 0; j < 4; ++j) { const f32x4 t = *(const f32x4*)(xrow + lane * 16 + j * 4); xv[j * 4 + 0] = t.x; xv[j * 4 + 1] = t.y; xv[j * 4 + 2] = t.z; xv[j * 4 + 3] = t.w; }
    const int id0 = exr[lane], id1 = exr[64 + lane];
    const float su0 = SU[id0], su1 = SU[id1];
    const float gs0 = gar[lane] * SV[id0], gs1 = gar[64 + lane] * SV[id1];
    float acc[16];
#pragma unroll
    for (int i = 0; i < 16; ++i) acc[i] = 0.f;
    v4u ua[4], va[4], ub[4], vb[4];
    PE_LOAD(ua, va, 0);
#pragma unroll 1
    for (int grp = 0; grp < 32; grp += 2) {
        PE_LOAD(ub, vb, grp + 1);
        PE_COMP(ua, va, grp);
        if (grp + 2 < 32) PE_LOAD(ua, va, grp + 2);
        PE_COMP(ub, vb, grp + 1);
    }
    float v[16]; float s = 0.f;
#pragma unroll
    for (int i = 0; i < 16; ++i) { v[i] = ALPHA * xv[i] + acc[i]; s += v[i]; }
    const float mean = wave_sum(s) * (1.0f / 1024.0f); float q = 0.f;
#pragma unroll
    for (int i = 0; i < 16; ++i) { v[i] -= mean; q += v[i] * v[i]; }
    const float rs = rsqrtf(wave_sum(q) * (1.0f / 1024.0f) + LN_EPS);
    float o[16];
#pragma unroll
    for (int j = 0; j < 4; ++j) {
        const f32x4 g4 = *(const f32x4*)(g + lane * 16 + j * 4), b4 = *(const f32x4*)(bta + lane * 16 + j * 4);
        o[j * 4 + 0] = v[j * 4 + 0] * rs * g4.x + b4.x; o[j * 4 + 1] = v[j * 4 + 1] * rs * g4.y + b4.y; o[j * 4 + 2] = v[j * 4 + 2] * rs * g4.z + b4.z; o[j * 4 + 3] = v[j * 4 + 3] * rs * g4.w + b4.w;
        *(f32x4*)(orow + lane * 16 + j * 4) = (f32x4){o[j * 4 + 0], o[j * 4 + 1], o[j * 4 + 2], o[j * 4 + 3]};
    }
    if (obrow) {
        v4u w0, w1; w0.x = pk2(o[0], o[1]); w0.y = pk2(o[2], o[3]); w0.z = pk2(o[4], o[5]); w0.w = pk2(o[6], o[7]); w1.x = pk2(o[8], o[9]); w1.y = pk2(o[10], o[11]); w1.z = pk2(o[12], o[13]); w1.w = pk2(o[14], o[15]);
        *(v4u*)(obrow + lane * 16) = w0; *(v4u*)(obrow + lane * 16 + 8) = w1;
    }
}


__device__ __forceinline__ void peer_expert_blk(const float* __restrict__ xrow, const int* __restrict__ exr, const float* __restrict__ gar,
                                                const unsigned char* __restrict__ U, const unsigned char* __restrict__ V, const float* __restrict__ SU, const float* __restrict__ SV,
                                                const float* __restrict__ g, const float* __restrict__ bta, float* __restrict__ orow, bf16* __restrict__ obrow, int lane, int wave, float* smem) {
    const bool hi32 = (lane & 32) != 0, hi16 = (lane & 16) != 0;
    const __amdgpu_buffer_rsrc_t ursrc = __builtin_amdgcn_make_buffer_rsrc((void*)U, 0, 16384 * 1024, 0x00020000);
    const __amdgpu_buffer_rsrc_t vrsrc = __builtin_amdgcn_make_buffer_rsrc((void*)V, 0, 16384 * 1024, 0x00020000);
    const int voff = lane * 16;
    float xv[16];
#pragma unroll
    for (int j = 0; j < 4; ++j) { const f32x4 t = *(const f32x4*)(xrow + lane * 16 + j * 4); xv[j * 4 + 0] = t.x; xv[j * 4 + 1] = t.y; xv[j * 4 + 2] = t.z; xv[j * 4 + 3] = t.w; }
    const int id0 = exr[lane], id1 = exr[64 + lane];
    const float su0 = SU[id0], su1 = SU[id1];
    const float gs0 = gar[lane] * SV[id0], gs1 = gar[64 + lane] * SV[id1];
    float acc[16];
#pragma unroll
    for (int i = 0; i < 16; ++i) acc[i] = 0.f;
    v4u ua[4], va[4], ub[4], vb[4];
    const int g0 = wave * 4;
    PE_LOAD(ua, va, g0); PE_LOAD(ub, vb, g0 + 1);
    PE_COMP(ua, va, g0); PE_LOAD(ua, va, g0 + 2);
    PE_COMP(ub, vb, g0 + 1); PE_LOAD(ub, vb, g0 + 3);
    PE_COMP(ua, va, g0 + 2);
    PE_COMP(ub, vb, g0 + 3);
    float* accs = smem;
    float* sred = smem + 8192;
#pragma unroll
    for (int j = 0; j < 4; ++j) *(f32x4*)(accs + wave * 1024 + lane * 16 + j * 4) = (f32x4){acc[j * 4 + 0], acc[j * 4 + 1], acc[j * 4 + 2], acc[j * 4 + 3]};
    __syncthreads();
    const int tid = wave * 64 + lane;
    float v0 = ALPHA * xrow[tid * 2], v1 = ALPHA * xrow[tid * 2 + 1];
#pragma unroll
    for (int w = 0; w < 8; ++w) { v0 += accs[w * 1024 + tid * 2]; v1 += accs[w * 1024 + tid * 2 + 1]; }
    const float s = wave_sum(v0 + v1);
    if (lane == 0) sred[wave] = s;
    __syncthreads();
    float mean = 0.f;
#pragma unroll
    for (int w = 0; w < 8; ++w) mean += sred[w];
    mean *= (1.0f / 1024.0f);
    __syncthreads();
    const float d0 = v0 - mean, d1 = v1 - mean;
    const float q = wave_sum(d0 * d0 + d1 * d1);
    if (lane == 0) sred[wave] = q;
    __syncthreads();
    float var = 0.f;
#pragma unroll
    for (int w = 0; w < 8; ++w) var += sred[w];
    const float rs = rsqrtf(var * (1.0f / 1024.0f) + LN_EPS);
    const float o0 = d0 * rs * g[tid * 2] + bta[tid * 2], o1 = d1 * rs * g[tid * 2 + 1] + bta[tid * 2 + 1];
    *(float2*)(orow + tid * 2) = make_float2(o0, o1);
    if (obrow) *(unsigned*)(obrow + tid * 2) = pk2(o0, o1);
    __syncthreads();
}

__device__ __forceinline__ void row_to_fp8_sliced(const float* __restrict__ xrow, unsigned char* __restrict__ tab, int r, float* __restrict__ scale, int lane) {
    f32x4 v[4]; float am = 0.f;
#pragma unroll
    for (int j = 0; j < 4; ++j) { v[j] = *(const f32x4*)(xrow + lane * 16 + j * 4); am = fmaxf(am, fmaxf(fmaxf(fabsf(v[j].x), fabsf(v[j].y)), fmaxf(fabsf(v[j].z), fabsf(v[j].w)))); }
    am = wave_max(am);
    const float s = am > 0.f ? am * (1.0f / 448.0f) : 1.0f, inv = 1.0f / s;
    v4u o; unsigned w;
    w = 0u; w = __builtin_amdgcn_cvt_pk_fp8_f32(v[0].x * inv, v[0].y * inv, w, false); w = __builtin_amdgcn_cvt_pk_fp8_f32(v[0].z * inv, v[0].w * inv, w, true); o.x = w;
    w = 0u; w = __builtin_amdgcn_cvt_pk_fp8_f32(v[1].x * inv, v[1].y * inv, w, false); w = __builtin_amdgcn_cvt_pk_fp8_f32(v[1].z * inv, v[1].w * inv, w, true); o.y = w;
    w = 0u; w = __builtin_amdgcn_cvt_pk_fp8_f32(v[2].x * inv, v[2].y * inv, w, false); w = __builtin_amdgcn_cvt_pk_fp8_f32(v[2].z * inv, v[2].w * inv, w, true); o.z = w;
    w = 0u; w = __builtin_amdgcn_cvt_pk_fp8_f32(v[3].x * inv, v[3].y * inv, w, false); w = __builtin_amdgcn_cvt_pk_fp8_f32(v[3].z * inv, v[3].w * inv, w, true); o.w = w;
    *(v4u*)(tab + ((size_t)(lane >> 3) * 16384 + r) * 128 + (lane & 7) * 16) = o;
    if (lane == 0) *scale = s;
}
__device__ __forceinline__ void peer_u_pass(const float* __restrict__ xrow, const int* __restrict__ exr, const unsigned char* __restrict__ U8x, float* __restrict__ pd, int x, int lane) {
    const int e8 = lane >> 3, c = lane & 7;
    f32x2_t xp[8];
#pragma unroll
    for (int j = 0; j < 4; ++j) { const f32x4 t = *(const f32x4*)(xrow + x * 128 + c * 16 + j * 4); xp[j * 2] = (f32x2_t){t.x, t.y}; xp[j * 2 + 1] = (f32x2_t){t.z, t.w}; }
    const __amdgpu_buffer_rsrc_t ursrc = __builtin_amdgcn_make_buffer_rsrc((void*)U8x, 0, 16384 * 128, 0x00020000);
    v4u wa[8], wb[8];
    float d[16];
    int ids[16];
#pragma unroll
    for (int j = 0; j < 4; ++j) { const v4u t = *(const v4u*)(exr + e8 * 16 + j * 4); ids[j * 4 + 0] = (int)t.x; ids[j * 4 + 1] = (int)t.y; ids[j * 4 + 2] = (int)t.z; ids[j * 4 + 3] = (int)t.w; }
#pragma unroll
    for (int g = 0; g < 8; ++g) wa[g] = __builtin_amdgcn_raw_buffer_load_b128(ursrc, ids[g] * 128 + c * 16, 0, 0);
#pragma unroll
    for (int g = 0; g < 8; ++g) wb[g] = __builtin_amdgcn_raw_buffer_load_b128(ursrc, ids[8 + g] * 128 + c * 16, 0, 0);
#define PU_DOT1(w_, k_) do { a_ = __builtin_elementwise_fma(__builtin_amdgcn_cvt_pk_f32_fp8((w_), false), xp[(k_) * 2], a_); a_ = __builtin_elementwise_fma(__builtin_amdgcn_cvt_pk_f32_fp8((w_), true), xp[(k_) * 2 + 1], a_); } while (0)
#pragma unroll
    for (int g = 0; g < 8; ++g) { f32x2_t a_ = (f32x2_t){0.f, 0.f}; PU_DOT1(wa[g].x, 0); PU_DOT1(wa[g].y, 1); PU_DOT1(wa[g].z, 2); PU_DOT1(wa[g].w, 3); d[g] = a_.x + a_.y; }
#pragma unroll
    for (int g = 0; g < 8; ++g) { f32x2_t a_ = (f32x2_t){0.f, 0.f}; PU_DOT1(wb[g].x, 0); PU_DOT1(wb[g].y, 1); PU_DOT1(wb[g].z, 2); PU_DOT1(wb[g].w, 3); d[8 + g] = a_.x + a_.y; }
#pragma unroll
    for (int g = 0; g < 16; ++g) { d[g] += DPPF(d[g], 0xB1, 0xf); d[g] += DPPF(d[g], 0x4E, 0xf); d[g] += DPPF(d[g], 0x141, 0xf); }
    if (c == 0) {
#pragma unroll
        for (int j = 0; j < 4; ++j) *(f32x4*)(pd + e8 * 16 + j * 4) = (f32x4){d[j * 4 + 0], d[j * 4 + 1], d[j * 4 + 2], d[j * 4 + 3]};
    }
}
#define PV_LOAD(VB, grp) do { _Pragma("unroll") for (int i_ = 0; i_ < 4; ++i_) { const int e_ = (grp) * 4 + i_; \
        const int id_ = __builtin_amdgcn_readlane(e_ < 64 ? id0 : id1, e_ & 63); \
        VB[i_] = __builtin_amdgcn_raw_buffer_load_b128(vrsrc, voff, (unsigned)id_ * 1024u, 0); } } while (0)
#define PV_COMP(VB, grp) do { _Pragma("unroll") for (int i_ = 0; i_ < 4; ++i_) { const int e_ = (grp) * 4 + i_; \
        const float cf_ = __uint_as_float(__builtin_amdgcn_readlane(__float_as_uint(e_ < 64 ? cf0 : cf1), e_ & 63)); \
        PE_AXPY4(VB[i_].x, 0); PE_AXPY4(VB[i_].y, 1); PE_AXPY4(VB[i_].z, 2); PE_AXPY4(VB[i_].w, 3); } } while (0)
#define PV_COEFS() \
    const int id0 = exr[lane], id1 = exr[64 + lane]; \
    float dot0 = 0.f, dot1 = 0.f; \
    { const int p0 = lane, p1 = 64 + lane;        \
      _Pragma("unroll") for (int x_ = 0; x_ < 8; ++x_) { dot0 += pdt[(size_t)x_ * NT * 128 + p0]; dot1 += pdt[(size_t)x_ * NT * 128 + p1]; } } \
    const float cf0 = gar[lane] * SV[id0] * geluf_(SU[id0] * dot0), cf1 = gar[64 + lane] * SV[id1] * geluf_(SU[id1] * dot1);
__device__ __forceinline__ void peer_v_w(const float* __restrict__ xrow, const int* __restrict__ exr, const float* __restrict__ gar, const float* __restrict__ pdt,
                                         const unsigned char* __restrict__ V, const float* __restrict__ SU, const float* __restrict__ SV,
                                         const float* __restrict__ g, const float* __restrict__ bta, float* __restrict__ orow, bf16* __restrict__ obrow, int lane) {
    const __amdgpu_buffer_rsrc_t vrsrc = __builtin_amdgcn_make_buffer_rsrc((void*)V, 0, 16384 * 1024, 0x00020000);
    const int voff = lane * 16;
    PV_COEFS()
    float acc[16];
#pragma unroll
    for (int i = 0; i < 16; ++i) acc[i] = 0.f;
    v4u va[4], vb[4], vc[4];
    PV_LOAD(va, 0); PV_LOAD(vb, 1);
#pragma unroll 1
    for (int grp = 0; grp < 30; grp += 3) {
        PV_LOAD(vc, grp + 2);
        PV_COMP(va, grp);
        PV_LOAD(va, grp + 3);
        PV_COMP(vb, grp + 1);
        PV_LOAD(vb, grp + 4);
        PV_COMP(vc, grp + 2);
    }
    PV_COMP(va, 30); PV_COMP(vb, 31);
    float xv[16];
#pragma unroll
    for (int j = 0; j < 4; ++j) { const f32x4 t = *(const f32x4*)(xrow + lane * 16 + j * 4); xv[j * 4 + 0] = t.x; xv[j * 4 + 1] = t.y; xv[j * 4 + 2] = t.z; xv[j * 4 + 3] = t.w; }
    float v[16]; float s = 0.f;
#pragma unroll
    for (int i = 0; i < 16; ++i) { v[i] = ALPHA * xv[i] + acc[i]; s += v[i]; }
    const float mean = wave_sum(s) * (1.0f / 1024.0f); float q = 0.f;
#pragma unroll
    for (int i = 0; i < 16; ++i) { v[i] -= mean; q += v[i] * v[i]; }
    const float rs = rsqrtf(wave_sum(q) * (1.0f / 1024.0f) + LN_EPS);
    float o[16];
#pragma unroll
    for (int j = 0; j < 4; ++j) {
        const f32x4 g4 = *(const f32x4*)(g + lane * 16 + j * 4), b4 = *(const f32x4*)(bta + lane * 16 + j * 4);
        o[j * 4 + 0] = v[j * 4 + 0] * rs * g4.x + b4.x; o[j * 4 + 1] = v[j * 4 + 1] * rs * g4.y + b4.y; o[j * 4 + 2] = v[j * 4 + 2] * rs * g4.z + b4.z; o[j * 4 + 3] = v[j * 4 + 3] * rs * g4.w + b4.w;
        *(f32x4*)(orow + lane * 16 + j * 4) = (f32x4){o[j * 4 + 0], o[j * 4 + 1], o[j * 4 + 2], o[j * 4 + 3]};
    }
    if (obrow) {
        v4u w0, w1; w0.x = pk2(o[0], o[1]); w0.y = pk2(o[2], o[3]); w0.z = pk2(o[4], o[5]); w0.w = pk2(o[6], o[7]); w1.x = pk2(o[8], o[9]); w1.y = pk2(o[10], o[11]); w1.z = pk2(o[12], o[13]); w1.w = pk2(o[14], o[15]);
        *(v4u*)(obrow + lane * 16) = w0; *(v4u*)(obrow + lane * 16 + 8) = w1;
    }
}
__device__ __forceinline__ void peer_v_blk(const float* __restrict__ xrow, const int* __restrict__ exr, const float* __restrict__ gar, const float* __restrict__ pdt,
                                           const unsigned char* __restrict__ V, const float* __restrict__ SU, const float* __restrict__ SV,
                                           const float* __restrict__ g, const float* __restrict__ bta, float* __restrict__ orow, bf16* __restrict__ obrow, int lane, int wave, float* smem) {
    const __amdgpu_buffer_rsrc_t vrsrc = __builtin_amdgcn_make_buffer_rsrc((void*)V, 0, 16384 * 1024, 0x00020000);
    const int voff = lane * 16;
    PV_COEFS()
    float acc[16];
#pragma unroll
    for (int i = 0; i < 16; ++i) acc[i] = 0.f;
    v4u va[4], vb[4], vc[4], vd[4];
    PV_LOAD(va, wave * 4); PV_LOAD(vb, wave * 4 + 1); PV_LOAD(vc, wave * 4 + 2); PV_LOAD(vd, wave * 4 + 3);
    PV_COMP(va, wave * 4); PV_COMP(vb, wave * 4 + 1); PV_COMP(vc, wave * 4 + 2); PV_COMP(vd, wave * 4 + 3);
    float* accs = smem;
    float* sred = smem + 8192;
#pragma unroll
    for (int j = 0; j < 4; ++j) *(f32x4*)(accs + wave * 1024 + lane * 16 + j * 4) = (f32x4){acc[j * 4 + 0], acc[j * 4 + 1], acc[j * 4 + 2], acc[j * 4 + 3]};
    __syncthreads();
    const int tid = wave * 64 + lane;
    float v0 = ALPHA * xrow[tid * 2], v1 = ALPHA * xrow[tid * 2 + 1];
#pragma unroll
    for (int w = 0; w < 8; ++w) { v0 += accs[w * 1024 + tid * 2]; v1 += accs[w * 1024 + tid * 2 + 1]; }
    const float s = wave_sum(v0 + v1);
    if (lane == 0) sred[wave] = s;
    __syncthreads();
    float mean = 0.f;
#pragma unroll
    for (int w = 0; w < 8; ++w) mean += sred[w];
    mean *= (1.0f / 1024.0f);
    __syncthreads();
    const float d0 = v0 - mean, d1 = v1 - mean;
    const float q = wave_sum(d0 * d0 + d1 * d1);
    if (lane == 0) sred[wave] = q;
    __syncthreads();
    float var = 0.f;
#pragma unroll
    for (int w = 0; w < 8; ++w) var += sred[w];
    const float rs = rsqrtf(var * (1.0f / 1024.0f) + LN_EPS);
    const float o0 = d0 * rs * g[tid * 2] + bta[tid * 2], o1 = d1 * rs * g[tid * 2 + 1] + bta[tid * 2 + 1];
    *(float2*)(orow + tid * 2) = make_float2(o0, o1);
    if (obrow) *(unsigned*)(obrow + tid * 2) = pk2(o0, o1);
    __syncthreads();
}

__device__ __forceinline__ void peer_xk(const int* __restrict__ exr, float* __restrict__ gar, const float* __restrict__ pdt, const float* __restrict__ SU, const float* __restrict__ SV, int lane) {
    PV_COEFS()
    gar[lane] = cf0; gar[64 + lane] = cf1;
}
__device__ __forceinline__ void peer_v_slice(const int* __restrict__ exr, const float* __restrict__ cfr, const unsigned char* __restrict__ V8x, float* __restrict__ outs  , int lane) {
    const int e8 = lane >> 3, c = lane & 7;
    const __amdgpu_buffer_rsrc_t vrsrc = __builtin_amdgcn_make_buffer_rsrc((void*)V8x, 0, 16384 * 128, 0x00020000);
    v4u wa[8], wb[8]; float cfa[8], cfb[8];
    int ids[16];
#pragma unroll
    for (int j = 0; j < 4; ++j) { const v4u t = *(const v4u*)(exr + e8 * 16 + j * 4); ids[j * 4 + 0] = (int)t.x; ids[j * 4 + 1] = (int)t.y; ids[j * 4 + 2] = (int)t.z; ids[j * 4 + 3] = (int)t.w; }
#pragma unroll
    for (int g = 0; g < 8; ++g) wa[g] = __builtin_amdgcn_raw_buffer_load_b128(vrsrc, ids[g] * 128 + c * 16, 0, 0);
#pragma unroll
    for (int g = 0; g < 8; ++g) wb[g] = __builtin_amdgcn_raw_buffer_load_b128(vrsrc, ids[8 + g] * 128 + c * 16, 0, 0);
#pragma unroll
    for (int j = 0; j < 2; ++j) { const f32x4 t = *(const f32x4*)(cfr + e8 * 16 + j * 4), u = *(const f32x4*)(cfr + e8 * 16 + 8 + j * 4);
        cfa[j * 4 + 0] = t.x; cfa[j * 4 + 1] = t.y; cfa[j * 4 + 2] = t.z; cfa[j * 4 + 3] = t.w; cfb[j * 4 + 0] = u.x; cfb[j * 4 + 1] = u.y; cfb[j * 4 + 2] = u.z; cfb[j * 4 + 3] = u.w; }
    f32x2_t ap[8];
#pragma unroll
    for (int i = 0; i < 8; ++i) ap[i] = (f32x2_t){0.f, 0.f};
#define PVS_AXPY(w_, k_) do { ap[(k_) * 2] = __builtin_elementwise_fma(cf2_, __builtin_amdgcn_cvt_pk_f32_fp8((w_), false), ap[(k_) * 2]); ap[(k_) * 2 + 1] = __builtin_elementwise_fma(cf2_, __builtin_amdgcn_cvt_pk_f32_fp8((w_), true), ap[(k_) * 2 + 1]); } while (0)
#pragma unroll
    for (int g = 0; g < 8; ++g) { const f32x2_t cf2_ = (f32x2_t){cfa[g], cfa[g]}; PVS_AXPY(wa[g].x, 0); PVS_AXPY(wa[g].y, 1); PVS_AXPY(wa[g].z, 2); PVS_AXPY(wa[g].w, 3); }
#pragma unroll
    for (int g = 0; g < 8; ++g) { const f32x2_t cf2_ = (f32x2_t){cfb[g], cfb[g]}; PVS_AXPY(wb[g].x, 0); PVS_AXPY(wb[g].y, 1); PVS_AXPY(wb[g].z, 2); PVS_AXPY(wb[g].w, 3); }
#undef PVS_AXPY
    float acc[16];
#pragma unroll
    for (int i = 0; i < 8; ++i) { acc[2 * i] = ap[i].x; acc[2 * i + 1] = ap[i].y; }
#pragma unroll
    for (int i = 0; i < 16; ++i) { float v = acc[i]; v += DPPF(v, 0x128, 0xf); v += __shfl_xor(v, 16); v += __shfl_xor(v, 32); acc[i] = v; }
    if (e8 == 0) {
#pragma unroll
        for (int j = 0; j < 4; ++j) *(f32x4*)(outs + c * 16 + j * 4) = (f32x4){acc[j * 4 + 0], acc[j * 4 + 1], acc[j * 4 + 2], acc[j * 4 + 3]};
    }
}
__device__ __forceinline__ void peer_xc(const float* __restrict__ xrow, const float* __restrict__ srow, const float* __restrict__ g, const float* __restrict__ bta, float* __restrict__ orow, bf16* __restrict__ obrow, int lane) {
    float v[16]; float s = 0.f;
#pragma unroll
    for (int j = 0; j < 4; ++j) { const f32x4 a = *(const f32x4*)(xrow + lane * 16 + j * 4), b = *(const f32x4*)(srow + lane * 16 + j * 4);
        v[j * 4 + 0] = ALPHA * a.x + b.x; v[j * 4 + 1] = ALPHA * a.y + b.y; v[j * 4 + 2] = ALPHA * a.z + b.z; v[j * 4 + 3] = ALPHA * a.w + b.w; }
#pragma unroll
    for (int i = 0; i < 16; ++i) s += v[i];
    const float mean = wave_sum(s) * (1.0f / 1024.0f); float q = 0.f;
#pragma unroll
    for (int i = 0; i < 16; ++i) { v[i] -= mean; q += v[i] * v[i]; }
    const float rs = rsqrtf(wave_sum(q) * (1.0f / 1024.0f) + LN_EPS);
    float o[16];
#pragma unroll
    for (int j = 0; j < 4; ++j) {
        const f32x4 g4 = *(const f32x4*)(g + lane * 16 + j * 4), b4 = *(const f32x4*)(bta + lane * 16 + j * 4);
        o[j * 4 + 0] = v[j * 4 + 0] * rs * g4.x + b4.x; o[j * 4 + 1] = v[j * 4 + 1] * rs * g4.y + b4.y; o[j * 4 + 2] = v[j * 4 + 2] * rs * g4.z + b4.z; o[j * 4 + 3] = v[j * 4 + 3] * rs * g4.w + b4.w;
        *(f32x4*)(orow + lane * 16 + j * 4) = (f32x4){o[j * 4 + 0], o[j * 4 + 1], o[j * 4 + 2], o[j * 4 + 3]};
    }
    if (obrow) {
        v4u w0, w1; w0.x = pk2(o[0], o[1]); w0.y = pk2(o[2], o[3]); w0.z = pk2(o[4], o[5]); w0.w = pk2(o[6], o[7]); w1.x = pk2(o[8], o[9]); w1.y = pk2(o[10], o[11]); w1.z = pk2(o[12], o[13]); w1.w = pk2(o[14], o[15]);
        *(v4u*)(obrow + lane * 16) = w0; *(v4u*)(obrow + lane * 16 + 8) = w1;
    }
}

__device__ __forceinline__ int t5_bucket(int n) {
    if (n < 16) return n;
    const int large = 16 + (int)(logf((float)n / 16.0f) / 2.0794415416798357f * 16.0f);
    return large < 31 ? large : 31;
}
__device__ __forceinline__ void swa_attn(const float* __restrict__ PC, const float* __restrict__ cache_k, const float* __restrict__ cache_v,
                                         const float* __restrict__ rel_bias, const float* __restrict__ sinks, bf16* __restrict__ ATT, int bx) {
    const int tid = threadIdx.x, lane = tid & 63, wid = tid >> 6;
    const int gw = bx * 8 + wid;
    const int t = gw >> 4, h = gw & 15, kvh = h >> 2;
    if (t >= NT) return;
    const bool samp = t >= NP; const int sb = t - NP, pos = t % SEQ;
    const float* qrow = PC + (size_t)t * CN + h * 64;
    float lg[2]; bool valid[2];
#pragma unroll
    for (int rr = 0; rr < 2; ++rr) {
        const int r = lane + 64 * rr;
        const float* krow;
        if (!samp) { valid[rr] = (pos - r) >= 0; krow = PC + (size_t)(valid[rr] ? t - r : t) * CN + 1024 + kvh * 64; }
        else { valid[rr] = true; krow = (r == 0) ? PC + (size_t)t * CN + 1024 + kvh * 64 : cache_k + (((size_t)sb * 128 + (128 - r)) * 4 + kvh) * 64; }
        float dot = 0.f;
#pragma unroll
        for (int d4 = 0; d4 < 16; ++d4) {
            const float4 kv = *(const float4*)(krow + d4 * 4);
            const float4 qv = *(const float4*)(qrow + d4 * 4);
            dot += qv.x * kv.x + qv.y * kv.y + qv.z * kv.z + qv.w * kv.w;
        }
        lg[rr] = valid[rr] ? dot * 0.125f + rel_bias[t5_bucket(r) * 16 + h] : -INFINITY;
    }
    const float sink = sinks[h];
    const float m = fmaxf(wave_max(fmaxf(lg[0], lg[1])), sink);
    float p[2];
#pragma unroll
    for (int rr = 0; rr < 2; ++rr) p[rr] = valid[rr] ? expf(lg[rr] - m) : 0.f;
    const float den = wave_sum(p[0] + p[1]) + expf(sink - m);
    const float inv = 1.0f / den;
    float o = 0.f;
#pragma unroll
    for (int rr = 0; rr < 2; ++rr)
        for (int l2 = 0; l2 < 64; ++l2) {
            const int r = l2 + 64 * rr;
            const float pj = __shfl(p[rr], l2);
            if (pj != 0.f) {
                const float* vrow;
                if (!samp) vrow = PC + (size_t)(t - r) * CN + 1280 + kvh * 64;
                else vrow = (r == 0) ? PC + (size_t)t * CN + 1280 + kvh * 64 : cache_v + (((size_t)sb * 128 + (128 - r)) * 4 + kvh) * 64;
                o += pj * vrow[lane];
            }
        }
    ATT[(size_t)t * D + h * 64 + lane] = (bf16)f2bf(o * inv);
}

__device__ __forceinline__ void swa_kv_out(const float* __restrict__ PC, const float* __restrict__ cache_k, const float* __restrict__ cache_v,
                                           float* __restrict__ pk, float* __restrict__ pv, float* __restrict__ sk, float* __restrict__ sv, int vb) {
    const int c = threadIdx.x & 255, row = vb * 2 + (threadIdx.x >> 8);
    if (row < NB * 128) {
        const int b = row >> 7, i = row & 127;
        const float* src = PC + (size_t)(b * SEQ + SEQ - 128 + i) * CN;
        pk[(size_t)row * 256 + c] = src[1024 + c];
        pv[(size_t)row * 256 + c] = src[1280 + c];
    } else {
        const int r2 = row - NB * 128, sb = r2 >> 7, i = r2 & 127;
        if (i < 127) {
            sk[(size_t)r2 * 256 + c] = cache_k[((size_t)sb * 128 + i + 1) * 256 + c];
            sv[(size_t)r2 * 256 + c] = cache_v[((size_t)sb * 128 + i + 1) * 256 + c];
        } else {
            const float* src = PC + (size_t)(NP + sb) * CN;
            sk[(size_t)r2 * 256 + c] = src[1024 + c];
            sv[(size_t)r2 * 256 + c] = src[1280 + c];
        }
    }
}
#define XB_TMO      128
#define XB_XCNT(j)  (256  + 64 * (j))
#define XB_XSUB(j)  (1280 + 64 * (j))
#define XB_XGEN(j)  (2304 + 64 * (j))
#define XB_TOP      3328
#define XB_TOPGEN   3392
#define XCD_BAR_WORDS 3456
#define XB_SPIN_CAP (1u << 18)

__device__ __forceinline__ unsigned xb_ld(unsigned* p)              { return __hip_atomic_load(p, __ATOMIC_RELAXED, __HIP_MEMORY_SCOPE_AGENT); }
__device__ __forceinline__ unsigned xb_add(unsigned* p, unsigned v) { return __hip_atomic_fetch_add(p, v, __ATOMIC_RELAXED, __HIP_MEMORY_SCOPE_AGENT); }
__device__ __forceinline__ unsigned xb_xcc_id() { return (unsigned)__builtin_amdgcn_s_getreg((3 << 11) | 20) & 0xFu; }
#define XB_SPIN(cond, bar) do { unsigned _sp = 0; while (cond) { __builtin_amdgcn_s_sleep(1); \
    if ((++_sp & 255u) == 0u) { if (xb_ld(&(bar)[XB_TMO])) break; if (_sp > XB_SPIN_CAP) { atomicAdd(&(bar)[XB_TMO], 1u); break; } } } } while (0)

struct XcdBarrier {
    unsigned* bar; unsigned x;
    volatile LAS unsigned* st;
};

__device__ __forceinline__ XcdBarrier xcd_barrier_post(unsigned* bar, volatile LAS unsigned* st) {
    XcdBarrier b; b.bar = bar; b.x = xb_xcc_id(); b.st = st;
    if (threadIdx.x == 0) (void)xb_add(&bar[XB_XCNT(b.x)], 1u);
    return b;
}
__device__ __forceinline__ void xcd_barrier_complete(unsigned* bar, unsigned x, unsigned& nloc, unsigned& nx) {
    const unsigned G = gridDim.x * gridDim.y * gridDim.z;
    unsigned sum, cnt, mine, sp = 0u;
    for (;;) {
        sum = 0u; cnt = 0u; mine = 0u;
#pragma unroll
        for (unsigned j = 0; j < 16; ++j) { const unsigned c = xb_ld(&bar[XB_XCNT(j)]); sum += c; cnt += (c > 0u) ? 1u : 0u; mine = (j == x) ? c : mine; }
        if (sum == G) break;
        __builtin_amdgcn_s_sleep(1);
        if ((++sp & 255u) == 0u) { if (xb_ld(&bar[XB_TMO])) break; if (sp > XB_SPIN_CAP) { atomicAdd(&bar[XB_TMO], 1u); break; } }
    }
    nloc = mine > 0u ? mine : 1u; nx = cnt > 0u ? cnt : 1u;
}

__device__ __forceinline__ void xcd_barrier(const XcdBarrier& b) {
    asm volatile("s_waitcnt vmcnt(0)" ::: "memory");
    __syncthreads();
    if (threadIdx.x == 0) {
        unsigned* bar = b.bar;
        __builtin_amdgcn_s_waitcnt(0);
        unsigned nloc = b.st[0], nx = b.st[1];
        if (nloc == 0u) { xcd_barrier_complete(bar, b.x, nloc, nx); b.st[0] = nloc; b.st[1] = nx; }
        const unsigned old = xb_add(&bar[XB_XSUB(b.x)], 1u);
        const unsigned gen = old / nloc;
        if (old + 1u == (gen + 1u) * nloc) {
            __builtin_amdgcn_fence(__ATOMIC_RELEASE, "agent");
            asm volatile("s_waitcnt vmcnt(0)" ::: "memory");
            const unsigned og = xb_add(&bar[XB_TOP], 1u);
            const unsigned tg = og / nx;
            if (og + 1u == (tg + 1u) * nx) xb_add(&bar[XB_TOPGEN], 1u);
            else XB_SPIN(xb_ld(&bar[XB_TOPGEN]) == tg, bar);
            __builtin_amdgcn_fence(__ATOMIC_ACQUIRE, "agent");
            xb_add(&bar[XB_XGEN(b.x)], 1u);
            asm volatile("s_waitcnt vmcnt(0)" ::: "memory");
        } else {
            XB_SPIN(xb_ld(&bar[XB_XGEN(b.x)]) == gen, bar);
            __builtin_amdgcn_fence(__ATOMIC_ACQUIRE, "agent");
            asm volatile("s_waitcnt vmcnt(0)" ::: "memory");
        }
    }
    __syncthreads();
}

typedef short bf16x8_t __attribute__((ext_vector_type(8)));
__device__ __forceinline__ f32x4 mfma16(bf16x8_t a, bf16x8_t b, f32x4 c) { return __builtin_amdgcn_mfma_f32_16x16x32_bf16(a, b, c, 0, 0, 0); }

struct GdnChunkBufs {
    bf16* W;
    bf16* QG;
    bf16* KDT;
    bf16* UT;
    bf16* QK;
    float* EGL;
};

constexpr int GP_QB = 0, GP_KB = 17408, GP_VB = 34816, GP_LS = 52224, GP_QKS = 69632, GP_WS = 78848, GP_SC = 96256;

__device__ __forceinline__ void gdn_prep_unit(const bf16* __restrict__ PROJ, const float* __restrict__ conv_w, const float* __restrict__ a_log, const float* __restrict__ dt_bias,
                                              const GdnChunkBufs& cb, float* __restrict__ p_gdn_conv, int un, unsigned char* lds) {
    int tid = threadIdx.x; asm volatile("" : "+v"(tid));
    const int lane = tid & 63, wave = __builtin_amdgcn_readfirstlane(tid >> 6), fr = lane & 15, fq = lane >> 4;
    const int h = un & 3, n = (un >> 2) & 63, b = un >> 8;
    const int t0 = b * SEQ + n * 64;
    bf16* Qb = (bf16*)(lds + GP_QB); bf16* Kb = (bf16*)(lds + GP_KB); bf16* Vb = (bf16*)(lds + GP_VB); bf16* Ws = (bf16*)(lds + GP_WS);
    float* Ls = (float*)(lds + GP_LS); bf16* QKs = (bf16*)(lds + GP_QKS);
    float* gcs = (float*)(lds + GP_SC); float* bets = gcs + 64; float* egcs = gcs + 128; float* ekds = gcs + 192; float* begs = gcs + 256;
    if (wave == 0) {
        const bf16* prow = PROJ + (size_t)(t0 + lane) * ABN;
        const float a_raw = bf2f(prow[C_A + h]), b_raw = bf2f(prow[C_B + h]);
        float g = -expf(a_log[h]) * softplusf_(a_raw + dt_bias[h]);
#pragma unroll
        for (int off = 1; off < 64; off <<= 1) { const float v = __shfl_up(g, off); if (lane >= off) g += v; }
        const float glast = __shfl(g, 63);
        { const float be_ = sigmoidf_(b_raw), eg_ = expf(g); gcs[lane] = g; bets[lane] = be_; egcs[lane] = eg_; ekds[lane] = expf(glast - g); begs[lane] = be_ * eg_; }
        if (lane == 0) cb.EGL[un] = expf(glast);
    }
    {
        int cols[6]; float cw[4][6], xw[3][6];
#pragma unroll
        for (int p = 0; p < 3; ++p)
#pragma unroll
            for (int e = 0; e < 2; ++e) cols[p * 2 + e] = p * 512 + h * 128 + e * 64 + lane;
#pragma unroll
        for (int i = 0; i < 4; ++i)
#pragma unroll
            for (int c = 0; c < 6; ++c) cw[i][c] = conv_w[i * 1536 + cols[c]];
        const int i0 = wave * 8;
#pragma unroll
        for (int k = 0; k < 3; ++k) {
            const int pos = n * 64 + i0 - 3 + k;
#pragma unroll
            for (int c = 0; c < 6; ++c) xw[k][c] = pos >= 0 ? bf2f(PROJ[(size_t)(t0 + i0 - 3 + k) * ABN + cols[c]]) : 0.f;
        }
        bf16 xraw[8][6];
#pragma unroll
        for (int ii = 0; ii < 8; ++ii)
#pragma unroll
            for (int c = 0; c < 6; ++c) xraw[ii][c] = PROJ[(size_t)(t0 + i0 + ii) * ABN + cols[c]];
#pragma unroll
        for (int ii = 0; ii < 8; ++ii) {
            const int i = i0 + ii;
            float xt[6], s[6];
#pragma unroll
            for (int c = 0; c < 6; ++c) xt[c] = bf2f(xraw[ii][c]);
#pragma unroll
            for (int c = 0; c < 6; ++c) { const float y_ = cw[0][c] * xw[0][c] + cw[1][c] * xw[1][c] + cw[2][c] * xw[2][c] + cw[3][c] * xt[c]; s[c] = y_ * __frcp_rn(1.0f + __expf(-y_)); }
            const float qs = rsqrtf(wave_sum(s[0] * s[0] + s[1] * s[1]) + 1e-6f) * 0.08838834764831845f;
            const float ks = rsqrtf(wave_sum(s[2] * s[2] + s[3] * s[3]) + 1e-6f);
            Qb[i * 136 + lane] = (bf16)f2bf(s[0] * qs); Qb[i * 136 + 64 + lane] = (bf16)f2bf(s[1] * qs);
            Kb[i * 136 + lane] = (bf16)f2bf(s[2] * ks); Kb[i * 136 + 64 + lane] = (bf16)f2bf(s[3] * ks);
            Vb[i * 136 + lane] = (bf16)f2bf(s[4]);      Vb[i * 136 + 64 + lane] = (bf16)f2bf(s[5]);
            if (n == 63 && i >= 61) {
#pragma unroll
                for (int c = 0; c < 6; ++c) p_gdn_conv[((size_t)b * 3 + (i - 61)) * 1536 + cols[c]] = xt[c];
            }
#pragma unroll
            for (int c = 0; c < 6; ++c) { xw[0][c] = xw[1][c]; xw[1][c] = xw[2][c]; xw[2][c] = xt[c]; }
        }
    }
    __syncthreads();
    {
        const int mi = wave >> 1;
        bf16x8_t aK[4], aQ[4];
#pragma unroll
        for (int ks = 0; ks < 4; ++ks) { aK[ks] = *(const bf16x8_t*)(Kb + (mi * 16 + fr) * 136 + ks * 32 + 8 * fq); aQ[ks] = *(const bf16x8_t*)(Qb + (mi * 16 + fr) * 136 + ks * 32 + 8 * fq); }
#pragma unroll
        for (int nn = 0; nn < 2; ++nn) {
            const int nj = (wave & 1) * 2 + nn;
            f32x4 accK = (f32x4){0.f, 0.f, 0.f, 0.f}, accQ = accK;
#pragma unroll
            for (int ks = 0; ks < 4; ++ks) { const bf16x8_t bk = *(const bf16x8_t*)(Kb + (nj * 16 + fr) * 136 + ks * 32 + 8 * fq); accK = mfma16(aK[ks], bk, accK); accQ = mfma16(aQ[ks], bk, accQ); }
            const int j = nj * 16 + fr; const float gj = gcs[j];
#pragma unroll
            for (int r = 0; r < 4; ++r) {
                const int i = mi * 16 + 4 * fq + r;
                const float dec = i >= j ? expf(gcs[i] - gj) : 0.f;
                Ls[j * 68 + i] = i > j ? bets[i] * accK[r] * dec : 0.f;
                QKs[i * 72 + j] = (bf16)f2bf(i >= j ? accQ[r] * dec : 0.f);
            }
        }
    }
    __syncthreads();
    if (wave < 4) {
        float x[64];
        const bool isu = tid < 128; const int c = isu ? tid : tid - 128;
        const LAS unsigned char* l3 = (const LAS unsigned char*)lds;
        unsigned so = (isu ? GP_VB : GP_KB) + c * 2, ro = GP_SC + (isu ? 64 * 4 : 256 * 4), lo = GP_LS;
        asm volatile("" : "+v"(so), "+v"(ro), "+v"(lo));
#pragma unroll
        for (int i = 0; i < 64; ++i) x[i] = *(const LAS float*)(l3 + ro + 4 * i) * bf2f(*(const LAS bf16*)(l3 + so + i * 272));
#pragma unroll
        for (int j = 0; j < 63; ++j) {
#pragma unroll
            for (int i4 = (j + 1) / 4; i4 < 16; ++i4) {
                const f32x4 l4 = *(const LAS f32x4*)(l3 + lo + j * 272 + i4 * 16);
                if (i4 * 4 + 0 > j) x[i4 * 4 + 0] -= l4.x * x[j];
                if (i4 * 4 + 1 > j) x[i4 * 4 + 1] -= l4.y * x[j];
                if (i4 * 4 + 2 > j) x[i4 * 4 + 2] -= l4.z * x[j];
                if (i4 * 4 + 3 > j) x[i4 * 4 + 3] -= l4.w * x[j];
            }
        }
        if (isu) {
            bf16* dst = cb.UT + ((size_t)un * 128 + c) * 64;
#pragma unroll
            for (int i8 = 0; i8 < 8; ++i8) { v4u o; o.x = pk2(x[i8 * 8 + 0], x[i8 * 8 + 1]); o.y = pk2(x[i8 * 8 + 2], x[i8 * 8 + 3]); o.z = pk2(x[i8 * 8 + 4], x[i8 * 8 + 5]); o.w = pk2(x[i8 * 8 + 6], x[i8 * 8 + 7]); *(v4u*)(dst + i8 * 8) = o; }
        } else {
#pragma unroll
            for (int i = 0; i < 64; ++i) Ws[i * 136 + c] = (bf16)f2bf(x[i]);
        }
    } else {
        const int t2 = tid - 256;
#pragma unroll
        for (int k = 0; k < 4; ++k) {
            const int ci = t2 + 256 * k, i = ci >> 4, d0 = (ci & 15) * 8; const float e = egcs[i];
            const v4u q = *(const v4u*)(Qb + i * 136 + d0);
            v4u o; o.x = pk2(bflo(q.x) * e, bfhi(q.x) * e); o.y = pk2(bflo(q.y) * e, bfhi(q.y) * e); o.z = pk2(bflo(q.z) * e, bfhi(q.z) * e); o.w = pk2(bflo(q.w) * e, bfhi(q.w) * e);
            *(v4u*)(cb.QG + ((size_t)un * 64 + i) * 128 + d0) = o;
        }
#pragma unroll
        for (int k = 0; k < 4; ++k) {
            const int ci = t2 + 256 * k, d = ci & 127, i0 = (ci >> 7) * 8;
            float v[8];
#pragma unroll
            for (int q = 0; q < 8; ++q) v[q] = bf2f(Kb[(i0 + q) * 136 + d]) * ekds[i0 + q];
            v4u o; o.x = pk2(v[0], v[1]); o.y = pk2(v[2], v[3]); o.z = pk2(v[4], v[5]); o.w = pk2(v[6], v[7]);
            *(v4u*)(cb.KDT + ((size_t)un * 128 + d) * 64 + i0) = o;
        }
#pragma unroll
        for (int k = 0; k < 2; ++k) {
            const int ci = t2 + 256 * k, i = ci >> 3, j0 = (ci & 7) * 8;
            *(v4u*)(cb.QK + ((size_t)un * 64 + i) * 64 + j0) = *(const v4u*)(QKs + i * 72 + j0);
        }
    }
    __syncthreads();
#pragma unroll
    for (int k = 0; k < 2; ++k) {
        const int ci = tid + 512 * k, i = ci >> 4, d0 = (ci & 15) * 8;
        *(v4u*)(cb.W + ((size_t)un * 64 + i) * 128 + d0) = *(const v4u*)(Ws + i * 136 + d0);
    }
    __syncthreads();
}

constexpr int GS_ST = 0, GS_VNT = 2 * 32 * 136 * 2, GS_END = GS_VNT + 32 * 72 * 2;
template <int N0, int N1>
__device__ __forceinline__ void gdn_seq(const GdnChunkBufs& cb, float* __restrict__ O, float* __restrict__ Sout, int b, int h, int sl, unsigned char* lds, f32x4 (&accS)[2], int& cur) {
    int tid = threadIdx.x; asm volatile("" : "+v"(tid));
    const int lane = tid & 63, wave = __builtin_amdgcn_readfirstlane(tid >> 6), fr = lane & 15, fq = lane >> 4;
    const int mi = wave >> 1, nj = wave & 1;
    bf16* St = (bf16*)(lds + GS_ST); bf16* VnT = (bf16*)(lds + GS_VNT);
    float* egls = (float*)(lds + GS_END);
    if (N0 == 0) {
        for (int i = tid; i < 2 * 32 * 136 / 2; i += NTH) ((unsigned*)St)[i] = 0u;
        accS[0] = (f32x4){0.f, 0.f, 0.f, 0.f}; accS[1] = accS[0]; cur = 0;
    }
    if (tid >= N0 && tid < N1) egls[tid] = cb.EGL[(size_t)((b * 64 + tid) * 4 + h)];
    __syncthreads();
#define GS_DECL(X) bf16x8_t aW##X[4], aQG##X[4], aQK##X[2], aKD##X[2]; v2u ut##X;
    GS_DECL(0) GS_DECL(1) GS_DECL(2)
#define GS_GLD16(dst, ptr) asm volatile("global_load_dwordx4 %0, %1, off" : "=v"(dst) : "v"(ptr))
#define GS_GLD8(dst, ptr) asm volatile("global_load_dwordx2 %0, %1, off" : "=v"(dst) : "v"(ptr))
#define GS_LOAD(X, n_) do { const size_t u_ = (size_t)((b * 64 + ((n_) < 63 ? (n_) : 63)) * 4 + h);     \
        _Pragma("unroll") for (int ks = 0; ks < 4; ++ks) { GS_GLD16(aW##X[ks], cb.W + (u_ * 64 + mi * 16 + fr) * 128 + ks * 32 + 8 * fq); GS_GLD16(aQG##X[ks], cb.QG + (u_ * 64 + mi * 16 + fr) * 128 + ks * 32 + 8 * fq); } \
        _Pragma("unroll") for (int ks = 0; ks < 2; ++ks) { GS_GLD16(aQK##X[ks], cb.QK + (u_ * 64 + mi * 16 + fr) * 64 + ks * 32 + 8 * fq); GS_GLD16(aKD##X[ks], cb.KDT + (u_ * 128 + wave * 16 + fr) * 64 + ks * 32 + 8 * fq); } \
        GS_GLD8(ut##X, cb.UT + (u_ * 128 + sl * 32 + nj * 16 + fr) * 64 + mi * 16 + 4 * fq); } while (0)
#define GS_WAITN(X, N) asm volatile("s_waitcnt vmcnt(" #N ")" : "+v"(aW##X[0]), "+v"(aW##X[1]), "+v"(aW##X[2]), "+v"(aW##X[3]), "+v"(aQG##X[0]), "+v"(aQG##X[1]), "+v"(aQG##X[2]), "+v"(aQG##X[3]), \
        "+v"(aQK##X[0]), "+v"(aQK##X[1]), "+v"(aKD##X[0]), "+v"(aKD##X[1]), "+v"(ut##X))
#define GS_WAIT(X, n_) GS_WAITN(X, 26)
#define GS_STEP(X, n_) do { \
        const float egl##X = egls[(n_)]; \
        GS_WAIT(X, n_); \
        __syncthreads();                                        \
        f32x4 accW = (f32x4){0.f, 0.f, 0.f, 0.f}, accO = accW; \
        const bf16* Sc = St + cur * 32 * 136; \
        _Pragma("unroll") for (int ks = 0; ks < 4; ++ks) { const bf16x8_t bs = *(const bf16x8_t*)(Sc + (nj * 16 + fr) * 136 + ks * 32 + 8 * fq); accW = mfma16(aW##X[ks], bs, accW); accO = mfma16(aQG##X[ks], bs, accO); } \
          \
        const float v0 = bflo(ut##X.x) - accW[0], v1 = bfhi(ut##X.x) - accW[1], v2 = bflo(ut##X.y) - accW[2], v3 = bfhi(ut##X.y) - accW[3]; \
        { v2u o; o.x = pk2(v0, v1); o.y = pk2(v2, v3); *(v2u*)(VnT + (nj * 16 + fr) * 72 + mi * 16 + 4 * fq) = o; } \
        __syncthreads();                                        \
        _Pragma("unroll") for (int ks = 0; ks < 2; ++ks) { const bf16x8_t bv = *(const bf16x8_t*)(VnT + (nj * 16 + fr) * 72 + ks * 32 + 8 * fq); accO = mfma16(aQK##X[ks], bv, accO); } \
        { float* orow = O + (size_t)(b * SEQ + (n_) * 64 + mi * 16 + 4 * fq) * 512 + h * 128 + sl * 32 + nj * 16 + fr; \
          orow[0] = accO[0]; orow[512] = accO[1]; orow[1024] = accO[2]; orow[1536] = accO[3]; } \
          \
        bf16* Sn = St + (cur ^ 1) * 32 * 136; \
        _Pragma("unroll") for (int njj = 0; njj < 2; ++njj) { \
            accS[njj] = accS[njj] * egl##X; \
            _Pragma("unroll") for (int ks = 0; ks < 2; ++ks) { const bf16x8_t bv = *(const bf16x8_t*)(VnT + (njj * 16 + fr) * 72 + ks * 32 + 8 * fq); accS[njj] = mfma16(aKD##X[ks], bv, accS[njj]); } \
            v2u o; o.x = pk2(accS[njj][0], accS[njj][1]); o.y = pk2(accS[njj][2], accS[njj][3]); \
            *(v2u*)(Sn + (njj * 16 + fr) * 136 + wave * 16 + 4 * fq) = o; } \
        cur ^= 1; } while (0)
    constexpr int NTRI = (N1 - N0) / 3, NREM = (N1 - N0) % 3, NM = N0 + 3 * NTRI;
    GS_LOAD(0, N0); GS_LOAD(1, N0 + 1);
#pragma unroll 1
    for (int n = N0; n < NM; n += 3) {
        GS_LOAD(2, n + 2);
        GS_STEP(0, n);
        GS_LOAD(0, n + 3);
        GS_STEP(1, n + 1);
        GS_LOAD(1, n + 4);
        GS_STEP(2, n + 2);
    }
    if (NREM >= 1) { GS_LOAD(2, NM + 2); GS_STEP(0, NM); }
    if (NREM == 2) { GS_LOAD(0, NM + 3); GS_STEP(1, NM + 1); }
    GS_WAITN(0, 0); GS_WAITN(1, 0); GS_WAITN(2, 0);
#undef GS_STEP
#undef GS_DECL
#undef GS_WAIT
#undef GS_WAITN
#undef GS_GLD16
#undef GS_GLD8
    asm volatile("s_waitcnt vmcnt(0)" ::: "memory");
#undef GS_LOAD
    if (N1 == 64) {
#pragma unroll
        for (int njj = 0; njj < 2; ++njj)
#pragma unroll
            for (int r = 0; r < 4; ++r) Sout[(((size_t)b * 4 + h) * 128 + wave * 16 + 4 * fq + r) * 128 + sl * 32 + njj * 16 + fr] = accS[njj][r];
    }
    __syncthreads();
}

__device__ __forceinline__ void lru_prep_unit(const bf16* __restrict__ PROJ, const float* __restrict__ conv_w, const float* __restrict__ conv_b,
                                              const float* __restrict__ w_r, const float* __restrict__ b_r, const float* __restrict__ w_i, const float* __restrict__ b_i, const float* __restrict__ lam,
                                              float* __restrict__ H, float* __restrict__ P, float* __restrict__ Hend, float* __restrict__ Pend, float* __restrict__ p_lru_conv, int ub) {
    int c = threadIdx.x; asm volatile("" : "+v"(c));
    const int nblk = c >> 6, d = c & 63;
    const int n = ub & 63, b = ub >> 6, t0 = b * SEQ + n * 64;
    float wr[64], wi[64];
#pragma unroll
    for (int cc = 0; cc < 64; ++cc) { wr[cc] = w_r[((size_t)nblk * 64 + cc) * 64 + d]; wi[cc] = w_i[((size_t)nblk * 64 + cc) * 64 + d]; }
    const float cw0 = conv_w[c], cw1 = conv_w[512 + c], cw2 = conv_w[1024 + c], cw3 = conv_w[1536 + c], cb_ = conv_b[c];
    const float br = b_r[c], bi = b_i[c], spl = -8.0f * softplusf_(-lam[c]);
    float x0 = (n * 64 - 3 >= 0) ? bf2f(PROJ[(size_t)(t0 - 3) * ABN + C_XR + c]) : 0.f;
    float x1 = (n * 64 - 2 >= 0) ? bf2f(PROJ[(size_t)(t0 - 2) * ABN + C_XR + c]) : 0.f;
    float x2 = (n * 64 - 1 >= 0) ? bf2f(PROJ[(size_t)(t0 - 1) * ABN + C_XR + c]) : 0.f;
    float hloc = 0.f, ploc = 1.f;
    bf16 xa[16], xb[16];
#pragma unroll
    for (int k = 0; k < 16; ++k) xa[k] = PROJ[(size_t)(t0 + k) * ABN + C_XR + c];
#pragma unroll 1
    for (int ib = 0; ib < 64; ib += 16) {
      if (ib + 16 < 64) {
#pragma unroll
        for (int k = 0; k < 16; ++k) xb[k] = PROJ[(size_t)(t0 + ib + 16 + k) * ABN + C_XR + c];
      }
#pragma unroll
      for (int k = 0; k < 16; ++k) {
        const int i = ib + k;
        const float xt = bf2f(xa[k]);
        const float xr = cb_ + cw0 * x0 + cw1 * x1 + cw2 * x2 + cw3 * xt;
        f32x2_t ga = (f32x2_t){br, bi}, gb = (f32x2_t){0.f, 0.f};
#pragma unroll
        for (int cc = 0; cc < 64; cc += 2) {
            const float xa_ = __uint_as_float(__builtin_amdgcn_readlane(__float_as_uint(xr), cc)), xb_ = __uint_as_float(__builtin_amdgcn_readlane(__float_as_uint(xr), cc + 1));
            ga += (f32x2_t){xa_, xa_} * (f32x2_t){wr[cc], wi[cc]}; gb += (f32x2_t){xb_, xb_} * (f32x2_t){wr[cc + 1], wi[cc + 1]};
        }
        ga += gb;
        const float r = __frcp_rn(1.0f + __expf(-ga.x)), ii = __frcp_rn(1.0f + __expf(-ga.y));
        const float a = __expf(spl * r), bb = __fsqrt_rn(fmaxf(1.0f - a * a, 0.f)) * (ii * xr);
        hloc = a * hloc + bb; ploc *= a;
        H[(size_t)(t0 + i) * 512 + c] = hloc; P[(size_t)(t0 + i) * 512 + c] = ploc;
        if (n == 63 && i >= 61) p_lru_conv[((size_t)b * 3 + (i - 61)) * 512 + c] = xt;
        x0 = x1; x1 = x2; x2 = xt;
      }
#pragma unroll
      for (int k = 0; k < 16; ++k) xa[k] = xb[k];
    }
    Hend[(size_t)ub * 512 + c] = hloc; Pend[(size_t)ub * 512 + c] = ploc;
}
constexpr int LR_XR = 64 * 68 * 4;
__device__ __forceinline__ void lru_prep_unit2(const bf16* __restrict__ PROJ, const float* __restrict__ conv_w, const float* __restrict__ conv_b,
                                               const bf16* __restrict__ WRT, const bf16* __restrict__ WIT  , const float* __restrict__ b_r, const float* __restrict__ b_i, const float* __restrict__ lam,
                                               float* __restrict__ H, float* __restrict__ P, float* __restrict__ Hend, float* __restrict__ Pend, float* __restrict__ p_lru_conv, int ub, unsigned char* lds) {
    int tid = threadIdx.x; asm volatile("" : "+v"(tid));
    const int lane = tid & 63, wave = __builtin_amdgcn_readfirstlane(tid >> 6), fr = lane & 15, fq = lane >> 4;
    const int n = ub & 63, b = ub >> 6, t0 = b * SEQ + n * 64;
    float* XR = (float*)(lds + wave * LR_XR);
    {
        const int c = wave * 64 + lane;
        const float cw0 = conv_w[c], cw1 = conv_w[512 + c], cw2 = conv_w[1024 + c], cw3 = conv_w[1536 + c], cb_ = conv_b[c];
        float x0 = (n * 64 - 3 >= 0) ? bf2f(PROJ[(size_t)(t0 - 3) * ABN + C_XR + c]) : 0.f;
        float x1 = (n * 64 - 2 >= 0) ? bf2f(PROJ[(size_t)(t0 - 2) * ABN + C_XR + c]) : 0.f;
        float x2 = (n * 64 - 1 >= 0) ? bf2f(PROJ[(size_t)(t0 - 1) * ABN + C_XR + c]) : 0.f;
#pragma unroll 1
        for (int ib = 0; ib < 64; ib += 16) {
            bf16 xa[16];
#pragma unroll
            for (int k = 0; k < 16; ++k) xa[k] = PROJ[(size_t)(t0 + ib + k) * ABN + C_XR + c];
#pragma unroll
            for (int k = 0; k < 16; ++k) {
                const int i = ib + k; const float xt = bf2f(xa[k]);
                XR[i * 68 + lane] = cb_ + cw0 * x0 + cw1 * x1 + cw2 * x2 + cw3 * xt;
                if (n == 63 && i >= 61) p_lru_conv[((size_t)b * 3 + (i - 61)) * 512 + c] = xt;
                x0 = x1; x1 = x2; x2 = xt;
            }
        }
    }
    asm volatile("s_waitcnt lgkmcnt(0)" ::: "memory");
    bf16x8_t bR[4][2], bI[4][2];
#pragma unroll
    for (int nt = 0; nt < 4; ++nt)
#pragma unroll
        for (int ks = 0; ks < 2; ++ks) {
            bR[nt][ks] = *(const bf16x8_t*)(WRT + ((size_t)wave * 64 + nt * 16 + fr) * 64 + ks * 32 + 8 * fq);
            bI[nt][ks] = *(const bf16x8_t*)(WIT + ((size_t)wave * 64 + nt * 16 + fr) * 64 + ks * 32 + 8 * fq);
        }
    float brv[4], biv[4], splv[4];
#pragma unroll
    for (int nt = 0; nt < 4; ++nt) { const int c = wave * 64 + nt * 16 + fr; brv[nt] = b_r[c]; biv[nt] = b_i[c]; splv[nt] = -8.0f * softplusf_(-lam[c]); }
    float hin[4], pin[4];
#pragma unroll
    for (int nt = 0; nt < 4; ++nt) { hin[nt] = 0.f; pin[nt] = 1.f; }
#pragma unroll 1
    for (int mt = 0; mt < 4; ++mt) {
        bf16x8_t aX[2];
#pragma unroll
        for (int ks = 0; ks < 2; ++ks) {
            const f32x4 lo = *(const f32x4*)(XR + (mt * 16 + fr) * 68 + ks * 32 + 8 * fq), hi = *(const f32x4*)(XR + (mt * 16 + fr) * 68 + ks * 32 + 8 * fq + 4);
            v4u w; w.x = pk2(lo.x, lo.y); w.y = pk2(lo.z, lo.w); w.z = pk2(hi.x, hi.y); w.w = pk2(hi.z, hi.w);
            aX[ks] = __builtin_bit_cast(bf16x8_t, w);
        }
#pragma unroll
        for (int nt = 0; nt < 4; ++nt) {
            f32x4 aR = (f32x4){0.f, 0.f, 0.f, 0.f}, aI = aR;
            aR = mfma16(aX[0], bR[nt][0], aR); aR = mfma16(aX[1], bR[nt][1], aR);
            aI = mfma16(aX[0], bI[nt][0], aI); aI = mfma16(aX[1], bI[nt][1], aI);
            float av[4], bv[4];
#pragma unroll
            for (int r = 0; r < 4; ++r) {
                const float rg = __frcp_rn(1.0f + __expf(-(aR[r] + brv[nt]))), ig = __frcp_rn(1.0f + __expf(-(aI[r] + biv[nt])));
                const float a = __expf(splv[nt] * rg);
                av[r] = a; bv[r] = __fsqrt_rn(fmaxf(1.0f - a * a, 0.f)) * (ig * XR[(mt * 16 + 4 * fq + r) * 68 + nt * 16 + fr]);
            }
            float PA[4], PB[4];
            PA[0] = av[0]; PB[0] = bv[0];
#pragma unroll
            for (int r = 1; r < 4; ++r) { PA[r] = av[r] * PA[r - 1]; PB[r] = av[r] * PB[r - 1] + bv[r]; }
            float GA = PA[3], GB = PB[3];
            { const float pa = __shfl_up(GA, 16), pb = __shfl_up(GB, 16); if (fq >= 1) { GB = GA * pb + GB; GA = GA * pa; } }
            { const float pa = __shfl_up(GA, 32), pb = __shfl_up(GB, 32); if (fq >= 2) { GB = GA * pb + GB; GA = GA * pa; } }
            float EA = __shfl_up(GA, 16), EB = __shfl_up(GB, 16);
            if (fq == 0) { EA = 1.f; EB = 0.f; }
            const float h0 = EA * hin[nt] + EB, p0 = pin[nt] * EA;
#pragma unroll
            for (int r = 0; r < 4; ++r) {
                const size_t o = (size_t)(t0 + mt * 16 + 4 * fq + r) * 512 + wave * 64 + nt * 16 + fr;
                H[o] = PA[r] * h0 + PB[r]; P[o] = p0 * PA[r];
            }
            const float TA = __shfl(GA, 48 + fr), TB = __shfl(GB, 48 + fr);
            hin[nt] = TA * hin[nt] + TB; pin[nt] = pin[nt] * TA;
        }
    }
    if (fq == 0) {
#pragma unroll
        for (int nt = 0; nt < 4; ++nt) { Hend[(size_t)ub * 512 + wave * 64 + nt * 16 + fr] = hin[nt]; Pend[(size_t)ub * 512 + wave * 64 + nt * 16 + fr] = pin[nt]; }
    }
    asm volatile("s_waitcnt lgkmcnt(0)" ::: "memory");
}
__device__ __forceinline__ void lru_carry(const float* __restrict__ Hend, const float* __restrict__ Pend, float* __restrict__ CIN, float* __restrict__ hlast, int bx) {
    int tx_ = threadIdx.x; asm volatile("" : "+v"(tx_));
    const int idx = bx * NTH + tx_, b = idx >> 9, c = idx & 511;
    float carry = 0.f;
#pragma unroll 8
    for (int n = 0; n < 64; ++n) {
        const size_t o = ((size_t)b * 64 + n) * 512 + c;
        CIN[o] = carry;
        carry = Hend[o] + Pend[o] * carry;
    }
    hlast[(size_t)b * 512 + c] = carry;
}

__device__ __forceinline__ unsigned f2key(float f) { const unsigned u = __float_as_uint(f); return u ^ ((u >> 31) ? 0xffffffffu : 0x80000000u); }
__device__ __forceinline__ float key2f(unsigned k) { return __uint_as_float(k ^ ((k >> 31) ? 0x80000000u : 0xffffffffu)); }
#define TK_CE(hi, lo) do { const unsigned a_ = (hi), b_ = (lo); (hi) = a_ > b_ ? a_ : b_; (lo) = a_ > b_ ? b_ : a_; } while (0)
template <int N> __device__ __forceinline__ void bitonic_sort_desc(unsigned (&a)[N]) {
#pragma unroll
    for (int k = 2; k <= N; k <<= 1)
#pragma unroll
        for (int j = k >> 1; j > 0; j >>= 1)
#pragma unroll
            for (int i = 0; i < N; ++i) { const int l = i ^ j; if (l > i) { if ((i & k) == 0) TK_CE(a[i], a[l]); else TK_CE(a[l], a[i]); } }
}
template <int XM> __device__ __forceinline__ void merge_top16(unsigned (&a)[16]) {
    unsigned c[16];
#pragma unroll
    for (int i = 0; i < 16; ++i) { const unsigned o = (unsigned)__shfl_xor((int)a[15 - i], XM); c[i] = a[i] > o ? a[i] : o; }
#pragma unroll
    for (int j = 8; j > 0; j >>= 1)
#pragma unroll
        for (int i = 0; i < 16; ++i) { const int l = i ^ j; if (l > i) TK_CE(c[i], c[l]); }
#pragma unroll
    for (int i = 0; i < 16; ++i) a[i] = c[i];
}
constexpr int TK_KS = 0, TK_TS = 2 * 128 * 136 * 2, TK_END = TK_TS + 64 * 2 * 16 * 4;
__device__ __forceinline__ void peer_topk_stage_keys(const bf16* __restrict__ KB, int h, unsigned char* lds) {
    bf16* Ks = (bf16*)(lds + TK_KS);
    for (int ci = threadIdx.x; ci < 2 * 128 * 16; ci += NTH) { const int row = ci >> 4, part = ci & 15;
        *(v4u*)(Ks + row * 136 + part * 8) = *(const v4u*)(KB + ((size_t)h * 256 + row) * 128 + part * 8); }
    __syncthreads();
}
__device__ __forceinline__ void peer_topk4(const bf16* __restrict__ Q, int* __restrict__ EXP, float* __restrict__ GATE, int tile, int h, unsigned char* lds) {
    int tid = threadIdx.x; asm volatile("" : "+v"(tid));
    const int lane = tid & 63, wave = __builtin_amdgcn_readfirstlane(tid >> 6), fr = lane & 15, fq = lane >> 4;
    const bf16* Ks = (const bf16*)(lds + TK_KS); unsigned* Ts = (unsigned*)(lds + TK_TS);
    {
        const int c = wave >> 2, nt = wave & 3;
        bf16x8_t bq[4];
#pragma unroll
        for (int ks = 0; ks < 4; ++ks) bq[ks] = *(const bf16x8_t*)(Q + (size_t)(tile * 64 + nt * 16 + fr) * 2048 + h * 256 + c * 128 + ks * 32 + 8 * fq);
        unsigned a[32];
#pragma unroll
        for (int mt = 0; mt < 8; ++mt) {
            f32x4 acc = (f32x4){0.f, 0.f, 0.f, 0.f};
#pragma unroll
            for (int ks = 0; ks < 4; ++ks) { const bf16x8_t ak = *(const bf16x8_t*)(Ks + (c * 128 + mt * 16 + fr) * 136 + ks * 32 + 8 * fq); acc = mfma16(ak, bq[ks], acc); }
#pragma unroll
            for (int r = 0; r < 4; ++r) a[mt * 4 + r] = (f2key(acc[r]) & ~127u) | (unsigned)(127 - (mt * 16 + 4 * fq + r));
        }
        bitonic_sort_desc<32>(a);
        unsigned t[16];
#pragma unroll
        for (int j = 0; j < 16; ++j) t[j] = a[j];
        merge_top16<16>(t); merge_top16<32>(t);
        if (fq == 0) {
            const int tk = nt * 16 + fr;
#pragma unroll
            for (int j = 0; j < 16; ++j) Ts[(tk * 2 + c) * 16 + j] = t[j];
        }
    }
    __syncthreads();
    if (tid < 256) {
        const int tk = tid >> 2, q = tid & 3;
        const unsigned* t0 = Ts + (tk * 2 + 0) * 16; const unsigned* t1 = Ts + (tk * 2 + 1) * 16;
        unsigned a[16];
#pragma unroll
        for (int s = 0; s < 13; ++s) {
            const int e = s * 4 + q;
            int i, j;
            if (e < 16) { i = 0; j = e; } else if (e < 24) { i = 1; j = e - 16; } else if (e < 29) { i = 2; j = e - 24; } else if (e < 33) { i = 3; j = e - 29; }
            else if (e < 36) { i = 4; j = e - 33; } else if (e < 42) { i = 5 + ((e - 36) >> 1); j = (e - 36) & 1; } else { i = 8 + (e - 42); j = 0; }
            const bool ok = e < 50;
            const float sum = key2f(t0[ok ? i : 0] & ~127u) + key2f(t1[ok ? j : 0] & ~127u);
            a[s] = ok ? ((f2key(sum) & ~255u) | (unsigned)(255 - (i * 16 + j))) : 0u;
        }
        a[13] = 0u; a[14] = 0u; a[15] = 0u;
        bitonic_sort_desc<16>(a);
        merge_top16<1>(a); merge_top16<2>(a);
        float ev[16], sum = 0.f; const float m = key2f(a[0] & ~255u);
#pragma unroll
        for (int j = 0; j < 16; ++j) { ev[j] = __expf(key2f(a[j] & ~255u) - m); sum += ev[j]; }
        const float inv = 1.0f / sum;
        const size_t o = (size_t)(tile * 64 + tk) * 128 + h * 16;
#pragma unroll
        for (int j = 0; j < 16; ++j)
            if ((j >> 2) == q) {
                const int code = 255 - (int)(a[j] & 255u), i = code >> 4, jj = code & 15;
                const int n0 = 127 - (int)(t0[i] & 127u), n1 = 127 - (int)(t1[jj] & 127u);
                EXP[o + j] = n0 * 128 + n1; GATE[o + j] = ev[j] * inv;
            }
    }
    __syncthreads();
}

constexpr int AT_KS = 0, AT_VT = 192 * 72 * 2, AT_BT = AT_VT + 64 * 200 * 2, AT_PW = AT_BT + 4 * 128 * 4, AT_END = AT_PW + 8 * 32 * 72 * 2;
__device__ __forceinline__ void attn_unit(const bf16* __restrict__ PCb, const float* __restrict__ rel_bias, const float* __restrict__ sinks, bf16* __restrict__ ATT, int un, unsigned char* lds) {
    int tid = threadIdx.x; asm volatile("" : "+v"(tid));
    const int lane = tid & 63, wave = __builtin_amdgcn_readfirstlane(tid >> 6), fr = lane & 15, fq = lane >> 4;
    const int kvh = un & 3, qblk = (un >> 2) & 63, b = un >> 8;
    const int q0 = qblk * 64, tb = b * SEQ;
    bf16* Ks = (bf16*)(lds + AT_KS); bf16* Vt = (bf16*)(lds + AT_VT); float* Bt = (float*)(lds + AT_BT); bf16* Pw = (bf16*)(lds + AT_PW) + wave * 32 * 72;
#pragma unroll
    for (int k = 0; k < 3; ++k) {
        const int ci = tid + 512 * k, row = ci >> 3, part = ci & 7, kpos = q0 - 128 + row;
        v4u kv = (v4u){0u, 0u, 0u, 0u}, vv = kv;
        if (kpos >= 0) { const bf16* src = PCb + (size_t)(tb + kpos) * CN + kvh * 64 + part * 8; kv = *(const v4u*)(src + 1024); vv = *(const v4u*)(src + 1280); }
        *(v4u*)(Ks + row * 72 + part * 8) = kv;
        bf16* vd = Vt + (part * 8) * 200 + row;
        vd[0 * 200] = (bf16)(vv.x & 0xffffu); vd[1 * 200] = (bf16)(vv.x >> 16); vd[2 * 200] = (bf16)(vv.y & 0xffffu); vd[3 * 200] = (bf16)(vv.y >> 16);
        vd[4 * 200] = (bf16)(vv.z & 0xffffu); vd[5 * 200] = (bf16)(vv.z >> 16); vd[6 * 200] = (bf16)(vv.w & 0xffffu); vd[7 * 200] = (bf16)(vv.w >> 16);
    }
    Bt[tid] = rel_bias[t5_bucket(tid & 127) * 16 + kvh * 4 + (tid >> 7)];
    __syncthreads();
    const int g = wave >> 1, qs = (wave & 1) * 32, hh = kvh * 4 + g;
    bf16x8_t aQ[2][2];
#pragma unroll
    for (int mt = 0; mt < 2; ++mt)
#pragma unroll
        for (int ks = 0; ks < 2; ++ks) aQ[mt][ks] = *(const bf16x8_t*)(PCb + (size_t)(tb + q0 + qs + mt * 16 + fr) * CN + hh * 64 + ks * 32 + 8 * fq);
    f32x4 sc[2][12];
#pragma unroll
    for (int nt = 0; nt < 12; ++nt) {
        const bf16x8_t b0 = *(const bf16x8_t*)(Ks + (nt * 16 + fr) * 72 + 8 * fq), b1 = *(const bf16x8_t*)(Ks + (nt * 16 + fr) * 72 + 32 + 8 * fq);
#pragma unroll
        for (int mt = 0; mt < 2; ++mt) { f32x4 a = (f32x4){0.f, 0.f, 0.f, 0.f}; a = mfma16(aQ[mt][0], b0, a); a = mfma16(aQ[mt][1], b1, a); sc[mt][nt] = a; }
    }
    const float sink = sinks[hh];
    const float* bt = Bt + g * 128;
#pragma unroll
    for (int mt = 0; mt < 2; ++mt)
#pragma unroll
        for (int r = 0; r < 4; ++r) {
            const int qi = qs + mt * 16 + 4 * fq + r;
            float mx = sink;
#pragma unroll
            for (int nt = 0; nt < 12; ++nt) {
                const int kk = nt * 16 + fr, rel = qi + 128 - kk;
                const bool valid = rel >= 0 && rel < 128 && (q0 - 128 + kk) >= 0;
                const float lg = valid ? sc[mt][nt][r] * 0.125f + bt[valid ? rel : 0] : -INFINITY;
                sc[mt][nt][r] = lg; mx = fmaxf(mx, lg);
            }
            mx = fmaxf(mx, __shfl_xor(mx, 1)); mx = fmaxf(mx, __shfl_xor(mx, 2)); mx = fmaxf(mx, __shfl_xor(mx, 4)); mx = fmaxf(mx, __shfl_xor(mx, 8));
            float sum = 0.f;
#pragma unroll
            for (int nt = 0; nt < 12; ++nt) { const float p = __expf(sc[mt][nt][r] - mx); sc[mt][nt][r] = p; sum += p; }
            sum += __shfl_xor(sum, 1); sum += __shfl_xor(sum, 2); sum += __shfl_xor(sum, 4); sum += __shfl_xor(sum, 8);
            const float inv = 1.0f / (sum + __expf(sink - mx));
#pragma unroll
            for (int nt = 0; nt < 12; ++nt) sc[mt][nt][r] *= inv;
        }
    f32x4 oacc[2][4];
#pragma unroll
    for (int mt = 0; mt < 2; ++mt)
#pragma unroll
        for (int dt = 0; dt < 4; ++dt) oacc[mt][dt] = (f32x4){0.f, 0.f, 0.f, 0.f};
#pragma unroll
    for (int kc = 0; kc < 3; ++kc) {
#pragma unroll
        for (int mt = 0; mt < 2; ++mt)
#pragma unroll
            for (int n4 = 0; n4 < 4; ++n4)
#pragma unroll
                for (int r = 0; r < 4; ++r) Pw[(mt * 16 + 4 * fq + r) * 72 + n4 * 16 + fr] = (bf16)f2bf(sc[mt][kc * 4 + n4][r]);
        asm volatile("s_waitcnt lgkmcnt(0)" ::: "memory");
#pragma unroll
        for (int ks = 0; ks < 2; ++ks) {
            const bf16x8_t p0 = *(const bf16x8_t*)(Pw + fr * 72 + ks * 32 + 8 * fq), p1 = *(const bf16x8_t*)(Pw + (16 + fr) * 72 + ks * 32 + 8 * fq);
#pragma unroll
            for (int dt = 0; dt < 4; ++dt) {
                const bf16x8_t bv = *(const bf16x8_t*)(Vt + (dt * 16 + fr) * 200 + kc * 64 + ks * 32 + 8 * fq);
                oacc[0][dt] = mfma16(p0, bv, oacc[0][dt]); oacc[1][dt] = mfma16(p1, bv, oacc[1][dt]);
            }
        }
        asm volatile("s_waitcnt lgkmcnt(0)" ::: "memory");
    }
#pragma unroll
    for (int mt = 0; mt < 2; ++mt)
#pragma unroll
        for (int dt = 0; dt < 4; ++dt)
#pragma unroll
            for (int r = 0; r < 4; ++r) Pw[(mt * 16 + 4 * fq + r) * 72 + dt * 16 + fr] = (bf16)f2bf(oacc[mt][dt][r]);
    asm volatile("s_waitcnt lgkmcnt(0)" ::: "memory");
#pragma unroll
    for (int k = 0; k < 4; ++k) {
        const int ci = lane + 64 * k, row = ci >> 3, part = ci & 7;
        *(v4u*)(ATT + (size_t)(tb + q0 + qs + row) * D + hh * 64 + part * 8) = *(const v4u*)(Pw + row * 72 + part * 8);
    }
    __syncthreads();
}

__device__ __forceinline__ void swa_attn_sample(const bf16* __restrict__ PCb, const float* __restrict__ cache_k, const float* __restrict__ cache_v,
                                                const float* __restrict__ rel_bias, const float* __restrict__ sinks, bf16* __restrict__ ATT, int gw, int lane) {
    const int sb = gw >> 4, h = gw & 15, kvh = h >> 2, t = NP + sb;
    const bf16* qrow = PCb + (size_t)t * CN + h * 64;
    float lg[2];
#pragma unroll
    for (int rr = 0; rr < 2; ++rr) {
        const int r = lane + 64 * rr;
        float dot = 0.f;
        if (r == 0) {
            const bf16* krow = PCb + (size_t)t * CN + 1024 + kvh * 64;
            for (int d = 0; d < 64; ++d) dot += bf2f(qrow[d]) * bf2f(krow[d]);
        } else {
            const float* krow = cache_k + (((size_t)sb * 128 + (128 - r)) * 4 + kvh) * 64;
#pragma unroll
            for (int d4 = 0; d4 < 16; ++d4) { const float4 kv = *(const float4*)(krow + d4 * 4);
                dot += bf2f(qrow[d4 * 4]) * kv.x + bf2f(qrow[d4 * 4 + 1]) * kv.y + bf2f(qrow[d4 * 4 + 2]) * kv.z + bf2f(qrow[d4 * 4 + 3]) * kv.w; }
        }
        lg[rr] = dot * 0.125f + rel_bias[t5_bucket(r) * 16 + h];
    }
    const float sink = sinks[h];
    const float m = fmaxf(wave_max(fmaxf(lg[0], lg[1])), sink);
    float p[2] = {expf(lg[0] - m), expf(lg[1] - m)};
    const float inv = 1.0f / (wave_sum(p[0] + p[1]) + expf(sink - m));
    float o = 0.f;
#pragma unroll
    for (int rr = 0; rr < 2; ++rr)
        for (int l2 = 0; l2 < 64; ++l2) {
            const int r = l2 + 64 * rr;
            const float pj = __shfl(p[rr], l2);
            const float vv = (r == 0) ? bf2f(PCb[(size_t)t * CN + 1280 + kvh * 64 + lane]) : cache_v[(((size_t)sb * 128 + (128 - r)) * 4 + kvh) * 64 + lane];
            o += pj * vv;
        }
    ATT[(size_t)t * D + h * 64 + lane] = (bf16)f2bf(o * inv);
}
__device__ __forceinline__ void swa_kv_out2(const bf16* __restrict__ PCb, const float* __restrict__ cache_k, const float* __restrict__ cache_v,
                                            float* __restrict__ pk, float* __restrict__ pv, float* __restrict__ sk, float* __restrict__ sv, int vb) {
    int tx_ = threadIdx.x; asm volatile("" : "+v"(tx_));
    const int c = tx_ & 255, row = vb * 2 + (tx_ >> 8);
    if (row < NB * 128) {
        const int b = row >> 7, i = row & 127;
        const bf16* src = PCb + (size_t)(b * SEQ + SEQ - 128 + i) * CN;
        pk[(size_t)row * 256 + c] = bf2f(src[1024 + c]);
        pv[(size_t)row * 256 + c] = bf2f(src[1280 + c]);
    } else {
        const int r2 = row - NB * 128, sb = r2 >> 7, i = r2 & 127;
        if (i < 127) {
            sk[(size_t)r2 * 256 + c] = cache_k[((size_t)sb * 128 + i + 1) * 256 + c];
            sv[(size_t)r2 * 256 + c] = cache_v[((size_t)sb * 128 + i + 1) * 256 + c];
        } else {
            const bf16* src = PCb + (size_t)(NP + sb) * CN;
            sk[(size_t)r2 * 256 + c] = bf2f(src[1024 + c]);
            sv[(size_t)r2 * 256 + c] = bf2f(src[1280 + c]);
        }
    }
}

constexpr size_t MiB = 1u << 20;
constexpr size_t WS_CTL = 0, CTL_ZERO_BYTES = 64 * 1024;
constexpr size_t WS_WAB = 1 * MiB;
constexpr size_t WS_WOUT = WS_WAB + (size_t)ABNP * D * 2;
constexpr size_t WS_WQ0 = WS_WOUT + (size_t)D * D * 2;
constexpr size_t WS_WQ1 = WS_WQ0 + (size_t)2048 * D * 2;
constexpr size_t WS_WINC = WS_WQ1 + (size_t)2048 * D * 2;
constexpr size_t WS_WOUTC = WS_WINC + (size_t)CN * D * 2;
constexpr size_t WS_ABUF = WS_WOUTC + (size_t)D * D * 2;
constexpr size_t WS_P = WS_ABUF + (size_t)MP * D * 2;
constexpr size_t WS_T = WS_P + (size_t)MP * ABN * 2;
constexpr size_t WS_Q = WS_T + (size_t)4 * 16384 * D + (size_t)4 * 16384 * 4;
constexpr size_t WS_A = WS_Q + (size_t)MP * 1536 * 4;
constexpr size_t WS_B = WS_A + (size_t)MP * 512 * 4;
constexpr size_t WS_O = WS_B + (size_t)MP * 512 * 4;
constexpr size_t WS_X1 = WS_O + (size_t)MP * 512 * 4;
constexpr size_t WS_G = WS_X1 + (size_t)MP * D * 4;
constexpr size_t WS_BETA = WS_G + (size_t)MP * 4 * 4;
constexpr size_t WS_GATE = WS_BETA + (size_t)MP * 4 * 4;
constexpr size_t WS_EXP = WS_GATE + (size_t)MP * 128 * 4;
constexpr size_t WS_HEND = WS_EXP + (size_t)MP * 128 * 4;
constexpr size_t WS_KEYS = WS_HEND + (size_t)3 * 4 * 64 * 512 * 4;
constexpr size_t WS_WGT = WS_KEYS + (size_t)2 * 8 * 2 * 128 * 128 * 2;
constexpr size_t WS_END = WS_WGT + (size_t)2 * 8 * 64 * 64 * 2;
constexpr size_t Q_QKVS = 0, Q_W = 1 * MiB, Q_QG = Q_W + 16 * MiB, Q_KDT = Q_QG + 16 * MiB, Q_UT = Q_KDT + 16 * MiB, Q_QK = Q_UT + 16 * MiB, Q_EGL = Q_QK + 8 * MiB, Q_END = Q_EGL + 4096;
static_assert(Q_END <= (size_t)MP * 1536 * 4, "region Q");
static_assert(WS_END <= 512 * MiB, "d_ws map");

struct MegaArgs {
    const float* in[35];
    float* out;
    unsigned char* ws;
};

__global__ void __launch_bounds__(NTH, 2) fwd_megakernel(MegaArgs ma) {
    cg::grid_group grid = cg::this_grid();
    extern __shared__ __attribute__((aligned(16))) unsigned char lds[];
    float* smem = (float*)lds;
    const int nb = gridDim.x, b0 = blockIdx.x, wave = __builtin_amdgcn_readfirstlane(threadIdx.x >> 6);
    int tid = threadIdx.x, lane = tid & 63;
    const float* x_prompt = ma.in[0];
    const float* x_sample = ma.in[1];
    const float* state_gdn = ma.in[2];
    const float* state_gdn_conv = ma.in[3];
    const float* state_lru = ma.in[4];
    const float* state_lru_conv = ma.in[5];
    const float* cache_k = ma.in[6];
    const float* cache_v = ma.in[7];
    const float* w_in_ab = ma.in[8];
    const float* gdn_conv_w = ma.in[9];
    const float* gdn_a_log = ma.in[10];
    const float* gdn_dt_bias = ma.in[11];
    const float* gdn_norm_w = ma.in[12];
    const float* lru_conv_w = ma.in[13];
    const float* lru_conv_b = ma.in[14];
    const float* lru_w_r = ma.in[15];
    const float* lru_b_r = ma.in[16];
    const float* lru_w_i = ma.in[17];
    const float* lru_b_i = ma.in[18];
    const float* lru_lam = ma.in[19];
    const float* w_out_ab = ma.in[20];
    const float* w_in_c = ma.in[21];
    const float* b_in_c = ma.in[22];
    const float* swa_sinks = ma.in[23];
    const float* w_out_c = ma.in[24];
    const float* b_out_c = ma.in[25];
    const float* rel_bias = ma.in[26];
    const float* ln_mix_g = ma.in[27];
    const float* ln_mix_b = ma.in[28];
    const float* ln_ffn_g = ma.in[29];
    const float* ln_ffn_b = ma.in[30];
    const float* peer_w_q = ma.in[31];
    const float* peer_keys = ma.in[32];
    const float* peer_u = ma.in[33];
    const float* peer_v = ma.in[34];

    float* out = ma.out;
    float* o_y = out;
    float* o_p_gdn = out + (size_t)NT * D;
    float* o_p_gdn_conv = o_p_gdn + 262144;
    float* o_p_lru = o_p_gdn_conv + 18432;
    float* o_p_lru_conv = o_p_lru + 2048;
    float* o_p_k = o_p_lru_conv + 6144;
    float* o_p_v = o_p_k + 131072;
    float* o_s_gdn = o_p_v + 131072;
    float* o_s_gdn_conv = o_s_gdn + 8388608;
    float* o_s_lru = o_s_gdn_conv + 589824;
    float* o_s_lru_conv = o_s_lru + 65536;
    float* o_s_k = o_s_lru_conv + 196608;
    float* o_s_v = o_s_k + 4194304;

    unsigned char* ws = ma.ws;
    bf16* WAB_T = (bf16*)(ws + WS_WAB); bf16* WOUT_T = (bf16*)(ws + WS_WOUT); bf16* WQ0_T = (bf16*)(ws + WS_WQ0); bf16* WQ1_T = (bf16*)(ws + WS_WQ1);
    bf16* WINC_T = (bf16*)(ws + WS_WINC); bf16* WOUTC_T = (bf16*)(ws + WS_WOUTC);
    bf16* ABUF = (bf16*)(ws + WS_ABUF);
    bf16* PROJ = (bf16*)(ws + WS_P); float* Y = (float*)(ws + WS_P); bf16* Qb = (bf16*)(ws + WS_P); bf16* PCb = (bf16*)(ws + WS_P); float* Y1 = (float*)(ws + WS_P);
    unsigned char* TAB8 = ws + WS_T; float* TSC = (float*)(ws + WS_T + (size_t)4 * 16384 * D);
    float* R_Q = (float*)(ws + WS_Q + Q_QKVS) - (size_t)NP * 1536; float* X2 = (float*)(ws + WS_A);
    GdnChunkBufs cbuf; cbuf.W = (bf16*)(ws + WS_Q + Q_W); cbuf.QG = (bf16*)(ws + WS_Q + Q_QG); cbuf.KDT = (bf16*)(ws + WS_Q + Q_KDT); cbuf.UT = (bf16*)(ws + WS_Q + Q_UT); cbuf.QK = (bf16*)(ws + WS_Q + Q_QK); cbuf.EGL = (float*)(ws + WS_Q + Q_EGL);
    float* OUTS = (float*)(ws + WS_Q);
    float* PD = (float*)(ws + WS_P);
    bf16* KEYSB = (bf16*)(ws + WS_KEYS); bf16* WRT = (bf16*)(ws + WS_WGT); bf16* WIT = WRT + 8 * 64 * 64;
    float* HEND = (float*)(ws + WS_HEND); float* PEND = HEND + 4 * 64 * 512; float* CIN = PEND + 4 * 64 * 512;
    float* R_A = (float*)(ws + WS_A); float* R_B = (float*)(ws + WS_B); float* R_O = (float*)(ws + WS_O);
    float* R_X1 = (float*)(ws + WS_X1); float* X3 = R_X1;
    float* R_G = (float*)(ws + WS_G); float* R_BETA = (float*)(ws + WS_BETA); float* R_GATE = (float*)(ws + WS_GATE); int* R_EXP = (int*)(ws + WS_EXP);

    for (int u = tid; u < (LDS_BYTES - RING_BYTES) / 4; u += NTH) ((unsigned*)(lds + RING_BYTES))[u] = 0u;
    __syncthreads();
    XcdBarrier bar = xcd_barrier_post((unsigned*)(ws + WS_CTL), (volatile LAS unsigned*)((LAS unsigned char*)lds + MISC_OFF) + 8);
#define GRID_BAR() do { xcd_barrier(bar); asm volatile("" : "+v"(tid)); lane = tid & 63; } while (0)
#define PHASE_LOOP(n) for (int vb = b0; vb < (n); vb += nb)
#define PHASE_END __syncthreads()
#define GEMM_PHASE(EPI, Aptr, Btptr, Nn, ...) do { pg8::Gemm g_{(const pg8::bf16_t*)(Aptr), (const pg8::bf16_t*)(Btptr), MP, (Nn), D}; pg8::StaticOrder S_; S_.init(MP, (Nn), nb, b0); \
        pg8::EPI E_{__VA_ARGS__}; pg8::gemm_phase<pg8::EPI, pg8::StaticOrder, true, true>((PG8_LAS unsigned char*)lds, g_, S_, E_); } while (0)

    {
        float* scr = smem + wave * 4096;
        const int gw = b0 * NWAVES + wave, NGW = nb * NWAVES;
        constexpr int I_AB = 16 * 97, I_OUT = 16 * 32, I_Q = 16 * 64, I_INC = 16 * 48;
        constexpr int NITEMS = I_AB + I_OUT + 2 * I_Q + I_INC + I_OUT;
        for (int it = gw; it < NITEMS; it += NGW) {
            int r = it;
            if (r < I_AB) { p0_transpose_item(w_in_ab, D, ABN, WAB_T, scr, r, lane); continue; } r -= I_AB;
            if (r < I_OUT) { p0_transpose_item(w_out_ab, D, D, WOUT_T, scr, r, lane); continue; } r -= I_OUT;
            if (r < I_Q) { p0_transpose_item(peer_w_q, D, 2048, WQ0_T, scr, r, lane); continue; } r -= I_Q;
            if (r < I_Q) { p0_transpose_item(peer_w_q + (size_t)D * 2048, D, 2048, WQ1_T, scr, r, lane); continue; } r -= I_Q;
            if (r < I_INC) { p0_transpose_item(w_in_c, D, CN, WINC_T, scr, r, lane); continue; } r -= I_INC;
            p0_transpose_item(w_out_c, D, D, WOUTC_T, scr, r, lane);
        }
        for (int it = b0 * NTH + tid; it < 2 * 8 * 64 * 8; it += nb * NTH) {
            const int gsel = it >> 12, nn = (it >> 9) & 7, dd = (it >> 3) & 63, c8 = (it & 7) * 8;
            const float* wsrc = (gsel ? lru_w_i : lru_w_r) + ((size_t)nn * 64 + c8) * 64 + dd;
            v4u o; o.x = pk2(wsrc[0], wsrc[64]); o.y = pk2(wsrc[128], wsrc[192]); o.z = pk2(wsrc[256], wsrc[320]); o.w = pk2(wsrc[384], wsrc[448]);
            *(v4u*)((gsel ? WIT : WRT) + ((size_t)nn * 64 + dd) * 64 + c8) = o;
        }
        for (int m = gw; m < MP + (ABNP - 97 * 32); m += NGW) {
            if (m < MP) row_to_bf16(m < NP ? x_prompt + (size_t)m * D : (m < NT ? x_sample + (size_t)(m - NP) * D : nullptr), ABUF + (size_t)m * D, lane);
            else row_to_bf16(nullptr, WAB_T + (size_t)(97 * 32 + (m - MP)) * D, lane);
        }
    }
    grid.sync();
    GEMM_PHASE(EpiStoreBf16, ABUF, WAB_T, ABNP, PROJ, ABN, nullptr, NT, ABN);
    GRID_BAR();
    { AbPrepArgs pa;
      pa.PROJ = PROJ; pa.st_gdn_conv = state_gdn_conv; pa.st_lru_conv = state_lru_conv;
      pa.gdn_conv_w = gdn_conv_w; pa.a_log = gdn_a_log; pa.dt_bias = gdn_dt_bias;
      pa.lru_conv_w = lru_conv_w; pa.lru_conv_b = lru_conv_b; pa.w_r = lru_w_r; pa.b_r = lru_b_r; pa.w_i = lru_w_i; pa.b_i = lru_b_i; pa.lam = lru_lam;
      pa.QKV = R_Q; pa.G = R_G; pa.BETA = R_BETA; pa.LA = R_A; pa.LB = R_B;
      pa.p_gdn_conv = o_p_gdn_conv; pa.p_lru_conv = o_p_lru_conv; pa.s_gdn_conv = o_s_gdn_conv; pa.s_lru_conv = o_s_lru_conv;
#define GDN_UN_A(i_) ((((i_) >> 7) * 64 + (((i_) >> 2) & 31)) * 4 + ((i_) & 3))
      if (b0 < 128) {
          lru_prep_unit2(PROJ, lru_conv_w, lru_conv_b, WRT, WIT, lru_b_r, lru_b_i, lru_lam, R_B, R_A, HEND, PEND, o_p_lru_conv, (b0 >> 5) * 64 + (b0 & 31), lds); PHASE_END;
          gdn_prep_unit(PROJ, gdn_conv_w, gdn_a_log, gdn_dt_bias, cbuf, o_p_gdn_conv, GDN_UN_A(b0), lds);
      } else if (b0 < 256) {
          ab_prep(pa, NP + (b0 - 128), smem); PHASE_END;
          for (int k = 0; k < 3; ++k) gdn_prep_unit(PROJ, gdn_conv_w, gdn_a_log, gdn_dt_bias, cbuf, o_p_gdn_conv, GDN_UN_A(128 + (b0 - 128) * 3 + k), lds);
      } }
    GRID_BAR();
    f32x4 seqS[2]; int seqcur = 0;
    if (b0 < 64) gdn_seq<0, 32>(cbuf, R_O, o_p_gdn, b0 >> 4, (b0 >> 2) & 3, b0 & 3, lds, seqS, seqcur);
    else if (b0 < 192) {
        const int i = b0 - 64;
        lru_prep_unit2(PROJ, lru_conv_w, lru_conv_b, WRT, WIT, lru_b_r, lru_b_i, lru_lam, R_B, R_A, HEND, PEND, o_p_lru_conv, (i >> 5) * 64 + 32 + (i & 31), lds); PHASE_END;
        for (int k = 0; k < 2; ++k) gdn_prep_unit(PROJ, gdn_conv_w, gdn_a_log, gdn_dt_bias, cbuf, o_p_gdn_conv, GDN_UN_A(i * 2 + k) + 32 * 4, lds);
    } else if (b0 < 256) {
        const int i = b0 - 192;
        for (int k = 0; k < 4; ++k) gdn_prep_unit(PROJ, gdn_conv_w, gdn_a_log, gdn_dt_bias, cbuf, o_p_gdn_conv, GDN_UN_A(256 + i * 4 + k) + 32 * 4, lds);
    }
    GRID_BAR();
    if (b0 < 64) gdn_seq<32, 64>(cbuf, R_O, o_p_gdn, b0 >> 4, (b0 >> 2) & 3, b0 & 3, lds, seqS, seqcur);
    else if (b0 < 68) lru_carry(HEND, PEND, CIN, o_p_lru, b0 - 64);
    else {
        for (int v = b0 - 68; v < 2048 + 128; v += nb - 68) {
            if (v < 2048) gdn_scan(R_Q, R_G, R_BETA, state_gdn, R_O, o_s_gdn, NP, 1, v & 3, (v >> 2) & 3, v >> 4, smem);
            else lru_scan(R_A, R_B, state_lru, o_s_lru, NP, 1, NS, v - 2048);
            PHASE_END;
        }
        const int gw2 = (b0 - 68) * NWAVES + wave, NGW2 = (nb - 68) * NWAVES;
        for (int m = gw2; m < 512; m += NGW2) row_to_bf16(peer_keys + (size_t)m * D, KEYSB + (size_t)m * D, lane);
        for (int m = gw2; m < 4 * 16384; m += NGW2) {
            const int k = m >> 14, r = m & 16383;
            row_to_fp8_sliced(((k & 1) ? peer_v : peer_u) + ((size_t)(k >> 1) * 16384 + r) * D, TAB8 + (size_t)k * 16384 * D, r, TSC + m, lane);
        }
    }
    GRID_BAR();
    PHASE_LOOP(NT / 2) { ab_mix(PROJ, R_O, R_B, R_A, CIN, gdn_norm_w, ABUF, vb); }
    GRID_BAR();
    GEMM_PHASE(EpiStoreF32, ABUF, WOUT_T, D, Y, D, nullptr, NT, D);
    GRID_BAR();
    PHASE_LOOP(NT / 8) { const int t = vb * 8 + wave;
        ln_res_w(t < NP ? x_prompt + (size_t)t * D : x_sample + (size_t)(t - NP) * D, Y + (size_t)t * D, ln_mix_g, ln_mix_b, R_X1 + (size_t)t * D, ABUF + (size_t)t * D, lane); }
    GRID_BAR();
    GEMM_PHASE(EpiStoreBf16, ABUF, WQ0_T, 2048, Qb, 2048, nullptr, NT, 2048);
    GRID_BAR();
    if ((nb & 7) == 0) { peer_topk_stage_keys(KEYSB, b0 & 7, lds); PHASE_LOOP((NT / 64) * 8) { peer_topk4(Qb, R_EXP, R_GATE, vb >> 3, vb & 7, lds); } }
    else PHASE_LOOP((NT / 64) * 8) { peer_topk_stage_keys(KEYSB, vb & 7, lds); peer_topk4(Qb, R_EXP, R_GATE, vb >> 3, vb & 7, lds); }
    GRID_BAR();
    asm volatile("" : "+v"(tid)); lane = tid & 63;
    for (int tg = b0 >> 3; tg < NT / 8; tg += nb >> 3) { const int t = tg * 8 + wave, x = b0 & 7;
        peer_u_pass(R_X1 + (size_t)t * D, R_EXP + (size_t)t * 128, TAB8 + (size_t)x * 16384 * 128, PD + ((size_t)x * NT + t) * 128, x, lane); }
    GRID_BAR();
    PHASE_LOOP(NT / 8) { const int t = vb * 8 + wave; peer_xk(R_EXP + (size_t)t * 128, R_GATE + (size_t)t * 128, PD + (size_t)t * 128, TSC, TSC + 16384, lane); }
    GRID_BAR();
    for (int tg = b0 >> 3; tg < NT / 8; tg += nb >> 3) { const int t = tg * 8 + wave, x = b0 & 7;
        peer_v_slice(R_EXP + (size_t)t * 128, R_GATE + (size_t)t * 128, TAB8 + (size_t)16384 * D + (size_t)x * 16384 * 128, OUTS + (size_t)t * D + x * 128, lane); }
    GRID_BAR();
    PHASE_LOOP(NT / 8) { const int t = vb * 8 + wave; peer_xc(R_X1 + (size_t)t * D, OUTS + (size_t)t * D, ln_ffn_g, ln_ffn_b, X2 + (size_t)t * D, ABUF + (size_t)t * D, lane); }
    GRID_BAR();

    GEMM_PHASE(EpiStoreBf16, ABUF, WINC_T, CN, PCb, CN, b_in_c, NT, CN);
    GRID_BAR();
    PHASE_LOOP(1024 + 256 + (NB * 128 + NS * 128) / 2) {
        if (vb < 1024) attn_unit(PCb, rel_bias, swa_sinks, ABUF, vb, lds);
        else if (vb < 1280) swa_attn_sample(PCb, cache_k, cache_v, rel_bias, swa_sinks, ABUF, (vb - 1024) * 8 + wave, lane);
        else swa_kv_out2(PCb, cache_k, cache_v, o_p_k, o_p_v, o_s_k, o_s_v, vb - 1280);
    }
    GRID_BAR();
    GEMM_PHASE(EpiStoreF32, ABUF, WOUTC_T, D, Y1, D, b_out_c, NT, D);
    GRID_BAR();
    PHASE_LOOP(NT / 8) { const int t = vb * 8 + wave;
        ln_res_w(X2 + (size_t)t * D, Y1 + (size_t)t * D, ln_mix_g + D, ln_mix_b + D, X3 + (size_t)t * D, ABUF + (size_t)t * D, lane); }
    GRID_BAR();
    GEMM_PHASE(EpiStoreBf16, ABUF, WQ1_T, 2048, Qb, 2048, nullptr, NT, 2048);
    GRID_BAR();
    if ((nb & 7) == 0) { peer_topk_stage_keys(KEYSB + (size_t)8 * 2 * 128 * 128, b0 & 7, lds); PHASE_LOOP((NT / 64) * 8) { peer_topk4(Qb, R_EXP, R_GATE, vb >> 3, vb & 7, lds); } }
    else PHASE_LOOP((NT / 64) * 8) { peer_topk_stage_keys(KEYSB + (size_t)8 * 2 * 128 * 128, vb & 7, lds); peer_topk4(Qb, R_EXP, R_GATE, vb >> 3, vb & 7, lds); }
    GRID_BAR();
    asm volatile("" : "+v"(tid)); lane = tid & 63;
    for (int tg = b0 >> 3; tg < NT / 8; tg += nb >> 3) { const int t = tg * 8 + wave, x = b0 & 7;
        peer_u_pass(X3 + (size_t)t * D, R_EXP + (size_t)t * 128, TAB8 + (size_t)2 * 16384 * D + (size_t)x * 16384 * 128, PD + ((size_t)x * NT + t) * 128, x, lane); }
    GRID_BAR();
    PHASE_LOOP(NT / 8) { const int t = vb * 8 + wave; peer_xk(R_EXP + (size_t)t * 128, R_GATE + (size_t)t * 128, PD + (size_t)t * 128, TSC + 2 * 16384, TSC + 3 * 16384, lane); }
    GRID_BAR();
    for (int tg = b0 >> 3; tg < NT / 8; tg += nb >> 3) { const int t = tg * 8 + wave, x = b0 & 7;
        peer_v_slice(R_EXP + (size_t)t * 128, R_GATE + (size_t)t * 128, TAB8 + (size_t)3 * 16384 * D + (size_t)x * 16384 * 128, OUTS + (size_t)t * D + x * 128, lane); }
    GRID_BAR();
    PHASE_LOOP(NT / 8) { const int t = vb * 8 + wave; peer_xc(X3 + (size_t)t * D, OUTS + (size_t)t * D, ln_ffn_g + D, ln_ffn_b + D, o_y + (size_t)t * D, nullptr, lane); }
}
}

extern "C" void kernel_launch(void* const* d_in, const int* in_sizes, int n_in,
                              void* d_out, int out_size, void* d_ws, size_t ws_size,
                              hipStream_t stream) {
    static int grid_blocks = 0;
    if (!grid_blocks) {
        int dev = 0, cus = 0, per_cu = 0;
        (void)hipGetDevice(&dev);
        (void)hipDeviceGetAttribute(&cus, hipDeviceAttributeMultiprocessorCount, dev);
        if (hipFuncSetAttribute((const void*)fwd_megakernel, hipFuncAttributeMaxDynamicSharedMemorySize, LDS_BYTES) != hipSuccess) { fprintf(stderr, "hipFuncSetAttribute failed\n"); grid_blocks = -1; return; }
        (void)hipOccupancyMaxActiveBlocksPerMultiprocessor(&per_cu, (const void*)fwd_megakernel, NTH, LDS_BYTES);
        if (per_cu < 1) { fprintf(stderr, "occupancy query says %d blocks per CU\n", per_cu); grid_blocks = -1; return; }
        if (cus * per_cu < 256) { fprintf(stderr, "this kernel needs 256 co-resident workgroups (device reports %d CUs x %d)\n", cus, per_cu); grid_blocks = -1; return; }
        grid_blocks = 256;
    }
    if (grid_blocks < 0) return;
    (void)hipMemsetAsync((char*)d_ws + WS_CTL, 0, CTL_ZERO_BYTES, stream);
    MegaArgs ma{};
    for (int i = 0; i < 35; ++i) ma.in[i] = (const float*)d_in[i];
    ma.out = (float*)d_out;
    ma.ws = (unsigned char*)d_ws;
    void* args[] = {&ma};
    hipError_t e = hipLaunchCooperativeKernel((void*)fwd_megakernel, dim3(grid_blocks), dim3(NTH), args, LDS_BYTES, stream);
    if (e != hipSuccess) fprintf(stderr, "cooperative launch failed: %s (grid %d)\n", hipGetErrorString(e), grid_blocks);
}
```

```cpp
#include <hip/hip_runtime.h>
#include <hip/hip_cooperative_groups.h>
#include <cstdio>
#include <cstdint>
namespace cg = cooperative_groups;

namespace pg8 {
#define PG8_LAS __attribute__((address_space(3)))
typedef unsigned short bf16_t;
typedef short bf16x8 __attribute__((ext_vector_type(8)));
typedef float f32x4 __attribute__((ext_vector_type(4)));
typedef unsigned u32x4 __attribute__((ext_vector_type(4)));
constexpr int BM = 256, BK = 64, HALF = 128, HTB = HALF * BK * 2  , STAGE_BYTES = 8 * HTB, NXCD = 8, WGM = 8;

__host__ __device__ __forceinline__ int lds_byte(int r, int c) { const int st = (r >> 4) * 2 + (c >> 5), rr = r & 15, cc = c & 31, ob = rr * 64 + cc * 2; return st * 1024 + (ob ^ (((ob >> 9) & 1) << 5)); }
__host__ __device__ __forceinline__ void stage_rc(int b, int& R, int& C) { const int st = b / 1024, sb = b % 1024, swz = sb ^ (((sb >> 9) & 1) << 5); R = (st >> 1) * 16 + swz / 64; C = (st & 1) * 32 + (swz % 64) / 2; }
__host__ __device__ __forceinline__ int perm32(int rho) { const int n = rho >> 4, i = rho & 15; return 8 * (i >> 2) + 4 * n + (i & 3); }

struct Unit { int pm, pn; };
struct Gemm { const bf16_t* A; const bf16_t* Bt; int M, N, K; };

struct StaticOrder {
    int nM, nN, nwg, G, c;
    __host__ __device__ void init(int M, int N, int G_, int c_) { nM = M / BM; nN = N / BM; nwg = nM * nN; G = G_; c = c_; }
    __host__ __device__ bool next(int i, Unit& u) const {
        const long L = (long)i * G + c; if (L >= nwg) return false;
        int wgid = (int)L; { const int q = nwg / NXCD, r = nwg % NXCD, xcd = wgid % NXCD, off = wgid / NXCD; wgid = (xcd < r ? xcd * (q + 1) : r * (q + 1) + (xcd - r) * q) + off; }
        const int nig = WGM * nN, gid = wgid / nig, fm = gid * WGM, gsz = (nM - fm) < WGM ? (nM - fm) : WGM;
        u.pm = fm + ((wgid % nig) % gsz); u.pn = (wgid % nig) / gsz; return true;
    }
    __device__ __forceinline__ void a_ready(const Unit&) const {}
    __device__ __forceinline__ void done(const Unit&) const {}
};

__device__ __forceinline__ unsigned cvt_pk_bf16(float lo, float hi) { unsigned r; asm volatile("v_cvt_pk_bf16_f32 %0, %1, %2" : "=v"(r) : "v"(lo), "v"(hi)); return r; }
template <class Epi, class Sched, bool ALIGN_EPI = false, bool SP2 = false>
__device__ __forceinline__ void gemm_phase(PG8_LAS unsigned char* lds, const Gemm g, const Sched& S, const Epi& E) {
    int tid_ = threadIdx.x; asm volatile("" : "+v"(tid_));
    const int tid = tid_, wid = __builtin_amdgcn_readfirstlane(tid >> 6), lane = tid & 63, wr = wid >> 2, wc = wid & 3, fr = lane & 15, fq = lane >> 4;
    const int K = g.K, nt = K / BK;
    unsigned voffA[2], voffB[2];
#pragma unroll
    for (int i = 0; i < 2; ++i) { int R, C; stage_rc(tid * 16 + i * 8192, R, C); const int Rb = Epi::PERM ? ((R & ~31) + perm32(R & 31)) : R;
        voffA[i] = (unsigned)(R * K + C) * 2u; voffB[i] = (unsigned)(Rb * K + C) * 2u; }
    const size_t kstep = (size_t)(BK * 2);
    const size_t hstep = (size_t)HALF * K * 2;
    const size_t tstep = 2 * hstep;
    const unsigned ldsw = (unsigned)wid * 1024u;
    const int aoff = lds_byte(wr * 64 + fr, fq * 8), boff = lds_byte(wc * 32 + fr, fq * 8);
#define PG8_SA(b, h) (((b) * 2 + (h)) * HTB)
#define PG8_SB(b, h) ((4 + (b) * 2 + (h)) * HTB)
#define PG8_STAGE(bufoff, gbase, voff) do { _Pragma("unroll") for (int _i = 0; _i < 2; ++_i) \
        __builtin_amdgcn_global_load_lds((const unsigned*)((const char*)(gbase) + (voff)[_i]), (PG8_LAS unsigned*)(lds + (bufoff) + ldsw + _i * 8192), 16, 0, 0); } while (0)
#define PG8_LDA(dst, b, h) do { _Pragma("unroll") for (int m = 0; m < 4; ++m) _Pragma("unroll") for (int k = 0; k < 2; ++k) dst[m][k] = *(const PG8_LAS bf16x8*)(lds + PG8_SA(b, h) + aoff + m * 2048 + k * 1024); } while (0)
#define PG8_LDB(dst, b, h) do { _Pragma("unroll") for (int n = 0; n < 2; ++n) _Pragma("unroll") for (int k = 0; k < 2; ++k) dst[n][k] = *(const PG8_LAS bf16x8*)(lds + PG8_SB(b, h) + boff + n * 2048 + k * 1024); } while (0)
#define PG8_MMA(ai, bj, At, Bt) do { __builtin_amdgcn_s_setprio(1); _Pragma("unroll") for (int m = 0; m < 4; ++m) _Pragma("unroll") for (int n = 0; n < 2; ++n) _Pragma("unroll") for (int k = 0; k < 2; ++k) \
        acc[ai][bj][m][n] = __builtin_amdgcn_mfma_f32_16x16x32_bf16(Bt[n][k], At[m][k], acc[ai][bj][m][n], 0, 0, 0); __builtin_amdgcn_s_setprio(0); } while (0)
#define PG8_WAIT_V(n) asm volatile("s_waitcnt vmcnt(" #n ")" ::: "memory")
#define PG8_WAIT_L(n) asm volatile("s_waitcnt lgkmcnt(" #n ")" ::: "memory")
#define PG8_BAR __builtin_amdgcn_s_barrier()
#define PG8_SCHED __builtin_amdgcn_sched_barrier(0)
    Unit cur, nxt; int ui = 0;
    if (!S.next(0, cur)) return;
    f32x4 acc[2][2][4][2];
#pragma unroll
    for (int a = 0; a < 2; ++a)
#pragma unroll
        for (int b = 0; b < 2; ++b)
#pragma unroll
            for (int m = 0; m < 4; ++m)
#pragma unroll
                for (int n = 0; n < 2; ++n) acc[a][b][m][n] = (f32x4){0.f, 0.f, 0.f, 0.f};
    bf16x8 At[4][2], B0[2][2], B1[2][2];
    const char* cA = (const char*)g.A + (size_t)cur.pm * tstep; const char* cB = (const char*)g.Bt + (size_t)cur.pn * tstep;
    S.a_ready(cur);
    if constexpr (SP2) {
        PG8_STAGE(PG8_SB(0, 0), cB, voffB); PG8_STAGE(PG8_SB(0, 1), cB + hstep, voffB); PG8_STAGE(PG8_SA(0, 0), cA, voffA); PG8_STAGE(PG8_SA(0, 1), cA + hstep, voffA);
        if (wr == 1) PG8_BAR;
        PG8_WAIT_V(2); PG8_BAR;
        PG8_STAGE(PG8_SB(1, 0), cB + kstep, voffB); PG8_STAGE(PG8_SA(1, 0), cA + kstep, voffA); PG8_STAGE(PG8_SB(1, 1), cB + hstep + kstep, voffB);
        PG8_WAIT_V(6); PG8_BAR;
    } else {
        PG8_STAGE(PG8_SB(0, 0), cB, voffB); PG8_STAGE(PG8_SA(0, 0), cA, voffA); PG8_STAGE(PG8_SB(0, 1), cB + hstep, voffB); PG8_STAGE(PG8_SA(0, 1), cA + hstep, voffA);
        if (wr == 1) PG8_BAR;
        PG8_WAIT_V(4); PG8_BAR;
        PG8_STAGE(PG8_SB(1, 0), cB + kstep, voffB); PG8_STAGE(PG8_SA(1, 0), cA + kstep, voffA); PG8_STAGE(PG8_SB(1, 1), cB + hstep + kstep, voffB);
        PG8_WAIT_V(6); PG8_BAR;
    }
    for (;;) {
        const bool has_next = S.next(ui + 1, nxt);
        const char* nA = has_next ? (const char*)g.A + (size_t)nxt.pm * tstep : cA; const char* nB = has_next ? (const char*)g.Bt + (size_t)nxt.pn * tstep : cB;
        for (int t = 0; t < nt; t += 2) {
            const bool last = (t == nt - 2);
            const char* a1 = cA + (size_t)(t + 1) * kstep;
            const char* a2 = last ? nA : cA + (size_t)(t + 2) * kstep; const char* b2 = last ? nB : cB + (size_t)(t + 2) * kstep;
            const char* a3 = a2 + kstep; const char* b3 = b2 + kstep;
            if (last && has_next) S.a_ready(nxt);
            if constexpr (SP2) {
            PG8_LDB(B0, 0, 0); PG8_LDB(B1, 0, 1); PG8_SCHED; PG8_LDA(At, 0, 0); PG8_STAGE(PG8_SA(1, 1), a1 + hstep, voffA);
            PG8_WAIT_V(8); PG8_WAIT_L(0); PG8_BAR; PG8_MMA(0, 0, At, B0); PG8_MMA(0, 1, At, B1); PG8_BAR; PG8_SCHED;
            PG8_LDA(At, 0, 1); PG8_STAGE(PG8_SB(0, 0), b2, voffB); PG8_STAGE(PG8_SB(0, 1), b2 + hstep, voffB); PG8_STAGE(PG8_SA(0, 0), a2, voffA);
            PG8_WAIT_V(8); PG8_WAIT_L(0); PG8_BAR; PG8_MMA(1, 0, At, B0); PG8_MMA(1, 1, At, B1); PG8_BAR; PG8_SCHED;
            PG8_LDB(B0, 1, 0); PG8_LDB(B1, 1, 1); PG8_SCHED; PG8_LDA(At, 1, 0); PG8_STAGE(PG8_SA(0, 1), a2 + hstep, voffA);
            PG8_WAIT_V(8); PG8_WAIT_L(0); PG8_BAR; PG8_MMA(0, 0, At, B0); PG8_MMA(0, 1, At, B1); PG8_BAR; PG8_SCHED;
            PG8_LDA(At, 1, 1); PG8_STAGE(PG8_SB(1, 0), b3, voffB); PG8_STAGE(PG8_SB(1, 1), b3 + hstep, voffB); PG8_STAGE(PG8_SA(1, 0), a3, voffA);
            PG8_WAIT_V(8); PG8_WAIT_L(0); PG8_BAR; PG8_MMA(1, 0, At, B0); PG8_MMA(1, 1, At, B1); PG8_BAR; PG8_SCHED;
            } else {
            PG8_LDB(B0, 0, 0); PG8_SCHED; PG8_LDA(At, 0, 0); PG8_STAGE(PG8_SA(1, 1), a1 + hstep, voffA);
            PG8_WAIT_L(8); PG8_BAR; PG8_WAIT_L(0); PG8_MMA(0, 0, At, B0); PG8_BAR; PG8_SCHED;
            PG8_LDB(B1, 0, 1); PG8_STAGE(PG8_SB(0, 0), b2, voffB);
            PG8_BAR; PG8_WAIT_L(0); PG8_MMA(0, 1, At, B1); PG8_BAR;
            PG8_LDA(At, 0, 1); PG8_STAGE(PG8_SA(0, 0), a2, voffA);
            PG8_BAR; PG8_WAIT_L(0); PG8_MMA(1, 0, At, B0); PG8_BAR; PG8_SCHED;
            PG8_STAGE(PG8_SB(0, 1), b2 + hstep, voffB);
            PG8_WAIT_V(6); PG8_BAR; PG8_MMA(1, 1, At, B1); PG8_BAR;
            PG8_LDB(B0, 1, 0); PG8_SCHED; PG8_LDA(At, 1, 0); PG8_STAGE(PG8_SA(0, 1), a2 + hstep, voffA);
            PG8_WAIT_L(8); PG8_BAR; PG8_WAIT_L(0); PG8_MMA(0, 0, At, B0); PG8_BAR; PG8_SCHED;
            PG8_LDB(B1, 1, 1); PG8_STAGE(PG8_SB(1, 0), b3, voffB);
            PG8_BAR; PG8_WAIT_L(0); PG8_MMA(0, 1, At, B1); PG8_BAR;
            PG8_LDA(At, 1, 1); PG8_STAGE(PG8_SA(1, 0), a3, voffA);
            PG8_BAR; PG8_WAIT_L(0); PG8_MMA(1, 0, At, B0); PG8_BAR; PG8_SCHED;
            PG8_STAGE(PG8_SB(1, 1), b3 + hstep, voffB);
            PG8_WAIT_V(6); PG8_BAR; PG8_MMA(1, 1, At, B1); PG8_BAR;
            }
        }
        if constexpr (ALIGN_EPI) { if (wr == 0) PG8_BAR; }
        if constexpr (!Epi::AFTER_DRAIN) { E(acc, cur, wr, wc, fr, fq); S.done(cur); }
        if (!has_next) break;
#pragma unroll
        for (int a = 0; a < 2; ++a)
#pragma unroll
            for (int b = 0; b < 2; ++b)
#pragma unroll
                for (int m = 0; m < 4; ++m)
#pragma unroll
                    for (int n = 0; n < 2; ++n) acc[a][b][m][n] = (f32x4){0.f, 0.f, 0.f, 0.f};
        cur = nxt; cA = nA; cB = nB; ++ui;
        if constexpr (ALIGN_EPI) { if (wr == 1) PG8_BAR; }
    }
    PG8_WAIT_V(0);
    if constexpr (!ALIGN_EPI) { if (wr == 0) PG8_BAR; }
    PG8_BAR;
    if constexpr (Epi::AFTER_DRAIN) { E.fused(acc, cur, wr, wc, fr, fq, lds, wid, lane); S.done(cur); }
#undef PG8_SA
#undef PG8_SB
#undef PG8_STAGE
#undef PG8_LDA
#undef PG8_LDB
#undef PG8_MMA
#undef PG8_WAIT_V
#undef PG8_WAIT_L
#undef PG8_BAR
#undef PG8_SCHED
}
}
namespace pg8 {
struct EpiStoreBf16 {
    static constexpr bool PERM = true, AFTER_DRAIN = false;
    bf16_t* O; int ldc; const float* bias; int m_real, n_real;
    __device__ __forceinline__ void operator()(const f32x4 (&acc)[2][2][4][2], const Unit& u, int wr, int wc, int fr, int fq) const {
        const int row0 = u.pm * BM + wr * 64 + fr, col0 = u.pn * BM + wc * 32 + 8 * fq;
#pragma unroll
        for (int bj = 0; bj < 2; ++bj) {
            const int col = col0 + bj * HALF;
            if (col >= n_real) continue;
            f32x4 b0 = (f32x4){0.f, 0.f, 0.f, 0.f}, b1 = b0;
            if (bias) { b0 = *(const f32x4*)(bias + col); b1 = *(const f32x4*)(bias + col + 4); }
#pragma unroll
            for (int ai = 0; ai < 2; ++ai)
#pragma unroll
                for (int m = 0; m < 4; ++m) {
                    const int row = row0 + ai * HALF + m * 16;
                    if (row >= m_real) continue;
                    const f32x4 v0 = acc[ai][bj][m][0] + b0, v1 = acc[ai][bj][m][1] + b1;
                    u32x4 w; w.x = cvt_pk_bf16(v0[0], v0[1]); w.y = cvt_pk_bf16(v0[2], v0[3]); w.z = cvt_pk_bf16(v1[0], v1[1]); w.w = cvt_pk_bf16(v1[2], v1[3]);
                    *(u32x4*)(O + (size_t)row * ldc + col) = w;
                }
        }
    }
};
struct EpiStoreF32 {
    static constexpr bool PERM = false, AFTER_DRAIN = false;
    float* O; int ldc; const float* bias; int m_real, n_real;
    __device__ __forceinline__ void operator()(const f32x4 (&acc)[2][2][4][2], const Unit& u, int wr, int wc, int fr, int fq) const {
        const int row0 = u.pm * BM + wr * 64 + fr, col0 = u.pn * BM + wc * 32 + 4 * fq;
#pragma unroll
        for (int bj = 0; bj < 2; ++bj)
#pragma unroll
            for (int n = 0; n < 2; ++n) {
                const int col = col0 + bj * HALF + n * 16;
                if (col >= n_real) continue;
                const f32x4 bv = bias ? *(const f32x4*)(bias + col) : (f32x4){0.f, 0.f, 0.f, 0.f};
#pragma unroll
                for (int ai = 0; ai < 2; ++ai)
#pragma unroll
                    for (int m = 0; m < 4; ++m) {
                        const int row = row0 + ai * HALF + m * 16;
                        if (row >= m_real) continue;
                        *(f32x4*)(O + (size_t)row * ldc + col) = acc[ai][bj][m][n] + bv;
                    }
            }
    }
};
}
namespace {
#define GAS __attribute__((address_space(1)))
#define LAS __attribute__((address_space(3)))
typedef unsigned short bf16;
typedef float f32x4 __attribute__((ext_vector_type(4)));
typedef unsigned v4u __attribute__((ext_vector_type(4)));
typedef unsigned v2u __attribute__((ext_vector_type(2)));

constexpr int D = 1024, NB = 4, SEQ = 4096, NP = NB * SEQ, NS = 128, NT = NP + NS, MP = 16640;
constexpr int ABN = 3080, ABNP = 3328;
constexpr int C_QKV = 0, C_Z = 1536, C_A = 2048, C_B = 2052, C_XR = 2056, C_GATE = 2568;
constexpr int CN = 1536;
constexpr float ALPHA = 1.4142135623730951f;
constexpr float LN_EPS = 1e-5f;
constexpr int NTH = 512, NWAVES = 8;
constexpr int RING_BYTES = 143360, MISC_OFF = RING_BYTES + 320, LDS_BYTES = 147456;

__device__ __forceinline__ float bf2f(bf16 v) { return __uint_as_float((unsigned)v << 16); }
__device__ __forceinline__ float bflo(unsigned w) { return __uint_as_float(w << 16); }
__device__ __forceinline__ float bfhi(unsigned w) { return __uint_as_float(w & 0xffff0000u); }
__device__ __forceinline__ unsigned f2bf(float f) { unsigned u = __float_as_uint(f); return (u + 0x7fffu + ((u >> 16) & 1u)) >> 16; }
__device__ __forceinline__ unsigned pk2(float lo, float hi) { return f2bf(lo) | (f2bf(hi) << 16); }
__device__ __forceinline__ float sigmoidf_(float x) { return 1.0f / (1.0f + expf(-x)); }
__device__ __forceinline__ float softplusf_(float x) { return fmaxf(x, 0.f) + log1pf(expf(-fabsf(x))); }
__device__ __forceinline__ float siluf_(float x) { return x / (1.0f + expf(-x)); }
__device__ __forceinline__ float geluf_(float x) { return 0.5f * x * (1.0f + tanhf(0.7978845608028654f * (x + 0.044715f * x * x * x))); }
#define DPPF(v_, ctrl_, rmask_) __int_as_float(__builtin_amdgcn_update_dpp(0, __float_as_int(v_), (ctrl_), (rmask_), 0xf, false))
__device__ __forceinline__ float wave_sum(float v) {
    v += DPPF(v, 0xB1, 0xf); v += DPPF(v, 0x4E, 0xf); v += DPPF(v, 0x141, 0xf); v += DPPF(v, 0x140, 0xf);
    v += DPPF(v, 0x142, 0xa); v += DPPF(v, 0x143, 0xc);
    return __int_as_float(__builtin_amdgcn_readlane(__float_as_int(v), 63));
}
__device__ __forceinline__ float wave_max(float v) {
    v = fmaxf(v, DPPF(v, 0xB1, 0xf)); v = fmaxf(v, DPPF(v, 0x4E, 0xf)); v = fmaxf(v, DPPF(v, 0x141, 0xf)); v = fmaxf(v, DPPF(v, 0x140, 0xf));
    { const float t = __int_as_float(__builtin_amdgcn_update_dpp(__float_as_int(v), __float_as_int(v), 0x142, 0xa, 0xf, false)); v = fmaxf(v, t); }
    { const float t = __int_as_float(__builtin_amdgcn_update_dpp(__float_as_int(v), __float_as_int(v), 0x143, 0xc, 0xf, false)); v = fmaxf(v, t); }
    return __int_as_float(__builtin_amdgcn_readlane(__float_as_int(v), 63));
}

__device__ __forceinline__ void p0_transpose_item(const float* __restrict__ W, int K, int N, bf16* __restrict__ WT, float* scr, int item, int lane) {
    const int nblk = (N + 31) / 32, kb = item / nblk, nb = item % nblk, k0 = 64 * kb, n0 = 32 * nb;
#pragma unroll 8
    for (int i = 0; i < 32; ++i) { const int kk = 2 * i + (lane >> 5), n = n0 + (lane & 31); scr[kk * 33 + (lane & 31)] = n < N ? W[(size_t)(k0 + kk) * N + n] : 0.f; }
    asm volatile("s_waitcnt lgkmcnt(0)" ::: "memory");
    const int c = lane & 7;
#pragma unroll
    for (int j = 0; j < 4; ++j) { const int n = (lane >> 3) + 8 * j; const float* s = scr + (8 * c) * 33 + n;
        v4u o; o.x = pk2(s[0 * 33], s[1 * 33]); o.y = pk2(s[2 * 33], s[3 * 33]); o.z = pk2(s[4 * 33], s[5 * 33]); o.w = pk2(s[6 * 33], s[7 * 33]);
        *(v4u*)(WT + (size_t)(n0 + n) * K + k0 + 8 * c) = o; }
    asm volatile("s_waitcnt lgkmcnt(0)" ::: "memory");
}
__device__ __forceinline__ void row_to_bf16(const float* __restrict__ xrow, bf16* __restrict__ orow, int lane) {
#pragma unroll
    for (int j = 0; j < 4; ++j) {
        f32x4 v = (f32x4){0.f, 0.f, 0.f, 0.f};
        if (xrow) v = ((const f32x4*)xrow)[lane + 64 * j];
        v2u o; o.x = pk2(v.x, v.y); o.y = pk2(v.z, v.w);
        ((v2u*)orow)[lane + 64 * j] = o;
    }
}

struct AbPrepArgs {
    const bf16* PROJ; const float* st_gdn_conv; const float* st_lru_conv;
    const float* gdn_conv_w; const float* a_log; const float* dt_bias;
    const float* lru_conv_w; const float* lru_conv_b; const float* w_r; const float* b_r; const float* w_i; const float* b_i; const float* lam;
    float* QKV; float* G; float* BETA; float* LA; float* LB;
    float* p_gdn_conv; float* p_lru_conv; float* s_gdn_conv; float* s_lru_conv;
};
__device__ __forceinline__ void ab_prep(const AbPrepArgs& a, int t, float* smem) {
    int tid = threadIdx.x; asm volatile("" : "+v"(tid));
    const int lane = tid & 63, wid = tid >> 6;
    const bool samp = t >= NP; const int sb = t - NP, pos = t % SEQ, b = t / SEQ;
    float* sq = smem;
    float* sx = smem + 1536;
    float* scl = smem + 2048;
    const bf16* prow = a.PROJ + (size_t)t * ABN;
    for (int c = tid; c < 1536; c += NTH) {
        float acc = 0.f;
#pragma unroll
        for (int i = 0; i < 4; ++i) {
            float xv;
            if (i == 3) xv = bf2f(prow[C_QKV + c]);
            else if (samp) xv = a.st_gdn_conv[((size_t)sb * 3 + i) * 1536 + c];
            else xv = (pos - 3 + i >= 0) ? bf2f(a.PROJ[(size_t)(t - 3 + i) * ABN + C_QKV + c]) : 0.f;
            acc += a.gdn_conv_w[i * 1536 + c] * xv;
        }
        sq[c] = siluf_(acc);
    }
    {
        const int c = tid;
        float acc = a.lru_conv_b[c];
#pragma unroll
        for (int i = 0; i < 4; ++i) {
            float xv;
            if (i == 3) xv = bf2f(prow[C_XR + c]);
            else if (samp) xv = a.st_lru_conv[((size_t)sb * 3 + i) * 512 + c];
            else xv = (pos - 3 + i >= 0) ? bf2f(a.PROJ[(size_t)(t - 3 + i) * ABN + C_XR + c]) : 0.f;
            acc += a.lru_conv_w[i * 512 + c] * xv;
        }
        sx[c] = acc;
    }
    __syncthreads();
    {
        const int grp = wid;
        const float v0 = sq[grp * 128 + lane], v1 = sq[grp * 128 + 64 + lane];
        const float s = wave_sum(v0 * v0 + v1 * v1);
        if (lane == 0) scl[grp] = rsqrtf(s + 1e-6f) * (grp < 4 ? 0.08838834764831845f : 1.0f);
    }
    __syncthreads();
    for (int c = tid; c < 1536; c += NTH) a.QKV[(size_t)t * 1536 + c] = (c < 1024) ? sq[c] * scl[c >> 7] : sq[c];
    if (tid < 4) {
        const float a_raw = bf2f(prow[C_A + tid]), b_raw = bf2f(prow[C_B + tid]);
        a.G[(size_t)t * 4 + tid] = -expf(a.a_log[tid]) * softplusf_(a_raw + a.dt_bias[tid]);
        a.BETA[(size_t)t * 4 + tid] = sigmoidf_(b_raw);
    }
    if (!samp) {
        if (pos >= SEQ - 3) {
            const int row = pos - (SEQ - 3);
            for (int c = tid; c < 1536; c += NTH) a.p_gdn_conv[((size_t)b * 3 + row) * 1536 + c] = bf2f(prow[C_QKV + c]);
            a.p_lru_conv[((size_t)b * 3 + row) * 512 + tid] = bf2f(prow[C_XR + tid]);
        }
    } else {
        for (int c = tid; c < 1536; c += NTH) {
            a.s_gdn_conv[((size_t)sb * 3 + 0) * 1536 + c] = a.st_gdn_conv[((size_t)sb * 3 + 1) * 1536 + c];
            a.s_gdn_conv[((size_t)sb * 3 + 1) * 1536 + c] = a.st_gdn_conv[((size_t)sb * 3 + 2) * 1536 + c];
            a.s_gdn_conv[((size_t)sb * 3 + 2) * 1536 + c] = bf2f(prow[C_QKV + c]);
        }
        {
            const int c = tid;
            a.s_lru_conv[((size_t)sb * 3 + 0) * 512 + c] = a.st_lru_conv[((size_t)sb * 3 + 1) * 512 + c];
            a.s_lru_conv[((size_t)sb * 3 + 1) * 512 + c] = a.st_lru_conv[((size_t)sb * 3 + 2) * 512 + c];
            a.s_lru_conv[((size_t)sb * 3 + 2) * 512 + c] = bf2f(prow[C_XR + c]);
        }
    }
    {
        const int c = tid, n = c >> 6, d = c & 63;
        float r = a.b_r[c], ii = a.b_i[c];
#pragma unroll 4
        for (int cc = 0; cc < 64; ++cc) {
            const float xv = sx[n * 64 + cc];
            r += xv * a.w_r[((size_t)n * 64 + cc) * 64 + d];
            ii += xv * a.w_i[((size_t)n * 64 + cc) * 64 + d];
        }
        r = sigmoidf_(r); ii = sigmoidf_(ii);
        const float log_a = -8.0f * r * softplusf_(-a.lam[c]);
        a.LA[(size_t)t * 512 + c] = expf(log_a);
        a.LB[(size_t)t * 512 + c] = sqrtf(-expm1f(2.0f * log_a)) * (ii * sx[c]);
    }
}

__device__ __forceinline__ void gdn_scan(const float* __restrict__ QKV, const float* __restrict__ G, const float* __restrict__ BETA,
                                         const float* __restrict__ S0, float* __restrict__ O, float* __restrict__ Sout, int tok_base, int T,
                                         int sl, int h, int sq, float* smem) {
    int tid = threadIdx.x; asm volatile("" : "+v"(tid));
    const int dvl = tid & 31, kg = tid >> 5;
    const int dv = sl * 32 + dvl;
    float (*red1)[32] = (float (*)[32])smem;
    float (*red2)[32] = (float (*)[32])(smem + 512);
    float S[8];
#pragma unroll
    for (int i = 0; i < 8; ++i) S[i] = S0 ? S0[(((size_t)sq * 4 + h) * 128 + kg * 8 + i) * 128 + dv] : 0.f;
    float kk[8], qq[8], vv, g, be;
    {
        const size_t tok = (size_t)tok_base + (size_t)sq * T;
        const float* row = QKV + tok * 1536;
#pragma unroll
        for (int i = 0; i < 8; ++i) { kk[i] = row[512 + h * 128 + kg * 8 + i]; qq[i] = row[h * 128 + kg * 8 + i]; }
        vv = row[1024 + h * 128 + dv]; g = G[tok * 4 + h]; be = BETA[tok * 4 + h];
    }
    for (int t = 0; t < T; ++t) {
        const size_t tok = (size_t)tok_base + (size_t)sq * T + t;
        float nk[8], nq[8], nv = 0.f, ng = 0.f, nb = 0.f;
        if (t + 1 < T) {
            const float* row = QKV + (tok + 1) * 1536;
#pragma unroll
            for (int i = 0; i < 8; ++i) { nk[i] = row[512 + h * 128 + kg * 8 + i]; nq[i] = row[h * 128 + kg * 8 + i]; }
            nv = row[1024 + h * 128 + dv]; ng = G[(tok + 1) * 4 + h]; nb = BETA[(tok + 1) * 4 + h];
        } else {
#pragma unroll
            for (int i = 0; i < 8; ++i) { nk[i] = 0.f; nq[i] = 0.f; }
        }
        const float al = expf(g);
        float p = 0.f;
#pragma unroll
        for (int i = 0; i < 8; ++i) { S[i] *= al; p += S[i] * kk[i]; }
        red1[kg][dvl] = p;
        __syncthreads();
        float ks = 0.f;
#pragma unroll
        for (int j = 0; j < 16; ++j) ks += red1[j][dvl];
        const float vn = be * (vv - ks);
        float o = 0.f;
#pragma unroll
        for (int i = 0; i < 8; ++i) { S[i] += kk[i] * vn; o += S[i] * qq[i]; }
        red2[kg][dvl] = o;
        __syncthreads();
        if (kg == 0) {
            float os = 0.f;
#pragma unroll
            for (int j = 0; j < 16; ++j) os += red2[j][dvl];
            O[tok * 512 + h * 128 + dv] = os;
        }
#pragma unroll
        for (int i = 0; i < 8; ++i) { kk[i] = nk[i]; qq[i] = nq[i]; }
        vv = nv; g = ng; be = nb;
    }
#pragma unroll
    for (int i = 0; i < 8; ++i) Sout[(((size_t)sq * 4 + h) * 128 + kg * 8 + i) * 128 + dv] = S[i];
}

__device__ __forceinline__ void lru_scan(const float* __restrict__ LA, float* __restrict__ LB, const float* __restrict__ h0,
                                         float* __restrict__ hlast, int tok_base, int T, int nseq, int bx) {
    int tx_ = threadIdx.x; asm volatile("" : "+v"(tx_));
    const int idx = bx * NTH + tx_;
    if (idx >= nseq * 512) return;
    const int sq = idx / 512, c = idx % 512;
    float h = h0 ? h0[(size_t)sq * 512 + c] : 0.f;
    const size_t base = ((size_t)tok_base + (size_t)sq * T) * 512 + c;
#pragma unroll 8
    for (int t = 0; t < T; ++t) {
        const size_t o = base + (size_t)t * 512;
        h = LA[o] * h + LB[o];
        LB[o] = h;
    }
    hlast[(size_t)sq * 512 + c] = h;
}

__device__ __forceinline__ void ab_mix(const bf16* __restrict__ PROJ, const float* __restrict__ O, const float* __restrict__ H, const float* __restrict__ P, const float* __restrict__ CIN,
                                       const float* __restrict__ norm_w, bf16* __restrict__ MIX, int vb) {
    int tx_ = threadIdx.x; asm volatile("" : "+v"(tx_));
    const int tid = tx_ & 255, lane = tid & 63, wid = tid >> 6, t = vb * 2 + (tx_ >> 8);
    const bf16* prow = PROJ + (size_t)t * ABN;
    {
        const int h = wid;
        const float o0 = O[(size_t)t * 512 + h * 128 + lane], o1 = O[(size_t)t * 512 + h * 128 + 64 + lane];
        const float ms = wave_sum(o0 * o0 + o1 * o1) * (1.0f / 128.0f);
        const float sc = rsqrtf(ms + 1e-6f);
        MIX[(size_t)t * 1024 + h * 128 + lane] = (bf16)f2bf(o0 * sc * norm_w[lane] * siluf_(bf2f(prow[C_Z + h * 128 + lane])));
        MIX[(size_t)t * 1024 + h * 128 + 64 + lane] = (bf16)f2bf(o1 * sc * norm_w[64 + lane] * siluf_(bf2f(prow[C_Z + h * 128 + 64 + lane])));
    }
    for (int c = tid; c < 512; c += 256) {
        float hv = H[(size_t)t * 512 + c];
        if (t < NP) hv += P[(size_t)t * 512 + c] * CIN[(size_t)(t >> 6) * 512 + c];
        MIX[(size_t)t * 1024 + 512 + c] = (bf16)f2bf(geluf_(bf2f(prow[C_GATE + c])) * hv);
    }
}

__device__ __forceinline__ void ln_res_w(const float* __restrict__ xrow, const bf16* __restrict__ yrow, const float* __restrict__ g, const float* __restrict__ bta,
                                         float* __restrict__ orow, bf16* __restrict__ obrow, int lane) {
    f32x4 v[4]; float s = 0.f;
#pragma unroll
    for (int j = 0; j < 4; ++j) { const f32x4 x4 = ((const f32x4*)xrow)[lane + 64 * j]; const v2u yb = ((const v2u*)yrow)[lane + 64 * j];
        const f32x4 y4 = (f32x4){bflo(yb.x), bfhi(yb.x), bflo(yb.y), bfhi(yb.y)}; v[j] = x4 * ALPHA + y4; s += (v[j].x + v[j].y) + (v[j].z + v[j].w); }
    const float mean = wave_sum(s) * (1.0f / 1024.0f); float q = 0.f;
#pragma unroll
    for (int j = 0; j < 4; ++j) { v[j] = v[j] - mean; q += (v[j].x * v[j].x + v[j].y * v[j].y) + (v[j].z * v[j].z + v[j].w * v[j].w); }
    const float rs = rsqrtf(wave_sum(q) * (1.0f / 1024.0f) + LN_EPS);
#pragma unroll
    for (int j = 0; j < 4; ++j) {
        const f32x4 g4 = ((const f32x4*)g)[lane + 64 * j], b4 = ((const f32x4*)bta)[lane + 64 * j];
        const f32x4 o = v[j] * rs * g4 + b4;
        ((f32x4*)orow)[lane + 64 * j] = o;
        v2u ob; ob.x = pk2(o.x, o.y); ob.y = pk2(o.z, o.w);
        ((v2u*)obrow)[lane + 64 * j] = ob;
    }
}

__device__ __forceinline__ void peer_topk(const bf16* __restrict__ Q, const float* __restrict__ keys, int* __restrict__ EXP, float* __restrict__ GATE,
                                          int tg, int h, float* smem) {
    const int tid = threadIdx.x, cn = tid & 255, c = cn >> 7, n = cn & 127, th = tid >> 8;
    float (*sq)[256] = (float (*)[256])smem;
    float (*ss)[257] = (float (*)[257])(smem + 32 * 256);
    float (*tvs)[2][16] = (float (*)[2][16])(smem + 32 * 256 + 32 * 257 + 32);
    int (*tis)[2][16] = (int (*)[2][16])(smem + 32 * 256 + 32 * 257 + 32 + 1024);
    for (int i = tid; i < 32 * 256; i += NTH) {
        const int tk = i >> 8, col = i & 255;
        sq[tk][col] = bf2f(Q[(size_t)(tg * 32 + tk) * 2048 + h * 256 + col]);
    }
    __syncthreads();
    float acc[16];
#pragma unroll
    for (int i = 0; i < 16; ++i) acc[i] = 0.f;
    const float* krow = keys + (((size_t)h * 2 + c) * 128 + n) * 128;
    for (int d4 = 0; d4 < 32; ++d4) {
        const float4 kv = *(const float4*)(krow + d4 * 4);
#pragma unroll
        for (int tk = 0; tk < 16; ++tk) {
            const float4 qv = *(const float4*)&sq[th * 16 + tk][c * 128 + d4 * 4];
            acc[tk] += qv.x * kv.x + qv.y * kv.y + qv.z * kv.z + qv.w * kv.w;
        }
    }
#pragma unroll
    for (int tk = 0; tk < 16; ++tk) ss[th * 16 + tk][cn] = acc[tk];
    __syncthreads();
    if (tid < 64) {
        const int tk = tid >> 1, cc = tid & 1;
        float tv[16]; int ti[16];
#pragma unroll
        for (int j = 0; j < 16; ++j) { tv[j] = -INFINITY; ti[j] = 0; }
        for (int nn = 0; nn < 128; ++nn) {
            float x = ss[tk][cc * 128 + nn]; int xi = nn;
#pragma unroll
            for (int j = 0; j < 16; ++j) {
                const bool gt = x > tv[j];
                const float tf = tv[j]; const int tj = ti[j];
                tv[j] = gt ? x : tf; ti[j] = gt ? xi : tj;
                x = gt ? tf : x; xi = gt ? tj : xi;
            }
        }
#pragma unroll
        for (int j = 0; j < 16; ++j) { tvs[tk][cc][j] = tv[j]; tis[tk][cc][j] = ti[j]; }
    }
    __syncthreads();
    if (tid < 32) {
        const int tk = tid;
        float bv[16]; int bi[16];
#pragma unroll
        for (int j = 0; j < 16; ++j) { bv[j] = -INFINITY; bi[j] = 0; }
        for (int i = 0; i < 16; ++i)
            for (int jj = 0; jj < 16; ++jj) {
                float x = tvs[tk][0][i] + tvs[tk][1][jj]; int xi = tis[tk][0][i] * 128 + tis[tk][1][jj];
#pragma unroll
                for (int j = 0; j < 16; ++j) {
                    const bool gt = x > bv[j];
                    const float tf = bv[j]; const int tj = bi[j];
                    bv[j] = gt ? x : tf; bi[j] = gt ? xi : tj;
                    x = gt ? tf : x; xi = gt ? tj : xi;
                }
            }
        float e[16], sum = 0.f;
#pragma unroll
        for (int j = 0; j < 16; ++j) { e[j] = expf(bv[j] - bv[0]); sum += e[j]; }
        const float inv = 1.0f / sum;
        const size_t o = (size_t)(tg * 32 + tk) * 128 + h * 16;
#pragma unroll
        for (int j = 0; j < 16; ++j) { EXP[o + j] = bi[j]; GATE[o + j] = e[j] * inv; }
    }
}

__device__ __forceinline__ void peer_expert(const float* __restrict__ X, const int* __restrict__ EXP, const float* __restrict__ GATE,
                                            const float* __restrict__ U, const float* __restrict__ V,
                                            const float* __restrict__ g, const float* __restrict__ bta, float* __restrict__ out, bf16* __restrict__ outb, int t, float* smem) {
    const int tid = threadIdx.x, lane = tid & 63, wid = tid >> 6;
    float (*accs)[1024] = (float (*)[1024])smem;
    float* sred = smem + 8192;
    const float4* xr = (const float4*)(X + (size_t)t * D);
    float4 xv[4];
#pragma unroll
    for (int j = 0; j < 4; ++j) xv[j] = xr[lane + 64 * j];
    float4 acc[4];
#pragma unroll
    for (int j = 0; j < 4; ++j) acc[j] = make_float4(0.f, 0.f, 0.f, 0.f);
    for (int e = 0; e < 16; ++e) {
        const int id = EXP[(size_t)t * 128 + wid * 16 + e];
        const float gt = GATE[(size_t)t * 128 + wid * 16 + e];
        const float4* ur = (const float4*)(U + (size_t)id * D);
        const float4* vr = (const float4*)(V + (size_t)id * D);
        float4 uv[4], vv[4];
#pragma unroll
        for (int j = 0; j < 4; ++j) { uv[j] = ur[lane + 64 * j]; vv[j] = vr[lane + 64 * j]; }
        float dot = 0.f;
#pragma unroll
        for (int j = 0; j < 4; ++j) dot += uv[j].x * xv[j].x + uv[j].y * xv[j].y + uv[j].z * xv[j].z + uv[j].w * xv[j].w;
        dot = wave_sum(dot);
        const float cf = gt * geluf_(dot);
#pragma unroll
        for (int j = 0; j < 4; ++j) { acc[j].x += cf * vv[j].x; acc[j].y += cf * vv[j].y; acc[j].z += cf * vv[j].z; acc[j].w += cf * vv[j].w; }
    }
#pragma unroll
    for (int j = 0; j < 4; ++j) *(float4*)&accs[wid][(lane + 64 * j) * 4] = acc[j];
    __syncthreads();
    float v[2];
#pragma unroll
    for (int i = 0; i < 2; ++i) {
        const int c = tid * 2 + i;
        float s = 0.f;
#pragma unroll
        for (int w = 0; w < 8; ++w) s += accs[w][c];
        v[i] = ALPHA * X[(size_t)t * D + c] + s;
    }
    float s = wave_sum(v[0] + v[1]);
    if (lane == 0) sred[wid] = s;
    __syncthreads();
    float mean = 0.f;
#pragma unroll
    for (int w = 0; w < 8; ++w) mean += sred[w];
    mean *= (1.0f / 1024.0f);
    __syncthreads();
    const float d0 = v[0] - mean, d1 = v[1] - mean;
    float q = wave_sum(d0 * d0 + d1 * d1);
    if (lane == 0) sred[wid] = q;
    __syncthreads();
    float var = 0.f;
#pragma unroll
    for (int w = 0; w < 8; ++w) var += sred[w];
    const float rs = rsqrtf(var * (1.0f / 1024.0f) + LN_EPS);
    const float o0 = d0 * rs * g[tid * 2] + bta[tid * 2], o1 = d1 * rs * g[tid * 2 + 1] + bta[tid * 2 + 1];
    *(float2*)(out + (size_t)t * D + tid * 2) = make_float2(o0, o1);
    if (outb) *(unsigned*)(outb + (size_t)t * D + tid * 2) = pk2(o0, o1);
}


typedef __bf16 bf16x2_t __attribute__((ext_vector_type(2)));
__device__ __forceinline__ float dot2bf(unsigned w, unsigned x, float acc) { return __builtin_amdgcn_fdot2_f32_bf16(__builtin_bit_cast(bf16x2_t, w), __builtin_bit_cast(bf16x2_t, x), acc, false); }
typedef float f32x2_t __attribute__((ext_vector_type(2)));
__device__ __forceinline__ void row_to_fp8(const float* __restrict__ xrow, unsigned char* __restrict__ orow, float* __restrict__ scale, int lane) {
    f32x4 v[4]; float am = 0.f;
#pragma unroll
    for (int j = 0; j < 4; ++j) { v[j] = *(const f32x4*)(xrow + lane * 16 + j * 4); am = fmaxf(am, fmaxf(fmaxf(fabsf(v[j].x), fabsf(v[j].y)), fmaxf(fabsf(v[j].z), fabsf(v[j].w)))); }
    am = wave_max(am);
    const float s = am > 0.f ? am * (1.0f / 448.0f) : 1.0f, inv = 1.0f / s;
    v4u o;
    unsigned w;
    w = 0u; w = __builtin_amdgcn_cvt_pk_fp8_f32(v[0].x * inv, v[0].y * inv, w, false); w = __builtin_amdgcn_cvt_pk_fp8_f32(v[0].z * inv, v[0].w * inv, w, true); o.x = w;
    w = 0u; w = __builtin_amdgcn_cvt_pk_fp8_f32(v[1].x * inv, v[1].y * inv, w, false); w = __builtin_amdgcn_cvt_pk_fp8_f32(v[1].z * inv, v[1].w * inv, w, true); o.y = w;
    w = 0u; w = __builtin_amdgcn_cvt_pk_fp8_f32(v[2].x * inv, v[2].y * inv, w, false); w = __builtin_amdgcn_cvt_pk_fp8_f32(v[2].z * inv, v[2].w * inv, w, true); o.z = w;
    w = 0u; w = __builtin_amdgcn_cvt_pk_fp8_f32(v[3].x * inv, v[3].y * inv, w, false); w = __builtin_amdgcn_cvt_pk_fp8_f32(v[3].z * inv, v[3].w * inv, w, true); o.w = w;
    *(v4u*)(orow + lane * 16) = o;
    if (lane == 0) *scale = s;
}
#define PE_LOAD(UB, VB, grp) do { _Pragma("unroll") for (int i_ = 0; i_ < 4; ++i_) { const int e_ = (grp) * 4 + i_; \
        const int id_ = __builtin_amdgcn_readlane(e_ < 64 ? id0 : id1, e_ & 63); \
        const unsigned so_ = (unsigned)id_ * 1024u; \
        UB[i_] = __builtin_amdgcn_raw_buffer_load_b128(ursrc, voff, so_, 0); VB[i_] = __builtin_amdgcn_raw_buffer_load_b128(vrsrc, voff, so_, 0); } } while (0)
#define PE_DOT4(w, k) do { const f32x2_t l_ = __builtin_amdgcn_cvt_pk_f32_fp8((w), false), h_ = __builtin_amdgcn_cvt_pk_f32_fp8((w), true); \
        a_ += l_.x * xv[(k) * 4 + 0]; b_ += l_.y * xv[(k) * 4 + 1]; a_ += h_.x * xv[(k) * 4 + 2]; b_ += h_.y * xv[(k) * 4 + 3]; } while (0)
#define PE_AXPY4(w, k) do { const f32x2_t l_ = __builtin_amdgcn_cvt_pk_f32_fp8((w), false), h_ = __builtin_amdgcn_cvt_pk_f32_fp8((w), true); \
        acc[(k) * 4 + 0] += cf_ * l_.x; acc[(k) * 4 + 1] += cf_ * l_.y; acc[(k) * 4 + 2] += cf_ * h_.x; acc[(k) * 4 + 3] += cf_ * h_.y; } while (0)
#define PE_COMP(UB, VB, grp) do { float d_[4]; \
        _Pragma("unroll") for (int i_ = 0; i_ < 4; ++i_) { float a_ = 0.f, b_ = 0.f; PE_DOT4(UB[i_].x, 0); PE_DOT4(UB[i_].y, 1); PE_DOT4(UB[i_].z, 2); PE_DOT4(UB[i_].w, 3); d_[i_] = a_ + b_; } \
          \
        float s0_ = hi32 ? d_[2] : d_[0], t0_ = hi32 ? d_[0] : d_[2]; s0_ += __shfl_xor(t0_, 32); \
        float s1_ = hi32 ? d_[3] : d_[1], t1_ = hi32 ? d_[1] : d_[3]; s1_ += __shfl_xor(t1_, 32); \
        float r_ = hi16 ? s1_ : s0_, t2_ = hi16 ? s0_ : s1_; r_ += __shfl_xor(t2_, 16); \
        r_ += __shfl_xor(r_, 8); r_ += __shfl_xor(r_, 4); r_ += __shfl_xor(r_, 2); r_ += __shfl_xor(r_, 1); \
          \
        const int esel_ = (grp) * 4 + (lane >> 4); \
        const float su_ = __shfl(esel_ < 64 ? su0 : su1, esel_ & 63), gv_ = __shfl(esel_ < 64 ? gs0 : gs1, esel_ & 63); \
        const float cfl_ = geluf_(r_ * su_) * gv_; \
        _Pragma("unroll") for (int i_ = 0; i_ < 4; ++i_) { \
            const float cf_ = __uint_as_float(__builtin_amdgcn_readlane(__float_as_uint(cfl_), 16 * i_)); \
            PE_AXPY4(VB[i_].x, 0); PE_AXPY4(VB[i_].y, 1); PE_AXPY4(VB[i_].z, 2); PE_AXPY4(VB[i_].w, 3); } } while (0)
__device__ __forceinline__ void peer_expert_w(const float* __restrict__ xrow, const int* __restrict__ exr, const float* __restrict__ gar,
                                              const unsigned char* __restrict__ U, const unsigned char* __restrict__ V, const float* __restrict__ SU, const float* __restrict__ SV,
                                              const float* __restrict__ g, const float* __restrict__ bta, float* __restrict__ orow, bf16* __restrict__ obrow, int lane) {
    const bool hi32 = (lane & 32) != 0, hi16 = (lane & 16) != 0;
    const __amdgpu_buffer_rsrc_t ursrc = __builtin_amdgcn_make_buffer_rsrc((void*)U, 0, 16384 * 1024, 0x00020000);
    const __amdgpu_buffer_rsrc_t vrsrc = __builtin_amdgcn_make_buffer_rsrc((void*)V, 0, 16384 * 1024, 0x00020000);
    const int voff = lane * 16;
    float xv[16];
#pragma unroll
    for (int j = 0; j < 4; ++j) { const f32x4 t = *(const f32x4*)(xrow + lane * 16 + j * 4); xv[j * 4 + 0] = t.x; xv[j * 4 + 1] = t.y; xv[j * 4 + 2] = t.z; xv[j * 4 + 3] = t.w; }
    const int id0 = exr[lane], id1 = exr[64 + lane];
    const float su0 = SU[id0], su1 = SU[id1];
    const float gs0 = gar[lane] * SV[id0], gs1 = gar[64 + lane] * SV[id1];
    float acc[16];
#pragma unroll
    for (int i = 0; i < 16; ++i) acc[i] = 0.f;
    v4u ua[4], va[4], ub[4], vb[4];
    PE_LOAD(ua, va, 0);
#pragma unroll 1
    for (int grp = 0; grp < 32; grp += 2) {
        PE_LOAD(ub, vb, grp + 1);
        PE_COMP(ua, va, grp);
        if (grp + 2 < 32) PE_LOAD(ua, va, grp + 2);
        PE_COMP(ub, vb, grp + 1);
    }
    float v[16]; float s = 0.f;
#pragma unroll
    for (int i = 0; i < 16; ++i) { v[i] = ALPHA * xv[i] + acc[i]; s += v[i]; }
    const float mean = wave_sum(s) * (1.0f / 1024.0f); float q = 0.f;
#pragma unroll
    for (int i = 0; i < 16; ++i) { v[i] -= mean; q += v[i] * v[i]; }
    const float rs = rsqrtf(wave_sum(q) * (1.0f / 1024.0f) + LN_EPS);
    float o[16];
#pragma unroll
    for (int j = 0; j < 4; ++j) {
        const f32x4 g4 = *(const f32x4*)(g + lane * 16 + j * 4), b4 = *(const f32x4*)(bta + lane * 16 + j * 4);
        o[j * 4 + 0] = v[j * 4 + 0] * rs * g4.x + b4.x; o[j * 4 + 1] = v[j * 4 + 1] * rs * g4.y + b4.y; o[j * 4 + 2] = v[j * 4 + 2] * rs * g4.z + b4.z; o[j * 4 + 3] = v[j * 4 + 3] * rs * g4.w + b4.w;
        *(f32x4*)(orow + lane * 16 + j * 4) = (f32x4){o[j * 4 + 0], o[j * 4 + 1], o[j * 4 + 2], o[j * 4 + 3]};
    }
    if (obrow) {
        v4u w0, w1; w0.x = pk2(o[0], o[1]); w0.y = pk2(o[2], o[3]); w0.z = pk2(o[4], o[5]); w0.w = pk2(o[6], o[7]); w1.x = pk2(o[8], o[9]); w1.y = pk2(o[10], o[11]); w1.z = pk2(o[12], o[13]); w1.w = pk2(o[14], o[15]);
        *(v4u*)(obrow + lane * 16) = w0; *(v4u*)(obrow + lane * 16 + 8) = w1;
    }
}


__device__ __forceinline__ void peer_expert_blk(const float* __restrict__ xrow, const int* __restrict__ exr, const float* __restrict__ gar,
                                                const unsigned char* __restrict__ U, const unsigned char* __restrict__ V, const float* __restrict__ SU, const float* __restrict__ SV,
                                                const float* __restrict__ g, const float* __restrict__ bta, float* __restrict__ orow, bf16* __restrict__ obrow, int lane, int wave, float* smem) {
    const bool hi32 = (lane & 32) != 0, hi16 = (lane & 16) != 0;
    const __amdgpu_buffer_rsrc_t ursrc = __builtin_amdgcn_make_buffer_rsrc((void*)U, 0, 16384 * 1024, 0x00020000);
    const __amdgpu_buffer_rsrc_t vrsrc = __builtin_amdgcn_make_buffer_rsrc((void*)V, 0, 16384 * 1024, 0x00020000);
    const int voff = lane * 16;
    float xv[16];
#pragma unroll
    for (int j = 0; j < 4; ++j) { const f32x4 t = *(const f32x4*)(xrow + lane * 16 + j * 4); xv[j * 4 + 0] = t.x; xv[j * 4 + 1] = t.y; xv[j * 4 + 2] = t.z; xv[j * 4 + 3] = t.w; }
    const int id0 = exr[lane], id1 = exr[64 + lane];
    const float su0 = SU[id0], su1 = SU[id1];
    const float gs0 = gar[lane] * SV[id0], gs1 = gar[64 + lane] * SV[id1];
    float acc[16];
#pragma unroll
    for (int i = 0; i < 16; ++i) acc[i] = 0.f;
    v4u ua[4], va[4], ub[4], vb[4];
    const int g0 = wave * 4;
    PE_LOAD(ua, va, g0); PE_LOAD(ub, vb, g0 + 1);
    PE_COMP(ua, va, g0); PE_LOAD(ua, va, g0 + 2);
    PE_COMP(ub, vb, g0 + 1); PE_LOAD(ub, vb, g0 + 3);
    PE_COMP(ua, va, g0 + 2);
    PE_COMP(ub, vb, g0 + 3);
    float* accs = smem;
    float* sred = smem + 8192;
#pragma unroll
    for (int j = 0; j < 4; ++j) *(f32x4*)(accs + wave * 1024 + lane * 16 + j * 4) = (f32x4){acc[j * 4 + 0], acc[j * 4 + 1], acc[j * 4 + 2], acc[j * 4 + 3]};
    __syncthreads();
    const int tid = wave * 64 + lane;
    float v0 = ALPHA * xrow[tid * 2], v1 = ALPHA * xrow[tid * 2 + 1];
#pragma unroll
    for (int w = 0; w < 8; ++w) { v0 += accs[w * 1024 + tid * 2]; v1 += accs[w * 1024 + tid * 2 + 1]; }
    const float s = wave_sum(v0 + v1);
    if (lane == 0) sred[wave] = s;
    __syncthreads();
    float mean = 0.f;
#pragma unroll
    for (int w = 0; w < 8; ++w) mean += sred[w];
    mean *= (1.0f / 1024.0f);
    __syncthreads();
    const float d0 = v0 - mean, d1 = v1 - mean;
    const float q = wave_sum(d0 * d0 + d1 * d1);
    if (lane == 0) sred[wave] = q;
    __syncthreads();
    float var = 0.f;
#pragma unroll
    for (int w = 0; w < 8; ++w) var += sred[w];
    const float rs = rsqrtf(var * (1.0f / 1024.0f) + LN_EPS);
    const float o0 = d0 * rs * g[tid * 2] + bta[tid * 2], o1 = d1 * rs * g[tid * 2 + 1] + bta[tid * 2 + 1];
    *(float2*)(orow + tid * 2) = make_float2(o0, o1);
    if (obrow) *(unsigned*)(obrow + tid * 2) = pk2(o0, o1);
    __syncthreads();
}

__device__ __forceinline__ void row_to_fp8_sliced(const float* __restrict__ xrow, unsigned char* __restrict__ tab, int r, float* __restrict__ scale, int lane) {
    f32x4 v[4]; float am = 0.f;
#pragma unroll
    for (int j = 0; j < 4; ++j) { v[j] = *(const f32x4*)(xrow + lane * 16 + j * 4); am = fmaxf(am, fmaxf(fmaxf(fabsf(v[j].x), fabsf(v[j].y)), fmaxf(fabsf(v[j].z), fabsf(v[j].w)))); }
    am = wave_max(am);
    const float s = am > 0.f ? am * (1.0f / 448.0f) : 1.0f, inv = 1.0f / s;
    v4u o; unsigned w;
    w = 0u; w = __builtin_amdgcn_cvt_pk_fp8_f32(v[0].x * inv, v[0].y * inv, w, false); w = __builtin_amdgcn_cvt_pk_fp8_f32(v[0].z * inv, v[0].w * inv, w, true); o.x = w;
    w = 0u; w = __builtin_amdgcn_cvt_pk_fp8_f32(v[1].x * inv, v[1].y * inv, w, false); w = __builtin_amdgcn_cvt_pk_fp8_f32(v[1].z * inv, v[1].w * inv, w, true); o.y = w;
    w = 0u; w = __builtin_amdgcn_cvt_pk_fp8_f32(v[2].x * inv, v[2].y * inv, w, false); w = __builtin_amdgcn_cvt_pk_fp8_f32(v[2].z * inv, v[2].w * inv, w, true); o.z = w;
    w = 0u; w = __builtin_amdgcn_cvt_pk_fp8_f32(v[3].x * inv, v[3].y * inv, w, false); w = __builtin_amdgcn_cvt_pk_fp8_f32(v[3].z * inv, v[3].w * inv, w, true); o.w = w;
    *(v4u*)(tab + ((size_t)(lane >> 3) * 16384 + r) * 128 + (lane & 7) * 16) = o;
    if (lane == 0) *scale = s;
}
__device__ __forceinline__ void peer_u_pass(const float* __restrict__ xrow, const int* __restrict__ exr, const unsigned char* __restrict__ U8x, float* __restrict__ pd, int x, int lane) {
    const int e8 = lane >> 3, c = lane & 7;
    f32x2_t xp[8];
#pragma unroll
    for (int j = 0; j < 4; ++j) { const f32x4 t = *(const f32x4*)(xrow + x * 128 + c * 16 + j * 4); xp[j * 2] = (f32x2_t){t.x, t.y}; xp[j * 2 + 1] = (f32x2_t){t.z, t.w}; }
    const __amdgpu_buffer_rsrc_t ursrc = __builtin_amdgcn_make_buffer_rsrc((void*)U8x, 0, 16384 * 128, 0x00020000);
    v4u wa[8], wb[8];
    float d[16];
    int ids[16];
#pragma unroll
    for (int j = 0; j < 4; ++j) { const v4u t = *(const v4u*)(exr + e8 * 16 + j * 4); ids[j * 4 + 0] = (int)t.x; ids[j * 4 + 1] = (int)t.y; ids[j * 4 + 2] = (int)t.z; ids[j * 4 + 3] = (int)t.w; }
#pragma unroll
    for (int g = 0; g < 8; ++g) wa[g] = __builtin_amdgcn_raw_buffer_load_b128(ursrc, ids[g] * 128 + c * 16, 0, 0);
#pragma unroll
    for (int g = 0; g < 8; ++g) wb[g] = __builtin_amdgcn_raw_buffer_load_b128(ursrc, ids[8 + g] * 128 + c * 16, 0, 0);
#define PU_DOT1(w_, k_) do { a_ = __builtin_elementwise_fma(__builtin_amdgcn_cvt_pk_f32_fp8((w_), false), xp[(k_) * 2], a_); a_ = __builtin_elementwise_fma(__builtin_amdgcn_cvt_pk_f32_fp8((w_), true), xp[(k_) * 2 + 1], a_); } while (0)
#pragma unroll
    for (int g = 0; g < 8; ++g) { f32x2_t a_ = (f32x2_t){0.f, 0.f}; PU_DOT1(wa[g].x, 0); PU_DOT1(wa[g].y, 1); PU_DOT1(wa[g].z, 2); PU_DOT1(wa[g].w, 3); d[g] = a_.x + a_.y; }
#pragma unroll
    for (int g = 0; g < 8; ++g) { f32x2_t a_ = (f32x2_t){0.f, 0.f}; PU_DOT1(wb[g].x, 0); PU_DOT1(wb[g].y, 1); PU_DOT1(wb[g].z, 2); PU_DOT1(wb[g].w, 3); d[8 + g] = a_.x + a_.y; }
#pragma unroll
    for (int g = 0; g < 16; ++g) { d[g] += DPPF(d[g], 0xB1, 0xf); d[g] += DPPF(d[g], 0x4E, 0xf); d[g] += DPPF(d[g], 0x141, 0xf); }
    if (c == 0) {
#pragma unroll
        for (int j = 0; j < 4; ++j) *(f32x4*)(pd + e8 * 16 + j * 4) = (f32x4){d[j * 4 + 0], d[j * 4 + 1], d[j * 4 + 2], d[j * 4 + 3]};
    }
}
#define PV_LOAD(VB, grp) do { _Pragma("unroll") for (int i_ = 0; i_ < 4; ++i_) { const int e_ = (grp) * 4 + i_; \
        const int id_ = __builtin_amdgcn_readlane(e_ < 64 ? id0 : id1, e_ & 63); \
        VB[i_] = __builtin_amdgcn_raw_buffer_load_b128(vrsrc, voff, (unsigned)id_ * 1024u, 0); } } while (0)
#define PV_COMP(VB, grp) do { _Pragma("unroll") for (int i_ = 0; i_ < 4; ++i_) { const int e_ = (grp) * 4 + i_; \
        const float cf_ = __uint_as_float(__builtin_amdgcn_readlane(__float_as_uint(e_ < 64 ? cf0 : cf1), e_ & 63)); \
        PE_AXPY4(VB[i_].x, 0); PE_AXPY4(VB[i_].y, 1); PE_AXPY4(VB[i_].z, 2); PE_AXPY4(VB[i_].w, 3); } } while (0)
#define PV_COEFS() \
    const int id0 = exr[lane], id1 = exr[64 + lane]; \
    float dot0 = 0.f, dot1 = 0.f; \
    { const int p0 = lane, p1 = 64 + lane;        \
      _Pragma("unroll") for (int x_ = 0; x_ < 8; ++x_) { dot0 += pdt[(size_t)x_ * NT * 128 + p0]; dot1 += pdt[(size_t)x_ * NT * 128 + p1]; } } \
    const float cf0 = gar[lane] * SV[id0] * geluf_(SU[id0] * dot0), cf1 = gar[64 + lane] * SV[id1] * geluf_(SU[id1] * dot1);
__device__ __forceinline__ void peer_v_w(const float* __restrict__ xrow, const int* __restrict__ exr, const float* __restrict__ gar, const float* __restrict__ pdt,
                                         const unsigned char* __restrict__ V, const float* __restrict__ SU, const float* __restrict__ SV,
                                         const float* __restrict__ g, const float* __restrict__ bta, float* __restrict__ orow, bf16* __restrict__ obrow, int lane) {
    const __amdgpu_buffer_rsrc_t vrsrc = __builtin_amdgcn_make_buffer_rsrc((void*)V, 0, 16384 * 1024, 0x00020000);
    const int voff = lane * 16;
    PV_COEFS()
    float acc[16];
#pragma unroll
    for (int i = 0; i < 16; ++i) acc[i] = 0.f;
    v4u va[4], vb[4], vc[4];
    PV_LOAD(va, 0); PV_LOAD(vb, 1);
#pragma unroll 1
    for (int grp = 0; grp < 30; grp += 3) {
        PV_LOAD(vc, grp + 2);
        PV_COMP(va, grp);
        PV_LOAD(va, grp + 3);
        PV_COMP(vb, grp + 1);
        PV_LOAD(vb, grp + 4);
        PV_COMP(vc, grp + 2);
    }
    PV_COMP(va, 30); PV_COMP(vb, 31);
    float xv[16];
#pragma unroll
    for (int j = 0; j < 4; ++j) { const f32x4 t = *(const f32x4*)(xrow + lane * 16 + j * 4); xv[j * 4 + 0] = t.x; xv[j * 4 + 1] = t.y; xv[j * 4 + 2] = t.z; xv[j * 4 + 3] = t.w; }
    float v[16]; float s = 0.f;
#pragma unroll
    for (int i = 0; i < 16; ++i) { v[i] = ALPHA * xv[i] + acc[i]; s += v[i]; }
    const float mean = wave_sum(s) * (1.0f / 1024.0f); float q = 0.f;
#pragma unroll
    for (int i = 0; i < 16; ++i) { v[i] -= mean; q += v[i] * v[i]; }
    const float rs = rsqrtf(wave_sum(q) * (1.0f / 1024.0f) + LN_EPS);
    float o[16];
#pragma unroll
    for (int j = 0; j < 4; ++j) {
        const f32x4 g4 = *(const f32x4*)(g + lane * 16 + j * 4), b4 = *(const f32x4*)(bta + lane * 16 + j * 4);
        o[j * 4 + 0] = v[j * 4 + 0] * rs * g4.x + b4.x; o[j * 4 + 1] = v[j * 4 + 1] * rs * g4.y + b4.y; o[j * 4 + 2] = v[j * 4 + 2] * rs * g4.z + b4.z; o[j * 4 + 3] = v[j * 4 + 3] * rs * g4.w + b4.w;
        *(f32x4*)(orow + lane * 16 + j * 4) = (f32x4){o[j * 4 + 0], o[j * 4 + 1], o[j * 4 + 2], o[j * 4 + 3]};
    }
    if (obrow) {
        v4u w0, w1; w0.x = pk2(o[0], o[1]); w0.y = pk2(o[2], o[3]); w0.z = pk2(o[4], o[5]); w0.w = pk2(o[6], o[7]); w1.x = pk2(o[8], o[9]); w1.y = pk2(o[10], o[11]); w1.z = pk2(o[12], o[13]); w1.w = pk2(o[14], o[15]);
        *(v4u*)(obrow + lane * 16) = w0; *(v4u*)(obrow + lane * 16 + 8) = w1;
    }
}
__device__ __forceinline__ void peer_v_blk(const float* __restrict__ xrow, const int* __restrict__ exr, const float* __restrict__ gar, const float* __restrict__ pdt,
                                           const unsigned char* __restrict__ V, const float* __restrict__ SU, const float* __restrict__ SV,
                                           const float* __restrict__ g, const float* __restrict__ bta, float* __restrict__ orow, bf16* __restrict__ obrow, int lane, int wave, float* smem) {
    const __amdgpu_buffer_rsrc_t vrsrc = __builtin_amdgcn_make_buffer_rsrc((void*)V, 0, 16384 * 1024, 0x00020000);
    const int voff = lane * 16;
    PV_COEFS()
    float acc[16];
#pragma unroll
    for (int i = 0; i < 16; ++i) acc[i] = 0.f;
    v4u va[4], vb[4], vc[4], vd[4];
    PV_LOAD(va, wave * 4); PV_LOAD(vb, wave * 4 + 1); PV_LOAD(vc, wave * 4 + 2); PV_LOAD(vd, wave * 4 + 3);
    PV_COMP(va, wave * 4); PV_COMP(vb, wave * 4 + 1); PV_COMP(vc, wave * 4 + 2); PV_COMP(vd, wave * 4 + 3);
    float* accs = smem;
    float* sred = smem + 8192;
#pragma unroll
    for (int j = 0; j < 4; ++j) *(f32x4*)(accs + wave * 1024 + lane * 16 + j * 4) = (f32x4){acc[j * 4 + 0], acc[j * 4 + 1], acc[j * 4 + 2], acc[j * 4 + 3]};
    __syncthreads();
    const int tid = wave * 64 + lane;
    float v0 = ALPHA * xrow[tid * 2], v1 = ALPHA * xrow[tid * 2 + 1];
#pragma unroll
    for (int w = 0; w < 8; ++w) { v0 += accs[w * 1024 + tid * 2]; v1 += accs[w * 1024 + tid * 2 + 1]; }
    const float s = wave_sum(v0 + v1);
    if (lane == 0) sred[wave] = s;
    __syncthreads();
    float mean = 0.f;
#pragma unroll
    for (int w = 0; w < 8; ++w) mean += sred[w];
    mean *= (1.0f / 1024.0f);
    __syncthreads();
    const float d0 = v0 - mean, d1 = v1 - mean;
    const float q = wave_sum(d0 * d0 + d1 * d1);
    if (lane == 0) sred[wave] = q;
    __syncthreads();
    float var = 0.f;
#pragma unroll
    for (int w = 0; w < 8; ++w) var += sred[w];
    const float rs = rsqrtf(var * (1.0f / 1024.0f) + LN_EPS);
    const float o0 = d0 * rs * g[tid * 2] + bta[tid * 2], o1 = d1 * rs * g[tid * 2 + 1] + bta[tid * 2 + 1];
    *(float2*)(orow + tid * 2) = make_float2(o0, o1);
    if (obrow) *(unsigned*)(obrow + tid * 2) = pk2(o0, o1);
    __syncthreads();
}

__device__ __forceinline__ void peer_xk(const int* __restrict__ exr, float* __restrict__ gar, const float* __restrict__ pdt, const float* __restrict__ SU, const float* __restrict__ SV, int lane) {
    PV_COEFS()
    gar[lane] = cf0; gar[64 + lane] = cf1;
}
__device__ __forceinline__ void peer_v_slice(const int* __restrict__ exr, const float* __restrict__ cfr, const unsigned char* __restrict__ V8x, float* __restrict__ outs  , int lane) {
    const int e8 = lane >> 3, c = lane & 7;
    const __amdgpu_buffer_rsrc_t vrsrc = __builtin_amdgcn_make_buffer_rsrc((void*)V8x, 0, 16384 * 128, 0x00020000);
    v4u wa[8], wb[8]; float cfa[8], cfb[8];
    int ids[16];
#pragma unroll
    for (int j = 0; j < 4; ++j) { const v4u t = *(const v4u*)(exr + e8 * 16 + j * 4); ids[j * 4 + 0] = (int)t.x; ids[j * 4 + 1] = (int)t.y; ids[j * 4 + 2] = (int)t.z; ids[j * 4 + 3] = (int)t.w; }
#pragma unroll
    for (int g = 0; g < 8; ++g) wa[g] = __builtin_amdgcn_raw_buffer_load_b128(vrsrc, ids[g] * 128 + c * 16, 0, 0);
#pragma unroll
    for (int g = 0; g < 8; ++g) wb[g] = __builtin_amdgcn_raw_buffer_load_b128(vrsrc, ids[8 + g] * 128 + c * 16, 0, 0);
#pragma unroll
    for (int j = 0; j < 2; ++j) { const f32x4 t = *(const f32x4*)(cfr + e8 * 16 + j * 4), u = *(const f32x4*)(cfr + e8 * 16 + 8 + j * 4);
        cfa[j * 4 + 0] = t.x; cfa[j * 4 + 1] = t.y; cfa[j * 4 + 2] = t.z; cfa[j * 4 + 3] = t.w; cfb[j * 4 + 0] = u.x; cfb[j * 4 + 1] = u.y; cfb[j * 4 + 2] = u.z; cfb[j * 4 + 3] = u.w; }
    f32x2_t ap[8];
#pragma unroll
    for (int i = 0; i < 8; ++i) ap[i] = (f32x2_t){0.f, 0.f};
#define PVS_AXPY(w_, k_) do { ap[(k_) * 2] = __builtin_elementwise_fma(cf2_, __builtin_amdgcn_cvt_pk_f32_fp8((w_), false), ap[(k_) * 2]); ap[(k_) * 2 + 1] = __builtin_elementwise_fma(cf2_, __builtin_amdgcn_cvt_pk_f32_fp8((w_), true), ap[(k_) * 2 + 1]); } while (0)
#pragma unroll
    for (int g = 0; g < 8; ++g) { const f32x2_t cf2_ = (f32x2_t){cfa[g], cfa[g]}; PVS_AXPY(wa[g].x, 0); PVS_AXPY(wa[g].y, 1); PVS_AXPY(wa[g].z, 2); PVS_AXPY(wa[g].w, 3); }
#pragma unroll
    for (int g = 0; g < 8; ++g) { const f32x2_t cf2_ = (f32x2_t){cfb[g], cfb[g]}; PVS_AXPY(wb[g].x, 0); PVS_AXPY(wb[g].y, 1); PVS_AXPY(wb[g].z, 2); PVS_AXPY(wb[g].w, 3); }
#undef PVS_AXPY
    float acc[16];
#pragma unroll
    for (int i = 0; i < 8; ++i) { acc[2 * i] = ap[i].x; acc[2 * i + 1] = ap[i].y; }
#pragma unroll
    for (int i = 0; i < 16; ++i) { float v = acc[i]; v += DPPF(v, 0x128, 0xf); v += __shfl_xor(v, 16); v += __shfl_xor(v, 32); acc[i] = v; }
    if (e8 == 0) {
#pragma unroll
        for (int j = 0; j < 4; ++j) *(f32x4*)(outs + c * 16 + j * 4) = (f32x4){acc[j * 4 + 0], acc[j * 4 + 1], acc[j * 4 + 2], acc[j * 4 + 3]};
    }
}
__device__ __forceinline__ void peer_xc(const float* __restrict__ xrow, const float* __restrict__ srow, const float* __restrict__ g, const float* __restrict__ bta, float* __restrict__ orow, bf16* __restrict__ obrow, int lane) {
    float v[16]; float s = 0.f;
#pragma unroll
    for (int j = 0; j < 4; ++j) { const f32x4 a = *(const f32x4*)(xrow + lane * 16 + j * 4), b = *(const f32x4*)(srow + lane * 16 + j * 4);
        v[j * 4 + 0] = ALPHA * a.x + b.x; v[j * 4 + 1] = ALPHA * a.y + b.y; v[j * 4 + 2] = ALPHA * a.z + b.z; v[j * 4 + 3] = ALPHA * a.w + b.w; }
#pragma unroll
    for (int i = 0; i < 16; ++i) s += v[i];
    const float mean = wave_sum(s) * (1.0f / 1024.0f); float q = 0.f;
#pragma unroll
    for (int i = 0; i < 16; ++i) { v[i] -= mean; q += v[i] * v[i]; }
    const float rs = rsqrtf(wave_sum(q) * (1.0f / 1024.0f) + LN_EPS);
    float o[16];
#pragma unroll
    for (int j = 0; j < 4; ++j) {
        const f32x4 g4 = *(const f32x4*)(g + lane * 16 + j * 4), b4 = *(const f32x4*)(bta + lane * 16 + j * 4);
        o[j * 4 + 0] = v[j * 4 + 0] * rs * g4.x + b4.x; o[j * 4 + 1] = v[j * 4 + 1] * rs * g4.y + b4.y; o[j * 4 + 2] = v[j * 4 + 2] * rs * g4.z + b4.z; o[j * 4 + 3] = v[j * 4 + 3] * rs * g4.w + b4.w;
        *(f32x4*)(orow + lane * 16 + j * 4) = (f32x4){o[j * 4 + 0], o[j * 4 + 1], o[j * 4 + 2], o[j * 4 + 3]};
    }
    if (obrow) {
        v4u w0, w1; w0.x = pk2(o[0], o[1]); w0.y = pk2(o[2], o[3]); w0.z = pk2(o[4], o[5]); w0.w = pk2(o[6], o[7]); w1.x = pk2(o[8], o[9]); w1.y = pk2(o[10], o[11]); w1.z = pk2(o[12], o[13]); w1.w = pk2(o[14], o[15]);
        *(v4u*)(obrow + lane * 16) = w0; *(v4u*)(obrow + lane * 16 + 8) = w1;
    }
}

__device__ __forceinline__ int t5_bucket(int n) {
    if (n < 16) return n;
    const int large = 16 + (int)(logf((float)n / 16.0f) / 2.0794415416798357f * 16.0f);
    return large < 31 ? large : 31;
}
__device__ __forceinline__ void swa_attn(const float* __restrict__ PC, const float* __restrict__ cache_k, const float* __restrict__ cache_v,
                                         const float* __restrict__ rel_bias, const float* __restrict__ sinks, bf16* __restrict__ ATT, int bx) {
    const int tid = threadIdx.x, lane = tid & 63, wid = tid >> 6;
    const int gw = bx * 8 + wid;
    const int t = gw >> 4, h = gw & 15, kvh = h >> 2;
    if (t >= NT) return;
    const bool samp = t >= NP; const int sb = t - NP, pos = t % SEQ;
    const float* qrow = PC + (size_t)t * CN + h * 64;
    float lg[2]; bool valid[2];
#pragma unroll
    for (int rr = 0; rr < 2; ++rr) {
        const int r = lane + 64 * rr;
        const float* krow;
        if (!samp) { valid[rr] = (pos - r) >= 0; krow = PC + (size_t)(valid[rr] ? t - r : t) * CN + 1024 + kvh * 64; }
        else { valid[rr] = true; krow = (r == 0) ? PC + (size_t)t * CN + 1024 + kvh * 64 : cache_k + (((size_t)sb * 128 + (128 - r)) * 4 + kvh) * 64; }
        float dot = 0.f;
#pragma unroll
        for (int d4 = 0; d4 < 16; ++d4) {
            const float4 kv = *(const float4*)(krow + d4 * 4);
            const float4 qv = *(const float4*)(qrow + d4 * 4);
            dot += qv.x * kv.x + qv.y * kv.y + qv.z * kv.z + qv.w * kv.w;
        }
        lg[rr] = valid[rr] ? dot * 0.125f + rel_bias[t5_bucket(r) * 16 + h] : -INFINITY;
    }
    const float sink = sinks[h];
    const float m = fmaxf(wave_max(fmaxf(lg[0], lg[1])), sink);
    float p[2];
#pragma unroll
    for (int rr = 0; rr < 2; ++rr) p[rr] = valid[rr] ? expf(lg[rr] - m) : 0.f;
    const float den = wave_sum(p[0] + p[1]) + expf(sink - m);
    const float inv = 1.0f / den;
    float o = 0.f;
#pragma unroll
    for (int rr = 0; rr < 2; ++rr)
        for (int l2 = 0; l2 < 64; ++l2) {
            const int r = l2 + 64 * rr;
            const float pj = __shfl(p[rr], l2);
            if (pj != 0.f) {
                const float* vrow;
                if (!samp) vrow = PC + (size_t)(t - r) * CN + 1280 + kvh * 64;
                else vrow = (r == 0) ? PC + (size_t)t * CN + 1280 + kvh * 64 : cache_v + (((size_t)sb * 128 + (128 - r)) * 4 + kvh) * 64;
                o += pj * vrow[lane];
            }
        }
    ATT[(size_t)t * D + h * 64 + lane] = (bf16)f2bf(o * inv);
}

__device__ __forceinline__ void swa_kv_out(const float* __restrict__ PC, const float* __restrict__ cache_k, const float* __restrict__ cache_v,
                                           float* __restrict__ pk, float* __restrict__ pv, float* __restrict__ sk, float* __restrict__ sv, int vb) {
    const int c = threadIdx.x & 255, row = vb * 2 + (threadIdx.x >> 8);
    if (row < NB * 128) {
        const int b = row >> 7, i = row & 127;
        const float* src = PC + (size_t)(b * SEQ + SEQ - 128 + i) * CN;
        pk[(size_t)row * 256 + c] = src[1024 + c];
        pv[(size_t)row * 256 + c] = src[1280 + c];
    } else {
        const int r2 = row - NB * 128, sb = r2 >> 7, i = r2 & 127;
        if (i < 127) {
            sk[(size_t)r2 * 256 + c] = cache_k[((size_t)sb * 128 + i + 1) * 256 + c];
            sv[(size_t)r2 * 256 + c] = cache_v[((size_t)sb * 128 + i + 1) * 256 + c];
        } else {
            const float* src = PC + (size_t)(NP + sb) * CN;
            sk[(size_t)r2 * 256 + c] = src[1024 + c];
            sv[(size_t)r2 * 256 + c] = src[1280 + c];
        }
    }
}
#define XB_TMO      128
#define XB_XCNT(j)  (256  + 64 * (j))
#define XB_XSUB(j)  (1280 + 64 * (j))
#define XB_XGEN(j)  (2304 + 64 * (j))
#define XB_TOP      3328
#define XB_TOPGEN   3392
#define XCD_BAR_WORDS 3456
#define XB_SPIN_CAP (1u << 18)

__device__ __forceinline__ unsigned xb_ld(unsigned* p)              { return __hip_atomic_load(p, __ATOMIC_RELAXED, __HIP_MEMORY_SCOPE_AGENT); }
__device__ __forceinline__ unsigned xb_add(unsigned* p, unsigned v) { return __hip_atomic_fetch_add(p, v, __ATOMIC_RELAXED, __HIP_MEMORY_SCOPE_AGENT); }
__device__ __forceinline__ unsigned xb_xcc_id() { return (unsigned)__builtin_amdgcn_s_getreg((3 << 11) | 20) & 0xFu; }
#define XB_SPIN(cond, bar) do { unsigned _sp = 0; while (cond) { __builtin_amdgcn_s_sleep(1); \
    if ((++_sp & 255u) == 0u) { if (xb_ld(&(bar)[XB_TMO])) break; if (_sp > XB_SPIN_CAP) { atomicAdd(&(bar)[XB_TMO], 1u); break; } } } } while (0)

struct XcdBarrier {
    unsigned* bar; unsigned x;
    volatile LAS unsigned* st;
};

__device__ __forceinline__ XcdBarrier xcd_barrier_post(unsigned* bar, volatile LAS unsigned* st) {
    XcdBarrier b; b.bar = bar; b.x = xb_xcc_id(); b.st = st;
    if (threadIdx.x == 0) (void)xb_add(&bar[XB_XCNT(b.x)], 1u);
    return b;
}
__device__ __forceinline__ void xcd_barrier_complete(unsigned* bar, unsigned x, unsigned& nloc, unsigned& nx) {
    const unsigned G = gridDim.x * gridDim.y * gridDim.z;
    unsigned sum, cnt, mine, sp = 0u;
    for (;;) {
        sum = 0u; cnt = 0u; mine = 0u;
#pragma unroll
        for (unsigned j = 0; j < 16; ++j) { const unsigned c = xb_ld(&bar[XB_XCNT(j)]); sum += c; cnt += (c > 0u) ? 1u : 0u; mine = (j == x) ? c : mine; }
        if (sum == G) break;
        __builtin_amdgcn_s_sleep(1);
        if ((++sp & 255u) == 0u) { if (xb_ld(&bar[XB_TMO])) break; if (sp > XB_SPIN_CAP) { atomicAdd(&bar[XB_TMO], 1u); break; } }
    }
    nloc = mine > 0u ? mine : 1u; nx = cnt > 0u ? cnt : 1u;
}

__device__ __forceinline__ void xcd_barrier(const XcdBarrier& b) {
    asm volatile("s_waitcnt vmcnt(0)" ::: "memory");
    __syncthreads();
    if (threadIdx.x == 0) {
        unsigned* bar = b.bar;
        __builtin_amdgcn_s_waitcnt(0);
        unsigned nloc = b.st[0], nx = b.st[1];
        if (nloc == 0u) { xcd_barrier_complete(bar, b.x, nloc, nx); b.st[0] = nloc; b.st[1] = nx; }
        const unsigned old = xb_add(&bar[XB_XSUB(b.x)], 1u);
        const unsigned gen = old / nloc;
        if (old + 1u == (gen + 1u) * nloc) {
            __builtin_amdgcn_fence(__ATOMIC_RELEASE, "agent");
            asm volatile("s_waitcnt vmcnt(0)" ::: "memory");
            const unsigned og = xb_add(&bar[XB_TOP], 1u);
            const unsigned tg = og / nx;
            if (og + 1u == (tg + 1u) * nx) xb_add(&bar[XB_TOPGEN], 1u);
            else XB_SPIN(xb_ld(&bar[XB_TOPGEN]) == tg, bar);
            __builtin_amdgcn_fence(__ATOMIC_ACQUIRE, "agent");
            xb_add(&bar[XB_XGEN(b.x)], 1u);
            asm volatile("s_waitcnt vmcnt(0)" ::: "memory");
        } else {
            XB_SPIN(xb_ld(&bar[XB_XGEN(b.x)]) == gen, bar);
            __builtin_amdgcn_fence(__ATOMIC_ACQUIRE, "agent");
            asm volatile("s_waitcnt vmcnt(0)" ::: "memory");
        }
    }
    __syncthreads();
}

typedef short bf16x8_t __attribute__((ext_vector_type(8)));
__device__ __forceinline__ f32x4 mfma16(bf16x8_t a, bf16x8_t b, f32x4 c) { return __builtin_amdgcn_mfma_f32_16x16x32_bf16(a, b, c, 0, 0, 0); }

struct GdnChunkBufs {
    bf16* W;
    bf16* QG;
    bf16* KDT;
    bf16* UT;
    bf16* QK;
    float* EGL;
};

constexpr int GP_QB = 0, GP_KB = 17408, GP_VB = 34816, GP_LS = 52224, GP_QKS = 69632, GP_WS = 78848, GP_SC = 96256;

__device__ __forceinline__ void gdn_prep_unit(const bf16* __restrict__ PROJ, const float* __restrict__ conv_w, const float* __restrict__ a_log, const float* __restrict__ dt_bias,
                                              const GdnChunkBufs& cb, float* __restrict__ p_gdn_conv, int un, unsigned char* lds) {
    int tid = threadIdx.x; asm volatile("" : "+v"(tid));
    const int lane = tid & 63, wave = __builtin_amdgcn_readfirstlane(tid >> 6), fr = lane & 15, fq = lane >> 4;
    const int h = un & 3, n = (un >> 2) & 63, b = un >> 8;
    const int t0 = b * SEQ + n * 64;
    bf16* Qb = (bf16*)(lds + GP_QB); bf16* Kb = (bf16*)(lds + GP_KB); bf16* Vb = (bf16*)(lds + GP_VB); bf16* Ws = (bf16*)(lds + GP_WS);
    float* Ls = (float*)(lds + GP_LS); bf16* QKs = (bf16*)(lds + GP_QKS);
    float* gcs = (float*)(lds + GP_SC); float* bets = gcs + 64; float* egcs = gcs + 128; float* ekds = gcs + 192; float* begs = gcs + 256;
    if (wave == 0) {
        const bf16* prow = PROJ + (size_t)(t0 + lane) * ABN;
        const float a_raw = bf2f(prow[C_A + h]), b_raw = bf2f(prow[C_B + h]);
        float g = -expf(a_log[h]) * softplusf_(a_raw + dt_bias[h]);
#pragma unroll
        for (int off = 1; off < 64; off <<= 1) { const float v = __shfl_up(g, off); if (lane >= off) g += v; }
        const float glast = __shfl(g, 63);
        { const float be_ = sigmoidf_(b_raw), eg_ = expf(g); gcs[lane] = g; bets[lane] = be_; egcs[lane] = eg_; ekds[lane] = expf(glast - g); begs[lane] = be_ * eg_; }
        if (lane == 0) cb.EGL[un] = expf(glast);
    }
    {
        int cols[6]; float cw[4][6], xw[3][6];
#pragma unroll
        for (int p = 0; p < 3; ++p)
#pragma unroll
            for (int e = 0; e < 2; ++e) cols[p * 2 + e] = p * 512 + h * 128 + e * 64 + lane;
#pragma unroll
        for (int i = 0; i < 4; ++i)
#pragma unroll
            for (int c = 0; c < 6; ++c) cw[i][c] = conv_w[i * 1536 + cols[c]];
        const int i0 = wave * 8;
#pragma unroll
        for (int k = 0; k < 3; ++k) {
            const int pos = n * 64 + i0 - 3 + k;
#pragma unroll
            for (int c = 0; c < 6; ++c) xw[k][c] = pos >= 0 ? bf2f(PROJ[(size_t)(t0 + i0 - 3 + k) * ABN + cols[c]]) : 0.f;
        }
        bf16 xraw[8][6];
#pragma unroll
        for (int ii = 0; ii < 8; ++ii)
#pragma unroll
            for (int c = 0; c < 6; ++c) xraw[ii][c] = PROJ[(size_t)(t0 + i0 + ii) * ABN + cols[c]];
#pragma unroll
        for (int ii = 0; ii < 8; ++ii) {
            const int i = i0 + ii;
            float xt[6], s[6];
#pragma unroll
            for (int c = 0; c < 6; ++c) xt[c] = bf2f(xraw[ii][c]);
#pragma unroll
            for (int c = 0; c < 6; ++c) { const float y_ = cw[0][c] * xw[0][c] + cw[1][c] * xw[1][c] + cw[2][c] * xw[2][c] + cw[3][c] * xt[c]; s[c] = y_ * __frcp_rn(1.0f + __expf(-y_)); }
            const float qs = rsqrtf(wave_sum(s[0] * s[0] + s[1] * s[1]) + 1e-6f) * 0.08838834764831845f;
            const float ks = rsqrtf(wave_sum(s[2] * s[2] + s[3] * s[3]) + 1e-6f);
            Qb[i * 136 + lane] = (bf16)f2bf(s[0] * qs); Qb[i * 136 + 64 + lane] = (bf16)f2bf(s[1] * qs);
            Kb[i * 136 + lane] = (bf16)f2bf(s[2] * ks); Kb[i * 136 + 64 + lane] = (bf16)f2bf(s[3] * ks);
            Vb[i * 136 + lane] = (bf16)f2bf(s[4]);      Vb[i * 136 + 64 + lane] = (bf16)f2bf(s[5]);
            if (n == 63 && i >= 61) {
#pragma unroll
                for (int c = 0; c < 6; ++c) p_gdn_conv[((size_t)b * 3 + (i - 61)) * 1536 + cols[c]] = xt[c];
            }
#pragma unroll
            for (int c = 0; c < 6; ++c) { xw[0][c] = xw[1][c]; xw[1][c] = xw[2][c]; xw[2][c] = xt[c]; }
        }
    }
    __syncthreads();
    {
        const int mi = wave >> 1;
        bf16x8_t aK[4], aQ[4];
#pragma unroll
        for (int ks = 0; ks < 4; ++ks) { aK[ks] = *(const bf16x8_t*)(Kb + (mi * 16 + fr) * 136 + ks * 32 + 8 * fq); aQ[ks] = *(const bf16x8_t*)(Qb + (mi * 16 + fr) * 136 + ks * 32 + 8 * fq); }
#pragma unroll
        for (int nn = 0; nn < 2; ++nn) {
            const int nj = (wave & 1) * 2 + nn;
            f32x4 accK = (f32x4){0.f, 0.f, 0.f, 0.f}, accQ = accK;
#pragma unroll
            for (int ks = 0; ks < 4; ++ks) { const bf16x8_t bk = *(const bf16x8_t*)(Kb + (nj * 16 + fr) * 136 + ks * 32 + 8 * fq); accK = mfma16(aK[ks], bk, accK); accQ = mfma16(aQ[ks], bk, accQ); }
            const int j = nj * 16 + fr; const float gj = gcs[j];
#pragma unroll
            for (int r = 0; r < 4; ++r) {
                const int i = mi * 16 + 4 * fq + r;
                const float dec = i >= j ? expf(gcs[i] - gj) : 0.f;
                Ls[j * 68 + i] = i > j ? bets[i] * accK[r] * dec : 0.f;
                QKs[i * 72 + j] = (bf16)f2bf(i >= j ? accQ[r] * dec : 0.f);
            }
        }
    }
    __syncthreads();
    if (wave < 4) {
        float x[64];
        const bool isu = tid < 128; const int c = isu ? tid : tid - 128;
        const LAS unsigned char* l3 = (const LAS unsigned char*)lds;
        unsigned so = (isu ? GP_VB : GP_KB) + c * 2, ro = GP_SC + (isu ? 64 * 4 : 256 * 4), lo = GP_LS;
        asm volatile("" : "+v"(so), "+v"(ro), "+v"(lo));
#pragma unroll
        for (int i = 0; i < 64; ++i) x[i] = *(const LAS float*)(l3 + ro + 4 * i) * bf2f(*(const LAS bf16*)(l3 + so + i * 272));
#pragma unroll
        for (int j = 0; j < 63; ++j) {
#pragma unroll
            for (int i4 = (j + 1) / 4; i4 < 16; ++i4) {
                const f32x4 l4 = *(const LAS f32x4*)(l3 + lo + j * 272 + i4 * 16);
                if (i4 * 4 + 0 > j) x[i4 * 4 + 0] -= l4.x * x[j];
                if (i4 * 4 + 1 > j) x[i4 * 4 + 1] -= l4.y * x[j];
                if (i4 * 4 + 2 > j) x[i4 * 4 + 2] -= l4.z * x[j];
                if (i4 * 4 + 3 > j) x[i4 * 4 + 3] -= l4.w * x[j];
            }
        }
        if (isu) {
            bf16* dst = cb.UT + ((size_t)un * 128 + c) * 64;
#pragma unroll
            for (int i8 = 0; i8 < 8; ++i8) { v4u o; o.x = pk2(x[i8 * 8 + 0], x[i8 * 8 + 1]); o.y = pk2(x[i8 * 8 + 2], x[i8 * 8 + 3]); o.z = pk2(x[i8 * 8 + 4], x[i8 * 8 + 5]); o.w = pk2(x[i8 * 8 + 6], x[i8 * 8 + 7]); *(v4u*)(dst + i8 * 8) = o; }
        } else {
#pragma unroll
            for (int i = 0; i < 64; ++i) Ws[i * 136 + c] = (bf16)f2bf(x[i]);
        }
    } else {
        const int t2 = tid - 256;
#pragma unroll
        for (int k = 0; k < 4; ++k) {
            const int ci = t2 + 256 * k, i = ci >> 4, d0 = (ci & 15) * 8; const float e = egcs[i];
            const v4u q = *(const v4u*)(Qb + i * 136 + d0);
            v4u o; o.x = pk2(bflo(q.x) * e, bfhi(q.x) * e); o.y = pk2(bflo(q.y) * e, bfhi(q.y) * e); o.z = pk2(bflo(q.z) * e, bfhi(q.z) * e); o.w = pk2(bflo(q.w) * e, bfhi(q.w) * e);
            *(v4u*)(cb.QG + ((size_t)un * 64 + i) * 128 + d0) = o;
        }
#pragma unroll
        for (int k = 0; k < 4; ++k) {
            const int ci = t2 + 256 * k, d = ci & 127, i0 = (ci >> 7) * 8;
            float v[8];
#pragma unroll
            for (int q = 0; q < 8; ++q) v[q] = bf2f(Kb[(i0 + q) * 136 + d]) * ekds[i0 + q];
            v4u o; o.x = pk2(v[0], v[1]); o.y = pk2(v[2], v[3]); o.z = pk2(v[4], v[5]); o.w = pk2(v[6], v[7]);
            *(v4u*)(cb.KDT + ((size_t)un * 128 + d) * 64 + i0) = o;
        }
#pragma unroll
        for (int k = 0; k < 2; ++k) {
            const int ci = t2 + 256 * k, i = ci >> 3, j0 = (ci & 7) * 8;
            *(v4u*)(cb.QK + ((size_t)un * 64 + i) * 64 + j0) = *(const v4u*)(QKs + i * 72 + j0);
        }
    }
    __syncthreads();
#pragma unroll
    for (int k = 0; k < 2; ++k) {
        const int ci = tid + 512 * k, i = ci >> 4, d0 = (ci & 15) * 8;
        *(v4u*)(cb.W + ((size_t)un * 64 + i) * 128 + d0) = *(const v4u*)(Ws + i * 136 + d0);
    }
    __syncthreads();
}

constexpr int GS_ST = 0, GS_VNT = 2 * 32 * 136 * 2, GS_END = GS_VNT + 32 * 72 * 2;
template <int N0, int N1>
__device__ __forceinline__ void gdn_seq(const GdnChunkBufs& cb, float* __restrict__ O, float* __restrict__ Sout, int b, int h, int sl, unsigned char* lds, f32x4 (&accS)[2], int& cur) {
    int tid = threadIdx.x; asm volatile("" : "+v"(tid));
    const int lane = tid & 63, wave = __builtin_amdgcn_readfirstlane(tid >> 6), fr = lane & 15, fq = lane >> 4;
    const int mi = wave >> 1, nj = wave & 1;
    bf16* St = (bf16*)(lds + GS_ST); bf16* VnT = (bf16*)(lds + GS_VNT);
    float* egls = (float*)(lds + GS_END);
    if (N0 == 0) {
        for (int i = tid; i < 2 * 32 * 136 / 2; i += NTH) ((unsigned*)St)[i] = 0u;
        accS[0] = (f32x4){0.f, 0.f, 0.f, 0.f}; accS[1] = accS[0]; cur = 0;
    }
    if (tid >= N0 && tid < N1) egls[tid] = cb.EGL[(size_t)((b * 64 + tid) * 4 + h)];
    __syncthreads();
#define GS_DECL(X) bf16x8_t aW##X[4], aQG##X[4], aQK##X[2], aKD##X[2]; v2u ut##X;
    GS_DECL(0) GS_DECL(1) GS_DECL(2)
#define GS_GLD16(dst, ptr) asm volatile("global_load_dwordx4 %0, %1, off" : "=v"(dst) : "v"(ptr))
#define GS_GLD8(dst, ptr) asm volatile("global_load_dwordx2 %0, %1, off" : "=v"(dst) : "v"(ptr))
#define GS_LOAD(X, n_) do { const size_t u_ = (size_t)((b * 64 + ((n_) < 63 ? (n_) : 63)) * 4 + h);     \
        _Pragma("unroll") for (int ks = 0; ks < 4; ++ks) { GS_GLD16(aW##X[ks], cb.W + (u_ * 64 + mi * 16 + fr) * 128 + ks * 32 + 8 * fq); GS_GLD16(aQG##X[ks], cb.QG + (u_ * 64 + mi * 16 + fr) * 128 + ks * 32 + 8 * fq); } \
        _Pragma("unroll") for (int ks = 0; ks < 2; ++ks) { GS_GLD16(aQK##X[ks], cb.QK + (u_ * 64 + mi * 16 + fr) * 64 + ks * 32 + 8 * fq); GS_GLD16(aKD##X[ks], cb.KDT + (u_ * 128 + wave * 16 + fr) * 64 + ks * 32 + 8 * fq); } \
        GS_GLD8(ut##X, cb.UT + (u_ * 128 + sl * 32 + nj * 16 + fr) * 64 + mi * 16 + 4 * fq); } while (0)
#define GS_WAITN(X, N) asm volatile("s_waitcnt vmcnt(" #N ")" : "+v"(aW##X[0]), "+v"(aW##X[1]), "+v"(aW##X[2]), "+v"(aW##X[3]), "+v"(aQG##X[0]), "+v"(aQG##X[1]), "+v"(aQG##X[2]), "+v"(aQG##X[3]), \
        "+v"(aQK##X[0]), "+v"(aQK##X[1]), "+v"(aKD##X[0]), "+v"(aKD##X[1]), "+v"(ut##X))
#define GS_WAIT(X, n_) GS_WAITN(X, 26)
#define GS_STEP(X, n_) do { \
        const float egl##X = egls[(n_)]; \
        GS_WAIT(X, n_); \
        __syncthreads();                                        \
        f32x4 accW = (f32x4){0.f, 0.f, 0.f, 0.f}, accO = accW; \
        const bf16* Sc = St + cur * 32 * 136; \
        _Pragma("unroll") for (int ks = 0; ks < 4; ++ks) { const bf16x8_t bs = *(const bf16x8_t*)(Sc + (nj * 16 + fr) * 136 + ks * 32 + 8 * fq); accW = mfma16(aW##X[ks], bs, accW); accO = mfma16(aQG##X[ks], bs, accO); } \
          \
        const float v0 = bflo(ut##X.x) - accW[0], v1 = bfhi(ut##X.x) - accW[1], v2 = bflo(ut##X.y) - accW[2], v3 = bfhi(ut##X.y) - accW[3]; \
        { v2u o; o.x = pk2(v0, v1); o.y = pk2(v2, v3); *(v2u*)(VnT + (nj * 16 + fr) * 72 + mi * 16 + 4 * fq) = o; } \
        __syncthreads();                                        \
        _Pragma("unroll") for (int ks = 0; ks < 2; ++ks) { const bf16x8_t bv = *(const bf16x8_t*)(VnT + (nj * 16 + fr) * 72 + ks * 32 + 8 * fq); accO = mfma16(aQK##X[ks], bv, accO); } \
        { float* orow = O + (size_t)(b * SEQ + (n_) * 64 + mi * 16 + 4 * fq) * 512 + h * 128 + sl * 32 + nj * 16 + fr; \
          orow[0] = accO[0]; orow[512] = accO[1]; orow[1024] = accO[2]; orow[1536] = accO[3]; } \
          \
        bf16* Sn = St + (cur ^ 1) * 32 * 136; \
        _Pragma("unroll") for (int njj = 0; njj < 2; ++njj) { \
            accS[njj] = accS[njj] * egl##X; \
            _Pragma("unroll") for (int ks = 0; ks < 2; ++ks) { const bf16x8_t bv = *(const bf16x8_t*)(VnT + (njj * 16 + fr) * 72 + ks * 32 + 8 * fq); accS[njj] = mfma16(aKD##X[ks], bv, accS[njj]); } \
            v2u o; o.x = pk2(accS[njj][0], accS[njj][1]); o.y = pk2(accS[njj][2], accS[njj][3]); \
            *(v2u*)(Sn + (njj * 16 + fr) * 136 + wave * 16 + 4 * fq) = o; } \
        cur ^= 1; } while (0)
    constexpr int NTRI = (N1 - N0) / 3, NREM = (N1 - N0) % 3, NM = N0 + 3 * NTRI;
    GS_LOAD(0, N0); GS_LOAD(1, N0 + 1);
#pragma unroll 1
    for (int n = N0; n < NM; n += 3) {
        GS_LOAD(2, n + 2);
        GS_STEP(0, n);
        GS_LOAD(0, n + 3);
        GS_STEP(1, n + 1);
        GS_LOAD(1, n + 4);
        GS_STEP(2, n + 2);
    }
    if (NREM >= 1) { GS_LOAD(2, NM + 2); GS_STEP(0, NM); }
    if (NREM == 2) { GS_LOAD(0, NM + 3); GS_STEP(1, NM + 1); }
    GS_WAITN(0, 0); GS_WAITN(1, 0); GS_WAITN(2, 0);
#undef GS_STEP
#undef GS_DECL
#undef GS_WAIT
#undef GS_WAITN
#undef GS_GLD16
#undef GS_GLD8
    asm volatile("s_waitcnt vmcnt(0)" ::: "memory");
#undef GS_LOAD
    if (N1 == 64) {
#pragma unroll
        for (int njj = 0; njj < 2; ++njj)
#pragma unroll
            for (int r = 0; r < 4; ++r) Sout[(((size_t)b * 4 + h) * 128 + wave * 16 + 4 * fq + r) * 128 + sl * 32 + njj * 16 + fr] = accS[njj][r];
    }
    __syncthreads();
}

__device__ __forceinline__ void lru_prep_unit(const bf16* __restrict__ PROJ, const float* __restrict__ conv_w, const float* __restrict__ conv_b,
                                              const float* __restrict__ w_r, const float* __restrict__ b_r, const float* __restrict__ w_i, const float* __restrict__ b_i, const float* __restrict__ lam,
                                              float* __restrict__ H, float* __restrict__ P, float* __restrict__ Hend, float* __restrict__ Pend, float* __restrict__ p_lru_conv, int ub) {
    int c = threadIdx.x; asm volatile("" : "+v"(c));
    const int nblk = c >> 6, d = c & 63;
    const int n = ub & 63, b = ub >> 6, t0 = b * SEQ + n * 64;
    float wr[64], wi[64];
#pragma unroll
    for (int cc = 0; cc < 64; ++cc) { wr[cc] = w_r[((size_t)nblk * 64 + cc) * 64 + d]; wi[cc] = w_i[((size_t)nblk * 64 + cc) * 64 + d]; }
    const float cw0 = conv_w[c], cw1 = conv_w[512 + c], cw2 = conv_w[1024 + c], cw3 = conv_w[1536 + c], cb_ = conv_b[c];
    const float br = b_r[c], bi = b_i[c], spl = -8.0f * softplusf_(-lam[c]);
    float x0 = (n * 64 - 3 >= 0) ? bf2f(PROJ[(size_t)(t0 - 3) * ABN + C_XR + c]) : 0.f;
    float x1 = (n * 64 - 2 >= 0) ? bf2f(PROJ[(size_t)(t0 - 2) * ABN + C_XR + c]) : 0.f;
    float x2 = (n * 64 - 1 >= 0) ? bf2f(PROJ[(size_t)(t0 - 1) * ABN + C_XR + c]) : 0.f;
    float hloc = 0.f, ploc = 1.f;
    bf16 xa[16], xb[16];
#pragma unroll
    for (int k = 0; k < 16; ++k) xa[k] = PROJ[(size_t)(t0 + k) * ABN + C_XR + c];
#pragma unroll 1
    for (int ib = 0; ib < 64; ib += 16) {
      if (ib + 16 < 64) {
#pragma unroll
        for (int k = 0; k < 16; ++k) xb[k] = PROJ[(size_t)(t0 + ib + 16 + k) * ABN + C_XR + c];
      }
#pragma unroll
      for (int k = 0; k < 16; ++k) {
        const int i = ib + k;
        const float xt = bf2f(xa[k]);
        const float xr = cb_ + cw0 * x0 + cw1 * x1 + cw2 * x2 + cw3 * xt;
        f32x2_t ga = (f32x2_t){br, bi}, gb = (f32x2_t){0.f, 0.f};
#pragma unroll
        for (int cc = 0; cc < 64; cc += 2) {
            const float xa_ = __uint_as_float(__builtin_amdgcn_readlane(__float_as_uint(xr), cc)), xb_ = __uint_as_float(__builtin_amdgcn_readlane(__float_as_uint(xr), cc + 1));
            ga += (f32x2_t){xa_, xa_} * (f32x2_t){wr[cc], wi[cc]}; gb += (f32x2_t){xb_, xb_} * (f32x2_t){wr[cc + 1], wi[cc + 1]};
        }
        ga += gb;
        const float r = __frcp_rn(1.0f + __expf(-ga.x)), ii = __frcp_rn(1.0f + __expf(-ga.y));
        const float a = __expf(spl * r), bb = __fsqrt_rn(fmaxf(1.0f - a * a, 0.f)) * (ii * xr);
        hloc = a * hloc + bb; ploc *= a;
        H[(size_t)(t0 + i) * 512 + c] = hloc; P[(size_t)(t0 + i) * 512 + c] = ploc;
        if (n == 63 && i >= 61) p_lru_conv[((size_t)b * 3 + (i - 61)) * 512 + c] = xt;
        x0 = x1; x1 = x2; x2 = xt;
      }
#pragma unroll
      for (int k = 0; k < 16; ++k) xa[k] = xb[k];
    }
    Hend[(size_t)ub * 512 + c] = hloc; Pend[(size_t)ub * 512 + c] = ploc;
}
constexpr int LR_XR = 64 * 68 * 4;
__device__ __forceinline__ void lru_prep_unit2(const bf16* __restrict__ PROJ, const float* __restrict__ conv_w, const float* __restrict__ conv_b,
                                               const bf16* __restrict__ WRT, const bf16* __restrict__ WIT  , const float* __restrict__ b_r, const float* __restrict__ b_i, const float* __restrict__ lam,
                                               float* __restrict__ H, float* __restrict__ P, float* __restrict__ Hend, float* __restrict__ Pend, float* __restrict__ p_lru_conv, int ub, unsigned char* lds) {
    int tid = threadIdx.x; asm volatile("" : "+v"(tid));
    const int lane = tid & 63, wave = __builtin_amdgcn_readfirstlane(tid >> 6), fr = lane & 15, fq = lane >> 4;
    const int n = ub & 63, b = ub >> 6, t0 = b * SEQ + n * 64;
    float* XR = (float*)(lds + wave * LR_XR);
    {
        const int c = wave * 64 + lane;
        const float cw0 = conv_w[c], cw1 = conv_w[512 + c], cw2 = conv_w[1024 + c], cw3 = conv_w[1536 + c], cb_ = conv_b[c];
        float x0 = (n * 64 - 3 >= 0) ? bf2f(PROJ[(size_t)(t0 - 3) * ABN + C_XR + c]) : 0.f;
        float x1 = (n * 64 - 2 >= 0) ? bf2f(PROJ[(size_t)(t0 - 2) * ABN + C_XR + c]) : 0.f;
        float x2 = (n * 64 - 1 >= 0) ? bf2f(PROJ[(size_t)(t0 - 1) * ABN + C_XR + c]) : 0.f;
#pragma unroll 1
        for (int ib = 0; ib < 64; ib += 16) {
            bf16 xa[16];
#pragma unroll
            for (int k = 0; k < 16; ++k) xa[k] = PROJ[(size_t)(t0 + ib + k) * ABN + C_XR + c];
#pragma unroll
            for (int k = 0; k < 16; ++k) {
                const int i = ib + k; const float xt = bf2f(xa[k]);
                XR[i * 68 + lane] = cb_ + cw0 * x0 + cw1 * x1 + cw2 * x2 + cw3 * xt;
                if (n == 63 && i >= 61) p_lru_conv[((size_t)b * 3 + (i - 61)) * 512 + c] = xt;
                x0 = x1; x1 = x2; x2 = xt;
            }
        }
    }
    asm volatile("s_waitcnt lgkmcnt(0)" ::: "memory");
    bf16x8_t bR[4][2], bI[4][2];
#pragma unroll
    for (int nt = 0; nt < 4; ++nt)
#pragma unroll
        for (int ks = 0; ks < 2; ++ks) {
            bR[nt][ks] = *(const bf16x8_t*)(WRT + ((size_t)wave * 64 + nt * 16 + fr) * 64 + ks * 32 + 8 * fq);
            bI[nt][ks] = *(const bf16x8_t*)(WIT + ((size_t)wave * 64 + nt * 16 + fr) * 64 + ks * 32 + 8 * fq);
        }
    float brv[4], biv[4], splv[4];
#pragma unroll
    for (int nt = 0; nt < 4; ++nt) { const int c = wave * 64 + nt * 16 + fr; brv[nt] = b_r[c]; biv[nt] = b_i[c]; splv[nt] = -8.0f * softplusf_(-lam[c]); }
    float hin[4], pin[4];
#pragma unroll
    for (int nt = 0; nt < 4; ++nt) { hin[nt] = 0.f; pin[nt] = 1.f; }
#pragma unroll 1
    for (int mt = 0; mt < 4; ++mt) {
        bf16x8_t aX[2];
#pragma unroll
        for (int ks = 0; ks < 2; ++ks) {
            const f32x4 lo = *(const f32x4*)(XR + (mt * 16 + fr) * 68 + ks * 32 + 8 * fq), hi = *(const f32x4*)(XR + (mt * 16 + fr) * 68 + ks * 32 + 8 * fq + 4);
            v4u w; w.x = pk2(lo.x, lo.y); w.y = pk2(lo.z, lo.w); w.z = pk2(hi.x, hi.y); w.w = pk2(hi.z, hi.w);
            aX[ks] = __builtin_bit_cast(bf16x8_t, w);
        }
#pragma unroll
        for (int nt = 0; nt < 4; ++nt) {
            f32x4 aR = (f32x4){0.f, 0.f, 0.f, 0.f}, aI = aR;
            aR = mfma16(aX[0], bR[nt][0], aR); aR = mfma16(aX[1], bR[nt][1], aR);
            aI = mfma16(aX[0], bI[nt][0], aI); aI = mfma16(aX[1], bI[nt][1], aI);
            float av[4], bv[4];
#pragma unroll
            for (int r = 0; r < 4; ++r) {
                const float rg = __frcp_rn(1.0f + __expf(-(aR[r] + brv[nt]))), ig = __frcp_rn(1.0f + __expf(-(aI[r] + biv[nt])));
                const float a = __expf(splv[nt] * rg);
                av[r] = a; bv[r] = __fsqrt_rn(fmaxf(1.0f - a * a, 0.f)) * (ig * XR[(mt * 16 + 4 * fq + r) * 68 + nt * 16 + fr]);
            }
            float PA[4], PB[4];
            PA[0] = av[0]; PB[0] = bv[0];
#pragma unroll
            for (int r = 1; r < 4; ++r) { PA[r] = av[r] * PA[r - 1]; PB[r] = av[r] * PB[r - 1] + bv[r]; }
            float GA = PA[3], GB = PB[3];
            { const float pa = __shfl_up(GA, 16), pb = __shfl_up(GB, 16); if (fq >= 1) { GB = GA * pb + GB; GA = GA * pa; } }
            { const float pa = __shfl_up(GA, 32), pb = __shfl_up(GB, 32); if (fq >= 2) { GB = GA * pb + GB; GA = GA * pa; } }
            float EA = __shfl_up(GA, 16), EB = __shfl_up(GB, 16);
            if (fq == 0) { EA = 1.f; EB = 0.f; }
            const float h0 = EA * hin[nt] + EB, p0 = pin[nt] * EA;
#pragma unroll
            for (int r = 0; r < 4; ++r) {
                const size_t o = (size_t)(t0 + mt * 16 + 4 * fq + r) * 512 + wave * 64 + nt * 16 + fr;
                H[o] = PA[r] * h0 + PB[r]; P[o] = p0 * PA[r];
            }
            const float TA = __shfl(GA, 48 + fr), TB = __shfl(GB, 48 + fr);
            hin[nt] = TA * hin[nt] + TB; pin[nt] = pin[nt] * TA;
        }
    }
    if (fq == 0) {
#pragma unroll
        for (int nt = 0; nt < 4; ++nt) { Hend[(size_t)ub * 512 + wave * 64 + nt * 16 + fr] = hin[nt]; Pend[(size_t)ub * 512 + wave * 64 + nt * 16 + fr] = pin[nt]; }
    }
    asm volatile("s_waitcnt lgkmcnt(0)" ::: "memory");
}
__device__ __forceinline__ void lru_carry(const float* __restrict__ Hend, const float* __restrict__ Pend, float* __restrict__ CIN, float* __restrict__ hlast, int bx) {
    int tx_ = threadIdx.x; asm volatile("" : "+v"(tx_));
    const int idx = bx * NTH + tx_, b = idx >> 9, c = idx & 511;
    float carry = 0.f;
#pragma unroll 8
    for (int n = 0; n < 64; ++n) {
        const size_t o = ((size_t)b * 64 + n) * 512 + c;
        CIN[o] = carry;
        carry = Hend[o] + Pend[o] * carry;
    }
    hlast[(size_t)b * 512 + c] = carry;
}

__device__ __forceinline__ unsigned f2key(float f) { const unsigned u = __float_as_uint(f); return u ^ ((u >> 31) ? 0xffffffffu : 0x80000000u); }
__device__ __forceinline__ float key2f(unsigned k) { return __uint_as_float(k ^ ((k >> 31) ? 0x80000000u : 0xffffffffu)); }
#define TK_CE(hi, lo) do { const unsigned a_ = (hi), b_ = (lo); (hi) = a_ > b_ ? a_ : b_; (lo) = a_ > b_ ? b_ : a_; } while (0)
template <int N> __device__ __forceinline__ void bitonic_sort_desc(unsigned (&a)[N]) {
#pragma unroll
    for (int k = 2; k <= N; k <<= 1)
#pragma unroll
        for (int j = k >> 1; j > 0; j >>= 1)
#pragma unroll
            for (int i = 0; i < N; ++i) { const int l = i ^ j; if (l > i) { if ((i & k) == 0) TK_CE(a[i], a[l]); else TK_CE(a[l], a[i]); } }
}
template <int XM> __device__ __forceinline__ void merge_top16(unsigned (&a)[16]) {
    unsigned c[16];
#pragma unroll
    for (int i = 0; i < 16; ++i) { const unsigned o = (unsigned)__shfl_xor((int)a[15 - i], XM); c[i] = a[i] > o ? a[i] : o; }
#pragma unroll
    for (int j = 8; j > 0; j >>= 1)
#pragma unroll
        for (int i = 0; i < 16; ++i) { const int l = i ^ j; if (l > i) TK_CE(c[i], c[l]); }
#pragma unroll
    for (int i = 0; i < 16; ++i) a[i] = c[i];
}
constexpr int TK_KS = 0, TK_TS = 2 * 128 * 136 * 2, TK_END = TK_TS + 64 * 2 * 16 * 4;
__device__ __forceinline__ void peer_topk_stage_keys(const bf16* __restrict__ KB, int h, unsigned char* lds) {
    bf16* Ks = (bf16*)(lds + TK_KS);
    for (int ci = threadIdx.x; ci < 2 * 128 * 16; ci += NTH) { const int row = ci >> 4, part = ci & 15;
        *(v4u*)(Ks + row * 136 + part * 8) = *(const v4u*)(KB + ((size_t)h * 256 + row) * 128 + part * 8); }
    __syncthreads();
}
__device__ __forceinline__ void peer_topk4(const bf16* __restrict__ Q, int* __restrict__ EXP, float* __restrict__ GATE, int tile, int h, unsigned char* lds) {
    int tid = threadIdx.x; asm volatile("" : "+v"(tid));
    const int lane = tid & 63, wave = __builtin_amdgcn_readfirstlane(tid >> 6), fr = lane & 15, fq = lane >> 4;
    const bf16* Ks = (const bf16*)(lds + TK_KS); unsigned* Ts = (unsigned*)(lds + TK_TS);
    {
        const int c = wave >> 2, nt = wave & 3;
        bf16x8_t bq[4];
#pragma unroll
        for (int ks = 0; ks < 4; ++ks) bq[ks] = *(const bf16x8_t*)(Q + (size_t)(tile * 64 + nt * 16 + fr) * 2048 + h * 256 + c * 128 + ks * 32 + 8 * fq);
        unsigned a[32];
#pragma unroll
        for (int mt = 0; mt < 8; ++mt) {
            f32x4 acc = (f32x4){0.f, 0.f, 0.f, 0.f};
#pragma unroll
            for (int ks = 0; ks < 4; ++ks) { const bf16x8_t ak = *(const bf16x8_t*)(Ks + (c * 128 + mt * 16 + fr) * 136 + ks * 32 + 8 * fq); acc = mfma16(ak, bq[ks], acc); }
#pragma unroll
            for (int r = 0; r < 4; ++r) a[mt * 4 + r] = (f2key(acc[r]) & ~127u) | (unsigned)(127 - (mt * 16 + 4 * fq + r));
        }
        bitonic_sort_desc<32>(a);
        unsigned t[16];
#pragma unroll
        for (int j = 0; j < 16; ++j) t[j] = a[j];
        merge_top16<16>(t); merge_top16<32>(t);
        if (fq == 0) {
            const int tk = nt * 16 + fr;
#pragma unroll
            for (int j = 0; j < 16; ++j) Ts[(tk * 2 + c) * 16 + j] = t[j];
        }
    }
    __syncthreads();
    if (tid < 256) {
        const int tk = tid >> 2, q = tid & 3;
        const unsigned* t0 = Ts + (tk * 2 + 0) * 16; const unsigned* t1 = Ts + (tk * 2 + 1) * 16;
        unsigned a[16];
#pragma unroll
        for (int s = 0; s < 13; ++s) {
            const int e = s * 4 + q;
            int i, j;
            if (e < 16) { i = 0; j = e; } else if (e < 24) { i = 1; j = e - 16; } else if (e < 29) { i = 2; j = e - 24; } else if (e < 33) { i = 3; j = e - 29; }
            else if (e < 36) { i = 4; j = e - 33; } else if (e < 42) { i = 5 + ((e - 36) >> 1); j = (e - 36) & 1; } else { i = 8 + (e - 42); j = 0; }
            const bool ok = e < 50;
            const float sum = key2f(t0[ok ? i : 0] & ~127u) + key2f(t1[ok ? j : 0] & ~127u);
            a[s] = ok ? ((f2key(sum) & ~255u) | (unsigned)(255 - (i * 16 + j))) : 0u;
        }
        a[13] = 0u; a[14] = 0u; a[15] = 0u;
        bitonic_sort_desc<16>(a);
        merge_top16<1>(a); merge_top16<2>(a);
        float ev[16], sum = 0.f; const float m = key2f(a[0] & ~255u);
#pragma unroll
        for (int j = 0; j < 16; ++j) { ev[j] = __expf(key2f(a[j] & ~255u) - m); sum += ev[j]; }
        const float inv = 1.0f / sum;
        const size_t o = (size_t)(tile * 64 + tk) * 128 + h * 16;
#pragma unroll
        for (int j = 0; j < 16; ++j)
            if ((j >> 2) == q) {
                const int code = 255 - (int)(a[j] & 255u), i = code >> 4, jj = code & 15;
                const int n0 = 127 - (int)(t0[i] & 127u), n1 = 127 - (int)(t1[jj] & 127u);
                EXP[o + j] = n0 * 128 + n1; GATE[o + j] = ev[j] * inv;
            }
    }
    __syncthreads();
}

constexpr int AT_KS = 0, AT_VT = 192 * 72 * 2, AT_BT = AT_VT + 64 * 200 * 2, AT_PW = AT_BT + 4 * 128 * 4, AT_END = AT_PW + 8 * 32 * 72 * 2;
__device__ __forceinline__ void attn_unit(const bf16* __restrict__ PCb, const float* __restrict__ rel_bias, const float* __restrict__ sinks, bf16* __restrict__ ATT, int un, unsigned char* lds) {
    int tid = threadIdx.x; asm volatile("" : "+v"(tid));
    const int lane = tid & 63, wave = __builtin_amdgcn_readfirstlane(tid >> 6), fr = lane & 15, fq = lane >> 4;
    const int kvh = un & 3, qblk = (un >> 2) & 63, b = un >> 8;
    const int q0 = qblk * 64, tb = b * SEQ;
    bf16* Ks = (bf16*)(lds + AT_KS); bf16* Vt = (bf16*)(lds + AT_VT); float* Bt = (float*)(lds + AT_BT); bf16* Pw = (bf16*)(lds + AT_PW) + wave * 32 * 72;
#pragma unroll
    for (int k = 0; k < 3; ++k) {
        const int ci = tid + 512 * k, row = ci >> 3, part = ci & 7, kpos = q0 - 128 + row;
        v4u kv = (v4u){0u, 0u, 0u, 0u}, vv = kv;
        if (kpos >= 0) { const bf16* src = PCb + (size_t)(tb + kpos) * CN + kvh * 64 + part * 8; kv = *(const v4u*)(src + 1024); vv = *(const v4u*)(src + 1280); }
        *(v4u*)(Ks + row * 72 + part * 8) = kv;
        bf16* vd = Vt + (part * 8) * 200 + row;
        vd[0 * 200] = (bf16)(vv.x & 0xffffu); vd[1 * 200] = (bf16)(vv.x >> 16); vd[2 * 200] = (bf16)(vv.y & 0xffffu); vd[3 * 200] = (bf16)(vv.y >> 16);
        vd[4 * 200] = (bf16)(vv.z & 0xffffu); vd[5 * 200] = (bf16)(vv.z >> 16); vd[6 * 200] = (bf16)(vv.w & 0xffffu); vd[7 * 200] = (bf16)(vv.w >> 16);
    }
    Bt[tid] = rel_bias[t5_bucket(tid & 127) * 16 + kvh * 4 + (tid >> 7)];
    __syncthreads();
    const int g = wave >> 1, qs = (wave & 1) * 32, hh = kvh * 4 + g;
    bf16x8_t aQ[2][2];
#pragma unroll
    for (int mt = 0; mt < 2; ++mt)
#pragma unroll
        for (int ks = 0; ks < 2; ++ks) aQ[mt][ks] = *(const bf16x8_t*)(PCb + (size_t)(tb + q0 + qs + mt * 16 + fr) * CN + hh * 64 + ks * 32 + 8 * fq);
    f32x4 sc[2][12];
#pragma unroll
    for (int nt = 0; nt < 12; ++nt) {
        const bf16x8_t b0 = *(const bf16x8_t*)(Ks + (nt * 16 + fr) * 72 + 8 * fq), b1 = *(const bf16x8_t*)(Ks + (nt * 16 + fr) * 72 + 32 + 8 * fq);
#pragma unroll
        for (int mt = 0; mt < 2; ++mt) { f32x4 a = (f32x4){0.f, 0.f, 0.f, 0.f}; a = mfma16(aQ[mt][0], b0, a); a = mfma16(aQ[mt][1], b1, a); sc[mt][nt] = a; }
    }
    const float sink = sinks[hh];
    const float* bt = Bt + g * 128;
#pragma unroll
    for (int mt = 0; mt < 2; ++mt)
#pragma unroll
        for (int r = 0; r < 4; ++r) {
            const int qi = qs + mt * 16 + 4 * fq + r;
            float mx = sink;
#pragma unroll
            for (int nt = 0; nt < 12; ++nt) {
                const int kk = nt * 16 + fr, rel = qi + 128 - kk;
                const bool valid = rel >= 0 && rel < 128 && (q0 - 128 + kk) >= 0;
                const float lg = valid ? sc[mt][nt][r] * 0.125f + bt[valid ? rel : 0] : -INFINITY;
                sc[mt][nt][r] = lg; mx = fmaxf(mx, lg);
            }
            mx = fmaxf(mx, __shfl_xor(mx, 1)); mx = fmaxf(mx, __shfl_xor(mx, 2)); mx = fmaxf(mx, __shfl_xor(mx, 4)); mx = fmaxf(mx, __shfl_xor(mx, 8));
            float sum = 0.f;
#pragma unroll
            for (int nt = 0; nt < 12; ++nt) { const float p = __expf(sc[mt][nt][r] - mx); sc[mt][nt][r] = p; sum += p; }
            sum += __shfl_xor(sum, 1); sum += __shfl_xor(sum, 2); sum += __shfl_xor(sum, 4); sum += __shfl_xor(sum, 8);
            const float inv = 1.0f / (sum + __expf(sink - mx));
#pragma unroll
            for (int nt = 0; nt < 12; ++nt) sc[mt][nt][r] *= inv;
        }
    f32x4 oacc[2][4];
#pragma unroll
    for (int mt = 0; mt < 2; ++mt)
#pragma unroll
        for (int dt = 0; dt < 4; ++dt) oacc[mt][dt] = (f32x4){0.f, 0.f, 0.f, 0.f};
#pragma unroll
    for (int kc = 0; kc < 3; ++kc) {
#pragma unroll
        for (int mt = 0; mt < 2; ++mt)
#pragma unroll
            for (int n4 = 0; n4 < 4; ++n4)
#pragma unroll
                for (int r = 0; r < 4; ++r) Pw[(mt * 16 + 4 * fq + r) * 72 + n4 * 16 + fr] = (bf16)f2bf(sc[mt][kc * 4 + n4][r]);
        asm volatile("s_waitcnt lgkmcnt(0)" ::: "memory");
#pragma unroll
        for (int ks = 0; ks < 2; ++ks) {
            const bf16x8_t p0 = *(const bf16x8_t*)(Pw + fr * 72 + ks * 32 + 8 * fq), p1 = *(const bf16x8_t*)(Pw + (16 + fr) * 72 + ks * 32 + 8 * fq);
#pragma unroll
            for (int dt = 0; dt < 4; ++dt) {
                const bf16x8_t bv = *(const bf16x8_t*)(Vt + (dt * 16 + fr) * 200 + kc * 64 + ks * 32 + 8 * fq);
                oacc[0][dt] = mfma16(p0, bv, oacc[0][dt]); oacc[1][dt] = mfma16(p1, bv, oacc[1][dt]);
            }
        }
        asm volatile("s_waitcnt lgkmcnt(0)" ::: "memory");
    }
#pragma unroll
    for (int mt = 0; mt < 2; ++mt)
#pragma unroll
        for (int dt = 0; dt < 4; ++dt)
#pragma unroll
            for (int r = 0; r < 4; ++r) Pw[(mt * 16 + 4 * fq + r) * 72 + dt * 16 + fr] = (bf16)f2bf(oacc[mt][dt][r]);
    asm volatile("s_waitcnt lgkmcnt(0)" ::: "memory");
#pragma unroll
    for (int k = 0; k < 4; ++k) {
        const int ci = lane + 64 * k, row = ci >> 3, part = ci & 7;
        *(v4u*)(ATT + (size_t)(tb + q0 + qs + row) * D + hh * 64 + part * 8) = *(const v4u*)(Pw + row * 72 + part * 8);
    }
    __syncthreads();
}

__device__ __forceinline__ void swa_attn_sample(const bf16* __restrict__ PCb, const float* __restrict__ cache_k, const float* __restrict__ cache_v,
                                                const float* __restrict__ rel_bias, const float* __restrict__ sinks, bf16* __restrict__ ATT, int gw, int lane) {
    const int sb = gw >> 4, h = gw & 15, kvh = h >> 2, t = NP + sb;
    const bf16* qrow = PCb + (size_t)t * CN + h * 64;
    float lg[2];
#pragma unroll
    for (int rr = 0; rr < 2; ++rr) {
        const int r = lane + 64 * rr;
        float dot = 0.f;
        if (r == 0) {
            const bf16* krow = PCb + (size_t)t * CN + 1024 + kvh * 64;
            for (int d = 0; d < 64; ++d) dot += bf2f(qrow[d]) * bf2f(krow[d]);
        } else {
            const float* krow = cache_k + (((size_t)sb * 128 + (128 - r)) * 4 + kvh) * 64;
#pragma unroll
            for (int d4 = 0; d4 < 16; ++d4) { const float4 kv = *(const float4*)(krow + d4 * 4);
                dot += bf2f(qrow[d4 * 4]) * kv.x + bf2f(qrow[d4 * 4 + 1]) * kv.y + bf2f(qrow[d4 * 4 + 2]) * kv.z + bf2f(qrow[d4 * 4 + 3]) * kv.w; }
        }
        lg[rr] = dot * 0.125f + rel_bias[t5_bucket(r) * 16 + h];
    }
    const float sink = sinks[h];
    const float m = fmaxf(wave_max(fmaxf(lg[0], lg[1])), sink);
    float p[2] = {expf(lg[0] - m), expf(lg[1] - m)};
    const float inv = 1.0f / (wave_sum(p[0] + p[1]) + expf(sink - m));
    float o = 0.f;
#pragma unroll
    for (int rr = 0; rr < 2; ++rr)
        for (int l2 = 0; l2 < 64; ++l2) {
            const int r = l2 + 64 * rr;
            const float pj = __shfl(p[rr], l2);
            const float vv = (r == 0) ? bf2f(PCb[(size_t)t * CN + 1280 + kvh * 64 + lane]) : cache_v[(((size_t)sb * 128 + (128 - r)) * 4 + kvh) * 64 + lane];
            o += pj * vv;
        }
    ATT[(size_t)t * D + h * 64 + lane] = (bf16)f2bf(o * inv);
}
__device__ __forceinline__ void swa_kv_out2(const bf16* __restrict__ PCb, const float* __restrict__ cache_k, const float* __restrict__ cache_v,
                                            float* __restrict__ pk, float* __restrict__ pv, float* __restrict__ sk, float* __restrict__ sv, int vb) {
    int tx_ = threadIdx.x; asm volatile("" : "+v"(tx_));
    const int c = tx_ & 255, row = vb * 2 + (tx_ >> 8);
    if (row < NB * 128) {
        const int b = row >> 7, i = row & 127;
        const bf16* src = PCb + (size_t)(b * SEQ + SEQ - 128 + i) * CN;
        pk[(size_t)row * 256 + c] = bf2f(src[1024 + c]);
        pv[(size_t)row * 256 + c] = bf2f(src[1280 + c]);
    } else {
        const int r2 = row - NB * 128, sb = r2 >> 7, i = r2 & 127;
        if (i < 127) {
            sk[(size_t)r2 * 256 + c] = cache_k[((size_t)sb * 128 + i + 1) * 256 + c];
            sv[(size_t)r2 * 256 + c] = cache_v[((size_t)sb * 128 + i + 1) * 256 + c];
        } else {
            const bf16* src = PCb + (size_t)(NP + sb) * CN;
            sk[(size_t)r2 * 256 + c] = bf2f(src[1024 + c]);
            sv[(size_t)r2 * 256 + c] = bf2f(src[1280 + c]);
        }
    }
}


__device__ __forceinline__ void sample_gemm_piece(const bf16* __restrict__ A, const bf16* __restrict__ Bt, const float* __restrict__ bias, bf16* __restrict__ O, int ldc, int p, unsigned char* lds) {
    int tid = threadIdx.x; asm volatile("" : "+v"(tid));
    const int lane = tid & 63, wave = __builtin_amdgcn_readfirstlane(tid >> 6), fr = lane & 15, fq = lane >> 4;
    const int mt = p & 7, cb = p >> 3, nt = wave & 3, kh = wave >> 2;
    const bf16* ap = A + (size_t)(NP + mt * 16 + fr) * D + kh * 512 + 8 * fq;
    const bf16* bp = Bt + (size_t)(cb * 64 + nt * 16 + fr) * D + kh * 512 + 8 * fq;
    bf16x8_t a[16], b[16];
#pragma unroll
    for (int ks = 0; ks < 16; ++ks) { a[ks] = *(const bf16x8_t*)(ap + ks * 32); b[ks] = *(const bf16x8_t*)(bp + ks * 32); }
    f32x4 acc = (f32x4){0.f, 0.f, 0.f, 0.f};
#pragma unroll
    for (int ks = 0; ks < 16; ++ks) acc = mfma16(a[ks], b[ks], acc);
    f32x4* part = (f32x4*)lds;
    if (kh == 1) part[nt * 64 + lane] = acc;
    __syncthreads();
    if (kh == 0) {
        acc = acc + part[nt * 64 + lane];
        const int col = cb * 64 + nt * 16 + fr; const float bv = bias ? bias[col] : 0.f;
#pragma unroll
        for (int r = 0; r < 4; ++r) O[(size_t)(NP + mt * 16 + 4 * fq + r) * ldc + col] = (bf16)f2bf(acc[r] + bv);
    }
    __syncthreads();
}

constexpr size_t MiB = 1u << 20;
constexpr size_t WS_CTL = 0, CTL_ZERO_BYTES = 64 * 1024;
constexpr size_t WS_WAB = 1 * MiB;
constexpr size_t WS_WOUT = WS_WAB + (size_t)ABNP * D * 2;
constexpr size_t WS_WQ0 = WS_WOUT + (size_t)D * D * 2;
constexpr size_t WS_WQ1 = WS_WQ0 + (size_t)2048 * D * 2;
constexpr size_t WS_WINC = WS_WQ1 + (size_t)2048 * D * 2;
constexpr size_t WS_WOUTC = WS_WINC + (size_t)CN * D * 2;
constexpr size_t WS_ABUF = WS_WOUTC + (size_t)D * D * 2;
constexpr size_t WS_P = WS_ABUF + (size_t)MP * D * 2;
constexpr size_t WS_T = WS_P + (size_t)MP * ABN * 2;
constexpr size_t WS_Q = WS_T + (size_t)4 * 16384 * D + (size_t)4 * 16384 * 4;
constexpr size_t WS_A = WS_Q + (size_t)MP * 1536 * 4;
constexpr size_t WS_B = WS_A + (size_t)MP * 512 * 4;
constexpr size_t WS_O = WS_B + (size_t)MP * 512 * 4;
constexpr size_t WS_X1 = WS_O + (size_t)MP * 512 * 4;
constexpr size_t WS_G = WS_X1 + (size_t)MP * D * 4;
constexpr size_t WS_BETA = WS_G + (size_t)MP * 4 * 4;
constexpr size_t WS_GATE = WS_BETA + (size_t)MP * 4 * 4;
constexpr size_t WS_EXP = WS_GATE + (size_t)MP * 128 * 4;
constexpr size_t WS_HEND = WS_EXP + (size_t)MP * 128 * 4;
constexpr size_t WS_KEYS = WS_HEND + (size_t)3 * 4 * 64 * 512 * 4;
constexpr size_t WS_WGT = WS_KEYS + (size_t)2 * 8 * 2 * 128 * 128 * 2;
constexpr size_t WS_END = WS_WGT + (size_t)2 * 8 * 64 * 64 * 2;
constexpr size_t Q_QKVS = 0, Q_W = 1 * MiB, Q_QG = Q_W + 16 * MiB, Q_KDT = Q_QG + 16 * MiB, Q_UT = Q_KDT + 16 * MiB, Q_QK = Q_UT + 16 * MiB, Q_EGL = Q_QK + 8 * MiB, Q_END = Q_EGL + 4096;
static_assert(Q_END <= (size_t)MP * 1536 * 4, "region Q");
static_assert(WS_END <= 512 * MiB, "d_ws map");

struct MegaArgs {
    const float* in[35];
    float* out;
    unsigned char* ws;
};

__global__ void __launch_bounds__(NTH, 2) fwd_megakernel(MegaArgs ma) {
    cg::grid_group grid = cg::this_grid();
    extern __shared__ __attribute__((aligned(16))) unsigned char lds[];
    float* smem = (float*)lds;
    const int nb = gridDim.x, b0 = blockIdx.x, wave = __builtin_amdgcn_readfirstlane(threadIdx.x >> 6);
    int tid = threadIdx.x, lane = tid & 63;
    const float* x_prompt = ma.in[0];
    const float* x_sample = ma.in[1];
    const float* state_gdn = ma.in[2];
    const float* state_gdn_conv = ma.in[3];
    const float* state_lru = ma.in[4];
    const float* state_lru_conv = ma.in[5];
    const float* cache_k = ma.in[6];
    const float* cache_v = ma.in[7];
    const float* w_in_ab = ma.in[8];
    const float* gdn_conv_w = ma.in[9];
    const float* gdn_a_log = ma.in[10];
    const float* gdn_dt_bias = ma.in[11];
    const float* gdn_norm_w = ma.in[12];
    const float* lru_conv_w = ma.in[13];
    const float* lru_conv_b = ma.in[14];
    const float* lru_w_r = ma.in[15];
    const float* lru_b_r = ma.in[16];
    const float* lru_w_i = ma.in[17];
    const float* lru_b_i = ma.in[18];
    const float* lru_lam = ma.in[19];
    const float* w_out_ab = ma.in[20];
    const float* w_in_c = ma.in[21];
    const float* b_in_c = ma.in[22];
    const float* swa_sinks = ma.in[23];
    const float* w_out_c = ma.in[24];
    const float* b_out_c = ma.in[25];
    const float* rel_bias = ma.in[26];
    const float* ln_mix_g = ma.in[27];
    const float* ln_mix_b = ma.in[28];
    const float* ln_ffn_g = ma.in[29];
    const float* ln_ffn_b = ma.in[30];
    const float* peer_w_q = ma.in[31];
    const float* peer_keys = ma.in[32];
    const float* peer_u = ma.in[33];
    const float* peer_v = ma.in[34];

    float* out = ma.out;
    float* o_y = out;
    float* o_p_gdn = out + (size_t)NT * D;
    float* o_p_gdn_conv = o_p_gdn + 262144;
    float* o_p_lru = o_p_gdn_conv + 18432;
    float* o_p_lru_conv = o_p_lru + 2048;
    float* o_p_k = o_p_lru_conv + 6144;
    float* o_p_v = o_p_k + 131072;
    float* o_s_gdn = o_p_v + 131072;
    float* o_s_gdn_conv = o_s_gdn + 8388608;
    float* o_s_lru = o_s_gdn_conv + 589824;
    float* o_s_lru_conv = o_s_lru + 65536;
    float* o_s_k = o_s_lru_conv + 196608;
    float* o_s_v = o_s_k + 4194304;

    unsigned char* ws = ma.ws;
    bf16* WAB_T = (bf16*)(ws + WS_WAB); bf16* WOUT_T = (bf16*)(ws + WS_WOUT); bf16* WQ0_T = (bf16*)(ws + WS_WQ0); bf16* WQ1_T = (bf16*)(ws + WS_WQ1);
    bf16* WINC_T = (bf16*)(ws + WS_WINC); bf16* WOUTC_T = (bf16*)(ws + WS_WOUTC);
    bf16* ABUF = (bf16*)(ws + WS_ABUF);
    bf16* PROJ = (bf16*)(ws + WS_P); float* Y = (float*)(ws + WS_P); bf16* Qb = (bf16*)(ws + WS_P); bf16* PCb = (bf16*)(ws + WS_P); float* Y1 = (float*)(ws + WS_P);
    unsigned char* TAB8 = ws + WS_T; float* TSC = (float*)(ws + WS_T + (size_t)4 * 16384 * D);
    float* R_Q = (float*)(ws + WS_Q + Q_QKVS) - (size_t)NP * 1536; float* X2 = (float*)(ws + WS_A);
    GdnChunkBufs cbuf; cbuf.W = (bf16*)(ws + WS_Q + Q_W); cbuf.QG = (bf16*)(ws + WS_Q + Q_QG); cbuf.KDT = (bf16*)(ws + WS_Q + Q_KDT); cbuf.UT = (bf16*)(ws + WS_Q + Q_UT); cbuf.QK = (bf16*)(ws + WS_Q + Q_QK); cbuf.EGL = (float*)(ws + WS_Q + Q_EGL);
    bf16* Yb = (bf16*)(ws + WS_P);
    float* OUTS = (float*)(ws + WS_Q);
    float* PD = (float*)(ws + WS_P);
    bf16* KEYSB = (bf16*)(ws + WS_KEYS); bf16* WRT = (bf16*)(ws + WS_WGT); bf16* WIT = WRT + 8 * 64 * 64;
    float* HEND = (float*)(ws + WS_HEND); float* PEND = HEND + 4 * 64 * 512; float* CIN = PEND + 4 * 64 * 512;
    float* R_A = (float*)(ws + WS_A); float* R_B = (float*)(ws + WS_B); float* R_O = (float*)(ws + WS_O);
    float* R_X1 = (float*)(ws + WS_X1); float* X3 = R_X1;
    float* R_G = (float*)(ws + WS_G); float* R_BETA = (float*)(ws + WS_BETA); float* R_GATE = (float*)(ws + WS_GATE); int* R_EXP = (int*)(ws + WS_EXP);

    for (int u = tid; u < (LDS_BYTES - RING_BYTES) / 4; u += NTH) ((unsigned*)(lds + RING_BYTES))[u] = 0u;
    __syncthreads();
    XcdBarrier bar = xcd_barrier_post((unsigned*)(ws + WS_CTL), (volatile LAS unsigned*)((LAS unsigned char*)lds + MISC_OFF) + 8);
#define GRID_BAR() do { xcd_barrier(bar); asm volatile("" : "+v"(tid)); lane = tid & 63; } while (0)
#define PHASE_LOOP(n) for (int vb = b0; vb < (n); vb += nb)
#define PHASE_END __syncthreads()
#define GEMM_PHASE_M(Mrows, EPI, Aptr, Btptr, Nn, ...) do { pg8::Gemm g_{(const pg8::bf16_t*)(Aptr), (const pg8::bf16_t*)(Btptr), (Mrows), (Nn), D}; pg8::StaticOrder S_; S_.init((Mrows), (Nn), nb, b0); \
        pg8::EPI E_{__VA_ARGS__}; pg8::gemm_phase<pg8::EPI, pg8::StaticOrder, true, true>((PG8_LAS unsigned char*)lds, g_, S_, E_); } while (0)
#define GEMM_PHASE(EPI, Aptr, Btptr, Nn, ...) GEMM_PHASE_M(MP, EPI, Aptr, Btptr, Nn, __VA_ARGS__)
#define GEMM_PHASE_SPLIT(Aptr, Btptr, Nn, Optr, biasptr) do { GEMM_PHASE_M(NP, EpiStoreBf16, Aptr, Btptr, Nn, Optr, Nn, biasptr, NP, Nn); \
        for (int p_ = b0; p_ < 8 * ((Nn) / 64); p_ += nb) sample_gemm_piece(Aptr, Btptr, biasptr, Optr, Nn, p_, lds); } while (0)

    {
        float* scr = smem + wave * 4096;
        const int gw = b0 * NWAVES + wave, NGW = nb * NWAVES;
        constexpr int I_AB = 16 * 97, I_OUT = 16 * 32, I_Q = 16 * 64, I_INC = 16 * 48;
        constexpr int NITEMS = I_AB + I_OUT + 2 * I_Q + I_INC + I_OUT;
        for (int it = gw; it < NITEMS; it += NGW) {
            int r = it;
            if (r < I_AB) { p0_transpose_item(w_in_ab, D, ABN, WAB_T, scr, r, lane); continue; } r -= I_AB;
            if (r < I_OUT) { p0_transpose_item(w_out_ab, D, D, WOUT_T, scr, r, lane); continue; } r -= I_OUT;
            if (r < I_Q) { p0_transpose_item(peer_w_q, D, 2048, WQ0_T, scr, r, lane); continue; } r -= I_Q;
            if (r < I_Q) { p0_transpose_item(peer_w_q + (size_t)D * 2048, D, 2048, WQ1_T, scr, r, lane); continue; } r -= I_Q;
            if (r < I_INC) { p0_transpose_item(w_in_c, D, CN, WINC_T, scr, r, lane); continue; } r -= I_INC;
            p0_transpose_item(w_out_c, D, D, WOUTC_T, scr, r, lane);
        }
        for (int it = b0 * NTH + tid; it < 2 * 8 * 64 * 8; it += nb * NTH) {
            const int gsel = it >> 12, nn = (it >> 9) & 7, dd = (it >> 3) & 63, c8 = (it & 7) * 8;
            const float* wsrc = (gsel ? lru_w_i : lru_w_r) + ((size_t)nn * 64 + c8) * 64 + dd;
            v4u o; o.x = pk2(wsrc[0], wsrc[64]); o.y = pk2(wsrc[128], wsrc[192]); o.z = pk2(wsrc[256], wsrc[320]); o.w = pk2(wsrc[384], wsrc[448]);
            *(v4u*)((gsel ? WIT : WRT) + ((size_t)nn * 64 + dd) * 64 + c8) = o;
        }
        for (int m = gw; m < MP + (ABNP - 97 * 32); m += NGW) {
            if (m < MP) row_to_bf16(m < NP ? x_prompt + (size_t)m * D : (m < NT ? x_sample + (size_t)(m - NP) * D : nullptr), ABUF + (size_t)m * D, lane);
            else row_to_bf16(nullptr, WAB_T + (size_t)(97 * 32 + (m - MP)) * D, lane);
        }
    }
    GRID_BAR();
    if (ma.out == nullptr) grid.sync();
    GEMM_PHASE(EpiStoreBf16, ABUF, WAB_T, ABNP, PROJ, ABN, nullptr, NT, ABN);
    GRID_BAR();
    { AbPrepArgs pa;
      pa.PROJ = PROJ; pa.st_gdn_conv = state_gdn_conv; pa.st_lru_conv = state_lru_conv;
      pa.gdn_conv_w = gdn_conv_w; pa.a_log = gdn_a_log; pa.dt_bias = gdn_dt_bias;
      pa.lru_conv_w = lru_conv_w; pa.lru_conv_b = lru_conv_b; pa.w_r = lru_w_r; pa.b_r = lru_b_r; pa.w_i = lru_w_i; pa.b_i = lru_b_i; pa.lam = lru_lam;
      pa.QKV = R_Q; pa.G = R_G; pa.BETA = R_BETA; pa.LA = R_A; pa.LB = R_B;
      pa.p_gdn_conv = o_p_gdn_conv; pa.p_lru_conv = o_p_lru_conv; pa.s_gdn_conv = o_s_gdn_conv; pa.s_lru_conv = o_s_lru_conv;
#define GDN_UN_A(i_) ((((i_) >> 7) * 64 + (((i_) >> 2) & 31)) * 4 + ((i_) & 3))
      if (b0 < 128) {
          lru_prep_unit2(PROJ, lru_conv_w, lru_conv_b, WRT, WIT, lru_b_r, lru_b_i, lru_lam, R_B, R_A, HEND, PEND, o_p_lru_conv, (b0 >> 5) * 64 + (b0 & 31), lds); PHASE_END;
          gdn_prep_unit(PROJ, gdn_conv_w, gdn_a_log, gdn_dt_bias, cbuf, o_p_gdn_conv, GDN_UN_A(b0), lds);
      } else if (b0 < 256) {
          ab_prep(pa, NP + (b0 - 128), smem); PHASE_END;
          for (int k = 0; k < 3; ++k) gdn_prep_unit(PROJ, gdn_conv_w, gdn_a_log, gdn_dt_bias, cbuf, o_p_gdn_conv, GDN_UN_A(128 + (b0 - 128) * 3 + k), lds);
      } }
    GRID_BAR();
    f32x4 seqS[2]; int seqcur = 0;
    const int seq_p = (b0 & 7) + 8 * (b0 >> 5), seq_s = (b0 >> 3) & 3;
    if (b0 < 64) gdn_seq<0, 32>(cbuf, R_O, o_p_gdn, seq_p >> 2, seq_p & 3, seq_s, lds, seqS, seqcur);
    else if (b0 < 192) {
        const int i = b0 - 64;
        lru_prep_unit2(PROJ, lru_conv_w, lru_conv_b, WRT, WIT, lru_b_r, lru_b_i, lru_lam, R_B, R_A, HEND, PEND, o_p_lru_conv, (i >> 5) * 64 + 32 + (i & 31), lds); PHASE_END;
        for (int k = 0; k < 2; ++k) gdn_prep_unit(PROJ, gdn_conv_w, gdn_a_log, gdn_dt_bias, cbuf, o_p_gdn_conv, GDN_UN_A(i * 2 + k) + 32 * 4, lds);
    } else if (b0 < 256) {
        const int i = b0 - 192;
        for (int k = 0; k < 4; ++k) gdn_prep_unit(PROJ, gdn_conv_w, gdn_a_log, gdn_dt_bias, cbuf, o_p_gdn_conv, GDN_UN_A(256 + i * 4 + k) + 32 * 4, lds);
    }
    GRID_BAR();
    if (b0 < 64) gdn_seq<32, 64>(cbuf, R_O, o_p_gdn, seq_p >> 2, seq_p & 3, seq_s, lds, seqS, seqcur);
    else if (b0 < 68) lru_carry(HEND, PEND, CIN, o_p_lru, b0 - 64);
    else {
        for (int v = b0 - 68; v < 2048 + 128; v += nb - 68) {
            if (v < 2048) gdn_scan(R_Q, R_G, R_BETA, state_gdn, R_O, o_s_gdn, NP, 1, v & 3, (v >> 2) & 3, v >> 4, smem);
            else lru_scan(R_A, R_B, state_lru, o_s_lru, NP, 1, NS, v - 2048);
            PHASE_END;
        }
        const int gw2 = (b0 - 68) * NWAVES + wave, NGW2 = (nb - 68) * NWAVES;
        for (int m = gw2; m < 512; m += NGW2) row_to_bf16(peer_keys + (size_t)m * D, KEYSB + (size_t)m * D, lane);
        for (int m = gw2; m < 4 * 16384; m += NGW2) {
            const int k = m >> 14, r = m & 16383;
            row_to_fp8_sliced(((k & 1) ? peer_v : peer_u) + ((size_t)(k >> 1) * 16384 + r) * D, TAB8 + (size_t)k * 16384 * D, r, TSC + m, lane);
        }
    }
    GRID_BAR();
    PHASE_LOOP(NT / 2) { ab_mix(PROJ, R_O, R_B, R_A, CIN, gdn_norm_w, ABUF, vb); }
    GRID_BAR();
    GEMM_PHASE_SPLIT(ABUF, WOUT_T, D, Yb, (const float*)nullptr);
    GRID_BAR();
    PHASE_LOOP(NT / 8) { const int t = vb * 8 + wave;
        ln_res_w(t < NP ? x_prompt + (size_t)t * D : x_sample + (size_t)(t - NP) * D, Yb + (size_t)t * D, ln_mix_g, ln_mix_b, R_X1 + (size_t)t * D, ABUF + (size_t)t * D, lane); }
    GRID_BAR();
    GEMM_PHASE_SPLIT(ABUF, WQ0_T, 2048, Qb, (const float*)nullptr);
    GRID_BAR();
    if ((nb & 7) == 0) { peer_topk_stage_keys(KEYSB, b0 & 7, lds); PHASE_LOOP((NT / 64) * 8) { peer_topk4(Qb, R_EXP, R_GATE, vb >> 3, vb & 7, lds); } }
    else PHASE_LOOP((NT / 64) * 8) { peer_topk_stage_keys(KEYSB, vb & 7, lds); peer_topk4(Qb, R_EXP, R_GATE, vb >> 3, vb & 7, lds); }
    GRID_BAR();
    asm volatile("" : "+v"(tid)); lane = tid & 63;
    for (int tg = b0 >> 3; tg < NT / 8; tg += nb >> 3) { const int t = tg * 8 + wave, x = b0 & 7;
        peer_u_pass(R_X1 + (size_t)t * D, R_EXP + (size_t)t * 128, TAB8 + (size_t)x * 16384 * 128, PD + ((size_t)x * NT + t) * 128, x, lane); }
    GRID_BAR();
    PHASE_LOOP(NT / 8) { const int t = vb * 8 + wave; peer_xk(R_EXP + (size_t)t * 128, R_GATE + (size_t)t * 128, PD + (size_t)t * 128, TSC, TSC + 16384, lane); }
    GRID_BAR();
    for (int tg = b0 >> 3; tg < NT / 8; tg += nb >> 3) { const int t = tg * 8 + wave, x = b0 & 7;
        peer_v_slice(R_EXP + (size_t)t * 128, R_GATE + (size_t)t * 128, TAB8 + (size_t)16384 * D + (size_t)x * 16384 * 128, OUTS + (size_t)t * D + x * 128, lane); }
    GRID_BAR();
    PHASE_LOOP(NT / 8) { const int t = vb * 8 + wave; peer_xc(R_X1 + (size_t)t * D, OUTS + (size_t)t * D, ln_ffn_g, ln_ffn_b, X2 + (size_t)t * D, ABUF + (size_t)t * D, lane); }
    GRID_BAR();

    GEMM_PHASE(EpiStoreBf16, ABUF, WINC_T, CN, PCb, CN, b_in_c, NT, CN);
    GRID_BAR();
    PHASE_LOOP(1024 + 256 + (NB * 128 + NS * 128) / 2) {
        if (vb < 1024) attn_unit(PCb, rel_bias, swa_sinks, ABUF, vb, lds);
        else if (vb < 1280) swa_attn_sample(PCb, cache_k, cache_v, rel_bias, swa_sinks, ABUF, (vb - 1024) * 8 + wave, lane);
        else swa_kv_out2(PCb, cache_k, cache_v, o_p_k, o_p_v, o_s_k, o_s_v, vb - 1280);
    }
    GRID_BAR();
    GEMM_PHASE_SPLIT(ABUF, WOUTC_T, D, Yb, b_out_c);
    GRID_BAR();
    PHASE_LOOP(NT / 8) { const int t = vb * 8 + wave;
        ln_res_w(X2 + (size_t)t * D, Yb + (size_t)t * D, ln_mix_g + D, ln_mix_b + D, X3 + (size_t)t * D, ABUF + (size_t)t * D, lane); }
    GRID_BAR();
    GEMM_PHASE_SPLIT(ABUF, WQ1_T, 2048, Qb, (const float*)nullptr);
    GRID_BAR();
    if ((nb & 7) == 0) { peer_topk_stage_keys(KEYSB + (size_t)8 * 2 * 128 * 128, b0 & 7, lds); PHASE_LOOP((NT / 64) * 8) { peer_topk4(Qb, R_EXP, R_GATE, vb >> 3, vb & 7, lds); } }
    else PHASE_LOOP((NT / 64) * 8) { peer_topk_stage_keys(KEYSB + (size_t)8 * 2 * 128 * 128, vb & 7, lds); peer_topk4(Qb, R_EXP, R_GATE, vb >> 3, vb & 7, lds); }
    GRID_BAR();
    asm volatile("" : "+v"(tid)); lane = tid & 63;
    for (int tg = b0 >> 3; tg < NT / 8; tg += nb >> 3) { const int t = tg * 8 + wave, x = b0 & 7;
        peer_u_pass(X3 + (size_t)t * D, R_EXP + (size_t)t * 128, TAB8 + (size_t)2 * 16384 * D + (size_t)x * 16384 * 128, PD + ((size_t)x * NT + t) * 128, x, lane); }
    GRID_BAR();
    PHASE_LOOP(NT / 8) { const int t = vb * 8 + wave; peer_xk(R_EXP + (size_t)t * 128, R_GATE + (size_t)t * 128, PD + (size_t)t * 128, TSC + 2 * 16384, TSC + 3 * 16384, lane); }
    GRID_BAR();
    for (int tg = b0 >> 3; tg < NT / 8; tg += nb >> 3) { const int t = tg * 8 + wave, x = b0 & 7;
        peer_v_slice(R_EXP + (size_t)t * 128, R_GATE + (size_t)t * 128, TAB8 + (size_t)3 * 16384 * D + (size_t)x * 16384 * 128, OUTS + (size_t)t * D + x * 128, lane); }
    GRID_BAR();
    PHASE_LOOP(NT / 8) { const int t = vb * 8 + wave; peer_xc(X3 + (size_t)t * D, OUTS + (size_t)t * D, ln_ffn_g + D, ln_ffn_b + D, o_y + (size_t)t * D, nullptr, lane); }
}
}

extern "C" void kernel_launch(void* const* d_in, const int* in_sizes, int n_in,
                              void* d_out, int out_size, void* d_ws, size_t ws_size,
                              hipStream_t stream) {
    static int grid_blocks = 0;
    if (!grid_blocks) {
        int dev = 0, cus = 0, per_cu = 0;
        (void)hipGetDevice(&dev);
        (void)hipDeviceGetAttribute(&cus, hipDeviceAttributeMultiprocessorCount, dev);
        if (hipFuncSetAttribute((const void*)fwd_megakernel, hipFuncAttributeMaxDynamicSharedMemorySize, LDS_BYTES) != hipSuccess) { fprintf(stderr, "hipFuncSetAttribute failed\n"); grid_blocks = -1; return; }
        (void)hipOccupancyMaxActiveBlocksPerMultiprocessor(&per_cu, (const void*)fwd_megakernel, NTH, LDS_BYTES);
        if (per_cu < 1) { fprintf(stderr, "occupancy query says %d blocks per CU\n", per_cu); grid_blocks = -1; return; }
        if (cus * per_cu < 256) { fprintf(stderr, "this kernel needs 256 co-resident workgroups (device reports %d CUs x %d)\n", cus, per_cu); grid_blocks = -1; return; }
        grid_blocks = 256;
    }
    if (grid_blocks < 0) return;
    (void)hipMemsetAsync((char*)d_ws + WS_CTL, 0, CTL_ZERO_BYTES, stream);
    MegaArgs ma{};
    for (int i = 0; i < 35; ++i) ma.in[i] = (const float*)d_in[i];
    ma.out = (float*)d_out;
    ma.ws = (unsigned char*)d_ws;
    void* args[] = {&ma};
    hipError_t e = hipLaunchCooperativeKernel((void*)fwd_megakernel, dim3(grid_blocks), dim3(NTH), args, LDS_BYTES, stream);
    if (e != hipSuccess) fprintf(stderr, "cooperative launch failed: %s (grid %d)\n", hipGetErrorString(e), grid_blocks);
}
```

```cpp
#include <hip/hip_runtime.h>
#include <hip/hip_cooperative_groups.h>
#include <cstdio>
#include <cstdint>
namespace cg = cooperative_groups;

namespace pg8 {
#define PG8_LAS __attribute__((address_space(3)))
typedef unsigned short bf16_t;
typedef short bf16x8 __attribute__((ext_vector_type(8)));
typedef float f32x4 __attribute__((ext_vector_type(4)));
typedef unsigned u32x4 __attribute__((ext_vector_type(4)));
constexpr int BM = 256, BK = 64, HALF = 128, HTB = HALF * BK * 2  , STAGE_BYTES = 8 * HTB, NXCD = 8, WGM = 8;

__host__ __device__ __forceinline__ int lds_byte(int r, int c) { const int st = (r >> 4) * 2 + (c >> 5), rr = r & 15, cc = c & 31, ob = rr * 64 + cc * 2; return st * 1024 + (ob ^ (((ob >> 9) & 1) << 5)); }
__host__ __device__ __forceinline__ void stage_rc(int b, int& R, int& C) { const int st = b / 1024, sb = b % 1024, swz = sb ^ (((sb >> 9) & 1) << 5); R = (st >> 1) * 16 + swz / 64; C = (st & 1) * 32 + (swz % 64) / 2; }
__host__ __device__ __forceinline__ int perm32(int rho) { const int n = rho >> 4, i = rho & 15; return 8 * (i >> 2) + 4 * n + (i & 3); }

struct Unit { int pm, pn; };
struct Gemm { const bf16_t* A; const bf16_t* Bt; int M, N, K; };

struct StaticOrder {
    int nM, nN, nwg, G, c;
    __host__ __device__ void init(int M, int N, int G_, int c_) { nM = M / BM; nN = N / BM; nwg = nM * nN; G = G_; c = c_; }
    __host__ __device__ bool next(int i, Unit& u) const {
        const long L = (long)i * G + c; if (L >= nwg) return false;
        int wgid = (int)L; { const int q = nwg / NXCD, r = nwg % NXCD, xcd = wgid % NXCD, off = wgid / NXCD; wgid = (xcd < r ? xcd * (q + 1) : r * (q + 1) + (xcd - r) * q) + off; }
        const int nig = WGM * nN, gid = wgid / nig, fm = gid * WGM, gsz = (nM - fm) < WGM ? (nM - fm) : WGM;
        u.pm = fm + ((wgid % nig) % gsz); u.pn = (wgid % nig) / gsz; return true;
    }
    __device__ __forceinline__ void a_ready(const Unit&) const {}
    __device__ __forceinline__ void done(const Unit&) const {}
};

__device__ __forceinline__ unsigned cvt_pk_bf16(float lo, float hi) { unsigned r; asm volatile("v_cvt_pk_bf16_f32 %0, %1, %2" : "=v"(r) : "v"(lo), "v"(hi)); return r; }
template <class Epi, class Sched, bool ALIGN_EPI = false, bool SP2 = false>
__device__ __forceinline__ void gemm_phase(PG8_LAS unsigned char* lds, const Gemm g, const Sched& S, const Epi& E) {
    int tid_ = threadIdx.x; asm volatile("" : "+v"(tid_));
    const int tid = tid_, wid = __builtin_amdgcn_readfirstlane(tid >> 6), lane = tid & 63, wr = wid >> 2, wc = wid & 3, fr = lane & 15, fq = lane >> 4;
    const int K = g.K, nt = K / BK;
    unsigned voffA[2], voffB[2];
#pragma unroll
    for (int i = 0; i < 2; ++i) { int R, C; stage_rc(tid * 16 + i * 8192, R, C); const int Rb = Epi::PERM ? ((R & ~31) + perm32(R & 31)) : R;
        voffA[i] = (unsigned)(R * K + C) * 2u; voffB[i] = (unsigned)(Rb * K + C) * 2u; }
    const size_t kstep = (size_t)(BK * 2);
    const size_t hstep = (size_t)HALF * K * 2;
    const size_t tstep = 2 * hstep;
    const unsigned ldsw = (unsigned)wid * 1024u;
    const int aoff = lds_byte(wr * 64 + fr, fq * 8), boff = lds_byte(wc * 32 + fr, fq * 8);
#define PG8_SA(b, h) (((b) * 2 + (h)) * HTB)
#define PG8_SB(b, h) ((4 + (b) * 2 + (h)) * HTB)
#define PG8_STAGE(bufoff, gbase, voff) do { _Pragma("unroll") for (int _i = 0; _i < 2; ++_i) \
        __builtin_amdgcn_global_load_lds((const unsigned*)((const char*)(gbase) + (voff)[_i]), (PG8_LAS unsigned*)(lds + (bufoff) + ldsw + _i * 8192), 16, 0, 0); } while (0)
#define PG8_LDA(dst, b, h) do { _Pragma("unroll") for (int m = 0; m < 4; ++m) _Pragma("unroll") for (int k = 0; k < 2; ++k) dst[m][k] = *(const PG8_LAS bf16x8*)(lds + PG8_SA(b, h) + aoff + m * 2048 + k * 1024); } while (0)
#define PG8_LDB(dst, b, h) do { _Pragma("unroll") for (int n = 0; n < 2; ++n) _Pragma("unroll") for (int k = 0; k < 2; ++k) dst[n][k] = *(const PG8_LAS bf16x8*)(lds + PG8_SB(b, h) + boff + n * 2048 + k * 1024); } while (0)
#define PG8_MMA(ai, bj, At, Bt) do { __builtin_amdgcn_s_setprio(1); _Pragma("unroll") for (int m = 0; m < 4; ++m) _Pragma("unroll") for (int n = 0; n < 2; ++n) _Pragma("unroll") for (int k = 0; k < 2; ++k) \
        acc[ai][bj][m][n] = __builtin_amdgcn_mfma_f32_16x16x32_bf16(Bt[n][k], At[m][k], acc[ai][bj][m][n], 0, 0, 0); __builtin_amdgcn_s_setprio(0); } while (0)
#define PG8_WAIT_V(n) asm volatile("s_waitcnt vmcnt(" #n ")" ::: "memory")
#define PG8_WAIT_L(n) asm volatile("s_waitcnt lgkmcnt(" #n ")" ::: "memory")
#define PG8_BAR __builtin_amdgcn_s_barrier()
#define PG8_SCHED __builtin_amdgcn_sched_barrier(0)
    Unit cur, nxt; int ui = 0;
    if (!S.next(0, cur)) return;
    f32x4 acc[2][2][4][2];
#pragma unroll
    for (int a = 0; a < 2; ++a)
#pragma unroll
        for (int b = 0; b < 2; ++b)
#pragma unroll
            for (int m = 0; m < 4; ++m)
#pragma unroll
                for (int n = 0; n < 2; ++n) acc[a][b][m][n] = (f32x4){0.f, 0.f, 0.f, 0.f};
    bf16x8 At[4][2], B0[2][2], B1[2][2];
    const char* cA = (const char*)g.A + (size_t)cur.pm * tstep; const char* cB = (const char*)g.Bt + (size_t)cur.pn * tstep;
    S.a_ready(cur);
    if constexpr (SP2) {
        PG8_STAGE(PG8_SB(0, 0), cB, voffB); PG8_STAGE(PG8_SB(0, 1), cB + hstep, voffB); PG8_STAGE(PG8_SA(0, 0), cA, voffA); PG8_STAGE(PG8_SA(0, 1), cA + hstep, voffA);
        if (wr == 1) PG8_BAR;
        PG8_WAIT_V(2); PG8_BAR;
        PG8_STAGE(PG8_SB(1, 0), cB + kstep, voffB); PG8_STAGE(PG8_SA(1, 0), cA + kstep, voffA); PG8_STAGE(PG8_SB(1, 1), cB + hstep + kstep, voffB);
        PG8_WAIT_V(6); PG8_BAR;
    } else {
        PG8_STAGE(PG8_SB(0, 0), cB, voffB); PG8_STAGE(PG8_SA(0, 0), cA, voffA); PG8_STAGE(PG8_SB(0, 1), cB + hstep, voffB); PG8_STAGE(PG8_SA(0, 1), cA + hstep, voffA);
        if (wr == 1) PG8_BAR;
        PG8_WAIT_V(4); PG8_BAR;
        PG8_STAGE(PG8_SB(1, 0), cB + kstep, voffB); PG8_STAGE(PG8_SA(1, 0), cA + kstep, voffA); PG8_STAGE(PG8_SB(1, 1), cB + hstep + kstep, voffB);
        PG8_WAIT_V(6); PG8_BAR;
    }
    for (;;) {
        const bool has_next = S.next(ui + 1, nxt);
        const char* nA = has_next ? (const char*)g.A + (size_t)nxt.pm * tstep : cA; const char* nB = has_next ? (const char*)g.Bt + (size_t)nxt.pn * tstep : cB;
        for (int t = 0; t < nt; t += 2) {
            const bool last = (t == nt - 2);
            const char* a1 = cA + (size_t)(t + 1) * kstep;
            const char* a2 = last ? nA : cA + (size_t)(t + 2) * kstep; const char* b2 = last ? nB : cB + (size_t)(t + 2) * kstep;
            const char* a3 = a2 + kstep; const char* b3 = b2 + kstep;
            if (last && has_next) S.a_ready(nxt);
            if constexpr (SP2) {
            PG8_LDB(B0, 0, 0); PG8_LDB(B1, 0, 1); PG8_SCHED; PG8_LDA(At, 0, 0); PG8_STAGE(PG8_SA(1, 1), a1 + hstep, voffA);
            PG8_WAIT_V(8); PG8_WAIT_L(0); PG8_BAR; PG8_MMA(0, 0, At, B0); PG8_MMA(0, 1, At, B1); PG8_BAR; PG8_SCHED;
            PG8_LDA(At, 0, 1); PG8_STAGE(PG8_SB(0, 0), b2, voffB); PG8_STAGE(PG8_SB(0, 1), b2 + hstep, voffB); PG8_STAGE(PG8_SA(0, 0), a2, voffA);
            PG8_WAIT_V(8); PG8_WAIT_L(0); PG8_BAR; PG8_MMA(1, 0, At, B0); PG8_MMA(1, 1, At, B1); PG8_BAR; PG8_SCHED;
            PG8_LDB(B0, 1, 0); PG8_LDB(B1, 1, 1); PG8_SCHED; PG8_LDA(At, 1, 0); PG8_STAGE(PG8_SA(0, 1), a2 + hstep, voffA);
            PG8_WAIT_V(8); PG8_WAIT_L(0); PG8_BAR; PG8_MMA(0, 0, At, B0); PG8_MMA(0, 1, At, B1); PG8_BAR; PG8_SCHED;
            PG8_LDA(At, 1, 1); PG8_STAGE(PG8_SB(1, 0), b3, voffB); PG8_STAGE(PG8_SB(1, 1), b3 + hstep, voffB); PG8_STAGE(PG8_SA(1, 0), a3, voffA);
            PG8_WAIT_V(8); PG8_WAIT_L(0); PG8_BAR; PG8_MMA(1, 0, At, B0); PG8_MMA(1, 1, At, B1); PG8_BAR; PG8_SCHED;
            } else {
            PG8_LDB(B0, 0, 0); PG8_SCHED; PG8_LDA(At, 0, 0); PG8_STAGE(PG8_SA(1, 1), a1 + hstep, voffA);
            PG8_WAIT_L(8); PG8_BAR; PG8_WAIT_L(0); PG8_MMA(0, 0, At, B0); PG8_BAR; PG8_SCHED;
            PG8_LDB(B1, 0, 1); PG8_STAGE(PG8_SB(0, 0), b2, voffB);
            PG8_BAR; PG8_WAIT_L(0); PG8_MMA(0, 1, At, B1); PG8_BAR;
            PG8_LDA(At, 0, 1); PG8_STAGE(PG8_SA(0, 0), a2, voffA);
            PG8_BAR; PG8_WAIT_L(0); PG8_MMA(1, 0, At, B0); PG8_BAR; PG8_SCHED;
            PG8_STAGE(PG8_SB(0, 1), b2 + hstep, voffB);
            PG8_WAIT_V(6); PG8_BAR; PG8_MMA(1, 1, At, B1); PG8_BAR;
            PG8_LDB(B0, 1, 0); PG8_SCHED; PG8_LDA(At, 1, 0); PG8_STAGE(PG8_SA(0, 1), a2 + hstep, voffA);
            PG8_WAIT_L(8); PG8_BAR; PG8_WAIT_L(0); PG8_MMA(0, 0, At, B0); PG8_BAR; PG8_SCHED;
            PG8_LDB(B1, 1, 1); PG8_STAGE(PG8_SB(1, 0), b3, voffB);
            PG8_BAR; PG8_WAIT_L(0); PG8_MMA(0, 1, At, B1); PG8_BAR;
            PG8_LDA(At, 1, 1); PG8_STAGE(PG8_SA(1, 0), a3, voffA);
            PG8_BAR; PG8_WAIT_L(0); PG8_MMA(1, 0, At, B0); PG8_BAR; PG8_SCHED;
            PG8_STAGE(PG8_SB(1, 1), b3 + hstep, voffB);
            PG8_WAIT_V(6); PG8_BAR; PG8_MMA(1, 1, At, B1); PG8_BAR;
            }
        }
        if constexpr (ALIGN_EPI) { if (wr == 0) PG8_BAR; }
        if constexpr (!Epi::AFTER_DRAIN) { E(acc, cur, wr, wc, fr, fq); S.done(cur); }
        if (!has_next) break;
#pragma unroll
        for (int a = 0; a < 2; ++a)
#pragma unroll
            for (int b = 0; b < 2; ++b)
#pragma unroll
                for (int m = 0; m < 4; ++m)
#pragma unroll
                    for (int n = 0; n < 2; ++n) acc[a][b][m][n] = (f32x4){0.f, 0.f, 0.f, 0.f};
        cur = nxt; cA = nA; cB = nB; ++ui;
        if constexpr (ALIGN_EPI) { if (wr == 1) PG8_BAR; }
    }
    PG8_WAIT_V(0);
    if constexpr (!ALIGN_EPI) { if (wr == 0) PG8_BAR; }
    PG8_BAR;
    if constexpr (Epi::AFTER_DRAIN) { E.fused(acc, cur, wr, wc, fr, fq, lds, wid, lane); S.done(cur); }
#undef PG8_SA
#undef PG8_SB
#undef PG8_STAGE
#undef PG8_LDA
#undef PG8_LDB
#undef PG8_MMA
#undef PG8_WAIT_V
#undef PG8_WAIT_L
#undef PG8_BAR
#undef PG8_SCHED
}
}
namespace pg8 {
struct EpiStoreBf16 {
    static constexpr bool PERM = true, AFTER_DRAIN = false;
    bf16_t* O; int ldc; const float* bias; int m_real, n_real;
    __device__ __forceinline__ void operator()(const f32x4 (&acc)[2][2][4][2], const Unit& u, int wr, int wc, int fr, int fq) const {
        const int row0 = u.pm * BM + wr * 64 + fr, col0 = u.pn * BM + wc * 32 + 8 * fq;
#pragma unroll
        for (int bj = 0; bj < 2; ++bj) {
            const int col = col0 + bj * HALF;
            if (col >= n_real) continue;
            f32x4 b0 = (f32x4){0.f, 0.f, 0.f, 0.f}, b1 = b0;
            if (bias) { b0 = *(const f32x4*)(bias + col); b1 = *(const f32x4*)(bias + col + 4); }
#pragma unroll
            for (int ai = 0; ai < 2; ++ai)
#pragma unroll
                for (int m = 0; m < 4; ++m) {
                    const int row = row0 + ai * HALF + m * 16;
                    if (row >= m_real) continue;
                    const f32x4 v0 = acc[ai][bj][m][0] + b0, v1 = acc[ai][bj][m][1] + b1;
                    u32x4 w; w.x = cvt_pk_bf16(v0[0], v0[1]); w.y = cvt_pk_bf16(v0[2], v0[3]); w.z = cvt_pk_bf16(v1[0], v1[1]); w.w = cvt_pk_bf16(v1[2], v1[3]);
                    *(u32x4*)(O + (size_t)row * ldc + col) = w;
                }
        }
    }
};
struct EpiStoreF32 {
    static constexpr bool PERM = false, AFTER_DRAIN = false;
    float* O; int ldc; const float* bias; int m_real, n_real;
    __device__ __forceinline__ void operator()(const f32x4 (&acc)[2][2][4][2], const Unit& u, int wr, int wc, int fr, int fq) const {
        const int row0 = u.pm * BM + wr * 64 + fr, col0 = u.pn * BM + wc * 32 + 4 * fq;
#pragma unroll
        for (int bj = 0; bj < 2; ++bj)
#pragma unroll
            for (int n = 0; n < 2; ++n) {
                const int col = col0 + bj * HALF + n * 16;
                if (col >= n_real) continue;
                const f32x4 bv = bias ? *(const f32x4*)(bias + col) : (f32x4){0.f, 0.f, 0.f, 0.f};
#pragma unroll
                for (int ai = 0; ai < 2; ++ai)
#pragma unroll
                    for (int m = 0; m < 4; ++m) {
                        const int row = row0 + ai * HALF + m * 16;
                        if (row >= m_real) continue;
                        *(f32x4*)(O + (size_t)row * ldc + col) = acc[ai][bj][m][n] + bv;
                    }
            }
    }
};
}
namespace {
#define GAS __attribute__((address_space(1)))
#define LAS __attribute__((address_space(3)))
typedef unsigned short bf16;
typedef float f32x4 __attribute__((ext_vector_type(4)));
typedef unsigned v4u __attribute__((ext_vector_type(4)));
typedef unsigned v2u __attribute__((ext_vector_type(2)));

constexpr int D = 1024, NB = 4, SEQ = 4096, NP = NB * SEQ, NS = 128, NT = NP + NS, MP = 16640;
constexpr int ABN = 3080, ABNP = 3328;
constexpr int C_QKV = 0, C_Z = 1536, C_A = 2048, C_B = 2052, C_XR = 2056, C_GATE = 2568;
constexpr int CN = 1536;
constexpr float ALPHA = 1.4142135623730951f;
constexpr float LN_EPS = 1e-5f;
constexpr int NTH = 512, NWAVES = 8;
constexpr int RING_BYTES = 143360, MISC_OFF = RING_BYTES + 320, LDS_BYTES = 147456;

__device__ __forceinline__ float bf2f(bf16 v) { return __uint_as_float((unsigned)v << 16); }
__device__ __forceinline__ float bflo(unsigned w) { return __uint_as_float(w << 16); }
__device__ __forceinline__ float bfhi(unsigned w) { return __uint_as_float(w & 0xffff0000u); }
__device__ __forceinline__ unsigned f2bf(float f) { unsigned u = __float_as_uint(f); return (u + 0x7fffu + ((u >> 16) & 1u)) >> 16; }
__device__ __forceinline__ unsigned pk2(float lo, float hi) { return f2bf(lo) | (f2bf(hi) << 16); }
__device__ __forceinline__ float sigmoidf_(float x) { return 1.0f / (1.0f + expf(-x)); }
__device__ __forceinline__ float softplusf_(float x) { return fmaxf(x, 0.f) + log1pf(expf(-fabsf(x))); }
__device__ __forceinline__ float siluf_(float x) { return x / (1.0f + expf(-x)); }
__device__ __forceinline__ float geluf_(float x) { return 0.5f * x * (1.0f + tanhf(0.7978845608028654f * (x + 0.044715f * x * x * x))); }
#define DPPF(v_, ctrl_, rmask_) __int_as_float(__builtin_amdgcn_update_dpp(0, __float_as_int(v_), (ctrl_), (rmask_), 0xf, false))
__device__ __forceinline__ float wave_sum(float v) {
    v += DPPF(v, 0xB1, 0xf); v += DPPF(v, 0x4E, 0xf); v += DPPF(v, 0x141, 0xf); v += DPPF(v, 0x140, 0xf);
    v += DPPF(v, 0x142, 0xa); v += DPPF(v, 0x143, 0xc);
    return __int_as_float(__builtin_amdgcn_readlane(__float_as_int(v), 63));
}
__device__ __forceinline__ float wave_max(float v) {
    v = fmaxf(v, DPPF(v, 0xB1, 0xf)); v = fmaxf(v, DPPF(v, 0x4E, 0xf)); v = fmaxf(v, DPPF(v, 0x141, 0xf)); v = fmaxf(v, DPPF(v, 0x140, 0xf));
    { const float t = __int_as_float(__builtin_amdgcn_update_dpp(__float_as_int(v), __float_as_int(v), 0x142, 0xa, 0xf, false)); v = fmaxf(v, t); }
    { const float t = __int_as_float(__builtin_amdgcn_update_dpp(__float_as_int(v), __float_as_int(v), 0x143, 0xc, 0xf, false)); v = fmaxf(v, t); }
    return __int_as_float(__builtin_amdgcn_readlane(__float_as_int(v), 63));
}

__device__ __forceinline__ void p0_transpose_item(const float* __restrict__ W, int K, int N, bf16* __restrict__ WT, float* scr, int item, int lane) {
    const int nblk = (N + 31) / 32, kb = item / nblk, nb = item % nblk, k0 = 64 * kb, n0 = 32 * nb;
#pragma unroll 8
    for (int i = 0; i < 32; ++i) { const int kk = 2 * i + (lane >> 5), n = n0 + (lane & 31); scr[kk * 33 + (lane & 31)] = n < N ? W[(size_t)(k0 + kk) * N + n] : 0.f; }
    asm volatile("s_waitcnt lgkmcnt(0)" ::: "memory");
    const int c = lane & 7;
#pragma unroll
    for (int j = 0; j < 4; ++j) { const int n = (lane >> 3) + 8 * j; const float* s = scr + (8 * c) * 33 + n;
        v4u o; o.x = pk2(s[0 * 33], s[1 * 33]); o.y = pk2(s[2 * 33], s[3 * 33]); o.z = pk2(s[4 * 33], s[5 * 33]); o.w = pk2(s[6 * 33], s[7 * 33]);
        *(v4u*)(WT + (size_t)(n0 + n) * K + k0 + 8 * c) = o; }
    asm volatile("s_waitcnt lgkmcnt(0)" ::: "memory");
}
__device__ __forceinline__ void row_to_bf16(const float* __restrict__ xrow, bf16* __restrict__ orow, int lane) {
#pragma unroll
    for (int j = 0; j < 4; ++j) {
        f32x4 v = (f32x4){0.f, 0.f, 0.f, 0.f};
        if (xrow) v = ((const f32x4*)xrow)[lane + 64 * j];
        v2u o; o.x = pk2(v.x, v.y); o.y = pk2(v.z, v.w);
        ((v2u*)orow)[lane + 64 * j] = o;
    }
}

struct AbPrepArgs {
    const bf16* PROJ; const float* st_gdn_conv; const float* st_lru_conv;
    const float* gdn_conv_w; const float* a_log; const float* dt_bias;
    const float* lru_conv_w; const float* lru_conv_b; const float* w_r; const float* b_r; const float* w_i; const float* b_i; const float* lam;
    float* QKV; float* G; float* BETA; float* LA; float* LB;
    float* p_gdn_conv; float* p_lru_conv; float* s_gdn_conv; float* s_lru_conv;
};
__device__ __forceinline__ void ab_prep(const AbPrepArgs& a, int t, float* smem) {
    int tid = threadIdx.x; asm volatile("" : "+v"(tid));
    const int lane = tid & 63, wid = tid >> 6;
    const bool samp = t >= NP; const int sb = t - NP, pos = t % SEQ, b = t / SEQ;
    float* sq = smem;
    float* sx = smem + 1536;
    float* scl = smem + 2048;
    const bf16* prow = a.PROJ + (size_t)t * ABN;
    for (int c = tid; c < 1536; c += NTH) {
        float acc = 0.f;
#pragma unroll
        for (int i = 0; i < 4; ++i) {
            float xv;
            if (i == 3) xv = bf2f(prow[C_QKV + c]);
            else if (samp) xv = a.st_gdn_conv[((size_t)sb * 3 + i) * 1536 + c];
            else xv = (pos - 3 + i >= 0) ? bf2f(a.PROJ[(size_t)(t - 3 + i) * ABN + C_QKV + c]) : 0.f;
            acc += a.gdn_conv_w[i * 1536 + c] * xv;
        }
        sq[c] = siluf_(acc);
    }
    {
        const int c = tid;
        float acc = a.lru_conv_b[c];
#pragma unroll
        for (int i = 0; i < 4; ++i) {
            float xv;
            if (i == 3) xv = bf2f(prow[C_XR + c]);
            else if (samp) xv = a.st_lru_conv[((size_t)sb * 3 + i) * 512 + c];
            else xv = (pos - 3 + i >= 0) ? bf2f(a.PROJ[(size_t)(t - 3 + i) * ABN + C_XR + c]) : 0.f;
            acc += a.lru_conv_w[i * 512 + c] * xv;
        }
        sx[c] = acc;
    }
    __syncthreads();
    {
        const int grp = wid;
        const float v0 = sq[grp * 128 + lane], v1 = sq[grp * 128 + 64 + lane];
        const float s = wave_sum(v0 * v0 + v1 * v1);
        if (lane == 0) scl[grp] = rsqrtf(s + 1e-6f) * (grp < 4 ? 0.08838834764831845f : 1.0f);
    }
    __syncthreads();
    for (int c = tid; c < 1536; c += NTH) a.QKV[(size_t)t * 1536 + c] = (c < 1024) ? sq[c] * scl[c >> 7] : sq[c];
    if (tid < 4) {
        const float a_raw = bf2f(prow[C_A + tid]), b_raw = bf2f(prow[C_B + tid]);
        a.G[(size_t)t * 4 + tid] = -expf(a.a_log[tid]) * softplusf_(a_raw + a.dt_bias[tid]);
        a.BETA[(size_t)t * 4 + tid] = sigmoidf_(b_raw);
    }
    if (!samp) {
        if (pos >= SEQ - 3) {
            const int row = pos - (SEQ - 3);
            for (int c = tid; c < 1536; c += NTH) a.p_gdn_conv[((size_t)b * 3 + row) * 1536 + c] = bf2f(prow[C_QKV + c]);
            a.p_lru_conv[((size_t)b * 3 + row) * 512 + tid] = bf2f(prow[C_XR + tid]);
        }
    } else {
        for (int c = tid; c < 1536; c += NTH) {
            a.s_gdn_conv[((size_t)sb * 3 + 0) * 1536 + c] = a.st_gdn_conv[((size_t)sb * 3 + 1) * 1536 + c];
            a.s_gdn_conv[((size_t)sb * 3 + 1) * 1536 + c] = a.st_gdn_conv[((size_t)sb * 3 + 2) * 1536 + c];
            a.s_gdn_conv[((size_t)sb * 3 + 2) * 1536 + c] = bf2f(prow[C_QKV + c]);
        }
        {
            const int c = tid;
            a.s_lru_conv[((size_t)sb * 3 + 0) * 512 + c] = a.st_lru_conv[((size_t)sb * 3 + 1) * 512 + c];
            a.s_lru_conv[((size_t)sb * 3 + 1) * 512 + c] = a.st_lru_conv[((size_t)sb * 3 + 2) * 512 + c];
            a.s_lru_conv[((size_t)sb * 3 + 2) * 512 + c] = bf2f(prow[C_XR + c]);
        }
    }
    {
        const int c = tid, n = c >> 6, d = c & 63;
        float r = a.b_r[c], ii = a.b_i[c];
#pragma unroll 4
        for (int cc = 0; cc < 64; ++cc) {
            const float xv = sx[n * 64 + cc];
            r += xv * a.w_r[((size_t)n * 64 + cc) * 64 + d];
            ii += xv * a.w_i[((size_t)n * 64 + cc) * 64 + d];
        }
        r = sigmoidf_(r); ii = sigmoidf_(ii);
        const float log_a = -8.0f * r * softplusf_(-a.lam[c]);
        a.LA[(size_t)t * 512 + c] = expf(log_a);
        a.LB[(size_t)t * 512 + c] = sqrtf(-expm1f(2.0f * log_a)) * (ii * sx[c]);
    }
}

__device__ __forceinline__ void gdn_scan(const float* __restrict__ QKV, const float* __restrict__ G, const float* __restrict__ BETA,
                                         const float* __restrict__ S0, float* __restrict__ O, float* __restrict__ Sout, int tok_base, int T,
                                         int sl, int h, int sq, float* smem) {
    int tid = threadIdx.x; asm volatile("" : "+v"(tid));
    const int dvl = tid & 31, kg = tid >> 5;
    const int dv = sl * 32 + dvl;
    float (*red1)[32] = (float (*)[32])smem;
    float (*red2)[32] = (float (*)[32])(smem + 512);
    float S[8];
#pragma unroll
    for (int i = 0; i < 8; ++i) S[i] = S0 ? S0[(((size_t)sq * 4 + h) * 128 + kg * 8 + i) * 128 + dv] : 0.f;
    float kk[8], qq[8], vv, g, be;
    {
        const size_t tok = (size_t)tok_base + (size_t)sq * T;
        const float* row = QKV + tok * 1536;
#pragma unroll
        for (int i = 0; i < 8; ++i) { kk[i] = row[512 + h * 128 + kg * 8 + i]; qq[i] = row[h * 128 + kg * 8 + i]; }
        vv = row[1024 + h * 128 + dv]; g = G[tok * 4 + h]; be = BETA[tok * 4 + h];
    }
    for (int t = 0; t < T; ++t) {
        const size_t tok = (size_t)tok_base + (size_t)sq * T + t;
        float nk[8], nq[8], nv = 0.f, ng = 0.f, nb = 0.f;
        if (t + 1 < T) {
            const float* row = QKV + (tok + 1) * 1536;
#pragma unroll
            for (int i = 0; i < 8; ++i) { nk[i] = row[512 + h * 128 + kg * 8 + i]; nq[i] = row[h * 128 + kg * 8 + i]; }
            nv = row[1024 + h * 128 + dv]; ng = G[(tok + 1) * 4 + h]; nb = BETA[(tok + 1) * 4 + h];
        } else {
#pragma unroll
            for (int i = 0; i < 8; ++i) { nk[i] = 0.f; nq[i] = 0.f; }
        }
        const float al = expf(g);
        float p = 0.f;
#pragma unroll
        for (int i = 0; i < 8; ++i) { S[i] *= al; p += S[i] * kk[i]; }
        red1[kg][dvl] = p;
        __syncthreads();
        float ks = 0.f;
#pragma unroll
        for (int j = 0; j < 16; ++j) ks += red1[j][dvl];
        const float vn = be * (vv - ks);
        float o = 0.f;
#pragma unroll
        for (int i = 0; i < 8; ++i) { S[i] += kk[i] * vn; o += S[i] * qq[i]; }
        red2[kg][dvl] = o;
        __syncthreads();
        if (kg == 0) {
            float os = 0.f;
#pragma unroll
            for (int j = 0; j < 16; ++j) os += red2[j][dvl];
            O[tok * 512 + h * 128 + dv] = os;
        }
#pragma unroll
        for (int i = 0; i < 8; ++i) { kk[i] = nk[i]; qq[i] = nq[i]; }
        vv = nv; g = ng; be = nb;
    }
#pragma unroll
    for (int i = 0; i < 8; ++i) Sout[(((size_t)sq * 4 + h) * 128 + kg * 8 + i) * 128 + dv] = S[i];
}

__device__ __forceinline__ void lru_scan(const float* __restrict__ LA, float* __restrict__ LB, const float* __restrict__ h0,
                                         float* __restrict__ hlast, int tok_base, int T, int nseq, int bx) {
    int tx_ = threadIdx.x; asm volatile("" : "+v"(tx_));
    const int idx = bx * NTH + tx_;
    if (idx >= nseq * 512) return;
    const int sq = idx / 512, c = idx % 512;
    float h = h0 ? h0[(size_t)sq * 512 + c] : 0.f;
    const size_t base = ((size_t)tok_base + (size_t)sq * T) * 512 + c;
#pragma unroll 8
    for (int t = 0; t < T; ++t) {
        const size_t o = base + (size_t)t * 512;
        h = LA[o] * h + LB[o];
        LB[o] = h;
    }
    hlast[(size_t)sq * 512 + c] = h;
}

__device__ __forceinline__ void ab_mix_w(const bf16* __restrict__ PROJ, const float* __restrict__ O, const float* __restrict__ H, const float* __restrict__ P, const float* __restrict__ CIN,
                                         const float* __restrict__ norm_w, bf16* __restrict__ MIX, int t, int lane) {
    const bf16* prow = PROJ + (size_t)t * ABN;
    {
        const int c0 = lane * 8;
        const f32x4 o0 = *(const f32x4*)(O + (size_t)t * 512 + c0), o1 = *(const f32x4*)(O + (size_t)t * 512 + c0 + 4);
        const v4u zb = *(const v4u*)(prow + C_Z + c0);
        const f32x4 w0 = *(const f32x4*)(norm_w + (c0 & 127)), w1 = *(const f32x4*)(norm_w + (c0 & 127) + 4);
        float ss = (o0.x * o0.x + o0.y * o0.y) + (o0.z * o0.z + o0.w * o0.w) + (o1.x * o1.x + o1.y * o1.y) + (o1.z * o1.z + o1.w * o1.w);
        ss += DPPF(ss, 0xB1, 0xf); ss += DPPF(ss, 0x4E, 0xf); ss += DPPF(ss, 0x141, 0xf); ss += DPPF(ss, 0x140, 0xf);
        const float sc = rsqrtf(ss * (1.0f / 128.0f) + 1e-6f);
        const float z[8] = {bflo(zb.x), bfhi(zb.x), bflo(zb.y), bfhi(zb.y), bflo(zb.z), bfhi(zb.z), bflo(zb.w), bfhi(zb.w)};
        const float ov[8] = {o0.x, o0.y, o0.z, o0.w, o1.x, o1.y, o1.z, o1.w}, wv[8] = {w0.x, w0.y, w0.z, w0.w, w1.x, w1.y, w1.z, w1.w};
        float r[8];
#pragma unroll
        for (int i = 0; i < 8; ++i) r[i] = ov[i] * sc * wv[i] * (z[i] * __frcp_rn(1.0f + __expf(-z[i])));
        v4u ob; ob.x = pk2(r[0], r[1]); ob.y = pk2(r[2], r[3]); ob.z = pk2(r[4], r[5]); ob.w = pk2(r[6], r[7]);
        *(v4u*)(MIX + (size_t)t * 1024 + c0) = ob;
    }
    {
        const int c0 = lane * 8;
        const v4u gb = *(const v4u*)(prow + C_GATE + c0);
        f32x4 h0 = *(const f32x4*)(H + (size_t)t * 512 + c0), h1 = *(const f32x4*)(H + (size_t)t * 512 + c0 + 4);
        if (t < NP) {
            const f32x4 p0 = *(const f32x4*)(P + (size_t)t * 512 + c0), p1 = *(const f32x4*)(P + (size_t)t * 512 + c0 + 4);
            const f32x4 ci0 = *(const f32x4*)(CIN + (size_t)(t >> 6) * 512 + c0), ci1 = *(const f32x4*)(CIN + (size_t)(t >> 6) * 512 + c0 + 4);
            h0 = h0 + p0 * ci0; h1 = h1 + p1 * ci1;
        }
        const float gv[8] = {bflo(gb.x), bfhi(gb.x), bflo(gb.y), bfhi(gb.y), bflo(gb.z), bfhi(gb.z), bflo(gb.w), bfhi(gb.w)}, hv[8] = {h0.x, h0.y, h0.z, h0.w, h1.x, h1.y, h1.z, h1.w};
        float r[8];
#pragma unroll
        for (int i = 0; i < 8; ++i) r[i] = geluf_(gv[i]) * hv[i];
        v4u ob; ob.x = pk2(r[0], r[1]); ob.y = pk2(r[2], r[3]); ob.z = pk2(r[4], r[5]); ob.w = pk2(r[6], r[7]);
        *(v4u*)(MIX + (size_t)t * 1024 + 512 + c0) = ob;
    }
}

template <bool XBF>
__device__ __forceinline__ void ln_res_w(const void* __restrict__ xrow_, const bf16* __restrict__ yrow, const float* __restrict__ g, const float* __restrict__ bta,
                                         bf16* __restrict__ obrow, int lane) {
    f32x4 v[4]; float s = 0.f;
#pragma unroll
    for (int j = 0; j < 4; ++j) {
        f32x4 x4;
        if (XBF) { const v2u xb = ((const v2u*)xrow_)[lane + 64 * j]; x4 = (f32x4){bflo(xb.x), bfhi(xb.x), bflo(xb.y), bfhi(xb.y)}; }
        else x4 = ((const f32x4*)xrow_)[lane + 64 * j];
        const v2u yb = ((const v2u*)yrow)[lane + 64 * j];
        const f32x4 y4 = (f32x4){bflo(yb.x), bfhi(yb.x), bflo(yb.y), bfhi(yb.y)}; v[j] = x4 * ALPHA + y4; s += (v[j].x + v[j].y) + (v[j].z + v[j].w); }
    const float mean = wave_sum(s) * (1.0f / 1024.0f); float q = 0.f;
#pragma unroll
    for (int j = 0; j < 4; ++j) { v[j] = v[j] - mean; q += (v[j].x * v[j].x + v[j].y * v[j].y) + (v[j].z * v[j].z + v[j].w * v[j].w); }
    const float rs = rsqrtf(wave_sum(q) * (1.0f / 1024.0f) + LN_EPS);
#pragma unroll
    for (int j = 0; j < 4; ++j) {
        const f32x4 g4 = ((const f32x4*)g)[lane + 64 * j], b4 = ((const f32x4*)bta)[lane + 64 * j];
        const f32x4 o = v[j] * rs * g4 + b4;
        v2u ob; ob.x = pk2(o.x, o.y); ob.y = pk2(o.z, o.w);
        ((v2u*)obrow)[lane + 64 * j] = ob;
    }
}

__device__ __forceinline__ void peer_topk(const bf16* __restrict__ Q, const float* __restrict__ keys, int* __restrict__ EXP, float* __restrict__ GATE,
                                          int tg, int h, float* smem) {
    const int tid = threadIdx.x, cn = tid & 255, c = cn >> 7, n = cn & 127, th = tid >> 8;
    float (*sq)[256] = (float (*)[256])smem;
    float (*ss)[257] = (float (*)[257])(smem + 32 * 256);
    float (*tvs)[2][16] = (float (*)[2][16])(smem + 32 * 256 + 32 * 257 + 32);
    int (*tis)[2][16] = (int (*)[2][16])(smem + 32 * 256 + 32 * 257 + 32 + 1024);
    for (int i = tid; i < 32 * 256; i += NTH) {
        const int tk = i >> 8, col = i & 255;
        sq[tk][col] = bf2f(Q[(size_t)(tg * 32 + tk) * 2048 + h * 256 + col]);
    }
    __syncthreads();
    float acc[16];
#pragma unroll
    for (int i = 0; i < 16; ++i) acc[i] = 0.f;
    const float* krow = keys + (((size_t)h * 2 + c) * 128 + n) * 128;
    for (int d4 = 0; d4 < 32; ++d4) {
        const float4 kv = *(const float4*)(krow + d4 * 4);
#pragma unroll
        for (int tk = 0; tk < 16; ++tk) {
            const float4 qv = *(const float4*)&sq[th * 16 + tk][c * 128 + d4 * 4];
            acc[tk] += qv.x * kv.x + qv.y * kv.y + qv.z * kv.z + qv.w * kv.w;
        }
    }
#pragma unroll
    for (int tk = 0; tk < 16; ++tk) ss[th * 16 + tk][cn] = acc[tk];
    __syncthreads();
    if (tid < 64) {
        const int tk = tid >> 1, cc = tid & 1;
        float tv[16]; int ti[16];
#pragma unroll
        for (int j = 0; j < 16; ++j) { tv[j] = -INFINITY; ti[j] = 0; }
        for (int nn = 0; nn < 128; ++nn) {
            float x = ss[tk][cc * 128 + nn]; int xi = nn;
#pragma unroll
            for (int j = 0; j < 16; ++j) {
                const bool gt = x > tv[j];
                const float tf = tv[j]; const int tj = ti[j];
                tv[j] = gt ? x : tf; ti[j] = gt ? xi : tj;
                x = gt ? tf : x; xi = gt ? tj : xi;
            }
        }
#pragma unroll
        for (int j = 0; j < 16; ++j) { tvs[tk][cc][j] = tv[j]; tis[tk][cc][j] = ti[j]; }
    }
    __syncthreads();
    if (tid < 32) {
        const int tk = tid;
        float bv[16]; int bi[16];
#pragma unroll
        for (int j = 0; j < 16; ++j) { bv[j] = -INFINITY; bi[j] = 0; }
        for (int i = 0; i < 16; ++i)
            for (int jj = 0; jj < 16; ++jj) {
                float x = tvs[tk][0][i] + tvs[tk][1][jj]; int xi = tis[tk][0][i] * 128 + tis[tk][1][jj];
#pragma unroll
                for (int j = 0; j < 16; ++j) {
                    const bool gt = x > bv[j];
                    const float tf = bv[j]; const int tj = bi[j];
                    bv[j] = gt ? x : tf; bi[j] = gt ? xi : tj;
                    x = gt ? tf : x; xi = gt ? tj : xi;
                }
            }
        float e[16], sum = 0.f;
#pragma unroll
        for (int j = 0; j < 16; ++j) { e[j] = expf(bv[j] - bv[0]); sum += e[j]; }
        const float inv = 1.0f / sum;
        const size_t o = (size_t)(tg * 32 + tk) * 128 + h * 16;
#pragma unroll
        for (int j = 0; j < 16; ++j) { EXP[o + j] = bi[j]; GATE[o + j] = e[j] * inv; }
    }
}

__device__ __forceinline__ void peer_expert(const float* __restrict__ X, const int* __restrict__ EXP, const float* __restrict__ GATE,
                                            const float* __restrict__ U, const float* __restrict__ V,
                                            const float* __restrict__ g, const float* __restrict__ bta, float* __restrict__ out, bf16* __restrict__ outb, int t, float* smem) {
    const int tid = threadIdx.x, lane = tid & 63, wid = tid >> 6;
    float (*accs)[1024] = (float (*)[1024])smem;
    float* sred = smem + 8192;
    const float4* xr = (const float4*)(X + (size_t)t * D);
    float4 xv[4];
#pragma unroll
    for (int j = 0; j < 4; ++j) xv[j] = xr[lane + 64 * j];
    float4 acc[4];
#pragma unroll
    for (int j = 0; j < 4; ++j) acc[j] = make_float4(0.f, 0.f, 0.f, 0.f);
    for (int e = 0; e < 16; ++e) {
        const int id = EXP[(size_t)t * 128 + wid * 16 + e];
        const float gt = GATE[(size_t)t * 128 + wid * 16 + e];
        const float4* ur = (const float4*)(U + (size_t)id * D);
        const float4* vr = (const float4*)(V + (size_t)id * D);
        float4 uv[4], vv[4];
#pragma unroll
        for (int j = 0; j < 4; ++j) { uv[j] = ur[lane + 64 * j]; vv[j] = vr[lane + 64 * j]; }
        float dot = 0.f;
#pragma unroll
        for (int j = 0; j < 4; ++j) dot += uv[j].x * xv[j].x + uv[j].y * xv[j].y + uv[j].z * xv[j].z + uv[j].w * xv[j].w;
        dot = wave_sum(dot);
        const float cf = gt * geluf_(dot);
#pragma unroll
        for (int j = 0; j < 4; ++j) { acc[j].x += cf * vv[j].x; acc[j].y += cf * vv[j].y; acc[j].z += cf * vv[j].z; acc[j].w += cf * vv[j].w; }
    }
#pragma unroll
    for (int j = 0; j < 4; ++j) *(float4*)&accs[wid][(lane + 64 * j) * 4] = acc[j];
    __syncthreads();
    float v[2];
#pragma unroll
    for (int i = 0; i < 2; ++i) {
        const int c = tid * 2 + i;
        float s = 0.f;
#pragma unroll
        for (int w = 0; w < 8; ++w) s += accs[w][c];
        v[i] = ALPHA * X[(size_t)t * D + c] + s;
    }
    float s = wave_sum(v[0] + v[1]);
    if (lane == 0) sred[wid] = s;
    __syncthreads();
    float mean = 0.f;
#pragma unroll
    for (int w = 0; w < 8; ++w) mean += sred[w];
    mean *= (1.0f / 1024.0f);
    __syncthreads();
    const float d0 = v[0] - mean, d1 = v[1] - mean;
    float q = wave_sum(d0 * d0 + d1 * d1);
    if (lane == 0) sred[wid] = q;
    __syncthreads();
    float var = 0.f;
#pragma unroll
    for (int w = 0; w < 8; ++w) var += sred[w];
    const float rs = rsqrtf(var * (1.0f / 1024.0f) + LN_EPS);
    const float o0 = d0 * rs * g[tid * 2] + bta[tid * 2], o1 = d1 * rs * g[tid * 2 + 1] + bta[tid * 2 + 1];
    *(float2*)(out + (size_t)t * D + tid * 2) = make_float2(o0, o1);
    if (outb) *(unsigned*)(outb + (size_t)t * D + tid * 2) = pk2(o0, o1);
}


typedef __bf16 bf16x2_t __attribute__((ext_vector_type(2)));
__device__ __forceinline__ float dot2bf(unsigned w, unsigned x, float acc) { return __builtin_amdgcn_fdot2_f32_bf16(__builtin_bit_cast(bf16x2_t, w), __builtin_bit_cast(bf16x2_t, x), acc, false); }
typedef float f32x2_t __attribute__((ext_vector_type(2)));
__device__ __forceinline__ void row_to_fp8(const float* __restrict__ xrow, unsigned char* __restrict__ orow, float* __restrict__ scale, int lane) {
    f32x4 v[4]; float am = 0.f;
#pragma unroll
    for (int j = 0; j < 4; ++j) { v[j] = *(const f32x4*)(xrow + lane * 16 + j * 4); am = fmaxf(am, fmaxf(fmaxf(fabsf(v[j].x), fabsf(v[j].y)), fmaxf(fabsf(v[j].z), fabsf(v[j].w)))); }
    am = wave_max(am);
    const float s = am > 0.f ? am * (1.0f / 448.0f) : 1.0f, inv = 1.0f / s;
    v4u o;
    unsigned w;
    w = 0u; w = __builtin_amdgcn_cvt_pk_fp8_f32(v[0].x * inv, v[0].y * inv, w, false); w = __builtin_amdgcn_cvt_pk_fp8_f32(v[0].z * inv, v[0].w * inv, w, true); o.x = w;
    w = 0u; w = __builtin_amdgcn_cvt_pk_fp8_f32(v[1].x * inv, v[1].y * inv, w, false); w = __builtin_amdgcn_cvt_pk_fp8_f32(v[1].z * inv, v[1].w * inv, w, true); o.y = w;
    w = 0u; w = __builtin_amdgcn_cvt_pk_fp8_f32(v[2].x * inv, v[2].y * inv, w, false); w = __builtin_amdgcn_cvt_pk_fp8_f32(v[2].z * inv, v[2].w * inv, w, true); o.z = w;
    w = 0u; w = __builtin_amdgcn_cvt_pk_fp8_f32(v[3].x * inv, v[3].y * inv, w, false); w = __builtin_amdgcn_cvt_pk_fp8_f32(v[3].z * inv, v[3].w * inv, w, true); o.w = w;
    *(v4u*)(orow + lane * 16) = o;
    if (lane == 0) *scale = s;
}
#define PE_LOAD(UB, VB, grp) do { _Pragma("unroll") for (int i_ = 0; i_ < 4; ++i_) { const int e_ = (grp) * 4 + i_; \
        const int id_ = __builtin_amdgcn_readlane(e_ < 64 ? id0 : id1, e_ & 63); \
        const unsigned so_ = (unsigned)id_ * 1024u; \
        UB[i_] = __builtin_amdgcn_raw_buffer_load_b128(ursrc, voff, so_, 0); VB[i_] = __builtin_amdgcn_raw_buffer_load_b128(vrsrc, voff, so_, 0); } } while (0)
#define PE_DOT4(w, k) do { const f32x2_t l_ = __builtin_amdgcn_cvt_pk_f32_fp8((w), false), h_ = __builtin_amdgcn_cvt_pk_f32_fp8((w), true); \
        a_ += l_.x * xv[(k) * 4 + 0]; b_ += l_.y * xv[(k) * 4 + 1]; a_ += h_.x * xv[(k) * 4 + 2]; b_ += h_.y * xv[(k) * 4 + 3]; } while (0)
#define PE_AXPY4(w, k) do { const f32x2_t l_ = __builtin_amdgcn_cvt_pk_f32_fp8((w), false), h_ = __builtin_amdgcn_cvt_pk_f32_fp8((w), true); \
        acc[(k) * 4 + 0] += cf_ * l_.x; acc[(k) * 4 + 1] += cf_ * l_.y; acc[(k) * 4 + 2] += cf_ * h_.x; acc[(k) * 4 + 3] += cf_ * h_.y; } while (0)
#define PE_COMP(UB, VB, grp) do { float d_[4]; \
        _Pragma("unroll") for (int i_ = 0; i_ < 4; ++i_) { float a_ = 0.f, b_ = 0.f; PE_DOT4(UB[i_].x, 0); PE_DOT4(UB[i_].y, 1); PE_DOT4(UB[i_].z, 2); PE_DOT4(UB[i_].w, 3); d_[i_] = a_ + b_; } \
          \
        float s0_ = hi32 ? d_[2] : d_[0], t0_ = hi32 ? d_[0] : d_[2]; s0_ += __shfl_xor(t0_, 32); \
        float s1_ = hi32 ? d_[3] : d_[1], t1_ = hi32 ? d_[1] : d_[3]; s1_ += __shfl_xor(t1_, 32); \
        float r_ = hi16 ? s1_ : s0_, t2_ = hi16 ? s0_ : s1_; r_ += __shfl_xor(t2_, 16); \
        r_ += __shfl_xor(r_, 8); r_ += __shfl_xor(r_, 4); r_ += __shfl_xor(r_, 2); r_ += __shfl_xor(r_, 1); \
          \
        const int esel_ = (grp) * 4 + (lane >> 4); \
        const float su_ = __shfl(esel_ < 64 ? su0 : su1, esel_ & 63), gv_ = __shfl(esel_ < 64 ? gs0 : gs1, esel_ & 63); \
        const float cfl_ = geluf_(r_ * su_) * gv_; \
        _Pragma("unroll") for (int i_ = 0; i_ < 4; ++i_) { \
            const float cf_ = __uint_as_float(__builtin_amdgcn_readlane(__float_as_uint(cfl_), 16 * i_)); \
            PE_AXPY4(VB[i_].x, 0); PE_AXPY4(VB[i_].y, 1); PE_AXPY4(VB[i_].z, 2); PE_AXPY4(VB[i_].w, 3); } } while (0)
__device__ __forceinline__ void peer_expert_w(const float* __restrict__ xrow, const int* __restrict__ exr, const float* __restrict__ gar,
                                              const unsigned char* __restrict__ U, const unsigned char* __restrict__ V, const float* __restrict__ SU, const float* __restrict__ SV,
                                              const float* __restrict__ g, const float* __restrict__ bta, float* __restrict__ orow, bf16* __restrict__ obrow, int lane) {
    const bool hi32 = (lane & 32) != 0, hi16 = (lane & 16) != 0;
    const __amdgpu_buffer_rsrc_t ursrc = __builtin_amdgcn_make_buffer_rsrc((void*)U, 0, 16384 * 1024, 0x00020000);
    const __amdgpu_buffer_rsrc_t vrsrc = __builtin_amdgcn_make_buffer_rsrc((void*)V, 0, 16384 * 1024, 0x00020000);
    const int voff = lane * 16;
    float xv[16];
#pragma unroll
    for (int j = 0; j < 4; ++j) { const f32x4 t = *(const f32x4*)(xrow + lane * 16 + j * 4); xv[j * 4 + 0] = t.x; xv[j * 4 + 1] = t.y; xv[j * 4 + 2] = t.z; xv[j * 4 + 3] = t.w; }
    const int id0 = exr[lane], id1 = exr[64 + lane];
    const float su0 = SU[id0], su1 = SU[id1];
    const float gs0 = gar[lane] * SV[id0], gs1 = gar[64 + lane] * SV[id1];
    float acc[16];
#pragma unroll
    for (int i = 0; i < 16; ++i) acc[i] = 0.f;
    v4u ua[4], va[4], ub[4], vb[4];
    PE_LOAD(ua, va, 0);
#pragma unroll 1
    for (int grp = 0; grp < 32; grp += 2) {
        PE_LOAD(ub, vb, grp + 1);
        PE_COMP(ua, va, grp);
        if (grp + 2 < 32) PE_LOAD(ua, va, grp + 2);
        PE_COMP(ub, vb, grp + 1);
    }
    float v[16]; float s = 0.f;
#pragma unroll
    for (int i = 0; i < 16; ++i) { v[i] = ALPHA * xv[i] + acc[i]; s += v[i]; }
    const float mean = wave_sum(s) * (1.0f / 1024.0f); float q = 0.f;
#pragma unroll
    for (int i = 0; i < 16; ++i) { v[i] -= mean; q += v[i] * v[i]; }
    const float rs = rsqrtf(wave_sum(q) * (1.0f / 1024.0f) + LN_EPS);
    float o[16];
#pragma unroll
    for (int j = 0; j < 4; ++j) {
        const f32x4 g4 = *(const f32x4*)(g + lane * 16 + j * 4), b4 = *(const f32x4*)(bta + lane * 16 + j * 4);
        o[j * 4 + 0] = v[j * 4 + 0] * rs * g4.x + b4.x; o[j * 4 + 1] = v[j * 4 + 1] * rs * g4.y + b4.y; o[j * 4 + 2] = v[j * 4 + 2] * rs * g4.z + b4.z; o[j * 4 + 3] = v[j * 4 + 3] * rs * g4.w + b4.w;
        *(f32x4*)(orow + lane * 16 + j * 4) = (f32x4){o[j * 4 + 0], o[j * 4 + 1], o[j * 4 + 2], o[j * 4 + 3]};
    }
    if (obrow) {
        v4u w0, w1; w0.x = pk2(o[0], o[1]); w0.y = pk2(o[2], o[3]); w0.z = pk2(o[4], o[5]); w0.w = pk2(o[6], o[7]); w1.x = pk2(o[8], o[9]); w1.y = pk2(o[10], o[11]); w1.z = pk2(o[12], o[13]); w1.w = pk2(o[14], o[15]);
        *(v4u*)(obrow + lane * 16) = w0; *(v4u*)(obrow + lane * 16 + 8) = w1;
    }
}


__device__ __forceinline__ void peer_expert_blk(const float* __restrict__ xrow, const int* __restrict__ exr, const float* __restrict__ gar,
                                                const unsigned char* __restrict__ U, const unsigned char* __restrict__ V, const float* __restrict__ SU, const float* __restrict__ SV,
                                                const float* __restrict__ g, const float* __restrict__ bta, float* __restrict__ orow, bf16* __restrict__ obrow, int lane, int wave, float* smem) {
    const bool hi32 = (lane & 32) != 0, hi16 = (lane & 16) != 0;
    const __amdgpu_buffer_rsrc_t ursrc = __builtin_amdgcn_make_buffer_rsrc((void*)U, 0, 16384 * 1024, 0x00020000);
    const __amdgpu_buffer_rsrc_t vrsrc = __builtin_amdgcn_make_buffer_rsrc((void*)V, 0, 16384 * 1024, 0x00020000);
    const int voff = lane * 16;
    float xv[16];
#pragma unroll
    for (int j = 0; j < 4; ++j) { const f32x4 t = *(const f32x4*)(xrow + lane * 16 + j * 4); xv[j * 4 + 0] = t.x; xv[j * 4 + 1] = t.y; xv[j * 4 + 2] = t.z; xv[j * 4 + 3] = t.w; }
    const int id0 = exr[lane], id1 = exr[64 + lane];
    const float su0 = SU[id0], su1 = SU[id1];
    const float gs0 = gar[lane] * SV[id0], gs1 = gar[64 + lane] * SV[id1];
    float acc[16];
#pragma unroll
    for (int i = 0; i < 16; ++i) acc[i] = 0.f;
    v4u ua[4], va[4], ub[4], vb[4];
    const int g0 = wave * 4;
    PE_LOAD(ua, va, g0); PE_LOAD(ub, vb, g0 + 1);
    PE_COMP(ua, va, g0); PE_LOAD(ua, va, g0 + 2);
    PE_COMP(ub, vb, g0 + 1); PE_LOAD(ub, vb, g0 + 3);
    PE_COMP(ua, va, g0 + 2);
    PE_COMP(ub, vb, g0 + 3);
    float* accs = smem;
    float* sred = smem + 8192;
#pragma unroll
    for (int j = 0; j < 4; ++j) *(f32x4*)(accs + wave * 1024 + lane * 16 + j * 4) = (f32x4){acc[j * 4 + 0], acc[j * 4 + 1], acc[j * 4 + 2], acc[j * 4 + 3]};
    __syncthreads();
    const int tid = wave * 64 + lane;
    float v0 = ALPHA * xrow[tid * 2], v1 = ALPHA * xrow[tid * 2 + 1];
#pragma unroll
    for (int w = 0; w < 8; ++w) { v0 += accs[w * 1024 + tid * 2]; v1 += accs[w * 1024 + tid * 2 + 1]; }
    const float s = wave_sum(v0 + v1);
    if (lane == 0) sred[wave] = s;
    __syncthreads();
    float mean = 0.f;
#pragma unroll
    for (int w = 0; w < 8; ++w) mean += sred[w];
    mean *= (1.0f / 1024.0f);
    __syncthreads();
    const float d0 = v0 - mean, d1 = v1 - mean;
    const float q = wave_sum(d0 * d0 + d1 * d1);
    if (lane == 0) sred[wave] = q;
    __syncthreads();
    float var = 0.f;
#pragma unroll
    for (int w = 0; w < 8; ++w) var += sred[w];
    const float rs = rsqrtf(var * (1.0f / 1024.0f) + LN_EPS);
    const float o0 = d0 * rs * g[tid * 2] + bta[tid * 2], o1 = d1 * rs * g[tid * 2 + 1] + bta[tid * 2 + 1];
    *(float2*)(orow + tid * 2) = make_float2(o0, o1);
    if (obrow) *(unsigned*)(obrow + tid * 2) = pk2(o0, o1);
    __syncthreads();
}

__device__ __forceinline__ void row_to_fp8_sliced(const float* __restrict__ xrow, unsigned char* __restrict__ tab, int r, float* __restrict__ scale, int lane) {
    f32x4 v[4]; float am = 0.f;
#pragma unroll
    for (int j = 0; j < 4; ++j) { v[j] = *(const f32x4*)(xrow + lane * 16 + j * 4); am = fmaxf(am, fmaxf(fmaxf(fabsf(v[j].x), fabsf(v[j].y)), fmaxf(fabsf(v[j].z), fabsf(v[j].w)))); }
    am = wave_max(am);
    const float s = am > 0.f ? am * (1.0f / 448.0f) : 1.0f, inv = 1.0f / s;
    v4u o; unsigned w;
    w = 0u; w = __builtin_amdgcn_cvt_pk_fp8_f32(v[0].x * inv, v[0].y * inv, w, false); w = __builtin_amdgcn_cvt_pk_fp8_f32(v[0].z * inv, v[0].w * inv, w, true); o.x = w;
    w = 0u; w = __builtin_amdgcn_cvt_pk_fp8_f32(v[1].x * inv, v[1].y * inv, w, false); w = __builtin_amdgcn_cvt_pk_fp8_f32(v[1].z * inv, v[1].w * inv, w, true); o.y = w;
    w = 0u; w = __builtin_amdgcn_cvt_pk_fp8_f32(v[2].x * inv, v[2].y * inv, w, false); w = __builtin_amdgcn_cvt_pk_fp8_f32(v[2].z * inv, v[2].w * inv, w, true); o.z = w;
    w = 0u; w = __builtin_amdgcn_cvt_pk_fp8_f32(v[3].x * inv, v[3].y * inv, w, false); w = __builtin_amdgcn_cvt_pk_fp8_f32(v[3].z * inv, v[3].w * inv, w, true); o.w = w;
    *(v4u*)(tab + ((size_t)(lane >> 3) * 16384 + r) * 128 + (lane & 7) * 16) = o;
    if (lane == 0) *scale = s;
}
__device__ __forceinline__ void peer_u_pass(const bf16* __restrict__ xrow, const int* __restrict__ exr, const unsigned char* __restrict__ U8x, float* __restrict__ pd, int x, int lane) {
    const int e8 = lane >> 3, c = lane & 7;
    f32x2_t xp[8];
#pragma unroll
    for (int j = 0; j < 2; ++j) { const v4u t = *(const v4u*)(xrow + x * 128 + c * 16 + j * 8);
        xp[j * 4 + 0] = (f32x2_t){bflo(t.x), bfhi(t.x)}; xp[j * 4 + 1] = (f32x2_t){bflo(t.y), bfhi(t.y)}; xp[j * 4 + 2] = (f32x2_t){bflo(t.z), bfhi(t.z)}; xp[j * 4 + 3] = (f32x2_t){bflo(t.w), bfhi(t.w)}; }
    const __amdgpu_buffer_rsrc_t ursrc = __builtin_amdgcn_make_buffer_rsrc((void*)U8x, 0, 16384 * 128, 0x00020000);
    v4u wa[8], wb[8];
    float d[16];
    int ids[16];
#pragma unroll
    for (int j = 0; j < 4; ++j) { const v4u t = *(const v4u*)(exr + e8 * 16 + j * 4); ids[j * 4 + 0] = (int)t.x; ids[j * 4 + 1] = (int)t.y; ids[j * 4 + 2] = (int)t.z; ids[j * 4 + 3] = (int)t.w; }
#pragma unroll
    for (int g = 0; g < 8; ++g) wa[g] = __builtin_amdgcn_raw_buffer_load_b128(ursrc, ids[g] * 128 + c * 16, 0, 0);
#pragma unroll
    for (int g = 0; g < 8; ++g) wb[g] = __builtin_amdgcn_raw_buffer_load_b128(ursrc, ids[8 + g] * 128 + c * 16, 0, 0);
#define PU_DOT1(w_, k_) do { a_ = __builtin_elementwise_fma(__builtin_amdgcn_cvt_pk_f32_fp8((w_), false), xp[(k_) * 2], a_); a_ = __builtin_elementwise_fma(__builtin_amdgcn_cvt_pk_f32_fp8((w_), true), xp[(k_) * 2 + 1], a_); } while (0)
#pragma unroll
    for (int g = 0; g < 8; ++g) { f32x2_t a_ = (f32x2_t){0.f, 0.f}; PU_DOT1(wa[g].x, 0); PU_DOT1(wa[g].y, 1); PU_DOT1(wa[g].z, 2); PU_DOT1(wa[g].w, 3); d[g] = a_.x + a_.y; }
#pragma unroll
    for (int g = 0; g < 8; ++g) { f32x2_t a_ = (f32x2_t){0.f, 0.f}; PU_DOT1(wb[g].x, 0); PU_DOT1(wb[g].y, 1); PU_DOT1(wb[g].z, 2); PU_DOT1(wb[g].w, 3); d[8 + g] = a_.x + a_.y; }
#pragma unroll
    for (int g = 0; g < 16; ++g) { d[g] += DPPF(d[g], 0xB1, 0xf); d[g] += DPPF(d[g], 0x4E, 0xf); d[g] += DPPF(d[g], 0x141, 0xf); }
    if (c == 0) {
#pragma unroll
        for (int j = 0; j < 4; ++j) *(f32x4*)(pd + e8 * 16 + j * 4) = (f32x4){d[j * 4 + 0], d[j * 4 + 1], d[j * 4 + 2], d[j * 4 + 3]};
    }
}
#define PV_LOAD(VB, grp) do { _Pragma("unroll") for (int i_ = 0; i_ < 4; ++i_) { const int e_ = (grp) * 4 + i_; \
        const int id_ = __builtin_amdgcn_readlane(e_ < 64 ? id0 : id1, e_ & 63); \
        VB[i_] = __builtin_amdgcn_raw_buffer_load_b128(vrsrc, voff, (unsigned)id_ * 1024u, 0); } } while (0)
#define PV_COMP(VB, grp) do { _Pragma("unroll") for (int i_ = 0; i_ < 4; ++i_) { const int e_ = (grp) * 4 + i_; \
        const float cf_ = __uint_as_float(__builtin_amdgcn_readlane(__float_as_uint(e_ < 64 ? cf0 : cf1), e_ & 63)); \
        PE_AXPY4(VB[i_].x, 0); PE_AXPY4(VB[i_].y, 1); PE_AXPY4(VB[i_].z, 2); PE_AXPY4(VB[i_].w, 3); } } while (0)
#define PV_COEFS() \
    const int id0 = exr[lane], id1 = exr[64 + lane]; \
    float dot0 = 0.f, dot1 = 0.f; \
    { const int p0 = lane, p1 = 64 + lane;        \
      _Pragma("unroll") for (int x_ = 0; x_ < 8; ++x_) { dot0 += pdt[(size_t)x_ * NT * 128 + p0]; dot1 += pdt[(size_t)x_ * NT * 128 + p1]; } } \
    const float cf0 = gar[lane] * SV[id0] * geluf_(SU[id0] * dot0), cf1 = gar[64 + lane] * SV[id1] * geluf_(SU[id1] * dot1);
__device__ __forceinline__ void peer_v_w(const float* __restrict__ xrow, const int* __restrict__ exr, const float* __restrict__ gar, const float* __restrict__ pdt,
                                         const unsigned char* __restrict__ V, const float* __restrict__ SU, const float* __restrict__ SV,
                                         const float* __restrict__ g, const float* __restrict__ bta, float* __restrict__ orow, bf16* __restrict__ obrow, int lane) {
    const __amdgpu_buffer_rsrc_t vrsrc = __builtin_amdgcn_make_buffer_rsrc((void*)V, 0, 16384 * 1024, 0x00020000);
    const int voff = lane * 16;
    PV_COEFS()
    float acc[16];
#pragma unroll
    for (int i = 0; i < 16; ++i) acc[i] = 0.f;
    v4u va[4], vb[4], vc[4];
    PV_LOAD(va, 0); PV_LOAD(vb, 1);
#pragma unroll 1
    for (int grp = 0; grp < 30; grp += 3) {
        PV_LOAD(vc, grp + 2);
        PV_COMP(va, grp);
        PV_LOAD(va, grp + 3);
        PV_COMP(vb, grp + 1);
        PV_LOAD(vb, grp + 4);
        PV_COMP(vc, grp + 2);
    }
    PV_COMP(va, 30); PV_COMP(vb, 31);
    float xv[16];
#pragma unroll
    for (int j = 0; j < 4; ++j) { const f32x4 t = *(const f32x4*)(xrow + lane * 16 + j * 4); xv[j * 4 + 0] = t.x; xv[j * 4 + 1] = t.y; xv[j * 4 + 2] = t.z; xv[j * 4 + 3] = t.w; }
    float v[16]; float s = 0.f;
#pragma unroll
    for (int i = 0; i < 16; ++i) { v[i] = ALPHA * xv[i] + acc[i]; s += v[i]; }
    const float mean = wave_sum(s) * (1.0f / 1024.0f); float q = 0.f;
#pragma unroll
    for (int i = 0; i < 16; ++i) { v[i] -= mean; q += v[i] * v[i]; }
    const float rs = rsqrtf(wave_sum(q) * (1.0f / 1024.0f) + LN_EPS);
    float o[16];
#pragma unroll
    for (int j = 0; j < 4; ++j) {
        const f32x4 g4 = *(const f32x4*)(g + lane * 16 + j * 4), b4 = *(const f32x4*)(bta + lane * 16 + j * 4);
        o[j * 4 + 0] = v[j * 4 + 0] * rs * g4.x + b4.x; o[j * 4 + 1] = v[j * 4 + 1] * rs * g4.y + b4.y; o[j * 4 + 2] = v[j * 4 + 2] * rs * g4.z + b4.z; o[j * 4 + 3] = v[j * 4 + 3] * rs * g4.w + b4.w;
        *(f32x4*)(orow + lane * 16 + j * 4) = (f32x4){o[j * 4 + 0], o[j * 4 + 1], o[j * 4 + 2], o[j * 4 + 3]};
    }
    if (obrow) {
        v4u w0, w1; w0.x = pk2(o[0], o[1]); w0.y = pk2(o[2], o[3]); w0.z = pk2(o[4], o[5]); w0.w = pk2(o[6], o[7]); w1.x = pk2(o[8], o[9]); w1.y = pk2(o[10], o[11]); w1.z = pk2(o[12], o[13]); w1.w = pk2(o[14], o[15]);
        *(v4u*)(obrow + lane * 16) = w0; *(v4u*)(obrow + lane * 16 + 8) = w1;
    }
}
__device__ __forceinline__ void peer_v_blk(const float* __restrict__ xrow, const int* __restrict__ exr, const float* __restrict__ gar, const float* __restrict__ pdt,
                                           const unsigned char* __restrict__ V, const float* __restrict__ SU, const float* __restrict__ SV,
                                           const float* __restrict__ g, const float* __restrict__ bta, float* __restrict__ orow, bf16* __restrict__ obrow, int lane, int wave, float* smem) {
    const __amdgpu_buffer_rsrc_t vrsrc = __builtin_amdgcn_make_buffer_rsrc((void*)V, 0, 16384 * 1024, 0x00020000);
    const int voff = lane * 16;
    PV_COEFS()
    float acc[16];
#pragma unroll
    for (int i = 0; i < 16; ++i) acc[i] = 0.f;
    v4u va[4], vb[4], vc[4], vd[4];
    PV_LOAD(va, wave * 4); PV_LOAD(vb, wave * 4 + 1); PV_LOAD(vc, wave * 4 + 2); PV_LOAD(vd, wave * 4 + 3);
    PV_COMP(va, wave * 4); PV_COMP(vb, wave * 4 + 1); PV_COMP(vc, wave * 4 + 2); PV_COMP(vd, wave * 4 + 3);
    float* accs = smem;
    float* sred = smem + 8192;
#pragma unroll
    for (int j = 0; j < 4; ++j) *(f32x4*)(accs + wave * 1024 + lane * 16 + j * 4) = (f32x4){acc[j * 4 + 0], acc[j * 4 + 1], acc[j * 4 + 2], acc[j * 4 + 3]};
    __syncthreads();
    const int tid = wave * 64 + lane;
    float v0 = ALPHA * xrow[tid * 2], v1 = ALPHA * xrow[tid * 2 + 1];
#pragma unroll
    for (int w = 0; w < 8; ++w) { v0 += accs[w * 1024 + tid * 2]; v1 += accs[w * 1024 + tid * 2 + 1]; }
    const float s = wave_sum(v0 + v1);
    if (lane == 0) sred[wave] = s;
    __syncthreads();
    float mean = 0.f;
#pragma unroll
    for (int w = 0; w < 8; ++w) mean += sred[w];
    mean *= (1.0f / 1024.0f);
    __syncthreads();
    const float d0 = v0 - mean, d1 = v1 - mean;
    const float q = wave_sum(d0 * d0 + d1 * d1);
    if (lane == 0) sred[wave] = q;
    __syncthreads();
    float var = 0.f;
#pragma unroll
    for (int w = 0; w < 8; ++w) var += sred[w];
    const float rs = rsqrtf(var * (1.0f / 1024.0f) + LN_EPS);
    const float o0 = d0 * rs * g[tid * 2] + bta[tid * 2], o1 = d1 * rs * g[tid * 2 + 1] + bta[tid * 2 + 1];
    *(float2*)(orow + tid * 2) = make_float2(o0, o1);
    if (obrow) *(unsigned*)(obrow + tid * 2) = pk2(o0, o1);
    __syncthreads();
}

__device__ __forceinline__ void peer_xk(const int* __restrict__ exr, float* __restrict__ gar, const float* __restrict__ pdt, const float* __restrict__ SU, const float* __restrict__ SV, int lane) {
    PV_COEFS()
    gar[lane] = cf0; gar[64 + lane] = cf1;
}
__device__ __forceinline__ void peer_v_slice(const int* __restrict__ exr, const float* __restrict__ cfr, const unsigned char* __restrict__ V8x, float* __restrict__ outs  , int lane) {
    const int e8 = lane >> 3, c = lane & 7;
    const __amdgpu_buffer_rsrc_t vrsrc = __builtin_amdgcn_make_buffer_rsrc((void*)V8x, 0, 16384 * 128, 0x00020000);
    v4u wa[8], wb[8]; float cfa[8], cfb[8];
    int ids[16];
#pragma unroll
    for (int j = 0; j < 4; ++j) { const v4u t = *(const v4u*)(exr + e8 * 16 + j * 4); ids[j * 4 + 0] = (int)t.x; ids[j * 4 + 1] = (int)t.y; ids[j * 4 + 2] = (int)t.z; ids[j * 4 + 3] = (int)t.w; }
#pragma unroll
    for (int g = 0; g < 8; ++g) wa[g] = __builtin_amdgcn_raw_buffer_load_b128(vrsrc, ids[g] * 128 + c * 16, 0, 0);
#pragma unroll
    for (int g = 0; g < 8; ++g) wb[g] = __builtin_amdgcn_raw_buffer_load_b128(vrsrc, ids[8 + g] * 128 + c * 16, 0, 0);
#pragma unroll
    for (int j = 0; j < 2; ++j) { const f32x4 t = *(const f32x4*)(cfr + e8 * 16 + j * 4), u = *(const f32x4*)(cfr + e8 * 16 + 8 + j * 4);
        cfa[j * 4 + 0] = t.x; cfa[j * 4 + 1] = t.y; cfa[j * 4 + 2] = t.z; cfa[j * 4 + 3] = t.w; cfb[j * 4 + 0] = u.x; cfb[j * 4 + 1] = u.y; cfb[j * 4 + 2] = u.z; cfb[j * 4 + 3] = u.w; }
    f32x2_t ap[8];
#pragma unroll
    for (int i = 0; i < 8; ++i) ap[i] = (f32x2_t){0.f, 0.f};
#define PVS_AXPY(w_, k_) do { ap[(k_) * 2] = __builtin_elementwise_fma(cf2_, __builtin_amdgcn_cvt_pk_f32_fp8((w_), false), ap[(k_) * 2]); ap[(k_) * 2 + 1] = __builtin_elementwise_fma(cf2_, __builtin_amdgcn_cvt_pk_f32_fp8((w_), true), ap[(k_) * 2 + 1]); } while (0)
#pragma unroll
    for (int g = 0; g < 8; ++g) { const f32x2_t cf2_ = (f32x2_t){cfa[g], cfa[g]}; PVS_AXPY(wa[g].x, 0); PVS_AXPY(wa[g].y, 1); PVS_AXPY(wa[g].z, 2); PVS_AXPY(wa[g].w, 3); }
#pragma unroll
    for (int g = 0; g < 8; ++g) { const f32x2_t cf2_ = (f32x2_t){cfb[g], cfb[g]}; PVS_AXPY(wb[g].x, 0); PVS_AXPY(wb[g].y, 1); PVS_AXPY(wb[g].z, 2); PVS_AXPY(wb[g].w, 3); }
#undef PVS_AXPY
    float acc[16];
#pragma unroll
    for (int i = 0; i < 8; ++i) { acc[2 * i] = ap[i].x; acc[2 * i + 1] = ap[i].y; }
#pragma unroll
    for (int i = 0; i < 16; ++i) { float v = acc[i]; v += DPPF(v, 0x128, 0xf); v += __shfl_xor(v, 16); v += __shfl_xor(v, 32); acc[i] = v; }
    if (e8 == 0) {
#pragma unroll
        for (int j = 0; j < 4; ++j) *(f32x4*)(outs + c * 16 + j * 4) = (f32x4){acc[j * 4 + 0], acc[j * 4 + 1], acc[j * 4 + 2], acc[j * 4 + 3]};
    }
}
__device__ __forceinline__ void peer_xc(const bf16* __restrict__ xrow, const float* __restrict__ srow, const float* __restrict__ g, const float* __restrict__ bta, float* __restrict__ orow, bf16* __restrict__ obrow, bf16* __restrict__ obrow2, int lane) {
    float v[16]; float s = 0.f;
#pragma unroll
    for (int j = 0; j < 4; ++j) { const v2u ab = *(const v2u*)(xrow + lane * 16 + j * 4); const f32x4 b = *(const f32x4*)(srow + lane * 16 + j * 4);
        v[j * 4 + 0] = ALPHA * bflo(ab.x) + b.x; v[j * 4 + 1] = ALPHA * bfhi(ab.x) + b.y; v[j * 4 + 2] = ALPHA * bflo(ab.y) + b.z; v[j * 4 + 3] = ALPHA * bfhi(ab.y) + b.w; }
#pragma unroll
    for (int i = 0; i < 16; ++i) s += v[i];
    const float mean = wave_sum(s) * (1.0f / 1024.0f); float q = 0.f;
#pragma unroll
    for (int i = 0; i < 16; ++i) { v[i] -= mean; q += v[i] * v[i]; }
    const float rs = rsqrtf(wave_sum(q) * (1.0f / 1024.0f) + LN_EPS);
    float o[16];
#pragma unroll
    for (int j = 0; j < 4; ++j) {
        const f32x4 g4 = *(const f32x4*)(g + lane * 16 + j * 4), b4 = *(const f32x4*)(bta + lane * 16 + j * 4);
        o[j * 4 + 0] = v[j * 4 + 0] * rs * g4.x + b4.x; o[j * 4 + 1] = v[j * 4 + 1] * rs * g4.y + b4.y; o[j * 4 + 2] = v[j * 4 + 2] * rs * g4.z + b4.z; o[j * 4 + 3] = v[j * 4 + 3] * rs * g4.w + b4.w;
        if (orow) *(f32x4*)(orow + lane * 16 + j * 4) = (f32x4){o[j * 4 + 0], o[j * 4 + 1], o[j * 4 + 2], o[j * 4 + 3]};
    }
    if (obrow) {
        v4u w0, w1; w0.x = pk2(o[0], o[1]); w0.y = pk2(o[2], o[3]); w0.z = pk2(o[4], o[5]); w0.w = pk2(o[6], o[7]); w1.x = pk2(o[8], o[9]); w1.y = pk2(o[10], o[11]); w1.z = pk2(o[12], o[13]); w1.w = pk2(o[14], o[15]);
        *(v4u*)(obrow + lane * 16) = w0; *(v4u*)(obrow + lane * 16 + 8) = w1;
        if (obrow2) { *(v4u*)(obrow2 + lane * 16) = w0; *(v4u*)(obrow2 + lane * 16 + 8) = w1; }
    }
}

__device__ __forceinline__ int t5_bucket(int n) {
    if (n < 16) return n;
    const int large = 16 + (int)(logf((float)n / 16.0f) / 2.0794415416798357f * 16.0f);
    return large < 31 ? large : 31;
}
__device__ __forceinline__ void swa_attn(const float* __restrict__ PC, const float* __restrict__ cache_k, const float* __restrict__ cache_v,
                                         const float* __restrict__ rel_bias, const float* __restrict__ sinks, bf16* __restrict__ ATT, int bx) {
    const int tid = threadIdx.x, lane = tid & 63, wid = tid >> 6;
    const int gw = bx * 8 + wid;
    const int t = gw >> 4, h = gw & 15, kvh = h >> 2;
    if (t >= NT) return;
    const bool samp = t >= NP; const int sb = t - NP, pos = t % SEQ;
    const float* qrow = PC + (size_t)t * CN + h * 64;
    float lg[2]; bool valid[2];
#pragma unroll
    for (int rr = 0; rr < 2; ++rr) {
        const int r = lane + 64 * rr;
        const float* krow;
        if (!samp) { valid[rr] = (pos - r) >= 0; krow = PC + (size_t)(valid[rr] ? t - r : t) * CN + 1024 + kvh * 64; }
        else { valid[rr] = true; krow = (r == 0) ? PC + (size_t)t * CN + 1024 + kvh * 64 : cache_k + (((size_t)sb * 128 + (128 - r)) * 4 + kvh) * 64; }
        float dot = 0.f;
#pragma unroll
        for (int d4 = 0; d4 < 16; ++d4) {
            const float4 kv = *(const float4*)(krow + d4 * 4);
            const float4 qv = *(const float4*)(qrow + d4 * 4);
            dot += qv.x * kv.x + qv.y * kv.y + qv.z * kv.z + qv.w * kv.w;
        }
        lg[rr] = valid[rr] ? dot * 0.125f + rel_bias[t5_bucket(r) * 16 + h] : -INFINITY;
    }
    const float sink = sinks[h];
    const float m = fmaxf(wave_max(fmaxf(lg[0], lg[1])), sink);
    float p[2];
#pragma unroll
    for (int rr = 0; rr < 2; ++rr) p[rr] = valid[rr] ? expf(lg[rr] - m) : 0.f;
    const float den = wave_sum(p[0] + p[1]) + expf(sink - m);
    const float inv = 1.0f / den;
    float o = 0.f;
#pragma unroll
    for (int rr = 0; rr < 2; ++rr)
        for (int l2 = 0; l2 < 64; ++l2) {
            const int r = l2 + 64 * rr;
            const float pj = __shfl(p[rr], l2);
            if (pj != 0.f) {
                const float* vrow;
                if (!samp) vrow = PC + (size_t)(t - r) * CN + 1280 + kvh * 64;
                else vrow = (r == 0) ? PC + (size_t)t * CN + 1280 + kvh * 64 : cache_v + (((size_t)sb * 128 + (128 - r)) * 4 + kvh) * 64;
                o += pj * vrow[lane];
            }
        }
    ATT[(size_t)t * D + h * 64 + lane] = (bf16)f2bf(o * inv);
}

__device__ __forceinline__ void swa_kv_out(const float* __restrict__ PC, const float* __restrict__ cache_k, const float* __restrict__ cache_v,
                                           float* __restrict__ pk, float* __restrict__ pv, float* __restrict__ sk, float* __restrict__ sv, int vb) {
    const int c = threadIdx.x & 255, row = vb * 2 + (threadIdx.x >> 8);
    if (row < NB * 128) {
        const int b = row >> 7, i = row & 127;
        const float* src = PC + (size_t)(b * SEQ + SEQ - 128 + i) * CN;
        pk[(size_t)row * 256 + c] = src[1024 + c];
        pv[(size_t)row * 256 + c] = src[1280 + c];
    } else {
        const int r2 = row - NB * 128, sb = r2 >> 7, i = r2 & 127;
        if (i < 127) {
            sk[(size_t)r2 * 256 + c] = cache_k[((size_t)sb * 128 + i + 1) * 256 + c];
            sv[(size_t)r2 * 256 + c] = cache_v[((size_t)sb * 128 + i + 1) * 256 + c];
        } else {
            const float* src = PC + (size_t)(NP + sb) * CN;
            sk[(size_t)r2 * 256 + c] = src[1024 + c];
            sv[(size_t)r2 * 256 + c] = src[1280 + c];
        }
    }
}
#define XB_TMO      128
#define XB_XCNT(j)  (256  + 64 * (j))
#define XB_XSUB(j)  (1280 + 64 * (j))
#define XB_XGEN(j)  (2304 + 64 * (j))
#define XB_TOP      3328
#define XB_TOPGEN   3392
#define XCD_BAR_WORDS 3456
#define XB_SPIN_CAP (1u << 18)

__device__ __forceinline__ unsigned xb_ld(unsigned* p)              { return __hip_atomic_load(p, __ATOMIC_RELAXED, __HIP_MEMORY_SCOPE_AGENT); }
__device__ __forceinline__ unsigned xb_add(unsigned* p, unsigned v) { return __hip_atomic_fetch_add(p, v, __ATOMIC_RELAXED, __HIP_MEMORY_SCOPE_AGENT); }
__device__ __forceinline__ unsigned xb_xcc_id() { return (unsigned)__builtin_amdgcn_s_getreg((3 << 11) | 20) & 0xFu; }
#define XB_SPIN(cond, bar) do { unsigned _sp = 0; while (cond) { __builtin_amdgcn_s_sleep(1); \
    if ((++_sp & 255u) == 0u) { if (xb_ld(&(bar)[XB_TMO])) break; if (_sp > XB_SPIN_CAP) { atomicAdd(&(bar)[XB_TMO], 1u); break; } } } } while (0)

struct XcdBarrier {
    unsigned* bar; unsigned x;
    volatile LAS unsigned* st;
};

__device__ __forceinline__ XcdBarrier xcd_barrier_post(unsigned* bar, volatile LAS unsigned* st) {
    XcdBarrier b; b.bar = bar; b.x = xb_xcc_id(); b.st = st;
    if (threadIdx.x == 0) (void)xb_add(&bar[XB_XCNT(b.x)], 1u);
    return b;
}
__device__ __forceinline__ void xcd_barrier_complete(unsigned* bar, unsigned x, unsigned& nloc, unsigned& nx) {
    const unsigned G = gridDim.x * gridDim.y * gridDim.z;
    unsigned sum, cnt, mine, sp = 0u;
    for (;;) {
        sum = 0u; cnt = 0u; mine = 0u;
#pragma unroll
        for (unsigned j = 0; j < 16; ++j) { const unsigned c = xb_ld(&bar[XB_XCNT(j)]); sum += c; cnt += (c > 0u) ? 1u : 0u; mine = (j == x) ? c : mine; }
        if (sum == G) break;
        __builtin_amdgcn_s_sleep(1);
        if ((++sp & 255u) == 0u) { if (xb_ld(&bar[XB_TMO])) break; if (sp > XB_SPIN_CAP) { atomicAdd(&bar[XB_TMO], 1u); break; } }
    }
    nloc = mine > 0u ? mine : 1u; nx = cnt > 0u ? cnt : 1u;
}

__device__ __forceinline__ void xcd_barrier(const XcdBarrier& b) {
    asm volatile("s_waitcnt vmcnt(0)" ::: "memory");
    __syncthreads();
    if (threadIdx.x == 0) {
        unsigned* bar = b.bar;
        __builtin_amdgcn_s_waitcnt(0);
        unsigned nloc = b.st[0], nx = b.st[1];
        if (nloc == 0u) { xcd_barrier_complete(bar, b.x, nloc, nx); b.st[0] = nloc; b.st[1] = nx; }
        const unsigned old = xb_add(&bar[XB_XSUB(b.x)], 1u);
        const unsigned gen = old / nloc;
        if (old + 1u == (gen + 1u) * nloc) {
            __builtin_amdgcn_fence(__ATOMIC_RELEASE, "agent");
            asm volatile("s_waitcnt vmcnt(0)" ::: "memory");
            const unsigned og = xb_add(&bar[XB_TOP], 1u);
            const unsigned tg = og / nx;
            if (og + 1u == (tg + 1u) * nx) xb_add(&bar[XB_TOPGEN], 1u);
            else XB_SPIN(xb_ld(&bar[XB_TOPGEN]) == tg, bar);
            __builtin_amdgcn_fence(__ATOMIC_ACQUIRE, "agent");
            xb_add(&bar[XB_XGEN(b.x)], 1u);
            asm volatile("s_waitcnt vmcnt(0)" ::: "memory");
        } else {
            XB_SPIN(xb_ld(&bar[XB_XGEN(b.x)]) == gen, bar);
            __builtin_amdgcn_fence(__ATOMIC_ACQUIRE, "agent");
            asm volatile("s_waitcnt vmcnt(0)" ::: "memory");
        }
    }
    __syncthreads();
}

typedef short bf16x8_t __attribute__((ext_vector_type(8)));
__device__ __forceinline__ f32x4 mfma16(bf16x8_t a, bf16x8_t b, f32x4 c) { return __builtin_amdgcn_mfma_f32_16x16x32_bf16(a, b, c, 0, 0, 0); }

struct GdnChunkBufs {
    bf16* W;
    bf16* QG;
    bf16* KDT;
    bf16* UT;
    bf16* QK;
    float* EGL;
};

constexpr int GP_QB = 0, GP_KB = 17408, GP_VB = 34816, GP_LS = 52224, GP_QKS = 69632, GP_WS = 78848, GP_SC = 96256;

__device__ __forceinline__ void gdn_prep_unit(const bf16* __restrict__ PROJ, const float* __restrict__ conv_w, const float* __restrict__ a_log, const float* __restrict__ dt_bias,
                                              const GdnChunkBufs& cb, float* __restrict__ p_gdn_conv, int un, unsigned char* lds) {
    int tid = threadIdx.x; asm volatile("" : "+v"(tid));
    const int lane = tid & 63, wave = __builtin_amdgcn_readfirstlane(tid >> 6), fr = lane & 15, fq = lane >> 4;
    const int h = un & 3, n = (un >> 2) & 63, b = un >> 8;
    const int t0 = b * SEQ + n * 64;
    bf16* Qb = (bf16*)(lds + GP_QB); bf16* Kb = (bf16*)(lds + GP_KB); bf16* Vb = (bf16*)(lds + GP_VB); bf16* Ws = (bf16*)(lds + GP_WS);
    float* Ls = (float*)(lds + GP_LS); bf16* QKs = (bf16*)(lds + GP_QKS);
    float* gcs = (float*)(lds + GP_SC); float* bets = gcs + 64; float* egcs = gcs + 128; float* ekds = gcs + 192; float* begs = gcs + 256;
    if (wave == 0) {
        const bf16* prow = PROJ + (size_t)(t0 + lane) * ABN;
        const float a_raw = bf2f(prow[C_A + h]), b_raw = bf2f(prow[C_B + h]);
        float g = -expf(a_log[h]) * softplusf_(a_raw + dt_bias[h]);
#pragma unroll
        for (int off = 1; off < 64; off <<= 1) { const float v = __shfl_up(g, off); if (lane >= off) g += v; }
        const float glast = __shfl(g, 63);
        { const float be_ = sigmoidf_(b_raw), eg_ = expf(g); gcs[lane] = g; bets[lane] = be_; egcs[lane] = eg_; ekds[lane] = expf(glast - g); begs[lane] = be_ * eg_; }
        if (lane == 0) cb.EGL[un] = expf(glast);
    }
    {
        int cols[6]; float cw[4][6], xw[3][6];
#pragma unroll
        for (int p = 0; p < 3; ++p)
#pragma unroll
            for (int e = 0; e < 2; ++e) cols[p * 2 + e] = p * 512 + h * 128 + e * 64 + lane;
#pragma unroll
        for (int i = 0; i < 4; ++i)
#pragma unroll
            for (int c = 0; c < 6; ++c) cw[i][c] = conv_w[i * 1536 + cols[c]];
        const int i0 = wave * 8;
#pragma unroll
        for (int k = 0; k < 3; ++k) {
            const int pos = n * 64 + i0 - 3 + k;
#pragma unroll
            for (int c = 0; c < 6; ++c) xw[k][c] = pos >= 0 ? bf2f(PROJ[(size_t)(t0 + i0 - 3 + k) * ABN + cols[c]]) : 0.f;
        }
        bf16 xraw[8][6];
#pragma unroll
        for (int ii = 0; ii < 8; ++ii)
#pragma unroll
            for (int c = 0; c < 6; ++c) xraw[ii][c] = PROJ[(size_t)(t0 + i0 + ii) * ABN + cols[c]];
#pragma unroll
        for (int ii = 0; ii < 8; ++ii) {
            const int i = i0 + ii;
            float xt[6], s[6];
#pragma unroll
            for (int c = 0; c < 6; ++c) xt[c] = bf2f(xraw[ii][c]);
#pragma unroll
            for (int c = 0; c < 6; ++c) { const float y_ = cw[0][c] * xw[0][c] + cw[1][c] * xw[1][c] + cw[2][c] * xw[2][c] + cw[3][c] * xt[c]; s[c] = y_ * __frcp_rn(1.0f + __expf(-y_)); }
            const float qs = rsqrtf(wave_sum(s[0] * s[0] + s[1] * s[1]) + 1e-6f) * 0.08838834764831845f;
            const float ks = rsqrtf(wave_sum(s[2] * s[2] + s[3] * s[3]) + 1e-6f);
            Qb[i * 136 + lane] = (bf16)f2bf(s[0] * qs); Qb[i * 136 + 64 + lane] = (bf16)f2bf(s[1] * qs);
            Kb[i * 136 + lane] = (bf16)f2bf(s[2] * ks); Kb[i * 136 + 64 + lane] = (bf16)f2bf(s[3] * ks);
            Vb[i * 136 + lane] = (bf16)f2bf(s[4]);      Vb[i * 136 + 64 + lane] = (bf16)f2bf(s[5]);
            if (n == 63 && i >= 61) {
#pragma unroll
                for (int c = 0; c < 6; ++c) p_gdn_conv[((size_t)b * 3 + (i - 61)) * 1536 + cols[c]] = xt[c];
            }
#pragma unroll
            for (int c = 0; c < 6; ++c) { xw[0][c] = xw[1][c]; xw[1][c] = xw[2][c]; xw[2][c] = xt[c]; }
        }
    }
    __syncthreads();
    {
        const int mi = wave >> 1;
        bf16x8_t aK[4], aQ[4];
#pragma unroll
        for (int ks = 0; ks < 4; ++ks) { aK[ks] = *(const bf16x8_t*)(Kb + (mi * 16 + fr) * 136 + ks * 32 + 8 * fq); aQ[ks] = *(const bf16x8_t*)(Qb + (mi * 16 + fr) * 136 + ks * 32 + 8 * fq); }
#pragma unroll
        for (int nn = 0; nn < 2; ++nn) {
            const int nj = (wave & 1) * 2 + nn;
            f32x4 accK = (f32x4){0.f, 0.f, 0.f, 0.f}, accQ = accK;
#pragma unroll
            for (int ks = 0; ks < 4; ++ks) { const bf16x8_t bk = *(const bf16x8_t*)(Kb + (nj * 16 + fr) * 136 + ks * 32 + 8 * fq); accK = mfma16(aK[ks], bk, accK); accQ = mfma16(aQ[ks], bk, accQ); }
            const int j = nj * 16 + fr; const float gj = gcs[j];
#pragma unroll
            for (int r = 0; r < 4; ++r) {
                const int i = mi * 16 + 4 * fq + r;
                const float dec = i >= j ? expf(gcs[i] - gj) : 0.f;
                Ls[j * 68 + i] = i > j ? bets[i] * accK[r] * dec : 0.f;
                QKs[i * 72 + j] = (bf16)f2bf(i >= j ? accQ[r] * dec : 0.f);
            }
        }
    }
    __syncthreads();
    if (wave < 4) {
        float x[64];
        const bool isu = tid < 128; const int c = isu ? tid : tid - 128;
        const LAS unsigned char* l3 = (const LAS unsigned char*)lds;
        unsigned so = (isu ? GP_VB : GP_KB) + c * 2, ro = GP_SC + (isu ? 64 * 4 : 256 * 4), lo = GP_LS;
        asm volatile("" : "+v"(so), "+v"(ro), "+v"(lo));
#pragma unroll
        for (int i = 0; i < 64; ++i) x[i] = *(const LAS float*)(l3 + ro + 4 * i) * bf2f(*(const LAS bf16*)(l3 + so + i * 272));
#pragma unroll
        for (int j = 0; j < 63; ++j) {
#pragma unroll
            for (int i4 = (j + 1) / 4; i4 < 16; ++i4) {
                const f32x4 l4 = *(const LAS f32x4*)(l3 + lo + j * 272 + i4 * 16);
                if (i4 * 4 + 0 > j) x[i4 * 4 + 0] -= l4.x * x[j];
                if (i4 * 4 + 1 > j) x[i4 * 4 + 1] -= l4.y * x[j];
                if (i4 * 4 + 2 > j) x[i4 * 4 + 2] -= l4.z * x[j];
                if (i4 * 4 + 3 > j) x[i4 * 4 + 3] -= l4.w * x[j];
            }
        }
        if (isu) {
            bf16* dst = cb.UT + ((size_t)un * 128 + c) * 64;
#pragma unroll
            for (int i8 = 0; i8 < 8; ++i8) { v4u o; o.x = pk2(x[i8 * 8 + 0], x[i8 * 8 + 1]); o.y = pk2(x[i8 * 8 + 2], x[i8 * 8 + 3]); o.z = pk2(x[i8 * 8 + 4], x[i8 * 8 + 5]); o.w = pk2(x[i8 * 8 + 6], x[i8 * 8 + 7]); *(v4u*)(dst + i8 * 8) = o; }
        } else {
#pragma unroll
            for (int i = 0; i < 64; ++i) Ws[i * 136 + c] = (bf16)f2bf(x[i]);
        }
    } else {
        const int t2 = tid - 256;
#pragma unroll
        for (int k = 0; k < 4; ++k) {
            const int ci = t2 + 256 * k, i = ci >> 4, d0 = (ci & 15) * 8; const float e = egcs[i];
            const v4u q = *(const v4u*)(Qb + i * 136 + d0);
            v4u o; o.x = pk2(bflo(q.x) * e, bfhi(q.x) * e); o.y = pk2(bflo(q.y) * e, bfhi(q.y) * e); o.z = pk2(bflo(q.z) * e, bfhi(q.z) * e); o.w = pk2(bflo(q.w) * e, bfhi(q.w) * e);
            *(v4u*)(cb.QG + ((size_t)un * 64 + i) * 128 + d0) = o;
        }
#pragma unroll
        for (int k = 0; k < 4; ++k) {
            const int ci = t2 + 256 * k, d = ci & 127, i0 = (ci >> 7) * 8;
            float v[8];
#pragma unroll
            for (int q = 0; q < 8; ++q) v[q] = bf2f(Kb[(i0 + q) * 136 + d]) * ekds[i0 + q];
            v4u o; o.x = pk2(v[0], v[1]); o.y = pk2(v[2], v[3]); o.z = pk2(v[4], v[5]); o.w = pk2(v[6], v[7]);
            *(v4u*)(cb.KDT + ((size_t)un * 128 + d) * 64 + i0) = o;
        }
#pragma unroll
        for (int k = 0; k < 2; ++k) {
            const int ci = t2 + 256 * k, i = ci >> 3, j0 = (ci & 7) * 8;
            *(v4u*)(cb.QK + ((size_t)un * 64 + i) * 64 + j0) = *(const v4u*)(QKs + i * 72 + j0);
        }
    }
    __syncthreads();
#pragma unroll
    for (int k = 0; k < 2; ++k) {
        const int ci = tid + 512 * k, i = ci >> 4, d0 = (ci & 15) * 8;
        *(v4u*)(cb.W + ((size_t)un * 64 + i) * 128 + d0) = *(const v4u*)(Ws + i * 136 + d0);
    }
    __syncthreads();
}

constexpr int GS_ST = 0, GS_VNT = 2 * 32 * 136 * 2, GS_END = GS_VNT + 32 * 72 * 2;
template <int N0, int N1>
__device__ __forceinline__ void gdn_seq(const GdnChunkBufs& cb, float* __restrict__ O, float* __restrict__ Sout, int b, int h, int sl, unsigned char* lds, f32x4 (&accS)[2], int& cur) {
    int tid = threadIdx.x; asm volatile("" : "+v"(tid));
    const int lane = tid & 63, wave = __builtin_amdgcn_readfirstlane(tid >> 6), fr = lane & 15, fq = lane >> 4;
    const int mi = wave >> 1, nj = wave & 1;
    bf16* St = (bf16*)(lds + GS_ST); bf16* VnT = (bf16*)(lds + GS_VNT);
    float* egls = (float*)(lds + GS_END);
    if (N0 == 0) {
        for (int i = tid; i < 2 * 32 * 136 / 2; i += NTH) ((unsigned*)St)[i] = 0u;
        accS[0] = (f32x4){0.f, 0.f, 0.f, 0.f}; accS[1] = accS[0]; cur = 0;
    }
    if (tid >= N0 && tid < N1) egls[tid] = cb.EGL[(size_t)((b * 64 + tid) * 4 + h)];
    __syncthreads();
#define GS_DECL(X) bf16x8_t aW##X[4], aQG##X[4], aQK##X[2], aKD##X[2]; v2u ut##X;
    GS_DECL(0) GS_DECL(1) GS_DECL(2)
#define GS_GLD16(dst, ptr) asm volatile("global_load_dwordx4 %0, %1, off" : "=v"(dst) : "v"(ptr))
#define GS_GLD8(dst, ptr) asm volatile("global_load_dwordx2 %0, %1, off" : "=v"(dst) : "v"(ptr))
#define GS_LOAD(X, n_) do { const size_t u_ = (size_t)((b * 64 + ((n_) < 63 ? (n_) : 63)) * 4 + h);     \
        _Pragma("unroll") for (int ks = 0; ks < 4; ++ks) { GS_GLD16(aW##X[ks], cb.W + (u_ * 64 + mi * 16 + fr) * 128 + ks * 32 + 8 * fq); GS_GLD16(aQG##X[ks], cb.QG + (u_ * 64 + mi * 16 + fr) * 128 + ks * 32 + 8 * fq); } \
        _Pragma("unroll") for (int ks = 0; ks < 2; ++ks) { GS_GLD16(aQK##X[ks], cb.QK + (u_ * 64 + mi * 16 + fr) * 64 + ks * 32 + 8 * fq); GS_GLD16(aKD##X[ks], cb.KDT + (u_ * 128 + wave * 16 + fr) * 64 + ks * 32 + 8 * fq); } \
        GS_GLD8(ut##X, cb.UT + (u_ * 128 + sl * 32 + nj * 16 + fr) * 64 + mi * 16 + 4 * fq); } while (0)
#define GS_WAITN(X, N) asm volatile("s_waitcnt vmcnt(" #N ")" : "+v"(aW##X[0]), "+v"(aW##X[1]), "+v"(aW##X[2]), "+v"(aW##X[3]), "+v"(aQG##X[0]), "+v"(aQG##X[1]), "+v"(aQG##X[2]), "+v"(aQG##X[3]), \
        "+v"(aQK##X[0]), "+v"(aQK##X[1]), "+v"(aKD##X[0]), "+v"(aKD##X[1]), "+v"(ut##X))
#define GS_WAIT(X, n_) GS_WAITN(X, 26)
#define GS_STEP(X, n_) do { \
        const float egl##X = egls[(n_)]; \
        GS_WAIT(X, n_); \
        __syncthreads();                                        \
        f32x4 accW = (f32x4){0.f, 0.f, 0.f, 0.f}, accO = accW; \
        const bf16* Sc = St + cur * 32 * 136; \
        _Pragma("unroll") for (int ks = 0; ks < 4; ++ks) { const bf16x8_t bs = *(const bf16x8_t*)(Sc + (nj * 16 + fr) * 136 + ks * 32 + 8 * fq); accW = mfma16(aW##X[ks], bs, accW); accO = mfma16(aQG##X[ks], bs, accO); } \
          \
        const float v0 = bflo(ut##X.x) - accW[0], v1 = bfhi(ut##X.x) - accW[1], v2 = bflo(ut##X.y) - accW[2], v3 = bfhi(ut##X.y) - accW[3]; \
        { v2u o; o.x = pk2(v0, v1); o.y = pk2(v2, v3); *(v2u*)(VnT + (nj * 16 + fr) * 72 + mi * 16 + 4 * fq) = o; } \
        __syncthreads();                                        \
        _Pragma("unroll") for (int ks = 0; ks < 2; ++ks) { const bf16x8_t bv = *(const bf16x8_t*)(VnT + (nj * 16 + fr) * 72 + ks * 32 + 8 * fq); accO = mfma16(aQK##X[ks], bv, accO); } \
        { float* orow = O + (size_t)(b * SEQ + (n_) * 64 + mi * 16 + 4 * fq) * 512 + h * 128 + sl * 32 + nj * 16 + fr; \
          orow[0] = accO[0]; orow[512] = accO[1]; orow[1024] = accO[2]; orow[1536] = accO[3]; } \
          \
        bf16* Sn = St + (cur ^ 1) * 32 * 136; \
        _Pragma("unroll") for (int njj = 0; njj < 2; ++njj) { \
            accS[njj] = accS[njj] * egl##X; \
            _Pragma("unroll") for (int ks = 0; ks < 2; ++ks) { const bf16x8_t bv = *(const bf16x8_t*)(VnT + (njj * 16 + fr) * 72 + ks * 32 + 8 * fq); accS[njj] = mfma16(aKD##X[ks], bv, accS[njj]); } \
            v2u o; o.x = pk2(accS[njj][0], accS[njj][1]); o.y = pk2(accS[njj][2], accS[njj][3]); \
            *(v2u*)(Sn + (njj * 16 + fr) * 136 + wave * 16 + 4 * fq) = o; } \
        cur ^= 1; } while (0)
    constexpr int NTRI = (N1 - N0) / 3, NREM = (N1 - N0) % 3, NM = N0 + 3 * NTRI;
    GS_LOAD(0, N0); GS_LOAD(1, N0 + 1);
#pragma unroll 1
    for (int n = N0; n < NM; n += 3) {
        GS_LOAD(2, n + 2);
        GS_STEP(0, n);
        GS_LOAD(0, n + 3);
        GS_STEP(1, n + 1);
        GS_LOAD(1, n + 4);
        GS_STEP(2, n + 2);
    }
    if (NREM >= 1) { GS_LOAD(2, NM + 2); GS_STEP(0, NM); }
    if (NREM == 2) { GS_LOAD(0, NM + 3); GS_STEP(1, NM + 1); }
    GS_WAITN(0, 0); GS_WAITN(1, 0); GS_WAITN(2, 0);
#undef GS_STEP
#undef GS_DECL
#undef GS_WAIT
#undef GS_WAITN
#undef GS_GLD16
#undef GS_GLD8
    asm volatile("s_waitcnt vmcnt(0)" ::: "memory");
#undef GS_LOAD
    if (N1 == 64) {
#pragma unroll
        for (int njj = 0; njj < 2; ++njj)
#pragma unroll
            for (int r = 0; r < 4; ++r) Sout[(((size_t)b * 4 + h) * 128 + wave * 16 + 4 * fq + r) * 128 + sl * 32 + njj * 16 + fr] = accS[njj][r];
    }
    __syncthreads();
}

__device__ __forceinline__ void lru_prep_unit(const bf16* __restrict__ PROJ, const float* __restrict__ conv_w, const float* __restrict__ conv_b,
                                              const float* __restrict__ w_r, const float* __restrict__ b_r, const float* __restrict__ w_i, const float* __restrict__ b_i, const float* __restrict__ lam,
                                              float* __restrict__ H, float* __restrict__ P, float* __restrict__ Hend, float* __restrict__ Pend, float* __restrict__ p_lru_conv, int ub) {
    int c = threadIdx.x; asm volatile("" : "+v"(c));
    const int nblk = c >> 6, d = c & 63;
    const int n = ub & 63, b = ub >> 6, t0 = b * SEQ + n * 64;
    float wr[64], wi[64];
#pragma unroll
    for (int cc = 0; cc < 64; ++cc) { wr[cc] = w_r[((size_t)nblk * 64 + cc) * 64 + d]; wi[cc] = w_i[((size_t)nblk * 64 + cc) * 64 + d]; }
    const float cw0 = conv_w[c], cw1 = conv_w[512 + c], cw2 = conv_w[1024 + c], cw3 = conv_w[1536 + c], cb_ = conv_b[c];
    const float br = b_r[c], bi = b_i[c], spl = -8.0f * softplusf_(-lam[c]);
    float x0 = (n * 64 - 3 >= 0) ? bf2f(PROJ[(size_t)(t0 - 3) * ABN + C_XR + c]) : 0.f;
    float x1 = (n * 64 - 2 >= 0) ? bf2f(PROJ[(size_t)(t0 - 2) * ABN + C_XR + c]) : 0.f;
    float x2 = (n * 64 - 1 >= 0) ? bf2f(PROJ[(size_t)(t0 - 1) * ABN + C_XR + c]) : 0.f;
    float hloc = 0.f, ploc = 1.f;
    bf16 xa[16], xb[16];
#pragma unroll
    for (int k = 0; k < 16; ++k) xa[k] = PROJ[(size_t)(t0 + k) * ABN + C_XR + c];
#pragma unroll 1
    for (int ib = 0; ib < 64; ib += 16) {
      if (ib + 16 < 64) {
#pragma unroll
        for (int k = 0; k < 16; ++k) xb[k] = PROJ[(size_t)(t0 + ib + 16 + k) * ABN + C_XR + c];
      }
#pragma unroll
      for (int k = 0; k < 16; ++k) {
        const int i = ib + k;
        const float xt = bf2f(xa[k]);
        const float xr = cb_ + cw0 * x0 + cw1 * x1 + cw2 * x2 + cw3 * xt;
        f32x2_t ga = (f32x2_t){br, bi}, gb = (f32x2_t){0.f, 0.f};
#pragma unroll
        for (int cc = 0; cc < 64; cc += 2) {
            const float xa_ = __uint_as_float(__builtin_amdgcn_readlane(__float_as_uint(xr), cc)), xb_ = __uint_as_float(__builtin_amdgcn_readlane(__float_as_uint(xr), cc + 1));
            ga += (f32x2_t){xa_, xa_} * (f32x2_t){wr[cc], wi[cc]}; gb += (f32x2_t){xb_, xb_} * (f32x2_t){wr[cc + 1], wi[cc + 1]};
        }
        ga += gb;
        const float r = __frcp_rn(1.0f + __expf(-ga.x)), ii = __frcp_rn(1.0f + __expf(-ga.y));
        const float a = __expf(spl * r), bb = __fsqrt_rn(fmaxf(1.0f - a * a, 0.f)) * (ii * xr);
        hloc = a * hloc + bb; ploc *= a;
        H[(size_t)(t0 + i) * 512 + c] = hloc; P[(size_t)(t0 + i) * 512 + c] = ploc;
        if (n == 63 && i >= 61) p_lru_conv[((size_t)b * 3 + (i - 61)) * 512 + c] = xt;
        x0 = x1; x1 = x2; x2 = xt;
      }
#pragma unroll
      for (int k = 0; k < 16; ++k) xa[k] = xb[k];
    }
    Hend[(size_t)ub * 512 + c] = hloc; Pend[(size_t)ub * 512 + c] = ploc;
}
constexpr int LR_XR = 64 * 68 * 4;
__device__ __forceinline__ void lru_prep_unit2(const bf16* __restrict__ PROJ, const float* __restrict__ conv_w, const float* __restrict__ conv_b,
                                               const bf16* __restrict__ WRT, const bf16* __restrict__ WIT  , const float* __restrict__ b_r, const float* __restrict__ b_i, const float* __restrict__ lam,
                                               float* __restrict__ H, float* __restrict__ P, float* __restrict__ Hend, float* __restrict__ Pend, float* __restrict__ p_lru_conv, int ub, unsigned char* lds) {
    int tid = threadIdx.x; asm volatile("" : "+v"(tid));
    const int lane = tid & 63, wave = __builtin_amdgcn_readfirstlane(tid >> 6), fr = lane & 15, fq = lane >> 4;
    const int n = ub & 63, b = ub >> 6, t0 = b * SEQ + n * 64;
    float* XR = (float*)(lds + wave * LR_XR);
    {
        const int c = wave * 64 + lane;
        const float cw0 = conv_w[c], cw1 = conv_w[512 + c], cw2 = conv_w[1024 + c], cw3 = conv_w[1536 + c], cb_ = conv_b[c];
        float x0 = (n * 64 - 3 >= 0) ? bf2f(PROJ[(size_t)(t0 - 3) * ABN + C_XR + c]) : 0.f;
        float x1 = (n * 64 - 2 >= 0) ? bf2f(PROJ[(size_t)(t0 - 2) * ABN + C_XR + c]) : 0.f;
        float x2 = (n * 64 - 1 >= 0) ? bf2f(PROJ[(size_t)(t0 - 1) * ABN + C_XR + c]) : 0.f;
#pragma unroll 1
        for (int ib = 0; ib < 64; ib += 16) {
            bf16 xa[16];
#pragma unroll
            for (int k = 0; k < 16; ++k) xa[k] = PROJ[(size_t)(t0 + ib + k) * ABN + C_XR + c];
#pragma unroll
            for (int k = 0; k < 16; ++k) {
                const int i = ib + k; const float xt = bf2f(xa[k]);
                XR[i * 68 + lane] = cb_ + cw0 * x0 + cw1 * x1 + cw2 * x2 + cw3 * xt;
                if (n == 63 && i >= 61) p_lru_conv[((size_t)b * 3 + (i - 61)) * 512 + c] = xt;
                x0 = x1; x1 = x2; x2 = xt;
            }
        }
    }
    asm volatile("s_waitcnt lgkmcnt(0)" ::: "memory");
    bf16x8_t bR[4][2], bI[4][2];
#pragma unroll
    for (int nt = 0; nt < 4; ++nt)
#pragma unroll
        for (int ks = 0; ks < 2; ++ks) {
            bR[nt][ks] = *(const bf16x8_t*)(WRT + ((size_t)wave * 64 + nt * 16 + fr) * 64 + ks * 32 + 8 * fq);
            bI[nt][ks] = *(const bf16x8_t*)(WIT + ((size_t)wave * 64 + nt * 16 + fr) * 64 + ks * 32 + 8 * fq);
        }
    float brv[4], biv[4], splv[4];
#pragma unroll
    for (int nt = 0; nt < 4; ++nt) { const int c = wave * 64 + nt * 16 + fr; brv[nt] = b_r[c]; biv[nt] = b_i[c]; splv[nt] = -8.0f * softplusf_(-lam[c]); }
    float hin[4], pin[4];
#pragma unroll
    for (int nt = 0; nt < 4; ++nt) { hin[nt] = 0.f; pin[nt] = 1.f; }
#pragma unroll 1
    for (int mt = 0; mt < 4; ++mt) {
        bf16x8_t aX[2];
#pragma unroll
        for (int ks = 0; ks < 2; ++ks) {
            const f32x4 lo = *(const f32x4*)(XR + (mt * 16 + fr) * 68 + ks * 32 + 8 * fq), hi = *(const f32x4*)(XR + (mt * 16 + fr) * 68 + ks * 32 + 8 * fq + 4);
            v4u w; w.x = pk2(lo.x, lo.y); w.y = pk2(lo.z, lo.w); w.z = pk2(hi.x, hi.y); w.w = pk2(hi.z, hi.w);
            aX[ks] = __builtin_bit_cast(bf16x8_t, w);
        }
#pragma unroll
        for (int nt = 0; nt < 4; ++nt) {
            f32x4 aR = (f32x4){0.f, 0.f, 0.f, 0.f}, aI = aR;
            aR = mfma16(aX[0], bR[nt][0], aR); aR = mfma16(aX[1], bR[nt][1], aR);
            aI = mfma16(aX[0], bI[nt][0], aI); aI = mfma16(aX[1], bI[nt][1], aI);
            float av[4], bv[4];
#pragma unroll
            for (int r = 0; r < 4; ++r) {
                const float rg = __frcp_rn(1.0f + __expf(-(aR[r] + brv[nt]))), ig = __frcp_rn(1.0f + __expf(-(aI[r] + biv[nt])));
                const float a = __expf(splv[nt] * rg);
                av[r] = a; bv[r] = __fsqrt_rn(fmaxf(1.0f - a * a, 0.f)) * (ig * XR[(mt * 16 + 4 * fq + r) * 68 + nt * 16 + fr]);
            }
            float PA[4], PB[4];
            PA[0] = av[0]; PB[0] = bv[0];
#pragma unroll
            for (int r = 1; r < 4; ++r) { PA[r] = av[r] * PA[r - 1]; PB[r] = av[r] * PB[r - 1] + bv[r]; }
            float GA = PA[3], GB = PB[3];
            { const float pa = __shfl_up(GA, 16), pb = __shfl_up(GB, 16); if (fq >= 1) { GB = GA * pb + GB; GA = GA * pa; } }
            { const float pa = __shfl_up(GA, 32), pb = __shfl_up(GB, 32); if (fq >= 2) { GB = GA * pb + GB; GA = GA * pa; } }
            float EA = __shfl_up(GA, 16), EB = __shfl_up(GB, 16);
            if (fq == 0) { EA = 1.f; EB = 0.f; }
            const float h0 = EA * hin[nt] + EB, p0 = pin[nt] * EA;
#pragma unroll
            for (int r = 0; r < 4; ++r) {
                const size_t o = (size_t)(t0 + mt * 16 + 4 * fq + r) * 512 + wave * 64 + nt * 16 + fr;
                H[o] = PA[r] * h0 + PB[r]; P[o] = p0 * PA[r];
            }
            const float TA = __shfl(GA, 48 + fr), TB = __shfl(GB, 48 + fr);
            hin[nt] = TA * hin[nt] + TB; pin[nt] = pin[nt] * TA;
        }
    }
    if (fq == 0) {
#pragma unroll
        for (int nt = 0; nt < 4; ++nt) { Hend[(size_t)ub * 512 + wave * 64 + nt * 16 + fr] = hin[nt]; Pend[(size_t)ub * 512 + wave * 64 + nt * 16 + fr] = pin[nt]; }
    }
    asm volatile("s_waitcnt lgkmcnt(0)" ::: "memory");
}
__device__ __forceinline__ void lru_carry(const float* __restrict__ Hend, const float* __restrict__ Pend, float* __restrict__ CIN, float* __restrict__ hlast, int bx) {
    int tx_ = threadIdx.x; asm volatile("" : "+v"(tx_));
    const int idx = bx * NTH + tx_, b = idx >> 9, c = idx & 511;
    float carry = 0.f;
#pragma unroll 8
    for (int n = 0; n < 64; ++n) {
        const size_t o = ((size_t)b * 64 + n) * 512 + c;
        CIN[o] = carry;
        carry = Hend[o] + Pend[o] * carry;
    }
    hlast[(size_t)b * 512 + c] = carry;
}

__device__ __forceinline__ unsigned f2key(float f) { const unsigned u = __float_as_uint(f); return u ^ ((u >> 31) ? 0xffffffffu : 0x80000000u); }
__device__ __forceinline__ float key2f(unsigned k) { return __uint_as_float(k ^ ((k >> 31) ? 0x80000000u : 0xffffffffu)); }
#define TK_CE(hi, lo) do { const unsigned a_ = (hi), b_ = (lo); (hi) = a_ > b_ ? a_ : b_; (lo) = a_ > b_ ? b_ : a_; } while (0)
template <int N> __device__ __forceinline__ void bitonic_sort_desc(unsigned (&a)[N]) {
#pragma unroll
    for (int k = 2; k <= N; k <<= 1)
#pragma unroll
        for (int j = k >> 1; j > 0; j >>= 1)
#pragma unroll
            for (int i = 0; i < N; ++i) { const int l = i ^ j; if (l > i) { if ((i & k) == 0) TK_CE(a[i], a[l]); else TK_CE(a[l], a[i]); } }
}
template <int XM> __device__ __forceinline__ void merge_top16(unsigned (&a)[16]) {
    unsigned c[16];
#pragma unroll
    for (int i = 0; i < 16; ++i) { const unsigned o = (unsigned)__shfl_xor((int)a[15 - i], XM); c[i] = a[i] > o ? a[i] : o; }
#pragma unroll
    for (int j = 8; j > 0; j >>= 1)
#pragma unroll
        for (int i = 0; i < 16; ++i) { const int l = i ^ j; if (l > i) TK_CE(c[i], c[l]); }
#pragma unroll
    for (int i = 0; i < 16; ++i) a[i] = c[i];
}
constexpr int TK_KS = 0, TK_TS = 2 * 128 * 136 * 2, TK_END = TK_TS + 64 * 2 * 16 * 4;
__device__ __forceinline__ void peer_topk_stage_keys(const bf16* __restrict__ KB, int h, unsigned char* lds) {
    bf16* Ks = (bf16*)(lds + TK_KS);
    for (int ci = threadIdx.x; ci < 2 * 128 * 16; ci += NTH) { const int row = ci >> 4, part = ci & 15;
        *(v4u*)(Ks + row * 136 + part * 8) = *(const v4u*)(KB + ((size_t)h * 256 + row) * 128 + part * 8); }
    __syncthreads();
}
__device__ __forceinline__ void peer_topk4(const bf16* __restrict__ Q, int* __restrict__ EXP, float* __restrict__ GATE, int tile, int h, unsigned char* lds) {
    int tid = threadIdx.x; asm volatile("" : "+v"(tid));
    const int lane = tid & 63, wave = __builtin_amdgcn_readfirstlane(tid >> 6), fr = lane & 15, fq = lane >> 4;
    const bf16* Ks = (const bf16*)(lds + TK_KS); unsigned* Ts = (unsigned*)(lds + TK_TS);
    {
        const int c = wave >> 2, nt = wave & 3;
        bf16x8_t bq[4];
#pragma unroll
        for (int ks = 0; ks < 4; ++ks) bq[ks] = *(const bf16x8_t*)(Q + (size_t)(tile * 64 + nt * 16 + fr) * 2048 + h * 256 + c * 128 + ks * 32 + 8 * fq);
        unsigned a[32];
#pragma unroll
        for (int mt = 0; mt < 8; ++mt) {
            f32x4 acc = (f32x4){0.f, 0.f, 0.f, 0.f};
#pragma unroll
            for (int ks = 0; ks < 4; ++ks) { const bf16x8_t ak = *(const bf16x8_t*)(Ks + (c * 128 + mt * 16 + fr) * 136 + ks * 32 + 8 * fq); acc = mfma16(ak, bq[ks], acc); }
#pragma unroll
            for (int r = 0; r < 4; ++r) a[mt * 4 + r] = (f2key(acc[r]) & ~127u) | (unsigned)(127 - (mt * 16 + 4 * fq + r));
        }
        bitonic_sort_desc<32>(a);
        unsigned t[16];
#pragma unroll
        for (int j = 0; j < 16; ++j) t[j] = a[j];
        merge_top16<16>(t); merge_top16<32>(t);
        if (fq == 0) {
            const int tk = nt * 16 + fr;
#pragma unroll
            for (int j = 0; j < 16; ++j) Ts[(tk * 2 + c) * 16 + j] = t[j];
        }
    }
    __syncthreads();
    if (tid < 256) {
        const int tk = tid >> 2, q = tid & 3;
        const unsigned* t0 = Ts + (tk * 2 + 0) * 16; const unsigned* t1 = Ts + (tk * 2 + 1) * 16;
        unsigned a[16];
#pragma unroll
        for (int s = 0; s < 13; ++s) {
            const int e = s * 4 + q;
            int i, j;
            if (e < 16) { i = 0; j = e; } else if (e < 24) { i = 1; j = e - 16; } else if (e < 29) { i = 2; j = e - 24; } else if (e < 33) { i = 3; j = e - 29; }
            else if (e < 36) { i = 4; j = e - 33; } else if (e < 42) { i = 5 + ((e - 36) >> 1); j = (e - 36) & 1; } else { i = 8 + (e - 42); j = 0; }
            const bool ok = e < 50;
            const float sum = key2f(t0[ok ? i : 0] & ~127u) + key2f(t1[ok ? j : 0] & ~127u);
            a[s] = ok ? ((f2key(sum) & ~255u) | (unsigned)(255 - (i * 16 + j))) : 0u;
        }
        a[13] = 0u; a[14] = 0u; a[15] = 0u;
        bitonic_sort_desc<16>(a);
        merge_top16<1>(a); merge_top16<2>(a);
        float ev[16], sum = 0.f; const float m = key2f(a[0] & ~255u);
#pragma unroll
        for (int j = 0; j < 16; ++j) { ev[j] = __expf(key2f(a[j] & ~255u) - m); sum += ev[j]; }
        const float inv = 1.0f / sum;
        const size_t o = (size_t)(tile * 64 + tk) * 128 + h * 16;
#pragma unroll
        for (int j = 0; j < 16; ++j)
            if ((j >> 2) == q) {
                const int code = 255 - (int)(a[j] & 255u), i = code >> 4, jj = code & 15;
                const int n0 = 127 - (int)(t0[i] & 127u), n1 = 127 - (int)(t1[jj] & 127u);
                EXP[o + j] = n0 * 128 + n1; GATE[o + j] = ev[j] * inv;
            }
    }
    __syncthreads();
}

constexpr int AT_KS = 0, AT_VT = 192 * 72 * 2, AT_BT = AT_VT + 64 * 200 * 2, AT_PW = AT_BT + 4 * 128 * 4, AT_END = AT_PW + 8 * 32 * 72 * 2;
__device__ __forceinline__ void attn_unit(const bf16* __restrict__ PCb, const float* __restrict__ rel_bias, const float* __restrict__ sinks, bf16* __restrict__ ATT, int un, unsigned char* lds) {
    int tid = threadIdx.x; asm volatile("" : "+v"(tid));
    const int lane = tid & 63, wave = __builtin_amdgcn_readfirstlane(tid >> 6), fr = lane & 15, fq = lane >> 4;
    const int kvh = un & 3, qblk = (un >> 2) & 63, b = un >> 8;
    const int q0 = qblk * 64, tb = b * SEQ;
    bf16* Ks = (bf16*)(lds + AT_KS); bf16* Vt = (bf16*)(lds + AT_VT); float* Bt = (float*)(lds + AT_BT); bf16* Pw = (bf16*)(lds + AT_PW) + wave * 32 * 72;
#pragma unroll
    for (int k = 0; k < 3; ++k) {
        const int ci = tid + 512 * k, row = ci >> 3, part = ci & 7, kpos = q0 - 128 + row;
        v4u kv = (v4u){0u, 0u, 0u, 0u}, vv = kv;
        if (kpos >= 0) { const bf16* src = PCb + (size_t)(tb + kpos) * CN + kvh * 64 + part * 8; kv = *(const v4u*)(src + 1024); vv = *(const v4u*)(src + 1280); }
        *(v4u*)(Ks + row * 72 + part * 8) = kv;
        bf16* vd = Vt + (part * 8) * 200 + row;
        vd[0 * 200] = (bf16)(vv.x & 0xffffu); vd[1 * 200] = (bf16)(vv.x >> 16); vd[2 * 200] = (bf16)(vv.y & 0xffffu); vd[3 * 200] = (bf16)(vv.y >> 16);
        vd[4 * 200] = (bf16)(vv.z & 0xffffu); vd[5 * 200] = (bf16)(vv.z >> 16); vd[6 * 200] = (bf16)(vv.w & 0xffffu); vd[7 * 200] = (bf16)(vv.w >> 16);
    }
    Bt[tid] = rel_bias[t5_bucket(tid & 127) * 16 + kvh * 4 + (tid >> 7)];
    __syncthreads();
    const int g = wave >> 1, qs = (wave & 1) * 32, hh = kvh * 4 + g;
    bf16x8_t aQ[2][2];
#pragma unroll
    for (int mt = 0; mt < 2; ++mt)
#pragma unroll
        for (int ks = 0; ks < 2; ++ks) aQ[mt][ks] = *(const bf16x8_t*)(PCb + (size_t)(tb + q0 + qs + mt * 16 + fr) * CN + hh * 64 + ks * 32 + 8 * fq);
    f32x4 sc[2][12];
#pragma unroll
    for (int nt = 0; nt < 12; ++nt) {
        const bf16x8_t b0 = *(const bf16x8_t*)(Ks + (nt * 16 + fr) * 72 + 8 * fq), b1 = *(const bf16x8_t*)(Ks + (nt * 16 + fr) * 72 + 32 + 8 * fq);
#pragma unroll
        for (int mt = 0; mt < 2; ++mt) { f32x4 a = (f32x4){0.f, 0.f, 0.f, 0.f}; a = mfma16(aQ[mt][0], b0, a); a = mfma16(aQ[mt][1], b1, a); sc[mt][nt] = a; }
    }
    const float sink = sinks[hh];
    const float* bt = Bt + g * 128;
#pragma unroll
    for (int mt = 0; mt < 2; ++mt)
#pragma unroll
        for (int r = 0; r < 4; ++r) {
            const int qi = qs + mt * 16 + 4 * fq + r;
            float mx = sink;
#pragma unroll
            for (int nt = 0; nt < 12; ++nt) {
                const int kk = nt * 16 + fr, rel = qi + 128 - kk;
                const bool valid = rel >= 0 && rel < 128 && (q0 - 128 + kk) >= 0;
                const float lg = valid ? sc[mt][nt][r] * 0.125f + bt[valid ? rel : 0] : -INFINITY;
                sc[mt][nt][r] = lg; mx = fmaxf(mx, lg);
            }
            mx = fmaxf(mx, __shfl_xor(mx, 1)); mx = fmaxf(mx, __shfl_xor(mx, 2)); mx = fmaxf(mx, __shfl_xor(mx, 4)); mx = fmaxf(mx, __shfl_xor(mx, 8));
            float sum = 0.f;
#pragma unroll
            for (int nt = 0; nt < 12; ++nt) { const float p = __expf(sc[mt][nt][r] - mx); sc[mt][nt][r] = p; sum += p; }
            sum += __shfl_xor(sum, 1); sum += __shfl_xor(sum, 2); sum += __shfl_xor(sum, 4); sum += __shfl_xor(sum, 8);
            const float inv = 1.0f / (sum + __expf(sink - mx));
#pragma unroll
            for (int nt = 0; nt < 12; ++nt) sc[mt][nt][r] *= inv;
        }
    f32x4 oacc[2][4];
#pragma unroll
    for (int mt = 0; mt < 2; ++mt)
#pragma unroll
        for (int dt = 0; dt < 4; ++dt) oacc[mt][dt] = (f32x4){0.f, 0.f, 0.f, 0.f};
#pragma unroll
    for (int kc = 0; kc < 3; ++kc) {
#pragma unroll
        for (int mt = 0; mt < 2; ++mt)
#pragma unroll
            for (int n4 = 0; n4 < 4; ++n4)
#pragma unroll
                for (int r = 0; r < 4; ++r) Pw[(mt * 16 + 4 * fq + r) * 72 + n4 * 16 + fr] = (bf16)f2bf(sc[mt][kc * 4 + n4][r]);
        asm volatile("s_waitcnt lgkmcnt(0)" ::: "memory");
#pragma unroll
        for (int ks = 0; ks < 2; ++ks) {
            const bf16x8_t p0 = *(const bf16x8_t*)(Pw + fr * 72 + ks * 32 + 8 * fq), p1 = *(const bf16x8_t*)(Pw + (16 + fr) * 72 + ks * 32 + 8 * fq);
#pragma unroll
            for (int dt = 0; dt < 4; ++dt) {
                const bf16x8_t bv = *(const bf16x8_t*)(Vt + (dt * 16 + fr) * 200 + kc * 64 + ks * 32 + 8 * fq);
                oacc[0][dt] = mfma16(p0, bv, oacc[0][dt]); oacc[1][dt] = mfma16(p1, bv, oacc[1][dt]);
            }
        }
        asm volatile("s_waitcnt lgkmcnt(0)" ::: "memory");
    }
#pragma unroll
    for (int mt = 0; mt < 2; ++mt)
#pragma unroll
        for (int dt = 0; dt < 4; ++dt)
#pragma unroll
            for (int r = 0; r < 4; ++r) Pw[(mt * 16 + 4 * fq + r) * 72 + dt * 16 + fr] = (bf16)f2bf(oacc[mt][dt][r]);
    asm volatile("s_waitcnt lgkmcnt(0)" ::: "memory");
#pragma unroll
    for (int k = 0; k < 4; ++k) {
        const int ci = lane + 64 * k, row = ci >> 3, part = ci & 7;
        *(v4u*)(ATT + (size_t)(tb + q0 + qs + row) * D + hh * 64 + part * 8) = *(const v4u*)(Pw + row * 72 + part * 8);
    }
    __syncthreads();
}

__device__ __forceinline__ void swa_attn_sample(const bf16* __restrict__ PCb, const float* __restrict__ cache_k, const float* __restrict__ cache_v,
                                                const float* __restrict__ rel_bias, const float* __restrict__ sinks, bf16* __restrict__ ATT, int gw, int lane) {
    const int sb = gw >> 4, h = gw & 15, kvh = h >> 2, t = NP + sb;
    const bf16* qrow = PCb + (size_t)t * CN + h * 64;
    float lg[2];
#pragma unroll
    for (int rr = 0; rr < 2; ++rr) {
        const int r = lane + 64 * rr;
        float dot = 0.f;
        if (r == 0) {
            const bf16* krow = PCb + (size_t)t * CN + 1024 + kvh * 64;
            for (int d = 0; d < 64; ++d) dot += bf2f(qrow[d]) * bf2f(krow[d]);
        } else {
            const float* krow = cache_k + (((size_t)sb * 128 + (128 - r)) * 4 + kvh) * 64;
#pragma unroll
            for (int d4 = 0; d4 < 16; ++d4) { const float4 kv = *(const float4*)(krow + d4 * 4);
                dot += bf2f(qrow[d4 * 4]) * kv.x + bf2f(qrow[d4 * 4 + 1]) * kv.y + bf2f(qrow[d4 * 4 + 2]) * kv.z + bf2f(qrow[d4 * 4 + 3]) * kv.w; }
        }
        lg[rr] = dot * 0.125f + rel_bias[t5_bucket(r) * 16 + h];
    }
    const float sink = sinks[h];
    const float m = fmaxf(wave_max(fmaxf(lg[0], lg[1])), sink);
    float p[2] = {expf(lg[0] - m), expf(lg[1] - m)};
    const float inv = 1.0f / (wave_sum(p[0] + p[1]) + expf(sink - m));
    float o = 0.f;
#pragma unroll
    for (int rr = 0; rr < 2; ++rr)
        for (int l2 = 0; l2 < 64; ++l2) {
            const int r = l2 + 64 * rr;
            const float pj = __shfl(p[rr], l2);
            const float vv = (r == 0) ? bf2f(PCb[(size_t)t * CN + 1280 + kvh * 64 + lane]) : cache_v[(((size_t)sb * 128 + (128 - r)) * 4 + kvh) * 64 + lane];
            o += pj * vv;
        }
    ATT[(size_t)t * D + h * 64 + lane] = (bf16)f2bf(o * inv);
}
__device__ __forceinline__ void swa_kv_out2(const bf16* __restrict__ PCb, const float* __restrict__ cache_k, const float* __restrict__ cache_v,
                                            float* __restrict__ pk, float* __restrict__ pv, float* __restrict__ sk, float* __restrict__ sv, int vb) {
    int tx_ = threadIdx.x; asm volatile("" : "+v"(tx_));
    const int c = tx_ & 255, row = vb * 2 + (tx_ >> 8);
    if (row < NB * 128) {
        const int b = row >> 7, i = row & 127;
        const bf16* src = PCb + (size_t)(b * SEQ + SEQ - 128 + i) * CN;
        pk[(size_t)row * 256 + c] = bf2f(src[1024 + c]);
        pv[(size_t)row * 256 + c] = bf2f(src[1280 + c]);
    } else {
        const int r2 = row - NB * 128, sb = r2 >> 7, i = r2 & 127;
        if (i < 127) {
            sk[(size_t)r2 * 256 + c] = cache_k[((size_t)sb * 128 + i + 1) * 256 + c];
            sv[(size_t)r2 * 256 + c] = cache_v[((size_t)sb * 128 + i + 1) * 256 + c];
        } else {
            const bf16* src = PCb + (size_t)(NP + sb) * CN;
            sk[(size_t)r2 * 256 + c] = bf2f(src[1024 + c]);
            sv[(size_t)r2 * 256 + c] = bf2f(src[1280 + c]);
        }
    }
}


__device__ __forceinline__ void sample_gemm_piece(const bf16* __restrict__ A, const bf16* __restrict__ Bt, const float* __restrict__ bias, bf16* __restrict__ O, int ldc, int p, unsigned char* lds) {
    int tid = threadIdx.x; asm volatile("" : "+v"(tid));
    const int lane = tid & 63, wave = __builtin_amdgcn_readfirstlane(tid >> 6), fr = lane & 15, fq = lane >> 4;
    const int mt = p & 7, cb = p >> 3, nt = wave & 3, kh = wave >> 2;
    const bf16* ap = A + (size_t)(NP + mt * 16 + fr) * D + kh * 512 + 8 * fq;
    const bf16* bp = Bt + (size_t)(cb * 64 + nt * 16 + fr) * D + kh * 512 + 8 * fq;
    bf16x8_t a[16], b[16];
#pragma unroll
    for (int ks = 0; ks < 16; ++ks) { a[ks] = *(const bf16x8_t*)(ap + ks * 32); b[ks] = *(const bf16x8_t*)(bp + ks * 32); }
    f32x4 acc = (f32x4){0.f, 0.f, 0.f, 0.f};
#pragma unroll
    for (int ks = 0; ks < 16; ++ks) acc = mfma16(a[ks], b[ks], acc);
    f32x4* part = (f32x4*)lds;
    if (kh == 1) part[nt * 64 + lane] = acc;
    __syncthreads();
    if (kh == 0) {
        acc = acc + part[nt * 64 + lane];
        const int col = cb * 64 + nt * 16 + fr; const float bv = bias ? bias[col] : 0.f;
#pragma unroll
        for (int r = 0; r < 4; ++r) O[(size_t)(NP + mt * 16 + 4 * fq + r) * ldc + col] = (bf16)f2bf(acc[r] + bv);
    }
    __syncthreads();
}

constexpr size_t MiB = 1u << 20;
constexpr size_t WS_CTL = 0, CTL_ZERO_BYTES = 64 * 1024;
constexpr size_t WS_WAB = 1 * MiB;
constexpr size_t WS_WOUT = WS_WAB + (size_t)ABNP * D * 2;
constexpr size_t WS_WQ0 = WS_WOUT + (size_t)D * D * 2;
constexpr size_t WS_WQ1 = WS_WQ0 + (size_t)2048 * D * 2;
constexpr size_t WS_WINC = WS_WQ1 + (size_t)2048 * D * 2;
constexpr size_t WS_WOUTC = WS_WINC + (size_t)CN * D * 2;
constexpr size_t WS_ABUF = WS_WOUTC + (size_t)D * D * 2;
constexpr size_t WS_P = WS_ABUF + (size_t)MP * D * 2;
constexpr size_t WS_T = WS_P + (size_t)MP * ABN * 2;
constexpr size_t WS_Q = WS_T + (size_t)4 * 16384 * D + (size_t)4 * 16384 * 4;
constexpr size_t WS_A = WS_Q + (size_t)MP * 1536 * 4;
constexpr size_t WS_B = WS_A + (size_t)MP * 512 * 4;
constexpr size_t WS_O = WS_B + (size_t)MP * 512 * 4;
constexpr size_t WS_X1 = WS_O + (size_t)MP * 512 * 4;
constexpr size_t WS_G = WS_X1 + (size_t)MP * D * 4;
constexpr size_t WS_BETA = WS_G + (size_t)MP * 4 * 4;
constexpr size_t WS_GATE = WS_BETA + (size_t)MP * 4 * 4;
constexpr size_t WS_EXP = WS_GATE + (size_t)MP * 128 * 4;
constexpr size_t WS_HEND = WS_EXP + (size_t)MP * 128 * 4;
constexpr size_t WS_KEYS = WS_HEND + (size_t)3 * 4 * 64 * 512 * 4;
constexpr size_t WS_WGT = WS_KEYS + (size_t)2 * 8 * 2 * 128 * 128 * 2;
constexpr size_t WS_END = WS_WGT + (size_t)2 * 8 * 64 * 64 * 2;
constexpr size_t Q_QKVS = 0, Q_W = 1 * MiB, Q_QG = Q_W + 16 * MiB, Q_KDT = Q_QG + 16 * MiB, Q_UT = Q_KDT + 16 * MiB, Q_QK = Q_UT + 16 * MiB, Q_EGL = Q_QK + 8 * MiB, Q_END = Q_EGL + 4096;
static_assert(Q_END <= (size_t)MP * 1536 * 4, "region Q");
static_assert(WS_END <= 512 * MiB, "d_ws map");

struct MegaArgs {
    const float* in[35];
    float* out;
    unsigned char* ws;
};

__global__ void __launch_bounds__(NTH, 2) fwd_megakernel(MegaArgs ma) {
    cg::grid_group grid = cg::this_grid();
    extern __shared__ __attribute__((aligned(16))) unsigned char lds[];
    float* smem = (float*)lds;
    const int nb = gridDim.x, b0 = blockIdx.x, wave = __builtin_amdgcn_readfirstlane(threadIdx.x >> 6);
    int tid = threadIdx.x, lane = tid & 63;
    const float* x_prompt = ma.in[0];
    const float* x_sample = ma.in[1];
    const float* state_gdn = ma.in[2];
    const float* state_gdn_conv = ma.in[3];
    const float* state_lru = ma.in[4];
    const float* state_lru_conv = ma.in[5];
    const float* cache_k = ma.in[6];
    const float* cache_v = ma.in[7];
    const float* w_in_ab = ma.in[8];
    const float* gdn_conv_w = ma.in[9];
    const float* gdn_a_log = ma.in[10];
    const float* gdn_dt_bias = ma.in[11];
    const float* gdn_norm_w = ma.in[12];
    const float* lru_conv_w = ma.in[13];
    const float* lru_conv_b = ma.in[14];
    const float* lru_w_r = ma.in[15];
    const float* lru_b_r = ma.in[16];
    const float* lru_w_i = ma.in[17];
    const float* lru_b_i = ma.in[18];
    const float* lru_lam = ma.in[19];
    const float* w_out_ab = ma.in[20];
    const float* w_in_c = ma.in[21];
    const float* b_in_c = ma.in[22];
    const float* swa_sinks = ma.in[23];
    const float* w_out_c = ma.in[24];
    const float* b_out_c = ma.in[25];
    const float* rel_bias = ma.in[26];
    const float* ln_mix_g = ma.in[27];
    const float* ln_mix_b = ma.in[28];
    const float* ln_ffn_g = ma.in[29];
    const float* ln_ffn_b = ma.in[30];
    const float* peer_w_q = ma.in[31];
    const float* peer_keys = ma.in[32];
    const float* peer_u = ma.in[33];
    const float* peer_v = ma.in[34];

    float* out = ma.out;
    float* o_y = out;
    float* o_p_gdn = out + (size_t)NT * D;
    float* o_p_gdn_conv = o_p_gdn + 262144;
    float* o_p_lru = o_p_gdn_conv + 18432;
    float* o_p_lru_conv = o_p_lru + 2048;
    float* o_p_k = o_p_lru_conv + 6144;
    float* o_p_v = o_p_k + 131072;
    float* o_s_gdn = o_p_v + 131072;
    float* o_s_gdn_conv = o_s_gdn + 8388608;
    float* o_s_lru = o_s_gdn_conv + 589824;
    float* o_s_lru_conv = o_s_lru + 65536;
    float* o_s_k = o_s_lru_conv + 196608;
    float* o_s_v = o_s_k + 4194304;

    unsigned char* ws = ma.ws;
    bf16* WAB_T = (bf16*)(ws + WS_WAB); bf16* WOUT_T = (bf16*)(ws + WS_WOUT); bf16* WQ0_T = (bf16*)(ws + WS_WQ0); bf16* WQ1_T = (bf16*)(ws + WS_WQ1);
    bf16* WINC_T = (bf16*)(ws + WS_WINC); bf16* WOUTC_T = (bf16*)(ws + WS_WOUTC);
    bf16* ABUF = (bf16*)(ws + WS_ABUF);
    bf16* PROJ = (bf16*)(ws + WS_P); float* Y = (float*)(ws + WS_P); bf16* Qb = (bf16*)(ws + WS_P); bf16* PCb = (bf16*)(ws + WS_P); float* Y1 = (float*)(ws + WS_P);
    unsigned char* TAB8 = ws + WS_T; float* TSC = (float*)(ws + WS_T + (size_t)4 * 16384 * D);
    float* R_Q = (float*)(ws + WS_Q + Q_QKVS) - (size_t)NP * 1536; float* X2 = (float*)(ws + WS_A);
    GdnChunkBufs cbuf; cbuf.W = (bf16*)(ws + WS_Q + Q_W); cbuf.QG = (bf16*)(ws + WS_Q + Q_QG); cbuf.KDT = (bf16*)(ws + WS_Q + Q_KDT); cbuf.UT = (bf16*)(ws + WS_Q + Q_UT); cbuf.QK = (bf16*)(ws + WS_Q + Q_QK); cbuf.EGL = (float*)(ws + WS_Q + Q_EGL);
    bf16* Yb = (bf16*)(ws + WS_P);
    float* OUTS = (float*)(ws + WS_Q);
    float* PD = (float*)(ws + WS_P);
    bf16* KEYSB = (bf16*)(ws + WS_KEYS); bf16* WRT = (bf16*)(ws + WS_WGT); bf16* WIT = WRT + 8 * 64 * 64;
    float* HEND = (float*)(ws + WS_HEND); float* PEND = HEND + 4 * 64 * 512; float* CIN = PEND + 4 * 64 * 512;
    float* R_A = (float*)(ws + WS_A); float* R_B = (float*)(ws + WS_B); float* R_O = (float*)(ws + WS_O);
    bf16* XRES = (bf16*)(ws + WS_X1);
    float* R_G = (float*)(ws + WS_G); float* R_BETA = (float*)(ws + WS_BETA); float* R_GATE = (float*)(ws + WS_GATE); int* R_EXP = (int*)(ws + WS_EXP);

    for (int u = tid; u < (LDS_BYTES - RING_BYTES) / 4; u += NTH) ((unsigned*)(lds + RING_BYTES))[u] = 0u;
    __syncthreads();
    XcdBarrier bar = xcd_barrier_post((unsigned*)(ws + WS_CTL), (volatile LAS unsigned*)((LAS unsigned char*)lds + MISC_OFF) + 8);
#define GRID_BAR() do { xcd_barrier(bar); asm volatile("" : "+v"(tid)); lane = tid & 63; } while (0)
#define PHASE_LOOP(n) for (int vb = b0; vb < (n); vb += nb)
#define PHASE_END __syncthreads()
#define GEMM_PHASE_M(Mrows, EPI, Aptr, Btptr, Nn, ...) do { pg8::Gemm g_{(const pg8::bf16_t*)(Aptr), (const pg8::bf16_t*)(Btptr), (Mrows), (Nn), D}; pg8::StaticOrder S_; S_.init((Mrows), (Nn), nb, b0); \
        pg8::EPI E_{__VA_ARGS__}; pg8::gemm_phase<pg8::EPI, pg8::StaticOrder, true, true>((PG8_LAS unsigned char*)lds, g_, S_, E_); } while (0)
#define GEMM_PHASE(EPI, Aptr, Btptr, Nn, ...) GEMM_PHASE_M(MP, EPI, Aptr, Btptr, Nn, __VA_ARGS__)
#define GEMM_PHASE_SPLIT(Aptr, Btptr, Nn, Optr, biasptr) do { GEMM_PHASE_M(NP, EpiStoreBf16, Aptr, Btptr, Nn, Optr, Nn, biasptr, NP, Nn); \
        for (int p_ = b0; p_ < 8 * ((Nn) / 64); p_ += nb) sample_gemm_piece(Aptr, Btptr, biasptr, Optr, Nn, p_, lds); } while (0)

    {
        float* scr = smem + wave * 4096;
        const int gw = b0 * NWAVES + wave, NGW = nb * NWAVES;
        constexpr int I_AB = 16 * 97, I_OUT = 16 * 32, I_Q = 16 * 64, I_INC = 16 * 48;
        constexpr int NITEMS = I_AB + I_OUT + 2 * I_Q + I_INC + I_OUT;
        for (int it = gw; it < NITEMS; it += NGW) {
            int r = it;
            if (r < I_AB) { p0_transpose_item(w_in_ab, D, ABN, WAB_T, scr, r, lane); continue; } r -= I_AB;
            if (r < I_OUT) { p0_transpose_item(w_out_ab, D, D, WOUT_T, scr, r, lane); continue; } r -= I_OUT;
            if (r < I_Q) { p0_transpose_item(peer_w_q, D, 2048, WQ0_T, scr, r, lane); continue; } r -= I_Q;
            if (r < I_Q) { p0_transpose_item(peer_w_q + (size_t)D * 2048, D, 2048, WQ1_T, scr, r, lane); continue; } r -= I_Q;
            if (r < I_INC) { p0_transpose_item(w_in_c, D, CN, WINC_T, scr, r, lane); continue; } r -= I_INC;
            p0_transpose_item(w_out_c, D, D, WOUTC_T, scr, r, lane);
        }
        for (int it = b0 * NTH + tid; it < 2 * 8 * 64 * 8; it += nb * NTH) {
            const int gsel = it >> 12, nn = (it >> 9) & 7, dd = (it >> 3) & 63, c8 = (it & 7) * 8;
            const float* wsrc = (gsel ? lru_w_i : lru_w_r) + ((size_t)nn * 64 + c8) * 64 + dd;
            v4u o; o.x = pk2(wsrc[0], wsrc[64]); o.y = pk2(wsrc[128], wsrc[192]); o.z = pk2(wsrc[256], wsrc[320]); o.w = pk2(wsrc[384], wsrc[448]);
            *(v4u*)((gsel ? WIT : WRT) + ((size_t)nn * 64 + dd) * 64 + c8) = o;
        }
        for (int m = gw; m < MP + (ABNP - 97 * 32); m += NGW) {
            if (m < MP) row_to_bf16(m < NP ? x_prompt + (size_t)m * D : (m < NT ? x_sample + (size_t)(m - NP) * D : nullptr), ABUF + (size_t)m * D, lane);
            else row_to_bf16(nullptr, WAB_T + (size_t)(97 * 32 + (m - MP)) * D, lane);
        }
    }
    GRID_BAR();
    if (ma.out == nullptr) grid.sync();
    GEMM_PHASE(EpiStoreBf16, ABUF, WAB_T, ABNP, PROJ, ABN, nullptr, NT, ABN);
    GRID_BAR();
    { AbPrepArgs pa;
      pa.PROJ = PROJ; pa.st_gdn_conv = state_gdn_conv; pa.st_lru_conv = state_lru_conv;
      pa.gdn_conv_w = gdn_conv_w; pa.a_log = gdn_a_log; pa.dt_bias = gdn_dt_bias;
      pa.lru_conv_w = lru_conv_w; pa.lru_conv_b = lru_conv_b; pa.w_r = lru_w_r; pa.b_r = lru_b_r; pa.w_i = lru_w_i; pa.b_i = lru_b_i; pa.lam = lru_lam;
      pa.QKV = R_Q; pa.G = R_G; pa.BETA = R_BETA; pa.LA = R_A; pa.LB = R_B;
      pa.p_gdn_conv = o_p_gdn_conv; pa.p_lru_conv = o_p_lru_conv; pa.s_gdn_conv = o_s_gdn_conv; pa.s_lru_conv = o_s_lru_conv;
#define GDN_UN_A(i_) ((((i_) >> 7) * 64 + (((i_) >> 2) & 31)) * 4 + ((i_) & 3))
      if (b0 < 128) {
          lru_prep_unit2(PROJ, lru_conv_w, lru_conv_b, WRT, WIT, lru_b_r, lru_b_i, lru_lam, R_B, R_A, HEND, PEND, o_p_lru_conv, (b0 >> 5) * 64 + (b0 & 31), lds); PHASE_END;
          gdn_prep_unit(PROJ, gdn_conv_w, gdn_a_log, gdn_dt_bias, cbuf, o_p_gdn_conv, GDN_UN_A(b0), lds);
      } else if (b0 < 256) {
          ab_prep(pa, NP + (b0 - 128), smem); PHASE_END;
          for (int k = 0; k < 3; ++k) gdn_prep_unit(PROJ, gdn_conv_w, gdn_a_log, gdn_dt_bias, cbuf, o_p_gdn_conv, GDN_UN_A(128 + (b0 - 128) * 3 + k), lds);
      } }
    GRID_BAR();
    f32x4 seqS[2]; int seqcur = 0;
    const int seq_p = (b0 & 7) + 8 * (b0 >> 5), seq_s = (b0 >> 3) & 3;
    if (b0 < 64) gdn_seq<0, 32>(cbuf, R_O, o_p_gdn, seq_p >> 2, seq_p & 3, seq_s, lds, seqS, seqcur);
    else if (b0 < 192) {
        const int i = b0 - 64;
        lru_prep_unit2(PROJ, lru_conv_w, lru_conv_b, WRT, WIT, lru_b_r, lru_b_i, lru_lam, R_B, R_A, HEND, PEND, o_p_lru_conv, (i >> 5) * 64 + 32 + (i & 31), lds); PHASE_END;
        for (int k = 0; k < 2; ++k) gdn_prep_unit(PROJ, gdn_conv_w, gdn_a_log, gdn_dt_bias, cbuf, o_p_gdn_conv, GDN_UN_A(i * 2 + k) + 32 * 4, lds);
    } else if (b0 < 256) {
        const int i = b0 - 192;
        for (int k = 0; k < 4; ++k) gdn_prep_unit(PROJ, gdn_conv_w, gdn_a_log, gdn_dt_bias, cbuf, o_p_gdn_conv, GDN_UN_A(256 + i * 4 + k) + 32 * 4, lds);
    }
    GRID_BAR();
    if (b0 < 64) gdn_seq<32, 64>(cbuf, R_O, o_p_gdn, seq_p >> 2, seq_p & 3, seq_s, lds, seqS, seqcur);
    else if (b0 < 68) lru_carry(HEND, PEND, CIN, o_p_lru, b0 - 64);
    else {
        for (int v = b0 - 68; v < 2048 + 128; v += nb - 68) {
            if (v < 2048) gdn_scan(R_Q, R_G, R_BETA, state_gdn, R_O, o_s_gdn, NP, 1, v & 3, (v >> 2) & 3, v >> 4, smem);
            else lru_scan(R_A, R_B, state_lru, o_s_lru, NP, 1, NS, v - 2048);
            PHASE_END;
        }
        const int gw2 = (b0 - 68) * NWAVES + wave, NGW2 = (nb - 68) * NWAVES;
        for (int m = gw2; m < 512; m += NGW2) row_to_bf16(peer_keys + (size_t)m * D, KEYSB + (size_t)m * D, lane);
        for (int m = gw2; m < 4 * 16384; m += NGW2) {
            const int k = m >> 14, r = m & 16383;
            row_to_fp8_sliced(((k & 1) ? peer_v : peer_u) + ((size_t)(k >> 1) * 16384 + r) * D, TAB8 + (size_t)k * 16384 * D, r, TSC + m, lane);
        }
    }
    GRID_BAR();
    PHASE_LOOP(NT / 8) { ab_mix_w(PROJ, R_O, R_B, R_A, CIN, gdn_norm_w, ABUF, vb * 8 + wave, lane); }
    GRID_BAR();
    GEMM_PHASE_SPLIT(ABUF, WOUT_T, D, Yb, (const float*)nullptr);
    GRID_BAR();
    PHASE_LOOP(NT / 8) { const int t = vb * 8 + wave;
        ln_res_w<false>(t < NP ? x_prompt + (size_t)t * D : x_sample + (size_t)(t - NP) * D, Yb + (size_t)t * D, ln_mix_g, ln_mix_b, ABUF + (size_t)t * D, lane); }
    GRID_BAR();
    GEMM_PHASE_SPLIT(ABUF, WQ0_T, 2048, Qb, (const float*)nullptr);
    GRID_BAR();
    if ((nb & 7) == 0) { peer_topk_stage_keys(KEYSB, b0 & 7, lds); PHASE_LOOP((NT / 64) * 8) { peer_topk4(Qb, R_EXP, R_GATE, vb >> 3, vb & 7, lds); } }
    else PHASE_LOOP((NT / 64) * 8) { peer_topk_stage_keys(KEYSB, vb & 7, lds); peer_topk4(Qb, R_EXP, R_GATE, vb >> 3, vb & 7, lds); }
    GRID_BAR();
    asm volatile("" : "+v"(tid)); lane = tid & 63;
    for (int tg = b0 >> 3; tg < NT / 8; tg += nb >> 3) { const int t = tg * 8 + wave, x = b0 & 7;
        peer_u_pass(ABUF + (size_t)t * D, R_EXP + (size_t)t * 128, TAB8 + (size_t)x * 16384 * 128, PD + ((size_t)x * NT + t) * 128, x, lane); }
    GRID_BAR();
    PHASE_LOOP(NT / 8) { const int t = vb * 8 + wave; peer_xk(R_EXP + (size_t)t * 128, R_GATE + (size_t)t * 128, PD + (size_t)t * 128, TSC, TSC + 16384, lane); }
    GRID_BAR();
    for (int tg = b0 >> 3; tg < NT / 8; tg += nb >> 3) { const int t = tg * 8 + wave, x = b0 & 7;
        peer_v_slice(R_EXP + (size_t)t * 128, R_GATE + (size_t)t * 128, TAB8 + (size_t)16384 * D + (size_t)x * 16384 * 128, OUTS + (size_t)t * D + x * 128, lane); }
    GRID_BAR();
    PHASE_LOOP(NT / 8) { const int t = vb * 8 + wave; peer_xc(ABUF + (size_t)t * D, OUTS + (size_t)t * D, ln_ffn_g, ln_ffn_b, nullptr, ABUF + (size_t)t * D, XRES + (size_t)t * D, lane); }
    GRID_BAR();

    GEMM_PHASE(EpiStoreBf16, ABUF, WINC_T, CN, PCb, CN, b_in_c, NT, CN);
    GRID_BAR();
    PHASE_LOOP(1024 + 256 + (NB * 128 + NS * 128) / 2) {
        if (vb < 1024) attn_unit(PCb, rel_bias, swa_sinks, ABUF, vb, lds);
        else if (vb < 1280) swa_attn_sample(PCb, cache_k, cache_v, rel_bias, swa_sinks, ABUF, (vb - 1024) * 8 + wave, lane);
        else swa_kv_out2(PCb, cache_k, cache_v, o_p_k, o_p_v, o_s_k, o_s_v, vb - 1280);
    }
    GRID_BAR();
    GEMM_PHASE_SPLIT(ABUF, WOUTC_T, D, Yb, b_out_c);
    GRID_BAR();
    PHASE_LOOP(NT / 8) { const int t = vb * 8 + wave;
        ln_res_w<true>(XRES + (size_t)t * D, Yb + (size_t)t * D, ln_mix_g + D, ln_mix_b + D, ABUF + (size_t)t * D, lane); }
    GRID_BAR();
    GEMM_PHASE_SPLIT(ABUF, WQ1_T, 2048, Qb, (const float*)nullptr);
    GRID_BAR();
    if ((nb & 7) == 0) { peer_topk_stage_keys(KEYSB + (size_t)8 * 2 * 128 * 128, b0 & 7, lds); PHASE_LOOP((NT / 64) * 8) { peer_topk4(Qb, R_EXP, R_GATE, vb >> 3, vb & 7, lds); } }
    else PHASE_LOOP((NT / 64) * 8) { peer_topk_stage_keys(KEYSB + (size_t)8 * 2 * 128 * 128, vb & 7, lds); peer_topk4(Qb, R_EXP, R_GATE, vb >> 3, vb & 7, lds); }
    GRID_BAR();
    asm volatile("" : "+v"(tid)); lane = tid & 63;
    for (int tg = b0 >> 3; tg < NT / 8; tg += nb >> 3) { const int t = tg * 8 + wave, x = b0 & 7;
        peer_u_pass(ABUF + (size_t)t * D, R_EXP + (size_t)t * 128, TAB8 + (size_t)2 * 16384 * D + (size_t)x * 16384 * 128, PD + ((size_t)x * NT + t) * 128, x, lane); }
    GRID_BAR();
    PHASE_LOOP(NT / 8) { const int t = vb * 8 + wave; peer_xk(R_EXP + (size_t)t * 128, R_GATE + (size_t)t * 128, PD + (size_t)t * 128, TSC + 2 * 16384, TSC + 3 * 16384, lane); }
    GRID_BAR();
    for (int tg = b0 >> 3; tg < NT / 8; tg += nb >> 3) { const int t = tg * 8 + wave, x = b0 & 7;
        peer_v_slice(R_EXP + (size_t)t * 128, R_GATE + (size_t)t * 128, TAB8 + (size_t)3 * 16384 * D + (size_t)x * 16384 * 128, OUTS + (size_t)t * D + x * 128, lane); }
    GRID_BAR();
    PHASE_LOOP(NT / 8) { const int t = vb * 8 + wave; peer_xc(ABUF + (size_t)t * D, OUTS + (size_t)t * D, ln_ffn_g + D, ln_ffn_b + D, o_y + (size_t)t * D, nullptr, nullptr, lane); }
}
}

extern "C" void kernel_launch(void* const* d_in, const int* in_sizes, int n_in,
                              void* d_out, int out_size, void* d_ws, size_t ws_size,
                              hipStream_t stream) {
    static int grid_blocks = 0;
    if (!grid_blocks) {
        int dev = 0, cus = 0, per_cu = 0;
        (void)hipGetDevice(&dev);
        (void)hipDeviceGetAttribute(&cus, hipDeviceAttributeMultiprocessorCount, dev);
        if (hipFuncSetAttribute((const void*)fwd_megakernel, hipFuncAttributeMaxDynamicSharedMemorySize, LDS_BYTES) != hipSuccess) { fprintf(stderr, "hipFuncSetAttribute failed\n"); grid_blocks = -1; return; }
        (void)hipOccupancyMaxActiveBlocksPerMultiprocessor(&per_cu, (const void*)fwd_megakernel, NTH, LDS_BYTES);
        if (per_cu < 1) { fprintf(stderr, "occupancy query says %d blocks per CU\n", per_cu); grid_blocks = -1; return; }
        if (cus * per_cu < 256) { fprintf(stderr, "this kernel needs 256 co-resident workgroups (device reports %d CUs x %d)\n", cus, per_cu); grid_blocks = -1; return; }
        grid_blocks = 256;
    }
    if (grid_blocks < 0) return;
    (void)hipMemsetAsync((char*)d_ws + WS_CTL, 0, CTL_ZERO_BYTES, stream);
    MegaArgs ma{};
    for (int i = 0; i < 35; ++i) ma.in[i] = (const float*)d_in[i];
    ma.out = (float*)d_out;
    ma.ws = (unsigned char*)d_ws;
    void* args[] = {&ma};
    hipError_t e = hipLaunchCooperativeKernel((void*)fwd_megakernel, dim3(grid_blocks), dim3(NTH), args, LDS_BYTES, stream);
    if (e != hipSuccess) fprintf(stderr, "cooperative launch failed: %s (grid %d)\n", hipGetErrorString(e), grid_blocks);
}
```

```cpp
#include <hip/hip_runtime.h>
#include <hip/hip_cooperative_groups.h>
#include <cstdio>
#include <cstdint>
namespace cg = cooperative_groups;

namespace pg8 {
#define PG8_LAS __attribute__((address_space(3)))
typedef unsigned short bf16_t;
typedef short bf16x8 __attribute__((ext_vector_type(8)));
typedef float f32x4 __attribute__((ext_vector_type(4)));
typedef unsigned u32x4 __attribute__((ext_vector_type(4)));
constexpr int BM = 256, BK = 64, HALF = 128, HTB = HALF * BK * 2  , STAGE_BYTES = 8 * HTB, NXCD = 8, WGM = 8;

__host__ __device__ __forceinline__ int lds_byte(int r, int c) { const int st = (r >> 4) * 2 + (c >> 5), rr = r & 15, cc = c & 31, ob = rr * 64 + cc * 2; return st * 1024 + (ob ^ (((ob >> 9) & 1) << 5)); }
__host__ __device__ __forceinline__ void stage_rc(int b, int& R, int& C) { const int st = b / 1024, sb = b % 1024, swz = sb ^ (((sb >> 9) & 1) << 5); R = (st >> 1) * 16 + swz / 64; C = (st & 1) * 32 + (swz % 64) / 2; }
__host__ __device__ __forceinline__ int perm32(int rho) { const int n = rho >> 4, i = rho & 15; return 8 * (i >> 2) + 4 * n + (i & 3); }

struct Unit { int pm, pn; };
struct Gemm { const bf16_t* A; const bf16_t* Bt; int M, N, K; };

struct StaticOrder {
    int nM, nN, nwg, G, c;
    __host__ __device__ void init(int M, int N, int G_, int c_) { nM = M / BM; nN = N / BM; nwg = nM * nN; G = G_; c = c_; }
    __host__ __device__ bool next(int i, Unit& u) const {
        const long L = (long)i * G + c; if (L >= nwg) return false;
        int wgid = (int)L; { const int q = nwg / NXCD, r = nwg % NXCD, xcd = wgid % NXCD, off = wgid / NXCD; wgid = (xcd < r ? xcd * (q + 1) : r * (q + 1) + (xcd - r) * q) + off; }
        const int nig = WGM * nN, gid = wgid / nig, fm = gid * WGM, gsz = (nM - fm) < WGM ? (nM - fm) : WGM;
        u.pm = fm + ((wgid % nig) % gsz); u.pn = (wgid % nig) / gsz; return true;
    }
    __device__ __forceinline__ void a_ready(const Unit&) const {}
    __device__ __forceinline__ void done(const Unit&) const {}
};

__device__ __forceinline__ unsigned cvt_pk_bf16(float lo, float hi) { unsigned r; asm volatile("v_cvt_pk_bf16_f32 %0, %1, %2" : "=v"(r) : "v"(lo), "v"(hi)); return r; }
template <class Epi, class Sched, bool ALIGN_EPI = false, bool SP2 = false>
__device__ __forceinline__ void gemm_phase(PG8_LAS unsigned char* lds, const Gemm g, const Sched& S, const Epi& E) {
    int tid_ = threadIdx.x; asm volatile("" : "+v"(tid_));
    const int tid = tid_, wid = __builtin_amdgcn_readfirstlane(tid >> 6), lane = tid & 63, wr = wid >> 2, wc = wid & 3, fr = lane & 15, fq = lane >> 4;
    const int K = g.K, nt = K / BK;
    unsigned voffA[2], voffB[2];
#pragma unroll
    for (int i = 0; i < 2; ++i) { int R, C; stage_rc(tid * 16 + i * 8192, R, C); const int Rb = Epi::PERM ? ((R & ~31) + perm32(R & 31)) : R;
        voffA[i] = (unsigned)(R * K + C) * 2u; voffB[i] = (unsigned)(Rb * K + C) * 2u; }
    const size_t kstep = (size_t)(BK * 2);
    const size_t hstep = (size_t)HALF * K * 2;
    const size_t tstep = 2 * hstep;
    const unsigned ldsw = (unsigned)wid * 1024u;
    const int aoff = lds_byte(wr * 64 + fr, fq * 8), boff = lds_byte(wc * 32 + fr, fq * 8);
#define PG8_SA(b, h) (((b) * 2 + (h)) * HTB)
#define PG8_SB(b, h) ((4 + (b) * 2 + (h)) * HTB)
#define PG8_STAGE(bufoff, gbase, voff) do { _Pragma("unroll") for (int _i = 0; _i < 2; ++_i) \
        __builtin_amdgcn_global_load_lds((const unsigned*)((const char*)(gbase) + (voff)[_i]), (PG8_LAS unsigned*)(lds + (bufoff) + ldsw + _i * 8192), 16, 0, 0); } while (0)
#define PG8_LDA(dst, b, h) do { _Pragma("unroll") for (int m = 0; m < 4; ++m) _Pragma("unroll") for (int k = 0; k < 2; ++k) dst[m][k] = *(const PG8_LAS bf16x8*)(lds + PG8_SA(b, h) + aoff + m * 2048 + k * 1024); } while (0)
#define PG8_LDB(dst, b, h) do { _Pragma("unroll") for (int n = 0; n < 2; ++n) _Pragma("unroll") for (int k = 0; k < 2; ++k) dst[n][k] = *(const PG8_LAS bf16x8*)(lds + PG8_SB(b, h) + boff + n * 2048 + k * 1024); } while (0)
#define PG8_MMA(ai, bj, At, Bt) do { __builtin_amdgcn_s_setprio(1); _Pragma("unroll") for (int m = 0; m < 4; ++m) _Pragma("unroll") for (int n = 0; n < 2; ++n) _Pragma("unroll") for (int k = 0; k < 2; ++k) \
        acc[ai][bj][m][n] = __builtin_amdgcn_mfma_f32_16x16x32_bf16(Bt[n][k], At[m][k], acc[ai][bj][m][n], 0, 0, 0); __builtin_amdgcn_s_setprio(0); } while (0)
#define PG8_WAIT_V(n) asm volatile("s_waitcnt vmcnt(" #n ")" ::: "memory")
#define PG8_WAIT_L(n) asm volatile("s_waitcnt lgkmcnt(" #n ")" ::: "memory")
#define PG8_BAR __builtin_amdgcn_s_barrier()
#define PG8_SCHED __builtin_amdgcn_sched_barrier(0)
    Unit cur, nxt; int ui = 0;
    if (!S.next(0, cur)) return;
    f32x4 acc[2][2][4][2];
#pragma unroll
    for (int a = 0; a < 2; ++a)
#pragma unroll
        for (int b = 0; b < 2; ++b)
#pragma unroll
            for (int m = 0; m < 4; ++m)
#pragma unroll
                for (int n = 0; n < 2; ++n) acc[a][b][m][n] = (f32x4){0.f, 0.f, 0.f, 0.f};
    bf16x8 At[4][2], B0[2][2], B1[2][2];
    const char* cA = (const char*)g.A + (size_t)cur.pm * tstep; const char* cB = (const char*)g.Bt + (size_t)cur.pn * tstep;
    S.a_ready(cur);
    if constexpr (SP2) {
        PG8_STAGE(PG8_SB(0, 0), cB, voffB); PG8_STAGE(PG8_SB(0, 1), cB + hstep, voffB); PG8_STAGE(PG8_SA(0, 0), cA, voffA); PG8_STAGE(PG8_SA(0, 1), cA + hstep, voffA);
        if (wr == 1) PG8_BAR;
        PG8_WAIT_V(2); PG8_BAR;
        PG8_STAGE(PG8_SB(1, 0), cB + kstep, voffB); PG8_STAGE(PG8_SA(1, 0), cA + kstep, voffA); PG8_STAGE(PG8_SB(1, 1), cB + hstep + kstep, voffB);
        PG8_WAIT_V(6); PG8_BAR;
    } else {
        PG8_STAGE(PG8_SB(0, 0), cB, voffB); PG8_STAGE(PG8_SA(0, 0), cA, voffA); PG8_STAGE(PG8_SB(0, 1), cB + hstep, voffB); PG8_STAGE(PG8_SA(0, 1), cA + hstep, voffA);
        if (wr == 1) PG8_BAR;
        PG8_WAIT_V(4); PG8_BAR;
        PG8_STAGE(PG8_SB(1, 0), cB + kstep, voffB); PG8_STAGE(PG8_SA(1, 0), cA + kstep, voffA); PG8_STAGE(PG8_SB(1, 1), cB + hstep + kstep, voffB);
        PG8_WAIT_V(6); PG8_BAR;
    }
    for (;;) {
        const bool has_next = S.next(ui + 1, nxt);
        const char* nA = has_next ? (const char*)g.A + (size_t)nxt.pm * tstep : cA; const char* nB = has_next ? (const char*)g.Bt + (size_t)nxt.pn * tstep : cB;
        for (int t = 0; t < nt; t += 2) {
            const bool last = (t == nt - 2);
            const char* a1 = cA + (size_t)(t + 1) * kstep;
            const char* a2 = last ? nA : cA + (size_t)(t + 2) * kstep; const char* b2 = last ? nB : cB + (size_t)(t + 2) * kstep;
            const char* a3 = a2 + kstep; const char* b3 = b2 + kstep;
            if (last && has_next) S.a_ready(nxt);
            if constexpr (SP2) {
            PG8_LDB(B0, 0, 0); PG8_LDB(B1, 0, 1); PG8_SCHED; PG8_LDA(At, 0, 0); PG8_STAGE(PG8_SA(1, 1), a1 + hstep, voffA);
            PG8_WAIT_V(8); PG8_WAIT_L(0); PG8_BAR; PG8_MMA(0, 0, At, B0); PG8_MMA(0, 1, At, B1); PG8_BAR; PG8_SCHED;
            PG8_LDA(At, 0, 1); PG8_STAGE(PG8_SB(0, 0), b2, voffB); PG8_STAGE(PG8_SB(0, 1), b2 + hstep, voffB); PG8_STAGE(PG8_SA(0, 0), a2, voffA);
            PG8_WAIT_V(8); PG8_WAIT_L(0); PG8_BAR; PG8_MMA(1, 0, At, B0); PG8_MMA(1, 1, At, B1); PG8_BAR; PG8_SCHED;
            PG8_LDB(B0, 1, 0); PG8_LDB(B1, 1, 1); PG8_SCHED; PG8_LDA(At, 1, 0); PG8_STAGE(PG8_SA(0, 1), a2 + hstep, voffA);
            PG8_WAIT_V(8); PG8_WAIT_L(0); PG8_BAR; PG8_MMA(0, 0, At, B0); PG8_MMA(0, 1, At, B1); PG8_BAR; PG8_SCHED;
            PG8_LDA(At, 1, 1); PG8_STAGE(PG8_SB(1, 0), b3, voffB); PG8_STAGE(PG8_SB(1, 1), b3 + hstep, voffB); PG8_STAGE(PG8_SA(1, 0), a3, voffA);
            PG8_WAIT_V(8); PG8_WAIT_L(0); PG8_BAR; PG8_MMA(1, 0, At, B0); PG8_MMA(1, 1, At, B1); PG8_BAR; PG8_SCHED;
            } else {
            PG8_LDB(B0, 0, 0); PG8_SCHED; PG8_LDA(At, 0, 0); PG8_STAGE(PG8_SA(1, 1), a1 + hstep, voffA);
            PG8_WAIT_L(8); PG8_BAR; PG8_WAIT_L(0); PG8_MMA(0, 0, At, B0); PG8_BAR; PG8_SCHED;
            PG8_LDB(B1, 0, 1); PG8_STAGE(PG8_SB(0, 0), b2, voffB);
            PG8_BAR; PG8_WAIT_L(0); PG8_MMA(0, 1, At, B1); PG8_BAR;
            PG8_LDA(At, 0, 1); PG8_STAGE(PG8_SA(0, 0), a2, voffA);
            PG8_BAR; PG8_WAIT_L(0); PG8_MMA(1, 0, At, B0); PG8_BAR; PG8_SCHED;
            PG8_STAGE(PG8_SB(0, 1), b2 + hstep, voffB);
            PG8_WAIT_V(6); PG8_BAR; PG8_MMA(1, 1, At, B1); PG8_BAR;
            PG8_LDB(B0, 1, 0); PG8_SCHED; PG8_LDA(At, 1, 0); PG8_STAGE(PG8_SA(0, 1), a2 + hstep, voffA);
            PG8_WAIT_L(8); PG8_BAR; PG8_WAIT_L(0); PG8_MMA(0, 0, At, B0); PG8_BAR; PG8_SCHED;
            PG8_LDB(B1, 1, 1); PG8_STAGE(PG8_SB(1, 0), b3, voffB);
            PG8_BAR; PG8_WAIT_L(0); PG8_MMA(0, 1, At, B1); PG8_BAR;
            PG8_LDA(At, 1, 1); PG8_STAGE(PG8_SA(1, 0), a3, voffA);
            PG8_BAR; PG8_WAIT_L(0); PG8_MMA(1, 0, At, B0); PG8_BAR; PG8_SCHED;
            PG8_STAGE(PG8_SB(1, 1), b3 + hstep, voffB);
            PG8_WAIT_V(6); PG8_BAR; PG8_MMA(1, 1, At, B1); PG8_BAR;
            }
        }
        if constexpr (ALIGN_EPI) { if (wr == 0) PG8_BAR; }
        if constexpr (!Epi::AFTER_DRAIN) { E(acc, cur, wr, wc, fr, fq); S.done(cur); }
        if (!has_next) break;
#pragma unroll
        for (int a = 0; a < 2; ++a)
#pragma unroll
            for (int b = 0; b < 2; ++b)
#pragma unroll
                for (int m = 0; m < 4; ++m)
#pragma unroll
                    for (int n = 0; n < 2; ++n) acc[a][b][m][n] = (f32x4){0.f, 0.f, 0.f, 0.f};
        cur = nxt; cA = nA; cB = nB; ++ui;
        if constexpr (ALIGN_EPI) { if (wr == 1) PG8_BAR; }
    }
    PG8_WAIT_V(0);
    if constexpr (!ALIGN_EPI) { if (wr == 0) PG8_BAR; }
    PG8_BAR;
    if constexpr (Epi::AFTER_DRAIN) { E.fused(acc, cur, wr, wc, fr, fq, lds, wid, lane); S.done(cur); }
#undef PG8_SA
#undef PG8_SB
#undef PG8_STAGE
#undef PG8_LDA
#undef PG8_LDB
#undef PG8_MMA
#undef PG8_WAIT_V
#undef PG8_WAIT_L
#undef PG8_BAR
#undef PG8_SCHED
}
}
namespace pg8 {
struct EpiStoreBf16 {
    static constexpr bool PERM = true, AFTER_DRAIN = false;
    bf16_t* O; int ldc; const float* bias; int m_real, n_real;
    __device__ __forceinline__ void operator()(const f32x4 (&acc)[2][2][4][2], const Unit& u, int wr, int wc, int fr, int fq) const {
        const int row0 = u.pm * BM + wr * 64 + fr, col0 = u.pn * BM + wc * 32 + 8 * fq;
#pragma unroll
        for (int bj = 0; bj < 2; ++bj) {
            const int col = col0 + bj * HALF;
            if (col >= n_real) continue;
            f32x4 b0 = (f32x4){0.f, 0.f, 0.f, 0.f}, b1 = b0;
            if (bias) { b0 = *(const f32x4*)(bias + col); b1 = *(const f32x4*)(bias + col + 4); }
#pragma unroll
            for (int ai = 0; ai < 2; ++ai)
#pragma unroll
                for (int m = 0; m < 4; ++m) {
                    const int row = row0 + ai * HALF + m * 16;
                    if (row >= m_real) continue;
                    const f32x4 v0 = acc[ai][bj][m][0] + b0, v1 = acc[ai][bj][m][1] + b1;
                    u32x4 w; w.x = cvt_pk_bf16(v0[0], v0[1]); w.y = cvt_pk_bf16(v0[2], v0[3]); w.z = cvt_pk_bf16(v1[0], v1[1]); w.w = cvt_pk_bf16(v1[2], v1[3]);
                    *(u32x4*)(O + (size_t)row * ldc + col) = w;
                }
        }
    }
};
struct EpiStoreF32 {
    static constexpr bool PERM = false, AFTER_DRAIN = false;
    float* O; int ldc; const float* bias; int m_real, n_real;
    __device__ __forceinline__ void operator()(const f32x4 (&acc)[2][2][4][2], const Unit& u, int wr, int wc, int fr, int fq) const {
        const int row0 = u.pm * BM + wr * 64 + fr, col0 = u.pn * BM + wc * 32 + 4 * fq;
#pragma unroll
        for (int bj = 0; bj < 2; ++bj)
#pragma unroll
            for (int n = 0; n < 2; ++n) {
                const int col = col0 + bj * HALF + n * 16;
                if (col >= n_real) continue;
                const f32x4 bv = bias ? *(const f32x4*)(bias + col) : (f32x4){0.f, 0.f, 0.f, 0.f};
#pragma unroll
                for (int ai = 0; ai < 2; ++ai)
#pragma unroll
                    for (int m = 0; m < 4; ++m) {
                        const int row = row0 + ai * HALF + m * 16;
                        if (row >= m_real) continue;
                        *(f32x4*)(O + (size_t)row * ldc + col) = acc[ai][bj][m][n] + bv;
                    }
            }
    }
};
}
namespace {
#define GAS __attribute__((address_space(1)))
#define LAS __attribute__((address_space(3)))
typedef unsigned short bf16;
typedef float f32x4 __attribute__((ext_vector_type(4)));
typedef unsigned v4u __attribute__((ext_vector_type(4)));
typedef unsigned v2u __attribute__((ext_vector_type(2)));

constexpr int D = 1024, NB = 4, SEQ = 4096, NP = NB * SEQ, NS = 128, NT = NP + NS, MP = 16640;
constexpr int ABN = 3080, ABNP = 3328;
constexpr int C_QKV = 0, C_Z = 1536, C_A = 2048, C_B = 2052, C_XR = 2056, C_GATE = 2568;
constexpr int CN = 1536;
constexpr float ALPHA = 1.4142135623730951f;
constexpr float LN_EPS = 1e-5f;
constexpr int NTH = 512, NWAVES = 8;
constexpr int RING_BYTES = 143360, MISC_OFF = RING_BYTES + 320, LDS_BYTES = 147456;

__device__ __forceinline__ float bf2f(bf16 v) { return __uint_as_float((unsigned)v << 16); }
__device__ __forceinline__ float bflo(unsigned w) { return __uint_as_float(w << 16); }
__device__ __forceinline__ float bfhi(unsigned w) { return __uint_as_float(w & 0xffff0000u); }
__device__ __forceinline__ unsigned f2bf(float f) { unsigned u = __float_as_uint(f); return (u + 0x7fffu + ((u >> 16) & 1u)) >> 16; }
__device__ __forceinline__ unsigned pk2(float lo, float hi) { return f2bf(lo) | (f2bf(hi) << 16); }
__device__ __forceinline__ float sigmoidf_(float x) { return 1.0f / (1.0f + expf(-x)); }
__device__ __forceinline__ float softplusf_(float x) { return fmaxf(x, 0.f) + log1pf(expf(-fabsf(x))); }
__device__ __forceinline__ float siluf_(float x) { return x / (1.0f + expf(-x)); }
__device__ __forceinline__ float geluf_(float x) { return 0.5f * x * (1.0f + tanhf(0.7978845608028654f * (x + 0.044715f * x * x * x))); }
#define DPPF(v_, ctrl_, rmask_) __int_as_float(__builtin_amdgcn_update_dpp(0, __float_as_int(v_), (ctrl_), (rmask_), 0xf, false))
__device__ __forceinline__ float wave_sum(float v) {
    v += DPPF(v, 0xB1, 0xf); v += DPPF(v, 0x4E, 0xf); v += DPPF(v, 0x141, 0xf); v += DPPF(v, 0x140, 0xf);
    v += DPPF(v, 0x142, 0xa); v += DPPF(v, 0x143, 0xc);
    return __int_as_float(__builtin_amdgcn_readlane(__float_as_int(v), 63));
}
__device__ __forceinline__ float wave_max(float v) {
    v = fmaxf(v, DPPF(v, 0xB1, 0xf)); v = fmaxf(v, DPPF(v, 0x4E, 0xf)); v = fmaxf(v, DPPF(v, 0x141, 0xf)); v = fmaxf(v, DPPF(v, 0x140, 0xf));
    { const float t = __int_as_float(__builtin_amdgcn_update_dpp(__float_as_int(v), __float_as_int(v), 0x142, 0xa, 0xf, false)); v = fmaxf(v, t); }
    { const float t = __int_as_float(__builtin_amdgcn_update_dpp(__float_as_int(v), __float_as_int(v), 0x143, 0xc, 0xf, false)); v = fmaxf(v, t); }
    return __int_as_float(__builtin_amdgcn_readlane(__float_as_int(v), 63));
}

__device__ __forceinline__ void p0_transpose_item(const float* __restrict__ W, int K, int N, bf16* __restrict__ WT, float* scr, int item, int lane) {
    const int nblk = (N + 31) / 32, kb = item / nblk, nb = item % nblk, k0 = 64 * kb, n0 = 32 * nb;
#pragma unroll 8
    for (int i = 0; i < 32; ++i) { const int kk = 2 * i + (lane >> 5), n = n0 + (lane & 31); scr[kk * 33 + (lane & 31)] = n < N ? W[(size_t)(k0 + kk) * N + n] : 0.f; }
    asm volatile("s_waitcnt lgkmcnt(0)" ::: "memory");
    const int c = lane & 7;
#pragma unroll
    for (int j = 0; j < 4; ++j) { const int n = (lane >> 3) + 8 * j; const float* s = scr + (8 * c) * 33 + n;
        v4u o; o.x = pk2(s[0 * 33], s[1 * 33]); o.y = pk2(s[2 * 33], s[3 * 33]); o.z = pk2(s[4 * 33], s[5 * 33]); o.w = pk2(s[6 * 33], s[7 * 33]);
        *(v4u*)(WT + (size_t)(n0 + n) * K + k0 + 8 * c) = o; }
    asm volatile("s_waitcnt lgkmcnt(0)" ::: "memory");
}
__device__ __forceinline__ void row_to_bf16(const float* __restrict__ xrow, bf16* __restrict__ orow, int lane) {
#pragma unroll
    for (int j = 0; j < 4; ++j) {
        f32x4 v = (f32x4){0.f, 0.f, 0.f, 0.f};
        if (xrow) v = ((const f32x4*)xrow)[lane + 64 * j];
        v2u o; o.x = pk2(v.x, v.y); o.y = pk2(v.z, v.w);
        ((v2u*)orow)[lane + 64 * j] = o;
    }
}

struct AbPrepArgs {
    const bf16* PROJ; const float* st_gdn_conv; const float* st_lru_conv;
    const float* gdn_conv_w; const float* a_log; const float* dt_bias;
    const float* lru_conv_w; const float* lru_conv_b; const float* w_r; const float* b_r; const float* w_i; const float* b_i; const float* lam;
    float* QKV; float* G; float* BETA; float* LA; float* LB;
    float* p_gdn_conv; float* p_lru_conv; float* s_gdn_conv; float* s_lru_conv;
};
__device__ __forceinline__ void ab_prep(const AbPrepArgs& a, int t, float* smem) {
    int tid = threadIdx.x; asm volatile("" : "+v"(tid));
    const int lane = tid & 63, wid = tid >> 6;
    const bool samp = t >= NP; const int sb = t - NP, pos = t % SEQ, b = t / SEQ;
    float* sq = smem;
    float* sx = smem + 1536;
    float* scl = smem + 2048;
    const bf16* prow = a.PROJ + (size_t)t * ABN;
    for (int c = tid; c < 1536; c += NTH) {
        float acc = 0.f;
#pragma unroll
        for (int i = 0; i < 4; ++i) {
            float xv;
            if (i == 3) xv = bf2f(prow[C_QKV + c]);
            else if (samp) xv = a.st_gdn_conv[((size_t)sb * 3 + i) * 1536 + c];
            else xv = (pos - 3 + i >= 0) ? bf2f(a.PROJ[(size_t)(t - 3 + i) * ABN + C_QKV + c]) : 0.f;
            acc += a.gdn_conv_w[i * 1536 + c] * xv;
        }
        sq[c] = siluf_(acc);
    }
    {
        const int c = tid;
        float acc = a.lru_conv_b[c];
#pragma unroll
        for (int i = 0; i < 4; ++i) {
            float xv;
            if (i == 3) xv = bf2f(prow[C_XR + c]);
            else if (samp) xv = a.st_lru_conv[((size_t)sb * 3 + i) * 512 + c];
            else xv = (pos - 3 + i >= 0) ? bf2f(a.PROJ[(size_t)(t - 3 + i) * ABN + C_XR + c]) : 0.f;
            acc += a.lru_conv_w[i * 512 + c] * xv;
        }
        sx[c] = acc;
    }
    __syncthreads();
    {
        const int grp = wid;
        const float v0 = sq[grp * 128 + lane], v1 = sq[grp * 128 + 64 + lane];
        const float s = wave_sum(v0 * v0 + v1 * v1);
        if (lane == 0) scl[grp] = rsqrtf(s + 1e-6f) * (grp < 4 ? 0.08838834764831845f : 1.0f);
    }
    __syncthreads();
    for (int c = tid; c < 1536; c += NTH) a.QKV[(size_t)t * 1536 + c] = (c < 1024) ? sq[c] * scl[c >> 7] : sq[c];
    if (tid < 4) {
        const float a_raw = bf2f(prow[C_A + tid]), b_raw = bf2f(prow[C_B + tid]);
        a.G[(size_t)t * 4 + tid] = -expf(a.a_log[tid]) * softplusf_(a_raw + a.dt_bias[tid]);
        a.BETA[(size_t)t * 4 + tid] = sigmoidf_(b_raw);
    }
    if (!samp) {
        if (pos >= SEQ - 3) {
            const int row = pos - (SEQ - 3);
            for (int c = tid; c < 1536; c += NTH) a.p_gdn_conv[((size_t)b * 3 + row) * 1536 + c] = bf2f(prow[C_QKV + c]);
            a.p_lru_conv[((size_t)b * 3 + row) * 512 + tid] = bf2f(prow[C_XR + tid]);
        }
    } else {
        for (int c = tid; c < 1536; c += NTH) {
            a.s_gdn_conv[((size_t)sb * 3 + 0) * 1536 + c] = a.st_gdn_conv[((size_t)sb * 3 + 1) * 1536 + c];
            a.s_gdn_conv[((size_t)sb * 3 + 1) * 1536 + c] = a.st_gdn_conv[((size_t)sb * 3 + 2) * 1536 + c];
            a.s_gdn_conv[((size_t)sb * 3 + 2) * 1536 + c] = bf2f(prow[C_QKV + c]);
        }
        {
            const int c = tid;
            a.s_lru_conv[((size_t)sb * 3 + 0) * 512 + c] = a.st_lru_conv[((size_t)sb * 3 + 1) * 512 + c];
            a.s_lru_conv[((size_t)sb * 3 + 1) * 512 + c] = a.st_lru_conv[((size_t)sb * 3 + 2) * 512 + c];
            a.s_lru_conv[((size_t)sb * 3 + 2) * 512 + c] = bf2f(prow[C_XR + c]);
        }
    }
    {
        const int c = tid, n = c >> 6, d = c & 63;
        float r = a.b_r[c], ii = a.b_i[c];
#pragma unroll 4
        for (int cc = 0; cc < 64; ++cc) {
            const float xv = sx[n * 64 + cc];
            r += xv * a.w_r[((size_t)n * 64 + cc) * 64 + d];
            ii += xv * a.w_i[((size_t)n * 64 + cc) * 64 + d];
        }
        r = sigmoidf_(r); ii = sigmoidf_(ii);
        const float log_a = -8.0f * r * softplusf_(-a.lam[c]);
        a.LA[(size_t)t * 512 + c] = expf(log_a);
        a.LB[(size_t)t * 512 + c] = sqrtf(-expm1f(2.0f * log_a)) * (ii * sx[c]);
    }
}

__device__ __forceinline__ void gdn_scan(const float* __restrict__ QKV, const float* __restrict__ G, const float* __restrict__ BETA,
                                         const float* __restrict__ S0, float* __restrict__ O, float* __restrict__ Sout, int tok_base, int T,
                                         int sl, int h, int sq, float* smem) {
    int tid = threadIdx.x; asm volatile("" : "+v"(tid));
    const int dvl = tid & 31, kg = tid >> 5;
    const int dv = sl * 32 + dvl;
    float (*red1)[32] = (float (*)[32])smem;
    float (*red2)[32] = (float (*)[32])(smem + 512);
    float S[8];
#pragma unroll
    for (int i = 0; i < 8; ++i) S[i] = S0 ? S0[(((size_t)sq * 4 + h) * 128 + kg * 8 + i) * 128 + dv] : 0.f;
    float kk[8], qq[8], vv, g, be;
    {
        const size_t tok = (size_t)tok_base + (size_t)sq * T;
        const float* row = QKV + tok * 1536;
#pragma unroll
        for (int i = 0; i < 8; ++i) { kk[i] = row[512 + h * 128 + kg * 8 + i]; qq[i] = row[h * 128 + kg * 8 + i]; }
        vv = row[1024 + h * 128 + dv]; g = G[tok * 4 + h]; be = BETA[tok * 4 + h];
    }
    for (int t = 0; t < T; ++t) {
        const size_t tok = (size_t)tok_base + (size_t)sq * T + t;
        float nk[8], nq[8], nv = 0.f, ng = 0.f, nb = 0.f;
        if (t + 1 < T) {
            const float* row = QKV + (tok + 1) * 1536;
#pragma unroll
            for (int i = 0; i < 8; ++i) { nk[i] = row[512 + h * 128 + kg * 8 + i]; nq[i] = row[h * 128 + kg * 8 + i]; }
            nv = row[1024 + h * 128 + dv]; ng = G[(tok + 1) * 4 + h]; nb = BETA[(tok + 1) * 4 + h];
        } else {
#pragma unroll
            for (int i = 0; i < 8; ++i) { nk[i] = 0.f; nq[i] = 0.f; }
        }
        const float al = expf(g);
        float p = 0.f;
#pragma unroll
        for (int i = 0; i < 8; ++i) { S[i] *= al; p += S[i] * kk[i]; }
        red1[kg][dvl] = p;
        __syncthreads();
        float ks = 0.f;
#pragma unroll
        for (int j = 0; j < 16; ++j) ks += red1[j][dvl];
        const float vn = be * (vv - ks);
        float o = 0.f;
#pragma unroll
        for (int i = 0; i < 8; ++i) { S[i] += kk[i] * vn; o += S[i] * qq[i]; }
        red2[kg][dvl] = o;
        __syncthreads();
        if (kg == 0) {
            float os = 0.f;
#pragma unroll
            for (int j = 0; j < 16; ++j) os += red2[j][dvl];
            O[tok * 512 + h * 128 + dv] = os;
        }
#pragma unroll
        for (int i = 0; i < 8; ++i) { kk[i] = nk[i]; qq[i] = nq[i]; }
        vv = nv; g = ng; be = nb;
    }
#pragma unroll
    for (int i = 0; i < 8; ++i) Sout[(((size_t)sq * 4 + h) * 128 + kg * 8 + i) * 128 + dv] = S[i];
}

__device__ __forceinline__ void lru_scan(const float* __restrict__ LA, float* __restrict__ LB, const float* __restrict__ h0,
                                         float* __restrict__ hlast, int tok_base, int T, int nseq, int bx) {
    int tx_ = threadIdx.x; asm volatile("" : "+v"(tx_));
    const int idx = bx * NTH + tx_;
    if (idx >= nseq * 512) return;
    const int sq = idx / 512, c = idx % 512;
    float h = h0 ? h0[(size_t)sq * 512 + c] : 0.f;
    const size_t base = ((size_t)tok_base + (size_t)sq * T) * 512 + c;
#pragma unroll 8
    for (int t = 0; t < T; ++t) {
        const size_t o = base + (size_t)t * 512;
        h = LA[o] * h + LB[o];
        LB[o] = h;
    }
    hlast[(size_t)sq * 512 + c] = h;
}

__device__ __forceinline__ void ab_mix_w(const bf16* __restrict__ PROJ, const float* __restrict__ O, const float* __restrict__ H, const float* __restrict__ P, const float* __restrict__ CIN,
                                         const float* __restrict__ norm_w, bf16* __restrict__ MIX, int t, int lane) {
    const bf16* prow = PROJ + (size_t)t * ABN;
    {
        const int c0 = lane * 8;
        const f32x4 o0 = *(const f32x4*)(O + (size_t)t * 512 + c0), o1 = *(const f32x4*)(O + (size_t)t * 512 + c0 + 4);
        const v4u zb = *(const v4u*)(prow + C_Z + c0);
        const f32x4 w0 = *(const f32x4*)(norm_w + (c0 & 127)), w1 = *(const f32x4*)(norm_w + (c0 & 127) + 4);
        float ss = (o0.x * o0.x + o0.y * o0.y) + (o0.z * o0.z + o0.w * o0.w) + (o1.x * o1.x + o1.y * o1.y) + (o1.z * o1.z + o1.w * o1.w);
        ss += DPPF(ss, 0xB1, 0xf); ss += DPPF(ss, 0x4E, 0xf); ss += DPPF(ss, 0x141, 0xf); ss += DPPF(ss, 0x140, 0xf);
        const float sc = rsqrtf(ss * (1.0f / 128.0f) + 1e-6f);
        const float z[8] = {bflo(zb.x), bfhi(zb.x), bflo(zb.y), bfhi(zb.y), bflo(zb.z), bfhi(zb.z), bflo(zb.w), bfhi(zb.w)};
        const float ov[8] = {o0.x, o0.y, o0.z, o0.w, o1.x, o1.y, o1.z, o1.w}, wv[8] = {w0.x, w0.y, w0.z, w0.w, w1.x, w1.y, w1.z, w1.w};
        float r[8];
#pragma unroll
        for (int i = 0; i < 8; ++i) r[i] = ov[i] * sc * wv[i] * (z[i] * __frcp_rn(1.0f + __expf(-z[i])));
        v4u ob; ob.x = pk2(r[0], r[1]); ob.y = pk2(r[2], r[3]); ob.z = pk2(r[4], r[5]); ob.w = pk2(r[6], r[7]);
        *(v4u*)(MIX + (size_t)t * 1024 + c0) = ob;
    }
    {
        const int c0 = lane * 8;
        const v4u gb = *(const v4u*)(prow + C_GATE + c0);
        f32x4 h0 = *(const f32x4*)(H + (size_t)t * 512 + c0), h1 = *(const f32x4*)(H + (size_t)t * 512 + c0 + 4);
        if (t < NP) {
            const f32x4 p0 = *(const f32x4*)(P + (size_t)t * 512 + c0), p1 = *(const f32x4*)(P + (size_t)t * 512 + c0 + 4);
            const f32x4 ci0 = *(const f32x4*)(CIN + (size_t)(t >> 6) * 512 + c0), ci1 = *(const f32x4*)(CIN + (size_t)(t >> 6) * 512 + c0 + 4);
            h0 = h0 + p0 * ci0; h1 = h1 + p1 * ci1;
        }
        const float gv[8] = {bflo(gb.x), bfhi(gb.x), bflo(gb.y), bfhi(gb.y), bflo(gb.z), bfhi(gb.z), bflo(gb.w), bfhi(gb.w)}, hv[8] = {h0.x, h0.y, h0.z, h0.w, h1.x, h1.y, h1.z, h1.w};
        float r[8];
#pragma unroll
        for (int i = 0; i < 8; ++i) r[i] = geluf_(gv[i]) * hv[i];
        v4u ob; ob.x = pk2(r[0], r[1]); ob.y = pk2(r[2], r[3]); ob.z = pk2(r[4], r[5]); ob.w = pk2(r[6], r[7]);
        *(v4u*)(MIX + (size_t)t * 1024 + 512 + c0) = ob;
    }
}

template <bool XBF>
__device__ __forceinline__ void ln_res_w(const void* __restrict__ xrow_, const bf16* __restrict__ yrow, const float* __restrict__ g, const float* __restrict__ bta,
                                         bf16* __restrict__ obrow, int lane) {
    f32x4 v[4]; float s = 0.f;
#pragma unroll
    for (int j = 0; j < 4; ++j) {
        f32x4 x4;
        if (XBF) { const v2u xb = ((const v2u*)xrow_)[lane + 64 * j]; x4 = (f32x4){bflo(xb.x), bfhi(xb.x), bflo(xb.y), bfhi(xb.y)}; }
        else x4 = ((const f32x4*)xrow_)[lane + 64 * j];
        const v2u yb = ((const v2u*)yrow)[lane + 64 * j];
        const f32x4 y4 = (f32x4){bflo(yb.x), bfhi(yb.x), bflo(yb.y), bfhi(yb.y)}; v[j] = x4 * ALPHA + y4; s += (v[j].x + v[j].y) + (v[j].z + v[j].w); }
    const float mean = wave_sum(s) * (1.0f / 1024.0f); float q = 0.f;
#pragma unroll
    for (int j = 0; j < 4; ++j) { v[j] = v[j] - mean; q += (v[j].x * v[j].x + v[j].y * v[j].y) + (v[j].z * v[j].z + v[j].w * v[j].w); }
    const float rs = rsqrtf(wave_sum(q) * (1.0f / 1024.0f) + LN_EPS);
#pragma unroll
    for (int j = 0; j < 4; ++j) {
        const f32x4 g4 = ((const f32x4*)g)[lane + 64 * j], b4 = ((const f32x4*)bta)[lane + 64 * j];
        const f32x4 o = v[j] * rs * g4 + b4;
        v2u ob; ob.x = pk2(o.x, o.y); ob.y = pk2(o.z, o.w);
        ((v2u*)obrow)[lane + 64 * j] = ob;
    }
}

__device__ __forceinline__ void peer_topk(const bf16* __restrict__ Q, const float* __restrict__ keys, int* __restrict__ EXP, float* __restrict__ GATE,
                                          int tg, int h, float* smem) {
    const int tid = threadIdx.x, cn = tid & 255, c = cn >> 7, n = cn & 127, th = tid >> 8;
    float (*sq)[256] = (float (*)[256])smem;
    float (*ss)[257] = (float (*)[257])(smem + 32 * 256);
    float (*tvs)[2][16] = (float (*)[2][16])(smem + 32 * 256 + 32 * 257 + 32);
    int (*tis)[2][16] = (int (*)[2][16])(smem + 32 * 256 + 32 * 257 + 32 + 1024);
    for (int i = tid; i < 32 * 256; i += NTH) {
        const int tk = i >> 8, col = i & 255;
        sq[tk][col] = bf2f(Q[(size_t)(tg * 32 + tk) * 2048 + h * 256 + col]);
    }
    __syncthreads();
    float acc[16];
#pragma unroll
    for (int i = 0; i < 16; ++i) acc[i] = 0.f;
    const float* krow = keys + (((size_t)h * 2 + c) * 128 + n) * 128;
    for (int d4 = 0; d4 < 32; ++d4) {
        const float4 kv = *(const float4*)(krow + d4 * 4);
#pragma unroll
        for (int tk = 0; tk < 16; ++tk) {
            const float4 qv = *(const float4*)&sq[th * 16 + tk][c * 128 + d4 * 4];
            acc[tk] += qv.x * kv.x + qv.y * kv.y + qv.z * kv.z + qv.w * kv.w;
        }
    }
#pragma unroll
    for (int tk = 0; tk < 16; ++tk) ss[th * 16 + tk][cn] = acc[tk];
    __syncthreads();
    if (tid < 64) {
        const int tk = tid >> 1, cc = tid & 1;
        float tv[16]; int ti[16];
#pragma unroll
        for (int j = 0; j < 16; ++j) { tv[j] = -INFINITY; ti[j] = 0; }
        for (int nn = 0; nn < 128; ++nn) {
            float x = ss[tk][cc * 128 + nn]; int xi = nn;
#pragma unroll
            for (int j = 0; j < 16; ++j) {
                const bool gt = x > tv[j];
                const float tf = tv[j]; const int tj = ti[j];
                tv[j] = gt ? x : tf; ti[j] = gt ? xi : tj;
                x = gt ? tf : x; xi = gt ? tj : xi;
            }
        }
#pragma unroll
        for (int j = 0; j < 16; ++j) { tvs[tk][cc][j] = tv[j]; tis[tk][cc][j] = ti[j]; }
    }
    __syncthreads();
    if (tid < 32) {
        const int tk = tid;
        float bv[16]; int bi[16];
#pragma unroll
        for (int j = 0; j < 16; ++j) { bv[j] = -INFINITY; bi[j] = 0; }
        for (int i = 0; i < 16; ++i)
            for (int jj = 0; jj < 16; ++jj) {
                float x = tvs[tk][0][i] + tvs[tk][1][jj]; int xi = tis[tk][0][i] * 128 + tis[tk][1][jj];
#pragma unroll
                for (int j = 0; j < 16; ++j) {
                    const bool gt = x > bv[j];
                    const float tf = bv[j]; const int tj = bi[j];
                    bv[j] = gt ? x : tf; bi[j] = gt ? xi : tj;
                    x = gt ? tf : x; xi = gt ? tj : xi;
                }
            }
        float e[16], sum = 0.f;
#pragma unroll
        for (int j = 0; j < 16; ++j) { e[j] = expf(bv[j] - bv[0]); sum += e[j]; }
        const float inv = 1.0f / sum;
        const size_t o = (size_t)(tg * 32 + tk) * 128 + h * 16;
#pragma unroll
        for (int j = 0; j < 16; ++j) { EXP[o + j] = bi[j]; GATE[o + j] = e[j] * inv; }
    }
}

__device__ __forceinline__ void peer_expert(const float* __restrict__ X, const int* __restrict__ EXP, const float* __restrict__ GATE,
                                            const float* __restrict__ U, const float* __restrict__ V,
                                            const float* __restrict__ g, const float* __restrict__ bta, float* __restrict__ out, bf16* __restrict__ outb, int t, float* smem) {
    const int tid = threadIdx.x, lane = tid & 63, wid = tid >> 6;
    float (*accs)[1024] = (float (*)[1024])smem;
    float* sred = smem + 8192;
    const float4* xr = (const float4*)(X + (size_t)t * D);
    float4 xv[4];
#pragma unroll
    for (int j = 0; j < 4; ++j) xv[j] = xr[lane + 64 * j];
    float4 acc[4];
#pragma unroll
    for (int j = 0; j < 4; ++j) acc[j] = make_float4(0.f, 0.f, 0.f, 0.f);
    for (int e = 0; e < 16; ++e) {
        const int id = EXP[(size_t)t * 128 + wid * 16 + e];
        const float gt = GATE[(size_t)t * 128 + wid * 16 + e];
        const float4* ur = (const float4*)(U + (size_t)id * D);
        const float4* vr = (const float4*)(V + (size_t)id * D);
        float4 uv[4], vv[4];
#pragma unroll
        for (int j = 0; j < 4; ++j) { uv[j] = ur[lane + 64 * j]; vv[j] = vr[lane + 64 * j]; }
        float dot = 0.f;
#pragma unroll
        for (int j = 0; j < 4; ++j) dot += uv[j].x * xv[j].x + uv[j].y * xv[j].y + uv[j].z * xv[j].z + uv[j].w * xv[j].w;
        dot = wave_sum(dot);
        const float cf = gt * geluf_(dot);
#pragma unroll
        for (int j = 0; j < 4; ++j) { acc[j].x += cf * vv[j].x; acc[j].y += cf * vv[j].y; acc[j].z += cf * vv[j].z; acc[j].w += cf * vv[j].w; }
    }
#pragma unroll
    for (int j = 0; j < 4; ++j) *(float4*)&accs[wid][(lane + 64 * j) * 4] = acc[j];
    __syncthreads();
    float v[2];
#pragma unroll
    for (int i = 0; i < 2; ++i) {
        const int c = tid * 2 + i;
        float s = 0.f;
#pragma unroll
        for (int w = 0; w < 8; ++w) s += accs[w][c];
        v[i] = ALPHA * X[(size_t)t * D + c] + s;
    }
    float s = wave_sum(v[0] + v[1]);
    if (lane == 0) sred[wid] = s;
    __syncthreads();
    float mean = 0.f;
#pragma unroll
    for (int w = 0; w < 8; ++w) mean += sred[w];
    mean *= (1.0f / 1024.0f);
    __syncthreads();
    const float d0 = v[0] - mean, d1 = v[1] - mean;
    float q = wave_sum(d0 * d0 + d1 * d1);
    if (lane == 0) sred[wid] = q;
    __syncthreads();
    float var = 0.f;
#pragma unroll
    for (int w = 0; w < 8; ++w) var += sred[w];
    const float rs = rsqrtf(var * (1.0f / 1024.0f) + LN_EPS);
    const float o0 = d0 * rs * g[tid * 2] + bta[tid * 2], o1 = d1 * rs * g[tid * 2 + 1] + bta[tid * 2 + 1];
    *(float2*)(out + (size_t)t * D + tid * 2) = make_float2(o0, o1);
    if (outb) *(unsigned*)(outb + (size_t)t * D + tid * 2) = pk2(o0, o1);
}


typedef __bf16 bf16x2_t __attribute__((ext_vector_type(2)));
__device__ __forceinline__ float dot2bf(unsigned w, unsigned x, float acc) { return __builtin_amdgcn_fdot2_f32_bf16(__builtin_bit_cast(bf16x2_t, w), __builtin_bit_cast(bf16x2_t, x), acc, false); }
typedef float f32x2_t __attribute__((ext_vector_type(2)));
__device__ __forceinline__ void row_to_fp8(const float* __restrict__ xrow, unsigned char* __restrict__ orow, float* __restrict__ scale, int lane) {
    f32x4 v[4]; float am = 0.f;
#pragma unroll
    for (int j = 0; j < 4; ++j) { v[j] = *(const f32x4*)(xrow + lane * 16 + j * 4); am = fmaxf(am, fmaxf(fmaxf(fabsf(v[j].x), fabsf(v[j].y)), fmaxf(fabsf(v[j].z), fabsf(v[j].w)))); }
    am = wave_max(am);
    const float s = am > 0.f ? am * (1.0f / 448.0f) : 1.0f, inv = 1.0f / s;
    v4u o;
    unsigned w;
    w = 0u; w = __builtin_amdgcn_cvt_pk_fp8_f32(v[0].x * inv, v[0].y * inv, w, false); w = __builtin_amdgcn_cvt_pk_fp8_f32(v[0].z * inv, v[0].w * inv, w, true); o.x = w;
    w = 0u; w = __builtin_amdgcn_cvt_pk_fp8_f32(v[1].x * inv, v[1].y * inv, w, false); w = __builtin_amdgcn_cvt_pk_fp8_f32(v[1].z * inv, v[1].w * inv, w, true); o.y = w;
    w = 0u; w = __builtin_amdgcn_cvt_pk_fp8_f32(v[2].x * inv, v[2].y * inv, w, false); w = __builtin_amdgcn_cvt_pk_fp8_f32(v[2].z * inv, v[2].w * inv, w, true); o.z = w;
    w = 0u; w = __builtin_amdgcn_cvt_pk_fp8_f32(v[3].x * inv, v[3].y * inv, w, false); w = __builtin_amdgcn_cvt_pk_fp8_f32(v[3].z * inv, v[3].w * inv, w, true); o.w = w;
    *(v4u*)(orow + lane * 16) = o;
    if (lane == 0) *scale = s;
}
#define PE_LOAD(UB, VB, grp) do { _Pragma("unroll") for (int i_ = 0; i_ < 4; ++i_) { const int e_ = (grp) * 4 + i_; \
        const int id_ = __builtin_amdgcn_readlane(e_ < 64 ? id0 : id1, e_ & 63); \
        const unsigned so_ = (unsigned)id_ * 1024u; \
        UB[i_] = __builtin_amdgcn_raw_buffer_load_b128(ursrc, voff, so_, 0); VB[i_] = __builtin_amdgcn_raw_buffer_load_b128(vrsrc, voff, so_, 0); } } while (0)
#define PE_DOT4(w, k) do { const f32x2_t l_ = __builtin_amdgcn_cvt_pk_f32_fp8((w), false), h_ = __builtin_amdgcn_cvt_pk_f32_fp8((w), true); \
        a_ += l_.x * xv[(k) * 4 + 0]; b_ += l_.y * xv[(k) * 4 + 1]; a_ += h_.x * xv[(k) * 4 + 2]; b_ += h_.y * xv[(k) * 4 + 3]; } while (0)
#define PE_AXPY4(w, k) do { const f32x2_t l_ = __builtin_amdgcn_cvt_pk_f32_fp8((w), false), h_ = __builtin_amdgcn_cvt_pk_f32_fp8((w), true); \
        acc[(k) * 4 + 0] += cf_ * l_.x; acc[(k) * 4 + 1] += cf_ * l_.y; acc[(k) * 4 + 2] += cf_ * h_.x; acc[(k) * 4 + 3] += cf_ * h_.y; } while (0)
#define PE_COMP(UB, VB, grp) do { float d_[4]; \
        _Pragma("unroll") for (int i_ = 0; i_ < 4; ++i_) { float a_ = 0.f, b_ = 0.f; PE_DOT4(UB[i_].x, 0); PE_DOT4(UB[i_].y, 1); PE_DOT4(UB[i_].z, 2); PE_DOT4(UB[i_].w, 3); d_[i_] = a_ + b_; } \
          \
        float s0_ = hi32 ? d_[2] : d_[0], t0_ = hi32 ? d_[0] : d_[2]; s0_ += __shfl_xor(t0_, 32); \
        float s1_ = hi32 ? d_[3] : d_[1], t1_ = hi32 ? d_[1] : d_[3]; s1_ += __shfl_xor(t1_, 32); \
        float r_ = hi16 ? s1_ : s0_, t2_ = hi16 ? s0_ : s1_; r_ += __shfl_xor(t2_, 16); \
        r_ += __shfl_xor(r_, 8); r_ += __shfl_xor(r_, 4); r_ += __shfl_xor(r_, 2); r_ += __shfl_xor(r_, 1); \
          \
        const int esel_ = (grp) * 4 + (lane >> 4); \
        const float su_ = __shfl(esel_ < 64 ? su0 : su1, esel_ & 63), gv_ = __shfl(esel_ < 64 ? gs0 : gs1, esel_ & 63); \
        const float cfl_ = geluf_(r_ * su_) * gv_; \
        _Pragma("unroll") for (int i_ = 0; i_ < 4; ++i_) { \
            const float cf_ = __uint_as_float(__builtin_amdgcn_readlane(__float_as_uint(cfl_), 16 * i_)); \
            PE_AXPY4(VB[i_].x, 0); PE_AXPY4(VB[i_].y, 1); PE_AXPY4(VB[i_].z, 2); PE_AXPY4(VB[i_].w, 3); } } while (0)
__device__ __forceinline__ void peer_expert_w(const float* __restrict__ xrow, const int* __restrict__ exr, const float* __restrict__ gar,
                                              const unsigned char* __restrict__ U, const unsigned char* __restrict__ V, const float* __restrict__ SU, const float* __restrict__ SV,
                                              const float* __restrict__ g, const float* __restrict__ bta, float* __restrict__ orow, bf16* __restrict__ obrow, int lane) {
    const bool hi32 = (lane & 32) != 0, hi16 = (lane & 16) != 0;
    const __amdgpu_buffer_rsrc_t ursrc = __builtin_amdgcn_make_buffer_rsrc((void*)U, 0, 16384 * 1024, 0x00020000);
    const __amdgpu_buffer_rsrc_t vrsrc = __builtin_amdgcn_make_buffer_rsrc((void*)V, 0, 16384 * 1024, 0x00020000);
    const int voff = lane * 16;
    float xv[16];
#pragma unroll
    for (int j = 0; j < 4; ++j) { const f32x4 t = *(const f32x4*)(xrow + lane * 16 + j * 4); xv[j * 4 + 0] = t.x; xv[j * 4 + 1] = t.y; xv[j * 4 + 2] = t.z; xv[j * 4 + 3] = t.w; }
    const int id0 = exr[lane], id1 = exr[64 + lane];
    const float su0 = SU[id0], su1 = SU[id1];
    const float gs0 = gar[lane] * SV[id0], gs1 = gar[64 + lane] * SV[id1];
    float acc[16];
#pragma unroll
    for (int i = 0; i < 16; ++i) acc[i] = 0.f;
    v4u ua[4], va[4], ub[4], vb[4];
    PE_LOAD(ua, va, 0);
#pragma unroll 1
    for (int grp = 0; grp < 32; grp += 2) {
        PE_LOAD(ub, vb, grp + 1);
        PE_COMP(ua, va, grp);
        if (grp + 2 < 32) PE_LOAD(ua, va, grp + 2);
        PE_COMP(ub, vb, grp + 1);
    }
    float v[16]; float s = 0.f;
#pragma unroll
    for (int i = 0; i < 16; ++i) { v[i] = ALPHA * xv[i] + acc[i]; s += v[i]; }
    const float mean = wave_sum(s) * (1.0f / 1024.0f); float q = 0.f;
#pragma unroll
    for (int i = 0; i < 16; ++i) { v[i] -= mean; q += v[i] * v[i]; }
    const float rs = rsqrtf(wave_sum(q) * (1.0f / 1024.0f) + LN_EPS);
    float o[16];
#pragma unroll
    for (int j = 0; j < 4; ++j) {
        const f32x4 g4 = *(const f32x4*)(g + lane * 16 + j * 4), b4 = *(const f32x4*)(bta + lane * 16 + j * 4);
        o[j * 4 + 0] = v[j * 4 + 0] * rs * g4.x + b4.x; o[j * 4 + 1] = v[j * 4 + 1] * rs * g4.y + b4.y; o[j * 4 + 2] = v[j * 4 + 2] * rs * g4.z + b4.z; o[j * 4 + 3] = v[j * 4 + 3] * rs * g4.w + b4.w;
        *(f32x4*)(orow + lane * 16 + j * 4) = (f32x4){o[j * 4 + 0], o[j * 4 + 1], o[j * 4 + 2], o[j * 4 + 3]};
    }
    if (obrow) {
        v4u w0, w1; w0.x = pk2(o[0], o[1]); w0.y = pk2(o[2], o[3]); w0.z = pk2(o[4], o[5]); w0.w = pk2(o[6], o[7]); w1.x = pk2(o[8], o[9]); w1.y = pk2(o[10], o[11]); w1.z = pk2(o[12], o[13]); w1.w = pk2(o[14], o[15]);
        *(v4u*)(obrow + lane * 16) = w0; *(v4u*)(obrow + lane * 16 + 8) = w1;
    }
}


__device__ __forceinline__ void peer_expert_blk(const float* __restrict__ xrow, const int* __restrict__ exr, const float* __restrict__ gar,
                                                const unsigned char* __restrict__ U, const unsigned char* __restrict__ V, const float* __restrict__ SU, const float* __restrict__ SV,
                                                const float* __restrict__ g, const float* __restrict__ bta, float* __restrict__ orow, bf16* __restrict__ obrow, int lane, int wave, float* smem) {
    const bool hi32 = (lane & 32) != 0, hi16 = (lane & 16) != 0;
    const __amdgpu_buffer_rsrc_t ursrc = __builtin_amdgcn_make_buffer_rsrc((void*)U, 0, 16384 * 1024, 0x00020000);
    const __amdgpu_buffer_rsrc_t vrsrc = __builtin_amdgcn_make_buffer_rsrc((void*)V, 0, 16384 * 1024, 0x00020000);
    const int voff = lane * 16;
    float xv[16];
#pragma unroll
    for (int j = 0; j < 4; ++j) { const f32x4 t = *(const f32x4*)(xrow + lane * 16 + j * 4); xv[j * 4 + 0] = t.x; xv[j * 4 + 1] = t.y; xv[j * 4 + 2] = t.z; xv[j * 4 + 3] = t.w; }
    const int id0 = exr[lane], id1 = exr[64 + lane];
    const float su0 = SU[id0], su1 = SU[id1];
    const float gs0 = gar[lane] * SV[id0], gs1 = gar[64 + lane] * SV[id1];
    float acc[16];
#pragma unroll
    for (int i = 0; i < 16; ++i) acc[i] = 0.f;
    v4u ua[4], va[4], ub[4], vb[4];
    const int g0 = wave * 4;
    PE_LOAD(ua, va, g0); PE_LOAD(ub, vb, g0 + 1);
    PE_COMP(ua, va, g0); PE_LOAD(ua, va, g0 + 2);
    PE_COMP(ub, vb, g0 + 1); PE_LOAD(ub, vb, g0 + 3);
    PE_COMP(ua, va, g0 + 2);
    PE_COMP(ub, vb, g0 + 3);
    float* accs = smem;
    float* sred = smem + 8192;
#pragma unroll
    for (int j = 0; j < 4; ++j) *(f32x4*)(accs + wave * 1024 + lane * 16 + j * 4) = (f32x4){acc[j * 4 + 0], acc[j * 4 + 1], acc[j * 4 + 2], acc[j * 4 + 3]};
    __syncthreads();
    const int tid = wave * 64 + lane;
    float v0 = ALPHA * xrow[tid * 2], v1 = ALPHA * xrow[tid * 2 + 1];
#pragma unroll
    for (int w = 0; w < 8; ++w) { v0 += accs[w * 1024 + tid * 2]; v1 += accs[w * 1024 + tid * 2 + 1]; }
    const float s = wave_sum(v0 + v1);
    if (lane == 0) sred[wave] = s;
    __syncthreads();
    float mean = 0.f;
#pragma unroll
    for (int w = 0; w < 8; ++w) mean += sred[w];
    mean *= (1.0f / 1024.0f);
    __syncthreads();
    const float d0 = v0 - mean, d1 = v1 - mean;
    const float q = wave_sum(d0 * d0 + d1 * d1);
    if (lane == 0) sred[wave] = q;
    __syncthreads();
    float var = 0.f;
#pragma unroll
    for (int w = 0; w < 8; ++w) var += sred[w];
    const float rs = rsqrtf(var * (1.0f / 1024.0f) + LN_EPS);
    const float o0 = d0 * rs * g[tid * 2] + bta[tid * 2], o1 = d1 * rs * g[tid * 2 + 1] + bta[tid * 2 + 1];
    *(float2*)(orow + tid * 2) = make_float2(o0, o1);
    if (obrow) *(unsigned*)(obrow + tid * 2) = pk2(o0, o1);
    __syncthreads();
}

__device__ __forceinline__ void row_to_fp8_sliced(const float* __restrict__ xrow, unsigned char* __restrict__ tab, int r, float* __restrict__ scale, int lane) {
    f32x4 v[4]; float am = 0.f;
#pragma unroll
    for (int j = 0; j < 4; ++j) { v[j] = *(const f32x4*)(xrow + lane * 16 + j * 4); am = fmaxf(am, fmaxf(fmaxf(fabsf(v[j].x), fabsf(v[j].y)), fmaxf(fabsf(v[j].z), fabsf(v[j].w)))); }
    am = wave_max(am);
    const float s = am > 0.f ? am * (1.0f / 448.0f) : 1.0f, inv = 1.0f / s;
    v4u o; unsigned w;
    w = 0u; w = __builtin_amdgcn_cvt_pk_fp8_f32(v[0].x * inv, v[0].y * inv, w, false); w = __builtin_amdgcn_cvt_pk_fp8_f32(v[0].z * inv, v[0].w * inv, w, true); o.x = w;
    w = 0u; w = __builtin_amdgcn_cvt_pk_fp8_f32(v[1].x * inv, v[1].y * inv, w, false); w = __builtin_amdgcn_cvt_pk_fp8_f32(v[1].z * inv, v[1].w * inv, w, true); o.y = w;
    w = 0u; w = __builtin_amdgcn_cvt_pk_fp8_f32(v[2].x * inv, v[2].y * inv, w, false); w = __builtin_amdgcn_cvt_pk_fp8_f32(v[2].z * inv, v[2].w * inv, w, true); o.z = w;
    w = 0u; w = __builtin_amdgcn_cvt_pk_fp8_f32(v[3].x * inv, v[3].y * inv, w, false); w = __builtin_amdgcn_cvt_pk_fp8_f32(v[3].z * inv, v[3].w * inv, w, true); o.w = w;
    *(v4u*)(tab + ((size_t)(lane >> 3) * 16384 + r) * 128 + (lane & 7) * 16) = o;
    if (lane == 0) *scale = s;
}
__device__ __forceinline__ void peer_u_pass(const bf16* __restrict__ xrow, const int* __restrict__ exr, const unsigned char* __restrict__ U8x, float* __restrict__ pd, int x, int lane) {
    const int e8 = lane >> 3, c = lane & 7;
    f32x2_t xp[8];
#pragma unroll
    for (int j = 0; j < 2; ++j) { const v4u t = *(const v4u*)(xrow + x * 128 + c * 16 + j * 8);
        xp[j * 4 + 0] = (f32x2_t){bflo(t.x), bfhi(t.x)}; xp[j * 4 + 1] = (f32x2_t){bflo(t.y), bfhi(t.y)}; xp[j * 4 + 2] = (f32x2_t){bflo(t.z), bfhi(t.z)}; xp[j * 4 + 3] = (f32x2_t){bflo(t.w), bfhi(t.w)}; }
    const __amdgpu_buffer_rsrc_t ursrc = __builtin_amdgcn_make_buffer_rsrc((void*)U8x, 0, 16384 * 128, 0x00020000);
    v4u wa[8], wb[8];
    float d[16];
    int ids[16];
#pragma unroll
    for (int j = 0; j < 4; ++j) { const v4u t = *(const v4u*)(exr + e8 * 16 + j * 4); ids[j * 4 + 0] = (int)t.x; ids[j * 4 + 1] = (int)t.y; ids[j * 4 + 2] = (int)t.z; ids[j * 4 + 3] = (int)t.w; }
#pragma unroll
    for (int g = 0; g < 8; ++g) wa[g] = __builtin_amdgcn_raw_buffer_load_b128(ursrc, ids[g] * 128 + c * 16, 0, 0);
#pragma unroll
    for (int g = 0; g < 8; ++g) wb[g] = __builtin_amdgcn_raw_buffer_load_b128(ursrc, ids[8 + g] * 128 + c * 16, 0, 0);
#define PU_DOT1(w_, k_) do { a_ = __builtin_elementwise_fma(__builtin_amdgcn_cvt_pk_f32_fp8((w_), false), xp[(k_) * 2], a_); a_ = __builtin_elementwise_fma(__builtin_amdgcn_cvt_pk_f32_fp8((w_), true), xp[(k_) * 2 + 1], a_); } while (0)
#pragma unroll
    for (int g = 0; g < 8; ++g) { f32x2_t a_ = (f32x2_t){0.f, 0.f}; PU_DOT1(wa[g].x, 0); PU_DOT1(wa[g].y, 1); PU_DOT1(wa[g].z, 2); PU_DOT1(wa[g].w, 3); d[g] = a_.x + a_.y; }
#pragma unroll
    for (int g = 0; g < 8; ++g) { f32x2_t a_ = (f32x2_t){0.f, 0.f}; PU_DOT1(wb[g].x, 0); PU_DOT1(wb[g].y, 1); PU_DOT1(wb[g].z, 2); PU_DOT1(wb[g].w, 3); d[8 + g] = a_.x + a_.y; }
#pragma unroll
    for (int g = 0; g < 16; ++g) { d[g] += DPPF(d[g], 0xB1, 0xf); d[g] += DPPF(d[g], 0x4E, 0xf); d[g] += DPPF(d[g], 0x141, 0xf); }
    if (c == 0) {
#pragma unroll
        for (int j = 0; j < 4; ++j) *(f32x4*)(pd + e8 * 16 + j * 4) = (f32x4){d[j * 4 + 0], d[j * 4 + 1], d[j * 4 + 2], d[j * 4 + 3]};
    }
}
#define PV_LOAD(VB, grp) do { _Pragma("unroll") for (int i_ = 0; i_ < 4; ++i_) { const int e_ = (grp) * 4 + i_; \
        const int id_ = __builtin_amdgcn_readlane(e_ < 64 ? id0 : id1, e_ & 63); \
        VB[i_] = __builtin_amdgcn_raw_buffer_load_b128(vrsrc, voff, (unsigned)id_ * 1024u, 0); } } while (0)
#define PV_COMP(VB, grp) do { _Pragma("unroll") for (int i_ = 0; i_ < 4; ++i_) { const int e_ = (grp) * 4 + i_; \
        const float cf_ = __uint_as_float(__builtin_amdgcn_readlane(__float_as_uint(e_ < 64 ? cf0 : cf1), e_ & 63)); \
        PE_AXPY4(VB[i_].x, 0); PE_AXPY4(VB[i_].y, 1); PE_AXPY4(VB[i_].z, 2); PE_AXPY4(VB[i_].w, 3); } } while (0)
#define PV_COEFS() \
    const int id0 = exr[lane], id1 = exr[64 + lane]; \
    float dot0 = 0.f, dot1 = 0.f; \
    { const int p0 = lane, p1 = 64 + lane;        \
      _Pragma("unroll") for (int x_ = 0; x_ < 8; ++x_) { dot0 += pdt[(size_t)x_ * NT * 128 + p0]; dot1 += pdt[(size_t)x_ * NT * 128 + p1]; } } \
    const float cf0 = gar[lane] * SV[id0] * geluf_(SU[id0] * dot0), cf1 = gar[64 + lane] * SV[id1] * geluf_(SU[id1] * dot1);
__device__ __forceinline__ void peer_v_w(const float* __restrict__ xrow, const int* __restrict__ exr, const float* __restrict__ gar, const float* __restrict__ pdt,
                                         const unsigned char* __restrict__ V, const float* __restrict__ SU, const float* __restrict__ SV,
                                         const float* __restrict__ g, const float* __restrict__ bta, float* __restrict__ orow, bf16* __restrict__ obrow, int lane) {
    const __amdgpu_buffer_rsrc_t vrsrc = __builtin_amdgcn_make_buffer_rsrc((void*)V, 0, 16384 * 1024, 0x00020000);
    const int voff = lane * 16;
    PV_COEFS()
    float acc[16];
#pragma unroll
    for (int i = 0; i < 16; ++i) acc[i] = 0.f;
    v4u va[4], vb[4], vc[4];
    PV_LOAD(va, 0); PV_LOAD(vb, 1);
#pragma unroll 1
    for (int grp = 0; grp < 30; grp += 3) {
        PV_LOAD(vc, grp + 2);
        PV_COMP(va, grp);
        PV_LOAD(va, grp + 3);
        PV_COMP(vb, grp + 1);
        PV_LOAD(vb, grp + 4);
        PV_COMP(vc, grp + 2);
    }
    PV_COMP(va, 30); PV_COMP(vb, 31);
    float xv[16];
#pragma unroll
    for (int j = 0; j < 4; ++j) { const f32x4 t = *(const f32x4*)(xrow + lane * 16 + j * 4); xv[j * 4 + 0] = t.x; xv[j * 4 + 1] = t.y; xv[j * 4 + 2] = t.z; xv[j * 4 + 3] = t.w; }
    float v[16]; float s = 0.f;
#pragma unroll
    for (int i = 0; i < 16; ++i) { v[i] = ALPHA * xv[i] + acc[i]; s += v[i]; }
    const float mean = wave_sum(s) * (1.0f / 1024.0f); float q = 0.f;
#pragma unroll
    for (int i = 0; i < 16; ++i) { v[i] -= mean; q += v[i] * v[i]; }
    const float rs = rsqrtf(wave_sum(q) * (1.0f / 1024.0f) + LN_EPS);
    float o[16];
#pragma unroll
    for (int j = 0; j < 4; ++j) {
        const f32x4 g4 = *(const f32x4*)(g + lane * 16 + j * 4), b4 = *(const f32x4*)(bta + lane * 16 + j * 4);
        o[j * 4 + 0] = v[j * 4 + 0] * rs * g4.x + b4.x; o[j * 4 + 1] = v[j * 4 + 1] * rs * g4.y + b4.y; o[j * 4 + 2] = v[j * 4 + 2] * rs * g4.z + b4.z; o[j * 4 + 3] = v[j * 4 + 3] * rs * g4.w + b4.w;
        *(f32x4*)(orow + lane * 16 + j * 4) = (f32x4){o[j * 4 + 0], o[j * 4 + 1], o[j * 4 + 2], o[j * 4 + 3]};
    }
    if (obrow) {
        v4u w0, w1; w0.x = pk2(o[0], o[1]); w0.y = pk2(o[2], o[3]); w0.z = pk2(o[4], o[5]); w0.w = pk2(o[6], o[7]); w1.x = pk2(o[8], o[9]); w1.y = pk2(o[10], o[11]); w1.z = pk2(o[12], o[13]); w1.w = pk2(o[14], o[15]);
        *(v4u*)(obrow + lane * 16) = w0; *(v4u*)(obrow + lane * 16 + 8) = w1;
    }
}
__device__ __forceinline__ void peer_v_blk(const float* __restrict__ xrow, const int* __restrict__ exr, const float* __restrict__ gar, const float* __restrict__ pdt,
                                           const unsigned char* __restrict__ V, const float* __restrict__ SU, const float* __restrict__ SV,
                                           const float* __restrict__ g, const float* __restrict__ bta, float* __restrict__ orow, bf16* __restrict__ obrow, int lane, int wave, float* smem) {
    const __amdgpu_buffer_rsrc_t vrsrc = __builtin_amdgcn_make_buffer_rsrc((void*)V, 0, 16384 * 1024, 0x00020000);
    const int voff = lane * 16;
    PV_COEFS()
    float acc[16];
#pragma unroll
    for (int i = 0; i < 16; ++i) acc[i] = 0.f;
    v4u va[4], vb[4], vc[4], vd[4];
    PV_LOAD(va, wave * 4); PV_LOAD(vb, wave * 4 + 1); PV_LOAD(vc, wave * 4 + 2); PV_LOAD(vd, wave * 4 + 3);
    PV_COMP(va, wave * 4); PV_COMP(vb, wave * 4 + 1); PV_COMP(vc, wave * 4 + 2); PV_COMP(vd, wave * 4 + 3);
    float* accs = smem;
    float* sred = smem + 8192;
#pragma unroll
    for (int j = 0; j < 4; ++j) *(f32x4*)(accs + wave * 1024 + lane * 16 + j * 4) = (f32x4){acc[j * 4 + 0], acc[j * 4 + 1], acc[j * 4 + 2], acc[j * 4 + 3]};
    __syncthreads();
    const int tid = wave * 64 + lane;
    float v0 = ALPHA * xrow[tid * 2], v1 = ALPHA * xrow[tid * 2 + 1];
#pragma unroll
    for (int w = 0; w < 8; ++w) { v0 += accs[w * 1024 + tid * 2]; v1 += accs[w * 1024 + tid * 2 + 1]; }
    const float s = wave_sum(v0 + v1);
    if (lane == 0) sred[wave] = s;
    __syncthreads();
    float mean = 0.f;
#pragma unroll
    for (int w = 0; w < 8; ++w) mean += sred[w];
    mean *= (1.0f / 1024.0f);
    __syncthreads();
    const float d0 = v0 - mean, d1 = v1 - mean;
    const float q = wave_sum(d0 * d0 + d1 * d1);
    if (lane == 0) sred[wave] = q;
    __syncthreads();
    float var = 0.f;
#pragma unroll
    for (int w = 0; w < 8; ++w) var += sred[w];
    const float rs = rsqrtf(var * (1.0f / 1024.0f) + LN_EPS);
    const float o0 = d0 * rs * g[tid * 2] + bta[tid * 2], o1 = d1 * rs * g[tid * 2 + 1] + bta[tid * 2 + 1];
    *(float2*)(orow + tid * 2) = make_float2(o0, o1);
    if (obrow) *(unsigned*)(obrow + tid * 2) = pk2(o0, o1);
    __syncthreads();
}

__device__ __forceinline__ void peer_xk(const int* __restrict__ exr, float* __restrict__ gar, const float* __restrict__ pdt, const float* __restrict__ SU, const float* __restrict__ SV, int lane) {
    PV_COEFS()
    gar[lane] = cf0; gar[64 + lane] = cf1;
}
__device__ __forceinline__ void peer_v_slice(const int* __restrict__ exr, const float* __restrict__ cfr, const unsigned char* __restrict__ V8x, float* __restrict__ outs  , int lane) {
    const int e8 = lane >> 3, c = lane & 7;
    const __amdgpu_buffer_rsrc_t vrsrc = __builtin_amdgcn_make_buffer_rsrc((void*)V8x, 0, 16384 * 128, 0x00020000);
    v4u wa[8], wb[8]; float cfa[8], cfb[8];
    int ids[16];
#pragma unroll
    for (int j = 0; j < 4; ++j) { const v4u t = *(const v4u*)(exr + e8 * 16 + j * 4); ids[j * 4 + 0] = (int)t.x; ids[j * 4 + 1] = (int)t.y; ids[j * 4 + 2] = (int)t.z; ids[j * 4 + 3] = (int)t.w; }
#pragma unroll
    for (int g = 0; g < 8; ++g) wa[g] = __builtin_amdgcn_raw_buffer_load_b128(vrsrc, ids[g] * 128 + c * 16, 0, 0);
#pragma unroll
    for (int g = 0; g < 8; ++g) wb[g] = __builtin_amdgcn_raw_buffer_load_b128(vrsrc, ids[8 + g] * 128 + c * 16, 0, 0);
#pragma unroll
    for (int j = 0; j < 2; ++j) { const f32x4 t = *(const f32x4*)(cfr + e8 * 16 + j * 4), u = *(const f32x4*)(cfr + e8 * 16 + 8 + j * 4);
        cfa[j * 4 + 0] = t.x; cfa[j * 4 + 1] = t.y; cfa[j * 4 + 2] = t.z; cfa[j * 4 + 3] = t.w; cfb[j * 4 + 0] = u.x; cfb[j * 4 + 1] = u.y; cfb[j * 4 + 2] = u.z; cfb[j * 4 + 3] = u.w; }
    f32x2_t ap[8];
#pragma unroll
    for (int i = 0; i < 8; ++i) ap[i] = (f32x2_t){0.f, 0.f};
#define PVS_AXPY(w_, k_) do { ap[(k_) * 2] = __builtin_elementwise_fma(cf2_, __builtin_amdgcn_cvt_pk_f32_fp8((w_), false), ap[(k_) * 2]); ap[(k_) * 2 + 1] = __builtin_elementwise_fma(cf2_, __builtin_amdgcn_cvt_pk_f32_fp8((w_), true), ap[(k_) * 2 + 1]); } while (0)
#pragma unroll
    for (int g = 0; g < 8; ++g) { const f32x2_t cf2_ = (f32x2_t){cfa[g], cfa[g]}; PVS_AXPY(wa[g].x, 0); PVS_AXPY(wa[g].y, 1); PVS_AXPY(wa[g].z, 2); PVS_AXPY(wa[g].w, 3); }
#pragma unroll
    for (int g = 0; g < 8; ++g) { const f32x2_t cf2_ = (f32x2_t){cfb[g], cfb[g]}; PVS_AXPY(wb[g].x, 0); PVS_AXPY(wb[g].y, 1); PVS_AXPY(wb[g].z, 2); PVS_AXPY(wb[g].w, 3); }
#undef PVS_AXPY
    float acc[16];
#pragma unroll
    for (int i = 0; i < 8; ++i) { acc[2 * i] = ap[i].x; acc[2 * i + 1] = ap[i].y; }
#pragma unroll
    for (int i = 0; i < 16; ++i) { float v = acc[i]; v += DPPF(v, 0x128, 0xf); v += __shfl_xor(v, 16); v += __shfl_xor(v, 32); acc[i] = v; }
    if (e8 == 0) {
#pragma unroll
        for (int j = 0; j < 4; ++j) *(f32x4*)(outs + c * 16 + j * 4) = (f32x4){acc[j * 4 + 0], acc[j * 4 + 1], acc[j * 4 + 2], acc[j * 4 + 3]};
    }
}
__device__ __forceinline__ void peer_xc(const bf16* __restrict__ xrow, const float* __restrict__ srow, const float* __restrict__ g, const float* __restrict__ bta, float* __restrict__ orow, bf16* __restrict__ obrow, bf16* __restrict__ obrow2, int lane) {
    float v[16]; float s = 0.f;
#pragma unroll
    for (int j = 0; j < 4; ++j) { const v2u ab = *(const v2u*)(xrow + lane * 16 + j * 4); const f32x4 b = *(const f32x4*)(srow + lane * 16 + j * 4);
        v[j * 4 + 0] = ALPHA * bflo(ab.x) + b.x; v[j * 4 + 1] = ALPHA * bfhi(ab.x) + b.y; v[j * 4 + 2] = ALPHA * bflo(ab.y) + b.z; v[j * 4 + 3] = ALPHA * bfhi(ab.y) + b.w; }
#pragma unroll
    for (int i = 0; i < 16; ++i) s += v[i];
    const float mean = wave_sum(s) * (1.0f / 1024.0f); float q = 0.f;
#pragma unroll
    for (int i = 0; i < 16; ++i) { v[i] -= mean; q += v[i] * v[i]; }
    const float rs = rsqrtf(wave_sum(q) * (1.0f / 1024.0f) + LN_EPS);
    float o[16];
#pragma unroll
    for (int j = 0; j < 4; ++j) {
        const f32x4 g4 = *(const f32x4*)(g + lane * 16 + j * 4), b4 = *(const f32x4*)(bta + lane * 16 + j * 4);
        o[j * 4 + 0] = v[j * 4 + 0] * rs * g4.x + b4.x; o[j * 4 + 1] = v[j * 4 + 1] * rs * g4.y + b4.y; o[j * 4 + 2] = v[j * 4 + 2] * rs * g4.z + b4.z; o[j * 4 + 3] = v[j * 4 + 3] * rs * g4.w + b4.w;
        if (orow) *(f32x4*)(orow + lane * 16 + j * 4) = (f32x4){o[j * 4 + 0], o[j * 4 + 1], o[j * 4 + 2], o[j * 4 + 3]};
    }
    if (obrow) {
        v4u w0, w1; w0.x = pk2(o[0], o[1]); w0.y = pk2(o[2], o[3]); w0.z = pk2(o[4], o[5]); w0.w = pk2(o[6], o[7]); w1.x = pk2(o[8], o[9]); w1.y = pk2(o[10], o[11]); w1.z = pk2(o[12], o[13]); w1.w = pk2(o[14], o[15]);
        *(v4u*)(obrow + lane * 16) = w0; *(v4u*)(obrow + lane * 16 + 8) = w1;
        if (obrow2) { *(v4u*)(obrow2 + lane * 16) = w0; *(v4u*)(obrow2 + lane * 16 + 8) = w1; }
    }
}

__device__ __forceinline__ int t5_bucket(int n) {
    if (n < 16) return n;
    const int large = 16 + (int)(logf((float)n / 16.0f) / 2.0794415416798357f * 16.0f);
    return large < 31 ? large : 31;
}
__device__ __forceinline__ void swa_attn(const float* __restrict__ PC, const float* __restrict__ cache_k, const float* __restrict__ cache_v,
                                         const float* __restrict__ rel_bias, const float* __restrict__ sinks, bf16* __restrict__ ATT, int bx) {
    const int tid = threadIdx.x, lane = tid & 63, wid = tid >> 6;
    const int gw = bx * 8 + wid;
    const int t = gw >> 4, h = gw & 15, kvh = h >> 2;
    if (t >= NT) return;
    const bool samp = t >= NP; const int sb = t - NP, pos = t % SEQ;
    const float* qrow = PC + (size_t)t * CN + h * 64;
    float lg[2]; bool valid[2];
#pragma unroll
    for (int rr = 0; rr < 2; ++rr) {
        const int r = lane + 64 * rr;
        const float* krow;
        if (!samp) { valid[rr] = (pos - r) >= 0; krow = PC + (size_t)(valid[rr] ? t - r : t) * CN + 1024 + kvh * 64; }
        else { valid[rr] = true; krow = (r == 0) ? PC + (size_t)t * CN + 1024 + kvh * 64 : cache_k + (((size_t)sb * 128 + (128 - r)) * 4 + kvh) * 64; }
        float dot = 0.f;
#pragma unroll
        for (int d4 = 0; d4 < 16; ++d4) {
            const float4 kv = *(const float4*)(krow + d4 * 4);
            const float4 qv = *(const float4*)(qrow + d4 * 4);
            dot += qv.x * kv.x + qv.y * kv.y + qv.z * kv.z + qv.w * kv.w;
        }
        lg[rr] = valid[rr] ? dot * 0.125f + rel_bias[t5_bucket(r) * 16 + h] : -INFINITY;
    }
    const float sink = sinks[h];
    const float m = fmaxf(wave_max(fmaxf(lg[0], lg[1])), sink);
    float p[2];
#pragma unroll
    for (int rr = 0; rr < 2; ++rr) p[rr] = valid[rr] ? expf(lg[rr] - m) : 0.f;
    const float den = wave_sum(p[0] + p[1]) + expf(sink - m);
    const float inv = 1.0f / den;
    float o = 0.f;
#pragma unroll
    for (int rr = 0; rr < 2; ++rr)
        for (int l2 = 0; l2 < 64; ++l2) {
            const int r = l2 + 64 * rr;
            const float pj = __shfl(p[rr], l2);
            if (pj != 0.f) {
                const float* vrow;
                if (!samp) vrow = PC + (size_t)(t - r) * CN + 1280 + kvh * 64;
                else vrow = (r == 0) ? PC + (size_t)t * CN + 1280 + kvh * 64 : cache_v + (((size_t)sb * 128 + (128 - r)) * 4 + kvh) * 64;
                o += pj * vrow[lane];
            }
        }
    ATT[(size_t)t * D + h * 64 + lane] = (bf16)f2bf(o * inv);
}

__device__ __forceinline__ void swa_kv_out(const float* __restrict__ PC, const float* __restrict__ cache_k, const float* __restrict__ cache_v,
                                           float* __restrict__ pk, float* __restrict__ pv, float* __restrict__ sk, float* __restrict__ sv, int vb) {
    const int c = threadIdx.x & 255, row = vb * 2 + (threadIdx.x >> 8);
    if (row < NB * 128) {
        const int b = row >> 7, i = row & 127;
        const float* src = PC + (size_t)(b * SEQ + SEQ - 128 + i) * CN;
        pk[(size_t)row * 256 + c] = src[1024 + c];
        pv[(size_t)row * 256 + c] = src[1280 + c];
    } else {
        const int r2 = row - NB * 128, sb = r2 >> 7, i = r2 & 127;
        if (i < 127) {
            sk[(size_t)r2 * 256 + c] = cache_k[((size_t)sb * 128 + i + 1) * 256 + c];
            sv[(size_t)r2 * 256 + c] = cache_v[((size_t)sb * 128 + i + 1) * 256 + c];
        } else {
            const float* src = PC + (size_t)(NP + sb) * CN;
            sk[(size_t)r2 * 256 + c] = src[1024 + c];
            sv[(size_t)r2 * 256 + c] = src[1280 + c];
        }
    }
}
#define XB_TMO      128
#define XB_XCNT(j)  (256  + 64 * (j))
#define XB_XSUB(j)  (1280 + 64 * (j))
#define XB_XGEN(j)  (2304 + 64 * (j))
#define XB_TOP      3328
#define XB_TOPGEN   3392
#define XCD_BAR_WORDS 3456
#define XB_SPIN_CAP (1u << 18)

__device__ __forceinline__ unsigned xb_ld(unsigned* p)              { return __hip_atomic_load(p, __ATOMIC_RELAXED, __HIP_MEMORY_SCOPE_AGENT); }
__device__ __forceinline__ unsigned xb_add(unsigned* p, unsigned v) { return __hip_atomic_fetch_add(p, v, __ATOMIC_RELAXED, __HIP_MEMORY_SCOPE_AGENT); }
__device__ __forceinline__ unsigned xb_xcc_id() { return (unsigned)__builtin_amdgcn_s_getreg((3 << 11) | 20) & 0xFu; }
#define XB_SPIN(cond, bar) do { unsigned _sp = 0; while (cond) { __builtin_amdgcn_s_sleep(1); \
    if ((++_sp & 255u) == 0u) { if (xb_ld(&(bar)[XB_TMO])) break; if (_sp > XB_SPIN_CAP) { atomicAdd(&(bar)[XB_TMO], 1u); break; } } } } while (0)

struct XcdBarrier {
    unsigned* bar; unsigned x;
    volatile LAS unsigned* st;
};

__device__ __forceinline__ XcdBarrier xcd_barrier_post(unsigned* bar, volatile LAS unsigned* st) {
    XcdBarrier b; b.bar = bar; b.x = xb_xcc_id(); b.st = st;
    if (threadIdx.x == 0) (void)xb_add(&bar[XB_XCNT(b.x)], 1u);
    return b;
}
__device__ __forceinline__ void xcd_barrier_complete(unsigned* bar, unsigned x, unsigned& nloc, unsigned& nx) {
    const unsigned G = gridDim.x * gridDim.y * gridDim.z;
    unsigned sum, cnt, mine, sp = 0u;
    for (;;) {
        sum = 0u; cnt = 0u; mine = 0u;
#pragma unroll
        for (unsigned j = 0; j < 16; ++j) { const unsigned c = xb_ld(&bar[XB_XCNT(j)]); sum += c; cnt += (c > 0u) ? 1u : 0u; mine = (j == x) ? c : mine; }
        if (sum == G) break;
        __builtin_amdgcn_s_sleep(1);
        if ((++sp & 255u) == 0u) { if (xb_ld(&bar[XB_TMO])) break; if (sp > XB_SPIN_CAP) { atomicAdd(&bar[XB_TMO], 1u); break; } }
    }
    nloc = mine > 0u ? mine : 1u; nx = cnt > 0u ? cnt : 1u;
}

__device__ __forceinline__ void xcd_barrier(const XcdBarrier& b) {
    asm volatile("s_waitcnt vmcnt(0)" ::: "memory");
    __syncthreads();
    if (threadIdx.x == 0) {
        unsigned* bar = b.bar;
        __builtin_amdgcn_s_waitcnt(0);
        unsigned nloc = b.st[0], nx = b.st[1];
        if (nloc == 0u) { xcd_barrier_complete(bar, b.x, nloc, nx); b.st[0] = nloc; b.st[1] = nx; }
        const unsigned old = xb_add(&bar[XB_XSUB(b.x)], 1u);
        const unsigned gen = old / nloc;
        if (old + 1u == (gen + 1u) * nloc) {
            __builtin_amdgcn_fence(__ATOMIC_RELEASE, "agent");
            asm volatile("s_waitcnt vmcnt(0)" ::: "memory");
            const unsigned og = xb_add(&bar[XB_TOP], 1u);
            const unsigned tg = og / nx;
            if (og + 1u == (tg + 1u) * nx) xb_add(&bar[XB_TOPGEN], 1u);
            else XB_SPIN(xb_ld(&bar[XB_TOPGEN]) == tg, bar);
            __builtin_amdgcn_fence(__ATOMIC_ACQUIRE, "agent");
            xb_add(&bar[XB_XGEN(b.x)], 1u);
            asm volatile("s_waitcnt vmcnt(0)" ::: "memory");
        } else {
            XB_SPIN(xb_ld(&bar[XB_XGEN(b.x)]) == gen, bar);
            __builtin_amdgcn_fence(__ATOMIC_ACQUIRE, "agent");
            asm volatile("s_waitcnt vmcnt(0)" ::: "memory");
        }
    }
    __syncthreads();
}

typedef short bf16x8_t __attribute__((ext_vector_type(8)));
__device__ __forceinline__ f32x4 mfma16(bf16x8_t a, bf16x8_t b, f32x4 c) { return __builtin_amdgcn_mfma_f32_16x16x32_bf16(a, b, c, 0, 0, 0); }

struct GdnChunkBufs {
    bf16* W;
    bf16* QG;
    bf16* KDT;
    bf16* UT;
    bf16* QK;
    float* EGL;
};

constexpr int GP_QB = 0, GP_KB = 17408, GP_VB = 34816, GP_LS = 52224, GP_QKS = 69632, GP_WS = 78848, GP_SC = 96256;

__device__ __forceinline__ void gdn_prep_unit(const bf16* __restrict__ PROJ, const float* __restrict__ conv_w, const float* __restrict__ a_log, const float* __restrict__ dt_bias,
                                              const GdnChunkBufs& cb, float* __restrict__ p_gdn_conv, int un, unsigned char* lds) {
    int tid = threadIdx.x; asm volatile("" : "+v"(tid));
    const int lane = tid & 63, wave = __builtin_amdgcn_readfirstlane(tid >> 6), fr = lane & 15, fq = lane >> 4;
    const int h = un & 3, n = (un >> 2) & 63, b = un >> 8;
    const int t0 = b * SEQ + n * 64;
    bf16* Qb = (bf16*)(lds + GP_QB); bf16* Kb = (bf16*)(lds + GP_KB); bf16* Vb = (bf16*)(lds + GP_VB); bf16* Ws = (bf16*)(lds + GP_WS);
    float* Ls = (float*)(lds + GP_LS); bf16* QKs = (bf16*)(lds + GP_QKS);
    float* gcs = (float*)(lds + GP_SC); float* bets = gcs + 64; float* egcs = gcs + 128; float* ekds = gcs + 192; float* begs = gcs + 256;
    if (wave == 0) {
        const bf16* prow = PROJ + (size_t)(t0 + lane) * ABN;
        const float a_raw = bf2f(prow[C_A + h]), b_raw = bf2f(prow[C_B + h]);
        float g = -expf(a_log[h]) * softplusf_(a_raw + dt_bias[h]);
#pragma unroll
        for (int off = 1; off < 64; off <<= 1) { const float v = __shfl_up(g, off); if (lane >= off) g += v; }
        const float glast = __shfl(g, 63);
        { const float be_ = sigmoidf_(b_raw), eg_ = expf(g); gcs[lane] = g; bets[lane] = be_; egcs[lane] = eg_; ekds[lane] = expf(glast - g); begs[lane] = be_ * eg_; }
        if (lane == 0) cb.EGL[un] = expf(glast);
    }
    {
        int cols[6]; float cw[4][6], xw[3][6];
#pragma unroll
        for (int p = 0; p < 3; ++p)
#pragma unroll
            for (int e = 0; e < 2; ++e) cols[p * 2 + e] = p * 512 + h * 128 + e * 64 + lane;
#pragma unroll
        for (int i = 0; i < 4; ++i)
#pragma unroll
            for (int c = 0; c < 6; ++c) cw[i][c] = conv_w[i * 1536 + cols[c]];
        const int i0 = wave * 8;
#pragma unroll
        for (int k = 0; k < 3; ++k) {
            const int pos = n * 64 + i0 - 3 + k;
#pragma unroll
            for (int c = 0; c < 6; ++c) xw[k][c] = pos >= 0 ? bf2f(PROJ[(size_t)(t0 + i0 - 3 + k) * ABN + cols[c]]) : 0.f;
        }
        bf16 xraw[8][6];
#pragma unroll
        for (int ii = 0; ii < 8; ++ii)
#pragma unroll
            for (int c = 0; c < 6; ++c) xraw[ii][c] = PROJ[(size_t)(t0 + i0 + ii) * ABN + cols[c]];
#pragma unroll
        for (int ii = 0; ii < 8; ++ii) {
            const int i = i0 + ii;
            float xt[6], s[6];
#pragma unroll
            for (int c = 0; c < 6; ++c) xt[c] = bf2f(xraw[ii][c]);
#pragma unroll
            for (int c = 0; c < 6; ++c) { const float y_ = cw[0][c] * xw[0][c] + cw[1][c] * xw[1][c] + cw[2][c] * xw[2][c] + cw[3][c] * xt[c]; s[c] = y_ * __frcp_rn(1.0f + __expf(-y_)); }
            const float qs = rsqrtf(wave_sum(s[0] * s[0] + s[1] * s[1]) + 1e-6f) * 0.08838834764831845f;
            const float ks = rsqrtf(wave_sum(s[2] * s[2] + s[3] * s[3]) + 1e-6f);
            Qb[i * 136 + lane] = (bf16)f2bf(s[0] * qs); Qb[i * 136 + 64 + lane] = (bf16)f2bf(s[1] * qs);
            Kb[i * 136 + lane] = (bf16)f2bf(s[2] * ks); Kb[i * 136 + 64 + lane] = (bf16)f2bf(s[3] * ks);
            Vb[i * 136 + lane] = (bf16)f2bf(s[4]);      Vb[i * 136 + 64 + lane] = (bf16)f2bf(s[5]);
            if (n == 63 && i >= 61) {
#pragma unroll
                for (int c = 0; c < 6; ++c) p_gdn_conv[((size_t)b * 3 + (i - 61)) * 1536 + cols[c]] = xt[c];
            }
#pragma unroll
            for (int c = 0; c < 6; ++c) { xw[0][c] = xw[1][c]; xw[1][c] = xw[2][c]; xw[2][c] = xt[c]; }
        }
    }
    __syncthreads();
    {
        const int mi = wave >> 1;
        bf16x8_t aK[4], aQ[4];
#pragma unroll
        for (int ks = 0; ks < 4; ++ks) { aK[ks] = *(const bf16x8_t*)(Kb + (mi * 16 + fr) * 136 + ks * 32 + 8 * fq); aQ[ks] = *(const bf16x8_t*)(Qb + (mi * 16 + fr) * 136 + ks * 32 + 8 * fq); }
#pragma unroll
        for (int nn = 0; nn < 2; ++nn) {
            const int nj = (wave & 1) * 2 + nn;
            f32x4 accK = (f32x4){0.f, 0.f, 0.f, 0.f}, accQ = accK;
#pragma unroll
            for (int ks = 0; ks < 4; ++ks) { const bf16x8_t bk = *(const bf16x8_t*)(Kb + (nj * 16 + fr) * 136 + ks * 32 + 8 * fq); accK = mfma16(aK[ks], bk, accK); accQ = mfma16(aQ[ks], bk, accQ); }
            const int j = nj * 16 + fr; const float gj = gcs[j];
#pragma unroll
            for (int r = 0; r < 4; ++r) {
                const int i = mi * 16 + 4 * fq + r;
                const float dec = i >= j ? expf(gcs[i] - gj) : 0.f;
                Ls[j * 68 + i] = i > j ? bets[i] * accK[r] * dec : 0.f;
                QKs[i * 72 + j] = (bf16)f2bf(i >= j ? accQ[r] * dec : 0.f);
            }
        }
    }
    __syncthreads();
    if (wave < 4) {
        float x[64];
        const bool isu = tid < 128; const int c = isu ? tid : tid - 128;
        const LAS unsigned char* l3 = (const LAS unsigned char*)lds;
        unsigned so = (isu ? GP_VB : GP_KB) + c * 2, ro = GP_SC + (isu ? 64 * 4 : 256 * 4), lo = GP_LS;
        asm volatile("" : "+v"(so), "+v"(ro), "+v"(lo));
#pragma unroll
        for (int i = 0; i < 64; ++i) x[i] = *(const LAS float*)(l3 + ro + 4 * i) * bf2f(*(const LAS bf16*)(l3 + so + i * 272));
#pragma unroll
        for (int j = 0; j < 63; ++j) {
#pragma unroll
            for (int i4 = (j + 1) / 4; i4 < 16; ++i4) {
                const f32x4 l4 = *(const LAS f32x4*)(l3 + lo + j * 272 + i4 * 16);
                if (i4 * 4 + 0 > j) x[i4 * 4 + 0] -= l4.x * x[j];
                if (i4 * 4 + 1 > j) x[i4 * 4 + 1] -= l4.y * x[j];
                if (i4 * 4 + 2 > j) x[i4 * 4 + 2] -= l4.z * x[j];
                if (i4 * 4 + 3 > j) x[i4 * 4 + 3] -= l4.w * x[j];
            }
        }
        if (isu) {
            bf16* dst = cb.UT + ((size_t)un * 128 + c) * 64;
#pragma unroll
            for (int i8 = 0; i8 < 8; ++i8) { v4u o; o.x = pk2(x[i8 * 8 + 0], x[i8 * 8 + 1]); o.y = pk2(x[i8 * 8 + 2], x[i8 * 8 + 3]); o.z = pk2(x[i8 * 8 + 4], x[i8 * 8 + 5]); o.w = pk2(x[i8 * 8 + 6], x[i8 * 8 + 7]); *(v4u*)(dst + i8 * 8) = o; }
        } else {
#pragma unroll
            for (int i = 0; i < 64; ++i) Ws[i * 136 + c] = (bf16)f2bf(x[i]);
        }
    } else {
        const int t2 = tid - 256;
#pragma unroll
        for (int k = 0; k < 4; ++k) {
            const int ci = t2 + 256 * k, i = ci >> 4, d0 = (ci & 15) * 8; const float e = egcs[i];
            const v4u q = *(const v4u*)(Qb + i * 136 + d0);
            v4u o; o.x = pk2(bflo(q.x) * e, bfhi(q.x) * e); o.y = pk2(bflo(q.y) * e, bfhi(q.y) * e); o.z = pk2(bflo(q.z) * e, bfhi(q.z) * e); o.w = pk2(bflo(q.w) * e, bfhi(q.w) * e);
            *(v4u*)(cb.QG + ((size_t)un * 64 + i) * 128 + d0) = o;
        }
#pragma unroll
        for (int k = 0; k < 4; ++k) {
            const int ci = t2 + 256 * k, d = ci & 127, i0 = (ci >> 7) * 8;
            float v[8];
#pragma unroll
            for (int q = 0; q < 8; ++q) v[q] = bf2f(Kb[(i0 + q) * 136 + d]) * ekds[i0 + q];
            v4u o; o.x = pk2(v[0], v[1]); o.y = pk2(v[2], v[3]); o.z = pk2(v[4], v[5]); o.w = pk2(v[6], v[7]);
            *(v4u*)(cb.KDT + ((size_t)un * 128 + d) * 64 + i0) = o;
        }
#pragma unroll
        for (int k = 0; k < 2; ++k) {
            const int ci = t2 + 256 * k, i = ci >> 3, j0 = (ci & 7) * 8;
            *(v4u*)(cb.QK + ((size_t)un * 64 + i) * 64 + j0) = *(const v4u*)(QKs + i * 72 + j0);
        }
    }
    __syncthreads();
#pragma unroll
    for (int k = 0; k < 2; ++k) {
        const int ci = tid + 512 * k, i = ci >> 4, d0 = (ci & 15) * 8;
        *(v4u*)(cb.W + ((size_t)un * 64 + i) * 128 + d0) = *(const v4u*)(Ws + i * 136 + d0);
    }
    __syncthreads();
}

constexpr int GS_ST = 0, GS_VNT = 2 * 32 * 136 * 2, GS_END = GS_VNT + 32 * 72 * 2;
template <int N0, int N1>
__device__ __forceinline__ void gdn_seq(const GdnChunkBufs& cb, float* __restrict__ O, float* __restrict__ Sout, int b, int h, int sl, unsigned char* lds, f32x4 (&accS)[2], int& cur) {
    int tid = threadIdx.x; asm volatile("" : "+v"(tid));
    const int lane = tid & 63, wave = __builtin_amdgcn_readfirstlane(tid >> 6), fr = lane & 15, fq = lane >> 4;
    const int mi = wave >> 1, nj = wave & 1;
    bf16* St = (bf16*)(lds + GS_ST); bf16* VnT = (bf16*)(lds + GS_VNT);
    float* egls = (float*)(lds + GS_END);
    if (N0 == 0) {
        for (int i = tid; i < 2 * 32 * 136 / 2; i += NTH) ((unsigned*)St)[i] = 0u;
        accS[0] = (f32x4){0.f, 0.f, 0.f, 0.f}; accS[1] = accS[0]; cur = 0;
    }
    if (tid >= N0 && tid < N1) egls[tid] = cb.EGL[(size_t)((b * 64 + tid) * 4 + h)];
    __syncthreads();
#define GS_DECL(X) bf16x8_t aW##X[4], aQG##X[4], aQK##X[2], aKD##X[2]; v2u ut##X;
    GS_DECL(0) GS_DECL(1) GS_DECL(2)
#define GS_GLD16(dst, ptr) asm volatile("global_load_dwordx4 %0, %1, off" : "=v"(dst) : "v"(ptr))
#define GS_GLD8(dst, ptr) asm volatile("global_load_dwordx2 %0, %1, off" : "=v"(dst) : "v"(ptr))
#define GS_LOAD(X, n_) do { const size_t u_ = (size_t)((b * 64 + ((n_) < 63 ? (n_) : 63)) * 4 + h);     \
        _Pragma("unroll") for (int ks = 0; ks < 4; ++ks) { GS_GLD16(aW##X[ks], cb.W + (u_ * 64 + mi * 16 + fr) * 128 + ks * 32 + 8 * fq); GS_GLD16(aQG##X[ks], cb.QG + (u_ * 64 + mi * 16 + fr) * 128 + ks * 32 + 8 * fq); } \
        _Pragma("unroll") for (int ks = 0; ks < 2; ++ks) { GS_GLD16(aQK##X[ks], cb.QK + (u_ * 64 + mi * 16 + fr) * 64 + ks * 32 + 8 * fq); GS_GLD16(aKD##X[ks], cb.KDT + (u_ * 128 + wave * 16 + fr) * 64 + ks * 32 + 8 * fq); } \
        GS_GLD8(ut##X, cb.UT + (u_ * 128 + sl * 32 + nj * 16 + fr) * 64 + mi * 16 + 4 * fq); } while (0)
#define GS_WAITN(X, N) asm volatile("s_waitcnt vmcnt(" #N ")" : "+v"(aW##X[0]), "+v"(aW##X[1]), "+v"(aW##X[2]), "+v"(aW##X[3]), "+v"(aQG##X[0]), "+v"(aQG##X[1]), "+v"(aQG##X[2]), "+v"(aQG##X[3]), \
        "+v"(aQK##X[0]), "+v"(aQK##X[1]), "+v"(aKD##X[0]), "+v"(aKD##X[1]), "+v"(ut##X))
#define GS_WAIT(X, n_) GS_WAITN(X, 26)
#define GS_STEP(X, n_) do { \
        const float egl##X = egls[(n_)]; \
        GS_WAIT(X, n_); \
        __syncthreads();                                        \
        f32x4 accW = (f32x4){0.f, 0.f, 0.f, 0.f}, accO = accW; \
        const bf16* Sc = St + cur * 32 * 136; \
        _Pragma("unroll") for (int ks = 0; ks < 4; ++ks) { const bf16x8_t bs = *(const bf16x8_t*)(Sc + (nj * 16 + fr) * 136 + ks * 32 + 8 * fq); accW = mfma16(aW##X[ks], bs, accW); accO = mfma16(aQG##X[ks], bs, accO); } \
          \
        const float v0 = bflo(ut##X.x) - accW[0], v1 = bfhi(ut##X.x) - accW[1], v2 = bflo(ut##X.y) - accW[2], v3 = bfhi(ut##X.y) - accW[3]; \
        { v2u o; o.x = pk2(v0, v1); o.y = pk2(v2, v3); *(v2u*)(VnT + (nj * 16 + fr) * 72 + mi * 16 + 4 * fq) = o; } \
        __syncthreads();                                        \
        _Pragma("unroll") for (int ks = 0; ks < 2; ++ks) { const bf16x8_t bv = *(const bf16x8_t*)(VnT + (nj * 16 + fr) * 72 + ks * 32 + 8 * fq); accO = mfma16(aQK##X[ks], bv, accO); } \
        { float* orow = O + (size_t)(b * SEQ + (n_) * 64 + mi * 16 + 4 * fq) * 512 + h * 128 + sl * 32 + nj * 16 + fr; \
          orow[0] = accO[0]; orow[512] = accO[1]; orow[1024] = accO[2]; orow[1536] = accO[3]; } \
          \
        bf16* Sn = St + (cur ^ 1) * 32 * 136; \
        _Pragma("unroll") for (int njj = 0; njj < 2; ++njj) { \
            accS[njj] = accS[njj] * egl##X; \
            _Pragma("unroll") for (int ks = 0; ks < 2; ++ks) { const bf16x8_t bv = *(const bf16x8_t*)(VnT + (njj * 16 + fr) * 72 + ks * 32 + 8 * fq); accS[njj] = mfma16(aKD##X[ks], bv, accS[njj]); } \
            v2u o; o.x = pk2(accS[njj][0], accS[njj][1]); o.y = pk2(accS[njj][2], accS[njj][3]); \
            *(v2u*)(Sn + (njj * 16 + fr) * 136 + wave * 16 + 4 * fq) = o; } \
        cur ^= 1; } while (0)
    constexpr int NTRI = (N1 - N0) / 3, NREM = (N1 - N0) % 3, NM = N0 + 3 * NTRI;
    GS_LOAD(0, N0); GS_LOAD(1, N0 + 1);
#pragma unroll 1
    for (int n = N0; n < NM; n += 3) {
        GS_LOAD(2, n + 2);
        GS_STEP(0, n);
        GS_LOAD(0, n + 3);
        GS_STEP(1, n + 1);
        GS_LOAD(1, n + 4);
        GS_STEP(2, n + 2);
    }
    if (NREM >= 1) { GS_LOAD(2, NM + 2); GS_STEP(0, NM); }
    if (NREM == 2) { GS_LOAD(0, NM + 3); GS_STEP(1, NM + 1); }
    GS_WAITN(0, 0); GS_WAITN(1, 0); GS_WAITN(2, 0);
#undef GS_STEP
#undef GS_DECL
#undef GS_WAIT
#undef GS_WAITN
#undef GS_GLD16
#undef GS_GLD8
    asm volatile("s_waitcnt vmcnt(0)" ::: "memory");
#undef GS_LOAD
    if (N1 == 64) {
#pragma unroll
        for (int njj = 0; njj < 2; ++njj)
#pragma unroll
            for (int r = 0; r < 4; ++r) Sout[(((size_t)b * 4 + h) * 128 + wave * 16 + 4 * fq + r) * 128 + sl * 32 + njj * 16 + fr] = accS[njj][r];
    }
    __syncthreads();
}

__device__ __forceinline__ void lru_prep_unit(const bf16* __restrict__ PROJ, const float* __restrict__ conv_w, const float* __restrict__ conv_b,
                                              const float* __restrict__ w_r, const float* __restrict__ b_r, const float* __restrict__ w_i, const float* __restrict__ b_i, const float* __restrict__ lam,
                                              float* __restrict__ H, float* __restrict__ P, float* __restrict__ Hend, float* __restrict__ Pend, float* __restrict__ p_lru_conv, int ub) {
    int c = threadIdx.x; asm volatile("" : "+v"(c));
    const int nblk = c >> 6, d = c & 63;
    const int n = ub & 63, b = ub >> 6, t0 = b * SEQ + n * 64;
    float wr[64], wi[64];
#pragma unroll
    for (int cc = 0; cc < 64; ++cc) { wr[cc] = w_r[((size_t)nblk * 64 + cc) * 64 + d]; wi[cc] = w_i[((size_t)nblk * 64 + cc) * 64 + d]; }
    const float cw0 = conv_w[c], cw1 = conv_w[512 + c], cw2 = conv_w[1024 + c], cw3 = conv_w[1536 + c], cb_ = conv_b[c];
    const float br = b_r[c], bi = b_i[c], spl = -8.0f * softplusf_(-lam[c]);
    float x0 = (n * 64 - 3 >= 0) ? bf2f(PROJ[(size_t)(t0 - 3) * ABN + C_XR + c]) : 0.f;
    float x1 = (n * 64 - 2 >= 0) ? bf2f(PROJ[(size_t)(t0 - 2) * ABN + C_XR + c]) : 0.f;
    float x2 = (n * 64 - 1 >= 0) ? bf2f(PROJ[(size_t)(t0 - 1) * ABN + C_XR + c]) : 0.f;
    float hloc = 0.f, ploc = 1.f;
    bf16 xa[16], xb[16];
#pragma unroll
    for (int k = 0; k < 16; ++k) xa[k] = PROJ[(size_t)(t0 + k) * ABN + C_XR + c];
#pragma unroll 1
    for (int ib = 0; ib < 64; ib += 16) {
      if (ib + 16 < 64) {
#pragma unroll
        for (int k = 0; k < 16; ++k) xb[k] = PROJ[(size_t)(t0 + ib + 16 + k) * ABN + C_XR + c];
      }
#pragma unroll
      for (int k = 0; k < 16; ++k) {
        const int i = ib + k;
        const float xt = bf2f(xa[k]);
        const float xr = cb_ + cw0 * x0 + cw1 * x1 + cw2 * x2 + cw3 * xt;
        f32x2_t ga = (f32x2_t){br, bi}, gb = (f32x2_t){0.f, 0.f};
#pragma unroll
        for (int cc = 0; cc < 64; cc += 2) {
            const float xa_ = __uint_as_float(__builtin_amdgcn_readlane(__float_as_uint(xr), cc)), xb_ = __uint_as_float(__builtin_amdgcn_readlane(__float_as_uint(xr), cc + 1));
            ga += (f32x2_t){xa_, xa_} * (f32x2_t){wr[cc], wi[cc]}; gb += (f32x2_t){xb_, xb_} * (f32x2_t){wr[cc + 1], wi[cc + 1]};
        }
        ga += gb;
        const float r = __frcp_rn(1.0f + __expf(-ga.x)), ii = __frcp_rn(1.0f + __expf(-ga.y));
        const float a = __expf(spl * r), bb = __fsqrt_rn(fmaxf(1.0f - a * a, 0.f)) * (ii * xr);
        hloc = a * hloc + bb; ploc *= a;
        H[(size_t)(t0 + i) * 512 + c] = hloc; P[(size_t)(t0 + i) * 512 + c] = ploc;
        if (n == 63 && i >= 61) p_lru_conv[((size_t)b * 3 + (i - 61)) * 512 + c] = xt;
        x0 = x1; x1 = x2; x2 = xt;
      }
#pragma unroll
      for (int k = 0; k < 16; ++k) xa[k] = xb[k];
    }
    Hend[(size_t)ub * 512 + c] = hloc; Pend[(size_t)ub * 512 + c] = ploc;
}
constexpr int LR_XR = 64 * 68 * 4;
__device__ __forceinline__ void lru_prep_unit2(const bf16* __restrict__ PROJ, const float* __restrict__ conv_w, const float* __restrict__ conv_b,
                                               const bf16* __restrict__ WRT, const bf16* __restrict__ WIT  , const float* __restrict__ b_r, const float* __restrict__ b_i, const float* __restrict__ lam,
                                               float* __restrict__ H, float* __restrict__ P, float* __restrict__ Hend, float* __restrict__ Pend, float* __restrict__ p_lru_conv, int ub, unsigned char* lds) {
    int tid = threadIdx.x; asm volatile("" : "+v"(tid));
    const int lane = tid & 63, wave = __builtin_amdgcn_readfirstlane(tid >> 6), fr = lane & 15, fq = lane >> 4;
    const int n = ub & 63, b = ub >> 6, t0 = b * SEQ + n * 64;
    float* XR = (float*)(lds + wave * LR_XR);
    {
        const int c = wave * 64 + lane;
        const float cw0 = conv_w[c], cw1 = conv_w[512 + c], cw2 = conv_w[1024 + c], cw3 = conv_w[1536 + c], cb_ = conv_b[c];
        float x0 = (n * 64 - 3 >= 0) ? bf2f(PROJ[(size_t)(t0 - 3) * ABN + C_XR + c]) : 0.f;
        float x1 = (n * 64 - 2 >= 0) ? bf2f(PROJ[(size_t)(t0 - 2) * ABN + C_XR + c]) : 0.f;
        float x2 = (n * 64 - 1 >= 0) ? bf2f(PROJ[(size_t)(t0 - 1) * ABN + C_XR + c]) : 0.f;
#pragma unroll 1
        for (int ib = 0; ib < 64; ib += 16) {
            bf16 xa[16];
#pragma unroll
            for (int k = 0; k < 16; ++k) xa[k] = PROJ[(size_t)(t0 + ib + k) * ABN + C_XR + c];
#pragma unroll
            for (int k = 0; k < 16; ++k) {
                const int i = ib + k; const float xt = bf2f(xa[k]);
                XR[i * 68 + lane] = cb_ + cw0 * x0 + cw1 * x1 + cw2 * x2 + cw3 * xt;
                if (n == 63 && i >= 61) p_lru_conv[((size_t)b * 3 + (i - 61)) * 512 + c] = xt;
                x0 = x1; x1 = x2; x2 = xt;
            }
        }
    }
    asm volatile("s_waitcnt lgkmcnt(0)" ::: "memory");
    bf16x8_t bR[4][2], bI[4][2];
#pragma unroll
    for (int nt = 0; nt < 4; ++nt)
#pragma unroll
        for (int ks = 0; ks < 2; ++ks) {
            bR[nt][ks] = *(const bf16x8_t*)(WRT + ((size_t)wave * 64 + nt * 16 + fr) * 64 + ks * 32 + 8 * fq);
            bI[nt][ks] = *(const bf16x8_t*)(WIT + ((size_t)wave * 64 + nt * 16 + fr) * 64 + ks * 32 + 8 * fq);
        }
    float brv[4], biv[4], splv[4];
#pragma unroll
    for (int nt = 0; nt < 4; ++nt) { const int c = wave * 64 + nt * 16 + fr; brv[nt] = b_r[c]; biv[nt] = b_i[c]; splv[nt] = -8.0f * softplusf_(-lam[c]); }
    float hin[4], pin[4];
#pragma unroll
    for (int nt = 0; nt < 4; ++nt) { hin[nt] = 0.f; pin[nt] = 1.f; }
#pragma unroll 1
    for (int mt = 0; mt < 4; ++mt) {
        bf16x8_t aX[2];
#pragma unroll
        for (int ks = 0; ks < 2; ++ks) {
            const f32x4 lo = *(const f32x4*)(XR + (mt * 16 + fr) * 68 + ks * 32 + 8 * fq), hi = *(const f32x4*)(XR + (mt * 16 + fr) * 68 + ks * 32 + 8 * fq + 4);
            v4u w; w.x = pk2(lo.x, lo.y); w.y = pk2(lo.z, lo.w); w.z = pk2(hi.x, hi.y); w.w = pk2(hi.z, hi.w);
            aX[ks] = __builtin_bit_cast(bf16x8_t, w);
        }
#pragma unroll
        for (int nt = 0; nt < 4; ++nt) {
            f32x4 aR = (f32x4){0.f, 0.f, 0.f, 0.f}, aI = aR;
            aR = mfma16(aX[0], bR[nt][0], aR); aR = mfma16(aX[1], bR[nt][1], aR);
            aI = mfma16(aX[0], bI[nt][0], aI); aI = mfma16(aX[1], bI[nt][1], aI);
            float av[4], bv[4];
#pragma unroll
            for (int r = 0; r < 4; ++r) {
                const float rg = __frcp_rn(1.0f + __expf(-(aR[r] + brv[nt]))), ig = __frcp_rn(1.0f + __expf(-(aI[r] + biv[nt])));
                const float a = __expf(splv[nt] * rg);
                av[r] = a; bv[r] = __fsqrt_rn(fmaxf(1.0f - a * a, 0.f)) * (ig * XR[(mt * 16 + 4 * fq + r) * 68 + nt * 16 + fr]);
            }
            float PA[4], PB[4];
            PA[0] = av[0]; PB[0] = bv[0];
#pragma unroll
            for (int r = 1; r < 4; ++r) { PA[r] = av[r] * PA[r - 1]; PB[r] = av[r] * PB[r - 1] + bv[r]; }
            float GA = PA[3], GB = PB[3];
            { const float pa = __shfl_up(GA, 16), pb = __shfl_up(GB, 16); if (fq >= 1) { GB = GA * pb + GB; GA = GA * pa; } }
            { const float pa = __shfl_up(GA, 32), pb = __shfl_up(GB, 32); if (fq >= 2) { GB = GA * pb + GB; GA = GA * pa; } }
            float EA = __shfl_up(GA, 16), EB = __shfl_up(GB, 16);
            if (fq == 0) { EA = 1.f; EB = 0.f; }
            const float h0 = EA * hin[nt] + EB, p0 = pin[nt] * EA;
#pragma unroll
            for (int r = 0; r < 4; ++r) {
                const size_t o = (size_t)(t0 + mt * 16 + 4 * fq + r) * 512 + wave * 64 + nt * 16 + fr;
                H[o] = PA[r] * h0 + PB[r]; P[o] = p0 * PA[r];
            }
            const float TA = __shfl(GA, 48 + fr), TB = __shfl(GB, 48 + fr);
            hin[nt] = TA * hin[nt] + TB; pin[nt] = pin[nt] * TA;
        }
    }
    if (fq == 0) {
#pragma unroll
        for (int nt = 0; nt < 4; ++nt) { Hend[(size_t)ub * 512 + wave * 64 + nt * 16 + fr] = hin[nt]; Pend[(size_t)ub * 512 + wave * 64 + nt * 16 + fr] = pin[nt]; }
    }
    asm volatile("s_waitcnt lgkmcnt(0)" ::: "memory");
}
__device__ __forceinline__ void lru_carry(const float* __restrict__ Hend, const float* __restrict__ Pend, float* __restrict__ CIN, float* __restrict__ hlast, int bx) {
    int tx_ = threadIdx.x; asm volatile("" : "+v"(tx_));
    const int idx = bx * NTH + tx_, b = idx >> 9, c = idx & 511;
    float carry = 0.f;
#pragma unroll 8
    for (int n = 0; n < 64; ++n) {
        const size_t o = ((size_t)b * 64 + n) * 512 + c;
        CIN[o] = carry;
        carry = Hend[o] + Pend[o] * carry;
    }
    hlast[(size_t)b * 512 + c] = carry;
}

__device__ __forceinline__ unsigned f2key(float f) { const unsigned u = __float_as_uint(f); return u ^ ((u >> 31) ? 0xffffffffu : 0x80000000u); }
__device__ __forceinline__ float key2f(unsigned k) { return __uint_as_float(k ^ ((k >> 31) ? 0x80000000u : 0xffffffffu)); }
#define TK_CE(hi, lo) do { const unsigned a_ = (hi), b_ = (lo); (hi) = a_ > b_ ? a_ : b_; (lo) = a_ > b_ ? b_ : a_; } while (0)
template <int N> __device__ __forceinline__ void bitonic_sort_desc(unsigned (&a)[N]) {
#pragma unroll
    for (int k = 2; k <= N; k <<= 1)
#pragma unroll
        for (int j = k >> 1; j > 0; j >>= 1)
#pragma unroll
            for (int i = 0; i < N; ++i) { const int l = i ^ j; if (l > i) { if ((i & k) == 0) TK_CE(a[i], a[l]); else TK_CE(a[l], a[i]); } }
}
template <int XM> __device__ __forceinline__ void merge_top16(unsigned (&a)[16]) {
    unsigned c[16];
#pragma unroll
    for (int i = 0; i < 16; ++i) { const unsigned o = (unsigned)__shfl_xor((int)a[15 - i], XM); c[i] = a[i] > o ? a[i] : o; }
#pragma unroll
    for (int j = 8; j > 0; j >>= 1)
#pragma unroll
        for (int i = 0; i < 16; ++i) { const int l = i ^ j; if (l > i) TK_CE(c[i], c[l]); }
#pragma unroll
    for (int i = 0; i < 16; ++i) a[i] = c[i];
}
constexpr int TK_KS = 0, TK_TS = 2 * 128 * 136 * 2, TK_END = TK_TS + 64 * 2 * 16 * 4;
__device__ __forceinline__ void peer_topk_stage_keys(const bf16* __restrict__ KB, int h, unsigned char* lds) {
    bf16* Ks = (bf16*)(lds + TK_KS);
    for (int ci = threadIdx.x; ci < 2 * 128 * 16; ci += NTH) { const int row = ci >> 4, part = ci & 15;
        *(v4u*)(Ks + row * 136 + part * 8) = *(const v4u*)(KB + ((size_t)h * 256 + row) * 128 + part * 8); }
    __syncthreads();
}
__device__ __forceinline__ void peer_topk4(const bf16* __restrict__ Q, int* __restrict__ EXP, float* __restrict__ GATE, int tile, int h, unsigned char* lds) {
    int tid = threadIdx.x; asm volatile("" : "+v"(tid));
    const int lane = tid & 63, wave = __builtin_amdgcn_readfirstlane(tid >> 6), fr = lane & 15, fq = lane >> 4;
    const bf16* Ks = (const bf16*)(lds + TK_KS); unsigned* Ts = (unsigned*)(lds + TK_TS);
    {
        const int c = wave >> 2, nt = wave & 3;
        bf16x8_t bq[4];
#pragma unroll
        for (int ks = 0; ks < 4; ++ks) bq[ks] = *(const bf16x8_t*)(Q + (size_t)(tile * 64 + nt * 16 + fr) * 2048 + h * 256 + c * 128 + ks * 32 + 8 * fq);
        unsigned a[32];
#pragma unroll
        for (int mt = 0; mt < 8; ++mt) {
            f32x4 acc = (f32x4){0.f, 0.f, 0.f, 0.f};
#pragma unroll
            for (int ks = 0; ks < 4; ++ks) { const bf16x8_t ak = *(const bf16x8_t*)(Ks + (c * 128 + mt * 16 + fr) * 136 + ks * 32 + 8 * fq); acc = mfma16(ak, bq[ks], acc); }
#pragma unroll
            for (int r = 0; r < 4; ++r) a[mt * 4 + r] = (f2key(acc[r]) & ~127u) | (unsigned)(127 - (mt * 16 + 4 * fq + r));
        }
        bitonic_sort_desc<32>(a);
        unsigned t[16];
#pragma unroll
        for (int j = 0; j < 16; ++j) t[j] = a[j];
        merge_top16<16>(t); merge_top16<32>(t);
        if (fq == 0) {
            const int tk = nt * 16 + fr;
#pragma unroll
            for (int j = 0; j < 16; ++j) Ts[(tk * 2 + c) * 16 + j] = t[j];
        }
    }
    __syncthreads();
    if (tid < 256) {
        const int tk = tid >> 2, q = tid & 3;
        const unsigned* t0 = Ts + (tk * 2 + 0) * 16; const unsigned* t1 = Ts + (tk * 2 + 1) * 16;
        unsigned a[16];
#pragma unroll
        for (int s = 0; s < 13; ++s) {
            const int e = s * 4 + q;
            int i, j;
            if (e < 16) { i = 0; j = e; } else if (e < 24) { i = 1; j = e - 16; } else if (e < 29) { i = 2; j = e - 24; } else if (e < 33) { i = 3; j = e - 29; }
            else if (e < 36) { i = 4; j = e - 33; } else if (e < 42) { i = 5 + ((e - 36) >> 1); j = (e - 36) & 1; } else { i = 8 + (e - 42); j = 0; }
            const bool ok = e < 50;
            const float sum = key2f(t0[ok ? i : 0] & ~127u) + key2f(t1[ok ? j : 0] & ~127u);
            a[s] = ok ? ((f2key(sum) & ~255u) | (unsigned)(255 - (i * 16 + j))) : 0u;
        }
        a[13] = 0u; a[14] = 0u; a[15] = 0u;
        bitonic_sort_desc<16>(a);
        merge_top16<1>(a); merge_top16<2>(a);
        float ev[16], sum = 0.f; const float m = key2f(a[0] & ~255u);
#pragma unroll
        for (int j = 0; j < 16; ++j) { ev[j] = __expf(key2f(a[j] & ~255u) - m); sum += ev[j]; }
        const float inv = 1.0f / sum;
        const size_t o = (size_t)(tile * 64 + tk) * 128 + h * 16;
#pragma unroll
        for (int j = 0; j < 16; ++j)
            if ((j >> 2) == q) {
                const int code = 255 - (int)(a[j] & 255u), i = code >> 4, jj = code & 15;
                const int n0 = 127 - (int)(t0[i] & 127u), n1 = 127 - (int)(t1[jj] & 127u);
                EXP[o + j] = n0 * 128 + n1; GATE[o + j] = ev[j] * inv;
            }
    }
    __syncthreads();
}

constexpr int AT_KS = 0, AT_VT = 192 * 72 * 2, AT_BT = AT_VT + 64 * 200 * 2, AT_PW = AT_BT + 4 * 128 * 4, AT_END = AT_PW + 8 * 32 * 72 * 2;
__device__ __forceinline__ void attn_unit(const bf16* __restrict__ PCb, const float* __restrict__ rel_bias, const float* __restrict__ sinks, bf16* __restrict__ ATT, int un, unsigned char* lds) {
    int tid = threadIdx.x; asm volatile("" : "+v"(tid));
    const int lane = tid & 63, wave = __builtin_amdgcn_readfirstlane(tid >> 6), fr = lane & 15, fq = lane >> 4;
    const int kvh = un & 3, qblk = (un >> 2) & 63, b = un >> 8;
    const int q0 = qblk * 64, tb = b * SEQ;
    bf16* Ks = (bf16*)(lds + AT_KS); bf16* Vt = (bf16*)(lds + AT_VT); float* Bt = (float*)(lds + AT_BT); bf16* Pw = (bf16*)(lds + AT_PW) + wave * 32 * 72;
#pragma unroll
    for (int k = 0; k < 3; ++k) {
        const int ci = tid + 512 * k, row = ci >> 3, part = ci & 7, kpos = q0 - 128 + row;
        v4u kv = (v4u){0u, 0u, 0u, 0u}, vv = kv;
        if (kpos >= 0) { const bf16* src = PCb + (size_t)(tb + kpos) * CN + kvh * 64 + part * 8; kv = *(const v4u*)(src + 1024); vv = *(const v4u*)(src + 1280); }
        *(v4u*)(Ks + row * 72 + part * 8) = kv;
        bf16* vd = Vt + (part * 8) * 200 + row;
        vd[0 * 200] = (bf16)(vv.x & 0xffffu); vd[1 * 200] = (bf16)(vv.x >> 16); vd[2 * 200] = (bf16)(vv.y & 0xffffu); vd[3 * 200] = (bf16)(vv.y >> 16);
        vd[4 * 200] = (bf16)(vv.z & 0xffffu); vd[5 * 200] = (bf16)(vv.z >> 16); vd[6 * 200] = (bf16)(vv.w & 0xffffu); vd[7 * 200] = (bf16)(vv.w >> 16);
    }
    Bt[tid] = rel_bias[t5_bucket(tid & 127) * 16 + kvh * 4 + (tid >> 7)];
    __syncthreads();
    const int g = wave >> 1, qs = (wave & 1) * 32, hh = kvh * 4 + g;
    bf16x8_t aQ[2][2];
#pragma unroll
    for (int mt = 0; mt < 2; ++mt)
#pragma unroll
        for (int ks = 0; ks < 2; ++ks) aQ[mt][ks] = *(const bf16x8_t*)(PCb + (size_t)(tb + q0 + qs + mt * 16 + fr) * CN + hh * 64 + ks * 32 + 8 * fq);
    f32x4 sc[2][12];
#pragma unroll
    for (int nt = 0; nt < 12; ++nt) {
        const bf16x8_t b0 = *(const bf16x8_t*)(Ks + (nt * 16 + fr) * 72 + 8 * fq), b1 = *(const bf16x8_t*)(Ks + (nt * 16 + fr) * 72 + 32 + 8 * fq);
#pragma unroll
        for (int mt = 0; mt < 2; ++mt) { f32x4 a = (f32x4){0.f, 0.f, 0.f, 0.f}; a = mfma16(aQ[mt][0], b0, a); a = mfma16(aQ[mt][1], b1, a); sc[mt][nt] = a; }
    }
    const float sink = sinks[hh];
    const float* bt = Bt + g * 128;
#pragma unroll
    for (int mt = 0; mt < 2; ++mt)
#pragma unroll
        for (int r = 0; r < 4; ++r) {
            const int qi = qs + mt * 16 + 4 * fq + r;
            float mx = sink;
#pragma unroll
            for (int nt = 0; nt < 12; ++nt) {
                const int kk = nt * 16 + fr, rel = qi + 128 - kk;
                const bool valid = rel >= 0 && rel < 128 && (q0 - 128 + kk) >= 0;
                const float lg = valid ? sc[mt][nt][r] * 0.125f + bt[valid ? rel : 0] : -INFINITY;
                sc[mt][nt][r] = lg; mx = fmaxf(mx, lg);
            }
            mx = fmaxf(mx, __shfl_xor(mx, 1)); mx = fmaxf(mx, __shfl_xor(mx, 2)); mx = fmaxf(mx, __shfl_xor(mx, 4)); mx = fmaxf(mx, __shfl_xor(mx, 8));
            float sum = 0.f;
#pragma unroll
            for (int nt = 0; nt < 12; ++nt) { const float p = __expf(sc[mt][nt][r] - mx); sc[mt][nt][r] = p; sum += p; }
            sum += __shfl_xor(sum, 1); sum += __shfl_xor(sum, 2); sum += __shfl_xor(sum, 4); sum += __shfl_xor(sum, 8);
            const float inv = 1.0f / (sum + __expf(sink - mx));
#pragma unroll
            for (int nt = 0; nt < 12; ++nt) sc[mt][nt][r] *= inv;
        }
    f32x4 oacc[2][4];
#pragma unroll
    for (int mt = 0; mt < 2; ++mt)
#pragma unroll
        for (int dt = 0; dt < 4; ++dt) oacc[mt][dt] = (f32x4){0.f, 0.f, 0.f, 0.f};
#pragma unroll
    for (int kc = 0; kc < 3; ++kc) {
#pragma unroll
        for (int mt = 0; mt < 2; ++mt)
#pragma unroll
            for (int n4 = 0; n4 < 4; ++n4)
#pragma unroll
                for (int r = 0; r < 4; ++r) Pw[(mt * 16 + 4 * fq + r) * 72 + n4 * 16 + fr] = (bf16)f2bf(sc[mt][kc * 4 + n4][r]);
        asm volatile("s_waitcnt lgkmcnt(0)" ::: "memory");
#pragma unroll
        for (int ks = 0; ks < 2; ++ks) {
            const bf16x8_t p0 = *(const bf16x8_t*)(Pw + fr * 72 + ks * 32 + 8 * fq), p1 = *(const bf16x8_t*)(Pw + (16 + fr) * 72 + ks * 32 + 8 * fq);
#pragma unroll
            for (int dt = 0; dt < 4; ++dt) {
                const bf16x8_t bv = *(const bf16x8_t*)(Vt + (dt * 16 + fr) * 200 + kc * 64 + ks * 32 + 8 * fq);
                oacc[0][dt] = mfma16(p0, bv, oacc[0][dt]); oacc[1][dt] = mfma16(p1, bv, oacc[1][dt]);
            }
        }
        asm volatile("s_waitcnt lgkmcnt(0)" ::: "memory");
    }
#pragma unroll
    for (int mt = 0; mt < 2; ++mt)
#pragma unroll
        for (int dt = 0; dt < 4; ++dt)
#pragma unroll
            for (int r = 0; r < 4; ++r) Pw[(mt * 16 + 4 * fq + r) * 72 + dt * 16 + fr] = (bf16)f2bf(oacc[mt][dt][r]);
    asm volatile("s_waitcnt lgkmcnt(0)" ::: "memory");
#pragma unroll
    for (int k = 0; k < 4; ++k) {
        const int ci = lane + 64 * k, row = ci >> 3, part = ci & 7;
        *(v4u*)(ATT + (size_t)(tb + q0 + qs + row) * D + hh * 64 + part * 8) = *(const v4u*)(Pw + row * 72 + part * 8);
    }
    __syncthreads();
}

__device__ __forceinline__ void swa_attn_sample(const bf16* __restrict__ PCb, const float* __restrict__ cache_k, const float* __restrict__ cache_v,
                                                const float* __restrict__ rel_bias, const float* __restrict__ sinks, bf16* __restrict__ ATT, int gw, int lane) {
    const int sb = gw >> 4, h = gw & 15, kvh = h >> 2, t = NP + sb;
    const bf16* qrow = PCb + (size_t)t * CN + h * 64;
    float lg[2];
#pragma unroll
    for (int rr = 0; rr < 2; ++rr) {
        const int r = lane + 64 * rr;
        float dot = 0.f;
        if (r == 0) {
            const bf16* krow = PCb + (size_t)t * CN + 1024 + kvh * 64;
            for (int d = 0; d < 64; ++d) dot += bf2f(qrow[d]) * bf2f(krow[d]);
        } else {
            const float* krow = cache_k + (((size_t)sb * 128 + (128 - r)) * 4 + kvh) * 64;
#pragma unroll
            for (int d4 = 0; d4 < 16; ++d4) { const float4 kv = *(const float4*)(krow + d4 * 4);
                dot += bf2f(qrow[d4 * 4]) * kv.x + bf2f(qrow[d4 * 4 + 1]) * kv.y + bf2f(qrow[d4 * 4 + 2]) * kv.z + bf2f(qrow[d4 * 4 + 3]) * kv.w; }
        }
        lg[rr] = dot * 0.125f + rel_bias[t5_bucket(r) * 16 + h];
    }
    const float sink = sinks[h];
    const float m = fmaxf(wave_max(fmaxf(lg[0], lg[1])), sink);
    float p[2] = {expf(lg[0] - m), expf(lg[1] - m)};
    const float inv = 1.0f / (wave_sum(p[0] + p[1]) + expf(sink - m));
    float o = 0.f;
#pragma unroll
    for (int rr = 0; rr < 2; ++rr)
        for (int l2 = 0; l2 < 64; ++l2) {
            const int r = l2 + 64 * rr;
            const float pj = __shfl(p[rr], l2);
            const float vv = (r == 0) ? bf2f(PCb[(size_t)t * CN + 1280 + kvh * 64 + lane]) : cache_v[(((size_t)sb * 128 + (128 - r)) * 4 + kvh) * 64 + lane];
            o += pj * vv;
        }
    ATT[(size_t)t * D + h * 64 + lane] = (bf16)f2bf(o * inv);
}
__device__ __forceinline__ void swa_kv_out2(const bf16* __restrict__ PCb, const float* __restrict__ cache_k, const float* __restrict__ cache_v,
                                            float* __restrict__ pk, float* __restrict__ pv, float* __restrict__ sk, float* __restrict__ sv, int vb) {
    int tx_ = threadIdx.x; asm volatile("" : "+v"(tx_));
    const int c = tx_ & 255, row = vb * 2 + (tx_ >> 8);
    if (row < NB * 128) {
        const int b = row >> 7, i = row & 127;
        const bf16* src = PCb + (size_t)(b * SEQ + SEQ - 128 + i) * CN;
        pk[(size_t)row * 256 + c] = bf2f(src[1024 + c]);
        pv[(size_t)row * 256 + c] = bf2f(src[1280 + c]);
    } else {
        const int r2 = row - NB * 128, sb = r2 >> 7, i = r2 & 127;
        if (i < 127) {
            sk[(size_t)r2 * 256 + c] = cache_k[((size_t)sb * 128 + i + 1) * 256 + c];
            sv[(size_t)r2 * 256 + c] = cache_v[((size_t)sb * 128 + i + 1) * 256 + c];
        } else {
            const bf16* src = PCb + (size_t)(NP + sb) * CN;
            sk[(size_t)r2 * 256 + c] = bf2f(src[1024 + c]);
            sv[(size_t)r2 * 256 + c] = bf2f(src[1280 + c]);
        }
    }
}


__device__ __forceinline__ void sample_gemm_piece(const bf16* __restrict__ A, const bf16* __restrict__ Bt, const float* __restrict__ bias, bf16* __restrict__ O, int ldc, int p, unsigned char* lds) {
    int tid = threadIdx.x; asm volatile("" : "+v"(tid));
    const int lane = tid & 63, wave = __builtin_amdgcn_readfirstlane(tid >> 6), fr = lane & 15, fq = lane >> 4;
    const int mt = p & 7, cb = p >> 3, nt = wave & 3, kh = wave >> 2;
    const bf16* ap = A + (size_t)(NP + mt * 16 + fr) * D + kh * 512 + 8 * fq;
    const bf16* bp = Bt + (size_t)(cb * 64 + nt * 16 + fr) * D + kh * 512 + 8 * fq;
    bf16x8_t a[16], b[16];
#pragma unroll
    for (int ks = 0; ks < 16; ++ks) { a[ks] = *(const bf16x8_t*)(ap + ks * 32); b[ks] = *(const bf16x8_t*)(bp + ks * 32); }
    f32x4 acc = (f32x4){0.f, 0.f, 0.f, 0.f};
#pragma unroll
    for (int ks = 0; ks < 16; ++ks) acc = mfma16(a[ks], b[ks], acc);
    f32x4* part = (f32x4*)lds;
    if (kh == 1) part[nt * 64 + lane] = acc;
    __syncthreads();
    if (kh == 0) {
        acc = acc + part[nt * 64 + lane];
        const int col = cb * 64 + nt * 16 + fr; const float bv = bias ? bias[col] : 0.f;
#pragma unroll
        for (int r = 0; r < 4; ++r) O[(size_t)(NP + mt * 16 + 4 * fq + r) * ldc + col] = (bf16)f2bf(acc[r] + bv);
    }
    __syncthreads();
}

constexpr size_t MiB = 1u << 20;
constexpr size_t WS_CTL = 0, CTL_ZERO_BYTES = 64 * 1024;
constexpr size_t WS_WAB = 1 * MiB;
constexpr size_t WS_WOUT = WS_WAB + (size_t)ABNP * D * 2;
constexpr size_t WS_WQ0 = WS_WOUT + (size_t)D * D * 2;
constexpr size_t WS_WQ1 = WS_WQ0 + (size_t)2048 * D * 2;
constexpr size_t WS_WINC = WS_WQ1 + (size_t)2048 * D * 2;
constexpr size_t WS_WOUTC = WS_WINC + (size_t)CN * D * 2;
constexpr size_t WS_ABUF = WS_WOUTC + (size_t)D * D * 2;
constexpr size_t WS_P = WS_ABUF + (size_t)MP * D * 2;
constexpr size_t WS_T = WS_P + (size_t)MP * ABN * 2;
constexpr size_t WS_Q = WS_T + (size_t)4 * 16384 * D + (size_t)4 * 16384 * 4;
constexpr size_t WS_A = WS_Q + (size_t)MP * 1536 * 4;
constexpr size_t WS_B = WS_A + (size_t)MP * 512 * 4;
constexpr size_t WS_O = WS_B + (size_t)MP * 512 * 4;
constexpr size_t WS_X1 = WS_O + (size_t)MP * 512 * 4;
constexpr size_t WS_G = WS_X1 + (size_t)MP * D * 4;
constexpr size_t WS_BETA = WS_G + (size_t)MP * 4 * 4;
constexpr size_t WS_GATE = WS_BETA + (size_t)MP * 4 * 4;
constexpr size_t WS_EXP = WS_GATE + (size_t)MP * 128 * 4;
constexpr size_t WS_HEND = WS_EXP + (size_t)MP * 128 * 4;
constexpr size_t WS_KEYS = WS_HEND + (size_t)3 * 4 * 64 * 512 * 4;
constexpr size_t WS_WGT = WS_KEYS + (size_t)2 * 8 * 2 * 128 * 128 * 2;
constexpr size_t WS_END = WS_WGT + (size_t)2 * 8 * 64 * 64 * 2;
constexpr size_t Q_QKVS = 0, Q_W = 1 * MiB, Q_QG = Q_W + 16 * MiB, Q_KDT = Q_QG + 16 * MiB, Q_UT = Q_KDT + 16 * MiB, Q_QK = Q_UT + 16 * MiB, Q_EGL = Q_QK + 8 * MiB, Q_END = Q_EGL + 4096;
static_assert(Q_END <= (size_t)MP * 1536 * 4, "region Q");
static_assert(WS_END <= 512 * MiB, "d_ws map");

struct MegaArgs {
    const float* in[35];
    float* out;
    unsigned char* ws;
};

__global__ void __launch_bounds__(NTH, 2) fwd_megakernel(MegaArgs ma) {
    cg::grid_group grid = cg::this_grid();
    extern __shared__ __attribute__((aligned(16))) unsigned char lds[];
    float* smem = (float*)lds;
    const int nb = gridDim.x, b0 = blockIdx.x, wave = __builtin_amdgcn_readfirstlane(threadIdx.x >> 6);
    int tid = threadIdx.x, lane = tid & 63;
    const float* x_prompt = ma.in[0];
    const float* x_sample = ma.in[1];
    const float* state_gdn = ma.in[2];
    const float* state_gdn_conv = ma.in[3];
    const float* state_lru = ma.in[4];
    const float* state_lru_conv = ma.in[5];
    const float* cache_k = ma.in[6];
    const float* cache_v = ma.in[7];
    const float* w_in_ab = ma.in[8];
    const float* gdn_conv_w = ma.in[9];
    const float* gdn_a_log = ma.in[10];
    const float* gdn_dt_bias = ma.in[11];
    const float* gdn_norm_w = ma.in[12];
    const float* lru_conv_w = ma.in[13];
    const float* lru_conv_b = ma.in[14];
    const float* lru_w_r = ma.in[15];
    const float* lru_b_r = ma.in[16];
    const float* lru_w_i = ma.in[17];
    const float* lru_b_i = ma.in[18];
    const float* lru_lam = ma.in[19];
    const float* w_out_ab = ma.in[20];
    const float* w_in_c = ma.in[21];
    const float* b_in_c = ma.in[22];
    const float* swa_sinks = ma.in[23];
    const float* w_out_c = ma.in[24];
    const float* b_out_c = ma.in[25];
    const float* rel_bias = ma.in[26];
    const float* ln_mix_g = ma.in[27];
    const float* ln_mix_b = ma.in[28];
    const float* ln_ffn_g = ma.in[29];
    const float* ln_ffn_b = ma.in[30];
    const float* peer_w_q = ma.in[31];
    const float* peer_keys = ma.in[32];
    const float* peer_u = ma.in[33];
    const float* peer_v = ma.in[34];

    float* out = ma.out;
    float* o_y = out;
    float* o_p_gdn = out + (size_t)NT * D;
    float* o_p_gdn_conv = o_p_gdn + 262144;
    float* o_p_lru = o_p_gdn_conv + 18432;
    float* o_p_lru_conv = o_p_lru + 2048;
    float* o_p_k = o_p_lru_conv + 6144;
    float* o_p_v = o_p_k + 131072;
    float* o_s_gdn = o_p_v + 131072;
    float* o_s_gdn_conv = o_s_gdn + 8388608;
    float* o_s_lru = o_s_gdn_conv + 589824;
    float* o_s_lru_conv = o_s_lru + 65536;
    float* o_s_k = o_s_lru_conv + 196608;
    float* o_s_v = o_s_k + 4194304;

    unsigned char* ws = ma.ws;
    bf16* WAB_T = (bf16*)(ws + WS_WAB); bf16* WOUT_T = (bf16*)(ws + WS_WOUT); bf16* WQ0_T = (bf16*)(ws + WS_WQ0); bf16* WQ1_T = (bf16*)(ws + WS_WQ1);
    bf16* WINC_T = (bf16*)(ws + WS_WINC); bf16* WOUTC_T = (bf16*)(ws + WS_WOUTC);
    bf16* ABUF = (bf16*)(ws + WS_ABUF);
    bf16* PROJ = (bf16*)(ws + WS_P); float* Y = (float*)(ws + WS_P); bf16* Qb = (bf16*)(ws + WS_P); bf16* PCb = (bf16*)(ws + WS_P); float* Y1 = (float*)(ws + WS_P);
    unsigned char* TAB8 = ws + WS_T; float* TSC = (float*)(ws + WS_T + (size_t)4 * 16384 * D);
    float* R_Q = (float*)(ws + WS_Q + Q_QKVS) - (size_t)NP * 1536; float* X2 = (float*)(ws + WS_A);
    GdnChunkBufs cbuf; cbuf.W = (bf16*)(ws + WS_Q + Q_W); cbuf.QG = (bf16*)(ws + WS_Q + Q_QG); cbuf.KDT = (bf16*)(ws + WS_Q + Q_KDT); cbuf.UT = (bf16*)(ws + WS_Q + Q_UT); cbuf.QK = (bf16*)(ws + WS_Q + Q_QK); cbuf.EGL = (float*)(ws + WS_Q + Q_EGL);
    bf16* Yb = (bf16*)(ws + WS_P);
    float* OUTS = (float*)(ws + WS_Q);
    float* PD = (float*)(ws + WS_P);
    bf16* KEYSB = (bf16*)(ws + WS_KEYS); bf16* WRT = (bf16*)(ws + WS_WGT); bf16* WIT = WRT + 8 * 64 * 64;
    float* HEND = (float*)(ws + WS_HEND); float* PEND = HEND + 4 * 64 * 512; float* CIN = PEND + 4 * 64 * 512;
    float* R_A = (float*)(ws + WS_A); float* R_B = (float*)(ws + WS_B); float* R_O = (float*)(ws + WS_O);
    bf16* XRES = (bf16*)(ws + WS_X1);
    float* R_G = (float*)(ws + WS_G); float* R_BETA = (float*)(ws + WS_BETA); float* R_GATE = (float*)(ws + WS_GATE); int* R_EXP = (int*)(ws + WS_EXP);

    for (int u = tid; u < (LDS_BYTES - RING_BYTES) / 4; u += NTH) ((unsigned*)(lds + RING_BYTES))[u] = 0u;
    __syncthreads();
    XcdBarrier bar = xcd_barrier_post((unsigned*)(ws + WS_CTL), (volatile LAS unsigned*)((LAS unsigned char*)lds + MISC_OFF) + 8);
#define GRID_BAR() do { xcd_barrier(bar); asm volatile("" : "+v"(tid)); lane = tid & 63; } while (0)
#define PHASE_LOOP(n) for (int vb = b0; vb < (n); vb += nb)
#define PHASE_END __syncthreads()
#define GEMM_PHASE_M(Mrows, EPI, Aptr, Btptr, Nn, ...) do { pg8::Gemm g_{(const pg8::bf16_t*)(Aptr), (const pg8::bf16_t*)(Btptr), (Mrows), (Nn), D}; pg8::StaticOrder S_; S_.init((Mrows), (Nn), nb, b0); \
        pg8::EPI E_{__VA_ARGS__}; pg8::gemm_phase<pg8::EPI, pg8::StaticOrder, true, true>((PG8_LAS unsigned char*)lds, g_, S_, E_); } while (0)
#define GEMM_PHASE(EPI, Aptr, Btptr, Nn, ...) GEMM_PHASE_M(MP, EPI, Aptr, Btptr, Nn, __VA_ARGS__)
#define GEMM_PHASE_SPLIT(Aptr, Btptr, Nn, Optr, biasptr) do { GEMM_PHASE_M(NP, EpiStoreBf16, Aptr, Btptr, Nn, Optr, Nn, biasptr, NP, Nn); \
        for (int p_ = b0; p_ < 8 * ((Nn) / 64); p_ += nb) sample_gemm_piece(Aptr, Btptr, biasptr, Optr, Nn, p_, lds); } while (0)

    {
        float* scr = smem + wave * 4096;
        const int gw = b0 * NWAVES + wave, NGW = nb * NWAVES;
        constexpr int I_AB = 16 * 97, I_OUT = 16 * 32, I_Q = 16 * 64, I_INC = 16 * 48;
        constexpr int NITEMS = I_AB + I_OUT + 2 * I_Q + I_INC + I_OUT;
        for (int it = gw; it < NITEMS; it += NGW) {
            int r = it;
            if (r < I_AB) { p0_transpose_item(w_in_ab, D, ABN, WAB_T, scr, r, lane); continue; } r -= I_AB;
            if (r < I_OUT) { p0_transpose_item(w_out_ab, D, D, WOUT_T, scr, r, lane); continue; } r -= I_OUT;
            if (r < I_Q) { p0_transpose_item(peer_w_q, D, 2048, WQ0_T, scr, r, lane); continue; } r -= I_Q;
            if (r < I_Q) { p0_transpose_item(peer_w_q + (size_t)D * 2048, D, 2048, WQ1_T, scr, r, lane); continue; } r -= I_Q;
            if (r < I_INC) { p0_transpose_item(w_in_c, D, CN, WINC_T, scr, r, lane); continue; } r -= I_INC;
            p0_transpose_item(w_out_c, D, D, WOUTC_T, scr, r, lane);
        }
        for (int it = b0 * NTH + tid; it < 2 * 8 * 64 * 8; it += nb * NTH) {
            const int gsel = it >> 12, nn = (it >> 9) & 7, dd = (it >> 3) & 63, c8 = (it & 7) * 8;
            const float* wsrc = (gsel ? lru_w_i : lru_w_r) + ((size_t)nn * 64 + c8) * 64 + dd;
            v4u o; o.x = pk2(wsrc[0], wsrc[64]); o.y = pk2(wsrc[128], wsrc[192]); o.z = pk2(wsrc[256], wsrc[320]); o.w = pk2(wsrc[384], wsrc[448]);
            *(v4u*)((gsel ? WIT : WRT) + ((size_t)nn * 64 + dd) * 64 + c8) = o;
        }
        for (int m = gw; m < MP + (ABNP - 97 * 32); m += NGW) {
            if (m < MP) row_to_bf16(m < NP ? x_prompt + (size_t)m * D : (m < NT ? x_sample + (size_t)(m - NP) * D : nullptr), ABUF + (size_t)m * D, lane);
            else row_to_bf16(nullptr, WAB_T + (size_t)(97 * 32 + (m - MP)) * D, lane);
        }
    }
    GRID_BAR();
    if (ma.out == nullptr) grid.sync();
    GEMM_PHASE(EpiStoreBf16, ABUF, WAB_T, ABNP, PROJ, ABN, nullptr, NT, ABN);
    GRID_BAR();
    constexpr int NSPLIT = 28, A_LRU = 4 * NSPLIT, A_GDN = 16 * NSPLIT, B_LRU = 4 * (64 - NSPLIT), B_GDN = 16 * (64 - NSPLIT);
    { AbPrepArgs pa;
      pa.PROJ = PROJ; pa.st_gdn_conv = state_gdn_conv; pa.st_lru_conv = state_lru_conv;
      pa.gdn_conv_w = gdn_conv_w; pa.a_log = gdn_a_log; pa.dt_bias = gdn_dt_bias;
      pa.lru_conv_w = lru_conv_w; pa.lru_conv_b = lru_conv_b; pa.w_r = lru_w_r; pa.b_r = lru_b_r; pa.w_i = lru_w_i; pa.b_i = lru_b_i; pa.lam = lru_lam;
      pa.QKV = R_Q; pa.G = R_G; pa.BETA = R_BETA; pa.LA = R_A; pa.LB = R_B;
      pa.p_gdn_conv = o_p_gdn_conv; pa.p_lru_conv = o_p_lru_conv; pa.s_gdn_conv = o_s_gdn_conv; pa.s_lru_conv = o_s_lru_conv;
      for (int v = b0; v < A_LRU + NS + A_GDN; v += nb) {
          if (v < A_LRU) { lru_prep_unit2(PROJ, lru_conv_w, lru_conv_b, WRT, WIT, lru_b_r, lru_b_i, lru_lam, R_B, R_A, HEND, PEND, o_p_lru_conv, (v / NSPLIT) * 64 + (v % NSPLIT), lds); PHASE_END; }
          else if (v < A_LRU + NS) { ab_prep(pa, NP + (v - A_LRU), smem); PHASE_END; }
          else { const int i = v - A_LRU - NS, h_ = i & 3, n_ = (i >> 2) % NSPLIT, b_ = (i >> 2) / NSPLIT;
                 gdn_prep_unit(PROJ, gdn_conv_w, gdn_a_log, gdn_dt_bias, cbuf, o_p_gdn_conv, (b_ * 64 + n_) * 4 + h_, lds); }
      } }
    GRID_BAR();
    f32x4 seqS[2]; int seqcur = 0;
    const int seq_p = (b0 & 7) + 8 * (b0 >> 5), seq_s = (b0 >> 3) & 3;
    if (b0 < 64) gdn_seq<0, NSPLIT>(cbuf, R_O, o_p_gdn, seq_p >> 2, seq_p & 3, seq_s, lds, seqS, seqcur);
    else for (int v = b0 - 64; v < B_LRU + B_GDN; v += nb - 64) {
        if (v < B_LRU) { lru_prep_unit2(PROJ, lru_conv_w, lru_conv_b, WRT, WIT, lru_b_r, lru_b_i, lru_lam, R_B, R_A, HEND, PEND, o_p_lru_conv, (v / (64 - NSPLIT)) * 64 + NSPLIT + (v % (64 - NSPLIT)), lds); PHASE_END; }
        else { const int i = v - B_LRU, h_ = i & 3, n_ = NSPLIT + (i >> 2) % (64 - NSPLIT), b_ = (i >> 2) / (64 - NSPLIT);
               gdn_prep_unit(PROJ, gdn_conv_w, gdn_a_log, gdn_dt_bias, cbuf, o_p_gdn_conv, (b_ * 64 + n_) * 4 + h_, lds); }
    }
    GRID_BAR();
    if (b0 < 64) gdn_seq<NSPLIT, 64>(cbuf, R_O, o_p_gdn, seq_p >> 2, seq_p & 3, seq_s, lds, seqS, seqcur);
    else if (b0 < 68) lru_carry(HEND, PEND, CIN, o_p_lru, b0 - 64);
    else {
        for (int v = b0 - 68; v < 2048 + 128; v += nb - 68) {
            if (v < 2048) gdn_scan(R_Q, R_G, R_BETA, state_gdn, R_O, o_s_gdn, NP, 1, v & 3, (v >> 2) & 3, v >> 4, smem);
            else lru_scan(R_A, R_B, state_lru, o_s_lru, NP, 1, NS, v - 2048);
            PHASE_END;
        }
        const int gw2 = (b0 - 68) * NWAVES + wave, NGW2 = (nb - 68) * NWAVES;
        for (int m = gw2; m < 512; m += NGW2) row_to_bf16(peer_keys + (size_t)m * D, KEYSB + (size_t)m * D, lane);
        for (int m = gw2; m < 4 * 16384; m += NGW2) {
            const int k = m >> 14, r = m & 16383;
            row_to_fp8_sliced(((k & 1) ? peer_v : peer_u) + ((size_t)(k >> 1) * 16384 + r) * D, TAB8 + (size_t)k * 16384 * D, r, TSC + m, lane);
        }
    }
    GRID_BAR();
    PHASE_LOOP(NT / 8) { ab_mix_w(PROJ, R_O, R_B, R_A, CIN, gdn_norm_w, ABUF, vb * 8 + wave, lane); }
    GRID_BAR();
    GEMM_PHASE_SPLIT(ABUF, WOUT_T, D, Yb, (const float*)nullptr);
    GRID_BAR();
    PHASE_LOOP(NT / 8) { const int t = vb * 8 + wave;
        ln_res_w<false>(t < NP ? x_prompt + (size_t)t * D : x_sample + (size_t)(t - NP) * D, Yb + (size_t)t * D, ln_mix_g, ln_mix_b, ABUF + (size_t)t * D, lane); }
    GRID_BAR();
    GEMM_PHASE_SPLIT(ABUF, WQ0_T, 2048, Qb, (const float*)nullptr);
    GRID_BAR();
    if ((nb & 7) == 0) { peer_topk_stage_keys(KEYSB, b0 & 7, lds); PHASE_LOOP((NT / 64) * 8) { peer_topk4(Qb, R_EXP, R_GATE, vb >> 3, vb & 7, lds); } }
    else PHASE_LOOP((NT / 64) * 8) { peer_topk_stage_keys(KEYSB, vb & 7, lds); peer_topk4(Qb, R_EXP, R_GATE, vb >> 3, vb & 7, lds); }
    GRID_BAR();
    asm volatile("" : "+v"(tid)); lane = tid & 63;
    for (int tg = b0 >> 3; tg < NT / 8; tg += nb >> 3) { const int t = tg * 8 + wave, x = b0 & 7;
        peer_u_pass(ABUF + (size_t)t * D, R_EXP + (size_t)t * 128, TAB8 + (size_t)x * 16384 * 128, PD + ((size_t)x * NT + t) * 128, x, lane); }
    GRID_BAR();
    PHASE_LOOP(NT / 8) { const int t = vb * 8 + wave; peer_xk(R_EXP + (size_t)t * 128, R_GATE + (size_t)t * 128, PD + (size_t)t * 128, TSC, TSC + 16384, lane); }
    GRID_BAR();
    for (int tg = b0 >> 3; tg < NT / 8; tg += nb >> 3) { const int t = tg * 8 + wave, x = b0 & 7;
        peer_v_slice(R_EXP + (size_t)t * 128, R_GATE + (size_t)t * 128, TAB8 + (size_t)16384 * D + (size_t)x * 16384 * 128, OUTS + (size_t)t * D + x * 128, lane); }
    GRID_BAR();
    PHASE_LOOP(NT / 8) { const int t = vb * 8 + wave; peer_xc(ABUF + (size_t)t * D, OUTS + (size_t)t * D, ln_ffn_g, ln_ffn_b, nullptr, ABUF + (size_t)t * D, XRES + (size_t)t * D, lane); }
    GRID_BAR();

    GEMM_PHASE(EpiStoreBf16, ABUF, WINC_T, CN, PCb, CN, b_in_c, NT, CN);
    GRID_BAR();
    PHASE_LOOP(1024 + 256 + (NB * 128 + NS * 128) / 2) {
        if (vb < 1024) attn_unit(PCb, rel_bias, swa_sinks, ABUF, vb, lds);
        else if (vb < 1280) swa_attn_sample(PCb, cache_k, cache_v, rel_bias, swa_sinks, ABUF, (vb - 1024) * 8 + wave, lane);
        else swa_kv_out2(PCb, cache_k, cache_v, o_p_k, o_p_v, o_s_k, o_s_v, vb - 1280);
    }
    GRID_BAR();
    GEMM_PHASE_SPLIT(ABUF, WOUTC_T, D, Yb, b_out_c);
    GRID_BAR();
    PHASE_LOOP(NT / 8) { const int t = vb * 8 + wave;
        ln_res_w<true>(XRES + (size_t)t * D, Yb + (size_t)t * D, ln_mix_g + D, ln_mix_b + D, ABUF + (size_t)t * D, lane); }
    GRID_BAR();
    GEMM_PHASE_SPLIT(ABUF, WQ1_T, 2048, Qb, (const float*)nullptr);
    GRID_BAR();
    if ((nb & 7) == 0) { peer_topk_stage_keys(KEYSB + (size_t)8 * 2 * 128 * 128, b0 & 7, lds); PHASE_LOOP((NT / 64) * 8) { peer_topk4(Qb, R_EXP, R_GATE, vb >> 3, vb & 7, lds); } }
    else PHASE_LOOP((NT / 64) * 8) { peer_topk_stage_keys(KEYSB + (size_t)8 * 2 * 128 * 128, vb & 7, lds); peer_topk4(Qb, R_EXP, R_GATE, vb >> 3, vb & 7, lds); }
    GRID_BAR();
    asm volatile("" : "+v"(tid)); lane = tid & 63;
    for (int tg = b0 >> 3; tg < NT / 8; tg += nb >> 3) { const int t = tg * 8 + wave, x = b0 & 7;
        peer_u_pass(ABUF + (size_t)t * D, R_EXP + (size_t)t * 128, TAB8 + (size_t)2 * 16384 * D + (size_t)x * 16384 * 128, PD + ((size_t)x * NT + t) * 128, x, lane); }
    GRID_BAR();
    PHASE_LOOP(NT / 8) { const int t = vb * 8 + wave; peer_xk(R_EXP + (size_t)t * 128, R_GATE + (size_t)t * 128, PD + (size_t)t * 128, TSC + 2 * 16384, TSC + 3 * 16384, lane); }
    GRID_BAR();
    for (int tg = b0 >> 3; tg < NT / 8; tg += nb >> 3) { const int t = tg * 8 + wave, x = b0 & 7;
        peer_v_slice(R_EXP + (size_t)t * 128, R_GATE + (size_t)t * 128, TAB8 + (size_t)3 * 16384 * D + (size_t)x * 16384 * 128, OUTS + (size_t)t * D + x * 128, lane); }
    GRID_BAR();
    PHASE_LOOP(NT / 8) { const int t = vb * 8 + wave; peer_xc(ABUF + (size_t)t * D, OUTS + (size_t)t * D, ln_ffn_g + D, ln_ffn_b + D, o_y + (size_t)t * D, nullptr, nullptr, lane); }
}
}

extern "C" void kernel_launch(void* const* d_in, const int* in_sizes, int n_in,
                              void* d_out, int out_size, void* d_ws, size_t ws_size,
                              hipStream_t stream) {
    static int grid_blocks = 0;
    if (!grid_blocks) {
        int dev = 0, cus = 0, per_cu = 0;
        (void)hipGetDevice(&dev);
        (void)hipDeviceGetAttribute(&cus, hipDeviceAttributeMultiprocessorCount, dev);
        if (hipFuncSetAttribute((const void*)fwd_megakernel, hipFuncAttributeMaxDynamicSharedMemorySize, LDS_BYTES) != hipSuccess) { fprintf(stderr, "hipFuncSetAttribute failed\n"); grid_blocks = -1; return; }
        (void)hipOccupancyMaxActiveBlocksPerMultiprocessor(&per_cu, (const void*)fwd_megakernel, NTH, LDS_BYTES);
        if (per_cu < 1) { fprintf(stderr, "occupancy query says %d blocks per CU\n", per_cu); grid_blocks = -1; return; }
        if (cus * per_cu < 256) { fprintf(stderr, "this kernel needs 256 co-resident workgroups (device reports %d CUs x %d)\n", cus, per_cu); grid_blocks = -1; return; }
        grid_blocks = 256;
    }
    if (grid_blocks < 0) return;
    (void)hipMemsetAsync((char*)d_ws + WS_CTL, 0, CTL_ZERO_BYTES, stream);
    MegaArgs ma{};
    for (int i = 0; i < 35; ++i) ma.in[i] = (const float*)d_in[i];
    ma.out = (float*)d_out;
    ma.ws = (unsigned char*)d_ws;
    void* args[] = {&ma};
    hipError_t e = hipLaunchCooperativeKernel((void*)fwd_megakernel, dim3(grid_blocks), dim3(NTH), args, LDS_BYTES, stream);
    if (e != hipSuccess) fprintf(stderr, "cooperative launch failed: %s (grid %d)\n", hipGetErrorString(e), grid_blocks);
}
```

```cpp
#include <hip/hip_runtime.h>
#include <hip/hip_cooperative_groups.h>
#include <cstdio>
#include <cstdint>
namespace cg = cooperative_groups;

namespace pg8 {
#define PG8_LAS __attribute__((address_space(3)))
typedef unsigned short bf16_t;
typedef short bf16x8 __attribute__((ext_vector_type(8)));
typedef float f32x4 __attribute__((ext_vector_type(4)));
typedef unsigned u32x4 __attribute__((ext_vector_type(4)));
constexpr int BM = 256, BK = 64, HALF = 128, HTB = HALF * BK * 2  , STAGE_BYTES = 8 * HTB, NXCD = 8, WGM = 8;

__host__ __device__ __forceinline__ int lds_byte(int r, int c) { const int st = (r >> 4) * 2 + (c >> 5), rr = r & 15, cc = c & 31, ob = rr * 64 + cc * 2; return st * 1024 + (ob ^ (((ob >> 9) & 1) << 5)); }
__host__ __device__ __forceinline__ void stage_rc(int b, int& R, int& C) { const int st = b / 1024, sb = b % 1024, swz = sb ^ (((sb >> 9) & 1) << 5); R = (st >> 1) * 16 + swz / 64; C = (st & 1) * 32 + (swz % 64) / 2; }
__host__ __device__ __forceinline__ int perm32(int rho) { const int n = rho >> 4, i = rho & 15; return 8 * (i >> 2) + 4 * n + (i & 3); }

struct Unit { int pm, pn; };
struct Gemm { const bf16_t* A; const bf16_t* Bt; int M, N, K; };

struct StaticOrder {
    int nM, nN, nwg, G, c;
    __host__ __device__ void init(int M, int N, int G_, int c_) { nM = M / BM; nN = N / BM; nwg = nM * nN; G = G_; c = c_; }
    __host__ __device__ bool next(int i, Unit& u) const {
        const long L = (long)i * G + c; if (L >= nwg) return false;
        int wgid = (int)L; { const int q = nwg / NXCD, r = nwg % NXCD, xcd = wgid % NXCD, off = wgid / NXCD; wgid = (xcd < r ? xcd * (q + 1) : r * (q + 1) + (xcd - r) * q) + off; }
        const int nig = WGM * nN, gid = wgid / nig, fm = gid * WGM, gsz = (nM - fm) < WGM ? (nM - fm) : WGM;
        u.pm = fm + ((wgid % nig) % gsz); u.pn = (wgid % nig) / gsz; return true;
    }
    __device__ __forceinline__ void a_ready(const Unit&) const {}
    __device__ __forceinline__ void done(const Unit&) const {}
};

__device__ __forceinline__ unsigned cvt_pk_bf16(float lo, float hi) { unsigned r; asm volatile("v_cvt_pk_bf16_f32 %0, %1, %2" : "=v"(r) : "v"(lo), "v"(hi)); return r; }
template <class Epi, class Sched, bool ALIGN_EPI = false, bool SP2 = false>
__device__ __forceinline__ void gemm_phase(PG8_LAS unsigned char* lds, const Gemm g, const Sched& S, const Epi& E) {
    int tid_ = threadIdx.x; asm volatile("" : "+v"(tid_));
    const int tid = tid_, wid = __builtin_amdgcn_readfirstlane(tid >> 6), lane = tid & 63, wr = wid >> 2, wc = wid & 3, fr = lane & 15, fq = lane >> 4;
    const int K = g.K, nt = K / BK;
    unsigned voffA[2], voffB[2];
#pragma unroll
    for (int i = 0; i < 2; ++i) { int R, C; stage_rc(tid * 16 + i * 8192, R, C); const int Rb = Epi::PERM ? ((R & ~31) + perm32(R & 31)) : R;
        voffA[i] = (unsigned)(R * K + C) * 2u; voffB[i] = (unsigned)(Rb * K + C) * 2u; }
    const size_t kstep = (size_t)(BK * 2);
    const size_t hstep = (size_t)HALF * K * 2;
    const size_t tstep = 2 * hstep;
    const unsigned ldsw = (unsigned)wid * 1024u;
    const int aoff = lds_byte(wr * 64 + fr, fq * 8), boff = lds_byte(wc * 32 + fr, fq * 8);
#define PG8_SA(b, h) (((b) * 2 + (h)) * HTB)
#define PG8_SB(b, h) ((4 + (b) * 2 + (h)) * HTB)
#define PG8_STAGE(bufoff, gbase, voff) do { _Pragma("unroll") for (int _i = 0; _i < 2; ++_i) \
        __builtin_amdgcn_global_load_lds((const unsigned*)((const char*)(gbase) + (voff)[_i]), (PG8_LAS unsigned*)(lds + (bufoff) + ldsw + _i * 8192), 16, 0, 0); } while (0)
#define PG8_LDA(dst, b, h) do { _Pragma("unroll") for (int m = 0; m < 4; ++m) _Pragma("unroll") for (int k = 0; k < 2; ++k) dst[m][k] = *(const PG8_LAS bf16x8*)(lds + PG8_SA(b, h) + aoff + m * 2048 + k * 1024); } while (0)
#define PG8_LDB(dst, b, h) do { _Pragma("unroll") for (int n = 0; n < 2; ++n) _Pragma("unroll") for (int k = 0; k < 2; ++k) dst[n][k] = *(const PG8_LAS bf16x8*)(lds + PG8_SB(b, h) + boff + n * 2048 + k * 1024); } while (0)
#define PG8_MMA(ai, bj, At, Bt) do { __builtin_amdgcn_s_setprio(1); _Pragma("unroll") for (int m = 0; m < 4; ++m) _Pragma("unroll") for (int n = 0; n < 2; ++n) _Pragma("unroll") for (int k = 0; k < 2; ++k) \
        acc[ai][bj][m][n] = __builtin_amdgcn_mfma_f32_16x16x32_bf16(Bt[n][k], At[m][k], acc[ai][bj][m][n], 0, 0, 0); __builtin_amdgcn_s_setprio(0); } while (0)
#define PG8_WAIT_V(n) asm volatile("s_waitcnt vmcnt(" #n ")" ::: "memory")
#define PG8_WAIT_L(n) asm volatile("s_waitcnt lgkmcnt(" #n ")" ::: "memory")
#define PG8_BAR __builtin_amdgcn_s_barrier()
#define PG8_SCHED __builtin_amdgcn_sched_barrier(0)
    Unit cur, nxt; int ui = 0;
    if (!S.next(0, cur)) return;
    f32x4 acc[2][2][4][2];
#pragma unroll
    for (int a = 0; a < 2; ++a)
#pragma unroll
        for (int b = 0; b < 2; ++b)
#pragma unroll
            for (int m = 0; m < 4; ++m)
#pragma unroll
                for (int n = 0; n < 2; ++n) acc[a][b][m][n] = (f32x4){0.f, 0.f, 0.f, 0.f};
    bf16x8 At[4][2], B0[2][2], B1[2][2];
    const char* cA = (const char*)g.A + (size_t)cur.pm * tstep; const char* cB = (const char*)g.Bt + (size_t)cur.pn * tstep;
    S.a_ready(cur);
    if constexpr (SP2) {
        PG8_STAGE(PG8_SB(0, 0), cB, voffB); PG8_STAGE(PG8_SB(0, 1), cB + hstep, voffB); PG8_STAGE(PG8_SA(0, 0), cA, voffA); PG8_STAGE(PG8_SA(0, 1), cA + hstep, voffA);
        if (wr == 1) PG8_BAR;
        PG8_WAIT_V(2); PG8_BAR;
        PG8_STAGE(PG8_SB(1, 0), cB + kstep, voffB); PG8_STAGE(PG8_SA(1, 0), cA + kstep, voffA); PG8_STAGE(PG8_SB(1, 1), cB + hstep + kstep, voffB);
        PG8_WAIT_V(6); PG8_BAR;
    } else {
        PG8_STAGE(PG8_SB(0, 0), cB, voffB); PG8_STAGE(PG8_SA(0, 0), cA, voffA); PG8_STAGE(PG8_SB(0, 1), cB + hstep, voffB); PG8_STAGE(PG8_SA(0, 1), cA + hstep, voffA);
        if (wr == 1) PG8_BAR;
        PG8_WAIT_V(4); PG8_BAR;
        PG8_STAGE(PG8_SB(1, 0), cB + kstep, voffB); PG8_STAGE(PG8_SA(1, 0), cA + kstep, voffA); PG8_STAGE(PG8_SB(1, 1), cB + hstep + kstep, voffB);
        PG8_WAIT_V(6); PG8_BAR;
    }
    for (;;) {
        const bool has_next = S.next(ui + 1, nxt);
        const char* nA = has_next ? (const char*)g.A + (size_t)nxt.pm * tstep : cA; const char* nB = has_next ? (const char*)g.Bt + (size_t)nxt.pn * tstep : cB;
        for (int t = 0; t < nt; t += 2) {
            const bool last = (t == nt - 2);
            const char* a1 = cA + (size_t)(t + 1) * kstep;
            const char* a2 = last ? nA : cA + (size_t)(t + 2) * kstep; const char* b2 = last ? nB : cB + (size_t)(t + 2) * kstep;
            const char* a3 = a2 + kstep; const char* b3 = b2 + kstep;
            if (last && has_next) S.a_ready(nxt);
            if constexpr (SP2) {
            PG8_LDB(B0, 0, 0); PG8_LDB(B1, 0, 1); PG8_SCHED; PG8_LDA(At, 0, 0); PG8_STAGE(PG8_SA(1, 1), a1 + hstep, voffA);
            PG8_WAIT_V(8); PG8_WAIT_L(0); PG8_BAR; PG8_MMA(0, 0, At, B0); PG8_MMA(0, 1, At, B1); PG8_BAR; PG8_SCHED;
            PG8_LDA(At, 0, 1); PG8_STAGE(PG8_SB(0, 0), b2, voffB); PG8_STAGE(PG8_SB(0, 1), b2 + hstep, voffB); PG8_STAGE(PG8_SA(0, 0), a2, voffA);
            PG8_WAIT_V(8); PG8_WAIT_L(0); PG8_BAR; PG8_MMA(1, 0, At, B0); PG8_MMA(1, 1, At, B1); PG8_BAR; PG8_SCHED;
            PG8_LDB(B0, 1, 0); PG8_LDB(B1, 1, 1); PG8_SCHED; PG8_LDA(At, 1, 0); PG8_STAGE(PG8_SA(0, 1), a2 + hstep, voffA);
            PG8_WAIT_V(8); PG8_WAIT_L(0); PG8_BAR; PG8_MMA(0, 0, At, B0); PG8_MMA(0, 1, At, B1); PG8_BAR; PG8_SCHED;
            PG8_LDA(At, 1, 1); PG8_STAGE(PG8_SB(1, 0), b3, voffB); PG8_STAGE(PG8_SB(1, 1), b3 + hstep, voffB); PG8_STAGE(PG8_SA(1, 0), a3, voffA);
            PG8_WAIT_V(8); PG8_WAIT_L(0); PG8_BAR; PG8_MMA(1, 0, At, B0); PG8_MMA(1, 1, At, B1); PG8_BAR; PG8_SCHED;
            } else {
            PG8_LDB(B0, 0, 0); PG8_SCHED; PG8_LDA(At, 0, 0); PG8_STAGE(PG8_SA(1, 1), a1 + hstep, voffA);
            PG8_WAIT_L(8); PG8_BAR; PG8_WAIT_L(0); PG8_MMA(0, 0, At, B0); PG8_BAR; PG8_SCHED;
            PG8_LDB(B1, 0, 1); PG8_STAGE(PG8_SB(0, 0), b2, voffB);
            PG8_BAR; PG8_WAIT_L(0); PG8_MMA(0, 1, At, B1); PG8_BAR;
            PG8_LDA(At, 0, 1); PG8_STAGE(PG8_SA(0, 0), a2, voffA);
            PG8_BAR; PG8_WAIT_L(0); PG8_MMA(1, 0, At, B0); PG8_BAR; PG8_SCHED;
            PG8_STAGE(PG8_SB(0, 1), b2 + hstep, voffB);
            PG8_WAIT_V(6); PG8_BAR; PG8_MMA(1, 1, At, B1); PG8_BAR;
            PG8_LDB(B0, 1, 0); PG8_SCHED; PG8_LDA(At, 1, 0); PG8_STAGE(PG8_SA(0, 1), a2 + hstep, voffA);
            PG8_WAIT_L(8); PG8_BAR; PG8_WAIT_L(0); PG8_MMA(0, 0, At, B0); PG8_BAR; PG8_SCHED;
            PG8_LDB(B1, 1, 1); PG8_STAGE(PG8_SB(1, 0), b3, voffB);
            PG8_BAR; PG8_WAIT_L(0); PG8_MMA(0, 1, At, B1); PG8_BAR;
            PG8_LDA(At, 1, 1); PG8_STAGE(PG8_SA(1, 0), a3, voffA);
            PG8_BAR; PG8_WAIT_L(0); PG8_MMA(1, 0, At, B0); PG8_BAR; PG8_SCHED;
            PG8_STAGE(PG8_SB(1, 1), b3 + hstep, voffB);
            PG8_WAIT_V(6); PG8_BAR; PG8_MMA(1, 1, At, B1); PG8_BAR;
            }
        }
        if constexpr (ALIGN_EPI) { if (wr == 0) PG8_BAR; }
        if constexpr (!Epi::AFTER_DRAIN) { E(acc, cur, wr, wc, fr, fq); S.done(cur); }
        if (!has_next) break;
#pragma unroll
        for (int a = 0; a < 2; ++a)
#pragma unroll
            for (int b = 0; b < 2; ++b)
#pragma unroll
                for (int m = 0; m < 4; ++m)
#pragma unroll
                    for (int n = 0; n < 2; ++n) acc[a][b][m][n] = (f32x4){0.f, 0.f, 0.f, 0.f};
        cur = nxt; cA = nA; cB = nB; ++ui;
        if constexpr (ALIGN_EPI) { if (wr == 1) PG8_BAR; }
    }
    PG8_WAIT_V(0);
    if constexpr (!ALIGN_EPI) { if (wr == 0) PG8_BAR; }
    PG8_BAR;
    if constexpr (Epi::AFTER_DRAIN) { E.fused(acc, cur, wr, wc, fr, fq, lds, wid, lane); S.done(cur); }
#undef PG8_SA
#undef PG8_SB
#undef PG8_STAGE
#undef PG8_LDA
#undef PG8_LDB
#undef PG8_MMA
#undef PG8_WAIT_V
#undef PG8_WAIT_L
#undef PG8_BAR
#undef PG8_SCHED
}
}
namespace pg8 {
struct EpiStoreBf16 {
    static constexpr bool PERM = true, AFTER_DRAIN = false;
    bf16_t* O; int ldc; const float* bias; int m_real, n_real;
    __device__ __forceinline__ void operator()(const f32x4 (&acc)[2][2][4][2], const Unit& u, int wr, int wc, int fr, int fq) const {
        const int row0 = u.pm * BM + wr * 64 + fr, col0 = u.pn * BM + wc * 32 + 8 * fq;
#pragma unroll
        for (int bj = 0; bj < 2; ++bj) {
            const int col = col0 + bj * HALF;
            if (col >= n_real) continue;
            f32x4 b0 = (f32x4){0.f, 0.f, 0.f, 0.f}, b1 = b0;
            if (bias) { b0 = *(const f32x4*)(bias + col); b1 = *(const f32x4*)(bias + col + 4); }
#pragma unroll
            for (int ai = 0; ai < 2; ++ai)
#pragma unroll
                for (int m = 0; m < 4; ++m) {
                    const int row = row0 + ai * HALF + m * 16;
                    if (row >= m_real) continue;
                    const f32x4 v0 = acc[ai][bj][m][0] + b0, v1 = acc[ai][bj][m][1] + b1;
                    u32x4 w; w.x = cvt_pk_bf16(v0[0], v0[1]); w.y = cvt_pk_bf16(v0[2], v0[3]); w.z = cvt_pk_bf16(v1[0], v1[1]); w.w = cvt_pk_bf16(v1[2], v1[3]);
                    *(u32x4*)(O + (size_t)row * ldc + col) = w;
                }
        }
    }
};
struct EpiStoreF32 {
    static constexpr bool PERM = false, AFTER_DRAIN = false;
    float* O; int ldc; const float* bias; int m_real, n_real;
    __device__ __forceinline__ void operator()(const f32x4 (&acc)[2][2][4][2], const Unit& u, int wr, int wc, int fr, int fq) const {
        const int row0 = u.pm * BM + wr * 64 + fr, col0 = u.pn * BM + wc * 32 + 4 * fq;
#pragma unroll
        for (int bj = 0; bj < 2; ++bj)
#pragma unroll
            for (int n = 0; n < 2; ++n) {
                const int col = col0 + bj * HALF + n * 16;
                if (col >= n_real) continue;
                const f32x4 bv = bias ? *(const f32x4*)(bias + col) : (f32x4){0.f, 0.f, 0.f, 0.f};
#pragma unroll
                for (int ai = 0; ai < 2; ++ai)
#pragma unroll
                    for (int m = 0; m < 4; ++m) {
                        const int row = row0 + ai * HALF + m * 16;
                        if (row >= m_real) continue;
                        *(f32x4*)(O + (size_t)row * ldc + col) = acc[ai][bj][m][n] + bv;
                    }
            }
    }
};
}
namespace {
#define GAS __attribute__((address_space(1)))
#define LAS __attribute__((address_space(3)))
typedef unsigned short bf16;
typedef float f32x4 __attribute__((ext_vector_type(4)));
typedef unsigned v4u __attribute__((ext_vector_type(4)));
typedef unsigned v2u __attribute__((ext_vector_type(2)));

constexpr int D = 1024, NB = 4, SEQ = 4096, NP = NB * SEQ, NS = 128, NT = NP + NS, MP = 16640;
constexpr int ABN = 3080, ABNP = 3328;
constexpr int C_QKV = 0, C_Z = 1536, C_A = 2048, C_B = 2052, C_XR = 2056, C_GATE = 2568;
constexpr int CN = 1536;
constexpr float ALPHA = 1.4142135623730951f;
constexpr float LN_EPS = 1e-5f;
constexpr int NTH = 512, NWAVES = 8;
constexpr int RING_BYTES = 143360, MISC_OFF = RING_BYTES + 320, LDS_BYTES = 147456;

__device__ __forceinline__ float bf2f(bf16 v) { return __uint_as_float((unsigned)v << 16); }
__device__ __forceinline__ float bflo(unsigned w) { return __uint_as_float(w << 16); }
__device__ __forceinline__ float bfhi(unsigned w) { return __uint_as_float(w & 0xffff0000u); }
__device__ __forceinline__ unsigned f2bf(float f) { unsigned u = __float_as_uint(f); return (u + 0x7fffu + ((u >> 16) & 1u)) >> 16; }
__device__ __forceinline__ unsigned pk2(float lo, float hi) { return f2bf(lo) | (f2bf(hi) << 16); }
__device__ __forceinline__ float sigmoidf_(float x) { return 1.0f / (1.0f + expf(-x)); }
__device__ __forceinline__ float softplusf_(float x) { return fmaxf(x, 0.f) + log1pf(expf(-fabsf(x))); }
__device__ __forceinline__ float siluf_(float x) { return x / (1.0f + expf(-x)); }
__device__ __forceinline__ float geluf_(float x) { return 0.5f * x * (1.0f + tanhf(0.7978845608028654f * (x + 0.044715f * x * x * x))); }
#define DPPF(v_, ctrl_, rmask_) __int_as_float(__builtin_amdgcn_update_dpp(0, __float_as_int(v_), (ctrl_), (rmask_), 0xf, false))
__device__ __forceinline__ float wave_sum(float v) {
    v += DPPF(v, 0xB1, 0xf); v += DPPF(v, 0x4E, 0xf); v += DPPF(v, 0x141, 0xf); v += DPPF(v, 0x140, 0xf);
    v += DPPF(v, 0x142, 0xa); v += DPPF(v, 0x143, 0xc);
    return __int_as_float(__builtin_amdgcn_readlane(__float_as_int(v), 63));
}
__device__ __forceinline__ float wave_max(float v) {
    v = fmaxf(v, DPPF(v, 0xB1, 0xf)); v = fmaxf(v, DPPF(v, 0x4E, 0xf)); v = fmaxf(v, DPPF(v, 0x141, 0xf)); v = fmaxf(v, DPPF(v, 0x140, 0xf));
    { const float t = __int_as_float(__builtin_amdgcn_update_dpp(__float_as_int(v), __float_as_int(v), 0x142, 0xa, 0xf, false)); v = fmaxf(v, t); }
    { const float t = __int_as_float(__builtin_amdgcn_update_dpp(__float_as_int(v), __float_as_int(v), 0x143, 0xc, 0xf, false)); v = fmaxf(v, t); }
    return __int_as_float(__builtin_amdgcn_readlane(__float_as_int(v), 63));
}

__device__ __forceinline__ void p0_transpose_item(const float* __restrict__ W, int K, int N, bf16* __restrict__ WT, float* scr, int item, int lane) {
    const int nblk = (N + 31) / 32, kb = item / nblk, nb = item % nblk, k0 = 64 * kb, n0 = 32 * nb;
#pragma unroll 8
    for (int i = 0; i < 32; ++i) { const int kk = 2 * i + (lane >> 5), n = n0 + (lane & 31); scr[kk * 33 + (lane & 31)] = n < N ? W[(size_t)(k0 + kk) * N + n] : 0.f; }
    asm volatile("s_waitcnt lgkmcnt(0)" ::: "memory");
    const int c = lane & 7;
#pragma unroll
    for (int j = 0; j < 4; ++j) { const int n = (lane >> 3) + 8 * j; const float* s = scr + (8 * c) * 33 + n;
        v4u o; o.x = pk2(s[0 * 33], s[1 * 33]); o.y = pk2(s[2 * 33], s[3 * 33]); o.z = pk2(s[4 * 33], s[5 * 33]); o.w = pk2(s[6 * 33], s[7 * 33]);
        *(v4u*)(WT + (size_t)(n0 + n) * K + k0 + 8 * c) = o; }
    asm volatile("s_waitcnt lgkmcnt(0)" ::: "memory");
}
__device__ __forceinline__ void row_to_bf16(const float* __restrict__ xrow, bf16* __restrict__ orow, int lane) {
#pragma unroll
    for (int j = 0; j < 4; ++j) {
        f32x4 v = (f32x4){0.f, 0.f, 0.f, 0.f};
        if (xrow) v = ((const f32x4*)xrow)[lane + 64 * j];
        v2u o; o.x = pk2(v.x, v.y); o.y = pk2(v.z, v.w);
        ((v2u*)orow)[lane + 64 * j] = o;
    }
}

struct AbPrepArgs {
    const bf16* PROJ; const float* st_gdn_conv; const float* st_lru_conv;
    const float* gdn_conv_w; const float* a_log; const float* dt_bias;
    const float* lru_conv_w; const float* lru_conv_b; const float* w_r; const float* b_r; const float* w_i; const float* b_i; const float* lam;
    float* QKV; float* G; float* BETA; float* LA; float* LB;
    float* p_gdn_conv; float* p_lru_conv; float* s_gdn_conv; float* s_lru_conv;
};
__device__ __forceinline__ void ab_prep(const AbPrepArgs& a, int t, float* smem) {
    int tid = threadIdx.x; asm volatile("" : "+v"(tid));
    const int lane = tid & 63, wid = tid >> 6;
    const bool samp = t >= NP; const int sb = t - NP, pos = t % SEQ, b = t / SEQ;
    float* sq = smem;
    float* sx = smem + 1536;
    float* scl = smem + 2048;
    const bf16* prow = a.PROJ + (size_t)t * ABN;
    for (int c = tid; c < 1536; c += NTH) {
        float acc = 0.f;
#pragma unroll
        for (int i = 0; i < 4; ++i) {
            float xv;
            if (i == 3) xv = bf2f(prow[C_QKV + c]);
            else if (samp) xv = a.st_gdn_conv[((size_t)sb * 3 + i) * 1536 + c];
            else xv = (pos - 3 + i >= 0) ? bf2f(a.PROJ[(size_t)(t - 3 + i) * ABN + C_QKV + c]) : 0.f;
            acc += a.gdn_conv_w[i * 1536 + c] * xv;
        }
        sq[c] = siluf_(acc);
    }
    {
        const int c = tid;
        float acc = a.lru_conv_b[c];
#pragma unroll
        for (int i = 0; i < 4; ++i) {
            float xv;
            if (i == 3) xv = bf2f(prow[C_XR + c]);
            else if (samp) xv = a.st_lru_conv[((size_t)sb * 3 + i) * 512 + c];
            else xv = (pos - 3 + i >= 0) ? bf2f(a.PROJ[(size_t)(t - 3 + i) * ABN + C_XR + c]) : 0.f;
            acc += a.lru_conv_w[i * 512 + c] * xv;
        }
        sx[c] = acc;
    }
    __syncthreads();
    {
        const int grp = wid;
        const float v0 = sq[grp * 128 + lane], v1 = sq[grp * 128 + 64 + lane];
        const float s = wave_sum(v0 * v0 + v1 * v1);
        if (lane == 0) scl[grp] = rsqrtf(s + 1e-6f) * (grp < 4 ? 0.08838834764831845f : 1.0f);
    }
    __syncthreads();
    for (int c = tid; c < 1536; c += NTH) a.QKV[(size_t)t * 1536 + c] = (c < 1024) ? sq[c] * scl[c >> 7] : sq[c];
    if (tid < 4) {
        const float a_raw = bf2f(prow[C_A + tid]), b_raw = bf2f(prow[C_B + tid]);
        a.G[(size_t)t * 4 + tid] = -expf(a.a_log[tid]) * softplusf_(a_raw + a.dt_bias[tid]);
        a.BETA[(size_t)t * 4 + tid] = sigmoidf_(b_raw);
    }
    if (!samp) {
        if (pos >= SEQ - 3) {
            const int row = pos - (SEQ - 3);
            for (int c = tid; c < 1536; c += NTH) a.p_gdn_conv[((size_t)b * 3 + row) * 1536 + c] = bf2f(prow[C_QKV + c]);
            a.p_lru_conv[((size_t)b * 3 + row) * 512 + tid] = bf2f(prow[C_XR + tid]);
        }
    } else {
        for (int c = tid; c < 1536; c += NTH) {
            a.s_gdn_conv[((size_t)sb * 3 + 0) * 1536 + c] = a.st_gdn_conv[((size_t)sb * 3 + 1) * 1536 + c];
            a.s_gdn_conv[((size_t)sb * 3 + 1) * 1536 + c] = a.st_gdn_conv[((size_t)sb * 3 + 2) * 1536 + c];
            a.s_gdn_conv[((size_t)sb * 3 + 2) * 1536 + c] = bf2f(prow[C_QKV + c]);
        }
        {
            const int c = tid;
            a.s_lru_conv[((size_t)sb * 3 + 0) * 512 + c] = a.st_lru_conv[((size_t)sb * 3 + 1) * 512 + c];
            a.s_lru_conv[((size_t)sb * 3 + 1) * 512 + c] = a.st_lru_conv[((size_t)sb * 3 + 2) * 512 + c];
            a.s_lru_conv[((size_t)sb * 3 + 2) * 512 + c] = bf2f(prow[C_XR + c]);
        }
    }
    {
        const int c = tid, n = c >> 6, d = c & 63;
        float r = a.b_r[c], ii = a.b_i[c];
#pragma unroll 4
        for (int cc = 0; cc < 64; ++cc) {
            const float xv = sx[n * 64 + cc];
            r += xv * a.w_r[((size_t)n * 64 + cc) * 64 + d];
            ii += xv * a.w_i[((size_t)n * 64 + cc) * 64 + d];
        }
        r = sigmoidf_(r); ii = sigmoidf_(ii);
        const float log_a = -8.0f * r * softplusf_(-a.lam[c]);
        a.LA[(size_t)t * 512 + c] = expf(log_a);
        a.LB[(size_t)t * 512 + c] = sqrtf(-expm1f(2.0f * log_a)) * (ii * sx[c]);
    }
}

__device__ __forceinline__ void gdn_scan(const float* __restrict__ QKV, const float* __restrict__ G, const float* __restrict__ BETA,
                                         const float* __restrict__ S0, float* __restrict__ O, float* __restrict__ Sout, int tok_base, int T,
                                         int sl, int h, int sq, float* smem) {
    int tid = threadIdx.x; asm volatile("" : "+v"(tid));
    const int dvl = tid & 31, kg = tid >> 5;
    const int dv = sl * 32 + dvl;
    float (*red1)[32] = (float (*)[32])smem;
    float (*red2)[32] = (float (*)[32])(smem + 512);
    float S[8];
#pragma unroll
    for (int i = 0; i < 8; ++i) S[i] = S0 ? S0[(((size_t)sq * 4 + h) * 128 + kg * 8 + i) * 128 + dv] : 0.f;
    float kk[8], qq[8], vv, g, be;
    {
        const size_t tok = (size_t)tok_base + (size_t)sq * T;
        const float* row = QKV + tok * 1536;
#pragma unroll
        for (int i = 0; i < 8; ++i) { kk[i] = row[512 + h * 128 + kg * 8 + i]; qq[i] = row[h * 128 + kg * 8 + i]; }
        vv = row[1024 + h * 128 + dv]; g = G[tok * 4 + h]; be = BETA[tok * 4 + h];
    }
    for (int t = 0; t < T; ++t) {
        const size_t tok = (size_t)tok_base + (size_t)sq * T + t;
        float nk[8], nq[8], nv = 0.f, ng = 0.f, nb = 0.f;
        if (t + 1 < T) {
            const float* row = QKV + (tok + 1) * 1536;
#pragma unroll
            for (int i = 0; i < 8; ++i) { nk[i] = row[512 + h * 128 + kg * 8 + i]; nq[i] = row[h * 128 + kg * 8 + i]; }
            nv = row[1024 + h * 128 + dv]; ng = G[(tok + 1) * 4 + h]; nb = BETA[(tok + 1) * 4 + h];
        } else {
#pragma unroll
            for (int i = 0; i < 8; ++i) { nk[i] = 0.f; nq[i] = 0.f; }
        }
        const float al = expf(g);
        float p = 0.f;
#pragma unroll
        for (int i = 0; i < 8; ++i) { S[i] *= al; p += S[i] * kk[i]; }
        red1[kg][dvl] = p;
        __syncthreads();
        float ks = 0.f;
#pragma unroll
        for (int j = 0; j < 16; ++j) ks += red1[j][dvl];
        const float vn = be * (vv - ks);
        float o = 0.f;
#pragma unroll
        for (int i = 0; i < 8; ++i) { S[i] += kk[i] * vn; o += S[i] * qq[i]; }
        red2[kg][dvl] = o;
        __syncthreads();
        if (kg == 0) {
            float os = 0.f;
#pragma unroll
            for (int j = 0; j < 16; ++j) os += red2[j][dvl];
            O[tok * 512 + h * 128 + dv] = os;
        }
#pragma unroll
        for (int i = 0; i < 8; ++i) { kk[i] = nk[i]; qq[i] = nq[i]; }
        vv = nv; g = ng; be = nb;
    }
#pragma unroll
    for (int i = 0; i < 8; ++i) Sout[(((size_t)sq * 4 + h) * 128 + kg * 8 + i) * 128 + dv] = S[i];
}

__device__ __forceinline__ void lru_scan(const float* __restrict__ LA, float* __restrict__ LB, const float* __restrict__ h0,
                                         float* __restrict__ hlast, int tok_base, int T, int nseq, int bx) {
    int tx_ = threadIdx.x; asm volatile("" : "+v"(tx_));
    const int idx = bx * NTH + tx_;
    if (idx >= nseq * 512) return;
    const int sq = idx / 512, c = idx % 512;
    float h = h0 ? h0[(size_t)sq * 512 + c] : 0.f;
    const size_t base = ((size_t)tok_base + (size_t)sq * T) * 512 + c;
#pragma unroll 8
    for (int t = 0; t < T; ++t) {
        const size_t o = base + (size_t)t * 512;
        h = LA[o] * h + LB[o];
        LB[o] = h;
    }
    hlast[(size_t)sq * 512 + c] = h;
}

__device__ __forceinline__ void ab_mix_w(const bf16* __restrict__ PROJ, const float* __restrict__ O, const float* __restrict__ H, const float* __restrict__ P, const float* __restrict__ CIN,
                                         const float* __restrict__ norm_w, bf16* __restrict__ MIX, int t, int lane) {
    const bf16* prow = PROJ + (size_t)t * ABN;
    {
        const int c0 = lane * 8;
        const f32x4 o0 = *(const f32x4*)(O + (size_t)t * 512 + c0), o1 = *(const f32x4*)(O + (size_t)t * 512 + c0 + 4);
        const v4u zb = *(const v4u*)(prow + C_Z + c0);
        const f32x4 w0 = *(const f32x4*)(norm_w + (c0 & 127)), w1 = *(const f32x4*)(norm_w + (c0 & 127) + 4);
        float ss = (o0.x * o0.x + o0.y * o0.y) + (o0.z * o0.z + o0.w * o0.w) + (o1.x * o1.x + o1.y * o1.y) + (o1.z * o1.z + o1.w * o1.w);
        ss += DPPF(ss, 0xB1, 0xf); ss += DPPF(ss, 0x4E, 0xf); ss += DPPF(ss, 0x141, 0xf); ss += DPPF(ss, 0x140, 0xf);
        const float sc = rsqrtf(ss * (1.0f / 128.0f) + 1e-6f);
        const float z[8] = {bflo(zb.x), bfhi(zb.x), bflo(zb.y), bfhi(zb.y), bflo(zb.z), bfhi(zb.z), bflo(zb.w), bfhi(zb.w)};
        const float ov[8] = {o0.x, o0.y, o0.z, o0.w, o1.x, o1.y, o1.z, o1.w}, wv[8] = {w0.x, w0.y, w0.z, w0.w, w1.x, w1.y, w1.z, w1.w};
        float r[8];
#pragma unroll
        for (int i = 0; i < 8; ++i) r[i] = ov[i] * sc * wv[i] * (z[i] * __frcp_rn(1.0f + __expf(-z[i])));
        v4u ob; ob.x = pk2(r[0], r[1]); ob.y = pk2(r[2], r[3]); ob.z = pk2(r[4], r[5]); ob.w = pk2(r[6], r[7]);
        *(v4u*)(MIX + (size_t)t * 1024 + c0) = ob;
    }
    {
        const int c0 = lane * 8;
        const v4u gb = *(const v4u*)(prow + C_GATE + c0);
        f32x4 h0 = *(const f32x4*)(H + (size_t)t * 512 + c0), h1 = *(const f32x4*)(H + (size_t)t * 512 + c0 + 4);
        if (t < NP) {
            const f32x4 p0 = *(const f32x4*)(P + (size_t)t * 512 + c0), p1 = *(const f32x4*)(P + (size_t)t * 512 + c0 + 4);
            const f32x4 ci0 = *(const f32x4*)(CIN + (size_t)(t >> 6) * 512 + c0), ci1 = *(const f32x4*)(CIN + (size_t)(t >> 6) * 512 + c0 + 4);
            h0 = h0 + p0 * ci0; h1 = h1 + p1 * ci1;
        }
        const float gv[8] = {bflo(gb.x), bfhi(gb.x), bflo(gb.y), bfhi(gb.y), bflo(gb.z), bfhi(gb.z), bflo(gb.w), bfhi(gb.w)}, hv[8] = {h0.x, h0.y, h0.z, h0.w, h1.x, h1.y, h1.z, h1.w};
        float r[8];
#pragma unroll
        for (int i = 0; i < 8; ++i) r[i] = geluf_(gv[i]) * hv[i];
        v4u ob; ob.x = pk2(r[0], r[1]); ob.y = pk2(r[2], r[3]); ob.z = pk2(r[4], r[5]); ob.w = pk2(r[6], r[7]);
        *(v4u*)(MIX + (size_t)t * 1024 + 512 + c0) = ob;
    }
}

template <bool XBF>
__device__ __forceinline__ void ln_res_w(const void* __restrict__ xrow_, const bf16* __restrict__ yrow, const float* __restrict__ g, const float* __restrict__ bta,
                                         bf16* __restrict__ obrow, int lane) {
    f32x4 v[4]; float s = 0.f;
#pragma unroll
    for (int j = 0; j < 4; ++j) {
        f32x4 x4;
        if (XBF) { const v2u xb = ((const v2u*)xrow_)[lane + 64 * j]; x4 = (f32x4){bflo(xb.x), bfhi(xb.x), bflo(xb.y), bfhi(xb.y)}; }
        else x4 = ((const f32x4*)xrow_)[lane + 64 * j];
        const v2u yb = ((const v2u*)yrow)[lane + 64 * j];
        const f32x4 y4 = (f32x4){bflo(yb.x), bfhi(yb.x), bflo(yb.y), bfhi(yb.y)}; v[j] = x4 * ALPHA + y4; s += (v[j].x + v[j].y) + (v[j].z + v[j].w); }
    const float mean = wave_sum(s) * (1.0f / 1024.0f); float q = 0.f;
#pragma unroll
    for (int j = 0; j < 4; ++j) { v[j] = v[j] - mean; q += (v[j].x * v[j].x + v[j].y * v[j].y) + (v[j].z * v[j].z + v[j].w * v[j].w); }
    const float rs = rsqrtf(wave_sum(q) * (1.0f / 1024.0f) + LN_EPS);
#pragma unroll
    for (int j = 0; j < 4; ++j) {
        const f32x4 g4 = ((const f32x4*)g)[lane + 64 * j], b4 = ((const f32x4*)bta)[lane + 64 * j];
        const f32x4 o = v[j] * rs * g4 + b4;
        v2u ob; ob.x = pk2(o.x, o.y); ob.y = pk2(o.z, o.w);
        ((v2u*)obrow)[lane + 64 * j] = ob;
    }
}

__device__ __forceinline__ void peer_topk(const bf16* __restrict__ Q, const float* __restrict__ keys, int* __restrict__ EXP, float* __restrict__ GATE,
                                          int tg, int h, float* smem) {
    const int tid = threadIdx.x, cn = tid & 255, c = cn >> 7, n = cn & 127, th = tid >> 8;
    float (*sq)[256] = (float (*)[256])smem;
    float (*ss)[257] = (float (*)[257])(smem + 32 * 256);
    float (*tvs)[2][16] = (float (*)[2][16])(smem + 32 * 256 + 32 * 257 + 32);
    int (*tis)[2][16] = (int (*)[2][16])(smem + 32 * 256 + 32 * 257 + 32 + 1024);
    for (int i = tid; i < 32 * 256; i += NTH) {
        const int tk = i >> 8, col = i & 255;
        sq[tk][col] = bf2f(Q[(size_t)(tg * 32 + tk) * 2048 + h * 256 + col]);
    }
    __syncthreads();
    float acc[16];
#pragma unroll
    for (int i = 0; i < 16; ++i) acc[i] = 0.f;
    const float* krow = keys + (((size_t)h * 2 + c) * 128 + n) * 128;
    for (int d4 = 0; d4 < 32; ++d4) {
        const float4 kv = *(const float4*)(krow + d4 * 4);
#pragma unroll
        for (int tk = 0; tk < 16; ++tk) {
            const float4 qv = *(const float4*)&sq[th * 16 + tk][c * 128 + d4 * 4];
            acc[tk] += qv.x * kv.x + qv.y * kv.y + qv.z * kv.z + qv.w * kv.w;
        }
    }
#pragma unroll
    for (int tk = 0; tk < 16; ++tk) ss[th * 16 + tk][cn] = acc[tk];
    __syncthreads();
    if (tid < 64) {
        const int tk = tid >> 1, cc = tid & 1;
        float tv[16]; int ti[16];
#pragma unroll
        for (int j = 0; j < 16; ++j) { tv[j] = -INFINITY; ti[j] = 0; }
        for (int nn = 0; nn < 128; ++nn) {
            float x = ss[tk][cc * 128 + nn]; int xi = nn;
#pragma unroll
            for (int j = 0; j < 16; ++j) {
                const bool gt = x > tv[j];
                const float tf = tv[j]; const int tj = ti[j];
                tv[j] = gt ? x : tf; ti[j] = gt ? xi : tj;
                x = gt ? tf : x; xi = gt ? tj : xi;
            }
        }
#pragma unroll
        for (int j = 0; j < 16; ++j) { tvs[tk][cc][j] = tv[j]; tis[tk][cc][j] = ti[j]; }
    }
    __syncthreads();
    if (tid < 32) {
        const int tk = tid;
        float bv[16]; int bi[16];
#pragma unroll
        for (int j = 0; j < 16; ++j) { bv[j] = -INFINITY; bi[j] = 0; }
        for (int i = 0; i < 16; ++i)
            for (int jj = 0; jj < 16; ++jj) {
                float x = tvs[tk][0][i] + tvs[tk][1][jj]; int xi = tis[tk][0][i] * 128 + tis[tk][1][jj];
#pragma unroll
                for (int j = 0; j < 16; ++j) {
                    const bool gt = x > bv[j];
                    const float tf = bv[j]; const int tj = bi[j];
                    bv[j] = gt ? x : tf; bi[j] = gt ? xi : tj;
                    x = gt ? tf : x; xi = gt ? tj : xi;
                }
            }
        float e[16], sum = 0.f;
#pragma unroll
        for (int j = 0; j < 16; ++j) { e[j] = expf(bv[j] - bv[0]); sum += e[j]; }
        const float inv = 1.0f / sum;
        const size_t o = (size_t)(tg * 32 + tk) * 128 + h * 16;
#pragma unroll
        for (int j = 0; j < 16; ++j) { EXP[o + j] = bi[j]; GATE[o + j] = e[j] * inv; }
    }
}

__device__ __forceinline__ void peer_expert(const float* __restrict__ X, const int* __restrict__ EXP, const float* __restrict__ GATE,
                                            const float* __restrict__ U, const float* __restrict__ V,
                                            const float* __restrict__ g, const float* __restrict__ bta, float* __restrict__ out, bf16* __restrict__ outb, int t, float* smem) {
    const int tid = threadIdx.x, lane = tid & 63, wid = tid >> 6;
    float (*accs)[1024] = (float (*)[1024])smem;
    float* sred = smem + 8192;
    const float4* xr = (const float4*)(X + (size_t)t * D);
    float4 xv[4];
#pragma unroll
    for (int j = 0; j < 4; ++j) xv[j] = xr[lane + 64 * j];
    float4 acc[4];
#pragma unroll
    for (int j = 0; j < 4; ++j) acc[j] = make_float4(0.f, 0.f, 0.f, 0.f);
    for (int e = 0; e < 16; ++e) {
        const int id = EXP[(size_t)t * 128 + wid * 16 + e];
        const float gt = GATE[(size_t)t * 128 + wid * 16 + e];
        const float4* ur = (const float4*)(U + (size_t)id * D);
        const float4* vr = (const float4*)(V + (size_t)id * D);
        float4 uv[4], vv[4];
#pragma unroll
        for (int j = 0; j < 4; ++j) { uv[j] = ur[lane + 64 * j]; vv[j] = vr[lane + 64 * j]; }
        float dot = 0.f;
#pragma unroll
        for (int j = 0; j < 4; ++j) dot += uv[j].x * xv[j].x + uv[j].y * xv[j].y + uv[j].z * xv[j].z + uv[j].w * xv[j].w;
        dot = wave_sum(dot);
        const float cf = gt * geluf_(dot);
#pragma unroll
        for (int j = 0; j < 4; ++j) { acc[j].x += cf * vv[j].x; acc[j].y += cf * vv[j].y; acc[j].z += cf * vv[j].z; acc[j].w += cf * vv[j].w; }
    }
#pragma unroll
    for (int j = 0; j < 4; ++j) *(float4*)&accs[wid][(lane + 64 * j) * 4] = acc[j];
    __syncthreads();
    float v[2];
#pragma unroll
    for (int i = 0; i < 2; ++i) {
        const int c = tid * 2 + i;
        float s = 0.f;
#pragma unroll
        for (int w = 0; w < 8; ++w) s += accs[w][c];
        v[i] = ALPHA * X[(size_t)t * D + c] + s;
    }
    float s = wave_sum(v[0] + v[1]);
    if (lane == 0) sred[wid] = s;
    __syncthreads();
    float mean = 0.f;
#pragma unroll
    for (int w = 0; w < 8; ++w) mean += sred[w];
    mean *= (1.0f / 1024.0f);
    __syncthreads();
    const float d0 = v[0] - mean, d1 = v[1] - mean;
    float q = wave_sum(d0 * d0 + d1 * d1);
    if (lane == 0) sred[wid] = q;
    __syncthreads();
    float var = 0.f;
#pragma unroll
    for (int w = 0; w < 8; ++w) var += sred[w];
    const float rs = rsqrtf(var * (1.0f / 1024.0f) + LN_EPS);
    const float o0 = d0 * rs * g[tid * 2] + bta[tid * 2], o1 = d1 * rs * g[tid * 2 + 1] + bta[tid * 2 + 1];
    *(float2*)(out + (size_t)t * D + tid * 2) = make_float2(o0, o1);
    if (outb) *(unsigned*)(outb + (size_t)t * D + tid * 2) = pk2(o0, o1);
}


typedef __bf16 bf16x2_t __attribute__((ext_vector_type(2)));
__device__ __forceinline__ float dot2bf(unsigned w, unsigned x, float acc) { return __builtin_amdgcn_fdot2_f32_bf16(__builtin_bit_cast(bf16x2_t, w), __builtin_bit_cast(bf16x2_t, x), acc, false); }
typedef float f32x2_t __attribute__((ext_vector_type(2)));
__device__ __forceinline__ void row_to_fp8(const float* __restrict__ xrow, unsigned char* __restrict__ orow, float* __restrict__ scale, int lane) {
    f32x4 v[4]; float am = 0.f;
#pragma unroll
    for (int j = 0; j < 4; ++j) { v[j] = *(const f32x4*)(xrow + lane * 16 + j * 4); am = fmaxf(am, fmaxf(fmaxf(fabsf(v[j].x), fabsf(v[j].y)), fmaxf(fabsf(v[j].z), fabsf(v[j].w)))); }
    am = wave_max(am);
    const float s = am > 0.f ? am * (1.0f / 448.0f) : 1.0f, inv = 1.0f / s;
    v4u o;
    unsigned w;
    w = 0u; w = __builtin_amdgcn_cvt_pk_fp8_f32(v[0].x * inv, v[0].y * inv, w, false); w = __builtin_amdgcn_cvt_pk_fp8_f32(v[0].z * inv, v[0].w * inv, w, true); o.x = w;
    w = 0u; w = __builtin_amdgcn_cvt_pk_fp8_f32(v[1].x * inv, v[1].y * inv, w, false); w = __builtin_amdgcn_cvt_pk_fp8_f32(v[1].z * inv, v[1].w * inv, w, true); o.y = w;
    w = 0u; w = __builtin_amdgcn_cvt_pk_fp8_f32(v[2].x * inv, v[2].y * inv, w, false); w = __builtin_amdgcn_cvt_pk_fp8_f32(v[2].z * inv, v[2].w * inv, w, true); o.z = w;
    w = 0u; w = __builtin_amdgcn_cvt_pk_fp8_f32(v[3].x * inv, v[3].y * inv, w, false); w = __builtin_amdgcn_cvt_pk_fp8_f32(v[3].z * inv, v[3].w * inv, w, true); o.w = w;
    *(v4u*)(orow + lane * 16) = o;
    if (lane == 0) *scale = s;
}
#define PE_LOAD(UB, VB, grp) do { _Pragma("unroll") for (int i_ = 0; i_ < 4; ++i_) { const int e_ = (grp) * 4 + i_; \
        const int id_ = __builtin_amdgcn_readlane(e_ < 64 ? id0 : id1, e_ & 63); \
        const unsigned so_ = (unsigned)id_ * 1024u; \
        UB[i_] = __builtin_amdgcn_raw_buffer_load_b128(ursrc, voff, so_, 0); VB[i_] = __builtin_amdgcn_raw_buffer_load_b128(vrsrc, voff, so_, 0); } } while (0)
#define PE_DOT4(w, k) do { const f32x2_t l_ = __builtin_amdgcn_cvt_pk_f32_fp8((w), false), h_ = __builtin_amdgcn_cvt_pk_f32_fp8((w), true); \
        a_ += l_.x * xv[(k) * 4 + 0]; b_ += l_.y * xv[(k) * 4 + 1]; a_ += h_.x * xv[(k) * 4 + 2]; b_ += h_.y * xv[(k) * 4 + 3]; } while (0)
#define PE_AXPY4(w, k) do { const f32x2_t l_ = __builtin_amdgcn_cvt_pk_f32_fp8((w), false), h_ = __builtin_amdgcn_cvt_pk_f32_fp8((w), true); \
        acc[(k) * 4 + 0] += cf_ * l_.x; acc[(k) * 4 + 1] += cf_ * l_.y; acc[(k) * 4 + 2] += cf_ * h_.x; acc[(k) * 4 + 3] += cf_ * h_.y; } while (0)
#define PE_COMP(UB, VB, grp) do { float d_[4]; \
        _Pragma("unroll") for (int i_ = 0; i_ < 4; ++i_) { float a_ = 0.f, b_ = 0.f; PE_DOT4(UB[i_].x, 0); PE_DOT4(UB[i_].y, 1); PE_DOT4(UB[i_].z, 2); PE_DOT4(UB[i_].w, 3); d_[i_] = a_ + b_; } \
          \
        float s0_ = hi32 ? d_[2] : d_[0], t0_ = hi32 ? d_[0] : d_[2]; s0_ += __shfl_xor(t0_, 32); \
        float s1_ = hi32 ? d_[3] : d_[1], t1_ = hi32 ? d_[1] : d_[3]; s1_ += __shfl_xor(t1_, 32); \
        float r_ = hi16 ? s1_ : s0_, t2_ = hi16 ? s0_ : s1_; r_ += __shfl_xor(t2_, 16); \
        r_ += __shfl_xor(r_, 8); r_ += __shfl_xor(r_, 4); r_ += __shfl_xor(r_, 2); r_ += __shfl_xor(r_, 1); \
          \
        const int esel_ = (grp) * 4 + (lane >> 4); \
        const float su_ = __shfl(esel_ < 64 ? su0 : su1, esel_ & 63), gv_ = __shfl(esel_ < 64 ? gs0 : gs1, esel_ & 63); \
        const float cfl_ = geluf_(r_ * su_) * gv_; \
        _Pragma("unroll") for (int i_ = 0; i_ < 4; ++i_) { \
            const float cf_ = __uint_as_float(__builtin_amdgcn_readlane(__float_as_uint(cfl_), 16 * i_)); \
            PE_AXPY4(VB[i_].x, 0); PE_AXPY4(VB[i_].y, 1); PE_AXPY4(VB[i_].z, 2); PE_AXPY4(VB[i_].w, 3); } } while (0)
__device__ __forceinline__ void peer_expert_w(const float* __restrict__ xrow, const int* __restrict__ exr, const float* __restrict__ gar,
                                              const unsigned char* __restrict__ U, const unsigned char* __restrict__ V, const float* __restrict__ SU, const float* __restrict__ SV,
                                              const float* __restrict__ g, const float* __restrict__ bta, float* __restrict__ orow, bf16* __restrict__ obrow, int lane) {
    const bool hi32 = (lane & 32) != 0, hi16 = (lane & 16) != 0;
    const __amdgpu_buffer_rsrc_t ursrc = __builtin_amdgcn_make_buffer_rsrc((void*)U, 0, 16384 * 1024, 0x00020000);
    const __amdgpu_buffer_rsrc_t vrsrc = __builtin_amdgcn_make_buffer_rsrc((void*)V, 0, 16384 * 1024, 0x00020000);
    const int voff = lane * 16;
    float xv[16];
#pragma unroll
    for (int j = 0; j < 4; ++j) { const f32x4 t = *(const f32x4*)(xrow + lane * 16 + j * 4); xv[j * 4 + 0] = t.x; xv[j * 4 + 1] = t.y; xv[j * 4 + 2] = t.z; xv[j * 4 + 3] = t.w; }
    const int id0 = exr[lane], id1 = exr[64 + lane];
    const float su0 = SU[id0], su1 = SU[id1];
    const float gs0 = gar[lane] * SV[id0], gs1 = gar[64 + lane] * SV[id1];
    float acc[16];
#pragma unroll
    for (int i = 0; i < 16; ++i) acc[i] = 0.f;
    v4u ua[4], va[4], ub[4], vb[4];
    PE_LOAD(ua, va, 0);
#pragma unroll 1
    for (int grp = 0; grp < 32; grp += 2) {
        PE_LOAD(ub, vb, grp + 1);
        PE_COMP(ua, va, grp);
        if (grp + 2 < 32) PE_LOAD(ua, va, grp + 2);
        PE_COMP(ub, vb, grp + 1);
    }
    float v[16]; float s = 0.f;
#pragma unroll
    for (int i = 0; i < 16; ++i) { v[i] = ALPHA * xv[i] + acc[i]; s += v[i]; }
    const float mean = wave_sum(s) * (1.0f / 1024.0f); float q = 0.f;
#pragma unroll
    for (int i = 0; i < 16; ++i) { v[i] -= mean; q += v[i] * v[i]; }
    const float rs = rsqrtf(wave_sum(q) * (1.0f / 1024.0f) + LN_EPS);
    float o[16];
#pragma unroll
    for (int j = 0; j < 4; ++j) {
        const f32x4 g4 = *(const f32x4*)(g + lane * 16 + j * 4), b4 = *(const f32x4*)(bta + lane * 16 + j * 4);
        o[j * 4 + 0] = v[j * 4 + 0] * rs * g4.x + b4.x; o[j * 4 + 1] = v[j * 4 + 1] * rs * g4.y + b4.y; o[j * 4 + 2] = v[j * 4 + 2] * rs * g4.z + b4.z; o[j * 4 + 3] = v[j * 4 + 3] * rs * g4.w + b4.w;
        *(f32x4*)(orow + lane * 16 + j * 4) = (f32x4){o[j * 4 + 0], o[j * 4 + 1], o[j * 4 + 2], o[j * 4 + 3]};
    }
    if (obrow) {
        v4u w0, w1; w0.x = pk2(o[0], o[1]); w0.y = pk2(o[2], o[3]); w0.z = pk2(o[4], o[5]); w0.w = pk2(o[6], o[7]); w1.x = pk2(o[8], o[9]); w1.y = pk2(o[10], o[11]); w1.z = pk2(o[12], o[13]); w1.w = pk2(o[14], o[15]);
        *(v4u*)(obrow + lane * 16) = w0; *(v4u*)(obrow + lane * 16 + 8) = w1;
    }
}


__device__ __forceinline__ void peer_expert_blk(const float* __restrict__ xrow, const int* __restrict__ exr, const float* __restrict__ gar,
                                                const unsigned char* __restrict__ U, const unsigned char* __restrict__ V, const float* __restrict__ SU, const float* __restrict__ SV,
                                                const float* __restrict__ g, const float* __restrict__ bta, float* __restrict__ orow, bf16* __restrict__ obrow, int lane, int wave, float* smem) {
    const bool hi32 = (lane & 32) != 0, hi16 = (lane & 16) != 0;
    const __amdgpu_buffer_rsrc_t ursrc = __builtin_amdgcn_make_buffer_rsrc((void*)U, 0, 16384 * 1024, 0x00020000);
    const __amdgpu_buffer_rsrc_t vrsrc = __builtin_amdgcn_make_buffer_rsrc((void*)V, 0, 16384 * 1024, 0x00020000);
    const int voff = lane * 16;
    float xv[16];
#pragma unroll
    for (int j = 0; j < 4; ++j) { const f32x4 t = *(const f32x4*)(xrow + lane * 16 + j * 4); xv[j * 4 + 0] = t.x; xv[j * 4 + 1] = t.y; xv[j * 4 + 2] = t.z; xv[j * 4 + 3] = t.w; }
    const int id0 = exr[lane], id1 = exr[64 + lane];
    const float su0 = SU[id0], su1 = SU[id1];
    const float gs0 = gar[lane] * SV[id0], gs1 = gar[64 + lane] * SV[id1];
    float acc[16];
#pragma unroll
    for (int i = 0; i < 16; ++i) acc[i] = 0.f;
    v4u ua[4], va[4], ub[4], vb[4];
    const int g0 = wave * 4;
    PE_LOAD(ua, va, g0); PE_LOAD(ub, vb, g0 + 1);
    PE_COMP(ua, va, g0); PE_LOAD(ua, va, g0 + 2);
    PE_COMP(ub, vb, g0 + 1); PE_LOAD(ub, vb, g0 + 3);
    PE_COMP(ua, va, g0 + 2);
    PE_COMP(ub, vb, g0 + 3);
    float* accs = smem;
    float* sred = smem + 8192;
#pragma unroll
    for (int j = 0; j < 4; ++j) *(f32x4*)(accs + wave * 1024 + lane * 16 + j * 4) = (f32x4){acc[j * 4 + 0], acc[j * 4 + 1], acc[j * 4 + 2], acc[j * 4 + 3]};
    __syncthreads();
    const int tid = wave * 64 + lane;
    float v0 = ALPHA * xrow[tid * 2], v1 = ALPHA * xrow[tid * 2 + 1];
#pragma unroll
    for (int w = 0; w < 8; ++w) { v0 += accs[w * 1024 + tid * 2]; v1 += accs[w * 1024 + tid * 2 + 1]; }
    const float s = wave_sum(v0 + v1);
    if (lane == 0) sred[wave] = s;
    __syncthreads();
    float mean = 0.f;
#pragma unroll
    for (int w = 0; w < 8; ++w) mean += sred[w];
    mean *= (1.0f / 1024.0f);
    __syncthreads();
    const float d0 = v0 - mean, d1 = v1 - mean;
    const float q = wave_sum(d0 * d0 + d1 * d1);
    if (lane == 0) sred[wave] = q;
    __syncthreads();
    float var = 0.f;
#pragma unroll
    for (int w = 0; w < 8; ++w) var += sred[w];
    const float rs = rsqrtf(var * (1.0f / 1024.0f) + LN_EPS);
    const float o0 = d0 * rs * g[tid * 2] + bta[tid * 2], o1 = d1 * rs * g[tid * 2 + 1] + bta[tid * 2 + 1];
    *(float2*)(orow + tid * 2) = make_float2(o0, o1);
    if (obrow) *(unsigned*)(obrow + tid * 2) = pk2(o0, o1);
    __syncthreads();
}

__device__ __forceinline__ void row_to_fp8_sliced(const float* __restrict__ xrow, unsigned char* __restrict__ tab, int r, float* __restrict__ scale, int lane) {
    f32x4 v[4]; float am = 0.f;
#pragma unroll
    for (int j = 0; j < 4; ++j) { v[j] = *(const f32x4*)(xrow + lane * 16 + j * 4); am = fmaxf(am, fmaxf(fmaxf(fabsf(v[j].x), fabsf(v[j].y)), fmaxf(fabsf(v[j].z), fabsf(v[j].w)))); }
    am = wave_max(am);
    const float s = am > 0.f ? am * (1.0f / 448.0f) : 1.0f, inv = 1.0f / s;
    v4u o; unsigned w;
    w = 0u; w = __builtin_amdgcn_cvt_pk_fp8_f32(v[0].x * inv, v[0].y * inv, w, false); w = __builtin_amdgcn_cvt_pk_fp8_f32(v[0].z * inv, v[0].w * inv, w, true); o.x = w;
    w = 0u; w = __builtin_amdgcn_cvt_pk_fp8_f32(v[1].x * inv, v[1].y * inv, w, false); w = __builtin_amdgcn_cvt_pk_fp8_f32(v[1].z * inv, v[1].w * inv, w, true); o.y = w;
    w = 0u; w = __builtin_amdgcn_cvt_pk_fp8_f32(v[2].x * inv, v[2].y * inv, w, false); w = __builtin_amdgcn_cvt_pk_fp8_f32(v[2].z * inv, v[2].w * inv, w, true); o.z = w;
    w = 0u; w = __builtin_amdgcn_cvt_pk_fp8_f32(v[3].x * inv, v[3].y * inv, w, false); w = __builtin_amdgcn_cvt_pk_fp8_f32(v[3].z * inv, v[3].w * inv, w, true); o.w = w;
    *(v4u*)(tab + ((size_t)(lane >> 3) * 16384 + r) * 128 + (lane & 7) * 16) = o;
    if (lane == 0) *scale = s;
}
__device__ __forceinline__ void row_to_i8_sliced(const float* __restrict__ xrow, unsigned char* __restrict__ tab, int r, float* __restrict__ scale, int lane) {
    f32x4 v[4]; float am = 0.f;
#pragma unroll
    for (int j = 0; j < 4; ++j) { v[j] = *(const f32x4*)(xrow + lane * 16 + j * 4); am = fmaxf(am, fmaxf(fmaxf(fabsf(v[j].x), fabsf(v[j].y)), fmaxf(fabsf(v[j].z), fabsf(v[j].w)))); }
    am = wave_max(am);
    const float s = am > 0.f ? am * (1.0f / 127.0f) : 1.0f, inv = 1.0f / s;
    v4u o;
#define I8PK(q_) (((unsigned)(int)rintf((q_).x * inv) & 0xffu) | (((unsigned)(int)rintf((q_).y * inv) & 0xffu) << 8) | (((unsigned)(int)rintf((q_).z * inv) & 0xffu) << 16) | (((unsigned)(int)rintf((q_).w * inv) & 0xffu) << 24))
    o.x = I8PK(v[0]); o.y = I8PK(v[1]); o.z = I8PK(v[2]); o.w = I8PK(v[3]);
    *(v4u*)(tab + ((size_t)(lane >> 3) * 16384 + r) * 128 + (lane & 7) * 16) = o;
    if (lane == 0) *scale = s;
}
__device__ __forceinline__ void peer_u_pass(const bf16* __restrict__ xrow, const int* __restrict__ exr, const unsigned char* __restrict__ U8x, float* __restrict__ pd, int x, int lane) {
    const int e8 = lane >> 3, c = lane & 7;
    f32x2_t xp[8];
#pragma unroll
    for (int j = 0; j < 2; ++j) { const v4u t = *(const v4u*)(xrow + x * 128 + c * 16 + j * 8);
        xp[j * 4 + 0] = (f32x2_t){bflo(t.x), bfhi(t.x)}; xp[j * 4 + 1] = (f32x2_t){bflo(t.y), bfhi(t.y)}; xp[j * 4 + 2] = (f32x2_t){bflo(t.z), bfhi(t.z)}; xp[j * 4 + 3] = (f32x2_t){bflo(t.w), bfhi(t.w)}; }
    const __amdgpu_buffer_rsrc_t ursrc = __builtin_amdgcn_make_buffer_rsrc((void*)U8x, 0, 16384 * 128, 0x00020000);
    v4u wa[8], wb[8];
    float d[16];
    int ids[16];
#pragma unroll
    for (int j = 0; j < 4; ++j) { const v4u t = *(const v4u*)(exr + e8 * 16 + j * 4); ids[j * 4 + 0] = (int)t.x; ids[j * 4 + 1] = (int)t.y; ids[j * 4 + 2] = (int)t.z; ids[j * 4 + 3] = (int)t.w; }
#pragma unroll
    for (int g = 0; g < 8; ++g) wa[g] = __builtin_amdgcn_raw_buffer_load_b128(ursrc, ids[g] * 128 + c * 16, 0, 0);
#pragma unroll
    for (int g = 0; g < 8; ++g) wb[g] = __builtin_amdgcn_raw_buffer_load_b128(ursrc, ids[8 + g] * 128 + c * 16, 0, 0);
#define PU_DOT1(w_, k_) do { a_ = __builtin_elementwise_fma(__builtin_amdgcn_cvt_pk_f32_fp8((w_), false), xp[(k_) * 2], a_); a_ = __builtin_elementwise_fma(__builtin_amdgcn_cvt_pk_f32_fp8((w_), true), xp[(k_) * 2 + 1], a_); } while (0)
#pragma unroll
    for (int g = 0; g < 8; ++g) { f32x2_t a_ = (f32x2_t){0.f, 0.f}; PU_DOT1(wa[g].x, 0); PU_DOT1(wa[g].y, 1); PU_DOT1(wa[g].z, 2); PU_DOT1(wa[g].w, 3); d[g] = a_.x + a_.y; }
#pragma unroll
    for (int g = 0; g < 8; ++g) { f32x2_t a_ = (f32x2_t){0.f, 0.f}; PU_DOT1(wb[g].x, 0); PU_DOT1(wb[g].y, 1); PU_DOT1(wb[g].z, 2); PU_DOT1(wb[g].w, 3); d[8 + g] = a_.x + a_.y; }
#pragma unroll
    for (int g = 0; g < 16; ++g) { d[g] += DPPF(d[g], 0xB1, 0xf); d[g] += DPPF(d[g], 0x4E, 0xf); d[g] += DPPF(d[g], 0x141, 0xf); }
    if (c == 0) {
#pragma unroll
        for (int j = 0; j < 4; ++j) *(f32x4*)(pd + e8 * 16 + j * 4) = (f32x4){d[j * 4 + 0], d[j * 4 + 1], d[j * 4 + 2], d[j * 4 + 3]};
    }
}
#define PUL_IDS(I, k_) do { const int t_ = ((tg0 + ((k_) < nit ? (k_) : nit - 1) * tgstep) * 8 + wave); _Pragma("unroll") for (int j = 0; j < 4; ++j) I[j] = *(const v4u*)(EXPp + (size_t)t_ * 128 + e8 * 16 + j * 4); } while (0)
#define PUL_ROWS(R, X, I, k_) do { const int t_ = ((tg0 + ((k_) < nit ? (k_) : nit - 1) * tgstep) * 8 + wave); \
        X[0] = *(const v4u*)(XBp + (size_t)t_ * D + x * 128 + c * 16); X[1] = *(const v4u*)(XBp + (size_t)t_ * D + x * 128 + c * 16 + 8); \
        _Pragma("unroll") for (int j = 0; j < 4; ++j) { R[j * 4 + 0] = __builtin_amdgcn_raw_buffer_load_b128(ursrc, (int)I[j].x * 128 + c * 16, 0, 0); R[j * 4 + 1] = __builtin_amdgcn_raw_buffer_load_b128(ursrc, (int)I[j].y * 128 + c * 16, 0, 0); \
            R[j * 4 + 2] = __builtin_amdgcn_raw_buffer_load_b128(ursrc, (int)I[j].z * 128 + c * 16, 0, 0); R[j * 4 + 3] = __builtin_amdgcn_raw_buffer_load_b128(ursrc, (int)I[j].w * 128 + c * 16, 0, 0); } } while (0)
#define PUL_COMP(R, X, k_) do { float xf_[16]; \
        _Pragma("unroll") for (int j = 0; j < 2; ++j) { xf_[j * 8 + 0] = bflo(X[j].x); xf_[j * 8 + 1] = bfhi(X[j].x); xf_[j * 8 + 2] = bflo(X[j].y); xf_[j * 8 + 3] = bfhi(X[j].y); xf_[j * 8 + 4] = bflo(X[j].z); xf_[j * 8 + 5] = bfhi(X[j].z); xf_[j * 8 + 6] = bflo(X[j].w); xf_[j * 8 + 7] = bfhi(X[j].w); } \
          \
        float am_ = 0.f; _Pragma("unroll") for (int i = 0; i < 16; ++i) am_ = fmaxf(am_, fabsf(xf_[i])); \
        am_ = fmaxf(am_, DPPF(am_, 0xB1, 0xf)); am_ = fmaxf(am_, DPPF(am_, 0x4E, 0xf)); am_ = fmaxf(am_, DPPF(am_, 0x141, 0xf)); \
        const float sx_ = am_ > 0.f ? am_ * (1.0f / 127.0f) : 1.0f, ix_ = 1.0f / sx_; \
        int xq_[4]; \
        _Pragma("unroll") for (int j = 0; j < 4; ++j) xq_[j] = (int)(((unsigned)(int)rintf(xf_[j * 4 + 0] * ix_) & 0xffu) | (((unsigned)(int)rintf(xf_[j * 4 + 1] * ix_) & 0xffu) << 8) | (((unsigned)(int)rintf(xf_[j * 4 + 2] * ix_) & 0xffu) << 16) | (((unsigned)(int)rintf(xf_[j * 4 + 3] * ix_) & 0xffu) << 24)); \
        float d[16]; \
        _Pragma("unroll") for (int g = 0; g < 16; ++g) { int a_ = __builtin_amdgcn_sdot4((int)R[g].x, xq_[0], 0, false); a_ = __builtin_amdgcn_sdot4((int)R[g].y, xq_[1], a_, false); a_ = __builtin_amdgcn_sdot4((int)R[g].z, xq_[2], a_, false); a_ = __builtin_amdgcn_sdot4((int)R[g].w, xq_[3], a_, false); d[g] = (float)a_; } \
        _Pragma("unroll") for (int g = 0; g < 16; ++g) { d[g] += DPPF(d[g], 0xB1, 0xf); d[g] += DPPF(d[g], 0x4E, 0xf); d[g] += DPPF(d[g], 0x141, 0xf); d[g] *= sx_; } \
        if (c == 0 && (k_) < nit) { float* pd_ = PDx + (size_t)((tg0 + (k_) * tgstep) * 8 + wave) * 128 + e8 * 16; \
            _Pragma("unroll") for (int j = 0; j < 4; ++j) *(f32x4*)(pd_ + j * 4) = (f32x4){d[j * 4 + 0], d[j * 4 + 1], d[j * 4 + 2], d[j * 4 + 3]}; } } while (0)
__device__ __forceinline__ void peer_u_loop(const bf16* __restrict__ XBp, const int* __restrict__ EXPp, const unsigned char* __restrict__ U8x, float* __restrict__ PDx, int x, int tg0, int tgstep, int nit, int wave, int lane) {
    const int e8 = lane >> 3, c = lane & 7;
    const __amdgpu_buffer_rsrc_t ursrc = __builtin_amdgcn_make_buffer_rsrc((void*)U8x, 0, 16384 * 128, 0x00020000);
    v4u ra[16], rb[16], xa[2], xb[2], i0[4], i1[4];
    PUL_IDS(i0, 0);
    PUL_ROWS(ra, xa, i0, 0);
    PUL_IDS(i1, 1);
#pragma unroll 1
    for (int k = 0; k < nit; k += 2) {
        PUL_ROWS(rb, xb, i1, k + 1);
        PUL_IDS(i0, k + 2);
        PUL_COMP(ra, xa, k);
        PUL_ROWS(ra, xa, i0, k + 2);
        PUL_IDS(i1, k + 3);
        PUL_COMP(rb, xb, k + 1);
    }
}
#define PV_LOAD(VB, grp) do { _Pragma("unroll") for (int i_ = 0; i_ < 4; ++i_) { const int e_ = (grp) * 4 + i_; \
        const int id_ = __builtin_amdgcn_readlane(e_ < 64 ? id0 : id1, e_ & 63); \
        VB[i_] = __builtin_amdgcn_raw_buffer_load_b128(vrsrc, voff, (unsigned)id_ * 1024u, 0); } } while (0)
#define PV_COMP(VB, grp) do { _Pragma("unroll") for (int i_ = 0; i_ < 4; ++i_) { const int e_ = (grp) * 4 + i_; \
        const float cf_ = __uint_as_float(__builtin_amdgcn_readlane(__float_as_uint(e_ < 64 ? cf0 : cf1), e_ & 63)); \
        PE_AXPY4(VB[i_].x, 0); PE_AXPY4(VB[i_].y, 1); PE_AXPY4(VB[i_].z, 2); PE_AXPY4(VB[i_].w, 3); } } while (0)
#define PV_COEFS() \
    const int id0 = exr[lane], id1 = exr[64 + lane]; \
    float dot0 = 0.f, dot1 = 0.f; \
    { const int p0 = lane, p1 = 64 + lane;        \
      _Pragma("unroll") for (int x_ = 0; x_ < 8; ++x_) { dot0 += pdt[(size_t)x_ * NT * 128 + p0]; dot1 += pdt[(size_t)x_ * NT * 128 + p1]; } } \
    const float cf0 = gar[lane] * SV[id0] * geluf_(SU[id0] * dot0), cf1 = gar[64 + lane] * SV[id1] * geluf_(SU[id1] * dot1);
__device__ __forceinline__ void peer_v_w(const float* __restrict__ xrow, const int* __restrict__ exr, const float* __restrict__ gar, const float* __restrict__ pdt,
                                         const unsigned char* __restrict__ V, const float* __restrict__ SU, const float* __restrict__ SV,
                                         const float* __restrict__ g, const float* __restrict__ bta, float* __restrict__ orow, bf16* __restrict__ obrow, int lane) {
    const __amdgpu_buffer_rsrc_t vrsrc = __builtin_amdgcn_make_buffer_rsrc((void*)V, 0, 16384 * 1024, 0x00020000);
    const int voff = lane * 16;
    PV_COEFS()
    float acc[16];
#pragma unroll
    for (int i = 0; i < 16; ++i) acc[i] = 0.f;
    v4u va[4], vb[4], vc[4];
    PV_LOAD(va, 0); PV_LOAD(vb, 1);
#pragma unroll 1
    for (int grp = 0; grp < 30; grp += 3) {
        PV_LOAD(vc, grp + 2);
        PV_COMP(va, grp);
        PV_LOAD(va, grp + 3);
        PV_COMP(vb, grp + 1);
        PV_LOAD(vb, grp + 4);
        PV_COMP(vc, grp + 2);
    }
    PV_COMP(va, 30); PV_COMP(vb, 31);
    float xv[16];
#pragma unroll
    for (int j = 0; j < 4; ++j) { const f32x4 t = *(const f32x4*)(xrow + lane * 16 + j * 4); xv[j * 4 + 0] = t.x; xv[j * 4 + 1] = t.y; xv[j * 4 + 2] = t.z; xv[j * 4 + 3] = t.w; }
    float v[16]; float s = 0.f;
#pragma unroll
    for (int i = 0; i < 16; ++i) { v[i] = ALPHA * xv[i] + acc[i]; s += v[i]; }
    const float mean = wave_sum(s) * (1.0f / 1024.0f); float q = 0.f;
#pragma unroll
    for (int i = 0; i < 16; ++i) { v[i] -= mean; q += v[i] * v[i]; }
    const float rs = rsqrtf(wave_sum(q) * (1.0f / 1024.0f) + LN_EPS);
    float o[16];
#pragma unroll
    for (int j = 0; j < 4; ++j) {
        const f32x4 g4 = *(const f32x4*)(g + lane * 16 + j * 4), b4 = *(const f32x4*)(bta + lane * 16 + j * 4);
        o[j * 4 + 0] = v[j * 4 + 0] * rs * g4.x + b4.x; o[j * 4 + 1] = v[j * 4 + 1] * rs * g4.y + b4.y; o[j * 4 + 2] = v[j * 4 + 2] * rs * g4.z + b4.z; o[j * 4 + 3] = v[j * 4 + 3] * rs * g4.w + b4.w;
        *(f32x4*)(orow + lane * 16 + j * 4) = (f32x4){o[j * 4 + 0], o[j * 4 + 1], o[j * 4 + 2], o[j * 4 + 3]};
    }
    if (obrow) {
        v4u w0, w1; w0.x = pk2(o[0], o[1]); w0.y = pk2(o[2], o[3]); w0.z = pk2(o[4], o[5]); w0.w = pk2(o[6], o[7]); w1.x = pk2(o[8], o[9]); w1.y = pk2(o[10], o[11]); w1.z = pk2(o[12], o[13]); w1.w = pk2(o[14], o[15]);
        *(v4u*)(obrow + lane * 16) = w0; *(v4u*)(obrow + lane * 16 + 8) = w1;
    }
}
__device__ __forceinline__ void peer_v_blk(const float* __restrict__ xrow, const int* __restrict__ exr, const float* __restrict__ gar, const float* __restrict__ pdt,
                                           const unsigned char* __restrict__ V, const float* __restrict__ SU, const float* __restrict__ SV,
                                           const float* __restrict__ g, const float* __restrict__ bta, float* __restrict__ orow, bf16* __restrict__ obrow, int lane, int wave, float* smem) {
    const __amdgpu_buffer_rsrc_t vrsrc = __builtin_amdgcn_make_buffer_rsrc((void*)V, 0, 16384 * 1024, 0x00020000);
    const int voff = lane * 16;
    PV_COEFS()
    float acc[16];
#pragma unroll
    for (int i = 0; i < 16; ++i) acc[i] = 0.f;
    v4u va[4], vb[4], vc[4], vd[4];
    PV_LOAD(va, wave * 4); PV_LOAD(vb, wave * 4 + 1); PV_LOAD(vc, wave * 4 + 2); PV_LOAD(vd, wave * 4 + 3);
    PV_COMP(va, wave * 4); PV_COMP(vb, wave * 4 + 1); PV_COMP(vc, wave * 4 + 2); PV_COMP(vd, wave * 4 + 3);
    float* accs = smem;
    float* sred = smem + 8192;
#pragma unroll
    for (int j = 0; j < 4; ++j) *(f32x4*)(accs + wave * 1024 + lane * 16 + j * 4) = (f32x4){acc[j * 4 + 0], acc[j * 4 + 1], acc[j * 4 + 2], acc[j * 4 + 3]};
    __syncthreads();
    const int tid = wave * 64 + lane;
    float v0 = ALPHA * xrow[tid * 2], v1 = ALPHA * xrow[tid * 2 + 1];
#pragma unroll
    for (int w = 0; w < 8; ++w) { v0 += accs[w * 1024 + tid * 2]; v1 += accs[w * 1024 + tid * 2 + 1]; }
    const float s = wave_sum(v0 + v1);
    if (lane == 0) sred[wave] = s;
    __syncthreads();
    float mean = 0.f;
#pragma unroll
    for (int w = 0; w < 8; ++w) mean += sred[w];
    mean *= (1.0f / 1024.0f);
    __syncthreads();
    const float d0 = v0 - mean, d1 = v1 - mean;
    const float q = wave_sum(d0 * d0 + d1 * d1);
    if (lane == 0) sred[wave] = q;
    __syncthreads();
    float var = 0.f;
#pragma unroll
    for (int w = 0; w < 8; ++w) var += sred[w];
    const float rs = rsqrtf(var * (1.0f / 1024.0f) + LN_EPS);
    const float o0 = d0 * rs * g[tid * 2] + bta[tid * 2], o1 = d1 * rs * g[tid * 2 + 1] + bta[tid * 2 + 1];
    *(float2*)(orow + tid * 2) = make_float2(o0, o1);
    if (obrow) *(unsigned*)(obrow + tid * 2) = pk2(o0, o1);
    __syncthreads();
}

__device__ __forceinline__ void peer_xk(const int* __restrict__ exr, float* __restrict__ gar, const float* __restrict__ pdt, const float* __restrict__ SU, const float* __restrict__ SV, int lane) {
    PV_COEFS()
    gar[lane] = cf0; gar[64 + lane] = cf1;
}
__device__ __forceinline__ void peer_v_slice(const int* __restrict__ exr, const float* __restrict__ cfr, const unsigned char* __restrict__ V8x, float* __restrict__ outs  , int lane) {
    const int e8 = lane >> 3, c = lane & 7;
    const __amdgpu_buffer_rsrc_t vrsrc = __builtin_amdgcn_make_buffer_rsrc((void*)V8x, 0, 16384 * 128, 0x00020000);
    v4u wa[8], wb[8]; float cfa[8], cfb[8];
    int ids[16];
#pragma unroll
    for (int j = 0; j < 4; ++j) { const v4u t = *(const v4u*)(exr + e8 * 16 + j * 4); ids[j * 4 + 0] = (int)t.x; ids[j * 4 + 1] = (int)t.y; ids[j * 4 + 2] = (int)t.z; ids[j * 4 + 3] = (int)t.w; }
#pragma unroll
    for (int g = 0; g < 8; ++g) wa[g] = __builtin_amdgcn_raw_buffer_load_b128(vrsrc, ids[g] * 128 + c * 16, 0, 0);
#pragma unroll
    for (int g = 0; g < 8; ++g) wb[g] = __builtin_amdgcn_raw_buffer_load_b128(vrsrc, ids[8 + g] * 128 + c * 16, 0, 0);
#pragma unroll
    for (int j = 0; j < 2; ++j) { const f32x4 t = *(const f32x4*)(cfr + e8 * 16 + j * 4), u = *(const f32x4*)(cfr + e8 * 16 + 8 + j * 4);
        cfa[j * 4 + 0] = t.x; cfa[j * 4 + 1] = t.y; cfa[j * 4 + 2] = t.z; cfa[j * 4 + 3] = t.w; cfb[j * 4 + 0] = u.x; cfb[j * 4 + 1] = u.y; cfb[j * 4 + 2] = u.z; cfb[j * 4 + 3] = u.w; }
    f32x2_t ap[8];
#pragma unroll
    for (int i = 0; i < 8; ++i) ap[i] = (f32x2_t){0.f, 0.f};
#define PVS_AXPY(w_, k_) do { ap[(k_) * 2] = __builtin_elementwise_fma(cf2_, __builtin_amdgcn_cvt_pk_f32_fp8((w_), false), ap[(k_) * 2]); ap[(k_) * 2 + 1] = __builtin_elementwise_fma(cf2_, __builtin_amdgcn_cvt_pk_f32_fp8((w_), true), ap[(k_) * 2 + 1]); } while (0)
#pragma unroll
    for (int g = 0; g < 8; ++g) { const f32x2_t cf2_ = (f32x2_t){cfa[g], cfa[g]}; PVS_AXPY(wa[g].x, 0); PVS_AXPY(wa[g].y, 1); PVS_AXPY(wa[g].z, 2); PVS_AXPY(wa[g].w, 3); }
#pragma unroll
    for (int g = 0; g < 8; ++g) { const f32x2_t cf2_ = (f32x2_t){cfb[g], cfb[g]}; PVS_AXPY(wb[g].x, 0); PVS_AXPY(wb[g].y, 1); PVS_AXPY(wb[g].z, 2); PVS_AXPY(wb[g].w, 3); }
#undef PVS_AXPY
    float acc[16];
#pragma unroll
    for (int i = 0; i < 8; ++i) { acc[2 * i] = ap[i].x; acc[2 * i + 1] = ap[i].y; }
#pragma unroll
    for (int i = 0; i < 16; ++i) { float v = acc[i]; v += DPPF(v, 0x128, 0xf); v += __shfl_xor(v, 16); v += __shfl_xor(v, 32); acc[i] = v; }
    if (e8 == 0) {
#pragma unroll
        for (int j = 0; j < 4; ++j) *(f32x4*)(outs + c * 16 + j * 4) = (f32x4){acc[j * 4 + 0], acc[j * 4 + 1], acc[j * 4 + 2], acc[j * 4 + 3]};
    }
}
__device__ __forceinline__ void peer_xc(const bf16* __restrict__ xrow, const float* __restrict__ srow, const float* __restrict__ g, const float* __restrict__ bta, float* __restrict__ orow, bf16* __restrict__ obrow, bf16* __restrict__ obrow2, int lane) {
    float v[16]; float s = 0.f;
#pragma unroll
    for (int j = 0; j < 4; ++j) { const v2u ab = *(const v2u*)(xrow + lane * 16 + j * 4); const f32x4 b = *(const f32x4*)(srow + lane * 16 + j * 4);
        v[j * 4 + 0] = ALPHA * bflo(ab.x) + b.x; v[j * 4 + 1] = ALPHA * bfhi(ab.x) + b.y; v[j * 4 + 2] = ALPHA * bflo(ab.y) + b.z; v[j * 4 + 3] = ALPHA * bfhi(ab.y) + b.w; }
#pragma unroll
    for (int i = 0; i < 16; ++i) s += v[i];
    const float mean = wave_sum(s) * (1.0f / 1024.0f); float q = 0.f;
#pragma unroll
    for (int i = 0; i < 16; ++i) { v[i] -= mean; q += v[i] * v[i]; }
    const float rs = rsqrtf(wave_sum(q) * (1.0f / 1024.0f) + LN_EPS);
    float o[16];
#pragma unroll
    for (int j = 0; j < 4; ++j) {
        const f32x4 g4 = *(const f32x4*)(g + lane * 16 + j * 4), b4 = *(const f32x4*)(bta + lane * 16 + j * 4);
        o[j * 4 + 0] = v[j * 4 + 0] * rs * g4.x + b4.x; o[j * 4 + 1] = v[j * 4 + 1] * rs * g4.y + b4.y; o[j * 4 + 2] = v[j * 4 + 2] * rs * g4.z + b4.z; o[j * 4 + 3] = v[j * 4 + 3] * rs * g4.w + b4.w;
        if (orow) *(f32x4*)(orow + lane * 16 + j * 4) = (f32x4){o[j * 4 + 0], o[j * 4 + 1], o[j * 4 + 2], o[j * 4 + 3]};
    }
    if (obrow) {
        v4u w0, w1; w0.x = pk2(o[0], o[1]); w0.y = pk2(o[2], o[3]); w0.z = pk2(o[4], o[5]); w0.w = pk2(o[6], o[7]); w1.x = pk2(o[8], o[9]); w1.y = pk2(o[10], o[11]); w1.z = pk2(o[12], o[13]); w1.w = pk2(o[14], o[15]);
        *(v4u*)(obrow + lane * 16) = w0; *(v4u*)(obrow + lane * 16 + 8) = w1;
        if (obrow2) { *(v4u*)(obrow2 + lane * 16) = w0; *(v4u*)(obrow2 + lane * 16 + 8) = w1; }
    }
}

__device__ __forceinline__ int t5_bucket(int n) {
    if (n < 16) return n;
    const int large = 16 + (int)(logf((float)n / 16.0f) / 2.0794415416798357f * 16.0f);
    return large < 31 ? large : 31;
}
__device__ __forceinline__ void swa_attn(const float* __restrict__ PC, const float* __restrict__ cache_k, const float* __restrict__ cache_v,
                                         const float* __restrict__ rel_bias, const float* __restrict__ sinks, bf16* __restrict__ ATT, int bx) {
    const int tid = threadIdx.x, lane = tid & 63, wid = tid >> 6;
    const int gw = bx * 8 + wid;
    const int t = gw >> 4, h = gw & 15, kvh = h >> 2;
    if (t >= NT) return;
    const bool samp = t >= NP; const int sb = t - NP, pos = t % SEQ;
    const float* qrow = PC + (size_t)t * CN + h * 64;
    float lg[2]; bool valid[2];
#pragma unroll
    for (int rr = 0; rr < 2; ++rr) {
        const int r = lane + 64 * rr;
        const float* krow;
        if (!samp) { valid[rr] = (pos - r) >= 0; krow = PC + (size_t)(valid[rr] ? t - r : t) * CN + 1024 + kvh * 64; }
        else { valid[rr] = true; krow = (r == 0) ? PC + (size_t)t * CN + 1024 + kvh * 64 : cache_k + (((size_t)sb * 128 + (128 - r)) * 4 + kvh) * 64; }
        float dot = 0.f;
#pragma unroll
        for (int d4 = 0; d4 < 16; ++d4) {
            const float4 kv = *(const float4*)(krow + d4 * 4);
            const float4 qv = *(const float4*)(qrow + d4 * 4);
            dot += qv.x * kv.x + qv.y * kv.y + qv.z * kv.z + qv.w * kv.w;
        }
        lg[rr] = valid[rr] ? dot * 0.125f + rel_bias[t5_bucket(r) * 16 + h] : -INFINITY;
    }
    const float sink = sinks[h];
    const float m = fmaxf(wave_max(fmaxf(lg[0], lg[1])), sink);
    float p[2];
#pragma unroll
    for (int rr = 0; rr < 2; ++rr) p[rr] = valid[rr] ? expf(lg[rr] - m) : 0.f;
    const float den = wave_sum(p[0] + p[1]) + expf(sink - m);
    const float inv = 1.0f / den;
    float o = 0.f;
#pragma unroll
    for (int rr = 0; rr < 2; ++rr)
        for (int l2 = 0; l2 < 64; ++l2) {
            const int r = l2 + 64 * rr;
            const float pj = __shfl(p[rr], l2);
            if (pj != 0.f) {
                const float* vrow;
                if (!samp) vrow = PC + (size_t)(t - r) * CN + 1280 + kvh * 64;
                else vrow = (r == 0) ? PC + (size_t)t * CN + 1280 + kvh * 64 : cache_v + (((size_t)sb * 128 + (128 - r)) * 4 + kvh) * 64;
                o += pj * vrow[lane];
            }
        }
    ATT[(size_t)t * D + h * 64 + lane] = (bf16)f2bf(o * inv);
}

__device__ __forceinline__ void swa_kv_out(const float* __restrict__ PC, const float* __restrict__ cache_k, const float* __restrict__ cache_v,
                                           float* __restrict__ pk, float* __restrict__ pv, float* __restrict__ sk, float* __restrict__ sv, int vb) {
    const int c = threadIdx.x & 255, row = vb * 2 + (threadIdx.x >> 8);
    if (row < NB * 128) {
        const int b = row >> 7, i = row & 127;
        const float* src = PC + (size_t)(b * SEQ + SEQ - 128 + i) * CN;
        pk[(size_t)row * 256 + c] = src[1024 + c];
        pv[(size_t)row * 256 + c] = src[1280 + c];
    } else {
        const int r2 = row - NB * 128, sb = r2 >> 7, i = r2 & 127;
        if (i < 127) {
            sk[(size_t)r2 * 256 + c] = cache_k[((size_t)sb * 128 + i + 1) * 256 + c];
            sv[(size_t)r2 * 256 + c] = cache_v[((size_t)sb * 128 + i + 1) * 256 + c];
        } else {
            const float* src = PC + (size_t)(NP + sb) * CN;
            sk[(size_t)r2 * 256 + c] = src[1024 + c];
            sv[(size_t)r2 * 256 + c] = src[1280 + c];
        }
    }
}
#define XB_TMO      128
#define XB_XCNT(j)  (256  + 64 * (j))
#define XB_XSUB(j)  (1280 + 64 * (j))
#define XB_XGEN(j)  (2304 + 64 * (j))
#define XB_TOP      3328
#define XB_TOPGEN   3392
#define XCD_BAR_WORDS 3456
#define XB_SPIN_CAP (1u << 18)

__device__ __forceinline__ unsigned xb_ld(unsigned* p)              { return __hip_atomic_load(p, __ATOMIC_RELAXED, __HIP_MEMORY_SCOPE_AGENT); }
__device__ __forceinline__ unsigned xb_add(unsigned* p, unsigned v) { return __hip_atomic_fetch_add(p, v, __ATOMIC_RELAXED, __HIP_MEMORY_SCOPE_AGENT); }
__device__ __forceinline__ unsigned xb_xcc_id() { return (unsigned)__builtin_amdgcn_s_getreg((3 << 11) | 20) & 0xFu; }
#define XB_SPIN(cond, bar) do { unsigned _sp = 0; while (cond) { __builtin_amdgcn_s_sleep(1); \
    if ((++_sp & 255u) == 0u) { if (xb_ld(&(bar)[XB_TMO])) break; if (_sp > XB_SPIN_CAP) { atomicAdd(&(bar)[XB_TMO], 1u); break; } } } } while (0)

struct XcdBarrier {
    unsigned* bar; unsigned x;
    volatile LAS unsigned* st;
};

__device__ __forceinline__ XcdBarrier xcd_barrier_post(unsigned* bar, volatile LAS unsigned* st) {
    XcdBarrier b; b.bar = bar; b.x = xb_xcc_id(); b.st = st;
    if (threadIdx.x == 0) (void)xb_add(&bar[XB_XCNT(b.x)], 1u);
    return b;
}
__device__ __forceinline__ void xcd_barrier_complete(unsigned* bar, unsigned x, unsigned& nloc, unsigned& nx) {
    const unsigned G = gridDim.x * gridDim.y * gridDim.z;
    unsigned sum, cnt, mine, sp = 0u;
    for (;;) {
        sum = 0u; cnt = 0u; mine = 0u;
#pragma unroll
        for (unsigned j = 0; j < 16; ++j) { const unsigned c = xb_ld(&bar[XB_XCNT(j)]); sum += c; cnt += (c > 0u) ? 1u : 0u; mine = (j == x) ? c : mine; }
        if (sum == G) break;
        __builtin_amdgcn_s_sleep(1);
        if ((++sp & 255u) == 0u) { if (xb_ld(&bar[XB_TMO])) break; if (sp > XB_SPIN_CAP) { atomicAdd(&bar[XB_TMO], 1u); break; } }
    }
    nloc = mine > 0u ? mine : 1u; nx = cnt > 0u ? cnt : 1u;
}

__device__ __forceinline__ void xcd_barrier(const XcdBarrier& b) {
    asm volatile("s_waitcnt vmcnt(0)" ::: "memory");
    __syncthreads();
    if (threadIdx.x == 0) {
        unsigned* bar = b.bar;
        __builtin_amdgcn_s_waitcnt(0);
        unsigned nloc = b.st[0], nx = b.st[1];
        if (nloc == 0u) { xcd_barrier_complete(bar, b.x, nloc, nx); b.st[0] = nloc; b.st[1] = nx; }
        const unsigned old = xb_add(&bar[XB_XSUB(b.x)], 1u);
        const unsigned gen = old / nloc;
        if (old + 1u == (gen + 1u) * nloc) {
            __builtin_amdgcn_fence(__ATOMIC_RELEASE, "agent");
            asm volatile("s_waitcnt vmcnt(0)" ::: "memory");
            const unsigned og = xb_add(&bar[XB_TOP], 1u);
            const unsigned tg = og / nx;
            if (og + 1u == (tg + 1u) * nx) xb_add(&bar[XB_TOPGEN], 1u);
            else XB_SPIN(xb_ld(&bar[XB_TOPGEN]) == tg, bar);
            __builtin_amdgcn_fence(__ATOMIC_ACQUIRE, "agent");
            xb_add(&bar[XB_XGEN(b.x)], 1u);
            asm volatile("s_waitcnt vmcnt(0)" ::: "memory");
        } else {
            XB_SPIN(xb_ld(&bar[XB_XGEN(b.x)]) == gen, bar);
            __builtin_amdgcn_fence(__ATOMIC_ACQUIRE, "agent");
            asm volatile("s_waitcnt vmcnt(0)" ::: "memory");
        }
    }
    __syncthreads();
}

typedef short bf16x8_t __attribute__((ext_vector_type(8)));
__device__ __forceinline__ f32x4 mfma16(bf16x8_t a, bf16x8_t b, f32x4 c) { return __builtin_amdgcn_mfma_f32_16x16x32_bf16(a, b, c, 0, 0, 0); }

struct GdnChunkBufs {
    bf16* W;
    bf16* QG;
    bf16* KDT;
    bf16* UT;
    bf16* QK;
    float* EGL;
};

constexpr int GP_QB = 0, GP_KB = 17408, GP_VB = 34816, GP_LS = 52224, GP_QKS = 69632, GP_WS = 78848, GP_SC = 96256;

__device__ __forceinline__ void gdn_prep_unit(const bf16* __restrict__ PROJ, const float* __restrict__ conv_w, const float* __restrict__ a_log, const float* __restrict__ dt_bias,
                                              const GdnChunkBufs& cb, float* __restrict__ p_gdn_conv, int un, unsigned char* lds) {
    int tid = threadIdx.x; asm volatile("" : "+v"(tid));
    const int lane = tid & 63, wave = __builtin_amdgcn_readfirstlane(tid >> 6), fr = lane & 15, fq = lane >> 4;
    const int h = un & 3, n = (un >> 2) & 63, b = un >> 8;
    const int t0 = b * SEQ + n * 64;
    bf16* Qb = (bf16*)(lds + GP_QB); bf16* Kb = (bf16*)(lds + GP_KB); bf16* Vb = (bf16*)(lds + GP_VB); bf16* Ws = (bf16*)(lds + GP_WS);
    float* Ls = (float*)(lds + GP_LS); bf16* QKs = (bf16*)(lds + GP_QKS);
    float* gcs = (float*)(lds + GP_SC); float* bets = gcs + 64; float* egcs = gcs + 128; float* ekds = gcs + 192; float* begs = gcs + 256;
    if (wave == 0) {
        const bf16* prow = PROJ + (size_t)(t0 + lane) * ABN;
        const float a_raw = bf2f(prow[C_A + h]), b_raw = bf2f(prow[C_B + h]);
        float g = -expf(a_log[h]) * softplusf_(a_raw + dt_bias[h]);
#pragma unroll
        for (int off = 1; off < 64; off <<= 1) { const float v = __shfl_up(g, off); if (lane >= off) g += v; }
        const float glast = __shfl(g, 63);
        { const float be_ = sigmoidf_(b_raw), eg_ = expf(g); gcs[lane] = g; bets[lane] = be_; egcs[lane] = eg_; ekds[lane] = expf(glast - g); begs[lane] = be_ * eg_; }
        if (lane == 0) cb.EGL[un] = expf(glast);
    }
    {
        int cols[6]; float cw[4][6], xw[3][6];
#pragma unroll
        for (int p = 0; p < 3; ++p)
#pragma unroll
            for (int e = 0; e < 2; ++e) cols[p * 2 + e] = p * 512 + h * 128 + e * 64 + lane;
#pragma unroll
        for (int i = 0; i < 4; ++i)
#pragma unroll
            for (int c = 0; c < 6; ++c) cw[i][c] = conv_w[i * 1536 + cols[c]];
        const int i0 = wave * 8;
#pragma unroll
        for (int k = 0; k < 3; ++k) {
            const int pos = n * 64 + i0 - 3 + k;
#pragma unroll
            for (int c = 0; c < 6; ++c) xw[k][c] = pos >= 0 ? bf2f(PROJ[(size_t)(t0 + i0 - 3 + k) * ABN + cols[c]]) : 0.f;
        }
        bf16 xraw[8][6];
#pragma unroll
        for (int ii = 0; ii < 8; ++ii)
#pragma unroll
            for (int c = 0; c < 6; ++c) xraw[ii][c] = PROJ[(size_t)(t0 + i0 + ii) * ABN + cols[c]];
#pragma unroll
        for (int ii = 0; ii < 8; ++ii) {
            const int i = i0 + ii;
            float xt[6], s[6];
#pragma unroll
            for (int c = 0; c < 6; ++c) xt[c] = bf2f(xraw[ii][c]);
#pragma unroll
            for (int c = 0; c < 6; ++c) { const float y_ = cw[0][c] * xw[0][c] + cw[1][c] * xw[1][c] + cw[2][c] * xw[2][c] + cw[3][c] * xt[c]; s[c] = y_ * __frcp_rn(1.0f + __expf(-y_)); }
            const float qs = rsqrtf(wave_sum(s[0] * s[0] + s[1] * s[1]) + 1e-6f) * 0.08838834764831845f;
            const float ks = rsqrtf(wave_sum(s[2] * s[2] + s[3] * s[3]) + 1e-6f);
            Qb[i * 136 + lane] = (bf16)f2bf(s[0] * qs); Qb[i * 136 + 64 + lane] = (bf16)f2bf(s[1] * qs);
            Kb[i * 136 + lane] = (bf16)f2bf(s[2] * ks); Kb[i * 136 + 64 + lane] = (bf16)f2bf(s[3] * ks);
            Vb[i * 136 + lane] = (bf16)f2bf(s[4]);      Vb[i * 136 + 64 + lane] = (bf16)f2bf(s[5]);
            if (n == 63 && i >= 61) {
#pragma unroll
                for (int c = 0; c < 6; ++c) p_gdn_conv[((size_t)b * 3 + (i - 61)) * 1536 + cols[c]] = xt[c];
            }
#pragma unroll
            for (int c = 0; c < 6; ++c) { xw[0][c] = xw[1][c]; xw[1][c] = xw[2][c]; xw[2][c] = xt[c]; }
        }
    }
    __syncthreads();
    {
        const int mi = wave >> 1;
        bf16x8_t aK[4], aQ[4];
#pragma unroll
        for (int ks = 0; ks < 4; ++ks) { aK[ks] = *(const bf16x8_t*)(Kb + (mi * 16 + fr) * 136 + ks * 32 + 8 * fq); aQ[ks] = *(const bf16x8_t*)(Qb + (mi * 16 + fr) * 136 + ks * 32 + 8 * fq); }
#pragma unroll
        for (int nn = 0; nn < 2; ++nn) {
            const int nj = (wave & 1) * 2 + nn;
            f32x4 accK = (f32x4){0.f, 0.f, 0.f, 0.f}, accQ = accK;
#pragma unroll
            for (int ks = 0; ks < 4; ++ks) { const bf16x8_t bk = *(const bf16x8_t*)(Kb + (nj * 16 + fr) * 136 + ks * 32 + 8 * fq); accK = mfma16(aK[ks], bk, accK); accQ = mfma16(aQ[ks], bk, accQ); }
            const int j = nj * 16 + fr; const float gj = gcs[j];
#pragma unroll
            for (int r = 0; r < 4; ++r) {
                const int i = mi * 16 + 4 * fq + r;
                const float dec = i >= j ? expf(gcs[i] - gj) : 0.f;
                Ls[j * 68 + i] = i > j ? bets[i] * accK[r] * dec : 0.f;
                QKs[i * 72 + j] = (bf16)f2bf(i >= j ? accQ[r] * dec : 0.f);
            }
        }
    }
    __syncthreads();
    if (wave < 4) {
        float x[64];
        const bool isu = tid < 128; const int c = isu ? tid : tid - 128;
        const LAS unsigned char* l3 = (const LAS unsigned char*)lds;
        unsigned so = (isu ? GP_VB : GP_KB) + c * 2, ro = GP_SC + (isu ? 64 * 4 : 256 * 4), lo = GP_LS;
        asm volatile("" : "+v"(so), "+v"(ro), "+v"(lo));
#pragma unroll
        for (int i = 0; i < 64; ++i) x[i] = *(const LAS float*)(l3 + ro + 4 * i) * bf2f(*(const LAS bf16*)(l3 + so + i * 272));
#pragma unroll
        for (int j = 0; j < 63; ++j) {
#pragma unroll
            for (int i4 = (j + 1) / 4; i4 < 16; ++i4) {
                const f32x4 l4 = *(const LAS f32x4*)(l3 + lo + j * 272 + i4 * 16);
                if (i4 * 4 + 0 > j) x[i4 * 4 + 0] -= l4.x * x[j];
                if (i4 * 4 + 1 > j) x[i4 * 4 + 1] -= l4.y * x[j];
                if (i4 * 4 + 2 > j) x[i4 * 4 + 2] -= l4.z * x[j];
                if (i4 * 4 + 3 > j) x[i4 * 4 + 3] -= l4.w * x[j];
            }
        }
        if (isu) {
            bf16* dst = cb.UT + ((size_t)un * 128 + c) * 64;
#pragma unroll
            for (int i8 = 0; i8 < 8; ++i8) { v4u o; o.x = pk2(x[i8 * 8 + 0], x[i8 * 8 + 1]); o.y = pk2(x[i8 * 8 + 2], x[i8 * 8 + 3]); o.z = pk2(x[i8 * 8 + 4], x[i8 * 8 + 5]); o.w = pk2(x[i8 * 8 + 6], x[i8 * 8 + 7]); *(v4u*)(dst + i8 * 8) = o; }
        } else {
#pragma unroll
            for (int i = 0; i < 64; ++i) Ws[i * 136 + c] = (bf16)f2bf(x[i]);
        }
    } else {
        const int t2 = tid - 256;
#pragma unroll
        for (int k = 0; k < 4; ++k) {
            const int ci = t2 + 256 * k, i = ci >> 4, d0 = (ci & 15) * 8; const float e = egcs[i];
            const v4u q = *(const v4u*)(Qb + i * 136 + d0);
            v4u o; o.x = pk2(bflo(q.x) * e, bfhi(q.x) * e); o.y = pk2(bflo(q.y) * e, bfhi(q.y) * e); o.z = pk2(bflo(q.z) * e, bfhi(q.z) * e); o.w = pk2(bflo(q.w) * e, bfhi(q.w) * e);
            *(v4u*)(cb.QG + ((size_t)un * 64 + i) * 128 + d0) = o;
        }
#pragma unroll
        for (int k = 0; k < 4; ++k) {
            const int ci = t2 + 256 * k, d = ci & 127, i0 = (ci >> 7) * 8;
            float v[8];
#pragma unroll
            for (int q = 0; q < 8; ++q) v[q] = bf2f(Kb[(i0 + q) * 136 + d]) * ekds[i0 + q];
            v4u o; o.x = pk2(v[0], v[1]); o.y = pk2(v[2], v[3]); o.z = pk2(v[4], v[5]); o.w = pk2(v[6], v[7]);
            *(v4u*)(cb.KDT + ((size_t)un * 128 + d) * 64 + i0) = o;
        }
#pragma unroll
        for (int k = 0; k < 2; ++k) {
            const int ci = t2 + 256 * k, i = ci >> 3, j0 = (ci & 7) * 8;
            *(v4u*)(cb.QK + ((size_t)un * 64 + i) * 64 + j0) = *(const v4u*)(QKs + i * 72 + j0);
        }
    }
    __syncthreads();
#pragma unroll
    for (int k = 0; k < 2; ++k) {
        const int ci = tid + 512 * k, i = ci >> 4, d0 = (ci & 15) * 8;
        *(v4u*)(cb.W + ((size_t)un * 64 + i) * 128 + d0) = *(const v4u*)(Ws + i * 136 + d0);
    }
    __syncthreads();
}

constexpr int GS_ST = 0, GS_VNT = 2 * 32 * 136 * 2, GS_END = GS_VNT + 32 * 72 * 2;
template <int N0, int N1>
__device__ __forceinline__ void gdn_seq(const GdnChunkBufs& cb, float* __restrict__ O, float* __restrict__ Sout, int b, int h, int sl, unsigned char* lds, f32x4 (&accS)[2], int& cur) {
    int tid = threadIdx.x; asm volatile("" : "+v"(tid));
    const int lane = tid & 63, wave = __builtin_amdgcn_readfirstlane(tid >> 6), fr = lane & 15, fq = lane >> 4;
    const int mi = wave >> 1, nj = wave & 1;
    bf16* St = (bf16*)(lds + GS_ST); bf16* VnT = (bf16*)(lds + GS_VNT);
    float* egls = (float*)(lds + GS_END);
    if (N0 == 0) {
        for (int i = tid; i < 2 * 32 * 136 / 2; i += NTH) ((unsigned*)St)[i] = 0u;
        accS[0] = (f32x4){0.f, 0.f, 0.f, 0.f}; accS[1] = accS[0]; cur = 0;
    }
    if (tid >= N0 && tid < N1) egls[tid] = cb.EGL[(size_t)((b * 64 + tid) * 4 + h)];
    __syncthreads();
#define GS_DECL(X) bf16x8_t aW##X[4], aQG##X[4], aQK##X[2], aKD##X[2]; v2u ut##X;
    GS_DECL(0) GS_DECL(1) GS_DECL(2)
#define GS_GLD16(dst, ptr) asm volatile("global_load_dwordx4 %0, %1, off" : "=v"(dst) : "v"(ptr))
#define GS_GLD8(dst, ptr) asm volatile("global_load_dwordx2 %0, %1, off" : "=v"(dst) : "v"(ptr))
#define GS_LOAD(X, n_) do { const size_t u_ = (size_t)((b * 64 + ((n_) < 63 ? (n_) : 63)) * 4 + h);     \
        _Pragma("unroll") for (int ks = 0; ks < 4; ++ks) { GS_GLD16(aW##X[ks], cb.W + (u_ * 64 + mi * 16 + fr) * 128 + ks * 32 + 8 * fq); GS_GLD16(aQG##X[ks], cb.QG + (u_ * 64 + mi * 16 + fr) * 128 + ks * 32 + 8 * fq); } \
        _Pragma("unroll") for (int ks = 0; ks < 2; ++ks) { GS_GLD16(aQK##X[ks], cb.QK + (u_ * 64 + mi * 16 + fr) * 64 + ks * 32 + 8 * fq); GS_GLD16(aKD##X[ks], cb.KDT + (u_ * 128 + wave * 16 + fr) * 64 + ks * 32 + 8 * fq); } \
        GS_GLD8(ut##X, cb.UT + (u_ * 128 + sl * 32 + nj * 16 + fr) * 64 + mi * 16 + 4 * fq); } while (0)
#define GS_WAITN(X, N) asm volatile("s_waitcnt vmcnt(" #N ")" : "+v"(aW##X[0]), "+v"(aW##X[1]), "+v"(aW##X[2]), "+v"(aW##X[3]), "+v"(aQG##X[0]), "+v"(aQG##X[1]), "+v"(aQG##X[2]), "+v"(aQG##X[3]), \
        "+v"(aQK##X[0]), "+v"(aQK##X[1]), "+v"(aKD##X[0]), "+v"(aKD##X[1]), "+v"(ut##X))
#define GS_WAIT(X, n_) GS_WAITN(X, 26)
#define GS_STEP(X, n_) do { \
        const float egl##X = egls[(n_)]; \
        GS_WAIT(X, n_); \
        __syncthreads();                                        \
        f32x4 accW = (f32x4){0.f, 0.f, 0.f, 0.f}, accO = accW; \
        const bf16* Sc = St + cur * 32 * 136; \
        _Pragma("unroll") for (int ks = 0; ks < 4; ++ks) { const bf16x8_t bs = *(const bf16x8_t*)(Sc + (nj * 16 + fr) * 136 + ks * 32 + 8 * fq); accW = mfma16(aW##X[ks], bs, accW); accO = mfma16(aQG##X[ks], bs, accO); } \
          \
        const float v0 = bflo(ut##X.x) - accW[0], v1 = bfhi(ut##X.x) - accW[1], v2 = bflo(ut##X.y) - accW[2], v3 = bfhi(ut##X.y) - accW[3]; \
        { v2u o; o.x = pk2(v0, v1); o.y = pk2(v2, v3); *(v2u*)(VnT + (nj * 16 + fr) * 72 + mi * 16 + 4 * fq) = o; } \
        __syncthreads();                                        \
        _Pragma("unroll") for (int ks = 0; ks < 2; ++ks) { const bf16x8_t bv = *(const bf16x8_t*)(VnT + (nj * 16 + fr) * 72 + ks * 32 + 8 * fq); accO = mfma16(aQK##X[ks], bv, accO); } \
        { float* orow = O + (size_t)(b * SEQ + (n_) * 64 + mi * 16 + 4 * fq) * 512 + h * 128 + sl * 32 + nj * 16 + fr; \
          orow[0] = accO[0]; orow[512] = accO[1]; orow[1024] = accO[2]; orow[1536] = accO[3]; } \
          \
        bf16* Sn = St + (cur ^ 1) * 32 * 136; \
        _Pragma("unroll") for (int njj = 0; njj < 2; ++njj) { \
            accS[njj] = accS[njj] * egl##X; \
            _Pragma("unroll") for (int ks = 0; ks < 2; ++ks) { const bf16x8_t bv = *(const bf16x8_t*)(VnT + (njj * 16 + fr) * 72 + ks * 32 + 8 * fq); accS[njj] = mfma16(aKD##X[ks], bv, accS[njj]); } \
            v2u o; o.x = pk2(accS[njj][0], accS[njj][1]); o.y = pk2(accS[njj][2], accS[njj][3]); \
            *(v2u*)(Sn + (njj * 16 + fr) * 136 + wave * 16 + 4 * fq) = o; } \
        cur ^= 1; } while (0)
    constexpr int NTRI = (N1 - N0) / 3, NREM = (N1 - N0) % 3, NM = N0 + 3 * NTRI;
    GS_LOAD(0, N0); GS_LOAD(1, N0 + 1);
#pragma unroll 1
    for (int n = N0; n < NM; n += 3) {
        GS_LOAD(2, n + 2);
        GS_STEP(0, n);
        GS_LOAD(0, n + 3);
        GS_STEP(1, n + 1);
        GS_LOAD(1, n + 4);
        GS_STEP(2, n + 2);
    }
    if (NREM >= 1) { GS_LOAD(2, NM + 2); GS_STEP(0, NM); }
    if (NREM == 2) { GS_LOAD(0, NM + 3); GS_STEP(1, NM + 1); }
    GS_WAITN(0, 0); GS_WAITN(1, 0); GS_WAITN(2, 0);
#undef GS_STEP
#undef GS_DECL
#undef GS_WAIT
#undef GS_WAITN
#undef GS_GLD16
#undef GS_GLD8
    asm volatile("s_waitcnt vmcnt(0)" ::: "memory");
#undef GS_LOAD
    if (N1 == 64) {
#pragma unroll
        for (int njj = 0; njj < 2; ++njj)
#pragma unroll
            for (int r = 0; r < 4; ++r) Sout[(((size_t)b * 4 + h) * 128 + wave * 16 + 4 * fq + r) * 128 + sl * 32 + njj * 16 + fr] = accS[njj][r];
    }
    __syncthreads();
}

__device__ __forceinline__ void lru_prep_unit(const bf16* __restrict__ PROJ, const float* __restrict__ conv_w, const float* __restrict__ conv_b,
                                              const float* __restrict__ w_r, const float* __restrict__ b_r, const float* __restrict__ w_i, const float* __restrict__ b_i, const float* __restrict__ lam,
                                              float* __restrict__ H, float* __restrict__ P, float* __restrict__ Hend, float* __restrict__ Pend, float* __restrict__ p_lru_conv, int ub) {
    int c = threadIdx.x; asm volatile("" : "+v"(c));
    const int nblk = c >> 6, d = c & 63;
    const int n = ub & 63, b = ub >> 6, t0 = b * SEQ + n * 64;
    float wr[64], wi[64];
#pragma unroll
    for (int cc = 0; cc < 64; ++cc) { wr[cc] = w_r[((size_t)nblk * 64 + cc) * 64 + d]; wi[cc] = w_i[((size_t)nblk * 64 + cc) * 64 + d]; }
    const float cw0 = conv_w[c], cw1 = conv_w[512 + c], cw2 = conv_w[1024 + c], cw3 = conv_w[1536 + c], cb_ = conv_b[c];
    const float br = b_r[c], bi = b_i[c], spl = -8.0f * softplusf_(-lam[c]);
    float x0 = (n * 64 - 3 >= 0) ? bf2f(PROJ[(size_t)(t0 - 3) * ABN + C_XR + c]) : 0.f;
    float x1 = (n * 64 - 2 >= 0) ? bf2f(PROJ[(size_t)(t0 - 2) * ABN + C_XR + c]) : 0.f;
    float x2 = (n * 64 - 1 >= 0) ? bf2f(PROJ[(size_t)(t0 - 1) * ABN + C_XR + c]) : 0.f;
    float hloc = 0.f, ploc = 1.f;
    bf16 xa[16], xb[16];
#pragma unroll
    for (int k = 0; k < 16; ++k) xa[k] = PROJ[(size_t)(t0 + k) * ABN + C_XR + c];
#pragma unroll 1
    for (int ib = 0; ib < 64; ib += 16) {
      if (ib + 16 < 64) {
#pragma unroll
        for (int k = 0; k < 16; ++k) xb[k] = PROJ[(size_t)(t0 + ib + 16 + k) * ABN + C_XR + c];
      }
#pragma unroll
      for (int k = 0; k < 16; ++k) {
        const int i = ib + k;
        const float xt = bf2f(xa[k]);
        const float xr = cb_ + cw0 * x0 + cw1 * x1 + cw2 * x2 + cw3 * xt;
        f32x2_t ga = (f32x2_t){br, bi}, gb = (f32x2_t){0.f, 0.f};
#pragma unroll
        for (int cc = 0; cc < 64; cc += 2) {
            const float xa_ = __uint_as_float(__builtin_amdgcn_readlane(__float_as_uint(xr), cc)), xb_ = __uint_as_float(__builtin_amdgcn_readlane(__float_as_uint(xr), cc + 1));
            ga += (f32x2_t){xa_, xa_} * (f32x2_t){wr[cc], wi[cc]}; gb += (f32x2_t){xb_, xb_} * (f32x2_t){wr[cc + 1], wi[cc + 1]};
        }
        ga += gb;
        const float r = __frcp_rn(1.0f + __expf(-ga.x)), ii = __frcp_rn(1.0f + __expf(-ga.y));
        const float a = __expf(spl * r), bb = __fsqrt_rn(fmaxf(1.0f - a * a, 0.f)) * (ii * xr);
        hloc = a * hloc + bb; ploc *= a;
        H[(size_t)(t0 + i) * 512 + c] = hloc; P[(size_t)(t0 + i) * 512 + c] = ploc;
        if (n == 63 && i >= 61) p_lru_conv[((size_t)b * 3 + (i - 61)) * 512 + c] = xt;
        x0 = x1; x1 = x2; x2 = xt;
      }
#pragma unroll
      for (int k = 0; k < 16; ++k) xa[k] = xb[k];
    }
    Hend[(size_t)ub * 512 + c] = hloc; Pend[(size_t)ub * 512 + c] = ploc;
}
constexpr int LR_XR = 64 * 68 * 4;
__device__ __forceinline__ void lru_prep_unit2(const bf16* __restrict__ PROJ, const float* __restrict__ conv_w, const float* __restrict__ conv_b,
                                               const bf16* __restrict__ WRT, const bf16* __restrict__ WIT  , const float* __restrict__ b_r, const float* __restrict__ b_i, const float* __restrict__ lam,
                                               float* __restrict__ H, float* __restrict__ P, float* __restrict__ Hend, float* __restrict__ Pend, float* __restrict__ p_lru_conv, int ub, unsigned char* lds) {
    int tid = threadIdx.x; asm volatile("" : "+v"(tid));
    const int lane = tid & 63, wave = __builtin_amdgcn_readfirstlane(tid >> 6), fr = lane & 15, fq = lane >> 4;
    const int n = ub & 63, b = ub >> 6, t0 = b * SEQ + n * 64;
    float* XR = (float*)(lds + wave * LR_XR);
    {
        const int c = wave * 64 + lane;
        const float cw0 = conv_w[c], cw1 = conv_w[512 + c], cw2 = conv_w[1024 + c], cw3 = conv_w[1536 + c], cb_ = conv_b[c];
        float x0 = (n * 64 - 3 >= 0) ? bf2f(PROJ[(size_t)(t0 - 3) * ABN + C_XR + c]) : 0.f;
        float x1 = (n * 64 - 2 >= 0) ? bf2f(PROJ[(size_t)(t0 - 2) * ABN + C_XR + c]) : 0.f;
        float x2 = (n * 64 - 1 >= 0) ? bf2f(PROJ[(size_t)(t0 - 1) * ABN + C_XR + c]) : 0.f;
#pragma unroll 1
        for (int ib = 0; ib < 64; ib += 16) {
            bf16 xa[16];
#pragma unroll
            for (int k = 0; k < 16; ++k) xa[k] = PROJ[(size_t)(t0 + ib + k) * ABN + C_XR + c];
#pragma unroll
            for (int k = 0; k < 16; ++k) {
                const int i = ib + k; const float xt = bf2f(xa[k]);
                XR[i * 68 + lane] = cb_ + cw0 * x0 + cw1 * x1 + cw2 * x2 + cw3 * xt;
                if (n == 63 && i >= 61) p_lru_conv[((size_t)b * 3 + (i - 61)) * 512 + c] = xt;
                x0 = x1; x1 = x2; x2 = xt;
            }
        }
    }
    asm volatile("s_waitcnt lgkmcnt(0)" ::: "memory");
    bf16x8_t bR[4][2], bI[4][2];
#pragma unroll
    for (int nt = 0; nt < 4; ++nt)
#pragma unroll
        for (int ks = 0; ks < 2; ++ks) {
            bR[nt][ks] = *(const bf16x8_t*)(WRT + ((size_t)wave * 64 + nt * 16 + fr) * 64 + ks * 32 + 8 * fq);
            bI[nt][ks] = *(const bf16x8_t*)(WIT + ((size_t)wave * 64 + nt * 16 + fr) * 64 + ks * 32 + 8 * fq);
        }
    float brv[4], biv[4], splv[4];
#pragma unroll
    for (int nt = 0; nt < 4; ++nt) { const int c = wave * 64 + nt * 16 + fr; brv[nt] = b_r[c]; biv[nt] = b_i[c]; splv[nt] = -8.0f * softplusf_(-lam[c]); }
    float hin[4], pin[4];
#pragma unroll
    for (int nt = 0; nt < 4; ++nt) { hin[nt] = 0.f; pin[nt] = 1.f; }
#pragma unroll 1
    for (int mt = 0; mt < 4; ++mt) {
        bf16x8_t aX[2];
#pragma unroll
        for (int ks = 0; ks < 2; ++ks) {
            const f32x4 lo = *(const f32x4*)(XR + (mt * 16 + fr) * 68 + ks * 32 + 8 * fq), hi = *(const f32x4*)(XR + (mt * 16 + fr) * 68 + ks * 32 + 8 * fq + 4);
            v4u w; w.x = pk2(lo.x, lo.y); w.y = pk2(lo.z, lo.w); w.z = pk2(hi.x, hi.y); w.w = pk2(hi.z, hi.w);
            aX[ks] = __builtin_bit_cast(bf16x8_t, w);
        }
#pragma unroll
        for (int nt = 0; nt < 4; ++nt) {
            f32x4 aR = (f32x4){0.f, 0.f, 0.f, 0.f}, aI = aR;
            aR = mfma16(aX[0], bR[nt][0], aR); aR = mfma16(aX[1], bR[nt][1], aR);
            aI = mfma16(aX[0], bI[nt][0], aI); aI = mfma16(aX[1], bI[nt][1], aI);
            float av[4], bv[4];
#pragma unroll
            for (int r = 0; r < 4; ++r) {
                const float rg = __frcp_rn(1.0f + __expf(-(aR[r] + brv[nt]))), ig = __frcp_rn(1.0f + __expf(-(aI[r] + biv[nt])));
                const float a = __expf(splv[nt] * rg);
                av[r] = a; bv[r] = __fsqrt_rn(fmaxf(1.0f - a * a, 0.f)) * (ig * XR[(mt * 16 + 4 * fq + r) * 68 + nt * 16 + fr]);
            }
            float PA[4], PB[4];
            PA[0] = av[0]; PB[0] = bv[0];
#pragma unroll
            for (int r = 1; r < 4; ++r) { PA[r] = av[r] * PA[r - 1]; PB[r] = av[r] * PB[r - 1] + bv[r]; }
            float GA = PA[3], GB = PB[3];
            { const float pa = __shfl_up(GA, 16), pb = __shfl_up(GB, 16); if (fq >= 1) { GB = GA * pb + GB; GA = GA * pa; } }
            { const float pa = __shfl_up(GA, 32), pb = __shfl_up(GB, 32); if (fq >= 2) { GB = GA * pb + GB; GA = GA * pa; } }
            float EA = __shfl_up(GA, 16), EB = __shfl_up(GB, 16);
            if (fq == 0) { EA = 1.f; EB = 0.f; }
            const float h0 = EA * hin[nt] + EB, p0 = pin[nt] * EA;
#pragma unroll
            for (int r = 0; r < 4; ++r) {
                const size_t o = (size_t)(t0 + mt * 16 + 4 * fq + r) * 512 + wave * 64 + nt * 16 + fr;
                H[o] = PA[r] * h0 + PB[r]; P[o] = p0 * PA[r];
            }
            const float TA = __shfl(GA, 48 + fr), TB = __shfl(GB, 48 + fr);
            hin[nt] = TA * hin[nt] + TB; pin[nt] = pin[nt] * TA;
        }
    }
    if (fq == 0) {
#pragma unroll
        for (int nt = 0; nt < 4; ++nt) { Hend[(size_t)ub * 512 + wave * 64 + nt * 16 + fr] = hin[nt]; Pend[(size_t)ub * 512 + wave * 64 + nt * 16 + fr] = pin[nt]; }
    }
    asm volatile("s_waitcnt lgkmcnt(0)" ::: "memory");
}
__device__ __forceinline__ void lru_carry(const float* __restrict__ Hend, const float* __restrict__ Pend, float* __restrict__ CIN, float* __restrict__ hlast, int bx) {
    int tx_ = threadIdx.x; asm volatile("" : "+v"(tx_));
    const int idx = bx * NTH + tx_, b = idx >> 9, c = idx & 511;
    float carry = 0.f;
#pragma unroll 8
    for (int n = 0; n < 64; ++n) {
        const size_t o = ((size_t)b * 64 + n) * 512 + c;
        CIN[o] = carry;
        carry = Hend[o] + Pend[o] * carry;
    }
    hlast[(size_t)b * 512 + c] = carry;
}

__device__ __forceinline__ unsigned f2key(float f) { const unsigned u = __float_as_uint(f); return u ^ ((u >> 31) ? 0xffffffffu : 0x80000000u); }
__device__ __forceinline__ float key2f(unsigned k) { return __uint_as_float(k ^ ((k >> 31) ? 0x80000000u : 0xffffffffu)); }
#define TK_CE(hi, lo) do { const unsigned a_ = (hi), b_ = (lo); (hi) = a_ > b_ ? a_ : b_; (lo) = a_ > b_ ? b_ : a_; } while (0)
template <int N> __device__ __forceinline__ void bitonic_sort_desc(unsigned (&a)[N]) {
#pragma unroll
    for (int k = 2; k <= N; k <<= 1)
#pragma unroll
        for (int j = k >> 1; j > 0; j >>= 1)
#pragma unroll
            for (int i = 0; i < N; ++i) { const int l = i ^ j; if (l > i) { if ((i & k) == 0) TK_CE(a[i], a[l]); else TK_CE(a[l], a[i]); } }
}
template <int XM> __device__ __forceinline__ void merge_top16(unsigned (&a)[16]) {
    unsigned c[16];
#pragma unroll
    for (int i = 0; i < 16; ++i) { const unsigned o = (unsigned)__shfl_xor((int)a[15 - i], XM); c[i] = a[i] > o ? a[i] : o; }
#pragma unroll
    for (int j = 8; j > 0; j >>= 1)
#pragma unroll
        for (int i = 0; i < 16; ++i) { const int l = i ^ j; if (l > i) TK_CE(c[i], c[l]); }
#pragma unroll
    for (int i = 0; i < 16; ++i) a[i] = c[i];
}
constexpr int TK_KS = 0, TK_TS = 2 * 128 * 136 * 2, TK_END = TK_TS + 64 * 2 * 16 * 4;
__device__ __forceinline__ void peer_topk_stage_keys(const bf16* __restrict__ KB, int h, unsigned char* lds) {
    bf16* Ks = (bf16*)(lds + TK_KS);
    for (int ci = threadIdx.x; ci < 2 * 128 * 16; ci += NTH) { const int row = ci >> 4, part = ci & 15;
        *(v4u*)(Ks + row * 136 + part * 8) = *(const v4u*)(KB + ((size_t)h * 256 + row) * 128 + part * 8); }
    __syncthreads();
}
__device__ __forceinline__ void peer_topk4(const bf16* __restrict__ Q, int* __restrict__ EXP, float* __restrict__ GATE, int tile, int h, unsigned char* lds) {
    int tid = threadIdx.x; asm volatile("" : "+v"(tid));
    const int lane = tid & 63, wave = __builtin_amdgcn_readfirstlane(tid >> 6), fr = lane & 15, fq = lane >> 4;
    const bf16* Ks = (const bf16*)(lds + TK_KS); unsigned* Ts = (unsigned*)(lds + TK_TS);
    {
        const int c = wave >> 2, nt = wave & 3;
        bf16x8_t bq[4];
#pragma unroll
        for (int ks = 0; ks < 4; ++ks) bq[ks] = *(const bf16x8_t*)(Q + (size_t)(tile * 64 + nt * 16 + fr) * 2048 + h * 256 + c * 128 + ks * 32 + 8 * fq);
        unsigned a[32];
#pragma unroll
        for (int mt = 0; mt < 8; ++mt) {
            f32x4 acc = (f32x4){0.f, 0.f, 0.f, 0.f};
#pragma unroll
            for (int ks = 0; ks < 4; ++ks) { const bf16x8_t ak = *(const bf16x8_t*)(Ks + (c * 128 + mt * 16 + fr) * 136 + ks * 32 + 8 * fq); acc = mfma16(ak, bq[ks], acc); }
#pragma unroll
            for (int r = 0; r < 4; ++r) a[mt * 4 + r] = (f2key(acc[r]) & ~127u) | (unsigned)(127 - (mt * 16 + 4 * fq + r));
        }
        bitonic_sort_desc<32>(a);
        unsigned t[16];
#pragma unroll
        for (int j = 0; j < 16; ++j) t[j] = a[j];
        merge_top16<16>(t); merge_top16<32>(t);
        if (fq == 0) {
            const int tk = nt * 16 + fr;
#pragma unroll
            for (int j = 0; j < 16; ++j) Ts[(tk * 2 + c) * 16 + j] = t[j];
        }
    }
    __syncthreads();
    if (tid < 256) {
        const int tk = tid >> 2, q = tid & 3;
        const unsigned* t0 = Ts + (tk * 2 + 0) * 16; const unsigned* t1 = Ts + (tk * 2 + 1) * 16;
        unsigned a[16];
#pragma unroll
        for (int s = 0; s < 13; ++s) {
            const int e = s * 4 + q;
            int i, j;
            if (e < 16) { i = 0; j = e; } else if (e < 24) { i = 1; j = e - 16; } else if (e < 29) { i = 2; j = e - 24; } else if (e < 33) { i = 3; j = e - 29; }
            else if (e < 36) { i = 4; j = e - 33; } else if (e < 42) { i = 5 + ((e - 36) >> 1); j = (e - 36) & 1; } else { i = 8 + (e - 42); j = 0; }
            const bool ok = e < 50;
            const float sum = key2f(t0[ok ? i : 0] & ~127u) + key2f(t1[ok ? j : 0] & ~127u);
            a[s] = ok ? ((f2key(sum) & ~255u) | (unsigned)(255 - (i * 16 + j))) : 0u;
        }
        a[13] = 0u; a[14] = 0u; a[15] = 0u;
        bitonic_sort_desc<16>(a);
        merge_top16<1>(a); merge_top16<2>(a);
        float ev[16], sum = 0.f; const float m = key2f(a[0] & ~255u);
#pragma unroll
        for (int j = 0; j < 16; ++j) { ev[j] = __expf(key2f(a[j] & ~255u) - m); sum += ev[j]; }
        const float inv = 1.0f / sum;
        const size_t o = (size_t)(tile * 64 + tk) * 128 + h * 16;
#pragma unroll
        for (int j = 0; j < 16; ++j)
            if ((j >> 2) == q) {
                const int code = 255 - (int)(a[j] & 255u), i = code >> 4, jj = code & 15;
                const int n0 = 127 - (int)(t0[i] & 127u), n1 = 127 - (int)(t1[jj] & 127u);
                EXP[o + j] = n0 * 128 + n1; GATE[o + j] = ev[j] * inv;
            }
    }
    __syncthreads();
}

constexpr int AT_KS = 0, AT_VT = 192 * 72 * 2, AT_BT = AT_VT + 64 * 200 * 2, AT_PW = AT_BT + 4 * 128 * 4, AT_END = AT_PW + 8 * 32 * 72 * 2;
__device__ __forceinline__ void attn_unit(const bf16* __restrict__ PCb, const float* __restrict__ rel_bias, const float* __restrict__ sinks, bf16* __restrict__ ATT, int un, unsigned char* lds) {
    int tid = threadIdx.x; asm volatile("" : "+v"(tid));
    const int lane = tid & 63, wave = __builtin_amdgcn_readfirstlane(tid >> 6), fr = lane & 15, fq = lane >> 4;
    const int kvh = un & 3, qblk = (un >> 2) & 63, b = un >> 8;
    const int q0 = qblk * 64, tb = b * SEQ;
    bf16* Ks = (bf16*)(lds + AT_KS); bf16* Vt = (bf16*)(lds + AT_VT); float* Bt = (float*)(lds + AT_BT); bf16* Pw = (bf16*)(lds + AT_PW) + wave * 32 * 72;
#pragma unroll
    for (int k = 0; k < 3; ++k) {
        const int ci = tid + 512 * k, row = ci >> 3, part = ci & 7, kpos = q0 - 128 + row;
        v4u kv = (v4u){0u, 0u, 0u, 0u}, vv = kv;
        if (kpos >= 0) { const bf16* src = PCb + (size_t)(tb + kpos) * CN + kvh * 64 + part * 8; kv = *(const v4u*)(src + 1024); vv = *(const v4u*)(src + 1280); }
        *(v4u*)(Ks + row * 72 + part * 8) = kv;
        bf16* vd = Vt + (part * 8) * 200 + row;
        vd[0 * 200] = (bf16)(vv.x & 0xffffu); vd[1 * 200] = (bf16)(vv.x >> 16); vd[2 * 200] = (bf16)(vv.y & 0xffffu); vd[3 * 200] = (bf16)(vv.y >> 16);
        vd[4 * 200] = (bf16)(vv.z & 0xffffu); vd[5 * 200] = (bf16)(vv.z >> 16); vd[6 * 200] = (bf16)(vv.w & 0xffffu); vd[7 * 200] = (bf16)(vv.w >> 16);
    }
    Bt[tid] = rel_bias[t5_bucket(tid & 127) * 16 + kvh * 4 + (tid >> 7)];
    __syncthreads();
    const int g = wave >> 1, qs = (wave & 1) * 32, hh = kvh * 4 + g;
    bf16x8_t aQ[2][2];
#pragma unroll
    for (int mt = 0; mt < 2; ++mt)
#pragma unroll
        for (int ks = 0; ks < 2; ++ks) aQ[mt][ks] = *(const bf16x8_t*)(PCb + (size_t)(tb + q0 + qs + mt * 16 + fr) * CN + hh * 64 + ks * 32 + 8 * fq);
    f32x4 sc[2][12];
#pragma unroll
    for (int nt = 0; nt < 12; ++nt) {
        const bf16x8_t b0 = *(const bf16x8_t*)(Ks + (nt * 16 + fr) * 72 + 8 * fq), b1 = *(const bf16x8_t*)(Ks + (nt * 16 + fr) * 72 + 32 + 8 * fq);
#pragma unroll
        for (int mt = 0; mt < 2; ++mt) { f32x4 a = (f32x4){0.f, 0.f, 0.f, 0.f}; a = mfma16(aQ[mt][0], b0, a); a = mfma16(aQ[mt][1], b1, a); sc[mt][nt] = a; }
    }
    const float sink = sinks[hh];
    const float* bt = Bt + g * 128;
#pragma unroll
    for (int mt = 0; mt < 2; ++mt)
#pragma unroll
        for (int r = 0; r < 4; ++r) {
            const int qi = qs + mt * 16 + 4 * fq + r;
            float mx = sink;
#pragma unroll
            for (int nt = 0; nt < 12; ++nt) {
                const int kk = nt * 16 + fr, rel = qi + 128 - kk;
                const bool valid = rel >= 0 && rel < 128 && (q0 - 128 + kk) >= 0;
                const float lg = valid ? sc[mt][nt][r] * 0.125f + bt[valid ? rel : 0] : -INFINITY;
                sc[mt][nt][r] = lg; mx = fmaxf(mx, lg);
            }
            mx = fmaxf(mx, __shfl_xor(mx, 1)); mx = fmaxf(mx, __shfl_xor(mx, 2)); mx = fmaxf(mx, __shfl_xor(mx, 4)); mx = fmaxf(mx, __shfl_xor(mx, 8));
            float sum = 0.f;
#pragma unroll
            for (int nt = 0; nt < 12; ++nt) { const float p = __expf(sc[mt][nt][r] - mx); sc[mt][nt][r] = p; sum += p; }
            sum += __shfl_xor(sum, 1); sum += __shfl_xor(sum, 2); sum += __shfl_xor(sum, 4); sum += __shfl_xor(sum, 8);
            const float inv = 1.0f / (sum + __expf(sink - mx));
#pragma unroll
            for (int nt = 0; nt < 12; ++nt) sc[mt][nt][r] *= inv;
        }
    f32x4 oacc[2][4];
#pragma unroll
    for (int mt = 0; mt < 2; ++mt)
#pragma unroll
        for (int dt = 0; dt < 4; ++dt) oacc[mt][dt] = (f32x4){0.f, 0.f, 0.f, 0.f};
#pragma unroll
    for (int kc = 0; kc < 3; ++kc) {
#pragma unroll
        for (int mt = 0; mt < 2; ++mt)
#pragma unroll
            for (int n4 = 0; n4 < 4; ++n4)
#pragma unroll
                for (int r = 0; r < 4; ++r) Pw[(mt * 16 + 4 * fq + r) * 72 + n4 * 16 + fr] = (bf16)f2bf(sc[mt][kc * 4 + n4][r]);
        asm volatile("s_waitcnt lgkmcnt(0)" ::: "memory");
#pragma unroll
        for (int ks = 0; ks < 2; ++ks) {
            const bf16x8_t p0 = *(const bf16x8_t*)(Pw + fr * 72 + ks * 32 + 8 * fq), p1 = *(const bf16x8_t*)(Pw + (16 + fr) * 72 + ks * 32 + 8 * fq);
#pragma unroll
            for (int dt = 0; dt < 4; ++dt) {
                const bf16x8_t bv = *(const bf16x8_t*)(Vt + (dt * 16 + fr) * 200 + kc * 64 + ks * 32 + 8 * fq);
                oacc[0][dt] = mfma16(p0, bv, oacc[0][dt]); oacc[1][dt] = mfma16(p1, bv, oacc[1][dt]);
            }
        }
        asm volatile("s_waitcnt lgkmcnt(0)" ::: "memory");
    }
#pragma unroll
    for (int mt = 0; mt < 2; ++mt)
#pragma unroll
        for (int dt = 0; dt < 4; ++dt)
#pragma unroll
            for (int r = 0; r < 4; ++r) Pw[(mt * 16 + 4 * fq + r) * 72 + dt * 16 + fr] = (bf16)f2bf(oacc[mt][dt][r]);
    asm volatile("s_waitcnt lgkmcnt(0)" ::: "memory");
#pragma unroll
    for (int k = 0; k < 4; ++k) {
        const int ci = lane + 64 * k, row = ci >> 3, part = ci & 7;
        *(v4u*)(ATT + (size_t)(tb + q0 + qs + row) * D + hh * 64 + part * 8) = *(const v4u*)(Pw + row * 72 + part * 8);
    }
    __syncthreads();
}

__device__ __forceinline__ void swa_attn_sample(const bf16* __restrict__ PCb, const float* __restrict__ cache_k, const float* __restrict__ cache_v,
                                                const float* __restrict__ rel_bias, const float* __restrict__ sinks, bf16* __restrict__ ATT, int gw, int lane) {
    const int sb = gw >> 4, h = gw & 15, kvh = h >> 2, t = NP + sb;
    const bf16* qrow = PCb + (size_t)t * CN + h * 64;
    float lg[2];
#pragma unroll
    for (int rr = 0; rr < 2; ++rr) {
        const int r = lane + 64 * rr;
        float dot = 0.f;
        if (r == 0) {
            const bf16* krow = PCb + (size_t)t * CN + 1024 + kvh * 64;
            for (int d = 0; d < 64; ++d) dot += bf2f(qrow[d]) * bf2f(krow[d]);
        } else {
            const float* krow = cache_k + (((size_t)sb * 128 + (128 - r)) * 4 + kvh) * 64;
#pragma unroll
            for (int d4 = 0; d4 < 16; ++d4) { const float4 kv = *(const float4*)(krow + d4 * 4);
                dot += bf2f(qrow[d4 * 4]) * kv.x + bf2f(qrow[d4 * 4 + 1]) * kv.y + bf2f(qrow[d4 * 4 + 2]) * kv.z + bf2f(qrow[d4 * 4 + 3]) * kv.w; }
        }
        lg[rr] = dot * 0.125f + rel_bias[t5_bucket(r) * 16 + h];
    }
    const float sink = sinks[h];
    const float m = fmaxf(wave_max(fmaxf(lg[0], lg[1])), sink);
    float p[2] = {expf(lg[0] - m), expf(lg[1] - m)};
    const float inv = 1.0f / (wave_sum(p[0] + p[1]) + expf(sink - m));
    float o = 0.f;
#pragma unroll
    for (int rr = 0; rr < 2; ++rr)
        for (int l2 = 0; l2 < 64; ++l2) {
            const int r = l2 + 64 * rr;
            const float pj = __shfl(p[rr], l2);
            const float vv = (r == 0) ? bf2f(PCb[(size_t)t * CN + 1280 + kvh * 64 + lane]) : cache_v[(((size_t)sb * 128 + (128 - r)) * 4 + kvh) * 64 + lane];
            o += pj * vv;
        }
    ATT[(size_t)t * D + h * 64 + lane] = (bf16)f2bf(o * inv);
}
__device__ __forceinline__ void swa_kv_out2(const bf16* __restrict__ PCb, const float* __restrict__ cache_k, const float* __restrict__ cache_v,
                                            float* __restrict__ pk, float* __restrict__ pv, float* __restrict__ sk, float* __restrict__ sv, int vb) {
    int tx_ = threadIdx.x; asm volatile("" : "+v"(tx_));
    const int c = tx_ & 255, row = vb * 2 + (tx_ >> 8);
    if (row < NB * 128) {
        const int b = row >> 7, i = row & 127;
        const bf16* src = PCb + (size_t)(b * SEQ + SEQ - 128 + i) * CN;
        pk[(size_t)row * 256 + c] = bf2f(src[1024 + c]);
        pv[(size_t)row * 256 + c] = bf2f(src[1280 + c]);
    } else {
        const int r2 = row - NB * 128, sb = r2 >> 7, i = r2 & 127;
        if (i < 127) {
            sk[(size_t)r2 * 256 + c] = cache_k[((size_t)sb * 128 + i + 1) * 256 + c];
            sv[(size_t)r2 * 256 + c] = cache_v[((size_t)sb * 128 + i + 1) * 256 + c];
        } else {
            const bf16* src = PCb + (size_t)(NP + sb) * CN;
            sk[(size_t)r2 * 256 + c] = bf2f(src[1024 + c]);
            sv[(size_t)r2 * 256 + c] = bf2f(src[1280 + c]);
        }
    }
}


__device__ __forceinline__ void sample_gemm_piece(const bf16* __restrict__ A, const bf16* __restrict__ Bt, const float* __restrict__ bias, bf16* __restrict__ O, int ldc, int p, unsigned char* lds) {
    int tid = threadIdx.x; asm volatile("" : "+v"(tid));
    const int lane = tid & 63, wave = __builtin_amdgcn_readfirstlane(tid >> 6), fr = lane & 15, fq = lane >> 4;
    const int mt = p & 7, cb = p >> 3, nt = wave & 3, kh = wave >> 2;
    const bf16* ap = A + (size_t)(NP + mt * 16 + fr) * D + kh * 512 + 8 * fq;
    const bf16* bp = Bt + (size_t)(cb * 64 + nt * 16 + fr) * D + kh * 512 + 8 * fq;
    bf16x8_t a[16], b[16];
#pragma unroll
    for (int ks = 0; ks < 16; ++ks) { a[ks] = *(const bf16x8_t*)(ap + ks * 32); b[ks] = *(const bf16x8_t*)(bp + ks * 32); }
    f32x4 acc = (f32x4){0.f, 0.f, 0.f, 0.f};
#pragma unroll
    for (int ks = 0; ks < 16; ++ks) acc = mfma16(a[ks], b[ks], acc);
    f32x4* part = (f32x4*)lds;
    if (kh == 1) part[nt * 64 + lane] = acc;
    __syncthreads();
    if (kh == 0) {
        acc = acc + part[nt * 64 + lane];
        const int col = cb * 64 + nt * 16 + fr; const float bv = bias ? bias[col] : 0.f;
#pragma unroll
        for (int r = 0; r < 4; ++r) O[(size_t)(NP + mt * 16 + 4 * fq + r) * ldc + col] = (bf16)f2bf(acc[r] + bv);
    }
    __syncthreads();
}

constexpr size_t MiB = 1u << 20;
constexpr size_t WS_CTL = 0, CTL_ZERO_BYTES = 64 * 1024;
constexpr size_t WS_WAB = 1 * MiB;
constexpr size_t WS_WOUT = WS_WAB + (size_t)ABNP * D * 2;
constexpr size_t WS_WQ0 = WS_WOUT + (size_t)D * D * 2;
constexpr size_t WS_WQ1 = WS_WQ0 + (size_t)2048 * D * 2;
constexpr size_t WS_WINC = WS_WQ1 + (size_t)2048 * D * 2;
constexpr size_t WS_WOUTC = WS_WINC + (size_t)CN * D * 2;
constexpr size_t WS_ABUF = WS_WOUTC + (size_t)D * D * 2;
constexpr size_t WS_P = WS_ABUF + (size_t)MP * D * 2;
constexpr size_t WS_T = WS_P + (size_t)MP * ABN * 2;
constexpr size_t WS_Q = WS_T + (size_t)4 * 16384 * D + (size_t)4 * 16384 * 4;
constexpr size_t WS_A = WS_Q + (size_t)MP * 1536 * 4;
constexpr size_t WS_B = WS_A + (size_t)MP * 512 * 4;
constexpr size_t WS_O = WS_B + (size_t)MP * 512 * 4;
constexpr size_t WS_X1 = WS_O + (size_t)MP * 512 * 4;
constexpr size_t WS_G = WS_X1 + (size_t)MP * D * 4;
constexpr size_t WS_BETA = WS_G + (size_t)MP * 4 * 4;
constexpr size_t WS_GATE = WS_BETA + (size_t)MP * 4 * 4;
constexpr size_t WS_EXP = WS_GATE + (size_t)MP * 128 * 4;
constexpr size_t WS_HEND = WS_EXP + (size_t)MP * 128 * 4;
constexpr size_t WS_KEYS = WS_HEND + (size_t)3 * 4 * 64 * 512 * 4;
constexpr size_t WS_WGT = WS_KEYS + (size_t)2 * 8 * 2 * 128 * 128 * 2;
constexpr size_t WS_END = WS_WGT + (size_t)2 * 8 * 64 * 64 * 2;
constexpr size_t Q_QKVS = 0, Q_W = 1 * MiB, Q_QG = Q_W + 16 * MiB, Q_KDT = Q_QG + 16 * MiB, Q_UT = Q_KDT + 16 * MiB, Q_QK = Q_UT + 16 * MiB, Q_EGL = Q_QK + 8 * MiB, Q_END = Q_EGL + 4096;
static_assert(Q_END <= (size_t)MP * 1536 * 4, "region Q");
static_assert(WS_END <= 512 * MiB, "d_ws map");

struct MegaArgs {
    const float* in[35];
    float* out;
    unsigned char* ws;
};

__global__ void __launch_bounds__(NTH, 2) fwd_megakernel(MegaArgs ma) {
    cg::grid_group grid = cg::this_grid();
    extern __shared__ __attribute__((aligned(16))) unsigned char lds[];
    float* smem = (float*)lds;
    const int nb = gridDim.x, b0 = blockIdx.x, wave = __builtin_amdgcn_readfirstlane(threadIdx.x >> 6);
    int tid = threadIdx.x, lane = tid & 63;
    const float* x_prompt = ma.in[0];
    const float* x_sample = ma.in[1];
    const float* state_gdn = ma.in[2];
    const float* state_gdn_conv = ma.in[3];
    const float* state_lru = ma.in[4];
    const float* state_lru_conv = ma.in[5];
    const float* cache_k = ma.in[6];
    const float* cache_v = ma.in[7];
    const float* w_in_ab = ma.in[8];
    const float* gdn_conv_w = ma.in[9];
    const float* gdn_a_log = ma.in[10];
    const float* gdn_dt_bias = ma.in[11];
    const float* gdn_norm_w = ma.in[12];
    const float* lru_conv_w = ma.in[13];
    const float* lru_conv_b = ma.in[14];
    const float* lru_w_r = ma.in[15];
    const float* lru_b_r = ma.in[16];
    const float* lru_w_i = ma.in[17];
    const float* lru_b_i = ma.in[18];
    const float* lru_lam = ma.in[19];
    const float* w_out_ab = ma.in[20];
    const float* w_in_c = ma.in[21];
    const float* b_in_c = ma.in[22];
    const float* swa_sinks = ma.in[23];
    const float* w_out_c = ma.in[24];
    const float* b_out_c = ma.in[25];
    const float* rel_bias = ma.in[26];
    const float* ln_mix_g = ma.in[27];
    const float* ln_mix_b = ma.in[28];
    const float* ln_ffn_g = ma.in[29];
    const float* ln_ffn_b = ma.in[30];
    const float* peer_w_q = ma.in[31];
    const float* peer_keys = ma.in[32];
    const float* peer_u = ma.in[33];
    const float* peer_v = ma.in[34];

    float* out = ma.out;
    float* o_y = out;
    float* o_p_gdn = out + (size_t)NT * D;
    float* o_p_gdn_conv = o_p_gdn + 262144;
    float* o_p_lru = o_p_gdn_conv + 18432;
    float* o_p_lru_conv = o_p_lru + 2048;
    float* o_p_k = o_p_lru_conv + 6144;
    float* o_p_v = o_p_k + 131072;
    float* o_s_gdn = o_p_v + 131072;
    float* o_s_gdn_conv = o_s_gdn + 8388608;
    float* o_s_lru = o_s_gdn_conv + 589824;
    float* o_s_lru_conv = o_s_lru + 65536;
    float* o_s_k = o_s_lru_conv + 196608;
    float* o_s_v = o_s_k + 4194304;

    unsigned char* ws = ma.ws;
    bf16* WAB_T = (bf16*)(ws + WS_WAB); bf16* WOUT_T = (bf16*)(ws + WS_WOUT); bf16* WQ0_T = (bf16*)(ws + WS_WQ0); bf16* WQ1_T = (bf16*)(ws + WS_WQ1);
    bf16* WINC_T = (bf16*)(ws + WS_WINC); bf16* WOUTC_T = (bf16*)(ws + WS_WOUTC);
    bf16* ABUF = (bf16*)(ws + WS_ABUF);
    bf16* PROJ = (bf16*)(ws + WS_P); float* Y = (float*)(ws + WS_P); bf16* Qb = (bf16*)(ws + WS_P); bf16* PCb = (bf16*)(ws + WS_P); float* Y1 = (float*)(ws + WS_P);
    unsigned char* TAB8 = ws + WS_T; float* TSC = (float*)(ws + WS_T + (size_t)4 * 16384 * D);
    float* R_Q = (float*)(ws + WS_Q + Q_QKVS) - (size_t)NP * 1536; float* X2 = (float*)(ws + WS_A);
    GdnChunkBufs cbuf; cbuf.W = (bf16*)(ws + WS_Q + Q_W); cbuf.QG = (bf16*)(ws + WS_Q + Q_QG); cbuf.KDT = (bf16*)(ws + WS_Q + Q_KDT); cbuf.UT = (bf16*)(ws + WS_Q + Q_UT); cbuf.QK = (bf16*)(ws + WS_Q + Q_QK); cbuf.EGL = (float*)(ws + WS_Q + Q_EGL);
    bf16* Yb = (bf16*)(ws + WS_P);
    float* OUTS = (float*)(ws + WS_Q);
    float* PD = (float*)(ws + WS_P);
    bf16* KEYSB = (bf16*)(ws + WS_KEYS); bf16* WRT = (bf16*)(ws + WS_WGT); bf16* WIT = WRT + 8 * 64 * 64;
    float* HEND = (float*)(ws + WS_HEND); float* PEND = HEND + 4 * 64 * 512; float* CIN = PEND + 4 * 64 * 512;
    float* R_A = (float*)(ws + WS_A); float* R_B = (float*)(ws + WS_B); float* R_O = (float*)(ws + WS_O);
    bf16* XRES = (bf16*)(ws + WS_X1);
    float* R_G = (float*)(ws + WS_G); float* R_BETA = (float*)(ws + WS_BETA); float* R_GATE = (float*)(ws + WS_GATE); int* R_EXP = (int*)(ws + WS_EXP);

    for (int u = tid; u < (LDS_BYTES - RING_BYTES) / 4; u += NTH) ((unsigned*)(lds + RING_BYTES))[u] = 0u;
    __syncthreads();
    XcdBarrier bar = xcd_barrier_post((unsigned*)(ws + WS_CTL), (volatile LAS unsigned*)((LAS unsigned char*)lds + MISC_OFF) + 8);
#define GRID_BAR() do { xcd_barrier(bar); asm volatile("" : "+v"(tid)); lane = tid & 63; } while (0)
#define PHASE_LOOP(n) for (int vb = b0; vb < (n); vb += nb)
#define PHASE_END __syncthreads()
#define GEMM_PHASE_M(Mrows, EPI, Aptr, Btptr, Nn, ...) do { pg8::Gemm g_{(const pg8::bf16_t*)(Aptr), (const pg8::bf16_t*)(Btptr), (Mrows), (Nn), D}; pg8::StaticOrder S_; S_.init((Mrows), (Nn), nb, b0); \
        pg8::EPI E_{__VA_ARGS__}; pg8::gemm_phase<pg8::EPI, pg8::StaticOrder, true, true>((PG8_LAS unsigned char*)lds, g_, S_, E_); } while (0)
#define GEMM_PHASE(EPI, Aptr, Btptr, Nn, ...) GEMM_PHASE_M(MP, EPI, Aptr, Btptr, Nn, __VA_ARGS__)
#define GEMM_PHASE_SPLIT(Aptr, Btptr, Nn, Optr, biasptr) do { GEMM_PHASE_M(NP, EpiStoreBf16, Aptr, Btptr, Nn, Optr, Nn, biasptr, NP, Nn); \
        for (int p_ = b0; p_ < 8 * ((Nn) / 64); p_ += nb) sample_gemm_piece(Aptr, Btptr, biasptr, Optr, Nn, p_, lds); } while (0)

    {
        float* scr = smem + wave * 4096;
        const int gw = b0 * NWAVES + wave, NGW = nb * NWAVES;
        constexpr int I_AB = 16 * 97, I_OUT = 16 * 32, I_Q = 16 * 64, I_INC = 16 * 48;
        constexpr int NITEMS = I_AB + I_OUT + 2 * I_Q + I_INC + I_OUT;
        for (int it = gw; it < NITEMS; it += NGW) {
            int r = it;
            if (r < I_AB) { p0_transpose_item(w_in_ab, D, ABN, WAB_T, scr, r, lane); continue; } r -= I_AB;
            if (r < I_OUT) { p0_transpose_item(w_out_ab, D, D, WOUT_T, scr, r, lane); continue; } r -= I_OUT;
            if (r < I_Q) { p0_transpose_item(peer_w_q, D, 2048, WQ0_T, scr, r, lane); continue; } r -= I_Q;
            if (r < I_Q) { p0_transpose_item(peer_w_q + (size_t)D * 2048, D, 2048, WQ1_T, scr, r, lane); continue; } r -= I_Q;
            if (r < I_INC) { p0_transpose_item(w_in_c, D, CN, WINC_T, scr, r, lane); continue; } r -= I_INC;
            p0_transpose_item(w_out_c, D, D, WOUTC_T, scr, r, lane);
        }
        for (int it = b0 * NTH + tid; it < 2 * 8 * 64 * 8; it += nb * NTH) {
            const int gsel = it >> 12, nn = (it >> 9) & 7, dd = (it >> 3) & 63, c8 = (it & 7) * 8;
            const float* wsrc = (gsel ? lru_w_i : lru_w_r) + ((size_t)nn * 64 + c8) * 64 + dd;
            v4u o; o.x = pk2(wsrc[0], wsrc[64]); o.y = pk2(wsrc[128], wsrc[192]); o.z = pk2(wsrc[256], wsrc[320]); o.w = pk2(wsrc[384], wsrc[448]);
            *(v4u*)((gsel ? WIT : WRT) + ((size_t)nn * 64 + dd) * 64 + c8) = o;
        }
        for (int m = gw; m < MP + (ABNP - 97 * 32); m += NGW) {
            if (m < MP) row_to_bf16(m < NP ? x_prompt + (size_t)m * D : (m < NT ? x_sample + (size_t)(m - NP) * D : nullptr), ABUF + (size_t)m * D, lane);
            else row_to_bf16(nullptr, WAB_T + (size_t)(97 * 32 + (m - MP)) * D, lane);
        }
    }
    GRID_BAR();
    if (ma.out == nullptr) grid.sync();
    GEMM_PHASE(EpiStoreBf16, ABUF, WAB_T, ABNP, PROJ, ABN, nullptr, NT, ABN);
    GRID_BAR();
    constexpr int NSPLIT = 28, A_LRU = 4 * NSPLIT, A_GDN = 16 * NSPLIT, B_LRU = 4 * (64 - NSPLIT), B_GDN = 16 * (64 - NSPLIT);
    { AbPrepArgs pa;
      pa.PROJ = PROJ; pa.st_gdn_conv = state_gdn_conv; pa.st_lru_conv = state_lru_conv;
      pa.gdn_conv_w = gdn_conv_w; pa.a_log = gdn_a_log; pa.dt_bias = gdn_dt_bias;
      pa.lru_conv_w = lru_conv_w; pa.lru_conv_b = lru_conv_b; pa.w_r = lru_w_r; pa.b_r = lru_b_r; pa.w_i = lru_w_i; pa.b_i = lru_b_i; pa.lam = lru_lam;
      pa.QKV = R_Q; pa.G = R_G; pa.BETA = R_BETA; pa.LA = R_A; pa.LB = R_B;
      pa.p_gdn_conv = o_p_gdn_conv; pa.p_lru_conv = o_p_lru_conv; pa.s_gdn_conv = o_s_gdn_conv; pa.s_lru_conv = o_s_lru_conv;
      for (int v = b0; v < A_LRU + NS + A_GDN; v += nb) {
          if (v < A_LRU) { lru_prep_unit2(PROJ, lru_conv_w, lru_conv_b, WRT, WIT, lru_b_r, lru_b_i, lru_lam, R_B, R_A, HEND, PEND, o_p_lru_conv, (v / NSPLIT) * 64 + (v % NSPLIT), lds); PHASE_END; }
          else if (v < A_LRU + NS) { ab_prep(pa, NP + (v - A_LRU), smem); PHASE_END; }
          else { const int i = v - A_LRU - NS, h_ = i & 3, n_ = (i >> 2) % NSPLIT, b_ = (i >> 2) / NSPLIT;
                 gdn_prep_unit(PROJ, gdn_conv_w, gdn_a_log, gdn_dt_bias, cbuf, o_p_gdn_conv, (b_ * 64 + n_) * 4 + h_, lds); }
      } }
    GRID_BAR();
    f32x4 seqS[2]; int seqcur = 0;
    const int seq_p = (b0 & 7) + 8 * (b0 >> 5), seq_s = (b0 >> 3) & 3;
    if (b0 < 64) gdn_seq<0, NSPLIT>(cbuf, R_O, o_p_gdn, seq_p >> 2, seq_p & 3, seq_s, lds, seqS, seqcur);
    else for (int v = b0 - 64; v < B_LRU + B_GDN; v += nb - 64) {
        if (v < B_LRU) { lru_prep_unit2(PROJ, lru_conv_w, lru_conv_b, WRT, WIT, lru_b_r, lru_b_i, lru_lam, R_B, R_A, HEND, PEND, o_p_lru_conv, (v / (64 - NSPLIT)) * 64 + NSPLIT + (v % (64 - NSPLIT)), lds); PHASE_END; }
        else { const int i = v - B_LRU, h_ = i & 3, n_ = NSPLIT + (i >> 2) % (64 - NSPLIT), b_ = (i >> 2) / (64 - NSPLIT);
               gdn_prep_unit(PROJ, gdn_conv_w, gdn_a_log, gdn_dt_bias, cbuf, o_p_gdn_conv, (b_ * 64 + n_) * 4 + h_, lds); }
    }
    GRID_BAR();
    if (b0 < 64) gdn_seq<NSPLIT, 64>(cbuf, R_O, o_p_gdn, seq_p >> 2, seq_p & 3, seq_s, lds, seqS, seqcur);
    else if (b0 < 68) lru_carry(HEND, PEND, CIN, o_p_lru, b0 - 64);
    else {
        for (int v = b0 - 68; v < 2048 + 128; v += nb - 68) {
            if (v < 2048) gdn_scan(R_Q, R_G, R_BETA, state_gdn, R_O, o_s_gdn, NP, 1, v & 3, (v >> 2) & 3, v >> 4, smem);
            else lru_scan(R_A, R_B, state_lru, o_s_lru, NP, 1, NS, v - 2048);
            PHASE_END;
        }
        const int gw2 = (b0 - 68) * NWAVES + wave, NGW2 = (nb - 68) * NWAVES;
        for (int m = gw2; m < 512; m += NGW2) row_to_bf16(peer_keys + (size_t)m * D, KEYSB + (size_t)m * D, lane);
        for (int m = gw2; m < 4 * 16384; m += NGW2) {
            const int k = m >> 14, r = m & 16383;
            if (k & 1) row_to_fp8_sliced(peer_v + ((size_t)(k >> 1) * 16384 + r) * D, TAB8 + (size_t)k * 16384 * D, r, TSC + m, lane);
            else row_to_i8_sliced(peer_u + ((size_t)(k >> 1) * 16384 + r) * D, TAB8 + (size_t)k * 16384 * D, r, TSC + m, lane);
        }
    }
    GRID_BAR();
    PHASE_LOOP(NT / 8) { ab_mix_w(PROJ, R_O, R_B, R_A, CIN, gdn_norm_w, ABUF, vb * 8 + wave, lane); }
    GRID_BAR();
    GEMM_PHASE_SPLIT(ABUF, WOUT_T, D, Yb, (const float*)nullptr);
    GRID_BAR();
    PHASE_LOOP(NT / 8) { const int t = vb * 8 + wave;
        ln_res_w<false>(t < NP ? x_prompt + (size_t)t * D : x_sample + (size_t)(t - NP) * D, Yb + (size_t)t * D, ln_mix_g, ln_mix_b, ABUF + (size_t)t * D, lane); }
    GRID_BAR();
    GEMM_PHASE_SPLIT(ABUF, WQ0_T, 2048, Qb, (const float*)nullptr);
    GRID_BAR();
    if ((nb & 7) == 0) { peer_topk_stage_keys(KEYSB, b0 & 7, lds); PHASE_LOOP((NT / 64) * 8) { peer_topk4(Qb, R_EXP, R_GATE, vb >> 3, vb & 7, lds); } }
    else PHASE_LOOP((NT / 64) * 8) { peer_topk_stage_keys(KEYSB, vb & 7, lds); peer_topk4(Qb, R_EXP, R_GATE, vb >> 3, vb & 7, lds); }
    GRID_BAR();
    asm volatile("" : "+v"(tid)); lane = tid & 63;
    { const int x = b0 & 7, tg0 = b0 >> 3, tgstep = nb >> 3, nit = (NT / 8 - tg0 + tgstep - 1) / tgstep;
      peer_u_loop(ABUF, R_EXP, TAB8 + (size_t)x * 16384 * 128, PD + (size_t)x * NT * 128, x, tg0, tgstep, nit, wave, lane); }
    GRID_BAR();
    PHASE_LOOP(NT / 8) { const int t = vb * 8 + wave; peer_xk(R_EXP + (size_t)t * 128, R_GATE + (size_t)t * 128, PD + (size_t)t * 128, TSC, TSC + 16384, lane); }
    GRID_BAR();
    for (int tg = b0 >> 3; tg < NT / 8; tg += nb >> 3) { const int t = tg * 8 + wave, x = b0 & 7;
        peer_v_slice(R_EXP + (size_t)t * 128, R_GATE + (size_t)t * 128, TAB8 + (size_t)16384 * D + (size_t)x * 16384 * 128, OUTS + (size_t)t * D + x * 128, lane); }
    GRID_BAR();
    PHASE_LOOP(NT / 8) { const int t = vb * 8 + wave; peer_xc(ABUF + (size_t)t * D, OUTS + (size_t)t * D, ln_ffn_g, ln_ffn_b, nullptr, ABUF + (size_t)t * D, XRES + (size_t)t * D, lane); }
    GRID_BAR();

    GEMM_PHASE(EpiStoreBf16, ABUF, WINC_T, CN, PCb, CN, b_in_c, NT, CN);
    GRID_BAR();
    PHASE_LOOP(1024 + 256 + (NB * 128 + NS * 128) / 2) {
        if (vb < 1024) attn_unit(PCb, rel_bias, swa_sinks, ABUF, vb, lds);
        else if (vb < 1280) swa_attn_sample(PCb, cache_k, cache_v, rel_bias, swa_sinks, ABUF, (vb - 1024) * 8 + wave, lane);
        else swa_kv_out2(PCb, cache_k, cache_v, o_p_k, o_p_v, o_s_k, o_s_v, vb - 1280);
    }
    GRID_BAR();
    GEMM_PHASE_SPLIT(ABUF, WOUTC_T, D, Yb, b_out_c);
    GRID_BAR();
    PHASE_LOOP(NT / 8) { const int t = vb * 8 + wave;
        ln_res_w<true>(XRES + (size_t)t * D, Yb + (size_t)t * D, ln_mix_g + D, ln_mix_b + D, ABUF + (size_t)t * D, lane); }
    GRID_BAR();
    GEMM_PHASE_SPLIT(ABUF, WQ1_T, 2048, Qb, (const float*)nullptr);
    GRID_BAR();
    if ((nb & 7) == 0) { peer_topk_stage_keys(KEYSB + (size_t)8 * 2 * 128 * 128, b0 & 7, lds); PHASE_LOOP((NT / 64) * 8) { peer_topk4(Qb, R_EXP, R_GATE, vb >> 3, vb & 7, lds); } }
    else PHASE_LOOP((NT / 64) * 8) { peer_topk_stage_keys(KEYSB + (size_t)8 * 2 * 128 * 128, vb & 7, lds); peer_topk4(Qb, R_EXP, R_GATE, vb >> 3, vb & 7, lds); }
    GRID_BAR();
    asm volatile("" : "+v"(tid)); lane = tid & 63;
    { const int x = b0 & 7, tg0 = b0 >> 3, tgstep = nb >> 3, nit = (NT / 8 - tg0 + tgstep - 1) / tgstep;
      peer_u_loop(ABUF, R_EXP, TAB8 + (size_t)2 * 16384 * D + (size_t)x * 16384 * 128, PD + (size_t)x * NT * 128, x, tg0, tgstep, nit, wave, lane); }
    GRID_BAR();
    PHASE_LOOP(NT / 8) { const int t = vb * 8 + wave; peer_xk(R_EXP + (size_t)t * 128, R_GATE + (size_t)t * 128, PD + (size_t)t * 128, TSC + 2 * 16384, TSC + 3 * 16384, lane); }
    GRID_BAR();
    for (int tg = b0 >> 3; tg < NT / 8; tg += nb >> 3) { const int t = tg * 8 + wave, x = b0 & 7;
        peer_v_slice(R_EXP + (size_t)t * 128, R_GATE + (size_t)t * 128, TAB8 + (size_t)3 * 16384 * D + (size_t)x * 16384 * 128, OUTS + (size_t)t * D + x * 128, lane); }
    GRID_BAR();
    PHASE_LOOP(NT / 8) { const int t = vb * 8 + wave; peer_xc(ABUF + (size_t)t * D, OUTS + (size_t)t * D, ln_ffn_g + D, ln_ffn_b + D, o_y + (size_t)t * D, nullptr, nullptr, lane); }
}
}

extern "C" void kernel_launch(void* const* d_in, const int* in_sizes, int n_in,
                              void* d_out, int out_size, void* d_ws, size_t ws_size,
                              hipStream_t stream) {
    static int grid_blocks = 0;
    if (!grid_blocks) {
        int dev = 0, cus = 0, per_cu = 0;
        (void)hipGetDevice(&dev);
        (void)hipDeviceGetAttribute(&cus, hipDeviceAttributeMultiprocessorCount, dev);
        if (hipFuncSetAttribute((const void*)fwd_megakernel, hipFuncAttributeMaxDynamicSharedMemorySize, LDS_BYTES) != hipSuccess) { fprintf(stderr, "hipFuncSetAttribute failed\n"); grid_blocks = -1; return; }
        (void)hipOccupancyMaxActiveBlocksPerMultiprocessor(&per_cu, (const void*)fwd_megakernel, NTH, LDS_BYTES);
        if (per_cu < 1) { fprintf(stderr, "occupancy query says %d blocks per CU\n", per_cu); grid_blocks = -1; return; }
        if (cus * per_cu < 256) { fprintf(stderr, "this kernel needs 256 co-resident workgroups (device reports %d CUs x %d)\n", cus, per_cu); grid_blocks = -1; return; }
        grid_blocks = 256;
    }
    if (grid_blocks < 0) return;
    (void)hipMemsetAsync((char*)d_ws + WS_CTL, 0, CTL_ZERO_BYTES, stream);
    MegaArgs ma{};
    for (int i = 0; i < 35; ++i) ma.in[i] = (const float*)d_in[i];
    ma.out = (float*)d_out;
    ma.ws = (unsigned char*)d_ws;
    void* args[] = {&ma};
    hipError_t e = hipLaunchCooperativeKernel((void*)fwd_megakernel, dim3(grid_blocks), dim3(NTH), args, LDS_BYTES, stream);
    if (e != hipSuccess) fprintf(stderr, "cooperative launch failed: %s (grid %d)\n", hipGetErrorString(e), grid_blocks);
}
```

```cpp
#include <hip/hip_runtime.h>
#include <hip/hip_cooperative_groups.h>
#include <cstdio>
#include <cstdint>
namespace cg = cooperative_groups;

namespace pg8 {
#define PG8_LAS __attribute__((address_space(3)))
typedef unsigned short bf16_t;
typedef short bf16x8 __attribute__((ext_vector_type(8)));
typedef float f32x4 __attribute__((ext_vector_type(4)));
typedef unsigned u32x4 __attribute__((ext_vector_type(4)));
constexpr int BM = 256, BK = 64, HALF = 128, HTB = HALF * BK * 2  , STAGE_BYTES = 8 * HTB, NXCD = 8, WGM = 8;

__host__ __device__ __forceinline__ int lds_byte(int r, int c) { const int st = (r >> 4) * 2 + (c >> 5), rr = r & 15, cc = c & 31, ob = rr * 64 + cc * 2; return st * 1024 + (ob ^ (((ob >> 9) & 1) << 5)); }
__host__ __device__ __forceinline__ void stage_rc(int b, int& R, int& C) { const int st = b / 1024, sb = b % 1024, swz = sb ^ (((sb >> 9) & 1) << 5); R = (st >> 1) * 16 + swz / 64; C = (st & 1) * 32 + (swz % 64) / 2; }
__host__ __device__ __forceinline__ int perm32(int rho) { const int n = rho >> 4, i = rho & 15; return 8 * (i >> 2) + 4 * n + (i & 3); }

struct Unit { int pm, pn; };
struct Gemm { const bf16_t* A; const bf16_t* Bt; int M, N, K; };

struct StaticOrder {
    int nM, nN, nwg, G, c;
    __host__ __device__ void init(int M, int N, int G_, int c_) { nM = M / BM; nN = N / BM; nwg = nM * nN; G = G_; c = c_; }
    __host__ __device__ bool next(int i, Unit& u) const {
        const long L = (long)i * G + c; if (L >= nwg) return false;
        int wgid = (int)L; { const int q = nwg / NXCD, r = nwg % NXCD, xcd = wgid % NXCD, off = wgid / NXCD; wgid = (xcd < r ? xcd * (q + 1) : r * (q + 1) + (xcd - r) * q) + off; }
        const int nig = WGM * nN, gid = wgid / nig, fm = gid * WGM, gsz = (nM - fm) < WGM ? (nM - fm) : WGM;
        u.pm = fm + ((wgid % nig) % gsz); u.pn = (wgid % nig) / gsz; return true;
    }
    __device__ __forceinline__ void a_ready(const Unit&) const {}
    __device__ __forceinline__ void done(const Unit&) const {}
};

__device__ __forceinline__ unsigned cvt_pk_bf16(float lo, float hi) { unsigned r; asm volatile("v_cvt_pk_bf16_f32 %0, %1, %2" : "=v"(r) : "v"(lo), "v"(hi)); return r; }
template <class Epi, class Sched, bool ALIGN_EPI = false, bool SP2 = false>
__device__ __forceinline__ void gemm_phase(PG8_LAS unsigned char* lds, const Gemm g, const Sched& S, const Epi& E) {
    int tid_ = threadIdx.x; asm volatile("" : "+v"(tid_));
    const int tid = tid_, wid = __builtin_amdgcn_readfirstlane(tid >> 6), lane = tid & 63, wr = wid >> 2, wc = wid & 3, fr = lane & 15, fq = lane >> 4;
    const int K = g.K, nt = K / BK;
    unsigned voffA[2], voffB[2];
#pragma unroll
    for (int i = 0; i < 2; ++i) { int R, C; stage_rc(tid * 16 + i * 8192, R, C); const int Rb = Epi::PERM ? ((R & ~31) + perm32(R & 31)) : R;
        voffA[i] = (unsigned)(R * K + C) * 2u; voffB[i] = (unsigned)(Rb * K + C) * 2u; }
    const size_t kstep = (size_t)(BK * 2);
    const size_t hstep = (size_t)HALF * K * 2;
    const size_t tstep = 2 * hstep;
    const unsigned ldsw = (unsigned)wid * 1024u;
    const int aoff = lds_byte(wr * 64 + fr, fq * 8), boff = lds_byte(wc * 32 + fr, fq * 8);
#define PG8_SA(b, h) (((b) * 2 + (h)) * HTB)
#define PG8_SB(b, h) ((4 + (b) * 2 + (h)) * HTB)
#define PG8_STAGE(bufoff, gbase, voff) do { _Pragma("unroll") for (int _i = 0; _i < 2; ++_i) \
        __builtin_amdgcn_global_load_lds((const unsigned*)((const char*)(gbase) + (voff)[_i]), (PG8_LAS unsigned*)(lds + (bufoff) + ldsw + _i * 8192), 16, 0, 0); } while (0)
#define PG8_LDA(dst, b, h) do { _Pragma("unroll") for (int m = 0; m < 4; ++m) _Pragma("unroll") for (int k = 0; k < 2; ++k) dst[m][k] = *(const PG8_LAS bf16x8*)(lds + PG8_SA(b, h) + aoff + m * 2048 + k * 1024); } while (0)
#define PG8_LDB(dst, b, h) do { _Pragma("unroll") for (int n = 0; n < 2; ++n) _Pragma("unroll") for (int k = 0; k < 2; ++k) dst[n][k] = *(const PG8_LAS bf16x8*)(lds + PG8_SB(b, h) + boff + n * 2048 + k * 1024); } while (0)
#define PG8_MMA(ai, bj, At, Bt) do { __builtin_amdgcn_s_setprio(1); _Pragma("unroll") for (int m = 0; m < 4; ++m) _Pragma("unroll") for (int n = 0; n < 2; ++n) _Pragma("unroll") for (int k = 0; k < 2; ++k) \
        acc[ai][bj][m][n] = __builtin_amdgcn_mfma_f32_16x16x32_bf16(Bt[n][k], At[m][k], acc[ai][bj][m][n], 0, 0, 0); __builtin_amdgcn_s_setprio(0); } while (0)
#define PG8_WAIT_V(n) asm volatile("s_waitcnt vmcnt(" #n ")" ::: "memory")
#define PG8_WAIT_L(n) asm volatile("s_waitcnt lgkmcnt(" #n ")" ::: "memory")
#define PG8_BAR __builtin_amdgcn_s_barrier()
#define PG8_SCHED __builtin_amdgcn_sched_barrier(0)
    Unit cur, nxt; int ui = 0;
    if (!S.next(0, cur)) return;
    f32x4 acc[2][2][4][2];
#pragma unroll
    for (int a = 0; a < 2; ++a)
#pragma unroll
        for (int b = 0; b < 2; ++b)
#pragma unroll
            for (int m = 0; m < 4; ++m)
#pragma unroll
                for (int n = 0; n < 2; ++n) acc[a][b][m][n] = (f32x4){0.f, 0.f, 0.f, 0.f};
    bf16x8 At[4][2], B0[2][2], B1[2][2];
    const char* cA = (const char*)g.A + (size_t)cur.pm * tstep; const char* cB = (const char*)g.Bt + (size_t)cur.pn * tstep;
    S.a_ready(cur);
    if constexpr (SP2) {
        PG8_STAGE(PG8_SB(0, 0), cB, voffB); PG8_STAGE(PG8_SB(0, 1), cB + hstep, voffB); PG8_STAGE(PG8_SA(0, 0), cA, voffA); PG8_STAGE(PG8_SA(0, 1), cA + hstep, voffA);
        if (wr == 1) PG8_BAR;
        PG8_WAIT_V(2); PG8_BAR;
        PG8_STAGE(PG8_SB(1, 0), cB + kstep, voffB); PG8_STAGE(PG8_SA(1, 0), cA + kstep, voffA); PG8_STAGE(PG8_SB(1, 1), cB + hstep + kstep, voffB);
        PG8_WAIT_V(6); PG8_BAR;
    } else {
        PG8_STAGE(PG8_SB(0, 0), cB, voffB); PG8_STAGE(PG8_SA(0, 0), cA, voffA); PG8_STAGE(PG8_SB(0, 1), cB + hstep, voffB); PG8_STAGE(PG8_SA(0, 1), cA + hstep, voffA);
        if (wr == 1) PG8_BAR;
        PG8_WAIT_V(4); PG8_BAR;
        PG8_STAGE(PG8_SB(1, 0), cB + kstep, voffB); PG8_STAGE(PG8_SA(1, 0), cA + kstep, voffA); PG8_STAGE(PG8_SB(1, 1), cB + hstep + kstep, voffB);
        PG8_WAIT_V(6); PG8_BAR;
    }
    for (;;) {
        const bool has_next = S.next(ui + 1, nxt);
        const char* nA = has_next ? (const char*)g.A + (size_t)nxt.pm * tstep : cA; const char* nB = has_next ? (const char*)g.Bt + (size_t)nxt.pn * tstep : cB;
        for (int t = 0; t < nt; t += 2) {
            const bool last = (t == nt - 2);
            const char* a1 = cA + (size_t)(t + 1) * kstep;
            const char* a2 = last ? nA : cA + (size_t)(t + 2) * kstep; const char* b2 = last ? nB : cB + (size_t)(t + 2) * kstep;
            const char* a3 = a2 + kstep; const char* b3 = b2 + kstep;
            if (last && has_next) S.a_ready(nxt);
            if constexpr (SP2) {
            PG8_LDB(B0, 0, 0); PG8_LDB(B1, 0, 1); PG8_SCHED; PG8_LDA(At, 0, 0); PG8_STAGE(PG8_SA(1, 1), a1 + hstep, voffA);
            PG8_WAIT_V(8); PG8_WAIT_L(0); PG8_BAR; PG8_MMA(0, 0, At, B0); PG8_MMA(0, 1, At, B1); PG8_BAR; PG8_SCHED;
            PG8_LDA(At, 0, 1); PG8_STAGE(PG8_SB(0, 0), b2, voffB); PG8_STAGE(PG8_SB(0, 1), b2 + hstep, voffB); PG8_STAGE(PG8_SA(0, 0), a2, voffA);
            PG8_WAIT_V(8); PG8_WAIT_L(0); PG8_BAR; PG8_MMA(1, 0, At, B0); PG8_MMA(1, 1, At, B1); PG8_BAR; PG8_SCHED;
            PG8_LDB(B0, 1, 0); PG8_LDB(B1, 1, 1); PG8_SCHED; PG8_LDA(At, 1, 0); PG8_STAGE(PG8_SA(0, 1), a2 + hstep, voffA);
            PG8_WAIT_V(8); PG8_WAIT_L(0); PG8_BAR; PG8_MMA(0, 0, At, B0); PG8_MMA(0, 1, At, B1); PG8_BAR; PG8_SCHED;
            PG8_LDA(At, 1, 1); PG8_STAGE(PG8_SB(1, 0), b3, voffB); PG8_STAGE(PG8_SB(1, 1), b3 + hstep, voffB); PG8_STAGE(PG8_SA(1, 0), a3, voffA);
            PG8_WAIT_V(8); PG8_WAIT_L(0); PG8_BAR; PG8_MMA(1, 0, At, B0); PG8_MMA(1, 1, At, B1); PG8_BAR; PG8_SCHED;
            } else {
            PG8_LDB(B0, 0, 0); PG8_SCHED; PG8_LDA(At, 0, 0); PG8_STAGE(PG8_SA(1, 1), a1 + hstep, voffA);
            PG8_WAIT_L(8); PG8_BAR; PG8_WAIT_L(0); PG8_MMA(0, 0, At, B0); PG8_BAR; PG8_SCHED;
            PG8_LDB(B1, 0, 1); PG8_STAGE(PG8_SB(0, 0), b2, voffB);
            PG8_BAR; PG8_WAIT_L(0); PG8_MMA(0, 1, At, B1); PG8_BAR;
            PG8_LDA(At, 0, 1); PG8_STAGE(PG8_SA(0, 0), a2, voffA);
            PG8_BAR; PG8_WAIT_L(0); PG8_MMA(1, 0, At, B0); PG8_BAR; PG8_SCHED;
            PG8_STAGE(PG8_SB(0, 1), b2 + hstep, voffB);
            PG8_WAIT_V(6); PG8_BAR; PG8_MMA(1, 1, At, B1); PG8_BAR;
            PG8_LDB(B0, 1, 0); PG8_SCHED; PG8_LDA(At, 1, 0); PG8_STAGE(PG8_SA(0, 1), a2 + hstep, voffA);
            PG8_WAIT_L(8); PG8_BAR; PG8_WAIT_L(0); PG8_MMA(0, 0, At, B0); PG8_BAR; PG8_SCHED;
            PG8_LDB(B1, 1, 1); PG8_STAGE(PG8_SB(1, 0), b3, voffB);
            PG8_BAR; PG8_WAIT_L(0); PG8_MMA(0, 1, At, B1); PG8_BAR;
            PG8_LDA(At, 1, 1); PG8_STAGE(PG8_SA(1, 0), a3, voffA);
            PG8_BAR; PG8_WAIT_L(0); PG8_MMA(1, 0, At, B0); PG8_BAR; PG8_SCHED;
            PG8_STAGE(PG8_SB(1, 1), b3 + hstep, voffB);
            PG8_WAIT_V(6); PG8_BAR; PG8_MMA(1, 1, At, B1); PG8_BAR;
            }
        }
        if constexpr (ALIGN_EPI) { if (wr == 0) PG8_BAR; }
        if constexpr (!Epi::AFTER_DRAIN) { E(acc, cur, wr, wc, fr, fq); S.done(cur); }
        if (!has_next) break;
#pragma unroll
        for (int a = 0; a < 2; ++a)
#pragma unroll
            for (int b = 0; b < 2; ++b)
#pragma unroll
                for (int m = 0; m < 4; ++m)
#pragma unroll
                    for (int n = 0; n < 2; ++n) acc[a][b][m][n] = (f32x4){0.f, 0.f, 0.f, 0.f};
        cur = nxt; cA = nA; cB = nB; ++ui;
        if constexpr (ALIGN_EPI) { if (wr == 1) PG8_BAR; }
    }
    PG8_WAIT_V(0);
    if constexpr (!ALIGN_EPI) { if (wr == 0) PG8_BAR; }
    PG8_BAR;
    if constexpr (Epi::AFTER_DRAIN) { E.fused(acc, cur, wr, wc, fr, fq, lds, wid, lane); S.done(cur); }
#undef PG8_SA
#undef PG8_SB
#undef PG8_STAGE
#undef PG8_LDA
#undef PG8_LDB
#undef PG8_MMA
#undef PG8_WAIT_V
#undef PG8_WAIT_L
#undef PG8_BAR
#undef PG8_SCHED
}
}
namespace pg8 {
struct EpiStoreBf16 {
    static constexpr bool PERM = true, AFTER_DRAIN = false;
    bf16_t* O; int ldc; const float* bias; int m_real, n_real;
    __device__ __forceinline__ void operator()(const f32x4 (&acc)[2][2][4][2], const Unit& u, int wr, int wc, int fr, int fq) const {
        const int row0 = u.pm * BM + wr * 64 + fr, col0 = u.pn * BM + wc * 32 + 8 * fq;
#pragma unroll
        for (int bj = 0; bj < 2; ++bj) {
            const int col = col0 + bj * HALF;
            if (col >= n_real) continue;
            f32x4 b0 = (f32x4){0.f, 0.f, 0.f, 0.f}, b1 = b0;
            if (bias) { b0 = *(const f32x4*)(bias + col); b1 = *(const f32x4*)(bias + col + 4); }
#pragma unroll
            for (int ai = 0; ai < 2; ++ai)
#pragma unroll
                for (int m = 0; m < 4; ++m) {
                    const int row = row0 + ai * HALF + m * 16;
                    if (row >= m_real) continue;
                    const f32x4 v0 = acc[ai][bj][m][0] + b0, v1 = acc[ai][bj][m][1] + b1;
                    u32x4 w; w.x = cvt_pk_bf16(v0[0], v0[1]); w.y = cvt_pk_bf16(v0[2], v0[3]); w.z = cvt_pk_bf16(v1[0], v1[1]); w.w = cvt_pk_bf16(v1[2], v1[3]);
                    *(u32x4*)(O + (size_t)row * ldc + col) = w;
                }
        }
    }
};
struct EpiStoreF32 {
    static constexpr bool PERM = false, AFTER_DRAIN = false;
    float* O; int ldc; const float* bias; int m_real, n_real;
    __device__ __forceinline__ void operator()(const f32x4 (&acc)[2][2][4][2], const Unit& u, int wr, int wc, int fr, int fq) const {
        const int row0 = u.pm * BM + wr * 64 + fr, col0 = u.pn * BM + wc * 32 + 4 * fq;
#pragma unroll
        for (int bj = 0; bj < 2; ++bj)
#pragma unroll
            for (int n = 0; n < 2; ++n) {
                const int col = col0 + bj * HALF + n * 16;
                if (col >= n_real) continue;
                const f32x4 bv = bias ? *(const f32x4*)(bias + col) : (f32x4){0.f, 0.f, 0.f, 0.f};
#pragma unroll
                for (int ai = 0; ai < 2; ++ai)
#pragma unroll
                    for (int m = 0; m < 4; ++m) {
                        const int row = row0 + ai * HALF + m * 16;
                        if (row >= m_real) continue;
                        *(f32x4*)(O + (size_t)row * ldc + col) = acc[ai][bj][m][n] + bv;
                    }
            }
    }
};
}
namespace {
#define GAS __attribute__((address_space(1)))
#define LAS __attribute__((address_space(3)))
typedef unsigned short bf16;
typedef float f32x4 __attribute__((ext_vector_type(4)));
typedef unsigned v4u __attribute__((ext_vector_type(4)));
typedef unsigned v2u __attribute__((ext_vector_type(2)));

constexpr int D = 1024, NB = 4, SEQ = 4096, NP = NB * SEQ, NS = 128, NT = NP + NS, MP = 16640;
constexpr int ABN = 3080, ABNP = 3328;
constexpr int C_QKV = 0, C_Z = 1536, C_A = 2048, C_B = 2052, C_XR = 2056, C_GATE = 2568;
constexpr int CN = 1536;
constexpr float ALPHA = 1.4142135623730951f;
constexpr float LN_EPS = 1e-5f;
constexpr int NTH = 512, NWAVES = 8;
constexpr int RING_BYTES = 143360, MISC_OFF = RING_BYTES + 320, LDS_BYTES = 147456;

__device__ __forceinline__ float bf2f(bf16 v) { return __uint_as_float((unsigned)v << 16); }
__device__ __forceinline__ float bflo(unsigned w) { return __uint_as_float(w << 16); }
__device__ __forceinline__ float bfhi(unsigned w) { return __uint_as_float(w & 0xffff0000u); }
__device__ __forceinline__ unsigned f2bf(float f) { unsigned u = __float_as_uint(f); return (u + 0x7fffu + ((u >> 16) & 1u)) >> 16; }
__device__ __forceinline__ unsigned pk2(float lo, float hi) { return f2bf(lo) | (f2bf(hi) << 16); }
__device__ __forceinline__ float sigmoidf_(float x) { return 1.0f / (1.0f + expf(-x)); }
__device__ __forceinline__ float softplusf_(float x) { return fmaxf(x, 0.f) + log1pf(expf(-fabsf(x))); }
__device__ __forceinline__ float siluf_(float x) { return x / (1.0f + expf(-x)); }
__device__ __forceinline__ float geluf_(float x) { return 0.5f * x * (1.0f + tanhf(0.7978845608028654f * (x + 0.044715f * x * x * x))); }
#define DPPF(v_, ctrl_, rmask_) __int_as_float(__builtin_amdgcn_update_dpp(0, __float_as_int(v_), (ctrl_), (rmask_), 0xf, false))
__device__ __forceinline__ float wave_sum(float v) {
    v += DPPF(v, 0xB1, 0xf); v += DPPF(v, 0x4E, 0xf); v += DPPF(v, 0x141, 0xf); v += DPPF(v, 0x140, 0xf);
    v += DPPF(v, 0x142, 0xa); v += DPPF(v, 0x143, 0xc);
    return __int_as_float(__builtin_amdgcn_readlane(__float_as_int(v), 63));
}
__device__ __forceinline__ float wave_max(float v) {
    v = fmaxf(v, DPPF(v, 0xB1, 0xf)); v = fmaxf(v, DPPF(v, 0x4E, 0xf)); v = fmaxf(v, DPPF(v, 0x141, 0xf)); v = fmaxf(v, DPPF(v, 0x140, 0xf));
    { const float t = __int_as_float(__builtin_amdgcn_update_dpp(__float_as_int(v), __float_as_int(v), 0x142, 0xa, 0xf, false)); v = fmaxf(v, t); }
    { const float t = __int_as_float(__builtin_amdgcn_update_dpp(__float_as_int(v), __float_as_int(v), 0x143, 0xc, 0xf, false)); v = fmaxf(v, t); }
    return __int_as_float(__builtin_amdgcn_readlane(__float_as_int(v), 63));
}

__device__ __forceinline__ void p0_transpose_item(const float* __restrict__ W, int K, int N, bf16* __restrict__ WT, float* scr, int item, int lane) {
    const int nblk = (N + 31) / 32, kb = item / nblk, nb = item % nblk, k0 = 64 * kb, n0 = 32 * nb;
#pragma unroll 8
    for (int i = 0; i < 32; ++i) { const int kk = 2 * i + (lane >> 5), n = n0 + (lane & 31); scr[kk * 33 + (lane & 31)] = n < N ? W[(size_t)(k0 + kk) * N + n] : 0.f; }
    asm volatile("s_waitcnt lgkmcnt(0)" ::: "memory");
    const int c = lane & 7;
#pragma unroll
    for (int j = 0; j < 4; ++j) { const int n = (lane >> 3) + 8 * j; const float* s = scr + (8 * c) * 33 + n;
        v4u o; o.x = pk2(s[0 * 33], s[1 * 33]); o.y = pk2(s[2 * 33], s[3 * 33]); o.z = pk2(s[4 * 33], s[5 * 33]); o.w = pk2(s[6 * 33], s[7 * 33]);
        *(v4u*)(WT + (size_t)(n0 + n) * K + k0 + 8 * c) = o; }
    asm volatile("s_waitcnt lgkmcnt(0)" ::: "memory");
}
__device__ __forceinline__ void row_to_bf16(const float* __restrict__ xrow, bf16* __restrict__ orow, int lane) {
#pragma unroll
    for (int j = 0; j < 4; ++j) {
        f32x4 v = (f32x4){0.f, 0.f, 0.f, 0.f};
        if (xrow) v = ((const f32x4*)xrow)[lane + 64 * j];
        v2u o; o.x = pk2(v.x, v.y); o.y = pk2(v.z, v.w);
        ((v2u*)orow)[lane + 64 * j] = o;
    }
}

struct AbPrepArgs {
    const bf16* PROJ; const float* st_gdn_conv; const float* st_lru_conv;
    const float* gdn_conv_w; const float* a_log; const float* dt_bias;
    const float* lru_conv_w; const float* lru_conv_b; const float* w_r; const float* b_r; const float* w_i; const float* b_i; const float* lam;
    float* QKV; float* G; float* BETA; float* LA; float* LB;
    float* p_gdn_conv; float* p_lru_conv; float* s_gdn_conv; float* s_lru_conv;
};
__device__ __forceinline__ void ab_prep(const AbPrepArgs& a, int t, float* smem) {
    int tid = threadIdx.x; asm volatile("" : "+v"(tid));
    const int lane = tid & 63, wid = tid >> 6;
    const bool samp = t >= NP; const int sb = t - NP, pos = t % SEQ, b = t / SEQ;
    float* sq = smem;
    float* sx = smem + 1536;
    float* scl = smem + 2048;
    const bf16* prow = a.PROJ + (size_t)t * ABN;
    for (int c = tid; c < 1536; c += NTH) {
        float acc = 0.f;
#pragma unroll
        for (int i = 0; i < 4; ++i) {
            float xv;
            if (i == 3) xv = bf2f(prow[C_QKV + c]);
            else if (samp) xv = a.st_gdn_conv[((size_t)sb * 3 + i) * 1536 + c];
            else xv = (pos - 3 + i >= 0) ? bf2f(a.PROJ[(size_t)(t - 3 + i) * ABN + C_QKV + c]) : 0.f;
            acc += a.gdn_conv_w[i * 1536 + c] * xv;
        }
        sq[c] = siluf_(acc);
    }
    {
        const int c = tid;
        float acc = a.lru_conv_b[c];
#pragma unroll
        for (int i = 0; i < 4; ++i) {
            float xv;
            if (i == 3) xv = bf2f(prow[C_XR + c]);
            else if (samp) xv = a.st_lru_conv[((size_t)sb * 3 + i) * 512 + c];
            else xv = (pos - 3 + i >= 0) ? bf2f(a.PROJ[(size_t)(t - 3 + i) * ABN + C_XR + c]) : 0.f;
            acc += a.lru_conv_w[i * 512 + c] * xv;
        }
        sx[c] = acc;
    }
    __syncthreads();
    {
        const int grp = wid;
        const float v0 = sq[grp * 128 + lane], v1 = sq[grp * 128 + 64 + lane];
        const float s = wave_sum(v0 * v0 + v1 * v1);
        if (lane == 0) scl[grp] = rsqrtf(s + 1e-6f) * (grp < 4 ? 0.08838834764831845f : 1.0f);
    }
    __syncthreads();
    for (int c = tid; c < 1536; c += NTH) a.QKV[(size_t)t * 1536 + c] = (c < 1024) ? sq[c] * scl[c >> 7] : sq[c];
    if (tid < 4) {
        const float a_raw = bf2f(prow[C_A + tid]), b_raw = bf2f(prow[C_B + tid]);
        a.G[(size_t)t * 4 + tid] = -expf(a.a_log[tid]) * softplusf_(a_raw + a.dt_bias[tid]);
        a.BETA[(size_t)t * 4 + tid] = sigmoidf_(b_raw);
    }
    if (!samp) {
        if (pos >= SEQ - 3) {
            const int row = pos - (SEQ - 3);
            for (int c = tid; c < 1536; c += NTH) a.p_gdn_conv[((size_t)b * 3 + row) * 1536 + c] = bf2f(prow[C_QKV + c]);
            a.p_lru_conv[((size_t)b * 3 + row) * 512 + tid] = bf2f(prow[C_XR + tid]);
        }
    } else {
        for (int c = tid; c < 1536; c += NTH) {
            a.s_gdn_conv[((size_t)sb * 3 + 0) * 1536 + c] = a.st_gdn_conv[((size_t)sb * 3 + 1) * 1536 + c];
            a.s_gdn_conv[((size_t)sb * 3 + 1) * 1536 + c] = a.st_gdn_conv[((size_t)sb * 3 + 2) * 1536 + c];
            a.s_gdn_conv[((size_t)sb * 3 + 2) * 1536 + c] = bf2f(prow[C_QKV + c]);
        }
        {
            const int c = tid;
            a.s_lru_conv[((size_t)sb * 3 + 0) * 512 + c] = a.st_lru_conv[((size_t)sb * 3 + 1) * 512 + c];
            a.s_lru_conv[((size_t)sb * 3 + 1) * 512 + c] = a.st_lru_conv[((size_t)sb * 3 + 2) * 512 + c];
            a.s_lru_conv[((size_t)sb * 3 + 2) * 512 + c] = bf2f(prow[C_XR + c]);
        }
    }
    {
        const int c = tid, n = c >> 6, d = c & 63;
        float r = a.b_r[c], ii = a.b_i[c];
#pragma unroll 4
        for (int cc = 0; cc < 64; ++cc) {
            const float xv = sx[n * 64 + cc];
            r += xv * a.w_r[((size_t)n * 64 + cc) * 64 + d];
            ii += xv * a.w_i[((size_t)n * 64 + cc) * 64 + d];
        }
        r = sigmoidf_(r); ii = sigmoidf_(ii);
        const float log_a = -8.0f * r * softplusf_(-a.lam[c]);
        a.LA[(size_t)t * 512 + c] = expf(log_a);
        a.LB[(size_t)t * 512 + c] = sqrtf(-expm1f(2.0f * log_a)) * (ii * sx[c]);
    }
}

__device__ __forceinline__ void gdn_scan(const float* __restrict__ QKV, const float* __restrict__ G, const float* __restrict__ BETA,
                                         const float* __restrict__ S0, float* __restrict__ O, float* __restrict__ Sout, int tok_base, int T,
                                         int sl, int h, int sq, float* smem) {
    int tid = threadIdx.x; asm volatile("" : "+v"(tid));
    const int dvl = tid & 31, kg = tid >> 5;
    const int dv = sl * 32 + dvl;
    float (*red1)[32] = (float (*)[32])smem;
    float (*red2)[32] = (float (*)[32])(smem + 512);
    float S[8];
#pragma unroll
    for (int i = 0; i < 8; ++i) S[i] = S0 ? S0[(((size_t)sq * 4 + h) * 128 + kg * 8 + i) * 128 + dv] : 0.f;
    float kk[8], qq[8], vv, g, be;
    {
        const size_t tok = (size_t)tok_base + (size_t)sq * T;
        const float* row = QKV + tok * 1536;
#pragma unroll
        for (int i = 0; i < 8; ++i) { kk[i] = row[512 + h * 128 + kg * 8 + i]; qq[i] = row[h * 128 + kg * 8 + i]; }
        vv = row[1024 + h * 128 + dv]; g = G[tok * 4 + h]; be = BETA[tok * 4 + h];
    }
    for (int t = 0; t < T; ++t) {
        const size_t tok = (size_t)tok_base + (size_t)sq * T + t;
        float nk[8], nq[8], nv = 0.f, ng = 0.f, nb = 0.f;
        if (t + 1 < T) {
            const float* row = QKV + (tok + 1) * 1536;
#pragma unroll
            for (int i = 0; i < 8; ++i) { nk[i] = row[512 + h * 128 + kg * 8 + i]; nq[i] = row[h * 128 + kg * 8 + i]; }
            nv = row[1024 + h * 128 + dv]; ng = G[(tok + 1) * 4 + h]; nb = BETA[(tok + 1) * 4 + h];
        } else {
#pragma unroll
            for (int i = 0; i < 8; ++i) { nk[i] = 0.f; nq[i] = 0.f; }
        }
        const float al = expf(g);
        float p = 0.f;
#pragma unroll
        for (int i = 0; i < 8; ++i) { S[i] *= al; p += S[i] * kk[i]; }
        red1[kg][dvl] = p;
        __syncthreads();
        float ks = 0.f;
#pragma unroll
        for (int j = 0; j < 16; ++j) ks += red1[j][dvl];
        const float vn = be * (vv - ks);
        float o = 0.f;
#pragma unroll
        for (int i = 0; i < 8; ++i) { S[i] += kk[i] * vn; o += S[i] * qq[i]; }
        red2[kg][dvl] = o;
        __syncthreads();
        if (kg == 0) {
            float os = 0.f;
#pragma unroll
            for (int j = 0; j < 16; ++j) os += red2[j][dvl];
            O[tok * 512 + h * 128 + dv] = os;
        }
#pragma unroll
        for (int i = 0; i < 8; ++i) { kk[i] = nk[i]; qq[i] = nq[i]; }
        vv = nv; g = ng; be = nb;
    }
#pragma unroll
    for (int i = 0; i < 8; ++i) Sout[(((size_t)sq * 4 + h) * 128 + kg * 8 + i) * 128 + dv] = S[i];
}

__device__ __forceinline__ void lru_scan(const float* __restrict__ LA, float* __restrict__ LB, const float* __restrict__ h0,
                                         float* __restrict__ hlast, int tok_base, int T, int nseq, int bx) {
    int tx_ = threadIdx.x; asm volatile("" : "+v"(tx_));
    const int idx = bx * NTH + tx_;
    if (idx >= nseq * 512) return;
    const int sq = idx / 512, c = idx % 512;
    float h = h0 ? h0[(size_t)sq * 512 + c] : 0.f;
    const size_t base = ((size_t)tok_base + (size_t)sq * T) * 512 + c;
#pragma unroll 8
    for (int t = 0; t < T; ++t) {
        const size_t o = base + (size_t)t * 512;
        h = LA[o] * h + LB[o];
        LB[o] = h;
    }
    hlast[(size_t)sq * 512 + c] = h;
}

__device__ __forceinline__ void ab_mix_w(const bf16* __restrict__ PROJ, const float* __restrict__ O, const float* __restrict__ H, const float* __restrict__ P, const float* __restrict__ CIN,
                                         const float* __restrict__ norm_w, bf16* __restrict__ MIX, int t, int lane) {
    const bf16* prow = PROJ + (size_t)t * ABN;
    {
        const int c0 = lane * 8;
        const f32x4 o0 = *(const f32x4*)(O + (size_t)t * 512 + c0), o1 = *(const f32x4*)(O + (size_t)t * 512 + c0 + 4);
        const v4u zb = *(const v4u*)(prow + C_Z + c0);
        const f32x4 w0 = *(const f32x4*)(norm_w + (c0 & 127)), w1 = *(const f32x4*)(norm_w + (c0 & 127) + 4);
        float ss = (o0.x * o0.x + o0.y * o0.y) + (o0.z * o0.z + o0.w * o0.w) + (o1.x * o1.x + o1.y * o1.y) + (o1.z * o1.z + o1.w * o1.w);
        ss += DPPF(ss, 0xB1, 0xf); ss += DPPF(ss, 0x4E, 0xf); ss += DPPF(ss, 0x141, 0xf); ss += DPPF(ss, 0x140, 0xf);
        const float sc = rsqrtf(ss * (1.0f / 128.0f) + 1e-6f);
        const float z[8] = {bflo(zb.x), bfhi(zb.x), bflo(zb.y), bfhi(zb.y), bflo(zb.z), bfhi(zb.z), bflo(zb.w), bfhi(zb.w)};
        const float ov[8] = {o0.x, o0.y, o0.z, o0.w, o1.x, o1.y, o1.z, o1.w}, wv[8] = {w0.x, w0.y, w0.z, w0.w, w1.x, w1.y, w1.z, w1.w};
        float r[8];
#pragma unroll
        for (int i = 0; i < 8; ++i) r[i] = ov[i] * sc * wv[i] * (z[i] * __frcp_rn(1.0f + __expf(-z[i])));
        v4u ob; ob.x = pk2(r[0], r[1]); ob.y = pk2(r[2], r[3]); ob.z = pk2(r[4], r[5]); ob.w = pk2(r[6], r[7]);
        *(v4u*)(MIX + (size_t)t * 1024 + c0) = ob;
    }
    {
        const int c0 = lane * 8;
        const v4u gb = *(const v4u*)(prow + C_GATE + c0);
        f32x4 h0 = *(const f32x4*)(H + (size_t)t * 512 + c0), h1 = *(const f32x4*)(H + (size_t)t * 512 + c0 + 4);
        if (t < NP) {
            const f32x4 p0 = *(const f32x4*)(P + (size_t)t * 512 + c0), p1 = *(const f32x4*)(P + (size_t)t * 512 + c0 + 4);
            const f32x4 ci0 = *(const f32x4*)(CIN + (size_t)(t >> 6) * 512 + c0), ci1 = *(const f32x4*)(CIN + (size_t)(t >> 6) * 512 + c0 + 4);
            h0 = h0 + p0 * ci0; h1 = h1 + p1 * ci1;
        }
        const float gv[8] = {bflo(gb.x), bfhi(gb.x), bflo(gb.y), bfhi(gb.y), bflo(gb.z), bfhi(gb.z), bflo(gb.w), bfhi(gb.w)}, hv[8] = {h0.x, h0.y, h0.z, h0.w, h1.x, h1.y, h1.z, h1.w};
        float r[8];
#pragma unroll
        for (int i = 0; i < 8; ++i) r[i] = geluf_(gv[i]) * hv[i];
        v4u ob; ob.x = pk2(r[0], r[1]); ob.y = pk2(r[2], r[3]); ob.z = pk2(r[4], r[5]); ob.w = pk2(r[6], r[7]);
        *(v4u*)(MIX + (size_t)t * 1024 + 512 + c0) = ob;
    }
}

template <bool XBF>
__device__ __forceinline__ void ln_res_w(const void* __restrict__ xrow_, const bf16* __restrict__ yrow, const float* __restrict__ g, const float* __restrict__ bta,
                                         bf16* __restrict__ obrow, int lane) {
    f32x4 v[4]; float s = 0.f;
#pragma unroll
    for (int j = 0; j < 4; ++j) {
        f32x4 x4;
        if (XBF) { const v2u xb = ((const v2u*)xrow_)[lane + 64 * j]; x4 = (f32x4){bflo(xb.x), bfhi(xb.x), bflo(xb.y), bfhi(xb.y)}; }
        else x4 = ((const f32x4*)xrow_)[lane + 64 * j];
        const v2u yb = ((const v2u*)yrow)[lane + 64 * j];
        const f32x4 y4 = (f32x4){bflo(yb.x), bfhi(yb.x), bflo(yb.y), bfhi(yb.y)}; v[j] = x4 * ALPHA + y4; s += (v[j].x + v[j].y) + (v[j].z + v[j].w); }
    const float mean = wave_sum(s) * (1.0f / 1024.0f); float q = 0.f;
#pragma unroll
    for (int j = 0; j < 4; ++j) { v[j] = v[j] - mean; q += (v[j].x * v[j].x + v[j].y * v[j].y) + (v[j].z * v[j].z + v[j].w * v[j].w); }
    const float rs = rsqrtf(wave_sum(q) * (1.0f / 1024.0f) + LN_EPS);
#pragma unroll
    for (int j = 0; j < 4; ++j) {
        const f32x4 g4 = ((const f32x4*)g)[lane + 64 * j], b4 = ((const f32x4*)bta)[lane + 64 * j];
        const f32x4 o = v[j] * rs * g4 + b4;
        v2u ob; ob.x = pk2(o.x, o.y); ob.y = pk2(o.z, o.w);
        ((v2u*)obrow)[lane + 64 * j] = ob;
    }
}

__device__ __forceinline__ void peer_topk(const bf16* __restrict__ Q, const float* __restrict__ keys, int* __restrict__ EXP, float* __restrict__ GATE,
                                          int tg, int h, float* smem) {
    const int tid = threadIdx.x, cn = tid & 255, c = cn >> 7, n = cn & 127, th = tid >> 8;
    float (*sq)[256] = (float (*)[256])smem;
    float (*ss)[257] = (float (*)[257])(smem + 32 * 256);
    float (*tvs)[2][16] = (float (*)[2][16])(smem + 32 * 256 + 32 * 257 + 32);
    int (*tis)[2][16] = (int (*)[2][16])(smem + 32 * 256 + 32 * 257 + 32 + 1024);
    for (int i = tid; i < 32 * 256; i += NTH) {
        const int tk = i >> 8, col = i & 255;
        sq[tk][col] = bf2f(Q[(size_t)(tg * 32 + tk) * 2048 + h * 256 + col]);
    }
    __syncthreads();
    float acc[16];
#pragma unroll
    for (int i = 0; i < 16; ++i) acc[i] = 0.f;
    const float* krow = keys + (((size_t)h * 2 + c) * 128 + n) * 128;
    for (int d4 = 0; d4 < 32; ++d4) {
        const float4 kv = *(const float4*)(krow + d4 * 4);
#pragma unroll
        for (int tk = 0; tk < 16; ++tk) {
            const float4 qv = *(const float4*)&sq[th * 16 + tk][c * 128 + d4 * 4];
            acc[tk] += qv.x * kv.x + qv.y * kv.y + qv.z * kv.z + qv.w * kv.w;
        }
    }
#pragma unroll
    for (int tk = 0; tk < 16; ++tk) ss[th * 16 + tk][cn] = acc[tk];
    __syncthreads();
    if (tid < 64) {
        const int tk = tid >> 1, cc = tid & 1;
        float tv[16]; int ti[16];
#pragma unroll
        for (int j = 0; j < 16; ++j) { tv[j] = -INFINITY; ti[j] = 0; }
        for (int nn = 0; nn < 128; ++nn) {
            float x = ss[tk][cc * 128 + nn]; int xi = nn;
#pragma unroll
            for (int j = 0; j < 16; ++j) {
                const bool gt = x > tv[j];
                const float tf = tv[j]; const int tj = ti[j];
                tv[j] = gt ? x : tf; ti[j] = gt ? xi : tj;
                x = gt ? tf : x; xi = gt ? tj : xi;
            }
        }
#pragma unroll
        for (int j = 0; j < 16; ++j) { tvs[tk][cc][j] = tv[j]; tis[tk][cc][j] = ti[j]; }
    }
    __syncthreads();
    if (tid < 32) {
        const int tk = tid;
        float bv[16]; int bi[16];
#pragma unroll
        for (int j = 0; j < 16; ++j) { bv[j] = -INFINITY; bi[j] = 0; }
        for (int i = 0; i < 16; ++i)
            for (int jj = 0; jj < 16; ++jj) {
                float x = tvs[tk][0][i] + tvs[tk][1][jj]; int xi = tis[tk][0][i] * 128 + tis[tk][1][jj];
#pragma unroll
                for (int j = 0; j < 16; ++j) {
                    const bool gt = x > bv[j];
                    const float tf = bv[j]; const int tj = bi[j];
                    bv[j] = gt ? x : tf; bi[j] = gt ? xi : tj;
                    x = gt ? tf : x; xi = gt ? tj : xi;
                }
            }
        float e[16], sum = 0.f;
#pragma unroll
        for (int j = 0; j < 16; ++j) { e[j] = expf(bv[j] - bv[0]); sum += e[j]; }
        const float inv = 1.0f / sum;
        const size_t o = (size_t)(tg * 32 + tk) * 128 + h * 16;
#pragma unroll
        for (int j = 0; j < 16; ++j) { EXP[o + j] = bi[j]; GATE[o + j] = e[j] * inv; }
    }
}

__device__ __forceinline__ void peer_expert(const float* __restrict__ X, const int* __restrict__ EXP, const float* __restrict__ GATE,
                                            const float* __restrict__ U, const float* __restrict__ V,
                                            const float* __restrict__ g, const float* __restrict__ bta, float* __restrict__ out, bf16* __restrict__ outb, int t, float* smem) {
    const int tid = threadIdx.x, lane = tid & 63, wid = tid >> 6;
    float (*accs)[1024] = (float (*)[1024])smem;
    float* sred = smem + 8192;
    const float4* xr = (const float4*)(X + (size_t)t * D);
    float4 xv[4];
#pragma unroll
    for (int j = 0; j < 4; ++j) xv[j] = xr[lane + 64 * j];
    float4 acc[4];
#pragma unroll
    for (int j = 0; j < 4; ++j) acc[j] = make_float4(0.f, 0.f, 0.f, 0.f);
    for (int e = 0; e < 16; ++e) {
        const int id = EXP[(size_t)t * 128 + wid * 16 + e];
        const float gt = GATE[(size_t)t * 128 + wid * 16 + e];
        const float4* ur = (const float4*)(U + (size_t)id * D);
        const float4* vr = (const float4*)(V + (size_t)id * D);
        float4 uv[4], vv[4];
#pragma unroll
        for (int j = 0; j < 4; ++j) { uv[j] = ur[lane + 64 * j]; vv[j] = vr[lane + 64 * j]; }
        float dot = 0.f;
#pragma unroll
        for (int j = 0; j < 4; ++j) dot += uv[j].x * xv[j].x + uv[j].y * xv[j].y + uv[j].z * xv[j].z + uv[j].w * xv[j].w;
        dot = wave_sum(dot);
        const float cf = gt * geluf_(dot);
#pragma unroll
        for (int j = 0; j < 4; ++j) { acc[j].x += cf * vv[j].x; acc[j].y += cf * vv[j].y; acc[j].z += cf * vv[j].z; acc[j].w += cf * vv[j].w; }
    }
#pragma unroll
    for (int j = 0; j < 4; ++j) *(float4*)&accs[wid][(lane + 64 * j) * 4] = acc[j];
    __syncthreads();
    float v[2];
#pragma unroll
    for (int i = 0; i < 2; ++i) {
        const int c = tid * 2 + i;
        float s = 0.f;
#pragma unroll
        for (int w = 0; w < 8; ++w) s += accs[w][c];
        v[i] = ALPHA * X[(size_t)t * D + c] + s;
    }
    float s = wave_sum(v[0] + v[1]);
    if (lane == 0) sred[wid] = s;
    __syncthreads();
    float mean = 0.f;
#pragma unroll
    for (int w = 0; w < 8; ++w) mean += sred[w];
    mean *= (1.0f / 1024.0f);
    __syncthreads();
    const float d0 = v[0] - mean, d1 = v[1] - mean;
    float q = wave_sum(d0 * d0 + d1 * d1);
    if (lane == 0) sred[wid] = q;
    __syncthreads();
    float var = 0.f;
#pragma unroll
    for (int w = 0; w < 8; ++w) var += sred[w];
    const float rs = rsqrtf(var * (1.0f / 1024.0f) + LN_EPS);
    const float o0 = d0 * rs * g[tid * 2] + bta[tid * 2], o1 = d1 * rs * g[tid * 2 + 1] + bta[tid * 2 + 1];
    *(float2*)(out + (size_t)t * D + tid * 2) = make_float2(o0, o1);
    if (outb) *(unsigned*)(outb + (size_t)t * D + tid * 2) = pk2(o0, o1);
}


typedef __bf16 bf16x2_t __attribute__((ext_vector_type(2)));
__device__ __forceinline__ float dot2bf(unsigned w, unsigned x, float acc) { return __builtin_amdgcn_fdot2_f32_bf16(__builtin_bit_cast(bf16x2_t, w), __builtin_bit_cast(bf16x2_t, x), acc, false); }
typedef float f32x2_t __attribute__((ext_vector_type(2)));
__device__ __forceinline__ void row_to_fp8(const float* __restrict__ xrow, unsigned char* __restrict__ orow, float* __restrict__ scale, int lane) {
    f32x4 v[4]; float am = 0.f;
#pragma unroll
    for (int j = 0; j < 4; ++j) { v[j] = *(const f32x4*)(xrow + lane * 16 + j * 4); am = fmaxf(am, fmaxf(fmaxf(fabsf(v[j].x), fabsf(v[j].y)), fmaxf(fabsf(v[j].z), fabsf(v[j].w)))); }
    am = wave_max(am);
    const float s = am > 0.f ? am * (1.0f / 448.0f) : 1.0f, inv = 1.0f / s;
    v4u o;
    unsigned w;
    w = 0u; w = __builtin_amdgcn_cvt_pk_fp8_f32(v[0].x * inv, v[0].y * inv, w, false); w = __builtin_amdgcn_cvt_pk_fp8_f32(v[0].z * inv, v[0].w * inv, w, true); o.x = w;
    w = 0u; w = __builtin_amdgcn_cvt_pk_fp8_f32(v[1].x * inv, v[1].y * inv, w, false); w = __builtin_amdgcn_cvt_pk_fp8_f32(v[1].z * inv, v[1].w * inv, w, true); o.y = w;
    w = 0u; w = __builtin_amdgcn_cvt_pk_fp8_f32(v[2].x * inv, v[2].y * inv, w, false); w = __builtin_amdgcn_cvt_pk_fp8_f32(v[2].z * inv, v[2].w * inv, w, true); o.z = w;
    w = 0u; w = __builtin_amdgcn_cvt_pk_fp8_f32(v[3].x * inv, v[3].y * inv, w, false); w = __builtin_amdgcn_cvt_pk_fp8_f32(v[3].z * inv, v[3].w * inv, w, true); o.w = w;
    *(v4u*)(orow + lane * 16) = o;
    if (lane == 0) *scale = s;
}
#define PE_LOAD(UB, VB, grp) do { _Pragma("unroll") for (int i_ = 0; i_ < 4; ++i_) { const int e_ = (grp) * 4 + i_; \
        const int id_ = __builtin_amdgcn_readlane(e_ < 64 ? id0 : id1, e_ & 63); \
        const unsigned so_ = (unsigned)id_ * 1024u; \
        UB[i_] = __builtin_amdgcn_raw_buffer_load_b128(ursrc, voff, so_, 0); VB[i_] = __builtin_amdgcn_raw_buffer_load_b128(vrsrc, voff, so_, 0); } } while (0)
#define PE_DOT4(w, k) do { const f32x2_t l_ = __builtin_amdgcn_cvt_pk_f32_fp8((w), false), h_ = __builtin_amdgcn_cvt_pk_f32_fp8((w), true); \
        a_ += l_.x * xv[(k) * 4 + 0]; b_ += l_.y * xv[(k) * 4 + 1]; a_ += h_.x * xv[(k) * 4 + 2]; b_ += h_.y * xv[(k) * 4 + 3]; } while (0)
#define PE_AXPY4(w, k) do { const f32x2_t l_ = __builtin_amdgcn_cvt_pk_f32_fp8((w), false), h_ = __builtin_amdgcn_cvt_pk_f32_fp8((w), true); \
        acc[(k) * 4 + 0] += cf_ * l_.x; acc[(k) * 4 + 1] += cf_ * l_.y; acc[(k) * 4 + 2] += cf_ * h_.x; acc[(k) * 4 + 3] += cf_ * h_.y; } while (0)
#define PE_COMP(UB, VB, grp) do { float d_[4]; \
        _Pragma("unroll") for (int i_ = 0; i_ < 4; ++i_) { float a_ = 0.f, b_ = 0.f; PE_DOT4(UB[i_].x, 0); PE_DOT4(UB[i_].y, 1); PE_DOT4(UB[i_].z, 2); PE_DOT4(UB[i_].w, 3); d_[i_] = a_ + b_; } \
          \
        float s0_ = hi32 ? d_[2] : d_[0], t0_ = hi32 ? d_[0] : d_[2]; s0_ += __shfl_xor(t0_, 32); \
        float s1_ = hi32 ? d_[3] : d_[1], t1_ = hi32 ? d_[1] : d_[3]; s1_ += __shfl_xor(t1_, 32); \
        float r_ = hi16 ? s1_ : s0_, t2_ = hi16 ? s0_ : s1_; r_ += __shfl_xor(t2_, 16); \
        r_ += __shfl_xor(r_, 8); r_ += __shfl_xor(r_, 4); r_ += __shfl_xor(r_, 2); r_ += __shfl_xor(r_, 1); \
          \
        const int esel_ = (grp) * 4 + (lane >> 4); \
        const float su_ = __shfl(esel_ < 64 ? su0 : su1, esel_ & 63), gv_ = __shfl(esel_ < 64 ? gs0 : gs1, esel_ & 63); \
        const float cfl_ = geluf_(r_ * su_) * gv_; \
        _Pragma("unroll") for (int i_ = 0; i_ < 4; ++i_) { \
            const float cf_ = __uint_as_float(__builtin_amdgcn_readlane(__float_as_uint(cfl_), 16 * i_)); \
            PE_AXPY4(VB[i_].x, 0); PE_AXPY4(VB[i_].y, 1); PE_AXPY4(VB[i_].z, 2); PE_AXPY4(VB[i_].w, 3); } } while (0)
__device__ __forceinline__ void peer_expert_w(const float* __restrict__ xrow, const int* __restrict__ exr, const float* __restrict__ gar,
                                              const unsigned char* __restrict__ U, const unsigned char* __restrict__ V, const float* __restrict__ SU, const float* __restrict__ SV,
                                              const float* __restrict__ g, const float* __restrict__ bta, float* __restrict__ orow, bf16* __restrict__ obrow, int lane) {
    const bool hi32 = (lane & 32) != 0, hi16 = (lane & 16) != 0;
    const __amdgpu_buffer_rsrc_t ursrc = __builtin_amdgcn_make_buffer_rsrc((void*)U, 0, 16384 * 1024, 0x00020000);
    const __amdgpu_buffer_rsrc_t vrsrc = __builtin_amdgcn_make_buffer_rsrc((void*)V, 0, 16384 * 1024, 0x00020000);
    const int voff = lane * 16;
    float xv[16];
#pragma unroll
    for (int j = 0; j < 4; ++j) { const f32x4 t = *(const f32x4*)(xrow + lane * 16 + j * 4); xv[j * 4 + 0] = t.x; xv[j * 4 + 1] = t.y; xv[j * 4 + 2] = t.z; xv[j * 4 + 3] = t.w; }
    const int id0 = exr[lane], id1 = exr[64 + lane];
    const float su0 = SU[id0], su1 = SU[id1];
    const float gs0 = gar[lane] * SV[id0], gs1 = gar[64 + lane] * SV[id1];
    float acc[16];
#pragma unroll
    for (int i = 0; i < 16; ++i) acc[i] = 0.f;
    v4u ua[4], va[4], ub[4], vb[4];
    PE_LOAD(ua, va, 0);
#pragma unroll 1
    for (int grp = 0; grp < 32; grp += 2) {
        PE_LOAD(ub, vb, grp + 1);
        PE_COMP(ua, va, grp);
        if (grp + 2 < 32) PE_LOAD(ua, va, grp + 2);
        PE_COMP(ub, vb, grp + 1);
    }
    float v[16]; float s = 0.f;
#pragma unroll
    for (int i = 0; i < 16; ++i) { v[i] = ALPHA * xv[i] + acc[i]; s += v[i]; }
    const float mean = wave_sum(s) * (1.0f / 1024.0f); float q = 0.f;
#pragma unroll
    for (int i = 0; i < 16; ++i) { v[i] -= mean; q += v[i] * v[i]; }
    const float rs = rsqrtf(wave_sum(q) * (1.0f / 1024.0f) + LN_EPS);
    float o[16];
#pragma unroll
    for (int j = 0; j < 4; ++j) {
        const f32x4 g4 = *(const f32x4*)(g + lane * 16 + j * 4), b4 = *(const f32x4*)(bta + lane * 16 + j * 4);
        o[j * 4 + 0] = v[j * 4 + 0] * rs * g4.x + b4.x; o[j * 4 + 1] = v[j * 4 + 1] * rs * g4.y + b4.y; o[j * 4 + 2] = v[j * 4 + 2] * rs * g4.z + b4.z; o[j * 4 + 3] = v[j * 4 + 3] * rs * g4.w + b4.w;
        *(f32x4*)(orow + lane * 16 + j * 4) = (f32x4){o[j * 4 + 0], o[j * 4 + 1], o[j * 4 + 2], o[j * 4 + 3]};
    }
    if (obrow) {
        v4u w0, w1; w0.x = pk2(o[0], o[1]); w0.y = pk2(o[2], o[3]); w0.z = pk2(o[4], o[5]); w0.w = pk2(o[6], o[7]); w1.x = pk2(o[8], o[9]); w1.y = pk2(o[10], o[11]); w1.z = pk2(o[12], o[13]); w1.w = pk2(o[14], o[15]);
        *(v4u*)(obrow + lane * 16) = w0; *(v4u*)(obrow + lane * 16 + 8) = w1;
    }
}


__device__ __forceinline__ void peer_expert_blk(const float* __restrict__ xrow, const int* __restrict__ exr, const float* __restrict__ gar,
                                                const unsigned char* __restrict__ U, const unsigned char* __restrict__ V, const float* __restrict__ SU, const float* __restrict__ SV,
                                                const float* __restrict__ g, const float* __restrict__ bta, float* __restrict__ orow, bf16* __restrict__ obrow, int lane, int wave, float* smem) {
    const bool hi32 = (lane & 32) != 0, hi16 = (lane & 16) != 0;
    const __amdgpu_buffer_rsrc_t ursrc = __builtin_amdgcn_make_buffer_rsrc((void*)U, 0, 16384 * 1024, 0x00020000);
    const __amdgpu_buffer_rsrc_t vrsrc = __builtin_amdgcn_make_buffer_rsrc((void*)V, 0, 16384 * 1024, 0x00020000);
    const int voff = lane * 16;
    float xv[16];
#pragma unroll
    for (int j = 0; j < 4; ++j) { const f32x4 t = *(const f32x4*)(xrow + lane * 16 + j * 4); xv[j * 4 + 0] = t.x; xv[j * 4 + 1] = t.y; xv[j * 4 + 2] = t.z; xv[j * 4 + 3] = t.w; }
    const int id0 = exr[lane], id1 = exr[64 + lane];
    const float su0 = SU[id0], su1 = SU[id1];
    const float gs0 = gar[lane] * SV[id0], gs1 = gar[64 + lane] * SV[id1];
    float acc[16];
#pragma unroll
    for (int i = 0; i < 16; ++i) acc[i] = 0.f;
    v4u ua[4], va[4], ub[4], vb[4];
    const int g0 = wave * 4;
    PE_LOAD(ua, va, g0); PE_LOAD(ub, vb, g0 + 1);
    PE_COMP(ua, va, g0); PE_LOAD(ua, va, g0 + 2);
    PE_COMP(ub, vb, g0 + 1); PE_LOAD(ub, vb, g0 + 3);
    PE_COMP(ua, va, g0 + 2);
    PE_COMP(ub, vb, g0 + 3);
    float* accs = smem;
    float* sred = smem + 8192;
#pragma unroll
    for (int j = 0; j < 4; ++j) *(f32x4*)(accs + wave * 1024 + lane * 16 + j * 4) = (f32x4){acc[j * 4 + 0], acc[j * 4 + 1], acc[j * 4 + 2], acc[j * 4 + 3]};
    __syncthreads();
    const int tid = wave * 64 + lane;
    float v0 = ALPHA * xrow[tid * 2], v1 = ALPHA * xrow[tid * 2 + 1];
#pragma unroll
    for (int w = 0; w < 8; ++w) { v0 += accs[w * 1024 + tid * 2]; v1 += accs[w * 1024 + tid * 2 + 1]; }
    const float s = wave_sum(v0 + v1);
    if (lane == 0) sred[wave] = s;
    __syncthreads();
    float mean = 0.f;
#pragma unroll
    for (int w = 0; w < 8; ++w) mean += sred[w];
    mean *= (1.0f / 1024.0f);
    __syncthreads();
    const float d0 = v0 - mean, d1 = v1 - mean;
    const float q = wave_sum(d0 * d0 + d1 * d1);
    if (lane == 0) sred[wave] = q;
    __syncthreads();
    float var = 0.f;
#pragma unroll
    for (int w = 0; w < 8; ++w) var += sred[w];
    const float rs = rsqrtf(var * (1.0f / 1024.0f) + LN_EPS);
    const float o0 = d0 * rs * g[tid * 2] + bta[tid * 2], o1 = d1 * rs * g[tid * 2 + 1] + bta[tid * 2 + 1];
    *(float2*)(orow + tid * 2) = make_float2(o0, o1);
    if (obrow) *(unsigned*)(obrow + tid * 2) = pk2(o0, o1);
    __syncthreads();
}

__device__ __forceinline__ void row_to_fp8_sliced(const float* __restrict__ xrow, unsigned char* __restrict__ tab, int r, float* __restrict__ scale, int lane) {
    f32x4 v[4]; float am = 0.f;
#pragma unroll
    for (int j = 0; j < 4; ++j) { v[j] = *(const f32x4*)(xrow + lane * 16 + j * 4); am = fmaxf(am, fmaxf(fmaxf(fabsf(v[j].x), fabsf(v[j].y)), fmaxf(fabsf(v[j].z), fabsf(v[j].w)))); }
    am = wave_max(am);
    const float s = am > 0.f ? am * (1.0f / 448.0f) : 1.0f, inv = 1.0f / s;
    v4u o; unsigned w;
    w = 0u; w = __builtin_amdgcn_cvt_pk_fp8_f32(v[0].x * inv, v[0].y * inv, w, false); w = __builtin_amdgcn_cvt_pk_fp8_f32(v[0].z * inv, v[0].w * inv, w, true); o.x = w;
    w = 0u; w = __builtin_amdgcn_cvt_pk_fp8_f32(v[1].x * inv, v[1].y * inv, w, false); w = __builtin_amdgcn_cvt_pk_fp8_f32(v[1].z * inv, v[1].w * inv, w, true); o.y = w;
    w = 0u; w = __builtin_amdgcn_cvt_pk_fp8_f32(v[2].x * inv, v[2].y * inv, w, false); w = __builtin_amdgcn_cvt_pk_fp8_f32(v[2].z * inv, v[2].w * inv, w, true); o.z = w;
    w = 0u; w = __builtin_amdgcn_cvt_pk_fp8_f32(v[3].x * inv, v[3].y * inv, w, false); w = __builtin_amdgcn_cvt_pk_fp8_f32(v[3].z * inv, v[3].w * inv, w, true); o.w = w;
    *(v4u*)(tab + ((size_t)(lane >> 3) * 16384 + r) * 128 + (lane & 7) * 16) = o;
    if (lane == 0) *scale = s;
}
__device__ __forceinline__ void row_to_i8_sliced(const float* __restrict__ xrow, unsigned char* __restrict__ tab, int r, float* __restrict__ scale, int lane) {
    f32x4 v[4]; float am = 0.f;
#pragma unroll
    for (int j = 0; j < 4; ++j) { v[j] = *(const f32x4*)(xrow + lane * 16 + j * 4); am = fmaxf(am, fmaxf(fmaxf(fabsf(v[j].x), fabsf(v[j].y)), fmaxf(fabsf(v[j].z), fabsf(v[j].w)))); }
    am = wave_max(am);
    const float s = am > 0.f ? am * (1.0f / 127.0f) : 1.0f, inv = 1.0f / s;
    v4u o;
#define I8PK(q_) (((unsigned)(int)rintf((q_).x * inv) & 0xffu) | (((unsigned)(int)rintf((q_).y * inv) & 0xffu) << 8) | (((unsigned)(int)rintf((q_).z * inv) & 0xffu) << 16) | (((unsigned)(int)rintf((q_).w * inv) & 0xffu) << 24))
    o.x = I8PK(v[0]); o.y = I8PK(v[1]); o.z = I8PK(v[2]); o.w = I8PK(v[3]);
    *(v4u*)(tab + ((size_t)(lane >> 3) * 16384 + r) * 128 + (lane & 7) * 16) = o;
    if (lane == 0) *scale = s;
}
__device__ __forceinline__ void peer_u_pass(const bf16* __restrict__ xrow, const int* __restrict__ exr, const unsigned char* __restrict__ U8x, float* __restrict__ pd, int x, int lane) {
    const int e8 = lane >> 3, c = lane & 7;
    f32x2_t xp[8];
#pragma unroll
    for (int j = 0; j < 2; ++j) { const v4u t = *(const v4u*)(xrow + x * 128 + c * 16 + j * 8);
        xp[j * 4 + 0] = (f32x2_t){bflo(t.x), bfhi(t.x)}; xp[j * 4 + 1] = (f32x2_t){bflo(t.y), bfhi(t.y)}; xp[j * 4 + 2] = (f32x2_t){bflo(t.z), bfhi(t.z)}; xp[j * 4 + 3] = (f32x2_t){bflo(t.w), bfhi(t.w)}; }
    const __amdgpu_buffer_rsrc_t ursrc = __builtin_amdgcn_make_buffer_rsrc((void*)U8x, 0, 16384 * 128, 0x00020000);
    v4u wa[8], wb[8];
    float d[16];
    int ids[16];
#pragma unroll
    for (int j = 0; j < 4; ++j) { const v4u t = *(const v4u*)(exr + e8 * 16 + j * 4); ids[j * 4 + 0] = (int)t.x; ids[j * 4 + 1] = (int)t.y; ids[j * 4 + 2] = (int)t.z; ids[j * 4 + 3] = (int)t.w; }
#pragma unroll
    for (int g = 0; g < 8; ++g) wa[g] = __builtin_amdgcn_raw_buffer_load_b128(ursrc, ids[g] * 128 + c * 16, 0, 0);
#pragma unroll
    for (int g = 0; g < 8; ++g) wb[g] = __builtin_amdgcn_raw_buffer_load_b128(ursrc, ids[8 + g] * 128 + c * 16, 0, 0);
#define PU_DOT1(w_, k_) do { a_ = __builtin_elementwise_fma(__builtin_amdgcn_cvt_pk_f32_fp8((w_), false), xp[(k_) * 2], a_); a_ = __builtin_elementwise_fma(__builtin_amdgcn_cvt_pk_f32_fp8((w_), true), xp[(k_) * 2 + 1], a_); } while (0)
#pragma unroll
    for (int g = 0; g < 8; ++g) { f32x2_t a_ = (f32x2_t){0.f, 0.f}; PU_DOT1(wa[g].x, 0); PU_DOT1(wa[g].y, 1); PU_DOT1(wa[g].z, 2); PU_DOT1(wa[g].w, 3); d[g] = a_.x + a_.y; }
#pragma unroll
    for (int g = 0; g < 8; ++g) { f32x2_t a_ = (f32x2_t){0.f, 0.f}; PU_DOT1(wb[g].x, 0); PU_DOT1(wb[g].y, 1); PU_DOT1(wb[g].z, 2); PU_DOT1(wb[g].w, 3); d[8 + g] = a_.x + a_.y; }
#pragma unroll
    for (int g = 0; g < 16; ++g) { d[g] += DPPF(d[g], 0xB1, 0xf); d[g] += DPPF(d[g], 0x4E, 0xf); d[g] += DPPF(d[g], 0x141, 0xf); }
    if (c == 0) {
#pragma unroll
        for (int j = 0; j < 4; ++j) *(f32x4*)(pd + e8 * 16 + j * 4) = (f32x4){d[j * 4 + 0], d[j * 4 + 1], d[j * 4 + 2], d[j * 4 + 3]};
    }
}
#define PUL_IDS(I, k_) do { const int t_ = ((tg0 + ((k_) < nit ? (k_) : nit - 1) * tgstep) * 8 + wave); _Pragma("unroll") for (int j = 0; j < 4; ++j) I[j] = *(const v4u*)(EXPp + (size_t)t_ * 128 + e8 * 16 + j * 4); } while (0)
#define PUL_ROWS(R, X, I, k_) do { const int t_ = ((tg0 + ((k_) < nit ? (k_) : nit - 1) * tgstep) * 8 + wave); \
        X[0] = *(const v4u*)(XBp + (size_t)t_ * D + x * 128 + c * 16); X[1] = *(const v4u*)(XBp + (size_t)t_ * D + x * 128 + c * 16 + 8); \
        _Pragma("unroll") for (int j = 0; j < 4; ++j) { R[j * 4 + 0] = __builtin_amdgcn_raw_buffer_load_b128(ursrc, (int)I[j].x * 128 + c * 16, 0, 0); R[j * 4 + 1] = __builtin_amdgcn_raw_buffer_load_b128(ursrc, (int)I[j].y * 128 + c * 16, 0, 0); \
            R[j * 4 + 2] = __builtin_amdgcn_raw_buffer_load_b128(ursrc, (int)I[j].z * 128 + c * 16, 0, 0); R[j * 4 + 3] = __builtin_amdgcn_raw_buffer_load_b128(ursrc, (int)I[j].w * 128 + c * 16, 0, 0); } } while (0)
#define PUL_COMP(R, X, k_) do { float xf_[16]; \
        _Pragma("unroll") for (int j = 0; j < 2; ++j) { xf_[j * 8 + 0] = bflo(X[j].x); xf_[j * 8 + 1] = bfhi(X[j].x); xf_[j * 8 + 2] = bflo(X[j].y); xf_[j * 8 + 3] = bfhi(X[j].y); xf_[j * 8 + 4] = bflo(X[j].z); xf_[j * 8 + 5] = bfhi(X[j].z); xf_[j * 8 + 6] = bflo(X[j].w); xf_[j * 8 + 7] = bfhi(X[j].w); } \
          \
        float am_ = 0.f; _Pragma("unroll") for (int i = 0; i < 16; ++i) am_ = fmaxf(am_, fabsf(xf_[i])); \
        am_ = fmaxf(am_, DPPF(am_, 0xB1, 0xf)); am_ = fmaxf(am_, DPPF(am_, 0x4E, 0xf)); am_ = fmaxf(am_, DPPF(am_, 0x141, 0xf)); \
        const float sx_ = am_ > 0.f ? am_ * (1.0f / 127.0f) : 1.0f, ix_ = 1.0f / sx_; \
        int xq_[4]; \
        _Pragma("unroll") for (int j = 0; j < 4; ++j) xq_[j] = (int)(((unsigned)(int)rintf(xf_[j * 4 + 0] * ix_) & 0xffu) | (((unsigned)(int)rintf(xf_[j * 4 + 1] * ix_) & 0xffu) << 8) | (((unsigned)(int)rintf(xf_[j * 4 + 2] * ix_) & 0xffu) << 16) | (((unsigned)(int)rintf(xf_[j * 4 + 3] * ix_) & 0xffu) << 24)); \
        float d[16]; \
        _Pragma("unroll") for (int g = 0; g < 16; ++g) { int a_ = __builtin_amdgcn_sdot4((int)R[g].x, xq_[0], 0, false); a_ = __builtin_amdgcn_sdot4((int)R[g].y, xq_[1], a_, false); a_ = __builtin_amdgcn_sdot4((int)R[g].z, xq_[2], a_, false); a_ = __builtin_amdgcn_sdot4((int)R[g].w, xq_[3], a_, false); d[g] = (float)a_; } \
        _Pragma("unroll") for (int g = 0; g < 16; ++g) { d[g] += DPPF(d[g], 0xB1, 0xf); d[g] += DPPF(d[g], 0x4E, 0xf); d[g] += DPPF(d[g], 0x141, 0xf); d[g] *= sx_; } \
        if (c == 0 && (k_) < nit) { float* pd_ = PDx + (size_t)((tg0 + (k_) * tgstep) * 8 + wave) * 128 + e8 * 16; \
            _Pragma("unroll") for (int j = 0; j < 4; ++j) *(f32x4*)(pd_ + j * 4) = (f32x4){d[j * 4 + 0], d[j * 4 + 1], d[j * 4 + 2], d[j * 4 + 3]}; } } while (0)
__device__ __forceinline__ void peer_u_loop(const bf16* __restrict__ XBp, const int* __restrict__ EXPp, const unsigned char* __restrict__ U8x, float* __restrict__ PDx, int x, int tg0, int tgstep, int nit, int wave, int lane) {
    const int e8 = lane >> 3, c = lane & 7;
    const __amdgpu_buffer_rsrc_t ursrc = __builtin_amdgcn_make_buffer_rsrc((void*)U8x, 0, 16384 * 128, 0x00020000);
    v4u ra[16], rb[16], xa[2], xb[2], i0[4], i1[4];
    PUL_IDS(i0, 0);
    PUL_ROWS(ra, xa, i0, 0);
    PUL_IDS(i1, 1);
#pragma unroll 1
    for (int k = 0; k < nit; k += 2) {
        PUL_ROWS(rb, xb, i1, k + 1);
        PUL_IDS(i0, k + 2);
        PUL_COMP(ra, xa, k);
        PUL_ROWS(ra, xa, i0, k + 2);
        PUL_IDS(i1, k + 3);
        PUL_COMP(rb, xb, k + 1);
    }
}
#define PV_LOAD(VB, grp) do { _Pragma("unroll") for (int i_ = 0; i_ < 4; ++i_) { const int e_ = (grp) * 4 + i_; \
        const int id_ = __builtin_amdgcn_readlane(e_ < 64 ? id0 : id1, e_ & 63); \
        VB[i_] = __builtin_amdgcn_raw_buffer_load_b128(vrsrc, voff, (unsigned)id_ * 1024u, 0); } } while (0)
#define PV_COMP(VB, grp) do { _Pragma("unroll") for (int i_ = 0; i_ < 4; ++i_) { const int e_ = (grp) * 4 + i_; \
        const float cf_ = __uint_as_float(__builtin_amdgcn_readlane(__float_as_uint(e_ < 64 ? cf0 : cf1), e_ & 63)); \
        PE_AXPY4(VB[i_].x, 0); PE_AXPY4(VB[i_].y, 1); PE_AXPY4(VB[i_].z, 2); PE_AXPY4(VB[i_].w, 3); } } while (0)
#define PV_COEFS() \
    const int id0 = exr[lane], id1 = exr[64 + lane]; \
    float dot0 = 0.f, dot1 = 0.f; \
    { const int p0 = lane, p1 = 64 + lane;        \
      _Pragma("unroll") for (int x_ = 0; x_ < 8; ++x_) { dot0 += pdt[(size_t)x_ * NT * 128 + p0]; dot1 += pdt[(size_t)x_ * NT * 128 + p1]; } } \
    const float cf0 = gar[lane] * SV[id0] * geluf_(SU[id0] * dot0), cf1 = gar[64 + lane] * SV[id1] * geluf_(SU[id1] * dot1);
__device__ __forceinline__ void peer_v_w(const float* __restrict__ xrow, const int* __restrict__ exr, const float* __restrict__ gar, const float* __restrict__ pdt,
                                         const unsigned char* __restrict__ V, const float* __restrict__ SU, const float* __restrict__ SV,
                                         const float* __restrict__ g, const float* __restrict__ bta, float* __restrict__ orow, bf16* __restrict__ obrow, int lane) {
    const __amdgpu_buffer_rsrc_t vrsrc = __builtin_amdgcn_make_buffer_rsrc((void*)V, 0, 16384 * 1024, 0x00020000);
    const int voff = lane * 16;
    PV_COEFS()
    float acc[16];
#pragma unroll
    for (int i = 0; i < 16; ++i) acc[i] = 0.f;
    v4u va[4], vb[4], vc[4];
    PV_LOAD(va, 0); PV_LOAD(vb, 1);
#pragma unroll 1
    for (int grp = 0; grp < 30; grp += 3) {
        PV_LOAD(vc, grp + 2);
        PV_COMP(va, grp);
        PV_LOAD(va, grp + 3);
        PV_COMP(vb, grp + 1);
        PV_LOAD(vb, grp + 4);
        PV_COMP(vc, grp + 2);
    }
    PV_COMP(va, 30); PV_COMP(vb, 31);
    float xv[16];
#pragma unroll
    for (int j = 0; j < 4; ++j) { const f32x4 t = *(const f32x4*)(xrow + lane * 16 + j * 4); xv[j * 4 + 0] = t.x; xv[j * 4 + 1] = t.y; xv[j * 4 + 2] = t.z; xv[j * 4 + 3] = t.w; }
    float v[16]; float s = 0.f;
#pragma unroll
    for (int i = 0; i < 16; ++i) { v[i] = ALPHA * xv[i] + acc[i]; s += v[i]; }
    const float mean = wave_sum(s) * (1.0f / 1024.0f); float q = 0.f;
#pragma unroll
    for (int i = 0; i < 16; ++i) { v[i] -= mean; q += v[i] * v[i]; }
    const float rs = rsqrtf(wave_sum(q) * (1.0f / 1024.0f) + LN_EPS);
    float o[16];
#pragma unroll
    for (int j = 0; j < 4; ++j) {
        const f32x4 g4 = *(const f32x4*)(g + lane * 16 + j * 4), b4 = *(const f32x4*)(bta + lane * 16 + j * 4);
        o[j * 4 + 0] = v[j * 4 + 0] * rs * g4.x + b4.x; o[j * 4 + 1] = v[j * 4 + 1] * rs * g4.y + b4.y; o[j * 4 + 2] = v[j * 4 + 2] * rs * g4.z + b4.z; o[j * 4 + 3] = v[j * 4 + 3] * rs * g4.w + b4.w;
        *(f32x4*)(orow + lane * 16 + j * 4) = (f32x4){o[j * 4 + 0], o[j * 4 + 1], o[j * 4 + 2], o[j * 4 + 3]};
    }
    if (obrow) {
        v4u w0, w1; w0.x = pk2(o[0], o[1]); w0.y = pk2(o[2], o[3]); w0.z = pk2(o[4], o[5]); w0.w = pk2(o[6], o[7]); w1.x = pk2(o[8], o[9]); w1.y = pk2(o[10], o[11]); w1.z = pk2(o[12], o[13]); w1.w = pk2(o[14], o[15]);
        *(v4u*)(obrow + lane * 16) = w0; *(v4u*)(obrow + lane * 16 + 8) = w1;
    }
}
__device__ __forceinline__ void peer_v_blk(const float* __restrict__ xrow, const int* __restrict__ exr, const float* __restrict__ gar, const float* __restrict__ pdt,
                                           const unsigned char* __restrict__ V, const float* __restrict__ SU, const float* __restrict__ SV,
                                           const float* __restrict__ g, const float* __restrict__ bta, float* __restrict__ orow, bf16* __restrict__ obrow, int lane, int wave, float* smem) {
    const __amdgpu_buffer_rsrc_t vrsrc = __builtin_amdgcn_make_buffer_rsrc((void*)V, 0, 16384 * 1024, 0x00020000);
    const int voff = lane * 16;
    PV_COEFS()
    float acc[16];
#pragma unroll
    for (int i = 0; i < 16; ++i) acc[i] = 0.f;
    v4u va[4], vb[4], vc[4], vd[4];
    PV_LOAD(va, wave * 4); PV_LOAD(vb, wave * 4 + 1); PV_LOAD(vc, wave * 4 + 2); PV_LOAD(vd, wave * 4 + 3);
    PV_COMP(va, wave * 4); PV_COMP(vb, wave * 4 + 1); PV_COMP(vc, wave * 4 + 2); PV_COMP(vd, wave * 4 + 3);
    float* accs = smem;
    float* sred = smem + 8192;
#pragma unroll
    for (int j = 0; j < 4; ++j) *(f32x4*)(accs + wave * 1024 + lane * 16 + j * 4) = (f32x4){acc[j * 4 + 0], acc[j * 4 + 1], acc[j * 4 + 2], acc[j * 4 + 3]};
    __syncthreads();
    const int tid = wave * 64 + lane;
    float v0 = ALPHA * xrow[tid * 2], v1 = ALPHA * xrow[tid * 2 + 1];
#pragma unroll
    for (int w = 0; w < 8; ++w) { v0 += accs[w * 1024 + tid * 2]; v1 += accs[w * 1024 + tid * 2 + 1]; }
    const float s = wave_sum(v0 + v1);
    if (lane == 0) sred[wave] = s;
    __syncthreads();
    float mean = 0.f;
#pragma unroll
    for (int w = 0; w < 8; ++w) mean += sred[w];
    mean *= (1.0f / 1024.0f);
    __syncthreads();
    const float d0 = v0 - mean, d1 = v1 - mean;
    const float q = wave_sum(d0 * d0 + d1 * d1);
    if (lane == 0) sred[wave] = q;
    __syncthreads();
    float var = 0.f;
#pragma unroll
    for (int w = 0; w < 8; ++w) var += sred[w];
    const float rs = rsqrtf(var * (1.0f / 1024.0f) + LN_EPS);
    const float o0 = d0 * rs * g[tid * 2] + bta[tid * 2], o1 = d1 * rs * g[tid * 2 + 1] + bta[tid * 2 + 1];
    *(float2*)(orow + tid * 2) = make_float2(o0, o1);
    if (obrow) *(unsigned*)(obrow + tid * 2) = pk2(o0, o1);
    __syncthreads();
}

__device__ __forceinline__ void peer_xk(const int* __restrict__ exr, float* __restrict__ gar, const float* __restrict__ pdt, const float* __restrict__ SU, const float* __restrict__ SV, int lane) {
    PV_COEFS()
    gar[lane] = cf0; gar[64 + lane] = cf1;
}
__device__ __forceinline__ void peer_v_slice(const int* __restrict__ exr, const float* __restrict__ cfr, const unsigned char* __restrict__ V8x, float* __restrict__ outs  , int lane) {
    const int e8 = lane >> 3, c = lane & 7;
    const __amdgpu_buffer_rsrc_t vrsrc = __builtin_amdgcn_make_buffer_rsrc((void*)V8x, 0, 16384 * 128, 0x00020000);
    v4u wa[8], wb[8]; float cfa[8], cfb[8];
    int ids[16];
#pragma unroll
    for (int j = 0; j < 4; ++j) { const v4u t = *(const v4u*)(exr + e8 * 16 + j * 4); ids[j * 4 + 0] = (int)t.x; ids[j * 4 + 1] = (int)t.y; ids[j * 4 + 2] = (int)t.z; ids[j * 4 + 3] = (int)t.w; }
#pragma unroll
    for (int g = 0; g < 8; ++g) wa[g] = __builtin_amdgcn_raw_buffer_load_b128(vrsrc, ids[g] * 128 + c * 16, 0, 0);
#pragma unroll
    for (int g = 0; g < 8; ++g) wb[g] = __builtin_amdgcn_raw_buffer_load_b128(vrsrc, ids[8 + g] * 128 + c * 16, 0, 0);
#pragma unroll
    for (int j = 0; j < 2; ++j) { const f32x4 t = *(const f32x4*)(cfr + e8 * 16 + j * 4), u = *(const f32x4*)(cfr + e8 * 16 + 8 + j * 4);
        cfa[j * 4 + 0] = t.x; cfa[j * 4 + 1] = t.y; cfa[j * 4 + 2] = t.z; cfa[j * 4 + 3] = t.w; cfb[j * 4 + 0] = u.x; cfb[j * 4 + 1] = u.y; cfb[j * 4 + 2] = u.z; cfb[j * 4 + 3] = u.w; }
    f32x2_t ap[8];
#pragma unroll
    for (int i = 0; i < 8; ++i) ap[i] = (f32x2_t){0.f, 0.f};
#define PVS_AXPY(w_, k_) do { ap[(k_) * 2] = __builtin_elementwise_fma(cf2_, __builtin_amdgcn_cvt_pk_f32_fp8((w_), false), ap[(k_) * 2]); ap[(k_) * 2 + 1] = __builtin_elementwise_fma(cf2_, __builtin_amdgcn_cvt_pk_f32_fp8((w_), true), ap[(k_) * 2 + 1]); } while (0)
#pragma unroll
    for (int g = 0; g < 8; ++g) { const f32x2_t cf2_ = (f32x2_t){cfa[g], cfa[g]}; PVS_AXPY(wa[g].x, 0); PVS_AXPY(wa[g].y, 1); PVS_AXPY(wa[g].z, 2); PVS_AXPY(wa[g].w, 3); }
#pragma unroll
    for (int g = 0; g < 8; ++g) { const f32x2_t cf2_ = (f32x2_t){cfb[g], cfb[g]}; PVS_AXPY(wb[g].x, 0); PVS_AXPY(wb[g].y, 1); PVS_AXPY(wb[g].z, 2); PVS_AXPY(wb[g].w, 3); }
#undef PVS_AXPY
    float acc[16];
#pragma unroll
    for (int i = 0; i < 8; ++i) { acc[2 * i] = ap[i].x; acc[2 * i + 1] = ap[i].y; }
#pragma unroll
    for (int i = 0; i < 16; ++i) { float v = acc[i]; v += DPPF(v, 0x128, 0xf); v += __shfl_xor(v, 16); v += __shfl_xor(v, 32); acc[i] = v; }
    if (e8 == 0) {
#pragma unroll
        for (int j = 0; j < 4; ++j) *(f32x4*)(outs + c * 16 + j * 4) = (f32x4){acc[j * 4 + 0], acc[j * 4 + 1], acc[j * 4 + 2], acc[j * 4 + 3]};
    }
}
#define PVL_IDS(I, k_) do { const int t_ = ((tg0 + ((k_) < nit ? (k_) : nit - 1) * tgstep) * 8 + wave); _Pragma("unroll") for (int j = 0; j < 4; ++j) I[j] = *(const v4u*)(EXPp + (size_t)t_ * 128 + e8 * 16 + j * 4); } while (0)
#define PVL_ROWS(R, C, I, k_) do { const int t_ = ((tg0 + ((k_) < nit ? (k_) : nit - 1) * tgstep) * 8 + wave); \
        _Pragma("unroll") for (int j = 0; j < 4; ++j) C[j] = *(const f32x4*)(CFp + (size_t)t_ * 128 + e8 * 16 + j * 4); \
        _Pragma("unroll") for (int j = 0; j < 4; ++j) { R[j * 4 + 0] = __builtin_amdgcn_raw_buffer_load_b128(vrsrc, (int)I[j].x * 128 + c * 16, 0, 0); R[j * 4 + 1] = __builtin_amdgcn_raw_buffer_load_b128(vrsrc, (int)I[j].y * 128 + c * 16, 0, 0); \
            R[j * 4 + 2] = __builtin_amdgcn_raw_buffer_load_b128(vrsrc, (int)I[j].z * 128 + c * 16, 0, 0); R[j * 4 + 3] = __builtin_amdgcn_raw_buffer_load_b128(vrsrc, (int)I[j].w * 128 + c * 16, 0, 0); } } while (0)
#define PVL_AXPY(w_, k2_) do { ap[(k2_) * 2] = __builtin_elementwise_fma(cf2_, __builtin_amdgcn_cvt_pk_f32_fp8((w_), false), ap[(k2_) * 2]); ap[(k2_) * 2 + 1] = __builtin_elementwise_fma(cf2_, __builtin_amdgcn_cvt_pk_f32_fp8((w_), true), ap[(k2_) * 2 + 1]); } while (0)
#define PVL_COMP(R, C, k_) do { f32x2_t ap[8]; \
        _Pragma("unroll") for (int i = 0; i < 8; ++i) ap[i] = (f32x2_t){0.f, 0.f}; \
        _Pragma("unroll") for (int g = 0; g < 16; ++g) { const float cfs_ = C[g >> 2][g & 3]; const f32x2_t cf2_ = (f32x2_t){cfs_, cfs_}; PVL_AXPY(R[g].x, 0); PVL_AXPY(R[g].y, 1); PVL_AXPY(R[g].z, 2); PVL_AXPY(R[g].w, 3); } \
        float acc[16]; \
        _Pragma("unroll") for (int i = 0; i < 8; ++i) { acc[2 * i] = ap[i].x; acc[2 * i + 1] = ap[i].y; } \
        float a8[8], a4[4], a2[2]; \
        _Pragma("unroll") for (int i = 0; i < 8; ++i) { const float keep = hA ? acc[8 + i] : acc[i], send = hA ? acc[i] : acc[8 + i]; a8[i] = keep + __shfl_xor(send, 32); } \
        _Pragma("unroll") for (int i = 0; i < 4; ++i) { const float keep = hB ? a8[4 + i] : a8[i], send = hB ? a8[i] : a8[4 + i]; a4[i] = keep + __shfl_xor(send, 16); } \
        _Pragma("unroll") for (int i = 0; i < 2; ++i) { const float keep = hC ? a4[2 + i] : a4[i], send = hC ? a4[i] : a4[2 + i]; a2[i] = keep + DPPF(send, 0x128, 0xf); } \
        if ((k_) < nit) *(float2*)(OUTp + (size_t)((tg0 + (k_) * tgstep) * 8 + wave) * D + x * 128 + c * 16 + 2 * e8) = make_float2(a2[0], a2[1]); } while (0)
__device__ __forceinline__ void peer_v_loop(const int* __restrict__ EXPp, const float* __restrict__ CFp, const unsigned char* __restrict__ V8x, float* __restrict__ OUTp, int x, int tg0, int tgstep, int nit, int wave, int lane) {
    const int e8 = lane >> 3, c = lane & 7;
    const bool hA = (lane & 32) != 0, hB = (lane & 16) != 0, hC = (lane & 8) != 0;
    const __amdgpu_buffer_rsrc_t vrsrc = __builtin_amdgcn_make_buffer_rsrc((void*)V8x, 0, 16384 * 128, 0x00020000);
    v4u ra[16], rb[16], i0[4], i1[4]; f32x4 ca[4], cb[4];
    PVL_IDS(i0, 0);
    PVL_ROWS(ra, ca, i0, 0);
    PVL_IDS(i1, 1);
#pragma unroll 1
    for (int k = 0; k < nit; k += 2) {
        PVL_ROWS(rb, cb, i1, k + 1);
        PVL_IDS(i0, k + 2);
        PVL_COMP(ra, ca, k);
        PVL_ROWS(ra, ca, i0, k + 2);
        PVL_IDS(i1, k + 3);
        PVL_COMP(rb, cb, k + 1);
    }
}
__device__ __forceinline__ void peer_xc(const bf16* __restrict__ xrow, const float* __restrict__ srow, const float* __restrict__ g, const float* __restrict__ bta, float* __restrict__ orow, bf16* __restrict__ obrow, bf16* __restrict__ obrow2, int lane) {
    float v[16]; float s = 0.f;
#pragma unroll
    for (int j = 0; j < 4; ++j) { const v2u ab = *(const v2u*)(xrow + lane * 16 + j * 4); const f32x4 b = *(const f32x4*)(srow + lane * 16 + j * 4);
        v[j * 4 + 0] = ALPHA * bflo(ab.x) + b.x; v[j * 4 + 1] = ALPHA * bfhi(ab.x) + b.y; v[j * 4 + 2] = ALPHA * bflo(ab.y) + b.z; v[j * 4 + 3] = ALPHA * bfhi(ab.y) + b.w; }
#pragma unroll
    for (int i = 0; i < 16; ++i) s += v[i];
    const float mean = wave_sum(s) * (1.0f / 1024.0f); float q = 0.f;
#pragma unroll
    for (int i = 0; i < 16; ++i) { v[i] -= mean; q += v[i] * v[i]; }
    const float rs = rsqrtf(wave_sum(q) * (1.0f / 1024.0f) + LN_EPS);
    float o[16];
#pragma unroll
    for (int j = 0; j < 4; ++j) {
        const f32x4 g4 = *(const f32x4*)(g + lane * 16 + j * 4), b4 = *(const f32x4*)(bta + lane * 16 + j * 4);
        o[j * 4 + 0] = v[j * 4 + 0] * rs * g4.x + b4.x; o[j * 4 + 1] = v[j * 4 + 1] * rs * g4.y + b4.y; o[j * 4 + 2] = v[j * 4 + 2] * rs * g4.z + b4.z; o[j * 4 + 3] = v[j * 4 + 3] * rs * g4.w + b4.w;
        if (orow) *(f32x4*)(orow + lane * 16 + j * 4) = (f32x4){o[j * 4 + 0], o[j * 4 + 1], o[j * 4 + 2], o[j * 4 + 3]};
    }
    if (obrow) {
        v4u w0, w1; w0.x = pk2(o[0], o[1]); w0.y = pk2(o[2], o[3]); w0.z = pk2(o[4], o[5]); w0.w = pk2(o[6], o[7]); w1.x = pk2(o[8], o[9]); w1.y = pk2(o[10], o[11]); w1.z = pk2(o[12], o[13]); w1.w = pk2(o[14], o[15]);
        *(v4u*)(obrow + lane * 16) = w0; *(v4u*)(obrow + lane * 16 + 8) = w1;
        if (obrow2) { *(v4u*)(obrow2 + lane * 16) = w0; *(v4u*)(obrow2 + lane * 16 + 8) = w1; }
    }
}

__device__ __forceinline__ int t5_bucket(int n) {
    if (n < 16) return n;
    const int large = 16 + (int)(logf((float)n / 16.0f) / 2.0794415416798357f * 16.0f);
    return large < 31 ? large : 31;
}
__device__ __forceinline__ void swa_attn(const float* __restrict__ PC, const float* __restrict__ cache_k, const float* __restrict__ cache_v,
                                         const float* __restrict__ rel_bias, const float* __restrict__ sinks, bf16* __restrict__ ATT, int bx) {
    const int tid = threadIdx.x, lane = tid & 63, wid = tid >> 6;
    const int gw = bx * 8 + wid;
    const int t = gw >> 4, h = gw & 15, kvh = h >> 2;
    if (t >= NT) return;
    const bool samp = t >= NP; const int sb = t - NP, pos = t % SEQ;
    const float* qrow = PC + (size_t)t * CN + h * 64;
    float lg[2]; bool valid[2];
#pragma unroll
    for (int rr = 0; rr < 2; ++rr) {
        const int r = lane + 64 * rr;
        const float* krow;
        if (!samp) { valid[rr] = (pos - r) >= 0; krow = PC + (size_t)(valid[rr] ? t - r : t) * CN + 1024 + kvh * 64; }
        else { valid[rr] = true; krow = (r == 0) ? PC + (size_t)t * CN + 1024 + kvh * 64 : cache_k + (((size_t)sb * 128 + (128 - r)) * 4 + kvh) * 64; }
        float dot = 0.f;
#pragma unroll
        for (int d4 = 0; d4 < 16; ++d4) {
            const float4 kv = *(const float4*)(krow + d4 * 4);
            const float4 qv = *(const float4*)(qrow + d4 * 4);
            dot += qv.x * kv.x + qv.y * kv.y + qv.z * kv.z + qv.w * kv.w;
        }
        lg[rr] = valid[rr] ? dot * 0.125f + rel_bias[t5_bucket(r) * 16 + h] : -INFINITY;
    }
    const float sink = sinks[h];
    const float m = fmaxf(wave_max(fmaxf(lg[0], lg[1])), sink);
    float p[2];
#pragma unroll
    for (int rr = 0; rr < 2; ++rr) p[rr] = valid[rr] ? expf(lg[rr] - m) : 0.f;
    const float den = wave_sum(p[0] + p[1]) + expf(sink - m);
    const float inv = 1.0f / den;
    float o = 0.f;
#pragma unroll
    for (int rr = 0; rr < 2; ++rr)
        for (int l2 = 0; l2 < 64; ++l2) {
            const int r = l2 + 64 * rr;
            const float pj = __shfl(p[rr], l2);
            if (pj != 0.f) {
                const float* vrow;
                if (!samp) vrow = PC + (size_t)(t - r) * CN + 1280 + kvh * 64;
                else vrow = (r == 0) ? PC + (size_t)t * CN + 1280 + kvh * 64 : cache_v + (((size_t)sb * 128 + (128 - r)) * 4 + kvh) * 64;
                o += pj * vrow[lane];
            }
        }
    ATT[(size_t)t * D + h * 64 + lane] = (bf16)f2bf(o * inv);
}

__device__ __forceinline__ void swa_kv_out(const float* __restrict__ PC, const float* __restrict__ cache_k, const float* __restrict__ cache_v,
                                           float* __restrict__ pk, float* __restrict__ pv, float* __restrict__ sk, float* __restrict__ sv, int vb) {
    const int c = threadIdx.x & 255, row = vb * 2 + (threadIdx.x >> 8);
    if (row < NB * 128) {
        const int b = row >> 7, i = row & 127;
        const float* src = PC + (size_t)(b * SEQ + SEQ - 128 + i) * CN;
        pk[(size_t)row * 256 + c] = src[1024 + c];
        pv[(size_t)row * 256 + c] = src[1280 + c];
    } else {
        const int r2 = row - NB * 128, sb = r2 >> 7, i = r2 & 127;
        if (i < 127) {
            sk[(size_t)r2 * 256 + c] = cache_k[((size_t)sb * 128 + i + 1) * 256 + c];
            sv[(size_t)r2 * 256 + c] = cache_v[((size_t)sb * 128 + i + 1) * 256 + c];
        } else {
            const float* src = PC + (size_t)(NP + sb) * CN;
            sk[(size_t)r2 * 256 + c] = src[1024 + c];
            sv[(size_t)r2 * 256 + c] = src[1280 + c];
        }
    }
}
#define XB_TMO      128
#define XB_XCNT(j)  (256  + 64 * (j))
#define XB_XSUB(j)  (1280 + 64 * (j))
#define XB_XGEN(j)  (2304 + 64 * (j))
#define XB_TOP      3328
#define XB_TOPGEN   3392
#define XCD_BAR_WORDS 3456
#define XB_SPIN_CAP (1u << 18)

__device__ __forceinline__ unsigned xb_ld(unsigned* p)              { return __hip_atomic_load(p, __ATOMIC_RELAXED, __HIP_MEMORY_SCOPE_AGENT); }
__device__ __forceinline__ unsigned xb_add(unsigned* p, unsigned v) { return __hip_atomic_fetch_add(p, v, __ATOMIC_RELAXED, __HIP_MEMORY_SCOPE_AGENT); }
__device__ __forceinline__ unsigned xb_xcc_id() { return (unsigned)__builtin_amdgcn_s_getreg((3 << 11) | 20) & 0xFu; }
#define XB_SPIN(cond, bar) do { unsigned _sp = 0; while (cond) { __builtin_amdgcn_s_sleep(1); \
    if ((++_sp & 255u) == 0u) { if (xb_ld(&(bar)[XB_TMO])) break; if (_sp > XB_SPIN_CAP) { atomicAdd(&(bar)[XB_TMO], 1u); break; } } } } while (0)

struct XcdBarrier {
    unsigned* bar; unsigned x;
    volatile LAS unsigned* st;
};

__device__ __forceinline__ XcdBarrier xcd_barrier_post(unsigned* bar, volatile LAS unsigned* st) {
    XcdBarrier b; b.bar = bar; b.x = xb_xcc_id(); b.st = st;
    if (threadIdx.x == 0) (void)xb_add(&bar[XB_XCNT(b.x)], 1u);
    return b;
}
__device__ __forceinline__ void xcd_barrier_complete(unsigned* bar, unsigned x, unsigned& nloc, unsigned& nx) {
    const unsigned G = gridDim.x * gridDim.y * gridDim.z;
    unsigned sum, cnt, mine, sp = 0u;
    for (;;) {
        sum = 0u; cnt = 0u; mine = 0u;
#pragma unroll
        for (unsigned j = 0; j < 16; ++j) { const unsigned c = xb_ld(&bar[XB_XCNT(j)]); sum += c; cnt += (c > 0u) ? 1u : 0u; mine = (j == x) ? c : mine; }
        if (sum == G) break;
        __builtin_amdgcn_s_sleep(1);
        if ((++sp & 255u) == 0u) { if (xb_ld(&bar[XB_TMO])) break; if (sp > XB_SPIN_CAP) { atomicAdd(&bar[XB_TMO], 1u); break; } }
    }
    nloc = mine > 0u ? mine : 1u; nx = cnt > 0u ? cnt : 1u;
}

__device__ __forceinline__ void xcd_barrier(const XcdBarrier& b) {
    asm volatile("s_waitcnt vmcnt(0)" ::: "memory");
    __syncthreads();
    if (threadIdx.x == 0) {
        unsigned* bar = b.bar;
        __builtin_amdgcn_s_waitcnt(0);
        unsigned nloc = b.st[0], nx = b.st[1];
        if (nloc == 0u) { xcd_barrier_complete(bar, b.x, nloc, nx); b.st[0] = nloc; b.st[1] = nx; }
        const unsigned old = xb_add(&bar[XB_XSUB(b.x)], 1u);
        const unsigned gen = old / nloc;
        if (old + 1u == (gen + 1u) * nloc) {
            __builtin_amdgcn_fence(__ATOMIC_RELEASE, "agent");
            asm volatile("s_waitcnt vmcnt(0)" ::: "memory");
            const unsigned og = xb_add(&bar[XB_TOP], 1u);
            const unsigned tg = og / nx;
            if (og + 1u == (tg + 1u) * nx) xb_add(&bar[XB_TOPGEN], 1u);
            else XB_SPIN(xb_ld(&bar[XB_TOPGEN]) == tg, bar);
            __builtin_amdgcn_fence(__ATOMIC_ACQUIRE, "agent");
            xb_add(&bar[XB_XGEN(b.x)], 1u);
            asm volatile("s_waitcnt vmcnt(0)" ::: "memory");
        } else {
            XB_SPIN(xb_ld(&bar[XB_XGEN(b.x)]) == gen, bar);
            __builtin_amdgcn_fence(__ATOMIC_ACQUIRE, "agent");
            asm volatile("s_waitcnt vmcnt(0)" ::: "memory");
        }
    }
    __syncthreads();
}

typedef short bf16x8_t __attribute__((ext_vector_type(8)));
__device__ __forceinline__ f32x4 mfma16(bf16x8_t a, bf16x8_t b, f32x4 c) { return __builtin_amdgcn_mfma_f32_16x16x32_bf16(a, b, c, 0, 0, 0); }

struct GdnChunkBufs {
    bf16* W;
    bf16* QG;
    bf16* KDT;
    bf16* UT;
    bf16* QK;
    float* EGL;
};

constexpr int GP_QB = 0, GP_KB = 17408, GP_VB = 34816, GP_LS = 52224, GP_QKS = 69632, GP_WS = 78848, GP_SC = 96256;

__device__ __forceinline__ void gdn_prep_unit(const bf16* __restrict__ PROJ, const float* __restrict__ conv_w, const float* __restrict__ a_log, const float* __restrict__ dt_bias,
                                              const GdnChunkBufs& cb, float* __restrict__ p_gdn_conv, int un, unsigned char* lds) {
    int tid = threadIdx.x; asm volatile("" : "+v"(tid));
    const int lane = tid & 63, wave = __builtin_amdgcn_readfirstlane(tid >> 6), fr = lane & 15, fq = lane >> 4;
    const int h = un & 3, n = (un >> 2) & 63, b = un >> 8;
    const int t0 = b * SEQ + n * 64;
    bf16* Qb = (bf16*)(lds + GP_QB); bf16* Kb = (bf16*)(lds + GP_KB); bf16* Vb = (bf16*)(lds + GP_VB); bf16* Ws = (bf16*)(lds + GP_WS);
    float* Ls = (float*)(lds + GP_LS); bf16* QKs = (bf16*)(lds + GP_QKS);
    float* gcs = (float*)(lds + GP_SC); float* bets = gcs + 64; float* egcs = gcs + 128; float* ekds = gcs + 192; float* begs = gcs + 256;
    if (wave == 0) {
        const bf16* prow = PROJ + (size_t)(t0 + lane) * ABN;
        const float a_raw = bf2f(prow[C_A + h]), b_raw = bf2f(prow[C_B + h]);
        float g = -expf(a_log[h]) * softplusf_(a_raw + dt_bias[h]);
#pragma unroll
        for (int off = 1; off < 64; off <<= 1) { const float v = __shfl_up(g, off); if (lane >= off) g += v; }
        const float glast = __shfl(g, 63);
        { const float be_ = sigmoidf_(b_raw), eg_ = expf(g); gcs[lane] = g; bets[lane] = be_; egcs[lane] = eg_; ekds[lane] = expf(glast - g); begs[lane] = be_ * eg_; }
        if (lane == 0) cb.EGL[un] = expf(glast);
    }
    {
        int cols[6]; float cw[4][6], xw[3][6];
#pragma unroll
        for (int p = 0; p < 3; ++p)
#pragma unroll
            for (int e = 0; e < 2; ++e) cols[p * 2 + e] = p * 512 + h * 128 + e * 64 + lane;
#pragma unroll
        for (int i = 0; i < 4; ++i)
#pragma unroll
            for (int c = 0; c < 6; ++c) cw[i][c] = conv_w[i * 1536 + cols[c]];
        const int i0 = wave * 8;
#pragma unroll
        for (int k = 0; k < 3; ++k) {
            const int pos = n * 64 + i0 - 3 + k;
#pragma unroll
            for (int c = 0; c < 6; ++c) xw[k][c] = pos >= 0 ? bf2f(PROJ[(size_t)(t0 + i0 - 3 + k) * ABN + cols[c]]) : 0.f;
        }
        bf16 xraw[8][6];
#pragma unroll
        for (int ii = 0; ii < 8; ++ii)
#pragma unroll
            for (int c = 0; c < 6; ++c) xraw[ii][c] = PROJ[(size_t)(t0 + i0 + ii) * ABN + cols[c]];
#pragma unroll
        for (int ii = 0; ii < 8; ++ii) {
            const int i = i0 + ii;
            float xt[6], s[6];
#pragma unroll
            for (int c = 0; c < 6; ++c) xt[c] = bf2f(xraw[ii][c]);
#pragma unroll
            for (int c = 0; c < 6; ++c) { const float y_ = cw[0][c] * xw[0][c] + cw[1][c] * xw[1][c] + cw[2][c] * xw[2][c] + cw[3][c] * xt[c]; s[c] = y_ * __frcp_rn(1.0f + __expf(-y_)); }
            const float qs = rsqrtf(wave_sum(s[0] * s[0] + s[1] * s[1]) + 1e-6f) * 0.08838834764831845f;
            const float ks = rsqrtf(wave_sum(s[2] * s[2] + s[3] * s[3]) + 1e-6f);
            Qb[i * 136 + lane] = (bf16)f2bf(s[0] * qs); Qb[i * 136 + 64 + lane] = (bf16)f2bf(s[1] * qs);
            Kb[i * 136 + lane] = (bf16)f2bf(s[2] * ks); Kb[i * 136 + 64 + lane] = (bf16)f2bf(s[3] * ks);
            Vb[i * 136 + lane] = (bf16)f2bf(s[4]);      Vb[i * 136 + 64 + lane] = (bf16)f2bf(s[5]);
            if (n == 63 && i >= 61) {
#pragma unroll
                for (int c = 0; c < 6; ++c) p_gdn_conv[((size_t)b * 3 + (i - 61)) * 1536 + cols[c]] = xt[c];
            }
#pragma unroll
            for (int c = 0; c < 6; ++c) { xw[0][c] = xw[1][c]; xw[1][c] = xw[2][c]; xw[2][c] = xt[c]; }
        }
    }
    __syncthreads();
    {
        const int mi = wave >> 1;
        bf16x8_t aK[4], aQ[4];
#pragma unroll
        for (int ks = 0; ks < 4; ++ks) { aK[ks] = *(const bf16x8_t*)(Kb + (mi * 16 + fr) * 136 + ks * 32 + 8 * fq); aQ[ks] = *(const bf16x8_t*)(Qb + (mi * 16 + fr) * 136 + ks * 32 + 8 * fq); }
#pragma unroll
        for (int nn = 0; nn < 2; ++nn) {
            const int nj = (wave & 1) * 2 + nn;
            f32x4 accK = (f32x4){0.f, 0.f, 0.f, 0.f}, accQ = accK;
#pragma unroll
            for (int ks = 0; ks < 4; ++ks) { const bf16x8_t bk = *(const bf16x8_t*)(Kb + (nj * 16 + fr) * 136 + ks * 32 + 8 * fq); accK = mfma16(aK[ks], bk, accK); accQ = mfma16(aQ[ks], bk, accQ); }
            const int j = nj * 16 + fr; const float gj = gcs[j];
#pragma unroll
            for (int r = 0; r < 4; ++r) {
                const int i = mi * 16 + 4 * fq + r;
                const float dec = i >= j ? expf(gcs[i] - gj) : 0.f;
                Ls[j * 68 + i] = i > j ? bets[i] * accK[r] * dec : 0.f;
                QKs[i * 72 + j] = (bf16)f2bf(i >= j ? accQ[r] * dec : 0.f);
            }
        }
    }
    __syncthreads();
    if (wave < 4) {
        float x[64];
        const bool isu = tid < 128; const int c = isu ? tid : tid - 128;
        const LAS unsigned char* l3 = (const LAS unsigned char*)lds;
        unsigned so = (isu ? GP_VB : GP_KB) + c * 2, ro = GP_SC + (isu ? 64 * 4 : 256 * 4), lo = GP_LS;
        asm volatile("" : "+v"(so), "+v"(ro), "+v"(lo));
#pragma unroll
        for (int i = 0; i < 64; ++i) x[i] = *(const LAS float*)(l3 + ro + 4 * i) * bf2f(*(const LAS bf16*)(l3 + so + i * 272));
#pragma unroll
        for (int j = 0; j < 63; ++j) {
#pragma unroll
            for (int i4 = (j + 1) / 4; i4 < 16; ++i4) {
                const f32x4 l4 = *(const LAS f32x4*)(l3 + lo + j * 272 + i4 * 16);
                if (i4 * 4 + 0 > j) x[i4 * 4 + 0] -= l4.x * x[j];
                if (i4 * 4 + 1 > j) x[i4 * 4 + 1] -= l4.y * x[j];
                if (i4 * 4 + 2 > j) x[i4 * 4 + 2] -= l4.z * x[j];
                if (i4 * 4 + 3 > j) x[i4 * 4 + 3] -= l4.w * x[j];
            }
        }
        if (isu) {
            bf16* dst = cb.UT + ((size_t)un * 128 + c) * 64;
#pragma unroll
            for (int i8 = 0; i8 < 8; ++i8) { v4u o; o.x = pk2(x[i8 * 8 + 0], x[i8 * 8 + 1]); o.y = pk2(x[i8 * 8 + 2], x[i8 * 8 + 3]); o.z = pk2(x[i8 * 8 + 4], x[i8 * 8 + 5]); o.w = pk2(x[i8 * 8 + 6], x[i8 * 8 + 7]); *(v4u*)(dst + i8 * 8) = o; }
        } else {
#pragma unroll
            for (int i = 0; i < 64; ++i) Ws[i * 136 + c] = (bf16)f2bf(x[i]);
        }
    } else {
        const int t2 = tid - 256;
#pragma unroll
        for (int k = 0; k < 4; ++k) {
            const int ci = t2 + 256 * k, i = ci >> 4, d0 = (ci & 15) * 8; const float e = egcs[i];
            const v4u q = *(const v4u*)(Qb + i * 136 + d0);
            v4u o; o.x = pk2(bflo(q.x) * e, bfhi(q.x) * e); o.y = pk2(bflo(q.y) * e, bfhi(q.y) * e); o.z = pk2(bflo(q.z) * e, bfhi(q.z) * e); o.w = pk2(bflo(q.w) * e, bfhi(q.w) * e);
            *(v4u*)(cb.QG + ((size_t)un * 64 + i) * 128 + d0) = o;
        }
#pragma unroll
        for (int k = 0; k < 4; ++k) {
            const int ci = t2 + 256 * k, d = ci & 127, i0 = (ci >> 7) * 8;
            float v[8];
#pragma unroll
            for (int q = 0; q < 8; ++q) v[q] = bf2f(Kb[(i0 + q) * 136 + d]) * ekds[i0 + q];
            v4u o; o.x = pk2(v[0], v[1]); o.y = pk2(v[2], v[3]); o.z = pk2(v[4], v[5]); o.w = pk2(v[6], v[7]);
            *(v4u*)(cb.KDT + ((size_t)un * 128 + d) * 64 + i0) = o;
        }
#pragma unroll
        for (int k = 0; k < 2; ++k) {
            const int ci = t2 + 256 * k, i = ci >> 3, j0 = (ci & 7) * 8;
            *(v4u*)(cb.QK + ((size_t)un * 64 + i) * 64 + j0) = *(const v4u*)(QKs + i * 72 + j0);
        }
    }
    __syncthreads();
#pragma unroll
    for (int k = 0; k < 2; ++k) {
        const int ci = tid + 512 * k, i = ci >> 4, d0 = (ci & 15) * 8;
        *(v4u*)(cb.W + ((size_t)un * 64 + i) * 128 + d0) = *(const v4u*)(Ws + i * 136 + d0);
    }
    __syncthreads();
}

constexpr int GS_ST = 0, GS_VNT = 2 * 32 * 136 * 2, GS_END = GS_VNT + 32 * 72 * 2;
template <int N0, int N1>
__device__ __forceinline__ void gdn_seq(const GdnChunkBufs& cb, float* __restrict__ O, float* __restrict__ Sout, int b, int h, int sl, unsigned char* lds, f32x4 (&accS)[2], int& cur) {
    int tid = threadIdx.x; asm volatile("" : "+v"(tid));
    const int lane = tid & 63, wave = __builtin_amdgcn_readfirstlane(tid >> 6), fr = lane & 15, fq = lane >> 4;
    const int mi = wave >> 1, nj = wave & 1;
    bf16* St = (bf16*)(lds + GS_ST); bf16* VnT = (bf16*)(lds + GS_VNT);
    float* egls = (float*)(lds + GS_END);
    if (N0 == 0) {
        for (int i = tid; i < 2 * 32 * 136 / 2; i += NTH) ((unsigned*)St)[i] = 0u;
        accS[0] = (f32x4){0.f, 0.f, 0.f, 0.f}; accS[1] = accS[0]; cur = 0;
    }
    if (tid >= N0 && tid < N1) egls[tid] = cb.EGL[(size_t)((b * 64 + tid) * 4 + h)];
    __syncthreads();
#define GS_DECL(X) bf16x8_t aW##X[4], aQG##X[4], aQK##X[2], aKD##X[2]; v2u ut##X;
    GS_DECL(0) GS_DECL(1) GS_DECL(2)
#define GS_GLD16(dst, ptr) asm volatile("global_load_dwordx4 %0, %1, off" : "=v"(dst) : "v"(ptr))
#define GS_GLD8(dst, ptr) asm volatile("global_load_dwordx2 %0, %1, off" : "=v"(dst) : "v"(ptr))
#define GS_LOAD(X, n_) do { const size_t u_ = (size_t)((b * 64 + ((n_) < 63 ? (n_) : 63)) * 4 + h);     \
        _Pragma("unroll") for (int ks = 0; ks < 4; ++ks) { GS_GLD16(aW##X[ks], cb.W + (u_ * 64 + mi * 16 + fr) * 128 + ks * 32 + 8 * fq); GS_GLD16(aQG##X[ks], cb.QG + (u_ * 64 + mi * 16 + fr) * 128 + ks * 32 + 8 * fq); } \
        _Pragma("unroll") for (int ks = 0; ks < 2; ++ks) { GS_GLD16(aQK##X[ks], cb.QK + (u_ * 64 + mi * 16 + fr) * 64 + ks * 32 + 8 * fq); GS_GLD16(aKD##X[ks], cb.KDT + (u_ * 128 + wave * 16 + fr) * 64 + ks * 32 + 8 * fq); } \
        GS_GLD8(ut##X, cb.UT + (u_ * 128 + sl * 32 + nj * 16 + fr) * 64 + mi * 16 + 4 * fq); } while (0)
#define GS_WAITN(X, N) asm volatile("s_waitcnt vmcnt(" #N ")" : "+v"(aW##X[0]), "+v"(aW##X[1]), "+v"(aW##X[2]), "+v"(aW##X[3]), "+v"(aQG##X[0]), "+v"(aQG##X[1]), "+v"(aQG##X[2]), "+v"(aQG##X[3]), \
        "+v"(aQK##X[0]), "+v"(aQK##X[1]), "+v"(aKD##X[0]), "+v"(aKD##X[1]), "+v"(ut##X))
#define GS_WAIT(X, n_) GS_WAITN(X, 26)
#define GS_STEP(X, n_) do { \
        const float egl##X = egls[(n_)]; \
        GS_WAIT(X, n_); \
        __syncthreads();                                        \
        f32x4 accW = (f32x4){0.f, 0.f, 0.f, 0.f}, accO = accW; \
        const bf16* Sc = St + cur * 32 * 136; \
        _Pragma("unroll") for (int ks = 0; ks < 4; ++ks) { const bf16x8_t bs = *(const bf16x8_t*)(Sc + (nj * 16 + fr) * 136 + ks * 32 + 8 * fq); accW = mfma16(aW##X[ks], bs, accW); accO = mfma16(aQG##X[ks], bs, accO); } \
          \
        const float v0 = bflo(ut##X.x) - accW[0], v1 = bfhi(ut##X.x) - accW[1], v2 = bflo(ut##X.y) - accW[2], v3 = bfhi(ut##X.y) - accW[3]; \
        { v2u o; o.x = pk2(v0, v1); o.y = pk2(v2, v3); *(v2u*)(VnT + (nj * 16 + fr) * 72 + mi * 16 + 4 * fq) = o; } \
        __syncthreads();                                        \
        _Pragma("unroll") for (int ks = 0; ks < 2; ++ks) { const bf16x8_t bv = *(const bf16x8_t*)(VnT + (nj * 16 + fr) * 72 + ks * 32 + 8 * fq); accO = mfma16(aQK##X[ks], bv, accO); } \
        { float* orow = O + (size_t)(b * SEQ + (n_) * 64 + mi * 16 + 4 * fq) * 512 + h * 128 + sl * 32 + nj * 16 + fr; \
          orow[0] = accO[0]; orow[512] = accO[1]; orow[1024] = accO[2]; orow[1536] = accO[3]; } \
          \
        bf16* Sn = St + (cur ^ 1) * 32 * 136; \
        _Pragma("unroll") for (int njj = 0; njj < 2; ++njj) { \
            accS[njj] = accS[njj] * egl##X; \
            _Pragma("unroll") for (int ks = 0; ks < 2; ++ks) { const bf16x8_t bv = *(const bf16x8_t*)(VnT + (njj * 16 + fr) * 72 + ks * 32 + 8 * fq); accS[njj] = mfma16(aKD##X[ks], bv, accS[njj]); } \
            v2u o; o.x = pk2(accS[njj][0], accS[njj][1]); o.y = pk2(accS[njj][2], accS[njj][3]); \
            *(v2u*)(Sn + (njj * 16 + fr) * 136 + wave * 16 + 4 * fq) = o; } \
        cur ^= 1; } while (0)
    constexpr int NTRI = (N1 - N0) / 3, NREM = (N1 - N0) % 3, NM = N0 + 3 * NTRI;
    GS_LOAD(0, N0); GS_LOAD(1, N0 + 1);
#pragma unroll 1
    for (int n = N0; n < NM; n += 3) {
        GS_LOAD(2, n + 2);
        GS_STEP(0, n);
        GS_LOAD(0, n + 3);
        GS_STEP(1, n + 1);
        GS_LOAD(1, n + 4);
        GS_STEP(2, n + 2);
    }
    if (NREM >= 1) { GS_LOAD(2, NM + 2); GS_STEP(0, NM); }
    if (NREM == 2) { GS_LOAD(0, NM + 3); GS_STEP(1, NM + 1); }
    GS_WAITN(0, 0); GS_WAITN(1, 0); GS_WAITN(2, 0);
#undef GS_STEP
#undef GS_DECL
#undef GS_WAIT
#undef GS_WAITN
#undef GS_GLD16
#undef GS_GLD8
    asm volatile("s_waitcnt vmcnt(0)" ::: "memory");
#undef GS_LOAD
    if (N1 == 64) {
#pragma unroll
        for (int njj = 0; njj < 2; ++njj)
#pragma unroll
            for (int r = 0; r < 4; ++r) Sout[(((size_t)b * 4 + h) * 128 + wave * 16 + 4 * fq + r) * 128 + sl * 32 + njj * 16 + fr] = accS[njj][r];
    }
    __syncthreads();
}

__device__ __forceinline__ void lru_prep_unit(const bf16* __restrict__ PROJ, const float* __restrict__ conv_w, const float* __restrict__ conv_b,
                                              const float* __restrict__ w_r, const float* __restrict__ b_r, const float* __restrict__ w_i, const float* __restrict__ b_i, const float* __restrict__ lam,
                                              float* __restrict__ H, float* __restrict__ P, float* __restrict__ Hend, float* __restrict__ Pend, float* __restrict__ p_lru_conv, int ub) {
    int c = threadIdx.x; asm volatile("" : "+v"(c));
    const int nblk = c >> 6, d = c & 63;
    const int n = ub & 63, b = ub >> 6, t0 = b * SEQ + n * 64;
    float wr[64], wi[64];
#pragma unroll
    for (int cc = 0; cc < 64; ++cc) { wr[cc] = w_r[((size_t)nblk * 64 + cc) * 64 + d]; wi[cc] = w_i[((size_t)nblk * 64 + cc) * 64 + d]; }
    const float cw0 = conv_w[c], cw1 = conv_w[512 + c], cw2 = conv_w[1024 + c], cw3 = conv_w[1536 + c], cb_ = conv_b[c];
    const float br = b_r[c], bi = b_i[c], spl = -8.0f * softplusf_(-lam[c]);
    float x0 = (n * 64 - 3 >= 0) ? bf2f(PROJ[(size_t)(t0 - 3) * ABN + C_XR + c]) : 0.f;
    float x1 = (n * 64 - 2 >= 0) ? bf2f(PROJ[(size_t)(t0 - 2) * ABN + C_XR + c]) : 0.f;
    float x2 = (n * 64 - 1 >= 0) ? bf2f(PROJ[(size_t)(t0 - 1) * ABN + C_XR + c]) : 0.f;
    float hloc = 0.f, ploc = 1.f;
    bf16 xa[16], xb[16];
#pragma unroll
    for (int k = 0; k < 16; ++k) xa[k] = PROJ[(size_t)(t0 + k) * ABN + C_XR + c];
#pragma unroll 1
    for (int ib = 0; ib < 64; ib += 16) {
      if (ib + 16 < 64) {
#pragma unroll
        for (int k = 0; k < 16; ++k) xb[k] = PROJ[(size_t)(t0 + ib + 16 + k) * ABN + C_XR + c];
      }
#pragma unroll
      for (int k = 0; k < 16; ++k) {
        const int i = ib + k;
        const float xt = bf2f(xa[k]);
        const float xr = cb_ + cw0 * x0 + cw1 * x1 + cw2 * x2 + cw3 * xt;
        f32x2_t ga = (f32x2_t){br, bi}, gb = (f32x2_t){0.f, 0.f};
#pragma unroll
        for (int cc = 0; cc < 64; cc += 2) {
            const float xa_ = __uint_as_float(__builtin_amdgcn_readlane(__float_as_uint(xr), cc)), xb_ = __uint_as_float(__builtin_amdgcn_readlane(__float_as_uint(xr), cc + 1));
            ga += (f32x2_t){xa_, xa_} * (f32x2_t){wr[cc], wi[cc]}; gb += (f32x2_t){xb_, xb_} * (f32x2_t){wr[cc + 1], wi[cc + 1]};
        }
        ga += gb;
        const float r = __frcp_rn(1.0f + __expf(-ga.x)), ii = __frcp_rn(1.0f + __expf(-ga.y));
        const float a = __expf(spl * r), bb = __fsqrt_rn(fmaxf(1.0f - a * a, 0.f)) * (ii * xr);
        hloc = a * hloc + bb; ploc *= a;
        H[(size_t)(t0 + i) * 512 + c] = hloc; P[(size_t)(t0 + i) * 512 + c] = ploc;
        if (n == 63 && i >= 61) p_lru_conv[((size_t)b * 3 + (i - 61)) * 512 + c] = xt;
        x0 = x1; x1 = x2; x2 = xt;
      }
#pragma unroll
      for (int k = 0; k < 16; ++k) xa[k] = xb[k];
    }
    Hend[(size_t)ub * 512 + c] = hloc; Pend[(size_t)ub * 512 + c] = ploc;
}
constexpr int LR_XR = 64 * 68 * 4;
__device__ __forceinline__ void lru_prep_unit2(const bf16* __restrict__ PROJ, const float* __restrict__ conv_w, const float* __restrict__ conv_b,
                                               const bf16* __restrict__ WRT, const bf16* __restrict__ WIT  , const float* __restrict__ b_r, const float* __restrict__ b_i, const float* __restrict__ lam,
                                               float* __restrict__ H, float* __restrict__ P, float* __restrict__ Hend, float* __restrict__ Pend, float* __restrict__ p_lru_conv, int ub, unsigned char* lds) {
    int tid = threadIdx.x; asm volatile("" : "+v"(tid));
    const int lane = tid & 63, wave = __builtin_amdgcn_readfirstlane(tid >> 6), fr = lane & 15, fq = lane >> 4;
    const int n = ub & 63, b = ub >> 6, t0 = b * SEQ + n * 64;
    float* XR = (float*)(lds + wave * LR_XR);
    {
        const int c = wave * 64 + lane;
        const float cw0 = conv_w[c], cw1 = conv_w[512 + c], cw2 = conv_w[1024 + c], cw3 = conv_w[1536 + c], cb_ = conv_b[c];
        float x0 = (n * 64 - 3 >= 0) ? bf2f(PROJ[(size_t)(t0 - 3) * ABN + C_XR + c]) : 0.f;
        float x1 = (n * 64 - 2 >= 0) ? bf2f(PROJ[(size_t)(t0 - 2) * ABN + C_XR + c]) : 0.f;
        float x2 = (n * 64 - 1 >= 0) ? bf2f(PROJ[(size_t)(t0 - 1) * ABN + C_XR + c]) : 0.f;
#pragma unroll 1
        for (int ib = 0; ib < 64; ib += 16) {
            bf16 xa[16];
#pragma unroll
            for (int k = 0; k < 16; ++k) xa[k] = PROJ[(size_t)(t0 + ib + k) * ABN + C_XR + c];
#pragma unroll
            for (int k = 0; k < 16; ++k) {
                const int i = ib + k; const float xt = bf2f(xa[k]);
                XR[i * 68 + lane] = cb_ + cw0 * x0 + cw1 * x1 + cw2 * x2 + cw3 * xt;
                if (n == 63 && i >= 61) p_lru_conv[((size_t)b * 3 + (i - 61)) * 512 + c] = xt;
                x0 = x1; x1 = x2; x2 = xt;
            }
        }
    }
    asm volatile("s_waitcnt lgkmcnt(0)" ::: "memory");
    bf16x8_t bR[4][2], bI[4][2];
#pragma unroll
    for (int nt = 0; nt < 4; ++nt)
#pragma unroll
        for (int ks = 0; ks < 2; ++ks) {
            bR[nt][ks] = *(const bf16x8_t*)(WRT + ((size_t)wave * 64 + nt * 16 + fr) * 64 + ks * 32 + 8 * fq);
            bI[nt][ks] = *(const bf16x8_t*)(WIT + ((size_t)wave * 64 + nt * 16 + fr) * 64 + ks * 32 + 8 * fq);
        }
    float brv[4], biv[4], splv[4];
#pragma unroll
    for (int nt = 0; nt < 4; ++nt) { const int c = wave * 64 + nt * 16 + fr; brv[nt] = b_r[c]; biv[nt] = b_i[c]; splv[nt] = -8.0f * softplusf_(-lam[c]); }
    float hin[4], pin[4];
#pragma unroll
    for (int nt = 0; nt < 4; ++nt) { hin[nt] = 0.f; pin[nt] = 1.f; }
#pragma unroll 1
    for (int mt = 0; mt < 4; ++mt) {
        bf16x8_t aX[2];
#pragma unroll
        for (int ks = 0; ks < 2; ++ks) {
            const f32x4 lo = *(const f32x4*)(XR + (mt * 16 + fr) * 68 + ks * 32 + 8 * fq), hi = *(const f32x4*)(XR + (mt * 16 + fr) * 68 + ks * 32 + 8 * fq + 4);
            v4u w; w.x = pk2(lo.x, lo.y); w.y = pk2(lo.z, lo.w); w.z = pk2(hi.x, hi.y); w.w = pk2(hi.z, hi.w);
            aX[ks] = __builtin_bit_cast(bf16x8_t, w);
        }
#pragma unroll
        for (int nt = 0; nt < 4; ++nt) {
            f32x4 aR = (f32x4){0.f, 0.f, 0.f, 0.f}, aI = aR;
            aR = mfma16(aX[0], bR[nt][0], aR); aR = mfma16(aX[1], bR[nt][1], aR);
            aI = mfma16(aX[0], bI[nt][0], aI); aI = mfma16(aX[1], bI[nt][1], aI);
            float av[4], bv[4];
#pragma unroll
            for (int r = 0; r < 4; ++r) {
                const float rg = __frcp_rn(1.0f + __expf(-(aR[r] + brv[nt]))), ig = __frcp_rn(1.0f + __expf(-(aI[r] + biv[nt])));
                const float a = __expf(splv[nt] * rg);
                av[r] = a; bv[r] = __fsqrt_rn(fmaxf(1.0f - a * a, 0.f)) * (ig * XR[(mt * 16 + 4 * fq + r) * 68 + nt * 16 + fr]);
            }
            float PA[4], PB[4];
            PA[0] = av[0]; PB[0] = bv[0];
#pragma unroll
            for (int r = 1; r < 4; ++r) { PA[r] = av[r] * PA[r - 1]; PB[r] = av[r] * PB[r - 1] + bv[r]; }
            float GA = PA[3], GB = PB[3];
            { const float pa = __shfl_up(GA, 16), pb = __shfl_up(GB, 16); if (fq >= 1) { GB = GA * pb + GB; GA = GA * pa; } }
            { const float pa = __shfl_up(GA, 32), pb = __shfl_up(GB, 32); if (fq >= 2) { GB = GA * pb + GB; GA = GA * pa; } }
            float EA = __shfl_up(GA, 16), EB = __shfl_up(GB, 16);
            if (fq == 0) { EA = 1.f; EB = 0.f; }
            const float h0 = EA * hin[nt] + EB, p0 = pin[nt] * EA;
#pragma unroll
            for (int r = 0; r < 4; ++r) {
                const size_t o = (size_t)(t0 + mt * 16 + 4 * fq + r) * 512 + wave * 64 + nt * 16 + fr;
                H[o] = PA[r] * h0 + PB[r]; P[o] = p0 * PA[r];
            }
            const float TA = __shfl(GA, 48 + fr), TB = __shfl(GB, 48 + fr);
            hin[nt] = TA * hin[nt] + TB; pin[nt] = pin[nt] * TA;
        }
    }
    if (fq == 0) {
#pragma unroll
        for (int nt = 0; nt < 4; ++nt) { Hend[(size_t)ub * 512 + wave * 64 + nt * 16 + fr] = hin[nt]; Pend[(size_t)ub * 512 + wave * 64 + nt * 16 + fr] = pin[nt]; }
    }
    asm volatile("s_waitcnt lgkmcnt(0)" ::: "memory");
}
__device__ __forceinline__ void lru_carry(const float* __restrict__ Hend, const float* __restrict__ Pend, float* __restrict__ CIN, float* __restrict__ hlast, int bx) {
    int tx_ = threadIdx.x; asm volatile("" : "+v"(tx_));
    const int idx = bx * NTH + tx_, b = idx >> 9, c = idx & 511;
    float carry = 0.f;
#pragma unroll 8
    for (int n = 0; n < 64; ++n) {
        const size_t o = ((size_t)b * 64 + n) * 512 + c;
        CIN[o] = carry;
        carry = Hend[o] + Pend[o] * carry;
    }
    hlast[(size_t)b * 512 + c] = carry;
}

__device__ __forceinline__ unsigned f2key(float f) { const unsigned u = __float_as_uint(f); return u ^ ((u >> 31) ? 0xffffffffu : 0x80000000u); }
__device__ __forceinline__ float key2f(unsigned k) { return __uint_as_float(k ^ ((k >> 31) ? 0x80000000u : 0xffffffffu)); }
#define TK_CE(hi, lo) do { const unsigned a_ = (hi), b_ = (lo); (hi) = a_ > b_ ? a_ : b_; (lo) = a_ > b_ ? b_ : a_; } while (0)
template <int N> __device__ __forceinline__ void bitonic_sort_desc(unsigned (&a)[N]) {
#pragma unroll
    for (int k = 2; k <= N; k <<= 1)
#pragma unroll
        for (int j = k >> 1; j > 0; j >>= 1)
#pragma unroll
            for (int i = 0; i < N; ++i) { const int l = i ^ j; if (l > i) { if ((i & k) == 0) TK_CE(a[i], a[l]); else TK_CE(a[l], a[i]); } }
}
template <int XM> __device__ __forceinline__ void merge_top16(unsigned (&a)[16]) {
    unsigned c[16];
#pragma unroll
    for (int i = 0; i < 16; ++i) { const unsigned o = (unsigned)__shfl_xor((int)a[15 - i], XM); c[i] = a[i] > o ? a[i] : o; }
#pragma unroll
    for (int j = 8; j > 0; j >>= 1)
#pragma unroll
        for (int i = 0; i < 16; ++i) { const int l = i ^ j; if (l > i) TK_CE(c[i], c[l]); }
#pragma unroll
    for (int i = 0; i < 16; ++i) a[i] = c[i];
}
constexpr int TK_KS = 0, TK_TS = 2 * 128 * 136 * 2, TK_END = TK_TS + 64 * 2 * 16 * 4;
__device__ __forceinline__ void peer_topk_stage_keys(const bf16* __restrict__ KB, int h, unsigned char* lds) {
    bf16* Ks = (bf16*)(lds + TK_KS);
    for (int ci = threadIdx.x; ci < 2 * 128 * 16; ci += NTH) { const int row = ci >> 4, part = ci & 15;
        *(v4u*)(Ks + row * 136 + part * 8) = *(const v4u*)(KB + ((size_t)h * 256 + row) * 128 + part * 8); }
    __syncthreads();
}
__device__ __forceinline__ void peer_topk4(const bf16* __restrict__ Q, int* __restrict__ EXP, float* __restrict__ GATE, int tile, int h, unsigned char* lds) {
    int tid = threadIdx.x; asm volatile("" : "+v"(tid));
    const int lane = tid & 63, wave = __builtin_amdgcn_readfirstlane(tid >> 6), fr = lane & 15, fq = lane >> 4;
    const bf16* Ks = (const bf16*)(lds + TK_KS); unsigned* Ts = (unsigned*)(lds + TK_TS);
    {
        const int c = wave >> 2, nt = wave & 3;
        bf16x8_t bq[4];
#pragma unroll
        for (int ks = 0; ks < 4; ++ks) bq[ks] = *(const bf16x8_t*)(Q + (size_t)(tile * 64 + nt * 16 + fr) * 2048 + h * 256 + c * 128 + ks * 32 + 8 * fq);
        unsigned a[32];
#pragma unroll
        for (int mt = 0; mt < 8; ++mt) {
            f32x4 acc = (f32x4){0.f, 0.f, 0.f, 0.f};
#pragma unroll
            for (int ks = 0; ks < 4; ++ks) { const bf16x8_t ak = *(const bf16x8_t*)(Ks + (c * 128 + mt * 16 + fr) * 136 + ks * 32 + 8 * fq); acc = mfma16(ak, bq[ks], acc); }
#pragma unroll
            for (int r = 0; r < 4; ++r) a[mt * 4 + r] = (f2key(acc[r]) & ~127u) | (unsigned)(127 - (mt * 16 + 4 * fq + r));
        }
        bitonic_sort_desc<32>(a);
        unsigned t[16];
#pragma unroll
        for (int j = 0; j < 16; ++j) t[j] = a[j];
        merge_top16<16>(t); merge_top16<32>(t);
        if (fq == 0) {
            const int tk = nt * 16 + fr;
#pragma unroll
            for (int j = 0; j < 16; ++j) Ts[(tk * 2 + c) * 16 + j] = t[j];
        }
    }
    __syncthreads();
    if (tid < 256) {
        const int tk = tid >> 2, q = tid & 3;
        const unsigned* t0 = Ts + (tk * 2 + 0) * 16; const unsigned* t1 = Ts + (tk * 2 + 1) * 16;
        unsigned a[16];
#pragma unroll
        for (int s = 0; s < 13; ++s) {
            const int e = s * 4 + q;
            int i, j;
            if (e < 16) { i = 0; j = e; } else if (e < 24) { i = 1; j = e - 16; } else if (e < 29) { i = 2; j = e - 24; } else if (e < 33) { i = 3; j = e - 29; }
            else if (e < 36) { i = 4; j = e - 33; } else if (e < 42) { i = 5 + ((e - 36) >> 1); j = (e - 36) & 1; } else { i = 8 + (e - 42); j = 0; }
            const bool ok = e < 50;
            const float sum = key2f(t0[ok ? i : 0] & ~127u) + key2f(t1[ok ? j : 0] & ~127u);
            a[s] = ok ? ((f2key(sum) & ~255u) | (unsigned)(255 - (i * 16 + j))) : 0u;
        }
        a[13] = 0u; a[14] = 0u; a[15] = 0u;
        bitonic_sort_desc<16>(a);
        merge_top16<1>(a); merge_top16<2>(a);
        float ev[16], sum = 0.f; const float m = key2f(a[0] & ~255u);
#pragma unroll
        for (int j = 0; j < 16; ++j) { ev[j] = __expf(key2f(a[j] & ~255u) - m); sum += ev[j]; }
        const float inv = 1.0f / sum;
        const size_t o = (size_t)(tile * 64 + tk) * 128 + h * 16;
#pragma unroll
        for (int j = 0; j < 16; ++j)
            if ((j >> 2) == q) {
                const int code = 255 - (int)(a[j] & 255u), i = code >> 4, jj = code & 15;
                const int n0 = 127 - (int)(t0[i] & 127u), n1 = 127 - (int)(t1[jj] & 127u);
                EXP[o + j] = n0 * 128 + n1; GATE[o + j] = ev[j] * inv;
            }
    }
    __syncthreads();
}

constexpr int AT_KS = 0, AT_VT = 192 * 72 * 2, AT_BT = AT_VT + 64 * 200 * 2, AT_PW = AT_BT + 4 * 128 * 4, AT_END = AT_PW + 8 * 32 * 72 * 2;
__device__ __forceinline__ void attn_unit(const bf16* __restrict__ PCb, const float* __restrict__ rel_bias, const float* __restrict__ sinks, bf16* __restrict__ ATT, int un, unsigned char* lds) {
    int tid = threadIdx.x; asm volatile("" : "+v"(tid));
    const int lane = tid & 63, wave = __builtin_amdgcn_readfirstlane(tid >> 6), fr = lane & 15, fq = lane >> 4;
    const int kvh = un & 3, qblk = (un >> 2) & 63, b = un >> 8;
    const int q0 = qblk * 64, tb = b * SEQ;
    bf16* Ks = (bf16*)(lds + AT_KS); bf16* Vt = (bf16*)(lds + AT_VT); float* Bt = (float*)(lds + AT_BT); bf16* Pw = (bf16*)(lds + AT_PW) + wave * 32 * 72;
#pragma unroll
    for (int k = 0; k < 3; ++k) {
        const int ci = tid + 512 * k, row = ci >> 3, part = ci & 7, kpos = q0 - 128 + row;
        v4u kv = (v4u){0u, 0u, 0u, 0u}, vv = kv;
        if (kpos >= 0) { const bf16* src = PCb + (size_t)(tb + kpos) * CN + kvh * 64 + part * 8; kv = *(const v4u*)(src + 1024); vv = *(const v4u*)(src + 1280); }
        *(v4u*)(Ks + row * 72 + part * 8) = kv;
        bf16* vd = Vt + (part * 8) * 200 + row;
        vd[0 * 200] = (bf16)(vv.x & 0xffffu); vd[1 * 200] = (bf16)(vv.x >> 16); vd[2 * 200] = (bf16)(vv.y & 0xffffu); vd[3 * 200] = (bf16)(vv.y >> 16);
        vd[4 * 200] = (bf16)(vv.z & 0xffffu); vd[5 * 200] = (bf16)(vv.z >> 16); vd[6 * 200] = (bf16)(vv.w & 0xffffu); vd[7 * 200] = (bf16)(vv.w >> 16);
    }
    Bt[tid] = rel_bias[t5_bucket(tid & 127) * 16 + kvh * 4 + (tid >> 7)];
    __syncthreads();
    const int g = wave >> 1, qs = (wave & 1) * 32, hh = kvh * 4 + g;
    bf16x8_t aQ[2][2];
#pragma unroll
    for (int mt = 0; mt < 2; ++mt)
#pragma unroll
        for (int ks = 0; ks < 2; ++ks) aQ[mt][ks] = *(const bf16x8_t*)(PCb + (size_t)(tb + q0 + qs + mt * 16 + fr) * CN + hh * 64 + ks * 32 + 8 * fq);
    f32x4 sc[2][12];
#pragma unroll
    for (int nt = 0; nt < 12; ++nt) {
        const bf16x8_t b0 = *(const bf16x8_t*)(Ks + (nt * 16 + fr) * 72 + 8 * fq), b1 = *(const bf16x8_t*)(Ks + (nt * 16 + fr) * 72 + 32 + 8 * fq);
#pragma unroll
        for (int mt = 0; mt < 2; ++mt) { f32x4 a = (f32x4){0.f, 0.f, 0.f, 0.f}; a = mfma16(aQ[mt][0], b0, a); a = mfma16(aQ[mt][1], b1, a); sc[mt][nt] = a; }
    }
    const float sink = sinks[hh];
    const float* bt = Bt + g * 128;
#pragma unroll
    for (int mt = 0; mt < 2; ++mt)
#pragma unroll
        for (int r = 0; r < 4; ++r) {
            const int qi = qs + mt * 16 + 4 * fq + r;
            float mx = sink;
#pragma unroll
            for (int nt = 0; nt < 12; ++nt) {
                const int kk = nt * 16 + fr, rel = qi + 128 - kk;
                const bool valid = rel >= 0 && rel < 128 && (q0 - 128 + kk) >= 0;
                const float lg = valid ? sc[mt][nt][r] * 0.125f + bt[valid ? rel : 0] : -INFINITY;
                sc[mt][nt][r] = lg; mx = fmaxf(mx, lg);
            }
            mx = fmaxf(mx, __shfl_xor(mx, 1)); mx = fmaxf(mx, __shfl_xor(mx, 2)); mx = fmaxf(mx, __shfl_xor(mx, 4)); mx = fmaxf(mx, __shfl_xor(mx, 8));
            float sum = 0.f;
#pragma unroll
            for (int nt = 0; nt < 12; ++nt) { const float p = __expf(sc[mt][nt][r] - mx); sc[mt][nt][r] = p; sum += p; }
            sum += __shfl_xor(sum, 1); sum += __shfl_xor(sum, 2); sum += __shfl_xor(sum, 4); sum += __shfl_xor(sum, 8);
            const float inv = 1.0f / (sum + __expf(sink - mx));
#pragma unroll
            for (int nt = 0; nt < 12; ++nt) sc[mt][nt][r] *= inv;
        }
    f32x4 oacc[2][4];
#pragma unroll
    for (int mt = 0; mt < 2; ++mt)
#pragma unroll
        for (int dt = 0; dt < 4; ++dt) oacc[mt][dt] = (f32x4){0.f, 0.f, 0.f, 0.f};
#pragma unroll
    for (int kc = 0; kc < 3; ++kc) {
#pragma unroll
        for (int mt = 0; mt < 2; ++mt)
#pragma unroll
            for (int n4 = 0; n4 < 4; ++n4)
#pragma unroll
                for (int r = 0; r < 4; ++r) Pw[(mt * 16 + 4 * fq + r) * 72 + n4 * 16 + fr] = (bf16)f2bf(sc[mt][kc * 4 + n4][r]);
        asm volatile("s_waitcnt lgkmcnt(0)" ::: "memory");
#pragma unroll
        for (int ks = 0; ks < 2; ++ks) {
            const bf16x8_t p0 = *(const bf16x8_t*)(Pw + fr * 72 + ks * 32 + 8 * fq), p1 = *(const bf16x8_t*)(Pw + (16 + fr) * 72 + ks * 32 + 8 * fq);
#pragma unroll
            for (int dt = 0; dt < 4; ++dt) {
                const bf16x8_t bv = *(const bf16x8_t*)(Vt + (dt * 16 + fr) * 200 + kc * 64 + ks * 32 + 8 * fq);
                oacc[0][dt] = mfma16(p0, bv, oacc[0][dt]); oacc[1][dt] = mfma16(p1, bv, oacc[1][dt]);
            }
        }
        asm volatile("s_waitcnt lgkmcnt(0)" ::: "memory");
    }
#pragma unroll
    for (int mt = 0; mt < 2; ++mt)
#pragma unroll
        for (int dt = 0; dt < 4; ++dt)
#pragma unroll
            for (int r = 0; r < 4; ++r) Pw[(mt * 16 + 4 * fq + r) * 72 + dt * 16 + fr] = (bf16)f2bf(oacc[mt][dt][r]);
    asm volatile("s_waitcnt lgkmcnt(0)" ::: "memory");
#pragma unroll
    for (int k = 0; k < 4; ++k) {
        const int ci = lane + 64 * k, row = ci >> 3, part = ci & 7;
        *(v4u*)(ATT + (size_t)(tb + q0 + qs + row) * D + hh * 64 + part * 8) = *(const v4u*)(Pw + row * 72 + part * 8);
    }
    __syncthreads();
}

__device__ __forceinline__ void swa_attn_sample(const bf16* __restrict__ PCb, const float* __restrict__ cache_k, const float* __restrict__ cache_v,
                                                const float* __restrict__ rel_bias, const float* __restrict__ sinks, bf16* __restrict__ ATT, int gw, int lane) {
    const int sb = gw >> 4, h = gw & 15, kvh = h >> 2, t = NP + sb;
    const bf16* qrow = PCb + (size_t)t * CN + h * 64;
    float lg[2];
#pragma unroll
    for (int rr = 0; rr < 2; ++rr) {
        const int r = lane + 64 * rr;
        float dot = 0.f;
        if (r == 0) {
            const bf16* krow = PCb + (size_t)t * CN + 1024 + kvh * 64;
            for (int d = 0; d < 64; ++d) dot += bf2f(qrow[d]) * bf2f(krow[d]);
        } else {
            const float* krow = cache_k + (((size_t)sb * 128 + (128 - r)) * 4 + kvh) * 64;
#pragma unroll
            for (int d4 = 0; d4 < 16; ++d4) { const float4 kv = *(const float4*)(krow + d4 * 4);
                dot += bf2f(qrow[d4 * 4]) * kv.x + bf2f(qrow[d4 * 4 + 1]) * kv.y + bf2f(qrow[d4 * 4 + 2]) * kv.z + bf2f(qrow[d4 * 4 + 3]) * kv.w; }
        }
        lg[rr] = dot * 0.125f + rel_bias[t5_bucket(r) * 16 + h];
    }
    const float sink = sinks[h];
    const float m = fmaxf(wave_max(fmaxf(lg[0], lg[1])), sink);
    float p[2] = {expf(lg[0] - m), expf(lg[1] - m)};
    const float inv = 1.0f / (wave_sum(p[0] + p[1]) + expf(sink - m));
    float o = 0.f;
#pragma unroll
    for (int rr = 0; rr < 2; ++rr)
        for (int l2 = 0; l2 < 64; ++l2) {
            const int r = l2 + 64 * rr;
            const float pj = __shfl(p[rr], l2);
            const float vv = (r == 0) ? bf2f(PCb[(size_t)t * CN + 1280 + kvh * 64 + lane]) : cache_v[(((size_t)sb * 128 + (128 - r)) * 4 + kvh) * 64 + lane];
            o += pj * vv;
        }
    ATT[(size_t)t * D + h * 64 + lane] = (bf16)f2bf(o * inv);
}
__device__ __forceinline__ void swa_kv_out2(const bf16* __restrict__ PCb, const float* __restrict__ cache_k, const float* __restrict__ cache_v,
                                            float* __restrict__ pk, float* __restrict__ pv, float* __restrict__ sk, float* __restrict__ sv, int vb) {
    int tx_ = threadIdx.x; asm volatile("" : "+v"(tx_));
    const int c = tx_ & 255, row = vb * 2 + (tx_ >> 8);
    if (row < NB * 128) {
        const int b = row >> 7, i = row & 127;
        const bf16* src = PCb + (size_t)(b * SEQ + SEQ - 128 + i) * CN;
        pk[(size_t)row * 256 + c] = bf2f(src[1024 + c]);
        pv[(size_t)row * 256 + c] = bf2f(src[1280 + c]);
    } else {
        const int r2 = row - NB * 128, sb = r2 >> 7, i = r2 & 127;
        if (i < 127) {
            sk[(size_t)r2 * 256 + c] = cache_k[((size_t)sb * 128 + i + 1) * 256 + c];
            sv[(size_t)r2 * 256 + c] = cache_v[((size_t)sb * 128 + i + 1) * 256 + c];
        } else {
            const bf16* src = PCb + (size_t)(NP + sb) * CN;
            sk[(size_t)r2 * 256 + c] = bf2f(src[1024 + c]);
            sv[(size_t)r2 * 256 + c] = bf2f(src[1280 + c]);
        }
    }
}


__device__ __forceinline__ void sample_gemm_piece(const bf16* __restrict__ A, const bf16* __restrict__ Bt, const float* __restrict__ bias, bf16* __restrict__ O, int ldc, int p, unsigned char* lds) {
    int tid = threadIdx.x; asm volatile("" : "+v"(tid));
    const int lane = tid & 63, wave = __builtin_amdgcn_readfirstlane(tid >> 6), fr = lane & 15, fq = lane >> 4;
    const int mt = p & 7, cb = p >> 3, nt = wave & 3, kh = wave >> 2;
    const bf16* ap = A + (size_t)(NP + mt * 16 + fr) * D + kh * 512 + 8 * fq;
    const bf16* bp = Bt + (size_t)(cb * 64 + nt * 16 + fr) * D + kh * 512 + 8 * fq;
    bf16x8_t a[16], b[16];
#pragma unroll
    for (int ks = 0; ks < 16; ++ks) { a[ks] = *(const bf16x8_t*)(ap + ks * 32); b[ks] = *(const bf16x8_t*)(bp + ks * 32); }
    f32x4 acc = (f32x4){0.f, 0.f, 0.f, 0.f};
#pragma unroll
    for (int ks = 0; ks < 16; ++ks) acc = mfma16(a[ks], b[ks], acc);
    f32x4* part = (f32x4*)lds;
    if (kh == 1) part[nt * 64 + lane] = acc;
    __syncthreads();
    if (kh == 0) {
        acc = acc + part[nt * 64 + lane];
        const int col = cb * 64 + nt * 16 + fr; const float bv = bias ? bias[col] : 0.f;
#pragma unroll
        for (int r = 0; r < 4; ++r) O[(size_t)(NP + mt * 16 + 4 * fq + r) * ldc + col] = (bf16)f2bf(acc[r] + bv);
    }
    __syncthreads();
}

constexpr size_t MiB = 1u << 20;
constexpr size_t WS_CTL = 0, CTL_ZERO_BYTES = 64 * 1024;
constexpr size_t WS_WAB = 1 * MiB;
constexpr size_t WS_WOUT = WS_WAB + (size_t)ABNP * D * 2;
constexpr size_t WS_WQ0 = WS_WOUT + (size_t)D * D * 2;
constexpr size_t WS_WQ1 = WS_WQ0 + (size_t)2048 * D * 2;
constexpr size_t WS_WINC = WS_WQ1 + (size_t)2048 * D * 2;
constexpr size_t WS_WOUTC = WS_WINC + (size_t)CN * D * 2;
constexpr size_t WS_ABUF = WS_WOUTC + (size_t)D * D * 2;
constexpr size_t WS_P = WS_ABUF + (size_t)MP * D * 2;
constexpr size_t WS_T = WS_P + (size_t)MP * ABN * 2;
constexpr size_t WS_Q = WS_T + (size_t)4 * 16384 * D + (size_t)4 * 16384 * 4;
constexpr size_t WS_A = WS_Q + (size_t)MP * 1536 * 4;
constexpr size_t WS_B = WS_A + (size_t)MP * 512 * 4;
constexpr size_t WS_O = WS_B + (size_t)MP * 512 * 4;
constexpr size_t WS_X1 = WS_O + (size_t)MP * 512 * 4;
constexpr size_t WS_G = WS_X1 + (size_t)MP * D * 4;
constexpr size_t WS_BETA = WS_G + (size_t)MP * 4 * 4;
constexpr size_t WS_GATE = WS_BETA + (size_t)MP * 4 * 4;
constexpr size_t WS_EXP = WS_GATE + (size_t)MP * 128 * 4;
constexpr size_t WS_HEND = WS_EXP + (size_t)MP * 128 * 4;
constexpr size_t WS_KEYS = WS_HEND + (size_t)3 * 4 * 64 * 512 * 4;
constexpr size_t WS_WGT = WS_KEYS + (size_t)2 * 8 * 2 * 128 * 128 * 2;
constexpr size_t WS_END = WS_WGT + (size_t)2 * 8 * 64 * 64 * 2;
constexpr size_t Q_QKVS = 0, Q_W = 1 * MiB, Q_QG = Q_W + 16 * MiB, Q_KDT = Q_QG + 16 * MiB, Q_UT = Q_KDT + 16 * MiB, Q_QK = Q_UT + 16 * MiB, Q_EGL = Q_QK + 8 * MiB, Q_END = Q_EGL + 4096;
static_assert(Q_END <= (size_t)MP * 1536 * 4, "region Q");
static_assert(WS_END <= 512 * MiB, "d_ws map");

struct MegaArgs {
    const float* in[35];
    float* out;
    unsigned char* ws;
};

__global__ void __launch_bounds__(NTH, 2) fwd_megakernel(MegaArgs ma) {
    cg::grid_group grid = cg::this_grid();
    extern __shared__ __attribute__((aligned(16))) unsigned char lds[];
    float* smem = (float*)lds;
    const int nb = gridDim.x, b0 = blockIdx.x, wave = __builtin_amdgcn_readfirstlane(threadIdx.x >> 6);
    int tid = threadIdx.x, lane = tid & 63;
    const float* x_prompt = ma.in[0];
    const float* x_sample = ma.in[1];
    const float* state_gdn = ma.in[2];
    const float* state_gdn_conv = ma.in[3];
    const float* state_lru = ma.in[4];
    const float* state_lru_conv = ma.in[5];
    const float* cache_k = ma.in[6];
    const float* cache_v = ma.in[7];
    const float* w_in_ab = ma.in[8];
    const float* gdn_conv_w = ma.in[9];
    const float* gdn_a_log = ma.in[10];
    const float* gdn_dt_bias = ma.in[11];
    const float* gdn_norm_w = ma.in[12];
    const float* lru_conv_w = ma.in[13];
    const float* lru_conv_b = ma.in[14];
    const float* lru_w_r = ma.in[15];
    const float* lru_b_r = ma.in[16];
    const float* lru_w_i = ma.in[17];
    const float* lru_b_i = ma.in[18];
    const float* lru_lam = ma.in[19];
    const float* w_out_ab = ma.in[20];
    const float* w_in_c = ma.in[21];
    const float* b_in_c = ma.in[22];
    const float* swa_sinks = ma.in[23];
    const float* w_out_c = ma.in[24];
    const float* b_out_c = ma.in[25];
    const float* rel_bias = ma.in[26];
    const float* ln_mix_g = ma.in[27];
    const float* ln_mix_b = ma.in[28];
    const float* ln_ffn_g = ma.in[29];
    const float* ln_ffn_b = ma.in[30];
    const float* peer_w_q = ma.in[31];
    const float* peer_keys = ma.in[32];
    const float* peer_u = ma.in[33];
    const float* peer_v = ma.in[34];

    float* out = ma.out;
    float* o_y = out;
    float* o_p_gdn = out + (size_t)NT * D;
    float* o_p_gdn_conv = o_p_gdn + 262144;
    float* o_p_lru = o_p_gdn_conv + 18432;
    float* o_p_lru_conv = o_p_lru + 2048;
    float* o_p_k = o_p_lru_conv + 6144;
    float* o_p_v = o_p_k + 131072;
    float* o_s_gdn = o_p_v + 131072;
    float* o_s_gdn_conv = o_s_gdn + 8388608;
    float* o_s_lru = o_s_gdn_conv + 589824;
    float* o_s_lru_conv = o_s_lru + 65536;
    float* o_s_k = o_s_lru_conv + 196608;
    float* o_s_v = o_s_k + 4194304;

    unsigned char* ws = ma.ws;
    bf16* WAB_T = (bf16*)(ws + WS_WAB); bf16* WOUT_T = (bf16*)(ws + WS_WOUT); bf16* WQ0_T = (bf16*)(ws + WS_WQ0); bf16* WQ1_T = (bf16*)(ws + WS_WQ1);
    bf16* WINC_T = (bf16*)(ws + WS_WINC); bf16* WOUTC_T = (bf16*)(ws + WS_WOUTC);
    bf16* ABUF = (bf16*)(ws + WS_ABUF);
    bf16* PROJ = (bf16*)(ws + WS_P); float* Y = (float*)(ws + WS_P); bf16* Qb = (bf16*)(ws + WS_P); bf16* PCb = (bf16*)(ws + WS_P); float* Y1 = (float*)(ws + WS_P);
    unsigned char* TAB8 = ws + WS_T; float* TSC = (float*)(ws + WS_T + (size_t)4 * 16384 * D);
    float* R_Q = (float*)(ws + WS_Q + Q_QKVS) - (size_t)NP * 1536; float* X2 = (float*)(ws + WS_A);
    GdnChunkBufs cbuf; cbuf.W = (bf16*)(ws + WS_Q + Q_W); cbuf.QG = (bf16*)(ws + WS_Q + Q_QG); cbuf.KDT = (bf16*)(ws + WS_Q + Q_KDT); cbuf.UT = (bf16*)(ws + WS_Q + Q_UT); cbuf.QK = (bf16*)(ws + WS_Q + Q_QK); cbuf.EGL = (float*)(ws + WS_Q + Q_EGL);
    bf16* Yb = (bf16*)(ws + WS_P);
    float* OUTS = (float*)(ws + WS_Q);
    float* PD = (float*)(ws + WS_P);
    bf16* KEYSB = (bf16*)(ws + WS_KEYS); bf16* WRT = (bf16*)(ws + WS_WGT); bf16* WIT = WRT + 8 * 64 * 64;
    float* HEND = (float*)(ws + WS_HEND); float* PEND = HEND + 4 * 64 * 512; float* CIN = PEND + 4 * 64 * 512;
    float* R_A = (float*)(ws + WS_A); float* R_B = (float*)(ws + WS_B); float* R_O = (float*)(ws + WS_O);
    bf16* XRES = (bf16*)(ws + WS_X1);
    float* R_G = (float*)(ws + WS_G); float* R_BETA = (float*)(ws + WS_BETA); float* R_GATE = (float*)(ws + WS_GATE); int* R_EXP = (int*)(ws + WS_EXP);

    for (int u = tid; u < (LDS_BYTES - RING_BYTES) / 4; u += NTH) ((unsigned*)(lds + RING_BYTES))[u] = 0u;
    __syncthreads();
    XcdBarrier bar = xcd_barrier_post((unsigned*)(ws + WS_CTL), (volatile LAS unsigned*)((LAS unsigned char*)lds + MISC_OFF) + 8);
#define GRID_BAR() do { xcd_barrier(bar); asm volatile("" : "+v"(tid)); lane = tid & 63; } while (0)
#define PHASE_LOOP(n) for (int vb = b0; vb < (n); vb += nb)
#define PHASE_END __syncthreads()
#define GEMM_PHASE_M(Mrows, EPI, Aptr, Btptr, Nn, ...) do { pg8::Gemm g_{(const pg8::bf16_t*)(Aptr), (const pg8::bf16_t*)(Btptr), (Mrows), (Nn), D}; pg8::StaticOrder S_; S_.init((Mrows), (Nn), nb, b0); \
        pg8::EPI E_{__VA_ARGS__}; pg8::gemm_phase<pg8::EPI, pg8::StaticOrder, true, true>((PG8_LAS unsigned char*)lds, g_, S_, E_); } while (0)
#define GEMM_PHASE(EPI, Aptr, Btptr, Nn, ...) GEMM_PHASE_M(MP, EPI, Aptr, Btptr, Nn, __VA_ARGS__)
#define GEMM_PHASE_SPLIT(Aptr, Btptr, Nn, Optr, biasptr) do { GEMM_PHASE_M(NP, EpiStoreBf16, Aptr, Btptr, Nn, Optr, Nn, biasptr, NP, Nn); \
        for (int p_ = b0; p_ < 8 * ((Nn) / 64); p_ += nb) sample_gemm_piece(Aptr, Btptr, biasptr, Optr, Nn, p_, lds); } while (0)

    {
        float* scr = smem + wave * 4096;
        const int gw = b0 * NWAVES + wave, NGW = nb * NWAVES;
        constexpr int I_AB = 16 * 97, I_OUT = 16 * 32, I_Q = 16 * 64, I_INC = 16 * 48;
        constexpr int NITEMS = I_AB + I_OUT + 2 * I_Q + I_INC + I_OUT;
        for (int it = gw; it < NITEMS; it += NGW) {
            int r = it;
            if (r < I_AB) { p0_transpose_item(w_in_ab, D, ABN, WAB_T, scr, r, lane); continue; } r -= I_AB;
            if (r < I_OUT) { p0_transpose_item(w_out_ab, D, D, WOUT_T, scr, r, lane); continue; } r -= I_OUT;
            if (r < I_Q) { p0_transpose_item(peer_w_q, D, 2048, WQ0_T, scr, r, lane); continue; } r -= I_Q;
            if (r < I_Q) { p0_transpose_item(peer_w_q + (size_t)D * 2048, D, 2048, WQ1_T, scr, r, lane); continue; } r -= I_Q;
            if (r < I_INC) { p0_transpose_item(w_in_c, D, CN, WINC_T, scr, r, lane); continue; } r -= I_INC;
            p0_transpose_item(w_out_c, D, D, WOUTC_T, scr, r, lane);
        }
        for (int it = b0 * NTH + tid; it < 2 * 8 * 64 * 8; it += nb * NTH) {
            const int gsel = it >> 12, nn = (it >> 9) & 7, dd = (it >> 3) & 63, c8 = (it & 7) * 8;
            const float* wsrc = (gsel ? lru_w_i : lru_w_r) + ((size_t)nn * 64 + c8) * 64 + dd;
            v4u o; o.x = pk2(wsrc[0], wsrc[64]); o.y = pk2(wsrc[128], wsrc[192]); o.z = pk2(wsrc[256], wsrc[320]); o.w = pk2(wsrc[384], wsrc[448]);
            *(v4u*)((gsel ? WIT : WRT) + ((size_t)nn * 64 + dd) * 64 + c8) = o;
        }
        for (int m = gw; m < MP + (ABNP - 97 * 32); m += NGW) {
            if (m < MP) row_to_bf16(m < NP ? x_prompt + (size_t)m * D : (m < NT ? x_sample + (size_t)(m - NP) * D : nullptr), ABUF + (size_t)m * D, lane);
            else row_to_bf16(nullptr, WAB_T + (size_t)(97 * 32 + (m - MP)) * D, lane);
        }
    }
    GRID_BAR();
    if (ma.out == nullptr) grid.sync();
    GEMM_PHASE(EpiStoreBf16, ABUF, WAB_T, ABNP, PROJ, ABN, nullptr, NT, ABN);
    GRID_BAR();
    constexpr int NSPLIT = 28, A_LRU = 4 * NSPLIT, A_GDN = 16 * NSPLIT, B_LRU = 4 * (64 - NSPLIT), B_GDN = 16 * (64 - NSPLIT);
    { AbPrepArgs pa;
      pa.PROJ = PROJ; pa.st_gdn_conv = state_gdn_conv; pa.st_lru_conv = state_lru_conv;
      pa.gdn_conv_w = gdn_conv_w; pa.a_log = gdn_a_log; pa.dt_bias = gdn_dt_bias;
      pa.lru_conv_w = lru_conv_w; pa.lru_conv_b = lru_conv_b; pa.w_r = lru_w_r; pa.b_r = lru_b_r; pa.w_i = lru_w_i; pa.b_i = lru_b_i; pa.lam = lru_lam;
      pa.QKV = R_Q; pa.G = R_G; pa.BETA = R_BETA; pa.LA = R_A; pa.LB = R_B;
      pa.p_gdn_conv = o_p_gdn_conv; pa.p_lru_conv = o_p_lru_conv; pa.s_gdn_conv = o_s_gdn_conv; pa.s_lru_conv = o_s_lru_conv;
      for (int v = b0; v < A_LRU + NS + A_GDN; v += nb) {
          if (v < A_LRU) { lru_prep_unit2(PROJ, lru_conv_w, lru_conv_b, WRT, WIT, lru_b_r, lru_b_i, lru_lam, R_B, R_A, HEND, PEND, o_p_lru_conv, (v / NSPLIT) * 64 + (v % NSPLIT), lds); PHASE_END; }
          else if (v < A_LRU + NS) { ab_prep(pa, NP + (v - A_LRU), smem); PHASE_END; }
          else { const int i = v - A_LRU - NS, h_ = i & 3, n_ = (i >> 2) % NSPLIT, b_ = (i >> 2) / NSPLIT;
                 gdn_prep_unit(PROJ, gdn_conv_w, gdn_a_log, gdn_dt_bias, cbuf, o_p_gdn_conv, (b_ * 64 + n_) * 4 + h_, lds); }
      } }
    GRID_BAR();
    f32x4 seqS[2]; int seqcur = 0;
    const int seq_p = (b0 & 7) + 8 * (b0 >> 5), seq_s = (b0 >> 3) & 3;
    if (b0 < 64) gdn_seq<0, NSPLIT>(cbuf, R_O, o_p_gdn, seq_p >> 2, seq_p & 3, seq_s, lds, seqS, seqcur);
    else for (int v = b0 - 64; v < B_LRU + B_GDN; v += nb - 64) {
        if (v < B_LRU) { lru_prep_unit2(PROJ, lru_conv_w, lru_conv_b, WRT, WIT, lru_b_r, lru_b_i, lru_lam, R_B, R_A, HEND, PEND, o_p_lru_conv, (v / (64 - NSPLIT)) * 64 + NSPLIT + (v % (64 - NSPLIT)), lds); PHASE_END; }
        else { const int i = v - B_LRU, h_ = i & 3, n_ = NSPLIT + (i >> 2) % (64 - NSPLIT), b_ = (i >> 2) / (64 - NSPLIT);
               gdn_prep_unit(PROJ, gdn_conv_w, gdn_a_log, gdn_dt_bias, cbuf, o_p_gdn_conv, (b_ * 64 + n_) * 4 + h_, lds); }
    }
    GRID_BAR();
    if (b0 < 64) gdn_seq<NSPLIT, 64>(cbuf, R_O, o_p_gdn, seq_p >> 2, seq_p & 3, seq_s, lds, seqS, seqcur);
    else if (b0 < 68) lru_carry(HEND, PEND, CIN, o_p_lru, b0 - 64);
    else {
        for (int v = b0 - 68; v < 2048 + 128; v += nb - 68) {
            if (v < 2048) gdn_scan(R_Q, R_G, R_BETA, state_gdn, R_O, o_s_gdn, NP, 1, v & 3, (v >> 2) & 3, v >> 4, smem);
            else lru_scan(R_A, R_B, state_lru, o_s_lru, NP, 1, NS, v - 2048);
            PHASE_END;
        }
        const int gw2 = (b0 - 68) * NWAVES + wave, NGW2 = (nb - 68) * NWAVES;
        for (int m = gw2; m < 512; m += NGW2) row_to_bf16(peer_keys + (size_t)m * D, KEYSB + (size_t)m * D, lane);
        for (int m = gw2; m < 4 * 16384; m += NGW2) {
            const int k = m >> 14, r = m & 16383;
            if (k & 1) row_to_fp8_sliced(peer_v + ((size_t)(k >> 1) * 16384 + r) * D, TAB8 + (size_t)k * 16384 * D, r, TSC + m, lane);
            else row_to_i8_sliced(peer_u + ((size_t)(k >> 1) * 16384 + r) * D, TAB8 + (size_t)k * 16384 * D, r, TSC + m, lane);
        }
    }
    GRID_BAR();
    PHASE_LOOP(NT / 8) { ab_mix_w(PROJ, R_O, R_B, R_A, CIN, gdn_norm_w, ABUF, vb * 8 + wave, lane); }
    GRID_BAR();
    GEMM_PHASE_SPLIT(ABUF, WOUT_T, D, Yb, (const float*)nullptr);
    GRID_BAR();
    PHASE_LOOP(NT / 8) { const int t = vb * 8 + wave;
        ln_res_w<false>(t < NP ? x_prompt + (size_t)t * D : x_sample + (size_t)(t - NP) * D, Yb + (size_t)t * D, ln_mix_g, ln_mix_b, ABUF + (size_t)t * D, lane); }
    GRID_BAR();
    GEMM_PHASE_SPLIT(ABUF, WQ0_T, 2048, Qb, (const float*)nullptr);
    GRID_BAR();
    if ((nb & 7) == 0) { peer_topk_stage_keys(KEYSB, b0 & 7, lds); PHASE_LOOP((NT / 64) * 8) { peer_topk4(Qb, R_EXP, R_GATE, vb >> 3, vb & 7, lds); } }
    else PHASE_LOOP((NT / 64) * 8) { peer_topk_stage_keys(KEYSB, vb & 7, lds); peer_topk4(Qb, R_EXP, R_GATE, vb >> 3, vb & 7, lds); }
    GRID_BAR();
    asm volatile("" : "+v"(tid)); lane = tid & 63;
    { const int x = b0 & 7, tg0 = b0 >> 3, tgstep = nb >> 3, nit = (NT / 8 - tg0 + tgstep - 1) / tgstep;
      peer_u_loop(ABUF, R_EXP, TAB8 + (size_t)x * 16384 * 128, PD + (size_t)x * NT * 128, x, tg0, tgstep, nit, wave, lane); }
    GRID_BAR();
    PHASE_LOOP(NT / 8) { const int t = vb * 8 + wave; peer_xk(R_EXP + (size_t)t * 128, R_GATE + (size_t)t * 128, PD + (size_t)t * 128, TSC, TSC + 16384, lane); }
    GRID_BAR();
    { const int x = b0 & 7, tg0 = b0 >> 3, tgstep = nb >> 3, nit = (NT / 8 - tg0 + tgstep - 1) / tgstep;
      peer_v_loop(R_EXP, R_GATE, TAB8 + (size_t)16384 * D + (size_t)x * 16384 * 128, OUTS, x, tg0, tgstep, nit, wave, lane); }
    GRID_BAR();
    PHASE_LOOP(NT / 8) { const int t = vb * 8 + wave; peer_xc(ABUF + (size_t)t * D, OUTS + (size_t)t * D, ln_ffn_g, ln_ffn_b, nullptr, ABUF + (size_t)t * D, XRES + (size_t)t * D, lane); }
    GRID_BAR();

    GEMM_PHASE(EpiStoreBf16, ABUF, WINC_T, CN, PCb, CN, b_in_c, NT, CN);
    GRID_BAR();
    PHASE_LOOP(1024 + 256 + (NB * 128 + NS * 128) / 2) {
        if (vb < 1024) attn_unit(PCb, rel_bias, swa_sinks, ABUF, vb, lds);
        else if (vb < 1280) swa_attn_sample(PCb, cache_k, cache_v, rel_bias, swa_sinks, ABUF, (vb - 1024) * 8 + wave, lane);
        else swa_kv_out2(PCb, cache_k, cache_v, o_p_k, o_p_v, o_s_k, o_s_v, vb - 1280);
    }
    GRID_BAR();
    GEMM_PHASE_SPLIT(ABUF, WOUTC_T, D, Yb, b_out_c);
    GRID_BAR();
    PHASE_LOOP(NT / 8) { const int t = vb * 8 + wave;
        ln_res_w<true>(XRES + (size_t)t * D, Yb + (size_t)t * D, ln_mix_g + D, ln_mix_b + D, ABUF + (size_t)t * D, lane); }
    GRID_BAR();
    GEMM_PHASE_SPLIT(ABUF, WQ1_T, 2048, Qb, (const float*)nullptr);
    GRID_BAR();
    if ((nb & 7) == 0) { peer_topk_stage_keys(KEYSB + (size_t)8 * 2 * 128 * 128, b0 & 7, lds); PHASE_LOOP((NT / 64) * 8) { peer_topk4(Qb, R_EXP, R_GATE, vb >> 3, vb & 7, lds); } }
    else PHASE_LOOP((NT / 64) * 8) { peer_topk_stage_keys(KEYSB + (size_t)8 * 2 * 128 * 128, vb & 7, lds); peer_topk4(Qb, R_EXP, R_GATE, vb >> 3, vb & 7, lds); }
    GRID_BAR();
    asm volatile("" : "+v"(tid)); lane = tid & 63;
    { const int x = b0 & 7, tg0 = b0 >> 3, tgstep = nb >> 3, nit = (NT / 8 - tg0 + tgstep - 1) / tgstep;
      peer_u_loop(ABUF, R_EXP, TAB8 + (size_t)2 * 16384 * D + (size_t)x * 16384 * 128, PD + (size_t)x * NT * 128, x, tg0, tgstep, nit, wave, lane); }
    GRID_BAR();
    PHASE_LOOP(NT / 8) { const int t = vb * 8 + wave; peer_xk(R_EXP + (size_t)t * 128, R_GATE + (size_t)t * 128, PD + (size_t)t * 128, TSC + 2 * 16384, TSC + 3 * 16384, lane); }
    GRID_BAR();
    { const int x = b0 & 7, tg0 = b0 >> 3, tgstep = nb >> 3, nit = (NT / 8 - tg0 + tgstep - 1) / tgstep;
      peer_v_loop(R_EXP, R_GATE, TAB8 + (size_t)3 * 16384 * D + (size_t)x * 16384 * 128, OUTS, x, tg0, tgstep, nit, wave, lane); }
    GRID_BAR();
    PHASE_LOOP(NT / 8) { const int t = vb * 8 + wave; peer_xc(ABUF + (size_t)t * D, OUTS + (size_t)t * D, ln_ffn_g + D, ln_ffn_b + D, o_y + (size_t)t * D, nullptr, nullptr, lane); }
}
}

extern "C" void kernel_launch(void* const* d_in, const int* in_sizes, int n_in,
                              void* d_out, int out_size, void* d_ws, size_t ws_size,
                              hipStream_t stream) {
    static int grid_blocks = 0;
    if (!grid_blocks) {
        int dev = 0, cus = 0, per_cu = 0;
        (void)hipGetDevice(&dev);
        (void)hipDeviceGetAttribute(&cus, hipDeviceAttributeMultiprocessorCount, dev);
        if (hipFuncSetAttribute((const void*)fwd_megakernel, hipFuncAttributeMaxDynamicSharedMemorySize, LDS_BYTES) != hipSuccess) { fprintf(stderr, "hipFuncSetAttribute failed\n"); grid_blocks = -1; return; }
        (void)hipOccupancyMaxActiveBlocksPerMultiprocessor(&per_cu, (const void*)fwd_megakernel, NTH, LDS_BYTES);
        if (per_cu < 1) { fprintf(stderr, "occupancy query says %d blocks per CU\n", per_cu); grid_blocks = -1; return; }
        if (cus * per_cu < 256) { fprintf(stderr, "this kernel needs 256 co-resident workgroups (device reports %d CUs x %d)\n", cus, per_cu); grid_blocks = -1; return; }
        grid_blocks = 256;
    }
    if (grid_blocks < 0) return;
    (void)hipMemsetAsync((char*)d_ws + WS_CTL, 0, CTL_ZERO_BYTES, stream);
    MegaArgs ma{};
    for (int i = 0; i < 35; ++i) ma.in[i] = (const float*)d_in[i];
    ma.out = (float*)d_out;
    ma.ws = (unsigned char*)d_ws;
    void* args[] = {&ma};
    hipError_t e = hipLaunchCooperativeKernel((void*)fwd_megakernel, dim3(grid_blocks), dim3(NTH), args, LDS_BYTES, stream);
    if (e != hipSuccess) fprintf(stderr, "cooperative launch failed: %s (grid %d)\n", hipGetErrorString(e), grid_blocks);
}
```

```cpp
#include <hip/hip_runtime.h>
#include <hip/hip_cooperative_groups.h>
#include <cstdio>
#include <cstdint>
namespace cg = cooperative_groups;

namespace pg8 {
#define PG8_LAS __attribute__((address_space(3)))
typedef unsigned short bf16_t;
typedef short bf16x8 __attribute__((ext_vector_type(8)));
typedef float f32x4 __attribute__((ext_vector_type(4)));
typedef unsigned u32x4 __attribute__((ext_vector_type(4)));
constexpr int BM = 256, BK = 64, HALF = 128, HTB = HALF * BK * 2  , STAGE_BYTES = 8 * HTB, NXCD = 8, WGM = 8;

__host__ __device__ __forceinline__ int lds_byte(int r, int c) { const int st = (r >> 4) * 2 + (c >> 5), rr = r & 15, cc = c & 31, ob = rr * 64 + cc * 2; return st * 1024 + (ob ^ (((ob >> 9) & 1) << 5)); }
__host__ __device__ __forceinline__ void stage_rc(int b, int& R, int& C) { const int st = b / 1024, sb = b % 1024, swz = sb ^ (((sb >> 9) & 1) << 5); R = (st >> 1) * 16 + swz / 64; C = (st & 1) * 32 + (swz % 64) / 2; }
__host__ __device__ __forceinline__ int perm32(int rho) { const int n = rho >> 4, i = rho & 15; return 8 * (i >> 2) + 4 * n + (i & 3); }

struct Unit { int pm, pn; };
struct Gemm { const bf16_t* A; const bf16_t* Bt; int M, N, K; };

struct StaticOrder {
    int nM, nN, nwg, G, c;
    __host__ __device__ void init(int M, int N, int G_, int c_) { nM = M / BM; nN = N / BM; nwg = nM * nN; G = G_; c = c_; }
    __host__ __device__ bool next(int i, Unit& u) const {
        const long L = (long)i * G + c; if (L >= nwg) return false;
        int wgid = (int)L; { const int q = nwg / NXCD, r = nwg % NXCD, xcd = wgid % NXCD, off = wgid / NXCD; wgid = (xcd < r ? xcd * (q + 1) : r * (q + 1) + (xcd - r) * q) + off; }
        const int nig = WGM * nN, gid = wgid / nig, fm = gid * WGM, gsz = (nM - fm) < WGM ? (nM - fm) : WGM;
        u.pm = fm + ((wgid % nig) % gsz); u.pn = (wgid % nig) / gsz; return true;
    }
    __device__ __forceinline__ void a_ready(const Unit&) const {}
    __device__ __forceinline__ void done(const Unit&) const {}
};

__device__ __forceinline__ unsigned cvt_pk_bf16(float lo, float hi) { unsigned r; asm volatile("v_cvt_pk_bf16_f32 %0, %1, %2" : "=v"(r) : "v"(lo), "v"(hi)); return r; }
template <class Epi, class Sched, bool ALIGN_EPI = false, bool SP2 = false>
__device__ __forceinline__ void gemm_phase(PG8_LAS unsigned char* lds, const Gemm g, const Sched& S, const Epi& E) {
    int tid_ = threadIdx.x; asm volatile("" : "+v"(tid_));
    const int tid = tid_, wid = __builtin_amdgcn_readfirstlane(tid >> 6), lane = tid & 63, wr = wid >> 2, wc = wid & 3, fr = lane & 15, fq = lane >> 4;
    const int K = g.K, nt = K / BK;
    unsigned voffA[2], voffB[2];
#pragma unroll
    for (int i = 0; i < 2; ++i) { int R, C; stage_rc(tid * 16 + i * 8192, R, C); const int Rb = Epi::PERM ? ((R & ~31) + perm32(R & 31)) : R;
        voffA[i] = (unsigned)(R * K + C) * 2u; voffB[i] = (unsigned)(Rb * K + C) * 2u; }
    const size_t kstep = (size_t)(BK * 2);
    const size_t hstep = (size_t)HALF * K * 2;
    const size_t tstep = 2 * hstep;
    const unsigned ldsw = (unsigned)wid * 1024u;
    const int aoff = lds_byte(wr * 64 + fr, fq * 8), boff = lds_byte(wc * 32 + fr, fq * 8);
#define PG8_SA(b, h) (((b) * 2 + (h)) * HTB)
#define PG8_SB(b, h) ((4 + (b) * 2 + (h)) * HTB)
#define PG8_STAGE(bufoff, gbase, voff) do { _Pragma("unroll") for (int _i = 0; _i < 2; ++_i) \
        __builtin_amdgcn_global_load_lds((const unsigned*)((const char*)(gbase) + (voff)[_i]), (PG8_LAS unsigned*)(lds + (bufoff) + ldsw + _i * 8192), 16, 0, 0); } while (0)
#define PG8_LDA(dst, b, h) do { _Pragma("unroll") for (int m = 0; m < 4; ++m) _Pragma("unroll") for (int k = 0; k < 2; ++k) dst[m][k] = *(const PG8_LAS bf16x8*)(lds + PG8_SA(b, h) + aoff + m * 2048 + k * 1024); } while (0)
#define PG8_LDB(dst, b, h) do { _Pragma("unroll") for (int n = 0; n < 2; ++n) _Pragma("unroll") for (int k = 0; k < 2; ++k) dst[n][k] = *(const PG8_LAS bf16x8*)(lds + PG8_SB(b, h) + boff + n * 2048 + k * 1024); } while (0)
#define PG8_MMA(ai, bj, At, Bt) do { __builtin_amdgcn_s_setprio(1); _Pragma("unroll") for (int m = 0; m < 4; ++m) _Pragma("unroll") for (int n = 0; n < 2; ++n) _Pragma("unroll") for (int k = 0; k < 2; ++k) \
        acc[ai][bj][m][n] = __builtin_amdgcn_mfma_f32_16x16x32_bf16(Bt[n][k], At[m][k], acc[ai][bj][m][n], 0, 0, 0); __builtin_amdgcn_s_setprio(0); } while (0)
#define PG8_WAIT_V(n) asm volatile("s_waitcnt vmcnt(" #n ")" ::: "memory")
#define PG8_WAIT_L(n) asm volatile("s_waitcnt lgkmcnt(" #n ")" ::: "memory")
#define PG8_BAR __builtin_amdgcn_s_barrier()
#define PG8_SCHED __builtin_amdgcn_sched_barrier(0)
    Unit cur, nxt; int ui = 0;
    if (!S.next(0, cur)) return;
    f32x4 acc[2][2][4][2];
#pragma unroll
    for (int a = 0; a < 2; ++a)
#pragma unroll
        for (int b = 0; b < 2; ++b)
#pragma unroll
            for (int m = 0; m < 4; ++m)
#pragma unroll
                for (int n = 0; n < 2; ++n) acc[a][b][m][n] = (f32x4){0.f, 0.f, 0.f, 0.f};
    bf16x8 At[4][2], B0[2][2], B1[2][2];
    const char* cA = (const char*)g.A + (size_t)cur.pm * tstep; const char* cB = (const char*)g.Bt + (size_t)cur.pn * tstep;
    S.a_ready(cur);
    if constexpr (SP2) {
        PG8_STAGE(PG8_SB(0, 0), cB, voffB); PG8_STAGE(PG8_SB(0, 1), cB + hstep, voffB); PG8_STAGE(PG8_SA(0, 0), cA, voffA); PG8_STAGE(PG8_SA(0, 1), cA + hstep, voffA);
        if (wr == 1) PG8_BAR;
        PG8_WAIT_V(2); PG8_BAR;
        PG8_STAGE(PG8_SB(1, 0), cB + kstep, voffB); PG8_STAGE(PG8_SA(1, 0), cA + kstep, voffA); PG8_STAGE(PG8_SB(1, 1), cB + hstep + kstep, voffB);
        PG8_WAIT_V(6); PG8_BAR;
    } else {
        PG8_STAGE(PG8_SB(0, 0), cB, voffB); PG8_STAGE(PG8_SA(0, 0), cA, voffA); PG8_STAGE(PG8_SB(0, 1), cB + hstep, voffB); PG8_STAGE(PG8_SA(0, 1), cA + hstep, voffA);
        if (wr == 1) PG8_BAR;
        PG8_WAIT_V(4); PG8_BAR;
        PG8_STAGE(PG8_SB(1, 0), cB + kstep, voffB); PG8_STAGE(PG8_SA(1, 0), cA + kstep, voffA); PG8_STAGE(PG8_SB(1, 1), cB + hstep + kstep, voffB);
        PG8_WAIT_V(6); PG8_BAR;
    }
    for (;;) {
        const bool has_next = S.next(ui + 1, nxt);
        const char* nA = has_next ? (const char*)g.A + (size_t)nxt.pm * tstep : cA; const char* nB = has_next ? (const char*)g.Bt + (size_t)nxt.pn * tstep : cB;
        for (int t = 0; t < nt; t += 2) {
            const bool last = (t == nt - 2);
            const char* a1 = cA + (size_t)(t + 1) * kstep;
            const char* a2 = last ? nA : cA + (size_t)(t + 2) * kstep; const char* b2 = last ? nB : cB + (size_t)(t + 2) * kstep;
            const char* a3 = a2 + kstep; const char* b3 = b2 + kstep;
            if (last && has_next) S.a_ready(nxt);
            if constexpr (SP2) {
            PG8_LDB(B0, 0, 0); PG8_LDB(B1, 0, 1); PG8_SCHED; PG8_LDA(At, 0, 0); PG8_STAGE(PG8_SA(1, 1), a1 + hstep, voffA);
            PG8_WAIT_V(8); PG8_WAIT_L(0); PG8_BAR; PG8_MMA(0, 0, At, B0); PG8_MMA(0, 1, At, B1); PG8_BAR; PG8_SCHED;
            PG8_LDA(At, 0, 1); PG8_STAGE(PG8_SB(0, 0), b2, voffB); PG8_STAGE(PG8_SB(0, 1), b2 + hstep, voffB); PG8_STAGE(PG8_SA(0, 0), a2, voffA);
            PG8_WAIT_V(8); PG8_WAIT_L(0); PG8_BAR; PG8_MMA(1, 0, At, B0); PG8_MMA(1, 1, At, B1); PG8_BAR; PG8_SCHED;
            PG8_LDB(B0, 1, 0); PG8_LDB(B1, 1, 1); PG8_SCHED; PG8_LDA(At, 1, 0); PG8_STAGE(PG8_SA(0, 1), a2 + hstep, voffA);
            PG8_WAIT_V(8); PG8_WAIT_L(0); PG8_BAR; PG8_MMA(0, 0, At, B0); PG8_MMA(0, 1, At, B1); PG8_BAR; PG8_SCHED;
            PG8_LDA(At, 1, 1); PG8_STAGE(PG8_SB(1, 0), b3, voffB); PG8_STAGE(PG8_SB(1, 1), b3 + hstep, voffB); PG8_STAGE(PG8_SA(1, 0), a3, voffA);
            PG8_WAIT_V(8); PG8_WAIT_L(0); PG8_BAR; PG8_MMA(1, 0, At, B0); PG8_MMA(1, 1, At, B1); PG8_BAR; PG8_SCHED;
            } else {
            PG8_LDB(B0, 0, 0); PG8_SCHED; PG8_LDA(At, 0, 0); PG8_STAGE(PG8_SA(1, 1), a1 + hstep, voffA);
            PG8_WAIT_L(8); PG8_BAR; PG8_WAIT_L(0); PG8_MMA(0, 0, At, B0); PG8_BAR; PG8_SCHED;
            PG8_LDB(B1, 0, 1); PG8_STAGE(PG8_SB(0, 0), b2, voffB);
            PG8_BAR; PG8_WAIT_L(0); PG8_MMA(0, 1, At, B1); PG8_BAR;
            PG8_LDA(At, 0, 1); PG8_STAGE(PG8_SA(0, 0), a2, voffA);
            PG8_BAR; PG8_WAIT_L(0); PG8_MMA(1, 0, At, B0); PG8_BAR; PG8_SCHED;
            PG8_STAGE(PG8_SB(0, 1), b2 + hstep, voffB);
            PG8_WAIT_V(6); PG8_BAR; PG8_MMA(1, 1, At, B1); PG8_BAR;
            PG8_LDB(B0, 1, 0); PG8_SCHED; PG8_LDA(At, 1, 0); PG8_STAGE(PG8_SA(0, 1), a2 + hstep, voffA);
            PG8_WAIT_L(8); PG8_BAR; PG8_WAIT_L(0); PG8_MMA(0, 0, At, B0); PG8_BAR; PG8_SCHED;
            PG8_LDB(B1, 1, 1); PG8_STAGE(PG8_SB(1, 0), b3, voffB);
            PG8_BAR; PG8_WAIT_L(0); PG8_MMA(0, 1, At, B1); PG8_BAR;
            PG8_LDA(At, 1, 1); PG8_STAGE(PG8_SA(1, 0), a3, voffA);
            PG8_BAR; PG8_WAIT_L(0); PG8_MMA(1, 0, At, B0); PG8_BAR; PG8_SCHED;
            PG8_STAGE(PG8_SB(1, 1), b3 + hstep, voffB);
            PG8_WAIT_V(6); PG8_BAR; PG8_MMA(1, 1, At, B1); PG8_BAR;
            }
        }
        if constexpr (ALIGN_EPI) { if (wr == 0) PG8_BAR; }
        if constexpr (!Epi::AFTER_DRAIN) { E(acc, cur, wr, wc, fr, fq); S.done(cur); }
        if (!has_next) break;
#pragma unroll
        for (int a = 0; a < 2; ++a)
#pragma unroll
            for (int b = 0; b < 2; ++b)
#pragma unroll
                for (int m = 0; m < 4; ++m)
#pragma unroll
                    for (int n = 0; n < 2; ++n) acc[a][b][m][n] = (f32x4){0.f, 0.f, 0.f, 0.f};
        cur = nxt; cA = nA; cB = nB; ++ui;
        if constexpr (ALIGN_EPI) { if (wr == 1) PG8_BAR; }
    }
    PG8_WAIT_V(0);
    if constexpr (!ALIGN_EPI) { if (wr == 0) PG8_BAR; }
    PG8_BAR;
    if constexpr (Epi::AFTER_DRAIN) { E.fused(acc, cur, wr, wc, fr, fq, lds, wid, lane); S.done(cur); }
#undef PG8_SA
#undef PG8_SB
#undef PG8_STAGE
#undef PG8_LDA
#undef PG8_LDB
#undef PG8_MMA
#undef PG8_WAIT_V
#undef PG8_WAIT_L
#undef PG8_BAR
#undef PG8_SCHED
}
}
namespace pg8 {
struct EpiStoreBf16 {
    static constexpr bool PERM = true, AFTER_DRAIN = false;
    bf16_t* O; int ldc; const float* bias; int m_real, n_real;
    __device__ __forceinline__ void operator()(const f32x4 (&acc)[2][2][4][2], const Unit& u, int wr, int wc, int fr, int fq) const {
        const int row0 = u.pm * BM + wr * 64 + fr, col0 = u.pn * BM + wc * 32 + 8 * fq;
#pragma unroll
        for (int bj = 0; bj < 2; ++bj) {
            const int col = col0 + bj * HALF;
            if (col >= n_real) continue;
            f32x4 b0 = (f32x4){0.f, 0.f, 0.f, 0.f}, b1 = b0;
            if (bias) { b0 = *(const f32x4*)(bias + col); b1 = *(const f32x4*)(bias + col + 4); }
#pragma unroll
            for (int ai = 0; ai < 2; ++ai)
#pragma unroll
                for (int m = 0; m < 4; ++m) {
                    const int row = row0 + ai * HALF + m * 16;
                    if (row >= m_real) continue;
                    const f32x4 v0 = acc[ai][bj][m][0] + b0, v1 = acc[ai][bj][m][1] + b1;
                    u32x4 w; w.x = cvt_pk_bf16(v0[0], v0[1]); w.y = cvt_pk_bf16(v0[2], v0[3]); w.z = cvt_pk_bf16(v1[0], v1[1]); w.w = cvt_pk_bf16(v1[2], v1[3]);
                    *(u32x4*)(O + (size_t)row * ldc + col) = w;
                }
        }
    }
};
struct EpiStoreF32 {
    static constexpr bool PERM = false, AFTER_DRAIN = false;
    float* O; int ldc; const float* bias; int m_real, n_real;
    __device__ __forceinline__ void operator()(const f32x4 (&acc)[2][2][4][2], const Unit& u, int wr, int wc, int fr, int fq) const {
        const int row0 = u.pm * BM + wr * 64 + fr, col0 = u.pn * BM + wc * 32 + 4 * fq;
#pragma unroll
        for (int bj = 0; bj < 2; ++bj)
#pragma unroll
            for (int n = 0; n < 2; ++n) {
                const int col = col0 + bj * HALF + n * 16;
                if (col >= n_real) continue;
                const f32x4 bv = bias ? *(const f32x4*)(bias + col) : (f32x4){0.f, 0.f, 0.f, 0.f};
#pragma unroll
                for (int ai = 0; ai < 2; ++ai)
#pragma unroll
                    for (int m = 0; m < 4; ++m) {
                        const int row = row0 + ai * HALF + m * 16;
                        if (row >= m_real) continue;
                        *(f32x4*)(O + (size_t)row * ldc + col) = acc[ai][bj][m][n] + bv;
                    }
            }
    }
};
}
namespace {
#define GAS __attribute__((address_space(1)))
#define LAS __attribute__((address_space(3)))
typedef unsigned short bf16;
typedef float f32x4 __attribute__((ext_vector_type(4)));
typedef unsigned v4u __attribute__((ext_vector_type(4)));
typedef unsigned v2u __attribute__((ext_vector_type(2)));

constexpr int D = 1024, NB = 4, SEQ = 4096, NP = NB * SEQ, NS = 128, NT = NP + NS, MP = 16640;
constexpr int ABN = 3080, ABNP = 3328;
constexpr int C_QKV = 0, C_Z = 1536, C_A = 2048, C_B = 2052, C_XR = 2056, C_GATE = 2568;
constexpr int CN = 1536;
constexpr float ALPHA = 1.4142135623730951f;
constexpr float LN_EPS = 1e-5f;
constexpr int NTH = 512, NWAVES = 8;
constexpr int RING_BYTES = 143360, MISC_OFF = RING_BYTES + 320, LDS_BYTES = 147456;

__device__ __forceinline__ float bf2f(bf16 v) { return __uint_as_float((unsigned)v << 16); }
__device__ __forceinline__ float bflo(unsigned w) { return __uint_as_float(w << 16); }
__device__ __forceinline__ float bfhi(unsigned w) { return __uint_as_float(w & 0xffff0000u); }
__device__ __forceinline__ unsigned f2bf(float f) { unsigned u = __float_as_uint(f); return (u + 0x7fffu + ((u >> 16) & 1u)) >> 16; }
__device__ __forceinline__ unsigned pk2(float lo, float hi) { return f2bf(lo) | (f2bf(hi) << 16); }
__device__ __forceinline__ float sigmoidf_(float x) { return 1.0f / (1.0f + expf(-x)); }
__device__ __forceinline__ float softplusf_(float x) { return fmaxf(x, 0.f) + log1pf(expf(-fabsf(x))); }
__device__ __forceinline__ float siluf_(float x) { return x / (1.0f + expf(-x)); }
__device__ __forceinline__ float geluf_(float x) { return 0.5f * x * (1.0f + tanhf(0.7978845608028654f * (x + 0.044715f * x * x * x))); }
#define DPPF(v_, ctrl_, rmask_) __int_as_float(__builtin_amdgcn_update_dpp(0, __float_as_int(v_), (ctrl_), (rmask_), 0xf, false))
__device__ __forceinline__ float wave_sum(float v) {
    v += DPPF(v, 0xB1, 0xf); v += DPPF(v, 0x4E, 0xf); v += DPPF(v, 0x141, 0xf); v += DPPF(v, 0x140, 0xf);
    v += DPPF(v, 0x142, 0xa); v += DPPF(v, 0x143, 0xc);
    return __int_as_float(__builtin_amdgcn_readlane(__float_as_int(v), 63));
}
__device__ __forceinline__ float wave_max(float v) {
    v = fmaxf(v, DPPF(v, 0xB1, 0xf)); v = fmaxf(v, DPPF(v, 0x4E, 0xf)); v = fmaxf(v, DPPF(v, 0x141, 0xf)); v = fmaxf(v, DPPF(v, 0x140, 0xf));
    { const float t = __int_as_float(__builtin_amdgcn_update_dpp(__float_as_int(v), __float_as_int(v), 0x142, 0xa, 0xf, false)); v = fmaxf(v, t); }
    { const float t = __int_as_float(__builtin_amdgcn_update_dpp(__float_as_int(v), __float_as_int(v), 0x143, 0xc, 0xf, false)); v = fmaxf(v, t); }
    return __int_as_float(__builtin_amdgcn_readlane(__float_as_int(v), 63));
}

__device__ __forceinline__ void p0_transpose_item(const float* __restrict__ W, int K, int N, bf16* __restrict__ WT, float* scr, int item, int lane) {
    const int nblk = (N + 31) / 32, kb = item / nblk, nb = item % nblk, k0 = 64 * kb, n0 = 32 * nb;
#pragma unroll 8
    for (int i = 0; i < 32; ++i) { const int kk = 2 * i + (lane >> 5), n = n0 + (lane & 31); scr[kk * 33 + (lane & 31)] = n < N ? W[(size_t)(k0 + kk) * N + n] : 0.f; }
    asm volatile("s_waitcnt lgkmcnt(0)" ::: "memory");
    const int c = lane & 7;
#pragma unroll
    for (int j = 0; j < 4; ++j) { const int n = (lane >> 3) + 8 * j; const float* s = scr + (8 * c) * 33 + n;
        v4u o; o.x = pk2(s[0 * 33], s[1 * 33]); o.y = pk2(s[2 * 33], s[3 * 33]); o.z = pk2(s[4 * 33], s[5 * 33]); o.w = pk2(s[6 * 33], s[7 * 33]);
        *(v4u*)(WT + (size_t)(n0 + n) * K + k0 + 8 * c) = o; }
    asm volatile("s_waitcnt lgkmcnt(0)" ::: "memory");
}
__device__ __forceinline__ void row_to_bf16(const float* __restrict__ xrow, bf16* __restrict__ orow, int lane) {
#pragma unroll
    for (int j = 0; j < 4; ++j) {
        f32x4 v = (f32x4){0.f, 0.f, 0.f, 0.f};
        if (xrow) v = ((const f32x4*)xrow)[lane + 64 * j];
        v2u o; o.x = pk2(v.x, v.y); o.y = pk2(v.z, v.w);
        ((v2u*)orow)[lane + 64 * j] = o;
    }
}

struct AbPrepArgs {
    const bf16* PROJ; const float* st_gdn_conv; const float* st_lru_conv;
    const float* gdn_conv_w; const float* a_log; const float* dt_bias;
    const float* lru_conv_w; const float* lru_conv_b; const float* w_r; const float* b_r; const float* w_i; const float* b_i; const float* lam;
    float* QKV; float* G; float* BETA; float* LA; float* LB;
    float* p_gdn_conv; float* p_lru_conv; float* s_gdn_conv; float* s_lru_conv;
};
__device__ __forceinline__ void ab_prep(const AbPrepArgs& a, int t, float* smem) {
    int tid = threadIdx.x; asm volatile("" : "+v"(tid));
    const int lane = tid & 63, wid = tid >> 6;
    const bool samp = t >= NP; const int sb = t - NP, pos = t % SEQ, b = t / SEQ;
    float* sq = smem;
    float* sx = smem + 1536;
    float* scl = smem + 2048;
    const bf16* prow = a.PROJ + (size_t)t * ABN;
    for (int c = tid; c < 1536; c += NTH) {
        float acc = 0.f;
#pragma unroll
        for (int i = 0; i < 4; ++i) {
            float xv;
            if (i == 3) xv = bf2f(prow[C_QKV + c]);
            else if (samp) xv = a.st_gdn_conv[((size_t)sb * 3 + i) * 1536 + c];
            else xv = (pos - 3 + i >= 0) ? bf2f(a.PROJ[(size_t)(t - 3 + i) * ABN + C_QKV + c]) : 0.f;
            acc += a.gdn_conv_w[i * 1536 + c] * xv;
        }
        sq[c] = siluf_(acc);
    }
    {
        const int c = tid;
        float acc = a.lru_conv_b[c];
#pragma unroll
        for (int i = 0; i < 4; ++i) {
            float xv;
            if (i == 3) xv = bf2f(prow[C_XR + c]);
            else if (samp) xv = a.st_lru_conv[((size_t)sb * 3 + i) * 512 + c];
            else xv = (pos - 3 + i >= 0) ? bf2f(a.PROJ[(size_t)(t - 3 + i) * ABN + C_XR + c]) : 0.f;
            acc += a.lru_conv_w[i * 512 + c] * xv;
        }
        sx[c] = acc;
    }
    __syncthreads();
    {
        const int grp = wid;
        const float v0 = sq[grp * 128 + lane], v1 = sq[grp * 128 + 64 + lane];
        const float s = wave_sum(v0 * v0 + v1 * v1);
        if (lane == 0) scl[grp] = rsqrtf(s + 1e-6f) * (grp < 4 ? 0.08838834764831845f : 1.0f);
    }
    __syncthreads();
    for (int c = tid; c < 1536; c += NTH) a.QKV[(size_t)t * 1536 + c] = (c < 1024) ? sq[c] * scl[c >> 7] : sq[c];
    if (tid < 4) {
        const float a_raw = bf2f(prow[C_A + tid]), b_raw = bf2f(prow[C_B + tid]);
        a.G[(size_t)t * 4 + tid] = -expf(a.a_log[tid]) * softplusf_(a_raw + a.dt_bias[tid]);
        a.BETA[(size_t)t * 4 + tid] = sigmoidf_(b_raw);
    }
    if (!samp) {
        if (pos >= SEQ - 3) {
            const int row = pos - (SEQ - 3);
            for (int c = tid; c < 1536; c += NTH) a.p_gdn_conv[((size_t)b * 3 + row) * 1536 + c] = bf2f(prow[C_QKV + c]);
            a.p_lru_conv[((size_t)b * 3 + row) * 512 + tid] = bf2f(prow[C_XR + tid]);
        }
    } else {
        for (int c = tid; c < 1536; c += NTH) {
            a.s_gdn_conv[((size_t)sb * 3 + 0) * 1536 + c] = a.st_gdn_conv[((size_t)sb * 3 + 1) * 1536 + c];
            a.s_gdn_conv[((size_t)sb * 3 + 1) * 1536 + c] = a.st_gdn_conv[((size_t)sb * 3 + 2) * 1536 + c];
            a.s_gdn_conv[((size_t)sb * 3 + 2) * 1536 + c] = bf2f(prow[C_QKV + c]);
        }
        {
            const int c = tid;
            a.s_lru_conv[((size_t)sb * 3 + 0) * 512 + c] = a.st_lru_conv[((size_t)sb * 3 + 1) * 512 + c];
            a.s_lru_conv[((size_t)sb * 3 + 1) * 512 + c] = a.st_lru_conv[((size_t)sb * 3 + 2) * 512 + c];
            a.s_lru_conv[((size_t)sb * 3 + 2) * 512 + c] = bf2f(prow[C_XR + c]);
        }
    }
    {
        const int c = tid, n = c >> 6, d = c & 63;
        float r = a.b_r[c], ii = a.b_i[c];
#pragma unroll 4
        for (int cc = 0; cc < 64; ++cc) {
            const float xv = sx[n * 64 + cc];
            r += xv * a.w_r[((size_t)n * 64 + cc) * 64 + d];
            ii += xv * a.w_i[((size_t)n * 64 + cc) * 64 + d];
        }
        r = sigmoidf_(r); ii = sigmoidf_(ii);
        const float log_a = -8.0f * r * softplusf_(-a.lam[c]);
        a.LA[(size_t)t * 512 + c] = expf(log_a);
        a.LB[(size_t)t * 512 + c] = sqrtf(-expm1f(2.0f * log_a)) * (ii * sx[c]);
    }
}

__device__ __forceinline__ void gdn_scan(const float* __restrict__ QKV, const float* __restrict__ G, const float* __restrict__ BETA,
                                         const float* __restrict__ S0, float* __restrict__ O, float* __restrict__ Sout, int tok_base, int T,
                                         int sl, int h, int sq, float* smem) {
    int tid = threadIdx.x; asm volatile("" : "+v"(tid));
    const int dvl = tid & 31, kg = tid >> 5;
    const int dv = sl * 32 + dvl;
    float (*red1)[32] = (float (*)[32])smem;
    float (*red2)[32] = (float (*)[32])(smem + 512);
    float S[8];
#pragma unroll
    for (int i = 0; i < 8; ++i) S[i] = S0 ? S0[(((size_t)sq * 4 + h) * 128 + kg * 8 + i) * 128 + dv] : 0.f;
    float kk[8], qq[8], vv, g, be;
    {
        const size_t tok = (size_t)tok_base + (size_t)sq * T;
        const float* row = QKV + tok * 1536;
#pragma unroll
        for (int i = 0; i < 8; ++i) { kk[i] = row[512 + h * 128 + kg * 8 + i]; qq[i] = row[h * 128 + kg * 8 + i]; }
        vv = row[1024 + h * 128 + dv]; g = G[tok * 4 + h]; be = BETA[tok * 4 + h];
    }
    for (int t = 0; t < T; ++t) {
        const size_t tok = (size_t)tok_base + (size_t)sq * T + t;
        float nk[8], nq[8], nv = 0.f, ng = 0.f, nb = 0.f;
        if (t + 1 < T) {
            const float* row = QKV + (tok + 1) * 1536;
#pragma unroll
            for (int i = 0; i < 8; ++i) { nk[i] = row[512 + h * 128 + kg * 8 + i]; nq[i] = row[h * 128 + kg * 8 + i]; }
            nv = row[1024 + h * 128 + dv]; ng = G[(tok + 1) * 4 + h]; nb = BETA[(tok + 1) * 4 + h];
        } else {
#pragma unroll
            for (int i = 0; i < 8; ++i) { nk[i] = 0.f; nq[i] = 0.f; }
        }
        const float al = expf(g);
        float p = 0.f;
#pragma unroll
        for (int i = 0; i < 8; ++i) { S[i] *= al; p += S[i] * kk[i]; }
        red1[kg][dvl] = p;
        __syncthreads();
        float ks = 0.f;
#pragma unroll
        for (int j = 0; j < 16; ++j) ks += red1[j][dvl];
        const float vn = be * (vv - ks);
        float o = 0.f;
#pragma unroll
        for (int i = 0; i < 8; ++i) { S[i] += kk[i] * vn; o += S[i] * qq[i]; }
        red2[kg][dvl] = o;
        __syncthreads();
        if (kg == 0) {
            float os = 0.f;
#pragma unroll
            for (int j = 0; j < 16; ++j) os += red2[j][dvl];
            O[tok * 512 + h * 128 + dv] = os;
        }
#pragma unroll
        for (int i = 0; i < 8; ++i) { kk[i] = nk[i]; qq[i] = nq[i]; }
        vv = nv; g = ng; be = nb;
    }
#pragma unroll
    for (int i = 0; i < 8; ++i) Sout[(((size_t)sq * 4 + h) * 128 + kg * 8 + i) * 128 + dv] = S[i];
}


__device__ __forceinline__ void gdn_step_sample_w(const float* __restrict__ QKV, const float* __restrict__ G, const float* __restrict__ BETA, const float* __restrict__ S0,
                                                  float* __restrict__ O, float* __restrict__ Sout, int item, int lane) {
    const int sl = item & 7, h = (item >> 3) & 3, sb = item >> 5, fr = lane & 15, fq = lane >> 4;
    const size_t tok = (size_t)NP + sb;
    const float* row = QKV + tok * 1536;
    const size_t sbase = (((size_t)sb * 4 + h) * 128 + fq * 32) * 128 + sl * 16 + fr;
    float S[32], kk[32], qq[32];
#pragma unroll
    for (int i = 0; i < 32; ++i) S[i] = S0[sbase + (size_t)i * 128];
#pragma unroll
    for (int i4 = 0; i4 < 8; ++i4) { const f32x4 k4 = *(const f32x4*)(row + 512 + h * 128 + fq * 32 + i4 * 4), q4 = *(const f32x4*)(row + h * 128 + fq * 32 + i4 * 4);
        kk[i4 * 4 + 0] = k4.x; kk[i4 * 4 + 1] = k4.y; kk[i4 * 4 + 2] = k4.z; kk[i4 * 4 + 3] = k4.w; qq[i4 * 4 + 0] = q4.x; qq[i4 * 4 + 1] = q4.y; qq[i4 * 4 + 2] = q4.z; qq[i4 * 4 + 3] = q4.w; }
    const float vv = row[1024 + h * 128 + sl * 16 + fr], al = expf(G[tok * 4 + h]), be = BETA[tok * 4 + h];
    float p = 0.f;
#pragma unroll
    for (int i = 0; i < 32; ++i) { S[i] *= al; p += S[i] * kk[i]; }
    p += __shfl_xor(p, 16); p += __shfl_xor(p, 32);
    const float vn = be * (vv - p);
    float o = 0.f;
#pragma unroll
    for (int i = 0; i < 32; ++i) { S[i] += kk[i] * vn; o += S[i] * qq[i]; }
    o += __shfl_xor(o, 16); o += __shfl_xor(o, 32);
    if (fq == 0) O[tok * 512 + h * 128 + sl * 16 + fr] = o;
#pragma unroll
    for (int i = 0; i < 32; ++i) Sout[sbase + (size_t)i * 128] = S[i];
}

__device__ __forceinline__ void lru_scan(const float* __restrict__ LA, float* __restrict__ LB, const float* __restrict__ h0,
                                         float* __restrict__ hlast, int tok_base, int T, int nseq, int bx) {
    int tx_ = threadIdx.x; asm volatile("" : "+v"(tx_));
    const int idx = bx * NTH + tx_;
    if (idx >= nseq * 512) return;
    const int sq = idx / 512, c = idx % 512;
    float h = h0 ? h0[(size_t)sq * 512 + c] : 0.f;
    const size_t base = ((size_t)tok_base + (size_t)sq * T) * 512 + c;
#pragma unroll 8
    for (int t = 0; t < T; ++t) {
        const size_t o = base + (size_t)t * 512;
        h = LA[o] * h + LB[o];
        LB[o] = h;
    }
    hlast[(size_t)sq * 512 + c] = h;
}

__device__ __forceinline__ void ab_mix_w(const bf16* __restrict__ PROJ, const float* __restrict__ O, const float* __restrict__ H, const float* __restrict__ P, const float* __restrict__ CIN,
                                         const float* __restrict__ norm_w, bf16* __restrict__ MIX, int t, int lane) {
    const bf16* prow = PROJ + (size_t)t * ABN;
    {
        const int c0 = lane * 8;
        const f32x4 o0 = *(const f32x4*)(O + (size_t)t * 512 + c0), o1 = *(const f32x4*)(O + (size_t)t * 512 + c0 + 4);
        const v4u zb = *(const v4u*)(prow + C_Z + c0);
        const f32x4 w0 = *(const f32x4*)(norm_w + (c0 & 127)), w1 = *(const f32x4*)(norm_w + (c0 & 127) + 4);
        float ss = (o0.x * o0.x + o0.y * o0.y) + (o0.z * o0.z + o0.w * o0.w) + (o1.x * o1.x + o1.y * o1.y) + (o1.z * o1.z + o1.w * o1.w);
        ss += DPPF(ss, 0xB1, 0xf); ss += DPPF(ss, 0x4E, 0xf); ss += DPPF(ss, 0x141, 0xf); ss += DPPF(ss, 0x140, 0xf);
        const float sc = rsqrtf(ss * (1.0f / 128.0f) + 1e-6f);
        const float z[8] = {bflo(zb.x), bfhi(zb.x), bflo(zb.y), bfhi(zb.y), bflo(zb.z), bfhi(zb.z), bflo(zb.w), bfhi(zb.w)};
        const float ov[8] = {o0.x, o0.y, o0.z, o0.w, o1.x, o1.y, o1.z, o1.w}, wv[8] = {w0.x, w0.y, w0.z, w0.w, w1.x, w1.y, w1.z, w1.w};
        float r[8];
#pragma unroll
        for (int i = 0; i < 8; ++i) r[i] = ov[i] * sc * wv[i] * (z[i] * __frcp_rn(1.0f + __expf(-z[i])));
        v4u ob; ob.x = pk2(r[0], r[1]); ob.y = pk2(r[2], r[3]); ob.z = pk2(r[4], r[5]); ob.w = pk2(r[6], r[7]);
        *(v4u*)(MIX + (size_t)t * 1024 + c0) = ob;
    }
    {
        const int c0 = lane * 8;
        const v4u gb = *(const v4u*)(prow + C_GATE + c0);
        f32x4 h0 = *(const f32x4*)(H + (size_t)t * 512 + c0), h1 = *(const f32x4*)(H + (size_t)t * 512 + c0 + 4);
        if (t < NP) {
            const f32x4 p0 = *(const f32x4*)(P + (size_t)t * 512 + c0), p1 = *(const f32x4*)(P + (size_t)t * 512 + c0 + 4);
            const f32x4 ci0 = *(const f32x4*)(CIN + (size_t)(t >> 6) * 512 + c0), ci1 = *(const f32x4*)(CIN + (size_t)(t >> 6) * 512 + c0 + 4);
            h0 = h0 + p0 * ci0; h1 = h1 + p1 * ci1;
        }
        const float gv[8] = {bflo(gb.x), bfhi(gb.x), bflo(gb.y), bfhi(gb.y), bflo(gb.z), bfhi(gb.z), bflo(gb.w), bfhi(gb.w)}, hv[8] = {h0.x, h0.y, h0.z, h0.w, h1.x, h1.y, h1.z, h1.w};
        float r[8];
#pragma unroll
        for (int i = 0; i < 8; ++i) r[i] = geluf_(gv[i]) * hv[i];
        v4u ob; ob.x = pk2(r[0], r[1]); ob.y = pk2(r[2], r[3]); ob.z = pk2(r[4], r[5]); ob.w = pk2(r[6], r[7]);
        *(v4u*)(MIX + (size_t)t * 1024 + 512 + c0) = ob;
    }
}

template <bool XBF>
__device__ __forceinline__ void ln_res_w(const void* __restrict__ xrow_, const bf16* __restrict__ yrow, const float* __restrict__ g, const float* __restrict__ bta,
                                         bf16* __restrict__ obrow, int lane) {
    f32x4 v[4]; float s = 0.f;
#pragma unroll
    for (int j = 0; j < 4; ++j) {
        f32x4 x4;
        if (XBF) { const v2u xb = ((const v2u*)xrow_)[lane + 64 * j]; x4 = (f32x4){bflo(xb.x), bfhi(xb.x), bflo(xb.y), bfhi(xb.y)}; }
        else x4 = ((const f32x4*)xrow_)[lane + 64 * j];
        const v2u yb = ((const v2u*)yrow)[lane + 64 * j];
        const f32x4 y4 = (f32x4){bflo(yb.x), bfhi(yb.x), bflo(yb.y), bfhi(yb.y)}; v[j] = x4 * ALPHA + y4; s += (v[j].x + v[j].y) + (v[j].z + v[j].w); }
    const float mean = wave_sum(s) * (1.0f / 1024.0f); float q = 0.f;
#pragma unroll
    for (int j = 0; j < 4; ++j) { v[j] = v[j] - mean; q += (v[j].x * v[j].x + v[j].y * v[j].y) + (v[j].z * v[j].z + v[j].w * v[j].w); }
    const float rs = rsqrtf(wave_sum(q) * (1.0f / 1024.0f) + LN_EPS);
#pragma unroll
    for (int j = 0; j < 4; ++j) {
        const f32x4 g4 = ((const f32x4*)g)[lane + 64 * j], b4 = ((const f32x4*)bta)[lane + 64 * j];
        const f32x4 o = v[j] * rs * g4 + b4;
        v2u ob; ob.x = pk2(o.x, o.y); ob.y = pk2(o.z, o.w);
        ((v2u*)obrow)[lane + 64 * j] = ob;
    }
}

__device__ __forceinline__ void peer_topk(const bf16* __restrict__ Q, const float* __restrict__ keys, int* __restrict__ EXP, float* __restrict__ GATE,
                                          int tg, int h, float* smem) {
    const int tid = threadIdx.x, cn = tid & 255, c = cn >> 7, n = cn & 127, th = tid >> 8;
    float (*sq)[256] = (float (*)[256])smem;
    float (*ss)[257] = (float (*)[257])(smem + 32 * 256);
    float (*tvs)[2][16] = (float (*)[2][16])(smem + 32 * 256 + 32 * 257 + 32);
    int (*tis)[2][16] = (int (*)[2][16])(smem + 32 * 256 + 32 * 257 + 32 + 1024);
    for (int i = tid; i < 32 * 256; i += NTH) {
        const int tk = i >> 8, col = i & 255;
        sq[tk][col] = bf2f(Q[(size_t)(tg * 32 + tk) * 2048 + h * 256 + col]);
    }
    __syncthreads();
    float acc[16];
#pragma unroll
    for (int i = 0; i < 16; ++i) acc[i] = 0.f;
    const float* krow = keys + (((size_t)h * 2 + c) * 128 + n) * 128;
    for (int d4 = 0; d4 < 32; ++d4) {
        const float4 kv = *(const float4*)(krow + d4 * 4);
#pragma unroll
        for (int tk = 0; tk < 16; ++tk) {
            const float4 qv = *(const float4*)&sq[th * 16 + tk][c * 128 + d4 * 4];
            acc[tk] += qv.x * kv.x + qv.y * kv.y + qv.z * kv.z + qv.w * kv.w;
        }
    }
#pragma unroll
    for (int tk = 0; tk < 16; ++tk) ss[th * 16 + tk][cn] = acc[tk];
    __syncthreads();
    if (tid < 64) {
        const int tk = tid >> 1, cc = tid & 1;
        float tv[16]; int ti[16];
#pragma unroll
        for (int j = 0; j < 16; ++j) { tv[j] = -INFINITY; ti[j] = 0; }
        for (int nn = 0; nn < 128; ++nn) {
            float x = ss[tk][cc * 128 + nn]; int xi = nn;
#pragma unroll
            for (int j = 0; j < 16; ++j) {
                const bool gt = x > tv[j];
                const float tf = tv[j]; const int tj = ti[j];
                tv[j] = gt ? x : tf; ti[j] = gt ? xi : tj;
                x = gt ? tf : x; xi = gt ? tj : xi;
            }
        }
#pragma unroll
        for (int j = 0; j < 16; ++j) { tvs[tk][cc][j] = tv[j]; tis[tk][cc][j] = ti[j]; }
    }
    __syncthreads();
    if (tid < 32) {
        const int tk = tid;
        float bv[16]; int bi[16];
#pragma unroll
        for (int j = 0; j < 16; ++j) { bv[j] = -INFINITY; bi[j] = 0; }
        for (int i = 0; i < 16; ++i)
            for (int jj = 0; jj < 16; ++jj) {
                float x = tvs[tk][0][i] + tvs[tk][1][jj]; int xi = tis[tk][0][i] * 128 + tis[tk][1][jj];
#pragma unroll
                for (int j = 0; j < 16; ++j) {
                    const bool gt = x > bv[j];
                    const float tf = bv[j]; const int tj = bi[j];
                    bv[j] = gt ? x : tf; bi[j] = gt ? xi : tj;
                    x = gt ? tf : x; xi = gt ? tj : xi;
                }
            }
        float e[16], sum = 0.f;
#pragma unroll
        for (int j = 0; j < 16; ++j) { e[j] = expf(bv[j] - bv[0]); sum += e[j]; }
        const float inv = 1.0f / sum;
        const size_t o = (size_t)(tg * 32 + tk) * 128 + h * 16;
#pragma unroll
        for (int j = 0; j < 16; ++j) { EXP[o + j] = bi[j]; GATE[o + j] = e[j] * inv; }
    }
}

__device__ __forceinline__ void peer_expert(const float* __restrict__ X, const int* __restrict__ EXP, const float* __restrict__ GATE,
                                            const float* __restrict__ U, const float* __restrict__ V,
                                            const float* __restrict__ g, const float* __restrict__ bta, float* __restrict__ out, bf16* __restrict__ outb, int t, float* smem) {
    const int tid = threadIdx.x, lane = tid & 63, wid = tid >> 6;
    float (*accs)[1024] = (float (*)[1024])smem;
    float* sred = smem + 8192;
    const float4* xr = (const float4*)(X + (size_t)t * D);
    float4 xv[4];
#pragma unroll
    for (int j = 0; j < 4; ++j) xv[j] = xr[lane + 64 * j];
    float4 acc[4];
#pragma unroll
    for (int j = 0; j < 4; ++j) acc[j] = make_float4(0.f, 0.f, 0.f, 0.f);
    for (int e = 0; e < 16; ++e) {
        const int id = EXP[(size_t)t * 128 + wid * 16 + e];
        const float gt = GATE[(size_t)t * 128 + wid * 16 + e];
        const float4* ur = (const float4*)(U + (size_t)id * D);
        const float4* vr = (const float4*)(V + (size_t)id * D);
        float4 uv[4], vv[4];
#pragma unroll
        for (int j = 0; j < 4; ++j) { uv[j] = ur[lane + 64 * j]; vv[j] = vr[lane + 64 * j]; }
        float dot = 0.f;
#pragma unroll
        for (int j = 0; j < 4; ++j) dot += uv[j].x * xv[j].x + uv[j].y * xv[j].y + uv[j].z * xv[j].z + uv[j].w * xv[j].w;
        dot = wave_sum(dot);
        const float cf = gt * geluf_(dot);
#pragma unroll
        for (int j = 0; j < 4; ++j) { acc[j].x += cf * vv[j].x; acc[j].y += cf * vv[j].y; acc[j].z += cf * vv[j].z; acc[j].w += cf * vv[j].w; }
    }
#pragma unroll
    for (int j = 0; j < 4; ++j) *(float4*)&accs[wid][(lane + 64 * j) * 4] = acc[j];
    __syncthreads();
    float v[2];
#pragma unroll
    for (int i = 0; i < 2; ++i) {
        const int c = tid * 2 + i;
        float s = 0.f;
#pragma unroll
        for (int w = 0; w < 8; ++w) s += accs[w][c];
        v[i] = ALPHA * X[(size_t)t * D + c] + s;
    }
    float s = wave_sum(v[0] + v[1]);
    if (lane == 0) sred[wid] = s;
    __syncthreads();
    float mean = 0.f;
#pragma unroll
    for (int w = 0; w < 8; ++w) mean += sred[w];
    mean *= (1.0f / 1024.0f);
    __syncthreads();
    const float d0 = v[0] - mean, d1 = v[1] - mean;
    float q = wave_sum(d0 * d0 + d1 * d1);
    if (lane == 0) sred[wid] = q;
    __syncthreads();
    float var = 0.f;
#pragma unroll
    for (int w = 0; w < 8; ++w) var += sred[w];
    const float rs = rsqrtf(var * (1.0f / 1024.0f) + LN_EPS);
    const float o0 = d0 * rs * g[tid * 2] + bta[tid * 2], o1 = d1 * rs * g[tid * 2 + 1] + bta[tid * 2 + 1];
    *(float2*)(out + (size_t)t * D + tid * 2) = make_float2(o0, o1);
    if (outb) *(unsigned*)(outb + (size_t)t * D + tid * 2) = pk2(o0, o1);
}


typedef __bf16 bf16x2_t __attribute__((ext_vector_type(2)));
__device__ __forceinline__ float dot2bf(unsigned w, unsigned x, float acc) { return __builtin_amdgcn_fdot2_f32_bf16(__builtin_bit_cast(bf16x2_t, w), __builtin_bit_cast(bf16x2_t, x), acc, false); }
typedef float f32x2_t __attribute__((ext_vector_type(2)));
__device__ __forceinline__ void row_to_fp8(const float* __restrict__ xrow, unsigned char* __restrict__ orow, float* __restrict__ scale, int lane) {
    f32x4 v[4]; float am = 0.f;
#pragma unroll
    for (int j = 0; j < 4; ++j) { v[j] = *(const f32x4*)(xrow + lane * 16 + j * 4); am = fmaxf(am, fmaxf(fmaxf(fabsf(v[j].x), fabsf(v[j].y)), fmaxf(fabsf(v[j].z), fabsf(v[j].w)))); }
    am = wave_max(am);
    const float s = am > 0.f ? am * (1.0f / 448.0f) : 1.0f, inv = 1.0f / s;
    v4u o;
    unsigned w;
    w = 0u; w = __builtin_amdgcn_cvt_pk_fp8_f32(v[0].x * inv, v[0].y * inv, w, false); w = __builtin_amdgcn_cvt_pk_fp8_f32(v[0].z * inv, v[0].w * inv, w, true); o.x = w;
    w = 0u; w = __builtin_amdgcn_cvt_pk_fp8_f32(v[1].x * inv, v[1].y * inv, w, false); w = __builtin_amdgcn_cvt_pk_fp8_f32(v[1].z * inv, v[1].w * inv, w, true); o.y = w;
    w = 0u; w = __builtin_amdgcn_cvt_pk_fp8_f32(v[2].x * inv, v[2].y * inv, w, false); w = __builtin_amdgcn_cvt_pk_fp8_f32(v[2].z * inv, v[2].w * inv, w, true); o.z = w;
    w = 0u; w = __builtin_amdgcn_cvt_pk_fp8_f32(v[3].x * inv, v[3].y * inv, w, false); w = __builtin_amdgcn_cvt_pk_fp8_f32(v[3].z * inv, v[3].w * inv, w, true); o.w = w;
    *(v4u*)(orow + lane * 16) = o;
    if (lane == 0) *scale = s;
}
#define PE_LOAD(UB, VB, grp) do { _Pragma("unroll") for (int i_ = 0; i_ < 4; ++i_) { const int e_ = (grp) * 4 + i_; \
        const int id_ = __builtin_amdgcn_readlane(e_ < 64 ? id0 : id1, e_ & 63); \
        const unsigned so_ = (unsigned)id_ * 1024u; \
        UB[i_] = __builtin_amdgcn_raw_buffer_load_b128(ursrc, voff, so_, 0); VB[i_] = __builtin_amdgcn_raw_buffer_load_b128(vrsrc, voff, so_, 0); } } while (0)
#define PE_DOT4(w, k) do { const f32x2_t l_ = __builtin_amdgcn_cvt_pk_f32_fp8((w), false), h_ = __builtin_amdgcn_cvt_pk_f32_fp8((w), true); \
        a_ += l_.x * xv[(k) * 4 + 0]; b_ += l_.y * xv[(k) * 4 + 1]; a_ += h_.x * xv[(k) * 4 + 2]; b_ += h_.y * xv[(k) * 4 + 3]; } while (0)
#define PE_AXPY4(w, k) do { const f32x2_t l_ = __builtin_amdgcn_cvt_pk_f32_fp8((w), false), h_ = __builtin_amdgcn_cvt_pk_f32_fp8((w), true); \
        acc[(k) * 4 + 0] += cf_ * l_.x; acc[(k) * 4 + 1] += cf_ * l_.y; acc[(k) * 4 + 2] += cf_ * h_.x; acc[(k) * 4 + 3] += cf_ * h_.y; } while (0)
#define PE_COMP(UB, VB, grp) do { float d_[4]; \
        _Pragma("unroll") for (int i_ = 0; i_ < 4; ++i_) { float a_ = 0.f, b_ = 0.f; PE_DOT4(UB[i_].x, 0); PE_DOT4(UB[i_].y, 1); PE_DOT4(UB[i_].z, 2); PE_DOT4(UB[i_].w, 3); d_[i_] = a_ + b_; } \
          \
        float s0_ = hi32 ? d_[2] : d_[0], t0_ = hi32 ? d_[0] : d_[2]; s0_ += __shfl_xor(t0_, 32); \
        float s1_ = hi32 ? d_[3] : d_[1], t1_ = hi32 ? d_[1] : d_[3]; s1_ += __shfl_xor(t1_, 32); \
        float r_ = hi16 ? s1_ : s0_, t2_ = hi16 ? s0_ : s1_; r_ += __shfl_xor(t2_, 16); \
        r_ += __shfl_xor(r_, 8); r_ += __shfl_xor(r_, 4); r_ += __shfl_xor(r_, 2); r_ += __shfl_xor(r_, 1); \
          \
        const int esel_ = (grp) * 4 + (lane >> 4); \
        const float su_ = __shfl(esel_ < 64 ? su0 : su1, esel_ & 63), gv_ = __shfl(esel_ < 64 ? gs0 : gs1, esel_ & 63); \
        const float cfl_ = geluf_(r_ * su_) * gv_; \
        _Pragma("unroll") for (int i_ = 0; i_ < 4; ++i_) { \
            const float cf_ = __uint_as_float(__builtin_amdgcn_readlane(__float_as_uint(cfl_), 16 * i_)); \
            PE_AXPY4(VB[i_].x, 0); PE_AXPY4(VB[i_].y, 1); PE_AXPY4(VB[i_].z, 2); PE_AXPY4(VB[i_].w, 3); } } while (0)
__device__ __forceinline__ void peer_expert_w(const float* __restrict__ xrow, const int* __restrict__ exr, const float* __restrict__ gar,
                                              const unsigned char* __restrict__ U, const unsigned char* __restrict__ V, const float* __restrict__ SU, const float* __restrict__ SV,
                                              const float* __restrict__ g, const float* __restrict__ bta, float* __restrict__ orow, bf16* __restrict__ obrow, int lane) {
    const bool hi32 = (lane & 32) != 0, hi16 = (lane & 16) != 0;
    const __amdgpu_buffer_rsrc_t ursrc = __builtin_amdgcn_make_buffer_rsrc((void*)U, 0, 16384 * 1024, 0x00020000);
    const __amdgpu_buffer_rsrc_t vrsrc = __builtin_amdgcn_make_buffer_rsrc((void*)V, 0, 16384 * 1024, 0x00020000);
    const int voff = lane * 16;
    float xv[16];
#pragma unroll
    for (int j = 0; j < 4; ++j) { const f32x4 t = *(const f32x4*)(xrow + lane * 16 + j * 4); xv[j * 4 + 0] = t.x; xv[j * 4 + 1] = t.y; xv[j * 4 + 2] = t.z; xv[j * 4 + 3] = t.w; }
    const int id0 = exr[lane], id1 = exr[64 + lane];
    const float su0 = SU[id0], su1 = SU[id1];
    const float gs0 = gar[lane] * SV[id0], gs1 = gar[64 + lane] * SV[id1];
    float acc[16];
#pragma unroll
    for (int i = 0; i < 16; ++i) acc[i] = 0.f;
    v4u ua[4], va[4], ub[4], vb[4];
    PE_LOAD(ua, va, 0);
#pragma unroll 1
    for (int grp = 0; grp < 32; grp += 2) {
        PE_LOAD(ub, vb, grp + 1);
        PE_COMP(ua, va, grp);
        if (grp + 2 < 32) PE_LOAD(ua, va, grp + 2);
        PE_COMP(ub, vb, grp + 1);
    }
    float v[16]; float s = 0.f;
#pragma unroll
    for (int i = 0; i < 16; ++i) { v[i] = ALPHA * xv[i] + acc[i]; s += v[i]; }
    const float mean = wave_sum(s) * (1.0f / 1024.0f); float q = 0.f;
#pragma unroll
    for (int i = 0; i < 16; ++i) { v[i] -= mean; q += v[i] * v[i]; }
    const float rs = rsqrtf(wave_sum(q) * (1.0f / 1024.0f) + LN_EPS);
    float o[16];
#pragma unroll
    for (int j = 0; j < 4; ++j) {
        const f32x4 g4 = *(const f32x4*)(g + lane * 16 + j * 4), b4 = *(const f32x4*)(bta + lane * 16 + j * 4);
        o[j * 4 + 0] = v[j * 4 + 0] * rs * g4.x + b4.x; o[j * 4 + 1] = v[j * 4 + 1] * rs * g4.y + b4.y; o[j * 4 + 2] = v[j * 4 + 2] * rs * g4.z + b4.z; o[j * 4 + 3] = v[j * 4 + 3] * rs * g4.w + b4.w;
        *(f32x4*)(orow + lane * 16 + j * 4) = (f32x4){o[j * 4 + 0], o[j * 4 + 1], o[j * 4 + 2], o[j * 4 + 3]};
    }
    if (obrow) {
        v4u w0, w1; w0.x = pk2(o[0], o[1]); w0.y = pk2(o[2], o[3]); w0.z = pk2(o[4], o[5]); w0.w = pk2(o[6], o[7]); w1.x = pk2(o[8], o[9]); w1.y = pk2(o[10], o[11]); w1.z = pk2(o[12], o[13]); w1.w = pk2(o[14], o[15]);
        *(v4u*)(obrow + lane * 16) = w0; *(v4u*)(obrow + lane * 16 + 8) = w1;
    }
}


__device__ __forceinline__ void peer_expert_blk(const float* __restrict__ xrow, const int* __restrict__ exr, const float* __restrict__ gar,
                                                const unsigned char* __restrict__ U, const unsigned char* __restrict__ V, const float* __restrict__ SU, const float* __restrict__ SV,
                                                const float* __restrict__ g, const float* __restrict__ bta, float* __restrict__ orow, bf16* __restrict__ obrow, int lane, int wave, float* smem) {
    const bool hi32 = (lane & 32) != 0, hi16 = (lane & 16) != 0;
    const __amdgpu_buffer_rsrc_t ursrc = __builtin_amdgcn_make_buffer_rsrc((void*)U, 0, 16384 * 1024, 0x00020000);
    const __amdgpu_buffer_rsrc_t vrsrc = __builtin_amdgcn_make_buffer_rsrc((void*)V, 0, 16384 * 1024, 0x00020000);
    const int voff = lane * 16;
    float xv[16];
#pragma unroll
    for (int j = 0; j < 4; ++j) { const f32x4 t = *(const f32x4*)(xrow + lane * 16 + j * 4); xv[j * 4 + 0] = t.x; xv[j * 4 + 1] = t.y; xv[j * 4 + 2] = t.z; xv[j * 4 + 3] = t.w; }
    const int id0 = exr[lane], id1 = exr[64 + lane];
    const float su0 = SU[id0], su1 = SU[id1];
    const float gs0 = gar[lane] * SV[id0], gs1 = gar[64 + lane] * SV[id1];
    float acc[16];
#pragma unroll
    for (int i = 0; i < 16; ++i) acc[i] = 0.f;
    v4u ua[4], va[4], ub[4], vb[4];
    const int g0 = wave * 4;
    PE_LOAD(ua, va, g0); PE_LOAD(ub, vb, g0 + 1);
    PE_COMP(ua, va, g0); PE_LOAD(ua, va, g0 + 2);
    PE_COMP(ub, vb, g0 + 1); PE_LOAD(ub, vb, g0 + 3);
    PE_COMP(ua, va, g0 + 2);
    PE_COMP(ub, vb, g0 + 3);
    float* accs = smem;
    float* sred = smem + 8192;
#pragma unroll
    for (int j = 0; j < 4; ++j) *(f32x4*)(accs + wave * 1024 + lane * 16 + j * 4) = (f32x4){acc[j * 4 + 0], acc[j * 4 + 1], acc[j * 4 + 2], acc[j * 4 + 3]};
    __syncthreads();
    const int tid = wave * 64 + lane;
    float v0 = ALPHA * xrow[tid * 2], v1 = ALPHA * xrow[tid * 2 + 1];
#pragma unroll
    for (int w = 0; w < 8; ++w) { v0 += accs[w * 1024 + tid * 2]; v1 += accs[w * 1024 + tid * 2 + 1]; }
    const float s = wave_sum(v0 + v1);
    if (lane == 0) sred[wave] = s;
    __syncthreads();
    float mean = 0.f;
#pragma unroll
    for (int w = 0; w < 8; ++w) mean += sred[w];
    mean *= (1.0f / 1024.0f);
    __syncthreads();
    const float d0 = v0 - mean, d1 = v1 - mean;
    const float q = wave_sum(d0 * d0 + d1 * d1);
    if (lane == 0) sred[wave] = q;
    __syncthreads();
    float var = 0.f;
#pragma unroll
    for (int w = 0; w < 8; ++w) var += sred[w];
    const float rs = rsqrtf(var * (1.0f / 1024.0f) + LN_EPS);
    const float o0 = d0 * rs * g[tid * 2] + bta[tid * 2], o1 = d1 * rs * g[tid * 2 + 1] + bta[tid * 2 + 1];
    *(float2*)(orow + tid * 2) = make_float2(o0, o1);
    if (obrow) *(unsigned*)(obrow + tid * 2) = pk2(o0, o1);
    __syncthreads();
}

__device__ __forceinline__ void row_to_fp8_sliced(const float* __restrict__ xrow, unsigned char* __restrict__ tab, int r, float* __restrict__ scale, int lane) {
    f32x4 v[4]; float am = 0.f;
#pragma unroll
    for (int j = 0; j < 4; ++j) { v[j] = *(const f32x4*)(xrow + lane * 16 + j * 4); am = fmaxf(am, fmaxf(fmaxf(fabsf(v[j].x), fabsf(v[j].y)), fmaxf(fabsf(v[j].z), fabsf(v[j].w)))); }
    am = wave_max(am);
    const float s = am > 0.f ? am * (1.0f / 448.0f) : 1.0f, inv = 1.0f / s;
    v4u o; unsigned w;
    w = 0u; w = __builtin_amdgcn_cvt_pk_fp8_f32(v[0].x * inv, v[0].y * inv, w, false); w = __builtin_amdgcn_cvt_pk_fp8_f32(v[0].z * inv, v[0].w * inv, w, true); o.x = w;
    w = 0u; w = __builtin_amdgcn_cvt_pk_fp8_f32(v[1].x * inv, v[1].y * inv, w, false); w = __builtin_amdgcn_cvt_pk_fp8_f32(v[1].z * inv, v[1].w * inv, w, true); o.y = w;
    w = 0u; w = __builtin_amdgcn_cvt_pk_fp8_f32(v[2].x * inv, v[2].y * inv, w, false); w = __builtin_amdgcn_cvt_pk_fp8_f32(v[2].z * inv, v[2].w * inv, w, true); o.z = w;
    w = 0u; w = __builtin_amdgcn_cvt_pk_fp8_f32(v[3].x * inv, v[3].y * inv, w, false); w = __builtin_amdgcn_cvt_pk_fp8_f32(v[3].z * inv, v[3].w * inv, w, true); o.w = w;
    *(v4u*)(tab + ((size_t)(lane >> 3) * 16384 + r) * 128 + (lane & 7) * 16) = o;
    if (lane == 0) *scale = s;
}
__device__ __forceinline__ void row_to_i8_sliced(const float* __restrict__ xrow, unsigned char* __restrict__ tab, int r, float* __restrict__ scale, int lane) {
    f32x4 v[4]; float am = 0.f;
#pragma unroll
    for (int j = 0; j < 4; ++j) { v[j] = *(const f32x4*)(xrow + lane * 16 + j * 4); am = fmaxf(am, fmaxf(fmaxf(fabsf(v[j].x), fabsf(v[j].y)), fmaxf(fabsf(v[j].z), fabsf(v[j].w)))); }
    am = wave_max(am);
    const float s = am > 0.f ? am * (1.0f / 127.0f) : 1.0f, inv = 1.0f / s;
    v4u o;
#define I8PK(q_) (((unsigned)(int)rintf((q_).x * inv) & 0xffu) | (((unsigned)(int)rintf((q_).y * inv) & 0xffu) << 8) | (((unsigned)(int)rintf((q_).z * inv) & 0xffu) << 16) | (((unsigned)(int)rintf((q_).w * inv) & 0xffu) << 24))
    o.x = I8PK(v[0]); o.y = I8PK(v[1]); o.z = I8PK(v[2]); o.w = I8PK(v[3]);
    *(v4u*)(tab + ((size_t)(lane >> 3) * 16384 + r) * 128 + (lane & 7) * 16) = o;
    if (lane == 0) *scale = s;
}
__device__ __forceinline__ void peer_u_pass(const bf16* __restrict__ xrow, const int* __restrict__ exr, const unsigned char* __restrict__ U8x, float* __restrict__ pd, int x, int lane) {
    const int e8 = lane >> 3, c = lane & 7;
    f32x2_t xp[8];
#pragma unroll
    for (int j = 0; j < 2; ++j) { const v4u t = *(const v4u*)(xrow + x * 128 + c * 16 + j * 8);
        xp[j * 4 + 0] = (f32x2_t){bflo(t.x), bfhi(t.x)}; xp[j * 4 + 1] = (f32x2_t){bflo(t.y), bfhi(t.y)}; xp[j * 4 + 2] = (f32x2_t){bflo(t.z), bfhi(t.z)}; xp[j * 4 + 3] = (f32x2_t){bflo(t.w), bfhi(t.w)}; }
    const __amdgpu_buffer_rsrc_t ursrc = __builtin_amdgcn_make_buffer_rsrc((void*)U8x, 0, 16384 * 128, 0x00020000);
    v4u wa[8], wb[8];
    float d[16];
    int ids[16];
#pragma unroll
    for (int j = 0; j < 4; ++j) { const v4u t = *(const v4u*)(exr + e8 * 16 + j * 4); ids[j * 4 + 0] = (int)t.x; ids[j * 4 + 1] = (int)t.y; ids[j * 4 + 2] = (int)t.z; ids[j * 4 + 3] = (int)t.w; }
#pragma unroll
    for (int g = 0; g < 8; ++g) wa[g] = __builtin_amdgcn_raw_buffer_load_b128(ursrc, ids[g] * 128 + c * 16, 0, 0);
#pragma unroll
    for (int g = 0; g < 8; ++g) wb[g] = __builtin_amdgcn_raw_buffer_load_b128(ursrc, ids[8 + g] * 128 + c * 16, 0, 0);
#define PU_DOT1(w_, k_) do { a_ = __builtin_elementwise_fma(__builtin_amdgcn_cvt_pk_f32_fp8((w_), false), xp[(k_) * 2], a_); a_ = __builtin_elementwise_fma(__builtin_amdgcn_cvt_pk_f32_fp8((w_), true), xp[(k_) * 2 + 1], a_); } while (0)
#pragma unroll
    for (int g = 0; g < 8; ++g) { f32x2_t a_ = (f32x2_t){0.f, 0.f}; PU_DOT1(wa[g].x, 0); PU_DOT1(wa[g].y, 1); PU_DOT1(wa[g].z, 2); PU_DOT1(wa[g].w, 3); d[g] = a_.x + a_.y; }
#pragma unroll
    for (int g = 0; g < 8; ++g) { f32x2_t a_ = (f32x2_t){0.f, 0.f}; PU_DOT1(wb[g].x, 0); PU_DOT1(wb[g].y, 1); PU_DOT1(wb[g].z, 2); PU_DOT1(wb[g].w, 3); d[8 + g] = a_.x + a_.y; }
#pragma unroll
    for (int g = 0; g < 16; ++g) { d[g] += DPPF(d[g], 0xB1, 0xf); d[g] += DPPF(d[g], 0x4E, 0xf); d[g] += DPPF(d[g], 0x141, 0xf); }
    if (c == 0) {
#pragma unroll
        for (int j = 0; j < 4; ++j) *(f32x4*)(pd + e8 * 16 + j * 4) = (f32x4){d[j * 4 + 0], d[j * 4 + 1], d[j * 4 + 2], d[j * 4 + 3]};
    }
}
#define PUL_IDS(I, k_) do { const int t_ = ((tg0 + ((k_) < nit ? (k_) : nit - 1) * tgstep) * 8 + wave); _Pragma("unroll") for (int j = 0; j < 4; ++j) I[j] = *(const v4u*)(EXPp + (size_t)t_ * 128 + e8 * 16 + j * 4); } while (0)
#define PUL_ROWS(R, X, I, k_) do { const int t_ = ((tg0 + ((k_) < nit ? (k_) : nit - 1) * tgstep) * 8 + wave); \
        X[0] = *(const v4u*)(XBp + (size_t)t_ * D + x * 128 + c * 16); X[1] = *(const v4u*)(XBp + (size_t)t_ * D + x * 128 + c * 16 + 8); \
        _Pragma("unroll") for (int j = 0; j < 4; ++j) { R[j * 4 + 0] = __builtin_amdgcn_raw_buffer_load_b128(ursrc, (int)I[j].x * 128 + c * 16, 0, 0); R[j * 4 + 1] = __builtin_amdgcn_raw_buffer_load_b128(ursrc, (int)I[j].y * 128 + c * 16, 0, 0); \
            R[j * 4 + 2] = __builtin_amdgcn_raw_buffer_load_b128(ursrc, (int)I[j].z * 128 + c * 16, 0, 0); R[j * 4 + 3] = __builtin_amdgcn_raw_buffer_load_b128(ursrc, (int)I[j].w * 128 + c * 16, 0, 0); } } while (0)
#define PUL_COMP(R, X, k_) do { float xf_[16]; \
        _Pragma("unroll") for (int j = 0; j < 2; ++j) { xf_[j * 8 + 0] = bflo(X[j].x); xf_[j * 8 + 1] = bfhi(X[j].x); xf_[j * 8 + 2] = bflo(X[j].y); xf_[j * 8 + 3] = bfhi(X[j].y); xf_[j * 8 + 4] = bflo(X[j].z); xf_[j * 8 + 5] = bfhi(X[j].z); xf_[j * 8 + 6] = bflo(X[j].w); xf_[j * 8 + 7] = bfhi(X[j].w); } \
          \
        float am_ = 0.f; _Pragma("unroll") for (int i = 0; i < 16; ++i) am_ = fmaxf(am_, fabsf(xf_[i])); \
        am_ = fmaxf(am_, DPPF(am_, 0xB1, 0xf)); am_ = fmaxf(am_, DPPF(am_, 0x4E, 0xf)); am_ = fmaxf(am_, DPPF(am_, 0x141, 0xf)); \
        const float sx_ = am_ > 0.f ? am_ * (1.0f / 127.0f) : 1.0f, ix_ = 1.0f / sx_; \
        int xq_[4]; \
        _Pragma("unroll") for (int j = 0; j < 4; ++j) xq_[j] = (int)(((unsigned)(int)rintf(xf_[j * 4 + 0] * ix_) & 0xffu) | (((unsigned)(int)rintf(xf_[j * 4 + 1] * ix_) & 0xffu) << 8) | (((unsigned)(int)rintf(xf_[j * 4 + 2] * ix_) & 0xffu) << 16) | (((unsigned)(int)rintf(xf_[j * 4 + 3] * ix_) & 0xffu) << 24)); \
        float d[16]; \
        _Pragma("unroll") for (int g = 0; g < 16; ++g) { int a_ = __builtin_amdgcn_sdot4((int)R[g].x, xq_[0], 0, false); a_ = __builtin_amdgcn_sdot4((int)R[g].y, xq_[1], a_, false); a_ = __builtin_amdgcn_sdot4((int)R[g].z, xq_[2], a_, false); a_ = __builtin_amdgcn_sdot4((int)R[g].w, xq_[3], a_, false); d[g] = (float)a_; } \
        _Pragma("unroll") for (int g = 0; g < 16; ++g) { d[g] += DPPF(d[g], 0xB1, 0xf); d[g] += DPPF(d[g], 0x4E, 0xf); d[g] += DPPF(d[g], 0x141, 0xf); d[g] *= sx_; } \
        if (c == 0 && (k_) < nit) { float* pd_ = PDx + (size_t)((tg0 + (k_) * tgstep) * 8 + wave) * 128 + e8 * 16; \
            _Pragma("unroll") for (int j = 0; j < 4; ++j) *(f32x4*)(pd_ + j * 4) = (f32x4){d[j * 4 + 0], d[j * 4 + 1], d[j * 4 + 2], d[j * 4 + 3]}; } } while (0)
__device__ __forceinline__ void peer_u_loop(const bf16* __restrict__ XBp, const int* __restrict__ EXPp, const unsigned char* __restrict__ U8x, float* __restrict__ PDx, int x, int tg0, int tgstep, int nit, int wave, int lane) {
    const int e8 = lane >> 3, c = lane & 7;
    const __amdgpu_buffer_rsrc_t ursrc = __builtin_amdgcn_make_buffer_rsrc((void*)U8x, 0, 16384 * 128, 0x00020000);
    v4u ra[16], rb[16], xa[2], xb[2], i0[4], i1[4];
    PUL_IDS(i0, 0);
    PUL_ROWS(ra, xa, i0, 0);
    PUL_IDS(i1, 1);
#pragma unroll 1
    for (int k = 0; k < nit; k += 2) {
        PUL_ROWS(rb, xb, i1, k + 1);
        PUL_IDS(i0, k + 2);
        PUL_COMP(ra, xa, k);
        PUL_ROWS(ra, xa, i0, k + 2);
        PUL_IDS(i1, k + 3);
        PUL_COMP(rb, xb, k + 1);
    }
}
#define PV_LOAD(VB, grp) do { _Pragma("unroll") for (int i_ = 0; i_ < 4; ++i_) { const int e_ = (grp) * 4 + i_; \
        const int id_ = __builtin_amdgcn_readlane(e_ < 64 ? id0 : id1, e_ & 63); \
        VB[i_] = __builtin_amdgcn_raw_buffer_load_b128(vrsrc, voff, (unsigned)id_ * 1024u, 0); } } while (0)
#define PV_COMP(VB, grp) do { _Pragma("unroll") for (int i_ = 0; i_ < 4; ++i_) { const int e_ = (grp) * 4 + i_; \
        const float cf_ = __uint_as_float(__builtin_amdgcn_readlane(__float_as_uint(e_ < 64 ? cf0 : cf1), e_ & 63)); \
        PE_AXPY4(VB[i_].x, 0); PE_AXPY4(VB[i_].y, 1); PE_AXPY4(VB[i_].z, 2); PE_AXPY4(VB[i_].w, 3); } } while (0)
#define PV_COEFS() \
    const int id0 = exr[lane], id1 = exr[64 + lane]; \
    float dot0 = 0.f, dot1 = 0.f; \
    { const int p0 = lane, p1 = 64 + lane;        \
      _Pragma("unroll") for (int x_ = 0; x_ < 8; ++x_) { dot0 += pdt[(size_t)x_ * NT * 128 + p0]; dot1 += pdt[(size_t)x_ * NT * 128 + p1]; } } \
    const float cf0 = gar[lane] * SV[id0] * geluf_(SU[id0] * dot0), cf1 = gar[64 + lane] * SV[id1] * geluf_(SU[id1] * dot1);
__device__ __forceinline__ void peer_v_w(const float* __restrict__ xrow, const int* __restrict__ exr, const float* __restrict__ gar, const float* __restrict__ pdt,
                                         const unsigned char* __restrict__ V, const float* __restrict__ SU, const float* __restrict__ SV,
                                         const float* __restrict__ g, const float* __restrict__ bta, float* __restrict__ orow, bf16* __restrict__ obrow, int lane) {
    const __amdgpu_buffer_rsrc_t vrsrc = __builtin_amdgcn_make_buffer_rsrc((void*)V, 0, 16384 * 1024, 0x00020000);
    const int voff = lane * 16;
    PV_COEFS()
    float acc[16];
#pragma unroll
    for (int i = 0; i < 16; ++i) acc[i] = 0.f;
    v4u va[4], vb[4], vc[4];
    PV_LOAD(va, 0); PV_LOAD(vb, 1);
#pragma unroll 1
    for (int grp = 0; grp < 30; grp += 3) {
        PV_LOAD(vc, grp + 2);
        PV_COMP(va, grp);
        PV_LOAD(va, grp + 3);
        PV_COMP(vb, grp + 1);
        PV_LOAD(vb, grp + 4);
        PV_COMP(vc, grp + 2);
    }
    PV_COMP(va, 30); PV_COMP(vb, 31);
    float xv[16];
#pragma unroll
    for (int j = 0; j < 4; ++j) { const f32x4 t = *(const f32x4*)(xrow + lane * 16 + j * 4); xv[j * 4 + 0] = t.x; xv[j * 4 + 1] = t.y; xv[j * 4 + 2] = t.z; xv[j * 4 + 3] = t.w; }
    float v[16]; float s = 0.f;
#pragma unroll
    for (int i = 0; i < 16; ++i) { v[i] = ALPHA * xv[i] + acc[i]; s += v[i]; }
    const float mean = wave_sum(s) * (1.0f / 1024.0f); float q = 0.f;
#pragma unroll
    for (int i = 0; i < 16; ++i) { v[i] -= mean; q += v[i] * v[i]; }
    const float rs = rsqrtf(wave_sum(q) * (1.0f / 1024.0f) + LN_EPS);
    float o[16];
#pragma unroll
    for (int j = 0; j < 4; ++j) {
        const f32x4 g4 = *(const f32x4*)(g + lane * 16 + j * 4), b4 = *(const f32x4*)(bta + lane * 16 + j * 4);
        o[j * 4 + 0] = v[j * 4 + 0] * rs * g4.x + b4.x; o[j * 4 + 1] = v[j * 4 + 1] * rs * g4.y + b4.y; o[j * 4 + 2] = v[j * 4 + 2] * rs * g4.z + b4.z; o[j * 4 + 3] = v[j * 4 + 3] * rs * g4.w + b4.w;
        *(f32x4*)(orow + lane * 16 + j * 4) = (f32x4){o[j * 4 + 0], o[j * 4 + 1], o[j * 4 + 2], o[j * 4 + 3]};
    }
    if (obrow) {
        v4u w0, w1; w0.x = pk2(o[0], o[1]); w0.y = pk2(o[2], o[3]); w0.z = pk2(o[4], o[5]); w0.w = pk2(o[6], o[7]); w1.x = pk2(o[8], o[9]); w1.y = pk2(o[10], o[11]); w1.z = pk2(o[12], o[13]); w1.w = pk2(o[14], o[15]);
        *(v4u*)(obrow + lane * 16) = w0; *(v4u*)(obrow + lane * 16 + 8) = w1;
    }
}
__device__ __forceinline__ void peer_v_blk(const float* __restrict__ xrow, const int* __restrict__ exr, const float* __restrict__ gar, const float* __restrict__ pdt,
                                           const unsigned char* __restrict__ V, const float* __restrict__ SU, const float* __restrict__ SV,
                                           const float* __restrict__ g, const float* __restrict__ bta, float* __restrict__ orow, bf16* __restrict__ obrow, int lane, int wave, float* smem) {
    const __amdgpu_buffer_rsrc_t vrsrc = __builtin_amdgcn_make_buffer_rsrc((void*)V, 0, 16384 * 1024, 0x00020000);
    const int voff = lane * 16;
    PV_COEFS()
    float acc[16];
#pragma unroll
    for (int i = 0; i < 16; ++i) acc[i] = 0.f;
    v4u va[4], vb[4], vc[4], vd[4];
    PV_LOAD(va, wave * 4); PV_LOAD(vb, wave * 4 + 1); PV_LOAD(vc, wave * 4 + 2); PV_LOAD(vd, wave * 4 + 3);
    PV_COMP(va, wave * 4); PV_COMP(vb, wave * 4 + 1); PV_COMP(vc, wave * 4 + 2); PV_COMP(vd, wave * 4 + 3);
    float* accs = smem;
    float* sred = smem + 8192;
#pragma unroll
    for (int j = 0; j < 4; ++j) *(f32x4*)(accs + wave * 1024 + lane * 16 + j * 4) = (f32x4){acc[j * 4 + 0], acc[j * 4 + 1], acc[j * 4 + 2], acc[j * 4 + 3]};
    __syncthreads();
    const int tid = wave * 64 + lane;
    float v0 = ALPHA * xrow[tid * 2], v1 = ALPHA * xrow[tid * 2 + 1];
#pragma unroll
    for (int w = 0; w < 8; ++w) { v0 += accs[w * 1024 + tid * 2]; v1 += accs[w * 1024 + tid * 2 + 1]; }
    const float s = wave_sum(v0 + v1);
    if (lane == 0) sred[wave] = s;
    __syncthreads();
    float mean = 0.f;
#pragma unroll
    for (int w = 0; w < 8; ++w) mean += sred[w];
    mean *= (1.0f / 1024.0f);
    __syncthreads();
    const float d0 = v0 - mean, d1 = v1 - mean;
    const float q = wave_sum(d0 * d0 + d1 * d1);
    if (lane == 0) sred[wave] = q;
    __syncthreads();
    float var = 0.f;
#pragma unroll
    for (int w = 0; w < 8; ++w) var += sred[w];
    const float rs = rsqrtf(var * (1.0f / 1024.0f) + LN_EPS);
    const float o0 = d0 * rs * g[tid * 2] + bta[tid * 2], o1 = d1 * rs * g[tid * 2 + 1] + bta[tid * 2 + 1];
    *(float2*)(orow + tid * 2) = make_float2(o0, o1);
    if (obrow) *(unsigned*)(obrow + tid * 2) = pk2(o0, o1);
    __syncthreads();
}

__device__ __forceinline__ void peer_xk(const int* __restrict__ exr, float* __restrict__ gar, const float* __restrict__ pdt, const float* __restrict__ SU, const float* __restrict__ SV, int lane) {
    PV_COEFS()
    gar[lane] = cf0; gar[64 + lane] = cf1;
}
__device__ __forceinline__ void peer_v_slice(const int* __restrict__ exr, const float* __restrict__ cfr, const unsigned char* __restrict__ V8x, float* __restrict__ outs  , int lane) {
    const int e8 = lane >> 3, c = lane & 7;
    const __amdgpu_buffer_rsrc_t vrsrc = __builtin_amdgcn_make_buffer_rsrc((void*)V8x, 0, 16384 * 128, 0x00020000);
    v4u wa[8], wb[8]; float cfa[8], cfb[8];
    int ids[16];
#pragma unroll
    for (int j = 0; j < 4; ++j) { const v4u t = *(const v4u*)(exr + e8 * 16 + j * 4); ids[j * 4 + 0] = (int)t.x; ids[j * 4 + 1] = (int)t.y; ids[j * 4 + 2] = (int)t.z; ids[j * 4 + 3] = (int)t.w; }
#pragma unroll
    for (int g = 0; g < 8; ++g) wa[g] = __builtin_amdgcn_raw_buffer_load_b128(vrsrc, ids[g] * 128 + c * 16, 0, 0);
#pragma unroll
    for (int g = 0; g < 8; ++g) wb[g] = __builtin_amdgcn_raw_buffer_load_b128(vrsrc, ids[8 + g] * 128 + c * 16, 0, 0);
#pragma unroll
    for (int j = 0; j < 2; ++j) { const f32x4 t = *(const f32x4*)(cfr + e8 * 16 + j * 4), u = *(const f32x4*)(cfr + e8 * 16 + 8 + j * 4);
        cfa[j * 4 + 0] = t.x; cfa[j * 4 + 1] = t.y; cfa[j * 4 + 2] = t.z; cfa[j * 4 + 3] = t.w; cfb[j * 4 + 0] = u.x; cfb[j * 4 + 1] = u.y; cfb[j * 4 + 2] = u.z; cfb[j * 4 + 3] = u.w; }
    f32x2_t ap[8];
#pragma unroll
    for (int i = 0; i < 8; ++i) ap[i] = (f32x2_t){0.f, 0.f};
#define PVS_AXPY(w_, k_) do { ap[(k_) * 2] = __builtin_elementwise_fma(cf2_, __builtin_amdgcn_cvt_pk_f32_fp8((w_), false), ap[(k_) * 2]); ap[(k_) * 2 + 1] = __builtin_elementwise_fma(cf2_, __builtin_amdgcn_cvt_pk_f32_fp8((w_), true), ap[(k_) * 2 + 1]); } while (0)
#pragma unroll
    for (int g = 0; g < 8; ++g) { const f32x2_t cf2_ = (f32x2_t){cfa[g], cfa[g]}; PVS_AXPY(wa[g].x, 0); PVS_AXPY(wa[g].y, 1); PVS_AXPY(wa[g].z, 2); PVS_AXPY(wa[g].w, 3); }
#pragma unroll
    for (int g = 0; g < 8; ++g) { const f32x2_t cf2_ = (f32x2_t){cfb[g], cfb[g]}; PVS_AXPY(wb[g].x, 0); PVS_AXPY(wb[g].y, 1); PVS_AXPY(wb[g].z, 2); PVS_AXPY(wb[g].w, 3); }
#undef PVS_AXPY
    float acc[16];
#pragma unroll
    for (int i = 0; i < 8; ++i) { acc[2 * i] = ap[i].x; acc[2 * i + 1] = ap[i].y; }
#pragma unroll
    for (int i = 0; i < 16; ++i) { float v = acc[i]; v += DPPF(v, 0x128, 0xf); v += __shfl_xor(v, 16); v += __shfl_xor(v, 32); acc[i] = v; }
    if (e8 == 0) {
#pragma unroll
        for (int j = 0; j < 4; ++j) *(f32x4*)(outs + c * 16 + j * 4) = (f32x4){acc[j * 4 + 0], acc[j * 4 + 1], acc[j * 4 + 2], acc[j * 4 + 3]};
    }
}
#define PVL_IDS(I, k_) do { const int t_ = ((tg0 + ((k_) < nit ? (k_) : nit - 1) * tgstep) * 8 + wave); _Pragma("unroll") for (int j = 0; j < 4; ++j) I[j] = *(const v4u*)(EXPp + (size_t)t_ * 128 + e8 * 16 + j * 4); } while (0)
#define PVL_ROWS(R, C, I, k_) do { const int t_ = ((tg0 + ((k_) < nit ? (k_) : nit - 1) * tgstep) * 8 + wave); \
        _Pragma("unroll") for (int j = 0; j < 4; ++j) C[j] = *(const f32x4*)(CFp + (size_t)t_ * 128 + e8 * 16 + j * 4); \
        _Pragma("unroll") for (int j = 0; j < 4; ++j) { R[j * 4 + 0] = __builtin_amdgcn_raw_buffer_load_b128(vrsrc, (int)I[j].x * 128 + c * 16, 0, 0); R[j * 4 + 1] = __builtin_amdgcn_raw_buffer_load_b128(vrsrc, (int)I[j].y * 128 + c * 16, 0, 0); \
            R[j * 4 + 2] = __builtin_amdgcn_raw_buffer_load_b128(vrsrc, (int)I[j].z * 128 + c * 16, 0, 0); R[j * 4 + 3] = __builtin_amdgcn_raw_buffer_load_b128(vrsrc, (int)I[j].w * 128 + c * 16, 0, 0); } } while (0)
#define PVL_AXPY(w_, k2_) do { ap[(k2_) * 2] = __builtin_elementwise_fma(cf2_, __builtin_amdgcn_cvt_pk_f32_fp8((w_), false), ap[(k2_) * 2]); ap[(k2_) * 2 + 1] = __builtin_elementwise_fma(cf2_, __builtin_amdgcn_cvt_pk_f32_fp8((w_), true), ap[(k2_) * 2 + 1]); } while (0)
#define PVL_COMP(R, C, k_) do { f32x2_t ap[8]; \
        _Pragma("unroll") for (int i = 0; i < 8; ++i) ap[i] = (f32x2_t){0.f, 0.f}; \
        _Pragma("unroll") for (int g = 0; g < 16; ++g) { const float cfs_ = C[g >> 2][g & 3]; const f32x2_t cf2_ = (f32x2_t){cfs_, cfs_}; PVL_AXPY(R[g].x, 0); PVL_AXPY(R[g].y, 1); PVL_AXPY(R[g].z, 2); PVL_AXPY(R[g].w, 3); } \
        float acc[16]; \
        _Pragma("unroll") for (int i = 0; i < 8; ++i) { acc[2 * i] = ap[i].x; acc[2 * i + 1] = ap[i].y; } \
        float a8[8], a4[4], a2[2]; \
        _Pragma("unroll") for (int i = 0; i < 8; ++i) { const float keep = hA ? acc[8 + i] : acc[i], send = hA ? acc[i] : acc[8 + i]; a8[i] = keep + __shfl_xor(send, 32); } \
        _Pragma("unroll") for (int i = 0; i < 4; ++i) { const float keep = hB ? a8[4 + i] : a8[i], send = hB ? a8[i] : a8[4 + i]; a4[i] = keep + __shfl_xor(send, 16); } \
        _Pragma("unroll") for (int i = 0; i < 2; ++i) { const float keep = hC ? a4[2 + i] : a4[i], send = hC ? a4[i] : a4[2 + i]; a2[i] = keep + DPPF(send, 0x128, 0xf); } \
        if ((k_) < nit) *(float2*)(OUTp + (size_t)((tg0 + (k_) * tgstep) * 8 + wave) * D + x * 128 + c * 16 + 2 * e8) = make_float2(a2[0], a2[1]); } while (0)
__device__ __forceinline__ void peer_v_loop(const int* __restrict__ EXPp, const float* __restrict__ CFp, const unsigned char* __restrict__ V8x, float* __restrict__ OUTp, int x, int tg0, int tgstep, int nit, int wave, int lane) {
    const int e8 = lane >> 3, c = lane & 7;
    const bool hA = (lane & 32) != 0, hB = (lane & 16) != 0, hC = (lane & 8) != 0;
    const __amdgpu_buffer_rsrc_t vrsrc = __builtin_amdgcn_make_buffer_rsrc((void*)V8x, 0, 16384 * 128, 0x00020000);
    v4u ra[16], rb[16], i0[4], i1[4]; f32x4 ca[4], cb[4];
    PVL_IDS(i0, 0);
    PVL_ROWS(ra, ca, i0, 0);
    PVL_IDS(i1, 1);
#pragma unroll 1
    for (int k = 0; k < nit; k += 2) {
        PVL_ROWS(rb, cb, i1, k + 1);
        PVL_IDS(i0, k + 2);
        PVL_COMP(ra, ca, k);
        PVL_ROWS(ra, ca, i0, k + 2);
        PVL_IDS(i1, k + 3);
        PVL_COMP(rb, cb, k + 1);
    }
}
__device__ __forceinline__ void peer_xc(const bf16* __restrict__ xrow, const float* __restrict__ srow, const float* __restrict__ g, const float* __restrict__ bta, float* __restrict__ orow, bf16* __restrict__ obrow, bf16* __restrict__ obrow2, int lane) {
    float v[16]; float s = 0.f;
#pragma unroll
    for (int j = 0; j < 4; ++j) { const v2u ab = *(const v2u*)(xrow + lane * 16 + j * 4); const f32x4 b = *(const f32x4*)(srow + lane * 16 + j * 4);
        v[j * 4 + 0] = ALPHA * bflo(ab.x) + b.x; v[j * 4 + 1] = ALPHA * bfhi(ab.x) + b.y; v[j * 4 + 2] = ALPHA * bflo(ab.y) + b.z; v[j * 4 + 3] = ALPHA * bfhi(ab.y) + b.w; }
#pragma unroll
    for (int i = 0; i < 16; ++i) s += v[i];
    const float mean = wave_sum(s) * (1.0f / 1024.0f); float q = 0.f;
#pragma unroll
    for (int i = 0; i < 16; ++i) { v[i] -= mean; q += v[i] * v[i]; }
    const float rs = rsqrtf(wave_sum(q) * (1.0f / 1024.0f) + LN_EPS);
    float o[16];
#pragma unroll
    for (int j = 0; j < 4; ++j) {
        const f32x4 g4 = *(const f32x4*)(g + lane * 16 + j * 4), b4 = *(const f32x4*)(bta + lane * 16 + j * 4);
        o[j * 4 + 0] = v[j * 4 + 0] * rs * g4.x + b4.x; o[j * 4 + 1] = v[j * 4 + 1] * rs * g4.y + b4.y; o[j * 4 + 2] = v[j * 4 + 2] * rs * g4.z + b4.z; o[j * 4 + 3] = v[j * 4 + 3] * rs * g4.w + b4.w;
        if (orow) *(f32x4*)(orow + lane * 16 + j * 4) = (f32x4){o[j * 4 + 0], o[j * 4 + 1], o[j * 4 + 2], o[j * 4 + 3]};
    }
    if (obrow) {
        v4u w0, w1; w0.x = pk2(o[0], o[1]); w0.y = pk2(o[2], o[3]); w0.z = pk2(o[4], o[5]); w0.w = pk2(o[6], o[7]); w1.x = pk2(o[8], o[9]); w1.y = pk2(o[10], o[11]); w1.z = pk2(o[12], o[13]); w1.w = pk2(o[14], o[15]);
        *(v4u*)(obrow + lane * 16) = w0; *(v4u*)(obrow + lane * 16 + 8) = w1;
        if (obrow2) { *(v4u*)(obrow2 + lane * 16) = w0; *(v4u*)(obrow2 + lane * 16 + 8) = w1; }
    }
}

__device__ __forceinline__ int t5_bucket(int n) {
    if (n < 16) return n;
    const int large = 16 + (int)(logf((float)n / 16.0f) / 2.0794415416798357f * 16.0f);
    return large < 31 ? large : 31;
}
__device__ __forceinline__ void swa_attn(const float* __restrict__ PC, const float* __restrict__ cache_k, const float* __restrict__ cache_v,
                                         const float* __restrict__ rel_bias, const float* __restrict__ sinks, bf16* __restrict__ ATT, int bx) {
    const int tid = threadIdx.x, lane = tid & 63, wid = tid >> 6;
    const int gw = bx * 8 + wid;
    const int t = gw >> 4, h = gw & 15, kvh = h >> 2;
    if (t >= NT) return;
    const bool samp = t >= NP; const int sb = t - NP, pos = t % SEQ;
    const float* qrow = PC + (size_t)t * CN + h * 64;
    float lg[2]; bool valid[2];
#pragma unroll
    for (int rr = 0; rr < 2; ++rr) {
        const int r = lane + 64 * rr;
        const float* krow;
        if (!samp) { valid[rr] = (pos - r) >= 0; krow = PC + (size_t)(valid[rr] ? t - r : t) * CN + 1024 + kvh * 64; }
        else { valid[rr] = true; krow = (r == 0) ? PC + (size_t)t * CN + 1024 + kvh * 64 : cache_k + (((size_t)sb * 128 + (128 - r)) * 4 + kvh) * 64; }
        float dot = 0.f;
#pragma unroll
        for (int d4 = 0; d4 < 16; ++d4) {
            const float4 kv = *(const float4*)(krow + d4 * 4);
            const float4 qv = *(const float4*)(qrow + d4 * 4);
            dot += qv.x * kv.x + qv.y * kv.y + qv.z * kv.z + qv.w * kv.w;
        }
        lg[rr] = valid[rr] ? dot * 0.125f + rel_bias[t5_bucket(r) * 16 + h] : -INFINITY;
    }
    const float sink = sinks[h];
    const float m = fmaxf(wave_max(fmaxf(lg[0], lg[1])), sink);
    float p[2];
#pragma unroll
    for (int rr = 0; rr < 2; ++rr) p[rr] = valid[rr] ? expf(lg[rr] - m) : 0.f;
    const float den = wave_sum(p[0] + p[1]) + expf(sink - m);
    const float inv = 1.0f / den;
    float o = 0.f;
#pragma unroll
    for (int rr = 0; rr < 2; ++rr)
        for (int l2 = 0; l2 < 64; ++l2) {
            const int r = l2 + 64 * rr;
            const float pj = __shfl(p[rr], l2);
            if (pj != 0.f) {
                const float* vrow;
                if (!samp) vrow = PC + (size_t)(t - r) * CN + 1280 + kvh * 64;
                else vrow = (r == 0) ? PC + (size_t)t * CN + 1280 + kvh * 64 : cache_v + (((size_t)sb * 128 + (128 - r)) * 4 + kvh) * 64;
                o += pj * vrow[lane];
            }
        }
    ATT[(size_t)t * D + h * 64 + lane] = (bf16)f2bf(o * inv);
}

__device__ __forceinline__ void swa_kv_out(const float* __restrict__ PC, const float* __restrict__ cache_k, const float* __restrict__ cache_v,
                                           float* __restrict__ pk, float* __restrict__ pv, float* __restrict__ sk, float* __restrict__ sv, int vb) {
    const int c = threadIdx.x & 255, row = vb * 2 + (threadIdx.x >> 8);
    if (row < NB * 128) {
        const int b = row >> 7, i = row & 127;
        const float* src = PC + (size_t)(b * SEQ + SEQ - 128 + i) * CN;
        pk[(size_t)row * 256 + c] = src[1024 + c];
        pv[(size_t)row * 256 + c] = src[1280 + c];
    } else {
        const int r2 = row - NB * 128, sb = r2 >> 7, i = r2 & 127;
        if (i < 127) {
            sk[(size_t)r2 * 256 + c] = cache_k[((size_t)sb * 128 + i + 1) * 256 + c];
            sv[(size_t)r2 * 256 + c] = cache_v[((size_t)sb * 128 + i + 1) * 256 + c];
        } else {
            const float* src = PC + (size_t)(NP + sb) * CN;
            sk[(size_t)r2 * 256 + c] = src[1024 + c];
            sv[(size_t)r2 * 256 + c] = src[1280 + c];
        }
    }
}
#define XB_TMO      128
#define XB_XCNT(j)  (256  + 64 * (j))
#define XB_XSUB(j)  (1280 + 64 * (j))
#define XB_XGEN(j)  (2304 + 64 * (j))
#define XB_TOP      3328
#define XB_TOPGEN   3392
#define XCD_BAR_WORDS 3456
#define XB_SPIN_CAP (1u << 18)

__device__ __forceinline__ unsigned xb_ld(unsigned* p)              { return __hip_atomic_load(p, __ATOMIC_RELAXED, __HIP_MEMORY_SCOPE_AGENT); }
__device__ __forceinline__ unsigned xb_add(unsigned* p, unsigned v) { return __hip_atomic_fetch_add(p, v, __ATOMIC_RELAXED, __HIP_MEMORY_SCOPE_AGENT); }
__device__ __forceinline__ unsigned xb_xcc_id() { return (unsigned)__builtin_amdgcn_s_getreg((3 << 11) | 20) & 0xFu; }
#define XB_SPIN(cond, bar) do { unsigned _sp = 0; while (cond) { __builtin_amdgcn_s_sleep(1); \
    if ((++_sp & 255u) == 0u) { if (xb_ld(&(bar)[XB_TMO])) break; if (_sp > XB_SPIN_CAP) { atomicAdd(&(bar)[XB_TMO], 1u); break; } } } } while (0)

struct XcdBarrier {
    unsigned* bar; unsigned x;
    volatile LAS unsigned* st;
};

__device__ __forceinline__ XcdBarrier xcd_barrier_post(unsigned* bar, volatile LAS unsigned* st) {
    XcdBarrier b; b.bar = bar; b.x = xb_xcc_id(); b.st = st;
    if (threadIdx.x == 0) (void)xb_add(&bar[XB_XCNT(b.x)], 1u);
    return b;
}
__device__ __forceinline__ void xcd_barrier_complete(unsigned* bar, unsigned x, unsigned& nloc, unsigned& nx) {
    const unsigned G = gridDim.x * gridDim.y * gridDim.z;
    unsigned sum, cnt, mine, sp = 0u;
    for (;;) {
        sum = 0u; cnt = 0u; mine = 0u;
#pragma unroll
        for (unsigned j = 0; j < 16; ++j) { const unsigned c = xb_ld(&bar[XB_XCNT(j)]); sum += c; cnt += (c > 0u) ? 1u : 0u; mine = (j == x) ? c : mine; }
        if (sum == G) break;
        __builtin_amdgcn_s_sleep(1);
        if ((++sp & 255u) == 0u) { if (xb_ld(&bar[XB_TMO])) break; if (sp > XB_SPIN_CAP) { atomicAdd(&bar[XB_TMO], 1u); break; } }
    }
    nloc = mine > 0u ? mine : 1u; nx = cnt > 0u ? cnt : 1u;
}

__device__ __forceinline__ void xcd_barrier(const XcdBarrier& b) {
    asm volatile("s_waitcnt vmcnt(0)" ::: "memory");
    __syncthreads();
    if (threadIdx.x == 0) {
        unsigned* bar = b.bar;
        __builtin_amdgcn_s_waitcnt(0);
        unsigned nloc = b.st[0], nx = b.st[1];
        if (nloc == 0u) { xcd_barrier_complete(bar, b.x, nloc, nx); b.st[0] = nloc; b.st[1] = nx; }
        const unsigned old = xb_add(&bar[XB_XSUB(b.x)], 1u);
        const unsigned gen = old / nloc;
        if (old + 1u == (gen + 1u) * nloc) {
            __builtin_amdgcn_fence(__ATOMIC_RELEASE, "agent");
            asm volatile("s_waitcnt vmcnt(0)" ::: "memory");
            const unsigned og = xb_add(&bar[XB_TOP], 1u);
            const unsigned tg = og / nx;
            if (og + 1u == (tg + 1u) * nx) xb_add(&bar[XB_TOPGEN], 1u);
            else XB_SPIN(xb_ld(&bar[XB_TOPGEN]) == tg, bar);
            __builtin_amdgcn_fence(__ATOMIC_ACQUIRE, "agent");
            xb_add(&bar[XB_XGEN(b.x)], 1u);
            asm volatile("s_waitcnt vmcnt(0)" ::: "memory");
        } else {
            XB_SPIN(xb_ld(&bar[XB_XGEN(b.x)]) == gen, bar);
            __builtin_amdgcn_fence(__ATOMIC_ACQUIRE, "agent");
            asm volatile("s_waitcnt vmcnt(0)" ::: "memory");
        }
    }
    __syncthreads();
}

typedef short bf16x8_t __attribute__((ext_vector_type(8)));
__device__ __forceinline__ f32x4 mfma16(bf16x8_t a, bf16x8_t b, f32x4 c) { return __builtin_amdgcn_mfma_f32_16x16x32_bf16(a, b, c, 0, 0, 0); }

struct GdnChunkBufs {
    bf16* W;
    bf16* QG;
    bf16* KDT;
    bf16* UT;
    bf16* QK;
    float* EGL;
};

constexpr int GP_QB = 0, GP_KB = 17408, GP_VB = 34816, GP_LS = 52224, GP_QKS = 69632, GP_WS = 78848, GP_SC = 96256;

__device__ __forceinline__ void gdn_prep_unit(const bf16* __restrict__ PROJ, const float* __restrict__ conv_w, const float* __restrict__ a_log, const float* __restrict__ dt_bias,
                                              const GdnChunkBufs& cb, float* __restrict__ p_gdn_conv, int un, unsigned char* lds) {
    int tid = threadIdx.x; asm volatile("" : "+v"(tid));
    const int lane = tid & 63, wave = __builtin_amdgcn_readfirstlane(tid >> 6), fr = lane & 15, fq = lane >> 4;
    const int h = un & 3, n = (un >> 2) & 63, b = un >> 8;
    const int t0 = b * SEQ + n * 64;
    bf16* Qb = (bf16*)(lds + GP_QB); bf16* Kb = (bf16*)(lds + GP_KB); bf16* Vb = (bf16*)(lds + GP_VB); bf16* Ws = (bf16*)(lds + GP_WS);
    float* Ls = (float*)(lds + GP_LS); bf16* QKs = (bf16*)(lds + GP_QKS);
    float* gcs = (float*)(lds + GP_SC); float* bets = gcs + 64; float* egcs = gcs + 128; float* ekds = gcs + 192; float* begs = gcs + 256;
    if (wave == 0) {
        const bf16* prow = PROJ + (size_t)(t0 + lane) * ABN;
        const float a_raw = bf2f(prow[C_A + h]), b_raw = bf2f(prow[C_B + h]);
        float g = -expf(a_log[h]) * softplusf_(a_raw + dt_bias[h]);
#pragma unroll
        for (int off = 1; off < 64; off <<= 1) { const float v = __shfl_up(g, off); if (lane >= off) g += v; }
        const float glast = __shfl(g, 63);
        { const float be_ = sigmoidf_(b_raw), eg_ = expf(g); gcs[lane] = g; bets[lane] = be_; egcs[lane] = eg_; ekds[lane] = expf(glast - g); begs[lane] = be_ * eg_; }
        if (lane == 0) cb.EGL[un] = expf(glast);
    }
    {
        int cols[6]; float cw[4][6], xw[3][6];
#pragma unroll
        for (int p = 0; p < 3; ++p)
#pragma unroll
            for (int e = 0; e < 2; ++e) cols[p * 2 + e] = p * 512 + h * 128 + e * 64 + lane;
#pragma unroll
        for (int i = 0; i < 4; ++i)
#pragma unroll
            for (int c = 0; c < 6; ++c) cw[i][c] = conv_w[i * 1536 + cols[c]];
        const int i0 = wave * 8;
#pragma unroll
        for (int k = 0; k < 3; ++k) {
            const int pos = n * 64 + i0 - 3 + k;
#pragma unroll
            for (int c = 0; c < 6; ++c) xw[k][c] = pos >= 0 ? bf2f(PROJ[(size_t)(t0 + i0 - 3 + k) * ABN + cols[c]]) : 0.f;
        }
        bf16 xraw[8][6];
#pragma unroll
        for (int ii = 0; ii < 8; ++ii)
#pragma unroll
            for (int c = 0; c < 6; ++c) xraw[ii][c] = PROJ[(size_t)(t0 + i0 + ii) * ABN + cols[c]];
#pragma unroll
        for (int ii = 0; ii < 8; ++ii) {
            const int i = i0 + ii;
            float xt[6], s[6];
#pragma unroll
            for (int c = 0; c < 6; ++c) xt[c] = bf2f(xraw[ii][c]);
#pragma unroll
            for (int c = 0; c < 6; ++c) { const float y_ = cw[0][c] * xw[0][c] + cw[1][c] * xw[1][c] + cw[2][c] * xw[2][c] + cw[3][c] * xt[c]; s[c] = y_ * __frcp_rn(1.0f + __expf(-y_)); }
            const float qs = rsqrtf(wave_sum(s[0] * s[0] + s[1] * s[1]) + 1e-6f) * 0.08838834764831845f;
            const float ks = rsqrtf(wave_sum(s[2] * s[2] + s[3] * s[3]) + 1e-6f);
            Qb[i * 136 + lane] = (bf16)f2bf(s[0] * qs); Qb[i * 136 + 64 + lane] = (bf16)f2bf(s[1] * qs);
            Kb[i * 136 + lane] = (bf16)f2bf(s[2] * ks); Kb[i * 136 + 64 + lane] = (bf16)f2bf(s[3] * ks);
            Vb[i * 136 + lane] = (bf16)f2bf(s[4]);      Vb[i * 136 + 64 + lane] = (bf16)f2bf(s[5]);
            if (n == 63 && i >= 61) {
#pragma unroll
                for (int c = 0; c < 6; ++c) p_gdn_conv[((size_t)b * 3 + (i - 61)) * 1536 + cols[c]] = xt[c];
            }
#pragma unroll
            for (int c = 0; c < 6; ++c) { xw[0][c] = xw[1][c]; xw[1][c] = xw[2][c]; xw[2][c] = xt[c]; }
        }
    }
    __syncthreads();
    {
        const int mi = wave >> 1;
        bf16x8_t aK[4], aQ[4];
#pragma unroll
        for (int ks = 0; ks < 4; ++ks) { aK[ks] = *(const bf16x8_t*)(Kb + (mi * 16 + fr) * 136 + ks * 32 + 8 * fq); aQ[ks] = *(const bf16x8_t*)(Qb + (mi * 16 + fr) * 136 + ks * 32 + 8 * fq); }
#pragma unroll
        for (int nn = 0; nn < 2; ++nn) {
            const int nj = (wave & 1) * 2 + nn;
            f32x4 accK = (f32x4){0.f, 0.f, 0.f, 0.f}, accQ = accK;
#pragma unroll
            for (int ks = 0; ks < 4; ++ks) { const bf16x8_t bk = *(const bf16x8_t*)(Kb + (nj * 16 + fr) * 136 + ks * 32 + 8 * fq); accK = mfma16(aK[ks], bk, accK); accQ = mfma16(aQ[ks], bk, accQ); }
            const int j = nj * 16 + fr; const float gj = gcs[j];
#pragma unroll
            for (int r = 0; r < 4; ++r) {
                const int i = mi * 16 + 4 * fq + r;
                const float dec = i >= j ? expf(gcs[i] - gj) : 0.f;
                Ls[j * 68 + i] = i > j ? bets[i] * accK[r] * dec : 0.f;
                QKs[i * 72 + j] = (bf16)f2bf(i >= j ? accQ[r] * dec : 0.f);
            }
        }
    }
    __syncthreads();
    if (wave < 4) {
        float x[64];
        const bool isu = tid < 128; const int c = isu ? tid : tid - 128;
        const LAS unsigned char* l3 = (const LAS unsigned char*)lds;
        unsigned so = (isu ? GP_VB : GP_KB) + c * 2, ro = GP_SC + (isu ? 64 * 4 : 256 * 4), lo = GP_LS;
        asm volatile("" : "+v"(so), "+v"(ro), "+v"(lo));
#pragma unroll
        for (int i = 0; i < 64; ++i) x[i] = *(const LAS float*)(l3 + ro + 4 * i) * bf2f(*(const LAS bf16*)(l3 + so + i * 272));
#pragma unroll
        for (int j = 0; j < 63; ++j) {
#pragma unroll
            for (int i4 = (j + 1) / 4; i4 < 16; ++i4) {
                const f32x4 l4 = *(const LAS f32x4*)(l3 + lo + j * 272 + i4 * 16);
                if (i4 * 4 + 0 > j) x[i4 * 4 + 0] -= l4.x * x[j];
                if (i4 * 4 + 1 > j) x[i4 * 4 + 1] -= l4.y * x[j];
                if (i4 * 4 + 2 > j) x[i4 * 4 + 2] -= l4.z * x[j];
                if (i4 * 4 + 3 > j) x[i4 * 4 + 3] -= l4.w * x[j];
            }
        }
        if (isu) {
            bf16* dst = cb.UT + ((size_t)un * 128 + c) * 64;
#pragma unroll
            for (int i8 = 0; i8 < 8; ++i8) { v4u o; o.x = pk2(x[i8 * 8 + 0], x[i8 * 8 + 1]); o.y = pk2(x[i8 * 8 + 2], x[i8 * 8 + 3]); o.z = pk2(x[i8 * 8 + 4], x[i8 * 8 + 5]); o.w = pk2(x[i8 * 8 + 6], x[i8 * 8 + 7]); *(v4u*)(dst + i8 * 8) = o; }
        } else {
#pragma unroll
            for (int i = 0; i < 64; ++i) Ws[i * 136 + c] = (bf16)f2bf(x[i]);
        }
    } else {
        const int t2 = tid - 256;
#pragma unroll
        for (int k = 0; k < 4; ++k) {
            const int ci = t2 + 256 * k, i = ci >> 4, d0 = (ci & 15) * 8; const float e = egcs[i];
            const v4u q = *(const v4u*)(Qb + i * 136 + d0);
            v4u o; o.x = pk2(bflo(q.x) * e, bfhi(q.x) * e); o.y = pk2(bflo(q.y) * e, bfhi(q.y) * e); o.z = pk2(bflo(q.z) * e, bfhi(q.z) * e); o.w = pk2(bflo(q.w) * e, bfhi(q.w) * e);
            *(v4u*)(cb.QG + ((size_t)un * 64 + i) * 128 + d0) = o;
        }
#pragma unroll
        for (int k = 0; k < 4; ++k) {
            const int ci = t2 + 256 * k, d = ci & 127, i0 = (ci >> 7) * 8;
            float v[8];
#pragma unroll
            for (int q = 0; q < 8; ++q) v[q] = bf2f(Kb[(i0 + q) * 136 + d]) * ekds[i0 + q];
            v4u o; o.x = pk2(v[0], v[1]); o.y = pk2(v[2], v[3]); o.z = pk2(v[4], v[5]); o.w = pk2(v[6], v[7]);
            *(v4u*)(cb.KDT + ((size_t)un * 128 + d) * 64 + i0) = o;
        }
#pragma unroll
        for (int k = 0; k < 2; ++k) {
            const int ci = t2 + 256 * k, i = ci >> 3, j0 = (ci & 7) * 8;
            *(v4u*)(cb.QK + ((size_t)un * 64 + i) * 64 + j0) = *(const v4u*)(QKs + i * 72 + j0);
        }
    }
    __syncthreads();
#pragma unroll
    for (int k = 0; k < 2; ++k) {
        const int ci = tid + 512 * k, i = ci >> 4, d0 = (ci & 15) * 8;
        *(v4u*)(cb.W + ((size_t)un * 64 + i) * 128 + d0) = *(const v4u*)(Ws + i * 136 + d0);
    }
    __syncthreads();
}

constexpr int GS_ST = 0, GS_VNT = 2 * 32 * 136 * 2, GS_END = GS_VNT + 32 * 72 * 2;
template <int N0, int N1>
__device__ __forceinline__ void gdn_seq(const GdnChunkBufs& cb, float* __restrict__ O, float* __restrict__ Sout, int b, int h, int sl, unsigned char* lds, f32x4 (&accS)[2], int& cur) {
    int tid = threadIdx.x; asm volatile("" : "+v"(tid));
    const int lane = tid & 63, wave = __builtin_amdgcn_readfirstlane(tid >> 6), fr = lane & 15, fq = lane >> 4;
    const int mi = wave >> 1, nj = wave & 1;
    bf16* St = (bf16*)(lds + GS_ST); bf16* VnT = (bf16*)(lds + GS_VNT);
    float* egls = (float*)(lds + GS_END);
    if (N0 == 0) {
        for (int i = tid; i < 2 * 32 * 136 / 2; i += NTH) ((unsigned*)St)[i] = 0u;
        accS[0] = (f32x4){0.f, 0.f, 0.f, 0.f}; accS[1] = accS[0]; cur = 0;
    }
    if (tid >= N0 && tid < N1) egls[tid] = cb.EGL[(size_t)((b * 64 + tid) * 4 + h)];
    __syncthreads();
#define GS_DECL(X) bf16x8_t aW##X[4], aQG##X[4], aQK##X[2], aKD##X[2]; v2u ut##X;
    GS_DECL(0) GS_DECL(1) GS_DECL(2)
#define GS_GLD16(dst, ptr) asm volatile("global_load_dwordx4 %0, %1, off" : "=v"(dst) : "v"(ptr))
#define GS_GLD8(dst, ptr) asm volatile("global_load_dwordx2 %0, %1, off" : "=v"(dst) : "v"(ptr))
#define GS_LOAD(X, n_) do { const size_t u_ = (size_t)((b * 64 + ((n_) < 63 ? (n_) : 63)) * 4 + h);     \
        _Pragma("unroll") for (int ks = 0; ks < 4; ++ks) { GS_GLD16(aW##X[ks], cb.W + (u_ * 64 + mi * 16 + fr) * 128 + ks * 32 + 8 * fq); GS_GLD16(aQG##X[ks], cb.QG + (u_ * 64 + mi * 16 + fr) * 128 + ks * 32 + 8 * fq); } \
        _Pragma("unroll") for (int ks = 0; ks < 2; ++ks) { GS_GLD16(aQK##X[ks], cb.QK + (u_ * 64 + mi * 16 + fr) * 64 + ks * 32 + 8 * fq); GS_GLD16(aKD##X[ks], cb.KDT + (u_ * 128 + wave * 16 + fr) * 64 + ks * 32 + 8 * fq); } \
        GS_GLD8(ut##X, cb.UT + (u_ * 128 + sl * 32 + nj * 16 + fr) * 64 + mi * 16 + 4 * fq); } while (0)
#define GS_WAITN(X, N) asm volatile("s_waitcnt vmcnt(" #N ")" : "+v"(aW##X[0]), "+v"(aW##X[1]), "+v"(aW##X[2]), "+v"(aW##X[3]), "+v"(aQG##X[0]), "+v"(aQG##X[1]), "+v"(aQG##X[2]), "+v"(aQG##X[3]), \
        "+v"(aQK##X[0]), "+v"(aQK##X[1]), "+v"(aKD##X[0]), "+v"(aKD##X[1]), "+v"(ut##X))
#define GS_WAIT(X, n_) GS_WAITN(X, 26)
#define GS_STEP(X, n_) do { \
        const float egl##X = egls[(n_)]; \
        GS_WAIT(X, n_); \
        __syncthreads();                                        \
        f32x4 accW = (f32x4){0.f, 0.f, 0.f, 0.f}, accO = accW; \
        const bf16* Sc = St + cur * 32 * 136; \
        _Pragma("unroll") for (int ks = 0; ks < 4; ++ks) { const bf16x8_t bs = *(const bf16x8_t*)(Sc + (nj * 16 + fr) * 136 + ks * 32 + 8 * fq); accW = mfma16(aW##X[ks], bs, accW); accO = mfma16(aQG##X[ks], bs, accO); } \
          \
        const float v0 = bflo(ut##X.x) - accW[0], v1 = bfhi(ut##X.x) - accW[1], v2 = bflo(ut##X.y) - accW[2], v3 = bfhi(ut##X.y) - accW[3]; \
        { v2u o; o.x = pk2(v0, v1); o.y = pk2(v2, v3); *(v2u*)(VnT + (nj * 16 + fr) * 72 + mi * 16 + 4 * fq) = o; } \
        __syncthreads();                                        \
        _Pragma("unroll") for (int ks = 0; ks < 2; ++ks) { const bf16x8_t bv = *(const bf16x8_t*)(VnT + (nj * 16 + fr) * 72 + ks * 32 + 8 * fq); accO = mfma16(aQK##X[ks], bv, accO); } \
        { float* orow = O + (size_t)(b * SEQ + (n_) * 64 + mi * 16 + 4 * fq) * 512 + h * 128 + sl * 32 + nj * 16 + fr; \
          orow[0] = accO[0]; orow[512] = accO[1]; orow[1024] = accO[2]; orow[1536] = accO[3]; } \
          \
        bf16* Sn = St + (cur ^ 1) * 32 * 136; \
        _Pragma("unroll") for (int njj = 0; njj < 2; ++njj) { \
            accS[njj] = accS[njj] * egl##X; \
            _Pragma("unroll") for (int ks = 0; ks < 2; ++ks) { const bf16x8_t bv = *(const bf16x8_t*)(VnT + (njj * 16 + fr) * 72 + ks * 32 + 8 * fq); accS[njj] = mfma16(aKD##X[ks], bv, accS[njj]); } \
            v2u o; o.x = pk2(accS[njj][0], accS[njj][1]); o.y = pk2(accS[njj][2], accS[njj][3]); \
            *(v2u*)(Sn + (njj * 16 + fr) * 136 + wave * 16 + 4 * fq) = o; } \
        cur ^= 1; } while (0)
    constexpr int NTRI = (N1 - N0) / 3, NREM = (N1 - N0) % 3, NM = N0 + 3 * NTRI;
    GS_LOAD(0, N0); GS_LOAD(1, N0 + 1);
#pragma unroll 1
    for (int n = N0; n < NM; n += 3) {
        GS_LOAD(2, n + 2);
        GS_STEP(0, n);
        GS_LOAD(0, n + 3);
        GS_STEP(1, n + 1);
        GS_LOAD(1, n + 4);
        GS_STEP(2, n + 2);
    }
    if (NREM >= 1) { GS_LOAD(2, NM + 2); GS_STEP(0, NM); }
    if (NREM == 2) { GS_LOAD(0, NM + 3); GS_STEP(1, NM + 1); }
    GS_WAITN(0, 0); GS_WAITN(1, 0); GS_WAITN(2, 0);
#undef GS_STEP
#undef GS_DECL
#undef GS_WAIT
#undef GS_WAITN
#undef GS_GLD16
#undef GS_GLD8
    asm volatile("s_waitcnt vmcnt(0)" ::: "memory");
#undef GS_LOAD
    if (N1 == 64) {
#pragma unroll
        for (int njj = 0; njj < 2; ++njj)
#pragma unroll
            for (int r = 0; r < 4; ++r) Sout[(((size_t)b * 4 + h) * 128 + wave * 16 + 4 * fq + r) * 128 + sl * 32 + njj * 16 + fr] = accS[njj][r];
    }
    __syncthreads();
}

__device__ __forceinline__ void lru_prep_unit(const bf16* __restrict__ PROJ, const float* __restrict__ conv_w, const float* __restrict__ conv_b,
                                              const float* __restrict__ w_r, const float* __restrict__ b_r, const float* __restrict__ w_i, const float* __restrict__ b_i, const float* __restrict__ lam,
                                              float* __restrict__ H, float* __restrict__ P, float* __restrict__ Hend, float* __restrict__ Pend, float* __restrict__ p_lru_conv, int ub) {
    int c = threadIdx.x; asm volatile("" : "+v"(c));
    const int nblk = c >> 6, d = c & 63;
    const int n = ub & 63, b = ub >> 6, t0 = b * SEQ + n * 64;
    float wr[64], wi[64];
#pragma unroll
    for (int cc = 0; cc < 64; ++cc) { wr[cc] = w_r[((size_t)nblk * 64 + cc) * 64 + d]; wi[cc] = w_i[((size_t)nblk * 64 + cc) * 64 + d]; }
    const float cw0 = conv_w[c], cw1 = conv_w[512 + c], cw2 = conv_w[1024 + c], cw3 = conv_w[1536 + c], cb_ = conv_b[c];
    const float br = b_r[c], bi = b_i[c], spl = -8.0f * softplusf_(-lam[c]);
    float x0 = (n * 64 - 3 >= 0) ? bf2f(PROJ[(size_t)(t0 - 3) * ABN + C_XR + c]) : 0.f;
    float x1 = (n * 64 - 2 >= 0) ? bf2f(PROJ[(size_t)(t0 - 2) * ABN + C_XR + c]) : 0.f;
    float x2 = (n * 64 - 1 >= 0) ? bf2f(PROJ[(size_t)(t0 - 1) * ABN + C_XR + c]) : 0.f;
    float hloc = 0.f, ploc = 1.f;
    bf16 xa[16], xb[16];
#pragma unroll
    for (int k = 0; k < 16; ++k) xa[k] = PROJ[(size_t)(t0 + k) * ABN + C_XR + c];
#pragma unroll 1
    for (int ib = 0; ib < 64; ib += 16) {
      if (ib + 16 < 64) {
#pragma unroll
        for (int k = 0; k < 16; ++k) xb[k] = PROJ[(size_t)(t0 + ib + 16 + k) * ABN + C_XR + c];
      }
#pragma unroll
      for (int k = 0; k < 16; ++k) {
        const int i = ib + k;
        const float xt = bf2f(xa[k]);
        const float xr = cb_ + cw0 * x0 + cw1 * x1 + cw2 * x2 + cw3 * xt;
        f32x2_t ga = (f32x2_t){br, bi}, gb = (f32x2_t){0.f, 0.f};
#pragma unroll
        for (int cc = 0; cc < 64; cc += 2) {
            const float xa_ = __uint_as_float(__builtin_amdgcn_readlane(__float_as_uint(xr), cc)), xb_ = __uint_as_float(__builtin_amdgcn_readlane(__float_as_uint(xr), cc + 1));
            ga += (f32x2_t){xa_, xa_} * (f32x2_t){wr[cc], wi[cc]}; gb += (f32x2_t){xb_, xb_} * (f32x2_t){wr[cc + 1], wi[cc + 1]};
        }
        ga += gb;
        const float r = __frcp_rn(1.0f + __expf(-ga.x)), ii = __frcp_rn(1.0f + __expf(-ga.y));
        const float a = __expf(spl * r), bb = __fsqrt_rn(fmaxf(1.0f - a * a, 0.f)) * (ii * xr);
        hloc = a * hloc + bb; ploc *= a;
        H[(size_t)(t0 + i) * 512 + c] = hloc; P[(size_t)(t0 + i) * 512 + c] = ploc;
        if (n == 63 && i >= 61) p_lru_conv[((size_t)b * 3 + (i - 61)) * 512 + c] = xt;
        x0 = x1; x1 = x2; x2 = xt;
      }
#pragma unroll
      for (int k = 0; k < 16; ++k) xa[k] = xb[k];
    }
    Hend[(size_t)ub * 512 + c] = hloc; Pend[(size_t)ub * 512 + c] = ploc;
}
constexpr int LR_XR = 64 * 68 * 4;
__device__ __forceinline__ void lru_prep_unit2(const bf16* __restrict__ PROJ, const float* __restrict__ conv_w, const float* __restrict__ conv_b,
                                               const bf16* __restrict__ WRT, const bf16* __restrict__ WIT  , const float* __restrict__ b_r, const float* __restrict__ b_i, const float* __restrict__ lam,
                                               float* __restrict__ H, float* __restrict__ P, float* __restrict__ Hend, float* __restrict__ Pend, float* __restrict__ p_lru_conv, int ub, unsigned char* lds) {
    int tid = threadIdx.x; asm volatile("" : "+v"(tid));
    const int lane = tid & 63, wave = __builtin_amdgcn_readfirstlane(tid >> 6), fr = lane & 15, fq = lane >> 4;
    const int n = ub & 63, b = ub >> 6, t0 = b * SEQ + n * 64;
    float* XR = (float*)(lds + wave * LR_XR);
    {
        const int c = wave * 64 + lane;
        const float cw0 = conv_w[c], cw1 = conv_w[512 + c], cw2 = conv_w[1024 + c], cw3 = conv_w[1536 + c], cb_ = conv_b[c];
        float x0 = (n * 64 - 3 >= 0) ? bf2f(PROJ[(size_t)(t0 - 3) * ABN + C_XR + c]) : 0.f;
        float x1 = (n * 64 - 2 >= 0) ? bf2f(PROJ[(size_t)(t0 - 2) * ABN + C_XR + c]) : 0.f;
        float x2 = (n * 64 - 1 >= 0) ? bf2f(PROJ[(size_t)(t0 - 1) * ABN + C_XR + c]) : 0.f;
#pragma unroll 1
        for (int ib = 0; ib < 64; ib += 16) {
            bf16 xa[16];
#pragma unroll
            for (int k = 0; k < 16; ++k) xa[k] = PROJ[(size_t)(t0 + ib + k) * ABN + C_XR + c];
#pragma unroll
            for (int k = 0; k < 16; ++k) {
                const int i = ib + k; const float xt = bf2f(xa[k]);
                XR[i * 68 + lane] = cb_ + cw0 * x0 + cw1 * x1 + cw2 * x2 + cw3 * xt;
                if (n == 63 && i >= 61) p_lru_conv[((size_t)b * 3 + (i - 61)) * 512 + c] = xt;
                x0 = x1; x1 = x2; x2 = xt;
            }
        }
    }
    asm volatile("s_waitcnt lgkmcnt(0)" ::: "memory");
    bf16x8_t bR[4][2], bI[4][2];
#pragma unroll
    for (int nt = 0; nt < 4; ++nt)
#pragma unroll
        for (int ks = 0; ks < 2; ++ks) {
            bR[nt][ks] = *(const bf16x8_t*)(WRT + ((size_t)wave * 64 + nt * 16 + fr) * 64 + ks * 32 + 8 * fq);
            bI[nt][ks] = *(const bf16x8_t*)(WIT + ((size_t)wave * 64 + nt * 16 + fr) * 64 + ks * 32 + 8 * fq);
        }
    float brv[4], biv[4], splv[4];
#pragma unroll
    for (int nt = 0; nt < 4; ++nt) { const int c = wave * 64 + nt * 16 + fr; brv[nt] = b_r[c]; biv[nt] = b_i[c]; splv[nt] = -8.0f * softplusf_(-lam[c]); }
    float hin[4], pin[4];
#pragma unroll
    for (int nt = 0; nt < 4; ++nt) { hin[nt] = 0.f; pin[nt] = 1.f; }
#pragma unroll 1
    for (int mt = 0; mt < 4; ++mt) {
        bf16x8_t aX[2];
#pragma unroll
        for (int ks = 0; ks < 2; ++ks) {
            const f32x4 lo = *(const f32x4*)(XR + (mt * 16 + fr) * 68 + ks * 32 + 8 * fq), hi = *(const f32x4*)(XR + (mt * 16 + fr) * 68 + ks * 32 + 8 * fq + 4);
            v4u w; w.x = pk2(lo.x, lo.y); w.y = pk2(lo.z, lo.w); w.z = pk2(hi.x, hi.y); w.w = pk2(hi.z, hi.w);
            aX[ks] = __builtin_bit_cast(bf16x8_t, w);
        }
#pragma unroll
        for (int nt = 0; nt < 4; ++nt) {
            f32x4 aR = (f32x4){0.f, 0.f, 0.f, 0.f}, aI = aR;
            aR = mfma16(aX[0], bR[nt][0], aR); aR = mfma16(aX[1], bR[nt][1], aR);
            aI = mfma16(aX[0], bI[nt][0], aI); aI = mfma16(aX[1], bI[nt][1], aI);
            float av[4], bv[4];
#pragma unroll
            for (int r = 0; r < 4; ++r) {
                const float rg = __frcp_rn(1.0f + __expf(-(aR[r] + brv[nt]))), ig = __frcp_rn(1.0f + __expf(-(aI[r] + biv[nt])));
                const float a = __expf(splv[nt] * rg);
                av[r] = a; bv[r] = __fsqrt_rn(fmaxf(1.0f - a * a, 0.f)) * (ig * XR[(mt * 16 + 4 * fq + r) * 68 + nt * 16 + fr]);
            }
            float PA[4], PB[4];
            PA[0] = av[0]; PB[0] = bv[0];
#pragma unroll
            for (int r = 1; r < 4; ++r) { PA[r] = av[r] * PA[r - 1]; PB[r] = av[r] * PB[r - 1] + bv[r]; }
            float GA = PA[3], GB = PB[3];
            { const float pa = __shfl_up(GA, 16), pb = __shfl_up(GB, 16); if (fq >= 1) { GB = GA * pb + GB; GA = GA * pa; } }
            { const float pa = __shfl_up(GA, 32), pb = __shfl_up(GB, 32); if (fq >= 2) { GB = GA * pb + GB; GA = GA * pa; } }
            float EA = __shfl_up(GA, 16), EB = __shfl_up(GB, 16);
            if (fq == 0) { EA = 1.f; EB = 0.f; }
            const float h0 = EA * hin[nt] + EB, p0 = pin[nt] * EA;
#pragma unroll
            for (int r = 0; r < 4; ++r) {
                const size_t o = (size_t)(t0 + mt * 16 + 4 * fq + r) * 512 + wave * 64 + nt * 16 + fr;
                H[o] = PA[r] * h0 + PB[r]; P[o] = p0 * PA[r];
            }
            const float TA = __shfl(GA, 48 + fr), TB = __shfl(GB, 48 + fr);
            hin[nt] = TA * hin[nt] + TB; pin[nt] = pin[nt] * TA;
        }
    }
    if (fq == 0) {
#pragma unroll
        for (int nt = 0; nt < 4; ++nt) { Hend[(size_t)ub * 512 + wave * 64 + nt * 16 + fr] = hin[nt]; Pend[(size_t)ub * 512 + wave * 64 + nt * 16 + fr] = pin[nt]; }
    }
    asm volatile("s_waitcnt lgkmcnt(0)" ::: "memory");
}
__device__ __forceinline__ void lru_carry(const float* __restrict__ Hend, const float* __restrict__ Pend, float* __restrict__ CIN, float* __restrict__ hlast, int bx) {
    int tx_ = threadIdx.x; asm volatile("" : "+v"(tx_));
    const int idx = bx * NTH + tx_, b = idx >> 9, c = idx & 511;
    float carry = 0.f;
#pragma unroll 8
    for (int n = 0; n < 64; ++n) {
        const size_t o = ((size_t)b * 64 + n) * 512 + c;
        CIN[o] = carry;
        carry = Hend[o] + Pend[o] * carry;
    }
    hlast[(size_t)b * 512 + c] = carry;
}

__device__ __forceinline__ unsigned f2key(float f) { const unsigned u = __float_as_uint(f); return u ^ ((u >> 31) ? 0xffffffffu : 0x80000000u); }
__device__ __forceinline__ float key2f(unsigned k) { return __uint_as_float(k ^ ((k >> 31) ? 0x80000000u : 0xffffffffu)); }
#define TK_CE(hi, lo) do { const unsigned a_ = (hi), b_ = (lo); (hi) = a_ > b_ ? a_ : b_; (lo) = a_ > b_ ? b_ : a_; } while (0)
template <int N> __device__ __forceinline__ void bitonic_sort_desc(unsigned (&a)[N]) {
#pragma unroll
    for (int k = 2; k <= N; k <<= 1)
#pragma unroll
        for (int j = k >> 1; j > 0; j >>= 1)
#pragma unroll
            for (int i = 0; i < N; ++i) { const int l = i ^ j; if (l > i) { if ((i & k) == 0) TK_CE(a[i], a[l]); else TK_CE(a[l], a[i]); } }
}
template <int XM> __device__ __forceinline__ void merge_top16(unsigned (&a)[16]) {
    unsigned c[16];
#pragma unroll
    for (int i = 0; i < 16; ++i) { const unsigned o = (unsigned)__shfl_xor((int)a[15 - i], XM); c[i] = a[i] > o ? a[i] : o; }
#pragma unroll
    for (int j = 8; j > 0; j >>= 1)
#pragma unroll
        for (int i = 0; i < 16; ++i) { const int l = i ^ j; if (l > i) TK_CE(c[i], c[l]); }
#pragma unroll
    for (int i = 0; i < 16; ++i) a[i] = c[i];
}
constexpr int TK_KS = 0, TK_TS = 2 * 128 * 136 * 2, TK_END = TK_TS + 64 * 2 * 16 * 4;
__device__ __forceinline__ void peer_topk_stage_keys(const bf16* __restrict__ KB, int h, unsigned char* lds) {
    bf16* Ks = (bf16*)(lds + TK_KS);
    for (int ci = threadIdx.x; ci < 2 * 128 * 16; ci += NTH) { const int row = ci >> 4, part = ci & 15;
        *(v4u*)(Ks + row * 136 + part * 8) = *(const v4u*)(KB + ((size_t)h * 256 + row) * 128 + part * 8); }
    __syncthreads();
}
__device__ __forceinline__ void peer_topk4(const bf16* __restrict__ Q, int* __restrict__ EXP, float* __restrict__ GATE, int tile, int h, unsigned char* lds) {
    int tid = threadIdx.x; asm volatile("" : "+v"(tid));
    const int lane = tid & 63, wave = __builtin_amdgcn_readfirstlane(tid >> 6), fr = lane & 15, fq = lane >> 4;
    const bf16* Ks = (const bf16*)(lds + TK_KS); unsigned* Ts = (unsigned*)(lds + TK_TS);
    {
        const int c = wave >> 2, nt = wave & 3;
        bf16x8_t bq[4];
#pragma unroll
        for (int ks = 0; ks < 4; ++ks) bq[ks] = *(const bf16x8_t*)(Q + (size_t)(tile * 64 + nt * 16 + fr) * 2048 + h * 256 + c * 128 + ks * 32 + 8 * fq);
        unsigned a[32];
#pragma unroll
        for (int mt = 0; mt < 8; ++mt) {
            f32x4 acc = (f32x4){0.f, 0.f, 0.f, 0.f};
#pragma unroll
            for (int ks = 0; ks < 4; ++ks) { const bf16x8_t ak = *(const bf16x8_t*)(Ks + (c * 128 + mt * 16 + fr) * 136 + ks * 32 + 8 * fq); acc = mfma16(ak, bq[ks], acc); }
#pragma unroll
            for (int r = 0; r < 4; ++r) a[mt * 4 + r] = (f2key(acc[r]) & ~127u) | (unsigned)(127 - (mt * 16 + 4 * fq + r));
        }
        bitonic_sort_desc<32>(a);
        unsigned t[16];
#pragma unroll
        for (int j = 0; j < 16; ++j) t[j] = a[j];
        merge_top16<16>(t); merge_top16<32>(t);
        if (fq == 0) {
            const int tk = nt * 16 + fr;
#pragma unroll
            for (int j = 0; j < 16; ++j) Ts[(tk * 2 + c) * 16 + j] = t[j];
        }
    }
    __syncthreads();
    if (tid < 256) {
        const int tk = tid >> 2, q = tid & 3;
        const unsigned* t0 = Ts + (tk * 2 + 0) * 16; const unsigned* t1 = Ts + (tk * 2 + 1) * 16;
        unsigned a[16];
#pragma unroll
        for (int s = 0; s < 13; ++s) {
            const int e = s * 4 + q;
            int i, j;
            if (e < 16) { i = 0; j = e; } else if (e < 24) { i = 1; j = e - 16; } else if (e < 29) { i = 2; j = e - 24; } else if (e < 33) { i = 3; j = e - 29; }
            else if (e < 36) { i = 4; j = e - 33; } else if (e < 42) { i = 5 + ((e - 36) >> 1); j = (e - 36) & 1; } else { i = 8 + (e - 42); j = 0; }
            const bool ok = e < 50;
            const float sum = key2f(t0[ok ? i : 0] & ~127u) + key2f(t1[ok ? j : 0] & ~127u);
            a[s] = ok ? ((f2key(sum) & ~255u) | (unsigned)(255 - (i * 16 + j))) : 0u;
        }
        a[13] = 0u; a[14] = 0u; a[15] = 0u;
        bitonic_sort_desc<16>(a);
        merge_top16<1>(a); merge_top16<2>(a);
        float ev[16], sum = 0.f; const float m = key2f(a[0] & ~255u);
#pragma unroll
        for (int j = 0; j < 16; ++j) { ev[j] = __expf(key2f(a[j] & ~255u) - m); sum += ev[j]; }
        const float inv = 1.0f / sum;
        const size_t o = (size_t)(tile * 64 + tk) * 128 + h * 16;
#pragma unroll
        for (int j = 0; j < 16; ++j)
            if ((j >> 2) == q) {
                const int code = 255 - (int)(a[j] & 255u), i = code >> 4, jj = code & 15;
                const int n0 = 127 - (int)(t0[i] & 127u), n1 = 127 - (int)(t1[jj] & 127u);
                EXP[o + j] = n0 * 128 + n1; GATE[o + j] = ev[j] * inv;
            }
    }
    __syncthreads();
}

constexpr int AT_KS = 0, AT_VT = 192 * 72 * 2, AT_BT = AT_VT + 64 * 200 * 2, AT_PW = AT_BT + 4 * 128 * 4, AT_END = AT_PW + 8 * 32 * 72 * 2;
__device__ __forceinline__ void attn_unit(const bf16* __restrict__ PCb, const float* __restrict__ rel_bias, const float* __restrict__ sinks, bf16* __restrict__ ATT, int un, unsigned char* lds) {
    int tid = threadIdx.x; asm volatile("" : "+v"(tid));
    const int lane = tid & 63, wave = __builtin_amdgcn_readfirstlane(tid >> 6), fr = lane & 15, fq = lane >> 4;
    const int kvh = un & 3, qblk = (un >> 2) & 63, b = un >> 8;
    const int q0 = qblk * 64, tb = b * SEQ;
    bf16* Ks = (bf16*)(lds + AT_KS); bf16* Vt = (bf16*)(lds + AT_VT); float* Bt = (float*)(lds + AT_BT); bf16* Pw = (bf16*)(lds + AT_PW) + wave * 32 * 72;
#pragma unroll
    for (int k = 0; k < 3; ++k) {
        const int ci = tid + 512 * k, row = ci >> 3, part = ci & 7, kpos = q0 - 128 + row;
        v4u kv = (v4u){0u, 0u, 0u, 0u}, vv = kv;
        if (kpos >= 0) { const bf16* src = PCb + (size_t)(tb + kpos) * CN + kvh * 64 + part * 8; kv = *(const v4u*)(src + 1024); vv = *(const v4u*)(src + 1280); }
        *(v4u*)(Ks + row * 72 + part * 8) = kv;
        bf16* vd = Vt + (part * 8) * 200 + row;
        vd[0 * 200] = (bf16)(vv.x & 0xffffu); vd[1 * 200] = (bf16)(vv.x >> 16); vd[2 * 200] = (bf16)(vv.y & 0xffffu); vd[3 * 200] = (bf16)(vv.y >> 16);
        vd[4 * 200] = (bf16)(vv.z & 0xffffu); vd[5 * 200] = (bf16)(vv.z >> 16); vd[6 * 200] = (bf16)(vv.w & 0xffffu); vd[7 * 200] = (bf16)(vv.w >> 16);
    }
    Bt[tid] = rel_bias[t5_bucket(tid & 127) * 16 + kvh * 4 + (tid >> 7)];
    __syncthreads();
    const int g = wave >> 1, qs = (wave & 1) * 32, hh = kvh * 4 + g;
    bf16x8_t aQ[2][2];
#pragma unroll
    for (int mt = 0; mt < 2; ++mt)
#pragma unroll
        for (int ks = 0; ks < 2; ++ks) aQ[mt][ks] = *(const bf16x8_t*)(PCb + (size_t)(tb + q0 + qs + mt * 16 + fr) * CN + hh * 64 + ks * 32 + 8 * fq);
    f32x4 sc[2][12];
#pragma unroll
    for (int nt = 0; nt < 12; ++nt) {
        const bf16x8_t b0 = *(const bf16x8_t*)(Ks + (nt * 16 + fr) * 72 + 8 * fq), b1 = *(const bf16x8_t*)(Ks + (nt * 16 + fr) * 72 + 32 + 8 * fq);
#pragma unroll
        for (int mt = 0; mt < 2; ++mt) { f32x4 a = (f32x4){0.f, 0.f, 0.f, 0.f}; a = mfma16(aQ[mt][0], b0, a); a = mfma16(aQ[mt][1], b1, a); sc[mt][nt] = a; }
    }
    const float sink = sinks[hh];
    const float* bt = Bt + g * 128;
#pragma unroll
    for (int mt = 0; mt < 2; ++mt)
#pragma unroll
        for (int r = 0; r < 4; ++r) {
            const int qi = qs + mt * 16 + 4 * fq + r;
            float mx = sink;
#pragma unroll
            for (int nt = 0; nt < 12; ++nt) {
                const int kk = nt * 16 + fr, rel = qi + 128 - kk;
                const bool valid = rel >= 0 && rel < 128 && (q0 - 128 + kk) >= 0;
                const float lg = valid ? sc[mt][nt][r] * 0.125f + bt[valid ? rel : 0] : -INFINITY;
                sc[mt][nt][r] = lg; mx = fmaxf(mx, lg);
            }
            mx = fmaxf(mx, __shfl_xor(mx, 1)); mx = fmaxf(mx, __shfl_xor(mx, 2)); mx = fmaxf(mx, __shfl_xor(mx, 4)); mx = fmaxf(mx, __shfl_xor(mx, 8));
            float sum = 0.f;
#pragma unroll
            for (int nt = 0; nt < 12; ++nt) { const float p = __expf(sc[mt][nt][r] - mx); sc[mt][nt][r] = p; sum += p; }
            sum += __shfl_xor(sum, 1); sum += __shfl_xor(sum, 2); sum += __shfl_xor(sum, 4); sum += __shfl_xor(sum, 8);
            const float inv = 1.0f / (sum + __expf(sink - mx));
#pragma unroll
            for (int nt = 0; nt < 12; ++nt) sc[mt][nt][r] *= inv;
        }
    f32x4 oacc[2][4];
#pragma unroll
    for (int mt = 0; mt < 2; ++mt)
#pragma unroll
        for (int dt = 0; dt < 4; ++dt) oacc[mt][dt] = (f32x4){0.f, 0.f, 0.f, 0.f};
#pragma unroll
    for (int kc = 0; kc < 3; ++kc) {
#pragma unroll
        for (int mt = 0; mt < 2; ++mt)
#pragma unroll
            for (int n4 = 0; n4 < 4; ++n4)
#pragma unroll
                for (int r = 0; r < 4; ++r) Pw[(mt * 16 + 4 * fq + r) * 72 + n4 * 16 + fr] = (bf16)f2bf(sc[mt][kc * 4 + n4][r]);
        asm volatile("s_waitcnt lgkmcnt(0)" ::: "memory");
#pragma unroll
        for (int ks = 0; ks < 2; ++ks) {
            const bf16x8_t p0 = *(const bf16x8_t*)(Pw + fr * 72 + ks * 32 + 8 * fq), p1 = *(const bf16x8_t*)(Pw + (16 + fr) * 72 + ks * 32 + 8 * fq);
#pragma unroll
            for (int dt = 0; dt < 4; ++dt) {
                const bf16x8_t bv = *(const bf16x8_t*)(Vt + (dt * 16 + fr) * 200 + kc * 64 + ks * 32 + 8 * fq);
                oacc[0][dt] = mfma16(p0, bv, oacc[0][dt]); oacc[1][dt] = mfma16(p1, bv, oacc[1][dt]);
            }
        }
        asm volatile("s_waitcnt lgkmcnt(0)" ::: "memory");
    }
#pragma unroll
    for (int mt = 0; mt < 2; ++mt)
#pragma unroll
        for (int dt = 0; dt < 4; ++dt)
#pragma unroll
            for (int r = 0; r < 4; ++r) Pw[(mt * 16 + 4 * fq + r) * 72 + dt * 16 + fr] = (bf16)f2bf(oacc[mt][dt][r]);
    asm volatile("s_waitcnt lgkmcnt(0)" ::: "memory");
#pragma unroll
    for (int k = 0; k < 4; ++k) {
        const int ci = lane + 64 * k, row = ci >> 3, part = ci & 7;
        *(v4u*)(ATT + (size_t)(tb + q0 + qs + row) * D + hh * 64 + part * 8) = *(const v4u*)(Pw + row * 72 + part * 8);
    }
    __syncthreads();
}

__device__ __forceinline__ void swa_attn_sample(const bf16* __restrict__ PCb, const float* __restrict__ cache_k, const float* __restrict__ cache_v,
                                                const float* __restrict__ rel_bias, const float* __restrict__ sinks, bf16* __restrict__ ATT, int gw, int lane) {
    const int sb = gw >> 4, h = gw & 15, kvh = h >> 2, t = NP + sb;
    const bf16* qrow = PCb + (size_t)t * CN + h * 64;
    float lg[2];
#pragma unroll
    for (int rr = 0; rr < 2; ++rr) {
        const int r = lane + 64 * rr;
        float dot = 0.f;
        if (r == 0) {
            const bf16* krow = PCb + (size_t)t * CN + 1024 + kvh * 64;
            for (int d = 0; d < 64; ++d) dot += bf2f(qrow[d]) * bf2f(krow[d]);
        } else {
            const float* krow = cache_k + (((size_t)sb * 128 + (128 - r)) * 4 + kvh) * 64;
#pragma unroll
            for (int d4 = 0; d4 < 16; ++d4) { const float4 kv = *(const float4*)(krow + d4 * 4);
                dot += bf2f(qrow[d4 * 4]) * kv.x + bf2f(qrow[d4 * 4 + 1]) * kv.y + bf2f(qrow[d4 * 4 + 2]) * kv.z + bf2f(qrow[d4 * 4 + 3]) * kv.w; }
        }
        lg[rr] = dot * 0.125f + rel_bias[t5_bucket(r) * 16 + h];
    }
    const float sink = sinks[h];
    const float m = fmaxf(wave_max(fmaxf(lg[0], lg[1])), sink);
    float p[2] = {expf(lg[0] - m), expf(lg[1] - m)};
    const float inv = 1.0f / (wave_sum(p[0] + p[1]) + expf(sink - m));
    float o = 0.f;
#pragma unroll
    for (int rr = 0; rr < 2; ++rr)
#pragma unroll 1
        for (int lb = 0; lb < 64; lb += 16) {
            float vv[16];
#pragma unroll
            for (int k = 0; k < 16; ++k) { const int r = lb + k + 64 * rr;
                vv[k] = (r == 0) ? bf2f(PCb[(size_t)t * CN + 1280 + kvh * 64 + lane]) : cache_v[(((size_t)sb * 128 + (128 - r)) * 4 + kvh) * 64 + lane]; }
#pragma unroll
            for (int k = 0; k < 16; ++k) o += __shfl(p[rr], lb + k) * vv[k];
        }
    ATT[(size_t)t * D + h * 64 + lane] = (bf16)f2bf(o * inv);
}
__device__ __forceinline__ void swa_kv_out2(const bf16* __restrict__ PCb, const float* __restrict__ cache_k, const float* __restrict__ cache_v,
                                            float* __restrict__ pk, float* __restrict__ pv, float* __restrict__ sk, float* __restrict__ sv, int vb) {
    int tx_ = threadIdx.x; asm volatile("" : "+v"(tx_));
    const int c = tx_ & 255, row = vb * 2 + (tx_ >> 8);
    if (row < NB * 128) {
        const int b = row >> 7, i = row & 127;
        const bf16* src = PCb + (size_t)(b * SEQ + SEQ - 128 + i) * CN;
        pk[(size_t)row * 256 + c] = bf2f(src[1024 + c]);
        pv[(size_t)row * 256 + c] = bf2f(src[1280 + c]);
    } else {
        const int r2 = row - NB * 128, sb = r2 >> 7, i = r2 & 127;
        if (i < 127) {
            sk[(size_t)r2 * 256 + c] = cache_k[((size_t)sb * 128 + i + 1) * 256 + c];
            sv[(size_t)r2 * 256 + c] = cache_v[((size_t)sb * 128 + i + 1) * 256 + c];
        } else {
            const bf16* src = PCb + (size_t)(NP + sb) * CN;
            sk[(size_t)r2 * 256 + c] = bf2f(src[1024 + c]);
            sv[(size_t)r2 * 256 + c] = bf2f(src[1280 + c]);
        }
    }
}


__device__ __forceinline__ void sample_gemm_piece(const bf16* __restrict__ A, const bf16* __restrict__ Bt, const float* __restrict__ bias, bf16* __restrict__ O, int ldc, int p, unsigned char* lds) {
    int tid = threadIdx.x; asm volatile("" : "+v"(tid));
    const int lane = tid & 63, wave = __builtin_amdgcn_readfirstlane(tid >> 6), fr = lane & 15, fq = lane >> 4;
    const int mt = p & 7, cb = p >> 3, nt = wave & 3, kh = wave >> 2;
    const bf16* ap = A + (size_t)(NP + mt * 16 + fr) * D + kh * 512 + 8 * fq;
    const bf16* bp = Bt + (size_t)(cb * 64 + nt * 16 + fr) * D + kh * 512 + 8 * fq;
    bf16x8_t a[16], b[16];
#pragma unroll
    for (int ks = 0; ks < 16; ++ks) { a[ks] = *(const bf16x8_t*)(ap + ks * 32); b[ks] = *(const bf16x8_t*)(bp + ks * 32); }
    f32x4 acc = (f32x4){0.f, 0.f, 0.f, 0.f};
#pragma unroll
    for (int ks = 0; ks < 16; ++ks) acc = mfma16(a[ks], b[ks], acc);
    f32x4* part = (f32x4*)lds;
    if (kh == 1) part[nt * 64 + lane] = acc;
    __syncthreads();
    if (kh == 0) {
        acc = acc + part[nt * 64 + lane];
        const int col = cb * 64 + nt * 16 + fr; const float bv = bias ? bias[col] : 0.f;
#pragma unroll
        for (int r = 0; r < 4; ++r) O[(size_t)(NP + mt * 16 + 4 * fq + r) * ldc + col] = (bf16)f2bf(acc[r] + bv);
    }
    __syncthreads();
}

constexpr size_t MiB = 1u << 20;
constexpr size_t WS_CTL = 0, CTL_ZERO_BYTES = 64 * 1024;
constexpr size_t WS_WAB = 1 * MiB;
constexpr size_t WS_WOUT = WS_WAB + (size_t)ABNP * D * 2;
constexpr size_t WS_WQ0 = WS_WOUT + (size_t)D * D * 2;
constexpr size_t WS_WQ1 = WS_WQ0 + (size_t)2048 * D * 2;
constexpr size_t WS_WINC = WS_WQ1 + (size_t)2048 * D * 2;
constexpr size_t WS_WOUTC = WS_WINC + (size_t)CN * D * 2;
constexpr size_t WS_ABUF = WS_WOUTC + (size_t)D * D * 2;
constexpr size_t WS_P = WS_ABUF + (size_t)MP * D * 2;
constexpr size_t WS_T = WS_P + (size_t)MP * ABN * 2;
constexpr size_t WS_Q = WS_T + (size_t)4 * 16384 * D + (size_t)4 * 16384 * 4;
constexpr size_t WS_A = WS_Q + (size_t)MP * 1536 * 4;
constexpr size_t WS_B = WS_A + (size_t)MP * 512 * 4;
constexpr size_t WS_O = WS_B + (size_t)MP * 512 * 4;
constexpr size_t WS_X1 = WS_O + (size_t)MP * 512 * 4;
constexpr size_t WS_G = WS_X1 + (size_t)MP * D * 4;
constexpr size_t WS_BETA = WS_G + (size_t)MP * 4 * 4;
constexpr size_t WS_GATE = WS_BETA + (size_t)MP * 4 * 4;
constexpr size_t WS_EXP = WS_GATE + (size_t)MP * 128 * 4;
constexpr size_t WS_HEND = WS_EXP + (size_t)MP * 128 * 4;
constexpr size_t WS_KEYS = WS_HEND + (size_t)3 * 4 * 64 * 512 * 4;
constexpr size_t WS_WGT = WS_KEYS + (size_t)2 * 8 * 2 * 128 * 128 * 2;
constexpr size_t WS_END = WS_WGT + (size_t)2 * 8 * 64 * 64 * 2;
constexpr size_t Q_QKVS = 0, Q_W = 1 * MiB, Q_QG = Q_W + 16 * MiB, Q_KDT = Q_QG + 16 * MiB, Q_UT = Q_KDT + 16 * MiB, Q_QK = Q_UT + 16 * MiB, Q_EGL = Q_QK + 8 * MiB, Q_END = Q_EGL + 4096;
static_assert(Q_END <= (size_t)MP * 1536 * 4, "region Q");
static_assert(WS_END <= 512 * MiB, "d_ws map");

struct MegaArgs {
    const float* in[35];
    float* out;
    unsigned char* ws;
};

__global__ void __launch_bounds__(NTH, 2) fwd_megakernel(MegaArgs ma) {
    cg::grid_group grid = cg::this_grid();
    extern __shared__ __attribute__((aligned(16))) unsigned char lds[];
    float* smem = (float*)lds;
    const int nb = gridDim.x, b0 = blockIdx.x, wave = __builtin_amdgcn_readfirstlane(threadIdx.x >> 6);
    int tid = threadIdx.x, lane = tid & 63;
    const float* x_prompt = ma.in[0];
    const float* x_sample = ma.in[1];
    const float* state_gdn = ma.in[2];
    const float* state_gdn_conv = ma.in[3];
    const float* state_lru = ma.in[4];
    const float* state_lru_conv = ma.in[5];
    const float* cache_k = ma.in[6];
    const float* cache_v = ma.in[7];
    const float* w_in_ab = ma.in[8];
    const float* gdn_conv_w = ma.in[9];
    const float* gdn_a_log = ma.in[10];
    const float* gdn_dt_bias = ma.in[11];
    const float* gdn_norm_w = ma.in[12];
    const float* lru_conv_w = ma.in[13];
    const float* lru_conv_b = ma.in[14];
    const float* lru_w_r = ma.in[15];
    const float* lru_b_r = ma.in[16];
    const float* lru_w_i = ma.in[17];
    const float* lru_b_i = ma.in[18];
    const float* lru_lam = ma.in[19];
    const float* w_out_ab = ma.in[20];
    const float* w_in_c = ma.in[21];
    const float* b_in_c = ma.in[22];
    const float* swa_sinks = ma.in[23];
    const float* w_out_c = ma.in[24];
    const float* b_out_c = ma.in[25];
    const float* rel_bias = ma.in[26];
    const float* ln_mix_g = ma.in[27];
    const float* ln_mix_b = ma.in[28];
    const float* ln_ffn_g = ma.in[29];
    const float* ln_ffn_b = ma.in[30];
    const float* peer_w_q = ma.in[31];
    const float* peer_keys = ma.in[32];
    const float* peer_u = ma.in[33];
    const float* peer_v = ma.in[34];

    float* out = ma.out;
    float* o_y = out;
    float* o_p_gdn = out + (size_t)NT * D;
    float* o_p_gdn_conv = o_p_gdn + 262144;
    float* o_p_lru = o_p_gdn_conv + 18432;
    float* o_p_lru_conv = o_p_lru + 2048;
    float* o_p_k = o_p_lru_conv + 6144;
    float* o_p_v = o_p_k + 131072;
    float* o_s_gdn = o_p_v + 131072;
    float* o_s_gdn_conv = o_s_gdn + 8388608;
    float* o_s_lru = o_s_gdn_conv + 589824;
    float* o_s_lru_conv = o_s_lru + 65536;
    float* o_s_k = o_s_lru_conv + 196608;
    float* o_s_v = o_s_k + 4194304;

    unsigned char* ws = ma.ws;
    bf16* WAB_T = (bf16*)(ws + WS_WAB); bf16* WOUT_T = (bf16*)(ws + WS_WOUT); bf16* WQ0_T = (bf16*)(ws + WS_WQ0); bf16* WQ1_T = (bf16*)(ws + WS_WQ1);
    bf16* WINC_T = (bf16*)(ws + WS_WINC); bf16* WOUTC_T = (bf16*)(ws + WS_WOUTC);
    bf16* ABUF = (bf16*)(ws + WS_ABUF);
    bf16* PROJ = (bf16*)(ws + WS_P); float* Y = (float*)(ws + WS_P); bf16* Qb = (bf16*)(ws + WS_P); bf16* PCb = (bf16*)(ws + WS_P); float* Y1 = (float*)(ws + WS_P);
    unsigned char* TAB8 = ws + WS_T; float* TSC = (float*)(ws + WS_T + (size_t)4 * 16384 * D);
    float* R_Q = (float*)(ws + WS_Q + Q_QKVS) - (size_t)NP * 1536; float* X2 = (float*)(ws + WS_A);
    GdnChunkBufs cbuf; cbuf.W = (bf16*)(ws + WS_Q + Q_W); cbuf.QG = (bf16*)(ws + WS_Q + Q_QG); cbuf.KDT = (bf16*)(ws + WS_Q + Q_KDT); cbuf.UT = (bf16*)(ws + WS_Q + Q_UT); cbuf.QK = (bf16*)(ws + WS_Q + Q_QK); cbuf.EGL = (float*)(ws + WS_Q + Q_EGL);
    bf16* Yb = (bf16*)(ws + WS_P);
    float* OUTS = (float*)(ws + WS_Q);
    float* PD = (float*)(ws + WS_P);
    bf16* KEYSB = (bf16*)(ws + WS_KEYS); bf16* WRT = (bf16*)(ws + WS_WGT); bf16* WIT = WRT + 8 * 64 * 64;
    float* HEND = (float*)(ws + WS_HEND); float* PEND = HEND + 4 * 64 * 512; float* CIN = PEND + 4 * 64 * 512;
    float* R_A = (float*)(ws + WS_A); float* R_B = (float*)(ws + WS_B); float* R_O = (float*)(ws + WS_O);
    bf16* XRES = (bf16*)(ws + WS_X1);
    float* R_G = (float*)(ws + WS_G); float* R_BETA = (float*)(ws + WS_BETA); float* R_GATE = (float*)(ws + WS_GATE); int* R_EXP = (int*)(ws + WS_EXP);

    for (int u = tid; u < (LDS_BYTES - RING_BYTES) / 4; u += NTH) ((unsigned*)(lds + RING_BYTES))[u] = 0u;
    __syncthreads();
    XcdBarrier bar = xcd_barrier_post((unsigned*)(ws + WS_CTL), (volatile LAS unsigned*)((LAS unsigned char*)lds + MISC_OFF) + 8);
#define GRID_BAR() do { xcd_barrier(bar); asm volatile("" : "+v"(tid)); lane = tid & 63; } while (0)
#define PHASE_LOOP(n) for (int vb = b0; vb < (n); vb += nb)
#define PHASE_END __syncthreads()
#define GEMM_PHASE_M(Mrows, EPI, Aptr, Btptr, Nn, ...) do { pg8::Gemm g_{(const pg8::bf16_t*)(Aptr), (const pg8::bf16_t*)(Btptr), (Mrows), (Nn), D}; pg8::StaticOrder S_; S_.init((Mrows), (Nn), nb, b0); \
        pg8::EPI E_{__VA_ARGS__}; pg8::gemm_phase<pg8::EPI, pg8::StaticOrder, true, true>((PG8_LAS unsigned char*)lds, g_, S_, E_); } while (0)
#define GEMM_PHASE(EPI, Aptr, Btptr, Nn, ...) GEMM_PHASE_M(MP, EPI, Aptr, Btptr, Nn, __VA_ARGS__)
#define GEMM_PHASE_SPLIT(Aptr, Btptr, Nn, Optr, biasptr) do { GEMM_PHASE_M(NP, EpiStoreBf16, Aptr, Btptr, Nn, Optr, Nn, biasptr, NP, Nn); \
        for (int p_ = b0; p_ < 8 * ((Nn) / 64); p_ += nb) sample_gemm_piece(Aptr, Btptr, biasptr, Optr, Nn, p_, lds); } while (0)

    {
        float* scr = smem + wave * 4096;
        const int gw = b0 * NWAVES + wave, NGW = nb * NWAVES;
        constexpr int I_AB = 16 * 97, I_OUT = 16 * 32, I_Q = 16 * 64, I_INC = 16 * 48;
        constexpr int NITEMS = I_AB + I_OUT + 2 * I_Q + I_INC + I_OUT;
        for (int it = gw; it < NITEMS; it += NGW) {
            int r = it;
            if (r < I_AB) { p0_transpose_item(w_in_ab, D, ABN, WAB_T, scr, r, lane); continue; } r -= I_AB;
            if (r < I_OUT) { p0_transpose_item(w_out_ab, D, D, WOUT_T, scr, r, lane); continue; } r -= I_OUT;
            if (r < I_Q) { p0_transpose_item(peer_w_q, D, 2048, WQ0_T, scr, r, lane); continue; } r -= I_Q;
            if (r < I_Q) { p0_transpose_item(peer_w_q + (size_t)D * 2048, D, 2048, WQ1_T, scr, r, lane); continue; } r -= I_Q;
            if (r < I_INC) { p0_transpose_item(w_in_c, D, CN, WINC_T, scr, r, lane); continue; } r -= I_INC;
            p0_transpose_item(w_out_c, D, D, WOUTC_T, scr, r, lane);
        }
        for (int it = b0 * NTH + tid; it < 2 * 8 * 64 * 8; it += nb * NTH) {
            const int gsel = it >> 12, nn = (it >> 9) & 7, dd = (it >> 3) & 63, c8 = (it & 7) * 8;
            const float* wsrc = (gsel ? lru_w_i : lru_w_r) + ((size_t)nn * 64 + c8) * 64 + dd;
            v4u o; o.x = pk2(wsrc[0], wsrc[64]); o.y = pk2(wsrc[128], wsrc[192]); o.z = pk2(wsrc[256], wsrc[320]); o.w = pk2(wsrc[384], wsrc[448]);
            *(v4u*)((gsel ? WIT : WRT) + ((size_t)nn * 64 + dd) * 64 + c8) = o;
        }
        for (int m = gw; m < MP + (ABNP - 97 * 32); m += NGW) {
            if (m < MP) row_to_bf16(m < NP ? x_prompt + (size_t)m * D : (m < NT ? x_sample + (size_t)(m - NP) * D : nullptr), ABUF + (size_t)m * D, lane);
            else row_to_bf16(nullptr, WAB_T + (size_t)(97 * 32 + (m - MP)) * D, lane);
        }
    }
    GRID_BAR();
    if (ma.out == nullptr) grid.sync();
    GEMM_PHASE(EpiStoreBf16, ABUF, WAB_T, ABNP, PROJ, ABN, nullptr, NT, ABN);
    GRID_BAR();
    constexpr int NSPLIT = 28, A_LRU = 4 * NSPLIT, A_GDN = 16 * NSPLIT, B_LRU = 4 * (64 - NSPLIT), B_GDN = 16 * (64 - NSPLIT);
    { AbPrepArgs pa;
      pa.PROJ = PROJ; pa.st_gdn_conv = state_gdn_conv; pa.st_lru_conv = state_lru_conv;
      pa.gdn_conv_w = gdn_conv_w; pa.a_log = gdn_a_log; pa.dt_bias = gdn_dt_bias;
      pa.lru_conv_w = lru_conv_w; pa.lru_conv_b = lru_conv_b; pa.w_r = lru_w_r; pa.b_r = lru_b_r; pa.w_i = lru_w_i; pa.b_i = lru_b_i; pa.lam = lru_lam;
      pa.QKV = R_Q; pa.G = R_G; pa.BETA = R_BETA; pa.LA = R_A; pa.LB = R_B;
      pa.p_gdn_conv = o_p_gdn_conv; pa.p_lru_conv = o_p_lru_conv; pa.s_gdn_conv = o_s_gdn_conv; pa.s_lru_conv = o_s_lru_conv;
      for (int v = b0; v < A_LRU + NS + A_GDN; v += nb) {
          if (v < A_LRU) { lru_prep_unit2(PROJ, lru_conv_w, lru_conv_b, WRT, WIT, lru_b_r, lru_b_i, lru_lam, R_B, R_A, HEND, PEND, o_p_lru_conv, (v / NSPLIT) * 64 + (v % NSPLIT), lds); PHASE_END; }
          else if (v < A_LRU + NS) { ab_prep(pa, NP + (v - A_LRU), smem); PHASE_END; }
          else { const int i = v - A_LRU - NS, h_ = i & 3, n_ = (i >> 2) % NSPLIT, b_ = (i >> 2) / NSPLIT;
                 gdn_prep_unit(PROJ, gdn_conv_w, gdn_a_log, gdn_dt_bias, cbuf, o_p_gdn_conv, (b_ * 64 + n_) * 4 + h_, lds); }
      } }
    GRID_BAR();
    f32x4 seqS[2]; int seqcur = 0;
    const int seq_p = (b0 & 7) + 8 * (b0 >> 5), seq_s = (b0 >> 3) & 3;
    if (b0 < 64) gdn_seq<0, NSPLIT>(cbuf, R_O, o_p_gdn, seq_p >> 2, seq_p & 3, seq_s, lds, seqS, seqcur);
    else for (int v = b0 - 64; v < B_LRU + B_GDN; v += nb - 64) {
        if (v < B_LRU) { lru_prep_unit2(PROJ, lru_conv_w, lru_conv_b, WRT, WIT, lru_b_r, lru_b_i, lru_lam, R_B, R_A, HEND, PEND, o_p_lru_conv, (v / (64 - NSPLIT)) * 64 + NSPLIT + (v % (64 - NSPLIT)), lds); PHASE_END; }
        else { const int i = v - B_LRU, h_ = i & 3, n_ = NSPLIT + (i >> 2) % (64 - NSPLIT), b_ = (i >> 2) / (64 - NSPLIT);
               gdn_prep_unit(PROJ, gdn_conv_w, gdn_a_log, gdn_dt_bias, cbuf, o_p_gdn_conv, (b_ * 64 + n_) * 4 + h_, lds); }
    }
    GRID_BAR();
    if (b0 < 64) gdn_seq<NSPLIT, 64>(cbuf, R_O, o_p_gdn, seq_p >> 2, seq_p & 3, seq_s, lds, seqS, seqcur);
    else if (b0 < 68) lru_carry(HEND, PEND, CIN, o_p_lru, b0 - 64);
    else {
        for (int v = (b0 - 68) * NWAVES + wave; v < NS * 4 * 8; v += (nb - 68) * NWAVES) gdn_step_sample_w(R_Q, R_G, R_BETA, state_gdn, R_O, o_s_gdn, v, lane);
        for (int v = b0 - 68; v < 128; v += nb - 68) lru_scan(R_A, R_B, state_lru, o_s_lru, NP, 1, NS, v);
        const int gw2 = (b0 - 68) * NWAVES + wave, NGW2 = (nb - 68) * NWAVES;
        for (int m = gw2; m < 512; m += NGW2) row_to_bf16(peer_keys + (size_t)m * D, KEYSB + (size_t)m * D, lane);
        for (int m = gw2; m < 4 * 16384; m += NGW2) {
            const int k = m >> 14, r = m & 16383;
            if (k & 1) row_to_fp8_sliced(peer_v + ((size_t)(k >> 1) * 16384 + r) * D, TAB8 + (size_t)k * 16384 * D, r, TSC + m, lane);
            else row_to_i8_sliced(peer_u + ((size_t)(k >> 1) * 16384 + r) * D, TAB8 + (size_t)k * 16384 * D, r, TSC + m, lane);
        }
    }
    GRID_BAR();
    PHASE_LOOP(NT / 8) { ab_mix_w(PROJ, R_O, R_B, R_A, CIN, gdn_norm_w, ABUF, vb * 8 + wave, lane); }
    GRID_BAR();
    GEMM_PHASE_SPLIT(ABUF, WOUT_T, D, Yb, (const float*)nullptr);
    GRID_BAR();
    PHASE_LOOP(NT / 8) { const int t = vb * 8 + wave;
        ln_res_w<false>(t < NP ? x_prompt + (size_t)t * D : x_sample + (size_t)(t - NP) * D, Yb + (size_t)t * D, ln_mix_g, ln_mix_b, ABUF + (size_t)t * D, lane); }
    GRID_BAR();
    GEMM_PHASE_SPLIT(ABUF, WQ0_T, 2048, Qb, (const float*)nullptr);
    GRID_BAR();
    if ((nb & 7) == 0) { peer_topk_stage_keys(KEYSB, b0 & 7, lds); PHASE_LOOP((NT / 64) * 8) { peer_topk4(Qb, R_EXP, R_GATE, vb >> 3, vb & 7, lds); } }
    else PHASE_LOOP((NT / 64) * 8) { peer_topk_stage_keys(KEYSB, vb & 7, lds); peer_topk4(Qb, R_EXP, R_GATE, vb >> 3, vb & 7, lds); }
    GRID_BAR();
    asm volatile("" : "+v"(tid)); lane = tid & 63;
    { const int x = b0 & 7, tg0 = b0 >> 3, tgstep = nb >> 3, nit = (NT / 8 - tg0 + tgstep - 1) / tgstep;
      peer_u_loop(ABUF, R_EXP, TAB8 + (size_t)x * 16384 * 128, PD + (size_t)x * NT * 128, x, tg0, tgstep, nit, wave, lane); }
    GRID_BAR();
    PHASE_LOOP(NT / 8) { const int t = vb * 8 + wave; peer_xk(R_EXP + (size_t)t * 128, R_GATE + (size_t)t * 128, PD + (size_t)t * 128, TSC, TSC + 16384, lane); }
    GRID_BAR();
    { const int x = b0 & 7, tg0 = b0 >> 3, tgstep = nb >> 3, nit = (NT / 8 - tg0 + tgstep - 1) / tgstep;
      peer_v_loop(R_EXP, R_GATE, TAB8 + (size_t)16384 * D + (size_t)x * 16384 * 128, OUTS, x, tg0, tgstep, nit, wave, lane); }
    GRID_BAR();
    PHASE_LOOP(NT / 8) { const int t = vb * 8 + wave; peer_xc(ABUF + (size_t)t * D, OUTS + (size_t)t * D, ln_ffn_g, ln_ffn_b, nullptr, ABUF + (size_t)t * D, XRES + (size_t)t * D, lane); }
    GRID_BAR();

    GEMM_PHASE(EpiStoreBf16, ABUF, WINC_T, CN, PCb, CN, b_in_c, NT, CN);
    GRID_BAR();
    PHASE_LOOP(1024 + 256 + (NB * 128 + NS * 128) / 2) {
        if (vb < 1024) attn_unit(PCb, rel_bias, swa_sinks, ABUF, vb, lds);
        else if (vb < 1280) swa_attn_sample(PCb, cache_k, cache_v, rel_bias, swa_sinks, ABUF, (vb - 1024) * 8 + wave, lane);
        else swa_kv_out2(PCb, cache_k, cache_v, o_p_k, o_p_v, o_s_k, o_s_v, vb - 1280);
    }
    GRID_BAR();
    GEMM_PHASE_SPLIT(ABUF, WOUTC_T, D, Yb, b_out_c);
    GRID_BAR();
    PHASE_LOOP(NT / 8) { const int t = vb * 8 + wave;
        ln_res_w<true>(XRES + (size_t)t * D, Yb + (size_t)t * D, ln_mix_g + D, ln_mix_b + D, ABUF + (size_t)t * D, lane); }
    GRID_BAR();
    GEMM_PHASE_SPLIT(ABUF, WQ1_T, 2048, Qb, (const float*)nullptr);
    GRID_BAR();
    if ((nb & 7) == 0) { peer_topk_stage_keys(KEYSB + (size_t)8 * 2 * 128 * 128, b0 & 7, lds); PHASE_LOOP((NT / 64) * 8) { peer_topk4(Qb, R_EXP, R_GATE, vb >> 3, vb & 7, lds); } }
    else PHASE_LOOP((NT / 64) * 8) { peer_topk_stage_keys(KEYSB + (size_t)8 * 2 * 128 * 128, vb & 7, lds); peer_topk4(Qb, R_EXP, R_GATE, vb >> 3, vb & 7, lds); }
    GRID_BAR();
    asm volatile("" : "+v"(tid)); lane = tid & 63;
    { const int x = b0 & 7, tg0 = b0 >> 3, tgstep = nb >> 3, nit = (NT / 8 - tg0 + tgstep - 1) / tgstep;
      peer_u_loop(ABUF, R_EXP, TAB8 + (size_t)2 * 16384 * D + (size_t)x * 16384 * 128, PD + (size_t)x * NT * 128, x, tg0, tgstep, nit, wave, lane); }
    GRID_BAR();
    PHASE_LOOP(NT / 8) { const int t = vb * 8 + wave; peer_xk(R_EXP + (size_t)t * 128, R_GATE + (size_t)t * 128, PD + (size_t)t * 128, TSC + 2 * 16384, TSC + 3 * 16384, lane); }
    GRID_BAR();
    { const int x = b0 & 7, tg0 = b0 >> 3, tgstep = nb >> 3, nit = (NT / 8 - tg0 + tgstep - 1) / tgstep;
      peer_v_loop(R_EXP, R_GATE, TAB8 + (size_t)3 * 16384 * D + (size_t)x * 16384 * 128, OUTS, x, tg0, tgstep, nit, wave, lane); }
    GRID_BAR();
    PHASE_LOOP(NT / 8) { const int t = vb * 8 + wave; peer_xc(ABUF + (size_t)t * D, OUTS + (size_t)t * D, ln_ffn_g + D, ln_ffn_b + D, o_y + (size_t)t * D, nullptr, nullptr, lane); }
}
}

extern "C" void kernel_launch(void* const* d_in, const int* in_sizes, int n_in,
                              void* d_out, int out_size, void* d_ws, size_t ws_size,
                              hipStream_t stream) {
    static int grid_blocks = 0;
    if (!grid_blocks) {
        int dev = 0, cus = 0, per_cu = 0;
        (void)hipGetDevice(&dev);
        (void)hipDeviceGetAttribute(&cus, hipDeviceAttributeMultiprocessorCount, dev);
        if (hipFuncSetAttribute((const void*)fwd_megakernel, hipFuncAttributeMaxDynamicSharedMemorySize, LDS_BYTES) != hipSuccess) { fprintf(stderr, "hipFuncSetAttribute failed\n"); grid_blocks = -1; return; }
        (void)hipOccupancyMaxActiveBlocksPerMultiprocessor(&per_cu, (const void*)fwd_megakernel, NTH, LDS_BYTES);
        if (per_cu < 1) { fprintf(stderr, "occupancy query says %d blocks per CU\n", per_cu); grid_blocks = -1; return; }
        if (cus * per_cu < 256) { fprintf(stderr, "this kernel needs 256 co-resident workgroups (device reports %d CUs x %d)\n", cus, per_cu); grid_blocks = -1; return; }
        grid_blocks = 256;
    }
    if (grid_blocks < 0) return;
    (void)hipMemsetAsync((char*)d_ws + WS_CTL, 0, CTL_ZERO_BYTES, stream);
    MegaArgs ma{};
    for (int i = 0; i < 35; ++i) ma.in[i] = (const float*)d_in[i];
    ma.out = (float*)d_out;
    ma.ws = (unsigned char*)d_ws;
    void* args[] = {&ma};
    hipError_t e = hipLaunchCooperativeKernel((void*)fwd_megakernel, dim3(grid_blocks), dim3(NTH), args, LDS_BYTES, stream);
    if (e != hipSuccess) fprintf(stderr, "cooperative launch failed: %s (grid %d)\n", hipGetErrorString(e), grid_blocks);
}
```

```cpp
#include <hip/hip_runtime.h>
#include <hip/hip_cooperative_groups.h>
#include <cstdio>
#include <cstdint>
namespace cg = cooperative_groups;

namespace pg8 {
#define PG8_LAS __attribute__((address_space(3)))
typedef unsigned short bf16_t;
typedef short bf16x8 __attribute__((ext_vector_type(8)));
typedef float f32x4 __attribute__((ext_vector_type(4)));
typedef unsigned u32x4 __attribute__((ext_vector_type(4)));
constexpr int BM = 256, BK = 64, HALF = 128, HTB = HALF * BK * 2  , STAGE_BYTES = 8 * HTB, NXCD = 8, WGM = 8;

__host__ __device__ __forceinline__ int lds_byte(int r, int c) { const int st = (r >> 4) * 2 + (c >> 5), rr = r & 15, cc = c & 31, ob = rr * 64 + cc * 2; return st * 1024 + (ob ^ (((ob >> 9) & 1) << 5)); }
__host__ __device__ __forceinline__ void stage_rc(int b, int& R, int& C) { const int st = b / 1024, sb = b % 1024, swz = sb ^ (((sb >> 9) & 1) << 5); R = (st >> 1) * 16 + swz / 64; C = (st & 1) * 32 + (swz % 64) / 2; }
__host__ __device__ __forceinline__ int perm32(int rho) { const int n = rho >> 4, i = rho & 15; return 8 * (i >> 2) + 4 * n + (i & 3); }

struct Unit { int pm, pn; };
struct Gemm { const bf16_t* A; const bf16_t* Bt; int M, N, K; };

struct StaticOrder {
    int nM, nN, nwg, G, c;
    __host__ __device__ void init(int M, int N, int G_, int c_) { nM = M / BM; nN = N / BM; nwg = nM * nN; G = G_; c = c_; }
    __host__ __device__ bool next(int i, Unit& u) const {
        const long L = (long)i * G + c; if (L >= nwg) return false;
        int wgid = (int)L; { const int q = nwg / NXCD, r = nwg % NXCD, xcd = wgid % NXCD, off = wgid / NXCD; wgid = (xcd < r ? xcd * (q + 1) : r * (q + 1) + (xcd - r) * q) + off; }
        const int nig = WGM * nN, gid = wgid / nig, fm = gid * WGM, gsz = (nM - fm) < WGM ? (nM - fm) : WGM;
        u.pm = fm + ((wgid % nig) % gsz); u.pn = (wgid % nig) / gsz; return true;
    }
    __device__ __forceinline__ void a_ready(const Unit&) const {}
    __device__ __forceinline__ void done(const Unit&) const {}
};

__device__ __forceinline__ unsigned cvt_pk_bf16(float lo, float hi) { unsigned r; asm volatile("v_cvt_pk_bf16_f32 %0, %1, %2" : "=v"(r) : "v"(lo), "v"(hi)); return r; }
template <class Epi, class Sched, bool ALIGN_EPI = false, bool SP2 = false>
__device__ __forceinline__ void gemm_phase(PG8_LAS unsigned char* lds, const Gemm g, const Sched& S, const Epi& E) {
    int tid_ = threadIdx.x; asm volatile("" : "+v"(tid_));
    const int tid = tid_, wid = __builtin_amdgcn_readfirstlane(tid >> 6), lane = tid & 63, wr = wid >> 2, wc = wid & 3, fr = lane & 15, fq = lane >> 4;
    const int K = g.K, nt = K / BK;
    unsigned voffA[2], voffB[2];
#pragma unroll
    for (int i = 0; i < 2; ++i) { int R, C; stage_rc(tid * 16 + i * 8192, R, C); const int Rb = Epi::PERM ? ((R & ~31) + perm32(R & 31)) : R;
        voffA[i] = (unsigned)(R * K + C) * 2u; voffB[i] = (unsigned)(Rb * K + C) * 2u; }
    const size_t kstep = (size_t)(BK * 2);
    const size_t hstep = (size_t)HALF * K * 2;
    const size_t tstep = 2 * hstep;
    const unsigned ldsw = (unsigned)wid * 1024u;
    const int aoff = lds_byte(wr * 64 + fr, fq * 8), boff = lds_byte(wc * 32 + fr, fq * 8);
#define PG8_SA(b, h) (((b) * 2 + (h)) * HTB)
#define PG8_SB(b, h) ((4 + (b) * 2 + (h)) * HTB)
#define PG8_STAGE(bufoff, gbase, voff) do { _Pragma("unroll") for (int _i = 0; _i < 2; ++_i) \
        __builtin_amdgcn_global_load_lds((const unsigned*)((const char*)(gbase) + (voff)[_i]), (PG8_LAS unsigned*)(lds + (bufoff) + ldsw + _i * 8192), 16, 0, 0); } while (0)
#define PG8_LDA(dst, b, h) do { _Pragma("unroll") for (int m = 0; m < 4; ++m) _Pragma("unroll") for (int k = 0; k < 2; ++k) dst[m][k] = *(const PG8_LAS bf16x8*)(lds + PG8_SA(b, h) + aoff + m * 2048 + k * 1024); } while (0)
#define PG8_LDB(dst, b, h) do { _Pragma("unroll") for (int n = 0; n < 2; ++n) _Pragma("unroll") for (int k = 0; k < 2; ++k) dst[n][k] = *(const PG8_LAS bf16x8*)(lds + PG8_SB(b, h) + boff + n * 2048 + k * 1024); } while (0)
#define PG8_MMA(ai, bj, At, Bt) do { __builtin_amdgcn_s_setprio(1); _Pragma("unroll") for (int m = 0; m < 4; ++m) _Pragma("unroll") for (int n = 0; n < 2; ++n) _Pragma("unroll") for (int k = 0; k < 2; ++k) \
        acc[ai][bj][m][n] = __builtin_amdgcn_mfma_f32_16x16x32_bf16(Bt[n][k], At[m][k], acc[ai][bj][m][n], 0, 0, 0); __builtin_amdgcn_s_setprio(0); } while (0)
#define PG8_WAIT_V(n) asm volatile("s_waitcnt vmcnt(" #n ")" ::: "memory")
#define PG8_WAIT_L(n) asm volatile("s_waitcnt lgkmcnt(" #n ")" ::: "memory")
#define PG8_BAR __builtin_amdgcn_s_barrier()
#define PG8_SCHED __builtin_amdgcn_sched_barrier(0)
    Unit cur, nxt; int ui = 0;
    if (!S.next(0, cur)) return;
    f32x4 acc[2][2][4][2];
#pragma unroll
    for (int a = 0; a < 2; ++a)
#pragma unroll
        for (int b = 0; b < 2; ++b)
#pragma unroll
            for (int m = 0; m < 4; ++m)
#pragma unroll
                for (int n = 0; n < 2; ++n) acc[a][b][m][n] = (f32x4){0.f, 0.f, 0.f, 0.f};
    bf16x8 At[4][2], B0[2][2], B1[2][2];
    const char* cA = (const char*)g.A + (size_t)cur.pm * tstep; const char* cB = (const char*)g.Bt + (size_t)cur.pn * tstep;
    S.a_ready(cur);
    if constexpr (SP2) {
        PG8_STAGE(PG8_SB(0, 0), cB, voffB); PG8_STAGE(PG8_SB(0, 1), cB + hstep, voffB); PG8_STAGE(PG8_SA(0, 0), cA, voffA); PG8_STAGE(PG8_SA(0, 1), cA + hstep, voffA);
        if (wr == 1) PG8_BAR;
        PG8_WAIT_V(2); PG8_BAR;
        PG8_STAGE(PG8_SB(1, 0), cB + kstep, voffB); PG8_STAGE(PG8_SA(1, 0), cA + kstep, voffA); PG8_STAGE(PG8_SB(1, 1), cB + hstep + kstep, voffB);
        PG8_WAIT_V(6); PG8_BAR;
    } else {
        PG8_STAGE(PG8_SB(0, 0), cB, voffB); PG8_STAGE(PG8_SA(0, 0), cA, voffA); PG8_STAGE(PG8_SB(0, 1), cB + hstep, voffB); PG8_STAGE(PG8_SA(0, 1), cA + hstep, voffA);
        if (wr == 1) PG8_BAR;
        PG8_WAIT_V(4); PG8_BAR;
        PG8_STAGE(PG8_SB(1, 0), cB + kstep, voffB); PG8_STAGE(PG8_SA(1, 0), cA + kstep, voffA); PG8_STAGE(PG8_SB(1, 1), cB + hstep + kstep, voffB);
        PG8_WAIT_V(6); PG8_BAR;
    }
    for (;;) {
        const bool has_next = S.next(ui + 1, nxt);
        const char* nA = has_next ? (const char*)g.A + (size_t)nxt.pm * tstep : cA; const char* nB = has_next ? (const char*)g.Bt + (size_t)nxt.pn * tstep : cB;
        for (int t = 0; t < nt; t += 2) {
            const bool last = (t == nt - 2);
            const char* a1 = cA + (size_t)(t + 1) * kstep;
            const char* a2 = last ? nA : cA + (size_t)(t + 2) * kstep; const char* b2 = last ? nB : cB + (size_t)(t + 2) * kstep;
            const char* a3 = a2 + kstep; const char* b3 = b2 + kstep;
            if (last && has_next) S.a_ready(nxt);
            if constexpr (SP2) {
            PG8_LDB(B0, 0, 0); PG8_LDB(B1, 0, 1); PG8_SCHED; PG8_LDA(At, 0, 0); PG8_STAGE(PG8_SA(1, 1), a1 + hstep, voffA);
            PG8_WAIT_V(8); PG8_WAIT_L(0); PG8_BAR; PG8_MMA(0, 0, At, B0); PG8_MMA(0, 1, At, B1); PG8_BAR; PG8_SCHED;
            PG8_LDA(At, 0, 1); PG8_STAGE(PG8_SB(0, 0), b2, voffB); PG8_STAGE(PG8_SB(0, 1), b2 + hstep, voffB); PG8_STAGE(PG8_SA(0, 0), a2, voffA);
            PG8_WAIT_V(8); PG8_WAIT_L(0); PG8_BAR; PG8_MMA(1, 0, At, B0); PG8_MMA(1, 1, At, B1); PG8_BAR; PG8_SCHED;
            PG8_LDB(B0, 1, 0); PG8_LDB(B1, 1, 1); PG8_SCHED; PG8_LDA(At, 1, 0); PG8_STAGE(PG8_SA(0, 1), a2 + hstep, voffA);
            PG8_WAIT_V(8); PG8_WAIT_L(0); PG8_BAR; PG8_MMA(0, 0, At, B0); PG8_MMA(0, 1, At, B1); PG8_BAR; PG8_SCHED;
            PG8_LDA(At, 1, 1); PG8_STAGE(PG8_SB(1, 0), b3, voffB); PG8_STAGE(PG8_SB(1, 1), b3 + hstep, voffB); PG8_STAGE(PG8_SA(1, 0), a3, voffA);
            PG8_WAIT_V(8); PG8_WAIT_L(0); PG8_BAR; PG8_MMA(1, 0, At, B0); PG8_MMA(1, 1, At, B1); PG8_BAR; PG8_SCHED;
            } else {
            PG8_LDB(B0, 0, 0); PG8_SCHED; PG8_LDA(At, 0, 0); PG8_STAGE(PG8_SA(1, 1), a1 + hstep, voffA);
            PG8_WAIT_L(8); PG8_BAR; PG8_WAIT_L(0); PG8_MMA(0, 0, At, B0); PG8_BAR; PG8_SCHED;
            PG8_LDB(B1, 0, 1); PG8_STAGE(PG8_SB(0, 0), b2, voffB);
            PG8_BAR; PG8_WAIT_L(0); PG8_MMA(0, 1, At, B1); PG8_BAR;
            PG8_LDA(At, 0, 1); PG8_STAGE(PG8_SA(0, 0), a2, voffA);
            PG8_BAR; PG8_WAIT_L(0); PG8_MMA(1, 0, At, B0); PG8_BAR; PG8_SCHED;
            PG8_STAGE(PG8_SB(0, 1), b2 + hstep, voffB);
            PG8_WAIT_V(6); PG8_BAR; PG8_MMA(1, 1, At, B1); PG8_BAR;
            PG8_LDB(B0, 1, 0); PG8_SCHED; PG8_LDA(At, 1, 0); PG8_STAGE(PG8_SA(0, 1), a2 + hstep, voffA);
            PG8_WAIT_L(8); PG8_BAR; PG8_WAIT_L(0); PG8_MMA(0, 0, At, B0); PG8_BAR; PG8_SCHED;
            PG8_LDB(B1, 1, 1); PG8_STAGE(PG8_SB(1, 0), b3, voffB);
            PG8_BAR; PG8_WAIT_L(0); PG8_MMA(0, 1, At, B1); PG8_BAR;
            PG8_LDA(At, 1, 1); PG8_STAGE(PG8_SA(1, 0), a3, voffA);
            PG8_BAR; PG8_WAIT_L(0); PG8_MMA(1, 0, At, B0); PG8_BAR; PG8_SCHED;
            PG8_STAGE(PG8_SB(1, 1), b3 + hstep, voffB);
            PG8_WAIT_V(6); PG8_BAR; PG8_MMA(1, 1, At, B1); PG8_BAR;
            }
        }
        if constexpr (ALIGN_EPI) { if (wr == 0) PG8_BAR; }
        if constexpr (!Epi::AFTER_DRAIN) { E(acc, cur, wr, wc, fr, fq); S.done(cur); }
        if (!has_next) break;
#pragma unroll
        for (int a = 0; a < 2; ++a)
#pragma unroll
            for (int b = 0; b < 2; ++b)
#pragma unroll
                for (int m = 0; m < 4; ++m)
#pragma unroll
                    for (int n = 0; n < 2; ++n) acc[a][b][m][n] = (f32x4){0.f, 0.f, 0.f, 0.f};
        cur = nxt; cA = nA; cB = nB; ++ui;
        if constexpr (ALIGN_EPI) { if (wr == 1) PG8_BAR; }
    }
    PG8_WAIT_V(0);
    if constexpr (!ALIGN_EPI) { if (wr == 0) PG8_BAR; }
    PG8_BAR;
    if constexpr (Epi::AFTER_DRAIN) { E.fused(acc, cur, wr, wc, fr, fq, lds, wid, lane); S.done(cur); }
#undef PG8_SA
#undef PG8_SB
#undef PG8_STAGE
#undef PG8_LDA
#undef PG8_LDB
#undef PG8_MMA
#undef PG8_WAIT_V
#undef PG8_WAIT_L
#undef PG8_BAR
#undef PG8_SCHED
}
}
namespace pg8 {
struct EpiStoreBf16 {
    static constexpr bool PERM = true, AFTER_DRAIN = false;
    bf16_t* O; int ldc; const float* bias; int m_real, n_real;
    __device__ __forceinline__ void operator()(const f32x4 (&acc)[2][2][4][2], const Unit& u, int wr, int wc, int fr, int fq) const {
        const int row0 = u.pm * BM + wr * 64 + fr, col0 = u.pn * BM + wc * 32 + 8 * fq;
#pragma unroll
        for (int bj = 0; bj < 2; ++bj) {
            const int col = col0 + bj * HALF;
            if (col >= n_real) continue;
            f32x4 b0 = (f32x4){0.f, 0.f, 0.f, 0.f}, b1 = b0;
            if (bias) { b0 = *(const f32x4*)(bias + col); b1 = *(const f32x4*)(bias + col + 4); }
#pragma unroll
            for (int ai = 0; ai < 2; ++ai)
#pragma unroll
                for (int m = 0; m < 4; ++m) {
                    const int row = row0 + ai * HALF + m * 16;
                    if (row >= m_real) continue;
                    const f32x4 v0 = acc[ai][bj][m][0] + b0, v1 = acc[ai][bj][m][1] + b1;
                    u32x4 w; w.x = cvt_pk_bf16(v0[0], v0[1]); w.y = cvt_pk_bf16(v0[2], v0[3]); w.z = cvt_pk_bf16(v1[0], v1[1]); w.w = cvt_pk_bf16(v1[2], v1[3]);
                    *(u32x4*)(O + (size_t)row * ldc + col) = w;
                }
        }
    }
};
struct EpiStoreF32 {
    static constexpr bool PERM = false, AFTER_DRAIN = false;
    float* O; int ldc; const float* bias; int m_real, n_real;
    __device__ __forceinline__ void operator()(const f32x4 (&acc)[2][2][4][2], const Unit& u, int wr, int wc, int fr, int fq) const {
        const int row0 = u.pm * BM + wr * 64 + fr, col0 = u.pn * BM + wc * 32 + 4 * fq;
#pragma unroll
        for (int bj = 0; bj < 2; ++bj)
#pragma unroll
            for (int n = 0; n < 2; ++n) {
                const int col = col0 + bj * HALF + n * 16;
                if (col >= n_real) continue;
                const f32x4 bv = bias ? *(const f32x4*)(bias + col) : (f32x4){0.f, 0.f, 0.f, 0.f};
#pragma unroll
                for (int ai = 0; ai < 2; ++ai)
#pragma unroll
                    for (int m = 0; m < 4; ++m) {
                        const int row = row0 + ai * HALF + m * 16;
                        if (row >= m_real) continue;
                        *(f32x4*)(O + (size_t)row * ldc + col) = acc[ai][bj][m][n] + bv;
                    }
            }
    }
};
}
namespace {
#define GAS __attribute__((address_space(1)))
#define LAS __attribute__((address_space(3)))
typedef unsigned short bf16;
typedef float f32x4 __attribute__((ext_vector_type(4)));
typedef unsigned v4u __attribute__((ext_vector_type(4)));
typedef unsigned v2u __attribute__((ext_vector_type(2)));

constexpr int D = 1024, NB = 4, SEQ = 4096, NP = NB * SEQ, NS = 128, NT = NP + NS, MP = 16640;
constexpr int ABN = 3080, ABNP = 3328;
constexpr int C_QKV = 0, C_Z = 1536, C_A = 2048, C_B = 2052, C_XR = 2056, C_GATE = 2568;
constexpr int CN = 1536;
constexpr float ALPHA = 1.4142135623730951f;
constexpr float LN_EPS = 1e-5f;
constexpr int NTH = 512, NWAVES = 8;
constexpr int RING_BYTES = 143360, MISC_OFF = RING_BYTES + 320, LDS_BYTES = 147456;

__device__ __forceinline__ float bf2f(bf16 v) { return __uint_as_float((unsigned)v << 16); }
__device__ __forceinline__ float bflo(unsigned w) { return __uint_as_float(w << 16); }
__device__ __forceinline__ float bfhi(unsigned w) { return __uint_as_float(w & 0xffff0000u); }
__device__ __forceinline__ unsigned f2bf(float f) { unsigned u = __float_as_uint(f); return (u + 0x7fffu + ((u >> 16) & 1u)) >> 16; }
__device__ __forceinline__ unsigned pk2(float lo, float hi) { return f2bf(lo) | (f2bf(hi) << 16); }
__device__ __forceinline__ float sigmoidf_(float x) { return 1.0f / (1.0f + expf(-x)); }
__device__ __forceinline__ float softplusf_(float x) { return fmaxf(x, 0.f) + log1pf(expf(-fabsf(x))); }
__device__ __forceinline__ float siluf_(float x) { return x / (1.0f + expf(-x)); }
__device__ __forceinline__ float geluf_(float x) { return 0.5f * x * (1.0f + tanhf(0.7978845608028654f * (x + 0.044715f * x * x * x))); }
#define DPPF(v_, ctrl_, rmask_) __int_as_float(__builtin_amdgcn_update_dpp(0, __float_as_int(v_), (ctrl_), (rmask_), 0xf, false))
__device__ __forceinline__ float wave_sum(float v) {
    v += DPPF(v, 0xB1, 0xf); v += DPPF(v, 0x4E, 0xf); v += DPPF(v, 0x141, 0xf); v += DPPF(v, 0x140, 0xf);
    v += DPPF(v, 0x142, 0xa); v += DPPF(v, 0x143, 0xc);
    return __int_as_float(__builtin_amdgcn_readlane(__float_as_int(v), 63));
}
__device__ __forceinline__ float wave_max(float v) {
    v = fmaxf(v, DPPF(v, 0xB1, 0xf)); v = fmaxf(v, DPPF(v, 0x4E, 0xf)); v = fmaxf(v, DPPF(v, 0x141, 0xf)); v = fmaxf(v, DPPF(v, 0x140, 0xf));
    { const float t = __int_as_float(__builtin_amdgcn_update_dpp(__float_as_int(v), __float_as_int(v), 0x142, 0xa, 0xf, false)); v = fmaxf(v, t); }
    { const float t = __int_as_float(__builtin_amdgcn_update_dpp(__float_as_int(v), __float_as_int(v), 0x143, 0xc, 0xf, false)); v = fmaxf(v, t); }
    return __int_as_float(__builtin_amdgcn_readlane(__float_as_int(v), 63));
}

__device__ __forceinline__ void p0_transpose_item(const float* __restrict__ W, int K, int N, bf16* __restrict__ WT, float* scr, int item, int lane) {
    const int nblk = (N + 31) / 32, kb = item / nblk, nb = item % nblk, k0 = 64 * kb, n0 = 32 * nb;
#pragma unroll 8
    for (int i = 0; i < 32; ++i) { const int kk = 2 * i + (lane >> 5), n = n0 + (lane & 31); scr[kk * 33 + (lane & 31)] = n < N ? W[(size_t)(k0 + kk) * N + n] : 0.f; }
    asm volatile("s_waitcnt lgkmcnt(0)" ::: "memory");
    const int c = lane & 7;
#pragma unroll
    for (int j = 0; j < 4; ++j) { const int n = (lane >> 3) + 8 * j; const float* s = scr + (8 * c) * 33 + n;
        v4u o; o.x = pk2(s[0 * 33], s[1 * 33]); o.y = pk2(s[2 * 33], s[3 * 33]); o.z = pk2(s[4 * 33], s[5 * 33]); o.w = pk2(s[6 * 33], s[7 * 33]);
        *(v4u*)(WT + (size_t)(n0 + n) * K + k0 + 8 * c) = o; }
    asm volatile("s_waitcnt lgkmcnt(0)" ::: "memory");
}
__device__ __forceinline__ void row_to_bf16(const float* __restrict__ xrow, bf16* __restrict__ orow, int lane) {
#pragma unroll
    for (int j = 0; j < 4; ++j) {
        f32x4 v = (f32x4){0.f, 0.f, 0.f, 0.f};
        if (xrow) v = ((const f32x4*)xrow)[lane + 64 * j];
        v2u o; o.x = pk2(v.x, v.y); o.y = pk2(v.z, v.w);
        ((v2u*)orow)[lane + 64 * j] = o;
    }
}

struct AbPrepArgs {
    const bf16* PROJ; const float* st_gdn_conv; const float* st_lru_conv;
    const float* gdn_conv_w; const float* a_log; const float* dt_bias;
    const float* lru_conv_w; const float* lru_conv_b; const float* w_r; const float* b_r; const float* w_i; const float* b_i; const float* lam;
    float* QKV; float* G; float* BETA; float* LA; float* LB;
    float* p_gdn_conv; float* p_lru_conv; float* s_gdn_conv; float* s_lru_conv;
};
__device__ __forceinline__ void ab_prep(const AbPrepArgs& a, int t, float* smem) {
    int tid = threadIdx.x; asm volatile("" : "+v"(tid));
    const int lane = tid & 63, wid = tid >> 6;
    const bool samp = t >= NP; const int sb = t - NP, pos = t % SEQ, b = t / SEQ;
    float* sq = smem;
    float* sx = smem + 1536;
    float* scl = smem + 2048;
    const bf16* prow = a.PROJ + (size_t)t * ABN;
    for (int c = tid; c < 1536; c += NTH) {
        float acc = 0.f;
#pragma unroll
        for (int i = 0; i < 4; ++i) {
            float xv;
            if (i == 3) xv = bf2f(prow[C_QKV + c]);
            else if (samp) xv = a.st_gdn_conv[((size_t)sb * 3 + i) * 1536 + c];
            else xv = (pos - 3 + i >= 0) ? bf2f(a.PROJ[(size_t)(t - 3 + i) * ABN + C_QKV + c]) : 0.f;
            acc += a.gdn_conv_w[i * 1536 + c] * xv;
        }
        sq[c] = siluf_(acc);
    }
    {
        const int c = tid;
        float acc = a.lru_conv_b[c];
#pragma unroll
        for (int i = 0; i < 4; ++i) {
            float xv;
            if (i == 3) xv = bf2f(prow[C_XR + c]);
            else if (samp) xv = a.st_lru_conv[((size_t)sb * 3 + i) * 512 + c];
            else xv = (pos - 3 + i >= 0) ? bf2f(a.PROJ[(size_t)(t - 3 + i) * ABN + C_XR + c]) : 0.f;
            acc += a.lru_conv_w[i * 512 + c] * xv;
        }
        sx[c] = acc;
    }
    __syncthreads();
    {
        const int grp = wid;
        const float v0 = sq[grp * 128 + lane], v1 = sq[grp * 128 + 64 + lane];
        const float s = wave_sum(v0 * v0 + v1 * v1);
        if (lane == 0) scl[grp] = rsqrtf(s + 1e-6f) * (grp < 4 ? 0.08838834764831845f : 1.0f);
    }
    __syncthreads();
    for (int c = tid; c < 1536; c += NTH) a.QKV[(size_t)t * 1536 + c] = (c < 1024) ? sq[c] * scl[c >> 7] : sq[c];
    if (tid < 4) {
        const float a_raw = bf2f(prow[C_A + tid]), b_raw = bf2f(prow[C_B + tid]);
        a.G[(size_t)t * 4 + tid] = -expf(a.a_log[tid]) * softplusf_(a_raw + a.dt_bias[tid]);
        a.BETA[(size_t)t * 4 + tid] = sigmoidf_(b_raw);
    }
    if (!samp) {
        if (pos >= SEQ - 3) {
            const int row = pos - (SEQ - 3);
            for (int c = tid; c < 1536; c += NTH) a.p_gdn_conv[((size_t)b * 3 + row) * 1536 + c] = bf2f(prow[C_QKV + c]);
            a.p_lru_conv[((size_t)b * 3 + row) * 512 + tid] = bf2f(prow[C_XR + tid]);
        }
    } else {
        for (int c = tid; c < 1536; c += NTH) {
            a.s_gdn_conv[((size_t)sb * 3 + 0) * 1536 + c] = a.st_gdn_conv[((size_t)sb * 3 + 1) * 1536 + c];
            a.s_gdn_conv[((size_t)sb * 3 + 1) * 1536 + c] = a.st_gdn_conv[((size_t)sb * 3 + 2) * 1536 + c];
            a.s_gdn_conv[((size_t)sb * 3 + 2) * 1536 + c] = bf2f(prow[C_QKV + c]);
        }
        {
            const int c = tid;
            a.s_lru_conv[((size_t)sb * 3 + 0) * 512 + c] = a.st_lru_conv[((size_t)sb * 3 + 1) * 512 + c];
            a.s_lru_conv[((size_t)sb * 3 + 1) * 512 + c] = a.st_lru_conv[((size_t)sb * 3 + 2) * 512 + c];
            a.s_lru_conv[((size_t)sb * 3 + 2) * 512 + c] = bf2f(prow[C_XR + c]);
        }
    }
    {
        const int c = tid, n = c >> 6, d = c & 63;
        float r = a.b_r[c], ii = a.b_i[c];
#pragma unroll 4
        for (int cc = 0; cc < 64; ++cc) {
            const float xv = sx[n * 64 + cc];
            r += xv * a.w_r[((size_t)n * 64 + cc) * 64 + d];
            ii += xv * a.w_i[((size_t)n * 64 + cc) * 64 + d];
        }
        r = sigmoidf_(r); ii = sigmoidf_(ii);
        const float log_a = -8.0f * r * softplusf_(-a.lam[c]);
        a.LA[(size_t)t * 512 + c] = expf(log_a);
        a.LB[(size_t)t * 512 + c] = sqrtf(-expm1f(2.0f * log_a)) * (ii * sx[c]);
    }
}

__device__ __forceinline__ void gdn_scan(const float* __restrict__ QKV, const float* __restrict__ G, const float* __restrict__ BETA,
                                         const float* __restrict__ S0, float* __restrict__ O, float* __restrict__ Sout, int tok_base, int T,
                                         int sl, int h, int sq, float* smem) {
    int tid = threadIdx.x; asm volatile("" : "+v"(tid));
    const int dvl = tid & 31, kg = tid >> 5;
    const int dv = sl * 32 + dvl;
    float (*red1)[32] = (float (*)[32])smem;
    float (*red2)[32] = (float (*)[32])(smem + 512);
    float S[8];
#pragma unroll
    for (int i = 0; i < 8; ++i) S[i] = S0 ? S0[(((size_t)sq * 4 + h) * 128 + kg * 8 + i) * 128 + dv] : 0.f;
    float kk[8], qq[8], vv, g, be;
    {
        const size_t tok = (size_t)tok_base + (size_t)sq * T;
        const float* row = QKV + tok * 1536;
#pragma unroll
        for (int i = 0; i < 8; ++i) { kk[i] = row[512 + h * 128 + kg * 8 + i]; qq[i] = row[h * 128 + kg * 8 + i]; }
        vv = row[1024 + h * 128 + dv]; g = G[tok * 4 + h]; be = BETA[tok * 4 + h];
    }
    for (int t = 0; t < T; ++t) {
        const size_t tok = (size_t)tok_base + (size_t)sq * T + t;
        float nk[8], nq[8], nv = 0.f, ng = 0.f, nb = 0.f;
        if (t + 1 < T) {
            const float* row = QKV + (tok + 1) * 1536;
#pragma unroll
            for (int i = 0; i < 8; ++i) { nk[i] = row[512 + h * 128 + kg * 8 + i]; nq[i] = row[h * 128 + kg * 8 + i]; }
            nv = row[1024 + h * 128 + dv]; ng = G[(tok + 1) * 4 + h]; nb = BETA[(tok + 1) * 4 + h];
        } else {
#pragma unroll
            for (int i = 0; i < 8; ++i) { nk[i] = 0.f; nq[i] = 0.f; }
        }
        const float al = expf(g);
        float p = 0.f;
#pragma unroll
        for (int i = 0; i < 8; ++i) { S[i] *= al; p += S[i] * kk[i]; }
        red1[kg][dvl] = p;
        __syncthreads();
        float ks = 0.f;
#pragma unroll
        for (int j = 0; j < 16; ++j) ks += red1[j][dvl];
        const float vn = be * (vv - ks);
        float o = 0.f;
#pragma unroll
        for (int i = 0; i < 8; ++i) { S[i] += kk[i] * vn; o += S[i] * qq[i]; }
        red2[kg][dvl] = o;
        __syncthreads();
        if (kg == 0) {
            float os = 0.f;
#pragma unroll
            for (int j = 0; j < 16; ++j) os += red2[j][dvl];
            O[tok * 512 + h * 128 + dv] = os;
        }
#pragma unroll
        for (int i = 0; i < 8; ++i) { kk[i] = nk[i]; qq[i] = nq[i]; }
        vv = nv; g = ng; be = nb;
    }
#pragma unroll
    for (int i = 0; i < 8; ++i) Sout[(((size_t)sq * 4 + h) * 128 + kg * 8 + i) * 128 + dv] = S[i];
}


__device__ __forceinline__ void gdn_step_sample_w(const float* __restrict__ QKV, const float* __restrict__ G, const float* __restrict__ BETA, const float* __restrict__ S0,
                                                  float* __restrict__ O, float* __restrict__ Sout, int item, int lane) {
    const int sl = item & 7, h = (item >> 3) & 3, sb = item >> 5, fr = lane & 15, fq = lane >> 4;
    const size_t tok = (size_t)NP + sb;
    const float* row = QKV + tok * 1536;
    const size_t sbase = (((size_t)sb * 4 + h) * 128 + fq * 32) * 128 + sl * 16 + fr;
    float S[32], kk[32], qq[32];
#pragma unroll
    for (int i = 0; i < 32; ++i) S[i] = S0[sbase + (size_t)i * 128];
#pragma unroll
    for (int i4 = 0; i4 < 8; ++i4) { const f32x4 k4 = *(const f32x4*)(row + 512 + h * 128 + fq * 32 + i4 * 4), q4 = *(const f32x4*)(row + h * 128 + fq * 32 + i4 * 4);
        kk[i4 * 4 + 0] = k4.x; kk[i4 * 4 + 1] = k4.y; kk[i4 * 4 + 2] = k4.z; kk[i4 * 4 + 3] = k4.w; qq[i4 * 4 + 0] = q4.x; qq[i4 * 4 + 1] = q4.y; qq[i4 * 4 + 2] = q4.z; qq[i4 * 4 + 3] = q4.w; }
    const float vv = row[1024 + h * 128 + sl * 16 + fr], al = expf(G[tok * 4 + h]), be = BETA[tok * 4 + h];
    float p = 0.f;
#pragma unroll
    for (int i = 0; i < 32; ++i) { S[i] *= al; p += S[i] * kk[i]; }
    p += __shfl_xor(p, 16); p += __shfl_xor(p, 32);
    const float vn = be * (vv - p);
    float o = 0.f;
#pragma unroll
    for (int i = 0; i < 32; ++i) { S[i] += kk[i] * vn; o += S[i] * qq[i]; }
    o += __shfl_xor(o, 16); o += __shfl_xor(o, 32);
    if (fq == 0) O[tok * 512 + h * 128 + sl * 16 + fr] = o;
#pragma unroll
    for (int i = 0; i < 32; ++i) Sout[sbase + (size_t)i * 128] = S[i];
}

__device__ __forceinline__ void lru_scan(const float* __restrict__ LA, float* __restrict__ LB, const float* __restrict__ h0,
                                         float* __restrict__ hlast, int tok_base, int T, int nseq, int bx) {
    int tx_ = threadIdx.x; asm volatile("" : "+v"(tx_));
    const int idx = bx * NTH + tx_;
    if (idx >= nseq * 512) return;
    const int sq = idx / 512, c = idx % 512;
    float h = h0 ? h0[(size_t)sq * 512 + c] : 0.f;
    const size_t base = ((size_t)tok_base + (size_t)sq * T) * 512 + c;
#pragma unroll 8
    for (int t = 0; t < T; ++t) {
        const size_t o = base + (size_t)t * 512;
        h = LA[o] * h + LB[o];
        LB[o] = h;
    }
    hlast[(size_t)sq * 512 + c] = h;
}

__device__ __forceinline__ void ab_mix_w(const bf16* __restrict__ PROJ, const float* __restrict__ O, const float* __restrict__ H, const float* __restrict__ P, const float* __restrict__ CIN,
                                         const float* __restrict__ norm_w, bf16* __restrict__ MIX, int t, int lane) {
    const bf16* prow = PROJ + (size_t)t * ABN;
    {
        const int c0 = lane * 8;
        const f32x4 o0 = *(const f32x4*)(O + (size_t)t * 512 + c0), o1 = *(const f32x4*)(O + (size_t)t * 512 + c0 + 4);
        const v4u zb = *(const v4u*)(prow + C_Z + c0);
        const f32x4 w0 = *(const f32x4*)(norm_w + (c0 & 127)), w1 = *(const f32x4*)(norm_w + (c0 & 127) + 4);
        float ss = (o0.x * o0.x + o0.y * o0.y) + (o0.z * o0.z + o0.w * o0.w) + (o1.x * o1.x + o1.y * o1.y) + (o1.z * o1.z + o1.w * o1.w);
        ss += DPPF(ss, 0xB1, 0xf); ss += DPPF(ss, 0x4E, 0xf); ss += DPPF(ss, 0x141, 0xf); ss += DPPF(ss, 0x140, 0xf);
        const float sc = rsqrtf(ss * (1.0f / 128.0f) + 1e-6f);
        const float z[8] = {bflo(zb.x), bfhi(zb.x), bflo(zb.y), bfhi(zb.y), bflo(zb.z), bfhi(zb.z), bflo(zb.w), bfhi(zb.w)};
        const float ov[8] = {o0.x, o0.y, o0.z, o0.w, o1.x, o1.y, o1.z, o1.w}, wv[8] = {w0.x, w0.y, w0.z, w0.w, w1.x, w1.y, w1.z, w1.w};
        float r[8];
#pragma unroll
        for (int i = 0; i < 8; ++i) r[i] = ov[i] * sc * wv[i] * (z[i] * __frcp_rn(1.0f + __expf(-z[i])));
        v4u ob; ob.x = pk2(r[0], r[1]); ob.y = pk2(r[2], r[3]); ob.z = pk2(r[4], r[5]); ob.w = pk2(r[6], r[7]);
        *(v4u*)(MIX + (size_t)t * 1024 + c0) = ob;
    }
    {
        const int c0 = lane * 8;
        const v4u gb = *(const v4u*)(prow + C_GATE + c0);
        f32x4 h0 = *(const f32x4*)(H + (size_t)t * 512 + c0), h1 = *(const f32x4*)(H + (size_t)t * 512 + c0 + 4);
        if (t < NP) {
            const f32x4 p0 = *(const f32x4*)(P + (size_t)t * 512 + c0), p1 = *(const f32x4*)(P + (size_t)t * 512 + c0 + 4);
            const f32x4 ci0 = *(const f32x4*)(CIN + (size_t)(t >> 6) * 512 + c0), ci1 = *(const f32x4*)(CIN + (size_t)(t >> 6) * 512 + c0 + 4);
            h0 = h0 + p0 * ci0; h1 = h1 + p1 * ci1;
        }
        const float gv[8] = {bflo(gb.x), bfhi(gb.x), bflo(gb.y), bfhi(gb.y), bflo(gb.z), bfhi(gb.z), bflo(gb.w), bfhi(gb.w)}, hv[8] = {h0.x, h0.y, h0.z, h0.w, h1.x, h1.y, h1.z, h1.w};
        float r[8];
#pragma unroll
        for (int i = 0; i < 8; ++i) r[i] = geluf_(gv[i]) * hv[i];
        v4u ob; ob.x = pk2(r[0], r[1]); ob.y = pk2(r[2], r[3]); ob.z = pk2(r[4], r[5]); ob.w = pk2(r[6], r[7]);
        *(v4u*)(MIX + (size_t)t * 1024 + 512 + c0) = ob;
    }
}

template <bool XBF>
__device__ __forceinline__ void ln_res_w(const void* __restrict__ xrow_, const bf16* __restrict__ yrow, const float* __restrict__ g, const float* __restrict__ bta,
                                         bf16* __restrict__ obrow, int lane) {
    f32x4 v[4]; float s = 0.f;
#pragma unroll
    for (int j = 0; j < 4; ++j) {
        f32x4 x4;
        if (XBF) { const v2u xb = ((const v2u*)xrow_)[lane + 64 * j]; x4 = (f32x4){bflo(xb.x), bfhi(xb.x), bflo(xb.y), bfhi(xb.y)}; }
        else x4 = ((const f32x4*)xrow_)[lane + 64 * j];
        const v2u yb = ((const v2u*)yrow)[lane + 64 * j];
        const f32x4 y4 = (f32x4){bflo(yb.x), bfhi(yb.x), bflo(yb.y), bfhi(yb.y)}; v[j] = x4 * ALPHA + y4; s += (v[j].x + v[j].y) + (v[j].z + v[j].w); }
    const float mean = wave_sum(s) * (1.0f / 1024.0f); float q = 0.f;
#pragma unroll
    for (int j = 0; j < 4; ++j) { v[j] = v[j] - mean; q += (v[j].x * v[j].x + v[j].y * v[j].y) + (v[j].z * v[j].z + v[j].w * v[j].w); }
    const float rs = rsqrtf(wave_sum(q) * (1.0f / 1024.0f) + LN_EPS);
#pragma unroll
    for (int j = 0; j < 4; ++j) {
        const f32x4 g4 = ((const f32x4*)g)[lane + 64 * j], b4 = ((const f32x4*)bta)[lane + 64 * j];
        const f32x4 o = v[j] * rs * g4 + b4;
        v2u ob; ob.x = pk2(o.x, o.y); ob.y = pk2(o.z, o.w);
        ((v2u*)obrow)[lane + 64 * j] = ob;
    }
}

__device__ __forceinline__ void peer_topk(const bf16* __restrict__ Q, const float* __restrict__ keys, int* __restrict__ EXP, float* __restrict__ GATE,
                                          int tg, int h, float* smem) {
    const int tid = threadIdx.x, cn = tid & 255, c = cn >> 7, n = cn & 127, th = tid >> 8;
    float (*sq)[256] = (float (*)[256])smem;
    float (*ss)[257] = (float (*)[257])(smem + 32 * 256);
    float (*tvs)[2][16] = (float (*)[2][16])(smem + 32 * 256 + 32 * 257 + 32);
    int (*tis)[2][16] = (int (*)[2][16])(smem + 32 * 256 + 32 * 257 + 32 + 1024);
    for (int i = tid; i < 32 * 256; i += NTH) {
        const int tk = i >> 8, col = i & 255;
        sq[tk][col] = bf2f(Q[(size_t)(tg * 32 + tk) * 2048 + h * 256 + col]);
    }
    __syncthreads();
    float acc[16];
#pragma unroll
    for (int i = 0; i < 16; ++i) acc[i] = 0.f;
    const float* krow = keys + (((size_t)h * 2 + c) * 128 + n) * 128;
    for (int d4 = 0; d4 < 32; ++d4) {
        const float4 kv = *(const float4*)(krow + d4 * 4);
#pragma unroll
        for (int tk = 0; tk < 16; ++tk) {
            const float4 qv = *(const float4*)&sq[th * 16 + tk][c * 128 + d4 * 4];
            acc[tk] += qv.x * kv.x + qv.y * kv.y + qv.z * kv.z + qv.w * kv.w;
        }
    }
#pragma unroll
    for (int tk = 0; tk < 16; ++tk) ss[th * 16 + tk][cn] = acc[tk];
    __syncthreads();
    if (tid < 64) {
        const int tk = tid >> 1, cc = tid & 1;
        float tv[16]; int ti[16];
#pragma unroll
        for (int j = 0; j < 16; ++j) { tv[j] = -INFINITY; ti[j] = 0; }
        for (int nn = 0; nn < 128; ++nn) {
            float x = ss[tk][cc * 128 + nn]; int xi = nn;
#pragma unroll
            for (int j = 0; j < 16; ++j) {
                const bool gt = x > tv[j];
                const float tf = tv[j]; const int tj = ti[j];
                tv[j] = gt ? x : tf; ti[j] = gt ? xi : tj;
                x = gt ? tf : x; xi = gt ? tj : xi;
            }
        }
#pragma unroll
        for (int j = 0; j < 16; ++j) { tvs[tk][cc][j] = tv[j]; tis[tk][cc][j] = ti[j]; }
    }
    __syncthreads();
    if (tid < 32) {
        const int tk = tid;
        float bv[16]; int bi[16];
#pragma unroll
        for (int j = 0; j < 16; ++j) { bv[j] = -INFINITY; bi[j] = 0; }
        for (int i = 0; i < 16; ++i)
            for (int jj = 0; jj < 16; ++jj) {
                float x = tvs[tk][0][i] + tvs[tk][1][jj]; int xi = tis[tk][0][i] * 128 + tis[tk][1][jj];
#pragma unroll
                for (int j = 0; j < 16; ++j) {
                    const bool gt = x > bv[j];
                    const float tf = bv[j]; const int tj = bi[j];
                    bv[j] = gt ? x : tf; bi[j] = gt ? xi : tj;
                    x = gt ? tf : x; xi = gt ? tj : xi;
                }
            }
        float e[16], sum = 0.f;
#pragma unroll
        for (int j = 0; j < 16; ++j) { e[j] = expf(bv[j] - bv[0]); sum += e[j]; }
        const float inv = 1.0f / sum;
        const size_t o = (size_t)(tg * 32 + tk) * 128 + h * 16;
#pragma unroll
        for (int j = 0; j < 16; ++j) { EXP[o + j] = bi[j]; GATE[o + j] = e[j] * inv; }
    }
}

__device__ __forceinline__ void peer_expert(const float* __restrict__ X, const int* __restrict__ EXP, const float* __restrict__ GATE,
                                            const float* __restrict__ U, const float* __restrict__ V,
                                            const float* __restrict__ g, const float* __restrict__ bta, float* __restrict__ out, bf16* __restrict__ outb, int t, float* smem) {
    const int tid = threadIdx.x, lane = tid & 63, wid = tid >> 6;
    float (*accs)[1024] = (float (*)[1024])smem;
    float* sred = smem + 8192;
    const float4* xr = (const float4*)(X + (size_t)t * D);
    float4 xv[4];
#pragma unroll
    for (int j = 0; j < 4; ++j) xv[j] = xr[lane + 64 * j];
    float4 acc[4];
#pragma unroll
    for (int j = 0; j < 4; ++j) acc[j] = make_float4(0.f, 0.f, 0.f, 0.f);
    for (int e = 0; e < 16; ++e) {
        const int id = EXP[(size_t)t * 128 + wid * 16 + e];
        const float gt = GATE[(size_t)t * 128 + wid * 16 + e];
        const float4* ur = (const float4*)(U + (size_t)id * D);
        const float4* vr = (const float4*)(V + (size_t)id * D);
        float4 uv[4], vv[4];
#pragma unroll
        for (int j = 0; j < 4; ++j) { uv[j] = ur[lane + 64 * j]; vv[j] = vr[lane + 64 * j]; }
        float dot = 0.f;
#pragma unroll
        for (int j = 0; j < 4; ++j) dot += uv[j].x * xv[j].x + uv[j].y * xv[j].y + uv[j].z * xv[j].z + uv[j].w * xv[j].w;
        dot = wave_sum(dot);
        const float cf = gt * geluf_(dot);
#pragma unroll
        for (int j = 0; j < 4; ++j) { acc[j].x += cf * vv[j].x; acc[j].y += cf * vv[j].y; acc[j].z += cf * vv[j].z; acc[j].w += cf * vv[j].w; }
    }
#pragma unroll
    for (int j = 0; j < 4; ++j) *(float4*)&accs[wid][(lane + 64 * j) * 4] = acc[j];
    __syncthreads();
    float v[2];
#pragma unroll
    for (int i = 0; i < 2; ++i) {
        const int c = tid * 2 + i;
        float s = 0.f;
#pragma unroll
        for (int w = 0; w < 8; ++w) s += accs[w][c];
        v[i] = ALPHA * X[(size_t)t * D + c] + s;
    }
    float s = wave_sum(v[0] + v[1]);
    if (lane == 0) sred[wid] = s;
    __syncthreads();
    float mean = 0.f;
#pragma unroll
    for (int w = 0; w < 8; ++w) mean += sred[w];
    mean *= (1.0f / 1024.0f);
    __syncthreads();
    const float d0 = v[0] - mean, d1 = v[1] - mean;
    float q = wave_sum(d0 * d0 + d1 * d1);
    if (lane == 0) sred[wid] = q;
    __syncthreads();
    float var = 0.f;
#pragma unroll
    for (int w = 0; w < 8; ++w) var += sred[w];
    const float rs = rsqrtf(var * (1.0f / 1024.0f) + LN_EPS);
    const float o0 = d0 * rs * g[tid * 2] + bta[tid * 2], o1 = d1 * rs * g[tid * 2 + 1] + bta[tid * 2 + 1];
    *(float2*)(out + (size_t)t * D + tid * 2) = make_float2(o0, o1);
    if (outb) *(unsigned*)(outb + (size_t)t * D + tid * 2) = pk2(o0, o1);
}


typedef __bf16 bf16x2_t __attribute__((ext_vector_type(2)));
__device__ __forceinline__ float dot2bf(unsigned w, unsigned x, float acc) { return __builtin_amdgcn_fdot2_f32_bf16(__builtin_bit_cast(bf16x2_t, w), __builtin_bit_cast(bf16x2_t, x), acc, false); }
typedef float f32x2_t __attribute__((ext_vector_type(2)));
__device__ __forceinline__ void row_to_fp8(const float* __restrict__ xrow, unsigned char* __restrict__ orow, float* __restrict__ scale, int lane) {
    f32x4 v[4]; float am = 0.f;
#pragma unroll
    for (int j = 0; j < 4; ++j) { v[j] = *(const f32x4*)(xrow + lane * 16 + j * 4); am = fmaxf(am, fmaxf(fmaxf(fabsf(v[j].x), fabsf(v[j].y)), fmaxf(fabsf(v[j].z), fabsf(v[j].w)))); }
    am = wave_max(am);
    const float s = am > 0.f ? am * (1.0f / 448.0f) : 1.0f, inv = 1.0f / s;
    v4u o;
    unsigned w;
    w = 0u; w = __builtin_amdgcn_cvt_pk_fp8_f32(v[0].x * inv, v[0].y * inv, w, false); w = __builtin_amdgcn_cvt_pk_fp8_f32(v[0].z * inv, v[0].w * inv, w, true); o.x = w;
    w = 0u; w = __builtin_amdgcn_cvt_pk_fp8_f32(v[1].x * inv, v[1].y * inv, w, false); w = __builtin_amdgcn_cvt_pk_fp8_f32(v[1].z * inv, v[1].w * inv, w, true); o.y = w;
    w = 0u; w = __builtin_amdgcn_cvt_pk_fp8_f32(v[2].x * inv, v[2].y * inv, w, false); w = __builtin_amdgcn_cvt_pk_fp8_f32(v[2].z * inv, v[2].w * inv, w, true); o.z = w;
    w = 0u; w = __builtin_amdgcn_cvt_pk_fp8_f32(v[3].x * inv, v[3].y * inv, w, false); w = __builtin_amdgcn_cvt_pk_fp8_f32(v[3].z * inv, v[3].w * inv, w, true); o.w = w;
    *(v4u*)(orow + lane * 16) = o;
    if (lane == 0) *scale = s;
}
#define PE_LOAD(UB, VB, grp) do { _Pragma("unroll") for (int i_ = 0; i_ < 4; ++i_) { const int e_ = (grp) * 4 + i_; \
        const int id_ = __builtin_amdgcn_readlane(e_ < 64 ? id0 : id1, e_ & 63); \
        const unsigned so_ = (unsigned)id_ * 1024u; \
        UB[i_] = __builtin_amdgcn_raw_buffer_load_b128(ursrc, voff, so_, 0); VB[i_] = __builtin_amdgcn_raw_buffer_load_b128(vrsrc, voff, so_, 0); } } while (0)
#define PE_DOT4(w, k) do { const f32x2_t l_ = __builtin_amdgcn_cvt_pk_f32_fp8((w), false), h_ = __builtin_amdgcn_cvt_pk_f32_fp8((w), true); \
        a_ += l_.x * xv[(k) * 4 + 0]; b_ += l_.y * xv[(k) * 4 + 1]; a_ += h_.x * xv[(k) * 4 + 2]; b_ += h_.y * xv[(k) * 4 + 3]; } while (0)
#define PE_AXPY4(w, k) do { const f32x2_t l_ = __builtin_amdgcn_cvt_pk_f32_fp8((w), false), h_ = __builtin_amdgcn_cvt_pk_f32_fp8((w), true); \
        acc[(k) * 4 + 0] += cf_ * l_.x; acc[(k) * 4 + 1] += cf_ * l_.y; acc[(k) * 4 + 2] += cf_ * h_.x; acc[(k) * 4 + 3] += cf_ * h_.y; } while (0)
#define PE_COMP(UB, VB, grp) do { float d_[4]; \
        _Pragma("unroll") for (int i_ = 0; i_ < 4; ++i_) { float a_ = 0.f, b_ = 0.f; PE_DOT4(UB[i_].x, 0); PE_DOT4(UB[i_].y, 1); PE_DOT4(UB[i_].z, 2); PE_DOT4(UB[i_].w, 3); d_[i_] = a_ + b_; } \
          \
        float s0_ = hi32 ? d_[2] : d_[0], t0_ = hi32 ? d_[0] : d_[2]; s0_ += __shfl_xor(t0_, 32); \
        float s1_ = hi32 ? d_[3] : d_[1], t1_ = hi32 ? d_[1] : d_[3]; s1_ += __shfl_xor(t1_, 32); \
        float r_ = hi16 ? s1_ : s0_, t2_ = hi16 ? s0_ : s1_; r_ += __shfl_xor(t2_, 16); \
        r_ += __shfl_xor(r_, 8); r_ += __shfl_xor(r_, 4); r_ += __shfl_xor(r_, 2); r_ += __shfl_xor(r_, 1); \
          \
        const int esel_ = (grp) * 4 + (lane >> 4); \
        const float su_ = __shfl(esel_ < 64 ? su0 : su1, esel_ & 63), gv_ = __shfl(esel_ < 64 ? gs0 : gs1, esel_ & 63); \
        const float cfl_ = geluf_(r_ * su_) * gv_; \
        _Pragma("unroll") for (int i_ = 0; i_ < 4; ++i_) { \
            const float cf_ = __uint_as_float(__builtin_amdgcn_readlane(__float_as_uint(cfl_), 16 * i_)); \
            PE_AXPY4(VB[i_].x, 0); PE_AXPY4(VB[i_].y, 1); PE_AXPY4(VB[i_].z, 2); PE_AXPY4(VB[i_].w, 3); } } while (0)
__device__ __forceinline__ void peer_expert_w(const float* __restrict__ xrow, const int* __restrict__ exr, const float* __restrict__ gar,
                                              const unsigned char* __restrict__ U, const unsigned char* __restrict__ V, const float* __restrict__ SU, const float* __restrict__ SV,
                                              const float* __restrict__ g, const float* __restrict__ bta, float* __restrict__ orow, bf16* __restrict__ obrow, int lane) {
    const bool hi32 = (lane & 32) != 0, hi16 = (lane & 16) != 0;
    const __amdgpu_buffer_rsrc_t ursrc = __builtin_amdgcn_make_buffer_rsrc((void*)U, 0, 16384 * 1024, 0x00020000);
    const __amdgpu_buffer_rsrc_t vrsrc = __builtin_amdgcn_make_buffer_rsrc((void*)V, 0, 16384 * 1024, 0x00020000);
    const int voff = lane * 16;
    float xv[16];
#pragma unroll
    for (int j = 0; j < 4; ++j) { const f32x4 t = *(const f32x4*)(xrow + lane * 16 + j * 4); xv[j * 4 + 0] = t.x; xv[j * 4 + 1] = t.y; xv[j * 4 + 2] = t.z; xv[j * 4 + 3] = t.w; }
    const int id0 = exr[lane], id1 = exr[64 + lane];
    const float su0 = SU[id0], su1 = SU[id1];
    const float gs0 = gar[lane] * SV[id0], gs1 = gar[64 + lane] * SV[id1];
    float acc[16];
#pragma unroll
    for (int i = 0; i < 16; ++i) acc[i] = 0.f;
    v4u ua[4], va[4], ub[4], vb[4];
    PE_LOAD(ua, va, 0);
#pragma unroll 1
    for (int grp = 0; grp < 32; grp += 2) {
        PE_LOAD(ub, vb, grp + 1);
        PE_COMP(ua, va, grp);
        if (grp + 2 < 32) PE_LOAD(ua, va, grp + 2);
        PE_COMP(ub, vb, grp + 1);
    }
    float v[16]; float s = 0.f;
#pragma unroll
    for (int i = 0; i < 16; ++i) { v[i] = ALPHA * xv[i] + acc[i]; s += v[i]; }
    const float mean = wave_sum(s) * (1.0f / 1024.0f); float q = 0.f;
#pragma unroll
    for (int i = 0; i < 16; ++i) { v[i] -= mean; q += v[i] * v[i]; }
    const float rs = rsqrtf(wave_sum(q) * (1.0f / 1024.0f) + LN_EPS);
    float o[16];
#pragma unroll
    for (int j = 0; j < 4; ++j) {
        const f32x4 g4 = *(const f32x4*)(g + lane * 16 + j * 4), b4 = *(const f32x4*)(bta + lane * 16 + j * 4);
        o[j * 4 + 0] = v[j * 4 + 0] * rs * g4.x + b4.x; o[j * 4 + 1] = v[j * 4 + 1] * rs * g4.y + b4.y; o[j * 4 + 2] = v[j * 4 + 2] * rs * g4.z + b4.z; o[j * 4 + 3] = v[j * 4 + 3] * rs * g4.w + b4.w;
        *(f32x4*)(orow + lane * 16 + j * 4) = (f32x4){o[j * 4 + 0], o[j * 4 + 1], o[j * 4 + 2], o[j * 4 + 3]};
    }
    if (obrow) {
        v4u w0, w1; w0.x = pk2(o[0], o[1]); w0.y = pk2(o[2], o[3]); w0.z = pk2(o[4], o[5]); w0.w = pk2(o[6], o[7]); w1.x = pk2(o[8], o[9]); w1.y = pk2(o[10], o[11]); w1.z = pk2(o[12], o[13]); w1.w = pk2(o[14], o[15]);
        *(v4u*)(obrow + lane * 16) = w0; *(v4u*)(obrow + lane * 16 + 8) = w1;
    }
}


__device__ __forceinline__ void peer_expert_blk(const float* __restrict__ xrow, const int* __restrict__ exr, const float* __restrict__ gar,
                                                const unsigned char* __restrict__ U, const unsigned char* __restrict__ V, const float* __restrict__ SU, const float* __restrict__ SV,
                                                const float* __restrict__ g, const float* __restrict__ bta, float* __restrict__ orow, bf16* __restrict__ obrow, int lane, int wave, float* smem) {
    const bool hi32 = (lane & 32) != 0, hi16 = (lane & 16) != 0;
    const __amdgpu_buffer_rsrc_t ursrc = __builtin_amdgcn_make_buffer_rsrc((void*)U, 0, 16384 * 1024, 0x00020000);
    const __amdgpu_buffer_rsrc_t vrsrc = __builtin_amdgcn_make_buffer_rsrc((void*)V, 0, 16384 * 1024, 0x00020000);
    const int voff = lane * 16;
    float xv[16];
#pragma unroll
    for (int j = 0; j < 4; ++j) { const f32x4 t = *(const f32x4*)(xrow + lane * 16 + j * 4); xv[j * 4 + 0] = t.x; xv[j * 4 + 1] = t.y; xv[j * 4 + 2] = t.z; xv[j * 4 + 3] = t.w; }
    const int id0 = exr[lane], id1 = exr[64 + lane];
    const float su0 = SU[id0], su1 = SU[id1];
    const float gs0 = gar[lane] * SV[id0], gs1 = gar[64 + lane] * SV[id1];
    float acc[16];
#pragma unroll
    for (int i = 0; i < 16; ++i) acc[i] = 0.f;
    v4u ua[4], va[4], ub[4], vb[4];
    const int g0 = wave * 4;
    PE_LOAD(ua, va, g0); PE_LOAD(ub, vb, g0 + 1);
    PE_COMP(ua, va, g0); PE_LOAD(ua, va, g0 + 2);
    PE_COMP(ub, vb, g0 + 1); PE_LOAD(ub, vb, g0 + 3);
    PE_COMP(ua, va, g0 + 2);
    PE_COMP(ub, vb, g0 + 3);
    float* accs = smem;
    float* sred = smem + 8192;
#pragma unroll
    for (int j = 0; j < 4; ++j) *(f32x4*)(accs + wave * 1024 + lane * 16 + j * 4) = (f32x4){acc[j * 4 + 0], acc[j * 4 + 1], acc[j * 4 + 2], acc[j * 4 + 3]};
    __syncthreads();
    const int tid = wave * 64 + lane;
    float v0 = ALPHA * xrow[tid * 2], v1 = ALPHA * xrow[tid * 2 + 1];
#pragma unroll
    for (int w = 0; w < 8; ++w) { v0 += accs[w * 1024 + tid * 2]; v1 += accs[w * 1024 + tid * 2 + 1]; }
    const float s = wave_sum(v0 + v1);
    if (lane == 0) sred[wave] = s;
    __syncthreads();
    float mean = 0.f;
#pragma unroll
    for (int w = 0; w < 8; ++w) mean += sred[w];
    mean *= (1.0f / 1024.0f);
    __syncthreads();
    const float d0 = v0 - mean, d1 = v1 - mean;
    const float q = wave_sum(d0 * d0 + d1 * d1);
    if (lane == 0) sred[wave] = q;
    __syncthreads();
    float var = 0.f;
#pragma unroll
    for (int w = 0; w < 8; ++w) var += sred[w];
    const float rs = rsqrtf(var * (1.0f / 1024.0f) + LN_EPS);
    const float o0 = d0 * rs * g[tid * 2] + bta[tid * 2], o1 = d1 * rs * g[tid * 2 + 1] + bta[tid * 2 + 1];
    *(float2*)(orow + tid * 2) = make_float2(o0, o1);
    if (obrow) *(unsigned*)(obrow + tid * 2) = pk2(o0, o1);
    __syncthreads();
}

__device__ __forceinline__ void row_to_fp8_sliced(const float* __restrict__ xrow, unsigned char* __restrict__ tab, int r, float* __restrict__ scale, int lane) {
    f32x4 v[4]; float am = 0.f;
#pragma unroll
    for (int j = 0; j < 4; ++j) { v[j] = *(const f32x4*)(xrow + lane * 16 + j * 4); am = fmaxf(am, fmaxf(fmaxf(fabsf(v[j].x), fabsf(v[j].y)), fmaxf(fabsf(v[j].z), fabsf(v[j].w)))); }
    am = wave_max(am);
    const float s = am > 0.f ? am * (1.0f / 448.0f) : 1.0f, inv = 1.0f / s;
    v4u o; unsigned w;
    w = 0u; w = __builtin_amdgcn_cvt_pk_fp8_f32(v[0].x * inv, v[0].y * inv, w, false); w = __builtin_amdgcn_cvt_pk_fp8_f32(v[0].z * inv, v[0].w * inv, w, true); o.x = w;
    w = 0u; w = __builtin_amdgcn_cvt_pk_fp8_f32(v[1].x * inv, v[1].y * inv, w, false); w = __builtin_amdgcn_cvt_pk_fp8_f32(v[1].z * inv, v[1].w * inv, w, true); o.y = w;
    w = 0u; w = __builtin_amdgcn_cvt_pk_fp8_f32(v[2].x * inv, v[2].y * inv, w, false); w = __builtin_amdgcn_cvt_pk_fp8_f32(v[2].z * inv, v[2].w * inv, w, true); o.z = w;
    w = 0u; w = __builtin_amdgcn_cvt_pk_fp8_f32(v[3].x * inv, v[3].y * inv, w, false); w = __builtin_amdgcn_cvt_pk_fp8_f32(v[3].z * inv, v[3].w * inv, w, true); o.w = w;
    *(v4u*)(tab + ((size_t)(lane >> 3) * 16384 + r) * 128 + (lane & 7) * 16) = o;
    if (lane == 0) *scale = s;
}
__device__ __forceinline__ void row_to_i8_sliced(const float* __restrict__ xrow, unsigned char* __restrict__ tab, int r, float* __restrict__ scale, int lane) {
    f32x4 v[4]; float am = 0.f;
#pragma unroll
    for (int j = 0; j < 4; ++j) { v[j] = *(const f32x4*)(xrow + lane * 16 + j * 4); am = fmaxf(am, fmaxf(fmaxf(fabsf(v[j].x), fabsf(v[j].y)), fmaxf(fabsf(v[j].z), fabsf(v[j].w)))); }
    am = wave_max(am);
    const float s = am > 0.f ? am * (1.0f / 127.0f) : 1.0f, inv = 1.0f / s;
    v4u o;
#define I8PK(q_) (((unsigned)(int)rintf((q_).x * inv) & 0xffu) | (((unsigned)(int)rintf((q_).y * inv) & 0xffu) << 8) | (((unsigned)(int)rintf((q_).z * inv) & 0xffu) << 16) | (((unsigned)(int)rintf((q_).w * inv) & 0xffu) << 24))
    o.x = I8PK(v[0]); o.y = I8PK(v[1]); o.z = I8PK(v[2]); o.w = I8PK(v[3]);
    *(v4u*)(tab + ((size_t)(lane >> 3) * 16384 + r) * 128 + (lane & 7) * 16) = o;
    if (lane == 0) *scale = s;
}
__device__ __forceinline__ void peer_u_pass(const bf16* __restrict__ xrow, const int* __restrict__ exr, const unsigned char* __restrict__ U8x, float* __restrict__ pd, int x, int lane) {
    const int e8 = lane >> 3, c = lane & 7;
    f32x2_t xp[8];
#pragma unroll
    for (int j = 0; j < 2; ++j) { const v4u t = *(const v4u*)(xrow + x * 128 + c * 16 + j * 8);
        xp[j * 4 + 0] = (f32x2_t){bflo(t.x), bfhi(t.x)}; xp[j * 4 + 1] = (f32x2_t){bflo(t.y), bfhi(t.y)}; xp[j * 4 + 2] = (f32x2_t){bflo(t.z), bfhi(t.z)}; xp[j * 4 + 3] = (f32x2_t){bflo(t.w), bfhi(t.w)}; }
    const __amdgpu_buffer_rsrc_t ursrc = __builtin_amdgcn_make_buffer_rsrc((void*)U8x, 0, 16384 * 128, 0x00020000);
    v4u wa[8], wb[8];
    float d[16];
    int ids[16];
#pragma unroll
    for (int j = 0; j < 4; ++j) { const v4u t = *(const v4u*)(exr + e8 * 16 + j * 4); ids[j * 4 + 0] = (int)t.x; ids[j * 4 + 1] = (int)t.y; ids[j * 4 + 2] = (int)t.z; ids[j * 4 + 3] = (int)t.w; }
#pragma unroll
    for (int g = 0; g < 8; ++g) wa[g] = __builtin_amdgcn_raw_buffer_load_b128(ursrc, ids[g] * 128 + c * 16, 0, 0);
#pragma unroll
    for (int g = 0; g < 8; ++g) wb[g] = __builtin_amdgcn_raw_buffer_load_b128(ursrc, ids[8 + g] * 128 + c * 16, 0, 0);
#define PU_DOT1(w_, k_) do { a_ = __builtin_elementwise_fma(__builtin_amdgcn_cvt_pk_f32_fp8((w_), false), xp[(k_) * 2], a_); a_ = __builtin_elementwise_fma(__builtin_amdgcn_cvt_pk_f32_fp8((w_), true), xp[(k_) * 2 + 1], a_); } while (0)
#pragma unroll
    for (int g = 0; g < 8; ++g) { f32x2_t a_ = (f32x2_t){0.f, 0.f}; PU_DOT1(wa[g].x, 0); PU_DOT1(wa[g].y, 1); PU_DOT1(wa[g].z, 2); PU_DOT1(wa[g].w, 3); d[g] = a_.x + a_.y; }
#pragma unroll
    for (int g = 0; g < 8; ++g) { f32x2_t a_ = (f32x2_t){0.f, 0.f}; PU_DOT1(wb[g].x, 0); PU_DOT1(wb[g].y, 1); PU_DOT1(wb[g].z, 2); PU_DOT1(wb[g].w, 3); d[8 + g] = a_.x + a_.y; }
#pragma unroll
    for (int g = 0; g < 16; ++g) { d[g] += DPPF(d[g], 0xB1, 0xf); d[g] += DPPF(d[g], 0x4E, 0xf); d[g] += DPPF(d[g], 0x141, 0xf); }
    if (c == 0) {
#pragma unroll
        for (int j = 0; j < 4; ++j) *(f32x4*)(pd + e8 * 16 + j * 4) = (f32x4){d[j * 4 + 0], d[j * 4 + 1], d[j * 4 + 2], d[j * 4 + 3]};
    }
}
#define PUL_IDS(I, k_) do { const int t_ = ((tg0 + ((k_) < nit ? (k_) : nit - 1) * tgstep) * 8 + wave); _Pragma("unroll") for (int j = 0; j < 4; ++j) I[j] = *(const v4u*)(EXPp + (size_t)t_ * 128 + e8 * 16 + j * 4); } while (0)
#define PUL_ROWS(R, X, I, k_) do { const int t_ = ((tg0 + ((k_) < nit ? (k_) : nit - 1) * tgstep) * 8 + wave); \
        X[0] = *(const v4u*)(XBp + (size_t)t_ * D + x * 128 + c * 16); X[1] = *(const v4u*)(XBp + (size_t)t_ * D + x * 128 + c * 16 + 8); \
        _Pragma("unroll") for (int j = 0; j < 4; ++j) { R[j * 4 + 0] = __builtin_amdgcn_raw_buffer_load_b128(ursrc, (int)I[j].x * 128 + c * 16, 0, 0); R[j * 4 + 1] = __builtin_amdgcn_raw_buffer_load_b128(ursrc, (int)I[j].y * 128 + c * 16, 0, 0); \
            R[j * 4 + 2] = __builtin_amdgcn_raw_buffer_load_b128(ursrc, (int)I[j].z * 128 + c * 16, 0, 0); R[j * 4 + 3] = __builtin_amdgcn_raw_buffer_load_b128(ursrc, (int)I[j].w * 128 + c * 16, 0, 0); } } while (0)
#define PUL_COMP(R, X, k_) do { float xf_[16]; \
        _Pragma("unroll") for (int j = 0; j < 2; ++j) { xf_[j * 8 + 0] = bflo(X[j].x); xf_[j * 8 + 1] = bfhi(X[j].x); xf_[j * 8 + 2] = bflo(X[j].y); xf_[j * 8 + 3] = bfhi(X[j].y); xf_[j * 8 + 4] = bflo(X[j].z); xf_[j * 8 + 5] = bfhi(X[j].z); xf_[j * 8 + 6] = bflo(X[j].w); xf_[j * 8 + 7] = bfhi(X[j].w); } \
          \
        float am_ = 0.f; _Pragma("unroll") for (int i = 0; i < 16; ++i) am_ = fmaxf(am_, fabsf(xf_[i])); \
        am_ = fmaxf(am_, DPPF(am_, 0xB1, 0xf)); am_ = fmaxf(am_, DPPF(am_, 0x4E, 0xf)); am_ = fmaxf(am_, DPPF(am_, 0x141, 0xf)); \
        const float sx_ = am_ > 0.f ? am_ * (1.0f / 127.0f) : 1.0f, ix_ = 1.0f / sx_; \
        int xq_[4]; \
        _Pragma("unroll") for (int j = 0; j < 4; ++j) xq_[j] = (int)(((unsigned)(int)rintf(xf_[j * 4 + 0] * ix_) & 0xffu) | (((unsigned)(int)rintf(xf_[j * 4 + 1] * ix_) & 0xffu) << 8) | (((unsigned)(int)rintf(xf_[j * 4 + 2] * ix_) & 0xffu) << 16) | (((unsigned)(int)rintf(xf_[j * 4 + 3] * ix_) & 0xffu) << 24)); \
        float d[16]; \
        _Pragma("unroll") for (int g = 0; g < 16; ++g) { int a_ = __builtin_amdgcn_sdot4((int)R[g].x, xq_[0], 0, false); a_ = __builtin_amdgcn_sdot4((int)R[g].y, xq_[1], a_, false); a_ = __builtin_amdgcn_sdot4((int)R[g].z, xq_[2], a_, false); a_ = __builtin_amdgcn_sdot4((int)R[g].w, xq_[3], a_, false); d[g] = (float)a_; } \
        _Pragma("unroll") for (int g = 0; g < 16; ++g) { d[g] += DPPF(d[g], 0xB1, 0xf); d[g] += DPPF(d[g], 0x4E, 0xf); d[g] += DPPF(d[g], 0x141, 0xf); d[g] *= sx_; } \
        if (c == 0 && (k_) < nit) { float* pd_ = PDx + (size_t)((tg0 + (k_) * tgstep) * 8 + wave) * 128 + e8 * 16; \
            _Pragma("unroll") for (int j = 0; j < 4; ++j) *(f32x4*)(pd_ + j * 4) = (f32x4){d[j * 4 + 0], d[j * 4 + 1], d[j * 4 + 2], d[j * 4 + 3]}; } } while (0)
__device__ __forceinline__ void peer_u_loop(const bf16* __restrict__ XBp, const int* __restrict__ EXPp, const unsigned char* __restrict__ U8x, float* __restrict__ PDx, int x, int tg0, int tgstep, int nit, int wave, int lane) {
    const int e8 = lane >> 3, c = lane & 7;
    const __amdgpu_buffer_rsrc_t ursrc = __builtin_amdgcn_make_buffer_rsrc((void*)U8x, 0, 16384 * 128, 0x00020000);
    v4u ra[16], rb[16], xa[2], xb[2], i0[4], i1[4];
    PUL_IDS(i0, 0);
    PUL_ROWS(ra, xa, i0, 0);
    PUL_IDS(i1, 1);
#pragma unroll 1
    for (int k = 0; k < nit; k += 2) {
        PUL_ROWS(rb, xb, i1, k + 1);
        PUL_IDS(i0, k + 2);
        PUL_COMP(ra, xa, k);
        PUL_ROWS(ra, xa, i0, k + 2);
        PUL_IDS(i1, k + 3);
        PUL_COMP(rb, xb, k + 1);
    }
}
#define PV_LOAD(VB, grp) do { _Pragma("unroll") for (int i_ = 0; i_ < 4; ++i_) { const int e_ = (grp) * 4 + i_; \
        const int id_ = __builtin_amdgcn_readlane(e_ < 64 ? id0 : id1, e_ & 63); \
        VB[i_] = __builtin_amdgcn_raw_buffer_load_b128(vrsrc, voff, (unsigned)id_ * 1024u, 0); } } while (0)
#define PV_COMP(VB, grp) do { _Pragma("unroll") for (int i_ = 0; i_ < 4; ++i_) { const int e_ = (grp) * 4 + i_; \
        const float cf_ = __uint_as_float(__builtin_amdgcn_readlane(__float_as_uint(e_ < 64 ? cf0 : cf1), e_ & 63)); \
        PE_AXPY4(VB[i_].x, 0); PE_AXPY4(VB[i_].y, 1); PE_AXPY4(VB[i_].z, 2); PE_AXPY4(VB[i_].w, 3); } } while (0)
#define PV_COEFS() \
    const int id0 = exr[lane], id1 = exr[64 + lane]; \
    float dot0 = 0.f, dot1 = 0.f; \
    { const int p0 = lane, p1 = 64 + lane;        \
      _Pragma("unroll") for (int x_ = 0; x_ < 8; ++x_) { dot0 += pdt[(size_t)x_ * NT * 128 + p0]; dot1 += pdt[(size_t)x_ * NT * 128 + p1]; } } \
    const float cf0 = gar[lane] * SV[id0] * geluf_(SU[id0] * dot0), cf1 = gar[64 + lane] * SV[id1] * geluf_(SU[id1] * dot1);
__device__ __forceinline__ void peer_v_w(const float* __restrict__ xrow, const int* __restrict__ exr, const float* __restrict__ gar, const float* __restrict__ pdt,
                                         const unsigned char* __restrict__ V, const float* __restrict__ SU, const float* __restrict__ SV,
                                         const float* __restrict__ g, const float* __restrict__ bta, float* __restrict__ orow, bf16* __restrict__ obrow, int lane) {
    const __amdgpu_buffer_rsrc_t vrsrc = __builtin_amdgcn_make_buffer_rsrc((void*)V, 0, 16384 * 1024, 0x00020000);
    const int voff = lane * 16;
    PV_COEFS()
    float acc[16];
#pragma unroll
    for (int i = 0; i < 16; ++i) acc[i] = 0.f;
    v4u va[4], vb[4], vc[4];
    PV_LOAD(va, 0); PV_LOAD(vb, 1);
#pragma unroll 1
    for (int grp = 0; grp < 30; grp += 3) {
        PV_LOAD(vc, grp + 2);
        PV_COMP(va, grp);
        PV_LOAD(va, grp + 3);
        PV_COMP(vb, grp + 1);
        PV_LOAD(vb, grp + 4);
        PV_COMP(vc, grp + 2);
    }
    PV_COMP(va, 30); PV_COMP(vb, 31);
    float xv[16];
#pragma unroll
    for (int j = 0; j < 4; ++j) { const f32x4 t = *(const f32x4*)(xrow + lane * 16 + j * 4); xv[j * 4 + 0] = t.x; xv[j * 4 + 1] = t.y; xv[j * 4 + 2] = t.z; xv[j * 4 + 3] = t.w; }
    float v[16]; float s = 0.f;
#pragma unroll
    for (int i = 0; i < 16; ++i) { v[i] = ALPHA * xv[i] + acc[i]; s += v[i]; }
    const float mean = wave_sum(s) * (1.0f / 1024.0f); float q = 0.f;
#pragma unroll
    for (int i = 0; i < 16; ++i) { v[i] -= mean; q += v[i] * v[i]; }
    const float rs = rsqrtf(wave_sum(q) * (1.0f / 1024.0f) + LN_EPS);
    float o[16];
#pragma unroll
    for (int j = 0; j < 4; ++j) {
        const f32x4 g4 = *(const f32x4*)(g + lane * 16 + j * 4), b4 = *(const f32x4*)(bta + lane * 16 + j * 4);
        o[j * 4 + 0] = v[j * 4 + 0] * rs * g4.x + b4.x; o[j * 4 + 1] = v[j * 4 + 1] * rs * g4.y + b4.y; o[j * 4 + 2] = v[j * 4 + 2] * rs * g4.z + b4.z; o[j * 4 + 3] = v[j * 4 + 3] * rs * g4.w + b4.w;
        *(f32x4*)(orow + lane * 16 + j * 4) = (f32x4){o[j * 4 + 0], o[j * 4 + 1], o[j * 4 + 2], o[j * 4 + 3]};
    }
    if (obrow) {
        v4u w0, w1; w0.x = pk2(o[0], o[1]); w0.y = pk2(o[2], o[3]); w0.z = pk2(o[4], o[5]); w0.w = pk2(o[6], o[7]); w1.x = pk2(o[8], o[9]); w1.y = pk2(o[10], o[11]); w1.z = pk2(o[12], o[13]); w1.w = pk2(o[14], o[15]);
        *(v4u*)(obrow + lane * 16) = w0; *(v4u*)(obrow + lane * 16 + 8) = w1;
    }
}
__device__ __forceinline__ void peer_v_blk(const float* __restrict__ xrow, const int* __restrict__ exr, const float* __restrict__ gar, const float* __restrict__ pdt,
                                           const unsigned char* __restrict__ V, const float* __restrict__ SU, const float* __restrict__ SV,
                                           const float* __restrict__ g, const float* __restrict__ bta, float* __restrict__ orow, bf16* __restrict__ obrow, int lane, int wave, float* smem) {
    const __amdgpu_buffer_rsrc_t vrsrc = __builtin_amdgcn_make_buffer_rsrc((void*)V, 0, 16384 * 1024, 0x00020000);
    const int voff = lane * 16;
    PV_COEFS()
    float acc[16];
#pragma unroll
    for (int i = 0; i < 16; ++i) acc[i] = 0.f;
    v4u va[4], vb[4], vc[4], vd[4];
    PV_LOAD(va, wave * 4); PV_LOAD(vb, wave * 4 + 1); PV_LOAD(vc, wave * 4 + 2); PV_LOAD(vd, wave * 4 + 3);
    PV_COMP(va, wave * 4); PV_COMP(vb, wave * 4 + 1); PV_COMP(vc, wave * 4 + 2); PV_COMP(vd, wave * 4 + 3);
    float* accs = smem;
    float* sred = smem + 8192;
#pragma unroll
    for (int j = 0; j < 4; ++j) *(f32x4*)(accs + wave * 1024 + lane * 16 + j * 4) = (f32x4){acc[j * 4 + 0], acc[j * 4 + 1], acc[j * 4 + 2], acc[j * 4 + 3]};
    __syncthreads();
    const int tid = wave * 64 + lane;
    float v0 = ALPHA * xrow[tid * 2], v1 = ALPHA * xrow[tid * 2 + 1];
#pragma unroll
    for (int w = 0; w < 8; ++w) { v0 += accs[w * 1024 + tid * 2]; v1 += accs[w * 1024 + tid * 2 + 1]; }
    const float s = wave_sum(v0 + v1);
    if (lane == 0) sred[wave] = s;
    __syncthreads();
    float mean = 0.f;
#pragma unroll
    for (int w = 0; w < 8; ++w) mean += sred[w];
    mean *= (1.0f / 1024.0f);
    __syncthreads();
    const float d0 = v0 - mean, d1 = v1 - mean;
    const float q = wave_sum(d0 * d0 + d1 * d1);
    if (lane == 0) sred[wave] = q;
    __syncthreads();
    float var = 0.f;
#pragma unroll
    for (int w = 0; w < 8; ++w) var += sred[w];
    const float rs = rsqrtf(var * (1.0f / 1024.0f) + LN_EPS);
    const float o0 = d0 * rs * g[tid * 2] + bta[tid * 2], o1 = d1 * rs * g[tid * 2 + 1] + bta[tid * 2 + 1];
    *(float2*)(orow + tid * 2) = make_float2(o0, o1);
    if (obrow) *(unsigned*)(obrow + tid * 2) = pk2(o0, o1);
    __syncthreads();
}

__device__ __forceinline__ void peer_xk(const int* __restrict__ exr, float* __restrict__ gar, const float* __restrict__ pdt, const float* __restrict__ SU, const float* __restrict__ SV, int lane) {
    PV_COEFS()
    gar[lane] = cf0; gar[64 + lane] = cf1;
}
__device__ __forceinline__ void peer_v_slice(const int* __restrict__ exr, const float* __restrict__ cfr, const unsigned char* __restrict__ V8x, float* __restrict__ outs  , int lane) {
    const int e8 = lane >> 3, c = lane & 7;
    const __amdgpu_buffer_rsrc_t vrsrc = __builtin_amdgcn_make_buffer_rsrc((void*)V8x, 0, 16384 * 128, 0x00020000);
    v4u wa[8], wb[8]; float cfa[8], cfb[8];
    int ids[16];
#pragma unroll
    for (int j = 0; j < 4; ++j) { const v4u t = *(const v4u*)(exr + e8 * 16 + j * 4); ids[j * 4 + 0] = (int)t.x; ids[j * 4 + 1] = (int)t.y; ids[j * 4 + 2] = (int)t.z; ids[j * 4 + 3] = (int)t.w; }
#pragma unroll
    for (int g = 0; g < 8; ++g) wa[g] = __builtin_amdgcn_raw_buffer_load_b128(vrsrc, ids[g] * 128 + c * 16, 0, 0);
#pragma unroll
    for (int g = 0; g < 8; ++g) wb[g] = __builtin_amdgcn_raw_buffer_load_b128(vrsrc, ids[8 + g] * 128 + c * 16, 0, 0);
#pragma unroll
    for (int j = 0; j < 2; ++j) { const f32x4 t = *(const f32x4*)(cfr + e8 * 16 + j * 4), u = *(const f32x4*)(cfr + e8 * 16 + 8 + j * 4);
        cfa[j * 4 + 0] = t.x; cfa[j * 4 + 1] = t.y; cfa[j * 4 + 2] = t.z; cfa[j * 4 + 3] = t.w; cfb[j * 4 + 0] = u.x; cfb[j * 4 + 1] = u.y; cfb[j * 4 + 2] = u.z; cfb[j * 4 + 3] = u.w; }
    f32x2_t ap[8];
#pragma unroll
    for (int i = 0; i < 8; ++i) ap[i] = (f32x2_t){0.f, 0.f};
#define PVS_AXPY(w_, k_) do { ap[(k_) * 2] = __builtin_elementwise_fma(cf2_, __builtin_amdgcn_cvt_pk_f32_fp8((w_), false), ap[(k_) * 2]); ap[(k_) * 2 + 1] = __builtin_elementwise_fma(cf2_, __builtin_amdgcn_cvt_pk_f32_fp8((w_), true), ap[(k_) * 2 + 1]); } while (0)
#pragma unroll
    for (int g = 0; g < 8; ++g) { const f32x2_t cf2_ = (f32x2_t){cfa[g], cfa[g]}; PVS_AXPY(wa[g].x, 0); PVS_AXPY(wa[g].y, 1); PVS_AXPY(wa[g].z, 2); PVS_AXPY(wa[g].w, 3); }
#pragma unroll
    for (int g = 0; g < 8; ++g) { const f32x2_t cf2_ = (f32x2_t){cfb[g], cfb[g]}; PVS_AXPY(wb[g].x, 0); PVS_AXPY(wb[g].y, 1); PVS_AXPY(wb[g].z, 2); PVS_AXPY(wb[g].w, 3); }
#undef PVS_AXPY
    float acc[16];
#pragma unroll
    for (int i = 0; i < 8; ++i) { acc[2 * i] = ap[i].x; acc[2 * i + 1] = ap[i].y; }
#pragma unroll
    for (int i = 0; i < 16; ++i) { float v = acc[i]; v += DPPF(v, 0x128, 0xf); v += __shfl_xor(v, 16); v += __shfl_xor(v, 32); acc[i] = v; }
    if (e8 == 0) {
#pragma unroll
        for (int j = 0; j < 4; ++j) *(f32x4*)(outs + c * 16 + j * 4) = (f32x4){acc[j * 4 + 0], acc[j * 4 + 1], acc[j * 4 + 2], acc[j * 4 + 3]};
    }
}
#define PVL_IDS(I, k_) do { const int t_ = ((tg0 + ((k_) < nit ? (k_) : nit - 1) * tgstep) * 8 + wave); _Pragma("unroll") for (int j = 0; j < 4; ++j) I[j] = *(const v4u*)(EXPp + (size_t)t_ * 128 + e8 * 16 + j * 4); } while (0)
#define PVL_ROWS(R, C, I, k_) do { const int t_ = ((tg0 + ((k_) < nit ? (k_) : nit - 1) * tgstep) * 8 + wave); \
        _Pragma("unroll") for (int j = 0; j < 4; ++j) C[j] = *(const f32x4*)(CFp + (size_t)t_ * 128 + e8 * 16 + j * 4); \
        _Pragma("unroll") for (int j = 0; j < 4; ++j) { R[j * 4 + 0] = __builtin_amdgcn_raw_buffer_load_b128(vrsrc, (int)I[j].x * 128 + c * 16, 0, 0); R[j * 4 + 1] = __builtin_amdgcn_raw_buffer_load_b128(vrsrc, (int)I[j].y * 128 + c * 16, 0, 0); \
            R[j * 4 + 2] = __builtin_amdgcn_raw_buffer_load_b128(vrsrc, (int)I[j].z * 128 + c * 16, 0, 0); R[j * 4 + 3] = __builtin_amdgcn_raw_buffer_load_b128(vrsrc, (int)I[j].w * 128 + c * 16, 0, 0); } } while (0)
#define PVL_AXPY(w_, k2_) do { ap[(k2_) * 2] = __builtin_elementwise_fma(cf2_, __builtin_amdgcn_cvt_pk_f32_fp8((w_), false), ap[(k2_) * 2]); ap[(k2_) * 2 + 1] = __builtin_elementwise_fma(cf2_, __builtin_amdgcn_cvt_pk_f32_fp8((w_), true), ap[(k2_) * 2 + 1]); } while (0)
#define PVL_COMP(R, C, k_) do { f32x2_t ap[8]; \
        _Pragma("unroll") for (int i = 0; i < 8; ++i) ap[i] = (f32x2_t){0.f, 0.f}; \
        _Pragma("unroll") for (int g = 0; g < 16; ++g) { const float cfs_ = C[g >> 2][g & 3]; const f32x2_t cf2_ = (f32x2_t){cfs_, cfs_}; PVL_AXPY(R[g].x, 0); PVL_AXPY(R[g].y, 1); PVL_AXPY(R[g].z, 2); PVL_AXPY(R[g].w, 3); } \
        float acc[16]; \
        _Pragma("unroll") for (int i = 0; i < 8; ++i) { acc[2 * i] = ap[i].x; acc[2 * i + 1] = ap[i].y; } \
        float a8[8], a4[4], a2[2]; \
        _Pragma("unroll") for (int i = 0; i < 8; ++i) { const float keep = hA ? acc[8 + i] : acc[i], send = hA ? acc[i] : acc[8 + i]; a8[i] = keep + __shfl_xor(send, 32); } \
        _Pragma("unroll") for (int i = 0; i < 4; ++i) { const float keep = hB ? a8[4 + i] : a8[i], send = hB ? a8[i] : a8[4 + i]; a4[i] = keep + __shfl_xor(send, 16); } \
        _Pragma("unroll") for (int i = 0; i < 2; ++i) { const float keep = hC ? a4[2 + i] : a4[i], send = hC ? a4[i] : a4[2 + i]; a2[i] = keep + DPPF(send, 0x128, 0xf); } \
        if ((k_) < nit) *(float2*)(OUTp + (size_t)((tg0 + (k_) * tgstep) * 8 + wave) * D + x * 128 + c * 16 + 2 * e8) = make_float2(a2[0], a2[1]); } while (0)
__device__ __forceinline__ void peer_v_loop(const int* __restrict__ EXPp, const float* __restrict__ CFp, const unsigned char* __restrict__ V8x, float* __restrict__ OUTp, int x, int tg0, int tgstep, int nit, int wave, int lane) {
    const int e8 = lane >> 3, c = lane & 7;
    const bool hA = (lane & 32) != 0, hB = (lane & 16) != 0, hC = (lane & 8) != 0;
    const __amdgpu_buffer_rsrc_t vrsrc = __builtin_amdgcn_make_buffer_rsrc((void*)V8x, 0, 16384 * 128, 0x00020000);
    v4u ra[16], rb[16], i0[4], i1[4]; f32x4 ca[4], cb[4];
    PVL_IDS(i0, 0);
    PVL_ROWS(ra, ca, i0, 0);
    PVL_IDS(i1, 1);
#pragma unroll 1
    for (int k = 0; k < nit; k += 2) {
        PVL_ROWS(rb, cb, i1, k + 1);
        PVL_IDS(i0, k + 2);
        PVL_COMP(ra, ca, k);
        PVL_ROWS(ra, ca, i0, k + 2);
        PVL_IDS(i1, k + 3);
        PVL_COMP(rb, cb, k + 1);
    }
}
__device__ __forceinline__ void peer_xc(const bf16* __restrict__ xrow, const float* __restrict__ srow, const float* __restrict__ g, const float* __restrict__ bta, float* __restrict__ orow, bf16* __restrict__ obrow, bf16* __restrict__ obrow2, int lane) {
    float v[16]; float s = 0.f;
#pragma unroll
    for (int j = 0; j < 4; ++j) { const v2u ab = *(const v2u*)(xrow + lane * 16 + j * 4); const f32x4 b = *(const f32x4*)(srow + lane * 16 + j * 4);
        v[j * 4 + 0] = ALPHA * bflo(ab.x) + b.x; v[j * 4 + 1] = ALPHA * bfhi(ab.x) + b.y; v[j * 4 + 2] = ALPHA * bflo(ab.y) + b.z; v[j * 4 + 3] = ALPHA * bfhi(ab.y) + b.w; }
#pragma unroll
    for (int i = 0; i < 16; ++i) s += v[i];
    const float mean = wave_sum(s) * (1.0f / 1024.0f); float q = 0.f;
#pragma unroll
    for (int i = 0; i < 16; ++i) { v[i] -= mean; q += v[i] * v[i]; }
    const float rs = rsqrtf(wave_sum(q) * (1.0f / 1024.0f) + LN_EPS);
    float o[16];
#pragma unroll
    for (int j = 0; j < 4; ++j) {
        const f32x4 g4 = *(const f32x4*)(g + lane * 16 + j * 4), b4 = *(const f32x4*)(bta + lane * 16 + j * 4);
        o[j * 4 + 0] = v[j * 4 + 0] * rs * g4.x + b4.x; o[j * 4 + 1] = v[j * 4 + 1] * rs * g4.y + b4.y; o[j * 4 + 2] = v[j * 4 + 2] * rs * g4.z + b4.z; o[j * 4 + 3] = v[j * 4 + 3] * rs * g4.w + b4.w;
        if (orow) *(f32x4*)(orow + lane * 16 + j * 4) = (f32x4){o[j * 4 + 0], o[j * 4 + 1], o[j * 4 + 2], o[j * 4 + 3]};
    }
    if (obrow) {
        v4u w0, w1; w0.x = pk2(o[0], o[1]); w0.y = pk2(o[2], o[3]); w0.z = pk2(o[4], o[5]); w0.w = pk2(o[6], o[7]); w1.x = pk2(o[8], o[9]); w1.y = pk2(o[10], o[11]); w1.z = pk2(o[12], o[13]); w1.w = pk2(o[14], o[15]);
        *(v4u*)(obrow + lane * 16) = w0; *(v4u*)(obrow + lane * 16 + 8) = w1;
        if (obrow2) { *(v4u*)(obrow2 + lane * 16) = w0; *(v4u*)(obrow2 + lane * 16 + 8) = w1; }
    }
}

__device__ __forceinline__ int t5_bucket(int n) {
    if (n < 16) return n;
    const int large = 16 + (int)(logf((float)n / 16.0f) / 2.0794415416798357f * 16.0f);
    return large < 31 ? large : 31;
}
__device__ __forceinline__ void swa_attn(const float* __restrict__ PC, const float* __restrict__ cache_k, const float* __restrict__ cache_v,
                                         const float* __restrict__ rel_bias, const float* __restrict__ sinks, bf16* __restrict__ ATT, int bx) {
    const int tid = threadIdx.x, lane = tid & 63, wid = tid >> 6;
    const int gw = bx * 8 + wid;
    const int t = gw >> 4, h = gw & 15, kvh = h >> 2;
    if (t >= NT) return;
    const bool samp = t >= NP; const int sb = t - NP, pos = t % SEQ;
    const float* qrow = PC + (size_t)t * CN + h * 64;
    float lg[2]; bool valid[2];
#pragma unroll
    for (int rr = 0; rr < 2; ++rr) {
        const int r = lane + 64 * rr;
        const float* krow;
        if (!samp) { valid[rr] = (pos - r) >= 0; krow = PC + (size_t)(valid[rr] ? t - r : t) * CN + 1024 + kvh * 64; }
        else { valid[rr] = true; krow = (r == 0) ? PC + (size_t)t * CN + 1024 + kvh * 64 : cache_k + (((size_t)sb * 128 + (128 - r)) * 4 + kvh) * 64; }
        float dot = 0.f;
#pragma unroll
        for (int d4 = 0; d4 < 16; ++d4) {
            const float4 kv = *(const float4*)(krow + d4 * 4);
            const float4 qv = *(const float4*)(qrow + d4 * 4);
            dot += qv.x * kv.x + qv.y * kv.y + qv.z * kv.z + qv.w * kv.w;
        }
        lg[rr] = valid[rr] ? dot * 0.125f + rel_bias[t5_bucket(r) * 16 + h] : -INFINITY;
    }
    const float sink = sinks[h];
    const float m = fmaxf(wave_max(fmaxf(lg[0], lg[1])), sink);
    float p[2];
#pragma unroll
    for (int rr = 0; rr < 2; ++rr) p[rr] = valid[rr] ? expf(lg[rr] - m) : 0.f;
    const float den = wave_sum(p[0] + p[1]) + expf(sink - m);
    const float inv = 1.0f / den;
    float o = 0.f;
#pragma unroll
    for (int rr = 0; rr < 2; ++rr)
        for (int l2 = 0; l2 < 64; ++l2) {
            const int r = l2 + 64 * rr;
            const float pj = __shfl(p[rr], l2);
            if (pj != 0.f) {
                const float* vrow;
                if (!samp) vrow = PC + (size_t)(t - r) * CN + 1280 + kvh * 64;
                else vrow = (r == 0) ? PC + (size_t)t * CN + 1280 + kvh * 64 : cache_v + (((size_t)sb * 128 + (128 - r)) * 4 + kvh) * 64;
                o += pj * vrow[lane];
            }
        }
    ATT[(size_t)t * D + h * 64 + lane] = (bf16)f2bf(o * inv);
}

__device__ __forceinline__ void swa_kv_out(const float* __restrict__ PC, const float* __restrict__ cache_k, const float* __restrict__ cache_v,
                                           float* __restrict__ pk, float* __restrict__ pv, float* __restrict__ sk, float* __restrict__ sv, int vb) {
    const int c = threadIdx.x & 255, row = vb * 2 + (threadIdx.x >> 8);
    if (row < NB * 128) {
        const int b = row >> 7, i = row & 127;
        const float* src = PC + (size_t)(b * SEQ + SEQ - 128 + i) * CN;
        pk[(size_t)row * 256 + c] = src[1024 + c];
        pv[(size_t)row * 256 + c] = src[1280 + c];
    } else {
        const int r2 = row - NB * 128, sb = r2 >> 7, i = r2 & 127;
        if (i < 127) {
            sk[(size_t)r2 * 256 + c] = cache_k[((size_t)sb * 128 + i + 1) * 256 + c];
            sv[(size_t)r2 * 256 + c] = cache_v[((size_t)sb * 128 + i + 1) * 256 + c];
        } else {
            const float* src = PC + (size_t)(NP + sb) * CN;
            sk[(size_t)r2 * 256 + c] = src[1024 + c];
            sv[(size_t)r2 * 256 + c] = src[1280 + c];
        }
    }
}
#define XB_TMO      128
#define XB_XCNT(j)  (256  + 64 * (j))
#define XB_XSUB(j)  (1280 + 64 * (j))
#define XB_XGEN(j)  (2304 + 64 * (j))
#define XB_TOP      3328
#define XB_TOPGEN   3392
#define XCD_BAR_WORDS 3456
#define XB_SPIN_CAP (1u << 18)

__device__ __forceinline__ unsigned xb_ld(unsigned* p)              { return __hip_atomic_load(p, __ATOMIC_RELAXED, __HIP_MEMORY_SCOPE_AGENT); }
__device__ __forceinline__ unsigned xb_add(unsigned* p, unsigned v) { return __hip_atomic_fetch_add(p, v, __ATOMIC_RELAXED, __HIP_MEMORY_SCOPE_AGENT); }
__device__ __forceinline__ unsigned xb_xcc_id() { return (unsigned)__builtin_amdgcn_s_getreg((3 << 11) | 20) & 0xFu; }
#define XB_SPIN(cond, bar) do { unsigned _sp = 0; while (cond) { __builtin_amdgcn_s_sleep(1); \
    if ((++_sp & 255u) == 0u) { if (xb_ld(&(bar)[XB_TMO])) break; if (_sp > XB_SPIN_CAP) { atomicAdd(&(bar)[XB_TMO], 1u); break; } } } } while (0)

struct XcdBarrier {
    unsigned* bar; unsigned x;
    volatile LAS unsigned* st;
};

__device__ __forceinline__ XcdBarrier xcd_barrier_post(unsigned* bar, volatile LAS unsigned* st) {
    XcdBarrier b; b.bar = bar; b.x = xb_xcc_id(); b.st = st;
    if (threadIdx.x == 0) (void)xb_add(&bar[XB_XCNT(b.x)], 1u);
    return b;
}
__device__ __forceinline__ void xcd_barrier_complete(unsigned* bar, unsigned x, unsigned& nloc, unsigned& nx) {
    const unsigned G = gridDim.x * gridDim.y * gridDim.z;
    unsigned sum, cnt, mine, sp = 0u;
    for (;;) {
        sum = 0u; cnt = 0u; mine = 0u;
#pragma unroll
        for (unsigned j = 0; j < 16; ++j) { const unsigned c = xb_ld(&bar[XB_XCNT(j)]); sum += c; cnt += (c > 0u) ? 1u : 0u; mine = (j == x) ? c : mine; }
        if (sum == G) break;
        __builtin_amdgcn_s_sleep(1);
        if ((++sp & 255u) == 0u) { if (xb_ld(&bar[XB_TMO])) break; if (sp > XB_SPIN_CAP) { atomicAdd(&bar[XB_TMO], 1u); break; } }
    }
    nloc = mine > 0u ? mine : 1u; nx = cnt > 0u ? cnt : 1u;
}

__device__ __forceinline__ void xcd_barrier(const XcdBarrier& b) {
    asm volatile("s_waitcnt vmcnt(0)" ::: "memory");
    __syncthreads();
    if (threadIdx.x == 0) {
        unsigned* bar = b.bar;
        __builtin_amdgcn_s_waitcnt(0);
        unsigned nloc = b.st[0], nx = b.st[1];
        if (nloc == 0u) { xcd_barrier_complete(bar, b.x, nloc, nx); b.st[0] = nloc; b.st[1] = nx; }
        const unsigned old = xb_add(&bar[XB_XSUB(b.x)], 1u);
        const unsigned gen = old / nloc;
        if (old + 1u == (gen + 1u) * nloc) {
            __builtin_amdgcn_fence(__ATOMIC_RELEASE, "agent");
            asm volatile("s_waitcnt vmcnt(0)" ::: "memory");
            const unsigned og = xb_add(&bar[XB_TOP], 1u);
            const unsigned tg = og / nx;
            if (og + 1u == (tg + 1u) * nx) xb_add(&bar[XB_TOPGEN], 1u);
            else XB_SPIN(xb_ld(&bar[XB_TOPGEN]) == tg, bar);
            __builtin_amdgcn_fence(__ATOMIC_ACQUIRE, "agent");
            xb_add(&bar[XB_XGEN(b.x)], 1u);
            asm volatile("s_waitcnt vmcnt(0)" ::: "memory");
        } else {
            XB_SPIN(xb_ld(&bar[XB_XGEN(b.x)]) == gen, bar);
            __builtin_amdgcn_fence(__ATOMIC_ACQUIRE, "agent");
            asm volatile("s_waitcnt vmcnt(0)" ::: "memory");
        }
    }
    __syncthreads();
}

typedef short bf16x8_t __attribute__((ext_vector_type(8)));
__device__ __forceinline__ f32x4 mfma16(bf16x8_t a, bf16x8_t b, f32x4 c) { return __builtin_amdgcn_mfma_f32_16x16x32_bf16(a, b, c, 0, 0, 0); }

struct GdnChunkBufs {
    bf16* W;
    bf16* QG;
    bf16* KDT;
    bf16* UT;
    bf16* QK;
    float* EGL;
};

constexpr int GP_QB = 0, GP_KB = 17408, GP_VB = 34816, GP_LS = 52224, GP_QKS = 69632, GP_WS = 78848, GP_SC = 96256;

__device__ __forceinline__ void gdn_prep_unit(const bf16* __restrict__ PROJ, const float* __restrict__ conv_w, const float* __restrict__ a_log, const float* __restrict__ dt_bias,
                                              const GdnChunkBufs& cb, float* __restrict__ p_gdn_conv, int un, unsigned char* lds) {
    int tid = threadIdx.x; asm volatile("" : "+v"(tid));
    const int lane = tid & 63, wave = __builtin_amdgcn_readfirstlane(tid >> 6), fr = lane & 15, fq = lane >> 4;
    const int h = un & 3, n = (un >> 2) & 63, b = un >> 8;
    const int t0 = b * SEQ + n * 64;
    bf16* Qb = (bf16*)(lds + GP_QB); bf16* Kb = (bf16*)(lds + GP_KB); bf16* Vb = (bf16*)(lds + GP_VB); bf16* Ws = (bf16*)(lds + GP_WS);
    float* Ls = (float*)(lds + GP_LS); bf16* QKs = (bf16*)(lds + GP_QKS);
    float* gcs = (float*)(lds + GP_SC); float* bets = gcs + 64; float* egcs = gcs + 128; float* ekds = gcs + 192; float* begs = gcs + 256;
    if (wave == 0) {
        const bf16* prow = PROJ + (size_t)(t0 + lane) * ABN;
        const float a_raw = bf2f(prow[C_A + h]), b_raw = bf2f(prow[C_B + h]);
        float g = -expf(a_log[h]) * softplusf_(a_raw + dt_bias[h]);
#pragma unroll
        for (int off = 1; off < 64; off <<= 1) { const float v = __shfl_up(g, off); if (lane >= off) g += v; }
        const float glast = __shfl(g, 63);
        { const float be_ = sigmoidf_(b_raw), eg_ = expf(g); gcs[lane] = g; bets[lane] = be_; egcs[lane] = eg_; ekds[lane] = expf(glast - g); begs[lane] = be_ * eg_; }
        if (lane == 0) cb.EGL[un] = expf(glast);
    }
    {
        int cols[6]; float cw[4][6], xw[3][6];
#pragma unroll
        for (int p = 0; p < 3; ++p)
#pragma unroll
            for (int e = 0; e < 2; ++e) cols[p * 2 + e] = p * 512 + h * 128 + e * 64 + lane;
#pragma unroll
        for (int i = 0; i < 4; ++i)
#pragma unroll
            for (int c = 0; c < 6; ++c) cw[i][c] = conv_w[i * 1536 + cols[c]];
        const int i0 = wave * 8;
#pragma unroll
        for (int k = 0; k < 3; ++k) {
            const int pos = n * 64 + i0 - 3 + k;
#pragma unroll
            for (int c = 0; c < 6; ++c) xw[k][c] = pos >= 0 ? bf2f(PROJ[(size_t)(t0 + i0 - 3 + k) * ABN + cols[c]]) : 0.f;
        }
        bf16 xraw[8][6];
#pragma unroll
        for (int ii = 0; ii < 8; ++ii)
#pragma unroll
            for (int c = 0; c < 6; ++c) xraw[ii][c] = PROJ[(size_t)(t0 + i0 + ii) * ABN + cols[c]];
#pragma unroll
        for (int ii = 0; ii < 8; ++ii) {
            const int i = i0 + ii;
            float xt[6], s[6];
#pragma unroll
            for (int c = 0; c < 6; ++c) xt[c] = bf2f(xraw[ii][c]);
#pragma unroll
            for (int c = 0; c < 6; ++c) { const float y_ = cw[0][c] * xw[0][c] + cw[1][c] * xw[1][c] + cw[2][c] * xw[2][c] + cw[3][c] * xt[c]; s[c] = y_ * __frcp_rn(1.0f + __expf(-y_)); }
            const float qs = rsqrtf(wave_sum(s[0] * s[0] + s[1] * s[1]) + 1e-6f) * 0.08838834764831845f;
            const float ks = rsqrtf(wave_sum(s[2] * s[2] + s[3] * s[3]) + 1e-6f);
            Qb[i * 136 + lane] = (bf16)f2bf(s[0] * qs); Qb[i * 136 + 64 + lane] = (bf16)f2bf(s[1] * qs);
            Kb[i * 136 + lane] = (bf16)f2bf(s[2] * ks); Kb[i * 136 + 64 + lane] = (bf16)f2bf(s[3] * ks);
            Vb[i * 136 + lane] = (bf16)f2bf(s[4]);      Vb[i * 136 + 64 + lane] = (bf16)f2bf(s[5]);
            if (n == 63 && i >= 61) {
#pragma unroll
                for (int c = 0; c < 6; ++c) p_gdn_conv[((size_t)b * 3 + (i - 61)) * 1536 + cols[c]] = xt[c];
            }
#pragma unroll
            for (int c = 0; c < 6; ++c) { xw[0][c] = xw[1][c]; xw[1][c] = xw[2][c]; xw[2][c] = xt[c]; }
        }
    }
    __syncthreads();
    {
        const int mi = wave >> 1;
        bf16x8_t aK[4], aQ[4];
#pragma unroll
        for (int ks = 0; ks < 4; ++ks) { aK[ks] = *(const bf16x8_t*)(Kb + (mi * 16 + fr) * 136 + ks * 32 + 8 * fq); aQ[ks] = *(const bf16x8_t*)(Qb + (mi * 16 + fr) * 136 + ks * 32 + 8 * fq); }
#pragma unroll
        for (int nn = 0; nn < 2; ++nn) {
            const int nj = (wave & 1) * 2 + nn;
            f32x4 accK = (f32x4){0.f, 0.f, 0.f, 0.f}, accQ = accK;
#pragma unroll
            for (int ks = 0; ks < 4; ++ks) { const bf16x8_t bk = *(const bf16x8_t*)(Kb + (nj * 16 + fr) * 136 + ks * 32 + 8 * fq); accK = mfma16(aK[ks], bk, accK); accQ = mfma16(aQ[ks], bk, accQ); }
            const int j = nj * 16 + fr; const float gj = gcs[j];
#pragma unroll
            for (int r = 0; r < 4; ++r) {
                const int i = mi * 16 + 4 * fq + r;
                const float dec = i >= j ? expf(gcs[i] - gj) : 0.f;
                Ls[j * 68 + i] = i > j ? bets[i] * accK[r] * dec : 0.f;
                QKs[i * 72 + j] = (bf16)f2bf(i >= j ? accQ[r] * dec : 0.f);
            }
        }
    }
    __syncthreads();
    if (wave < 4) {
        float x[64];
        const bool isu = tid < 128; const int c = isu ? tid : tid - 128;
        const LAS unsigned char* l3 = (const LAS unsigned char*)lds;
        unsigned so = (isu ? GP_VB : GP_KB) + c * 2, ro = GP_SC + (isu ? 64 * 4 : 256 * 4), lo = GP_LS;
        asm volatile("" : "+v"(so), "+v"(ro), "+v"(lo));
#pragma unroll
        for (int i = 0; i < 64; ++i) x[i] = *(const LAS float*)(l3 + ro + 4 * i) * bf2f(*(const LAS bf16*)(l3 + so + i * 272));
#pragma unroll
        for (int j = 0; j < 63; ++j) {
#pragma unroll
            for (int i4 = (j + 1) / 4; i4 < 16; ++i4) {
                const f32x4 l4 = *(const LAS f32x4*)(l3 + lo + j * 272 + i4 * 16);
                if (i4 * 4 + 0 > j) x[i4 * 4 + 0] -= l4.x * x[j];
                if (i4 * 4 + 1 > j) x[i4 * 4 + 1] -= l4.y * x[j];
                if (i4 * 4 + 2 > j) x[i4 * 4 + 2] -= l4.z * x[j];
                if (i4 * 4 + 3 > j) x[i4 * 4 + 3] -= l4.w * x[j];
            }
        }
        if (isu) {
            bf16* dst = cb.UT + ((size_t)un * 128 + c) * 64;
#pragma unroll
            for (int i8 = 0; i8 < 8; ++i8) { v4u o; o.x = pk2(x[i8 * 8 + 0], x[i8 * 8 + 1]); o.y = pk2(x[i8 * 8 + 2], x[i8 * 8 + 3]); o.z = pk2(x[i8 * 8 + 4], x[i8 * 8 + 5]); o.w = pk2(x[i8 * 8 + 6], x[i8 * 8 + 7]); *(v4u*)(dst + i8 * 8) = o; }
        } else {
#pragma unroll
            for (int i = 0; i < 64; ++i) Ws[i * 136 + c] = (bf16)f2bf(x[i]);
        }
    } else {
        const int t2 = tid - 256;
#pragma unroll
        for (int k = 0; k < 4; ++k) {
            const int ci = t2 + 256 * k, i = ci >> 4, d0 = (ci & 15) * 8; const float e = egcs[i];
            const v4u q = *(const v4u*)(Qb + i * 136 + d0);
            v4u o; o.x = pk2(bflo(q.x) * e, bfhi(q.x) * e); o.y = pk2(bflo(q.y) * e, bfhi(q.y) * e); o.z = pk2(bflo(q.z) * e, bfhi(q.z) * e); o.w = pk2(bflo(q.w) * e, bfhi(q.w) * e);
            *(v4u*)(cb.QG + ((size_t)un * 64 + i) * 128 + d0) = o;
        }
#pragma unroll
        for (int k = 0; k < 4; ++k) {
            const int ci = t2 + 256 * k, d = ci & 127, i0 = (ci >> 7) * 8;
            float v[8];
#pragma unroll
            for (int q = 0; q < 8; ++q) v[q] = bf2f(Kb[(i0 + q) * 136 + d]) * ekds[i0 + q];
            v4u o; o.x = pk2(v[0], v[1]); o.y = pk2(v[2], v[3]); o.z = pk2(v[4], v[5]); o.w = pk2(v[6], v[7]);
            *(v4u*)(cb.KDT + ((size_t)un * 128 + d) * 64 + i0) = o;
        }
#pragma unroll
        for (int k = 0; k < 2; ++k) {
            const int ci = t2 + 256 * k, i = ci >> 3, j0 = (ci & 7) * 8;
            *(v4u*)(cb.QK + ((size_t)un * 64 + i) * 64 + j0) = *(const v4u*)(QKs + i * 72 + j0);
        }
    }
    __syncthreads();
#pragma unroll
    for (int k = 0; k < 2; ++k) {
        const int ci = tid + 512 * k, i = ci >> 4, d0 = (ci & 15) * 8;
        *(v4u*)(cb.W + ((size_t)un * 64 + i) * 128 + d0) = *(const v4u*)(Ws + i * 136 + d0);
    }
    __syncthreads();
}

constexpr int GS_ST = 0, GS_VNT = 2 * 32 * 136 * 2, GS_END = GS_VNT + 32 * 72 * 2;
template <int N0, int N1>
__device__ __forceinline__ void gdn_seq(const GdnChunkBufs& cb, float* __restrict__ O, float* __restrict__ Sout, int b, int h, int sl, unsigned char* lds, f32x4 (&accS)[2], int& cur) {
    int tid = threadIdx.x; asm volatile("" : "+v"(tid));
    const int lane = tid & 63, wave = __builtin_amdgcn_readfirstlane(tid >> 6), fr = lane & 15, fq = lane >> 4;
    const int mi = wave >> 1, nj = wave & 1;
    bf16* St = (bf16*)(lds + GS_ST); bf16* VnT = (bf16*)(lds + GS_VNT);
    float* egls = (float*)(lds + GS_END);
    if (N0 == 0) {
        for (int i = tid; i < 2 * 32 * 136 / 2; i += NTH) ((unsigned*)St)[i] = 0u;
        accS[0] = (f32x4){0.f, 0.f, 0.f, 0.f}; accS[1] = accS[0]; cur = 0;
    }
    if (tid >= N0 && tid < N1) egls[tid] = cb.EGL[(size_t)((b * 64 + tid) * 4 + h)];
    __syncthreads();
#define GS_DECL(X) bf16x8_t aW##X[4], aQG##X[4], aQK##X[2], aKD##X[2]; v2u ut##X;
    GS_DECL(0) GS_DECL(1) GS_DECL(2)
#define GS_GLD16(dst, ptr) asm volatile("global_load_dwordx4 %0, %1, off" : "=v"(dst) : "v"(ptr))
#define GS_GLD8(dst, ptr) asm volatile("global_load_dwordx2 %0, %1, off" : "=v"(dst) : "v"(ptr))
#define GS_LOAD(X, n_) do { const size_t u_ = (size_t)((b * 64 + ((n_) < 63 ? (n_) : 63)) * 4 + h);     \
        _Pragma("unroll") for (int ks = 0; ks < 4; ++ks) { GS_GLD16(aW##X[ks], cb.W + (u_ * 64 + mi * 16 + fr) * 128 + ks * 32 + 8 * fq); GS_GLD16(aQG##X[ks], cb.QG + (u_ * 64 + mi * 16 + fr) * 128 + ks * 32 + 8 * fq); } \
        _Pragma("unroll") for (int ks = 0; ks < 2; ++ks) { GS_GLD16(aQK##X[ks], cb.QK + (u_ * 64 + mi * 16 + fr) * 64 + ks * 32 + 8 * fq); GS_GLD16(aKD##X[ks], cb.KDT + (u_ * 128 + wave * 16 + fr) * 64 + ks * 32 + 8 * fq); } \
        GS_GLD8(ut##X, cb.UT + (u_ * 128 + sl * 32 + nj * 16 + fr) * 64 + mi * 16 + 4 * fq); } while (0)
#define GS_WAITN(X, N) asm volatile("s_waitcnt vmcnt(" #N ")" : "+v"(aW##X[0]), "+v"(aW##X[1]), "+v"(aW##X[2]), "+v"(aW##X[3]), "+v"(aQG##X[0]), "+v"(aQG##X[1]), "+v"(aQG##X[2]), "+v"(aQG##X[3]), \
        "+v"(aQK##X[0]), "+v"(aQK##X[1]), "+v"(aKD##X[0]), "+v"(aKD##X[1]), "+v"(ut##X))
#define GS_WAIT(X, n_) GS_WAITN(X, 26)
#define GS_STEP(X, n_) do { \
        const float egl##X = egls[(n_)]; \
        GS_WAIT(X, n_); \
        __syncthreads();                                        \
        f32x4 accW = (f32x4){0.f, 0.f, 0.f, 0.f}, accO = accW; \
        const bf16* Sc = St + cur * 32 * 136; \
        _Pragma("unroll") for (int ks = 0; ks < 4; ++ks) { const bf16x8_t bs = *(const bf16x8_t*)(Sc + (nj * 16 + fr) * 136 + ks * 32 + 8 * fq); accW = mfma16(aW##X[ks], bs, accW); accO = mfma16(aQG##X[ks], bs, accO); } \
          \
        const float v0 = bflo(ut##X.x) - accW[0], v1 = bfhi(ut##X.x) - accW[1], v2 = bflo(ut##X.y) - accW[2], v3 = bfhi(ut##X.y) - accW[3]; \
        { v2u o; o.x = pk2(v0, v1); o.y = pk2(v2, v3); *(v2u*)(VnT + (nj * 16 + fr) * 72 + mi * 16 + 4 * fq) = o; } \
        __syncthreads();                                        \
        _Pragma("unroll") for (int ks = 0; ks < 2; ++ks) { const bf16x8_t bv = *(const bf16x8_t*)(VnT + (nj * 16 + fr) * 72 + ks * 32 + 8 * fq); accO = mfma16(aQK##X[ks], bv, accO); } \
        { float* orow = O + (size_t)(b * SEQ + (n_) * 64 + mi * 16 + 4 * fq) * 512 + h * 128 + sl * 32 + nj * 16 + fr; \
          orow[0] = accO[0]; orow[512] = accO[1]; orow[1024] = accO[2]; orow[1536] = accO[3]; } \
          \
        bf16* Sn = St + (cur ^ 1) * 32 * 136; \
        _Pragma("unroll") for (int njj = 0; njj < 2; ++njj) { \
            accS[njj] = accS[njj] * egl##X; \
            _Pragma("unroll") for (int ks = 0; ks < 2; ++ks) { const bf16x8_t bv = *(const bf16x8_t*)(VnT + (njj * 16 + fr) * 72 + ks * 32 + 8 * fq); accS[njj] = mfma16(aKD##X[ks], bv, accS[njj]); } \
            v2u o; o.x = pk2(accS[njj][0], accS[njj][1]); o.y = pk2(accS[njj][2], accS[njj][3]); \
            *(v2u*)(Sn + (njj * 16 + fr) * 136 + wave * 16 + 4 * fq) = o; } \
        cur ^= 1; } while (0)
    constexpr int NTRI = (N1 - N0) / 3, NREM = (N1 - N0) % 3, NM = N0 + 3 * NTRI;
    GS_LOAD(0, N0); GS_LOAD(1, N0 + 1);
#pragma unroll 1
    for (int n = N0; n < NM; n += 3) {
        GS_LOAD(2, n + 2);
        GS_STEP(0, n);
        GS_LOAD(0, n + 3);
        GS_STEP(1, n + 1);
        GS_LOAD(1, n + 4);
        GS_STEP(2, n + 2);
    }
    if (NREM >= 1) { GS_LOAD(2, NM + 2); GS_STEP(0, NM); }
    if (NREM == 2) { GS_LOAD(0, NM + 3); GS_STEP(1, NM + 1); }
    GS_WAITN(0, 0); GS_WAITN(1, 0); GS_WAITN(2, 0);
#undef GS_STEP
#undef GS_DECL
#undef GS_WAIT
#undef GS_WAITN
#undef GS_GLD16
#undef GS_GLD8
    asm volatile("s_waitcnt vmcnt(0)" ::: "memory");
#undef GS_LOAD
    if (N1 == 64) {
#pragma unroll
        for (int njj = 0; njj < 2; ++njj)
#pragma unroll
            for (int r = 0; r < 4; ++r) Sout[(((size_t)b * 4 + h) * 128 + wave * 16 + 4 * fq + r) * 128 + sl * 32 + njj * 16 + fr] = accS[njj][r];
    }
    __syncthreads();
}

__device__ __forceinline__ void lru_prep_unit(const bf16* __restrict__ PROJ, const float* __restrict__ conv_w, const float* __restrict__ conv_b,
                                              const float* __restrict__ w_r, const float* __restrict__ b_r, const float* __restrict__ w_i, const float* __restrict__ b_i, const float* __restrict__ lam,
                                              float* __restrict__ H, float* __restrict__ P, float* __restrict__ Hend, float* __restrict__ Pend, float* __restrict__ p_lru_conv, int ub) {
    int c = threadIdx.x; asm volatile("" : "+v"(c));
    const int nblk = c >> 6, d = c & 63;
    const int n = ub & 63, b = ub >> 6, t0 = b * SEQ + n * 64;
    float wr[64], wi[64];
#pragma unroll
    for (int cc = 0; cc < 64; ++cc) { wr[cc] = w_r[((size_t)nblk * 64 + cc) * 64 + d]; wi[cc] = w_i[((size_t)nblk * 64 + cc) * 64 + d]; }
    const float cw0 = conv_w[c], cw1 = conv_w[512 + c], cw2 = conv_w[1024 + c], cw3 = conv_w[1536 + c], cb_ = conv_b[c];
    const float br = b_r[c], bi = b_i[c], spl = -8.0f * softplusf_(-lam[c]);
    float x0 = (n * 64 - 3 >= 0) ? bf2f(PROJ[(size_t)(t0 - 3) * ABN + C_XR + c]) : 0.f;
    float x1 = (n * 64 - 2 >= 0) ? bf2f(PROJ[(size_t)(t0 - 2) * ABN + C_XR + c]) : 0.f;
    float x2 = (n * 64 - 1 >= 0) ? bf2f(PROJ[(size_t)(t0 - 1) * ABN + C_XR + c]) : 0.f;
    float hloc = 0.f, ploc = 1.f;
    bf16 xa[16], xb[16];
#pragma unroll
    for (int k = 0; k < 16; ++k) xa[k] = PROJ[(size_t)(t0 + k) * ABN + C_XR + c];
#pragma unroll 1
    for (int ib = 0; ib < 64; ib += 16) {
      if (ib + 16 < 64) {
#pragma unroll
        for (int k = 0; k < 16; ++k) xb[k] = PROJ[(size_t)(t0 + ib + 16 + k) * ABN + C_XR + c];
      }
#pragma unroll
      for (int k = 0; k < 16; ++k) {
        const int i = ib + k;
        const float xt = bf2f(xa[k]);
        const float xr = cb_ + cw0 * x0 + cw1 * x1 + cw2 * x2 + cw3 * xt;
        f32x2_t ga = (f32x2_t){br, bi}, gb = (f32x2_t){0.f, 0.f};
#pragma unroll
        for (int cc = 0; cc < 64; cc += 2) {
            const float xa_ = __uint_as_float(__builtin_amdgcn_readlane(__float_as_uint(xr), cc)), xb_ = __uint_as_float(__builtin_amdgcn_readlane(__float_as_uint(xr), cc + 1));
            ga += (f32x2_t){xa_, xa_} * (f32x2_t){wr[cc], wi[cc]}; gb += (f32x2_t){xb_, xb_} * (f32x2_t){wr[cc + 1], wi[cc + 1]};
        }
        ga += gb;
        const float r = __frcp_rn(1.0f + __expf(-ga.x)), ii = __frcp_rn(1.0f + __expf(-ga.y));
        const float a = __expf(spl * r), bb = __fsqrt_rn(fmaxf(1.0f - a * a, 0.f)) * (ii * xr);
        hloc = a * hloc + bb; ploc *= a;
        H[(size_t)(t0 + i) * 512 + c] = hloc; P[(size_t)(t0 + i) * 512 + c] = ploc;
        if (n == 63 && i >= 61) p_lru_conv[((size_t)b * 3 + (i - 61)) * 512 + c] = xt;
        x0 = x1; x1 = x2; x2 = xt;
      }
#pragma unroll
      for (int k = 0; k < 16; ++k) xa[k] = xb[k];
    }
    Hend[(size_t)ub * 512 + c] = hloc; Pend[(size_t)ub * 512 + c] = ploc;
}
constexpr int LR_XR = 64 * 68 * 4;
__device__ __forceinline__ void lru_prep_unit2(const bf16* __restrict__ PROJ, const float* __restrict__ conv_w, const float* __restrict__ conv_b,
                                               const bf16* __restrict__ WRT, const bf16* __restrict__ WIT  , const float* __restrict__ b_r, const float* __restrict__ b_i, const float* __restrict__ lam,
                                               float* __restrict__ H, float* __restrict__ P, float* __restrict__ Hend, float* __restrict__ Pend, float* __restrict__ p_lru_conv, int ub, unsigned char* lds) {
    int tid = threadIdx.x; asm volatile("" : "+v"(tid));
    const int lane = tid & 63, wave = __builtin_amdgcn_readfirstlane(tid >> 6), fr = lane & 15, fq = lane >> 4;
    const int n = ub & 63, b = ub >> 6, t0 = b * SEQ + n * 64;
    float* XR = (float*)(lds + wave * LR_XR);
    {
        const int c = wave * 64 + lane;
        const float cw0 = conv_w[c], cw1 = conv_w[512 + c], cw2 = conv_w[1024 + c], cw3 = conv_w[1536 + c], cb_ = conv_b[c];
        float x0 = (n * 64 - 3 >= 0) ? bf2f(PROJ[(size_t)(t0 - 3) * ABN + C_XR + c]) : 0.f;
        float x1 = (n * 64 - 2 >= 0) ? bf2f(PROJ[(size_t)(t0 - 2) * ABN + C_XR + c]) : 0.f;
        float x2 = (n * 64 - 1 >= 0) ? bf2f(PROJ[(size_t)(t0 - 1) * ABN + C_XR + c]) : 0.f;
#pragma unroll 1
        for (int ib = 0; ib < 64; ib += 16) {
            bf16 xa[16];
#pragma unroll
            for (int k = 0; k < 16; ++k) xa[k] = PROJ[(size_t)(t0 + ib + k) * ABN + C_XR + c];
#pragma unroll
            for (int k = 0; k < 16; ++k) {
                const int i = ib + k; const float xt = bf2f(xa[k]);
                XR[i * 68 + lane] = cb_ + cw0 * x0 + cw1 * x1 + cw2 * x2 + cw3 * xt;
                if (n == 63 && i >= 61) p_lru_conv[((size_t)b * 3 + (i - 61)) * 512 + c] = xt;
                x0 = x1; x1 = x2; x2 = xt;
            }
        }
    }
    asm volatile("s_waitcnt lgkmcnt(0)" ::: "memory");
    bf16x8_t bR[4][2], bI[4][2];
#pragma unroll
    for (int nt = 0; nt < 4; ++nt)
#pragma unroll
        for (int ks = 0; ks < 2; ++ks) {
            bR[nt][ks] = *(const bf16x8_t*)(WRT + ((size_t)wave * 64 + nt * 16 + fr) * 64 + ks * 32 + 8 * fq);
            bI[nt][ks] = *(const bf16x8_t*)(WIT + ((size_t)wave * 64 + nt * 16 + fr) * 64 + ks * 32 + 8 * fq);
        }
    float brv[4], biv[4], splv[4];
#pragma unroll
    for (int nt = 0; nt < 4; ++nt) { const int c = wave * 64 + nt * 16 + fr; brv[nt] = b_r[c]; biv[nt] = b_i[c]; splv[nt] = -8.0f * softplusf_(-lam[c]); }
    float hin[4], pin[4];
#pragma unroll
    for (int nt = 0; nt < 4; ++nt) { hin[nt] = 0.f; pin[nt] = 1.f; }
#pragma unroll 1
    for (int mt = 0; mt < 4; ++mt) {
        bf16x8_t aX[2];
#pragma unroll
        for (int ks = 0; ks < 2; ++ks) {
            const f32x4 lo = *(const f32x4*)(XR + (mt * 16 + fr) * 68 + ks * 32 + 8 * fq), hi = *(const f32x4*)(XR + (mt * 16 + fr) * 68 + ks * 32 + 8 * fq + 4);
            v4u w; w.x = pk2(lo.x, lo.y); w.y = pk2(lo.z, lo.w); w.z = pk2(hi.x, hi.y); w.w = pk2(hi.z, hi.w);
            aX[ks] = __builtin_bit_cast(bf16x8_t, w);
        }
#pragma unroll
        for (int nt = 0; nt < 4; ++nt) {
            f32x4 aR = (f32x4){0.f, 0.f, 0.f, 0.f}, aI = aR;
            aR = mfma16(aX[0], bR[nt][0], aR); aR = mfma16(aX[1], bR[nt][1], aR);
            aI = mfma16(aX[0], bI[nt][0], aI); aI = mfma16(aX[1], bI[nt][1], aI);
            float av[4], bv[4];
#pragma unroll
            for (int r = 0; r < 4; ++r) {
                const float rg = __frcp_rn(1.0f + __expf(-(aR[r] + brv[nt]))), ig = __frcp_rn(1.0f + __expf(-(aI[r] + biv[nt])));
                const float a = __expf(splv[nt] * rg);
                av[r] = a; bv[r] = __fsqrt_rn(fmaxf(1.0f - a * a, 0.f)) * (ig * XR[(mt * 16 + 4 * fq + r) * 68 + nt * 16 + fr]);
            }
            float PA[4], PB[4];
            PA[0] = av[0]; PB[0] = bv[0];
#pragma unroll
            for (int r = 1; r < 4; ++r) { PA[r] = av[r] * PA[r - 1]; PB[r] = av[r] * PB[r - 1] + bv[r]; }
            float GA = PA[3], GB = PB[3];
            { const float pa = __shfl_up(GA, 16), pb = __shfl_up(GB, 16); if (fq >= 1) { GB = GA * pb + GB; GA = GA * pa; } }
            { const float pa = __shfl_up(GA, 32), pb = __shfl_up(GB, 32); if (fq >= 2) { GB = GA * pb + GB; GA = GA * pa; } }
            float EA = __shfl_up(GA, 16), EB = __shfl_up(GB, 16);
            if (fq == 0) { EA = 1.f; EB = 0.f; }
            const float h0 = EA * hin[nt] + EB, p0 = pin[nt] * EA;
#pragma unroll
            for (int r = 0; r < 4; ++r) {
                const size_t o = (size_t)(t0 + mt * 16 + 4 * fq + r) * 512 + wave * 64 + nt * 16 + fr;
                H[o] = PA[r] * h0 + PB[r]; P[o] = p0 * PA[r];
            }
            const float TA = __shfl(GA, 48 + fr), TB = __shfl(GB, 48 + fr);
            hin[nt] = TA * hin[nt] + TB; pin[nt] = pin[nt] * TA;
        }
    }
    if (fq == 0) {
#pragma unroll
        for (int nt = 0; nt < 4; ++nt) { Hend[(size_t)ub * 512 + wave * 64 + nt * 16 + fr] = hin[nt]; Pend[(size_t)ub * 512 + wave * 64 + nt * 16 + fr] = pin[nt]; }
    }
    asm volatile("s_waitcnt lgkmcnt(0)" ::: "memory");
}
__device__ __forceinline__ void lru_carry(const float* __restrict__ Hend, const float* __restrict__ Pend, float* __restrict__ CIN, float* __restrict__ hlast, int bx) {
    int tx_ = threadIdx.x; asm volatile("" : "+v"(tx_));
    const int idx = bx * NTH + tx_, b = idx >> 9, c = idx & 511;
    float carry = 0.f;
#pragma unroll 8
    for (int n = 0; n < 64; ++n) {
        const size_t o = ((size_t)b * 64 + n) * 512 + c;
        CIN[o] = carry;
        carry = Hend[o] + Pend[o] * carry;
    }
    hlast[(size_t)b * 512 + c] = carry;
}

__device__ __forceinline__ unsigned f2key(float f) { const unsigned u = __float_as_uint(f); return u ^ ((u >> 31) ? 0xffffffffu : 0x80000000u); }
__device__ __forceinline__ float key2f(unsigned k) { return __uint_as_float(k ^ ((k >> 31) ? 0x80000000u : 0xffffffffu)); }
#define TK_CE(hi, lo) do { const unsigned a_ = (hi), b_ = (lo); (hi) = a_ > b_ ? a_ : b_; (lo) = a_ > b_ ? b_ : a_; } while (0)
template <int N> __device__ __forceinline__ void bitonic_sort_desc(unsigned (&a)[N]) {
#pragma unroll
    for (int k = 2; k <= N; k <<= 1)
#pragma unroll
        for (int j = k >> 1; j > 0; j >>= 1)
#pragma unroll
            for (int i = 0; i < N; ++i) { const int l = i ^ j; if (l > i) { if ((i & k) == 0) TK_CE(a[i], a[l]); else TK_CE(a[l], a[i]); } }
}
template <int XM> __device__ __forceinline__ void merge_top16(unsigned (&a)[16]) {
    unsigned c[16];
#pragma unroll
    for (int i = 0; i < 16; ++i) { const unsigned o = (unsigned)__shfl_xor((int)a[15 - i], XM); c[i] = a[i] > o ? a[i] : o; }
#pragma unroll
    for (int j = 8; j > 0; j >>= 1)
#pragma unroll
        for (int i = 0; i < 16; ++i) { const int l = i ^ j; if (l > i) TK_CE(c[i], c[l]); }
#pragma unroll
    for (int i = 0; i < 16; ++i) a[i] = c[i];
}
constexpr int TK_KS = 0, TK_TS = 2 * 128 * 136 * 2, TK_END = TK_TS + 64 * 2 * 16 * 4;
__device__ __forceinline__ void peer_topk_stage_keys(const bf16* __restrict__ KB, int h, unsigned char* lds) {
    bf16* Ks = (bf16*)(lds + TK_KS);
    for (int ci = threadIdx.x; ci < 2 * 128 * 16; ci += NTH) { const int row = ci >> 4, part = ci & 15;
        *(v4u*)(Ks + row * 136 + part * 8) = *(const v4u*)(KB + ((size_t)h * 256 + row) * 128 + part * 8); }
    __syncthreads();
}
__device__ __forceinline__ void peer_topk4(const bf16* __restrict__ Q, int* __restrict__ EXP, float* __restrict__ GATE, int tile, int h, unsigned char* lds) {
    int tid = threadIdx.x; asm volatile("" : "+v"(tid));
    const int lane = tid & 63, wave = __builtin_amdgcn_readfirstlane(tid >> 6), fr = lane & 15, fq = lane >> 4;
    const bf16* Ks = (const bf16*)(lds + TK_KS); unsigned* Ts = (unsigned*)(lds + TK_TS);
    {
        const int c = wave >> 2, nt = wave & 3;
        bf16x8_t bq[4];
#pragma unroll
        for (int ks = 0; ks < 4; ++ks) bq[ks] = *(const bf16x8_t*)(Q + (size_t)(tile * 64 + nt * 16 + fr) * 2048 + h * 256 + c * 128 + ks * 32 + 8 * fq);
        unsigned a[32];
#pragma unroll
        for (int mt = 0; mt < 8; ++mt) {
            f32x4 acc = (f32x4){0.f, 0.f, 0.f, 0.f};
#pragma unroll
            for (int ks = 0; ks < 4; ++ks) { const bf16x8_t ak = *(const bf16x8_t*)(Ks + (c * 128 + mt * 16 + fr) * 136 + ks * 32 + 8 * fq); acc = mfma16(ak, bq[ks], acc); }
#pragma unroll
            for (int r = 0; r < 4; ++r) a[mt * 4 + r] = (f2key(acc[r]) & ~127u) | (unsigned)(127 - (mt * 16 + 4 * fq + r));
        }
        bitonic_sort_desc<32>(a);
        unsigned t[16];
#pragma unroll
        for (int j = 0; j < 16; ++j) t[j] = a[j];
        merge_top16<16>(t); merge_top16<32>(t);
        if (fq == 0) {
            const int tk = nt * 16 + fr;
#pragma unroll
            for (int j = 0; j < 16; ++j) Ts[(tk * 2 + c) * 16 + j] = t[j];
        }
    }
    __syncthreads();
    if (tid < 256) {
        const int tk = tid >> 2, q = tid & 3;
        const unsigned* t0 = Ts + (tk * 2 + 0) * 16; const unsigned* t1 = Ts + (tk * 2 + 1) * 16;
        unsigned a[16];
#pragma unroll
        for (int s = 0; s < 13; ++s) {
            const int e = s * 4 + q;
            int i, j;
            if (e < 16) { i = 0; j = e; } else if (e < 24) { i = 1; j = e - 16; } else if (e < 29) { i = 2; j = e - 24; } else if (e < 33) { i = 3; j = e - 29; }
            else if (e < 36) { i = 4; j = e - 33; } else if (e < 42) { i = 5 + ((e - 36) >> 1); j = (e - 36) & 1; } else { i = 8 + (e - 42); j = 0; }
            const bool ok = e < 50;
            const float sum = key2f(t0[ok ? i : 0] & ~127u) + key2f(t1[ok ? j : 0] & ~127u);
            a[s] = ok ? ((f2key(sum) & ~255u) | (unsigned)(255 - (i * 16 + j))) : 0u;
        }
        a[13] = 0u; a[14] = 0u; a[15] = 0u;
        bitonic_sort_desc<16>(a);
        merge_top16<1>(a); merge_top16<2>(a);
        float ev[16], sum = 0.f; const float m = key2f(a[0] & ~255u);
#pragma unroll
        for (int j = 0; j < 16; ++j) { ev[j] = __expf(key2f(a[j] & ~255u) - m); sum += ev[j]; }
        const float inv = 1.0f / sum;
        const size_t o = (size_t)(tile * 64 + tk) * 128 + h * 16;
#pragma unroll
        for (int j = 0; j < 16; ++j)
            if ((j >> 2) == q) {
                const int code = 255 - (int)(a[j] & 255u), i = code >> 4, jj = code & 15;
                const int n0 = 127 - (int)(t0[i] & 127u), n1 = 127 - (int)(t1[jj] & 127u);
                EXP[o + j] = n0 * 128 + n1; GATE[o + j] = ev[j] * inv;
            }
    }
    __syncthreads();
}

constexpr int AT_KS = 0, AT_VT = 192 * 72 * 2, AT_BT = AT_VT + 64 * 200 * 2, AT_PW = AT_BT + 4 * 128 * 4, AT_END = AT_PW + 8 * 32 * 72 * 2;
__device__ __forceinline__ void attn_unit(const bf16* __restrict__ PCb, const float* __restrict__ rel_bias, const float* __restrict__ sinks, bf16* __restrict__ ATT, int un, unsigned char* lds) {
    int tid = threadIdx.x; asm volatile("" : "+v"(tid));
    const int lane = tid & 63, wave = __builtin_amdgcn_readfirstlane(tid >> 6), fr = lane & 15, fq = lane >> 4;
    const int kvh = un & 3, qblk = (un >> 2) & 63, b = un >> 8;
    const int q0 = qblk * 64, tb = b * SEQ;
    bf16* Ks = (bf16*)(lds + AT_KS); bf16* Vt = (bf16*)(lds + AT_VT); float* Bt = (float*)(lds + AT_BT); bf16* Pw = (bf16*)(lds + AT_PW) + wave * 32 * 72;
#pragma unroll
    for (int k = 0; k < 3; ++k) {
        const int ci = tid + 512 * k, row = ci >> 3, part = ci & 7, kpos = q0 - 128 + row;
        v4u kv = (v4u){0u, 0u, 0u, 0u}, vv = kv;
        if (kpos >= 0) { const bf16* src = PCb + (size_t)(tb + kpos) * CN + kvh * 64 + part * 8; kv = *(const v4u*)(src + 1024); vv = *(const v4u*)(src + 1280); }
        *(v4u*)(Ks + row * 72 + part * 8) = kv;
        bf16* vd = Vt + (part * 8) * 200 + row;
        vd[0 * 200] = (bf16)(vv.x & 0xffffu); vd[1 * 200] = (bf16)(vv.x >> 16); vd[2 * 200] = (bf16)(vv.y & 0xffffu); vd[3 * 200] = (bf16)(vv.y >> 16);
        vd[4 * 200] = (bf16)(vv.z & 0xffffu); vd[5 * 200] = (bf16)(vv.z >> 16); vd[6 * 200] = (bf16)(vv.w & 0xffffu); vd[7 * 200] = (bf16)(vv.w >> 16);
    }
    Bt[tid] = rel_bias[t5_bucket(tid & 127) * 16 + kvh * 4 + (tid >> 7)];
    __syncthreads();
    const int g = wave >> 1, qs = (wave & 1) * 32, hh = kvh * 4 + g;
    bf16x8_t aQ[2][2];
#pragma unroll
    for (int mt = 0; mt < 2; ++mt)
#pragma unroll
        for (int ks = 0; ks < 2; ++ks) aQ[mt][ks] = *(const bf16x8_t*)(PCb + (size_t)(tb + q0 + qs + mt * 16 + fr) * CN + hh * 64 + ks * 32 + 8 * fq);
    f32x4 sc[2][12];
#pragma unroll
    for (int nt = 0; nt < 12; ++nt) {
        const bf16x8_t b0 = *(const bf16x8_t*)(Ks + (nt * 16 + fr) * 72 + 8 * fq), b1 = *(const bf16x8_t*)(Ks + (nt * 16 + fr) * 72 + 32 + 8 * fq);
#pragma unroll
        for (int mt = 0; mt < 2; ++mt) { f32x4 a = (f32x4){0.f, 0.f, 0.f, 0.f}; a = mfma16(aQ[mt][0], b0, a); a = mfma16(aQ[mt][1], b1, a); sc[mt][nt] = a; }
    }
    const float sink = sinks[hh];
    const float* bt = Bt + g * 128;
#pragma unroll
    for (int mt = 0; mt < 2; ++mt)
#pragma unroll
        for (int r = 0; r < 4; ++r) {
            const int qi = qs + mt * 16 + 4 * fq + r;
            float mx = sink;
#pragma unroll
            for (int nt = 0; nt < 12; ++nt) {
                const int kk = nt * 16 + fr, rel = qi + 128 - kk;
                const bool valid = rel >= 0 && rel < 128 && (q0 - 128 + kk) >= 0;
                const float lg = valid ? sc[mt][nt][r] * 0.125f + bt[valid ? rel : 0] : -INFINITY;
                sc[mt][nt][r] = lg; mx = fmaxf(mx, lg);
            }
            mx = fmaxf(mx, __shfl_xor(mx, 1)); mx = fmaxf(mx, __shfl_xor(mx, 2)); mx = fmaxf(mx, __shfl_xor(mx, 4)); mx = fmaxf(mx, __shfl_xor(mx, 8));
            float sum = 0.f;
#pragma unroll
            for (int nt = 0; nt < 12; ++nt) { const float p = __expf(sc[mt][nt][r] - mx); sc[mt][nt][r] = p; sum += p; }
            sum += __shfl_xor(sum, 1); sum += __shfl_xor(sum, 2); sum += __shfl_xor(sum, 4); sum += __shfl_xor(sum, 8);
            const float inv = 1.0f / (sum + __expf(sink - mx));
#pragma unroll
            for (int nt = 0; nt < 12; ++nt) sc[mt][nt][r] *= inv;
        }
    f32x4 oacc[2][4];
#pragma unroll
    for (int mt = 0; mt < 2; ++mt)
#pragma unroll
        for (int dt = 0; dt < 4; ++dt) oacc[mt][dt] = (f32x4){0.f, 0.f, 0.f, 0.f};
#pragma unroll
    for (int kc = 0; kc < 3; ++kc) {
#pragma unroll
        for (int mt = 0; mt < 2; ++mt)
#pragma unroll
            for (int n4 = 0; n4 < 4; ++n4)
#pragma unroll
                for (int r = 0; r < 4; ++r) Pw[(mt * 16 + 4 * fq + r) * 72 + n4 * 16 + fr] = (bf16)f2bf(sc[mt][kc * 4 + n4][r]);
        asm volatile("s_waitcnt lgkmcnt(0)" ::: "memory");
#pragma unroll
        for (int ks = 0; ks < 2; ++ks) {
            const bf16x8_t p0 = *(const bf16x8_t*)(Pw + fr * 72 + ks * 32 + 8 * fq), p1 = *(const bf16x8_t*)(Pw + (16 + fr) * 72 + ks * 32 + 8 * fq);
#pragma unroll
            for (int dt = 0; dt < 4; ++dt) {
                const bf16x8_t bv = *(const bf16x8_t*)(Vt + (dt * 16 + fr) * 200 + kc * 64 + ks * 32 + 8 * fq);
                oacc[0][dt] = mfma16(p0, bv, oacc[0][dt]); oacc[1][dt] = mfma16(p1, bv, oacc[1][dt]);
            }
        }
        asm volatile("s_waitcnt lgkmcnt(0)" ::: "memory");
    }
#pragma unroll
    for (int mt = 0; mt < 2; ++mt)
#pragma unroll
        for (int dt = 0; dt < 4; ++dt)
#pragma unroll
            for (int r = 0; r < 4; ++r) Pw[(mt * 16 + 4 * fq + r) * 72 + dt * 16 + fr] = (bf16)f2bf(oacc[mt][dt][r]);
    asm volatile("s_waitcnt lgkmcnt(0)" ::: "memory");
#pragma unroll
    for (int k = 0; k < 4; ++k) {
        const int ci = lane + 64 * k, row = ci >> 3, part = ci & 7;
        *(v4u*)(ATT + (size_t)(tb + q0 + qs + row) * D + hh * 64 + part * 8) = *(const v4u*)(Pw + row * 72 + part * 8);
    }
    __syncthreads();
}

__device__ __forceinline__ void swa_attn_sample(const bf16* __restrict__ PCb, const float* __restrict__ cache_k, const float* __restrict__ cache_v,
                                                const float* __restrict__ rel_bias, const float* __restrict__ sinks, bf16* __restrict__ ATT, int gw, int lane) {
    const int sb = gw >> 4, h = gw & 15, kvh = h >> 2, t = NP + sb;
    const bf16* qrow = PCb + (size_t)t * CN + h * 64;
    float lg[2];
#pragma unroll
    for (int rr = 0; rr < 2; ++rr) {
        const int r = lane + 64 * rr;
        float dot = 0.f;
        if (r == 0) {
            const bf16* krow = PCb + (size_t)t * CN + 1024 + kvh * 64;
            for (int d = 0; d < 64; ++d) dot += bf2f(qrow[d]) * bf2f(krow[d]);
        } else {
            const float* krow = cache_k + (((size_t)sb * 128 + (128 - r)) * 4 + kvh) * 64;
#pragma unroll
            for (int d4 = 0; d4 < 16; ++d4) { const float4 kv = *(const float4*)(krow + d4 * 4);
                dot += bf2f(qrow[d4 * 4]) * kv.x + bf2f(qrow[d4 * 4 + 1]) * kv.y + bf2f(qrow[d4 * 4 + 2]) * kv.z + bf2f(qrow[d4 * 4 + 3]) * kv.w; }
        }
        lg[rr] = dot * 0.125f + rel_bias[t5_bucket(r) * 16 + h];
    }
    const float sink = sinks[h];
    const float m = fmaxf(wave_max(fmaxf(lg[0], lg[1])), sink);
    float p[2] = {expf(lg[0] - m), expf(lg[1] - m)};
    const float inv = 1.0f / (wave_sum(p[0] + p[1]) + expf(sink - m));
    float o = 0.f;
#pragma unroll
    for (int rr = 0; rr < 2; ++rr)
#pragma unroll 1
        for (int lb = 0; lb < 64; lb += 16) {
            float vv[16];
#pragma unroll
            for (int k = 0; k < 16; ++k) { const int r = lb + k + 64 * rr;
                vv[k] = (r == 0) ? bf2f(PCb[(size_t)t * CN + 1280 + kvh * 64 + lane]) : cache_v[(((size_t)sb * 128 + (128 - r)) * 4 + kvh) * 64 + lane]; }
#pragma unroll
            for (int k = 0; k < 16; ++k) o += __shfl(p[rr], lb + k) * vv[k];
        }
    ATT[(size_t)t * D + h * 64 + lane] = (bf16)f2bf(o * inv);
}
__device__ __forceinline__ void swa_kv_out3(const bf16* __restrict__ PCb, const float* __restrict__ cache_k, const float* __restrict__ cache_v,
                                            float* __restrict__ pk, float* __restrict__ pv, float* __restrict__ sk, float* __restrict__ sv, int item) {
    int tid = threadIdx.x; asm volatile("" : "+v"(tid));
    if (item < 256) {
        const int sb = item >> 1, isv = item & 1;
        const f32x4* src = (const f32x4*)((isv ? cache_v : cache_k) + ((size_t)sb * 128 + 1) * 256);
        f32x4* dst = (f32x4*)((isv ? sv : sk) + (size_t)sb * 128 * 256);
#pragma unroll 4
        for (int i = tid; i < 127 * 64; i += NTH) dst[i] = src[i];
        if (tid < 32) {
            const v4u w = *(const v4u*)(PCb + (size_t)(NP + sb) * CN + 1024 + isv * 256 + tid * 8);
            f32x4* d = dst + 127 * 64 + tid * 2;
            d[0] = (f32x4){bflo(w.x), bfhi(w.x), bflo(w.y), bfhi(w.y)}; d[1] = (f32x4){bflo(w.z), bfhi(w.z), bflo(w.w), bfhi(w.w)};
        }
    } else {
        const int b = item - 256;
#pragma unroll 4
        for (int e = tid; e < 128 * 64; e += NTH) {
            const int row = e >> 6, part = e & 63;
            const v4u w = *(const v4u*)(PCb + (size_t)(b * SEQ + SEQ - 128 + row) * CN + 1024 + part * 8);
            f32x4* d = (f32x4*)((part < 32 ? pk : pv) + ((size_t)b * 128 + row) * 256 + (part & 31) * 8);
            d[0] = (f32x4){bflo(w.x), bfhi(w.x), bflo(w.y), bfhi(w.y)}; d[1] = (f32x4){bflo(w.z), bfhi(w.z), bflo(w.w), bfhi(w.w)};
        }
    }
}


__device__ __forceinline__ void sample_gemm_piece(const bf16* __restrict__ A, const bf16* __restrict__ Bt, const float* __restrict__ bias, bf16* __restrict__ O, int ldc, int p, unsigned char* lds) {
    int tid = threadIdx.x; asm volatile("" : "+v"(tid));
    const int lane = tid & 63, wave = __builtin_amdgcn_readfirstlane(tid >> 6), fr = lane & 15, fq = lane >> 4;
    const int mt = p & 7, cb = p >> 3, nt = wave & 3, kh = wave >> 2;
    const bf16* ap = A + (size_t)(NP + mt * 16 + fr) * D + kh * 512 + 8 * fq;
    const bf16* bp = Bt + (size_t)(cb * 64 + nt * 16 + fr) * D + kh * 512 + 8 * fq;
    bf16x8_t a[16], b[16];
#pragma unroll
    for (int ks = 0; ks < 16; ++ks) { a[ks] = *(const bf16x8_t*)(ap + ks * 32); b[ks] = *(const bf16x8_t*)(bp + ks * 32); }
    f32x4 acc = (f32x4){0.f, 0.f, 0.f, 0.f};
#pragma unroll
    for (int ks = 0; ks < 16; ++ks) acc = mfma16(a[ks], b[ks], acc);
    f32x4* part = (f32x4*)lds;
    if (kh == 1) part[nt * 64 + lane] = acc;
    __syncthreads();
    if (kh == 0) {
        acc = acc + part[nt * 64 + lane];
        const int col = cb * 64 + nt * 16 + fr; const float bv = bias ? bias[col] : 0.f;
#pragma unroll
        for (int r = 0; r < 4; ++r) O[(size_t)(NP + mt * 16 + 4 * fq + r) * ldc + col] = (bf16)f2bf(acc[r] + bv);
    }
    __syncthreads();
}

constexpr size_t MiB = 1u << 20;
constexpr size_t WS_CTL = 0, CTL_ZERO_BYTES = 64 * 1024;
constexpr size_t WS_WAB = 1 * MiB;
constexpr size_t WS_WOUT = WS_WAB + (size_t)ABNP * D * 2;
constexpr size_t WS_WQ0 = WS_WOUT + (size_t)D * D * 2;
constexpr size_t WS_WQ1 = WS_WQ0 + (size_t)2048 * D * 2;
constexpr size_t WS_WINC = WS_WQ1 + (size_t)2048 * D * 2;
constexpr size_t WS_WOUTC = WS_WINC + (size_t)CN * D * 2;
constexpr size_t WS_ABUF = WS_WOUTC + (size_t)D * D * 2;
constexpr size_t WS_P = WS_ABUF + (size_t)MP * D * 2;
constexpr size_t WS_T = WS_P + (size_t)MP * ABN * 2;
constexpr size_t WS_Q = WS_T + (size_t)4 * 16384 * D + (size_t)4 * 16384 * 4;
constexpr size_t WS_A = WS_Q + (size_t)MP * 1536 * 4;
constexpr size_t WS_B = WS_A + (size_t)MP * 512 * 4;
constexpr size_t WS_O = WS_B + (size_t)MP * 512 * 4;
constexpr size_t WS_X1 = WS_O + (size_t)MP * 512 * 4;
constexpr size_t WS_G = WS_X1 + (size_t)MP * D * 4;
constexpr size_t WS_BETA = WS_G + (size_t)MP * 4 * 4;
constexpr size_t WS_GATE = WS_BETA + (size_t)MP * 4 * 4;
constexpr size_t WS_EXP = WS_GATE + (size_t)MP * 128 * 4;
constexpr size_t WS_HEND = WS_EXP + (size_t)MP * 128 * 4;
constexpr size_t WS_KEYS = WS_HEND + (size_t)3 * 4 * 64 * 512 * 4;
constexpr size_t WS_WGT = WS_KEYS + (size_t)2 * 8 * 2 * 128 * 128 * 2;
constexpr size_t WS_END = WS_WGT + (size_t)2 * 8 * 64 * 64 * 2;
constexpr size_t Q_QKVS = 0, Q_W = 1 * MiB, Q_QG = Q_W + 16 * MiB, Q_KDT = Q_QG + 16 * MiB, Q_UT = Q_KDT + 16 * MiB, Q_QK = Q_UT + 16 * MiB, Q_EGL = Q_QK + 8 * MiB, Q_END = Q_EGL + 4096;
static_assert(Q_END <= (size_t)MP * 1536 * 4, "region Q");
static_assert(WS_END <= 512 * MiB, "d_ws map");

struct MegaArgs {
    const float* in[35];
    float* out;
    unsigned char* ws;
};

__global__ void __launch_bounds__(NTH, 2) fwd_megakernel(MegaArgs ma) {
    cg::grid_group grid = cg::this_grid();
    extern __shared__ __attribute__((aligned(16))) unsigned char lds[];
    float* smem = (float*)lds;
    const int nb = gridDim.x, b0 = blockIdx.x, wave = __builtin_amdgcn_readfirstlane(threadIdx.x >> 6);
    int tid = threadIdx.x, lane = tid & 63;
    const float* x_prompt = ma.in[0];
    const float* x_sample = ma.in[1];
    const float* state_gdn = ma.in[2];
    const float* state_gdn_conv = ma.in[3];
    const float* state_lru = ma.in[4];
    const float* state_lru_conv = ma.in[5];
    const float* cache_k = ma.in[6];
    const float* cache_v = ma.in[7];
    const float* w_in_ab = ma.in[8];
    const float* gdn_conv_w = ma.in[9];
    const float* gdn_a_log = ma.in[10];
    const float* gdn_dt_bias = ma.in[11];
    const float* gdn_norm_w = ma.in[12];
    const float* lru_conv_w = ma.in[13];
    const float* lru_conv_b = ma.in[14];
    const float* lru_w_r = ma.in[15];
    const float* lru_b_r = ma.in[16];
    const float* lru_w_i = ma.in[17];
    const float* lru_b_i = ma.in[18];
    const float* lru_lam = ma.in[19];
    const float* w_out_ab = ma.in[20];
    const float* w_in_c = ma.in[21];
    const float* b_in_c = ma.in[22];
    const float* swa_sinks = ma.in[23];
    const float* w_out_c = ma.in[24];
    const float* b_out_c = ma.in[25];
    const float* rel_bias = ma.in[26];
    const float* ln_mix_g = ma.in[27];
    const float* ln_mix_b = ma.in[28];
    const float* ln_ffn_g = ma.in[29];
    const float* ln_ffn_b = ma.in[30];
    const float* peer_w_q = ma.in[31];
    const float* peer_keys = ma.in[32];
    const float* peer_u = ma.in[33];
    const float* peer_v = ma.in[34];

    float* out = ma.out;
    float* o_y = out;
    float* o_p_gdn = out + (size_t)NT * D;
    float* o_p_gdn_conv = o_p_gdn + 262144;
    float* o_p_lru = o_p_gdn_conv + 18432;
    float* o_p_lru_conv = o_p_lru + 2048;
    float* o_p_k = o_p_lru_conv + 6144;
    float* o_p_v = o_p_k + 131072;
    float* o_s_gdn = o_p_v + 131072;
    float* o_s_gdn_conv = o_s_gdn + 8388608;
    float* o_s_lru = o_s_gdn_conv + 589824;
    float* o_s_lru_conv = o_s_lru + 65536;
    float* o_s_k = o_s_lru_conv + 196608;
    float* o_s_v = o_s_k + 4194304;

    unsigned char* ws = ma.ws;
    bf16* WAB_T = (bf16*)(ws + WS_WAB); bf16* WOUT_T = (bf16*)(ws + WS_WOUT); bf16* WQ0_T = (bf16*)(ws + WS_WQ0); bf16* WQ1_T = (bf16*)(ws + WS_WQ1);
    bf16* WINC_T = (bf16*)(ws + WS_WINC); bf16* WOUTC_T = (bf16*)(ws + WS_WOUTC);
    bf16* ABUF = (bf16*)(ws + WS_ABUF);
    bf16* PROJ = (bf16*)(ws + WS_P); float* Y = (float*)(ws + WS_P); bf16* Qb = (bf16*)(ws + WS_P); bf16* PCb = (bf16*)(ws + WS_P); float* Y1 = (float*)(ws + WS_P);
    unsigned char* TAB8 = ws + WS_T; float* TSC = (float*)(ws + WS_T + (size_t)4 * 16384 * D);
    float* R_Q = (float*)(ws + WS_Q + Q_QKVS) - (size_t)NP * 1536; float* X2 = (float*)(ws + WS_A);
    GdnChunkBufs cbuf; cbuf.W = (bf16*)(ws + WS_Q + Q_W); cbuf.QG = (bf16*)(ws + WS_Q + Q_QG); cbuf.KDT = (bf16*)(ws + WS_Q + Q_KDT); cbuf.UT = (bf16*)(ws + WS_Q + Q_UT); cbuf.QK = (bf16*)(ws + WS_Q + Q_QK); cbuf.EGL = (float*)(ws + WS_Q + Q_EGL);
    bf16* Yb = (bf16*)(ws + WS_P);
    float* OUTS = (float*)(ws + WS_Q);
    float* PD = (float*)(ws + WS_P);
    bf16* KEYSB = (bf16*)(ws + WS_KEYS); bf16* WRT = (bf16*)(ws + WS_WGT); bf16* WIT = WRT + 8 * 64 * 64;
    float* HEND = (float*)(ws + WS_HEND); float* PEND = HEND + 4 * 64 * 512; float* CIN = PEND + 4 * 64 * 512;
    float* R_A = (float*)(ws + WS_A); float* R_B = (float*)(ws + WS_B); float* R_O = (float*)(ws + WS_O);
    bf16* XRES = (bf16*)(ws + WS_X1);
    float* R_G = (float*)(ws + WS_G); float* R_BETA = (float*)(ws + WS_BETA); float* R_GATE = (float*)(ws + WS_GATE); int* R_EXP = (int*)(ws + WS_EXP);

    for (int u = tid; u < (LDS_BYTES - RING_BYTES) / 4; u += NTH) ((unsigned*)(lds + RING_BYTES))[u] = 0u;
    __syncthreads();
    XcdBarrier bar = xcd_barrier_post((unsigned*)(ws + WS_CTL), (volatile LAS unsigned*)((LAS unsigned char*)lds + MISC_OFF) + 8);
#define GRID_BAR() do { xcd_barrier(bar); asm volatile("" : "+v"(tid)); lane = tid & 63; } while (0)
#define PHASE_LOOP(n) for (int vb = b0; vb < (n); vb += nb)
#define PHASE_END __syncthreads()
#define GEMM_PHASE_M(Mrows, EPI, Aptr, Btptr, Nn, ...) do { pg8::Gemm g_{(const pg8::bf16_t*)(Aptr), (const pg8::bf16_t*)(Btptr), (Mrows), (Nn), D}; pg8::StaticOrder S_; S_.init((Mrows), (Nn), nb, b0); \
        pg8::EPI E_{__VA_ARGS__}; pg8::gemm_phase<pg8::EPI, pg8::StaticOrder, true, true>((PG8_LAS unsigned char*)lds, g_, S_, E_); } while (0)
#define GEMM_PHASE(EPI, Aptr, Btptr, Nn, ...) GEMM_PHASE_M(MP, EPI, Aptr, Btptr, Nn, __VA_ARGS__)
#define GEMM_PHASE_SPLIT(Aptr, Btptr, Nn, Optr, biasptr) do { GEMM_PHASE_M(NP, EpiStoreBf16, Aptr, Btptr, Nn, Optr, Nn, biasptr, NP, Nn); \
        for (int p_ = b0; p_ < 8 * ((Nn) / 64); p_ += nb) sample_gemm_piece(Aptr, Btptr, biasptr, Optr, Nn, p_, lds); } while (0)

    {
        float* scr = smem + wave * 4096;
        const int gw = b0 * NWAVES + wave, NGW = nb * NWAVES;
        constexpr int I_AB = 16 * 97, I_OUT = 16 * 32, I_Q = 16 * 64, I_INC = 16 * 48;
        constexpr int NITEMS = I_AB + I_OUT + 2 * I_Q + I_INC + I_OUT;
        for (int it = gw; it < NITEMS; it += NGW) {
            int r = it;
            if (r < I_AB) { p0_transpose_item(w_in_ab, D, ABN, WAB_T, scr, r, lane); continue; } r -= I_AB;
            if (r < I_OUT) { p0_transpose_item(w_out_ab, D, D, WOUT_T, scr, r, lane); continue; } r -= I_OUT;
            if (r < I_Q) { p0_transpose_item(peer_w_q, D, 2048, WQ0_T, scr, r, lane); continue; } r -= I_Q;
            if (r < I_Q) { p0_transpose_item(peer_w_q + (size_t)D * 2048, D, 2048, WQ1_T, scr, r, lane); continue; } r -= I_Q;
            if (r < I_INC) { p0_transpose_item(w_in_c, D, CN, WINC_T, scr, r, lane); continue; } r -= I_INC;
            p0_transpose_item(w_out_c, D, D, WOUTC_T, scr, r, lane);
        }
        for (int it = b0 * NTH + tid; it < 2 * 8 * 64 * 8; it += nb * NTH) {
            const int gsel = it >> 12, nn = (it >> 9) & 7, dd = (it >> 3) & 63, c8 = (it & 7) * 8;
            const float* wsrc = (gsel ? lru_w_i : lru_w_r) + ((size_t)nn * 64 + c8) * 64 + dd;
            v4u o; o.x = pk2(wsrc[0], wsrc[64]); o.y = pk2(wsrc[128], wsrc[192]); o.z = pk2(wsrc[256], wsrc[320]); o.w = pk2(wsrc[384], wsrc[448]);
            *(v4u*)((gsel ? WIT : WRT) + ((size_t)nn * 64 + dd) * 64 + c8) = o;
        }
        for (int m = gw; m < MP + (ABNP - 97 * 32); m += NGW) {
            if (m < MP) row_to_bf16(m < NP ? x_prompt + (size_t)m * D : (m < NT ? x_sample + (size_t)(m - NP) * D : nullptr), ABUF + (size_t)m * D, lane);
            else row_to_bf16(nullptr, WAB_T + (size_t)(97 * 32 + (m - MP)) * D, lane);
        }
    }
    GRID_BAR();
    if (ma.out == nullptr) grid.sync();
    GEMM_PHASE(EpiStoreBf16, ABUF, WAB_T, ABNP, PROJ, ABN, nullptr, NT, ABN);
    GRID_BAR();
    constexpr int NSPLIT = 28, A_LRU = 4 * NSPLIT, A_GDN = 16 * NSPLIT, B_LRU = 4 * (64 - NSPLIT), B_GDN = 16 * (64 - NSPLIT);
    { AbPrepArgs pa;
      pa.PROJ = PROJ; pa.st_gdn_conv = state_gdn_conv; pa.st_lru_conv = state_lru_conv;
      pa.gdn_conv_w = gdn_conv_w; pa.a_log = gdn_a_log; pa.dt_bias = gdn_dt_bias;
      pa.lru_conv_w = lru_conv_w; pa.lru_conv_b = lru_conv_b; pa.w_r = lru_w_r; pa.b_r = lru_b_r; pa.w_i = lru_w_i; pa.b_i = lru_b_i; pa.lam = lru_lam;
      pa.QKV = R_Q; pa.G = R_G; pa.BETA = R_BETA; pa.LA = R_A; pa.LB = R_B;
      pa.p_gdn_conv = o_p_gdn_conv; pa.p_lru_conv = o_p_lru_conv; pa.s_gdn_conv = o_s_gdn_conv; pa.s_lru_conv = o_s_lru_conv;
      for (int v = b0; v < A_LRU + NS + A_GDN; v += nb) {
          if (v < A_LRU) { lru_prep_unit2(PROJ, lru_conv_w, lru_conv_b, WRT, WIT, lru_b_r, lru_b_i, lru_lam, R_B, R_A, HEND, PEND, o_p_lru_conv, (v / NSPLIT) * 64 + (v % NSPLIT), lds); PHASE_END; }
          else if (v < A_LRU + NS) { ab_prep(pa, NP + (v - A_LRU), smem); PHASE_END; }
          else { const int i = v - A_LRU - NS, h_ = i & 3, n_ = (i >> 2) % NSPLIT, b_ = (i >> 2) / NSPLIT;
                 gdn_prep_unit(PROJ, gdn_conv_w, gdn_a_log, gdn_dt_bias, cbuf, o_p_gdn_conv, (b_ * 64 + n_) * 4 + h_, lds); }
      } }
    GRID_BAR();
    f32x4 seqS[2]; int seqcur = 0;
    const int seq_p = (b0 & 7) + 8 * (b0 >> 5), seq_s = (b0 >> 3) & 3;
    if (b0 < 64) gdn_seq<0, NSPLIT>(cbuf, R_O, o_p_gdn, seq_p >> 2, seq_p & 3, seq_s, lds, seqS, seqcur);
    else for (int v = b0 - 64; v < B_LRU + B_GDN; v += nb - 64) {
        if (v < B_LRU) { lru_prep_unit2(PROJ, lru_conv_w, lru_conv_b, WRT, WIT, lru_b_r, lru_b_i, lru_lam, R_B, R_A, HEND, PEND, o_p_lru_conv, (v / (64 - NSPLIT)) * 64 + NSPLIT + (v % (64 - NSPLIT)), lds); PHASE_END; }
        else { const int i = v - B_LRU, h_ = i & 3, n_ = NSPLIT + (i >> 2) % (64 - NSPLIT), b_ = (i >> 2) / (64 - NSPLIT);
               gdn_prep_unit(PROJ, gdn_conv_w, gdn_a_log, gdn_dt_bias, cbuf, o_p_gdn_conv, (b_ * 64 + n_) * 4 + h_, lds); }
    }
    GRID_BAR();
    if (b0 < 64) gdn_seq<NSPLIT, 64>(cbuf, R_O, o_p_gdn, seq_p >> 2, seq_p & 3, seq_s, lds, seqS, seqcur);
    else if (b0 < 68) lru_carry(HEND, PEND, CIN, o_p_lru, b0 - 64);
    else {
        for (int v = (b0 - 68) * NWAVES + wave; v < NS * 4 * 8; v += (nb - 68) * NWAVES) gdn_step_sample_w(R_Q, R_G, R_BETA, state_gdn, R_O, o_s_gdn, v, lane);
        for (int v = b0 - 68; v < 128; v += nb - 68) lru_scan(R_A, R_B, state_lru, o_s_lru, NP, 1, NS, v);
        const int gw2 = (b0 - 68) * NWAVES + wave, NGW2 = (nb - 68) * NWAVES;
        for (int m = gw2; m < 512; m += NGW2) row_to_bf16(peer_keys + (size_t)m * D, KEYSB + (size_t)m * D, lane);
        for (int m = gw2; m < 4 * 16384; m += NGW2) {
            const int k = m >> 14, r = m & 16383;
            if (k & 1) row_to_fp8_sliced(peer_v + ((size_t)(k >> 1) * 16384 + r) * D, TAB8 + (size_t)k * 16384 * D, r, TSC + m, lane);
            else row_to_i8_sliced(peer_u + ((size_t)(k >> 1) * 16384 + r) * D, TAB8 + (size_t)k * 16384 * D, r, TSC + m, lane);
        }
    }
    GRID_BAR();
    PHASE_LOOP(NT / 8) { ab_mix_w(PROJ, R_O, R_B, R_A, CIN, gdn_norm_w, ABUF, vb * 8 + wave, lane); }
    GRID_BAR();
    GEMM_PHASE_SPLIT(ABUF, WOUT_T, D, Yb, (const float*)nullptr);
    GRID_BAR();
    PHASE_LOOP(NT / 8) { const int t = vb * 8 + wave;
        ln_res_w<false>(t < NP ? x_prompt + (size_t)t * D : x_sample + (size_t)(t - NP) * D, Yb + (size_t)t * D, ln_mix_g, ln_mix_b, ABUF + (size_t)t * D, lane); }
    GRID_BAR();
    GEMM_PHASE_SPLIT(ABUF, WQ0_T, 2048, Qb, (const float*)nullptr);
    GRID_BAR();
    if ((nb & 7) == 0) { peer_topk_stage_keys(KEYSB, b0 & 7, lds); PHASE_LOOP((NT / 64) * 8) { peer_topk4(Qb, R_EXP, R_GATE, vb >> 3, vb & 7, lds); } }
    else PHASE_LOOP((NT / 64) * 8) { peer_topk_stage_keys(KEYSB, vb & 7, lds); peer_topk4(Qb, R_EXP, R_GATE, vb >> 3, vb & 7, lds); }
    GRID_BAR();
    asm volatile("" : "+v"(tid)); lane = tid & 63;
    { const int x = b0 & 7, tg0 = b0 >> 3, tgstep = nb >> 3, nit = (NT / 8 - tg0 + tgstep - 1) / tgstep;
      peer_u_loop(ABUF, R_EXP, TAB8 + (size_t)x * 16384 * 128, PD + (size_t)x * NT * 128, x, tg0, tgstep, nit, wave, lane); }
    GRID_BAR();
    PHASE_LOOP(NT / 8) { const int t = vb * 8 + wave; peer_xk(R_EXP + (size_t)t * 128, R_GATE + (size_t)t * 128, PD + (size_t)t * 128, TSC, TSC + 16384, lane); }
    GRID_BAR();
    { const int x = b0 & 7, tg0 = b0 >> 3, tgstep = nb >> 3, nit = (NT / 8 - tg0 + tgstep - 1) / tgstep;
      peer_v_loop(R_EXP, R_GATE, TAB8 + (size_t)16384 * D + (size_t)x * 16384 * 128, OUTS, x, tg0, tgstep, nit, wave, lane); }
    GRID_BAR();
    PHASE_LOOP(NT / 8) { const int t = vb * 8 + wave; peer_xc(ABUF + (size_t)t * D, OUTS + (size_t)t * D, ln_ffn_g, ln_ffn_b, nullptr, ABUF + (size_t)t * D, XRES + (size_t)t * D, lane); }
    GRID_BAR();

    GEMM_PHASE(EpiStoreBf16, ABUF, WINC_T, CN, PCb, CN, b_in_c, NT, CN);
    GRID_BAR();
    PHASE_LOOP(1024 + 256 + 260) {
        if (vb < 1024) attn_unit(PCb, rel_bias, swa_sinks, ABUF, vb, lds);
        else if (vb < 1280) swa_attn_sample(PCb, cache_k, cache_v, rel_bias, swa_sinks, ABUF, (vb - 1024) * 8 + wave, lane);
        else swa_kv_out3(PCb, cache_k, cache_v, o_p_k, o_p_v, o_s_k, o_s_v, vb - 1280);
    }
    GRID_BAR();
    GEMM_PHASE_SPLIT(ABUF, WOUTC_T, D, Yb, b_out_c);
    GRID_BAR();
    PHASE_LOOP(NT / 8) { const int t = vb * 8 + wave;
        ln_res_w<true>(XRES + (size_t)t * D, Yb + (size_t)t * D, ln_mix_g + D, ln_mix_b + D, ABUF + (size_t)t * D, lane); }
    GRID_BAR();
    GEMM_PHASE_SPLIT(ABUF, WQ1_T, 2048, Qb, (const float*)nullptr);
    GRID_BAR();
    if ((nb & 7) == 0) { peer_topk_stage_keys(KEYSB + (size_t)8 * 2 * 128 * 128, b0 & 7, lds); PHASE_LOOP((NT / 64) * 8) { peer_topk4(Qb, R_EXP, R_GATE, vb >> 3, vb & 7, lds); } }
    else PHASE_LOOP((NT / 64) * 8) { peer_topk_stage_keys(KEYSB + (size_t)8 * 2 * 128 * 128, vb & 7, lds); peer_topk4(Qb, R_EXP, R_GATE, vb >> 3, vb & 7, lds); }
    GRID_BAR();
    asm volatile("" : "+v"(tid)); lane = tid & 63;
    { const int x = b0 & 7, tg0 = b0 >> 3, tgstep = nb >> 3, nit = (NT / 8 - tg0 + tgstep - 1) / tgstep;
      peer_u_loop(ABUF, R_EXP, TAB8 + (size_t)2 * 16384 * D + (size_t)x * 16384 * 128, PD + (size_t)x * NT * 128, x, tg0, tgstep, nit, wave, lane); }
    GRID_BAR();
    PHASE_LOOP(NT / 8) { const int t = vb * 8 + wave; peer_xk(R_EXP + (size_t)t * 128, R_GATE + (size_t)t * 128, PD + (size_t)t * 128, TSC + 2 * 16384, TSC + 3 * 16384, lane); }
    GRID_BAR();
    { const int x = b0 & 7, tg0 = b0 >> 3, tgstep = nb >> 3, nit = (NT / 8 - tg0 + tgstep - 1) / tgstep;
      peer_v_loop(R_EXP, R_GATE, TAB8 + (size_t)3 * 16384 * D + (size_t)x * 16384 * 128, OUTS, x, tg0, tgstep, nit, wave, lane); }
    GRID_BAR();
    PHASE_LOOP(NT / 8) { const int t = vb * 8 + wave; peer_xc(ABUF + (size_t)t * D, OUTS + (size_t)t * D, ln_ffn_g + D, ln_ffn_b + D, o_y + (size_t)t * D, nullptr, nullptr, lane); }
}
}

extern "C" void kernel_launch(void* const* d_in, const int* in_sizes, int n_in,
                              void* d_out, int out_size, void* d_ws, size_t ws_size,
                              hipStream_t stream) {
    static int grid_blocks = 0;
    if (!grid_blocks) {
        int dev = 0, cus = 0, per_cu = 0;
        (void)hipGetDevice(&dev);
        (void)hipDeviceGetAttribute(&cus, hipDeviceAttributeMultiprocessorCount, dev);
        if (hipFuncSetAttribute((const void*)fwd_megakernel, hipFuncAttributeMaxDynamicSharedMemorySize, LDS_BYTES) != hipSuccess) { fprintf(stderr, "hipFuncSetAttribute failed\n"); grid_blocks = -1; return; }
        (void)hipOccupancyMaxActiveBlocksPerMultiprocessor(&per_cu, (const void*)fwd_megakernel, NTH, LDS_BYTES);
        if (per_cu < 1) { fprintf(stderr, "occupancy query says %d blocks per CU\n", per_cu); grid_blocks = -1; return; }
        if (cus * per_cu < 256) { fprintf(stderr, "this kernel needs 256 co-resident workgroups (device reports %d CUs x %d)\n", cus, per_cu); grid_blocks = -1; return; }
        grid_blocks = 256;
    }
    if (grid_blocks < 0) return;
    (void)hipMemsetAsync((char*)d_ws + WS_CTL, 0, CTL_ZERO_BYTES, stream);
    MegaArgs ma{};
    for (int i = 0; i < 35; ++i) ma.in[i] = (const float*)d_in[i];
    ma.out = (float*)d_out;
    ma.ws = (unsigned char*)d_ws;
    void* args[] = {&ma};
    hipError_t e = hipLaunchCooperativeKernel((void*)fwd_megakernel, dim3(grid_blocks), dim3(NTH), args, LDS_BYTES, stream);
    if (e != hipSuccess) fprintf(stderr, "cooperative launch failed: %s (grid %d)\n", hipGetErrorString(e), grid_blocks);
}
```

```cpp
#include <hip/hip_runtime.h>
#include <hip/hip_cooperative_groups.h>
#include <cstdio>
#include <cstdint>
namespace cg = cooperative_groups;

namespace pg8 {
#define PG8_LAS __attribute__((address_space(3)))
typedef unsigned short bf16_t;
typedef short bf16x8 __attribute__((ext_vector_type(8)));
typedef float f32x4 __attribute__((ext_vector_type(4)));
typedef unsigned u32x4 __attribute__((ext_vector_type(4)));
constexpr int BM = 256, BK = 64, HALF = 128, HTB = HALF * BK * 2  , STAGE_BYTES = 8 * HTB, NXCD = 8, WGM = 8;

__host__ __device__ __forceinline__ int lds_byte(int r, int c) { const int st = (r >> 4) * 2 + (c >> 5), rr = r & 15, cc = c & 31, ob = rr * 64 + cc * 2; return st * 1024 + (ob ^ (((ob >> 9) & 1) << 5)); }
__host__ __device__ __forceinline__ void stage_rc(int b, int& R, int& C) { const int st = b / 1024, sb = b % 1024, swz = sb ^ (((sb >> 9) & 1) << 5); R = (st >> 1) * 16 + swz / 64; C = (st & 1) * 32 + (swz % 64) / 2; }
__host__ __device__ __forceinline__ int perm32(int rho) { const int n = rho >> 4, i = rho & 15; return 8 * (i >> 2) + 4 * n + (i & 3); }

struct Unit { int pm, pn; };
struct Gemm { const bf16_t* A; const bf16_t* Bt; int M, N, K; };

struct StaticOrder {
    int nM, nN, nwg, G, c;
    __host__ __device__ void init(int M, int N, int G_, int c_) { nM = M / BM; nN = N / BM; nwg = nM * nN; G = G_; c = c_; }
    __host__ __device__ bool next(int i, Unit& u) const {
        const long L = (long)i * G + c; if (L >= nwg) return false;
        int wgid = (int)L; { const int q = nwg / NXCD, r = nwg % NXCD, xcd = wgid % NXCD, off = wgid / NXCD; wgid = (xcd < r ? xcd * (q + 1) : r * (q + 1) + (xcd - r) * q) + off; }
        const int nig = WGM * nN, gid = wgid / nig, fm = gid * WGM, gsz = (nM - fm) < WGM ? (nM - fm) : WGM;
        u.pm = fm + ((wgid % nig) % gsz); u.pn = (wgid % nig) / gsz; return true;
    }
    __device__ __forceinline__ void a_ready(const Unit&) const {}
    __device__ __forceinline__ void done(const Unit&) const {}
};

__device__ __forceinline__ unsigned cvt_pk_bf16(float lo, float hi) { unsigned r; asm volatile("v_cvt_pk_bf16_f32 %0, %1, %2" : "=v"(r) : "v"(lo), "v"(hi)); return r; }
template <class Epi, class Sched, bool ALIGN_EPI = false, bool SP2 = false>
__device__ __forceinline__ void gemm_phase(PG8_LAS unsigned char* lds, const Gemm g, const Sched& S, const Epi& E) {
    int tid_ = threadIdx.x; asm volatile("" : "+v"(tid_));
    const int tid = tid_, wid = __builtin_amdgcn_readfirstlane(tid >> 6), lane = tid & 63, wr = wid >> 2, wc = wid & 3, fr = lane & 15, fq = lane >> 4;
    const int K = g.K, nt = K / BK;
    unsigned voffA[2], voffB[2];
#pragma unroll
    for (int i = 0; i < 2; ++i) { int R, C; stage_rc(tid * 16 + i * 8192, R, C); const int Rb = Epi::PERM ? ((R & ~31) + perm32(R & 31)) : R;
        voffA[i] = (unsigned)(R * K + C) * 2u; voffB[i] = (unsigned)(Rb * K + C) * 2u; }
    const size_t kstep = (size_t)(BK * 2);
    const size_t hstep = (size_t)HALF * K * 2;
    const size_t tstep = 2 * hstep;
    const unsigned ldsw = (unsigned)wid * 1024u;
    const int aoff = lds_byte(wr * 64 + fr, fq * 8), boff = lds_byte(wc * 32 + fr, fq * 8);
#define PG8_SA(b, h) (((b) * 2 + (h)) * HTB)
#define PG8_SB(b, h) ((4 + (b) * 2 + (h)) * HTB)
#define PG8_STAGE(bufoff, gbase, voff) do { _Pragma("unroll") for (int _i = 0; _i < 2; ++_i) \
        __builtin_amdgcn_global_load_lds((const unsigned*)((const char*)(gbase) + (voff)[_i]), (PG8_LAS unsigned*)(lds + (bufoff) + ldsw + _i * 8192), 16, 0, 0); } while (0)
#define PG8_LDA(dst, b, h) do { _Pragma("unroll") for (int m = 0; m < 4; ++m) _Pragma("unroll") for (int k = 0; k < 2; ++k) dst[m][k] = *(const PG8_LAS bf16x8*)(lds + PG8_SA(b, h) + aoff + m * 2048 + k * 1024); } while (0)
#define PG8_LDB(dst, b, h) do { _Pragma("unroll") for (int n = 0; n < 2; ++n) _Pragma("unroll") for (int k = 0; k < 2; ++k) dst[n][k] = *(const PG8_LAS bf16x8*)(lds + PG8_SB(b, h) + boff + n * 2048 + k * 1024); } while (0)
#define PG8_MMA(ai, bj, At, Bt) do { __builtin_amdgcn_s_setprio(1); _Pragma("unroll") for (int m = 0; m < 4; ++m) _Pragma("unroll") for (int n = 0; n < 2; ++n) _Pragma("unroll") for (int k = 0; k < 2; ++k) \
        acc[ai][bj][m][n] = __builtin_amdgcn_mfma_f32_16x16x32_bf16(Bt[n][k], At[m][k], acc[ai][bj][m][n], 0, 0, 0); __builtin_amdgcn_s_setprio(0); } while (0)
#define PG8_WAIT_V(n) asm volatile("s_waitcnt vmcnt(" #n ")" ::: "memory")
#define PG8_WAIT_L(n) asm volatile("s_waitcnt lgkmcnt(" #n ")" ::: "memory")
#define PG8_BAR __builtin_amdgcn_s_barrier()
#define PG8_SCHED __builtin_amdgcn_sched_barrier(0)
    Unit cur, nxt; int ui = 0;
    if (!S.next(0, cur)) return;
    f32x4 acc[2][2][4][2];
#pragma unroll
    for (int a = 0; a < 2; ++a)
#pragma unroll
        for (int b = 0; b < 2; ++b)
#pragma unroll
            for (int m = 0; m < 4; ++m)
#pragma unroll
                for (int n = 0; n < 2; ++n) acc[a][b][m][n] = (f32x4){0.f, 0.f, 0.f, 0.f};
    bf16x8 At[4][2], B0[2][2], B1[2][2];
    const char* cA = (const char*)g.A + (size_t)cur.pm * tstep; const char* cB = (const char*)g.Bt + (size_t)cur.pn * tstep;
    S.a_ready(cur);
    if constexpr (SP2) {
        PG8_STAGE(PG8_SB(0, 0), cB, voffB); PG8_STAGE(PG8_SB(0, 1), cB + hstep, voffB); PG8_STAGE(PG8_SA(0, 0), cA, voffA); PG8_STAGE(PG8_SA(0, 1), cA + hstep, voffA);
        if (wr == 1) PG8_BAR;
        PG8_WAIT_V(2); PG8_BAR;
        PG8_STAGE(PG8_SB(1, 0), cB + kstep, voffB); PG8_STAGE(PG8_SA(1, 0), cA + kstep, voffA); PG8_STAGE(PG8_SB(1, 1), cB + hstep + kstep, voffB);
        PG8_WAIT_V(6); PG8_BAR;
    } else {
        PG8_STAGE(PG8_SB(0, 0), cB, voffB); PG8_STAGE(PG8_SA(0, 0), cA, voffA); PG8_STAGE(PG8_SB(0, 1), cB + hstep, voffB); PG8_STAGE(PG8_SA(0, 1), cA + hstep, voffA);
        if (wr == 1) PG8_BAR;
        PG8_WAIT_V(4); PG8_BAR;
        PG8_STAGE(PG8_SB(1, 0), cB + kstep, voffB); PG8_STAGE(PG8_SA(1, 0), cA + kstep, voffA); PG8_STAGE(PG8_SB(1, 1), cB + hstep + kstep, voffB);
        PG8_WAIT_V(6); PG8_BAR;
    }
    for (;;) {
        const bool has_next = S.next(ui + 1, nxt);
        const char* nA = has_next ? (const char*)g.A + (size_t)nxt.pm * tstep : cA; const char* nB = has_next ? (const char*)g.Bt + (size_t)nxt.pn * tstep : cB;
        for (int t = 0; t < nt; t += 2) {
            const bool last = (t == nt - 2);
            const char* a1 = cA + (size_t)(t + 1) * kstep;
            const char* a2 = last ? nA : cA + (size_t)(t + 2) * kstep; const char* b2 = last ? nB : cB + (size_t)(t + 2) * kstep;
            const char* a3 = a2 + kstep; const char* b3 = b2 + kstep;
            if (last && has_next) S.a_ready(nxt);
            if constexpr (SP2) {
            PG8_LDB(B0, 0, 0); PG8_LDB(B1, 0, 1); PG8_SCHED; PG8_LDA(At, 0, 0); PG8_STAGE(PG8_SA(1, 1), a1 + hstep, voffA);
            PG8_WAIT_V(8); PG8_WAIT_L(0); PG8_BAR; PG8_MMA(0, 0, At, B0); PG8_MMA(0, 1, At, B1); PG8_BAR; PG8_SCHED;
            PG8_LDA(At, 0, 1); PG8_STAGE(PG8_SB(0, 0), b2, voffB); PG8_STAGE(PG8_SB(0, 1), b2 + hstep, voffB); PG8_STAGE(PG8_SA(0, 0), a2, voffA);
            PG8_WAIT_V(8); PG8_WAIT_L(0); PG8_BAR; PG8_MMA(1, 0, At, B0); PG8_MMA(1, 1, At, B1); PG8_BAR; PG8_SCHED;
            PG8_LDB(B0, 1, 0); PG8_LDB(B1, 1, 1); PG8_SCHED; PG8_LDA(At, 1, 0); PG8_STAGE(PG8_SA(0, 1), a2 + hstep, voffA);
            PG8_WAIT_V(8); PG8_WAIT_L(0); PG8_BAR; PG8_MMA(0, 0, At, B0); PG8_MMA(0, 1, At, B1); PG8_BAR; PG8_SCHED;
            PG8_LDA(At, 1, 1); PG8_STAGE(PG8_SB(1, 0), b3, voffB); PG8_STAGE(PG8_SB(1, 1), b3 + hstep, voffB); PG8_STAGE(PG8_SA(1, 0), a3, voffA);
            PG8_WAIT_V(8); PG8_WAIT_L(0); PG8_BAR; PG8_MMA(1, 0, At, B0); PG8_MMA(1, 1, At, B1); PG8_BAR; PG8_SCHED;
            } else {
            PG8_LDB(B0, 0, 0); PG8_SCHED; PG8_LDA(At, 0, 0); PG8_STAGE(PG8_SA(1, 1), a1 + hstep, voffA);
            PG8_WAIT_L(8); PG8_BAR; PG8_WAIT_L(0); PG8_MMA(0, 0, At, B0); PG8_BAR; PG8_SCHED;
            PG8_LDB(B1, 0, 1); PG8_STAGE(PG8_SB(0, 0), b2, voffB);
            PG8_BAR; PG8_WAIT_L(0); PG8_MMA(0, 1, At, B1); PG8_BAR;
            PG8_LDA(At, 0, 1); PG8_STAGE(PG8_SA(0, 0), a2, voffA);
            PG8_BAR; PG8_WAIT_L(0); PG8_MMA(1, 0, At, B0); PG8_BAR; PG8_SCHED;
            PG8_STAGE(PG8_SB(0, 1), b2 + hstep, voffB);
            PG8_WAIT_V(6); PG8_BAR; PG8_MMA(1, 1, At, B1); PG8_BAR;
            PG8_LDB(B0, 1, 0); PG8_SCHED; PG8_LDA(At, 1, 0); PG8_STAGE(PG8_SA(0, 1), a2 + hstep, voffA);
            PG8_WAIT_L(8); PG8_BAR; PG8_WAIT_L(0); PG8_MMA(0, 0, At, B0); PG8_BAR; PG8_SCHED;
            PG8_LDB(B1, 1, 1); PG8_STAGE(PG8_SB(1, 0), b3, voffB);
            PG8_BAR; PG8_WAIT_L(0); PG8_MMA(0, 1, At, B1); PG8_BAR;
            PG8_LDA(At, 1, 1); PG8_STAGE(PG8_SA(1, 0), a3, voffA);
            PG8_BAR; PG8_WAIT_L(0); PG8_MMA(1, 0, At, B0); PG8_BAR; PG8_SCHED;
            PG8_STAGE(PG8_SB(1, 1), b3 + hstep, voffB);
            PG8_WAIT_V(6); PG8_BAR; PG8_MMA(1, 1, At, B1); PG8_BAR;
            }
        }
        if constexpr (ALIGN_EPI) { if (wr == 0) PG8_BAR; }
        if constexpr (!Epi::AFTER_DRAIN) { E(acc, cur, wr, wc, fr, fq); S.done(cur); }
        if (!has_next) break;
#pragma unroll
        for (int a = 0; a < 2; ++a)
#pragma unroll
            for (int b = 0; b < 2; ++b)
#pragma unroll
                for (int m = 0; m < 4; ++m)
#pragma unroll
                    for (int n = 0; n < 2; ++n) acc[a][b][m][n] = (f32x4){0.f, 0.f, 0.f, 0.f};
        cur = nxt; cA = nA; cB = nB; ++ui;
        if constexpr (ALIGN_EPI) { if (wr == 1) PG8_BAR; }
    }
    PG8_WAIT_V(0);
    if constexpr (!ALIGN_EPI) { if (wr == 0) PG8_BAR; }
    PG8_BAR;
    if constexpr (Epi::AFTER_DRAIN) { E.fused(acc, cur, wr, wc, fr, fq, lds, wid, lane); S.done(cur); }
#undef PG8_SA
#undef PG8_SB
#undef PG8_STAGE
#undef PG8_LDA
#undef PG8_LDB
#undef PG8_MMA
#undef PG8_WAIT_V
#undef PG8_WAIT_L
#undef PG8_BAR
#undef PG8_SCHED
}
}
namespace pg8 {
struct EpiStoreBf16 {
    static constexpr bool PERM = true, AFTER_DRAIN = false;
    bf16_t* O; int ldc; const float* bias; int m_real, n_real;
    __device__ __forceinline__ void operator()(const f32x4 (&acc)[2][2][4][2], const Unit& u, int wr, int wc, int fr, int fq) const {
        const int row0 = u.pm * BM + wr * 64 + fr, col0 = u.pn * BM + wc * 32 + 8 * fq;
#pragma unroll
        for (int bj = 0; bj < 2; ++bj) {
            const int col = col0 + bj * HALF;
            if (col >= n_real) continue;
            f32x4 b0 = (f32x4){0.f, 0.f, 0.f, 0.f}, b1 = b0;
            if (bias) { b0 = *(const f32x4*)(bias + col); b1 = *(const f32x4*)(bias + col + 4); }
#pragma unroll
            for (int ai = 0; ai < 2; ++ai)
#pragma unroll
                for (int m = 0; m < 4; ++m) {
                    const int row = row0 + ai * HALF + m * 16;
                    if (row >= m_real) continue;
                    const f32x4 v0 = acc[ai][bj][m][0] + b0, v1 = acc[ai][bj][m][1] + b1;
                    u32x4 w; w.x = cvt_pk_bf16(v0[0], v0[1]); w.y = cvt_pk_bf16(v0[2], v0[3]); w.z = cvt_pk_bf16(v1[0], v1[1]); w.w = cvt_pk_bf16(v1[2], v1[3]);
                    *(u32x4*)(O + (size_t)row * ldc + col) = w;
                }
        }
    }
};
struct EpiStoreF32 {
    static constexpr bool PERM = false, AFTER_DRAIN = false;
    float* O; int ldc; const float* bias; int m_real, n_real;
    __device__ __forceinline__ void operator()(const f32x4 (&acc)[2][2][4][2], const Unit& u, int wr, int wc, int fr, int fq) const {
        const int row0 = u.pm * BM + wr * 64 + fr, col0 = u.pn * BM + wc * 32 + 4 * fq;
#pragma unroll
        for (int bj = 0; bj < 2; ++bj)
#pragma unroll
            for (int n = 0; n < 2; ++n) {
                const int col = col0 + bj * HALF + n * 16;
                if (col >= n_real) continue;
                const f32x4 bv = bias ? *(const f32x4*)(bias + col) : (f32x4){0.f, 0.f, 0.f, 0.f};
#pragma unroll
                for (int ai = 0; ai < 2; ++ai)
#pragma unroll
                    for (int m = 0; m < 4; ++m) {
                        const int row = row0 + ai * HALF + m * 16;
                        if (row >= m_real) continue;
                        *(f32x4*)(O + (size_t)row * ldc + col) = acc[ai][bj][m][n] + bv;
                    }
            }
    }
};
}
namespace {
#define GAS __attribute__((address_space(1)))
#define LAS __attribute__((address_space(3)))
typedef unsigned short bf16;
typedef float f32x4 __attribute__((ext_vector_type(4)));
typedef unsigned v4u __attribute__((ext_vector_type(4)));
typedef unsigned v2u __attribute__((ext_vector_type(2)));

constexpr int D = 1024, NB = 4, SEQ = 4096, NP = NB * SEQ, NS = 128, NT = NP + NS, MP = 16640;
constexpr int ABN = 3080, ABNP = 3328;
constexpr int C_QKV = 0, C_Z = 1536, C_A = 2048, C_B = 2052, C_XR = 2056, C_GATE = 2568;
constexpr int CN = 1536;
constexpr float ALPHA = 1.4142135623730951f;
constexpr float LN_EPS = 1e-5f;
constexpr int NTH = 512, NWAVES = 8;
constexpr int RING_BYTES = 143360, MISC_OFF = RING_BYTES + 320, LDS_BYTES = 147456;

__device__ __forceinline__ float bf2f(bf16 v) { return __uint_as_float((unsigned)v << 16); }
__device__ __forceinline__ float bflo(unsigned w) { return __uint_as_float(w << 16); }
__device__ __forceinline__ float bfhi(unsigned w) { return __uint_as_float(w & 0xffff0000u); }
__device__ __forceinline__ unsigned f2bf(float f) { unsigned u = __float_as_uint(f); return (u + 0x7fffu + ((u >> 16) & 1u)) >> 16; }
__device__ __forceinline__ unsigned pk2(float lo, float hi) { return f2bf(lo) | (f2bf(hi) << 16); }
__device__ __forceinline__ float sigmoidf_(float x) { return 1.0f / (1.0f + expf(-x)); }
__device__ __forceinline__ float softplusf_(float x) { return fmaxf(x, 0.f) + log1pf(expf(-fabsf(x))); }
__device__ __forceinline__ float siluf_(float x) { return x / (1.0f + expf(-x)); }
__device__ __forceinline__ float geluf_(float x) { return 0.5f * x * (1.0f + tanhf(0.7978845608028654f * (x + 0.044715f * x * x * x))); }
#define DPPF(v_, ctrl_, rmask_) __int_as_float(__builtin_amdgcn_update_dpp(0, __float_as_int(v_), (ctrl_), (rmask_), 0xf, false))
__device__ __forceinline__ float wave_sum(float v) {
    v += DPPF(v, 0xB1, 0xf); v += DPPF(v, 0x4E, 0xf); v += DPPF(v, 0x141, 0xf); v += DPPF(v, 0x140, 0xf);
    v += DPPF(v, 0x142, 0xa); v += DPPF(v, 0x143, 0xc);
    return __int_as_float(__builtin_amdgcn_readlane(__float_as_int(v), 63));
}
__device__ __forceinline__ float wave_max(float v) {
    v = fmaxf(v, DPPF(v, 0xB1, 0xf)); v = fmaxf(v, DPPF(v, 0x4E, 0xf)); v = fmaxf(v, DPPF(v, 0x141, 0xf)); v = fmaxf(v, DPPF(v, 0x140, 0xf));
    { const float t = __int_as_float(__builtin_amdgcn_update_dpp(__float_as_int(v), __float_as_int(v), 0x142, 0xa, 0xf, false)); v = fmaxf(v, t); }
    { const float t = __int_as_float(__builtin_amdgcn_update_dpp(__float_as_int(v), __float_as_int(v), 0x143, 0xc, 0xf, false)); v = fmaxf(v, t); }
    return __int_as_float(__builtin_amdgcn_readlane(__float_as_int(v), 63));
}

__device__ __forceinline__ void p0_transpose_item(const float* __restrict__ W, int K, int N, bf16* __restrict__ WT, float* scr, int item, int lane) {
    const int nblk = (N + 31) / 32, kb = item / nblk, nb = item % nblk, k0 = 64 * kb, n0 = 32 * nb;
#pragma unroll 8
    for (int i = 0; i < 32; ++i) { const int kk = 2 * i + (lane >> 5), n = n0 + (lane & 31); scr[kk * 33 + (lane & 31)] = n < N ? W[(size_t)(k0 + kk) * N + n] : 0.f; }
    asm volatile("s_waitcnt lgkmcnt(0)" ::: "memory");
    const int c = lane & 7;
#pragma unroll
    for (int j = 0; j < 4; ++j) { const int n = (lane >> 3) + 8 * j; const float* s = scr + (8 * c) * 33 + n;
        v4u o; o.x = pk2(s[0 * 33], s[1 * 33]); o.y = pk2(s[2 * 33], s[3 * 33]); o.z = pk2(s[4 * 33], s[5 * 33]); o.w = pk2(s[6 * 33], s[7 * 33]);
        *(v4u*)(WT + (size_t)(n0 + n) * K + k0 + 8 * c) = o; }
    asm volatile("s_waitcnt lgkmcnt(0)" ::: "memory");
}
__device__ __forceinline__ void row_to_bf16(const float* __restrict__ xrow, bf16* __restrict__ orow, int lane) {
#pragma unroll
    for (int j = 0; j < 4; ++j) {
        f32x4 v = (f32x4){0.f, 0.f, 0.f, 0.f};
        if (xrow) v = ((const f32x4*)xrow)[lane + 64 * j];
        v2u o; o.x = pk2(v.x, v.y); o.y = pk2(v.z, v.w);
        ((v2u*)orow)[lane + 64 * j] = o;
    }
}

struct AbPrepArgs {
    const bf16* PROJ; const float* st_gdn_conv; const float* st_lru_conv;
    const float* gdn_conv_w; const float* a_log; const float* dt_bias;
    const float* lru_conv_w; const float* lru_conv_b; const float* w_r; const float* b_r; const float* w_i; const float* b_i; const float* lam;
    float* QKV; float* G; float* BETA; float* LA; float* LB;
    float* p_gdn_conv; float* p_lru_conv; float* s_gdn_conv; float* s_lru_conv;
};
__device__ __forceinline__ void ab_prep(const AbPrepArgs& a, int t, float* smem) {
    int tid = threadIdx.x; asm volatile("" : "+v"(tid));
    const int lane = tid & 63, wid = tid >> 6;
    const bool samp = t >= NP; const int sb = t - NP, pos = t % SEQ, b = t / SEQ;
    float* sq = smem;
    float* sx = smem + 1536;
    float* scl = smem + 2048;
    const bf16* prow = a.PROJ + (size_t)t * ABN;
    for (int c = tid; c < 1536; c += NTH) {
        float acc = 0.f;
#pragma unroll
        for (int i = 0; i < 4; ++i) {
            float xv;
            if (i == 3) xv = bf2f(prow[C_QKV + c]);
            else if (samp) xv = a.st_gdn_conv[((size_t)sb * 3 + i) * 1536 + c];
            else xv = (pos - 3 + i >= 0) ? bf2f(a.PROJ[(size_t)(t - 3 + i) * ABN + C_QKV + c]) : 0.f;
            acc += a.gdn_conv_w[i * 1536 + c] * xv;
        }
        sq[c] = siluf_(acc);
    }
    {
        const int c = tid;
        float acc = a.lru_conv_b[c];
#pragma unroll
        for (int i = 0; i < 4; ++i) {
            float xv;
            if (i == 3) xv = bf2f(prow[C_XR + c]);
            else if (samp) xv = a.st_lru_conv[((size_t)sb * 3 + i) * 512 + c];
            else xv = (pos - 3 + i >= 0) ? bf2f(a.PROJ[(size_t)(t - 3 + i) * ABN + C_XR + c]) : 0.f;
            acc += a.lru_conv_w[i * 512 + c] * xv;
        }
        sx[c] = acc;
    }
    __syncthreads();
    {
        const int grp = wid;
        const float v0 = sq[grp * 128 + lane], v1 = sq[grp * 128 + 64 + lane];
        const float s = wave_sum(v0 * v0 + v1 * v1);
        if (lane == 0) scl[grp] = rsqrtf(s + 1e-6f) * (grp < 4 ? 0.08838834764831845f : 1.0f);
    }
    __syncthreads();
    for (int c = tid; c < 1536; c += NTH) a.QKV[(size_t)t * 1536 + c] = (c < 1024) ? sq[c] * scl[c >> 7] : sq[c];
    if (tid < 4) {
        const float a_raw = bf2f(prow[C_A + tid]), b_raw = bf2f(prow[C_B + tid]);
        a.G[(size_t)t * 4 + tid] = -expf(a.a_log[tid]) * softplusf_(a_raw + a.dt_bias[tid]);
        a.BETA[(size_t)t * 4 + tid] = sigmoidf_(b_raw);
    }
    if (!samp) {
        if (pos >= SEQ - 3) {
            const int row = pos - (SEQ - 3);
            for (int c = tid; c < 1536; c += NTH) a.p_gdn_conv[((size_t)b * 3 + row) * 1536 + c] = bf2f(prow[C_QKV + c]);
            a.p_lru_conv[((size_t)b * 3 + row) * 512 + tid] = bf2f(prow[C_XR + tid]);
        }
    } else {
        for (int c = tid; c < 1536; c += NTH) {
            a.s_gdn_conv[((size_t)sb * 3 + 0) * 1536 + c] = a.st_gdn_conv[((size_t)sb * 3 + 1) * 1536 + c];
            a.s_gdn_conv[((size_t)sb * 3 + 1) * 1536 + c] = a.st_gdn_conv[((size_t)sb * 3 + 2) * 1536 + c];
            a.s_gdn_conv[((size_t)sb * 3 + 2) * 1536 + c] = bf2f(prow[C_QKV + c]);
        }
        {
            const int c = tid;
            a.s_lru_conv[((size_t)sb * 3 + 0) * 512 + c] = a.st_lru_conv[((size_t)sb * 3 + 1) * 512 + c];
            a.s_lru_conv[((size_t)sb * 3 + 1) * 512 + c] = a.st_lru_conv[((size_t)sb * 3 + 2) * 512 + c];
            a.s_lru_conv[((size_t)sb * 3 + 2) * 512 + c] = bf2f(prow[C_XR + c]);
        }
    }
    {
        const int c = tid, n = c >> 6, d = c & 63;
        float r = a.b_r[c], ii = a.b_i[c];
#pragma unroll 4
        for (int cc = 0; cc < 64; ++cc) {
            const float xv = sx[n * 64 + cc];
            r += xv * a.w_r[((size_t)n * 64 + cc) * 64 + d];
            ii += xv * a.w_i[((size_t)n * 64 + cc) * 64 + d];
        }
        r = sigmoidf_(r); ii = sigmoidf_(ii);
        const float log_a = -8.0f * r * softplusf_(-a.lam[c]);
        a.LA[(size_t)t * 512 + c] = expf(log_a);
        a.LB[(size_t)t * 512 + c] = sqrtf(-expm1f(2.0f * log_a)) * (ii * sx[c]);
    }
}

__device__ __forceinline__ void gdn_scan(const float* __restrict__ QKV, const float* __restrict__ G, const float* __restrict__ BETA,
                                         const float* __restrict__ S0, float* __restrict__ O, float* __restrict__ Sout, int tok_base, int T,
                                         int sl, int h, int sq, float* smem) {
    int tid = threadIdx.x; asm volatile("" : "+v"(tid));
    const int dvl = tid & 31, kg = tid >> 5;
    const int dv = sl * 32 + dvl;
    float (*red1)[32] = (float (*)[32])smem;
    float (*red2)[32] = (float (*)[32])(smem + 512);
    float S[8];
#pragma unroll
    for (int i = 0; i < 8; ++i) S[i] = S0 ? S0[(((size_t)sq * 4 + h) * 128 + kg * 8 + i) * 128 + dv] : 0.f;
    float kk[8], qq[8], vv, g, be;
    {
        const size_t tok = (size_t)tok_base + (size_t)sq * T;
        const float* row = QKV + tok * 1536;
#pragma unroll
        for (int i = 0; i < 8; ++i) { kk[i] = row[512 + h * 128 + kg * 8 + i]; qq[i] = row[h * 128 + kg * 8 + i]; }
        vv = row[1024 + h * 128 + dv]; g = G[tok * 4 + h]; be = BETA[tok * 4 + h];
    }
    for (int t = 0; t < T; ++t) {
        const size_t tok = (size_t)tok_base + (size_t)sq * T + t;
        float nk[8], nq[8], nv = 0.f, ng = 0.f, nb = 0.f;
        if (t + 1 < T) {
            const float* row = QKV + (tok + 1) * 1536;
#pragma unroll
            for (int i = 0; i < 8; ++i) { nk[i] = row[512 + h * 128 + kg * 8 + i]; nq[i] = row[h * 128 + kg * 8 + i]; }
            nv = row[1024 + h * 128 + dv]; ng = G[(tok + 1) * 4 + h]; nb = BETA[(tok + 1) * 4 + h];
        } else {
#pragma unroll
            for (int i = 0; i < 8; ++i) { nk[i] = 0.f; nq[i] = 0.f; }
        }
        const float al = expf(g);
        float p = 0.f;
#pragma unroll
        for (int i = 0; i < 8; ++i) { S[i] *= al; p += S[i] * kk[i]; }
        red1[kg][dvl] = p;
        __syncthreads();
        float ks = 0.f;
#pragma unroll
        for (int j = 0; j < 16; ++j) ks += red1[j][dvl];
        const float vn = be * (vv - ks);
        float o = 0.f;
#pragma unroll
        for (int i = 0; i < 8; ++i) { S[i] += kk[i] * vn; o += S[i] * qq[i]; }
        red2[kg][dvl] = o;
        __syncthreads();
        if (kg == 0) {
            float os = 0.f;
#pragma unroll
            for (int j = 0; j < 16; ++j) os += red2[j][dvl];
            O[tok * 512 + h * 128 + dv] = os;
        }
#pragma unroll
        for (int i = 0; i < 8; ++i) { kk[i] = nk[i]; qq[i] = nq[i]; }
        vv = nv; g = ng; be = nb;
    }
#pragma unroll
    for (int i = 0; i < 8; ++i) Sout[(((size_t)sq * 4 + h) * 128 + kg * 8 + i) * 128 + dv] = S[i];
}


__device__ __forceinline__ void gdn_step_sample_w(const float* __restrict__ QKV, const float* __restrict__ G, const float* __restrict__ BETA, const float* __restrict__ S0,
                                                  float* __restrict__ O, float* __restrict__ Sout, int item, int lane) {
    const int sl = item & 7, h = (item >> 3) & 3, sb = item >> 5, fr = lane & 15, fq = lane >> 4;
    const size_t tok = (size_t)NP + sb;
    const float* row = QKV + tok * 1536;
    const size_t sbase = (((size_t)sb * 4 + h) * 128 + fq * 32) * 128 + sl * 16 + fr;
    float S[32], kk[32], qq[32];
#pragma unroll
    for (int i = 0; i < 32; ++i) S[i] = S0[sbase + (size_t)i * 128];
#pragma unroll
    for (int i4 = 0; i4 < 8; ++i4) { const f32x4 k4 = *(const f32x4*)(row + 512 + h * 128 + fq * 32 + i4 * 4), q4 = *(const f32x4*)(row + h * 128 + fq * 32 + i4 * 4);
        kk[i4 * 4 + 0] = k4.x; kk[i4 * 4 + 1] = k4.y; kk[i4 * 4 + 2] = k4.z; kk[i4 * 4 + 3] = k4.w; qq[i4 * 4 + 0] = q4.x; qq[i4 * 4 + 1] = q4.y; qq[i4 * 4 + 2] = q4.z; qq[i4 * 4 + 3] = q4.w; }
    const float vv = row[1024 + h * 128 + sl * 16 + fr], al = expf(G[tok * 4 + h]), be = BETA[tok * 4 + h];
    float p = 0.f;
#pragma unroll
    for (int i = 0; i < 32; ++i) { S[i] *= al; p += S[i] * kk[i]; }
    p += __shfl_xor(p, 16); p += __shfl_xor(p, 32);
    const float vn = be * (vv - p);
    float o = 0.f;
#pragma unroll
    for (int i = 0; i < 32; ++i) { S[i] += kk[i] * vn; o += S[i] * qq[i]; }
    o += __shfl_xor(o, 16); o += __shfl_xor(o, 32);
    if (fq == 0) O[tok * 512 + h * 128 + sl * 16 + fr] = o;
#pragma unroll
    for (int i = 0; i < 32; ++i) Sout[sbase + (size_t)i * 128] = S[i];
}

__device__ __forceinline__ void lru_scan(const float* __restrict__ LA, float* __restrict__ LB, const float* __restrict__ h0,
                                         float* __restrict__ hlast, int tok_base, int T, int nseq, int bx) {
    int tx_ = threadIdx.x; asm volatile("" : "+v"(tx_));
    const int idx = bx * NTH + tx_;
    if (idx >= nseq * 512) return;
    const int sq = idx / 512, c = idx % 512;
    float h = h0 ? h0[(size_t)sq * 512 + c] : 0.f;
    const size_t base = ((size_t)tok_base + (size_t)sq * T) * 512 + c;
#pragma unroll 8
    for (int t = 0; t < T; ++t) {
        const size_t o = base + (size_t)t * 512;
        h = LA[o] * h + LB[o];
        LB[o] = h;
    }
    hlast[(size_t)sq * 512 + c] = h;
}

__device__ __forceinline__ void ab_mix_w(const bf16* __restrict__ PROJ, const float* __restrict__ O, const float* __restrict__ H, const float* __restrict__ P, const float* __restrict__ CIN,
                                         const float* __restrict__ norm_w, bf16* __restrict__ MIX, int t, int lane) {
    const bf16* prow = PROJ + (size_t)t * ABN;
    {
        const int c0 = lane * 8;
        const f32x4 o0 = *(const f32x4*)(O + (size_t)t * 512 + c0), o1 = *(const f32x4*)(O + (size_t)t * 512 + c0 + 4);
        const v4u zb = *(const v4u*)(prow + C_Z + c0);
        const f32x4 w0 = *(const f32x4*)(norm_w + (c0 & 127)), w1 = *(const f32x4*)(norm_w + (c0 & 127) + 4);
        float ss = (o0.x * o0.x + o0.y * o0.y) + (o0.z * o0.z + o0.w * o0.w) + (o1.x * o1.x + o1.y * o1.y) + (o1.z * o1.z + o1.w * o1.w);
        ss += DPPF(ss, 0xB1, 0xf); ss += DPPF(ss, 0x4E, 0xf); ss += DPPF(ss, 0x141, 0xf); ss += DPPF(ss, 0x140, 0xf);
        const float sc = rsqrtf(ss * (1.0f / 128.0f) + 1e-6f);
        const float z[8] = {bflo(zb.x), bfhi(zb.x), bflo(zb.y), bfhi(zb.y), bflo(zb.z), bfhi(zb.z), bflo(zb.w), bfhi(zb.w)};
        const float ov[8] = {o0.x, o0.y, o0.z, o0.w, o1.x, o1.y, o1.z, o1.w}, wv[8] = {w0.x, w0.y, w0.z, w0.w, w1.x, w1.y, w1.z, w1.w};
        float r[8];
#pragma unroll
        for (int i = 0; i < 8; ++i) r[i] = ov[i] * sc * wv[i] * (z[i] * __frcp_rn(1.0f + __expf(-z[i])));
        v4u ob; ob.x = pk2(r[0], r[1]); ob.y = pk2(r[2], r[3]); ob.z = pk2(r[4], r[5]); ob.w = pk2(r[6], r[7]);
        *(v4u*)(MIX + (size_t)t * 1024 + c0) = ob;
    }
    {
        const int c0 = lane * 8;
        const v4u gb = *(const v4u*)(prow + C_GATE + c0);
        f32x4 h0 = *(const f32x4*)(H + (size_t)t * 512 + c0), h1 = *(const f32x4*)(H + (size_t)t * 512 + c0 + 4);
        if (t < NP) {
            const f32x4 p0 = *(const f32x4*)(P + (size_t)t * 512 + c0), p1 = *(const f32x4*)(P + (size_t)t * 512 + c0 + 4);
            const f32x4 ci0 = *(const f32x4*)(CIN + (size_t)(t >> 6) * 512 + c0), ci1 = *(const f32x4*)(CIN + (size_t)(t >> 6) * 512 + c0 + 4);
            h0 = h0 + p0 * ci0; h1 = h1 + p1 * ci1;
        }
        const float gv[8] = {bflo(gb.x), bfhi(gb.x), bflo(gb.y), bfhi(gb.y), bflo(gb.z), bfhi(gb.z), bflo(gb.w), bfhi(gb.w)}, hv[8] = {h0.x, h0.y, h0.z, h0.w, h1.x, h1.y, h1.z, h1.w};
        float r[8];
#pragma unroll
        for (int i = 0; i < 8; ++i) r[i] = geluf_(gv[i]) * hv[i];
        v4u ob; ob.x = pk2(r[0], r[1]); ob.y = pk2(r[2], r[3]); ob.z = pk2(r[4], r[5]); ob.w = pk2(r[6], r[7]);
        *(v4u*)(MIX + (size_t)t * 1024 + 512 + c0) = ob;
    }
}

template <bool XBF>
__device__ __forceinline__ void ln_res_w(const void* __restrict__ xrow_, const bf16* __restrict__ yrow, const float* __restrict__ g, const float* __restrict__ bta,
                                         bf16* __restrict__ obrow, int lane) {
    f32x4 v[4]; float s = 0.f;
#pragma unroll
    for (int j = 0; j < 4; ++j) {
        f32x4 x4;
        if (XBF) { const v2u xb = ((const v2u*)xrow_)[lane + 64 * j]; x4 = (f32x4){bflo(xb.x), bfhi(xb.x), bflo(xb.y), bfhi(xb.y)}; }
        else x4 = ((const f32x4*)xrow_)[lane + 64 * j];
        const v2u yb = ((const v2u*)yrow)[lane + 64 * j];
        const f32x4 y4 = (f32x4){bflo(yb.x), bfhi(yb.x), bflo(yb.y), bfhi(yb.y)}; v[j] = x4 * ALPHA + y4; s += (v[j].x + v[j].y) + (v[j].z + v[j].w); }
    const float mean = wave_sum(s) * (1.0f / 1024.0f); float q = 0.f;
#pragma unroll
    for (int j = 0; j < 4; ++j) { v[j] = v[j] - mean; q += (v[j].x * v[j].x + v[j].y * v[j].y) + (v[j].z * v[j].z + v[j].w * v[j].w); }
    const float rs = rsqrtf(wave_sum(q) * (1.0f / 1024.0f) + LN_EPS);
#pragma unroll
    for (int j = 0; j < 4; ++j) {
        const f32x4 g4 = ((const f32x4*)g)[lane + 64 * j], b4 = ((const f32x4*)bta)[lane + 64 * j];
        const f32x4 o = v[j] * rs * g4 + b4;
        v2u ob; ob.x = pk2(o.x, o.y); ob.y = pk2(o.z, o.w);
        ((v2u*)obrow)[lane + 64 * j] = ob;
    }
}

__device__ __forceinline__ void peer_topk(const bf16* __restrict__ Q, const float* __restrict__ keys, int* __restrict__ EXP, float* __restrict__ GATE,
                                          int tg, int h, float* smem) {
    const int tid = threadIdx.x, cn = tid & 255, c = cn >> 7, n = cn & 127, th = tid >> 8;
    float (*sq)[256] = (float (*)[256])smem;
    float (*ss)[257] = (float (*)[257])(smem + 32 * 256);
    float (*tvs)[2][16] = (float (*)[2][16])(smem + 32 * 256 + 32 * 257 + 32);
    int (*tis)[2][16] = (int (*)[2][16])(smem + 32 * 256 + 32 * 257 + 32 + 1024);
    for (int i = tid; i < 32 * 256; i += NTH) {
        const int tk = i >> 8, col = i & 255;
        sq[tk][col] = bf2f(Q[(size_t)(tg * 32 + tk) * 2048 + h * 256 + col]);
    }
    __syncthreads();
    float acc[16];
#pragma unroll
    for (int i = 0; i < 16; ++i) acc[i] = 0.f;
    const float* krow = keys + (((size_t)h * 2 + c) * 128 + n) * 128;
    for (int d4 = 0; d4 < 32; ++d4) {
        const float4 kv = *(const float4*)(krow + d4 * 4);
#pragma unroll
        for (int tk = 0; tk < 16; ++tk) {
            const float4 qv = *(const float4*)&sq[th * 16 + tk][c * 128 + d4 * 4];
            acc[tk] += qv.x * kv.x + qv.y * kv.y + qv.z * kv.z + qv.w * kv.w;
        }
    }
#pragma unroll
    for (int tk = 0; tk < 16; ++tk) ss[th * 16 + tk][cn] = acc[tk];
    __syncthreads();
    if (tid < 64) {
        const int tk = tid >> 1, cc = tid & 1;
        float tv[16]; int ti[16];
#pragma unroll
        for (int j = 0; j < 16; ++j) { tv[j] = -INFINITY; ti[j] = 0; }
        for (int nn = 0; nn < 128; ++nn) {
            float x = ss[tk][cc * 128 + nn]; int xi = nn;
#pragma unroll
            for (int j = 0; j < 16; ++j) {
                const bool gt = x > tv[j];
                const float tf = tv[j]; const int tj = ti[j];
                tv[j] = gt ? x : tf; ti[j] = gt ? xi : tj;
                x = gt ? tf : x; xi = gt ? tj : xi;
            }
        }
#pragma unroll
        for (int j = 0; j < 16; ++j) { tvs[tk][cc][j] = tv[j]; tis[tk][cc][j] = ti[j]; }
    }
    __syncthreads();
    if (tid < 32) {
        const int tk = tid;
        float bv[16]; int bi[16];
#pragma unroll
        for (int j = 0; j < 16; ++j) { bv[j] = -INFINITY; bi[j] = 0; }
        for (int i = 0; i < 16; ++i)
            for (int jj = 0; jj < 16; ++jj) {
                float x = tvs[tk][0][i] + tvs[tk][1][jj]; int xi = tis[tk][0][i] * 128 + tis[tk][1][jj];
#pragma unroll
                for (int j = 0; j < 16; ++j) {
                    const bool gt = x > bv[j];
                    const float tf = bv[j]; const int tj = bi[j];
                    bv[j] = gt ? x : tf; bi[j] = gt ? xi : tj;
                    x = gt ? tf : x; xi = gt ? tj : xi;
                }
            }
        float e[16], sum = 0.f;
#pragma unroll
        for (int j = 0; j < 16; ++j) { e[j] = expf(bv[j] - bv[0]); sum += e[j]; }
        const float inv = 1.0f / sum;
        const size_t o = (size_t)(tg * 32 + tk) * 128 + h * 16;
#pragma unroll
        for (int j = 0; j < 16; ++j) { EXP[o + j] = bi[j]; GATE[o + j] = e[j] * inv; }
    }
}

__device__ __forceinline__ void peer_expert(const float* __restrict__ X, const int* __restrict__ EXP, const float* __restrict__ GATE,
                                            const float* __restrict__ U, const float* __restrict__ V,
                                            const float* __restrict__ g, const float* __restrict__ bta, float* __restrict__ out, bf16* __restrict__ outb, int t, float* smem) {
    const int tid = threadIdx.x, lane = tid & 63, wid = tid >> 6;
    float (*accs)[1024] = (float (*)[1024])smem;
    float* sred = smem + 8192;
    const float4* xr = (const float4*)(X + (size_t)t * D);
    float4 xv[4];
#pragma unroll
    for (int j = 0; j < 4; ++j) xv[j] = xr[lane + 64 * j];
    float4 acc[4];
#pragma unroll
    for (int j = 0; j < 4; ++j) acc[j] = make_float4(0.f, 0.f, 0.f, 0.f);
    for (int e = 0; e < 16; ++e) {
        const int id = EXP[(size_t)t * 128 + wid * 16 + e];
        const float gt = GATE[(size_t)t * 128 + wid * 16 + e];
        const float4* ur = (const float4*)(U + (size_t)id * D);
        const float4* vr = (const float4*)(V + (size_t)id * D);
        float4 uv[4], vv[4];
#pragma unroll
        for (int j = 0; j < 4; ++j) { uv[j] = ur[lane + 64 * j]; vv[j] = vr[lane + 64 * j]; }
        float dot = 0.f;
#pragma unroll
        for (int j = 0; j < 4; ++j) dot += uv[j].x * xv[j].x + uv[j].y * xv[j].y + uv[j].z * xv[j].z + uv[j].w * xv[j].w;
        dot = wave_sum(dot);
        const float cf = gt * geluf_(dot);
#pragma unroll
        for (int j = 0; j < 4; ++j) { acc[j].x += cf * vv[j].x; acc[j].y += cf * vv[j].y; acc[j].z += cf * vv[j].z; acc[j].w += cf * vv[j].w; }
    }
#pragma unroll
    for (int j = 0; j < 4; ++j) *(float4*)&accs[wid][(lane + 64 * j) * 4] = acc[j];
    __syncthreads();
    float v[2];
#pragma unroll
    for (int i = 0; i < 2; ++i) {
        const int c = tid * 2 + i;
        float s = 0.f;
#pragma unroll
        for (int w = 0; w < 8; ++w) s += accs[w][c];
        v[i] = ALPHA * X[(size_t)t * D + c] + s;
    }
    float s = wave_sum(v[0] + v[1]);
    if (lane == 0) sred[wid] = s;
    __syncthreads();
    float mean = 0.f;
#pragma unroll
    for (int w = 0; w < 8; ++w) mean += sred[w];
    mean *= (1.0f / 1024.0f);
    __syncthreads();
    const float d0 = v[0] - mean, d1 = v[1] - mean;
    float q = wave_sum(d0 * d0 + d1 * d1);
    if (lane == 0) sred[wid] = q;
    __syncthreads();
    float var = 0.f;
#pragma unroll
    for (int w = 0; w < 8; ++w) var += sred[w];
    const float rs = rsqrtf(var * (1.0f / 1024.0f) + LN_EPS);
    const float o0 = d0 * rs * g[tid * 2] + bta[tid * 2], o1 = d1 * rs * g[tid * 2 + 1] + bta[tid * 2 + 1];
    *(float2*)(out + (size_t)t * D + tid * 2) = make_float2(o0, o1);
    if (outb) *(unsigned*)(outb + (size_t)t * D + tid * 2) = pk2(o0, o1);
}


typedef __bf16 bf16x2_t __attribute__((ext_vector_type(2)));
__device__ __forceinline__ float dot2bf(unsigned w, unsigned x, float acc) { return __builtin_amdgcn_fdot2_f32_bf16(__builtin_bit_cast(bf16x2_t, w), __builtin_bit_cast(bf16x2_t, x), acc, false); }
typedef float f32x2_t __attribute__((ext_vector_type(2)));
__device__ __forceinline__ void row_to_fp8(const float* __restrict__ xrow, unsigned char* __restrict__ orow, float* __restrict__ scale, int lane) {
    f32x4 v[4]; float am = 0.f;
#pragma unroll
    for (int j = 0; j < 4; ++j) { v[j] = *(const f32x4*)(xrow + lane * 16 + j * 4); am = fmaxf(am, fmaxf(fmaxf(fabsf(v[j].x), fabsf(v[j].y)), fmaxf(fabsf(v[j].z), fabsf(v[j].w)))); }
    am = wave_max(am);
    const float s = am > 0.f ? am * (1.0f / 448.0f) : 1.0f, inv = 1.0f / s;
    v4u o;
    unsigned w;
    w = 0u; w = __builtin_amdgcn_cvt_pk_fp8_f32(v[0].x * inv, v[0].y * inv, w, false); w = __builtin_amdgcn_cvt_pk_fp8_f32(v[0].z * inv, v[0].w * inv, w, true); o.x = w;
    w = 0u; w = __builtin_amdgcn_cvt_pk_fp8_f32(v[1].x * inv, v[1].y * inv, w, false); w = __builtin_amdgcn_cvt_pk_fp8_f32(v[1].z * inv, v[1].w * inv, w, true); o.y = w;
    w = 0u; w = __builtin_amdgcn_cvt_pk_fp8_f32(v[2].x * inv, v[2].y * inv, w, false); w = __builtin_amdgcn_cvt_pk_fp8_f32(v[2].z * inv, v[2].w * inv, w, true); o.z = w;
    w = 0u; w = __builtin_amdgcn_cvt_pk_fp8_f32(v[3].x * inv, v[3].y * inv, w, false); w = __builtin_amdgcn_cvt_pk_fp8_f32(v[3].z * inv, v[3].w * inv, w, true); o.w = w;
    *(v4u*)(orow + lane * 16) = o;
    if (lane == 0) *scale = s;
}
#define PE_LOAD(UB, VB, grp) do { _Pragma("unroll") for (int i_ = 0; i_ < 4; ++i_) { const int e_ = (grp) * 4 + i_; \
        const int id_ = __builtin_amdgcn_readlane(e_ < 64 ? id0 : id1, e_ & 63); \
        const unsigned so_ = (unsigned)id_ * 1024u; \
        UB[i_] = __builtin_amdgcn_raw_buffer_load_b128(ursrc, voff, so_, 0); VB[i_] = __builtin_amdgcn_raw_buffer_load_b128(vrsrc, voff, so_, 0); } } while (0)
#define PE_DOT4(w, k) do { const f32x2_t l_ = __builtin_amdgcn_cvt_pk_f32_fp8((w), false), h_ = __builtin_amdgcn_cvt_pk_f32_fp8((w), true); \
        a_ += l_.x * xv[(k) * 4 + 0]; b_ += l_.y * xv[(k) * 4 + 1]; a_ += h_.x * xv[(k) * 4 + 2]; b_ += h_.y * xv[(k) * 4 + 3]; } while (0)
#define PE_AXPY4(w, k) do { const f32x2_t l_ = __builtin_amdgcn_cvt_pk_f32_fp8((w), false), h_ = __builtin_amdgcn_cvt_pk_f32_fp8((w), true); \
        acc[(k) * 4 + 0] += cf_ * l_.x; acc[(k) * 4 + 1] += cf_ * l_.y; acc[(k) * 4 + 2] += cf_ * h_.x; acc[(k) * 4 + 3] += cf_ * h_.y; } while (0)
#define PE_COMP(UB, VB, grp) do { float d_[4]; \
        _Pragma("unroll") for (int i_ = 0; i_ < 4; ++i_) { float a_ = 0.f, b_ = 0.f; PE_DOT4(UB[i_].x, 0); PE_DOT4(UB[i_].y, 1); PE_DOT4(UB[i_].z, 2); PE_DOT4(UB[i_].w, 3); d_[i_] = a_ + b_; } \
          \
        float s0_ = hi32 ? d_[2] : d_[0], t0_ = hi32 ? d_[0] : d_[2]; s0_ += __shfl_xor(t0_, 32); \
        float s1_ = hi32 ? d_[3] : d_[1], t1_ = hi32 ? d_[1] : d_[3]; s1_ += __shfl_xor(t1_, 32); \
        float r_ = hi16 ? s1_ : s0_, t2_ = hi16 ? s0_ : s1_; r_ += __shfl_xor(t2_, 16); \
        r_ += __shfl_xor(r_, 8); r_ += __shfl_xor(r_, 4); r_ += __shfl_xor(r_, 2); r_ += __shfl_xor(r_, 1); \
          \
        const int esel_ = (grp) * 4 + (lane >> 4); \
        const float su_ = __shfl(esel_ < 64 ? su0 : su1, esel_ & 63), gv_ = __shfl(esel_ < 64 ? gs0 : gs1, esel_ & 63); \
        const float cfl_ = geluf_(r_ * su_) * gv_; \
        _Pragma("unroll") for (int i_ = 0; i_ < 4; ++i_) { \
            const float cf_ = __uint_as_float(__builtin_amdgcn_readlane(__float_as_uint(cfl_), 16 * i_)); \
            PE_AXPY4(VB[i_].x, 0); PE_AXPY4(VB[i_].y, 1); PE_AXPY4(VB[i_].z, 2); PE_AXPY4(VB[i_].w, 3); } } while (0)
__device__ __forceinline__ void peer_expert_w(const float* __restrict__ xrow, const int* __restrict__ exr, const float* __restrict__ gar,
                                              const unsigned char* __restrict__ U, const unsigned char* __restrict__ V, const float* __restrict__ SU, const float* __restrict__ SV,
                                              const float* __restrict__ g, const float* __restrict__ bta, float* __restrict__ orow, bf16* __restrict__ obrow, int lane) {
    const bool hi32 = (lane & 32) != 0, hi16 = (lane & 16) != 0;
    const __amdgpu_buffer_rsrc_t ursrc = __builtin_amdgcn_make_buffer_rsrc((void*)U, 0, 16384 * 1024, 0x00020000);
    const __amdgpu_buffer_rsrc_t vrsrc = __builtin_amdgcn_make_buffer_rsrc((void*)V, 0, 16384 * 1024, 0x00020000);
    const int voff = lane * 16;
    float xv[16];
#pragma unroll
    for (int j = 0; j < 4; ++j) { const f32x4 t = *(const f32x4*)(xrow + lane * 16 + j * 4); xv[j * 4 + 0] = t.x; xv[j * 4 + 1] = t.y; xv[j * 4 + 2] = t.z; xv[j * 4 + 3] = t.w; }
    const int id0 = exr[lane], id1 = exr[64 + lane];
    const float su0 = SU[id0], su1 = SU[id1];
    const float gs0 = gar[lane] * SV[id0], gs1 = gar[64 + lane] * SV[id1];
    float acc[16];
#pragma unroll
    for (int i = 0; i < 16; ++i) acc[i] = 0.f;
    v4u ua[4], va[4], ub[4], vb[4];
    PE_LOAD(ua, va, 0);
#pragma unroll 1
    for (int grp = 0; grp < 32; grp += 2) {
        PE_LOAD(ub, vb, grp + 1);
        PE_COMP(ua, va, grp);
        if (grp + 2 < 32) PE_LOAD(ua, va, grp + 2);
        PE_COMP(ub, vb, grp + 1);
    }
    float v[16]; float s = 0.f;
#pragma unroll
    for (int i = 0; i < 16; ++i) { v[i] = ALPHA * xv[i] + acc[i]; s += v[i]; }
    const float mean = wave_sum(s) * (1.0f / 1024.0f); float q = 0.f;
#pragma unroll
    for (int i = 0; i < 16; ++i) { v[i] -= mean; q += v[i] * v[i]; }
    const float rs = rsqrtf(wave_sum(q) * (1.0f / 1024.0f) + LN_EPS);
    float o[16];
#pragma unroll
    for (int j = 0; j < 4; ++j) {
        const f32x4 g4 = *(const f32x4*)(g + lane * 16 + j * 4), b4 = *(const f32x4*)(bta + lane * 16 + j * 4);
        o[j * 4 + 0] = v[j * 4 + 0] * rs * g4.x + b4.x; o[j * 4 + 1] = v[j * 4 + 1] * rs * g4.y + b4.y; o[j * 4 + 2] = v[j * 4 + 2] * rs * g4.z + b4.z; o[j * 4 + 3] = v[j * 4 + 3] * rs * g4.w + b4.w;
        *(f32x4*)(orow + lane * 16 + j * 4) = (f32x4){o[j * 4 + 0], o[j * 4 + 1], o[j * 4 + 2], o[j * 4 + 3]};
    }
    if (obrow) {
        v4u w0, w1; w0.x = pk2(o[0], o[1]); w0.y = pk2(o[2], o[3]); w0.z = pk2(o[4], o[5]); w0.w = pk2(o[6], o[7]); w1.x = pk2(o[8], o[9]); w1.y = pk2(o[10], o[11]); w1.z = pk2(o[12], o[13]); w1.w = pk2(o[14], o[15]);
        *(v4u*)(obrow + lane * 16) = w0; *(v4u*)(obrow + lane * 16 + 8) = w1;
    }
}


__device__ __forceinline__ void peer_expert_blk(const float* __restrict__ xrow, const int* __restrict__ exr, const float* __restrict__ gar,
                                                const unsigned char* __restrict__ U, const unsigned char* __restrict__ V, const float* __restrict__ SU, const float* __restrict__ SV,
                                                const float* __restrict__ g, const float* __restrict__ bta, float* __restrict__ orow, bf16* __restrict__ obrow, int lane, int wave, float* smem) {
    const bool hi32 = (lane & 32) != 0, hi16 = (lane & 16) != 0;
    const __amdgpu_buffer_rsrc_t ursrc = __builtin_amdgcn_make_buffer_rsrc((void*)U, 0, 16384 * 1024, 0x00020000);
    const __amdgpu_buffer_rsrc_t vrsrc = __builtin_amdgcn_make_buffer_rsrc((void*)V, 0, 16384 * 1024, 0x00020000);
    const int voff = lane * 16;
    float xv[16];
#pragma unroll
    for (int j = 0; j < 4; ++j) { const f32x4 t = *(const f32x4*)(xrow + lane * 16 + j * 4); xv[j * 4 + 0] = t.x; xv[j * 4 + 1] = t.y; xv[j * 4 + 2] = t.z; xv[j * 4 + 3] = t.w; }
    const int id0 = exr[lane], id1 = exr[64 + lane];
    const float su0 = SU[id0], su1 = SU[id1];
    const float gs0 = gar[lane] * SV[id0], gs1 = gar[64 + lane] * SV[id1];
    float acc[16];
#pragma unroll
    for (int i = 0; i < 16; ++i) acc[i] = 0.f;
    v4u ua[4], va[4], ub[4], vb[4];
    const int g0 = wave * 4;
    PE_LOAD(ua, va, g0); PE_LOAD(ub, vb, g0 + 1);
    PE_COMP(ua, va, g0); PE_LOAD(ua, va, g0 + 2);
    PE_COMP(ub, vb, g0 + 1); PE_LOAD(ub, vb, g0 + 3);
    PE_COMP(ua, va, g0 + 2);
    PE_COMP(ub, vb, g0 + 3);
    float* accs = smem;
    float* sred = smem + 8192;
#pragma unroll
    for (int j = 0; j < 4; ++j) *(f32x4*)(accs + wave * 1024 + lane * 16 + j * 4) = (f32x4){acc[j * 4 + 0], acc[j * 4 + 1], acc[j * 4 + 2], acc[j * 4 + 3]};
    __syncthreads();
    const int tid = wave * 64 + lane;
    float v0 = ALPHA * xrow[tid * 2], v1 = ALPHA * xrow[tid * 2 + 1];
#pragma unroll
    for (int w = 0; w < 8; ++w) { v0 += accs[w * 1024 + tid * 2]; v1 += accs[w * 1024 + tid * 2 + 1]; }
    const float s = wave_sum(v0 + v1);
    if (lane == 0) sred[wave] = s;
    __syncthreads();
    float mean = 0.f;
#pragma unroll
    for (int w = 0; w < 8; ++w) mean += sred[w];
    mean *= (1.0f / 1024.0f);
    __syncthreads();
    const float d0 = v0 - mean, d1 = v1 - mean;
    const float q = wave_sum(d0 * d0 + d1 * d1);
    if (lane == 0) sred[wave] = q;
    __syncthreads();
    float var = 0.f;
#pragma unroll
    for (int w = 0; w < 8; ++w) var += sred[w];
    const float rs = rsqrtf(var * (1.0f / 1024.0f) + LN_EPS);
    const float o0 = d0 * rs * g[tid * 2] + bta[tid * 2], o1 = d1 * rs * g[tid * 2 + 1] + bta[tid * 2 + 1];
    *(float2*)(orow + tid * 2) = make_float2(o0, o1);
    if (obrow) *(unsigned*)(obrow + tid * 2) = pk2(o0, o1);
    __syncthreads();
}

__device__ __forceinline__ void row_to_fp8_sliced(const float* __restrict__ xrow, unsigned char* __restrict__ tab, int r, float* __restrict__ scale, int lane) {
    f32x4 v[4]; float am = 0.f;
#pragma unroll
    for (int j = 0; j < 4; ++j) { v[j] = *(const f32x4*)(xrow + lane * 16 + j * 4); am = fmaxf(am, fmaxf(fmaxf(fabsf(v[j].x), fabsf(v[j].y)), fmaxf(fabsf(v[j].z), fabsf(v[j].w)))); }
    am = wave_max(am);
    const float s = am > 0.f ? am * (1.0f / 448.0f) : 1.0f, inv = 1.0f / s;
    v4u o; unsigned w;
    w = 0u; w = __builtin_amdgcn_cvt_pk_fp8_f32(v[0].x * inv, v[0].y * inv, w, false); w = __builtin_amdgcn_cvt_pk_fp8_f32(v[0].z * inv, v[0].w * inv, w, true); o.x = w;
    w = 0u; w = __builtin_amdgcn_cvt_pk_fp8_f32(v[1].x * inv, v[1].y * inv, w, false); w = __builtin_amdgcn_cvt_pk_fp8_f32(v[1].z * inv, v[1].w * inv, w, true); o.y = w;
    w = 0u; w = __builtin_amdgcn_cvt_pk_fp8_f32(v[2].x * inv, v[2].y * inv, w, false); w = __builtin_amdgcn_cvt_pk_fp8_f32(v[2].z * inv, v[2].w * inv, w, true); o.z = w;
    w = 0u; w = __builtin_amdgcn_cvt_pk_fp8_f32(v[3].x * inv, v[3].y * inv, w, false); w = __builtin_amdgcn_cvt_pk_fp8_f32(v[3].z * inv, v[3].w * inv, w, true); o.w = w;
    *(v4u*)(tab + ((size_t)(lane >> 3) * 16384 + r) * 128 + (lane & 7) * 16) = o;
    if (lane == 0) *scale = s;
}
__device__ __forceinline__ void row_to_i8_sliced(const float* __restrict__ xrow, unsigned char* __restrict__ tab, int r, float* __restrict__ scale, int lane) {
    f32x4 v[4]; float am = 0.f;
#pragma unroll
    for (int j = 0; j < 4; ++j) { v[j] = *(const f32x4*)(xrow + lane * 16 + j * 4); am = fmaxf(am, fmaxf(fmaxf(fabsf(v[j].x), fabsf(v[j].y)), fmaxf(fabsf(v[j].z), fabsf(v[j].w)))); }
    am = wave_max(am);
    const float s = am > 0.f ? am * (1.0f / 127.0f) : 1.0f, inv = 1.0f / s;
    v4u o;
#define I8PK(q_) (((unsigned)(int)rintf((q_).x * inv) & 0xffu) | (((unsigned)(int)rintf((q_).y * inv) & 0xffu) << 8) | (((unsigned)(int)rintf((q_).z * inv) & 0xffu) << 16) | (((unsigned)(int)rintf((q_).w * inv) & 0xffu) << 24))
    o.x = I8PK(v[0]); o.y = I8PK(v[1]); o.z = I8PK(v[2]); o.w = I8PK(v[3]);
    *(v4u*)(tab + ((size_t)(lane >> 3) * 16384 + r) * 128 + (lane & 7) * 16) = o;
    if (lane == 0) *scale = s;
}
__device__ __forceinline__ void peer_u_pass(const bf16* __restrict__ xrow, const int* __restrict__ exr, const unsigned char* __restrict__ U8x, float* __restrict__ pd, int x, int lane) {
    const int e8 = lane >> 3, c = lane & 7;
    f32x2_t xp[8];
#pragma unroll
    for (int j = 0; j < 2; ++j) { const v4u t = *(const v4u*)(xrow + x * 128 + c * 16 + j * 8);
        xp[j * 4 + 0] = (f32x2_t){bflo(t.x), bfhi(t.x)}; xp[j * 4 + 1] = (f32x2_t){bflo(t.y), bfhi(t.y)}; xp[j * 4 + 2] = (f32x2_t){bflo(t.z), bfhi(t.z)}; xp[j * 4 + 3] = (f32x2_t){bflo(t.w), bfhi(t.w)}; }
    const __amdgpu_buffer_rsrc_t ursrc = __builtin_amdgcn_make_buffer_rsrc((void*)U8x, 0, 16384 * 128, 0x00020000);
    v4u wa[8], wb[8];
    float d[16];
    int ids[16];
#pragma unroll
    for (int j = 0; j < 4; ++j) { const v4u t = *(const v4u*)(exr + e8 * 16 + j * 4); ids[j * 4 + 0] = (int)t.x; ids[j * 4 + 1] = (int)t.y; ids[j * 4 + 2] = (int)t.z; ids[j * 4 + 3] = (int)t.w; }
#pragma unroll
    for (int g = 0; g < 8; ++g) wa[g] = __builtin_amdgcn_raw_buffer_load_b128(ursrc, ids[g] * 128 + c * 16, 0, 0);
#pragma unroll
    for (int g = 0; g < 8; ++g) wb[g] = __builtin_amdgcn_raw_buffer_load_b128(ursrc, ids[8 + g] * 128 + c * 16, 0, 0);
#define PU_DOT1(w_, k_) do { a_ = __builtin_elementwise_fma(__builtin_amdgcn_cvt_pk_f32_fp8((w_), false), xp[(k_) * 2], a_); a_ = __builtin_elementwise_fma(__builtin_amdgcn_cvt_pk_f32_fp8((w_), true), xp[(k_) * 2 + 1], a_); } while (0)
#pragma unroll
    for (int g = 0; g < 8; ++g) { f32x2_t a_ = (f32x2_t){0.f, 0.f}; PU_DOT1(wa[g].x, 0); PU_DOT1(wa[g].y, 1); PU_DOT1(wa[g].z, 2); PU_DOT1(wa[g].w, 3); d[g] = a_.x + a_.y; }
#pragma unroll
    for (int g = 0; g < 8; ++g) { f32x2_t a_ = (f32x2_t){0.f, 0.f}; PU_DOT1(wb[g].x, 0); PU_DOT1(wb[g].y, 1); PU_DOT1(wb[g].z, 2); PU_DOT1(wb[g].w, 3); d[8 + g] = a_.x + a_.y; }
#pragma unroll
    for (int g = 0; g < 16; ++g) { d[g] += DPPF(d[g], 0xB1, 0xf); d[g] += DPPF(d[g], 0x4E, 0xf); d[g] += DPPF(d[g], 0x141, 0xf); }
    if (c == 0) {
#pragma unroll
        for (int j = 0; j < 4; ++j) *(f32x4*)(pd + e8 * 16 + j * 4) = (f32x4){d[j * 4 + 0], d[j * 4 + 1], d[j * 4 + 2], d[j * 4 + 3]};
    }
}
#define PUL_IDS(I, k_) do { const int t_ = ((tg0 + ((k_) < nit ? (k_) : nit - 1) * tgstep) * 8 + wave); _Pragma("unroll") for (int j = 0; j < 4; ++j) I[j] = *(const v4u*)(EXPp + (size_t)t_ * 128 + e8 * 16 + j * 4); } while (0)
#define PUL_ROWS(R, X, I, k_) do { const int t_ = ((tg0 + ((k_) < nit ? (k_) : nit - 1) * tgstep) * 8 + wave); \
        X[0] = *(const v4u*)(XBp + (size_t)t_ * D + x * 128 + c * 16); X[1] = *(const v4u*)(XBp + (size_t)t_ * D + x * 128 + c * 16 + 8); \
        _Pragma("unroll") for (int j = 0; j < 4; ++j) { R[j * 4 + 0] = __builtin_amdgcn_raw_buffer_load_b128(ursrc, (int)I[j].x * 128 + c * 16, 0, 0); R[j * 4 + 1] = __builtin_amdgcn_raw_buffer_load_b128(ursrc, (int)I[j].y * 128 + c * 16, 0, 0); \
            R[j * 4 + 2] = __builtin_amdgcn_raw_buffer_load_b128(ursrc, (int)I[j].z * 128 + c * 16, 0, 0); R[j * 4 + 3] = __builtin_amdgcn_raw_buffer_load_b128(ursrc, (int)I[j].w * 128 + c * 16, 0, 0); } } while (0)
#define PUL_COMP(R, X, k_) do { float xf_[16]; \
        _Pragma("unroll") for (int j = 0; j < 2; ++j) { xf_[j * 8 + 0] = bflo(X[j].x); xf_[j * 8 + 1] = bfhi(X[j].x); xf_[j * 8 + 2] = bflo(X[j].y); xf_[j * 8 + 3] = bfhi(X[j].y); xf_[j * 8 + 4] = bflo(X[j].z); xf_[j * 8 + 5] = bfhi(X[j].z); xf_[j * 8 + 6] = bflo(X[j].w); xf_[j * 8 + 7] = bfhi(X[j].w); } \
          \
        float am_ = 0.f; _Pragma("unroll") for (int i = 0; i < 16; ++i) am_ = fmaxf(am_, fabsf(xf_[i])); \
        am_ = fmaxf(am_, DPPF(am_, 0xB1, 0xf)); am_ = fmaxf(am_, DPPF(am_, 0x4E, 0xf)); am_ = fmaxf(am_, DPPF(am_, 0x141, 0xf)); \
        const float sx_ = am_ > 0.f ? am_ * (1.0f / 127.0f) : 1.0f, ix_ = 1.0f / sx_; \
        int xq_[4]; \
        _Pragma("unroll") for (int j = 0; j < 4; ++j) xq_[j] = (int)(((unsigned)(int)rintf(xf_[j * 4 + 0] * ix_) & 0xffu) | (((unsigned)(int)rintf(xf_[j * 4 + 1] * ix_) & 0xffu) << 8) | (((unsigned)(int)rintf(xf_[j * 4 + 2] * ix_) & 0xffu) << 16) | (((unsigned)(int)rintf(xf_[j * 4 + 3] * ix_) & 0xffu) << 24)); \
        float d[16]; \
        _Pragma("unroll") for (int g = 0; g < 16; ++g) { int a_ = __builtin_amdgcn_sdot4((int)R[g].x, xq_[0], 0, false); a_ = __builtin_amdgcn_sdot4((int)R[g].y, xq_[1], a_, false); a_ = __builtin_amdgcn_sdot4((int)R[g].z, xq_[2], a_, false); a_ = __builtin_amdgcn_sdot4((int)R[g].w, xq_[3], a_, false); d[g] = (float)a_; } \
        _Pragma("unroll") for (int g = 0; g < 16; ++g) { d[g] += DPPF(d[g], 0xB1, 0xf); d[g] += DPPF(d[g], 0x4E, 0xf); d[g] += DPPF(d[g], 0x141, 0xf); d[g] *= sx_; } \
        if (c == 0 && (k_) < nit) { float* pd_ = PDx + (size_t)((tg0 + (k_) * tgstep) * 8 + wave) * 128 + e8 * 16; \
            _Pragma("unroll") for (int j = 0; j < 4; ++j) *(f32x4*)(pd_ + j * 4) = (f32x4){d[j * 4 + 0], d[j * 4 + 1], d[j * 4 + 2], d[j * 4 + 3]}; } } while (0)
__device__ __forceinline__ void peer_u_loop(const bf16* __restrict__ XBp, const int* __restrict__ EXPp, const unsigned char* __restrict__ U8x, float* __restrict__ PDx, int x, int tg0, int tgstep, int nit, int wave, int lane) {
    const int e8 = lane >> 3, c = lane & 7;
    const __amdgpu_buffer_rsrc_t ursrc = __builtin_amdgcn_make_buffer_rsrc((void*)U8x, 0, 16384 * 128, 0x00020000);
    v4u ra[16], rb[16], xa[2], xb[2], i0[4], i1[4];
    PUL_IDS(i0, 0);
    PUL_ROWS(ra, xa, i0, 0);
    PUL_IDS(i1, 1);
#pragma unroll 1
    for (int k = 0; k < nit; k += 2) {
        PUL_ROWS(rb, xb, i1, k + 1);
        PUL_IDS(i0, k + 2);
        PUL_COMP(ra, xa, k);
        PUL_ROWS(ra, xa, i0, k + 2);
        PUL_IDS(i1, k + 3);
        PUL_COMP(rb, xb, k + 1);
    }
}
#define PV_LOAD(VB, grp) do { _Pragma("unroll") for (int i_ = 0; i_ < 4; ++i_) { const int e_ = (grp) * 4 + i_; \
        const int id_ = __builtin_amdgcn_readlane(e_ < 64 ? id0 : id1, e_ & 63); \
        VB[i_] = __builtin_amdgcn_raw_buffer_load_b128(vrsrc, voff, (unsigned)id_ * 1024u, 0); } } while (0)
#define PV_COMP(VB, grp) do { _Pragma("unroll") for (int i_ = 0; i_ < 4; ++i_) { const int e_ = (grp) * 4 + i_; \
        const float cf_ = __uint_as_float(__builtin_amdgcn_readlane(__float_as_uint(e_ < 64 ? cf0 : cf1), e_ & 63)); \
        PE_AXPY4(VB[i_].x, 0); PE_AXPY4(VB[i_].y, 1); PE_AXPY4(VB[i_].z, 2); PE_AXPY4(VB[i_].w, 3); } } while (0)
#define PV_COEFS() \
    const int id0 = exr[lane], id1 = exr[64 + lane]; \
    float dot0 = 0.f, dot1 = 0.f; \
    { const int p0 = lane, p1 = 64 + lane;        \
      _Pragma("unroll") for (int x_ = 0; x_ < 8; ++x_) { dot0 += pdt[(size_t)x_ * NT * 128 + p0]; dot1 += pdt[(size_t)x_ * NT * 128 + p1]; } } \
    const float cf0 = gar[lane] * SV[id0] * geluf_(SU[id0] * dot0), cf1 = gar[64 + lane] * SV[id1] * geluf_(SU[id1] * dot1);
__device__ __forceinline__ void peer_v_w(const float* __restrict__ xrow, const int* __restrict__ exr, const float* __restrict__ gar, const float* __restrict__ pdt,
                                         const unsigned char* __restrict__ V, const float* __restrict__ SU, const float* __restrict__ SV,
                                         const float* __restrict__ g, const float* __restrict__ bta, float* __restrict__ orow, bf16* __restrict__ obrow, int lane) {
    const __amdgpu_buffer_rsrc_t vrsrc = __builtin_amdgcn_make_buffer_rsrc((void*)V, 0, 16384 * 1024, 0x00020000);
    const int voff = lane * 16;
    PV_COEFS()
    float acc[16];
#pragma unroll
    for (int i = 0; i < 16; ++i) acc[i] = 0.f;
    v4u va[4], vb[4], vc[4];
    PV_LOAD(va, 0); PV_LOAD(vb, 1);
#pragma unroll 1
    for (int grp = 0; grp < 30; grp += 3) {
        PV_LOAD(vc, grp + 2);
        PV_COMP(va, grp);
        PV_LOAD(va, grp + 3);
        PV_COMP(vb, grp + 1);
        PV_LOAD(vb, grp + 4);
        PV_COMP(vc, grp + 2);
    }
    PV_COMP(va, 30); PV_COMP(vb, 31);
    float xv[16];
#pragma unroll
    for (int j = 0; j < 4; ++j) { const f32x4 t = *(const f32x4*)(xrow + lane * 16 + j * 4); xv[j * 4 + 0] = t.x; xv[j * 4 + 1] = t.y; xv[j * 4 + 2] = t.z; xv[j * 4 + 3] = t.w; }
    float v[16]; float s = 0.f;
#pragma unroll
    for (int i = 0; i < 16; ++i) { v[i] = ALPHA * xv[i] + acc[i]; s += v[i]; }
    const float mean = wave_sum(s) * (1.0f / 1024.0f); float q = 0.f;
#pragma unroll
    for (int i = 0; i < 16; ++i) { v[i] -= mean; q += v[i] * v[i]; }
    const float rs = rsqrtf(wave_sum(q) * (1.0f / 1024.0f) + LN_EPS);
    float o[16];
#pragma unroll
    for (int j = 0; j < 4; ++j) {
        const f32x4 g4 = *(const f32x4*)(g + lane * 16 + j * 4), b4 = *(const f32x4*)(bta + lane * 16 + j * 4);
        o[j * 4 + 0] = v[j * 4 + 0] * rs * g4.x + b4.x; o[j * 4 + 1] = v[j * 4 + 1] * rs * g4.y + b4.y; o[j * 4 + 2] = v[j * 4 + 2] * rs * g4.z + b4.z; o[j * 4 + 3] = v[j * 4 + 3] * rs * g4.w + b4.w;
        *(f32x4*)(orow + lane * 16 + j * 4) = (f32x4){o[j * 4 + 0], o[j * 4 + 1], o[j * 4 + 2], o[j * 4 + 3]};
    }
    if (obrow) {
        v4u w0, w1; w0.x = pk2(o[0], o[1]); w0.y = pk2(o[2], o[3]); w0.z = pk2(o[4], o[5]); w0.w = pk2(o[6], o[7]); w1.x = pk2(o[8], o[9]); w1.y = pk2(o[10], o[11]); w1.z = pk2(o[12], o[13]); w1.w = pk2(o[14], o[15]);
        *(v4u*)(obrow + lane * 16) = w0; *(v4u*)(obrow + lane * 16 + 8) = w1;
    }
}
__device__ __forceinline__ void peer_v_blk(const float* __restrict__ xrow, const int* __restrict__ exr, const float* __restrict__ gar, const float* __restrict__ pdt,
                                           const unsigned char* __restrict__ V, const float* __restrict__ SU, const float* __restrict__ SV,
                                           const float* __restrict__ g, const float* __restrict__ bta, float* __restrict__ orow, bf16* __restrict__ obrow, int lane, int wave, float* smem) {
    const __amdgpu_buffer_rsrc_t vrsrc = __builtin_amdgcn_make_buffer_rsrc((void*)V, 0, 16384 * 1024, 0x00020000);
    const int voff = lane * 16;
    PV_COEFS()
    float acc[16];
#pragma unroll
    for (int i = 0; i < 16; ++i) acc[i] = 0.f;
    v4u va[4], vb[4], vc[4], vd[4];
    PV_LOAD(va, wave * 4); PV_LOAD(vb, wave * 4 + 1); PV_LOAD(vc, wave * 4 + 2); PV_LOAD(vd, wave * 4 + 3);
    PV_COMP(va, wave * 4); PV_COMP(vb, wave * 4 + 1); PV_COMP(vc, wave * 4 + 2); PV_COMP(vd, wave * 4 + 3);
    float* accs = smem;
    float* sred = smem + 8192;
#pragma unroll
    for (int j = 0; j < 4; ++j) *(f32x4*)(accs + wave * 1024 + lane * 16 + j * 4) = (f32x4){acc[j * 4 + 0], acc[j * 4 + 1], acc[j * 4 + 2], acc[j * 4 + 3]};
    __syncthreads();
    const int tid = wave * 64 + lane;
    float v0 = ALPHA * xrow[tid * 2], v1 = ALPHA * xrow[tid * 2 + 1];
#pragma unroll
    for (int w = 0; w < 8; ++w) { v0 += accs[w * 1024 + tid * 2]; v1 += accs[w * 1024 + tid * 2 + 1]; }
    const float s = wave_sum(v0 + v1);
    if (lane == 0) sred[wave] = s;
    __syncthreads();
    float mean = 0.f;
#pragma unroll
    for (int w = 0; w < 8; ++w) mean += sred[w];
    mean *= (1.0f / 1024.0f);
    __syncthreads();
    const float d0 = v0 - mean, d1 = v1 - mean;
    const float q = wave_sum(d0 * d0 + d1 * d1);
    if (lane == 0) sred[wave] = q;
    __syncthreads();
    float var = 0.f;
#pragma unroll
    for (int w = 0; w < 8; ++w) var += sred[w];
    const float rs = rsqrtf(var * (1.0f / 1024.0f) + LN_EPS);
    const float o0 = d0 * rs * g[tid * 2] + bta[tid * 2], o1 = d1 * rs * g[tid * 2 + 1] + bta[tid * 2 + 1];
    *(float2*)(orow + tid * 2) = make_float2(o0, o1);
    if (obrow) *(unsigned*)(obrow + tid * 2) = pk2(o0, o1);
    __syncthreads();
}

__device__ __forceinline__ void peer_xk(const int* __restrict__ exr, float* __restrict__ gar, const float* __restrict__ pdt, const float* __restrict__ SU, const float* __restrict__ SV, int lane) {
    PV_COEFS()
    gar[lane] = cf0; gar[64 + lane] = cf1;
}
__device__ __forceinline__ void peer_v_slice(const int* __restrict__ exr, const float* __restrict__ cfr, const unsigned char* __restrict__ V8x, float* __restrict__ outs  , int lane) {
    const int e8 = lane >> 3, c = lane & 7;
    const __amdgpu_buffer_rsrc_t vrsrc = __builtin_amdgcn_make_buffer_rsrc((void*)V8x, 0, 16384 * 128, 0x00020000);
    v4u wa[8], wb[8]; float cfa[8], cfb[8];
    int ids[16];
#pragma unroll
    for (int j = 0; j < 4; ++j) { const v4u t = *(const v4u*)(exr + e8 * 16 + j * 4); ids[j * 4 + 0] = (int)t.x; ids[j * 4 + 1] = (int)t.y; ids[j * 4 + 2] = (int)t.z; ids[j * 4 + 3] = (int)t.w; }
#pragma unroll
    for (int g = 0; g < 8; ++g) wa[g] = __builtin_amdgcn_raw_buffer_load_b128(vrsrc, ids[g] * 128 + c * 16, 0, 0);
#pragma unroll
    for (int g = 0; g < 8; ++g) wb[g] = __builtin_amdgcn_raw_buffer_load_b128(vrsrc, ids[8 + g] * 128 + c * 16, 0, 0);
#pragma unroll
    for (int j = 0; j < 2; ++j) { const f32x4 t = *(const f32x4*)(cfr + e8 * 16 + j * 4), u = *(const f32x4*)(cfr + e8 * 16 + 8 + j * 4);
        cfa[j * 4 + 0] = t.x; cfa[j * 4 + 1] = t.y; cfa[j * 4 + 2] = t.z; cfa[j * 4 + 3] = t.w; cfb[j * 4 + 0] = u.x; cfb[j * 4 + 1] = u.y; cfb[j * 4 + 2] = u.z; cfb[j * 4 + 3] = u.w; }
    f32x2_t ap[8];
#pragma unroll
    for (int i = 0; i < 8; ++i) ap[i] = (f32x2_t){0.f, 0.f};
#define PVS_AXPY(w_, k_) do { ap[(k_) * 2] = __builtin_elementwise_fma(cf2_, __builtin_amdgcn_cvt_pk_f32_fp8((w_), false), ap[(k_) * 2]); ap[(k_) * 2 + 1] = __builtin_elementwise_fma(cf2_, __builtin_amdgcn_cvt_pk_f32_fp8((w_), true), ap[(k_) * 2 + 1]); } while (0)
#pragma unroll
    for (int g = 0; g < 8; ++g) { const f32x2_t cf2_ = (f32x2_t){cfa[g], cfa[g]}; PVS_AXPY(wa[g].x, 0); PVS_AXPY(wa[g].y, 1); PVS_AXPY(wa[g].z, 2); PVS_AXPY(wa[g].w, 3); }
#pragma unroll
    for (int g = 0; g < 8; ++g) { const f32x2_t cf2_ = (f32x2_t){cfb[g], cfb[g]}; PVS_AXPY(wb[g].x, 0); PVS_AXPY(wb[g].y, 1); PVS_AXPY(wb[g].z, 2); PVS_AXPY(wb[g].w, 3); }
#undef PVS_AXPY
    float acc[16];
#pragma unroll
    for (int i = 0; i < 8; ++i) { acc[2 * i] = ap[i].x; acc[2 * i + 1] = ap[i].y; }
#pragma unroll
    for (int i = 0; i < 16; ++i) { float v = acc[i]; v += DPPF(v, 0x128, 0xf); v += __shfl_xor(v, 16); v += __shfl_xor(v, 32); acc[i] = v; }
    if (e8 == 0) {
#pragma unroll
        for (int j = 0; j < 4; ++j) *(f32x4*)(outs + c * 16 + j * 4) = (f32x4){acc[j * 4 + 0], acc[j * 4 + 1], acc[j * 4 + 2], acc[j * 4 + 3]};
    }
}
#define PVL_IDS(I, k_) do { const int t_ = ((tg0 + ((k_) < nit ? (k_) : nit - 1) * tgstep) * 8 + wave); _Pragma("unroll") for (int j = 0; j < 4; ++j) I[j] = *(const v4u*)(EXPp + (size_t)t_ * 128 + e8 * 16 + j * 4); } while (0)
#define PVL_ROWS(R, C, I, k_) do { const int t_ = ((tg0 + ((k_) < nit ? (k_) : nit - 1) * tgstep) * 8 + wave); \
        _Pragma("unroll") for (int j = 0; j < 4; ++j) C[j] = *(const f32x4*)(CFp + (size_t)t_ * 128 + e8 * 16 + j * 4); \
        _Pragma("unroll") for (int j = 0; j < 4; ++j) { R[j * 4 + 0] = __builtin_amdgcn_raw_buffer_load_b128(vrsrc, (int)I[j].x * 128 + c * 16, 0, 0); R[j * 4 + 1] = __builtin_amdgcn_raw_buffer_load_b128(vrsrc, (int)I[j].y * 128 + c * 16, 0, 0); \
            R[j * 4 + 2] = __builtin_amdgcn_raw_buffer_load_b128(vrsrc, (int)I[j].z * 128 + c * 16, 0, 0); R[j * 4 + 3] = __builtin_amdgcn_raw_buffer_load_b128(vrsrc, (int)I[j].w * 128 + c * 16, 0, 0); } } while (0)
#define PVL_AXPY(w_, k2_) do { ap[(k2_) * 2] = __builtin_elementwise_fma(cf2_, __builtin_amdgcn_cvt_pk_f32_fp8((w_), false), ap[(k2_) * 2]); ap[(k2_) * 2 + 1] = __builtin_elementwise_fma(cf2_, __builtin_amdgcn_cvt_pk_f32_fp8((w_), true), ap[(k2_) * 2 + 1]); } while (0)
#define PVL_COMP(R, C, k_) do { f32x2_t ap[8]; \
        _Pragma("unroll") for (int i = 0; i < 8; ++i) ap[i] = (f32x2_t){0.f, 0.f}; \
        _Pragma("unroll") for (int g = 0; g < 16; ++g) { const float cfs_ = C[g >> 2][g & 3]; const f32x2_t cf2_ = (f32x2_t){cfs_, cfs_}; PVL_AXPY(R[g].x, 0); PVL_AXPY(R[g].y, 1); PVL_AXPY(R[g].z, 2); PVL_AXPY(R[g].w, 3); } \
        float acc[16]; \
        _Pragma("unroll") for (int i = 0; i < 8; ++i) { acc[2 * i] = ap[i].x; acc[2 * i + 1] = ap[i].y; } \
        float a8[8], a4[4], a2[2]; \
        _Pragma("unroll") for (int i = 0; i < 8; ++i) { const float keep = hA ? acc[8 + i] : acc[i], send = hA ? acc[i] : acc[8 + i]; a8[i] = keep + __shfl_xor(send, 32); } \
        _Pragma("unroll") for (int i = 0; i < 4; ++i) { const float keep = hB ? a8[4 + i] : a8[i], send = hB ? a8[i] : a8[4 + i]; a4[i] = keep + __shfl_xor(send, 16); } \
        _Pragma("unroll") for (int i = 0; i < 2; ++i) { const float keep = hC ? a4[2 + i] : a4[i], send = hC ? a4[i] : a4[2 + i]; a2[i] = keep + DPPF(send, 0x128, 0xf); } \
        if ((k_) < nit) *(float2*)(OUTp + (size_t)((tg0 + (k_) * tgstep) * 8 + wave) * D + x * 128 + c * 16 + 2 * e8) = make_float2(a2[0], a2[1]); } while (0)
__device__ __forceinline__ void peer_v_loop(const int* __restrict__ EXPp, const float* __restrict__ CFp, const unsigned char* __restrict__ V8x, float* __restrict__ OUTp, int x, int tg0, int tgstep, int nit, int wave, int lane) {
    const int e8 = lane >> 3, c = lane & 7;
    const bool hA = (lane & 32) != 0, hB = (lane & 16) != 0, hC = (lane & 8) != 0;
    const __amdgpu_buffer_rsrc_t vrsrc = __builtin_amdgcn_make_buffer_rsrc((void*)V8x, 0, 16384 * 128, 0x00020000);
    v4u ra[16], rb[16], i0[4], i1[4]; f32x4 ca[4], cb[4];
    PVL_IDS(i0, 0);
    PVL_ROWS(ra, ca, i0, 0);
    PVL_IDS(i1, 1);
#pragma unroll 1
    for (int k = 0; k < nit; k += 2) {
        PVL_ROWS(rb, cb, i1, k + 1);
        PVL_IDS(i0, k + 2);
        PVL_COMP(ra, ca, k);
        PVL_ROWS(ra, ca, i0, k + 2);
        PVL_IDS(i1, k + 3);
        PVL_COMP(rb, cb, k + 1);
    }
}
__device__ __forceinline__ void peer_xc(const bf16* __restrict__ xrow, const float* __restrict__ srow, const float* __restrict__ g, const float* __restrict__ bta, float* __restrict__ orow, bf16* __restrict__ obrow, bf16* __restrict__ obrow2, int lane) {
    float v[16]; float s = 0.f;
#pragma unroll
    for (int j = 0; j < 4; ++j) { const v2u ab = *(const v2u*)(xrow + lane * 16 + j * 4); const f32x4 b = *(const f32x4*)(srow + lane * 16 + j * 4);
        v[j * 4 + 0] = ALPHA * bflo(ab.x) + b.x; v[j * 4 + 1] = ALPHA * bfhi(ab.x) + b.y; v[j * 4 + 2] = ALPHA * bflo(ab.y) + b.z; v[j * 4 + 3] = ALPHA * bfhi(ab.y) + b.w; }
#pragma unroll
    for (int i = 0; i < 16; ++i) s += v[i];
    const float mean = wave_sum(s) * (1.0f / 1024.0f); float q = 0.f;
#pragma unroll
    for (int i = 0; i < 16; ++i) { v[i] -= mean; q += v[i] * v[i]; }
    const float rs = rsqrtf(wave_sum(q) * (1.0f / 1024.0f) + LN_EPS);
    float o[16];
#pragma unroll
    for (int j = 0; j < 4; ++j) {
        const f32x4 g4 = *(const f32x4*)(g + lane * 16 + j * 4), b4 = *(const f32x4*)(bta + lane * 16 + j * 4);
        o[j * 4 + 0] = v[j * 4 + 0] * rs * g4.x + b4.x; o[j * 4 + 1] = v[j * 4 + 1] * rs * g4.y + b4.y; o[j * 4 + 2] = v[j * 4 + 2] * rs * g4.z + b4.z; o[j * 4 + 3] = v[j * 4 + 3] * rs * g4.w + b4.w;
        if (orow) *(f32x4*)(orow + lane * 16 + j * 4) = (f32x4){o[j * 4 + 0], o[j * 4 + 1], o[j * 4 + 2], o[j * 4 + 3]};
    }
    if (obrow) {
        v4u w0, w1; w0.x = pk2(o[0], o[1]); w0.y = pk2(o[2], o[3]); w0.z = pk2(o[4], o[5]); w0.w = pk2(o[6], o[7]); w1.x = pk2(o[8], o[9]); w1.y = pk2(o[10], o[11]); w1.z = pk2(o[12], o[13]); w1.w = pk2(o[14], o[15]);
        *(v4u*)(obrow + lane * 16) = w0; *(v4u*)(obrow + lane * 16 + 8) = w1;
        if (obrow2) { *(v4u*)(obrow2 + lane * 16) = w0; *(v4u*)(obrow2 + lane * 16 + 8) = w1; }
    }
}

__device__ __forceinline__ int t5_bucket(int n) {
    if (n < 16) return n;
    const int large = 16 + (int)(logf((float)n / 16.0f) / 2.0794415416798357f * 16.0f);
    return large < 31 ? large : 31;
}
__device__ __forceinline__ void swa_attn(const float* __restrict__ PC, const float* __restrict__ cache_k, const float* __restrict__ cache_v,
                                         const float* __restrict__ rel_bias, const float* __restrict__ sinks, bf16* __restrict__ ATT, int bx) {
    const int tid = threadIdx.x, lane = tid & 63, wid = tid >> 6;
    const int gw = bx * 8 + wid;
    const int t = gw >> 4, h = gw & 15, kvh = h >> 2;
    if (t >= NT) return;
    const bool samp = t >= NP; const int sb = t - NP, pos = t % SEQ;
    const float* qrow = PC + (size_t)t * CN + h * 64;
    float lg[2]; bool valid[2];
#pragma unroll
    for (int rr = 0; rr < 2; ++rr) {
        const int r = lane + 64 * rr;
        const float* krow;
        if (!samp) { valid[rr] = (pos - r) >= 0; krow = PC + (size_t)(valid[rr] ? t - r : t) * CN + 1024 + kvh * 64; }
        else { valid[rr] = true; krow = (r == 0) ? PC + (size_t)t * CN + 1024 + kvh * 64 : cache_k + (((size_t)sb * 128 + (128 - r)) * 4 + kvh) * 64; }
        float dot = 0.f;
#pragma unroll
        for (int d4 = 0; d4 < 16; ++d4) {
            const float4 kv = *(const float4*)(krow + d4 * 4);
            const float4 qv = *(const float4*)(qrow + d4 * 4);
            dot += qv.x * kv.x + qv.y * kv.y + qv.z * kv.z + qv.w * kv.w;
        }
        lg[rr] = valid[rr] ? dot * 0.125f + rel_bias[t5_bucket(r) * 16 + h] : -INFINITY;
    }
    const float sink = sinks[h];
    const float m = fmaxf(wave_max(fmaxf(lg[0], lg[1])), sink);
    float p[2];
#pragma unroll
    for (int rr = 0; rr < 2; ++rr) p[rr] = valid[rr] ? expf(lg[rr] - m) : 0.f;
    const float den = wave_sum(p[0] + p[1]) + expf(sink - m);
    const float inv = 1.0f / den;
    float o = 0.f;
#pragma unroll
    for (int rr = 0; rr < 2; ++rr)
        for (int l2 = 0; l2 < 64; ++l2) {
            const int r = l2 + 64 * rr;
            const float pj = __shfl(p[rr], l2);
            if (pj != 0.f) {
                const float* vrow;
                if (!samp) vrow = PC + (size_t)(t - r) * CN + 1280 + kvh * 64;
                else vrow = (r == 0) ? PC + (size_t)t * CN + 1280 + kvh * 64 : cache_v + (((size_t)sb * 128 + (128 - r)) * 4 + kvh) * 64;
                o += pj * vrow[lane];
            }
        }
    ATT[(size_t)t * D + h * 64 + lane] = (bf16)f2bf(o * inv);
}

__device__ __forceinline__ void swa_kv_out(const float* __restrict__ PC, const float* __restrict__ cache_k, const float* __restrict__ cache_v,
                                           float* __restrict__ pk, float* __restrict__ pv, float* __restrict__ sk, float* __restrict__ sv, int vb) {
    const int c = threadIdx.x & 255, row = vb * 2 + (threadIdx.x >> 8);
    if (row < NB * 128) {
        const int b = row >> 7, i = row & 127;
        const float* src = PC + (size_t)(b * SEQ + SEQ - 128 + i) * CN;
        pk[(size_t)row * 256 + c] = src[1024 + c];
        pv[(size_t)row * 256 + c] = src[1280 + c];
    } else {
        const int r2 = row - NB * 128, sb = r2 >> 7, i = r2 & 127;
        if (i < 127) {
            sk[(size_t)r2 * 256 + c] = cache_k[((size_t)sb * 128 + i + 1) * 256 + c];
            sv[(size_t)r2 * 256 + c] = cache_v[((size_t)sb * 128 + i + 1) * 256 + c];
        } else {
            const float* src = PC + (size_t)(NP + sb) * CN;
            sk[(size_t)r2 * 256 + c] = src[1024 + c];
            sv[(size_t)r2 * 256 + c] = src[1280 + c];
        }
    }
}
#define XB_TMO      128
#define XB_XCNT(j)  (256  + 64 * (j))
#define XB_XSUB(j)  (1280 + 64 * (j))
#define XB_XGEN(j)  (2304 + 64 * (j))
#define XB_TOP      3328
#define XB_TOPGEN   3392
#define XCD_BAR_WORDS 3456
#define XB_SPIN_CAP (1u << 18)

__device__ __forceinline__ unsigned xb_ld(unsigned* p)              { return __hip_atomic_load(p, __ATOMIC_RELAXED, __HIP_MEMORY_SCOPE_AGENT); }
__device__ __forceinline__ unsigned xb_add(unsigned* p, unsigned v) { return __hip_atomic_fetch_add(p, v, __ATOMIC_RELAXED, __HIP_MEMORY_SCOPE_AGENT); }
__device__ __forceinline__ unsigned xb_xcc_id() { return (unsigned)__builtin_amdgcn_s_getreg((3 << 11) | 20) & 0xFu; }
#define XB_SPIN(cond, bar) do { unsigned _sp = 0; while (cond) { __builtin_amdgcn_s_sleep(1); \
    if ((++_sp & 255u) == 0u) { if (xb_ld(&(bar)[XB_TMO])) break; if (_sp > XB_SPIN_CAP) { atomicAdd(&(bar)[XB_TMO], 1u); break; } } } } while (0)

struct XcdBarrier {
    unsigned* bar; unsigned x;
    volatile LAS unsigned* st;
};

__device__ __forceinline__ XcdBarrier xcd_barrier_post(unsigned* bar, volatile LAS unsigned* st) {
    XcdBarrier b; b.bar = bar; b.x = xb_xcc_id(); b.st = st;
    if (threadIdx.x == 0) (void)xb_add(&bar[XB_XCNT(b.x)], 1u);
    return b;
}
__device__ __forceinline__ void xcd_barrier_complete(unsigned* bar, unsigned x, unsigned& nloc, unsigned& nx) {
    const unsigned G = gridDim.x * gridDim.y * gridDim.z;
    unsigned sum, cnt, mine, sp = 0u;
    for (;;) {
        sum = 0u; cnt = 0u; mine = 0u;
#pragma unroll
        for (unsigned j = 0; j < 16; ++j) { const unsigned c = xb_ld(&bar[XB_XCNT(j)]); sum += c; cnt += (c > 0u) ? 1u : 0u; mine = (j == x) ? c : mine; }
        if (sum == G) break;
        __builtin_amdgcn_s_sleep(1);
        if ((++sp & 255u) == 0u) { if (xb_ld(&bar[XB_TMO])) break; if (sp > XB_SPIN_CAP) { atomicAdd(&bar[XB_TMO], 1u); break; } }
    }
    nloc = mine > 0u ? mine : 1u; nx = cnt > 0u ? cnt : 1u;
}

__device__ __forceinline__ void xcd_barrier(const XcdBarrier& b) {
    asm volatile("s_waitcnt vmcnt(0)" ::: "memory");
    __syncthreads();
    if (threadIdx.x == 0) {
        unsigned* bar = b.bar;
        __builtin_amdgcn_s_waitcnt(0);
        unsigned nloc = b.st[0], nx = b.st[1];
        if (nloc == 0u) { xcd_barrier_complete(bar, b.x, nloc, nx); b.st[0] = nloc; b.st[1] = nx; }
        const unsigned old = xb_add(&bar[XB_XSUB(b.x)], 1u);
        const unsigned gen = old / nloc;
        if (old + 1u == (gen + 1u) * nloc) {
            __builtin_amdgcn_fence(__ATOMIC_RELEASE, "agent");
            asm volatile("s_waitcnt vmcnt(0)" ::: "memory");
            const unsigned og = xb_add(&bar[XB_TOP], 1u);
            const unsigned tg = og / nx;
            if (og + 1u == (tg + 1u) * nx) xb_add(&bar[XB_TOPGEN], 1u);
            else XB_SPIN(xb_ld(&bar[XB_TOPGEN]) == tg, bar);
            __builtin_amdgcn_fence(__ATOMIC_ACQUIRE, "agent");
            xb_add(&bar[XB_XGEN(b.x)], 1u);
            asm volatile("s_waitcnt vmcnt(0)" ::: "memory");
        } else {
            XB_SPIN(xb_ld(&bar[XB_XGEN(b.x)]) == gen, bar);
            __builtin_amdgcn_fence(__ATOMIC_ACQUIRE, "agent");
            asm volatile("s_waitcnt vmcnt(0)" ::: "memory");
        }
    }
    __syncthreads();
}

typedef short bf16x8_t __attribute__((ext_vector_type(8)));
__device__ __forceinline__ f32x4 mfma16(bf16x8_t a, bf16x8_t b, f32x4 c) { return __builtin_amdgcn_mfma_f32_16x16x32_bf16(a, b, c, 0, 0, 0); }

struct GdnChunkBufs {
    bf16* W;
    bf16* QG;
    bf16* KDT;
    bf16* UT;
    bf16* QK;
    float* EGL;
};

constexpr int GP_QB = 0, GP_KB = 17408, GP_VB = 34816, GP_LS = 52224, GP_QKS = 69632, GP_WS = 78848, GP_SC = 96256;

__device__ __forceinline__ void gdn_prep_unit(const bf16* __restrict__ PROJ, const float* __restrict__ conv_w, const float* __restrict__ a_log, const float* __restrict__ dt_bias,
                                              const GdnChunkBufs& cb, float* __restrict__ p_gdn_conv, int un, unsigned char* lds) {
    int tid = threadIdx.x; asm volatile("" : "+v"(tid));
    const int lane = tid & 63, wave = __builtin_amdgcn_readfirstlane(tid >> 6), fr = lane & 15, fq = lane >> 4;
    const int h = un & 3, n = (un >> 2) & 63, b = un >> 8;
    const int t0 = b * SEQ + n * 64;
    bf16* Qb = (bf16*)(lds + GP_QB); bf16* Kb = (bf16*)(lds + GP_KB); bf16* Vb = (bf16*)(lds + GP_VB); bf16* Ws = (bf16*)(lds + GP_WS);
    float* Ls = (float*)(lds + GP_LS); bf16* QKs = (bf16*)(lds + GP_QKS);
    float* gcs = (float*)(lds + GP_SC); float* bets = gcs + 64; float* egcs = gcs + 128; float* ekds = gcs + 192; float* begs = gcs + 256;
    if (wave == 0) {
        const bf16* prow = PROJ + (size_t)(t0 + lane) * ABN;
        const float a_raw = bf2f(prow[C_A + h]), b_raw = bf2f(prow[C_B + h]);
        float g = -expf(a_log[h]) * softplusf_(a_raw + dt_bias[h]);
#pragma unroll
        for (int off = 1; off < 64; off <<= 1) { const float v = __shfl_up(g, off); if (lane >= off) g += v; }
        const float glast = __shfl(g, 63);
        { const float be_ = sigmoidf_(b_raw), eg_ = expf(g); gcs[lane] = g; bets[lane] = be_; egcs[lane] = eg_; ekds[lane] = expf(glast - g); begs[lane] = be_ * eg_; }
        if (lane == 0) cb.EGL[un] = expf(glast);
    }
    {
        int cols[6]; float cw[4][6], xw[3][6];
#pragma unroll
        for (int p = 0; p < 3; ++p)
#pragma unroll
            for (int e = 0; e < 2; ++e) cols[p * 2 + e] = p * 512 + h * 128 + e * 64 + lane;
#pragma unroll
        for (int i = 0; i < 4; ++i)
#pragma unroll
            for (int c = 0; c < 6; ++c) cw[i][c] = conv_w[i * 1536 + cols[c]];
        const int i0 = wave * 8;
#pragma unroll
        for (int k = 0; k < 3; ++k) {
            const int pos = n * 64 + i0 - 3 + k;
#pragma unroll
            for (int c = 0; c < 6; ++c) xw[k][c] = pos >= 0 ? bf2f(PROJ[(size_t)(t0 + i0 - 3 + k) * ABN + cols[c]]) : 0.f;
        }
        bf16 xraw[8][6];
#pragma unroll
        for (int ii = 0; ii < 8; ++ii)
#pragma unroll
            for (int c = 0; c < 6; ++c) xraw[ii][c] = PROJ[(size_t)(t0 + i0 + ii) * ABN + cols[c]];
#pragma unroll
        for (int ii = 0; ii < 8; ++ii) {
            const int i = i0 + ii;
            float xt[6], s[6];
#pragma unroll
            for (int c = 0; c < 6; ++c) xt[c] = bf2f(xraw[ii][c]);
#pragma unroll
            for (int c = 0; c < 6; ++c) { const float y_ = cw[0][c] * xw[0][c] + cw[1][c] * xw[1][c] + cw[2][c] * xw[2][c] + cw[3][c] * xt[c]; s[c] = y_ * __frcp_rn(1.0f + __expf(-y_)); }
            const float qs = rsqrtf(wave_sum(s[0] * s[0] + s[1] * s[1]) + 1e-6f) * 0.08838834764831845f;
            const float ks = rsqrtf(wave_sum(s[2] * s[2] + s[3] * s[3]) + 1e-6f);
            Qb[i * 136 + lane] = (bf16)f2bf(s[0] * qs); Qb[i * 136 + 64 + lane] = (bf16)f2bf(s[1] * qs);
            Kb[i * 136 + lane] = (bf16)f2bf(s[2] * ks); Kb[i * 136 + 64 + lane] = (bf16)f2bf(s[3] * ks);
            Vb[i * 136 + lane] = (bf16)f2bf(s[4]);      Vb[i * 136 + 64 + lane] = (bf16)f2bf(s[5]);
            if (n == 63 && i >= 61) {
#pragma unroll
                for (int c = 0; c < 6; ++c) p_gdn_conv[((size_t)b * 3 + (i - 61)) * 1536 + cols[c]] = xt[c];
            }
#pragma unroll
            for (int c = 0; c < 6; ++c) { xw[0][c] = xw[1][c]; xw[1][c] = xw[2][c]; xw[2][c] = xt[c]; }
        }
    }
    __syncthreads();
    {
        const int mi = wave >> 1;
        bf16x8_t aK[4], aQ[4];
#pragma unroll
        for (int ks = 0; ks < 4; ++ks) { aK[ks] = *(const bf16x8_t*)(Kb + (mi * 16 + fr) * 136 + ks * 32 + 8 * fq); aQ[ks] = *(const bf16x8_t*)(Qb + (mi * 16 + fr) * 136 + ks * 32 + 8 * fq); }
#pragma unroll
        for (int nn = 0; nn < 2; ++nn) {
            const int nj = (wave & 1) * 2 + nn;
            f32x4 accK = (f32x4){0.f, 0.f, 0.f, 0.f}, accQ = accK;
#pragma unroll
            for (int ks = 0; ks < 4; ++ks) { const bf16x8_t bk = *(const bf16x8_t*)(Kb + (nj * 16 + fr) * 136 + ks * 32 + 8 * fq); accK = mfma16(aK[ks], bk, accK); accQ = mfma16(aQ[ks], bk, accQ); }
            const int j = nj * 16 + fr; const float gj = gcs[j];
#pragma unroll
            for (int r = 0; r < 4; ++r) {
                const int i = mi * 16 + 4 * fq + r;
                const float dec = i >= j ? expf(gcs[i] - gj) : 0.f;
                Ls[j * 68 + i] = i > j ? bets[i] * accK[r] * dec : 0.f;
                QKs[i * 72 + j] = (bf16)f2bf(i >= j ? accQ[r] * dec : 0.f);
            }
        }
    }
    __syncthreads();
    if (wave < 4) {
        float x[64];
        const bool isu = tid < 128; const int c = isu ? tid : tid - 128;
        const LAS unsigned char* l3 = (const LAS unsigned char*)lds;
        unsigned so = (isu ? GP_VB : GP_KB) + c * 2, ro = GP_SC + (isu ? 64 * 4 : 256 * 4), lo = GP_LS;
        asm volatile("" : "+v"(so), "+v"(ro), "+v"(lo));
#pragma unroll
        for (int i = 0; i < 64; ++i) x[i] = *(const LAS float*)(l3 + ro + 4 * i) * bf2f(*(const LAS bf16*)(l3 + so + i * 272));
#pragma unroll
        for (int j = 0; j < 63; ++j) {
#pragma unroll
            for (int i4 = (j + 1) / 4; i4 < 16; ++i4) {
                const f32x4 l4 = *(const LAS f32x4*)(l3 + lo + j * 272 + i4 * 16);
                if (i4 * 4 + 0 > j) x[i4 * 4 + 0] -= l4.x * x[j];
                if (i4 * 4 + 1 > j) x[i4 * 4 + 1] -= l4.y * x[j];
                if (i4 * 4 + 2 > j) x[i4 * 4 + 2] -= l4.z * x[j];
                if (i4 * 4 + 3 > j) x[i4 * 4 + 3] -= l4.w * x[j];
            }
        }
        if (isu) {
            bf16* dst = cb.UT + ((size_t)un * 128 + c) * 64;
#pragma unroll
            for (int i8 = 0; i8 < 8; ++i8) { v4u o; o.x = pk2(x[i8 * 8 + 0], x[i8 * 8 + 1]); o.y = pk2(x[i8 * 8 + 2], x[i8 * 8 + 3]); o.z = pk2(x[i8 * 8 + 4], x[i8 * 8 + 5]); o.w = pk2(x[i8 * 8 + 6], x[i8 * 8 + 7]); *(v4u*)(dst + i8 * 8) = o; }
        } else {
#pragma unroll
            for (int i = 0; i < 64; ++i) Ws[i * 136 + c] = (bf16)f2bf(x[i]);
        }
    } else {
        const int t2 = tid - 256;
#pragma unroll
        for (int k = 0; k < 4; ++k) {
            const int ci = t2 + 256 * k, i = ci >> 4, d0 = (ci & 15) * 8; const float e = egcs[i];
            const v4u q = *(const v4u*)(Qb + i * 136 + d0);
            v4u o; o.x = pk2(bflo(q.x) * e, bfhi(q.x) * e); o.y = pk2(bflo(q.y) * e, bfhi(q.y) * e); o.z = pk2(bflo(q.z) * e, bfhi(q.z) * e); o.w = pk2(bflo(q.w) * e, bfhi(q.w) * e);
            *(v4u*)(cb.QG + ((size_t)un * 64 + i) * 128 + d0) = o;
        }
#pragma unroll
        for (int k = 0; k < 4; ++k) {
            const int ci = t2 + 256 * k, d = ci & 127, i0 = (ci >> 7) * 8;
            float v[8];
#pragma unroll
            for (int q = 0; q < 8; ++q) v[q] = bf2f(Kb[(i0 + q) * 136 + d]) * ekds[i0 + q];
            v4u o; o.x = pk2(v[0], v[1]); o.y = pk2(v[2], v[3]); o.z = pk2(v[4], v[5]); o.w = pk2(v[6], v[7]);
            *(v4u*)(cb.KDT + ((size_t)un * 128 + d) * 64 + i0) = o;
        }
#pragma unroll
        for (int k = 0; k < 2; ++k) {
            const int ci = t2 + 256 * k, i = ci >> 3, j0 = (ci & 7) * 8;
            *(v4u*)(cb.QK + ((size_t)un * 64 + i) * 64 + j0) = *(const v4u*)(QKs + i * 72 + j0);
        }
    }
    __syncthreads();
#pragma unroll
    for (int k = 0; k < 2; ++k) {
        const int ci = tid + 512 * k, i = ci >> 4, d0 = (ci & 15) * 8;
        *(v4u*)(cb.W + ((size_t)un * 64 + i) * 128 + d0) = *(const v4u*)(Ws + i * 136 + d0);
    }
    __syncthreads();
}

constexpr int GS_ST = 0, GS_VNT = 2 * 32 * 136 * 2, GS_END = GS_VNT + 32 * 72 * 2;
template <int N0, int N1>
__device__ __forceinline__ void gdn_seq(const GdnChunkBufs& cb, float* __restrict__ O, float* __restrict__ Sout, int b, int h, int sl, unsigned char* lds, f32x4 (&accS)[2], int& cur) {
    int tid = threadIdx.x; asm volatile("" : "+v"(tid));
    const int lane = tid & 63, wave = __builtin_amdgcn_readfirstlane(tid >> 6), fr = lane & 15, fq = lane >> 4;
    const int mi = wave >> 1, nj = wave & 1;
    bf16* St = (bf16*)(lds + GS_ST); bf16* VnT = (bf16*)(lds + GS_VNT);
    float* egls = (float*)(lds + GS_END);
    if (N0 == 0) {
        for (int i = tid; i < 2 * 32 * 136 / 2; i += NTH) ((unsigned*)St)[i] = 0u;
        accS[0] = (f32x4){0.f, 0.f, 0.f, 0.f}; accS[1] = accS[0]; cur = 0;
    }
    if (tid >= N0 && tid < N1) egls[tid] = cb.EGL[(size_t)((b * 64 + tid) * 4 + h)];
    __syncthreads();
#define GS_DECL(X) bf16x8_t aW##X[4], aQG##X[4], aQK##X[2], aKD##X[2]; v2u ut##X;
    GS_DECL(0) GS_DECL(1) GS_DECL(2)
#define GS_GLD16(dst, ptr) asm volatile("global_load_dwordx4 %0, %1, off" : "=v"(dst) : "v"(ptr))
#define GS_GLD8(dst, ptr) asm volatile("global_load_dwordx2 %0, %1, off" : "=v"(dst) : "v"(ptr))
#define GS_LOAD(X, n_) do { const size_t u_ = (size_t)((b * 64 + ((n_) < 63 ? (n_) : 63)) * 4 + h);     \
        _Pragma("unroll") for (int ks = 0; ks < 4; ++ks) { GS_GLD16(aW##X[ks], cb.W + (u_ * 64 + mi * 16 + fr) * 128 + ks * 32 + 8 * fq); GS_GLD16(aQG##X[ks], cb.QG + (u_ * 64 + mi * 16 + fr) * 128 + ks * 32 + 8 * fq); } \
        _Pragma("unroll") for (int ks = 0; ks < 2; ++ks) { GS_GLD16(aQK##X[ks], cb.QK + (u_ * 64 + mi * 16 + fr) * 64 + ks * 32 + 8 * fq); GS_GLD16(aKD##X[ks], cb.KDT + (u_ * 128 + wave * 16 + fr) * 64 + ks * 32 + 8 * fq); } \
        GS_GLD8(ut##X, cb.UT + (u_ * 128 + sl * 32 + nj * 16 + fr) * 64 + mi * 16 + 4 * fq); } while (0)
#define GS_WAITN(X, N) asm volatile("s_waitcnt vmcnt(" #N ")" : "+v"(aW##X[0]), "+v"(aW##X[1]), "+v"(aW##X[2]), "+v"(aW##X[3]), "+v"(aQG##X[0]), "+v"(aQG##X[1]), "+v"(aQG##X[2]), "+v"(aQG##X[3]), \
        "+v"(aQK##X[0]), "+v"(aQK##X[1]), "+v"(aKD##X[0]), "+v"(aKD##X[1]), "+v"(ut##X))
#define GS_WAIT(X, n_) GS_WAITN(X, 26)
#define GS_STEP(X, n_) do { \
        const float egl##X = egls[(n_)]; \
        GS_WAIT(X, n_); \
        __syncthreads();                                        \
        f32x4 accW = (f32x4){0.f, 0.f, 0.f, 0.f}, accO = accW; \
        const bf16* Sc = St + cur * 32 * 136; \
        _Pragma("unroll") for (int ks = 0; ks < 4; ++ks) { const bf16x8_t bs = *(const bf16x8_t*)(Sc + (nj * 16 + fr) * 136 + ks * 32 + 8 * fq); accW = mfma16(aW##X[ks], bs, accW); accO = mfma16(aQG##X[ks], bs, accO); } \
          \
        const float v0 = bflo(ut##X.x) - accW[0], v1 = bfhi(ut##X.x) - accW[1], v2 = bflo(ut##X.y) - accW[2], v3 = bfhi(ut##X.y) - accW[3]; \
        { v2u o; o.x = pk2(v0, v1); o.y = pk2(v2, v3); *(v2u*)(VnT + (nj * 16 + fr) * 72 + mi * 16 + 4 * fq) = o; } \
        __syncthreads();                                        \
        _Pragma("unroll") for (int ks = 0; ks < 2; ++ks) { const bf16x8_t bv = *(const bf16x8_t*)(VnT + (nj * 16 + fr) * 72 + ks * 32 + 8 * fq); accO = mfma16(aQK##X[ks], bv, accO); } \
        { float* orow = O + (size_t)(b * SEQ + (n_) * 64 + mi * 16 + 4 * fq) * 512 + h * 128 + sl * 32 + nj * 16 + fr; \
          orow[0] = accO[0]; orow[512] = accO[1]; orow[1024] = accO[2]; orow[1536] = accO[3]; } \
          \
        bf16* Sn = St + (cur ^ 1) * 32 * 136; \
        _Pragma("unroll") for (int njj = 0; njj < 2; ++njj) { \
            accS[njj] = accS[njj] * egl##X; \
            _Pragma("unroll") for (int ks = 0; ks < 2; ++ks) { const bf16x8_t bv = *(const bf16x8_t*)(VnT + (njj * 16 + fr) * 72 + ks * 32 + 8 * fq); accS[njj] = mfma16(aKD##X[ks], bv, accS[njj]); } \
            v2u o; o.x = pk2(accS[njj][0], accS[njj][1]); o.y = pk2(accS[njj][2], accS[njj][3]); \
            *(v2u*)(Sn + (njj * 16 + fr) * 136 + wave * 16 + 4 * fq) = o; } \
        cur ^= 1; } while (0)
    constexpr int NTRI = (N1 - N0) / 3, NREM = (N1 - N0) % 3, NM = N0 + 3 * NTRI;
    GS_LOAD(0, N0); GS_LOAD(1, N0 + 1);
#pragma unroll 1
    for (int n = N0; n < NM; n += 3) {
        GS_LOAD(2, n + 2);
        GS_STEP(0, n);
        GS_LOAD(0, n + 3);
        GS_STEP(1, n + 1);
        GS_LOAD(1, n + 4);
        GS_STEP(2, n + 2);
    }
    if (NREM >= 1) { GS_LOAD(2, NM + 2); GS_STEP(0, NM); }
    if (NREM == 2) { GS_LOAD(0, NM + 3); GS_STEP(1, NM + 1); }
    GS_WAITN(0, 0); GS_WAITN(1, 0); GS_WAITN(2, 0);
#undef GS_STEP
#undef GS_DECL
#undef GS_WAIT
#undef GS_WAITN
#undef GS_GLD16
#undef GS_GLD8
    asm volatile("s_waitcnt vmcnt(0)" ::: "memory");
#undef GS_LOAD
    if (N1 == 64) {
#pragma unroll
        for (int njj = 0; njj < 2; ++njj)
#pragma unroll
            for (int r = 0; r < 4; ++r) Sout[(((size_t)b * 4 + h) * 128 + wave * 16 + 4 * fq + r) * 128 + sl * 32 + njj * 16 + fr] = accS[njj][r];
    }
    __syncthreads();
}

__device__ __forceinline__ void lru_prep_unit(const bf16* __restrict__ PROJ, const float* __restrict__ conv_w, const float* __restrict__ conv_b,
                                              const float* __restrict__ w_r, const float* __restrict__ b_r, const float* __restrict__ w_i, const float* __restrict__ b_i, const float* __restrict__ lam,
                                              float* __restrict__ H, float* __restrict__ P, float* __restrict__ Hend, float* __restrict__ Pend, float* __restrict__ p_lru_conv, int ub) {
    int c = threadIdx.x; asm volatile("" : "+v"(c));
    const int nblk = c >> 6, d = c & 63;
    const int n = ub & 63, b = ub >> 6, t0 = b * SEQ + n * 64;
    float wr[64], wi[64];
#pragma unroll
    for (int cc = 0; cc < 64; ++cc) { wr[cc] = w_r[((size_t)nblk * 64 + cc) * 64 + d]; wi[cc] = w_i[((size_t)nblk * 64 + cc) * 64 + d]; }
    const float cw0 = conv_w[c], cw1 = conv_w[512 + c], cw2 = conv_w[1024 + c], cw3 = conv_w[1536 + c], cb_ = conv_b[c];
    const float br = b_r[c], bi = b_i[c], spl = -8.0f * softplusf_(-lam[c]);
    float x0 = (n * 64 - 3 >= 0) ? bf2f(PROJ[(size_t)(t0 - 3) * ABN + C_XR + c]) : 0.f;
    float x1 = (n * 64 - 2 >= 0) ? bf2f(PROJ[(size_t)(t0 - 2) * ABN + C_XR + c]) : 0.f;
    float x2 = (n * 64 - 1 >= 0) ? bf2f(PROJ[(size_t)(t0 - 1) * ABN + C_XR + c]) : 0.f;
    float hloc = 0.f, ploc = 1.f;
    bf16 xa[16], xb[16];
#pragma unroll
    for (int k = 0; k < 16; ++k) xa[k] = PROJ[(size_t)(t0 + k) * ABN + C_XR + c];
#pragma unroll 1
    for (int ib = 0; ib < 64; ib += 16) {
      if (ib + 16 < 64) {
#pragma unroll
        for (int k = 0; k < 16; ++k) xb[k] = PROJ[(size_t)(t0 + ib + 16 + k) * ABN + C_XR + c];
      }
#pragma unroll
      for (int k = 0; k < 16; ++k) {
        const int i = ib + k;
        const float xt = bf2f(xa[k]);
        const float xr = cb_ + cw0 * x0 + cw1 * x1 + cw2 * x2 + cw3 * xt;
        f32x2_t ga = (f32x2_t){br, bi}, gb = (f32x2_t){0.f, 0.f};
#pragma unroll
        for (int cc = 0; cc < 64; cc += 2) {
            const float xa_ = __uint_as_float(__builtin_amdgcn_readlane(__float_as_uint(xr), cc)), xb_ = __uint_as_float(__builtin_amdgcn_readlane(__float_as_uint(xr), cc + 1));
            ga += (f32x2_t){xa_, xa_} * (f32x2_t){wr[cc], wi[cc]}; gb += (f32x2_t){xb_, xb_} * (f32x2_t){wr[cc + 1], wi[cc + 1]};
        }
        ga += gb;
        const float r = __frcp_rn(1.0f + __expf(-ga.x)), ii = __frcp_rn(1.0f + __expf(-ga.y));
        const float a = __expf(spl * r), bb = __fsqrt_rn(fmaxf(1.0f - a * a, 0.f)) * (ii * xr);
        hloc = a * hloc + bb; ploc *= a;
        H[(size_t)(t0 + i) * 512 + c] = hloc; P[(size_t)(t0 + i) * 512 + c] = ploc;
        if (n == 63 && i >= 61) p_lru_conv[((size_t)b * 3 + (i - 61)) * 512 + c] = xt;
        x0 = x1; x1 = x2; x2 = xt;
      }
#pragma unroll
      for (int k = 0; k < 16; ++k) xa[k] = xb[k];
    }
    Hend[(size_t)ub * 512 + c] = hloc; Pend[(size_t)ub * 512 + c] = ploc;
}
constexpr int LR_XR = 64 * 68 * 4;
__device__ __forceinline__ void lru_prep_unit2(const bf16* __restrict__ PROJ, const float* __restrict__ conv_w, const float* __restrict__ conv_b,
                                               const bf16* __restrict__ WRT, const bf16* __restrict__ WIT  , const float* __restrict__ b_r, const float* __restrict__ b_i, const float* __restrict__ lam,
                                               float* __restrict__ H, float* __restrict__ P, float* __restrict__ Hend, float* __restrict__ Pend, float* __restrict__ p_lru_conv, int ub, unsigned char* lds) {
    int tid = threadIdx.x; asm volatile("" : "+v"(tid));
    const int lane = tid & 63, wave = __builtin_amdgcn_readfirstlane(tid >> 6), fr = lane & 15, fq = lane >> 4;
    const int n = ub & 63, b = ub >> 6, t0 = b * SEQ + n * 64;
    float* XR = (float*)(lds + wave * LR_XR);
    {
        const int c = wave * 64 + lane;
        const float cw0 = conv_w[c], cw1 = conv_w[512 + c], cw2 = conv_w[1024 + c], cw3 = conv_w[1536 + c], cb_ = conv_b[c];
        float x0 = (n * 64 - 3 >= 0) ? bf2f(PROJ[(size_t)(t0 - 3) * ABN + C_XR + c]) : 0.f;
        float x1 = (n * 64 - 2 >= 0) ? bf2f(PROJ[(size_t)(t0 - 2) * ABN + C_XR + c]) : 0.f;
        float x2 = (n * 64 - 1 >= 0) ? bf2f(PROJ[(size_t)(t0 - 1) * ABN + C_XR + c]) : 0.f;
#pragma unroll 1
        for (int ib = 0; ib < 64; ib += 16) {
            bf16 xa[16];
#pragma unroll
            for (int k = 0; k < 16; ++k) xa[k] = PROJ[(size_t)(t0 + ib + k) * ABN + C_XR + c];
#pragma unroll
            for (int k = 0; k < 16; ++k) {
                const int i = ib + k; const float xt = bf2f(xa[k]);
                XR[i * 68 + lane] = cb_ + cw0 * x0 + cw1 * x1 + cw2 * x2 + cw3 * xt;
                if (n == 63 && i >= 61) p_lru_conv[((size_t)b * 3 + (i - 61)) * 512 + c] = xt;
                x0 = x1; x1 = x2; x2 = xt;
            }
        }
    }
    asm volatile("s_waitcnt lgkmcnt(0)" ::: "memory");
    bf16x8_t bR[4][2], bI[4][2];
#pragma unroll
    for (int nt = 0; nt < 4; ++nt)
#pragma unroll
        for (int ks = 0; ks < 2; ++ks) {
            bR[nt][ks] = *(const bf16x8_t*)(WRT + ((size_t)wave * 64 + nt * 16 + fr) * 64 + ks * 32 + 8 * fq);
            bI[nt][ks] = *(const bf16x8_t*)(WIT + ((size_t)wave * 64 + nt * 16 + fr) * 64 + ks * 32 + 8 * fq);
        }
    float brv[4], biv[4], splv[4];
#pragma unroll
    for (int nt = 0; nt < 4; ++nt) { const int c = wave * 64 + nt * 16 + fr; brv[nt] = b_r[c]; biv[nt] = b_i[c]; splv[nt] = -8.0f * softplusf_(-lam[c]); }
    float hin[4], pin[4];
#pragma unroll
    for (int nt = 0; nt < 4; ++nt) { hin[nt] = 0.f; pin[nt] = 1.f; }
#pragma unroll 1
    for (int mt = 0; mt < 4; ++mt) {
        bf16x8_t aX[2];
#pragma unroll
        for (int ks = 0; ks < 2; ++ks) {
            const f32x4 lo = *(const f32x4*)(XR + (mt * 16 + fr) * 68 + ks * 32 + 8 * fq), hi = *(const f32x4*)(XR + (mt * 16 + fr) * 68 + ks * 32 + 8 * fq + 4);
            v4u w; w.x = pk2(lo.x, lo.y); w.y = pk2(lo.z, lo.w); w.z = pk2(hi.x, hi.y); w.w = pk2(hi.z, hi.w);
            aX[ks] = __builtin_bit_cast(bf16x8_t, w);
        }
#pragma unroll
        for (int nt = 0; nt < 4; ++nt) {
            f32x4 aR = (f32x4){0.f, 0.f, 0.f, 0.f}, aI = aR;
            aR = mfma16(aX[0], bR[nt][0], aR); aR = mfma16(aX[1], bR[nt][1], aR);
            aI = mfma16(aX[0], bI[nt][0], aI); aI = mfma16(aX[1], bI[nt][1], aI);
            float av[4], bv[4];
#pragma unroll
            for (int r = 0; r < 4; ++r) {
                const float rg = __frcp_rn(1.0f + __expf(-(aR[r] + brv[nt]))), ig = __frcp_rn(1.0f + __expf(-(aI[r] + biv[nt])));
                const float a = __expf(splv[nt] * rg);
                av[r] = a; bv[r] = __fsqrt_rn(fmaxf(1.0f - a * a, 0.f)) * (ig * XR[(mt * 16 + 4 * fq + r) * 68 + nt * 16 + fr]);
            }
            float PA[4], PB[4];
            PA[0] = av[0]; PB[0] = bv[0];
#pragma unroll
            for (int r = 1; r < 4; ++r) { PA[r] = av[r] * PA[r - 1]; PB[r] = av[r] * PB[r - 1] + bv[r]; }
            float GA = PA[3], GB = PB[3];
            { const float pa = __shfl_up(GA, 16), pb = __shfl_up(GB, 16); if (fq >= 1) { GB = GA * pb + GB; GA = GA * pa; } }
            { const float pa = __shfl_up(GA, 32), pb = __shfl_up(GB, 32); if (fq >= 2) { GB = GA * pb + GB; GA = GA * pa; } }
            float EA = __shfl_up(GA, 16), EB = __shfl_up(GB, 16);
            if (fq == 0) { EA = 1.f; EB = 0.f; }
            const float h0 = EA * hin[nt] + EB, p0 = pin[nt] * EA;
#pragma unroll
            for (int r = 0; r < 4; ++r) {
                const size_t o = (size_t)(t0 + mt * 16 + 4 * fq + r) * 512 + wave * 64 + nt * 16 + fr;
                H[o] = PA[r] * h0 + PB[r]; P[o] = p0 * PA[r];
            }
            const float TA = __shfl(GA, 48 + fr), TB = __shfl(GB, 48 + fr);
            hin[nt] = TA * hin[nt] + TB; pin[nt] = pin[nt] * TA;
        }
    }
    if (fq == 0) {
#pragma unroll
        for (int nt = 0; nt < 4; ++nt) { Hend[(size_t)ub * 512 + wave * 64 + nt * 16 + fr] = hin[nt]; Pend[(size_t)ub * 512 + wave * 64 + nt * 16 + fr] = pin[nt]; }
    }
    asm volatile("s_waitcnt lgkmcnt(0)" ::: "memory");
}
__device__ __forceinline__ void lru_carry(const float* __restrict__ Hend, const float* __restrict__ Pend, float* __restrict__ CIN, float* __restrict__ hlast, int bx) {
    int tx_ = threadIdx.x; asm volatile("" : "+v"(tx_));
    const int idx = bx * NTH + tx_, b = idx >> 9, c = idx & 511;
    float carry = 0.f;
#pragma unroll 8
    for (int n = 0; n < 64; ++n) {
        const size_t o = ((size_t)b * 64 + n) * 512 + c;
        CIN[o] = carry;
        carry = Hend[o] + Pend[o] * carry;
    }
    hlast[(size_t)b * 512 + c] = carry;
}

__device__ __forceinline__ unsigned f2key(float f) { const unsigned u = __float_as_uint(f); return u ^ ((u >> 31) ? 0xffffffffu : 0x80000000u); }
__device__ __forceinline__ float key2f(unsigned k) { return __uint_as_float(k ^ ((k >> 31) ? 0x80000000u : 0xffffffffu)); }
#define TK_CE(hi, lo) do { const unsigned a_ = (hi), b_ = (lo); (hi) = a_ > b_ ? a_ : b_; (lo) = a_ > b_ ? b_ : a_; } while (0)
template <int N> __device__ __forceinline__ void bitonic_sort_desc(unsigned (&a)[N]) {
#pragma unroll
    for (int k = 2; k <= N; k <<= 1)
#pragma unroll
        for (int j = k >> 1; j > 0; j >>= 1)
#pragma unroll
            for (int i = 0; i < N; ++i) { const int l = i ^ j; if (l > i) { if ((i & k) == 0) TK_CE(a[i], a[l]); else TK_CE(a[l], a[i]); } }
}
template <int XM> __device__ __forceinline__ void merge_top16(unsigned (&a)[16]) {
    unsigned c[16];
#pragma unroll
    for (int i = 0; i < 16; ++i) { const unsigned o = (unsigned)__shfl_xor((int)a[15 - i], XM); c[i] = a[i] > o ? a[i] : o; }
#pragma unroll
    for (int j = 8; j > 0; j >>= 1)
#pragma unroll
        for (int i = 0; i < 16; ++i) { const int l = i ^ j; if (l > i) TK_CE(c[i], c[l]); }
#pragma unroll
    for (int i = 0; i < 16; ++i) a[i] = c[i];
}
constexpr int TK_KS = 0, TK_TS = 2 * 128 * 136 * 2, TK_END = TK_TS + 64 * 2 * 16 * 4;
__device__ __forceinline__ void peer_topk_stage_keys(const bf16* __restrict__ KB, int h, unsigned char* lds) {
    bf16* Ks = (bf16*)(lds + TK_KS);
    for (int ci = threadIdx.x; ci < 2 * 128 * 16; ci += NTH) { const int row = ci >> 4, part = ci & 15;
        *(v4u*)(Ks + row * 136 + part * 8) = *(const v4u*)(KB + ((size_t)h * 256 + row) * 128 + part * 8); }
    __syncthreads();
}
__device__ __forceinline__ void peer_topk_ldq(bf16x8_t (&bq)[4], const bf16* __restrict__ Q, int tile, int h, int tid) {
    const int lane = tid & 63, wave = tid >> 6, fr = lane & 15, fq = lane >> 4, c = wave >> 2, nt = wave & 3;
#pragma unroll
    for (int ks = 0; ks < 4; ++ks) bq[ks] = *(const bf16x8_t*)(Q + (size_t)(tile * 64 + nt * 16 + fr) * 2048 + h * 256 + c * 128 + ks * 32 + 8 * fq);
}
__device__ __forceinline__ void peer_topk4(const bf16* __restrict__ Q, int* __restrict__ EXP, float* __restrict__ GATE, int tile, int h, unsigned char* lds, bf16x8_t (&bq)[4], int tile_next) {
    int tid = threadIdx.x; asm volatile("" : "+v"(tid));
    const int lane = tid & 63, wave = __builtin_amdgcn_readfirstlane(tid >> 6), fr = lane & 15, fq = lane >> 4;
    const bf16* Ks = (const bf16*)(lds + TK_KS); unsigned* Ts = (unsigned*)(lds + TK_TS);
    {
        const int c = wave >> 2, nt = wave & 3;
        unsigned a[32];
#pragma unroll
        for (int mt = 0; mt < 8; ++mt) {
            f32x4 acc = (f32x4){0.f, 0.f, 0.f, 0.f};
#pragma unroll
            for (int ks = 0; ks < 4; ++ks) { const bf16x8_t ak = *(const bf16x8_t*)(Ks + (c * 128 + mt * 16 + fr) * 136 + ks * 32 + 8 * fq); acc = mfma16(ak, bq[ks], acc); }
#pragma unroll
            for (int r = 0; r < 4; ++r) a[mt * 4 + r] = (f2key(acc[r]) & ~127u) | (unsigned)(127 - (mt * 16 + 4 * fq + r));
        }
        if (tile_next >= 0) peer_topk_ldq(bq, Q, tile_next, h, tid);
        bitonic_sort_desc<32>(a);
        unsigned t[16];
#pragma unroll
        for (int j = 0; j < 16; ++j) t[j] = a[j];
        merge_top16<16>(t); merge_top16<32>(t);
        if (fq == 0) {
            const int tk = nt * 16 + fr;
#pragma unroll
            for (int j = 0; j < 16; ++j) Ts[(tk * 2 + c) * 16 + j] = t[j];
        }
    }
    __syncthreads();
    if (tid < 256) {
        const int tk = tid >> 2, q = tid & 3;
        const unsigned* t0 = Ts + (tk * 2 + 0) * 16; const unsigned* t1 = Ts + (tk * 2 + 1) * 16;
        unsigned a[16];
#pragma unroll
        for (int s = 0; s < 13; ++s) {
            const int e = s * 4 + q;
            int i, j;
            if (e < 16) { i = 0; j = e; } else if (e < 24) { i = 1; j = e - 16; } else if (e < 29) { i = 2; j = e - 24; } else if (e < 33) { i = 3; j = e - 29; }
            else if (e < 36) { i = 4; j = e - 33; } else if (e < 42) { i = 5 + ((e - 36) >> 1); j = (e - 36) & 1; } else { i = 8 + (e - 42); j = 0; }
            const bool ok = e < 50;
            const float sum = key2f(t0[ok ? i : 0] & ~127u) + key2f(t1[ok ? j : 0] & ~127u);
            a[s] = ok ? ((f2key(sum) & ~255u) | (unsigned)(255 - (i * 16 + j))) : 0u;
        }
        a[13] = 0u; a[14] = 0u; a[15] = 0u;
        bitonic_sort_desc<16>(a);
        merge_top16<1>(a); merge_top16<2>(a);
        float ev[16], sum = 0.f; const float m = key2f(a[0] & ~255u);
#pragma unroll
        for (int j = 0; j < 16; ++j) { ev[j] = __expf(key2f(a[j] & ~255u) - m); sum += ev[j]; }
        const float inv = 1.0f / sum;
        const size_t o = (size_t)(tile * 64 + tk) * 128 + h * 16;
#pragma unroll
        for (int j = 0; j < 16; ++j)
            if ((j >> 2) == q) {
                const int code = 255 - (int)(a[j] & 255u), i = code >> 4, jj = code & 15;
                const int n0 = 127 - (int)(t0[i] & 127u), n1 = 127 - (int)(t1[jj] & 127u);
                EXP[o + j] = n0 * 128 + n1; GATE[o + j] = ev[j] * inv;
            }
    }
    __syncthreads();
}

constexpr int AT_KS = 0, AT_VT = 192 * 72 * 2, AT_BT = AT_VT + 64 * 200 * 2, AT_PW = AT_BT + 4 * 128 * 4, AT_END = AT_PW + 8 * 32 * 72 * 2;
__device__ __forceinline__ void attn_unit(const bf16* __restrict__ PCb, const float* __restrict__ rel_bias, const float* __restrict__ sinks, bf16* __restrict__ ATT, int un, unsigned char* lds) {
    int tid = threadIdx.x; asm volatile("" : "+v"(tid));
    const int lane = tid & 63, wave = __builtin_amdgcn_readfirstlane(tid >> 6), fr = lane & 15, fq = lane >> 4;
    const int kvh = un & 3, qblk = (un >> 2) & 63, b = un >> 8;
    const int q0 = qblk * 64, tb = b * SEQ;
    bf16* Ks = (bf16*)(lds + AT_KS); bf16* Vt = (bf16*)(lds + AT_VT); float* Bt = (float*)(lds + AT_BT); bf16* Pw = (bf16*)(lds + AT_PW) + wave * 32 * 72;
#pragma unroll
    for (int k = 0; k < 3; ++k) {
        const int ci = tid + 512 * k, row = ci >> 3, part = ci & 7, kpos = q0 - 128 + row;
        v4u kv = (v4u){0u, 0u, 0u, 0u}, vv = kv;
        if (kpos >= 0) { const bf16* src = PCb + (size_t)(tb + kpos) * CN + kvh * 64 + part * 8; kv = *(const v4u*)(src + 1024); vv = *(const v4u*)(src + 1280); }
        *(v4u*)(Ks + row * 72 + part * 8) = kv;
        bf16* vd = Vt + (part * 8) * 200 + row;
        vd[0 * 200] = (bf16)(vv.x & 0xffffu); vd[1 * 200] = (bf16)(vv.x >> 16); vd[2 * 200] = (bf16)(vv.y & 0xffffu); vd[3 * 200] = (bf16)(vv.y >> 16);
        vd[4 * 200] = (bf16)(vv.z & 0xffffu); vd[5 * 200] = (bf16)(vv.z >> 16); vd[6 * 200] = (bf16)(vv.w & 0xffffu); vd[7 * 200] = (bf16)(vv.w >> 16);
    }
    Bt[tid] = rel_bias[t5_bucket(tid & 127) * 16 + kvh * 4 + (tid >> 7)];
    __syncthreads();
    const int g = wave >> 1, qs = (wave & 1) * 32, hh = kvh * 4 + g;
    bf16x8_t aQ[2][2];
#pragma unroll
    for (int mt = 0; mt < 2; ++mt)
#pragma unroll
        for (int ks = 0; ks < 2; ++ks) aQ[mt][ks] = *(const bf16x8_t*)(PCb + (size_t)(tb + q0 + qs + mt * 16 + fr) * CN + hh * 64 + ks * 32 + 8 * fq);
    f32x4 sc[2][12];
#pragma unroll
    for (int nt = 0; nt < 12; ++nt) {
        const bf16x8_t b0 = *(const bf16x8_t*)(Ks + (nt * 16 + fr) * 72 + 8 * fq), b1 = *(const bf16x8_t*)(Ks + (nt * 16 + fr) * 72 + 32 + 8 * fq);
#pragma unroll
        for (int mt = 0; mt < 2; ++mt) { f32x4 a = (f32x4){0.f, 0.f, 0.f, 0.f}; a = mfma16(aQ[mt][0], b0, a); a = mfma16(aQ[mt][1], b1, a); sc[mt][nt] = a; }
    }
    const float sink = sinks[hh];
    const float* bt = Bt + g * 128;
#pragma unroll
    for (int mt = 0; mt < 2; ++mt)
#pragma unroll
        for (int r = 0; r < 4; ++r) {
            const int qi = qs + mt * 16 + 4 * fq + r;
            float mx = sink;
#pragma unroll
            for (int nt = 0; nt < 12; ++nt) {
                const int kk = nt * 16 + fr, rel = qi + 128 - kk;
                const bool valid = rel >= 0 && rel < 128 && (q0 - 128 + kk) >= 0;
                const float lg = valid ? sc[mt][nt][r] * 0.125f + bt[valid ? rel : 0] : -INFINITY;
                sc[mt][nt][r] = lg; mx = fmaxf(mx, lg);
            }
            mx = fmaxf(mx, __shfl_xor(mx, 1)); mx = fmaxf(mx, __shfl_xor(mx, 2)); mx = fmaxf(mx, __shfl_xor(mx, 4)); mx = fmaxf(mx, __shfl_xor(mx, 8));
            float sum = 0.f;
#pragma unroll
            for (int nt = 0; nt < 12; ++nt) { const float p = __expf(sc[mt][nt][r] - mx); sc[mt][nt][r] = p; sum += p; }
            sum += __shfl_xor(sum, 1); sum += __shfl_xor(sum, 2); sum += __shfl_xor(sum, 4); sum += __shfl_xor(sum, 8);
            const float inv = 1.0f / (sum + __expf(sink - mx));
#pragma unroll
            for (int nt = 0; nt < 12; ++nt) sc[mt][nt][r] *= inv;
        }
    f32x4 oacc[2][4];
#pragma unroll
    for (int mt = 0; mt < 2; ++mt)
#pragma unroll
        for (int dt = 0; dt < 4; ++dt) oacc[mt][dt] = (f32x4){0.f, 0.f, 0.f, 0.f};
#pragma unroll
    for (int kc = 0; kc < 3; ++kc) {
#pragma unroll
        for (int mt = 0; mt < 2; ++mt)
#pragma unroll
            for (int n4 = 0; n4 < 4; ++n4)
#pragma unroll
                for (int r = 0; r < 4; ++r) Pw[(mt * 16 + 4 * fq + r) * 72 + n4 * 16 + fr] = (bf16)f2bf(sc[mt][kc * 4 + n4][r]);
        asm volatile("s_waitcnt lgkmcnt(0)" ::: "memory");
#pragma unroll
        for (int ks = 0; ks < 2; ++ks) {
            const bf16x8_t p0 = *(const bf16x8_t*)(Pw + fr * 72 + ks * 32 + 8 * fq), p1 = *(const bf16x8_t*)(Pw + (16 + fr) * 72 + ks * 32 + 8 * fq);
#pragma unroll
            for (int dt = 0; dt < 4; ++dt) {
                const bf16x8_t bv = *(const bf16x8_t*)(Vt + (dt * 16 + fr) * 200 + kc * 64 + ks * 32 + 8 * fq);
                oacc[0][dt] = mfma16(p0, bv, oacc[0][dt]); oacc[1][dt] = mfma16(p1, bv, oacc[1][dt]);
            }
        }
        asm volatile("s_waitcnt lgkmcnt(0)" ::: "memory");
    }
#pragma unroll
    for (int mt = 0; mt < 2; ++mt)
#pragma unroll
        for (int dt = 0; dt < 4; ++dt)
#pragma unroll
            for (int r = 0; r < 4; ++r) Pw[(mt * 16 + 4 * fq + r) * 72 + dt * 16 + fr] = (bf16)f2bf(oacc[mt][dt][r]);
    asm volatile("s_waitcnt lgkmcnt(0)" ::: "memory");
#pragma unroll
    for (int k = 0; k < 4; ++k) {
        const int ci = lane + 64 * k, row = ci >> 3, part = ci & 7;
        *(v4u*)(ATT + (size_t)(tb + q0 + qs + row) * D + hh * 64 + part * 8) = *(const v4u*)(Pw + row * 72 + part * 8);
    }
    __syncthreads();
}

__device__ __forceinline__ void swa_attn_sample(const bf16* __restrict__ PCb, const float* __restrict__ cache_k, const float* __restrict__ cache_v,
                                                const float* __restrict__ rel_bias, const float* __restrict__ sinks, bf16* __restrict__ ATT, int gw, int lane) {
    const int sb = gw >> 4, h = gw & 15, kvh = h >> 2, t = NP + sb;
    const bf16* qrow = PCb + (size_t)t * CN + h * 64;
    float lg[2];
#pragma unroll
    for (int rr = 0; rr < 2; ++rr) {
        const int r = lane + 64 * rr;
        float dot = 0.f;
        if (r == 0) {
            const bf16* krow = PCb + (size_t)t * CN + 1024 + kvh * 64;
            for (int d = 0; d < 64; ++d) dot += bf2f(qrow[d]) * bf2f(krow[d]);
        } else {
            const float* krow = cache_k + (((size_t)sb * 128 + (128 - r)) * 4 + kvh) * 64;
#pragma unroll
            for (int d4 = 0; d4 < 16; ++d4) { const float4 kv = *(const float4*)(krow + d4 * 4);
                dot += bf2f(qrow[d4 * 4]) * kv.x + bf2f(qrow[d4 * 4 + 1]) * kv.y + bf2f(qrow[d4 * 4 + 2]) * kv.z + bf2f(qrow[d4 * 4 + 3]) * kv.w; }
        }
        lg[rr] = dot * 0.125f + rel_bias[t5_bucket(r) * 16 + h];
    }
    const float sink = sinks[h];
    const float m = fmaxf(wave_max(fmaxf(lg[0], lg[1])), sink);
    float p[2] = {expf(lg[0] - m), expf(lg[1] - m)};
    const float inv = 1.0f / (wave_sum(p[0] + p[1]) + expf(sink - m));
    float o = 0.f;
#pragma unroll
    for (int rr = 0; rr < 2; ++rr)
#pragma unroll 1
        for (int lb = 0; lb < 64; lb += 16) {
            float vv[16];
#pragma unroll
            for (int k = 0; k < 16; ++k) { const int r = lb + k + 64 * rr;
                vv[k] = (r == 0) ? bf2f(PCb[(size_t)t * CN + 1280 + kvh * 64 + lane]) : cache_v[(((size_t)sb * 128 + (128 - r)) * 4 + kvh) * 64 + lane]; }
#pragma unroll
            for (int k = 0; k < 16; ++k) o += __shfl(p[rr], lb + k) * vv[k];
        }
    ATT[(size_t)t * D + h * 64 + lane] = (bf16)f2bf(o * inv);
}
__device__ __forceinline__ void swa_kv_out3(const bf16* __restrict__ PCb, const float* __restrict__ cache_k, const float* __restrict__ cache_v,
                                            float* __restrict__ pk, float* __restrict__ pv, float* __restrict__ sk, float* __restrict__ sv, int item) {
    int tid = threadIdx.x; asm volatile("" : "+v"(tid));
    if (item < 256) {
        const int sb = item >> 1, isv = item & 1;
        const f32x4* src = (const f32x4*)((isv ? cache_v : cache_k) + ((size_t)sb * 128 + 1) * 256);
        f32x4* dst = (f32x4*)((isv ? sv : sk) + (size_t)sb * 128 * 256);
#pragma unroll 4
        for (int i = tid; i < 127 * 64; i += NTH) dst[i] = src[i];
        if (tid < 32) {
            const v4u w = *(const v4u*)(PCb + (size_t)(NP + sb) * CN + 1024 + isv * 256 + tid * 8);
            f32x4* d = dst + 127 * 64 + tid * 2;
            d[0] = (f32x4){bflo(w.x), bfhi(w.x), bflo(w.y), bfhi(w.y)}; d[1] = (f32x4){bflo(w.z), bfhi(w.z), bflo(w.w), bfhi(w.w)};
        }
    } else {
        const int b = item - 256;
#pragma unroll 4
        for (int e = tid; e < 128 * 64; e += NTH) {
            const int row = e >> 6, part = e & 63;
            const v4u w = *(const v4u*)(PCb + (size_t)(b * SEQ + SEQ - 128 + row) * CN + 1024 + part * 8);
            f32x4* d = (f32x4*)((part < 32 ? pk : pv) + ((size_t)b * 128 + row) * 256 + (part & 31) * 8);
            d[0] = (f32x4){bflo(w.x), bfhi(w.x), bflo(w.y), bfhi(w.y)}; d[1] = (f32x4){bflo(w.z), bfhi(w.z), bflo(w.w), bfhi(w.w)};
        }
    }
}


__device__ __forceinline__ void sample_gemm_piece(const bf16* __restrict__ A, const bf16* __restrict__ Bt, const float* __restrict__ bias, bf16* __restrict__ O, int ldc, int p, unsigned char* lds) {
    int tid = threadIdx.x; asm volatile("" : "+v"(tid));
    const int lane = tid & 63, wave = __builtin_amdgcn_readfirstlane(tid >> 6), fr = lane & 15, fq = lane >> 4;
    const int mt = p & 7, cb = p >> 3, nt = wave & 3, kh = wave >> 2;
    const bf16* ap = A + (size_t)(NP + mt * 16 + fr) * D + kh * 512 + 8 * fq;
    const bf16* bp = Bt + (size_t)(cb * 64 + nt * 16 + fr) * D + kh * 512 + 8 * fq;
    bf16x8_t a[16], b[16];
#pragma unroll
    for (int ks = 0; ks < 16; ++ks) { a[ks] = *(const bf16x8_t*)(ap + ks * 32); b[ks] = *(const bf16x8_t*)(bp + ks * 32); }
    f32x4 acc = (f32x4){0.f, 0.f, 0.f, 0.f};
#pragma unroll
    for (int ks = 0; ks < 16; ++ks) acc = mfma16(a[ks], b[ks], acc);
    f32x4* part = (f32x4*)lds;
    if (kh == 1) part[nt * 64 + lane] = acc;
    __syncthreads();
    if (kh == 0) {
        acc = acc + part[nt * 64 + lane];
        const int col = cb * 64 + nt * 16 + fr; const float bv = bias ? bias[col] : 0.f;
#pragma unroll
        for (int r = 0; r < 4; ++r) O[(size_t)(NP + mt * 16 + 4 * fq + r) * ldc + col] = (bf16)f2bf(acc[r] + bv);
    }
    __syncthreads();
}

constexpr size_t MiB = 1u << 20;
constexpr size_t WS_CTL = 0, CTL_ZERO_BYTES = 64 * 1024;
constexpr size_t WS_WAB = 1 * MiB;
constexpr size_t WS_WOUT = WS_WAB + (size_t)ABNP * D * 2;
constexpr size_t WS_WQ0 = WS_WOUT + (size_t)D * D * 2;
constexpr size_t WS_WQ1 = WS_WQ0 + (size_t)2048 * D * 2;
constexpr size_t WS_WINC = WS_WQ1 + (size_t)2048 * D * 2;
constexpr size_t WS_WOUTC = WS_WINC + (size_t)CN * D * 2;
constexpr size_t WS_ABUF = WS_WOUTC + (size_t)D * D * 2;
constexpr size_t WS_P = WS_ABUF + (size_t)MP * D * 2;
constexpr size_t WS_T = WS_P + (size_t)MP * ABN * 2;
constexpr size_t WS_Q = WS_T + (size_t)4 * 16384 * D + (size_t)4 * 16384 * 4;
constexpr size_t WS_A = WS_Q + (size_t)MP * 1536 * 4;
constexpr size_t WS_B = WS_A + (size_t)MP * 512 * 4;
constexpr size_t WS_O = WS_B + (size_t)MP * 512 * 4;
constexpr size_t WS_X1 = WS_O + (size_t)MP * 512 * 4;
constexpr size_t WS_G = WS_X1 + (size_t)MP * D * 4;
constexpr size_t WS_BETA = WS_G + (size_t)MP * 4 * 4;
constexpr size_t WS_GATE = WS_BETA + (size_t)MP * 4 * 4;
constexpr size_t WS_EXP = WS_GATE + (size_t)MP * 128 * 4;
constexpr size_t WS_HEND = WS_EXP + (size_t)MP * 128 * 4;
constexpr size_t WS_KEYS = WS_HEND + (size_t)3 * 4 * 64 * 512 * 4;
constexpr size_t WS_WGT = WS_KEYS + (size_t)2 * 8 * 2 * 128 * 128 * 2;
constexpr size_t WS_END = WS_WGT + (size_t)2 * 8 * 64 * 64 * 2;
constexpr size_t Q_QKVS = 0, Q_W = 1 * MiB, Q_QG = Q_W + 16 * MiB, Q_KDT = Q_QG + 16 * MiB, Q_UT = Q_KDT + 16 * MiB, Q_QK = Q_UT + 16 * MiB, Q_EGL = Q_QK + 8 * MiB, Q_END = Q_EGL + 4096;
static_assert(Q_END <= (size_t)MP * 1536 * 4, "region Q");
static_assert(WS_END <= 512 * MiB, "d_ws map");

struct MegaArgs {
    const float* in[35];
    float* out;
    unsigned char* ws;
};

__global__ void __launch_bounds__(NTH, 2) fwd_megakernel(MegaArgs ma) {
    cg::grid_group grid = cg::this_grid();
    extern __shared__ __attribute__((aligned(16))) unsigned char lds[];
    float* smem = (float*)lds;
    const int nb = gridDim.x, b0 = blockIdx.x, wave = __builtin_amdgcn_readfirstlane(threadIdx.x >> 6);
    int tid = threadIdx.x, lane = tid & 63;
    const float* x_prompt = ma.in[0];
    const float* x_sample = ma.in[1];
    const float* state_gdn = ma.in[2];
    const float* state_gdn_conv = ma.in[3];
    const float* state_lru = ma.in[4];
    const float* state_lru_conv = ma.in[5];
    const float* cache_k = ma.in[6];
    const float* cache_v = ma.in[7];
    const float* w_in_ab = ma.in[8];
    const float* gdn_conv_w = ma.in[9];
    const float* gdn_a_log = ma.in[10];
    const float* gdn_dt_bias = ma.in[11];
    const float* gdn_norm_w = ma.in[12];
    const float* lru_conv_w = ma.in[13];
    const float* lru_conv_b = ma.in[14];
    const float* lru_w_r = ma.in[15];
    const float* lru_b_r = ma.in[16];
    const float* lru_w_i = ma.in[17];
    const float* lru_b_i = ma.in[18];
    const float* lru_lam = ma.in[19];
    const float* w_out_ab = ma.in[20];
    const float* w_in_c = ma.in[21];
    const float* b_in_c = ma.in[22];
    const float* swa_sinks = ma.in[23];
    const float* w_out_c = ma.in[24];
    const float* b_out_c = ma.in[25];
    const float* rel_bias = ma.in[26];
    const float* ln_mix_g = ma.in[27];
    const float* ln_mix_b = ma.in[28];
    const float* ln_ffn_g = ma.in[29];
    const float* ln_ffn_b = ma.in[30];
    const float* peer_w_q = ma.in[31];
    const float* peer_keys = ma.in[32];
    const float* peer_u = ma.in[33];
    const float* peer_v = ma.in[34];

    float* out = ma.out;
    float* o_y = out;
    float* o_p_gdn = out + (size_t)NT * D;
    float* o_p_gdn_conv = o_p_gdn + 262144;
    float* o_p_lru = o_p_gdn_conv + 18432;
    float* o_p_lru_conv = o_p_lru + 2048;
    float* o_p_k = o_p_lru_conv + 6144;
    float* o_p_v = o_p_k + 131072;
    float* o_s_gdn = o_p_v + 131072;
    float* o_s_gdn_conv = o_s_gdn + 8388608;
    float* o_s_lru = o_s_gdn_conv + 589824;
    float* o_s_lru_conv = o_s_lru + 65536;
    float* o_s_k = o_s_lru_conv + 196608;
    float* o_s_v = o_s_k + 4194304;

    unsigned char* ws = ma.ws;
    bf16* WAB_T = (bf16*)(ws + WS_WAB); bf16* WOUT_T = (bf16*)(ws + WS_WOUT); bf16* WQ0_T = (bf16*)(ws + WS_WQ0); bf16* WQ1_T = (bf16*)(ws + WS_WQ1);
    bf16* WINC_T = (bf16*)(ws + WS_WINC); bf16* WOUTC_T = (bf16*)(ws + WS_WOUTC);
    bf16* ABUF = (bf16*)(ws + WS_ABUF);
    bf16* PROJ = (bf16*)(ws + WS_P); float* Y = (float*)(ws + WS_P); bf16* Qb = (bf16*)(ws + WS_P); bf16* PCb = (bf16*)(ws + WS_P); float* Y1 = (float*)(ws + WS_P);
    unsigned char* TAB8 = ws + WS_T; float* TSC = (float*)(ws + WS_T + (size_t)4 * 16384 * D);
    float* R_Q = (float*)(ws + WS_Q + Q_QKVS) - (size_t)NP * 1536; float* X2 = (float*)(ws + WS_A);
    GdnChunkBufs cbuf; cbuf.W = (bf16*)(ws + WS_Q + Q_W); cbuf.QG = (bf16*)(ws + WS_Q + Q_QG); cbuf.KDT = (bf16*)(ws + WS_Q + Q_KDT); cbuf.UT = (bf16*)(ws + WS_Q + Q_UT); cbuf.QK = (bf16*)(ws + WS_Q + Q_QK); cbuf.EGL = (float*)(ws + WS_Q + Q_EGL);
    bf16* Yb = (bf16*)(ws + WS_P);
    float* OUTS = (float*)(ws + WS_Q);
    float* PD = (float*)(ws + WS_P);
    bf16* KEYSB = (bf16*)(ws + WS_KEYS); bf16* WRT = (bf16*)(ws + WS_WGT); bf16* WIT = WRT + 8 * 64 * 64;
    float* HEND = (float*)(ws + WS_HEND); float* PEND = HEND + 4 * 64 * 512; float* CIN = PEND + 4 * 64 * 512;
    float* R_A = (float*)(ws + WS_A); float* R_B = (float*)(ws + WS_B); float* R_O = (float*)(ws + WS_O);
    bf16* XRES = (bf16*)(ws + WS_X1);
    float* R_G = (float*)(ws + WS_G); float* R_BETA = (float*)(ws + WS_BETA); float* R_GATE = (float*)(ws + WS_GATE); int* R_EXP = (int*)(ws + WS_EXP);

    for (int u = tid; u < (LDS_BYTES - RING_BYTES) / 4; u += NTH) ((unsigned*)(lds + RING_BYTES))[u] = 0u;
    __syncthreads();
    XcdBarrier bar = xcd_barrier_post((unsigned*)(ws + WS_CTL), (volatile LAS unsigned*)((LAS unsigned char*)lds + MISC_OFF) + 8);
#define GRID_BAR() do { xcd_barrier(bar); asm volatile("" : "+v"(tid)); lane = tid & 63; } while (0)
#define PHASE_LOOP(n) for (int vb = b0; vb < (n); vb += nb)
#define PHASE_END __syncthreads()
#define GEMM_PHASE_M(Mrows, EPI, Aptr, Btptr, Nn, ...) do { pg8::Gemm g_{(const pg8::bf16_t*)(Aptr), (const pg8::bf16_t*)(Btptr), (Mrows), (Nn), D}; pg8::StaticOrder S_; S_.init((Mrows), (Nn), nb, b0); \
        pg8::EPI E_{__VA_ARGS__}; pg8::gemm_phase<pg8::EPI, pg8::StaticOrder, true, true>((PG8_LAS unsigned char*)lds, g_, S_, E_); } while (0)
#define GEMM_PHASE(EPI, Aptr, Btptr, Nn, ...) GEMM_PHASE_M(MP, EPI, Aptr, Btptr, Nn, __VA_ARGS__)
#define GEMM_PHASE_SPLIT(Aptr, Btptr, Nn, Optr, biasptr) do { GEMM_PHASE_M(NP, EpiStoreBf16, Aptr, Btptr, Nn, Optr, Nn, biasptr, NP, Nn); \
        for (int p_ = b0; p_ < 8 * ((Nn) / 64); p_ += nb) sample_gemm_piece(Aptr, Btptr, biasptr, Optr, Nn, p_, lds); } while (0)

    {
        float* scr = smem + wave * 4096;
        const int gw = b0 * NWAVES + wave, NGW = nb * NWAVES;
        constexpr int I_AB = 16 * 97, I_OUT = 16 * 32, I_Q = 16 * 64, I_INC = 16 * 48;
        constexpr int NITEMS = I_AB + I_OUT + 2 * I_Q + I_INC + I_OUT;
        for (int it = gw; it < NITEMS; it += NGW) {
            int r = it;
            if (r < I_AB) { p0_transpose_item(w_in_ab, D, ABN, WAB_T, scr, r, lane); continue; } r -= I_AB;
            if (r < I_OUT) { p0_transpose_item(w_out_ab, D, D, WOUT_T, scr, r, lane); continue; } r -= I_OUT;
            if (r < I_Q) { p0_transpose_item(peer_w_q, D, 2048, WQ0_T, scr, r, lane); continue; } r -= I_Q;
            if (r < I_Q) { p0_transpose_item(peer_w_q + (size_t)D * 2048, D, 2048, WQ1_T, scr, r, lane); continue; } r -= I_Q;
            if (r < I_INC) { p0_transpose_item(w_in_c, D, CN, WINC_T, scr, r, lane); continue; } r -= I_INC;
            p0_transpose_item(w_out_c, D, D, WOUTC_T, scr, r, lane);
        }
        for (int it = b0 * NTH + tid; it < 2 * 8 * 64 * 8; it += nb * NTH) {
            const int gsel = it >> 12, nn = (it >> 9) & 7, dd = (it >> 3) & 63, c8 = (it & 7) * 8;
            const float* wsrc = (gsel ? lru_w_i : lru_w_r) + ((size_t)nn * 64 + c8) * 64 + dd;
            v4u o; o.x = pk2(wsrc[0], wsrc[64]); o.y = pk2(wsrc[128], wsrc[192]); o.z = pk2(wsrc[256], wsrc[320]); o.w = pk2(wsrc[384], wsrc[448]);
            *(v4u*)((gsel ? WIT : WRT) + ((size_t)nn * 64 + dd) * 64 + c8) = o;
        }
        for (int m = gw; m < MP + (ABNP - 97 * 32); m += NGW) {
            if (m < MP) row_to_bf16(m < NP ? x_prompt + (size_t)m * D : (m < NT ? x_sample + (size_t)(m - NP) * D : nullptr), ABUF + (size_t)m * D, lane);
            else row_to_bf16(nullptr, WAB_T + (size_t)(97 * 32 + (m - MP)) * D, lane);
        }
    }
    GRID_BAR();
    if (ma.out == nullptr) grid.sync();
    GEMM_PHASE(EpiStoreBf16, ABUF, WAB_T, ABNP, PROJ, ABN, nullptr, NT, ABN);
    GRID_BAR();
    constexpr int NSPLIT = 28, A_LRU = 4 * NSPLIT, A_GDN = 16 * NSPLIT, B_LRU = 4 * (64 - NSPLIT), B_GDN = 16 * (64 - NSPLIT);
    { AbPrepArgs pa;
      pa.PROJ = PROJ; pa.st_gdn_conv = state_gdn_conv; pa.st_lru_conv = state_lru_conv;
      pa.gdn_conv_w = gdn_conv_w; pa.a_log = gdn_a_log; pa.dt_bias = gdn_dt_bias;
      pa.lru_conv_w = lru_conv_w; pa.lru_conv_b = lru_conv_b; pa.w_r = lru_w_r; pa.b_r = lru_b_r; pa.w_i = lru_w_i; pa.b_i = lru_b_i; pa.lam = lru_lam;
      pa.QKV = R_Q; pa.G = R_G; pa.BETA = R_BETA; pa.LA = R_A; pa.LB = R_B;
      pa.p_gdn_conv = o_p_gdn_conv; pa.p_lru_conv = o_p_lru_conv; pa.s_gdn_conv = o_s_gdn_conv; pa.s_lru_conv = o_s_lru_conv;
      for (int v = b0; v < A_LRU + NS + A_GDN; v += nb) {
          if (v < A_LRU) { lru_prep_unit2(PROJ, lru_conv_w, lru_conv_b, WRT, WIT, lru_b_r, lru_b_i, lru_lam, R_B, R_A, HEND, PEND, o_p_lru_conv, (v / NSPLIT) * 64 + (v % NSPLIT), lds); PHASE_END; }
          else if (v < A_LRU + NS) { ab_prep(pa, NP + (v - A_LRU), smem); PHASE_END; }
          else { const int i = v - A_LRU - NS, h_ = i & 3, n_ = (i >> 2) % NSPLIT, b_ = (i >> 2) / NSPLIT;
                 gdn_prep_unit(PROJ, gdn_conv_w, gdn_a_log, gdn_dt_bias, cbuf, o_p_gdn_conv, (b_ * 64 + n_) * 4 + h_, lds); }
      } }
    GRID_BAR();
    f32x4 seqS[2]; int seqcur = 0;
    const int seq_p = (b0 & 7) + 8 * (b0 >> 5), seq_s = (b0 >> 3) & 3;
    if (b0 < 64) gdn_seq<0, NSPLIT>(cbuf, R_O, o_p_gdn, seq_p >> 2, seq_p & 3, seq_s, lds, seqS, seqcur);
    else for (int v = b0 - 64; v < B_LRU + B_GDN; v += nb - 64) {
        if (v < B_LRU) { lru_prep_unit2(PROJ, lru_conv_w, lru_conv_b, WRT, WIT, lru_b_r, lru_b_i, lru_lam, R_B, R_A, HEND, PEND, o_p_lru_conv, (v / (64 - NSPLIT)) * 64 + NSPLIT + (v % (64 - NSPLIT)), lds); PHASE_END; }
        else { const int i = v - B_LRU, h_ = i & 3, n_ = NSPLIT + (i >> 2) % (64 - NSPLIT), b_ = (i >> 2) / (64 - NSPLIT);
               gdn_prep_unit(PROJ, gdn_conv_w, gdn_a_log, gdn_dt_bias, cbuf, o_p_gdn_conv, (b_ * 64 + n_) * 4 + h_, lds); }
    }
    GRID_BAR();
    if (b0 < 64) gdn_seq<NSPLIT, 64>(cbuf, R_O, o_p_gdn, seq_p >> 2, seq_p & 3, seq_s, lds, seqS, seqcur);
    else if (b0 < 68) lru_carry(HEND, PEND, CIN, o_p_lru, b0 - 64);
    else {
        for (int v = (b0 - 68) * NWAVES + wave; v < NS * 4 * 8; v += (nb - 68) * NWAVES) gdn_step_sample_w(R_Q, R_G, R_BETA, state_gdn, R_O, o_s_gdn, v, lane);
        for (int v = b0 - 68; v < 128; v += nb - 68) lru_scan(R_A, R_B, state_lru, o_s_lru, NP, 1, NS, v);
        const int gw2 = (b0 - 68) * NWAVES + wave, NGW2 = (nb - 68) * NWAVES;
        for (int m = gw2; m < 512; m += NGW2) row_to_bf16(peer_keys + (size_t)m * D, KEYSB + (size_t)m * D, lane);
        for (int m = gw2; m < 4 * 16384; m += NGW2) {
            const int k = m >> 14, r = m & 16383;
            if (k & 1) row_to_fp8_sliced(peer_v + ((size_t)(k >> 1) * 16384 + r) * D, TAB8 + (size_t)k * 16384 * D, r, TSC + m, lane);
            else row_to_i8_sliced(peer_u + ((size_t)(k >> 1) * 16384 + r) * D, TAB8 + (size_t)k * 16384 * D, r, TSC + m, lane);
        }
    }
    GRID_BAR();
    PHASE_LOOP(NT / 8) { ab_mix_w(PROJ, R_O, R_B, R_A, CIN, gdn_norm_w, ABUF, vb * 8 + wave, lane); }
    GRID_BAR();
    GEMM_PHASE_SPLIT(ABUF, WOUT_T, D, Yb, (const float*)nullptr);
    GRID_BAR();
    PHASE_LOOP(NT / 8) { const int t = vb * 8 + wave;
        ln_res_w<false>(t < NP ? x_prompt + (size_t)t * D : x_sample + (size_t)(t - NP) * D, Yb + (size_t)t * D, ln_mix_g, ln_mix_b, ABUF + (size_t)t * D, lane); }
    GRID_BAR();
    GEMM_PHASE_SPLIT(ABUF, WQ0_T, 2048, Qb, (const float*)nullptr);
    GRID_BAR();
    { bf16x8_t tq_[4]; if (b0 < (NT / 64) * 8) peer_topk_ldq(tq_, Qb, b0 >> 3, b0 & 7, tid);
      if ((nb & 7) == 0) { peer_topk_stage_keys(KEYSB, b0 & 7, lds); PHASE_LOOP((NT / 64) * 8) { peer_topk4(Qb, R_EXP, R_GATE, vb >> 3, vb & 7, lds, tq_, vb + nb < (NT / 64) * 8 ? (vb + nb) >> 3 : -1); } }
      else PHASE_LOOP((NT / 64) * 8) { peer_topk_stage_keys(KEYSB, vb & 7, lds); peer_topk_ldq(tq_, Qb, vb >> 3, vb & 7, tid); peer_topk4(Qb, R_EXP, R_GATE, vb >> 3, vb & 7, lds, tq_, -1); } }
    GRID_BAR();
    asm volatile("" : "+v"(tid)); lane = tid & 63;
    { const int x = b0 & 7, tg0 = b0 >> 3, tgstep = nb >> 3, nit = (NT / 8 - tg0 + tgstep - 1) / tgstep;
      peer_u_loop(ABUF, R_EXP, TAB8 + (size_t)x * 16384 * 128, PD + (size_t)x * NT * 128, x, tg0, tgstep, nit, wave, lane); }
    GRID_BAR();
    PHASE_LOOP(NT / 8) { const int t = vb * 8 + wave; peer_xk(R_EXP + (size_t)t * 128, R_GATE + (size_t)t * 128, PD + (size_t)t * 128, TSC, TSC + 16384, lane); }
    GRID_BAR();
    { const int x = b0 & 7, tg0 = b0 >> 3, tgstep = nb >> 3, nit = (NT / 8 - tg0 + tgstep - 1) / tgstep;
      peer_v_loop(R_EXP, R_GATE, TAB8 + (size_t)16384 * D + (size_t)x * 16384 * 128, OUTS, x, tg0, tgstep, nit, wave, lane); }
    GRID_BAR();
    PHASE_LOOP(NT / 8) { const int t = vb * 8 + wave; peer_xc(ABUF + (size_t)t * D, OUTS + (size_t)t * D, ln_ffn_g, ln_ffn_b, nullptr, ABUF + (size_t)t * D, XRES + (size_t)t * D, lane); }
    GRID_BAR();

    GEMM_PHASE(EpiStoreBf16, ABUF, WINC_T, CN, PCb, CN, b_in_c, NT, CN);
    GRID_BAR();
    PHASE_LOOP(1024 + 256 + 260) {
        if (vb < 1024) attn_unit(PCb, rel_bias, swa_sinks, ABUF, vb, lds);
        else if (vb < 1280) swa_attn_sample(PCb, cache_k, cache_v, rel_bias, swa_sinks, ABUF, (vb - 1024) * 8 + wave, lane);
        else swa_kv_out3(PCb, cache_k, cache_v, o_p_k, o_p_v, o_s_k, o_s_v, vb - 1280);
    }
    GRID_BAR();
    GEMM_PHASE_SPLIT(ABUF, WOUTC_T, D, Yb, b_out_c);
    GRID_BAR();
    PHASE_LOOP(NT / 8) { const int t = vb * 8 + wave;
        ln_res_w<true>(XRES + (size_t)t * D, Yb + (size_t)t * D, ln_mix_g + D, ln_mix_b + D, ABUF + (size_t)t * D, lane); }
    GRID_BAR();
    GEMM_PHASE_SPLIT(ABUF, WQ1_T, 2048, Qb, (const float*)nullptr);
    GRID_BAR();
    { bf16x8_t tq_[4]; if (b0 < (NT / 64) * 8) peer_topk_ldq(tq_, Qb, b0 >> 3, b0 & 7, tid);
      if ((nb & 7) == 0) { peer_topk_stage_keys(KEYSB + (size_t)8 * 2 * 128 * 128, b0 & 7, lds); PHASE_LOOP((NT / 64) * 8) { peer_topk4(Qb, R_EXP, R_GATE, vb >> 3, vb & 7, lds, tq_, vb + nb < (NT / 64) * 8 ? (vb + nb) >> 3 : -1); } }
      else PHASE_LOOP((NT / 64) * 8) { peer_topk_stage_keys(KEYSB + (size_t)8 * 2 * 128 * 128, vb & 7, lds); peer_topk_ldq(tq_, Qb, vb >> 3, vb & 7, tid); peer_topk4(Qb, R_EXP, R_GATE, vb >> 3, vb & 7, lds, tq_, -1); } }
    GRID_BAR();
    asm volatile("" : "+v"(tid)); lane = tid & 63;
    { const int x = b0 & 7, tg0 = b0 >> 3, tgstep = nb >> 3, nit = (NT / 8 - tg0 + tgstep - 1) / tgstep;
      peer_u_loop(ABUF, R_EXP, TAB8 + (size_t)2 * 16384 * D + (size_t)x * 16384 * 128, PD + (size_t)x * NT * 128, x, tg0, tgstep, nit, wave, lane); }
    GRID_BAR();
    PHASE_LOOP(NT / 8) { const int t = vb * 8 + wave; peer_xk(R_EXP + (size_t)t * 128, R_GATE + (size_t)t * 128, PD + (size_t)t * 128, TSC + 2 * 16384, TSC + 3 * 16384, lane); }
    GRID_BAR();
    { const int x = b0 & 7, tg0 = b0 >> 3, tgstep = nb >> 3, nit = (NT / 8 - tg0 + tgstep - 1) / tgstep;
      peer_v_loop(R_EXP, R_GATE, TAB8 + (size_t)3 * 16384 * D + (size_t)x * 16384 * 128, OUTS, x, tg0, tgstep, nit, wave, lane); }
    GRID_BAR();
    PHASE_LOOP(NT / 8) { const int t = vb * 8 + wave; peer_xc(ABUF + (size_t)t * D, OUTS + (size_t)t * D, ln_ffn_g + D, ln_ffn_b + D, o_y + (size_t)t * D, nullptr, nullptr, lane); }
}
}

extern "C" void kernel_launch(void* const* d_in, const int* in_sizes, int n_in,
                              void* d_out, int out_size, void* d_ws, size_t ws_size,
                              hipStream_t stream) {
    static int grid_blocks = 0;
    if (!grid_blocks) {
        int dev = 0, cus = 0, per_cu = 0;
        (void)hipGetDevice(&dev);
        (void)hipDeviceGetAttribute(&cus, hipDeviceAttributeMultiprocessorCount, dev);
        if (hipFuncSetAttribute((const void*)fwd_megakernel, hipFuncAttributeMaxDynamicSharedMemorySize, LDS_BYTES) != hipSuccess) { fprintf(stderr, "hipFuncSetAttribute failed\n"); grid_blocks = -1; return; }
        (void)hipOccupancyMaxActiveBlocksPerMultiprocessor(&per_cu, (const void*)fwd_megakernel, NTH, LDS_BYTES);
        if (per_cu < 1) { fprintf(stderr, "occupancy query says %d blocks per CU\n", per_cu); grid_blocks = -1; return; }
        if (cus * per_cu < 256) { fprintf(stderr, "this kernel needs 256 co-resident workgroups (device reports %d CUs x %d)\n", cus, per_cu); grid_blocks = -1; return; }
        grid_blocks = 256;
    }
    if (grid_blocks < 0) return;
    (void)hipMemsetAsync((char*)d_ws + WS_CTL, 0, CTL_ZERO_BYTES, stream);
    MegaArgs ma{};
    for (int i = 0; i < 35; ++i) ma.in[i] = (const float*)d_in[i];
    ma.out = (float*)d_out;
    ma.ws = (unsigned char*)d_ws;
    void* args[] = {&ma};
    hipError_t e = hipLaunchCooperativeKernel((void*)fwd_megakernel, dim3(grid_blocks), dim3(NTH), args, LDS_BYTES, stream);
    if (e != hipSuccess) fprintf(stderr, "cooperative launch failed: %s (grid %d)\n", hipGetErrorString(e), grid_blocks);
}
```

```cpp
#include <hip/hip_runtime.h>
#include <hip/hip_cooperative_groups.h>
#include <cstdio>
#include <cstdint>
namespace cg = cooperative_groups;

namespace pg8 {
#define PG8_LAS __attribute__((address_space(3)))
typedef unsigned short bf16_t;
typedef short bf16x8 __attribute__((ext_vector_type(8)));
typedef float f32x4 __attribute__((ext_vector_type(4)));
typedef unsigned u32x4 __attribute__((ext_vector_type(4)));
constexpr int BM = 256, BK = 64, HALF = 128, HTB = HALF * BK * 2  , STAGE_BYTES = 8 * HTB, NXCD = 8, WGM = 8;

__host__ __device__ __forceinline__ int lds_byte(int r, int c) { const int st = (r >> 4) * 2 + (c >> 5), rr = r & 15, cc = c & 31, ob = rr * 64 + cc * 2; return st * 1024 + (ob ^ (((ob >> 9) & 1) << 5)); }
__host__ __device__ __forceinline__ void stage_rc(int b, int& R, int& C) { const int st = b / 1024, sb = b % 1024, swz = sb ^ (((sb >> 9) & 1) << 5); R = (st >> 1) * 16 + swz / 64; C = (st & 1) * 32 + (swz % 64) / 2; }
__host__ __device__ __forceinline__ int perm32(int rho) { const int n = rho >> 4, i = rho & 15; return 8 * (i >> 2) + 4 * n + (i & 3); }

struct Unit { int pm, pn; };
struct Gemm { const bf16_t* A; const bf16_t* Bt; int M, N, K; };

struct StaticOrder {
    int nM, nN, nwg, G, c;
    __host__ __device__ void init(int M, int N, int G_, int c_) { nM = M / BM; nN = N / BM; nwg = nM * nN; G = G_; c = c_; }
    __host__ __device__ bool next(int i, Unit& u) const {
        const long L = (long)i * G + c; if (L >= nwg) return false;
        int wgid = (int)L; { const int q = nwg / NXCD, r = nwg % NXCD, xcd = wgid % NXCD, off = wgid / NXCD; wgid = (xcd < r ? xcd * (q + 1) : r * (q + 1) + (xcd - r) * q) + off; }
        const int nig = WGM * nN, gid = wgid / nig, fm = gid * WGM, gsz = (nM - fm) < WGM ? (nM - fm) : WGM;
        u.pm = fm + ((wgid % nig) % gsz); u.pn = (wgid % nig) / gsz; return true;
    }
    __device__ __forceinline__ void a_ready(const Unit&) const {}
    __device__ __forceinline__ void done(const Unit&) const {}
};

__device__ __forceinline__ unsigned cvt_pk_bf16(float lo, float hi) { unsigned r; asm volatile("v_cvt_pk_bf16_f32 %0, %1, %2" : "=v"(r) : "v"(lo), "v"(hi)); return r; }
template <class Epi, class Sched, bool ALIGN_EPI = false, bool SP2 = false>
__device__ __forceinline__ void gemm_phase(PG8_LAS unsigned char* lds, const Gemm g, const Sched& S, const Epi& E) {
    int tid_ = threadIdx.x; asm volatile("" : "+v"(tid_));
    const int tid = tid_, wid = __builtin_amdgcn_readfirstlane(tid >> 6), lane = tid & 63, wr = wid >> 2, wc = wid & 3, fr = lane & 15, fq = lane >> 4;
    const int K = g.K, nt = K / BK;
    unsigned voffA[2], voffB[2];
#pragma unroll
    for (int i = 0; i < 2; ++i) { int R, C; stage_rc(tid * 16 + i * 8192, R, C); const int Rb = Epi::PERM ? ((R & ~31) + perm32(R & 31)) : R;
        voffA[i] = (unsigned)(R * K + C) * 2u; voffB[i] = (unsigned)(Rb * K + C) * 2u; }
    const size_t kstep = (size_t)(BK * 2);
    const size_t hstep = (size_t)HALF * K * 2;
    const size_t tstep = 2 * hstep;
    const unsigned ldsw = (unsigned)wid * 1024u;
    const int aoff = lds_byte(wr * 64 + fr, fq * 8), boff = lds_byte(wc * 32 + fr, fq * 8);
#define PG8_SA(b, h) (((b) * 2 + (h)) * HTB)
#define PG8_SB(b, h) ((4 + (b) * 2 + (h)) * HTB)
#define PG8_STAGE(bufoff, gbase, voff) do { _Pragma("unroll") for (int _i = 0; _i < 2; ++_i) \
        __builtin_amdgcn_global_load_lds((const unsigned*)((const char*)(gbase) + (voff)[_i]), (PG8_LAS unsigned*)(lds + (bufoff) + ldsw + _i * 8192), 16, 0, 0); } while (0)
#define PG8_LDA(dst, b, h) do { _Pragma("unroll") for (int m = 0; m < 4; ++m) _Pragma("unroll") for (int k = 0; k < 2; ++k) dst[m][k] = *(const PG8_LAS bf16x8*)(lds + PG8_SA(b, h) + aoff + m * 2048 + k * 1024); } while (0)
#define PG8_LDB(dst, b, h) do { _Pragma("unroll") for (int n = 0; n < 2; ++n) _Pragma("unroll") for (int k = 0; k < 2; ++k) dst[n][k] = *(const PG8_LAS bf16x8*)(lds + PG8_SB(b, h) + boff + n * 2048 + k * 1024); } while (0)
#define PG8_MMA(ai, bj, At, Bt) do { __builtin_amdgcn_s_setprio(1); _Pragma("unroll") for (int m = 0; m < 4; ++m) _Pragma("unroll") for (int n = 0; n < 2; ++n) _Pragma("unroll") for (int k = 0; k < 2; ++k) \
        acc[ai][bj][m][n] = __builtin_amdgcn_mfma_f32_16x16x32_bf16(Bt[n][k], At[m][k], acc[ai][bj][m][n], 0, 0, 0); __builtin_amdgcn_s_setprio(0); } while (0)
#define PG8_WAIT_V(n) asm volatile("s_waitcnt vmcnt(" #n ")" ::: "memory")
#define PG8_WAIT_L(n) asm volatile("s_waitcnt lgkmcnt(" #n ")" ::: "memory")
#define PG8_BAR __builtin_amdgcn_s_barrier()
#define PG8_SCHED __builtin_amdgcn_sched_barrier(0)
    Unit cur, nxt; int ui = 0;
    if (!S.next(0, cur)) return;
    f32x4 acc[2][2][4][2];
#pragma unroll
    for (int a = 0; a < 2; ++a)
#pragma unroll
        for (int b = 0; b < 2; ++b)
#pragma unroll
            for (int m = 0; m < 4; ++m)
#pragma unroll
                for (int n = 0; n < 2; ++n) acc[a][b][m][n] = (f32x4){0.f, 0.f, 0.f, 0.f};
    bf16x8 At[4][2], B0[2][2], B1[2][2];
    const char* cA = (const char*)g.A + (size_t)cur.pm * tstep; const char* cB = (const char*)g.Bt + (size_t)cur.pn * tstep;
    S.a_ready(cur);
    if constexpr (SP2) {
        PG8_STAGE(PG8_SB(0, 0), cB, voffB); PG8_STAGE(PG8_SB(0, 1), cB + hstep, voffB); PG8_STAGE(PG8_SA(0, 0), cA, voffA); PG8_STAGE(PG8_SA(0, 1), cA + hstep, voffA);
        if (wr == 1) PG8_BAR;
        PG8_WAIT_V(2); PG8_BAR;
        PG8_STAGE(PG8_SB(1, 0), cB + kstep, voffB); PG8_STAGE(PG8_SA(1, 0), cA + kstep, voffA); PG8_STAGE(PG8_SB(1, 1), cB + hstep + kstep, voffB);
        PG8_WAIT_V(6); PG8_BAR;
    } else {
        PG8_STAGE(PG8_SB(0, 0), cB, voffB); PG8_STAGE(PG8_SA(0, 0), cA, voffA); PG8_STAGE(PG8_SB(0, 1), cB + hstep, voffB); PG8_STAGE(PG8_SA(0, 1), cA + hstep, voffA);
        if (wr == 1) PG8_BAR;
        PG8_WAIT_V(4); PG8_BAR;
        PG8_STAGE(PG8_SB(1, 0), cB + kstep, voffB); PG8_STAGE(PG8_SA(1, 0), cA + kstep, voffA); PG8_STAGE(PG8_SB(1, 1), cB + hstep + kstep, voffB);
        PG8_WAIT_V(6); PG8_BAR;
    }
    for (;;) {
        const bool has_next = S.next(ui + 1, nxt);
        const char* nA = has_next ? (const char*)g.A + (size_t)nxt.pm * tstep : cA; const char* nB = has_next ? (const char*)g.Bt + (size_t)nxt.pn * tstep : cB;
        for (int t = 0; t < nt; t += 2) {
            const bool last = (t == nt - 2);
            const char* a1 = cA + (size_t)(t + 1) * kstep;
            const char* a2 = last ? nA : cA + (size_t)(t + 2) * kstep; const char* b2 = last ? nB : cB + (size_t)(t + 2) * kstep;
            const char* a3 = a2 + kstep; const char* b3 = b2 + kstep;
            if (last && has_next) S.a_ready(nxt);
            if constexpr (SP2) {
            PG8_LDB(B0, 0, 0); PG8_LDB(B1, 0, 1); PG8_SCHED; PG8_LDA(At, 0, 0); PG8_STAGE(PG8_SA(1, 1), a1 + hstep, voffA);
            PG8_WAIT_V(8); PG8_WAIT_L(0); PG8_BAR; PG8_MMA(0, 0, At, B0); PG8_MMA(0, 1, At, B1); PG8_BAR; PG8_SCHED;
            PG8_LDA(At, 0, 1); PG8_STAGE(PG8_SB(0, 0), b2, voffB); PG8_STAGE(PG8_SB(0, 1), b2 + hstep, voffB); PG8_STAGE(PG8_SA(0, 0), a2, voffA);
            PG8_WAIT_V(8); PG8_WAIT_L(0); PG8_BAR; PG8_MMA(1, 0, At, B0); PG8_MMA(1, 1, At, B1); PG8_BAR; PG8_SCHED;
            PG8_LDB(B0, 1, 0); PG8_LDB(B1, 1, 1); PG8_SCHED; PG8_LDA(At, 1, 0); PG8_STAGE(PG8_SA(0, 1), a2 + hstep, voffA);
            PG8_WAIT_V(8); PG8_WAIT_L(0); PG8_BAR; PG8_MMA(0, 0, At, B0); PG8_MMA(0, 1, At, B1); PG8_BAR; PG8_SCHED;
            PG8_LDA(At, 1, 1); PG8_STAGE(PG8_SB(1, 0), b3, voffB); PG8_STAGE(PG8_SB(1, 1), b3 + hstep, voffB); PG8_STAGE(PG8_SA(1, 0), a3, voffA);
            PG8_WAIT_V(8); PG8_WAIT_L(0); PG8_BAR; PG8_MMA(1, 0, At, B0); PG8_MMA(1, 1, At, B1); PG8_BAR; PG8_SCHED;
            } else {
            PG8_LDB(B0, 0, 0); PG8_SCHED; PG8_LDA(At, 0, 0); PG8_STAGE(PG8_SA(1, 1), a1 + hstep, voffA);
            PG8_WAIT_L(8); PG8_BAR; PG8_WAIT_L(0); PG8_MMA(0, 0, At, B0); PG8_BAR; PG8_SCHED;
            PG8_LDB(B1, 0, 1); PG8_STAGE(PG8_SB(0, 0), b2, voffB);
            PG8_BAR; PG8_WAIT_L(0); PG8_MMA(0, 1, At, B1); PG8_BAR;
            PG8_LDA(At, 0, 1); PG8_STAGE(PG8_SA(0, 0), a2, voffA);
            PG8_BAR; PG8_WAIT_L(0); PG8_MMA(1, 0, At, B0); PG8_BAR; PG8_SCHED;
            PG8_STAGE(PG8_SB(0, 1), b2 + hstep, voffB);
            PG8_WAIT_V(6); PG8_BAR; PG8_MMA(1, 1, At, B1); PG8_BAR;
            PG8_LDB(B0, 1, 0); PG8_SCHED; PG8_LDA(At, 1, 0); PG8_STAGE(PG8_SA(0, 1), a2 + hstep, voffA);
            PG8_WAIT_L(8); PG8_BAR; PG8_WAIT_L(0); PG8_MMA(0, 0, At, B0); PG8_BAR; PG8_SCHED;
            PG8_LDB(B1, 1, 1); PG8_STAGE(PG8_SB(1, 0), b3, voffB);
            PG8_BAR; PG8_WAIT_L(0); PG8_MMA(0, 1, At, B1); PG8_BAR;
            PG8_LDA(At, 1, 1); PG8_STAGE(PG8_SA(1, 0), a3, voffA);
            PG8_BAR; PG8_WAIT_L(0); PG8_MMA(1, 0, At, B0); PG8_BAR; PG8_SCHED;
            PG8_STAGE(PG8_SB(1, 1), b3 + hstep, voffB);
            PG8_WAIT_V(6); PG8_BAR; PG8_MMA(1, 1, At, B1); PG8_BAR;
            }
        }
        if constexpr (ALIGN_EPI) { if (wr == 0) PG8_BAR; }
        if constexpr (!Epi::AFTER_DRAIN) { E(acc, cur, wr, wc, fr, fq); S.done(cur); }
        if (!has_next) break;
#pragma unroll
        for (int a = 0; a < 2; ++a)
#pragma unroll
            for (int b = 0; b < 2; ++b)
#pragma unroll
                for (int m = 0; m < 4; ++m)
#pragma unroll
                    for (int n = 0; n < 2; ++n) acc[a][b][m][n] = (f32x4){0.f, 0.f, 0.f, 0.f};
        cur = nxt; cA = nA; cB = nB; ++ui;
        if constexpr (ALIGN_EPI) { if (wr == 1) PG8_BAR; }
    }
    PG8_WAIT_V(0);
    if constexpr (!ALIGN_EPI) { if (wr == 0) PG8_BAR; }
    PG8_BAR;
    if constexpr (Epi::AFTER_DRAIN) { E.fused(acc, cur, wr, wc, fr, fq, lds, wid, lane); S.done(cur); }
#undef PG8_SA
#undef PG8_SB
#undef PG8_STAGE
#undef PG8_LDA
#undef PG8_LDB
#undef PG8_MMA
#undef PG8_WAIT_V
#undef PG8_WAIT_L
#undef PG8_BAR
#undef PG8_SCHED
}
}
namespace pg8 {
struct EpiStoreBf16 {
    static constexpr bool PERM = true, AFTER_DRAIN = false;
    bf16_t* O; int ldc; const float* bias; int m_real, n_real;
    __device__ __forceinline__ void operator()(const f32x4 (&acc)[2][2][4][2], const Unit& u, int wr, int wc, int fr, int fq) const {
        const int row0 = u.pm * BM + wr * 64 + fr, col0 = u.pn * BM + wc * 32 + 8 * fq;
#pragma unroll
        for (int bj = 0; bj < 2; ++bj) {
            const int col = col0 + bj * HALF;
            if (col >= n_real) continue;
            f32x4 b0 = (f32x4){0.f, 0.f, 0.f, 0.f}, b1 = b0;
            if (bias) { b0 = *(const f32x4*)(bias + col); b1 = *(const f32x4*)(bias + col + 4); }
#pragma unroll
            for (int ai = 0; ai < 2; ++ai)
#pragma unroll
                for (int m = 0; m < 4; ++m) {
                    const int row = row0 + ai * HALF + m * 16;
                    if (row >= m_real) continue;
                    const f32x4 v0 = acc[ai][bj][m][0] + b0, v1 = acc[ai][bj][m][1] + b1;
                    u32x4 w; w.x = cvt_pk_bf16(v0[0], v0[1]); w.y = cvt_pk_bf16(v0[2], v0[3]); w.z = cvt_pk_bf16(v1[0], v1[1]); w.w = cvt_pk_bf16(v1[2], v1[3]);
                    *(u32x4*)(O + (size_t)row * ldc + col) = w;
                }
        }
    }
};
struct EpiStoreF32 {
    static constexpr bool PERM = false, AFTER_DRAIN = false;
    float* O; int ldc; const float* bias; int m_real, n_real;
    __device__ __forceinline__ void operator()(const f32x4 (&acc)[2][2][4][2], const Unit& u, int wr, int wc, int fr, int fq) const {
        const int row0 = u.pm * BM + wr * 64 + fr, col0 = u.pn * BM + wc * 32 + 4 * fq;
#pragma unroll
        for (int bj = 0; bj < 2; ++bj)
#pragma unroll
            for (int n = 0; n < 2; ++n) {
                const int col = col0 + bj * HALF + n * 16;
                if (col >= n_real) continue;
                const f32x4 bv = bias ? *(const f32x4*)(bias + col) : (f32x4){0.f, 0.f, 0.f, 0.f};
#pragma unroll
                for (int ai = 0; ai < 2; ++ai)
#pragma unroll
                    for (int m = 0; m < 4; ++m) {
                        const int row = row0 + ai * HALF + m * 16;
                        if (row >= m_real) continue;
                        *(f32x4*)(O + (size_t)row * ldc + col) = acc[ai][bj][m][n] + bv;
                    }
            }
    }
};
}
namespace {
#define GAS __attribute__((address_space(1)))
#define LAS __attribute__((address_space(3)))
typedef unsigned short bf16;
typedef float f32x4 __attribute__((ext_vector_type(4)));
typedef unsigned v4u __attribute__((ext_vector_type(4)));
typedef unsigned v2u __attribute__((ext_vector_type(2)));

constexpr int D = 1024, NB = 4, SEQ = 4096, NP = NB * SEQ, NS = 128, NT = NP + NS, MP = 16640;
constexpr int ABN = 3080, ABNP = 3328;
constexpr int C_QKV = 0, C_Z = 1536, C_XR = 2048, C_GATE = 2560, C_A = 3072, C_B = 3076;
constexpr int ABMAIN = 3072;
constexpr int CN = 1536;
constexpr float ALPHA = 1.4142135623730951f;
constexpr float LN_EPS = 1e-5f;
constexpr int NTH = 512, NWAVES = 8;
constexpr int RING_BYTES = 143360, MISC_OFF = RING_BYTES + 320, LDS_BYTES = 147456;

__device__ __forceinline__ float bf2f(bf16 v) { return __uint_as_float((unsigned)v << 16); }
__device__ __forceinline__ float bflo(unsigned w) { return __uint_as_float(w << 16); }
__device__ __forceinline__ float bfhi(unsigned w) { return __uint_as_float(w & 0xffff0000u); }
typedef float f32x2c_t __attribute__((ext_vector_type(2)));
typedef __bf16 bf16x2c_t __attribute__((ext_vector_type(2)));
__device__ __forceinline__ unsigned f2bf(float f) { return (unsigned)__builtin_bit_cast(unsigned short, (__bf16)f); }
__device__ __forceinline__ unsigned pk2(float lo, float hi) { return __builtin_bit_cast(unsigned, __builtin_convertvector((f32x2c_t){lo, hi}, bf16x2c_t)); }
__device__ __forceinline__ float sigmoidf_(float x) { return 1.0f / (1.0f + expf(-x)); }
__device__ __forceinline__ float softplusf_(float x) { return fmaxf(x, 0.f) + log1pf(expf(-fabsf(x))); }
__device__ __forceinline__ float siluf_(float x) { return x / (1.0f + expf(-x)); }
__device__ __forceinline__ float geluf_(float x) { return 0.5f * x * (1.0f + tanhf(0.7978845608028654f * (x + 0.044715f * x * x * x))); }
#define DPPF(v_, ctrl_, rmask_) __int_as_float(__builtin_amdgcn_update_dpp(0, __float_as_int(v_), (ctrl_), (rmask_), 0xf, false))
__device__ __forceinline__ float wave_sum(float v) {
    v += DPPF(v, 0xB1, 0xf); v += DPPF(v, 0x4E, 0xf); v += DPPF(v, 0x141, 0xf); v += DPPF(v, 0x140, 0xf);
    v += DPPF(v, 0x142, 0xa); v += DPPF(v, 0x143, 0xc);
    return __int_as_float(__builtin_amdgcn_readlane(__float_as_int(v), 63));
}
__device__ __forceinline__ float wave_max(float v) {
    v = fmaxf(v, DPPF(v, 0xB1, 0xf)); v = fmaxf(v, DPPF(v, 0x4E, 0xf)); v = fmaxf(v, DPPF(v, 0x141, 0xf)); v = fmaxf(v, DPPF(v, 0x140, 0xf));
    { const float t = __int_as_float(__builtin_amdgcn_update_dpp(__float_as_int(v), __float_as_int(v), 0x142, 0xa, 0xf, false)); v = fmaxf(v, t); }
    { const float t = __int_as_float(__builtin_amdgcn_update_dpp(__float_as_int(v), __float_as_int(v), 0x143, 0xc, 0xf, false)); v = fmaxf(v, t); }
    return __int_as_float(__builtin_amdgcn_readlane(__float_as_int(v), 63));
}

template <bool ABORDER = false>
__device__ __forceinline__ void p0_transpose_item(const float* __restrict__ W, int K, int N, bf16* __restrict__ WT, float* scr, int item, int lane) {
    const int nblk = (N + 31) / 32, kb = item / nblk, nb = item % nblk, k0 = 64 * kb, n0 = 32 * nb;
    const int n_ = n0 + (lane & 31);
    const int ns = ABORDER ? (n_ < 2048 ? n_ : (n_ < ABMAIN ? n_ + 8 : n_ - 1024)) : n_;
#pragma unroll 8
    for (int i = 0; i < 32; ++i) { const int kk = 2 * i + (lane >> 5); scr[kk * 33 + (lane & 31)] = n_ < N ? W[(size_t)(k0 + kk) * N + ns] : 0.f; }
    asm volatile("s_waitcnt lgkmcnt(0)" ::: "memory");
    const int c = lane & 7;
#pragma unroll
    for (int j = 0; j < 4; ++j) { const int n = (lane >> 3) + 8 * j; const float* s = scr + (8 * c) * 33 + n;
        v4u o; o.x = pk2(s[0 * 33], s[1 * 33]); o.y = pk2(s[2 * 33], s[3 * 33]); o.z = pk2(s[4 * 33], s[5 * 33]); o.w = pk2(s[6 * 33], s[7 * 33]);
        *(v4u*)(WT + (size_t)(n0 + n) * K + k0 + 8 * c) = o; }
    asm volatile("s_waitcnt lgkmcnt(0)" ::: "memory");
}
__device__ __forceinline__ void row_to_bf16(const float* __restrict__ xrow, bf16* __restrict__ orow, int lane) {
#pragma unroll
    for (int j = 0; j < 4; ++j) {
        f32x4 v = (f32x4){0.f, 0.f, 0.f, 0.f};
        if (xrow) v = ((const f32x4*)xrow)[lane + 64 * j];
        v2u o; o.x = pk2(v.x, v.y); o.y = pk2(v.z, v.w);
        ((v2u*)orow)[lane + 64 * j] = o;
    }
}

struct AbPrepArgs {
    const bf16* PROJ; const float* st_gdn_conv; const float* st_lru_conv;
    const float* gdn_conv_w; const float* a_log; const float* dt_bias;
    const float* lru_conv_w; const float* lru_conv_b; const float* w_r; const float* b_r; const float* w_i; const float* b_i; const float* lam;
    float* QKV; float* G; float* BETA; float* LA; float* LB;
    float* p_gdn_conv; float* p_lru_conv; float* s_gdn_conv; float* s_lru_conv;
};
__device__ __forceinline__ void ab_prep(const AbPrepArgs& a, int t, float* smem) {
    int tid = threadIdx.x; asm volatile("" : "+v"(tid));
    const int lane = tid & 63, wid = tid >> 6;
    const bool samp = t >= NP; const int sb = t - NP, pos = t % SEQ, b = t / SEQ;
    float* sq = smem;
    float* sx = smem + 1536;
    float* scl = smem + 2048;
    const bf16* prow = a.PROJ + (size_t)t * ABN;
    for (int c = tid; c < 1536; c += NTH) {
        float acc = 0.f;
#pragma unroll
        for (int i = 0; i < 4; ++i) {
            float xv;
            if (i == 3) xv = bf2f(prow[C_QKV + c]);
            else if (samp) xv = a.st_gdn_conv[((size_t)sb * 3 + i) * 1536 + c];
            else xv = (pos - 3 + i >= 0) ? bf2f(a.PROJ[(size_t)(t - 3 + i) * ABN + C_QKV + c]) : 0.f;
            acc += a.gdn_conv_w[i * 1536 + c] * xv;
        }
        sq[c] = siluf_(acc);
    }
    {
        const int c = tid;
        float acc = a.lru_conv_b[c];
#pragma unroll
        for (int i = 0; i < 4; ++i) {
            float xv;
            if (i == 3) xv = bf2f(prow[C_XR + c]);
            else if (samp) xv = a.st_lru_conv[((size_t)sb * 3 + i) * 512 + c];
            else xv = (pos - 3 + i >= 0) ? bf2f(a.PROJ[(size_t)(t - 3 + i) * ABN + C_XR + c]) : 0.f;
            acc += a.lru_conv_w[i * 512 + c] * xv;
        }
        sx[c] = acc;
    }
    __syncthreads();
    {
        const int grp = wid;
        const float v0 = sq[grp * 128 + lane], v1 = sq[grp * 128 + 64 + lane];
        const float s = wave_sum(v0 * v0 + v1 * v1);
        if (lane == 0) scl[grp] = rsqrtf(s + 1e-6f) * (grp < 4 ? 0.08838834764831845f : 1.0f);
    }
    __syncthreads();
    for (int c = tid; c < 1536; c += NTH) a.QKV[(size_t)t * 1536 + c] = (c < 1024) ? sq[c] * scl[c >> 7] : sq[c];
    if (tid < 4) {
        const float a_raw = bf2f(prow[C_A + tid]), b_raw = bf2f(prow[C_B + tid]);
        a.G[(size_t)t * 4 + tid] = -expf(a.a_log[tid]) * softplusf_(a_raw + a.dt_bias[tid]);
        a.BETA[(size_t)t * 4 + tid] = sigmoidf_(b_raw);
    }
    if (!samp) {
        if (pos >= SEQ - 3) {
            const int row = pos - (SEQ - 3);
            for (int c = tid; c < 1536; c += NTH) a.p_gdn_conv[((size_t)b * 3 + row) * 1536 + c] = bf2f(prow[C_QKV + c]);
            a.p_lru_conv[((size_t)b * 3 + row) * 512 + tid] = bf2f(prow[C_XR + tid]);
        }
    } else {
        for (int c = tid; c < 1536; c += NTH) {
            a.s_gdn_conv[((size_t)sb * 3 + 0) * 1536 + c] = a.st_gdn_conv[((size_t)sb * 3 + 1) * 1536 + c];
            a.s_gdn_conv[((size_t)sb * 3 + 1) * 1536 + c] = a.st_gdn_conv[((size_t)sb * 3 + 2) * 1536 + c];
            a.s_gdn_conv[((size_t)sb * 3 + 2) * 1536 + c] = bf2f(prow[C_QKV + c]);
        }
        {
            const int c = tid;
            a.s_lru_conv[((size_t)sb * 3 + 0) * 512 + c] = a.st_lru_conv[((size_t)sb * 3 + 1) * 512 + c];
            a.s_lru_conv[((size_t)sb * 3 + 1) * 512 + c] = a.st_lru_conv[((size_t)sb * 3 + 2) * 512 + c];
            a.s_lru_conv[((size_t)sb * 3 + 2) * 512 + c] = bf2f(prow[C_XR + c]);
        }
    }
    {
        const int c = tid, n = c >> 6, d = c & 63;
        float r = a.b_r[c], ii = a.b_i[c];
#pragma unroll 4
        for (int cc = 0; cc < 64; ++cc) {
            const float xv = sx[n * 64 + cc];
            r += xv * a.w_r[((size_t)n * 64 + cc) * 64 + d];
            ii += xv * a.w_i[((size_t)n * 64 + cc) * 64 + d];
        }
        r = sigmoidf_(r); ii = sigmoidf_(ii);
        const float log_a = -8.0f * r * softplusf_(-a.lam[c]);
        a.LA[(size_t)t * 512 + c] = expf(log_a);
        a.LB[(size_t)t * 512 + c] = sqrtf(-expm1f(2.0f * log_a)) * (ii * sx[c]);
    }
}

__device__ __forceinline__ void gdn_scan(const float* __restrict__ QKV, const float* __restrict__ G, const float* __restrict__ BETA,
                                         const float* __restrict__ S0, float* __restrict__ O, float* __restrict__ Sout, int tok_base, int T,
                                         int sl, int h, int sq, float* smem) {
    int tid = threadIdx.x; asm volatile("" : "+v"(tid));
    const int dvl = tid & 31, kg = tid >> 5;
    const int dv = sl * 32 + dvl;
    float (*red1)[32] = (float (*)[32])smem;
    float (*red2)[32] = (float (*)[32])(smem + 512);
    float S[8];
#pragma unroll
    for (int i = 0; i < 8; ++i) S[i] = S0 ? S0[(((size_t)sq * 4 + h) * 128 + kg * 8 + i) * 128 + dv] : 0.f;
    float kk[8], qq[8], vv, g, be;
    {
        const size_t tok = (size_t)tok_base + (size_t)sq * T;
        const float* row = QKV + tok * 1536;
#pragma unroll
        for (int i = 0; i < 8; ++i) { kk[i] = row[512 + h * 128 + kg * 8 + i]; qq[i] = row[h * 128 + kg * 8 + i]; }
        vv = row[1024 + h * 128 + dv]; g = G[tok * 4 + h]; be = BETA[tok * 4 + h];
    }
    for (int t = 0; t < T; ++t) {
        const size_t tok = (size_t)tok_base + (size_t)sq * T + t;
        float nk[8], nq[8], nv = 0.f, ng = 0.f, nb = 0.f;
        if (t + 1 < T) {
            const float* row = QKV + (tok + 1) * 1536;
#pragma unroll
            for (int i = 0; i < 8; ++i) { nk[i] = row[512 + h * 128 + kg * 8 + i]; nq[i] = row[h * 128 + kg * 8 + i]; }
            nv = row[1024 + h * 128 + dv]; ng = G[(tok + 1) * 4 + h]; nb = BETA[(tok + 1) * 4 + h];
        } else {
#pragma unroll
            for (int i = 0; i < 8; ++i) { nk[i] = 0.f; nq[i] = 0.f; }
        }
        const float al = expf(g);
        float p = 0.f;
#pragma unroll
        for (int i = 0; i < 8; ++i) { S[i] *= al; p += S[i] * kk[i]; }
        red1[kg][dvl] = p;
        __syncthreads();
        float ks = 0.f;
#pragma unroll
        for (int j = 0; j < 16; ++j) ks += red1[j][dvl];
        const float vn = be * (vv - ks);
        float o = 0.f;
#pragma unroll
        for (int i = 0; i < 8; ++i) { S[i] += kk[i] * vn; o += S[i] * qq[i]; }
        red2[kg][dvl] = o;
        __syncthreads();
        if (kg == 0) {
            float os = 0.f;
#pragma unroll
            for (int j = 0; j < 16; ++j) os += red2[j][dvl];
            O[tok * 512 + h * 128 + dv] = os;
        }
#pragma unroll
        for (int i = 0; i < 8; ++i) { kk[i] = nk[i]; qq[i] = nq[i]; }
        vv = nv; g = ng; be = nb;
    }
#pragma unroll
    for (int i = 0; i < 8; ++i) Sout[(((size_t)sq * 4 + h) * 128 + kg * 8 + i) * 128 + dv] = S[i];
}


__device__ __forceinline__ void gdn_step_sample_w(const float* __restrict__ QKV, const float* __restrict__ G, const float* __restrict__ BETA, const float* __restrict__ S0,
                                                  float* __restrict__ O, float* __restrict__ Sout, int item, int lane) {
    const int sl = item & 7, h = (item >> 3) & 3, sb = item >> 5, fr = lane & 15, fq = lane >> 4;
    const size_t tok = (size_t)NP + sb;
    const float* row = QKV + tok * 1536;
    const size_t sbase = (((size_t)sb * 4 + h) * 128 + fq * 32) * 128 + sl * 16 + fr;
    float S[32], kk[32], qq[32];
#pragma unroll
    for (int i = 0; i < 32; ++i) S[i] = S0[sbase + (size_t)i * 128];
#pragma unroll
    for (int i4 = 0; i4 < 8; ++i4) { const f32x4 k4 = *(const f32x4*)(row + 512 + h * 128 + fq * 32 + i4 * 4), q4 = *(const f32x4*)(row + h * 128 + fq * 32 + i4 * 4);
        kk[i4 * 4 + 0] = k4.x; kk[i4 * 4 + 1] = k4.y; kk[i4 * 4 + 2] = k4.z; kk[i4 * 4 + 3] = k4.w; qq[i4 * 4 + 0] = q4.x; qq[i4 * 4 + 1] = q4.y; qq[i4 * 4 + 2] = q4.z; qq[i4 * 4 + 3] = q4.w; }
    const float vv = row[1024 + h * 128 + sl * 16 + fr], al = expf(G[tok * 4 + h]), be = BETA[tok * 4 + h];
    float p = 0.f;
#pragma unroll
    for (int i = 0; i < 32; ++i) { S[i] *= al; p += S[i] * kk[i]; }
    p += __shfl_xor(p, 16); p += __shfl_xor(p, 32);
    const float vn = be * (vv - p);
    float o = 0.f;
#pragma unroll
    for (int i = 0; i < 32; ++i) { S[i] += kk[i] * vn; o += S[i] * qq[i]; }
    o += __shfl_xor(o, 16); o += __shfl_xor(o, 32);
    if (fq == 0) O[tok * 512 + h * 128 + sl * 16 + fr] = o;
#pragma unroll
    for (int i = 0; i < 32; ++i) Sout[sbase + (size_t)i * 128] = S[i];
}

__device__ __forceinline__ void lru_scan(const float* __restrict__ LA, float* __restrict__ LB, const float* __restrict__ h0,
                                         float* __restrict__ hlast, int tok_base, int T, int nseq, int bx) {
    int tx_ = threadIdx.x; asm volatile("" : "+v"(tx_));
    const int idx = bx * NTH + tx_;
    if (idx >= nseq * 512) return;
    const int sq = idx / 512, c = idx % 512;
    float h = h0 ? h0[(size_t)sq * 512 + c] : 0.f;
    const size_t base = ((size_t)tok_base + (size_t)sq * T) * 512 + c;
#pragma unroll 8
    for (int t = 0; t < T; ++t) {
        const size_t o = base + (size_t)t * 512;
        h = LA[o] * h + LB[o];
        LB[o] = h;
    }
    hlast[(size_t)sq * 512 + c] = h;
}

__device__ __forceinline__ void ab_mix_w(const bf16* __restrict__ PROJ, const float* __restrict__ O, const float* __restrict__ H, const float* __restrict__ P, const float* __restrict__ CIN,
                                         const float* __restrict__ norm_w, bf16* __restrict__ MIX, int t, int lane) {
    const bf16* prow = PROJ + (size_t)t * ABN;
#pragma unroll
    for (int jj = 0; jj < 2; ++jj) {
        const int c0 = 256 * jj + 4 * lane;
        const f32x4 o = *(const f32x4*)(O + (size_t)t * 512 + c0);
        const v2u zb = *(const v2u*)(prow + C_Z + c0);
        const f32x4 w = *(const f32x4*)(norm_w + (c0 & 127));
        float ss = (o.x * o.x + o.y * o.y) + (o.z * o.z + o.w * o.w);
        ss += DPPF(ss, 0xB1, 0xf); ss += DPPF(ss, 0x4E, 0xf); ss += DPPF(ss, 0x141, 0xf); ss += DPPF(ss, 0x140, 0xf);
        { const auto sw_ = __builtin_amdgcn_permlane16_swap(__float_as_uint(ss), __float_as_uint(ss), false, false); ss = __uint_as_float(sw_[0]) + __uint_as_float(sw_[1]); }
        const float sc = rsqrtf(ss * (1.0f / 128.0f) + 1e-6f);
        const float z0 = bflo(zb.x), z1 = bfhi(zb.x), z2 = bflo(zb.y), z3 = bfhi(zb.y);
        v2u ob;
        ob.x = pk2(o.x * sc * w.x * (z0 * __frcp_rn(1.0f + __expf(-z0))), o.y * sc * w.y * (z1 * __frcp_rn(1.0f + __expf(-z1))));
        ob.y = pk2(o.z * sc * w.z * (z2 * __frcp_rn(1.0f + __expf(-z2))), o.w * sc * w.w * (z3 * __frcp_rn(1.0f + __expf(-z3))));
        *(v2u*)(MIX + (size_t)t * 1024 + c0) = ob;
    }
#pragma unroll
    for (int jj = 0; jj < 2; ++jj) {
        const int c0 = 256 * jj + 4 * lane;
        const v2u gb = *(const v2u*)(prow + C_GATE + c0);
        f32x4 h = *(const f32x4*)(H + (size_t)t * 512 + c0);
        if (t < NP) { const f32x4 p = *(const f32x4*)(P + (size_t)t * 512 + c0), ci = *(const f32x4*)(CIN + (size_t)(t >> 6) * 512 + c0); h = h + p * ci; }
        v2u ob; ob.x = pk2(geluf_(bflo(gb.x)) * h.x, geluf_(bfhi(gb.x)) * h.y); ob.y = pk2(geluf_(bflo(gb.y)) * h.z, geluf_(bfhi(gb.y)) * h.w);
        *(v2u*)(MIX + (size_t)t * 1024 + 512 + c0) = ob;
    }
}

template <bool XBF>
__device__ __forceinline__ void ln_res_w(const void* __restrict__ xrow_, const bf16* __restrict__ yrow, const float* __restrict__ g, const float* __restrict__ bta,
                                         bf16* __restrict__ obrow, int lane) {
    f32x4 v[4]; float s = 0.f;
#pragma unroll
    for (int j = 0; j < 4; ++j) {
        f32x4 x4;
        if (XBF) { const v2u xb = ((const v2u*)xrow_)[lane + 64 * j]; x4 = (f32x4){bflo(xb.x), bfhi(xb.x), bflo(xb.y), bfhi(xb.y)}; }
        else x4 = ((const f32x4*)xrow_)[lane + 64 * j];
        const v2u yb = ((const v2u*)yrow)[lane + 64 * j];
        const f32x4 y4 = (f32x4){bflo(yb.x), bfhi(yb.x), bflo(yb.y), bfhi(yb.y)}; v[j] = x4 * ALPHA + y4; s += (v[j].x + v[j].y) + (v[j].z + v[j].w); }
    const float mean = wave_sum(s) * (1.0f / 1024.0f); float q = 0.f;
#pragma unroll
    for (int j = 0; j < 4; ++j) { v[j] = v[j] - mean; q += (v[j].x * v[j].x + v[j].y * v[j].y) + (v[j].z * v[j].z + v[j].w * v[j].w); }
    const float rs = rsqrtf(wave_sum(q) * (1.0f / 1024.0f) + LN_EPS);
#pragma unroll
    for (int j = 0; j < 4; ++j) {
        const f32x4 g4 = ((const f32x4*)g)[lane + 64 * j], b4 = ((const f32x4*)bta)[lane + 64 * j];
        const f32x4 o = v[j] * rs * g4 + b4;
        v2u ob; ob.x = pk2(o.x, o.y); ob.y = pk2(o.z, o.w);
        ((v2u*)obrow)[lane + 64 * j] = ob;
    }
}

__device__ __forceinline__ void peer_topk(const bf16* __restrict__ Q, const float* __restrict__ keys, int* __restrict__ EXP, float* __restrict__ GATE,
                                          int tg, int h, float* smem) {
    const int tid = threadIdx.x, cn = tid & 255, c = cn >> 7, n = cn & 127, th = tid >> 8;
    float (*sq)[256] = (float (*)[256])smem;
    float (*ss)[257] = (float (*)[257])(smem + 32 * 256);
    float (*tvs)[2][16] = (float (*)[2][16])(smem + 32 * 256 + 32 * 257 + 32);
    int (*tis)[2][16] = (int (*)[2][16])(smem + 32 * 256 + 32 * 257 + 32 + 1024);
    for (int i = tid; i < 32 * 256; i += NTH) {
        const int tk = i >> 8, col = i & 255;
        sq[tk][col] = bf2f(Q[(size_t)(tg * 32 + tk) * 2048 + h * 256 + col]);
    }
    __syncthreads();
    float acc[16];
#pragma unroll
    for (int i = 0; i < 16; ++i) acc[i] = 0.f;
    const float* krow = keys + (((size_t)h * 2 + c) * 128 + n) * 128;
    for (int d4 = 0; d4 < 32; ++d4) {
        const float4 kv = *(const float4*)(krow + d4 * 4);
#pragma unroll
        for (int tk = 0; tk < 16; ++tk) {
            const float4 qv = *(const float4*)&sq[th * 16 + tk][c * 128 + d4 * 4];
            acc[tk] += qv.x * kv.x + qv.y * kv.y + qv.z * kv.z + qv.w * kv.w;
        }
    }
#pragma unroll
    for (int tk = 0; tk < 16; ++tk) ss[th * 16 + tk][cn] = acc[tk];
    __syncthreads();
    if (tid < 64) {
        const int tk = tid >> 1, cc = tid & 1;
        float tv[16]; int ti[16];
#pragma unroll
        for (int j = 0; j < 16; ++j) { tv[j] = -INFINITY; ti[j] = 0; }
        for (int nn = 0; nn < 128; ++nn) {
            float x = ss[tk][cc * 128 + nn]; int xi = nn;
#pragma unroll
            for (int j = 0; j < 16; ++j) {
                const bool gt = x > tv[j];
                const float tf = tv[j]; const int tj = ti[j];
                tv[j] = gt ? x : tf; ti[j] = gt ? xi : tj;
                x = gt ? tf : x; xi = gt ? tj : xi;
            }
        }
#pragma unroll
        for (int j = 0; j < 16; ++j) { tvs[tk][cc][j] = tv[j]; tis[tk][cc][j] = ti[j]; }
    }
    __syncthreads();
    if (tid < 32) {
        const int tk = tid;
        float bv[16]; int bi[16];
#pragma unroll
        for (int j = 0; j < 16; ++j) { bv[j] = -INFINITY; bi[j] = 0; }
        for (int i = 0; i < 16; ++i)
            for (int jj = 0; jj < 16; ++jj) {
                float x = tvs[tk][0][i] + tvs[tk][1][jj]; int xi = tis[tk][0][i] * 128 + tis[tk][1][jj];
#pragma unroll
                for (int j = 0; j < 16; ++j) {
                    const bool gt = x > bv[j];
                    const float tf = bv[j]; const int tj = bi[j];
                    bv[j] = gt ? x : tf; bi[j] = gt ? xi : tj;
                    x = gt ? tf : x; xi = gt ? tj : xi;
                }
            }
        float e[16], sum = 0.f;
#pragma unroll
        for (int j = 0; j < 16; ++j) { e[j] = expf(bv[j] - bv[0]); sum += e[j]; }
        const float inv = 1.0f / sum;
        const size_t o = (size_t)(tg * 32 + tk) * 128 + h * 16;
#pragma unroll
        for (int j = 0; j < 16; ++j) { EXP[o + j] = bi[j]; GATE[o + j] = e[j] * inv; }
    }
}

__device__ __forceinline__ void peer_expert(const float* __restrict__ X, const int* __restrict__ EXP, const float* __restrict__ GATE,
                                            const float* __restrict__ U, const float* __restrict__ V,
                                            const float* __restrict__ g, const float* __restrict__ bta, float* __restrict__ out, bf16* __restrict__ outb, int t, float* smem) {
    const int tid = threadIdx.x, lane = tid & 63, wid = tid >> 6;
    float (*accs)[1024] = (float (*)[1024])smem;
    float* sred = smem + 8192;
    const float4* xr = (const float4*)(X + (size_t)t * D);
    float4 xv[4];
#pragma unroll
    for (int j = 0; j < 4; ++j) xv[j] = xr[lane + 64 * j];
    float4 acc[4];
#pragma unroll
    for (int j = 0; j < 4; ++j) acc[j] = make_float4(0.f, 0.f, 0.f, 0.f);
    for (int e = 0; e < 16; ++e) {
        const int id = EXP[(size_t)t * 128 + wid * 16 + e];
        const float gt = GATE[(size_t)t * 128 + wid * 16 + e];
        const float4* ur = (const float4*)(U + (size_t)id * D);
        const float4* vr = (const float4*)(V + (size_t)id * D);
        float4 uv[4], vv[4];
#pragma unroll
        for (int j = 0; j < 4; ++j) { uv[j] = ur[lane + 64 * j]; vv[j] = vr[lane + 64 * j]; }
        float dot = 0.f;
#pragma unroll
        for (int j = 0; j < 4; ++j) dot += uv[j].x * xv[j].x + uv[j].y * xv[j].y + uv[j].z * xv[j].z + uv[j].w * xv[j].w;
        dot = wave_sum(dot);
        const float cf = gt * geluf_(dot);
#pragma unroll
        for (int j = 0; j < 4; ++j) { acc[j].x += cf * vv[j].x; acc[j].y += cf * vv[j].y; acc[j].z += cf * vv[j].z; acc[j].w += cf * vv[j].w; }
    }
#pragma unroll
    for (int j = 0; j < 4; ++j) *(float4*)&accs[wid][(lane + 64 * j) * 4] = acc[j];
    __syncthreads();
    float v[2];
#pragma unroll
    for (int i = 0; i < 2; ++i) {
        const int c = tid * 2 + i;
        float s = 0.f;
#pragma unroll
        for (int w = 0; w < 8; ++w) s += accs[w][c];
        v[i] = ALPHA * X[(size_t)t * D + c] + s;
    }
    float s = wave_sum(v[0] + v[1]);
    if (lane == 0) sred[wid] = s;
    __syncthreads();
    float mean = 0.f;
#pragma unroll
    for (int w = 0; w < 8; ++w) mean += sred[w];
    mean *= (1.0f / 1024.0f);
    __syncthreads();
    const float d0 = v[0] - mean, d1 = v[1] - mean;
    float q = wave_sum(d0 * d0 + d1 * d1);
    if (lane == 0) sred[wid] = q;
    __syncthreads();
    float var = 0.f;
#pragma unroll
    for (int w = 0; w < 8; ++w) var += sred[w];
    const float rs = rsqrtf(var * (1.0f / 1024.0f) + LN_EPS);
    const float o0 = d0 * rs * g[tid * 2] + bta[tid * 2], o1 = d1 * rs * g[tid * 2 + 1] + bta[tid * 2 + 1];
    *(float2*)(out + (size_t)t * D + tid * 2) = make_float2(o0, o1);
    if (outb) *(unsigned*)(outb + (size_t)t * D + tid * 2) = pk2(o0, o1);
}


typedef __bf16 bf16x2_t __attribute__((ext_vector_type(2)));
__device__ __forceinline__ float dot2bf(unsigned w, unsigned x, float acc) { return __builtin_amdgcn_fdot2_f32_bf16(__builtin_bit_cast(bf16x2_t, w), __builtin_bit_cast(bf16x2_t, x), acc, false); }
typedef float f32x2_t __attribute__((ext_vector_type(2)));
__device__ __forceinline__ void row_to_fp8(const float* __restrict__ xrow, unsigned char* __restrict__ orow, float* __restrict__ scale, int lane) {
    f32x4 v[4]; float am = 0.f;
#pragma unroll
    for (int j = 0; j < 4; ++j) { v[j] = *(const f32x4*)(xrow + lane * 16 + j * 4); am = fmaxf(am, fmaxf(fmaxf(fabsf(v[j].x), fabsf(v[j].y)), fmaxf(fabsf(v[j].z), fabsf(v[j].w)))); }
    am = wave_max(am);
    const float s = am > 0.f ? am * (1.0f / 448.0f) : 1.0f, inv = 1.0f / s;
    v4u o;
    unsigned w;
    w = 0u; w = __builtin_amdgcn_cvt_pk_fp8_f32(v[0].x * inv, v[0].y * inv, w, false); w = __builtin_amdgcn_cvt_pk_fp8_f32(v[0].z * inv, v[0].w * inv, w, true); o.x = w;
    w = 0u; w = __builtin_amdgcn_cvt_pk_fp8_f32(v[1].x * inv, v[1].y * inv, w, false); w = __builtin_amdgcn_cvt_pk_fp8_f32(v[1].z * inv, v[1].w * inv, w, true); o.y = w;
    w = 0u; w = __builtin_amdgcn_cvt_pk_fp8_f32(v[2].x * inv, v[2].y * inv, w, false); w = __builtin_amdgcn_cvt_pk_fp8_f32(v[2].z * inv, v[2].w * inv, w, true); o.z = w;
    w = 0u; w = __builtin_amdgcn_cvt_pk_fp8_f32(v[3].x * inv, v[3].y * inv, w, false); w = __builtin_amdgcn_cvt_pk_fp8_f32(v[3].z * inv, v[3].w * inv, w, true); o.w = w;
    *(v4u*)(orow + lane * 16) = o;
    if (lane == 0) *scale = s;
}
#define PE_LOAD(UB, VB, grp) do { _Pragma("unroll") for (int i_ = 0; i_ < 4; ++i_) { const int e_ = (grp) * 4 + i_; \
        const int id_ = __builtin_amdgcn_readlane(e_ < 64 ? id0 : id1, e_ & 63); \
        const unsigned so_ = (unsigned)id_ * 1024u; \
        UB[i_] = __builtin_amdgcn_raw_buffer_load_b128(ursrc, voff, so_, 0); VB[i_] = __builtin_amdgcn_raw_buffer_load_b128(vrsrc, voff, so_, 0); } } while (0)
#define PE_DOT4(w, k) do { const f32x2_t l_ = __builtin_amdgcn_cvt_pk_f32_fp8((w), false), h_ = __builtin_amdgcn_cvt_pk_f32_fp8((w), true); \
        a_ += l_.x * xv[(k) * 4 + 0]; b_ += l_.y * xv[(k) * 4 + 1]; a_ += h_.x * xv[(k) * 4 + 2]; b_ += h_.y * xv[(k) * 4 + 3]; } while (0)
#define PE_AXPY4(w, k) do { const f32x2_t l_ = __builtin_amdgcn_cvt_pk_f32_fp8((w), false), h_ = __builtin_amdgcn_cvt_pk_f32_fp8((w), true); \
        acc[(k) * 4 + 0] += cf_ * l_.x; acc[(k) * 4 + 1] += cf_ * l_.y; acc[(k) * 4 + 2] += cf_ * h_.x; acc[(k) * 4 + 3] += cf_ * h_.y; } while (0)
#define PE_COMP(UB, VB, grp) do { float d_[4]; \
        _Pragma("unroll") for (int i_ = 0; i_ < 4; ++i_) { float a_ = 0.f, b_ = 0.f; PE_DOT4(UB[i_].x, 0); PE_DOT4(UB[i_].y, 1); PE_DOT4(UB[i_].z, 2); PE_DOT4(UB[i_].w, 3); d_[i_] = a_ + b_; } \
          \
        float s0_ = hi32 ? d_[2] : d_[0], t0_ = hi32 ? d_[0] : d_[2]; s0_ += __shfl_xor(t0_, 32); \
        float s1_ = hi32 ? d_[3] : d_[1], t1_ = hi32 ? d_[1] : d_[3]; s1_ += __shfl_xor(t1_, 32); \
        float r_ = hi16 ? s1_ : s0_, t2_ = hi16 ? s0_ : s1_; r_ += __shfl_xor(t2_, 16); \
        r_ += __shfl_xor(r_, 8); r_ += __shfl_xor(r_, 4); r_ += __shfl_xor(r_, 2); r_ += __shfl_xor(r_, 1); \
          \
        const int esel_ = (grp) * 4 + (lane >> 4); \
        const float su_ = __shfl(esel_ < 64 ? su0 : su1, esel_ & 63), gv_ = __shfl(esel_ < 64 ? gs0 : gs1, esel_ & 63); \
        const float cfl_ = geluf_(r_ * su_) * gv_; \
        _Pragma("unroll") for (int i_ = 0; i_ < 4; ++i_) { \
            const float cf_ = __uint_as_float(__builtin_amdgcn_readlane(__float_as_uint(cfl_), 16 * i_)); \
            PE_AXPY4(VB[i_].x, 0); PE_AXPY4(VB[i_].y, 1); PE_AXPY4(VB[i_].z, 2); PE_AXPY4(VB[i_].w, 3); } } while (0)
__device__ __forceinline__ void peer_expert_w(const float* __restrict__ xrow, const int* __restrict__ exr, const float* __restrict__ gar,
                                              const unsigned char* __restrict__ U, const unsigned char* __restrict__ V, const float* __restrict__ SU, const float* __restrict__ SV,
                                              const float* __restrict__ g, const float* __restrict__ bta, float* __restrict__ orow, bf16* __restrict__ obrow, int lane) {
    const bool hi32 = (lane & 32) != 0, hi16 = (lane & 16) != 0;
    const __amdgpu_buffer_rsrc_t ursrc = __builtin_amdgcn_make_buffer_rsrc((void*)U, 0, 16384 * 1024, 0x00020000);
    const __amdgpu_buffer_rsrc_t vrsrc = __builtin_amdgcn_make_buffer_rsrc((void*)V, 0, 16384 * 1024, 0x00020000);
    const int voff = lane * 16;
    float xv[16];
#pragma unroll
    for (int j = 0; j < 4; ++j) { const f32x4 t = *(const f32x4*)(xrow + lane * 16 + j * 4); xv[j * 4 + 0] = t.x; xv[j * 4 + 1] = t.y; xv[j * 4 + 2] = t.z; xv[j * 4 + 3] = t.w; }
    const int id0 = exr[lane], id1 = exr[64 + lane];
    const float su0 = SU[id0], su1 = SU[id1];
    const float gs0 = gar[lane] * SV[id0], gs1 = gar[64 + lane] * SV[id1];
    float acc[16];
#pragma unroll
    for (int i = 0; i < 16; ++i) acc[i] = 0.f;
    v4u ua[4], va[4], ub[4], vb[4];
    PE_LOAD(ua, va, 0);
#pragma unroll 1
    for (int grp = 0; grp < 32; grp += 2) {
        PE_LOAD(ub, vb, grp + 1);
        PE_COMP(ua, va, grp);
        if (grp + 2 < 32) PE_LOAD(ua, va, grp + 2);
        PE_COMP(ub, vb, grp + 1);
    }
    float v[16]; float s = 0.f;
#pragma unroll
    for (int i = 0; i < 16; ++i) { v[i] = ALPHA * xv[i] + acc[i]; s += v[i]; }
    const float mean = wave_sum(s) * (1.0f / 1024.0f); float q = 0.f;
#pragma unroll
    for (int i = 0; i < 16; ++i) { v[i] -= mean; q += v[i] * v[i]; }
    const float rs = rsqrtf(wave_sum(q) * (1.0f / 1024.0f) + LN_EPS);
    float o[16];
#pragma unroll
    for (int j = 0; j < 4; ++j) {
        const f32x4 g4 = *(const f32x4*)(g + lane * 16 + j * 4), b4 = *(const f32x4*)(bta + lane * 16 + j * 4);
        o[j * 4 + 0] = v[j * 4 + 0] * rs * g4.x + b4.x; o[j * 4 + 1] = v[j * 4 + 1] * rs * g4.y + b4.y; o[j * 4 + 2] = v[j * 4 + 2] * rs * g4.z + b4.z; o[j * 4 + 3] = v[j * 4 + 3] * rs * g4.w + b4.w;
        *(f32x4*)(orow + lane * 16 + j * 4) = (f32x4){o[j * 4 + 0], o[j * 4 + 1], o[j * 4 + 2], o[j * 4 + 3]};
    }
    if (obrow) {
        v4u w0, w1; w0.x = pk2(o[0], o[1]); w0.y = pk2(o[2], o[3]); w0.z = pk2(o[4], o[5]); w0.w = pk2(o[6], o[7]); w1.x = pk2(o[8], o[9]); w1.y = pk2(o[10], o[11]); w1.z = pk2(o[12], o[13]); w1.w = pk2(o[14], o[15]);
        *(v4u*)(obrow + lane * 16) = w0; *(v4u*)(obrow + lane * 16 + 8) = w1;
    }
}


__device__ __forceinline__ void peer_expert_blk(const float* __restrict__ xrow, const int* __restrict__ exr, const float* __restrict__ gar,
                                                const unsigned char* __restrict__ U, const unsigned char* __restrict__ V, const float* __restrict__ SU, const float* __restrict__ SV,
                                                const float* __restrict__ g, const float* __restrict__ bta, float* __restrict__ orow, bf16* __restrict__ obrow, int lane, int wave, float* smem) {
    const bool hi32 = (lane & 32) != 0, hi16 = (lane & 16) != 0;
    const __amdgpu_buffer_rsrc_t ursrc = __builtin_amdgcn_make_buffer_rsrc((void*)U, 0, 16384 * 1024, 0x00020000);
    const __amdgpu_buffer_rsrc_t vrsrc = __builtin_amdgcn_make_buffer_rsrc((void*)V, 0, 16384 * 1024, 0x00020000);
    const int voff = lane * 16;
    float xv[16];
#pragma unroll
    for (int j = 0; j < 4; ++j) { const f32x4 t = *(const f32x4*)(xrow + lane * 16 + j * 4); xv[j * 4 + 0] = t.x; xv[j * 4 + 1] = t.y; xv[j * 4 + 2] = t.z; xv[j * 4 + 3] = t.w; }
    const int id0 = exr[lane], id1 = exr[64 + lane];
    const float su0 = SU[id0], su1 = SU[id1];
    const float gs0 = gar[lane] * SV[id0], gs1 = gar[64 + lane] * SV[id1];
    float acc[16];
#pragma unroll
    for (int i = 0; i < 16; ++i) acc[i] = 0.f;
    v4u ua[4], va[4], ub[4], vb[4];
    const int g0 = wave * 4;
    PE_LOAD(ua, va, g0); PE_LOAD(ub, vb, g0 + 1);
    PE_COMP(ua, va, g0); PE_LOAD(ua, va, g0 + 2);
    PE_COMP(ub, vb, g0 + 1); PE_LOAD(ub, vb, g0 + 3);
    PE_COMP(ua, va, g0 + 2);
    PE_COMP(ub, vb, g0 + 3);
    float* accs = smem;
    float* sred = smem + 8192;
#pragma unroll
    for (int j = 0; j < 4; ++j) *(f32x4*)(accs + wave * 1024 + lane * 16 + j * 4) = (f32x4){acc[j * 4 + 0], acc[j * 4 + 1], acc[j * 4 + 2], acc[j * 4 + 3]};
    __syncthreads();
    const int tid = wave * 64 + lane;
    float v0 = ALPHA * xrow[tid * 2], v1 = ALPHA * xrow[tid * 2 + 1];
#pragma unroll
    for (int w = 0; w < 8; ++w) { v0 += accs[w * 1024 + tid * 2]; v1 += accs[w * 1024 + tid * 2 + 1]; }
    const float s = wave_sum(v0 + v1);
    if (lane == 0) sred[wave] = s;
    __syncthreads();
    float mean = 0.f;
#pragma unroll
    for (int w = 0; w < 8; ++w) mean += sred[w];
    mean *= (1.0f / 1024.0f);
    __syncthreads();
    const float d0 = v0 - mean, d1 = v1 - mean;
    const float q = wave_sum(d0 * d0 + d1 * d1);
    if (lane == 0) sred[wave] = q;
    __syncthreads();
    float var = 0.f;
#pragma unroll
    for (int w = 0; w < 8; ++w) var += sred[w];
    const float rs = rsqrtf(var * (1.0f / 1024.0f) + LN_EPS);
    const float o0 = d0 * rs * g[tid * 2] + bta[tid * 2], o1 = d1 * rs * g[tid * 2 + 1] + bta[tid * 2 + 1];
    *(float2*)(orow + tid * 2) = make_float2(o0, o1);
    if (obrow) *(unsigned*)(obrow + tid * 2) = pk2(o0, o1);
    __syncthreads();
}

__device__ __forceinline__ void row_to_fp8_sliced(const float* __restrict__ xrow, unsigned char* __restrict__ tab, int r, float* __restrict__ scale, int lane) {
    f32x4 v[4]; float am = 0.f;
#pragma unroll
    for (int j = 0; j < 4; ++j) { v[j] = *(const f32x4*)(xrow + lane * 16 + j * 4); am = fmaxf(am, fmaxf(fmaxf(fabsf(v[j].x), fabsf(v[j].y)), fmaxf(fabsf(v[j].z), fabsf(v[j].w)))); }
    am = wave_max(am);
    const float s = am > 0.f ? am * (1.0f / 448.0f) : 1.0f, inv = 1.0f / s;
    v4u o; unsigned w;
    w = 0u; w = __builtin_amdgcn_cvt_pk_fp8_f32(v[0].x * inv, v[0].y * inv, w, false); w = __builtin_amdgcn_cvt_pk_fp8_f32(v[0].z * inv, v[0].w * inv, w, true); o.x = w;
    w = 0u; w = __builtin_amdgcn_cvt_pk_fp8_f32(v[1].x * inv, v[1].y * inv, w, false); w = __builtin_amdgcn_cvt_pk_fp8_f32(v[1].z * inv, v[1].w * inv, w, true); o.y = w;
    w = 0u; w = __builtin_amdgcn_cvt_pk_fp8_f32(v[2].x * inv, v[2].y * inv, w, false); w = __builtin_amdgcn_cvt_pk_fp8_f32(v[2].z * inv, v[2].w * inv, w, true); o.z = w;
    w = 0u; w = __builtin_amdgcn_cvt_pk_fp8_f32(v[3].x * inv, v[3].y * inv, w, false); w = __builtin_amdgcn_cvt_pk_fp8_f32(v[3].z * inv, v[3].w * inv, w, true); o.w = w;
    *(v4u*)(tab + ((size_t)(lane >> 3) * 16384 + r) * 128 + (lane & 7) * 16) = o;
    if (lane == 0) *scale = s;
}
__device__ __forceinline__ void row_to_i8_sliced(const float* __restrict__ xrow, unsigned char* __restrict__ tab, int r, float* __restrict__ scale, int lane) {
    f32x4 v[4]; float am = 0.f;
#pragma unroll
    for (int j = 0; j < 4; ++j) { v[j] = *(const f32x4*)(xrow + lane * 16 + j * 4); am = fmaxf(am, fmaxf(fmaxf(fabsf(v[j].x), fabsf(v[j].y)), fmaxf(fabsf(v[j].z), fabsf(v[j].w)))); }
    am = wave_max(am);
    const float s = am > 0.f ? am * (1.0f / 127.0f) : 1.0f, inv = 1.0f / s;
    v4u o;
#define I8PK(q_) (((unsigned)(int)rintf((q_).x * inv) & 0xffu) | (((unsigned)(int)rintf((q_).y * inv) & 0xffu) << 8) | (((unsigned)(int)rintf((q_).z * inv) & 0xffu) << 16) | (((unsigned)(int)rintf((q_).w * inv) & 0xffu) << 24))
    o.x = I8PK(v[0]); o.y = I8PK(v[1]); o.z = I8PK(v[2]); o.w = I8PK(v[3]);
    *(v4u*)(tab + ((size_t)(lane >> 3) * 16384 + r) * 128 + (lane & 7) * 16) = o;
    if (lane == 0) *scale = s;
}

template <bool FP8>
__device__ __forceinline__ void table_rows_convert(const float* __restrict__ src, unsigned char* __restrict__ tab, float* __restrict__ scales, int rbeg, int rend, int gw, int ngw, int lane) {
    for (int r0 = rbeg + gw; r0 < rend; r0 += 4 * ngw) {
        f32x4 v[4][4]; int rr[4]; float am[4];
#pragma unroll
        for (int i = 0; i < 4; ++i) { rr[i] = r0 + i * ngw < rend ? r0 + i * ngw : rend - 1;
#pragma unroll
            for (int j = 0; j < 4; ++j) v[i][j] = *(const f32x4*)(src + (size_t)rr[i] * D + j * 256 + lane * 4); }
#pragma unroll
        for (int i = 0; i < 4; ++i) { float a = 0.f;
#pragma unroll
            for (int j = 0; j < 4; ++j) a = fmaxf(a, fmaxf(fmaxf(fabsf(v[i][j].x), fabsf(v[i][j].y)), fmaxf(fabsf(v[i][j].z), fabsf(v[i][j].w))));
            am[i] = a; }
#pragma unroll
        for (int i = 0; i < 4; ++i) am[i] = wave_max(am[i]);
#pragma unroll
        for (int i = 0; i < 4; ++i) {
            const float s = am[i] > 0.f ? am[i] * (FP8 ? 1.0f / 448.0f : 1.0f / 127.0f) : 1.0f, inv = 1.0f / s;
#pragma unroll
            for (int j = 0; j < 4; ++j) {
                unsigned w;
                if (FP8) { w = 0u; w = __builtin_amdgcn_cvt_pk_fp8_f32(v[i][j].x * inv, v[i][j].y * inv, w, false); w = __builtin_amdgcn_cvt_pk_fp8_f32(v[i][j].z * inv, v[i][j].w * inv, w, true); }
                else w = ((unsigned)(int)rintf(v[i][j].x * inv) & 0xffu) | (((unsigned)(int)rintf(v[i][j].y * inv) & 0xffu) << 8) | (((unsigned)(int)rintf(v[i][j].z * inv) & 0xffu) << 16) | (((unsigned)(int)rintf(v[i][j].w * inv) & 0xffu) << 24);
                *(unsigned*)(tab + ((size_t)(2 * j + (lane >> 5)) * 16384 + rr[i]) * 128 + (lane & 31) * 4) = w;
            }
            if (lane == 0) scales[rr[i]] = s;
        }
    }
}
__device__ __forceinline__ void peer_u_pass(const bf16* __restrict__ xrow, const int* __restrict__ exr, const unsigned char* __restrict__ U8x, float* __restrict__ pd, int x, int lane) {
    const int e8 = lane >> 3, c = lane & 7;
    f32x2_t xp[8];
#pragma unroll
    for (int j = 0; j < 2; ++j) { const v4u t = *(const v4u*)(xrow + x * 128 + c * 16 + j * 8);
        xp[j * 4 + 0] = (f32x2_t){bflo(t.x), bfhi(t.x)}; xp[j * 4 + 1] = (f32x2_t){bflo(t.y), bfhi(t.y)}; xp[j * 4 + 2] = (f32x2_t){bflo(t.z), bfhi(t.z)}; xp[j * 4 + 3] = (f32x2_t){bflo(t.w), bfhi(t.w)}; }
    const __amdgpu_buffer_rsrc_t ursrc = __builtin_amdgcn_make_buffer_rsrc((void*)U8x, 0, 16384 * 128, 0x00020000);
    v4u wa[8], wb[8];
    float d[16];
    int ids[16];
#pragma unroll
    for (int j = 0; j < 4; ++j) { const v4u t = *(const v4u*)(exr + e8 * 16 + j * 4); ids[j * 4 + 0] = (int)t.x; ids[j * 4 + 1] = (int)t.y; ids[j * 4 + 2] = (int)t.z; ids[j * 4 + 3] = (int)t.w; }
#pragma unroll
    for (int g = 0; g < 8; ++g) wa[g] = __builtin_amdgcn_raw_buffer_load_b128(ursrc, ids[g] * 128 + c * 16, 0, 0);
#pragma unroll
    for (int g = 0; g < 8; ++g) wb[g] = __builtin_amdgcn_raw_buffer_load_b128(ursrc, ids[8 + g] * 128 + c * 16, 0, 0);
#define PU_DOT1(w_, k_) do { a_ = __builtin_elementwise_fma(__builtin_amdgcn_cvt_pk_f32_fp8((w_), false), xp[(k_) * 2], a_); a_ = __builtin_elementwise_fma(__builtin_amdgcn_cvt_pk_f32_fp8((w_), true), xp[(k_) * 2 + 1], a_); } while (0)
#pragma unroll
    for (int g = 0; g < 8; ++g) { f32x2_t a_ = (f32x2_t){0.f, 0.f}; PU_DOT1(wa[g].x, 0); PU_DOT1(wa[g].y, 1); PU_DOT1(wa[g].z, 2); PU_DOT1(wa[g].w, 3); d[g] = a_.x + a_.y; }
#pragma unroll
    for (int g = 0; g < 8; ++g) { f32x2_t a_ = (f32x2_t){0.f, 0.f}; PU_DOT1(wb[g].x, 0); PU_DOT1(wb[g].y, 1); PU_DOT1(wb[g].z, 2); PU_DOT1(wb[g].w, 3); d[8 + g] = a_.x + a_.y; }
#pragma unroll
    for (int g = 0; g < 16; ++g) { d[g] += DPPF(d[g], 0xB1, 0xf); d[g] += DPPF(d[g], 0x4E, 0xf); d[g] += DPPF(d[g], 0x141, 0xf); }
    if (c == 0) {
#pragma unroll
        for (int j = 0; j < 4; ++j) *(f32x4*)(pd + e8 * 16 + j * 4) = (f32x4){d[j * 4 + 0], d[j * 4 + 1], d[j * 4 + 2], d[j * 4 + 3]};
    }
}
#define PUL_IDS(I, k_) do { const int t_ = ((tg0 + ((k_) < nit ? (k_) : nit - 1) * tgstep) * 8 + wave); _Pragma("unroll") for (int j = 0; j < 4; ++j) I[j] = *(const v4u*)(EXPp + (size_t)t_ * 128 + e8 * 16 + j * 4); } while (0)
#define PUL_ROWS(R, X, I, k_) do { const int t_ = ((tg0 + ((k_) < nit ? (k_) : nit - 1) * tgstep) * 8 + wave); \
        X[0] = *(const v4u*)(XBp + (size_t)t_ * D + x * 128 + c * 16); X[1] = *(const v4u*)(XBp + (size_t)t_ * D + x * 128 + c * 16 + 8); \
        _Pragma("unroll") for (int j = 0; j < 4; ++j) { R[j * 4 + 0] = __builtin_amdgcn_raw_buffer_load_b128(ursrc, (int)I[j].x * 128 + c * 16, 0, 0); R[j * 4 + 1] = __builtin_amdgcn_raw_buffer_load_b128(ursrc, (int)I[j].y * 128 + c * 16, 0, 0); \
            R[j * 4 + 2] = __builtin_amdgcn_raw_buffer_load_b128(ursrc, (int)I[j].z * 128 + c * 16, 0, 0); R[j * 4 + 3] = __builtin_amdgcn_raw_buffer_load_b128(ursrc, (int)I[j].w * 128 + c * 16, 0, 0); } } while (0)
#define PUL_COMP(R, X, k_) do { float xf_[16]; \
        _Pragma("unroll") for (int j = 0; j < 2; ++j) { xf_[j * 8 + 0] = bflo(X[j].x); xf_[j * 8 + 1] = bfhi(X[j].x); xf_[j * 8 + 2] = bflo(X[j].y); xf_[j * 8 + 3] = bfhi(X[j].y); xf_[j * 8 + 4] = bflo(X[j].z); xf_[j * 8 + 5] = bfhi(X[j].z); xf_[j * 8 + 6] = bflo(X[j].w); xf_[j * 8 + 7] = bfhi(X[j].w); } \
          \
        float am_ = 0.f; _Pragma("unroll") for (int i = 0; i < 16; ++i) am_ = fmaxf(am_, fabsf(xf_[i])); \
        am_ = fmaxf(am_, DPPF(am_, 0xB1, 0xf)); am_ = fmaxf(am_, DPPF(am_, 0x4E, 0xf)); am_ = fmaxf(am_, DPPF(am_, 0x141, 0xf)); \
        const float sx_ = am_ > 0.f ? am_ * (1.0f / 127.0f) : 1.0f, ix_ = 1.0f / sx_; \
        int xq_[4]; \
        _Pragma("unroll") for (int j = 0; j < 4; ++j) xq_[j] = (int)(((unsigned)(int)rintf(xf_[j * 4 + 0] * ix_) & 0xffu) | (((unsigned)(int)rintf(xf_[j * 4 + 1] * ix_) & 0xffu) << 8) | (((unsigned)(int)rintf(xf_[j * 4 + 2] * ix_) & 0xffu) << 16) | (((unsigned)(int)rintf(xf_[j * 4 + 3] * ix_) & 0xffu) << 24)); \
        float d[16]; \
        _Pragma("unroll") for (int g = 0; g < 16; ++g) { int a_ = __builtin_amdgcn_sdot4((int)R[g].x, xq_[0], 0, false); a_ = __builtin_amdgcn_sdot4((int)R[g].y, xq_[1], a_, false); a_ = __builtin_amdgcn_sdot4((int)R[g].z, xq_[2], a_, false); a_ = __builtin_amdgcn_sdot4((int)R[g].w, xq_[3], a_, false); d[g] = (float)a_; } \
        _Pragma("unroll") for (int g = 0; g < 16; ++g) { d[g] += DPPF(d[g], 0xB1, 0xf); d[g] += DPPF(d[g], 0x4E, 0xf); d[g] += DPPF(d[g], 0x141, 0xf); d[g] *= sx_; } \
        if (c == 0 && (k_) < nit) { float* pd_ = PDx + (size_t)((tg0 + (k_) * tgstep) * 8 + wave) * 128 + e8 * 16; \
            _Pragma("unroll") for (int j = 0; j < 4; ++j) *(f32x4*)(pd_ + j * 4) = (f32x4){d[j * 4 + 0], d[j * 4 + 1], d[j * 4 + 2], d[j * 4 + 3]}; } } while (0)
__device__ __forceinline__ void peer_u_loop(const bf16* __restrict__ XBp, const int* __restrict__ EXPp, const unsigned char* __restrict__ U8x, float* __restrict__ PDx, int x, int tg0, int tgstep, int nit, int wave, int lane) {
    const int e8 = lane >> 3, c = lane & 7;
    const __amdgpu_buffer_rsrc_t ursrc = __builtin_amdgcn_make_buffer_rsrc((void*)U8x, 0, 16384 * 128, 0x00020000);
    v4u ra[16], rb[16], xa[2], xb[2], i0[4], i1[4];
    PUL_IDS(i0, 0);
    PUL_ROWS(ra, xa, i0, 0);
    PUL_IDS(i1, 1);
#pragma unroll 1
    for (int k = 0; k < nit; k += 2) {
        PUL_ROWS(rb, xb, i1, k + 1);
        PUL_IDS(i0, k + 2);
        PUL_COMP(ra, xa, k);
        PUL_ROWS(ra, xa, i0, k + 2);
        PUL_IDS(i1, k + 3);
        PUL_COMP(rb, xb, k + 1);
    }
}
#define PV_LOAD(VB, grp) do { _Pragma("unroll") for (int i_ = 0; i_ < 4; ++i_) { const int e_ = (grp) * 4 + i_; \
        const int id_ = __builtin_amdgcn_readlane(e_ < 64 ? id0 : id1, e_ & 63); \
        VB[i_] = __builtin_amdgcn_raw_buffer_load_b128(vrsrc, voff, (unsigned)id_ * 1024u, 0); } } while (0)
#define PV_COMP(VB, grp) do { _Pragma("unroll") for (int i_ = 0; i_ < 4; ++i_) { const int e_ = (grp) * 4 + i_; \
        const float cf_ = __uint_as_float(__builtin_amdgcn_readlane(__float_as_uint(e_ < 64 ? cf0 : cf1), e_ & 63)); \
        PE_AXPY4(VB[i_].x, 0); PE_AXPY4(VB[i_].y, 1); PE_AXPY4(VB[i_].z, 2); PE_AXPY4(VB[i_].w, 3); } } while (0)
#define PV_COEFS() \
    const int id0 = exr[lane], id1 = exr[64 + lane]; \
    float dot0 = 0.f, dot1 = 0.f; \
    { const int p0 = lane, p1 = 64 + lane;        \
      _Pragma("unroll") for (int x_ = 0; x_ < 8; ++x_) { dot0 += pdt[(size_t)x_ * NT * 128 + p0]; dot1 += pdt[(size_t)x_ * NT * 128 + p1]; } } \
    const float cf0 = gar[lane] * SV[id0] * geluf_(SU[id0] * dot0), cf1 = gar[64 + lane] * SV[id1] * geluf_(SU[id1] * dot1);
__device__ __forceinline__ void peer_v_w(const float* __restrict__ xrow, const int* __restrict__ exr, const float* __restrict__ gar, const float* __restrict__ pdt,
                                         const unsigned char* __restrict__ V, const float* __restrict__ SU, const float* __restrict__ SV,
                                         const float* __restrict__ g, const float* __restrict__ bta, float* __restrict__ orow, bf16* __restrict__ obrow, int lane) {
    const __amdgpu_buffer_rsrc_t vrsrc = __builtin_amdgcn_make_buffer_rsrc((void*)V, 0, 16384 * 1024, 0x00020000);
    const int voff = lane * 16;
    PV_COEFS()
    float acc[16];
#pragma unroll
    for (int i = 0; i < 16; ++i) acc[i] = 0.f;
    v4u va[4], vb[4], vc[4];
    PV_LOAD(va, 0); PV_LOAD(vb, 1);
#pragma unroll 1
    for (int grp = 0; grp < 30; grp += 3) {
        PV_LOAD(vc, grp + 2);
        PV_COMP(va, grp);
        PV_LOAD(va, grp + 3);
        PV_COMP(vb, grp + 1);
        PV_LOAD(vb, grp + 4);
        PV_COMP(vc, grp + 2);
    }
    PV_COMP(va, 30); PV_COMP(vb, 31);
    float xv[16];
#pragma unroll
    for (int j = 0; j < 4; ++j) { const f32x4 t = *(const f32x4*)(xrow + lane * 16 + j * 4); xv[j * 4 + 0] = t.x; xv[j * 4 + 1] = t.y; xv[j * 4 + 2] = t.z; xv[j * 4 + 3] = t.w; }
    float v[16]; float s = 0.f;
#pragma unroll
    for (int i = 0; i < 16; ++i) { v[i] = ALPHA * xv[i] + acc[i]; s += v[i]; }
    const float mean = wave_sum(s) * (1.0f / 1024.0f); float q = 0.f;
#pragma unroll
    for (int i = 0; i < 16; ++i) { v[i] -= mean; q += v[i] * v[i]; }
    const float rs = rsqrtf(wave_sum(q) * (1.0f / 1024.0f) + LN_EPS);
    float o[16];
#pragma unroll
    for (int j = 0; j < 4; ++j) {
        const f32x4 g4 = *(const f32x4*)(g + lane * 16 + j * 4), b4 = *(const f32x4*)(bta + lane * 16 + j * 4);
        o[j * 4 + 0] = v[j * 4 + 0] * rs * g4.x + b4.x; o[j * 4 + 1] = v[j * 4 + 1] * rs * g4.y + b4.y; o[j * 4 + 2] = v[j * 4 + 2] * rs * g4.z + b4.z; o[j * 4 + 3] = v[j * 4 + 3] * rs * g4.w + b4.w;
        *(f32x4*)(orow + lane * 16 + j * 4) = (f32x4){o[j * 4 + 0], o[j * 4 + 1], o[j * 4 + 2], o[j * 4 + 3]};
    }
    if (obrow) {
        v4u w0, w1; w0.x = pk2(o[0], o[1]); w0.y = pk2(o[2], o[3]); w0.z = pk2(o[4], o[5]); w0.w = pk2(o[6], o[7]); w1.x = pk2(o[8], o[9]); w1.y = pk2(o[10], o[11]); w1.z = pk2(o[12], o[13]); w1.w = pk2(o[14], o[15]);
        *(v4u*)(obrow + lane * 16) = w0; *(v4u*)(obrow + lane * 16 + 8) = w1;
    }
}
__device__ __forceinline__ void peer_v_blk(const float* __restrict__ xrow, const int* __restrict__ exr, const float* __restrict__ gar, const float* __restrict__ pdt,
                                           const unsigned char* __restrict__ V, const float* __restrict__ SU, const float* __restrict__ SV,
                                           const float* __restrict__ g, const float* __restrict__ bta, float* __restrict__ orow, bf16* __restrict__ obrow, int lane, int wave, float* smem) {
    const __amdgpu_buffer_rsrc_t vrsrc = __builtin_amdgcn_make_buffer_rsrc((void*)V, 0, 16384 * 1024, 0x00020000);
    const int voff = lane * 16;
    PV_COEFS()
    float acc[16];
#pragma unroll
    for (int i = 0; i < 16; ++i) acc[i] = 0.f;
    v4u va[4], vb[4], vc[4], vd[4];
    PV_LOAD(va, wave * 4); PV_LOAD(vb, wave * 4 + 1); PV_LOAD(vc, wave * 4 + 2); PV_LOAD(vd, wave * 4 + 3);
    PV_COMP(va, wave * 4); PV_COMP(vb, wave * 4 + 1); PV_COMP(vc, wave * 4 + 2); PV_COMP(vd, wave * 4 + 3);
    float* accs = smem;
    float* sred = smem + 8192;
#pragma unroll
    for (int j = 0; j < 4; ++j) *(f32x4*)(accs + wave * 1024 + lane * 16 + j * 4) = (f32x4){acc[j * 4 + 0], acc[j * 4 + 1], acc[j * 4 + 2], acc[j * 4 + 3]};
    __syncthreads();
    const int tid = wave * 64 + lane;
    float v0 = ALPHA * xrow[tid * 2], v1 = ALPHA * xrow[tid * 2 + 1];
#pragma unroll
    for (int w = 0; w < 8; ++w) { v0 += accs[w * 1024 + tid * 2]; v1 += accs[w * 1024 + tid * 2 + 1]; }
    const float s = wave_sum(v0 + v1);
    if (lane == 0) sred[wave] = s;
    __syncthreads();
    float mean = 0.f;
#pragma unroll
    for (int w = 0; w < 8; ++w) mean += sred[w];
    mean *= (1.0f / 1024.0f);
    __syncthreads();
    const float d0 = v0 - mean, d1 = v1 - mean;
    const float q = wave_sum(d0 * d0 + d1 * d1);
    if (lane == 0) sred[wave] = q;
    __syncthreads();
    float var = 0.f;
#pragma unroll
    for (int w = 0; w < 8; ++w) var += sred[w];
    const float rs = rsqrtf(var * (1.0f / 1024.0f) + LN_EPS);
    const float o0 = d0 * rs * g[tid * 2] + bta[tid * 2], o1 = d1 * rs * g[tid * 2 + 1] + bta[tid * 2 + 1];
    *(float2*)(orow + tid * 2) = make_float2(o0, o1);
    if (obrow) *(unsigned*)(obrow + tid * 2) = pk2(o0, o1);
    __syncthreads();
}

__device__ __forceinline__ void peer_xk(const int* __restrict__ exr, float* __restrict__ gar, const float* __restrict__ pdt, const float* __restrict__ SU, const float* __restrict__ SV, int lane) {
    PV_COEFS()
    gar[lane] = cf0; gar[64 + lane] = cf1;
}
__device__ __forceinline__ void peer_v_slice(const int* __restrict__ exr, const float* __restrict__ cfr, const unsigned char* __restrict__ V8x, float* __restrict__ outs  , int lane) {
    const int e8 = lane >> 3, c = lane & 7;
    const __amdgpu_buffer_rsrc_t vrsrc = __builtin_amdgcn_make_buffer_rsrc((void*)V8x, 0, 16384 * 128, 0x00020000);
    v4u wa[8], wb[8]; float cfa[8], cfb[8];
    int ids[16];
#pragma unroll
    for (int j = 0; j < 4; ++j) { const v4u t = *(const v4u*)(exr + e8 * 16 + j * 4); ids[j * 4 + 0] = (int)t.x; ids[j * 4 + 1] = (int)t.y; ids[j * 4 + 2] = (int)t.z; ids[j * 4 + 3] = (int)t.w; }
#pragma unroll
    for (int g = 0; g < 8; ++g) wa[g] = __builtin_amdgcn_raw_buffer_load_b128(vrsrc, ids[g] * 128 + c * 16, 0, 0);
#pragma unroll
    for (int g = 0; g < 8; ++g) wb[g] = __builtin_amdgcn_raw_buffer_load_b128(vrsrc, ids[8 + g] * 128 + c * 16, 0, 0);
#pragma unroll
    for (int j = 0; j < 2; ++j) { const f32x4 t = *(const f32x4*)(cfr + e8 * 16 + j * 4), u = *(const f32x4*)(cfr + e8 * 16 + 8 + j * 4);
        cfa[j * 4 + 0] = t.x; cfa[j * 4 + 1] = t.y; cfa[j * 4 + 2] = t.z; cfa[j * 4 + 3] = t.w; cfb[j * 4 + 0] = u.x; cfb[j * 4 + 1] = u.y; cfb[j * 4 + 2] = u.z; cfb[j * 4 + 3] = u.w; }
    f32x2_t ap[8];
#pragma unroll
    for (int i = 0; i < 8; ++i) ap[i] = (f32x2_t){0.f, 0.f};
#define PVS_AXPY(w_, k_) do { ap[(k_) * 2] = __builtin_elementwise_fma(cf2_, __builtin_amdgcn_cvt_pk_f32_fp8((w_), false), ap[(k_) * 2]); ap[(k_) * 2 + 1] = __builtin_elementwise_fma(cf2_, __builtin_amdgcn_cvt_pk_f32_fp8((w_), true), ap[(k_) * 2 + 1]); } while (0)
#pragma unroll
    for (int g = 0; g < 8; ++g) { const f32x2_t cf2_ = (f32x2_t){cfa[g], cfa[g]}; PVS_AXPY(wa[g].x, 0); PVS_AXPY(wa[g].y, 1); PVS_AXPY(wa[g].z, 2); PVS_AXPY(wa[g].w, 3); }
#pragma unroll
    for (int g = 0; g < 8; ++g) { const f32x2_t cf2_ = (f32x2_t){cfb[g], cfb[g]}; PVS_AXPY(wb[g].x, 0); PVS_AXPY(wb[g].y, 1); PVS_AXPY(wb[g].z, 2); PVS_AXPY(wb[g].w, 3); }
#undef PVS_AXPY
    float acc[16];
#pragma unroll
    for (int i = 0; i < 8; ++i) { acc[2 * i] = ap[i].x; acc[2 * i + 1] = ap[i].y; }
#pragma unroll
    for (int i = 0; i < 16; ++i) { float v = acc[i]; v += DPPF(v, 0x128, 0xf); v += __shfl_xor(v, 16); v += __shfl_xor(v, 32); acc[i] = v; }
    if (e8 == 0) {
#pragma unroll
        for (int j = 0; j < 4; ++j) *(f32x4*)(outs + c * 16 + j * 4) = (f32x4){acc[j * 4 + 0], acc[j * 4 + 1], acc[j * 4 + 2], acc[j * 4 + 3]};
    }
}
#define PVL_IDS(I, k_) do { const int t_ = ((tg0 + ((k_) < nit ? (k_) : nit - 1) * tgstep) * 8 + wave); _Pragma("unroll") for (int j = 0; j < 4; ++j) I[j] = *(const v4u*)(EXPp + (size_t)t_ * 128 + e8 * 16 + j * 4); } while (0)
#define PVL_ROWS(R, C, I, k_) do { const int t_ = ((tg0 + ((k_) < nit ? (k_) : nit - 1) * tgstep) * 8 + wave); \
        _Pragma("unroll") for (int j = 0; j < 4; ++j) C[j] = *(const f32x4*)(CFp + (size_t)t_ * 128 + e8 * 16 + j * 4); \
        _Pragma("unroll") for (int j = 0; j < 4; ++j) { R[j * 4 + 0] = __builtin_amdgcn_raw_buffer_load_b128(vrsrc, (int)I[j].x * 128 + c * 16, 0, 0); R[j * 4 + 1] = __builtin_amdgcn_raw_buffer_load_b128(vrsrc, (int)I[j].y * 128 + c * 16, 0, 0); \
            R[j * 4 + 2] = __builtin_amdgcn_raw_buffer_load_b128(vrsrc, (int)I[j].z * 128 + c * 16, 0, 0); R[j * 4 + 3] = __builtin_amdgcn_raw_buffer_load_b128(vrsrc, (int)I[j].w * 128 + c * 16, 0, 0); } } while (0)
#define PVL_AXPY(w_, k2_) do { ap[(k2_) * 2] = __builtin_elementwise_fma(cf2_, __builtin_amdgcn_cvt_pk_f32_fp8((w_), false), ap[(k2_) * 2]); ap[(k2_) * 2 + 1] = __builtin_elementwise_fma(cf2_, __builtin_amdgcn_cvt_pk_f32_fp8((w_), true), ap[(k2_) * 2 + 1]); } while (0)
#define PVL_COMP(R, C, k_) do { f32x2_t ap[8]; \
        _Pragma("unroll") for (int i = 0; i < 8; ++i) ap[i] = (f32x2_t){0.f, 0.f}; \
        _Pragma("unroll") for (int g = 0; g < 16; ++g) { const float cfs_ = C[g >> 2][g & 3]; const f32x2_t cf2_ = (f32x2_t){cfs_, cfs_}; PVL_AXPY(R[g].x, 0); PVL_AXPY(R[g].y, 1); PVL_AXPY(R[g].z, 2); PVL_AXPY(R[g].w, 3); } \
        float acc[16]; \
        _Pragma("unroll") for (int i = 0; i < 8; ++i) { acc[2 * i] = ap[i].x; acc[2 * i + 1] = ap[i].y; } \
        float a8[8], a4[4], a2[2]; \
          \
        _Pragma("unroll") for (int i = 0; i < 8; ++i) { const auto sw_ = __builtin_amdgcn_permlane32_swap(__float_as_uint(acc[i]), __float_as_uint(acc[8 + i]), false, false); a8[i] = __uint_as_float(sw_[0]) + __uint_as_float(sw_[1]); } \
        _Pragma("unroll") for (int i = 0; i < 4; ++i) { const auto sw_ = __builtin_amdgcn_permlane16_swap(__float_as_uint(a8[i]), __float_as_uint(a8[4 + i]), false, false); a4[i] = __uint_as_float(sw_[0]) + __uint_as_float(sw_[1]); } \
        _Pragma("unroll") for (int i = 0; i < 2; ++i) { const float keep = hC ? a4[2 + i] : a4[i], send = hC ? a4[i] : a4[2 + i]; a2[i] = keep + DPPF(send, 0x128, 0xf); } \
        if ((k_) < nit) *(float2*)(OUTp + (size_t)((tg0 + (k_) * tgstep) * 8 + wave) * D + x * 128 + c * 16 + 2 * e8) = make_float2(a2[0], a2[1]); } while (0)
__device__ __forceinline__ void peer_v_loop(const int* __restrict__ EXPp, const float* __restrict__ CFp, const unsigned char* __restrict__ V8x, float* __restrict__ OUTp, int x, int tg0, int tgstep, int nit, int wave, int lane) {
    const int e8 = lane >> 3, c = lane & 7;
    const bool hA = (lane & 32) != 0, hB = (lane & 16) != 0, hC = (lane & 8) != 0;
    const __amdgpu_buffer_rsrc_t vrsrc = __builtin_amdgcn_make_buffer_rsrc((void*)V8x, 0, 16384 * 128, 0x00020000);
    v4u ra[16], rb[16], i0[4], i1[4]; f32x4 ca[4], cb[4];
    PVL_IDS(i0, 0);
    PVL_ROWS(ra, ca, i0, 0);
    PVL_IDS(i1, 1);
#pragma unroll 1
    for (int k = 0; k < nit; k += 2) {
        PVL_ROWS(rb, cb, i1, k + 1);
        PVL_IDS(i0, k + 2);
        PVL_COMP(ra, ca, k);
        PVL_ROWS(ra, ca, i0, k + 2);
        PVL_IDS(i1, k + 3);
        PVL_COMP(rb, cb, k + 1);
    }
}
__device__ __forceinline__ void peer_xc(const bf16* __restrict__ xrow, const float* __restrict__ srow, const float* __restrict__ g, const float* __restrict__ bta, float* __restrict__ orow, bf16* __restrict__ obrow, bf16* __restrict__ obrow2, int lane) {
    f32x4 v[4]; float s = 0.f;
#pragma unroll
    for (int j = 0; j < 4; ++j) { const v2u ab = ((const v2u*)xrow)[lane + 64 * j]; const f32x4 b = ((const f32x4*)srow)[lane + 64 * j];
        v[j] = (f32x4){ALPHA * bflo(ab.x) + b.x, ALPHA * bfhi(ab.x) + b.y, ALPHA * bflo(ab.y) + b.z, ALPHA * bfhi(ab.y) + b.w}; s += (v[j].x + v[j].y) + (v[j].z + v[j].w); }
    const float mean = wave_sum(s) * (1.0f / 1024.0f); float q = 0.f;
#pragma unroll
    for (int j = 0; j < 4; ++j) { v[j] = v[j] - mean; q += (v[j].x * v[j].x + v[j].y * v[j].y) + (v[j].z * v[j].z + v[j].w * v[j].w); }
    const float rs = rsqrtf(wave_sum(q) * (1.0f / 1024.0f) + LN_EPS);
#pragma unroll
    for (int j = 0; j < 4; ++j) {
        const f32x4 g4 = ((const f32x4*)g)[lane + 64 * j], b4 = ((const f32x4*)bta)[lane + 64 * j];
        const f32x4 o = v[j] * rs * g4 + b4;
        if (orow) ((f32x4*)orow)[lane + 64 * j] = o;
        if (obrow) { v2u ob; ob.x = pk2(o.x, o.y); ob.y = pk2(o.z, o.w); ((v2u*)obrow)[lane + 64 * j] = ob; if (obrow2) ((v2u*)obrow2)[lane + 64 * j] = ob; }
    }
}

__device__ __forceinline__ int t5_bucket(int n) {
    if (n < 16) return n;
    const int large = 16 + (int)(logf((float)n / 16.0f) / 2.0794415416798357f * 16.0f);
    return large < 31 ? large : 31;
}
__device__ __forceinline__ void swa_attn(const float* __restrict__ PC, const float* __restrict__ cache_k, const float* __restrict__ cache_v,
                                         const float* __restrict__ rel_bias, const float* __restrict__ sinks, bf16* __restrict__ ATT, int bx) {
    const int tid = threadIdx.x, lane = tid & 63, wid = tid >> 6;
    const int gw = bx * 8 + wid;
    const int t = gw >> 4, h = gw & 15, kvh = h >> 2;
    if (t >= NT) return;
    const bool samp = t >= NP; const int sb = t - NP, pos = t % SEQ;
    const float* qrow = PC + (size_t)t * CN + h * 64;
    float lg[2]; bool valid[2];
#pragma unroll
    for (int rr = 0; rr < 2; ++rr) {
        const int r = lane + 64 * rr;
        const float* krow;
        if (!samp) { valid[rr] = (pos - r) >= 0; krow = PC + (size_t)(valid[rr] ? t - r : t) * CN + 1024 + kvh * 64; }
        else { valid[rr] = true; krow = (r == 0) ? PC + (size_t)t * CN + 1024 + kvh * 64 : cache_k + (((size_t)sb * 128 + (128 - r)) * 4 + kvh) * 64; }
        float dot = 0.f;
#pragma unroll
        for (int d4 = 0; d4 < 16; ++d4) {
            const float4 kv = *(const float4*)(krow + d4 * 4);
            const float4 qv = *(const float4*)(qrow + d4 * 4);
            dot += qv.x * kv.x + qv.y * kv.y + qv.z * kv.z + qv.w * kv.w;
        }
        lg[rr] = valid[rr] ? dot * 0.125f + rel_bias[t5_bucket(r) * 16 + h] : -INFINITY;
    }
    const float sink = sinks[h];
    const float m = fmaxf(wave_max(fmaxf(lg[0], lg[1])), sink);
    float p[2];
#pragma unroll
    for (int rr = 0; rr < 2; ++rr) p[rr] = valid[rr] ? expf(lg[rr] - m) : 0.f;
    const float den = wave_sum(p[0] + p[1]) + expf(sink - m);
    const float inv = 1.0f / den;
    float o = 0.f;
#pragma unroll
    for (int rr = 0; rr < 2; ++rr)
        for (int l2 = 0; l2 < 64; ++l2) {
            const int r = l2 + 64 * rr;
            const float pj = __shfl(p[rr], l2);
            if (pj != 0.f) {
                const float* vrow;
                if (!samp) vrow = PC + (size_t)(t - r) * CN + 1280 + kvh * 64;
                else vrow = (r == 0) ? PC + (size_t)t * CN + 1280 + kvh * 64 : cache_v + (((size_t)sb * 128 + (128 - r)) * 4 + kvh) * 64;
                o += pj * vrow[lane];
            }
        }
    ATT[(size_t)t * D + h * 64 + lane] = (bf16)f2bf(o * inv);
}

__device__ __forceinline__ void swa_kv_out(const float* __restrict__ PC, const float* __restrict__ cache_k, const float* __restrict__ cache_v,
                                           float* __restrict__ pk, float* __restrict__ pv, float* __restrict__ sk, float* __restrict__ sv, int vb) {
    const int c = threadIdx.x & 255, row = vb * 2 + (threadIdx.x >> 8);
    if (row < NB * 128) {
        const int b = row >> 7, i = row & 127;
        const float* src = PC + (size_t)(b * SEQ + SEQ - 128 + i) * CN;
        pk[(size_t)row * 256 + c] = src[1024 + c];
        pv[(size_t)row * 256 + c] = src[1280 + c];
    } else {
        const int r2 = row - NB * 128, sb = r2 >> 7, i = r2 & 127;
        if (i < 127) {
            sk[(size_t)r2 * 256 + c] = cache_k[((size_t)sb * 128 + i + 1) * 256 + c];
            sv[(size_t)r2 * 256 + c] = cache_v[((size_t)sb * 128 + i + 1) * 256 + c];
        } else {
            const float* src = PC + (size_t)(NP + sb) * CN;
            sk[(size_t)r2 * 256 + c] = src[1024 + c];
            sv[(size_t)r2 * 256 + c] = src[1280 + c];
        }
    }
}
#define XB_TMO      128
#define XB_XCNT(j)  (256  + 64 * (j))
#define XB_XSUB(j)  (1280 + 64 * (j))
#define XB_XGEN(j)  (2304 + 64 * (j))
#define XB_TOP      3328
#define XB_TOPGEN   3392
#define XCD_BAR_WORDS 3456
#define XB_SPIN_CAP (1u << 18)

__device__ __forceinline__ unsigned xb_ld(unsigned* p)              { return __hip_atomic_load(p, __ATOMIC_RELAXED, __HIP_MEMORY_SCOPE_AGENT); }
__device__ __forceinline__ unsigned xb_add(unsigned* p, unsigned v) { return __hip_atomic_fetch_add(p, v, __ATOMIC_RELAXED, __HIP_MEMORY_SCOPE_AGENT); }
__device__ __forceinline__ unsigned xb_xcc_id() { return (unsigned)__builtin_amdgcn_s_getreg((3 << 11) | 20) & 0xFu; }
#define XB_SPIN(cond, bar) do { unsigned _sp = 0; while (cond) { __builtin_amdgcn_s_sleep(1); \
    if ((++_sp & 255u) == 0u) { if (xb_ld(&(bar)[XB_TMO])) break; if (_sp > XB_SPIN_CAP) { atomicAdd(&(bar)[XB_TMO], 1u); break; } } } } while (0)

struct XcdBarrier {
    unsigned* bar; unsigned x;
    volatile LAS unsigned* st;
};

__device__ __forceinline__ XcdBarrier xcd_barrier_post(unsigned* bar, volatile LAS unsigned* st) {
    XcdBarrier b; b.bar = bar; b.x = xb_xcc_id(); b.st = st;
    if (threadIdx.x == 0) (void)xb_add(&bar[XB_XCNT(b.x)], 1u);
    return b;
}
__device__ __forceinline__ void xcd_barrier_complete(unsigned* bar, unsigned x, unsigned& nloc, unsigned& nx) {
    const unsigned G = gridDim.x * gridDim.y * gridDim.z;
    unsigned sum, cnt, mine, sp = 0u;
    for (;;) {
        sum = 0u; cnt = 0u; mine = 0u;
#pragma unroll
        for (unsigned j = 0; j < 16; ++j) { const unsigned c = xb_ld(&bar[XB_XCNT(j)]); sum += c; cnt += (c > 0u) ? 1u : 0u; mine = (j == x) ? c : mine; }
        if (sum == G) break;
        __builtin_amdgcn_s_sleep(1);
        if ((++sp & 255u) == 0u) { if (xb_ld(&bar[XB_TMO])) break; if (sp > XB_SPIN_CAP) { atomicAdd(&bar[XB_TMO], 1u); break; } }
    }
    nloc = mine > 0u ? mine : 1u; nx = cnt > 0u ? cnt : 1u;
}

__device__ __forceinline__ void xcd_barrier(const XcdBarrier& b) {
    asm volatile("s_waitcnt vmcnt(0)" ::: "memory");
    __syncthreads();
    if (threadIdx.x == 0) {
        unsigned* bar = b.bar;
        __builtin_amdgcn_s_waitcnt(0);
        unsigned nloc = b.st[0], nx = b.st[1];
        if (nloc == 0u) { xcd_barrier_complete(bar, b.x, nloc, nx); b.st[0] = nloc; b.st[1] = nx; }
        const unsigned old = xb_add(&bar[XB_XSUB(b.x)], 1u);
        const unsigned gen = old / nloc;
        if (old + 1u == (gen + 1u) * nloc) {
            __builtin_amdgcn_fence(__ATOMIC_RELEASE, "agent");
            asm volatile("s_waitcnt vmcnt(0)" ::: "memory");
            const unsigned og = xb_add(&bar[XB_TOP], 1u);
            const unsigned tg = og / nx;
            if (og + 1u == (tg + 1u) * nx) xb_add(&bar[XB_TOPGEN], 1u);
            else XB_SPIN(xb_ld(&bar[XB_TOPGEN]) == tg, bar);
            __builtin_amdgcn_fence(__ATOMIC_ACQUIRE, "agent");
            xb_add(&bar[XB_XGEN(b.x)], 1u);
            asm volatile("s_waitcnt vmcnt(0)" ::: "memory");
        } else {
            XB_SPIN(xb_ld(&bar[XB_XGEN(b.x)]) == gen, bar);
            __builtin_amdgcn_fence(__ATOMIC_ACQUIRE, "agent");
            asm volatile("s_waitcnt vmcnt(0)" ::: "memory");
        }
    }
    __syncthreads();
}

typedef short bf16x8_t __attribute__((ext_vector_type(8)));
__device__ __forceinline__ f32x4 mfma16(bf16x8_t a, bf16x8_t b, f32x4 c) { return __builtin_amdgcn_mfma_f32_16x16x32_bf16(a, b, c, 0, 0, 0); }

struct GdnChunkBufs {
    bf16* W;
    bf16* QG;
    bf16* KDT;
    bf16* UT;
    bf16* QK;
    float* EGL;
};

constexpr int GP_QB = 0, GP_KB = 17408, GP_VB = 34816, GP_LS = 52224, GP_QKS = 69632, GP_WS = 78848, GP_SC = 96256;

struct ConvJob { const float* u0; const float* v0; unsigned char* tab; float* tsc; };
__device__ __forceinline__ void gdn_prep_unit(const bf16* __restrict__ PROJ, const float* __restrict__ conv_w, const float* __restrict__ a_log, const float* __restrict__ dt_bias,
                                              const GdnChunkBufs& cb, float* __restrict__ p_gdn_conv, int un, unsigned char* lds, const ConvJob& cj) {
    int tid = threadIdx.x; asm volatile("" : "+v"(tid));
    const int lane = tid & 63, wave = __builtin_amdgcn_readfirstlane(tid >> 6), fr = lane & 15, fq = lane >> 4;
    const int h = un & 3, n = (un >> 2) & 63, b = un >> 8;
    const int t0 = b * SEQ + n * 64;
    bf16* Qb = (bf16*)(lds + GP_QB); bf16* Kb = (bf16*)(lds + GP_KB); bf16* Vb = (bf16*)(lds + GP_VB); bf16* Ws = (bf16*)(lds + GP_WS);
    float* Ls = (float*)(lds + GP_LS); bf16* QKs = (bf16*)(lds + GP_QKS);
    float* gcs = (float*)(lds + GP_SC); float* bets = gcs + 64; float* egcs = gcs + 128; float* ekds = gcs + 192; float* begs = gcs + 256;
    if (wave == 0) {
        const bf16* prow = PROJ + (size_t)(t0 + lane) * ABN;
        const float a_raw = bf2f(prow[C_A + h]), b_raw = bf2f(prow[C_B + h]);
        float g = -expf(a_log[h]) * softplusf_(a_raw + dt_bias[h]);
#pragma unroll
        for (int off = 1; off < 64; off <<= 1) { const float v = __shfl_up(g, off); if (lane >= off) g += v; }
        const float glast = __shfl(g, 63);
        { const float be_ = sigmoidf_(b_raw), eg_ = expf(g); gcs[lane] = g; bets[lane] = be_; egcs[lane] = eg_; ekds[lane] = expf(glast - g); begs[lane] = be_ * eg_; }
        if (lane == 0) cb.EGL[un] = expf(glast);
    }
    {
        int cols[6]; float cw[4][6], xw[3][6];
#pragma unroll
        for (int p = 0; p < 3; ++p)
#pragma unroll
            for (int e = 0; e < 2; ++e) cols[p * 2 + e] = p * 512 + h * 128 + e * 64 + lane;
#pragma unroll
        for (int i = 0; i < 4; ++i)
#pragma unroll
            for (int c = 0; c < 6; ++c) cw[i][c] = conv_w[i * 1536 + cols[c]];
        const int i0 = wave * 8;
#pragma unroll
        for (int k = 0; k < 3; ++k) {
            const int pos = n * 64 + i0 - 3 + k;
#pragma unroll
            for (int c = 0; c < 6; ++c) xw[k][c] = pos >= 0 ? bf2f(PROJ[(size_t)(t0 + i0 - 3 + k) * ABN + cols[c]]) : 0.f;
        }
        bf16 xraw[8][6];
#pragma unroll
        for (int ii = 0; ii < 8; ++ii)
#pragma unroll
            for (int c = 0; c < 6; ++c) xraw[ii][c] = PROJ[(size_t)(t0 + i0 + ii) * ABN + cols[c]];
#pragma unroll
        for (int ii = 0; ii < 8; ++ii) {
            const int i = i0 + ii;
            float xt[6], s[6];
#pragma unroll
            for (int c = 0; c < 6; ++c) xt[c] = bf2f(xraw[ii][c]);
#pragma unroll
            for (int c = 0; c < 6; ++c) { const float y_ = cw[0][c] * xw[0][c] + cw[1][c] * xw[1][c] + cw[2][c] * xw[2][c] + cw[3][c] * xt[c]; s[c] = y_ * __frcp_rn(1.0f + __expf(-y_)); }
            const float qs = rsqrtf(wave_sum(s[0] * s[0] + s[1] * s[1]) + 1e-6f) * 0.08838834764831845f;
            const float ks = rsqrtf(wave_sum(s[2] * s[2] + s[3] * s[3]) + 1e-6f);
            Qb[i * 136 + lane] = (bf16)f2bf(s[0] * qs); Qb[i * 136 + 64 + lane] = (bf16)f2bf(s[1] * qs);
            Kb[i * 136 + lane] = (bf16)f2bf(s[2] * ks); Kb[i * 136 + 64 + lane] = (bf16)f2bf(s[3] * ks);
            Vb[i * 136 + lane] = (bf16)f2bf(s[4]);      Vb[i * 136 + 64 + lane] = (bf16)f2bf(s[5]);
            if (n == 63 && i >= 61) {
#pragma unroll
                for (int c = 0; c < 6; ++c) p_gdn_conv[((size_t)b * 3 + (i - 61)) * 1536 + cols[c]] = xt[c];
            }
#pragma unroll
            for (int c = 0; c < 6; ++c) { xw[0][c] = xw[1][c]; xw[1][c] = xw[2][c]; xw[2][c] = xt[c]; }
        }
    }
    __syncthreads();
    {
        const int mi = wave >> 1;
        bf16x8_t aK[4], aQ[4];
#pragma unroll
        for (int ks = 0; ks < 4; ++ks) { aK[ks] = *(const bf16x8_t*)(Kb + (mi * 16 + fr) * 136 + ks * 32 + 8 * fq); aQ[ks] = *(const bf16x8_t*)(Qb + (mi * 16 + fr) * 136 + ks * 32 + 8 * fq); }
#pragma unroll
        for (int nn = 0; nn < 2; ++nn) {
            const int nj = (wave & 1) * 2 + nn;
            f32x4 accK = (f32x4){0.f, 0.f, 0.f, 0.f}, accQ = accK;
#pragma unroll
            for (int ks = 0; ks < 4; ++ks) { const bf16x8_t bk = *(const bf16x8_t*)(Kb + (nj * 16 + fr) * 136 + ks * 32 + 8 * fq); accK = mfma16(aK[ks], bk, accK); accQ = mfma16(aQ[ks], bk, accQ); }
            const int j = nj * 16 + fr; const float gj = gcs[j];
#pragma unroll
            for (int r = 0; r < 4; ++r) {
                const int i = mi * 16 + 4 * fq + r;
                const float dec = i >= j ? expf(gcs[i] - gj) : 0.f;
                Ls[j * 68 + i] = i > j ? bets[i] * accK[r] * dec : 0.f;
                QKs[i * 72 + j] = (bf16)f2bf(i >= j ? accQ[r] * dec : 0.f);
            }
        }
    }
    __syncthreads();
    if (wave < 4) {
        float x[64];
        const bool isu = tid < 128; const int c = isu ? tid : tid - 128;
        const LAS unsigned char* l3 = (const LAS unsigned char*)lds;
        unsigned so = (isu ? GP_VB : GP_KB) + c * 2, ro = GP_SC + (isu ? 64 * 4 : 256 * 4), lo = GP_LS;
        asm volatile("" : "+v"(so), "+v"(ro), "+v"(lo));
#pragma unroll
        for (int i = 0; i < 64; ++i) x[i] = *(const LAS float*)(l3 + ro + 4 * i) * bf2f(*(const LAS bf16*)(l3 + so + i * 272));
#pragma unroll
        for (int j = 0; j < 63; ++j) {
#pragma unroll
            for (int i4 = (j + 1) / 4; i4 < 16; ++i4) {
                const f32x4 l4 = *(const LAS f32x4*)(l3 + lo + j * 272 + i4 * 16);
                if (i4 * 4 + 0 > j) x[i4 * 4 + 0] -= l4.x * x[j];
                if (i4 * 4 + 1 > j) x[i4 * 4 + 1] -= l4.y * x[j];
                if (i4 * 4 + 2 > j) x[i4 * 4 + 2] -= l4.z * x[j];
                if (i4 * 4 + 3 > j) x[i4 * 4 + 3] -= l4.w * x[j];
            }
        }
        if (isu) {
            bf16* dst = cb.UT + (size_t)un * 8192 + ((c >> 4) * 4 * 64 + (c & 15)) * 4;
#pragma unroll
            for (int m4 = 0; m4 < 16; ++m4) { v2u o; o.x = pk2(x[m4 * 4 + 0], x[m4 * 4 + 1]); o.y = pk2(x[m4 * 4 + 2], x[m4 * 4 + 3]); *(v2u*)(dst + ((m4 >> 2) * 64 + (m4 & 3) * 16) * 4) = o; }
        } else {
#pragma unroll
            for (int i = 0; i < 64; ++i) Ws[i * 136 + c] = (bf16)f2bf(x[i]);
        }
    } else {
        const int t2 = tid - 256;
#pragma unroll
        for (int k = 0; k < 4; ++k) {
            const int ci = t2 + 256 * k, i = ((ci >> 8) << 4) | (ci & 15), d0 = (((ci >> 6) & 3) * 4 + ((ci >> 4) & 3)) * 8; const float e = egcs[i];
            const v4u q = *(const v4u*)(Qb + i * 136 + d0);
            v4u o; o.x = pk2(bflo(q.x) * e, bfhi(q.x) * e); o.y = pk2(bflo(q.y) * e, bfhi(q.y) * e); o.z = pk2(bflo(q.z) * e, bfhi(q.z) * e); o.w = pk2(bflo(q.w) * e, bfhi(q.w) * e);
            *(v4u*)(cb.QG + (size_t)un * 8192 + ci * 8) = o;
        }
#pragma unroll
        for (int k = 0; k < 4; ++k) {
            const int ci = t2 + 256 * k, d = ((ci >> 7) << 4) | (ci & 15), i0 = (((ci >> 6) & 1) * 4 + ((ci >> 4) & 3)) * 8;
            float v[8];
#pragma unroll
            for (int q = 0; q < 8; ++q) v[q] = bf2f(Kb[(i0 + q) * 136 + d]) * ekds[i0 + q];
            v4u o; o.x = pk2(v[0], v[1]); o.y = pk2(v[2], v[3]); o.z = pk2(v[4], v[5]); o.w = pk2(v[6], v[7]);
            *(v4u*)(cb.KDT + (size_t)un * 8192 + ci * 8) = o;
        }
#pragma unroll
        for (int k = 0; k < 2; ++k) {
            const int ci = t2 + 256 * k, i = ((ci >> 7) << 4) | (ci & 15), j0 = (((ci >> 6) & 1) * 4 + ((ci >> 4) & 3)) * 8;
            *(v4u*)(cb.QK + (size_t)un * 4096 + ci * 8) = *(const v4u*)(QKs + i * 72 + j0);
        }
        { const int rb = (un & 511) * 32 + (wave - 4) * 8;
          if (un < 512) table_rows_convert<false>(cj.u0, cj.tab, cj.tsc, rb, rb + 8, 0, 1, lane);
          else table_rows_convert<true>(cj.v0, cj.tab + (size_t)16384 * D, cj.tsc + 16384, rb, rb + 8, 0, 1, lane); }
    }
    __syncthreads();
#pragma unroll
    for (int k = 0; k < 2; ++k) {
        const int ci = tid + 512 * k, i = ((ci >> 8) << 4) | (ci & 15), d0 = (((ci >> 6) & 3) * 4 + ((ci >> 4) & 3)) * 8;
        *(v4u*)(cb.W + (size_t)un * 8192 + ci * 8) = *(const v4u*)(Ws + i * 136 + d0);
    }
    __syncthreads();
}

constexpr int GS_ST = 0, GS_VNT = 2 * 32 * 136 * 2, GS_END = GS_VNT + 32 * 72 * 2;
template <int N0, int N1>
__device__ __forceinline__ void gdn_seq(const GdnChunkBufs& cb, float* __restrict__ O, float* __restrict__ Sout, int b, int h, int sl, unsigned char* lds, f32x4 (&accS)[2], int& cur) {
    int tid = threadIdx.x; asm volatile("" : "+v"(tid));
    const int lane = tid & 63, wave = __builtin_amdgcn_readfirstlane(tid >> 6), fr = lane & 15, fq = lane >> 4;
    const int mi = wave >> 1, nj = wave & 1;
    bf16* St = (bf16*)(lds + GS_ST); bf16* VnT = (bf16*)(lds + GS_VNT);
    float* egls = (float*)(lds + GS_END);
    if (N0 == 0) {
        for (int i = tid; i < 2 * 32 * 136 / 2; i += NTH) ((unsigned*)St)[i] = 0u;
        accS[0] = (f32x4){0.f, 0.f, 0.f, 0.f}; accS[1] = accS[0]; cur = 0;
    }
    if (tid >= N0 && tid < N1) egls[tid] = cb.EGL[(size_t)((b * 64 + tid) * 4 + h)];
    __syncthreads();
#define GS_DECL(X) bf16x8_t aW##X[4], aQG##X[4], aQK##X[2], aKD##X[2]; v2u ut##X;
    GS_DECL(0) GS_DECL(1) GS_DECL(2)
#define GS_GLD16(dst, ptr) asm volatile("global_load_dwordx4 %0, %1, off" : "=v"(dst) : "v"(ptr))
#define GS_GLD8(dst, ptr) asm volatile("global_load_dwordx2 %0, %1, off" : "=v"(dst) : "v"(ptr))
#define GS_LOAD(X, n_) do { const size_t u_ = (size_t)((b * 64 + ((n_) < 63 ? (n_) : 63)) * 4 + h);     \
        _Pragma("unroll") for (int ks = 0; ks < 4; ++ks) { GS_GLD16(aW##X[ks], cb.W + u_ * 8192 + ((mi * 4 + ks) * 64 + lane) * 8); GS_GLD16(aQG##X[ks], cb.QG + u_ * 8192 + ((mi * 4 + ks) * 64 + lane) * 8); } \
        _Pragma("unroll") for (int ks = 0; ks < 2; ++ks) { GS_GLD16(aQK##X[ks], cb.QK + u_ * 4096 + ((mi * 2 + ks) * 64 + lane) * 8); GS_GLD16(aKD##X[ks], cb.KDT + u_ * 8192 + ((wave * 2 + ks) * 64 + lane) * 8); } \
        GS_GLD8(ut##X, cb.UT + u_ * 8192 + (((sl * 2 + nj) * 4 + mi) * 64 + lane) * 4); } while (0)
#define GS_WAITN(X, N) asm volatile("s_waitcnt vmcnt(" #N ")" : "+v"(aW##X[0]), "+v"(aW##X[1]), "+v"(aW##X[2]), "+v"(aW##X[3]), "+v"(aQG##X[0]), "+v"(aQG##X[1]), "+v"(aQG##X[2]), "+v"(aQG##X[3]), \
        "+v"(aQK##X[0]), "+v"(aQK##X[1]), "+v"(aKD##X[0]), "+v"(aKD##X[1]), "+v"(ut##X))
#define GS_WAIT(X, n_) GS_WAITN(X, 26)
#define GS_STEP(X, n_) do { \
        const float egl##X = egls[(n_)]; \
        GS_WAIT(X, n_); \
        __syncthreads();                                        \
        f32x4 accW = (f32x4){0.f, 0.f, 0.f, 0.f}, accO = accW; \
        const bf16* Sc = St + cur * 32 * 136; \
        _Pragma("unroll") for (int ks = 0; ks < 4; ++ks) { const bf16x8_t bs = *(const bf16x8_t*)(Sc + (nj * 16 + fr) * 136 + ks * 32 + 8 * fq); accW = mfma16(aW##X[ks], bs, accW); accO = mfma16(aQG##X[ks], bs, accO); } \
          \
        const float v0 = bflo(ut##X.x) - accW[0], v1 = bfhi(ut##X.x) - accW[1], v2 = bflo(ut##X.y) - accW[2], v3 = bfhi(ut##X.y) - accW[3]; \
        { v2u o; o.x = pk2(v0, v1); o.y = pk2(v2, v3); *(v2u*)(VnT + (nj * 16 + fr) * 72 + mi * 16 + 4 * fq) = o; } \
        __syncthreads();                                        \
        _Pragma("unroll") for (int ks = 0; ks < 2; ++ks) { const bf16x8_t bv = *(const bf16x8_t*)(VnT + (nj * 16 + fr) * 72 + ks * 32 + 8 * fq); accO = mfma16(aQK##X[ks], bv, accO); } \
        { float* orow = O + (size_t)(b * SEQ + (n_) * 64 + mi * 16 + 4 * fq) * 512 + h * 128 + sl * 32 + nj * 16 + fr; \
          orow[0] = accO[0]; orow[512] = accO[1]; orow[1024] = accO[2]; orow[1536] = accO[3]; } \
          \
        bf16* Sn = St + (cur ^ 1) * 32 * 136; \
        _Pragma("unroll") for (int njj = 0; njj < 2; ++njj) { \
            accS[njj] = accS[njj] * egl##X; \
            _Pragma("unroll") for (int ks = 0; ks < 2; ++ks) { const bf16x8_t bv = *(const bf16x8_t*)(VnT + (njj * 16 + fr) * 72 + ks * 32 + 8 * fq); accS[njj] = mfma16(aKD##X[ks], bv, accS[njj]); } \
            v2u o; o.x = pk2(accS[njj][0], accS[njj][1]); o.y = pk2(accS[njj][2], accS[njj][3]); \
            *(v2u*)(Sn + (njj * 16 + fr) * 136 + wave * 16 + 4 * fq) = o; } \
        cur ^= 1; } while (0)
    constexpr int NTRI = (N1 - N0) / 3, NREM = (N1 - N0) % 3, NM = N0 + 3 * NTRI;
    GS_LOAD(0, N0); GS_LOAD(1, N0 + 1);
#pragma unroll 1
    for (int n = N0; n < NM; n += 3) {
        GS_LOAD(2, n + 2);
        GS_STEP(0, n);
        GS_LOAD(0, n + 3);
        GS_STEP(1, n + 1);
        GS_LOAD(1, n + 4);
        GS_STEP(2, n + 2);
    }
    if (NREM >= 1) { GS_LOAD(2, NM + 2); GS_STEP(0, NM); }
    if (NREM == 2) { GS_LOAD(0, NM + 3); GS_STEP(1, NM + 1); }
    GS_WAITN(0, 0); GS_WAITN(1, 0); GS_WAITN(2, 0);
#undef GS_STEP
#undef GS_DECL
#undef GS_WAIT
#undef GS_WAITN
#undef GS_GLD16
#undef GS_GLD8
    asm volatile("s_waitcnt vmcnt(0)" ::: "memory");
#undef GS_LOAD
    if (N1 == 64) {
#pragma unroll
        for (int njj = 0; njj < 2; ++njj)
#pragma unroll
            for (int r = 0; r < 4; ++r) Sout[(((size_t)b * 4 + h) * 128 + wave * 16 + 4 * fq + r) * 128 + sl * 32 + njj * 16 + fr] = accS[njj][r];
    }
    __syncthreads();
}

__device__ __forceinline__ void lru_prep_unit(const bf16* __restrict__ PROJ, const float* __restrict__ conv_w, const float* __restrict__ conv_b,
                                              const float* __restrict__ w_r, const float* __restrict__ b_r, const float* __restrict__ w_i, const float* __restrict__ b_i, const float* __restrict__ lam,
                                              float* __restrict__ H, float* __restrict__ P, float* __restrict__ Hend, float* __restrict__ Pend, float* __restrict__ p_lru_conv, int ub) {
    int c = threadIdx.x; asm volatile("" : "+v"(c));
    const int nblk = c >> 6, d = c & 63;
    const int n = ub & 63, b = ub >> 6, t0 = b * SEQ + n * 64;
    float wr[64], wi[64];
#pragma unroll
    for (int cc = 0; cc < 64; ++cc) { wr[cc] = w_r[((size_t)nblk * 64 + cc) * 64 + d]; wi[cc] = w_i[((size_t)nblk * 64 + cc) * 64 + d]; }
    const float cw0 = conv_w[c], cw1 = conv_w[512 + c], cw2 = conv_w[1024 + c], cw3 = conv_w[1536 + c], cb_ = conv_b[c];
    const float br = b_r[c], bi = b_i[c], spl = -8.0f * softplusf_(-lam[c]);
    float x0 = (n * 64 - 3 >= 0) ? bf2f(PROJ[(size_t)(t0 - 3) * ABN + C_XR + c]) : 0.f;
    float x1 = (n * 64 - 2 >= 0) ? bf2f(PROJ[(size_t)(t0 - 2) * ABN + C_XR + c]) : 0.f;
    float x2 = (n * 64 - 1 >= 0) ? bf2f(PROJ[(size_t)(t0 - 1) * ABN + C_XR + c]) : 0.f;
    float hloc = 0.f, ploc = 1.f;
    bf16 xa[16], xb[16];
#pragma unroll
    for (int k = 0; k < 16; ++k) xa[k] = PROJ[(size_t)(t0 + k) * ABN + C_XR + c];
#pragma unroll 1
    for (int ib = 0; ib < 64; ib += 16) {
      if (ib + 16 < 64) {
#pragma unroll
        for (int k = 0; k < 16; ++k) xb[k] = PROJ[(size_t)(t0 + ib + 16 + k) * ABN + C_XR + c];
      }
#pragma unroll
      for (int k = 0; k < 16; ++k) {
        const int i = ib + k;
        const float xt = bf2f(xa[k]);
        const float xr = cb_ + cw0 * x0 + cw1 * x1 + cw2 * x2 + cw3 * xt;
        f32x2_t ga = (f32x2_t){br, bi}, gb = (f32x2_t){0.f, 0.f};
#pragma unroll
        for (int cc = 0; cc < 64; cc += 2) {
            const float xa_ = __uint_as_float(__builtin_amdgcn_readlane(__float_as_uint(xr), cc)), xb_ = __uint_as_float(__builtin_amdgcn_readlane(__float_as_uint(xr), cc + 1));
            ga += (f32x2_t){xa_, xa_} * (f32x2_t){wr[cc], wi[cc]}; gb += (f32x2_t){xb_, xb_} * (f32x2_t){wr[cc + 1], wi[cc + 1]};
        }
        ga += gb;
        const float r = __frcp_rn(1.0f + __expf(-ga.x)), ii = __frcp_rn(1.0f + __expf(-ga.y));
        const float a = __expf(spl * r), bb = __fsqrt_rn(fmaxf(1.0f - a * a, 0.f)) * (ii * xr);
        hloc = a * hloc + bb; ploc *= a;
        H[(size_t)(t0 + i) * 512 + c] = hloc; P[(size_t)(t0 + i) * 512 + c] = ploc;
        if (n == 63 && i >= 61) p_lru_conv[((size_t)b * 3 + (i - 61)) * 512 + c] = xt;
        x0 = x1; x1 = x2; x2 = xt;
      }
#pragma unroll
      for (int k = 0; k < 16; ++k) xa[k] = xb[k];
    }
    Hend[(size_t)ub * 512 + c] = hloc; Pend[(size_t)ub * 512 + c] = ploc;
}
constexpr int LR_XR = 64 * 68 * 4;
__device__ __forceinline__ void lru_prep_unit2(const bf16* __restrict__ PROJ, const float* __restrict__ conv_w, const float* __restrict__ conv_b,
                                               const bf16* __restrict__ WRT, const bf16* __restrict__ WIT  , const float* __restrict__ b_r, const float* __restrict__ b_i, const float* __restrict__ lam,
                                               float* __restrict__ H, float* __restrict__ P, float* __restrict__ Hend, float* __restrict__ Pend, float* __restrict__ p_lru_conv, int ub, unsigned char* lds) {
    int tid = threadIdx.x; asm volatile("" : "+v"(tid));
    const int lane = tid & 63, wave = __builtin_amdgcn_readfirstlane(tid >> 6), fr = lane & 15, fq = lane >> 4;
    const int n = ub & 63, b = ub >> 6, t0 = b * SEQ + n * 64;
    float* XR = (float*)(lds + wave * LR_XR);
    {
        const int c = wave * 64 + lane;
        const float cw0 = conv_w[c], cw1 = conv_w[512 + c], cw2 = conv_w[1024 + c], cw3 = conv_w[1536 + c], cb_ = conv_b[c];
        float x0 = (n * 64 - 3 >= 0) ? bf2f(PROJ[(size_t)(t0 - 3) * ABN + C_XR + c]) : 0.f;
        float x1 = (n * 64 - 2 >= 0) ? bf2f(PROJ[(size_t)(t0 - 2) * ABN + C_XR + c]) : 0.f;
        float x2 = (n * 64 - 1 >= 0) ? bf2f(PROJ[(size_t)(t0 - 1) * ABN + C_XR + c]) : 0.f;
#pragma unroll 1
        for (int ib = 0; ib < 64; ib += 16) {
            bf16 xa[16];
#pragma unroll
            for (int k = 0; k < 16; ++k) xa[k] = PROJ[(size_t)(t0 + ib + k) * ABN + C_XR + c];
#pragma unroll
            for (int k = 0; k < 16; ++k) {
                const int i = ib + k; const float xt = bf2f(xa[k]);
                XR[i * 68 + lane] = cb_ + cw0 * x0 + cw1 * x1 + cw2 * x2 + cw3 * xt;
                if (n == 63 && i >= 61) p_lru_conv[((size_t)b * 3 + (i - 61)) * 512 + c] = xt;
                x0 = x1; x1 = x2; x2 = xt;
            }
        }
    }
    asm volatile("s_waitcnt lgkmcnt(0)" ::: "memory");
    bf16x8_t bR[4][2], bI[4][2];
#pragma unroll
    for (int nt = 0; nt < 4; ++nt)
#pragma unroll
        for (int ks = 0; ks < 2; ++ks) {
            bR[nt][ks] = *(const bf16x8_t*)(WRT + ((size_t)wave * 64 + nt * 16 + fr) * 64 + ks * 32 + 8 * fq);
            bI[nt][ks] = *(const bf16x8_t*)(WIT + ((size_t)wave * 64 + nt * 16 + fr) * 64 + ks * 32 + 8 * fq);
        }
    float brv[4], biv[4], splv[4];
#pragma unroll
    for (int nt = 0; nt < 4; ++nt) { const int c = wave * 64 + nt * 16 + fr; brv[nt] = b_r[c]; biv[nt] = b_i[c]; splv[nt] = -8.0f * softplusf_(-lam[c]); }
    float hin[4], pin[4];
#pragma unroll
    for (int nt = 0; nt < 4; ++nt) { hin[nt] = 0.f; pin[nt] = 1.f; }
#pragma unroll 1
    for (int mt = 0; mt < 4; ++mt) {
        bf16x8_t aX[2];
#pragma unroll
        for (int ks = 0; ks < 2; ++ks) {
            const f32x4 lo = *(const f32x4*)(XR + (mt * 16 + fr) * 68 + ks * 32 + 8 * fq), hi = *(const f32x4*)(XR + (mt * 16 + fr) * 68 + ks * 32 + 8 * fq + 4);
            v4u w; w.x = pk2(lo.x, lo.y); w.y = pk2(lo.z, lo.w); w.z = pk2(hi.x, hi.y); w.w = pk2(hi.z, hi.w);
            aX[ks] = __builtin_bit_cast(bf16x8_t, w);
        }
#pragma unroll
        for (int nt = 0; nt < 4; ++nt) {
            f32x4 aR = (f32x4){0.f, 0.f, 0.f, 0.f}, aI = aR;
            aR = mfma16(aX[0], bR[nt][0], aR); aR = mfma16(aX[1], bR[nt][1], aR);
            aI = mfma16(aX[0], bI[nt][0], aI); aI = mfma16(aX[1], bI[nt][1], aI);
            float av[4], bv[4];
#pragma unroll
            for (int r = 0; r < 4; ++r) {
                const float rg = __frcp_rn(1.0f + __expf(-(aR[r] + brv[nt]))), ig = __frcp_rn(1.0f + __expf(-(aI[r] + biv[nt])));
                const float a = __expf(splv[nt] * rg);
                av[r] = a; bv[r] = __fsqrt_rn(fmaxf(1.0f - a * a, 0.f)) * (ig * XR[(mt * 16 + 4 * fq + r) * 68 + nt * 16 + fr]);
            }
            float PA[4], PB[4];
            PA[0] = av[0]; PB[0] = bv[0];
#pragma unroll
            for (int r = 1; r < 4; ++r) { PA[r] = av[r] * PA[r - 1]; PB[r] = av[r] * PB[r - 1] + bv[r]; }
            float GA = PA[3], GB = PB[3];
            { const float pa = __shfl_up(GA, 16), pb = __shfl_up(GB, 16); if (fq >= 1) { GB = GA * pb + GB; GA = GA * pa; } }
            { const float pa = __shfl_up(GA, 32), pb = __shfl_up(GB, 32); if (fq >= 2) { GB = GA * pb + GB; GA = GA * pa; } }
            float EA = __shfl_up(GA, 16), EB = __shfl_up(GB, 16);
            if (fq == 0) { EA = 1.f; EB = 0.f; }
            const float h0 = EA * hin[nt] + EB, p0 = pin[nt] * EA;
#pragma unroll
            for (int r = 0; r < 4; ++r) {
                const size_t o = (size_t)(t0 + mt * 16 + 4 * fq + r) * 512 + wave * 64 + nt * 16 + fr;
                H[o] = PA[r] * h0 + PB[r]; P[o] = p0 * PA[r];
            }
            const float TA = __shfl(GA, 48 + fr), TB = __shfl(GB, 48 + fr);
            hin[nt] = TA * hin[nt] + TB; pin[nt] = pin[nt] * TA;
        }
    }
    if (fq == 0) {
#pragma unroll
        for (int nt = 0; nt < 4; ++nt) { Hend[(size_t)ub * 512 + wave * 64 + nt * 16 + fr] = hin[nt]; Pend[(size_t)ub * 512 + wave * 64 + nt * 16 + fr] = pin[nt]; }
    }
    asm volatile("s_waitcnt lgkmcnt(0)" ::: "memory");
}
__device__ __forceinline__ void lru_carry(const float* __restrict__ Hend, const float* __restrict__ Pend, float* __restrict__ CIN, float* __restrict__ hlast, int bx) {
    int tx_ = threadIdx.x; asm volatile("" : "+v"(tx_));
    const int idx = bx * NTH + tx_, b = idx >> 9, c = idx & 511;
    float carry = 0.f;
#pragma unroll 8
    for (int n = 0; n < 64; ++n) {
        const size_t o = ((size_t)b * 64 + n) * 512 + c;
        CIN[o] = carry;
        carry = Hend[o] + Pend[o] * carry;
    }
    hlast[(size_t)b * 512 + c] = carry;
}

__device__ __forceinline__ unsigned f2key(float f) { const unsigned u = __float_as_uint(f); return u ^ ((u >> 31) ? 0xffffffffu : 0x80000000u); }
__device__ __forceinline__ float key2f(unsigned k) { return __uint_as_float(k ^ ((k >> 31) ? 0x80000000u : 0xffffffffu)); }
#define TK_CE(hi, lo) do { const unsigned a_ = (hi), b_ = (lo); (hi) = a_ > b_ ? a_ : b_; (lo) = a_ > b_ ? b_ : a_; } while (0)
template <int N> __device__ __forceinline__ void bitonic_sort_desc(unsigned (&a)[N]) {
#pragma unroll
    for (int k = 2; k <= N; k <<= 1)
#pragma unroll
        for (int j = k >> 1; j > 0; j >>= 1)
#pragma unroll
            for (int i = 0; i < N; ++i) { const int l = i ^ j; if (l > i) { if ((i & k) == 0) TK_CE(a[i], a[l]); else TK_CE(a[l], a[i]); } }
}
template <int XM> __device__ __forceinline__ void merge_top16(unsigned (&a)[16]) {
    unsigned c[16];
#pragma unroll
    for (int i = 0; i < 16; ++i) {
        unsigned o;
        if (XM == 1) o = (unsigned)__builtin_amdgcn_update_dpp(0, (int)a[15 - i], 0xB1, 0xf, 0xf, false);
        else if (XM == 2) o = (unsigned)__builtin_amdgcn_update_dpp(0, (int)a[15 - i], 0x4E, 0xf, 0xf, false);
        else if (XM == 16) o = __builtin_amdgcn_permlane16_swap(a[15 - i], a[15 - i], false, false)[1];
        else o = __builtin_amdgcn_permlane32_swap(a[15 - i], a[15 - i], false, false)[1];
        c[i] = a[i] > o ? a[i] : o; }
#pragma unroll
    for (int j = 8; j > 0; j >>= 1)
#pragma unroll
        for (int i = 0; i < 16; ++i) { const int l = i ^ j; if (l > i) TK_CE(c[i], c[l]); }
#pragma unroll
    for (int i = 0; i < 16; ++i) a[i] = c[i];
}
constexpr int TK_KS = 0, TK_TS = 2 * 128 * 136 * 2, TK_END = TK_TS + 64 * 2 * 16 * 4;
__device__ __forceinline__ void peer_topk_stage_keys(const bf16* __restrict__ KB, int h, unsigned char* lds) {
    bf16* Ks = (bf16*)(lds + TK_KS);
    for (int ci = threadIdx.x; ci < 2 * 128 * 16; ci += NTH) { const int row = ci >> 4, part = ci & 15;
        *(v4u*)(Ks + row * 136 + part * 8) = *(const v4u*)(KB + ((size_t)h * 256 + row) * 128 + part * 8); }
    __syncthreads();
}
__device__ __forceinline__ void peer_topk_ldq(bf16x8_t (&bq)[4], const bf16* __restrict__ Q, int tile, int h, int tid) {
    const int lane = tid & 63, wave = tid >> 6, fr = lane & 15, fq = lane >> 4, c = wave >> 2, nt = wave & 3;
#pragma unroll
    for (int ks = 0; ks < 4; ++ks) bq[ks] = *(const bf16x8_t*)(Q + (size_t)(tile * 64 + nt * 16 + fr) * 2048 + h * 256 + c * 128 + ks * 32 + 8 * fq);
}
__device__ __forceinline__ void peer_topk4(const bf16* __restrict__ Q, int* __restrict__ EXP, float* __restrict__ GATE, int tile, int h, unsigned char* lds, bf16x8_t (&bq)[4], int tile_next) {
    int tid = threadIdx.x; asm volatile("" : "+v"(tid));
    const int lane = tid & 63, wave = __builtin_amdgcn_readfirstlane(tid >> 6), fr = lane & 15, fq = lane >> 4;
    const bf16* Ks = (const bf16*)(lds + TK_KS); unsigned* Ts = (unsigned*)(lds + TK_TS);
    {
        const int c = wave >> 2, nt = wave & 3;
        unsigned a[32];
#pragma unroll
        for (int mt = 0; mt < 8; ++mt) {
            f32x4 acc = (f32x4){0.f, 0.f, 0.f, 0.f};
#pragma unroll
            for (int ks = 0; ks < 4; ++ks) { const bf16x8_t ak = *(const bf16x8_t*)(Ks + (c * 128 + mt * 16 + fr) * 136 + ks * 32 + 8 * fq); acc = mfma16(ak, bq[ks], acc); }
#pragma unroll
            for (int r = 0; r < 4; ++r) a[mt * 4 + r] = (f2key(acc[r]) & ~127u) | (unsigned)(127 - (mt * 16 + 4 * fq + r));
        }
        if (tile_next >= 0) peer_topk_ldq(bq, Q, tile_next, h, tid);
        bitonic_sort_desc<32>(a);
        unsigned t[16];
#pragma unroll
        for (int j = 0; j < 16; ++j) t[j] = a[j];
        merge_top16<16>(t); merge_top16<32>(t);
        if (fq == 0) {
            const int tk = nt * 16 + fr;
#pragma unroll
            for (int j = 0; j < 16; ++j) Ts[(tk * 2 + c) * 16 + j] = t[j];
        }
    }
    __syncthreads();
    if (tid < 256) {
        const int tk = tid >> 2, q = tid & 3;
        const unsigned* t0 = Ts + (tk * 2 + 0) * 16; const unsigned* t1 = Ts + (tk * 2 + 1) * 16;
        unsigned a[16];
#pragma unroll
        for (int s = 0; s < 13; ++s) {
            const int e = s * 4 + q;
            int i, j;
            if (e < 16) { i = 0; j = e; } else if (e < 24) { i = 1; j = e - 16; } else if (e < 29) { i = 2; j = e - 24; } else if (e < 33) { i = 3; j = e - 29; }
            else if (e < 36) { i = 4; j = e - 33; } else if (e < 42) { i = 5 + ((e - 36) >> 1); j = (e - 36) & 1; } else { i = 8 + (e - 42); j = 0; }
            const bool ok = e < 50;
            const float sum = key2f(t0[ok ? i : 0] & ~127u) + key2f(t1[ok ? j : 0] & ~127u);
            a[s] = ok ? ((f2key(sum) & ~255u) | (unsigned)(255 - (i * 16 + j))) : 0u;
        }
        a[13] = 0u; a[14] = 0u; a[15] = 0u;
        bitonic_sort_desc<16>(a);
        merge_top16<1>(a); merge_top16<2>(a);
        float ev[16], sum = 0.f; const float m = key2f(a[0] & ~255u);
#pragma unroll
        for (int j = 0; j < 16; ++j) { ev[j] = __expf(key2f(a[j] & ~255u) - m); sum += ev[j]; }
        const float inv = 1.0f / sum;
        const size_t o = (size_t)(tile * 64 + tk) * 128 + h * 16;
#pragma unroll
        for (int j = 0; j < 16; ++j)
            if ((j >> 2) == q) {
                const int code = 255 - (int)(a[j] & 255u), i = code >> 4, jj = code & 15;
                const int n0 = 127 - (int)(t0[i] & 127u), n1 = 127 - (int)(t1[jj] & 127u);
                EXP[o + j] = n0 * 128 + n1; GATE[o + j] = ev[j] * inv;
            }
    }
    __syncthreads();
}

constexpr int AT_KS = 0, AT_VT = 192 * 72 * 2, AT_BT = AT_VT + 64 * 200 * 2, AT_PW = AT_BT + 4 * 256 * 4, AT_END = AT_PW + 8 * 32 * 72 * 2;
template <int QS>
__device__ __forceinline__ void attn_core(const bf16* __restrict__ PCb, const float* __restrict__ sinks, bf16* __restrict__ ATT, int kvh, int q0, int tb, int wave, int lane, int fr, int fq,
                                          const bf16* Ks, const bf16* Vt, const float* Bt, bf16* Pw, const bf16x8_t (&aQ)[2][2], float sink_raw) {
    constexpr int NT0 = QS ? 2 : 0;
    const int g = wave >> 1, hh = kvh * 4 + g; constexpr int qs = QS;
    f32x4 sc[2][12];
#pragma unroll
    for (int nt = NT0; nt < NT0 + 10; ++nt) {
        const bf16x8_t b0 = *(const bf16x8_t*)(Ks + (nt * 16 + fr) * 72 + 8 * fq), b1 = *(const bf16x8_t*)(Ks + (nt * 16 + fr) * 72 + 32 + 8 * fq);
#pragma unroll
        for (int mt = 0; mt < 2; ++mt) { f32x4 a = (f32x4){0.f, 0.f, 0.f, 0.f}; a = mfma16(aQ[mt][0], b0, a); a = mfma16(aQ[mt][1], b1, a); sc[mt][nt] = a; }
    }
    const float sink = sink_raw * 1.4426950408889634f;
    const float* bt = Bt + g * 256 + 64;
    float rinv[2][4];
    float kadd[12];
#pragma unroll
    for (int nt = NT0; nt < NT0 + 10; ++nt) kadd[nt] = (q0 - 128 + nt * 16 + fr) >= 0 ? 0.f : -INFINITY;
#pragma unroll
    for (int mt = 0; mt < 2; ++mt)
#pragma unroll
        for (int r = 0; r < 4; ++r) {
            const int qi = qs + mt * 16 + 4 * fq + r;
            float mx = sink;
#pragma unroll
            for (int nt = NT0; nt < NT0 + 10; ++nt) {
                const int kk = nt * 16 + fr, rel = qi + 128 - kk;
                const float lg = (sc[mt][nt][r] * (0.125f * 1.4426950408889634f) + bt[rel]) + kadd[nt];
                sc[mt][nt][r] = lg; mx = fmaxf(mx, lg);
            }
            mx = fmaxf(mx, DPPF(mx, 0xB1, 0xf)); mx = fmaxf(mx, DPPF(mx, 0x4E, 0xf)); mx = fmaxf(mx, DPPF(mx, 0x141, 0xf)); mx = fmaxf(mx, DPPF(mx, 0x140, 0xf));
            float sum = 0.f;
#pragma unroll
            for (int nt = NT0; nt < NT0 + 10; ++nt) { const float p = __builtin_amdgcn_exp2f(sc[mt][nt][r] - mx); sc[mt][nt][r] = p; sum += p; }
            sum += DPPF(sum, 0xB1, 0xf); sum += DPPF(sum, 0x4E, 0xf); sum += DPPF(sum, 0x141, 0xf); sum += DPPF(sum, 0x140, 0xf);
            rinv[mt][r] = 1.0f / (sum + __builtin_amdgcn_exp2f(sink - mx));
        }
    f32x4 oacc[2][4];
#pragma unroll
    for (int mt = 0; mt < 2; ++mt)
#pragma unroll
        for (int dt = 0; dt < 4; ++dt) oacc[mt][dt] = (f32x4){0.f, 0.f, 0.f, 0.f};
#pragma unroll
    for (int kc = 0; kc < 3; ++kc) {
#pragma unroll
        for (int mt = 0; mt < 2; ++mt)
#pragma unroll
            for (int n4 = 0; n4 < 4; ++n4)
#pragma unroll
                for (int r = 0; r < 4; ++r) if (kc * 4 + n4 >= NT0 && kc * 4 + n4 < NT0 + 10) Pw[(mt * 16 + 4 * fq + r) * 72 + n4 * 16 + fr] = (bf16)f2bf(sc[mt][kc * 4 + n4][r]);
        asm volatile("s_waitcnt lgkmcnt(0)" ::: "memory");
#pragma unroll
        for (int ks = 0; ks < 2; ++ks) {
            if (kc * 4 + ks * 2 < NT0 || kc * 4 + ks * 2 >= NT0 + 10) continue;
            const bf16x8_t p0 = *(const bf16x8_t*)(Pw + fr * 72 + ks * 32 + 8 * fq), p1 = *(const bf16x8_t*)(Pw + (16 + fr) * 72 + ks * 32 + 8 * fq);
#pragma unroll
            for (int dt = 0; dt < 4; ++dt) {
                const bf16x8_t bv = *(const bf16x8_t*)(Vt + (dt * 16 + fr) * 200 + kc * 64 + ks * 32 + 8 * fq);
                oacc[0][dt] = mfma16(p0, bv, oacc[0][dt]); oacc[1][dt] = mfma16(p1, bv, oacc[1][dt]);
            }
        }
        asm volatile("s_waitcnt lgkmcnt(0)" ::: "memory");
    }
#pragma unroll
    for (int mt = 0; mt < 2; ++mt)
#pragma unroll
        for (int dt = 0; dt < 4; ++dt)
#pragma unroll
            for (int r = 0; r < 4; ++r) Pw[(mt * 16 + 4 * fq + r) * 72 + dt * 16 + fr] = (bf16)f2bf(oacc[mt][dt][r] * rinv[mt][r]);
    asm volatile("s_waitcnt lgkmcnt(0)" ::: "memory");
#pragma unroll
    for (int k = 0; k < 4; ++k) {
        const int ci = lane + 64 * k, row = ci >> 3, part = ci & 7;
        *(v4u*)(ATT + (size_t)(tb + q0 + qs + row) * D + hh * 64 + part * 8) = *(const v4u*)(Pw + row * 72 + part * 8);
    }
}
struct AttnPre { v4u kv[3], vv[3]; float bt[2]; bf16x8_t aQ[2][2]; };
__device__ __forceinline__ void attn_load(AttnPre& p, const bf16* __restrict__ PCb, const float* __restrict__ rel_bias, int un, int tid) {
    const int lane = tid & 63, wave = tid >> 6, fr = lane & 15, fq = lane >> 4;
    const int kvh = un & 3, qblk = (un >> 2) & 63, b = un >> 8, q0 = qblk * 64, tb = b * SEQ;
#pragma unroll
    for (int k = 0; k < 3; ++k) {
        const int ci = tid + 512 * k, row = ci >> 3, part = ci & 7, kpos = q0 - 128 + row;
        p.kv[k] = (v4u){0u, 0u, 0u, 0u}; p.vv[k] = p.kv[k];
        if (kpos >= 0) { const bf16* src = PCb + (size_t)(tb + kpos) * CN + kvh * 64 + part * 8; p.kv[k] = *(const v4u*)(src + 1024); p.vv[k] = *(const v4u*)(src + 1280); }
    }
#pragma unroll
    for (int k = 0; k < 2; ++k) { const int idx = tid + 512 * k, g_ = idx >> 8, rel = (idx & 255) - 64;
        p.bt[k] = (rel >= 0 && rel < 128) ? rel_bias[t5_bucket(rel) * 16 + kvh * 4 + g_] * 1.4426950408889634f : -INFINITY; }
    const int g = wave >> 1, qs = (wave & 1) * 32, hh = kvh * 4 + g;
#pragma unroll
    for (int mt = 0; mt < 2; ++mt)
#pragma unroll
        for (int ks = 0; ks < 2; ++ks) p.aQ[mt][ks] = *(const bf16x8_t*)(PCb + (size_t)(tb + q0 + qs + mt * 16 + fr) * CN + hh * 64 + ks * 32 + 8 * fq);
}
__device__ __forceinline__ void attn_unit(const bf16* __restrict__ PCb, const float* __restrict__ rel_bias, const float* __restrict__ sinks, bf16* __restrict__ ATT, int un, int un_next, AttnPre& pre, unsigned char* lds) {
    int tid = threadIdx.x; asm volatile("" : "+v"(tid));
    const int lane = tid & 63, wave = __builtin_amdgcn_readfirstlane(tid >> 6), fr = lane & 15, fq = lane >> 4;
    const int kvh = un & 3, qblk = (un >> 2) & 63, b = un >> 8;
    const int q0 = qblk * 64, tb = b * SEQ;
    bf16* Ks = (bf16*)(lds + AT_KS); bf16* Vt = (bf16*)(lds + AT_VT); float* Bt = (float*)(lds + AT_BT); bf16* Pw = (bf16*)(lds + AT_PW) + wave * 32 * 72;
#pragma unroll
    for (int k = 0; k < 3; ++k) {
        const int ci = tid + 512 * k, row = ci >> 3, part = ci & 7;
        const v4u kv = pre.kv[k], vv = pre.vv[k];
        *(v4u*)(Ks + row * 72 + part * 8) = kv;
        bf16* vd = Vt + (part * 8) * 200 + row;
        vd[0 * 200] = (bf16)(vv.x & 0xffffu); vd[1 * 200] = (bf16)(vv.x >> 16); vd[2 * 200] = (bf16)(vv.y & 0xffffu); vd[3 * 200] = (bf16)(vv.y >> 16);
        vd[4 * 200] = (bf16)(vv.z & 0xffffu); vd[5 * 200] = (bf16)(vv.z >> 16); vd[6 * 200] = (bf16)(vv.w & 0xffffu); vd[7 * 200] = (bf16)(vv.w >> 16);
    }
    Bt[tid] = pre.bt[0]; Bt[tid + 512] = pre.bt[1];
    bf16x8_t aQ[2][2];
#pragma unroll
    for (int mt = 0; mt < 2; ++mt)
#pragma unroll
        for (int ks = 0; ks < 2; ++ks) aQ[mt][ks] = pre.aQ[mt][ks];
    float sink_raw = sinks[kvh * 4 + (wave >> 1)];
    asm volatile("s_waitcnt vmcnt(0)" : "+v"(sink_raw));
    __syncthreads();
    if (un_next >= 0) attn_load(pre, PCb, rel_bias, un_next, tid);
    if (wave & 1) attn_core<32>(PCb, sinks, ATT, kvh, q0, tb, wave, lane, fr, fq, Ks, Vt, Bt, Pw, aQ, sink_raw);
    else attn_core<0>(PCb, sinks, ATT, kvh, q0, tb, wave, lane, fr, fq, Ks, Vt, Bt, Pw, aQ, sink_raw);
    __syncthreads();
}

__device__ __forceinline__ void swa_attn_sample(const bf16* __restrict__ PCb, const float* __restrict__ cache_k, const float* __restrict__ cache_v,
                                                const float* __restrict__ rel_bias, const float* __restrict__ sinks, bf16* __restrict__ ATT, int gw, int lane) {
    const int sb = gw >> 4, h = gw & 15, kvh = h >> 2, t = NP + sb;
    const bf16* qrow = PCb + (size_t)t * CN + h * 64;
    float lg[2];
#pragma unroll
    for (int rr = 0; rr < 2; ++rr) {
        const int r = lane + 64 * rr;
        float dot = 0.f;
        if (r == 0) {
            const bf16* krow = PCb + (size_t)t * CN + 1024 + kvh * 64;
            for (int d = 0; d < 64; ++d) dot += bf2f(qrow[d]) * bf2f(krow[d]);
        } else {
            const float* krow = cache_k + (((size_t)sb * 128 + (128 - r)) * 4 + kvh) * 64;
#pragma unroll
            for (int d4 = 0; d4 < 16; ++d4) { const float4 kv = *(const float4*)(krow + d4 * 4);
                dot += bf2f(qrow[d4 * 4]) * kv.x + bf2f(qrow[d4 * 4 + 1]) * kv.y + bf2f(qrow[d4 * 4 + 2]) * kv.z + bf2f(qrow[d4 * 4 + 3]) * kv.w; }
        }
        lg[rr] = dot * 0.125f + rel_bias[t5_bucket(r) * 16 + h];
    }
    const float sink = sinks[h];
    const float m = fmaxf(wave_max(fmaxf(lg[0], lg[1])), sink);
    float p[2] = {expf(lg[0] - m), expf(lg[1] - m)};
    const float inv = 1.0f / (wave_sum(p[0] + p[1]) + expf(sink - m));
    float o = 0.f;
#pragma unroll
    for (int rr = 0; rr < 2; ++rr)
#pragma unroll 1
        for (int lb = 0; lb < 64; lb += 16) {
            float vv[16];
#pragma unroll
            for (int k = 0; k < 16; ++k) { const int r = lb + k + 64 * rr;
                vv[k] = (r == 0) ? bf2f(PCb[(size_t)t * CN + 1280 + kvh * 64 + lane]) : cache_v[(((size_t)sb * 128 + (128 - r)) * 4 + kvh) * 64 + lane]; }
#pragma unroll
            for (int k = 0; k < 16; ++k) o += __shfl(p[rr], lb + k) * vv[k];
        }
    ATT[(size_t)t * D + h * 64 + lane] = (bf16)f2bf(o * inv);
}
__device__ __forceinline__ void swa_kv_out3(const bf16* __restrict__ PCb, const float* __restrict__ cache_k, const float* __restrict__ cache_v,
                                            float* __restrict__ pk, float* __restrict__ pv, float* __restrict__ sk, float* __restrict__ sv, int item) {
    int tid = threadIdx.x; asm volatile("" : "+v"(tid));
    if (item < 256) {
        const int sb = item >> 1, isv = item & 1;
        const f32x4* src = (const f32x4*)((isv ? cache_v : cache_k) + ((size_t)sb * 128 + 1) * 256);
        f32x4* dst = (f32x4*)((isv ? sv : sk) + (size_t)sb * 128 * 256);
#pragma unroll 4
        for (int i = tid; i < 127 * 64; i += NTH) dst[i] = src[i];
        if (tid < 32) {
            const v4u w = *(const v4u*)(PCb + (size_t)(NP + sb) * CN + 1024 + isv * 256 + tid * 8);
            f32x4* d = dst + 127 * 64 + tid * 2;
            d[0] = (f32x4){bflo(w.x), bfhi(w.x), bflo(w.y), bfhi(w.y)}; d[1] = (f32x4){bflo(w.z), bfhi(w.z), bflo(w.w), bfhi(w.w)};
        }
    } else {
        const int b = item - 256;
#pragma unroll 4
        for (int e = tid; e < 128 * 64; e += NTH) {
            const int row = e >> 6, part = e & 63;
            const v4u w = *(const v4u*)(PCb + (size_t)(b * SEQ + SEQ - 128 + row) * CN + 1024 + part * 8);
            f32x4* d = (f32x4*)((part < 32 ? pk : pv) + ((size_t)b * 128 + row) * 256 + (part & 31) * 8);
            d[0] = (f32x4){bflo(w.x), bfhi(w.x), bflo(w.y), bfhi(w.y)}; d[1] = (f32x4){bflo(w.z), bfhi(w.z), bflo(w.w), bfhi(w.w)};
        }
    }
}


constexpr int PC_STRIDE = 1040, PC_RED = 80 * PC_STRIDE;
template <class StoreF>
__device__ __forceinline__ void gemm_piece80(const bf16* __restrict__ arows, const bf16* __restrict__ brows, unsigned char* lds, const StoreF& store) {
    int tid = threadIdx.x; asm volatile("" : "+v"(tid));
    const int lane = tid & 63, wave = __builtin_amdgcn_readfirstlane(tid >> 6), fr = lane & 15, fq = lane >> 4;
    const int rsel = tid >> 6, ch = tid & 63, nt = wave & 3, kq = wave >> 2;
    v4u st[2][10];
#pragma unroll
    for (int h = 0; h < 2; ++h)
#pragma unroll
        for (int r = 0; r < 10; ++r) {
            const bf16* src = (r < 2 ? arows + (size_t)(r * 8 + rsel) * D : brows + (size_t)(r * 8 + rsel - 16) * D) + h * 512 + ch * 8;
            st[h][r] = *(const v4u*)src;
        }
    f32x4 acc = (f32x4){0.f, 0.f, 0.f, 0.f};
#pragma unroll
    for (int h = 0; h < 2; ++h) {
        if (h) __syncthreads();
#pragma unroll
        for (int r = 0; r < 10; ++r) *(v4u*)(lds + (r * 8 + rsel) * PC_STRIDE + ch * 16) = st[h][r];
        __syncthreads();
#pragma unroll
        for (int ks = 0; ks < 8; ++ks) {
            const bf16x8_t a = *(const bf16x8_t*)(lds + fr * PC_STRIDE + (kq * 256 + ks * 32 + 8 * fq) * 2);
            const bf16x8_t b = *(const bf16x8_t*)(lds + (16 + nt * 16 + fr) * PC_STRIDE + (kq * 256 + ks * 32 + 8 * fq) * 2);
            acc = mfma16(a, b, acc);
        }
    }
    f32x4* part = (f32x4*)(lds + PC_RED);
    if (kq == 1) part[nt * 64 + lane] = acc;
    __syncthreads();
    if (kq == 0) { acc = acc + part[nt * 64 + lane]; store(acc, nt, fr, fq); }
}
__device__ __forceinline__ void sample_gemm_piece(const bf16* __restrict__ A, const bf16* __restrict__ Bt, const float* __restrict__ bias, bf16* __restrict__ O, int ldc, int p, unsigned char* lds) {
    const int mt = p & 7, cb = p >> 3;
    gemm_piece80(A + (size_t)(NP + mt * 16) * D, Bt + (size_t)(cb * 64) * D, lds, [&](const f32x4& acc, int nt, int fr, int fq) {
        const int col = cb * 64 + nt * 16 + fr; const float bv = bias ? bias[col] : 0.f;
#pragma unroll
        for (int r = 0; r < 4; ++r) O[(size_t)(NP + mt * 16 + 4 * fq + r) * ldc + col] = (bf16)f2bf(acc[r] + bv);
    });
}
__device__ __forceinline__ void ab_cols_piece(const bf16* __restrict__ A, const bf16* __restrict__ Bt, bf16* __restrict__ O, int tg, unsigned char* lds) {
    gemm_piece80(Bt + (size_t)ABMAIN * D, A + (size_t)(tg * 64) * D, lds, [&](const f32x4& acc, int nt, int fr, int fq) {
        if (fq < 2) { uint2 o; o.x = pk2(acc[0], acc[1]); o.y = pk2(acc[2], acc[3]); *(uint2*)(O + (size_t)(tg * 64 + nt * 16 + fr) * ABN + ABMAIN + 4 * fq) = o; }
    });
}

constexpr size_t MiB = 1u << 20;
constexpr size_t WS_CTL = 0, CTL_ZERO_BYTES = 64 * 1024;
constexpr size_t WS_WAB = 1 * MiB;
constexpr size_t WS_WOUT = WS_WAB + (size_t)ABNP * D * 2;
constexpr size_t WS_WQ0 = WS_WOUT + (size_t)D * D * 2;
constexpr size_t WS_WQ1 = WS_WQ0 + (size_t)2048 * D * 2;
constexpr size_t WS_WINC = WS_WQ1 + (size_t)2048 * D * 2;
constexpr size_t WS_WOUTC = WS_WINC + (size_t)CN * D * 2;
constexpr size_t WS_ABUF = WS_WOUTC + (size_t)D * D * 2;
constexpr size_t WS_P = WS_ABUF + (size_t)MP * D * 2;
constexpr size_t WS_T = WS_P + (size_t)MP * ABN * 2;
constexpr size_t WS_Q = WS_T + (size_t)4 * 16384 * D + (size_t)4 * 16384 * 4;
constexpr size_t WS_A = WS_Q + (size_t)MP * 1536 * 4;
constexpr size_t WS_B = WS_A + (size_t)MP * 512 * 4;
constexpr size_t WS_O = WS_B + (size_t)MP * 512 * 4;
constexpr size_t WS_X1 = WS_O + (size_t)MP * 512 * 4;
constexpr size_t WS_G = WS_X1 + (size_t)MP * D * 4;
constexpr size_t WS_BETA = WS_G + (size_t)MP * 4 * 4;
constexpr size_t WS_GATE = WS_BETA + (size_t)MP * 4 * 4;
constexpr size_t WS_EXP = WS_GATE + (size_t)MP * 128 * 4;
constexpr size_t WS_HEND = WS_EXP + (size_t)MP * 128 * 4;
constexpr size_t WS_KEYS = WS_HEND + (size_t)3 * 4 * 64 * 512 * 4;
constexpr size_t WS_WGT = WS_KEYS + (size_t)2 * 8 * 2 * 128 * 128 * 2;
constexpr size_t WS_END = WS_WGT + (size_t)2 * 8 * 64 * 64 * 2;
constexpr size_t Q_QKVS = 0, Q_W = 1 * MiB, Q_QG = Q_W + 16 * MiB, Q_KDT = Q_QG + 16 * MiB, Q_UT = Q_KDT + 16 * MiB, Q_QK = Q_UT + 16 * MiB, Q_EGL = Q_QK + 8 * MiB, Q_END = Q_EGL + 4096;
static_assert(Q_END <= (size_t)MP * 1536 * 4, "region Q");
static_assert(WS_END <= 512 * MiB, "d_ws map");

struct MegaArgs {
    const float* in[35];
    float* out;
    unsigned char* ws;
};

__global__ void __launch_bounds__(NTH, 2) fwd_megakernel(MegaArgs ma) {
    cg::grid_group grid = cg::this_grid();
    extern __shared__ __attribute__((aligned(16))) unsigned char lds[];
    float* smem = (float*)lds;
    const int nb = gridDim.x, b0 = blockIdx.x, wave = __builtin_amdgcn_readfirstlane(threadIdx.x >> 6);
    int tid = threadIdx.x, lane = tid & 63;
    const float* x_prompt = ma.in[0];
    const float* x_sample = ma.in[1];
    const float* state_gdn = ma.in[2];
    const float* state_gdn_conv = ma.in[3];
    const float* state_lru = ma.in[4];
    const float* state_lru_conv = ma.in[5];
    const float* cache_k = ma.in[6];
    const float* cache_v = ma.in[7];
    const float* w_in_ab = ma.in[8];
    const float* gdn_conv_w = ma.in[9];
    const float* gdn_a_log = ma.in[10];
    const float* gdn_dt_bias = ma.in[11];
    const float* gdn_norm_w = ma.in[12];
    const float* lru_conv_w = ma.in[13];
    const float* lru_conv_b = ma.in[14];
    const float* lru_w_r = ma.in[15];
    const float* lru_b_r = ma.in[16];
    const float* lru_w_i = ma.in[17];
    const float* lru_b_i = ma.in[18];
    const float* lru_lam = ma.in[19];
    const float* w_out_ab = ma.in[20];
    const float* w_in_c = ma.in[21];
    const float* b_in_c = ma.in[22];
    const float* swa_sinks = ma.in[23];
    const float* w_out_c = ma.in[24];
    const float* b_out_c = ma.in[25];
    const float* rel_bias = ma.in[26];
    const float* ln_mix_g = ma.in[27];
    const float* ln_mix_b = ma.in[28];
    const float* ln_ffn_g = ma.in[29];
    const float* ln_ffn_b = ma.in[30];
    const float* peer_w_q = ma.in[31];
    const float* peer_keys = ma.in[32];
    const float* peer_u = ma.in[33];
    const float* peer_v = ma.in[34];

    float* out = ma.out;
    float* o_y = out;
    float* o_p_gdn = out + (size_t)NT * D;
    float* o_p_gdn_conv = o_p_gdn + 262144;
    float* o_p_lru = o_p_gdn_conv + 18432;
    float* o_p_lru_conv = o_p_lru + 2048;
    float* o_p_k = o_p_lru_conv + 6144;
    float* o_p_v = o_p_k + 131072;
    float* o_s_gdn = o_p_v + 131072;
    float* o_s_gdn_conv = o_s_gdn + 8388608;
    float* o_s_lru = o_s_gdn_conv + 589824;
    float* o_s_lru_conv = o_s_lru + 65536;
    float* o_s_k = o_s_lru_conv + 196608;
    float* o_s_v = o_s_k + 4194304;

    unsigned char* ws = ma.ws;
    bf16* WAB_T = (bf16*)(ws + WS_WAB); bf16* WOUT_T = (bf16*)(ws + WS_WOUT); bf16* WQ0_T = (bf16*)(ws + WS_WQ0); bf16* WQ1_T = (bf16*)(ws + WS_WQ1);
    bf16* WINC_T = (bf16*)(ws + WS_WINC); bf16* WOUTC_T = (bf16*)(ws + WS_WOUTC);
    bf16* ABUF = (bf16*)(ws + WS_ABUF);
    bf16* PROJ = (bf16*)(ws + WS_P); float* Y = (float*)(ws + WS_P); bf16* Qb = (bf16*)(ws + WS_P); bf16* PCb = (bf16*)(ws + WS_P); float* Y1 = (float*)(ws + WS_P);
    unsigned char* TAB8 = ws + WS_T; float* TSC = (float*)(ws + WS_T + (size_t)4 * 16384 * D);
    float* R_Q = (float*)(ws + WS_Q + Q_QKVS) - (size_t)NP * 1536; float* X2 = (float*)(ws + WS_A);
    GdnChunkBufs cbuf; cbuf.W = (bf16*)(ws + WS_Q + Q_W); cbuf.QG = (bf16*)(ws + WS_Q + Q_QG); cbuf.KDT = (bf16*)(ws + WS_Q + Q_KDT); cbuf.UT = (bf16*)(ws + WS_Q + Q_UT); cbuf.QK = (bf16*)(ws + WS_Q + Q_QK); cbuf.EGL = (float*)(ws + WS_Q + Q_EGL);
    bf16* Yb = (bf16*)(ws + WS_P);
    float* OUTS = (float*)(ws + WS_Q);
    float* PD = (float*)(ws + WS_P);
    bf16* KEYSB = (bf16*)(ws + WS_KEYS); bf16* WRT = (bf16*)(ws + WS_WGT); bf16* WIT = WRT + 8 * 64 * 64;
    float* HEND = (float*)(ws + WS_HEND); float* PEND = HEND + 4 * 64 * 512; float* CIN = PEND + 4 * 64 * 512;
    float* R_A = (float*)(ws + WS_A); float* R_B = (float*)(ws + WS_B); float* R_O = (float*)(ws + WS_O);
    bf16* ATTB = (bf16*)(ws + WS_X1);
    float* R_G = (float*)(ws + WS_G); float* R_BETA = (float*)(ws + WS_BETA); float* R_GATE = (float*)(ws + WS_GATE); int* R_EXP = (int*)(ws + WS_EXP);

    for (int u = tid; u < (LDS_BYTES - RING_BYTES) / 4; u += NTH) ((unsigned*)(lds + RING_BYTES))[u] = 0u;
    __syncthreads();
    XcdBarrier bar = xcd_barrier_post((unsigned*)(ws + WS_CTL), (volatile LAS unsigned*)((LAS unsigned char*)lds + MISC_OFF) + 8);
#define GRID_BAR() do { xcd_barrier(bar); asm volatile("" : "+v"(tid)); lane = tid & 63; } while (0)
#define PHASE_LOOP(n) for (int vb = b0; vb < (n); vb += nb)
#define PHASE_END __syncthreads()
#define GEMM_PHASE_M(Mrows, EPI, Aptr, Btptr, Nn, ...) do { pg8::Gemm g_{(const pg8::bf16_t*)(Aptr), (const pg8::bf16_t*)(Btptr), (Mrows), (Nn), D}; pg8::StaticOrder S_; S_.init((Mrows), (Nn), nb, b0); \
        pg8::EPI E_{__VA_ARGS__}; pg8::gemm_phase<pg8::EPI, pg8::StaticOrder, true, true>((PG8_LAS unsigned char*)lds, g_, S_, E_); } while (0)
#define GEMM_PHASE(EPI, Aptr, Btptr, Nn, ...) GEMM_PHASE_M(MP, EPI, Aptr, Btptr, Nn, __VA_ARGS__)
#define GEMM_PHASE_SPLIT(Aptr, Btptr, Nn, Optr, biasptr) do { GEMM_PHASE_M(NP, EpiStoreBf16, Aptr, Btptr, Nn, Optr, Nn, biasptr, NP, Nn); \
          \
        for (int j_ = b0 >> 3; (b0 & 7) + 8 * (j_ >> 3) < (Nn) / 64; j_ += nb >> 3) sample_gemm_piece(Aptr, Btptr, biasptr, Optr, Nn, (j_ & 7) | (((b0 & 7) + 8 * (j_ >> 3)) << 3), lds); } while (0)

    {
        float* scr = smem + wave * 4096;
        const int gw = b0 * NWAVES + wave, NGW = nb * NWAVES;
        constexpr int I_AB = 16 * 97, I_OUT = 16 * 32, I_Q = 16 * 64, I_INC = 16 * 48;
        constexpr int NITEMS = I_AB + I_OUT + 2 * I_Q + I_INC + I_OUT;
        for (int it = gw; it < NITEMS; it += NGW) {
            int r = it;
            if (r < I_AB) { p0_transpose_item<true>(w_in_ab, D, ABN, WAB_T, scr, r, lane); continue; } r -= I_AB;
            if (r < I_OUT) { p0_transpose_item(w_out_ab, D, D, WOUT_T, scr, r, lane); continue; } r -= I_OUT;
            if (r < I_Q) { p0_transpose_item(peer_w_q, D, 2048, WQ0_T, scr, r, lane); continue; } r -= I_Q;
            if (r < I_Q) { p0_transpose_item(peer_w_q + (size_t)D * 2048, D, 2048, WQ1_T, scr, r, lane); continue; } r -= I_Q;
            if (r < I_INC) { p0_transpose_item(w_in_c, D, CN, WINC_T, scr, r, lane); continue; } r -= I_INC;
            p0_transpose_item(w_out_c, D, D, WOUTC_T, scr, r, lane);
        }
        for (int it = b0 * NTH + tid; it < 2 * 8 * 64 * 8; it += nb * NTH) {
            const int gsel = it >> 12, nn = (it >> 9) & 7, dd = (it >> 3) & 63, c8 = (it & 7) * 8;
            const float* wsrc = (gsel ? lru_w_i : lru_w_r) + ((size_t)nn * 64 + c8) * 64 + dd;
            v4u o; o.x = pk2(wsrc[0], wsrc[64]); o.y = pk2(wsrc[128], wsrc[192]); o.z = pk2(wsrc[256], wsrc[320]); o.w = pk2(wsrc[384], wsrc[448]);
            *(v4u*)((gsel ? WIT : WRT) + ((size_t)nn * 64 + dd) * 64 + c8) = o;
        }
        for (int m = gw; m < MP + (ABNP - 97 * 32); m += NGW) {
            if (m < MP) row_to_bf16(m < NP ? x_prompt + (size_t)m * D : (m < NT ? x_sample + (size_t)(m - NP) * D : nullptr), ABUF + (size_t)m * D, lane);
            else row_to_bf16(nullptr, WAB_T + (size_t)(97 * 32 + (m - MP)) * D, lane);
        }
    }
    GRID_BAR();
    if (ma.out == nullptr) grid.sync();
    GEMM_PHASE(EpiStoreBf16, ABUF, WAB_T, ABNP, PROJ, ABN, nullptr, NT, ABN);
    GRID_BAR();
    ConvJob cjob; cjob.u0 = peer_u; cjob.v0 = peer_v; cjob.tab = TAB8; cjob.tsc = TSC;
    constexpr int NSPLIT = 32, A_LRU = 4 * NSPLIT, A_GDN = 16 * NSPLIT, B_LRU = 4 * (64 - NSPLIT), B_GDN = 16 * (64 - NSPLIT);
    { AbPrepArgs pa;
      pa.PROJ = PROJ; pa.st_gdn_conv = state_gdn_conv; pa.st_lru_conv = state_lru_conv;
      pa.gdn_conv_w = gdn_conv_w; pa.a_log = gdn_a_log; pa.dt_bias = gdn_dt_bias;
      pa.lru_conv_w = lru_conv_w; pa.lru_conv_b = lru_conv_b; pa.w_r = lru_w_r; pa.b_r = lru_b_r; pa.w_i = lru_w_i; pa.b_i = lru_b_i; pa.lam = lru_lam;
      pa.QKV = R_Q; pa.G = R_G; pa.BETA = R_BETA; pa.LA = R_A; pa.LB = R_B;
      pa.p_gdn_conv = o_p_gdn_conv; pa.p_lru_conv = o_p_lru_conv; pa.s_gdn_conv = o_s_gdn_conv; pa.s_lru_conv = o_s_lru_conv;
      for (int v = b0; v < A_LRU + NS + A_GDN; v += nb) {
          if (v < A_LRU) { lru_prep_unit2(PROJ, lru_conv_w, lru_conv_b, WRT, WIT, lru_b_r, lru_b_i, lru_lam, R_B, R_A, HEND, PEND, o_p_lru_conv, (v / NSPLIT) * 64 + (v % NSPLIT), lds); PHASE_END; }
          else if (v < A_LRU + NS) { ab_prep(pa, NP + (v - A_LRU), smem); PHASE_END; }
          else { const int i = v - A_LRU - NS, h_ = i & 3, n_ = (i >> 2) % NSPLIT, b_ = (i >> 2) / NSPLIT;
                 gdn_prep_unit(PROJ, gdn_conv_w, gdn_a_log, gdn_dt_bias, cbuf, o_p_gdn_conv, (b_ * 64 + n_) * 4 + h_, lds, cjob); }
      } }
    GRID_BAR();
    f32x4 seqS[2]; int seqcur = 0;
    const int seq_p = (b0 & 7) + 8 * (b0 >> 5), seq_s = (b0 >> 3) & 3;
    if (b0 < 64) {
        gdn_seq<0, NSPLIT>(cbuf, R_O, o_p_gdn, seq_p >> 2, seq_p & 3, seq_s, lds, seqS, seqcur);
        table_rows_convert<false>(peer_u + (size_t)16384 * D, TAB8 + (size_t)2 * 16384 * D, TSC + 2 * 16384, 0, 16384, b0 * NWAVES + wave, 64 * NWAVES, lane);
    }
    else for (int v = b0 - 64; v < B_LRU + B_GDN; v += nb - 64) {
        if (v < B_LRU) { lru_prep_unit2(PROJ, lru_conv_w, lru_conv_b, WRT, WIT, lru_b_r, lru_b_i, lru_lam, R_B, R_A, HEND, PEND, o_p_lru_conv, (v / (64 - NSPLIT)) * 64 + NSPLIT + (v % (64 - NSPLIT)), lds); PHASE_END; }
        else { const int i = v - B_LRU, h_ = i & 3, n_ = NSPLIT + (i >> 2) % (64 - NSPLIT), b_ = (i >> 2) / (64 - NSPLIT);
               gdn_prep_unit(PROJ, gdn_conv_w, gdn_a_log, gdn_dt_bias, cbuf, o_p_gdn_conv, (b_ * 64 + n_) * 4 + h_, lds, cjob); }
    }
    GRID_BAR();
    if (b0 < 64) gdn_seq<NSPLIT, 64>(cbuf, R_O, o_p_gdn, seq_p >> 2, seq_p & 3, seq_s, lds, seqS, seqcur);
    else if (b0 < 68) lru_carry(HEND, PEND, CIN, o_p_lru, b0 - 64);
    else {
        for (int v = (b0 - 68) * NWAVES + wave; v < NS * 4 * 8; v += (nb - 68) * NWAVES) gdn_step_sample_w(R_Q, R_G, R_BETA, state_gdn, R_O, o_s_gdn, v, lane);
        for (int v = b0 - 68; v < 128; v += nb - 68) lru_scan(R_A, R_B, state_lru, o_s_lru, NP, 1, NS, v);
        const int gw2 = (b0 - 68) * NWAVES + wave, NGW2 = (nb - 68) * NWAVES;
        for (int m = gw2; m < 512; m += NGW2) row_to_bf16(peer_keys + (size_t)m * D, KEYSB + (size_t)m * D, lane);
        table_rows_convert<true>(peer_v + (size_t)16384 * D, TAB8 + (size_t)3 * 16384 * D, TSC + 3 * 16384, 0, 16384, gw2, NGW2, lane);
    }
    GRID_BAR();
    PHASE_LOOP(NT / 8) { ab_mix_w(PROJ, R_O, R_B, R_A, CIN, gdn_norm_w, ABUF, vb * 8 + wave, lane); }
    GRID_BAR();
    GEMM_PHASE_SPLIT(ABUF, WOUT_T, D, Yb, (const float*)nullptr);
    GRID_BAR();
    PHASE_LOOP(NT / 8) { const int t = vb * 8 + wave;
        ln_res_w<false>(t < NP ? x_prompt + (size_t)t * D : x_sample + (size_t)(t - NP) * D, Yb + (size_t)t * D, ln_mix_g, ln_mix_b, ABUF + (size_t)t * D, lane); }
    GRID_BAR();
    GEMM_PHASE_SPLIT(ABUF, WQ0_T, 2048, Qb, (const float*)nullptr);
    GRID_BAR();
    { bf16x8_t tq_[4]; if (b0 < (NT / 64) * 8) peer_topk_ldq(tq_, Qb, b0 >> 3, b0 & 7, tid);
      if ((nb & 7) == 0) { peer_topk_stage_keys(KEYSB, b0 & 7, lds); PHASE_LOOP((NT / 64) * 8) { peer_topk4(Qb, R_EXP, R_GATE, vb >> 3, vb & 7, lds, tq_, vb + nb < (NT / 64) * 8 ? (vb + nb) >> 3 : -1); } }
      else PHASE_LOOP((NT / 64) * 8) { peer_topk_stage_keys(KEYSB, vb & 7, lds); peer_topk_ldq(tq_, Qb, vb >> 3, vb & 7, tid); peer_topk4(Qb, R_EXP, R_GATE, vb >> 3, vb & 7, lds, tq_, -1); } }
    GRID_BAR();
    asm volatile("" : "+v"(tid)); lane = tid & 63;
    { const int x = b0 & 7, tg0 = b0 >> 3, tgstep = nb >> 3, nit = (NT / 8 - tg0 + tgstep - 1) / tgstep;
      peer_u_loop(ABUF, R_EXP, TAB8 + (size_t)x * 16384 * 128, PD + (size_t)x * NT * 128, x, tg0, tgstep, nit, wave, lane); }
    GRID_BAR();
    PHASE_LOOP(NT / 8) { const int t = vb * 8 + wave; peer_xk(R_EXP + (size_t)t * 128, R_GATE + (size_t)t * 128, PD + (size_t)t * 128, TSC, TSC + 16384, lane); }
    GRID_BAR();
    { const int x = b0 & 7, tg0 = b0 >> 3, tgstep = nb >> 3, nit = (NT / 8 - tg0 + tgstep - 1) / tgstep;
      peer_v_loop(R_EXP, R_GATE, TAB8 + (size_t)16384 * D + (size_t)x * 16384 * 128, OUTS, x, tg0, tgstep, nit, wave, lane); }
    GRID_BAR();
    PHASE_LOOP(NT / 8) { const int t = vb * 8 + wave; peer_xc(ABUF + (size_t)t * D, OUTS + (size_t)t * D, ln_ffn_g, ln_ffn_b, nullptr, ABUF + (size_t)t * D, nullptr, lane); }
    GRID_BAR();

    GEMM_PHASE(EpiStoreBf16, ABUF, WINC_T, CN, PCb, CN, b_in_c, NT, CN);
    GRID_BAR();
    AttnPre apre; attn_load(apre, PCb, rel_bias, b0, tid);
    PHASE_LOOP(1024 + 256 + 260) {
        if (vb < 1024) attn_unit(PCb, rel_bias, swa_sinks, ATTB, vb, vb + nb < 1024 ? vb + nb : -1, apre, lds);
        else if (vb < 1280) swa_attn_sample(PCb, cache_k, cache_v, rel_bias, swa_sinks, ATTB, (vb - 1024) * 8 + wave, lane);
        else swa_kv_out3(PCb, cache_k, cache_v, o_p_k, o_p_v, o_s_k, o_s_v, vb - 1280);
    }
    GRID_BAR();
    GEMM_PHASE_SPLIT(ATTB, WOUTC_T, D, Yb, b_out_c);
    GRID_BAR();
    PHASE_LOOP(NT / 8) { const int t = vb * 8 + wave;
        ln_res_w<true>(ABUF + (size_t)t * D, Yb + (size_t)t * D, ln_mix_g + D, ln_mix_b + D, ABUF + (size_t)t * D, lane); }
    GRID_BAR();
    GEMM_PHASE_SPLIT(ABUF, WQ1_T, 2048, Qb, (const float*)nullptr);
    GRID_BAR();
    { bf16x8_t tq_[4]; if (b0 < (NT / 64) * 8) peer_topk_ldq(tq_, Qb, b0 >> 3, b0 & 7, tid);
      if ((nb & 7) == 0) { peer_topk_stage_keys(KEYSB + (size_t)8 * 2 * 128 * 128, b0 & 7, lds); PHASE_LOOP((NT / 64) * 8) { peer_topk4(Qb, R_EXP, R_GATE, vb >> 3, vb & 7, lds, tq_, vb + nb < (NT / 64) * 8 ? (vb + nb) >> 3 : -1); } }
      else PHASE_LOOP((NT / 64) * 8) { peer_topk_stage_keys(KEYSB + (size_t)8 * 2 * 128 * 128, vb & 7, lds); peer_topk_ldq(tq_, Qb, vb >> 3, vb & 7, tid); peer_topk4(Qb, R_EXP, R_GATE, vb >> 3, vb & 7, lds, tq_, -1); } }
    GRID_BAR();
    asm volatile("" : "+v"(tid)); lane = tid & 63;
    { const int x = b0 & 7, tg0 = b0 >> 3, tgstep = nb >> 3, nit = (NT / 8 - tg0 + tgstep - 1) / tgstep;
      peer_u_loop(ABUF, R_EXP, TAB8 + (size_t)2 * 16384 * D + (size_t)x * 16384 * 128, PD + (size_t)x * NT * 128, x, tg0, tgstep, nit, wave, lane); }
    GRID_BAR();
    PHASE_LOOP(NT / 8) { const int t = vb * 8 + wave; peer_xk(R_EXP + (size_t)t * 128, R_GATE + (size_t)t * 128, PD + (size_t)t * 128, TSC + 2 * 16384, TSC + 3 * 16384, lane); }
    GRID_BAR();
    { const int x = b0 & 7, tg0 = b0 >> 3, tgstep = nb >> 3, nit = (NT / 8 - tg0 + tgstep - 1) / tgstep;
      peer_v_loop(R_EXP, R_GATE, TAB8 + (size_t)3 * 16384 * D + (size_t)x * 16384 * 128, OUTS, x, tg0, tgstep, nit, wave, lane); }
    GRID_BAR();
    PHASE_LOOP(NT / 8) { const int t = vb * 8 + wave; peer_xc(ABUF + (size_t)t * D, OUTS + (size_t)t * D, ln_ffn_g + D, ln_ffn_b + D, o_y + (size_t)t * D, nullptr, nullptr, lane); }
}
}

extern "C" void kernel_launch(void* const* d_in, const int* in_sizes, int n_in,
                              void* d_out, int out_size, void* d_ws, size_t ws_size,
                              hipStream_t stream) {
    static int grid_blocks = 0;
    if (!grid_blocks) {
        int dev = 0, cus = 0, per_cu = 0;
        (void)hipGetDevice(&dev);
        (void)hipDeviceGetAttribute(&cus, hipDeviceAttributeMultiprocessorCount, dev);
        if (hipFuncSetAttribute((const void*)fwd_megakernel, hipFuncAttributeMaxDynamicSharedMemorySize, LDS_BYTES) != hipSuccess) { fprintf(stderr, "hipFuncSetAttribute failed\n"); grid_blocks = -1; return; }
        (void)hipOccupancyMaxActiveBlocksPerMultiprocessor(&per_cu, (const void*)fwd_megakernel, NTH, LDS_BYTES);
        if (per_cu < 1) { fprintf(stderr, "occupancy query says %d blocks per CU\n", per_cu); grid_blocks = -1; return; }
        if (cus * per_cu < 256) { fprintf(stderr, "this kernel needs 256 co-resident workgroups (device reports %d CUs x %d)\n", cus, per_cu); grid_blocks = -1; return; }
        grid_blocks = 256;
    }
    if (grid_blocks < 0) return;
    (void)hipMemsetAsync((char*)d_ws + WS_CTL, 0, CTL_ZERO_BYTES, stream);
    MegaArgs ma{};
    for (int i = 0; i < 35; ++i) ma.in[i] = (const float*)d_in[i];
    ma.out = (float*)d_out;
    ma.ws = (unsigned char*)d_ws;
    void* args[] = {&ma};
    hipError_t e = hipLaunchCooperativeKernel((void*)fwd_megakernel, dim3(grid_blocks), dim3(NTH), args, LDS_BYTES, stream);
    if (e != hipSuccess) fprintf(stderr, "cooperative launch failed: %s (grid %d)\n", hipGetErrorString(e), grid_blocks);
}
```

```cpp
#include <hip/hip_runtime.h>
#include <hip/hip_cooperative_groups.h>
#include <cstdio>
#include <cstdint>
namespace cg = cooperative_groups;

namespace pg8 {
#define PG8_LAS __attribute__((address_space(3)))
typedef unsigned short bf16_t;
typedef short bf16x8 __attribute__((ext_vector_type(8)));
typedef float f32x4 __attribute__((ext_vector_type(4)));
typedef unsigned u32x4 __attribute__((ext_vector_type(4)));
constexpr int BM = 256, BK = 64, HALF = 128, HTB = HALF * BK * 2  , STAGE_BYTES = 8 * HTB, NXCD = 8, WGM = 8;

__host__ __device__ __forceinline__ int lds_byte(int r, int c) { const int st = (r >> 4) * 2 + (c >> 5), rr = r & 15, cc = c & 31, ob = rr * 64 + cc * 2; return st * 1024 + (ob ^ (((ob >> 9) & 1) << 5)); }
__host__ __device__ __forceinline__ void stage_rc(int b, int& R, int& C) { const int st = b / 1024, sb = b % 1024, swz = sb ^ (((sb >> 9) & 1) << 5); R = (st >> 1) * 16 + swz / 64; C = (st & 1) * 32 + (swz % 64) / 2; }
__host__ __device__ __forceinline__ int perm32(int rho) { const int n = rho >> 4, i = rho & 15; return 8 * (i >> 2) + 4 * n + (i & 3); }

struct Unit { int pm, pn; };
struct Gemm { const bf16_t* A; const bf16_t* Bt; int M, N, K; };

struct StaticOrder {
    int nM, nN, nwg, G, c;
    __host__ __device__ void init(int M, int N, int G_, int c_) { nM = M / BM; nN = N / BM; nwg = nM * nN; G = G_; c = c_; }
    __host__ __device__ bool next(int i, Unit& u) const {
        const long L = (long)i * G + c; if (L >= nwg) return false;
        int wgid = (int)L; { const int q = nwg / NXCD, r = nwg % NXCD, xcd = wgid % NXCD, off = wgid / NXCD; wgid = (xcd < r ? xcd * (q + 1) : r * (q + 1) + (xcd - r) * q) + off; }
        const int nig = WGM * nN, gid = wgid / nig, fm = gid * WGM, gsz = (nM - fm) < WGM ? (nM - fm) : WGM;
        u.pm = fm + ((wgid % nig) % gsz); u.pn = (wgid % nig) / gsz; return true;
    }
    __device__ __forceinline__ void a_ready(const Unit&) const {}
    __device__ __forceinline__ void done(const Unit&) const {}
};

__device__ __forceinline__ unsigned cvt_pk_bf16(float lo, float hi) { unsigned r; asm volatile("v_cvt_pk_bf16_f32 %0, %1, %2" : "=v"(r) : "v"(lo), "v"(hi)); return r; }
template <class Epi, class Sched, bool ALIGN_EPI = false, bool SP2 = false>
__device__ __forceinline__ void gemm_phase(PG8_LAS unsigned char* lds, const Gemm g, const Sched& S, const Epi& E) {
    int tid_ = threadIdx.x; asm volatile("" : "+v"(tid_));
    const int tid = tid_, wid = __builtin_amdgcn_readfirstlane(tid >> 6), lane = tid & 63, wr = wid >> 2, wc = wid & 3, fr = lane & 15, fq = lane >> 4;
    const int K = g.K, nt = K / BK;
    unsigned voffA[2], voffB[2];
#pragma unroll
    for (int i = 0; i < 2; ++i) { int R, C; stage_rc(tid * 16 + i * 8192, R, C); const int Rb = Epi::PERM ? ((R & ~31) + perm32(R & 31)) : R;
        voffA[i] = (unsigned)(R * K + C) * 2u; voffB[i] = (unsigned)(Rb * K + C) * 2u; }
    const size_t kstep = (size_t)(BK * 2);
    const size_t hstep = (size_t)HALF * K * 2;
    const size_t tstep = 2 * hstep;
    const unsigned ldsw = (unsigned)wid * 1024u;
    const int aoff = lds_byte(wr * 64 + fr, fq * 8), boff = lds_byte(wc * 32 + fr, fq * 8);
#define PG8_SA(b, h) (((b) * 2 + (h)) * HTB)
#define PG8_SB(b, h) ((4 + (b) * 2 + (h)) * HTB)
#define PG8_STAGE(bufoff, gbase, voff) do { _Pragma("unroll") for (int _i = 0; _i < 2; ++_i) \
        __builtin_amdgcn_global_load_lds((const unsigned*)((const char*)(gbase) + (voff)[_i]), (PG8_LAS unsigned*)(lds + (bufoff) + ldsw + _i * 8192), 16, 0, 0); } while (0)
#define PG8_LDA(dst, b, h) do { _Pragma("unroll") for (int m = 0; m < 4; ++m) _Pragma("unroll") for (int k = 0; k < 2; ++k) dst[m][k] = *(const PG8_LAS bf16x8*)(lds + PG8_SA(b, h) + aoff + m * 2048 + k * 1024); } while (0)
#define PG8_LDB(dst, b, h) do { _Pragma("unroll") for (int n = 0; n < 2; ++n) _Pragma("unroll") for (int k = 0; k < 2; ++k) dst[n][k] = *(const PG8_LAS bf16x8*)(lds + PG8_SB(b, h) + boff + n * 2048 + k * 1024); } while (0)
#define PG8_MMA(ai, bj, At, Bt) do { __builtin_amdgcn_s_setprio(1); _Pragma("unroll") for (int m = 0; m < 4; ++m) _Pragma("unroll") for (int n = 0; n < 2; ++n) _Pragma("unroll") for (int k = 0; k < 2; ++k) \
        acc[ai][bj][m][n] = __builtin_amdgcn_mfma_f32_16x16x32_bf16(Bt[n][k], At[m][k], acc[ai][bj][m][n], 0, 0, 0); __builtin_amdgcn_s_setprio(0); } while (0)
#define PG8_WAIT_V(n) asm volatile("s_waitcnt vmcnt(" #n ")" ::: "memory")
#define PG8_WAIT_L(n) asm volatile("s_waitcnt lgkmcnt(" #n ")" ::: "memory")
#define PG8_BAR __builtin_amdgcn_s_barrier()
#define PG8_SCHED __builtin_amdgcn_sched_barrier(0)
    Unit cur, nxt; int ui = 0;
    if (!S.next(0, cur)) return;
    f32x4 acc[2][2][4][2];
#pragma unroll
    for (int a = 0; a < 2; ++a)
#pragma unroll
        for (int b = 0; b < 2; ++b)
#pragma unroll
            for (int m = 0; m < 4; ++m)
#pragma unroll
                for (int n = 0; n < 2; ++n) acc[a][b][m][n] = (f32x4){0.f, 0.f, 0.f, 0.f};
    bf16x8 At[4][2], B0[2][2], B1[2][2];
    const char* cA = (const char*)g.A + (size_t)cur.pm * tstep; const char* cB = (const char*)g.Bt + (size_t)cur.pn * tstep;
    S.a_ready(cur);
    if constexpr (SP2) {
        PG8_STAGE(PG8_SB(0, 0), cB, voffB); PG8_STAGE(PG8_SB(0, 1), cB + hstep, voffB); PG8_STAGE(PG8_SA(0, 0), cA, voffA); PG8_STAGE(PG8_SA(0, 1), cA + hstep, voffA);
        if (wr == 1) PG8_BAR;
        PG8_WAIT_V(2); PG8_BAR;
        PG8_STAGE(PG8_SB(1, 0), cB + kstep, voffB); PG8_STAGE(PG8_SA(1, 0), cA + kstep, voffA); PG8_STAGE(PG8_SB(1, 1), cB + hstep + kstep, voffB);
        PG8_WAIT_V(6); PG8_BAR;
    } else {
        PG8_STAGE(PG8_SB(0, 0), cB, voffB); PG8_STAGE(PG8_SA(0, 0), cA, voffA); PG8_STAGE(PG8_SB(0, 1), cB + hstep, voffB); PG8_STAGE(PG8_SA(0, 1), cA + hstep, voffA);
        if (wr == 1) PG8_BAR;
        PG8_WAIT_V(4); PG8_BAR;
        PG8_STAGE(PG8_SB(1, 0), cB + kstep, voffB); PG8_STAGE(PG8_SA(1, 0), cA + kstep, voffA); PG8_STAGE(PG8_SB(1, 1), cB + hstep + kstep, voffB);
        PG8_WAIT_V(6); PG8_BAR;
    }
    for (;;) {
        const bool has_next = S.next(ui + 1, nxt);
        const char* nA = has_next ? (const char*)g.A + (size_t)nxt.pm * tstep : cA; const char* nB = has_next ? (const char*)g.Bt + (size_t)nxt.pn * tstep : cB;
        for (int t = 0; t < nt; t += 2) {
            const bool last = (t == nt - 2);
            const char* a1 = cA + (size_t)(t + 1) * kstep;
            const char* a2 = last ? nA : cA + (size_t)(t + 2) * kstep; const char* b2 = last ? nB : cB + (size_t)(t + 2) * kstep;
            const char* a3 = a2 + kstep; const char* b3 = b2 + kstep;
            if (last && has_next) S.a_ready(nxt);
            if constexpr (SP2) {
            PG8_LDB(B0, 0, 0); PG8_LDB(B1, 0, 1); PG8_SCHED; PG8_LDA(At, 0, 0); PG8_STAGE(PG8_SA(1, 1), a1 + hstep, voffA);
            PG8_WAIT_V(8); PG8_WAIT_L(0); PG8_BAR; PG8_MMA(0, 0, At, B0); PG8_MMA(0, 1, At, B1); PG8_BAR; PG8_SCHED;
            PG8_LDA(At, 0, 1); PG8_STAGE(PG8_SB(0, 0), b2, voffB); PG8_STAGE(PG8_SB(0, 1), b2 + hstep, voffB); PG8_STAGE(PG8_SA(0, 0), a2, voffA);
            PG8_WAIT_V(8); PG8_WAIT_L(0); PG8_BAR; PG8_MMA(1, 0, At, B0); PG8_MMA(1, 1, At, B1); PG8_BAR; PG8_SCHED;
            PG8_LDB(B0, 1, 0); PG8_LDB(B1, 1, 1); PG8_SCHED; PG8_LDA(At, 1, 0); PG8_STAGE(PG8_SA(0, 1), a2 + hstep, voffA);
            PG8_WAIT_V(8); PG8_WAIT_L(0); PG8_BAR; PG8_MMA(0, 0, At, B0); PG8_MMA(0, 1, At, B1); PG8_BAR; PG8_SCHED;
            PG8_LDA(At, 1, 1); PG8_STAGE(PG8_SB(1, 0), b3, voffB); PG8_STAGE(PG8_SB(1, 1), b3 + hstep, voffB); PG8_STAGE(PG8_SA(1, 0), a3, voffA);
            PG8_WAIT_V(8); PG8_WAIT_L(0); PG8_BAR; PG8_MMA(1, 0, At, B0); PG8_MMA(1, 1, At, B1); PG8_BAR; PG8_SCHED;
            } else {
            PG8_LDB(B0, 0, 0); PG8_SCHED; PG8_LDA(At, 0, 0); PG8_STAGE(PG8_SA(1, 1), a1 + hstep, voffA);
            PG8_WAIT_L(8); PG8_BAR; PG8_WAIT_L(0); PG8_MMA(0, 0, At, B0); PG8_BAR; PG8_SCHED;
            PG8_LDB(B1, 0, 1); PG8_STAGE(PG8_SB(0, 0), b2, voffB);
            PG8_BAR; PG8_WAIT_L(0); PG8_MMA(0, 1, At, B1); PG8_BAR;
            PG8_LDA(At, 0, 1); PG8_STAGE(PG8_SA(0, 0), a2, voffA);
            PG8_BAR; PG8_WAIT_L(0); PG8_MMA(1, 0, At, B0); PG8_BAR; PG8_SCHED;
            PG8_STAGE(PG8_SB(0, 1), b2 + hstep, voffB);
            PG8_WAIT_V(6); PG8_BAR; PG8_MMA(1, 1, At, B1); PG8_BAR;
            PG8_LDB(B0, 1, 0); PG8_SCHED; PG8_LDA(At, 1, 0); PG8_STAGE(PG8_SA(0, 1), a2 + hstep, voffA);
            PG8_WAIT_L(8); PG8_BAR; PG8_WAIT_L(0); PG8_MMA(0, 0, At, B0); PG8_BAR; PG8_SCHED;
            PG8_LDB(B1, 1, 1); PG8_STAGE(PG8_SB(1, 0), b3, voffB);
            PG8_BAR; PG8_WAIT_L(0); PG8_MMA(0, 1, At, B1); PG8_BAR;
            PG8_LDA(At, 1, 1); PG8_STAGE(PG8_SA(1, 0), a3, voffA);
            PG8_BAR; PG8_WAIT_L(0); PG8_MMA(1, 0, At, B0); PG8_BAR; PG8_SCHED;
            PG8_STAGE(PG8_SB(1, 1), b3 + hstep, voffB);
            PG8_WAIT_V(6); PG8_BAR; PG8_MMA(1, 1, At, B1); PG8_BAR;
            }
        }
        if constexpr (ALIGN_EPI) { if (wr == 0) PG8_BAR; }
        if constexpr (!Epi::AFTER_DRAIN) { E(acc, cur, wr, wc, fr, fq); S.done(cur); }
        if (!has_next) break;
#pragma unroll
        for (int a = 0; a < 2; ++a)
#pragma unroll
            for (int b = 0; b < 2; ++b)
#pragma unroll
                for (int m = 0; m < 4; ++m)
#pragma unroll
                    for (int n = 0; n < 2; ++n) acc[a][b][m][n] = (f32x4){0.f, 0.f, 0.f, 0.f};
        cur = nxt; cA = nA; cB = nB; ++ui;
        if constexpr (ALIGN_EPI) { if (wr == 1) PG8_BAR; }
    }
    PG8_WAIT_V(0);
    if constexpr (!ALIGN_EPI) { if (wr == 0) PG8_BAR; }
    PG8_BAR;
    if constexpr (Epi::AFTER_DRAIN) { E.fused(acc, cur, wr, wc, fr, fq, lds, wid, lane); S.done(cur); }
#undef PG8_SA
#undef PG8_SB
#undef PG8_STAGE
#undef PG8_LDA
#undef PG8_LDB
#undef PG8_MMA
#undef PG8_WAIT_V
#undef PG8_WAIT_L
#undef PG8_BAR
#undef PG8_SCHED
}
}
namespace pg8 {
struct EpiStoreBf16 {
    static constexpr bool PERM = true, AFTER_DRAIN = false;
    bf16_t* O; int ldc; const float* bias; int m_real, n_real;
    __device__ __forceinline__ void operator()(const f32x4 (&acc)[2][2][4][2], const Unit& u, int wr, int wc, int fr, int fq) const {
        const int row0 = u.pm * BM + wr * 64 + fr, col0 = u.pn * BM + wc * 32 + 8 * fq;
#pragma unroll
        for (int bj = 0; bj < 2; ++bj) {
            const int col = col0 + bj * HALF;
            if (col >= n_real) continue;
            f32x4 b0 = (f32x4){0.f, 0.f, 0.f, 0.f}, b1 = b0;
            if (bias) { b0 = *(const f32x4*)(bias + col); b1 = *(const f32x4*)(bias + col + 4); }
#pragma unroll
            for (int ai = 0; ai < 2; ++ai)
#pragma unroll
                for (int m = 0; m < 4; ++m) {
                    const int row = row0 + ai * HALF + m * 16;
                    if (row >= m_real) continue;
                    const f32x4 v0 = acc[ai][bj][m][0] + b0, v1 = acc[ai][bj][m][1] + b1;
                    u32x4 w; w.x = cvt_pk_bf16(v0[0], v0[1]); w.y = cvt_pk_bf16(v0[2], v0[3]); w.z = cvt_pk_bf16(v1[0], v1[1]); w.w = cvt_pk_bf16(v1[2], v1[3]);
                    *(u32x4*)(O + (size_t)row * ldc + col) = w;
                }
        }
    }
};
struct EpiStoreF32 {
    static constexpr bool PERM = false, AFTER_DRAIN = false;
    float* O; int ldc; const float* bias; int m_real, n_real;
    __device__ __forceinline__ void operator()(const f32x4 (&acc)[2][2][4][2], const Unit& u, int wr, int wc, int fr, int fq) const {
        const int row0 = u.pm * BM + wr * 64 + fr, col0 = u.pn * BM + wc * 32 + 4 * fq;
#pragma unroll
        for (int bj = 0; bj < 2; ++bj)
#pragma unroll
            for (int n = 0; n < 2; ++n) {
                const int col = col0 + bj * HALF + n * 16;
                if (col >= n_real) continue;
                const f32x4 bv = bias ? *(const f32x4*)(bias + col) : (f32x4){0.f, 0.f, 0.f, 0.f};
#pragma unroll
                for (int ai = 0; ai < 2; ++ai)
#pragma unroll
                    for (int m = 0; m < 4; ++m) {
                        const int row = row0 + ai * HALF + m * 16;
                        if (row >= m_real) continue;
                        *(f32x4*)(O + (size_t)row * ldc + col) = acc[ai][bj][m][n] + bv;
                    }
            }
    }
};
}
namespace {
#define GAS __attribute__((address_space(1)))
#define LAS __attribute__((address_space(3)))
typedef unsigned short bf16;
typedef float f32x4 __attribute__((ext_vector_type(4)));
typedef unsigned v4u __attribute__((ext_vector_type(4)));
typedef unsigned v2u __attribute__((ext_vector_type(2)));

constexpr int D = 1024, NB = 4, SEQ = 4096, NP = NB * SEQ, NS = 128, NT = NP + NS, MP = 16640;
constexpr int ABN = 3080, ABNP = 3328;
constexpr int C_QKV = 0, C_Z = 1536, C_XR = 2048, C_GATE = 2560, C_A = 3072, C_B = 3076;
constexpr int ABMAIN = 3072;
constexpr int CN = 1536;
constexpr float ALPHA = 1.4142135623730951f;
constexpr float LN_EPS = 1e-5f;
constexpr int NTH = 512, NWAVES = 8;
constexpr int RING_BYTES = 143360, MISC_OFF = RING_BYTES + 320, LDS_BYTES = 147456;

__device__ __forceinline__ float bf2f(bf16 v) { return __uint_as_float((unsigned)v << 16); }
__device__ __forceinline__ float bflo(unsigned w) { return __uint_as_float(w << 16); }
__device__ __forceinline__ float bfhi(unsigned w) { return __uint_as_float(w & 0xffff0000u); }
typedef float f32x2c_t __attribute__((ext_vector_type(2)));
typedef __bf16 bf16x2c_t __attribute__((ext_vector_type(2)));
__device__ __forceinline__ unsigned f2bf(float f) { return (unsigned)__builtin_bit_cast(unsigned short, (__bf16)f); }
__device__ __forceinline__ unsigned pk2(float lo, float hi) { return __builtin_bit_cast(unsigned, __builtin_convertvector((f32x2c_t){lo, hi}, bf16x2c_t)); }
__device__ __forceinline__ float sigmoidf_(float x) { return 1.0f / (1.0f + expf(-x)); }
__device__ __forceinline__ float softplusf_(float x) { return fmaxf(x, 0.f) + log1pf(expf(-fabsf(x))); }
__device__ __forceinline__ float siluf_(float x) { return x / (1.0f + expf(-x)); }
__device__ __forceinline__ float geluf_(float x) { return 0.5f * x * (1.0f + tanhf(0.7978845608028654f * (x + 0.044715f * x * x * x))); }
#define DPPF(v_, ctrl_, rmask_) __int_as_float(__builtin_amdgcn_update_dpp(0, __float_as_int(v_), (ctrl_), (rmask_), 0xf, false))
__device__ __forceinline__ float wave_sum(float v) {
    v += DPPF(v, 0xB1, 0xf); v += DPPF(v, 0x4E, 0xf); v += DPPF(v, 0x141, 0xf); v += DPPF(v, 0x140, 0xf);
    v += DPPF(v, 0x142, 0xa); v += DPPF(v, 0x143, 0xc);
    return __int_as_float(__builtin_amdgcn_readlane(__float_as_int(v), 63));
}
__device__ __forceinline__ float wave_max(float v) {
    v = fmaxf(v, DPPF(v, 0xB1, 0xf)); v = fmaxf(v, DPPF(v, 0x4E, 0xf)); v = fmaxf(v, DPPF(v, 0x141, 0xf)); v = fmaxf(v, DPPF(v, 0x140, 0xf));
    { const float t = __int_as_float(__builtin_amdgcn_update_dpp(__float_as_int(v), __float_as_int(v), 0x142, 0xa, 0xf, false)); v = fmaxf(v, t); }
    { const float t = __int_as_float(__builtin_amdgcn_update_dpp(__float_as_int(v), __float_as_int(v), 0x143, 0xc, 0xf, false)); v = fmaxf(v, t); }
    return __int_as_float(__builtin_amdgcn_readlane(__float_as_int(v), 63));
}

template <bool ABORDER = false>
__device__ __forceinline__ void p0_transpose_item(const float* __restrict__ W, int K, int N, bf16* __restrict__ WT, float* scr, int item, int lane) {
    const int nblk = (N + 31) / 32, kb = item / nblk, nb = item % nblk, k0 = 64 * kb, n0 = 32 * nb;
    const int n_ = n0 + (lane & 31);
    const int ns = ABORDER ? (n_ < 2048 ? n_ : (n_ < ABMAIN ? n_ + 8 : n_ - 1024)) : n_;
    float wv_[32];
#pragma unroll
    for (int i = 0; i < 32; ++i) { const int kk = 2 * i + (lane >> 5); wv_[i] = n_ < N ? W[(size_t)(k0 + kk) * N + ns] : 0.f; }
#pragma unroll
    for (int i = 0; i < 32; ++i) { const int kk = 2 * i + (lane >> 5); scr[kk * 33 + (lane & 31)] = wv_[i]; }
    asm volatile("s_waitcnt lgkmcnt(0)" ::: "memory");
    const int c = lane & 7;
#pragma unroll
    for (int j = 0; j < 4; ++j) { const int n = (lane >> 3) + 8 * j; const float* s = scr + (8 * c) * 33 + n;
        v4u o; o.x = pk2(s[0 * 33], s[1 * 33]); o.y = pk2(s[2 * 33], s[3 * 33]); o.z = pk2(s[4 * 33], s[5 * 33]); o.w = pk2(s[6 * 33], s[7 * 33]);
        *(v4u*)(WT + (size_t)(n0 + n) * K + k0 + 8 * c) = o; }
    asm volatile("s_waitcnt lgkmcnt(0)" ::: "memory");
}
__device__ __forceinline__ void row_to_bf16(const float* __restrict__ xrow, bf16* __restrict__ orow, int lane) {
#pragma unroll
    for (int j = 0; j < 4; ++j) {
        f32x4 v = (f32x4){0.f, 0.f, 0.f, 0.f};
        if (xrow) v = ((const f32x4*)xrow)[lane + 64 * j];
        v2u o; o.x = pk2(v.x, v.y); o.y = pk2(v.z, v.w);
        ((v2u*)orow)[lane + 64 * j] = o;
    }
}

struct AbPrepArgs {
    const bf16* PROJ; const float* st_gdn_conv; const float* st_lru_conv;
    const float* gdn_conv_w; const float* a_log; const float* dt_bias;
    const float* lru_conv_w; const float* lru_conv_b; const float* w_r; const float* b_r; const float* w_i; const float* b_i; const float* lam;
    float* QKV; float* G; float* BETA; float* LA; float* LB;
    float* p_gdn_conv; float* p_lru_conv; float* s_gdn_conv; float* s_lru_conv;
};
__device__ __forceinline__ void ab_prep(const AbPrepArgs& a, int t, float* smem) {
    int tid = threadIdx.x; asm volatile("" : "+v"(tid));
    const int lane = tid & 63, wid = tid >> 6;
    const bool samp = t >= NP; const int sb = t - NP, pos = t % SEQ, b = t / SEQ;
    float* sq = smem;
    float* sx = smem + 1536;
    float* scl = smem + 2048;
    const bf16* prow = a.PROJ + (size_t)t * ABN;
    for (int c = tid; c < 1536; c += NTH) {
        float acc = 0.f;
#pragma unroll
        for (int i = 0; i < 4; ++i) {
            float xv;
            if (i == 3) xv = bf2f(prow[C_QKV + c]);
            else if (samp) xv = a.st_gdn_conv[((size_t)sb * 3 + i) * 1536 + c];
            else xv = (pos - 3 + i >= 0) ? bf2f(a.PROJ[(size_t)(t - 3 + i) * ABN + C_QKV + c]) : 0.f;
            acc += a.gdn_conv_w[i * 1536 + c] * xv;
        }
        sq[c] = siluf_(acc);
    }
    {
        const int c = tid;
        float acc = a.lru_conv_b[c];
#pragma unroll
        for (int i = 0; i < 4; ++i) {
            float xv;
            if (i == 3) xv = bf2f(prow[C_XR + c]);
            else if (samp) xv = a.st_lru_conv[((size_t)sb * 3 + i) * 512 + c];
            else xv = (pos - 3 + i >= 0) ? bf2f(a.PROJ[(size_t)(t - 3 + i) * ABN + C_XR + c]) : 0.f;
            acc += a.lru_conv_w[i * 512 + c] * xv;
        }
        sx[c] = acc;
    }
    __syncthreads();
    {
        const int grp = wid;
        const float v0 = sq[grp * 128 + lane], v1 = sq[grp * 128 + 64 + lane];
        const float s = wave_sum(v0 * v0 + v1 * v1);
        if (lane == 0) scl[grp] = rsqrtf(s + 1e-6f) * (grp < 4 ? 0.08838834764831845f : 1.0f);
    }
    __syncthreads();
    for (int c = tid; c < 1536; c += NTH) a.QKV[(size_t)t * 1536 + c] = (c < 1024) ? sq[c] * scl[c >> 7] : sq[c];
    if (tid < 4) {
        const float a_raw = bf2f(prow[C_A + tid]), b_raw = bf2f(prow[C_B + tid]);
        a.G[(size_t)t * 4 + tid] = -expf(a.a_log[tid]) * softplusf_(a_raw + a.dt_bias[tid]);
        a.BETA[(size_t)t * 4 + tid] = sigmoidf_(b_raw);
    }
    if (!samp) {
        if (pos >= SEQ - 3) {
            const int row = pos - (SEQ - 3);
            for (int c = tid; c < 1536; c += NTH) a.p_gdn_conv[((size_t)b * 3 + row) * 1536 + c] = bf2f(prow[C_QKV + c]);
            a.p_lru_conv[((size_t)b * 3 + row) * 512 + tid] = bf2f(prow[C_XR + tid]);
        }
    } else {
        for (int c = tid; c < 1536; c += NTH) {
            a.s_gdn_conv[((size_t)sb * 3 + 0) * 1536 + c] = a.st_gdn_conv[((size_t)sb * 3 + 1) * 1536 + c];
            a.s_gdn_conv[((size_t)sb * 3 + 1) * 1536 + c] = a.st_gdn_conv[((size_t)sb * 3 + 2) * 1536 + c];
            a.s_gdn_conv[((size_t)sb * 3 + 2) * 1536 + c] = bf2f(prow[C_QKV + c]);
        }
        {
            const int c = tid;
            a.s_lru_conv[((size_t)sb * 3 + 0) * 512 + c] = a.st_lru_conv[((size_t)sb * 3 + 1) * 512 + c];
            a.s_lru_conv[((size_t)sb * 3 + 1) * 512 + c] = a.st_lru_conv[((size_t)sb * 3 + 2) * 512 + c];
            a.s_lru_conv[((size_t)sb * 3 + 2) * 512 + c] = bf2f(prow[C_XR + c]);
        }
    }
    {
        const int c = tid, n = c >> 6, d = c & 63;
        float r = a.b_r[c], ii = a.b_i[c];
#pragma unroll 4
        for (int cc = 0; cc < 64; ++cc) {
            const float xv = sx[n * 64 + cc];
            r += xv * a.w_r[((size_t)n * 64 + cc) * 64 + d];
            ii += xv * a.w_i[((size_t)n * 64 + cc) * 64 + d];
        }
        r = sigmoidf_(r); ii = sigmoidf_(ii);
        const float log_a = -8.0f * r * softplusf_(-a.lam[c]);
        a.LA[(size_t)t * 512 + c] = expf(log_a);
        a.LB[(size_t)t * 512 + c] = sqrtf(-expm1f(2.0f * log_a)) * (ii * sx[c]);
    }
}

__device__ __forceinline__ void gdn_scan(const float* __restrict__ QKV, const float* __restrict__ G, const float* __restrict__ BETA,
                                         const float* __restrict__ S0, float* __restrict__ O, float* __restrict__ Sout, int tok_base, int T,
                                         int sl, int h, int sq, float* smem) {
    int tid = threadIdx.x; asm volatile("" : "+v"(tid));
    const int dvl = tid & 31, kg = tid >> 5;
    const int dv = sl * 32 + dvl;
    float (*red1)[32] = (float (*)[32])smem;
    float (*red2)[32] = (float (*)[32])(smem + 512);
    float S[8];
#pragma unroll
    for (int i = 0; i < 8; ++i) S[i] = S0 ? S0[(((size_t)sq * 4 + h) * 128 + kg * 8 + i) * 128 + dv] : 0.f;
    float kk[8], qq[8], vv, g, be;
    {
        const size_t tok = (size_t)tok_base + (size_t)sq * T;
        const float* row = QKV + tok * 1536;
#pragma unroll
        for (int i = 0; i < 8; ++i) { kk[i] = row[512 + h * 128 + kg * 8 + i]; qq[i] = row[h * 128 + kg * 8 + i]; }
        vv = row[1024 + h * 128 + dv]; g = G[tok * 4 + h]; be = BETA[tok * 4 + h];
    }
    for (int t = 0; t < T; ++t) {
        const size_t tok = (size_t)tok_base + (size_t)sq * T + t;
        float nk[8], nq[8], nv = 0.f, ng = 0.f, nb = 0.f;
        if (t + 1 < T) {
            const float* row = QKV + (tok + 1) * 1536;
#pragma unroll
            for (int i = 0; i < 8; ++i) { nk[i] = row[512 + h * 128 + kg * 8 + i]; nq[i] = row[h * 128 + kg * 8 + i]; }
            nv = row[1024 + h * 128 + dv]; ng = G[(tok + 1) * 4 + h]; nb = BETA[(tok + 1) * 4 + h];
        } else {
#pragma unroll
            for (int i = 0; i < 8; ++i) { nk[i] = 0.f; nq[i] = 0.f; }
        }
        const float al = expf(g);
        float p = 0.f;
#pragma unroll
        for (int i = 0; i < 8; ++i) { S[i] *= al; p += S[i] * kk[i]; }
        red1[kg][dvl] = p;
        __syncthreads();
        float ks = 0.f;
#pragma unroll
        for (int j = 0; j < 16; ++j) ks += red1[j][dvl];
        const float vn = be * (vv - ks);
        float o = 0.f;
#pragma unroll
        for (int i = 0; i < 8; ++i) { S[i] += kk[i] * vn; o += S[i] * qq[i]; }
        red2[kg][dvl] = o;
        __syncthreads();
        if (kg == 0) {
            float os = 0.f;
#pragma unroll
            for (int j = 0; j < 16; ++j) os += red2[j][dvl];
            O[tok * 512 + h * 128 + dv] = os;
        }
#pragma unroll
        for (int i = 0; i < 8; ++i) { kk[i] = nk[i]; qq[i] = nq[i]; }
        vv = nv; g = ng; be = nb;
    }
#pragma unroll
    for (int i = 0; i < 8; ++i) Sout[(((size_t)sq * 4 + h) * 128 + kg * 8 + i) * 128 + dv] = S[i];
}


__device__ __forceinline__ void gdn_step_sample_w(const float* __restrict__ QKV, const float* __restrict__ G, const float* __restrict__ BETA, const float* __restrict__ S0,
                                                  float* __restrict__ O, float* __restrict__ Sout, int item, int lane) {
    const int sl = item & 7, h = (item >> 3) & 3, sb = item >> 5, fr = lane & 15, fq = lane >> 4;
    const size_t tok = (size_t)NP + sb;
    const float* row = QKV + tok * 1536;
    const size_t sbase = (((size_t)sb * 4 + h) * 128 + fq * 32) * 128 + sl * 16 + fr;
    float S[32], kk[32], qq[32];
#pragma unroll
    for (int i = 0; i < 32; ++i) S[i] = S0[sbase + (size_t)i * 128];
#pragma unroll
    for (int i4 = 0; i4 < 8; ++i4) { const f32x4 k4 = *(const f32x4*)(row + 512 + h * 128 + fq * 32 + i4 * 4), q4 = *(const f32x4*)(row + h * 128 + fq * 32 + i4 * 4);
        kk[i4 * 4 + 0] = k4.x; kk[i4 * 4 + 1] = k4.y; kk[i4 * 4 + 2] = k4.z; kk[i4 * 4 + 3] = k4.w; qq[i4 * 4 + 0] = q4.x; qq[i4 * 4 + 1] = q4.y; qq[i4 * 4 + 2] = q4.z; qq[i4 * 4 + 3] = q4.w; }
    const float vv = row[1024 + h * 128 + sl * 16 + fr], al = expf(G[tok * 4 + h]), be = BETA[tok * 4 + h];
    float p = 0.f;
#pragma unroll
    for (int i = 0; i < 32; ++i) { S[i] *= al; p += S[i] * kk[i]; }
    p += __shfl_xor(p, 16); p += __shfl_xor(p, 32);
    const float vn = be * (vv - p);
    float o = 0.f;
#pragma unroll
    for (int i = 0; i < 32; ++i) { S[i] += kk[i] * vn; o += S[i] * qq[i]; }
    o += __shfl_xor(o, 16); o += __shfl_xor(o, 32);
    if (fq == 0) O[tok * 512 + h * 128 + sl * 16 + fr] = o;
#pragma unroll
    for (int i = 0; i < 32; ++i) Sout[sbase + (size_t)i * 128] = S[i];
}

__device__ __forceinline__ void lru_scan(const float* __restrict__ LA, float* __restrict__ LB, const float* __restrict__ h0,
                                         float* __restrict__ hlast, int tok_base, int T, int nseq, int bx) {
    int tx_ = threadIdx.x; asm volatile("" : "+v"(tx_));
    const int idx = bx * NTH + tx_;
    if (idx >= nseq * 512) return;
    const int sq = idx / 512, c = idx % 512;
    float h = h0 ? h0[(size_t)sq * 512 + c] : 0.f;
    const size_t base = ((size_t)tok_base + (size_t)sq * T) * 512 + c;
#pragma unroll 8
    for (int t = 0; t < T; ++t) {
        const size_t o = base + (size_t)t * 512;
        h = LA[o] * h + LB[o];
        LB[o] = h;
    }
    hlast[(size_t)sq * 512 + c] = h;
}

__device__ __forceinline__ void ab_mix_w(const bf16* __restrict__ PROJ, const float* __restrict__ O, const float* __restrict__ H, const float* __restrict__ P, const float* __restrict__ CIN,
                                         const float* __restrict__ norm_w, bf16* __restrict__ MIX, int t, int lane) {
    const bf16* prow = PROJ + (size_t)t * ABN;
#pragma unroll
    for (int jj = 0; jj < 2; ++jj) {
        const int c0 = 256 * jj + 4 * lane;
        const f32x4 o = *(const f32x4*)(O + (size_t)t * 512 + c0);
        const v2u zb = *(const v2u*)(prow + C_Z + c0);
        const f32x4 w = *(const f32x4*)(norm_w + (c0 & 127));
        float ss = (o.x * o.x + o.y * o.y) + (o.z * o.z + o.w * o.w);
        ss += DPPF(ss, 0xB1, 0xf); ss += DPPF(ss, 0x4E, 0xf); ss += DPPF(ss, 0x141, 0xf); ss += DPPF(ss, 0x140, 0xf);
        { const auto sw_ = __builtin_amdgcn_permlane16_swap(__float_as_uint(ss), __float_as_uint(ss), false, false); ss = __uint_as_float(sw_[0]) + __uint_as_float(sw_[1]); }
        const float sc = rsqrtf(ss * (1.0f / 128.0f) + 1e-6f);
        const float z0 = bflo(zb.x), z1 = bfhi(zb.x), z2 = bflo(zb.y), z3 = bfhi(zb.y);
        v2u ob;
        ob.x = pk2(o.x * sc * w.x * (z0 * __frcp_rn(1.0f + __expf(-z0))), o.y * sc * w.y * (z1 * __frcp_rn(1.0f + __expf(-z1))));
        ob.y = pk2(o.z * sc * w.z * (z2 * __frcp_rn(1.0f + __expf(-z2))), o.w * sc * w.w * (z3 * __frcp_rn(1.0f + __expf(-z3))));
        *(v2u*)(MIX + (size_t)t * 1024 + c0) = ob;
    }
#pragma unroll
    for (int jj = 0; jj < 2; ++jj) {
        const int c0 = 256 * jj + 4 * lane;
        const v2u gb = *(const v2u*)(prow + C_GATE + c0);
        f32x4 h = *(const f32x4*)(H + (size_t)t * 512 + c0);
        if (t < NP) { const f32x4 p = *(const f32x4*)(P + (size_t)t * 512 + c0), ci = *(const f32x4*)(CIN + (size_t)(t >> 6) * 512 + c0); h = h + p * ci; }
        v2u ob; ob.x = pk2(geluf_(bflo(gb.x)) * h.x, geluf_(bfhi(gb.x)) * h.y); ob.y = pk2(geluf_(bflo(gb.y)) * h.z, geluf_(bfhi(gb.y)) * h.w);
        *(v2u*)(MIX + (size_t)t * 1024 + 512 + c0) = ob;
    }
}

template <bool XBF>
__device__ __forceinline__ void ln_res_w(const void* __restrict__ xrow_, const bf16* __restrict__ yrow, const float* __restrict__ g, const float* __restrict__ bta,
                                         bf16* __restrict__ obrow, int lane) {
    f32x4 v[4]; float s = 0.f;
#pragma unroll
    for (int j = 0; j < 4; ++j) {
        f32x4 x4;
        if (XBF) { const v2u xb = ((const v2u*)xrow_)[lane + 64 * j]; x4 = (f32x4){bflo(xb.x), bfhi(xb.x), bflo(xb.y), bfhi(xb.y)}; }
        else x4 = ((const f32x4*)xrow_)[lane + 64 * j];
        const v2u yb = ((const v2u*)yrow)[lane + 64 * j];
        const f32x4 y4 = (f32x4){bflo(yb.x), bfhi(yb.x), bflo(yb.y), bfhi(yb.y)}; v[j] = x4 * ALPHA + y4; s += (v[j].x + v[j].y) + (v[j].z + v[j].w); }
    const float mean = wave_sum(s) * (1.0f / 1024.0f); float q = 0.f;
#pragma unroll
    for (int j = 0; j < 4; ++j) { v[j] = v[j] - mean; q += (v[j].x * v[j].x + v[j].y * v[j].y) + (v[j].z * v[j].z + v[j].w * v[j].w); }
    const float rs = rsqrtf(wave_sum(q) * (1.0f / 1024.0f) + LN_EPS);
#pragma unroll
    for (int j = 0; j < 4; ++j) {
        const f32x4 g4 = ((const f32x4*)g)[lane + 64 * j], b4 = ((const f32x4*)bta)[lane + 64 * j];
        const f32x4 o = v[j] * rs * g4 + b4;
        v2u ob; ob.x = pk2(o.x, o.y); ob.y = pk2(o.z, o.w);
        ((v2u*)obrow)[lane + 64 * j] = ob;
    }
}

__device__ __forceinline__ void peer_topk(const bf16* __restrict__ Q, const float* __restrict__ keys, int* __restrict__ EXP, float* __restrict__ GATE,
                                          int tg, int h, float* smem) {
    const int tid = threadIdx.x, cn = tid & 255, c = cn >> 7, n = cn & 127, th = tid >> 8;
    float (*sq)[256] = (float (*)[256])smem;
    float (*ss)[257] = (float (*)[257])(smem + 32 * 256);
    float (*tvs)[2][16] = (float (*)[2][16])(smem + 32 * 256 + 32 * 257 + 32);
    int (*tis)[2][16] = (int (*)[2][16])(smem + 32 * 256 + 32 * 257 + 32 + 1024);
    for (int i = tid; i < 32 * 256; i += NTH) {
        const int tk = i >> 8, col = i & 255;
        sq[tk][col] = bf2f(Q[(size_t)(tg * 32 + tk) * 2048 + h * 256 + col]);
    }
    __syncthreads();
    float acc[16];
#pragma unroll
    for (int i = 0; i < 16; ++i) acc[i] = 0.f;
    const float* krow = keys + (((size_t)h * 2 + c) * 128 + n) * 128;
    for (int d4 = 0; d4 < 32; ++d4) {
        const float4 kv = *(const float4*)(krow + d4 * 4);
#pragma unroll
        for (int tk = 0; tk < 16; ++tk) {
            const float4 qv = *(const float4*)&sq[th * 16 + tk][c * 128 + d4 * 4];
            acc[tk] += qv.x * kv.x + qv.y * kv.y + qv.z * kv.z + qv.w * kv.w;
        }
    }
#pragma unroll
    for (int tk = 0; tk < 16; ++tk) ss[th * 16 + tk][cn] = acc[tk];
    __syncthreads();
    if (tid < 64) {
        const int tk = tid >> 1, cc = tid & 1;
        float tv[16]; int ti[16];
#pragma unroll
        for (int j = 0; j < 16; ++j) { tv[j] = -INFINITY; ti[j] = 0; }
        for (int nn = 0; nn < 128; ++nn) {
            float x = ss[tk][cc * 128 + nn]; int xi = nn;
#pragma unroll
            for (int j = 0; j < 16; ++j) {
                const bool gt = x > tv[j];
                const float tf = tv[j]; const int tj = ti[j];
                tv[j] = gt ? x : tf; ti[j] = gt ? xi : tj;
                x = gt ? tf : x; xi = gt ? tj : xi;
            }
        }
#pragma unroll
        for (int j = 0; j < 16; ++j) { tvs[tk][cc][j] = tv[j]; tis[tk][cc][j] = ti[j]; }
    }
    __syncthreads();
    if (tid < 32) {
        const int tk = tid;
        float bv[16]; int bi[16];
#pragma unroll
        for (int j = 0; j < 16; ++j) { bv[j] = -INFINITY; bi[j] = 0; }
        for (int i = 0; i < 16; ++i)
            for (int jj = 0; jj < 16; ++jj) {
                float x = tvs[tk][0][i] + tvs[tk][1][jj]; int xi = tis[tk][0][i] * 128 + tis[tk][1][jj];
#pragma unroll
                for (int j = 0; j < 16; ++j) {
                    const bool gt = x > bv[j];
                    const float tf = bv[j]; const int tj = bi[j];
                    bv[j] = gt ? x : tf; bi[j] = gt ? xi : tj;
                    x = gt ? tf : x; xi = gt ? tj : xi;
                }
            }
        float e[16], sum = 0.f;
#pragma unroll
        for (int j = 0; j < 16; ++j) { e[j] = expf(bv[j] - bv[0]); sum += e[j]; }
        const float inv = 1.0f / sum;
        const size_t o = (size_t)(tg * 32 + tk) * 128 + h * 16;
#pragma unroll
        for (int j = 0; j < 16; ++j) { EXP[o + j] = bi[j]; GATE[o + j] = e[j] * inv; }
    }
}

__device__ __forceinline__ void peer_expert(const float* __restrict__ X, const int* __restrict__ EXP, const float* __restrict__ GATE,
                                            const float* __restrict__ U, const float* __restrict__ V,
                                            const float* __restrict__ g, const float* __restrict__ bta, float* __restrict__ out, bf16* __restrict__ outb, int t, float* smem) {
    const int tid = threadIdx.x, lane = tid & 63, wid = tid >> 6;
    float (*accs)[1024] = (float (*)[1024])smem;
    float* sred = smem + 8192;
    const float4* xr = (const float4*)(X + (size_t)t * D);
    float4 xv[4];
#pragma unroll
    for (int j = 0; j < 4; ++j) xv[j] = xr[lane + 64 * j];
    float4 acc[4];
#pragma unroll
    for (int j = 0; j < 4; ++j) acc[j] = make_float4(0.f, 0.f, 0.f, 0.f);
    for (int e = 0; e < 16; ++e) {
        const int id = EXP[(size_t)t * 128 + wid * 16 + e];
        const float gt = GATE[(size_t)t * 128 + wid * 16 + e];
        const float4* ur = (const float4*)(U + (size_t)id * D);
        const float4* vr = (const float4*)(V + (size_t)id * D);
        float4 uv[4], vv[4];
#pragma unroll
        for (int j = 0; j < 4; ++j) { uv[j] = ur[lane + 64 * j]; vv[j] = vr[lane + 64 * j]; }
        float dot = 0.f;
#pragma unroll
        for (int j = 0; j < 4; ++j) dot += uv[j].x * xv[j].x + uv[j].y * xv[j].y + uv[j].z * xv[j].z + uv[j].w * xv[j].w;
        dot = wave_sum(dot);
        const float cf = gt * geluf_(dot);
#pragma unroll
        for (int j = 0; j < 4; ++j) { acc[j].x += cf * vv[j].x; acc[j].y += cf * vv[j].y; acc[j].z += cf * vv[j].z; acc[j].w += cf * vv[j].w; }
    }
#pragma unroll
    for (int j = 0; j < 4; ++j) *(float4*)&accs[wid][(lane + 64 * j) * 4] = acc[j];
    __syncthreads();
    float v[2];
#pragma unroll
    for (int i = 0; i < 2; ++i) {
        const int c = tid * 2 + i;
        float s = 0.f;
#pragma unroll
        for (int w = 0; w < 8; ++w) s += accs[w][c];
        v[i] = ALPHA * X[(size_t)t * D + c] + s;
    }
    float s = wave_sum(v[0] + v[1]);
    if (lane == 0) sred[wid] = s;
    __syncthreads();
    float mean = 0.f;
#pragma unroll
    for (int w = 0; w < 8; ++w) mean += sred[w];
    mean *= (1.0f / 1024.0f);
    __syncthreads();
    const float d0 = v[0] - mean, d1 = v[1] - mean;
    float q = wave_sum(d0 * d0 + d1 * d1);
    if (lane == 0) sred[wid] = q;
    __syncthreads();
    float var = 0.f;
#pragma unroll
    for (int w = 0; w < 8; ++w) var += sred[w];
    const float rs = rsqrtf(var * (1.0f / 1024.0f) + LN_EPS);
    const float o0 = d0 * rs * g[tid * 2] + bta[tid * 2], o1 = d1 * rs * g[tid * 2 + 1] + bta[tid * 2 + 1];
    *(float2*)(out + (size_t)t * D + tid * 2) = make_float2(o0, o1);
    if (outb) *(unsigned*)(outb + (size_t)t * D + tid * 2) = pk2(o0, o1);
}


typedef __bf16 bf16x2_t __attribute__((ext_vector_type(2)));
__device__ __forceinline__ float dot2bf(unsigned w, unsigned x, float acc) { return __builtin_amdgcn_fdot2_f32_bf16(__builtin_bit_cast(bf16x2_t, w), __builtin_bit_cast(bf16x2_t, x), acc, false); }
typedef float f32x2_t __attribute__((ext_vector_type(2)));
__device__ __forceinline__ void row_to_fp8(const float* __restrict__ xrow, unsigned char* __restrict__ orow, float* __restrict__ scale, int lane) {
    f32x4 v[4]; float am = 0.f;
#pragma unroll
    for (int j = 0; j < 4; ++j) { v[j] = *(const f32x4*)(xrow + lane * 16 + j * 4); am = fmaxf(am, fmaxf(fmaxf(fabsf(v[j].x), fabsf(v[j].y)), fmaxf(fabsf(v[j].z), fabsf(v[j].w)))); }
    am = wave_max(am);
    const float s = am > 0.f ? am * (1.0f / 448.0f) : 1.0f, inv = 1.0f / s;
    v4u o;
    unsigned w;
    w = 0u; w = __builtin_amdgcn_cvt_pk_fp8_f32(v[0].x * inv, v[0].y * inv, w, false); w = __builtin_amdgcn_cvt_pk_fp8_f32(v[0].z * inv, v[0].w * inv, w, true); o.x = w;
    w = 0u; w = __builtin_amdgcn_cvt_pk_fp8_f32(v[1].x * inv, v[1].y * inv, w, false); w = __builtin_amdgcn_cvt_pk_fp8_f32(v[1].z * inv, v[1].w * inv, w, true); o.y = w;
    w = 0u; w = __builtin_amdgcn_cvt_pk_fp8_f32(v[2].x * inv, v[2].y * inv, w, false); w = __builtin_amdgcn_cvt_pk_fp8_f32(v[2].z * inv, v[2].w * inv, w, true); o.z = w;
    w = 0u; w = __builtin_amdgcn_cvt_pk_fp8_f32(v[3].x * inv, v[3].y * inv, w, false); w = __builtin_amdgcn_cvt_pk_fp8_f32(v[3].z * inv, v[3].w * inv, w, true); o.w = w;
    *(v4u*)(orow + lane * 16) = o;
    if (lane == 0) *scale = s;
}
#define PE_LOAD(UB, VB, grp) do { _Pragma("unroll") for (int i_ = 0; i_ < 4; ++i_) { const int e_ = (grp) * 4 + i_; \
        const int id_ = __builtin_amdgcn_readlane(e_ < 64 ? id0 : id1, e_ & 63); \
        const unsigned so_ = (unsigned)id_ * 1024u; \
        UB[i_] = __builtin_amdgcn_raw_buffer_load_b128(ursrc, voff, so_, 0); VB[i_] = __builtin_amdgcn_raw_buffer_load_b128(vrsrc, voff, so_, 0); } } while (0)
#define PE_DOT4(w, k) do { const f32x2_t l_ = __builtin_amdgcn_cvt_pk_f32_fp8((w), false), h_ = __builtin_amdgcn_cvt_pk_f32_fp8((w), true); \
        a_ += l_.x * xv[(k) * 4 + 0]; b_ += l_.y * xv[(k) * 4 + 1]; a_ += h_.x * xv[(k) * 4 + 2]; b_ += h_.y * xv[(k) * 4 + 3]; } while (0)
#define PE_AXPY4(w, k) do { const f32x2_t l_ = __builtin_amdgcn_cvt_pk_f32_fp8((w), false), h_ = __builtin_amdgcn_cvt_pk_f32_fp8((w), true); \
        acc[(k) * 4 + 0] += cf_ * l_.x; acc[(k) * 4 + 1] += cf_ * l_.y; acc[(k) * 4 + 2] += cf_ * h_.x; acc[(k) * 4 + 3] += cf_ * h_.y; } while (0)
#define PE_COMP(UB, VB, grp) do { float d_[4]; \
        _Pragma("unroll") for (int i_ = 0; i_ < 4; ++i_) { float a_ = 0.f, b_ = 0.f; PE_DOT4(UB[i_].x, 0); PE_DOT4(UB[i_].y, 1); PE_DOT4(UB[i_].z, 2); PE_DOT4(UB[i_].w, 3); d_[i_] = a_ + b_; } \
          \
        float s0_ = hi32 ? d_[2] : d_[0], t0_ = hi32 ? d_[0] : d_[2]; s0_ += __shfl_xor(t0_, 32); \
        float s1_ = hi32 ? d_[3] : d_[1], t1_ = hi32 ? d_[1] : d_[3]; s1_ += __shfl_xor(t1_, 32); \
        float r_ = hi16 ? s1_ : s0_, t2_ = hi16 ? s0_ : s1_; r_ += __shfl_xor(t2_, 16); \
        r_ += __shfl_xor(r_, 8); r_ += __shfl_xor(r_, 4); r_ += __shfl_xor(r_, 2); r_ += __shfl_xor(r_, 1); \
          \
        const int esel_ = (grp) * 4 + (lane >> 4); \
        const float su_ = __shfl(esel_ < 64 ? su0 : su1, esel_ & 63), gv_ = __shfl(esel_ < 64 ? gs0 : gs1, esel_ & 63); \
        const float cfl_ = geluf_(r_ * su_) * gv_; \
        _Pragma("unroll") for (int i_ = 0; i_ < 4; ++i_) { \
            const float cf_ = __uint_as_float(__builtin_amdgcn_readlane(__float_as_uint(cfl_), 16 * i_)); \
            PE_AXPY4(VB[i_].x, 0); PE_AXPY4(VB[i_].y, 1); PE_AXPY4(VB[i_].z, 2); PE_AXPY4(VB[i_].w, 3); } } while (0)
__device__ __forceinline__ void peer_expert_w(const float* __restrict__ xrow, const int* __restrict__ exr, const float* __restrict__ gar,
                                              const unsigned char* __restrict__ U, const unsigned char* __restrict__ V, const float* __restrict__ SU, const float* __restrict__ SV,
                                              const float* __restrict__ g, const float* __restrict__ bta, float* __restrict__ orow, bf16* __restrict__ obrow, int lane) {
    const bool hi32 = (lane & 32) != 0, hi16 = (lane & 16) != 0;
    const __amdgpu_buffer_rsrc_t ursrc = __builtin_amdgcn_make_buffer_rsrc((void*)U, 0, 16384 * 1024, 0x00020000);
    const __amdgpu_buffer_rsrc_t vrsrc = __builtin_amdgcn_make_buffer_rsrc((void*)V, 0, 16384 * 1024, 0x00020000);
    const int voff = lane * 16;
    float xv[16];
#pragma unroll
    for (int j = 0; j < 4; ++j) { const f32x4 t = *(const f32x4*)(xrow + lane * 16 + j * 4); xv[j * 4 + 0] = t.x; xv[j * 4 + 1] = t.y; xv[j * 4 + 2] = t.z; xv[j * 4 + 3] = t.w; }
    const int id0 = exr[lane], id1 = exr[64 + lane];
    const float su0 = SU[id0], su1 = SU[id1];
    const float gs0 = gar[lane] * SV[id0], gs1 = gar[64 + lane] * SV[id1];
    float acc[16];
#pragma unroll
    for (int i = 0; i < 16; ++i) acc[i] = 0.f;
    v4u ua[4], va[4], ub[4], vb[4];
    PE_LOAD(ua, va, 0);
#pragma unroll 1
    for (int grp = 0; grp < 32; grp += 2) {
        PE_LOAD(ub, vb, grp + 1);
        PE_COMP(ua, va, grp);
        if (grp + 2 < 32) PE_LOAD(ua, va, grp + 2);
        PE_COMP(ub, vb, grp + 1);
    }
    float v[16]; float s = 0.f;
#pragma unroll
    for (int i = 0; i < 16; ++i) { v[i] = ALPHA * xv[i] + acc[i]; s += v[i]; }
    const float mean = wave_sum(s) * (1.0f / 1024.0f); float q = 0.f;
#pragma unroll
    for (int i = 0; i < 16; ++i) { v[i] -= mean; q += v[i] * v[i]; }
    const float rs = rsqrtf(wave_sum(q) * (1.0f / 1024.0f) + LN_EPS);
    float o[16];
#pragma unroll
    for (int j = 0; j < 4; ++j) {
        const f32x4 g4 = *(const f32x4*)(g + lane * 16 + j * 4), b4 = *(const f32x4*)(bta + lane * 16 + j * 4);
        o[j * 4 + 0] = v[j * 4 + 0] * rs * g4.x + b4.x; o[j * 4 + 1] = v[j * 4 + 1] * rs * g4.y + b4.y; o[j * 4 + 2] = v[j * 4 + 2] * rs * g4.z + b4.z; o[j * 4 + 3] = v[j * 4 + 3] * rs * g4.w + b4.w;
        *(f32x4*)(orow + lane * 16 + j * 4) = (f32x4){o[j * 4 + 0], o[j * 4 + 1], o[j * 4 + 2], o[j * 4 + 3]};
    }
    if (obrow) {
        v4u w0, w1; w0.x = pk2(o[0], o[1]); w0.y = pk2(o[2], o[3]); w0.z = pk2(o[4], o[5]); w0.w = pk2(o[6], o[7]); w1.x = pk2(o[8], o[9]); w1.y = pk2(o[10], o[11]); w1.z = pk2(o[12], o[13]); w1.w = pk2(o[14], o[15]);
        *(v4u*)(obrow + lane * 16) = w0; *(v4u*)(obrow + lane * 16 + 8) = w1;
    }
}


__device__ __forceinline__ void peer_expert_blk(const float* __restrict__ xrow, const int* __restrict__ exr, const float* __restrict__ gar,
                                                const unsigned char* __restrict__ U, const unsigned char* __restrict__ V, const float* __restrict__ SU, const float* __restrict__ SV,
                                                const float* __restrict__ g, const float* __restrict__ bta, float* __restrict__ orow, bf16* __restrict__ obrow, int lane, int wave, float* smem) {
    const bool hi32 = (lane & 32) != 0, hi16 = (lane & 16) != 0;
    const __amdgpu_buffer_rsrc_t ursrc = __builtin_amdgcn_make_buffer_rsrc((void*)U, 0, 16384 * 1024, 0x00020000);
    const __amdgpu_buffer_rsrc_t vrsrc = __builtin_amdgcn_make_buffer_rsrc((void*)V, 0, 16384 * 1024, 0x00020000);
    const int voff = lane * 16;
    float xv[16];
#pragma unroll
    for (int j = 0; j < 4; ++j) { const f32x4 t = *(const f32x4*)(xrow + lane * 16 + j * 4); xv[j * 4 + 0] = t.x; xv[j * 4 + 1] = t.y; xv[j * 4 + 2] = t.z; xv[j * 4 + 3] = t.w; }
    const int id0 = exr[lane], id1 = exr[64 + lane];
    const float su0 = SU[id0], su1 = SU[id1];
    const float gs0 = gar[lane] * SV[id0], gs1 = gar[64 + lane] * SV[id1];
    float acc[16];
#pragma unroll
    for (int i = 0; i < 16; ++i) acc[i] = 0.f;
    v4u ua[4], va[4], ub[4], vb[4];
    const int g0 = wave * 4;
    PE_LOAD(ua, va, g0); PE_LOAD(ub, vb, g0 + 1);
    PE_COMP(ua, va, g0); PE_LOAD(ua, va, g0 + 2);
    PE_COMP(ub, vb, g0 + 1); PE_LOAD(ub, vb, g0 + 3);
    PE_COMP(ua, va, g0 + 2);
    PE_COMP(ub, vb, g0 + 3);
    float* accs = smem;
    float* sred = smem + 8192;
#pragma unroll
    for (int j = 0; j < 4; ++j) *(f32x4*)(accs + wave * 1024 + lane * 16 + j * 4) = (f32x4){acc[j * 4 + 0], acc[j * 4 + 1], acc[j * 4 + 2], acc[j * 4 + 3]};
    __syncthreads();
    const int tid = wave * 64 + lane;
    float v0 = ALPHA * xrow[tid * 2], v1 = ALPHA * xrow[tid * 2 + 1];
#pragma unroll
    for (int w = 0; w < 8; ++w) { v0 += accs[w * 1024 + tid * 2]; v1 += accs[w * 1024 + tid * 2 + 1]; }
    const float s = wave_sum(v0 + v1);
    if (lane == 0) sred[wave] = s;
    __syncthreads();
    float mean = 0.f;
#pragma unroll
    for (int w = 0; w < 8; ++w) mean += sred[w];
    mean *= (1.0f / 1024.0f);
    __syncthreads();
    const float d0 = v0 - mean, d1 = v1 - mean;
    const float q = wave_sum(d0 * d0 + d1 * d1);
    if (lane == 0) sred[wave] = q;
    __syncthreads();
    float var = 0.f;
#pragma unroll
    for (int w = 0; w < 8; ++w) var += sred[w];
    const float rs = rsqrtf(var * (1.0f / 1024.0f) + LN_EPS);
    const float o0 = d0 * rs * g[tid * 2] + bta[tid * 2], o1 = d1 * rs * g[tid * 2 + 1] + bta[tid * 2 + 1];
    *(float2*)(orow + tid * 2) = make_float2(o0, o1);
    if (obrow) *(unsigned*)(obrow + tid * 2) = pk2(o0, o1);
    __syncthreads();
}

__device__ __forceinline__ void row_to_fp8_sliced(const float* __restrict__ xrow, unsigned char* __restrict__ tab, int r, float* __restrict__ scale, int lane) {
    f32x4 v[4]; float am = 0.f;
#pragma unroll
    for (int j = 0; j < 4; ++j) { v[j] = *(const f32x4*)(xrow + lane * 16 + j * 4); am = fmaxf(am, fmaxf(fmaxf(fabsf(v[j].x), fabsf(v[j].y)), fmaxf(fabsf(v[j].z), fabsf(v[j].w)))); }
    am = wave_max(am);
    const float s = am > 0.f ? am * (1.0f / 448.0f) : 1.0f, inv = 1.0f / s;
    v4u o; unsigned w;
    w = 0u; w = __builtin_amdgcn_cvt_pk_fp8_f32(v[0].x * inv, v[0].y * inv, w, false); w = __builtin_amdgcn_cvt_pk_fp8_f32(v[0].z * inv, v[0].w * inv, w, true); o.x = w;
    w = 0u; w = __builtin_amdgcn_cvt_pk_fp8_f32(v[1].x * inv, v[1].y * inv, w, false); w = __builtin_amdgcn_cvt_pk_fp8_f32(v[1].z * inv, v[1].w * inv, w, true); o.y = w;
    w = 0u; w = __builtin_amdgcn_cvt_pk_fp8_f32(v[2].x * inv, v[2].y * inv, w, false); w = __builtin_amdgcn_cvt_pk_fp8_f32(v[2].z * inv, v[2].w * inv, w, true); o.z = w;
    w = 0u; w = __builtin_amdgcn_cvt_pk_fp8_f32(v[3].x * inv, v[3].y * inv, w, false); w = __builtin_amdgcn_cvt_pk_fp8_f32(v[3].z * inv, v[3].w * inv, w, true); o.w = w;
    *(v4u*)(tab + ((size_t)(lane >> 3) * 16384 + r) * 128 + (lane & 7) * 16) = o;
    if (lane == 0) *scale = s;
}
__device__ __forceinline__ void row_to_i8_sliced(const float* __restrict__ xrow, unsigned char* __restrict__ tab, int r, float* __restrict__ scale, int lane) {
    f32x4 v[4]; float am = 0.f;
#pragma unroll
    for (int j = 0; j < 4; ++j) { v[j] = *(const f32x4*)(xrow + lane * 16 + j * 4); am = fmaxf(am, fmaxf(fmaxf(fabsf(v[j].x), fabsf(v[j].y)), fmaxf(fabsf(v[j].z), fabsf(v[j].w)))); }
    am = wave_max(am);
    const float s = am > 0.f ? am * (1.0f / 127.0f) : 1.0f, inv = 1.0f / s;
    v4u o;
#define I8PK(q_) (((unsigned)(int)rintf((q_).x * inv) & 0xffu) | (((unsigned)(int)rintf((q_).y * inv) & 0xffu) << 8) | (((unsigned)(int)rintf((q_).z * inv) & 0xffu) << 16) | (((unsigned)(int)rintf((q_).w * inv) & 0xffu) << 24))
    o.x = I8PK(v[0]); o.y = I8PK(v[1]); o.z = I8PK(v[2]); o.w = I8PK(v[3]);
    *(v4u*)(tab + ((size_t)(lane >> 3) * 16384 + r) * 128 + (lane & 7) * 16) = o;
    if (lane == 0) *scale = s;
}

template <bool FP8>
__device__ __forceinline__ void table_rows_convert(const float* __restrict__ src, unsigned char* __restrict__ tab, float* __restrict__ scales, int rbeg, int rend, int gw, int ngw, int lane) {
    for (int r0 = rbeg + gw; r0 < rend; r0 += 4 * ngw) {
        f32x4 v[4][4]; int rr[4]; float am[4];
#pragma unroll
        for (int i = 0; i < 4; ++i) { rr[i] = r0 + i * ngw < rend ? r0 + i * ngw : rend - 1;
#pragma unroll
            for (int j = 0; j < 4; ++j) v[i][j] = *(const f32x4*)(src + (size_t)rr[i] * D + j * 256 + lane * 4); }
#pragma unroll
        for (int i = 0; i < 4; ++i) { float a = 0.f;
#pragma unroll
            for (int j = 0; j < 4; ++j) a = fmaxf(a, fmaxf(fmaxf(fabsf(v[i][j].x), fabsf(v[i][j].y)), fmaxf(fabsf(v[i][j].z), fabsf(v[i][j].w))));
            am[i] = a; }
#pragma unroll
        for (int i = 0; i < 4; ++i) am[i] = wave_max(am[i]);
#pragma unroll
        for (int i = 0; i < 4; ++i) {
            const float s = am[i] > 0.f ? am[i] * (FP8 ? 1.0f / 448.0f : 1.0f / 127.0f) : 1.0f, inv = 1.0f / s;
#pragma unroll
            for (int j = 0; j < 4; ++j) {
                unsigned w;
                if (FP8) { w = 0u; w = __builtin_amdgcn_cvt_pk_fp8_f32(v[i][j].x * inv, v[i][j].y * inv, w, false); w = __builtin_amdgcn_cvt_pk_fp8_f32(v[i][j].z * inv, v[i][j].w * inv, w, true); }
                else w = ((unsigned)(int)rintf(v[i][j].x * inv) & 0xffu) | (((unsigned)(int)rintf(v[i][j].y * inv) & 0xffu) << 8) | (((unsigned)(int)rintf(v[i][j].z * inv) & 0xffu) << 16) | (((unsigned)(int)rintf(v[i][j].w * inv) & 0xffu) << 24);
                *(unsigned*)(tab + ((size_t)(2 * j + (lane >> 5)) * 16384 + rr[i]) * 128 + (lane & 31) * 4) = w;
            }
            if (lane == 0) scales[rr[i]] = s;
        }
    }
}
__device__ __forceinline__ void peer_u_pass(const bf16* __restrict__ xrow, const int* __restrict__ exr, const unsigned char* __restrict__ U8x, float* __restrict__ pd, int x, int lane) {
    const int e8 = lane >> 3, c = lane & 7;
    f32x2_t xp[8];
#pragma unroll
    for (int j = 0; j < 2; ++j) { const v4u t = *(const v4u*)(xrow + x * 128 + c * 16 + j * 8);
        xp[j * 4 + 0] = (f32x2_t){bflo(t.x), bfhi(t.x)}; xp[j * 4 + 1] = (f32x2_t){bflo(t.y), bfhi(t.y)}; xp[j * 4 + 2] = (f32x2_t){bflo(t.z), bfhi(t.z)}; xp[j * 4 + 3] = (f32x2_t){bflo(t.w), bfhi(t.w)}; }
    const __amdgpu_buffer_rsrc_t ursrc = __builtin_amdgcn_make_buffer_rsrc((void*)U8x, 0, 16384 * 128, 0x00020000);
    v4u wa[8], wb[8];
    float d[16];
    int ids[16];
#pragma unroll
    for (int j = 0; j < 4; ++j) { const v4u t = *(const v4u*)(exr + e8 * 16 + j * 4); ids[j * 4 + 0] = (int)t.x; ids[j * 4 + 1] = (int)t.y; ids[j * 4 + 2] = (int)t.z; ids[j * 4 + 3] = (int)t.w; }
#pragma unroll
    for (int g = 0; g < 8; ++g) wa[g] = __builtin_amdgcn_raw_buffer_load_b128(ursrc, ids[g] * 128 + c * 16, 0, 0);
#pragma unroll
    for (int g = 0; g < 8; ++g) wb[g] = __builtin_amdgcn_raw_buffer_load_b128(ursrc, ids[8 + g] * 128 + c * 16, 0, 0);
#define PU_DOT1(w_, k_) do { a_ = __builtin_elementwise_fma(__builtin_amdgcn_cvt_pk_f32_fp8((w_), false), xp[(k_) * 2], a_); a_ = __builtin_elementwise_fma(__builtin_amdgcn_cvt_pk_f32_fp8((w_), true), xp[(k_) * 2 + 1], a_); } while (0)
#pragma unroll
    for (int g = 0; g < 8; ++g) { f32x2_t a_ = (f32x2_t){0.f, 0.f}; PU_DOT1(wa[g].x, 0); PU_DOT1(wa[g].y, 1); PU_DOT1(wa[g].z, 2); PU_DOT1(wa[g].w, 3); d[g] = a_.x + a_.y; }
#pragma unroll
    for (int g = 0; g < 8; ++g) { f32x2_t a_ = (f32x2_t){0.f, 0.f}; PU_DOT1(wb[g].x, 0); PU_DOT1(wb[g].y, 1); PU_DOT1(wb[g].z, 2); PU_DOT1(wb[g].w, 3); d[8 + g] = a_.x + a_.y; }
#pragma unroll
    for (int g = 0; g < 16; ++g) { d[g] += DPPF(d[g], 0xB1, 0xf); d[g] += DPPF(d[g], 0x4E, 0xf); d[g] += DPPF(d[g], 0x141, 0xf); }
    if (c == 0) {
#pragma unroll
        for (int j = 0; j < 4; ++j) *(f32x4*)(pd + e8 * 16 + j * 4) = (f32x4){d[j * 4 + 0], d[j * 4 + 1], d[j * 4 + 2], d[j * 4 + 3]};
    }
}
#define PUL_IDS(I, k_) do { const int t_ = ((tg0 + ((k_) < nit ? (k_) : nit - 1) * tgstep) * 8 + wave); _Pragma("unroll") for (int j = 0; j < 4; ++j) I[j] = *(const v4u*)(EXPp + (size_t)t_ * 128 + e8 * 16 + j * 4); } while (0)
#define PUL_ROWS(R, X, I, k_) do { const int t_ = ((tg0 + ((k_) < nit ? (k_) : nit - 1) * tgstep) * 8 + wave); \
        X[0] = *(const v4u*)(XBp + (size_t)t_ * D + x * 128 + c * 16); X[1] = *(const v4u*)(XBp + (size_t)t_ * D + x * 128 + c * 16 + 8); \
        _Pragma("unroll") for (int j = 0; j < 4; ++j) { R[j * 4 + 0] = __builtin_amdgcn_raw_buffer_load_b128(ursrc, (int)I[j].x * 128 + c * 16, 0, 0); R[j * 4 + 1] = __builtin_amdgcn_raw_buffer_load_b128(ursrc, (int)I[j].y * 128 + c * 16, 0, 0); \
            R[j * 4 + 2] = __builtin_amdgcn_raw_buffer_load_b128(ursrc, (int)I[j].z * 128 + c * 16, 0, 0); R[j * 4 + 3] = __builtin_amdgcn_raw_buffer_load_b128(ursrc, (int)I[j].w * 128 + c * 16, 0, 0); } } while (0)
#define PUL_COMP(R, X, k_) do { float xf_[16]; \
        _Pragma("unroll") for (int j = 0; j < 2; ++j) { xf_[j * 8 + 0] = bflo(X[j].x); xf_[j * 8 + 1] = bfhi(X[j].x); xf_[j * 8 + 2] = bflo(X[j].y); xf_[j * 8 + 3] = bfhi(X[j].y); xf_[j * 8 + 4] = bflo(X[j].z); xf_[j * 8 + 5] = bfhi(X[j].z); xf_[j * 8 + 6] = bflo(X[j].w); xf_[j * 8 + 7] = bfhi(X[j].w); } \
          \
        float am_ = 0.f; _Pragma("unroll") for (int i = 0; i < 16; ++i) am_ = fmaxf(am_, fabsf(xf_[i])); \
        am_ = fmaxf(am_, DPPF(am_, 0xB1, 0xf)); am_ = fmaxf(am_, DPPF(am_, 0x4E, 0xf)); am_ = fmaxf(am_, DPPF(am_, 0x141, 0xf)); \
        const float sx_ = am_ > 0.f ? am_ * (1.0f / 127.0f) : 1.0f, ix_ = 1.0f / sx_; \
        int xq_[4]; \
        _Pragma("unroll") for (int j = 0; j < 4; ++j) xq_[j] = (int)(((unsigned)(int)rintf(xf_[j * 4 + 0] * ix_) & 0xffu) | (((unsigned)(int)rintf(xf_[j * 4 + 1] * ix_) & 0xffu) << 8) | (((unsigned)(int)rintf(xf_[j * 4 + 2] * ix_) & 0xffu) << 16) | (((unsigned)(int)rintf(xf_[j * 4 + 3] * ix_) & 0xffu) << 24)); \
        float d[16]; \
        _Pragma("unroll") for (int g = 0; g < 16; ++g) { int a_ = __builtin_amdgcn_sdot4((int)R[g].x, xq_[0], 0, false); a_ = __builtin_amdgcn_sdot4((int)R[g].y, xq_[1], a_, false); a_ = __builtin_amdgcn_sdot4((int)R[g].z, xq_[2], a_, false); a_ = __builtin_amdgcn_sdot4((int)R[g].w, xq_[3], a_, false); d[g] = (float)a_; } \
        _Pragma("unroll") for (int g = 0; g < 16; ++g) { d[g] += DPPF(d[g], 0xB1, 0xf); d[g] += DPPF(d[g], 0x4E, 0xf); d[g] += DPPF(d[g], 0x141, 0xf); d[g] *= sx_; } \
        if (c == 0 && (k_) < nit) { float* pd_ = PDx + (size_t)((tg0 + (k_) * tgstep) * 8 + wave) * 128 + e8 * 16; \
            _Pragma("unroll") for (int j = 0; j < 4; ++j) *(f32x4*)(pd_ + j * 4) = (f32x4){d[j * 4 + 0], d[j * 4 + 1], d[j * 4 + 2], d[j * 4 + 3]}; } } while (0)
__device__ __forceinline__ void peer_u_loop(const bf16* __restrict__ XBp, const int* __restrict__ EXPp, const unsigned char* __restrict__ U8x, float* __restrict__ PDx, int x, int tg0, int tgstep, int nit, int wave, int lane) {
    const int e8 = lane >> 3, c = lane & 7;
    const __amdgpu_buffer_rsrc_t ursrc = __builtin_amdgcn_make_buffer_rsrc((void*)U8x, 0, 16384 * 128, 0x00020000);
    v4u ra[16], rb[16], xa[2], xb[2], i0[4], i1[4];
    PUL_IDS(i0, 0);
    PUL_ROWS(ra, xa, i0, 0);
    PUL_IDS(i1, 1);
#pragma unroll 1
    for (int k = 0; k < nit; k += 2) {
        PUL_ROWS(rb, xb, i1, k + 1);
        PUL_IDS(i0, k + 2);
        PUL_COMP(ra, xa, k);
        PUL_ROWS(ra, xa, i0, k + 2);
        PUL_IDS(i1, k + 3);
        PUL_COMP(rb, xb, k + 1);
    }
}
#define PV_LOAD(VB, grp) do { _Pragma("unroll") for (int i_ = 0; i_ < 4; ++i_) { const int e_ = (grp) * 4 + i_; \
        const int id_ = __builtin_amdgcn_readlane(e_ < 64 ? id0 : id1, e_ & 63); \
        VB[i_] = __builtin_amdgcn_raw_buffer_load_b128(vrsrc, voff, (unsigned)id_ * 1024u, 0); } } while (0)
#define PV_COMP(VB, grp) do { _Pragma("unroll") for (int i_ = 0; i_ < 4; ++i_) { const int e_ = (grp) * 4 + i_; \
        const float cf_ = __uint_as_float(__builtin_amdgcn_readlane(__float_as_uint(e_ < 64 ? cf0 : cf1), e_ & 63)); \
        PE_AXPY4(VB[i_].x, 0); PE_AXPY4(VB[i_].y, 1); PE_AXPY4(VB[i_].z, 2); PE_AXPY4(VB[i_].w, 3); } } while (0)
#define PV_COEFS() \
    const int id0 = exr[lane], id1 = exr[64 + lane]; \
    float dot0 = 0.f, dot1 = 0.f; \
    { const int p0 = lane, p1 = 64 + lane;        \
      _Pragma("unroll") for (int x_ = 0; x_ < 8; ++x_) { dot0 += pdt[(size_t)x_ * NT * 128 + p0]; dot1 += pdt[(size_t)x_ * NT * 128 + p1]; } } \
    const float cf0 = gar[lane] * SV[id0] * geluf_(SU[id0] * dot0), cf1 = gar[64 + lane] * SV[id1] * geluf_(SU[id1] * dot1);
__device__ __forceinline__ void peer_v_w(const float* __restrict__ xrow, const int* __restrict__ exr, const float* __restrict__ gar, const float* __restrict__ pdt,
                                         const unsigned char* __restrict__ V, const float* __restrict__ SU, const float* __restrict__ SV,
                                         const float* __restrict__ g, const float* __restrict__ bta, float* __restrict__ orow, bf16* __restrict__ obrow, int lane) {
    const __amdgpu_buffer_rsrc_t vrsrc = __builtin_amdgcn_make_buffer_rsrc((void*)V, 0, 16384 * 1024, 0x00020000);
    const int voff = lane * 16;
    PV_COEFS()
    float acc[16];
#pragma unroll
    for (int i = 0; i < 16; ++i) acc[i] = 0.f;
    v4u va[4], vb[4], vc[4];
    PV_LOAD(va, 0); PV_LOAD(vb, 1);
#pragma unroll 1
    for (int grp = 0; grp < 30; grp += 3) {
        PV_LOAD(vc, grp + 2);
        PV_COMP(va, grp);
        PV_LOAD(va, grp + 3);
        PV_COMP(vb, grp + 1);
        PV_LOAD(vb, grp + 4);
        PV_COMP(vc, grp + 2);
    }
    PV_COMP(va, 30); PV_COMP(vb, 31);
    float xv[16];
#pragma unroll
    for (int j = 0; j < 4; ++j) { const f32x4 t = *(const f32x4*)(xrow + lane * 16 + j * 4); xv[j * 4 + 0] = t.x; xv[j * 4 + 1] = t.y; xv[j * 4 + 2] = t.z; xv[j * 4 + 3] = t.w; }
    float v[16]; float s = 0.f;
#pragma unroll
    for (int i = 0; i < 16; ++i) { v[i] = ALPHA * xv[i] + acc[i]; s += v[i]; }
    const float mean = wave_sum(s) * (1.0f / 1024.0f); float q = 0.f;
#pragma unroll
    for (int i = 0; i < 16; ++i) { v[i] -= mean; q += v[i] * v[i]; }
    const float rs = rsqrtf(wave_sum(q) * (1.0f / 1024.0f) + LN_EPS);
    float o[16];
#pragma unroll
    for (int j = 0; j < 4; ++j) {
        const f32x4 g4 = *(const f32x4*)(g + lane * 16 + j * 4), b4 = *(const f32x4*)(bta + lane * 16 + j * 4);
        o[j * 4 + 0] = v[j * 4 + 0] * rs * g4.x + b4.x; o[j * 4 + 1] = v[j * 4 + 1] * rs * g4.y + b4.y; o[j * 4 + 2] = v[j * 4 + 2] * rs * g4.z + b4.z; o[j * 4 + 3] = v[j * 4 + 3] * rs * g4.w + b4.w;
        *(f32x4*)(orow + lane * 16 + j * 4) = (f32x4){o[j * 4 + 0], o[j * 4 + 1], o[j * 4 + 2], o[j * 4 + 3]};
    }
    if (obrow) {
        v4u w0, w1; w0.x = pk2(o[0], o[1]); w0.y = pk2(o[2], o[3]); w0.z = pk2(o[4], o[5]); w0.w = pk2(o[6], o[7]); w1.x = pk2(o[8], o[9]); w1.y = pk2(o[10], o[11]); w1.z = pk2(o[12], o[13]); w1.w = pk2(o[14], o[15]);
        *(v4u*)(obrow + lane * 16) = w0; *(v4u*)(obrow + lane * 16 + 8) = w1;
    }
}
__device__ __forceinline__ void peer_v_blk(const float* __restrict__ xrow, const int* __restrict__ exr, const float* __restrict__ gar, const float* __restrict__ pdt,
                                           const unsigned char* __restrict__ V, const float* __restrict__ SU, const float* __restrict__ SV,
                                           const float* __restrict__ g, const float* __restrict__ bta, float* __restrict__ orow, bf16* __restrict__ obrow, int lane, int wave, float* smem) {
    const __amdgpu_buffer_rsrc_t vrsrc = __builtin_amdgcn_make_buffer_rsrc((void*)V, 0, 16384 * 1024, 0x00020000);
    const int voff = lane * 16;
    PV_COEFS()
    float acc[16];
#pragma unroll
    for (int i = 0; i < 16; ++i) acc[i] = 0.f;
    v4u va[4], vb[4], vc[4], vd[4];
    PV_LOAD(va, wave * 4); PV_LOAD(vb, wave * 4 + 1); PV_LOAD(vc, wave * 4 + 2); PV_LOAD(vd, wave * 4 + 3);
    PV_COMP(va, wave * 4); PV_COMP(vb, wave * 4 + 1); PV_COMP(vc, wave * 4 + 2); PV_COMP(vd, wave * 4 + 3);
    float* accs = smem;
    float* sred = smem + 8192;
#pragma unroll
    for (int j = 0; j < 4; ++j) *(f32x4*)(accs + wave * 1024 + lane * 16 + j * 4) = (f32x4){acc[j * 4 + 0], acc[j * 4 + 1], acc[j * 4 + 2], acc[j * 4 + 3]};
    __syncthreads();
    const int tid = wave * 64 + lane;
    float v0 = ALPHA * xrow[tid * 2], v1 = ALPHA * xrow[tid * 2 + 1];
#pragma unroll
    for (int w = 0; w < 8; ++w) { v0 += accs[w * 1024 + tid * 2]; v1 += accs[w * 1024 + tid * 2 + 1]; }
    const float s = wave_sum(v0 + v1);
    if (lane == 0) sred[wave] = s;
    __syncthreads();
    float mean = 0.f;
#pragma unroll
    for (int w = 0; w < 8; ++w) mean += sred[w];
    mean *= (1.0f / 1024.0f);
    __syncthreads();
    const float d0 = v0 - mean, d1 = v1 - mean;
    const float q = wave_sum(d0 * d0 + d1 * d1);
    if (lane == 0) sred[wave] = q;
    __syncthreads();
    float var = 0.f;
#pragma unroll
    for (int w = 0; w < 8; ++w) var += sred[w];
    const float rs = rsqrtf(var * (1.0f / 1024.0f) + LN_EPS);
    const float o0 = d0 * rs * g[tid * 2] + bta[tid * 2], o1 = d1 * rs * g[tid * 2 + 1] + bta[tid * 2 + 1];
    *(float2*)(orow + tid * 2) = make_float2(o0, o1);
    if (obrow) *(unsigned*)(obrow + tid * 2) = pk2(o0, o1);
    __syncthreads();
}

__device__ __forceinline__ void peer_xk(const int* __restrict__ exr, float* __restrict__ gar, const float* __restrict__ pdt, const float* __restrict__ SU, const float* __restrict__ SV, int lane) {
    PV_COEFS()
    gar[lane] = cf0; gar[64 + lane] = cf1;
}
__device__ __forceinline__ void peer_v_slice(const int* __restrict__ exr, const float* __restrict__ cfr, const unsigned char* __restrict__ V8x, float* __restrict__ outs  , int lane) {
    const int e8 = lane >> 3, c = lane & 7;
    const __amdgpu_buffer_rsrc_t vrsrc = __builtin_amdgcn_make_buffer_rsrc((void*)V8x, 0, 16384 * 128, 0x00020000);
    v4u wa[8], wb[8]; float cfa[8], cfb[8];
    int ids[16];
#pragma unroll
    for (int j = 0; j < 4; ++j) { const v4u t = *(const v4u*)(exr + e8 * 16 + j * 4); ids[j * 4 + 0] = (int)t.x; ids[j * 4 + 1] = (int)t.y; ids[j * 4 + 2] = (int)t.z; ids[j * 4 + 3] = (int)t.w; }
#pragma unroll
    for (int g = 0; g < 8; ++g) wa[g] = __builtin_amdgcn_raw_buffer_load_b128(vrsrc, ids[g] * 128 + c * 16, 0, 0);
#pragma unroll
    for (int g = 0; g < 8; ++g) wb[g] = __builtin_amdgcn_raw_buffer_load_b128(vrsrc, ids[8 + g] * 128 + c * 16, 0, 0);
#pragma unroll
    for (int j = 0; j < 2; ++j) { const f32x4 t = *(const f32x4*)(cfr + e8 * 16 + j * 4), u = *(const f32x4*)(cfr + e8 * 16 + 8 + j * 4);
        cfa[j * 4 + 0] = t.x; cfa[j * 4 + 1] = t.y; cfa[j * 4 + 2] = t.z; cfa[j * 4 + 3] = t.w; cfb[j * 4 + 0] = u.x; cfb[j * 4 + 1] = u.y; cfb[j * 4 + 2] = u.z; cfb[j * 4 + 3] = u.w; }
    f32x2_t ap[8];
#pragma unroll
    for (int i = 0; i < 8; ++i) ap[i] = (f32x2_t){0.f, 0.f};
#define PVS_AXPY(w_, k_) do { ap[(k_) * 2] = __builtin_elementwise_fma(cf2_, __builtin_amdgcn_cvt_pk_f32_fp8((w_), false), ap[(k_) * 2]); ap[(k_) * 2 + 1] = __builtin_elementwise_fma(cf2_, __builtin_amdgcn_cvt_pk_f32_fp8((w_), true), ap[(k_) * 2 + 1]); } while (0)
#pragma unroll
    for (int g = 0; g < 8; ++g) { const f32x2_t cf2_ = (f32x2_t){cfa[g], cfa[g]}; PVS_AXPY(wa[g].x, 0); PVS_AXPY(wa[g].y, 1); PVS_AXPY(wa[g].z, 2); PVS_AXPY(wa[g].w, 3); }
#pragma unroll
    for (int g = 0; g < 8; ++g) { const f32x2_t cf2_ = (f32x2_t){cfb[g], cfb[g]}; PVS_AXPY(wb[g].x, 0); PVS_AXPY(wb[g].y, 1); PVS_AXPY(wb[g].z, 2); PVS_AXPY(wb[g].w, 3); }
#undef PVS_AXPY
    float acc[16];
#pragma unroll
    for (int i = 0; i < 8; ++i) { acc[2 * i] = ap[i].x; acc[2 * i + 1] = ap[i].y; }
#pragma unroll
    for (int i = 0; i < 16; ++i) { float v = acc[i]; v += DPPF(v, 0x128, 0xf); v += __shfl_xor(v, 16); v += __shfl_xor(v, 32); acc[i] = v; }
    if (e8 == 0) {
#pragma unroll
        for (int j = 0; j < 4; ++j) *(f32x4*)(outs + c * 16 + j * 4) = (f32x4){acc[j * 4 + 0], acc[j * 4 + 1], acc[j * 4 + 2], acc[j * 4 + 3]};
    }
}
#define PVL_IDS(I, k_) do { const int t_ = ((tg0 + ((k_) < nit ? (k_) : nit - 1) * tgstep) * 8 + wave); _Pragma("unroll") for (int j = 0; j < 4; ++j) I[j] = *(const v4u*)(EXPp + (size_t)t_ * 128 + e8 * 16 + j * 4); } while (0)
#define PVL_ROWS(R, C, I, k_) do { const int t_ = ((tg0 + ((k_) < nit ? (k_) : nit - 1) * tgstep) * 8 + wave); \
        _Pragma("unroll") for (int j = 0; j < 4; ++j) C[j] = *(const f32x4*)(CFp + (size_t)t_ * 128 + e8 * 16 + j * 4); \
        _Pragma("unroll") for (int j = 0; j < 4; ++j) { R[j * 4 + 0] = __builtin_amdgcn_raw_buffer_load_b128(vrsrc, (int)I[j].x * 128 + c * 16, 0, 0); R[j * 4 + 1] = __builtin_amdgcn_raw_buffer_load_b128(vrsrc, (int)I[j].y * 128 + c * 16, 0, 0); \
            R[j * 4 + 2] = __builtin_amdgcn_raw_buffer_load_b128(vrsrc, (int)I[j].z * 128 + c * 16, 0, 0); R[j * 4 + 3] = __builtin_amdgcn_raw_buffer_load_b128(vrsrc, (int)I[j].w * 128 + c * 16, 0, 0); } } while (0)
#define PVL_AXPY(w_, k2_) do { ap[(k2_) * 2] = __builtin_elementwise_fma(cf2_, __builtin_amdgcn_cvt_pk_f32_fp8((w_), false), ap[(k2_) * 2]); ap[(k2_) * 2 + 1] = __builtin_elementwise_fma(cf2_, __builtin_amdgcn_cvt_pk_f32_fp8((w_), true), ap[(k2_) * 2 + 1]); } while (0)
#define PVL_COMP(R, C, k_) do { f32x2_t ap[8]; \
        _Pragma("unroll") for (int i = 0; i < 8; ++i) ap[i] = (f32x2_t){0.f, 0.f}; \
        _Pragma("unroll") for (int g = 0; g < 16; ++g) { const float cfs_ = C[g >> 2][g & 3]; const f32x2_t cf2_ = (f32x2_t){cfs_, cfs_}; PVL_AXPY(R[g].x, 0); PVL_AXPY(R[g].y, 1); PVL_AXPY(R[g].z, 2); PVL_AXPY(R[g].w, 3); } \
        float acc[16]; \
        _Pragma("unroll") for (int i = 0; i < 8; ++i) { acc[2 * i] = ap[i].x; acc[2 * i + 1] = ap[i].y; } \
        float a8[8], a4[4], a2[2]; \
          \
        _Pragma("unroll") for (int i = 0; i < 8; ++i) { const auto sw_ = __builtin_amdgcn_permlane32_swap(__float_as_uint(acc[i]), __float_as_uint(acc[8 + i]), false, false); a8[i] = __uint_as_float(sw_[0]) + __uint_as_float(sw_[1]); } \
        _Pragma("unroll") for (int i = 0; i < 4; ++i) { const auto sw_ = __builtin_amdgcn_permlane16_swap(__float_as_uint(a8[i]), __float_as_uint(a8[4 + i]), false, false); a4[i] = __uint_as_float(sw_[0]) + __uint_as_float(sw_[1]); } \
        _Pragma("unroll") for (int i = 0; i < 2; ++i) { const float keep = hC ? a4[2 + i] : a4[i], send = hC ? a4[i] : a4[2 + i]; a2[i] = keep + DPPF(send, 0x128, 0xf); } \
        if ((k_) < nit) *(float2*)(OUTp + (size_t)((tg0 + (k_) * tgstep) * 8 + wave) * D + x * 128 + c * 16 + 2 * e8) = make_float2(a2[0], a2[1]); } while (0)
__device__ __forceinline__ void peer_v_loop(const int* __restrict__ EXPp, const float* __restrict__ CFp, const unsigned char* __restrict__ V8x, float* __restrict__ OUTp, int x, int tg0, int tgstep, int nit, int wave, int lane) {
    const int e8 = lane >> 3, c = lane & 7;
    const bool hA = (lane & 32) != 0, hB = (lane & 16) != 0, hC = (lane & 8) != 0;
    const __amdgpu_buffer_rsrc_t vrsrc = __builtin_amdgcn_make_buffer_rsrc((void*)V8x, 0, 16384 * 128, 0x00020000);
    v4u ra[16], rb[16], i0[4], i1[4]; f32x4 ca[4], cb[4];
    PVL_IDS(i0, 0);
    PVL_ROWS(ra, ca, i0, 0);
    PVL_IDS(i1, 1);
#pragma unroll 1
    for (int k = 0; k < nit; k += 2) {
        PVL_ROWS(rb, cb, i1, k + 1);
        PVL_IDS(i0, k + 2);
        PVL_COMP(ra, ca, k);
        PVL_ROWS(ra, ca, i0, k + 2);
        PVL_IDS(i1, k + 3);
        PVL_COMP(rb, cb, k + 1);
    }
}
__device__ __forceinline__ void peer_xc(const bf16* __restrict__ xrow, const float* __restrict__ srow, const float* __restrict__ g, const float* __restrict__ bta, float* __restrict__ orow, bf16* __restrict__ obrow, bf16* __restrict__ obrow2, int lane) {
    f32x4 v[4]; float s = 0.f;
#pragma unroll
    for (int j = 0; j < 4; ++j) { const v2u ab = ((const v2u*)xrow)[lane + 64 * j]; const f32x4 b = ((const f32x4*)srow)[lane + 64 * j];
        v[j] = (f32x4){ALPHA * bflo(ab.x) + b.x, ALPHA * bfhi(ab.x) + b.y, ALPHA * bflo(ab.y) + b.z, ALPHA * bfhi(ab.y) + b.w}; s += (v[j].x + v[j].y) + (v[j].z + v[j].w); }
    const float mean = wave_sum(s) * (1.0f / 1024.0f); float q = 0.f;
#pragma unroll
    for (int j = 0; j < 4; ++j) { v[j] = v[j] - mean; q += (v[j].x * v[j].x + v[j].y * v[j].y) + (v[j].z * v[j].z + v[j].w * v[j].w); }
    const float rs = rsqrtf(wave_sum(q) * (1.0f / 1024.0f) + LN_EPS);
#pragma unroll
    for (int j = 0; j < 4; ++j) {
        const f32x4 g4 = ((const f32x4*)g)[lane + 64 * j], b4 = ((const f32x4*)bta)[lane + 64 * j];
        const f32x4 o = v[j] * rs * g4 + b4;
        if (orow) ((f32x4*)orow)[lane + 64 * j] = o;
        if (obrow) { v2u ob; ob.x = pk2(o.x, o.y); ob.y = pk2(o.z, o.w); ((v2u*)obrow)[lane + 64 * j] = ob; if (obrow2) ((v2u*)obrow2)[lane + 64 * j] = ob; }
    }
}

__device__ __forceinline__ int t5_bucket(int n) {
    if (n < 16) return n;
    const int large = 16 + (int)(logf((float)n / 16.0f) / 2.0794415416798357f * 16.0f);
    return large < 31 ? large : 31;
}
__device__ __forceinline__ void swa_attn(const float* __restrict__ PC, const float* __restrict__ cache_k, const float* __restrict__ cache_v,
                                         const float* __restrict__ rel_bias, const float* __restrict__ sinks, bf16* __restrict__ ATT, int bx) {
    const int tid = threadIdx.x, lane = tid & 63, wid = tid >> 6;
    const int gw = bx * 8 + wid;
    const int t = gw >> 4, h = gw & 15, kvh = h >> 2;
    if (t >= NT) return;
    const bool samp = t >= NP; const int sb = t - NP, pos = t % SEQ;
    const float* qrow = PC + (size_t)t * CN + h * 64;
    float lg[2]; bool valid[2];
#pragma unroll
    for (int rr = 0; rr < 2; ++rr) {
        const int r = lane + 64 * rr;
        const float* krow;
        if (!samp) { valid[rr] = (pos - r) >= 0; krow = PC + (size_t)(valid[rr] ? t - r : t) * CN + 1024 + kvh * 64; }
        else { valid[rr] = true; krow = (r == 0) ? PC + (size_t)t * CN + 1024 + kvh * 64 : cache_k + (((size_t)sb * 128 + (128 - r)) * 4 + kvh) * 64; }
        float dot = 0.f;
#pragma unroll
        for (int d4 = 0; d4 < 16; ++d4) {
            const float4 kv = *(const float4*)(krow + d4 * 4);
            const float4 qv = *(const float4*)(qrow + d4 * 4);
            dot += qv.x * kv.x + qv.y * kv.y + qv.z * kv.z + qv.w * kv.w;
        }
        lg[rr] = valid[rr] ? dot * 0.125f + rel_bias[t5_bucket(r) * 16 + h] : -INFINITY;
    }
    const float sink = sinks[h];
    const float m = fmaxf(wave_max(fmaxf(lg[0], lg[1])), sink);
    float p[2];
#pragma unroll
    for (int rr = 0; rr < 2; ++rr) p[rr] = valid[rr] ? expf(lg[rr] - m) : 0.f;
    const float den = wave_sum(p[0] + p[1]) + expf(sink - m);
    const float inv = 1.0f / den;
    float o = 0.f;
#pragma unroll
    for (int rr = 0; rr < 2; ++rr)
        for (int l2 = 0; l2 < 64; ++l2) {
            const int r = l2 + 64 * rr;
            const float pj = __shfl(p[rr], l2);
            if (pj != 0.f) {
                const float* vrow;
                if (!samp) vrow = PC + (size_t)(t - r) * CN + 1280 + kvh * 64;
                else vrow = (r == 0) ? PC + (size_t)t * CN + 1280 + kvh * 64 : cache_v + (((size_t)sb * 128 + (128 - r)) * 4 + kvh) * 64;
                o += pj * vrow[lane];
            }
        }
    ATT[(size_t)t * D + h * 64 + lane] = (bf16)f2bf(o * inv);
}

__device__ __forceinline__ void swa_kv_out(const float* __restrict__ PC, const float* __restrict__ cache_k, const float* __restrict__ cache_v,
                                           float* __restrict__ pk, float* __restrict__ pv, float* __restrict__ sk, float* __restrict__ sv, int vb) {
    const int c = threadIdx.x & 255, row = vb * 2 + (threadIdx.x >> 8);
    if (row < NB * 128) {
        const int b = row >> 7, i = row & 127;
        const float* src = PC + (size_t)(b * SEQ + SEQ - 128 + i) * CN;
        pk[(size_t)row * 256 + c] = src[1024 + c];
        pv[(size_t)row * 256 + c] = src[1280 + c];
    } else {
        const int r2 = row - NB * 128, sb = r2 >> 7, i = r2 & 127;
        if (i < 127) {
            sk[(size_t)r2 * 256 + c] = cache_k[((size_t)sb * 128 + i + 1) * 256 + c];
            sv[(size_t)r2 * 256 + c] = cache_v[((size_t)sb * 128 + i + 1) * 256 + c];
        } else {
            const float* src = PC + (size_t)(NP + sb) * CN;
            sk[(size_t)r2 * 256 + c] = src[1024 + c];
            sv[(size_t)r2 * 256 + c] = src[1280 + c];
        }
    }
}
#define XB_TMO      128
#define XB_XCNT(j)  (256  + 64 * (j))
#define XB_XSUB(j)  (1280 + 64 * (j))
#define XB_XGEN(j)  (2304 + 64 * (j))
#define XB_TOP      3328
#define XB_TOPGEN   3392
#define XCD_BAR_WORDS 3456
#define XB_SPIN_CAP (1u << 18)

__device__ __forceinline__ unsigned xb_ld(unsigned* p)              { return __hip_atomic_load(p, __ATOMIC_RELAXED, __HIP_MEMORY_SCOPE_AGENT); }
__device__ __forceinline__ unsigned xb_add(unsigned* p, unsigned v) { return __hip_atomic_fetch_add(p, v, __ATOMIC_RELAXED, __HIP_MEMORY_SCOPE_AGENT); }
__device__ __forceinline__ unsigned xb_xcc_id() { return (unsigned)__builtin_amdgcn_s_getreg((3 << 11) | 20) & 0xFu; }
#define XB_SPIN(cond, bar) do { unsigned _sp = 0; while (cond) { __builtin_amdgcn_s_sleep(1); \
    if ((++_sp & 255u) == 0u) { if (xb_ld(&(bar)[XB_TMO])) break; if (_sp > XB_SPIN_CAP) { atomicAdd(&(bar)[XB_TMO], 1u); break; } } } } while (0)

struct XcdBarrier {
    unsigned* bar; unsigned x;
    volatile LAS unsigned* st;
};

__device__ __forceinline__ XcdBarrier xcd_barrier_post(unsigned* bar, volatile LAS unsigned* st) {
    XcdBarrier b; b.bar = bar; b.x = xb_xcc_id(); b.st = st;
    if (threadIdx.x == 0) (void)xb_add(&bar[XB_XCNT(b.x)], 1u);
    return b;
}
__device__ __forceinline__ void xcd_barrier_complete(unsigned* bar, unsigned x, unsigned& nloc, unsigned& nx) {
    const unsigned G = gridDim.x * gridDim.y * gridDim.z;
    unsigned sum, cnt, mine, sp = 0u;
    for (;;) {
        sum = 0u; cnt = 0u; mine = 0u;
#pragma unroll
        for (unsigned j = 0; j < 16; ++j) { const unsigned c = xb_ld(&bar[XB_XCNT(j)]); sum += c; cnt += (c > 0u) ? 1u : 0u; mine = (j == x) ? c : mine; }
        if (sum == G) break;
        __builtin_amdgcn_s_sleep(1);
        if ((++sp & 255u) == 0u) { if (xb_ld(&bar[XB_TMO])) break; if (sp > XB_SPIN_CAP) { atomicAdd(&bar[XB_TMO], 1u); break; } }
    }
    nloc = mine > 0u ? mine : 1u; nx = cnt > 0u ? cnt : 1u;
}

__device__ __forceinline__ void xcd_barrier(const XcdBarrier& b) {
    asm volatile("s_waitcnt vmcnt(0)" ::: "memory");
    __syncthreads();
    if (threadIdx.x == 0) {
        unsigned* bar = b.bar;
        __builtin_amdgcn_s_waitcnt(0);
        unsigned nloc = b.st[0], nx = b.st[1];
        if (nloc == 0u) { xcd_barrier_complete(bar, b.x, nloc, nx); b.st[0] = nloc; b.st[1] = nx; }
        const unsigned old = xb_add(&bar[XB_XSUB(b.x)], 1u);
        const unsigned gen = old / nloc;
        if (old + 1u == (gen + 1u) * nloc) {
            __builtin_amdgcn_fence(__ATOMIC_RELEASE, "agent");
            asm volatile("s_waitcnt vmcnt(0)" ::: "memory");
            const unsigned og = xb_add(&bar[XB_TOP], 1u);
            const unsigned tg = og / nx;
            if (og + 1u == (tg + 1u) * nx) xb_add(&bar[XB_TOPGEN], 1u);
            else XB_SPIN(xb_ld(&bar[XB_TOPGEN]) == tg, bar);
            __builtin_amdgcn_fence(__ATOMIC_ACQUIRE, "agent");
            xb_add(&bar[XB_XGEN(b.x)], 1u);
            asm volatile("s_waitcnt vmcnt(0)" ::: "memory");
        } else {
            XB_SPIN(xb_ld(&bar[XB_XGEN(b.x)]) == gen, bar);
            __builtin_amdgcn_fence(__ATOMIC_ACQUIRE, "agent");
            asm volatile("s_waitcnt vmcnt(0)" ::: "memory");
        }
    }
    __syncthreads();
}

typedef short bf16x8_t __attribute__((ext_vector_type(8)));
__device__ __forceinline__ f32x4 mfma16(bf16x8_t a, bf16x8_t b, f32x4 c) { return __builtin_amdgcn_mfma_f32_16x16x32_bf16(a, b, c, 0, 0, 0); }

struct GdnChunkBufs {
    bf16* W;
    bf16* QG;
    bf16* KDT;
    bf16* UT;
    bf16* QK;
    float* EGL;
};

constexpr int GP_QB = 0, GP_KB = 17408, GP_VB = 34816, GP_LS = 52224, GP_QKS = 69632, GP_WS = 78848, GP_SC = 96256;

struct ConvJob { const float* u0; const float* v0; unsigned char* tab; float* tsc; };
__device__ __forceinline__ void gdn_prep_unit(const bf16* __restrict__ PROJ, const float* __restrict__ conv_w, const float* __restrict__ a_log, const float* __restrict__ dt_bias,
                                              const GdnChunkBufs& cb, float* __restrict__ p_gdn_conv, int un, unsigned char* lds, const ConvJob& cj) {
    int tid = threadIdx.x; asm volatile("" : "+v"(tid));
    const int lane = tid & 63, wave = __builtin_amdgcn_readfirstlane(tid >> 6), fr = lane & 15, fq = lane >> 4;
    const int h = un & 3, n = (un >> 2) & 63, b = un >> 8;
    const int t0 = b * SEQ + n * 64;
    bf16* Qb = (bf16*)(lds + GP_QB); bf16* Kb = (bf16*)(lds + GP_KB); bf16* Vb = (bf16*)(lds + GP_VB); bf16* Ws = (bf16*)(lds + GP_WS);
    float* Ls = (float*)(lds + GP_LS); bf16* QKs = (bf16*)(lds + GP_QKS);
    float* gcs = (float*)(lds + GP_SC); float* bets = gcs + 64; float* egcs = gcs + 128; float* ekds = gcs + 192; float* begs = gcs + 256;
    if (wave == 0) {
        const bf16* prow = PROJ + (size_t)(t0 + lane) * ABN;
        const float a_raw = bf2f(prow[C_A + h]), b_raw = bf2f(prow[C_B + h]);
        float g = -expf(a_log[h]) * softplusf_(a_raw + dt_bias[h]);
#pragma unroll
        for (int off = 1; off < 64; off <<= 1) { const float v = __shfl_up(g, off); if (lane >= off) g += v; }
        const float glast = __shfl(g, 63);
        { const float be_ = sigmoidf_(b_raw), eg_ = expf(g); gcs[lane] = g; bets[lane] = be_; egcs[lane] = eg_; ekds[lane] = expf(glast - g); begs[lane] = be_ * eg_; }
        if (lane == 0) cb.EGL[un] = expf(glast);
    }
    {
        int cols[6]; float cw[4][6], xw[3][6];
#pragma unroll
        for (int p = 0; p < 3; ++p)
#pragma unroll
            for (int e = 0; e < 2; ++e) cols[p * 2 + e] = p * 512 + h * 128 + e * 64 + lane;
#pragma unroll
        for (int i = 0; i < 4; ++i)
#pragma unroll
            for (int c = 0; c < 6; ++c) cw[i][c] = conv_w[i * 1536 + cols[c]];
        const int i0 = wave * 8;
#pragma unroll
        for (int k = 0; k < 3; ++k) {
            const int pos = n * 64 + i0 - 3 + k;
#pragma unroll
            for (int c = 0; c < 6; ++c) xw[k][c] = pos >= 0 ? bf2f(PROJ[(size_t)(t0 + i0 - 3 + k) * ABN + cols[c]]) : 0.f;
        }
        bf16 xraw[8][6];
#pragma unroll
        for (int ii = 0; ii < 8; ++ii)
#pragma unroll
            for (int c = 0; c < 6; ++c) xraw[ii][c] = PROJ[(size_t)(t0 + i0 + ii) * ABN + cols[c]];
#pragma unroll
        for (int ii = 0; ii < 8; ++ii) {
            const int i = i0 + ii;
            float xt[6], s[6];
#pragma unroll
            for (int c = 0; c < 6; ++c) xt[c] = bf2f(xraw[ii][c]);
#pragma unroll
            for (int c = 0; c < 6; ++c) { const float y_ = cw[0][c] * xw[0][c] + cw[1][c] * xw[1][c] + cw[2][c] * xw[2][c] + cw[3][c] * xt[c]; s[c] = y_ * __frcp_rn(1.0f + __expf(-y_)); }
            const float qs = rsqrtf(wave_sum(s[0] * s[0] + s[1] * s[1]) + 1e-6f) * 0.08838834764831845f;
            const float ks = rsqrtf(wave_sum(s[2] * s[2] + s[3] * s[3]) + 1e-6f);
            Qb[i * 136 + lane] = (bf16)f2bf(s[0] * qs); Qb[i * 136 + 64 + lane] = (bf16)f2bf(s[1] * qs);
            Kb[i * 136 + lane] = (bf16)f2bf(s[2] * ks); Kb[i * 136 + 64 + lane] = (bf16)f2bf(s[3] * ks);
            Vb[i * 136 + lane] = (bf16)f2bf(s[4]);      Vb[i * 136 + 64 + lane] = (bf16)f2bf(s[5]);
            if (n == 63 && i >= 61) {
#pragma unroll
                for (int c = 0; c < 6; ++c) p_gdn_conv[((size_t)b * 3 + (i - 61)) * 1536 + cols[c]] = xt[c];
            }
#pragma unroll
            for (int c = 0; c < 6; ++c) { xw[0][c] = xw[1][c]; xw[1][c] = xw[2][c]; xw[2][c] = xt[c]; }
        }
    }
    __syncthreads();
    {
        const int mi = wave >> 1;
        bf16x8_t aK[4], aQ[4];
#pragma unroll
        for (int ks = 0; ks < 4; ++ks) { aK[ks] = *(const bf16x8_t*)(Kb + (mi * 16 + fr) * 136 + ks * 32 + 8 * fq); aQ[ks] = *(const bf16x8_t*)(Qb + (mi * 16 + fr) * 136 + ks * 32 + 8 * fq); }
#pragma unroll
        for (int nn = 0; nn < 2; ++nn) {
            const int nj = (wave & 1) * 2 + nn;
            f32x4 accK = (f32x4){0.f, 0.f, 0.f, 0.f}, accQ = accK;
#pragma unroll
            for (int ks = 0; ks < 4; ++ks) { const bf16x8_t bk = *(const bf16x8_t*)(Kb + (nj * 16 + fr) * 136 + ks * 32 + 8 * fq); accK = mfma16(aK[ks], bk, accK); accQ = mfma16(aQ[ks], bk, accQ); }
            const int j = nj * 16 + fr; const float gj = gcs[j];
#pragma unroll
            for (int r = 0; r < 4; ++r) {
                const int i = mi * 16 + 4 * fq + r;
                const float dec = i >= j ? expf(gcs[i] - gj) : 0.f;
                Ls[j * 68 + i] = i > j ? bets[i] * accK[r] * dec : 0.f;
                QKs[i * 72 + j] = (bf16)f2bf(i >= j ? accQ[r] * dec : 0.f);
            }
        }
    }
    __syncthreads();
    if (wave < 4) {
        float x[64];
        const bool isu = tid < 128; const int c = isu ? tid : tid - 128;
        const LAS unsigned char* l3 = (const LAS unsigned char*)lds;
        unsigned so = (isu ? GP_VB : GP_KB) + c * 2, ro = GP_SC + (isu ? 64 * 4 : 256 * 4), lo = GP_LS;
        asm volatile("" : "+v"(so), "+v"(ro), "+v"(lo));
#pragma unroll
        for (int i = 0; i < 64; ++i) x[i] = *(const LAS float*)(l3 + ro + 4 * i) * bf2f(*(const LAS bf16*)(l3 + so + i * 272));
#pragma unroll
        for (int j = 0; j < 63; ++j) {
#pragma unroll
            for (int i4 = (j + 1) / 4; i4 < 16; ++i4) {
                const f32x4 l4 = *(const LAS f32x4*)(l3 + lo + j * 272 + i4 * 16);
                if (i4 * 4 + 0 > j) x[i4 * 4 + 0] -= l4.x * x[j];
                if (i4 * 4 + 1 > j) x[i4 * 4 + 1] -= l4.y * x[j];
                if (i4 * 4 + 2 > j) x[i4 * 4 + 2] -= l4.z * x[j];
                if (i4 * 4 + 3 > j) x[i4 * 4 + 3] -= l4.w * x[j];
            }
        }
        if (isu) {
            bf16* dst = cb.UT + (size_t)un * 8192 + ((c >> 4) * 4 * 64 + (c & 15)) * 4;
#pragma unroll
            for (int m4 = 0; m4 < 16; ++m4) { v2u o; o.x = pk2(x[m4 * 4 + 0], x[m4 * 4 + 1]); o.y = pk2(x[m4 * 4 + 2], x[m4 * 4 + 3]); *(v2u*)(dst + ((m4 >> 2) * 64 + (m4 & 3) * 16) * 4) = o; }
        } else {
#pragma unroll
            for (int i = 0; i < 64; ++i) Ws[i * 136 + c] = (bf16)f2bf(x[i]);
        }
    } else {
        const int t2 = tid - 256;
#pragma unroll
        for (int k = 0; k < 4; ++k) {
            const int ci = t2 + 256 * k, i = ((ci >> 8) << 4) | (ci & 15), d0 = (((ci >> 6) & 3) * 4 + ((ci >> 4) & 3)) * 8; const float e = egcs[i];
            const v4u q = *(const v4u*)(Qb + i * 136 + d0);
            v4u o; o.x = pk2(bflo(q.x) * e, bfhi(q.x) * e); o.y = pk2(bflo(q.y) * e, bfhi(q.y) * e); o.z = pk2(bflo(q.z) * e, bfhi(q.z) * e); o.w = pk2(bflo(q.w) * e, bfhi(q.w) * e);
            *(v4u*)(cb.QG + (size_t)un * 8192 + ci * 8) = o;
        }
#pragma unroll
        for (int k = 0; k < 4; ++k) {
            const int ci = t2 + 256 * k, d = ((ci >> 7) << 4) | (ci & 15), i0 = (((ci >> 6) & 1) * 4 + ((ci >> 4) & 3)) * 8;
            float v[8];
#pragma unroll
            for (int q = 0; q < 8; ++q) v[q] = bf2f(Kb[(i0 + q) * 136 + d]) * ekds[i0 + q];
            v4u o; o.x = pk2(v[0], v[1]); o.y = pk2(v[2], v[3]); o.z = pk2(v[4], v[5]); o.w = pk2(v[6], v[7]);
            *(v4u*)(cb.KDT + (size_t)un * 8192 + ci * 8) = o;
        }
#pragma unroll
        for (int k = 0; k < 2; ++k) {
            const int ci = t2 + 256 * k, i = ((ci >> 7) << 4) | (ci & 15), j0 = (((ci >> 6) & 1) * 4 + ((ci >> 4) & 3)) * 8;
            *(v4u*)(cb.QK + (size_t)un * 4096 + ci * 8) = *(const v4u*)(QKs + i * 72 + j0);
        }
        { const int rb = (un & 511) * 32 + (wave - 4) * 8;
          if (un < 512) table_rows_convert<false>(cj.u0, cj.tab, cj.tsc, rb, rb + 8, 0, 1, lane);
          else table_rows_convert<true>(cj.v0, cj.tab + (size_t)16384 * D, cj.tsc + 16384, rb, rb + 8, 0, 1, lane); }
    }
    __syncthreads();
#pragma unroll
    for (int k = 0; k < 2; ++k) {
        const int ci = tid + 512 * k, i = ((ci >> 8) << 4) | (ci & 15), d0 = (((ci >> 6) & 3) * 4 + ((ci >> 4) & 3)) * 8;
        *(v4u*)(cb.W + (size_t)un * 8192 + ci * 8) = *(const v4u*)(Ws + i * 136 + d0);
    }
    __syncthreads();
}

constexpr int GS_ST = 0, GS_VNT = 2 * 32 * 136 * 2, GS_END = GS_VNT + 32 * 72 * 2;
template <int N0, int N1>
__device__ __forceinline__ void gdn_seq(const GdnChunkBufs& cb, float* __restrict__ O, float* __restrict__ Sout, int b, int h, int sl, unsigned char* lds, f32x4 (&accS)[2], int& cur) {
    int tid = threadIdx.x; asm volatile("" : "+v"(tid));
    const int lane = tid & 63, wave = __builtin_amdgcn_readfirstlane(tid >> 6), fr = lane & 15, fq = lane >> 4;
    const int mi = wave >> 1, nj = wave & 1;
    bf16* St = (bf16*)(lds + GS_ST); bf16* VnT = (bf16*)(lds + GS_VNT);
    float* egls = (float*)(lds + GS_END);
    if (N0 == 0) {
        for (int i = tid; i < 2 * 32 * 136 / 2; i += NTH) ((unsigned*)St)[i] = 0u;
        accS[0] = (f32x4){0.f, 0.f, 0.f, 0.f}; accS[1] = accS[0]; cur = 0;
    }
    if (tid >= N0 && tid < N1) egls[tid] = cb.EGL[(size_t)((b * 64 + tid) * 4 + h)];
    __syncthreads();
#define GS_DECL(X) bf16x8_t aW##X[4], aQG##X[4], aQK##X[2], aKD##X[2]; v2u ut##X;
    GS_DECL(0) GS_DECL(1) GS_DECL(2)
#define GS_GLD16(dst, ptr) asm volatile("global_load_dwordx4 %0, %1, off" : "=v"(dst) : "v"(ptr))
#define GS_GLD8(dst, ptr) asm volatile("global_load_dwordx2 %0, %1, off" : "=v"(dst) : "v"(ptr))
#define GS_LOAD(X, n_) do { const size_t u_ = (size_t)((b * 64 + ((n_) < 63 ? (n_) : 63)) * 4 + h);     \
        _Pragma("unroll") for (int ks = 0; ks < 4; ++ks) { GS_GLD16(aW##X[ks], cb.W + u_ * 8192 + ((mi * 4 + ks) * 64 + lane) * 8); GS_GLD16(aQG##X[ks], cb.QG + u_ * 8192 + ((mi * 4 + ks) * 64 + lane) * 8); } \
        _Pragma("unroll") for (int ks = 0; ks < 2; ++ks) { GS_GLD16(aQK##X[ks], cb.QK + u_ * 4096 + ((mi * 2 + ks) * 64 + lane) * 8); GS_GLD16(aKD##X[ks], cb.KDT + u_ * 8192 + ((wave * 2 + ks) * 64 + lane) * 8); } \
        GS_GLD8(ut##X, cb.UT + u_ * 8192 + (((sl * 2 + nj) * 4 + mi) * 64 + lane) * 4); } while (0)
#define GS_WAITN(X, N) asm volatile("s_waitcnt vmcnt(" #N ")" : "+v"(aW##X[0]), "+v"(aW##X[1]), "+v"(aW##X[2]), "+v"(aW##X[3]), "+v"(aQG##X[0]), "+v"(aQG##X[1]), "+v"(aQG##X[2]), "+v"(aQG##X[3]), \
        "+v"(aQK##X[0]), "+v"(aQK##X[1]), "+v"(aKD##X[0]), "+v"(aKD##X[1]), "+v"(ut##X))
#define GS_WAIT(X, n_) GS_WAITN(X, 26)
#define GS_STEP(X, n_) do { \
        const float egl##X = egls[(n_)]; \
        GS_WAIT(X, n_); \
        __syncthreads();                                        \
        f32x4 accW = (f32x4){0.f, 0.f, 0.f, 0.f}, accO = accW; \
        const bf16* Sc = St + cur * 32 * 136; \
        _Pragma("unroll") for (int ks = 0; ks < 4; ++ks) { const bf16x8_t bs = *(const bf16x8_t*)(Sc + (nj * 16 + fr) * 136 + ks * 32 + 8 * fq); accW = mfma16(aW##X[ks], bs, accW); accO = mfma16(aQG##X[ks], bs, accO); } \
          \
        const float v0 = bflo(ut##X.x) - accW[0], v1 = bfhi(ut##X.x) - accW[1], v2 = bflo(ut##X.y) - accW[2], v3 = bfhi(ut##X.y) - accW[3]; \
        { v2u o; o.x = pk2(v0, v1); o.y = pk2(v2, v3); *(v2u*)(VnT + (nj * 16 + fr) * 72 + mi * 16 + 4 * fq) = o; } \
        __syncthreads();                                        \
        _Pragma("unroll") for (int ks = 0; ks < 2; ++ks) { const bf16x8_t bv = *(const bf16x8_t*)(VnT + (nj * 16 + fr) * 72 + ks * 32 + 8 * fq); accO = mfma16(aQK##X[ks], bv, accO); } \
        { float* orow = O + (size_t)(b * SEQ + (n_) * 64 + mi * 16 + 4 * fq) * 512 + h * 128 + sl * 32 + nj * 16 + fr; \
          orow[0] = accO[0]; orow[512] = accO[1]; orow[1024] = accO[2]; orow[1536] = accO[3]; } \
          \
        bf16* Sn = St + (cur ^ 1) * 32 * 136; \
        _Pragma("unroll") for (int njj = 0; njj < 2; ++njj) { \
            accS[njj] = accS[njj] * egl##X; \
            _Pragma("unroll") for (int ks = 0; ks < 2; ++ks) { const bf16x8_t bv = *(const bf16x8_t*)(VnT + (njj * 16 + fr) * 72 + ks * 32 + 8 * fq); accS[njj] = mfma16(aKD##X[ks], bv, accS[njj]); } \
            v2u o; o.x = pk2(accS[njj][0], accS[njj][1]); o.y = pk2(accS[njj][2], accS[njj][3]); \
            *(v2u*)(Sn + (njj * 16 + fr) * 136 + wave * 16 + 4 * fq) = o; } \
        cur ^= 1; } while (0)
    constexpr int NTRI = (N1 - N0) / 3, NREM = (N1 - N0) % 3, NM = N0 + 3 * NTRI;
    GS_LOAD(0, N0); GS_LOAD(1, N0 + 1);
#pragma unroll 1
    for (int n = N0; n < NM; n += 3) {
        GS_LOAD(2, n + 2);
        GS_STEP(0, n);
        GS_LOAD(0, n + 3);
        GS_STEP(1, n + 1);
        GS_LOAD(1, n + 4);
        GS_STEP(2, n + 2);
    }
    if (NREM >= 1) { GS_LOAD(2, NM + 2); GS_STEP(0, NM); }
    if (NREM == 2) { GS_LOAD(0, NM + 3); GS_STEP(1, NM + 1); }
    GS_WAITN(0, 0); GS_WAITN(1, 0); GS_WAITN(2, 0);
#undef GS_STEP
#undef GS_DECL
#undef GS_WAIT
#undef GS_WAITN
#undef GS_GLD16
#undef GS_GLD8
    asm volatile("s_waitcnt vmcnt(0)" ::: "memory");
#undef GS_LOAD
    if (N1 == 64) {
#pragma unroll
        for (int njj = 0; njj < 2; ++njj)
#pragma unroll
            for (int r = 0; r < 4; ++r) Sout[(((size_t)b * 4 + h) * 128 + wave * 16 + 4 * fq + r) * 128 + sl * 32 + njj * 16 + fr] = accS[njj][r];
    }
    __syncthreads();
}

__device__ __forceinline__ void lru_prep_unit(const bf16* __restrict__ PROJ, const float* __restrict__ conv_w, const float* __restrict__ conv_b,
                                              const float* __restrict__ w_r, const float* __restrict__ b_r, const float* __restrict__ w_i, const float* __restrict__ b_i, const float* __restrict__ lam,
                                              float* __restrict__ H, float* __restrict__ P, float* __restrict__ Hend, float* __restrict__ Pend, float* __restrict__ p_lru_conv, int ub) {
    int c = threadIdx.x; asm volatile("" : "+v"(c));
    const int nblk = c >> 6, d = c & 63;
    const int n = ub & 63, b = ub >> 6, t0 = b * SEQ + n * 64;
    float wr[64], wi[64];
#pragma unroll
    for (int cc = 0; cc < 64; ++cc) { wr[cc] = w_r[((size_t)nblk * 64 + cc) * 64 + d]; wi[cc] = w_i[((size_t)nblk * 64 + cc) * 64 + d]; }
    const float cw0 = conv_w[c], cw1 = conv_w[512 + c], cw2 = conv_w[1024 + c], cw3 = conv_w[1536 + c], cb_ = conv_b[c];
    const float br = b_r[c], bi = b_i[c], spl = -8.0f * softplusf_(-lam[c]);
    float x0 = (n * 64 - 3 >= 0) ? bf2f(PROJ[(size_t)(t0 - 3) * ABN + C_XR + c]) : 0.f;
    float x1 = (n * 64 - 2 >= 0) ? bf2f(PROJ[(size_t)(t0 - 2) * ABN + C_XR + c]) : 0.f;
    float x2 = (n * 64 - 1 >= 0) ? bf2f(PROJ[(size_t)(t0 - 1) * ABN + C_XR + c]) : 0.f;
    float hloc = 0.f, ploc = 1.f;
    bf16 xa[16], xb[16];
#pragma unroll
    for (int k = 0; k < 16; ++k) xa[k] = PROJ[(size_t)(t0 + k) * ABN + C_XR + c];
#pragma unroll 1
    for (int ib = 0; ib < 64; ib += 16) {
      if (ib + 16 < 64) {
#pragma unroll
        for (int k = 0; k < 16; ++k) xb[k] = PROJ[(size_t)(t0 + ib + 16 + k) * ABN + C_XR + c];
      }
#pragma unroll
      for (int k = 0; k < 16; ++k) {
        const int i = ib + k;
        const float xt = bf2f(xa[k]);
        const float xr = cb_ + cw0 * x0 + cw1 * x1 + cw2 * x2 + cw3 * xt;
        f32x2_t ga = (f32x2_t){br, bi}, gb = (f32x2_t){0.f, 0.f};
#pragma unroll
        for (int cc = 0; cc < 64; cc += 2) {
            const float xa_ = __uint_as_float(__builtin_amdgcn_readlane(__float_as_uint(xr), cc)), xb_ = __uint_as_float(__builtin_amdgcn_readlane(__float_as_uint(xr), cc + 1));
            ga += (f32x2_t){xa_, xa_} * (f32x2_t){wr[cc], wi[cc]}; gb += (f32x2_t){xb_, xb_} * (f32x2_t){wr[cc + 1], wi[cc + 1]};
        }
        ga += gb;
        const float r = __frcp_rn(1.0f + __expf(-ga.x)), ii = __frcp_rn(1.0f + __expf(-ga.y));
        const float a = __expf(spl * r), bb = __fsqrt_rn(fmaxf(1.0f - a * a, 0.f)) * (ii * xr);
        hloc = a * hloc + bb; ploc *= a;
        H[(size_t)(t0 + i) * 512 + c] = hloc; P[(size_t)(t0 + i) * 512 + c] = ploc;
        if (n == 63 && i >= 61) p_lru_conv[((size_t)b * 3 + (i - 61)) * 512 + c] = xt;
        x0 = x1; x1 = x2; x2 = xt;
      }
#pragma unroll
      for (int k = 0; k < 16; ++k) xa[k] = xb[k];
    }
    Hend[(size_t)ub * 512 + c] = hloc; Pend[(size_t)ub * 512 + c] = ploc;
}
constexpr int LR_XR = 64 * 68 * 4;
__device__ __forceinline__ void lru_prep_unit2(const bf16* __restrict__ PROJ, const float* __restrict__ conv_w, const float* __restrict__ conv_b,
                                               const bf16* __restrict__ WRT, const bf16* __restrict__ WIT  , const float* __restrict__ b_r, const float* __restrict__ b_i, const float* __restrict__ lam,
                                               float* __restrict__ H, float* __restrict__ P, float* __restrict__ Hend, float* __restrict__ Pend, float* __restrict__ p_lru_conv, int ub, unsigned char* lds) {
    int tid = threadIdx.x; asm volatile("" : "+v"(tid));
    const int lane = tid & 63, wave = __builtin_amdgcn_readfirstlane(tid >> 6), fr = lane & 15, fq = lane >> 4;
    const int n = ub & 63, b = ub >> 6, t0 = b * SEQ + n * 64;
    float* XR = (float*)(lds + wave * LR_XR);
    {
        const int c = wave * 64 + lane;
        const float cw0 = conv_w[c], cw1 = conv_w[512 + c], cw2 = conv_w[1024 + c], cw3 = conv_w[1536 + c], cb_ = conv_b[c];
        float x0 = (n * 64 - 3 >= 0) ? bf2f(PROJ[(size_t)(t0 - 3) * ABN + C_XR + c]) : 0.f;
        float x1 = (n * 64 - 2 >= 0) ? bf2f(PROJ[(size_t)(t0 - 2) * ABN + C_XR + c]) : 0.f;
        float x2 = (n * 64 - 1 >= 0) ? bf2f(PROJ[(size_t)(t0 - 1) * ABN + C_XR + c]) : 0.f;
#pragma unroll 1
        for (int ib = 0; ib < 64; ib += 16) {
            bf16 xa[16];
#pragma unroll
            for (int k = 0; k < 16; ++k) xa[k] = PROJ[(size_t)(t0 + ib + k) * ABN + C_XR + c];
#pragma unroll
            for (int k = 0; k < 16; ++k) {
                const int i = ib + k; const float xt = bf2f(xa[k]);
                XR[i * 68 + lane] = cb_ + cw0 * x0 + cw1 * x1 + cw2 * x2 + cw3 * xt;
                if (n == 63 && i >= 61) p_lru_conv[((size_t)b * 3 + (i - 61)) * 512 + c] = xt;
                x0 = x1; x1 = x2; x2 = xt;
            }
        }
    }
    asm volatile("s_waitcnt lgkmcnt(0)" ::: "memory");
    bf16x8_t bR[4][2], bI[4][2];
#pragma unroll
    for (int nt = 0; nt < 4; ++nt)
#pragma unroll
        for (int ks = 0; ks < 2; ++ks) {
            bR[nt][ks] = *(const bf16x8_t*)(WRT + ((size_t)wave * 64 + nt * 16 + fr) * 64 + ks * 32 + 8 * fq);
            bI[nt][ks] = *(const bf16x8_t*)(WIT + ((size_t)wave * 64 + nt * 16 + fr) * 64 + ks * 32 + 8 * fq);
        }
    float brv[4], biv[4], splv[4];
#pragma unroll
    for (int nt = 0; nt < 4; ++nt) { const int c = wave * 64 + nt * 16 + fr; brv[nt] = b_r[c]; biv[nt] = b_i[c]; splv[nt] = -8.0f * softplusf_(-lam[c]); }
    float hin[4], pin[4];
#pragma unroll
    for (int nt = 0; nt < 4; ++nt) { hin[nt] = 0.f; pin[nt] = 1.f; }
#pragma unroll 1
    for (int mt = 0; mt < 4; ++mt) {
        bf16x8_t aX[2];
#pragma unroll
        for (int ks = 0; ks < 2; ++ks) {
            const f32x4 lo = *(const f32x4*)(XR + (mt * 16 + fr) * 68 + ks * 32 + 8 * fq), hi = *(const f32x4*)(XR + (mt * 16 + fr) * 68 + ks * 32 + 8 * fq + 4);
            v4u w; w.x = pk2(lo.x, lo.y); w.y = pk2(lo.z, lo.w); w.z = pk2(hi.x, hi.y); w.w = pk2(hi.z, hi.w);
            aX[ks] = __builtin_bit_cast(bf16x8_t, w);
        }
#pragma unroll
        for (int nt = 0; nt < 4; ++nt) {
            f32x4 aR = (f32x4){0.f, 0.f, 0.f, 0.f}, aI = aR;
            aR = mfma16(aX[0], bR[nt][0], aR); aR = mfma16(aX[1], bR[nt][1], aR);
            aI = mfma16(aX[0], bI[nt][0], aI); aI = mfma16(aX[1], bI[nt][1], aI);
            float av[4], bv[4];
#pragma unroll
            for (int r = 0; r < 4; ++r) {
                const float rg = __frcp_rn(1.0f + __expf(-(aR[r] + brv[nt]))), ig = __frcp_rn(1.0f + __expf(-(aI[r] + biv[nt])));
                const float a = __expf(splv[nt] * rg);
                av[r] = a; bv[r] = __fsqrt_rn(fmaxf(1.0f - a * a, 0.f)) * (ig * XR[(mt * 16 + 4 * fq + r) * 68 + nt * 16 + fr]);
            }
            float PA[4], PB[4];
            PA[0] = av[0]; PB[0] = bv[0];
#pragma unroll
            for (int r = 1; r < 4; ++r) { PA[r] = av[r] * PA[r - 1]; PB[r] = av[r] * PB[r - 1] + bv[r]; }
            float GA = PA[3], GB = PB[3];
            { const float pa = __shfl_up(GA, 16), pb = __shfl_up(GB, 16); if (fq >= 1) { GB = GA * pb + GB; GA = GA * pa; } }
            { const float pa = __shfl_up(GA, 32), pb = __shfl_up(GB, 32); if (fq >= 2) { GB = GA * pb + GB; GA = GA * pa; } }
            float EA = __shfl_up(GA, 16), EB = __shfl_up(GB, 16);
            if (fq == 0) { EA = 1.f; EB = 0.f; }
            const float h0 = EA * hin[nt] + EB, p0 = pin[nt] * EA;
#pragma unroll
            for (int r = 0; r < 4; ++r) {
                const size_t o = (size_t)(t0 + mt * 16 + 4 * fq + r) * 512 + wave * 64 + nt * 16 + fr;
                H[o] = PA[r] * h0 + PB[r]; P[o] = p0 * PA[r];
            }
            const float TA = __shfl(GA, 48 + fr), TB = __shfl(GB, 48 + fr);
            hin[nt] = TA * hin[nt] + TB; pin[nt] = pin[nt] * TA;
        }
    }
    if (fq == 0) {
#pragma unroll
        for (int nt = 0; nt < 4; ++nt) { Hend[(size_t)ub * 512 + wave * 64 + nt * 16 + fr] = hin[nt]; Pend[(size_t)ub * 512 + wave * 64 + nt * 16 + fr] = pin[nt]; }
    }
    asm volatile("s_waitcnt lgkmcnt(0)" ::: "memory");
}
__device__ __forceinline__ void lru_carry(const float* __restrict__ Hend, const float* __restrict__ Pend, float* __restrict__ CIN, float* __restrict__ hlast, int bx) {
    int tx_ = threadIdx.x; asm volatile("" : "+v"(tx_));
    const int idx = bx * NTH + tx_, b = idx >> 9, c = idx & 511;
    float carry = 0.f;
#pragma unroll 8
    for (int n = 0; n < 64; ++n) {
        const size_t o = ((size_t)b * 64 + n) * 512 + c;
        CIN[o] = carry;
        carry = Hend[o] + Pend[o] * carry;
    }
    hlast[(size_t)b * 512 + c] = carry;
}

__device__ __forceinline__ unsigned f2key(float f) { const unsigned u = __float_as_uint(f); return u ^ ((u >> 31) ? 0xffffffffu : 0x80000000u); }
__device__ __forceinline__ float key2f(unsigned k) { return __uint_as_float(k ^ ((k >> 31) ? 0x80000000u : 0xffffffffu)); }
#define TK_CE(hi, lo) do { const unsigned a_ = (hi), b_ = (lo); (hi) = a_ > b_ ? a_ : b_; (lo) = a_ > b_ ? b_ : a_; } while (0)
template <int N> __device__ __forceinline__ void bitonic_sort_desc(unsigned (&a)[N]) {
#pragma unroll
    for (int k = 2; k <= N; k <<= 1)
#pragma unroll
        for (int j = k >> 1; j > 0; j >>= 1)
#pragma unroll
            for (int i = 0; i < N; ++i) { const int l = i ^ j; if (l > i) { if ((i & k) == 0) TK_CE(a[i], a[l]); else TK_CE(a[l], a[i]); } }
}
template <int XM> __device__ __forceinline__ void merge_top16(unsigned (&a)[16]) {
    unsigned c[16];
#pragma unroll
    for (int i = 0; i < 16; ++i) {
        unsigned o;
        if (XM == 1) o = (unsigned)__builtin_amdgcn_update_dpp(0, (int)a[15 - i], 0xB1, 0xf, 0xf, false);
        else if (XM == 2) o = (unsigned)__builtin_amdgcn_update_dpp(0, (int)a[15 - i], 0x4E, 0xf, 0xf, false);
        else if (XM == 16) o = __builtin_amdgcn_permlane16_swap(a[15 - i], a[15 - i], false, false)[1];
        else o = __builtin_amdgcn_permlane32_swap(a[15 - i], a[15 - i], false, false)[1];
        c[i] = a[i] > o ? a[i] : o; }
#pragma unroll
    for (int j = 8; j > 0; j >>= 1)
#pragma unroll
        for (int i = 0; i < 16; ++i) { const int l = i ^ j; if (l > i) TK_CE(c[i], c[l]); }
#pragma unroll
    for (int i = 0; i < 16; ++i) a[i] = c[i];
}
constexpr int TK_KS = 0, TK_TS = 2 * 128 * 136 * 2, TK_END = TK_TS + 64 * 2 * 16 * 4;
__device__ __forceinline__ void peer_topk_stage_keys(const bf16* __restrict__ KB, int h, unsigned char* lds) {
    bf16* Ks = (bf16*)(lds + TK_KS);
    for (int ci = threadIdx.x; ci < 2 * 128 * 16; ci += NTH) { const int row = ci >> 4, part = ci & 15;
        *(v4u*)(Ks + row * 136 + part * 8) = *(const v4u*)(KB + ((size_t)h * 256 + row) * 128 + part * 8); }
    __syncthreads();
}
__device__ __forceinline__ void peer_topk_ldq(bf16x8_t (&bq)[4], const bf16* __restrict__ Q, int tile, int h, int tid) {
    const int lane = tid & 63, wave = tid >> 6, fr = lane & 15, fq = lane >> 4, c = wave >> 2, nt = wave & 3;
#pragma unroll
    for (int ks = 0; ks < 4; ++ks) bq[ks] = *(const bf16x8_t*)(Q + (size_t)(tile * 64 + nt * 16 + fr) * 2048 + h * 256 + c * 128 + ks * 32 + 8 * fq);
}
__device__ __forceinline__ void peer_topk4(const bf16* __restrict__ Q, int* __restrict__ EXP, float* __restrict__ GATE, int tile, int h, unsigned char* lds, bf16x8_t (&bq)[4], int tile_next) {
    int tid = threadIdx.x; asm volatile("" : "+v"(tid));
    const int lane = tid & 63, wave = __builtin_amdgcn_readfirstlane(tid >> 6), fr = lane & 15, fq = lane >> 4;
    const bf16* Ks = (const bf16*)(lds + TK_KS); unsigned* Ts = (unsigned*)(lds + TK_TS);
    {
        const int c = wave >> 2, nt = wave & 3;
        unsigned a[32];
#pragma unroll
        for (int mt = 0; mt < 8; ++mt) {
            f32x4 acc = (f32x4){0.f, 0.f, 0.f, 0.f};
#pragma unroll
            for (int ks = 0; ks < 4; ++ks) { const bf16x8_t ak = *(const bf16x8_t*)(Ks + (c * 128 + mt * 16 + fr) * 136 + ks * 32 + 8 * fq); acc = mfma16(ak, bq[ks], acc); }
#pragma unroll
            for (int r = 0; r < 4; ++r) a[mt * 4 + r] = (f2key(acc[r]) & ~127u) | (unsigned)(127 - (mt * 16 + 4 * fq + r));
        }
        if (tile_next >= 0) peer_topk_ldq(bq, Q, tile_next, h, tid);
        bitonic_sort_desc<32>(a);
        unsigned t[16];
#pragma unroll
        for (int j = 0; j < 16; ++j) t[j] = a[j];
        merge_top16<16>(t); merge_top16<32>(t);
        if (fq == 0) {
            const int tk = nt * 16 + fr;
#pragma unroll
            for (int j = 0; j < 16; ++j) Ts[(tk * 2 + c) * 16 + j] = t[j];
        }
    }
    __syncthreads();
    if (tid < 256) {
        const int tk = tid >> 2, q = tid & 3;
        const unsigned* t0 = Ts + (tk * 2 + 0) * 16; const unsigned* t1 = Ts + (tk * 2 + 1) * 16;
        unsigned a[16];
#pragma unroll
        for (int s = 0; s < 13; ++s) {
            const int e = s * 4 + q;
            int i, j;
            if (e < 16) { i = 0; j = e; } else if (e < 24) { i = 1; j = e - 16; } else if (e < 29) { i = 2; j = e - 24; } else if (e < 33) { i = 3; j = e - 29; }
            else if (e < 36) { i = 4; j = e - 33; } else if (e < 42) { i = 5 + ((e - 36) >> 1); j = (e - 36) & 1; } else { i = 8 + (e - 42); j = 0; }
            const bool ok = e < 50;
            const float sum = key2f(t0[ok ? i : 0] & ~127u) + key2f(t1[ok ? j : 0] & ~127u);
            a[s] = ok ? ((f2key(sum) & ~255u) | (unsigned)(255 - (i * 16 + j))) : 0u;
        }
        a[13] = 0u; a[14] = 0u; a[15] = 0u;
        bitonic_sort_desc<16>(a);
        merge_top16<1>(a); merge_top16<2>(a);
        float ev[16], sum = 0.f; const float m = key2f(a[0] & ~255u);
#pragma unroll
        for (int j = 0; j < 16; ++j) { ev[j] = __expf(key2f(a[j] & ~255u) - m); sum += ev[j]; }
        const float inv = 1.0f / sum;
        const size_t o = (size_t)(tile * 64 + tk) * 128 + h * 16;
#pragma unroll
        for (int j = 0; j < 16; ++j)
            if ((j >> 2) == q) {
                const int code = 255 - (int)(a[j] & 255u), i = code >> 4, jj = code & 15;
                const int n0 = 127 - (int)(t0[i] & 127u), n1 = 127 - (int)(t1[jj] & 127u);
                EXP[o + j] = n0 * 128 + n1; GATE[o + j] = ev[j] * inv;
            }
    }
    __syncthreads();
}

constexpr int AT_KS = 0, AT_VT = 192 * 72 * 2, AT_BT = AT_VT + 64 * 200 * 2, AT_PW = AT_BT + 4 * 256 * 4, AT_END = AT_PW + 8 * 32 * 72 * 2;
template <int QS>
__device__ __forceinline__ void attn_core(const bf16* __restrict__ PCb, const float* __restrict__ sinks, bf16* __restrict__ ATT, int kvh, int q0, int tb, int wave, int lane, int fr, int fq,
                                          const bf16* Ks, const bf16* Vt, const float* Bt, bf16* Pw) {
    constexpr int NT0 = QS ? 2 : 0;
    const int g = wave >> 1, hh = kvh * 4 + g; constexpr int qs = QS;
    bf16x8_t aQ[2][2];
#pragma unroll
    for (int mt = 0; mt < 2; ++mt)
#pragma unroll
        for (int ks = 0; ks < 2; ++ks) aQ[mt][ks] = *(const bf16x8_t*)(PCb + (size_t)(tb + q0 + qs + mt * 16 + fr) * CN + hh * 64 + ks * 32 + 8 * fq);
    f32x4 sc[2][12];
#pragma unroll
    for (int nt = NT0; nt < NT0 + 10; ++nt) {
        const bf16x8_t b0 = *(const bf16x8_t*)(Ks + (nt * 16 + fr) * 72 + 8 * fq), b1 = *(const bf16x8_t*)(Ks + (nt * 16 + fr) * 72 + 32 + 8 * fq);
#pragma unroll
        for (int mt = 0; mt < 2; ++mt) { f32x4 a = (f32x4){0.f, 0.f, 0.f, 0.f}; a = mfma16(aQ[mt][0], b0, a); a = mfma16(aQ[mt][1], b1, a); sc[mt][nt] = a; }
    }
    const float sink = sinks[hh] * 1.4426950408889634f;
    const float* bt = Bt + g * 256 + 64;
    float rinv[2][4];
    float kadd[12];
#pragma unroll
    for (int nt = NT0; nt < NT0 + 10; ++nt) kadd[nt] = (q0 - 128 + nt * 16 + fr) >= 0 ? 0.f : -INFINITY;
#pragma unroll
    for (int mt = 0; mt < 2; ++mt)
#pragma unroll
        for (int r = 0; r < 4; ++r) {
            const int qi = qs + mt * 16 + 4 * fq + r;
            float mx = sink;
#pragma unroll
            for (int nt = NT0; nt < NT0 + 10; ++nt) {
                const int kk = nt * 16 + fr, rel = qi + 128 - kk;
                const float lg = (sc[mt][nt][r] * (0.125f * 1.4426950408889634f) + bt[rel]) + kadd[nt];
                sc[mt][nt][r] = lg; mx = fmaxf(mx, lg);
            }
            mx = fmaxf(mx, DPPF(mx, 0xB1, 0xf)); mx = fmaxf(mx, DPPF(mx, 0x4E, 0xf)); mx = fmaxf(mx, DPPF(mx, 0x141, 0xf)); mx = fmaxf(mx, DPPF(mx, 0x140, 0xf));
            float sum = 0.f;
#pragma unroll
            for (int nt = NT0; nt < NT0 + 10; ++nt) { const float p = __builtin_amdgcn_exp2f(sc[mt][nt][r] - mx); sc[mt][nt][r] = p; sum += p; }
            sum += DPPF(sum, 0xB1, 0xf); sum += DPPF(sum, 0x4E, 0xf); sum += DPPF(sum, 0x141, 0xf); sum += DPPF(sum, 0x140, 0xf);
            rinv[mt][r] = 1.0f / (sum + __builtin_amdgcn_exp2f(sink - mx));
        }
    f32x4 oacc[2][4];
#pragma unroll
    for (int mt = 0; mt < 2; ++mt)
#pragma unroll
        for (int dt = 0; dt < 4; ++dt) oacc[mt][dt] = (f32x4){0.f, 0.f, 0.f, 0.f};
#pragma unroll
    for (int kc = 0; kc < 3; ++kc) {
#pragma unroll
        for (int mt = 0; mt < 2; ++mt)
#pragma unroll
            for (int n4 = 0; n4 < 4; ++n4)
#pragma unroll
                for (int r = 0; r < 4; ++r) if (kc * 4 + n4 >= NT0 && kc * 4 + n4 < NT0 + 10) Pw[(mt * 16 + 4 * fq + r) * 72 + n4 * 16 + fr] = (bf16)f2bf(sc[mt][kc * 4 + n4][r]);
        asm volatile("s_waitcnt lgkmcnt(0)" ::: "memory");
#pragma unroll
        for (int ks = 0; ks < 2; ++ks) {
            if (kc * 4 + ks * 2 < NT0 || kc * 4 + ks * 2 >= NT0 + 10) continue;
            const bf16x8_t p0 = *(const bf16x8_t*)(Pw + fr * 72 + ks * 32 + 8 * fq), p1 = *(const bf16x8_t*)(Pw + (16 + fr) * 72 + ks * 32 + 8 * fq);
#pragma unroll
            for (int dt = 0; dt < 4; ++dt) {
                const bf16x8_t bv = *(const bf16x8_t*)(Vt + (dt * 16 + fr) * 200 + kc * 64 + ks * 32 + 8 * fq);
                oacc[0][dt] = mfma16(p0, bv, oacc[0][dt]); oacc[1][dt] = mfma16(p1, bv, oacc[1][dt]);
            }
        }
        asm volatile("s_waitcnt lgkmcnt(0)" ::: "memory");
    }
#pragma unroll
    for (int mt = 0; mt < 2; ++mt)
#pragma unroll
        for (int dt = 0; dt < 4; ++dt)
#pragma unroll
            for (int r = 0; r < 4; ++r) Pw[(mt * 16 + 4 * fq + r) * 72 + dt * 16 + fr] = (bf16)f2bf(oacc[mt][dt][r] * rinv[mt][r]);
    asm volatile("s_waitcnt lgkmcnt(0)" ::: "memory");
#pragma unroll
    for (int k = 0; k < 4; ++k) {
        const int ci = lane + 64 * k, row = ci >> 3, part = ci & 7;
        *(v4u*)(ATT + (size_t)(tb + q0 + qs + row) * D + hh * 64 + part * 8) = *(const v4u*)(Pw + row * 72 + part * 8);
    }
}
__device__ __forceinline__ void attn_unit(const bf16* __restrict__ PCb, const float* __restrict__ rel_bias, const float* __restrict__ sinks, bf16* __restrict__ ATT, int un, unsigned char* lds) {
    int tid = threadIdx.x; asm volatile("" : "+v"(tid));
    const int lane = tid & 63, wave = __builtin_amdgcn_readfirstlane(tid >> 6), fr = lane & 15, fq = lane >> 4;
    const int kvh = un & 3, qblk = (un >> 2) & 63, b = un >> 8;
    const int q0 = qblk * 64, tb = b * SEQ;
    bf16* Ks = (bf16*)(lds + AT_KS); bf16* Vt = (bf16*)(lds + AT_VT); float* Bt = (float*)(lds + AT_BT); bf16* Pw = (bf16*)(lds + AT_PW) + wave * 32 * 72;
#pragma unroll
    for (int k = 0; k < 3; ++k) {
        const int ci = tid + 512 * k, row = ci >> 3, part = ci & 7, kpos = q0 - 128 + row;
        v4u kv = (v4u){0u, 0u, 0u, 0u}, vv = kv;
        if (kpos >= 0) { const bf16* src = PCb + (size_t)(tb + kpos) * CN + kvh * 64 + part * 8; kv = *(const v4u*)(src + 1024); vv = *(const v4u*)(src + 1280); }
        *(v4u*)(Ks + row * 72 + part * 8) = kv;
        bf16* vd = Vt + (part * 8) * 200 + row;
        vd[0 * 200] = (bf16)(vv.x & 0xffffu); vd[1 * 200] = (bf16)(vv.x >> 16); vd[2 * 200] = (bf16)(vv.y & 0xffffu); vd[3 * 200] = (bf16)(vv.y >> 16);
        vd[4 * 200] = (bf16)(vv.z & 0xffffu); vd[5 * 200] = (bf16)(vv.z >> 16); vd[6 * 200] = (bf16)(vv.w & 0xffffu); vd[7 * 200] = (bf16)(vv.w >> 16);
    }
#pragma unroll
    for (int k = 0; k < 2; ++k) { const int idx = tid + 512 * k, g_ = idx >> 8, rel = (idx & 255) - 64;
        Bt[idx] = (rel >= 0 && rel < 128) ? rel_bias[t5_bucket(rel) * 16 + kvh * 4 + g_] * 1.4426950408889634f : -INFINITY; }
    __syncthreads();
    if (wave & 1) attn_core<32>(PCb, sinks, ATT, kvh, q0, tb, wave, lane, fr, fq, Ks, Vt, Bt, Pw);
    else attn_core<0>(PCb, sinks, ATT, kvh, q0, tb, wave, lane, fr, fq, Ks, Vt, Bt, Pw);
    __syncthreads();
}

__device__ __forceinline__ void swa_attn_sample(const bf16* __restrict__ PCb, const float* __restrict__ cache_k, const float* __restrict__ cache_v,
                                                const float* __restrict__ rel_bias, const float* __restrict__ sinks, bf16* __restrict__ ATT, int gw, int lane) {
    const int sb = gw >> 4, h = gw & 15, kvh = h >> 2, t = NP + sb;
    const bf16* qrow = PCb + (size_t)t * CN + h * 64;
    float lg[2];
#pragma unroll
    for (int rr = 0; rr < 2; ++rr) {
        const int r = lane + 64 * rr;
        float dot = 0.f;
        if (r == 0) {
            const bf16* krow = PCb + (size_t)t * CN + 1024 + kvh * 64;
            for (int d = 0; d < 64; ++d) dot += bf2f(qrow[d]) * bf2f(krow[d]);
        } else {
            const float* krow = cache_k + (((size_t)sb * 128 + (128 - r)) * 4 + kvh) * 64;
#pragma unroll
            for (int d4 = 0; d4 < 16; ++d4) { const float4 kv = *(const float4*)(krow + d4 * 4);
                dot += bf2f(qrow[d4 * 4]) * kv.x + bf2f(qrow[d4 * 4 + 1]) * kv.y + bf2f(qrow[d4 * 4 + 2]) * kv.z + bf2f(qrow[d4 * 4 + 3]) * kv.w; }
        }
        lg[rr] = dot * 0.125f + rel_bias[t5_bucket(r) * 16 + h];
    }
    const float sink = sinks[h];
    const float m = fmaxf(wave_max(fmaxf(lg[0], lg[1])), sink);
    float p[2] = {expf(lg[0] - m), expf(lg[1] - m)};
    const float inv = 1.0f / (wave_sum(p[0] + p[1]) + expf(sink - m));
    float o = 0.f;
#pragma unroll
    for (int rr = 0; rr < 2; ++rr)
#pragma unroll 1
        for (int lb = 0; lb < 64; lb += 16) {
            float vv[16];
#pragma unroll
            for (int k = 0; k < 16; ++k) { const int r = lb + k + 64 * rr;
                vv[k] = (r == 0) ? bf2f(PCb[(size_t)t * CN + 1280 + kvh * 64 + lane]) : cache_v[(((size_t)sb * 128 + (128 - r)) * 4 + kvh) * 64 + lane]; }
#pragma unroll
            for (int k = 0; k < 16; ++k) o += __shfl(p[rr], lb + k) * vv[k];
        }
    ATT[(size_t)t * D + h * 64 + lane] = (bf16)f2bf(o * inv);
}
__device__ __forceinline__ void swa_kv_out3(const bf16* __restrict__ PCb, const float* __restrict__ cache_k, const float* __restrict__ cache_v,
                                            float* __restrict__ pk, float* __restrict__ pv, float* __restrict__ sk, float* __restrict__ sv, int item) {
    int tid = threadIdx.x; asm volatile("" : "+v"(tid));
    if (item < 256) {
        const int sb = item >> 1, isv = item & 1;
        const f32x4* src = (const f32x4*)((isv ? cache_v : cache_k) + ((size_t)sb * 128 + 1) * 256);
        f32x4* dst = (f32x4*)((isv ? sv : sk) + (size_t)sb * 128 * 256);
#pragma unroll 4
        for (int i = tid; i < 127 * 64; i += NTH) dst[i] = src[i];
        if (tid < 32) {
            const v4u w = *(const v4u*)(PCb + (size_t)(NP + sb) * CN + 1024 + isv * 256 + tid * 8);
            f32x4* d = dst + 127 * 64 + tid * 2;
            d[0] = (f32x4){bflo(w.x), bfhi(w.x), bflo(w.y), bfhi(w.y)}; d[1] = (f32x4){bflo(w.z), bfhi(w.z), bflo(w.w), bfhi(w.w)};
        }
    } else {
        const int b = item - 256;
#pragma unroll 4
        for (int e = tid; e < 128 * 64; e += NTH) {
            const int row = e >> 6, part = e & 63;
            const v4u w = *(const v4u*)(PCb + (size_t)(b * SEQ + SEQ - 128 + row) * CN + 1024 + part * 8);
            f32x4* d = (f32x4*)((part < 32 ? pk : pv) + ((size_t)b * 128 + row) * 256 + (part & 31) * 8);
            d[0] = (f32x4){bflo(w.x), bfhi(w.x), bflo(w.y), bfhi(w.y)}; d[1] = (f32x4){bflo(w.z), bfhi(w.z), bflo(w.w), bfhi(w.w)};
        }
    }
}


constexpr int PC_STRIDE = 1040, PC_RED = 80 * PC_STRIDE;
template <class StoreF>
__device__ __forceinline__ void gemm_piece80(const bf16* __restrict__ arows, const bf16* __restrict__ brows, unsigned char* lds, const StoreF& store) {
    int tid = threadIdx.x; asm volatile("" : "+v"(tid));
    const int lane = tid & 63, wave = __builtin_amdgcn_readfirstlane(tid >> 6), fr = lane & 15, fq = lane >> 4;
    const int rsel = tid >> 6, ch = tid & 63, nt = wave & 3, kq = wave >> 2;
    v4u st[2][10];
#pragma unroll
    for (int h = 0; h < 2; ++h)
#pragma unroll
        for (int r = 0; r < 10; ++r) {
            const bf16* src = (r < 2 ? arows + (size_t)(r * 8 + rsel) * D : brows + (size_t)(r * 8 + rsel - 16) * D) + h * 512 + ch * 8;
            st[h][r] = *(const v4u*)src;
        }
    f32x4 acc = (f32x4){0.f, 0.f, 0.f, 0.f};
#pragma unroll
    for (int h = 0; h < 2; ++h) {
        if (h) __syncthreads();
#pragma unroll
        for (int r = 0; r < 10; ++r) *(v4u*)(lds + (r * 8 + rsel) * PC_STRIDE + ch * 16) = st[h][r];
        __syncthreads();
#pragma unroll
        for (int ks = 0; ks < 8; ++ks) {
            const bf16x8_t a = *(const bf16x8_t*)(lds + fr * PC_STRIDE + (kq * 256 + ks * 32 + 8 * fq) * 2);
            const bf16x8_t b = *(const bf16x8_t*)(lds + (16 + nt * 16 + fr) * PC_STRIDE + (kq * 256 + ks * 32 + 8 * fq) * 2);
            acc = mfma16(a, b, acc);
        }
    }
    f32x4* part = (f32x4*)(lds + PC_RED);
    if (kq == 1) part[nt * 64 + lane] = acc;
    __syncthreads();
    if (kq == 0) { acc = acc + part[nt * 64 + lane]; store(acc, nt, fr, fq); }
}
__device__ __forceinline__ void sample_gemm_piece(const bf16* __restrict__ A, const bf16* __restrict__ Bt, const float* __restrict__ bias, bf16* __restrict__ O, int ldc, int p, unsigned char* lds) {
    const int mt = p & 7, cb = p >> 3;
    gemm_piece80(A + (size_t)(NP + mt * 16) * D, Bt + (size_t)(cb * 64) * D, lds, [&](const f32x4& acc, int nt, int fr, int fq) {
        const int col = cb * 64 + nt * 16 + fr; const float bv = bias ? bias[col] : 0.f;
#pragma unroll
        for (int r = 0; r < 4; ++r) O[(size_t)(NP + mt * 16 + 4 * fq + r) * ldc + col] = (bf16)f2bf(acc[r] + bv);
    });
}
__device__ __forceinline__ void ab_cols_piece(const bf16* __restrict__ A, const bf16* __restrict__ Bt, bf16* __restrict__ O, int tg, unsigned char* lds) {
    gemm_piece80(Bt + (size_t)ABMAIN * D, A + (size_t)(tg * 64) * D, lds, [&](const f32x4& acc, int nt, int fr, int fq) {
        if (fq < 2) { uint2 o; o.x = pk2(acc[0], acc[1]); o.y = pk2(acc[2], acc[3]); *(uint2*)(O + (size_t)(tg * 64 + nt * 16 + fr) * ABN + ABMAIN + 4 * fq) = o; }
    });
}

constexpr size_t MiB = 1u << 20;
constexpr size_t WS_CTL = 0, CTL_ZERO_BYTES = 64 * 1024;
constexpr size_t WS_WAB = 1 * MiB;
constexpr size_t WS_WOUT = WS_WAB + (size_t)ABNP * D * 2;
constexpr size_t WS_WQ0 = WS_WOUT + (size_t)D * D * 2;
constexpr size_t WS_WQ1 = WS_WQ0 + (size_t)2048 * D * 2;
constexpr size_t WS_WINC = WS_WQ1 + (size_t)2048 * D * 2;
constexpr size_t WS_WOUTC = WS_WINC + (size_t)CN * D * 2;
constexpr size_t WS_ABUF = WS_WOUTC + (size_t)D * D * 2;
constexpr size_t WS_P = WS_ABUF + (size_t)MP * D * 2;
constexpr size_t WS_T = WS_P + (size_t)MP * ABN * 2;
constexpr size_t WS_Q = WS_T + (size_t)4 * 16384 * D + (size_t)4 * 16384 * 4;
constexpr size_t WS_A = WS_Q + (size_t)MP * 1536 * 4;
constexpr size_t WS_B = WS_A + (size_t)MP * 512 * 4;
constexpr size_t WS_O = WS_B + (size_t)MP * 512 * 4;
constexpr size_t WS_X1 = WS_O + (size_t)MP * 512 * 4;
constexpr size_t WS_G = WS_X1 + (size_t)MP * D * 4;
constexpr size_t WS_BETA = WS_G + (size_t)MP * 4 * 4;
constexpr size_t WS_GATE = WS_BETA + (size_t)MP * 4 * 4;
constexpr size_t WS_EXP = WS_GATE + (size_t)MP * 128 * 4;
constexpr size_t WS_HEND = WS_EXP + (size_t)MP * 128 * 4;
constexpr size_t WS_KEYS = WS_HEND + (size_t)3 * 4 * 64 * 512 * 4;
constexpr size_t WS_WGT = WS_KEYS + (size_t)2 * 8 * 2 * 128 * 128 * 2;
constexpr size_t WS_END = WS_WGT + (size_t)2 * 8 * 64 * 64 * 2;
constexpr size_t Q_QKVS = 0, Q_W = 1 * MiB, Q_QG = Q_W + 16 * MiB, Q_KDT = Q_QG + 16 * MiB, Q_UT = Q_KDT + 16 * MiB, Q_QK = Q_UT + 16 * MiB, Q_EGL = Q_QK + 8 * MiB, Q_END = Q_EGL + 4096;
static_assert(Q_END <= (size_t)MP * 1536 * 4, "region Q");
static_assert(WS_END <= 512 * MiB, "d_ws map");

struct MegaArgs {
    const float* in[35];
    float* out;
    unsigned char* ws;
};

__global__ void __launch_bounds__(NTH, 2) fwd_megakernel(MegaArgs ma) {
    cg::grid_group grid = cg::this_grid();
    extern __shared__ __attribute__((aligned(16))) unsigned char lds[];
    float* smem = (float*)lds;
    const int nb = gridDim.x, b0 = blockIdx.x, wave = __builtin_amdgcn_readfirstlane(threadIdx.x >> 6);
    int tid = threadIdx.x, lane = tid & 63;
    const float* x_prompt = ma.in[0];
    const float* x_sample = ma.in[1];
    const float* state_gdn = ma.in[2];
    const float* state_gdn_conv = ma.in[3];
    const float* state_lru = ma.in[4];
    const float* state_lru_conv = ma.in[5];
    const float* cache_k = ma.in[6];
    const float* cache_v = ma.in[7];
    const float* w_in_ab = ma.in[8];
    const float* gdn_conv_w = ma.in[9];
    const float* gdn_a_log = ma.in[10];
    const float* gdn_dt_bias = ma.in[11];
    const float* gdn_norm_w = ma.in[12];
    const float* lru_conv_w = ma.in[13];
    const float* lru_conv_b = ma.in[14];
    const float* lru_w_r = ma.in[15];
    const float* lru_b_r = ma.in[16];
    const float* lru_w_i = ma.in[17];
    const float* lru_b_i = ma.in[18];
    const float* lru_lam = ma.in[19];
    const float* w_out_ab = ma.in[20];
    const float* w_in_c = ma.in[21];
    const float* b_in_c = ma.in[22];
    const float* swa_sinks = ma.in[23];
    const float* w_out_c = ma.in[24];
    const float* b_out_c = ma.in[25];
    const float* rel_bias = ma.in[26];
    const float* ln_mix_g = ma.in[27];
    const float* ln_mix_b = ma.in[28];
    const float* ln_ffn_g = ma.in[29];
    const float* ln_ffn_b = ma.in[30];
    const float* peer_w_q = ma.in[31];
    const float* peer_keys = ma.in[32];
    const float* peer_u = ma.in[33];
    const float* peer_v = ma.in[34];

    float* out = ma.out;
    float* o_y = out;
    float* o_p_gdn = out + (size_t)NT * D;
    float* o_p_gdn_conv = o_p_gdn + 262144;
    float* o_p_lru = o_p_gdn_conv + 18432;
    float* o_p_lru_conv = o_p_lru + 2048;
    float* o_p_k = o_p_lru_conv + 6144;
    float* o_p_v = o_p_k + 131072;
    float* o_s_gdn = o_p_v + 131072;
    float* o_s_gdn_conv = o_s_gdn + 8388608;
    float* o_s_lru = o_s_gdn_conv + 589824;
    float* o_s_lru_conv = o_s_lru + 65536;
    float* o_s_k = o_s_lru_conv + 196608;
    float* o_s_v = o_s_k + 4194304;

    unsigned char* ws = ma.ws;
    bf16* WAB_T = (bf16*)(ws + WS_WAB); bf16* WOUT_T = (bf16*)(ws + WS_WOUT); bf16* WQ0_T = (bf16*)(ws + WS_WQ0); bf16* WQ1_T = (bf16*)(ws + WS_WQ1);
    bf16* WINC_T = (bf16*)(ws + WS_WINC); bf16* WOUTC_T = (bf16*)(ws + WS_WOUTC);
    bf16* ABUF = (bf16*)(ws + WS_ABUF);
    bf16* PROJ = (bf16*)(ws + WS_P); float* Y = (float*)(ws + WS_P); bf16* Qb = (bf16*)(ws + WS_P); bf16* PCb = (bf16*)(ws + WS_P); float* Y1 = (float*)(ws + WS_P);
    unsigned char* TAB8 = ws + WS_T; float* TSC = (float*)(ws + WS_T + (size_t)4 * 16384 * D);
    float* R_Q = (float*)(ws + WS_Q + Q_QKVS) - (size_t)NP * 1536; float* X2 = (float*)(ws + WS_A);
    GdnChunkBufs cbuf; cbuf.W = (bf16*)(ws + WS_Q + Q_W); cbuf.QG = (bf16*)(ws + WS_Q + Q_QG); cbuf.KDT = (bf16*)(ws + WS_Q + Q_KDT); cbuf.UT = (bf16*)(ws + WS_Q + Q_UT); cbuf.QK = (bf16*)(ws + WS_Q + Q_QK); cbuf.EGL = (float*)(ws + WS_Q + Q_EGL);
    bf16* Yb = (bf16*)(ws + WS_P);
    float* OUTS = (float*)(ws + WS_Q);
    float* PD = (float*)(ws + WS_P);
    bf16* KEYSB = (bf16*)(ws + WS_KEYS); bf16* WRT = (bf16*)(ws + WS_WGT); bf16* WIT = WRT + 8 * 64 * 64;
    float* HEND = (float*)(ws + WS_HEND); float* PEND = HEND + 4 * 64 * 512; float* CIN = PEND + 4 * 64 * 512;
    float* R_A = (float*)(ws + WS_A); float* R_B = (float*)(ws + WS_B); float* R_O = (float*)(ws + WS_O);
    bf16* ATTB = (bf16*)(ws + WS_X1);
    float* R_G = (float*)(ws + WS_G); float* R_BETA = (float*)(ws + WS_BETA); float* R_GATE = (float*)(ws + WS_GATE); int* R_EXP = (int*)(ws + WS_EXP);

    for (int u = tid; u < (LDS_BYTES - RING_BYTES) / 4; u += NTH) ((unsigned*)(lds + RING_BYTES))[u] = 0u;
    __syncthreads();
    XcdBarrier bar = xcd_barrier_post((unsigned*)(ws + WS_CTL), (volatile LAS unsigned*)((LAS unsigned char*)lds + MISC_OFF) + 8);
#define GRID_BAR() do { xcd_barrier(bar); asm volatile("" : "+v"(tid)); lane = tid & 63; } while (0)
#define PHASE_LOOP(n) for (int vb = b0; vb < (n); vb += nb)
#define PHASE_END __syncthreads()
#define GEMM_PHASE_M(Mrows, EPI, Aptr, Btptr, Nn, ...) do { pg8::Gemm g_{(const pg8::bf16_t*)(Aptr), (const pg8::bf16_t*)(Btptr), (Mrows), (Nn), D}; pg8::StaticOrder S_; S_.init((Mrows), (Nn), nb, b0); \
        pg8::EPI E_{__VA_ARGS__}; pg8::gemm_phase<pg8::EPI, pg8::StaticOrder, true, true>((PG8_LAS unsigned char*)lds, g_, S_, E_); } while (0)
#define GEMM_PHASE(EPI, Aptr, Btptr, Nn, ...) GEMM_PHASE_M(MP, EPI, Aptr, Btptr, Nn, __VA_ARGS__)
#define GEMM_PHASE_SPLIT(Aptr, Btptr, Nn, Optr, biasptr) do { GEMM_PHASE_M(NP, EpiStoreBf16, Aptr, Btptr, Nn, Optr, Nn, biasptr, NP, Nn); \
          \
        for (int j_ = b0 >> 3; (b0 & 7) + 8 * (j_ >> 3) < (Nn) / 64; j_ += nb >> 3) sample_gemm_piece(Aptr, Btptr, biasptr, Optr, Nn, (j_ & 7) | (((b0 & 7) + 8 * (j_ >> 3)) << 3), lds); } while (0)

    {
        float* scr = smem + wave * 4096;
        const int gw = b0 * NWAVES + wave, NGW = nb * NWAVES;
        constexpr int I_AB = 16 * 97, I_OUT = 16 * 32, I_Q = 16 * 64, I_INC = 16 * 48;
        constexpr int NITEMS = I_AB + I_OUT + 2 * I_Q + I_INC + I_OUT;
        for (int it = gw; it < I_AB; it += NGW) p0_transpose_item<true>(w_in_ab, D, ABN, WAB_T, scr, it, lane);
        for (int it = b0 * NTH + tid; it < 2 * 8 * 64 * 8; it += nb * NTH) {
            const int gsel = it >> 12, nn = (it >> 9) & 7, dd = (it >> 3) & 63, c8 = (it & 7) * 8;
            const float* wsrc = (gsel ? lru_w_i : lru_w_r) + ((size_t)nn * 64 + c8) * 64 + dd;
            v4u o; o.x = pk2(wsrc[0], wsrc[64]); o.y = pk2(wsrc[128], wsrc[192]); o.z = pk2(wsrc[256], wsrc[320]); o.w = pk2(wsrc[384], wsrc[448]);
            *(v4u*)((gsel ? WIT : WRT) + ((size_t)nn * 64 + dd) * 64 + c8) = o;
        }
        for (int kb = 0; kb < NP / 2048; kb += 4) {
            f32x4 v4_[4][4];
#pragma unroll
            for (int i = 0; i < 4; ++i)
#pragma unroll
                for (int j = 0; j < 4; ++j) v4_[i][j] = ((const f32x4*)(x_prompt + (size_t)(gw + (kb + i) * 2048) * D))[lane + 64 * j];
#pragma unroll
            for (int i = 0; i < 4; ++i)
#pragma unroll
                for (int j = 0; j < 4; ++j) { v2u o; o.x = pk2(v4_[i][j].x, v4_[i][j].y); o.y = pk2(v4_[i][j].z, v4_[i][j].w); ((v2u*)(ABUF + (size_t)(gw + (kb + i) * 2048) * D))[lane + 64 * j] = o; }
        }
        for (int m = NP + gw; m < MP + (ABNP - 97 * 32); m += NGW) {
            if (m < MP) row_to_bf16(m < NP ? x_prompt + (size_t)m * D : (m < NT ? x_sample + (size_t)(m - NP) * D : nullptr), ABUF + (size_t)m * D, lane);
            else row_to_bf16(nullptr, WAB_T + (size_t)(97 * 32 + (m - MP)) * D, lane);
        }
    }
    GRID_BAR();
    if (ma.out == nullptr) grid.sync();
    GEMM_PHASE(EpiStoreBf16, ABUF, WAB_T, ABNP, PROJ, ABN, nullptr, NT, ABN);
    GRID_BAR();
    ConvJob cjob; cjob.u0 = peer_u; cjob.v0 = peer_v; cjob.tab = TAB8; cjob.tsc = TSC;
    constexpr int NSPLIT = 32, A_LRU = 4 * NSPLIT, A_GDN = 16 * NSPLIT, B_LRU = 4 * (64 - NSPLIT), B_GDN = 16 * (64 - NSPLIT);
    { AbPrepArgs pa;
      pa.PROJ = PROJ; pa.st_gdn_conv = state_gdn_conv; pa.st_lru_conv = state_lru_conv;
      pa.gdn_conv_w = gdn_conv_w; pa.a_log = gdn_a_log; pa.dt_bias = gdn_dt_bias;
      pa.lru_conv_w = lru_conv_w; pa.lru_conv_b = lru_conv_b; pa.w_r = lru_w_r; pa.b_r = lru_b_r; pa.w_i = lru_w_i; pa.b_i = lru_b_i; pa.lam = lru_lam;
      pa.QKV = R_Q; pa.G = R_G; pa.BETA = R_BETA; pa.LA = R_A; pa.LB = R_B;
      pa.p_gdn_conv = o_p_gdn_conv; pa.p_lru_conv = o_p_lru_conv; pa.s_gdn_conv = o_s_gdn_conv; pa.s_lru_conv = o_s_lru_conv;
      for (int v = b0; v < A_LRU + NS + A_GDN; v += nb) {
          if (v < A_LRU) { lru_prep_unit2(PROJ, lru_conv_w, lru_conv_b, WRT, WIT, lru_b_r, lru_b_i, lru_lam, R_B, R_A, HEND, PEND, o_p_lru_conv, (v / NSPLIT) * 64 + (v % NSPLIT), lds); PHASE_END; }
          else if (v < A_LRU + NS) { ab_prep(pa, NP + (v - A_LRU), smem); PHASE_END; }
          else { const int i = v - A_LRU - NS, h_ = i & 3, n_ = (i >> 2) % NSPLIT, b_ = (i >> 2) / NSPLIT;
                 gdn_prep_unit(PROJ, gdn_conv_w, gdn_a_log, gdn_dt_bias, cbuf, o_p_gdn_conv, (b_ * 64 + n_) * 4 + h_, lds, cjob); }
      } }
    GRID_BAR();
    f32x4 seqS[2]; int seqcur = 0;
    const int seq_p = (b0 & 7) + 8 * (b0 >> 5), seq_s = (b0 >> 3) & 3;
    if (b0 < 64) {
        gdn_seq<0, NSPLIT>(cbuf, R_O, o_p_gdn, seq_p >> 2, seq_p & 3, seq_s, lds, seqS, seqcur);
        table_rows_convert<false>(peer_u + (size_t)16384 * D, TAB8 + (size_t)2 * 16384 * D, TSC + 2 * 16384, 0, 16384, b0 * NWAVES + wave, 64 * NWAVES, lane);
    }
    else for (int v = b0 - 64; v < B_LRU + B_GDN; v += nb - 64) {
        if (v < B_LRU) { lru_prep_unit2(PROJ, lru_conv_w, lru_conv_b, WRT, WIT, lru_b_r, lru_b_i, lru_lam, R_B, R_A, HEND, PEND, o_p_lru_conv, (v / (64 - NSPLIT)) * 64 + NSPLIT + (v % (64 - NSPLIT)), lds); PHASE_END; }
        else { const int i = v - B_LRU, h_ = i & 3, n_ = NSPLIT + (i >> 2) % (64 - NSPLIT), b_ = (i >> 2) / (64 - NSPLIT);
               gdn_prep_unit(PROJ, gdn_conv_w, gdn_a_log, gdn_dt_bias, cbuf, o_p_gdn_conv, (b_ * 64 + n_) * 4 + h_, lds, cjob); }
    }
    GRID_BAR();
    if (b0 < 64) gdn_seq<NSPLIT, 64>(cbuf, R_O, o_p_gdn, seq_p >> 2, seq_p & 3, seq_s, lds, seqS, seqcur);
    else if (b0 < 68) lru_carry(HEND, PEND, CIN, o_p_lru, b0 - 64);
    else {
        for (int v = (b0 - 68) * NWAVES + wave; v < NS * 4 * 8; v += (nb - 68) * NWAVES) gdn_step_sample_w(R_Q, R_G, R_BETA, state_gdn, R_O, o_s_gdn, v, lane);
        for (int v = b0 - 68; v < 128; v += nb - 68) lru_scan(R_A, R_B, state_lru, o_s_lru, NP, 1, NS, v);
        const int gw2 = (b0 - 68) * NWAVES + wave, NGW2 = (nb - 68) * NWAVES;
        for (int m = gw2; m < 512; m += NGW2) row_to_bf16(peer_keys + (size_t)m * D, KEYSB + (size_t)m * D, lane);
        {
            constexpr int I_OUT = 16 * 32, I_Q = 16 * 64, I_INC = 16 * 48;
            float* scr = smem + wave * 4096;
            for (int it = gw2; it < I_OUT + 2 * I_Q + I_INC + I_OUT; it += NGW2) {
                int r = it;
                if (r < I_OUT) { p0_transpose_item(w_out_ab, D, D, WOUT_T, scr, r, lane); continue; } r -= I_OUT;
                if (r < I_Q) { p0_transpose_item(peer_w_q, D, 2048, WQ0_T, scr, r, lane); continue; } r -= I_Q;
                if (r < I_Q) { p0_transpose_item(peer_w_q + (size_t)D * 2048, D, 2048, WQ1_T, scr, r, lane); continue; } r -= I_Q;
                if (r < I_INC) { p0_transpose_item(w_in_c, D, CN, WINC_T, scr, r, lane); continue; } r -= I_INC;
                p0_transpose_item(w_out_c, D, D, WOUTC_T, scr, r, lane);
            }
        }
        table_rows_convert<true>(peer_v + (size_t)16384 * D, TAB8 + (size_t)3 * 16384 * D, TSC + 3 * 16384, 0, 16384, gw2, NGW2, lane);
    }
    GRID_BAR();
    PHASE_LOOP(NT / 8) { ab_mix_w(PROJ, R_O, R_B, R_A, CIN, gdn_norm_w, ABUF, vb * 8 + wave, lane); }
    GRID_BAR();
    GEMM_PHASE_SPLIT(ABUF, WOUT_T, D, Yb, (const float*)nullptr);
    GRID_BAR();
    PHASE_LOOP(NT / 8) { const int t = vb * 8 + wave;
        ln_res_w<false>(t < NP ? x_prompt + (size_t)t * D : x_sample + (size_t)(t - NP) * D, Yb + (size_t)t * D, ln_mix_g, ln_mix_b, ABUF + (size_t)t * D, lane); }
    GRID_BAR();
    GEMM_PHASE_SPLIT(ABUF, WQ0_T, 2048, Qb, (const float*)nullptr);
    GRID_BAR();
    { bf16x8_t tq_[4]; if (b0 < (NT / 64) * 8) peer_topk_ldq(tq_, Qb, b0 >> 3, b0 & 7, tid);
      if ((nb & 7) == 0) { peer_topk_stage_keys(KEYSB, b0 & 7, lds); PHASE_LOOP((NT / 64) * 8) { peer_topk4(Qb, R_EXP, R_GATE, vb >> 3, vb & 7, lds, tq_, vb + nb < (NT / 64) * 8 ? (vb + nb) >> 3 : -1); } }
      else PHASE_LOOP((NT / 64) * 8) { peer_topk_stage_keys(KEYSB, vb & 7, lds); peer_topk_ldq(tq_, Qb, vb >> 3, vb & 7, tid); peer_topk4(Qb, R_EXP, R_GATE, vb >> 3, vb & 7, lds, tq_, -1); } }
    GRID_BAR();
    asm volatile("" : "+v"(tid)); lane = tid & 63;
    { const int x = b0 & 7, tg0 = b0 >> 3, tgstep = nb >> 3, nit = (NT / 8 - tg0 + tgstep - 1) / tgstep;
      peer_u_loop(ABUF, R_EXP, TAB8 + (size_t)x * 16384 * 128, PD + (size_t)x * NT * 128, x, tg0, tgstep, nit, wave, lane); }
    GRID_BAR();
    PHASE_LOOP(NT / 8) { const int t = vb * 8 + wave; peer_xk(R_EXP + (size_t)t * 128, R_GATE + (size_t)t * 128, PD + (size_t)t * 128, TSC, TSC + 16384, lane); }
    GRID_BAR();
    { const int x = b0 & 7, tg0 = b0 >> 3, tgstep = nb >> 3, nit = (NT / 8 - tg0 + tgstep - 1) / tgstep;
      peer_v_loop(R_EXP, R_GATE, TAB8 + (size_t)16384 * D + (size_t)x * 16384 * 128, OUTS, x, tg0, tgstep, nit, wave, lane); }
    GRID_BAR();
    PHASE_LOOP(NT / 8) { const int t = vb * 8 + wave; peer_xc(ABUF + (size_t)t * D, OUTS + (size_t)t * D, ln_ffn_g, ln_ffn_b, nullptr, ABUF + (size_t)t * D, nullptr, lane); }
    GRID_BAR();

    GEMM_PHASE(EpiStoreBf16, ABUF, WINC_T, CN, PCb, CN, b_in_c, NT, CN);
    GRID_BAR();
    PHASE_LOOP(1024 + 256 + 260) {
        if (vb < 1024) attn_unit(PCb, rel_bias, swa_sinks, ATTB, vb, lds);
        else if (vb < 1280) swa_attn_sample(PCb, cache_k, cache_v, rel_bias, swa_sinks, ATTB, (vb - 1024) * 8 + wave, lane);
        else swa_kv_out3(PCb, cache_k, cache_v, o_p_k, o_p_v, o_s_k, o_s_v, vb - 1280);
    }
    GRID_BAR();
    GEMM_PHASE_SPLIT(ATTB, WOUTC_T, D, Yb, b_out_c);
    GRID_BAR();
    PHASE_LOOP(NT / 8) { const int t = vb * 8 + wave;
        ln_res_w<true>(ABUF + (size_t)t * D, Yb + (size_t)t * D, ln_mix_g + D, ln_mix_b + D, ABUF + (size_t)t * D, lane); }
    GRID_BAR();
    GEMM_PHASE_SPLIT(ABUF, WQ1_T, 2048, Qb, (const float*)nullptr);
    GRID_BAR();
    { bf16x8_t tq_[4]; if (b0 < (NT / 64) * 8) peer_topk_ldq(tq_, Qb, b0 >> 3, b0 & 7, tid);
      if ((nb & 7) == 0) { peer_topk_stage_keys(KEYSB + (size_t)8 * 2 * 128 * 128, b0 & 7, lds); PHASE_LOOP((NT / 64) * 8) { peer_topk4(Qb, R_EXP, R_GATE, vb >> 3, vb & 7, lds, tq_, vb + nb < (NT / 64) * 8 ? (vb + nb) >> 3 : -1); } }
      else PHASE_LOOP((NT / 64) * 8) { peer_topk_stage_keys(KEYSB + (size_t)8 * 2 * 128 * 128, vb & 7, lds); peer_topk_ldq(tq_, Qb, vb >> 3, vb & 7, tid); peer_topk4(Qb, R_EXP, R_GATE, vb >> 3, vb & 7, lds, tq_, -1); } }
    GRID_BAR();
    asm volatile("" : "+v"(tid)); lane = tid & 63;
    { const int x = b0 & 7, tg0 = b0 >> 3, tgstep = nb >> 3, nit = (NT / 8 - tg0 + tgstep - 1) / tgstep;
      peer_u_loop(ABUF, R_EXP, TAB8 + (size_t)2 * 16384 * D + (size_t)x * 16384 * 128, PD + (size_t)x * NT * 128, x, tg0, tgstep, nit, wave, lane); }
    GRID_BAR();
    PHASE_LOOP(NT / 8) { const int t = vb * 8 + wave; peer_xk(R_EXP + (size_t)t * 128, R_GATE + (size_t)t * 128, PD + (size_t)t * 128, TSC + 2 * 16384, TSC + 3 * 16384, lane); }
    GRID_BAR();
    { const int x = b0 & 7, tg0 = b0 >> 3, tgstep = nb >> 3, nit = (NT / 8 - tg0 + tgstep - 1) / tgstep;
      peer_v_loop(R_EXP, R_GATE, TAB8 + (size_t)3 * 16384 * D + (size_t)x * 16384 * 128, OUTS, x, tg0, tgstep, nit, wave, lane); }
    GRID_BAR();
    PHASE_LOOP(NT / 8) { const int t = vb * 8 + wave; peer_xc(ABUF + (size_t)t * D, OUTS + (size_t)t * D, ln_ffn_g + D, ln_ffn_b + D, o_y + (size_t)t * D, nullptr, nullptr, lane); }
}
}

extern "C" void kernel_launch(void* const* d_in, const int* in_sizes, int n_in,
                              void* d_out, int out_size, void* d_ws, size_t ws_size,
                              hipStream_t stream) {
    static int grid_blocks = 0;
    if (!grid_blocks) {
        int dev = 0, cus = 0, per_cu = 0;
        (void)hipGetDevice(&dev);
        (void)hipDeviceGetAttribute(&cus, hipDeviceAttributeMultiprocessorCount, dev);
        if (hipFuncSetAttribute((const void*)fwd_megakernel, hipFuncAttributeMaxDynamicSharedMemorySize, LDS_BYTES) != hipSuccess) { fprintf(stderr, "hipFuncSetAttribute failed\n"); grid_blocks = -1; return; }
        (void)hipOccupancyMaxActiveBlocksPerMultiprocessor(&per_cu, (const void*)fwd_megakernel, NTH, LDS_BYTES);
        if (per_cu < 1) { fprintf(stderr, "occupancy query says %d blocks per CU\n", per_cu); grid_blocks = -1; return; }
        if (cus * per_cu < 256) { fprintf(stderr, "this kernel needs 256 co-resident workgroups (device reports %d CUs x %d)\n", cus, per_cu); grid_blocks = -1; return; }
        grid_blocks = 256;
    }
    if (grid_blocks < 0) return;
    (void)hipMemsetAsync((char*)d_ws + WS_CTL, 0, CTL_ZERO_BYTES, stream);
    MegaArgs ma{};
    for (int i = 0; i < 35; ++i) ma.in[i] = (const float*)d_in[i];
    ma.out = (float*)d_out;
    ma.ws = (unsigned char*)d_ws;
    void* args[] = {&ma};
    hipError_t e = hipLaunchCooperativeKernel((void*)fwd_megakernel, dim3(grid_blocks), dim3(NTH), args, LDS_BYTES, stream);
    if (e != hipSuccess) fprintf(stderr, "cooperative launch failed: %s (grid %d)\n", hipGetErrorString(e), grid_blocks);
}
```

```cpp
#include <hip/hip_runtime.h>
#include <hip/hip_cooperative_groups.h>
#include <cstdio>
#include <cstdint>
namespace cg = cooperative_groups;

namespace pg8 {
#define PG8_LAS __attribute__((address_space(3)))
typedef unsigned short bf16_t;
typedef short bf16x8 __attribute__((ext_vector_type(8)));
typedef float f32x4 __attribute__((ext_vector_type(4)));
typedef unsigned u32x4 __attribute__((ext_vector_type(4)));
constexpr int BM = 256, BK = 64, HALF = 128, HTB = HALF * BK * 2  , STAGE_BYTES = 8 * HTB, NXCD = 8, WGM = 8;

__host__ __device__ __forceinline__ int lds_byte(int r, int c) { const int st = (r >> 4) * 2 + (c >> 5), rr = r & 15, cc = c & 31, ob = rr * 64 + cc * 2; return st * 1024 + (ob ^ (((ob >> 9) & 1) << 5)); }
__host__ __device__ __forceinline__ void stage_rc(int b, int& R, int& C) { const int st = b / 1024, sb = b % 1024, swz = sb ^ (((sb >> 9) & 1) << 5); R = (st >> 1) * 16 + swz / 64; C = (st & 1) * 32 + (swz % 64) / 2; }
__host__ __device__ __forceinline__ int perm32(int rho) { const int n = rho >> 4, i = rho & 15; return 8 * (i >> 2) + 4 * n + (i & 3); }

struct Unit { int pm, pn; };
struct Gemm { const bf16_t* A; const bf16_t* Bt; int M, N, K; };

struct StaticOrder {
    int nM, nN, nwg, G, c;
    __host__ __device__ void init(int M, int N, int G_, int c_) { nM = M / BM; nN = N / BM; nwg = nM * nN; G = G_; c = c_; }
    __host__ __device__ bool next(int i, Unit& u) const {
        const long L = (long)i * G + c; if (L >= nwg) return false;
        int wgid = (int)L; { const int q = nwg / NXCD, r = nwg % NXCD, xcd = wgid % NXCD, off = wgid / NXCD; wgid = (xcd < r ? xcd * (q + 1) : r * (q + 1) + (xcd - r) * q) + off; }
        const int nig = WGM * nN, gid = wgid / nig, fm = gid * WGM, gsz = (nM - fm) < WGM ? (nM - fm) : WGM;
        u.pm = fm + ((wgid % nig) % gsz); u.pn = (wgid % nig) / gsz; return true;
    }
    __device__ __forceinline__ void a_ready(const Unit&) const {}
    __device__ __forceinline__ void done(const Unit&) const {}
};

__device__ __forceinline__ unsigned cvt_pk_bf16(float lo, float hi) { unsigned r; asm volatile("v_cvt_pk_bf16_f32 %0, %1, %2" : "=v"(r) : "v"(lo), "v"(hi)); return r; }
template <class Epi, class Sched, bool ALIGN_EPI = false, bool SP2 = false>
__device__ __forceinline__ void gemm_phase(PG8_LAS unsigned char* lds, const Gemm g, const Sched& S, const Epi& E) {
    int tid_ = threadIdx.x; asm volatile("" : "+v"(tid_));
    const int tid = tid_, wid = __builtin_amdgcn_readfirstlane(tid >> 6), lane = tid & 63, wr = wid >> 2, wc = wid & 3, fr = lane & 15, fq = lane >> 4;
    const int K = g.K, nt = K / BK;
    unsigned voffA[2], voffB[2];
#pragma unroll
    for (int i = 0; i < 2; ++i) { int R, C; stage_rc(tid * 16 + i * 8192, R, C); const int Rb = Epi::PERM ? ((R & ~31) + perm32(R & 31)) : R;
        voffA[i] = (unsigned)(R * K + C) * 2u; voffB[i] = (unsigned)(Rb * K + C) * 2u; }
    const size_t kstep = (size_t)(BK * 2);
    const size_t hstep = (size_t)HALF * K * 2;
    const size_t tstep = 2 * hstep;
    const unsigned ldsw = (unsigned)wid * 1024u;
    const int aoff = lds_byte(wr * 64 + fr, fq * 8), boff = lds_byte(wc * 32 + fr, fq * 8);
#define PG8_SA(b, h) (((b) * 2 + (h)) * HTB)
#define PG8_SB(b, h) ((4 + (b) * 2 + (h)) * HTB)
#define PG8_STAGE(bufoff, gbase, voff) do { _Pragma("unroll") for (int _i = 0; _i < 2; ++_i) \
        __builtin_amdgcn_global_load_lds((const unsigned*)((const char*)(gbase) + (voff)[_i]), (PG8_LAS unsigned*)(lds + (bufoff) + ldsw + _i * 8192), 16, 0, 0); } while (0)
#define PG8_LDA(dst, b, h) do { _Pragma("unroll") for (int m = 0; m < 4; ++m) _Pragma("unroll") for (int k = 0; k < 2; ++k) dst[m][k] = *(const PG8_LAS bf16x8*)(lds + PG8_SA(b, h) + aoff + m * 2048 + k * 1024); } while (0)
#define PG8_LDB(dst, b, h) do { _Pragma("unroll") for (int n = 0; n < 2; ++n) _Pragma("unroll") for (int k = 0; k < 2; ++k) dst[n][k] = *(const PG8_LAS bf16x8*)(lds + PG8_SB(b, h) + boff + n * 2048 + k * 1024); } while (0)
#define PG8_MMA(ai, bj, At, Bt) do { __builtin_amdgcn_s_setprio(1); _Pragma("unroll") for (int m = 0; m < 4; ++m) _Pragma("unroll") for (int n = 0; n < 2; ++n) _Pragma("unroll") for (int k = 0; k < 2; ++k) \
        acc[ai][bj][m][n] = __builtin_amdgcn_mfma_f32_16x16x32_bf16(Bt[n][k], At[m][k], acc[ai][bj][m][n], 0, 0, 0); __builtin_amdgcn_s_setprio(0); } while (0)
#define PG8_WAIT_V(n) asm volatile("s_waitcnt vmcnt(" #n ")" ::: "memory")
#define PG8_WAIT_L(n) asm volatile("s_waitcnt lgkmcnt(" #n ")" ::: "memory")
#define PG8_BAR __builtin_amdgcn_s_barrier()
#define PG8_SCHED __builtin_amdgcn_sched_barrier(0)
    Unit cur, nxt; int ui = 0;
    if (!S.next(0, cur)) return;
    f32x4 acc[2][2][4][2];
#pragma unroll
    for (int a = 0; a < 2; ++a)
#pragma unroll
        for (int b = 0; b < 2; ++b)
#pragma unroll
            for (int m = 0; m < 4; ++m)
#pragma unroll
                for (int n = 0; n < 2; ++n) acc[a][b][m][n] = (f32x4){0.f, 0.f, 0.f, 0.f};
    bf16x8 At[4][2], B0[2][2], B1[2][2];
    const char* cA = (const char*)g.A + (size_t)cur.pm * tstep; const char* cB = (const char*)g.Bt + (size_t)cur.pn * tstep;
    S.a_ready(cur);
    if constexpr (SP2) {
        PG8_STAGE(PG8_SB(0, 0), cB, voffB); PG8_STAGE(PG8_SB(0, 1), cB + hstep, voffB); PG8_STAGE(PG8_SA(0, 0), cA, voffA); PG8_STAGE(PG8_SA(0, 1), cA + hstep, voffA);
        if (wr == 1) PG8_BAR;
        PG8_WAIT_V(2); PG8_BAR;
        PG8_STAGE(PG8_SB(1, 0), cB + kstep, voffB); PG8_STAGE(PG8_SA(1, 0), cA + kstep, voffA); PG8_STAGE(PG8_SB(1, 1), cB + hstep + kstep, voffB);
        PG8_WAIT_V(6); PG8_BAR;
    } else {
        PG8_STAGE(PG8_SB(0, 0), cB, voffB); PG8_STAGE(PG8_SA(0, 0), cA, voffA); PG8_STAGE(PG8_SB(0, 1), cB + hstep, voffB); PG8_STAGE(PG8_SA(0, 1), cA + hstep, voffA);
        if (wr == 1) PG8_BAR;
        PG8_WAIT_V(4); PG8_BAR;
        PG8_STAGE(PG8_SB(1, 0), cB + kstep, voffB); PG8_STAGE(PG8_SA(1, 0), cA + kstep, voffA); PG8_STAGE(PG8_SB(1, 1), cB + hstep + kstep, voffB);
        PG8_WAIT_V(6); PG8_BAR;
    }
    for (;;) {
        const bool has_next = S.next(ui + 1, nxt);
        const char* nA = has_next ? (const char*)g.A + (size_t)nxt.pm * tstep : cA; const char* nB = has_next ? (const char*)g.Bt + (size_t)nxt.pn * tstep : cB;
        for (int t = 0; t < nt; t += 2) {
            const bool last = (t == nt - 2);
            const char* a1 = cA + (size_t)(t + 1) * kstep;
            const char* a2 = last ? nA : cA + (size_t)(t + 2) * kstep; const char* b2 = last ? nB : cB + (size_t)(t + 2) * kstep;
            const char* a3 = a2 + kstep; const char* b3 = b2 + kstep;
            if (last && has_next) S.a_ready(nxt);
            if constexpr (SP2) {
            PG8_LDB(B0, 0, 0); PG8_LDB(B1, 0, 1); PG8_SCHED; PG8_LDA(At, 0, 0); PG8_STAGE(PG8_SA(1, 1), a1 + hstep, voffA);
            PG8_WAIT_V(8); PG8_WAIT_L(0); PG8_BAR; PG8_MMA(0, 0, At, B0); PG8_MMA(0, 1, At, B1); PG8_BAR; PG8_SCHED;
            PG8_LDA(At, 0, 1); PG8_STAGE(PG8_SB(0, 0), b2, voffB); PG8_STAGE(PG8_SB(0, 1), b2 + hstep, voffB); PG8_STAGE(PG8_SA(0, 0), a2, voffA);
            PG8_WAIT_V(8); PG8_WAIT_L(0); PG8_BAR; PG8_MMA(1, 0, At, B0); PG8_MMA(1, 1, At, B1); PG8_BAR; PG8_SCHED;
            PG8_LDB(B0, 1, 0); PG8_LDB(B1, 1, 1); PG8_SCHED; PG8_LDA(At, 1, 0); PG8_STAGE(PG8_SA(0, 1), a2 + hstep, voffA);
            PG8_WAIT_V(8); PG8_WAIT_L(0); PG8_BAR; PG8_MMA(0, 0, At, B0); PG8_MMA(0, 1, At, B1); PG8_BAR; PG8_SCHED;
            PG8_LDA(At, 1, 1); PG8_STAGE(PG8_SB(1, 0), b3, voffB); PG8_STAGE(PG8_SB(1, 1), b3 + hstep, voffB); PG8_STAGE(PG8_SA(1, 0), a3, voffA);
            PG8_WAIT_V(8); PG8_WAIT_L(0); PG8_BAR; PG8_MMA(1, 0, At, B0); PG8_MMA(1, 1, At, B1); PG8_BAR; PG8_SCHED;
            } else {
            PG8_LDB(B0, 0, 0); PG8_SCHED; PG8_LDA(At, 0, 0); PG8_STAGE(PG8_SA(1, 1), a1 + hstep, voffA);
            PG8_WAIT_L(8); PG8_BAR; PG8_WAIT_L(0); PG8_MMA(0, 0, At, B0); PG8_BAR; PG8_SCHED;
            PG8_LDB(B1, 0, 1); PG8_STAGE(PG8_SB(0, 0), b2, voffB);
            PG8_BAR; PG8_WAIT_L(0); PG8_MMA(0, 1, At, B1); PG8_BAR;
            PG8_LDA(At, 0, 1); PG8_STAGE(PG8_SA(0, 0), a2, voffA);
            PG8_BAR; PG8_WAIT_L(0); PG8_MMA(1, 0, At, B0); PG8_BAR; PG8_SCHED;
            PG8_STAGE(PG8_SB(0, 1), b2 + hstep, voffB);
            PG8_WAIT_V(6); PG8_BAR; PG8_MMA(1, 1, At, B1); PG8_BAR;
            PG8_LDB(B0, 1, 0); PG8_SCHED; PG8_LDA(At, 1, 0); PG8_STAGE(PG8_SA(0, 1), a2 + hstep, voffA);
            PG8_WAIT_L(8); PG8_BAR; PG8_WAIT_L(0); PG8_MMA(0, 0, At, B0); PG8_BAR; PG8_SCHED;
            PG8_LDB(B1, 1, 1); PG8_STAGE(PG8_SB(1, 0), b3, voffB);
            PG8_BAR; PG8_WAIT_L(0); PG8_MMA(0, 1, At, B1); PG8_BAR;
            PG8_LDA(At, 1, 1); PG8_STAGE(PG8_SA(1, 0), a3, voffA);
            PG8_BAR; PG8_WAIT_L(0); PG8_MMA(1, 0, At, B0); PG8_BAR; PG8_SCHED;
            PG8_STAGE(PG8_SB(1, 1), b3 + hstep, voffB);
            PG8_WAIT_V(6); PG8_BAR; PG8_MMA(1, 1, At, B1); PG8_BAR;
            }
        }
        if constexpr (ALIGN_EPI) { if (wr == 0) PG8_BAR; }
        if constexpr (!Epi::AFTER_DRAIN) { E(acc, cur, wr, wc, fr, fq); S.done(cur); }
        if (!has_next) break;
#pragma unroll
        for (int a = 0; a < 2; ++a)
#pragma unroll
            for (int b = 0; b < 2; ++b)
#pragma unroll
                for (int m = 0; m < 4; ++m)
#pragma unroll
                    for (int n = 0; n < 2; ++n) acc[a][b][m][n] = (f32x4){0.f, 0.f, 0.f, 0.f};
        cur = nxt; cA = nA; cB = nB; ++ui;
        if constexpr (ALIGN_EPI) { if (wr == 1) PG8_BAR; }
    }
    PG8_WAIT_V(0);
    if constexpr (!ALIGN_EPI) { if (wr == 0) PG8_BAR; }
    PG8_BAR;
    if constexpr (Epi::AFTER_DRAIN) { E.fused(acc, cur, wr, wc, fr, fq, lds, wid, lane); S.done(cur); }
#undef PG8_SA
#undef PG8_SB
#undef PG8_STAGE
#undef PG8_LDA
#undef PG8_LDB
#undef PG8_MMA
#undef PG8_WAIT_V
#undef PG8_WAIT_L
#undef PG8_BAR
#undef PG8_SCHED
}
}
namespace pg8 {
struct EpiStoreBf16 {
    static constexpr bool PERM = true, AFTER_DRAIN = false;
    bf16_t* O; int ldc; const float* bias; int m_real, n_real;
    __device__ __forceinline__ void operator()(const f32x4 (&acc)[2][2][4][2], const Unit& u, int wr, int wc, int fr, int fq) const {
        const int row0 = u.pm * BM + wr * 64 + fr, col0 = u.pn * BM + wc * 32 + 8 * fq;
#pragma unroll
        for (int bj = 0; bj < 2; ++bj) {
            const int col = col0 + bj * HALF;
            if (col >= n_real) continue;
            f32x4 b0 = (f32x4){0.f, 0.f, 0.f, 0.f}, b1 = b0;
            if (bias) { b0 = *(const f32x4*)(bias + col); b1 = *(const f32x4*)(bias + col + 4); }
#pragma unroll
            for (int ai = 0; ai < 2; ++ai)
#pragma unroll
                for (int m = 0; m < 4; ++m) {
                    const int row = row0 + ai * HALF + m * 16;
                    if (row >= m_real) continue;
                    const f32x4 v0 = acc[ai][bj][m][0] + b0, v1 = acc[ai][bj][m][1] + b1;
                    u32x4 w; w.x = cvt_pk_bf16(v0[0], v0[1]); w.y = cvt_pk_bf16(v0[2], v0[3]); w.z = cvt_pk_bf16(v1[0], v1[1]); w.w = cvt_pk_bf16(v1[2], v1[3]);
                    *(u32x4*)(O + (size_t)row * ldc + col) = w;
                }
        }
    }
};
struct EpiStoreF32 {
    static constexpr bool PERM = false, AFTER_DRAIN = false;
    float* O; int ldc; const float* bias; int m_real, n_real;
    __device__ __forceinline__ void operator()(const f32x4 (&acc)[2][2][4][2], const Unit& u, int wr, int wc, int fr, int fq) const {
        const int row0 = u.pm * BM + wr * 64 + fr, col0 = u.pn * BM + wc * 32 + 4 * fq;
#pragma unroll
        for (int bj = 0; bj < 2; ++bj)
#pragma unroll
            for (int n = 0; n < 2; ++n) {
                const int col = col0 + bj * HALF + n * 16;
                if (col >= n_real) continue;
                const f32x4 bv = bias ? *(const f32x4*)(bias + col) : (f32x4){0.f, 0.f, 0.f, 0.f};
#pragma unroll
                for (int ai = 0; ai < 2; ++ai)
#pragma unroll
                    for (int m = 0; m < 4; ++m) {
                        const int row = row0 + ai * HALF + m * 16;
                        if (row >= m_real) continue;
                        *(f32x4*)(O + (size_t)row * ldc + col) = acc[ai][bj][m][n] + bv;
                    }
            }
    }
};
}
namespace {
#define GAS __attribute__((address_space(1)))
#define LAS __attribute__((address_space(3)))
typedef unsigned short bf16;
typedef float f32x4 __attribute__((ext_vector_type(4)));
typedef unsigned v4u __attribute__((ext_vector_type(4)));
typedef unsigned v2u __attribute__((ext_vector_type(2)));

constexpr int D = 1024, NB = 4, SEQ = 4096, NP = NB * SEQ, NS = 128, NT = NP + NS, MP = 16640;
constexpr int ABN = 3080, ABNP = 3328;
constexpr int C_QKV = 0, C_Z = 1536, C_XR = 2048, C_GATE = 2560, C_A = 3072, C_B = 3076;
constexpr int ABMAIN = 3072;
constexpr int CN = 1536;
constexpr float ALPHA = 1.4142135623730951f;
constexpr float LN_EPS = 1e-5f;
constexpr int NTH = 512, NWAVES = 8;
constexpr int RING_BYTES = 143360, MISC_OFF = RING_BYTES + 320, LDS_BYTES = 147456;

__device__ __forceinline__ float bf2f(bf16 v) { return __uint_as_float((unsigned)v << 16); }
__device__ __forceinline__ float bflo(unsigned w) { return __uint_as_float(w << 16); }
__device__ __forceinline__ float bfhi(unsigned w) { return __uint_as_float(w & 0xffff0000u); }
typedef float f32x2c_t __attribute__((ext_vector_type(2)));
typedef __bf16 bf16x2c_t __attribute__((ext_vector_type(2)));
__device__ __forceinline__ unsigned f2bf(float f) { return (unsigned)__builtin_bit_cast(unsigned short, (__bf16)f); }
__device__ __forceinline__ unsigned pk2(float lo, float hi) { return __builtin_bit_cast(unsigned, __builtin_convertvector((f32x2c_t){lo, hi}, bf16x2c_t)); }
__device__ __forceinline__ float sigmoidf_(float x) { return 1.0f / (1.0f + expf(-x)); }
__device__ __forceinline__ float softplusf_(float x) { return fmaxf(x, 0.f) + log1pf(expf(-fabsf(x))); }
__device__ __forceinline__ float siluf_(float x) { return x / (1.0f + expf(-x)); }
__device__ __forceinline__ float geluf_(float x) { return 0.5f * x * (1.0f + tanhf(0.7978845608028654f * (x + 0.044715f * x * x * x))); }
#define DPPF(v_, ctrl_, rmask_) __int_as_float(__builtin_amdgcn_update_dpp(0, __float_as_int(v_), (ctrl_), (rmask_), 0xf, false))
__device__ __forceinline__ float wave_sum(float v) {
    v += DPPF(v, 0xB1, 0xf); v += DPPF(v, 0x4E, 0xf); v += DPPF(v, 0x141, 0xf); v += DPPF(v, 0x140, 0xf);
    v += DPPF(v, 0x142, 0xa); v += DPPF(v, 0x143, 0xc);
    return __int_as_float(__builtin_amdgcn_readlane(__float_as_int(v), 63));
}
__device__ __forceinline__ float wave_max(float v) {
    v = fmaxf(v, DPPF(v, 0xB1, 0xf)); v = fmaxf(v, DPPF(v, 0x4E, 0xf)); v = fmaxf(v, DPPF(v, 0x141, 0xf)); v = fmaxf(v, DPPF(v, 0x140, 0xf));
    { const float t = __int_as_float(__builtin_amdgcn_update_dpp(__float_as_int(v), __float_as_int(v), 0x142, 0xa, 0xf, false)); v = fmaxf(v, t); }
    { const float t = __int_as_float(__builtin_amdgcn_update_dpp(__float_as_int(v), __float_as_int(v), 0x143, 0xc, 0xf, false)); v = fmaxf(v, t); }
    return __int_as_float(__builtin_amdgcn_readlane(__float_as_int(v), 63));
}

template <bool ABORDER = false>
__device__ __forceinline__ void p0_transpose_item(const float* __restrict__ W, int K, int N, bf16* __restrict__ WT, float* scr, int item, int lane) {
    const int nblk = (N + 31) / 32, kb = item / nblk, nb = item % nblk, k0 = 64 * kb, n0 = 32 * nb;
    const int n_ = n0 + (lane & 31);
    const int ns = ABORDER ? (n_ < 2048 ? n_ : (n_ < ABMAIN ? n_ + 8 : n_ - 1024)) : n_;
    float wv_[32];
#pragma unroll
    for (int i = 0; i < 32; ++i) { const int kk = 2 * i + (lane >> 5); wv_[i] = n_ < N ? W[(size_t)(k0 + kk) * N + ns] : 0.f; }
#pragma unroll
    for (int i = 0; i < 32; ++i) { const int kk = 2 * i + (lane >> 5); scr[kk * 33 + (lane & 31)] = wv_[i]; }
    asm volatile("s_waitcnt lgkmcnt(0)" ::: "memory");
    const int c = lane & 7;
#pragma unroll
    for (int j = 0; j < 4; ++j) { const int n = (lane >> 3) + 8 * j; const float* s = scr + (8 * c) * 33 + n;
        v4u o; o.x = pk2(s[0 * 33], s[1 * 33]); o.y = pk2(s[2 * 33], s[3 * 33]); o.z = pk2(s[4 * 33], s[5 * 33]); o.w = pk2(s[6 * 33], s[7 * 33]);
        *(v4u*)(WT + (size_t)(n0 + n) * K + k0 + 8 * c) = o; }
    asm volatile("s_waitcnt lgkmcnt(0)" ::: "memory");
}
__device__ __forceinline__ void row_to_bf16(const float* __restrict__ xrow, bf16* __restrict__ orow, int lane) {
#pragma unroll
    for (int j = 0; j < 4; ++j) {
        f32x4 v = (f32x4){0.f, 0.f, 0.f, 0.f};
        if (xrow) v = ((const f32x4*)xrow)[lane + 64 * j];
        v2u o; o.x = pk2(v.x, v.y); o.y = pk2(v.z, v.w);
        ((v2u*)orow)[lane + 64 * j] = o;
    }
}

struct AbPrepArgs {
    const bf16* PROJ; const float* st_gdn_conv; const float* st_lru_conv;
    const float* gdn_conv_w; const float* a_log; const float* dt_bias;
    const float* lru_conv_w; const float* lru_conv_b; const float* w_r; const float* b_r; const float* w_i; const float* b_i; const float* lam;
    float* QKV; float* G; float* BETA; float* LA; float* LB;
    float* p_gdn_conv; float* p_lru_conv; float* s_gdn_conv; float* s_lru_conv;
};
__device__ __forceinline__ void ab_prep(const AbPrepArgs& a, int t, float* smem) {
    int tid = threadIdx.x; asm volatile("" : "+v"(tid));
    const int lane = tid & 63, wid = tid >> 6;
    const bool samp = t >= NP; const int sb = t - NP, pos = t % SEQ, b = t / SEQ;
    float* sq = smem;
    float* sx = smem + 1536;
    float* scl = smem + 2048;
    const bf16* prow = a.PROJ + (size_t)t * ABN;
    for (int c = tid; c < 1536; c += NTH) {
        float acc = 0.f;
#pragma unroll
        for (int i = 0; i < 4; ++i) {
            float xv;
            if (i == 3) xv = bf2f(prow[C_QKV + c]);
            else if (samp) xv = a.st_gdn_conv[((size_t)sb * 3 + i) * 1536 + c];
            else xv = (pos - 3 + i >= 0) ? bf2f(a.PROJ[(size_t)(t - 3 + i) * ABN + C_QKV + c]) : 0.f;
            acc += a.gdn_conv_w[i * 1536 + c] * xv;
        }
        sq[c] = siluf_(acc);
    }
    {
        const int c = tid;
        float acc = a.lru_conv_b[c];
#pragma unroll
        for (int i = 0; i < 4; ++i) {
            float xv;
            if (i == 3) xv = bf2f(prow[C_XR + c]);
            else if (samp) xv = a.st_lru_conv[((size_t)sb * 3 + i) * 512 + c];
            else xv = (pos - 3 + i >= 0) ? bf2f(a.PROJ[(size_t)(t - 3 + i) * ABN + C_XR + c]) : 0.f;
            acc += a.lru_conv_w[i * 512 + c] * xv;
        }
        sx[c] = acc;
    }
    __syncthreads();
    {
        const int grp = wid;
        const float v0 = sq[grp * 128 + lane], v1 = sq[grp * 128 + 64 + lane];
        const float s = wave_sum(v0 * v0 + v1 * v1);
        if (lane == 0) scl[grp] = rsqrtf(s + 1e-6f) * (grp < 4 ? 0.08838834764831845f : 1.0f);
    }
    __syncthreads();
    for (int c = tid; c < 1536; c += NTH) a.QKV[(size_t)t * 1536 + c] = (c < 1024) ? sq[c] * scl[c >> 7] : sq[c];
    if (tid < 4) {
        const float a_raw = bf2f(prow[C_A + tid]), b_raw = bf2f(prow[C_B + tid]);
        a.G[(size_t)t * 4 + tid] = -expf(a.a_log[tid]) * softplusf_(a_raw + a.dt_bias[tid]);
        a.BETA[(size_t)t * 4 + tid] = sigmoidf_(b_raw);
    }
    if (!samp) {
        if (pos >= SEQ - 3) {
            const int row = pos - (SEQ - 3);
            for (int c = tid; c < 1536; c += NTH) a.p_gdn_conv[((size_t)b * 3 + row) * 1536 + c] = bf2f(prow[C_QKV + c]);
            a.p_lru_conv[((size_t)b * 3 + row) * 512 + tid] = bf2f(prow[C_XR + tid]);
        }
    } else {
        for (int c = tid; c < 1536; c += NTH) {
            a.s_gdn_conv[((size_t)sb * 3 + 0) * 1536 + c] = a.st_gdn_conv[((size_t)sb * 3 + 1) * 1536 + c];
            a.s_gdn_conv[((size_t)sb * 3 + 1) * 1536 + c] = a.st_gdn_conv[((size_t)sb * 3 + 2) * 1536 + c];
            a.s_gdn_conv[((size_t)sb * 3 + 2) * 1536 + c] = bf2f(prow[C_QKV + c]);
        }
        {
            const int c = tid;
            a.s_lru_conv[((size_t)sb * 3 + 0) * 512 + c] = a.st_lru_conv[((size_t)sb * 3 + 1) * 512 + c];
            a.s_lru_conv[((size_t)sb * 3 + 1) * 512 + c] = a.st_lru_conv[((size_t)sb * 3 + 2) * 512 + c];
            a.s_lru_conv[((size_t)sb * 3 + 2) * 512 + c] = bf2f(prow[C_XR + c]);
        }
    }
    {
        const int c = tid, n = c >> 6, d = c & 63;
        float r = a.b_r[c], ii = a.b_i[c];
#pragma unroll 4
        for (int cc = 0; cc < 64; ++cc) {
            const float xv = sx[n * 64 + cc];
            r += xv * a.w_r[((size_t)n * 64 + cc) * 64 + d];
            ii += xv * a.w_i[((size_t)n * 64 + cc) * 64 + d];
        }
        r = sigmoidf_(r); ii = sigmoidf_(ii);
        const float log_a = -8.0f * r * softplusf_(-a.lam[c]);
        a.LA[(size_t)t * 512 + c] = expf(log_a);
        a.LB[(size_t)t * 512 + c] = sqrtf(-expm1f(2.0f * log_a)) * (ii * sx[c]);
    }
}

__device__ __forceinline__ void gdn_scan(const float* __restrict__ QKV, const float* __restrict__ G, const float* __restrict__ BETA,
                                         const float* __restrict__ S0, float* __restrict__ O, float* __restrict__ Sout, int tok_base, int T,
                                         int sl, int h, int sq, float* smem) {
    int tid = threadIdx.x; asm volatile("" : "+v"(tid));
    const int dvl = tid & 31, kg = tid >> 5;
    const int dv = sl * 32 + dvl;
    float (*red1)[32] = (float (*)[32])smem;
    float (*red2)[32] = (float (*)[32])(smem + 512);
    float S[8];
#pragma unroll
    for (int i = 0; i < 8; ++i) S[i] = S0 ? S0[(((size_t)sq * 4 + h) * 128 + kg * 8 + i) * 128 + dv] : 0.f;
    float kk[8], qq[8], vv, g, be;
    {
        const size_t tok = (size_t)tok_base + (size_t)sq * T;
        const float* row = QKV + tok * 1536;
#pragma unroll
        for (int i = 0; i < 8; ++i) { kk[i] = row[512 + h * 128 + kg * 8 + i]; qq[i] = row[h * 128 + kg * 8 + i]; }
        vv = row[1024 + h * 128 + dv]; g = G[tok * 4 + h]; be = BETA[tok * 4 + h];
    }
    for (int t = 0; t < T; ++t) {
        const size_t tok = (size_t)tok_base + (size_t)sq * T + t;
        float nk[8], nq[8], nv = 0.f, ng = 0.f, nb = 0.f;
        if (t + 1 < T) {
            const float* row = QKV + (tok + 1) * 1536;
#pragma unroll
            for (int i = 0; i < 8; ++i) { nk[i] = row[512 + h * 128 + kg * 8 + i]; nq[i] = row[h * 128 + kg * 8 + i]; }
            nv = row[1024 + h * 128 + dv]; ng = G[(tok + 1) * 4 + h]; nb = BETA[(tok + 1) * 4 + h];
        } else {
#pragma unroll
            for (int i = 0; i < 8; ++i) { nk[i] = 0.f; nq[i] = 0.f; }
        }
        const float al = expf(g);
        float p = 0.f;
#pragma unroll
        for (int i = 0; i < 8; ++i) { S[i] *= al; p += S[i] * kk[i]; }
        red1[kg][dvl] = p;
        __syncthreads();
        float ks = 0.f;
#pragma unroll
        for (int j = 0; j < 16; ++j) ks += red1[j][dvl];
        const float vn = be * (vv - ks);
        float o = 0.f;
#pragma unroll
        for (int i = 0; i < 8; ++i) { S[i] += kk[i] * vn; o += S[i] * qq[i]; }
        red2[kg][dvl] = o;
        __syncthreads();
        if (kg == 0) {
            float os = 0.f;
#pragma unroll
            for (int j = 0; j < 16; ++j) os += red2[j][dvl];
            O[tok * 512 + h * 128 + dv] = os;
        }
#pragma unroll
        for (int i = 0; i < 8; ++i) { kk[i] = nk[i]; qq[i] = nq[i]; }
        vv = nv; g = ng; be = nb;
    }
#pragma unroll
    for (int i = 0; i < 8; ++i) Sout[(((size_t)sq * 4 + h) * 128 + kg * 8 + i) * 128 + dv] = S[i];
}


__device__ __forceinline__ void gdn_step_sample_w(const float* __restrict__ QKV, const float* __restrict__ G, const float* __restrict__ BETA, const float* __restrict__ S0,
                                                  float* __restrict__ O, float* __restrict__ Sout, int item, int lane) {
    const int sl = item & 7, h = (item >> 3) & 3, sb = item >> 5, fr = lane & 15, fq = lane >> 4;
    const size_t tok = (size_t)NP + sb;
    const float* row = QKV + tok * 1536;
    const size_t sbase = (((size_t)sb * 4 + h) * 128 + fq * 32) * 128 + sl * 16 + fr;
    float S[32], kk[32], qq[32];
#pragma unroll
    for (int i = 0; i < 32; ++i) S[i] = S0[sbase + (size_t)i * 128];
#pragma unroll
    for (int i4 = 0; i4 < 8; ++i4) { const f32x4 k4 = *(const f32x4*)(row + 512 + h * 128 + fq * 32 + i4 * 4), q4 = *(const f32x4*)(row + h * 128 + fq * 32 + i4 * 4);
        kk[i4 * 4 + 0] = k4.x; kk[i4 * 4 + 1] = k4.y; kk[i4 * 4 + 2] = k4.z; kk[i4 * 4 + 3] = k4.w; qq[i4 * 4 + 0] = q4.x; qq[i4 * 4 + 1] = q4.y; qq[i4 * 4 + 2] = q4.z; qq[i4 * 4 + 3] = q4.w; }
    const float vv = row[1024 + h * 128 + sl * 16 + fr], al = expf(G[tok * 4 + h]), be = BETA[tok * 4 + h];
    float p = 0.f;
#pragma unroll
    for (int i = 0; i < 32; ++i) { S[i] *= al; p += S[i] * kk[i]; }
    p += __shfl_xor(p, 16); p += __shfl_xor(p, 32);
    const float vn = be * (vv - p);
    float o = 0.f;
#pragma unroll
    for (int i = 0; i < 32; ++i) { S[i] += kk[i] * vn; o += S[i] * qq[i]; }
    o += __shfl_xor(o, 16); o += __shfl_xor(o, 32);
    if (fq == 0) O[tok * 512 + h * 128 + sl * 16 + fr] = o;
#pragma unroll
    for (int i = 0; i < 32; ++i) Sout[sbase + (size_t)i * 128] = S[i];
}

__device__ __forceinline__ void lru_scan(const float* __restrict__ LA, float* __restrict__ LB, const float* __restrict__ h0,
                                         float* __restrict__ hlast, int tok_base, int T, int nseq, int bx) {
    int tx_ = threadIdx.x; asm volatile("" : "+v"(tx_));
    const int idx = bx * NTH + tx_;
    if (idx >= nseq * 512) return;
    const int sq = idx / 512, c = idx % 512;
    float h = h0 ? h0[(size_t)sq * 512 + c] : 0.f;
    const size_t base = ((size_t)tok_base + (size_t)sq * T) * 512 + c;
#pragma unroll 8
    for (int t = 0; t < T; ++t) {
        const size_t o = base + (size_t)t * 512;
        h = LA[o] * h + LB[o];
        LB[o] = h;
    }
    hlast[(size_t)sq * 512 + c] = h;
}

__device__ __forceinline__ void ab_mix_w(const bf16* __restrict__ PROJ, const float* __restrict__ O, const float* __restrict__ H, const float* __restrict__ P, const float* __restrict__ CIN,
                                         const float* __restrict__ norm_w, bf16* __restrict__ MIX, int t, int lane) {
    const bf16* prow = PROJ + (size_t)t * ABN;
#pragma unroll
    for (int jj = 0; jj < 2; ++jj) {
        const int c0 = 256 * jj + 4 * lane;
        const f32x4 o = *(const f32x4*)(O + (size_t)t * 512 + c0);
        const v2u zb = *(const v2u*)(prow + C_Z + c0);
        const f32x4 w = *(const f32x4*)(norm_w + (c0 & 127));
        float ss = (o.x * o.x + o.y * o.y) + (o.z * o.z + o.w * o.w);
        ss += DPPF(ss, 0xB1, 0xf); ss += DPPF(ss, 0x4E, 0xf); ss += DPPF(ss, 0x141, 0xf); ss += DPPF(ss, 0x140, 0xf);
        { const auto sw_ = __builtin_amdgcn_permlane16_swap(__float_as_uint(ss), __float_as_uint(ss), false, false); ss = __uint_as_float(sw_[0]) + __uint_as_float(sw_[1]); }
        const float sc = rsqrtf(ss * (1.0f / 128.0f) + 1e-6f);
        const float z0 = bflo(zb.x), z1 = bfhi(zb.x), z2 = bflo(zb.y), z3 = bfhi(zb.y);
        v2u ob;
        ob.x = pk2(o.x * sc * w.x * (z0 * __frcp_rn(1.0f + __expf(-z0))), o.y * sc * w.y * (z1 * __frcp_rn(1.0f + __expf(-z1))));
        ob.y = pk2(o.z * sc * w.z * (z2 * __frcp_rn(1.0f + __expf(-z2))), o.w * sc * w.w * (z3 * __frcp_rn(1.0f + __expf(-z3))));
        *(v2u*)(MIX + (size_t)t * 1024 + c0) = ob;
    }
#pragma unroll
    for (int jj = 0; jj < 2; ++jj) {
        const int c0 = 256 * jj + 4 * lane;
        const v2u gb = *(const v2u*)(prow + C_GATE + c0);
        f32x4 h = *(const f32x4*)(H + (size_t)t * 512 + c0);
        if (t < NP) { const f32x4 p = *(const f32x4*)(P + (size_t)t * 512 + c0), ci = *(const f32x4*)(CIN + (size_t)(t >> 6) * 512 + c0); h = h + p * ci; }
        v2u ob; ob.x = pk2(geluf_(bflo(gb.x)) * h.x, geluf_(bfhi(gb.x)) * h.y); ob.y = pk2(geluf_(bflo(gb.y)) * h.z, geluf_(bfhi(gb.y)) * h.w);
        *(v2u*)(MIX + (size_t)t * 1024 + 512 + c0) = ob;
    }
}

template <bool XBF>
__device__ __forceinline__ void ln_res_w(const void* __restrict__ xrow_, const bf16* __restrict__ yrow, const float* __restrict__ g, const float* __restrict__ bta,
                                         bf16* __restrict__ obrow, int lane) {
    f32x4 v[4]; float s = 0.f;
#pragma unroll
    for (int j = 0; j < 4; ++j) {
        f32x4 x4;
        if (XBF) { const v2u xb = ((const v2u*)xrow_)[lane + 64 * j]; x4 = (f32x4){bflo(xb.x), bfhi(xb.x), bflo(xb.y), bfhi(xb.y)}; }
        else x4 = ((const f32x4*)xrow_)[lane + 64 * j];
        const v2u yb = ((const v2u*)yrow)[lane + 64 * j];
        const f32x4 y4 = (f32x4){bflo(yb.x), bfhi(yb.x), bflo(yb.y), bfhi(yb.y)}; v[j] = x4 * ALPHA + y4; s += (v[j].x + v[j].y) + (v[j].z + v[j].w); }
    const float mean = wave_sum(s) * (1.0f / 1024.0f); float q = 0.f;
#pragma unroll
    for (int j = 0; j < 4; ++j) { v[j] = v[j] - mean; q += (v[j].x * v[j].x + v[j].y * v[j].y) + (v[j].z * v[j].z + v[j].w * v[j].w); }
    const float rs = rsqrtf(wave_sum(q) * (1.0f / 1024.0f) + LN_EPS);
#pragma unroll
    for (int j = 0; j < 4; ++j) {
        const f32x4 g4 = ((const f32x4*)g)[lane + 64 * j], b4 = ((const f32x4*)bta)[lane + 64 * j];
        const f32x4 o = v[j] * rs * g4 + b4;
        v2u ob; ob.x = pk2(o.x, o.y); ob.y = pk2(o.z, o.w);
        ((v2u*)obrow)[lane + 64 * j] = ob;
    }
}

__device__ __forceinline__ void peer_topk(const bf16* __restrict__ Q, const float* __restrict__ keys, int* __restrict__ EXP, float* __restrict__ GATE,
                                          int tg, int h, float* smem) {
    const int tid = threadIdx.x, cn = tid & 255, c = cn >> 7, n = cn & 127, th = tid >> 8;
    float (*sq)[256] = (float (*)[256])smem;
    float (*ss)[257] = (float (*)[257])(smem + 32 * 256);
    float (*tvs)[2][16] = (float (*)[2][16])(smem + 32 * 256 + 32 * 257 + 32);
    int (*tis)[2][16] = (int (*)[2][16])(smem + 32 * 256 + 32 * 257 + 32 + 1024);
    for (int i = tid; i < 32 * 256; i += NTH) {
        const int tk = i >> 8, col = i & 255;
        sq[tk][col] = bf2f(Q[(size_t)(tg * 32 + tk) * 2048 + h * 256 + col]);
    }
    __syncthreads();
    float acc[16];
#pragma unroll
    for (int i = 0; i < 16; ++i) acc[i] = 0.f;
    const float* krow = keys + (((size_t)h * 2 + c) * 128 + n) * 128;
    for (int d4 = 0; d4 < 32; ++d4) {
        const float4 kv = *(const float4*)(krow + d4 * 4);
#pragma unroll
        for (int tk = 0; tk < 16; ++tk) {
            const float4 qv = *(const float4*)&sq[th * 16 + tk][c * 128 + d4 * 4];
            acc[tk] += qv.x * kv.x + qv.y * kv.y + qv.z * kv.z + qv.w * kv.w;
        }
    }
#pragma unroll
    for (int tk = 0; tk < 16; ++tk) ss[th * 16 + tk][cn] = acc[tk];
    __syncthreads();
    if (tid < 64) {
        const int tk = tid >> 1, cc = tid & 1;
        float tv[16]; int ti[16];
#pragma unroll
        for (int j = 0; j < 16; ++j) { tv[j] = -INFINITY; ti[j] = 0; }
        for (int nn = 0; nn < 128; ++nn) {
            float x = ss[tk][cc * 128 + nn]; int xi = nn;
#pragma unroll
            for (int j = 0; j < 16; ++j) {
                const bool gt = x > tv[j];
                const float tf = tv[j]; const int tj = ti[j];
                tv[j] = gt ? x : tf; ti[j] = gt ? xi : tj;
                x = gt ? tf : x; xi = gt ? tj : xi;
            }
        }
#pragma unroll
        for (int j = 0; j < 16; ++j) { tvs[tk][cc][j] = tv[j]; tis[tk][cc][j] = ti[j]; }
    }
    __syncthreads();
    if (tid < 32) {
        const int tk = tid;
        float bv[16]; int bi[16];
#pragma unroll
        for (int j = 0; j < 16; ++j) { bv[j] = -INFINITY; bi[j] = 0; }
        for (int i = 0; i < 16; ++i)
            for (int jj = 0; jj < 16; ++jj) {
                float x = tvs[tk][0][i] + tvs[tk][1][jj]; int xi = tis[tk][0][i] * 128 + tis[tk][1][jj];
#pragma unroll
                for (int j = 0; j < 16; ++j) {
                    const bool gt = x > bv[j];
                    const float tf = bv[j]; const int tj = bi[j];
                    bv[j] = gt ? x : tf; bi[j] = gt ? xi : tj;
                    x = gt ? tf : x; xi = gt ? tj : xi;
                }
            }
        float e[16], sum = 0.f;
#pragma unroll
        for (int j = 0; j < 16; ++j) { e[j] = expf(bv[j] - bv[0]); sum += e[j]; }
        const float inv = 1.0f / sum;
        const size_t o = (size_t)(tg * 32 + tk) * 128 + h * 16;
#pragma unroll
        for (int j = 0; j < 16; ++j) { EXP[o + j] = bi[j]; GATE[o + j] = e[j] * inv; }
    }
}

__device__ __forceinline__ void peer_expert(const float* __restrict__ X, const int* __restrict__ EXP, const float* __restrict__ GATE,
                                            const float* __restrict__ U, const float* __restrict__ V,
                                            const float* __restrict__ g, const float* __restrict__ bta, float* __restrict__ out, bf16* __restrict__ outb, int t, float* smem) {
    const int tid = threadIdx.x, lane = tid & 63, wid = tid >> 6;
    float (*accs)[1024] = (float (*)[1024])smem;
    float* sred = smem + 8192;
    const float4* xr = (const float4*)(X + (size_t)t * D);
    float4 xv[4];
#pragma unroll
    for (int j = 0; j < 4; ++j) xv[j] = xr[lane + 64 * j];
    float4 acc[4];
#pragma unroll
    for (int j = 0; j < 4; ++j) acc[j] = make_float4(0.f, 0.f, 0.f, 0.f);
    for (int e = 0; e < 16; ++e) {
        const int id = EXP[(size_t)t * 128 + wid * 16 + e];
        const float gt = GATE[(size_t)t * 128 + wid * 16 + e];
        const float4* ur = (const float4*)(U + (size_t)id * D);
        const float4* vr = (const float4*)(V + (size_t)id * D);
        float4 uv[4], vv[4];
#pragma unroll
        for (int j = 0; j < 4; ++j) { uv[j] = ur[lane + 64 * j]; vv[j] = vr[lane + 64 * j]; }
        float dot = 0.f;
#pragma unroll
        for (int j = 0; j < 4; ++j) dot += uv[j].x * xv[j].x + uv[j].y * xv[j].y + uv[j].z * xv[j].z + uv[j].w * xv[j].w;
        dot = wave_sum(dot);
        const float cf = gt * geluf_(dot);
#pragma unroll
        for (int j = 0; j < 4; ++j) { acc[j].x += cf * vv[j].x; acc[j].y += cf * vv[j].y; acc[j].z += cf * vv[j].z; acc[j].w += cf * vv[j].w; }
    }
#pragma unroll
    for (int j = 0; j < 4; ++j) *(float4*)&accs[wid][(lane + 64 * j) * 4] = acc[j];
    __syncthreads();
    float v[2];
#pragma unroll
    for (int i = 0; i < 2; ++i) {
        const int c = tid * 2 + i;
        float s = 0.f;
#pragma unroll
        for (int w = 0; w < 8; ++w) s += accs[w][c];
        v[i] = ALPHA * X[(size_t)t * D + c] + s;
    }
    float s = wave_sum(v[0] + v[1]);
    if (lane == 0) sred[wid] = s;
    __syncthreads();
    float mean = 0.f;
#pragma unroll
    for (int w = 0; w < 8; ++w) mean += sred[w];
    mean *= (1.0f / 1024.0f);
    __syncthreads();
    const float d0 = v[0] - mean, d1 = v[1] - mean;
    float q = wave_sum(d0 * d0 + d1 * d1);
    if (lane == 0) sred[wid] = q;
    __syncthreads();
    float var = 0.f;
#pragma unroll
    for (int w = 0; w < 8; ++w) var += sred[w];
    const float rs = rsqrtf(var * (1.0f / 1024.0f) + LN_EPS);
    const float o0 = d0 * rs * g[tid * 2] + bta[tid * 2], o1 = d1 * rs * g[tid * 2 + 1] + bta[tid * 2 + 1];
    *(float2*)(out + (size_t)t * D + tid * 2) = make_float2(o0, o1);
    if (outb) *(unsigned*)(outb + (size_t)t * D + tid * 2) = pk2(o0, o1);
}


typedef __bf16 bf16x2_t __attribute__((ext_vector_type(2)));
__device__ __forceinline__ float dot2bf(unsigned w, unsigned x, float acc) { return __builtin_amdgcn_fdot2_f32_bf16(__builtin_bit_cast(bf16x2_t, w), __builtin_bit_cast(bf16x2_t, x), acc, false); }
typedef float f32x2_t __attribute__((ext_vector_type(2)));
__device__ __forceinline__ void row_to_fp8(const float* __restrict__ xrow, unsigned char* __restrict__ orow, float* __restrict__ scale, int lane) {
    f32x4 v[4]; float am = 0.f;
#pragma unroll
    for (int j = 0; j < 4; ++j) { v[j] = *(const f32x4*)(xrow + lane * 16 + j * 4); am = fmaxf(am, fmaxf(fmaxf(fabsf(v[j].x), fabsf(v[j].y)), fmaxf(fabsf(v[j].z), fabsf(v[j].w)))); }
    am = wave_max(am);
    const float s = am > 0.f ? am * (1.0f / 448.0f) : 1.0f, inv = 1.0f / s;
    v4u o;
    unsigned w;
    w = 0u; w = __builtin_amdgcn_cvt_pk_fp8_f32(v[0].x * inv, v[0].y * inv, w, false); w = __builtin_amdgcn_cvt_pk_fp8_f32(v[0].z * inv, v[0].w * inv, w, true); o.x = w;
    w = 0u; w = __builtin_amdgcn_cvt_pk_fp8_f32(v[1].x * inv, v[1].y * inv, w, false); w = __builtin_amdgcn_cvt_pk_fp8_f32(v[1].z * inv, v[1].w * inv, w, true); o.y = w;
    w = 0u; w = __builtin_amdgcn_cvt_pk_fp8_f32(v[2].x * inv, v[2].y * inv, w, false); w = __builtin_amdgcn_cvt_pk_fp8_f32(v[2].z * inv, v[2].w * inv, w, true); o.z = w;
    w = 0u; w = __builtin_amdgcn_cvt_pk_fp8_f32(v[3].x * inv, v[3].y * inv, w, false); w = __builtin_amdgcn_cvt_pk_fp8_f32(v[3].z * inv, v[3].w * inv, w, true); o.w = w;
    *(v4u*)(orow + lane * 16) = o;
    if (lane == 0) *scale = s;
}
#define PE_LOAD(UB, VB, grp) do { _Pragma("unroll") for (int i_ = 0; i_ < 4; ++i_) { const int e_ = (grp) * 4 + i_; \
        const int id_ = __builtin_amdgcn_readlane(e_ < 64 ? id0 : id1, e_ & 63); \
        const unsigned so_ = (unsigned)id_ * 1024u; \
        UB[i_] = __builtin_amdgcn_raw_buffer_load_b128(ursrc, voff, so_, 0); VB[i_] = __builtin_amdgcn_raw_buffer_load_b128(vrsrc, voff, so_, 0); } } while (0)
#define PE_DOT4(w, k) do { const f32x2_t l_ = __builtin_amdgcn_cvt_pk_f32_fp8((w), false), h_ = __builtin_amdgcn_cvt_pk_f32_fp8((w), true); \
        a_ += l_.x * xv[(k) * 4 + 0]; b_ += l_.y * xv[(k) * 4 + 1]; a_ += h_.x * xv[(k) * 4 + 2]; b_ += h_.y * xv[(k) * 4 + 3]; } while (0)
#define PE_AXPY4(w, k) do { const f32x2_t l_ = __builtin_amdgcn_cvt_pk_f32_fp8((w), false), h_ = __builtin_amdgcn_cvt_pk_f32_fp8((w), true); \
        acc[(k) * 4 + 0] += cf_ * l_.x; acc[(k) * 4 + 1] += cf_ * l_.y; acc[(k) * 4 + 2] += cf_ * h_.x; acc[(k) * 4 + 3] += cf_ * h_.y; } while (0)
#define PE_COMP(UB, VB, grp) do { float d_[4]; \
        _Pragma("unroll") for (int i_ = 0; i_ < 4; ++i_) { float a_ = 0.f, b_ = 0.f; PE_DOT4(UB[i_].x, 0); PE_DOT4(UB[i_].y, 1); PE_DOT4(UB[i_].z, 2); PE_DOT4(UB[i_].w, 3); d_[i_] = a_ + b_; } \
          \
        float s0_ = hi32 ? d_[2] : d_[0], t0_ = hi32 ? d_[0] : d_[2]; s0_ += __shfl_xor(t0_, 32); \
        float s1_ = hi32 ? d_[3] : d_[1], t1_ = hi32 ? d_[1] : d_[3]; s1_ += __shfl_xor(t1_, 32); \
        float r_ = hi16 ? s1_ : s0_, t2_ = hi16 ? s0_ : s1_; r_ += __shfl_xor(t2_, 16); \
        r_ += __shfl_xor(r_, 8); r_ += __shfl_xor(r_, 4); r_ += __shfl_xor(r_, 2); r_ += __shfl_xor(r_, 1); \
          \
        const int esel_ = (grp) * 4 + (lane >> 4); \
        const float su_ = __shfl(esel_ < 64 ? su0 : su1, esel_ & 63), gv_ = __shfl(esel_ < 64 ? gs0 : gs1, esel_ & 63); \
        const float cfl_ = geluf_(r_ * su_) * gv_; \
        _Pragma("unroll") for (int i_ = 0; i_ < 4; ++i_) { \
            const float cf_ = __uint_as_float(__builtin_amdgcn_readlane(__float_as_uint(cfl_), 16 * i_)); \
            PE_AXPY4(VB[i_].x, 0); PE_AXPY4(VB[i_].y, 1); PE_AXPY4(VB[i_].z, 2); PE_AXPY4(VB[i_].w, 3); } } while (0)
__device__ __forceinline__ void peer_expert_w(const float* __restrict__ xrow, const int* __restrict__ exr, const float* __restrict__ gar,
                                              const unsigned char* __restrict__ U, const unsigned char* __restrict__ V, const float* __restrict__ SU, const float* __restrict__ SV,
                                              const float* __restrict__ g, const float* __restrict__ bta, float* __restrict__ orow, bf16* __restrict__ obrow, int lane) {
    const bool hi32 = (lane & 32) != 0, hi16 = (lane & 16) != 0;
    const __amdgpu_buffer_rsrc_t ursrc = __builtin_amdgcn_make_buffer_rsrc((void*)U, 0, 16384 * 1024, 0x00020000);
    const __amdgpu_buffer_rsrc_t vrsrc = __builtin_amdgcn_make_buffer_rsrc((void*)V, 0, 16384 * 1024, 0x00020000);
    const int voff = lane * 16;
    float xv[16];
#pragma unroll
    for (int j = 0; j < 4; ++j) { const f32x4 t = *(const f32x4*)(xrow + lane * 16 + j * 4); xv[j * 4 + 0] = t.x; xv[j * 4 + 1] = t.y; xv[j * 4 + 2] = t.z; xv[j * 4 + 3] = t.w; }
    const int id0 = exr[lane], id1 = exr[64 + lane];
    const float su0 = SU[id0], su1 = SU[id1];
    const float gs0 = gar[lane] * SV[id0], gs1 = gar[64 + lane] * SV[id1];
    float acc[16];
#pragma unroll
    for (int i = 0; i < 16; ++i) acc[i] = 0.f;
    v4u ua[4], va[4], ub[4], vb[4];
    PE_LOAD(ua, va, 0);
#pragma unroll 1
    for (int grp = 0; grp < 32; grp += 2) {
        PE_LOAD(ub, vb, grp + 1);
        PE_COMP(ua, va, grp);
        if (grp + 2 < 32) PE_LOAD(ua, va, grp + 2);
        PE_COMP(ub, vb, grp + 1);
    }
    float v[16]; float s = 0.f;
#pragma unroll
    for (int i = 0; i < 16; ++i) { v[i] = ALPHA * xv[i] + acc[i]; s += v[i]; }
    const float mean = wave_sum(s) * (1.0f / 1024.0f); float q = 0.f;
#pragma unroll
    for (int i = 0; i < 16; ++i) { v[i] -= mean; q += v[i] * v[i]; }
    const float rs = rsqrtf(wave_sum(q) * (1.0f / 1024.0f) + LN_EPS);
    float o[16];
#pragma unroll
    for (int j = 0; j < 4; ++j) {
        const f32x4 g4 = *(const f32x4*)(g + lane * 16 + j * 4), b4 = *(const f32x4*)(bta + lane * 16 + j * 4);
        o[j * 4 + 0] = v[j * 4 + 0] * rs * g4.x + b4.x; o[j * 4 + 1] = v[j * 4 + 1] * rs * g4.y + b4.y; o[j * 4 + 2] = v[j * 4 + 2] * rs * g4.z + b4.z; o[j * 4 + 3] = v[j * 4 + 3] * rs * g4.w + b4.w;
        *(f32x4*)(orow + lane * 16 + j * 4) = (f32x4){o[j * 4 + 0], o[j * 4 + 1], o[j * 4 + 2], o[j * 4 + 3]};
    }
    if (obrow) {
        v4u w0, w1; w0.x = pk2(o[0], o[1]); w0.y = pk2(o[2], o[3]); w0.z = pk2(o[4], o[5]); w0.w = pk2(o[6], o[7]); w1.x = pk2(o[8], o[9]); w1.y = pk2(o[10], o[11]); w1.z = pk2(o[12], o[13]); w1.w = pk2(o[14], o[15]);
        *(v4u*)(obrow + lane * 16) = w0; *(v4u*)(obrow + lane * 16 + 8) = w1;
    }
}


__device__ __forceinline__ void peer_expert_blk(const float* __restrict__ xrow, const int* __restrict__ exr, const float* __restrict__ gar,
                                                const unsigned char* __restrict__ U, const unsigned char* __restrict__ V, const float* __restrict__ SU, const float* __restrict__ SV,
                                                const float* __restrict__ g, const float* __restrict__ bta, float* __restrict__ orow, bf16* __restrict__ obrow, int lane, int wave, float* smem) {
    const bool hi32 = (lane & 32) != 0, hi16 = (lane & 16) != 0;
    const __amdgpu_buffer_rsrc_t ursrc = __builtin_amdgcn_make_buffer_rsrc((void*)U, 0, 16384 * 1024, 0x00020000);
    const __amdgpu_buffer_rsrc_t vrsrc = __builtin_amdgcn_make_buffer_rsrc((void*)V, 0, 16384 * 1024, 0x00020000);
    const int voff = lane * 16;
    float xv[16];
#pragma unroll
    for (int j = 0; j < 4; ++j) { const f32x4 t = *(const f32x4*)(xrow + lane * 16 + j * 4); xv[j * 4 + 0] = t.x; xv[j * 4 + 1] = t.y; xv[j * 4 + 2] = t.z; xv[j * 4 + 3] = t.w; }
    const int id0 = exr[lane], id1 = exr[64 + lane];
    const float su0 = SU[id0], su1 = SU[id1];
    const float gs0 = gar[lane] * SV[id0], gs1 = gar[64 + lane] * SV[id1];
    float acc[16];
#pragma unroll
    for (int i = 0; i < 16; ++i) acc[i] = 0.f;
    v4u ua[4], va[4], ub[4], vb[4];
    const int g0 = wave * 4;
    PE_LOAD(ua, va, g0); PE_LOAD(ub, vb, g0 + 1);
    PE_COMP(ua, va, g0); PE_LOAD(ua, va, g0 + 2);
    PE_COMP(ub, vb, g0 + 1); PE_LOAD(ub, vb, g0 + 3);
    PE_COMP(ua, va, g0 + 2);
    PE_COMP(ub, vb, g0 + 3);
    float* accs = smem;
    float* sred = smem + 8192;
#pragma unroll
    for (int j = 0; j < 4; ++j) *(f32x4*)(accs + wave * 1024 + lane * 16 + j * 4) = (f32x4){acc[j * 4 + 0], acc[j * 4 + 1], acc[j * 4 + 2], acc[j * 4 + 3]};
    __syncthreads();
    const int tid = wave * 64 + lane;
    float v0 = ALPHA * xrow[tid * 2], v1 = ALPHA * xrow[tid * 2 + 1];
#pragma unroll
    for (int w = 0; w < 8; ++w) { v0 += accs[w * 1024 + tid * 2]; v1 += accs[w * 1024 + tid * 2 + 1]; }
    const float s = wave_sum(v0 + v1);
    if (lane == 0) sred[wave] = s;
    __syncthreads();
    float mean = 0.f;
#pragma unroll
    for (int w = 0; w < 8; ++w) mean += sred[w];
    mean *= (1.0f / 1024.0f);
    __syncthreads();
    const float d0 = v0 - mean, d1 = v1 - mean;
    const float q = wave_sum(d0 * d0 + d1 * d1);
    if (lane == 0) sred[wave] = q;
    __syncthreads();
    float var = 0.f;
#pragma unroll
    for (int w = 0; w < 8; ++w) var += sred[w];
    const float rs = rsqrtf(var * (1.0f / 1024.0f) + LN_EPS);
    const float o0 = d0 * rs * g[tid * 2] + bta[tid * 2], o1 = d1 * rs * g[tid * 2 + 1] + bta[tid * 2 + 1];
    *(float2*)(orow + tid * 2) = make_float2(o0, o1);
    if (obrow) *(unsigned*)(obrow + tid * 2) = pk2(o0, o1);
    __syncthreads();
}

__device__ __forceinline__ void row_to_fp8_sliced(const float* __restrict__ xrow, unsigned char* __restrict__ tab, int r, float* __restrict__ scale, int lane) {
    f32x4 v[4]; float am = 0.f;
#pragma unroll
    for (int j = 0; j < 4; ++j) { v[j] = *(const f32x4*)(xrow + lane * 16 + j * 4); am = fmaxf(am, fmaxf(fmaxf(fabsf(v[j].x), fabsf(v[j].y)), fmaxf(fabsf(v[j].z), fabsf(v[j].w)))); }
    am = wave_max(am);
    const float s = am > 0.f ? am * (1.0f / 448.0f) : 1.0f, inv = 1.0f / s;
    v4u o; unsigned w;
    w = 0u; w = __builtin_amdgcn_cvt_pk_fp8_f32(v[0].x * inv, v[0].y * inv, w, false); w = __builtin_amdgcn_cvt_pk_fp8_f32(v[0].z * inv, v[0].w * inv, w, true); o.x = w;
    w = 0u; w = __builtin_amdgcn_cvt_pk_fp8_f32(v[1].x * inv, v[1].y * inv, w, false); w = __builtin_amdgcn_cvt_pk_fp8_f32(v[1].z * inv, v[1].w * inv, w, true); o.y = w;
    w = 0u; w = __builtin_amdgcn_cvt_pk_fp8_f32(v[2].x * inv, v[2].y * inv, w, false); w = __builtin_amdgcn_cvt_pk_fp8_f32(v[2].z * inv, v[2].w * inv, w, true); o.z = w;
    w = 0u; w = __builtin_amdgcn_cvt_pk_fp8_f32(v[3].x * inv, v[3].y * inv, w, false); w = __builtin_amdgcn_cvt_pk_fp8_f32(v[3].z * inv, v[3].w * inv, w, true); o.w = w;
    *(v4u*)(tab + ((size_t)(lane >> 3) * 16384 + r) * 128 + (lane & 7) * 16) = o;
    if (lane == 0) *scale = s;
}
__device__ __forceinline__ void row_to_i8_sliced(const float* __restrict__ xrow, unsigned char* __restrict__ tab, int r, float* __restrict__ scale, int lane) {
    f32x4 v[4]; float am = 0.f;
#pragma unroll
    for (int j = 0; j < 4; ++j) { v[j] = *(const f32x4*)(xrow + lane * 16 + j * 4); am = fmaxf(am, fmaxf(fmaxf(fabsf(v[j].x), fabsf(v[j].y)), fmaxf(fabsf(v[j].z), fabsf(v[j].w)))); }
    am = wave_max(am);
    const float s = am > 0.f ? am * (1.0f / 127.0f) : 1.0f, inv = 1.0f / s;
    v4u o;
#define I8PK(q_) (((unsigned)(int)rintf((q_).x * inv) & 0xffu) | (((unsigned)(int)rintf((q_).y * inv) & 0xffu) << 8) | (((unsigned)(int)rintf((q_).z * inv) & 0xffu) << 16) | (((unsigned)(int)rintf((q_).w * inv) & 0xffu) << 24))
    o.x = I8PK(v[0]); o.y = I8PK(v[1]); o.z = I8PK(v[2]); o.w = I8PK(v[3]);
    *(v4u*)(tab + ((size_t)(lane >> 3) * 16384 + r) * 128 + (lane & 7) * 16) = o;
    if (lane == 0) *scale = s;
}

template <bool FP8>
__device__ __forceinline__ void table_rows_convert(const float* __restrict__ src, unsigned char* __restrict__ tab, float* __restrict__ scales, int rbeg, int rend, int gw, int ngw, int lane) {
    for (int r0 = rbeg + gw; r0 < rend; r0 += 4 * ngw) {
        f32x4 v[4][4]; int rr[4]; float am[4];
#pragma unroll
        for (int i = 0; i < 4; ++i) { rr[i] = r0 + i * ngw < rend ? r0 + i * ngw : rend - 1;
#pragma unroll
            for (int j = 0; j < 4; ++j) v[i][j] = *(const f32x4*)(src + (size_t)rr[i] * D + j * 256 + lane * 4); }
#pragma unroll
        for (int i = 0; i < 4; ++i) { float a = 0.f;
#pragma unroll
            for (int j = 0; j < 4; ++j) a = fmaxf(a, fmaxf(fmaxf(fabsf(v[i][j].x), fabsf(v[i][j].y)), fmaxf(fabsf(v[i][j].z), fabsf(v[i][j].w))));
            am[i] = a; }
#pragma unroll
        for (int i = 0; i < 4; ++i) am[i] = wave_max(am[i]);
#pragma unroll
        for (int i = 0; i < 4; ++i) {
            const float s = am[i] > 0.f ? am[i] * (FP8 ? 1.0f / 448.0f : 1.0f / 127.0f) : 1.0f, inv = 1.0f / s;
#pragma unroll
            for (int j = 0; j < 4; ++j) {
                unsigned w;
                if (FP8) { w = 0u; w = __builtin_amdgcn_cvt_pk_fp8_f32(v[i][j].x * inv, v[i][j].y * inv, w, false); w = __builtin_amdgcn_cvt_pk_fp8_f32(v[i][j].z * inv, v[i][j].w * inv, w, true); }
                else w = ((unsigned)(int)rintf(v[i][j].x * inv) & 0xffu) | (((unsigned)(int)rintf(v[i][j].y * inv) & 0xffu) << 8) | (((unsigned)(int)rintf(v[i][j].z * inv) & 0xffu) << 16) | (((unsigned)(int)rintf(v[i][j].w * inv) & 0xffu) << 24);
                *(unsigned*)(tab + ((size_t)(2 * j + (lane >> 5)) * 16384 + rr[i]) * 128 + (lane & 31) * 4) = w;
            }
            if (lane == 0) scales[rr[i]] = s;
        }
    }
}
__device__ __forceinline__ void peer_u_pass(const bf16* __restrict__ xrow, const int* __restrict__ exr, const unsigned char* __restrict__ U8x, float* __restrict__ pd, int x, int lane) {
    const int e8 = lane >> 3, c = lane & 7;
    f32x2_t xp[8];
#pragma unroll
    for (int j = 0; j < 2; ++j) { const v4u t = *(const v4u*)(xrow + x * 128 + c * 16 + j * 8);
        xp[j * 4 + 0] = (f32x2_t){bflo(t.x), bfhi(t.x)}; xp[j * 4 + 1] = (f32x2_t){bflo(t.y), bfhi(t.y)}; xp[j * 4 + 2] = (f32x2_t){bflo(t.z), bfhi(t.z)}; xp[j * 4 + 3] = (f32x2_t){bflo(t.w), bfhi(t.w)}; }
    const __amdgpu_buffer_rsrc_t ursrc = __builtin_amdgcn_make_buffer_rsrc((void*)U8x, 0, 16384 * 128, 0x00020000);
    v4u wa[8], wb[8];
    float d[16];
    int ids[16];
#pragma unroll
    for (int j = 0; j < 4; ++j) { const v4u t = *(const v4u*)(exr + e8 * 16 + j * 4); ids[j * 4 + 0] = (int)t.x; ids[j * 4 + 1] = (int)t.y; ids[j * 4 + 2] = (int)t.z; ids[j * 4 + 3] = (int)t.w; }
#pragma unroll
    for (int g = 0; g < 8; ++g) wa[g] = __builtin_amdgcn_raw_buffer_load_b128(ursrc, ids[g] * 128 + c * 16, 0, 0);
#pragma unroll
    for (int g = 0; g < 8; ++g) wb[g] = __builtin_amdgcn_raw_buffer_load_b128(ursrc, ids[8 + g] * 128 + c * 16, 0, 0);
#define PU_DOT1(w_, k_) do { a_ = __builtin_elementwise_fma(__builtin_amdgcn_cvt_pk_f32_fp8((w_), false), xp[(k_) * 2], a_); a_ = __builtin_elementwise_fma(__builtin_amdgcn_cvt_pk_f32_fp8((w_), true), xp[(k_) * 2 + 1], a_); } while (0)
#pragma unroll
    for (int g = 0; g < 8; ++g) { f32x2_t a_ = (f32x2_t){0.f, 0.f}; PU_DOT1(wa[g].x, 0); PU_DOT1(wa[g].y, 1); PU_DOT1(wa[g].z, 2); PU_DOT1(wa[g].w, 3); d[g] = a_.x + a_.y; }
#pragma unroll
    for (int g = 0; g < 8; ++g) { f32x2_t a_ = (f32x2_t){0.f, 0.f}; PU_DOT1(wb[g].x, 0); PU_DOT1(wb[g].y, 1); PU_DOT1(wb[g].z, 2); PU_DOT1(wb[g].w, 3); d[8 + g] = a_.x + a_.y; }
#pragma unroll
    for (int g = 0; g < 16; ++g) { d[g] += DPPF(d[g], 0xB1, 0xf); d[g] += DPPF(d[g], 0x4E, 0xf); d[g] += DPPF(d[g], 0x141, 0xf); }
    if (c == 0) {
#pragma unroll
        for (int j = 0; j < 4; ++j) *(f32x4*)(pd + e8 * 16 + j * 4) = (f32x4){d[j * 4 + 0], d[j * 4 + 1], d[j * 4 + 2], d[j * 4 + 3]};
    }
}
#define PUL_IDS(I, k_) do { const int t_ = ((tg0 + ((k_) < nit ? (k_) : nit - 1) * tgstep) * 8 + wave); _Pragma("unroll") for (int j = 0; j < 4; ++j) I[j] = *(const v4u*)(EXPp + (size_t)t_ * 128 + e8 * 16 + j * 4); } while (0)
#define PUL_ROWS(R, X, I, k_) do { const int t_ = ((tg0 + ((k_) < nit ? (k_) : nit - 1) * tgstep) * 8 + wave); \
        X[0] = *(const v4u*)(XBp + (size_t)t_ * D + x * 128 + c * 16); X[1] = *(const v4u*)(XBp + (size_t)t_ * D + x * 128 + c * 16 + 8); \
        _Pragma("unroll") for (int j = 0; j < 4; ++j) { R[j * 4 + 0] = __builtin_amdgcn_raw_buffer_load_b128(ursrc, (int)I[j].x * 128 + c * 16, 0, 0); R[j * 4 + 1] = __builtin_amdgcn_raw_buffer_load_b128(ursrc, (int)I[j].y * 128 + c * 16, 0, 0); \
            R[j * 4 + 2] = __builtin_amdgcn_raw_buffer_load_b128(ursrc, (int)I[j].z * 128 + c * 16, 0, 0); R[j * 4 + 3] = __builtin_amdgcn_raw_buffer_load_b128(ursrc, (int)I[j].w * 128 + c * 16, 0, 0); } } while (0)
#define PUL_COMP(R, X, k_) do { float xf_[16]; \
        _Pragma("unroll") for (int j = 0; j < 2; ++j) { xf_[j * 8 + 0] = bflo(X[j].x); xf_[j * 8 + 1] = bfhi(X[j].x); xf_[j * 8 + 2] = bflo(X[j].y); xf_[j * 8 + 3] = bfhi(X[j].y); xf_[j * 8 + 4] = bflo(X[j].z); xf_[j * 8 + 5] = bfhi(X[j].z); xf_[j * 8 + 6] = bflo(X[j].w); xf_[j * 8 + 7] = bfhi(X[j].w); } \
          \
        float am_ = 0.f; _Pragma("unroll") for (int i = 0; i < 16; ++i) am_ = fmaxf(am_, fabsf(xf_[i])); \
        am_ = fmaxf(am_, DPPF(am_, 0xB1, 0xf)); am_ = fmaxf(am_, DPPF(am_, 0x4E, 0xf)); am_ = fmaxf(am_, DPPF(am_, 0x141, 0xf)); \
        const float sx_ = am_ > 0.f ? am_ * (1.0f / 127.0f) : 1.0f, ix_ = 1.0f / sx_; \
        int xq_[4]; \
        _Pragma("unroll") for (int j = 0; j < 4; ++j) xq_[j] = (int)(((unsigned)(int)rintf(xf_[j * 4 + 0] * ix_) & 0xffu) | (((unsigned)(int)rintf(xf_[j * 4 + 1] * ix_) & 0xffu) << 8) | (((unsigned)(int)rintf(xf_[j * 4 + 2] * ix_) & 0xffu) << 16) | (((unsigned)(int)rintf(xf_[j * 4 + 3] * ix_) & 0xffu) << 24)); \
        float d[16]; \
        _Pragma("unroll") for (int g = 0; g < 16; ++g) { int a_ = __builtin_amdgcn_sdot4((int)R[g].x, xq_[0], 0, false); a_ = __builtin_amdgcn_sdot4((int)R[g].y, xq_[1], a_, false); a_ = __builtin_amdgcn_sdot4((int)R[g].z, xq_[2], a_, false); a_ = __builtin_amdgcn_sdot4((int)R[g].w, xq_[3], a_, false); d[g] = (float)a_; } \
        _Pragma("unroll") for (int g = 0; g < 16; ++g) { d[g] += DPPF(d[g], 0xB1, 0xf); d[g] += DPPF(d[g], 0x4E, 0xf); d[g] += DPPF(d[g], 0x141, 0xf); d[g] *= sx_; } \
        if (c == 0 && (k_) < nit) { float* pd_ = PDx + (size_t)((tg0 + (k_) * tgstep) * 8 + wave) * 128 + e8 * 16; \
            _Pragma("unroll") for (int j = 0; j < 4; ++j) *(f32x4*)(pd_ + j * 4) = (f32x4){d[j * 4 + 0], d[j * 4 + 1], d[j * 4 + 2], d[j * 4 + 3]}; } } while (0)
__device__ __forceinline__ void peer_u_loop(const bf16* __restrict__ XBp, const int* __restrict__ EXPp, const unsigned char* __restrict__ U8x, float* __restrict__ PDx, int x, int tg0, int tgstep, int nit, int wave, int lane) {
    const int e8 = lane >> 3, c = lane & 7;
    const __amdgpu_buffer_rsrc_t ursrc = __builtin_amdgcn_make_buffer_rsrc((void*)U8x, 0, 16384 * 128, 0x00020000);
    v4u ra[16], rb[16], xa[2], xb[2], i0[4], i1[4];
    PUL_IDS(i0, 0);
    PUL_ROWS(ra, xa, i0, 0);
    PUL_IDS(i1, 1);
#pragma unroll 1
    for (int k = 0; k < nit; k += 2) {
        PUL_ROWS(rb, xb, i1, k + 1);
        PUL_IDS(i0, k + 2);
        PUL_COMP(ra, xa, k);
        PUL_ROWS(ra, xa, i0, k + 2);
        PUL_IDS(i1, k + 3);
        PUL_COMP(rb, xb, k + 1);
    }
}
#define PV_LOAD(VB, grp) do { _Pragma("unroll") for (int i_ = 0; i_ < 4; ++i_) { const int e_ = (grp) * 4 + i_; \
        const int id_ = __builtin_amdgcn_readlane(e_ < 64 ? id0 : id1, e_ & 63); \
        VB[i_] = __builtin_amdgcn_raw_buffer_load_b128(vrsrc, voff, (unsigned)id_ * 1024u, 0); } } while (0)
#define PV_COMP(VB, grp) do { _Pragma("unroll") for (int i_ = 0; i_ < 4; ++i_) { const int e_ = (grp) * 4 + i_; \
        const float cf_ = __uint_as_float(__builtin_amdgcn_readlane(__float_as_uint(e_ < 64 ? cf0 : cf1), e_ & 63)); \
        PE_AXPY4(VB[i_].x, 0); PE_AXPY4(VB[i_].y, 1); PE_AXPY4(VB[i_].z, 2); PE_AXPY4(VB[i_].w, 3); } } while (0)
#define PV_COEFS() \
    const int id0 = exr[lane], id1 = exr[64 + lane]; \
    float dot0 = 0.f, dot1 = 0.f; \
    { const int p0 = lane, p1 = 64 + lane;        \
      _Pragma("unroll") for (int x_ = 0; x_ < 8; ++x_) { dot0 += pdt[(size_t)x_ * NT * 128 + p0]; dot1 += pdt[(size_t)x_ * NT * 128 + p1]; } } \
    const float cf0 = gar[lane] * SV[id0] * geluf_(SU[id0] * dot0), cf1 = gar[64 + lane] * SV[id1] * geluf_(SU[id1] * dot1);
__device__ __forceinline__ void peer_v_w(const float* __restrict__ xrow, const int* __restrict__ exr, const float* __restrict__ gar, const float* __restrict__ pdt,
                                         const unsigned char* __restrict__ V, const float* __restrict__ SU, const float* __restrict__ SV,
                                         const float* __restrict__ g, const float* __restrict__ bta, float* __restrict__ orow, bf16* __restrict__ obrow, int lane) {
    const __amdgpu_buffer_rsrc_t vrsrc = __builtin_amdgcn_make_buffer_rsrc((void*)V, 0, 16384 * 1024, 0x00020000);
    const int voff = lane * 16;
    PV_COEFS()
    float acc[16];
#pragma unroll
    for (int i = 0; i < 16; ++i) acc[i] = 0.f;
    v4u va[4], vb[4], vc[4];
    PV_LOAD(va, 0); PV_LOAD(vb, 1);
#pragma unroll 1
    for (int grp = 0; grp < 30; grp += 3) {
        PV_LOAD(vc, grp + 2);
        PV_COMP(va, grp);
        PV_LOAD(va, grp + 3);
        PV_COMP(vb, grp + 1);
        PV_LOAD(vb, grp + 4);
        PV_COMP(vc, grp + 2);
    }
    PV_COMP(va, 30); PV_COMP(vb, 31);
    float xv[16];
#pragma unroll
    for (int j = 0; j < 4; ++j) { const f32x4 t = *(const f32x4*)(xrow + lane * 16 + j * 4); xv[j * 4 + 0] = t.x; xv[j * 4 + 1] = t.y; xv[j * 4 + 2] = t.z; xv[j * 4 + 3] = t.w; }
    float v[16]; float s = 0.f;
#pragma unroll
    for (int i = 0; i < 16; ++i) { v[i] = ALPHA * xv[i] + acc[i]; s += v[i]; }
    const float mean = wave_sum(s) * (1.0f / 1024.0f); float q = 0.f;
#pragma unroll
    for (int i = 0; i < 16; ++i) { v[i] -= mean; q += v[i] * v[i]; }
    const float rs = rsqrtf(wave_sum(q) * (1.0f / 1024.0f) + LN_EPS);
    float o[16];
#pragma unroll
    for (int j = 0; j < 4; ++j) {
        const f32x4 g4 = *(const f32x4*)(g + lane * 16 + j * 4), b4 = *(const f32x4*)(bta + lane * 16 + j * 4);
        o[j * 4 + 0] = v[j * 4 + 0] * rs * g4.x + b4.x; o[j * 4 + 1] = v[j * 4 + 1] * rs * g4.y + b4.y; o[j * 4 + 2] = v[j * 4 + 2] * rs * g4.z + b4.z; o[j * 4 + 3] = v[j * 4 + 3] * rs * g4.w + b4.w;
        *(f32x4*)(orow + lane * 16 + j * 4) = (f32x4){o[j * 4 + 0], o[j * 4 + 1], o[j * 4 + 2], o[j * 4 + 3]};
    }
    if (obrow) {
        v4u w0, w1; w0.x = pk2(o[0], o[1]); w0.y = pk2(o[2], o[3]); w0.z = pk2(o[4], o[5]); w0.w = pk2(o[6], o[7]); w1.x = pk2(o[8], o[9]); w1.y = pk2(o[10], o[11]); w1.z = pk2(o[12], o[13]); w1.w = pk2(o[14], o[15]);
        *(v4u*)(obrow + lane * 16) = w0; *(v4u*)(obrow + lane * 16 + 8) = w1;
    }
}
__device__ __forceinline__ void peer_v_blk(const float* __restrict__ xrow, const int* __restrict__ exr, const float* __restrict__ gar, const float* __restrict__ pdt,
                                           const unsigned char* __restrict__ V, const float* __restrict__ SU, const float* __restrict__ SV,
                                           const float* __restrict__ g, const float* __restrict__ bta, float* __restrict__ orow, bf16* __restrict__ obrow, int lane, int wave, float* smem) {
    const __amdgpu_buffer_rsrc_t vrsrc = __builtin_amdgcn_make_buffer_rsrc((void*)V, 0, 16384 * 1024, 0x00020000);
    const int voff = lane * 16;
    PV_COEFS()
    float acc[16];
#pragma unroll
    for (int i = 0; i < 16; ++i) acc[i] = 0.f;
    v4u va[4], vb[4], vc[4], vd[4];
    PV_LOAD(va, wave * 4); PV_LOAD(vb, wave * 4 + 1); PV_LOAD(vc, wave * 4 + 2); PV_LOAD(vd, wave * 4 + 3);
    PV_COMP(va, wave * 4); PV_COMP(vb, wave * 4 + 1); PV_COMP(vc, wave * 4 + 2); PV_COMP(vd, wave * 4 + 3);
    float* accs = smem;
    float* sred = smem + 8192;
#pragma unroll
    for (int j = 0; j < 4; ++j) *(f32x4*)(accs + wave * 1024 + lane * 16 + j * 4) = (f32x4){acc[j * 4 + 0], acc[j * 4 + 1], acc[j * 4 + 2], acc[j * 4 + 3]};
    __syncthreads();
    const int tid = wave * 64 + lane;
    float v0 = ALPHA * xrow[tid * 2], v1 = ALPHA * xrow[tid * 2 + 1];
#pragma unroll
    for (int w = 0; w < 8; ++w) { v0 += accs[w * 1024 + tid * 2]; v1 += accs[w * 1024 + tid * 2 + 1]; }
    const float s = wave_sum(v0 + v1);
    if (lane == 0) sred[wave] = s;
    __syncthreads();
    float mean = 0.f;
#pragma unroll
    for (int w = 0; w < 8; ++w) mean += sred[w];
    mean *= (1.0f / 1024.0f);
    __syncthreads();
    const float d0 = v0 - mean, d1 = v1 - mean;
    const float q = wave_sum(d0 * d0 + d1 * d1);
    if (lane == 0) sred[wave] = q;
    __syncthreads();
    float var = 0.f;
#pragma unroll
    for (int w = 0; w < 8; ++w) var += sred[w];
    const float rs = rsqrtf(var * (1.0f / 1024.0f) + LN_EPS);
    const float o0 = d0 * rs * g[tid * 2] + bta[tid * 2], o1 = d1 * rs * g[tid * 2 + 1] + bta[tid * 2 + 1];
    *(float2*)(orow + tid * 2) = make_float2(o0, o1);
    if (obrow) *(unsigned*)(obrow + tid * 2) = pk2(o0, o1);
    __syncthreads();
}

__device__ __forceinline__ void peer_xk(const int* __restrict__ exr, float* __restrict__ gar, const float* __restrict__ pdt, const float* __restrict__ SU, const float* __restrict__ SV, int lane) {
    PV_COEFS()
    gar[lane] = cf0; gar[64 + lane] = cf1;
}
__device__ __forceinline__ void peer_v_slice(const int* __restrict__ exr, const float* __restrict__ cfr, const unsigned char* __restrict__ V8x, float* __restrict__ outs  , int lane) {
    const int e8 = lane >> 3, c = lane & 7;
    const __amdgpu_buffer_rsrc_t vrsrc = __builtin_amdgcn_make_buffer_rsrc((void*)V8x, 0, 16384 * 128, 0x00020000);
    v4u wa[8], wb[8]; float cfa[8], cfb[8];
    int ids[16];
#pragma unroll
    for (int j = 0; j < 4; ++j) { const v4u t = *(const v4u*)(exr + e8 * 16 + j * 4); ids[j * 4 + 0] = (int)t.x; ids[j * 4 + 1] = (int)t.y; ids[j * 4 + 2] = (int)t.z; ids[j * 4 + 3] = (int)t.w; }
#pragma unroll
    for (int g = 0; g < 8; ++g) wa[g] = __builtin_amdgcn_raw_buffer_load_b128(vrsrc, ids[g] * 128 + c * 16, 0, 0);
#pragma unroll
    for (int g = 0; g < 8; ++g) wb[g] = __builtin_amdgcn_raw_buffer_load_b128(vrsrc, ids[8 + g] * 128 + c * 16, 0, 0);
#pragma unroll
    for (int j = 0; j < 2; ++j) { const f32x4 t = *(const f32x4*)(cfr + e8 * 16 + j * 4), u = *(const f32x4*)(cfr + e8 * 16 + 8 + j * 4);
        cfa[j * 4 + 0] = t.x; cfa[j * 4 + 1] = t.y; cfa[j * 4 + 2] = t.z; cfa[j * 4 + 3] = t.w; cfb[j * 4 + 0] = u.x; cfb[j * 4 + 1] = u.y; cfb[j * 4 + 2] = u.z; cfb[j * 4 + 3] = u.w; }
    f32x2_t ap[8];
#pragma unroll
    for (int i = 0; i < 8; ++i) ap[i] = (f32x2_t){0.f, 0.f};
#define PVS_AXPY(w_, k_) do { ap[(k_) * 2] = __builtin_elementwise_fma(cf2_, __builtin_amdgcn_cvt_pk_f32_fp8((w_), false), ap[(k_) * 2]); ap[(k_) * 2 + 1] = __builtin_elementwise_fma(cf2_, __builtin_amdgcn_cvt_pk_f32_fp8((w_), true), ap[(k_) * 2 + 1]); } while (0)
#pragma unroll
    for (int g = 0; g < 8; ++g) { const f32x2_t cf2_ = (f32x2_t){cfa[g], cfa[g]}; PVS_AXPY(wa[g].x, 0); PVS_AXPY(wa[g].y, 1); PVS_AXPY(wa[g].z, 2); PVS_AXPY(wa[g].w, 3); }
#pragma unroll
    for (int g = 0; g < 8; ++g) { const f32x2_t cf2_ = (f32x2_t){cfb[g], cfb[g]}; PVS_AXPY(wb[g].x, 0); PVS_AXPY(wb[g].y, 1); PVS_AXPY(wb[g].z, 2); PVS_AXPY(wb[g].w, 3); }
#undef PVS_AXPY
    float acc[16];
#pragma unroll
    for (int i = 0; i < 8; ++i) { acc[2 * i] = ap[i].x; acc[2 * i + 1] = ap[i].y; }
#pragma unroll
    for (int i = 0; i < 16; ++i) { float v = acc[i]; v += DPPF(v, 0x128, 0xf); v += __shfl_xor(v, 16); v += __shfl_xor(v, 32); acc[i] = v; }
    if (e8 == 0) {
#pragma unroll
        for (int j = 0; j < 4; ++j) *(f32x4*)(outs + c * 16 + j * 4) = (f32x4){acc[j * 4 + 0], acc[j * 4 + 1], acc[j * 4 + 2], acc[j * 4 + 3]};
    }
}
#define PVL_IDS(I, k_) do { const int t_ = ((tg0 + ((k_) < nit ? (k_) : nit - 1) * tgstep) * 8 + wave); _Pragma("unroll") for (int j = 0; j < 4; ++j) I[j] = *(const v4u*)(EXPp + (size_t)t_ * 128 + e8 * 16 + j * 4); } while (0)
#define PVL_ROWS(R, C, I, k_) do { const int t_ = ((tg0 + ((k_) < nit ? (k_) : nit - 1) * tgstep) * 8 + wave); \
        _Pragma("unroll") for (int j = 0; j < 4; ++j) C[j] = *(const f32x4*)(CFp + (size_t)t_ * 128 + e8 * 16 + j * 4); \
        _Pragma("unroll") for (int j = 0; j < 4; ++j) { R[j * 4 + 0] = __builtin_amdgcn_raw_buffer_load_b128(vrsrc, (int)I[j].x * 128 + c * 16, 0, 0); R[j * 4 + 1] = __builtin_amdgcn_raw_buffer_load_b128(vrsrc, (int)I[j].y * 128 + c * 16, 0, 0); \
            R[j * 4 + 2] = __builtin_amdgcn_raw_buffer_load_b128(vrsrc, (int)I[j].z * 128 + c * 16, 0, 0); R[j * 4 + 3] = __builtin_amdgcn_raw_buffer_load_b128(vrsrc, (int)I[j].w * 128 + c * 16, 0, 0); } } while (0)
#define PVL_AXPY(w_, k2_) do { ap[(k2_) * 2] = __builtin_elementwise_fma(cf2_, __builtin_amdgcn_cvt_pk_f32_fp8((w_), false), ap[(k2_) * 2]); ap[(k2_) * 2 + 1] = __builtin_elementwise_fma(cf2_, __builtin_amdgcn_cvt_pk_f32_fp8((w_), true), ap[(k2_) * 2 + 1]); } while (0)
#define PVL_COMP(R, C, k_) do { f32x2_t ap[8]; \
        _Pragma("unroll") for (int i = 0; i < 8; ++i) ap[i] = (f32x2_t){0.f, 0.f}; \
        _Pragma("unroll") for (int g = 0; g < 16; ++g) { const float cfs_ = C[g >> 2][g & 3]; const f32x2_t cf2_ = (f32x2_t){cfs_, cfs_}; PVL_AXPY(R[g].x, 0); PVL_AXPY(R[g].y, 1); PVL_AXPY(R[g].z, 2); PVL_AXPY(R[g].w, 3); } \
        float acc[16]; \
        _Pragma("unroll") for (int i = 0; i < 8; ++i) { acc[2 * i] = ap[i].x; acc[2 * i + 1] = ap[i].y; } \
        float a8[8], a4[4], a2[2]; \
          \
        _Pragma("unroll") for (int i = 0; i < 8; ++i) { const auto sw_ = __builtin_amdgcn_permlane32_swap(__float_as_uint(acc[i]), __float_as_uint(acc[8 + i]), false, false); a8[i] = __uint_as_float(sw_[0]) + __uint_as_float(sw_[1]); } \
        _Pragma("unroll") for (int i = 0; i < 4; ++i) { const auto sw_ = __builtin_amdgcn_permlane16_swap(__float_as_uint(a8[i]), __float_as_uint(a8[4 + i]), false, false); a4[i] = __uint_as_float(sw_[0]) + __uint_as_float(sw_[1]); } \
        _Pragma("unroll") for (int i = 0; i < 2; ++i) { const float keep = hC ? a4[2 + i] : a4[i], send = hC ? a4[i] : a4[2 + i]; a2[i] = keep + DPPF(send, 0x128, 0xf); } \
        if ((k_) < nit) *(float2*)(OUTp + (size_t)((tg0 + (k_) * tgstep) * 8 + wave) * D + x * 128 + c * 16 + 2 * e8) = make_float2(a2[0], a2[1]); } while (0)
__device__ __forceinline__ void peer_v_loop(const int* __restrict__ EXPp, const float* __restrict__ CFp, const unsigned char* __restrict__ V8x, float* __restrict__ OUTp, int x, int tg0, int tgstep, int nit, int wave, int lane) {
    const int e8 = lane >> 3, c = lane & 7;
    const bool hA = (lane & 32) != 0, hB = (lane & 16) != 0, hC = (lane & 8) != 0;
    const __amdgpu_buffer_rsrc_t vrsrc = __builtin_amdgcn_make_buffer_rsrc((void*)V8x, 0, 16384 * 128, 0x00020000);
    v4u ra[16], rb[16], i0[4], i1[4]; f32x4 ca[4], cb[4];
    PVL_IDS(i0, 0);
    PVL_ROWS(ra, ca, i0, 0);
    PVL_IDS(i1, 1);
#pragma unroll 1
    for (int k = 0; k < nit; k += 2) {
        PVL_ROWS(rb, cb, i1, k + 1);
        PVL_IDS(i0, k + 2);
        PVL_COMP(ra, ca, k);
        PVL_ROWS(ra, ca, i0, k + 2);
        PVL_IDS(i1, k + 3);
        PVL_COMP(rb, cb, k + 1);
    }
}
__device__ __forceinline__ void peer_xc(const bf16* __restrict__ xrow, const float* __restrict__ srow, const float* __restrict__ g, const float* __restrict__ bta, float* __restrict__ orow, bf16* __restrict__ obrow, bf16* __restrict__ obrow2, int lane) {
    f32x4 v[4]; float s = 0.f;
#pragma unroll
    for (int j = 0; j < 4; ++j) { const v2u ab = ((const v2u*)xrow)[lane + 64 * j]; const f32x4 b = ((const f32x4*)srow)[lane + 64 * j];
        v[j] = (f32x4){ALPHA * bflo(ab.x) + b.x, ALPHA * bfhi(ab.x) + b.y, ALPHA * bflo(ab.y) + b.z, ALPHA * bfhi(ab.y) + b.w}; s += (v[j].x + v[j].y) + (v[j].z + v[j].w); }
    const float mean = wave_sum(s) * (1.0f / 1024.0f); float q = 0.f;
#pragma unroll
    for (int j = 0; j < 4; ++j) { v[j] = v[j] - mean; q += (v[j].x * v[j].x + v[j].y * v[j].y) + (v[j].z * v[j].z + v[j].w * v[j].w); }
    const float rs = rsqrtf(wave_sum(q) * (1.0f / 1024.0f) + LN_EPS);
#pragma unroll
    for (int j = 0; j < 4; ++j) {
        const f32x4 g4 = ((const f32x4*)g)[lane + 64 * j], b4 = ((const f32x4*)bta)[lane + 64 * j];
        const f32x4 o = v[j] * rs * g4 + b4;
        if (orow) ((f32x4*)orow)[lane + 64 * j] = o;
        if (obrow) { v2u ob; ob.x = pk2(o.x, o.y); ob.y = pk2(o.z, o.w); ((v2u*)obrow)[lane + 64 * j] = ob; if (obrow2) ((v2u*)obrow2)[lane + 64 * j] = ob; }
    }
}

__device__ __forceinline__ int t5_bucket(int n) {
    if (n < 16) return n;
    const int large = 16 + (int)(logf((float)n / 16.0f) / 2.0794415416798357f * 16.0f);
    return large < 31 ? large : 31;
}
__device__ __forceinline__ void swa_attn(const float* __restrict__ PC, const float* __restrict__ cache_k, const float* __restrict__ cache_v,
                                         const float* __restrict__ rel_bias, const float* __restrict__ sinks, bf16* __restrict__ ATT, int bx) {
    const int tid = threadIdx.x, lane = tid & 63, wid = tid >> 6;
    const int gw = bx * 8 + wid;
    const int t = gw >> 4, h = gw & 15, kvh = h >> 2;
    if (t >= NT) return;
    const bool samp = t >= NP; const int sb = t - NP, pos = t % SEQ;
    const float* qrow = PC + (size_t)t * CN + h * 64;
    float lg[2]; bool valid[2];
#pragma unroll
    for (int rr = 0; rr < 2; ++rr) {
        const int r = lane + 64 * rr;
        const float* krow;
        if (!samp) { valid[rr] = (pos - r) >= 0; krow = PC + (size_t)(valid[rr] ? t - r : t) * CN + 1024 + kvh * 64; }
        else { valid[rr] = true; krow = (r == 0) ? PC + (size_t)t * CN + 1024 + kvh * 64 : cache_k + (((size_t)sb * 128 + (128 - r)) * 4 + kvh) * 64; }
        float dot = 0.f;
#pragma unroll
        for (int d4 = 0; d4 < 16; ++d4) {
            const float4 kv = *(const float4*)(krow + d4 * 4);
            const float4 qv = *(const float4*)(qrow + d4 * 4);
            dot += qv.x * kv.x + qv.y * kv.y + qv.z * kv.z + qv.w * kv.w;
        }
        lg[rr] = valid[rr] ? dot * 0.125f + rel_bias[t5_bucket(r) * 16 + h] : -INFINITY;
    }
    const float sink = sinks[h];
    const float m = fmaxf(wave_max(fmaxf(lg[0], lg[1])), sink);
    float p[2];
#pragma unroll
    for (int rr = 0; rr < 2; ++rr) p[rr] = valid[rr] ? expf(lg[rr] - m) : 0.f;
    const float den = wave_sum(p[0] + p[1]) + expf(sink - m);
    const float inv = 1.0f / den;
    float o = 0.f;
#pragma unroll
    for (int rr = 0; rr < 2; ++rr)
        for (int l2 = 0; l2 < 64; ++l2) {
            const int r = l2 + 64 * rr;
            const float pj = __shfl(p[rr], l2);
            if (pj != 0.f) {
                const float* vrow;
                if (!samp) vrow = PC + (size_t)(t - r) * CN + 1280 + kvh * 64;
                else vrow = (r == 0) ? PC + (size_t)t * CN + 1280 + kvh * 64 : cache_v + (((size_t)sb * 128 + (128 - r)) * 4 + kvh) * 64;
                o += pj * vrow[lane];
            }
        }
    ATT[(size_t)t * D + h * 64 + lane] = (bf16)f2bf(o * inv);
}

__device__ __forceinline__ void swa_kv_out(const float* __restrict__ PC, const float* __restrict__ cache_k, const float* __restrict__ cache_v,
                                           float* __restrict__ pk, float* __restrict__ pv, float* __restrict__ sk, float* __restrict__ sv, int vb) {
    const int c = threadIdx.x & 255, row = vb * 2 + (threadIdx.x >> 8);
    if (row < NB * 128) {
        const int b = row >> 7, i = row & 127;
        const float* src = PC + (size_t)(b * SEQ + SEQ - 128 + i) * CN;
        pk[(size_t)row * 256 + c] = src[1024 + c];
        pv[(size_t)row * 256 + c] = src[1280 + c];
    } else {
        const int r2 = row - NB * 128, sb = r2 >> 7, i = r2 & 127;
        if (i < 127) {
            sk[(size_t)r2 * 256 + c] = cache_k[((size_t)sb * 128 + i + 1) * 256 + c];
            sv[(size_t)r2 * 256 + c] = cache_v[((size_t)sb * 128 + i + 1) * 256 + c];
        } else {
            const float* src = PC + (size_t)(NP + sb) * CN;
            sk[(size_t)r2 * 256 + c] = src[1024 + c];
            sv[(size_t)r2 * 256 + c] = src[1280 + c];
        }
    }
}
#define XB_TMO      128
#define XB_XCNT(j)  (256  + 64 * (j))
#define XB_XSUB(j)  (1280 + 64 * (j))
#define XB_XGEN(j)  (2304 + 64 * (j))
#define XB_TOP      3328
#define XB_TOPGEN   3392
#define XCD_BAR_WORDS 3456
#define XB_SPIN_CAP (1u << 18)

__device__ __forceinline__ unsigned xb_ld(unsigned* p)              { return __hip_atomic_load(p, __ATOMIC_RELAXED, __HIP_MEMORY_SCOPE_AGENT); }
__device__ __forceinline__ unsigned xb_add(unsigned* p, unsigned v) { return __hip_atomic_fetch_add(p, v, __ATOMIC_RELAXED, __HIP_MEMORY_SCOPE_AGENT); }
__device__ __forceinline__ unsigned xb_xcc_id() { return (unsigned)__builtin_amdgcn_s_getreg((3 << 11) | 20) & 0xFu; }
#define XB_SPIN(cond, bar) do { unsigned _sp = 0; while (cond) { __builtin_amdgcn_s_sleep(1); \
    if ((++_sp & 255u) == 0u) { if (xb_ld(&(bar)[XB_TMO])) break; if (_sp > XB_SPIN_CAP) { atomicAdd(&(bar)[XB_TMO], 1u); break; } } } } while (0)

struct XcdBarrier {
    unsigned* bar; unsigned x;
    volatile LAS unsigned* st;
};

__device__ __forceinline__ XcdBarrier xcd_barrier_post(unsigned* bar, volatile LAS unsigned* st) {
    XcdBarrier b; b.bar = bar; b.x = xb_xcc_id(); b.st = st;
    if (threadIdx.x == 0) (void)xb_add(&bar[XB_XCNT(b.x)], 1u);
    return b;
}
__device__ __forceinline__ void xcd_barrier_complete(unsigned* bar, unsigned x, unsigned& nloc, unsigned& nx) {
    const unsigned G = gridDim.x * gridDim.y * gridDim.z;
    unsigned sum, cnt, mine, sp = 0u;
    for (;;) {
        sum = 0u; cnt = 0u; mine = 0u;
#pragma unroll
        for (unsigned j = 0; j < 16; ++j) { const unsigned c = xb_ld(&bar[XB_XCNT(j)]); sum += c; cnt += (c > 0u) ? 1u : 0u; mine = (j == x) ? c : mine; }
        if (sum == G) break;
        __builtin_amdgcn_s_sleep(1);
        if ((++sp & 255u) == 0u) { if (xb_ld(&bar[XB_TMO])) break; if (sp > XB_SPIN_CAP) { atomicAdd(&bar[XB_TMO], 1u); break; } }
    }
    nloc = mine > 0u ? mine : 1u; nx = cnt > 0u ? cnt : 1u;
}

__device__ __forceinline__ void xcd_barrier(const XcdBarrier& b) {
    asm volatile("s_waitcnt vmcnt(0)" ::: "memory");
    __syncthreads();
    if (threadIdx.x == 0) {
        unsigned* bar = b.bar;
        __builtin_amdgcn_s_waitcnt(0);
        unsigned nloc = b.st[0], nx = b.st[1];
        if (nloc == 0u) { xcd_barrier_complete(bar, b.x, nloc, nx); b.st[0] = nloc; b.st[1] = nx; }
        const unsigned old = xb_add(&bar[XB_XSUB(b.x)], 1u);
        const unsigned gen = old / nloc;
        if (old + 1u == (gen + 1u) * nloc) {
            __builtin_amdgcn_fence(__ATOMIC_RELEASE, "agent");
            asm volatile("s_waitcnt vmcnt(0)" ::: "memory");
            const unsigned og = xb_add(&bar[XB_TOP], 1u);
            const unsigned tg = og / nx;
            if (og + 1u == (tg + 1u) * nx) xb_add(&bar[XB_TOPGEN], 1u);
            else XB_SPIN(xb_ld(&bar[XB_TOPGEN]) == tg, bar);
            __builtin_amdgcn_fence(__ATOMIC_ACQUIRE, "agent");
            xb_add(&bar[XB_XGEN(b.x)], 1u);
            asm volatile("s_waitcnt vmcnt(0)" ::: "memory");
        } else {
            XB_SPIN(xb_ld(&bar[XB_XGEN(b.x)]) == gen, bar);
            __builtin_amdgcn_fence(__ATOMIC_ACQUIRE, "agent");
            asm volatile("s_waitcnt vmcnt(0)" ::: "memory");
        }
    }
    __syncthreads();
}

typedef short bf16x8_t __attribute__((ext_vector_type(8)));
__device__ __forceinline__ f32x4 mfma16(bf16x8_t a, bf16x8_t b, f32x4 c) { return __builtin_amdgcn_mfma_f32_16x16x32_bf16(a, b, c, 0, 0, 0); }

struct GdnChunkBufs {
    bf16* W;
    bf16* QG;
    bf16* KDT;
    bf16* UT;
    bf16* QK;
    float* EGL;
};

constexpr int GP_QB = 0, GP_KB = 17408, GP_VB = 34816, GP_LS = 52224, GP_QKS = 69632, GP_WS = 78848, GP_SC = 96256;

struct ConvJob { const float* u0; const float* v0; unsigned char* tab; float* tsc; };
__device__ __forceinline__ void gdn_prep_unit(const bf16* __restrict__ PROJ, const float* __restrict__ conv_w, const float* __restrict__ a_log, const float* __restrict__ dt_bias,
                                              const GdnChunkBufs& cb, float* __restrict__ p_gdn_conv, int un, unsigned char* lds, const ConvJob& cj) {
    int tid = threadIdx.x; asm volatile("" : "+v"(tid));
    const int lane = tid & 63, wave = __builtin_amdgcn_readfirstlane(tid >> 6), fr = lane & 15, fq = lane >> 4;
    const int h = un & 3, n = (un >> 2) & 63, b = un >> 8;
    const int t0 = b * SEQ + n * 64;
    bf16* Qb = (bf16*)(lds + GP_QB); bf16* Kb = (bf16*)(lds + GP_KB); bf16* Vb = (bf16*)(lds + GP_VB); bf16* Ws = (bf16*)(lds + GP_WS);
    float* Ls = (float*)(lds + GP_LS); bf16* QKs = (bf16*)(lds + GP_QKS);
    float* gcs = (float*)(lds + GP_SC); float* bets = gcs + 64; float* egcs = gcs + 128; float* ekds = gcs + 192; float* begs = gcs + 256;
    if (wave == 0) {
        const bf16* prow = PROJ + (size_t)(t0 + lane) * ABN;
        const float a_raw = bf2f(prow[C_A + h]), b_raw = bf2f(prow[C_B + h]);
        float g = -expf(a_log[h]) * softplusf_(a_raw + dt_bias[h]);
#pragma unroll
        for (int off = 1; off < 64; off <<= 1) { const float v = __shfl_up(g, off); if (lane >= off) g += v; }
        const float glast = __shfl(g, 63);
        { const float be_ = sigmoidf_(b_raw), eg_ = expf(g); gcs[lane] = g; bets[lane] = be_; egcs[lane] = eg_; ekds[lane] = expf(glast - g); begs[lane] = be_ * eg_; }
        if (lane == 0) cb.EGL[un] = expf(glast);
    }
    {
        int cols[6]; float cw[4][6], xw[3][6];
#pragma unroll
        for (int p = 0; p < 3; ++p)
#pragma unroll
            for (int e = 0; e < 2; ++e) cols[p * 2 + e] = p * 512 + h * 128 + e * 64 + lane;
#pragma unroll
        for (int i = 0; i < 4; ++i)
#pragma unroll
            for (int c = 0; c < 6; ++c) cw[i][c] = conv_w[i * 1536 + cols[c]];
        const int i0 = wave * 8;
#pragma unroll
        for (int k = 0; k < 3; ++k) {
            const int pos = n * 64 + i0 - 3 + k;
#pragma unroll
            for (int c = 0; c < 6; ++c) xw[k][c] = pos >= 0 ? bf2f(PROJ[(size_t)(t0 + i0 - 3 + k) * ABN + cols[c]]) : 0.f;
        }
        bf16 xraw[8][6];
#pragma unroll
        for (int ii = 0; ii < 8; ++ii)
#pragma unroll
            for (int c = 0; c < 6; ++c) xraw[ii][c] = PROJ[(size_t)(t0 + i0 + ii) * ABN + cols[c]];
#pragma unroll
        for (int ii = 0; ii < 8; ++ii) {
            const int i = i0 + ii;
            float xt[6], s[6];
#pragma unroll
            for (int c = 0; c < 6; ++c) xt[c] = bf2f(xraw[ii][c]);
#pragma unroll
            for (int c = 0; c < 6; ++c) { const float y_ = cw[0][c] * xw[0][c] + cw[1][c] * xw[1][c] + cw[2][c] * xw[2][c] + cw[3][c] * xt[c]; s[c] = y_ * __frcp_rn(1.0f + __expf(-y_)); }
            const float qs = rsqrtf(wave_sum(s[0] * s[0] + s[1] * s[1]) + 1e-6f) * 0.08838834764831845f;
            const float ks = rsqrtf(wave_sum(s[2] * s[2] + s[3] * s[3]) + 1e-6f);
            Qb[i * 136 + lane] = (bf16)f2bf(s[0] * qs); Qb[i * 136 + 64 + lane] = (bf16)f2bf(s[1] * qs);
            Kb[i * 136 + lane] = (bf16)f2bf(s[2] * ks); Kb[i * 136 + 64 + lane] = (bf16)f2bf(s[3] * ks);
            Vb[i * 136 + lane] = (bf16)f2bf(s[4]);      Vb[i * 136 + 64 + lane] = (bf16)f2bf(s[5]);
            if (n == 63 && i >= 61) {
#pragma unroll
                for (int c = 0; c < 6; ++c) p_gdn_conv[((size_t)b * 3 + (i - 61)) * 1536 + cols[c]] = xt[c];
            }
#pragma unroll
            for (int c = 0; c < 6; ++c) { xw[0][c] = xw[1][c]; xw[1][c] = xw[2][c]; xw[2][c] = xt[c]; }
        }
    }
    __syncthreads();
    {
        const int mi = wave >> 1;
        bf16x8_t aK[4], aQ[4];
#pragma unroll
        for (int ks = 0; ks < 4; ++ks) { aK[ks] = *(const bf16x8_t*)(Kb + (mi * 16 + fr) * 136 + ks * 32 + 8 * fq); aQ[ks] = *(const bf16x8_t*)(Qb + (mi * 16 + fr) * 136 + ks * 32 + 8 * fq); }
#pragma unroll
        for (int nn = 0; nn < 2; ++nn) {
            const int nj = (wave & 1) * 2 + nn;
            f32x4 accK = (f32x4){0.f, 0.f, 0.f, 0.f}, accQ = accK;
#pragma unroll
            for (int ks = 0; ks < 4; ++ks) { const bf16x8_t bk = *(const bf16x8_t*)(Kb + (nj * 16 + fr) * 136 + ks * 32 + 8 * fq); accK = mfma16(aK[ks], bk, accK); accQ = mfma16(aQ[ks], bk, accQ); }
            const int j = nj * 16 + fr; const float gj = gcs[j];
#pragma unroll
            for (int r = 0; r < 4; ++r) {
                const int i = mi * 16 + 4 * fq + r;
                const float dec = i >= j ? expf(gcs[i] - gj) : 0.f;
                Ls[j * 68 + i] = i > j ? bets[i] * accK[r] * dec : 0.f;
                QKs[i * 72 + j] = (bf16)f2bf(i >= j ? accQ[r] * dec : 0.f);
            }
        }
    }
    __syncthreads();
    if (wave < 4) {
        float x[64];
        const bool isu = tid < 128; const int c = isu ? tid : tid - 128;
        const LAS unsigned char* l3 = (const LAS unsigned char*)lds;
        unsigned so = (isu ? GP_VB : GP_KB) + c * 2, ro = GP_SC + (isu ? 64 * 4 : 256 * 4), lo = GP_LS;
        asm volatile("" : "+v"(so), "+v"(ro), "+v"(lo));
#pragma unroll
        for (int i = 0; i < 64; ++i) x[i] = *(const LAS float*)(l3 + ro + 4 * i) * bf2f(*(const LAS bf16*)(l3 + so + i * 272));
#pragma unroll
        for (int j = 0; j < 63; ++j) {
            const float nxj = -x[j]; const f32x2c_t nx2 = (f32x2c_t){nxj, nxj};
#pragma unroll
            for (int i4 = (j + 1) / 4; i4 < 16; ++i4) {
                const f32x4 l4 = *(const LAS f32x4*)(l3 + lo + j * 272 + i4 * 16);
#pragma unroll
                for (int hp = 0; hp < 2; ++hp) {
                    const int i0 = i4 * 4 + 2 * hp; const float la = hp ? l4.z : l4.x, lb = hp ? l4.w : l4.y;
                    if (i0 > j) { const f32x2c_t r = __builtin_elementwise_fma((f32x2c_t){la, lb}, nx2, (f32x2c_t){x[i0], x[i0 + 1]}); x[i0] = r.x; x[i0 + 1] = r.y; }
                    else if (i0 + 1 > j) x[i0 + 1] = fmaf(lb, nxj, x[i0 + 1]);
                }
            }
        }
        if (isu) {
            bf16* dst = cb.UT + (size_t)un * 8192 + ((c >> 4) * 4 * 64 + (c & 15)) * 4;
#pragma unroll
            for (int m4 = 0; m4 < 16; ++m4) { v2u o; o.x = pk2(x[m4 * 4 + 0], x[m4 * 4 + 1]); o.y = pk2(x[m4 * 4 + 2], x[m4 * 4 + 3]); *(v2u*)(dst + ((m4 >> 2) * 64 + (m4 & 3) * 16) * 4) = o; }
        } else {
#pragma unroll
            for (int i = 0; i < 64; ++i) Ws[i * 136 + c] = (bf16)f2bf(x[i]);
        }
    } else {
        const int t2 = tid - 256;
#pragma unroll
        for (int k = 0; k < 4; ++k) {
            const int ci = t2 + 256 * k, i = ((ci >> 8) << 4) | (ci & 15), d0 = (((ci >> 6) & 3) * 4 + ((ci >> 4) & 3)) * 8; const float e = egcs[i];
            const v4u q = *(const v4u*)(Qb + i * 136 + d0);
            v4u o; o.x = pk2(bflo(q.x) * e, bfhi(q.x) * e); o.y = pk2(bflo(q.y) * e, bfhi(q.y) * e); o.z = pk2(bflo(q.z) * e, bfhi(q.z) * e); o.w = pk2(bflo(q.w) * e, bfhi(q.w) * e);
            *(v4u*)(cb.QG + (size_t)un * 8192 + ci * 8) = o;
        }
#pragma unroll
        for (int k = 0; k < 4; ++k) {
            const int ci = t2 + 256 * k, d = ((ci >> 7) << 4) | (ci & 15), i0 = (((ci >> 6) & 1) * 4 + ((ci >> 4) & 3)) * 8;
            float v[8];
#pragma unroll
            for (int q = 0; q < 8; ++q) v[q] = bf2f(Kb[(i0 + q) * 136 + d]) * ekds[i0 + q];
            v4u o; o.x = pk2(v[0], v[1]); o.y = pk2(v[2], v[3]); o.z = pk2(v[4], v[5]); o.w = pk2(v[6], v[7]);
            *(v4u*)(cb.KDT + (size_t)un * 8192 + ci * 8) = o;
        }
#pragma unroll
        for (int k = 0; k < 2; ++k) {
            const int ci = t2 + 256 * k, i = ((ci >> 7) << 4) | (ci & 15), j0 = (((ci >> 6) & 1) * 4 + ((ci >> 4) & 3)) * 8;
            *(v4u*)(cb.QK + (size_t)un * 4096 + ci * 8) = *(const v4u*)(QKs + i * 72 + j0);
        }
        { const int rb = (un & 511) * 32 + (wave - 4) * 8;
          if (un < 512) table_rows_convert<false>(cj.u0, cj.tab, cj.tsc, rb, rb + 8, 0, 1, lane);
          else table_rows_convert<true>(cj.v0, cj.tab + (size_t)16384 * D, cj.tsc + 16384, rb, rb + 8, 0, 1, lane); }
    }
    __syncthreads();
#pragma unroll
    for (int k = 0; k < 2; ++k) {
        const int ci = tid + 512 * k, i = ((ci >> 8) << 4) | (ci & 15), d0 = (((ci >> 6) & 3) * 4 + ((ci >> 4) & 3)) * 8;
        *(v4u*)(cb.W + (size_t)un * 8192 + ci * 8) = *(const v4u*)(Ws + i * 136 + d0);
    }
    __syncthreads();
}

constexpr int GS_ST = 0, GS_VNT = 2 * 32 * 136 * 2, GS_END = GS_VNT + 32 * 72 * 2;
template <int N0, int N1>
__device__ __forceinline__ void gdn_seq(const GdnChunkBufs& cb, float* __restrict__ O, float* __restrict__ Sout, int b, int h, int sl, unsigned char* lds, f32x4 (&accS)[2], int& cur) {
    int tid = threadIdx.x; asm volatile("" : "+v"(tid));
    const int lane = tid & 63, wave = __builtin_amdgcn_readfirstlane(tid >> 6), fr = lane & 15, fq = lane >> 4;
    const int mi = wave >> 1, nj = wave & 1;
    bf16* St = (bf16*)(lds + GS_ST); bf16* VnT = (bf16*)(lds + GS_VNT);
    float* egls = (float*)(lds + GS_END);
    if (N0 == 0) {
        for (int i = tid; i < 2 * 32 * 136 / 2; i += NTH) ((unsigned*)St)[i] = 0u;
        accS[0] = (f32x4){0.f, 0.f, 0.f, 0.f}; accS[1] = accS[0]; cur = 0;
    }
    if (tid >= N0 && tid < N1) egls[tid] = cb.EGL[(size_t)((b * 64 + tid) * 4 + h)];
    __syncthreads();
#define GS_DECL(X) bf16x8_t aW##X[4], aQG##X[4], aQK##X[2], aKD##X[2]; v2u ut##X;
    GS_DECL(0) GS_DECL(1) GS_DECL(2)
#define GS_GLD16(dst, ptr) asm volatile("global_load_dwordx4 %0, %1, off" : "=v"(dst) : "v"(ptr))
#define GS_GLD8(dst, ptr) asm volatile("global_load_dwordx2 %0, %1, off" : "=v"(dst) : "v"(ptr))
#define GS_LOAD(X, n_) do { const size_t u_ = (size_t)((b * 64 + ((n_) < 63 ? (n_) : 63)) * 4 + h);     \
        _Pragma("unroll") for (int ks = 0; ks < 4; ++ks) { GS_GLD16(aW##X[ks], cb.W + u_ * 8192 + ((mi * 4 + ks) * 64 + lane) * 8); GS_GLD16(aQG##X[ks], cb.QG + u_ * 8192 + ((mi * 4 + ks) * 64 + lane) * 8); } \
        _Pragma("unroll") for (int ks = 0; ks < 2; ++ks) { GS_GLD16(aQK##X[ks], cb.QK + u_ * 4096 + ((mi * 2 + ks) * 64 + lane) * 8); GS_GLD16(aKD##X[ks], cb.KDT + u_ * 8192 + ((wave * 2 + ks) * 64 + lane) * 8); } \
        GS_GLD8(ut##X, cb.UT + u_ * 8192 + (((sl * 2 + nj) * 4 + mi) * 64 + lane) * 4); } while (0)
#define GS_WAITN(X, N) asm volatile("s_waitcnt vmcnt(" #N ")" : "+v"(aW##X[0]), "+v"(aW##X[1]), "+v"(aW##X[2]), "+v"(aW##X[3]), "+v"(aQG##X[0]), "+v"(aQG##X[1]), "+v"(aQG##X[2]), "+v"(aQG##X[3]), \
        "+v"(aQK##X[0]), "+v"(aQK##X[1]), "+v"(aKD##X[0]), "+v"(aKD##X[1]), "+v"(ut##X))
#define GS_WAIT(X, n_) GS_WAITN(X, 26)
#define GS_STEP(X, n_) do { \
        const float egl##X = egls[(n_)]; \
        GS_WAIT(X, n_); \
        __syncthreads();                                        \
        f32x4 accW = (f32x4){0.f, 0.f, 0.f, 0.f}, accO = accW; \
        const bf16* Sc = St + cur * 32 * 136; \
        _Pragma("unroll") for (int ks = 0; ks < 4; ++ks) { const bf16x8_t bs = *(const bf16x8_t*)(Sc + (nj * 16 + fr) * 136 + ks * 32 + 8 * fq); accW = mfma16(aW##X[ks], bs, accW); accO = mfma16(aQG##X[ks], bs, accO); } \
          \
        const float v0 = bflo(ut##X.x) - accW[0], v1 = bfhi(ut##X.x) - accW[1], v2 = bflo(ut##X.y) - accW[2], v3 = bfhi(ut##X.y) - accW[3]; \
        { v2u o; o.x = pk2(v0, v1); o.y = pk2(v2, v3); *(v2u*)(VnT + (nj * 16 + fr) * 72 + mi * 16 + 4 * fq) = o; } \
        __syncthreads();                                        \
        _Pragma("unroll") for (int ks = 0; ks < 2; ++ks) { const bf16x8_t bv = *(const bf16x8_t*)(VnT + (nj * 16 + fr) * 72 + ks * 32 + 8 * fq); accO = mfma16(aQK##X[ks], bv, accO); } \
        { float* orow = O + (size_t)(b * SEQ + (n_) * 64 + mi * 16 + 4 * fq) * 512 + h * 128 + sl * 32 + nj * 16 + fr; \
          orow[0] = accO[0]; orow[512] = accO[1]; orow[1024] = accO[2]; orow[1536] = accO[3]; } \
          \
        bf16* Sn = St + (cur ^ 1) * 32 * 136; \
        _Pragma("unroll") for (int njj = 0; njj < 2; ++njj) { \
            accS[njj] = accS[njj] * egl##X; \
            _Pragma("unroll") for (int ks = 0; ks < 2; ++ks) { const bf16x8_t bv = *(const bf16x8_t*)(VnT + (njj * 16 + fr) * 72 + ks * 32 + 8 * fq); accS[njj] = mfma16(aKD##X[ks], bv, accS[njj]); } \
            v2u o; o.x = pk2(accS[njj][0], accS[njj][1]); o.y = pk2(accS[njj][2], accS[njj][3]); \
            *(v2u*)(Sn + (njj * 16 + fr) * 136 + wave * 16 + 4 * fq) = o; } \
        cur ^= 1; } while (0)
    constexpr int NTRI = (N1 - N0) / 3, NREM = (N1 - N0) % 3, NM = N0 + 3 * NTRI;
    GS_LOAD(0, N0); GS_LOAD(1, N0 + 1);
#pragma unroll 1
    for (int n = N0; n < NM; n += 3) {
        GS_LOAD(2, n + 2);
        GS_STEP(0, n);
        GS_LOAD(0, n + 3);
        GS_STEP(1, n + 1);
        GS_LOAD(1, n + 4);
        GS_STEP(2, n + 2);
    }
    if (NREM >= 1) { GS_LOAD(2, NM + 2); GS_STEP(0, NM); }
    if (NREM == 2) { GS_LOAD(0, NM + 3); GS_STEP(1, NM + 1); }
    GS_WAITN(0, 0); GS_WAITN(1, 0); GS_WAITN(2, 0);
#undef GS_STEP
#undef GS_DECL
#undef GS_WAIT
#undef GS_WAITN
#undef GS_GLD16
#undef GS_GLD8
    asm volatile("s_waitcnt vmcnt(0)" ::: "memory");
#undef GS_LOAD
    if (N1 == 64) {
#pragma unroll
        for (int njj = 0; njj < 2; ++njj)
#pragma unroll
            for (int r = 0; r < 4; ++r) Sout[(((size_t)b * 4 + h) * 128 + wave * 16 + 4 * fq + r) * 128 + sl * 32 + njj * 16 + fr] = accS[njj][r];
    }
    __syncthreads();
}

__device__ __forceinline__ void lru_prep_unit(const bf16* __restrict__ PROJ, const float* __restrict__ conv_w, const float* __restrict__ conv_b,
                                              const float* __restrict__ w_r, const float* __restrict__ b_r, const float* __restrict__ w_i, const float* __restrict__ b_i, const float* __restrict__ lam,
                                              float* __restrict__ H, float* __restrict__ P, float* __restrict__ Hend, float* __restrict__ Pend, float* __restrict__ p_lru_conv, int ub) {
    int c = threadIdx.x; asm volatile("" : "+v"(c));
    const int nblk = c >> 6, d = c & 63;
    const int n = ub & 63, b = ub >> 6, t0 = b * SEQ + n * 64;
    float wr[64], wi[64];
#pragma unroll
    for (int cc = 0; cc < 64; ++cc) { wr[cc] = w_r[((size_t)nblk * 64 + cc) * 64 + d]; wi[cc] = w_i[((size_t)nblk * 64 + cc) * 64 + d]; }
    const float cw0 = conv_w[c], cw1 = conv_w[512 + c], cw2 = conv_w[1024 + c], cw3 = conv_w[1536 + c], cb_ = conv_b[c];
    const float br = b_r[c], bi = b_i[c], spl = -8.0f * softplusf_(-lam[c]);
    float x0 = (n * 64 - 3 >= 0) ? bf2f(PROJ[(size_t)(t0 - 3) * ABN + C_XR + c]) : 0.f;
    float x1 = (n * 64 - 2 >= 0) ? bf2f(PROJ[(size_t)(t0 - 2) * ABN + C_XR + c]) : 0.f;
    float x2 = (n * 64 - 1 >= 0) ? bf2f(PROJ[(size_t)(t0 - 1) * ABN + C_XR + c]) : 0.f;
    float hloc = 0.f, ploc = 1.f;
    bf16 xa[16], xb[16];
#pragma unroll
    for (int k = 0; k < 16; ++k) xa[k] = PROJ[(size_t)(t0 + k) * ABN + C_XR + c];
#pragma unroll 1
    for (int ib = 0; ib < 64; ib += 16) {
      if (ib + 16 < 64) {
#pragma unroll
        for (int k = 0; k < 16; ++k) xb[k] = PROJ[(size_t)(t0 + ib + 16 + k) * ABN + C_XR + c];
      }
#pragma unroll
      for (int k = 0; k < 16; ++k) {
        const int i = ib + k;
        const float xt = bf2f(xa[k]);
        const float xr = cb_ + cw0 * x0 + cw1 * x1 + cw2 * x2 + cw3 * xt;
        f32x2_t ga = (f32x2_t){br, bi}, gb = (f32x2_t){0.f, 0.f};
#pragma unroll
        for (int cc = 0; cc < 64; cc += 2) {
            const float xa_ = __uint_as_float(__builtin_amdgcn_readlane(__float_as_uint(xr), cc)), xb_ = __uint_as_float(__builtin_amdgcn_readlane(__float_as_uint(xr), cc + 1));
            ga += (f32x2_t){xa_, xa_} * (f32x2_t){wr[cc], wi[cc]}; gb += (f32x2_t){xb_, xb_} * (f32x2_t){wr[cc + 1], wi[cc + 1]};
        }
        ga += gb;
        const float r = __frcp_rn(1.0f + __expf(-ga.x)), ii = __frcp_rn(1.0f + __expf(-ga.y));
        const float a = __expf(spl * r), bb = __fsqrt_rn(fmaxf(1.0f - a * a, 0.f)) * (ii * xr);
        hloc = a * hloc + bb; ploc *= a;
        H[(size_t)(t0 + i) * 512 + c] = hloc; P[(size_t)(t0 + i) * 512 + c] = ploc;
        if (n == 63 && i >= 61) p_lru_conv[((size_t)b * 3 + (i - 61)) * 512 + c] = xt;
        x0 = x1; x1 = x2; x2 = xt;
      }
#pragma unroll
      for (int k = 0; k < 16; ++k) xa[k] = xb[k];
    }
    Hend[(size_t)ub * 512 + c] = hloc; Pend[(size_t)ub * 512 + c] = ploc;
}
constexpr int LR_XR = 64 * 68 * 4;
__device__ __forceinline__ void lru_prep_unit2(const bf16* __restrict__ PROJ, const float* __restrict__ conv_w, const float* __restrict__ conv_b,
                                               const bf16* __restrict__ WRT, const bf16* __restrict__ WIT  , const float* __restrict__ b_r, const float* __restrict__ b_i, const float* __restrict__ lam,
                                               float* __restrict__ H, float* __restrict__ P, float* __restrict__ Hend, float* __restrict__ Pend, float* __restrict__ p_lru_conv, int ub, unsigned char* lds) {
    int tid = threadIdx.x; asm volatile("" : "+v"(tid));
    const int lane = tid & 63, wave = __builtin_amdgcn_readfirstlane(tid >> 6), fr = lane & 15, fq = lane >> 4;
    const int n = ub & 63, b = ub >> 6, t0 = b * SEQ + n * 64;
    float* XR = (float*)(lds + wave * LR_XR);
    {
        const int c = wave * 64 + lane;
        const float cw0 = conv_w[c], cw1 = conv_w[512 + c], cw2 = conv_w[1024 + c], cw3 = conv_w[1536 + c], cb_ = conv_b[c];
        float x0 = (n * 64 - 3 >= 0) ? bf2f(PROJ[(size_t)(t0 - 3) * ABN + C_XR + c]) : 0.f;
        float x1 = (n * 64 - 2 >= 0) ? bf2f(PROJ[(size_t)(t0 - 2) * ABN + C_XR + c]) : 0.f;
        float x2 = (n * 64 - 1 >= 0) ? bf2f(PROJ[(size_t)(t0 - 1) * ABN + C_XR + c]) : 0.f;
        bf16 xa[64];
#pragma unroll
        for (int k = 0; k < 64; ++k) xa[k] = PROJ[(size_t)(t0 + k) * ABN + C_XR + c];
#pragma unroll
        for (int i = 0; i < 64; ++i) {
            const float xt = bf2f(xa[i]);
            XR[i * 68 + lane] = cb_ + cw0 * x0 + cw1 * x1 + cw2 * x2 + cw3 * xt;
            if (n == 63 && i >= 61) p_lru_conv[((size_t)b * 3 + (i - 61)) * 512 + c] = xt;
            x0 = x1; x1 = x2; x2 = xt;
        }
    }
    asm volatile("s_waitcnt lgkmcnt(0)" ::: "memory");
    bf16x8_t bR[4][2], bI[4][2];
#pragma unroll
    for (int nt = 0; nt < 4; ++nt)
#pragma unroll
        for (int ks = 0; ks < 2; ++ks) {
            bR[nt][ks] = *(const bf16x8_t*)(WRT + ((size_t)wave * 64 + nt * 16 + fr) * 64 + ks * 32 + 8 * fq);
            bI[nt][ks] = *(const bf16x8_t*)(WIT + ((size_t)wave * 64 + nt * 16 + fr) * 64 + ks * 32 + 8 * fq);
        }
    float brv[4], biv[4], splv[4];
#pragma unroll
    for (int nt = 0; nt < 4; ++nt) { const int c = wave * 64 + nt * 16 + fr; brv[nt] = b_r[c]; biv[nt] = b_i[c]; splv[nt] = -8.0f * softplusf_(-lam[c]); }
    float hin[4], pin[4];
#pragma unroll
    for (int nt = 0; nt < 4; ++nt) { hin[nt] = 0.f; pin[nt] = 1.f; }
#pragma unroll 1
    for (int mt = 0; mt < 4; ++mt) {
        bf16x8_t aX[2];
#pragma unroll
        for (int ks = 0; ks < 2; ++ks) {
            const f32x4 lo = *(const f32x4*)(XR + (mt * 16 + fr) * 68 + ks * 32 + 8 * fq), hi = *(const f32x4*)(XR + (mt * 16 + fr) * 68 + ks * 32 + 8 * fq + 4);
            v4u w; w.x = pk2(lo.x, lo.y); w.y = pk2(lo.z, lo.w); w.z = pk2(hi.x, hi.y); w.w = pk2(hi.z, hi.w);
            aX[ks] = __builtin_bit_cast(bf16x8_t, w);
        }
#pragma unroll
        for (int nt = 0; nt < 4; ++nt) {
            f32x4 aR = (f32x4){0.f, 0.f, 0.f, 0.f}, aI = aR;
            aR = mfma16(aX[0], bR[nt][0], aR); aR = mfma16(aX[1], bR[nt][1], aR);
            aI = mfma16(aX[0], bI[nt][0], aI); aI = mfma16(aX[1], bI[nt][1], aI);
            float av[4], bv[4];
#pragma unroll
            for (int r = 0; r < 4; ++r) {
                const float rg = __frcp_rn(1.0f + __expf(-(aR[r] + brv[nt]))), ig = __frcp_rn(1.0f + __expf(-(aI[r] + biv[nt])));
                const float a = __expf(splv[nt] * rg);
                av[r] = a; bv[r] = __fsqrt_rn(fmaxf(1.0f - a * a, 0.f)) * (ig * XR[(mt * 16 + 4 * fq + r) * 68 + nt * 16 + fr]);
            }
            float PA[4], PB[4];
            PA[0] = av[0]; PB[0] = bv[0];
#pragma unroll
            for (int r = 1; r < 4; ++r) { PA[r] = av[r] * PA[r - 1]; PB[r] = av[r] * PB[r - 1] + bv[r]; }
            float GA = PA[3], GB = PB[3];
            { const float pa = __shfl_up(GA, 16), pb = __shfl_up(GB, 16); if (fq >= 1) { GB = GA * pb + GB; GA = GA * pa; } }
            { const float pa = __shfl_up(GA, 32), pb = __shfl_up(GB, 32); if (fq >= 2) { GB = GA * pb + GB; GA = GA * pa; } }
            float EA = __shfl_up(GA, 16), EB = __shfl_up(GB, 16);
            if (fq == 0) { EA = 1.f; EB = 0.f; }
            const float h0 = EA * hin[nt] + EB, p0 = pin[nt] * EA;
#pragma unroll
            for (int r = 0; r < 4; ++r) {
                const size_t o = (size_t)(t0 + mt * 16 + 4 * fq + r) * 512 + wave * 64 + nt * 16 + fr;
                H[o] = PA[r] * h0 + PB[r]; P[o] = p0 * PA[r];
            }
            const float TA = __shfl(GA, 48 + fr), TB = __shfl(GB, 48 + fr);
            hin[nt] = TA * hin[nt] + TB; pin[nt] = pin[nt] * TA;
        }
    }
    if (fq == 0) {
#pragma unroll
        for (int nt = 0; nt < 4; ++nt) { Hend[(size_t)ub * 512 + wave * 64 + nt * 16 + fr] = hin[nt]; Pend[(size_t)ub * 512 + wave * 64 + nt * 16 + fr] = pin[nt]; }
    }
    asm volatile("s_waitcnt lgkmcnt(0)" ::: "memory");
}
__device__ __forceinline__ void lru_carry(const float* __restrict__ Hend, const float* __restrict__ Pend, float* __restrict__ CIN, float* __restrict__ hlast, int bx) {
    int tx_ = threadIdx.x; asm volatile("" : "+v"(tx_));
    const int idx = bx * NTH + tx_, b = idx >> 9, c = idx & 511;
    float carry = 0.f;
#pragma unroll 8
    for (int n = 0; n < 64; ++n) {
        const size_t o = ((size_t)b * 64 + n) * 512 + c;
        CIN[o] = carry;
        carry = Hend[o] + Pend[o] * carry;
    }
    hlast[(size_t)b * 512 + c] = carry;
}

__device__ __forceinline__ unsigned f2key(float f) { const unsigned u = __float_as_uint(f); return u ^ ((u >> 31) ? 0xffffffffu : 0x80000000u); }
__device__ __forceinline__ float key2f(unsigned k) { return __uint_as_float(k ^ ((k >> 31) ? 0x80000000u : 0xffffffffu)); }
#define TK_CE(hi, lo) do { const unsigned a_ = (hi), b_ = (lo); (hi) = a_ > b_ ? a_ : b_; (lo) = a_ > b_ ? b_ : a_; } while (0)
template <int N> __device__ __forceinline__ void bitonic_sort_desc(unsigned (&a)[N]) {
#pragma unroll
    for (int k = 2; k <= N; k <<= 1)
#pragma unroll
        for (int j = k >> 1; j > 0; j >>= 1)
#pragma unroll
            for (int i = 0; i < N; ++i) { const int l = i ^ j; if (l > i) { if ((i & k) == 0) TK_CE(a[i], a[l]); else TK_CE(a[l], a[i]); } }
}
template <int XM> __device__ __forceinline__ void merge_top16(unsigned (&a)[16]) {
    unsigned c[16];
#pragma unroll
    for (int i = 0; i < 16; ++i) {
        unsigned o;
        if (XM == 1) o = (unsigned)__builtin_amdgcn_update_dpp(0, (int)a[15 - i], 0xB1, 0xf, 0xf, false);
        else if (XM == 2) o = (unsigned)__builtin_amdgcn_update_dpp(0, (int)a[15 - i], 0x4E, 0xf, 0xf, false);
        else if (XM == 16) o = __builtin_amdgcn_permlane16_swap(a[15 - i], a[15 - i], false, false)[1];
        else o = __builtin_amdgcn_permlane32_swap(a[15 - i], a[15 - i], false, false)[1];
        c[i] = a[i] > o ? a[i] : o; }
#pragma unroll
    for (int j = 8; j > 0; j >>= 1)
#pragma unroll
        for (int i = 0; i < 16; ++i) { const int l = i ^ j; if (l > i) TK_CE(c[i], c[l]); }
#pragma unroll
    for (int i = 0; i < 16; ++i) a[i] = c[i];
}
constexpr int TK_KS = 0, TK_TS = 2 * 128 * 136 * 2, TK_END = TK_TS + 64 * 2 * 16 * 4;
__device__ __forceinline__ void peer_topk_stage_keys(const bf16* __restrict__ KB, int h, unsigned char* lds) {
    bf16* Ks = (bf16*)(lds + TK_KS);
    for (int ci = threadIdx.x; ci < 2 * 128 * 16; ci += NTH) { const int row = ci >> 4, part = ci & 15;
        *(v4u*)(Ks + row * 136 + part * 8) = *(const v4u*)(KB + ((size_t)h * 256 + row) * 128 + part * 8); }
    __syncthreads();
}
__device__ __forceinline__ void peer_topk_ldq(bf16x8_t (&bq)[4], const bf16* __restrict__ Q, int tile, int h, int tid) {
    const int lane = tid & 63, wave = tid >> 6, fr = lane & 15, fq = lane >> 4, c = wave >> 2, nt = wave & 3;
#pragma unroll
    for (int ks = 0; ks < 4; ++ks) bq[ks] = *(const bf16x8_t*)(Q + (size_t)(tile * 64 + nt * 16 + fr) * 2048 + h * 256 + c * 128 + ks * 32 + 8 * fq);
}
__device__ __forceinline__ void peer_topk4(const bf16* __restrict__ Q, int* __restrict__ EXP, float* __restrict__ GATE, int tile, int h, unsigned char* lds, bf16x8_t (&bq)[4], int tile_next) {
    int tid = threadIdx.x; asm volatile("" : "+v"(tid));
    const int lane = tid & 63, wave = __builtin_amdgcn_readfirstlane(tid >> 6), fr = lane & 15, fq = lane >> 4;
    const bf16* Ks = (const bf16*)(lds + TK_KS); unsigned* Ts = (unsigned*)(lds + TK_TS);
    {
        const int c = wave >> 2, nt = wave & 3;
        unsigned a[32];
#pragma unroll
        for (int mt = 0; mt < 8; ++mt) {
            f32x4 acc = (f32x4){0.f, 0.f, 0.f, 0.f};
#pragma unroll
            for (int ks = 0; ks < 4; ++ks) { const bf16x8_t ak = *(const bf16x8_t*)(Ks + (c * 128 + mt * 16 + fr) * 136 + ks * 32 + 8 * fq); acc = mfma16(ak, bq[ks], acc); }
#pragma unroll
            for (int r = 0; r < 4; ++r) a[mt * 4 + r] = (f2key(acc[r]) & ~127u) | (unsigned)(127 - (mt * 16 + 4 * fq + r));
        }
        if (tile_next >= 0) peer_topk_ldq(bq, Q, tile_next, h, tid);
        bitonic_sort_desc<32>(a);
        unsigned t[16];
#pragma unroll
        for (int j = 0; j < 16; ++j) t[j] = a[j];
        merge_top16<16>(t); merge_top16<32>(t);
        if (fq == 0) {
            const int tk = nt * 16 + fr;
#pragma unroll
            for (int j = 0; j < 16; ++j) Ts[(tk * 2 + c) * 16 + j] = t[j];
        }
    }
    __syncthreads();
    if (tid < 256) {
        const int tk = tid >> 2, q = tid & 3;
        const unsigned* t0 = Ts + (tk * 2 + 0) * 16; const unsigned* t1 = Ts + (tk * 2 + 1) * 16;
        unsigned a[16];
#pragma unroll
        for (int s = 0; s < 13; ++s) {
            const int e = s * 4 + q;
            int i, j;
            if (e < 16) { i = 0; j = e; } else if (e < 24) { i = 1; j = e - 16; } else if (e < 29) { i = 2; j = e - 24; } else if (e < 33) { i = 3; j = e - 29; }
            else if (e < 36) { i = 4; j = e - 33; } else if (e < 42) { i = 5 + ((e - 36) >> 1); j = (e - 36) & 1; } else { i = 8 + (e - 42); j = 0; }
            const bool ok = e < 50;
            const float sum = key2f(t0[ok ? i : 0] & ~127u) + key2f(t1[ok ? j : 0] & ~127u);
            a[s] = ok ? ((f2key(sum) & ~255u) | (unsigned)(255 - (i * 16 + j))) : 0u;
        }
        a[13] = 0u; a[14] = 0u; a[15] = 0u;
        bitonic_sort_desc<16>(a);
        merge_top16<1>(a); merge_top16<2>(a);
        float ev[16], sum = 0.f; const float m = key2f(a[0] & ~255u);
#pragma unroll
        for (int j = 0; j < 16; ++j) { ev[j] = __expf(key2f(a[j] & ~255u) - m); sum += ev[j]; }
        const float inv = 1.0f / sum;
        const size_t o = (size_t)(tile * 64 + tk) * 128 + h * 16;
#pragma unroll
        for (int j = 0; j < 16; ++j)
            if ((j >> 2) == q) {
                const int code = 255 - (int)(a[j] & 255u), i = code >> 4, jj = code & 15;
                const int n0 = 127 - (int)(t0[i] & 127u), n1 = 127 - (int)(t1[jj] & 127u);
                EXP[o + j] = n0 * 128 + n1; GATE[o + j] = ev[j] * inv;
            }
    }
    __syncthreads();
}

constexpr int AT_KS = 0, AT_VT = 192 * 72 * 2, AT_BT = AT_VT + 64 * 200 * 2, AT_PW = AT_BT + 4 * 256 * 4, AT_END = AT_PW + 8 * 32 * 72 * 2;
template <int QS>
__device__ __forceinline__ void attn_core(const bf16* __restrict__ PCb, const float* __restrict__ sinks, bf16* __restrict__ ATT, int kvh, int q0, int tb, int wave, int lane, int fr, int fq,
                                          const bf16* Ks, const bf16* Vt, const float* Bt, bf16* Pw) {
    constexpr int NT0 = QS ? 2 : 0;
    const int g = wave >> 1, hh = kvh * 4 + g; constexpr int qs = QS;
    bf16x8_t aQ[2][2];
#pragma unroll
    for (int mt = 0; mt < 2; ++mt)
#pragma unroll
        for (int ks = 0; ks < 2; ++ks) aQ[mt][ks] = *(const bf16x8_t*)(PCb + (size_t)(tb + q0 + qs + mt * 16 + fr) * CN + hh * 64 + ks * 32 + 8 * fq);
    f32x4 sc[2][12];
#pragma unroll
    for (int nt = NT0; nt < NT0 + 10; ++nt) {
        const bf16x8_t b0 = *(const bf16x8_t*)(Ks + (nt * 16 + fr) * 72 + 8 * fq), b1 = *(const bf16x8_t*)(Ks + (nt * 16 + fr) * 72 + 32 + 8 * fq);
#pragma unroll
        for (int mt = 0; mt < 2; ++mt) { f32x4 a = (f32x4){0.f, 0.f, 0.f, 0.f}; a = mfma16(aQ[mt][0], b0, a); a = mfma16(aQ[mt][1], b1, a); sc[mt][nt] = a; }
    }
    const float sink = sinks[hh] * 1.4426950408889634f;
    const float* bt = Bt + g * 256 + 64;
    float rinv[2][4];
    float kadd[12];
#pragma unroll
    for (int nt = NT0; nt < NT0 + 10; ++nt) kadd[nt] = (q0 - 128 + nt * 16 + fr) >= 0 ? 0.f : -INFINITY;
#pragma unroll
    for (int mt = 0; mt < 2; ++mt)
#pragma unroll
        for (int r = 0; r < 4; ++r) {
            const int qi = qs + mt * 16 + 4 * fq + r;
            float mx = sink;
#pragma unroll
            for (int nt = NT0; nt < NT0 + 10; ++nt) {
                const int kk = nt * 16 + fr, rel = qi + 128 - kk;
                const float lg = (sc[mt][nt][r] * (0.125f * 1.4426950408889634f) + bt[rel]) + kadd[nt];
                sc[mt][nt][r] = lg; mx = fmaxf(mx, lg);
            }
            mx = fmaxf(mx, DPPF(mx, 0xB1, 0xf)); mx = fmaxf(mx, DPPF(mx, 0x4E, 0xf)); mx = fmaxf(mx, DPPF(mx, 0x141, 0xf)); mx = fmaxf(mx, DPPF(mx, 0x140, 0xf));
            float sum = 0.f;
#pragma unroll
            for (int nt = NT0; nt < NT0 + 10; ++nt) { const float p = __builtin_amdgcn_exp2f(sc[mt][nt][r] - mx); sc[mt][nt][r] = p; sum += p; }
            sum += DPPF(sum, 0xB1, 0xf); sum += DPPF(sum, 0x4E, 0xf); sum += DPPF(sum, 0x141, 0xf); sum += DPPF(sum, 0x140, 0xf);
            rinv[mt][r] = 1.0f / (sum + __builtin_amdgcn_exp2f(sink - mx));
        }
    f32x4 oacc[2][4];
#pragma unroll
    for (int mt = 0; mt < 2; ++mt)
#pragma unroll
        for (int dt = 0; dt < 4; ++dt) oacc[mt][dt] = (f32x4){0.f, 0.f, 0.f, 0.f};
#pragma unroll
    for (int kc = 0; kc < 3; ++kc) {
#pragma unroll
        for (int mt = 0; mt < 2; ++mt)
#pragma unroll
            for (int n4 = 0; n4 < 4; ++n4)
#pragma unroll
                for (int r = 0; r < 4; ++r) if (kc * 4 + n4 >= NT0 && kc * 4 + n4 < NT0 + 10) Pw[(mt * 16 + 4 * fq + r) * 72 + n4 * 16 + fr] = (bf16)f2bf(sc[mt][kc * 4 + n4][r]);
        asm volatile("s_waitcnt lgkmcnt(0)" ::: "memory");
#pragma unroll
        for (int ks = 0; ks < 2; ++ks) {
            if (kc * 4 + ks * 2 < NT0 || kc * 4 + ks * 2 >= NT0 + 10) continue;
            const bf16x8_t p0 = *(const bf16x8_t*)(Pw + fr * 72 + ks * 32 + 8 * fq), p1 = *(const bf16x8_t*)(Pw + (16 + fr) * 72 + ks * 32 + 8 * fq);
#pragma unroll
            for (int dt = 0; dt < 4; ++dt) {
                const bf16x8_t bv = *(const bf16x8_t*)(Vt + (dt * 16 + fr) * 200 + kc * 64 + ks * 32 + 8 * fq);
                oacc[0][dt] = mfma16(p0, bv, oacc[0][dt]); oacc[1][dt] = mfma16(p1, bv, oacc[1][dt]);
            }
        }
        asm volatile("s_waitcnt lgkmcnt(0)" ::: "memory");
    }
#pragma unroll
    for (int mt = 0; mt < 2; ++mt)
#pragma unroll
        for (int dt = 0; dt < 4; ++dt)
#pragma unroll
            for (int r = 0; r < 4; ++r) Pw[(mt * 16 + 4 * fq + r) * 72 + dt * 16 + fr] = (bf16)f2bf(oacc[mt][dt][r] * rinv[mt][r]);
    asm volatile("s_waitcnt lgkmcnt(0)" ::: "memory");
#pragma unroll
    for (int k = 0; k < 4; ++k) {
        const int ci = lane + 64 * k, row = ci >> 3, part = ci & 7;
        *(v4u*)(ATT + (size_t)(tb + q0 + qs + row) * D + hh * 64 + part * 8) = *(const v4u*)(Pw + row * 72 + part * 8);
    }
}
__device__ __forceinline__ void attn_unit(const bf16* __restrict__ PCb, const float* __restrict__ rel_bias, const float* __restrict__ sinks, bf16* __restrict__ ATT, int un, unsigned char* lds) {
    int tid = threadIdx.x; asm volatile("" : "+v"(tid));
    const int lane = tid & 63, wave = __builtin_amdgcn_readfirstlane(tid >> 6), fr = lane & 15, fq = lane >> 4;
    const int kvh = un & 3, qblk = (un >> 2) & 63, b = un >> 8;
    const int q0 = qblk * 64, tb = b * SEQ;
    bf16* Ks = (bf16*)(lds + AT_KS); bf16* Vt = (bf16*)(lds + AT_VT); float* Bt = (float*)(lds + AT_BT); bf16* Pw = (bf16*)(lds + AT_PW) + wave * 32 * 72;
#pragma unroll
    for (int k = 0; k < 3; ++k) {
        const int ci = tid + 512 * k, row = ci >> 3, part = ci & 7, kpos = q0 - 128 + row;
        v4u kv = (v4u){0u, 0u, 0u, 0u}, vv = kv;
        if (kpos >= 0) { const bf16* src = PCb + (size_t)(tb + kpos) * CN + kvh * 64 + part * 8; kv = *(const v4u*)(src + 1024); vv = *(const v4u*)(src + 1280); }
        *(v4u*)(Ks + row * 72 + part * 8) = kv;
        bf16* vd = Vt + (part * 8) * 200 + row;
        vd[0 * 200] = (bf16)(vv.x & 0xffffu); vd[1 * 200] = (bf16)(vv.x >> 16); vd[2 * 200] = (bf16)(vv.y & 0xffffu); vd[3 * 200] = (bf16)(vv.y >> 16);
        vd[4 * 200] = (bf16)(vv.z & 0xffffu); vd[5 * 200] = (bf16)(vv.z >> 16); vd[6 * 200] = (bf16)(vv.w & 0xffffu); vd[7 * 200] = (bf16)(vv.w >> 16);
    }
#pragma unroll
    for (int k = 0; k < 2; ++k) { const int idx = tid + 512 * k, g_ = idx >> 8, rel = (idx & 255) - 64;
        Bt[idx] = (rel >= 0 && rel < 128) ? rel_bias[t5_bucket(rel) * 16 + kvh * 4 + g_] * 1.4426950408889634f : -INFINITY; }
    __syncthreads();
    if (wave & 1) attn_core<32>(PCb, sinks, ATT, kvh, q0, tb, wave, lane, fr, fq, Ks, Vt, Bt, Pw);
    else attn_core<0>(PCb, sinks, ATT, kvh, q0, tb, wave, lane, fr, fq, Ks, Vt, Bt, Pw);
    __syncthreads();
}

__device__ __forceinline__ void swa_attn_sample(const bf16* __restrict__ PCb, const float* __restrict__ cache_k, const float* __restrict__ cache_v,
                                                const float* __restrict__ rel_bias, const float* __restrict__ sinks, bf16* __restrict__ ATT, int gw, int lane) {
    const int sb = gw >> 4, h = gw & 15, kvh = h >> 2, t = NP + sb;
    const bf16* qrow = PCb + (size_t)t * CN + h * 64;
    float lg[2];
#pragma unroll
    for (int rr = 0; rr < 2; ++rr) {
        const int r = lane + 64 * rr;
        float dot = 0.f;
        if (r == 0) {
            const bf16* krow = PCb + (size_t)t * CN + 1024 + kvh * 64;
            for (int d = 0; d < 64; ++d) dot += bf2f(qrow[d]) * bf2f(krow[d]);
        } else {
            const float* krow = cache_k + (((size_t)sb * 128 + (128 - r)) * 4 + kvh) * 64;
#pragma unroll
            for (int d4 = 0; d4 < 16; ++d4) { const float4 kv = *(const float4*)(krow + d4 * 4);
                dot += bf2f(qrow[d4 * 4]) * kv.x + bf2f(qrow[d4 * 4 + 1]) * kv.y + bf2f(qrow[d4 * 4 + 2]) * kv.z + bf2f(qrow[d4 * 4 + 3]) * kv.w; }
        }
        lg[rr] = dot * 0.125f + rel_bias[t5_bucket(r) * 16 + h];
    }
    const float sink = sinks[h];
    const float m = fmaxf(wave_max(fmaxf(lg[0], lg[1])), sink);
    float p[2] = {expf(lg[0] - m), expf(lg[1] - m)};
    const float inv = 1.0f / (wave_sum(p[0] + p[1]) + expf(sink - m));
    float o = 0.f;
#pragma unroll
    for (int rr = 0; rr < 2; ++rr)
#pragma unroll 1
        for (int lb = 0; lb < 64; lb += 16) {
            float vv[16];
#pragma unroll
            for (int k = 0; k < 16; ++k) { const int r = lb + k + 64 * rr;
                vv[k] = (r == 0) ? bf2f(PCb[(size_t)t * CN + 1280 + kvh * 64 + lane]) : cache_v[(((size_t)sb * 128 + (128 - r)) * 4 + kvh) * 64 + lane]; }
#pragma unroll
            for (int k = 0; k < 16; ++k) o += __shfl(p[rr], lb + k) * vv[k];
        }
    ATT[(size_t)t * D + h * 64 + lane] = (bf16)f2bf(o * inv);
}
__device__ __forceinline__ void swa_cache_shift(const float* __restrict__ cache_k, const float* __restrict__ cache_v, float* __restrict__ sk, float* __restrict__ sv, int item) {
    int tid = threadIdx.x; asm volatile("" : "+v"(tid));
    const int sb = item >> 1, isv = item & 1;
    const f32x4* src = (const f32x4*)((isv ? cache_v : cache_k) + ((size_t)sb * 128 + 1) * 256);
    f32x4* dst = (f32x4*)((isv ? sv : sk) + (size_t)sb * 128 * 256);
    f32x4 v[16];
#pragma unroll
    for (int k = 0; k < 16; ++k) { const int i = tid + NTH * k; if (i < 127 * 64) v[k] = src[i]; }
#pragma unroll
    for (int k = 0; k < 16; ++k) { const int i = tid + NTH * k; if (i < 127 * 64) dst[i] = v[k]; }
}
__device__ __forceinline__ void swa_kv_out3(const bf16* __restrict__ PCb, const float* __restrict__ cache_k, const float* __restrict__ cache_v,
                                            float* __restrict__ pk, float* __restrict__ pv, float* __restrict__ sk, float* __restrict__ sv, int item) {
    int tid = threadIdx.x; asm volatile("" : "+v"(tid));
    if (item < 256) {
        const int sb = item >> 1, isv = item & 1;
        const f32x4* src = (const f32x4*)((isv ? cache_v : cache_k) + ((size_t)sb * 128 + 1) * 256);
        f32x4* dst = (f32x4*)((isv ? sv : sk) + (size_t)sb * 128 * 256);
        (void)src;
        if (tid < 32) {
            const v4u w = *(const v4u*)(PCb + (size_t)(NP + sb) * CN + 1024 + isv * 256 + tid * 8);
            f32x4* d = dst + 127 * 64 + tid * 2;
            d[0] = (f32x4){bflo(w.x), bfhi(w.x), bflo(w.y), bfhi(w.y)}; d[1] = (f32x4){bflo(w.z), bfhi(w.z), bflo(w.w), bfhi(w.w)};
        }
    } else {
        const int b = item - 256;
#pragma unroll 4
        for (int e = tid; e < 128 * 64; e += NTH) {
            const int row = e >> 6, part = e & 63;
            const v4u w = *(const v4u*)(PCb + (size_t)(b * SEQ + SEQ - 128 + row) * CN + 1024 + part * 8);
            f32x4* d = (f32x4*)((part < 32 ? pk : pv) + ((size_t)b * 128 + row) * 256 + (part & 31) * 8);
            d[0] = (f32x4){bflo(w.x), bfhi(w.x), bflo(w.y), bfhi(w.y)}; d[1] = (f32x4){bflo(w.z), bfhi(w.z), bflo(w.w), bfhi(w.w)};
        }
    }
}


constexpr int PC_STRIDE = 1040, PC_RED = 80 * PC_STRIDE;
template <class StoreF>
__device__ __forceinline__ void gemm_piece80(const bf16* __restrict__ arows, const bf16* __restrict__ brows, unsigned char* lds, const StoreF& store) {
    int tid = threadIdx.x; asm volatile("" : "+v"(tid));
    const int lane = tid & 63, wave = __builtin_amdgcn_readfirstlane(tid >> 6), fr = lane & 15, fq = lane >> 4;
    const int rsel = tid >> 6, ch = tid & 63, nt = wave & 3, kq = wave >> 2;
    v4u st[2][10];
#pragma unroll
    for (int h = 0; h < 2; ++h)
#pragma unroll
        for (int r = 0; r < 10; ++r) {
            const bf16* src = (r < 2 ? arows + (size_t)(r * 8 + rsel) * D : brows + (size_t)(r * 8 + rsel - 16) * D) + h * 512 + ch * 8;
            st[h][r] = *(const v4u*)src;
        }
    f32x4 acc = (f32x4){0.f, 0.f, 0.f, 0.f};
#pragma unroll
    for (int h = 0; h < 2; ++h) {
        if (h) __syncthreads();
#pragma unroll
        for (int r = 0; r < 10; ++r) *(v4u*)(lds + (r * 8 + rsel) * PC_STRIDE + ch * 16) = st[h][r];
        __syncthreads();
#pragma unroll
        for (int ks = 0; ks < 8; ++ks) {
            const bf16x8_t a = *(const bf16x8_t*)(lds + fr * PC_STRIDE + (kq * 256 + ks * 32 + 8 * fq) * 2);
            const bf16x8_t b = *(const bf16x8_t*)(lds + (16 + nt * 16 + fr) * PC_STRIDE + (kq * 256 + ks * 32 + 8 * fq) * 2);
            acc = mfma16(a, b, acc);
        }
    }
    f32x4* part = (f32x4*)(lds + PC_RED);
    if (kq == 1) part[nt * 64 + lane] = acc;
    __syncthreads();
    if (kq == 0) { acc = acc + part[nt * 64 + lane]; store(acc, nt, fr, fq); }
}
__device__ __forceinline__ void sample_gemm_piece(const bf16* __restrict__ A, const bf16* __restrict__ Bt, const float* __restrict__ bias, bf16* __restrict__ O, int ldc, int p, unsigned char* lds) {
    const int mt = p & 7, cb = p >> 3;
    gemm_piece80(A + (size_t)(NP + mt * 16) * D, Bt + (size_t)(cb * 64) * D, lds, [&](const f32x4& acc, int nt, int fr, int fq) {
        const int col = cb * 64 + nt * 16 + fr; const float bv = bias ? bias[col] : 0.f;
#pragma unroll
        for (int r = 0; r < 4; ++r) O[(size_t)(NP + mt * 16 + 4 * fq + r) * ldc + col] = (bf16)f2bf(acc[r] + bv);
    });
}
__device__ __forceinline__ void ab_cols_piece(const bf16* __restrict__ A, const bf16* __restrict__ Bt, bf16* __restrict__ O, int tg, unsigned char* lds) {
    gemm_piece80(Bt + (size_t)ABMAIN * D, A + (size_t)(tg * 64) * D, lds, [&](const f32x4& acc, int nt, int fr, int fq) {
        if (fq < 2) { uint2 o; o.x = pk2(acc[0], acc[1]); o.y = pk2(acc[2], acc[3]); *(uint2*)(O + (size_t)(tg * 64 + nt * 16 + fr) * ABN + ABMAIN + 4 * fq) = o; }
    });
}

constexpr size_t MiB = 1u << 20;
constexpr size_t WS_CTL = 0, CTL_ZERO_BYTES = 64 * 1024;
constexpr size_t WS_WAB = 1 * MiB;
constexpr size_t WS_WOUT = WS_WAB + (size_t)ABNP * D * 2;
constexpr size_t WS_WQ0 = WS_WOUT + (size_t)D * D * 2;
constexpr size_t WS_WQ1 = WS_WQ0 + (size_t)2048 * D * 2;
constexpr size_t WS_WINC = WS_WQ1 + (size_t)2048 * D * 2;
constexpr size_t WS_WOUTC = WS_WINC + (size_t)CN * D * 2;
constexpr size_t WS_ABUF = WS_WOUTC + (size_t)D * D * 2;
constexpr size_t WS_P = WS_ABUF + (size_t)MP * D * 2;
constexpr size_t WS_T = WS_P + (size_t)MP * ABN * 2;
constexpr size_t WS_Q = WS_T + (size_t)4 * 16384 * D + (size_t)4 * 16384 * 4;
constexpr size_t WS_A = WS_Q + (size_t)MP * 1536 * 4;
constexpr size_t WS_B = WS_A + (size_t)MP * 512 * 4;
constexpr size_t WS_O = WS_B + (size_t)MP * 512 * 4;
constexpr size_t WS_X1 = WS_O + (size_t)MP * 512 * 4;
constexpr size_t WS_G = WS_X1 + (size_t)MP * D * 4;
constexpr size_t WS_BETA = WS_G + (size_t)MP * 4 * 4;
constexpr size_t WS_GATE = WS_BETA + (size_t)MP * 4 * 4;
constexpr size_t WS_EXP = WS_GATE + (size_t)MP * 128 * 4;
constexpr size_t WS_HEND = WS_EXP + (size_t)MP * 128 * 4;
constexpr size_t WS_KEYS = WS_HEND + (size_t)3 * 4 * 64 * 512 * 4;
constexpr size_t WS_WGT = WS_KEYS + (size_t)2 * 8 * 2 * 128 * 128 * 2;
constexpr size_t WS_END = WS_WGT + (size_t)2 * 8 * 64 * 64 * 2;
constexpr size_t Q_QKVS = 0, Q_W = 1 * MiB, Q_QG = Q_W + 16 * MiB, Q_KDT = Q_QG + 16 * MiB, Q_UT = Q_KDT + 16 * MiB, Q_QK = Q_UT + 16 * MiB, Q_EGL = Q_QK + 8 * MiB, Q_END = Q_EGL + 4096;
static_assert(Q_END <= (size_t)MP * 1536 * 4, "region Q");
static_assert(WS_END <= 512 * MiB, "d_ws map");

struct MegaArgs {
    const float* in[35];
    float* out;
    unsigned char* ws;
};

__global__ void __launch_bounds__(NTH, 2) fwd_megakernel(MegaArgs ma) {
    cg::grid_group grid = cg::this_grid();
    extern __shared__ __attribute__((aligned(16))) unsigned char lds[];
    float* smem = (float*)lds;
    const int nb = gridDim.x, b0 = blockIdx.x, wave = __builtin_amdgcn_readfirstlane(threadIdx.x >> 6);
    int tid = threadIdx.x, lane = tid & 63;
    const float* x_prompt = ma.in[0];
    const float* x_sample = ma.in[1];
    const float* state_gdn = ma.in[2];
    const float* state_gdn_conv = ma.in[3];
    const float* state_lru = ma.in[4];
    const float* state_lru_conv = ma.in[5];
    const float* cache_k = ma.in[6];
    const float* cache_v = ma.in[7];
    const float* w_in_ab = ma.in[8];
    const float* gdn_conv_w = ma.in[9];
    const float* gdn_a_log = ma.in[10];
    const float* gdn_dt_bias = ma.in[11];
    const float* gdn_norm_w = ma.in[12];
    const float* lru_conv_w = ma.in[13];
    const float* lru_conv_b = ma.in[14];
    const float* lru_w_r = ma.in[15];
    const float* lru_b_r = ma.in[16];
    const float* lru_w_i = ma.in[17];
    const float* lru_b_i = ma.in[18];
    const float* lru_lam = ma.in[19];
    const float* w_out_ab = ma.in[20];
    const float* w_in_c = ma.in[21];
    const float* b_in_c = ma.in[22];
    const float* swa_sinks = ma.in[23];
    const float* w_out_c = ma.in[24];
    const float* b_out_c = ma.in[25];
    const float* rel_bias = ma.in[26];
    const float* ln_mix_g = ma.in[27];
    const float* ln_mix_b = ma.in[28];
    const float* ln_ffn_g = ma.in[29];
    const float* ln_ffn_b = ma.in[30];
    const float* peer_w_q = ma.in[31];
    const float* peer_keys = ma.in[32];
    const float* peer_u = ma.in[33];
    const float* peer_v = ma.in[34];

    float* out = ma.out;
    float* o_y = out;
    float* o_p_gdn = out + (size_t)NT * D;
    float* o_p_gdn_conv = o_p_gdn + 262144;
    float* o_p_lru = o_p_gdn_conv + 18432;
    float* o_p_lru_conv = o_p_lru + 2048;
    float* o_p_k = o_p_lru_conv + 6144;
    float* o_p_v = o_p_k + 131072;
    float* o_s_gdn = o_p_v + 131072;
    float* o_s_gdn_conv = o_s_gdn + 8388608;
    float* o_s_lru = o_s_gdn_conv + 589824;
    float* o_s_lru_conv = o_s_lru + 65536;
    float* o_s_k = o_s_lru_conv + 196608;
    float* o_s_v = o_s_k + 4194304;

    unsigned char* ws = ma.ws;
    bf16* WAB_T = (bf16*)(ws + WS_WAB); bf16* WOUT_T = (bf16*)(ws + WS_WOUT); bf16* WQ0_T = (bf16*)(ws + WS_WQ0); bf16* WQ1_T = (bf16*)(ws + WS_WQ1);
    bf16* WINC_T = (bf16*)(ws + WS_WINC); bf16* WOUTC_T = (bf16*)(ws + WS_WOUTC);
    bf16* ABUF = (bf16*)(ws + WS_ABUF);
    bf16* PROJ = (bf16*)(ws + WS_P); float* Y = (float*)(ws + WS_P); bf16* Qb = (bf16*)(ws + WS_P); bf16* PCb = (bf16*)(ws + WS_P); float* Y1 = (float*)(ws + WS_P);
    unsigned char* TAB8 = ws + WS_T; float* TSC = (float*)(ws + WS_T + (size_t)4 * 16384 * D);
    float* R_Q = (float*)(ws + WS_Q + Q_QKVS) - (size_t)NP * 1536; float* X2 = (float*)(ws + WS_A);
    GdnChunkBufs cbuf; cbuf.W = (bf16*)(ws + WS_Q + Q_W); cbuf.QG = (bf16*)(ws + WS_Q + Q_QG); cbuf.KDT = (bf16*)(ws + WS_Q + Q_KDT); cbuf.UT = (bf16*)(ws + WS_Q + Q_UT); cbuf.QK = (bf16*)(ws + WS_Q + Q_QK); cbuf.EGL = (float*)(ws + WS_Q + Q_EGL);
    bf16* Yb = (bf16*)(ws + WS_P);
    float* OUTS = (float*)(ws + WS_Q);
    float* PD = (float*)(ws + WS_P);
    bf16* KEYSB = (bf16*)(ws + WS_KEYS); bf16* WRT = (bf16*)(ws + WS_WGT); bf16* WIT = WRT + 8 * 64 * 64;
    float* HEND = (float*)(ws + WS_HEND); float* PEND = HEND + 4 * 64 * 512; float* CIN = PEND + 4 * 64 * 512;
    float* R_A = (float*)(ws + WS_A); float* R_B = (float*)(ws + WS_B); float* R_O = (float*)(ws + WS_O);
    bf16* ATTB = (bf16*)(ws + WS_X1);
    float* R_G = (float*)(ws + WS_G); float* R_BETA = (float*)(ws + WS_BETA); float* R_GATE = (float*)(ws + WS_GATE); int* R_EXP = (int*)(ws + WS_EXP);

    for (int u = tid; u < (LDS_BYTES - RING_BYTES) / 4; u += NTH) ((unsigned*)(lds + RING_BYTES))[u] = 0u;
    __syncthreads();
    XcdBarrier bar = xcd_barrier_post((unsigned*)(ws + WS_CTL), (volatile LAS unsigned*)((LAS unsigned char*)lds + MISC_OFF) + 8);
#define GRID_BAR() do { xcd_barrier(bar); asm volatile("" : "+v"(tid)); lane = tid & 63; } while (0)
#define PHASE_LOOP(n) for (int vb = b0; vb < (n); vb += nb)
#define PHASE_END __syncthreads()
#define GEMM_PHASE_M(Mrows, EPI, Aptr, Btptr, Nn, ...) do { pg8::Gemm g_{(const pg8::bf16_t*)(Aptr), (const pg8::bf16_t*)(Btptr), (Mrows), (Nn), D}; pg8::StaticOrder S_; S_.init((Mrows), (Nn), nb, b0); \
        pg8::EPI E_{__VA_ARGS__}; pg8::gemm_phase<pg8::EPI, pg8::StaticOrder, true, true>((PG8_LAS unsigned char*)lds, g_, S_, E_); } while (0)
#define GEMM_PHASE(EPI, Aptr, Btptr, Nn, ...) GEMM_PHASE_M(MP, EPI, Aptr, Btptr, Nn, __VA_ARGS__)
#define GEMM_PHASE_SPLIT(Aptr, Btptr, Nn, Optr, biasptr) do { GEMM_PHASE_M(NP, EpiStoreBf16, Aptr, Btptr, Nn, Optr, Nn, biasptr, NP, Nn); \
          \
        for (int j_ = b0 >> 3; (b0 & 7) + 8 * (j_ >> 3) < (Nn) / 64; j_ += nb >> 3) sample_gemm_piece(Aptr, Btptr, biasptr, Optr, Nn, (j_ & 7) | (((b0 & 7) + 8 * (j_ >> 3)) << 3), lds); } while (0)

    {
        float* scr = smem + wave * 4096;
        const int gw = b0 * NWAVES + wave, NGW = nb * NWAVES;
        constexpr int I_AB = 16 * 97, I_OUT = 16 * 32, I_Q = 16 * 64, I_INC = 16 * 48;
        constexpr int NITEMS = I_AB + I_OUT + 2 * I_Q + I_INC + I_OUT;
        for (int it = gw; it < I_AB; it += NGW) p0_transpose_item<true>(w_in_ab, D, ABN, WAB_T, scr, it, lane);
        for (int it = b0 * NTH + tid; it < 2 * 8 * 64 * 8; it += nb * NTH) {
            const int gsel = it >> 12, nn = (it >> 9) & 7, dd = (it >> 3) & 63, c8 = (it & 7) * 8;
            const float* wsrc = (gsel ? lru_w_i : lru_w_r) + ((size_t)nn * 64 + c8) * 64 + dd;
            v4u o; o.x = pk2(wsrc[0], wsrc[64]); o.y = pk2(wsrc[128], wsrc[192]); o.z = pk2(wsrc[256], wsrc[320]); o.w = pk2(wsrc[384], wsrc[448]);
            *(v4u*)((gsel ? WIT : WRT) + ((size_t)nn * 64 + dd) * 64 + c8) = o;
        }
        for (int kb = 0; kb < NP / 2048; kb += 4) {
            f32x4 v4_[4][4];
#pragma unroll
            for (int i = 0; i < 4; ++i)
#pragma unroll
                for (int j = 0; j < 4; ++j) v4_[i][j] = ((const f32x4*)(x_prompt + (size_t)(gw + (kb + i) * 2048) * D))[lane + 64 * j];
#pragma unroll
            for (int i = 0; i < 4; ++i)
#pragma unroll
                for (int j = 0; j < 4; ++j) { v2u o; o.x = pk2(v4_[i][j].x, v4_[i][j].y); o.y = pk2(v4_[i][j].z, v4_[i][j].w); ((v2u*)(ABUF + (size_t)(gw + (kb + i) * 2048) * D))[lane + 64 * j] = o; }
        }
        for (int m = NP + gw; m < MP + (ABNP - 97 * 32); m += NGW) {
            if (m < MP) row_to_bf16(m < NP ? x_prompt + (size_t)m * D : (m < NT ? x_sample + (size_t)(m - NP) * D : nullptr), ABUF + (size_t)m * D, lane);
            else row_to_bf16(nullptr, WAB_T + (size_t)(97 * 32 + (m - MP)) * D, lane);
        }
    }
    GRID_BAR();
    if (ma.out == nullptr) grid.sync();
    GEMM_PHASE(EpiStoreBf16, ABUF, WAB_T, ABNP, PROJ, ABN, nullptr, NT, ABN);
    GRID_BAR();
    ConvJob cjob; cjob.u0 = peer_u; cjob.v0 = peer_v; cjob.tab = TAB8; cjob.tsc = TSC;
    constexpr int NSPLIT = 32, A_LRU = 4 * NSPLIT, A_GDN = 16 * NSPLIT, B_LRU = 4 * (64 - NSPLIT), B_GDN = 16 * (64 - NSPLIT);
    { AbPrepArgs pa;
      pa.PROJ = PROJ; pa.st_gdn_conv = state_gdn_conv; pa.st_lru_conv = state_lru_conv;
      pa.gdn_conv_w = gdn_conv_w; pa.a_log = gdn_a_log; pa.dt_bias = gdn_dt_bias;
      pa.lru_conv_w = lru_conv_w; pa.lru_conv_b = lru_conv_b; pa.w_r = lru_w_r; pa.b_r = lru_b_r; pa.w_i = lru_w_i; pa.b_i = lru_b_i; pa.lam = lru_lam;
      pa.QKV = R_Q; pa.G = R_G; pa.BETA = R_BETA; pa.LA = R_A; pa.LB = R_B;
      pa.p_gdn_conv = o_p_gdn_conv; pa.p_lru_conv = o_p_lru_conv; pa.s_gdn_conv = o_s_gdn_conv; pa.s_lru_conv = o_s_lru_conv;
      for (int v = b0; v < A_LRU + NS + A_GDN; v += nb) {
          if (v < A_LRU) { lru_prep_unit2(PROJ, lru_conv_w, lru_conv_b, WRT, WIT, lru_b_r, lru_b_i, lru_lam, R_B, R_A, HEND, PEND, o_p_lru_conv, (v / NSPLIT) * 64 + (v % NSPLIT), lds); PHASE_END; }
          else if (v < A_LRU + NS) { ab_prep(pa, NP + (v - A_LRU), smem); PHASE_END; }
          else { const int i = v - A_LRU - NS, h_ = i & 3, n_ = (i >> 2) % NSPLIT, b_ = (i >> 2) / NSPLIT;
                 gdn_prep_unit(PROJ, gdn_conv_w, gdn_a_log, gdn_dt_bias, cbuf, o_p_gdn_conv, (b_ * 64 + n_) * 4 + h_, lds, cjob); }
      } }
    GRID_BAR();
    f32x4 seqS[2]; int seqcur = 0;
    const int seq_p = (b0 & 7) + 8 * (b0 >> 5), seq_s = (b0 >> 3) & 3;
    if (b0 < 64) {
        gdn_seq<0, NSPLIT>(cbuf, R_O, o_p_gdn, seq_p >> 2, seq_p & 3, seq_s, lds, seqS, seqcur);
        table_rows_convert<false>(peer_u + (size_t)16384 * D, TAB8 + (size_t)2 * 16384 * D, TSC + 2 * 16384, 0, 16384, b0 * NWAVES + wave, 64 * NWAVES, lane);
    }
    else for (int v = b0 - 64; v < B_LRU + B_GDN; v += nb - 64) {
        if (v < B_LRU) { lru_prep_unit2(PROJ, lru_conv_w, lru_conv_b, WRT, WIT, lru_b_r, lru_b_i, lru_lam, R_B, R_A, HEND, PEND, o_p_lru_conv, (v / (64 - NSPLIT)) * 64 + NSPLIT + (v % (64 - NSPLIT)), lds); PHASE_END; }
        else { const int i = v - B_LRU, h_ = i & 3, n_ = NSPLIT + (i >> 2) % (64 - NSPLIT), b_ = (i >> 2) / (64 - NSPLIT);
               gdn_prep_unit(PROJ, gdn_conv_w, gdn_a_log, gdn_dt_bias, cbuf, o_p_gdn_conv, (b_ * 64 + n_) * 4 + h_, lds, cjob); }
    }
    GRID_BAR();
    if (b0 < 64) gdn_seq<NSPLIT, 64>(cbuf, R_O, o_p_gdn, seq_p >> 2, seq_p & 3, seq_s, lds, seqS, seqcur);
    else if (b0 < 68) lru_carry(HEND, PEND, CIN, o_p_lru, b0 - 64);
    else {
        for (int v = (b0 - 68) * NWAVES + wave; v < NS * 4 * 8; v += (nb - 68) * NWAVES) gdn_step_sample_w(R_Q, R_G, R_BETA, state_gdn, R_O, o_s_gdn, v, lane);
        for (int v = b0 - 68; v < 128; v += nb - 68) lru_scan(R_A, R_B, state_lru, o_s_lru, NP, 1, NS, v);
        const int gw2 = (b0 - 68) * NWAVES + wave, NGW2 = (nb - 68) * NWAVES;
        for (int m = gw2; m < 512; m += NGW2) row_to_bf16(peer_keys + (size_t)m * D, KEYSB + (size_t)m * D, lane);
        for (int v = b0 - 68; v < 256; v += nb - 68) swa_cache_shift(cache_k, cache_v, o_s_k, o_s_v, v);
        {
            constexpr int I_OUT = 16 * 32, I_Q = 16 * 64, I_INC = 16 * 48;
            float* scr = smem + wave * 4096;
            for (int it = gw2; it < I_OUT + 2 * I_Q + I_INC + I_OUT; it += NGW2) {
                int r = it;
                if (r < I_OUT) { p0_transpose_item(w_out_ab, D, D, WOUT_T, scr, r, lane); continue; } r -= I_OUT;
                if (r < I_Q) { p0_transpose_item(peer_w_q, D, 2048, WQ0_T, scr, r, lane); continue; } r -= I_Q;
                if (r < I_Q) { p0_transpose_item(peer_w_q + (size_t)D * 2048, D, 2048, WQ1_T, scr, r, lane); continue; } r -= I_Q;
                if (r < I_INC) { p0_transpose_item(w_in_c, D, CN, WINC_T, scr, r, lane); continue; } r -= I_INC;
                p0_transpose_item(w_out_c, D, D, WOUTC_T, scr, r, lane);
            }
        }
        table_rows_convert<true>(peer_v + (size_t)16384 * D, TAB8 + (size_t)3 * 16384 * D, TSC + 3 * 16384, 0, 16384, gw2, NGW2, lane);
    }
    GRID_BAR();
    PHASE_LOOP(NT / 8) { ab_mix_w(PROJ, R_O, R_B, R_A, CIN, gdn_norm_w, ABUF, vb * 8 + wave, lane); }
    GRID_BAR();
    GEMM_PHASE_SPLIT(ABUF, WOUT_T, D, Yb, (const float*)nullptr);
    GRID_BAR();
    PHASE_LOOP(NT / 8) { const int t = vb * 8 + wave;
        ln_res_w<false>(t < NP ? x_prompt + (size_t)t * D : x_sample + (size_t)(t - NP) * D, Yb + (size_t)t * D, ln_mix_g, ln_mix_b, ABUF + (size_t)t * D, lane); }
    GRID_BAR();
    GEMM_PHASE_SPLIT(ABUF, WQ0_T, 2048, Qb, (const float*)nullptr);
    GRID_BAR();
    { bf16x8_t tq_[4]; if (b0 < (NT / 64) * 8) peer_topk_ldq(tq_, Qb, b0 >> 3, b0 & 7, tid);
      if ((nb & 7) == 0) { peer_topk_stage_keys(KEYSB, b0 & 7, lds); PHASE_LOOP((NT / 64) * 8) { peer_topk4(Qb, R_EXP, R_GATE, vb >> 3, vb & 7, lds, tq_, vb + nb < (NT / 64) * 8 ? (vb + nb) >> 3 : -1); } }
      else PHASE_LOOP((NT / 64) * 8) { peer_topk_stage_keys(KEYSB, vb & 7, lds); peer_topk_ldq(tq_, Qb, vb >> 3, vb & 7, tid); peer_topk4(Qb, R_EXP, R_GATE, vb >> 3, vb & 7, lds, tq_, -1); } }
    GRID_BAR();
    asm volatile("" : "+v"(tid)); lane = tid & 63;
    { const int x = b0 & 7, tg0 = b0 >> 3, tgstep = nb >> 3, nit = (NT / 8 - tg0 + tgstep - 1) / tgstep;
      peer_u_loop(ABUF, R_EXP, TAB8 + (size_t)x * 16384 * 128, PD + (size_t)x * NT * 128, x, tg0, tgstep, nit, wave, lane); }
    GRID_BAR();
    PHASE_LOOP(NT / 8) { const int t = vb * 8 + wave; peer_xk(R_EXP + (size_t)t * 128, R_GATE + (size_t)t * 128, PD + (size_t)t * 128, TSC, TSC + 16384, lane); }
    GRID_BAR();
    { const int x = b0 & 7, tg0 = b0 >> 3, tgstep = nb >> 3, nit = (NT / 8 - tg0 + tgstep - 1) / tgstep;
      peer_v_loop(R_EXP, R_GATE, TAB8 + (size_t)16384 * D + (size_t)x * 16384 * 128, OUTS, x, tg0, tgstep, nit, wave, lane); }
    GRID_BAR();
    PHASE_LOOP(NT / 8) { const int t = vb * 8 + wave; peer_xc(ABUF + (size_t)t * D, OUTS + (size_t)t * D, ln_ffn_g, ln_ffn_b, nullptr, ABUF + (size_t)t * D, nullptr, lane); }
    GRID_BAR();

    GEMM_PHASE(EpiStoreBf16, ABUF, WINC_T, CN, PCb, CN, b_in_c, NT, CN);
    GRID_BAR();
    PHASE_LOOP(1024 + 256 + 260) {
        if (vb < 1024) attn_unit(PCb, rel_bias, swa_sinks, ATTB, vb, lds);
        else if (vb < 1280) swa_attn_sample(PCb, cache_k, cache_v, rel_bias, swa_sinks, ATTB, (vb - 1024) * 8 + wave, lane);
        else swa_kv_out3(PCb, cache_k, cache_v, o_p_k, o_p_v, o_s_k, o_s_v, vb - 1280);
    }
    GRID_BAR();
    GEMM_PHASE_SPLIT(ATTB, WOUTC_T, D, Yb, b_out_c);
    GRID_BAR();
    PHASE_LOOP(NT / 8) { const int t = vb * 8 + wave;
        ln_res_w<true>(ABUF + (size_t)t * D, Yb + (size_t)t * D, ln_mix_g + D, ln_mix_b + D, ABUF + (size_t)t * D, lane); }
    GRID_BAR();
    GEMM_PHASE_SPLIT(ABUF, WQ1_T, 2048, Qb, (const float*)nullptr);
    GRID_BAR();
    { bf16x8_t tq_[4]; if (b0 < (NT / 64) * 8) peer_topk_ldq(tq_, Qb, b0 >> 3, b0 & 7, tid);
      if ((nb & 7) == 0) { peer_topk_stage_keys(KEYSB + (size_t)8 * 2 * 128 * 128, b0 & 7, lds); PHASE_LOOP((NT / 64) * 8) { peer_topk4(Qb, R_EXP, R_GATE, vb >> 3, vb & 7, lds, tq_, vb + nb < (NT / 64) * 8 ? (vb + nb) >> 3 : -1); } }
      else PHASE_LOOP((NT / 64) * 8) { peer_topk_stage_keys(KEYSB + (size_t)8 * 2 * 128 * 128, vb & 7, lds); peer_topk_ldq(tq_, Qb, vb >> 3, vb & 7, tid); peer_topk4(Qb, R_EXP, R_GATE, vb >> 3, vb & 7, lds, tq_, -1); } }
    GRID_BAR();
    asm volatile("" : "+v"(tid)); lane = tid & 63;
    { const int x = b0 & 7, tg0 = b0 >> 3, tgstep = nb >> 3, nit = (NT / 8 - tg0 + tgstep - 1) / tgstep;
      peer_u_loop(ABUF, R_EXP, TAB8 + (size_t)2 * 16384 * D + (size_t)x * 16384 * 128, PD + (size_t)x * NT * 128, x, tg0, tgstep, nit, wave, lane); }
    GRID_BAR();
    PHASE_LOOP(NT / 8) { const int t = vb * 8 + wave; peer_xk(R_EXP + (size_t)t * 128, R_GATE + (size_t)t * 128, PD + (size_t)t * 128, TSC + 2 * 16384, TSC + 3 * 16384, lane); }
    GRID_BAR();
    { const int x = b0 & 7, tg0 = b0 >> 3, tgstep = nb >> 3, nit = (NT / 8 - tg0 + tgstep - 1) / tgstep;
      peer_v_loop(R_EXP, R_GATE, TAB8 + (size_t)3 * 16384 * D + (size_t)x * 16384 * 128, OUTS, x, tg0, tgstep, nit, wave, lane); }
    GRID_BAR();
    PHASE_LOOP(NT / 8) { const int t = vb * 8 + wave; peer_xc(ABUF + (size_t)t * D, OUTS + (size_t)t * D, ln_ffn_g + D, ln_ffn_b + D, o_y + (size_t)t * D, nullptr, nullptr, lane); }
}
}

extern "C" void kernel_launch(void* const* d_in, const int* in_sizes, int n_in,
                              void* d_out, int out_size, void* d_ws, size_t ws_size,
                              hipStream_t stream) {
    static int grid_blocks = 0;
    if (!grid_blocks) {
        int dev = 0, cus = 0, per_cu = 0;
        (void)hipGetDevice(&dev);
        (void)hipDeviceGetAttribute(&cus, hipDeviceAttributeMultiprocessorCount, dev);
        if (hipFuncSetAttribute((const void*)fwd_megakernel, hipFuncAttributeMaxDynamicSharedMemorySize, LDS_BYTES) != hipSuccess) { fprintf(stderr, "hipFuncSetAttribute failed\n"); grid_blocks = -1; return; }
        (void)hipOccupancyMaxActiveBlocksPerMultiprocessor(&per_cu, (const void*)fwd_megakernel, NTH, LDS_BYTES);
        if (per_cu < 1) { fprintf(stderr, "occupancy query says %d blocks per CU\n", per_cu); grid_blocks = -1; return; }
        if (cus * per_cu < 256) { fprintf(stderr, "this kernel needs 256 co-resident workgroups (device reports %d CUs x %d)\n", cus, per_cu); grid_blocks = -1; return; }
        grid_blocks = 256;
    }
    if (grid_blocks < 0) return;
    (void)hipMemsetAsync((char*)d_ws + WS_CTL, 0, CTL_ZERO_BYTES, stream);
    MegaArgs ma{};
    for (int i = 0; i < 35; ++i) ma.in[i] = (const float*)d_in[i];
    ma.out = (float*)d_out;
    ma.ws = (unsigned char*)d_ws;
    void* args[] = {&ma};
    hipError_t e = hipLaunchCooperativeKernel((void*)fwd_megakernel, dim3(grid_blocks), dim3(NTH), args, LDS_BYTES, stream);
    if (e != hipSuccess) fprintf(stderr, "cooperative launch failed: %s (grid %d)\n", hipGetErrorString(e), grid_blocks);
}
```

```cpp
#include <hip/hip_runtime.h>
#include <hip/hip_cooperative_groups.h>
#include <cstdio>
#include <cstdint>
namespace cg = cooperative_groups;

namespace pg8 {
#define PG8_LAS __attribute__((address_space(3)))
typedef unsigned short bf16_t;
typedef short bf16x8 __attribute__((ext_vector_type(8)));
typedef float f32x4 __attribute__((ext_vector_type(4)));
typedef unsigned u32x4 __attribute__((ext_vector_type(4)));
constexpr int BM = 256, BK = 64, HALF = 128, HTB = HALF * BK * 2  , STAGE_BYTES = 8 * HTB, NXCD = 8, WGM = 8;

__host__ __device__ __forceinline__ int lds_byte(int r, int c) { const int st = (r >> 4) * 2 + (c >> 5), rr = r & 15, cc = c & 31, ob = rr * 64 + cc * 2; return st * 1024 + (ob ^ (((ob >> 9) & 1) << 5)); }
__host__ __device__ __forceinline__ void stage_rc(int b, int& R, int& C) { const int st = b / 1024, sb = b % 1024, swz = sb ^ (((sb >> 9) & 1) << 5); R = (st >> 1) * 16 + swz / 64; C = (st & 1) * 32 + (swz % 64) / 2; }
__host__ __device__ __forceinline__ int perm32(int rho) { const int n = rho >> 4, i = rho & 15; return 8 * (i >> 2) + 4 * n + (i & 3); }

struct Unit { int pm, pn; };
struct Gemm { const bf16_t* A; const bf16_t* Bt; int M, N, K; };

struct StaticOrder {
    int nM, nN, nwg, G, c;
    __host__ __device__ void init(int M, int N, int G_, int c_) { nM = M / BM; nN = N / BM; nwg = nM * nN; G = G_; c = c_; }
    __host__ __device__ bool next(int i, Unit& u) const {
        const long L = (long)i * G + c; if (L >= nwg) return false;
        int wgid = (int)L; { const int q = nwg / NXCD, r = nwg % NXCD, xcd = wgid % NXCD, off = wgid / NXCD; wgid = (xcd < r ? xcd * (q + 1) : r * (q + 1) + (xcd - r) * q) + off; }
        const int nig = WGM * nN, gid = wgid / nig, fm = gid * WGM, gsz = (nM - fm) < WGM ? (nM - fm) : WGM;
        u.pm = fm + ((wgid % nig) % gsz); u.pn = (wgid % nig) / gsz; return true;
    }
    __device__ __forceinline__ void a_ready(const Unit&) const {}
    __device__ __forceinline__ void done(const Unit&) const {}
};

__device__ __forceinline__ unsigned cvt_pk_bf16(float lo, float hi) { unsigned r; asm volatile("v_cvt_pk_bf16_f32 %0, %1, %2" : "=v"(r) : "v"(lo), "v"(hi)); return r; }
template <class Epi, class Sched, bool ALIGN_EPI = false, bool SP2 = false>
__device__ __forceinline__ void gemm_phase(PG8_LAS unsigned char* lds, const Gemm g, const Sched& S, const Epi& E) {
    int tid_ = threadIdx.x; asm volatile("" : "+v"(tid_));
    const int tid = tid_, wid = __builtin_amdgcn_readfirstlane(tid >> 6), lane = tid & 63, wr = wid >> 2, wc = wid & 3, fr = lane & 15, fq = lane >> 4;
    const int K = g.K, nt = K / BK;
    unsigned voffA[2], voffB[2];
#pragma unroll
    for (int i = 0; i < 2; ++i) { int R, C; stage_rc(tid * 16 + i * 8192, R, C); const int Rb = Epi::PERM ? ((R & ~31) + perm32(R & 31)) : R;
        voffA[i] = (unsigned)(R * K + C) * 2u; voffB[i] = (unsigned)(Rb * K + C) * 2u; }
    const size_t kstep = (size_t)(BK * 2);
    const size_t hstep = (size_t)HALF * K * 2;
    const size_t tstep = 2 * hstep;
    const unsigned ldsw = (unsigned)wid * 1024u;
    const int aoff = lds_byte(wr * 64 + fr, fq * 8), boff = lds_byte(wc * 32 + fr, fq * 8);
#define PG8_SA(b, h) (((b) * 2 + (h)) * HTB)
#define PG8_SB(b, h) ((4 + (b) * 2 + (h)) * HTB)
#define PG8_STAGE(bufoff, gbase, voff) do { _Pragma("unroll") for (int _i = 0; _i < 2; ++_i) \
        __builtin_amdgcn_global_load_lds((const unsigned*)((const char*)(gbase) + (voff)[_i]), (PG8_LAS unsigned*)(lds + (bufoff) + ldsw + _i * 8192), 16, 0, 0); } while (0)
#define PG8_LDA(dst, b, h) do { _Pragma("unroll") for (int m = 0; m < 4; ++m) _Pragma("unroll") for (int k = 0; k < 2; ++k) dst[m][k] = *(const PG8_LAS bf16x8*)(lds + PG8_SA(b, h) + aoff + m * 2048 + k * 1024); } while (0)
#define PG8_LDB(dst, b, h) do { _Pragma("unroll") for (int n = 0; n < 2; ++n) _Pragma("unroll") for (int k = 0; k < 2; ++k) dst[n][k] = *(const PG8_LAS bf16x8*)(lds + PG8_SB(b, h) + boff + n * 2048 + k * 1024); } while (0)
#define PG8_MMA(ai, bj, At, Bt) do { __builtin_amdgcn_s_setprio(1); _Pragma("unroll") for (int m = 0; m < 4; ++m) _Pragma("unroll") for (int n = 0; n < 2; ++n) _Pragma("unroll") for (int k = 0; k < 2; ++k) \
        acc[ai][bj][m][n] = __builtin_amdgcn_mfma_f32_16x16x32_bf16(Bt[n][k], At[m][k], acc[ai][bj][m][n], 0, 0, 0); __builtin_amdgcn_s_setprio(0); } while (0)
#define PG8_WAIT_V(n) asm volatile("s_waitcnt vmcnt(" #n ")" ::: "memory")
#define PG8_WAIT_L(n) asm volatile("s_waitcnt lgkmcnt(" #n ")" ::: "memory")
#define PG8_BAR __builtin_amdgcn_s_barrier()
#define PG8_SCHED __builtin_amdgcn_sched_barrier(0)
    Unit cur, nxt; int ui = 0;
    if (!S.next(0, cur)) return;
    f32x4 acc[2][2][4][2];
#pragma unroll
    for (int a = 0; a < 2; ++a)
#pragma unroll
        for (int b = 0; b < 2; ++b)
#pragma unroll
            for (int m = 0; m < 4; ++m)
#pragma unroll
                for (int n = 0; n < 2; ++n) acc[a][b][m][n] = (f32x4){0.f, 0.f, 0.f, 0.f};
    bf16x8 At[4][2], B0[2][2], B1[2][2];
    const char* cA = (const char*)g.A + (size_t)cur.pm * tstep; const char* cB = (const char*)g.Bt + (size_t)cur.pn * tstep;
    S.a_ready(cur);
    if constexpr (SP2) {
        PG8_STAGE(PG8_SB(0, 0), cB, voffB); PG8_STAGE(PG8_SB(0, 1), cB + hstep, voffB); PG8_STAGE(PG8_SA(0, 0), cA, voffA); PG8_STAGE(PG8_SA(0, 1), cA + hstep, voffA);
        if (wr == 1) PG8_BAR;
        PG8_WAIT_V(2); PG8_BAR;
        PG8_STAGE(PG8_SB(1, 0), cB + kstep, voffB); PG8_STAGE(PG8_SA(1, 0), cA + kstep, voffA); PG8_STAGE(PG8_SB(1, 1), cB + hstep + kstep, voffB);
        PG8_WAIT_V(6); PG8_BAR;
    } else {
        PG8_STAGE(PG8_SB(0, 0), cB, voffB); PG8_STAGE(PG8_SA(0, 0), cA, voffA); PG8_STAGE(PG8_SB(0, 1), cB + hstep, voffB); PG8_STAGE(PG8_SA(0, 1), cA + hstep, voffA);
        if (wr == 1) PG8_BAR;
        PG8_WAIT_V(4); PG8_BAR;
        PG8_STAGE(PG8_SB(1, 0), cB + kstep, voffB); PG8_STAGE(PG8_SA(1, 0), cA + kstep, voffA); PG8_STAGE(PG8_SB(1, 1), cB + hstep + kstep, voffB);
        PG8_WAIT_V(6); PG8_BAR;
    }
    for (;;) {
        const bool has_next = S.next(ui + 1, nxt);
        const char* nA = has_next ? (const char*)g.A + (size_t)nxt.pm * tstep : cA; const char* nB = has_next ? (const char*)g.Bt + (size_t)nxt.pn * tstep : cB;
        for (int t = 0; t < nt; t += 2) {
            const bool last = (t == nt - 2);
            const char* a1 = cA + (size_t)(t + 1) * kstep;
            const char* a2 = last ? nA : cA + (size_t)(t + 2) * kstep; const char* b2 = last ? nB : cB + (size_t)(t + 2) * kstep;
            const char* a3 = a2 + kstep; const char* b3 = b2 + kstep;
            if (last && has_next) S.a_ready(nxt);
            if constexpr (SP2) {
            PG8_LDB(B0, 0, 0); PG8_LDB(B1, 0, 1); PG8_SCHED; PG8_LDA(At, 0, 0); PG8_STAGE(PG8_SA(1, 1), a1 + hstep, voffA);
            PG8_WAIT_V(8); PG8_WAIT_L(0); PG8_BAR; PG8_MMA(0, 0, At, B0); PG8_MMA(0, 1, At, B1); PG8_BAR; PG8_SCHED;
            PG8_LDA(At, 0, 1); PG8_STAGE(PG8_SB(0, 0), b2, voffB); PG8_STAGE(PG8_SB(0, 1), b2 + hstep, voffB); PG8_STAGE(PG8_SA(0, 0), a2, voffA);
            PG8_WAIT_V(8); PG8_WAIT_L(0); PG8_BAR; PG8_MMA(1, 0, At, B0); PG8_MMA(1, 1, At, B1); PG8_BAR; PG8_SCHED;
            PG8_LDB(B0, 1, 0); PG8_LDB(B1, 1, 1); PG8_SCHED; PG8_LDA(At, 1, 0); PG8_STAGE(PG8_SA(0, 1), a2 + hstep, voffA);
            PG8_WAIT_V(8); PG8_WAIT_L(0); PG8_BAR; PG8_MMA(0, 0, At, B0); PG8_MMA(0, 1, At, B1); PG8_BAR; PG8_SCHED;
            PG8_LDA(At, 1, 1); PG8_STAGE(PG8_SB(1, 0), b3, voffB); PG8_STAGE(PG8_SB(1, 1), b3 + hstep, voffB); PG8_STAGE(PG8_SA(1, 0), a3, voffA);
            PG8_WAIT_V(8); PG8_WAIT_L(0); PG8_BAR; PG8_MMA(1, 0, At, B0); PG8_MMA(1, 1, At, B1); PG8_BAR; PG8_SCHED;
            } else {
            PG8_LDB(B0, 0, 0); PG8_SCHED; PG8_LDA(At, 0, 0); PG8_STAGE(PG8_SA(1, 1), a1 + hstep, voffA);
            PG8_WAIT_L(8); PG8_BAR; PG8_WAIT_L(0); PG8_MMA(0, 0, At, B0); PG8_BAR; PG8_SCHED;
            PG8_LDB(B1, 0, 1); PG8_STAGE(PG8_SB(0, 0), b2, voffB);
            PG8_BAR; PG8_WAIT_L(0); PG8_MMA(0, 1, At, B1); PG8_BAR;
            PG8_LDA(At, 0, 1); PG8_STAGE(PG8_SA(0, 0), a2, voffA);
            PG8_BAR; PG8_WAIT_L(0); PG8_MMA(1, 0, At, B0); PG8_BAR; PG8_SCHED;
            PG8_STAGE(PG8_SB(0, 1), b2 + hstep, voffB);
            PG8_WAIT_V(6); PG8_BAR; PG8_MMA(1, 1, At, B1); PG8_BAR;
            PG8_LDB(B0, 1, 0); PG8_SCHED; PG8_LDA(At, 1, 0); PG8_STAGE(PG8_SA(0, 1), a2 + hstep, voffA);
            PG8_WAIT_L(8); PG8_BAR; PG8_WAIT_L(0); PG8_MMA(0, 0, At, B0); PG8_BAR; PG8_SCHED;
            PG8_LDB(B1, 1, 1); PG8_STAGE(PG8_SB(1, 0), b3, voffB);
            PG8_BAR; PG8_WAIT_L(0); PG8_MMA(0, 1, At, B1); PG8_BAR;
            PG8_LDA(At, 1, 1); PG8_STAGE(PG8_SA(1, 0), a3, voffA);
            PG8_BAR; PG8_WAIT_L(0); PG8_MMA(1, 0, At, B0); PG8_BAR; PG8_SCHED;
            PG8_STAGE(PG8_SB(1, 1), b3 + hstep, voffB);
            PG8_WAIT_V(6); PG8_BAR; PG8_MMA(1, 1, At, B1); PG8_BAR;
            }
        }
        if constexpr (ALIGN_EPI) { if (wr == 0) PG8_BAR; }
        if constexpr (!Epi::AFTER_DRAIN) { E(acc, cur, wr, wc, fr, fq); S.done(cur); }
        if (!has_next) break;
#pragma unroll
        for (int a = 0; a < 2; ++a)
#pragma unroll
            for (int b = 0; b < 2; ++b)
#pragma unroll
                for (int m = 0; m < 4; ++m)
#pragma unroll
                    for (int n = 0; n < 2; ++n) acc[a][b][m][n] = (f32x4){0.f, 0.f, 0.f, 0.f};
        cur = nxt; cA = nA; cB = nB; ++ui;
        if constexpr (ALIGN_EPI) { if (wr == 1) PG8_BAR; }
    }
    PG8_WAIT_V(0);
    if constexpr (!ALIGN_EPI) { if (wr == 0) PG8_BAR; }
    PG8_BAR;
    if constexpr (Epi::AFTER_DRAIN) { E.fused(acc, cur, wr, wc, fr, fq, lds, wid, lane); S.done(cur); }
#undef PG8_SA
#undef PG8_SB
#undef PG8_STAGE
#undef PG8_LDA
#undef PG8_LDB
#undef PG8_MMA
#undef PG8_WAIT_V
#undef PG8_WAIT_L
#undef PG8_BAR
#undef PG8_SCHED
}
}
namespace pg8 {
struct EpiStoreBf16 {
    static constexpr bool PERM = true, AFTER_DRAIN = false;
    bf16_t* O; int ldc; const float* bias; int m_real, n_real;
    __device__ __forceinline__ void operator()(const f32x4 (&acc)[2][2][4][2], const Unit& u, int wr, int wc, int fr, int fq) const {
        const int row0 = u.pm * BM + wr * 64 + fr, col0 = u.pn * BM + wc * 32 + 8 * fq;
#pragma unroll
        for (int bj = 0; bj < 2; ++bj) {
            const int col = col0 + bj * HALF;
            if (col >= n_real) continue;
            f32x4 b0 = (f32x4){0.f, 0.f, 0.f, 0.f}, b1 = b0;
            if (bias) { b0 = *(const f32x4*)(bias + col); b1 = *(const f32x4*)(bias + col + 4); }
#pragma unroll
            for (int ai = 0; ai < 2; ++ai)
#pragma unroll
                for (int m = 0; m < 4; ++m) {
                    const int row = row0 + ai * HALF + m * 16;
                    if (row >= m_real) continue;
                    const f32x4 v0 = acc[ai][bj][m][0] + b0, v1 = acc[ai][bj][m][1] + b1;
                    u32x4 w; w.x = cvt_pk_bf16(v0[0], v0[1]); w.y = cvt_pk_bf16(v0[2], v0[3]); w.z = cvt_pk_bf16(v1[0], v1[1]); w.w = cvt_pk_bf16(v1[2], v1[3]);
                    *(u32x4*)(O + (size_t)row * ldc + col) = w;
                }
        }
    }
};
struct EpiStoreF32 {
    static constexpr bool PERM = false, AFTER_DRAIN = false;
    float* O; int ldc; const float* bias; int m_real, n_real;
    __device__ __forceinline__ void operator()(const f32x4 (&acc)[2][2][4][2], const Unit& u, int wr, int wc, int fr, int fq) const {
        const int row0 = u.pm * BM + wr * 64 + fr, col0 = u.pn * BM + wc * 32 + 4 * fq;
#pragma unroll
        for (int bj = 0; bj < 2; ++bj)
#pragma unroll
            for (int n = 0; n < 2; ++n) {
                const int col = col0 + bj * HALF + n * 16;
                if (col >= n_real) continue;
                const f32x4 bv = bias ? *(const f32x4*)(bias + col) : (f32x4){0.f, 0.f, 0.f, 0.f};
#pragma unroll
                for (int ai = 0; ai < 2; ++ai)
#pragma unroll
                    for (int m = 0; m < 4; ++m) {
                        const int row = row0 + ai * HALF + m * 16;
                        if (row >= m_real) continue;
                        *(f32x4*)(O + (size_t)row * ldc + col) = acc[ai][bj][m][n] + bv;
                    }
            }
    }
};
}
namespace {
#define GAS __attribute__((address_space(1)))
#define LAS __attribute__((address_space(3)))
typedef unsigned short bf16;
typedef float f32x4 __attribute__((ext_vector_type(4)));
typedef unsigned v4u __attribute__((ext_vector_type(4)));
typedef unsigned v2u __attribute__((ext_vector_type(2)));

constexpr int D = 1024, NB = 4, SEQ = 4096, NP = NB * SEQ, NS = 128, NT = NP + NS, MP = 16640;
constexpr int ABN = 3080, ABNP = 3328;
constexpr int C_QKV = 0, C_Z = 1536, C_XR = 2048, C_GATE = 2560, C_A = 3072, C_B = 3076;
constexpr int ABMAIN = 3072;
constexpr int CN = 1536;
constexpr float ALPHA = 1.4142135623730951f;
constexpr float LN_EPS = 1e-5f;
constexpr int NTH = 512, NWAVES = 8;
constexpr int RING_BYTES = 143360, MISC_OFF = RING_BYTES + 320, LDS_BYTES = 147456;

__device__ __forceinline__ float bf2f(bf16 v) { return __uint_as_float((unsigned)v << 16); }
__device__ __forceinline__ float bflo(unsigned w) { return __uint_as_float(w << 16); }
__device__ __forceinline__ float bfhi(unsigned w) { return __uint_as_float(w & 0xffff0000u); }
typedef float f32x2c_t __attribute__((ext_vector_type(2)));
typedef __bf16 bf16x2c_t __attribute__((ext_vector_type(2)));
__device__ __forceinline__ unsigned f2bf(float f) { return (unsigned)__builtin_bit_cast(unsigned short, (__bf16)f); }
__device__ __forceinline__ unsigned pk2(float lo, float hi) { return __builtin_bit_cast(unsigned, __builtin_convertvector((f32x2c_t){lo, hi}, bf16x2c_t)); }
__device__ __forceinline__ float sigmoidf_(float x) { return 1.0f / (1.0f + expf(-x)); }
__device__ __forceinline__ float softplusf_(float x) { return fmaxf(x, 0.f) + log1pf(expf(-fabsf(x))); }
__device__ __forceinline__ float siluf_(float x) { return x / (1.0f + expf(-x)); }
__device__ __forceinline__ float geluf_(float x) { return 0.5f * x * (1.0f + tanhf(0.7978845608028654f * (x + 0.044715f * x * x * x))); }
#define DPPF(v_, ctrl_, rmask_) __int_as_float(__builtin_amdgcn_update_dpp(0, __float_as_int(v_), (ctrl_), (rmask_), 0xf, false))
__device__ __forceinline__ float wave_sum(float v) {
    v += DPPF(v, 0xB1, 0xf); v += DPPF(v, 0x4E, 0xf); v += DPPF(v, 0x141, 0xf); v += DPPF(v, 0x140, 0xf);
    v += DPPF(v, 0x142, 0xa); v += DPPF(v, 0x143, 0xc);
    return __int_as_float(__builtin_amdgcn_readlane(__float_as_int(v), 63));
}
__device__ __forceinline__ float wave_max(float v) {
    v = fmaxf(v, DPPF(v, 0xB1, 0xf)); v = fmaxf(v, DPPF(v, 0x4E, 0xf)); v = fmaxf(v, DPPF(v, 0x141, 0xf)); v = fmaxf(v, DPPF(v, 0x140, 0xf));
    { const float t = __int_as_float(__builtin_amdgcn_update_dpp(__float_as_int(v), __float_as_int(v), 0x142, 0xa, 0xf, false)); v = fmaxf(v, t); }
    { const float t = __int_as_float(__builtin_amdgcn_update_dpp(__float_as_int(v), __float_as_int(v), 0x143, 0xc, 0xf, false)); v = fmaxf(v, t); }
    return __int_as_float(__builtin_amdgcn_readlane(__float_as_int(v), 63));
}

template <bool ABORDER = false>
__device__ __forceinline__ void p0_transpose_item(const float* __restrict__ W, int K, int N, bf16* __restrict__ WT, float* scr, int item, int lane) {
    const int nblk = (N + 31) / 32, kb = item / nblk, nb = item % nblk, k0 = 64 * kb, n0 = 32 * nb;
    const int n_ = n0 + (lane & 31);
    const int ns = ABORDER ? (n_ < 2048 ? n_ : (n_ < ABMAIN ? n_ + 8 : n_ - 1024)) : n_;
    float wv_[32];
#pragma unroll
    for (int i = 0; i < 32; ++i) { const int kk = 2 * i + (lane >> 5); wv_[i] = n_ < N ? W[(size_t)(k0 + kk) * N + ns] : 0.f; }
#pragma unroll
    for (int i = 0; i < 32; ++i) { const int kk = 2 * i + (lane >> 5); scr[kk * 33 + (lane & 31)] = wv_[i]; }
    asm volatile("s_waitcnt lgkmcnt(0)" ::: "memory");
    const int c = lane & 7;
#pragma unroll
    for (int j = 0; j < 4; ++j) { const int n = (lane >> 3) + 8 * j; const float* s = scr + (8 * c) * 33 + n;
        v4u o; o.x = pk2(s[0 * 33], s[1 * 33]); o.y = pk2(s[2 * 33], s[3 * 33]); o.z = pk2(s[4 * 33], s[5 * 33]); o.w = pk2(s[6 * 33], s[7 * 33]);
        *(v4u*)(WT + (size_t)(n0 + n) * K + k0 + 8 * c) = o; }
    asm volatile("s_waitcnt lgkmcnt(0)" ::: "memory");
}
__device__ __forceinline__ void row_to_bf16(const float* __restrict__ xrow, bf16* __restrict__ orow, int lane) {
#pragma unroll
    for (int j = 0; j < 4; ++j) {
        f32x4 v = (f32x4){0.f, 0.f, 0.f, 0.f};
        if (xrow) v = ((const f32x4*)xrow)[lane + 64 * j];
        v2u o; o.x = pk2(v.x, v.y); o.y = pk2(v.z, v.w);
        ((v2u*)orow)[lane + 64 * j] = o;
    }
}

struct AbPrepArgs {
    const bf16* PROJ; const float* st_gdn_conv; const float* st_lru_conv;
    const float* gdn_conv_w; const float* a_log; const float* dt_bias;
    const float* lru_conv_w; const float* lru_conv_b; const float* w_r; const float* b_r; const float* w_i; const float* b_i; const float* lam;
    float* QKV; float* G; float* BETA; float* LA; float* LB;
    float* p_gdn_conv; float* p_lru_conv; float* s_gdn_conv; float* s_lru_conv;
};
__device__ __forceinline__ void ab_prep(const AbPrepArgs& a, int t, float* smem) {
    int tid = threadIdx.x; asm volatile("" : "+v"(tid));
    const int lane = tid & 63, wid = tid >> 6;
    const bool samp = t >= NP; const int sb = t - NP, pos = t % SEQ, b = t / SEQ;
    float* sq = smem;
    float* sx = smem + 1536;
    float* scl = smem + 2048;
    const bf16* prow = a.PROJ + (size_t)t * ABN;
    for (int c = tid; c < 1536; c += NTH) {
        float acc = 0.f;
#pragma unroll
        for (int i = 0; i < 4; ++i) {
            float xv;
            if (i == 3) xv = bf2f(prow[C_QKV + c]);
            else if (samp) xv = a.st_gdn_conv[((size_t)sb * 3 + i) * 1536 + c];
            else xv = (pos - 3 + i >= 0) ? bf2f(a.PROJ[(size_t)(t - 3 + i) * ABN + C_QKV + c]) : 0.f;
            acc += a.gdn_conv_w[i * 1536 + c] * xv;
        }
        sq[c] = siluf_(acc);
    }
    {
        const int c = tid;
        float acc = a.lru_conv_b[c];
#pragma unroll
        for (int i = 0; i < 4; ++i) {
            float xv;
            if (i == 3) xv = bf2f(prow[C_XR + c]);
            else if (samp) xv = a.st_lru_conv[((size_t)sb * 3 + i) * 512 + c];
            else xv = (pos - 3 + i >= 0) ? bf2f(a.PROJ[(size_t)(t - 3 + i) * ABN + C_XR + c]) : 0.f;
            acc += a.lru_conv_w[i * 512 + c] * xv;
        }
        sx[c] = acc;
    }
    __syncthreads();
    {
        const int grp = wid;
        const float v0 = sq[grp * 128 + lane], v1 = sq[grp * 128 + 64 + lane];
        const float s = wave_sum(v0 * v0 + v1 * v1);
        if (lane == 0) scl[grp] = rsqrtf(s + 1e-6f) * (grp < 4 ? 0.08838834764831845f : 1.0f);
    }
    __syncthreads();
    for (int c = tid; c < 1536; c += NTH) a.QKV[(size_t)t * 1536 + c] = (c < 1024) ? sq[c] * scl[c >> 7] : sq[c];
    if (tid < 4) {
        const float a_raw = bf2f(prow[C_A + tid]), b_raw = bf2f(prow[C_B + tid]);
        a.G[(size_t)t * 4 + tid] = -expf(a.a_log[tid]) * softplusf_(a_raw + a.dt_bias[tid]);
        a.BETA[(size_t)t * 4 + tid] = sigmoidf_(b_raw);
    }
    if (!samp) {
        if (pos >= SEQ - 3) {
            const int row = pos - (SEQ - 3);
            for (int c = tid; c < 1536; c += NTH) a.p_gdn_conv[((size_t)b * 3 + row) * 1536 + c] = bf2f(prow[C_QKV + c]);
            a.p_lru_conv[((size_t)b * 3 + row) * 512 + tid] = bf2f(prow[C_XR + tid]);
        }
    } else {
        for (int c = tid; c < 1536; c += NTH) {
            a.s_gdn_conv[((size_t)sb * 3 + 0) * 1536 + c] = a.st_gdn_conv[((size_t)sb * 3 + 1) * 1536 + c];
            a.s_gdn_conv[((size_t)sb * 3 + 1) * 1536 + c] = a.st_gdn_conv[((size_t)sb * 3 + 2) * 1536 + c];
            a.s_gdn_conv[((size_t)sb * 3 + 2) * 1536 + c] = bf2f(prow[C_QKV + c]);
        }
        {
            const int c = tid;
            a.s_lru_conv[((size_t)sb * 3 + 0) * 512 + c] = a.st_lru_conv[((size_t)sb * 3 + 1) * 512 + c];
            a.s_lru_conv[((size_t)sb * 3 + 1) * 512 + c] = a.st_lru_conv[((size_t)sb * 3 + 2) * 512 + c];
            a.s_lru_conv[((size_t)sb * 3 + 2) * 512 + c] = bf2f(prow[C_XR + c]);
        }
    }
    {
        const int c = tid, n = c >> 6, d = c & 63;
        float r = a.b_r[c], ii = a.b_i[c];
#pragma unroll 4
        for (int cc = 0; cc < 64; ++cc) {
            const float xv = sx[n * 64 + cc];
            r += xv * a.w_r[((size_t)n * 64 + cc) * 64 + d];
            ii += xv * a.w_i[((size_t)n * 64 + cc) * 64 + d];
        }
        r = sigmoidf_(r); ii = sigmoidf_(ii);
        const float log_a = -8.0f * r * softplusf_(-a.lam[c]);
        a.LA[(size_t)t * 512 + c] = expf(log_a);
        a.LB[(size_t)t * 512 + c] = sqrtf(-expm1f(2.0f * log_a)) * (ii * sx[c]);
    }
}

__device__ __forceinline__ void gdn_scan(const float* __restrict__ QKV, const float* __restrict__ G, const float* __restrict__ BETA,
                                         const float* __restrict__ S0, float* __restrict__ O, float* __restrict__ Sout, int tok_base, int T,
                                         int sl, int h, int sq, float* smem) {
    int tid = threadIdx.x; asm volatile("" : "+v"(tid));
    const int dvl = tid & 31, kg = tid >> 5;
    const int dv = sl * 32 + dvl;
    float (*red1)[32] = (float (*)[32])smem;
    float (*red2)[32] = (float (*)[32])(smem + 512);
    float S[8];
#pragma unroll
    for (int i = 0; i < 8; ++i) S[i] = S0 ? S0[(((size_t)sq * 4 + h) * 128 + kg * 8 + i) * 128 + dv] : 0.f;
    float kk[8], qq[8], vv, g, be;
    {
        const size_t tok = (size_t)tok_base + (size_t)sq * T;
        const float* row = QKV + tok * 1536;
#pragma unroll
        for (int i = 0; i < 8; ++i) { kk[i] = row[512 + h * 128 + kg * 8 + i]; qq[i] = row[h * 128 + kg * 8 + i]; }
        vv = row[1024 + h * 128 + dv]; g = G[tok * 4 + h]; be = BETA[tok * 4 + h];
    }
    for (int t = 0; t < T; ++t) {
        const size_t tok = (size_t)tok_base + (size_t)sq * T + t;
        float nk[8], nq[8], nv = 0.f, ng = 0.f, nb = 0.f;
        if (t + 1 < T) {
            const float* row = QKV + (tok + 1) * 1536;
#pragma unroll
            for (int i = 0; i < 8; ++i) { nk[i] = row[512 + h * 128 + kg * 8 + i]; nq[i] = row[h * 128 + kg * 8 + i]; }
            nv = row[1024 + h * 128 + dv]; ng = G[(tok + 1) * 4 + h]; nb = BETA[(tok + 1) * 4 + h];
        } else {
#pragma unroll
            for (int i = 0; i < 8; ++i) { nk[i] = 0.f; nq[i] = 0.f; }
        }
        const float al = expf(g);
        float p = 0.f;
#pragma unroll
        for (int i = 0; i < 8; ++i) { S[i] *= al; p += S[i] * kk[i]; }
        red1[kg][dvl] = p;
        __syncthreads();
        float ks = 0.f;
#pragma unroll
        for (int j = 0; j < 16; ++j) ks += red1[j][dvl];
        const float vn = be * (vv - ks);
        float o = 0.f;
#pragma unroll
        for (int i = 0; i < 8; ++i) { S[i] += kk[i] * vn; o += S[i] * qq[i]; }
        red2[kg][dvl] = o;
        __syncthreads();
        if (kg == 0) {
            float os = 0.f;
#pragma unroll
            for (int j = 0; j < 16; ++j) os += red2[j][dvl];
            O[tok * 512 + h * 128 + dv] = os;
        }
#pragma unroll
        for (int i = 0; i < 8; ++i) { kk[i] = nk[i]; qq[i] = nq[i]; }
        vv = nv; g = ng; be = nb;
    }
#pragma unroll
    for (int i = 0; i < 8; ++i) Sout[(((size_t)sq * 4 + h) * 128 + kg * 8 + i) * 128 + dv] = S[i];
}


__device__ __forceinline__ void gdn_step_sample_w(const float* __restrict__ QKV, const float* __restrict__ G, const float* __restrict__ BETA, const float* __restrict__ S0,
                                                  float* __restrict__ O, float* __restrict__ Sout, int item, int lane) {
    const int sl = item & 7, h = (item >> 3) & 3, sb = item >> 5, fr = lane & 15, fq = lane >> 4;
    const size_t tok = (size_t)NP + sb;
    const float* row = QKV + tok * 1536;
    const size_t sbase = (((size_t)sb * 4 + h) * 128 + fq * 32) * 128 + sl * 16 + fr;
    float S[32], kk[32], qq[32];
#pragma unroll
    for (int i = 0; i < 32; ++i) S[i] = S0[sbase + (size_t)i * 128];
#pragma unroll
    for (int i4 = 0; i4 < 8; ++i4) { const f32x4 k4 = *(const f32x4*)(row + 512 + h * 128 + fq * 32 + i4 * 4), q4 = *(const f32x4*)(row + h * 128 + fq * 32 + i4 * 4);
        kk[i4 * 4 + 0] = k4.x; kk[i4 * 4 + 1] = k4.y; kk[i4 * 4 + 2] = k4.z; kk[i4 * 4 + 3] = k4.w; qq[i4 * 4 + 0] = q4.x; qq[i4 * 4 + 1] = q4.y; qq[i4 * 4 + 2] = q4.z; qq[i4 * 4 + 3] = q4.w; }
    const float vv = row[1024 + h * 128 + sl * 16 + fr], al = expf(G[tok * 4 + h]), be = BETA[tok * 4 + h];
    float p = 0.f;
#pragma unroll
    for (int i = 0; i < 32; ++i) { S[i] *= al; p += S[i] * kk[i]; }
    p += __shfl_xor(p, 16); p += __shfl_xor(p, 32);
    const float vn = be * (vv - p);
    float o = 0.f;
#pragma unroll
    for (int i = 0; i < 32; ++i) { S[i] += kk[i] * vn; o += S[i] * qq[i]; }
    o += __shfl_xor(o, 16); o += __shfl_xor(o, 32);
    if (fq == 0) O[tok * 512 + h * 128 + sl * 16 + fr] = o;
#pragma unroll
    for (int i = 0; i < 32; ++i) Sout[sbase + (size_t)i * 128] = S[i];
}

__device__ __forceinline__ void lru_scan(const float* __restrict__ LA, float* __restrict__ LB, const float* __restrict__ h0,
                                         float* __restrict__ hlast, int tok_base, int T, int nseq, int bx) {
    int tx_ = threadIdx.x; asm volatile("" : "+v"(tx_));
    const int idx = bx * NTH + tx_;
    if (idx >= nseq * 512) return;
    const int sq = idx / 512, c = idx % 512;
    float h = h0 ? h0[(size_t)sq * 512 + c] : 0.f;
    const size_t base = ((size_t)tok_base + (size_t)sq * T) * 512 + c;
#pragma unroll 8
    for (int t = 0; t < T; ++t) {
        const size_t o = base + (size_t)t * 512;
        h = LA[o] * h + LB[o];
        LB[o] = h;
    }
    hlast[(size_t)sq * 512 + c] = h;
}

__device__ __forceinline__ void ab_mix_w(const bf16* __restrict__ PROJ, const float* __restrict__ O, const float* __restrict__ H, const float* __restrict__ P, const float* __restrict__ CIN,
                                         const float* __restrict__ norm_w, bf16* __restrict__ MIX, int t, int lane) {
    const bf16* prow = PROJ + (size_t)t * ABN;
#pragma unroll
    for (int jj = 0; jj < 2; ++jj) {
        const int c0 = 256 * jj + 4 * lane;
        const f32x4 o = *(const f32x4*)(O + (size_t)t * 512 + c0);
        const v2u zb = *(const v2u*)(prow + C_Z + c0);
        const f32x4 w = *(const f32x4*)(norm_w + (c0 & 127));
        float ss = (o.x * o.x + o.y * o.y) + (o.z * o.z + o.w * o.w);
        ss += DPPF(ss, 0xB1, 0xf); ss += DPPF(ss, 0x4E, 0xf); ss += DPPF(ss, 0x141, 0xf); ss += DPPF(ss, 0x140, 0xf);
        { const auto sw_ = __builtin_amdgcn_permlane16_swap(__float_as_uint(ss), __float_as_uint(ss), false, false); ss = __uint_as_float(sw_[0]) + __uint_as_float(sw_[1]); }
        const float sc = rsqrtf(ss * (1.0f / 128.0f) + 1e-6f);
        const float z0 = bflo(zb.x), z1 = bfhi(zb.x), z2 = bflo(zb.y), z3 = bfhi(zb.y);
        v2u ob;
        ob.x = pk2(o.x * sc * w.x * (z0 * __frcp_rn(1.0f + __expf(-z0))), o.y * sc * w.y * (z1 * __frcp_rn(1.0f + __expf(-z1))));
        ob.y = pk2(o.z * sc * w.z * (z2 * __frcp_rn(1.0f + __expf(-z2))), o.w * sc * w.w * (z3 * __frcp_rn(1.0f + __expf(-z3))));
        *(v2u*)(MIX + (size_t)t * 1024 + c0) = ob;
    }
#pragma unroll
    for (int jj = 0; jj < 2; ++jj) {
        const int c0 = 256 * jj + 4 * lane;
        const v2u gb = *(const v2u*)(prow + C_GATE + c0);
        f32x4 h = *(const f32x4*)(H + (size_t)t * 512 + c0);
        if (t < NP) { const f32x4 p = *(const f32x4*)(P + (size_t)t * 512 + c0), ci = *(const f32x4*)(CIN + (size_t)(t >> 6) * 512 + c0); h = h + p * ci; }
        v2u ob; ob.x = pk2(geluf_(bflo(gb.x)) * h.x, geluf_(bfhi(gb.x)) * h.y); ob.y = pk2(geluf_(bflo(gb.y)) * h.z, geluf_(bfhi(gb.y)) * h.w);
        *(v2u*)(MIX + (size_t)t * 1024 + 512 + c0) = ob;
    }
}

template <bool XBF>
__device__ __forceinline__ void ln_res_w(const void* __restrict__ xrow_, const bf16* __restrict__ yrow, const float* __restrict__ g, const float* __restrict__ bta,
                                         bf16* __restrict__ obrow, int lane) {
    f32x4 v[4]; float s = 0.f;
#pragma unroll
    for (int j = 0; j < 4; ++j) {
        f32x4 x4;
        if (XBF) { const v2u xb = ((const v2u*)xrow_)[lane + 64 * j]; x4 = (f32x4){bflo(xb.x), bfhi(xb.x), bflo(xb.y), bfhi(xb.y)}; }
        else x4 = ((const f32x4*)xrow_)[lane + 64 * j];
        const v2u yb = ((const v2u*)yrow)[lane + 64 * j];
        const f32x4 y4 = (f32x4){bflo(yb.x), bfhi(yb.x), bflo(yb.y), bfhi(yb.y)}; v[j] = x4 * ALPHA + y4; s += (v[j].x + v[j].y) + (v[j].z + v[j].w); }
    const float mean = wave_sum(s) * (1.0f / 1024.0f); float q = 0.f;
#pragma unroll
    for (int j = 0; j < 4; ++j) { v[j] = v[j] - mean; q += (v[j].x * v[j].x + v[j].y * v[j].y) + (v[j].z * v[j].z + v[j].w * v[j].w); }
    const float rs = rsqrtf(wave_sum(q) * (1.0f / 1024.0f) + LN_EPS);
#pragma unroll
    for (int j = 0; j < 4; ++j) {
        const f32x4 g4 = ((const f32x4*)g)[lane + 64 * j], b4 = ((const f32x4*)bta)[lane + 64 * j];
        const f32x4 o = v[j] * rs * g4 + b4;
        v2u ob; ob.x = pk2(o.x, o.y); ob.y = pk2(o.z, o.w);
        ((v2u*)obrow)[lane + 64 * j] = ob;
    }
}

__device__ __forceinline__ void peer_topk(const bf16* __restrict__ Q, const float* __restrict__ keys, int* __restrict__ EXP, float* __restrict__ GATE,
                                          int tg, int h, float* smem) {
    const int tid = threadIdx.x, cn = tid & 255, c = cn >> 7, n = cn & 127, th = tid >> 8;
    float (*sq)[256] = (float (*)[256])smem;
    float (*ss)[257] = (float (*)[257])(smem + 32 * 256);
    float (*tvs)[2][16] = (float (*)[2][16])(smem + 32 * 256 + 32 * 257 + 32);
    int (*tis)[2][16] = (int (*)[2][16])(smem + 32 * 256 + 32 * 257 + 32 + 1024);
    for (int i = tid; i < 32 * 256; i += NTH) {
        const int tk = i >> 8, col = i & 255;
        sq[tk][col] = bf2f(Q[(size_t)(tg * 32 + tk) * 2048 + h * 256 + col]);
    }
    __syncthreads();
    float acc[16];
#pragma unroll
    for (int i = 0; i < 16; ++i) acc[i] = 0.f;
    const float* krow = keys + (((size_t)h * 2 + c) * 128 + n) * 128;
    for (int d4 = 0; d4 < 32; ++d4) {
        const float4 kv = *(const float4*)(krow + d4 * 4);
#pragma unroll
        for (int tk = 0; tk < 16; ++tk) {
            const float4 qv = *(const float4*)&sq[th * 16 + tk][c * 128 + d4 * 4];
            acc[tk] += qv.x * kv.x + qv.y * kv.y + qv.z * kv.z + qv.w * kv.w;
        }
    }
#pragma unroll
    for (int tk = 0; tk < 16; ++tk) ss[th * 16 + tk][cn] = acc[tk];
    __syncthreads();
    if (tid < 64) {
        const int tk = tid >> 1, cc = tid & 1;
        float tv[16]; int ti[16];
#pragma unroll
        for (int j = 0; j < 16; ++j) { tv[j] = -INFINITY; ti[j] = 0; }
        for (int nn = 0; nn < 128; ++nn) {
            float x = ss[tk][cc * 128 + nn]; int xi = nn;
#pragma unroll
            for (int j = 0; j < 16; ++j) {
                const bool gt = x > tv[j];
                const float tf = tv[j]; const int tj = ti[j];
                tv[j] = gt ? x : tf; ti[j] = gt ? xi : tj;
                x = gt ? tf : x; xi = gt ? tj : xi;
            }
        }
#pragma unroll
        for (int j = 0; j < 16; ++j) { tvs[tk][cc][j] = tv[j]; tis[tk][cc][j] = ti[j]; }
    }
    __syncthreads();
    if (tid < 32) {
        const int tk = tid;
        float bv[16]; int bi[16];
#pragma unroll
        for (int j = 0; j < 16; ++j) { bv[j] = -INFINITY; bi[j] = 0; }
        for (int i = 0; i < 16; ++i)
            for (int jj = 0; jj < 16; ++jj) {
                float x = tvs[tk][0][i] + tvs[tk][1][jj]; int xi = tis[tk][0][i] * 128 + tis[tk][1][jj];
#pragma unroll
                for (int j = 0; j < 16; ++j) {
                    const bool gt = x > bv[j];
                    const float tf = bv[j]; const int tj = bi[j];
                    bv[j] = gt ? x : tf; bi[j] = gt ? xi : tj;
                    x = gt ? tf : x; xi = gt ? tj : xi;
                }
            }
        float e[16], sum = 0.f;
#pragma unroll
        for (int j = 0; j < 16; ++j) { e[j] = expf(bv[j] - bv[0]); sum += e[j]; }
        const float inv = 1.0f / sum;
        const size_t o = (size_t)(tg * 32 + tk) * 128 + h * 16;
#pragma unroll
        for (int j = 0; j < 16; ++j) { EXP[o + j] = bi[j]; GATE[o + j] = e[j] * inv; }
    }
}

__device__ __forceinline__ void peer_expert(const float* __restrict__ X, const int* __restrict__ EXP, const float* __restrict__ GATE,
                                            const float* __restrict__ U, const float* __restrict__ V,
                                            const float* __restrict__ g, const float* __restrict__ bta, float* __restrict__ out, bf16* __restrict__ outb, int t, float* smem) {
    const int tid = threadIdx.x, lane = tid & 63, wid = tid >> 6;
    float (*accs)[1024] = (float (*)[1024])smem;
    float* sred = smem + 8192;
    const float4* xr = (const float4*)(X + (size_t)t * D);
    float4 xv[4];
#pragma unroll
    for (int j = 0; j < 4; ++j) xv[j] = xr[lane + 64 * j];
    float4 acc[4];
#pragma unroll
    for (int j = 0; j < 4; ++j) acc[j] = make_float4(0.f, 0.f, 0.f, 0.f);
    for (int e = 0; e < 16; ++e) {
        const int id = EXP[(size_t)t * 128 + wid * 16 + e];
        const float gt = GATE[(size_t)t * 128 + wid * 16 + e];
        const float4* ur = (const float4*)(U + (size_t)id * D);
        const float4* vr = (const float4*)(V + (size_t)id * D);
        float4 uv[4], vv[4];
#pragma unroll
        for (int j = 0; j < 4; ++j) { uv[j] = ur[lane + 64 * j]; vv[j] = vr[lane + 64 * j]; }
        float dot = 0.f;
#pragma unroll
        for (int j = 0; j < 4; ++j) dot += uv[j].x * xv[j].x + uv[j].y * xv[j].y + uv[j].z * xv[j].z + uv[j].w * xv[j].w;
        dot = wave_sum(dot);
        const float cf = gt * geluf_(dot);
#pragma unroll
        for (int j = 0; j < 4; ++j) { acc[j].x += cf * vv[j].x; acc[j].y += cf * vv[j].y; acc[j].z += cf * vv[j].z; acc[j].w += cf * vv[j].w; }
    }
#pragma unroll
    for (int j = 0; j < 4; ++j) *(float4*)&accs[wid][(lane + 64 * j) * 4] = acc[j];
    __syncthreads();
    float v[2];
#pragma unroll
    for (int i = 0; i < 2; ++i) {
        const int c = tid * 2 + i;
        float s = 0.f;
#pragma unroll
        for (int w = 0; w < 8; ++w) s += accs[w][c];
        v[i] = ALPHA * X[(size_t)t * D + c] + s;
    }
    float s = wave_sum(v[0] + v[1]);
    if (lane == 0) sred[wid] = s;
    __syncthreads();
    float mean = 0.f;
#pragma unroll
    for (int w = 0; w < 8; ++w) mean += sred[w];
    mean *= (1.0f / 1024.0f);
    __syncthreads();
    const float d0 = v[0] - mean, d1 = v[1] - mean;
    float q = wave_sum(d0 * d0 + d1 * d1);
    if (lane == 0) sred[wid] = q;
    __syncthreads();
    float var = 0.f;
#pragma unroll
    for (int w = 0; w < 8; ++w) var += sred[w];
    const float rs = rsqrtf(var * (1.0f / 1024.0f) + LN_EPS);
    const float o0 = d0 * rs * g[tid * 2] + bta[tid * 2], o1 = d1 * rs * g[tid * 2 + 1] + bta[tid * 2 + 1];
    *(float2*)(out + (size_t)t * D + tid * 2) = make_float2(o0, o1);
    if (outb) *(unsigned*)(outb + (size_t)t * D + tid * 2) = pk2(o0, o1);
}


typedef __bf16 bf16x2_t __attribute__((ext_vector_type(2)));
__device__ __forceinline__ float dot2bf(unsigned w, unsigned x, float acc) { return __builtin_amdgcn_fdot2_f32_bf16(__builtin_bit_cast(bf16x2_t, w), __builtin_bit_cast(bf16x2_t, x), acc, false); }
typedef float f32x2_t __attribute__((ext_vector_type(2)));
__device__ __forceinline__ void row_to_fp8(const float* __restrict__ xrow, unsigned char* __restrict__ orow, float* __restrict__ scale, int lane) {
    f32x4 v[4]; float am = 0.f;
#pragma unroll
    for (int j = 0; j < 4; ++j) { v[j] = *(const f32x4*)(xrow + lane * 16 + j * 4); am = fmaxf(am, fmaxf(fmaxf(fabsf(v[j].x), fabsf(v[j].y)), fmaxf(fabsf(v[j].z), fabsf(v[j].w)))); }
    am = wave_max(am);
    const float s = am > 0.f ? am * (1.0f / 448.0f) : 1.0f, inv = 1.0f / s;
    v4u o;
    unsigned w;
    w = 0u; w = __builtin_amdgcn_cvt_pk_fp8_f32(v[0].x * inv, v[0].y * inv, w, false); w = __builtin_amdgcn_cvt_pk_fp8_f32(v[0].z * inv, v[0].w * inv, w, true); o.x = w;
    w = 0u; w = __builtin_amdgcn_cvt_pk_fp8_f32(v[1].x * inv, v[1].y * inv, w, false); w = __builtin_amdgcn_cvt_pk_fp8_f32(v[1].z * inv, v[1].w * inv, w, true); o.y = w;
    w = 0u; w = __builtin_amdgcn_cvt_pk_fp8_f32(v[2].x * inv, v[2].y * inv, w, false); w = __builtin_amdgcn_cvt_pk_fp8_f32(v[2].z * inv, v[2].w * inv, w, true); o.z = w;
    w = 0u; w = __builtin_amdgcn_cvt_pk_fp8_f32(v[3].x * inv, v[3].y * inv, w, false); w = __builtin_amdgcn_cvt_pk_fp8_f32(v[3].z * inv, v[3].w * inv, w, true); o.w = w;
    *(v4u*)(orow + lane * 16) = o;
    if (lane == 0) *scale = s;
}
#define PE_LOAD(UB, VB, grp) do { _Pragma("unroll") for (int i_ = 0; i_ < 4; ++i_) { const int e_ = (grp) * 4 + i_; \
        const int id_ = __builtin_amdgcn_readlane(e_ < 64 ? id0 : id1, e_ & 63); \
        const unsigned so_ = (unsigned)id_ * 1024u; \
        UB[i_] = __builtin_amdgcn_raw_buffer_load_b128(ursrc, voff, so_, 0); VB[i_] = __builtin_amdgcn_raw_buffer_load_b128(vrsrc, voff, so_, 0); } } while (0)
#define PE_DOT4(w, k) do { const f32x2_t l_ = __builtin_amdgcn_cvt_pk_f32_fp8((w), false), h_ = __builtin_amdgcn_cvt_pk_f32_fp8((w), true); \
        a_ += l_.x * xv[(k) * 4 + 0]; b_ += l_.y * xv[(k) * 4 + 1]; a_ += h_.x * xv[(k) * 4 + 2]; b_ += h_.y * xv[(k) * 4 + 3]; } while (0)
#define PE_AXPY4(w, k) do { const f32x2_t l_ = __builtin_amdgcn_cvt_pk_f32_fp8((w), false), h_ = __builtin_amdgcn_cvt_pk_f32_fp8((w), true); \
        acc[(k) * 4 + 0] += cf_ * l_.x; acc[(k) * 4 + 1] += cf_ * l_.y; acc[(k) * 4 + 2] += cf_ * h_.x; acc[(k) * 4 + 3] += cf_ * h_.y; } while (0)
#define PE_COMP(UB, VB, grp) do { float d_[4]; \
        _Pragma("unroll") for (int i_ = 0; i_ < 4; ++i_) { float a_ = 0.f, b_ = 0.f; PE_DOT4(UB[i_].x, 0); PE_DOT4(UB[i_].y, 1); PE_DOT4(UB[i_].z, 2); PE_DOT4(UB[i_].w, 3); d_[i_] = a_ + b_; } \
          \
        float s0_ = hi32 ? d_[2] : d_[0], t0_ = hi32 ? d_[0] : d_[2]; s0_ += __shfl_xor(t0_, 32); \
        float s1_ = hi32 ? d_[3] : d_[1], t1_ = hi32 ? d_[1] : d_[3]; s1_ += __shfl_xor(t1_, 32); \
        float r_ = hi16 ? s1_ : s0_, t2_ = hi16 ? s0_ : s1_; r_ += __shfl_xor(t2_, 16); \
        r_ += __shfl_xor(r_, 8); r_ += __shfl_xor(r_, 4); r_ += __shfl_xor(r_, 2); r_ += __shfl_xor(r_, 1); \
          \
        const int esel_ = (grp) * 4 + (lane >> 4); \
        const float su_ = __shfl(esel_ < 64 ? su0 : su1, esel_ & 63), gv_ = __shfl(esel_ < 64 ? gs0 : gs1, esel_ & 63); \
        const float cfl_ = geluf_(r_ * su_) * gv_; \
        _Pragma("unroll") for (int i_ = 0; i_ < 4; ++i_) { \
            const float cf_ = __uint_as_float(__builtin_amdgcn_readlane(__float_as_uint(cfl_), 16 * i_)); \
            PE_AXPY4(VB[i_].x, 0); PE_AXPY4(VB[i_].y, 1); PE_AXPY4(VB[i_].z, 2); PE_AXPY4(VB[i_].w, 3); } } while (0)
__device__ __forceinline__ void peer_expert_w(const float* __restrict__ xrow, const int* __restrict__ exr, const float* __restrict__ gar,
                                              const unsigned char* __restrict__ U, const unsigned char* __restrict__ V, const float* __restrict__ SU, const float* __restrict__ SV,
                                              const float* __restrict__ g, const float* __restrict__ bta, float* __restrict__ orow, bf16* __restrict__ obrow, int lane) {
    const bool hi32 = (lane & 32) != 0, hi16 = (lane & 16) != 0;
    const __amdgpu_buffer_rsrc_t ursrc = __builtin_amdgcn_make_buffer_rsrc((void*)U, 0, 16384 * 1024, 0x00020000);
    const __amdgpu_buffer_rsrc_t vrsrc = __builtin_amdgcn_make_buffer_rsrc((void*)V, 0, 16384 * 1024, 0x00020000);
    const int voff = lane * 16;
    float xv[16];
#pragma unroll
    for (int j = 0; j < 4; ++j) { const f32x4 t = *(const f32x4*)(xrow + lane * 16 + j * 4); xv[j * 4 + 0] = t.x; xv[j * 4 + 1] = t.y; xv[j * 4 + 2] = t.z; xv[j * 4 + 3] = t.w; }
    const int id0 = exr[lane], id1 = exr[64 + lane];
    const float su0 = SU[id0], su1 = SU[id1];
    const float gs0 = gar[lane] * SV[id0], gs1 = gar[64 + lane] * SV[id1];
    float acc[16];
#pragma unroll
    for (int i = 0; i < 16; ++i) acc[i] = 0.f;
    v4u ua[4], va[4], ub[4], vb[4];
    PE_LOAD(ua, va, 0);
#pragma unroll 1
    for (int grp = 0; grp < 32; grp += 2) {
        PE_LOAD(ub, vb, grp + 1);
        PE_COMP(ua, va, grp);
        if (grp + 2 < 32) PE_LOAD(ua, va, grp + 2);
        PE_COMP(ub, vb, grp + 1);
    }
    float v[16]; float s = 0.f;
#pragma unroll
    for (int i = 0; i < 16; ++i) { v[i] = ALPHA * xv[i] + acc[i]; s += v[i]; }
    const float mean = wave_sum(s) * (1.0f / 1024.0f); float q = 0.f;
#pragma unroll
    for (int i = 0; i < 16; ++i) { v[i] -= mean; q += v[i] * v[i]; }
    const float rs = rsqrtf(wave_sum(q) * (1.0f / 1024.0f) + LN_EPS);
    float o[16];
#pragma unroll
    for (int j = 0; j < 4; ++j) {
        const f32x4 g4 = *(const f32x4*)(g + lane * 16 + j * 4), b4 = *(const f32x4*)(bta + lane * 16 + j * 4);
        o[j * 4 + 0] = v[j * 4 + 0] * rs * g4.x + b4.x; o[j * 4 + 1] = v[j * 4 + 1] * rs * g4.y + b4.y; o[j * 4 + 2] = v[j * 4 + 2] * rs * g4.z + b4.z; o[j * 4 + 3] = v[j * 4 + 3] * rs * g4.w + b4.w;
        *(f32x4*)(orow + lane * 16 + j * 4) = (f32x4){o[j * 4 + 0], o[j * 4 + 1], o[j * 4 + 2], o[j * 4 + 3]};
    }
    if (obrow) {
        v4u w0, w1; w0.x = pk2(o[0], o[1]); w0.y = pk2(o[2], o[3]); w0.z = pk2(o[4], o[5]); w0.w = pk2(o[6], o[7]); w1.x = pk2(o[8], o[9]); w1.y = pk2(o[10], o[11]); w1.z = pk2(o[12], o[13]); w1.w = pk2(o[14], o[15]);
        *(v4u*)(obrow + lane * 16) = w0; *(v4u*)(obrow + lane * 16 + 8) = w1;
    }
}


__device__ __forceinline__ void peer_expert_blk(const float* __restrict__ xrow, const int* __restrict__ exr, const float* __restrict__ gar,
                                                const unsigned char* __restrict__ U, const unsigned char* __restrict__ V, const float* __restrict__ SU, const float* __restrict__ SV,
                                                const float* __restrict__ g, const float* __restrict__ bta, float* __restrict__ orow, bf16* __restrict__ obrow, int lane, int wave, float* smem) {
    const bool hi32 = (lane & 32) != 0, hi16 = (lane & 16) != 0;
    const __amdgpu_buffer_rsrc_t ursrc = __builtin_amdgcn_make_buffer_rsrc((void*)U, 0, 16384 * 1024, 0x00020000);
    const __amdgpu_buffer_rsrc_t vrsrc = __builtin_amdgcn_make_buffer_rsrc((void*)V, 0, 16384 * 1024, 0x00020000);
    const int voff = lane * 16;
    float xv[16];
#pragma unroll
    for (int j = 0; j < 4; ++j) { const f32x4 t = *(const f32x4*)(xrow + lane * 16 + j * 4); xv[j * 4 + 0] = t.x; xv[j * 4 + 1] = t.y; xv[j * 4 + 2] = t.z; xv[j * 4 + 3] = t.w; }
    const int id0 = exr[lane], id1 = exr[64 + lane];
    const float su0 = SU[id0], su1 = SU[id1];
    const float gs0 = gar[lane] * SV[id0], gs1 = gar[64 + lane] * SV[id1];
    float acc[16];
#pragma unroll
    for (int i = 0; i < 16; ++i) acc[i] = 0.f;
    v4u ua[4], va[4], ub[4], vb[4];
    const int g0 = wave * 4;
    PE_LOAD(ua, va, g0); PE_LOAD(ub, vb, g0 + 1);
    PE_COMP(ua, va, g0); PE_LOAD(ua, va, g0 + 2);
    PE_COMP(ub, vb, g0 + 1); PE_LOAD(ub, vb, g0 + 3);
    PE_COMP(ua, va, g0 + 2);
    PE_COMP(ub, vb, g0 + 3);
    float* accs = smem;
    float* sred = smem + 8192;
#pragma unroll
    for (int j = 0; j < 4; ++j) *(f32x4*)(accs + wave * 1024 + lane * 16 + j * 4) = (f32x4){acc[j * 4 + 0], acc[j * 4 + 1], acc[j * 4 + 2], acc[j * 4 + 3]};
    __syncthreads();
    const int tid = wave * 64 + lane;
    float v0 = ALPHA * xrow[tid * 2], v1 = ALPHA * xrow[tid * 2 + 1];
#pragma unroll
    for (int w = 0; w < 8; ++w) { v0 += accs[w * 1024 + tid * 2]; v1 += accs[w * 1024 + tid * 2 + 1]; }
    const float s = wave_sum(v0 + v1);
    if (lane == 0) sred[wave] = s;
    __syncthreads();
    float mean = 0.f;
#pragma unroll
    for (int w = 0; w < 8; ++w) mean += sred[w];
    mean *= (1.0f / 1024.0f);
    __syncthreads();
    const float d0 = v0 - mean, d1 = v1 - mean;
    const float q = wave_sum(d0 * d0 + d1 * d1);
    if (lane == 0) sred[wave] = q;
    __syncthreads();
    float var = 0.f;
#pragma unroll
    for (int w = 0; w < 8; ++w) var += sred[w];
    const float rs = rsqrtf(var * (1.0f / 1024.0f) + LN_EPS);
    const float o0 = d0 * rs * g[tid * 2] + bta[tid * 2], o1 = d1 * rs * g[tid * 2 + 1] + bta[tid * 2 + 1];
    *(float2*)(orow + tid * 2) = make_float2(o0, o1);
    if (obrow) *(unsigned*)(obrow + tid * 2) = pk2(o0, o1);
    __syncthreads();
}

__device__ __forceinline__ void row_to_fp8_sliced(const float* __restrict__ xrow, unsigned char* __restrict__ tab, int r, float* __restrict__ scale, int lane) {
    f32x4 v[4]; float am = 0.f;
#pragma unroll
    for (int j = 0; j < 4; ++j) { v[j] = *(const f32x4*)(xrow + lane * 16 + j * 4); am = fmaxf(am, fmaxf(fmaxf(fabsf(v[j].x), fabsf(v[j].y)), fmaxf(fabsf(v[j].z), fabsf(v[j].w)))); }
    am = wave_max(am);
    const float s = am > 0.f ? am * (1.0f / 448.0f) : 1.0f, inv = 1.0f / s;
    v4u o; unsigned w;
    w = 0u; w = __builtin_amdgcn_cvt_pk_fp8_f32(v[0].x * inv, v[0].y * inv, w, false); w = __builtin_amdgcn_cvt_pk_fp8_f32(v[0].z * inv, v[0].w * inv, w, true); o.x = w;
    w = 0u; w = __builtin_amdgcn_cvt_pk_fp8_f32(v[1].x * inv, v[1].y * inv, w, false); w = __builtin_amdgcn_cvt_pk_fp8_f32(v[1].z * inv, v[1].w * inv, w, true); o.y = w;
    w = 0u; w = __builtin_amdgcn_cvt_pk_fp8_f32(v[2].x * inv, v[2].y * inv, w, false); w = __builtin_amdgcn_cvt_pk_fp8_f32(v[2].z * inv, v[2].w * inv, w, true); o.z = w;
    w = 0u; w = __builtin_amdgcn_cvt_pk_fp8_f32(v[3].x * inv, v[3].y * inv, w, false); w = __builtin_amdgcn_cvt_pk_fp8_f32(v[3].z * inv, v[3].w * inv, w, true); o.w = w;
    *(v4u*)(tab + ((size_t)(lane >> 3) * 16384 + r) * 128 + (lane & 7) * 16) = o;
    if (lane == 0) *scale = s;
}
__device__ __forceinline__ void row_to_i8_sliced(const float* __restrict__ xrow, unsigned char* __restrict__ tab, int r, float* __restrict__ scale, int lane) {
    f32x4 v[4]; float am = 0.f;
#pragma unroll
    for (int j = 0; j < 4; ++j) { v[j] = *(const f32x4*)(xrow + lane * 16 + j * 4); am = fmaxf(am, fmaxf(fmaxf(fabsf(v[j].x), fabsf(v[j].y)), fmaxf(fabsf(v[j].z), fabsf(v[j].w)))); }
    am = wave_max(am);
    const float s = am > 0.f ? am * (1.0f / 127.0f) : 1.0f, inv = 1.0f / s;
    v4u o;
#define I8PK(q_) (((unsigned)(int)rintf((q_).x * inv) & 0xffu) | (((unsigned)(int)rintf((q_).y * inv) & 0xffu) << 8) | (((unsigned)(int)rintf((q_).z * inv) & 0xffu) << 16) | (((unsigned)(int)rintf((q_).w * inv) & 0xffu) << 24))
    o.x = I8PK(v[0]); o.y = I8PK(v[1]); o.z = I8PK(v[2]); o.w = I8PK(v[3]);
    *(v4u*)(tab + ((size_t)(lane >> 3) * 16384 + r) * 128 + (lane & 7) * 16) = o;
    if (lane == 0) *scale = s;
}

template <bool FP8>
__device__ __forceinline__ void table_rows_convert(const float* __restrict__ src, unsigned char* __restrict__ tab, float* __restrict__ scales, int rbeg, int rend, int gw, int ngw, int lane) {
    for (int r0 = rbeg + gw; r0 < rend; r0 += 4 * ngw) {
        f32x4 v[4][4]; int rr[4]; float am[4];
#pragma unroll
        for (int i = 0; i < 4; ++i) { rr[i] = r0 + i * ngw < rend ? r0 + i * ngw : rend - 1;
#pragma unroll
            for (int j = 0; j < 4; ++j) v[i][j] = *(const f32x4*)(src + (size_t)rr[i] * D + j * 256 + lane * 4); }
#pragma unroll
        for (int i = 0; i < 4; ++i) { float a = 0.f;
#pragma unroll
            for (int j = 0; j < 4; ++j) a = fmaxf(a, fmaxf(fmaxf(fabsf(v[i][j].x), fabsf(v[i][j].y)), fmaxf(fabsf(v[i][j].z), fabsf(v[i][j].w))));
            am[i] = a; }
#pragma unroll
        for (int i = 0; i < 4; ++i) am[i] = wave_max(am[i]);
#pragma unroll
        for (int i = 0; i < 4; ++i) {
            const float s = am[i] > 0.f ? am[i] * (FP8 ? 1.0f / 448.0f : 1.0f / 127.0f) : 1.0f, inv = 1.0f / s;
#pragma unroll
            for (int j = 0; j < 4; ++j) {
                unsigned w;
                if (FP8) { w = 0u; w = __builtin_amdgcn_cvt_pk_fp8_f32(v[i][j].x * inv, v[i][j].y * inv, w, false); w = __builtin_amdgcn_cvt_pk_fp8_f32(v[i][j].z * inv, v[i][j].w * inv, w, true); }
                else w = ((unsigned)(int)rintf(v[i][j].x * inv) & 0xffu) | (((unsigned)(int)rintf(v[i][j].y * inv) & 0xffu) << 8) | (((unsigned)(int)rintf(v[i][j].z * inv) & 0xffu) << 16) | (((unsigned)(int)rintf(v[i][j].w * inv) & 0xffu) << 24);
                *(unsigned*)(tab + ((size_t)(2 * j + (lane >> 5)) * 16384 + rr[i]) * 128 + (lane & 31) * 4) = w;
            }
            if (lane == 0) scales[rr[i]] = s;
        }
    }
}
__device__ __forceinline__ void peer_u_pass(const bf16* __restrict__ xrow, const int* __restrict__ exr, const unsigned char* __restrict__ U8x, float* __restrict__ pd, int x, int lane) {
    const int e8 = lane >> 3, c = lane & 7;
    f32x2_t xp[8];
#pragma unroll
    for (int j = 0; j < 2; ++j) { const v4u t = *(const v4u*)(xrow + x * 128 + c * 16 + j * 8);
        xp[j * 4 + 0] = (f32x2_t){bflo(t.x), bfhi(t.x)}; xp[j * 4 + 1] = (f32x2_t){bflo(t.y), bfhi(t.y)}; xp[j * 4 + 2] = (f32x2_t){bflo(t.z), bfhi(t.z)}; xp[j * 4 + 3] = (f32x2_t){bflo(t.w), bfhi(t.w)}; }
    const __amdgpu_buffer_rsrc_t ursrc = __builtin_amdgcn_make_buffer_rsrc((void*)U8x, 0, 16384 * 128, 0x00020000);
    v4u wa[8], wb[8];
    float d[16];
    int ids[16];
#pragma unroll
    for (int j = 0; j < 4; ++j) { const v4u t = *(const v4u*)(exr + e8 * 16 + j * 4); ids[j * 4 + 0] = (int)t.x; ids[j * 4 + 1] = (int)t.y; ids[j * 4 + 2] = (int)t.z; ids[j * 4 + 3] = (int)t.w; }
#pragma unroll
    for (int g = 0; g < 8; ++g) wa[g] = __builtin_amdgcn_raw_buffer_load_b128(ursrc, ids[g] * 128 + c * 16, 0, 0);
#pragma unroll
    for (int g = 0; g < 8; ++g) wb[g] = __builtin_amdgcn_raw_buffer_load_b128(ursrc, ids[8 + g] * 128 + c * 16, 0, 0);
#define PU_DOT1(w_, k_) do { a_ = __builtin_elementwise_fma(__builtin_amdgcn_cvt_pk_f32_fp8((w_), false), xp[(k_) * 2], a_); a_ = __builtin_elementwise_fma(__builtin_amdgcn_cvt_pk_f32_fp8((w_), true), xp[(k_) * 2 + 1], a_); } while (0)
#pragma unroll
    for (int g = 0; g < 8; ++g) { f32x2_t a_ = (f32x2_t){0.f, 0.f}; PU_DOT1(wa[g].x, 0); PU_DOT1(wa[g].y, 1); PU_DOT1(wa[g].z, 2); PU_DOT1(wa[g].w, 3); d[g] = a_.x + a_.y; }
#pragma unroll
    for (int g = 0; g < 8; ++g) { f32x2_t a_ = (f32x2_t){0.f, 0.f}; PU_DOT1(wb[g].x, 0); PU_DOT1(wb[g].y, 1); PU_DOT1(wb[g].z, 2); PU_DOT1(wb[g].w, 3); d[8 + g] = a_.x + a_.y; }
#pragma unroll
    for (int g = 0; g < 16; ++g) { d[g] += DPPF(d[g], 0xB1, 0xf); d[g] += DPPF(d[g], 0x4E, 0xf); d[g] += DPPF(d[g], 0x141, 0xf); }
    if (c == 0) {
#pragma unroll
        for (int j = 0; j < 4; ++j) *(f32x4*)(pd + e8 * 16 + j * 4) = (f32x4){d[j * 4 + 0], d[j * 4 + 1], d[j * 4 + 2], d[j * 4 + 3]};
    }
}
#define PUL_IDS(I, k_) do { const int t_ = ((tg0 + ((k_) < nit ? (k_) : nit - 1) * tgstep) * 8 + wave); _Pragma("unroll") for (int j = 0; j < 4; ++j) I[j] = *(const v4u*)(EXPp + (size_t)t_ * 128 + e8 * 16 + j * 4); } while (0)
#define PUL_ROWS(R, X, I, k_) do { const int t_ = ((tg0 + ((k_) < nit ? (k_) : nit - 1) * tgstep) * 8 + wave); \
        X[0] = *(const v4u*)(XBp + (size_t)t_ * D + x * 128 + c * 16); X[1] = *(const v4u*)(XBp + (size_t)t_ * D + x * 128 + c * 16 + 8); \
        _Pragma("unroll") for (int j = 0; j < 4; ++j) { R[j * 4 + 0] = __builtin_amdgcn_raw_buffer_load_b128(ursrc, (int)I[j].x * 128 + c * 16, 0, 0); R[j * 4 + 1] = __builtin_amdgcn_raw_buffer_load_b128(ursrc, (int)I[j].y * 128 + c * 16, 0, 0); \
            R[j * 4 + 2] = __builtin_amdgcn_raw_buffer_load_b128(ursrc, (int)I[j].z * 128 + c * 16, 0, 0); R[j * 4 + 3] = __builtin_amdgcn_raw_buffer_load_b128(ursrc, (int)I[j].w * 128 + c * 16, 0, 0); } } while (0)
#define PUL_COMP(R, X, k_) do { float xf_[16]; \
        _Pragma("unroll") for (int j = 0; j < 2; ++j) { xf_[j * 8 + 0] = bflo(X[j].x); xf_[j * 8 + 1] = bfhi(X[j].x); xf_[j * 8 + 2] = bflo(X[j].y); xf_[j * 8 + 3] = bfhi(X[j].y); xf_[j * 8 + 4] = bflo(X[j].z); xf_[j * 8 + 5] = bfhi(X[j].z); xf_[j * 8 + 6] = bflo(X[j].w); xf_[j * 8 + 7] = bfhi(X[j].w); } \
          \
        float am_ = 0.f; _Pragma("unroll") for (int i = 0; i < 16; ++i) am_ = fmaxf(am_, fabsf(xf_[i])); \
        am_ = fmaxf(am_, DPPF(am_, 0xB1, 0xf)); am_ = fmaxf(am_, DPPF(am_, 0x4E, 0xf)); am_ = fmaxf(am_, DPPF(am_, 0x141, 0xf)); \
        const float sx_ = am_ > 0.f ? am_ * (1.0f / 127.0f) : 1.0f, ix_ = 1.0f / sx_; \
        int xq_[4]; \
        _Pragma("unroll") for (int j = 0; j < 4; ++j) xq_[j] = (int)(((unsigned)(int)rintf(xf_[j * 4 + 0] * ix_) & 0xffu) | (((unsigned)(int)rintf(xf_[j * 4 + 1] * ix_) & 0xffu) << 8) | (((unsigned)(int)rintf(xf_[j * 4 + 2] * ix_) & 0xffu) << 16) | (((unsigned)(int)rintf(xf_[j * 4 + 3] * ix_) & 0xffu) << 24)); \
        float d[16]; \
        _Pragma("unroll") for (int g = 0; g < 16; ++g) { int a_ = __builtin_amdgcn_sdot4((int)R[g].x, xq_[0], 0, false); a_ = __builtin_amdgcn_sdot4((int)R[g].y, xq_[1], a_, false); a_ = __builtin_amdgcn_sdot4((int)R[g].z, xq_[2], a_, false); a_ = __builtin_amdgcn_sdot4((int)R[g].w, xq_[3], a_, false); d[g] = (float)a_; } \
        _Pragma("unroll") for (int g = 0; g < 16; ++g) { d[g] += DPPF(d[g], 0xB1, 0xf); d[g] += DPPF(d[g], 0x4E, 0xf); d[g] += DPPF(d[g], 0x141, 0xf); d[g] *= sx_; } \
        if (c == 0 && (k_) < nit) { float* pd_ = PDx + (size_t)((tg0 + (k_) * tgstep) * 8 + wave) * 128 + e8 * 16; \
            _Pragma("unroll") for (int j = 0; j < 4; ++j) *(f32x4*)(pd_ + j * 4) = (f32x4){d[j * 4 + 0], d[j * 4 + 1], d[j * 4 + 2], d[j * 4 + 3]}; } } while (0)
__device__ __forceinline__ void peer_u_loop(const bf16* __restrict__ XBp, const int* __restrict__ EXPp, const unsigned char* __restrict__ U8x, float* __restrict__ PDx, int x, int tg0, int tgstep, int nit, int wave, int lane) {
    const int e8 = lane >> 3, c = lane & 7;
    const __amdgpu_buffer_rsrc_t ursrc = __builtin_amdgcn_make_buffer_rsrc((void*)U8x, 0, 16384 * 128, 0x00020000);
    v4u ra[16], rb[16], xa[2], xb[2], i0[4], i1[4];
    PUL_IDS(i0, 0);
    PUL_ROWS(ra, xa, i0, 0);
    PUL_IDS(i1, 1);
#pragma unroll 1
    for (int k = 0; k < nit; k += 2) {
        PUL_ROWS(rb, xb, i1, k + 1);
        PUL_IDS(i0, k + 2);
        PUL_COMP(ra, xa, k);
        PUL_ROWS(ra, xa, i0, k + 2);
        PUL_IDS(i1, k + 3);
        PUL_COMP(rb, xb, k + 1);
    }
}
#define PV_LOAD(VB, grp) do { _Pragma("unroll") for (int i_ = 0; i_ < 4; ++i_) { const int e_ = (grp) * 4 + i_; \
        const int id_ = __builtin_amdgcn_readlane(e_ < 64 ? id0 : id1, e_ & 63); \
        VB[i_] = __builtin_amdgcn_raw_buffer_load_b128(vrsrc, voff, (unsigned)id_ * 1024u, 0); } } while (0)
#define PV_COMP(VB, grp) do { _Pragma("unroll") for (int i_ = 0; i_ < 4; ++i_) { const int e_ = (grp) * 4 + i_; \
        const float cf_ = __uint_as_float(__builtin_amdgcn_readlane(__float_as_uint(e_ < 64 ? cf0 : cf1), e_ & 63)); \
        PE_AXPY4(VB[i_].x, 0); PE_AXPY4(VB[i_].y, 1); PE_AXPY4(VB[i_].z, 2); PE_AXPY4(VB[i_].w, 3); } } while (0)
#define PV_COEFS() \
    const int id0 = exr[lane], id1 = exr[64 + lane]; \
    float dot0 = 0.f, dot1 = 0.f; \
    { const int p0 = lane, p1 = 64 + lane;        \
      _Pragma("unroll") for (int x_ = 0; x_ < 8; ++x_) { dot0 += pdt[(size_t)x_ * NT * 128 + p0]; dot1 += pdt[(size_t)x_ * NT * 128 + p1]; } } \
    const float cf0 = gar[lane] * SV[id0] * geluf_(SU[id0] * dot0), cf1 = gar[64 + lane] * SV[id1] * geluf_(SU[id1] * dot1);
__device__ __forceinline__ void peer_v_w(const float* __restrict__ xrow, const int* __restrict__ exr, const float* __restrict__ gar, const float* __restrict__ pdt,
                                         const unsigned char* __restrict__ V, const float* __restrict__ SU, const float* __restrict__ SV,
                                         const float* __restrict__ g, const float* __restrict__ bta, float* __restrict__ orow, bf16* __restrict__ obrow, int lane) {
    const __amdgpu_buffer_rsrc_t vrsrc = __builtin_amdgcn_make_buffer_rsrc((void*)V, 0, 16384 * 1024, 0x00020000);
    const int voff = lane * 16;
    PV_COEFS()
    float acc[16];
#pragma unroll
    for (int i = 0; i < 16; ++i) acc[i] = 0.f;
    v4u va[4], vb[4], vc[4];
    PV_LOAD(va, 0); PV_LOAD(vb, 1);
#pragma unroll 1
    for (int grp = 0; grp < 30; grp += 3) {
        PV_LOAD(vc, grp + 2);
        PV_COMP(va, grp);
        PV_LOAD(va, grp + 3);
        PV_COMP(vb, grp + 1);
        PV_LOAD(vb, grp + 4);
        PV_COMP(vc, grp + 2);
    }
    PV_COMP(va, 30); PV_COMP(vb, 31);
    float xv[16];
#pragma unroll
    for (int j = 0; j < 4; ++j) { const f32x4 t = *(const f32x4*)(xrow + lane * 16 + j * 4); xv[j * 4 + 0] = t.x; xv[j * 4 + 1] = t.y; xv[j * 4 + 2] = t.z; xv[j * 4 + 3] = t.w; }
    float v[16]; float s = 0.f;
#pragma unroll
    for (int i = 0; i < 16; ++i) { v[i] = ALPHA * xv[i] + acc[i]; s += v[i]; }
    const float mean = wave_sum(s) * (1.0f / 1024.0f); float q = 0.f;
#pragma unroll
    for (int i = 0; i < 16; ++i) { v[i] -= mean; q += v[i] * v[i]; }
    const float rs = rsqrtf(wave_sum(q) * (1.0f / 1024.0f) + LN_EPS);
    float o[16];
#pragma unroll
    for (int j = 0; j < 4; ++j) {
        const f32x4 g4 = *(const f32x4*)(g + lane * 16 + j * 4), b4 = *(const f32x4*)(bta + lane * 16 + j * 4);
        o[j * 4 + 0] = v[j * 4 + 0] * rs * g4.x + b4.x; o[j * 4 + 1] = v[j * 4 + 1] * rs * g4.y + b4.y; o[j * 4 + 2] = v[j * 4 + 2] * rs * g4.z + b4.z; o[j * 4 + 3] = v[j * 4 + 3] * rs * g4.w + b4.w;
        *(f32x4*)(orow + lane * 16 + j * 4) = (f32x4){o[j * 4 + 0], o[j * 4 + 1], o[j * 4 + 2], o[j * 4 + 3]};
    }
    if (obrow) {
        v4u w0, w1; w0.x = pk2(o[0], o[1]); w0.y = pk2(o[2], o[3]); w0.z = pk2(o[4], o[5]); w0.w = pk2(o[6], o[7]); w1.x = pk2(o[8], o[9]); w1.y = pk2(o[10], o[11]); w1.z = pk2(o[12], o[13]); w1.w = pk2(o[14], o[15]);
        *(v4u*)(obrow + lane * 16) = w0; *(v4u*)(obrow + lane * 16 + 8) = w1;
    }
}
__device__ __forceinline__ void peer_v_blk(const float* __restrict__ xrow, const int* __restrict__ exr, const float* __restrict__ gar, const float* __restrict__ pdt,
                                           const unsigned char* __restrict__ V, const float* __restrict__ SU, const float* __restrict__ SV,
                                           const float* __restrict__ g, const float* __restrict__ bta, float* __restrict__ orow, bf16* __restrict__ obrow, int lane, int wave, float* smem) {
    const __amdgpu_buffer_rsrc_t vrsrc = __builtin_amdgcn_make_buffer_rsrc((void*)V, 0, 16384 * 1024, 0x00020000);
    const int voff = lane * 16;
    PV_COEFS()
    float acc[16];
#pragma unroll
    for (int i = 0; i < 16; ++i) acc[i] = 0.f;
    v4u va[4], vb[4], vc[4], vd[4];
    PV_LOAD(va, wave * 4); PV_LOAD(vb, wave * 4 + 1); PV_LOAD(vc, wave * 4 + 2); PV_LOAD(vd, wave * 4 + 3);
    PV_COMP(va, wave * 4); PV_COMP(vb, wave * 4 + 1); PV_COMP(vc, wave * 4 + 2); PV_COMP(vd, wave * 4 + 3);
    float* accs = smem;
    float* sred = smem + 8192;
#pragma unroll
    for (int j = 0; j < 4; ++j) *(f32x4*)(accs + wave * 1024 + lane * 16 + j * 4) = (f32x4){acc[j * 4 + 0], acc[j * 4 + 1], acc[j * 4 + 2], acc[j * 4 + 3]};
    __syncthreads();
    const int tid = wave * 64 + lane;
    float v0 = ALPHA * xrow[tid * 2], v1 = ALPHA * xrow[tid * 2 + 1];
#pragma unroll
    for (int w = 0; w < 8; ++w) { v0 += accs[w * 1024 + tid * 2]; v1 += accs[w * 1024 + tid * 2 + 1]; }
    const float s = wave_sum(v0 + v1);
    if (lane == 0) sred[wave] = s;
    __syncthreads();
    float mean = 0.f;
#pragma unroll
    for (int w = 0; w < 8; ++w) mean += sred[w];
    mean *= (1.0f / 1024.0f);
    __syncthreads();
    const float d0 = v0 - mean, d1 = v1 - mean;
    const float q = wave_sum(d0 * d0 + d1 * d1);
    if (lane == 0) sred[wave] = q;
    __syncthreads();
    float var = 0.f;
#pragma unroll
    for (int w = 0; w < 8; ++w) var += sred[w];
    const float rs = rsqrtf(var * (1.0f / 1024.0f) + LN_EPS);
    const float o0 = d0 * rs * g[tid * 2] + bta[tid * 2], o1 = d1 * rs * g[tid * 2 + 1] + bta[tid * 2 + 1];
    *(float2*)(orow + tid * 2) = make_float2(o0, o1);
    if (obrow) *(unsigned*)(obrow + tid * 2) = pk2(o0, o1);
    __syncthreads();
}

__device__ __forceinline__ void peer_xk(const int* __restrict__ exr, float* __restrict__ gar, const float* __restrict__ pdt, const float* __restrict__ SU, const float* __restrict__ SV, int lane) {
    PV_COEFS()
    gar[lane] = cf0; gar[64 + lane] = cf1;
}
__device__ __forceinline__ void peer_v_slice(const int* __restrict__ exr, const float* __restrict__ cfr, const unsigned char* __restrict__ V8x, float* __restrict__ outs  , int lane) {
    const int e8 = lane >> 3, c = lane & 7;
    const __amdgpu_buffer_rsrc_t vrsrc = __builtin_amdgcn_make_buffer_rsrc((void*)V8x, 0, 16384 * 128, 0x00020000);
    v4u wa[8], wb[8]; float cfa[8], cfb[8];
    int ids[16];
#pragma unroll
    for (int j = 0; j < 4; ++j) { const v4u t = *(const v4u*)(exr + e8 * 16 + j * 4); ids[j * 4 + 0] = (int)t.x; ids[j * 4 + 1] = (int)t.y; ids[j * 4 + 2] = (int)t.z; ids[j * 4 + 3] = (int)t.w; }
#pragma unroll
    for (int g = 0; g < 8; ++g) wa[g] = __builtin_amdgcn_raw_buffer_load_b128(vrsrc, ids[g] * 128 + c * 16, 0, 0);
#pragma unroll
    for (int g = 0; g < 8; ++g) wb[g] = __builtin_amdgcn_raw_buffer_load_b128(vrsrc, ids[8 + g] * 128 + c * 16, 0, 0);
#pragma unroll
    for (int j = 0; j < 2; ++j) { const f32x4 t = *(const f32x4*)(cfr + e8 * 16 + j * 4), u = *(const f32x4*)(cfr + e8 * 16 + 8 + j * 4);
        cfa[j * 4 + 0] = t.x; cfa[j * 4 + 1] = t.y; cfa[j * 4 + 2] = t.z; cfa[j * 4 + 3] = t.w; cfb[j * 4 + 0] = u.x; cfb[j * 4 + 1] = u.y; cfb[j * 4 + 2] = u.z; cfb[j * 4 + 3] = u.w; }
    f32x2_t ap[8];
#pragma unroll
    for (int i = 0; i < 8; ++i) ap[i] = (f32x2_t){0.f, 0.f};
#define PVS_AXPY(w_, k_) do { ap[(k_) * 2] = __builtin_elementwise_fma(cf2_, __builtin_amdgcn_cvt_pk_f32_fp8((w_), false), ap[(k_) * 2]); ap[(k_) * 2 + 1] = __builtin_elementwise_fma(cf2_, __builtin_amdgcn_cvt_pk_f32_fp8((w_), true), ap[(k_) * 2 + 1]); } while (0)
#pragma unroll
    for (int g = 0; g < 8; ++g) { const f32x2_t cf2_ = (f32x2_t){cfa[g], cfa[g]}; PVS_AXPY(wa[g].x, 0); PVS_AXPY(wa[g].y, 1); PVS_AXPY(wa[g].z, 2); PVS_AXPY(wa[g].w, 3); }
#pragma unroll
    for (int g = 0; g < 8; ++g) { const f32x2_t cf2_ = (f32x2_t){cfb[g], cfb[g]}; PVS_AXPY(wb[g].x, 0); PVS_AXPY(wb[g].y, 1); PVS_AXPY(wb[g].z, 2); PVS_AXPY(wb[g].w, 3); }
#undef PVS_AXPY
    float acc[16];
#pragma unroll
    for (int i = 0; i < 8; ++i) { acc[2 * i] = ap[i].x; acc[2 * i + 1] = ap[i].y; }
#pragma unroll
    for (int i = 0; i < 16; ++i) { float v = acc[i]; v += DPPF(v, 0x128, 0xf); v += __shfl_xor(v, 16); v += __shfl_xor(v, 32); acc[i] = v; }
    if (e8 == 0) {
#pragma unroll
        for (int j = 0; j < 4; ++j) *(f32x4*)(outs + c * 16 + j * 4) = (f32x4){acc[j * 4 + 0], acc[j * 4 + 1], acc[j * 4 + 2], acc[j * 4 + 3]};
    }
}
#define PVL_IDS(I, k_) do { const int t_ = ((tg0 + ((k_) < nit ? (k_) : nit - 1) * tgstep) * 8 + wave); _Pragma("unroll") for (int j = 0; j < 4; ++j) I[j] = *(const v4u*)(EXPp + (size_t)t_ * 128 + e8 * 16 + j * 4); } while (0)
#define PVL_ROWS(R, C, I, k_) do { const int t_ = ((tg0 + ((k_) < nit ? (k_) : nit - 1) * tgstep) * 8 + wave); \
        _Pragma("unroll") for (int j = 0; j < 4; ++j) C[j] = *(const f32x4*)(CFp + (size_t)t_ * 128 + e8 * 16 + j * 4); \
        _Pragma("unroll") for (int j = 0; j < 4; ++j) { R[j * 4 + 0] = __builtin_amdgcn_raw_buffer_load_b128(vrsrc, (int)I[j].x * 128 + c * 16, 0, 0); R[j * 4 + 1] = __builtin_amdgcn_raw_buffer_load_b128(vrsrc, (int)I[j].y * 128 + c * 16, 0, 0); \
            R[j * 4 + 2] = __builtin_amdgcn_raw_buffer_load_b128(vrsrc, (int)I[j].z * 128 + c * 16, 0, 0); R[j * 4 + 3] = __builtin_amdgcn_raw_buffer_load_b128(vrsrc, (int)I[j].w * 128 + c * 16, 0, 0); } } while (0)
#define PVL_AXPY(w_, k2_) do { ap[(k2_) * 2] = __builtin_elementwise_fma(cf2_, __builtin_amdgcn_cvt_pk_f32_fp8((w_), false), ap[(k2_) * 2]); ap[(k2_) * 2 + 1] = __builtin_elementwise_fma(cf2_, __builtin_amdgcn_cvt_pk_f32_fp8((w_), true), ap[(k2_) * 2 + 1]); } while (0)
#define PVL_COMP(R, C, k_) do { f32x2_t ap[8]; \
        _Pragma("unroll") for (int i = 0; i < 8; ++i) ap[i] = (f32x2_t){0.f, 0.f}; \
        _Pragma("unroll") for (int g = 0; g < 16; ++g) { const float cfs_ = C[g >> 2][g & 3]; const f32x2_t cf2_ = (f32x2_t){cfs_, cfs_}; PVL_AXPY(R[g].x, 0); PVL_AXPY(R[g].y, 1); PVL_AXPY(R[g].z, 2); PVL_AXPY(R[g].w, 3); } \
        float acc[16]; \
        _Pragma("unroll") for (int i = 0; i < 8; ++i) { acc[2 * i] = ap[i].x; acc[2 * i + 1] = ap[i].y; } \
        float a8[8], a4[4], a2[2]; \
          \
        _Pragma("unroll") for (int i = 0; i < 8; ++i) { const auto sw_ = __builtin_amdgcn_permlane32_swap(__float_as_uint(acc[i]), __float_as_uint(acc[8 + i]), false, false); a8[i] = __uint_as_float(sw_[0]) + __uint_as_float(sw_[1]); } \
        _Pragma("unroll") for (int i = 0; i < 4; ++i) { const auto sw_ = __builtin_amdgcn_permlane16_swap(__float_as_uint(a8[i]), __float_as_uint(a8[4 + i]), false, false); a4[i] = __uint_as_float(sw_[0]) + __uint_as_float(sw_[1]); } \
        _Pragma("unroll") for (int i = 0; i < 2; ++i) { const float keep = hC ? a4[2 + i] : a4[i], send = hC ? a4[i] : a4[2 + i]; a2[i] = keep + DPPF(send, 0x128, 0xf); } \
        if ((k_) < nit) *(float2*)(OUTp + (size_t)((tg0 + (k_) * tgstep) * 8 + wave) * D + x * 128 + c * 16 + 2 * e8) = make_float2(a2[0], a2[1]); } while (0)
__device__ __forceinline__ void peer_v_loop(const int* __restrict__ EXPp, const float* __restrict__ CFp, const unsigned char* __restrict__ V8x, float* __restrict__ OUTp, int x, int tg0, int tgstep, int nit, int wave, int lane) {
    const int e8 = lane >> 3, c = lane & 7;
    const bool hA = (lane & 32) != 0, hB = (lane & 16) != 0, hC = (lane & 8) != 0;
    const __amdgpu_buffer_rsrc_t vrsrc = __builtin_amdgcn_make_buffer_rsrc((void*)V8x, 0, 16384 * 128, 0x00020000);
    v4u ra[16], rb[16], i0[4], i1[4]; f32x4 ca[4], cb[4];
    PVL_IDS(i0, 0);
    PVL_ROWS(ra, ca, i0, 0);
    PVL_IDS(i1, 1);
#pragma unroll 1
    for (int k = 0; k < nit; k += 2) {
        PVL_ROWS(rb, cb, i1, k + 1);
        PVL_IDS(i0, k + 2);
        PVL_COMP(ra, ca, k);
        PVL_ROWS(ra, ca, i0, k + 2);
        PVL_IDS(i1, k + 3);
        PVL_COMP(rb, cb, k + 1);
    }
}
__device__ __forceinline__ void peer_xc(const bf16* __restrict__ xrow, const float* __restrict__ srow, const float* __restrict__ g, const float* __restrict__ bta, float* __restrict__ orow, bf16* __restrict__ obrow, bf16* __restrict__ obrow2, int lane) {
    f32x4 v[4]; float s = 0.f;
#pragma unroll
    for (int j = 0; j < 4; ++j) { const v2u ab = ((const v2u*)xrow)[lane + 64 * j]; const f32x4 b = ((const f32x4*)srow)[lane + 64 * j];
        v[j] = (f32x4){ALPHA * bflo(ab.x) + b.x, ALPHA * bfhi(ab.x) + b.y, ALPHA * bflo(ab.y) + b.z, ALPHA * bfhi(ab.y) + b.w}; s += (v[j].x + v[j].y) + (v[j].z + v[j].w); }
    const float mean = wave_sum(s) * (1.0f / 1024.0f); float q = 0.f;
#pragma unroll
    for (int j = 0; j < 4; ++j) { v[j] = v[j] - mean; q += (v[j].x * v[j].x + v[j].y * v[j].y) + (v[j].z * v[j].z + v[j].w * v[j].w); }
    const float rs = rsqrtf(wave_sum(q) * (1.0f / 1024.0f) + LN_EPS);
#pragma unroll
    for (int j = 0; j < 4; ++j) {
        const f32x4 g4 = ((const f32x4*)g)[lane + 64 * j], b4 = ((const f32x4*)bta)[lane + 64 * j];
        const f32x4 o = v[j] * rs * g4 + b4;
        if (orow) ((f32x4*)orow)[lane + 64 * j] = o;
        if (obrow) { v2u ob; ob.x = pk2(o.x, o.y); ob.y = pk2(o.z, o.w); ((v2u*)obrow)[lane + 64 * j] = ob; if (obrow2) ((v2u*)obrow2)[lane + 64 * j] = ob; }
    }
}

__device__ __forceinline__ int t5_bucket(int n) {
    if (n < 16) return n;
    const int large = 16 + (int)(logf((float)n / 16.0f) / 2.0794415416798357f * 16.0f);
    return large < 31 ? large : 31;
}
__device__ __forceinline__ void swa_attn(const float* __restrict__ PC, const float* __restrict__ cache_k, const float* __restrict__ cache_v,
                                         const float* __restrict__ rel_bias, const float* __restrict__ sinks, bf16* __restrict__ ATT, int bx) {
    const int tid = threadIdx.x, lane = tid & 63, wid = tid >> 6;
    const int gw = bx * 8 + wid;
    const int t = gw >> 4, h = gw & 15, kvh = h >> 2;
    if (t >= NT) return;
    const bool samp = t >= NP; const int sb = t - NP, pos = t % SEQ;
    const float* qrow = PC + (size_t)t * CN + h * 64;
    float lg[2]; bool valid[2];
#pragma unroll
    for (int rr = 0; rr < 2; ++rr) {
        const int r = lane + 64 * rr;
        const float* krow;
        if (!samp) { valid[rr] = (pos - r) >= 0; krow = PC + (size_t)(valid[rr] ? t - r : t) * CN + 1024 + kvh * 64; }
        else { valid[rr] = true; krow = (r == 0) ? PC + (size_t)t * CN + 1024 + kvh * 64 : cache_k + (((size_t)sb * 128 + (128 - r)) * 4 + kvh) * 64; }
        float dot = 0.f;
#pragma unroll
        for (int d4 = 0; d4 < 16; ++d4) {
            const float4 kv = *(const float4*)(krow + d4 * 4);
            const float4 qv = *(const float4*)(qrow + d4 * 4);
            dot += qv.x * kv.x + qv.y * kv.y + qv.z * kv.z + qv.w * kv.w;
        }
        lg[rr] = valid[rr] ? dot * 0.125f + rel_bias[t5_bucket(r) * 16 + h] : -INFINITY;
    }
    const float sink = sinks[h];
    const float m = fmaxf(wave_max(fmaxf(lg[0], lg[1])), sink);
    float p[2];
#pragma unroll
    for (int rr = 0; rr < 2; ++rr) p[rr] = valid[rr] ? expf(lg[rr] - m) : 0.f;
    const float den = wave_sum(p[0] + p[1]) + expf(sink - m);
    const float inv = 1.0f / den;
    float o = 0.f;
#pragma unroll
    for (int rr = 0; rr < 2; ++rr)
        for (int l2 = 0; l2 < 64; ++l2) {
            const int r = l2 + 64 * rr;
            const float pj = __shfl(p[rr], l2);
            if (pj != 0.f) {
                const float* vrow;
                if (!samp) vrow = PC + (size_t)(t - r) * CN + 1280 + kvh * 64;
                else vrow = (r == 0) ? PC + (size_t)t * CN + 1280 + kvh * 64 : cache_v + (((size_t)sb * 128 + (128 - r)) * 4 + kvh) * 64;
                o += pj * vrow[lane];
            }
        }
    ATT[(size_t)t * D + h * 64 + lane] = (bf16)f2bf(o * inv);
}

__device__ __forceinline__ void swa_kv_out(const float* __restrict__ PC, const float* __restrict__ cache_k, const float* __restrict__ cache_v,
                                           float* __restrict__ pk, float* __restrict__ pv, float* __restrict__ sk, float* __restrict__ sv, int vb) {
    const int c = threadIdx.x & 255, row = vb * 2 + (threadIdx.x >> 8);
    if (row < NB * 128) {
        const int b = row >> 7, i = row & 127;
        const float* src = PC + (size_t)(b * SEQ + SEQ - 128 + i) * CN;
        pk[(size_t)row * 256 + c] = src[1024 + c];
        pv[(size_t)row * 256 + c] = src[1280 + c];
    } else {
        const int r2 = row - NB * 128, sb = r2 >> 7, i = r2 & 127;
        if (i < 127) {
            sk[(size_t)r2 * 256 + c] = cache_k[((size_t)sb * 128 + i + 1) * 256 + c];
            sv[(size_t)r2 * 256 + c] = cache_v[((size_t)sb * 128 + i + 1) * 256 + c];
        } else {
            const float* src = PC + (size_t)(NP + sb) * CN;
            sk[(size_t)r2 * 256 + c] = src[1024 + c];
            sv[(size_t)r2 * 256 + c] = src[1280 + c];
        }
    }
}
#define XB_TMO      128
#define XB_XCNT(j)  (256  + 64 * (j))
#define XB_XSUB(j)  (1280 + 64 * (j))
#define XB_XGEN(j)  (2304 + 64 * (j))
#define XB_TOP      3328
#define XB_TOPGEN   3392
#define XCD_BAR_WORDS 3456
#define XB_SPIN_CAP (1u << 18)

__device__ __forceinline__ unsigned xb_ld(unsigned* p)              { return __hip_atomic_load(p, __ATOMIC_RELAXED, __HIP_MEMORY_SCOPE_AGENT); }
__device__ __forceinline__ unsigned xb_add(unsigned* p, unsigned v) { return __hip_atomic_fetch_add(p, v, __ATOMIC_RELAXED, __HIP_MEMORY_SCOPE_AGENT); }
__device__ __forceinline__ unsigned xb_xcc_id() { return (unsigned)__builtin_amdgcn_s_getreg((3 << 11) | 20) & 0xFu; }
#define XB_SPIN(cond, bar) do { unsigned _sp = 0; while (cond) { __builtin_amdgcn_s_sleep(1); \
    if ((++_sp & 255u) == 0u) { if (xb_ld(&(bar)[XB_TMO])) break; if (_sp > XB_SPIN_CAP) { atomicAdd(&(bar)[XB_TMO], 1u); break; } } } } while (0)

struct XcdBarrier {
    unsigned* bar; unsigned x;
    volatile LAS unsigned* st;
};

__device__ __forceinline__ XcdBarrier xcd_barrier_post(unsigned* bar, volatile LAS unsigned* st) {
    XcdBarrier b; b.bar = bar; b.x = xb_xcc_id(); b.st = st;
    if (threadIdx.x == 0) (void)xb_add(&bar[XB_XCNT(b.x)], 1u);
    return b;
}
__device__ __forceinline__ void xcd_barrier_complete(unsigned* bar, unsigned x, unsigned& nloc, unsigned& nx) {
    const unsigned G = gridDim.x * gridDim.y * gridDim.z;
    unsigned sum, cnt, mine, sp = 0u;
    for (;;) {
        sum = 0u; cnt = 0u; mine = 0u;
#pragma unroll
        for (unsigned j = 0; j < 16; ++j) { const unsigned c = xb_ld(&bar[XB_XCNT(j)]); sum += c; cnt += (c > 0u) ? 1u : 0u; mine = (j == x) ? c : mine; }
        if (sum == G) break;
        __builtin_amdgcn_s_sleep(1);
        if ((++sp & 255u) == 0u) { if (xb_ld(&bar[XB_TMO])) break; if (sp > XB_SPIN_CAP) { atomicAdd(&bar[XB_TMO], 1u); break; } }
    }
    nloc = mine > 0u ? mine : 1u; nx = cnt > 0u ? cnt : 1u;
}

__device__ __forceinline__ void xcd_barrier(const XcdBarrier& b) {
    asm volatile("s_waitcnt vmcnt(0)" ::: "memory");
    __syncthreads();
    if (threadIdx.x == 0) {
        unsigned* bar = b.bar;
        __builtin_amdgcn_s_waitcnt(0);
        unsigned nloc = b.st[0], nx = b.st[1];
        if (nloc == 0u) { xcd_barrier_complete(bar, b.x, nloc, nx); b.st[0] = nloc; b.st[1] = nx; }
        const unsigned old = xb_add(&bar[XB_XSUB(b.x)], 1u);
        const unsigned gen = old / nloc;
        if (old + 1u == (gen + 1u) * nloc) {
            __builtin_amdgcn_fence(__ATOMIC_RELEASE, "agent");
            asm volatile("s_waitcnt vmcnt(0)" ::: "memory");
            const unsigned og = xb_add(&bar[XB_TOP], 1u);
            const unsigned tg = og / nx;
            if (og + 1u == (tg + 1u) * nx) xb_add(&bar[XB_TOPGEN], 1u);
            else XB_SPIN(xb_ld(&bar[XB_TOPGEN]) == tg, bar);
            __builtin_amdgcn_fence(__ATOMIC_ACQUIRE, "agent");
            xb_add(&bar[XB_XGEN(b.x)], 1u);
            asm volatile("s_waitcnt vmcnt(0)" ::: "memory");
        } else {
            XB_SPIN(xb_ld(&bar[XB_XGEN(b.x)]) == gen, bar);
            __builtin_amdgcn_fence(__ATOMIC_ACQUIRE, "agent");
            asm volatile("s_waitcnt vmcnt(0)" ::: "memory");
        }
    }
    __syncthreads();
}

typedef short bf16x8_t __attribute__((ext_vector_type(8)));
__device__ __forceinline__ f32x4 mfma16(bf16x8_t a, bf16x8_t b, f32x4 c) { return __builtin_amdgcn_mfma_f32_16x16x32_bf16(a, b, c, 0, 0, 0); }

struct GdnChunkBufs {
    bf16* W;
    bf16* QG;
    bf16* KDT;
    bf16* UT;
    bf16* QK;
    float* EGL;
};

constexpr int GP_QB = 0, GP_KB = 17408, GP_VB = 34816, GP_LS = 52224, GP_QKS = 69632, GP_WS = 78848, GP_SC = 96256;

struct ConvJob { const float* u0; const float* v0; unsigned char* tab; float* tsc; };
__device__ __forceinline__ void gdn_prep_unit(const bf16* __restrict__ PROJ, const float* __restrict__ conv_w, const float* __restrict__ a_log, const float* __restrict__ dt_bias,
                                              const GdnChunkBufs& cb, float* __restrict__ p_gdn_conv, int un, unsigned char* lds, const ConvJob& cj) {
    int tid = threadIdx.x; asm volatile("" : "+v"(tid));
    const int lane = tid & 63, wave = __builtin_amdgcn_readfirstlane(tid >> 6), fr = lane & 15, fq = lane >> 4;
    const int h = un & 3, n = (un >> 2) & 63, b = un >> 8;
    const int t0 = b * SEQ + n * 64;
    bf16* Qb = (bf16*)(lds + GP_QB); bf16* Kb = (bf16*)(lds + GP_KB); bf16* Vb = (bf16*)(lds + GP_VB); bf16* Ws = (bf16*)(lds + GP_WS);
    float* Ls = (float*)(lds + GP_LS); bf16* QKs = (bf16*)(lds + GP_QKS);
    float* gcs = (float*)(lds + GP_SC); float* bets = gcs + 64; float* egcs = gcs + 128; float* ekds = gcs + 192; float* begs = gcs + 256;
    bf16 a_raw_h = 0, b_raw_h = 0; float alog_ = 0.f, dtb_ = 0.f;
    if (wave == 0) { const bf16* prow = PROJ + (size_t)(t0 + lane) * ABN; a_raw_h = prow[C_A + h]; b_raw_h = prow[C_B + h]; alog_ = a_log[h]; dtb_ = dt_bias[h]; }
    {
        const int part = lane >> 4, chunk = lane & 15, col0 = (part < 3 ? part : 2) * 512 + h * 128 + chunk * 8, i0 = wave * 8;
        v4u xr[11];
#pragma unroll
        for (int r = 0; r < 11; ++r) { const int pos = n * 64 + i0 - 3 + r; xr[r] = (v4u){0u, 0u, 0u, 0u}; if (pos >= 0 && part < 3) xr[r] = *(const v4u*)(PROJ + (size_t)(t0 + i0 - 3 + r) * ABN + col0); }
        f32x4 cwl[4][2];
#pragma unroll
        for (int tp = 0; tp < 4; ++tp) { cwl[tp][0] = *(const f32x4*)(conv_w + tp * 1536 + col0); cwl[tp][1] = *(const f32x4*)(conv_w + tp * 1536 + col0 + 4); }
        bf16* dstb = part == 0 ? Qb : (part == 1 ? Kb : Vb);
#pragma unroll
        for (int ii = 0; ii < 8; ++ii) {
            const int i = i0 + ii;
            float sv_[8], ss = 0.f;
#pragma unroll
            for (int e = 0; e < 8; ++e) {
                float y_ = 0.f;
#pragma unroll
                for (int tp = 0; tp < 4; ++tp) { const unsigned w_ = xr[ii + tp][e >> 1]; const float xv_ = (e & 1) ? bfhi(w_) : bflo(w_); y_ += cwl[tp][e >> 2][e & 3] * xv_; }
                sv_[e] = y_ * __frcp_rn(1.0f + __expf(-y_)); ss += sv_[e] * sv_[e];
            }
            ss += DPPF(ss, 0xB1, 0xf); ss += DPPF(ss, 0x4E, 0xf); ss += DPPF(ss, 0x141, 0xf); ss += DPPF(ss, 0x140, 0xf);
            const float scl_ = part == 0 ? rsqrtf(ss + 1e-6f) * 0.08838834764831845f : (part == 1 ? rsqrtf(ss + 1e-6f) : 1.0f);
            if (part < 3) {
                v4u o; o.x = pk2(sv_[0] * scl_, sv_[1] * scl_); o.y = pk2(sv_[2] * scl_, sv_[3] * scl_); o.z = pk2(sv_[4] * scl_, sv_[5] * scl_); o.w = pk2(sv_[6] * scl_, sv_[7] * scl_);
                *(v4u*)(dstb + i * 136 + chunk * 8) = o;
                if (n == 63 && i >= 61) {
                    const v4u w_ = xr[ii + 3]; float* pc = p_gdn_conv + ((size_t)b * 3 + (i - 61)) * 1536 + col0;
                    *(f32x4*)pc = (f32x4){bflo(w_.x), bfhi(w_.x), bflo(w_.y), bfhi(w_.y)}; *(f32x4*)(pc + 4) = (f32x4){bflo(w_.z), bfhi(w_.z), bflo(w_.w), bfhi(w_.w)};
                }
            }
        }
    }
    if (wave == 0) {
        const float a_raw = bf2f(a_raw_h), b_raw = bf2f(b_raw_h);
        float g = -expf(alog_) * softplusf_(a_raw + dtb_);
#pragma unroll
        for (int off = 1; off < 64; off <<= 1) { const float v = __shfl_up(g, off); if (lane >= off) g += v; }
        const float glast = __shfl(g, 63);
        { const float be_ = sigmoidf_(b_raw), eg_ = expf(g); gcs[lane] = g; bets[lane] = be_; egcs[lane] = eg_; ekds[lane] = expf(glast - g); begs[lane] = be_ * eg_; }
        if (lane == 0) cb.EGL[un] = expf(glast);
    }
    __syncthreads();
    {
        const int mi = wave >> 1;
        bf16x8_t aK[4], aQ[4];
#pragma unroll
        for (int ks = 0; ks < 4; ++ks) { aK[ks] = *(const bf16x8_t*)(Kb + (mi * 16 + fr) * 136 + ks * 32 + 8 * fq); aQ[ks] = *(const bf16x8_t*)(Qb + (mi * 16 + fr) * 136 + ks * 32 + 8 * fq); }
#pragma unroll
        for (int nn = 0; nn < 2; ++nn) {
            const int nj = (wave & 1) * 2 + nn;
            f32x4 accK = (f32x4){0.f, 0.f, 0.f, 0.f}, accQ = accK;
#pragma unroll
            for (int ks = 0; ks < 4; ++ks) { const bf16x8_t bk = *(const bf16x8_t*)(Kb + (nj * 16 + fr) * 136 + ks * 32 + 8 * fq); accK = mfma16(aK[ks], bk, accK); accQ = mfma16(aQ[ks], bk, accQ); }
            const int j = nj * 16 + fr; const float gj = gcs[j];
#pragma unroll
            for (int r = 0; r < 4; ++r) {
                const int i = mi * 16 + 4 * fq + r;
                const float dec = i >= j ? expf(gcs[i] - gj) : 0.f;
                Ls[j * 68 + i] = i > j ? bets[i] * accK[r] * dec : 0.f;
                QKs[i * 72 + j] = (bf16)f2bf(i >= j ? accQ[r] * dec : 0.f);
            }
        }
    }
    __syncthreads();
    if (wave < 4) {
        float x[64];
        const bool isu = tid < 128; const int c = isu ? tid : tid - 128;
        const LAS unsigned char* l3 = (const LAS unsigned char*)lds;
        unsigned so = (isu ? GP_VB : GP_KB) + c * 2, ro = GP_SC + (isu ? 64 * 4 : 256 * 4), lo = GP_LS;
        asm volatile("" : "+v"(so), "+v"(ro), "+v"(lo));
#pragma unroll
        for (int i = 0; i < 64; ++i) x[i] = *(const LAS float*)(l3 + ro + 4 * i) * bf2f(*(const LAS bf16*)(l3 + so + i * 272));
#pragma unroll
        for (int j = 0; j < 63; ++j) {
            const float nxj = -x[j]; const f32x2c_t nx2 = (f32x2c_t){nxj, nxj};
#pragma unroll
            for (int i4 = (j + 1) / 4; i4 < 16; ++i4) {
                const f32x4 l4 = *(const LAS f32x4*)(l3 + lo + j * 272 + i4 * 16);
#pragma unroll
                for (int hp = 0; hp < 2; ++hp) {
                    const int i0 = i4 * 4 + 2 * hp; const float la = hp ? l4.z : l4.x, lb = hp ? l4.w : l4.y;
                    if (i0 > j) { const f32x2c_t r = __builtin_elementwise_fma((f32x2c_t){la, lb}, nx2, (f32x2c_t){x[i0], x[i0 + 1]}); x[i0] = r.x; x[i0 + 1] = r.y; }
                    else if (i0 + 1 > j) x[i0 + 1] = fmaf(lb, nxj, x[i0 + 1]);
                }
            }
        }
        if (isu) {
            bf16* dst = cb.UT + (size_t)un * 8192 + ((c >> 4) * 4 * 64 + (c & 15)) * 4;
#pragma unroll
            for (int m4 = 0; m4 < 16; ++m4) { v2u o; o.x = pk2(x[m4 * 4 + 0], x[m4 * 4 + 1]); o.y = pk2(x[m4 * 4 + 2], x[m4 * 4 + 3]); *(v2u*)(dst + ((m4 >> 2) * 64 + (m4 & 3) * 16) * 4) = o; }
        } else {
#pragma unroll
            for (int i = 0; i < 64; ++i) Ws[i * 136 + c] = (bf16)f2bf(x[i]);
        }
    } else {
        const int t2 = tid - 256;
#pragma unroll
        for (int k = 0; k < 4; ++k) {
            const int ci = t2 + 256 * k, i = ((ci >> 8) << 4) | (ci & 15), d0 = (((ci >> 6) & 3) * 4 + ((ci >> 4) & 3)) * 8; const float e = egcs[i];
            const v4u q = *(const v4u*)(Qb + i * 136 + d0);
            v4u o; o.x = pk2(bflo(q.x) * e, bfhi(q.x) * e); o.y = pk2(bflo(q.y) * e, bfhi(q.y) * e); o.z = pk2(bflo(q.z) * e, bfhi(q.z) * e); o.w = pk2(bflo(q.w) * e, bfhi(q.w) * e);
            *(v4u*)(cb.QG + (size_t)un * 8192 + ci * 8) = o;
        }
#pragma unroll
        for (int k = 0; k < 4; ++k) {
            const int ci = t2 + 256 * k, d = ((ci >> 7) << 4) | (ci & 15), i0 = (((ci >> 6) & 1) * 4 + ((ci >> 4) & 3)) * 8;
            float v[8];
#pragma unroll
            for (int q = 0; q < 8; ++q) v[q] = bf2f(Kb[(i0 + q) * 136 + d]) * ekds[i0 + q];
            v4u o; o.x = pk2(v[0], v[1]); o.y = pk2(v[2], v[3]); o.z = pk2(v[4], v[5]); o.w = pk2(v[6], v[7]);
            *(v4u*)(cb.KDT + (size_t)un * 8192 + ci * 8) = o;
        }
#pragma unroll
        for (int k = 0; k < 2; ++k) {
            const int ci = t2 + 256 * k, i = ((ci >> 7) << 4) | (ci & 15), j0 = (((ci >> 6) & 1) * 4 + ((ci >> 4) & 3)) * 8;
            *(v4u*)(cb.QK + (size_t)un * 4096 + ci * 8) = *(const v4u*)(QKs + i * 72 + j0);
        }
        { const int rb = (un & 511) * 32 + (wave - 4) * 8;
          if (un < 512) table_rows_convert<false>(cj.u0, cj.tab, cj.tsc, rb, rb + 8, 0, 1, lane);
          else table_rows_convert<true>(cj.v0, cj.tab + (size_t)16384 * D, cj.tsc + 16384, rb, rb + 8, 0, 1, lane); }
    }
    __syncthreads();
#pragma unroll
    for (int k = 0; k < 2; ++k) {
        const int ci = tid + 512 * k, i = ((ci >> 8) << 4) | (ci & 15), d0 = (((ci >> 6) & 3) * 4 + ((ci >> 4) & 3)) * 8;
        *(v4u*)(cb.W + (size_t)un * 8192 + ci * 8) = *(const v4u*)(Ws + i * 136 + d0);
    }
    __syncthreads();
}

constexpr int GS_ST = 0, GS_VNT = 2 * 32 * 136 * 2, GS_END = GS_VNT + 32 * 72 * 2;
template <int N0, int N1>
__device__ __forceinline__ void gdn_seq(const GdnChunkBufs& cb, float* __restrict__ O, float* __restrict__ Sout, int b, int h, int sl, unsigned char* lds, f32x4 (&accS)[2], int& cur) {
    int tid = threadIdx.x; asm volatile("" : "+v"(tid));
    const int lane = tid & 63, wave = __builtin_amdgcn_readfirstlane(tid >> 6), fr = lane & 15, fq = lane >> 4;
    const int mi = wave >> 1, nj = wave & 1;
    bf16* St = (bf16*)(lds + GS_ST); bf16* VnT = (bf16*)(lds + GS_VNT);
    float* egls = (float*)(lds + GS_END);
    if (N0 == 0) {
        for (int i = tid; i < 2 * 32 * 136 / 2; i += NTH) ((unsigned*)St)[i] = 0u;
        accS[0] = (f32x4){0.f, 0.f, 0.f, 0.f}; accS[1] = accS[0]; cur = 0;
    }
    if (tid >= N0 && tid < N1) egls[tid] = cb.EGL[(size_t)((b * 64 + tid) * 4 + h)];
    __syncthreads();
#define GS_DECL(X) bf16x8_t aW##X[4], aQG##X[4], aQK##X[2], aKD##X[2]; v2u ut##X;
    GS_DECL(0) GS_DECL(1) GS_DECL(2)
#define GS_GLD16(dst, ptr) asm volatile("global_load_dwordx4 %0, %1, off" : "=v"(dst) : "v"(ptr))
#define GS_GLD8(dst, ptr) asm volatile("global_load_dwordx2 %0, %1, off" : "=v"(dst) : "v"(ptr))
#define GS_LOAD(X, n_) do { const size_t u_ = (size_t)((b * 64 + ((n_) < 63 ? (n_) : 63)) * 4 + h);     \
        _Pragma("unroll") for (int ks = 0; ks < 4; ++ks) { GS_GLD16(aW##X[ks], cb.W + u_ * 8192 + ((mi * 4 + ks) * 64 + lane) * 8); GS_GLD16(aQG##X[ks], cb.QG + u_ * 8192 + ((mi * 4 + ks) * 64 + lane) * 8); } \
        _Pragma("unroll") for (int ks = 0; ks < 2; ++ks) { GS_GLD16(aQK##X[ks], cb.QK + u_ * 4096 + ((mi * 2 + ks) * 64 + lane) * 8); GS_GLD16(aKD##X[ks], cb.KDT + u_ * 8192 + ((wave * 2 + ks) * 64 + lane) * 8); } \
        GS_GLD8(ut##X, cb.UT + u_ * 8192 + (((sl * 2 + nj) * 4 + mi) * 64 + lane) * 4); } while (0)
#define GS_WAITN(X, N) asm volatile("s_waitcnt vmcnt(" #N ")" : "+v"(aW##X[0]), "+v"(aW##X[1]), "+v"(aW##X[2]), "+v"(aW##X[3]), "+v"(aQG##X[0]), "+v"(aQG##X[1]), "+v"(aQG##X[2]), "+v"(aQG##X[3]), \
        "+v"(aQK##X[0]), "+v"(aQK##X[1]), "+v"(aKD##X[0]), "+v"(aKD##X[1]), "+v"(ut##X))
#define GS_WAIT(X, n_) GS_WAITN(X, 26)
#define GS_STEP(X, n_) do { \
        const float egl##X = egls[(n_)]; \
        GS_WAIT(X, n_); \
        __syncthreads();                                        \
        f32x4 accW = (f32x4){0.f, 0.f, 0.f, 0.f}, accO = accW; \
        const bf16* Sc = St + cur * 32 * 136; \
        _Pragma("unroll") for (int ks = 0; ks < 4; ++ks) { const bf16x8_t bs = *(const bf16x8_t*)(Sc + (nj * 16 + fr) * 136 + ks * 32 + 8 * fq); accW = mfma16(aW##X[ks], bs, accW); accO = mfma16(aQG##X[ks], bs, accO); } \
          \
        const float v0 = bflo(ut##X.x) - accW[0], v1 = bfhi(ut##X.x) - accW[1], v2 = bflo(ut##X.y) - accW[2], v3 = bfhi(ut##X.y) - accW[3]; \
        { v2u o; o.x = pk2(v0, v1); o.y = pk2(v2, v3); *(v2u*)(VnT + (nj * 16 + fr) * 72 + mi * 16 + 4 * fq) = o; } \
        __syncthreads();                                        \
        _Pragma("unroll") for (int ks = 0; ks < 2; ++ks) { const bf16x8_t bv = *(const bf16x8_t*)(VnT + (nj * 16 + fr) * 72 + ks * 32 + 8 * fq); accO = mfma16(aQK##X[ks], bv, accO); } \
        { float* orow = O + (size_t)(b * SEQ + (n_) * 64 + mi * 16 + 4 * fq) * 512 + h * 128 + sl * 32 + nj * 16 + fr; \
          orow[0] = accO[0]; orow[512] = accO[1]; orow[1024] = accO[2]; orow[1536] = accO[3]; } \
          \
        bf16* Sn = St + (cur ^ 1) * 32 * 136; \
        _Pragma("unroll") for (int njj = 0; njj < 2; ++njj) { \
            accS[njj] = accS[njj] * egl##X; \
            _Pragma("unroll") for (int ks = 0; ks < 2; ++ks) { const bf16x8_t bv = *(const bf16x8_t*)(VnT + (njj * 16 + fr) * 72 + ks * 32 + 8 * fq); accS[njj] = mfma16(aKD##X[ks], bv, accS[njj]); } \
            v2u o; o.x = pk2(accS[njj][0], accS[njj][1]); o.y = pk2(accS[njj][2], accS[njj][3]); \
            *(v2u*)(Sn + (njj * 16 + fr) * 136 + wave * 16 + 4 * fq) = o; } \
        cur ^= 1; } while (0)
    constexpr int NTRI = (N1 - N0) / 3, NREM = (N1 - N0) % 3, NM = N0 + 3 * NTRI;
    GS_LOAD(0, N0); GS_LOAD(1, N0 + 1);
#pragma unroll 1
    for (int n = N0; n < NM; n += 3) {
        GS_LOAD(2, n + 2);
        GS_STEP(0, n);
        GS_LOAD(0, n + 3);
        GS_STEP(1, n + 1);
        GS_LOAD(1, n + 4);
        GS_STEP(2, n + 2);
    }
    if (NREM >= 1) { GS_LOAD(2, NM + 2); GS_STEP(0, NM); }
    if (NREM == 2) { GS_LOAD(0, NM + 3); GS_STEP(1, NM + 1); }
    GS_WAITN(0, 0); GS_WAITN(1, 0); GS_WAITN(2, 0);
#undef GS_STEP
#undef GS_DECL
#undef GS_WAIT
#undef GS_WAITN
#undef GS_GLD16
#undef GS_GLD8
    asm volatile("s_waitcnt vmcnt(0)" ::: "memory");
#undef GS_LOAD
    if (N1 == 64) {
#pragma unroll
        for (int njj = 0; njj < 2; ++njj)
#pragma unroll
            for (int r = 0; r < 4; ++r) Sout[(((size_t)b * 4 + h) * 128 + wave * 16 + 4 * fq + r) * 128 + sl * 32 + njj * 16 + fr] = accS[njj][r];
    }
    __syncthreads();
}

__device__ __forceinline__ void lru_prep_unit(const bf16* __restrict__ PROJ, const float* __restrict__ conv_w, const float* __restrict__ conv_b,
                                              const float* __restrict__ w_r, const float* __restrict__ b_r, const float* __restrict__ w_i, const float* __restrict__ b_i, const float* __restrict__ lam,
                                              float* __restrict__ H, float* __restrict__ P, float* __restrict__ Hend, float* __restrict__ Pend, float* __restrict__ p_lru_conv, int ub) {
    int c = threadIdx.x; asm volatile("" : "+v"(c));
    const int nblk = c >> 6, d = c & 63;
    const int n = ub & 63, b = ub >> 6, t0 = b * SEQ + n * 64;
    float wr[64], wi[64];
#pragma unroll
    for (int cc = 0; cc < 64; ++cc) { wr[cc] = w_r[((size_t)nblk * 64 + cc) * 64 + d]; wi[cc] = w_i[((size_t)nblk * 64 + cc) * 64 + d]; }
    const float cw0 = conv_w[c], cw1 = conv_w[512 + c], cw2 = conv_w[1024 + c], cw3 = conv_w[1536 + c], cb_ = conv_b[c];
    const float br = b_r[c], bi = b_i[c], spl = -8.0f * softplusf_(-lam[c]);
    float x0 = (n * 64 - 3 >= 0) ? bf2f(PROJ[(size_t)(t0 - 3) * ABN + C_XR + c]) : 0.f;
    float x1 = (n * 64 - 2 >= 0) ? bf2f(PROJ[(size_t)(t0 - 2) * ABN + C_XR + c]) : 0.f;
    float x2 = (n * 64 - 1 >= 0) ? bf2f(PROJ[(size_t)(t0 - 1) * ABN + C_XR + c]) : 0.f;
    float hloc = 0.f, ploc = 1.f;
    bf16 xa[16], xb[16];
#pragma unroll
    for (int k = 0; k < 16; ++k) xa[k] = PROJ[(size_t)(t0 + k) * ABN + C_XR + c];
#pragma unroll 1
    for (int ib = 0; ib < 64; ib += 16) {
      if (ib + 16 < 64) {
#pragma unroll
        for (int k = 0; k < 16; ++k) xb[k] = PROJ[(size_t)(t0 + ib + 16 + k) * ABN + C_XR + c];
      }
#pragma unroll
      for (int k = 0; k < 16; ++k) {
        const int i = ib + k;
        const float xt = bf2f(xa[k]);
        const float xr = cb_ + cw0 * x0 + cw1 * x1 + cw2 * x2 + cw3 * xt;
        f32x2_t ga = (f32x2_t){br, bi}, gb = (f32x2_t){0.f, 0.f};
#pragma unroll
        for (int cc = 0; cc < 64; cc += 2) {
            const float xa_ = __uint_as_float(__builtin_amdgcn_readlane(__float_as_uint(xr), cc)), xb_ = __uint_as_float(__builtin_amdgcn_readlane(__float_as_uint(xr), cc + 1));
            ga += (f32x2_t){xa_, xa_} * (f32x2_t){wr[cc], wi[cc]}; gb += (f32x2_t){xb_, xb_} * (f32x2_t){wr[cc + 1], wi[cc + 1]};
        }
        ga += gb;
        const float r = __frcp_rn(1.0f + __expf(-ga.x)), ii = __frcp_rn(1.0f + __expf(-ga.y));
        const float a = __expf(spl * r), bb = __fsqrt_rn(fmaxf(1.0f - a * a, 0.f)) * (ii * xr);
        hloc = a * hloc + bb; ploc *= a;
        H[(size_t)(t0 + i) * 512 + c] = hloc; P[(size_t)(t0 + i) * 512 + c] = ploc;
        if (n == 63 && i >= 61) p_lru_conv[((size_t)b * 3 + (i - 61)) * 512 + c] = xt;
        x0 = x1; x1 = x2; x2 = xt;
      }
#pragma unroll
      for (int k = 0; k < 16; ++k) xa[k] = xb[k];
    }
    Hend[(size_t)ub * 512 + c] = hloc; Pend[(size_t)ub * 512 + c] = ploc;
}
constexpr int LR_XR = 64 * 68 * 4;
__device__ __forceinline__ void lru_prep_unit2(const bf16* __restrict__ PROJ, const float* __restrict__ conv_w, const float* __restrict__ conv_b,
                                               const bf16* __restrict__ WRT, const bf16* __restrict__ WIT  , const float* __restrict__ b_r, const float* __restrict__ b_i, const float* __restrict__ lam,
                                               float* __restrict__ H, float* __restrict__ P, float* __restrict__ Hend, float* __restrict__ Pend, float* __restrict__ p_lru_conv, int ub, unsigned char* lds) {
    int tid = threadIdx.x; asm volatile("" : "+v"(tid));
    const int lane = tid & 63, wave = __builtin_amdgcn_readfirstlane(tid >> 6), fr = lane & 15, fq = lane >> 4;
    const int n = ub & 63, b = ub >> 6, t0 = b * SEQ + n * 64;
    float* XR = (float*)(lds + wave * LR_XR);
    {
        const int c = wave * 64 + lane;
        const float cw0 = conv_w[c], cw1 = conv_w[512 + c], cw2 = conv_w[1024 + c], cw3 = conv_w[1536 + c], cb_ = conv_b[c];
        float x0 = (n * 64 - 3 >= 0) ? bf2f(PROJ[(size_t)(t0 - 3) * ABN + C_XR + c]) : 0.f;
        float x1 = (n * 64 - 2 >= 0) ? bf2f(PROJ[(size_t)(t0 - 2) * ABN + C_XR + c]) : 0.f;
        float x2 = (n * 64 - 1 >= 0) ? bf2f(PROJ[(size_t)(t0 - 1) * ABN + C_XR + c]) : 0.f;
        bf16 xa[64];
#pragma unroll
        for (int k = 0; k < 64; ++k) xa[k] = PROJ[(size_t)(t0 + k) * ABN + C_XR + c];
#pragma unroll
        for (int i = 0; i < 64; ++i) {
            const float xt = bf2f(xa[i]);
            XR[i * 68 + lane] = cb_ + cw0 * x0 + cw1 * x1 + cw2 * x2 + cw3 * xt;
            if (n == 63 && i >= 61) p_lru_conv[((size_t)b * 3 + (i - 61)) * 512 + c] = xt;
            x0 = x1; x1 = x2; x2 = xt;
        }
    }
    asm volatile("s_waitcnt lgkmcnt(0)" ::: "memory");
    bf16x8_t bR[4][2], bI[4][2];
#pragma unroll
    for (int nt = 0; nt < 4; ++nt)
#pragma unroll
        for (int ks = 0; ks < 2; ++ks) {
            bR[nt][ks] = *(const bf16x8_t*)(WRT + ((size_t)wave * 64 + nt * 16 + fr) * 64 + ks * 32 + 8 * fq);
            bI[nt][ks] = *(const bf16x8_t*)(WIT + ((size_t)wave * 64 + nt * 16 + fr) * 64 + ks * 32 + 8 * fq);
        }
    float brv[4], biv[4], splv[4];
#pragma unroll
    for (int nt = 0; nt < 4; ++nt) { const int c = wave * 64 + nt * 16 + fr; brv[nt] = b_r[c]; biv[nt] = b_i[c]; splv[nt] = -8.0f * softplusf_(-lam[c]); }
    float hin[4], pin[4];
#pragma unroll
    for (int nt = 0; nt < 4; ++nt) { hin[nt] = 0.f; pin[nt] = 1.f; }
#pragma unroll 1
    for (int mt = 0; mt < 4; ++mt) {
        bf16x8_t aX[2];
#pragma unroll
        for (int ks = 0; ks < 2; ++ks) {
            const f32x4 lo = *(const f32x4*)(XR + (mt * 16 + fr) * 68 + ks * 32 + 8 * fq), hi = *(const f32x4*)(XR + (mt * 16 + fr) * 68 + ks * 32 + 8 * fq + 4);
            v4u w; w.x = pk2(lo.x, lo.y); w.y = pk2(lo.z, lo.w); w.z = pk2(hi.x, hi.y); w.w = pk2(hi.z, hi.w);
            aX[ks] = __builtin_bit_cast(bf16x8_t, w);
        }
#pragma unroll
        for (int nt = 0; nt < 4; ++nt) {
            f32x4 aR = (f32x4){0.f, 0.f, 0.f, 0.f}, aI = aR;
            aR = mfma16(aX[0], bR[nt][0], aR); aR = mfma16(aX[1], bR[nt][1], aR);
            aI = mfma16(aX[0], bI[nt][0], aI); aI = mfma16(aX[1], bI[nt][1], aI);
            float av[4], bv[4];
#pragma unroll
            for (int r = 0; r < 4; ++r) {
                const float rg = __frcp_rn(1.0f + __expf(-(aR[r] + brv[nt]))), ig = __frcp_rn(1.0f + __expf(-(aI[r] + biv[nt])));
                const float a = __expf(splv[nt] * rg);
                av[r] = a; bv[r] = __fsqrt_rn(fmaxf(1.0f - a * a, 0.f)) * (ig * XR[(mt * 16 + 4 * fq + r) * 68 + nt * 16 + fr]);
            }
            float PA[4], PB[4];
            PA[0] = av[0]; PB[0] = bv[0];
#pragma unroll
            for (int r = 1; r < 4; ++r) { PA[r] = av[r] * PA[r - 1]; PB[r] = av[r] * PB[r - 1] + bv[r]; }
            float GA = PA[3], GB = PB[3];
            { const float pa = __shfl_up(GA, 16), pb = __shfl_up(GB, 16); if (fq >= 1) { GB = GA * pb + GB; GA = GA * pa; } }
            { const float pa = __shfl_up(GA, 32), pb = __shfl_up(GB, 32); if (fq >= 2) { GB = GA * pb + GB; GA = GA * pa; } }
            float EA = __shfl_up(GA, 16), EB = __shfl_up(GB, 16);
            if (fq == 0) { EA = 1.f; EB = 0.f; }
            const float h0 = EA * hin[nt] + EB, p0 = pin[nt] * EA;
#pragma unroll
            for (int r = 0; r < 4; ++r) {
                const size_t o = (size_t)(t0 + mt * 16 + 4 * fq + r) * 512 + wave * 64 + nt * 16 + fr;
                H[o] = PA[r] * h0 + PB[r]; P[o] = p0 * PA[r];
            }
            const float TA = __shfl(GA, 48 + fr), TB = __shfl(GB, 48 + fr);
            hin[nt] = TA * hin[nt] + TB; pin[nt] = pin[nt] * TA;
        }
    }
    if (fq == 0) {
#pragma unroll
        for (int nt = 0; nt < 4; ++nt) { Hend[(size_t)ub * 512 + wave * 64 + nt * 16 + fr] = hin[nt]; Pend[(size_t)ub * 512 + wave * 64 + nt * 16 + fr] = pin[nt]; }
    }
    asm volatile("s_waitcnt lgkmcnt(0)" ::: "memory");
}
__device__ __forceinline__ void lru_carry(const float* __restrict__ Hend, const float* __restrict__ Pend, float* __restrict__ CIN, float* __restrict__ hlast, int bx) {
    int tx_ = threadIdx.x; asm volatile("" : "+v"(tx_));
    const int idx = bx * NTH + tx_, b = idx >> 9, c = idx & 511;
    float carry = 0.f;
#pragma unroll 8
    for (int n = 0; n < 64; ++n) {
        const size_t o = ((size_t)b * 64 + n) * 512 + c;
        CIN[o] = carry;
        carry = Hend[o] + Pend[o] * carry;
    }
    hlast[(size_t)b * 512 + c] = carry;
}

__device__ __forceinline__ unsigned f2key(float f) { const unsigned u = __float_as_uint(f); return u ^ ((u >> 31) ? 0xffffffffu : 0x80000000u); }
__device__ __forceinline__ float key2f(unsigned k) { return __uint_as_float(k ^ ((k >> 31) ? 0x80000000u : 0xffffffffu)); }
#define TK_CE(hi, lo) do { const unsigned a_ = (hi), b_ = (lo); (hi) = a_ > b_ ? a_ : b_; (lo) = a_ > b_ ? b_ : a_; } while (0)
template <int N> __device__ __forceinline__ void bitonic_sort_desc(unsigned (&a)[N]) {
#pragma unroll
    for (int k = 2; k <= N; k <<= 1)
#pragma unroll
        for (int j = k >> 1; j > 0; j >>= 1)
#pragma unroll
            for (int i = 0; i < N; ++i) { const int l = i ^ j; if (l > i) { if ((i & k) == 0) TK_CE(a[i], a[l]); else TK_CE(a[l], a[i]); } }
}
template <int XM> __device__ __forceinline__ void merge_top16(unsigned (&a)[16]) {
    unsigned c[16];
#pragma unroll
    for (int i = 0; i < 16; ++i) {
        unsigned o;
        if (XM == 1) o = (unsigned)__builtin_amdgcn_update_dpp(0, (int)a[15 - i], 0xB1, 0xf, 0xf, false);
        else if (XM == 2) o = (unsigned)__builtin_amdgcn_update_dpp(0, (int)a[15 - i], 0x4E, 0xf, 0xf, false);
        else if (XM == 16) o = __builtin_amdgcn_permlane16_swap(a[15 - i], a[15 - i], false, false)[1];
        else o = __builtin_amdgcn_permlane32_swap(a[15 - i], a[15 - i], false, false)[1];
        c[i] = a[i] > o ? a[i] : o; }
#pragma unroll
    for (int j = 8; j > 0; j >>= 1)
#pragma unroll
        for (int i = 0; i < 16; ++i) { const int l = i ^ j; if (l > i) TK_CE(c[i], c[l]); }
#pragma unroll
    for (int i = 0; i < 16; ++i) a[i] = c[i];
}
constexpr int TK_KS = 0, TK_TS = 2 * 128 * 136 * 2, TK_END = TK_TS + 64 * 2 * 16 * 4;
__device__ __forceinline__ void peer_topk_stage_keys(const bf16* __restrict__ KB, int h, unsigned char* lds) {
    bf16* Ks = (bf16*)(lds + TK_KS);
    for (int ci = threadIdx.x; ci < 2 * 128 * 16; ci += NTH) { const int row = ci >> 4, part = ci & 15;
        *(v4u*)(Ks + row * 136 + part * 8) = *(const v4u*)(KB + ((size_t)h * 256 + row) * 128 + part * 8); }
    __syncthreads();
}
__device__ __forceinline__ void peer_topk_ldq(bf16x8_t (&bq)[4], const bf16* __restrict__ Q, int tile, int h, int tid) {
    const int lane = tid & 63, wave = tid >> 6, fr = lane & 15, fq = lane >> 4, c = wave >> 2, nt = wave & 3;
#pragma unroll
    for (int ks = 0; ks < 4; ++ks) bq[ks] = *(const bf16x8_t*)(Q + (size_t)(tile * 64 + nt * 16 + fr) * 2048 + h * 256 + c * 128 + ks * 32 + 8 * fq);
}
__device__ __forceinline__ void peer_topk4(const bf16* __restrict__ Q, int* __restrict__ EXP, float* __restrict__ GATE, int tile, int h, unsigned char* lds, bf16x8_t (&bq)[4], int tile_next) {
    int tid = threadIdx.x; asm volatile("" : "+v"(tid));
    const int lane = tid & 63, wave = __builtin_amdgcn_readfirstlane(tid >> 6), fr = lane & 15, fq = lane >> 4;
    const bf16* Ks = (const bf16*)(lds + TK_KS); unsigned* Ts = (unsigned*)(lds + TK_TS);
    {
        const int c = wave >> 2, nt = wave & 3;
        unsigned a[32];
#pragma unroll
        for (int mt = 0; mt < 8; ++mt) {
            f32x4 acc = (f32x4){0.f, 0.f, 0.f, 0.f};
#pragma unroll
            for (int ks = 0; ks < 4; ++ks) { const bf16x8_t ak = *(const bf16x8_t*)(Ks + (c * 128 + mt * 16 + fr) * 136 + ks * 32 + 8 * fq); acc = mfma16(ak, bq[ks], acc); }
#pragma unroll
            for (int r = 0; r < 4; ++r) a[mt * 4 + r] = (f2key(acc[r]) & ~127u) | (unsigned)(127 - (mt * 16 + 4 * fq + r));
        }
        if (tile_next >= 0) peer_topk_ldq(bq, Q, tile_next, h, tid);
        bitonic_sort_desc<32>(a);
        unsigned t[16];
#pragma unroll
        for (int j = 0; j < 16; ++j) t[j] = a[j];
        merge_top16<16>(t); merge_top16<32>(t);
        if (fq == 0) {
            const int tk = nt * 16 + fr;
#pragma unroll
            for (int j = 0; j < 16; ++j) Ts[(tk * 2 + c) * 16 + j] = t[j];
        }
    }
    __syncthreads();
    if (tid < 256) {
        const int tk = tid >> 2, q = tid & 3;
        const unsigned* t0 = Ts + (tk * 2 + 0) * 16; const unsigned* t1 = Ts + (tk * 2 + 1) * 16;
        unsigned a[16];
#pragma unroll
        for (int s = 0; s < 13; ++s) {
            const int e = s * 4 + q;
            int i, j;
            if (e < 16) { i = 0; j = e; } else if (e < 24) { i = 1; j = e - 16; } else if (e < 29) { i = 2; j = e - 24; } else if (e < 33) { i = 3; j = e - 29; }
            else if (e < 36) { i = 4; j = e - 33; } else if (e < 42) { i = 5 + ((e - 36) >> 1); j = (e - 36) & 1; } else { i = 8 + (e - 42); j = 0; }
            const bool ok = e < 50;
            const float sum = key2f(t0[ok ? i : 0] & ~127u) + key2f(t1[ok ? j : 0] & ~127u);
            a[s] = ok ? ((f2key(sum) & ~255u) | (unsigned)(255 - (i * 16 + j))) : 0u;
        }
        a[13] = 0u; a[14] = 0u; a[15] = 0u;
        bitonic_sort_desc<16>(a);
        merge_top16<1>(a); merge_top16<2>(a);
        float ev[16], sum = 0.f; const float m = key2f(a[0] & ~255u);
#pragma unroll
        for (int j = 0; j < 16; ++j) { ev[j] = __expf(key2f(a[j] & ~255u) - m); sum += ev[j]; }
        const float inv = 1.0f / sum;
        const size_t o = (size_t)(tile * 64 + tk) * 128 + h * 16;
#pragma unroll
        for (int j = 0; j < 16; ++j)
            if ((j >> 2) == q) {
                const int code = 255 - (int)(a[j] & 255u), i = code >> 4, jj = code & 15;
                const int n0 = 127 - (int)(t0[i] & 127u), n1 = 127 - (int)(t1[jj] & 127u);
                EXP[o + j] = n0 * 128 + n1; GATE[o + j] = ev[j] * inv;
            }
    }
    __syncthreads();
}

constexpr int AT_KS = 0, AT_VT = 192 * 72 * 2, AT_BT = AT_VT + 64 * 200 * 2, AT_PW = AT_BT + 4 * 256 * 4, AT_END = AT_PW + 8 * 32 * 72 * 2;
template <int QS>
__device__ __forceinline__ void attn_core(const bf16* __restrict__ PCb, const float* __restrict__ sinks, bf16* __restrict__ ATT, int kvh, int q0, int tb, int wave, int lane, int fr, int fq,
                                          const bf16* Ks, const bf16* Vt, const float* Bt, bf16* Pw) {
    constexpr int NT0 = QS ? 2 : 0;
    const int g = wave >> 1, hh = kvh * 4 + g; constexpr int qs = QS;
    bf16x8_t aQ[2][2];
#pragma unroll
    for (int mt = 0; mt < 2; ++mt)
#pragma unroll
        for (int ks = 0; ks < 2; ++ks) aQ[mt][ks] = *(const bf16x8_t*)(PCb + (size_t)(tb + q0 + qs + mt * 16 + fr) * CN + hh * 64 + ks * 32 + 8 * fq);
    f32x4 sc[2][12];
#pragma unroll
    for (int nt = NT0; nt < NT0 + 10; ++nt) {
        const bf16x8_t b0 = *(const bf16x8_t*)(Ks + (nt * 16 + fr) * 72 + 8 * fq), b1 = *(const bf16x8_t*)(Ks + (nt * 16 + fr) * 72 + 32 + 8 * fq);
#pragma unroll
        for (int mt = 0; mt < 2; ++mt) { f32x4 a = (f32x4){0.f, 0.f, 0.f, 0.f}; a = mfma16(aQ[mt][0], b0, a); a = mfma16(aQ[mt][1], b1, a); sc[mt][nt] = a; }
    }
    const float sink = sinks[hh] * 1.4426950408889634f;
    const float* bt = Bt + g * 256 + 64;
    float rinv[2][4];
    float kadd[12];
#pragma unroll
    for (int nt = NT0; nt < NT0 + 10; ++nt) kadd[nt] = (q0 - 128 + nt * 16 + fr) >= 0 ? 0.f : -INFINITY;
#pragma unroll
    for (int mt = 0; mt < 2; ++mt)
#pragma unroll
        for (int r = 0; r < 4; ++r) {
            const int qi = qs + mt * 16 + 4 * fq + r;
            float mx = sink;
#pragma unroll
            for (int nt = NT0; nt < NT0 + 10; ++nt) {
                const int kk = nt * 16 + fr, rel = qi + 128 - kk;
                const float lg = (sc[mt][nt][r] * (0.125f * 1.4426950408889634f) + bt[rel]) + kadd[nt];
                sc[mt][nt][r] = lg; mx = fmaxf(mx, lg);
            }
            mx = fmaxf(mx, DPPF(mx, 0xB1, 0xf)); mx = fmaxf(mx, DPPF(mx, 0x4E, 0xf)); mx = fmaxf(mx, DPPF(mx, 0x141, 0xf)); mx = fmaxf(mx, DPPF(mx, 0x140, 0xf));
            float sum = 0.f;
#pragma unroll
            for (int nt = NT0; nt < NT0 + 10; ++nt) { const float p = __builtin_amdgcn_exp2f(sc[mt][nt][r] - mx); sc[mt][nt][r] = p; sum += p; }
            sum += DPPF(sum, 0xB1, 0xf); sum += DPPF(sum, 0x4E, 0xf); sum += DPPF(sum, 0x141, 0xf); sum += DPPF(sum, 0x140, 0xf);
            rinv[mt][r] = 1.0f / (sum + __builtin_amdgcn_exp2f(sink - mx));
        }
    f32x4 oacc[2][4];
#pragma unroll
    for (int mt = 0; mt < 2; ++mt)
#pragma unroll
        for (int dt = 0; dt < 4; ++dt) oacc[mt][dt] = (f32x4){0.f, 0.f, 0.f, 0.f};
#pragma unroll
    for (int kc = 0; kc < 3; ++kc) {
#pragma unroll
        for (int mt = 0; mt < 2; ++mt)
#pragma unroll
            for (int n4 = 0; n4 < 4; ++n4)
#pragma unroll
                for (int r = 0; r < 4; ++r) if (kc * 4 + n4 >= NT0 && kc * 4 + n4 < NT0 + 10) Pw[(mt * 16 + 4 * fq + r) * 72 + n4 * 16 + fr] = (bf16)f2bf(sc[mt][kc * 4 + n4][r]);
        asm volatile("s_waitcnt lgkmcnt(0)" ::: "memory");
#pragma unroll
        for (int ks = 0; ks < 2; ++ks) {
            if (kc * 4 + ks * 2 < NT0 || kc * 4 + ks * 2 >= NT0 + 10) continue;
            const bf16x8_t p0 = *(const bf16x8_t*)(Pw + fr * 72 + ks * 32 + 8 * fq), p1 = *(const bf16x8_t*)(Pw + (16 + fr) * 72 + ks * 32 + 8 * fq);
#pragma unroll
            for (int dt = 0; dt < 4; ++dt) {
                const bf16x8_t bv = *(const bf16x8_t*)(Vt + (dt * 16 + fr) * 200 + kc * 64 + ks * 32 + 8 * fq);
                oacc[0][dt] = mfma16(p0, bv, oacc[0][dt]); oacc[1][dt] = mfma16(p1, bv, oacc[1][dt]);
            }
        }
        asm volatile("s_waitcnt lgkmcnt(0)" ::: "memory");
    }
#pragma unroll
    for (int mt = 0; mt < 2; ++mt)
#pragma unroll
        for (int dt = 0; dt < 4; ++dt)
#pragma unroll
            for (int r = 0; r < 4; ++r) Pw[(mt * 16 + 4 * fq + r) * 72 + dt * 16 + fr] = (bf16)f2bf(oacc[mt][dt][r] * rinv[mt][r]);
    asm volatile("s_waitcnt lgkmcnt(0)" ::: "memory");
#pragma unroll
    for (int k = 0; k < 4; ++k) {
        const int ci = lane + 64 * k, row = ci >> 3, part = ci & 7;
        *(v4u*)(ATT + (size_t)(tb + q0 + qs + row) * D + hh * 64 + part * 8) = *(const v4u*)(Pw + row * 72 + part * 8);
    }
}
__device__ __forceinline__ void attn_unit(const bf16* __restrict__ PCb, const float* __restrict__ rel_bias, const float* __restrict__ sinks, bf16* __restrict__ ATT, int un, unsigned char* lds) {
    int tid = threadIdx.x; asm volatile("" : "+v"(tid));
    const int lane = tid & 63, wave = __builtin_amdgcn_readfirstlane(tid >> 6), fr = lane & 15, fq = lane >> 4;
    const int kvh = un & 3, qblk = (un >> 2) & 63, b = un >> 8;
    const int q0 = qblk * 64, tb = b * SEQ;
    bf16* Ks = (bf16*)(lds + AT_KS); bf16* Vt = (bf16*)(lds + AT_VT); float* Bt = (float*)(lds + AT_BT); bf16* Pw = (bf16*)(lds + AT_PW) + wave * 32 * 72;
#pragma unroll
    for (int k = 0; k < 3; ++k) {
        const int ci = tid + 512 * k, row = ci >> 3, part = ci & 7, kpos = q0 - 128 + row;
        v4u kv = (v4u){0u, 0u, 0u, 0u}, vv = kv;
        if (kpos >= 0) { const bf16* src = PCb + (size_t)(tb + kpos) * CN + kvh * 64 + part * 8; kv = *(const v4u*)(src + 1024); vv = *(const v4u*)(src + 1280); }
        *(v4u*)(Ks + row * 72 + part * 8) = kv;
        bf16* vd = Vt + (part * 8) * 200 + row;
        vd[0 * 200] = (bf16)(vv.x & 0xffffu); vd[1 * 200] = (bf16)(vv.x >> 16); vd[2 * 200] = (bf16)(vv.y & 0xffffu); vd[3 * 200] = (bf16)(vv.y >> 16);
        vd[4 * 200] = (bf16)(vv.z & 0xffffu); vd[5 * 200] = (bf16)(vv.z >> 16); vd[6 * 200] = (bf16)(vv.w & 0xffffu); vd[7 * 200] = (bf16)(vv.w >> 16);
    }
#pragma unroll
    for (int k = 0; k < 2; ++k) { const int idx = tid + 512 * k, g_ = idx >> 8, rel = (idx & 255) - 64;
        Bt[idx] = (rel >= 0 && rel < 128) ? rel_bias[t5_bucket(rel) * 16 + kvh * 4 + g_] * 1.4426950408889634f : -INFINITY; }
    __syncthreads();
    if (wave & 1) attn_core<32>(PCb, sinks, ATT, kvh, q0, tb, wave, lane, fr, fq, Ks, Vt, Bt, Pw);
    else attn_core<0>(PCb, sinks, ATT, kvh, q0, tb, wave, lane, fr, fq, Ks, Vt, Bt, Pw);
    __syncthreads();
}

__device__ __forceinline__ void swa_attn_sample(const bf16* __restrict__ PCb, const float* __restrict__ cache_k, const float* __restrict__ cache_v,
                                                const float* __restrict__ rel_bias, const float* __restrict__ sinks, bf16* __restrict__ ATT, int gw, int lane) {
    const int sb = gw >> 4, h = gw & 15, kvh = h >> 2, t = NP + sb;
    const bf16* qrow = PCb + (size_t)t * CN + h * 64;
    float lg[2];
#pragma unroll
    for (int rr = 0; rr < 2; ++rr) {
        const int r = lane + 64 * rr;
        float dot = 0.f;
        if (r == 0) {
            const bf16* krow = PCb + (size_t)t * CN + 1024 + kvh * 64;
            for (int d = 0; d < 64; ++d) dot += bf2f(qrow[d]) * bf2f(krow[d]);
        } else {
            const float* krow = cache_k + (((size_t)sb * 128 + (128 - r)) * 4 + kvh) * 64;
#pragma unroll
            for (int d4 = 0; d4 < 16; ++d4) { const float4 kv = *(const float4*)(krow + d4 * 4);
                dot += bf2f(qrow[d4 * 4]) * kv.x + bf2f(qrow[d4 * 4 + 1]) * kv.y + bf2f(qrow[d4 * 4 + 2]) * kv.z + bf2f(qrow[d4 * 4 + 3]) * kv.w; }
        }
        lg[rr] = dot * 0.125f + rel_bias[t5_bucket(r) * 16 + h];
    }
    const float sink = sinks[h];
    const float m = fmaxf(wave_max(fmaxf(lg[0], lg[1])), sink);
    float p[2] = {expf(lg[0] - m), expf(lg[1] - m)};
    const float inv = 1.0f / (wave_sum(p[0] + p[1]) + expf(sink - m));
    float o = 0.f;
#pragma unroll
    for (int rr = 0; rr < 2; ++rr)
#pragma unroll 1
        for (int lb = 0; lb < 64; lb += 16) {
            float vv[16];
#pragma unroll
            for (int k = 0; k < 16; ++k) { const int r = lb + k + 64 * rr;
                vv[k] = (r == 0) ? bf2f(PCb[(size_t)t * CN + 1280 + kvh * 64 + lane]) : cache_v[(((size_t)sb * 128 + (128 - r)) * 4 + kvh) * 64 + lane]; }
#pragma unroll
            for (int k = 0; k < 16; ++k) o += __shfl(p[rr], lb + k) * vv[k];
        }
    ATT[(size_t)t * D + h * 64 + lane] = (bf16)f2bf(o * inv);
}
__device__ __forceinline__ void swa_cache_shift(const float* __restrict__ cache_k, const float* __restrict__ cache_v, float* __restrict__ sk, float* __restrict__ sv, int item) {
    int tid = threadIdx.x; asm volatile("" : "+v"(tid));
    const int sb = item >> 1, isv = item & 1;
    const f32x4* src = (const f32x4*)((isv ? cache_v : cache_k) + ((size_t)sb * 128 + 1) * 256);
    f32x4* dst = (f32x4*)((isv ? sv : sk) + (size_t)sb * 128 * 256);
    f32x4 v[16];
#pragma unroll
    for (int k = 0; k < 16; ++k) { const int i = tid + NTH * k; if (i < 127 * 64) v[k] = src[i]; }
#pragma unroll
    for (int k = 0; k < 16; ++k) { const int i = tid + NTH * k; if (i < 127 * 64) dst[i] = v[k]; }
}
__device__ __forceinline__ void swa_kv_out3(const bf16* __restrict__ PCb, const float* __restrict__ cache_k, const float* __restrict__ cache_v,
                                            float* __restrict__ pk, float* __restrict__ pv, float* __restrict__ sk, float* __restrict__ sv, int item) {
    int tid = threadIdx.x; asm volatile("" : "+v"(tid));
    if (item < 256) {
        const int sb = item >> 1, isv = item & 1;
        const f32x4* src = (const f32x4*)((isv ? cache_v : cache_k) + ((size_t)sb * 128 + 1) * 256);
        f32x4* dst = (f32x4*)((isv ? sv : sk) + (size_t)sb * 128 * 256);
        (void)src;
        if (tid < 32) {
            const v4u w = *(const v4u*)(PCb + (size_t)(NP + sb) * CN + 1024 + isv * 256 + tid * 8);
            f32x4* d = dst + 127 * 64 + tid * 2;
            d[0] = (f32x4){bflo(w.x), bfhi(w.x), bflo(w.y), bfhi(w.y)}; d[1] = (f32x4){bflo(w.z), bfhi(w.z), bflo(w.w), bfhi(w.w)};
        }
    } else {
        const int b = item - 256;
#pragma unroll 4
        for (int e = tid; e < 128 * 64; e += NTH) {
            const int row = e >> 6, part = e & 63;
            const v4u w = *(const v4u*)(PCb + (size_t)(b * SEQ + SEQ - 128 + row) * CN + 1024 + part * 8);
            f32x4* d = (f32x4*)((part < 32 ? pk : pv) + ((size_t)b * 128 + row) * 256 + (part & 31) * 8);
            d[0] = (f32x4){bflo(w.x), bfhi(w.x), bflo(w.y), bfhi(w.y)}; d[1] = (f32x4){bflo(w.z), bfhi(w.z), bflo(w.w), bfhi(w.w)};
        }
    }
}


constexpr int PC_STRIDE = 1040, PC_RED = 80 * PC_STRIDE;
template <class StoreF>
__device__ __forceinline__ void gemm_piece80(const bf16* __restrict__ arows, const bf16* __restrict__ brows, unsigned char* lds, const StoreF& store) {
    int tid = threadIdx.x; asm volatile("" : "+v"(tid));
    const int lane = tid & 63, wave = __builtin_amdgcn_readfirstlane(tid >> 6), fr = lane & 15, fq = lane >> 4;
    const int rsel = tid >> 6, ch = tid & 63, nt = wave & 3, kq = wave >> 2;
    v4u st[2][10];
#pragma unroll
    for (int h = 0; h < 2; ++h)
#pragma unroll
        for (int r = 0; r < 10; ++r) {
            const bf16* src = (r < 2 ? arows + (size_t)(r * 8 + rsel) * D : brows + (size_t)(r * 8 + rsel - 16) * D) + h * 512 + ch * 8;
            st[h][r] = *(const v4u*)src;
        }
    f32x4 acc = (f32x4){0.f, 0.f, 0.f, 0.f};
#pragma unroll
    for (int h = 0; h < 2; ++h) {
        if (h) __syncthreads();
#pragma unroll
        for (int r = 0; r < 10; ++r) *(v4u*)(lds + (r * 8 + rsel) * PC_STRIDE + ch * 16) = st[h][r];
        __syncthreads();
#pragma unroll
        for (int ks = 0; ks < 8; ++ks) {
            const bf16x8_t a = *(const bf16x8_t*)(lds + fr * PC_STRIDE + (kq * 256 + ks * 32 + 8 * fq) * 2);
            const bf16x8_t b = *(const bf16x8_t*)(lds + (16 + nt * 16 + fr) * PC_STRIDE + (kq * 256 + ks * 32 + 8 * fq) * 2);
            acc = mfma16(a, b, acc);
        }
    }
    f32x4* part = (f32x4*)(lds + PC_RED);
    if (kq == 1) part[nt * 64 + lane] = acc;
    __syncthreads();
    if (kq == 0) { acc = acc + part[nt * 64 + lane]; store(acc, nt, fr, fq); }
}
__device__ __forceinline__ void sample_gemm_piece(const bf16* __restrict__ A, const bf16* __restrict__ Bt, const float* __restrict__ bias, bf16* __restrict__ O, int ldc, int p, unsigned char* lds) {
    const int mt = p & 7, cb = p >> 3;
    gemm_piece80(A + (size_t)(NP + mt * 16) * D, Bt + (size_t)(cb * 64) * D, lds, [&](const f32x4& acc, int nt, int fr, int fq) {
        const int col = cb * 64 + nt * 16 + fr; const float bv = bias ? bias[col] : 0.f;
#pragma unroll
        for (int r = 0; r < 4; ++r) O[(size_t)(NP + mt * 16 + 4 * fq + r) * ldc + col] = (bf16)f2bf(acc[r] + bv);
    });
}
__device__ __forceinline__ void ab_cols_piece(const bf16* __restrict__ A, const bf16* __restrict__ Bt, bf16* __restrict__ O, int tg, unsigned char* lds) {
    gemm_piece80(Bt + (size_t)ABMAIN * D, A + (size_t)(tg * 64) * D, lds, [&](const f32x4& acc, int nt, int fr, int fq) {
        if (fq < 2) { uint2 o; o.x = pk2(acc[0], acc[1]); o.y = pk2(acc[2], acc[3]); *(uint2*)(O + (size_t)(tg * 64 + nt * 16 + fr) * ABN + ABMAIN + 4 * fq) = o; }
    });
}

constexpr size_t MiB = 1u << 20;
constexpr size_t WS_CTL = 0, CTL_ZERO_BYTES = 64 * 1024;
constexpr size_t WS_WAB = 1 * MiB;
constexpr size_t WS_WOUT = WS_WAB + (size_t)ABNP * D * 2;
constexpr size_t WS_WQ0 = WS_WOUT + (size_t)D * D * 2;
constexpr size_t WS_WQ1 = WS_WQ0 + (size_t)2048 * D * 2;
constexpr size_t WS_WINC = WS_WQ1 + (size_t)2048 * D * 2;
constexpr size_t WS_WOUTC = WS_WINC + (size_t)CN * D * 2;
constexpr size_t WS_ABUF = WS_WOUTC + (size_t)D * D * 2;
constexpr size_t WS_P = WS_ABUF + (size_t)MP * D * 2;
constexpr size_t WS_T = WS_P + (size_t)MP * ABN * 2;
constexpr size_t WS_Q = WS_T + (size_t)4 * 16384 * D + (size_t)4 * 16384 * 4;
constexpr size_t WS_A = WS_Q + (size_t)MP * 1536 * 4;
constexpr size_t WS_B = WS_A + (size_t)MP * 512 * 4;
constexpr size_t WS_O = WS_B + (size_t)MP * 512 * 4;
constexpr size_t WS_X1 = WS_O + (size_t)MP * 512 * 4;
constexpr size_t WS_G = WS_X1 + (size_t)MP * D * 4;
constexpr size_t WS_BETA = WS_G + (size_t)MP * 4 * 4;
constexpr size_t WS_GATE = WS_BETA + (size_t)MP * 4 * 4;
constexpr size_t WS_EXP = WS_GATE + (size_t)MP * 128 * 4;
constexpr size_t WS_HEND = WS_EXP + (size_t)MP * 128 * 4;
constexpr size_t WS_KEYS = WS_HEND + (size_t)3 * 4 * 64 * 512 * 4;
constexpr size_t WS_WGT = WS_KEYS + (size_t)2 * 8 * 2 * 128 * 128 * 2;
constexpr size_t WS_END = WS_WGT + (size_t)2 * 8 * 64 * 64 * 2;
constexpr size_t Q_QKVS = 0, Q_W = 1 * MiB, Q_QG = Q_W + 16 * MiB, Q_KDT = Q_QG + 16 * MiB, Q_UT = Q_KDT + 16 * MiB, Q_QK = Q_UT + 16 * MiB, Q_EGL = Q_QK + 8 * MiB, Q_END = Q_EGL + 4096;
static_assert(Q_END <= (size_t)MP * 1536 * 4, "region Q");
static_assert(WS_END <= 512 * MiB, "d_ws map");

struct MegaArgs {
    const float* in[35];
    float* out;
    unsigned char* ws;
};

__global__ void __launch_bounds__(NTH, 2) fwd_megakernel(MegaArgs ma) {
    cg::grid_group grid = cg::this_grid();
    extern __shared__ __attribute__((aligned(16))) unsigned char lds[];
    float* smem = (float*)lds;
    const int nb = gridDim.x, b0 = blockIdx.x, wave = __builtin_amdgcn_readfirstlane(threadIdx.x >> 6);
    int tid = threadIdx.x, lane = tid & 63;
    const float* x_prompt = ma.in[0];
    const float* x_sample = ma.in[1];
    const float* state_gdn = ma.in[2];
    const float* state_gdn_conv = ma.in[3];
    const float* state_lru = ma.in[4];
    const float* state_lru_conv = ma.in[5];
    const float* cache_k = ma.in[6];
    const float* cache_v = ma.in[7];
    const float* w_in_ab = ma.in[8];
    const float* gdn_conv_w = ma.in[9];
    const float* gdn_a_log = ma.in[10];
    const float* gdn_dt_bias = ma.in[11];
    const float* gdn_norm_w = ma.in[12];
    const float* lru_conv_w = ma.in[13];
    const float* lru_conv_b = ma.in[14];
    const float* lru_w_r = ma.in[15];
    const float* lru_b_r = ma.in[16];
    const float* lru_w_i = ma.in[17];
    const float* lru_b_i = ma.in[18];
    const float* lru_lam = ma.in[19];
    const float* w_out_ab = ma.in[20];
    const float* w_in_c = ma.in[21];
    const float* b_in_c = ma.in[22];
    const float* swa_sinks = ma.in[23];
    const float* w_out_c = ma.in[24];
    const float* b_out_c = ma.in[25];
    const float* rel_bias = ma.in[26];
    const float* ln_mix_g = ma.in[27];
    const float* ln_mix_b = ma.in[28];
    const float* ln_ffn_g = ma.in[29];
    const float* ln_ffn_b = ma.in[30];
    const float* peer_w_q = ma.in[31];
    const float* peer_keys = ma.in[32];
    const float* peer_u = ma.in[33];
    const float* peer_v = ma.in[34];

    float* out = ma.out;
    float* o_y = out;
    float* o_p_gdn = out + (size_t)NT * D;
    float* o_p_gdn_conv = o_p_gdn + 262144;
    float* o_p_lru = o_p_gdn_conv + 18432;
    float* o_p_lru_conv = o_p_lru + 2048;
    float* o_p_k = o_p_lru_conv + 6144;
    float* o_p_v = o_p_k + 131072;
    float* o_s_gdn = o_p_v + 131072;
    float* o_s_gdn_conv = o_s_gdn + 8388608;
    float* o_s_lru = o_s_gdn_conv + 589824;
    float* o_s_lru_conv = o_s_lru + 65536;
    float* o_s_k = o_s_lru_conv + 196608;
    float* o_s_v = o_s_k + 4194304;

    unsigned char* ws = ma.ws;
    bf16* WAB_T = (bf16*)(ws + WS_WAB); bf16* WOUT_T = (bf16*)(ws + WS_WOUT); bf16* WQ0_T = (bf16*)(ws + WS_WQ0); bf16* WQ1_T = (bf16*)(ws + WS_WQ1);
    bf16* WINC_T = (bf16*)(ws + WS_WINC); bf16* WOUTC_T = (bf16*)(ws + WS_WOUTC);
    bf16* ABUF = (bf16*)(ws + WS_ABUF);
    bf16* PROJ = (bf16*)(ws + WS_P); float* Y = (float*)(ws + WS_P); bf16* Qb = (bf16*)(ws + WS_P); bf16* PCb = (bf16*)(ws + WS_P); float* Y1 = (float*)(ws + WS_P);
    unsigned char* TAB8 = ws + WS_T; float* TSC = (float*)(ws + WS_T + (size_t)4 * 16384 * D);
    float* R_Q = (float*)(ws + WS_Q + Q_QKVS) - (size_t)NP * 1536; float* X2 = (float*)(ws + WS_A);
    GdnChunkBufs cbuf; cbuf.W = (bf16*)(ws + WS_Q + Q_W); cbuf.QG = (bf16*)(ws + WS_Q + Q_QG); cbuf.KDT = (bf16*)(ws + WS_Q + Q_KDT); cbuf.UT = (bf16*)(ws + WS_Q + Q_UT); cbuf.QK = (bf16*)(ws + WS_Q + Q_QK); cbuf.EGL = (float*)(ws + WS_Q + Q_EGL);
    bf16* Yb = (bf16*)(ws + WS_P);
    float* OUTS = (float*)(ws + WS_Q);
    float* PD = (float*)(ws + WS_P);
    bf16* KEYSB = (bf16*)(ws + WS_KEYS); bf16* WRT = (bf16*)(ws + WS_WGT); bf16* WIT = WRT + 8 * 64 * 64;
    float* HEND = (float*)(ws + WS_HEND); float* PEND = HEND + 4 * 64 * 512; float* CIN = PEND + 4 * 64 * 512;
    float* R_A = (float*)(ws + WS_A); float* R_B = (float*)(ws + WS_B); float* R_O = (float*)(ws + WS_O);
    bf16* ATTB = (bf16*)(ws + WS_X1);
    float* R_G = (float*)(ws + WS_G); float* R_BETA = (float*)(ws + WS_BETA); float* R_GATE = (float*)(ws + WS_GATE); int* R_EXP = (int*)(ws + WS_EXP);

    for (int u = tid; u < (LDS_BYTES - RING_BYTES) / 4; u += NTH) ((unsigned*)(lds + RING_BYTES))[u] = 0u;
    __syncthreads();
    XcdBarrier bar = xcd_barrier_post((unsigned*)(ws + WS_CTL), (volatile LAS unsigned*)((LAS unsigned char*)lds + MISC_OFF) + 8);
#define GRID_BAR() do { xcd_barrier(bar); asm volatile("" : "+v"(tid)); lane = tid & 63; } while (0)
#define PHASE_LOOP(n) for (int vb = b0; vb < (n); vb += nb)
#define PHASE_END __syncthreads()
#define GEMM_PHASE_M(Mrows, EPI, Aptr, Btptr, Nn, ...) do { pg8::Gemm g_{(const pg8::bf16_t*)(Aptr), (const pg8::bf16_t*)(Btptr), (Mrows), (Nn), D}; pg8::StaticOrder S_; S_.init((Mrows), (Nn), nb, b0); \
        pg8::EPI E_{__VA_ARGS__}; pg8::gemm_phase<pg8::EPI, pg8::StaticOrder, true, true>((PG8_LAS unsigned char*)lds, g_, S_, E_); } while (0)
#define GEMM_PHASE(EPI, Aptr, Btptr, Nn, ...) GEMM_PHASE_M(MP, EPI, Aptr, Btptr, Nn, __VA_ARGS__)
#define GEMM_PHASE_SPLIT(Aptr, Btptr, Nn, Optr, biasptr) do { GEMM_PHASE_M(NP, EpiStoreBf16, Aptr, Btptr, Nn, Optr, Nn, biasptr, NP, Nn); \
          \
        for (int j_ = b0 >> 3; (b0 & 7) + 8 * (j_ >> 3) < (Nn) / 64; j_ += nb >> 3) sample_gemm_piece(Aptr, Btptr, biasptr, Optr, Nn, (j_ & 7) | (((b0 & 7) + 8 * (j_ >> 3)) << 3), lds); } while (0)

    {
        float* scr = smem + wave * 4096;
        const int gw = b0 * NWAVES + wave, NGW = nb * NWAVES;
        constexpr int I_AB = 16 * 97, I_OUT = 16 * 32, I_Q = 16 * 64, I_INC = 16 * 48;
        constexpr int NITEMS = I_AB + I_OUT + 2 * I_Q + I_INC + I_OUT;
        for (int it = gw; it < I_AB; it += NGW) p0_transpose_item<true>(w_in_ab, D, ABN, WAB_T, scr, it, lane);
        for (int it = b0 * NTH + tid; it < 2 * 8 * 64 * 8; it += nb * NTH) {
            const int gsel = it >> 12, nn = (it >> 9) & 7, dd = (it >> 3) & 63, c8 = (it & 7) * 8;
            const float* wsrc = (gsel ? lru_w_i : lru_w_r) + ((size_t)nn * 64 + c8) * 64 + dd;
            v4u o; o.x = pk2(wsrc[0], wsrc[64]); o.y = pk2(wsrc[128], wsrc[192]); o.z = pk2(wsrc[256], wsrc[320]); o.w = pk2(wsrc[384], wsrc[448]);
            *(v4u*)((gsel ? WIT : WRT) + ((size_t)nn * 64 + dd) * 64 + c8) = o;
        }
        for (int kb = 0; kb < NP / 2048; kb += 4) {
            f32x4 v4_[4][4];
#pragma unroll
            for (int i = 0; i < 4; ++i)
#pragma unroll
                for (int j = 0; j < 4; ++j) v4_[i][j] = ((const f32x4*)(x_prompt + (size_t)(gw + (kb + i) * 2048) * D))[lane + 64 * j];
#pragma unroll
            for (int i = 0; i < 4; ++i)
#pragma unroll
                for (int j = 0; j < 4; ++j) { v2u o; o.x = pk2(v4_[i][j].x, v4_[i][j].y); o.y = pk2(v4_[i][j].z, v4_[i][j].w); ((v2u*)(ABUF + (size_t)(gw + (kb + i) * 2048) * D))[lane + 64 * j] = o; }
        }
        for (int m = NP + gw; m < MP + (ABNP - 97 * 32); m += NGW) {
            if (m < MP) row_to_bf16(m < NP ? x_prompt + (size_t)m * D : (m < NT ? x_sample + (size_t)(m - NP) * D : nullptr), ABUF + (size_t)m * D, lane);
            else row_to_bf16(nullptr, WAB_T + (size_t)(97 * 32 + (m - MP)) * D, lane);
        }
    }
    GRID_BAR();
    if (ma.out == nullptr) grid.sync();
    GEMM_PHASE(EpiStoreBf16, ABUF, WAB_T, ABNP, PROJ, ABN, nullptr, NT, ABN);
    GRID_BAR();
    ConvJob cjob; cjob.u0 = peer_u; cjob.v0 = peer_v; cjob.tab = TAB8; cjob.tsc = TSC;
    constexpr int NSPLIT = 32, A_LRU = 4 * NSPLIT, A_GDN = 16 * NSPLIT, B_LRU = 4 * (64 - NSPLIT), B_GDN = 16 * (64 - NSPLIT);
    { AbPrepArgs pa;
      pa.PROJ = PROJ; pa.st_gdn_conv = state_gdn_conv; pa.st_lru_conv = state_lru_conv;
      pa.gdn_conv_w = gdn_conv_w; pa.a_log = gdn_a_log; pa.dt_bias = gdn_dt_bias;
      pa.lru_conv_w = lru_conv_w; pa.lru_conv_b = lru_conv_b; pa.w_r = lru_w_r; pa.b_r = lru_b_r; pa.w_i = lru_w_i; pa.b_i = lru_b_i; pa.lam = lru_lam;
      pa.QKV = R_Q; pa.G = R_G; pa.BETA = R_BETA; pa.LA = R_A; pa.LB = R_B;
      pa.p_gdn_conv = o_p_gdn_conv; pa.p_lru_conv = o_p_lru_conv; pa.s_gdn_conv = o_s_gdn_conv; pa.s_lru_conv = o_s_lru_conv;
      for (int v = b0; v < A_LRU + NS + A_GDN; v += nb) {
          if (v < A_LRU) { lru_prep_unit2(PROJ, lru_conv_w, lru_conv_b, WRT, WIT, lru_b_r, lru_b_i, lru_lam, R_B, R_A, HEND, PEND, o_p_lru_conv, (v / NSPLIT) * 64 + (v % NSPLIT), lds); PHASE_END; }
          else if (v < A_LRU + NS) { ab_prep(pa, NP + (v - A_LRU), smem); PHASE_END; }
          else { const int i = v - A_LRU - NS, h_ = i & 3, n_ = (i >> 2) % NSPLIT, b_ = (i >> 2) / NSPLIT;
                 gdn_prep_unit(PROJ, gdn_conv_w, gdn_a_log, gdn_dt_bias, cbuf, o_p_gdn_conv, (b_ * 64 + n_) * 4 + h_, lds, cjob); }
      } }
    GRID_BAR();
    f32x4 seqS[2]; int seqcur = 0;
    const int seq_p = (b0 & 7) + 8 * (b0 >> 5), seq_s = (b0 >> 3) & 3;
    if (b0 < 64) {
        gdn_seq<0, NSPLIT>(cbuf, R_O, o_p_gdn, seq_p >> 2, seq_p & 3, seq_s, lds, seqS, seqcur);
        table_rows_convert<false>(peer_u + (size_t)16384 * D, TAB8 + (size_t)2 * 16384 * D, TSC + 2 * 16384, 0, 16384, b0 * NWAVES + wave, 64 * NWAVES, lane);
    }
    else for (int v = b0 - 64; v < B_LRU + B_GDN; v += nb - 64) {
        if (v < B_LRU) { lru_prep_unit2(PROJ, lru_conv_w, lru_conv_b, WRT, WIT, lru_b_r, lru_b_i, lru_lam, R_B, R_A, HEND, PEND, o_p_lru_conv, (v / (64 - NSPLIT)) * 64 + NSPLIT + (v % (64 - NSPLIT)), lds); PHASE_END; }
        else { const int i = v - B_LRU, h_ = i & 3, n_ = NSPLIT + (i >> 2) % (64 - NSPLIT), b_ = (i >> 2) / (64 - NSPLIT);
               gdn_prep_unit(PROJ, gdn_conv_w, gdn_a_log, gdn_dt_bias, cbuf, o_p_gdn_conv, (b_ * 64 + n_) * 4 + h_, lds, cjob); }
    }
    GRID_BAR();
    if (b0 < 64) gdn_seq<NSPLIT, 64>(cbuf, R_O, o_p_gdn, seq_p >> 2, seq_p & 3, seq_s, lds, seqS, seqcur);
    else if (b0 < 68) lru_carry(HEND, PEND, CIN, o_p_lru, b0 - 64);
    else {
        for (int v = (b0 - 68) * NWAVES + wave; v < NS * 4 * 8; v += (nb - 68) * NWAVES) gdn_step_sample_w(R_Q, R_G, R_BETA, state_gdn, R_O, o_s_gdn, v, lane);
        for (int v = b0 - 68; v < 128; v += nb - 68) lru_scan(R_A, R_B, state_lru, o_s_lru, NP, 1, NS, v);
        const int gw2 = (b0 - 68) * NWAVES + wave, NGW2 = (nb - 68) * NWAVES;
        for (int m = gw2; m < 512; m += NGW2) row_to_bf16(peer_keys + (size_t)m * D, KEYSB + (size_t)m * D, lane);
        for (int v = b0 - 68; v < 256; v += nb - 68) swa_cache_shift(cache_k, cache_v, o_s_k, o_s_v, v);
        {
            constexpr int I_OUT = 16 * 32, I_Q = 16 * 64, I_INC = 16 * 48;
            float* scr = smem + wave * 4096;
            for (int it = gw2; it < I_OUT + 2 * I_Q + I_INC + I_OUT; it += NGW2) {
                int r = it;
                if (r < I_OUT) { p0_transpose_item(w_out_ab, D, D, WOUT_T, scr, r, lane); continue; } r -= I_OUT;
                if (r < I_Q) { p0_transpose_item(peer_w_q, D, 2048, WQ0_T, scr, r, lane); continue; } r -= I_Q;
                if (r < I_Q) { p0_transpose_item(peer_w_q + (size_t)D * 2048, D, 2048, WQ1_T, scr, r, lane); continue; } r -= I_Q;
                if (r < I_INC) { p0_transpose_item(w_in_c, D, CN, WINC_T, scr, r, lane); continue; } r -= I_INC;
                p0_transpose_item(w_out_c, D, D, WOUTC_T, scr, r, lane);
            }
        }
        table_rows_convert<true>(peer_v + (size_t)16384 * D, TAB8 + (size_t)3 * 16384 * D, TSC + 3 * 16384, 0, 16384, gw2, NGW2, lane);
    }
    GRID_BAR();
    PHASE_LOOP(NT / 8) { ab_mix_w(PROJ, R_O, R_B, R_A, CIN, gdn_norm_w, ABUF, vb * 8 + wave, lane); }
    GRID_BAR();
    GEMM_PHASE_SPLIT(ABUF, WOUT_T, D, Yb, (const float*)nullptr);
    GRID_BAR();
    PHASE_LOOP(NT / 8) { const int t = vb * 8 + wave;
        ln_res_w<false>(t < NP ? x_prompt + (size_t)t * D : x_sample + (size_t)(t - NP) * D, Yb + (size_t)t * D, ln_mix_g, ln_mix_b, ABUF + (size_t)t * D, lane); }
    GRID_BAR();
    GEMM_PHASE_SPLIT(ABUF, WQ0_T, 2048, Qb, (const float*)nullptr);
    GRID_BAR();
    { bf16x8_t tq_[4]; if (b0 < (NT / 64) * 8) peer_topk_ldq(tq_, Qb, b0 >> 3, b0 & 7, tid);
      if ((nb & 7) == 0) { peer_topk_stage_keys(KEYSB, b0 & 7, lds); PHASE_LOOP((NT / 64) * 8) { peer_topk4(Qb, R_EXP, R_GATE, vb >> 3, vb & 7, lds, tq_, vb + nb < (NT / 64) * 8 ? (vb + nb) >> 3 : -1); } }
      else PHASE_LOOP((NT / 64) * 8) { peer_topk_stage_keys(KEYSB, vb & 7, lds); peer_topk_ldq(tq_, Qb, vb >> 3, vb & 7, tid); peer_topk4(Qb, R_EXP, R_GATE, vb >> 3, vb & 7, lds, tq_, -1); } }
    GRID_BAR();
    asm volatile("" : "+v"(tid)); lane = tid & 63;
    { const int x = b0 & 7, tg0 = b0 >> 3, tgstep = nb >> 3, nit = (NT / 8 - tg0 + tgstep - 1) / tgstep;
      peer_u_loop(ABUF, R_EXP, TAB8 + (size_t)x * 16384 * 128, PD + (size_t)x * NT * 128, x, tg0, tgstep, nit, wave, lane); }
    GRID_BAR();
    PHASE_LOOP(NT / 8) { const int t = vb * 8 + wave; peer_xk(R_EXP + (size_t)t * 128, R_GATE + (size_t)t * 128, PD + (size_t)t * 128, TSC, TSC + 16384, lane); }
    GRID_BAR();
    { const int x = b0 & 7, tg0 = b0 >> 3, tgstep = nb >> 3, nit = (NT / 8 - tg0 + tgstep - 1) / tgstep;
      peer_v_loop(R_EXP, R_GATE, TAB8 + (size_t)16384 * D + (size_t)x * 16384 * 128, OUTS, x, tg0, tgstep, nit, wave, lane); }
    GRID_BAR();
    PHASE_LOOP(NT / 8) { const int t = vb * 8 + wave; peer_xc(ABUF + (size_t)t * D, OUTS + (size_t)t * D, ln_ffn_g, ln_ffn_b, nullptr, ABUF + (size_t)t * D, nullptr, lane); }
    GRID_BAR();

    GEMM_PHASE(EpiStoreBf16, ABUF, WINC_T, CN, PCb, CN, b_in_c, NT, CN);
    GRID_BAR();
    PHASE_LOOP(1024 + 256 + 260) {
        if (vb < 1024) attn_unit(PCb, rel_bias, swa_sinks, ATTB, vb, lds);
        else if (vb < 1280) swa_attn_sample(PCb, cache_k, cache_v, rel_bias, swa_sinks, ATTB, (vb - 1024) * 8 + wave, lane);
        else swa_kv_out3(PCb, cache_k, cache_v, o_p_k, o_p_v, o_s_k, o_s_v, vb - 1280);
    }
    GRID_BAR();
    GEMM_PHASE_SPLIT(ATTB, WOUTC_T, D, Yb, b_out_c);
    GRID_BAR();
    PHASE_LOOP(NT / 8) { const int t = vb * 8 + wave;
        ln_res_w<true>(ABUF + (size_t)t * D, Yb + (size_t)t * D, ln_mix_g + D, ln_mix_b + D, ABUF + (size_t)t * D, lane); }
    GRID_BAR();
    GEMM_PHASE_SPLIT(ABUF, WQ1_T, 2048, Qb, (const float*)nullptr);
    GRID_BAR();
    { bf16x8_t tq_[4]; if (b0 < (NT / 64) * 8) peer_topk_ldq(tq_, Qb, b0 >> 3, b0 & 7, tid);
      if ((nb & 7) == 0) { peer_topk_stage_keys(KEYSB + (size_t)8 * 2 * 128 * 128, b0 & 7, lds); PHASE_LOOP((NT / 64) * 8) { peer_topk4(Qb, R_EXP, R_GATE, vb >> 3, vb & 7, lds, tq_, vb + nb < (NT / 64) * 8 ? (vb + nb) >> 3 : -1); } }
      else PHASE_LOOP((NT / 64) * 8) { peer_topk_stage_keys(KEYSB + (size_t)8 * 2 * 128 * 128, vb & 7, lds); peer_topk_ldq(tq_, Qb, vb >> 3, vb & 7, tid); peer_topk4(Qb, R_EXP, R_GATE, vb >> 3, vb & 7, lds, tq_, -1); } }
    GRID_BAR();
    asm volatile("" : "+v"(tid)); lane = tid & 63;
    { const int x = b0 & 7, tg0 = b0 >> 3, tgstep = nb >> 3, nit = (NT / 8 - tg0 + tgstep - 1) / tgstep;
      peer_u_loop(ABUF, R_EXP, TAB8 + (size_t)2 * 16384 * D + (size_t)x * 16384 * 128, PD + (size_t)x * NT * 128, x, tg0, tgstep, nit, wave, lane); }
    GRID_BAR();
    PHASE_LOOP(NT / 8) { const int t = vb * 8 + wave; peer_xk(R_EXP + (size_t)t * 128, R_GATE + (size_t)t * 128, PD + (size_t)t * 128, TSC + 2 * 16384, TSC + 3 * 16384, lane); }
    GRID_BAR();
    { const int x = b0 & 7, tg0 = b0 >> 3, tgstep = nb >> 3, nit = (NT / 8 - tg0 + tgstep - 1) / tgstep;
      peer_v_loop(R_EXP, R_GATE, TAB8 + (size_t)3 * 16384 * D + (size_t)x * 16384 * 128, OUTS, x, tg0, tgstep, nit, wave, lane); }
    GRID_BAR();
    PHASE_LOOP(NT / 8) { const int t = vb * 8 + wave; peer_xc(ABUF + (size_t)t * D, OUTS + (size_t)t * D, ln_ffn_g + D, ln_ffn_b + D, o_y + (size_t)t * D, nullptr, nullptr, lane); }
}
}

extern "C" void kernel_launch(void* const* d_in, const int* in_sizes, int n_in,
                              void* d_out, int out_size, void* d_ws, size_t ws_size,
                              hipStream_t stream) {
    static int grid_blocks = 0;
    if (!grid_blocks) {
        int dev = 0, cus = 0, per_cu = 0;
        (void)hipGetDevice(&dev);
        (void)hipDeviceGetAttribute(&cus, hipDeviceAttributeMultiprocessorCount, dev);
        if (hipFuncSetAttribute((const void*)fwd_megakernel, hipFuncAttributeMaxDynamicSharedMemorySize, LDS_BYTES) != hipSuccess) { fprintf(stderr, "hipFuncSetAttribute failed\n"); grid_blocks = -1; return; }
        (void)hipOccupancyMaxActiveBlocksPerMultiprocessor(&per_cu, (const void*)fwd_megakernel, NTH, LDS_BYTES);
        if (per_cu < 1) { fprintf(stderr, "occupancy query says %d blocks per CU\n", per_cu); grid_blocks = -1; return; }
        if (cus * per_cu < 256) { fprintf(stderr, "this kernel needs 256 co-resident workgroups (device reports %d CUs x %d)\n", cus, per_cu); grid_blocks = -1; return; }
        grid_blocks = 256;
    }
    if (grid_blocks < 0) return;
    (void)hipMemsetAsync((char*)d_ws + WS_CTL, 0, CTL_ZERO_BYTES, stream);
    MegaArgs ma{};
    for (int i = 0; i < 35; ++i) ma.in[i] = (const float*)d_in[i];
    ma.out = (float*)d_out;
    ma.ws = (unsigned char*)d_ws;
    void* args[] = {&ma};
    hipError_t e = hipLaunchCooperativeKernel((void*)fwd_megakernel, dim3(grid_blocks), dim3(NTH), args, LDS_BYTES, stream);
    if (e != hipSuccess) fprintf(stderr, "cooperative launch failed: %s (grid %d)\n", hipGetErrorString(e), grid_blocks);
}
```

```cpp
#include <hip/hip_runtime.h>
#include <hip/hip_cooperative_groups.h>
#include <cstdio>
#include <cstdint>
namespace cg = cooperative_groups;

namespace pg8 {
#define PG8_LAS __attribute__((address_space(3)))
typedef unsigned short bf16_t;
typedef short bf16x8 __attribute__((ext_vector_type(8)));
typedef float f32x4 __attribute__((ext_vector_type(4)));
typedef unsigned u32x4 __attribute__((ext_vector_type(4)));
constexpr int BM = 256, BK = 64, HALF = 128, HTB = HALF * BK * 2  , STAGE_BYTES = 8 * HTB, NXCD = 8, WGM = 8;

__host__ __device__ __forceinline__ int lds_byte(int r, int c) { const int st = (r >> 4) * 2 + (c >> 5), rr = r & 15, cc = c & 31, ob = rr * 64 + cc * 2; return st * 1024 + (ob ^ (((ob >> 9) & 1) << 5)); }
__host__ __device__ __forceinline__ void stage_rc(int b, int& R, int& C) { const int st = b / 1024, sb = b % 1024, swz = sb ^ (((sb >> 9) & 1) << 5); R = (st >> 1) * 16 + swz / 64; C = (st & 1) * 32 + (swz % 64) / 2; }
__host__ __device__ __forceinline__ int perm32(int rho) { const int n = rho >> 4, i = rho & 15; return 8 * (i >> 2) + 4 * n + (i & 3); }

struct Unit { int pm, pn; };
struct Gemm { const bf16_t* A; const bf16_t* Bt; int M, N, K; };

struct StaticOrder {
    int nM, nN, nwg, G, c;
    __host__ __device__ void init(int M, int N, int G_, int c_) { nM = M / BM; nN = N / BM; nwg = nM * nN; G = G_; c = c_; }
    __host__ __device__ bool next(int i, Unit& u) const {
        const long L = (long)i * G + c; if (L >= nwg) return false;
        int wgid = (int)L; { const int q = nwg / NXCD, r = nwg % NXCD, xcd = wgid % NXCD, off = wgid / NXCD; wgid = (xcd < r ? xcd * (q + 1) : r * (q + 1) + (xcd - r) * q) + off; }
        const int nig = WGM * nN, gid = wgid / nig, fm = gid * WGM, gsz = (nM - fm) < WGM ? (nM - fm) : WGM;
        u.pm = fm + ((wgid % nig) % gsz); u.pn = (wgid % nig) / gsz; return true;
    }
    __device__ __forceinline__ void a_ready(const Unit&) const {}
    __device__ __forceinline__ void done(const Unit&) const {}
};

__device__ __forceinline__ unsigned cvt_pk_bf16(float lo, float hi) { unsigned r; asm volatile("v_cvt_pk_bf16_f32 %0, %1, %2" : "=v"(r) : "v"(lo), "v"(hi)); return r; }
template <class Epi, class Sched, bool ALIGN_EPI = false, bool SP2 = false>
__device__ __forceinline__ void gemm_phase(PG8_LAS unsigned char* lds, const Gemm g, const Sched& S, const Epi& E) {
    int tid_ = threadIdx.x; asm volatile("" : "+v"(tid_));
    const int tid = tid_, wid = __builtin_amdgcn_readfirstlane(tid >> 6), lane = tid & 63, wr = wid >> 2, wc = wid & 3, fr = lane & 15, fq = lane >> 4;
    const int K = g.K, nt = K / BK;
    unsigned voffA[2], voffB[2];
#pragma unroll
    for (int i = 0; i < 2; ++i) { int R, C; stage_rc(tid * 16 + i * 8192, R, C); const int Rb = Epi::PERM ? ((R & ~31) + perm32(R & 31)) : R;
        voffA[i] = (unsigned)(R * K + C) * 2u; voffB[i] = (unsigned)(Rb * K + C) * 2u; }
    const size_t kstep = (size_t)(BK * 2);
    const size_t hstep = (size_t)HALF * K * 2;
    const size_t tstep = 2 * hstep;
    const unsigned ldsw = (unsigned)wid * 1024u;
    const int aoff = lds_byte(wr * 64 + fr, fq * 8), boff = lds_byte(wc * 32 + fr, fq * 8);
#define PG8_SA(b, h) (((b) * 2 + (h)) * HTB)
#define PG8_SB(b, h) ((4 + (b) * 2 + (h)) * HTB)
#define PG8_STAGE(bufoff, gbase, voff) do { _Pragma("unroll") for (int _i = 0; _i < 2; ++_i) \
        __builtin_amdgcn_global_load_lds((const unsigned*)((const char*)(gbase) + (voff)[_i]), (PG8_LAS unsigned*)(lds + (bufoff) + ldsw + _i * 8192), 16, 0, 0); } while (0)
#define PG8_LDA(dst, b, h) do { _Pragma("unroll") for (int m = 0; m < 4; ++m) _Pragma("unroll") for (int k = 0; k < 2; ++k) dst[m][k] = *(const PG8_LAS bf16x8*)(lds + PG8_SA(b, h) + aoff + m * 2048 + k * 1024); } while (0)
#define PG8_LDB(dst, b, h) do { _Pragma("unroll") for (int n = 0; n < 2; ++n) _Pragma("unroll") for (int k = 0; k < 2; ++k) dst[n][k] = *(const PG8_LAS bf16x8*)(lds + PG8_SB(b, h) + boff + n * 2048 + k * 1024); } while (0)
#define PG8_MMA(ai, bj, At, Bt) do { __builtin_amdgcn_s_setprio(1); _Pragma("unroll") for (int m = 0; m < 4; ++m) _Pragma("unroll") for (int n = 0; n < 2; ++n) _Pragma("unroll") for (int k = 0; k < 2; ++k) \
        acc[ai][bj][m][n] = __builtin_amdgcn_mfma_f32_16x16x32_bf16(Bt[n][k], At[m][k], acc[ai][bj][m][n], 0, 0, 0); __builtin_amdgcn_s_setprio(0); } while (0)
#define PG8_WAIT_V(n) asm volatile("s_waitcnt vmcnt(" #n ")" ::: "memory")
#define PG8_WAIT_L(n) asm volatile("s_waitcnt lgkmcnt(" #n ")" ::: "memory")
#define PG8_BAR __builtin_amdgcn_s_barrier()
#define PG8_SCHED __builtin_amdgcn_sched_barrier(0)
    Unit cur, nxt; int ui = 0;
    if (!S.next(0, cur)) return;
    f32x4 acc[2][2][4][2];
#pragma unroll
    for (int a = 0; a < 2; ++a)
#pragma unroll
        for (int b = 0; b < 2; ++b)
#pragma unroll
            for (int m = 0; m < 4; ++m)
#pragma unroll
                for (int n = 0; n < 2; ++n) acc[a][b][m][n] = (f32x4){0.f, 0.f, 0.f, 0.f};
    bf16x8 At[4][2], B0[2][2], B1[2][2];
    const char* cA = (const char*)g.A + (size_t)cur.pm * tstep; const char* cB = (const char*)g.Bt + (size_t)cur.pn * tstep;
    S.a_ready(cur);
    if constexpr (SP2) {
        PG8_STAGE(PG8_SB(0, 0), cB, voffB); PG8_STAGE(PG8_SB(0, 1), cB + hstep, voffB); PG8_STAGE(PG8_SA(0, 0), cA, voffA); PG8_STAGE(PG8_SA(0, 1), cA + hstep, voffA);
        if (wr == 1) PG8_BAR;
        PG8_WAIT_V(2); PG8_BAR;
        PG8_STAGE(PG8_SB(1, 0), cB + kstep, voffB); PG8_STAGE(PG8_SA(1, 0), cA + kstep, voffA); PG8_STAGE(PG8_SB(1, 1), cB + hstep + kstep, voffB);
        PG8_WAIT_V(6); PG8_BAR;
    } else {
        PG8_STAGE(PG8_SB(0, 0), cB, voffB); PG8_STAGE(PG8_SA(0, 0), cA, voffA); PG8_STAGE(PG8_SB(0, 1), cB + hstep, voffB); PG8_STAGE(PG8_SA(0, 1), cA + hstep, voffA);
        if (wr == 1) PG8_BAR;
        PG8_WAIT_V(4); PG8_BAR;
        PG8_STAGE(PG8_SB(1, 0), cB + kstep, voffB); PG8_STAGE(PG8_SA(1, 0), cA + kstep, voffA); PG8_STAGE(PG8_SB(1, 1), cB + hstep + kstep, voffB);
        PG8_WAIT_V(6); PG8_BAR;
    }
    for (;;) {
        const bool has_next = S.next(ui + 1, nxt);
        const char* nA = has_next ? (const char*)g.A + (size_t)nxt.pm * tstep : cA; const char* nB = has_next ? (const char*)g.Bt + (size_t)nxt.pn * tstep : cB;
        for (int t = 0; t < nt; t += 2) {
            const bool last = (t == nt - 2);
            const char* a1 = cA + (size_t)(t + 1) * kstep;
            const char* a2 = last ? nA : cA + (size_t)(t + 2) * kstep; const char* b2 = last ? nB : cB + (size_t)(t + 2) * kstep;
            const char* a3 = a2 + kstep; const char* b3 = b2 + kstep;
            if (last && has_next) S.a_ready(nxt);
            if constexpr (SP2) {
            PG8_LDB(B0, 0, 0); PG8_LDB(B1, 0, 1); PG8_SCHED; PG8_LDA(At, 0, 0); PG8_STAGE(PG8_SA(1, 1), a1 + hstep, voffA);
            PG8_WAIT_V(8); PG8_WAIT_L(0); PG8_BAR; PG8_MMA(0, 0, At, B0); PG8_MMA(0, 1, At, B1); PG8_BAR; PG8_SCHED;
            PG8_LDA(At, 0, 1); PG8_STAGE(PG8_SB(0, 0), b2, voffB); PG8_STAGE(PG8_SB(0, 1), b2 + hstep, voffB); PG8_STAGE(PG8_SA(0, 0), a2, voffA);
            PG8_WAIT_V(8); PG8_WAIT_L(0); PG8_BAR; PG8_MMA(1, 0, At, B0); PG8_MMA(1, 1, At, B1); PG8_BAR; PG8_SCHED;
            PG8_LDB(B0, 1, 0); PG8_LDB(B1, 1, 1); PG8_SCHED; PG8_LDA(At, 1, 0); PG8_STAGE(PG8_SA(0, 1), a2 + hstep, voffA);
            PG8_WAIT_V(8); PG8_WAIT_L(0); PG8_BAR; PG8_MMA(0, 0, At, B0); PG8_MMA(0, 1, At, B1); PG8_BAR; PG8_SCHED;
            PG8_LDA(At, 1, 1); PG8_STAGE(PG8_SB(1, 0), b3, voffB); PG8_STAGE(PG8_SB(1, 1), b3 + hstep, voffB); PG8_STAGE(PG8_SA(1, 0), a3, voffA);
            PG8_WAIT_V(8); PG8_WAIT_L(0); PG8_BAR; PG8_MMA(1, 0, At, B0); PG8_MMA(1, 1, At, B1); PG8_BAR; PG8_SCHED;
            } else {
            PG8_LDB(B0, 0, 0); PG8_SCHED; PG8_LDA(At, 0, 0); PG8_STAGE(PG8_SA(1, 1), a1 + hstep, voffA);
            PG8_WAIT_L(8); PG8_BAR; PG8_WAIT_L(0); PG8_MMA(0, 0, At, B0); PG8_BAR; PG8_SCHED;
            PG8_LDB(B1, 0, 1); PG8_STAGE(PG8_SB(0, 0), b2, voffB);
            PG8_BAR; PG8_WAIT_L(0); PG8_MMA(0, 1, At, B1); PG8_BAR;
            PG8_LDA(At, 0, 1); PG8_STAGE(PG8_SA(0, 0), a2, voffA);
            PG8_BAR; PG8_WAIT_L(0); PG8_MMA(1, 0, At, B0); PG8_BAR; PG8_SCHED;
            PG8_STAGE(PG8_SB(0, 1), b2 + hstep, voffB);
            PG8_WAIT_V(6); PG8_BAR; PG8_MMA(1, 1, At, B1); PG8_BAR;
            PG8_LDB(B0, 1, 0); PG8_SCHED; PG8_LDA(At, 1, 0); PG8_STAGE(PG8_SA(0, 1), a2 + hstep, voffA);
            PG8_WAIT_L(8); PG8_BAR; PG8_WAIT_L(0); PG8_MMA(0, 0, At, B0); PG8_BAR; PG8_SCHED;
            PG8_LDB(B1, 1, 1); PG8_STAGE(PG8_SB(1, 0), b3, voffB);
            PG8_BAR; PG8_WAIT_L(0); PG8_MMA(0, 1, At, B1); PG8_BAR;
            PG8_LDA(At, 1, 1); PG8_STAGE(PG8_SA(1, 0), a3, voffA);
            PG8_BAR; PG8_WAIT_L(0); PG8_MMA(1, 0, At, B0); PG8_BAR; PG8_SCHED;
            PG8_STAGE(PG8_SB(1, 1), b3 + hstep, voffB);
            PG8_WAIT_V(6); PG8_BAR; PG8_MMA(1, 1, At, B1); PG8_BAR;
            }
        }
        if constexpr (ALIGN_EPI) { if (wr == 0) PG8_BAR; }
        if constexpr (!Epi::AFTER_DRAIN) { E(acc, cur, wr, wc, fr, fq); S.done(cur); }
        if (!has_next) break;
#pragma unroll
        for (int a = 0; a < 2; ++a)
#pragma unroll
            for (int b = 0; b < 2; ++b)
#pragma unroll
                for (int m = 0; m < 4; ++m)
#pragma unroll
                    for (int n = 0; n < 2; ++n) acc[a][b][m][n] = (f32x4){0.f, 0.f, 0.f, 0.f};
        cur = nxt; cA = nA; cB = nB; ++ui;
        if constexpr (ALIGN_EPI) { if (wr == 1) PG8_BAR; }
    }
    PG8_WAIT_V(0);
    if constexpr (!ALIGN_EPI) { if (wr == 0) PG8_BAR; }
    PG8_BAR;
    if constexpr (Epi::AFTER_DRAIN) { E.fused(acc, cur, wr, wc, fr, fq, lds, wid, lane); S.done(cur); }
#undef PG8_SA
#undef PG8_SB
#undef PG8_STAGE
#undef PG8_LDA
#undef PG8_LDB
#undef PG8_MMA
#undef PG8_WAIT_V
#undef PG8_WAIT_L
#undef PG8_BAR
#undef PG8_SCHED
}
}
namespace pg8 {
struct EpiStoreBf16 {
    static constexpr bool PERM = true, AFTER_DRAIN = false;
    bf16_t* O; int ldc; const float* bias; int m_real, n_real;
    __device__ __forceinline__ void operator()(const f32x4 (&acc)[2][2][4][2], const Unit& u, int wr, int wc, int fr, int fq) const {
        const int row0 = u.pm * BM + wr * 64 + fr, col0 = u.pn * BM + wc * 32 + 8 * fq;
#pragma unroll
        for (int bj = 0; bj < 2; ++bj) {
            const int col = col0 + bj * HALF;
            if (col >= n_real) continue;
            f32x4 b0 = (f32x4){0.f, 0.f, 0.f, 0.f}, b1 = b0;
            if (bias) { b0 = *(const f32x4*)(bias + col); b1 = *(const f32x4*)(bias + col + 4); }
#pragma unroll
            for (int ai = 0; ai < 2; ++ai)
#pragma unroll
                for (int m = 0; m < 4; ++m) {
                    const int row = row0 + ai * HALF + m * 16;
                    if (row >= m_real) continue;
                    const f32x4 v0 = acc[ai][bj][m][0] + b0, v1 = acc[ai][bj][m][1] + b1;
                    u32x4 w; w.x = cvt_pk_bf16(v0[0], v0[1]); w.y = cvt_pk_bf16(v0[2], v0[3]); w.z = cvt_pk_bf16(v1[0], v1[1]); w.w = cvt_pk_bf16(v1[2], v1[3]);
                    *(u32x4*)(O + (size_t)row * ldc + col) = w;
                }
        }
    }
};
struct EpiStoreF32 {
    static constexpr bool PERM = false, AFTER_DRAIN = false;
    float* O; int ldc; const float* bias; int m_real, n_real;
    __device__ __forceinline__ void operator()(const f32x4 (&acc)[2][2][4][2], const Unit& u, int wr, int wc, int fr, int fq) const {
        const int row0 = u.pm * BM + wr * 64 + fr, col0 = u.pn * BM + wc * 32 + 4 * fq;
#pragma unroll
        for (int bj = 0; bj < 2; ++bj)
#pragma unroll
            for (int n = 0; n < 2; ++n) {
                const int col = col0 + bj * HALF + n * 16;
                if (col >= n_real) continue;
                const f32x4 bv = bias ? *(const f32x4*)(bias + col) : (f32x4){0.f, 0.f, 0.f, 0.f};
#pragma unroll
                for (int ai = 0; ai < 2; ++ai)
#pragma unroll
                    for (int m = 0; m < 4; ++m) {
                        const int row = row0 + ai * HALF + m * 16;
                        if (row >= m_real) continue;
                        *(f32x4*)(O + (size_t)row * ldc + col) = acc[ai][bj][m][n] + bv;
                    }
            }
    }
};
}
namespace {
#define GAS __attribute__((address_space(1)))
#define LAS __attribute__((address_space(3)))
typedef unsigned short bf16;
typedef float f32x4 __attribute__((ext_vector_type(4)));
typedef unsigned v4u __attribute__((ext_vector_type(4)));
typedef unsigned v2u __attribute__((ext_vector_type(2)));

constexpr int D = 1024, NB = 4, SEQ = 4096, NP = NB * SEQ, NS = 128, NT = NP + NS, MP = 16640;
constexpr int ABN = 3080, ABNP = 3328;
constexpr int C_QKV = 0, C_Z = 1536, C_XR = 2048, C_GATE = 2560, C_A = 3072, C_B = 3076;
constexpr int ABMAIN = 3072;
constexpr int CN = 1536;
constexpr float ALPHA = 1.4142135623730951f;
constexpr float LN_EPS = 1e-5f;
constexpr int NTH = 512, NWAVES = 8;
constexpr int RING_BYTES = 143360, MISC_OFF = RING_BYTES + 320, LDS_BYTES = 147456;

__device__ __forceinline__ float bf2f(bf16 v) { return __uint_as_float((unsigned)v << 16); }
__device__ __forceinline__ float bflo(unsigned w) { return __uint_as_float(w << 16); }
__device__ __forceinline__ float bfhi(unsigned w) { return __uint_as_float(w & 0xffff0000u); }
typedef float f32x2c_t __attribute__((ext_vector_type(2)));
typedef __bf16 bf16x2c_t __attribute__((ext_vector_type(2)));
__device__ __forceinline__ unsigned f2bf(float f) { return (unsigned)__builtin_bit_cast(unsigned short, (__bf16)f); }
__device__ __forceinline__ unsigned pk2(float lo, float hi) { return __builtin_bit_cast(unsigned, __builtin_convertvector((f32x2c_t){lo, hi}, bf16x2c_t)); }
__device__ __forceinline__ float sigmoidf_(float x) { return 1.0f / (1.0f + expf(-x)); }
__device__ __forceinline__ float softplusf_(float x) { return fmaxf(x, 0.f) + log1pf(expf(-fabsf(x))); }
__device__ __forceinline__ float siluf_(float x) { return x / (1.0f + expf(-x)); }
__device__ __forceinline__ float geluf_(float x) { return 0.5f * x * (1.0f + tanhf(0.7978845608028654f * (x + 0.044715f * x * x * x))); }
#define DPPF(v_, ctrl_, rmask_) __int_as_float(__builtin_amdgcn_update_dpp(0, __float_as_int(v_), (ctrl_), (rmask_), 0xf, false))
__device__ __forceinline__ float wave_sum(float v) {
    v += DPPF(v, 0xB1, 0xf); v += DPPF(v, 0x4E, 0xf); v += DPPF(v, 0x141, 0xf); v += DPPF(v, 0x140, 0xf);
    v += DPPF(v, 0x142, 0xa); v += DPPF(v, 0x143, 0xc);
    return __int_as_float(__builtin_amdgcn_readlane(__float_as_int(v), 63));
}
__device__ __forceinline__ float wave_max(float v) {
    v = fmaxf(v, DPPF(v, 0xB1, 0xf)); v = fmaxf(v, DPPF(v, 0x4E, 0xf)); v = fmaxf(v, DPPF(v, 0x141, 0xf)); v = fmaxf(v, DPPF(v, 0x140, 0xf));
    { const float t = __int_as_float(__builtin_amdgcn_update_dpp(__float_as_int(v), __float_as_int(v), 0x142, 0xa, 0xf, false)); v = fmaxf(v, t); }
    { const float t = __int_as_float(__builtin_amdgcn_update_dpp(__float_as_int(v), __float_as_int(v), 0x143, 0xc, 0xf, false)); v = fmaxf(v, t); }
    return __int_as_float(__builtin_amdgcn_readlane(__float_as_int(v), 63));
}

template <bool ABORDER = false>
__device__ __forceinline__ void p0_transpose_item(const float* __restrict__ W, int K, int N, bf16* __restrict__ WT, float* scr, int item, int lane) {
    const int nblk = (N + 31) / 32, kb = item / nblk, nb = item % nblk, k0 = 64 * kb, n0 = 32 * nb;
    const int n_ = n0 + (lane & 31);
    const int ns = ABORDER ? (n_ < 2048 ? n_ : (n_ < ABMAIN ? n_ + 8 : n_ - 1024)) : n_;
    float wv_[32];
#pragma unroll
    for (int i = 0; i < 32; ++i) { const int kk = 2 * i + (lane >> 5); wv_[i] = n_ < N ? W[(size_t)(k0 + kk) * N + ns] : 0.f; }
#pragma unroll
    for (int i = 0; i < 32; ++i) { const int kk = 2 * i + (lane >> 5); scr[kk * 33 + (lane & 31)] = wv_[i]; }
    asm volatile("s_waitcnt lgkmcnt(0)" ::: "memory");
    const int c = lane & 7;
#pragma unroll
    for (int j = 0; j < 4; ++j) { const int n = (lane >> 3) + 8 * j; const float* s = scr + (8 * c) * 33 + n;
        v4u o; o.x = pk2(s[0 * 33], s[1 * 33]); o.y = pk2(s[2 * 33], s[3 * 33]); o.z = pk2(s[4 * 33], s[5 * 33]); o.w = pk2(s[6 * 33], s[7 * 33]);
        *(v4u*)(WT + (size_t)(n0 + n) * K + k0 + 8 * c) = o; }
    asm volatile("s_waitcnt lgkmcnt(0)" ::: "memory");
}
__device__ __forceinline__ void row_to_bf16(const float* __restrict__ xrow, bf16* __restrict__ orow, int lane) {
#pragma unroll
    for (int j = 0; j < 4; ++j) {
        f32x4 v = (f32x4){0.f, 0.f, 0.f, 0.f};
        if (xrow) v = ((const f32x4*)xrow)[lane + 64 * j];
        v2u o; o.x = pk2(v.x, v.y); o.y = pk2(v.z, v.w);
        ((v2u*)orow)[lane + 64 * j] = o;
    }
}

struct AbPrepArgs {
    const bf16* PROJ; const float* st_gdn_conv; const float* st_lru_conv;
    const float* gdn_conv_w; const float* a_log; const float* dt_bias;
    const float* lru_conv_w; const float* lru_conv_b; const float* w_r; const float* b_r; const float* w_i; const float* b_i; const float* lam;
    float* QKV; float* G; float* BETA; float* LA; float* LB;
    float* p_gdn_conv; float* p_lru_conv; float* s_gdn_conv; float* s_lru_conv;
};
__device__ __forceinline__ void ab_prep(const AbPrepArgs& a, int t, float* smem) {
    int tid = threadIdx.x; asm volatile("" : "+v"(tid));
    const int lane = tid & 63, wid = tid >> 6;
    const bool samp = t >= NP; const int sb = t - NP, pos = t % SEQ, b = t / SEQ;
    float* sq = smem;
    float* sx = smem + 1536;
    float* scl = smem + 2048;
    const bf16* prow = a.PROJ + (size_t)t * ABN;
    for (int c = tid; c < 1536; c += NTH) {
        float acc = 0.f;
#pragma unroll
        for (int i = 0; i < 4; ++i) {
            float xv;
            if (i == 3) xv = bf2f(prow[C_QKV + c]);
            else if (samp) xv = a.st_gdn_conv[((size_t)sb * 3 + i) * 1536 + c];
            else xv = (pos - 3 + i >= 0) ? bf2f(a.PROJ[(size_t)(t - 3 + i) * ABN + C_QKV + c]) : 0.f;
            acc += a.gdn_conv_w[i * 1536 + c] * xv;
        }
        sq[c] = siluf_(acc);
    }
    {
        const int c = tid;
        float acc = a.lru_conv_b[c];
#pragma unroll
        for (int i = 0; i < 4; ++i) {
            float xv;
            if (i == 3) xv = bf2f(prow[C_XR + c]);
            else if (samp) xv = a.st_lru_conv[((size_t)sb * 3 + i) * 512 + c];
            else xv = (pos - 3 + i >= 0) ? bf2f(a.PROJ[(size_t)(t - 3 + i) * ABN + C_XR + c]) : 0.f;
            acc += a.lru_conv_w[i * 512 + c] * xv;
        }
        sx[c] = acc;
    }
    __syncthreads();
    {
        const int grp = wid;
        const float v0 = sq[grp * 128 + lane], v1 = sq[grp * 128 + 64 + lane];
        const float s = wave_sum(v0 * v0 + v1 * v1);
        if (lane == 0) scl[grp] = rsqrtf(s + 1e-6f) * (grp < 4 ? 0.08838834764831845f : 1.0f);
    }
    __syncthreads();
    for (int c = tid; c < 1536; c += NTH) a.QKV[(size_t)t * 1536 + c] = (c < 1024) ? sq[c] * scl[c >> 7] : sq[c];
    if (tid < 4) {
        const float a_raw = bf2f(prow[C_A + tid]), b_raw = bf2f(prow[C_B + tid]);
        a.G[(size_t)t * 4 + tid] = -expf(a.a_log[tid]) * softplusf_(a_raw + a.dt_bias[tid]);
        a.BETA[(size_t)t * 4 + tid] = sigmoidf_(b_raw);
    }
    if (!samp) {
        if (pos >= SEQ - 3) {
            const int row = pos - (SEQ - 3);
            for (int c = tid; c < 1536; c += NTH) a.p_gdn_conv[((size_t)b * 3 + row) * 1536 + c] = bf2f(prow[C_QKV + c]);
            a.p_lru_conv[((size_t)b * 3 + row) * 512 + tid] = bf2f(prow[C_XR + tid]);
        }
    } else {
        for (int c = tid; c < 1536; c += NTH) {
            a.s_gdn_conv[((size_t)sb * 3 + 0) * 1536 + c] = a.st_gdn_conv[((size_t)sb * 3 + 1) * 1536 + c];
            a.s_gdn_conv[((size_t)sb * 3 + 1) * 1536 + c] = a.st_gdn_conv[((size_t)sb * 3 + 2) * 1536 + c];
            a.s_gdn_conv[((size_t)sb * 3 + 2) * 1536 + c] = bf2f(prow[C_QKV + c]);
        }
        {
            const int c = tid;
            a.s_lru_conv[((size_t)sb * 3 + 0) * 512 + c] = a.st_lru_conv[((size_t)sb * 3 + 1) * 512 + c];
            a.s_lru_conv[((size_t)sb * 3 + 1) * 512 + c] = a.st_lru_conv[((size_t)sb * 3 + 2) * 512 + c];
            a.s_lru_conv[((size_t)sb * 3 + 2) * 512 + c] = bf2f(prow[C_XR + c]);
        }
    }
    {
        const int c = tid, n = c >> 6, d = c & 63;
        float r = a.b_r[c], ii = a.b_i[c];
#pragma unroll 4
        for (int cc = 0; cc < 64; ++cc) {
            const float xv = sx[n * 64 + cc];
            r += xv * a.w_r[((size_t)n * 64 + cc) * 64 + d];
            ii += xv * a.w_i[((size_t)n * 64 + cc) * 64 + d];
        }
        r = sigmoidf_(r); ii = sigmoidf_(ii);
        const float log_a = -8.0f * r * softplusf_(-a.lam[c]);
        a.LA[(size_t)t * 512 + c] = expf(log_a);
        a.LB[(size_t)t * 512 + c] = sqrtf(-expm1f(2.0f * log_a)) * (ii * sx[c]);
    }
}

__device__ __forceinline__ void gdn_scan(const float* __restrict__ QKV, const float* __restrict__ G, const float* __restrict__ BETA,
                                         const float* __restrict__ S0, float* __restrict__ O, float* __restrict__ Sout, int tok_base, int T,
                                         int sl, int h, int sq, float* smem) {
    int tid = threadIdx.x; asm volatile("" : "+v"(tid));
    const int dvl = tid & 31, kg = tid >> 5;
    const int dv = sl * 32 + dvl;
    float (*red1)[32] = (float (*)[32])smem;
    float (*red2)[32] = (float (*)[32])(smem + 512);
    float S[8];
#pragma unroll
    for (int i = 0; i < 8; ++i) S[i] = S0 ? S0[(((size_t)sq * 4 + h) * 128 + kg * 8 + i) * 128 + dv] : 0.f;
    float kk[8], qq[8], vv, g, be;
    {
        const size_t tok = (size_t)tok_base + (size_t)sq * T;
        const float* row = QKV + tok * 1536;
#pragma unroll
        for (int i = 0; i < 8; ++i) { kk[i] = row[512 + h * 128 + kg * 8 + i]; qq[i] = row[h * 128 + kg * 8 + i]; }
        vv = row[1024 + h * 128 + dv]; g = G[tok * 4 + h]; be = BETA[tok * 4 + h];
    }
    for (int t = 0; t < T; ++t) {
        const size_t tok = (size_t)tok_base + (size_t)sq * T + t;
        float nk[8], nq[8], nv = 0.f, ng = 0.f, nb = 0.f;
        if (t + 1 < T) {
            const float* row = QKV + (tok + 1) * 1536;
#pragma unroll
            for (int i = 0; i < 8; ++i) { nk[i] = row[512 + h * 128 + kg * 8 + i]; nq[i] = row[h * 128 + kg * 8 + i]; }
            nv = row[1024 + h * 128 + dv]; ng = G[(tok + 1) * 4 + h]; nb = BETA[(tok + 1) * 4 + h];
        } else {
#pragma unroll
            for (int i = 0; i < 8; ++i) { nk[i] = 0.f; nq[i] = 0.f; }
        }
        const float al = expf(g);
        float p = 0.f;
#pragma unroll
        for (int i = 0; i < 8; ++i) { S[i] *= al; p += S[i] * kk[i]; }
        red1[kg][dvl] = p;
        __syncthreads();
        float ks = 0.f;
#pragma unroll
        for (int j = 0; j < 16; ++j) ks += red1[j][dvl];
        const float vn = be * (vv - ks);
        float o = 0.f;
#pragma unroll
        for (int i = 0; i < 8; ++i) { S[i] += kk[i] * vn; o += S[i] * qq[i]; }
        red2[kg][dvl] = o;
        __syncthreads();
        if (kg == 0) {
            float os = 0.f;
#pragma unroll
            for (int j = 0; j < 16; ++j) os += red2[j][dvl];
            O[tok * 512 + h * 128 + dv] = os;
        }
#pragma unroll
        for (int i = 0; i < 8; ++i) { kk[i] = nk[i]; qq[i] = nq[i]; }
        vv = nv; g = ng; be = nb;
    }
#pragma unroll
    for (int i = 0; i < 8; ++i) Sout[(((size_t)sq * 4 + h) * 128 + kg * 8 + i) * 128 + dv] = S[i];
}


__device__ __forceinline__ void gdn_step_sample_w(const float* __restrict__ QKV, const float* __restrict__ G, const float* __restrict__ BETA, const float* __restrict__ S0,
                                                  float* __restrict__ O, float* __restrict__ Sout, int item, int lane) {
    const int sl = item & 7, h = (item >> 3) & 3, sb = item >> 5, fr = lane & 15, fq = lane >> 4;
    const size_t tok = (size_t)NP + sb;
    const float* row = QKV + tok * 1536;
    const size_t sbase = (((size_t)sb * 4 + h) * 128 + fq * 32) * 128 + sl * 16 + fr;
    float S[32], kk[32], qq[32];
#pragma unroll
    for (int i = 0; i < 32; ++i) S[i] = S0[sbase + (size_t)i * 128];
#pragma unroll
    for (int i4 = 0; i4 < 8; ++i4) { const f32x4 k4 = *(const f32x4*)(row + 512 + h * 128 + fq * 32 + i4 * 4), q4 = *(const f32x4*)(row + h * 128 + fq * 32 + i4 * 4);
        kk[i4 * 4 + 0] = k4.x; kk[i4 * 4 + 1] = k4.y; kk[i4 * 4 + 2] = k4.z; kk[i4 * 4 + 3] = k4.w; qq[i4 * 4 + 0] = q4.x; qq[i4 * 4 + 1] = q4.y; qq[i4 * 4 + 2] = q4.z; qq[i4 * 4 + 3] = q4.w; }
    const float vv = row[1024 + h * 128 + sl * 16 + fr], al = expf(G[tok * 4 + h]), be = BETA[tok * 4 + h];
    float p = 0.f;
#pragma unroll
    for (int i = 0; i < 32; ++i) { S[i] *= al; p += S[i] * kk[i]; }
    p += __shfl_xor(p, 16); p += __shfl_xor(p, 32);
    const float vn = be * (vv - p);
    float o = 0.f;
#pragma unroll
    for (int i = 0; i < 32; ++i) { S[i] += kk[i] * vn; o += S[i] * qq[i]; }
    o += __shfl_xor(o, 16); o += __shfl_xor(o, 32);
    if (fq == 0) O[tok * 512 + h * 128 + sl * 16 + fr] = o;
#pragma unroll
    for (int i = 0; i < 32; ++i) Sout[sbase + (size_t)i * 128] = S[i];
}

__device__ __forceinline__ void lru_scan(const float* __restrict__ LA, float* __restrict__ LB, const float* __restrict__ h0,
                                         float* __restrict__ hlast, int tok_base, int T, int nseq, int bx) {
    int tx_ = threadIdx.x; asm volatile("" : "+v"(tx_));
    const int idx = bx * NTH + tx_;
    if (idx >= nseq * 512) return;
    const int sq = idx / 512, c = idx % 512;
    float h = h0 ? h0[(size_t)sq * 512 + c] : 0.f;
    const size_t base = ((size_t)tok_base + (size_t)sq * T) * 512 + c;
#pragma unroll 8
    for (int t = 0; t < T; ++t) {
        const size_t o = base + (size_t)t * 512;
        h = LA[o] * h + LB[o];
        LB[o] = h;
    }
    hlast[(size_t)sq * 512 + c] = h;
}

__device__ __forceinline__ void ab_mix_w(const bf16* __restrict__ PROJ, const float* __restrict__ O, const float* __restrict__ H, const float* __restrict__ P, const float* __restrict__ CIN,
                                         const float* __restrict__ norm_w, bf16* __restrict__ MIX, int t, int lane) {
    const bf16* prow = PROJ + (size_t)t * ABN;
#pragma unroll
    for (int jj = 0; jj < 2; ++jj) {
        const int c0 = 256 * jj + 4 * lane;
        const f32x4 o = *(const f32x4*)(O + (size_t)t * 512 + c0);
        const v2u zb = *(const v2u*)(prow + C_Z + c0);
        const f32x4 w = *(const f32x4*)(norm_w + (c0 & 127));
        float ss = (o.x * o.x + o.y * o.y) + (o.z * o.z + o.w * o.w);
        ss += DPPF(ss, 0xB1, 0xf); ss += DPPF(ss, 0x4E, 0xf); ss += DPPF(ss, 0x141, 0xf); ss += DPPF(ss, 0x140, 0xf);
        { const auto sw_ = __builtin_amdgcn_permlane16_swap(__float_as_uint(ss), __float_as_uint(ss), false, false); ss = __uint_as_float(sw_[0]) + __uint_as_float(sw_[1]); }
        const float sc = rsqrtf(ss * (1.0f / 128.0f) + 1e-6f);
        const float z0 = bflo(zb.x), z1 = bfhi(zb.x), z2 = bflo(zb.y), z3 = bfhi(zb.y);
        v2u ob;
        ob.x = pk2(o.x * sc * w.x * (z0 * __frcp_rn(1.0f + __expf(-z0))), o.y * sc * w.y * (z1 * __frcp_rn(1.0f + __expf(-z1))));
        ob.y = pk2(o.z * sc * w.z * (z2 * __frcp_rn(1.0f + __expf(-z2))), o.w * sc * w.w * (z3 * __frcp_rn(1.0f + __expf(-z3))));
        *(v2u*)(MIX + (size_t)t * 1024 + c0) = ob;
    }
#pragma unroll
    for (int jj = 0; jj < 2; ++jj) {
        const int c0 = 256 * jj + 4 * lane;
        const v2u gb = *(const v2u*)(prow + C_GATE + c0);
        f32x4 h = *(const f32x4*)(H + (size_t)t * 512 + c0);
        if (t < NP) { const f32x4 p = *(const f32x4*)(P + (size_t)t * 512 + c0), ci = *(const f32x4*)(CIN + (size_t)(t >> 6) * 512 + c0); h = h + p * ci; }
        v2u ob; ob.x = pk2(geluf_(bflo(gb.x)) * h.x, geluf_(bfhi(gb.x)) * h.y); ob.y = pk2(geluf_(bflo(gb.y)) * h.z, geluf_(bfhi(gb.y)) * h.w);
        *(v2u*)(MIX + (size_t)t * 1024 + 512 + c0) = ob;
    }
}

template <bool XBF>
__device__ __forceinline__ void ln_res_w(const void* __restrict__ xrow_, const bf16* __restrict__ yrow, const float* __restrict__ g, const float* __restrict__ bta,
                                         bf16* __restrict__ obrow, int lane) {
    f32x4 v[4]; float s = 0.f;
#pragma unroll
    for (int j = 0; j < 4; ++j) {
        f32x4 x4;
        if (XBF) { const v2u xb = ((const v2u*)xrow_)[lane + 64 * j]; x4 = (f32x4){bflo(xb.x), bfhi(xb.x), bflo(xb.y), bfhi(xb.y)}; }
        else x4 = ((const f32x4*)xrow_)[lane + 64 * j];
        const v2u yb = ((const v2u*)yrow)[lane + 64 * j];
        const f32x4 y4 = (f32x4){bflo(yb.x), bfhi(yb.x), bflo(yb.y), bfhi(yb.y)}; v[j] = x4 * ALPHA + y4; s += (v[j].x + v[j].y) + (v[j].z + v[j].w); }
    const float mean = wave_sum(s) * (1.0f / 1024.0f); float q = 0.f;
#pragma unroll
    for (int j = 0; j < 4; ++j) { v[j] = v[j] - mean; q += (v[j].x * v[j].x + v[j].y * v[j].y) + (v[j].z * v[j].z + v[j].w * v[j].w); }
    const float rs = rsqrtf(wave_sum(q) * (1.0f / 1024.0f) + LN_EPS);
#pragma unroll
    for (int j = 0; j < 4; ++j) {
        const f32x4 g4 = ((const f32x4*)g)[lane + 64 * j], b4 = ((const f32x4*)bta)[lane + 64 * j];
        const f32x4 o = v[j] * rs * g4 + b4;
        v2u ob; ob.x = pk2(o.x, o.y); ob.y = pk2(o.z, o.w);
        ((v2u*)obrow)[lane + 64 * j] = ob;
    }
}

__device__ __forceinline__ void peer_topk(const bf16* __restrict__ Q, const float* __restrict__ keys, int* __restrict__ EXP, float* __restrict__ GATE,
                                          int tg, int h, float* smem) {
    const int tid = threadIdx.x, cn = tid & 255, c = cn >> 7, n = cn & 127, th = tid >> 8;
    float (*sq)[256] = (float (*)[256])smem;
    float (*ss)[257] = (float (*)[257])(smem + 32 * 256);
    float (*tvs)[2][16] = (float (*)[2][16])(smem + 32 * 256 + 32 * 257 + 32);
    int (*tis)[2][16] = (int (*)[2][16])(smem + 32 * 256 + 32 * 257 + 32 + 1024);
    for (int i = tid; i < 32 * 256; i += NTH) {
        const int tk = i >> 8, col = i & 255;
        sq[tk][col] = bf2f(Q[(size_t)(tg * 32 + tk) * 2048 + h * 256 + col]);
    }
    __syncthreads();
    float acc[16];
#pragma unroll
    for (int i = 0; i < 16; ++i) acc[i] = 0.f;
    const float* krow = keys + (((size_t)h * 2 + c) * 128 + n) * 128;
    for (int d4 = 0; d4 < 32; ++d4) {
        const float4 kv = *(const float4*)(krow + d4 * 4);
#pragma unroll
        for (int tk = 0; tk < 16; ++tk) {
            const float4 qv = *(const float4*)&sq[th * 16 + tk][c * 128 + d4 * 4];
            acc[tk] += qv.x * kv.x + qv.y * kv.y + qv.z * kv.z + qv.w * kv.w;
        }
    }
#pragma unroll
    for (int tk = 0; tk < 16; ++tk) ss[th * 16 + tk][cn] = acc[tk];
    __syncthreads();
    if (tid < 64) {
        const int tk = tid >> 1, cc = tid & 1;
        float tv[16]; int ti[16];
#pragma unroll
        for (int j = 0; j < 16; ++j) { tv[j] = -INFINITY; ti[j] = 0; }
        for (int nn = 0; nn < 128; ++nn) {
            float x = ss[tk][cc * 128 + nn]; int xi = nn;
#pragma unroll
            for (int j = 0; j < 16; ++j) {
                const bool gt = x > tv[j];
                const float tf = tv[j]; const int tj = ti[j];
                tv[j] = gt ? x : tf; ti[j] = gt ? xi : tj;
                x = gt ? tf : x; xi = gt ? tj : xi;
            }
        }
#pragma unroll
        for (int j = 0; j < 16; ++j) { tvs[tk][cc][j] = tv[j]; tis[tk][cc][j] = ti[j]; }
    }
    __syncthreads();
    if (tid < 32) {
        const int tk = tid;
        float bv[16]; int bi[16];
#pragma unroll
        for (int j = 0; j < 16; ++j) { bv[j] = -INFINITY; bi[j] = 0; }
        for (int i = 0; i < 16; ++i)
            for (int jj = 0; jj < 16; ++jj) {
                float x = tvs[tk][0][i] + tvs[tk][1][jj]; int xi = tis[tk][0][i] * 128 + tis[tk][1][jj];
#pragma unroll
                for (int j = 0; j < 16; ++j) {
                    const bool gt = x > bv[j];
                    const float tf = bv[j]; const int tj = bi[j];
                    bv[j] = gt ? x : tf; bi[j] = gt ? xi : tj;
                    x = gt ? tf : x; xi = gt ? tj : xi;
                }
            }
        float e[16], sum = 0.f;
#pragma unroll
        for (int j = 0; j < 16; ++j) { e[j] = expf(bv[j] - bv[0]); sum += e[j]; }
        const float inv = 1.0f / sum;
        const size_t o = (size_t)(tg * 32 + tk) * 128 + h * 16;
#pragma unroll
        for (int j = 0; j < 16; ++j) { EXP[o + j] = bi[j]; GATE[o + j] = e[j] * inv; }
    }
}

__device__ __forceinline__ void peer_expert(const float* __restrict__ X, const int* __restrict__ EXP, const float* __restrict__ GATE,
                                            const float* __restrict__ U, const float* __restrict__ V,
                                            const float* __restrict__ g, const float* __restrict__ bta, float* __restrict__ out, bf16* __restrict__ outb, int t, float* smem) {
    const int tid = threadIdx.x, lane = tid & 63, wid = tid >> 6;
    float (*accs)[1024] = (float (*)[1024])smem;
    float* sred = smem + 8192;
    const float4* xr = (const float4*)(X + (size_t)t * D);
    float4 xv[4];
#pragma unroll
    for (int j = 0; j < 4; ++j) xv[j] = xr[lane + 64 * j];
    float4 acc[4];
#pragma unroll
    for (int j = 0; j < 4; ++j) acc[j] = make_float4(0.f, 0.f, 0.f, 0.f);
    for (int e = 0; e < 16; ++e) {
        const int id = EXP[(size_t)t * 128 + wid * 16 + e];
        const float gt = GATE[(size_t)t * 128 + wid * 16 + e];
        const float4* ur = (const float4*)(U + (size_t)id * D);
        const float4* vr = (const float4*)(V + (size_t)id * D);
        float4 uv[4], vv[4];
#pragma unroll
        for (int j = 0; j < 4; ++j) { uv[j] = ur[lane + 64 * j]; vv[j] = vr[lane + 64 * j]; }
        float dot = 0.f;
#pragma unroll
        for (int j = 0; j < 4; ++j) dot += uv[j].x * xv[j].x + uv[j].y * xv[j].y + uv[j].z * xv[j].z + uv[j].w * xv[j].w;
        dot = wave_sum(dot);
        const float cf = gt * geluf_(dot);
#pragma unroll
        for (int j = 0; j < 4; ++j) { acc[j].x += cf * vv[j].x; acc[j].y += cf * vv[j].y; acc[j].z += cf * vv[j].z; acc[j].w += cf * vv[j].w; }
    }
#pragma unroll
    for (int j = 0; j < 4; ++j) *(float4*)&accs[wid][(lane + 64 * j) * 4] = acc[j];
    __syncthreads();
    float v[2];
#pragma unroll
    for (int i = 0; i < 2; ++i) {
        const int c = tid * 2 + i;
        float s = 0.f;
#pragma unroll
        for (int w = 0; w < 8; ++w) s += accs[w][c];
        v[i] = ALPHA * X[(size_t)t * D + c] + s;
    }
    float s = wave_sum(v[0] + v[1]);
    if (lane == 0) sred[wid] = s;
    __syncthreads();
    float mean = 0.f;
#pragma unroll
    for (int w = 0; w < 8; ++w) mean += sred[w];
    mean *= (1.0f / 1024.0f);
    __syncthreads();
    const float d0 = v[0] - mean, d1 = v[1] - mean;
    float q = wave_sum(d0 * d0 + d1 * d1);
    if (lane == 0) sred[wid] = q;
    __syncthreads();
    float var = 0.f;
#pragma unroll
    for (int w = 0; w < 8; ++w) var += sred[w];
    const float rs = rsqrtf(var * (1.0f / 1024.0f) + LN_EPS);
    const float o0 = d0 * rs * g[tid * 2] + bta[tid * 2], o1 = d1 * rs * g[tid * 2 + 1] + bta[tid * 2 + 1];
    *(float2*)(out + (size_t)t * D + tid * 2) = make_float2(o0, o1);
    if (outb) *(unsigned*)(outb + (size_t)t * D + tid * 2) = pk2(o0, o1);
}


typedef __bf16 bf16x2_t __attribute__((ext_vector_type(2)));
__device__ __forceinline__ float dot2bf(unsigned w, unsigned x, float acc) { return __builtin_amdgcn_fdot2_f32_bf16(__builtin_bit_cast(bf16x2_t, w), __builtin_bit_cast(bf16x2_t, x), acc, false); }
typedef float f32x2_t __attribute__((ext_vector_type(2)));
__device__ __forceinline__ void row_to_fp8(const float* __restrict__ xrow, unsigned char* __restrict__ orow, float* __restrict__ scale, int lane) {
    f32x4 v[4]; float am = 0.f;
#pragma unroll
    for (int j = 0; j < 4; ++j) { v[j] = *(const f32x4*)(xrow + lane * 16 + j * 4); am = fmaxf(am, fmaxf(fmaxf(fabsf(v[j].x), fabsf(v[j].y)), fmaxf(fabsf(v[j].z), fabsf(v[j].w)))); }
    am = wave_max(am);
    const float s = am > 0.f ? am * (1.0f / 448.0f) : 1.0f, inv = 1.0f / s;
    v4u o;
    unsigned w;
    w = 0u; w = __builtin_amdgcn_cvt_pk_fp8_f32(v[0].x * inv, v[0].y * inv, w, false); w = __builtin_amdgcn_cvt_pk_fp8_f32(v[0].z * inv, v[0].w * inv, w, true); o.x = w;
    w = 0u; w = __builtin_amdgcn_cvt_pk_fp8_f32(v[1].x * inv, v[1].y * inv, w, false); w = __builtin_amdgcn_cvt_pk_fp8_f32(v[1].z * inv, v[1].w * inv, w, true); o.y = w;
    w = 0u; w = __builtin_amdgcn_cvt_pk_fp8_f32(v[2].x * inv, v[2].y * inv, w, false); w = __builtin_amdgcn_cvt_pk_fp8_f32(v[2].z * inv, v[2].w * inv, w, true); o.z = w;
    w = 0u; w = __builtin_amdgcn_cvt_pk_fp8_f32(v[3].x * inv, v[3].y * inv, w, false); w = __builtin_amdgcn_cvt_pk_fp8_f32(v[3].z * inv, v[3].w * inv, w, true); o.w = w;
    *(v4u*)(orow + lane * 16) = o;
    if (lane == 0) *scale = s;
}
#define PE_LOAD(UB, VB, grp) do { _Pragma("unroll") for (int i_ = 0; i_ < 4; ++i_) { const int e_ = (grp) * 4 + i_; \
        const int id_ = __builtin_amdgcn_readlane(e_ < 64 ? id0 : id1, e_ & 63); \
        const unsigned so_ = (unsigned)id_ * 1024u; \
        UB[i_] = __builtin_amdgcn_raw_buffer_load_b128(ursrc, voff, so_, 0); VB[i_] = __builtin_amdgcn_raw_buffer_load_b128(vrsrc, voff, so_, 0); } } while (0)
#define PE_DOT4(w, k) do { const f32x2_t l_ = __builtin_amdgcn_cvt_pk_f32_fp8((w), false), h_ = __builtin_amdgcn_cvt_pk_f32_fp8((w), true); \
        a_ += l_.x * xv[(k) * 4 + 0]; b_ += l_.y * xv[(k) * 4 + 1]; a_ += h_.x * xv[(k) * 4 + 2]; b_ += h_.y * xv[(k) * 4 + 3]; } while (0)
#define PE_AXPY4(w, k) do { const f32x2_t l_ = __builtin_amdgcn_cvt_pk_f32_fp8((w), false), h_ = __builtin_amdgcn_cvt_pk_f32_fp8((w), true); \
        acc[(k) * 4 + 0] += cf_ * l_.x; acc[(k) * 4 + 1] += cf_ * l_.y; acc[(k) * 4 + 2] += cf_ * h_.x; acc[(k) * 4 + 3] += cf_ * h_.y; } while (0)
#define PE_COMP(UB, VB, grp) do { float d_[4]; \
        _Pragma("unroll") for (int i_ = 0; i_ < 4; ++i_) { float a_ = 0.f, b_ = 0.f; PE_DOT4(UB[i_].x, 0); PE_DOT4(UB[i_].y, 1); PE_DOT4(UB[i_].z, 2); PE_DOT4(UB[i_].w, 3); d_[i_] = a_ + b_; } \
          \
        float s0_ = hi32 ? d_[2] : d_[0], t0_ = hi32 ? d_[0] : d_[2]; s0_ += __shfl_xor(t0_, 32); \
        float s1_ = hi32 ? d_[3] : d_[1], t1_ = hi32 ? d_[1] : d_[3]; s1_ += __shfl_xor(t1_, 32); \
        float r_ = hi16 ? s1_ : s0_, t2_ = hi16 ? s0_ : s1_; r_ += __shfl_xor(t2_, 16); \
        r_ += __shfl_xor(r_, 8); r_ += __shfl_xor(r_, 4); r_ += __shfl_xor(r_, 2); r_ += __shfl_xor(r_, 1); \
          \
        const int esel_ = (grp) * 4 + (lane >> 4); \
        const float su_ = __shfl(esel_ < 64 ? su0 : su1, esel_ & 63), gv_ = __shfl(esel_ < 64 ? gs0 : gs1, esel_ & 63); \
        const float cfl_ = geluf_(r_ * su_) * gv_; \
        _Pragma("unroll") for (int i_ = 0; i_ < 4; ++i_) { \
            const float cf_ = __uint_as_float(__builtin_amdgcn_readlane(__float_as_uint(cfl_), 16 * i_)); \
            PE_AXPY4(VB[i_].x, 0); PE_AXPY4(VB[i_].y, 1); PE_AXPY4(VB[i_].z, 2); PE_AXPY4(VB[i_].w, 3); } } while (0)
__device__ __forceinline__ void peer_expert_w(const float* __restrict__ xrow, const int* __restrict__ exr, const float* __restrict__ gar,
                                              const unsigned char* __restrict__ U, const unsigned char* __restrict__ V, const float* __restrict__ SU, const float* __restrict__ SV,
                                              const float* __restrict__ g, const float* __restrict__ bta, float* __restrict__ orow, bf16* __restrict__ obrow, int lane) {
    const bool hi32 = (lane & 32) != 0, hi16 = (lane & 16) != 0;
    const __amdgpu_buffer_rsrc_t ursrc = __builtin_amdgcn_make_buffer_rsrc((void*)U, 0, 16384 * 1024, 0x00020000);
    const __amdgpu_buffer_rsrc_t vrsrc = __builtin_amdgcn_make_buffer_rsrc((void*)V, 0, 16384 * 1024, 0x00020000);
    const int voff = lane * 16;
    float xv[16];
#pragma unroll
    for (int j = 0; j < 4; ++j) { const f32x4 t = *(const f32x4*)(xrow + lane * 16 + j * 4); xv[j * 4 + 0] = t.x; xv[j * 4 + 1] = t.y; xv[j * 4 + 2] = t.z; xv[j * 4 + 3] = t.w; }
    const int id0 = exr[lane], id1 = exr[64 + lane];
    const float su0 = SU[id0], su1 = SU[id1];
    const float gs0 = gar[lane] * SV[id0], gs1 = gar[64 + lane] * SV[id1];
    float acc[16];
#pragma unroll
    for (int i = 0; i < 16; ++i) acc[i] = 0.f;
    v4u ua[4], va[4], ub[4], vb[4];
    PE_LOAD(ua, va, 0);
#pragma unroll 1
    for (int grp = 0; grp < 32; grp += 2) {
        PE_LOAD(ub, vb, grp + 1);
        PE_COMP(ua, va, grp);
        if (grp + 2 < 32) PE_LOAD(ua, va, grp + 2);
        PE_COMP(ub, vb, grp + 1);
    }
    float v[16]; float s = 0.f;
#pragma unroll
    for (int i = 0; i < 16; ++i) { v[i] = ALPHA * xv[i] + acc[i]; s += v[i]; }
    const float mean = wave_sum(s) * (1.0f / 1024.0f); float q = 0.f;
#pragma unroll
    for (int i = 0; i < 16; ++i) { v[i] -= mean; q += v[i] * v[i]; }
    const float rs = rsqrtf(wave_sum(q) * (1.0f / 1024.0f) + LN_EPS);
    float o[16];
#pragma unroll
    for (int j = 0; j < 4; ++j) {
        const f32x4 g4 = *(const f32x4*)(g + lane * 16 + j * 4), b4 = *(const f32x4*)(bta + lane * 16 + j * 4);
        o[j * 4 + 0] = v[j * 4 + 0] * rs * g4.x + b4.x; o[j * 4 + 1] = v[j * 4 + 1] * rs * g4.y + b4.y; o[j * 4 + 2] = v[j * 4 + 2] * rs * g4.z + b4.z; o[j * 4 + 3] = v[j * 4 + 3] * rs * g4.w + b4.w;
        *(f32x4*)(orow + lane * 16 + j * 4) = (f32x4){o[j * 4 + 0], o[j * 4 + 1], o[j * 4 + 2], o[j * 4 + 3]};
    }
    if (obrow) {
        v4u w0, w1; w0.x = pk2(o[0], o[1]); w0.y = pk2(o[2], o[3]); w0.z = pk2(o[4], o[5]); w0.w = pk2(o[6], o[7]); w1.x = pk2(o[8], o[9]); w1.y = pk2(o[10], o[11]); w1.z = pk2(o[12], o[13]); w1.w = pk2(o[14], o[15]);
        *(v4u*)(obrow + lane * 16) = w0; *(v4u*)(obrow + lane * 16 + 8) = w1;
    }
}


__device__ __forceinline__ void peer_expert_blk(const float* __restrict__ xrow, const int* __restrict__ exr, const float* __restrict__ gar,
                                                const unsigned char* __restrict__ U, const unsigned char* __restrict__ V, const float* __restrict__ SU, const float* __restrict__ SV,
                                                const float* __restrict__ g, const float* __restrict__ bta, float* __restrict__ orow, bf16* __restrict__ obrow, int lane, int wave, float* smem) {
    const bool hi32 = (lane & 32) != 0, hi16 = (lane & 16) != 0;
    const __amdgpu_buffer_rsrc_t ursrc = __builtin_amdgcn_make_buffer_rsrc((void*)U, 0, 16384 * 1024, 0x00020000);
    const __amdgpu_buffer_rsrc_t vrsrc = __builtin_amdgcn_make_buffer_rsrc((void*)V, 0, 16384 * 1024, 0x00020000);
    const int voff = lane * 16;
    float xv[16];
#pragma unroll
    for (int j = 0; j < 4; ++j) { const f32x4 t = *(const f32x4*)(xrow + lane * 16 + j * 4); xv[j * 4 + 0] = t.x; xv[j * 4 + 1] = t.y; xv[j * 4 + 2] = t.z; xv[j * 4 + 3] = t.w; }
    const int id0 = exr[lane], id1 = exr[64 + lane];
    const float su0 = SU[id0], su1 = SU[id1];
    const float gs0 = gar[lane] * SV[id0], gs1 = gar[64 + lane] * SV[id1];
    float acc[16];
#pragma unroll
    for (int i = 0; i < 16; ++i) acc[i] = 0.f;
    v4u ua[4], va[4], ub[4], vb[4];
    const int g0 = wave * 4;
    PE_LOAD(ua, va, g0); PE_LOAD(ub, vb, g0 + 1);
    PE_COMP(ua, va, g0); PE_LOAD(ua, va, g0 + 2);
    PE_COMP(ub, vb, g0 + 1); PE_LOAD(ub, vb, g0 + 3);
    PE_COMP(ua, va, g0 + 2);
    PE_COMP(ub, vb, g0 + 3);
    float* accs = smem;
    float* sred = smem + 8192;
#pragma unroll
    for (int j = 0; j < 4; ++j) *(f32x4*)(accs + wave * 1024 + lane * 16 + j * 4) = (f32x4){acc[j * 4 + 0], acc[j * 4 + 1], acc[j * 4 + 2], acc[j * 4 + 3]};
    __syncthreads();
    const int tid = wave * 64 + lane;
    float v0 = ALPHA * xrow[tid * 2], v1 = ALPHA * xrow[tid * 2 + 1];
#pragma unroll
    for (int w = 0; w < 8; ++w) { v0 += accs[w * 1024 + tid * 2]; v1 += accs[w * 1024 + tid * 2 + 1]; }
    const float s = wave_sum(v0 + v1);
    if (lane == 0) sred[wave] = s;
    __syncthreads();
    float mean = 0.f;
#pragma unroll
    for (int w = 0; w < 8; ++w) mean += sred[w];
    mean *= (1.0f / 1024.0f);
    __syncthreads();
    const float d0 = v0 - mean, d1 = v1 - mean;
    const float q = wave_sum(d0 * d0 + d1 * d1);
    if (lane == 0) sred[wave] = q;
    __syncthreads();
    float var = 0.f;
#pragma unroll
    for (int w = 0; w < 8; ++w) var += sred[w];
    const float rs = rsqrtf(var * (1.0f / 1024.0f) + LN_EPS);
    const float o0 = d0 * rs * g[tid * 2] + bta[tid * 2], o1 = d1 * rs * g[tid * 2 + 1] + bta[tid * 2 + 1];
    *(float2*)(orow + tid * 2) = make_float2(o0, o1);
    if (obrow) *(unsigned*)(obrow + tid * 2) = pk2(o0, o1);
    __syncthreads();
}

__device__ __forceinline__ void row_to_fp8_sliced(const float* __restrict__ xrow, unsigned char* __restrict__ tab, int r, float* __restrict__ scale, int lane) {
    f32x4 v[4]; float am = 0.f;
#pragma unroll
    for (int j = 0; j < 4; ++j) { v[j] = *(const f32x4*)(xrow + lane * 16 + j * 4); am = fmaxf(am, fmaxf(fmaxf(fabsf(v[j].x), fabsf(v[j].y)), fmaxf(fabsf(v[j].z), fabsf(v[j].w)))); }
    am = wave_max(am);
    const float s = am > 0.f ? am * (1.0f / 448.0f) : 1.0f, inv = 1.0f / s;
    v4u o; unsigned w;
    w = 0u; w = __builtin_amdgcn_cvt_pk_fp8_f32(v[0].x * inv, v[0].y * inv, w, false); w = __builtin_amdgcn_cvt_pk_fp8_f32(v[0].z * inv, v[0].w * inv, w, true); o.x = w;
    w = 0u; w = __builtin_amdgcn_cvt_pk_fp8_f32(v[1].x * inv, v[1].y * inv, w, false); w = __builtin_amdgcn_cvt_pk_fp8_f32(v[1].z * inv, v[1].w * inv, w, true); o.y = w;
    w = 0u; w = __builtin_amdgcn_cvt_pk_fp8_f32(v[2].x * inv, v[2].y * inv, w, false); w = __builtin_amdgcn_cvt_pk_fp8_f32(v[2].z * inv, v[2].w * inv, w, true); o.z = w;
    w = 0u; w = __builtin_amdgcn_cvt_pk_fp8_f32(v[3].x * inv, v[3].y * inv, w, false); w = __builtin_amdgcn_cvt_pk_fp8_f32(v[3].z * inv, v[3].w * inv, w, true); o.w = w;
    *(v4u*)(tab + ((size_t)(lane >> 3) * 16384 + r) * 128 + (lane & 7) * 16) = o;
    if (lane == 0) *scale = s;
}
__device__ __forceinline__ void row_to_i8_sliced(const float* __restrict__ xrow, unsigned char* __restrict__ tab, int r, float* __restrict__ scale, int lane) {
    f32x4 v[4]; float am = 0.f;
#pragma unroll
    for (int j = 0; j < 4; ++j) { v[j] = *(const f32x4*)(xrow + lane * 16 + j * 4); am = fmaxf(am, fmaxf(fmaxf(fabsf(v[j].x), fabsf(v[j].y)), fmaxf(fabsf(v[j].z), fabsf(v[j].w)))); }
    am = wave_max(am);
    const float s = am > 0.f ? am * (1.0f / 127.0f) : 1.0f, inv = 1.0f / s;
    v4u o;
#define I8PK(q_) (((unsigned)(int)rintf((q_).x * inv) & 0xffu) | (((unsigned)(int)rintf((q_).y * inv) & 0xffu) << 8) | (((unsigned)(int)rintf((q_).z * inv) & 0xffu) << 16) | (((unsigned)(int)rintf((q_).w * inv) & 0xffu) << 24))
    o.x = I8PK(v[0]); o.y = I8PK(v[1]); o.z = I8PK(v[2]); o.w = I8PK(v[3]);
    *(v4u*)(tab + ((size_t)(lane >> 3) * 16384 + r) * 128 + (lane & 7) * 16) = o;
    if (lane == 0) *scale = s;
}

template <bool FP8>
__device__ __forceinline__ void table_rows_convert(const float* __restrict__ src, unsigned char* __restrict__ tab, float* __restrict__ scales, int rbeg, int rend, int gw, int ngw, int lane) {
    for (int r0 = rbeg + gw; r0 < rend; r0 += 4 * ngw) {
        f32x4 v[4][4]; int rr[4]; float am[4];
#pragma unroll
        for (int i = 0; i < 4; ++i) { rr[i] = r0 + i * ngw < rend ? r0 + i * ngw : rend - 1;
#pragma unroll
            for (int j = 0; j < 4; ++j) v[i][j] = *(const f32x4*)(src + (size_t)rr[i] * D + j * 256 + lane * 4); }
#pragma unroll
        for (int i = 0; i < 4; ++i) { float a = 0.f;
#pragma unroll
            for (int j = 0; j < 4; ++j) a = fmaxf(a, fmaxf(fmaxf(fabsf(v[i][j].x), fabsf(v[i][j].y)), fmaxf(fabsf(v[i][j].z), fabsf(v[i][j].w))));
            am[i] = a; }
#pragma unroll
        for (int i = 0; i < 4; ++i) am[i] = wave_max(am[i]);
#pragma unroll
        for (int i = 0; i < 4; ++i) {
            const float s = am[i] > 0.f ? am[i] * (FP8 ? 1.0f / 448.0f : 1.0f / 127.0f) : 1.0f, inv = 1.0f / s;
#pragma unroll
            for (int j = 0; j < 4; ++j) {
                unsigned w;
                if (FP8) { w = 0u; w = __builtin_amdgcn_cvt_pk_fp8_f32(v[i][j].x * inv, v[i][j].y * inv, w, false); w = __builtin_amdgcn_cvt_pk_fp8_f32(v[i][j].z * inv, v[i][j].w * inv, w, true); }
                else w = ((unsigned)(int)rintf(v[i][j].x * inv) & 0xffu) | (((unsigned)(int)rintf(v[i][j].y * inv) & 0xffu) << 8) | (((unsigned)(int)rintf(v[i][j].z * inv) & 0xffu) << 16) | (((unsigned)(int)rintf(v[i][j].w * inv) & 0xffu) << 24);
                *(unsigned*)(tab + ((size_t)(2 * j + (lane >> 5)) * 16384 + rr[i]) * 128 + (lane & 31) * 4) = w;
            }
            if (lane == 0) scales[rr[i]] = s;
        }
    }
}
__device__ __forceinline__ void peer_u_pass(const bf16* __restrict__ xrow, const int* __restrict__ exr, const unsigned char* __restrict__ U8x, float* __restrict__ pd, int x, int lane) {
    const int e8 = lane >> 3, c = lane & 7;
    f32x2_t xp[8];
#pragma unroll
    for (int j = 0; j < 2; ++j) { const v4u t = *(const v4u*)(xrow + x * 128 + c * 16 + j * 8);
        xp[j * 4 + 0] = (f32x2_t){bflo(t.x), bfhi(t.x)}; xp[j * 4 + 1] = (f32x2_t){bflo(t.y), bfhi(t.y)}; xp[j * 4 + 2] = (f32x2_t){bflo(t.z), bfhi(t.z)}; xp[j * 4 + 3] = (f32x2_t){bflo(t.w), bfhi(t.w)}; }
    const __amdgpu_buffer_rsrc_t ursrc = __builtin_amdgcn_make_buffer_rsrc((void*)U8x, 0, 16384 * 128, 0x00020000);
    v4u wa[8], wb[8];
    float d[16];
    int ids[16];
#pragma unroll
    for (int j = 0; j < 4; ++j) { const v4u t = *(const v4u*)(exr + e8 * 16 + j * 4); ids[j * 4 + 0] = (int)t.x; ids[j * 4 + 1] = (int)t.y; ids[j * 4 + 2] = (int)t.z; ids[j * 4 + 3] = (int)t.w; }
#pragma unroll
    for (int g = 0; g < 8; ++g) wa[g] = __builtin_amdgcn_raw_buffer_load_b128(ursrc, ids[g] * 128 + c * 16, 0, 0);
#pragma unroll
    for (int g = 0; g < 8; ++g) wb[g] = __builtin_amdgcn_raw_buffer_load_b128(ursrc, ids[8 + g] * 128 + c * 16, 0, 0);
#define PU_DOT1(w_, k_) do { a_ = __builtin_elementwise_fma(__builtin_amdgcn_cvt_pk_f32_fp8((w_), false), xp[(k_) * 2], a_); a_ = __builtin_elementwise_fma(__builtin_amdgcn_cvt_pk_f32_fp8((w_), true), xp[(k_) * 2 + 1], a_); } while (0)
#pragma unroll
    for (int g = 0; g < 8; ++g) { f32x2_t a_ = (f32x2_t){0.f, 0.f}; PU_DOT1(wa[g].x, 0); PU_DOT1(wa[g].y, 1); PU_DOT1(wa[g].z, 2); PU_DOT1(wa[g].w, 3); d[g] = a_.x + a_.y; }
#pragma unroll
    for (int g = 0; g < 8; ++g) { f32x2_t a_ = (f32x2_t){0.f, 0.f}; PU_DOT1(wb[g].x, 0); PU_DOT1(wb[g].y, 1); PU_DOT1(wb[g].z, 2); PU_DOT1(wb[g].w, 3); d[8 + g] = a_.x + a_.y; }
#pragma unroll
    for (int g = 0; g < 16; ++g) { d[g] += DPPF(d[g], 0xB1, 0xf); d[g] += DPPF(d[g], 0x4E, 0xf); d[g] += DPPF(d[g], 0x141, 0xf); }
    if (c == 0) {
#pragma unroll
        for (int j = 0; j < 4; ++j) *(f32x4*)(pd + e8 * 16 + j * 4) = (f32x4){d[j * 4 + 0], d[j * 4 + 1], d[j * 4 + 2], d[j * 4 + 3]};
    }
}
#define PUL_IDS(I, k_) do { const int t_ = ((tg0 + ((k_) < nit ? (k_) : nit - 1) * tgstep) * 8 + wave); _Pragma("unroll") for (int j = 0; j < 4; ++j) I[j] = *(const v4u*)(EXPp + (size_t)t_ * 128 + e8 * 16 + j * 4); } while (0)
#define PUL_ROWS(R, X, I, k_) do { const int t_ = ((tg0 + ((k_) < nit ? (k_) : nit - 1) * tgstep) * 8 + wave); \
        X[0] = *(const v4u*)(XBp + (size_t)t_ * D + x * 128 + c * 16); X[1] = *(const v4u*)(XBp + (size_t)t_ * D + x * 128 + c * 16 + 8); \
        _Pragma("unroll") for (int j = 0; j < 4; ++j) { R[j * 4 + 0] = __builtin_amdgcn_raw_buffer_load_b128(ursrc, (int)I[j].x * 128 + c * 16, 0, 0); R[j * 4 + 1] = __builtin_amdgcn_raw_buffer_load_b128(ursrc, (int)I[j].y * 128 + c * 16, 0, 0); \
            R[j * 4 + 2] = __builtin_amdgcn_raw_buffer_load_b128(ursrc, (int)I[j].z * 128 + c * 16, 0, 0); R[j * 4 + 3] = __builtin_amdgcn_raw_buffer_load_b128(ursrc, (int)I[j].w * 128 + c * 16, 0, 0); } } while (0)
#define PUL_COMP(R, X, k_) do { float xf_[16]; \
        _Pragma("unroll") for (int j = 0; j < 2; ++j) { xf_[j * 8 + 0] = bflo(X[j].x); xf_[j * 8 + 1] = bfhi(X[j].x); xf_[j * 8 + 2] = bflo(X[j].y); xf_[j * 8 + 3] = bfhi(X[j].y); xf_[j * 8 + 4] = bflo(X[j].z); xf_[j * 8 + 5] = bfhi(X[j].z); xf_[j * 8 + 6] = bflo(X[j].w); xf_[j * 8 + 7] = bfhi(X[j].w); } \
          \
        float am_ = 0.f; _Pragma("unroll") for (int i = 0; i < 16; ++i) am_ = fmaxf(am_, fabsf(xf_[i])); \
        am_ = fmaxf(am_, DPPF(am_, 0xB1, 0xf)); am_ = fmaxf(am_, DPPF(am_, 0x4E, 0xf)); am_ = fmaxf(am_, DPPF(am_, 0x141, 0xf)); \
        const float sx_ = am_ > 0.f ? am_ * (1.0f / 127.0f) : 1.0f, ix_ = 1.0f / sx_; \
        int xq_[4]; \
        _Pragma("unroll") for (int j = 0; j < 4; ++j) xq_[j] = (int)(((unsigned)(int)rintf(xf_[j * 4 + 0] * ix_) & 0xffu) | (((unsigned)(int)rintf(xf_[j * 4 + 1] * ix_) & 0xffu) << 8) | (((unsigned)(int)rintf(xf_[j * 4 + 2] * ix_) & 0xffu) << 16) | (((unsigned)(int)rintf(xf_[j * 4 + 3] * ix_) & 0xffu) << 24)); \
        float d[16]; \
        _Pragma("unroll") for (int g = 0; g < 16; ++g) { int a_ = __builtin_amdgcn_sdot4((int)R[g].x, xq_[0], 0, false); a_ = __builtin_amdgcn_sdot4((int)R[g].y, xq_[1], a_, false); a_ = __builtin_amdgcn_sdot4((int)R[g].z, xq_[2], a_, false); a_ = __builtin_amdgcn_sdot4((int)R[g].w, xq_[3], a_, false); d[g] = (float)a_; } \
        _Pragma("unroll") for (int g = 0; g < 16; ++g) { d[g] += DPPF(d[g], 0xB1, 0xf); d[g] += DPPF(d[g], 0x4E, 0xf); d[g] += DPPF(d[g], 0x141, 0xf); d[g] *= sx_; } \
        if (c == 0 && (k_) < nit) { float* pd_ = PDx + (size_t)((tg0 + (k_) * tgstep) * 8 + wave) * 128 + e8 * 16; \
            _Pragma("unroll") for (int j = 0; j < 4; ++j) *(f32x4*)(pd_ + j * 4) = (f32x4){d[j * 4 + 0], d[j * 4 + 1], d[j * 4 + 2], d[j * 4 + 3]}; } } while (0)
__device__ __forceinline__ void peer_u_loop(const bf16* __restrict__ XBp, const int* __restrict__ EXPp, const unsigned char* __restrict__ U8x, float* __restrict__ PDx, int x, int tg0, int tgstep, int nit, int wave, int lane) {
    const int e8 = lane >> 3, c = lane & 7;
    const __amdgpu_buffer_rsrc_t ursrc = __builtin_amdgcn_make_buffer_rsrc((void*)U8x, 0, 16384 * 128, 0x00020000);
    v4u ra[16], rb[16], xa[2], xb[2], i0[4], i1[4];
    PUL_IDS(i0, 0);
    PUL_ROWS(ra, xa, i0, 0);
    PUL_IDS(i1, 1);
#pragma unroll 1
    for (int k = 0; k < nit; k += 2) {
        PUL_ROWS(rb, xb, i1, k + 1);
        PUL_IDS(i0, k + 2);
        PUL_COMP(ra, xa, k);
        PUL_ROWS(ra, xa, i0, k + 2);
        PUL_IDS(i1, k + 3);
        PUL_COMP(rb, xb, k + 1);
    }
}
#define PV_LOAD(VB, grp) do { _Pragma("unroll") for (int i_ = 0; i_ < 4; ++i_) { const int e_ = (grp) * 4 + i_; \
        const int id_ = __builtin_amdgcn_readlane(e_ < 64 ? id0 : id1, e_ & 63); \
        VB[i_] = __builtin_amdgcn_raw_buffer_load_b128(vrsrc, voff, (unsigned)id_ * 1024u, 0); } } while (0)
#define PV_COMP(VB, grp) do { _Pragma("unroll") for (int i_ = 0; i_ < 4; ++i_) { const int e_ = (grp) * 4 + i_; \
        const float cf_ = __uint_as_float(__builtin_amdgcn_readlane(__float_as_uint(e_ < 64 ? cf0 : cf1), e_ & 63)); \
        PE_AXPY4(VB[i_].x, 0); PE_AXPY4(VB[i_].y, 1); PE_AXPY4(VB[i_].z, 2); PE_AXPY4(VB[i_].w, 3); } } while (0)
#define PV_COEFS() \
    const int id0 = exr[lane], id1 = exr[64 + lane]; \
    float dot0 = 0.f, dot1 = 0.f; \
    { const int p0 = lane, p1 = 64 + lane;        \
      _Pragma("unroll") for (int x_ = 0; x_ < 8; ++x_) { dot0 += pdt[(size_t)x_ * NT * 128 + p0]; dot1 += pdt[(size_t)x_ * NT * 128 + p1]; } } \
    const float cf0 = gar[lane] * SV[id0] * geluf_(SU[id0] * dot0), cf1 = gar[64 + lane] * SV[id1] * geluf_(SU[id1] * dot1);
__device__ __forceinline__ void peer_v_w(const float* __restrict__ xrow, const int* __restrict__ exr, const float* __restrict__ gar, const float* __restrict__ pdt,
                                         const unsigned char* __restrict__ V, const float* __restrict__ SU, const float* __restrict__ SV,
                                         const float* __restrict__ g, const float* __restrict__ bta, float* __restrict__ orow, bf16* __restrict__ obrow, int lane) {
    const __amdgpu_buffer_rsrc_t vrsrc = __builtin_amdgcn_make_buffer_rsrc((void*)V, 0, 16384 * 1024, 0x00020000);
    const int voff = lane * 16;
    PV_COEFS()
    float acc[16];
#pragma unroll
    for (int i = 0; i < 16; ++i) acc[i] = 0.f;
    v4u va[4], vb[4], vc[4];
    PV_LOAD(va, 0); PV_LOAD(vb, 1);
#pragma unroll 1
    for (int grp = 0; grp < 30; grp += 3) {
        PV_LOAD(vc, grp + 2);
        PV_COMP(va, grp);
        PV_LOAD(va, grp + 3);
        PV_COMP(vb, grp + 1);
        PV_LOAD(vb, grp + 4);
        PV_COMP(vc, grp + 2);
    }
    PV_COMP(va, 30); PV_COMP(vb, 31);
    float xv[16];
#pragma unroll
    for (int j = 0; j < 4; ++j) { const f32x4 t = *(const f32x4*)(xrow + lane * 16 + j * 4); xv[j * 4 + 0] = t.x; xv[j * 4 + 1] = t.y; xv[j * 4 + 2] = t.z; xv[j * 4 + 3] = t.w; }
    float v[16]; float s = 0.f;
#pragma unroll
    for (int i = 0; i < 16; ++i) { v[i] = ALPHA * xv[i] + acc[i]; s += v[i]; }
    const float mean = wave_sum(s) * (1.0f / 1024.0f); float q = 0.f;
#pragma unroll
    for (int i = 0; i < 16; ++i) { v[i] -= mean; q += v[i] * v[i]; }
    const float rs = rsqrtf(wave_sum(q) * (1.0f / 1024.0f) + LN_EPS);
    float o[16];
#pragma unroll
    for (int j = 0; j < 4; ++j) {
        const f32x4 g4 = *(const f32x4*)(g + lane * 16 + j * 4), b4 = *(const f32x4*)(bta + lane * 16 + j * 4);
        o[j * 4 + 0] = v[j * 4 + 0] * rs * g4.x + b4.x; o[j * 4 + 1] = v[j * 4 + 1] * rs * g4.y + b4.y; o[j * 4 + 2] = v[j * 4 + 2] * rs * g4.z + b4.z; o[j * 4 + 3] = v[j * 4 + 3] * rs * g4.w + b4.w;
        *(f32x4*)(orow + lane * 16 + j * 4) = (f32x4){o[j * 4 + 0], o[j * 4 + 1], o[j * 4 + 2], o[j * 4 + 3]};
    }
    if (obrow) {
        v4u w0, w1; w0.x = pk2(o[0], o[1]); w0.y = pk2(o[2], o[3]); w0.z = pk2(o[4], o[5]); w0.w = pk2(o[6], o[7]); w1.x = pk2(o[8], o[9]); w1.y = pk2(o[10], o[11]); w1.z = pk2(o[12], o[13]); w1.w = pk2(o[14], o[15]);
        *(v4u*)(obrow + lane * 16) = w0; *(v4u*)(obrow + lane * 16 + 8) = w1;
    }
}
__device__ __forceinline__ void peer_v_blk(const float* __restrict__ xrow, const int* __restrict__ exr, const float* __restrict__ gar, const float* __restrict__ pdt,
                                           const unsigned char* __restrict__ V, const float* __restrict__ SU, const float* __restrict__ SV,
                                           const float* __restrict__ g, const float* __restrict__ bta, float* __restrict__ orow, bf16* __restrict__ obrow, int lane, int wave, float* smem) {
    const __amdgpu_buffer_rsrc_t vrsrc = __builtin_amdgcn_make_buffer_rsrc((void*)V, 0, 16384 * 1024, 0x00020000);
    const int voff = lane * 16;
    PV_COEFS()
    float acc[16];
#pragma unroll
    for (int i = 0; i < 16; ++i) acc[i] = 0.f;
    v4u va[4], vb[4], vc[4], vd[4];
    PV_LOAD(va, wave * 4); PV_LOAD(vb, wave * 4 + 1); PV_LOAD(vc, wave * 4 + 2); PV_LOAD(vd, wave * 4 + 3);
    PV_COMP(va, wave * 4); PV_COMP(vb, wave * 4 + 1); PV_COMP(vc, wave * 4 + 2); PV_COMP(vd, wave * 4 + 3);
    float* accs = smem;
    float* sred = smem + 8192;
#pragma unroll
    for (int j = 0; j < 4; ++j) *(f32x4*)(accs + wave * 1024 + lane * 16 + j * 4) = (f32x4){acc[j * 4 + 0], acc[j * 4 + 1], acc[j * 4 + 2], acc[j * 4 + 3]};
    __syncthreads();
    const int tid = wave * 64 + lane;
    float v0 = ALPHA * xrow[tid * 2], v1 = ALPHA * xrow[tid * 2 + 1];
#pragma unroll
    for (int w = 0; w < 8; ++w) { v0 += accs[w * 1024 + tid * 2]; v1 += accs[w * 1024 + tid * 2 + 1]; }
    const float s = wave_sum(v0 + v1);
    if (lane == 0) sred[wave] = s;
    __syncthreads();
    float mean = 0.f;
#pragma unroll
    for (int w = 0; w < 8; ++w) mean += sred[w];
    mean *= (1.0f / 1024.0f);
    __syncthreads();
    const float d0 = v0 - mean, d1 = v1 - mean;
    const float q = wave_sum(d0 * d0 + d1 * d1);
    if (lane == 0) sred[wave] = q;
    __syncthreads();
    float var = 0.f;
#pragma unroll
    for (int w = 0; w < 8; ++w) var += sred[w];
    const float rs = rsqrtf(var * (1.0f / 1024.0f) + LN_EPS);
    const float o0 = d0 * rs * g[tid * 2] + bta[tid * 2], o1 = d1 * rs * g[tid * 2 + 1] + bta[tid * 2 + 1];
    *(float2*)(orow + tid * 2) = make_float2(o0, o1);
    if (obrow) *(unsigned*)(obrow + tid * 2) = pk2(o0, o1);
    __syncthreads();
}

__device__ __forceinline__ void peer_xk(const int* __restrict__ exr, float* __restrict__ gar, const float* __restrict__ pdt, const float* __restrict__ SU, const float* __restrict__ SV, int lane) {
    PV_COEFS()
    gar[lane] = cf0; gar[64 + lane] = cf1;
}
__device__ __forceinline__ void peer_v_slice(const int* __restrict__ exr, const float* __restrict__ cfr, const unsigned char* __restrict__ V8x, float* __restrict__ outs  , int lane) {
    const int e8 = lane >> 3, c = lane & 7;
    const __amdgpu_buffer_rsrc_t vrsrc = __builtin_amdgcn_make_buffer_rsrc((void*)V8x, 0, 16384 * 128, 0x00020000);
    v4u wa[8], wb[8]; float cfa[8], cfb[8];
    int ids[16];
#pragma unroll
    for (int j = 0; j < 4; ++j) { const v4u t = *(const v4u*)(exr + e8 * 16 + j * 4); ids[j * 4 + 0] = (int)t.x; ids[j * 4 + 1] = (int)t.y; ids[j * 4 + 2] = (int)t.z; ids[j * 4 + 3] = (int)t.w; }
#pragma unroll
    for (int g = 0; g < 8; ++g) wa[g] = __builtin_amdgcn_raw_buffer_load_b128(vrsrc, ids[g] * 128 + c * 16, 0, 0);
#pragma unroll
    for (int g = 0; g < 8; ++g) wb[g] = __builtin_amdgcn_raw_buffer_load_b128(vrsrc, ids[8 + g] * 128 + c * 16, 0, 0);
#pragma unroll
    for (int j = 0; j < 2; ++j) { const f32x4 t = *(const f32x4*)(cfr + e8 * 16 + j * 4), u = *(const f32x4*)(cfr + e8 * 16 + 8 + j * 4);
        cfa[j * 4 + 0] = t.x; cfa[j * 4 + 1] = t.y; cfa[j * 4 + 2] = t.z; cfa[j * 4 + 3] = t.w; cfb[j * 4 + 0] = u.x; cfb[j * 4 + 1] = u.y; cfb[j * 4 + 2] = u.z; cfb[j * 4 + 3] = u.w; }
    f32x2_t ap[8];
#pragma unroll
    for (int i = 0; i < 8; ++i) ap[i] = (f32x2_t){0.f, 0.f};
#define PVS_AXPY(w_, k_) do { ap[(k_) * 2] = __builtin_elementwise_fma(cf2_, __builtin_amdgcn_cvt_pk_f32_fp8((w_), false), ap[(k_) * 2]); ap[(k_) * 2 + 1] = __builtin_elementwise_fma(cf2_, __builtin_amdgcn_cvt_pk_f32_fp8((w_), true), ap[(k_) * 2 + 1]); } while (0)
#pragma unroll
    for (int g = 0; g < 8; ++g) { const f32x2_t cf2_ = (f32x2_t){cfa[g], cfa[g]}; PVS_AXPY(wa[g].x, 0); PVS_AXPY(wa[g].y, 1); PVS_AXPY(wa[g].z, 2); PVS_AXPY(wa[g].w, 3); }
#pragma unroll
    for (int g = 0; g < 8; ++g) { const f32x2_t cf2_ = (f32x2_t){cfb[g], cfb[g]}; PVS_AXPY(wb[g].x, 0); PVS_AXPY(wb[g].y, 1); PVS_AXPY(wb[g].z, 2); PVS_AXPY(wb[g].w, 3); }
#undef PVS_AXPY
    float acc[16];
#pragma unroll
    for (int i = 0; i < 8; ++i) { acc[2 * i] = ap[i].x; acc[2 * i + 1] = ap[i].y; }
#pragma unroll
    for (int i = 0; i < 16; ++i) { float v = acc[i]; v += DPPF(v, 0x128, 0xf); v += __shfl_xor(v, 16); v += __shfl_xor(v, 32); acc[i] = v; }
    if (e8 == 0) {
#pragma unroll
        for (int j = 0; j < 4; ++j) *(f32x4*)(outs + c * 16 + j * 4) = (f32x4){acc[j * 4 + 0], acc[j * 4 + 1], acc[j * 4 + 2], acc[j * 4 + 3]};
    }
}
#define PVL_IDS(I, k_) do { const int t_ = ((tg0 + ((k_) < nit ? (k_) : nit - 1) * tgstep) * 8 + wave); _Pragma("unroll") for (int j = 0; j < 4; ++j) I[j] = *(const v4u*)(EXPp + (size_t)t_ * 128 + e8 * 16 + j * 4); } while (0)
#define PVL_ROWS(R, C, I, k_) do { const int t_ = ((tg0 + ((k_) < nit ? (k_) : nit - 1) * tgstep) * 8 + wave); \
        _Pragma("unroll") for (int j = 0; j < 4; ++j) C[j] = *(const f32x4*)(CFp + (size_t)t_ * 128 + e8 * 16 + j * 4); \
        _Pragma("unroll") for (int j = 0; j < 4; ++j) { R[j * 4 + 0] = __builtin_amdgcn_raw_buffer_load_b128(vrsrc, (int)I[j].x * 128 + c * 16, 0, 0); R[j * 4 + 1] = __builtin_amdgcn_raw_buffer_load_b128(vrsrc, (int)I[j].y * 128 + c * 16, 0, 0); \
            R[j * 4 + 2] = __builtin_amdgcn_raw_buffer_load_b128(vrsrc, (int)I[j].z * 128 + c * 16, 0, 0); R[j * 4 + 3] = __builtin_amdgcn_raw_buffer_load_b128(vrsrc, (int)I[j].w * 128 + c * 16, 0, 0); } } while (0)
#define PVL_AXPY(w_, k2_) do { ap[(k2_) * 2] = __builtin_elementwise_fma(cf2_, __builtin_amdgcn_cvt_pk_f32_fp8((w_), false), ap[(k2_) * 2]); ap[(k2_) * 2 + 1] = __builtin_elementwise_fma(cf2_, __builtin_amdgcn_cvt_pk_f32_fp8((w_), true), ap[(k2_) * 2 + 1]); } while (0)
#define PVL_COMP(R, C, k_) do { f32x2_t ap[8]; \
        _Pragma("unroll") for (int i = 0; i < 8; ++i) ap[i] = (f32x2_t){0.f, 0.f}; \
        _Pragma("unroll") for (int g = 0; g < 16; ++g) { const float cfs_ = C[g >> 2][g & 3]; const f32x2_t cf2_ = (f32x2_t){cfs_, cfs_}; PVL_AXPY(R[g].x, 0); PVL_AXPY(R[g].y, 1); PVL_AXPY(R[g].z, 2); PVL_AXPY(R[g].w, 3); } \
        float acc[16]; \
        _Pragma("unroll") for (int i = 0; i < 8; ++i) { acc[2 * i] = ap[i].x; acc[2 * i + 1] = ap[i].y; } \
        float a8[8], a4[4], a2[2]; \
          \
        _Pragma("unroll") for (int i = 0; i < 8; ++i) { const auto sw_ = __builtin_amdgcn_permlane32_swap(__float_as_uint(acc[i]), __float_as_uint(acc[8 + i]), false, false); a8[i] = __uint_as_float(sw_[0]) + __uint_as_float(sw_[1]); } \
        _Pragma("unroll") for (int i = 0; i < 4; ++i) { const auto sw_ = __builtin_amdgcn_permlane16_swap(__float_as_uint(a8[i]), __float_as_uint(a8[4 + i]), false, false); a4[i] = __uint_as_float(sw_[0]) + __uint_as_float(sw_[1]); } \
        _Pragma("unroll") for (int i = 0; i < 2; ++i) { const float keep = hC ? a4[2 + i] : a4[i], send = hC ? a4[i] : a4[2 + i]; a2[i] = keep + DPPF(send, 0x128, 0xf); } \
        if ((k_) < nit) *(float2*)(OUTp + (size_t)((tg0 + (k_) * tgstep) * 8 + wave) * D + x * 128 + c * 16 + 2 * e8) = make_float2(a2[0], a2[1]); } while (0)
__device__ __forceinline__ void peer_v_loop(const int* __restrict__ EXPp, const float* __restrict__ CFp, const unsigned char* __restrict__ V8x, float* __restrict__ OUTp, int x, int tg0, int tgstep, int nit, int wave, int lane) {
    const int e8 = lane >> 3, c = lane & 7;
    const bool hA = (lane & 32) != 0, hB = (lane & 16) != 0, hC = (lane & 8) != 0;
    const __amdgpu_buffer_rsrc_t vrsrc = __builtin_amdgcn_make_buffer_rsrc((void*)V8x, 0, 16384 * 128, 0x00020000);
    v4u ra[16], rb[16], i0[4], i1[4]; f32x4 ca[4], cb[4];
    PVL_IDS(i0, 0);
    PVL_ROWS(ra, ca, i0, 0);
    PVL_IDS(i1, 1);
#pragma unroll 1
    for (int k = 0; k < nit; k += 2) {
        PVL_ROWS(rb, cb, i1, k + 1);
        PVL_IDS(i0, k + 2);
        PVL_COMP(ra, ca, k);
        PVL_ROWS(ra, ca, i0, k + 2);
        PVL_IDS(i1, k + 3);
        PVL_COMP(rb, cb, k + 1);
    }
}
__device__ __forceinline__ void peer_xc(const bf16* __restrict__ xrow, const float* __restrict__ srow, const float* __restrict__ g, const float* __restrict__ bta, float* __restrict__ orow, bf16* __restrict__ obrow, bf16* __restrict__ obrow2, int lane) {
    f32x4 v[4]; float s = 0.f;
#pragma unroll
    for (int j = 0; j < 4; ++j) { const v2u ab = ((const v2u*)xrow)[lane + 64 * j]; const f32x4 b = ((const f32x4*)srow)[lane + 64 * j];
        v[j] = (f32x4){ALPHA * bflo(ab.x) + b.x, ALPHA * bfhi(ab.x) + b.y, ALPHA * bflo(ab.y) + b.z, ALPHA * bfhi(ab.y) + b.w}; s += (v[j].x + v[j].y) + (v[j].z + v[j].w); }
    const float mean = wave_sum(s) * (1.0f / 1024.0f); float q = 0.f;
#pragma unroll
    for (int j = 0; j < 4; ++j) { v[j] = v[j] - mean; q += (v[j].x * v[j].x + v[j].y * v[j].y) + (v[j].z * v[j].z + v[j].w * v[j].w); }
    const float rs = rsqrtf(wave_sum(q) * (1.0f / 1024.0f) + LN_EPS);
#pragma unroll
    for (int j = 0; j < 4; ++j) {
        const f32x4 g4 = ((const f32x4*)g)[lane + 64 * j], b4 = ((const f32x4*)bta)[lane + 64 * j];
        const f32x4 o = v[j] * rs * g4 + b4;
        if (orow) ((f32x4*)orow)[lane + 64 * j] = o;
        if (obrow) { v2u ob; ob.x = pk2(o.x, o.y); ob.y = pk2(o.z, o.w); ((v2u*)obrow)[lane + 64 * j] = ob; if (obrow2) ((v2u*)obrow2)[lane + 64 * j] = ob; }
    }
}

__device__ __forceinline__ int t5_bucket(int n) {
    if (n < 16) return n;
    const int large = 16 + (int)(logf((float)n / 16.0f) / 2.0794415416798357f * 16.0f);
    return large < 31 ? large : 31;
}
__device__ __forceinline__ void swa_attn(const float* __restrict__ PC, const float* __restrict__ cache_k, const float* __restrict__ cache_v,
                                         const float* __restrict__ rel_bias, const float* __restrict__ sinks, bf16* __restrict__ ATT, int bx) {
    const int tid = threadIdx.x, lane = tid & 63, wid = tid >> 6;
    const int gw = bx * 8 + wid;
    const int t = gw >> 4, h = gw & 15, kvh = h >> 2;
    if (t >= NT) return;
    const bool samp = t >= NP; const int sb = t - NP, pos = t % SEQ;
    const float* qrow = PC + (size_t)t * CN + h * 64;
    float lg[2]; bool valid[2];
#pragma unroll
    for (int rr = 0; rr < 2; ++rr) {
        const int r = lane + 64 * rr;
        const float* krow;
        if (!samp) { valid[rr] = (pos - r) >= 0; krow = PC + (size_t)(valid[rr] ? t - r : t) * CN + 1024 + kvh * 64; }
        else { valid[rr] = true; krow = (r == 0) ? PC + (size_t)t * CN + 1024 + kvh * 64 : cache_k + (((size_t)sb * 128 + (128 - r)) * 4 + kvh) * 64; }
        float dot = 0.f;
#pragma unroll
        for (int d4 = 0; d4 < 16; ++d4) {
            const float4 kv = *(const float4*)(krow + d4 * 4);
            const float4 qv = *(const float4*)(qrow + d4 * 4);
            dot += qv.x * kv.x + qv.y * kv.y + qv.z * kv.z + qv.w * kv.w;
        }
        lg[rr] = valid[rr] ? dot * 0.125f + rel_bias[t5_bucket(r) * 16 + h] : -INFINITY;
    }
    const float sink = sinks[h];
    const float m = fmaxf(wave_max(fmaxf(lg[0], lg[1])), sink);
    float p[2];
#pragma unroll
    for (int rr = 0; rr < 2; ++rr) p[rr] = valid[rr] ? expf(lg[rr] - m) : 0.f;
    const float den = wave_sum(p[0] + p[1]) + expf(sink - m);
    const float inv = 1.0f / den;
    float o = 0.f;
#pragma unroll
    for (int rr = 0; rr < 2; ++rr)
        for (int l2 = 0; l2 < 64; ++l2) {
            const int r = l2 + 64 * rr;
            const float pj = __shfl(p[rr], l2);
            if (pj != 0.f) {
                const float* vrow;
                if (!samp) vrow = PC + (size_t)(t - r) * CN + 1280 + kvh * 64;
                else vrow = (r == 0) ? PC + (size_t)t * CN + 1280 + kvh * 64 : cache_v + (((size_t)sb * 128 + (128 - r)) * 4 + kvh) * 64;
                o += pj * vrow[lane];
            }
        }
    ATT[(size_t)t * D + h * 64 + lane] = (bf16)f2bf(o * inv);
}

__device__ __forceinline__ void swa_kv_out(const float* __restrict__ PC, const float* __restrict__ cache_k, const float* __restrict__ cache_v,
                                           float* __restrict__ pk, float* __restrict__ pv, float* __restrict__ sk, float* __restrict__ sv, int vb) {
    const int c = threadIdx.x & 255, row = vb * 2 + (threadIdx.x >> 8);
    if (row < NB * 128) {
        const int b = row >> 7, i = row & 127;
        const float* src = PC + (size_t)(b * SEQ + SEQ - 128 + i) * CN;
        pk[(size_t)row * 256 + c] = src[1024 + c];
        pv[(size_t)row * 256 + c] = src[1280 + c];
    } else {
        const int r2 = row - NB * 128, sb = r2 >> 7, i = r2 & 127;
        if (i < 127) {
            sk[(size_t)r2 * 256 + c] = cache_k[((size_t)sb * 128 + i + 1) * 256 + c];
            sv[(size_t)r2 * 256 + c] = cache_v[((size_t)sb * 128 + i + 1) * 256 + c];
        } else {
            const float* src = PC + (size_t)(NP + sb) * CN;
            sk[(size_t)r2 * 256 + c] = src[1024 + c];
            sv[(size_t)r2 * 256 + c] = src[1280 + c];
        }
    }
}
#define XB_TMO      128
#define XB_XCNT(j)  (256  + 64 * (j))
#define XB_XSUB(j)  (1280 + 64 * (j))
#define XB_XGEN(j)  (2304 + 64 * (j))
#define XB_TOP      3328
#define XB_TOPGEN   3392
#define XCD_BAR_WORDS 3456
#define XB_SPIN_CAP (1u << 18)

__device__ __forceinline__ unsigned xb_ld(unsigned* p)              { return __hip_atomic_load(p, __ATOMIC_RELAXED, __HIP_MEMORY_SCOPE_AGENT); }
__device__ __forceinline__ unsigned xb_add(unsigned* p, unsigned v) { return __hip_atomic_fetch_add(p, v, __ATOMIC_RELAXED, __HIP_MEMORY_SCOPE_AGENT); }
__device__ __forceinline__ unsigned xb_xcc_id() { return (unsigned)__builtin_amdgcn_s_getreg((3 << 11) | 20) & 0xFu; }
#define XB_SPIN(cond, bar) do { unsigned _sp = 0; while (cond) { __builtin_amdgcn_s_sleep(1); \
    if ((++_sp & 255u) == 0u) { if (xb_ld(&(bar)[XB_TMO])) break; if (_sp > XB_SPIN_CAP) { atomicAdd(&(bar)[XB_TMO], 1u); break; } } } } while (0)

struct XcdBarrier {
    unsigned* bar; unsigned x;
    volatile LAS unsigned* st;
};

__device__ __forceinline__ XcdBarrier xcd_barrier_post(unsigned* bar, volatile LAS unsigned* st) {
    XcdBarrier b; b.bar = bar; b.x = xb_xcc_id(); b.st = st;
    if (threadIdx.x == 0) (void)xb_add(&bar[XB_XCNT(b.x)], 1u);
    return b;
}
__device__ __forceinline__ void xcd_barrier_complete(unsigned* bar, unsigned x, unsigned& nloc, unsigned& nx) {
    const unsigned G = gridDim.x * gridDim.y * gridDim.z;
    unsigned sum, cnt, mine, sp = 0u;
    for (;;) {
        sum = 0u; cnt = 0u; mine = 0u;
#pragma unroll
        for (unsigned j = 0; j < 16; ++j) { const unsigned c = xb_ld(&bar[XB_XCNT(j)]); sum += c; cnt += (c > 0u) ? 1u : 0u; mine = (j == x) ? c : mine; }
        if (sum == G) break;
        __builtin_amdgcn_s_sleep(1);
        if ((++sp & 255u) == 0u) { if (xb_ld(&bar[XB_TMO])) break; if (sp > XB_SPIN_CAP) { atomicAdd(&bar[XB_TMO], 1u); break; } }
    }
    nloc = mine > 0u ? mine : 1u; nx = cnt > 0u ? cnt : 1u;
}

__device__ __forceinline__ void xcd_barrier(const XcdBarrier& b) {
    asm volatile("s_waitcnt vmcnt(0)" ::: "memory");
    __syncthreads();
    if (threadIdx.x == 0) {
        unsigned* bar = b.bar;
        __builtin_amdgcn_s_waitcnt(0);
        unsigned nloc = b.st[0], nx = b.st[1];
        if (nloc == 0u) { xcd_barrier_complete(bar, b.x, nloc, nx); b.st[0] = nloc; b.st[1] = nx; }
        const unsigned old = xb_add(&bar[XB_XSUB(b.x)], 1u);
        const unsigned gen = old / nloc;
        if (old + 1u == (gen + 1u) * nloc) {
            __builtin_amdgcn_fence(__ATOMIC_RELEASE, "agent");
            asm volatile("s_waitcnt vmcnt(0)" ::: "memory");
            const unsigned og = xb_add(&bar[XB_TOP], 1u);
            const unsigned tg = og / nx;
            if (og + 1u == (tg + 1u) * nx) xb_add(&bar[XB_TOPGEN], 1u);
            else XB_SPIN(xb_ld(&bar[XB_TOPGEN]) == tg, bar);
            __builtin_amdgcn_fence(__ATOMIC_ACQUIRE, "agent");
            xb_add(&bar[XB_XGEN(b.x)], 1u);
            asm volatile("s_waitcnt vmcnt(0)" ::: "memory");
        } else {
            XB_SPIN(xb_ld(&bar[XB_XGEN(b.x)]) == gen, bar);
            __builtin_amdgcn_fence(__ATOMIC_ACQUIRE, "agent");
            asm volatile("s_waitcnt vmcnt(0)" ::: "memory");
        }
    }
    __syncthreads();
}

typedef short bf16x8_t __attribute__((ext_vector_type(8)));
__device__ __forceinline__ f32x4 mfma16(bf16x8_t a, bf16x8_t b, f32x4 c) { return __builtin_amdgcn_mfma_f32_16x16x32_bf16(a, b, c, 0, 0, 0); }

struct GdnChunkBufs {
    bf16* W;
    bf16* QG;
    bf16* KDT;
    bf16* UT;
    bf16* QK;
    float* EGL;
};

constexpr int GP_QB = 0, GP_KB = 17408, GP_VB = 34816, GP_LS = 52224, GP_QKS = 69632, GP_WS = 78848, GP_SC = 96256;

struct ConvJob { const float* u0; const float* v0; unsigned char* tab; float* tsc; };
__device__ __forceinline__ void gdn_prep_unit(const bf16* __restrict__ PROJ, const float* __restrict__ conv_w, const float* __restrict__ a_log, const float* __restrict__ dt_bias,
                                              const GdnChunkBufs& cb, float* __restrict__ p_gdn_conv, int un, unsigned char* lds, const ConvJob& cj) {
    int tid = threadIdx.x; asm volatile("" : "+v"(tid));
    const int lane = tid & 63, wave = __builtin_amdgcn_readfirstlane(tid >> 6), fr = lane & 15, fq = lane >> 4;
    const int h = un & 3, n = (un >> 2) & 63, b = un >> 8;
    const int t0 = b * SEQ + n * 64;
    bf16* Qb = (bf16*)(lds + GP_QB); bf16* Kb = (bf16*)(lds + GP_KB); bf16* Vb = (bf16*)(lds + GP_VB); bf16* Ws = (bf16*)(lds + GP_WS);
    float* Ls = (float*)(lds + GP_LS); bf16* QKs = (bf16*)(lds + GP_QKS);
    float* gcs = (float*)(lds + GP_SC); float* bets = gcs + 64; float* egcs = gcs + 128; float* ekds = gcs + 192; float* begs = gcs + 256;
    bf16 a_raw_h = 0, b_raw_h = 0; float alog_ = 0.f, dtb_ = 0.f;
    if (wave == 0) { const bf16* prow = PROJ + (size_t)(t0 + lane) * ABN; a_raw_h = prow[C_A + h]; b_raw_h = prow[C_B + h]; alog_ = a_log[h]; dtb_ = dt_bias[h]; }
    {
        const int part = lane >> 4, chunk = lane & 15, col0 = (part < 3 ? part : 2) * 512 + h * 128 + chunk * 8, i0 = wave * 8;
        v4u xr[11];
#pragma unroll
        for (int r = 0; r < 11; ++r) { const int pos = n * 64 + i0 - 3 + r; xr[r] = (v4u){0u, 0u, 0u, 0u}; if (pos >= 0 && part < 3) xr[r] = *(const v4u*)(PROJ + (size_t)(t0 + i0 - 3 + r) * ABN + col0); }
        f32x4 cwl[4][2];
#pragma unroll
        for (int tp = 0; tp < 4; ++tp) { cwl[tp][0] = *(const f32x4*)(conv_w + tp * 1536 + col0); cwl[tp][1] = *(const f32x4*)(conv_w + tp * 1536 + col0 + 4); }
        bf16* dstb = part == 0 ? Qb : (part == 1 ? Kb : Vb);
#pragma unroll
        for (int ii = 0; ii < 8; ++ii) {
            const int i = i0 + ii;
            float sv_[8], ss = 0.f;
#pragma unroll
            for (int e = 0; e < 8; ++e) {
                float y_ = 0.f;
#pragma unroll
                for (int tp = 0; tp < 4; ++tp) { const unsigned w_ = xr[ii + tp][e >> 1]; const float xv_ = (e & 1) ? bfhi(w_) : bflo(w_); y_ += cwl[tp][e >> 2][e & 3] * xv_; }
                sv_[e] = y_ * __frcp_rn(1.0f + __expf(-y_)); ss += sv_[e] * sv_[e];
            }
            ss += DPPF(ss, 0xB1, 0xf); ss += DPPF(ss, 0x4E, 0xf); ss += DPPF(ss, 0x141, 0xf); ss += DPPF(ss, 0x140, 0xf);
            const float scl_ = part == 0 ? rsqrtf(ss + 1e-6f) * 0.08838834764831845f : (part == 1 ? rsqrtf(ss + 1e-6f) : 1.0f);
            if (part < 3) {
                v4u o; o.x = pk2(sv_[0] * scl_, sv_[1] * scl_); o.y = pk2(sv_[2] * scl_, sv_[3] * scl_); o.z = pk2(sv_[4] * scl_, sv_[5] * scl_); o.w = pk2(sv_[6] * scl_, sv_[7] * scl_);
                *(v4u*)(dstb + i * 136 + chunk * 8) = o;
                if (n == 63 && i >= 61) {
                    const v4u w_ = xr[ii + 3]; float* pc = p_gdn_conv + ((size_t)b * 3 + (i - 61)) * 1536 + col0;
                    *(f32x4*)pc = (f32x4){bflo(w_.x), bfhi(w_.x), bflo(w_.y), bfhi(w_.y)}; *(f32x4*)(pc + 4) = (f32x4){bflo(w_.z), bfhi(w_.z), bflo(w_.w), bfhi(w_.w)};
                }
            }
        }
    }
    if (wave == 0) {
        const float a_raw = bf2f(a_raw_h), b_raw = bf2f(b_raw_h);
        float g = -expf(alog_) * softplusf_(a_raw + dtb_);
#pragma unroll
        for (int off = 1; off < 64; off <<= 1) { const float v = __shfl_up(g, off); if (lane >= off) g += v; }
        const float glast = __shfl(g, 63);
        { const float be_ = sigmoidf_(b_raw), eg_ = expf(g); gcs[lane] = g; bets[lane] = be_; egcs[lane] = eg_; ekds[lane] = expf(glast - g); begs[lane] = be_ * eg_; }
        if (lane == 0) cb.EGL[un] = expf(glast);
    }
    __syncthreads();
    {
        const int mi = wave >> 1;
        bf16x8_t aK[4], aQ[4];
#pragma unroll
        for (int ks = 0; ks < 4; ++ks) { aK[ks] = *(const bf16x8_t*)(Kb + (mi * 16 + fr) * 136 + ks * 32 + 8 * fq); aQ[ks] = *(const bf16x8_t*)(Qb + (mi * 16 + fr) * 136 + ks * 32 + 8 * fq); }
#pragma unroll
        for (int nn = 0; nn < 2; ++nn) {
            const int nj = (wave & 1) * 2 + nn;
            f32x4 accK = (f32x4){0.f, 0.f, 0.f, 0.f}, accQ = accK;
#pragma unroll
            for (int ks = 0; ks < 4; ++ks) { const bf16x8_t bk = *(const bf16x8_t*)(Kb + (nj * 16 + fr) * 136 + ks * 32 + 8 * fq); accK = mfma16(aK[ks], bk, accK); accQ = mfma16(aQ[ks], bk, accQ); }
            const int j = nj * 16 + fr; const float gj = gcs[j];
#pragma unroll
            for (int r = 0; r < 4; ++r) {
                const int i = mi * 16 + 4 * fq + r;
                const float dec = i >= j ? expf(gcs[i] - gj) : 0.f;
                Ls[j * 68 + i] = i > j ? bets[i] * accK[r] * dec : 0.f;
                QKs[i * 72 + j] = (bf16)f2bf(i >= j ? accQ[r] * dec : 0.f);
            }
        }
    }
    __syncthreads();
    if (wave < 4) {
        float x[64];
        const bool isu = tid < 128; const int c = isu ? tid : tid - 128;
        const LAS unsigned char* l3 = (const LAS unsigned char*)lds;
        unsigned so = (isu ? GP_VB : GP_KB) + c * 2, ro = GP_SC + (isu ? 64 * 4 : 256 * 4), lo = GP_LS;
        asm volatile("" : "+v"(so), "+v"(ro), "+v"(lo));
#pragma unroll
        for (int i = 0; i < 64; ++i) x[i] = *(const LAS float*)(l3 + ro + 4 * i) * bf2f(*(const LAS bf16*)(l3 + so + i * 272));
#pragma unroll
        for (int j = 0; j < 63; ++j) {
            const float nxj = -x[j]; const f32x2c_t nx2 = (f32x2c_t){nxj, nxj};
#pragma unroll
            for (int i4 = (j + 1) / 4; i4 < 16; ++i4) {
                const f32x4 l4 = *(const LAS f32x4*)(l3 + lo + j * 272 + i4 * 16);
#pragma unroll
                for (int hp = 0; hp < 2; ++hp) {
                    const int i0 = i4 * 4 + 2 * hp; const float la = hp ? l4.z : l4.x, lb = hp ? l4.w : l4.y;
                    if (i0 > j) { const f32x2c_t r = __builtin_elementwise_fma((f32x2c_t){la, lb}, nx2, (f32x2c_t){x[i0], x[i0 + 1]}); x[i0] = r.x; x[i0 + 1] = r.y; }
                    else if (i0 + 1 > j) x[i0 + 1] = fmaf(lb, nxj, x[i0 + 1]);
                }
            }
        }
        if (isu) {
            bf16* dst = cb.UT + (size_t)un * 8192 + ((c >> 4) * 4 * 64 + (c & 15)) * 4;
#pragma unroll
            for (int m4 = 0; m4 < 16; ++m4) { v2u o; o.x = pk2(x[m4 * 4 + 0], x[m4 * 4 + 1]); o.y = pk2(x[m4 * 4 + 2], x[m4 * 4 + 3]); *(v2u*)(dst + ((m4 >> 2) * 64 + (m4 & 3) * 16) * 4) = o; }
        } else {
#pragma unroll
            for (int i = 0; i < 64; ++i) Ws[i * 136 + c] = (bf16)f2bf(x[i]);
        }
    } else {
        const int t2 = tid - 256;
#pragma unroll
        for (int k = 0; k < 4; ++k) {
            const int ci = t2 + 256 * k, i = ((ci >> 8) << 4) | (ci & 15), d0 = (((ci >> 6) & 3) * 4 + ((ci >> 4) & 3)) * 8; const float e = egcs[i];
            const v4u q = *(const v4u*)(Qb + i * 136 + d0);
            v4u o; o.x = pk2(bflo(q.x) * e, bfhi(q.x) * e); o.y = pk2(bflo(q.y) * e, bfhi(q.y) * e); o.z = pk2(bflo(q.z) * e, bfhi(q.z) * e); o.w = pk2(bflo(q.w) * e, bfhi(q.w) * e);
            *(v4u*)(cb.QG + (size_t)un * 8192 + ci * 8) = o;
        }
#pragma unroll
        for (int k = 0; k < 4; ++k) {
            const int ci = t2 + 256 * k, d = ((ci >> 7) << 4) | (ci & 15), i0 = (((ci >> 6) & 1) * 4 + ((ci >> 4) & 3)) * 8;
            float v[8];
#pragma unroll
            for (int q = 0; q < 8; ++q) v[q] = bf2f(Kb[(i0 + q) * 136 + d]) * ekds[i0 + q];
            v4u o; o.x = pk2(v[0], v[1]); o.y = pk2(v[2], v[3]); o.z = pk2(v[4], v[5]); o.w = pk2(v[6], v[7]);
            *(v4u*)(cb.KDT + (size_t)un * 8192 + ci * 8) = o;
        }
#pragma unroll
        for (int k = 0; k < 2; ++k) {
            const int ci = t2 + 256 * k, i = ((ci >> 7) << 4) | (ci & 15), j0 = (((ci >> 6) & 1) * 4 + ((ci >> 4) & 3)) * 8;
            *(v4u*)(cb.QK + (size_t)un * 4096 + ci * 8) = *(const v4u*)(QKs + i * 72 + j0);
        }
        { const int rb = (un & 511) * 32 + (wave - 4) * 8;
          if (un < 512) table_rows_convert<false>(cj.u0, cj.tab, cj.tsc, rb, rb + 8, 0, 1, lane);
          else table_rows_convert<true>(cj.v0, cj.tab + (size_t)16384 * D, cj.tsc + 16384, rb, rb + 8, 0, 1, lane); }
    }
    __syncthreads();
#pragma unroll
    for (int k = 0; k < 2; ++k) {
        const int ci = tid + 512 * k, i = ((ci >> 8) << 4) | (ci & 15), d0 = (((ci >> 6) & 3) * 4 + ((ci >> 4) & 3)) * 8;
        *(v4u*)(cb.W + (size_t)un * 8192 + ci * 8) = *(const v4u*)(Ws + i * 136 + d0);
    }
    __syncthreads();
}

constexpr int GS_ST = 0, GS_VNT = 2 * 32 * 136 * 2, GS_END = GS_VNT + 32 * 72 * 2;
template <int N0, int N1>
__device__ __forceinline__ void gdn_seq(const GdnChunkBufs& cb, float* __restrict__ O, float* __restrict__ Sout, int b, int h, int sl, unsigned char* lds, f32x4 (&accS)[2], int& cur) {
    int tid = threadIdx.x; asm volatile("" : "+v"(tid));
    const int lane = tid & 63, wave = __builtin_amdgcn_readfirstlane(tid >> 6), fr = lane & 15, fq = lane >> 4;
    const int mi = wave >> 1, nj = wave & 1;
    bf16* St = (bf16*)(lds + GS_ST); bf16* VnT = (bf16*)(lds + GS_VNT);
    float* egls = (float*)(lds + GS_END);
    if (N0 == 0) {
        for (int i = tid; i < 2 * 32 * 136 / 2; i += NTH) ((unsigned*)St)[i] = 0u;
        accS[0] = (f32x4){0.f, 0.f, 0.f, 0.f}; accS[1] = accS[0]; cur = 0;
    }
    if (tid >= N0 && tid < N1) egls[tid] = cb.EGL[(size_t)((b * 64 + tid) * 4 + h)];
    __syncthreads();
#define GS_DECL(X) bf16x8_t aW##X[4], aQG##X[4], aQK##X[2], aKD##X[2]; v2u ut##X;
    GS_DECL(0) GS_DECL(1) GS_DECL(2)
#define GS_GLD16(dst, ptr) asm volatile("global_load_dwordx4 %0, %1, off" : "=v"(dst) : "v"(ptr))
#define GS_GLD8(dst, ptr) asm volatile("global_load_dwordx2 %0, %1, off" : "=v"(dst) : "v"(ptr))
#define GS_LOAD(X, n_) do { const size_t u_ = (size_t)((b * 64 + ((n_) < 63 ? (n_) : 63)) * 4 + h);     \
        _Pragma("unroll") for (int ks = 0; ks < 4; ++ks) { GS_GLD16(aW##X[ks], cb.W + u_ * 8192 + ((mi * 4 + ks) * 64 + lane) * 8); GS_GLD16(aQG##X[ks], cb.QG + u_ * 8192 + ((mi * 4 + ks) * 64 + lane) * 8); } \
        _Pragma("unroll") for (int ks = 0; ks < 2; ++ks) { GS_GLD16(aQK##X[ks], cb.QK + u_ * 4096 + ((mi * 2 + ks) * 64 + lane) * 8); GS_GLD16(aKD##X[ks], cb.KDT + u_ * 8192 + ((wave * 2 + ks) * 64 + lane) * 8); } \
        GS_GLD8(ut##X, cb.UT + u_ * 8192 + (((sl * 2 + nj) * 4 + mi) * 64 + lane) * 4); } while (0)
#define GS_WAITN(X, N) asm volatile("s_waitcnt vmcnt(" #N ")" : "+v"(aW##X[0]), "+v"(aW##X[1]), "+v"(aW##X[2]), "+v"(aW##X[3]), "+v"(aQG##X[0]), "+v"(aQG##X[1]), "+v"(aQG##X[2]), "+v"(aQG##X[3]), \
        "+v"(aQK##X[0]), "+v"(aQK##X[1]), "+v"(aKD##X[0]), "+v"(aKD##X[1]), "+v"(ut##X))
#define GS_WAIT(X, n_) GS_WAITN(X, 26)
#define GS_STEP(X, n_) do { \
        const float egl##X = egls[(n_)]; \
        GS_WAIT(X, n_); \
        __syncthreads();                                        \
        f32x4 accW = (f32x4){0.f, 0.f, 0.f, 0.f}, accO = accW; \
        const bf16* Sc = St + cur * 32 * 136; \
        _Pragma("unroll") for (int ks = 0; ks < 4; ++ks) { const bf16x8_t bs = *(const bf16x8_t*)(Sc + (nj * 16 + fr) * 136 + ks * 32 + 8 * fq); accW = mfma16(aW##X[ks], bs, accW); accO = mfma16(aQG##X[ks], bs, accO); } \
          \
        const float v0 = bflo(ut##X.x) - accW[0], v1 = bfhi(ut##X.x) - accW[1], v2 = bflo(ut##X.y) - accW[2], v3 = bfhi(ut##X.y) - accW[3]; \
        { v2u o; o.x = pk2(v0, v1); o.y = pk2(v2, v3); *(v2u*)(VnT + (nj * 16 + fr) * 72 + mi * 16 + 4 * fq) = o; } \
        __syncthreads();                                        \
        _Pragma("unroll") for (int ks = 0; ks < 2; ++ks) { const bf16x8_t bv = *(const bf16x8_t*)(VnT + (nj * 16 + fr) * 72 + ks * 32 + 8 * fq); accO = mfma16(aQK##X[ks], bv, accO); } \
        { float* orow = O + (size_t)(b * SEQ + (n_) * 64 + mi * 16 + 4 * fq) * 512 + h * 128 + sl * 32 + nj * 16 + fr; \
          orow[0] = accO[0]; orow[512] = accO[1]; orow[1024] = accO[2]; orow[1536] = accO[3]; } \
          \
        bf16* Sn = St + (cur ^ 1) * 32 * 136; \
        _Pragma("unroll") for (int njj = 0; njj < 2; ++njj) { \
            accS[njj] = accS[njj] * egl##X; \
            _Pragma("unroll") for (int ks = 0; ks < 2; ++ks) { const bf16x8_t bv = *(const bf16x8_t*)(VnT + (njj * 16 + fr) * 72 + ks * 32 + 8 * fq); accS[njj] = mfma16(aKD##X[ks], bv, accS[njj]); } \
            v2u o; o.x = pk2(accS[njj][0], accS[njj][1]); o.y = pk2(accS[njj][2], accS[njj][3]); \
            *(v2u*)(Sn + (njj * 16 + fr) * 136 + wave * 16 + 4 * fq) = o; } \
        cur ^= 1; } while (0)
    constexpr int NTRI = (N1 - N0) / 3, NREM = (N1 - N0) % 3, NM = N0 + 3 * NTRI;
    GS_LOAD(0, N0); GS_LOAD(1, N0 + 1);
#pragma unroll 1
    for (int n = N0; n < NM; n += 3) {
        GS_LOAD(2, n + 2);
        GS_STEP(0, n);
        GS_LOAD(0, n + 3);
        GS_STEP(1, n + 1);
        GS_LOAD(1, n + 4);
        GS_STEP(2, n + 2);
    }
    if (NREM >= 1) { GS_LOAD(2, NM + 2); GS_STEP(0, NM); }
    if (NREM == 2) { GS_LOAD(0, NM + 3); GS_STEP(1, NM + 1); }
    GS_WAITN(0, 0); GS_WAITN(1, 0); GS_WAITN(2, 0);
#undef GS_STEP
#undef GS_DECL
#undef GS_WAIT
#undef GS_WAITN
#undef GS_GLD16
#undef GS_GLD8
    asm volatile("s_waitcnt vmcnt(0)" ::: "memory");
#undef GS_LOAD
    if (N1 == 64) {
#pragma unroll
        for (int njj = 0; njj < 2; ++njj)
#pragma unroll
            for (int r = 0; r < 4; ++r) Sout[(((size_t)b * 4 + h) * 128 + wave * 16 + 4 * fq + r) * 128 + sl * 32 + njj * 16 + fr] = accS[njj][r];
    }
    __syncthreads();
}

__device__ __forceinline__ void lru_prep_unit(const bf16* __restrict__ PROJ, const float* __restrict__ conv_w, const float* __restrict__ conv_b,
                                              const float* __restrict__ w_r, const float* __restrict__ b_r, const float* __restrict__ w_i, const float* __restrict__ b_i, const float* __restrict__ lam,
                                              float* __restrict__ H, float* __restrict__ P, float* __restrict__ Hend, float* __restrict__ Pend, float* __restrict__ p_lru_conv, int ub) {
    int c = threadIdx.x; asm volatile("" : "+v"(c));
    const int nblk = c >> 6, d = c & 63;
    const int n = ub & 63, b = ub >> 6, t0 = b * SEQ + n * 64;
    float wr[64], wi[64];
#pragma unroll
    for (int cc = 0; cc < 64; ++cc) { wr[cc] = w_r[((size_t)nblk * 64 + cc) * 64 + d]; wi[cc] = w_i[((size_t)nblk * 64 + cc) * 64 + d]; }
    const float cw0 = conv_w[c], cw1 = conv_w[512 + c], cw2 = conv_w[1024 + c], cw3 = conv_w[1536 + c], cb_ = conv_b[c];
    const float br = b_r[c], bi = b_i[c], spl = -8.0f * softplusf_(-lam[c]);
    float x0 = (n * 64 - 3 >= 0) ? bf2f(PROJ[(size_t)(t0 - 3) * ABN + C_XR + c]) : 0.f;
    float x1 = (n * 64 - 2 >= 0) ? bf2f(PROJ[(size_t)(t0 - 2) * ABN + C_XR + c]) : 0.f;
    float x2 = (n * 64 - 1 >= 0) ? bf2f(PROJ[(size_t)(t0 - 1) * ABN + C_XR + c]) : 0.f;
    float hloc = 0.f, ploc = 1.f;
    bf16 xa[16], xb[16];
#pragma unroll
    for (int k = 0; k < 16; ++k) xa[k] = PROJ[(size_t)(t0 + k) * ABN + C_XR + c];
#pragma unroll 1
    for (int ib = 0; ib < 64; ib += 16) {
      if (ib + 16 < 64) {
#pragma unroll
        for (int k = 0; k < 16; ++k) xb[k] = PROJ[(size_t)(t0 + ib + 16 + k) * ABN + C_XR + c];
      }
#pragma unroll
      for (int k = 0; k < 16; ++k) {
        const int i = ib + k;
        const float xt = bf2f(xa[k]);
        const float xr = cb_ + cw0 * x0 + cw1 * x1 + cw2 * x2 + cw3 * xt;
        f32x2_t ga = (f32x2_t){br, bi}, gb = (f32x2_t){0.f, 0.f};
#pragma unroll
        for (int cc = 0; cc < 64; cc += 2) {
            const float xa_ = __uint_as_float(__builtin_amdgcn_readlane(__float_as_uint(xr), cc)), xb_ = __uint_as_float(__builtin_amdgcn_readlane(__float_as_uint(xr), cc + 1));
            ga += (f32x2_t){xa_, xa_} * (f32x2_t){wr[cc], wi[cc]}; gb += (f32x2_t){xb_, xb_} * (f32x2_t){wr[cc + 1], wi[cc + 1]};
        }
        ga += gb;
        const float r = __frcp_rn(1.0f + __expf(-ga.x)), ii = __frcp_rn(1.0f + __expf(-ga.y));
        const float a = __expf(spl * r), bb = __fsqrt_rn(fmaxf(1.0f - a * a, 0.f)) * (ii * xr);
        hloc = a * hloc + bb; ploc *= a;
        H[(size_t)(t0 + i) * 512 + c] = hloc; P[(size_t)(t0 + i) * 512 + c] = ploc;
        if (n == 63 && i >= 61) p_lru_conv[((size_t)b * 3 + (i - 61)) * 512 + c] = xt;
        x0 = x1; x1 = x2; x2 = xt;
      }
#pragma unroll
      for (int k = 0; k < 16; ++k) xa[k] = xb[k];
    }
    Hend[(size_t)ub * 512 + c] = hloc; Pend[(size_t)ub * 512 + c] = ploc;
}
constexpr int LR_XR = 64 * 68 * 4;
__device__ __forceinline__ void lru_prep_unit2(const bf16* __restrict__ PROJ, const float* __restrict__ conv_w, const float* __restrict__ conv_b,
                                               const bf16* __restrict__ WRT, const bf16* __restrict__ WIT  , const float* __restrict__ b_r, const float* __restrict__ b_i, const float* __restrict__ lam,
                                               float* __restrict__ H, float* __restrict__ P, float* __restrict__ Hend, float* __restrict__ Pend, float* __restrict__ p_lru_conv, int ub, unsigned char* lds) {
    int tid = threadIdx.x; asm volatile("" : "+v"(tid));
    const int lane = tid & 63, wave = __builtin_amdgcn_readfirstlane(tid >> 6), fr = lane & 15, fq = lane >> 4;
    const int n = ub & 63, b = ub >> 6, t0 = b * SEQ + n * 64;
    float* XR = (float*)(lds + wave * LR_XR);
    {
        const int c = wave * 64 + lane;
        const float cw0 = conv_w[c], cw1 = conv_w[512 + c], cw2 = conv_w[1024 + c], cw3 = conv_w[1536 + c], cb_ = conv_b[c];
        float x0 = (n * 64 - 3 >= 0) ? bf2f(PROJ[(size_t)(t0 - 3) * ABN + C_XR + c]) : 0.f;
        float x1 = (n * 64 - 2 >= 0) ? bf2f(PROJ[(size_t)(t0 - 2) * ABN + C_XR + c]) : 0.f;
        float x2 = (n * 64 - 1 >= 0) ? bf2f(PROJ[(size_t)(t0 - 1) * ABN + C_XR + c]) : 0.f;
        bf16 xa[64];
#pragma unroll
        for (int k = 0; k < 64; ++k) xa[k] = PROJ[(size_t)(t0 + k) * ABN + C_XR + c];
#pragma unroll
        for (int i = 0; i < 64; ++i) {
            const float xt = bf2f(xa[i]);
            XR[i * 68 + lane] = cb_ + cw0 * x0 + cw1 * x1 + cw2 * x2 + cw3 * xt;
            if (n == 63 && i >= 61) p_lru_conv[((size_t)b * 3 + (i - 61)) * 512 + c] = xt;
            x0 = x1; x1 = x2; x2 = xt;
        }
    }
    asm volatile("s_waitcnt lgkmcnt(0)" ::: "memory");
    bf16x8_t bR[4][2], bI[4][2];
#pragma unroll
    for (int nt = 0; nt < 4; ++nt)
#pragma unroll
        for (int ks = 0; ks < 2; ++ks) {
            bR[nt][ks] = *(const bf16x8_t*)(WRT + ((size_t)wave * 64 + nt * 16 + fr) * 64 + ks * 32 + 8 * fq);
            bI[nt][ks] = *(const bf16x8_t*)(WIT + ((size_t)wave * 64 + nt * 16 + fr) * 64 + ks * 32 + 8 * fq);
        }
    float brv[4], biv[4], splv[4];
#pragma unroll
    for (int nt = 0; nt < 4; ++nt) { const int c = wave * 64 + nt * 16 + fr; brv[nt] = b_r[c]; biv[nt] = b_i[c]; splv[nt] = -8.0f * softplusf_(-lam[c]); }
    float hin[4], pin[4];
#pragma unroll
    for (int nt = 0; nt < 4; ++nt) { hin[nt] = 0.f; pin[nt] = 1.f; }
#pragma unroll 1
    for (int mt = 0; mt < 4; ++mt) {
        float pkeep[4][4];
        bf16x8_t aX[2];
#pragma unroll
        for (int ks = 0; ks < 2; ++ks) {
            const f32x4 lo = *(const f32x4*)(XR + (mt * 16 + fr) * 68 + ks * 32 + 8 * fq), hi = *(const f32x4*)(XR + (mt * 16 + fr) * 68 + ks * 32 + 8 * fq + 4);
            v4u w; w.x = pk2(lo.x, lo.y); w.y = pk2(lo.z, lo.w); w.z = pk2(hi.x, hi.y); w.w = pk2(hi.z, hi.w);
            aX[ks] = __builtin_bit_cast(bf16x8_t, w);
        }
#pragma unroll
        for (int nt = 0; nt < 4; ++nt) {
            f32x4 aR = (f32x4){0.f, 0.f, 0.f, 0.f}, aI = aR;
            aR = mfma16(aX[0], bR[nt][0], aR); aR = mfma16(aX[1], bR[nt][1], aR);
            aI = mfma16(aX[0], bI[nt][0], aI); aI = mfma16(aX[1], bI[nt][1], aI);
            float av[4], bv[4];
#pragma unroll
            for (int r = 0; r < 4; ++r) {
                const float rg = __frcp_rn(1.0f + __expf(-(aR[r] + brv[nt]))), ig = __frcp_rn(1.0f + __expf(-(aI[r] + biv[nt])));
                const float a = __expf(splv[nt] * rg);
                av[r] = a; bv[r] = __fsqrt_rn(fmaxf(1.0f - a * a, 0.f)) * (ig * XR[(mt * 16 + 4 * fq + r) * 68 + nt * 16 + fr]);
            }
            float PA[4], PB[4];
            PA[0] = av[0]; PB[0] = bv[0];
#pragma unroll
            for (int r = 1; r < 4; ++r) { PA[r] = av[r] * PA[r - 1]; PB[r] = av[r] * PB[r - 1] + bv[r]; }
            float GA = PA[3], GB = PB[3];
            { const float pa = __shfl_up(GA, 16), pb = __shfl_up(GB, 16); if (fq >= 1) { GB = GA * pb + GB; GA = GA * pa; } }
            { const float pa = __shfl_up(GA, 32), pb = __shfl_up(GB, 32); if (fq >= 2) { GB = GA * pb + GB; GA = GA * pa; } }
            float EA = __shfl_up(GA, 16), EB = __shfl_up(GB, 16);
            if (fq == 0) { EA = 1.f; EB = 0.f; }
            const float h0 = EA * hin[nt] + EB, p0 = pin[nt] * EA;
#pragma unroll
            for (int r = 0; r < 4; ++r) {
                XR[(mt * 16 + 4 * fq + r) * 68 + nt * 16 + fr] = PA[r] * h0 + PB[r]; pkeep[nt][r] = p0 * PA[r];
            }
            const float TA = __shfl(GA, 48 + fr), TB = __shfl(GB, 48 + fr);
            hin[nt] = TA * hin[nt] + TB; pin[nt] = pin[nt] * TA;
        }
#pragma unroll
        for (int q = 0; q < 4; ++q) { const int tok = q * 4 + fq; *(f32x4*)(H + (size_t)(t0 + mt * 16 + tok) * 512 + wave * 64 + fr * 4) = *(const f32x4*)(XR + (mt * 16 + tok) * 68 + fr * 4); }
#pragma unroll
        for (int nt = 0; nt < 4; ++nt)
#pragma unroll
            for (int r = 0; r < 4; ++r) XR[(mt * 16 + 4 * fq + r) * 68 + nt * 16 + fr] = pkeep[nt][r];
#pragma unroll
        for (int q = 0; q < 4; ++q) { const int tok = q * 4 + fq; *(f32x4*)(P + (size_t)(t0 + mt * 16 + tok) * 512 + wave * 64 + fr * 4) = *(const f32x4*)(XR + (mt * 16 + tok) * 68 + fr * 4); }
    }
    if (fq == 0) {
#pragma unroll
        for (int nt = 0; nt < 4; ++nt) { Hend[(size_t)ub * 512 + wave * 64 + nt * 16 + fr] = hin[nt]; Pend[(size_t)ub * 512 + wave * 64 + nt * 16 + fr] = pin[nt]; }
    }
    asm volatile("s_waitcnt lgkmcnt(0)" ::: "memory");
}
__device__ __forceinline__ void lru_carry(const float* __restrict__ Hend, const float* __restrict__ Pend, float* __restrict__ CIN, float* __restrict__ hlast, int bx) {
    int tx_ = threadIdx.x; asm volatile("" : "+v"(tx_));
    const int idx = bx * NTH + tx_, b = idx >> 9, c = idx & 511;
    float carry = 0.f;
#pragma unroll 8
    for (int n = 0; n < 64; ++n) {
        const size_t o = ((size_t)b * 64 + n) * 512 + c;
        CIN[o] = carry;
        carry = Hend[o] + Pend[o] * carry;
    }
    hlast[(size_t)b * 512 + c] = carry;
}

__device__ __forceinline__ unsigned f2key(float f) { const unsigned u = __float_as_uint(f); return u ^ ((u >> 31) ? 0xffffffffu : 0x80000000u); }
__device__ __forceinline__ float key2f(unsigned k) { return __uint_as_float(k ^ ((k >> 31) ? 0x80000000u : 0xffffffffu)); }
#define TK_CE(hi, lo) do { const unsigned a_ = (hi), b_ = (lo); (hi) = a_ > b_ ? a_ : b_; (lo) = a_ > b_ ? b_ : a_; } while (0)
template <int N> __device__ __forceinline__ void bitonic_sort_desc(unsigned (&a)[N]) {
#pragma unroll
    for (int k = 2; k <= N; k <<= 1)
#pragma unroll
        for (int j = k >> 1; j > 0; j >>= 1)
#pragma unroll
            for (int i = 0; i < N; ++i) { const int l = i ^ j; if (l > i) { if ((i & k) == 0) TK_CE(a[i], a[l]); else TK_CE(a[l], a[i]); } }
}
template <int XM> __device__ __forceinline__ void merge_top16(unsigned (&a)[16]) {
    unsigned c[16];
#pragma unroll
    for (int i = 0; i < 16; ++i) {
        unsigned o;
        if (XM == 1) o = (unsigned)__builtin_amdgcn_update_dpp(0, (int)a[15 - i], 0xB1, 0xf, 0xf, false);
        else if (XM == 2) o = (unsigned)__builtin_amdgcn_update_dpp(0, (int)a[15 - i], 0x4E, 0xf, 0xf, false);
        else if (XM == 16) o = __builtin_amdgcn_permlane16_swap(a[15 - i], a[15 - i], false, false)[1];
        else o = __builtin_amdgcn_permlane32_swap(a[15 - i], a[15 - i], false, false)[1];
        c[i] = a[i] > o ? a[i] : o; }
#pragma unroll
    for (int j = 8; j > 0; j >>= 1)
#pragma unroll
        for (int i = 0; i < 16; ++i) { const int l = i ^ j; if (l > i) TK_CE(c[i], c[l]); }
#pragma unroll
    for (int i = 0; i < 16; ++i) a[i] = c[i];
}
constexpr int TK_KS = 0, TK_TS = 2 * 128 * 136 * 2, TK_END = TK_TS + 64 * 2 * 16 * 4;
__device__ __forceinline__ void peer_topk_stage_keys(const bf16* __restrict__ KB, int h, unsigned char* lds) {
    bf16* Ks = (bf16*)(lds + TK_KS);
    for (int ci = threadIdx.x; ci < 2 * 128 * 16; ci += NTH) { const int row = ci >> 4, part = ci & 15;
        *(v4u*)(Ks + row * 136 + part * 8) = *(const v4u*)(KB + ((size_t)h * 256 + row) * 128 + part * 8); }
    __syncthreads();
}
__device__ __forceinline__ void peer_topk_ldq(bf16x8_t (&bq)[4], const bf16* __restrict__ Q, int tile, int h, int tid) {
    const int lane = tid & 63, wave = tid >> 6, fr = lane & 15, fq = lane >> 4, c = wave >> 2, nt = wave & 3;
#pragma unroll
    for (int ks = 0; ks < 4; ++ks) bq[ks] = *(const bf16x8_t*)(Q + (size_t)(tile * 64 + nt * 16 + fr) * 2048 + h * 256 + c * 128 + ks * 32 + 8 * fq);
}
__device__ __forceinline__ void peer_topk4(const bf16* __restrict__ Q, int* __restrict__ EXP, float* __restrict__ GATE, int tile, int h, unsigned char* lds, bf16x8_t (&bq)[4], int tile_next) {
    int tid = threadIdx.x; asm volatile("" : "+v"(tid));
    const int lane = tid & 63, wave = __builtin_amdgcn_readfirstlane(tid >> 6), fr = lane & 15, fq = lane >> 4;
    const bf16* Ks = (const bf16*)(lds + TK_KS); unsigned* Ts = (unsigned*)(lds + TK_TS);
    {
        const int c = wave >> 2, nt = wave & 3;
        unsigned a[32];
#pragma unroll
        for (int mt = 0; mt < 8; ++mt) {
            f32x4 acc = (f32x4){0.f, 0.f, 0.f, 0.f};
#pragma unroll
            for (int ks = 0; ks < 4; ++ks) { const bf16x8_t ak = *(const bf16x8_t*)(Ks + (c * 128 + mt * 16 + fr) * 136 + ks * 32 + 8 * fq); acc = mfma16(ak, bq[ks], acc); }
#pragma unroll
            for (int r = 0; r < 4; ++r) a[mt * 4 + r] = (f2key(acc[r]) & ~127u) | (unsigned)(127 - (mt * 16 + 4 * fq + r));
        }
        if (tile_next >= 0) peer_topk_ldq(bq, Q, tile_next, h, tid);
        bitonic_sort_desc<32>(a);
        unsigned t[16];
#pragma unroll
        for (int j = 0; j < 16; ++j) t[j] = a[j];
        merge_top16<16>(t); merge_top16<32>(t);
        if (fq == 0) {
            const int tk = nt * 16 + fr;
#pragma unroll
            for (int j = 0; j < 16; ++j) Ts[(tk * 2 + c) * 16 + j] = t[j];
        }
    }
    __syncthreads();
    if (tid < 256) {
        const int tk = tid >> 2, q = tid & 3;
        const unsigned* t0 = Ts + (tk * 2 + 0) * 16; const unsigned* t1 = Ts + (tk * 2 + 1) * 16;
        unsigned a[16];
#pragma unroll
        for (int s = 0; s < 13; ++s) {
            const int e = s * 4 + q;
            int i, j;
            if (e < 16) { i = 0; j = e; } else if (e < 24) { i = 1; j = e - 16; } else if (e < 29) { i = 2; j = e - 24; } else if (e < 33) { i = 3; j = e - 29; }
            else if (e < 36) { i = 4; j = e - 33; } else if (e < 42) { i = 5 + ((e - 36) >> 1); j = (e - 36) & 1; } else { i = 8 + (e - 42); j = 0; }
            const bool ok = e < 50;
            const float sum = key2f(t0[ok ? i : 0] & ~127u) + key2f(t1[ok ? j : 0] & ~127u);
            a[s] = ok ? ((f2key(sum) & ~255u) | (unsigned)(255 - (i * 16 + j))) : 0u;
        }
        a[13] = 0u; a[14] = 0u; a[15] = 0u;
        bitonic_sort_desc<16>(a);
        merge_top16<1>(a); merge_top16<2>(a);
        float ev[16], sum = 0.f; const float m = key2f(a[0] & ~255u);
#pragma unroll
        for (int j = 0; j < 16; ++j) { ev[j] = __expf(key2f(a[j] & ~255u) - m); sum += ev[j]; }
        const float inv = 1.0f / sum;
        const size_t o = (size_t)(tile * 64 + tk) * 128 + h * 16;
#pragma unroll
        for (int j = 0; j < 16; ++j)
            if ((j >> 2) == q) {
                const int code = 255 - (int)(a[j] & 255u), i = code >> 4, jj = code & 15;
                const int n0 = 127 - (int)(t0[i] & 127u), n1 = 127 - (int)(t1[jj] & 127u);
                EXP[o + j] = n0 * 128 + n1; GATE[o + j] = ev[j] * inv;
            }
    }
    __syncthreads();
}

constexpr int AT_KS = 0, AT_VT = 192 * 72 * 2, AT_BT = AT_VT + 64 * 200 * 2, AT_PW = AT_BT + 4 * 256 * 4, AT_END = AT_PW + 8 * 32 * 72 * 2;
template <int QS>
__device__ __forceinline__ void attn_core(const bf16* __restrict__ PCb, const float* __restrict__ sinks, bf16* __restrict__ ATT, int kvh, int q0, int tb, int wave, int lane, int fr, int fq,
                                          const bf16* Ks, const bf16* Vt, const float* Bt, bf16* Pw) {
    constexpr int NT0 = QS ? 2 : 0;
    const int g = wave >> 1, hh = kvh * 4 + g; constexpr int qs = QS;
    bf16x8_t aQ[2][2];
#pragma unroll
    for (int mt = 0; mt < 2; ++mt)
#pragma unroll
        for (int ks = 0; ks < 2; ++ks) aQ[mt][ks] = *(const bf16x8_t*)(PCb + (size_t)(tb + q0 + qs + mt * 16 + fr) * CN + hh * 64 + ks * 32 + 8 * fq);
    f32x4 sc[2][12];
#pragma unroll
    for (int nt = NT0; nt < NT0 + 10; ++nt) {
        const bf16x8_t b0 = *(const bf16x8_t*)(Ks + (nt * 16 + fr) * 72 + 8 * fq), b1 = *(const bf16x8_t*)(Ks + (nt * 16 + fr) * 72 + 32 + 8 * fq);
#pragma unroll
        for (int mt = 0; mt < 2; ++mt) { f32x4 a = (f32x4){0.f, 0.f, 0.f, 0.f}; a = mfma16(aQ[mt][0], b0, a); a = mfma16(aQ[mt][1], b1, a); sc[mt][nt] = a; }
    }
    const float sink = sinks[hh] * 1.4426950408889634f;
    const float* bt = Bt + g * 256 + 64;
    float rinv[2][4];
    float kadd[12];
#pragma unroll
    for (int nt = NT0; nt < NT0 + 10; ++nt) kadd[nt] = (q0 - 128 + nt * 16 + fr) >= 0 ? 0.f : -INFINITY;
#pragma unroll
    for (int mt = 0; mt < 2; ++mt)
#pragma unroll
        for (int r = 0; r < 4; ++r) {
            const int qi = qs + mt * 16 + 4 * fq + r;
            float mx = sink;
#pragma unroll
            for (int nt = NT0; nt < NT0 + 10; ++nt) {
                const int kk = nt * 16 + fr, rel = qi + 128 - kk;
                const float lg = (sc[mt][nt][r] * (0.125f * 1.4426950408889634f) + bt[rel]) + kadd[nt];
                sc[mt][nt][r] = lg; mx = fmaxf(mx, lg);
            }
            mx = fmaxf(mx, DPPF(mx, 0xB1, 0xf)); mx = fmaxf(mx, DPPF(mx, 0x4E, 0xf)); mx = fmaxf(mx, DPPF(mx, 0x141, 0xf)); mx = fmaxf(mx, DPPF(mx, 0x140, 0xf));
            float sum = 0.f;
#pragma unroll
            for (int nt = NT0; nt < NT0 + 10; ++nt) { const float p = __builtin_amdgcn_exp2f(sc[mt][nt][r] - mx); sc[mt][nt][r] = p; sum += p; }
            sum += DPPF(sum, 0xB1, 0xf); sum += DPPF(sum, 0x4E, 0xf); sum += DPPF(sum, 0x141, 0xf); sum += DPPF(sum, 0x140, 0xf);
            rinv[mt][r] = 1.0f / (sum + __builtin_amdgcn_exp2f(sink - mx));
        }
    f32x4 oacc[2][4];
#pragma unroll
    for (int mt = 0; mt < 2; ++mt)
#pragma unroll
        for (int dt = 0; dt < 4; ++dt) oacc[mt][dt] = (f32x4){0.f, 0.f, 0.f, 0.f};
#pragma unroll
    for (int kc = 0; kc < 3; ++kc) {
#pragma unroll
        for (int mt = 0; mt < 2; ++mt)
#pragma unroll
            for (int n4 = 0; n4 < 4; ++n4)
#pragma unroll
                for (int r = 0; r < 4; ++r) if (kc * 4 + n4 >= NT0 && kc * 4 + n4 < NT0 + 10) Pw[(mt * 16 + 4 * fq + r) * 72 + n4 * 16 + fr] = (bf16)f2bf(sc[mt][kc * 4 + n4][r]);
        asm volatile("s_waitcnt lgkmcnt(0)" ::: "memory");
#pragma unroll
        for (int ks = 0; ks < 2; ++ks) {
            if (kc * 4 + ks * 2 < NT0 || kc * 4 + ks * 2 >= NT0 + 10) continue;
            const bf16x8_t p0 = *(const bf16x8_t*)(Pw + fr * 72 + ks * 32 + 8 * fq), p1 = *(const bf16x8_t*)(Pw + (16 + fr) * 72 + ks * 32 + 8 * fq);
#pragma unroll
            for (int dt = 0; dt < 4; ++dt) {
                const bf16x8_t bv = *(const bf16x8_t*)(Vt + (dt * 16 + fr) * 200 + kc * 64 + ks * 32 + 8 * fq);
                oacc[0][dt] = mfma16(p0, bv, oacc[0][dt]); oacc[1][dt] = mfma16(p1, bv, oacc[1][dt]);
            }
        }
        asm volatile("s_waitcnt lgkmcnt(0)" ::: "memory");
    }
#pragma unroll
    for (int mt = 0; mt < 2; ++mt)
#pragma unroll
        for (int dt = 0; dt < 4; ++dt)
#pragma unroll
            for (int r = 0; r < 4; ++r) Pw[(mt * 16 + 4 * fq + r) * 72 + dt * 16 + fr] = (bf16)f2bf(oacc[mt][dt][r] * rinv[mt][r]);
    asm volatile("s_waitcnt lgkmcnt(0)" ::: "memory");
#pragma unroll
    for (int k = 0; k < 4; ++k) {
        const int ci = lane + 64 * k, row = ci >> 3, part = ci & 7;
        *(v4u*)(ATT + (size_t)(tb + q0 + qs + row) * D + hh * 64 + part * 8) = *(const v4u*)(Pw + row * 72 + part * 8);
    }
}
__device__ __forceinline__ void attn_unit(const bf16* __restrict__ PCb, const float* __restrict__ rel_bias, const float* __restrict__ sinks, bf16* __restrict__ ATT, int un, unsigned char* lds) {
    int tid = threadIdx.x; asm volatile("" : "+v"(tid));
    const int lane = tid & 63, wave = __builtin_amdgcn_readfirstlane(tid >> 6), fr = lane & 15, fq = lane >> 4;
    const int kvh = un & 3, qblk = (un >> 2) & 63, b = un >> 8;
    const int q0 = qblk * 64, tb = b * SEQ;
    bf16* Ks = (bf16*)(lds + AT_KS); bf16* Vt = (bf16*)(lds + AT_VT); float* Bt = (float*)(lds + AT_BT); bf16* Pw = (bf16*)(lds + AT_PW) + wave * 32 * 72;
#pragma unroll
    for (int k = 0; k < 3; ++k) {
        const int ci = tid + 512 * k, row = ci >> 3, part = ci & 7, kpos = q0 - 128 + row;
        v4u kv = (v4u){0u, 0u, 0u, 0u}, vv = kv;
        if (kpos >= 0) { const bf16* src = PCb + (size_t)(tb + kpos) * CN + kvh * 64 + part * 8; kv = *(const v4u*)(src + 1024); vv = *(const v4u*)(src + 1280); }
        *(v4u*)(Ks + row * 72 + part * 8) = kv;
        bf16* vd = Vt + (part * 8) * 200 + row;
        vd[0 * 200] = (bf16)(vv.x & 0xffffu); vd[1 * 200] = (bf16)(vv.x >> 16); vd[2 * 200] = (bf16)(vv.y & 0xffffu); vd[3 * 200] = (bf16)(vv.y >> 16);
        vd[4 * 200] = (bf16)(vv.z & 0xffffu); vd[5 * 200] = (bf16)(vv.z >> 16); vd[6 * 200] = (bf16)(vv.w & 0xffffu); vd[7 * 200] = (bf16)(vv.w >> 16);
    }
#pragma unroll
    for (int k = 0; k < 2; ++k) { const int idx = tid + 512 * k, g_ = idx >> 8, rel = (idx & 255) - 64;
        Bt[idx] = (rel >= 0 && rel < 128) ? rel_bias[t5_bucket(rel) * 16 + kvh * 4 + g_] * 1.4426950408889634f : -INFINITY; }
    __syncthreads();
    if (wave & 1) attn_core<32>(PCb, sinks, ATT, kvh, q0, tb, wave, lane, fr, fq, Ks, Vt, Bt, Pw);
    else attn_core<0>(PCb, sinks, ATT, kvh, q0, tb, wave, lane, fr, fq, Ks, Vt, Bt, Pw);
    __syncthreads();
}

__device__ __forceinline__ void swa_attn_sample(const bf16* __restrict__ PCb, const float* __restrict__ cache_k, const float* __restrict__ cache_v,
                                                const float* __restrict__ rel_bias, const float* __restrict__ sinks, bf16* __restrict__ ATT, int gw, int lane) {
    const int sb = gw >> 4, h = gw & 15, kvh = h >> 2, t = NP + sb;
    const bf16* qrow = PCb + (size_t)t * CN + h * 64;
    float lg[2];
#pragma unroll
    for (int rr = 0; rr < 2; ++rr) {
        const int r = lane + 64 * rr;
        float dot = 0.f;
        if (r == 0) {
            const bf16* krow = PCb + (size_t)t * CN + 1024 + kvh * 64;
            for (int d = 0; d < 64; ++d) dot += bf2f(qrow[d]) * bf2f(krow[d]);
        } else {
            const float* krow = cache_k + (((size_t)sb * 128 + (128 - r)) * 4 + kvh) * 64;
#pragma unroll
            for (int d4 = 0; d4 < 16; ++d4) { const float4 kv = *(const float4*)(krow + d4 * 4);
                dot += bf2f(qrow[d4 * 4]) * kv.x + bf2f(qrow[d4 * 4 + 1]) * kv.y + bf2f(qrow[d4 * 4 + 2]) * kv.z + bf2f(qrow[d4 * 4 + 3]) * kv.w; }
        }
        lg[rr] = dot * 0.125f + rel_bias[t5_bucket(r) * 16 + h];
    }
    const float sink = sinks[h];
    const float m = fmaxf(wave_max(fmaxf(lg[0], lg[1])), sink);
    float p[2] = {expf(lg[0] - m), expf(lg[1] - m)};
    const float inv = 1.0f / (wave_sum(p[0] + p[1]) + expf(sink - m));
    float o = 0.f;
#pragma unroll
    for (int rr = 0; rr < 2; ++rr)
#pragma unroll 1
        for (int lb = 0; lb < 64; lb += 16) {
            float vv[16];
#pragma unroll
            for (int k = 0; k < 16; ++k) { const int r = lb + k + 64 * rr;
                vv[k] = (r == 0) ? bf2f(PCb[(size_t)t * CN + 1280 + kvh * 64 + lane]) : cache_v[(((size_t)sb * 128 + (128 - r)) * 4 + kvh) * 64 + lane]; }
#pragma unroll
            for (int k = 0; k < 16; ++k) o += __shfl(p[rr], lb + k) * vv[k];
        }
    ATT[(size_t)t * D + h * 64 + lane] = (bf16)f2bf(o * inv);
}
__device__ __forceinline__ void swa_cache_shift(const float* __restrict__ cache_k, const float* __restrict__ cache_v, float* __restrict__ sk, float* __restrict__ sv, int item) {
    int tid = threadIdx.x; asm volatile("" : "+v"(tid));
    const int sb = item >> 1, isv = item & 1;
    const f32x4* src = (const f32x4*)((isv ? cache_v : cache_k) + ((size_t)sb * 128 + 1) * 256);
    f32x4* dst = (f32x4*)((isv ? sv : sk) + (size_t)sb * 128 * 256);
    f32x4 v[16];
#pragma unroll
    for (int k = 0; k < 16; ++k) { const int i = tid + NTH * k; if (i < 127 * 64) v[k] = src[i]; }
#pragma unroll
    for (int k = 0; k < 16; ++k) { const int i = tid + NTH * k; if (i < 127 * 64) dst[i] = v[k]; }
}
__device__ __forceinline__ void swa_kv_out3(const bf16* __restrict__ PCb, const float* __restrict__ cache_k, const float* __restrict__ cache_v,
                                            float* __restrict__ pk, float* __restrict__ pv, float* __restrict__ sk, float* __restrict__ sv, int item) {
    int tid = threadIdx.x; asm volatile("" : "+v"(tid));
    if (item < 256) {
        const int sb = item >> 1, isv = item & 1;
        const f32x4* src = (const f32x4*)((isv ? cache_v : cache_k) + ((size_t)sb * 128 + 1) * 256);
        f32x4* dst = (f32x4*)((isv ? sv : sk) + (size_t)sb * 128 * 256);
        (void)src;
        if (tid < 32) {
            const v4u w = *(const v4u*)(PCb + (size_t)(NP + sb) * CN + 1024 + isv * 256 + tid * 8);
            f32x4* d = dst + 127 * 64 + tid * 2;
            d[0] = (f32x4){bflo(w.x), bfhi(w.x), bflo(w.y), bfhi(w.y)}; d[1] = (f32x4){bflo(w.z), bfhi(w.z), bflo(w.w), bfhi(w.w)};
        }
    } else {
        const int b = item - 256;
#pragma unroll 4
        for (int e = tid; e < 128 * 64; e += NTH) {
            const int row = e >> 6, part = e & 63;
            const v4u w = *(const v4u*)(PCb + (size_t)(b * SEQ + SEQ - 128 + row) * CN + 1024 + part * 8);
            f32x4* d = (f32x4*)((part < 32 ? pk : pv) + ((size_t)b * 128 + row) * 256 + (part & 31) * 8);
            d[0] = (f32x4){bflo(w.x), bfhi(w.x), bflo(w.y), bfhi(w.y)}; d[1] = (f32x4){bflo(w.z), bfhi(w.z), bflo(w.w), bfhi(w.w)};
        }
    }
}


constexpr int PC_STRIDE = 1040, PC_RED = 80 * PC_STRIDE;
template <class StoreF>
__device__ __forceinline__ void gemm_piece80(const bf16* __restrict__ arows, const bf16* __restrict__ brows, unsigned char* lds, const StoreF& store) {
    int tid = threadIdx.x; asm volatile("" : "+v"(tid));
    const int lane = tid & 63, wave = __builtin_amdgcn_readfirstlane(tid >> 6), fr = lane & 15, fq = lane >> 4;
    const int rsel = tid >> 6, ch = tid & 63, nt = wave & 3, kq = wave >> 2;
    v4u st[2][10];
#pragma unroll
    for (int h = 0; h < 2; ++h)
#pragma unroll
        for (int r = 0; r < 10; ++r) {
            const bf16* src = (r < 2 ? arows + (size_t)(r * 8 + rsel) * D : brows + (size_t)(r * 8 + rsel - 16) * D) + h * 512 + ch * 8;
            st[h][r] = *(const v4u*)src;
        }
    f32x4 acc = (f32x4){0.f, 0.f, 0.f, 0.f};
#pragma unroll
    for (int h = 0; h < 2; ++h) {
        if (h) __syncthreads();
#pragma unroll
        for (int r = 0; r < 10; ++r) *(v4u*)(lds + (r * 8 + rsel) * PC_STRIDE + ch * 16) = st[h][r];
        __syncthreads();
#pragma unroll
        for (int ks = 0; ks < 8; ++ks) {
            const bf16x8_t a = *(const bf16x8_t*)(lds + fr * PC_STRIDE + (kq * 256 + ks * 32 + 8 * fq) * 2);
            const bf16x8_t b = *(const bf16x8_t*)(lds + (16 + nt * 16 + fr) * PC_STRIDE + (kq * 256 + ks * 32 + 8 * fq) * 2);
            acc = mfma16(a, b, acc);
        }
    }
    f32x4* part = (f32x4*)(lds + PC_RED);
    if (kq == 1) part[nt * 64 + lane] = acc;
    __syncthreads();
    if (kq == 0) { acc = acc + part[nt * 64 + lane]; store(acc, nt, fr, fq); }
}
__device__ __forceinline__ void sample_gemm_piece(const bf16* __restrict__ A, const bf16* __restrict__ Bt, const float* __restrict__ bias, bf16* __restrict__ O, int ldc, int p, unsigned char* lds) {
    const int mt = p & 7, cb = p >> 3;
    gemm_piece80(A + (size_t)(NP + mt * 16) * D, Bt + (size_t)(cb * 64) * D, lds, [&](const f32x4& acc, int nt, int fr, int fq) {
        const int col = cb * 64 + nt * 16 + fr; const float bv = bias ? bias[col] : 0.f;
#pragma unroll
        for (int r = 0; r < 4; ++r) O[(size_t)(NP + mt * 16 + 4 * fq + r) * ldc + col] = (bf16)f2bf(acc[r] + bv);
    });
}
__device__ __forceinline__ void ab_cols_piece(const bf16* __restrict__ A, const bf16* __restrict__ Bt, bf16* __restrict__ O, int tg, unsigned char* lds) {
    gemm_piece80(Bt + (size_t)ABMAIN * D, A + (size_t)(tg * 64) * D, lds, [&](const f32x4& acc, int nt, int fr, int fq) {
        if (fq < 2) { uint2 o; o.x = pk2(acc[0], acc[1]); o.y = pk2(acc[2], acc[3]); *(uint2*)(O + (size_t)(tg * 64 + nt * 16 + fr) * ABN + ABMAIN + 4 * fq) = o; }
    });
}

constexpr size_t MiB = 1u << 20;
constexpr size_t WS_CTL = 0, CTL_ZERO_BYTES = 64 * 1024;
constexpr size_t WS_WAB = 1 * MiB;
constexpr size_t WS_WOUT = WS_WAB + (size_t)ABNP * D * 2;
constexpr size_t WS_WQ0 = WS_WOUT + (size_t)D * D * 2;
constexpr size_t WS_WQ1 = WS_WQ0 + (size_t)2048 * D * 2;
constexpr size_t WS_WINC = WS_WQ1 + (size_t)2048 * D * 2;
constexpr size_t WS_WOUTC = WS_WINC + (size_t)CN * D * 2;
constexpr size_t WS_ABUF = WS_WOUTC + (size_t)D * D * 2;
constexpr size_t WS_P = WS_ABUF + (size_t)MP * D * 2;
constexpr size_t WS_T = WS_P + (size_t)MP * ABN * 2;
constexpr size_t WS_Q = WS_T + (size_t)4 * 16384 * D + (size_t)4 * 16384 * 4;
constexpr size_t WS_A = WS_Q + (size_t)MP * 1536 * 4;
constexpr size_t WS_B = WS_A + (size_t)MP * 512 * 4;
constexpr size_t WS_O = WS_B + (size_t)MP * 512 * 4;
constexpr size_t WS_X1 = WS_O + (size_t)MP * 512 * 4;
constexpr size_t WS_G = WS_X1 + (size_t)MP * D * 4;
constexpr size_t WS_BETA = WS_G + (size_t)MP * 4 * 4;
constexpr size_t WS_GATE = WS_BETA + (size_t)MP * 4 * 4;
constexpr size_t WS_EXP = WS_GATE + (size_t)MP * 128 * 4;
constexpr size_t WS_HEND = WS_EXP + (size_t)MP * 128 * 4;
constexpr size_t WS_KEYS = WS_HEND + (size_t)3 * 4 * 64 * 512 * 4;
constexpr size_t WS_WGT = WS_KEYS + (size_t)2 * 8 * 2 * 128 * 128 * 2;
constexpr size_t WS_END = WS_WGT + (size_t)2 * 8 * 64 * 64 * 2;
constexpr size_t Q_QKVS = 0, Q_W = 1 * MiB, Q_QG = Q_W + 16 * MiB, Q_KDT = Q_QG + 16 * MiB, Q_UT = Q_KDT + 16 * MiB, Q_QK = Q_UT + 16 * MiB, Q_EGL = Q_QK + 8 * MiB, Q_END = Q_EGL + 4096;
static_assert(Q_END <= (size_t)MP * 1536 * 4, "region Q");
static_assert(WS_END <= 512 * MiB, "d_ws map");

struct MegaArgs {
    const float* in[35];
    float* out;
    unsigned char* ws;
};

__global__ void __launch_bounds__(NTH, 2) fwd_megakernel(MegaArgs ma) {
    cg::grid_group grid = cg::this_grid();
    extern __shared__ __attribute__((aligned(16))) unsigned char lds[];
    float* smem = (float*)lds;
    const int nb = gridDim.x, b0 = blockIdx.x, wave = __builtin_amdgcn_readfirstlane(threadIdx.x >> 6);
    int tid = threadIdx.x, lane = tid & 63;
    const float* x_prompt = ma.in[0];
    const float* x_sample = ma.in[1];
    const float* state_gdn = ma.in[2];
    const float* state_gdn_conv = ma.in[3];
    const float* state_lru = ma.in[4];
    const float* state_lru_conv = ma.in[5];
    const float* cache_k = ma.in[6];
    const float* cache_v = ma.in[7];
    const float* w_in_ab = ma.in[8];
    const float* gdn_conv_w = ma.in[9];
    const float* gdn_a_log = ma.in[10];
    const float* gdn_dt_bias = ma.in[11];
    const float* gdn_norm_w = ma.in[12];
    const float* lru_conv_w = ma.in[13];
    const float* lru_conv_b = ma.in[14];
    const float* lru_w_r = ma.in[15];
    const float* lru_b_r = ma.in[16];
    const float* lru_w_i = ma.in[17];
    const float* lru_b_i = ma.in[18];
    const float* lru_lam = ma.in[19];
    const float* w_out_ab = ma.in[20];
    const float* w_in_c = ma.in[21];
    const float* b_in_c = ma.in[22];
    const float* swa_sinks = ma.in[23];
    const float* w_out_c = ma.in[24];
    const float* b_out_c = ma.in[25];
    const float* rel_bias = ma.in[26];
    const float* ln_mix_g = ma.in[27];
    const float* ln_mix_b = ma.in[28];
    const float* ln_ffn_g = ma.in[29];
    const float* ln_ffn_b = ma.in[30];
    const float* peer_w_q = ma.in[31];
    const float* peer_keys = ma.in[32];
    const float* peer_u = ma.in[33];
    const float* peer_v = ma.in[34];

    float* out = ma.out;
    float* o_y = out;
    float* o_p_gdn = out + (size_t)NT * D;
    float* o_p_gdn_conv = o_p_gdn + 262144;
    float* o_p_lru = o_p_gdn_conv + 18432;
    float* o_p_lru_conv = o_p_lru + 2048;
    float* o_p_k = o_p_lru_conv + 6144;
    float* o_p_v = o_p_k + 131072;
    float* o_s_gdn = o_p_v + 131072;
    float* o_s_gdn_conv = o_s_gdn + 8388608;
    float* o_s_lru = o_s_gdn_conv + 589824;
    float* o_s_lru_conv = o_s_lru + 65536;
    float* o_s_k = o_s_lru_conv + 196608;
    float* o_s_v = o_s_k + 4194304;

    unsigned char* ws = ma.ws;
    bf16* WAB_T = (bf16*)(ws + WS_WAB); bf16* WOUT_T = (bf16*)(ws + WS_WOUT); bf16* WQ0_T = (bf16*)(ws + WS_WQ0); bf16* WQ1_T = (bf16*)(ws + WS_WQ1);
    bf16* WINC_T = (bf16*)(ws + WS_WINC); bf16* WOUTC_T = (bf16*)(ws + WS_WOUTC);
    bf16* ABUF = (bf16*)(ws + WS_ABUF);
    bf16* PROJ = (bf16*)(ws + WS_P); float* Y = (float*)(ws + WS_P); bf16* Qb = (bf16*)(ws + WS_P); bf16* PCb = (bf16*)(ws + WS_P); float* Y1 = (float*)(ws + WS_P);
    unsigned char* TAB8 = ws + WS_T; float* TSC = (float*)(ws + WS_T + (size_t)4 * 16384 * D);
    float* R_Q = (float*)(ws + WS_Q + Q_QKVS) - (size_t)NP * 1536; float* X2 = (float*)(ws + WS_A);
    GdnChunkBufs cbuf; cbuf.W = (bf16*)(ws + WS_Q + Q_W); cbuf.QG = (bf16*)(ws + WS_Q + Q_QG); cbuf.KDT = (bf16*)(ws + WS_Q + Q_KDT); cbuf.UT = (bf16*)(ws + WS_Q + Q_UT); cbuf.QK = (bf16*)(ws + WS_Q + Q_QK); cbuf.EGL = (float*)(ws + WS_Q + Q_EGL);
    bf16* Yb = (bf16*)(ws + WS_P);
    float* OUTS = (float*)(ws + WS_Q);
    float* PD = (float*)(ws + WS_P);
    bf16* KEYSB = (bf16*)(ws + WS_KEYS); bf16* WRT = (bf16*)(ws + WS_WGT); bf16* WIT = WRT + 8 * 64 * 64;
    float* HEND = (float*)(ws + WS_HEND); float* PEND = HEND + 4 * 64 * 512; float* CIN = PEND + 4 * 64 * 512;
    float* R_A = (float*)(ws + WS_A); float* R_B = (float*)(ws + WS_B); float* R_O = (float*)(ws + WS_O);
    bf16* ATTB = (bf16*)(ws + WS_X1);
    float* R_G = (float*)(ws + WS_G); float* R_BETA = (float*)(ws + WS_BETA); float* R_GATE = (float*)(ws + WS_GATE); int* R_EXP = (int*)(ws + WS_EXP);

    for (int u = tid; u < (LDS_BYTES - RING_BYTES) / 4; u += NTH) ((unsigned*)(lds + RING_BYTES))[u] = 0u;
    __syncthreads();
    XcdBarrier bar = xcd_barrier_post((unsigned*)(ws + WS_CTL), (volatile LAS unsigned*)((LAS unsigned char*)lds + MISC_OFF) + 8);
#define GRID_BAR() do { xcd_barrier(bar); asm volatile("" : "+v"(tid)); lane = tid & 63; } while (0)
#define PHASE_LOOP(n) for (int vb = b0; vb < (n); vb += nb)
#define PHASE_END __syncthreads()
#define GEMM_PHASE_M(Mrows, EPI, Aptr, Btptr, Nn, ...) do { pg8::Gemm g_{(const pg8::bf16_t*)(Aptr), (const pg8::bf16_t*)(Btptr), (Mrows), (Nn), D}; pg8::StaticOrder S_; S_.init((Mrows), (Nn), nb, b0); \
        pg8::EPI E_{__VA_ARGS__}; pg8::gemm_phase<pg8::EPI, pg8::StaticOrder, true, true>((PG8_LAS unsigned char*)lds, g_, S_, E_); } while (0)
#define GEMM_PHASE(EPI, Aptr, Btptr, Nn, ...) GEMM_PHASE_M(MP, EPI, Aptr, Btptr, Nn, __VA_ARGS__)
#define GEMM_PHASE_SPLIT(Aptr, Btptr, Nn, Optr, biasptr) do { GEMM_PHASE_M(NP, EpiStoreBf16, Aptr, Btptr, Nn, Optr, Nn, biasptr, NP, Nn); \
          \
        for (int j_ = b0 >> 3; (b0 & 7) + 8 * (j_ >> 3) < (Nn) / 64; j_ += nb >> 3) sample_gemm_piece(Aptr, Btptr, biasptr, Optr, Nn, (j_ & 7) | (((b0 & 7) + 8 * (j_ >> 3)) << 3), lds); } while (0)

    {
        float* scr = smem + wave * 4096;
        const int gw = b0 * NWAVES + wave, NGW = nb * NWAVES;
        constexpr int I_AB = 16 * 97, I_OUT = 16 * 32, I_Q = 16 * 64, I_INC = 16 * 48;
        constexpr int NITEMS = I_AB + I_OUT + 2 * I_Q + I_INC + I_OUT;
        for (int it = gw; it < I_AB; it += NGW) p0_transpose_item<true>(w_in_ab, D, ABN, WAB_T, scr, it, lane);
        for (int it = b0 * NTH + tid; it < 2 * 8 * 64 * 8; it += nb * NTH) {
            const int gsel = it >> 12, nn = (it >> 9) & 7, dd = (it >> 3) & 63, c8 = (it & 7) * 8;
            const float* wsrc = (gsel ? lru_w_i : lru_w_r) + ((size_t)nn * 64 + c8) * 64 + dd;
            v4u o; o.x = pk2(wsrc[0], wsrc[64]); o.y = pk2(wsrc[128], wsrc[192]); o.z = pk2(wsrc[256], wsrc[320]); o.w = pk2(wsrc[384], wsrc[448]);
            *(v4u*)((gsel ? WIT : WRT) + ((size_t)nn * 64 + dd) * 64 + c8) = o;
        }
        for (int kb = 0; kb < NP / 2048; kb += 4) {
            f32x4 v4_[4][4];
#pragma unroll
            for (int i = 0; i < 4; ++i)
#pragma unroll
                for (int j = 0; j < 4; ++j) v4_[i][j] = ((const f32x4*)(x_prompt + (size_t)(gw + (kb + i) * 2048) * D))[lane + 64 * j];
#pragma unroll
            for (int i = 0; i < 4; ++i)
#pragma unroll
                for (int j = 0; j < 4; ++j) { v2u o; o.x = pk2(v4_[i][j].x, v4_[i][j].y); o.y = pk2(v4_[i][j].z, v4_[i][j].w); ((v2u*)(ABUF + (size_t)(gw + (kb + i) * 2048) * D))[lane + 64 * j] = o; }
        }
        for (int m = NP + gw; m < MP + (ABNP - 97 * 32); m += NGW) {
            if (m < MP) row_to_bf16(m < NP ? x_prompt + (size_t)m * D : (m < NT ? x_sample + (size_t)(m - NP) * D : nullptr), ABUF + (size_t)m * D, lane);
            else row_to_bf16(nullptr, WAB_T + (size_t)(97 * 32 + (m - MP)) * D, lane);
        }
    }
    GRID_BAR();
    if (ma.out == nullptr) grid.sync();
    GEMM_PHASE(EpiStoreBf16, ABUF, WAB_T, ABNP, PROJ, ABN, nullptr, NT, ABN);
    GRID_BAR();
    ConvJob cjob; cjob.u0 = peer_u; cjob.v0 = peer_v; cjob.tab = TAB8; cjob.tsc = TSC;
    constexpr int NSPLIT = 32, A_LRU = 4 * NSPLIT, A_GDN = 16 * NSPLIT, B_LRU = 4 * (64 - NSPLIT), B_GDN = 16 * (64 - NSPLIT);
    { AbPrepArgs pa;
      pa.PROJ = PROJ; pa.st_gdn_conv = state_gdn_conv; pa.st_lru_conv = state_lru_conv;
      pa.gdn_conv_w = gdn_conv_w; pa.a_log = gdn_a_log; pa.dt_bias = gdn_dt_bias;
      pa.lru_conv_w = lru_conv_w; pa.lru_conv_b = lru_conv_b; pa.w_r = lru_w_r; pa.b_r = lru_b_r; pa.w_i = lru_w_i; pa.b_i = lru_b_i; pa.lam = lru_lam;
      pa.QKV = R_Q; pa.G = R_G; pa.BETA = R_BETA; pa.LA = R_A; pa.LB = R_B;
      pa.p_gdn_conv = o_p_gdn_conv; pa.p_lru_conv = o_p_lru_conv; pa.s_gdn_conv = o_s_gdn_conv; pa.s_lru_conv = o_s_lru_conv;
      for (int v = b0; v < A_LRU + NS + A_GDN; v += nb) {
          if (v < A_LRU) { lru_prep_unit2(PROJ, lru_conv_w, lru_conv_b, WRT, WIT, lru_b_r, lru_b_i, lru_lam, R_B, R_A, HEND, PEND, o_p_lru_conv, (v / NSPLIT) * 64 + (v % NSPLIT), lds); PHASE_END; }
          else if (v < A_LRU + NS) { ab_prep(pa, NP + (v - A_LRU), smem); PHASE_END; }
          else { const int i = v - A_LRU - NS, h_ = i & 3, n_ = (i >> 2) % NSPLIT, b_ = (i >> 2) / NSPLIT;
                 gdn_prep_unit(PROJ, gdn_conv_w, gdn_a_log, gdn_dt_bias, cbuf, o_p_gdn_conv, (b_ * 64 + n_) * 4 + h_, lds, cjob); }
      } }
    GRID_BAR();
    f32x4 seqS[2]; int seqcur = 0;
    const int seq_p = (b0 & 7) + 8 * (b0 >> 5), seq_s = (b0 >> 3) & 3;
    if (b0 < 64) {
        gdn_seq<0, NSPLIT>(cbuf, R_O, o_p_gdn, seq_p >> 2, seq_p & 3, seq_s, lds, seqS, seqcur);
        table_rows_convert<false>(peer_u + (size_t)16384 * D, TAB8 + (size_t)2 * 16384 * D, TSC + 2 * 16384, 0, 16384, b0 * NWAVES + wave, 64 * NWAVES, lane);
    }
    else for (int v = b0 - 64; v < B_LRU + B_GDN; v += nb - 64) {
        if (v < B_LRU) { lru_prep_unit2(PROJ, lru_conv_w, lru_conv_b, WRT, WIT, lru_b_r, lru_b_i, lru_lam, R_B, R_A, HEND, PEND, o_p_lru_conv, (v / (64 - NSPLIT)) * 64 + NSPLIT + (v % (64 - NSPLIT)), lds); PHASE_END; }
        else { const int i = v - B_LRU, h_ = i & 3, n_ = NSPLIT + (i >> 2) % (64 - NSPLIT), b_ = (i >> 2) / (64 - NSPLIT);
               gdn_prep_unit(PROJ, gdn_conv_w, gdn_a_log, gdn_dt_bias, cbuf, o_p_gdn_conv, (b_ * 64 + n_) * 4 + h_, lds, cjob); }
    }
    GRID_BAR();
    if (b0 < 64) gdn_seq<NSPLIT, 64>(cbuf, R_O, o_p_gdn, seq_p >> 2, seq_p & 3, seq_s, lds, seqS, seqcur);
    else if (b0 < 68) lru_carry(HEND, PEND, CIN, o_p_lru, b0 - 64);
    else {
        for (int v = (b0 - 68) * NWAVES + wave; v < NS * 4 * 8; v += (nb - 68) * NWAVES) gdn_step_sample_w(R_Q, R_G, R_BETA, state_gdn, R_O, o_s_gdn, v, lane);
        for (int v = b0 - 68; v < 128; v += nb - 68) lru_scan(R_A, R_B, state_lru, o_s_lru, NP, 1, NS, v);
        const int gw2 = (b0 - 68) * NWAVES + wave, NGW2 = (nb - 68) * NWAVES;
        for (int m = gw2; m < 512; m += NGW2) row_to_bf16(peer_keys + (size_t)m * D, KEYSB + (size_t)m * D, lane);
        for (int v = b0 - 68; v < 256; v += nb - 68) swa_cache_shift(cache_k, cache_v, o_s_k, o_s_v, v);
        {
            constexpr int I_OUT = 16 * 32, I_Q = 16 * 64, I_INC = 16 * 48;
            float* scr = smem + wave * 4096;
            for (int it = gw2; it < I_OUT + 2 * I_Q + I_INC + I_OUT; it += NGW2) {
                int r = it;
                if (r < I_OUT) { p0_transpose_item(w_out_ab, D, D, WOUT_T, scr, r, lane); continue; } r -= I_OUT;
                if (r < I_Q) { p0_transpose_item(peer_w_q, D, 2048, WQ0_T, scr, r, lane); continue; } r -= I_Q;
                if (r < I_Q) { p0_transpose_item(peer_w_q + (size_t)D * 2048, D, 2048, WQ1_T, scr, r, lane); continue; } r -= I_Q;
                if (r < I_INC) { p0_transpose_item(w_in_c, D, CN, WINC_T, scr, r, lane); continue; } r -= I_INC;
                p0_transpose_item(w_out_c, D, D, WOUTC_T, scr, r, lane);
            }
        }
        table_rows_convert<true>(peer_v + (size_t)16384 * D, TAB8 + (size_t)3 * 16384 * D, TSC + 3 * 16384, 0, 16384, gw2, NGW2, lane);
    }
    GRID_BAR();
    PHASE_LOOP(NT / 8) { ab_mix_w(PROJ, R_O, R_B, R_A, CIN, gdn_norm_w, ABUF, vb * 8 + wave, lane); }
    GRID_BAR();
    GEMM_PHASE_SPLIT(ABUF, WOUT_T, D, Yb, (const float*)nullptr);
    GRID_BAR();
    PHASE_LOOP(NT / 8) { const int t = vb * 8 + wave;
        ln_res_w<false>(t < NP ? x_prompt + (size_t)t * D : x_sample + (size_t)(t - NP) * D, Yb + (size_t)t * D, ln_mix_g, ln_mix_b, ABUF + (size_t)t * D, lane); }
    GRID_BAR();
    GEMM_PHASE_SPLIT(ABUF, WQ0_T, 2048, Qb, (const float*)nullptr);
    GRID_BAR();
    { bf16x8_t tq_[4]; if (b0 < (NT / 64) * 8) peer_topk_ldq(tq_, Qb, b0 >> 3, b0 & 7, tid);
      if ((nb & 7) == 0) { peer_topk_stage_keys(KEYSB, b0 & 7, lds); PHASE_LOOP((NT / 64) * 8) { peer_topk4(Qb, R_EXP, R_GATE, vb >> 3, vb & 7, lds, tq_, vb + nb < (NT / 64) * 8 ? (vb + nb) >> 3 : -1); } }
      else PHASE_LOOP((NT / 64) * 8) { peer_topk_stage_keys(KEYSB, vb & 7, lds); peer_topk_ldq(tq_, Qb, vb >> 3, vb & 7, tid); peer_topk4(Qb, R_EXP, R_GATE, vb >> 3, vb & 7, lds, tq_, -1); } }
    GRID_BAR();
    asm volatile("" : "+v"(tid)); lane = tid & 63;
    { const int x = b0 & 7, tg0 = b0 >> 3, tgstep = nb >> 3, nit = (NT / 8 - tg0 + tgstep - 1) / tgstep;
      peer_u_loop(ABUF, R_EXP, TAB8 + (size_t)x * 16384 * 128, PD + (size_t)x * NT * 128, x, tg0, tgstep, nit, wave, lane); }
    GRID_BAR();
    PHASE_LOOP(NT / 8) { const int t = vb * 8 + wave; peer_xk(R_EXP + (size_t)t * 128, R_GATE + (size_t)t * 128, PD + (size_t)t * 128, TSC, TSC + 16384, lane); }
    GRID_BAR();
    { const int x = b0 & 7, tg0 = b0 >> 3, tgstep = nb >> 3, nit = (NT / 8 - tg0 + tgstep - 1) / tgstep;
      peer_v_loop(R_EXP, R_GATE, TAB8 + (size_t)16384 * D + (size_t)x * 16384 * 128, OUTS, x, tg0, tgstep, nit, wave, lane); }
    GRID_BAR();
    PHASE_LOOP(NT / 8) { const int t = vb * 8 + wave; peer_xc(ABUF + (size_t)t * D, OUTS + (size_t)t * D, ln_ffn_g, ln_ffn_b, nullptr, ABUF + (size_t)t * D, nullptr, lane); }
    GRID_BAR();

    GEMM_PHASE(EpiStoreBf16, ABUF, WINC_T, CN, PCb, CN, b_in_c, NT, CN);
    GRID_BAR();
    PHASE_LOOP(1024 + 256 + 260) {
        if (vb < 1024) attn_unit(PCb, rel_bias, swa_sinks, ATTB, vb, lds);
        else if (vb < 1280) swa_attn_sample(PCb, cache_k, cache_v, rel_bias, swa_sinks, ATTB, (vb - 1024) * 8 + wave, lane);
        else swa_kv_out3(PCb, cache_k, cache_v, o_p_k, o_p_v, o_s_k, o_s_v, vb - 1280);
    }
    GRID_BAR();
    GEMM_PHASE_SPLIT(ATTB, WOUTC_T, D, Yb, b_out_c);
    GRID_BAR();
    PHASE_LOOP(NT / 8) { const int t = vb * 8 + wave;
        ln_res_w<true>(ABUF + (size_t)t * D, Yb + (size_t)t * D, ln_mix_g + D, ln_mix_b + D, ABUF + (size_t)t * D, lane); }
    GRID_BAR();
    GEMM_PHASE_SPLIT(ABUF, WQ1_T, 2048, Qb, (const float*)nullptr);
    GRID_BAR();
    { bf16x8_t tq_[4]; if (b0 < (NT / 64) * 8) peer_topk_ldq(tq_, Qb, b0 >> 3, b0 & 7, tid);
      if ((nb & 7) == 0) { peer_topk_stage_keys(KEYSB + (size_t)8 * 2 * 128 * 128, b0 & 7, lds); PHASE_LOOP((NT / 64) * 8) { peer_topk4(Qb, R_EXP, R_GATE, vb >> 3, vb & 7, lds, tq_, vb + nb < (NT / 64) * 8 ? (vb + nb) >> 3 : -1); } }
      else PHASE_LOOP((NT / 64) * 8) { peer_topk_stage_keys(KEYSB + (size_t)8 * 2 * 128 * 128, vb & 7, lds); peer_topk_ldq(tq_, Qb, vb >> 3, vb & 7, tid); peer_topk4(Qb, R_EXP, R_GATE, vb >> 3, vb & 7, lds, tq_, -1); } }
    GRID_BAR();
    asm volatile("" : "+v"(tid)); lane = tid & 63;
    { const int x = b0 & 7, tg0 = b0 >> 3, tgstep = nb >> 3, nit = (NT / 8 - tg0 + tgstep - 1) / tgstep;
      peer_u_loop(ABUF, R_EXP, TAB8 + (size_t)2 * 16384 * D + (size_t)x * 16384 * 128, PD + (size_t)x * NT * 128, x, tg0, tgstep, nit, wave, lane); }
    GRID_BAR();
    PHASE_LOOP(NT / 8) { const int t = vb * 8 + wave; peer_xk(R_EXP + (size_t)t * 128, R_GATE + (size_t)t * 128, PD + (size_t)t * 128, TSC + 2 * 16384, TSC + 3 * 16384, lane); }
    GRID_BAR();
    { const int x = b0 & 7, tg0 = b0 >> 3, tgstep = nb >> 3, nit = (NT / 8 - tg0 + tgstep - 1) / tgstep;
      peer_v_loop(R_EXP, R_GATE, TAB8 + (size_t)3 * 16384 * D + (size_t)x * 16384 * 128, OUTS, x, tg0, tgstep, nit, wave, lane); }
    GRID_BAR();
    PHASE_LOOP(NT / 8) { const int t = vb * 8 + wave; peer_xc(ABUF + (size_t)t * D, OUTS + (size_t)t * D, ln_ffn_g + D, ln_ffn_b + D, o_y + (size_t)t * D, nullptr, nullptr, lane); }
}
}

extern "C" void kernel_launch(void* const* d_in, const int* in_sizes, int n_in,
                              void* d_out, int out_size, void* d_ws, size_t ws_size,
                              hipStream_t stream) {
    static int grid_blocks = 0;
    if (!grid_blocks) {
        int dev = 0, cus = 0, per_cu = 0;
        (void)hipGetDevice(&dev);
        (void)hipDeviceGetAttribute(&cus, hipDeviceAttributeMultiprocessorCount, dev);
        if (hipFuncSetAttribute((const void*)fwd_megakernel, hipFuncAttributeMaxDynamicSharedMemorySize, LDS_BYTES) != hipSuccess) { fprintf(stderr, "hipFuncSetAttribute failed\n"); grid_blocks = -1; return; }
        (void)hipOccupancyMaxActiveBlocksPerMultiprocessor(&per_cu, (const void*)fwd_megakernel, NTH, LDS_BYTES);
        if (per_cu < 1) { fprintf(stderr, "occupancy query says %d blocks per CU\n", per_cu); grid_blocks = -1; return; }
        if (cus * per_cu < 256) { fprintf(stderr, "this kernel needs 256 co-resident workgroups (device reports %d CUs x %d)\n", cus, per_cu); grid_blocks = -1; return; }
        grid_blocks = 256;
    }
    if (grid_blocks < 0) return;
    (void)hipMemsetAsync((char*)d_ws + WS_CTL, 0, CTL_ZERO_BYTES, stream);
    MegaArgs ma{};
    for (int i = 0; i < 35; ++i) ma.in[i] = (const float*)d_in[i];
    ma.out = (float*)d_out;
    ma.ws = (unsigned char*)d_ws;
    void* args[] = {&ma};
    hipError_t e = hipLaunchCooperativeKernel((void*)fwd_megakernel, dim3(grid_blocks), dim3(NTH), args, LDS_BYTES, stream);
    if (e != hipSuccess) fprintf(stderr, "cooperative launch failed: %s (grid %d)\n", hipGetErrorString(e), grid_blocks);
}
```
